# Optimizing an MI355X kernel written in HIP

```python
import math
import jax, jax.numpy as jnp
from jax import lax
import numpy as np

D_MODEL = 2048
BATCH = 4
SEQ = 2048
DEPTH = 1
DEC_BATCH = 128
DEC_SEQ = 4
PAST_LEN = 16384
PAGE_SIZE = 128

N_HEADS_A = 8
HEAD_DK = 128
HEAD_DV = 128
QK_WIDTH = N_HEADS_A * HEAD_DK
V_WIDTH = N_HEADS_A * HEAD_DV
CONV_W = 4
CONV_CH = 2 * QK_WIDTH + V_WIDTH
CHUNK = 64
POOL_WINDOWS = (2, 4, 8, 16)
N_POOL_GROUPS = 4
POOL_WIDTH = D_MODEL // 2
POOL_GROUP = POOL_WIDTH // N_POOL_GROUPS
POOL_MAX = 16
D_FF = ((8 * D_MODEL + 3 * 256 - 1) // (3 * 256)) * 256
IN_SIZES = (QK_WIDTH, QK_WIDTH, V_WIDTH, V_WIDTH, N_HEADS_A, N_HEADS_A, POOL_WIDTH, D_MODEL, D_MODEL)
IN_WIDTH = 2 * QK_WIDTH + 2 * V_WIDTH + 2 * N_HEADS_A + POOL_WIDTH + 2 * D_MODEL
EPS = 1e-6

kernel_name = 'gated_delta_pool_hybrid_step'


def rms_norm(x, gain):
    xf = x.astype(jnp.float32)
    y = xf * lax.rsqrt(jnp.mean(xf * xf, axis=-1, keepdims=True) + EPS)
    return (y * gain.astype(jnp.float32)).astype(x.dtype)


def l2_norm(x):
    xf = x.astype(jnp.float32)
    return xf * lax.rsqrt(jnp.sum(xf * xf, axis=-1, keepdims=True) + EPS)


def ada_modulate(h, shift, scale):
    return h * (1.0 + scale[:, None, :]) + shift[:, None, :]


def causal_conv_silu(x, buf, w):
    T = x.shape[1]
    xp = jnp.concatenate([buf.astype(x.dtype), x], axis=1)
    y = xp[:, 0:T] * w[0]
    for j in range(1, CONV_W):
        y = y + xp[:, j:j + T] * w[j]
    return jax.nn.silu(y), xp[:, -(CONV_W - 1):]


def gated_delta_chunked(q, k, v, g, beta, s0):
    B, T, H, DK = q.shape
    DV = v.shape[-1]
    C = CHUNK if T % CHUNK == 0 else T
    N = T // C

    def blk(t):
        t = t.reshape((B, N, C) + t.shape[2:])
        return jnp.moveaxis(t, 3, 2) if t.ndim == 5 else jnp.moveaxis(t, 3, 2)

    q = blk(q) * (DK ** -0.5)
    k = blk(k)
    v = blk(v)
    g = blk(g)
    beta = blk(beta)
    decay = jnp.cumsum(g, axis=-1)
    idx = jnp.arange(C)
    causal = idx[:, None] >= idx[None, :]
    strict = idx[:, None] > idx[None, :]
    diff = decay[..., :, None] - decay[..., None, :]
    lmask = jnp.where(causal, jnp.exp(jnp.where(causal, diff, 0.0)), 0.0)
    kb = k * beta[..., None]
    m = jnp.where(strict, jnp.einsum('bnhrd,bnhsd->bnhrs', kb, k) * lmask, 0.0)
    eye = jnp.eye(C, dtype=jnp.float32)
    tmat = lax.linalg.triangular_solve(eye + m, jnp.broadcast_to(eye, m.shape), left_side=True, lower=True, unit_diagonal=True)
    u_base = jnp.einsum('bnhrs,bnhsv->bnhrv', tmat, v * beta[..., None])
    w_dec = jnp.einsum('bnhrs,bnhsd->bnhrd', tmat, kb * jnp.exp(decay)[..., None])
    qk = jnp.einsum('bnhrd,bnhsd->bnhrs', q, k) * lmask
    last = decay[..., -1:]
    k_tail = k * jnp.exp(last - decay)[..., None]
    q_dec = q * jnp.exp(decay)[..., None]
    chunk_decay = jnp.exp(last[..., 0])
    xs = (u_base.swapaxes(0, 1), w_dec.swapaxes(0, 1), qk.swapaxes(0, 1), k_tail.swapaxes(0, 1), q_dec.swapaxes(0, 1), chunk_decay.swapaxes(0, 1))

    def step(s, inp):
        u_b, w_d, qk_c, k_t, q_d, cd = inp
        u = u_b - jnp.einsum('bhrd,bhdv->bhrv', w_d, s)
        o = jnp.einsum('bhrd,bhdv->bhrv', q_d, s) + jnp.einsum('bhrs,bhsv->bhrv', qk_c, u)
        s = s * cd[..., None, None] + jnp.einsum('bhrd,bhrv->bhdv', k_t, u)
        return s, o

    s_fin, o = lax.scan(step, s0, xs)
    o = jnp.transpose(o, (1, 0, 3, 2, 4)).reshape(B, T, H, DV)
    return o, s_fin


def multiscale_pool(x, buf, pos0):
    B, T, W = x.shape
    P = POOL_MAX - 1
    xp = jnp.concatenate([buf.astype(x.dtype), x], axis=1)
    cs = jnp.cumsum(xp.astype(jnp.float32), axis=1)
    cs = jnp.concatenate([jnp.zeros((B, 1, W), jnp.float32), cs], axis=1)
    pos = pos0 + jnp.arange(T)
    xf = x.astype(jnp.float32)
    outs = []
    for gi in range(N_POOL_GROUPS):
        w = POOL_WINDOWS[gi]
        lo, hi = gi * POOL_GROUP, (gi + 1) * POOL_GROUP
        s = cs[:, P + 1:P + 1 + T, lo:hi] - cs[:, P + 1 - w:P + 1 - w + T, lo:hi]
        cnt = jnp.minimum(w, pos + 1).astype(jnp.float32)
        outs.append(s / cnt[None, :, None] - xf[:, :, lo:hi])
    return jnp.concatenate(outs, axis=-1).astype(x.dtype), xp[:, -P:]


def token_mixers(u, conv_buf, s0, pool_buf, pos0, w_in, conv_w, a_log, dt_bias, o_norm_g, pool_w, pool_scale, w_proj_a, w_proj_b, w_out):
    B, T, _ = u.shape
    f32 = jnp.float32
    proj = u @ w_in
    splits = np.cumsum(IN_SIZES)[:-1].tolist()
    q, k, v, z, a, b, xpool, ga, gb = jnp.split(proj, splits, axis=-1)
    qkv, conv_new = causal_conv_silu(jnp.concatenate([q, k, v], axis=-1), conv_buf, conv_w)
    q, k, v = jnp.split(qkv, [QK_WIDTH, 2 * QK_WIDTH], axis=-1)
    q = l2_norm(q.reshape(B, T, N_HEADS_A, HEAD_DK))
    k = l2_norm(k.reshape(B, T, N_HEADS_A, HEAD_DK))
    v = v.reshape(B, T, N_HEADS_A, HEAD_DV).astype(f32)
    beta = jax.nn.sigmoid(b.astype(f32))
    g = -jnp.exp(a_log.astype(f32)) * jax.nn.softplus(a.astype(f32) + dt_bias.astype(f32))
    o, s_new = gated_delta_chunked(q, k, v, g, beta, s0.astype(f32))
    o = rms_norm(o, o_norm_g) * jax.nn.silu(z.reshape(B, T, N_HEADS_A, HEAD_DV).astype(f32))
    y_a = o.reshape(B, T, V_WIDTH).astype(u.dtype) @ w_proj_a
    y_p, pool_new = multiscale_pool(xpool, pool_buf, pos0)
    y_p = jnp.einsum('btgc,gcd->btgd', y_p.reshape(B, T, N_POOL_GROUPS, POOL_GROUP), pool_w).reshape(B, T, POOL_WIDTH) * pool_scale
    y_b = y_p @ w_proj_b
    merged = jax.nn.sigmoid(ga) * y_a + jax.nn.sigmoid(gb) * y_b
    return merged @ w_out, s_new.astype(s0.dtype), conv_new, pool_new


def decoder_layer(x, c, s0, conv_buf, pool_buf, pos0, w_ada, b_ada, norm1_g, w_in, conv_w, a_log, dt_bias, o_norm_g, pool_w, pool_scale, w_proj_a, w_proj_b, w_out, norm2_g, w_gate_up, w_down):
    mod = jax.nn.silu(c) @ w_ada + b_ada
    sh1, sc1, gt1, sh2, sc2, gt2 = jnp.split(mod, 6, axis=-1)
    u = ada_modulate(rms_norm(x, norm1_g), sh1, sc1)
    mix, s_new, conv_new, pool_new = token_mixers(u, conv_buf, s0, pool_buf, pos0, w_in, conv_w, a_log, dt_bias, o_norm_g, pool_w, pool_scale, w_proj_a, w_proj_b, w_out)
    x = x + gt1[:, None, :] * mix
    h = ada_modulate(rms_norm(x, norm2_g), sh2, sc2)
    gate, up = jnp.split(h @ w_gate_up, 2, axis=-1)
    x = x + gt2[:, None, :] * ((jax.nn.silu(gate) * up) @ w_down)
    return x, s_new, conv_new, pool_new


def setup_inputs(seed: int = 0) -> dict:
    key = jax.random.key(seed)
    ks = jax.random.split(key, 26)
    f32 = jnp.float32
    L = DEPTH

    def nrm(k, shape, s):
        return jax.random.normal(k, shape, f32) * s

    dt = jnp.exp(jax.random.uniform(ks[13], (L, N_HEADS_A), f32, math.log(1e-3), math.log(1e-1)))
    dt_bias = dt + jnp.log(-jnp.expm1(-dt))
    return {
        'x_prompt': nrm(ks[0], (BATCH, SEQ, D_MODEL), 1.0),
        'x_sample': nrm(ks[1], (DEC_BATCH, DEC_SEQ, D_MODEL), 1.0),
        'c_prompt': nrm(ks[2], (BATCH, D_MODEL), 1.0),
        'c_sample': nrm(ks[3], (DEC_BATCH, D_MODEL), 1.0),
        'state_delta': nrm(ks[4], (L, DEC_BATCH, N_HEADS_A, HEAD_DK, HEAD_DV), 0.1),
        'state_conv': nrm(ks[5], (L, DEC_BATCH, CONV_W - 1, CONV_CH), 1.0),
        'state_pool': nrm(ks[6], (L, DEC_BATCH, POOL_MAX - 1, POOL_WIDTH), 1.0),
        'w_ada': nrm(ks[7], (L, D_MODEL, 6 * D_MODEL), 0.5 * D_MODEL ** -0.5),
        'b_ada': nrm(ks[8], (L, 6 * D_MODEL), 0.01),
        'norm1_g': 1.0 + nrm(ks[9], (L, D_MODEL), 0.02),
        'w_in': nrm(ks[10], (L, D_MODEL, IN_WIDTH), D_MODEL ** -0.5),
        'conv_w': nrm(ks[11], (L, CONV_W, CONV_CH), CONV_W ** -0.5),
        'a_log': jnp.log(jax.random.uniform(ks[12], (L, N_HEADS_A), f32, 1.0, 16.0)),
        'dt_bias': dt_bias,
        'o_norm_g': 1.0 + nrm(ks[14], (L, HEAD_DV), 0.02),
        'pool_w': nrm(ks[15], (L, N_POOL_GROUPS, POOL_GROUP, POOL_GROUP), POOL_GROUP ** -0.5),
        'pool_scale': 1.0 + nrm(ks[16], (L, POOL_WIDTH), 0.1),
        'w_proj_a': nrm(ks[17], (L, V_WIDTH, D_MODEL), V_WIDTH ** -0.5),
        'w_proj_b': nrm(ks[18], (L, POOL_WIDTH, D_MODEL), POOL_WIDTH ** -0.5),
        'w_out': nrm(ks[19], (L, D_MODEL, D_MODEL), D_MODEL ** -0.5),
        'norm2_g': 1.0 + nrm(ks[20], (L, D_MODEL), 0.02),
        'w_gate_up': nrm(ks[21], (L, D_MODEL, 2 * D_FF), D_MODEL ** -0.5),
        'w_down': nrm(ks[22], (L, D_FF, D_MODEL), D_FF ** -0.5),
        'final_g': 1.0 + nrm(ks[23], (D_MODEL,), 0.02),
    }


def reference(x_prompt, x_sample, c_prompt, c_sample, state_delta, state_conv, state_pool, w_ada, b_ada, norm1_g, w_in, conv_w, a_log, dt_bias, o_norm_g, pool_w, pool_scale, w_proj_a, w_proj_b, w_out, norm2_g, w_gate_up, w_down, final_g):
    xp, xs = x_prompt, x_sample
    dp, cp, pp, ds, cs, ps = [], [], [], [], [], []
    for l in range(DEPTH):
        lw = (w_ada[l], b_ada[l], norm1_g[l], w_in[l], conv_w[l], a_log[l], dt_bias[l], o_norm_g[l], pool_w[l], pool_scale[l], w_proj_a[l], w_proj_b[l], w_out[l], norm2_g[l], w_gate_up[l], w_down[l])
        s0_p = jnp.zeros((BATCH, N_HEADS_A, HEAD_DK, HEAD_DV), state_delta.dtype)
        conv0_p = jnp.zeros((BATCH, CONV_W - 1, CONV_CH), xp.dtype)
        pool0_p = jnp.zeros((BATCH, POOL_MAX - 1, POOL_WIDTH), xp.dtype)
        xp, s_p, c_p, p_p = decoder_layer(xp, c_prompt, s0_p, conv0_p, pool0_p, 0, *lw)
        xs, s_s, c_s, p_s = decoder_layer(xs, c_sample, state_delta[l], state_conv[l], state_pool[l], PAST_LEN, *lw)
        dp.append(s_p); cp.append(c_p); pp.append(p_p)
        ds.append(s_s); cs.append(c_s); ps.append(p_s)
    y_prompt = rms_norm(xp, final_g)
    y_sample = rms_norm(xs, final_g)
    return (y_prompt, y_sample, jnp.stack(dp), jnp.stack(cp), jnp.stack(pp), jnp.stack(ds), jnp.stack(cs), jnp.stack(ps))
```

```cpp
#include <hip/hip_runtime.h>
#include <hip/hip_cooperative_groups.h>
#include <cstdio>
#include <cstring>
namespace cg = cooperative_groups;

#ifndef MK_PER_PHASE
#define MK_PER_PHASE 0
#endif

#define LAS __attribute__((address_space(3)))
typedef unsigned short bf16_t;
typedef short bf16x8 __attribute__((ext_vector_type(8)));
typedef float f32x4 __attribute__((ext_vector_type(4)));
typedef float f32x2 __attribute__((ext_vector_type(2)));
typedef unsigned u32x4 __attribute__((ext_vector_type(4)));
typedef unsigned u32x2 __attribute__((ext_vector_type(2)));

constexpr int DM = 2048, TP = 8192, TS = 512, TT = 8704, NB = 132;
constexpr int NPROJ = 9472;
constexpr int DFF = 5632;
constexpr int MODW = 12288;
constexpr float EPS = 1e-6f;
constexpr int C_Q = 0, C_K = 1024, C_V = 2048, C_Z = 3072, C_XP = 4096, C_GA = 5120, C_GB = 7168, C_AB = 9216;
constexpr size_t O_Y = 0, O_DP = 17825792, O_CP = 18350080, O_PP = 18386944, O_DS = 18448384, O_CS = 35225600, O_PS = 36405248;
constexpr size_t OS_O = 0, OS_UB = 8912896;
constexpr size_t WS_WIN = 0;
constexpr size_t WS_WGU = WS_WIN + (size_t)NPROJ * 2048 * 2;
constexpr size_t WS_WD = WS_WGU + (size_t)11264 * 2048 * 2;
constexpr size_t WS_WO = WS_WD + (size_t)2048 * 5632 * 2;
constexpr size_t WS_WAB = WS_WO + (size_t)2048 * 2048 * 2;
constexpr size_t WS_PW = WS_WAB + (size_t)2048 * 2048 * 2;
constexpr size_t WS_AADA = WS_PW + (size_t)1024 * 256 * 2;
constexpr size_t WS_MOD = WS_AADA + (size_t)256 * 2048 * 2;
constexpr size_t WS_G = WS_MOD + (size_t)NB * MODW * 4;
constexpr size_t WS_BETA = WS_G + (size_t)TT * 8 * 4;
constexpr size_t WS_CD = WS_BETA + (size_t)TT * 8 * 4;
constexpr size_t WS_U = WS_CD + 4096;
constexpr size_t WS_QN = WS_U + (size_t)TT * 2048 * 2;
constexpr size_t WS_KN = WS_QN + (size_t)TT * 1024 * 2;
constexpr size_t WS_VV = WS_KN + (size_t)TT * 1024 * 2;
constexpr size_t WS_YP = WS_VV + (size_t)TT * 1024 * 2;
constexpr size_t WS_WDC = WS_YP + (size_t)TT * 1024 * 2;
constexpr size_t WS_QD = WS_WDC + (size_t)1024 * 64 * 128 * 2;
constexpr size_t WS_KT = WS_QD + (size_t)1024 * 64 * 128 * 2;
constexpr size_t WS_QK = WS_KT + (size_t)1024 * 64 * 128 * 2;
constexpr size_t WS_PROJ = WS_QK + (size_t)1024 * 64 * 64 * 2;
constexpr size_t WS_END = WS_PROJ + (size_t)TT * NPROJ * 2;
static_assert(WS_END <= 501510720ull, "workspace too large");
static_assert((WS_PROJ % 256) == 0 && (WS_QK % 256) == 0 && (WS_U % 256) == 0, "align");

constexpr int LDS_BYTES = 147456;

struct Params {
    const float* in[24];
    float* out;
    unsigned char* ws;
    int ph_lo, ph_hi;
};

__device__ __forceinline__ float bf2f(unsigned short x) { return __uint_as_float(((unsigned)x) << 16); }
__device__ __forceinline__ unsigned short f2bf(float f) { unsigned u = __float_as_uint(f); u += 0x7FFFu + ((u >> 16) & 1u); return (unsigned short)(u >> 16); }
__device__ __forceinline__ unsigned pk2(float lo, float hi) { return (unsigned)f2bf(lo) | ((unsigned)f2bf(hi) << 16); }
__device__ __forceinline__ void unpack8(const u32x4 w, float* f) {
    f[0] = __uint_as_float(w.x << 16); f[1] = __uint_as_float(w.x & 0xffff0000u);
    f[2] = __uint_as_float(w.y << 16); f[3] = __uint_as_float(w.y & 0xffff0000u);
    f[4] = __uint_as_float(w.z << 16); f[5] = __uint_as_float(w.z & 0xffff0000u);
    f[6] = __uint_as_float(w.w << 16); f[7] = __uint_as_float(w.w & 0xffff0000u);
}
__device__ __forceinline__ u32x4 pack8(const float* f) { u32x4 w; w.x = pk2(f[0], f[1]); w.y = pk2(f[2], f[3]); w.z = pk2(f[4], f[5]); w.w = pk2(f[6], f[7]); return w; }
__device__ __forceinline__ float sigmoidf_(float x) { return 1.0f / (1.0f + __expf(-x)); }
__device__ __forceinline__ float siluf_(float x) { return x / (1.0f + __expf(-x)); }
__device__ __forceinline__ int bidx_of_row(int row) { return row < TP ? (row >> 11) : 4 + ((row - TP) >> 2); }

namespace pg8 {
constexpr int BM = 256, BK = 64, HALF = 128, HTB = HALF * BK * 2, STAGE_BYTES = 8 * HTB, NXCD = 8, WGM = 8;
__host__ __device__ __forceinline__ int lds_byte(int r, int c) { const int st = (r >> 4) * 2 + (c >> 5), rr = r & 15, cc = c & 31, ob = rr * 64 + cc * 2; return st * 1024 + (ob ^ (((ob >> 9) & 1) << 5)); }
__host__ __device__ __forceinline__ void stage_rc(int b, int& R, int& C) { const int st = b / 1024, sb = b % 1024, swz = sb ^ (((sb >> 9) & 1) << 5); R = (st >> 1) * 16 + swz / 64; C = (st & 1) * 32 + (swz % 64) / 2; }
__host__ __device__ __forceinline__ int perm32(int rho) { const int n = rho >> 4, i = rho & 15; return 8 * (i >> 2) + 4 * n + (i & 3); }

struct Unit { int pm, pn; };
struct Gemm { const bf16_t* A; const bf16_t* Bt; int lda, ldb, K; size_t a_pn_off; };

struct StaticOrder {
    int nM, nN, nwg, G, c;
    __device__ void init(int M, int N, int G_, int c_) { nM = M / BM; nN = N / BM; nwg = nM * nN; G = G_; c = c_; }
    __device__ bool next(int i, Unit& u) const {
        const long L = (long)i * G + c; if (L >= nwg) return false;
        int wgid = (int)L; { const int q = nwg / NXCD, r = nwg % NXCD, xcd = wgid % NXCD, off = wgid / NXCD; wgid = (xcd < r ? xcd * (q + 1) : r * (q + 1) + (xcd - r) * q) + off; }
        const int nig = WGM * nN, gid = wgid / nig, fm = gid * WGM, gsz = (nM - fm) < WGM ? (nM - fm) : WGM;
        u.pm = fm + ((wgid % nig) % gsz); u.pn = (wgid % nig) / gsz; return true;
    }
};
struct OneUnitOrder {
    int n, c;
    __device__ bool next(int i, Unit& u) const { if (i != 0 || c >= n) return false; u.pm = 0; u.pn = c; return true; }
};

template <class Epi, class Sched>
__device__ __forceinline__ void gemm_phase(LAS unsigned char* lds, const Gemm g, const Sched& S, const Epi& E) {
    const int tid = threadIdx.x, wid = __builtin_amdgcn_readfirstlane(tid >> 6), lane = tid & 63, wr = wid >> 2, wc = wid & 3, fr = lane & 15, fq = lane >> 4;
    const int K = g.K, nt = K / BK;
    unsigned voffA[2], voffB[2];
#pragma unroll
    for (int i = 0; i < 2; ++i) { int R, C; stage_rc(tid * 16 + i * 8192, R, C); const int Rb = Epi::PERM ? ((R & ~31) + perm32(R & 31)) : R;
        voffA[i] = (unsigned)(R * g.lda + C) * 2u; voffB[i] = (unsigned)(Rb * g.ldb + C) * 2u; }
    const size_t kstep = (size_t)(BK * 2);
    const size_t hstepA = (size_t)HALF * g.lda * 2, hstepB = (size_t)HALF * g.ldb * 2;
    const size_t tstepA = 2 * hstepA, tstepB = 2 * hstepB;
    const unsigned ldsw = (unsigned)wid * 1024u;
    const int aoff = lds_byte(wr * 64 + fr, fq * 8), boff = lds_byte(wc * 32 + fr, fq * 8);
#define PG8_SA(b, h) (((b) * 2 + (h)) * HTB)
#define PG8_SB(b, h) ((4 + (b) * 2 + (h)) * HTB)
#define PG8_STAGE(bufoff, gbase, voff) do { _Pragma("unroll") for (int _i = 0; _i < 2; ++_i) \
        __builtin_amdgcn_global_load_lds((const unsigned*)((const char*)(gbase) + (voff)[_i]), (LAS unsigned*)(lds + (bufoff) + ldsw + _i * 8192), 16, 0, 0); } while (0)
#define PG8_LDA(dst, b, h) do { _Pragma("unroll") for (int m = 0; m < 4; ++m) _Pragma("unroll") for (int k = 0; k < 2; ++k) dst[m][k] = *(const LAS bf16x8*)(lds + PG8_SA(b, h) + aoff + m * 2048 + k * 1024); } while (0)
#define PG8_LDB(dst, b, h) do { _Pragma("unroll") for (int n = 0; n < 2; ++n) _Pragma("unroll") for (int k = 0; k < 2; ++k) dst[n][k] = *(const LAS bf16x8*)(lds + PG8_SB(b, h) + boff + n * 2048 + k * 1024); } while (0)
#define PG8_MMA(ai, bj, At, Bt) do { __builtin_amdgcn_s_setprio(1); _Pragma("unroll") for (int m = 0; m < 4; ++m) _Pragma("unroll") for (int n = 0; n < 2; ++n) _Pragma("unroll") for (int k = 0; k < 2; ++k) \
        acc[ai][bj][m][n] = __builtin_amdgcn_mfma_f32_16x16x32_bf16(Bt[n][k], At[m][k], acc[ai][bj][m][n], 0, 0, 0); __builtin_amdgcn_s_setprio(0); } while (0)
#define PG8_WAIT_V(n) asm volatile("s_waitcnt vmcnt(" #n ")" ::: "memory")
#define PG8_WAIT_L(n) asm volatile("s_waitcnt lgkmcnt(" #n ")" ::: "memory")
#define PG8_BAR __builtin_amdgcn_s_barrier()
#define PG8_SCHED __builtin_amdgcn_sched_barrier(0)
    Unit cur, nxt; int ui = 0;
    if (!S.next(0, cur)) return;
    f32x4 acc[2][2][4][2];
#pragma unroll
    for (int a = 0; a < 2; ++a)
#pragma unroll
        for (int b = 0; b < 2; ++b)
#pragma unroll
            for (int m = 0; m < 4; ++m)
#pragma unroll
                for (int n = 0; n < 2; ++n) acc[a][b][m][n] = (f32x4){0.f, 0.f, 0.f, 0.f};
    bf16x8 At[4][2], B0[2][2], B1[2][2];
    const char* cA = (const char*)g.A + (size_t)cur.pm * tstepA + (size_t)cur.pn * g.a_pn_off; const char* cB = (const char*)g.Bt + (size_t)cur.pn * tstepB;
    PG8_STAGE(PG8_SB(0, 0), cB, voffB); PG8_STAGE(PG8_SA(0, 0), cA, voffA); PG8_STAGE(PG8_SB(0, 1), cB + hstepB, voffB); PG8_STAGE(PG8_SA(0, 1), cA + hstepA, voffA);
    if (wr == 1) PG8_BAR;
    PG8_WAIT_V(4); PG8_BAR;
    PG8_STAGE(PG8_SB(1, 0), cB + kstep, voffB); PG8_STAGE(PG8_SA(1, 0), cA + kstep, voffA); PG8_STAGE(PG8_SB(1, 1), cB + hstepB + kstep, voffB);
    PG8_WAIT_V(6); PG8_BAR;
    for (;;) {
        const bool has_next = S.next(ui + 1, nxt);
        const char* nA = has_next ? (const char*)g.A + (size_t)nxt.pm * tstepA + (size_t)nxt.pn * g.a_pn_off : cA; const char* nB = has_next ? (const char*)g.Bt + (size_t)nxt.pn * tstepB : cB;
#pragma unroll 1
        for (int t = 0; t < nt; t += 2) {
            const bool last = (t == nt - 2);
            const char* a1 = cA + (size_t)(t + 1) * kstep;
            const char* a2 = last ? nA : cA + (size_t)(t + 2) * kstep; const char* b2 = last ? nB : cB + (size_t)(t + 2) * kstep;
            const char* a3 = a2 + kstep; const char* b3 = b2 + kstep;
            PG8_LDB(B0, 0, 0); PG8_SCHED; PG8_LDA(At, 0, 0); PG8_STAGE(PG8_SA(1, 1), a1 + hstepA, voffA);
            PG8_WAIT_L(8); PG8_BAR; PG8_WAIT_L(0); PG8_MMA(0, 0, At, B0); PG8_BAR; PG8_SCHED;
            PG8_LDB(B1, 0, 1); PG8_STAGE(PG8_SB(0, 0), b2, voffB);
            PG8_BAR; PG8_WAIT_L(0); PG8_MMA(0, 1, At, B1); PG8_BAR;
            PG8_LDA(At, 0, 1); PG8_STAGE(PG8_SA(0, 0), a2, voffA);
            PG8_BAR; PG8_WAIT_L(0); PG8_MMA(1, 0, At, B0); PG8_BAR; PG8_SCHED;
            PG8_STAGE(PG8_SB(0, 1), b2 + hstepB, voffB);
            PG8_WAIT_V(6); PG8_BAR; PG8_MMA(1, 1, At, B1); PG8_BAR;
            PG8_LDB(B0, 1, 0); PG8_SCHED; PG8_LDA(At, 1, 0); PG8_STAGE(PG8_SA(0, 1), a2 + hstepA, voffA);
            PG8_WAIT_L(8); PG8_BAR; PG8_WAIT_L(0); PG8_MMA(0, 0, At, B0); PG8_BAR; PG8_SCHED;
            PG8_LDB(B1, 1, 1); PG8_STAGE(PG8_SB(1, 0), b3, voffB);
            PG8_BAR; PG8_WAIT_L(0); PG8_MMA(0, 1, At, B1); PG8_BAR;
            PG8_LDA(At, 1, 1); PG8_STAGE(PG8_SA(1, 0), a3, voffA);
            PG8_BAR; PG8_WAIT_L(0); PG8_MMA(1, 0, At, B0); PG8_BAR; PG8_SCHED;
            PG8_STAGE(PG8_SB(1, 1), b3 + hstepB, voffB);
            PG8_WAIT_V(6); PG8_BAR; PG8_MMA(1, 1, At, B1); PG8_BAR;
        }
        E(acc, cur, wr, wc, fr, fq);
        if (!has_next) break;
#pragma unroll
        for (int a = 0; a < 2; ++a)
#pragma unroll
            for (int b = 0; b < 2; ++b)
#pragma unroll
                for (int m = 0; m < 4; ++m)
#pragma unroll
                    for (int n = 0; n < 2; ++n) acc[a][b][m][n] = (f32x4){0.f, 0.f, 0.f, 0.f};
        cur = nxt; cA = nA; cB = nB; ++ui;
    }
    PG8_WAIT_V(0);
    if (wr == 0) PG8_BAR;
    PG8_BAR;
#undef PG8_SA
#undef PG8_SB
#undef PG8_STAGE
#undef PG8_LDA
#undef PG8_LDB
#undef PG8_MMA
#undef PG8_WAIT_V
#undef PG8_WAIT_L
#undef PG8_BAR
#undef PG8_SCHED
}

typedef f32x4 Acc[2][2][4][2];

struct EpiAda {
    static constexpr bool PERM = false, MID = false;
    float* C; const float* bias;
    __device__ __forceinline__ void operator()(const Acc& acc, const Unit& u, int wr, int wc, int fr, int fq) const {
        const int row0 = wr * 64 + fr, col0 = u.pn * BM + wc * 32 + 4 * fq;
#pragma unroll
        for (int ai = 0; ai < 2; ++ai)
#pragma unroll
            for (int m = 0; m < 4; ++m) { const int row = row0 + ai * HALF + m * 16; if (row < NB) {
#pragma unroll
                for (int bj = 0; bj < 2; ++bj)
#pragma unroll
                    for (int n = 0; n < 2; ++n) { const int c = col0 + bj * HALF + n * 16; *(f32x4*)(C + (size_t)row * MODW + c) = acc[ai][bj][m][n] + *(const f32x4*)(bias + c); } } }
    }
};
struct EpiBf16 {
    static constexpr bool PERM = true, MID = false;
    bf16_t* O; int ldc; int col_off; const float* scale;
    __device__ __forceinline__ void operator()(const Acc& acc, const Unit& u, int wr, int wc, int fr, int fq) const {
        const int row0 = u.pm * BM + wr * 64 + fr, col0 = u.pn * BM + wc * 32 + 8 * fq;
#pragma unroll
        for (int ai = 0; ai < 2; ++ai)
#pragma unroll
            for (int m = 0; m < 4; ++m) { bf16_t* rowp = O + (size_t)(row0 + ai * HALF + m * 16) * ldc + col_off + col0;
#pragma unroll
                for (int bj = 0; bj < 2; ++bj) { f32x4 v0 = acc[ai][bj][m][0], v1 = acc[ai][bj][m][1];
                    if (scale) { v0 *= *(const f32x4*)(scale + col0 + bj * HALF); v1 *= *(const f32x4*)(scale + col0 + bj * HALF + 4); }
                    u32x4 w; w.x = pk2(v0[0], v0[1]); w.y = pk2(v0[2], v0[3]); w.z = pk2(v1[0], v1[1]); w.w = pk2(v1[2], v1[3]);
                    *(u32x4*)(rowp + bj * HALF) = w; }
                if (scale) asm volatile("" ::: "memory"); }
    }
};
struct EpiG1 {
    static constexpr bool PERM = true, MID = false;
    float* T1; const bf16_t* proj;
    __device__ __forceinline__ void operator()(const Acc& acc, const Unit& u, int wr, int wc, int fr, int fq) const {
        const int row0 = u.pm * BM + wr * 64 + fr, col0 = u.pn * BM + wc * 32 + 8 * fq;
#pragma unroll
        for (int ai = 0; ai < 2; ++ai)
#pragma unroll
            for (int m = 0; m < 4; ++m) { const size_t row = (size_t)(row0 + ai * HALF + m * 16); const bf16_t* pr = proj + row * NPROJ + col0;
#pragma unroll
                for (int bj = 0; bj < 2; ++bj) { float ga[8]; unpack8(*(const u32x4*)(pr + C_GA + bj * HALF), ga); f32x4 v0, v1;
#pragma unroll
                    for (int j = 0; j < 4; ++j) { v0[j] = acc[ai][bj][m][0][j] * __builtin_amdgcn_rcpf(1.0f + __expf(-ga[j])); v1[j] = acc[ai][bj][m][1][j] * __builtin_amdgcn_rcpf(1.0f + __expf(-ga[4 + j])); }
                    float* o = T1 + row * DM + col0 + bj * HALF; *(f32x4*)o = v0; *(f32x4*)(o + 4) = v1; }
                asm volatile("" ::: "memory"); }
    }
};
struct EpiG2 {
    static constexpr bool PERM = true, MID = false;
    bf16_t* O; const float* T1; const bf16_t* proj;
    __device__ __forceinline__ void operator()(const Acc& acc, const Unit& u, int wr, int wc, int fr, int fq) const {
        const int row0 = u.pm * BM + wr * 64 + fr, col0 = u.pn * BM + wc * 32 + 8 * fq;
#pragma unroll
        for (int ai = 0; ai < 2; ++ai)
#pragma unroll
            for (int m = 0; m < 4; ++m) { const size_t row = (size_t)(row0 + ai * HALF + m * 16); const bf16_t* pr = proj + row * NPROJ + col0;
#pragma unroll
                for (int bj = 0; bj < 2; ++bj) { float gb[8], v[8]; unpack8(*(const u32x4*)(pr + C_GB + bj * HALF), gb);
                    const float* t = T1 + row * DM + col0 + bj * HALF; const f32x4 t0 = *(const f32x4*)t, t1 = *(const f32x4*)(t + 4);
#pragma unroll
                    for (int j = 0; j < 4; ++j) { v[j] = t0[j] + acc[ai][bj][m][0][j] * __builtin_amdgcn_rcpf(1.0f + __expf(-gb[j])); v[4 + j] = t1[j] + acc[ai][bj][m][1][j] * __builtin_amdgcn_rcpf(1.0f + __expf(-gb[4 + j])); }
                    *(u32x4*)(O + row * DM + col0 + bj * HALF) = pack8(v); }
                asm volatile("" ::: "memory"); }
    }
};
struct EpiRes {
    static constexpr bool PERM = false, MID = false;
    float* X1; const float* x0p; const float* x0s; const float* gate;
    __device__ __forceinline__ void operator()(const Acc& acc, const Unit& u, int wr, int wc, int fr, int fq) const {
        const int row0 = u.pm * BM + wr * 64 + fr, col0 = u.pn * BM + wc * 32 + 4 * fq;
#pragma unroll
        for (int ai = 0; ai < 2; ++ai)
#pragma unroll
            for (int m = 0; m < 4; ++m) { const int row = row0 + ai * HALF + m * 16; const int b = bidx_of_row(row);
                const float* xr = (row < TP) ? x0p + (size_t)row * DM : x0s + (size_t)(row - TP) * DM; const float* gr = gate + (size_t)b * MODW; float* orow = X1 + (size_t)row * DM;
#pragma unroll
                for (int bj = 0; bj < 2; ++bj)
#pragma unroll
                    for (int n = 0; n < 2; ++n) { const int c = col0 + bj * HALF + n * 16; const f32x4 xv = *(const f32x4*)(xr + c), gv = *(const f32x4*)(gr + c);
                        *(f32x4*)(orow + c) = xv + gv * acc[ai][bj][m][n]; } }
    }
};
struct EpiGU {
    static constexpr bool PERM = true, MID = false;
    bf16_t* O;
    __device__ __forceinline__ void operator()(const Acc& acc, const Unit& u, int wr, int wc, int fr, int fq) const {
        const int row0 = u.pm * BM + wr * 64 + fr, col0 = u.pn * HALF + wc * 32 + 8 * fq;
#pragma unroll
        for (int ai = 0; ai < 2; ++ai)
#pragma unroll
            for (int m = 0; m < 4; ++m) { float v[8];
#pragma unroll
                for (int n = 0; n < 2; ++n)
#pragma unroll
                    for (int j = 0; j < 4; ++j) { const float gt = acc[ai][0][m][n][j]; v[4 * n + j] = gt * __builtin_amdgcn_rcpf(1.0f + __expf(-gt)) * acc[ai][1][m][n][j]; }
                *(u32x4*)(O + (size_t)(row0 + ai * HALF + m * 16) * DFF + col0) = pack8(v); }
    }
};
}

struct TJob { const float* src; bf16_t* dst; int ld_src, K, Nout, ld_dst, map, pad; };
__device__ __forceinline__ int map_col(int map, int n) {
    if (map == 1) { if (n < 4096) return n; if (n < 5120) return 4112 + (n - 4096); if (n < 9216) return 5136 + (n - 5120); if (n < 9232) return 4096 + (n - 9216); return -1; }
    if (map == 2) { const int pn = n >> 8, w = n & 255; return w < 128 ? 128 * pn + w : DFF + 128 * pn + (w - 128); }
    return n;
}
__device__ __forceinline__ void tjob_load(const TJob& j, int tile, f32x4 (&v)[4]) {
    const int tid = threadIdx.x, nkt = j.K >> 7, tn = tile / nkt, tk = tile - tn * nkt;
    const int n = tn * 64 + (tid & 15) * 4, kr = tid >> 4, col = map_col(j.map, n);
#pragma unroll
    for (int i = 0; i < 4; ++i) v[i] = col >= 0 ? __builtin_nontemporal_load((const f32x4*)(j.src + (size_t)(tk * 128 + kr + 32 * i) * j.ld_src + col)) : (f32x4){0.f, 0.f, 0.f, 0.f};
}
__device__ __forceinline__ void tjob_store(const TJob& j, int tile, const f32x4 (&v)[4], LAS float* s) {
    const int tid = threadIdx.x, nkt = j.K >> 7, tn = tile / nkt, tk = tile - tn * nkt;
    const int nq = tid & 15, kr = tid >> 4;
    __syncthreads();
#pragma unroll
    for (int i = 0; i < 4; ++i)
#pragma unroll
        for (int q = 0; q < 4; ++q) s[(4 * nq + q) * 129 + kr + 32 * i] = v[i][q];
    __syncthreads();
    const int n = tid >> 3, k16 = (tid & 7) * 16;
    float f[16];
#pragma unroll
    for (int i = 0; i < 16; ++i) f[i] = s[n * 129 + k16 + i];
    bf16_t* d = j.dst + (size_t)(tn * 64 + n) * j.ld_dst + tk * 128 + k16;
    *(u32x4*)d = pack8(f); *(u32x4*)(d + 8) = pack8(f + 8);
}
__device__ void transpose_jobs(const TJob* jobs, int njobs, int bi, int nblk, LAS unsigned char* lds) {
    LAS float* s = (LAS float*)lds;
    int total = 0;
    for (int q = 0; q < njobs; ++q) total += (jobs[q].Nout >> 6) * (jobs[q].K >> 7);
    f32x4 v[4]; int curj = 0, base = 0;
    int t = bi;
    auto locate = [&](int tt, int& jj, int& bb) { while (tt >= bb + (jobs[jj].Nout >> 6) * (jobs[jj].K >> 7)) { bb += (jobs[jj].Nout >> 6) * (jobs[jj].K >> 7); ++jj; } };
    if (t < total) { locate(t, curj, base); tjob_load(jobs[curj], t - base, v); }
    while (t < total) {
        const int tn = t + nblk; int nj = curj, nb = base; f32x4 w[4];
        if (tn < total) { locate(tn, nj, nb); tjob_load(jobs[nj], tn - nb, w); }
        tjob_store(jobs[curj], t - base, v, s);
        if (tn < total) {
#pragma unroll
            for (int i = 0; i < 4; ++i) v[i] = w[i]; }
        t = tn; curj = nj; base = nb;
    }
    __syncthreads();
}

template <int MODE>
__device__ void norm_phase(const Params& p, int bid, int nblk) {
    const int lane = threadIdx.x & 63, wid = threadIdx.x >> 6;
    const float* mod = (const float*)(p.ws + WS_MOD);
    const float* gain = MODE == 0 ? p.in[9] : (MODE == 1 ? p.in[20] : p.in[23]);
    bf16_t* U = (bf16_t*)(p.ws + WS_U);
    for (int row = bid * 8 + wid; row < TT; row += nblk * 8) {
        const float* src = MODE == 0 ? (row < TP ? p.in[0] + (size_t)row * DM : p.in[1] + (size_t)(row - TP) * DM) : p.out + O_Y + (size_t)row * DM;
        f32x4 v[8]; float ss = 0.f;
#pragma unroll
        for (int i = 0; i < 8; ++i) { v[i] = *(const f32x4*)(src + i * 256 + lane * 4); ss += v[i][0] * v[i][0] + v[i][1] * v[i][1] + v[i][2] * v[i][2] + v[i][3] * v[i][3]; }
#pragma unroll
        for (int o = 32; o >= 1; o >>= 1) ss += __shfl_xor(ss, o);
        const float rstd = rsqrtf(ss * (1.0f / DM) + EPS);
        if (MODE == 2) {
            float* dst = p.out + O_Y + (size_t)row * DM;
#pragma unroll
            for (int i = 0; i < 8; ++i) { const f32x4 g = *(const f32x4*)(gain + i * 256 + lane * 4); *(f32x4*)(dst + i * 256 + lane * 4) = v[i] * rstd * g; }
        } else {
            const float* sh = mod + (size_t)bidx_of_row(row) * MODW + (MODE == 0 ? 0 : 6144); const float* sc = sh + 2048;
#pragma unroll
            for (int i = 0; i < 8; ++i) { const int c = i * 256 + lane * 4; const f32x4 g = *(const f32x4*)(gain + c), s1 = *(const f32x4*)(sc + c), s0 = *(const f32x4*)(sh + c);
                const f32x4 y = (v[i] * rstd * g) * (1.0f + s1) + s0; u32x2 w; w.x = pk2(y[0], y[1]); w.y = pk2(y[2], y[3]); *(u32x2*)(U + (size_t)row * DM + c) = w; }
        }
    }
}

__device__ void mixer_prep_phase(const Params& p, int bid, int nblk) {
    const int tid = threadIdx.x;
    const bf16_t* proj = (const bf16_t*)(p.ws + WS_PROJ);
    bf16_t* qn = (bf16_t*)(p.ws + WS_QN); bf16_t* kn = (bf16_t*)(p.ws + WS_KN); bf16_t* vv = (bf16_t*)(p.ws + WS_VV); bf16_t* yp = (bf16_t*)(p.ws + WS_YP);
    float* gbuf = (float*)(p.ws + WS_G); float* bbuf = (float*)(p.ws + WS_BETA);
    for (int it = bid; it < 640; it += nblk) {
        const bool smp = it >= 512; const int sb = it - 512;
        const int b = smp ? 0 : (it >> 7), t0 = smp ? 0 : (it & 127) * 16, ntok = smp ? 4 : 16;
        const int rowbase = smp ? TP + sb * 4 : b * 2048 + t0;
        if (tid < 384) {
            const int c0 = tid * 8;
            float w0[8], w1[8], w2[8], w3[8], xm3[8], xm2[8], xm1[8];
            const float* cw = p.in[11];
#pragma unroll
            for (int i = 0; i < 8; ++i) { w0[i] = cw[c0 + i]; w1[i] = cw[3072 + c0 + i]; w2[i] = cw[6144 + c0 + i]; w3[i] = cw[9216 + c0 + i]; }
            if (smp) { const float* sc = p.in[5] + (size_t)sb * 3 * 3072 + c0;
#pragma unroll
                for (int i = 0; i < 8; ++i) { xm3[i] = sc[i]; xm2[i] = sc[3072 + i]; xm1[i] = sc[6144 + i]; }
            } else if (t0 == 0) {
#pragma unroll
                for (int i = 0; i < 8; ++i) { xm3[i] = 0.f; xm2[i] = 0.f; xm1[i] = 0.f; }
            } else {
                unpack8(*(const u32x4*)(proj + (size_t)(rowbase - 3) * NPROJ + c0), xm3); unpack8(*(const u32x4*)(proj + (size_t)(rowbase - 2) * NPROJ + c0), xm2); unpack8(*(const u32x4*)(proj + (size_t)(rowbase - 1) * NPROJ + c0), xm1);
            }
            for (int t = 0; t < ntok; ++t) {
                const int row = rowbase + t; float xt[8], y[8];
                unpack8(*(const u32x4*)(proj + (size_t)row * NPROJ + c0), xt);
                float ss = 0.f;
#pragma unroll
                for (int i = 0; i < 8; ++i) { const float a = w0[i] * xm3[i] + w1[i] * xm2[i] + w2[i] * xm1[i] + w3[i] * xt[i]; y[i] = siluf_(a); ss += y[i] * y[i]; }
                if (c0 < 2048) {
                    ss += __shfl_xor(ss, 1); ss += __shfl_xor(ss, 2); ss += __shfl_xor(ss, 4); ss += __shfl_xor(ss, 8);
                    const float inv = rsqrtf(ss + EPS);
#pragma unroll
                    for (int i = 0; i < 8; ++i) y[i] *= inv;
                }
                bf16_t* dst = c0 < 1024 ? qn + (size_t)row * 1024 + c0 : (c0 < 2048 ? kn + (size_t)row * 1024 + (c0 - 1024) : vv + (size_t)row * 1024 + (c0 - 2048));
                *(u32x4*)dst = pack8(y);
                if (smp) { if (t >= 1) { float* o = p.out + O_CS + ((size_t)sb * 3 + (t - 1)) * 3072 + c0; *(f32x4*)o = (f32x4){xt[0], xt[1], xt[2], xt[3]}; *(f32x4*)(o + 4) = (f32x4){xt[4], xt[5], xt[6], xt[7]}; } }
                else if (t0 + t >= 2045) { float* o = p.out + O_CP + ((size_t)b * 3 + (t0 + t - 2045)) * 3072 + c0; *(f32x4*)o = (f32x4){xt[0], xt[1], xt[2], xt[3]}; *(f32x4*)(o + 4) = (f32x4){xt[4], xt[5], xt[6], xt[7]}; }
#pragma unroll
                for (int i = 0; i < 8; ++i) { xm3[i] = xm2[i]; xm2[i] = xm1[i]; xm1[i] = xt[i]; }
            }
        } else {
            const int pc = (tid - 384) * 8, gi = pc >> 8, w = 2 << gi;
            const int seqrow0 = smp ? TP + sb * 4 : b * 2048;
            const float* sp = p.in[6] + (size_t)sb * 15 * 1024 + pc;
            auto xpool = [&](int tt, float* f) {
                if (tt >= 0) unpack8(*(const u32x4*)(proj + (size_t)(seqrow0 + tt) * NPROJ + C_XP + pc), f);
                else if (smp) { const float* s = sp + (size_t)(15 + tt) * 1024;
#pragma unroll
                    for (int i = 0; i < 8; ++i) f[i] = s[i]; }
                else {
#pragma unroll
                    for (int i = 0; i < 8; ++i) f[i] = 0.f; }
            };
            float s[8], f[8];
#pragma unroll
            for (int i = 0; i < 8; ++i) s[i] = 0.f;
            for (int q = 1; q < w; ++q) { xpool(t0 - q, f);
#pragma unroll
                for (int i = 0; i < 8; ++i) s[i] += f[i]; }
            for (int t = 0; t < ntok; ++t) {
                const int tt = t0 + t; float x[8], y[8];
                xpool(tt, x);
                const float cnt = smp ? (float)w : (float)min(w, tt + 1); const float ic = 1.0f / cnt;
#pragma unroll
                for (int i = 0; i < 8; ++i) { s[i] += x[i]; y[i] = s[i] * ic - x[i]; }
                *(u32x4*)(yp + (size_t)(seqrow0 + tt) * 1024 + pc) = pack8(y);
                xpool(tt - w + 1, f);
#pragma unroll
                for (int i = 0; i < 8; ++i) s[i] -= f[i];
                if (smp) { float* o = p.out + O_PS + ((size_t)sb * 15 + 11 + t) * 1024 + pc; *(f32x4*)o = (f32x4){x[0], x[1], x[2], x[3]}; *(f32x4*)(o + 4) = (f32x4){x[4], x[5], x[6], x[7]}; }
                else if (tt >= 2033) { float* o = p.out + O_PP + ((size_t)b * 15 + (tt - 2033)) * 1024 + pc; *(f32x4*)o = (f32x4){x[0], x[1], x[2], x[3]}; *(f32x4*)(o + 4) = (f32x4){x[4], x[5], x[6], x[7]}; }
            }
            if (smp) for (int r = 0; r < 11; ++r) { const float* s2 = sp + (size_t)(4 + r) * 1024; float* o = p.out + O_PS + ((size_t)sb * 15 + r) * 1024 + pc; *(f32x4*)o = *(const f32x4*)s2; *(f32x4*)(o + 4) = *(const f32x4*)(s2 + 4); }
        }
        if (tid < 256) { const int tk = tid >> 4, jj = tid & 15;
            if (tk < ntok) { const int row = rowbase + tk; const float val = bf2f(proj[(size_t)row * NPROJ + C_AB + jj]);
                if (jj < 8) { const float xx = val + p.in[13][jj]; const float spl = xx > 20.f ? xx : log1pf(__expf(xx)); gbuf[row * 8 + jj] = -__expf(p.in[12][jj]) * spl; }
                else bbuf[row * 8 + (jj - 8)] = sigmoidf_(val); } }
    }
}

constexpr int P5_QS = 0, P5_KS = 17408, P5_VS = 34816, P5_MM = 52224, P5_DEC = 68608, P5_BETA = 68864;
__device__ void chunk_prep_phase(const Params& p, int bid, int nblk, LAS unsigned char* lds) {
    const int tid = threadIdx.x, lane = tid & 63, wid = tid >> 6;
    const bf16_t* qn = (const bf16_t*)(p.ws + WS_QN); const bf16_t* kn = (const bf16_t*)(p.ws + WS_KN); const bf16_t* vv = (const bf16_t*)(p.ws + WS_VV);
    const float* gbuf = (const float*)(p.ws + WS_G); const float* bbuf = (const float*)(p.ws + WS_BETA);
    bf16_t* wdc = (bf16_t*)(p.ws + WS_WDC); bf16_t* qd = (bf16_t*)(p.ws + WS_QD); bf16_t* kt = (bf16_t*)(p.ws + WS_KT); bf16_t* qk = (bf16_t*)(p.ws + WS_QK);
    float* cdv = (float*)(p.ws + WS_CD); float* ub = p.out + OS_UB;
    LAS float* Mm = (LAS float*)(lds + P5_MM); LAS float* dec = (LAS float*)(lds + P5_DEC); LAS float* bet = (LAS float*)(lds + P5_BETA);
    const float scale = 0.08838834764831845f;
    for (int item = bid; item < 1024; item += nblk) {
        const int n = item & 31, bh = item >> 5, h = bh & 7, b = bh >> 3;
        const int r0 = b * 2048 + n * 64;
        __syncthreads();
#pragma unroll
        for (int i = 0; i < 2; ++i) { const int ch = tid + 512 * i, r = ch >> 4, c8 = (ch & 15) * 8; const size_t go = (size_t)(r0 + r) * 1024 + h * 128 + c8; const int lo = r * 272 + c8 * 2;
            *(LAS u32x4*)(lds + P5_QS + lo) = *(const u32x4*)(qn + go); *(LAS u32x4*)(lds + P5_KS + lo) = *(const u32x4*)(kn + go); *(LAS u32x4*)(lds + P5_VS + lo) = *(const u32x4*)(vv + go); }
        if (tid < 64) {
            float g = gbuf[(r0 + tid) * 8 + h];
#pragma unroll
            for (int o = 1; o < 64; o <<= 1) { const float t = __shfl_up(g, o); if (lane >= o) g += t; }
            dec[tid] = g;
        } else if (tid < 128) bet[tid - 64] = bbuf[(r0 + tid - 64) * 8 + h];
        __syncthreads();
        const float last = dec[63];
        {
            const int mat = wid >> 2, rt = wid & 3, fr = lane & 15, fq = lane >> 4;
            bf16x8 a[4];
#pragma unroll
            for (int kk = 0; kk < 4; ++kk) a[kk] = *(const LAS bf16x8*)(lds + (mat ? P5_QS : P5_KS) + (rt * 16 + fr) * 272 + (kk * 32 + fq * 8) * 2);
#pragma unroll
            for (int st = 0; st < 4; ++st) {
                f32x4 d = (f32x4){0.f, 0.f, 0.f, 0.f};
#pragma unroll
                for (int kk = 0; kk < 4; ++kk) { const bf16x8 bb = *(const LAS bf16x8*)(lds + P5_KS + (st * 16 + fr) * 272 + (kk * 32 + fq * 8) * 2); d = __builtin_amdgcn_mfma_f32_16x16x32_bf16(a[kk], bb, d, 0, 0, 0); }
                const int s = st * 16 + fr; const float ds = dec[s];
#pragma unroll
                for (int j = 0; j < 4; ++j) { const int r = rt * 16 + fq * 4 + j; const float dr = dec[r];
                    if (mat == 0) Mm[r * 64 + s] = (r > s) ? bet[r] * d[j] * __expf(dr - ds) : 0.f;
                    else qk[(size_t)item * 4096 + r * 64 + s] = f2bf((r >= s) ? scale * d[j] * __expf(dr - ds) : 0.f); }
            }
        }
        __syncthreads();
        if (tid < 256) {
            const int c = tid; float x[64];
            if (c < 128) {
#pragma unroll
                for (int r = 0; r < 64; ++r) x[r] = bf2f(*(const LAS bf16_t*)(lds + P5_VS + r * 272 + c * 2)) * bet[r];
            } else {
#pragma unroll
                for (int r = 0; r < 64; ++r) x[r] = bf2f(*(const LAS bf16_t*)(lds + P5_KS + r * 272 + (c - 128) * 2)) * bet[r] * __expf(dec[r]);
            }
#pragma unroll
            for (int r = 1; r < 64; ++r) {
                float acc = x[r];
#pragma unroll
                for (int s4 = 0; s4 < (r + 3) / 4; ++s4) { const f32x4 m4 = *(const LAS f32x4*)(Mm + r * 64 + s4 * 4);
#pragma unroll
                    for (int q = 0; q < 4; ++q) if (s4 * 4 + q < r) acc -= m4[q] * x[s4 * 4 + q]; }
                x[r] = acc;
            }
            if (c < 128) {
#pragma unroll
                for (int r = 0; r < 64; ++r) ub[(size_t)item * 8192 + r * 128 + c] = x[r];
            } else {
#pragma unroll
                for (int r = 0; r < 64; ++r) wdc[(size_t)item * 8192 + r * 128 + (c - 128)] = f2bf(-x[r]);
            }
        } else {
            const int tt = tid - 256;
#pragma unroll
            for (int i = 0; i < 4; ++i) { const int vid = tt + 256 * i, r = vid >> 4, d0 = (vid & 15) * 8; float f[8]; unpack8(*(const LAS u32x4*)(lds + P5_QS + r * 272 + d0 * 2), f);
                const float e = scale * __expf(dec[r]);
#pragma unroll
                for (int q = 0; q < 8; ++q) f[q] *= e;
                *(u32x4*)(qd + (size_t)item * 8192 + r * 128 + d0) = pack8(f); }
#pragma unroll
            for (int i = 0; i < 4; ++i) { const int vid = tt + 256 * i, d = vid >> 3, rg = (vid & 7) * 8; float f[8];
#pragma unroll
                for (int q = 0; q < 8; ++q) f[q] = bf2f(*(const LAS bf16_t*)(lds + P5_KS + (rg + q) * 272 + d * 2)) * __expf(last - dec[rg + q]);
                *(u32x4*)(kt + (size_t)item * 8192 + d * 64 + rg) = pack8(f); }
            if (tt == 0) cdv[item] = __expf(last);
        }
    }
    __syncthreads();
}

constexpr int SB_WD = 0, SB_QD = 17408, SB_KT = 34816, SB_QK = 53248, SB_UB = 62464, SB_SIZE = 66560;
constexpr int SC_ST = 2 * SB_SIZE, SC_UT = SC_ST + 4352, SC_END = SC_UT + 2304;
static_assert(SC_END <= LDS_BYTES, "lds");
__device__ void scan_phase(const Params& p, int bid, int nblk, LAS unsigned char* lds) {
    const int tid = threadIdx.x, lane = tid & 63, wid = tid >> 6, fr = lane & 15, fq = lane >> 4;
    const bf16_t* wdc = (const bf16_t*)(p.ws + WS_WDC); const bf16_t* qd = (const bf16_t*)(p.ws + WS_QD); const bf16_t* kt = (const bf16_t*)(p.ws + WS_KT); const bf16_t* qk = (const bf16_t*)(p.ws + WS_QK);
    const float* cdv = (const float*)(p.ws + WS_CD); const float* ub = p.out + OS_UB; float* obuf = p.out + OS_O;
    for (int item = bid; item < 256; item += nblk) {
        const int xcd = item & 7, iq = item >> 3, bh = xcd * 4 + (iq >> 3), sl = iq & 7, h = bh & 7, b = bh >> 3;
        u32x4 r_wd[2], r_qd[2], r_kt[2], r_qk, r_ub;
        auto gload = [&](int n) {
            const size_t it = (size_t)(bh * 32 + n);
#pragma unroll
            for (int i = 0; i < 2; ++i) { const int ch = tid + 512 * i; r_wd[i] = *(const u32x4*)(wdc + it * 8192 + ch * 8); r_qd[i] = *(const u32x4*)(qd + it * 8192 + ch * 8); r_kt[i] = *(const u32x4*)(kt + it * 8192 + ch * 8); }
            r_qk = *(const u32x4*)(qk + it * 4096 + tid * 8);
            if (tid < 256) r_ub = *(const u32x4*)(ub + it * 8192 + (tid >> 2) * 128 + sl * 16 + (tid & 3) * 4);
        };
        auto lstore = [&](int buf) {
            LAS unsigned char* B = lds + buf * SB_SIZE;
#pragma unroll
            for (int i = 0; i < 2; ++i) { const int ch = tid + 512 * i; const int r = ch >> 4, c8 = (ch & 15) * 8; *(LAS u32x4*)(B + SB_WD + r * 272 + c8 * 2) = r_wd[i]; *(LAS u32x4*)(B + SB_QD + r * 272 + c8 * 2) = r_qd[i];
                const int d = ch >> 3, t8 = (ch & 7) * 8; *(LAS u32x4*)(B + SB_KT + d * 144 + t8 * 2) = r_kt[i]; }
            { const int r = tid >> 3, s8 = (tid & 7) * 8; *(LAS u32x4*)(B + SB_QK + r * 144 + s8 * 2) = r_qk; }
            if (tid < 256) *(LAS u32x4*)(B + SB_UB + (tid >> 2) * 64 + (tid & 3) * 16) = r_ub;
        };
        __syncthreads();
        gload(0);
        for (int i = tid; i < 4352 / 4; i += 512) *(LAS unsigned*)(lds + SC_ST + i * 4) = 0u;
        lstore(0);
        f32x4 sacc = (f32x4){0.f, 0.f, 0.f, 0.f};
        __syncthreads();
        for (int n = 0; n < 32; ++n) {
            const int cur = n & 1; LAS unsigned char* B = lds + cur * SB_SIZE;
            if (n + 1 < 32) gload(n + 1);
            const float cd = cdv[bh * 32 + n];
            f32x4 acc;
            const int tw = wid & 3;
            if (wid < 4) {
#pragma unroll
                for (int j = 0; j < 4; ++j) acc[j] = *(const LAS float*)(B + SB_UB + ((tw * 16 + fq * 4 + j) * 16 + fr) * 4);
#pragma unroll
                for (int kk = 0; kk < 4; ++kk) { const bf16x8 a = *(const LAS bf16x8*)(B + SB_WD + (tw * 16 + fr) * 272 + (kk * 32 + fq * 8) * 2); const bf16x8 bb = *(const LAS bf16x8*)(lds + SC_ST + fr * 272 + (kk * 32 + fq * 8) * 2);
                    acc = __builtin_amdgcn_mfma_f32_16x16x32_bf16(a, bb, acc, 0, 0, 0); }
                u32x2 w; w.x = pk2(acc[0], acc[1]); w.y = pk2(acc[2], acc[3]);
                *(LAS u32x2*)(lds + SC_UT + fr * 144 + (tw * 16 + fq * 4) * 2) = w;
            } else {
                acc = (f32x4){0.f, 0.f, 0.f, 0.f};
#pragma unroll
                for (int kk = 0; kk < 4; ++kk) { const bf16x8 a = *(const LAS bf16x8*)(B + SB_QD + (tw * 16 + fr) * 272 + (kk * 32 + fq * 8) * 2); const bf16x8 bb = *(const LAS bf16x8*)(lds + SC_ST + fr * 272 + (kk * 32 + fq * 8) * 2);
                    acc = __builtin_amdgcn_mfma_f32_16x16x32_bf16(a, bb, acc, 0, 0, 0); }
            }
            __syncthreads();
            sacc *= cd;
#pragma unroll
            for (int kk = 0; kk < 2; ++kk) { const bf16x8 a = *(const LAS bf16x8*)(B + SB_KT + (wid * 16 + fr) * 144 + (kk * 32 + fq * 8) * 2); const bf16x8 bb = *(const LAS bf16x8*)(lds + SC_UT + fr * 144 + (kk * 32 + fq * 8) * 2);
                sacc = __builtin_amdgcn_mfma_f32_16x16x32_bf16(a, bb, sacc, 0, 0, 0); }
            if (wid >= 4) {
#pragma unroll
                for (int kk = 0; kk < 2; ++kk) { const bf16x8 a = *(const LAS bf16x8*)(B + SB_QK + (tw * 16 + fr) * 144 + (kk * 32 + fq * 8) * 2); const bf16x8 bb = *(const LAS bf16x8*)(lds + SC_UT + fr * 144 + (kk * 32 + fq * 8) * 2);
                    acc = __builtin_amdgcn_mfma_f32_16x16x32_bf16(a, bb, acc, 0, 0, 0); }
#pragma unroll
                for (int j = 0; j < 4; ++j) obuf[(size_t)(b * 2048 + n * 64 + tw * 16 + fq * 4 + j) * 1024 + h * 128 + sl * 16 + fr] = acc[j];
            }
            { u32x2 w; w.x = pk2(sacc[0], sacc[1]); w.y = pk2(sacc[2], sacc[3]); *(LAS u32x2*)(lds + SC_ST + fr * 272 + (wid * 16 + fq * 4) * 2) = w; }
            if (n + 1 < 32) lstore(cur ^ 1);
            __syncthreads();
        }
#pragma unroll
        for (int j = 0; j < 4; ++j) p.out[O_DP + ((size_t)bh * 128 + wid * 16 + fq * 4 + j) * 128 + sl * 16 + fr] = sacc[j];
    }
    __syncthreads();
    {
        const bf16_t* qn = (const bf16_t*)(p.ws + WS_QN); const bf16_t* kn = (const bf16_t*)(p.ws + WS_KN); const bf16_t* vv = (const bf16_t*)(p.ws + WS_VV);
        const float* gbuf = (const float*)(p.ws + WS_G); const float* bbuf = (const float*)(p.ws + WS_BETA);
        const int grp = tid >> 8, w4 = (tid >> 6) & 3, j = w4 * 32 + (lane & 31), half = lane >> 5;
        LAS float* qs = (LAS float*)lds + grp * 1024;
        LAS float* ks = qs + 512;
        const float scale = 0.08838834764831845f;
        for (int it0 = bid * 2; it0 < 1024; it0 += nblk * 2) {
            const int item = it0 + grp, sb = item >> 3, h = item & 7;
            __syncthreads();
#pragma unroll
            for (int i = 0; i < 4; ++i) { const int idx = (tid & 255) + 256 * i, tk = idx >> 7, c = idx & 127, t = tk & 3; const size_t go = (size_t)(TP + sb * 4 + t) * 1024 + h * 128 + c;
                if (tk < 4) qs[t * 128 + c] = bf2f(qn[go]); else ks[t * 128 + c] = bf2f(kn[go]); }
            float S[64];
            const float* s0 = p.in[4] + (size_t)item * 16384 + (size_t)half * 64 * 128 + j;
#pragma unroll
            for (int i = 0; i < 64; ++i) S[i] = __builtin_nontemporal_load(s0 + i * 128);
            __syncthreads();
#pragma unroll 1
            for (int t = 0; t < 4; ++t) {
                const int row = TP + sb * 4 + t;
                const float a = __expf(gbuf[row * 8 + h]), be = bbuf[row * 8 + h], v = bf2f(vv[(size_t)row * 1024 + h * 128 + j]);
                float kS = 0.f;
#pragma unroll
                for (int i4 = 0; i4 < 16; ++i4) { const f32x4 k4 = *(const LAS f32x4*)(ks + t * 128 + half * 64 + i4 * 4); kS += k4[0] * S[i4 * 4] + k4[1] * S[i4 * 4 + 1] + k4[2] * S[i4 * 4 + 2] + k4[3] * S[i4 * 4 + 3]; }
                kS += __shfl_xor(kS, 32);
                const float coef = be * (v - a * kS);
                float o = 0.f;
#pragma unroll
                for (int i4 = 0; i4 < 16; ++i4) { const f32x4 k4 = *(const LAS f32x4*)(ks + t * 128 + half * 64 + i4 * 4); const f32x4 q4 = *(const LAS f32x4*)(qs + t * 128 + half * 64 + i4 * 4);
#pragma unroll
                    for (int q = 0; q < 4; ++q) { S[i4 * 4 + q] = a * S[i4 * 4 + q] + k4[q] * coef; o += q4[q] * S[i4 * 4 + q]; } }
                o += __shfl_xor(o, 32);
                if (half == 0) obuf[(size_t)row * 1024 + h * 128 + j] = o * scale;
            }
            float* so = p.out + O_DS + (size_t)item * 16384 + (size_t)half * 64 * 128 + j;
#pragma unroll
            for (int i = 0; i < 64; ++i) so[i * 128] = S[i];
        }
    }
    __syncthreads();
}

__device__ void onorm_phase(const Params& p, int bid, int nblk) {
    const int lane = threadIdx.x & 63, wid = threadIdx.x >> 6;
    const float* obuf = p.out + OS_O; const bf16_t* proj = (const bf16_t*)(p.ws + WS_PROJ); bf16_t* acat = (bf16_t*)(p.ws + WS_U); const float* og = p.in[14];
    for (int row = bid * 8 + wid; row < TT; row += nblk * 8) {
        const int c0 = lane * 16; float o[16], z[16], g[16];
#pragma unroll
        for (int i = 0; i < 4; ++i) { const f32x4 v = *(const f32x4*)(obuf + (size_t)row * 1024 + c0 + i * 4); o[i * 4] = v[0]; o[i * 4 + 1] = v[1]; o[i * 4 + 2] = v[2]; o[i * 4 + 3] = v[3];
            const f32x4 gg = *(const f32x4*)(og + (c0 & 127) + i * 4); g[i * 4] = gg[0]; g[i * 4 + 1] = gg[1]; g[i * 4 + 2] = gg[2]; g[i * 4 + 3] = gg[3]; }
        unpack8(*(const u32x4*)(proj + (size_t)row * NPROJ + C_Z + c0), z); unpack8(*(const u32x4*)(proj + (size_t)row * NPROJ + C_Z + c0 + 8), z + 8);
        float ss = 0.f;
#pragma unroll
        for (int i = 0; i < 16; ++i) ss += o[i] * o[i];
        ss += __shfl_xor(ss, 1); ss += __shfl_xor(ss, 2); ss += __shfl_xor(ss, 4);
        const float rstd = rsqrtf(ss * (1.0f / 128.0f) + EPS);
#pragma unroll
        for (int i = 0; i < 16; ++i) o[i] = o[i] * rstd * g[i] * siluf_(z[i]);
        *(u32x4*)(acat + (size_t)row * DM + c0) = pack8(o); *(u32x4*)(acat + (size_t)row * DM + c0 + 8) = pack8(o + 8);
    }
}

struct KArgs { Params p; TJob jobs[11]; };
constexpr int N_PHASES = 15;
#ifndef PH_MASK
#define PH_MASK 0xFFFF
#endif

__global__ void __launch_bounds__(512, 2) fwd_megakernel(KArgs ka) {
    extern __shared__ __attribute__((aligned(16))) unsigned char lds_raw[];
    LAS unsigned char* lds = (LAS unsigned char*)lds_raw;
    const Params& p = ka.p;
    const int bid = blockIdx.x, nblk = gridDim.x;
    unsigned char* ws = p.ws;
    const int lo = p.ph_lo, hi = p.ph_hi;
#define IN(k) ((PH_MASK & (1 << (k))) && lo <= (k) && (k) < hi)
#define SEAM(k) do { if (lo <= (k) && (k) + 1 < hi) cg::this_grid().sync(); } while (0)
    if (IN(0)) {
            bf16_t* aada = (bf16_t*)(ws + WS_AADA);
            for (int idx = bid * 512 + threadIdx.x; idx < 256 * 2048; idx += nblk * 512) { const int row = idx >> 11, col = idx & 2047;
                const float v = row < 4 ? siluf_(p.in[2][row * 2048 + col]) : (row < NB ? siluf_(p.in[3][(row - 4) * 2048 + col]) : 0.f); aada[idx] = f2bf(v); }
            transpose_jobs(ka.jobs, 1, bid, nblk, lds);
        }
    SEAM(0);
    if (IN(1)) {
            if (bid < 48) { pg8::Gemm g{(const bf16_t*)(ws + WS_AADA), (const bf16_t*)(ws + WS_PROJ), 2048, 2048, 2048, 0}; pg8::OneUnitOrder S{48, bid}; pg8::EpiAda E{(float*)(ws + WS_MOD), p.in[8]}; pg8::gemm_phase(lds, g, S, E); }
            else transpose_jobs(ka.jobs + 1, 10, bid - 48, nblk - 48, lds);
        }
    SEAM(1);
    if (IN(2)) norm_phase<0>(p, bid, nblk);
    SEAM(2);
    if (IN(3)) { pg8::Gemm g{(const bf16_t*)(ws + WS_U), (const bf16_t*)(ws + WS_WIN), 2048, 2048, 2048, 0}; pg8::StaticOrder S; S.init(TT, NPROJ, nblk, bid); pg8::EpiBf16 E{(bf16_t*)(ws + WS_PROJ), NPROJ, 0, nullptr}; pg8::gemm_phase(lds, g, S, E); }
    SEAM(3);
    if (IN(4)) mixer_prep_phase(p, bid, nblk);
    SEAM(4);
    if (IN(5)) chunk_prep_phase(p, bid, nblk, lds);
    SEAM(5);
    if (IN(6)) scan_phase(p, bid, nblk, lds);
    SEAM(6);
    if (IN(7)) { onorm_phase(p, bid, nblk);
            pg8::Gemm g{(const bf16_t*)(ws + WS_YP), (const bf16_t*)(ws + WS_PW), 1024, 256, 256, 512}; pg8::StaticOrder S; S.init(TT, 1024, nblk, bid); pg8::EpiBf16 E{(bf16_t*)(ws + WS_U), DM, 1024, p.in[16]}; pg8::gemm_phase(lds, g, S, E); }
    SEAM(7);
    if (IN(8)) { pg8::Gemm g{(const bf16_t*)(ws + WS_U), (const bf16_t*)(ws + WS_WAB), 2048, 2048, 1024, 0}; pg8::StaticOrder S; S.init(TT, 2048, nblk, bid); pg8::EpiG1 E{p.out + O_Y, (const bf16_t*)(ws + WS_PROJ)}; pg8::gemm_phase(lds, g, S, E); }
    SEAM(8);
    if (IN(9)) { pg8::Gemm g{(const bf16_t*)(ws + WS_U) + 1024, (const bf16_t*)(ws + WS_WAB) + 1024, 2048, 2048, 1024, 0}; pg8::StaticOrder S; S.init(TT, 2048, nblk, bid); pg8::EpiG2 E{(bf16_t*)(ws + WS_QN), p.out + O_Y, (const bf16_t*)(ws + WS_PROJ)}; pg8::gemm_phase(lds, g, S, E); }
    SEAM(9);
    if (IN(10)) { pg8::Gemm g{(const bf16_t*)(ws + WS_QN), (const bf16_t*)(ws + WS_WO), 2048, 2048, 2048, 0}; pg8::StaticOrder S; S.init(TT, 2048, nblk, bid); pg8::EpiRes E{p.out + O_Y, p.in[0], p.in[1], (const float*)(ws + WS_MOD) + 4096}; pg8::gemm_phase(lds, g, S, E); }
    SEAM(10);
    if (IN(11)) norm_phase<1>(p, bid, nblk);
    SEAM(11);
    if (IN(12)) { pg8::Gemm g{(const bf16_t*)(ws + WS_U), (const bf16_t*)(ws + WS_WGU), 2048, 2048, 2048, 0}; pg8::StaticOrder S; S.init(TT, 11264, nblk, bid); pg8::EpiGU E{(bf16_t*)(ws + WS_PROJ)}; pg8::gemm_phase(lds, g, S, E); }
    SEAM(12);
    if (IN(13)) { pg8::Gemm g{(const bf16_t*)(ws + WS_PROJ), (const bf16_t*)(ws + WS_WD), DFF, DFF, DFF, 0}; pg8::StaticOrder S; S.init(TT, 2048, nblk, bid); pg8::EpiRes E{p.out + O_Y, p.out + O_Y, p.out + O_Y + (size_t)TP * DM, (const float*)(ws + WS_MOD) + 10240}; pg8::gemm_phase(lds, g, S, E); }
    SEAM(13);
    if (IN(14)) norm_phase<2>(p, bid, nblk);
    SEAM(14);
}

extern "C" void kernel_launch(void* const* d_in, const int* in_sizes, int n_in, void* d_out, int out_size, void* d_ws, size_t ws_size, hipStream_t stream) {
    static int grid = 0;
    if (grid == 0) {
        if (n_in != 24 || ws_size < WS_END) { fprintf(stderr, "kernel_launch: unexpected n_in %d / ws_size %zu (need %zu)\n", n_in, ws_size, (size_t)WS_END); grid = -1; return; }
        int dev = 0, cus = 0, per_cu = 0;
        hipGetDevice(&dev); hipDeviceGetAttribute(&cus, hipDeviceAttributeMultiprocessorCount, dev);
        if (hipFuncSetAttribute((const void*)fwd_megakernel, hipFuncAttributeMaxDynamicSharedMemorySize, LDS_BYTES) != hipSuccess) { fprintf(stderr, "kernel_launch: hipFuncSetAttribute failed\n"); grid = -1; return; }
        if (hipOccupancyMaxActiveBlocksPerMultiprocessor(&per_cu, (const void*)fwd_megakernel, 512, LDS_BYTES) != hipSuccess || per_cu < 1) { fprintf(stderr, "kernel_launch: occupancy query says %d\n", per_cu); per_cu = 1; }
        (void)hipGetLastError();
        grid = cus > 0 ? cus : 256;
        if (grid < 64) grid = 64;
    }
    if (grid < 0) return;
    KArgs ka; memset(&ka, 0, sizeof(ka));
    for (int i = 0; i < 24; ++i) ka.p.in[i] = (const float*)d_in[i];
    ka.p.out = (float*)d_out; ka.p.ws = (unsigned char*)d_ws;
    unsigned char* ws = (unsigned char*)d_ws;
    auto setjob = [&](int i, const void* src, void* dst, int ld_src, int K, int Nout, int ld_dst, int map) { TJob& j = ka.jobs[i]; j.src = (const float*)src; j.dst = (bf16_t*)dst; j.ld_src = ld_src; j.K = K; j.Nout = Nout; j.ld_dst = ld_dst; j.map = map; j.pad = 0; };
    setjob(0, d_in[7], ws + WS_PROJ, MODW, 2048, MODW, 2048, 0);
    setjob(1, d_in[10], ws + WS_WIN, 9232, 2048, NPROJ, 2048, 1);
    setjob(2, d_in[21], ws + WS_WGU, 2 * DFF, 2048, 2 * DFF, 2048, 2);
    setjob(3, d_in[22], ws + WS_WD, 2048, DFF, 2048, DFF, 0);
    setjob(4, d_in[19], ws + WS_WO, 2048, 2048, 2048, 2048, 0);
    setjob(5, d_in[17], ws + WS_WAB, 2048, 1024, 2048, 2048, 0);
    setjob(6, d_in[18], ws + WS_WAB + 1024 * 2, 2048, 1024, 2048, 2048, 0);
    for (int g = 0; g < 4; ++g) setjob(7 + g, (const float*)d_in[15] + g * 65536, ws + WS_PW + (size_t)g * 65536 * 2, 256, 256, 256, 256, 0);
#if MK_PER_PHASE
    for (int ph = 0; ph < N_PHASES; ++ph) { ka.p.ph_lo = ph; ka.p.ph_hi = ph + 1; hipLaunchKernelGGL(fwd_megakernel, dim3(grid), dim3(512), LDS_BYTES, stream, ka); }
#else
    ka.p.ph_lo = 0; ka.p.ph_hi = N_PHASES;
    void* args[] = {&ka};
    hipError_t e = hipLaunchCooperativeKernel((const void*)fwd_megakernel, dim3(grid), dim3(512), args, LDS_BYTES, stream);
    if (e != hipSuccess) fprintf(stderr, "cooperative launch failed: %s (grid %d)\n", hipGetErrorString(e), grid);
#endif
}
```

```cpp
#include <hip/hip_runtime.h>
#include <hip/hip_cooperative_groups.h>
#include <cstdio>
#include <cstring>
namespace cg = cooperative_groups;

#ifndef MK_PER_PHASE
#define MK_PER_PHASE 0
#endif

#define LAS __attribute__((address_space(3)))
typedef unsigned short bf16_t;
typedef short bf16x8 __attribute__((ext_vector_type(8)));
typedef float f32x4 __attribute__((ext_vector_type(4)));
typedef float f32x2 __attribute__((ext_vector_type(2)));
typedef unsigned u32x4 __attribute__((ext_vector_type(4)));
typedef unsigned u32x2 __attribute__((ext_vector_type(2)));

constexpr int DM = 2048, TP = 8192, TS = 512, TT = 8704, NB = 132;
constexpr int NPROJ = 9472;
constexpr int DFF = 5632;
constexpr int MODW = 12288;
constexpr float EPS = 1e-6f;
constexpr int C_Q = 0, C_K = 1024, C_V = 2048, C_Z = 3072, C_XP = 4096, C_GA = 5120, C_GB = 7168, C_AB = 9216;
constexpr size_t O_Y = 0, O_DP = 17825792, O_CP = 18350080, O_PP = 18386944, O_DS = 18448384, O_CS = 35225600, O_PS = 36405248;
constexpr size_t OS_O = 0, OS_UB = 8912896;
constexpr size_t WS_WIN = 0;
constexpr size_t WS_WGU = WS_WIN + (size_t)NPROJ * 2048 * 2;
constexpr size_t WS_WD = WS_WGU + (size_t)11264 * 2048 * 2;
constexpr size_t WS_WO = WS_WD + (size_t)2048 * 5632 * 2;
constexpr size_t WS_WAB = WS_WO + (size_t)2048 * 2048 * 2;
constexpr size_t WS_PW = WS_WAB + (size_t)2048 * 2048 * 2;
constexpr size_t WS_AADA = WS_PW + (size_t)1024 * 256 * 2;
constexpr size_t WS_MOD = WS_AADA + (size_t)256 * 2048 * 2;
constexpr size_t WS_G = WS_MOD + (size_t)NB * MODW * 4;
constexpr size_t WS_BETA = WS_G + (size_t)TT * 8 * 4;
constexpr size_t WS_CD = WS_BETA + (size_t)TT * 8 * 4;
constexpr size_t WS_U = WS_CD + 4096;
constexpr size_t WS_QN = WS_U + (size_t)TT * 2048 * 2;
constexpr size_t WS_KN = WS_QN + (size_t)TT * 1024 * 2;
constexpr size_t WS_VV = WS_KN + (size_t)TT * 1024 * 2;
constexpr size_t WS_YP = WS_VV + (size_t)TT * 1024 * 2;
constexpr size_t WS_WDC = WS_YP + (size_t)TT * 1024 * 2;
constexpr size_t WS_QD = WS_WDC + (size_t)1024 * 64 * 128 * 2;
constexpr size_t WS_KT = WS_QD + (size_t)1024 * 64 * 128 * 2;
constexpr size_t WS_QK = WS_KT + (size_t)1024 * 64 * 128 * 2;
constexpr size_t WS_PROJ = WS_QK + (size_t)1024 * 64 * 64 * 2;
constexpr size_t WS_END = WS_PROJ + (size_t)TT * NPROJ * 2;
static_assert(WS_END + 16384 <= 501510720ull, "workspace too large");
static_assert((WS_PROJ % 256) == 0 && (WS_QK % 256) == 0 && (WS_U % 256) == 0, "align");

constexpr int LDS_BYTES = 147456;

struct Params {
    const float* in[24];
    float* out;
    unsigned char* ws;
    int ph_lo, ph_hi;
};

__device__ __forceinline__ float bf2f(unsigned short x) { return __uint_as_float(((unsigned)x) << 16); }
__device__ __forceinline__ unsigned short f2bf(float f) { unsigned u = __float_as_uint(f); u += 0x7FFFu + ((u >> 16) & 1u); return (unsigned short)(u >> 16); }
__device__ __forceinline__ unsigned pk2(float lo, float hi) { return (unsigned)f2bf(lo) | ((unsigned)f2bf(hi) << 16); }
__device__ __forceinline__ void unpack8(const u32x4 w, float* f) {
    f[0] = __uint_as_float(w.x << 16); f[1] = __uint_as_float(w.x & 0xffff0000u);
    f[2] = __uint_as_float(w.y << 16); f[3] = __uint_as_float(w.y & 0xffff0000u);
    f[4] = __uint_as_float(w.z << 16); f[5] = __uint_as_float(w.z & 0xffff0000u);
    f[6] = __uint_as_float(w.w << 16); f[7] = __uint_as_float(w.w & 0xffff0000u);
}
__device__ __forceinline__ u32x4 pack8(const float* f) { u32x4 w; w.x = pk2(f[0], f[1]); w.y = pk2(f[2], f[3]); w.z = pk2(f[4], f[5]); w.w = pk2(f[6], f[7]); return w; }
__device__ __forceinline__ float sigmoidf_(float x) { return 1.0f / (1.0f + __expf(-x)); }
__device__ __forceinline__ float siluf_(float x) { return x / (1.0f + __expf(-x)); }
__device__ __forceinline__ int bidx_of_row(int row) { return row < TP ? (row >> 11) : 4 + ((row - TP) >> 2); }

namespace pg8 {
constexpr int BM = 256, BK = 64, HALF = 128, HTB = HALF * BK * 2, STAGE_BYTES = 8 * HTB, NXCD = 8, WGM = 8;
__host__ __device__ __forceinline__ int lds_byte(int r, int c) { const int st = (r >> 4) * 2 + (c >> 5), rr = r & 15, cc = c & 31, ob = rr * 64 + cc * 2; return st * 1024 + (ob ^ (((ob >> 9) & 1) << 5)); }
__host__ __device__ __forceinline__ void stage_rc(int b, int& R, int& C) { const int st = b / 1024, sb = b % 1024, swz = sb ^ (((sb >> 9) & 1) << 5); R = (st >> 1) * 16 + swz / 64; C = (st & 1) * 32 + (swz % 64) / 2; }
__host__ __device__ __forceinline__ int perm32(int rho) { const int n = rho >> 4, i = rho & 15; return 8 * (i >> 2) + 4 * n + (i & 3); }

struct Unit { int pm, pn; };
struct Gemm { const bf16_t* A; const bf16_t* Bt; int lda, ldb, K; size_t a_pn_off; };

struct StaticOrder {
    int nM, nN, nwg, G, c;
    __device__ void init(int M, int N, int G_, int c_) { nM = M / BM; nN = N / BM; nwg = nM * nN; G = G_; c = c_; }
    __device__ bool next(int i, Unit& u) const {
        const long L = (long)i * G + c; if (L >= nwg) return false;
        int wgid = (int)L; { const int q = nwg / NXCD, r = nwg % NXCD, xcd = wgid % NXCD, off = wgid / NXCD; wgid = (xcd < r ? xcd * (q + 1) : r * (q + 1) + (xcd - r) * q) + off; }
        const int nig = WGM * nN, gid = wgid / nig, fm = gid * WGM, gsz = (nM - fm) < WGM ? (nM - fm) : WGM;
        u.pm = fm + ((wgid % nig) % gsz); u.pn = (wgid % nig) / gsz; return true;
    }
};
struct OneUnitOrder {
    int n, c;
    __device__ bool next(int i, Unit& u) const { if (i != 0 || c >= n) return false; u.pm = 0; u.pn = c; return true; }
};

template <class Epi, class Sched>
__device__ __forceinline__ void gemm_phase(LAS unsigned char* lds, const Gemm g, const Sched& S, const Epi& E) {
    const int tid = threadIdx.x, wid = __builtin_amdgcn_readfirstlane(tid >> 6), lane = tid & 63, wr = wid >> 2, wc = wid & 3, fr = lane & 15, fq = lane >> 4;
    const int K = g.K, nt = K / BK;
    unsigned voffA[2], voffB[2];
#pragma unroll
    for (int i = 0; i < 2; ++i) { int R, C; stage_rc(tid * 16 + i * 8192, R, C); const int Rb = Epi::PERM ? ((R & ~31) + perm32(R & 31)) : R;
        voffA[i] = (unsigned)(R * g.lda + C) * 2u; voffB[i] = (unsigned)(Rb * g.ldb + C) * 2u; }
    const size_t kstep = (size_t)(BK * 2);
    const size_t hstepA = (size_t)HALF * g.lda * 2, hstepB = (size_t)HALF * g.ldb * 2;
    const size_t tstepA = 2 * hstepA, tstepB = 2 * hstepB;
    const unsigned ldsw = (unsigned)wid * 1024u;
    const int aoff = lds_byte(wr * 64 + fr, fq * 8), boff = lds_byte(wc * 32 + fr, fq * 8);
#define PG8_SA(b, h) (((b) * 2 + (h)) * HTB)
#define PG8_SB(b, h) ((4 + (b) * 2 + (h)) * HTB)
#define PG8_STAGE(bufoff, gbase, voff) do { _Pragma("unroll") for (int _i = 0; _i < 2; ++_i) \
        __builtin_amdgcn_global_load_lds((const unsigned*)((const char*)(gbase) + (voff)[_i]), (LAS unsigned*)(lds + (bufoff) + ldsw + _i * 8192), 16, 0, 0); } while (0)
#define PG8_LDA(dst, b, h) do { _Pragma("unroll") for (int m = 0; m < 4; ++m) _Pragma("unroll") for (int k = 0; k < 2; ++k) dst[m][k] = *(const LAS bf16x8*)(lds + PG8_SA(b, h) + aoff + m * 2048 + k * 1024); } while (0)
#define PG8_LDB(dst, b, h) do { _Pragma("unroll") for (int n = 0; n < 2; ++n) _Pragma("unroll") for (int k = 0; k < 2; ++k) dst[n][k] = *(const LAS bf16x8*)(lds + PG8_SB(b, h) + boff + n * 2048 + k * 1024); } while (0)
#define PG8_MMA(ai, bj, At, Bt) do { __builtin_amdgcn_s_setprio(1); _Pragma("unroll") for (int m = 0; m < 4; ++m) _Pragma("unroll") for (int n = 0; n < 2; ++n) _Pragma("unroll") for (int k = 0; k < 2; ++k) \
        acc[ai][bj][m][n] = __builtin_amdgcn_mfma_f32_16x16x32_bf16(Bt[n][k], At[m][k], acc[ai][bj][m][n], 0, 0, 0); __builtin_amdgcn_s_setprio(0); } while (0)
#define PG8_WAIT_V(n) asm volatile("s_waitcnt vmcnt(" #n ")" ::: "memory")
#define PG8_WAIT_L(n) asm volatile("s_waitcnt lgkmcnt(" #n ")" ::: "memory")
#define PG8_BAR __builtin_amdgcn_s_barrier()
#define PG8_SCHED __builtin_amdgcn_sched_barrier(0)
    Unit cur, nxt; int ui = 0;
    if (!S.next(0, cur)) return;
    f32x4 acc[2][2][4][2];
#pragma unroll
    for (int a = 0; a < 2; ++a)
#pragma unroll
        for (int b = 0; b < 2; ++b)
#pragma unroll
            for (int m = 0; m < 4; ++m)
#pragma unroll
                for (int n = 0; n < 2; ++n) acc[a][b][m][n] = (f32x4){0.f, 0.f, 0.f, 0.f};
    bf16x8 At[4][2], B0[2][2], B1[2][2];
    const char* cA = (const char*)g.A + (size_t)cur.pm * tstepA + (size_t)cur.pn * g.a_pn_off; const char* cB = (const char*)g.Bt + (size_t)cur.pn * tstepB;
    PG8_STAGE(PG8_SB(0, 0), cB, voffB); PG8_STAGE(PG8_SA(0, 0), cA, voffA); PG8_STAGE(PG8_SB(0, 1), cB + hstepB, voffB); PG8_STAGE(PG8_SA(0, 1), cA + hstepA, voffA);
    if (wr == 1) PG8_BAR;
    PG8_WAIT_V(4); PG8_BAR;
    PG8_STAGE(PG8_SB(1, 0), cB + kstep, voffB); PG8_STAGE(PG8_SA(1, 0), cA + kstep, voffA); PG8_STAGE(PG8_SB(1, 1), cB + hstepB + kstep, voffB);
    PG8_WAIT_V(6); PG8_BAR;
    for (;;) {
        const bool has_next = S.next(ui + 1, nxt);
        const char* nA = has_next ? (const char*)g.A + (size_t)nxt.pm * tstepA + (size_t)nxt.pn * g.a_pn_off : cA; const char* nB = has_next ? (const char*)g.Bt + (size_t)nxt.pn * tstepB : cB;
#pragma unroll 1
        for (int t = 0; t < nt; t += 2) {
            const bool last = (t == nt - 2);
            const char* a1 = cA + (size_t)(t + 1) * kstep;
            const char* a2 = last ? nA : cA + (size_t)(t + 2) * kstep; const char* b2 = last ? nB : cB + (size_t)(t + 2) * kstep;
            const char* a3 = a2 + kstep; const char* b3 = b2 + kstep;
            PG8_LDB(B0, 0, 0); PG8_SCHED; PG8_LDA(At, 0, 0); PG8_STAGE(PG8_SA(1, 1), a1 + hstepA, voffA);
            PG8_WAIT_L(8); PG8_BAR; PG8_WAIT_L(0); PG8_MMA(0, 0, At, B0); PG8_BAR; PG8_SCHED;
            PG8_LDB(B1, 0, 1); PG8_STAGE(PG8_SB(0, 0), b2, voffB);
            PG8_BAR; PG8_WAIT_L(0); PG8_MMA(0, 1, At, B1); PG8_BAR;
            PG8_LDA(At, 0, 1); PG8_STAGE(PG8_SA(0, 0), a2, voffA);
            PG8_BAR; PG8_WAIT_L(0); PG8_MMA(1, 0, At, B0); PG8_BAR; PG8_SCHED;
            PG8_STAGE(PG8_SB(0, 1), b2 + hstepB, voffB);
            PG8_WAIT_V(6); PG8_BAR; PG8_MMA(1, 1, At, B1); PG8_BAR;
            PG8_LDB(B0, 1, 0); PG8_SCHED; PG8_LDA(At, 1, 0); PG8_STAGE(PG8_SA(0, 1), a2 + hstepA, voffA);
            PG8_WAIT_L(8); PG8_BAR; PG8_WAIT_L(0); PG8_MMA(0, 0, At, B0); PG8_BAR; PG8_SCHED;
            PG8_LDB(B1, 1, 1); PG8_STAGE(PG8_SB(1, 0), b3, voffB);
            PG8_BAR; PG8_WAIT_L(0); PG8_MMA(0, 1, At, B1); PG8_BAR;
            PG8_LDA(At, 1, 1); PG8_STAGE(PG8_SA(1, 0), a3, voffA);
            PG8_BAR; PG8_WAIT_L(0); PG8_MMA(1, 0, At, B0); PG8_BAR; PG8_SCHED;
            PG8_STAGE(PG8_SB(1, 1), b3 + hstepB, voffB);
            PG8_WAIT_V(6); PG8_BAR; PG8_MMA(1, 1, At, B1); PG8_BAR;
        }
        E(acc, cur, wr, wc, fr, fq);
        if (!has_next) break;
#pragma unroll
        for (int a = 0; a < 2; ++a)
#pragma unroll
            for (int b = 0; b < 2; ++b)
#pragma unroll
                for (int m = 0; m < 4; ++m)
#pragma unroll
                    for (int n = 0; n < 2; ++n) acc[a][b][m][n] = (f32x4){0.f, 0.f, 0.f, 0.f};
        cur = nxt; cA = nA; cB = nB; ++ui;
    }
    PG8_WAIT_V(0);
    if (wr == 0) PG8_BAR;
    PG8_BAR;
#undef PG8_SA
#undef PG8_SB
#undef PG8_STAGE
#undef PG8_LDA
#undef PG8_LDB
#undef PG8_MMA
#undef PG8_WAIT_V
#undef PG8_WAIT_L
#undef PG8_BAR
#undef PG8_SCHED
}

typedef f32x4 Acc[2][2][4][2];

struct EpiAda {
    static constexpr bool PERM = false, MID = false;
    float* C; const float* bias;
    __device__ __forceinline__ void operator()(const Acc& acc, const Unit& u, int wr, int wc, int fr, int fq) const {
        const int row0 = wr * 64 + fr, col0 = u.pn * BM + wc * 32 + 4 * fq;
#pragma unroll
        for (int ai = 0; ai < 2; ++ai)
#pragma unroll
            for (int m = 0; m < 4; ++m) { const int row = row0 + ai * HALF + m * 16; if (row < NB) {
#pragma unroll
                for (int bj = 0; bj < 2; ++bj)
#pragma unroll
                    for (int n = 0; n < 2; ++n) { const int c = col0 + bj * HALF + n * 16; *(f32x4*)(C + (size_t)row * MODW + c) = acc[ai][bj][m][n] + *(const f32x4*)(bias + c); } } }
    }
};
struct EpiBf16 {
    static constexpr bool PERM = true, MID = false;
    bf16_t* O; int ldc; int col_off; const float* scale;
    __device__ __forceinline__ void operator()(const Acc& acc, const Unit& u, int wr, int wc, int fr, int fq) const {
        const int row0 = u.pm * BM + wr * 64 + fr, col0 = u.pn * BM + wc * 32 + 8 * fq;
#pragma unroll
        for (int ai = 0; ai < 2; ++ai)
#pragma unroll
            for (int m = 0; m < 4; ++m) { bf16_t* rowp = O + (size_t)(row0 + ai * HALF + m * 16) * ldc + col_off + col0;
#pragma unroll
                for (int bj = 0; bj < 2; ++bj) { f32x4 v0 = acc[ai][bj][m][0], v1 = acc[ai][bj][m][1];
                    if (scale) { v0 *= *(const f32x4*)(scale + col0 + bj * HALF); v1 *= *(const f32x4*)(scale + col0 + bj * HALF + 4); }
                    u32x4 w; w.x = pk2(v0[0], v0[1]); w.y = pk2(v0[2], v0[3]); w.z = pk2(v1[0], v1[1]); w.w = pk2(v1[2], v1[3]);
                    *(u32x4*)(rowp + bj * HALF) = w; }
                if (scale) asm volatile("" ::: "memory"); }
    }
};
struct EpiG1 {
    static constexpr bool PERM = true, MID = false;
    float* T1; const bf16_t* proj;
    __device__ __forceinline__ void operator()(const Acc& acc, const Unit& u, int wr, int wc, int fr, int fq) const {
        const int row0 = u.pm * BM + wr * 64 + fr, col0 = u.pn * BM + wc * 32 + 8 * fq;
#pragma unroll
        for (int ai = 0; ai < 2; ++ai)
#pragma unroll
            for (int m = 0; m < 4; ++m) { const size_t row = (size_t)(row0 + ai * HALF + m * 16); const bf16_t* pr = proj + row * NPROJ + col0;
#pragma unroll
                for (int bj = 0; bj < 2; ++bj) { float ga[8]; unpack8(*(const u32x4*)(pr + C_GA + bj * HALF), ga); f32x4 v0, v1;
#pragma unroll
                    for (int j = 0; j < 4; ++j) { v0[j] = acc[ai][bj][m][0][j] * __builtin_amdgcn_rcpf(1.0f + __expf(-ga[j])); v1[j] = acc[ai][bj][m][1][j] * __builtin_amdgcn_rcpf(1.0f + __expf(-ga[4 + j])); }
                    float* o = T1 + row * DM + col0 + bj * HALF; *(f32x4*)o = v0; *(f32x4*)(o + 4) = v1; }
                asm volatile("" ::: "memory"); }
    }
};
struct EpiG2 {
    static constexpr bool PERM = true, MID = false;
    bf16_t* O; const float* T1; const bf16_t* proj;
    __device__ __forceinline__ void operator()(const Acc& acc, const Unit& u, int wr, int wc, int fr, int fq) const {
        const int row0 = u.pm * BM + wr * 64 + fr, col0 = u.pn * BM + wc * 32 + 8 * fq;
#pragma unroll
        for (int ai = 0; ai < 2; ++ai)
#pragma unroll
            for (int m = 0; m < 4; ++m) { const size_t row = (size_t)(row0 + ai * HALF + m * 16); const bf16_t* pr = proj + row * NPROJ + col0;
#pragma unroll
                for (int bj = 0; bj < 2; ++bj) { float gb[8], v[8]; unpack8(*(const u32x4*)(pr + C_GB + bj * HALF), gb);
                    const float* t = T1 + row * DM + col0 + bj * HALF; const f32x4 t0 = *(const f32x4*)t, t1 = *(const f32x4*)(t + 4);
#pragma unroll
                    for (int j = 0; j < 4; ++j) { v[j] = t0[j] + acc[ai][bj][m][0][j] * __builtin_amdgcn_rcpf(1.0f + __expf(-gb[j])); v[4 + j] = t1[j] + acc[ai][bj][m][1][j] * __builtin_amdgcn_rcpf(1.0f + __expf(-gb[4 + j])); }
                    *(u32x4*)(O + row * DM + col0 + bj * HALF) = pack8(v); }
                asm volatile("" ::: "memory"); }
    }
};
struct EpiRes {
    static constexpr bool PERM = false, MID = false;
    float* X1; const float* x0p; const float* x0s; const float* gate;
    __device__ __forceinline__ void operator()(const Acc& acc, const Unit& u, int wr, int wc, int fr, int fq) const {
        const int row0 = u.pm * BM + wr * 64 + fr, col0 = u.pn * BM + wc * 32 + 4 * fq;
#pragma unroll
        for (int ai = 0; ai < 2; ++ai)
#pragma unroll
            for (int m = 0; m < 4; ++m) { const int row = row0 + ai * HALF + m * 16; const int b = bidx_of_row(row);
                const float* xr = (row < TP) ? x0p + (size_t)row * DM : x0s + (size_t)(row - TP) * DM; const float* gr = gate + (size_t)b * MODW; float* orow = X1 + (size_t)row * DM;
#pragma unroll
                for (int bj = 0; bj < 2; ++bj)
#pragma unroll
                    for (int n = 0; n < 2; ++n) { const int c = col0 + bj * HALF + n * 16; const f32x4 xv = *(const f32x4*)(xr + c), gv = *(const f32x4*)(gr + c);
                        *(f32x4*)(orow + c) = xv + gv * acc[ai][bj][m][n]; } }
    }
};
struct EpiGU {
    static constexpr bool PERM = true, MID = false;
    bf16_t* O;
    __device__ __forceinline__ void operator()(const Acc& acc, const Unit& u, int wr, int wc, int fr, int fq) const {
        const int row0 = u.pm * BM + wr * 64 + fr, col0 = u.pn * HALF + wc * 32 + 8 * fq;
#pragma unroll
        for (int ai = 0; ai < 2; ++ai)
#pragma unroll
            for (int m = 0; m < 4; ++m) { float v[8];
#pragma unroll
                for (int n = 0; n < 2; ++n)
#pragma unroll
                    for (int j = 0; j < 4; ++j) { const float gt = acc[ai][0][m][n][j]; v[4 * n + j] = gt * __builtin_amdgcn_rcpf(1.0f + __expf(-gt)) * acc[ai][1][m][n][j]; }
                *(u32x4*)(O + (size_t)(row0 + ai * HALF + m * 16) * DFF + col0) = pack8(v); }
    }
};
}

struct TJob { const float* src; bf16_t* dst; int ld_src, K, Nout, ld_dst, map, pad; };
__device__ __forceinline__ int map_col(int map, int n) {
    if (map == 1) { if (n < 4096) return n; if (n < 5120) return 4112 + (n - 4096); if (n < 9216) return 5136 + (n - 5120); if (n < 9232) return 4096 + (n - 9216); return -1; }
    if (map == 2) { const int pn = n >> 8, w = n & 255; return w < 128 ? 128 * pn + w : DFF + 128 * pn + (w - 128); }
    return n;
}
__device__ __forceinline__ void tjob_load(const TJob& j, int tile, f32x4 (&v)[4]) {
    const int tid = threadIdx.x, nkt = j.K >> 7, tn = tile / nkt, tk = tile - tn * nkt;
    const int n = tn * 64 + (tid & 15) * 4, kr = tid >> 4, col = map_col(j.map, n);
#pragma unroll
    for (int i = 0; i < 4; ++i) v[i] = col >= 0 ? __builtin_nontemporal_load((const f32x4*)(j.src + (size_t)(tk * 128 + kr + 32 * i) * j.ld_src + col)) : (f32x4){0.f, 0.f, 0.f, 0.f};
}
__device__ __forceinline__ void tjob_store(const TJob& j, int tile, const f32x4 (&v)[4], LAS float* s) {
    const int tid = threadIdx.x, nkt = j.K >> 7, tn = tile / nkt, tk = tile - tn * nkt;
    const int nq = tid & 15, kr = tid >> 4;
    __syncthreads();
#pragma unroll
    for (int i = 0; i < 4; ++i)
#pragma unroll
        for (int q = 0; q < 4; ++q) s[(4 * nq + q) * 129 + kr + 32 * i] = v[i][q];
    __syncthreads();
    const int n = tid >> 3, k16 = (tid & 7) * 16;
    float f[16];
#pragma unroll
    for (int i = 0; i < 16; ++i) f[i] = s[n * 129 + k16 + i];
    bf16_t* d = j.dst + (size_t)(tn * 64 + n) * j.ld_dst + tk * 128 + k16;
    *(u32x4*)d = pack8(f); *(u32x4*)(d + 8) = pack8(f + 8);
}
__device__ void transpose_jobs(const TJob* jobs, int njobs, int bi, int nblk, LAS unsigned char* lds) {
    LAS float* s = (LAS float*)lds;
    int total = 0;
    for (int q = 0; q < njobs; ++q) total += (jobs[q].Nout >> 6) * (jobs[q].K >> 7);
    f32x4 v[4]; int curj = 0, base = 0;
    int t = bi;
    auto locate = [&](int tt, int& jj, int& bb) { while (tt >= bb + (jobs[jj].Nout >> 6) * (jobs[jj].K >> 7)) { bb += (jobs[jj].Nout >> 6) * (jobs[jj].K >> 7); ++jj; } };
    if (t < total) { locate(t, curj, base); tjob_load(jobs[curj], t - base, v); }
    while (t < total) {
        const int tn = t + nblk; int nj = curj, nb = base; f32x4 w[4];
        if (tn < total) { locate(tn, nj, nb); tjob_load(jobs[nj], tn - nb, w); }
        tjob_store(jobs[curj], t - base, v, s);
        if (tn < total) {
#pragma unroll
            for (int i = 0; i < 4; ++i) v[i] = w[i]; }
        t = tn; curj = nj; base = nb;
    }
    __syncthreads();
}

template <int MODE>
__device__ void norm_phase(const Params& p, int bid, int nblk) {
    const int lane = threadIdx.x & 63, wid = threadIdx.x >> 6;
    const float* mod = (const float*)(p.ws + WS_MOD);
    const float* gain = MODE == 0 ? p.in[9] : (MODE == 1 ? p.in[20] : p.in[23]);
    bf16_t* U = (bf16_t*)(p.ws + WS_U);
    for (int row = bid * 8 + wid; row < TT; row += nblk * 8) {
        const float* src = MODE == 0 ? (row < TP ? p.in[0] + (size_t)row * DM : p.in[1] + (size_t)(row - TP) * DM) : p.out + O_Y + (size_t)row * DM;
        f32x4 v[8]; float ss = 0.f;
#pragma unroll
        for (int i = 0; i < 8; ++i) { v[i] = *(const f32x4*)(src + i * 256 + lane * 4); ss += v[i][0] * v[i][0] + v[i][1] * v[i][1] + v[i][2] * v[i][2] + v[i][3] * v[i][3]; }
#pragma unroll
        for (int o = 32; o >= 1; o >>= 1) ss += __shfl_xor(ss, o);
        const float rstd = rsqrtf(ss * (1.0f / DM) + EPS);
        if (MODE == 2) {
            float* dst = p.out + O_Y + (size_t)row * DM;
#pragma unroll
            for (int i = 0; i < 8; ++i) { const f32x4 g = *(const f32x4*)(gain + i * 256 + lane * 4); *(f32x4*)(dst + i * 256 + lane * 4) = v[i] * rstd * g; }
        } else {
            const float* sh = mod + (size_t)bidx_of_row(row) * MODW + (MODE == 0 ? 0 : 6144); const float* sc = sh + 2048;
#pragma unroll
            for (int i = 0; i < 8; ++i) { const int c = i * 256 + lane * 4; const f32x4 g = *(const f32x4*)(gain + c), s1 = *(const f32x4*)(sc + c), s0 = *(const f32x4*)(sh + c);
                const f32x4 y = (v[i] * rstd * g) * (1.0f + s1) + s0; u32x2 w; w.x = pk2(y[0], y[1]); w.y = pk2(y[2], y[3]); *(u32x2*)(U + (size_t)row * DM + c) = w; }
        }
    }
}

__device__ void mixer_prep_phase(const Params& p, int bid, int nblk) {
    const int tid = threadIdx.x;
    const bf16_t* proj = (const bf16_t*)(p.ws + WS_PROJ);
    bf16_t* qn = (bf16_t*)(p.ws + WS_QN); bf16_t* kn = (bf16_t*)(p.ws + WS_KN); bf16_t* vv = (bf16_t*)(p.ws + WS_VV); bf16_t* yp = (bf16_t*)(p.ws + WS_YP);
    float* gbuf = (float*)(p.ws + WS_G); float* bbuf = (float*)(p.ws + WS_BETA);
    for (int it = bid; it < 640; it += nblk) {
        const bool smp = it >= 512; const int sb = it - 512;
        const int b = smp ? 0 : (it >> 7), t0 = smp ? 0 : (it & 127) * 16, ntok = smp ? 4 : 16;
        const int rowbase = smp ? TP + sb * 4 : b * 2048 + t0;
        if (tid < 384) {
            const int c0 = tid * 8;
            float w0[8], w1[8], w2[8], w3[8], xm3[8], xm2[8], xm1[8];
            const float* cw = p.in[11];
#pragma unroll
            for (int i = 0; i < 8; ++i) { w0[i] = cw[c0 + i]; w1[i] = cw[3072 + c0 + i]; w2[i] = cw[6144 + c0 + i]; w3[i] = cw[9216 + c0 + i]; }
            if (smp) { const float* sc = p.in[5] + (size_t)sb * 3 * 3072 + c0;
#pragma unroll
                for (int i = 0; i < 8; ++i) { xm3[i] = sc[i]; xm2[i] = sc[3072 + i]; xm1[i] = sc[6144 + i]; }
            } else if (t0 == 0) {
#pragma unroll
                for (int i = 0; i < 8; ++i) { xm3[i] = 0.f; xm2[i] = 0.f; xm1[i] = 0.f; }
            } else {
                unpack8(*(const u32x4*)(proj + (size_t)(rowbase - 3) * NPROJ + c0), xm3); unpack8(*(const u32x4*)(proj + (size_t)(rowbase - 2) * NPROJ + c0), xm2); unpack8(*(const u32x4*)(proj + (size_t)(rowbase - 1) * NPROJ + c0), xm1);
            }
            for (int t = 0; t < ntok; ++t) {
                const int row = rowbase + t; float xt[8], y[8];
                unpack8(*(const u32x4*)(proj + (size_t)row * NPROJ + c0), xt);
                float ss = 0.f;
#pragma unroll
                for (int i = 0; i < 8; ++i) { const float a = w0[i] * xm3[i] + w1[i] * xm2[i] + w2[i] * xm1[i] + w3[i] * xt[i]; y[i] = siluf_(a); ss += y[i] * y[i]; }
                if (c0 < 2048) {
                    ss += __shfl_xor(ss, 1); ss += __shfl_xor(ss, 2); ss += __shfl_xor(ss, 4); ss += __shfl_xor(ss, 8);
                    const float inv = rsqrtf(ss + EPS);
#pragma unroll
                    for (int i = 0; i < 8; ++i) y[i] *= inv;
                }
                bf16_t* dst = c0 < 1024 ? qn + (size_t)row * 1024 + c0 : (c0 < 2048 ? kn + (size_t)row * 1024 + (c0 - 1024) : vv + (size_t)row * 1024 + (c0 - 2048));
                *(u32x4*)dst = pack8(y);
                if (smp) { if (t >= 1) { float* o = p.out + O_CS + ((size_t)sb * 3 + (t - 1)) * 3072 + c0; *(f32x4*)o = (f32x4){xt[0], xt[1], xt[2], xt[3]}; *(f32x4*)(o + 4) = (f32x4){xt[4], xt[5], xt[6], xt[7]}; } }
                else if (t0 + t >= 2045) { float* o = p.out + O_CP + ((size_t)b * 3 + (t0 + t - 2045)) * 3072 + c0; *(f32x4*)o = (f32x4){xt[0], xt[1], xt[2], xt[3]}; *(f32x4*)(o + 4) = (f32x4){xt[4], xt[5], xt[6], xt[7]}; }
#pragma unroll
                for (int i = 0; i < 8; ++i) { xm3[i] = xm2[i]; xm2[i] = xm1[i]; xm1[i] = xt[i]; }
            }
        } else {
            const int pc = (tid - 384) * 8, gi = pc >> 8, w = 2 << gi;
            const int seqrow0 = smp ? TP + sb * 4 : b * 2048;
            const float* sp = p.in[6] + (size_t)sb * 15 * 1024 + pc;
            auto xpool = [&](int tt, float* f) {
                if (tt >= 0) unpack8(*(const u32x4*)(proj + (size_t)(seqrow0 + tt) * NPROJ + C_XP + pc), f);
                else if (smp) { const float* s = sp + (size_t)(15 + tt) * 1024;
#pragma unroll
                    for (int i = 0; i < 8; ++i) f[i] = s[i]; }
                else {
#pragma unroll
                    for (int i = 0; i < 8; ++i) f[i] = 0.f; }
            };
            float s[8], f[8];
#pragma unroll
            for (int i = 0; i < 8; ++i) s[i] = 0.f;
            for (int q = 1; q < w; ++q) { xpool(t0 - q, f);
#pragma unroll
                for (int i = 0; i < 8; ++i) s[i] += f[i]; }
            for (int t = 0; t < ntok; ++t) {
                const int tt = t0 + t; float x[8], y[8];
                xpool(tt, x);
                const float cnt = smp ? (float)w : (float)min(w, tt + 1); const float ic = 1.0f / cnt;
#pragma unroll
                for (int i = 0; i < 8; ++i) { s[i] += x[i]; y[i] = s[i] * ic - x[i]; }
                *(u32x4*)(yp + (size_t)(seqrow0 + tt) * 1024 + pc) = pack8(y);
                xpool(tt - w + 1, f);
#pragma unroll
                for (int i = 0; i < 8; ++i) s[i] -= f[i];
                if (smp) { float* o = p.out + O_PS + ((size_t)sb * 15 + 11 + t) * 1024 + pc; *(f32x4*)o = (f32x4){x[0], x[1], x[2], x[3]}; *(f32x4*)(o + 4) = (f32x4){x[4], x[5], x[6], x[7]}; }
                else if (tt >= 2033) { float* o = p.out + O_PP + ((size_t)b * 15 + (tt - 2033)) * 1024 + pc; *(f32x4*)o = (f32x4){x[0], x[1], x[2], x[3]}; *(f32x4*)(o + 4) = (f32x4){x[4], x[5], x[6], x[7]}; }
            }
            if (smp) for (int r = 0; r < 11; ++r) { const float* s2 = sp + (size_t)(4 + r) * 1024; float* o = p.out + O_PS + ((size_t)sb * 15 + r) * 1024 + pc; *(f32x4*)o = *(const f32x4*)s2; *(f32x4*)(o + 4) = *(const f32x4*)(s2 + 4); }
        }
        if (tid < 256) { const int tk = tid >> 4, jj = tid & 15;
            if (tk < ntok) { const int row = rowbase + tk; const float val = bf2f(proj[(size_t)row * NPROJ + C_AB + jj]);
                if (jj < 8) { const float xx = val + p.in[13][jj]; const float spl = xx > 20.f ? xx : log1pf(__expf(xx)); gbuf[row * 8 + jj] = -__expf(p.in[12][jj]) * spl; }
                else bbuf[row * 8 + (jj - 8)] = sigmoidf_(val); } }
    }
}

constexpr int P5_QS = 0, P5_KS = 17408, P5_VS = 34816, P5_MM = 52224, P5_DEC = 68608, P5_BETA = 68864;
__device__ void chunk_prep_phase(const Params& p, int bid, int nblk, LAS unsigned char* lds) {
    const int tid = threadIdx.x, lane = tid & 63, wid = tid >> 6;
    const bf16_t* qn = (const bf16_t*)(p.ws + WS_QN); const bf16_t* kn = (const bf16_t*)(p.ws + WS_KN); const bf16_t* vv = (const bf16_t*)(p.ws + WS_VV);
    const float* gbuf = (const float*)(p.ws + WS_G); const float* bbuf = (const float*)(p.ws + WS_BETA);
    bf16_t* wdc = (bf16_t*)(p.ws + WS_WDC); bf16_t* qd = (bf16_t*)(p.ws + WS_QD); bf16_t* kt = (bf16_t*)(p.ws + WS_KT); bf16_t* qk = (bf16_t*)(p.ws + WS_QK);
    float* cdv = (float*)(p.ws + WS_CD); float* ub = p.out + OS_UB;
    LAS float* Mm = (LAS float*)(lds + P5_MM); LAS float* dec = (LAS float*)(lds + P5_DEC); LAS float* bet = (LAS float*)(lds + P5_BETA);
    const float scale = 0.08838834764831845f;
    for (int item = bid; item < 1024; item += nblk) {
        const int n = item & 31, bh = item >> 5, h = bh & 7, b = bh >> 3;
        const int r0 = b * 2048 + n * 64;
        __syncthreads();
#pragma unroll
        for (int i = 0; i < 2; ++i) { const int ch = tid + 512 * i, r = ch >> 4, c8 = (ch & 15) * 8; const size_t go = (size_t)(r0 + r) * 1024 + h * 128 + c8; const int lo = r * 272 + c8 * 2;
            *(LAS u32x4*)(lds + P5_QS + lo) = *(const u32x4*)(qn + go); *(LAS u32x4*)(lds + P5_KS + lo) = *(const u32x4*)(kn + go); *(LAS u32x4*)(lds + P5_VS + lo) = *(const u32x4*)(vv + go); }
        if (tid < 64) {
            float g = gbuf[(r0 + tid) * 8 + h];
#pragma unroll
            for (int o = 1; o < 64; o <<= 1) { const float t = __shfl_up(g, o); if (lane >= o) g += t; }
            dec[tid] = g;
        } else if (tid < 128) bet[tid - 64] = bbuf[(r0 + tid - 64) * 8 + h];
        __syncthreads();
        const float last = dec[63];
        {
            const int mat = wid >> 2, rt = wid & 3, fr = lane & 15, fq = lane >> 4;
            bf16x8 a[4];
#pragma unroll
            for (int kk = 0; kk < 4; ++kk) a[kk] = *(const LAS bf16x8*)(lds + (mat ? P5_QS : P5_KS) + (rt * 16 + fr) * 272 + (kk * 32 + fq * 8) * 2);
#pragma unroll
            for (int st = 0; st < 4; ++st) {
                f32x4 d = (f32x4){0.f, 0.f, 0.f, 0.f};
#pragma unroll
                for (int kk = 0; kk < 4; ++kk) { const bf16x8 bb = *(const LAS bf16x8*)(lds + P5_KS + (st * 16 + fr) * 272 + (kk * 32 + fq * 8) * 2); d = __builtin_amdgcn_mfma_f32_16x16x32_bf16(a[kk], bb, d, 0, 0, 0); }
                const int s = st * 16 + fr; const float ds = dec[s];
#pragma unroll
                for (int j = 0; j < 4; ++j) { const int r = rt * 16 + fq * 4 + j; const float dr = dec[r];
                    if (mat == 0) Mm[r * 64 + s] = (r > s) ? bet[r] * d[j] * __expf(dr - ds) : 0.f;
                    else qk[(size_t)item * 4096 + r * 64 + s] = f2bf((r >= s) ? scale * d[j] * __expf(dr - ds) : 0.f); }
            }
        }
        __syncthreads();
        if (tid < 256) {
            const int c = tid; float x[64];
            if (c < 128) {
#pragma unroll
                for (int r = 0; r < 64; ++r) x[r] = bf2f(*(const LAS bf16_t*)(lds + P5_VS + r * 272 + c * 2)) * bet[r];
            } else {
#pragma unroll
                for (int r = 0; r < 64; ++r) x[r] = bf2f(*(const LAS bf16_t*)(lds + P5_KS + r * 272 + (c - 128) * 2)) * bet[r] * __expf(dec[r]);
            }
#pragma unroll
            for (int r = 1; r < 64; ++r) {
                float acc = x[r];
#pragma unroll
                for (int s4 = 0; s4 < (r + 3) / 4; ++s4) { const f32x4 m4 = *(const LAS f32x4*)(Mm + r * 64 + s4 * 4);
#pragma unroll
                    for (int q = 0; q < 4; ++q) if (s4 * 4 + q < r) acc -= m4[q] * x[s4 * 4 + q]; }
                x[r] = acc;
            }
            if (c < 128) {
#pragma unroll
                for (int r = 0; r < 64; ++r) ub[(size_t)item * 8192 + r * 128 + c] = x[r];
            } else {
#pragma unroll
                for (int r = 0; r < 64; ++r) wdc[(size_t)item * 8192 + r * 128 + (c - 128)] = f2bf(-x[r]);
            }
        } else {
            const int tt = tid - 256;
#pragma unroll
            for (int i = 0; i < 4; ++i) { const int vid = tt + 256 * i, r = vid >> 4, d0 = (vid & 15) * 8; float f[8]; unpack8(*(const LAS u32x4*)(lds + P5_QS + r * 272 + d0 * 2), f);
                const float e = scale * __expf(dec[r]);
#pragma unroll
                for (int q = 0; q < 8; ++q) f[q] *= e;
                *(u32x4*)(qd + (size_t)item * 8192 + r * 128 + d0) = pack8(f); }
#pragma unroll
            for (int i = 0; i < 4; ++i) { const int vid = tt + 256 * i, d = vid >> 3, rg = (vid & 7) * 8; float f[8];
#pragma unroll
                for (int q = 0; q < 8; ++q) f[q] = bf2f(*(const LAS bf16_t*)(lds + P5_KS + (rg + q) * 272 + d * 2)) * __expf(last - dec[rg + q]);
                *(u32x4*)(kt + (size_t)item * 8192 + d * 64 + rg) = pack8(f); }
            if (tt == 0) cdv[item] = __expf(last);
        }
    }
    __syncthreads();
}

constexpr int SB_WD = 0, SB_QD = 17408, SB_KT = 34816, SB_QK = 53248, SB_UB = 62464, SB_SIZE = 66560;
constexpr int SC_ST = 2 * SB_SIZE, SC_UT = SC_ST + 4352, SC_END = SC_UT + 2304;
static_assert(SC_END <= LDS_BYTES, "lds");
__device__ void scan_phase(const Params& p, int bid, int nblk, LAS unsigned char* lds) {
    const int tid = threadIdx.x, lane = tid & 63, wid = tid >> 6, fr = lane & 15, fq = lane >> 4;
    const bf16_t* wdc = (const bf16_t*)(p.ws + WS_WDC); const bf16_t* qd = (const bf16_t*)(p.ws + WS_QD); const bf16_t* kt = (const bf16_t*)(p.ws + WS_KT); const bf16_t* qk = (const bf16_t*)(p.ws + WS_QK);
    const float* cdv = (const float*)(p.ws + WS_CD); const float* ub = p.out + OS_UB; float* obuf = p.out + OS_O;
    for (int item = bid; item < 256; item += nblk) {
        const int xcd = item & 7, iq = item >> 3, bh = xcd * 4 + (iq >> 3), sl = iq & 7, h = bh & 7, b = bh >> 3;
        u32x4 r_wd[2], r_qd[2], r_kt[2], r_qk, r_ub;
        auto gload = [&](int n) {
            const size_t it = (size_t)(bh * 32 + n);
#pragma unroll
            for (int i = 0; i < 2; ++i) { const int ch = tid + 512 * i; r_wd[i] = *(const u32x4*)(wdc + it * 8192 + ch * 8); r_qd[i] = *(const u32x4*)(qd + it * 8192 + ch * 8); r_kt[i] = *(const u32x4*)(kt + it * 8192 + ch * 8); }
            r_qk = *(const u32x4*)(qk + it * 4096 + tid * 8);
            if (tid < 256) r_ub = *(const u32x4*)(ub + it * 8192 + (tid >> 2) * 128 + sl * 16 + (tid & 3) * 4);
        };
        auto lstore = [&](int buf) {
            LAS unsigned char* B = lds + buf * SB_SIZE;
#pragma unroll
            for (int i = 0; i < 2; ++i) { const int ch = tid + 512 * i; const int r = ch >> 4, c8 = (ch & 15) * 8; *(LAS u32x4*)(B + SB_WD + r * 272 + c8 * 2) = r_wd[i]; *(LAS u32x4*)(B + SB_QD + r * 272 + c8 * 2) = r_qd[i];
                const int d = ch >> 3, t8 = (ch & 7) * 8; *(LAS u32x4*)(B + SB_KT + d * 144 + t8 * 2) = r_kt[i]; }
            { const int r = tid >> 3, s8 = (tid & 7) * 8; *(LAS u32x4*)(B + SB_QK + r * 144 + s8 * 2) = r_qk; }
            if (tid < 256) *(LAS u32x4*)(B + SB_UB + (tid >> 2) * 64 + (tid & 3) * 16) = r_ub;
        };
        __syncthreads();
        gload(0);
        for (int i = tid; i < 4352 / 4; i += 512) *(LAS unsigned*)(lds + SC_ST + i * 4) = 0u;
        lstore(0);
        f32x4 sacc = (f32x4){0.f, 0.f, 0.f, 0.f};
        __syncthreads();
        for (int n = 0; n < 32; ++n) {
            const int cur = n & 1; LAS unsigned char* B = lds + cur * SB_SIZE;
            if (n + 1 < 32) gload(n + 1);
            const float cd = cdv[bh * 32 + n];
            f32x4 acc;
            const int tw = wid & 3;
            if (wid < 4) {
#pragma unroll
                for (int j = 0; j < 4; ++j) acc[j] = *(const LAS float*)(B + SB_UB + ((tw * 16 + fq * 4 + j) * 16 + fr) * 4);
#pragma unroll
                for (int kk = 0; kk < 4; ++kk) { const bf16x8 a = *(const LAS bf16x8*)(B + SB_WD + (tw * 16 + fr) * 272 + (kk * 32 + fq * 8) * 2); const bf16x8 bb = *(const LAS bf16x8*)(lds + SC_ST + fr * 272 + (kk * 32 + fq * 8) * 2);
                    acc = __builtin_amdgcn_mfma_f32_16x16x32_bf16(a, bb, acc, 0, 0, 0); }
                u32x2 w; w.x = pk2(acc[0], acc[1]); w.y = pk2(acc[2], acc[3]);
                *(LAS u32x2*)(lds + SC_UT + fr * 144 + (tw * 16 + fq * 4) * 2) = w;
            } else {
                acc = (f32x4){0.f, 0.f, 0.f, 0.f};
#pragma unroll
                for (int kk = 0; kk < 4; ++kk) { const bf16x8 a = *(const LAS bf16x8*)(B + SB_QD + (tw * 16 + fr) * 272 + (kk * 32 + fq * 8) * 2); const bf16x8 bb = *(const LAS bf16x8*)(lds + SC_ST + fr * 272 + (kk * 32 + fq * 8) * 2);
                    acc = __builtin_amdgcn_mfma_f32_16x16x32_bf16(a, bb, acc, 0, 0, 0); }
            }
            __syncthreads();
            sacc *= cd;
#pragma unroll
            for (int kk = 0; kk < 2; ++kk) { const bf16x8 a = *(const LAS bf16x8*)(B + SB_KT + (wid * 16 + fr) * 144 + (kk * 32 + fq * 8) * 2); const bf16x8 bb = *(const LAS bf16x8*)(lds + SC_UT + fr * 144 + (kk * 32 + fq * 8) * 2);
                sacc = __builtin_amdgcn_mfma_f32_16x16x32_bf16(a, bb, sacc, 0, 0, 0); }
            if (wid >= 4) {
#pragma unroll
                for (int kk = 0; kk < 2; ++kk) { const bf16x8 a = *(const LAS bf16x8*)(B + SB_QK + (tw * 16 + fr) * 144 + (kk * 32 + fq * 8) * 2); const bf16x8 bb = *(const LAS bf16x8*)(lds + SC_UT + fr * 144 + (kk * 32 + fq * 8) * 2);
                    acc = __builtin_amdgcn_mfma_f32_16x16x32_bf16(a, bb, acc, 0, 0, 0); }
#pragma unroll
                for (int j = 0; j < 4; ++j) obuf[(size_t)(b * 2048 + n * 64 + tw * 16 + fq * 4 + j) * 1024 + h * 128 + sl * 16 + fr] = acc[j];
            }
            { u32x2 w; w.x = pk2(sacc[0], sacc[1]); w.y = pk2(sacc[2], sacc[3]); *(LAS u32x2*)(lds + SC_ST + fr * 272 + (wid * 16 + fq * 4) * 2) = w; }
            if (n + 1 < 32) lstore(cur ^ 1);
            __syncthreads();
        }
#pragma unroll
        for (int j = 0; j < 4; ++j) p.out[O_DP + ((size_t)bh * 128 + wid * 16 + fq * 4 + j) * 128 + sl * 16 + fr] = sacc[j];
    }
    __syncthreads();
    {
        const bf16_t* qn = (const bf16_t*)(p.ws + WS_QN); const bf16_t* kn = (const bf16_t*)(p.ws + WS_KN); const bf16_t* vv = (const bf16_t*)(p.ws + WS_VV);
        const float* gbuf = (const float*)(p.ws + WS_G); const float* bbuf = (const float*)(p.ws + WS_BETA);
        const int grp = tid >> 8, w4 = (tid >> 6) & 3, j = w4 * 32 + (lane & 31), half = lane >> 5;
        LAS float* qs = (LAS float*)lds + grp * 1024;
        LAS float* ks = qs + 512;
        const float scale = 0.08838834764831845f;
        for (int it0 = bid * 2; it0 < 1024; it0 += nblk * 2) {
            const int item = it0 + grp, sb = item >> 3, h = item & 7;
            __syncthreads();
#pragma unroll
            for (int i = 0; i < 4; ++i) { const int idx = (tid & 255) + 256 * i, tk = idx >> 7, c = idx & 127, t = tk & 3; const size_t go = (size_t)(TP + sb * 4 + t) * 1024 + h * 128 + c;
                if (tk < 4) qs[t * 128 + c] = bf2f(qn[go]); else ks[t * 128 + c] = bf2f(kn[go]); }
            float S[64];
            const float* s0 = p.in[4] + (size_t)item * 16384 + (size_t)half * 64 * 128 + j;
#pragma unroll
            for (int i = 0; i < 64; ++i) S[i] = __builtin_nontemporal_load(s0 + i * 128);
            __syncthreads();
#pragma unroll 1
            for (int t = 0; t < 4; ++t) {
                const int row = TP + sb * 4 + t;
                const float a = __expf(gbuf[row * 8 + h]), be = bbuf[row * 8 + h], v = bf2f(vv[(size_t)row * 1024 + h * 128 + j]);
                float kS = 0.f;
#pragma unroll
                for (int i4 = 0; i4 < 16; ++i4) { const f32x4 k4 = *(const LAS f32x4*)(ks + t * 128 + half * 64 + i4 * 4); kS += k4[0] * S[i4 * 4] + k4[1] * S[i4 * 4 + 1] + k4[2] * S[i4 * 4 + 2] + k4[3] * S[i4 * 4 + 3]; }
                kS += __shfl_xor(kS, 32);
                const float coef = be * (v - a * kS);
                float o = 0.f;
#pragma unroll
                for (int i4 = 0; i4 < 16; ++i4) { const f32x4 k4 = *(const LAS f32x4*)(ks + t * 128 + half * 64 + i4 * 4); const f32x4 q4 = *(const LAS f32x4*)(qs + t * 128 + half * 64 + i4 * 4);
#pragma unroll
                    for (int q = 0; q < 4; ++q) { S[i4 * 4 + q] = a * S[i4 * 4 + q] + k4[q] * coef; o += q4[q] * S[i4 * 4 + q]; } }
                o += __shfl_xor(o, 32);
                if (half == 0) obuf[(size_t)row * 1024 + h * 128 + j] = o * scale;
            }
            float* so = p.out + O_DS + (size_t)item * 16384 + (size_t)half * 64 * 128 + j;
#pragma unroll
            for (int i = 0; i < 64; ++i) so[i * 128] = S[i];
        }
    }
    __syncthreads();
}

__device__ void onorm_phase(const Params& p, int bid, int nblk) {
    const int lane = threadIdx.x & 63, wid = threadIdx.x >> 6;
    const float* obuf = p.out + OS_O; const bf16_t* proj = (const bf16_t*)(p.ws + WS_PROJ); bf16_t* acat = (bf16_t*)(p.ws + WS_U); const float* og = p.in[14];
    for (int row = bid * 8 + wid; row < TT; row += nblk * 8) {
        const int c0 = lane * 16; float o[16], z[16], g[16];
#pragma unroll
        for (int i = 0; i < 4; ++i) { const f32x4 v = *(const f32x4*)(obuf + (size_t)row * 1024 + c0 + i * 4); o[i * 4] = v[0]; o[i * 4 + 1] = v[1]; o[i * 4 + 2] = v[2]; o[i * 4 + 3] = v[3];
            const f32x4 gg = *(const f32x4*)(og + (c0 & 127) + i * 4); g[i * 4] = gg[0]; g[i * 4 + 1] = gg[1]; g[i * 4 + 2] = gg[2]; g[i * 4 + 3] = gg[3]; }
        unpack8(*(const u32x4*)(proj + (size_t)row * NPROJ + C_Z + c0), z); unpack8(*(const u32x4*)(proj + (size_t)row * NPROJ + C_Z + c0 + 8), z + 8);
        float ss = 0.f;
#pragma unroll
        for (int i = 0; i < 16; ++i) ss += o[i] * o[i];
        ss += __shfl_xor(ss, 1); ss += __shfl_xor(ss, 2); ss += __shfl_xor(ss, 4);
        const float rstd = rsqrtf(ss * (1.0f / 128.0f) + EPS);
#pragma unroll
        for (int i = 0; i < 16; ++i) o[i] = o[i] * rstd * g[i] * siluf_(z[i]);
        *(u32x4*)(acat + (size_t)row * DM + c0) = pack8(o); *(u32x4*)(acat + (size_t)row * DM + c0 + 8) = pack8(o + 8);
    }
}

#define XB_TMO      128
#define XB_XCNT(j)  (256  + 64 * (j))
#define XB_XSUB(j)  (1280 + 64 * (j))
#define XB_XGEN(j)  (2304 + 64 * (j))
#define XB_TOP      3328
#define XB_TOPGEN   3392
#define XCD_BAR_WORDS 3456
#define XB_SPIN_CAP (1u << 18)

__device__ __forceinline__ unsigned xb_ld(unsigned* p)              { return __hip_atomic_load(p, __ATOMIC_RELAXED, __HIP_MEMORY_SCOPE_AGENT); }
__device__ __forceinline__ unsigned xb_add(unsigned* p, unsigned v) { return __hip_atomic_fetch_add(p, v, __ATOMIC_RELAXED, __HIP_MEMORY_SCOPE_AGENT); }
__device__ __forceinline__ unsigned xb_xcc_id() { return (unsigned)__builtin_amdgcn_s_getreg((3 << 11) | 20) & 0xFu; }
#define XB_SPIN(cond, bar) do { unsigned _sp = 0; while (cond) { __builtin_amdgcn_s_sleep(1); \
    if ((++_sp & 255u) == 0u) { if (xb_ld(&(bar)[XB_TMO])) break; if (_sp > XB_SPIN_CAP) { atomicAdd(&(bar)[XB_TMO], 1u); break; } } } } while (0)

struct XcdBarrier {
    unsigned* bar; unsigned x;
    volatile LAS unsigned* st;
};

__device__ __forceinline__ XcdBarrier xcd_barrier_post(unsigned* bar, volatile LAS unsigned* st) {
    XcdBarrier b; b.bar = bar; b.x = xb_xcc_id(); b.st = st;
    if (threadIdx.x == 0) (void)xb_add(&bar[XB_XCNT(b.x)], 1u);
    return b;
}
__device__ __forceinline__ void xcd_barrier_complete(unsigned* bar, unsigned x, unsigned& nloc, unsigned& nx) {
    const unsigned G = gridDim.x * gridDim.y * gridDim.z;
    unsigned sum, cnt, mine, sp = 0u;
    for (;;) {
        sum = 0u; cnt = 0u; mine = 0u;
#pragma unroll
        for (unsigned j = 0; j < 16; ++j) { const unsigned c = xb_ld(&bar[XB_XCNT(j)]); sum += c; cnt += (c > 0u) ? 1u : 0u; mine = (j == x) ? c : mine; }
        if (sum == G) break;
        __builtin_amdgcn_s_sleep(1);
        if ((++sp & 255u) == 0u) { if (xb_ld(&bar[XB_TMO])) break; if (sp > XB_SPIN_CAP) { atomicAdd(&bar[XB_TMO], 1u); break; } }
    }
    nloc = mine > 0u ? mine : 1u; nx = cnt > 0u ? cnt : 1u;
}

__device__ __forceinline__ void xcd_barrier(const XcdBarrier& b) {
    asm volatile("s_waitcnt vmcnt(0)" ::: "memory");
    __syncthreads();
    if (threadIdx.x == 0) {
        unsigned* bar = b.bar;
        __builtin_amdgcn_s_waitcnt(0);
        unsigned nloc = b.st[0], nx = b.st[1];
        if (nloc == 0u) { xcd_barrier_complete(bar, b.x, nloc, nx); b.st[0] = nloc; b.st[1] = nx; }
        const unsigned old = xb_add(&bar[XB_XSUB(b.x)], 1u);
        const unsigned gen = old / nloc;
        if (old + 1u == (gen + 1u) * nloc) {
            __builtin_amdgcn_fence(__ATOMIC_RELEASE, "agent");
            asm volatile("s_waitcnt vmcnt(0)" ::: "memory");
            const unsigned og = xb_add(&bar[XB_TOP], 1u);
            const unsigned tg = og / nx;
            if (og + 1u == (tg + 1u) * nx) xb_add(&bar[XB_TOPGEN], 1u);
            else XB_SPIN(xb_ld(&bar[XB_TOPGEN]) == tg, bar);
            __builtin_amdgcn_fence(__ATOMIC_ACQUIRE, "agent");
            xb_add(&bar[XB_XGEN(b.x)], 1u);
            asm volatile("s_waitcnt vmcnt(0)" ::: "memory");
        } else {
            XB_SPIN(xb_ld(&bar[XB_XGEN(b.x)]) == gen, bar);
            __builtin_amdgcn_fence(__ATOMIC_ACQUIRE, "agent");
            asm volatile("s_waitcnt vmcnt(0)" ::: "memory");
        }
    }
    __syncthreads();
}

constexpr size_t WS_BAR = WS_END;
constexpr int LDS_ST_OFF = LDS_BYTES - 16;
struct KArgs { Params p; TJob jobs[11]; };
constexpr int N_PHASES = 15;
#ifndef PH_MASK
#define PH_MASK 0xFFFF
#endif
#ifndef DUP_MASK
#define DUP_MASK 0
#endif

__global__ void __launch_bounds__(512, 2) fwd_megakernel(KArgs ka) {
    extern __shared__ __attribute__((aligned(16))) unsigned char lds_raw[];
    LAS unsigned char* lds = (LAS unsigned char*)lds_raw;
    const Params& p = ka.p;
    const int bid = blockIdx.x, nblk = gridDim.x;
    unsigned char* ws = p.ws;
    const int lo = p.ph_lo, hi = p.ph_hi;
    if (threadIdx.x < 4) ((LAS unsigned*)(lds + LDS_ST_OFF))[threadIdx.x] = 0u;
    __syncthreads();
    XcdBarrier xbar = xcd_barrier_post((unsigned*)(ws + WS_BAR), (volatile LAS unsigned*)(lds + LDS_ST_OFF));
#define IN(k) ((PH_MASK & (1 << (k))) && lo <= (k) && (k) < hi)
#define SEAM(k) do { if (lo <= (k) && (k) + 1 < hi) { if ((k) == 0) cg::this_grid().sync(); else xcd_barrier(xbar); } } while (0)
    if (IN(0)) for (int rep = 0; rep <= ((DUP_MASK >> 0) & 1); ++rep) {
            bf16_t* aada = (bf16_t*)(ws + WS_AADA);
            for (int idx = bid * 512 + threadIdx.x; idx < 256 * 2048; idx += nblk * 512) { const int row = idx >> 11, col = idx & 2047;
                const float v = row < 4 ? siluf_(p.in[2][row * 2048 + col]) : (row < NB ? siluf_(p.in[3][(row - 4) * 2048 + col]) : 0.f); aada[idx] = f2bf(v); }
            transpose_jobs(ka.jobs, 1, bid, nblk, lds);
        }
    SEAM(0);
    if (IN(1)) for (int rep = 0; rep <= ((DUP_MASK >> 1) & 1); ++rep) {
            if (bid < 48) { pg8::Gemm g{(const bf16_t*)(ws + WS_AADA), (const bf16_t*)(ws + WS_PROJ), 2048, 2048, 2048, 0}; pg8::OneUnitOrder S{48, bid}; pg8::EpiAda E{(float*)(ws + WS_MOD), p.in[8]}; pg8::gemm_phase(lds, g, S, E); }
            else transpose_jobs(ka.jobs + 1, 10, bid - 48, nblk - 48, lds);
        }
    SEAM(1);
    if (IN(2)) for (int rep = 0; rep <= ((DUP_MASK >> 2) & 1); ++rep) norm_phase<0>(p, bid, nblk);
    SEAM(2);
    if (IN(3)) for (int rep = 0; rep <= ((DUP_MASK >> 3) & 1); ++rep) { pg8::Gemm g{(const bf16_t*)(ws + WS_U), (const bf16_t*)(ws + WS_WIN), 2048, 2048, 2048, 0}; pg8::StaticOrder S; S.init(TT, NPROJ, nblk, bid); pg8::EpiBf16 E{(bf16_t*)(ws + WS_PROJ), NPROJ, 0, nullptr}; pg8::gemm_phase(lds, g, S, E); }
    SEAM(3);
    if (IN(4)) for (int rep = 0; rep <= ((DUP_MASK >> 4) & 1); ++rep) mixer_prep_phase(p, bid, nblk);
    SEAM(4);
    if (IN(5)) for (int rep = 0; rep <= ((DUP_MASK >> 5) & 1); ++rep) chunk_prep_phase(p, bid, nblk, lds);
    SEAM(5);
    if (IN(6)) for (int rep = 0; rep <= ((DUP_MASK >> 6) & 1); ++rep) scan_phase(p, bid, nblk, lds);
    SEAM(6);
    if (IN(7)) for (int rep = 0; rep <= ((DUP_MASK >> 7) & 1); ++rep) { onorm_phase(p, bid, nblk);
            pg8::Gemm g{(const bf16_t*)(ws + WS_YP), (const bf16_t*)(ws + WS_PW), 1024, 256, 256, 512}; pg8::StaticOrder S; S.init(TT, 1024, nblk, bid); pg8::EpiBf16 E{(bf16_t*)(ws + WS_U), DM, 1024, p.in[16]}; pg8::gemm_phase(lds, g, S, E); }
    SEAM(7);
    if (IN(8)) for (int rep = 0; rep <= ((DUP_MASK >> 8) & 1); ++rep) { pg8::Gemm g{(const bf16_t*)(ws + WS_U), (const bf16_t*)(ws + WS_WAB), 2048, 2048, 1024, 0}; pg8::StaticOrder S; S.init(TT, 2048, nblk, bid); pg8::EpiG1 E{p.out + O_Y, (const bf16_t*)(ws + WS_PROJ)}; pg8::gemm_phase(lds, g, S, E); }
    SEAM(8);
    if (IN(9)) for (int rep = 0; rep <= ((DUP_MASK >> 9) & 1); ++rep) { pg8::Gemm g{(const bf16_t*)(ws + WS_U) + 1024, (const bf16_t*)(ws + WS_WAB) + 1024, 2048, 2048, 1024, 0}; pg8::StaticOrder S; S.init(TT, 2048, nblk, bid); pg8::EpiG2 E{(bf16_t*)(ws + WS_QN), p.out + O_Y, (const bf16_t*)(ws + WS_PROJ)}; pg8::gemm_phase(lds, g, S, E); }
    SEAM(9);
    if (IN(10)) for (int rep = 0; rep <= ((DUP_MASK >> 10) & 1); ++rep) { pg8::Gemm g{(const bf16_t*)(ws + WS_QN), (const bf16_t*)(ws + WS_WO), 2048, 2048, 2048, 0}; pg8::StaticOrder S; S.init(TT, 2048, nblk, bid); pg8::EpiRes E{p.out + O_Y, p.in[0], p.in[1], (const float*)(ws + WS_MOD) + 4096}; pg8::gemm_phase(lds, g, S, E); }
    SEAM(10);
    if (IN(11)) for (int rep = 0; rep <= ((DUP_MASK >> 11) & 1); ++rep) norm_phase<1>(p, bid, nblk);
    SEAM(11);
    if (IN(12)) for (int rep = 0; rep <= ((DUP_MASK >> 12) & 1); ++rep) { pg8::Gemm g{(const bf16_t*)(ws + WS_U), (const bf16_t*)(ws + WS_WGU), 2048, 2048, 2048, 0}; pg8::StaticOrder S; S.init(TT, 11264, nblk, bid); pg8::EpiGU E{(bf16_t*)(ws + WS_PROJ)}; pg8::gemm_phase(lds, g, S, E); }
    SEAM(12);
    if (IN(13)) for (int rep = 0; rep <= ((DUP_MASK >> 13) & 1); ++rep) { pg8::Gemm g{(const bf16_t*)(ws + WS_PROJ), (const bf16_t*)(ws + WS_WD), DFF, DFF, DFF, 0}; pg8::StaticOrder S; S.init(TT, 2048, nblk, bid); pg8::EpiRes E{p.out + O_Y, p.out + O_Y, p.out + O_Y + (size_t)TP * DM, (const float*)(ws + WS_MOD) + 10240}; pg8::gemm_phase(lds, g, S, E); }
    SEAM(13);
    if (IN(14)) for (int rep = 0; rep <= ((DUP_MASK >> 14) & 1); ++rep) norm_phase<2>(p, bid, nblk);
    SEAM(14);
}

extern "C" void kernel_launch(void* const* d_in, const int* in_sizes, int n_in, void* d_out, int out_size, void* d_ws, size_t ws_size, hipStream_t stream) {
    static int grid = 0;
    if (grid == 0) {
        if (n_in != 24 || ws_size < WS_BAR + XCD_BAR_WORDS * 4) { fprintf(stderr, "kernel_launch: unexpected n_in %d / ws_size %zu (need %zu)\n", n_in, ws_size, (size_t)WS_END); grid = -1; return; }
        int dev = 0, cus = 0, per_cu = 0;
        hipGetDevice(&dev); hipDeviceGetAttribute(&cus, hipDeviceAttributeMultiprocessorCount, dev);
        if (hipFuncSetAttribute((const void*)fwd_megakernel, hipFuncAttributeMaxDynamicSharedMemorySize, LDS_BYTES) != hipSuccess) { fprintf(stderr, "kernel_launch: hipFuncSetAttribute failed\n"); grid = -1; return; }
        if (hipOccupancyMaxActiveBlocksPerMultiprocessor(&per_cu, (const void*)fwd_megakernel, 512, LDS_BYTES) != hipSuccess || per_cu < 1) { fprintf(stderr, "kernel_launch: occupancy query says %d\n", per_cu); per_cu = 1; }
        (void)hipGetLastError();
        grid = cus > 0 ? cus : 256;
        if (grid < 64) grid = 64;
    }
    if (grid < 0) return;
    if (hipMemsetAsync((unsigned char*)d_ws + WS_BAR, 0, XCD_BAR_WORDS * 4, stream) != hipSuccess) { fprintf(stderr, "kernel_launch: memset failed\n"); return; }
    KArgs ka; memset(&ka, 0, sizeof(ka));
    for (int i = 0; i < 24; ++i) ka.p.in[i] = (const float*)d_in[i];
    ka.p.out = (float*)d_out; ka.p.ws = (unsigned char*)d_ws;
    unsigned char* ws = (unsigned char*)d_ws;
    auto setjob = [&](int i, const void* src, void* dst, int ld_src, int K, int Nout, int ld_dst, int map) { TJob& j = ka.jobs[i]; j.src = (const float*)src; j.dst = (bf16_t*)dst; j.ld_src = ld_src; j.K = K; j.Nout = Nout; j.ld_dst = ld_dst; j.map = map; j.pad = 0; };
    setjob(0, d_in[7], ws + WS_PROJ, MODW, 2048, MODW, 2048, 0);
    setjob(1, d_in[10], ws + WS_WIN, 9232, 2048, NPROJ, 2048, 1);
    setjob(2, d_in[21], ws + WS_WGU, 2 * DFF, 2048, 2 * DFF, 2048, 2);
    setjob(3, d_in[22], ws + WS_WD, 2048, DFF, 2048, DFF, 0);
    setjob(4, d_in[19], ws + WS_WO, 2048, 2048, 2048, 2048, 0);
    setjob(5, d_in[17], ws + WS_WAB, 2048, 1024, 2048, 2048, 0);
    setjob(6, d_in[18], ws + WS_WAB + 1024 * 2, 2048, 1024, 2048, 2048, 0);
    for (int g = 0; g < 4; ++g) setjob(7 + g, (const float*)d_in[15] + g * 65536, ws + WS_PW + (size_t)g * 65536 * 2, 256, 256, 256, 256, 0);
#if MK_PER_PHASE
    for (int ph = 0; ph < N_PHASES; ++ph) { ka.p.ph_lo = ph; ka.p.ph_hi = ph + 1; hipLaunchKernelGGL(fwd_megakernel, dim3(grid), dim3(512), LDS_BYTES, stream, ka); }
#else
    ka.p.ph_lo = 0; ka.p.ph_hi = N_PHASES;
    void* args[] = {&ka};
    hipError_t e = hipLaunchCooperativeKernel((const void*)fwd_megakernel, dim3(grid), dim3(512), args, LDS_BYTES, stream);
    if (e != hipSuccess) fprintf(stderr, "cooperative launch failed: %s (grid %d)\n", hipGetErrorString(e), grid);
#endif
}
```

```cpp
#include <hip/hip_runtime.h>
#include <hip/hip_cooperative_groups.h>
#include <cstdio>
#include <cstring>
namespace cg = cooperative_groups;

#ifndef MK_PER_PHASE
#define MK_PER_PHASE 0
#endif

#define LAS __attribute__((address_space(3)))
typedef unsigned short bf16_t;
typedef short bf16x8 __attribute__((ext_vector_type(8)));
typedef float f32x4 __attribute__((ext_vector_type(4)));
typedef float f32x2 __attribute__((ext_vector_type(2)));
typedef unsigned u32x4 __attribute__((ext_vector_type(4)));
typedef unsigned u32x2 __attribute__((ext_vector_type(2)));

constexpr int DM = 2048, TP = 8192, TS = 512, TT = 8704, NB = 132;
constexpr int NPROJ = 9472;
constexpr int DFF = 5632;
constexpr int MODW = 12288;
constexpr float EPS = 1e-6f;
constexpr int C_Q = 0, C_K = 1024, C_V = 2048, C_Z = 3072, C_XP = 4096, C_GA = 5120, C_GB = 7168, C_AB = 9216;
constexpr size_t O_Y = 0, O_DP = 17825792, O_CP = 18350080, O_PP = 18386944, O_DS = 18448384, O_CS = 35225600, O_PS = 36405248;
constexpr size_t OS_O = 0, OS_UB = 8912896;
constexpr size_t WS_WIN = 0;
constexpr size_t WS_WGU = WS_WIN + (size_t)NPROJ * 2048 * 2;
constexpr size_t WS_WD = WS_WGU + (size_t)11264 * 2048 * 2;
constexpr size_t WS_WO = WS_WD + (size_t)2048 * 5632 * 2;
constexpr size_t WS_WAB = WS_WO + (size_t)2048 * 2048 * 2;
constexpr size_t WS_PW = WS_WAB + (size_t)2048 * 2048 * 2;
constexpr size_t WS_AADA = WS_PW + (size_t)1024 * 256 * 2;
constexpr size_t WS_MOD = WS_AADA + (size_t)256 * 2048 * 2;
constexpr size_t WS_G = WS_MOD + (size_t)NB * MODW * 4;
constexpr size_t WS_BETA = WS_G + (size_t)TT * 8 * 4;
constexpr size_t WS_CD = WS_BETA + (size_t)TT * 8 * 4;
constexpr size_t WS_U = WS_CD + 4096;
constexpr size_t WS_QN = WS_U + (size_t)TT * 2048 * 2;
constexpr size_t WS_KN = WS_QN + (size_t)TT * 1024 * 2;
constexpr size_t WS_VV = WS_KN + (size_t)TT * 1024 * 2;
constexpr size_t WS_YP = WS_VV + (size_t)TT * 1024 * 2;
constexpr size_t WS_WDC = WS_YP + (size_t)TT * 1024 * 2;
constexpr size_t WS_QD = WS_WDC + (size_t)1024 * 64 * 128 * 2;
constexpr size_t WS_KT = WS_QD + (size_t)1024 * 64 * 128 * 2;
constexpr size_t WS_QK = WS_KT + (size_t)1024 * 64 * 128 * 2;
constexpr size_t WS_PROJ = WS_QK + (size_t)1024 * 64 * 64 * 2;
constexpr size_t WS_END = WS_PROJ + (size_t)TT * NPROJ * 2;
constexpr size_t WS_PB10 = WS_PROJ;
constexpr size_t WS_PB13 = WS_PROJ + (size_t)TT * DFF * 2;
static_assert(WS_PB13 + (size_t)11 * TS * DM * 4 <= WS_END && (WS_PB13 % 256) == 0, "partials");
static_assert(WS_END + 16384 <= 501510720ull, "workspace too large");
static_assert((WS_PROJ % 256) == 0 && (WS_QK % 256) == 0 && (WS_U % 256) == 0, "align");

constexpr int LDS_BYTES = 147456;

struct Params {
    const float* in[24];
    float* out;
    unsigned char* ws;
    int ph_lo, ph_hi;
};

__device__ __forceinline__ float bf2f(unsigned short x) { return __uint_as_float(((unsigned)x) << 16); }
__device__ __forceinline__ unsigned short f2bf(float f) { unsigned u = __float_as_uint(f); u += 0x7FFFu + ((u >> 16) & 1u); return (unsigned short)(u >> 16); }
__device__ __forceinline__ unsigned pk2(float lo, float hi) { return (unsigned)f2bf(lo) | ((unsigned)f2bf(hi) << 16); }
__device__ __forceinline__ void unpack8(const u32x4 w, float* f) {
    f[0] = __uint_as_float(w.x << 16); f[1] = __uint_as_float(w.x & 0xffff0000u);
    f[2] = __uint_as_float(w.y << 16); f[3] = __uint_as_float(w.y & 0xffff0000u);
    f[4] = __uint_as_float(w.z << 16); f[5] = __uint_as_float(w.z & 0xffff0000u);
    f[6] = __uint_as_float(w.w << 16); f[7] = __uint_as_float(w.w & 0xffff0000u);
}
__device__ __forceinline__ u32x4 pack8(const float* f) { u32x4 w; w.x = pk2(f[0], f[1]); w.y = pk2(f[2], f[3]); w.z = pk2(f[4], f[5]); w.w = pk2(f[6], f[7]); return w; }
__device__ __forceinline__ float sigmoidf_(float x) { return 1.0f / (1.0f + __expf(-x)); }
__device__ __forceinline__ float siluf_(float x) { return x / (1.0f + __expf(-x)); }
__device__ __forceinline__ int bidx_of_row(int row) { return row < TP ? (row >> 11) : 4 + ((row - TP) >> 2); }

namespace pg8 {
constexpr int BM = 256, BK = 64, HALF = 128, HTB = HALF * BK * 2, STAGE_BYTES = 8 * HTB, NXCD = 8, WGM = 8;
__host__ __device__ __forceinline__ int lds_byte(int r, int c) { const int st = (r >> 4) * 2 + (c >> 5), rr = r & 15, cc = c & 31, ob = rr * 64 + cc * 2; return st * 1024 + (ob ^ (((ob >> 9) & 1) << 5)); }
__host__ __device__ __forceinline__ void stage_rc(int b, int& R, int& C) { const int st = b / 1024, sb = b % 1024, swz = sb ^ (((sb >> 9) & 1) << 5); R = (st >> 1) * 16 + swz / 64; C = (st & 1) * 32 + (swz % 64) / 2; }
__host__ __device__ __forceinline__ int perm32(int rho) { const int n = rho >> 4, i = rho & 15; return 8 * (i >> 2) + 4 * n + (i & 3); }

struct Unit { int pm, pn, kt0, nkt, piece; };
struct Gemm { const bf16_t* A; const bf16_t* Bt; int lda, ldb, K; size_t a_pn_off; };

__device__ __forceinline__ void tile_of(int wgid, int nM, int nN, Unit& u) {
    const int nwg = nM * nN;
    { const int q = nwg / NXCD, r = nwg % NXCD, xcd = wgid % NXCD, off = wgid / NXCD; wgid = (xcd < r ? xcd * (q + 1) : r * (q + 1) + (xcd - r) * q) + off; }
    const int nig = WGM * nN, gid = wgid / nig, fm = gid * WGM, gsz = (nM - fm) < WGM ? (nM - fm) : WGM;
    u.pm = fm + ((wgid % nig) % gsz); u.pn = (wgid % nig) / gsz;
}
struct StaticOrder {
    int nM, nN, nwg, G, c, ntk;
    __device__ __forceinline__ void init(int M, int N, int K, int G_, int c_) { nM = M / BM; nN = N / BM; nwg = nM * nN; G = G_; c = c_; ntk = K / BK; }
    __device__ __forceinline__ bool next(int i, Unit& u) const {
        const long L = (long)i * G + c; if (L >= nwg) return false;
        tile_of((int)L, nM, nN, u); u.kt0 = 0; u.nkt = ntk; u.piece = -1; return true;
    }
};
struct OneUnitOrder {
    int n, c, ntk;
    __device__ __forceinline__ bool next(int i, Unit& u) const { if (i != 0 || c >= n) return false; u.pm = 0; u.pn = c; u.kt0 = 0; u.nkt = ntk; u.piece = -1; return true; }
};
struct SplitOrder {
    int G, c, ntk, pk, npc;
    __device__ __forceinline__ bool next(int i, Unit& u) const {
        const int L = i * G + c;
        const bool full = L < 256;
        int fpm, fpn;
        { int wgid = full ? L : 0; const int xcd = wgid % NXCD, off = wgid / NXCD; wgid = xcd * 32 + off;
          const int nig = WGM * 8, gid = wgid / nig, fm = gid * WGM; fpm = fm + ((wgid % nig) % WGM); fpn = (wgid % nig) / WGM; }
        const int pidx = full ? 0 : L - 256, tile = pidx / npc, pc = pidx - tile * npc;
        u.pm = full ? fpm : 32 + (tile >> 3); u.pn = full ? fpn : (tile & 7); u.kt0 = full ? 0 : pc * pk; u.nkt = full ? ntk : pk; u.piece = full ? -1 : pc;
        return full || pidx < 16 * npc;
    }
};

template <class Epi, class Sched>
__device__ __forceinline__ void gemm_phase(LAS unsigned char* lds, const Gemm g, const Sched& S, const Epi& E) {
    const int tid = threadIdx.x, wid = __builtin_amdgcn_readfirstlane(tid >> 6), lane = tid & 63, wr = wid >> 2, wc = wid & 3, fr = lane & 15, fq = lane >> 4;
    unsigned voffA[2], voffB[2];
#pragma unroll
    for (int i = 0; i < 2; ++i) { int R, C; stage_rc(tid * 16 + i * 8192, R, C); const int Rb = Epi::PERM ? ((R & ~31) + perm32(R & 31)) : R;
        voffA[i] = (unsigned)(R * g.lda + C) * 2u; voffB[i] = (unsigned)(Rb * g.ldb + C) * 2u; }
    const size_t kstep = (size_t)(BK * 2);
    const size_t hstepA = (size_t)HALF * g.lda * 2, hstepB = (size_t)HALF * g.ldb * 2;
    const size_t tstepA = 2 * hstepA, tstepB = 2 * hstepB;
    const unsigned ldsw = (unsigned)wid * 1024u;
    const int aoff = lds_byte(wr * 64 + fr, fq * 8), boff = lds_byte(wc * 32 + fr, fq * 8);
#define PG8_SA(b, h) (((b) * 2 + (h)) * HTB)
#define PG8_SB(b, h) ((4 + (b) * 2 + (h)) * HTB)
#define PG8_STAGE(bufoff, gbase, voff) do { _Pragma("unroll") for (int _i = 0; _i < 2; ++_i) \
        __builtin_amdgcn_global_load_lds((const unsigned*)((const char*)(gbase) + (voff)[_i]), (LAS unsigned*)(lds + (bufoff) + ldsw + _i * 8192), 16, 0, 0); } while (0)
#define PG8_LDA(dst, b, h) do { _Pragma("unroll") for (int m = 0; m < 4; ++m) _Pragma("unroll") for (int k = 0; k < 2; ++k) dst[m][k] = *(const LAS bf16x8*)(lds + PG8_SA(b, h) + aoff + m * 2048 + k * 1024); } while (0)
#define PG8_LDB(dst, b, h) do { _Pragma("unroll") for (int n = 0; n < 2; ++n) _Pragma("unroll") for (int k = 0; k < 2; ++k) dst[n][k] = *(const LAS bf16x8*)(lds + PG8_SB(b, h) + boff + n * 2048 + k * 1024); } while (0)
#define PG8_MMA(ai, bj, At, Bt) do { __builtin_amdgcn_s_setprio(1); _Pragma("unroll") for (int m = 0; m < 4; ++m) _Pragma("unroll") for (int n = 0; n < 2; ++n) _Pragma("unroll") for (int k = 0; k < 2; ++k) \
        acc[ai][bj][m][n] = __builtin_amdgcn_mfma_f32_16x16x32_bf16(Bt[n][k], At[m][k], acc[ai][bj][m][n], 0, 0, 0); __builtin_amdgcn_s_setprio(0); } while (0)
#define PG8_WAIT_V(n) asm volatile("s_waitcnt vmcnt(" #n ")" ::: "memory")
#define PG8_WAIT_L(n) asm volatile("s_waitcnt lgkmcnt(" #n ")" ::: "memory")
#define PG8_BAR __builtin_amdgcn_s_barrier()
#define PG8_SCHED __builtin_amdgcn_sched_barrier(0)
    Unit cur, nxt; int ui = 0;
    if (!S.next(0, cur)) return;
    f32x4 acc[2][2][4][2];
#pragma unroll
    for (int a = 0; a < 2; ++a)
#pragma unroll
        for (int b = 0; b < 2; ++b)
#pragma unroll
            for (int m = 0; m < 4; ++m)
#pragma unroll
                for (int n = 0; n < 2; ++n) acc[a][b][m][n] = (f32x4){0.f, 0.f, 0.f, 0.f};
    bf16x8 At[4][2], B0[2][2], B1[2][2];
    const char* cA = (const char*)g.A + (size_t)cur.pm * tstepA + (size_t)cur.pn * g.a_pn_off + (size_t)cur.kt0 * kstep; const char* cB = (const char*)g.Bt + (size_t)cur.pn * tstepB + (size_t)cur.kt0 * kstep;
    PG8_STAGE(PG8_SB(0, 0), cB, voffB); PG8_STAGE(PG8_SA(0, 0), cA, voffA); PG8_STAGE(PG8_SB(0, 1), cB + hstepB, voffB); PG8_STAGE(PG8_SA(0, 1), cA + hstepA, voffA);
    if (wr == 1) PG8_BAR;
    PG8_WAIT_V(4); PG8_BAR;
    PG8_STAGE(PG8_SB(1, 0), cB + kstep, voffB); PG8_STAGE(PG8_SA(1, 0), cA + kstep, voffA); PG8_STAGE(PG8_SB(1, 1), cB + hstepB + kstep, voffB);
    PG8_WAIT_V(6); PG8_BAR;
    for (;;) {
        const bool has_next = S.next(ui + 1, nxt);
        const char* nA = has_next ? (const char*)g.A + (size_t)nxt.pm * tstepA + (size_t)nxt.pn * g.a_pn_off + (size_t)nxt.kt0 * kstep : cA; const char* nB = has_next ? (const char*)g.Bt + (size_t)nxt.pn * tstepB + (size_t)nxt.kt0 * kstep : cB;
        const int nt = cur.nkt;
#pragma unroll 1
        for (int t = 0; t < nt; t += 2) {
            const bool last = (t == nt - 2);
            const char* a1 = cA + (size_t)(t + 1) * kstep;
            const char* a2 = last ? nA : cA + (size_t)(t + 2) * kstep; const char* b2 = last ? nB : cB + (size_t)(t + 2) * kstep;
            const char* a3 = a2 + kstep; const char* b3 = b2 + kstep;
            PG8_LDB(B0, 0, 0); PG8_SCHED; PG8_LDA(At, 0, 0); PG8_STAGE(PG8_SA(1, 1), a1 + hstepA, voffA);
            PG8_WAIT_L(8); PG8_BAR; PG8_WAIT_L(0); PG8_MMA(0, 0, At, B0); PG8_BAR; PG8_SCHED;
            PG8_LDB(B1, 0, 1); PG8_STAGE(PG8_SB(0, 0), b2, voffB);
            PG8_BAR; PG8_WAIT_L(0); PG8_MMA(0, 1, At, B1); PG8_BAR;
            PG8_LDA(At, 0, 1); PG8_STAGE(PG8_SA(0, 0), a2, voffA);
            PG8_BAR; PG8_WAIT_L(0); PG8_MMA(1, 0, At, B0); PG8_BAR; PG8_SCHED;
            PG8_STAGE(PG8_SB(0, 1), b2 + hstepB, voffB);
            PG8_WAIT_V(6); PG8_BAR; PG8_MMA(1, 1, At, B1); PG8_BAR;
            PG8_LDB(B0, 1, 0); PG8_SCHED; PG8_LDA(At, 1, 0); PG8_STAGE(PG8_SA(0, 1), a2 + hstepA, voffA);
            PG8_WAIT_L(8); PG8_BAR; PG8_WAIT_L(0); PG8_MMA(0, 0, At, B0); PG8_BAR; PG8_SCHED;
            PG8_LDB(B1, 1, 1); PG8_STAGE(PG8_SB(1, 0), b3, voffB);
            PG8_BAR; PG8_WAIT_L(0); PG8_MMA(0, 1, At, B1); PG8_BAR;
            PG8_LDA(At, 1, 1); PG8_STAGE(PG8_SA(1, 0), a3, voffA);
            PG8_BAR; PG8_WAIT_L(0); PG8_MMA(1, 0, At, B0); PG8_BAR; PG8_SCHED;
            PG8_STAGE(PG8_SB(1, 1), b3 + hstepB, voffB);
            PG8_WAIT_V(6); PG8_BAR; PG8_MMA(1, 1, At, B1); PG8_BAR;
        }
        E(acc, cur, wr, wc, fr, fq);
        if (!has_next) break;
#pragma unroll
        for (int a = 0; a < 2; ++a)
#pragma unroll
            for (int b = 0; b < 2; ++b)
#pragma unroll
                for (int m = 0; m < 4; ++m)
#pragma unroll
                    for (int n = 0; n < 2; ++n) acc[a][b][m][n] = (f32x4){0.f, 0.f, 0.f, 0.f};
        cur = nxt; cA = nA; cB = nB; ++ui;
    }
    PG8_WAIT_V(0);
    if (wr == 0) PG8_BAR;
    PG8_BAR;
#undef PG8_SA
#undef PG8_SB
#undef PG8_STAGE
#undef PG8_LDA
#undef PG8_LDB
#undef PG8_MMA
#undef PG8_WAIT_V
#undef PG8_WAIT_L
#undef PG8_BAR
#undef PG8_SCHED
}

typedef f32x4 Acc[2][2][4][2];

struct EpiAda {
    static constexpr bool PERM = false, MID = false;
    float* C; const float* bias;
    __device__ __forceinline__ void operator()(const Acc& acc, const Unit& u, int wr, int wc, int fr, int fq) const {
        const int row0 = wr * 64 + fr, col0 = u.pn * BM + wc * 32 + 4 * fq;
#pragma unroll
        for (int ai = 0; ai < 2; ++ai)
#pragma unroll
            for (int m = 0; m < 4; ++m) { const int row = row0 + ai * HALF + m * 16; if (row < NB) {
#pragma unroll
                for (int bj = 0; bj < 2; ++bj)
#pragma unroll
                    for (int n = 0; n < 2; ++n) { const int c = col0 + bj * HALF + n * 16; *(f32x4*)(C + (size_t)row * MODW + c) = acc[ai][bj][m][n] + *(const f32x4*)(bias + c); } } }
    }
};
struct EpiBf16 {
    static constexpr bool PERM = true, MID = false;
    bf16_t* O; int ldc; int col_off; const float* scale;
    __device__ __forceinline__ void operator()(const Acc& acc, const Unit& u, int wr, int wc, int fr, int fq) const {
        const int row0 = u.pm * BM + wr * 64 + fr, col0 = u.pn * BM + wc * 32 + 8 * fq;
#pragma unroll
        for (int ai = 0; ai < 2; ++ai)
#pragma unroll
            for (int m = 0; m < 4; ++m) { bf16_t* rowp = O + (size_t)(row0 + ai * HALF + m * 16) * ldc + col_off + col0;
#pragma unroll
                for (int bj = 0; bj < 2; ++bj) { f32x4 v0 = acc[ai][bj][m][0], v1 = acc[ai][bj][m][1];
                    if (scale) { v0 *= *(const f32x4*)(scale + col0 + bj * HALF); v1 *= *(const f32x4*)(scale + col0 + bj * HALF + 4); }
                    u32x4 w; w.x = pk2(v0[0], v0[1]); w.y = pk2(v0[2], v0[3]); w.z = pk2(v1[0], v1[1]); w.w = pk2(v1[2], v1[3]);
                    *(u32x4*)(rowp + bj * HALF) = w; }
                if (scale) asm volatile("" ::: "memory"); }
    }
};
struct EpiG1 {
    static constexpr bool PERM = true, MID = false;
    float* T1; const bf16_t* proj;
    __device__ __forceinline__ void operator()(const Acc& acc, const Unit& u, int wr, int wc, int fr, int fq) const {
        const int row0 = u.pm * BM + wr * 64 + fr, col0 = u.pn * BM + wc * 32 + 8 * fq;
#pragma unroll
        for (int ai = 0; ai < 2; ++ai)
#pragma unroll
            for (int m = 0; m < 4; ++m) { const size_t row = (size_t)(row0 + ai * HALF + m * 16); const bf16_t* pr = proj + row * NPROJ + col0;
#pragma unroll
                for (int bj = 0; bj < 2; ++bj) { float ga[8]; unpack8(*(const u32x4*)(pr + C_GA + bj * HALF), ga); f32x4 v0, v1;
#pragma unroll
                    for (int j = 0; j < 4; ++j) { v0[j] = acc[ai][bj][m][0][j] * __builtin_amdgcn_rcpf(1.0f + __expf(-ga[j])); v1[j] = acc[ai][bj][m][1][j] * __builtin_amdgcn_rcpf(1.0f + __expf(-ga[4 + j])); }
                    float* o = T1 + row * DM + col0 + bj * HALF; *(f32x4*)o = v0; *(f32x4*)(o + 4) = v1; }
                asm volatile("" ::: "memory"); }
    }
};
struct EpiG2 {
    static constexpr bool PERM = true, MID = false;
    bf16_t* O; const float* T1; const bf16_t* proj;
    __device__ __forceinline__ void operator()(const Acc& acc, const Unit& u, int wr, int wc, int fr, int fq) const {
        const int row0 = u.pm * BM + wr * 64 + fr, col0 = u.pn * BM + wc * 32 + 8 * fq;
#pragma unroll
        for (int ai = 0; ai < 2; ++ai)
#pragma unroll
            for (int m = 0; m < 4; ++m) { const size_t row = (size_t)(row0 + ai * HALF + m * 16); const bf16_t* pr = proj + row * NPROJ + col0;
#pragma unroll
                for (int bj = 0; bj < 2; ++bj) { float gb[8], v[8]; unpack8(*(const u32x4*)(pr + C_GB + bj * HALF), gb);
                    const float* t = T1 + row * DM + col0 + bj * HALF; const f32x4 t0 = *(const f32x4*)t, t1 = *(const f32x4*)(t + 4);
#pragma unroll
                    for (int j = 0; j < 4; ++j) { v[j] = t0[j] + acc[ai][bj][m][0][j] * __builtin_amdgcn_rcpf(1.0f + __expf(-gb[j])); v[4 + j] = t1[j] + acc[ai][bj][m][1][j] * __builtin_amdgcn_rcpf(1.0f + __expf(-gb[4 + j])); }
                    *(u32x4*)(O + row * DM + col0 + bj * HALF) = pack8(v); }
                asm volatile("" ::: "memory"); }
    }
};
struct EpiRes {
    static constexpr bool PERM = false, MID = false;
    float* X1; const float* x0p; const float* x0s; const float* gate; float* PB;
    __device__ __forceinline__ void operator()(const Acc& acc, const Unit& u, int wr, int wc, int fr, int fq) const {
        const int row0 = u.pm * BM + wr * 64 + fr, col0 = u.pn * BM + wc * 32 + 4 * fq;
        if (u.piece >= 0) {
            float* pb = PB + (size_t)u.piece * TS * DM;
#pragma unroll
            for (int ai = 0; ai < 2; ++ai)
#pragma unroll
                for (int m = 0; m < 4; ++m) { float* orow = pb + (size_t)(row0 + ai * HALF + m * 16 - TP) * DM;
#pragma unroll
                    for (int bj = 0; bj < 2; ++bj)
#pragma unroll
                        for (int n = 0; n < 2; ++n) *(f32x4*)(orow + col0 + bj * HALF + n * 16) = acc[ai][bj][m][n]; }
            return;
        }
#pragma unroll
        for (int ai = 0; ai < 2; ++ai)
#pragma unroll
            for (int m = 0; m < 4; ++m) { const int row = row0 + ai * HALF + m * 16; const int b = bidx_of_row(row);
                const float* xr = (row < TP) ? x0p + (size_t)row * DM : x0s + (size_t)(row - TP) * DM; const float* gr = gate + (size_t)b * MODW; float* orow = X1 + (size_t)row * DM;
#pragma unroll
                for (int bj = 0; bj < 2; ++bj)
#pragma unroll
                    for (int n = 0; n < 2; ++n) { const int c = col0 + bj * HALF + n * 16; const f32x4 xv = *(const f32x4*)(xr + c), gv = *(const f32x4*)(gr + c);
                        *(f32x4*)(orow + c) = xv + gv * acc[ai][bj][m][n]; } }
    }
};
struct EpiGU {
    static constexpr bool PERM = true, MID = false;
    bf16_t* O;
    __device__ __forceinline__ void operator()(const Acc& acc, const Unit& u, int wr, int wc, int fr, int fq) const {
        const int row0 = u.pm * BM + wr * 64 + fr, col0 = u.pn * HALF + wc * 32 + 8 * fq;
#pragma unroll
        for (int ai = 0; ai < 2; ++ai)
#pragma unroll
            for (int m = 0; m < 4; ++m) { float v[8];
#pragma unroll
                for (int n = 0; n < 2; ++n)
#pragma unroll
                    for (int j = 0; j < 4; ++j) { const float gt = acc[ai][0][m][n][j]; v[4 * n + j] = gt * __builtin_amdgcn_rcpf(1.0f + __expf(-gt)) * acc[ai][1][m][n][j]; }
                *(u32x4*)(O + (size_t)(row0 + ai * HALF + m * 16) * DFF + col0) = pack8(v); }
    }
};
}

struct TJob { const float* src; bf16_t* dst; int ld_src, K, Nout, ld_dst, map, pad; };
__device__ __forceinline__ int map_col(int map, int n) {
    if (map == 1) { if (n < 4096) return n; if (n < 5120) return 4112 + (n - 4096); if (n < 9216) return 5136 + (n - 5120); if (n < 9232) return 4096 + (n - 9216); return -1; }
    if (map == 2) { const int pn = n >> 8, w = n & 255; return w < 128 ? 128 * pn + w : DFF + 128 * pn + (w - 128); }
    return n;
}
__device__ __forceinline__ void tjob_load(const TJob& j, int tile, f32x4 (&v)[4]) {
    const int tid = threadIdx.x, nkt = j.K >> 7, tn = tile / nkt, tk = tile - tn * nkt;
    const int n = tn * 64 + (tid & 15) * 4, kr = tid >> 4, col = map_col(j.map, n);
#pragma unroll
    for (int i = 0; i < 4; ++i) v[i] = col >= 0 ? __builtin_nontemporal_load((const f32x4*)(j.src + (size_t)(tk * 128 + kr + 32 * i) * j.ld_src + col)) : (f32x4){0.f, 0.f, 0.f, 0.f};
}
__device__ __forceinline__ void tjob_store(const TJob& j, int tile, const f32x4 (&v)[4], LAS float* s) {
    const int tid = threadIdx.x, nkt = j.K >> 7, tn = tile / nkt, tk = tile - tn * nkt;
    const int nq = tid & 15, kr = tid >> 4;
    __syncthreads();
#pragma unroll
    for (int i = 0; i < 4; ++i)
#pragma unroll
        for (int q = 0; q < 4; ++q) s[(4 * nq + q) * 129 + kr + 32 * i] = v[i][q];
    __syncthreads();
    const int n = tid >> 3, k16 = (tid & 7) * 16;
    float f[16];
#pragma unroll
    for (int i = 0; i < 16; ++i) f[i] = s[n * 129 + k16 + i];
    bf16_t* d = j.dst + (size_t)(tn * 64 + n) * j.ld_dst + tk * 128 + k16;
    *(u32x4*)d = pack8(f); *(u32x4*)(d + 8) = pack8(f + 8);
}
__device__ __forceinline__ void transpose_jobs(const TJob* jobs, int njobs, int bi, int nblk, LAS unsigned char* lds) {
    LAS float* s = (LAS float*)lds;
    int total = 0;
    for (int q = 0; q < njobs; ++q) total += (jobs[q].Nout >> 6) * (jobs[q].K >> 7);
    f32x4 v[4]; int curj = 0, base = 0;
    int t = bi;
    auto locate = [&](int tt, int& jj, int& bb) { while (tt >= bb + (jobs[jj].Nout >> 6) * (jobs[jj].K >> 7)) { bb += (jobs[jj].Nout >> 6) * (jobs[jj].K >> 7); ++jj; } };
    if (t < total) { locate(t, curj, base); tjob_load(jobs[curj], t - base, v); }
    while (t < total) {
        const int tn = t + nblk; int nj = curj, nb = base; f32x4 w[4];
        if (tn < total) { locate(tn, nj, nb); tjob_load(jobs[nj], tn - nb, w); }
        tjob_store(jobs[curj], t - base, v, s);
        if (tn < total) {
#pragma unroll
            for (int i = 0; i < 4; ++i) v[i] = w[i]; }
        t = tn; curj = nj; base = nb;
    }
    __syncthreads();
}

template <int MODE>
__device__ __forceinline__ void norm_phase(const Params& p, int bid, int nblk) {
    const int lane = threadIdx.x & 63, wid = threadIdx.x >> 6;
    const float* mod = (const float*)(p.ws + WS_MOD);
    const float* gain = MODE == 0 ? p.in[9] : (MODE == 1 ? p.in[20] : p.in[23]);
    bf16_t* U = (bf16_t*)(p.ws + WS_U);
    for (int row = bid * 8 + wid; row < TT; row += nblk * 8) {
        const float* src = MODE == 0 ? (row < TP ? p.in[0] + (size_t)row * DM : p.in[1] + (size_t)(row - TP) * DM) : p.out + O_Y + (size_t)row * DM;
        if (MODE != 0 && row >= TP) {
            const float* xs = p.in[1] + (size_t)(row - TP) * DM;
            const float* pb = (const float*)(p.ws + (MODE == 1 ? WS_PB10 : WS_PB13)) + (size_t)(row - TP) * DM;
            const float* gt = mod + (size_t)bidx_of_row(row) * MODW + (MODE == 1 ? 4096 : 10240);
            float* xo = p.out + O_Y + (size_t)row * DM;
            constexpr int NPC = MODE == 1 ? 8 : 11;
#pragma unroll 1
            for (int i = 0; i < 8; ++i) { const int c = i * 256 + lane * 4; f32x4 s = *(const f32x4*)(pb + c);
#pragma unroll
                for (int q = 1; q < NPC; ++q) s += *(const f32x4*)(pb + (size_t)q * TS * DM + c);
                const f32x4 base = MODE == 1 ? *(const f32x4*)(xs + c) : *(const f32x4*)(xo + c);
                *(f32x4*)(xo + c) = base + *(const f32x4*)(gt + c) * s; }
            asm volatile("s_waitcnt vmcnt(0)" ::: "memory");
        }
        f32x4 v[8]; float ss = 0.f;
#pragma unroll
        for (int i = 0; i < 8; ++i) v[i] = *(const f32x4*)(src + i * 256 + lane * 4);
#pragma unroll
        for (int i = 0; i < 8; ++i) ss += v[i][0] * v[i][0] + v[i][1] * v[i][1] + v[i][2] * v[i][2] + v[i][3] * v[i][3];
#pragma unroll
        for (int o = 32; o >= 1; o >>= 1) ss += __shfl_xor(ss, o);
        const float rstd = rsqrtf(ss * (1.0f / DM) + EPS);
        if (MODE == 2) {
            float* dst = p.out + O_Y + (size_t)row * DM;
#pragma unroll
            for (int i = 0; i < 8; ++i) { const f32x4 g = *(const f32x4*)(gain + i * 256 + lane * 4); *(f32x4*)(dst + i * 256 + lane * 4) = v[i] * rstd * g; }
        } else {
            const float* sh = mod + (size_t)bidx_of_row(row) * MODW + (MODE == 0 ? 0 : 6144); const float* sc = sh + 2048;
#pragma unroll
            for (int i = 0; i < 8; ++i) { const int c = i * 256 + lane * 4; const f32x4 g = *(const f32x4*)(gain + c), s1 = *(const f32x4*)(sc + c), s0 = *(const f32x4*)(sh + c);
                const f32x4 y = (v[i] * rstd * g) * (1.0f + s1) + s0; u32x2 w; w.x = pk2(y[0], y[1]); w.y = pk2(y[2], y[3]); *(u32x2*)(U + (size_t)row * DM + c) = w; }
        }
    }
}

template <int NTOK, bool SMP>
__device__ __forceinline__ void mixer_item(const Params& p, int it) {
    const int tid = threadIdx.x;
    const bf16_t* proj = (const bf16_t*)(p.ws + WS_PROJ);
    bf16_t* qn = (bf16_t*)(p.ws + WS_QN); bf16_t* kn = (bf16_t*)(p.ws + WS_KN); bf16_t* vv = (bf16_t*)(p.ws + WS_VV); bf16_t* yp = (bf16_t*)(p.ws + WS_YP);
    float* gbuf = (float*)(p.ws + WS_G); float* bbuf = (float*)(p.ws + WS_BETA);
    const int sb = it - 512;
    const int b = SMP ? 0 : (it >> 7), t0 = SMP ? 0 : (it & 127) * 16;
    const int rowbase = SMP ? TP + sb * 4 : b * 2048 + t0;
    if (tid < 384) {
        const int c0 = tid * 8;
        float w0[8], w1[8], w2[8], w3[8], xm3[8], xm2[8], xm1[8];
        const float* cw = p.in[11];
#pragma unroll
        for (int i = 0; i < 8; ++i) { w0[i] = cw[c0 + i]; w1[i] = cw[3072 + c0 + i]; w2[i] = cw[6144 + c0 + i]; w3[i] = cw[9216 + c0 + i]; }
        if (SMP) { const float* sc = p.in[5] + (size_t)sb * 3 * 3072 + c0;
#pragma unroll
            for (int i = 0; i < 8; ++i) { xm3[i] = sc[i]; xm2[i] = sc[3072 + i]; xm1[i] = sc[6144 + i]; }
        } else if (t0 == 0) {
#pragma unroll
            for (int i = 0; i < 8; ++i) { xm3[i] = 0.f; xm2[i] = 0.f; xm1[i] = 0.f; }
        } else {
            unpack8(*(const u32x4*)(proj + (size_t)(rowbase - 3) * NPROJ + c0), xm3); unpack8(*(const u32x4*)(proj + (size_t)(rowbase - 2) * NPROJ + c0), xm2); unpack8(*(const u32x4*)(proj + (size_t)(rowbase - 1) * NPROJ + c0), xm1);
        }
        constexpr int CH = NTOK < 8 ? NTOK : 8;
#pragma unroll 1
        for (int tc = 0; tc < NTOK; tc += CH) {
        u32x4 xr[CH];
#pragma unroll
        for (int t = 0; t < CH; ++t) xr[t] = *(const u32x4*)(proj + (size_t)(rowbase + tc + t) * NPROJ + c0);
#pragma unroll
        for (int t2 = 0; t2 < CH; ++t2) {
            const int t = tc + t2;
            const int row = rowbase + t; float xt[8], y[8];
            unpack8(xr[t2], xt);
            float ss = 0.f;
#pragma unroll
            for (int i = 0; i < 8; ++i) { const float a = w0[i] * xm3[i] + w1[i] * xm2[i] + w2[i] * xm1[i] + w3[i] * xt[i]; y[i] = siluf_(a); ss += y[i] * y[i]; }
            if (c0 < 2048) {
                ss += __shfl_xor(ss, 1); ss += __shfl_xor(ss, 2); ss += __shfl_xor(ss, 4); ss += __shfl_xor(ss, 8);
                const float inv = rsqrtf(ss + EPS);
#pragma unroll
                for (int i = 0; i < 8; ++i) y[i] *= inv;
            }
            bf16_t* dst = c0 < 1024 ? qn + (size_t)row * 1024 + c0 : (c0 < 2048 ? kn + (size_t)row * 1024 + (c0 - 1024) : vv + (size_t)row * 1024 + (c0 - 2048));
            *(u32x4*)dst = pack8(y);
            if (SMP) { if (t >= 1) { float* o = p.out + O_CS + ((size_t)sb * 3 + (t - 1)) * 3072 + c0; *(f32x4*)o = (f32x4){xt[0], xt[1], xt[2], xt[3]}; *(f32x4*)(o + 4) = (f32x4){xt[4], xt[5], xt[6], xt[7]}; } }
            else if (t0 + t >= 2045) { float* o = p.out + O_CP + ((size_t)b * 3 + (t0 + t - 2045)) * 3072 + c0; *(f32x4*)o = (f32x4){xt[0], xt[1], xt[2], xt[3]}; *(f32x4*)(o + 4) = (f32x4){xt[4], xt[5], xt[6], xt[7]}; }
#pragma unroll
            for (int i = 0; i < 8; ++i) { xm3[i] = xm2[i]; xm2[i] = xm1[i]; xm1[i] = xt[i]; }
        }
        }
    } else {
        const int pc = (tid - 384) * 8, gi = pc >> 8, w = 2 << gi;
        const int seqrow0 = SMP ? TP + sb * 4 : b * 2048;
        const float* sp = p.in[6] + (size_t)sb * 15 * 1024 + pc;
        auto xpool = [&](int tt, float* f) {
            if (tt >= 0) unpack8(*(const u32x4*)(proj + (size_t)(seqrow0 + tt) * NPROJ + C_XP + pc), f);
            else if (SMP) { const float* s = sp + (size_t)(15 + tt) * 1024;
#pragma unroll
                for (int i = 0; i < 8; ++i) f[i] = s[i]; }
            else {
#pragma unroll
                for (int i = 0; i < 8; ++i) f[i] = 0.f; }
        };
        float s[8];
#pragma unroll
        for (int i = 0; i < 8; ++i) s[i] = 0.f;
#pragma unroll
        for (int q = 1; q < 16; ++q) if (q < w) { float f[8]; xpool(t0 - q, f);
#pragma unroll
            for (int i = 0; i < 8; ++i) s[i] += f[i]; }
#pragma unroll 4
        for (int t = 0; t < NTOK; ++t) {
            const int tt = t0 + t; float x[8], y[8], f[8];
            xpool(tt, x);
            const float cnt = SMP ? (float)w : (float)min(w, tt + 1); const float ic = 1.0f / cnt;
#pragma unroll
            for (int i = 0; i < 8; ++i) { s[i] += x[i]; y[i] = s[i] * ic - x[i]; }
            *(u32x4*)(yp + (size_t)(seqrow0 + tt) * 1024 + pc) = pack8(y);
            xpool(tt - w + 1, f);
#pragma unroll
            for (int i = 0; i < 8; ++i) s[i] -= f[i];
            if (SMP) { float* o = p.out + O_PS + ((size_t)sb * 15 + 11 + t) * 1024 + pc; *(f32x4*)o = (f32x4){x[0], x[1], x[2], x[3]}; *(f32x4*)(o + 4) = (f32x4){x[4], x[5], x[6], x[7]}; }
            else if (tt >= 2033) { float* o = p.out + O_PP + ((size_t)b * 15 + (tt - 2033)) * 1024 + pc; *(f32x4*)o = (f32x4){x[0], x[1], x[2], x[3]}; *(f32x4*)(o + 4) = (f32x4){x[4], x[5], x[6], x[7]}; }
        }
        if (SMP) {
#pragma unroll
            for (int r = 0; r < 11; ++r) { const float* s2 = sp + (size_t)(4 + r) * 1024; float* o = p.out + O_PS + ((size_t)sb * 15 + r) * 1024 + pc; *(f32x4*)o = *(const f32x4*)s2; *(f32x4*)(o + 4) = *(const f32x4*)(s2 + 4); } }
    }
    if (tid < 256) { const int tk = tid >> 4, jj = tid & 15;
        if (tk < NTOK) { const int row = rowbase + tk; const float val = bf2f(proj[(size_t)row * NPROJ + C_AB + jj]);
            if (jj < 8) { const float xx = val + p.in[13][jj]; const float spl = xx > 20.f ? xx : log1pf(__expf(xx)); gbuf[row * 8 + jj] = -__expf(p.in[12][jj]) * spl; }
            else bbuf[row * 8 + (jj - 8)] = sigmoidf_(val); } }
}
__device__ __forceinline__ void mixer_prep_phase(const Params& p, int bid, int nblk) {
    for (int it = bid; it < 640; it += nblk) { if (it >= 512) mixer_item<4, true>(p, it); else mixer_item<16, false>(p, it); }
}

constexpr int P5_QS = 0, P5_KS = 17408, P5_VS = 34816, P5_MM = 52224, P5_DEC = 68608, P5_BETA = 68864;
__device__ __forceinline__ void chunk_prep_phase(const Params& p, int bid, int nblk, LAS unsigned char* lds) {
    const int tid = threadIdx.x, lane = tid & 63, wid = tid >> 6;
    const bf16_t* qn = (const bf16_t*)(p.ws + WS_QN); const bf16_t* kn = (const bf16_t*)(p.ws + WS_KN); const bf16_t* vv = (const bf16_t*)(p.ws + WS_VV);
    const float* gbuf = (const float*)(p.ws + WS_G); const float* bbuf = (const float*)(p.ws + WS_BETA);
    bf16_t* wdc = (bf16_t*)(p.ws + WS_WDC); bf16_t* qd = (bf16_t*)(p.ws + WS_QD); bf16_t* kt = (bf16_t*)(p.ws + WS_KT); bf16_t* qk = (bf16_t*)(p.ws + WS_QK);
    float* cdv = (float*)(p.ws + WS_CD); float* ub = p.out + OS_UB;
    LAS float* Mm = (LAS float*)(lds + P5_MM); LAS float* dec = (LAS float*)(lds + P5_DEC); LAS float* bet = (LAS float*)(lds + P5_BETA);
    const float scale = 0.08838834764831845f;
    for (int item = bid; item < 1024; item += nblk) {
        const int n = item & 31, bh = item >> 5, h = bh & 7, b = bh >> 3;
        const int r0 = b * 2048 + n * 64;
        __syncthreads();
#pragma unroll
        for (int i = 0; i < 2; ++i) { const int ch = tid + 512 * i, r = ch >> 4, c8 = (ch & 15) * 8; const size_t go = (size_t)(r0 + r) * 1024 + h * 128 + c8; const int lo = r * 272 + c8 * 2;
            *(LAS u32x4*)(lds + P5_QS + lo) = *(const u32x4*)(qn + go); *(LAS u32x4*)(lds + P5_KS + lo) = *(const u32x4*)(kn + go); *(LAS u32x4*)(lds + P5_VS + lo) = *(const u32x4*)(vv + go); }
        if (tid < 64) {
            float g = gbuf[(r0 + tid) * 8 + h];
#pragma unroll
            for (int o = 1; o < 64; o <<= 1) { const float t = __shfl_up(g, o); if (lane >= o) g += t; }
            dec[tid] = g;
        } else if (tid < 128) bet[tid - 64] = bbuf[(r0 + tid - 64) * 8 + h];
        __syncthreads();
        const float last = dec[63];
        {
            const int mat = wid >> 2, rt = wid & 3, fr = lane & 15, fq = lane >> 4;
            bf16x8 a[4];
#pragma unroll
            for (int kk = 0; kk < 4; ++kk) a[kk] = *(const LAS bf16x8*)(lds + (mat ? P5_QS : P5_KS) + (rt * 16 + fr) * 272 + (kk * 32 + fq * 8) * 2);
#pragma unroll
            for (int st = 0; st < 4; ++st) {
                f32x4 d = (f32x4){0.f, 0.f, 0.f, 0.f};
#pragma unroll
                for (int kk = 0; kk < 4; ++kk) { const bf16x8 bb = *(const LAS bf16x8*)(lds + P5_KS + (st * 16 + fr) * 272 + (kk * 32 + fq * 8) * 2); d = __builtin_amdgcn_mfma_f32_16x16x32_bf16(a[kk], bb, d, 0, 0, 0); }
                const int s = st * 16 + fr; const float ds = dec[s];
#pragma unroll
                for (int j = 0; j < 4; ++j) { const int r = rt * 16 + fq * 4 + j; const float dr = dec[r];
                    if (mat == 0) Mm[r * 64 + s] = (r > s) ? bet[r] * d[j] * __expf(dr - ds) : 0.f;
                    else qk[(size_t)item * 4096 + r * 64 + s] = f2bf((r >= s) ? scale * d[j] * __expf(dr - ds) : 0.f); }
            }
        }
        __syncthreads();
        if (tid < 256) {
            const int c = tid; float x[64];
            if (c < 128) {
#pragma unroll
                for (int r = 0; r < 64; ++r) x[r] = bf2f(*(const LAS bf16_t*)(lds + P5_VS + r * 272 + c * 2)) * bet[r];
            } else {
#pragma unroll
                for (int r = 0; r < 64; ++r) x[r] = bf2f(*(const LAS bf16_t*)(lds + P5_KS + r * 272 + (c - 128) * 2)) * bet[r] * __expf(dec[r]);
            }
            f32x4 mq[12]; float a0, a1;
            mq[0] = *(const LAS f32x4*)(Mm + 64); mq[1] = *(const LAS f32x4*)(Mm + 128); mq[2] = *(const LAS f32x4*)(Mm + 192); mq[3] = *(const LAS f32x4*)(Mm + 256); mq[4] = *(const LAS f32x4*)(Mm + 320); mq[5] = *(const LAS f32x4*)(Mm + 324); mq[6] = *(const LAS f32x4*)(Mm + 384); mq[7] = *(const LAS f32x4*)(Mm + 388); mq[8] = *(const LAS f32x4*)(Mm + 448); mq[9] = *(const LAS f32x4*)(Mm + 452); mq[10] = *(const LAS f32x4*)(Mm + 512); mq[11] = *(const LAS f32x4*)(Mm + 516);
            a0 = x[1]; a1 = 0.f; a0 -= mq[0][0] * x[0]; x[1] = a0 + a1; mq[0] = *(const LAS f32x4*)(Mm + 576);
            a0 = x[2]; a1 = 0.f; a0 -= mq[1][0] * x[0]; a1 -= mq[1][1] * x[1]; x[2] = a0 + a1; mq[1] = *(const LAS f32x4*)(Mm + 580);
            a0 = x[3]; a1 = 0.f; a0 -= mq[2][0] * x[0]; a1 -= mq[2][1] * x[1]; a0 -= mq[2][2] * x[2]; x[3] = a0 + a1; mq[2] = *(const LAS f32x4*)(Mm + 584);
            a0 = x[4]; a1 = 0.f; a0 -= mq[3][0] * x[0]; a1 -= mq[3][1] * x[1]; a0 -= mq[3][2] * x[2]; a1 -= mq[3][3] * x[3]; x[4] = a0 + a1; mq[3] = *(const LAS f32x4*)(Mm + 640);
            a0 = x[5]; a1 = 0.f; a0 -= mq[4][0] * x[0]; a1 -= mq[4][1] * x[1]; a0 -= mq[4][2] * x[2]; a1 -= mq[4][3] * x[3]; mq[4] = *(const LAS f32x4*)(Mm + 644);
            a0 -= mq[5][0] * x[4]; x[5] = a0 + a1; mq[5] = *(const LAS f32x4*)(Mm + 648);
            a0 = x[6]; a1 = 0.f; a0 -= mq[6][0] * x[0]; a1 -= mq[6][1] * x[1]; a0 -= mq[6][2] * x[2]; a1 -= mq[6][3] * x[3]; mq[6] = *(const LAS f32x4*)(Mm + 704);
            a0 -= mq[7][0] * x[4]; a1 -= mq[7][1] * x[5]; x[6] = a0 + a1; mq[7] = *(const LAS f32x4*)(Mm + 708);
            a0 = x[7]; a1 = 0.f; a0 -= mq[8][0] * x[0]; a1 -= mq[8][1] * x[1]; a0 -= mq[8][2] * x[2]; a1 -= mq[8][3] * x[3]; mq[8] = *(const LAS f32x4*)(Mm + 712);
            a0 -= mq[9][0] * x[4]; a1 -= mq[9][1] * x[5]; a0 -= mq[9][2] * x[6]; x[7] = a0 + a1; mq[9] = *(const LAS f32x4*)(Mm + 768);
            a0 = x[8]; a1 = 0.f; a0 -= mq[10][0] * x[0]; a1 -= mq[10][1] * x[1]; a0 -= mq[10][2] * x[2]; a1 -= mq[10][3] * x[3]; mq[10] = *(const LAS f32x4*)(Mm + 772);
            a0 -= mq[11][0] * x[4]; a1 -= mq[11][1] * x[5]; a0 -= mq[11][2] * x[6]; a1 -= mq[11][3] * x[7]; x[8] = a0 + a1; mq[11] = *(const LAS f32x4*)(Mm + 776);
            a0 = x[9]; a1 = 0.f; a0 -= mq[0][0] * x[0]; a1 -= mq[0][1] * x[1]; a0 -= mq[0][2] * x[2]; a1 -= mq[0][3] * x[3]; mq[0] = *(const LAS f32x4*)(Mm + 832);
            a0 -= mq[1][0] * x[4]; a1 -= mq[1][1] * x[5]; a0 -= mq[1][2] * x[6]; a1 -= mq[1][3] * x[7]; mq[1] = *(const LAS f32x4*)(Mm + 836);
            a0 -= mq[2][0] * x[8]; x[9] = a0 + a1; mq[2] = *(const LAS f32x4*)(Mm + 840);
            a0 = x[10]; a1 = 0.f; a0 -= mq[3][0] * x[0]; a1 -= mq[3][1] * x[1]; a0 -= mq[3][2] * x[2]; a1 -= mq[3][3] * x[3]; mq[3] = *(const LAS f32x4*)(Mm + 844);
            a0 -= mq[4][0] * x[4]; a1 -= mq[4][1] * x[5]; a0 -= mq[4][2] * x[6]; a1 -= mq[4][3] * x[7]; mq[4] = *(const LAS f32x4*)(Mm + 896);
            a0 -= mq[5][0] * x[8]; a1 -= mq[5][1] * x[9]; x[10] = a0 + a1; mq[5] = *(const LAS f32x4*)(Mm + 900);
            a0 = x[11]; a1 = 0.f; a0 -= mq[6][0] * x[0]; a1 -= mq[6][1] * x[1]; a0 -= mq[6][2] * x[2]; a1 -= mq[6][3] * x[3]; mq[6] = *(const LAS f32x4*)(Mm + 904);
            a0 -= mq[7][0] * x[4]; a1 -= mq[7][1] * x[5]; a0 -= mq[7][2] * x[6]; a1 -= mq[7][3] * x[7]; mq[7] = *(const LAS f32x4*)(Mm + 908);
            a0 -= mq[8][0] * x[8]; a1 -= mq[8][1] * x[9]; a0 -= mq[8][2] * x[10]; x[11] = a0 + a1; mq[8] = *(const LAS f32x4*)(Mm + 960);
            a0 = x[12]; a1 = 0.f; a0 -= mq[9][0] * x[0]; a1 -= mq[9][1] * x[1]; a0 -= mq[9][2] * x[2]; a1 -= mq[9][3] * x[3]; mq[9] = *(const LAS f32x4*)(Mm + 964);
            a0 -= mq[10][0] * x[4]; a1 -= mq[10][1] * x[5]; a0 -= mq[10][2] * x[6]; a1 -= mq[10][3] * x[7]; mq[10] = *(const LAS f32x4*)(Mm + 968);
            a0 -= mq[11][0] * x[8]; a1 -= mq[11][1] * x[9]; a0 -= mq[11][2] * x[10]; a1 -= mq[11][3] * x[11]; x[12] = a0 + a1; mq[11] = *(const LAS f32x4*)(Mm + 972);
            a0 = x[13]; a1 = 0.f; a0 -= mq[0][0] * x[0]; a1 -= mq[0][1] * x[1]; a0 -= mq[0][2] * x[2]; a1 -= mq[0][3] * x[3]; mq[0] = *(const LAS f32x4*)(Mm + 1024);
            a0 -= mq[1][0] * x[4]; a1 -= mq[1][1] * x[5]; a0 -= mq[1][2] * x[6]; a1 -= mq[1][3] * x[7]; mq[1] = *(const LAS f32x4*)(Mm + 1028);
            a0 -= mq[2][0] * x[8]; a1 -= mq[2][1] * x[9]; a0 -= mq[2][2] * x[10]; a1 -= mq[2][3] * x[11]; mq[2] = *(const LAS f32x4*)(Mm + 1032);
            a0 -= mq[3][0] * x[12]; x[13] = a0 + a1; mq[3] = *(const LAS f32x4*)(Mm + 1036);
            a0 = x[14]; a1 = 0.f; a0 -= mq[4][0] * x[0]; a1 -= mq[4][1] * x[1]; a0 -= mq[4][2] * x[2]; a1 -= mq[4][3] * x[3]; mq[4] = *(const LAS f32x4*)(Mm + 1088);
            a0 -= mq[5][0] * x[4]; a1 -= mq[5][1] * x[5]; a0 -= mq[5][2] * x[6]; a1 -= mq[5][3] * x[7]; mq[5] = *(const LAS f32x4*)(Mm + 1092);
            a0 -= mq[6][0] * x[8]; a1 -= mq[6][1] * x[9]; a0 -= mq[6][2] * x[10]; a1 -= mq[6][3] * x[11]; mq[6] = *(const LAS f32x4*)(Mm + 1096);
            a0 -= mq[7][0] * x[12]; a1 -= mq[7][1] * x[13]; x[14] = a0 + a1; mq[7] = *(const LAS f32x4*)(Mm + 1100);
            a0 = x[15]; a1 = 0.f; a0 -= mq[8][0] * x[0]; a1 -= mq[8][1] * x[1]; a0 -= mq[8][2] * x[2]; a1 -= mq[8][3] * x[3]; mq[8] = *(const LAS f32x4*)(Mm + 1104);
            a0 -= mq[9][0] * x[4]; a1 -= mq[9][1] * x[5]; a0 -= mq[9][2] * x[6]; a1 -= mq[9][3] * x[7]; mq[9] = *(const LAS f32x4*)(Mm + 1152);
            a0 -= mq[10][0] * x[8]; a1 -= mq[10][1] * x[9]; a0 -= mq[10][2] * x[10]; a1 -= mq[10][3] * x[11]; mq[10] = *(const LAS f32x4*)(Mm + 1156);
            a0 -= mq[11][0] * x[12]; a1 -= mq[11][1] * x[13]; a0 -= mq[11][2] * x[14]; x[15] = a0 + a1; mq[11] = *(const LAS f32x4*)(Mm + 1160);
            a0 = x[16]; a1 = 0.f; a0 -= mq[0][0] * x[0]; a1 -= mq[0][1] * x[1]; a0 -= mq[0][2] * x[2]; a1 -= mq[0][3] * x[3]; mq[0] = *(const LAS f32x4*)(Mm + 1164);
            a0 -= mq[1][0] * x[4]; a1 -= mq[1][1] * x[5]; a0 -= mq[1][2] * x[6]; a1 -= mq[1][3] * x[7]; mq[1] = *(const LAS f32x4*)(Mm + 1168);
            a0 -= mq[2][0] * x[8]; a1 -= mq[2][1] * x[9]; a0 -= mq[2][2] * x[10]; a1 -= mq[2][3] * x[11]; mq[2] = *(const LAS f32x4*)(Mm + 1216);
            a0 -= mq[3][0] * x[12]; a1 -= mq[3][1] * x[13]; a0 -= mq[3][2] * x[14]; a1 -= mq[3][3] * x[15]; x[16] = a0 + a1; mq[3] = *(const LAS f32x4*)(Mm + 1220);
            a0 = x[17]; a1 = 0.f; a0 -= mq[4][0] * x[0]; a1 -= mq[4][1] * x[1]; a0 -= mq[4][2] * x[2]; a1 -= mq[4][3] * x[3]; mq[4] = *(const LAS f32x4*)(Mm + 1224);
            a0 -= mq[5][0] * x[4]; a1 -= mq[5][1] * x[5]; a0 -= mq[5][2] * x[6]; a1 -= mq[5][3] * x[7]; mq[5] = *(const LAS f32x4*)(Mm + 1228);
            a0 -= mq[6][0] * x[8]; a1 -= mq[6][1] * x[9]; a0 -= mq[6][2] * x[10]; a1 -= mq[6][3] * x[11]; mq[6] = *(const LAS f32x4*)(Mm + 1232);
            a0 -= mq[7][0] * x[12]; a1 -= mq[7][1] * x[13]; a0 -= mq[7][2] * x[14]; a1 -= mq[7][3] * x[15]; mq[7] = *(const LAS f32x4*)(Mm + 1280);
            a0 -= mq[8][0] * x[16]; x[17] = a0 + a1; mq[8] = *(const LAS f32x4*)(Mm + 1284);
            a0 = x[18]; a1 = 0.f; a0 -= mq[9][0] * x[0]; a1 -= mq[9][1] * x[1]; a0 -= mq[9][2] * x[2]; a1 -= mq[9][3] * x[3]; mq[9] = *(const LAS f32x4*)(Mm + 1288);
            a0 -= mq[10][0] * x[4]; a1 -= mq[10][1] * x[5]; a0 -= mq[10][2] * x[6]; a1 -= mq[10][3] * x[7]; mq[10] = *(const LAS f32x4*)(Mm + 1292);
            a0 -= mq[11][0] * x[8]; a1 -= mq[11][1] * x[9]; a0 -= mq[11][2] * x[10]; a1 -= mq[11][3] * x[11]; mq[11] = *(const LAS f32x4*)(Mm + 1296);
            a0 -= mq[0][0] * x[12]; a1 -= mq[0][1] * x[13]; a0 -= mq[0][2] * x[14]; a1 -= mq[0][3] * x[15]; mq[0] = *(const LAS f32x4*)(Mm + 1344);
            a0 -= mq[1][0] * x[16]; a1 -= mq[1][1] * x[17]; x[18] = a0 + a1; mq[1] = *(const LAS f32x4*)(Mm + 1348);
            a0 = x[19]; a1 = 0.f; a0 -= mq[2][0] * x[0]; a1 -= mq[2][1] * x[1]; a0 -= mq[2][2] * x[2]; a1 -= mq[2][3] * x[3]; mq[2] = *(const LAS f32x4*)(Mm + 1352);
            a0 -= mq[3][0] * x[4]; a1 -= mq[3][1] * x[5]; a0 -= mq[3][2] * x[6]; a1 -= mq[3][3] * x[7]; mq[3] = *(const LAS f32x4*)(Mm + 1356);
            a0 -= mq[4][0] * x[8]; a1 -= mq[4][1] * x[9]; a0 -= mq[4][2] * x[10]; a1 -= mq[4][3] * x[11]; mq[4] = *(const LAS f32x4*)(Mm + 1360);
            a0 -= mq[5][0] * x[12]; a1 -= mq[5][1] * x[13]; a0 -= mq[5][2] * x[14]; a1 -= mq[5][3] * x[15]; mq[5] = *(const LAS f32x4*)(Mm + 1364);
            a0 -= mq[6][0] * x[16]; a1 -= mq[6][1] * x[17]; a0 -= mq[6][2] * x[18]; x[19] = a0 + a1; mq[6] = *(const LAS f32x4*)(Mm + 1408);
            a0 = x[20]; a1 = 0.f; a0 -= mq[7][0] * x[0]; a1 -= mq[7][1] * x[1]; a0 -= mq[7][2] * x[2]; a1 -= mq[7][3] * x[3]; mq[7] = *(const LAS f32x4*)(Mm + 1412);
            a0 -= mq[8][0] * x[4]; a1 -= mq[8][1] * x[5]; a0 -= mq[8][2] * x[6]; a1 -= mq[8][3] * x[7]; mq[8] = *(const LAS f32x4*)(Mm + 1416);
            a0 -= mq[9][0] * x[8]; a1 -= mq[9][1] * x[9]; a0 -= mq[9][2] * x[10]; a1 -= mq[9][3] * x[11]; mq[9] = *(const LAS f32x4*)(Mm + 1420);
            a0 -= mq[10][0] * x[12]; a1 -= mq[10][1] * x[13]; a0 -= mq[10][2] * x[14]; a1 -= mq[10][3] * x[15]; mq[10] = *(const LAS f32x4*)(Mm + 1424);
            a0 -= mq[11][0] * x[16]; a1 -= mq[11][1] * x[17]; a0 -= mq[11][2] * x[18]; a1 -= mq[11][3] * x[19]; x[20] = a0 + a1; mq[11] = *(const LAS f32x4*)(Mm + 1428);
            a0 = x[21]; a1 = 0.f; a0 -= mq[0][0] * x[0]; a1 -= mq[0][1] * x[1]; a0 -= mq[0][2] * x[2]; a1 -= mq[0][3] * x[3]; mq[0] = *(const LAS f32x4*)(Mm + 1472);
            a0 -= mq[1][0] * x[4]; a1 -= mq[1][1] * x[5]; a0 -= mq[1][2] * x[6]; a1 -= mq[1][3] * x[7]; mq[1] = *(const LAS f32x4*)(Mm + 1476);
            a0 -= mq[2][0] * x[8]; a1 -= mq[2][1] * x[9]; a0 -= mq[2][2] * x[10]; a1 -= mq[2][3] * x[11]; mq[2] = *(const LAS f32x4*)(Mm + 1480);
            a0 -= mq[3][0] * x[12]; a1 -= mq[3][1] * x[13]; a0 -= mq[3][2] * x[14]; a1 -= mq[3][3] * x[15]; mq[3] = *(const LAS f32x4*)(Mm + 1484);
            a0 -= mq[4][0] * x[16]; a1 -= mq[4][1] * x[17]; a0 -= mq[4][2] * x[18]; a1 -= mq[4][3] * x[19]; mq[4] = *(const LAS f32x4*)(Mm + 1488);
            a0 -= mq[5][0] * x[20]; x[21] = a0 + a1; mq[5] = *(const LAS f32x4*)(Mm + 1492);
            a0 = x[22]; a1 = 0.f; a0 -= mq[6][0] * x[0]; a1 -= mq[6][1] * x[1]; a0 -= mq[6][2] * x[2]; a1 -= mq[6][3] * x[3]; mq[6] = *(const LAS f32x4*)(Mm + 1536);
            a0 -= mq[7][0] * x[4]; a1 -= mq[7][1] * x[5]; a0 -= mq[7][2] * x[6]; a1 -= mq[7][3] * x[7]; mq[7] = *(const LAS f32x4*)(Mm + 1540);
            a0 -= mq[8][0] * x[8]; a1 -= mq[8][1] * x[9]; a0 -= mq[8][2] * x[10]; a1 -= mq[8][3] * x[11]; mq[8] = *(const LAS f32x4*)(Mm + 1544);
            a0 -= mq[9][0] * x[12]; a1 -= mq[9][1] * x[13]; a0 -= mq[9][2] * x[14]; a1 -= mq[9][3] * x[15]; mq[9] = *(const LAS f32x4*)(Mm + 1548);
            a0 -= mq[10][0] * x[16]; a1 -= mq[10][1] * x[17]; a0 -= mq[10][2] * x[18]; a1 -= mq[10][3] * x[19]; mq[10] = *(const LAS f32x4*)(Mm + 1552);
            a0 -= mq[11][0] * x[20]; a1 -= mq[11][1] * x[21]; x[22] = a0 + a1; mq[11] = *(const LAS f32x4*)(Mm + 1556);
            a0 = x[23]; a1 = 0.f; a0 -= mq[0][0] * x[0]; a1 -= mq[0][1] * x[1]; a0 -= mq[0][2] * x[2]; a1 -= mq[0][3] * x[3]; mq[0] = *(const LAS f32x4*)(Mm + 1600);
            a0 -= mq[1][0] * x[4]; a1 -= mq[1][1] * x[5]; a0 -= mq[1][2] * x[6]; a1 -= mq[1][3] * x[7]; mq[1] = *(const LAS f32x4*)(Mm + 1604);
            a0 -= mq[2][0] * x[8]; a1 -= mq[2][1] * x[9]; a0 -= mq[2][2] * x[10]; a1 -= mq[2][3] * x[11]; mq[2] = *(const LAS f32x4*)(Mm + 1608);
            a0 -= mq[3][0] * x[12]; a1 -= mq[3][1] * x[13]; a0 -= mq[3][2] * x[14]; a1 -= mq[3][3] * x[15]; mq[3] = *(const LAS f32x4*)(Mm + 1612);
            a0 -= mq[4][0] * x[16]; a1 -= mq[4][1] * x[17]; a0 -= mq[4][2] * x[18]; a1 -= mq[4][3] * x[19]; mq[4] = *(const LAS f32x4*)(Mm + 1616);
            a0 -= mq[5][0] * x[20]; a1 -= mq[5][1] * x[21]; a0 -= mq[5][2] * x[22]; x[23] = a0 + a1; mq[5] = *(const LAS f32x4*)(Mm + 1620);
            a0 = x[24]; a1 = 0.f; a0 -= mq[6][0] * x[0]; a1 -= mq[6][1] * x[1]; a0 -= mq[6][2] * x[2]; a1 -= mq[6][3] * x[3]; mq[6] = *(const LAS f32x4*)(Mm + 1624);
            a0 -= mq[7][0] * x[4]; a1 -= mq[7][1] * x[5]; a0 -= mq[7][2] * x[6]; a1 -= mq[7][3] * x[7]; mq[7] = *(const LAS f32x4*)(Mm + 1664);
            a0 -= mq[8][0] * x[8]; a1 -= mq[8][1] * x[9]; a0 -= mq[8][2] * x[10]; a1 -= mq[8][3] * x[11]; mq[8] = *(const LAS f32x4*)(Mm + 1668);
            a0 -= mq[9][0] * x[12]; a1 -= mq[9][1] * x[13]; a0 -= mq[9][2] * x[14]; a1 -= mq[9][3] * x[15]; mq[9] = *(const LAS f32x4*)(Mm + 1672);
            a0 -= mq[10][0] * x[16]; a1 -= mq[10][1] * x[17]; a0 -= mq[10][2] * x[18]; a1 -= mq[10][3] * x[19]; mq[10] = *(const LAS f32x4*)(Mm + 1676);
            a0 -= mq[11][0] * x[20]; a1 -= mq[11][1] * x[21]; a0 -= mq[11][2] * x[22]; a1 -= mq[11][3] * x[23]; x[24] = a0 + a1; mq[11] = *(const LAS f32x4*)(Mm + 1680);
            a0 = x[25]; a1 = 0.f; a0 -= mq[0][0] * x[0]; a1 -= mq[0][1] * x[1]; a0 -= mq[0][2] * x[2]; a1 -= mq[0][3] * x[3]; mq[0] = *(const LAS f32x4*)(Mm + 1684);
            a0 -= mq[1][0] * x[4]; a1 -= mq[1][1] * x[5]; a0 -= mq[1][2] * x[6]; a1 -= mq[1][3] * x[7]; mq[1] = *(const LAS f32x4*)(Mm + 1688);
            a0 -= mq[2][0] * x[8]; a1 -= mq[2][1] * x[9]; a0 -= mq[2][2] * x[10]; a1 -= mq[2][3] * x[11]; mq[2] = *(const LAS f32x4*)(Mm + 1728);
            a0 -= mq[3][0] * x[12]; a1 -= mq[3][1] * x[13]; a0 -= mq[3][2] * x[14]; a1 -= mq[3][3] * x[15]; mq[3] = *(const LAS f32x4*)(Mm + 1732);
            a0 -= mq[4][0] * x[16]; a1 -= mq[4][1] * x[17]; a0 -= mq[4][2] * x[18]; a1 -= mq[4][3] * x[19]; mq[4] = *(const LAS f32x4*)(Mm + 1736);
            a0 -= mq[5][0] * x[20]; a1 -= mq[5][1] * x[21]; a0 -= mq[5][2] * x[22]; a1 -= mq[5][3] * x[23]; mq[5] = *(const LAS f32x4*)(Mm + 1740);
            a0 -= mq[6][0] * x[24]; x[25] = a0 + a1; mq[6] = *(const LAS f32x4*)(Mm + 1744);
            a0 = x[26]; a1 = 0.f; a0 -= mq[7][0] * x[0]; a1 -= mq[7][1] * x[1]; a0 -= mq[7][2] * x[2]; a1 -= mq[7][3] * x[3]; mq[7] = *(const LAS f32x4*)(Mm + 1748);
            a0 -= mq[8][0] * x[4]; a1 -= mq[8][1] * x[5]; a0 -= mq[8][2] * x[6]; a1 -= mq[8][3] * x[7]; mq[8] = *(const LAS f32x4*)(Mm + 1752);
            a0 -= mq[9][0] * x[8]; a1 -= mq[9][1] * x[9]; a0 -= mq[9][2] * x[10]; a1 -= mq[9][3] * x[11]; mq[9] = *(const LAS f32x4*)(Mm + 1792);
            a0 -= mq[10][0] * x[12]; a1 -= mq[10][1] * x[13]; a0 -= mq[10][2] * x[14]; a1 -= mq[10][3] * x[15]; mq[10] = *(const LAS f32x4*)(Mm + 1796);
            a0 -= mq[11][0] * x[16]; a1 -= mq[11][1] * x[17]; a0 -= mq[11][2] * x[18]; a1 -= mq[11][3] * x[19]; mq[11] = *(const LAS f32x4*)(Mm + 1800);
            a0 -= mq[0][0] * x[20]; a1 -= mq[0][1] * x[21]; a0 -= mq[0][2] * x[22]; a1 -= mq[0][3] * x[23]; mq[0] = *(const LAS f32x4*)(Mm + 1804);
            a0 -= mq[1][0] * x[24]; a1 -= mq[1][1] * x[25]; x[26] = a0 + a1; mq[1] = *(const LAS f32x4*)(Mm + 1808);
            a0 = x[27]; a1 = 0.f; a0 -= mq[2][0] * x[0]; a1 -= mq[2][1] * x[1]; a0 -= mq[2][2] * x[2]; a1 -= mq[2][3] * x[3]; mq[2] = *(const LAS f32x4*)(Mm + 1812);
            a0 -= mq[3][0] * x[4]; a1 -= mq[3][1] * x[5]; a0 -= mq[3][2] * x[6]; a1 -= mq[3][3] * x[7]; mq[3] = *(const LAS f32x4*)(Mm + 1816);
            a0 -= mq[4][0] * x[8]; a1 -= mq[4][1] * x[9]; a0 -= mq[4][2] * x[10]; a1 -= mq[4][3] * x[11]; mq[4] = *(const LAS f32x4*)(Mm + 1856);
            a0 -= mq[5][0] * x[12]; a1 -= mq[5][1] * x[13]; a0 -= mq[5][2] * x[14]; a1 -= mq[5][3] * x[15]; mq[5] = *(const LAS f32x4*)(Mm + 1860);
            a0 -= mq[6][0] * x[16]; a1 -= mq[6][1] * x[17]; a0 -= mq[6][2] * x[18]; a1 -= mq[6][3] * x[19]; mq[6] = *(const LAS f32x4*)(Mm + 1864);
            a0 -= mq[7][0] * x[20]; a1 -= mq[7][1] * x[21]; a0 -= mq[7][2] * x[22]; a1 -= mq[7][3] * x[23]; mq[7] = *(const LAS f32x4*)(Mm + 1868);
            a0 -= mq[8][0] * x[24]; a1 -= mq[8][1] * x[25]; a0 -= mq[8][2] * x[26]; x[27] = a0 + a1; mq[8] = *(const LAS f32x4*)(Mm + 1872);
            a0 = x[28]; a1 = 0.f; a0 -= mq[9][0] * x[0]; a1 -= mq[9][1] * x[1]; a0 -= mq[9][2] * x[2]; a1 -= mq[9][3] * x[3]; mq[9] = *(const LAS f32x4*)(Mm + 1876);
            a0 -= mq[10][0] * x[4]; a1 -= mq[10][1] * x[5]; a0 -= mq[10][2] * x[6]; a1 -= mq[10][3] * x[7]; mq[10] = *(const LAS f32x4*)(Mm + 1880);
            a0 -= mq[11][0] * x[8]; a1 -= mq[11][1] * x[9]; a0 -= mq[11][2] * x[10]; a1 -= mq[11][3] * x[11]; mq[11] = *(const LAS f32x4*)(Mm + 1884);
            a0 -= mq[0][0] * x[12]; a1 -= mq[0][1] * x[13]; a0 -= mq[0][2] * x[14]; a1 -= mq[0][3] * x[15]; mq[0] = *(const LAS f32x4*)(Mm + 1920);
            a0 -= mq[1][0] * x[16]; a1 -= mq[1][1] * x[17]; a0 -= mq[1][2] * x[18]; a1 -= mq[1][3] * x[19]; mq[1] = *(const LAS f32x4*)(Mm + 1924);
            a0 -= mq[2][0] * x[20]; a1 -= mq[2][1] * x[21]; a0 -= mq[2][2] * x[22]; a1 -= mq[2][3] * x[23]; mq[2] = *(const LAS f32x4*)(Mm + 1928);
            a0 -= mq[3][0] * x[24]; a1 -= mq[3][1] * x[25]; a0 -= mq[3][2] * x[26]; a1 -= mq[3][3] * x[27]; x[28] = a0 + a1; mq[3] = *(const LAS f32x4*)(Mm + 1932);
            a0 = x[29]; a1 = 0.f; a0 -= mq[4][0] * x[0]; a1 -= mq[4][1] * x[1]; a0 -= mq[4][2] * x[2]; a1 -= mq[4][3] * x[3]; mq[4] = *(const LAS f32x4*)(Mm + 1936);
            a0 -= mq[5][0] * x[4]; a1 -= mq[5][1] * x[5]; a0 -= mq[5][2] * x[6]; a1 -= mq[5][3] * x[7]; mq[5] = *(const LAS f32x4*)(Mm + 1940);
            a0 -= mq[6][0] * x[8]; a1 -= mq[6][1] * x[9]; a0 -= mq[6][2] * x[10]; a1 -= mq[6][3] * x[11]; mq[6] = *(const LAS f32x4*)(Mm + 1944);
            a0 -= mq[7][0] * x[12]; a1 -= mq[7][1] * x[13]; a0 -= mq[7][2] * x[14]; a1 -= mq[7][3] * x[15]; mq[7] = *(const LAS f32x4*)(Mm + 1948);
            a0 -= mq[8][0] * x[16]; a1 -= mq[8][1] * x[17]; a0 -= mq[8][2] * x[18]; a1 -= mq[8][3] * x[19]; mq[8] = *(const LAS f32x4*)(Mm + 1984);
            a0 -= mq[9][0] * x[20]; a1 -= mq[9][1] * x[21]; a0 -= mq[9][2] * x[22]; a1 -= mq[9][3] * x[23]; mq[9] = *(const LAS f32x4*)(Mm + 1988);
            a0 -= mq[10][0] * x[24]; a1 -= mq[10][1] * x[25]; a0 -= mq[10][2] * x[26]; a1 -= mq[10][3] * x[27]; mq[10] = *(const LAS f32x4*)(Mm + 1992);
            a0 -= mq[11][0] * x[28]; x[29] = a0 + a1; mq[11] = *(const LAS f32x4*)(Mm + 1996);
            a0 = x[30]; a1 = 0.f; a0 -= mq[0][0] * x[0]; a1 -= mq[0][1] * x[1]; a0 -= mq[0][2] * x[2]; a1 -= mq[0][3] * x[3]; mq[0] = *(const LAS f32x4*)(Mm + 2000);
            a0 -= mq[1][0] * x[4]; a1 -= mq[1][1] * x[5]; a0 -= mq[1][2] * x[6]; a1 -= mq[1][3] * x[7]; mq[1] = *(const LAS f32x4*)(Mm + 2004);
            a0 -= mq[2][0] * x[8]; a1 -= mq[2][1] * x[9]; a0 -= mq[2][2] * x[10]; a1 -= mq[2][3] * x[11]; mq[2] = *(const LAS f32x4*)(Mm + 2008);
            a0 -= mq[3][0] * x[12]; a1 -= mq[3][1] * x[13]; a0 -= mq[3][2] * x[14]; a1 -= mq[3][3] * x[15]; mq[3] = *(const LAS f32x4*)(Mm + 2012);
            a0 -= mq[4][0] * x[16]; a1 -= mq[4][1] * x[17]; a0 -= mq[4][2] * x[18]; a1 -= mq[4][3] * x[19]; mq[4] = *(const LAS f32x4*)(Mm + 2048);
            a0 -= mq[5][0] * x[20]; a1 -= mq[5][1] * x[21]; a0 -= mq[5][2] * x[22]; a1 -= mq[5][3] * x[23]; mq[5] = *(const LAS f32x4*)(Mm + 2052);
            a0 -= mq[6][0] * x[24]; a1 -= mq[6][1] * x[25]; a0 -= mq[6][2] * x[26]; a1 -= mq[6][3] * x[27]; mq[6] = *(const LAS f32x4*)(Mm + 2056);
            a0 -= mq[7][0] * x[28]; a1 -= mq[7][1] * x[29]; x[30] = a0 + a1; mq[7] = *(const LAS f32x4*)(Mm + 2060);
            a0 = x[31]; a1 = 0.f; a0 -= mq[8][0] * x[0]; a1 -= mq[8][1] * x[1]; a0 -= mq[8][2] * x[2]; a1 -= mq[8][3] * x[3]; mq[8] = *(const LAS f32x4*)(Mm + 2064);
            a0 -= mq[9][0] * x[4]; a1 -= mq[9][1] * x[5]; a0 -= mq[9][2] * x[6]; a1 -= mq[9][3] * x[7]; mq[9] = *(const LAS f32x4*)(Mm + 2068);
            a0 -= mq[10][0] * x[8]; a1 -= mq[10][1] * x[9]; a0 -= mq[10][2] * x[10]; a1 -= mq[10][3] * x[11]; mq[10] = *(const LAS f32x4*)(Mm + 2072);
            a0 -= mq[11][0] * x[12]; a1 -= mq[11][1] * x[13]; a0 -= mq[11][2] * x[14]; a1 -= mq[11][3] * x[15]; mq[11] = *(const LAS f32x4*)(Mm + 2076);
            a0 -= mq[0][0] * x[16]; a1 -= mq[0][1] * x[17]; a0 -= mq[0][2] * x[18]; a1 -= mq[0][3] * x[19]; mq[0] = *(const LAS f32x4*)(Mm + 2112);
            a0 -= mq[1][0] * x[20]; a1 -= mq[1][1] * x[21]; a0 -= mq[1][2] * x[22]; a1 -= mq[1][3] * x[23]; mq[1] = *(const LAS f32x4*)(Mm + 2116);
            a0 -= mq[2][0] * x[24]; a1 -= mq[2][1] * x[25]; a0 -= mq[2][2] * x[26]; a1 -= mq[2][3] * x[27]; mq[2] = *(const LAS f32x4*)(Mm + 2120);
            a0 -= mq[3][0] * x[28]; a1 -= mq[3][1] * x[29]; a0 -= mq[3][2] * x[30]; x[31] = a0 + a1; mq[3] = *(const LAS f32x4*)(Mm + 2124);
            a0 = x[32]; a1 = 0.f; a0 -= mq[4][0] * x[0]; a1 -= mq[4][1] * x[1]; a0 -= mq[4][2] * x[2]; a1 -= mq[4][3] * x[3]; mq[4] = *(const LAS f32x4*)(Mm + 2128);
            a0 -= mq[5][0] * x[4]; a1 -= mq[5][1] * x[5]; a0 -= mq[5][2] * x[6]; a1 -= mq[5][3] * x[7]; mq[5] = *(const LAS f32x4*)(Mm + 2132);
            a0 -= mq[6][0] * x[8]; a1 -= mq[6][1] * x[9]; a0 -= mq[6][2] * x[10]; a1 -= mq[6][3] * x[11]; mq[6] = *(const LAS f32x4*)(Mm + 2136);
            a0 -= mq[7][0] * x[12]; a1 -= mq[7][1] * x[13]; a0 -= mq[7][2] * x[14]; a1 -= mq[7][3] * x[15]; mq[7] = *(const LAS f32x4*)(Mm + 2140);
            a0 -= mq[8][0] * x[16]; a1 -= mq[8][1] * x[17]; a0 -= mq[8][2] * x[18]; a1 -= mq[8][3] * x[19]; mq[8] = *(const LAS f32x4*)(Mm + 2144);
            a0 -= mq[9][0] * x[20]; a1 -= mq[9][1] * x[21]; a0 -= mq[9][2] * x[22]; a1 -= mq[9][3] * x[23]; mq[9] = *(const LAS f32x4*)(Mm + 2176);
            a0 -= mq[10][0] * x[24]; a1 -= mq[10][1] * x[25]; a0 -= mq[10][2] * x[26]; a1 -= mq[10][3] * x[27]; mq[10] = *(const LAS f32x4*)(Mm + 2180);
            a0 -= mq[11][0] * x[28]; a1 -= mq[11][1] * x[29]; a0 -= mq[11][2] * x[30]; a1 -= mq[11][3] * x[31]; x[32] = a0 + a1; mq[11] = *(const LAS f32x4*)(Mm + 2184);
            a0 = x[33]; a1 = 0.f; a0 -= mq[0][0] * x[0]; a1 -= mq[0][1] * x[1]; a0 -= mq[0][2] * x[2]; a1 -= mq[0][3] * x[3]; mq[0] = *(const LAS f32x4*)(Mm + 2188);
            a0 -= mq[1][0] * x[4]; a1 -= mq[1][1] * x[5]; a0 -= mq[1][2] * x[6]; a1 -= mq[1][3] * x[7]; mq[1] = *(const LAS f32x4*)(Mm + 2192);
            a0 -= mq[2][0] * x[8]; a1 -= mq[2][1] * x[9]; a0 -= mq[2][2] * x[10]; a1 -= mq[2][3] * x[11]; mq[2] = *(const LAS f32x4*)(Mm + 2196);
            a0 -= mq[3][0] * x[12]; a1 -= mq[3][1] * x[13]; a0 -= mq[3][2] * x[14]; a1 -= mq[3][3] * x[15]; mq[3] = *(const LAS f32x4*)(Mm + 2200);
            a0 -= mq[4][0] * x[16]; a1 -= mq[4][1] * x[17]; a0 -= mq[4][2] * x[18]; a1 -= mq[4][3] * x[19]; mq[4] = *(const LAS f32x4*)(Mm + 2204);
            a0 -= mq[5][0] * x[20]; a1 -= mq[5][1] * x[21]; a0 -= mq[5][2] * x[22]; a1 -= mq[5][3] * x[23]; mq[5] = *(const LAS f32x4*)(Mm + 2208);
            a0 -= mq[6][0] * x[24]; a1 -= mq[6][1] * x[25]; a0 -= mq[6][2] * x[26]; a1 -= mq[6][3] * x[27]; mq[6] = *(const LAS f32x4*)(Mm + 2240);
            a0 -= mq[7][0] * x[28]; a1 -= mq[7][1] * x[29]; a0 -= mq[7][2] * x[30]; a1 -= mq[7][3] * x[31]; mq[7] = *(const LAS f32x4*)(Mm + 2244);
            a0 -= mq[8][0] * x[32]; x[33] = a0 + a1; mq[8] = *(const LAS f32x4*)(Mm + 2248);
            a0 = x[34]; a1 = 0.f; a0 -= mq[9][0] * x[0]; a1 -= mq[9][1] * x[1]; a0 -= mq[9][2] * x[2]; a1 -= mq[9][3] * x[3]; mq[9] = *(const LAS f32x4*)(Mm + 2252);
            a0 -= mq[10][0] * x[4]; a1 -= mq[10][1] * x[5]; a0 -= mq[10][2] * x[6]; a1 -= mq[10][3] * x[7]; mq[10] = *(const LAS f32x4*)(Mm + 2256);
            a0 -= mq[11][0] * x[8]; a1 -= mq[11][1] * x[9]; a0 -= mq[11][2] * x[10]; a1 -= mq[11][3] * x[11]; mq[11] = *(const LAS f32x4*)(Mm + 2260);
            a0 -= mq[0][0] * x[12]; a1 -= mq[0][1] * x[13]; a0 -= mq[0][2] * x[14]; a1 -= mq[0][3] * x[15]; mq[0] = *(const LAS f32x4*)(Mm + 2264);
            a0 -= mq[1][0] * x[16]; a1 -= mq[1][1] * x[17]; a0 -= mq[1][2] * x[18]; a1 -= mq[1][3] * x[19]; mq[1] = *(const LAS f32x4*)(Mm + 2268);
            a0 -= mq[2][0] * x[20]; a1 -= mq[2][1] * x[21]; a0 -= mq[2][2] * x[22]; a1 -= mq[2][3] * x[23]; mq[2] = *(const LAS f32x4*)(Mm + 2272);
            a0 -= mq[3][0] * x[24]; a1 -= mq[3][1] * x[25]; a0 -= mq[3][2] * x[26]; a1 -= mq[3][3] * x[27]; mq[3] = *(const LAS f32x4*)(Mm + 2304);
            a0 -= mq[4][0] * x[28]; a1 -= mq[4][1] * x[29]; a0 -= mq[4][2] * x[30]; a1 -= mq[4][3] * x[31]; mq[4] = *(const LAS f32x4*)(Mm + 2308);
            a0 -= mq[5][0] * x[32]; a1 -= mq[5][1] * x[33]; x[34] = a0 + a1; mq[5] = *(const LAS f32x4*)(Mm + 2312);
            a0 = x[35]; a1 = 0.f; a0 -= mq[6][0] * x[0]; a1 -= mq[6][1] * x[1]; a0 -= mq[6][2] * x[2]; a1 -= mq[6][3] * x[3]; mq[6] = *(const LAS f32x4*)(Mm + 2316);
            a0 -= mq[7][0] * x[4]; a1 -= mq[7][1] * x[5]; a0 -= mq[7][2] * x[6]; a1 -= mq[7][3] * x[7]; mq[7] = *(const LAS f32x4*)(Mm + 2320);
            a0 -= mq[8][0] * x[8]; a1 -= mq[8][1] * x[9]; a0 -= mq[8][2] * x[10]; a1 -= mq[8][3] * x[11]; mq[8] = *(const LAS f32x4*)(Mm + 2324);
            a0 -= mq[9][0] * x[12]; a1 -= mq[9][1] * x[13]; a0 -= mq[9][2] * x[14]; a1 -= mq[9][3] * x[15]; mq[9] = *(const LAS f32x4*)(Mm + 2328);
            a0 -= mq[10][0] * x[16]; a1 -= mq[10][1] * x[17]; a0 -= mq[10][2] * x[18]; a1 -= mq[10][3] * x[19]; mq[10] = *(const LAS f32x4*)(Mm + 2332);
            a0 -= mq[11][0] * x[20]; a1 -= mq[11][1] * x[21]; a0 -= mq[11][2] * x[22]; a1 -= mq[11][3] * x[23]; mq[11] = *(const LAS f32x4*)(Mm + 2336);
            a0 -= mq[0][0] * x[24]; a1 -= mq[0][1] * x[25]; a0 -= mq[0][2] * x[26]; a1 -= mq[0][3] * x[27]; mq[0] = *(const LAS f32x4*)(Mm + 2368);
            a0 -= mq[1][0] * x[28]; a1 -= mq[1][1] * x[29]; a0 -= mq[1][2] * x[30]; a1 -= mq[1][3] * x[31]; mq[1] = *(const LAS f32x4*)(Mm + 2372);
            a0 -= mq[2][0] * x[32]; a1 -= mq[2][1] * x[33]; a0 -= mq[2][2] * x[34]; x[35] = a0 + a1; mq[2] = *(const LAS f32x4*)(Mm + 2376);
            a0 = x[36]; a1 = 0.f; a0 -= mq[3][0] * x[0]; a1 -= mq[3][1] * x[1]; a0 -= mq[3][2] * x[2]; a1 -= mq[3][3] * x[3]; mq[3] = *(const LAS f32x4*)(Mm + 2380);
            a0 -= mq[4][0] * x[4]; a1 -= mq[4][1] * x[5]; a0 -= mq[4][2] * x[6]; a1 -= mq[4][3] * x[7]; mq[4] = *(const LAS f32x4*)(Mm + 2384);
            a0 -= mq[5][0] * x[8]; a1 -= mq[5][1] * x[9]; a0 -= mq[5][2] * x[10]; a1 -= mq[5][3] * x[11]; mq[5] = *(const LAS f32x4*)(Mm + 2388);
            a0 -= mq[6][0] * x[12]; a1 -= mq[6][1] * x[13]; a0 -= mq[6][2] * x[14]; a1 -= mq[6][3] * x[15]; mq[6] = *(const LAS f32x4*)(Mm + 2392);
            a0 -= mq[7][0] * x[16]; a1 -= mq[7][1] * x[17]; a0 -= mq[7][2] * x[18]; a1 -= mq[7][3] * x[19]; mq[7] = *(const LAS f32x4*)(Mm + 2396);
            a0 -= mq[8][0] * x[20]; a1 -= mq[8][1] * x[21]; a0 -= mq[8][2] * x[22]; a1 -= mq[8][3] * x[23]; mq[8] = *(const LAS f32x4*)(Mm + 2400);
            a0 -= mq[9][0] * x[24]; a1 -= mq[9][1] * x[25]; a0 -= mq[9][2] * x[26]; a1 -= mq[9][3] * x[27]; mq[9] = *(const LAS f32x4*)(Mm + 2404);
            a0 -= mq[10][0] * x[28]; a1 -= mq[10][1] * x[29]; a0 -= mq[10][2] * x[30]; a1 -= mq[10][3] * x[31]; mq[10] = *(const LAS f32x4*)(Mm + 2432);
            a0 -= mq[11][0] * x[32]; a1 -= mq[11][1] * x[33]; a0 -= mq[11][2] * x[34]; a1 -= mq[11][3] * x[35]; x[36] = a0 + a1; mq[11] = *(const LAS f32x4*)(Mm + 2436);
            a0 = x[37]; a1 = 0.f; a0 -= mq[0][0] * x[0]; a1 -= mq[0][1] * x[1]; a0 -= mq[0][2] * x[2]; a1 -= mq[0][3] * x[3]; mq[0] = *(const LAS f32x4*)(Mm + 2440);
            a0 -= mq[1][0] * x[4]; a1 -= mq[1][1] * x[5]; a0 -= mq[1][2] * x[6]; a1 -= mq[1][3] * x[7]; mq[1] = *(const LAS f32x4*)(Mm + 2444);
            a0 -= mq[2][0] * x[8]; a1 -= mq[2][1] * x[9]; a0 -= mq[2][2] * x[10]; a1 -= mq[2][3] * x[11]; mq[2] = *(const LAS f32x4*)(Mm + 2448);
            a0 -= mq[3][0] * x[12]; a1 -= mq[3][1] * x[13]; a0 -= mq[3][2] * x[14]; a1 -= mq[3][3] * x[15]; mq[3] = *(const LAS f32x4*)(Mm + 2452);
            a0 -= mq[4][0] * x[16]; a1 -= mq[4][1] * x[17]; a0 -= mq[4][2] * x[18]; a1 -= mq[4][3] * x[19]; mq[4] = *(const LAS f32x4*)(Mm + 2456);
            a0 -= mq[5][0] * x[20]; a1 -= mq[5][1] * x[21]; a0 -= mq[5][2] * x[22]; a1 -= mq[5][3] * x[23]; mq[5] = *(const LAS f32x4*)(Mm + 2460);
            a0 -= mq[6][0] * x[24]; a1 -= mq[6][1] * x[25]; a0 -= mq[6][2] * x[26]; a1 -= mq[6][3] * x[27]; mq[6] = *(const LAS f32x4*)(Mm + 2464);
            a0 -= mq[7][0] * x[28]; a1 -= mq[7][1] * x[29]; a0 -= mq[7][2] * x[30]; a1 -= mq[7][3] * x[31]; mq[7] = *(const LAS f32x4*)(Mm + 2468);
            a0 -= mq[8][0] * x[32]; a1 -= mq[8][1] * x[33]; a0 -= mq[8][2] * x[34]; a1 -= mq[8][3] * x[35]; mq[8] = *(const LAS f32x4*)(Mm + 2496);
            a0 -= mq[9][0] * x[36]; x[37] = a0 + a1; mq[9] = *(const LAS f32x4*)(Mm + 2500);
            a0 = x[38]; a1 = 0.f; a0 -= mq[10][0] * x[0]; a1 -= mq[10][1] * x[1]; a0 -= mq[10][2] * x[2]; a1 -= mq[10][3] * x[3]; mq[10] = *(const LAS f32x4*)(Mm + 2504);
            a0 -= mq[11][0] * x[4]; a1 -= mq[11][1] * x[5]; a0 -= mq[11][2] * x[6]; a1 -= mq[11][3] * x[7]; mq[11] = *(const LAS f32x4*)(Mm + 2508);
            a0 -= mq[0][0] * x[8]; a1 -= mq[0][1] * x[9]; a0 -= mq[0][2] * x[10]; a1 -= mq[0][3] * x[11]; mq[0] = *(const LAS f32x4*)(Mm + 2512);
            a0 -= mq[1][0] * x[12]; a1 -= mq[1][1] * x[13]; a0 -= mq[1][2] * x[14]; a1 -= mq[1][3] * x[15]; mq[1] = *(const LAS f32x4*)(Mm + 2516);
            a0 -= mq[2][0] * x[16]; a1 -= mq[2][1] * x[17]; a0 -= mq[2][2] * x[18]; a1 -= mq[2][3] * x[19]; mq[2] = *(const LAS f32x4*)(Mm + 2520);
            a0 -= mq[3][0] * x[20]; a1 -= mq[3][1] * x[21]; a0 -= mq[3][2] * x[22]; a1 -= mq[3][3] * x[23]; mq[3] = *(const LAS f32x4*)(Mm + 2524);
            a0 -= mq[4][0] * x[24]; a1 -= mq[4][1] * x[25]; a0 -= mq[4][2] * x[26]; a1 -= mq[4][3] * x[27]; mq[4] = *(const LAS f32x4*)(Mm + 2528);
            a0 -= mq[5][0] * x[28]; a1 -= mq[5][1] * x[29]; a0 -= mq[5][2] * x[30]; a1 -= mq[5][3] * x[31]; mq[5] = *(const LAS f32x4*)(Mm + 2532);
            a0 -= mq[6][0] * x[32]; a1 -= mq[6][1] * x[33]; a0 -= mq[6][2] * x[34]; a1 -= mq[6][3] * x[35]; mq[6] = *(const LAS f32x4*)(Mm + 2560);
            a0 -= mq[7][0] * x[36]; a1 -= mq[7][1] * x[37]; x[38] = a0 + a1; mq[7] = *(const LAS f32x4*)(Mm + 2564);
            a0 = x[39]; a1 = 0.f; a0 -= mq[8][0] * x[0]; a1 -= mq[8][1] * x[1]; a0 -= mq[8][2] * x[2]; a1 -= mq[8][3] * x[3]; mq[8] = *(const LAS f32x4*)(Mm + 2568);
            a0 -= mq[9][0] * x[4]; a1 -= mq[9][1] * x[5]; a0 -= mq[9][2] * x[6]; a1 -= mq[9][3] * x[7]; mq[9] = *(const LAS f32x4*)(Mm + 2572);
            a0 -= mq[10][0] * x[8]; a1 -= mq[10][1] * x[9]; a0 -= mq[10][2] * x[10]; a1 -= mq[10][3] * x[11]; mq[10] = *(const LAS f32x4*)(Mm + 2576);
            a0 -= mq[11][0] * x[12]; a1 -= mq[11][1] * x[13]; a0 -= mq[11][2] * x[14]; a1 -= mq[11][3] * x[15]; mq[11] = *(const LAS f32x4*)(Mm + 2580);
            a0 -= mq[0][0] * x[16]; a1 -= mq[0][1] * x[17]; a0 -= mq[0][2] * x[18]; a1 -= mq[0][3] * x[19]; mq[0] = *(const LAS f32x4*)(Mm + 2584);
            a0 -= mq[1][0] * x[20]; a1 -= mq[1][1] * x[21]; a0 -= mq[1][2] * x[22]; a1 -= mq[1][3] * x[23]; mq[1] = *(const LAS f32x4*)(Mm + 2588);
            a0 -= mq[2][0] * x[24]; a1 -= mq[2][1] * x[25]; a0 -= mq[2][2] * x[26]; a1 -= mq[2][3] * x[27]; mq[2] = *(const LAS f32x4*)(Mm + 2592);
            a0 -= mq[3][0] * x[28]; a1 -= mq[3][1] * x[29]; a0 -= mq[3][2] * x[30]; a1 -= mq[3][3] * x[31]; mq[3] = *(const LAS f32x4*)(Mm + 2596);
            a0 -= mq[4][0] * x[32]; a1 -= mq[4][1] * x[33]; a0 -= mq[4][2] * x[34]; a1 -= mq[4][3] * x[35]; mq[4] = *(const LAS f32x4*)(Mm + 2624);
            a0 -= mq[5][0] * x[36]; a1 -= mq[5][1] * x[37]; a0 -= mq[5][2] * x[38]; x[39] = a0 + a1; mq[5] = *(const LAS f32x4*)(Mm + 2628);
            a0 = x[40]; a1 = 0.f; a0 -= mq[6][0] * x[0]; a1 -= mq[6][1] * x[1]; a0 -= mq[6][2] * x[2]; a1 -= mq[6][3] * x[3]; mq[6] = *(const LAS f32x4*)(Mm + 2632);
            a0 -= mq[7][0] * x[4]; a1 -= mq[7][1] * x[5]; a0 -= mq[7][2] * x[6]; a1 -= mq[7][3] * x[7]; mq[7] = *(const LAS f32x4*)(Mm + 2636);
            a0 -= mq[8][0] * x[8]; a1 -= mq[8][1] * x[9]; a0 -= mq[8][2] * x[10]; a1 -= mq[8][3] * x[11]; mq[8] = *(const LAS f32x4*)(Mm + 2640);
            a0 -= mq[9][0] * x[12]; a1 -= mq[9][1] * x[13]; a0 -= mq[9][2] * x[14]; a1 -= mq[9][3] * x[15]; mq[9] = *(const LAS f32x4*)(Mm + 2644);
            a0 -= mq[10][0] * x[16]; a1 -= mq[10][1] * x[17]; a0 -= mq[10][2] * x[18]; a1 -= mq[10][3] * x[19]; mq[10] = *(const LAS f32x4*)(Mm + 2648);
            a0 -= mq[11][0] * x[20]; a1 -= mq[11][1] * x[21]; a0 -= mq[11][2] * x[22]; a1 -= mq[11][3] * x[23]; mq[11] = *(const LAS f32x4*)(Mm + 2652);
            a0 -= mq[0][0] * x[24]; a1 -= mq[0][1] * x[25]; a0 -= mq[0][2] * x[26]; a1 -= mq[0][3] * x[27]; mq[0] = *(const LAS f32x4*)(Mm + 2656);
            a0 -= mq[1][0] * x[28]; a1 -= mq[1][1] * x[29]; a0 -= mq[1][2] * x[30]; a1 -= mq[1][3] * x[31]; mq[1] = *(const LAS f32x4*)(Mm + 2660);
            a0 -= mq[2][0] * x[32]; a1 -= mq[2][1] * x[33]; a0 -= mq[2][2] * x[34]; a1 -= mq[2][3] * x[35]; mq[2] = *(const LAS f32x4*)(Mm + 2664);
            a0 -= mq[3][0] * x[36]; a1 -= mq[3][1] * x[37]; a0 -= mq[3][2] * x[38]; a1 -= mq[3][3] * x[39]; x[40] = a0 + a1; mq[3] = *(const LAS f32x4*)(Mm + 2688);
            a0 = x[41]; a1 = 0.f; a0 -= mq[4][0] * x[0]; a1 -= mq[4][1] * x[1]; a0 -= mq[4][2] * x[2]; a1 -= mq[4][3] * x[3]; mq[4] = *(const LAS f32x4*)(Mm + 2692);
            a0 -= mq[5][0] * x[4]; a1 -= mq[5][1] * x[5]; a0 -= mq[5][2] * x[6]; a1 -= mq[5][3] * x[7]; mq[5] = *(const LAS f32x4*)(Mm + 2696);
            a0 -= mq[6][0] * x[8]; a1 -= mq[6][1] * x[9]; a0 -= mq[6][2] * x[10]; a1 -= mq[6][3] * x[11]; mq[6] = *(const LAS f32x4*)(Mm + 2700);
            a0 -= mq[7][0] * x[12]; a1 -= mq[7][1] * x[13]; a0 -= mq[7][2] * x[14]; a1 -= mq[7][3] * x[15]; mq[7] = *(const LAS f32x4*)(Mm + 2704);
            a0 -= mq[8][0] * x[16]; a1 -= mq[8][1] * x[17]; a0 -= mq[8][2] * x[18]; a1 -= mq[8][3] * x[19]; mq[8] = *(const LAS f32x4*)(Mm + 2708);
            a0 -= mq[9][0] * x[20]; a1 -= mq[9][1] * x[21]; a0 -= mq[9][2] * x[22]; a1 -= mq[9][3] * x[23]; mq[9] = *(const LAS f32x4*)(Mm + 2712);
            a0 -= mq[10][0] * x[24]; a1 -= mq[10][1] * x[25]; a0 -= mq[10][2] * x[26]; a1 -= mq[10][3] * x[27]; mq[10] = *(const LAS f32x4*)(Mm + 2716);
            a0 -= mq[11][0] * x[28]; a1 -= mq[11][1] * x[29]; a0 -= mq[11][2] * x[30]; a1 -= mq[11][3] * x[31]; mq[11] = *(const LAS f32x4*)(Mm + 2720);
            a0 -= mq[0][0] * x[32]; a1 -= mq[0][1] * x[33]; a0 -= mq[0][2] * x[34]; a1 -= mq[0][3] * x[35]; mq[0] = *(const LAS f32x4*)(Mm + 2724);
            a0 -= mq[1][0] * x[36]; a1 -= mq[1][1] * x[37]; a0 -= mq[1][2] * x[38]; a1 -= mq[1][3] * x[39]; mq[1] = *(const LAS f32x4*)(Mm + 2728);
            a0 -= mq[2][0] * x[40]; x[41] = a0 + a1; mq[2] = *(const LAS f32x4*)(Mm + 2752);
            a0 = x[42]; a1 = 0.f; a0 -= mq[3][0] * x[0]; a1 -= mq[3][1] * x[1]; a0 -= mq[3][2] * x[2]; a1 -= mq[3][3] * x[3]; mq[3] = *(const LAS f32x4*)(Mm + 2756);
            a0 -= mq[4][0] * x[4]; a1 -= mq[4][1] * x[5]; a0 -= mq[4][2] * x[6]; a1 -= mq[4][3] * x[7]; mq[4] = *(const LAS f32x4*)(Mm + 2760);
            a0 -= mq[5][0] * x[8]; a1 -= mq[5][1] * x[9]; a0 -= mq[5][2] * x[10]; a1 -= mq[5][3] * x[11]; mq[5] = *(const LAS f32x4*)(Mm + 2764);
            a0 -= mq[6][0] * x[12]; a1 -= mq[6][1] * x[13]; a0 -= mq[6][2] * x[14]; a1 -= mq[6][3] * x[15]; mq[6] = *(const LAS f32x4*)(Mm + 2768);
            a0 -= mq[7][0] * x[16]; a1 -= mq[7][1] * x[17]; a0 -= mq[7][2] * x[18]; a1 -= mq[7][3] * x[19]; mq[7] = *(const LAS f32x4*)(Mm + 2772);
            a0 -= mq[8][0] * x[20]; a1 -= mq[8][1] * x[21]; a0 -= mq[8][2] * x[22]; a1 -= mq[8][3] * x[23]; mq[8] = *(const LAS f32x4*)(Mm + 2776);
            a0 -= mq[9][0] * x[24]; a1 -= mq[9][1] * x[25]; a0 -= mq[9][2] * x[26]; a1 -= mq[9][3] * x[27]; mq[9] = *(const LAS f32x4*)(Mm + 2780);
            a0 -= mq[10][0] * x[28]; a1 -= mq[10][1] * x[29]; a0 -= mq[10][2] * x[30]; a1 -= mq[10][3] * x[31]; mq[10] = *(const LAS f32x4*)(Mm + 2784);
            a0 -= mq[11][0] * x[32]; a1 -= mq[11][1] * x[33]; a0 -= mq[11][2] * x[34]; a1 -= mq[11][3] * x[35]; mq[11] = *(const LAS f32x4*)(Mm + 2788);
            a0 -= mq[0][0] * x[36]; a1 -= mq[0][1] * x[37]; a0 -= mq[0][2] * x[38]; a1 -= mq[0][3] * x[39]; mq[0] = *(const LAS f32x4*)(Mm + 2792);
            a0 -= mq[1][0] * x[40]; a1 -= mq[1][1] * x[41]; x[42] = a0 + a1; mq[1] = *(const LAS f32x4*)(Mm + 2816);
            a0 = x[43]; a1 = 0.f; a0 -= mq[2][0] * x[0]; a1 -= mq[2][1] * x[1]; a0 -= mq[2][2] * x[2]; a1 -= mq[2][3] * x[3]; mq[2] = *(const LAS f32x4*)(Mm + 2820);
            a0 -= mq[3][0] * x[4]; a1 -= mq[3][1] * x[5]; a0 -= mq[3][2] * x[6]; a1 -= mq[3][3] * x[7]; mq[3] = *(const LAS f32x4*)(Mm + 2824);
            a0 -= mq[4][0] * x[8]; a1 -= mq[4][1] * x[9]; a0 -= mq[4][2] * x[10]; a1 -= mq[4][3] * x[11]; mq[4] = *(const LAS f32x4*)(Mm + 2828);
            a0 -= mq[5][0] * x[12]; a1 -= mq[5][1] * x[13]; a0 -= mq[5][2] * x[14]; a1 -= mq[5][3] * x[15]; mq[5] = *(const LAS f32x4*)(Mm + 2832);
            a0 -= mq[6][0] * x[16]; a1 -= mq[6][1] * x[17]; a0 -= mq[6][2] * x[18]; a1 -= mq[6][3] * x[19]; mq[6] = *(const LAS f32x4*)(Mm + 2836);
            a0 -= mq[7][0] * x[20]; a1 -= mq[7][1] * x[21]; a0 -= mq[7][2] * x[22]; a1 -= mq[7][3] * x[23]; mq[7] = *(const LAS f32x4*)(Mm + 2840);
            a0 -= mq[8][0] * x[24]; a1 -= mq[8][1] * x[25]; a0 -= mq[8][2] * x[26]; a1 -= mq[8][3] * x[27]; mq[8] = *(const LAS f32x4*)(Mm + 2844);
            a0 -= mq[9][0] * x[28]; a1 -= mq[9][1] * x[29]; a0 -= mq[9][2] * x[30]; a1 -= mq[9][3] * x[31]; mq[9] = *(const LAS f32x4*)(Mm + 2848);
            a0 -= mq[10][0] * x[32]; a1 -= mq[10][1] * x[33]; a0 -= mq[10][2] * x[34]; a1 -= mq[10][3] * x[35]; mq[10] = *(const LAS f32x4*)(Mm + 2852);
            a0 -= mq[11][0] * x[36]; a1 -= mq[11][1] * x[37]; a0 -= mq[11][2] * x[38]; a1 -= mq[11][3] * x[39]; mq[11] = *(const LAS f32x4*)(Mm + 2856);
            a0 -= mq[0][0] * x[40]; a1 -= mq[0][1] * x[41]; a0 -= mq[0][2] * x[42]; x[43] = a0 + a1; mq[0] = *(const LAS f32x4*)(Mm + 2880);
            a0 = x[44]; a1 = 0.f; a0 -= mq[1][0] * x[0]; a1 -= mq[1][1] * x[1]; a0 -= mq[1][2] * x[2]; a1 -= mq[1][3] * x[3]; mq[1] = *(const LAS f32x4*)(Mm + 2884);
            a0 -= mq[2][0] * x[4]; a1 -= mq[2][1] * x[5]; a0 -= mq[2][2] * x[6]; a1 -= mq[2][3] * x[7]; mq[2] = *(const LAS f32x4*)(Mm + 2888);
            a0 -= mq[3][0] * x[8]; a1 -= mq[3][1] * x[9]; a0 -= mq[3][2] * x[10]; a1 -= mq[3][3] * x[11]; mq[3] = *(const LAS f32x4*)(Mm + 2892);
            a0 -= mq[4][0] * x[12]; a1 -= mq[4][1] * x[13]; a0 -= mq[4][2] * x[14]; a1 -= mq[4][3] * x[15]; mq[4] = *(const LAS f32x4*)(Mm + 2896);
            a0 -= mq[5][0] * x[16]; a1 -= mq[5][1] * x[17]; a0 -= mq[5][2] * x[18]; a1 -= mq[5][3] * x[19]; mq[5] = *(const LAS f32x4*)(Mm + 2900);
            a0 -= mq[6][0] * x[20]; a1 -= mq[6][1] * x[21]; a0 -= mq[6][2] * x[22]; a1 -= mq[6][3] * x[23]; mq[6] = *(const LAS f32x4*)(Mm + 2904);
            a0 -= mq[7][0] * x[24]; a1 -= mq[7][1] * x[25]; a0 -= mq[7][2] * x[26]; a1 -= mq[7][3] * x[27]; mq[7] = *(const LAS f32x4*)(Mm + 2908);
            a0 -= mq[8][0] * x[28]; a1 -= mq[8][1] * x[29]; a0 -= mq[8][2] * x[30]; a1 -= mq[8][3] * x[31]; mq[8] = *(const LAS f32x4*)(Mm + 2912);
            a0 -= mq[9][0] * x[32]; a1 -= mq[9][1] * x[33]; a0 -= mq[9][2] * x[34]; a1 -= mq[9][3] * x[35]; mq[9] = *(const LAS f32x4*)(Mm + 2916);
            a0 -= mq[10][0] * x[36]; a1 -= mq[10][1] * x[37]; a0 -= mq[10][2] * x[38]; a1 -= mq[10][3] * x[39]; mq[10] = *(const LAS f32x4*)(Mm + 2920);
            a0 -= mq[11][0] * x[40]; a1 -= mq[11][1] * x[41]; a0 -= mq[11][2] * x[42]; a1 -= mq[11][3] * x[43]; x[44] = a0 + a1; mq[11] = *(const LAS f32x4*)(Mm + 2924);
            a0 = x[45]; a1 = 0.f; a0 -= mq[0][0] * x[0]; a1 -= mq[0][1] * x[1]; a0 -= mq[0][2] * x[2]; a1 -= mq[0][3] * x[3]; mq[0] = *(const LAS f32x4*)(Mm + 2944);
            a0 -= mq[1][0] * x[4]; a1 -= mq[1][1] * x[5]; a0 -= mq[1][2] * x[6]; a1 -= mq[1][3] * x[7]; mq[1] = *(const LAS f32x4*)(Mm + 2948);
            a0 -= mq[2][0] * x[8]; a1 -= mq[2][1] * x[9]; a0 -= mq[2][2] * x[10]; a1 -= mq[2][3] * x[11]; mq[2] = *(const LAS f32x4*)(Mm + 2952);
            a0 -= mq[3][0] * x[12]; a1 -= mq[3][1] * x[13]; a0 -= mq[3][2] * x[14]; a1 -= mq[3][3] * x[15]; mq[3] = *(const LAS f32x4*)(Mm + 2956);
            a0 -= mq[4][0] * x[16]; a1 -= mq[4][1] * x[17]; a0 -= mq[4][2] * x[18]; a1 -= mq[4][3] * x[19]; mq[4] = *(const LAS f32x4*)(Mm + 2960);
            a0 -= mq[5][0] * x[20]; a1 -= mq[5][1] * x[21]; a0 -= mq[5][2] * x[22]; a1 -= mq[5][3] * x[23]; mq[5] = *(const LAS f32x4*)(Mm + 2964);
            a0 -= mq[6][0] * x[24]; a1 -= mq[6][1] * x[25]; a0 -= mq[6][2] * x[26]; a1 -= mq[6][3] * x[27]; mq[6] = *(const LAS f32x4*)(Mm + 2968);
            a0 -= mq[7][0] * x[28]; a1 -= mq[7][1] * x[29]; a0 -= mq[7][2] * x[30]; a1 -= mq[7][3] * x[31]; mq[7] = *(const LAS f32x4*)(Mm + 2972);
            a0 -= mq[8][0] * x[32]; a1 -= mq[8][1] * x[33]; a0 -= mq[8][2] * x[34]; a1 -= mq[8][3] * x[35]; mq[8] = *(const LAS f32x4*)(Mm + 2976);
            a0 -= mq[9][0] * x[36]; a1 -= mq[9][1] * x[37]; a0 -= mq[9][2] * x[38]; a1 -= mq[9][3] * x[39]; mq[9] = *(const LAS f32x4*)(Mm + 2980);
            a0 -= mq[10][0] * x[40]; a1 -= mq[10][1] * x[41]; a0 -= mq[10][2] * x[42]; a1 -= mq[10][3] * x[43]; mq[10] = *(const LAS f32x4*)(Mm + 2984);
            a0 -= mq[11][0] * x[44]; x[45] = a0 + a1; mq[11] = *(const LAS f32x4*)(Mm + 2988);
            a0 = x[46]; a1 = 0.f; a0 -= mq[0][0] * x[0]; a1 -= mq[0][1] * x[1]; a0 -= mq[0][2] * x[2]; a1 -= mq[0][3] * x[3]; mq[0] = *(const LAS f32x4*)(Mm + 3008);
            a0 -= mq[1][0] * x[4]; a1 -= mq[1][1] * x[5]; a0 -= mq[1][2] * x[6]; a1 -= mq[1][3] * x[7]; mq[1] = *(const LAS f32x4*)(Mm + 3012);
            a0 -= mq[2][0] * x[8]; a1 -= mq[2][1] * x[9]; a0 -= mq[2][2] * x[10]; a1 -= mq[2][3] * x[11]; mq[2] = *(const LAS f32x4*)(Mm + 3016);
            a0 -= mq[3][0] * x[12]; a1 -= mq[3][1] * x[13]; a0 -= mq[3][2] * x[14]; a1 -= mq[3][3] * x[15]; mq[3] = *(const LAS f32x4*)(Mm + 3020);
            a0 -= mq[4][0] * x[16]; a1 -= mq[4][1] * x[17]; a0 -= mq[4][2] * x[18]; a1 -= mq[4][3] * x[19]; mq[4] = *(const LAS f32x4*)(Mm + 3024);
            a0 -= mq[5][0] * x[20]; a1 -= mq[5][1] * x[21]; a0 -= mq[5][2] * x[22]; a1 -= mq[5][3] * x[23]; mq[5] = *(const LAS f32x4*)(Mm + 3028);
            a0 -= mq[6][0] * x[24]; a1 -= mq[6][1] * x[25]; a0 -= mq[6][2] * x[26]; a1 -= mq[6][3] * x[27]; mq[6] = *(const LAS f32x4*)(Mm + 3032);
            a0 -= mq[7][0] * x[28]; a1 -= mq[7][1] * x[29]; a0 -= mq[7][2] * x[30]; a1 -= mq[7][3] * x[31]; mq[7] = *(const LAS f32x4*)(Mm + 3036);
            a0 -= mq[8][0] * x[32]; a1 -= mq[8][1] * x[33]; a0 -= mq[8][2] * x[34]; a1 -= mq[8][3] * x[35]; mq[8] = *(const LAS f32x4*)(Mm + 3040);
            a0 -= mq[9][0] * x[36]; a1 -= mq[9][1] * x[37]; a0 -= mq[9][2] * x[38]; a1 -= mq[9][3] * x[39]; mq[9] = *(const LAS f32x4*)(Mm + 3044);
            a0 -= mq[10][0] * x[40]; a1 -= mq[10][1] * x[41]; a0 -= mq[10][2] * x[42]; a1 -= mq[10][3] * x[43]; mq[10] = *(const LAS f32x4*)(Mm + 3048);
            a0 -= mq[11][0] * x[44]; a1 -= mq[11][1] * x[45]; x[46] = a0 + a1; mq[11] = *(const LAS f32x4*)(Mm + 3052);
            a0 = x[47]; a1 = 0.f; a0 -= mq[0][0] * x[0]; a1 -= mq[0][1] * x[1]; a0 -= mq[0][2] * x[2]; a1 -= mq[0][3] * x[3]; mq[0] = *(const LAS f32x4*)(Mm + 3072);
            a0 -= mq[1][0] * x[4]; a1 -= mq[1][1] * x[5]; a0 -= mq[1][2] * x[6]; a1 -= mq[1][3] * x[7]; mq[1] = *(const LAS f32x4*)(Mm + 3076);
            a0 -= mq[2][0] * x[8]; a1 -= mq[2][1] * x[9]; a0 -= mq[2][2] * x[10]; a1 -= mq[2][3] * x[11]; mq[2] = *(const LAS f32x4*)(Mm + 3080);
            a0 -= mq[3][0] * x[12]; a1 -= mq[3][1] * x[13]; a0 -= mq[3][2] * x[14]; a1 -= mq[3][3] * x[15]; mq[3] = *(const LAS f32x4*)(Mm + 3084);
            a0 -= mq[4][0] * x[16]; a1 -= mq[4][1] * x[17]; a0 -= mq[4][2] * x[18]; a1 -= mq[4][3] * x[19]; mq[4] = *(const LAS f32x4*)(Mm + 3088);
            a0 -= mq[5][0] * x[20]; a1 -= mq[5][1] * x[21]; a0 -= mq[5][2] * x[22]; a1 -= mq[5][3] * x[23]; mq[5] = *(const LAS f32x4*)(Mm + 3092);
            a0 -= mq[6][0] * x[24]; a1 -= mq[6][1] * x[25]; a0 -= mq[6][2] * x[26]; a1 -= mq[6][3] * x[27]; mq[6] = *(const LAS f32x4*)(Mm + 3096);
            a0 -= mq[7][0] * x[28]; a1 -= mq[7][1] * x[29]; a0 -= mq[7][2] * x[30]; a1 -= mq[7][3] * x[31]; mq[7] = *(const LAS f32x4*)(Mm + 3100);
            a0 -= mq[8][0] * x[32]; a1 -= mq[8][1] * x[33]; a0 -= mq[8][2] * x[34]; a1 -= mq[8][3] * x[35]; mq[8] = *(const LAS f32x4*)(Mm + 3104);
            a0 -= mq[9][0] * x[36]; a1 -= mq[9][1] * x[37]; a0 -= mq[9][2] * x[38]; a1 -= mq[9][3] * x[39]; mq[9] = *(const LAS f32x4*)(Mm + 3108);
            a0 -= mq[10][0] * x[40]; a1 -= mq[10][1] * x[41]; a0 -= mq[10][2] * x[42]; a1 -= mq[10][3] * x[43]; mq[10] = *(const LAS f32x4*)(Mm + 3112);
            a0 -= mq[11][0] * x[44]; a1 -= mq[11][1] * x[45]; a0 -= mq[11][2] * x[46]; x[47] = a0 + a1; mq[11] = *(const LAS f32x4*)(Mm + 3116);
            a0 = x[48]; a1 = 0.f; a0 -= mq[0][0] * x[0]; a1 -= mq[0][1] * x[1]; a0 -= mq[0][2] * x[2]; a1 -= mq[0][3] * x[3]; mq[0] = *(const LAS f32x4*)(Mm + 3136);
            a0 -= mq[1][0] * x[4]; a1 -= mq[1][1] * x[5]; a0 -= mq[1][2] * x[6]; a1 -= mq[1][3] * x[7]; mq[1] = *(const LAS f32x4*)(Mm + 3140);
            a0 -= mq[2][0] * x[8]; a1 -= mq[2][1] * x[9]; a0 -= mq[2][2] * x[10]; a1 -= mq[2][3] * x[11]; mq[2] = *(const LAS f32x4*)(Mm + 3144);
            a0 -= mq[3][0] * x[12]; a1 -= mq[3][1] * x[13]; a0 -= mq[3][2] * x[14]; a1 -= mq[3][3] * x[15]; mq[3] = *(const LAS f32x4*)(Mm + 3148);
            a0 -= mq[4][0] * x[16]; a1 -= mq[4][1] * x[17]; a0 -= mq[4][2] * x[18]; a1 -= mq[4][3] * x[19]; mq[4] = *(const LAS f32x4*)(Mm + 3152);
            a0 -= mq[5][0] * x[20]; a1 -= mq[5][1] * x[21]; a0 -= mq[5][2] * x[22]; a1 -= mq[5][3] * x[23]; mq[5] = *(const LAS f32x4*)(Mm + 3156);
            a0 -= mq[6][0] * x[24]; a1 -= mq[6][1] * x[25]; a0 -= mq[6][2] * x[26]; a1 -= mq[6][3] * x[27]; mq[6] = *(const LAS f32x4*)(Mm + 3160);
            a0 -= mq[7][0] * x[28]; a1 -= mq[7][1] * x[29]; a0 -= mq[7][2] * x[30]; a1 -= mq[7][3] * x[31]; mq[7] = *(const LAS f32x4*)(Mm + 3164);
            a0 -= mq[8][0] * x[32]; a1 -= mq[8][1] * x[33]; a0 -= mq[8][2] * x[34]; a1 -= mq[8][3] * x[35]; mq[8] = *(const LAS f32x4*)(Mm + 3168);
            a0 -= mq[9][0] * x[36]; a1 -= mq[9][1] * x[37]; a0 -= mq[9][2] * x[38]; a1 -= mq[9][3] * x[39]; mq[9] = *(const LAS f32x4*)(Mm + 3172);
            a0 -= mq[10][0] * x[40]; a1 -= mq[10][1] * x[41]; a0 -= mq[10][2] * x[42]; a1 -= mq[10][3] * x[43]; mq[10] = *(const LAS f32x4*)(Mm + 3176);
            a0 -= mq[11][0] * x[44]; a1 -= mq[11][1] * x[45]; a0 -= mq[11][2] * x[46]; a1 -= mq[11][3] * x[47]; x[48] = a0 + a1; mq[11] = *(const LAS f32x4*)(Mm + 3180);
            a0 = x[49]; a1 = 0.f; a0 -= mq[0][0] * x[0]; a1 -= mq[0][1] * x[1]; a0 -= mq[0][2] * x[2]; a1 -= mq[0][3] * x[3]; mq[0] = *(const LAS f32x4*)(Mm + 3184);
            a0 -= mq[1][0] * x[4]; a1 -= mq[1][1] * x[5]; a0 -= mq[1][2] * x[6]; a1 -= mq[1][3] * x[7]; mq[1] = *(const LAS f32x4*)(Mm + 3200);
            a0 -= mq[2][0] * x[8]; a1 -= mq[2][1] * x[9]; a0 -= mq[2][2] * x[10]; a1 -= mq[2][3] * x[11]; mq[2] = *(const LAS f32x4*)(Mm + 3204);
            a0 -= mq[3][0] * x[12]; a1 -= mq[3][1] * x[13]; a0 -= mq[3][2] * x[14]; a1 -= mq[3][3] * x[15]; mq[3] = *(const LAS f32x4*)(Mm + 3208);
            a0 -= mq[4][0] * x[16]; a1 -= mq[4][1] * x[17]; a0 -= mq[4][2] * x[18]; a1 -= mq[4][3] * x[19]; mq[4] = *(const LAS f32x4*)(Mm + 3212);
            a0 -= mq[5][0] * x[20]; a1 -= mq[5][1] * x[21]; a0 -= mq[5][2] * x[22]; a1 -= mq[5][3] * x[23]; mq[5] = *(const LAS f32x4*)(Mm + 3216);
            a0 -= mq[6][0] * x[24]; a1 -= mq[6][1] * x[25]; a0 -= mq[6][2] * x[26]; a1 -= mq[6][3] * x[27]; mq[6] = *(const LAS f32x4*)(Mm + 3220);
            a0 -= mq[7][0] * x[28]; a1 -= mq[7][1] * x[29]; a0 -= mq[7][2] * x[30]; a1 -= mq[7][3] * x[31]; mq[7] = *(const LAS f32x4*)(Mm + 3224);
            a0 -= mq[8][0] * x[32]; a1 -= mq[8][1] * x[33]; a0 -= mq[8][2] * x[34]; a1 -= mq[8][3] * x[35]; mq[8] = *(const LAS f32x4*)(Mm + 3228);
            a0 -= mq[9][0] * x[36]; a1 -= mq[9][1] * x[37]; a0 -= mq[9][2] * x[38]; a1 -= mq[9][3] * x[39]; mq[9] = *(const LAS f32x4*)(Mm + 3232);
            a0 -= mq[10][0] * x[40]; a1 -= mq[10][1] * x[41]; a0 -= mq[10][2] * x[42]; a1 -= mq[10][3] * x[43]; mq[10] = *(const LAS f32x4*)(Mm + 3236);
            a0 -= mq[11][0] * x[44]; a1 -= mq[11][1] * x[45]; a0 -= mq[11][2] * x[46]; a1 -= mq[11][3] * x[47]; mq[11] = *(const LAS f32x4*)(Mm + 3240);
            a0 -= mq[0][0] * x[48]; x[49] = a0 + a1; mq[0] = *(const LAS f32x4*)(Mm + 3244);
            a0 = x[50]; a1 = 0.f; a0 -= mq[1][0] * x[0]; a1 -= mq[1][1] * x[1]; a0 -= mq[1][2] * x[2]; a1 -= mq[1][3] * x[3]; mq[1] = *(const LAS f32x4*)(Mm + 3248);
            a0 -= mq[2][0] * x[4]; a1 -= mq[2][1] * x[5]; a0 -= mq[2][2] * x[6]; a1 -= mq[2][3] * x[7]; mq[2] = *(const LAS f32x4*)(Mm + 3264);
            a0 -= mq[3][0] * x[8]; a1 -= mq[3][1] * x[9]; a0 -= mq[3][2] * x[10]; a1 -= mq[3][3] * x[11]; mq[3] = *(const LAS f32x4*)(Mm + 3268);
            a0 -= mq[4][0] * x[12]; a1 -= mq[4][1] * x[13]; a0 -= mq[4][2] * x[14]; a1 -= mq[4][3] * x[15]; mq[4] = *(const LAS f32x4*)(Mm + 3272);
            a0 -= mq[5][0] * x[16]; a1 -= mq[5][1] * x[17]; a0 -= mq[5][2] * x[18]; a1 -= mq[5][3] * x[19]; mq[5] = *(const LAS f32x4*)(Mm + 3276);
            a0 -= mq[6][0] * x[20]; a1 -= mq[6][1] * x[21]; a0 -= mq[6][2] * x[22]; a1 -= mq[6][3] * x[23]; mq[6] = *(const LAS f32x4*)(Mm + 3280);
            a0 -= mq[7][0] * x[24]; a1 -= mq[7][1] * x[25]; a0 -= mq[7][2] * x[26]; a1 -= mq[7][3] * x[27]; mq[7] = *(const LAS f32x4*)(Mm + 3284);
            a0 -= mq[8][0] * x[28]; a1 -= mq[8][1] * x[29]; a0 -= mq[8][2] * x[30]; a1 -= mq[8][3] * x[31]; mq[8] = *(const LAS f32x4*)(Mm + 3288);
            a0 -= mq[9][0] * x[32]; a1 -= mq[9][1] * x[33]; a0 -= mq[9][2] * x[34]; a1 -= mq[9][3] * x[35]; mq[9] = *(const LAS f32x4*)(Mm + 3292);
            a0 -= mq[10][0] * x[36]; a1 -= mq[10][1] * x[37]; a0 -= mq[10][2] * x[38]; a1 -= mq[10][3] * x[39]; mq[10] = *(const LAS f32x4*)(Mm + 3296);
            a0 -= mq[11][0] * x[40]; a1 -= mq[11][1] * x[41]; a0 -= mq[11][2] * x[42]; a1 -= mq[11][3] * x[43]; mq[11] = *(const LAS f32x4*)(Mm + 3300);
            a0 -= mq[0][0] * x[44]; a1 -= mq[0][1] * x[45]; a0 -= mq[0][2] * x[46]; a1 -= mq[0][3] * x[47]; mq[0] = *(const LAS f32x4*)(Mm + 3304);
            a0 -= mq[1][0] * x[48]; a1 -= mq[1][1] * x[49]; x[50] = a0 + a1; mq[1] = *(const LAS f32x4*)(Mm + 3308);
            a0 = x[51]; a1 = 0.f; a0 -= mq[2][0] * x[0]; a1 -= mq[2][1] * x[1]; a0 -= mq[2][2] * x[2]; a1 -= mq[2][3] * x[3]; mq[2] = *(const LAS f32x4*)(Mm + 3312);
            a0 -= mq[3][0] * x[4]; a1 -= mq[3][1] * x[5]; a0 -= mq[3][2] * x[6]; a1 -= mq[3][3] * x[7]; mq[3] = *(const LAS f32x4*)(Mm + 3328);
            a0 -= mq[4][0] * x[8]; a1 -= mq[4][1] * x[9]; a0 -= mq[4][2] * x[10]; a1 -= mq[4][3] * x[11]; mq[4] = *(const LAS f32x4*)(Mm + 3332);
            a0 -= mq[5][0] * x[12]; a1 -= mq[5][1] * x[13]; a0 -= mq[5][2] * x[14]; a1 -= mq[5][3] * x[15]; mq[5] = *(const LAS f32x4*)(Mm + 3336);
            a0 -= mq[6][0] * x[16]; a1 -= mq[6][1] * x[17]; a0 -= mq[6][2] * x[18]; a1 -= mq[6][3] * x[19]; mq[6] = *(const LAS f32x4*)(Mm + 3340);
            a0 -= mq[7][0] * x[20]; a1 -= mq[7][1] * x[21]; a0 -= mq[7][2] * x[22]; a1 -= mq[7][3] * x[23]; mq[7] = *(const LAS f32x4*)(Mm + 3344);
            a0 -= mq[8][0] * x[24]; a1 -= mq[8][1] * x[25]; a0 -= mq[8][2] * x[26]; a1 -= mq[8][3] * x[27]; mq[8] = *(const LAS f32x4*)(Mm + 3348);
            a0 -= mq[9][0] * x[28]; a1 -= mq[9][1] * x[29]; a0 -= mq[9][2] * x[30]; a1 -= mq[9][3] * x[31]; mq[9] = *(const LAS f32x4*)(Mm + 3352);
            a0 -= mq[10][0] * x[32]; a1 -= mq[10][1] * x[33]; a0 -= mq[10][2] * x[34]; a1 -= mq[10][3] * x[35]; mq[10] = *(const LAS f32x4*)(Mm + 3356);
            a0 -= mq[11][0] * x[36]; a1 -= mq[11][1] * x[37]; a0 -= mq[11][2] * x[38]; a1 -= mq[11][3] * x[39]; mq[11] = *(const LAS f32x4*)(Mm + 3360);
            a0 -= mq[0][0] * x[40]; a1 -= mq[0][1] * x[41]; a0 -= mq[0][2] * x[42]; a1 -= mq[0][3] * x[43]; mq[0] = *(const LAS f32x4*)(Mm + 3364);
            a0 -= mq[1][0] * x[44]; a1 -= mq[1][1] * x[45]; a0 -= mq[1][2] * x[46]; a1 -= mq[1][3] * x[47]; mq[1] = *(const LAS f32x4*)(Mm + 3368);
            a0 -= mq[2][0] * x[48]; a1 -= mq[2][1] * x[49]; a0 -= mq[2][2] * x[50]; x[51] = a0 + a1; mq[2] = *(const LAS f32x4*)(Mm + 3372);
            a0 = x[52]; a1 = 0.f; a0 -= mq[3][0] * x[0]; a1 -= mq[3][1] * x[1]; a0 -= mq[3][2] * x[2]; a1 -= mq[3][3] * x[3]; mq[3] = *(const LAS f32x4*)(Mm + 3376);
            a0 -= mq[4][0] * x[4]; a1 -= mq[4][1] * x[5]; a0 -= mq[4][2] * x[6]; a1 -= mq[4][3] * x[7]; mq[4] = *(const LAS f32x4*)(Mm + 3392);
            a0 -= mq[5][0] * x[8]; a1 -= mq[5][1] * x[9]; a0 -= mq[5][2] * x[10]; a1 -= mq[5][3] * x[11]; mq[5] = *(const LAS f32x4*)(Mm + 3396);
            a0 -= mq[6][0] * x[12]; a1 -= mq[6][1] * x[13]; a0 -= mq[6][2] * x[14]; a1 -= mq[6][3] * x[15]; mq[6] = *(const LAS f32x4*)(Mm + 3400);
            a0 -= mq[7][0] * x[16]; a1 -= mq[7][1] * x[17]; a0 -= mq[7][2] * x[18]; a1 -= mq[7][3] * x[19]; mq[7] = *(const LAS f32x4*)(Mm + 3404);
            a0 -= mq[8][0] * x[20]; a1 -= mq[8][1] * x[21]; a0 -= mq[8][2] * x[22]; a1 -= mq[8][3] * x[23]; mq[8] = *(const LAS f32x4*)(Mm + 3408);
            a0 -= mq[9][0] * x[24]; a1 -= mq[9][1] * x[25]; a0 -= mq[9][2] * x[26]; a1 -= mq[9][3] * x[27]; mq[9] = *(const LAS f32x4*)(Mm + 3412);
            a0 -= mq[10][0] * x[28]; a1 -= mq[10][1] * x[29]; a0 -= mq[10][2] * x[30]; a1 -= mq[10][3] * x[31]; mq[10] = *(const LAS f32x4*)(Mm + 3416);
            a0 -= mq[11][0] * x[32]; a1 -= mq[11][1] * x[33]; a0 -= mq[11][2] * x[34]; a1 -= mq[11][3] * x[35]; mq[11] = *(const LAS f32x4*)(Mm + 3420);
            a0 -= mq[0][0] * x[36]; a1 -= mq[0][1] * x[37]; a0 -= mq[0][2] * x[38]; a1 -= mq[0][3] * x[39]; mq[0] = *(const LAS f32x4*)(Mm + 3424);
            a0 -= mq[1][0] * x[40]; a1 -= mq[1][1] * x[41]; a0 -= mq[1][2] * x[42]; a1 -= mq[1][3] * x[43]; mq[1] = *(const LAS f32x4*)(Mm + 3428);
            a0 -= mq[2][0] * x[44]; a1 -= mq[2][1] * x[45]; a0 -= mq[2][2] * x[46]; a1 -= mq[2][3] * x[47]; mq[2] = *(const LAS f32x4*)(Mm + 3432);
            a0 -= mq[3][0] * x[48]; a1 -= mq[3][1] * x[49]; a0 -= mq[3][2] * x[50]; a1 -= mq[3][3] * x[51]; x[52] = a0 + a1; mq[3] = *(const LAS f32x4*)(Mm + 3436);
            a0 = x[53]; a1 = 0.f; a0 -= mq[4][0] * x[0]; a1 -= mq[4][1] * x[1]; a0 -= mq[4][2] * x[2]; a1 -= mq[4][3] * x[3]; mq[4] = *(const LAS f32x4*)(Mm + 3440);
            a0 -= mq[5][0] * x[4]; a1 -= mq[5][1] * x[5]; a0 -= mq[5][2] * x[6]; a1 -= mq[5][3] * x[7]; mq[5] = *(const LAS f32x4*)(Mm + 3444);
            a0 -= mq[6][0] * x[8]; a1 -= mq[6][1] * x[9]; a0 -= mq[6][2] * x[10]; a1 -= mq[6][3] * x[11]; mq[6] = *(const LAS f32x4*)(Mm + 3456);
            a0 -= mq[7][0] * x[12]; a1 -= mq[7][1] * x[13]; a0 -= mq[7][2] * x[14]; a1 -= mq[7][3] * x[15]; mq[7] = *(const LAS f32x4*)(Mm + 3460);
            a0 -= mq[8][0] * x[16]; a1 -= mq[8][1] * x[17]; a0 -= mq[8][2] * x[18]; a1 -= mq[8][3] * x[19]; mq[8] = *(const LAS f32x4*)(Mm + 3464);
            a0 -= mq[9][0] * x[20]; a1 -= mq[9][1] * x[21]; a0 -= mq[9][2] * x[22]; a1 -= mq[9][3] * x[23]; mq[9] = *(const LAS f32x4*)(Mm + 3468);
            a0 -= mq[10][0] * x[24]; a1 -= mq[10][1] * x[25]; a0 -= mq[10][2] * x[26]; a1 -= mq[10][3] * x[27]; mq[10] = *(const LAS f32x4*)(Mm + 3472);
            a0 -= mq[11][0] * x[28]; a1 -= mq[11][1] * x[29]; a0 -= mq[11][2] * x[30]; a1 -= mq[11][3] * x[31]; mq[11] = *(const LAS f32x4*)(Mm + 3476);
            a0 -= mq[0][0] * x[32]; a1 -= mq[0][1] * x[33]; a0 -= mq[0][2] * x[34]; a1 -= mq[0][3] * x[35]; mq[0] = *(const LAS f32x4*)(Mm + 3480);
            a0 -= mq[1][0] * x[36]; a1 -= mq[1][1] * x[37]; a0 -= mq[1][2] * x[38]; a1 -= mq[1][3] * x[39]; mq[1] = *(const LAS f32x4*)(Mm + 3484);
            a0 -= mq[2][0] * x[40]; a1 -= mq[2][1] * x[41]; a0 -= mq[2][2] * x[42]; a1 -= mq[2][3] * x[43]; mq[2] = *(const LAS f32x4*)(Mm + 3488);
            a0 -= mq[3][0] * x[44]; a1 -= mq[3][1] * x[45]; a0 -= mq[3][2] * x[46]; a1 -= mq[3][3] * x[47]; mq[3] = *(const LAS f32x4*)(Mm + 3492);
            a0 -= mq[4][0] * x[48]; a1 -= mq[4][1] * x[49]; a0 -= mq[4][2] * x[50]; a1 -= mq[4][3] * x[51]; mq[4] = *(const LAS f32x4*)(Mm + 3496);
            a0 -= mq[5][0] * x[52]; x[53] = a0 + a1; mq[5] = *(const LAS f32x4*)(Mm + 3500);
            a0 = x[54]; a1 = 0.f; a0 -= mq[6][0] * x[0]; a1 -= mq[6][1] * x[1]; a0 -= mq[6][2] * x[2]; a1 -= mq[6][3] * x[3]; mq[6] = *(const LAS f32x4*)(Mm + 3504);
            a0 -= mq[7][0] * x[4]; a1 -= mq[7][1] * x[5]; a0 -= mq[7][2] * x[6]; a1 -= mq[7][3] * x[7]; mq[7] = *(const LAS f32x4*)(Mm + 3508);
            a0 -= mq[8][0] * x[8]; a1 -= mq[8][1] * x[9]; a0 -= mq[8][2] * x[10]; a1 -= mq[8][3] * x[11]; mq[8] = *(const LAS f32x4*)(Mm + 3520);
            a0 -= mq[9][0] * x[12]; a1 -= mq[9][1] * x[13]; a0 -= mq[9][2] * x[14]; a1 -= mq[9][3] * x[15]; mq[9] = *(const LAS f32x4*)(Mm + 3524);
            a0 -= mq[10][0] * x[16]; a1 -= mq[10][1] * x[17]; a0 -= mq[10][2] * x[18]; a1 -= mq[10][3] * x[19]; mq[10] = *(const LAS f32x4*)(Mm + 3528);
            a0 -= mq[11][0] * x[20]; a1 -= mq[11][1] * x[21]; a0 -= mq[11][2] * x[22]; a1 -= mq[11][3] * x[23]; mq[11] = *(const LAS f32x4*)(Mm + 3532);
            a0 -= mq[0][0] * x[24]; a1 -= mq[0][1] * x[25]; a0 -= mq[0][2] * x[26]; a1 -= mq[0][3] * x[27]; mq[0] = *(const LAS f32x4*)(Mm + 3536);
            a0 -= mq[1][0] * x[28]; a1 -= mq[1][1] * x[29]; a0 -= mq[1][2] * x[30]; a1 -= mq[1][3] * x[31]; mq[1] = *(const LAS f32x4*)(Mm + 3540);
            a0 -= mq[2][0] * x[32]; a1 -= mq[2][1] * x[33]; a0 -= mq[2][2] * x[34]; a1 -= mq[2][3] * x[35]; mq[2] = *(const LAS f32x4*)(Mm + 3544);
            a0 -= mq[3][0] * x[36]; a1 -= mq[3][1] * x[37]; a0 -= mq[3][2] * x[38]; a1 -= mq[3][3] * x[39]; mq[3] = *(const LAS f32x4*)(Mm + 3548);
            a0 -= mq[4][0] * x[40]; a1 -= mq[4][1] * x[41]; a0 -= mq[4][2] * x[42]; a1 -= mq[4][3] * x[43]; mq[4] = *(const LAS f32x4*)(Mm + 3552);
            a0 -= mq[5][0] * x[44]; a1 -= mq[5][1] * x[45]; a0 -= mq[5][2] * x[46]; a1 -= mq[5][3] * x[47]; mq[5] = *(const LAS f32x4*)(Mm + 3556);
            a0 -= mq[6][0] * x[48]; a1 -= mq[6][1] * x[49]; a0 -= mq[6][2] * x[50]; a1 -= mq[6][3] * x[51]; mq[6] = *(const LAS f32x4*)(Mm + 3560);
            a0 -= mq[7][0] * x[52]; a1 -= mq[7][1] * x[53]; x[54] = a0 + a1; mq[7] = *(const LAS f32x4*)(Mm + 3564);
            a0 = x[55]; a1 = 0.f; a0 -= mq[8][0] * x[0]; a1 -= mq[8][1] * x[1]; a0 -= mq[8][2] * x[2]; a1 -= mq[8][3] * x[3]; mq[8] = *(const LAS f32x4*)(Mm + 3568);
            a0 -= mq[9][0] * x[4]; a1 -= mq[9][1] * x[5]; a0 -= mq[9][2] * x[6]; a1 -= mq[9][3] * x[7]; mq[9] = *(const LAS f32x4*)(Mm + 3572);
            a0 -= mq[10][0] * x[8]; a1 -= mq[10][1] * x[9]; a0 -= mq[10][2] * x[10]; a1 -= mq[10][3] * x[11]; mq[10] = *(const LAS f32x4*)(Mm + 3584);
            a0 -= mq[11][0] * x[12]; a1 -= mq[11][1] * x[13]; a0 -= mq[11][2] * x[14]; a1 -= mq[11][3] * x[15]; mq[11] = *(const LAS f32x4*)(Mm + 3588);
            a0 -= mq[0][0] * x[16]; a1 -= mq[0][1] * x[17]; a0 -= mq[0][2] * x[18]; a1 -= mq[0][3] * x[19]; mq[0] = *(const LAS f32x4*)(Mm + 3592);
            a0 -= mq[1][0] * x[20]; a1 -= mq[1][1] * x[21]; a0 -= mq[1][2] * x[22]; a1 -= mq[1][3] * x[23]; mq[1] = *(const LAS f32x4*)(Mm + 3596);
            a0 -= mq[2][0] * x[24]; a1 -= mq[2][1] * x[25]; a0 -= mq[2][2] * x[26]; a1 -= mq[2][3] * x[27]; mq[2] = *(const LAS f32x4*)(Mm + 3600);
            a0 -= mq[3][0] * x[28]; a1 -= mq[3][1] * x[29]; a0 -= mq[3][2] * x[30]; a1 -= mq[3][3] * x[31]; mq[3] = *(const LAS f32x4*)(Mm + 3604);
            a0 -= mq[4][0] * x[32]; a1 -= mq[4][1] * x[33]; a0 -= mq[4][2] * x[34]; a1 -= mq[4][3] * x[35]; mq[4] = *(const LAS f32x4*)(Mm + 3608);
            a0 -= mq[5][0] * x[36]; a1 -= mq[5][1] * x[37]; a0 -= mq[5][2] * x[38]; a1 -= mq[5][3] * x[39]; mq[5] = *(const LAS f32x4*)(Mm + 3612);
            a0 -= mq[6][0] * x[40]; a1 -= mq[6][1] * x[41]; a0 -= mq[6][2] * x[42]; a1 -= mq[6][3] * x[43]; mq[6] = *(const LAS f32x4*)(Mm + 3616);
            a0 -= mq[7][0] * x[44]; a1 -= mq[7][1] * x[45]; a0 -= mq[7][2] * x[46]; a1 -= mq[7][3] * x[47]; mq[7] = *(const LAS f32x4*)(Mm + 3620);
            a0 -= mq[8][0] * x[48]; a1 -= mq[8][1] * x[49]; a0 -= mq[8][2] * x[50]; a1 -= mq[8][3] * x[51]; mq[8] = *(const LAS f32x4*)(Mm + 3624);
            a0 -= mq[9][0] * x[52]; a1 -= mq[9][1] * x[53]; a0 -= mq[9][2] * x[54]; x[55] = a0 + a1; mq[9] = *(const LAS f32x4*)(Mm + 3628);
            a0 = x[56]; a1 = 0.f; a0 -= mq[10][0] * x[0]; a1 -= mq[10][1] * x[1]; a0 -= mq[10][2] * x[2]; a1 -= mq[10][3] * x[3]; mq[10] = *(const LAS f32x4*)(Mm + 3632);
            a0 -= mq[11][0] * x[4]; a1 -= mq[11][1] * x[5]; a0 -= mq[11][2] * x[6]; a1 -= mq[11][3] * x[7]; mq[11] = *(const LAS f32x4*)(Mm + 3636);
            a0 -= mq[0][0] * x[8]; a1 -= mq[0][1] * x[9]; a0 -= mq[0][2] * x[10]; a1 -= mq[0][3] * x[11]; mq[0] = *(const LAS f32x4*)(Mm + 3648);
            a0 -= mq[1][0] * x[12]; a1 -= mq[1][1] * x[13]; a0 -= mq[1][2] * x[14]; a1 -= mq[1][3] * x[15]; mq[1] = *(const LAS f32x4*)(Mm + 3652);
            a0 -= mq[2][0] * x[16]; a1 -= mq[2][1] * x[17]; a0 -= mq[2][2] * x[18]; a1 -= mq[2][3] * x[19]; mq[2] = *(const LAS f32x4*)(Mm + 3656);
            a0 -= mq[3][0] * x[20]; a1 -= mq[3][1] * x[21]; a0 -= mq[3][2] * x[22]; a1 -= mq[3][3] * x[23]; mq[3] = *(const LAS f32x4*)(Mm + 3660);
            a0 -= mq[4][0] * x[24]; a1 -= mq[4][1] * x[25]; a0 -= mq[4][2] * x[26]; a1 -= mq[4][3] * x[27]; mq[4] = *(const LAS f32x4*)(Mm + 3664);
            a0 -= mq[5][0] * x[28]; a1 -= mq[5][1] * x[29]; a0 -= mq[5][2] * x[30]; a1 -= mq[5][3] * x[31]; mq[5] = *(const LAS f32x4*)(Mm + 3668);
            a0 -= mq[6][0] * x[32]; a1 -= mq[6][1] * x[33]; a0 -= mq[6][2] * x[34]; a1 -= mq[6][3] * x[35]; mq[6] = *(const LAS f32x4*)(Mm + 3672);
            a0 -= mq[7][0] * x[36]; a1 -= mq[7][1] * x[37]; a0 -= mq[7][2] * x[38]; a1 -= mq[7][3] * x[39]; mq[7] = *(const LAS f32x4*)(Mm + 3676);
            a0 -= mq[8][0] * x[40]; a1 -= mq[8][1] * x[41]; a0 -= mq[8][2] * x[42]; a1 -= mq[8][3] * x[43]; mq[8] = *(const LAS f32x4*)(Mm + 3680);
            a0 -= mq[9][0] * x[44]; a1 -= mq[9][1] * x[45]; a0 -= mq[9][2] * x[46]; a1 -= mq[9][3] * x[47]; mq[9] = *(const LAS f32x4*)(Mm + 3684);
            a0 -= mq[10][0] * x[48]; a1 -= mq[10][1] * x[49]; a0 -= mq[10][2] * x[50]; a1 -= mq[10][3] * x[51]; mq[10] = *(const LAS f32x4*)(Mm + 3688);
            a0 -= mq[11][0] * x[52]; a1 -= mq[11][1] * x[53]; a0 -= mq[11][2] * x[54]; a1 -= mq[11][3] * x[55]; x[56] = a0 + a1; mq[11] = *(const LAS f32x4*)(Mm + 3692);
            a0 = x[57]; a1 = 0.f; a0 -= mq[0][0] * x[0]; a1 -= mq[0][1] * x[1]; a0 -= mq[0][2] * x[2]; a1 -= mq[0][3] * x[3]; mq[0] = *(const LAS f32x4*)(Mm + 3696);
            a0 -= mq[1][0] * x[4]; a1 -= mq[1][1] * x[5]; a0 -= mq[1][2] * x[6]; a1 -= mq[1][3] * x[7]; mq[1] = *(const LAS f32x4*)(Mm + 3700);
            a0 -= mq[2][0] * x[8]; a1 -= mq[2][1] * x[9]; a0 -= mq[2][2] * x[10]; a1 -= mq[2][3] * x[11]; mq[2] = *(const LAS f32x4*)(Mm + 3704);
            a0 -= mq[3][0] * x[12]; a1 -= mq[3][1] * x[13]; a0 -= mq[3][2] * x[14]; a1 -= mq[3][3] * x[15]; mq[3] = *(const LAS f32x4*)(Mm + 3712);
            a0 -= mq[4][0] * x[16]; a1 -= mq[4][1] * x[17]; a0 -= mq[4][2] * x[18]; a1 -= mq[4][3] * x[19]; mq[4] = *(const LAS f32x4*)(Mm + 3716);
            a0 -= mq[5][0] * x[20]; a1 -= mq[5][1] * x[21]; a0 -= mq[5][2] * x[22]; a1 -= mq[5][3] * x[23]; mq[5] = *(const LAS f32x4*)(Mm + 3720);
            a0 -= mq[6][0] * x[24]; a1 -= mq[6][1] * x[25]; a0 -= mq[6][2] * x[26]; a1 -= mq[6][3] * x[27]; mq[6] = *(const LAS f32x4*)(Mm + 3724);
            a0 -= mq[7][0] * x[28]; a1 -= mq[7][1] * x[29]; a0 -= mq[7][2] * x[30]; a1 -= mq[7][3] * x[31]; mq[7] = *(const LAS f32x4*)(Mm + 3728);
            a0 -= mq[8][0] * x[32]; a1 -= mq[8][1] * x[33]; a0 -= mq[8][2] * x[34]; a1 -= mq[8][3] * x[35]; mq[8] = *(const LAS f32x4*)(Mm + 3732);
            a0 -= mq[9][0] * x[36]; a1 -= mq[9][1] * x[37]; a0 -= mq[9][2] * x[38]; a1 -= mq[9][3] * x[39]; mq[9] = *(const LAS f32x4*)(Mm + 3736);
            a0 -= mq[10][0] * x[40]; a1 -= mq[10][1] * x[41]; a0 -= mq[10][2] * x[42]; a1 -= mq[10][3] * x[43]; mq[10] = *(const LAS f32x4*)(Mm + 3740);
            a0 -= mq[11][0] * x[44]; a1 -= mq[11][1] * x[45]; a0 -= mq[11][2] * x[46]; a1 -= mq[11][3] * x[47]; mq[11] = *(const LAS f32x4*)(Mm + 3744);
            a0 -= mq[0][0] * x[48]; a1 -= mq[0][1] * x[49]; a0 -= mq[0][2] * x[50]; a1 -= mq[0][3] * x[51]; mq[0] = *(const LAS f32x4*)(Mm + 3748);
            a0 -= mq[1][0] * x[52]; a1 -= mq[1][1] * x[53]; a0 -= mq[1][2] * x[54]; a1 -= mq[1][3] * x[55]; mq[1] = *(const LAS f32x4*)(Mm + 3752);
            a0 -= mq[2][0] * x[56]; x[57] = a0 + a1; mq[2] = *(const LAS f32x4*)(Mm + 3756);
            a0 = x[58]; a1 = 0.f; a0 -= mq[3][0] * x[0]; a1 -= mq[3][1] * x[1]; a0 -= mq[3][2] * x[2]; a1 -= mq[3][3] * x[3]; mq[3] = *(const LAS f32x4*)(Mm + 3760);
            a0 -= mq[4][0] * x[4]; a1 -= mq[4][1] * x[5]; a0 -= mq[4][2] * x[6]; a1 -= mq[4][3] * x[7]; mq[4] = *(const LAS f32x4*)(Mm + 3764);
            a0 -= mq[5][0] * x[8]; a1 -= mq[5][1] * x[9]; a0 -= mq[5][2] * x[10]; a1 -= mq[5][3] * x[11]; mq[5] = *(const LAS f32x4*)(Mm + 3768);
            a0 -= mq[6][0] * x[12]; a1 -= mq[6][1] * x[13]; a0 -= mq[6][2] * x[14]; a1 -= mq[6][3] * x[15]; mq[6] = *(const LAS f32x4*)(Mm + 3776);
            a0 -= mq[7][0] * x[16]; a1 -= mq[7][1] * x[17]; a0 -= mq[7][2] * x[18]; a1 -= mq[7][3] * x[19]; mq[7] = *(const LAS f32x4*)(Mm + 3780);
            a0 -= mq[8][0] * x[20]; a1 -= mq[8][1] * x[21]; a0 -= mq[8][2] * x[22]; a1 -= mq[8][3] * x[23]; mq[8] = *(const LAS f32x4*)(Mm + 3784);
            a0 -= mq[9][0] * x[24]; a1 -= mq[9][1] * x[25]; a0 -= mq[9][2] * x[26]; a1 -= mq[9][3] * x[27]; mq[9] = *(const LAS f32x4*)(Mm + 3788);
            a0 -= mq[10][0] * x[28]; a1 -= mq[10][1] * x[29]; a0 -= mq[10][2] * x[30]; a1 -= mq[10][3] * x[31]; mq[10] = *(const LAS f32x4*)(Mm + 3792);
            a0 -= mq[11][0] * x[32]; a1 -= mq[11][1] * x[33]; a0 -= mq[11][2] * x[34]; a1 -= mq[11][3] * x[35]; mq[11] = *(const LAS f32x4*)(Mm + 3796);
            a0 -= mq[0][0] * x[36]; a1 -= mq[0][1] * x[37]; a0 -= mq[0][2] * x[38]; a1 -= mq[0][3] * x[39]; mq[0] = *(const LAS f32x4*)(Mm + 3800);
            a0 -= mq[1][0] * x[40]; a1 -= mq[1][1] * x[41]; a0 -= mq[1][2] * x[42]; a1 -= mq[1][3] * x[43]; mq[1] = *(const LAS f32x4*)(Mm + 3804);
            a0 -= mq[2][0] * x[44]; a1 -= mq[2][1] * x[45]; a0 -= mq[2][2] * x[46]; a1 -= mq[2][3] * x[47]; mq[2] = *(const LAS f32x4*)(Mm + 3808);
            a0 -= mq[3][0] * x[48]; a1 -= mq[3][1] * x[49]; a0 -= mq[3][2] * x[50]; a1 -= mq[3][3] * x[51]; mq[3] = *(const LAS f32x4*)(Mm + 3812);
            a0 -= mq[4][0] * x[52]; a1 -= mq[4][1] * x[53]; a0 -= mq[4][2] * x[54]; a1 -= mq[4][3] * x[55]; mq[4] = *(const LAS f32x4*)(Mm + 3816);
            a0 -= mq[5][0] * x[56]; a1 -= mq[5][1] * x[57]; x[58] = a0 + a1; mq[5] = *(const LAS f32x4*)(Mm + 3820);
            a0 = x[59]; a1 = 0.f; a0 -= mq[6][0] * x[0]; a1 -= mq[6][1] * x[1]; a0 -= mq[6][2] * x[2]; a1 -= mq[6][3] * x[3]; mq[6] = *(const LAS f32x4*)(Mm + 3824);
            a0 -= mq[7][0] * x[4]; a1 -= mq[7][1] * x[5]; a0 -= mq[7][2] * x[6]; a1 -= mq[7][3] * x[7]; mq[7] = *(const LAS f32x4*)(Mm + 3828);
            a0 -= mq[8][0] * x[8]; a1 -= mq[8][1] * x[9]; a0 -= mq[8][2] * x[10]; a1 -= mq[8][3] * x[11]; mq[8] = *(const LAS f32x4*)(Mm + 3832);
            a0 -= mq[9][0] * x[12]; a1 -= mq[9][1] * x[13]; a0 -= mq[9][2] * x[14]; a1 -= mq[9][3] * x[15]; mq[9] = *(const LAS f32x4*)(Mm + 3840);
            a0 -= mq[10][0] * x[16]; a1 -= mq[10][1] * x[17]; a0 -= mq[10][2] * x[18]; a1 -= mq[10][3] * x[19]; mq[10] = *(const LAS f32x4*)(Mm + 3844);
            a0 -= mq[11][0] * x[20]; a1 -= mq[11][1] * x[21]; a0 -= mq[11][2] * x[22]; a1 -= mq[11][3] * x[23]; mq[11] = *(const LAS f32x4*)(Mm + 3848);
            a0 -= mq[0][0] * x[24]; a1 -= mq[0][1] * x[25]; a0 -= mq[0][2] * x[26]; a1 -= mq[0][3] * x[27]; mq[0] = *(const LAS f32x4*)(Mm + 3852);
            a0 -= mq[1][0] * x[28]; a1 -= mq[1][1] * x[29]; a0 -= mq[1][2] * x[30]; a1 -= mq[1][3] * x[31]; mq[1] = *(const LAS f32x4*)(Mm + 3856);
            a0 -= mq[2][0] * x[32]; a1 -= mq[2][1] * x[33]; a0 -= mq[2][2] * x[34]; a1 -= mq[2][3] * x[35]; mq[2] = *(const LAS f32x4*)(Mm + 3860);
            a0 -= mq[3][0] * x[36]; a1 -= mq[3][1] * x[37]; a0 -= mq[3][2] * x[38]; a1 -= mq[3][3] * x[39]; mq[3] = *(const LAS f32x4*)(Mm + 3864);
            a0 -= mq[4][0] * x[40]; a1 -= mq[4][1] * x[41]; a0 -= mq[4][2] * x[42]; a1 -= mq[4][3] * x[43]; mq[4] = *(const LAS f32x4*)(Mm + 3868);
            a0 -= mq[5][0] * x[44]; a1 -= mq[5][1] * x[45]; a0 -= mq[5][2] * x[46]; a1 -= mq[5][3] * x[47]; mq[5] = *(const LAS f32x4*)(Mm + 3872);
            a0 -= mq[6][0] * x[48]; a1 -= mq[6][1] * x[49]; a0 -= mq[6][2] * x[50]; a1 -= mq[6][3] * x[51]; mq[6] = *(const LAS f32x4*)(Mm + 3876);
            a0 -= mq[7][0] * x[52]; a1 -= mq[7][1] * x[53]; a0 -= mq[7][2] * x[54]; a1 -= mq[7][3] * x[55]; mq[7] = *(const LAS f32x4*)(Mm + 3880);
            a0 -= mq[8][0] * x[56]; a1 -= mq[8][1] * x[57]; a0 -= mq[8][2] * x[58]; x[59] = a0 + a1; mq[8] = *(const LAS f32x4*)(Mm + 3884);
            a0 = x[60]; a1 = 0.f; a0 -= mq[9][0] * x[0]; a1 -= mq[9][1] * x[1]; a0 -= mq[9][2] * x[2]; a1 -= mq[9][3] * x[3]; mq[9] = *(const LAS f32x4*)(Mm + 3888);
            a0 -= mq[10][0] * x[4]; a1 -= mq[10][1] * x[5]; a0 -= mq[10][2] * x[6]; a1 -= mq[10][3] * x[7]; mq[10] = *(const LAS f32x4*)(Mm + 3892);
            a0 -= mq[11][0] * x[8]; a1 -= mq[11][1] * x[9]; a0 -= mq[11][2] * x[10]; a1 -= mq[11][3] * x[11]; mq[11] = *(const LAS f32x4*)(Mm + 3896);
            a0 -= mq[0][0] * x[12]; a1 -= mq[0][1] * x[13]; a0 -= mq[0][2] * x[14]; a1 -= mq[0][3] * x[15]; mq[0] = *(const LAS f32x4*)(Mm + 3904);
            a0 -= mq[1][0] * x[16]; a1 -= mq[1][1] * x[17]; a0 -= mq[1][2] * x[18]; a1 -= mq[1][3] * x[19]; mq[1] = *(const LAS f32x4*)(Mm + 3908);
            a0 -= mq[2][0] * x[20]; a1 -= mq[2][1] * x[21]; a0 -= mq[2][2] * x[22]; a1 -= mq[2][3] * x[23]; mq[2] = *(const LAS f32x4*)(Mm + 3912);
            a0 -= mq[3][0] * x[24]; a1 -= mq[3][1] * x[25]; a0 -= mq[3][2] * x[26]; a1 -= mq[3][3] * x[27]; mq[3] = *(const LAS f32x4*)(Mm + 3916);
            a0 -= mq[4][0] * x[28]; a1 -= mq[4][1] * x[29]; a0 -= mq[4][2] * x[30]; a1 -= mq[4][3] * x[31]; mq[4] = *(const LAS f32x4*)(Mm + 3920);
            a0 -= mq[5][0] * x[32]; a1 -= mq[5][1] * x[33]; a0 -= mq[5][2] * x[34]; a1 -= mq[5][3] * x[35]; mq[5] = *(const LAS f32x4*)(Mm + 3924);
            a0 -= mq[6][0] * x[36]; a1 -= mq[6][1] * x[37]; a0 -= mq[6][2] * x[38]; a1 -= mq[6][3] * x[39]; mq[6] = *(const LAS f32x4*)(Mm + 3928);
            a0 -= mq[7][0] * x[40]; a1 -= mq[7][1] * x[41]; a0 -= mq[7][2] * x[42]; a1 -= mq[7][3] * x[43]; mq[7] = *(const LAS f32x4*)(Mm + 3932);
            a0 -= mq[8][0] * x[44]; a1 -= mq[8][1] * x[45]; a0 -= mq[8][2] * x[46]; a1 -= mq[8][3] * x[47]; mq[8] = *(const LAS f32x4*)(Mm + 3936);
            a0 -= mq[9][0] * x[48]; a1 -= mq[9][1] * x[49]; a0 -= mq[9][2] * x[50]; a1 -= mq[9][3] * x[51]; mq[9] = *(const LAS f32x4*)(Mm + 3940);
            a0 -= mq[10][0] * x[52]; a1 -= mq[10][1] * x[53]; a0 -= mq[10][2] * x[54]; a1 -= mq[10][3] * x[55]; mq[10] = *(const LAS f32x4*)(Mm + 3944);
            a0 -= mq[11][0] * x[56]; a1 -= mq[11][1] * x[57]; a0 -= mq[11][2] * x[58]; a1 -= mq[11][3] * x[59]; x[60] = a0 + a1; mq[11] = *(const LAS f32x4*)(Mm + 3948);
            a0 = x[61]; a1 = 0.f; a0 -= mq[0][0] * x[0]; a1 -= mq[0][1] * x[1]; a0 -= mq[0][2] * x[2]; a1 -= mq[0][3] * x[3]; mq[0] = *(const LAS f32x4*)(Mm + 3952);
            a0 -= mq[1][0] * x[4]; a1 -= mq[1][1] * x[5]; a0 -= mq[1][2] * x[6]; a1 -= mq[1][3] * x[7]; mq[1] = *(const LAS f32x4*)(Mm + 3956);
            a0 -= mq[2][0] * x[8]; a1 -= mq[2][1] * x[9]; a0 -= mq[2][2] * x[10]; a1 -= mq[2][3] * x[11]; mq[2] = *(const LAS f32x4*)(Mm + 3960);
            a0 -= mq[3][0] * x[12]; a1 -= mq[3][1] * x[13]; a0 -= mq[3][2] * x[14]; a1 -= mq[3][3] * x[15]; mq[3] = *(const LAS f32x4*)(Mm + 3964);
            a0 -= mq[4][0] * x[16]; a1 -= mq[4][1] * x[17]; a0 -= mq[4][2] * x[18]; a1 -= mq[4][3] * x[19]; mq[4] = *(const LAS f32x4*)(Mm + 3968);
            a0 -= mq[5][0] * x[20]; a1 -= mq[5][1] * x[21]; a0 -= mq[5][2] * x[22]; a1 -= mq[5][3] * x[23]; mq[5] = *(const LAS f32x4*)(Mm + 3972);
            a0 -= mq[6][0] * x[24]; a1 -= mq[6][1] * x[25]; a0 -= mq[6][2] * x[26]; a1 -= mq[6][3] * x[27]; mq[6] = *(const LAS f32x4*)(Mm + 3976);
            a0 -= mq[7][0] * x[28]; a1 -= mq[7][1] * x[29]; a0 -= mq[7][2] * x[30]; a1 -= mq[7][3] * x[31]; mq[7] = *(const LAS f32x4*)(Mm + 3980);
            a0 -= mq[8][0] * x[32]; a1 -= mq[8][1] * x[33]; a0 -= mq[8][2] * x[34]; a1 -= mq[8][3] * x[35]; mq[8] = *(const LAS f32x4*)(Mm + 3984);
            a0 -= mq[9][0] * x[36]; a1 -= mq[9][1] * x[37]; a0 -= mq[9][2] * x[38]; a1 -= mq[9][3] * x[39]; mq[9] = *(const LAS f32x4*)(Mm + 3988);
            a0 -= mq[10][0] * x[40]; a1 -= mq[10][1] * x[41]; a0 -= mq[10][2] * x[42]; a1 -= mq[10][3] * x[43]; mq[10] = *(const LAS f32x4*)(Mm + 3992);
            a0 -= mq[11][0] * x[44]; a1 -= mq[11][1] * x[45]; a0 -= mq[11][2] * x[46]; a1 -= mq[11][3] * x[47]; mq[11] = *(const LAS f32x4*)(Mm + 3996);
            a0 -= mq[0][0] * x[48]; a1 -= mq[0][1] * x[49]; a0 -= mq[0][2] * x[50]; a1 -= mq[0][3] * x[51]; mq[0] = *(const LAS f32x4*)(Mm + 4000);
            a0 -= mq[1][0] * x[52]; a1 -= mq[1][1] * x[53]; a0 -= mq[1][2] * x[54]; a1 -= mq[1][3] * x[55]; mq[1] = *(const LAS f32x4*)(Mm + 4004);
            a0 -= mq[2][0] * x[56]; a1 -= mq[2][1] * x[57]; a0 -= mq[2][2] * x[58]; a1 -= mq[2][3] * x[59]; mq[2] = *(const LAS f32x4*)(Mm + 4008);
            a0 -= mq[3][0] * x[60]; x[61] = a0 + a1; mq[3] = *(const LAS f32x4*)(Mm + 4012);
            a0 = x[62]; a1 = 0.f; a0 -= mq[4][0] * x[0]; a1 -= mq[4][1] * x[1]; a0 -= mq[4][2] * x[2]; a1 -= mq[4][3] * x[3]; mq[4] = *(const LAS f32x4*)(Mm + 4016);
            a0 -= mq[5][0] * x[4]; a1 -= mq[5][1] * x[5]; a0 -= mq[5][2] * x[6]; a1 -= mq[5][3] * x[7]; mq[5] = *(const LAS f32x4*)(Mm + 4020);
            a0 -= mq[6][0] * x[8]; a1 -= mq[6][1] * x[9]; a0 -= mq[6][2] * x[10]; a1 -= mq[6][3] * x[11]; mq[6] = *(const LAS f32x4*)(Mm + 4024);
            a0 -= mq[7][0] * x[12]; a1 -= mq[7][1] * x[13]; a0 -= mq[7][2] * x[14]; a1 -= mq[7][3] * x[15]; mq[7] = *(const LAS f32x4*)(Mm + 4028);
            a0 -= mq[8][0] * x[16]; a1 -= mq[8][1] * x[17]; a0 -= mq[8][2] * x[18]; a1 -= mq[8][3] * x[19]; mq[8] = *(const LAS f32x4*)(Mm + 4032);
            a0 -= mq[9][0] * x[20]; a1 -= mq[9][1] * x[21]; a0 -= mq[9][2] * x[22]; a1 -= mq[9][3] * x[23]; mq[9] = *(const LAS f32x4*)(Mm + 4036);
            a0 -= mq[10][0] * x[24]; a1 -= mq[10][1] * x[25]; a0 -= mq[10][2] * x[26]; a1 -= mq[10][3] * x[27]; mq[10] = *(const LAS f32x4*)(Mm + 4040);
            a0 -= mq[11][0] * x[28]; a1 -= mq[11][1] * x[29]; a0 -= mq[11][2] * x[30]; a1 -= mq[11][3] * x[31]; mq[11] = *(const LAS f32x4*)(Mm + 4044);
            a0 -= mq[0][0] * x[32]; a1 -= mq[0][1] * x[33]; a0 -= mq[0][2] * x[34]; a1 -= mq[0][3] * x[35]; mq[0] = *(const LAS f32x4*)(Mm + 4048);
            a0 -= mq[1][0] * x[36]; a1 -= mq[1][1] * x[37]; a0 -= mq[1][2] * x[38]; a1 -= mq[1][3] * x[39]; mq[1] = *(const LAS f32x4*)(Mm + 4052);
            a0 -= mq[2][0] * x[40]; a1 -= mq[2][1] * x[41]; a0 -= mq[2][2] * x[42]; a1 -= mq[2][3] * x[43]; mq[2] = *(const LAS f32x4*)(Mm + 4056);
            a0 -= mq[3][0] * x[44]; a1 -= mq[3][1] * x[45]; a0 -= mq[3][2] * x[46]; a1 -= mq[3][3] * x[47]; mq[3] = *(const LAS f32x4*)(Mm + 4060);
            a0 -= mq[4][0] * x[48]; a1 -= mq[4][1] * x[49]; a0 -= mq[4][2] * x[50]; a1 -= mq[4][3] * x[51]; mq[4] = *(const LAS f32x4*)(Mm + 4064);
            a0 -= mq[5][0] * x[52]; a1 -= mq[5][1] * x[53]; a0 -= mq[5][2] * x[54]; a1 -= mq[5][3] * x[55]; mq[5] = *(const LAS f32x4*)(Mm + 4068);
            a0 -= mq[6][0] * x[56]; a1 -= mq[6][1] * x[57]; a0 -= mq[6][2] * x[58]; a1 -= mq[6][3] * x[59]; mq[6] = *(const LAS f32x4*)(Mm + 4072);
            a0 -= mq[7][0] * x[60]; a1 -= mq[7][1] * x[61]; x[62] = a0 + a1; mq[7] = *(const LAS f32x4*)(Mm + 4076);
            a0 = x[63]; a1 = 0.f; a0 -= mq[8][0] * x[0]; a1 -= mq[8][1] * x[1]; a0 -= mq[8][2] * x[2]; a1 -= mq[8][3] * x[3]; mq[8] = *(const LAS f32x4*)(Mm + 4080);
            a0 -= mq[9][0] * x[4]; a1 -= mq[9][1] * x[5]; a0 -= mq[9][2] * x[6]; a1 -= mq[9][3] * x[7]; mq[9] = *(const LAS f32x4*)(Mm + 4084);
            a0 -= mq[10][0] * x[8]; a1 -= mq[10][1] * x[9]; a0 -= mq[10][2] * x[10]; a1 -= mq[10][3] * x[11]; mq[10] = *(const LAS f32x4*)(Mm + 4088);
            a0 -= mq[11][0] * x[12]; a1 -= mq[11][1] * x[13]; a0 -= mq[11][2] * x[14]; a1 -= mq[11][3] * x[15]; mq[11] = *(const LAS f32x4*)(Mm + 4092);
            a0 -= mq[0][0] * x[16]; a1 -= mq[0][1] * x[17]; a0 -= mq[0][2] * x[18]; a1 -= mq[0][3] * x[19];
            a0 -= mq[1][0] * x[20]; a1 -= mq[1][1] * x[21]; a0 -= mq[1][2] * x[22]; a1 -= mq[1][3] * x[23];
            a0 -= mq[2][0] * x[24]; a1 -= mq[2][1] * x[25]; a0 -= mq[2][2] * x[26]; a1 -= mq[2][3] * x[27];
            a0 -= mq[3][0] * x[28]; a1 -= mq[3][1] * x[29]; a0 -= mq[3][2] * x[30]; a1 -= mq[3][3] * x[31];
            a0 -= mq[4][0] * x[32]; a1 -= mq[4][1] * x[33]; a0 -= mq[4][2] * x[34]; a1 -= mq[4][3] * x[35];
            a0 -= mq[5][0] * x[36]; a1 -= mq[5][1] * x[37]; a0 -= mq[5][2] * x[38]; a1 -= mq[5][3] * x[39];
            a0 -= mq[6][0] * x[40]; a1 -= mq[6][1] * x[41]; a0 -= mq[6][2] * x[42]; a1 -= mq[6][3] * x[43];
            a0 -= mq[7][0] * x[44]; a1 -= mq[7][1] * x[45]; a0 -= mq[7][2] * x[46]; a1 -= mq[7][3] * x[47];
            a0 -= mq[8][0] * x[48]; a1 -= mq[8][1] * x[49]; a0 -= mq[8][2] * x[50]; a1 -= mq[8][3] * x[51];
            a0 -= mq[9][0] * x[52]; a1 -= mq[9][1] * x[53]; a0 -= mq[9][2] * x[54]; a1 -= mq[9][3] * x[55];
            a0 -= mq[10][0] * x[56]; a1 -= mq[10][1] * x[57]; a0 -= mq[10][2] * x[58]; a1 -= mq[10][3] * x[59];
            a0 -= mq[11][0] * x[60]; a1 -= mq[11][1] * x[61]; a0 -= mq[11][2] * x[62]; x[63] = a0 + a1;
            if (c < 128) {
#pragma unroll
                for (int r = 0; r < 64; ++r) ub[(size_t)item * 8192 + r * 128 + c] = x[r];
            } else {
#pragma unroll
                for (int r = 0; r < 64; ++r) wdc[(size_t)item * 8192 + r * 128 + (c - 128)] = f2bf(-x[r]);
            }
        } else {
            const int tt = tid - 256;
#pragma unroll
            for (int i = 0; i < 4; ++i) { const int vid = tt + 256 * i, r = vid >> 4, d0 = (vid & 15) * 8; float f[8]; unpack8(*(const LAS u32x4*)(lds + P5_QS + r * 272 + d0 * 2), f);
                const float e = scale * __expf(dec[r]);
#pragma unroll
                for (int q = 0; q < 8; ++q) f[q] *= e;
                *(u32x4*)(qd + (size_t)item * 8192 + r * 128 + d0) = pack8(f); }
#pragma unroll
            for (int i = 0; i < 4; ++i) { const int vid = tt + 256 * i, d = vid >> 3, rg = (vid & 7) * 8; float f[8];
#pragma unroll
                for (int q = 0; q < 8; ++q) f[q] = bf2f(*(const LAS bf16_t*)(lds + P5_KS + (rg + q) * 272 + d * 2)) * __expf(last - dec[rg + q]);
                *(u32x4*)(kt + (size_t)item * 8192 + d * 64 + rg) = pack8(f); }
            if (tt == 0) cdv[item] = __expf(last);
        }
    }
    __syncthreads();
}

constexpr int SB_WD = 0, SB_QD = 17408, SB_KT = 34816, SB_QK = 53248, SB_UB = 62464, SB_SIZE = 66560;
constexpr int SC_ST = 2 * SB_SIZE, SC_UT = SC_ST + 4352, SC_END = SC_UT + 2304;
static_assert(SC_END <= LDS_BYTES, "lds");
__device__ __forceinline__ void scan_phase(const Params& p, int bid, int nblk, LAS unsigned char* lds) {
    const int tid = threadIdx.x, lane = tid & 63, wid = tid >> 6, fr = lane & 15, fq = lane >> 4;
    const bf16_t* wdc = (const bf16_t*)(p.ws + WS_WDC); const bf16_t* qd = (const bf16_t*)(p.ws + WS_QD); const bf16_t* kt = (const bf16_t*)(p.ws + WS_KT); const bf16_t* qk = (const bf16_t*)(p.ws + WS_QK);
    const float* cdv = (const float*)(p.ws + WS_CD); const float* ub = p.out + OS_UB; float* obuf = p.out + OS_O;
    for (int item = bid; item < 256; item += nblk) {
        const int xcd = item & 7, iq = item >> 3, bh = xcd * 4 + (iq >> 3), sl = iq & 7, h = bh & 7, b = bh >> 3;
        u32x4 r_wd[2], r_qd[2], r_kt[2], r_qk, r_ub;
        auto gload = [&](int n) {
            const size_t it = (size_t)(bh * 32 + n);
#pragma unroll
            for (int i = 0; i < 2; ++i) { const int ch = tid + 512 * i; r_wd[i] = *(const u32x4*)(wdc + it * 8192 + ch * 8); r_qd[i] = *(const u32x4*)(qd + it * 8192 + ch * 8); r_kt[i] = *(const u32x4*)(kt + it * 8192 + ch * 8); }
            r_qk = *(const u32x4*)(qk + it * 4096 + tid * 8);
            if (tid < 256) r_ub = *(const u32x4*)(ub + it * 8192 + (tid >> 2) * 128 + sl * 16 + (tid & 3) * 4);
        };
        auto lstore = [&](int buf) {
            LAS unsigned char* B = lds + buf * SB_SIZE;
#pragma unroll
            for (int i = 0; i < 2; ++i) { const int ch = tid + 512 * i; const int r = ch >> 4, c8 = (ch & 15) * 8; *(LAS u32x4*)(B + SB_WD + r * 272 + c8 * 2) = r_wd[i]; *(LAS u32x4*)(B + SB_QD + r * 272 + c8 * 2) = r_qd[i];
                const int d = ch >> 3, t8 = (ch & 7) * 8; *(LAS u32x4*)(B + SB_KT + d * 144 + t8 * 2) = r_kt[i]; }
            { const int r = tid >> 3, s8 = (tid & 7) * 8; *(LAS u32x4*)(B + SB_QK + r * 144 + s8 * 2) = r_qk; }
            if (tid < 256) *(LAS u32x4*)(B + SB_UB + (tid >> 2) * 64 + (tid & 3) * 16) = r_ub;
        };
        __syncthreads();
        gload(0);
        for (int i = tid; i < 4352 / 4; i += 512) *(LAS unsigned*)(lds + SC_ST + i * 4) = 0u;
        lstore(0);
        f32x4 sacc = (f32x4){0.f, 0.f, 0.f, 0.f};
        __syncthreads();
        for (int n = 0; n < 32; ++n) {
            const int cur = n & 1; LAS unsigned char* B = lds + cur * SB_SIZE;
            if (n + 1 < 32) gload(n + 1);
            const float cd = cdv[bh * 32 + n];
            f32x4 acc;
            const int tw = wid & 3;
            if (wid < 4) {
#pragma unroll
                for (int j = 0; j < 4; ++j) acc[j] = *(const LAS float*)(B + SB_UB + ((tw * 16 + fq * 4 + j) * 16 + fr) * 4);
#pragma unroll
                for (int kk = 0; kk < 4; ++kk) { const bf16x8 a = *(const LAS bf16x8*)(B + SB_WD + (tw * 16 + fr) * 272 + (kk * 32 + fq * 8) * 2); const bf16x8 bb = *(const LAS bf16x8*)(lds + SC_ST + fr * 272 + (kk * 32 + fq * 8) * 2);
                    acc = __builtin_amdgcn_mfma_f32_16x16x32_bf16(a, bb, acc, 0, 0, 0); }
                u32x2 w; w.x = pk2(acc[0], acc[1]); w.y = pk2(acc[2], acc[3]);
                *(LAS u32x2*)(lds + SC_UT + fr * 144 + (tw * 16 + fq * 4) * 2) = w;
            } else {
                acc = (f32x4){0.f, 0.f, 0.f, 0.f};
#pragma unroll
                for (int kk = 0; kk < 4; ++kk) { const bf16x8 a = *(const LAS bf16x8*)(B + SB_QD + (tw * 16 + fr) * 272 + (kk * 32 + fq * 8) * 2); const bf16x8 bb = *(const LAS bf16x8*)(lds + SC_ST + fr * 272 + (kk * 32 + fq * 8) * 2);
                    acc = __builtin_amdgcn_mfma_f32_16x16x32_bf16(a, bb, acc, 0, 0, 0); }
            }
            __syncthreads();
            sacc *= cd;
#pragma unroll
            for (int kk = 0; kk < 2; ++kk) { const bf16x8 a = *(const LAS bf16x8*)(B + SB_KT + (wid * 16 + fr) * 144 + (kk * 32 + fq * 8) * 2); const bf16x8 bb = *(const LAS bf16x8*)(lds + SC_UT + fr * 144 + (kk * 32 + fq * 8) * 2);
                sacc = __builtin_amdgcn_mfma_f32_16x16x32_bf16(a, bb, sacc, 0, 0, 0); }
            if (wid >= 4) {
#pragma unroll
                for (int kk = 0; kk < 2; ++kk) { const bf16x8 a = *(const LAS bf16x8*)(B + SB_QK + (tw * 16 + fr) * 144 + (kk * 32 + fq * 8) * 2); const bf16x8 bb = *(const LAS bf16x8*)(lds + SC_UT + fr * 144 + (kk * 32 + fq * 8) * 2);
                    acc = __builtin_amdgcn_mfma_f32_16x16x32_bf16(a, bb, acc, 0, 0, 0); }
#pragma unroll
                for (int j = 0; j < 4; ++j) obuf[(size_t)(b * 2048 + n * 64 + tw * 16 + fq * 4 + j) * 1024 + h * 128 + sl * 16 + fr] = acc[j];
            }
            { u32x2 w; w.x = pk2(sacc[0], sacc[1]); w.y = pk2(sacc[2], sacc[3]); *(LAS u32x2*)(lds + SC_ST + fr * 272 + (wid * 16 + fq * 4) * 2) = w; }
            if (n + 1 < 32) lstore(cur ^ 1);
            __syncthreads();
        }
#pragma unroll
        for (int j = 0; j < 4; ++j) p.out[O_DP + ((size_t)bh * 128 + wid * 16 + fq * 4 + j) * 128 + sl * 16 + fr] = sacc[j];
    }
    __syncthreads();
    {
        const bf16_t* qn = (const bf16_t*)(p.ws + WS_QN); const bf16_t* kn = (const bf16_t*)(p.ws + WS_KN); const bf16_t* vv = (const bf16_t*)(p.ws + WS_VV);
        const float* gbuf = (const float*)(p.ws + WS_G); const float* bbuf = (const float*)(p.ws + WS_BETA);
        const int grp = tid >> 8, w4 = (tid >> 6) & 3, j = w4 * 32 + (lane & 31), half = lane >> 5;
        LAS float* qs = (LAS float*)lds + grp * 1024;
        LAS float* ks = qs + 512;
        const float scale = 0.08838834764831845f;
        for (int it0 = bid * 2; it0 < 1024; it0 += nblk * 2) {
            const int item = it0 + grp, sb = item >> 3, h = item & 7;
            __syncthreads();
#pragma unroll
            for (int i = 0; i < 4; ++i) { const int idx = (tid & 255) + 256 * i, tk = idx >> 7, c = idx & 127, t = tk & 3; const size_t go = (size_t)(TP + sb * 4 + t) * 1024 + h * 128 + c;
                if (tk < 4) qs[t * 128 + c] = bf2f(qn[go]); else ks[t * 128 + c] = bf2f(kn[go]); }
            float S[64];
            const float* s0 = p.in[4] + (size_t)item * 16384 + (size_t)half * 64 * 128 + j;
#pragma unroll
            for (int i = 0; i < 64; ++i) S[i] = __builtin_nontemporal_load(s0 + i * 128);
            __syncthreads();
#pragma unroll 1
            for (int t = 0; t < 4; ++t) {
                const int row = TP + sb * 4 + t;
                const float a = __expf(gbuf[row * 8 + h]), be = bbuf[row * 8 + h], v = bf2f(vv[(size_t)row * 1024 + h * 128 + j]);
                float kS = 0.f;
#pragma unroll
                for (int i4 = 0; i4 < 16; ++i4) { const f32x4 k4 = *(const LAS f32x4*)(ks + t * 128 + half * 64 + i4 * 4); kS += k4[0] * S[i4 * 4] + k4[1] * S[i4 * 4 + 1] + k4[2] * S[i4 * 4 + 2] + k4[3] * S[i4 * 4 + 3]; }
                kS += __shfl_xor(kS, 32);
                const float coef = be * (v - a * kS);
                float o = 0.f;
#pragma unroll
                for (int i4 = 0; i4 < 16; ++i4) { const f32x4 k4 = *(const LAS f32x4*)(ks + t * 128 + half * 64 + i4 * 4); const f32x4 q4 = *(const LAS f32x4*)(qs + t * 128 + half * 64 + i4 * 4);
#pragma unroll
                    for (int q = 0; q < 4; ++q) { S[i4 * 4 + q] = a * S[i4 * 4 + q] + k4[q] * coef; o += q4[q] * S[i4 * 4 + q]; } }
                o += __shfl_xor(o, 32);
                if (half == 0) obuf[(size_t)row * 1024 + h * 128 + j] = o * scale;
            }
            float* so = p.out + O_DS + (size_t)item * 16384 + (size_t)half * 64 * 128 + j;
#pragma unroll
            for (int i = 0; i < 64; ++i) so[i * 128] = S[i];
        }
    }
    __syncthreads();
}

__device__ __forceinline__ void onorm_phase(const Params& p, int bid, int nblk) {
    const int lane = threadIdx.x & 63, wid = threadIdx.x >> 6;
    const float* obuf = p.out + OS_O; const bf16_t* proj = (const bf16_t*)(p.ws + WS_PROJ); bf16_t* acat = (bf16_t*)(p.ws + WS_U); const float* og = p.in[14];
    for (int row = bid * 8 + wid; row < TT; row += nblk * 8) {
        const int c0 = lane * 16; float o[16], z[16], g[16];
#pragma unroll
        for (int i = 0; i < 4; ++i) { const f32x4 v = *(const f32x4*)(obuf + (size_t)row * 1024 + c0 + i * 4); o[i * 4] = v[0]; o[i * 4 + 1] = v[1]; o[i * 4 + 2] = v[2]; o[i * 4 + 3] = v[3];
            const f32x4 gg = *(const f32x4*)(og + (c0 & 127) + i * 4); g[i * 4] = gg[0]; g[i * 4 + 1] = gg[1]; g[i * 4 + 2] = gg[2]; g[i * 4 + 3] = gg[3]; }
        unpack8(*(const u32x4*)(proj + (size_t)row * NPROJ + C_Z + c0), z); unpack8(*(const u32x4*)(proj + (size_t)row * NPROJ + C_Z + c0 + 8), z + 8);
        float ss = 0.f;
#pragma unroll
        for (int i = 0; i < 16; ++i) ss += o[i] * o[i];
        ss += __shfl_xor(ss, 1); ss += __shfl_xor(ss, 2); ss += __shfl_xor(ss, 4);
        const float rstd = rsqrtf(ss * (1.0f / 128.0f) + EPS);
#pragma unroll
        for (int i = 0; i < 16; ++i) o[i] = o[i] * rstd * g[i] * siluf_(z[i]);
        *(u32x4*)(acat + (size_t)row * DM + c0) = pack8(o); *(u32x4*)(acat + (size_t)row * DM + c0 + 8) = pack8(o + 8);
    }
}

#define XB_TMO      128
#define XB_XCNT(j)  (256  + 64 * (j))
#define XB_XSUB(j)  (1280 + 64 * (j))
#define XB_XGEN(j)  (2304 + 64 * (j))
#define XB_TOP      3328
#define XB_TOPGEN   3392
#define XCD_BAR_WORDS 3456
#define XB_SPIN_CAP (1u << 18)

__device__ __forceinline__ unsigned xb_ld(unsigned* p)              { return __hip_atomic_load(p, __ATOMIC_RELAXED, __HIP_MEMORY_SCOPE_AGENT); }
__device__ __forceinline__ unsigned xb_add(unsigned* p, unsigned v) { return __hip_atomic_fetch_add(p, v, __ATOMIC_RELAXED, __HIP_MEMORY_SCOPE_AGENT); }
__device__ __forceinline__ unsigned xb_xcc_id() { return (unsigned)__builtin_amdgcn_s_getreg((3 << 11) | 20) & 0xFu; }
#define XB_SPIN(cond, bar) do { unsigned _sp = 0; while (cond) { __builtin_amdgcn_s_sleep(1); \
    if ((++_sp & 255u) == 0u) { if (xb_ld(&(bar)[XB_TMO])) break; if (_sp > XB_SPIN_CAP) { atomicAdd(&(bar)[XB_TMO], 1u); break; } } } } while (0)

struct XcdBarrier {
    unsigned* bar; unsigned x;
    volatile LAS unsigned* st;
};

__device__ __forceinline__ XcdBarrier xcd_barrier_post(unsigned* bar, volatile LAS unsigned* st) {
    XcdBarrier b; b.bar = bar; b.x = xb_xcc_id(); b.st = st;
    if (threadIdx.x == 0) (void)xb_add(&bar[XB_XCNT(b.x)], 1u);
    return b;
}
__device__ __forceinline__ void xcd_barrier_complete(unsigned* bar, unsigned x, unsigned& nloc, unsigned& nx) {
    const unsigned G = gridDim.x * gridDim.y * gridDim.z;
    unsigned sum, cnt, mine, sp = 0u;
    for (;;) {
        sum = 0u; cnt = 0u; mine = 0u;
#pragma unroll
        for (unsigned j = 0; j < 16; ++j) { const unsigned c = xb_ld(&bar[XB_XCNT(j)]); sum += c; cnt += (c > 0u) ? 1u : 0u; mine = (j == x) ? c : mine; }
        if (sum == G) break;
        __builtin_amdgcn_s_sleep(1);
        if ((++sp & 255u) == 0u) { if (xb_ld(&bar[XB_TMO])) break; if (sp > XB_SPIN_CAP) { atomicAdd(&bar[XB_TMO], 1u); break; } }
    }
    nloc = mine > 0u ? mine : 1u; nx = cnt > 0u ? cnt : 1u;
}

__device__ __forceinline__ void xcd_barrier(const XcdBarrier& b) {
    asm volatile("s_waitcnt vmcnt(0)" ::: "memory");
    __syncthreads();
    if (threadIdx.x == 0) {
        unsigned* bar = b.bar;
        __builtin_amdgcn_s_waitcnt(0);
        unsigned nloc = b.st[0], nx = b.st[1];
        if (nloc == 0u) { xcd_barrier_complete(bar, b.x, nloc, nx); b.st[0] = nloc; b.st[1] = nx; }
        const unsigned old = xb_add(&bar[XB_XSUB(b.x)], 1u);
        const unsigned gen = old / nloc;
        if (old + 1u == (gen + 1u) * nloc) {
            __builtin_amdgcn_fence(__ATOMIC_RELEASE, "agent");
            asm volatile("s_waitcnt vmcnt(0)" ::: "memory");
            const unsigned og = xb_add(&bar[XB_TOP], 1u);
            const unsigned tg = og / nx;
            if (og + 1u == (tg + 1u) * nx) xb_add(&bar[XB_TOPGEN], 1u);
            else XB_SPIN(xb_ld(&bar[XB_TOPGEN]) == tg, bar);
            __builtin_amdgcn_fence(__ATOMIC_ACQUIRE, "agent");
            xb_add(&bar[XB_XGEN(b.x)], 1u);
            asm volatile("s_waitcnt vmcnt(0)" ::: "memory");
        } else {
            XB_SPIN(xb_ld(&bar[XB_XGEN(b.x)]) == gen, bar);
            __builtin_amdgcn_fence(__ATOMIC_ACQUIRE, "agent");
            asm volatile("s_waitcnt vmcnt(0)" ::: "memory");
        }
    }
    __syncthreads();
}

constexpr size_t WS_BAR = WS_END;
constexpr int LDS_ST_OFF = LDS_BYTES - 16;
struct KArgs { Params p; TJob jobs[11]; };
constexpr int N_PHASES = 15;
#ifndef PH_MASK
#define PH_MASK 0xFFFF
#endif
#ifndef DUP_MASK
#define DUP_MASK 0
#endif

__global__ void __launch_bounds__(512, 2) fwd_megakernel(KArgs ka) {
    extern __shared__ __attribute__((aligned(16))) unsigned char lds_raw[];
    LAS unsigned char* lds = (LAS unsigned char*)lds_raw;
    const Params& p = ka.p;
    const int bid = blockIdx.x, nblk = gridDim.x;
    unsigned char* ws = p.ws;
    const int lo = p.ph_lo, hi = p.ph_hi;
    if (threadIdx.x < 4) ((LAS unsigned*)(lds + LDS_ST_OFF))[threadIdx.x] = 0u;
    __syncthreads();
    XcdBarrier xbar = xcd_barrier_post((unsigned*)(ws + WS_BAR), (volatile LAS unsigned*)(lds + LDS_ST_OFF));
#define IN(k) ((PH_MASK & (1 << (k))) && lo <= (k) && (k) < hi)
#define SEAM(k) do { if (lo <= (k) && (k) + 1 < hi) { if ((k) == 0) cg::this_grid().sync(); else xcd_barrier(xbar); } } while (0)
    if (IN(0)) for (int rep = 0; rep <= ((DUP_MASK >> 0) & 1); ++rep) {
            bf16_t* aada = (bf16_t*)(ws + WS_AADA);
            for (int idx = bid * 512 + threadIdx.x; idx < 256 * 2048; idx += nblk * 512) { const int row = idx >> 11, col = idx & 2047;
                const float v = row < 4 ? siluf_(p.in[2][row * 2048 + col]) : (row < NB ? siluf_(p.in[3][(row - 4) * 2048 + col]) : 0.f); aada[idx] = f2bf(v); }
            transpose_jobs(ka.jobs, 1, bid, nblk, lds);
        }
    SEAM(0);
    if (IN(1)) for (int rep = 0; rep <= ((DUP_MASK >> 1) & 1); ++rep) {
            if (bid < 48) { pg8::Gemm g{(const bf16_t*)(ws + WS_AADA), (const bf16_t*)(ws + WS_PROJ), 2048, 2048, 2048, 0}; pg8::OneUnitOrder S{48, bid, 32}; pg8::EpiAda E{(float*)(ws + WS_MOD), p.in[8]}; pg8::gemm_phase(lds, g, S, E); }
            else transpose_jobs(ka.jobs + 1, 10, bid - 48, nblk - 48, lds);
        }
    SEAM(1);
    if (IN(2)) for (int rep = 0; rep <= ((DUP_MASK >> 2) & 1); ++rep) norm_phase<0>(p, bid, nblk);
    SEAM(2);
    if (IN(3)) for (int rep = 0; rep <= ((DUP_MASK >> 3) & 1); ++rep) { pg8::Gemm g{(const bf16_t*)(ws + WS_U), (const bf16_t*)(ws + WS_WIN), 2048, 2048, 2048, 0}; pg8::StaticOrder S; S.init(TT, NPROJ, 2048, nblk, bid); pg8::EpiBf16 E{(bf16_t*)(ws + WS_PROJ), NPROJ, 0, nullptr}; pg8::gemm_phase(lds, g, S, E); }
    SEAM(3);
    if (IN(4)) for (int rep = 0; rep <= ((DUP_MASK >> 4) & 1); ++rep) mixer_prep_phase(p, bid, nblk);
    SEAM(4);
    if (IN(5)) for (int rep = 0; rep <= ((DUP_MASK >> 5) & 1); ++rep) chunk_prep_phase(p, bid, nblk, lds);
    SEAM(5);
    if (IN(6)) for (int rep = 0; rep <= ((DUP_MASK >> 6) & 1); ++rep) scan_phase(p, bid, nblk, lds);
    SEAM(6);
    if (IN(7)) for (int rep = 0; rep <= ((DUP_MASK >> 7) & 1); ++rep) { onorm_phase(p, bid, nblk);
            pg8::Gemm g{(const bf16_t*)(ws + WS_YP), (const bf16_t*)(ws + WS_PW), 1024, 256, 256, 512}; pg8::StaticOrder S; S.init(TT, 1024, 256, nblk, bid); pg8::EpiBf16 E{(bf16_t*)(ws + WS_U), DM, 1024, p.in[16]}; pg8::gemm_phase(lds, g, S, E); }
    SEAM(7);
    if (IN(8)) for (int rep = 0; rep <= ((DUP_MASK >> 8) & 1); ++rep) { pg8::Gemm g{(const bf16_t*)(ws + WS_U), (const bf16_t*)(ws + WS_WAB), 2048, 2048, 1024, 0}; pg8::StaticOrder S; S.init(TT, 2048, 1024, nblk, bid); pg8::EpiG1 E{p.out + O_Y, (const bf16_t*)(ws + WS_PROJ)}; pg8::gemm_phase(lds, g, S, E); }
    SEAM(8);
    if (IN(9)) for (int rep = 0; rep <= ((DUP_MASK >> 9) & 1); ++rep) { pg8::Gemm g{(const bf16_t*)(ws + WS_U) + 1024, (const bf16_t*)(ws + WS_WAB) + 1024, 2048, 2048, 1024, 0}; pg8::StaticOrder S; S.init(TT, 2048, 1024, nblk, bid); pg8::EpiG2 E{(bf16_t*)(ws + WS_QN), p.out + O_Y, (const bf16_t*)(ws + WS_PROJ)}; pg8::gemm_phase(lds, g, S, E); }
    SEAM(9);
    if (IN(10)) for (int rep = 0; rep <= ((DUP_MASK >> 10) & 1); ++rep) { pg8::Gemm g{(const bf16_t*)(ws + WS_QN), (const bf16_t*)(ws + WS_WO), 2048, 2048, 2048, 0}; pg8::SplitOrder S{nblk, bid, 32, 4, 8}; pg8::EpiRes E{p.out + O_Y, p.in[0], p.in[1], (const float*)(ws + WS_MOD) + 4096, (float*)(ws + WS_PB10)}; pg8::gemm_phase(lds, g, S, E); }
    SEAM(10);
    if (IN(11)) for (int rep = 0; rep <= ((DUP_MASK >> 11) & 1); ++rep) norm_phase<1>(p, bid, nblk);
    SEAM(11);
    if (IN(12)) for (int rep = 0; rep <= ((DUP_MASK >> 12) & 1); ++rep) { pg8::Gemm g{(const bf16_t*)(ws + WS_U), (const bf16_t*)(ws + WS_WGU), 2048, 2048, 2048, 0}; pg8::StaticOrder S; S.init(TT, 11264, 2048, nblk, bid); pg8::EpiGU E{(bf16_t*)(ws + WS_PROJ)}; pg8::gemm_phase(lds, g, S, E); }
    SEAM(12);
    if (IN(13)) for (int rep = 0; rep <= ((DUP_MASK >> 13) & 1); ++rep) { pg8::Gemm g{(const bf16_t*)(ws + WS_PROJ), (const bf16_t*)(ws + WS_WD), DFF, DFF, DFF, 0}; pg8::SplitOrder S{nblk, bid, 88, 8, 11}; pg8::EpiRes E{p.out + O_Y, p.out + O_Y, p.out + O_Y + (size_t)TP * DM, (const float*)(ws + WS_MOD) + 10240, (float*)(ws + WS_PB13)}; pg8::gemm_phase(lds, g, S, E); }
    SEAM(13);
    if (IN(14)) for (int rep = 0; rep <= ((DUP_MASK >> 14) & 1); ++rep) norm_phase<2>(p, bid, nblk);
    SEAM(14);
}

extern "C" void kernel_launch(void* const* d_in, const int* in_sizes, int n_in, void* d_out, int out_size, void* d_ws, size_t ws_size, hipStream_t stream) {
    static int grid = 0;
    if (grid == 0) {
        if (n_in != 24 || ws_size < WS_BAR + XCD_BAR_WORDS * 4) { fprintf(stderr, "kernel_launch: unexpected n_in %d / ws_size %zu (need %zu)\n", n_in, ws_size, (size_t)WS_END); grid = -1; return; }
        int dev = 0, cus = 0, per_cu = 0;
        hipGetDevice(&dev); hipDeviceGetAttribute(&cus, hipDeviceAttributeMultiprocessorCount, dev);
        if (hipFuncSetAttribute((const void*)fwd_megakernel, hipFuncAttributeMaxDynamicSharedMemorySize, LDS_BYTES) != hipSuccess) { fprintf(stderr, "kernel_launch: hipFuncSetAttribute failed\n"); grid = -1; return; }
        if (hipOccupancyMaxActiveBlocksPerMultiprocessor(&per_cu, (const void*)fwd_megakernel, 512, LDS_BYTES) != hipSuccess || per_cu < 1) { fprintf(stderr, "kernel_launch: occupancy query says %d\n", per_cu); per_cu = 1; }
        (void)hipGetLastError();
        grid = cus > 0 ? cus : 256;
        if (grid < 64) grid = 64;
    }
    if (grid < 0) return;
    if (hipMemsetAsync((unsigned char*)d_ws + WS_BAR, 0, XCD_BAR_WORDS * 4, stream) != hipSuccess) { fprintf(stderr, "kernel_launch: memset failed\n"); return; }
    KArgs ka; memset(&ka, 0, sizeof(ka));
    for (int i = 0; i < 24; ++i) ka.p.in[i] = (const float*)d_in[i];
    ka.p.out = (float*)d_out; ka.p.ws = (unsigned char*)d_ws;
    unsigned char* ws = (unsigned char*)d_ws;
    auto setjob = [&](int i, const void* src, void* dst, int ld_src, int K, int Nout, int ld_dst, int map) { TJob& j = ka.jobs[i]; j.src = (const float*)src; j.dst = (bf16_t*)dst; j.ld_src = ld_src; j.K = K; j.Nout = Nout; j.ld_dst = ld_dst; j.map = map; j.pad = 0; };
    setjob(0, d_in[7], ws + WS_PROJ, MODW, 2048, MODW, 2048, 0);
    setjob(1, d_in[10], ws + WS_WIN, 9232, 2048, NPROJ, 2048, 1);
    setjob(2, d_in[21], ws + WS_WGU, 2 * DFF, 2048, 2 * DFF, 2048, 2);
    setjob(3, d_in[22], ws + WS_WD, 2048, DFF, 2048, DFF, 0);
    setjob(4, d_in[19], ws + WS_WO, 2048, 2048, 2048, 2048, 0);
    setjob(5, d_in[17], ws + WS_WAB, 2048, 1024, 2048, 2048, 0);
    setjob(6, d_in[18], ws + WS_WAB + 1024 * 2, 2048, 1024, 2048, 2048, 0);
    for (int g = 0; g < 4; ++g) setjob(7 + g, (const float*)d_in[15] + g * 65536, ws + WS_PW + (size_t)g * 65536 * 2, 256, 256, 256, 256, 0);
#if MK_PER_PHASE
    for (int ph = 0; ph < N_PHASES; ++ph) { ka.p.ph_lo = ph; ka.p.ph_hi = ph + 1; hipLaunchKernelGGL(fwd_megakernel, dim3(grid), dim3(512), LDS_BYTES, stream, ka); }
#else
    ka.p.ph_lo = 0; ka.p.ph_hi = N_PHASES;
    void* args[] = {&ka};
    hipError_t e = hipLaunchCooperativeKernel((const void*)fwd_megakernel, dim3(grid), dim3(512), args, LDS_BYTES, stream);
    if (e != hipSuccess) fprintf(stderr, "cooperative launch failed: %s (grid %d)\n", hipGetErrorString(e), grid);
#endif
}
```

```cpp
#include <hip/hip_runtime.h>
#include <hip/hip_cooperative_groups.h>
#include <cstdio>
#include <cstring>
namespace cg = cooperative_groups;

#ifndef MK_PER_PHASE
#define MK_PER_PHASE 0
#endif

#define LAS __attribute__((address_space(3)))
typedef unsigned short bf16_t;
typedef short bf16x8 __attribute__((ext_vector_type(8)));
typedef float f32x4 __attribute__((ext_vector_type(4)));
typedef float f32x2 __attribute__((ext_vector_type(2)));
typedef unsigned u32x4 __attribute__((ext_vector_type(4)));
typedef unsigned u32x2 __attribute__((ext_vector_type(2)));

constexpr int DM = 2048, TP = 8192, TS = 512, TT = 8704, NB = 132;
constexpr int NPROJ = 9472;
constexpr int DFF = 5632;
constexpr int MODW = 12288;
constexpr float EPS = 1e-6f;
constexpr int C_Q = 0, C_K = 1024, C_V = 2048, C_Z = 3072, C_XP = 4096, C_GA = 5120, C_GB = 7168, C_AB = 9216;
constexpr size_t O_Y = 0, O_DP = 17825792, O_CP = 18350080, O_PP = 18386944, O_DS = 18448384, O_CS = 35225600, O_PS = 36405248;
constexpr size_t OS_O = 0, OS_UB = 8912896;
constexpr size_t WS_WIN = 0;
constexpr size_t WS_WGU = WS_WIN + (size_t)NPROJ * 2048 * 2;
constexpr size_t WS_WD = WS_WGU + (size_t)11264 * 2048 * 2;
constexpr size_t WS_WO = WS_WD + (size_t)2048 * 5632 * 2;
constexpr size_t WS_WAB = WS_WO + (size_t)2048 * 2048 * 2;
constexpr size_t WS_PW = WS_WAB + (size_t)2048 * 2048 * 2;
constexpr size_t WS_AADA = WS_PW + (size_t)1024 * 256 * 2;
constexpr size_t WS_MOD = WS_AADA + (size_t)256 * 2048 * 2;
constexpr size_t WS_G = WS_MOD + (size_t)NB * MODW * 4;
constexpr size_t WS_BETA = WS_G + (size_t)TT * 8 * 4;
constexpr size_t WS_CD = WS_BETA + (size_t)TT * 8 * 4;
constexpr size_t WS_U = WS_CD + 4096;
constexpr size_t WS_QN = WS_U + (size_t)TT * 2048 * 2;
constexpr size_t WS_KN = WS_QN + (size_t)TT * 1024 * 2;
constexpr size_t WS_VV = WS_KN + (size_t)TT * 1024 * 2;
constexpr size_t WS_YP = WS_VV + (size_t)TT * 1024 * 2;
constexpr size_t WS_WDC = WS_YP + (size_t)TT * 1024 * 2;
constexpr size_t WS_QD = WS_WDC + (size_t)1024 * 64 * 128 * 2;
constexpr size_t WS_KT = WS_QD + (size_t)1024 * 64 * 128 * 2;
constexpr size_t WS_QK = WS_KT + (size_t)1024 * 64 * 128 * 2;
constexpr size_t WS_PROJ = WS_QK + (size_t)1024 * 64 * 64 * 2;
constexpr size_t WS_END = WS_PROJ + (size_t)TT * NPROJ * 2;
constexpr size_t WS_PB10 = WS_PROJ;
constexpr size_t WS_PB13 = WS_PROJ + (size_t)TT * DFF * 2;
static_assert(WS_PB13 + (size_t)11 * TS * DM * 4 <= WS_END && (WS_PB13 % 256) == 0, "partials");
static_assert(WS_END + 16384 <= 501510720ull, "workspace too large");
static_assert((WS_PROJ % 256) == 0 && (WS_QK % 256) == 0 && (WS_U % 256) == 0, "align");

constexpr int LDS_BYTES = 147456;

struct Params {
    const float* in[24];
    float* out;
    unsigned char* ws;
    int ph_lo, ph_hi;
};

__device__ __forceinline__ float bf2f(unsigned short x) { return __uint_as_float(((unsigned)x) << 16); }
__device__ __forceinline__ unsigned short f2bf(float f) { unsigned u = __float_as_uint(f); u += 0x7FFFu + ((u >> 16) & 1u); return (unsigned short)(u >> 16); }
__device__ __forceinline__ unsigned pk2(float lo, float hi) { return (unsigned)f2bf(lo) | ((unsigned)f2bf(hi) << 16); }
__device__ __forceinline__ void unpack8(const u32x4 w, float* f) {
    f[0] = __uint_as_float(w.x << 16); f[1] = __uint_as_float(w.x & 0xffff0000u);
    f[2] = __uint_as_float(w.y << 16); f[3] = __uint_as_float(w.y & 0xffff0000u);
    f[4] = __uint_as_float(w.z << 16); f[5] = __uint_as_float(w.z & 0xffff0000u);
    f[6] = __uint_as_float(w.w << 16); f[7] = __uint_as_float(w.w & 0xffff0000u);
}
__device__ __forceinline__ u32x4 pack8(const float* f) { u32x4 w; w.x = pk2(f[0], f[1]); w.y = pk2(f[2], f[3]); w.z = pk2(f[4], f[5]); w.w = pk2(f[6], f[7]); return w; }
__device__ __forceinline__ float sigmoidf_(float x) { return 1.0f / (1.0f + __expf(-x)); }
__device__ __forceinline__ float siluf_(float x) { return x / (1.0f + __expf(-x)); }
__device__ __forceinline__ int bidx_of_row(int row) { return row < TP ? (row >> 11) : 4 + ((row - TP) >> 2); }

namespace pg8 {
constexpr int BM = 256, BK = 64, HALF = 128, HTB = HALF * BK * 2, STAGE_BYTES = 8 * HTB, NXCD = 8, WGM = 8;
__host__ __device__ __forceinline__ int lds_byte(int r, int c) { const int st = (r >> 4) * 2 + (c >> 5), rr = r & 15, cc = c & 31, ob = rr * 64 + cc * 2; return st * 1024 + (ob ^ (((ob >> 9) & 1) << 5)); }
__host__ __device__ __forceinline__ void stage_rc(int b, int& R, int& C) { const int st = b / 1024, sb = b % 1024, swz = sb ^ (((sb >> 9) & 1) << 5); R = (st >> 1) * 16 + swz / 64; C = (st & 1) * 32 + (swz % 64) / 2; }
__host__ __device__ __forceinline__ int perm32(int rho) { const int n = rho >> 4, i = rho & 15; return 8 * (i >> 2) + 4 * n + (i & 3); }

struct Unit { int pm, pn, kt0, nkt, piece; };
struct Gemm { const bf16_t* A; const bf16_t* Bt; int lda, ldb, K; size_t a_pn_off; };

__device__ __forceinline__ void tile_of(int wgid, int nM, int nN, Unit& u) {
    const int nwg = nM * nN;
    { const int q = nwg / NXCD, r = nwg % NXCD, xcd = wgid % NXCD, off = wgid / NXCD; wgid = (xcd < r ? xcd * (q + 1) : r * (q + 1) + (xcd - r) * q) + off; }
    const int nig = WGM * nN, gid = wgid / nig, fm = gid * WGM, gsz = (nM - fm) < WGM ? (nM - fm) : WGM;
    u.pm = fm + ((wgid % nig) % gsz); u.pn = (wgid % nig) / gsz;
}
struct StaticOrder {
    int nM, nN, nwg, G, c, ntk;
    __device__ __forceinline__ void init(int M, int N, int K, int G_, int c_) { nM = M / BM; nN = N / BM; nwg = nM * nN; G = G_; c = c_; ntk = K / BK; }
    __device__ __forceinline__ bool next(int i, Unit& u) const {
        const long L = (long)i * G + c; if (L >= nwg) return false;
        tile_of((int)L, nM, nN, u); u.kt0 = 0; u.nkt = ntk; u.piece = -1; return true;
    }
};
struct OneUnitOrder {
    int n, c, ntk;
    __device__ __forceinline__ bool next(int i, Unit& u) const { if (i != 0 || c >= n) return false; u.pm = 0; u.pn = c; u.kt0 = 0; u.nkt = ntk; u.piece = -1; return true; }
};
struct SplitOrder {
    int G, c, ntk, pk, npc;
    __device__ __forceinline__ bool next(int i, Unit& u) const {
        const int L = i * G + c;
        const bool full = L < 256;
        int fpm, fpn;
        { int wgid = full ? L : 0; const int xcd = wgid % NXCD, off = wgid / NXCD; wgid = xcd * 32 + off;
          const int nig = WGM * 8, gid = wgid / nig, fm = gid * WGM; fpm = fm + ((wgid % nig) % WGM); fpn = (wgid % nig) / WGM; }
        const int pidx = full ? 0 : L - 256, tile = pidx / npc, pc = pidx - tile * npc;
        u.pm = full ? fpm : 32 + (tile >> 3); u.pn = full ? fpn : (tile & 7); u.kt0 = full ? 0 : pc * pk; u.nkt = full ? ntk : pk; u.piece = full ? -1 : pc;
        return full || pidx < 16 * npc;
    }
};

template <class Epi, class Sched>
__device__ __forceinline__ void gemm_phase(LAS unsigned char* lds, const Gemm g, const Sched& S, const Epi& E) {
    const int tid = threadIdx.x, wid = __builtin_amdgcn_readfirstlane(tid >> 6), lane = tid & 63, wr = wid >> 2, wc = wid & 3, fr = lane & 15, fq = lane >> 4;
    unsigned voffA[2], voffB[2];
#pragma unroll
    for (int i = 0; i < 2; ++i) { int R, C; stage_rc(tid * 16 + i * 8192, R, C); const int Rb = Epi::PERM ? ((R & ~31) + perm32(R & 31)) : R;
        voffA[i] = (unsigned)(R * g.lda + C) * 2u; voffB[i] = (unsigned)(Rb * g.ldb + C) * 2u; }
    const size_t kstep = (size_t)(BK * 2);
    const size_t hstepA = (size_t)HALF * g.lda * 2, hstepB = (size_t)HALF * g.ldb * 2;
    const size_t tstepA = 2 * hstepA, tstepB = 2 * hstepB;
    const unsigned ldsw = (unsigned)wid * 1024u;
    const int aoff = lds_byte(wr * 64 + fr, fq * 8), boff = lds_byte(wc * 32 + fr, fq * 8);
#define PG8_SA(b, h) (((b) * 2 + (h)) * HTB)
#define PG8_SB(b, h) ((4 + (b) * 2 + (h)) * HTB)
#define PG8_STAGE(bufoff, gbase, voff) do { _Pragma("unroll") for (int _i = 0; _i < 2; ++_i) \
        __builtin_amdgcn_global_load_lds((const unsigned*)((const char*)(gbase) + (voff)[_i]), (LAS unsigned*)(lds + (bufoff) + ldsw + _i * 8192), 16, 0, 0); } while (0)
#define PG8_LDA(dst, b, h) do { _Pragma("unroll") for (int m = 0; m < 4; ++m) _Pragma("unroll") for (int k = 0; k < 2; ++k) dst[m][k] = *(const LAS bf16x8*)(lds + PG8_SA(b, h) + aoff + m * 2048 + k * 1024); } while (0)
#define PG8_LDB(dst, b, h) do { _Pragma("unroll") for (int n = 0; n < 2; ++n) _Pragma("unroll") for (int k = 0; k < 2; ++k) dst[n][k] = *(const LAS bf16x8*)(lds + PG8_SB(b, h) + boff + n * 2048 + k * 1024); } while (0)
#define PG8_MMA(ai, bj, At, Bt) do { __builtin_amdgcn_s_setprio(1); _Pragma("unroll") for (int m = 0; m < 4; ++m) _Pragma("unroll") for (int n = 0; n < 2; ++n) _Pragma("unroll") for (int k = 0; k < 2; ++k) \
        acc[ai][bj][m][n] = __builtin_amdgcn_mfma_f32_16x16x32_bf16(Bt[n][k], At[m][k], acc[ai][bj][m][n], 0, 0, 0); __builtin_amdgcn_s_setprio(0); } while (0)
#define PG8_WAIT_V(n) asm volatile("s_waitcnt vmcnt(" #n ")" ::: "memory")
#define PG8_WAIT_L(n) asm volatile("s_waitcnt lgkmcnt(" #n ")" ::: "memory")
#define PG8_BAR __builtin_amdgcn_s_barrier()
#define PG8_SCHED __builtin_amdgcn_sched_barrier(0)
    Unit cur, nxt; int ui = 0;
    if (!S.next(0, cur)) return;
    f32x4 acc[2][2][4][2];
#pragma unroll
    for (int a = 0; a < 2; ++a)
#pragma unroll
        for (int b = 0; b < 2; ++b)
#pragma unroll
            for (int m = 0; m < 4; ++m)
#pragma unroll
                for (int n = 0; n < 2; ++n) acc[a][b][m][n] = (f32x4){0.f, 0.f, 0.f, 0.f};
    bf16x8 At[4][2], B0[2][2], B1[2][2];
    const char* cA = (const char*)g.A + (size_t)cur.pm * tstepA + (size_t)cur.pn * g.a_pn_off + (size_t)cur.kt0 * kstep; const char* cB = (const char*)g.Bt + (size_t)cur.pn * tstepB + (size_t)cur.kt0 * kstep;
    PG8_STAGE(PG8_SB(0, 0), cB, voffB); PG8_STAGE(PG8_SA(0, 0), cA, voffA); PG8_STAGE(PG8_SB(0, 1), cB + hstepB, voffB); PG8_STAGE(PG8_SA(0, 1), cA + hstepA, voffA);
    if (wr == 1) PG8_BAR;
    PG8_WAIT_V(4); PG8_BAR;
    PG8_STAGE(PG8_SB(1, 0), cB + kstep, voffB); PG8_STAGE(PG8_SA(1, 0), cA + kstep, voffA); PG8_STAGE(PG8_SB(1, 1), cB + hstepB + kstep, voffB);
    PG8_WAIT_V(6); PG8_BAR;
    for (;;) {
        const bool has_next = S.next(ui + 1, nxt);
        const char* nA = has_next ? (const char*)g.A + (size_t)nxt.pm * tstepA + (size_t)nxt.pn * g.a_pn_off + (size_t)nxt.kt0 * kstep : cA; const char* nB = has_next ? (const char*)g.Bt + (size_t)nxt.pn * tstepB + (size_t)nxt.kt0 * kstep : cB;
        const int nt = cur.nkt;
#pragma unroll 1
        for (int t = 0; t < nt; t += 2) {
            const bool last = (t == nt - 2);
            const char* a1 = cA + (size_t)(t + 1) * kstep;
            const char* a2 = last ? nA : cA + (size_t)(t + 2) * kstep; const char* b2 = last ? nB : cB + (size_t)(t + 2) * kstep;
            const char* a3 = a2 + kstep; const char* b3 = b2 + kstep;
            PG8_LDB(B0, 0, 0); PG8_SCHED; PG8_LDA(At, 0, 0); PG8_STAGE(PG8_SA(1, 1), a1 + hstepA, voffA);
            PG8_WAIT_L(8); PG8_BAR; PG8_WAIT_L(0); PG8_MMA(0, 0, At, B0); PG8_BAR; PG8_SCHED;
            PG8_LDB(B1, 0, 1); PG8_STAGE(PG8_SB(0, 0), b2, voffB);
            PG8_BAR; PG8_WAIT_L(0); PG8_MMA(0, 1, At, B1); PG8_BAR;
            PG8_LDA(At, 0, 1); PG8_STAGE(PG8_SA(0, 0), a2, voffA);
            PG8_BAR; PG8_WAIT_L(0); PG8_MMA(1, 0, At, B0); PG8_BAR; PG8_SCHED;
            PG8_STAGE(PG8_SB(0, 1), b2 + hstepB, voffB);
            PG8_WAIT_V(6); PG8_BAR; PG8_MMA(1, 1, At, B1); PG8_BAR;
            PG8_LDB(B0, 1, 0); PG8_SCHED; PG8_LDA(At, 1, 0); PG8_STAGE(PG8_SA(0, 1), a2 + hstepA, voffA);
            PG8_WAIT_L(8); PG8_BAR; PG8_WAIT_L(0); PG8_MMA(0, 0, At, B0); PG8_BAR; PG8_SCHED;
            PG8_LDB(B1, 1, 1); PG8_STAGE(PG8_SB(1, 0), b3, voffB);
            PG8_BAR; PG8_WAIT_L(0); PG8_MMA(0, 1, At, B1); PG8_BAR;
            PG8_LDA(At, 1, 1); PG8_STAGE(PG8_SA(1, 0), a3, voffA);
            PG8_BAR; PG8_WAIT_L(0); PG8_MMA(1, 0, At, B0); PG8_BAR; PG8_SCHED;
            PG8_STAGE(PG8_SB(1, 1), b3 + hstepB, voffB);
            PG8_WAIT_V(6); PG8_BAR; PG8_MMA(1, 1, At, B1); PG8_BAR;
        }
        E(acc, cur, wr, wc, fr, fq);
        if (!has_next) break;
#pragma unroll
        for (int a = 0; a < 2; ++a)
#pragma unroll
            for (int b = 0; b < 2; ++b)
#pragma unroll
                for (int m = 0; m < 4; ++m)
#pragma unroll
                    for (int n = 0; n < 2; ++n) acc[a][b][m][n] = (f32x4){0.f, 0.f, 0.f, 0.f};
        cur = nxt; cA = nA; cB = nB; ++ui;
    }
    PG8_WAIT_V(0);
    if (wr == 0) PG8_BAR;
    PG8_BAR;
#undef PG8_SA
#undef PG8_SB
#undef PG8_STAGE
#undef PG8_LDA
#undef PG8_LDB
#undef PG8_MMA
#undef PG8_WAIT_V
#undef PG8_WAIT_L
#undef PG8_BAR
#undef PG8_SCHED
}

typedef f32x4 Acc[2][2][4][2];

struct EpiAda {
    static constexpr bool PERM = false, MID = false;
    float* C; const float* bias;
    __device__ __forceinline__ void operator()(const Acc& acc, const Unit& u, int wr, int wc, int fr, int fq) const {
        const int row0 = wr * 64 + fr, col0 = u.pn * BM + wc * 32 + 4 * fq;
#pragma unroll
        for (int ai = 0; ai < 2; ++ai)
#pragma unroll
            for (int m = 0; m < 4; ++m) { const int row = row0 + ai * HALF + m * 16; if (row < NB) {
#pragma unroll
                for (int bj = 0; bj < 2; ++bj)
#pragma unroll
                    for (int n = 0; n < 2; ++n) { const int c = col0 + bj * HALF + n * 16; *(f32x4*)(C + (size_t)row * MODW + c) = acc[ai][bj][m][n] + *(const f32x4*)(bias + c); } } }
    }
};
struct EpiBf16 {
    static constexpr bool PERM = true, MID = false;
    bf16_t* O; int ldc; int col_off; const float* scale;
    __device__ __forceinline__ void operator()(const Acc& acc, const Unit& u, int wr, int wc, int fr, int fq) const {
        const int row0 = u.pm * BM + wr * 64 + fr, col0 = u.pn * BM + wc * 32 + 8 * fq;
#pragma unroll
        for (int ai = 0; ai < 2; ++ai)
#pragma unroll
            for (int m = 0; m < 4; ++m) { bf16_t* rowp = O + (size_t)(row0 + ai * HALF + m * 16) * ldc + col_off + col0;
#pragma unroll
                for (int bj = 0; bj < 2; ++bj) { f32x4 v0 = acc[ai][bj][m][0], v1 = acc[ai][bj][m][1];
                    if (scale) { v0 *= *(const f32x4*)(scale + col0 + bj * HALF); v1 *= *(const f32x4*)(scale + col0 + bj * HALF + 4); }
                    u32x4 w; w.x = pk2(v0[0], v0[1]); w.y = pk2(v0[2], v0[3]); w.z = pk2(v1[0], v1[1]); w.w = pk2(v1[2], v1[3]);
                    *(u32x4*)(rowp + bj * HALF) = w; }
                if (scale) asm volatile("" ::: "memory"); }
    }
};
struct EpiG1 {
    static constexpr bool PERM = true, MID = false;
    float* T1; const bf16_t* proj;
    __device__ __forceinline__ void operator()(const Acc& acc, const Unit& u, int wr, int wc, int fr, int fq) const {
        const int row0 = u.pm * BM + wr * 64 + fr, col0 = u.pn * BM + wc * 32 + 8 * fq;
#pragma unroll
        for (int ai = 0; ai < 2; ++ai)
#pragma unroll
            for (int m = 0; m < 4; ++m) { const size_t row = (size_t)(row0 + ai * HALF + m * 16); const bf16_t* pr = proj + row * NPROJ + col0;
#pragma unroll
                for (int bj = 0; bj < 2; ++bj) { float ga[8]; unpack8(*(const u32x4*)(pr + C_GA + bj * HALF), ga); f32x4 v0, v1;
#pragma unroll
                    for (int j = 0; j < 4; ++j) { v0[j] = acc[ai][bj][m][0][j] * __builtin_amdgcn_rcpf(1.0f + __expf(-ga[j])); v1[j] = acc[ai][bj][m][1][j] * __builtin_amdgcn_rcpf(1.0f + __expf(-ga[4 + j])); }
                    float* o = T1 + row * DM + col0 + bj * HALF; *(f32x4*)o = v0; *(f32x4*)(o + 4) = v1; }
                }
    }
};
struct EpiG2 {
    static constexpr bool PERM = true, MID = false;
    bf16_t* O; const float* T1; const bf16_t* proj;
    __device__ __forceinline__ void operator()(const Acc& acc, const Unit& u, int wr, int wc, int fr, int fq) const {
        const int row0 = u.pm * BM + wr * 64 + fr, col0 = u.pn * BM + wc * 32 + 8 * fq;
#pragma unroll
        for (int ai = 0; ai < 2; ++ai)
#pragma unroll
            for (int m = 0; m < 4; ++m) { const size_t row = (size_t)(row0 + ai * HALF + m * 16); const bf16_t* pr = proj + row * NPROJ + col0;
#pragma unroll
                for (int bj = 0; bj < 2; ++bj) { float gb[8], v[8]; unpack8(*(const u32x4*)(pr + C_GB + bj * HALF), gb);
                    const float* t = T1 + row * DM + col0 + bj * HALF; const f32x4 t0 = *(const f32x4*)t, t1 = *(const f32x4*)(t + 4);
#pragma unroll
                    for (int j = 0; j < 4; ++j) { v[j] = t0[j] + acc[ai][bj][m][0][j] * __builtin_amdgcn_rcpf(1.0f + __expf(-gb[j])); v[4 + j] = t1[j] + acc[ai][bj][m][1][j] * __builtin_amdgcn_rcpf(1.0f + __expf(-gb[4 + j])); }
                    *(u32x4*)(O + row * DM + col0 + bj * HALF) = pack8(v); }
                if (m & 1) asm volatile("" ::: "memory"); }
    }
};
struct EpiRes {
    static constexpr bool PERM = false, MID = false;
    float* X1; const float* x0p; const float* x0s; const float* gate; float* PB;
    __device__ __forceinline__ void operator()(const Acc& acc, const Unit& u, int wr, int wc, int fr, int fq) const {
        const int row0 = u.pm * BM + wr * 64 + fr, col0 = u.pn * BM + wc * 32 + 4 * fq;
        if (u.piece >= 0) {
            float* pb = PB + (size_t)u.piece * TS * DM;
#pragma unroll
            for (int ai = 0; ai < 2; ++ai)
#pragma unroll
                for (int m = 0; m < 4; ++m) { float* orow = pb + (size_t)(row0 + ai * HALF + m * 16 - TP) * DM;
#pragma unroll
                    for (int bj = 0; bj < 2; ++bj)
#pragma unroll
                        for (int n = 0; n < 2; ++n) *(f32x4*)(orow + col0 + bj * HALF + n * 16) = acc[ai][bj][m][n]; }
            return;
        }
#pragma unroll
        for (int ai = 0; ai < 2; ++ai)
#pragma unroll
            for (int m = 0; m < 4; ++m) { const int row = row0 + ai * HALF + m * 16; const int b = bidx_of_row(row);
                const float* xr = (row < TP) ? x0p + (size_t)row * DM : x0s + (size_t)(row - TP) * DM; const float* gr = gate + (size_t)b * MODW; float* orow = X1 + (size_t)row * DM;
#pragma unroll
                for (int bj = 0; bj < 2; ++bj)
#pragma unroll
                    for (int n = 0; n < 2; ++n) { const int c = col0 + bj * HALF + n * 16; const f32x4 xv = *(const f32x4*)(xr + c), gv = *(const f32x4*)(gr + c);
                        *(f32x4*)(orow + c) = xv + gv * acc[ai][bj][m][n]; } }
    }
};
struct EpiGU {
    static constexpr bool PERM = true, MID = false;
    bf16_t* O;
    __device__ __forceinline__ void operator()(const Acc& acc, const Unit& u, int wr, int wc, int fr, int fq) const {
        const int row0 = u.pm * BM + wr * 64 + fr, col0 = u.pn * HALF + wc * 32 + 8 * fq;
#pragma unroll
        for (int ai = 0; ai < 2; ++ai)
#pragma unroll
            for (int m = 0; m < 4; ++m) { float v[8];
#pragma unroll
                for (int n = 0; n < 2; ++n)
#pragma unroll
                    for (int j = 0; j < 4; ++j) { const float gt = acc[ai][0][m][n][j]; v[4 * n + j] = gt * __builtin_amdgcn_rcpf(1.0f + __expf(-gt)) * acc[ai][1][m][n][j]; }
                *(u32x4*)(O + (size_t)(row0 + ai * HALF + m * 16) * DFF + col0) = pack8(v); }
    }
};
}

struct TJob { const float* src; bf16_t* dst; int ld_src, K, Nout, ld_dst, map, pad; };
__device__ __forceinline__ int map_col(int map, int n) {
    if (map == 1) { if (n < 4096) return n; if (n < 5120) return 4112 + (n - 4096); if (n < 9216) return 5136 + (n - 5120); if (n < 9232) return 4096 + (n - 9216); return -1; }
    if (map == 2) { const int pn = n >> 8, w = n & 255; return w < 128 ? 128 * pn + w : DFF + 128 * pn + (w - 128); }
    return n;
}
__device__ __forceinline__ void tjob_load(const TJob& j, int tile, f32x4 (&v)[4]) {
    const int tid = threadIdx.x, nkt = j.K >> 7, tn = tile / nkt, tk = tile - tn * nkt;
    const int n = tn * 64 + (tid & 15) * 4, kr = tid >> 4, col = map_col(j.map, n);
#pragma unroll
    for (int i = 0; i < 4; ++i) v[i] = col >= 0 ? __builtin_nontemporal_load((const f32x4*)(j.src + (size_t)(tk * 128 + kr + 32 * i) * j.ld_src + col)) : (f32x4){0.f, 0.f, 0.f, 0.f};
}
__device__ __forceinline__ void tjob_store(const TJob& j, int tile, const f32x4 (&v)[4], LAS float* s) {
    const int tid = threadIdx.x, nkt = j.K >> 7, tn = tile / nkt, tk = tile - tn * nkt;
    const int nq = tid & 15, kr = tid >> 4;
    __syncthreads();
#pragma unroll
    for (int i = 0; i < 4; ++i)
#pragma unroll
        for (int q = 0; q < 4; ++q) s[(4 * nq + q) * 129 + kr + 32 * i] = v[i][q];
    __syncthreads();
    const int n = tid >> 3, k16 = (tid & 7) * 16;
    float f[16];
#pragma unroll
    for (int i = 0; i < 16; ++i) f[i] = s[n * 129 + k16 + i];
    bf16_t* d = j.dst + (size_t)(tn * 64 + n) * j.ld_dst + tk * 128 + k16;
    *(u32x4*)d = pack8(f); *(u32x4*)(d + 8) = pack8(f + 8);
}
__device__ __forceinline__ void transpose_jobs(const TJob* jobs, int njobs, int bi, int nblk, LAS unsigned char* lds) {
    LAS float* s = (LAS float*)lds;
    int total = 0;
    for (int q = 0; q < njobs; ++q) total += (jobs[q].Nout >> 6) * (jobs[q].K >> 7);
    f32x4 v[4]; int curj = 0, base = 0;
    int t = bi;
    auto locate = [&](int tt, int& jj, int& bb) { while (tt >= bb + (jobs[jj].Nout >> 6) * (jobs[jj].K >> 7)) { bb += (jobs[jj].Nout >> 6) * (jobs[jj].K >> 7); ++jj; } };
    if (t < total) { locate(t, curj, base); tjob_load(jobs[curj], t - base, v); }
    while (t < total) {
        const int tn = t + nblk; int nj = curj, nb = base; f32x4 w[4];
        if (tn < total) { locate(tn, nj, nb); tjob_load(jobs[nj], tn - nb, w); }
        tjob_store(jobs[curj], t - base, v, s);
        if (tn < total) {
#pragma unroll
            for (int i = 0; i < 4; ++i) v[i] = w[i]; }
        t = tn; curj = nj; base = nb;
    }
    __syncthreads();
}

template <int MODE>
__device__ __forceinline__ void norm_phase(const Params& p, int bid, int nblk) {
    const int lane = threadIdx.x & 63, wid = threadIdx.x >> 6;
    const float* mod = (const float*)(p.ws + WS_MOD);
    const float* gain = MODE == 0 ? p.in[9] : (MODE == 1 ? p.in[20] : p.in[23]);
    bf16_t* U = (bf16_t*)(p.ws + WS_U);
    for (int row = bid * 8 + wid; row < TT; row += nblk * 8) {
        const float* src = MODE == 0 ? (row < TP ? p.in[0] + (size_t)row * DM : p.in[1] + (size_t)(row - TP) * DM) : p.out + O_Y + (size_t)row * DM;
        if (MODE != 0 && row >= TP) {
            const float* xs = p.in[1] + (size_t)(row - TP) * DM;
            const float* pb = (const float*)(p.ws + (MODE == 1 ? WS_PB10 : WS_PB13)) + (size_t)(row - TP) * DM;
            const float* gt = mod + (size_t)bidx_of_row(row) * MODW + (MODE == 1 ? 4096 : 10240);
            float* xo = p.out + O_Y + (size_t)row * DM;
            constexpr int NPC = MODE == 1 ? 8 : 11;
#pragma unroll 1
            for (int i = 0; i < 8; ++i) { const int c = i * 256 + lane * 4; f32x4 s = *(const f32x4*)(pb + c);
#pragma unroll
                for (int q = 1; q < NPC; ++q) s += *(const f32x4*)(pb + (size_t)q * TS * DM + c);
                const f32x4 base = MODE == 1 ? *(const f32x4*)(xs + c) : *(const f32x4*)(xo + c);
                *(f32x4*)(xo + c) = base + *(const f32x4*)(gt + c) * s; }
            asm volatile("s_waitcnt vmcnt(0)" ::: "memory");
        }
        f32x4 v[8]; float ss = 0.f;
#pragma unroll
        for (int i = 0; i < 8; ++i) v[i] = *(const f32x4*)(src + i * 256 + lane * 4);
#pragma unroll
        for (int i = 0; i < 8; ++i) ss += v[i][0] * v[i][0] + v[i][1] * v[i][1] + v[i][2] * v[i][2] + v[i][3] * v[i][3];
#pragma unroll
        for (int o = 32; o >= 1; o >>= 1) ss += __shfl_xor(ss, o);
        const float rstd = rsqrtf(ss * (1.0f / DM) + EPS);
        if (MODE == 2) {
            float* dst = p.out + O_Y + (size_t)row * DM;
#pragma unroll
            for (int i = 0; i < 8; ++i) { const f32x4 g = *(const f32x4*)(gain + i * 256 + lane * 4); *(f32x4*)(dst + i * 256 + lane * 4) = v[i] * rstd * g; }
        } else {
            const float* sh = mod + (size_t)bidx_of_row(row) * MODW + (MODE == 0 ? 0 : 6144); const float* sc = sh + 2048;
#pragma unroll
            for (int i = 0; i < 8; ++i) { const int c = i * 256 + lane * 4; const f32x4 g = *(const f32x4*)(gain + c), s1 = *(const f32x4*)(sc + c), s0 = *(const f32x4*)(sh + c);
                const f32x4 y = (v[i] * rstd * g) * (1.0f + s1) + s0; u32x2 w; w.x = pk2(y[0], y[1]); w.y = pk2(y[2], y[3]); *(u32x2*)(U + (size_t)row * DM + c) = w; }
        }
    }
}

template <int NTOK, bool SMP>
__device__ __forceinline__ void mixer_item(const Params& p, int it) {
    const int tid = threadIdx.x;
    const bf16_t* proj = (const bf16_t*)(p.ws + WS_PROJ);
    bf16_t* qn = (bf16_t*)(p.ws + WS_QN); bf16_t* kn = (bf16_t*)(p.ws + WS_KN); bf16_t* vv = (bf16_t*)(p.ws + WS_VV); bf16_t* yp = (bf16_t*)(p.ws + WS_YP);
    float* gbuf = (float*)(p.ws + WS_G); float* bbuf = (float*)(p.ws + WS_BETA);
    const int sb = it - 512;
    const int b = SMP ? 0 : (it >> 7), t0 = SMP ? 0 : (it & 127) * 16;
    const int rowbase = SMP ? TP + sb * 4 : b * 2048 + t0;
    if (tid < 384) {
        const int c0 = tid * 8;
        float w0[8], w1[8], w2[8], w3[8], xm3[8], xm2[8], xm1[8];
        const float* cw = p.in[11];
#pragma unroll
        for (int i = 0; i < 8; ++i) { w0[i] = cw[c0 + i]; w1[i] = cw[3072 + c0 + i]; w2[i] = cw[6144 + c0 + i]; w3[i] = cw[9216 + c0 + i]; }
        if (SMP) { const float* sc = p.in[5] + (size_t)sb * 3 * 3072 + c0;
#pragma unroll
            for (int i = 0; i < 8; ++i) { xm3[i] = sc[i]; xm2[i] = sc[3072 + i]; xm1[i] = sc[6144 + i]; }
        } else if (t0 == 0) {
#pragma unroll
            for (int i = 0; i < 8; ++i) { xm3[i] = 0.f; xm2[i] = 0.f; xm1[i] = 0.f; }
        } else {
            unpack8(*(const u32x4*)(proj + (size_t)(rowbase - 3) * NPROJ + c0), xm3); unpack8(*(const u32x4*)(proj + (size_t)(rowbase - 2) * NPROJ + c0), xm2); unpack8(*(const u32x4*)(proj + (size_t)(rowbase - 1) * NPROJ + c0), xm1);
        }
        constexpr int CH = NTOK < 8 ? NTOK : 8;
#pragma unroll 1
        for (int tc = 0; tc < NTOK; tc += CH) {
        u32x4 xr[CH];
#pragma unroll
        for (int t = 0; t < CH; ++t) xr[t] = *(const u32x4*)(proj + (size_t)(rowbase + tc + t) * NPROJ + c0);
#pragma unroll
        for (int t2 = 0; t2 < CH; ++t2) {
            const int t = tc + t2;
            const int row = rowbase + t; float xt[8], y[8];
            unpack8(xr[t2], xt);
            float ss = 0.f;
#pragma unroll
            for (int i = 0; i < 8; ++i) { const float a = w0[i] * xm3[i] + w1[i] * xm2[i] + w2[i] * xm1[i] + w3[i] * xt[i]; y[i] = siluf_(a); ss += y[i] * y[i]; }
            if (c0 < 2048) {
                ss += __shfl_xor(ss, 1); ss += __shfl_xor(ss, 2); ss += __shfl_xor(ss, 4); ss += __shfl_xor(ss, 8);
                const float inv = rsqrtf(ss + EPS);
#pragma unroll
                for (int i = 0; i < 8; ++i) y[i] *= inv;
            }
            bf16_t* dst = c0 < 1024 ? qn + (size_t)row * 1024 + c0 : (c0 < 2048 ? kn + (size_t)row * 1024 + (c0 - 1024) : vv + (size_t)row * 1024 + (c0 - 2048));
            *(u32x4*)dst = pack8(y);
            if (SMP) { if (t >= 1) { float* o = p.out + O_CS + ((size_t)sb * 3 + (t - 1)) * 3072 + c0; *(f32x4*)o = (f32x4){xt[0], xt[1], xt[2], xt[3]}; *(f32x4*)(o + 4) = (f32x4){xt[4], xt[5], xt[6], xt[7]}; } }
            else if (t0 + t >= 2045) { float* o = p.out + O_CP + ((size_t)b * 3 + (t0 + t - 2045)) * 3072 + c0; *(f32x4*)o = (f32x4){xt[0], xt[1], xt[2], xt[3]}; *(f32x4*)(o + 4) = (f32x4){xt[4], xt[5], xt[6], xt[7]}; }
#pragma unroll
            for (int i = 0; i < 8; ++i) { xm3[i] = xm2[i]; xm2[i] = xm1[i]; xm1[i] = xt[i]; }
        }
        }
    } else {
        const int pc = (tid - 384) * 8, gi = pc >> 8, w = 2 << gi;
        const int seqrow0 = SMP ? TP + sb * 4 : b * 2048;
        const float* sp = p.in[6] + (size_t)sb * 15 * 1024 + pc;
        auto xpool = [&](int tt, float* f) {
            if (tt >= 0) unpack8(*(const u32x4*)(proj + (size_t)(seqrow0 + tt) * NPROJ + C_XP + pc), f);
            else if (SMP) { const float* s = sp + (size_t)(15 + tt) * 1024;
#pragma unroll
                for (int i = 0; i < 8; ++i) f[i] = s[i]; }
            else {
#pragma unroll
                for (int i = 0; i < 8; ++i) f[i] = 0.f; }
        };
        float s[8];
#pragma unroll
        for (int i = 0; i < 8; ++i) s[i] = 0.f;
#pragma unroll
        for (int q = 1; q < 16; ++q) if (q < w) { float f[8]; xpool(t0 - q, f);
#pragma unroll
            for (int i = 0; i < 8; ++i) s[i] += f[i]; }
#pragma unroll 4
        for (int t = 0; t < NTOK; ++t) {
            const int tt = t0 + t; float x[8], y[8], f[8];
            xpool(tt, x);
            const float cnt = SMP ? (float)w : (float)min(w, tt + 1); const float ic = 1.0f / cnt;
#pragma unroll
            for (int i = 0; i < 8; ++i) { s[i] += x[i]; y[i] = s[i] * ic - x[i]; }
            *(u32x4*)(yp + (size_t)(seqrow0 + tt) * 1024 + pc) = pack8(y);
            xpool(tt - w + 1, f);
#pragma unroll
            for (int i = 0; i < 8; ++i) s[i] -= f[i];
            if (SMP) { float* o = p.out + O_PS + ((size_t)sb * 15 + 11 + t) * 1024 + pc; *(f32x4*)o = (f32x4){x[0], x[1], x[2], x[3]}; *(f32x4*)(o + 4) = (f32x4){x[4], x[5], x[6], x[7]}; }
            else if (tt >= 2033) { float* o = p.out + O_PP + ((size_t)b * 15 + (tt - 2033)) * 1024 + pc; *(f32x4*)o = (f32x4){x[0], x[1], x[2], x[3]}; *(f32x4*)(o + 4) = (f32x4){x[4], x[5], x[6], x[7]}; }
        }
        if (SMP) {
#pragma unroll
            for (int r = 0; r < 11; ++r) { const float* s2 = sp + (size_t)(4 + r) * 1024; float* o = p.out + O_PS + ((size_t)sb * 15 + r) * 1024 + pc; *(f32x4*)o = *(const f32x4*)s2; *(f32x4*)(o + 4) = *(const f32x4*)(s2 + 4); } }
    }
    if (tid < 256) { const int tk = tid >> 4, jj = tid & 15;
        if (tk < NTOK) { const int row = rowbase + tk; const float val = bf2f(proj[(size_t)row * NPROJ + C_AB + jj]);
            if (jj < 8) { const float xx = val + p.in[13][jj]; const float spl = xx > 20.f ? xx : log1pf(__expf(xx)); gbuf[row * 8 + jj] = -__expf(p.in[12][jj]) * spl; }
            else bbuf[row * 8 + (jj - 8)] = sigmoidf_(val); } }
}
__device__ __forceinline__ void mixer_prep_phase(const Params& p, int bid, int nblk) {
    for (int it = bid; it < 640; it += nblk) { if (it >= 512) mixer_item<4, true>(p, it); else mixer_item<16, false>(p, it); }
}

constexpr int P5_QS = 0, P5_KS = 17408, P5_VS = 34816, P5_MM = 52224, P5_DEC = 68608, P5_BETA = 68864;
__device__ __forceinline__ void chunk_prep_phase(const Params& p, int bid, int nblk, LAS unsigned char* lds) {
    const int tid = threadIdx.x, lane = tid & 63, wid = tid >> 6;
    const bf16_t* qn = (const bf16_t*)(p.ws + WS_QN); const bf16_t* kn = (const bf16_t*)(p.ws + WS_KN); const bf16_t* vv = (const bf16_t*)(p.ws + WS_VV);
    const float* gbuf = (const float*)(p.ws + WS_G); const float* bbuf = (const float*)(p.ws + WS_BETA);
    bf16_t* wdc = (bf16_t*)(p.ws + WS_WDC); bf16_t* qd = (bf16_t*)(p.ws + WS_QD); bf16_t* kt = (bf16_t*)(p.ws + WS_KT); bf16_t* qk = (bf16_t*)(p.ws + WS_QK);
    float* cdv = (float*)(p.ws + WS_CD); float* ub = p.out + OS_UB;
    LAS float* Mm = (LAS float*)(lds + P5_MM); LAS float* dec = (LAS float*)(lds + P5_DEC); LAS float* bet = (LAS float*)(lds + P5_BETA);
    const float scale = 0.08838834764831845f;
    for (int item = bid; item < 1024; item += nblk) {
        const int n = item & 31, bh = item >> 5, h = bh & 7, b = bh >> 3;
        const int r0 = b * 2048 + n * 64;
        __syncthreads();
#pragma unroll
        for (int i = 0; i < 2; ++i) { const int ch = tid + 512 * i, r = ch >> 4, c8 = (ch & 15) * 8; const size_t go = (size_t)(r0 + r) * 1024 + h * 128 + c8; const int lo = r * 272 + c8 * 2;
            *(LAS u32x4*)(lds + P5_QS + lo) = *(const u32x4*)(qn + go); *(LAS u32x4*)(lds + P5_KS + lo) = *(const u32x4*)(kn + go); *(LAS u32x4*)(lds + P5_VS + lo) = *(const u32x4*)(vv + go); }
        if (tid < 64) {
            float g = gbuf[(r0 + tid) * 8 + h];
#pragma unroll
            for (int o = 1; o < 64; o <<= 1) { const float t = __shfl_up(g, o); if (lane >= o) g += t; }
            dec[tid] = g;
        } else if (tid < 128) bet[tid - 64] = bbuf[(r0 + tid - 64) * 8 + h];
        __syncthreads();
        const float last = dec[63];
        {
            const int mat = wid >> 2, rt = wid & 3, fr = lane & 15, fq = lane >> 4;
            bf16x8 a[4];
#pragma unroll
            for (int kk = 0; kk < 4; ++kk) a[kk] = *(const LAS bf16x8*)(lds + (mat ? P5_QS : P5_KS) + (rt * 16 + fr) * 272 + (kk * 32 + fq * 8) * 2);
#pragma unroll
            for (int st = 0; st < 4; ++st) {
                f32x4 d = (f32x4){0.f, 0.f, 0.f, 0.f};
#pragma unroll
                for (int kk = 0; kk < 4; ++kk) { const bf16x8 bb = *(const LAS bf16x8*)(lds + P5_KS + (st * 16 + fr) * 272 + (kk * 32 + fq * 8) * 2); d = __builtin_amdgcn_mfma_f32_16x16x32_bf16(a[kk], bb, d, 0, 0, 0); }
                const int s = st * 16 + fr; const float ds = dec[s];
#pragma unroll
                for (int j = 0; j < 4; ++j) { const int r = rt * 16 + fq * 4 + j; const float dr = dec[r];
                    if (mat == 0) Mm[r * 64 + s] = (r > s) ? bet[r] * d[j] * __expf(dr - ds) : 0.f;
                    else qk[(size_t)item * 4096 + r * 64 + s] = f2bf((r >= s) ? scale * d[j] * __expf(dr - ds) : 0.f); }
            }
        }
        __syncthreads();
        if (tid < 256) {
            const int c = tid; float x[64];
            if (c < 128) {
#pragma unroll
                for (int r = 0; r < 64; ++r) x[r] = bf2f(*(const LAS bf16_t*)(lds + P5_VS + r * 272 + c * 2)) * bet[r];
            } else {
#pragma unroll
                for (int r = 0; r < 64; ++r) x[r] = bf2f(*(const LAS bf16_t*)(lds + P5_KS + r * 272 + (c - 128) * 2)) * bet[r] * __expf(dec[r]);
            }
            f32x4 mq[12]; float a0, a1;
            mq[0] = *(const LAS f32x4*)(Mm + 64); mq[1] = *(const LAS f32x4*)(Mm + 128); mq[2] = *(const LAS f32x4*)(Mm + 192); mq[3] = *(const LAS f32x4*)(Mm + 256); mq[4] = *(const LAS f32x4*)(Mm + 320); mq[5] = *(const LAS f32x4*)(Mm + 324); mq[6] = *(const LAS f32x4*)(Mm + 384); mq[7] = *(const LAS f32x4*)(Mm + 388); mq[8] = *(const LAS f32x4*)(Mm + 448); mq[9] = *(const LAS f32x4*)(Mm + 452); mq[10] = *(const LAS f32x4*)(Mm + 512); mq[11] = *(const LAS f32x4*)(Mm + 516);
            a0 = x[1]; a1 = 0.f; a0 -= mq[0][0] * x[0]; x[1] = a0 + a1; mq[0] = *(const LAS f32x4*)(Mm + 576);
            a0 = x[2]; a1 = 0.f; a0 -= mq[1][0] * x[0]; a1 -= mq[1][1] * x[1]; x[2] = a0 + a1; mq[1] = *(const LAS f32x4*)(Mm + 580);
            a0 = x[3]; a1 = 0.f; a0 -= mq[2][0] * x[0]; a1 -= mq[2][1] * x[1]; a0 -= mq[2][2] * x[2]; x[3] = a0 + a1; mq[2] = *(const LAS f32x4*)(Mm + 584);
            a0 = x[4]; a1 = 0.f; a0 -= mq[3][0] * x[0]; a1 -= mq[3][1] * x[1]; a0 -= mq[3][2] * x[2]; a1 -= mq[3][3] * x[3]; x[4] = a0 + a1; mq[3] = *(const LAS f32x4*)(Mm + 640);
            a0 = x[5]; a1 = 0.f; a0 -= mq[4][0] * x[0]; a1 -= mq[4][1] * x[1]; a0 -= mq[4][2] * x[2]; a1 -= mq[4][3] * x[3]; mq[4] = *(const LAS f32x4*)(Mm + 644);
            a0 -= mq[5][0] * x[4]; x[5] = a0 + a1; mq[5] = *(const LAS f32x4*)(Mm + 648);
            a0 = x[6]; a1 = 0.f; a0 -= mq[6][0] * x[0]; a1 -= mq[6][1] * x[1]; a0 -= mq[6][2] * x[2]; a1 -= mq[6][3] * x[3]; mq[6] = *(const LAS f32x4*)(Mm + 704);
            a0 -= mq[7][0] * x[4]; a1 -= mq[7][1] * x[5]; x[6] = a0 + a1; mq[7] = *(const LAS f32x4*)(Mm + 708);
            a0 = x[7]; a1 = 0.f; a0 -= mq[8][0] * x[0]; a1 -= mq[8][1] * x[1]; a0 -= mq[8][2] * x[2]; a1 -= mq[8][3] * x[3]; mq[8] = *(const LAS f32x4*)(Mm + 712);
            a0 -= mq[9][0] * x[4]; a1 -= mq[9][1] * x[5]; a0 -= mq[9][2] * x[6]; x[7] = a0 + a1; mq[9] = *(const LAS f32x4*)(Mm + 768);
            a0 = x[8]; a1 = 0.f; a0 -= mq[10][0] * x[0]; a1 -= mq[10][1] * x[1]; a0 -= mq[10][2] * x[2]; a1 -= mq[10][3] * x[3]; mq[10] = *(const LAS f32x4*)(Mm + 772);
            a0 -= mq[11][0] * x[4]; a1 -= mq[11][1] * x[5]; a0 -= mq[11][2] * x[6]; a1 -= mq[11][3] * x[7]; x[8] = a0 + a1; mq[11] = *(const LAS f32x4*)(Mm + 776);
            a0 = x[9]; a1 = 0.f; a0 -= mq[0][0] * x[0]; a1 -= mq[0][1] * x[1]; a0 -= mq[0][2] * x[2]; a1 -= mq[0][3] * x[3]; mq[0] = *(const LAS f32x4*)(Mm + 832);
            a0 -= mq[1][0] * x[4]; a1 -= mq[1][1] * x[5]; a0 -= mq[1][2] * x[6]; a1 -= mq[1][3] * x[7]; mq[1] = *(const LAS f32x4*)(Mm + 836);
            a0 -= mq[2][0] * x[8]; x[9] = a0 + a1; mq[2] = *(const LAS f32x4*)(Mm + 840);
            a0 = x[10]; a1 = 0.f; a0 -= mq[3][0] * x[0]; a1 -= mq[3][1] * x[1]; a0 -= mq[3][2] * x[2]; a1 -= mq[3][3] * x[3]; mq[3] = *(const LAS f32x4*)(Mm + 844);
            a0 -= mq[4][0] * x[4]; a1 -= mq[4][1] * x[5]; a0 -= mq[4][2] * x[6]; a1 -= mq[4][3] * x[7]; mq[4] = *(const LAS f32x4*)(Mm + 896);
            a0 -= mq[5][0] * x[8]; a1 -= mq[5][1] * x[9]; x[10] = a0 + a1; mq[5] = *(const LAS f32x4*)(Mm + 900);
            a0 = x[11]; a1 = 0.f; a0 -= mq[6][0] * x[0]; a1 -= mq[6][1] * x[1]; a0 -= mq[6][2] * x[2]; a1 -= mq[6][3] * x[3]; mq[6] = *(const LAS f32x4*)(Mm + 904);
            a0 -= mq[7][0] * x[4]; a1 -= mq[7][1] * x[5]; a0 -= mq[7][2] * x[6]; a1 -= mq[7][3] * x[7]; mq[7] = *(const LAS f32x4*)(Mm + 908);
            a0 -= mq[8][0] * x[8]; a1 -= mq[8][1] * x[9]; a0 -= mq[8][2] * x[10]; x[11] = a0 + a1; mq[8] = *(const LAS f32x4*)(Mm + 960);
            a0 = x[12]; a1 = 0.f; a0 -= mq[9][0] * x[0]; a1 -= mq[9][1] * x[1]; a0 -= mq[9][2] * x[2]; a1 -= mq[9][3] * x[3]; mq[9] = *(const LAS f32x4*)(Mm + 964);
            a0 -= mq[10][0] * x[4]; a1 -= mq[10][1] * x[5]; a0 -= mq[10][2] * x[6]; a1 -= mq[10][3] * x[7]; mq[10] = *(const LAS f32x4*)(Mm + 968);
            a0 -= mq[11][0] * x[8]; a1 -= mq[11][1] * x[9]; a0 -= mq[11][2] * x[10]; a1 -= mq[11][3] * x[11]; x[12] = a0 + a1; mq[11] = *(const LAS f32x4*)(Mm + 972);
            a0 = x[13]; a1 = 0.f; a0 -= mq[0][0] * x[0]; a1 -= mq[0][1] * x[1]; a0 -= mq[0][2] * x[2]; a1 -= mq[0][3] * x[3]; mq[0] = *(const LAS f32x4*)(Mm + 1024);
            a0 -= mq[1][0] * x[4]; a1 -= mq[1][1] * x[5]; a0 -= mq[1][2] * x[6]; a1 -= mq[1][3] * x[7]; mq[1] = *(const LAS f32x4*)(Mm + 1028);
            a0 -= mq[2][0] * x[8]; a1 -= mq[2][1] * x[9]; a0 -= mq[2][2] * x[10]; a1 -= mq[2][3] * x[11]; mq[2] = *(const LAS f32x4*)(Mm + 1032);
            a0 -= mq[3][0] * x[12]; x[13] = a0 + a1; mq[3] = *(const LAS f32x4*)(Mm + 1036);
            a0 = x[14]; a1 = 0.f; a0 -= mq[4][0] * x[0]; a1 -= mq[4][1] * x[1]; a0 -= mq[4][2] * x[2]; a1 -= mq[4][3] * x[3]; mq[4] = *(const LAS f32x4*)(Mm + 1088);
            a0 -= mq[5][0] * x[4]; a1 -= mq[5][1] * x[5]; a0 -= mq[5][2] * x[6]; a1 -= mq[5][3] * x[7]; mq[5] = *(const LAS f32x4*)(Mm + 1092);
            a0 -= mq[6][0] * x[8]; a1 -= mq[6][1] * x[9]; a0 -= mq[6][2] * x[10]; a1 -= mq[6][3] * x[11]; mq[6] = *(const LAS f32x4*)(Mm + 1096);
            a0 -= mq[7][0] * x[12]; a1 -= mq[7][1] * x[13]; x[14] = a0 + a1; mq[7] = *(const LAS f32x4*)(Mm + 1100);
            a0 = x[15]; a1 = 0.f; a0 -= mq[8][0] * x[0]; a1 -= mq[8][1] * x[1]; a0 -= mq[8][2] * x[2]; a1 -= mq[8][3] * x[3]; mq[8] = *(const LAS f32x4*)(Mm + 1104);
            a0 -= mq[9][0] * x[4]; a1 -= mq[9][1] * x[5]; a0 -= mq[9][2] * x[6]; a1 -= mq[9][3] * x[7]; mq[9] = *(const LAS f32x4*)(Mm + 1152);
            a0 -= mq[10][0] * x[8]; a1 -= mq[10][1] * x[9]; a0 -= mq[10][2] * x[10]; a1 -= mq[10][3] * x[11]; mq[10] = *(const LAS f32x4*)(Mm + 1156);
            a0 -= mq[11][0] * x[12]; a1 -= mq[11][1] * x[13]; a0 -= mq[11][2] * x[14]; x[15] = a0 + a1; mq[11] = *(const LAS f32x4*)(Mm + 1160);
            a0 = x[16]; a1 = 0.f; a0 -= mq[0][0] * x[0]; a1 -= mq[0][1] * x[1]; a0 -= mq[0][2] * x[2]; a1 -= mq[0][3] * x[3]; mq[0] = *(const LAS f32x4*)(Mm + 1164);
            a0 -= mq[1][0] * x[4]; a1 -= mq[1][1] * x[5]; a0 -= mq[1][2] * x[6]; a1 -= mq[1][3] * x[7]; mq[1] = *(const LAS f32x4*)(Mm + 1168);
            a0 -= mq[2][0] * x[8]; a1 -= mq[2][1] * x[9]; a0 -= mq[2][2] * x[10]; a1 -= mq[2][3] * x[11]; mq[2] = *(const LAS f32x4*)(Mm + 1216);
            a0 -= mq[3][0] * x[12]; a1 -= mq[3][1] * x[13]; a0 -= mq[3][2] * x[14]; a1 -= mq[3][3] * x[15]; x[16] = a0 + a1; mq[3] = *(const LAS f32x4*)(Mm + 1220);
            a0 = x[17]; a1 = 0.f; a0 -= mq[4][0] * x[0]; a1 -= mq[4][1] * x[1]; a0 -= mq[4][2] * x[2]; a1 -= mq[4][3] * x[3]; mq[4] = *(const LAS f32x4*)(Mm + 1224);
            a0 -= mq[5][0] * x[4]; a1 -= mq[5][1] * x[5]; a0 -= mq[5][2] * x[6]; a1 -= mq[5][3] * x[7]; mq[5] = *(const LAS f32x4*)(Mm + 1228);
            a0 -= mq[6][0] * x[8]; a1 -= mq[6][1] * x[9]; a0 -= mq[6][2] * x[10]; a1 -= mq[6][3] * x[11]; mq[6] = *(const LAS f32x4*)(Mm + 1232);
            a0 -= mq[7][0] * x[12]; a1 -= mq[7][1] * x[13]; a0 -= mq[7][2] * x[14]; a1 -= mq[7][3] * x[15]; mq[7] = *(const LAS f32x4*)(Mm + 1280);
            a0 -= mq[8][0] * x[16]; x[17] = a0 + a1; mq[8] = *(const LAS f32x4*)(Mm + 1284);
            a0 = x[18]; a1 = 0.f; a0 -= mq[9][0] * x[0]; a1 -= mq[9][1] * x[1]; a0 -= mq[9][2] * x[2]; a1 -= mq[9][3] * x[3]; mq[9] = *(const LAS f32x4*)(Mm + 1288);
            a0 -= mq[10][0] * x[4]; a1 -= mq[10][1] * x[5]; a0 -= mq[10][2] * x[6]; a1 -= mq[10][3] * x[7]; mq[10] = *(const LAS f32x4*)(Mm + 1292);
            a0 -= mq[11][0] * x[8]; a1 -= mq[11][1] * x[9]; a0 -= mq[11][2] * x[10]; a1 -= mq[11][3] * x[11]; mq[11] = *(const LAS f32x4*)(Mm + 1296);
            a0 -= mq[0][0] * x[12]; a1 -= mq[0][1] * x[13]; a0 -= mq[0][2] * x[14]; a1 -= mq[0][3] * x[15]; mq[0] = *(const LAS f32x4*)(Mm + 1344);
            a0 -= mq[1][0] * x[16]; a1 -= mq[1][1] * x[17]; x[18] = a0 + a1; mq[1] = *(const LAS f32x4*)(Mm + 1348);
            a0 = x[19]; a1 = 0.f; a0 -= mq[2][0] * x[0]; a1 -= mq[2][1] * x[1]; a0 -= mq[2][2] * x[2]; a1 -= mq[2][3] * x[3]; mq[2] = *(const LAS f32x4*)(Mm + 1352);
            a0 -= mq[3][0] * x[4]; a1 -= mq[3][1] * x[5]; a0 -= mq[3][2] * x[6]; a1 -= mq[3][3] * x[7]; mq[3] = *(const LAS f32x4*)(Mm + 1356);
            a0 -= mq[4][0] * x[8]; a1 -= mq[4][1] * x[9]; a0 -= mq[4][2] * x[10]; a1 -= mq[4][3] * x[11]; mq[4] = *(const LAS f32x4*)(Mm + 1360);
            a0 -= mq[5][0] * x[12]; a1 -= mq[5][1] * x[13]; a0 -= mq[5][2] * x[14]; a1 -= mq[5][3] * x[15]; mq[5] = *(const LAS f32x4*)(Mm + 1364);
            a0 -= mq[6][0] * x[16]; a1 -= mq[6][1] * x[17]; a0 -= mq[6][2] * x[18]; x[19] = a0 + a1; mq[6] = *(const LAS f32x4*)(Mm + 1408);
            a0 = x[20]; a1 = 0.f; a0 -= mq[7][0] * x[0]; a1 -= mq[7][1] * x[1]; a0 -= mq[7][2] * x[2]; a1 -= mq[7][3] * x[3]; mq[7] = *(const LAS f32x4*)(Mm + 1412);
            a0 -= mq[8][0] * x[4]; a1 -= mq[8][1] * x[5]; a0 -= mq[8][2] * x[6]; a1 -= mq[8][3] * x[7]; mq[8] = *(const LAS f32x4*)(Mm + 1416);
            a0 -= mq[9][0] * x[8]; a1 -= mq[9][1] * x[9]; a0 -= mq[9][2] * x[10]; a1 -= mq[9][3] * x[11]; mq[9] = *(const LAS f32x4*)(Mm + 1420);
            a0 -= mq[10][0] * x[12]; a1 -= mq[10][1] * x[13]; a0 -= mq[10][2] * x[14]; a1 -= mq[10][3] * x[15]; mq[10] = *(const LAS f32x4*)(Mm + 1424);
            a0 -= mq[11][0] * x[16]; a1 -= mq[11][1] * x[17]; a0 -= mq[11][2] * x[18]; a1 -= mq[11][3] * x[19]; x[20] = a0 + a1; mq[11] = *(const LAS f32x4*)(Mm + 1428);
            a0 = x[21]; a1 = 0.f; a0 -= mq[0][0] * x[0]; a1 -= mq[0][1] * x[1]; a0 -= mq[0][2] * x[2]; a1 -= mq[0][3] * x[3]; mq[0] = *(const LAS f32x4*)(Mm + 1472);
            a0 -= mq[1][0] * x[4]; a1 -= mq[1][1] * x[5]; a0 -= mq[1][2] * x[6]; a1 -= mq[1][3] * x[7]; mq[1] = *(const LAS f32x4*)(Mm + 1476);
            a0 -= mq[2][0] * x[8]; a1 -= mq[2][1] * x[9]; a0 -= mq[2][2] * x[10]; a1 -= mq[2][3] * x[11]; mq[2] = *(const LAS f32x4*)(Mm + 1480);
            a0 -= mq[3][0] * x[12]; a1 -= mq[3][1] * x[13]; a0 -= mq[3][2] * x[14]; a1 -= mq[3][3] * x[15]; mq[3] = *(const LAS f32x4*)(Mm + 1484);
            a0 -= mq[4][0] * x[16]; a1 -= mq[4][1] * x[17]; a0 -= mq[4][2] * x[18]; a1 -= mq[4][3] * x[19]; mq[4] = *(const LAS f32x4*)(Mm + 1488);
            a0 -= mq[5][0] * x[20]; x[21] = a0 + a1; mq[5] = *(const LAS f32x4*)(Mm + 1492);
            a0 = x[22]; a1 = 0.f; a0 -= mq[6][0] * x[0]; a1 -= mq[6][1] * x[1]; a0 -= mq[6][2] * x[2]; a1 -= mq[6][3] * x[3]; mq[6] = *(const LAS f32x4*)(Mm + 1536);
            a0 -= mq[7][0] * x[4]; a1 -= mq[7][1] * x[5]; a0 -= mq[7][2] * x[6]; a1 -= mq[7][3] * x[7]; mq[7] = *(const LAS f32x4*)(Mm + 1540);
            a0 -= mq[8][0] * x[8]; a1 -= mq[8][1] * x[9]; a0 -= mq[8][2] * x[10]; a1 -= mq[8][3] * x[11]; mq[8] = *(const LAS f32x4*)(Mm + 1544);
            a0 -= mq[9][0] * x[12]; a1 -= mq[9][1] * x[13]; a0 -= mq[9][2] * x[14]; a1 -= mq[9][3] * x[15]; mq[9] = *(const LAS f32x4*)(Mm + 1548);
            a0 -= mq[10][0] * x[16]; a1 -= mq[10][1] * x[17]; a0 -= mq[10][2] * x[18]; a1 -= mq[10][3] * x[19]; mq[10] = *(const LAS f32x4*)(Mm + 1552);
            a0 -= mq[11][0] * x[20]; a1 -= mq[11][1] * x[21]; x[22] = a0 + a1; mq[11] = *(const LAS f32x4*)(Mm + 1556);
            a0 = x[23]; a1 = 0.f; a0 -= mq[0][0] * x[0]; a1 -= mq[0][1] * x[1]; a0 -= mq[0][2] * x[2]; a1 -= mq[0][3] * x[3]; mq[0] = *(const LAS f32x4*)(Mm + 1600);
            a0 -= mq[1][0] * x[4]; a1 -= mq[1][1] * x[5]; a0 -= mq[1][2] * x[6]; a1 -= mq[1][3] * x[7]; mq[1] = *(const LAS f32x4*)(Mm + 1604);
            a0 -= mq[2][0] * x[8]; a1 -= mq[2][1] * x[9]; a0 -= mq[2][2] * x[10]; a1 -= mq[2][3] * x[11]; mq[2] = *(const LAS f32x4*)(Mm + 1608);
            a0 -= mq[3][0] * x[12]; a1 -= mq[3][1] * x[13]; a0 -= mq[3][2] * x[14]; a1 -= mq[3][3] * x[15]; mq[3] = *(const LAS f32x4*)(Mm + 1612);
            a0 -= mq[4][0] * x[16]; a1 -= mq[4][1] * x[17]; a0 -= mq[4][2] * x[18]; a1 -= mq[4][3] * x[19]; mq[4] = *(const LAS f32x4*)(Mm + 1616);
            a0 -= mq[5][0] * x[20]; a1 -= mq[5][1] * x[21]; a0 -= mq[5][2] * x[22]; x[23] = a0 + a1; mq[5] = *(const LAS f32x4*)(Mm + 1620);
            a0 = x[24]; a1 = 0.f; a0 -= mq[6][0] * x[0]; a1 -= mq[6][1] * x[1]; a0 -= mq[6][2] * x[2]; a1 -= mq[6][3] * x[3]; mq[6] = *(const LAS f32x4*)(Mm + 1624);
            a0 -= mq[7][0] * x[4]; a1 -= mq[7][1] * x[5]; a0 -= mq[7][2] * x[6]; a1 -= mq[7][3] * x[7]; mq[7] = *(const LAS f32x4*)(Mm + 1664);
            a0 -= mq[8][0] * x[8]; a1 -= mq[8][1] * x[9]; a0 -= mq[8][2] * x[10]; a1 -= mq[8][3] * x[11]; mq[8] = *(const LAS f32x4*)(Mm + 1668);
            a0 -= mq[9][0] * x[12]; a1 -= mq[9][1] * x[13]; a0 -= mq[9][2] * x[14]; a1 -= mq[9][3] * x[15]; mq[9] = *(const LAS f32x4*)(Mm + 1672);
            a0 -= mq[10][0] * x[16]; a1 -= mq[10][1] * x[17]; a0 -= mq[10][2] * x[18]; a1 -= mq[10][3] * x[19]; mq[10] = *(const LAS f32x4*)(Mm + 1676);
            a0 -= mq[11][0] * x[20]; a1 -= mq[11][1] * x[21]; a0 -= mq[11][2] * x[22]; a1 -= mq[11][3] * x[23]; x[24] = a0 + a1; mq[11] = *(const LAS f32x4*)(Mm + 1680);
            a0 = x[25]; a1 = 0.f; a0 -= mq[0][0] * x[0]; a1 -= mq[0][1] * x[1]; a0 -= mq[0][2] * x[2]; a1 -= mq[0][3] * x[3]; mq[0] = *(const LAS f32x4*)(Mm + 1684);
            a0 -= mq[1][0] * x[4]; a1 -= mq[1][1] * x[5]; a0 -= mq[1][2] * x[6]; a1 -= mq[1][3] * x[7]; mq[1] = *(const LAS f32x4*)(Mm + 1688);
            a0 -= mq[2][0] * x[8]; a1 -= mq[2][1] * x[9]; a0 -= mq[2][2] * x[10]; a1 -= mq[2][3] * x[11]; mq[2] = *(const LAS f32x4*)(Mm + 1728);
            a0 -= mq[3][0] * x[12]; a1 -= mq[3][1] * x[13]; a0 -= mq[3][2] * x[14]; a1 -= mq[3][3] * x[15]; mq[3] = *(const LAS f32x4*)(Mm + 1732);
            a0 -= mq[4][0] * x[16]; a1 -= mq[4][1] * x[17]; a0 -= mq[4][2] * x[18]; a1 -= mq[4][3] * x[19]; mq[4] = *(const LAS f32x4*)(Mm + 1736);
            a0 -= mq[5][0] * x[20]; a1 -= mq[5][1] * x[21]; a0 -= mq[5][2] * x[22]; a1 -= mq[5][3] * x[23]; mq[5] = *(const LAS f32x4*)(Mm + 1740);
            a0 -= mq[6][0] * x[24]; x[25] = a0 + a1; mq[6] = *(const LAS f32x4*)(Mm + 1744);
            a0 = x[26]; a1 = 0.f; a0 -= mq[7][0] * x[0]; a1 -= mq[7][1] * x[1]; a0 -= mq[7][2] * x[2]; a1 -= mq[7][3] * x[3]; mq[7] = *(const LAS f32x4*)(Mm + 1748);
            a0 -= mq[8][0] * x[4]; a1 -= mq[8][1] * x[5]; a0 -= mq[8][2] * x[6]; a1 -= mq[8][3] * x[7]; mq[8] = *(const LAS f32x4*)(Mm + 1752);
            a0 -= mq[9][0] * x[8]; a1 -= mq[9][1] * x[9]; a0 -= mq[9][2] * x[10]; a1 -= mq[9][3] * x[11]; mq[9] = *(const LAS f32x4*)(Mm + 1792);
            a0 -= mq[10][0] * x[12]; a1 -= mq[10][1] * x[13]; a0 -= mq[10][2] * x[14]; a1 -= mq[10][3] * x[15]; mq[10] = *(const LAS f32x4*)(Mm + 1796);
            a0 -= mq[11][0] * x[16]; a1 -= mq[11][1] * x[17]; a0 -= mq[11][2] * x[18]; a1 -= mq[11][3] * x[19]; mq[11] = *(const LAS f32x4*)(Mm + 1800);
            a0 -= mq[0][0] * x[20]; a1 -= mq[0][1] * x[21]; a0 -= mq[0][2] * x[22]; a1 -= mq[0][3] * x[23]; mq[0] = *(const LAS f32x4*)(Mm + 1804);
            a0 -= mq[1][0] * x[24]; a1 -= mq[1][1] * x[25]; x[26] = a0 + a1; mq[1] = *(const LAS f32x4*)(Mm + 1808);
            a0 = x[27]; a1 = 0.f; a0 -= mq[2][0] * x[0]; a1 -= mq[2][1] * x[1]; a0 -= mq[2][2] * x[2]; a1 -= mq[2][3] * x[3]; mq[2] = *(const LAS f32x4*)(Mm + 1812);
            a0 -= mq[3][0] * x[4]; a1 -= mq[3][1] * x[5]; a0 -= mq[3][2] * x[6]; a1 -= mq[3][3] * x[7]; mq[3] = *(const LAS f32x4*)(Mm + 1816);
            a0 -= mq[4][0] * x[8]; a1 -= mq[4][1] * x[9]; a0 -= mq[4][2] * x[10]; a1 -= mq[4][3] * x[11]; mq[4] = *(const LAS f32x4*)(Mm + 1856);
            a0 -= mq[5][0] * x[12]; a1 -= mq[5][1] * x[13]; a0 -= mq[5][2] * x[14]; a1 -= mq[5][3] * x[15]; mq[5] = *(const LAS f32x4*)(Mm + 1860);
            a0 -= mq[6][0] * x[16]; a1 -= mq[6][1] * x[17]; a0 -= mq[6][2] * x[18]; a1 -= mq[6][3] * x[19]; mq[6] = *(const LAS f32x4*)(Mm + 1864);
            a0 -= mq[7][0] * x[20]; a1 -= mq[7][1] * x[21]; a0 -= mq[7][2] * x[22]; a1 -= mq[7][3] * x[23]; mq[7] = *(const LAS f32x4*)(Mm + 1868);
            a0 -= mq[8][0] * x[24]; a1 -= mq[8][1] * x[25]; a0 -= mq[8][2] * x[26]; x[27] = a0 + a1; mq[8] = *(const LAS f32x4*)(Mm + 1872);
            a0 = x[28]; a1 = 0.f; a0 -= mq[9][0] * x[0]; a1 -= mq[9][1] * x[1]; a0 -= mq[9][2] * x[2]; a1 -= mq[9][3] * x[3]; mq[9] = *(const LAS f32x4*)(Mm + 1876);
            a0 -= mq[10][0] * x[4]; a1 -= mq[10][1] * x[5]; a0 -= mq[10][2] * x[6]; a1 -= mq[10][3] * x[7]; mq[10] = *(const LAS f32x4*)(Mm + 1880);
            a0 -= mq[11][0] * x[8]; a1 -= mq[11][1] * x[9]; a0 -= mq[11][2] * x[10]; a1 -= mq[11][3] * x[11]; mq[11] = *(const LAS f32x4*)(Mm + 1884);
            a0 -= mq[0][0] * x[12]; a1 -= mq[0][1] * x[13]; a0 -= mq[0][2] * x[14]; a1 -= mq[0][3] * x[15]; mq[0] = *(const LAS f32x4*)(Mm + 1920);
            a0 -= mq[1][0] * x[16]; a1 -= mq[1][1] * x[17]; a0 -= mq[1][2] * x[18]; a1 -= mq[1][3] * x[19]; mq[1] = *(const LAS f32x4*)(Mm + 1924);
            a0 -= mq[2][0] * x[20]; a1 -= mq[2][1] * x[21]; a0 -= mq[2][2] * x[22]; a1 -= mq[2][3] * x[23]; mq[2] = *(const LAS f32x4*)(Mm + 1928);
            a0 -= mq[3][0] * x[24]; a1 -= mq[3][1] * x[25]; a0 -= mq[3][2] * x[26]; a1 -= mq[3][3] * x[27]; x[28] = a0 + a1; mq[3] = *(const LAS f32x4*)(Mm + 1932);
            a0 = x[29]; a1 = 0.f; a0 -= mq[4][0] * x[0]; a1 -= mq[4][1] * x[1]; a0 -= mq[4][2] * x[2]; a1 -= mq[4][3] * x[3]; mq[4] = *(const LAS f32x4*)(Mm + 1936);
            a0 -= mq[5][0] * x[4]; a1 -= mq[5][1] * x[5]; a0 -= mq[5][2] * x[6]; a1 -= mq[5][3] * x[7]; mq[5] = *(const LAS f32x4*)(Mm + 1940);
            a0 -= mq[6][0] * x[8]; a1 -= mq[6][1] * x[9]; a0 -= mq[6][2] * x[10]; a1 -= mq[6][3] * x[11]; mq[6] = *(const LAS f32x4*)(Mm + 1944);
            a0 -= mq[7][0] * x[12]; a1 -= mq[7][1] * x[13]; a0 -= mq[7][2] * x[14]; a1 -= mq[7][3] * x[15]; mq[7] = *(const LAS f32x4*)(Mm + 1948);
            a0 -= mq[8][0] * x[16]; a1 -= mq[8][1] * x[17]; a0 -= mq[8][2] * x[18]; a1 -= mq[8][3] * x[19]; mq[8] = *(const LAS f32x4*)(Mm + 1984);
            a0 -= mq[9][0] * x[20]; a1 -= mq[9][1] * x[21]; a0 -= mq[9][2] * x[22]; a1 -= mq[9][3] * x[23]; mq[9] = *(const LAS f32x4*)(Mm + 1988);
            a0 -= mq[10][0] * x[24]; a1 -= mq[10][1] * x[25]; a0 -= mq[10][2] * x[26]; a1 -= mq[10][3] * x[27]; mq[10] = *(const LAS f32x4*)(Mm + 1992);
            a0 -= mq[11][0] * x[28]; x[29] = a0 + a1; mq[11] = *(const LAS f32x4*)(Mm + 1996);
            a0 = x[30]; a1 = 0.f; a0 -= mq[0][0] * x[0]; a1 -= mq[0][1] * x[1]; a0 -= mq[0][2] * x[2]; a1 -= mq[0][3] * x[3]; mq[0] = *(const LAS f32x4*)(Mm + 2000);
            a0 -= mq[1][0] * x[4]; a1 -= mq[1][1] * x[5]; a0 -= mq[1][2] * x[6]; a1 -= mq[1][3] * x[7]; mq[1] = *(const LAS f32x4*)(Mm + 2004);
            a0 -= mq[2][0] * x[8]; a1 -= mq[2][1] * x[9]; a0 -= mq[2][2] * x[10]; a1 -= mq[2][3] * x[11]; mq[2] = *(const LAS f32x4*)(Mm + 2008);
            a0 -= mq[3][0] * x[12]; a1 -= mq[3][1] * x[13]; a0 -= mq[3][2] * x[14]; a1 -= mq[3][3] * x[15]; mq[3] = *(const LAS f32x4*)(Mm + 2012);
            a0 -= mq[4][0] * x[16]; a1 -= mq[4][1] * x[17]; a0 -= mq[4][2] * x[18]; a1 -= mq[4][3] * x[19]; mq[4] = *(const LAS f32x4*)(Mm + 2048);
            a0 -= mq[5][0] * x[20]; a1 -= mq[5][1] * x[21]; a0 -= mq[5][2] * x[22]; a1 -= mq[5][3] * x[23]; mq[5] = *(const LAS f32x4*)(Mm + 2052);
            a0 -= mq[6][0] * x[24]; a1 -= mq[6][1] * x[25]; a0 -= mq[6][2] * x[26]; a1 -= mq[6][3] * x[27]; mq[6] = *(const LAS f32x4*)(Mm + 2056);
            a0 -= mq[7][0] * x[28]; a1 -= mq[7][1] * x[29]; x[30] = a0 + a1; mq[7] = *(const LAS f32x4*)(Mm + 2060);
            a0 = x[31]; a1 = 0.f; a0 -= mq[8][0] * x[0]; a1 -= mq[8][1] * x[1]; a0 -= mq[8][2] * x[2]; a1 -= mq[8][3] * x[3]; mq[8] = *(const LAS f32x4*)(Mm + 2064);
            a0 -= mq[9][0] * x[4]; a1 -= mq[9][1] * x[5]; a0 -= mq[9][2] * x[6]; a1 -= mq[9][3] * x[7]; mq[9] = *(const LAS f32x4*)(Mm + 2068);
            a0 -= mq[10][0] * x[8]; a1 -= mq[10][1] * x[9]; a0 -= mq[10][2] * x[10]; a1 -= mq[10][3] * x[11]; mq[10] = *(const LAS f32x4*)(Mm + 2072);
            a0 -= mq[11][0] * x[12]; a1 -= mq[11][1] * x[13]; a0 -= mq[11][2] * x[14]; a1 -= mq[11][3] * x[15]; mq[11] = *(const LAS f32x4*)(Mm + 2076);
            a0 -= mq[0][0] * x[16]; a1 -= mq[0][1] * x[17]; a0 -= mq[0][2] * x[18]; a1 -= mq[0][3] * x[19]; mq[0] = *(const LAS f32x4*)(Mm + 2112);
            a0 -= mq[1][0] * x[20]; a1 -= mq[1][1] * x[21]; a0 -= mq[1][2] * x[22]; a1 -= mq[1][3] * x[23]; mq[1] = *(const LAS f32x4*)(Mm + 2116);
            a0 -= mq[2][0] * x[24]; a1 -= mq[2][1] * x[25]; a0 -= mq[2][2] * x[26]; a1 -= mq[2][3] * x[27]; mq[2] = *(const LAS f32x4*)(Mm + 2120);
            a0 -= mq[3][0] * x[28]; a1 -= mq[3][1] * x[29]; a0 -= mq[3][2] * x[30]; x[31] = a0 + a1; mq[3] = *(const LAS f32x4*)(Mm + 2124);
            a0 = x[32]; a1 = 0.f; a0 -= mq[4][0] * x[0]; a1 -= mq[4][1] * x[1]; a0 -= mq[4][2] * x[2]; a1 -= mq[4][3] * x[3]; mq[4] = *(const LAS f32x4*)(Mm + 2128);
            a0 -= mq[5][0] * x[4]; a1 -= mq[5][1] * x[5]; a0 -= mq[5][2] * x[6]; a1 -= mq[5][3] * x[7]; mq[5] = *(const LAS f32x4*)(Mm + 2132);
            a0 -= mq[6][0] * x[8]; a1 -= mq[6][1] * x[9]; a0 -= mq[6][2] * x[10]; a1 -= mq[6][3] * x[11]; mq[6] = *(const LAS f32x4*)(Mm + 2136);
            a0 -= mq[7][0] * x[12]; a1 -= mq[7][1] * x[13]; a0 -= mq[7][2] * x[14]; a1 -= mq[7][3] * x[15]; mq[7] = *(const LAS f32x4*)(Mm + 2140);
            a0 -= mq[8][0] * x[16]; a1 -= mq[8][1] * x[17]; a0 -= mq[8][2] * x[18]; a1 -= mq[8][3] * x[19]; mq[8] = *(const LAS f32x4*)(Mm + 2144);
            a0 -= mq[9][0] * x[20]; a1 -= mq[9][1] * x[21]; a0 -= mq[9][2] * x[22]; a1 -= mq[9][3] * x[23]; mq[9] = *(const LAS f32x4*)(Mm + 2176);
            a0 -= mq[10][0] * x[24]; a1 -= mq[10][1] * x[25]; a0 -= mq[10][2] * x[26]; a1 -= mq[10][3] * x[27]; mq[10] = *(const LAS f32x4*)(Mm + 2180);
            a0 -= mq[11][0] * x[28]; a1 -= mq[11][1] * x[29]; a0 -= mq[11][2] * x[30]; a1 -= mq[11][3] * x[31]; x[32] = a0 + a1; mq[11] = *(const LAS f32x4*)(Mm + 2184);
            a0 = x[33]; a1 = 0.f; a0 -= mq[0][0] * x[0]; a1 -= mq[0][1] * x[1]; a0 -= mq[0][2] * x[2]; a1 -= mq[0][3] * x[3]; mq[0] = *(const LAS f32x4*)(Mm + 2188);
            a0 -= mq[1][0] * x[4]; a1 -= mq[1][1] * x[5]; a0 -= mq[1][2] * x[6]; a1 -= mq[1][3] * x[7]; mq[1] = *(const LAS f32x4*)(Mm + 2192);
            a0 -= mq[2][0] * x[8]; a1 -= mq[2][1] * x[9]; a0 -= mq[2][2] * x[10]; a1 -= mq[2][3] * x[11]; mq[2] = *(const LAS f32x4*)(Mm + 2196);
            a0 -= mq[3][0] * x[12]; a1 -= mq[3][1] * x[13]; a0 -= mq[3][2] * x[14]; a1 -= mq[3][3] * x[15]; mq[3] = *(const LAS f32x4*)(Mm + 2200);
            a0 -= mq[4][0] * x[16]; a1 -= mq[4][1] * x[17]; a0 -= mq[4][2] * x[18]; a1 -= mq[4][3] * x[19]; mq[4] = *(const LAS f32x4*)(Mm + 2204);
            a0 -= mq[5][0] * x[20]; a1 -= mq[5][1] * x[21]; a0 -= mq[5][2] * x[22]; a1 -= mq[5][3] * x[23]; mq[5] = *(const LAS f32x4*)(Mm + 2208);
            a0 -= mq[6][0] * x[24]; a1 -= mq[6][1] * x[25]; a0 -= mq[6][2] * x[26]; a1 -= mq[6][3] * x[27]; mq[6] = *(const LAS f32x4*)(Mm + 2240);
            a0 -= mq[7][0] * x[28]; a1 -= mq[7][1] * x[29]; a0 -= mq[7][2] * x[30]; a1 -= mq[7][3] * x[31]; mq[7] = *(const LAS f32x4*)(Mm + 2244);
            a0 -= mq[8][0] * x[32]; x[33] = a0 + a1; mq[8] = *(const LAS f32x4*)(Mm + 2248);
            a0 = x[34]; a1 = 0.f; a0 -= mq[9][0] * x[0]; a1 -= mq[9][1] * x[1]; a0 -= mq[9][2] * x[2]; a1 -= mq[9][3] * x[3]; mq[9] = *(const LAS f32x4*)(Mm + 2252);
            a0 -= mq[10][0] * x[4]; a1 -= mq[10][1] * x[5]; a0 -= mq[10][2] * x[6]; a1 -= mq[10][3] * x[7]; mq[10] = *(const LAS f32x4*)(Mm + 2256);
            a0 -= mq[11][0] * x[8]; a1 -= mq[11][1] * x[9]; a0 -= mq[11][2] * x[10]; a1 -= mq[11][3] * x[11]; mq[11] = *(const LAS f32x4*)(Mm + 2260);
            a0 -= mq[0][0] * x[12]; a1 -= mq[0][1] * x[13]; a0 -= mq[0][2] * x[14]; a1 -= mq[0][3] * x[15]; mq[0] = *(const LAS f32x4*)(Mm + 2264);
            a0 -= mq[1][0] * x[16]; a1 -= mq[1][1] * x[17]; a0 -= mq[1][2] * x[18]; a1 -= mq[1][3] * x[19]; mq[1] = *(const LAS f32x4*)(Mm + 2268);
            a0 -= mq[2][0] * x[20]; a1 -= mq[2][1] * x[21]; a0 -= mq[2][2] * x[22]; a1 -= mq[2][3] * x[23]; mq[2] = *(const LAS f32x4*)(Mm + 2272);
            a0 -= mq[3][0] * x[24]; a1 -= mq[3][1] * x[25]; a0 -= mq[3][2] * x[26]; a1 -= mq[3][3] * x[27]; mq[3] = *(const LAS f32x4*)(Mm + 2304);
            a0 -= mq[4][0] * x[28]; a1 -= mq[4][1] * x[29]; a0 -= mq[4][2] * x[30]; a1 -= mq[4][3] * x[31]; mq[4] = *(const LAS f32x4*)(Mm + 2308);
            a0 -= mq[5][0] * x[32]; a1 -= mq[5][1] * x[33]; x[34] = a0 + a1; mq[5] = *(const LAS f32x4*)(Mm + 2312);
            a0 = x[35]; a1 = 0.f; a0 -= mq[6][0] * x[0]; a1 -= mq[6][1] * x[1]; a0 -= mq[6][2] * x[2]; a1 -= mq[6][3] * x[3]; mq[6] = *(const LAS f32x4*)(Mm + 2316);
            a0 -= mq[7][0] * x[4]; a1 -= mq[7][1] * x[5]; a0 -= mq[7][2] * x[6]; a1 -= mq[7][3] * x[7]; mq[7] = *(const LAS f32x4*)(Mm + 2320);
            a0 -= mq[8][0] * x[8]; a1 -= mq[8][1] * x[9]; a0 -= mq[8][2] * x[10]; a1 -= mq[8][3] * x[11]; mq[8] = *(const LAS f32x4*)(Mm + 2324);
            a0 -= mq[9][0] * x[12]; a1 -= mq[9][1] * x[13]; a0 -= mq[9][2] * x[14]; a1 -= mq[9][3] * x[15]; mq[9] = *(const LAS f32x4*)(Mm + 2328);
            a0 -= mq[10][0] * x[16]; a1 -= mq[10][1] * x[17]; a0 -= mq[10][2] * x[18]; a1 -= mq[10][3] * x[19]; mq[10] = *(const LAS f32x4*)(Mm + 2332);
            a0 -= mq[11][0] * x[20]; a1 -= mq[11][1] * x[21]; a0 -= mq[11][2] * x[22]; a1 -= mq[11][3] * x[23]; mq[11] = *(const LAS f32x4*)(Mm + 2336);
            a0 -= mq[0][0] * x[24]; a1 -= mq[0][1] * x[25]; a0 -= mq[0][2] * x[26]; a1 -= mq[0][3] * x[27]; mq[0] = *(const LAS f32x4*)(Mm + 2368);
            a0 -= mq[1][0] * x[28]; a1 -= mq[1][1] * x[29]; a0 -= mq[1][2] * x[30]; a1 -= mq[1][3] * x[31]; mq[1] = *(const LAS f32x4*)(Mm + 2372);
            a0 -= mq[2][0] * x[32]; a1 -= mq[2][1] * x[33]; a0 -= mq[2][2] * x[34]; x[35] = a0 + a1; mq[2] = *(const LAS f32x4*)(Mm + 2376);
            a0 = x[36]; a1 = 0.f; a0 -= mq[3][0] * x[0]; a1 -= mq[3][1] * x[1]; a0 -= mq[3][2] * x[2]; a1 -= mq[3][3] * x[3]; mq[3] = *(const LAS f32x4*)(Mm + 2380);
            a0 -= mq[4][0] * x[4]; a1 -= mq[4][1] * x[5]; a0 -= mq[4][2] * x[6]; a1 -= mq[4][3] * x[7]; mq[4] = *(const LAS f32x4*)(Mm + 2384);
            a0 -= mq[5][0] * x[8]; a1 -= mq[5][1] * x[9]; a0 -= mq[5][2] * x[10]; a1 -= mq[5][3] * x[11]; mq[5] = *(const LAS f32x4*)(Mm + 2388);
            a0 -= mq[6][0] * x[12]; a1 -= mq[6][1] * x[13]; a0 -= mq[6][2] * x[14]; a1 -= mq[6][3] * x[15]; mq[6] = *(const LAS f32x4*)(Mm + 2392);
            a0 -= mq[7][0] * x[16]; a1 -= mq[7][1] * x[17]; a0 -= mq[7][2] * x[18]; a1 -= mq[7][3] * x[19]; mq[7] = *(const LAS f32x4*)(Mm + 2396);
            a0 -= mq[8][0] * x[20]; a1 -= mq[8][1] * x[21]; a0 -= mq[8][2] * x[22]; a1 -= mq[8][3] * x[23]; mq[8] = *(const LAS f32x4*)(Mm + 2400);
            a0 -= mq[9][0] * x[24]; a1 -= mq[9][1] * x[25]; a0 -= mq[9][2] * x[26]; a1 -= mq[9][3] * x[27]; mq[9] = *(const LAS f32x4*)(Mm + 2404);
            a0 -= mq[10][0] * x[28]; a1 -= mq[10][1] * x[29]; a0 -= mq[10][2] * x[30]; a1 -= mq[10][3] * x[31]; mq[10] = *(const LAS f32x4*)(Mm + 2432);
            a0 -= mq[11][0] * x[32]; a1 -= mq[11][1] * x[33]; a0 -= mq[11][2] * x[34]; a1 -= mq[11][3] * x[35]; x[36] = a0 + a1; mq[11] = *(const LAS f32x4*)(Mm + 2436);
            a0 = x[37]; a1 = 0.f; a0 -= mq[0][0] * x[0]; a1 -= mq[0][1] * x[1]; a0 -= mq[0][2] * x[2]; a1 -= mq[0][3] * x[3]; mq[0] = *(const LAS f32x4*)(Mm + 2440);
            a0 -= mq[1][0] * x[4]; a1 -= mq[1][1] * x[5]; a0 -= mq[1][2] * x[6]; a1 -= mq[1][3] * x[7]; mq[1] = *(const LAS f32x4*)(Mm + 2444);
            a0 -= mq[2][0] * x[8]; a1 -= mq[2][1] * x[9]; a0 -= mq[2][2] * x[10]; a1 -= mq[2][3] * x[11]; mq[2] = *(const LAS f32x4*)(Mm + 2448);
            a0 -= mq[3][0] * x[12]; a1 -= mq[3][1] * x[13]; a0 -= mq[3][2] * x[14]; a1 -= mq[3][3] * x[15]; mq[3] = *(const LAS f32x4*)(Mm + 2452);
            a0 -= mq[4][0] * x[16]; a1 -= mq[4][1] * x[17]; a0 -= mq[4][2] * x[18]; a1 -= mq[4][3] * x[19]; mq[4] = *(const LAS f32x4*)(Mm + 2456);
            a0 -= mq[5][0] * x[20]; a1 -= mq[5][1] * x[21]; a0 -= mq[5][2] * x[22]; a1 -= mq[5][3] * x[23]; mq[5] = *(const LAS f32x4*)(Mm + 2460);
            a0 -= mq[6][0] * x[24]; a1 -= mq[6][1] * x[25]; a0 -= mq[6][2] * x[26]; a1 -= mq[6][3] * x[27]; mq[6] = *(const LAS f32x4*)(Mm + 2464);
            a0 -= mq[7][0] * x[28]; a1 -= mq[7][1] * x[29]; a0 -= mq[7][2] * x[30]; a1 -= mq[7][3] * x[31]; mq[7] = *(const LAS f32x4*)(Mm + 2468);
            a0 -= mq[8][0] * x[32]; a1 -= mq[8][1] * x[33]; a0 -= mq[8][2] * x[34]; a1 -= mq[8][3] * x[35]; mq[8] = *(const LAS f32x4*)(Mm + 2496);
            a0 -= mq[9][0] * x[36]; x[37] = a0 + a1; mq[9] = *(const LAS f32x4*)(Mm + 2500);
            a0 = x[38]; a1 = 0.f; a0 -= mq[10][0] * x[0]; a1 -= mq[10][1] * x[1]; a0 -= mq[10][2] * x[2]; a1 -= mq[10][3] * x[3]; mq[10] = *(const LAS f32x4*)(Mm + 2504);
            a0 -= mq[11][0] * x[4]; a1 -= mq[11][1] * x[5]; a0 -= mq[11][2] * x[6]; a1 -= mq[11][3] * x[7]; mq[11] = *(const LAS f32x4*)(Mm + 2508);
            a0 -= mq[0][0] * x[8]; a1 -= mq[0][1] * x[9]; a0 -= mq[0][2] * x[10]; a1 -= mq[0][3] * x[11]; mq[0] = *(const LAS f32x4*)(Mm + 2512);
            a0 -= mq[1][0] * x[12]; a1 -= mq[1][1] * x[13]; a0 -= mq[1][2] * x[14]; a1 -= mq[1][3] * x[15]; mq[1] = *(const LAS f32x4*)(Mm + 2516);
            a0 -= mq[2][0] * x[16]; a1 -= mq[2][1] * x[17]; a0 -= mq[2][2] * x[18]; a1 -= mq[2][3] * x[19]; mq[2] = *(const LAS f32x4*)(Mm + 2520);
            a0 -= mq[3][0] * x[20]; a1 -= mq[3][1] * x[21]; a0 -= mq[3][2] * x[22]; a1 -= mq[3][3] * x[23]; mq[3] = *(const LAS f32x4*)(Mm + 2524);
            a0 -= mq[4][0] * x[24]; a1 -= mq[4][1] * x[25]; a0 -= mq[4][2] * x[26]; a1 -= mq[4][3] * x[27]; mq[4] = *(const LAS f32x4*)(Mm + 2528);
            a0 -= mq[5][0] * x[28]; a1 -= mq[5][1] * x[29]; a0 -= mq[5][2] * x[30]; a1 -= mq[5][3] * x[31]; mq[5] = *(const LAS f32x4*)(Mm + 2532);
            a0 -= mq[6][0] * x[32]; a1 -= mq[6][1] * x[33]; a0 -= mq[6][2] * x[34]; a1 -= mq[6][3] * x[35]; mq[6] = *(const LAS f32x4*)(Mm + 2560);
            a0 -= mq[7][0] * x[36]; a1 -= mq[7][1] * x[37]; x[38] = a0 + a1; mq[7] = *(const LAS f32x4*)(Mm + 2564);
            a0 = x[39]; a1 = 0.f; a0 -= mq[8][0] * x[0]; a1 -= mq[8][1] * x[1]; a0 -= mq[8][2] * x[2]; a1 -= mq[8][3] * x[3]; mq[8] = *(const LAS f32x4*)(Mm + 2568);
            a0 -= mq[9][0] * x[4]; a1 -= mq[9][1] * x[5]; a0 -= mq[9][2] * x[6]; a1 -= mq[9][3] * x[7]; mq[9] = *(const LAS f32x4*)(Mm + 2572);
            a0 -= mq[10][0] * x[8]; a1 -= mq[10][1] * x[9]; a0 -= mq[10][2] * x[10]; a1 -= mq[10][3] * x[11]; mq[10] = *(const LAS f32x4*)(Mm + 2576);
            a0 -= mq[11][0] * x[12]; a1 -= mq[11][1] * x[13]; a0 -= mq[11][2] * x[14]; a1 -= mq[11][3] * x[15]; mq[11] = *(const LAS f32x4*)(Mm + 2580);
            a0 -= mq[0][0] * x[16]; a1 -= mq[0][1] * x[17]; a0 -= mq[0][2] * x[18]; a1 -= mq[0][3] * x[19]; mq[0] = *(const LAS f32x4*)(Mm + 2584);
            a0 -= mq[1][0] * x[20]; a1 -= mq[1][1] * x[21]; a0 -= mq[1][2] * x[22]; a1 -= mq[1][3] * x[23]; mq[1] = *(const LAS f32x4*)(Mm + 2588);
            a0 -= mq[2][0] * x[24]; a1 -= mq[2][1] * x[25]; a0 -= mq[2][2] * x[26]; a1 -= mq[2][3] * x[27]; mq[2] = *(const LAS f32x4*)(Mm + 2592);
            a0 -= mq[3][0] * x[28]; a1 -= mq[3][1] * x[29]; a0 -= mq[3][2] * x[30]; a1 -= mq[3][3] * x[31]; mq[3] = *(const LAS f32x4*)(Mm + 2596);
            a0 -= mq[4][0] * x[32]; a1 -= mq[4][1] * x[33]; a0 -= mq[4][2] * x[34]; a1 -= mq[4][3] * x[35]; mq[4] = *(const LAS f32x4*)(Mm + 2624);
            a0 -= mq[5][0] * x[36]; a1 -= mq[5][1] * x[37]; a0 -= mq[5][2] * x[38]; x[39] = a0 + a1; mq[5] = *(const LAS f32x4*)(Mm + 2628);
            a0 = x[40]; a1 = 0.f; a0 -= mq[6][0] * x[0]; a1 -= mq[6][1] * x[1]; a0 -= mq[6][2] * x[2]; a1 -= mq[6][3] * x[3]; mq[6] = *(const LAS f32x4*)(Mm + 2632);
            a0 -= mq[7][0] * x[4]; a1 -= mq[7][1] * x[5]; a0 -= mq[7][2] * x[6]; a1 -= mq[7][3] * x[7]; mq[7] = *(const LAS f32x4*)(Mm + 2636);
            a0 -= mq[8][0] * x[8]; a1 -= mq[8][1] * x[9]; a0 -= mq[8][2] * x[10]; a1 -= mq[8][3] * x[11]; mq[8] = *(const LAS f32x4*)(Mm + 2640);
            a0 -= mq[9][0] * x[12]; a1 -= mq[9][1] * x[13]; a0 -= mq[9][2] * x[14]; a1 -= mq[9][3] * x[15]; mq[9] = *(const LAS f32x4*)(Mm + 2644);
            a0 -= mq[10][0] * x[16]; a1 -= mq[10][1] * x[17]; a0 -= mq[10][2] * x[18]; a1 -= mq[10][3] * x[19]; mq[10] = *(const LAS f32x4*)(Mm + 2648);
            a0 -= mq[11][0] * x[20]; a1 -= mq[11][1] * x[21]; a0 -= mq[11][2] * x[22]; a1 -= mq[11][3] * x[23]; mq[11] = *(const LAS f32x4*)(Mm + 2652);
            a0 -= mq[0][0] * x[24]; a1 -= mq[0][1] * x[25]; a0 -= mq[0][2] * x[26]; a1 -= mq[0][3] * x[27]; mq[0] = *(const LAS f32x4*)(Mm + 2656);
            a0 -= mq[1][0] * x[28]; a1 -= mq[1][1] * x[29]; a0 -= mq[1][2] * x[30]; a1 -= mq[1][3] * x[31]; mq[1] = *(const LAS f32x4*)(Mm + 2660);
            a0 -= mq[2][0] * x[32]; a1 -= mq[2][1] * x[33]; a0 -= mq[2][2] * x[34]; a1 -= mq[2][3] * x[35]; mq[2] = *(const LAS f32x4*)(Mm + 2664);
            a0 -= mq[3][0] * x[36]; a1 -= mq[3][1] * x[37]; a0 -= mq[3][2] * x[38]; a1 -= mq[3][3] * x[39]; x[40] = a0 + a1; mq[3] = *(const LAS f32x4*)(Mm + 2688);
            a0 = x[41]; a1 = 0.f; a0 -= mq[4][0] * x[0]; a1 -= mq[4][1] * x[1]; a0 -= mq[4][2] * x[2]; a1 -= mq[4][3] * x[3]; mq[4] = *(const LAS f32x4*)(Mm + 2692);
            a0 -= mq[5][0] * x[4]; a1 -= mq[5][1] * x[5]; a0 -= mq[5][2] * x[6]; a1 -= mq[5][3] * x[7]; mq[5] = *(const LAS f32x4*)(Mm + 2696);
            a0 -= mq[6][0] * x[8]; a1 -= mq[6][1] * x[9]; a0 -= mq[6][2] * x[10]; a1 -= mq[6][3] * x[11]; mq[6] = *(const LAS f32x4*)(Mm + 2700);
            a0 -= mq[7][0] * x[12]; a1 -= mq[7][1] * x[13]; a0 -= mq[7][2] * x[14]; a1 -= mq[7][3] * x[15]; mq[7] = *(const LAS f32x4*)(Mm + 2704);
            a0 -= mq[8][0] * x[16]; a1 -= mq[8][1] * x[17]; a0 -= mq[8][2] * x[18]; a1 -= mq[8][3] * x[19]; mq[8] = *(const LAS f32x4*)(Mm + 2708);
            a0 -= mq[9][0] * x[20]; a1 -= mq[9][1] * x[21]; a0 -= mq[9][2] * x[22]; a1 -= mq[9][3] * x[23]; mq[9] = *(const LAS f32x4*)(Mm + 2712);
            a0 -= mq[10][0] * x[24]; a1 -= mq[10][1] * x[25]; a0 -= mq[10][2] * x[26]; a1 -= mq[10][3] * x[27]; mq[10] = *(const LAS f32x4*)(Mm + 2716);
            a0 -= mq[11][0] * x[28]; a1 -= mq[11][1] * x[29]; a0 -= mq[11][2] * x[30]; a1 -= mq[11][3] * x[31]; mq[11] = *(const LAS f32x4*)(Mm + 2720);
            a0 -= mq[0][0] * x[32]; a1 -= mq[0][1] * x[33]; a0 -= mq[0][2] * x[34]; a1 -= mq[0][3] * x[35]; mq[0] = *(const LAS f32x4*)(Mm + 2724);
            a0 -= mq[1][0] * x[36]; a1 -= mq[1][1] * x[37]; a0 -= mq[1][2] * x[38]; a1 -= mq[1][3] * x[39]; mq[1] = *(const LAS f32x4*)(Mm + 2728);
            a0 -= mq[2][0] * x[40]; x[41] = a0 + a1; mq[2] = *(const LAS f32x4*)(Mm + 2752);
            a0 = x[42]; a1 = 0.f; a0 -= mq[3][0] * x[0]; a1 -= mq[3][1] * x[1]; a0 -= mq[3][2] * x[2]; a1 -= mq[3][3] * x[3]; mq[3] = *(const LAS f32x4*)(Mm + 2756);
            a0 -= mq[4][0] * x[4]; a1 -= mq[4][1] * x[5]; a0 -= mq[4][2] * x[6]; a1 -= mq[4][3] * x[7]; mq[4] = *(const LAS f32x4*)(Mm + 2760);
            a0 -= mq[5][0] * x[8]; a1 -= mq[5][1] * x[9]; a0 -= mq[5][2] * x[10]; a1 -= mq[5][3] * x[11]; mq[5] = *(const LAS f32x4*)(Mm + 2764);
            a0 -= mq[6][0] * x[12]; a1 -= mq[6][1] * x[13]; a0 -= mq[6][2] * x[14]; a1 -= mq[6][3] * x[15]; mq[6] = *(const LAS f32x4*)(Mm + 2768);
            a0 -= mq[7][0] * x[16]; a1 -= mq[7][1] * x[17]; a0 -= mq[7][2] * x[18]; a1 -= mq[7][3] * x[19]; mq[7] = *(const LAS f32x4*)(Mm + 2772);
            a0 -= mq[8][0] * x[20]; a1 -= mq[8][1] * x[21]; a0 -= mq[8][2] * x[22]; a1 -= mq[8][3] * x[23]; mq[8] = *(const LAS f32x4*)(Mm + 2776);
            a0 -= mq[9][0] * x[24]; a1 -= mq[9][1] * x[25]; a0 -= mq[9][2] * x[26]; a1 -= mq[9][3] * x[27]; mq[9] = *(const LAS f32x4*)(Mm + 2780);
            a0 -= mq[10][0] * x[28]; a1 -= mq[10][1] * x[29]; a0 -= mq[10][2] * x[30]; a1 -= mq[10][3] * x[31]; mq[10] = *(const LAS f32x4*)(Mm + 2784);
            a0 -= mq[11][0] * x[32]; a1 -= mq[11][1] * x[33]; a0 -= mq[11][2] * x[34]; a1 -= mq[11][3] * x[35]; mq[11] = *(const LAS f32x4*)(Mm + 2788);
            a0 -= mq[0][0] * x[36]; a1 -= mq[0][1] * x[37]; a0 -= mq[0][2] * x[38]; a1 -= mq[0][3] * x[39]; mq[0] = *(const LAS f32x4*)(Mm + 2792);
            a0 -= mq[1][0] * x[40]; a1 -= mq[1][1] * x[41]; x[42] = a0 + a1; mq[1] = *(const LAS f32x4*)(Mm + 2816);
            a0 = x[43]; a1 = 0.f; a0 -= mq[2][0] * x[0]; a1 -= mq[2][1] * x[1]; a0 -= mq[2][2] * x[2]; a1 -= mq[2][3] * x[3]; mq[2] = *(const LAS f32x4*)(Mm + 2820);
            a0 -= mq[3][0] * x[4]; a1 -= mq[3][1] * x[5]; a0 -= mq[3][2] * x[6]; a1 -= mq[3][3] * x[7]; mq[3] = *(const LAS f32x4*)(Mm + 2824);
            a0 -= mq[4][0] * x[8]; a1 -= mq[4][1] * x[9]; a0 -= mq[4][2] * x[10]; a1 -= mq[4][3] * x[11]; mq[4] = *(const LAS f32x4*)(Mm + 2828);
            a0 -= mq[5][0] * x[12]; a1 -= mq[5][1] * x[13]; a0 -= mq[5][2] * x[14]; a1 -= mq[5][3] * x[15]; mq[5] = *(const LAS f32x4*)(Mm + 2832);
            a0 -= mq[6][0] * x[16]; a1 -= mq[6][1] * x[17]; a0 -= mq[6][2] * x[18]; a1 -= mq[6][3] * x[19]; mq[6] = *(const LAS f32x4*)(Mm + 2836);
            a0 -= mq[7][0] * x[20]; a1 -= mq[7][1] * x[21]; a0 -= mq[7][2] * x[22]; a1 -= mq[7][3] * x[23]; mq[7] = *(const LAS f32x4*)(Mm + 2840);
            a0 -= mq[8][0] * x[24]; a1 -= mq[8][1] * x[25]; a0 -= mq[8][2] * x[26]; a1 -= mq[8][3] * x[27]; mq[8] = *(const LAS f32x4*)(Mm + 2844);
            a0 -= mq[9][0] * x[28]; a1 -= mq[9][1] * x[29]; a0 -= mq[9][2] * x[30]; a1 -= mq[9][3] * x[31]; mq[9] = *(const LAS f32x4*)(Mm + 2848);
            a0 -= mq[10][0] * x[32]; a1 -= mq[10][1] * x[33]; a0 -= mq[10][2] * x[34]; a1 -= mq[10][3] * x[35]; mq[10] = *(const LAS f32x4*)(Mm + 2852);
            a0 -= mq[11][0] * x[36]; a1 -= mq[11][1] * x[37]; a0 -= mq[11][2] * x[38]; a1 -= mq[11][3] * x[39]; mq[11] = *(const LAS f32x4*)(Mm + 2856);
            a0 -= mq[0][0] * x[40]; a1 -= mq[0][1] * x[41]; a0 -= mq[0][2] * x[42]; x[43] = a0 + a1; mq[0] = *(const LAS f32x4*)(Mm + 2880);
            a0 = x[44]; a1 = 0.f; a0 -= mq[1][0] * x[0]; a1 -= mq[1][1] * x[1]; a0 -= mq[1][2] * x[2]; a1 -= mq[1][3] * x[3]; mq[1] = *(const LAS f32x4*)(Mm + 2884);
            a0 -= mq[2][0] * x[4]; a1 -= mq[2][1] * x[5]; a0 -= mq[2][2] * x[6]; a1 -= mq[2][3] * x[7]; mq[2] = *(const LAS f32x4*)(Mm + 2888);
            a0 -= mq[3][0] * x[8]; a1 -= mq[3][1] * x[9]; a0 -= mq[3][2] * x[10]; a1 -= mq[3][3] * x[11]; mq[3] = *(const LAS f32x4*)(Mm + 2892);
            a0 -= mq[4][0] * x[12]; a1 -= mq[4][1] * x[13]; a0 -= mq[4][2] * x[14]; a1 -= mq[4][3] * x[15]; mq[4] = *(const LAS f32x4*)(Mm + 2896);
            a0 -= mq[5][0] * x[16]; a1 -= mq[5][1] * x[17]; a0 -= mq[5][2] * x[18]; a1 -= mq[5][3] * x[19]; mq[5] = *(const LAS f32x4*)(Mm + 2900);
            a0 -= mq[6][0] * x[20]; a1 -= mq[6][1] * x[21]; a0 -= mq[6][2] * x[22]; a1 -= mq[6][3] * x[23]; mq[6] = *(const LAS f32x4*)(Mm + 2904);
            a0 -= mq[7][0] * x[24]; a1 -= mq[7][1] * x[25]; a0 -= mq[7][2] * x[26]; a1 -= mq[7][3] * x[27]; mq[7] = *(const LAS f32x4*)(Mm + 2908);
            a0 -= mq[8][0] * x[28]; a1 -= mq[8][1] * x[29]; a0 -= mq[8][2] * x[30]; a1 -= mq[8][3] * x[31]; mq[8] = *(const LAS f32x4*)(Mm + 2912);
            a0 -= mq[9][0] * x[32]; a1 -= mq[9][1] * x[33]; a0 -= mq[9][2] * x[34]; a1 -= mq[9][3] * x[35]; mq[9] = *(const LAS f32x4*)(Mm + 2916);
            a0 -= mq[10][0] * x[36]; a1 -= mq[10][1] * x[37]; a0 -= mq[10][2] * x[38]; a1 -= mq[10][3] * x[39]; mq[10] = *(const LAS f32x4*)(Mm + 2920);
            a0 -= mq[11][0] * x[40]; a1 -= mq[11][1] * x[41]; a0 -= mq[11][2] * x[42]; a1 -= mq[11][3] * x[43]; x[44] = a0 + a1; mq[11] = *(const LAS f32x4*)(Mm + 2924);
            a0 = x[45]; a1 = 0.f; a0 -= mq[0][0] * x[0]; a1 -= mq[0][1] * x[1]; a0 -= mq[0][2] * x[2]; a1 -= mq[0][3] * x[3]; mq[0] = *(const LAS f32x4*)(Mm + 2944);
            a0 -= mq[1][0] * x[4]; a1 -= mq[1][1] * x[5]; a0 -= mq[1][2] * x[6]; a1 -= mq[1][3] * x[7]; mq[1] = *(const LAS f32x4*)(Mm + 2948);
            a0 -= mq[2][0] * x[8]; a1 -= mq[2][1] * x[9]; a0 -= mq[2][2] * x[10]; a1 -= mq[2][3] * x[11]; mq[2] = *(const LAS f32x4*)(Mm + 2952);
            a0 -= mq[3][0] * x[12]; a1 -= mq[3][1] * x[13]; a0 -= mq[3][2] * x[14]; a1 -= mq[3][3] * x[15]; mq[3] = *(const LAS f32x4*)(Mm + 2956);
            a0 -= mq[4][0] * x[16]; a1 -= mq[4][1] * x[17]; a0 -= mq[4][2] * x[18]; a1 -= mq[4][3] * x[19]; mq[4] = *(const LAS f32x4*)(Mm + 2960);
            a0 -= mq[5][0] * x[20]; a1 -= mq[5][1] * x[21]; a0 -= mq[5][2] * x[22]; a1 -= mq[5][3] * x[23]; mq[5] = *(const LAS f32x4*)(Mm + 2964);
            a0 -= mq[6][0] * x[24]; a1 -= mq[6][1] * x[25]; a0 -= mq[6][2] * x[26]; a1 -= mq[6][3] * x[27]; mq[6] = *(const LAS f32x4*)(Mm + 2968);
            a0 -= mq[7][0] * x[28]; a1 -= mq[7][1] * x[29]; a0 -= mq[7][2] * x[30]; a1 -= mq[7][3] * x[31]; mq[7] = *(const LAS f32x4*)(Mm + 2972);
            a0 -= mq[8][0] * x[32]; a1 -= mq[8][1] * x[33]; a0 -= mq[8][2] * x[34]; a1 -= mq[8][3] * x[35]; mq[8] = *(const LAS f32x4*)(Mm + 2976);
            a0 -= mq[9][0] * x[36]; a1 -= mq[9][1] * x[37]; a0 -= mq[9][2] * x[38]; a1 -= mq[9][3] * x[39]; mq[9] = *(const LAS f32x4*)(Mm + 2980);
            a0 -= mq[10][0] * x[40]; a1 -= mq[10][1] * x[41]; a0 -= mq[10][2] * x[42]; a1 -= mq[10][3] * x[43]; mq[10] = *(const LAS f32x4*)(Mm + 2984);
            a0 -= mq[11][0] * x[44]; x[45] = a0 + a1; mq[11] = *(const LAS f32x4*)(Mm + 2988);
            a0 = x[46]; a1 = 0.f; a0 -= mq[0][0] * x[0]; a1 -= mq[0][1] * x[1]; a0 -= mq[0][2] * x[2]; a1 -= mq[0][3] * x[3]; mq[0] = *(const LAS f32x4*)(Mm + 3008);
            a0 -= mq[1][0] * x[4]; a1 -= mq[1][1] * x[5]; a0 -= mq[1][2] * x[6]; a1 -= mq[1][3] * x[7]; mq[1] = *(const LAS f32x4*)(Mm + 3012);
            a0 -= mq[2][0] * x[8]; a1 -= mq[2][1] * x[9]; a0 -= mq[2][2] * x[10]; a1 -= mq[2][3] * x[11]; mq[2] = *(const LAS f32x4*)(Mm + 3016);
            a0 -= mq[3][0] * x[12]; a1 -= mq[3][1] * x[13]; a0 -= mq[3][2] * x[14]; a1 -= mq[3][3] * x[15]; mq[3] = *(const LAS f32x4*)(Mm + 3020);
            a0 -= mq[4][0] * x[16]; a1 -= mq[4][1] * x[17]; a0 -= mq[4][2] * x[18]; a1 -= mq[4][3] * x[19]; mq[4] = *(const LAS f32x4*)(Mm + 3024);
            a0 -= mq[5][0] * x[20]; a1 -= mq[5][1] * x[21]; a0 -= mq[5][2] * x[22]; a1 -= mq[5][3] * x[23]; mq[5] = *(const LAS f32x4*)(Mm + 3028);
            a0 -= mq[6][0] * x[24]; a1 -= mq[6][1] * x[25]; a0 -= mq[6][2] * x[26]; a1 -= mq[6][3] * x[27]; mq[6] = *(const LAS f32x4*)(Mm + 3032);
            a0 -= mq[7][0] * x[28]; a1 -= mq[7][1] * x[29]; a0 -= mq[7][2] * x[30]; a1 -= mq[7][3] * x[31]; mq[7] = *(const LAS f32x4*)(Mm + 3036);
            a0 -= mq[8][0] * x[32]; a1 -= mq[8][1] * x[33]; a0 -= mq[8][2] * x[34]; a1 -= mq[8][3] * x[35]; mq[8] = *(const LAS f32x4*)(Mm + 3040);
            a0 -= mq[9][0] * x[36]; a1 -= mq[9][1] * x[37]; a0 -= mq[9][2] * x[38]; a1 -= mq[9][3] * x[39]; mq[9] = *(const LAS f32x4*)(Mm + 3044);
            a0 -= mq[10][0] * x[40]; a1 -= mq[10][1] * x[41]; a0 -= mq[10][2] * x[42]; a1 -= mq[10][3] * x[43]; mq[10] = *(const LAS f32x4*)(Mm + 3048);
            a0 -= mq[11][0] * x[44]; a1 -= mq[11][1] * x[45]; x[46] = a0 + a1; mq[11] = *(const LAS f32x4*)(Mm + 3052);
            a0 = x[47]; a1 = 0.f; a0 -= mq[0][0] * x[0]; a1 -= mq[0][1] * x[1]; a0 -= mq[0][2] * x[2]; a1 -= mq[0][3] * x[3]; mq[0] = *(const LAS f32x4*)(Mm + 3072);
            a0 -= mq[1][0] * x[4]; a1 -= mq[1][1] * x[5]; a0 -= mq[1][2] * x[6]; a1 -= mq[1][3] * x[7]; mq[1] = *(const LAS f32x4*)(Mm + 3076);
            a0 -= mq[2][0] * x[8]; a1 -= mq[2][1] * x[9]; a0 -= mq[2][2] * x[10]; a1 -= mq[2][3] * x[11]; mq[2] = *(const LAS f32x4*)(Mm + 3080);
            a0 -= mq[3][0] * x[12]; a1 -= mq[3][1] * x[13]; a0 -= mq[3][2] * x[14]; a1 -= mq[3][3] * x[15]; mq[3] = *(const LAS f32x4*)(Mm + 3084);
            a0 -= mq[4][0] * x[16]; a1 -= mq[4][1] * x[17]; a0 -= mq[4][2] * x[18]; a1 -= mq[4][3] * x[19]; mq[4] = *(const LAS f32x4*)(Mm + 3088);
            a0 -= mq[5][0] * x[20]; a1 -= mq[5][1] * x[21]; a0 -= mq[5][2] * x[22]; a1 -= mq[5][3] * x[23]; mq[5] = *(const LAS f32x4*)(Mm + 3092);
            a0 -= mq[6][0] * x[24]; a1 -= mq[6][1] * x[25]; a0 -= mq[6][2] * x[26]; a1 -= mq[6][3] * x[27]; mq[6] = *(const LAS f32x4*)(Mm + 3096);
            a0 -= mq[7][0] * x[28]; a1 -= mq[7][1] * x[29]; a0 -= mq[7][2] * x[30]; a1 -= mq[7][3] * x[31]; mq[7] = *(const LAS f32x4*)(Mm + 3100);
            a0 -= mq[8][0] * x[32]; a1 -= mq[8][1] * x[33]; a0 -= mq[8][2] * x[34]; a1 -= mq[8][3] * x[35]; mq[8] = *(const LAS f32x4*)(Mm + 3104);
            a0 -= mq[9][0] * x[36]; a1 -= mq[9][1] * x[37]; a0 -= mq[9][2] * x[38]; a1 -= mq[9][3] * x[39]; mq[9] = *(const LAS f32x4*)(Mm + 3108);
            a0 -= mq[10][0] * x[40]; a1 -= mq[10][1] * x[41]; a0 -= mq[10][2] * x[42]; a1 -= mq[10][3] * x[43]; mq[10] = *(const LAS f32x4*)(Mm + 3112);
            a0 -= mq[11][0] * x[44]; a1 -= mq[11][1] * x[45]; a0 -= mq[11][2] * x[46]; x[47] = a0 + a1; mq[11] = *(const LAS f32x4*)(Mm + 3116);
            a0 = x[48]; a1 = 0.f; a0 -= mq[0][0] * x[0]; a1 -= mq[0][1] * x[1]; a0 -= mq[0][2] * x[2]; a1 -= mq[0][3] * x[3]; mq[0] = *(const LAS f32x4*)(Mm + 3136);
            a0 -= mq[1][0] * x[4]; a1 -= mq[1][1] * x[5]; a0 -= mq[1][2] * x[6]; a1 -= mq[1][3] * x[7]; mq[1] = *(const LAS f32x4*)(Mm + 3140);
            a0 -= mq[2][0] * x[8]; a1 -= mq[2][1] * x[9]; a0 -= mq[2][2] * x[10]; a1 -= mq[2][3] * x[11]; mq[2] = *(const LAS f32x4*)(Mm + 3144);
            a0 -= mq[3][0] * x[12]; a1 -= mq[3][1] * x[13]; a0 -= mq[3][2] * x[14]; a1 -= mq[3][3] * x[15]; mq[3] = *(const LAS f32x4*)(Mm + 3148);
            a0 -= mq[4][0] * x[16]; a1 -= mq[4][1] * x[17]; a0 -= mq[4][2] * x[18]; a1 -= mq[4][3] * x[19]; mq[4] = *(const LAS f32x4*)(Mm + 3152);
            a0 -= mq[5][0] * x[20]; a1 -= mq[5][1] * x[21]; a0 -= mq[5][2] * x[22]; a1 -= mq[5][3] * x[23]; mq[5] = *(const LAS f32x4*)(Mm + 3156);
            a0 -= mq[6][0] * x[24]; a1 -= mq[6][1] * x[25]; a0 -= mq[6][2] * x[26]; a1 -= mq[6][3] * x[27]; mq[6] = *(const LAS f32x4*)(Mm + 3160);
            a0 -= mq[7][0] * x[28]; a1 -= mq[7][1] * x[29]; a0 -= mq[7][2] * x[30]; a1 -= mq[7][3] * x[31]; mq[7] = *(const LAS f32x4*)(Mm + 3164);
            a0 -= mq[8][0] * x[32]; a1 -= mq[8][1] * x[33]; a0 -= mq[8][2] * x[34]; a1 -= mq[8][3] * x[35]; mq[8] = *(const LAS f32x4*)(Mm + 3168);
            a0 -= mq[9][0] * x[36]; a1 -= mq[9][1] * x[37]; a0 -= mq[9][2] * x[38]; a1 -= mq[9][3] * x[39]; mq[9] = *(const LAS f32x4*)(Mm + 3172);
            a0 -= mq[10][0] * x[40]; a1 -= mq[10][1] * x[41]; a0 -= mq[10][2] * x[42]; a1 -= mq[10][3] * x[43]; mq[10] = *(const LAS f32x4*)(Mm + 3176);
            a0 -= mq[11][0] * x[44]; a1 -= mq[11][1] * x[45]; a0 -= mq[11][2] * x[46]; a1 -= mq[11][3] * x[47]; x[48] = a0 + a1; mq[11] = *(const LAS f32x4*)(Mm + 3180);
            a0 = x[49]; a1 = 0.f; a0 -= mq[0][0] * x[0]; a1 -= mq[0][1] * x[1]; a0 -= mq[0][2] * x[2]; a1 -= mq[0][3] * x[3]; mq[0] = *(const LAS f32x4*)(Mm + 3184);
            a0 -= mq[1][0] * x[4]; a1 -= mq[1][1] * x[5]; a0 -= mq[1][2] * x[6]; a1 -= mq[1][3] * x[7]; mq[1] = *(const LAS f32x4*)(Mm + 3200);
            a0 -= mq[2][0] * x[8]; a1 -= mq[2][1] * x[9]; a0 -= mq[2][2] * x[10]; a1 -= mq[2][3] * x[11]; mq[2] = *(const LAS f32x4*)(Mm + 3204);
            a0 -= mq[3][0] * x[12]; a1 -= mq[3][1] * x[13]; a0 -= mq[3][2] * x[14]; a1 -= mq[3][3] * x[15]; mq[3] = *(const LAS f32x4*)(Mm + 3208);
            a0 -= mq[4][0] * x[16]; a1 -= mq[4][1] * x[17]; a0 -= mq[4][2] * x[18]; a1 -= mq[4][3] * x[19]; mq[4] = *(const LAS f32x4*)(Mm + 3212);
            a0 -= mq[5][0] * x[20]; a1 -= mq[5][1] * x[21]; a0 -= mq[5][2] * x[22]; a1 -= mq[5][3] * x[23]; mq[5] = *(const LAS f32x4*)(Mm + 3216);
            a0 -= mq[6][0] * x[24]; a1 -= mq[6][1] * x[25]; a0 -= mq[6][2] * x[26]; a1 -= mq[6][3] * x[27]; mq[6] = *(const LAS f32x4*)(Mm + 3220);
            a0 -= mq[7][0] * x[28]; a1 -= mq[7][1] * x[29]; a0 -= mq[7][2] * x[30]; a1 -= mq[7][3] * x[31]; mq[7] = *(const LAS f32x4*)(Mm + 3224);
            a0 -= mq[8][0] * x[32]; a1 -= mq[8][1] * x[33]; a0 -= mq[8][2] * x[34]; a1 -= mq[8][3] * x[35]; mq[8] = *(const LAS f32x4*)(Mm + 3228);
            a0 -= mq[9][0] * x[36]; a1 -= mq[9][1] * x[37]; a0 -= mq[9][2] * x[38]; a1 -= mq[9][3] * x[39]; mq[9] = *(const LAS f32x4*)(Mm + 3232);
            a0 -= mq[10][0] * x[40]; a1 -= mq[10][1] * x[41]; a0 -= mq[10][2] * x[42]; a1 -= mq[10][3] * x[43]; mq[10] = *(const LAS f32x4*)(Mm + 3236);
            a0 -= mq[11][0] * x[44]; a1 -= mq[11][1] * x[45]; a0 -= mq[11][2] * x[46]; a1 -= mq[11][3] * x[47]; mq[11] = *(const LAS f32x4*)(Mm + 3240);
            a0 -= mq[0][0] * x[48]; x[49] = a0 + a1; mq[0] = *(const LAS f32x4*)(Mm + 3244);
            a0 = x[50]; a1 = 0.f; a0 -= mq[1][0] * x[0]; a1 -= mq[1][1] * x[1]; a0 -= mq[1][2] * x[2]; a1 -= mq[1][3] * x[3]; mq[1] = *(const LAS f32x4*)(Mm + 3248);
            a0 -= mq[2][0] * x[4]; a1 -= mq[2][1] * x[5]; a0 -= mq[2][2] * x[6]; a1 -= mq[2][3] * x[7]; mq[2] = *(const LAS f32x4*)(Mm + 3264);
            a0 -= mq[3][0] * x[8]; a1 -= mq[3][1] * x[9]; a0 -= mq[3][2] * x[10]; a1 -= mq[3][3] * x[11]; mq[3] = *(const LAS f32x4*)(Mm + 3268);
            a0 -= mq[4][0] * x[12]; a1 -= mq[4][1] * x[13]; a0 -= mq[4][2] * x[14]; a1 -= mq[4][3] * x[15]; mq[4] = *(const LAS f32x4*)(Mm + 3272);
            a0 -= mq[5][0] * x[16]; a1 -= mq[5][1] * x[17]; a0 -= mq[5][2] * x[18]; a1 -= mq[5][3] * x[19]; mq[5] = *(const LAS f32x4*)(Mm + 3276);
            a0 -= mq[6][0] * x[20]; a1 -= mq[6][1] * x[21]; a0 -= mq[6][2] * x[22]; a1 -= mq[6][3] * x[23]; mq[6] = *(const LAS f32x4*)(Mm + 3280);
            a0 -= mq[7][0] * x[24]; a1 -= mq[7][1] * x[25]; a0 -= mq[7][2] * x[26]; a1 -= mq[7][3] * x[27]; mq[7] = *(const LAS f32x4*)(Mm + 3284);
            a0 -= mq[8][0] * x[28]; a1 -= mq[8][1] * x[29]; a0 -= mq[8][2] * x[30]; a1 -= mq[8][3] * x[31]; mq[8] = *(const LAS f32x4*)(Mm + 3288);
            a0 -= mq[9][0] * x[32]; a1 -= mq[9][1] * x[33]; a0 -= mq[9][2] * x[34]; a1 -= mq[9][3] * x[35]; mq[9] = *(const LAS f32x4*)(Mm + 3292);
            a0 -= mq[10][0] * x[36]; a1 -= mq[10][1] * x[37]; a0 -= mq[10][2] * x[38]; a1 -= mq[10][3] * x[39]; mq[10] = *(const LAS f32x4*)(Mm + 3296);
            a0 -= mq[11][0] * x[40]; a1 -= mq[11][1] * x[41]; a0 -= mq[11][2] * x[42]; a1 -= mq[11][3] * x[43]; mq[11] = *(const LAS f32x4*)(Mm + 3300);
            a0 -= mq[0][0] * x[44]; a1 -= mq[0][1] * x[45]; a0 -= mq[0][2] * x[46]; a1 -= mq[0][3] * x[47]; mq[0] = *(const LAS f32x4*)(Mm + 3304);
            a0 -= mq[1][0] * x[48]; a1 -= mq[1][1] * x[49]; x[50] = a0 + a1; mq[1] = *(const LAS f32x4*)(Mm + 3308);
            a0 = x[51]; a1 = 0.f; a0 -= mq[2][0] * x[0]; a1 -= mq[2][1] * x[1]; a0 -= mq[2][2] * x[2]; a1 -= mq[2][3] * x[3]; mq[2] = *(const LAS f32x4*)(Mm + 3312);
            a0 -= mq[3][0] * x[4]; a1 -= mq[3][1] * x[5]; a0 -= mq[3][2] * x[6]; a1 -= mq[3][3] * x[7]; mq[3] = *(const LAS f32x4*)(Mm + 3328);
            a0 -= mq[4][0] * x[8]; a1 -= mq[4][1] * x[9]; a0 -= mq[4][2] * x[10]; a1 -= mq[4][3] * x[11]; mq[4] = *(const LAS f32x4*)(Mm + 3332);
            a0 -= mq[5][0] * x[12]; a1 -= mq[5][1] * x[13]; a0 -= mq[5][2] * x[14]; a1 -= mq[5][3] * x[15]; mq[5] = *(const LAS f32x4*)(Mm + 3336);
            a0 -= mq[6][0] * x[16]; a1 -= mq[6][1] * x[17]; a0 -= mq[6][2] * x[18]; a1 -= mq[6][3] * x[19]; mq[6] = *(const LAS f32x4*)(Mm + 3340);
            a0 -= mq[7][0] * x[20]; a1 -= mq[7][1] * x[21]; a0 -= mq[7][2] * x[22]; a1 -= mq[7][3] * x[23]; mq[7] = *(const LAS f32x4*)(Mm + 3344);
            a0 -= mq[8][0] * x[24]; a1 -= mq[8][1] * x[25]; a0 -= mq[8][2] * x[26]; a1 -= mq[8][3] * x[27]; mq[8] = *(const LAS f32x4*)(Mm + 3348);
            a0 -= mq[9][0] * x[28]; a1 -= mq[9][1] * x[29]; a0 -= mq[9][2] * x[30]; a1 -= mq[9][3] * x[31]; mq[9] = *(const LAS f32x4*)(Mm + 3352);
            a0 -= mq[10][0] * x[32]; a1 -= mq[10][1] * x[33]; a0 -= mq[10][2] * x[34]; a1 -= mq[10][3] * x[35]; mq[10] = *(const LAS f32x4*)(Mm + 3356);
            a0 -= mq[11][0] * x[36]; a1 -= mq[11][1] * x[37]; a0 -= mq[11][2] * x[38]; a1 -= mq[11][3] * x[39]; mq[11] = *(const LAS f32x4*)(Mm + 3360);
            a0 -= mq[0][0] * x[40]; a1 -= mq[0][1] * x[41]; a0 -= mq[0][2] * x[42]; a1 -= mq[0][3] * x[43]; mq[0] = *(const LAS f32x4*)(Mm + 3364);
            a0 -= mq[1][0] * x[44]; a1 -= mq[1][1] * x[45]; a0 -= mq[1][2] * x[46]; a1 -= mq[1][3] * x[47]; mq[1] = *(const LAS f32x4*)(Mm + 3368);
            a0 -= mq[2][0] * x[48]; a1 -= mq[2][1] * x[49]; a0 -= mq[2][2] * x[50]; x[51] = a0 + a1; mq[2] = *(const LAS f32x4*)(Mm + 3372);
            a0 = x[52]; a1 = 0.f; a0 -= mq[3][0] * x[0]; a1 -= mq[3][1] * x[1]; a0 -= mq[3][2] * x[2]; a1 -= mq[3][3] * x[3]; mq[3] = *(const LAS f32x4*)(Mm + 3376);
            a0 -= mq[4][0] * x[4]; a1 -= mq[4][1] * x[5]; a0 -= mq[4][2] * x[6]; a1 -= mq[4][3] * x[7]; mq[4] = *(const LAS f32x4*)(Mm + 3392);
            a0 -= mq[5][0] * x[8]; a1 -= mq[5][1] * x[9]; a0 -= mq[5][2] * x[10]; a1 -= mq[5][3] * x[11]; mq[5] = *(const LAS f32x4*)(Mm + 3396);
            a0 -= mq[6][0] * x[12]; a1 -= mq[6][1] * x[13]; a0 -= mq[6][2] * x[14]; a1 -= mq[6][3] * x[15]; mq[6] = *(const LAS f32x4*)(Mm + 3400);
            a0 -= mq[7][0] * x[16]; a1 -= mq[7][1] * x[17]; a0 -= mq[7][2] * x[18]; a1 -= mq[7][3] * x[19]; mq[7] = *(const LAS f32x4*)(Mm + 3404);
            a0 -= mq[8][0] * x[20]; a1 -= mq[8][1] * x[21]; a0 -= mq[8][2] * x[22]; a1 -= mq[8][3] * x[23]; mq[8] = *(const LAS f32x4*)(Mm + 3408);
            a0 -= mq[9][0] * x[24]; a1 -= mq[9][1] * x[25]; a0 -= mq[9][2] * x[26]; a1 -= mq[9][3] * x[27]; mq[9] = *(const LAS f32x4*)(Mm + 3412);
            a0 -= mq[10][0] * x[28]; a1 -= mq[10][1] * x[29]; a0 -= mq[10][2] * x[30]; a1 -= mq[10][3] * x[31]; mq[10] = *(const LAS f32x4*)(Mm + 3416);
            a0 -= mq[11][0] * x[32]; a1 -= mq[11][1] * x[33]; a0 -= mq[11][2] * x[34]; a1 -= mq[11][3] * x[35]; mq[11] = *(const LAS f32x4*)(Mm + 3420);
            a0 -= mq[0][0] * x[36]; a1 -= mq[0][1] * x[37]; a0 -= mq[0][2] * x[38]; a1 -= mq[0][3] * x[39]; mq[0] = *(const LAS f32x4*)(Mm + 3424);
            a0 -= mq[1][0] * x[40]; a1 -= mq[1][1] * x[41]; a0 -= mq[1][2] * x[42]; a1 -= mq[1][3] * x[43]; mq[1] = *(const LAS f32x4*)(Mm + 3428);
            a0 -= mq[2][0] * x[44]; a1 -= mq[2][1] * x[45]; a0 -= mq[2][2] * x[46]; a1 -= mq[2][3] * x[47]; mq[2] = *(const LAS f32x4*)(Mm + 3432);
            a0 -= mq[3][0] * x[48]; a1 -= mq[3][1] * x[49]; a0 -= mq[3][2] * x[50]; a1 -= mq[3][3] * x[51]; x[52] = a0 + a1; mq[3] = *(const LAS f32x4*)(Mm + 3436);
            a0 = x[53]; a1 = 0.f; a0 -= mq[4][0] * x[0]; a1 -= mq[4][1] * x[1]; a0 -= mq[4][2] * x[2]; a1 -= mq[4][3] * x[3]; mq[4] = *(const LAS f32x4*)(Mm + 3440);
            a0 -= mq[5][0] * x[4]; a1 -= mq[5][1] * x[5]; a0 -= mq[5][2] * x[6]; a1 -= mq[5][3] * x[7]; mq[5] = *(const LAS f32x4*)(Mm + 3444);
            a0 -= mq[6][0] * x[8]; a1 -= mq[6][1] * x[9]; a0 -= mq[6][2] * x[10]; a1 -= mq[6][3] * x[11]; mq[6] = *(const LAS f32x4*)(Mm + 3456);
            a0 -= mq[7][0] * x[12]; a1 -= mq[7][1] * x[13]; a0 -= mq[7][2] * x[14]; a1 -= mq[7][3] * x[15]; mq[7] = *(const LAS f32x4*)(Mm + 3460);
            a0 -= mq[8][0] * x[16]; a1 -= mq[8][1] * x[17]; a0 -= mq[8][2] * x[18]; a1 -= mq[8][3] * x[19]; mq[8] = *(const LAS f32x4*)(Mm + 3464);
            a0 -= mq[9][0] * x[20]; a1 -= mq[9][1] * x[21]; a0 -= mq[9][2] * x[22]; a1 -= mq[9][3] * x[23]; mq[9] = *(const LAS f32x4*)(Mm + 3468);
            a0 -= mq[10][0] * x[24]; a1 -= mq[10][1] * x[25]; a0 -= mq[10][2] * x[26]; a1 -= mq[10][3] * x[27]; mq[10] = *(const LAS f32x4*)(Mm + 3472);
            a0 -= mq[11][0] * x[28]; a1 -= mq[11][1] * x[29]; a0 -= mq[11][2] * x[30]; a1 -= mq[11][3] * x[31]; mq[11] = *(const LAS f32x4*)(Mm + 3476);
            a0 -= mq[0][0] * x[32]; a1 -= mq[0][1] * x[33]; a0 -= mq[0][2] * x[34]; a1 -= mq[0][3] * x[35]; mq[0] = *(const LAS f32x4*)(Mm + 3480);
            a0 -= mq[1][0] * x[36]; a1 -= mq[1][1] * x[37]; a0 -= mq[1][2] * x[38]; a1 -= mq[1][3] * x[39]; mq[1] = *(const LAS f32x4*)(Mm + 3484);
            a0 -= mq[2][0] * x[40]; a1 -= mq[2][1] * x[41]; a0 -= mq[2][2] * x[42]; a1 -= mq[2][3] * x[43]; mq[2] = *(const LAS f32x4*)(Mm + 3488);
            a0 -= mq[3][0] * x[44]; a1 -= mq[3][1] * x[45]; a0 -= mq[3][2] * x[46]; a1 -= mq[3][3] * x[47]; mq[3] = *(const LAS f32x4*)(Mm + 3492);
            a0 -= mq[4][0] * x[48]; a1 -= mq[4][1] * x[49]; a0 -= mq[4][2] * x[50]; a1 -= mq[4][3] * x[51]; mq[4] = *(const LAS f32x4*)(Mm + 3496);
            a0 -= mq[5][0] * x[52]; x[53] = a0 + a1; mq[5] = *(const LAS f32x4*)(Mm + 3500);
            a0 = x[54]; a1 = 0.f; a0 -= mq[6][0] * x[0]; a1 -= mq[6][1] * x[1]; a0 -= mq[6][2] * x[2]; a1 -= mq[6][3] * x[3]; mq[6] = *(const LAS f32x4*)(Mm + 3504);
            a0 -= mq[7][0] * x[4]; a1 -= mq[7][1] * x[5]; a0 -= mq[7][2] * x[6]; a1 -= mq[7][3] * x[7]; mq[7] = *(const LAS f32x4*)(Mm + 3508);
            a0 -= mq[8][0] * x[8]; a1 -= mq[8][1] * x[9]; a0 -= mq[8][2] * x[10]; a1 -= mq[8][3] * x[11]; mq[8] = *(const LAS f32x4*)(Mm + 3520);
            a0 -= mq[9][0] * x[12]; a1 -= mq[9][1] * x[13]; a0 -= mq[9][2] * x[14]; a1 -= mq[9][3] * x[15]; mq[9] = *(const LAS f32x4*)(Mm + 3524);
            a0 -= mq[10][0] * x[16]; a1 -= mq[10][1] * x[17]; a0 -= mq[10][2] * x[18]; a1 -= mq[10][3] * x[19]; mq[10] = *(const LAS f32x4*)(Mm + 3528);
            a0 -= mq[11][0] * x[20]; a1 -= mq[11][1] * x[21]; a0 -= mq[11][2] * x[22]; a1 -= mq[11][3] * x[23]; mq[11] = *(const LAS f32x4*)(Mm + 3532);
            a0 -= mq[0][0] * x[24]; a1 -= mq[0][1] * x[25]; a0 -= mq[0][2] * x[26]; a1 -= mq[0][3] * x[27]; mq[0] = *(const LAS f32x4*)(Mm + 3536);
            a0 -= mq[1][0] * x[28]; a1 -= mq[1][1] * x[29]; a0 -= mq[1][2] * x[30]; a1 -= mq[1][3] * x[31]; mq[1] = *(const LAS f32x4*)(Mm + 3540);
            a0 -= mq[2][0] * x[32]; a1 -= mq[2][1] * x[33]; a0 -= mq[2][2] * x[34]; a1 -= mq[2][3] * x[35]; mq[2] = *(const LAS f32x4*)(Mm + 3544);
            a0 -= mq[3][0] * x[36]; a1 -= mq[3][1] * x[37]; a0 -= mq[3][2] * x[38]; a1 -= mq[3][3] * x[39]; mq[3] = *(const LAS f32x4*)(Mm + 3548);
            a0 -= mq[4][0] * x[40]; a1 -= mq[4][1] * x[41]; a0 -= mq[4][2] * x[42]; a1 -= mq[4][3] * x[43]; mq[4] = *(const LAS f32x4*)(Mm + 3552);
            a0 -= mq[5][0] * x[44]; a1 -= mq[5][1] * x[45]; a0 -= mq[5][2] * x[46]; a1 -= mq[5][3] * x[47]; mq[5] = *(const LAS f32x4*)(Mm + 3556);
            a0 -= mq[6][0] * x[48]; a1 -= mq[6][1] * x[49]; a0 -= mq[6][2] * x[50]; a1 -= mq[6][3] * x[51]; mq[6] = *(const LAS f32x4*)(Mm + 3560);
            a0 -= mq[7][0] * x[52]; a1 -= mq[7][1] * x[53]; x[54] = a0 + a1; mq[7] = *(const LAS f32x4*)(Mm + 3564);
            a0 = x[55]; a1 = 0.f; a0 -= mq[8][0] * x[0]; a1 -= mq[8][1] * x[1]; a0 -= mq[8][2] * x[2]; a1 -= mq[8][3] * x[3]; mq[8] = *(const LAS f32x4*)(Mm + 3568);
            a0 -= mq[9][0] * x[4]; a1 -= mq[9][1] * x[5]; a0 -= mq[9][2] * x[6]; a1 -= mq[9][3] * x[7]; mq[9] = *(const LAS f32x4*)(Mm + 3572);
            a0 -= mq[10][0] * x[8]; a1 -= mq[10][1] * x[9]; a0 -= mq[10][2] * x[10]; a1 -= mq[10][3] * x[11]; mq[10] = *(const LAS f32x4*)(Mm + 3584);
            a0 -= mq[11][0] * x[12]; a1 -= mq[11][1] * x[13]; a0 -= mq[11][2] * x[14]; a1 -= mq[11][3] * x[15]; mq[11] = *(const LAS f32x4*)(Mm + 3588);
            a0 -= mq[0][0] * x[16]; a1 -= mq[0][1] * x[17]; a0 -= mq[0][2] * x[18]; a1 -= mq[0][3] * x[19]; mq[0] = *(const LAS f32x4*)(Mm + 3592);
            a0 -= mq[1][0] * x[20]; a1 -= mq[1][1] * x[21]; a0 -= mq[1][2] * x[22]; a1 -= mq[1][3] * x[23]; mq[1] = *(const LAS f32x4*)(Mm + 3596);
            a0 -= mq[2][0] * x[24]; a1 -= mq[2][1] * x[25]; a0 -= mq[2][2] * x[26]; a1 -= mq[2][3] * x[27]; mq[2] = *(const LAS f32x4*)(Mm + 3600);
            a0 -= mq[3][0] * x[28]; a1 -= mq[3][1] * x[29]; a0 -= mq[3][2] * x[30]; a1 -= mq[3][3] * x[31]; mq[3] = *(const LAS f32x4*)(Mm + 3604);
            a0 -= mq[4][0] * x[32]; a1 -= mq[4][1] * x[33]; a0 -= mq[4][2] * x[34]; a1 -= mq[4][3] * x[35]; mq[4] = *(const LAS f32x4*)(Mm + 3608);
            a0 -= mq[5][0] * x[36]; a1 -= mq[5][1] * x[37]; a0 -= mq[5][2] * x[38]; a1 -= mq[5][3] * x[39]; mq[5] = *(const LAS f32x4*)(Mm + 3612);
            a0 -= mq[6][0] * x[40]; a1 -= mq[6][1] * x[41]; a0 -= mq[6][2] * x[42]; a1 -= mq[6][3] * x[43]; mq[6] = *(const LAS f32x4*)(Mm + 3616);
            a0 -= mq[7][0] * x[44]; a1 -= mq[7][1] * x[45]; a0 -= mq[7][2] * x[46]; a1 -= mq[7][3] * x[47]; mq[7] = *(const LAS f32x4*)(Mm + 3620);
            a0 -= mq[8][0] * x[48]; a1 -= mq[8][1] * x[49]; a0 -= mq[8][2] * x[50]; a1 -= mq[8][3] * x[51]; mq[8] = *(const LAS f32x4*)(Mm + 3624);
            a0 -= mq[9][0] * x[52]; a1 -= mq[9][1] * x[53]; a0 -= mq[9][2] * x[54]; x[55] = a0 + a1; mq[9] = *(const LAS f32x4*)(Mm + 3628);
            a0 = x[56]; a1 = 0.f; a0 -= mq[10][0] * x[0]; a1 -= mq[10][1] * x[1]; a0 -= mq[10][2] * x[2]; a1 -= mq[10][3] * x[3]; mq[10] = *(const LAS f32x4*)(Mm + 3632);
            a0 -= mq[11][0] * x[4]; a1 -= mq[11][1] * x[5]; a0 -= mq[11][2] * x[6]; a1 -= mq[11][3] * x[7]; mq[11] = *(const LAS f32x4*)(Mm + 3636);
            a0 -= mq[0][0] * x[8]; a1 -= mq[0][1] * x[9]; a0 -= mq[0][2] * x[10]; a1 -= mq[0][3] * x[11]; mq[0] = *(const LAS f32x4*)(Mm + 3648);
            a0 -= mq[1][0] * x[12]; a1 -= mq[1][1] * x[13]; a0 -= mq[1][2] * x[14]; a1 -= mq[1][3] * x[15]; mq[1] = *(const LAS f32x4*)(Mm + 3652);
            a0 -= mq[2][0] * x[16]; a1 -= mq[2][1] * x[17]; a0 -= mq[2][2] * x[18]; a1 -= mq[2][3] * x[19]; mq[2] = *(const LAS f32x4*)(Mm + 3656);
            a0 -= mq[3][0] * x[20]; a1 -= mq[3][1] * x[21]; a0 -= mq[3][2] * x[22]; a1 -= mq[3][3] * x[23]; mq[3] = *(const LAS f32x4*)(Mm + 3660);
            a0 -= mq[4][0] * x[24]; a1 -= mq[4][1] * x[25]; a0 -= mq[4][2] * x[26]; a1 -= mq[4][3] * x[27]; mq[4] = *(const LAS f32x4*)(Mm + 3664);
            a0 -= mq[5][0] * x[28]; a1 -= mq[5][1] * x[29]; a0 -= mq[5][2] * x[30]; a1 -= mq[5][3] * x[31]; mq[5] = *(const LAS f32x4*)(Mm + 3668);
            a0 -= mq[6][0] * x[32]; a1 -= mq[6][1] * x[33]; a0 -= mq[6][2] * x[34]; a1 -= mq[6][3] * x[35]; mq[6] = *(const LAS f32x4*)(Mm + 3672);
            a0 -= mq[7][0] * x[36]; a1 -= mq[7][1] * x[37]; a0 -= mq[7][2] * x[38]; a1 -= mq[7][3] * x[39]; mq[7] = *(const LAS f32x4*)(Mm + 3676);
            a0 -= mq[8][0] * x[40]; a1 -= mq[8][1] * x[41]; a0 -= mq[8][2] * x[42]; a1 -= mq[8][3] * x[43]; mq[8] = *(const LAS f32x4*)(Mm + 3680);
            a0 -= mq[9][0] * x[44]; a1 -= mq[9][1] * x[45]; a0 -= mq[9][2] * x[46]; a1 -= mq[9][3] * x[47]; mq[9] = *(const LAS f32x4*)(Mm + 3684);
            a0 -= mq[10][0] * x[48]; a1 -= mq[10][1] * x[49]; a0 -= mq[10][2] * x[50]; a1 -= mq[10][3] * x[51]; mq[10] = *(const LAS f32x4*)(Mm + 3688);
            a0 -= mq[11][0] * x[52]; a1 -= mq[11][1] * x[53]; a0 -= mq[11][2] * x[54]; a1 -= mq[11][3] * x[55]; x[56] = a0 + a1; mq[11] = *(const LAS f32x4*)(Mm + 3692);
            a0 = x[57]; a1 = 0.f; a0 -= mq[0][0] * x[0]; a1 -= mq[0][1] * x[1]; a0 -= mq[0][2] * x[2]; a1 -= mq[0][3] * x[3]; mq[0] = *(const LAS f32x4*)(Mm + 3696);
            a0 -= mq[1][0] * x[4]; a1 -= mq[1][1] * x[5]; a0 -= mq[1][2] * x[6]; a1 -= mq[1][3] * x[7]; mq[1] = *(const LAS f32x4*)(Mm + 3700);
            a0 -= mq[2][0] * x[8]; a1 -= mq[2][1] * x[9]; a0 -= mq[2][2] * x[10]; a1 -= mq[2][3] * x[11]; mq[2] = *(const LAS f32x4*)(Mm + 3704);
            a0 -= mq[3][0] * x[12]; a1 -= mq[3][1] * x[13]; a0 -= mq[3][2] * x[14]; a1 -= mq[3][3] * x[15]; mq[3] = *(const LAS f32x4*)(Mm + 3712);
            a0 -= mq[4][0] * x[16]; a1 -= mq[4][1] * x[17]; a0 -= mq[4][2] * x[18]; a1 -= mq[4][3] * x[19]; mq[4] = *(const LAS f32x4*)(Mm + 3716);
            a0 -= mq[5][0] * x[20]; a1 -= mq[5][1] * x[21]; a0 -= mq[5][2] * x[22]; a1 -= mq[5][3] * x[23]; mq[5] = *(const LAS f32x4*)(Mm + 3720);
            a0 -= mq[6][0] * x[24]; a1 -= mq[6][1] * x[25]; a0 -= mq[6][2] * x[26]; a1 -= mq[6][3] * x[27]; mq[6] = *(const LAS f32x4*)(Mm + 3724);
            a0 -= mq[7][0] * x[28]; a1 -= mq[7][1] * x[29]; a0 -= mq[7][2] * x[30]; a1 -= mq[7][3] * x[31]; mq[7] = *(const LAS f32x4*)(Mm + 3728);
            a0 -= mq[8][0] * x[32]; a1 -= mq[8][1] * x[33]; a0 -= mq[8][2] * x[34]; a1 -= mq[8][3] * x[35]; mq[8] = *(const LAS f32x4*)(Mm + 3732);
            a0 -= mq[9][0] * x[36]; a1 -= mq[9][1] * x[37]; a0 -= mq[9][2] * x[38]; a1 -= mq[9][3] * x[39]; mq[9] = *(const LAS f32x4*)(Mm + 3736);
            a0 -= mq[10][0] * x[40]; a1 -= mq[10][1] * x[41]; a0 -= mq[10][2] * x[42]; a1 -= mq[10][3] * x[43]; mq[10] = *(const LAS f32x4*)(Mm + 3740);
            a0 -= mq[11][0] * x[44]; a1 -= mq[11][1] * x[45]; a0 -= mq[11][2] * x[46]; a1 -= mq[11][3] * x[47]; mq[11] = *(const LAS f32x4*)(Mm + 3744);
            a0 -= mq[0][0] * x[48]; a1 -= mq[0][1] * x[49]; a0 -= mq[0][2] * x[50]; a1 -= mq[0][3] * x[51]; mq[0] = *(const LAS f32x4*)(Mm + 3748);
            a0 -= mq[1][0] * x[52]; a1 -= mq[1][1] * x[53]; a0 -= mq[1][2] * x[54]; a1 -= mq[1][3] * x[55]; mq[1] = *(const LAS f32x4*)(Mm + 3752);
            a0 -= mq[2][0] * x[56]; x[57] = a0 + a1; mq[2] = *(const LAS f32x4*)(Mm + 3756);
            a0 = x[58]; a1 = 0.f; a0 -= mq[3][0] * x[0]; a1 -= mq[3][1] * x[1]; a0 -= mq[3][2] * x[2]; a1 -= mq[3][3] * x[3]; mq[3] = *(const LAS f32x4*)(Mm + 3760);
            a0 -= mq[4][0] * x[4]; a1 -= mq[4][1] * x[5]; a0 -= mq[4][2] * x[6]; a1 -= mq[4][3] * x[7]; mq[4] = *(const LAS f32x4*)(Mm + 3764);
            a0 -= mq[5][0] * x[8]; a1 -= mq[5][1] * x[9]; a0 -= mq[5][2] * x[10]; a1 -= mq[5][3] * x[11]; mq[5] = *(const LAS f32x4*)(Mm + 3768);
            a0 -= mq[6][0] * x[12]; a1 -= mq[6][1] * x[13]; a0 -= mq[6][2] * x[14]; a1 -= mq[6][3] * x[15]; mq[6] = *(const LAS f32x4*)(Mm + 3776);
            a0 -= mq[7][0] * x[16]; a1 -= mq[7][1] * x[17]; a0 -= mq[7][2] * x[18]; a1 -= mq[7][3] * x[19]; mq[7] = *(const LAS f32x4*)(Mm + 3780);
            a0 -= mq[8][0] * x[20]; a1 -= mq[8][1] * x[21]; a0 -= mq[8][2] * x[22]; a1 -= mq[8][3] * x[23]; mq[8] = *(const LAS f32x4*)(Mm + 3784);
            a0 -= mq[9][0] * x[24]; a1 -= mq[9][1] * x[25]; a0 -= mq[9][2] * x[26]; a1 -= mq[9][3] * x[27]; mq[9] = *(const LAS f32x4*)(Mm + 3788);
            a0 -= mq[10][0] * x[28]; a1 -= mq[10][1] * x[29]; a0 -= mq[10][2] * x[30]; a1 -= mq[10][3] * x[31]; mq[10] = *(const LAS f32x4*)(Mm + 3792);
            a0 -= mq[11][0] * x[32]; a1 -= mq[11][1] * x[33]; a0 -= mq[11][2] * x[34]; a1 -= mq[11][3] * x[35]; mq[11] = *(const LAS f32x4*)(Mm + 3796);
            a0 -= mq[0][0] * x[36]; a1 -= mq[0][1] * x[37]; a0 -= mq[0][2] * x[38]; a1 -= mq[0][3] * x[39]; mq[0] = *(const LAS f32x4*)(Mm + 3800);
            a0 -= mq[1][0] * x[40]; a1 -= mq[1][1] * x[41]; a0 -= mq[1][2] * x[42]; a1 -= mq[1][3] * x[43]; mq[1] = *(const LAS f32x4*)(Mm + 3804);
            a0 -= mq[2][0] * x[44]; a1 -= mq[2][1] * x[45]; a0 -= mq[2][2] * x[46]; a1 -= mq[2][3] * x[47]; mq[2] = *(const LAS f32x4*)(Mm + 3808);
            a0 -= mq[3][0] * x[48]; a1 -= mq[3][1] * x[49]; a0 -= mq[3][2] * x[50]; a1 -= mq[3][3] * x[51]; mq[3] = *(const LAS f32x4*)(Mm + 3812);
            a0 -= mq[4][0] * x[52]; a1 -= mq[4][1] * x[53]; a0 -= mq[4][2] * x[54]; a1 -= mq[4][3] * x[55]; mq[4] = *(const LAS f32x4*)(Mm + 3816);
            a0 -= mq[5][0] * x[56]; a1 -= mq[5][1] * x[57]; x[58] = a0 + a1; mq[5] = *(const LAS f32x4*)(Mm + 3820);
            a0 = x[59]; a1 = 0.f; a0 -= mq[6][0] * x[0]; a1 -= mq[6][1] * x[1]; a0 -= mq[6][2] * x[2]; a1 -= mq[6][3] * x[3]; mq[6] = *(const LAS f32x4*)(Mm + 3824);
            a0 -= mq[7][0] * x[4]; a1 -= mq[7][1] * x[5]; a0 -= mq[7][2] * x[6]; a1 -= mq[7][3] * x[7]; mq[7] = *(const LAS f32x4*)(Mm + 3828);
            a0 -= mq[8][0] * x[8]; a1 -= mq[8][1] * x[9]; a0 -= mq[8][2] * x[10]; a1 -= mq[8][3] * x[11]; mq[8] = *(const LAS f32x4*)(Mm + 3832);
            a0 -= mq[9][0] * x[12]; a1 -= mq[9][1] * x[13]; a0 -= mq[9][2] * x[14]; a1 -= mq[9][3] * x[15]; mq[9] = *(const LAS f32x4*)(Mm + 3840);
            a0 -= mq[10][0] * x[16]; a1 -= mq[10][1] * x[17]; a0 -= mq[10][2] * x[18]; a1 -= mq[10][3] * x[19]; mq[10] = *(const LAS f32x4*)(Mm + 3844);
            a0 -= mq[11][0] * x[20]; a1 -= mq[11][1] * x[21]; a0 -= mq[11][2] * x[22]; a1 -= mq[11][3] * x[23]; mq[11] = *(const LAS f32x4*)(Mm + 3848);
            a0 -= mq[0][0] * x[24]; a1 -= mq[0][1] * x[25]; a0 -= mq[0][2] * x[26]; a1 -= mq[0][3] * x[27]; mq[0] = *(const LAS f32x4*)(Mm + 3852);
            a0 -= mq[1][0] * x[28]; a1 -= mq[1][1] * x[29]; a0 -= mq[1][2] * x[30]; a1 -= mq[1][3] * x[31]; mq[1] = *(const LAS f32x4*)(Mm + 3856);
            a0 -= mq[2][0] * x[32]; a1 -= mq[2][1] * x[33]; a0 -= mq[2][2] * x[34]; a1 -= mq[2][3] * x[35]; mq[2] = *(const LAS f32x4*)(Mm + 3860);
            a0 -= mq[3][0] * x[36]; a1 -= mq[3][1] * x[37]; a0 -= mq[3][2] * x[38]; a1 -= mq[3][3] * x[39]; mq[3] = *(const LAS f32x4*)(Mm + 3864);
            a0 -= mq[4][0] * x[40]; a1 -= mq[4][1] * x[41]; a0 -= mq[4][2] * x[42]; a1 -= mq[4][3] * x[43]; mq[4] = *(const LAS f32x4*)(Mm + 3868);
            a0 -= mq[5][0] * x[44]; a1 -= mq[5][1] * x[45]; a0 -= mq[5][2] * x[46]; a1 -= mq[5][3] * x[47]; mq[5] = *(const LAS f32x4*)(Mm + 3872);
            a0 -= mq[6][0] * x[48]; a1 -= mq[6][1] * x[49]; a0 -= mq[6][2] * x[50]; a1 -= mq[6][3] * x[51]; mq[6] = *(const LAS f32x4*)(Mm + 3876);
            a0 -= mq[7][0] * x[52]; a1 -= mq[7][1] * x[53]; a0 -= mq[7][2] * x[54]; a1 -= mq[7][3] * x[55]; mq[7] = *(const LAS f32x4*)(Mm + 3880);
            a0 -= mq[8][0] * x[56]; a1 -= mq[8][1] * x[57]; a0 -= mq[8][2] * x[58]; x[59] = a0 + a1; mq[8] = *(const LAS f32x4*)(Mm + 3884);
            a0 = x[60]; a1 = 0.f; a0 -= mq[9][0] * x[0]; a1 -= mq[9][1] * x[1]; a0 -= mq[9][2] * x[2]; a1 -= mq[9][3] * x[3]; mq[9] = *(const LAS f32x4*)(Mm + 3888);
            a0 -= mq[10][0] * x[4]; a1 -= mq[10][1] * x[5]; a0 -= mq[10][2] * x[6]; a1 -= mq[10][3] * x[7]; mq[10] = *(const LAS f32x4*)(Mm + 3892);
            a0 -= mq[11][0] * x[8]; a1 -= mq[11][1] * x[9]; a0 -= mq[11][2] * x[10]; a1 -= mq[11][3] * x[11]; mq[11] = *(const LAS f32x4*)(Mm + 3896);
            a0 -= mq[0][0] * x[12]; a1 -= mq[0][1] * x[13]; a0 -= mq[0][2] * x[14]; a1 -= mq[0][3] * x[15]; mq[0] = *(const LAS f32x4*)(Mm + 3904);
            a0 -= mq[1][0] * x[16]; a1 -= mq[1][1] * x[17]; a0 -= mq[1][2] * x[18]; a1 -= mq[1][3] * x[19]; mq[1] = *(const LAS f32x4*)(Mm + 3908);
            a0 -= mq[2][0] * x[20]; a1 -= mq[2][1] * x[21]; a0 -= mq[2][2] * x[22]; a1 -= mq[2][3] * x[23]; mq[2] = *(const LAS f32x4*)(Mm + 3912);
            a0 -= mq[3][0] * x[24]; a1 -= mq[3][1] * x[25]; a0 -= mq[3][2] * x[26]; a1 -= mq[3][3] * x[27]; mq[3] = *(const LAS f32x4*)(Mm + 3916);
            a0 -= mq[4][0] * x[28]; a1 -= mq[4][1] * x[29]; a0 -= mq[4][2] * x[30]; a1 -= mq[4][3] * x[31]; mq[4] = *(const LAS f32x4*)(Mm + 3920);
            a0 -= mq[5][0] * x[32]; a1 -= mq[5][1] * x[33]; a0 -= mq[5][2] * x[34]; a1 -= mq[5][3] * x[35]; mq[5] = *(const LAS f32x4*)(Mm + 3924);
            a0 -= mq[6][0] * x[36]; a1 -= mq[6][1] * x[37]; a0 -= mq[6][2] * x[38]; a1 -= mq[6][3] * x[39]; mq[6] = *(const LAS f32x4*)(Mm + 3928);
            a0 -= mq[7][0] * x[40]; a1 -= mq[7][1] * x[41]; a0 -= mq[7][2] * x[42]; a1 -= mq[7][3] * x[43]; mq[7] = *(const LAS f32x4*)(Mm + 3932);
            a0 -= mq[8][0] * x[44]; a1 -= mq[8][1] * x[45]; a0 -= mq[8][2] * x[46]; a1 -= mq[8][3] * x[47]; mq[8] = *(const LAS f32x4*)(Mm + 3936);
            a0 -= mq[9][0] * x[48]; a1 -= mq[9][1] * x[49]; a0 -= mq[9][2] * x[50]; a1 -= mq[9][3] * x[51]; mq[9] = *(const LAS f32x4*)(Mm + 3940);
            a0 -= mq[10][0] * x[52]; a1 -= mq[10][1] * x[53]; a0 -= mq[10][2] * x[54]; a1 -= mq[10][3] * x[55]; mq[10] = *(const LAS f32x4*)(Mm + 3944);
            a0 -= mq[11][0] * x[56]; a1 -= mq[11][1] * x[57]; a0 -= mq[11][2] * x[58]; a1 -= mq[11][3] * x[59]; x[60] = a0 + a1; mq[11] = *(const LAS f32x4*)(Mm + 3948);
            a0 = x[61]; a1 = 0.f; a0 -= mq[0][0] * x[0]; a1 -= mq[0][1] * x[1]; a0 -= mq[0][2] * x[2]; a1 -= mq[0][3] * x[3]; mq[0] = *(const LAS f32x4*)(Mm + 3952);
            a0 -= mq[1][0] * x[4]; a1 -= mq[1][1] * x[5]; a0 -= mq[1][2] * x[6]; a1 -= mq[1][3] * x[7]; mq[1] = *(const LAS f32x4*)(Mm + 3956);
            a0 -= mq[2][0] * x[8]; a1 -= mq[2][1] * x[9]; a0 -= mq[2][2] * x[10]; a1 -= mq[2][3] * x[11]; mq[2] = *(const LAS f32x4*)(Mm + 3960);
            a0 -= mq[3][0] * x[12]; a1 -= mq[3][1] * x[13]; a0 -= mq[3][2] * x[14]; a1 -= mq[3][3] * x[15]; mq[3] = *(const LAS f32x4*)(Mm + 3964);
            a0 -= mq[4][0] * x[16]; a1 -= mq[4][1] * x[17]; a0 -= mq[4][2] * x[18]; a1 -= mq[4][3] * x[19]; mq[4] = *(const LAS f32x4*)(Mm + 3968);
            a0 -= mq[5][0] * x[20]; a1 -= mq[5][1] * x[21]; a0 -= mq[5][2] * x[22]; a1 -= mq[5][3] * x[23]; mq[5] = *(const LAS f32x4*)(Mm + 3972);
            a0 -= mq[6][0] * x[24]; a1 -= mq[6][1] * x[25]; a0 -= mq[6][2] * x[26]; a1 -= mq[6][3] * x[27]; mq[6] = *(const LAS f32x4*)(Mm + 3976);
            a0 -= mq[7][0] * x[28]; a1 -= mq[7][1] * x[29]; a0 -= mq[7][2] * x[30]; a1 -= mq[7][3] * x[31]; mq[7] = *(const LAS f32x4*)(Mm + 3980);
            a0 -= mq[8][0] * x[32]; a1 -= mq[8][1] * x[33]; a0 -= mq[8][2] * x[34]; a1 -= mq[8][3] * x[35]; mq[8] = *(const LAS f32x4*)(Mm + 3984);
            a0 -= mq[9][0] * x[36]; a1 -= mq[9][1] * x[37]; a0 -= mq[9][2] * x[38]; a1 -= mq[9][3] * x[39]; mq[9] = *(const LAS f32x4*)(Mm + 3988);
            a0 -= mq[10][0] * x[40]; a1 -= mq[10][1] * x[41]; a0 -= mq[10][2] * x[42]; a1 -= mq[10][3] * x[43]; mq[10] = *(const LAS f32x4*)(Mm + 3992);
            a0 -= mq[11][0] * x[44]; a1 -= mq[11][1] * x[45]; a0 -= mq[11][2] * x[46]; a1 -= mq[11][3] * x[47]; mq[11] = *(const LAS f32x4*)(Mm + 3996);
            a0 -= mq[0][0] * x[48]; a1 -= mq[0][1] * x[49]; a0 -= mq[0][2] * x[50]; a1 -= mq[0][3] * x[51]; mq[0] = *(const LAS f32x4*)(Mm + 4000);
            a0 -= mq[1][0] * x[52]; a1 -= mq[1][1] * x[53]; a0 -= mq[1][2] * x[54]; a1 -= mq[1][3] * x[55]; mq[1] = *(const LAS f32x4*)(Mm + 4004);
            a0 -= mq[2][0] * x[56]; a1 -= mq[2][1] * x[57]; a0 -= mq[2][2] * x[58]; a1 -= mq[2][3] * x[59]; mq[2] = *(const LAS f32x4*)(Mm + 4008);
            a0 -= mq[3][0] * x[60]; x[61] = a0 + a1; mq[3] = *(const LAS f32x4*)(Mm + 4012);
            a0 = x[62]; a1 = 0.f; a0 -= mq[4][0] * x[0]; a1 -= mq[4][1] * x[1]; a0 -= mq[4][2] * x[2]; a1 -= mq[4][3] * x[3]; mq[4] = *(const LAS f32x4*)(Mm + 4016);
            a0 -= mq[5][0] * x[4]; a1 -= mq[5][1] * x[5]; a0 -= mq[5][2] * x[6]; a1 -= mq[5][3] * x[7]; mq[5] = *(const LAS f32x4*)(Mm + 4020);
            a0 -= mq[6][0] * x[8]; a1 -= mq[6][1] * x[9]; a0 -= mq[6][2] * x[10]; a1 -= mq[6][3] * x[11]; mq[6] = *(const LAS f32x4*)(Mm + 4024);
            a0 -= mq[7][0] * x[12]; a1 -= mq[7][1] * x[13]; a0 -= mq[7][2] * x[14]; a1 -= mq[7][3] * x[15]; mq[7] = *(const LAS f32x4*)(Mm + 4028);
            a0 -= mq[8][0] * x[16]; a1 -= mq[8][1] * x[17]; a0 -= mq[8][2] * x[18]; a1 -= mq[8][3] * x[19]; mq[8] = *(const LAS f32x4*)(Mm + 4032);
            a0 -= mq[9][0] * x[20]; a1 -= mq[9][1] * x[21]; a0 -= mq[9][2] * x[22]; a1 -= mq[9][3] * x[23]; mq[9] = *(const LAS f32x4*)(Mm + 4036);
            a0 -= mq[10][0] * x[24]; a1 -= mq[10][1] * x[25]; a0 -= mq[10][2] * x[26]; a1 -= mq[10][3] * x[27]; mq[10] = *(const LAS f32x4*)(Mm + 4040);
            a0 -= mq[11][0] * x[28]; a1 -= mq[11][1] * x[29]; a0 -= mq[11][2] * x[30]; a1 -= mq[11][3] * x[31]; mq[11] = *(const LAS f32x4*)(Mm + 4044);
            a0 -= mq[0][0] * x[32]; a1 -= mq[0][1] * x[33]; a0 -= mq[0][2] * x[34]; a1 -= mq[0][3] * x[35]; mq[0] = *(const LAS f32x4*)(Mm + 4048);
            a0 -= mq[1][0] * x[36]; a1 -= mq[1][1] * x[37]; a0 -= mq[1][2] * x[38]; a1 -= mq[1][3] * x[39]; mq[1] = *(const LAS f32x4*)(Mm + 4052);
            a0 -= mq[2][0] * x[40]; a1 -= mq[2][1] * x[41]; a0 -= mq[2][2] * x[42]; a1 -= mq[2][3] * x[43]; mq[2] = *(const LAS f32x4*)(Mm + 4056);
            a0 -= mq[3][0] * x[44]; a1 -= mq[3][1] * x[45]; a0 -= mq[3][2] * x[46]; a1 -= mq[3][3] * x[47]; mq[3] = *(const LAS f32x4*)(Mm + 4060);
            a0 -= mq[4][0] * x[48]; a1 -= mq[4][1] * x[49]; a0 -= mq[4][2] * x[50]; a1 -= mq[4][3] * x[51]; mq[4] = *(const LAS f32x4*)(Mm + 4064);
            a0 -= mq[5][0] * x[52]; a1 -= mq[5][1] * x[53]; a0 -= mq[5][2] * x[54]; a1 -= mq[5][3] * x[55]; mq[5] = *(const LAS f32x4*)(Mm + 4068);
            a0 -= mq[6][0] * x[56]; a1 -= mq[6][1] * x[57]; a0 -= mq[6][2] * x[58]; a1 -= mq[6][3] * x[59]; mq[6] = *(const LAS f32x4*)(Mm + 4072);
            a0 -= mq[7][0] * x[60]; a1 -= mq[7][1] * x[61]; x[62] = a0 + a1; mq[7] = *(const LAS f32x4*)(Mm + 4076);
            a0 = x[63]; a1 = 0.f; a0 -= mq[8][0] * x[0]; a1 -= mq[8][1] * x[1]; a0 -= mq[8][2] * x[2]; a1 -= mq[8][3] * x[3]; mq[8] = *(const LAS f32x4*)(Mm + 4080);
            a0 -= mq[9][0] * x[4]; a1 -= mq[9][1] * x[5]; a0 -= mq[9][2] * x[6]; a1 -= mq[9][3] * x[7]; mq[9] = *(const LAS f32x4*)(Mm + 4084);
            a0 -= mq[10][0] * x[8]; a1 -= mq[10][1] * x[9]; a0 -= mq[10][2] * x[10]; a1 -= mq[10][3] * x[11]; mq[10] = *(const LAS f32x4*)(Mm + 4088);
            a0 -= mq[11][0] * x[12]; a1 -= mq[11][1] * x[13]; a0 -= mq[11][2] * x[14]; a1 -= mq[11][3] * x[15]; mq[11] = *(const LAS f32x4*)(Mm + 4092);
            a0 -= mq[0][0] * x[16]; a1 -= mq[0][1] * x[17]; a0 -= mq[0][2] * x[18]; a1 -= mq[0][3] * x[19];
            a0 -= mq[1][0] * x[20]; a1 -= mq[1][1] * x[21]; a0 -= mq[1][2] * x[22]; a1 -= mq[1][3] * x[23];
            a0 -= mq[2][0] * x[24]; a1 -= mq[2][1] * x[25]; a0 -= mq[2][2] * x[26]; a1 -= mq[2][3] * x[27];
            a0 -= mq[3][0] * x[28]; a1 -= mq[3][1] * x[29]; a0 -= mq[3][2] * x[30]; a1 -= mq[3][3] * x[31];
            a0 -= mq[4][0] * x[32]; a1 -= mq[4][1] * x[33]; a0 -= mq[4][2] * x[34]; a1 -= mq[4][3] * x[35];
            a0 -= mq[5][0] * x[36]; a1 -= mq[5][1] * x[37]; a0 -= mq[5][2] * x[38]; a1 -= mq[5][3] * x[39];
            a0 -= mq[6][0] * x[40]; a1 -= mq[6][1] * x[41]; a0 -= mq[6][2] * x[42]; a1 -= mq[6][3] * x[43];
            a0 -= mq[7][0] * x[44]; a1 -= mq[7][1] * x[45]; a0 -= mq[7][2] * x[46]; a1 -= mq[7][3] * x[47];
            a0 -= mq[8][0] * x[48]; a1 -= mq[8][1] * x[49]; a0 -= mq[8][2] * x[50]; a1 -= mq[8][3] * x[51];
            a0 -= mq[9][0] * x[52]; a1 -= mq[9][1] * x[53]; a0 -= mq[9][2] * x[54]; a1 -= mq[9][3] * x[55];
            a0 -= mq[10][0] * x[56]; a1 -= mq[10][1] * x[57]; a0 -= mq[10][2] * x[58]; a1 -= mq[10][3] * x[59];
            a0 -= mq[11][0] * x[60]; a1 -= mq[11][1] * x[61]; a0 -= mq[11][2] * x[62]; x[63] = a0 + a1;
            if (c < 128) {
#pragma unroll
                for (int r = 0; r < 64; ++r) ub[(size_t)item * 8192 + r * 128 + c] = x[r];
            } else {
#pragma unroll
                for (int r = 0; r < 64; ++r) wdc[(size_t)item * 8192 + r * 128 + (c - 128)] = f2bf(-x[r]);
            }
        } else {
            const int tt = tid - 256;
#pragma unroll
            for (int i = 0; i < 4; ++i) { const int vid = tt + 256 * i, r = vid >> 4, d0 = (vid & 15) * 8; float f[8]; unpack8(*(const LAS u32x4*)(lds + P5_QS + r * 272 + d0 * 2), f);
                const float e = scale * __expf(dec[r]);
#pragma unroll
                for (int q = 0; q < 8; ++q) f[q] *= e;
                *(u32x4*)(qd + (size_t)item * 8192 + r * 128 + d0) = pack8(f); }
#pragma unroll
            for (int i = 0; i < 4; ++i) { const int vid = tt + 256 * i, d = vid >> 3, rg = (vid & 7) * 8; float f[8];
#pragma unroll
                for (int q = 0; q < 8; ++q) f[q] = bf2f(*(const LAS bf16_t*)(lds + P5_KS + (rg + q) * 272 + d * 2)) * __expf(last - dec[rg + q]);
                *(u32x4*)(kt + (size_t)item * 8192 + d * 64 + rg) = pack8(f); }
            if (tt == 0) cdv[item] = __expf(last);
        }
    }
    __syncthreads();
}

constexpr int SB_WD = 0, SB_QD = 17408, SB_KT = 34816, SB_QK = 53248, SB_UB = 62464, SB_SIZE = 66560;
constexpr int SC_ST = 2 * SB_SIZE, SC_UT = SC_ST + 4352, SC_END = SC_UT + 2304;
static_assert(SC_END <= LDS_BYTES, "lds");
__device__ __forceinline__ void scan_phase(const Params& p, int bid, int nblk, LAS unsigned char* lds) {
    const int tid = threadIdx.x, lane = tid & 63, wid = tid >> 6, fr = lane & 15, fq = lane >> 4;
    const bf16_t* wdc = (const bf16_t*)(p.ws + WS_WDC); const bf16_t* qd = (const bf16_t*)(p.ws + WS_QD); const bf16_t* kt = (const bf16_t*)(p.ws + WS_KT); const bf16_t* qk = (const bf16_t*)(p.ws + WS_QK);
    const float* cdv = (const float*)(p.ws + WS_CD); const float* ub = p.out + OS_UB; float* obuf = p.out + OS_O;
    for (int item = bid; item < 256; item += nblk) {
        const int xcd = item & 7, iq = item >> 3, bh = xcd * 4 + (iq >> 3), sl = iq & 7, h = bh & 7, b = bh >> 3;
        u32x4 r_wd[2], r_qd[2], r_kt[2], r_qk, r_ub;
        auto gload = [&](int n) {
            const size_t it = (size_t)(bh * 32 + n);
#pragma unroll
            for (int i = 0; i < 2; ++i) { const int ch = tid + 512 * i; r_wd[i] = *(const u32x4*)(wdc + it * 8192 + ch * 8); r_qd[i] = *(const u32x4*)(qd + it * 8192 + ch * 8); r_kt[i] = *(const u32x4*)(kt + it * 8192 + ch * 8); }
            r_qk = *(const u32x4*)(qk + it * 4096 + tid * 8);
            if (tid < 256) r_ub = *(const u32x4*)(ub + it * 8192 + (tid >> 2) * 128 + sl * 16 + (tid & 3) * 4);
        };
        auto lstore = [&](int buf) {
            LAS unsigned char* B = lds + buf * SB_SIZE;
#pragma unroll
            for (int i = 0; i < 2; ++i) { const int ch = tid + 512 * i; const int r = ch >> 4, c8 = (ch & 15) * 8; *(LAS u32x4*)(B + SB_WD + r * 272 + c8 * 2) = r_wd[i]; *(LAS u32x4*)(B + SB_QD + r * 272 + c8 * 2) = r_qd[i];
                const int d = ch >> 3, t8 = (ch & 7) * 8; *(LAS u32x4*)(B + SB_KT + d * 144 + t8 * 2) = r_kt[i]; }
            { const int r = tid >> 3, s8 = (tid & 7) * 8; *(LAS u32x4*)(B + SB_QK + r * 144 + s8 * 2) = r_qk; }
            if (tid < 256) *(LAS u32x4*)(B + SB_UB + (tid >> 2) * 64 + (tid & 3) * 16) = r_ub;
        };
        __syncthreads();
        gload(0);
        for (int i = tid; i < 4352 / 4; i += 512) *(LAS unsigned*)(lds + SC_ST + i * 4) = 0u;
        lstore(0);
        f32x4 sacc = (f32x4){0.f, 0.f, 0.f, 0.f};
        __syncthreads();
        for (int n = 0; n < 32; ++n) {
            const int cur = n & 1; LAS unsigned char* B = lds + cur * SB_SIZE;
            if (n + 1 < 32) gload(n + 1);
            const float cd = cdv[bh * 32 + n];
            f32x4 acc;
            const int tw = wid & 3;
            if (wid < 4) {
#pragma unroll
                for (int j = 0; j < 4; ++j) acc[j] = *(const LAS float*)(B + SB_UB + ((tw * 16 + fq * 4 + j) * 16 + fr) * 4);
#pragma unroll
                for (int kk = 0; kk < 4; ++kk) { const bf16x8 a = *(const LAS bf16x8*)(B + SB_WD + (tw * 16 + fr) * 272 + (kk * 32 + fq * 8) * 2); const bf16x8 bb = *(const LAS bf16x8*)(lds + SC_ST + fr * 272 + (kk * 32 + fq * 8) * 2);
                    acc = __builtin_amdgcn_mfma_f32_16x16x32_bf16(a, bb, acc, 0, 0, 0); }
                u32x2 w; w.x = pk2(acc[0], acc[1]); w.y = pk2(acc[2], acc[3]);
                *(LAS u32x2*)(lds + SC_UT + fr * 144 + (tw * 16 + fq * 4) * 2) = w;
            } else {
                acc = (f32x4){0.f, 0.f, 0.f, 0.f};
#pragma unroll
                for (int kk = 0; kk < 4; ++kk) { const bf16x8 a = *(const LAS bf16x8*)(B + SB_QD + (tw * 16 + fr) * 272 + (kk * 32 + fq * 8) * 2); const bf16x8 bb = *(const LAS bf16x8*)(lds + SC_ST + fr * 272 + (kk * 32 + fq * 8) * 2);
                    acc = __builtin_amdgcn_mfma_f32_16x16x32_bf16(a, bb, acc, 0, 0, 0); }
            }
            __syncthreads();
            sacc *= cd;
#pragma unroll
            for (int kk = 0; kk < 2; ++kk) { const bf16x8 a = *(const LAS bf16x8*)(B + SB_KT + (wid * 16 + fr) * 144 + (kk * 32 + fq * 8) * 2); const bf16x8 bb = *(const LAS bf16x8*)(lds + SC_UT + fr * 144 + (kk * 32 + fq * 8) * 2);
                sacc = __builtin_amdgcn_mfma_f32_16x16x32_bf16(a, bb, sacc, 0, 0, 0); }
            if (wid >= 4) {
#pragma unroll
                for (int kk = 0; kk < 2; ++kk) { const bf16x8 a = *(const LAS bf16x8*)(B + SB_QK + (tw * 16 + fr) * 144 + (kk * 32 + fq * 8) * 2); const bf16x8 bb = *(const LAS bf16x8*)(lds + SC_UT + fr * 144 + (kk * 32 + fq * 8) * 2);
                    acc = __builtin_amdgcn_mfma_f32_16x16x32_bf16(a, bb, acc, 0, 0, 0); }
#pragma unroll
                for (int j = 0; j < 4; ++j) obuf[(size_t)(b * 2048 + n * 64 + tw * 16 + fq * 4 + j) * 1024 + h * 128 + sl * 16 + fr] = acc[j];
            }
            { u32x2 w; w.x = pk2(sacc[0], sacc[1]); w.y = pk2(sacc[2], sacc[3]); *(LAS u32x2*)(lds + SC_ST + fr * 272 + (wid * 16 + fq * 4) * 2) = w; }
            if (n + 1 < 32) lstore(cur ^ 1);
            __syncthreads();
        }
#pragma unroll
        for (int j = 0; j < 4; ++j) p.out[O_DP + ((size_t)bh * 128 + wid * 16 + fq * 4 + j) * 128 + sl * 16 + fr] = sacc[j];
    }
    __syncthreads();
    {
        const bf16_t* qn = (const bf16_t*)(p.ws + WS_QN); const bf16_t* kn = (const bf16_t*)(p.ws + WS_KN); const bf16_t* vv = (const bf16_t*)(p.ws + WS_VV);
        const float* gbuf = (const float*)(p.ws + WS_G); const float* bbuf = (const float*)(p.ws + WS_BETA);
        const int grp = tid >> 8, w4 = (tid >> 6) & 3, j = w4 * 32 + (lane & 31), half = lane >> 5;
        LAS float* qs = (LAS float*)lds + grp * 1024;
        LAS float* ks = qs + 512;
        const float scale = 0.08838834764831845f;
        for (int it0 = bid * 2; it0 < 1024; it0 += nblk * 2) {
            const int item = it0 + grp, sb = item >> 3, h = item & 7;
            __syncthreads();
#pragma unroll
            for (int i = 0; i < 4; ++i) { const int idx = (tid & 255) + 256 * i, tk = idx >> 7, c = idx & 127, t = tk & 3; const size_t go = (size_t)(TP + sb * 4 + t) * 1024 + h * 128 + c;
                if (tk < 4) qs[t * 128 + c] = bf2f(qn[go]); else ks[t * 128 + c] = bf2f(kn[go]); }
            float S[64];
            const float* s0 = p.in[4] + (size_t)item * 16384 + (size_t)half * 64 * 128 + j;
#pragma unroll
            for (int i = 0; i < 64; ++i) S[i] = __builtin_nontemporal_load(s0 + i * 128);
            __syncthreads();
#pragma unroll 1
            for (int t = 0; t < 4; ++t) {
                const int row = TP + sb * 4 + t;
                const float a = __expf(gbuf[row * 8 + h]), be = bbuf[row * 8 + h], v = bf2f(vv[(size_t)row * 1024 + h * 128 + j]);
                float kS = 0.f;
#pragma unroll
                for (int i4 = 0; i4 < 16; ++i4) { const f32x4 k4 = *(const LAS f32x4*)(ks + t * 128 + half * 64 + i4 * 4); kS += k4[0] * S[i4 * 4] + k4[1] * S[i4 * 4 + 1] + k4[2] * S[i4 * 4 + 2] + k4[3] * S[i4 * 4 + 3]; }
                kS += __shfl_xor(kS, 32);
                const float coef = be * (v - a * kS);
                float o = 0.f;
#pragma unroll
                for (int i4 = 0; i4 < 16; ++i4) { const f32x4 k4 = *(const LAS f32x4*)(ks + t * 128 + half * 64 + i4 * 4); const f32x4 q4 = *(const LAS f32x4*)(qs + t * 128 + half * 64 + i4 * 4);
#pragma unroll
                    for (int q = 0; q < 4; ++q) { S[i4 * 4 + q] = a * S[i4 * 4 + q] + k4[q] * coef; o += q4[q] * S[i4 * 4 + q]; } }
                o += __shfl_xor(o, 32);
                if (half == 0) obuf[(size_t)row * 1024 + h * 128 + j] = o * scale;
            }
            float* so = p.out + O_DS + (size_t)item * 16384 + (size_t)half * 64 * 128 + j;
#pragma unroll
            for (int i = 0; i < 64; ++i) so[i * 128] = S[i];
        }
    }
    __syncthreads();
}

__device__ __forceinline__ void onorm_phase(const Params& p, int bid, int nblk) {
    const int lane = threadIdx.x & 63, wid = threadIdx.x >> 6;
    const float* obuf = p.out + OS_O; const bf16_t* proj = (const bf16_t*)(p.ws + WS_PROJ); bf16_t* acat = (bf16_t*)(p.ws + WS_U); const float* og = p.in[14];
    for (int row = bid * 8 + wid; row < TT; row += nblk * 8) {
        const int c0 = lane * 16; float o[16], z[16], g[16];
#pragma unroll
        for (int i = 0; i < 4; ++i) { const f32x4 v = *(const f32x4*)(obuf + (size_t)row * 1024 + c0 + i * 4); o[i * 4] = v[0]; o[i * 4 + 1] = v[1]; o[i * 4 + 2] = v[2]; o[i * 4 + 3] = v[3];
            const f32x4 gg = *(const f32x4*)(og + (c0 & 127) + i * 4); g[i * 4] = gg[0]; g[i * 4 + 1] = gg[1]; g[i * 4 + 2] = gg[2]; g[i * 4 + 3] = gg[3]; }
        unpack8(*(const u32x4*)(proj + (size_t)row * NPROJ + C_Z + c0), z); unpack8(*(const u32x4*)(proj + (size_t)row * NPROJ + C_Z + c0 + 8), z + 8);
        float ss = 0.f;
#pragma unroll
        for (int i = 0; i < 16; ++i) ss += o[i] * o[i];
        ss += __shfl_xor(ss, 1); ss += __shfl_xor(ss, 2); ss += __shfl_xor(ss, 4);
        const float rstd = rsqrtf(ss * (1.0f / 128.0f) + EPS);
#pragma unroll
        for (int i = 0; i < 16; ++i) o[i] = o[i] * rstd * g[i] * siluf_(z[i]);
        *(u32x4*)(acat + (size_t)row * DM + c0) = pack8(o); *(u32x4*)(acat + (size_t)row * DM + c0 + 8) = pack8(o + 8);
    }
}

#define XB_TMO      128
#define XB_XCNT(j)  (256  + 64 * (j))
#define XB_XSUB(j)  (1280 + 64 * (j))
#define XB_XGEN(j)  (2304 + 64 * (j))
#define XB_TOP      3328
#define XB_TOPGEN   3392
#define XCD_BAR_WORDS 3456
#define XB_SPIN_CAP (1u << 18)

__device__ __forceinline__ unsigned xb_ld(unsigned* p)              { return __hip_atomic_load(p, __ATOMIC_RELAXED, __HIP_MEMORY_SCOPE_AGENT); }
__device__ __forceinline__ unsigned xb_add(unsigned* p, unsigned v) { return __hip_atomic_fetch_add(p, v, __ATOMIC_RELAXED, __HIP_MEMORY_SCOPE_AGENT); }
__device__ __forceinline__ unsigned xb_xcc_id() { return (unsigned)__builtin_amdgcn_s_getreg((3 << 11) | 20) & 0xFu; }
#define XB_SPIN(cond, bar) do { unsigned _sp = 0; while (cond) { __builtin_amdgcn_s_sleep(1); \
    if ((++_sp & 255u) == 0u) { if (xb_ld(&(bar)[XB_TMO])) break; if (_sp > XB_SPIN_CAP) { atomicAdd(&(bar)[XB_TMO], 1u); break; } } } } while (0)

struct XcdBarrier {
    unsigned* bar; unsigned x;
    volatile LAS unsigned* st;
};

__device__ __forceinline__ XcdBarrier xcd_barrier_post(unsigned* bar, volatile LAS unsigned* st) {
    XcdBarrier b; b.bar = bar; b.x = xb_xcc_id(); b.st = st;
    if (threadIdx.x == 0) (void)xb_add(&bar[XB_XCNT(b.x)], 1u);
    return b;
}
__device__ __forceinline__ void xcd_barrier_complete(unsigned* bar, unsigned x, unsigned& nloc, unsigned& nx) {
    const unsigned G = gridDim.x * gridDim.y * gridDim.z;
    unsigned sum, cnt, mine, sp = 0u;
    for (;;) {
        sum = 0u; cnt = 0u; mine = 0u;
#pragma unroll
        for (unsigned j = 0; j < 16; ++j) { const unsigned c = xb_ld(&bar[XB_XCNT(j)]); sum += c; cnt += (c > 0u) ? 1u : 0u; mine = (j == x) ? c : mine; }
        if (sum == G) break;
        __builtin_amdgcn_s_sleep(1);
        if ((++sp & 255u) == 0u) { if (xb_ld(&bar[XB_TMO])) break; if (sp > XB_SPIN_CAP) { atomicAdd(&bar[XB_TMO], 1u); break; } }
    }
    nloc = mine > 0u ? mine : 1u; nx = cnt > 0u ? cnt : 1u;
}

__device__ __forceinline__ void xcd_barrier(const XcdBarrier& b) {
    asm volatile("s_waitcnt vmcnt(0)" ::: "memory");
    __syncthreads();
    if (threadIdx.x == 0) {
        unsigned* bar = b.bar;
        __builtin_amdgcn_s_waitcnt(0);
        unsigned nloc = b.st[0], nx = b.st[1];
        if (nloc == 0u) { xcd_barrier_complete(bar, b.x, nloc, nx); b.st[0] = nloc; b.st[1] = nx; }
        const unsigned old = xb_add(&bar[XB_XSUB(b.x)], 1u);
        const unsigned gen = old / nloc;
        if (old + 1u == (gen + 1u) * nloc) {
            __builtin_amdgcn_fence(__ATOMIC_RELEASE, "agent");
            asm volatile("s_waitcnt vmcnt(0)" ::: "memory");
            const unsigned og = xb_add(&bar[XB_TOP], 1u);
            const unsigned tg = og / nx;
            if (og + 1u == (tg + 1u) * nx) xb_add(&bar[XB_TOPGEN], 1u);
            else XB_SPIN(xb_ld(&bar[XB_TOPGEN]) == tg, bar);
            __builtin_amdgcn_fence(__ATOMIC_ACQUIRE, "agent");
            xb_add(&bar[XB_XGEN(b.x)], 1u);
            asm volatile("s_waitcnt vmcnt(0)" ::: "memory");
        } else {
            XB_SPIN(xb_ld(&bar[XB_XGEN(b.x)]) == gen, bar);
            __builtin_amdgcn_fence(__ATOMIC_ACQUIRE, "agent");
            asm volatile("s_waitcnt vmcnt(0)" ::: "memory");
        }
    }
    __syncthreads();
}

constexpr size_t WS_BAR = WS_END;
constexpr int LDS_ST_OFF = LDS_BYTES - 16;
struct KArgs { Params p; TJob jobs[11]; };
constexpr int N_PHASES = 15;
#ifndef PH_MASK
#define PH_MASK 0xFFFF
#endif
#ifndef DUP_MASK
#define DUP_MASK 0
#endif

__global__ void __launch_bounds__(512, 2) fwd_megakernel(KArgs ka) {
    extern __shared__ __attribute__((aligned(16))) unsigned char lds_raw[];
    LAS unsigned char* lds = (LAS unsigned char*)lds_raw;
    const Params& p = ka.p;
    const int bid = blockIdx.x, nblk = gridDim.x;
    unsigned char* ws = p.ws;
    const int lo = p.ph_lo, hi = p.ph_hi;
    if (threadIdx.x < 4) ((LAS unsigned*)(lds + LDS_ST_OFF))[threadIdx.x] = 0u;
    __syncthreads();
    if (hi > 1000) cg::this_grid().sync();
    XcdBarrier xbar = xcd_barrier_post((unsigned*)(ws + WS_BAR), (volatile LAS unsigned*)(lds + LDS_ST_OFF));
#define IN(k) ((PH_MASK & (1 << (k))) && lo <= (k) && (k) < hi)
#define SEAM(k) do { if (lo <= (k) && (k) + 1 < hi) xcd_barrier(xbar); } while (0)
    if (IN(0)) for (int rep = 0; rep <= ((DUP_MASK >> 0) & 1); ++rep) {
            bf16_t* aada = (bf16_t*)(ws + WS_AADA);
            for (int idx = bid * 512 + threadIdx.x; idx < 256 * 2048; idx += nblk * 512) { const int row = idx >> 11, col = idx & 2047;
                const float v = row < 4 ? siluf_(p.in[2][row * 2048 + col]) : (row < NB ? siluf_(p.in[3][(row - 4) * 2048 + col]) : 0.f); aada[idx] = f2bf(v); }
            transpose_jobs(ka.jobs, 1, bid, nblk, lds);
        }
    SEAM(0);
    if (IN(1)) for (int rep = 0; rep <= ((DUP_MASK >> 1) & 1); ++rep) {
            if (bid < 48) { pg8::Gemm g{(const bf16_t*)(ws + WS_AADA), (const bf16_t*)(ws + WS_PROJ), 2048, 2048, 2048, 0}; pg8::OneUnitOrder S{48, bid, 32}; pg8::EpiAda E{(float*)(ws + WS_MOD), p.in[8]}; pg8::gemm_phase(lds, g, S, E); }
            else { transpose_jobs(ka.jobs + 1, 1, bid - 48, nblk - 48, lds); transpose_jobs(ka.jobs + 4, 7, bid - 48, nblk - 48, lds); }
        }
    SEAM(1);
    if (IN(2)) for (int rep = 0; rep <= ((DUP_MASK >> 2) & 1); ++rep) norm_phase<0>(p, bid, nblk);
    SEAM(2);
    if (IN(3)) for (int rep = 0; rep <= ((DUP_MASK >> 3) & 1); ++rep) { pg8::Gemm g{(const bf16_t*)(ws + WS_U), (const bf16_t*)(ws + WS_WIN), 2048, 2048, 2048, 0}; pg8::StaticOrder S; S.init(TT, NPROJ, 2048, nblk, bid); pg8::EpiBf16 E{(bf16_t*)(ws + WS_PROJ), NPROJ, 0, nullptr}; pg8::gemm_phase(lds, g, S, E); }
    SEAM(3);
    if (IN(4)) for (int rep = 0; rep <= ((DUP_MASK >> 4) & 1); ++rep) mixer_prep_phase(p, bid, nblk);
    SEAM(4);
    if (IN(5)) for (int rep = 0; rep <= ((DUP_MASK >> 5) & 1); ++rep) chunk_prep_phase(p, bid, nblk, lds);
    SEAM(5);
    if (IN(6)) for (int rep = 0; rep <= ((DUP_MASK >> 6) & 1); ++rep) scan_phase(p, bid, nblk, lds);
    SEAM(6);
    if (IN(7)) for (int rep = 0; rep <= ((DUP_MASK >> 7) & 1); ++rep) { onorm_phase(p, bid, nblk);
            pg8::Gemm g{(const bf16_t*)(ws + WS_YP), (const bf16_t*)(ws + WS_PW), 1024, 256, 256, 512}; pg8::StaticOrder S; S.init(TT, 1024, 256, nblk, bid); pg8::EpiBf16 E{(bf16_t*)(ws + WS_U), DM, 1024, p.in[16]}; pg8::gemm_phase(lds, g, S, E); }
    SEAM(7);
    if (IN(8)) for (int rep = 0; rep <= ((DUP_MASK >> 8) & 1); ++rep) { pg8::Gemm g{(const bf16_t*)(ws + WS_U), (const bf16_t*)(ws + WS_WAB), 2048, 2048, 1024, 0}; pg8::StaticOrder S; S.init(TT, 2048, 1024, nblk, bid); pg8::EpiG1 E{p.out + O_Y, (const bf16_t*)(ws + WS_PROJ)}; pg8::gemm_phase(lds, g, S, E);
            if (rep == 0) { if (nblk <= 16) transpose_jobs(ka.jobs + 2, 1, bid, nblk, lds); else if (bid >= 16) transpose_jobs(ka.jobs + 2, 1, bid - 16, nblk - 16, lds); } }
    SEAM(8);
    if (IN(9)) for (int rep = 0; rep <= ((DUP_MASK >> 9) & 1); ++rep) { pg8::Gemm g{(const bf16_t*)(ws + WS_U) + 1024, (const bf16_t*)(ws + WS_WAB) + 1024, 2048, 2048, 1024, 0}; pg8::StaticOrder S; S.init(TT, 2048, 1024, nblk, bid); pg8::EpiG2 E{(bf16_t*)(ws + WS_QN), p.out + O_Y, (const bf16_t*)(ws + WS_PROJ)}; pg8::gemm_phase(lds, g, S, E);
            if (rep == 0) { if (nblk <= 16) transpose_jobs(ka.jobs + 3, 1, bid, nblk, lds); else if (bid >= 16) transpose_jobs(ka.jobs + 3, 1, bid - 16, nblk - 16, lds); } }
    SEAM(9);
    if (IN(10)) for (int rep = 0; rep <= ((DUP_MASK >> 10) & 1); ++rep) { pg8::Gemm g{(const bf16_t*)(ws + WS_QN), (const bf16_t*)(ws + WS_WO), 2048, 2048, 2048, 0}; pg8::SplitOrder S{nblk, bid, 32, 4, 8}; pg8::EpiRes E{p.out + O_Y, p.in[0], p.in[1], (const float*)(ws + WS_MOD) + 4096, (float*)(ws + WS_PB10)}; pg8::gemm_phase(lds, g, S, E); }
    SEAM(10);
    if (IN(11)) for (int rep = 0; rep <= ((DUP_MASK >> 11) & 1); ++rep) norm_phase<1>(p, bid, nblk);
    SEAM(11);
    if (IN(12)) for (int rep = 0; rep <= ((DUP_MASK >> 12) & 1); ++rep) { pg8::Gemm g{(const bf16_t*)(ws + WS_U), (const bf16_t*)(ws + WS_WGU), 2048, 2048, 2048, 0}; pg8::StaticOrder S; S.init(TT, 11264, 2048, nblk, bid); pg8::EpiGU E{(bf16_t*)(ws + WS_PROJ)}; pg8::gemm_phase(lds, g, S, E); }
    SEAM(12);
    if (IN(13)) for (int rep = 0; rep <= ((DUP_MASK >> 13) & 1); ++rep) { pg8::Gemm g{(const bf16_t*)(ws + WS_PROJ), (const bf16_t*)(ws + WS_WD), DFF, DFF, DFF, 0}; pg8::SplitOrder S{nblk, bid, 88, 8, 11}; pg8::EpiRes E{p.out + O_Y, p.out + O_Y, p.out + O_Y + (size_t)TP * DM, (const float*)(ws + WS_MOD) + 10240, (float*)(ws + WS_PB13)}; pg8::gemm_phase(lds, g, S, E); }
    SEAM(13);
    if (IN(14)) for (int rep = 0; rep <= ((DUP_MASK >> 14) & 1); ++rep) norm_phase<2>(p, bid, nblk);
    SEAM(14);
}

extern "C" void kernel_launch(void* const* d_in, const int* in_sizes, int n_in, void* d_out, int out_size, void* d_ws, size_t ws_size, hipStream_t stream) {
    static int grid = 0;
    if (grid == 0) {
        if (n_in != 24 || ws_size < WS_BAR + XCD_BAR_WORDS * 4) { fprintf(stderr, "kernel_launch: unexpected n_in %d / ws_size %zu (need %zu)\n", n_in, ws_size, (size_t)WS_END); grid = -1; return; }
        int dev = 0, cus = 0, per_cu = 0;
        hipGetDevice(&dev); hipDeviceGetAttribute(&cus, hipDeviceAttributeMultiprocessorCount, dev);
        if (hipFuncSetAttribute((const void*)fwd_megakernel, hipFuncAttributeMaxDynamicSharedMemorySize, LDS_BYTES) != hipSuccess) { fprintf(stderr, "kernel_launch: hipFuncSetAttribute failed\n"); grid = -1; return; }
        if (hipOccupancyMaxActiveBlocksPerMultiprocessor(&per_cu, (const void*)fwd_megakernel, 512, LDS_BYTES) != hipSuccess || per_cu < 1) { fprintf(stderr, "kernel_launch: occupancy query says %d\n", per_cu); per_cu = 1; }
        (void)hipGetLastError();
        grid = cus > 0 ? cus : 256;
        if (grid < 64) grid = 64;
    }
    if (grid < 0) return;
    if (hipMemsetAsync((unsigned char*)d_ws + WS_BAR, 0, XCD_BAR_WORDS * 4, stream) != hipSuccess) { fprintf(stderr, "kernel_launch: memset failed\n"); return; }
    KArgs ka; memset(&ka, 0, sizeof(ka));
    for (int i = 0; i < 24; ++i) ka.p.in[i] = (const float*)d_in[i];
    ka.p.out = (float*)d_out; ka.p.ws = (unsigned char*)d_ws;
    unsigned char* ws = (unsigned char*)d_ws;
    auto setjob = [&](int i, const void* src, void* dst, int ld_src, int K, int Nout, int ld_dst, int map) { TJob& j = ka.jobs[i]; j.src = (const float*)src; j.dst = (bf16_t*)dst; j.ld_src = ld_src; j.K = K; j.Nout = Nout; j.ld_dst = ld_dst; j.map = map; j.pad = 0; };
    setjob(0, d_in[7], ws + WS_PROJ, MODW, 2048, MODW, 2048, 0);
    setjob(1, d_in[10], ws + WS_WIN, 9232, 2048, NPROJ, 2048, 1);
    setjob(2, d_in[21], ws + WS_WGU, 2 * DFF, 2048, 2 * DFF, 2048, 2);
    setjob(3, d_in[22], ws + WS_WD, 2048, DFF, 2048, DFF, 0);
    setjob(4, d_in[19], ws + WS_WO, 2048, 2048, 2048, 2048, 0);
    setjob(5, d_in[17], ws + WS_WAB, 2048, 1024, 2048, 2048, 0);
    setjob(6, d_in[18], ws + WS_WAB + 1024 * 2, 2048, 1024, 2048, 2048, 0);
    for (int g = 0; g < 4; ++g) setjob(7 + g, (const float*)d_in[15] + g * 65536, ws + WS_PW + (size_t)g * 65536 * 2, 256, 256, 256, 256, 0);
#if MK_PER_PHASE
    for (int ph = 0; ph < N_PHASES; ++ph) { ka.p.ph_lo = ph; ka.p.ph_hi = ph + 1; hipLaunchKernelGGL(fwd_megakernel, dim3(grid), dim3(512), LDS_BYTES, stream, ka); }
#else
    ka.p.ph_lo = 0; ka.p.ph_hi = N_PHASES;
    void* args[] = {&ka};
    hipError_t e = hipLaunchCooperativeKernel((const void*)fwd_megakernel, dim3(grid), dim3(512), args, LDS_BYTES, stream);
    if (e != hipSuccess) fprintf(stderr, "cooperative launch failed: %s (grid %d)\n", hipGetErrorString(e), grid);
#endif
}
```

```cpp
#include <hip/hip_runtime.h>
#include <hip/hip_cooperative_groups.h>
#include <cstdio>
#include <cstring>
namespace cg = cooperative_groups;

#ifndef MK_PER_PHASE
#define MK_PER_PHASE 0
#endif

#define LAS __attribute__((address_space(3)))
typedef unsigned short bf16_t;
typedef short bf16x8 __attribute__((ext_vector_type(8)));
typedef float f32x4 __attribute__((ext_vector_type(4)));
typedef float f32x2 __attribute__((ext_vector_type(2)));
typedef unsigned u32x4 __attribute__((ext_vector_type(4)));
typedef unsigned u32x2 __attribute__((ext_vector_type(2)));

constexpr int DM = 2048, TP = 8192, TS = 512, TT = 8704, NB = 132;
constexpr int NPROJ = 9472;
constexpr int DFF = 5632;
constexpr int MODW = 12288;
constexpr float EPS = 1e-6f;
constexpr int C_Q = 0, C_K = 1024, C_V = 2048, C_Z = 3072, C_XP = 4096, C_GA = 5120, C_GB = 7168, C_AB = 9216;
constexpr size_t O_Y = 0, O_DP = 17825792, O_CP = 18350080, O_PP = 18386944, O_DS = 18448384, O_CS = 35225600, O_PS = 36405248;
constexpr size_t OS_O = 0, OS_UB = 8912896;
constexpr size_t WS_WIN = 0;
constexpr size_t WS_WGU = WS_WIN + (size_t)NPROJ * 2048 * 2;
constexpr size_t WS_WD = WS_WGU + (size_t)11264 * 2048 * 2;
constexpr size_t WS_WO = WS_WD + (size_t)2048 * 5632 * 2;
constexpr size_t WS_WAB = WS_WO + (size_t)2048 * 2048 * 2;
constexpr size_t WS_PW = WS_WAB + (size_t)2048 * 2048 * 2;
constexpr size_t WS_AADA = WS_PW + (size_t)1024 * 256 * 2;
constexpr size_t WS_MOD = WS_AADA + (size_t)256 * 2048 * 2;
constexpr size_t WS_G = WS_MOD + (size_t)NB * MODW * 4;
constexpr size_t WS_BETA = WS_G + (size_t)TT * 8 * 4;
constexpr size_t WS_CD = WS_BETA + (size_t)TT * 8 * 4;
constexpr size_t WS_U = WS_CD + 4096;
constexpr size_t WS_QN = WS_U + (size_t)TT * 2048 * 2;
constexpr size_t WS_KN = WS_QN + (size_t)TT * 1024 * 2;
constexpr size_t WS_VV = WS_KN + (size_t)TT * 1024 * 2;
constexpr size_t WS_YP = WS_VV + (size_t)TT * 1024 * 2;
constexpr size_t WS_WDC = WS_YP + (size_t)TT * 1024 * 2;
constexpr size_t WS_QD = WS_WDC + (size_t)1024 * 64 * 128 * 2;
constexpr size_t WS_KT = WS_QD + (size_t)1024 * 64 * 128 * 2;
constexpr size_t WS_QK = WS_KT + (size_t)1024 * 64 * 128 * 2;
constexpr size_t WS_PROJ = WS_QK + (size_t)1024 * 64 * 64 * 2;
constexpr size_t WS_END = WS_PROJ + (size_t)TT * NPROJ * 2;
constexpr size_t WS_PB10 = WS_PROJ;
constexpr size_t WS_PB13 = WS_PROJ + (size_t)TT * DFF * 2;
static_assert(WS_PB13 + (size_t)11 * TS * DM * 4 <= WS_END && (WS_PB13 % 256) == 0, "partials");
static_assert(WS_END + 16384 <= 501510720ull, "workspace too large");
static_assert((WS_PROJ % 256) == 0 && (WS_QK % 256) == 0 && (WS_U % 256) == 0, "align");

constexpr int LDS_BYTES = 147456;

struct Params {
    const float* in[24];
    float* out;
    unsigned char* ws;
    int ph_lo, ph_hi;
};

__device__ __forceinline__ float bf2f(unsigned short x) { return __uint_as_float(((unsigned)x) << 16); }
__device__ __forceinline__ unsigned short f2bf(float f) { unsigned u = __float_as_uint(f); u += 0x7FFFu + ((u >> 16) & 1u); return (unsigned short)(u >> 16); }
__device__ __forceinline__ unsigned pk2(float lo, float hi) { return (unsigned)f2bf(lo) | ((unsigned)f2bf(hi) << 16); }
__device__ __forceinline__ void unpack8(const u32x4 w, float* f) {
    f[0] = __uint_as_float(w.x << 16); f[1] = __uint_as_float(w.x & 0xffff0000u);
    f[2] = __uint_as_float(w.y << 16); f[3] = __uint_as_float(w.y & 0xffff0000u);
    f[4] = __uint_as_float(w.z << 16); f[5] = __uint_as_float(w.z & 0xffff0000u);
    f[6] = __uint_as_float(w.w << 16); f[7] = __uint_as_float(w.w & 0xffff0000u);
}
__device__ __forceinline__ u32x4 pack8(const float* f) { u32x4 w; w.x = pk2(f[0], f[1]); w.y = pk2(f[2], f[3]); w.z = pk2(f[4], f[5]); w.w = pk2(f[6], f[7]); return w; }
__device__ __forceinline__ float sigmoidf_(float x) { return 1.0f / (1.0f + __expf(-x)); }
__device__ __forceinline__ float siluf_(float x) { return x / (1.0f + __expf(-x)); }
__device__ __forceinline__ int bidx_of_row(int row) { return row < TP ? (row >> 11) : 4 + ((row - TP) >> 2); }

namespace pg8 {
constexpr int BM = 256, BK = 64, HALF = 128, HTB = HALF * BK * 2, STAGE_BYTES = 8 * HTB, NXCD = 8, WGM = 8;
__host__ __device__ __forceinline__ int lds_byte(int r, int c) { const int st = (r >> 4) * 2 + (c >> 5), rr = r & 15, cc = c & 31, ob = rr * 64 + cc * 2; return st * 1024 + (ob ^ (((ob >> 9) & 1) << 5)); }
__host__ __device__ __forceinline__ void stage_rc(int b, int& R, int& C) { const int st = b / 1024, sb = b % 1024, swz = sb ^ (((sb >> 9) & 1) << 5); R = (st >> 1) * 16 + swz / 64; C = (st & 1) * 32 + (swz % 64) / 2; }
__host__ __device__ __forceinline__ int perm32(int rho) { const int n = rho >> 4, i = rho & 15; return 8 * (i >> 2) + 4 * n + (i & 3); }

struct Unit { int pm, pn, kt0, nkt, piece; };
struct Gemm { const bf16_t* A; const bf16_t* Bt; int lda, ldb, K; size_t a_pn_off; };

__device__ __forceinline__ void tile_of(int wgid, int nM, int nN, Unit& u) {
    const int nwg = nM * nN;
    { const int q = nwg / NXCD, r = nwg % NXCD, xcd = wgid % NXCD, off = wgid / NXCD; wgid = (xcd < r ? xcd * (q + 1) : r * (q + 1) + (xcd - r) * q) + off; }
    const int nig = WGM * nN, gid = wgid / nig, fm = gid * WGM, gsz = (nM - fm) < WGM ? (nM - fm) : WGM;
    u.pm = fm + ((wgid % nig) % gsz); u.pn = (wgid % nig) / gsz;
}
struct StaticOrder {
    int nM, nN, nwg, G, c, ntk;
    __device__ __forceinline__ void init(int M, int N, int K, int G_, int c_) { nM = M / BM; nN = N / BM; nwg = nM * nN; G = G_; c = c_; ntk = K / BK; }
    __device__ __forceinline__ bool next(int i, Unit& u) const {
        const long L = (long)i * G + c; if (L >= nwg) return false;
        tile_of((int)L, nM, nN, u); u.kt0 = 0; u.nkt = ntk; u.piece = -1; return true;
    }
};
struct OneUnitOrder {
    int n, c, ntk;
    __device__ __forceinline__ bool next(int i, Unit& u) const { if (i != 0 || c >= n) return false; u.pm = 0; u.pn = c; u.kt0 = 0; u.nkt = ntk; u.piece = -1; return true; }
};
struct SplitOrder {
    int G, c, ntk, pk, npc;
    __device__ __forceinline__ bool next(int i, Unit& u) const {
        const int L = i * G + c;
        const bool full = L < 256;
        int fpm, fpn;
        { int wgid = full ? L : 0; const int xcd = wgid % NXCD, off = wgid / NXCD; wgid = xcd * 32 + off;
          const int nig = WGM * 8, gid = wgid / nig, fm = gid * WGM; fpm = fm + ((wgid % nig) % WGM); fpn = (wgid % nig) / WGM; }
        const int pidx = full ? 0 : L - 256, tile = pidx / npc, pc = pidx - tile * npc;
        u.pm = full ? fpm : 32 + (tile >> 3); u.pn = full ? fpn : (tile & 7); u.kt0 = full ? 0 : pc * pk; u.nkt = full ? ntk : pk; u.piece = full ? -1 : pc;
        return full || pidx < 16 * npc;
    }
};

template <class Epi, class Sched>
__device__ __forceinline__ void gemm_phase(LAS unsigned char* lds, const Gemm g, const Sched& S, const Epi& E) {
    const int tid = threadIdx.x, wid = __builtin_amdgcn_readfirstlane(tid >> 6), lane = tid & 63, wr = wid >> 2, wc = wid & 3, fr = lane & 15, fq = lane >> 4;
    unsigned voffA[2], voffB[2];
#pragma unroll
    for (int i = 0; i < 2; ++i) { int R, C; stage_rc(tid * 16 + i * 8192, R, C); const int Rb = Epi::PERM ? ((R & ~31) + perm32(R & 31)) : R;
        voffA[i] = (unsigned)(R * g.lda + C) * 2u; voffB[i] = (unsigned)(Rb * g.ldb + C) * 2u; }
    const size_t kstep = (size_t)(BK * 2);
    const size_t hstepA = (size_t)HALF * g.lda * 2, hstepB = (size_t)HALF * g.ldb * 2;
    const size_t tstepA = 2 * hstepA, tstepB = 2 * hstepB;
    const unsigned ldsw = (unsigned)wid * 1024u;
    const int aoff = lds_byte(wr * 64 + fr, fq * 8), boff = lds_byte(wc * 32 + fr, fq * 8);
#define PG8_SA(b, h) (((b) * 2 + (h)) * HTB)
#define PG8_SB(b, h) ((4 + (b) * 2 + (h)) * HTB)
#define PG8_STAGE(bufoff, gbase, voff) do { _Pragma("unroll") for (int _i = 0; _i < 2; ++_i) \
        __builtin_amdgcn_global_load_lds((const unsigned*)((const char*)(gbase) + (voff)[_i]), (LAS unsigned*)(lds + (bufoff) + ldsw + _i * 8192), 16, 0, 0); } while (0)
#define PG8_LDA(dst, b, h) do { _Pragma("unroll") for (int m = 0; m < 4; ++m) _Pragma("unroll") for (int k = 0; k < 2; ++k) dst[m][k] = *(const LAS bf16x8*)(lds + PG8_SA(b, h) + aoff + m * 2048 + k * 1024); } while (0)
#define PG8_LDB(dst, b, h) do { _Pragma("unroll") for (int n = 0; n < 2; ++n) _Pragma("unroll") for (int k = 0; k < 2; ++k) dst[n][k] = *(const LAS bf16x8*)(lds + PG8_SB(b, h) + boff + n * 2048 + k * 1024); } while (0)
#define PG8_MMA(ai, bj, At, Bt) do { __builtin_amdgcn_s_setprio(1); _Pragma("unroll") for (int m = 0; m < 4; ++m) _Pragma("unroll") for (int n = 0; n < 2; ++n) _Pragma("unroll") for (int k = 0; k < 2; ++k) \
        acc[ai][bj][m][n] = __builtin_amdgcn_mfma_f32_16x16x32_bf16(Bt[n][k], At[m][k], acc[ai][bj][m][n], 0, 0, 0); __builtin_amdgcn_s_setprio(0); } while (0)
#define PG8_WAIT_V(n) asm volatile("s_waitcnt vmcnt(" #n ")" ::: "memory")
#define PG8_WAIT_L(n) asm volatile("s_waitcnt lgkmcnt(" #n ")" ::: "memory")
#define PG8_BAR __builtin_amdgcn_s_barrier()
#define PG8_SCHED __builtin_amdgcn_sched_barrier(0)
    Unit cur, nxt; int ui = 0;
    if (!S.next(0, cur)) return;
    f32x4 acc[2][2][4][2];
#pragma unroll
    for (int a = 0; a < 2; ++a)
#pragma unroll
        for (int b = 0; b < 2; ++b)
#pragma unroll
            for (int m = 0; m < 4; ++m)
#pragma unroll
                for (int n = 0; n < 2; ++n) acc[a][b][m][n] = (f32x4){0.f, 0.f, 0.f, 0.f};
    bf16x8 At[4][2], B0[2][2], B1[2][2];
    const char* cA = (const char*)g.A + (size_t)cur.pm * tstepA + (size_t)cur.pn * g.a_pn_off + (size_t)cur.kt0 * kstep; const char* cB = (const char*)g.Bt + (size_t)cur.pn * tstepB + (size_t)cur.kt0 * kstep;
    PG8_STAGE(PG8_SB(0, 0), cB, voffB); PG8_STAGE(PG8_SA(0, 0), cA, voffA); PG8_STAGE(PG8_SB(0, 1), cB + hstepB, voffB); PG8_STAGE(PG8_SA(0, 1), cA + hstepA, voffA);
    if (wr == 1) PG8_BAR;
    PG8_WAIT_V(4); PG8_BAR;
    PG8_STAGE(PG8_SB(1, 0), cB + kstep, voffB); PG8_STAGE(PG8_SA(1, 0), cA + kstep, voffA); PG8_STAGE(PG8_SB(1, 1), cB + hstepB + kstep, voffB);
    PG8_WAIT_V(6); PG8_BAR;
    for (;;) {
        const bool has_next = S.next(ui + 1, nxt);
        const char* nA = has_next ? (const char*)g.A + (size_t)nxt.pm * tstepA + (size_t)nxt.pn * g.a_pn_off + (size_t)nxt.kt0 * kstep : cA; const char* nB = has_next ? (const char*)g.Bt + (size_t)nxt.pn * tstepB + (size_t)nxt.kt0 * kstep : cB;
        const int nt = cur.nkt;
#pragma unroll 1
        for (int t = 0; t < nt; t += 2) {
            const bool last = (t == nt - 2);
            const char* a1 = cA + (size_t)(t + 1) * kstep;
            const char* a2 = last ? nA : cA + (size_t)(t + 2) * kstep; const char* b2 = last ? nB : cB + (size_t)(t + 2) * kstep;
            const char* a3 = a2 + kstep; const char* b3 = b2 + kstep;
            PG8_LDB(B0, 0, 0); PG8_SCHED; PG8_LDA(At, 0, 0); PG8_STAGE(PG8_SA(1, 1), a1 + hstepA, voffA);
            PG8_WAIT_L(8); PG8_BAR; PG8_WAIT_L(0); PG8_MMA(0, 0, At, B0); PG8_BAR; PG8_SCHED;
            PG8_LDB(B1, 0, 1); PG8_STAGE(PG8_SB(0, 0), b2, voffB);
            PG8_BAR; PG8_WAIT_L(0); PG8_MMA(0, 1, At, B1); PG8_BAR;
            PG8_LDA(At, 0, 1); PG8_STAGE(PG8_SA(0, 0), a2, voffA);
            PG8_BAR; PG8_WAIT_L(0); PG8_MMA(1, 0, At, B0); PG8_BAR; PG8_SCHED;
            PG8_STAGE(PG8_SB(0, 1), b2 + hstepB, voffB);
            PG8_WAIT_V(6); PG8_BAR; PG8_MMA(1, 1, At, B1); PG8_BAR;
            PG8_LDB(B0, 1, 0); PG8_SCHED; PG8_LDA(At, 1, 0); PG8_STAGE(PG8_SA(0, 1), a2 + hstepA, voffA);
            PG8_WAIT_L(8); PG8_BAR; PG8_WAIT_L(0); PG8_MMA(0, 0, At, B0); PG8_BAR; PG8_SCHED;
            PG8_LDB(B1, 1, 1); PG8_STAGE(PG8_SB(1, 0), b3, voffB);
            PG8_BAR; PG8_WAIT_L(0); PG8_MMA(0, 1, At, B1); PG8_BAR;
            PG8_LDA(At, 1, 1); PG8_STAGE(PG8_SA(1, 0), a3, voffA);
            PG8_BAR; PG8_WAIT_L(0); PG8_MMA(1, 0, At, B0); PG8_BAR; PG8_SCHED;
            PG8_STAGE(PG8_SB(1, 1), b3 + hstepB, voffB);
            PG8_WAIT_V(6); PG8_BAR; PG8_MMA(1, 1, At, B1); PG8_BAR;
        }
        E(acc, cur, wr, wc, fr, fq);
        if (!has_next) break;
#pragma unroll
        for (int a = 0; a < 2; ++a)
#pragma unroll
            for (int b = 0; b < 2; ++b)
#pragma unroll
                for (int m = 0; m < 4; ++m)
#pragma unroll
                    for (int n = 0; n < 2; ++n) acc[a][b][m][n] = (f32x4){0.f, 0.f, 0.f, 0.f};
        cur = nxt; cA = nA; cB = nB; ++ui;
    }
    PG8_WAIT_V(0);
    if (wr == 0) PG8_BAR;
    PG8_BAR;
#undef PG8_SA
#undef PG8_SB
#undef PG8_STAGE
#undef PG8_LDA
#undef PG8_LDB
#undef PG8_MMA
#undef PG8_WAIT_V
#undef PG8_WAIT_L
#undef PG8_BAR
#undef PG8_SCHED
}

typedef f32x4 Acc[2][2][4][2];

struct EpiAda {
    static constexpr bool PERM = false, MID = false;
    float* C; const float* bias;
    __device__ __forceinline__ void operator()(const Acc& acc, const Unit& u, int wr, int wc, int fr, int fq) const {
        const int row0 = wr * 64 + fr, col0 = u.pn * BM + wc * 32 + 4 * fq;
#pragma unroll
        for (int ai = 0; ai < 2; ++ai)
#pragma unroll
            for (int m = 0; m < 4; ++m) { const int row = row0 + ai * HALF + m * 16; if (row < NB) {
#pragma unroll
                for (int bj = 0; bj < 2; ++bj)
#pragma unroll
                    for (int n = 0; n < 2; ++n) { const int c = col0 + bj * HALF + n * 16; *(f32x4*)(C + (size_t)row * MODW + c) = acc[ai][bj][m][n] + *(const f32x4*)(bias + c); } } }
    }
};
struct EpiBf16 {
    static constexpr bool PERM = true, MID = false;
    bf16_t* O; int ldc; int col_off; const float* scale;
    __device__ __forceinline__ void operator()(const Acc& acc, const Unit& u, int wr, int wc, int fr, int fq) const {
        const int row0 = u.pm * BM + wr * 64 + fr, col0 = u.pn * BM + wc * 32 + 8 * fq;
#pragma unroll
        for (int ai = 0; ai < 2; ++ai)
#pragma unroll
            for (int m = 0; m < 4; ++m) { bf16_t* rowp = O + (size_t)(row0 + ai * HALF + m * 16) * ldc + col_off + col0;
#pragma unroll
                for (int bj = 0; bj < 2; ++bj) { f32x4 v0 = acc[ai][bj][m][0], v1 = acc[ai][bj][m][1];
                    if (scale) { v0 *= *(const f32x4*)(scale + col0 + bj * HALF); v1 *= *(const f32x4*)(scale + col0 + bj * HALF + 4); }
                    u32x4 w; w.x = pk2(v0[0], v0[1]); w.y = pk2(v0[2], v0[3]); w.z = pk2(v1[0], v1[1]); w.w = pk2(v1[2], v1[3]);
                    *(u32x4*)(rowp + bj * HALF) = w; }
                if (scale) asm volatile("" ::: "memory"); }
    }
};
struct EpiG1 {
    static constexpr bool PERM = true, MID = false;
    float* T1; const bf16_t* proj;
    __device__ __forceinline__ void operator()(const Acc& acc, const Unit& u, int wr, int wc, int fr, int fq) const {
        const int row0 = u.pm * BM + wr * 64 + fr, col0 = u.pn * BM + wc * 32 + 8 * fq;
#pragma unroll
        for (int ai = 0; ai < 2; ++ai)
#pragma unroll
            for (int m = 0; m < 4; ++m) { const size_t row = (size_t)(row0 + ai * HALF + m * 16); const bf16_t* pr = proj + row * NPROJ + col0;
#pragma unroll
                for (int bj = 0; bj < 2; ++bj) { float ga[8]; unpack8(*(const u32x4*)(pr + C_GA + bj * HALF), ga); f32x4 v0, v1;
#pragma unroll
                    for (int j = 0; j < 4; ++j) { v0[j] = acc[ai][bj][m][0][j] * __builtin_amdgcn_rcpf(1.0f + __expf(-ga[j])); v1[j] = acc[ai][bj][m][1][j] * __builtin_amdgcn_rcpf(1.0f + __expf(-ga[4 + j])); }
                    float* o = T1 + row * DM + col0 + bj * HALF; *(f32x4*)o = v0; *(f32x4*)(o + 4) = v1; }
                }
    }
};
struct EpiG2 {
    static constexpr bool PERM = true, MID = false;
    bf16_t* O; const float* T1; const bf16_t* proj;
    __device__ __forceinline__ void operator()(const Acc& acc, const Unit& u, int wr, int wc, int fr, int fq) const {
        const int row0 = u.pm * BM + wr * 64 + fr, col0 = u.pn * BM + wc * 32 + 8 * fq;
#pragma unroll
        for (int ai = 0; ai < 2; ++ai)
#pragma unroll
            for (int m = 0; m < 4; ++m) { const size_t row = (size_t)(row0 + ai * HALF + m * 16); const bf16_t* pr = proj + row * NPROJ + col0;
#pragma unroll
                for (int bj = 0; bj < 2; ++bj) { float gb[8], v[8]; unpack8(*(const u32x4*)(pr + C_GB + bj * HALF), gb);
                    const float* t = T1 + row * DM + col0 + bj * HALF; const f32x4 t0 = *(const f32x4*)t, t1 = *(const f32x4*)(t + 4);
#pragma unroll
                    for (int j = 0; j < 4; ++j) { v[j] = t0[j] + acc[ai][bj][m][0][j] * __builtin_amdgcn_rcpf(1.0f + __expf(-gb[j])); v[4 + j] = t1[j] + acc[ai][bj][m][1][j] * __builtin_amdgcn_rcpf(1.0f + __expf(-gb[4 + j])); }
                    *(u32x4*)(O + row * DM + col0 + bj * HALF) = pack8(v); }
                if (m & 1) asm volatile("" ::: "memory"); }
    }
};
struct EpiRes {
    static constexpr bool PERM = false, MID = false;
    float* X1; const float* x0p; const float* x0s; const float* gate; float* PB;
    __device__ __forceinline__ void operator()(const Acc& acc, const Unit& u, int wr, int wc, int fr, int fq) const {
        const int row0 = u.pm * BM + wr * 64 + fr, col0 = u.pn * BM + wc * 32 + 4 * fq;
        if (u.piece >= 0) {
            float* pb = PB + (size_t)u.piece * TS * DM;
#pragma unroll
            for (int ai = 0; ai < 2; ++ai)
#pragma unroll
                for (int m = 0; m < 4; ++m) { float* orow = pb + (size_t)(row0 + ai * HALF + m * 16 - TP) * DM;
#pragma unroll
                    for (int bj = 0; bj < 2; ++bj)
#pragma unroll
                        for (int n = 0; n < 2; ++n) *(f32x4*)(orow + col0 + bj * HALF + n * 16) = acc[ai][bj][m][n]; }
            return;
        }
#pragma unroll
        for (int ai = 0; ai < 2; ++ai)
#pragma unroll
            for (int m = 0; m < 4; ++m) { const int row = row0 + ai * HALF + m * 16; const int b = bidx_of_row(row);
                const float* xr = (row < TP) ? x0p + (size_t)row * DM : x0s + (size_t)(row - TP) * DM; const float* gr = gate + (size_t)b * MODW; float* orow = X1 + (size_t)row * DM;
#pragma unroll
                for (int bj = 0; bj < 2; ++bj)
#pragma unroll
                    for (int n = 0; n < 2; ++n) { const int c = col0 + bj * HALF + n * 16; const f32x4 xv = *(const f32x4*)(xr + c), gv = *(const f32x4*)(gr + c);
                        *(f32x4*)(orow + c) = xv + gv * acc[ai][bj][m][n]; } }
    }
};
struct EpiGU {
    static constexpr bool PERM = true, MID = false;
    bf16_t* O;
    __device__ __forceinline__ void operator()(const Acc& acc, const Unit& u, int wr, int wc, int fr, int fq) const {
        const int row0 = u.pm * BM + wr * 64 + fr, col0 = u.pn * HALF + wc * 32 + 8 * fq;
#pragma unroll
        for (int ai = 0; ai < 2; ++ai)
#pragma unroll
            for (int m = 0; m < 4; ++m) { float v[8];
#pragma unroll
                for (int n = 0; n < 2; ++n)
#pragma unroll
                    for (int j = 0; j < 4; ++j) { const float gt = acc[ai][0][m][n][j]; v[4 * n + j] = gt * __builtin_amdgcn_rcpf(1.0f + __expf(-gt)) * acc[ai][1][m][n][j]; }
                *(u32x4*)(O + (size_t)(row0 + ai * HALF + m * 16) * DFF + col0) = pack8(v); }
    }
};
}

struct TJob { const float* src; bf16_t* dst; int ld_src, K, Nout, ld_dst, map, pad; };
__device__ __forceinline__ int map_col(int map, int n) {
    if (map == 1) { if (n < 4096) return n; if (n < 5120) return 4112 + (n - 4096); if (n < 9216) return 5136 + (n - 5120); if (n < 9232) return 4096 + (n - 9216); return -1; }
    if (map == 2) { const int pn = n >> 8, w = n & 255; return w < 128 ? 128 * pn + w : DFF + 128 * pn + (w - 128); }
    return n;
}
__device__ __forceinline__ void tjob_load(const TJob& j, int tile, f32x4 (&v)[4]) {
    const int tid = threadIdx.x, nkt = j.K >> 7, tn = tile / nkt, tk = tile - tn * nkt;
    const int n = tn * 64 + (tid & 15) * 4, kr = tid >> 4, col = map_col(j.map, n);
#pragma unroll
    for (int i = 0; i < 4; ++i) v[i] = col >= 0 ? __builtin_nontemporal_load((const f32x4*)(j.src + (size_t)(tk * 128 + kr + 32 * i) * j.ld_src + col)) : (f32x4){0.f, 0.f, 0.f, 0.f};
}
__device__ __forceinline__ void tjob_store(const TJob& j, int tile, const f32x4 (&v)[4], LAS float* s) {
    const int tid = threadIdx.x, nkt = j.K >> 7, tn = tile / nkt, tk = tile - tn * nkt;
    const int nq = tid & 15, kr = tid >> 4;
    __syncthreads();
#pragma unroll
    for (int i = 0; i < 4; ++i)
#pragma unroll
        for (int q = 0; q < 4; ++q) s[(4 * nq + q) * 129 + kr + 32 * i] = v[i][q];
    __syncthreads();
    const int n = tid >> 3, k16 = (tid & 7) * 16;
    float f[16];
#pragma unroll
    for (int i = 0; i < 16; ++i) f[i] = s[n * 129 + k16 + i];
    bf16_t* d = j.dst + (size_t)(tn * 64 + n) * j.ld_dst + tk * 128 + k16;
    *(u32x4*)d = pack8(f); *(u32x4*)(d + 8) = pack8(f + 8);
}
__device__ __forceinline__ void transpose_jobs(const TJob* jobs, int njobs, int bi, int nblk, LAS unsigned char* lds) {
    LAS float* s = (LAS float*)lds;
    int total = 0;
    for (int q = 0; q < njobs; ++q) total += (jobs[q].Nout >> 6) * (jobs[q].K >> 7);
    f32x4 v[4]; int curj = 0, base = 0;
    int t = bi;
    auto locate = [&](int tt, int& jj, int& bb) { while (tt >= bb + (jobs[jj].Nout >> 6) * (jobs[jj].K >> 7)) { bb += (jobs[jj].Nout >> 6) * (jobs[jj].K >> 7); ++jj; } };
    if (t < total) { locate(t, curj, base); tjob_load(jobs[curj], t - base, v); }
    while (t < total) {
        const int tn = t + nblk; int nj = curj, nb = base; f32x4 w[4];
        if (tn < total) { locate(tn, nj, nb); tjob_load(jobs[nj], tn - nb, w); }
        tjob_store(jobs[curj], t - base, v, s);
        if (tn < total) {
#pragma unroll
            for (int i = 0; i < 4; ++i) v[i] = w[i]; }
        t = tn; curj = nj; base = nb;
    }
    __syncthreads();
}

template <int MODE>
__device__ __forceinline__ void norm_phase(const Params& p, int bid, int nblk) {
    const int lane = threadIdx.x & 63, wid = __builtin_amdgcn_readfirstlane(threadIdx.x >> 6);
    const float* mod = (const float*)(p.ws + WS_MOD);
    const float* gain = MODE == 0 ? p.in[9] : (MODE == 1 ? p.in[20] : p.in[23]);
    bf16_t* U = (bf16_t*)(p.ws + WS_U);
    for (int row = bid * 8 + wid; row < TT; row += nblk * 8) {
        const float* src = MODE == 0 ? (row < TP ? p.in[0] + (size_t)row * DM : p.in[1] + (size_t)(row - TP) * DM) : p.out + O_Y + (size_t)row * DM;
        if (MODE != 0 && row >= TP) {
            const float* xs = p.in[1] + (size_t)(row - TP) * DM;
            const float* pb = (const float*)(p.ws + (MODE == 1 ? WS_PB10 : WS_PB13)) + (size_t)(row - TP) * DM;
            const float* gt = mod + (size_t)bidx_of_row(row) * MODW + (MODE == 1 ? 4096 : 10240);
            float* xo = p.out + O_Y + (size_t)row * DM;
            constexpr int NPC = MODE == 1 ? 8 : 11;
#pragma unroll 1
            for (int i = 0; i < 8; ++i) { const int c = i * 256 + lane * 4; f32x4 s = *(const f32x4*)(pb + c);
#pragma unroll
                for (int q = 1; q < NPC; ++q) s += *(const f32x4*)(pb + (size_t)q * TS * DM + c);
                const f32x4 base = MODE == 1 ? *(const f32x4*)(xs + c) : *(const f32x4*)(xo + c);
                *(f32x4*)(xo + c) = base + *(const f32x4*)(gt + c) * s; }
            asm volatile("s_waitcnt vmcnt(0)" ::: "memory");
        }
        f32x4 v[8]; float ss = 0.f;
#pragma unroll
        for (int i = 0; i < 8; ++i) v[i] = *(const f32x4*)(src + i * 256 + lane * 4);
#pragma unroll
        for (int i = 0; i < 8; ++i) ss += v[i][0] * v[i][0] + v[i][1] * v[i][1] + v[i][2] * v[i][2] + v[i][3] * v[i][3];
#pragma unroll
        for (int o = 32; o >= 1; o >>= 1) ss += __shfl_xor(ss, o);
        const float rstd = rsqrtf(ss * (1.0f / DM) + EPS);
        if (MODE == 2) {
            float* dst = p.out + O_Y + (size_t)row * DM;
#pragma unroll
            for (int i = 0; i < 8; ++i) { const f32x4 g = *(const f32x4*)(gain + i * 256 + lane * 4); *(f32x4*)(dst + i * 256 + lane * 4) = v[i] * rstd * g; }
        } else {
            const float* sh = mod + (size_t)bidx_of_row(row) * MODW + (MODE == 0 ? 0 : 6144); const float* sc = sh + 2048;
#pragma unroll
            for (int i = 0; i < 8; ++i) { const int c = i * 256 + lane * 4; const f32x4 g = *(const f32x4*)(gain + c), s1 = *(const f32x4*)(sc + c), s0 = *(const f32x4*)(sh + c);
                const f32x4 y = (v[i] * rstd * g) * (1.0f + s1) + s0; u32x2 w; w.x = pk2(y[0], y[1]); w.y = pk2(y[2], y[3]); *(u32x2*)(U + (size_t)row * DM + c) = w; }
        }
    }
}

template <int NTOK, bool SMP>
__device__ __forceinline__ void mixer_item(const Params& p, int it) {
    const int tid = threadIdx.x;
    const bf16_t* proj = (const bf16_t*)(p.ws + WS_PROJ);
    bf16_t* qn = (bf16_t*)(p.ws + WS_QN); bf16_t* kn = (bf16_t*)(p.ws + WS_KN); bf16_t* vv = (bf16_t*)(p.ws + WS_VV); bf16_t* yp = (bf16_t*)(p.ws + WS_YP);
    float* gbuf = (float*)(p.ws + WS_G); float* bbuf = (float*)(p.ws + WS_BETA);
    const int sb = it - 512;
    const int b = SMP ? 0 : (it >> 7), t0 = SMP ? 0 : (it & 127) * 16;
    const int rowbase = SMP ? TP + sb * 4 : b * 2048 + t0;
    if (tid < 384) {
        const int c0 = tid * 8;
        float w0[8], w1[8], w2[8], w3[8], xm3[8], xm2[8], xm1[8];
        const float* cw = p.in[11];
#pragma unroll
        for (int i = 0; i < 8; ++i) { w0[i] = cw[c0 + i]; w1[i] = cw[3072 + c0 + i]; w2[i] = cw[6144 + c0 + i]; w3[i] = cw[9216 + c0 + i]; }
        if (SMP) { const float* sc = p.in[5] + (size_t)sb * 3 * 3072 + c0;
#pragma unroll
            for (int i = 0; i < 8; ++i) { xm3[i] = sc[i]; xm2[i] = sc[3072 + i]; xm1[i] = sc[6144 + i]; }
        } else if (t0 == 0) {
#pragma unroll
            for (int i = 0; i < 8; ++i) { xm3[i] = 0.f; xm2[i] = 0.f; xm1[i] = 0.f; }
        } else {
            unpack8(*(const u32x4*)(proj + (size_t)(rowbase - 3) * NPROJ + c0), xm3); unpack8(*(const u32x4*)(proj + (size_t)(rowbase - 2) * NPROJ + c0), xm2); unpack8(*(const u32x4*)(proj + (size_t)(rowbase - 1) * NPROJ + c0), xm1);
        }
        constexpr int CH = NTOK < 8 ? NTOK : 8;
#pragma unroll 1
        for (int tc = 0; tc < NTOK; tc += CH) {
        u32x4 xr[CH];
#pragma unroll
        for (int t = 0; t < CH; ++t) xr[t] = *(const u32x4*)(proj + (size_t)(rowbase + tc + t) * NPROJ + c0);
#pragma unroll
        for (int t2 = 0; t2 < CH; ++t2) {
            const int t = tc + t2;
            const int row = rowbase + t; float xt[8], y[8];
            unpack8(xr[t2], xt);
            float ss = 0.f;
#pragma unroll
            for (int i = 0; i < 8; ++i) { const float a = w0[i] * xm3[i] + w1[i] * xm2[i] + w2[i] * xm1[i] + w3[i] * xt[i]; y[i] = siluf_(a); ss += y[i] * y[i]; }
            if (c0 < 2048) {
                ss += __shfl_xor(ss, 1); ss += __shfl_xor(ss, 2); ss += __shfl_xor(ss, 4); ss += __shfl_xor(ss, 8);
                const float inv = rsqrtf(ss + EPS);
#pragma unroll
                for (int i = 0; i < 8; ++i) y[i] *= inv;
            }
            bf16_t* dst = c0 < 1024 ? qn + (size_t)row * 1024 + c0 : (c0 < 2048 ? kn + (size_t)row * 1024 + (c0 - 1024) : vv + (size_t)row * 1024 + (c0 - 2048));
            *(u32x4*)dst = pack8(y);
            if (SMP) { if (t >= 1) { float* o = p.out + O_CS + ((size_t)sb * 3 + (t - 1)) * 3072 + c0; *(f32x4*)o = (f32x4){xt[0], xt[1], xt[2], xt[3]}; *(f32x4*)(o + 4) = (f32x4){xt[4], xt[5], xt[6], xt[7]}; } }
            else if (t0 + t >= 2045) { float* o = p.out + O_CP + ((size_t)b * 3 + (t0 + t - 2045)) * 3072 + c0; *(f32x4*)o = (f32x4){xt[0], xt[1], xt[2], xt[3]}; *(f32x4*)(o + 4) = (f32x4){xt[4], xt[5], xt[6], xt[7]}; }
#pragma unroll
            for (int i = 0; i < 8; ++i) { xm3[i] = xm2[i]; xm2[i] = xm1[i]; xm1[i] = xt[i]; }
        }
        }
    } else {
        const int pc = (tid - 384) * 8, gi = pc >> 8, w = 2 << gi;
        const int seqrow0 = SMP ? TP + sb * 4 : b * 2048;
        const float* sp = p.in[6] + (size_t)sb * 15 * 1024 + pc;
        auto xpool = [&](int tt, float* f) {
            if (tt >= 0) unpack8(*(const u32x4*)(proj + (size_t)(seqrow0 + tt) * NPROJ + C_XP + pc), f);
            else if (SMP) { const float* s = sp + (size_t)(15 + tt) * 1024;
#pragma unroll
                for (int i = 0; i < 8; ++i) f[i] = s[i]; }
            else {
#pragma unroll
                for (int i = 0; i < 8; ++i) f[i] = 0.f; }
        };
        float s[8];
#pragma unroll
        for (int i = 0; i < 8; ++i) s[i] = 0.f;
#pragma unroll
        for (int q = 1; q < 16; ++q) if (q < w) { float f[8]; xpool(t0 - q, f);
#pragma unroll
            for (int i = 0; i < 8; ++i) s[i] += f[i]; }
#pragma unroll 4
        for (int t = 0; t < NTOK; ++t) {
            const int tt = t0 + t; float x[8], y[8], f[8];
            xpool(tt, x);
            const float cnt = SMP ? (float)w : (float)min(w, tt + 1); const float ic = 1.0f / cnt;
#pragma unroll
            for (int i = 0; i < 8; ++i) { s[i] += x[i]; y[i] = s[i] * ic - x[i]; }
            *(u32x4*)(yp + (size_t)(seqrow0 + tt) * 1024 + pc) = pack8(y);
            xpool(tt - w + 1, f);
#pragma unroll
            for (int i = 0; i < 8; ++i) s[i] -= f[i];
            if (SMP) { float* o = p.out + O_PS + ((size_t)sb * 15 + 11 + t) * 1024 + pc; *(f32x4*)o = (f32x4){x[0], x[1], x[2], x[3]}; *(f32x4*)(o + 4) = (f32x4){x[4], x[5], x[6], x[7]}; }
            else if (tt >= 2033) { float* o = p.out + O_PP + ((size_t)b * 15 + (tt - 2033)) * 1024 + pc; *(f32x4*)o = (f32x4){x[0], x[1], x[2], x[3]}; *(f32x4*)(o + 4) = (f32x4){x[4], x[5], x[6], x[7]}; }
        }
        if (SMP) {
#pragma unroll
            for (int r = 0; r < 11; ++r) { const float* s2 = sp + (size_t)(4 + r) * 1024; float* o = p.out + O_PS + ((size_t)sb * 15 + r) * 1024 + pc; *(f32x4*)o = *(const f32x4*)s2; *(f32x4*)(o + 4) = *(const f32x4*)(s2 + 4); } }
    }
    if (tid < 256) { const int tk = tid >> 4, jj = tid & 15;
        if (tk < NTOK) { const int row = rowbase + tk; const float val = bf2f(proj[(size_t)row * NPROJ + C_AB + jj]);
            if (jj < 8) { const float xx = val + p.in[13][jj]; const float spl = xx > 20.f ? xx : log1pf(__expf(xx)); gbuf[row * 8 + jj] = -__expf(p.in[12][jj]) * spl; }
            else bbuf[row * 8 + (jj - 8)] = sigmoidf_(val); } }
}
__device__ __forceinline__ void mixer_prep_phase(const Params& p, int bid, int nblk) {
    for (int it = bid; it < 640; it += nblk) { if (it >= 512) mixer_item<4, true>(p, it); else mixer_item<16, false>(p, it); }
}

constexpr int P5_QS = 0, P5_KS = 17408, P5_VS = 34816, P5_MM = 52224, P5_DEC = 68608, P5_BETA = 68864, P5_GRP = 69632;
static_assert(2 * P5_GRP <= LDS_BYTES - 16, "lds");
__device__ __forceinline__ void chunk_prep_phase(const Params& p, int bid, int nblk, LAS unsigned char* lds0) {
    const int tid = threadIdx.x, lane = tid & 63, grp = tid >> 8, lt = tid & 255, lw = __builtin_amdgcn_readfirstlane(tid >> 6) & 3;
    LAS unsigned char* lds = lds0 + grp * P5_GRP;
    const bf16_t* qn = (const bf16_t*)(p.ws + WS_QN); const bf16_t* kn = (const bf16_t*)(p.ws + WS_KN); const bf16_t* vv = (const bf16_t*)(p.ws + WS_VV);
    const float* gbuf = (const float*)(p.ws + WS_G); const float* bbuf = (const float*)(p.ws + WS_BETA);
    bf16_t* wdc = (bf16_t*)(p.ws + WS_WDC); bf16_t* qd = (bf16_t*)(p.ws + WS_QD); bf16_t* kt = (bf16_t*)(p.ws + WS_KT); bf16_t* qk = (bf16_t*)(p.ws + WS_QK);
    float* cdv = (float*)(p.ws + WS_CD); float* ub = p.out + OS_UB;
    LAS float* Mm = (LAS float*)(lds + P5_MM); LAS float* dec = (LAS float*)(lds + P5_DEC); LAS float* bet = (LAS float*)(lds + P5_BETA);
    const float scale = 0.08838834764831845f;
    for (int it0 = bid * 2; it0 < 1024; it0 += nblk * 2) {
        const int item = it0 + grp, n = item & 31, bh = item >> 5, h = bh & 7, b = bh >> 3;
        const int r0 = b * 2048 + n * 64;
        __syncthreads();
#pragma unroll
        for (int i = 0; i < 4; ++i) { const int ch = lt + 256 * i, r = ch >> 4, c8 = (ch & 15) * 8; const size_t go = (size_t)(r0 + r) * 1024 + h * 128 + c8; const int lo = r * 272 + c8 * 2;
            *(LAS u32x4*)(lds + P5_QS + lo) = *(const u32x4*)(qn + go); *(LAS u32x4*)(lds + P5_KS + lo) = *(const u32x4*)(kn + go); *(LAS u32x4*)(lds + P5_VS + lo) = *(const u32x4*)(vv + go); }
        if (lt < 64) {
            float g = gbuf[(r0 + lt) * 8 + h];
#pragma unroll
            for (int o = 1; o < 64; o <<= 1) { const float t = __shfl_up(g, o); if (lane >= o) g += t; }
            dec[lt] = g;
        } else if (lt < 128) bet[lt - 64] = bbuf[(r0 + lt - 64) * 8 + h];
        __syncthreads();
        {
            const int rt = lw, fr = lane & 15, fq = lane >> 4;
#pragma unroll
            for (int mat = 0; mat < 2; ++mat) {
                bf16x8 a[4];
#pragma unroll
                for (int kk = 0; kk < 4; ++kk) a[kk] = *(const LAS bf16x8*)(lds + (mat ? P5_QS : P5_KS) + (rt * 16 + fr) * 272 + (kk * 32 + fq * 8) * 2);
#pragma unroll
                for (int st = 0; st < 4; ++st) {
                    f32x4 d = (f32x4){0.f, 0.f, 0.f, 0.f};
#pragma unroll
                    for (int kk = 0; kk < 4; ++kk) { const bf16x8 bb = *(const LAS bf16x8*)(lds + P5_KS + (st * 16 + fr) * 272 + (kk * 32 + fq * 8) * 2); d = __builtin_amdgcn_mfma_f32_16x16x32_bf16(a[kk], bb, d, 0, 0, 0); }
                    const int s = st * 16 + fr; const float ds = dec[s];
#pragma unroll
                    for (int j = 0; j < 4; ++j) { const int r = rt * 16 + fq * 4 + j; const float dr = dec[r];
                        if (mat == 0) Mm[r * 64 + s] = (r > s) ? bet[r] * d[j] * __expf(dr - ds) : 0.f;
                        else qk[(size_t)item * 4096 + r * 64 + s] = f2bf((r >= s) ? scale * d[j] * __expf(dr - ds) : 0.f); }
                }
            }
        }
        __syncthreads();
        const int w8 = __builtin_amdgcn_readfirstlane(tid >> 6);
        if (w8 < 4) {
            const int g2 = w8 >> 1, c = (w8 & 1) * 64 + lane; const int item2 = it0 + g2;
            LAS unsigned char* lg = lds0 + g2 * P5_GRP; LAS float* Mg = (LAS float*)(lg + P5_MM); LAS float* decg = (LAS float*)(lg + P5_DEC); LAS float* betg = (LAS float*)(lg + P5_BETA);
            float x[64], y[64]; f32x4 mq[6]; float a0, a1, b0, b1;
            float* up = ub + (size_t)item2 * 8192 + c; bf16_t* wp = wdc + (size_t)item2 * 8192 + c;
            { const float br = betg[0]; a0 = bf2f(*(const LAS bf16_t*)(lg + P5_VS + 0 + c * 2)) * br; b0 = bf2f(*(const LAS bf16_t*)(lg + P5_KS + 0 + c * 2)) * br * __expf(decg[0]); a1 = 0.f; b1 = 0.f; } x[0] = a0; y[0] = b0; up[0] = x[0]; wp[0] = f2bf(-y[0]);
            mq[0] = *(const LAS f32x4*)(Mg + 64); mq[1] = *(const LAS f32x4*)(Mg + 128); mq[2] = *(const LAS f32x4*)(Mg + 192); mq[3] = *(const LAS f32x4*)(Mg + 256); mq[4] = *(const LAS f32x4*)(Mg + 320); mq[5] = *(const LAS f32x4*)(Mg + 324);
            { const float br = betg[1]; a0 = bf2f(*(const LAS bf16_t*)(lg + P5_VS + 272 + c * 2)) * br; b0 = bf2f(*(const LAS bf16_t*)(lg + P5_KS + 272 + c * 2)) * br * __expf(decg[1]); a1 = 0.f; b1 = 0.f; } a0 -= mq[0][0] * x[0]; b0 -= mq[0][0] * y[0]; x[1] = a0 + a1; y[1] = b0 + b1; up[128] = x[1]; wp[128] = f2bf(-y[1]); mq[0] = *(const LAS f32x4*)(Mg + 384);
            { const float br = betg[2]; a0 = bf2f(*(const LAS bf16_t*)(lg + P5_VS + 544 + c * 2)) * br; b0 = bf2f(*(const LAS bf16_t*)(lg + P5_KS + 544 + c * 2)) * br * __expf(decg[2]); a1 = 0.f; b1 = 0.f; } a0 -= mq[1][0] * x[0]; b0 -= mq[1][0] * y[0]; a1 -= mq[1][1] * x[1]; b1 -= mq[1][1] * y[1]; x[2] = a0 + a1; y[2] = b0 + b1; up[256] = x[2]; wp[256] = f2bf(-y[2]); mq[1] = *(const LAS f32x4*)(Mg + 388);
            { const float br = betg[3]; a0 = bf2f(*(const LAS bf16_t*)(lg + P5_VS + 816 + c * 2)) * br; b0 = bf2f(*(const LAS bf16_t*)(lg + P5_KS + 816 + c * 2)) * br * __expf(decg[3]); a1 = 0.f; b1 = 0.f; } a0 -= mq[2][0] * x[0]; b0 -= mq[2][0] * y[0]; a1 -= mq[2][1] * x[1]; b1 -= mq[2][1] * y[1]; a0 -= mq[2][2] * x[2]; b0 -= mq[2][2] * y[2]; x[3] = a0 + a1; y[3] = b0 + b1; up[384] = x[3]; wp[384] = f2bf(-y[3]); mq[2] = *(const LAS f32x4*)(Mg + 448);
            { const float br = betg[4]; a0 = bf2f(*(const LAS bf16_t*)(lg + P5_VS + 1088 + c * 2)) * br; b0 = bf2f(*(const LAS bf16_t*)(lg + P5_KS + 1088 + c * 2)) * br * __expf(decg[4]); a1 = 0.f; b1 = 0.f; } a0 -= mq[3][0] * x[0]; b0 -= mq[3][0] * y[0]; a1 -= mq[3][1] * x[1]; b1 -= mq[3][1] * y[1]; a0 -= mq[3][2] * x[2]; b0 -= mq[3][2] * y[2]; a1 -= mq[3][3] * x[3]; b1 -= mq[3][3] * y[3]; x[4] = a0 + a1; y[4] = b0 + b1; up[512] = x[4]; wp[512] = f2bf(-y[4]); mq[3] = *(const LAS f32x4*)(Mg + 452);
            { const float br = betg[5]; a0 = bf2f(*(const LAS bf16_t*)(lg + P5_VS + 1360 + c * 2)) * br; b0 = bf2f(*(const LAS bf16_t*)(lg + P5_KS + 1360 + c * 2)) * br * __expf(decg[5]); a1 = 0.f; b1 = 0.f; } a0 -= mq[4][0] * x[0]; b0 -= mq[4][0] * y[0]; a1 -= mq[4][1] * x[1]; b1 -= mq[4][1] * y[1]; a0 -= mq[4][2] * x[2]; b0 -= mq[4][2] * y[2]; a1 -= mq[4][3] * x[3]; b1 -= mq[4][3] * y[3]; mq[4] = *(const LAS f32x4*)(Mg + 512);
            a0 -= mq[5][0] * x[4]; b0 -= mq[5][0] * y[4]; x[5] = a0 + a1; y[5] = b0 + b1; up[640] = x[5]; wp[640] = f2bf(-y[5]); mq[5] = *(const LAS f32x4*)(Mg + 516);
            { const float br = betg[6]; a0 = bf2f(*(const LAS bf16_t*)(lg + P5_VS + 1632 + c * 2)) * br; b0 = bf2f(*(const LAS bf16_t*)(lg + P5_KS + 1632 + c * 2)) * br * __expf(decg[6]); a1 = 0.f; b1 = 0.f; } a0 -= mq[0][0] * x[0]; b0 -= mq[0][0] * y[0]; a1 -= mq[0][1] * x[1]; b1 -= mq[0][1] * y[1]; a0 -= mq[0][2] * x[2]; b0 -= mq[0][2] * y[2]; a1 -= mq[0][3] * x[3]; b1 -= mq[0][3] * y[3]; mq[0] = *(const LAS f32x4*)(Mg + 576);
            a0 -= mq[1][0] * x[4]; b0 -= mq[1][0] * y[4]; a1 -= mq[1][1] * x[5]; b1 -= mq[1][1] * y[5]; x[6] = a0 + a1; y[6] = b0 + b1; up[768] = x[6]; wp[768] = f2bf(-y[6]); mq[1] = *(const LAS f32x4*)(Mg + 580);
            { const float br = betg[7]; a0 = bf2f(*(const LAS bf16_t*)(lg + P5_VS + 1904 + c * 2)) * br; b0 = bf2f(*(const LAS bf16_t*)(lg + P5_KS + 1904 + c * 2)) * br * __expf(decg[7]); a1 = 0.f; b1 = 0.f; } a0 -= mq[2][0] * x[0]; b0 -= mq[2][0] * y[0]; a1 -= mq[2][1] * x[1]; b1 -= mq[2][1] * y[1]; a0 -= mq[2][2] * x[2]; b0 -= mq[2][2] * y[2]; a1 -= mq[2][3] * x[3]; b1 -= mq[2][3] * y[3]; mq[2] = *(const LAS f32x4*)(Mg + 584);
            a0 -= mq[3][0] * x[4]; b0 -= mq[3][0] * y[4]; a1 -= mq[3][1] * x[5]; b1 -= mq[3][1] * y[5]; a0 -= mq[3][2] * x[6]; b0 -= mq[3][2] * y[6]; x[7] = a0 + a1; y[7] = b0 + b1; up[896] = x[7]; wp[896] = f2bf(-y[7]); mq[3] = *(const LAS f32x4*)(Mg + 640);
            { const float br = betg[8]; a0 = bf2f(*(const LAS bf16_t*)(lg + P5_VS + 2176 + c * 2)) * br; b0 = bf2f(*(const LAS bf16_t*)(lg + P5_KS + 2176 + c * 2)) * br * __expf(decg[8]); a1 = 0.f; b1 = 0.f; } a0 -= mq[4][0] * x[0]; b0 -= mq[4][0] * y[0]; a1 -= mq[4][1] * x[1]; b1 -= mq[4][1] * y[1]; a0 -= mq[4][2] * x[2]; b0 -= mq[4][2] * y[2]; a1 -= mq[4][3] * x[3]; b1 -= mq[4][3] * y[3]; mq[4] = *(const LAS f32x4*)(Mg + 644);
            a0 -= mq[5][0] * x[4]; b0 -= mq[5][0] * y[4]; a1 -= mq[5][1] * x[5]; b1 -= mq[5][1] * y[5]; a0 -= mq[5][2] * x[6]; b0 -= mq[5][2] * y[6]; a1 -= mq[5][3] * x[7]; b1 -= mq[5][3] * y[7]; x[8] = a0 + a1; y[8] = b0 + b1; up[1024] = x[8]; wp[1024] = f2bf(-y[8]); mq[5] = *(const LAS f32x4*)(Mg + 648);
            { const float br = betg[9]; a0 = bf2f(*(const LAS bf16_t*)(lg + P5_VS + 2448 + c * 2)) * br; b0 = bf2f(*(const LAS bf16_t*)(lg + P5_KS + 2448 + c * 2)) * br * __expf(decg[9]); a1 = 0.f; b1 = 0.f; } a0 -= mq[0][0] * x[0]; b0 -= mq[0][0] * y[0]; a1 -= mq[0][1] * x[1]; b1 -= mq[0][1] * y[1]; a0 -= mq[0][2] * x[2]; b0 -= mq[0][2] * y[2]; a1 -= mq[0][3] * x[3]; b1 -= mq[0][3] * y[3]; mq[0] = *(const LAS f32x4*)(Mg + 704);
            a0 -= mq[1][0] * x[4]; b0 -= mq[1][0] * y[4]; a1 -= mq[1][1] * x[5]; b1 -= mq[1][1] * y[5]; a0 -= mq[1][2] * x[6]; b0 -= mq[1][2] * y[6]; a1 -= mq[1][3] * x[7]; b1 -= mq[1][3] * y[7]; mq[1] = *(const LAS f32x4*)(Mg + 708);
            a0 -= mq[2][0] * x[8]; b0 -= mq[2][0] * y[8]; x[9] = a0 + a1; y[9] = b0 + b1; up[1152] = x[9]; wp[1152] = f2bf(-y[9]); mq[2] = *(const LAS f32x4*)(Mg + 712);
            { const float br = betg[10]; a0 = bf2f(*(const LAS bf16_t*)(lg + P5_VS + 2720 + c * 2)) * br; b0 = bf2f(*(const LAS bf16_t*)(lg + P5_KS + 2720 + c * 2)) * br * __expf(decg[10]); a1 = 0.f; b1 = 0.f; } a0 -= mq[3][0] * x[0]; b0 -= mq[3][0] * y[0]; a1 -= mq[3][1] * x[1]; b1 -= mq[3][1] * y[1]; a0 -= mq[3][2] * x[2]; b0 -= mq[3][2] * y[2]; a1 -= mq[3][3] * x[3]; b1 -= mq[3][3] * y[3]; mq[3] = *(const LAS f32x4*)(Mg + 768);
            a0 -= mq[4][0] * x[4]; b0 -= mq[4][0] * y[4]; a1 -= mq[4][1] * x[5]; b1 -= mq[4][1] * y[5]; a0 -= mq[4][2] * x[6]; b0 -= mq[4][2] * y[6]; a1 -= mq[4][3] * x[7]; b1 -= mq[4][3] * y[7]; mq[4] = *(const LAS f32x4*)(Mg + 772);
            a0 -= mq[5][0] * x[8]; b0 -= mq[5][0] * y[8]; a1 -= mq[5][1] * x[9]; b1 -= mq[5][1] * y[9]; x[10] = a0 + a1; y[10] = b0 + b1; up[1280] = x[10]; wp[1280] = f2bf(-y[10]); mq[5] = *(const LAS f32x4*)(Mg + 776);
            { const float br = betg[11]; a0 = bf2f(*(const LAS bf16_t*)(lg + P5_VS + 2992 + c * 2)) * br; b0 = bf2f(*(const LAS bf16_t*)(lg + P5_KS + 2992 + c * 2)) * br * __expf(decg[11]); a1 = 0.f; b1 = 0.f; } a0 -= mq[0][0] * x[0]; b0 -= mq[0][0] * y[0]; a1 -= mq[0][1] * x[1]; b1 -= mq[0][1] * y[1]; a0 -= mq[0][2] * x[2]; b0 -= mq[0][2] * y[2]; a1 -= mq[0][3] * x[3]; b1 -= mq[0][3] * y[3]; mq[0] = *(const LAS f32x4*)(Mg + 832);
            a0 -= mq[1][0] * x[4]; b0 -= mq[1][0] * y[4]; a1 -= mq[1][1] * x[5]; b1 -= mq[1][1] * y[5]; a0 -= mq[1][2] * x[6]; b0 -= mq[1][2] * y[6]; a1 -= mq[1][3] * x[7]; b1 -= mq[1][3] * y[7]; mq[1] = *(const LAS f32x4*)(Mg + 836);
            a0 -= mq[2][0] * x[8]; b0 -= mq[2][0] * y[8]; a1 -= mq[2][1] * x[9]; b1 -= mq[2][1] * y[9]; a0 -= mq[2][2] * x[10]; b0 -= mq[2][2] * y[10]; x[11] = a0 + a1; y[11] = b0 + b1; up[1408] = x[11]; wp[1408] = f2bf(-y[11]); mq[2] = *(const LAS f32x4*)(Mg + 840);
            { const float br = betg[12]; a0 = bf2f(*(const LAS bf16_t*)(lg + P5_VS + 3264 + c * 2)) * br; b0 = bf2f(*(const LAS bf16_t*)(lg + P5_KS + 3264 + c * 2)) * br * __expf(decg[12]); a1 = 0.f; b1 = 0.f; } a0 -= mq[3][0] * x[0]; b0 -= mq[3][0] * y[0]; a1 -= mq[3][1] * x[1]; b1 -= mq[3][1] * y[1]; a0 -= mq[3][2] * x[2]; b0 -= mq[3][2] * y[2]; a1 -= mq[3][3] * x[3]; b1 -= mq[3][3] * y[3]; mq[3] = *(const LAS f32x4*)(Mg + 844);
            a0 -= mq[4][0] * x[4]; b0 -= mq[4][0] * y[4]; a1 -= mq[4][1] * x[5]; b1 -= mq[4][1] * y[5]; a0 -= mq[4][2] * x[6]; b0 -= mq[4][2] * y[6]; a1 -= mq[4][3] * x[7]; b1 -= mq[4][3] * y[7]; mq[4] = *(const LAS f32x4*)(Mg + 896);
            a0 -= mq[5][0] * x[8]; b0 -= mq[5][0] * y[8]; a1 -= mq[5][1] * x[9]; b1 -= mq[5][1] * y[9]; a0 -= mq[5][2] * x[10]; b0 -= mq[5][2] * y[10]; a1 -= mq[5][3] * x[11]; b1 -= mq[5][3] * y[11]; x[12] = a0 + a1; y[12] = b0 + b1; up[1536] = x[12]; wp[1536] = f2bf(-y[12]); mq[5] = *(const LAS f32x4*)(Mg + 900);
            { const float br = betg[13]; a0 = bf2f(*(const LAS bf16_t*)(lg + P5_VS + 3536 + c * 2)) * br; b0 = bf2f(*(const LAS bf16_t*)(lg + P5_KS + 3536 + c * 2)) * br * __expf(decg[13]); a1 = 0.f; b1 = 0.f; } a0 -= mq[0][0] * x[0]; b0 -= mq[0][0] * y[0]; a1 -= mq[0][1] * x[1]; b1 -= mq[0][1] * y[1]; a0 -= mq[0][2] * x[2]; b0 -= mq[0][2] * y[2]; a1 -= mq[0][3] * x[3]; b1 -= mq[0][3] * y[3]; mq[0] = *(const LAS f32x4*)(Mg + 904);
            a0 -= mq[1][0] * x[4]; b0 -= mq[1][0] * y[4]; a1 -= mq[1][1] * x[5]; b1 -= mq[1][1] * y[5]; a0 -= mq[1][2] * x[6]; b0 -= mq[1][2] * y[6]; a1 -= mq[1][3] * x[7]; b1 -= mq[1][3] * y[7]; mq[1] = *(const LAS f32x4*)(Mg + 908);
            a0 -= mq[2][0] * x[8]; b0 -= mq[2][0] * y[8]; a1 -= mq[2][1] * x[9]; b1 -= mq[2][1] * y[9]; a0 -= mq[2][2] * x[10]; b0 -= mq[2][2] * y[10]; a1 -= mq[2][3] * x[11]; b1 -= mq[2][3] * y[11]; mq[2] = *(const LAS f32x4*)(Mg + 960);
            a0 -= mq[3][0] * x[12]; b0 -= mq[3][0] * y[12]; x[13] = a0 + a1; y[13] = b0 + b1; up[1664] = x[13]; wp[1664] = f2bf(-y[13]); mq[3] = *(const LAS f32x4*)(Mg + 964);
            { const float br = betg[14]; a0 = bf2f(*(const LAS bf16_t*)(lg + P5_VS + 3808 + c * 2)) * br; b0 = bf2f(*(const LAS bf16_t*)(lg + P5_KS + 3808 + c * 2)) * br * __expf(decg[14]); a1 = 0.f; b1 = 0.f; } a0 -= mq[4][0] * x[0]; b0 -= mq[4][0] * y[0]; a1 -= mq[4][1] * x[1]; b1 -= mq[4][1] * y[1]; a0 -= mq[4][2] * x[2]; b0 -= mq[4][2] * y[2]; a1 -= mq[4][3] * x[3]; b1 -= mq[4][3] * y[3]; mq[4] = *(const LAS f32x4*)(Mg + 968);
            a0 -= mq[5][0] * x[4]; b0 -= mq[5][0] * y[4]; a1 -= mq[5][1] * x[5]; b1 -= mq[5][1] * y[5]; a0 -= mq[5][2] * x[6]; b0 -= mq[5][2] * y[6]; a1 -= mq[5][3] * x[7]; b1 -= mq[5][3] * y[7]; mq[5] = *(const LAS f32x4*)(Mg + 972);
            a0 -= mq[0][0] * x[8]; b0 -= mq[0][0] * y[8]; a1 -= mq[0][1] * x[9]; b1 -= mq[0][1] * y[9]; a0 -= mq[0][2] * x[10]; b0 -= mq[0][2] * y[10]; a1 -= mq[0][3] * x[11]; b1 -= mq[0][3] * y[11]; mq[0] = *(const LAS f32x4*)(Mg + 1024);
            a0 -= mq[1][0] * x[12]; b0 -= mq[1][0] * y[12]; a1 -= mq[1][1] * x[13]; b1 -= mq[1][1] * y[13]; x[14] = a0 + a1; y[14] = b0 + b1; up[1792] = x[14]; wp[1792] = f2bf(-y[14]); mq[1] = *(const LAS f32x4*)(Mg + 1028);
            { const float br = betg[15]; a0 = bf2f(*(const LAS bf16_t*)(lg + P5_VS + 4080 + c * 2)) * br; b0 = bf2f(*(const LAS bf16_t*)(lg + P5_KS + 4080 + c * 2)) * br * __expf(decg[15]); a1 = 0.f; b1 = 0.f; } a0 -= mq[2][0] * x[0]; b0 -= mq[2][0] * y[0]; a1 -= mq[2][1] * x[1]; b1 -= mq[2][1] * y[1]; a0 -= mq[2][2] * x[2]; b0 -= mq[2][2] * y[2]; a1 -= mq[2][3] * x[3]; b1 -= mq[2][3] * y[3]; mq[2] = *(const LAS f32x4*)(Mg + 1032);
            a0 -= mq[3][0] * x[4]; b0 -= mq[3][0] * y[4]; a1 -= mq[3][1] * x[5]; b1 -= mq[3][1] * y[5]; a0 -= mq[3][2] * x[6]; b0 -= mq[3][2] * y[6]; a1 -= mq[3][3] * x[7]; b1 -= mq[3][3] * y[7]; mq[3] = *(const LAS f32x4*)(Mg + 1036);
            a0 -= mq[4][0] * x[8]; b0 -= mq[4][0] * y[8]; a1 -= mq[4][1] * x[9]; b1 -= mq[4][1] * y[9]; a0 -= mq[4][2] * x[10]; b0 -= mq[4][2] * y[10]; a1 -= mq[4][3] * x[11]; b1 -= mq[4][3] * y[11]; mq[4] = *(const LAS f32x4*)(Mg + 1088);
            a0 -= mq[5][0] * x[12]; b0 -= mq[5][0] * y[12]; a1 -= mq[5][1] * x[13]; b1 -= mq[5][1] * y[13]; a0 -= mq[5][2] * x[14]; b0 -= mq[5][2] * y[14]; x[15] = a0 + a1; y[15] = b0 + b1; up[1920] = x[15]; wp[1920] = f2bf(-y[15]); mq[5] = *(const LAS f32x4*)(Mg + 1092);
            { const float br = betg[16]; a0 = bf2f(*(const LAS bf16_t*)(lg + P5_VS + 4352 + c * 2)) * br; b0 = bf2f(*(const LAS bf16_t*)(lg + P5_KS + 4352 + c * 2)) * br * __expf(decg[16]); a1 = 0.f; b1 = 0.f; } a0 -= mq[0][0] * x[0]; b0 -= mq[0][0] * y[0]; a1 -= mq[0][1] * x[1]; b1 -= mq[0][1] * y[1]; a0 -= mq[0][2] * x[2]; b0 -= mq[0][2] * y[2]; a1 -= mq[0][3] * x[3]; b1 -= mq[0][3] * y[3]; mq[0] = *(const LAS f32x4*)(Mg + 1096);
            a0 -= mq[1][0] * x[4]; b0 -= mq[1][0] * y[4]; a1 -= mq[1][1] * x[5]; b1 -= mq[1][1] * y[5]; a0 -= mq[1][2] * x[6]; b0 -= mq[1][2] * y[6]; a1 -= mq[1][3] * x[7]; b1 -= mq[1][3] * y[7]; mq[1] = *(const LAS f32x4*)(Mg + 1100);
            a0 -= mq[2][0] * x[8]; b0 -= mq[2][0] * y[8]; a1 -= mq[2][1] * x[9]; b1 -= mq[2][1] * y[9]; a0 -= mq[2][2] * x[10]; b0 -= mq[2][2] * y[10]; a1 -= mq[2][3] * x[11]; b1 -= mq[2][3] * y[11]; mq[2] = *(const LAS f32x4*)(Mg + 1104);
            a0 -= mq[3][0] * x[12]; b0 -= mq[3][0] * y[12]; a1 -= mq[3][1] * x[13]; b1 -= mq[3][1] * y[13]; a0 -= mq[3][2] * x[14]; b0 -= mq[3][2] * y[14]; a1 -= mq[3][3] * x[15]; b1 -= mq[3][3] * y[15]; x[16] = a0 + a1; y[16] = b0 + b1; up[2048] = x[16]; wp[2048] = f2bf(-y[16]); mq[3] = *(const LAS f32x4*)(Mg + 1152);
            { const float br = betg[17]; a0 = bf2f(*(const LAS bf16_t*)(lg + P5_VS + 4624 + c * 2)) * br; b0 = bf2f(*(const LAS bf16_t*)(lg + P5_KS + 4624 + c * 2)) * br * __expf(decg[17]); a1 = 0.f; b1 = 0.f; } a0 -= mq[4][0] * x[0]; b0 -= mq[4][0] * y[0]; a1 -= mq[4][1] * x[1]; b1 -= mq[4][1] * y[1]; a0 -= mq[4][2] * x[2]; b0 -= mq[4][2] * y[2]; a1 -= mq[4][3] * x[3]; b1 -= mq[4][3] * y[3]; mq[4] = *(const LAS f32x4*)(Mg + 1156);
            a0 -= mq[5][0] * x[4]; b0 -= mq[5][0] * y[4]; a1 -= mq[5][1] * x[5]; b1 -= mq[5][1] * y[5]; a0 -= mq[5][2] * x[6]; b0 -= mq[5][2] * y[6]; a1 -= mq[5][3] * x[7]; b1 -= mq[5][3] * y[7]; mq[5] = *(const LAS f32x4*)(Mg + 1160);
            a0 -= mq[0][0] * x[8]; b0 -= mq[0][0] * y[8]; a1 -= mq[0][1] * x[9]; b1 -= mq[0][1] * y[9]; a0 -= mq[0][2] * x[10]; b0 -= mq[0][2] * y[10]; a1 -= mq[0][3] * x[11]; b1 -= mq[0][3] * y[11]; mq[0] = *(const LAS f32x4*)(Mg + 1164);
            a0 -= mq[1][0] * x[12]; b0 -= mq[1][0] * y[12]; a1 -= mq[1][1] * x[13]; b1 -= mq[1][1] * y[13]; a0 -= mq[1][2] * x[14]; b0 -= mq[1][2] * y[14]; a1 -= mq[1][3] * x[15]; b1 -= mq[1][3] * y[15]; mq[1] = *(const LAS f32x4*)(Mg + 1168);
            a0 -= mq[2][0] * x[16]; b0 -= mq[2][0] * y[16]; x[17] = a0 + a1; y[17] = b0 + b1; up[2176] = x[17]; wp[2176] = f2bf(-y[17]); mq[2] = *(const LAS f32x4*)(Mg + 1216);
            { const float br = betg[18]; a0 = bf2f(*(const LAS bf16_t*)(lg + P5_VS + 4896 + c * 2)) * br; b0 = bf2f(*(const LAS bf16_t*)(lg + P5_KS + 4896 + c * 2)) * br * __expf(decg[18]); a1 = 0.f; b1 = 0.f; } a0 -= mq[3][0] * x[0]; b0 -= mq[3][0] * y[0]; a1 -= mq[3][1] * x[1]; b1 -= mq[3][1] * y[1]; a0 -= mq[3][2] * x[2]; b0 -= mq[3][2] * y[2]; a1 -= mq[3][3] * x[3]; b1 -= mq[3][3] * y[3]; mq[3] = *(const LAS f32x4*)(Mg + 1220);
            a0 -= mq[4][0] * x[4]; b0 -= mq[4][0] * y[4]; a1 -= mq[4][1] * x[5]; b1 -= mq[4][1] * y[5]; a0 -= mq[4][2] * x[6]; b0 -= mq[4][2] * y[6]; a1 -= mq[4][3] * x[7]; b1 -= mq[4][3] * y[7]; mq[4] = *(const LAS f32x4*)(Mg + 1224);
            a0 -= mq[5][0] * x[8]; b0 -= mq[5][0] * y[8]; a1 -= mq[5][1] * x[9]; b1 -= mq[5][1] * y[9]; a0 -= mq[5][2] * x[10]; b0 -= mq[5][2] * y[10]; a1 -= mq[5][3] * x[11]; b1 -= mq[5][3] * y[11]; mq[5] = *(const LAS f32x4*)(Mg + 1228);
            a0 -= mq[0][0] * x[12]; b0 -= mq[0][0] * y[12]; a1 -= mq[0][1] * x[13]; b1 -= mq[0][1] * y[13]; a0 -= mq[0][2] * x[14]; b0 -= mq[0][2] * y[14]; a1 -= mq[0][3] * x[15]; b1 -= mq[0][3] * y[15]; mq[0] = *(const LAS f32x4*)(Mg + 1232);
            a0 -= mq[1][0] * x[16]; b0 -= mq[1][0] * y[16]; a1 -= mq[1][1] * x[17]; b1 -= mq[1][1] * y[17]; x[18] = a0 + a1; y[18] = b0 + b1; up[2304] = x[18]; wp[2304] = f2bf(-y[18]); mq[1] = *(const LAS f32x4*)(Mg + 1280);
            { const float br = betg[19]; a0 = bf2f(*(const LAS bf16_t*)(lg + P5_VS + 5168 + c * 2)) * br; b0 = bf2f(*(const LAS bf16_t*)(lg + P5_KS + 5168 + c * 2)) * br * __expf(decg[19]); a1 = 0.f; b1 = 0.f; } a0 -= mq[2][0] * x[0]; b0 -= mq[2][0] * y[0]; a1 -= mq[2][1] * x[1]; b1 -= mq[2][1] * y[1]; a0 -= mq[2][2] * x[2]; b0 -= mq[2][2] * y[2]; a1 -= mq[2][3] * x[3]; b1 -= mq[2][3] * y[3]; mq[2] = *(const LAS f32x4*)(Mg + 1284);
            a0 -= mq[3][0] * x[4]; b0 -= mq[3][0] * y[4]; a1 -= mq[3][1] * x[5]; b1 -= mq[3][1] * y[5]; a0 -= mq[3][2] * x[6]; b0 -= mq[3][2] * y[6]; a1 -= mq[3][3] * x[7]; b1 -= mq[3][3] * y[7]; mq[3] = *(const LAS f32x4*)(Mg + 1288);
            a0 -= mq[4][0] * x[8]; b0 -= mq[4][0] * y[8]; a1 -= mq[4][1] * x[9]; b1 -= mq[4][1] * y[9]; a0 -= mq[4][2] * x[10]; b0 -= mq[4][2] * y[10]; a1 -= mq[4][3] * x[11]; b1 -= mq[4][3] * y[11]; mq[4] = *(const LAS f32x4*)(Mg + 1292);
            a0 -= mq[5][0] * x[12]; b0 -= mq[5][0] * y[12]; a1 -= mq[5][1] * x[13]; b1 -= mq[5][1] * y[13]; a0 -= mq[5][2] * x[14]; b0 -= mq[5][2] * y[14]; a1 -= mq[5][3] * x[15]; b1 -= mq[5][3] * y[15]; mq[5] = *(const LAS f32x4*)(Mg + 1296);
            a0 -= mq[0][0] * x[16]; b0 -= mq[0][0] * y[16]; a1 -= mq[0][1] * x[17]; b1 -= mq[0][1] * y[17]; a0 -= mq[0][2] * x[18]; b0 -= mq[0][2] * y[18]; x[19] = a0 + a1; y[19] = b0 + b1; up[2432] = x[19]; wp[2432] = f2bf(-y[19]); mq[0] = *(const LAS f32x4*)(Mg + 1344);
            { const float br = betg[20]; a0 = bf2f(*(const LAS bf16_t*)(lg + P5_VS + 5440 + c * 2)) * br; b0 = bf2f(*(const LAS bf16_t*)(lg + P5_KS + 5440 + c * 2)) * br * __expf(decg[20]); a1 = 0.f; b1 = 0.f; } a0 -= mq[1][0] * x[0]; b0 -= mq[1][0] * y[0]; a1 -= mq[1][1] * x[1]; b1 -= mq[1][1] * y[1]; a0 -= mq[1][2] * x[2]; b0 -= mq[1][2] * y[2]; a1 -= mq[1][3] * x[3]; b1 -= mq[1][3] * y[3]; mq[1] = *(const LAS f32x4*)(Mg + 1348);
            a0 -= mq[2][0] * x[4]; b0 -= mq[2][0] * y[4]; a1 -= mq[2][1] * x[5]; b1 -= mq[2][1] * y[5]; a0 -= mq[2][2] * x[6]; b0 -= mq[2][2] * y[6]; a1 -= mq[2][3] * x[7]; b1 -= mq[2][3] * y[7]; mq[2] = *(const LAS f32x4*)(Mg + 1352);
            a0 -= mq[3][0] * x[8]; b0 -= mq[3][0] * y[8]; a1 -= mq[3][1] * x[9]; b1 -= mq[3][1] * y[9]; a0 -= mq[3][2] * x[10]; b0 -= mq[3][2] * y[10]; a1 -= mq[3][3] * x[11]; b1 -= mq[3][3] * y[11]; mq[3] = *(const LAS f32x4*)(Mg + 1356);
            a0 -= mq[4][0] * x[12]; b0 -= mq[4][0] * y[12]; a1 -= mq[4][1] * x[13]; b1 -= mq[4][1] * y[13]; a0 -= mq[4][2] * x[14]; b0 -= mq[4][2] * y[14]; a1 -= mq[4][3] * x[15]; b1 -= mq[4][3] * y[15]; mq[4] = *(const LAS f32x4*)(Mg + 1360);
            a0 -= mq[5][0] * x[16]; b0 -= mq[5][0] * y[16]; a1 -= mq[5][1] * x[17]; b1 -= mq[5][1] * y[17]; a0 -= mq[5][2] * x[18]; b0 -= mq[5][2] * y[18]; a1 -= mq[5][3] * x[19]; b1 -= mq[5][3] * y[19]; x[20] = a0 + a1; y[20] = b0 + b1; up[2560] = x[20]; wp[2560] = f2bf(-y[20]); mq[5] = *(const LAS f32x4*)(Mg + 1364);
            { const float br = betg[21]; a0 = bf2f(*(const LAS bf16_t*)(lg + P5_VS + 5712 + c * 2)) * br; b0 = bf2f(*(const LAS bf16_t*)(lg + P5_KS + 5712 + c * 2)) * br * __expf(decg[21]); a1 = 0.f; b1 = 0.f; } a0 -= mq[0][0] * x[0]; b0 -= mq[0][0] * y[0]; a1 -= mq[0][1] * x[1]; b1 -= mq[0][1] * y[1]; a0 -= mq[0][2] * x[2]; b0 -= mq[0][2] * y[2]; a1 -= mq[0][3] * x[3]; b1 -= mq[0][3] * y[3]; mq[0] = *(const LAS f32x4*)(Mg + 1408);
            a0 -= mq[1][0] * x[4]; b0 -= mq[1][0] * y[4]; a1 -= mq[1][1] * x[5]; b1 -= mq[1][1] * y[5]; a0 -= mq[1][2] * x[6]; b0 -= mq[1][2] * y[6]; a1 -= mq[1][3] * x[7]; b1 -= mq[1][3] * y[7]; mq[1] = *(const LAS f32x4*)(Mg + 1412);
            a0 -= mq[2][0] * x[8]; b0 -= mq[2][0] * y[8]; a1 -= mq[2][1] * x[9]; b1 -= mq[2][1] * y[9]; a0 -= mq[2][2] * x[10]; b0 -= mq[2][2] * y[10]; a1 -= mq[2][3] * x[11]; b1 -= mq[2][3] * y[11]; mq[2] = *(const LAS f32x4*)(Mg + 1416);
            a0 -= mq[3][0] * x[12]; b0 -= mq[3][0] * y[12]; a1 -= mq[3][1] * x[13]; b1 -= mq[3][1] * y[13]; a0 -= mq[3][2] * x[14]; b0 -= mq[3][2] * y[14]; a1 -= mq[3][3] * x[15]; b1 -= mq[3][3] * y[15]; mq[3] = *(const LAS f32x4*)(Mg + 1420);
            a0 -= mq[4][0] * x[16]; b0 -= mq[4][0] * y[16]; a1 -= mq[4][1] * x[17]; b1 -= mq[4][1] * y[17]; a0 -= mq[4][2] * x[18]; b0 -= mq[4][2] * y[18]; a1 -= mq[4][3] * x[19]; b1 -= mq[4][3] * y[19]; mq[4] = *(const LAS f32x4*)(Mg + 1424);
            a0 -= mq[5][0] * x[20]; b0 -= mq[5][0] * y[20]; x[21] = a0 + a1; y[21] = b0 + b1; up[2688] = x[21]; wp[2688] = f2bf(-y[21]); mq[5] = *(const LAS f32x4*)(Mg + 1428);
            { const float br = betg[22]; a0 = bf2f(*(const LAS bf16_t*)(lg + P5_VS + 5984 + c * 2)) * br; b0 = bf2f(*(const LAS bf16_t*)(lg + P5_KS + 5984 + c * 2)) * br * __expf(decg[22]); a1 = 0.f; b1 = 0.f; } a0 -= mq[0][0] * x[0]; b0 -= mq[0][0] * y[0]; a1 -= mq[0][1] * x[1]; b1 -= mq[0][1] * y[1]; a0 -= mq[0][2] * x[2]; b0 -= mq[0][2] * y[2]; a1 -= mq[0][3] * x[3]; b1 -= mq[0][3] * y[3]; mq[0] = *(const LAS f32x4*)(Mg + 1472);
            a0 -= mq[1][0] * x[4]; b0 -= mq[1][0] * y[4]; a1 -= mq[1][1] * x[5]; b1 -= mq[1][1] * y[5]; a0 -= mq[1][2] * x[6]; b0 -= mq[1][2] * y[6]; a1 -= mq[1][3] * x[7]; b1 -= mq[1][3] * y[7]; mq[1] = *(const LAS f32x4*)(Mg + 1476);
            a0 -= mq[2][0] * x[8]; b0 -= mq[2][0] * y[8]; a1 -= mq[2][1] * x[9]; b1 -= mq[2][1] * y[9]; a0 -= mq[2][2] * x[10]; b0 -= mq[2][2] * y[10]; a1 -= mq[2][3] * x[11]; b1 -= mq[2][3] * y[11]; mq[2] = *(const LAS f32x4*)(Mg + 1480);
            a0 -= mq[3][0] * x[12]; b0 -= mq[3][0] * y[12]; a1 -= mq[3][1] * x[13]; b1 -= mq[3][1] * y[13]; a0 -= mq[3][2] * x[14]; b0 -= mq[3][2] * y[14]; a1 -= mq[3][3] * x[15]; b1 -= mq[3][3] * y[15]; mq[3] = *(const LAS f32x4*)(Mg + 1484);
            a0 -= mq[4][0] * x[16]; b0 -= mq[4][0] * y[16]; a1 -= mq[4][1] * x[17]; b1 -= mq[4][1] * y[17]; a0 -= mq[4][2] * x[18]; b0 -= mq[4][2] * y[18]; a1 -= mq[4][3] * x[19]; b1 -= mq[4][3] * y[19]; mq[4] = *(const LAS f32x4*)(Mg + 1488);
            a0 -= mq[5][0] * x[20]; b0 -= mq[5][0] * y[20]; a1 -= mq[5][1] * x[21]; b1 -= mq[5][1] * y[21]; x[22] = a0 + a1; y[22] = b0 + b1; up[2816] = x[22]; wp[2816] = f2bf(-y[22]); mq[5] = *(const LAS f32x4*)(Mg + 1492);
            { const float br = betg[23]; a0 = bf2f(*(const LAS bf16_t*)(lg + P5_VS + 6256 + c * 2)) * br; b0 = bf2f(*(const LAS bf16_t*)(lg + P5_KS + 6256 + c * 2)) * br * __expf(decg[23]); a1 = 0.f; b1 = 0.f; } a0 -= mq[0][0] * x[0]; b0 -= mq[0][0] * y[0]; a1 -= mq[0][1] * x[1]; b1 -= mq[0][1] * y[1]; a0 -= mq[0][2] * x[2]; b0 -= mq[0][2] * y[2]; a1 -= mq[0][3] * x[3]; b1 -= mq[0][3] * y[3]; mq[0] = *(const LAS f32x4*)(Mg + 1536);
            a0 -= mq[1][0] * x[4]; b0 -= mq[1][0] * y[4]; a1 -= mq[1][1] * x[5]; b1 -= mq[1][1] * y[5]; a0 -= mq[1][2] * x[6]; b0 -= mq[1][2] * y[6]; a1 -= mq[1][3] * x[7]; b1 -= mq[1][3] * y[7]; mq[1] = *(const LAS f32x4*)(Mg + 1540);
            a0 -= mq[2][0] * x[8]; b0 -= mq[2][0] * y[8]; a1 -= mq[2][1] * x[9]; b1 -= mq[2][1] * y[9]; a0 -= mq[2][2] * x[10]; b0 -= mq[2][2] * y[10]; a1 -= mq[2][3] * x[11]; b1 -= mq[2][3] * y[11]; mq[2] = *(const LAS f32x4*)(Mg + 1544);
            a0 -= mq[3][0] * x[12]; b0 -= mq[3][0] * y[12]; a1 -= mq[3][1] * x[13]; b1 -= mq[3][1] * y[13]; a0 -= mq[3][2] * x[14]; b0 -= mq[3][2] * y[14]; a1 -= mq[3][3] * x[15]; b1 -= mq[3][3] * y[15]; mq[3] = *(const LAS f32x4*)(Mg + 1548);
            a0 -= mq[4][0] * x[16]; b0 -= mq[4][0] * y[16]; a1 -= mq[4][1] * x[17]; b1 -= mq[4][1] * y[17]; a0 -= mq[4][2] * x[18]; b0 -= mq[4][2] * y[18]; a1 -= mq[4][3] * x[19]; b1 -= mq[4][3] * y[19]; mq[4] = *(const LAS f32x4*)(Mg + 1552);
            a0 -= mq[5][0] * x[20]; b0 -= mq[5][0] * y[20]; a1 -= mq[5][1] * x[21]; b1 -= mq[5][1] * y[21]; a0 -= mq[5][2] * x[22]; b0 -= mq[5][2] * y[22]; x[23] = a0 + a1; y[23] = b0 + b1; up[2944] = x[23]; wp[2944] = f2bf(-y[23]); mq[5] = *(const LAS f32x4*)(Mg + 1556);
            { const float br = betg[24]; a0 = bf2f(*(const LAS bf16_t*)(lg + P5_VS + 6528 + c * 2)) * br; b0 = bf2f(*(const LAS bf16_t*)(lg + P5_KS + 6528 + c * 2)) * br * __expf(decg[24]); a1 = 0.f; b1 = 0.f; } a0 -= mq[0][0] * x[0]; b0 -= mq[0][0] * y[0]; a1 -= mq[0][1] * x[1]; b1 -= mq[0][1] * y[1]; a0 -= mq[0][2] * x[2]; b0 -= mq[0][2] * y[2]; a1 -= mq[0][3] * x[3]; b1 -= mq[0][3] * y[3]; mq[0] = *(const LAS f32x4*)(Mg + 1600);
            a0 -= mq[1][0] * x[4]; b0 -= mq[1][0] * y[4]; a1 -= mq[1][1] * x[5]; b1 -= mq[1][1] * y[5]; a0 -= mq[1][2] * x[6]; b0 -= mq[1][2] * y[6]; a1 -= mq[1][3] * x[7]; b1 -= mq[1][3] * y[7]; mq[1] = *(const LAS f32x4*)(Mg + 1604);
            a0 -= mq[2][0] * x[8]; b0 -= mq[2][0] * y[8]; a1 -= mq[2][1] * x[9]; b1 -= mq[2][1] * y[9]; a0 -= mq[2][2] * x[10]; b0 -= mq[2][2] * y[10]; a1 -= mq[2][3] * x[11]; b1 -= mq[2][3] * y[11]; mq[2] = *(const LAS f32x4*)(Mg + 1608);
            a0 -= mq[3][0] * x[12]; b0 -= mq[3][0] * y[12]; a1 -= mq[3][1] * x[13]; b1 -= mq[3][1] * y[13]; a0 -= mq[3][2] * x[14]; b0 -= mq[3][2] * y[14]; a1 -= mq[3][3] * x[15]; b1 -= mq[3][3] * y[15]; mq[3] = *(const LAS f32x4*)(Mg + 1612);
            a0 -= mq[4][0] * x[16]; b0 -= mq[4][0] * y[16]; a1 -= mq[4][1] * x[17]; b1 -= mq[4][1] * y[17]; a0 -= mq[4][2] * x[18]; b0 -= mq[4][2] * y[18]; a1 -= mq[4][3] * x[19]; b1 -= mq[4][3] * y[19]; mq[4] = *(const LAS f32x4*)(Mg + 1616);
            a0 -= mq[5][0] * x[20]; b0 -= mq[5][0] * y[20]; a1 -= mq[5][1] * x[21]; b1 -= mq[5][1] * y[21]; a0 -= mq[5][2] * x[22]; b0 -= mq[5][2] * y[22]; a1 -= mq[5][3] * x[23]; b1 -= mq[5][3] * y[23]; x[24] = a0 + a1; y[24] = b0 + b1; up[3072] = x[24]; wp[3072] = f2bf(-y[24]); mq[5] = *(const LAS f32x4*)(Mg + 1620);
            { const float br = betg[25]; a0 = bf2f(*(const LAS bf16_t*)(lg + P5_VS + 6800 + c * 2)) * br; b0 = bf2f(*(const LAS bf16_t*)(lg + P5_KS + 6800 + c * 2)) * br * __expf(decg[25]); a1 = 0.f; b1 = 0.f; } a0 -= mq[0][0] * x[0]; b0 -= mq[0][0] * y[0]; a1 -= mq[0][1] * x[1]; b1 -= mq[0][1] * y[1]; a0 -= mq[0][2] * x[2]; b0 -= mq[0][2] * y[2]; a1 -= mq[0][3] * x[3]; b1 -= mq[0][3] * y[3]; mq[0] = *(const LAS f32x4*)(Mg + 1624);
            a0 -= mq[1][0] * x[4]; b0 -= mq[1][0] * y[4]; a1 -= mq[1][1] * x[5]; b1 -= mq[1][1] * y[5]; a0 -= mq[1][2] * x[6]; b0 -= mq[1][2] * y[6]; a1 -= mq[1][3] * x[7]; b1 -= mq[1][3] * y[7]; mq[1] = *(const LAS f32x4*)(Mg + 1664);
            a0 -= mq[2][0] * x[8]; b0 -= mq[2][0] * y[8]; a1 -= mq[2][1] * x[9]; b1 -= mq[2][1] * y[9]; a0 -= mq[2][2] * x[10]; b0 -= mq[2][2] * y[10]; a1 -= mq[2][3] * x[11]; b1 -= mq[2][3] * y[11]; mq[2] = *(const LAS f32x4*)(Mg + 1668);
            a0 -= mq[3][0] * x[12]; b0 -= mq[3][0] * y[12]; a1 -= mq[3][1] * x[13]; b1 -= mq[3][1] * y[13]; a0 -= mq[3][2] * x[14]; b0 -= mq[3][2] * y[14]; a1 -= mq[3][3] * x[15]; b1 -= mq[3][3] * y[15]; mq[3] = *(const LAS f32x4*)(Mg + 1672);
            a0 -= mq[4][0] * x[16]; b0 -= mq[4][0] * y[16]; a1 -= mq[4][1] * x[17]; b1 -= mq[4][1] * y[17]; a0 -= mq[4][2] * x[18]; b0 -= mq[4][2] * y[18]; a1 -= mq[4][3] * x[19]; b1 -= mq[4][3] * y[19]; mq[4] = *(const LAS f32x4*)(Mg + 1676);
            a0 -= mq[5][0] * x[20]; b0 -= mq[5][0] * y[20]; a1 -= mq[5][1] * x[21]; b1 -= mq[5][1] * y[21]; a0 -= mq[5][2] * x[22]; b0 -= mq[5][2] * y[22]; a1 -= mq[5][3] * x[23]; b1 -= mq[5][3] * y[23]; mq[5] = *(const LAS f32x4*)(Mg + 1680);
            a0 -= mq[0][0] * x[24]; b0 -= mq[0][0] * y[24]; x[25] = a0 + a1; y[25] = b0 + b1; up[3200] = x[25]; wp[3200] = f2bf(-y[25]); mq[0] = *(const LAS f32x4*)(Mg + 1684);
            { const float br = betg[26]; a0 = bf2f(*(const LAS bf16_t*)(lg + P5_VS + 7072 + c * 2)) * br; b0 = bf2f(*(const LAS bf16_t*)(lg + P5_KS + 7072 + c * 2)) * br * __expf(decg[26]); a1 = 0.f; b1 = 0.f; } a0 -= mq[1][0] * x[0]; b0 -= mq[1][0] * y[0]; a1 -= mq[1][1] * x[1]; b1 -= mq[1][1] * y[1]; a0 -= mq[1][2] * x[2]; b0 -= mq[1][2] * y[2]; a1 -= mq[1][3] * x[3]; b1 -= mq[1][3] * y[3]; mq[1] = *(const LAS f32x4*)(Mg + 1688);
            a0 -= mq[2][0] * x[4]; b0 -= mq[2][0] * y[4]; a1 -= mq[2][1] * x[5]; b1 -= mq[2][1] * y[5]; a0 -= mq[2][2] * x[6]; b0 -= mq[2][2] * y[6]; a1 -= mq[2][3] * x[7]; b1 -= mq[2][3] * y[7]; mq[2] = *(const LAS f32x4*)(Mg + 1728);
            a0 -= mq[3][0] * x[8]; b0 -= mq[3][0] * y[8]; a1 -= mq[3][1] * x[9]; b1 -= mq[3][1] * y[9]; a0 -= mq[3][2] * x[10]; b0 -= mq[3][2] * y[10]; a1 -= mq[3][3] * x[11]; b1 -= mq[3][3] * y[11]; mq[3] = *(const LAS f32x4*)(Mg + 1732);
            a0 -= mq[4][0] * x[12]; b0 -= mq[4][0] * y[12]; a1 -= mq[4][1] * x[13]; b1 -= mq[4][1] * y[13]; a0 -= mq[4][2] * x[14]; b0 -= mq[4][2] * y[14]; a1 -= mq[4][3] * x[15]; b1 -= mq[4][3] * y[15]; mq[4] = *(const LAS f32x4*)(Mg + 1736);
            a0 -= mq[5][0] * x[16]; b0 -= mq[5][0] * y[16]; a1 -= mq[5][1] * x[17]; b1 -= mq[5][1] * y[17]; a0 -= mq[5][2] * x[18]; b0 -= mq[5][2] * y[18]; a1 -= mq[5][3] * x[19]; b1 -= mq[5][3] * y[19]; mq[5] = *(const LAS f32x4*)(Mg + 1740);
            a0 -= mq[0][0] * x[20]; b0 -= mq[0][0] * y[20]; a1 -= mq[0][1] * x[21]; b1 -= mq[0][1] * y[21]; a0 -= mq[0][2] * x[22]; b0 -= mq[0][2] * y[22]; a1 -= mq[0][3] * x[23]; b1 -= mq[0][3] * y[23]; mq[0] = *(const LAS f32x4*)(Mg + 1744);
            a0 -= mq[1][0] * x[24]; b0 -= mq[1][0] * y[24]; a1 -= mq[1][1] * x[25]; b1 -= mq[1][1] * y[25]; x[26] = a0 + a1; y[26] = b0 + b1; up[3328] = x[26]; wp[3328] = f2bf(-y[26]); mq[1] = *(const LAS f32x4*)(Mg + 1748);
            { const float br = betg[27]; a0 = bf2f(*(const LAS bf16_t*)(lg + P5_VS + 7344 + c * 2)) * br; b0 = bf2f(*(const LAS bf16_t*)(lg + P5_KS + 7344 + c * 2)) * br * __expf(decg[27]); a1 = 0.f; b1 = 0.f; } a0 -= mq[2][0] * x[0]; b0 -= mq[2][0] * y[0]; a1 -= mq[2][1] * x[1]; b1 -= mq[2][1] * y[1]; a0 -= mq[2][2] * x[2]; b0 -= mq[2][2] * y[2]; a1 -= mq[2][3] * x[3]; b1 -= mq[2][3] * y[3]; mq[2] = *(const LAS f32x4*)(Mg + 1752);
            a0 -= mq[3][0] * x[4]; b0 -= mq[3][0] * y[4]; a1 -= mq[3][1] * x[5]; b1 -= mq[3][1] * y[5]; a0 -= mq[3][2] * x[6]; b0 -= mq[3][2] * y[6]; a1 -= mq[3][3] * x[7]; b1 -= mq[3][3] * y[7]; mq[3] = *(const LAS f32x4*)(Mg + 1792);
            a0 -= mq[4][0] * x[8]; b0 -= mq[4][0] * y[8]; a1 -= mq[4][1] * x[9]; b1 -= mq[4][1] * y[9]; a0 -= mq[4][2] * x[10]; b0 -= mq[4][2] * y[10]; a1 -= mq[4][3] * x[11]; b1 -= mq[4][3] * y[11]; mq[4] = *(const LAS f32x4*)(Mg + 1796);
            a0 -= mq[5][0] * x[12]; b0 -= mq[5][0] * y[12]; a1 -= mq[5][1] * x[13]; b1 -= mq[5][1] * y[13]; a0 -= mq[5][2] * x[14]; b0 -= mq[5][2] * y[14]; a1 -= mq[5][3] * x[15]; b1 -= mq[5][3] * y[15]; mq[5] = *(const LAS f32x4*)(Mg + 1800);
            a0 -= mq[0][0] * x[16]; b0 -= mq[0][0] * y[16]; a1 -= mq[0][1] * x[17]; b1 -= mq[0][1] * y[17]; a0 -= mq[0][2] * x[18]; b0 -= mq[0][2] * y[18]; a1 -= mq[0][3] * x[19]; b1 -= mq[0][3] * y[19]; mq[0] = *(const LAS f32x4*)(Mg + 1804);
            a0 -= mq[1][0] * x[20]; b0 -= mq[1][0] * y[20]; a1 -= mq[1][1] * x[21]; b1 -= mq[1][1] * y[21]; a0 -= mq[1][2] * x[22]; b0 -= mq[1][2] * y[22]; a1 -= mq[1][3] * x[23]; b1 -= mq[1][3] * y[23]; mq[1] = *(const LAS f32x4*)(Mg + 1808);
            a0 -= mq[2][0] * x[24]; b0 -= mq[2][0] * y[24]; a1 -= mq[2][1] * x[25]; b1 -= mq[2][1] * y[25]; a0 -= mq[2][2] * x[26]; b0 -= mq[2][2] * y[26]; x[27] = a0 + a1; y[27] = b0 + b1; up[3456] = x[27]; wp[3456] = f2bf(-y[27]); mq[2] = *(const LAS f32x4*)(Mg + 1812);
            { const float br = betg[28]; a0 = bf2f(*(const LAS bf16_t*)(lg + P5_VS + 7616 + c * 2)) * br; b0 = bf2f(*(const LAS bf16_t*)(lg + P5_KS + 7616 + c * 2)) * br * __expf(decg[28]); a1 = 0.f; b1 = 0.f; } a0 -= mq[3][0] * x[0]; b0 -= mq[3][0] * y[0]; a1 -= mq[3][1] * x[1]; b1 -= mq[3][1] * y[1]; a0 -= mq[3][2] * x[2]; b0 -= mq[3][2] * y[2]; a1 -= mq[3][3] * x[3]; b1 -= mq[3][3] * y[3]; mq[3] = *(const LAS f32x4*)(Mg + 1816);
            a0 -= mq[4][0] * x[4]; b0 -= mq[4][0] * y[4]; a1 -= mq[4][1] * x[5]; b1 -= mq[4][1] * y[5]; a0 -= mq[4][2] * x[6]; b0 -= mq[4][2] * y[6]; a1 -= mq[4][3] * x[7]; b1 -= mq[4][3] * y[7]; mq[4] = *(const LAS f32x4*)(Mg + 1856);
            a0 -= mq[5][0] * x[8]; b0 -= mq[5][0] * y[8]; a1 -= mq[5][1] * x[9]; b1 -= mq[5][1] * y[9]; a0 -= mq[5][2] * x[10]; b0 -= mq[5][2] * y[10]; a1 -= mq[5][3] * x[11]; b1 -= mq[5][3] * y[11]; mq[5] = *(const LAS f32x4*)(Mg + 1860);
            a0 -= mq[0][0] * x[12]; b0 -= mq[0][0] * y[12]; a1 -= mq[0][1] * x[13]; b1 -= mq[0][1] * y[13]; a0 -= mq[0][2] * x[14]; b0 -= mq[0][2] * y[14]; a1 -= mq[0][3] * x[15]; b1 -= mq[0][3] * y[15]; mq[0] = *(const LAS f32x4*)(Mg + 1864);
            a0 -= mq[1][0] * x[16]; b0 -= mq[1][0] * y[16]; a1 -= mq[1][1] * x[17]; b1 -= mq[1][1] * y[17]; a0 -= mq[1][2] * x[18]; b0 -= mq[1][2] * y[18]; a1 -= mq[1][3] * x[19]; b1 -= mq[1][3] * y[19]; mq[1] = *(const LAS f32x4*)(Mg + 1868);
            a0 -= mq[2][0] * x[20]; b0 -= mq[2][0] * y[20]; a1 -= mq[2][1] * x[21]; b1 -= mq[2][1] * y[21]; a0 -= mq[2][2] * x[22]; b0 -= mq[2][2] * y[22]; a1 -= mq[2][3] * x[23]; b1 -= mq[2][3] * y[23]; mq[2] = *(const LAS f32x4*)(Mg + 1872);
            a0 -= mq[3][0] * x[24]; b0 -= mq[3][0] * y[24]; a1 -= mq[3][1] * x[25]; b1 -= mq[3][1] * y[25]; a0 -= mq[3][2] * x[26]; b0 -= mq[3][2] * y[26]; a1 -= mq[3][3] * x[27]; b1 -= mq[3][3] * y[27]; x[28] = a0 + a1; y[28] = b0 + b1; up[3584] = x[28]; wp[3584] = f2bf(-y[28]); mq[3] = *(const LAS f32x4*)(Mg + 1876);
            { const float br = betg[29]; a0 = bf2f(*(const LAS bf16_t*)(lg + P5_VS + 7888 + c * 2)) * br; b0 = bf2f(*(const LAS bf16_t*)(lg + P5_KS + 7888 + c * 2)) * br * __expf(decg[29]); a1 = 0.f; b1 = 0.f; } a0 -= mq[4][0] * x[0]; b0 -= mq[4][0] * y[0]; a1 -= mq[4][1] * x[1]; b1 -= mq[4][1] * y[1]; a0 -= mq[4][2] * x[2]; b0 -= mq[4][2] * y[2]; a1 -= mq[4][3] * x[3]; b1 -= mq[4][3] * y[3]; mq[4] = *(const LAS f32x4*)(Mg + 1880);
            a0 -= mq[5][0] * x[4]; b0 -= mq[5][0] * y[4]; a1 -= mq[5][1] * x[5]; b1 -= mq[5][1] * y[5]; a0 -= mq[5][2] * x[6]; b0 -= mq[5][2] * y[6]; a1 -= mq[5][3] * x[7]; b1 -= mq[5][3] * y[7]; mq[5] = *(const LAS f32x4*)(Mg + 1884);
            a0 -= mq[0][0] * x[8]; b0 -= mq[0][0] * y[8]; a1 -= mq[0][1] * x[9]; b1 -= mq[0][1] * y[9]; a0 -= mq[0][2] * x[10]; b0 -= mq[0][2] * y[10]; a1 -= mq[0][3] * x[11]; b1 -= mq[0][3] * y[11]; mq[0] = *(const LAS f32x4*)(Mg + 1920);
            a0 -= mq[1][0] * x[12]; b0 -= mq[1][0] * y[12]; a1 -= mq[1][1] * x[13]; b1 -= mq[1][1] * y[13]; a0 -= mq[1][2] * x[14]; b0 -= mq[1][2] * y[14]; a1 -= mq[1][3] * x[15]; b1 -= mq[1][3] * y[15]; mq[1] = *(const LAS f32x4*)(Mg + 1924);
            a0 -= mq[2][0] * x[16]; b0 -= mq[2][0] * y[16]; a1 -= mq[2][1] * x[17]; b1 -= mq[2][1] * y[17]; a0 -= mq[2][2] * x[18]; b0 -= mq[2][2] * y[18]; a1 -= mq[2][3] * x[19]; b1 -= mq[2][3] * y[19]; mq[2] = *(const LAS f32x4*)(Mg + 1928);
            a0 -= mq[3][0] * x[20]; b0 -= mq[3][0] * y[20]; a1 -= mq[3][1] * x[21]; b1 -= mq[3][1] * y[21]; a0 -= mq[3][2] * x[22]; b0 -= mq[3][2] * y[22]; a1 -= mq[3][3] * x[23]; b1 -= mq[3][3] * y[23]; mq[3] = *(const LAS f32x4*)(Mg + 1932);
            a0 -= mq[4][0] * x[24]; b0 -= mq[4][0] * y[24]; a1 -= mq[4][1] * x[25]; b1 -= mq[4][1] * y[25]; a0 -= mq[4][2] * x[26]; b0 -= mq[4][2] * y[26]; a1 -= mq[4][3] * x[27]; b1 -= mq[4][3] * y[27]; mq[4] = *(const LAS f32x4*)(Mg + 1936);
            a0 -= mq[5][0] * x[28]; b0 -= mq[5][0] * y[28]; x[29] = a0 + a1; y[29] = b0 + b1; up[3712] = x[29]; wp[3712] = f2bf(-y[29]); mq[5] = *(const LAS f32x4*)(Mg + 1940);
            { const float br = betg[30]; a0 = bf2f(*(const LAS bf16_t*)(lg + P5_VS + 8160 + c * 2)) * br; b0 = bf2f(*(const LAS bf16_t*)(lg + P5_KS + 8160 + c * 2)) * br * __expf(decg[30]); a1 = 0.f; b1 = 0.f; } a0 -= mq[0][0] * x[0]; b0 -= mq[0][0] * y[0]; a1 -= mq[0][1] * x[1]; b1 -= mq[0][1] * y[1]; a0 -= mq[0][2] * x[2]; b0 -= mq[0][2] * y[2]; a1 -= mq[0][3] * x[3]; b1 -= mq[0][3] * y[3]; mq[0] = *(const LAS f32x4*)(Mg + 1944);
            a0 -= mq[1][0] * x[4]; b0 -= mq[1][0] * y[4]; a1 -= mq[1][1] * x[5]; b1 -= mq[1][1] * y[5]; a0 -= mq[1][2] * x[6]; b0 -= mq[1][2] * y[6]; a1 -= mq[1][3] * x[7]; b1 -= mq[1][3] * y[7]; mq[1] = *(const LAS f32x4*)(Mg + 1948);
            a0 -= mq[2][0] * x[8]; b0 -= mq[2][0] * y[8]; a1 -= mq[2][1] * x[9]; b1 -= mq[2][1] * y[9]; a0 -= mq[2][2] * x[10]; b0 -= mq[2][2] * y[10]; a1 -= mq[2][3] * x[11]; b1 -= mq[2][3] * y[11]; mq[2] = *(const LAS f32x4*)(Mg + 1984);
            a0 -= mq[3][0] * x[12]; b0 -= mq[3][0] * y[12]; a1 -= mq[3][1] * x[13]; b1 -= mq[3][1] * y[13]; a0 -= mq[3][2] * x[14]; b0 -= mq[3][2] * y[14]; a1 -= mq[3][3] * x[15]; b1 -= mq[3][3] * y[15]; mq[3] = *(const LAS f32x4*)(Mg + 1988);
            a0 -= mq[4][0] * x[16]; b0 -= mq[4][0] * y[16]; a1 -= mq[4][1] * x[17]; b1 -= mq[4][1] * y[17]; a0 -= mq[4][2] * x[18]; b0 -= mq[4][2] * y[18]; a1 -= mq[4][3] * x[19]; b1 -= mq[4][3] * y[19]; mq[4] = *(const LAS f32x4*)(Mg + 1992);
            a0 -= mq[5][0] * x[20]; b0 -= mq[5][0] * y[20]; a1 -= mq[5][1] * x[21]; b1 -= mq[5][1] * y[21]; a0 -= mq[5][2] * x[22]; b0 -= mq[5][2] * y[22]; a1 -= mq[5][3] * x[23]; b1 -= mq[5][3] * y[23]; mq[5] = *(const LAS f32x4*)(Mg + 1996);
            a0 -= mq[0][0] * x[24]; b0 -= mq[0][0] * y[24]; a1 -= mq[0][1] * x[25]; b1 -= mq[0][1] * y[25]; a0 -= mq[0][2] * x[26]; b0 -= mq[0][2] * y[26]; a1 -= mq[0][3] * x[27]; b1 -= mq[0][3] * y[27]; mq[0] = *(const LAS f32x4*)(Mg + 2000);
            a0 -= mq[1][0] * x[28]; b0 -= mq[1][0] * y[28]; a1 -= mq[1][1] * x[29]; b1 -= mq[1][1] * y[29]; x[30] = a0 + a1; y[30] = b0 + b1; up[3840] = x[30]; wp[3840] = f2bf(-y[30]); mq[1] = *(const LAS f32x4*)(Mg + 2004);
            { const float br = betg[31]; a0 = bf2f(*(const LAS bf16_t*)(lg + P5_VS + 8432 + c * 2)) * br; b0 = bf2f(*(const LAS bf16_t*)(lg + P5_KS + 8432 + c * 2)) * br * __expf(decg[31]); a1 = 0.f; b1 = 0.f; } a0 -= mq[2][0] * x[0]; b0 -= mq[2][0] * y[0]; a1 -= mq[2][1] * x[1]; b1 -= mq[2][1] * y[1]; a0 -= mq[2][2] * x[2]; b0 -= mq[2][2] * y[2]; a1 -= mq[2][3] * x[3]; b1 -= mq[2][3] * y[3]; mq[2] = *(const LAS f32x4*)(Mg + 2008);
            a0 -= mq[3][0] * x[4]; b0 -= mq[3][0] * y[4]; a1 -= mq[3][1] * x[5]; b1 -= mq[3][1] * y[5]; a0 -= mq[3][2] * x[6]; b0 -= mq[3][2] * y[6]; a1 -= mq[3][3] * x[7]; b1 -= mq[3][3] * y[7]; mq[3] = *(const LAS f32x4*)(Mg + 2012);
            a0 -= mq[4][0] * x[8]; b0 -= mq[4][0] * y[8]; a1 -= mq[4][1] * x[9]; b1 -= mq[4][1] * y[9]; a0 -= mq[4][2] * x[10]; b0 -= mq[4][2] * y[10]; a1 -= mq[4][3] * x[11]; b1 -= mq[4][3] * y[11]; mq[4] = *(const LAS f32x4*)(Mg + 2048);
            a0 -= mq[5][0] * x[12]; b0 -= mq[5][0] * y[12]; a1 -= mq[5][1] * x[13]; b1 -= mq[5][1] * y[13]; a0 -= mq[5][2] * x[14]; b0 -= mq[5][2] * y[14]; a1 -= mq[5][3] * x[15]; b1 -= mq[5][3] * y[15]; mq[5] = *(const LAS f32x4*)(Mg + 2052);
            a0 -= mq[0][0] * x[16]; b0 -= mq[0][0] * y[16]; a1 -= mq[0][1] * x[17]; b1 -= mq[0][1] * y[17]; a0 -= mq[0][2] * x[18]; b0 -= mq[0][2] * y[18]; a1 -= mq[0][3] * x[19]; b1 -= mq[0][3] * y[19]; mq[0] = *(const LAS f32x4*)(Mg + 2056);
            a0 -= mq[1][0] * x[20]; b0 -= mq[1][0] * y[20]; a1 -= mq[1][1] * x[21]; b1 -= mq[1][1] * y[21]; a0 -= mq[1][2] * x[22]; b0 -= mq[1][2] * y[22]; a1 -= mq[1][3] * x[23]; b1 -= mq[1][3] * y[23]; mq[1] = *(const LAS f32x4*)(Mg + 2060);
            a0 -= mq[2][0] * x[24]; b0 -= mq[2][0] * y[24]; a1 -= mq[2][1] * x[25]; b1 -= mq[2][1] * y[25]; a0 -= mq[2][2] * x[26]; b0 -= mq[2][2] * y[26]; a1 -= mq[2][3] * x[27]; b1 -= mq[2][3] * y[27]; mq[2] = *(const LAS f32x4*)(Mg + 2064);
            a0 -= mq[3][0] * x[28]; b0 -= mq[3][0] * y[28]; a1 -= mq[3][1] * x[29]; b1 -= mq[3][1] * y[29]; a0 -= mq[3][2] * x[30]; b0 -= mq[3][2] * y[30]; x[31] = a0 + a1; y[31] = b0 + b1; up[3968] = x[31]; wp[3968] = f2bf(-y[31]); mq[3] = *(const LAS f32x4*)(Mg + 2068);
            { const float br = betg[32]; a0 = bf2f(*(const LAS bf16_t*)(lg + P5_VS + 8704 + c * 2)) * br; b0 = bf2f(*(const LAS bf16_t*)(lg + P5_KS + 8704 + c * 2)) * br * __expf(decg[32]); a1 = 0.f; b1 = 0.f; } a0 -= mq[4][0] * x[0]; b0 -= mq[4][0] * y[0]; a1 -= mq[4][1] * x[1]; b1 -= mq[4][1] * y[1]; a0 -= mq[4][2] * x[2]; b0 -= mq[4][2] * y[2]; a1 -= mq[4][3] * x[3]; b1 -= mq[4][3] * y[3]; mq[4] = *(const LAS f32x4*)(Mg + 2072);
            a0 -= mq[5][0] * x[4]; b0 -= mq[5][0] * y[4]; a1 -= mq[5][1] * x[5]; b1 -= mq[5][1] * y[5]; a0 -= mq[5][2] * x[6]; b0 -= mq[5][2] * y[6]; a1 -= mq[5][3] * x[7]; b1 -= mq[5][3] * y[7]; mq[5] = *(const LAS f32x4*)(Mg + 2076);
            a0 -= mq[0][0] * x[8]; b0 -= mq[0][0] * y[8]; a1 -= mq[0][1] * x[9]; b1 -= mq[0][1] * y[9]; a0 -= mq[0][2] * x[10]; b0 -= mq[0][2] * y[10]; a1 -= mq[0][3] * x[11]; b1 -= mq[0][3] * y[11]; mq[0] = *(const LAS f32x4*)(Mg + 2112);
            a0 -= mq[1][0] * x[12]; b0 -= mq[1][0] * y[12]; a1 -= mq[1][1] * x[13]; b1 -= mq[1][1] * y[13]; a0 -= mq[1][2] * x[14]; b0 -= mq[1][2] * y[14]; a1 -= mq[1][3] * x[15]; b1 -= mq[1][3] * y[15]; mq[1] = *(const LAS f32x4*)(Mg + 2116);
            a0 -= mq[2][0] * x[16]; b0 -= mq[2][0] * y[16]; a1 -= mq[2][1] * x[17]; b1 -= mq[2][1] * y[17]; a0 -= mq[2][2] * x[18]; b0 -= mq[2][2] * y[18]; a1 -= mq[2][3] * x[19]; b1 -= mq[2][3] * y[19]; mq[2] = *(const LAS f32x4*)(Mg + 2120);
            a0 -= mq[3][0] * x[20]; b0 -= mq[3][0] * y[20]; a1 -= mq[3][1] * x[21]; b1 -= mq[3][1] * y[21]; a0 -= mq[3][2] * x[22]; b0 -= mq[3][2] * y[22]; a1 -= mq[3][3] * x[23]; b1 -= mq[3][3] * y[23]; mq[3] = *(const LAS f32x4*)(Mg + 2124);
            a0 -= mq[4][0] * x[24]; b0 -= mq[4][0] * y[24]; a1 -= mq[4][1] * x[25]; b1 -= mq[4][1] * y[25]; a0 -= mq[4][2] * x[26]; b0 -= mq[4][2] * y[26]; a1 -= mq[4][3] * x[27]; b1 -= mq[4][3] * y[27]; mq[4] = *(const LAS f32x4*)(Mg + 2128);
            a0 -= mq[5][0] * x[28]; b0 -= mq[5][0] * y[28]; a1 -= mq[5][1] * x[29]; b1 -= mq[5][1] * y[29]; a0 -= mq[5][2] * x[30]; b0 -= mq[5][2] * y[30]; a1 -= mq[5][3] * x[31]; b1 -= mq[5][3] * y[31]; x[32] = a0 + a1; y[32] = b0 + b1; up[4096] = x[32]; wp[4096] = f2bf(-y[32]); mq[5] = *(const LAS f32x4*)(Mg + 2132);
            { const float br = betg[33]; a0 = bf2f(*(const LAS bf16_t*)(lg + P5_VS + 8976 + c * 2)) * br; b0 = bf2f(*(const LAS bf16_t*)(lg + P5_KS + 8976 + c * 2)) * br * __expf(decg[33]); a1 = 0.f; b1 = 0.f; } a0 -= mq[0][0] * x[0]; b0 -= mq[0][0] * y[0]; a1 -= mq[0][1] * x[1]; b1 -= mq[0][1] * y[1]; a0 -= mq[0][2] * x[2]; b0 -= mq[0][2] * y[2]; a1 -= mq[0][3] * x[3]; b1 -= mq[0][3] * y[3]; mq[0] = *(const LAS f32x4*)(Mg + 2136);
            a0 -= mq[1][0] * x[4]; b0 -= mq[1][0] * y[4]; a1 -= mq[1][1] * x[5]; b1 -= mq[1][1] * y[5]; a0 -= mq[1][2] * x[6]; b0 -= mq[1][2] * y[6]; a1 -= mq[1][3] * x[7]; b1 -= mq[1][3] * y[7]; mq[1] = *(const LAS f32x4*)(Mg + 2140);
            a0 -= mq[2][0] * x[8]; b0 -= mq[2][0] * y[8]; a1 -= mq[2][1] * x[9]; b1 -= mq[2][1] * y[9]; a0 -= mq[2][2] * x[10]; b0 -= mq[2][2] * y[10]; a1 -= mq[2][3] * x[11]; b1 -= mq[2][3] * y[11]; mq[2] = *(const LAS f32x4*)(Mg + 2144);
            a0 -= mq[3][0] * x[12]; b0 -= mq[3][0] * y[12]; a1 -= mq[3][1] * x[13]; b1 -= mq[3][1] * y[13]; a0 -= mq[3][2] * x[14]; b0 -= mq[3][2] * y[14]; a1 -= mq[3][3] * x[15]; b1 -= mq[3][3] * y[15]; mq[3] = *(const LAS f32x4*)(Mg + 2176);
            a0 -= mq[4][0] * x[16]; b0 -= mq[4][0] * y[16]; a1 -= mq[4][1] * x[17]; b1 -= mq[4][1] * y[17]; a0 -= mq[4][2] * x[18]; b0 -= mq[4][2] * y[18]; a1 -= mq[4][3] * x[19]; b1 -= mq[4][3] * y[19]; mq[4] = *(const LAS f32x4*)(Mg + 2180);
            a0 -= mq[5][0] * x[20]; b0 -= mq[5][0] * y[20]; a1 -= mq[5][1] * x[21]; b1 -= mq[5][1] * y[21]; a0 -= mq[5][2] * x[22]; b0 -= mq[5][2] * y[22]; a1 -= mq[5][3] * x[23]; b1 -= mq[5][3] * y[23]; mq[5] = *(const LAS f32x4*)(Mg + 2184);
            a0 -= mq[0][0] * x[24]; b0 -= mq[0][0] * y[24]; a1 -= mq[0][1] * x[25]; b1 -= mq[0][1] * y[25]; a0 -= mq[0][2] * x[26]; b0 -= mq[0][2] * y[26]; a1 -= mq[0][3] * x[27]; b1 -= mq[0][3] * y[27]; mq[0] = *(const LAS f32x4*)(Mg + 2188);
            a0 -= mq[1][0] * x[28]; b0 -= mq[1][0] * y[28]; a1 -= mq[1][1] * x[29]; b1 -= mq[1][1] * y[29]; a0 -= mq[1][2] * x[30]; b0 -= mq[1][2] * y[30]; a1 -= mq[1][3] * x[31]; b1 -= mq[1][3] * y[31]; mq[1] = *(const LAS f32x4*)(Mg + 2192);
            a0 -= mq[2][0] * x[32]; b0 -= mq[2][0] * y[32]; x[33] = a0 + a1; y[33] = b0 + b1; up[4224] = x[33]; wp[4224] = f2bf(-y[33]); mq[2] = *(const LAS f32x4*)(Mg + 2196);
            { const float br = betg[34]; a0 = bf2f(*(const LAS bf16_t*)(lg + P5_VS + 9248 + c * 2)) * br; b0 = bf2f(*(const LAS bf16_t*)(lg + P5_KS + 9248 + c * 2)) * br * __expf(decg[34]); a1 = 0.f; b1 = 0.f; } a0 -= mq[3][0] * x[0]; b0 -= mq[3][0] * y[0]; a1 -= mq[3][1] * x[1]; b1 -= mq[3][1] * y[1]; a0 -= mq[3][2] * x[2]; b0 -= mq[3][2] * y[2]; a1 -= mq[3][3] * x[3]; b1 -= mq[3][3] * y[3]; mq[3] = *(const LAS f32x4*)(Mg + 2200);
            a0 -= mq[4][0] * x[4]; b0 -= mq[4][0] * y[4]; a1 -= mq[4][1] * x[5]; b1 -= mq[4][1] * y[5]; a0 -= mq[4][2] * x[6]; b0 -= mq[4][2] * y[6]; a1 -= mq[4][3] * x[7]; b1 -= mq[4][3] * y[7]; mq[4] = *(const LAS f32x4*)(Mg + 2204);
            a0 -= mq[5][0] * x[8]; b0 -= mq[5][0] * y[8]; a1 -= mq[5][1] * x[9]; b1 -= mq[5][1] * y[9]; a0 -= mq[5][2] * x[10]; b0 -= mq[5][2] * y[10]; a1 -= mq[5][3] * x[11]; b1 -= mq[5][3] * y[11]; mq[5] = *(const LAS f32x4*)(Mg + 2208);
            a0 -= mq[0][0] * x[12]; b0 -= mq[0][0] * y[12]; a1 -= mq[0][1] * x[13]; b1 -= mq[0][1] * y[13]; a0 -= mq[0][2] * x[14]; b0 -= mq[0][2] * y[14]; a1 -= mq[0][3] * x[15]; b1 -= mq[0][3] * y[15]; mq[0] = *(const LAS f32x4*)(Mg + 2240);
            a0 -= mq[1][0] * x[16]; b0 -= mq[1][0] * y[16]; a1 -= mq[1][1] * x[17]; b1 -= mq[1][1] * y[17]; a0 -= mq[1][2] * x[18]; b0 -= mq[1][2] * y[18]; a1 -= mq[1][3] * x[19]; b1 -= mq[1][3] * y[19]; mq[1] = *(const LAS f32x4*)(Mg + 2244);
            a0 -= mq[2][0] * x[20]; b0 -= mq[2][0] * y[20]; a1 -= mq[2][1] * x[21]; b1 -= mq[2][1] * y[21]; a0 -= mq[2][2] * x[22]; b0 -= mq[2][2] * y[22]; a1 -= mq[2][3] * x[23]; b1 -= mq[2][3] * y[23]; mq[2] = *(const LAS f32x4*)(Mg + 2248);
            a0 -= mq[3][0] * x[24]; b0 -= mq[3][0] * y[24]; a1 -= mq[3][1] * x[25]; b1 -= mq[3][1] * y[25]; a0 -= mq[3][2] * x[26]; b0 -= mq[3][2] * y[26]; a1 -= mq[3][3] * x[27]; b1 -= mq[3][3] * y[27]; mq[3] = *(const LAS f32x4*)(Mg + 2252);
            a0 -= mq[4][0] * x[28]; b0 -= mq[4][0] * y[28]; a1 -= mq[4][1] * x[29]; b1 -= mq[4][1] * y[29]; a0 -= mq[4][2] * x[30]; b0 -= mq[4][2] * y[30]; a1 -= mq[4][3] * x[31]; b1 -= mq[4][3] * y[31]; mq[4] = *(const LAS f32x4*)(Mg + 2256);
            a0 -= mq[5][0] * x[32]; b0 -= mq[5][0] * y[32]; a1 -= mq[5][1] * x[33]; b1 -= mq[5][1] * y[33]; x[34] = a0 + a1; y[34] = b0 + b1; up[4352] = x[34]; wp[4352] = f2bf(-y[34]); mq[5] = *(const LAS f32x4*)(Mg + 2260);
            { const float br = betg[35]; a0 = bf2f(*(const LAS bf16_t*)(lg + P5_VS + 9520 + c * 2)) * br; b0 = bf2f(*(const LAS bf16_t*)(lg + P5_KS + 9520 + c * 2)) * br * __expf(decg[35]); a1 = 0.f; b1 = 0.f; } a0 -= mq[0][0] * x[0]; b0 -= mq[0][0] * y[0]; a1 -= mq[0][1] * x[1]; b1 -= mq[0][1] * y[1]; a0 -= mq[0][2] * x[2]; b0 -= mq[0][2] * y[2]; a1 -= mq[0][3] * x[3]; b1 -= mq[0][3] * y[3]; mq[0] = *(const LAS f32x4*)(Mg + 2264);
            a0 -= mq[1][0] * x[4]; b0 -= mq[1][0] * y[4]; a1 -= mq[1][1] * x[5]; b1 -= mq[1][1] * y[5]; a0 -= mq[1][2] * x[6]; b0 -= mq[1][2] * y[6]; a1 -= mq[1][3] * x[7]; b1 -= mq[1][3] * y[7]; mq[1] = *(const LAS f32x4*)(Mg + 2268);
            a0 -= mq[2][0] * x[8]; b0 -= mq[2][0] * y[8]; a1 -= mq[2][1] * x[9]; b1 -= mq[2][1] * y[9]; a0 -= mq[2][2] * x[10]; b0 -= mq[2][2] * y[10]; a1 -= mq[2][3] * x[11]; b1 -= mq[2][3] * y[11]; mq[2] = *(const LAS f32x4*)(Mg + 2272);
            a0 -= mq[3][0] * x[12]; b0 -= mq[3][0] * y[12]; a1 -= mq[3][1] * x[13]; b1 -= mq[3][1] * y[13]; a0 -= mq[3][2] * x[14]; b0 -= mq[3][2] * y[14]; a1 -= mq[3][3] * x[15]; b1 -= mq[3][3] * y[15]; mq[3] = *(const LAS f32x4*)(Mg + 2304);
            a0 -= mq[4][0] * x[16]; b0 -= mq[4][0] * y[16]; a1 -= mq[4][1] * x[17]; b1 -= mq[4][1] * y[17]; a0 -= mq[4][2] * x[18]; b0 -= mq[4][2] * y[18]; a1 -= mq[4][3] * x[19]; b1 -= mq[4][3] * y[19]; mq[4] = *(const LAS f32x4*)(Mg + 2308);
            a0 -= mq[5][0] * x[20]; b0 -= mq[5][0] * y[20]; a1 -= mq[5][1] * x[21]; b1 -= mq[5][1] * y[21]; a0 -= mq[5][2] * x[22]; b0 -= mq[5][2] * y[22]; a1 -= mq[5][3] * x[23]; b1 -= mq[5][3] * y[23]; mq[5] = *(const LAS f32x4*)(Mg + 2312);
            a0 -= mq[0][0] * x[24]; b0 -= mq[0][0] * y[24]; a1 -= mq[0][1] * x[25]; b1 -= mq[0][1] * y[25]; a0 -= mq[0][2] * x[26]; b0 -= mq[0][2] * y[26]; a1 -= mq[0][3] * x[27]; b1 -= mq[0][3] * y[27]; mq[0] = *(const LAS f32x4*)(Mg + 2316);
            a0 -= mq[1][0] * x[28]; b0 -= mq[1][0] * y[28]; a1 -= mq[1][1] * x[29]; b1 -= mq[1][1] * y[29]; a0 -= mq[1][2] * x[30]; b0 -= mq[1][2] * y[30]; a1 -= mq[1][3] * x[31]; b1 -= mq[1][3] * y[31]; mq[1] = *(const LAS f32x4*)(Mg + 2320);
            a0 -= mq[2][0] * x[32]; b0 -= mq[2][0] * y[32]; a1 -= mq[2][1] * x[33]; b1 -= mq[2][1] * y[33]; a0 -= mq[2][2] * x[34]; b0 -= mq[2][2] * y[34]; x[35] = a0 + a1; y[35] = b0 + b1; up[4480] = x[35]; wp[4480] = f2bf(-y[35]); mq[2] = *(const LAS f32x4*)(Mg + 2324);
            { const float br = betg[36]; a0 = bf2f(*(const LAS bf16_t*)(lg + P5_VS + 9792 + c * 2)) * br; b0 = bf2f(*(const LAS bf16_t*)(lg + P5_KS + 9792 + c * 2)) * br * __expf(decg[36]); a1 = 0.f; b1 = 0.f; } a0 -= mq[3][0] * x[0]; b0 -= mq[3][0] * y[0]; a1 -= mq[3][1] * x[1]; b1 -= mq[3][1] * y[1]; a0 -= mq[3][2] * x[2]; b0 -= mq[3][2] * y[2]; a1 -= mq[3][3] * x[3]; b1 -= mq[3][3] * y[3]; mq[3] = *(const LAS f32x4*)(Mg + 2328);
            a0 -= mq[4][0] * x[4]; b0 -= mq[4][0] * y[4]; a1 -= mq[4][1] * x[5]; b1 -= mq[4][1] * y[5]; a0 -= mq[4][2] * x[6]; b0 -= mq[4][2] * y[6]; a1 -= mq[4][3] * x[7]; b1 -= mq[4][3] * y[7]; mq[4] = *(const LAS f32x4*)(Mg + 2332);
            a0 -= mq[5][0] * x[8]; b0 -= mq[5][0] * y[8]; a1 -= mq[5][1] * x[9]; b1 -= mq[5][1] * y[9]; a0 -= mq[5][2] * x[10]; b0 -= mq[5][2] * y[10]; a1 -= mq[5][3] * x[11]; b1 -= mq[5][3] * y[11]; mq[5] = *(const LAS f32x4*)(Mg + 2336);
            a0 -= mq[0][0] * x[12]; b0 -= mq[0][0] * y[12]; a1 -= mq[0][1] * x[13]; b1 -= mq[0][1] * y[13]; a0 -= mq[0][2] * x[14]; b0 -= mq[0][2] * y[14]; a1 -= mq[0][3] * x[15]; b1 -= mq[0][3] * y[15]; mq[0] = *(const LAS f32x4*)(Mg + 2368);
            a0 -= mq[1][0] * x[16]; b0 -= mq[1][0] * y[16]; a1 -= mq[1][1] * x[17]; b1 -= mq[1][1] * y[17]; a0 -= mq[1][2] * x[18]; b0 -= mq[1][2] * y[18]; a1 -= mq[1][3] * x[19]; b1 -= mq[1][3] * y[19]; mq[1] = *(const LAS f32x4*)(Mg + 2372);
            a0 -= mq[2][0] * x[20]; b0 -= mq[2][0] * y[20]; a1 -= mq[2][1] * x[21]; b1 -= mq[2][1] * y[21]; a0 -= mq[2][2] * x[22]; b0 -= mq[2][2] * y[22]; a1 -= mq[2][3] * x[23]; b1 -= mq[2][3] * y[23]; mq[2] = *(const LAS f32x4*)(Mg + 2376);
            a0 -= mq[3][0] * x[24]; b0 -= mq[3][0] * y[24]; a1 -= mq[3][1] * x[25]; b1 -= mq[3][1] * y[25]; a0 -= mq[3][2] * x[26]; b0 -= mq[3][2] * y[26]; a1 -= mq[3][3] * x[27]; b1 -= mq[3][3] * y[27]; mq[3] = *(const LAS f32x4*)(Mg + 2380);
            a0 -= mq[4][0] * x[28]; b0 -= mq[4][0] * y[28]; a1 -= mq[4][1] * x[29]; b1 -= mq[4][1] * y[29]; a0 -= mq[4][2] * x[30]; b0 -= mq[4][2] * y[30]; a1 -= mq[4][3] * x[31]; b1 -= mq[4][3] * y[31]; mq[4] = *(const LAS f32x4*)(Mg + 2384);
            a0 -= mq[5][0] * x[32]; b0 -= mq[5][0] * y[32]; a1 -= mq[5][1] * x[33]; b1 -= mq[5][1] * y[33]; a0 -= mq[5][2] * x[34]; b0 -= mq[5][2] * y[34]; a1 -= mq[5][3] * x[35]; b1 -= mq[5][3] * y[35]; x[36] = a0 + a1; y[36] = b0 + b1; up[4608] = x[36]; wp[4608] = f2bf(-y[36]); mq[5] = *(const LAS f32x4*)(Mg + 2388);
            { const float br = betg[37]; a0 = bf2f(*(const LAS bf16_t*)(lg + P5_VS + 10064 + c * 2)) * br; b0 = bf2f(*(const LAS bf16_t*)(lg + P5_KS + 10064 + c * 2)) * br * __expf(decg[37]); a1 = 0.f; b1 = 0.f; } a0 -= mq[0][0] * x[0]; b0 -= mq[0][0] * y[0]; a1 -= mq[0][1] * x[1]; b1 -= mq[0][1] * y[1]; a0 -= mq[0][2] * x[2]; b0 -= mq[0][2] * y[2]; a1 -= mq[0][3] * x[3]; b1 -= mq[0][3] * y[3]; mq[0] = *(const LAS f32x4*)(Mg + 2392);
            a0 -= mq[1][0] * x[4]; b0 -= mq[1][0] * y[4]; a1 -= mq[1][1] * x[5]; b1 -= mq[1][1] * y[5]; a0 -= mq[1][2] * x[6]; b0 -= mq[1][2] * y[6]; a1 -= mq[1][3] * x[7]; b1 -= mq[1][3] * y[7]; mq[1] = *(const LAS f32x4*)(Mg + 2396);
            a0 -= mq[2][0] * x[8]; b0 -= mq[2][0] * y[8]; a1 -= mq[2][1] * x[9]; b1 -= mq[2][1] * y[9]; a0 -= mq[2][2] * x[10]; b0 -= mq[2][2] * y[10]; a1 -= mq[2][3] * x[11]; b1 -= mq[2][3] * y[11]; mq[2] = *(const LAS f32x4*)(Mg + 2400);
            a0 -= mq[3][0] * x[12]; b0 -= mq[3][0] * y[12]; a1 -= mq[3][1] * x[13]; b1 -= mq[3][1] * y[13]; a0 -= mq[3][2] * x[14]; b0 -= mq[3][2] * y[14]; a1 -= mq[3][3] * x[15]; b1 -= mq[3][3] * y[15]; mq[3] = *(const LAS f32x4*)(Mg + 2404);
            a0 -= mq[4][0] * x[16]; b0 -= mq[4][0] * y[16]; a1 -= mq[4][1] * x[17]; b1 -= mq[4][1] * y[17]; a0 -= mq[4][2] * x[18]; b0 -= mq[4][2] * y[18]; a1 -= mq[4][3] * x[19]; b1 -= mq[4][3] * y[19]; mq[4] = *(const LAS f32x4*)(Mg + 2432);
            a0 -= mq[5][0] * x[20]; b0 -= mq[5][0] * y[20]; a1 -= mq[5][1] * x[21]; b1 -= mq[5][1] * y[21]; a0 -= mq[5][2] * x[22]; b0 -= mq[5][2] * y[22]; a1 -= mq[5][3] * x[23]; b1 -= mq[5][3] * y[23]; mq[5] = *(const LAS f32x4*)(Mg + 2436);
            a0 -= mq[0][0] * x[24]; b0 -= mq[0][0] * y[24]; a1 -= mq[0][1] * x[25]; b1 -= mq[0][1] * y[25]; a0 -= mq[0][2] * x[26]; b0 -= mq[0][2] * y[26]; a1 -= mq[0][3] * x[27]; b1 -= mq[0][3] * y[27]; mq[0] = *(const LAS f32x4*)(Mg + 2440);
            a0 -= mq[1][0] * x[28]; b0 -= mq[1][0] * y[28]; a1 -= mq[1][1] * x[29]; b1 -= mq[1][1] * y[29]; a0 -= mq[1][2] * x[30]; b0 -= mq[1][2] * y[30]; a1 -= mq[1][3] * x[31]; b1 -= mq[1][3] * y[31]; mq[1] = *(const LAS f32x4*)(Mg + 2444);
            a0 -= mq[2][0] * x[32]; b0 -= mq[2][0] * y[32]; a1 -= mq[2][1] * x[33]; b1 -= mq[2][1] * y[33]; a0 -= mq[2][2] * x[34]; b0 -= mq[2][2] * y[34]; a1 -= mq[2][3] * x[35]; b1 -= mq[2][3] * y[35]; mq[2] = *(const LAS f32x4*)(Mg + 2448);
            a0 -= mq[3][0] * x[36]; b0 -= mq[3][0] * y[36]; x[37] = a0 + a1; y[37] = b0 + b1; up[4736] = x[37]; wp[4736] = f2bf(-y[37]); mq[3] = *(const LAS f32x4*)(Mg + 2452);
            { const float br = betg[38]; a0 = bf2f(*(const LAS bf16_t*)(lg + P5_VS + 10336 + c * 2)) * br; b0 = bf2f(*(const LAS bf16_t*)(lg + P5_KS + 10336 + c * 2)) * br * __expf(decg[38]); a1 = 0.f; b1 = 0.f; } a0 -= mq[4][0] * x[0]; b0 -= mq[4][0] * y[0]; a1 -= mq[4][1] * x[1]; b1 -= mq[4][1] * y[1]; a0 -= mq[4][2] * x[2]; b0 -= mq[4][2] * y[2]; a1 -= mq[4][3] * x[3]; b1 -= mq[4][3] * y[3]; mq[4] = *(const LAS f32x4*)(Mg + 2456);
            a0 -= mq[5][0] * x[4]; b0 -= mq[5][0] * y[4]; a1 -= mq[5][1] * x[5]; b1 -= mq[5][1] * y[5]; a0 -= mq[5][2] * x[6]; b0 -= mq[5][2] * y[6]; a1 -= mq[5][3] * x[7]; b1 -= mq[5][3] * y[7]; mq[5] = *(const LAS f32x4*)(Mg + 2460);
            a0 -= mq[0][0] * x[8]; b0 -= mq[0][0] * y[8]; a1 -= mq[0][1] * x[9]; b1 -= mq[0][1] * y[9]; a0 -= mq[0][2] * x[10]; b0 -= mq[0][2] * y[10]; a1 -= mq[0][3] * x[11]; b1 -= mq[0][3] * y[11]; mq[0] = *(const LAS f32x4*)(Mg + 2464);
            a0 -= mq[1][0] * x[12]; b0 -= mq[1][0] * y[12]; a1 -= mq[1][1] * x[13]; b1 -= mq[1][1] * y[13]; a0 -= mq[1][2] * x[14]; b0 -= mq[1][2] * y[14]; a1 -= mq[1][3] * x[15]; b1 -= mq[1][3] * y[15]; mq[1] = *(const LAS f32x4*)(Mg + 2468);
            a0 -= mq[2][0] * x[16]; b0 -= mq[2][0] * y[16]; a1 -= mq[2][1] * x[17]; b1 -= mq[2][1] * y[17]; a0 -= mq[2][2] * x[18]; b0 -= mq[2][2] * y[18]; a1 -= mq[2][3] * x[19]; b1 -= mq[2][3] * y[19]; mq[2] = *(const LAS f32x4*)(Mg + 2496);
            a0 -= mq[3][0] * x[20]; b0 -= mq[3][0] * y[20]; a1 -= mq[3][1] * x[21]; b1 -= mq[3][1] * y[21]; a0 -= mq[3][2] * x[22]; b0 -= mq[3][2] * y[22]; a1 -= mq[3][3] * x[23]; b1 -= mq[3][3] * y[23]; mq[3] = *(const LAS f32x4*)(Mg + 2500);
            a0 -= mq[4][0] * x[24]; b0 -= mq[4][0] * y[24]; a1 -= mq[4][1] * x[25]; b1 -= mq[4][1] * y[25]; a0 -= mq[4][2] * x[26]; b0 -= mq[4][2] * y[26]; a1 -= mq[4][3] * x[27]; b1 -= mq[4][3] * y[27]; mq[4] = *(const LAS f32x4*)(Mg + 2504);
            a0 -= mq[5][0] * x[28]; b0 -= mq[5][0] * y[28]; a1 -= mq[5][1] * x[29]; b1 -= mq[5][1] * y[29]; a0 -= mq[5][2] * x[30]; b0 -= mq[5][2] * y[30]; a1 -= mq[5][3] * x[31]; b1 -= mq[5][3] * y[31]; mq[5] = *(const LAS f32x4*)(Mg + 2508);
            a0 -= mq[0][0] * x[32]; b0 -= mq[0][0] * y[32]; a1 -= mq[0][1] * x[33]; b1 -= mq[0][1] * y[33]; a0 -= mq[0][2] * x[34]; b0 -= mq[0][2] * y[34]; a1 -= mq[0][3] * x[35]; b1 -= mq[0][3] * y[35]; mq[0] = *(const LAS f32x4*)(Mg + 2512);
            a0 -= mq[1][0] * x[36]; b0 -= mq[1][0] * y[36]; a1 -= mq[1][1] * x[37]; b1 -= mq[1][1] * y[37]; x[38] = a0 + a1; y[38] = b0 + b1; up[4864] = x[38]; wp[4864] = f2bf(-y[38]); mq[1] = *(const LAS f32x4*)(Mg + 2516);
            { const float br = betg[39]; a0 = bf2f(*(const LAS bf16_t*)(lg + P5_VS + 10608 + c * 2)) * br; b0 = bf2f(*(const LAS bf16_t*)(lg + P5_KS + 10608 + c * 2)) * br * __expf(decg[39]); a1 = 0.f; b1 = 0.f; } a0 -= mq[2][0] * x[0]; b0 -= mq[2][0] * y[0]; a1 -= mq[2][1] * x[1]; b1 -= mq[2][1] * y[1]; a0 -= mq[2][2] * x[2]; b0 -= mq[2][2] * y[2]; a1 -= mq[2][3] * x[3]; b1 -= mq[2][3] * y[3]; mq[2] = *(const LAS f32x4*)(Mg + 2520);
            a0 -= mq[3][0] * x[4]; b0 -= mq[3][0] * y[4]; a1 -= mq[3][1] * x[5]; b1 -= mq[3][1] * y[5]; a0 -= mq[3][2] * x[6]; b0 -= mq[3][2] * y[6]; a1 -= mq[3][3] * x[7]; b1 -= mq[3][3] * y[7]; mq[3] = *(const LAS f32x4*)(Mg + 2524);
            a0 -= mq[4][0] * x[8]; b0 -= mq[4][0] * y[8]; a1 -= mq[4][1] * x[9]; b1 -= mq[4][1] * y[9]; a0 -= mq[4][2] * x[10]; b0 -= mq[4][2] * y[10]; a1 -= mq[4][3] * x[11]; b1 -= mq[4][3] * y[11]; mq[4] = *(const LAS f32x4*)(Mg + 2528);
            a0 -= mq[5][0] * x[12]; b0 -= mq[5][0] * y[12]; a1 -= mq[5][1] * x[13]; b1 -= mq[5][1] * y[13]; a0 -= mq[5][2] * x[14]; b0 -= mq[5][2] * y[14]; a1 -= mq[5][3] * x[15]; b1 -= mq[5][3] * y[15]; mq[5] = *(const LAS f32x4*)(Mg + 2532);
            a0 -= mq[0][0] * x[16]; b0 -= mq[0][0] * y[16]; a1 -= mq[0][1] * x[17]; b1 -= mq[0][1] * y[17]; a0 -= mq[0][2] * x[18]; b0 -= mq[0][2] * y[18]; a1 -= mq[0][3] * x[19]; b1 -= mq[0][3] * y[19]; mq[0] = *(const LAS f32x4*)(Mg + 2560);
            a0 -= mq[1][0] * x[20]; b0 -= mq[1][0] * y[20]; a1 -= mq[1][1] * x[21]; b1 -= mq[1][1] * y[21]; a0 -= mq[1][2] * x[22]; b0 -= mq[1][2] * y[22]; a1 -= mq[1][3] * x[23]; b1 -= mq[1][3] * y[23]; mq[1] = *(const LAS f32x4*)(Mg + 2564);
            a0 -= mq[2][0] * x[24]; b0 -= mq[2][0] * y[24]; a1 -= mq[2][1] * x[25]; b1 -= mq[2][1] * y[25]; a0 -= mq[2][2] * x[26]; b0 -= mq[2][2] * y[26]; a1 -= mq[2][3] * x[27]; b1 -= mq[2][3] * y[27]; mq[2] = *(const LAS f32x4*)(Mg + 2568);
            a0 -= mq[3][0] * x[28]; b0 -= mq[3][0] * y[28]; a1 -= mq[3][1] * x[29]; b1 -= mq[3][1] * y[29]; a0 -= mq[3][2] * x[30]; b0 -= mq[3][2] * y[30]; a1 -= mq[3][3] * x[31]; b1 -= mq[3][3] * y[31]; mq[3] = *(const LAS f32x4*)(Mg + 2572);
            a0 -= mq[4][0] * x[32]; b0 -= mq[4][0] * y[32]; a1 -= mq[4][1] * x[33]; b1 -= mq[4][1] * y[33]; a0 -= mq[4][2] * x[34]; b0 -= mq[4][2] * y[34]; a1 -= mq[4][3] * x[35]; b1 -= mq[4][3] * y[35]; mq[4] = *(const LAS f32x4*)(Mg + 2576);
            a0 -= mq[5][0] * x[36]; b0 -= mq[5][0] * y[36]; a1 -= mq[5][1] * x[37]; b1 -= mq[5][1] * y[37]; a0 -= mq[5][2] * x[38]; b0 -= mq[5][2] * y[38]; x[39] = a0 + a1; y[39] = b0 + b1; up[4992] = x[39]; wp[4992] = f2bf(-y[39]); mq[5] = *(const LAS f32x4*)(Mg + 2580);
            { const float br = betg[40]; a0 = bf2f(*(const LAS bf16_t*)(lg + P5_VS + 10880 + c * 2)) * br; b0 = bf2f(*(const LAS bf16_t*)(lg + P5_KS + 10880 + c * 2)) * br * __expf(decg[40]); a1 = 0.f; b1 = 0.f; } a0 -= mq[0][0] * x[0]; b0 -= mq[0][0] * y[0]; a1 -= mq[0][1] * x[1]; b1 -= mq[0][1] * y[1]; a0 -= mq[0][2] * x[2]; b0 -= mq[0][2] * y[2]; a1 -= mq[0][3] * x[3]; b1 -= mq[0][3] * y[3]; mq[0] = *(const LAS f32x4*)(Mg + 2584);
            a0 -= mq[1][0] * x[4]; b0 -= mq[1][0] * y[4]; a1 -= mq[1][1] * x[5]; b1 -= mq[1][1] * y[5]; a0 -= mq[1][2] * x[6]; b0 -= mq[1][2] * y[6]; a1 -= mq[1][3] * x[7]; b1 -= mq[1][3] * y[7]; mq[1] = *(const LAS f32x4*)(Mg + 2588);
            a0 -= mq[2][0] * x[8]; b0 -= mq[2][0] * y[8]; a1 -= mq[2][1] * x[9]; b1 -= mq[2][1] * y[9]; a0 -= mq[2][2] * x[10]; b0 -= mq[2][2] * y[10]; a1 -= mq[2][3] * x[11]; b1 -= mq[2][3] * y[11]; mq[2] = *(const LAS f32x4*)(Mg + 2592);
            a0 -= mq[3][0] * x[12]; b0 -= mq[3][0] * y[12]; a1 -= mq[3][1] * x[13]; b1 -= mq[3][1] * y[13]; a0 -= mq[3][2] * x[14]; b0 -= mq[3][2] * y[14]; a1 -= mq[3][3] * x[15]; b1 -= mq[3][3] * y[15]; mq[3] = *(const LAS f32x4*)(Mg + 2596);
            a0 -= mq[4][0] * x[16]; b0 -= mq[4][0] * y[16]; a1 -= mq[4][1] * x[17]; b1 -= mq[4][1] * y[17]; a0 -= mq[4][2] * x[18]; b0 -= mq[4][2] * y[18]; a1 -= mq[4][3] * x[19]; b1 -= mq[4][3] * y[19]; mq[4] = *(const LAS f32x4*)(Mg + 2624);
            a0 -= mq[5][0] * x[20]; b0 -= mq[5][0] * y[20]; a1 -= mq[5][1] * x[21]; b1 -= mq[5][1] * y[21]; a0 -= mq[5][2] * x[22]; b0 -= mq[5][2] * y[22]; a1 -= mq[5][3] * x[23]; b1 -= mq[5][3] * y[23]; mq[5] = *(const LAS f32x4*)(Mg + 2628);
            a0 -= mq[0][0] * x[24]; b0 -= mq[0][0] * y[24]; a1 -= mq[0][1] * x[25]; b1 -= mq[0][1] * y[25]; a0 -= mq[0][2] * x[26]; b0 -= mq[0][2] * y[26]; a1 -= mq[0][3] * x[27]; b1 -= mq[0][3] * y[27]; mq[0] = *(const LAS f32x4*)(Mg + 2632);
            a0 -= mq[1][0] * x[28]; b0 -= mq[1][0] * y[28]; a1 -= mq[1][1] * x[29]; b1 -= mq[1][1] * y[29]; a0 -= mq[1][2] * x[30]; b0 -= mq[1][2] * y[30]; a1 -= mq[1][3] * x[31]; b1 -= mq[1][3] * y[31]; mq[1] = *(const LAS f32x4*)(Mg + 2636);
            a0 -= mq[2][0] * x[32]; b0 -= mq[2][0] * y[32]; a1 -= mq[2][1] * x[33]; b1 -= mq[2][1] * y[33]; a0 -= mq[2][2] * x[34]; b0 -= mq[2][2] * y[34]; a1 -= mq[2][3] * x[35]; b1 -= mq[2][3] * y[35]; mq[2] = *(const LAS f32x4*)(Mg + 2640);
            a0 -= mq[3][0] * x[36]; b0 -= mq[3][0] * y[36]; a1 -= mq[3][1] * x[37]; b1 -= mq[3][1] * y[37]; a0 -= mq[3][2] * x[38]; b0 -= mq[3][2] * y[38]; a1 -= mq[3][3] * x[39]; b1 -= mq[3][3] * y[39]; x[40] = a0 + a1; y[40] = b0 + b1; up[5120] = x[40]; wp[5120] = f2bf(-y[40]); mq[3] = *(const LAS f32x4*)(Mg + 2644);
            { const float br = betg[41]; a0 = bf2f(*(const LAS bf16_t*)(lg + P5_VS + 11152 + c * 2)) * br; b0 = bf2f(*(const LAS bf16_t*)(lg + P5_KS + 11152 + c * 2)) * br * __expf(decg[41]); a1 = 0.f; b1 = 0.f; } a0 -= mq[4][0] * x[0]; b0 -= mq[4][0] * y[0]; a1 -= mq[4][1] * x[1]; b1 -= mq[4][1] * y[1]; a0 -= mq[4][2] * x[2]; b0 -= mq[4][2] * y[2]; a1 -= mq[4][3] * x[3]; b1 -= mq[4][3] * y[3]; mq[4] = *(const LAS f32x4*)(Mg + 2648);
            a0 -= mq[5][0] * x[4]; b0 -= mq[5][0] * y[4]; a1 -= mq[5][1] * x[5]; b1 -= mq[5][1] * y[5]; a0 -= mq[5][2] * x[6]; b0 -= mq[5][2] * y[6]; a1 -= mq[5][3] * x[7]; b1 -= mq[5][3] * y[7]; mq[5] = *(const LAS f32x4*)(Mg + 2652);
            a0 -= mq[0][0] * x[8]; b0 -= mq[0][0] * y[8]; a1 -= mq[0][1] * x[9]; b1 -= mq[0][1] * y[9]; a0 -= mq[0][2] * x[10]; b0 -= mq[0][2] * y[10]; a1 -= mq[0][3] * x[11]; b1 -= mq[0][3] * y[11]; mq[0] = *(const LAS f32x4*)(Mg + 2656);
            a0 -= mq[1][0] * x[12]; b0 -= mq[1][0] * y[12]; a1 -= mq[1][1] * x[13]; b1 -= mq[1][1] * y[13]; a0 -= mq[1][2] * x[14]; b0 -= mq[1][2] * y[14]; a1 -= mq[1][3] * x[15]; b1 -= mq[1][3] * y[15]; mq[1] = *(const LAS f32x4*)(Mg + 2660);
            a0 -= mq[2][0] * x[16]; b0 -= mq[2][0] * y[16]; a1 -= mq[2][1] * x[17]; b1 -= mq[2][1] * y[17]; a0 -= mq[2][2] * x[18]; b0 -= mq[2][2] * y[18]; a1 -= mq[2][3] * x[19]; b1 -= mq[2][3] * y[19]; mq[2] = *(const LAS f32x4*)(Mg + 2664);
            a0 -= mq[3][0] * x[20]; b0 -= mq[3][0] * y[20]; a1 -= mq[3][1] * x[21]; b1 -= mq[3][1] * y[21]; a0 -= mq[3][2] * x[22]; b0 -= mq[3][2] * y[22]; a1 -= mq[3][3] * x[23]; b1 -= mq[3][3] * y[23]; mq[3] = *(const LAS f32x4*)(Mg + 2688);
            a0 -= mq[4][0] * x[24]; b0 -= mq[4][0] * y[24]; a1 -= mq[4][1] * x[25]; b1 -= mq[4][1] * y[25]; a0 -= mq[4][2] * x[26]; b0 -= mq[4][2] * y[26]; a1 -= mq[4][3] * x[27]; b1 -= mq[4][3] * y[27]; mq[4] = *(const LAS f32x4*)(Mg + 2692);
            a0 -= mq[5][0] * x[28]; b0 -= mq[5][0] * y[28]; a1 -= mq[5][1] * x[29]; b1 -= mq[5][1] * y[29]; a0 -= mq[5][2] * x[30]; b0 -= mq[5][2] * y[30]; a1 -= mq[5][3] * x[31]; b1 -= mq[5][3] * y[31]; mq[5] = *(const LAS f32x4*)(Mg + 2696);
            a0 -= mq[0][0] * x[32]; b0 -= mq[0][0] * y[32]; a1 -= mq[0][1] * x[33]; b1 -= mq[0][1] * y[33]; a0 -= mq[0][2] * x[34]; b0 -= mq[0][2] * y[34]; a1 -= mq[0][3] * x[35]; b1 -= mq[0][3] * y[35]; mq[0] = *(const LAS f32x4*)(Mg + 2700);
            a0 -= mq[1][0] * x[36]; b0 -= mq[1][0] * y[36]; a1 -= mq[1][1] * x[37]; b1 -= mq[1][1] * y[37]; a0 -= mq[1][2] * x[38]; b0 -= mq[1][2] * y[38]; a1 -= mq[1][3] * x[39]; b1 -= mq[1][3] * y[39]; mq[1] = *(const LAS f32x4*)(Mg + 2704);
            a0 -= mq[2][0] * x[40]; b0 -= mq[2][0] * y[40]; x[41] = a0 + a1; y[41] = b0 + b1; up[5248] = x[41]; wp[5248] = f2bf(-y[41]); mq[2] = *(const LAS f32x4*)(Mg + 2708);
            { const float br = betg[42]; a0 = bf2f(*(const LAS bf16_t*)(lg + P5_VS + 11424 + c * 2)) * br; b0 = bf2f(*(const LAS bf16_t*)(lg + P5_KS + 11424 + c * 2)) * br * __expf(decg[42]); a1 = 0.f; b1 = 0.f; } a0 -= mq[3][0] * x[0]; b0 -= mq[3][0] * y[0]; a1 -= mq[3][1] * x[1]; b1 -= mq[3][1] * y[1]; a0 -= mq[3][2] * x[2]; b0 -= mq[3][2] * y[2]; a1 -= mq[3][3] * x[3]; b1 -= mq[3][3] * y[3]; mq[3] = *(const LAS f32x4*)(Mg + 2712);
            a0 -= mq[4][0] * x[4]; b0 -= mq[4][0] * y[4]; a1 -= mq[4][1] * x[5]; b1 -= mq[4][1] * y[5]; a0 -= mq[4][2] * x[6]; b0 -= mq[4][2] * y[6]; a1 -= mq[4][3] * x[7]; b1 -= mq[4][3] * y[7]; mq[4] = *(const LAS f32x4*)(Mg + 2716);
            a0 -= mq[5][0] * x[8]; b0 -= mq[5][0] * y[8]; a1 -= mq[5][1] * x[9]; b1 -= mq[5][1] * y[9]; a0 -= mq[5][2] * x[10]; b0 -= mq[5][2] * y[10]; a1 -= mq[5][3] * x[11]; b1 -= mq[5][3] * y[11]; mq[5] = *(const LAS f32x4*)(Mg + 2720);
            a0 -= mq[0][0] * x[12]; b0 -= mq[0][0] * y[12]; a1 -= mq[0][1] * x[13]; b1 -= mq[0][1] * y[13]; a0 -= mq[0][2] * x[14]; b0 -= mq[0][2] * y[14]; a1 -= mq[0][3] * x[15]; b1 -= mq[0][3] * y[15]; mq[0] = *(const LAS f32x4*)(Mg + 2724);
            a0 -= mq[1][0] * x[16]; b0 -= mq[1][0] * y[16]; a1 -= mq[1][1] * x[17]; b1 -= mq[1][1] * y[17]; a0 -= mq[1][2] * x[18]; b0 -= mq[1][2] * y[18]; a1 -= mq[1][3] * x[19]; b1 -= mq[1][3] * y[19]; mq[1] = *(const LAS f32x4*)(Mg + 2728);
            a0 -= mq[2][0] * x[20]; b0 -= mq[2][0] * y[20]; a1 -= mq[2][1] * x[21]; b1 -= mq[2][1] * y[21]; a0 -= mq[2][2] * x[22]; b0 -= mq[2][2] * y[22]; a1 -= mq[2][3] * x[23]; b1 -= mq[2][3] * y[23]; mq[2] = *(const LAS f32x4*)(Mg + 2752);
            a0 -= mq[3][0] * x[24]; b0 -= mq[3][0] * y[24]; a1 -= mq[3][1] * x[25]; b1 -= mq[3][1] * y[25]; a0 -= mq[3][2] * x[26]; b0 -= mq[3][2] * y[26]; a1 -= mq[3][3] * x[27]; b1 -= mq[3][3] * y[27]; mq[3] = *(const LAS f32x4*)(Mg + 2756);
            a0 -= mq[4][0] * x[28]; b0 -= mq[4][0] * y[28]; a1 -= mq[4][1] * x[29]; b1 -= mq[4][1] * y[29]; a0 -= mq[4][2] * x[30]; b0 -= mq[4][2] * y[30]; a1 -= mq[4][3] * x[31]; b1 -= mq[4][3] * y[31]; mq[4] = *(const LAS f32x4*)(Mg + 2760);
            a0 -= mq[5][0] * x[32]; b0 -= mq[5][0] * y[32]; a1 -= mq[5][1] * x[33]; b1 -= mq[5][1] * y[33]; a0 -= mq[5][2] * x[34]; b0 -= mq[5][2] * y[34]; a1 -= mq[5][3] * x[35]; b1 -= mq[5][3] * y[35]; mq[5] = *(const LAS f32x4*)(Mg + 2764);
            a0 -= mq[0][0] * x[36]; b0 -= mq[0][0] * y[36]; a1 -= mq[0][1] * x[37]; b1 -= mq[0][1] * y[37]; a0 -= mq[0][2] * x[38]; b0 -= mq[0][2] * y[38]; a1 -= mq[0][3] * x[39]; b1 -= mq[0][3] * y[39]; mq[0] = *(const LAS f32x4*)(Mg + 2768);
            a0 -= mq[1][0] * x[40]; b0 -= mq[1][0] * y[40]; a1 -= mq[1][1] * x[41]; b1 -= mq[1][1] * y[41]; x[42] = a0 + a1; y[42] = b0 + b1; up[5376] = x[42]; wp[5376] = f2bf(-y[42]); mq[1] = *(const LAS f32x4*)(Mg + 2772);
            { const float br = betg[43]; a0 = bf2f(*(const LAS bf16_t*)(lg + P5_VS + 11696 + c * 2)) * br; b0 = bf2f(*(const LAS bf16_t*)(lg + P5_KS + 11696 + c * 2)) * br * __expf(decg[43]); a1 = 0.f; b1 = 0.f; } a0 -= mq[2][0] * x[0]; b0 -= mq[2][0] * y[0]; a1 -= mq[2][1] * x[1]; b1 -= mq[2][1] * y[1]; a0 -= mq[2][2] * x[2]; b0 -= mq[2][2] * y[2]; a1 -= mq[2][3] * x[3]; b1 -= mq[2][3] * y[3]; mq[2] = *(const LAS f32x4*)(Mg + 2776);
            a0 -= mq[3][0] * x[4]; b0 -= mq[3][0] * y[4]; a1 -= mq[3][1] * x[5]; b1 -= mq[3][1] * y[5]; a0 -= mq[3][2] * x[6]; b0 -= mq[3][2] * y[6]; a1 -= mq[3][3] * x[7]; b1 -= mq[3][3] * y[7]; mq[3] = *(const LAS f32x4*)(Mg + 2780);
            a0 -= mq[4][0] * x[8]; b0 -= mq[4][0] * y[8]; a1 -= mq[4][1] * x[9]; b1 -= mq[4][1] * y[9]; a0 -= mq[4][2] * x[10]; b0 -= mq[4][2] * y[10]; a1 -= mq[4][3] * x[11]; b1 -= mq[4][3] * y[11]; mq[4] = *(const LAS f32x4*)(Mg + 2784);
            a0 -= mq[5][0] * x[12]; b0 -= mq[5][0] * y[12]; a1 -= mq[5][1] * x[13]; b1 -= mq[5][1] * y[13]; a0 -= mq[5][2] * x[14]; b0 -= mq[5][2] * y[14]; a1 -= mq[5][3] * x[15]; b1 -= mq[5][3] * y[15]; mq[5] = *(const LAS f32x4*)(Mg + 2788);
            a0 -= mq[0][0] * x[16]; b0 -= mq[0][0] * y[16]; a1 -= mq[0][1] * x[17]; b1 -= mq[0][1] * y[17]; a0 -= mq[0][2] * x[18]; b0 -= mq[0][2] * y[18]; a1 -= mq[0][3] * x[19]; b1 -= mq[0][3] * y[19]; mq[0] = *(const LAS f32x4*)(Mg + 2792);
            a0 -= mq[1][0] * x[20]; b0 -= mq[1][0] * y[20]; a1 -= mq[1][1] * x[21]; b1 -= mq[1][1] * y[21]; a0 -= mq[1][2] * x[22]; b0 -= mq[1][2] * y[22]; a1 -= mq[1][3] * x[23]; b1 -= mq[1][3] * y[23]; mq[1] = *(const LAS f32x4*)(Mg + 2816);
            a0 -= mq[2][0] * x[24]; b0 -= mq[2][0] * y[24]; a1 -= mq[2][1] * x[25]; b1 -= mq[2][1] * y[25]; a0 -= mq[2][2] * x[26]; b0 -= mq[2][2] * y[26]; a1 -= mq[2][3] * x[27]; b1 -= mq[2][3] * y[27]; mq[2] = *(const LAS f32x4*)(Mg + 2820);
            a0 -= mq[3][0] * x[28]; b0 -= mq[3][0] * y[28]; a1 -= mq[3][1] * x[29]; b1 -= mq[3][1] * y[29]; a0 -= mq[3][2] * x[30]; b0 -= mq[3][2] * y[30]; a1 -= mq[3][3] * x[31]; b1 -= mq[3][3] * y[31]; mq[3] = *(const LAS f32x4*)(Mg + 2824);
            a0 -= mq[4][0] * x[32]; b0 -= mq[4][0] * y[32]; a1 -= mq[4][1] * x[33]; b1 -= mq[4][1] * y[33]; a0 -= mq[4][2] * x[34]; b0 -= mq[4][2] * y[34]; a1 -= mq[4][3] * x[35]; b1 -= mq[4][3] * y[35]; mq[4] = *(const LAS f32x4*)(Mg + 2828);
            a0 -= mq[5][0] * x[36]; b0 -= mq[5][0] * y[36]; a1 -= mq[5][1] * x[37]; b1 -= mq[5][1] * y[37]; a0 -= mq[5][2] * x[38]; b0 -= mq[5][2] * y[38]; a1 -= mq[5][3] * x[39]; b1 -= mq[5][3] * y[39]; mq[5] = *(const LAS f32x4*)(Mg + 2832);
            a0 -= mq[0][0] * x[40]; b0 -= mq[0][0] * y[40]; a1 -= mq[0][1] * x[41]; b1 -= mq[0][1] * y[41]; a0 -= mq[0][2] * x[42]; b0 -= mq[0][2] * y[42]; x[43] = a0 + a1; y[43] = b0 + b1; up[5504] = x[43]; wp[5504] = f2bf(-y[43]); mq[0] = *(const LAS f32x4*)(Mg + 2836);
            { const float br = betg[44]; a0 = bf2f(*(const LAS bf16_t*)(lg + P5_VS + 11968 + c * 2)) * br; b0 = bf2f(*(const LAS bf16_t*)(lg + P5_KS + 11968 + c * 2)) * br * __expf(decg[44]); a1 = 0.f; b1 = 0.f; } a0 -= mq[1][0] * x[0]; b0 -= mq[1][0] * y[0]; a1 -= mq[1][1] * x[1]; b1 -= mq[1][1] * y[1]; a0 -= mq[1][2] * x[2]; b0 -= mq[1][2] * y[2]; a1 -= mq[1][3] * x[3]; b1 -= mq[1][3] * y[3]; mq[1] = *(const LAS f32x4*)(Mg + 2840);
            a0 -= mq[2][0] * x[4]; b0 -= mq[2][0] * y[4]; a1 -= mq[2][1] * x[5]; b1 -= mq[2][1] * y[5]; a0 -= mq[2][2] * x[6]; b0 -= mq[2][2] * y[6]; a1 -= mq[2][3] * x[7]; b1 -= mq[2][3] * y[7]; mq[2] = *(const LAS f32x4*)(Mg + 2844);
            a0 -= mq[3][0] * x[8]; b0 -= mq[3][0] * y[8]; a1 -= mq[3][1] * x[9]; b1 -= mq[3][1] * y[9]; a0 -= mq[3][2] * x[10]; b0 -= mq[3][2] * y[10]; a1 -= mq[3][3] * x[11]; b1 -= mq[3][3] * y[11]; mq[3] = *(const LAS f32x4*)(Mg + 2848);
            a0 -= mq[4][0] * x[12]; b0 -= mq[4][0] * y[12]; a1 -= mq[4][1] * x[13]; b1 -= mq[4][1] * y[13]; a0 -= mq[4][2] * x[14]; b0 -= mq[4][2] * y[14]; a1 -= mq[4][3] * x[15]; b1 -= mq[4][3] * y[15]; mq[4] = *(const LAS f32x4*)(Mg + 2852);
            a0 -= mq[5][0] * x[16]; b0 -= mq[5][0] * y[16]; a1 -= mq[5][1] * x[17]; b1 -= mq[5][1] * y[17]; a0 -= mq[5][2] * x[18]; b0 -= mq[5][2] * y[18]; a1 -= mq[5][3] * x[19]; b1 -= mq[5][3] * y[19]; mq[5] = *(const LAS f32x4*)(Mg + 2856);
            a0 -= mq[0][0] * x[20]; b0 -= mq[0][0] * y[20]; a1 -= mq[0][1] * x[21]; b1 -= mq[0][1] * y[21]; a0 -= mq[0][2] * x[22]; b0 -= mq[0][2] * y[22]; a1 -= mq[0][3] * x[23]; b1 -= mq[0][3] * y[23]; mq[0] = *(const LAS f32x4*)(Mg + 2880);
            a0 -= mq[1][0] * x[24]; b0 -= mq[1][0] * y[24]; a1 -= mq[1][1] * x[25]; b1 -= mq[1][1] * y[25]; a0 -= mq[1][2] * x[26]; b0 -= mq[1][2] * y[26]; a1 -= mq[1][3] * x[27]; b1 -= mq[1][3] * y[27]; mq[1] = *(const LAS f32x4*)(Mg + 2884);
            a0 -= mq[2][0] * x[28]; b0 -= mq[2][0] * y[28]; a1 -= mq[2][1] * x[29]; b1 -= mq[2][1] * y[29]; a0 -= mq[2][2] * x[30]; b0 -= mq[2][2] * y[30]; a1 -= mq[2][3] * x[31]; b1 -= mq[2][3] * y[31]; mq[2] = *(const LAS f32x4*)(Mg + 2888);
            a0 -= mq[3][0] * x[32]; b0 -= mq[3][0] * y[32]; a1 -= mq[3][1] * x[33]; b1 -= mq[3][1] * y[33]; a0 -= mq[3][2] * x[34]; b0 -= mq[3][2] * y[34]; a1 -= mq[3][3] * x[35]; b1 -= mq[3][3] * y[35]; mq[3] = *(const LAS f32x4*)(Mg + 2892);
            a0 -= mq[4][0] * x[36]; b0 -= mq[4][0] * y[36]; a1 -= mq[4][1] * x[37]; b1 -= mq[4][1] * y[37]; a0 -= mq[4][2] * x[38]; b0 -= mq[4][2] * y[38]; a1 -= mq[4][3] * x[39]; b1 -= mq[4][3] * y[39]; mq[4] = *(const LAS f32x4*)(Mg + 2896);
            a0 -= mq[5][0] * x[40]; b0 -= mq[5][0] * y[40]; a1 -= mq[5][1] * x[41]; b1 -= mq[5][1] * y[41]; a0 -= mq[5][2] * x[42]; b0 -= mq[5][2] * y[42]; a1 -= mq[5][3] * x[43]; b1 -= mq[5][3] * y[43]; x[44] = a0 + a1; y[44] = b0 + b1; up[5632] = x[44]; wp[5632] = f2bf(-y[44]); mq[5] = *(const LAS f32x4*)(Mg + 2900);
            { const float br = betg[45]; a0 = bf2f(*(const LAS bf16_t*)(lg + P5_VS + 12240 + c * 2)) * br; b0 = bf2f(*(const LAS bf16_t*)(lg + P5_KS + 12240 + c * 2)) * br * __expf(decg[45]); a1 = 0.f; b1 = 0.f; } a0 -= mq[0][0] * x[0]; b0 -= mq[0][0] * y[0]; a1 -= mq[0][1] * x[1]; b1 -= mq[0][1] * y[1]; a0 -= mq[0][2] * x[2]; b0 -= mq[0][2] * y[2]; a1 -= mq[0][3] * x[3]; b1 -= mq[0][3] * y[3]; mq[0] = *(const LAS f32x4*)(Mg + 2904);
            a0 -= mq[1][0] * x[4]; b0 -= mq[1][0] * y[4]; a1 -= mq[1][1] * x[5]; b1 -= mq[1][1] * y[5]; a0 -= mq[1][2] * x[6]; b0 -= mq[1][2] * y[6]; a1 -= mq[1][3] * x[7]; b1 -= mq[1][3] * y[7]; mq[1] = *(const LAS f32x4*)(Mg + 2908);
            a0 -= mq[2][0] * x[8]; b0 -= mq[2][0] * y[8]; a1 -= mq[2][1] * x[9]; b1 -= mq[2][1] * y[9]; a0 -= mq[2][2] * x[10]; b0 -= mq[2][2] * y[10]; a1 -= mq[2][3] * x[11]; b1 -= mq[2][3] * y[11]; mq[2] = *(const LAS f32x4*)(Mg + 2912);
            a0 -= mq[3][0] * x[12]; b0 -= mq[3][0] * y[12]; a1 -= mq[3][1] * x[13]; b1 -= mq[3][1] * y[13]; a0 -= mq[3][2] * x[14]; b0 -= mq[3][2] * y[14]; a1 -= mq[3][3] * x[15]; b1 -= mq[3][3] * y[15]; mq[3] = *(const LAS f32x4*)(Mg + 2916);
            a0 -= mq[4][0] * x[16]; b0 -= mq[4][0] * y[16]; a1 -= mq[4][1] * x[17]; b1 -= mq[4][1] * y[17]; a0 -= mq[4][2] * x[18]; b0 -= mq[4][2] * y[18]; a1 -= mq[4][3] * x[19]; b1 -= mq[4][3] * y[19]; mq[4] = *(const LAS f32x4*)(Mg + 2920);
            a0 -= mq[5][0] * x[20]; b0 -= mq[5][0] * y[20]; a1 -= mq[5][1] * x[21]; b1 -= mq[5][1] * y[21]; a0 -= mq[5][2] * x[22]; b0 -= mq[5][2] * y[22]; a1 -= mq[5][3] * x[23]; b1 -= mq[5][3] * y[23]; mq[5] = *(const LAS f32x4*)(Mg + 2924);
            a0 -= mq[0][0] * x[24]; b0 -= mq[0][0] * y[24]; a1 -= mq[0][1] * x[25]; b1 -= mq[0][1] * y[25]; a0 -= mq[0][2] * x[26]; b0 -= mq[0][2] * y[26]; a1 -= mq[0][3] * x[27]; b1 -= mq[0][3] * y[27]; mq[0] = *(const LAS f32x4*)(Mg + 2944);
            a0 -= mq[1][0] * x[28]; b0 -= mq[1][0] * y[28]; a1 -= mq[1][1] * x[29]; b1 -= mq[1][1] * y[29]; a0 -= mq[1][2] * x[30]; b0 -= mq[1][2] * y[30]; a1 -= mq[1][3] * x[31]; b1 -= mq[1][3] * y[31]; mq[1] = *(const LAS f32x4*)(Mg + 2948);
            a0 -= mq[2][0] * x[32]; b0 -= mq[2][0] * y[32]; a1 -= mq[2][1] * x[33]; b1 -= mq[2][1] * y[33]; a0 -= mq[2][2] * x[34]; b0 -= mq[2][2] * y[34]; a1 -= mq[2][3] * x[35]; b1 -= mq[2][3] * y[35]; mq[2] = *(const LAS f32x4*)(Mg + 2952);
            a0 -= mq[3][0] * x[36]; b0 -= mq[3][0] * y[36]; a1 -= mq[3][1] * x[37]; b1 -= mq[3][1] * y[37]; a0 -= mq[3][2] * x[38]; b0 -= mq[3][2] * y[38]; a1 -= mq[3][3] * x[39]; b1 -= mq[3][3] * y[39]; mq[3] = *(const LAS f32x4*)(Mg + 2956);
            a0 -= mq[4][0] * x[40]; b0 -= mq[4][0] * y[40]; a1 -= mq[4][1] * x[41]; b1 -= mq[4][1] * y[41]; a0 -= mq[4][2] * x[42]; b0 -= mq[4][2] * y[42]; a1 -= mq[4][3] * x[43]; b1 -= mq[4][3] * y[43]; mq[4] = *(const LAS f32x4*)(Mg + 2960);
            a0 -= mq[5][0] * x[44]; b0 -= mq[5][0] * y[44]; x[45] = a0 + a1; y[45] = b0 + b1; up[5760] = x[45]; wp[5760] = f2bf(-y[45]); mq[5] = *(const LAS f32x4*)(Mg + 2964);
            { const float br = betg[46]; a0 = bf2f(*(const LAS bf16_t*)(lg + P5_VS + 12512 + c * 2)) * br; b0 = bf2f(*(const LAS bf16_t*)(lg + P5_KS + 12512 + c * 2)) * br * __expf(decg[46]); a1 = 0.f; b1 = 0.f; } a0 -= mq[0][0] * x[0]; b0 -= mq[0][0] * y[0]; a1 -= mq[0][1] * x[1]; b1 -= mq[0][1] * y[1]; a0 -= mq[0][2] * x[2]; b0 -= mq[0][2] * y[2]; a1 -= mq[0][3] * x[3]; b1 -= mq[0][3] * y[3]; mq[0] = *(const LAS f32x4*)(Mg + 2968);
            a0 -= mq[1][0] * x[4]; b0 -= mq[1][0] * y[4]; a1 -= mq[1][1] * x[5]; b1 -= mq[1][1] * y[5]; a0 -= mq[1][2] * x[6]; b0 -= mq[1][2] * y[6]; a1 -= mq[1][3] * x[7]; b1 -= mq[1][3] * y[7]; mq[1] = *(const LAS f32x4*)(Mg + 2972);
            a0 -= mq[2][0] * x[8]; b0 -= mq[2][0] * y[8]; a1 -= mq[2][1] * x[9]; b1 -= mq[2][1] * y[9]; a0 -= mq[2][2] * x[10]; b0 -= mq[2][2] * y[10]; a1 -= mq[2][3] * x[11]; b1 -= mq[2][3] * y[11]; mq[2] = *(const LAS f32x4*)(Mg + 2976);
            a0 -= mq[3][0] * x[12]; b0 -= mq[3][0] * y[12]; a1 -= mq[3][1] * x[13]; b1 -= mq[3][1] * y[13]; a0 -= mq[3][2] * x[14]; b0 -= mq[3][2] * y[14]; a1 -= mq[3][3] * x[15]; b1 -= mq[3][3] * y[15]; mq[3] = *(const LAS f32x4*)(Mg + 2980);
            a0 -= mq[4][0] * x[16]; b0 -= mq[4][0] * y[16]; a1 -= mq[4][1] * x[17]; b1 -= mq[4][1] * y[17]; a0 -= mq[4][2] * x[18]; b0 -= mq[4][2] * y[18]; a1 -= mq[4][3] * x[19]; b1 -= mq[4][3] * y[19]; mq[4] = *(const LAS f32x4*)(Mg + 2984);
            a0 -= mq[5][0] * x[20]; b0 -= mq[5][0] * y[20]; a1 -= mq[5][1] * x[21]; b1 -= mq[5][1] * y[21]; a0 -= mq[5][2] * x[22]; b0 -= mq[5][2] * y[22]; a1 -= mq[5][3] * x[23]; b1 -= mq[5][3] * y[23]; mq[5] = *(const LAS f32x4*)(Mg + 2988);
            a0 -= mq[0][0] * x[24]; b0 -= mq[0][0] * y[24]; a1 -= mq[0][1] * x[25]; b1 -= mq[0][1] * y[25]; a0 -= mq[0][2] * x[26]; b0 -= mq[0][2] * y[26]; a1 -= mq[0][3] * x[27]; b1 -= mq[0][3] * y[27]; mq[0] = *(const LAS f32x4*)(Mg + 3008);
            a0 -= mq[1][0] * x[28]; b0 -= mq[1][0] * y[28]; a1 -= mq[1][1] * x[29]; b1 -= mq[1][1] * y[29]; a0 -= mq[1][2] * x[30]; b0 -= mq[1][2] * y[30]; a1 -= mq[1][3] * x[31]; b1 -= mq[1][3] * y[31]; mq[1] = *(const LAS f32x4*)(Mg + 3012);
            a0 -= mq[2][0] * x[32]; b0 -= mq[2][0] * y[32]; a1 -= mq[2][1] * x[33]; b1 -= mq[2][1] * y[33]; a0 -= mq[2][2] * x[34]; b0 -= mq[2][2] * y[34]; a1 -= mq[2][3] * x[35]; b1 -= mq[2][3] * y[35]; mq[2] = *(const LAS f32x4*)(Mg + 3016);
            a0 -= mq[3][0] * x[36]; b0 -= mq[3][0] * y[36]; a1 -= mq[3][1] * x[37]; b1 -= mq[3][1] * y[37]; a0 -= mq[3][2] * x[38]; b0 -= mq[3][2] * y[38]; a1 -= mq[3][3] * x[39]; b1 -= mq[3][3] * y[39]; mq[3] = *(const LAS f32x4*)(Mg + 3020);
            a0 -= mq[4][0] * x[40]; b0 -= mq[4][0] * y[40]; a1 -= mq[4][1] * x[41]; b1 -= mq[4][1] * y[41]; a0 -= mq[4][2] * x[42]; b0 -= mq[4][2] * y[42]; a1 -= mq[4][3] * x[43]; b1 -= mq[4][3] * y[43]; mq[4] = *(const LAS f32x4*)(Mg + 3024);
            a0 -= mq[5][0] * x[44]; b0 -= mq[5][0] * y[44]; a1 -= mq[5][1] * x[45]; b1 -= mq[5][1] * y[45]; x[46] = a0 + a1; y[46] = b0 + b1; up[5888] = x[46]; wp[5888] = f2bf(-y[46]); mq[5] = *(const LAS f32x4*)(Mg + 3028);
            { const float br = betg[47]; a0 = bf2f(*(const LAS bf16_t*)(lg + P5_VS + 12784 + c * 2)) * br; b0 = bf2f(*(const LAS bf16_t*)(lg + P5_KS + 12784 + c * 2)) * br * __expf(decg[47]); a1 = 0.f; b1 = 0.f; } a0 -= mq[0][0] * x[0]; b0 -= mq[0][0] * y[0]; a1 -= mq[0][1] * x[1]; b1 -= mq[0][1] * y[1]; a0 -= mq[0][2] * x[2]; b0 -= mq[0][2] * y[2]; a1 -= mq[0][3] * x[3]; b1 -= mq[0][3] * y[3]; mq[0] = *(const LAS f32x4*)(Mg + 3032);
            a0 -= mq[1][0] * x[4]; b0 -= mq[1][0] * y[4]; a1 -= mq[1][1] * x[5]; b1 -= mq[1][1] * y[5]; a0 -= mq[1][2] * x[6]; b0 -= mq[1][2] * y[6]; a1 -= mq[1][3] * x[7]; b1 -= mq[1][3] * y[7]; mq[1] = *(const LAS f32x4*)(Mg + 3036);
            a0 -= mq[2][0] * x[8]; b0 -= mq[2][0] * y[8]; a1 -= mq[2][1] * x[9]; b1 -= mq[2][1] * y[9]; a0 -= mq[2][2] * x[10]; b0 -= mq[2][2] * y[10]; a1 -= mq[2][3] * x[11]; b1 -= mq[2][3] * y[11]; mq[2] = *(const LAS f32x4*)(Mg + 3040);
            a0 -= mq[3][0] * x[12]; b0 -= mq[3][0] * y[12]; a1 -= mq[3][1] * x[13]; b1 -= mq[3][1] * y[13]; a0 -= mq[3][2] * x[14]; b0 -= mq[3][2] * y[14]; a1 -= mq[3][3] * x[15]; b1 -= mq[3][3] * y[15]; mq[3] = *(const LAS f32x4*)(Mg + 3044);
            a0 -= mq[4][0] * x[16]; b0 -= mq[4][0] * y[16]; a1 -= mq[4][1] * x[17]; b1 -= mq[4][1] * y[17]; a0 -= mq[4][2] * x[18]; b0 -= mq[4][2] * y[18]; a1 -= mq[4][3] * x[19]; b1 -= mq[4][3] * y[19]; mq[4] = *(const LAS f32x4*)(Mg + 3048);
            a0 -= mq[5][0] * x[20]; b0 -= mq[5][0] * y[20]; a1 -= mq[5][1] * x[21]; b1 -= mq[5][1] * y[21]; a0 -= mq[5][2] * x[22]; b0 -= mq[5][2] * y[22]; a1 -= mq[5][3] * x[23]; b1 -= mq[5][3] * y[23]; mq[5] = *(const LAS f32x4*)(Mg + 3052);
            a0 -= mq[0][0] * x[24]; b0 -= mq[0][0] * y[24]; a1 -= mq[0][1] * x[25]; b1 -= mq[0][1] * y[25]; a0 -= mq[0][2] * x[26]; b0 -= mq[0][2] * y[26]; a1 -= mq[0][3] * x[27]; b1 -= mq[0][3] * y[27]; mq[0] = *(const LAS f32x4*)(Mg + 3072);
            a0 -= mq[1][0] * x[28]; b0 -= mq[1][0] * y[28]; a1 -= mq[1][1] * x[29]; b1 -= mq[1][1] * y[29]; a0 -= mq[1][2] * x[30]; b0 -= mq[1][2] * y[30]; a1 -= mq[1][3] * x[31]; b1 -= mq[1][3] * y[31]; mq[1] = *(const LAS f32x4*)(Mg + 3076);
            a0 -= mq[2][0] * x[32]; b0 -= mq[2][0] * y[32]; a1 -= mq[2][1] * x[33]; b1 -= mq[2][1] * y[33]; a0 -= mq[2][2] * x[34]; b0 -= mq[2][2] * y[34]; a1 -= mq[2][3] * x[35]; b1 -= mq[2][3] * y[35]; mq[2] = *(const LAS f32x4*)(Mg + 3080);
            a0 -= mq[3][0] * x[36]; b0 -= mq[3][0] * y[36]; a1 -= mq[3][1] * x[37]; b1 -= mq[3][1] * y[37]; a0 -= mq[3][2] * x[38]; b0 -= mq[3][2] * y[38]; a1 -= mq[3][3] * x[39]; b1 -= mq[3][3] * y[39]; mq[3] = *(const LAS f32x4*)(Mg + 3084);
            a0 -= mq[4][0] * x[40]; b0 -= mq[4][0] * y[40]; a1 -= mq[4][1] * x[41]; b1 -= mq[4][1] * y[41]; a0 -= mq[4][2] * x[42]; b0 -= mq[4][2] * y[42]; a1 -= mq[4][3] * x[43]; b1 -= mq[4][3] * y[43]; mq[4] = *(const LAS f32x4*)(Mg + 3088);
            a0 -= mq[5][0] * x[44]; b0 -= mq[5][0] * y[44]; a1 -= mq[5][1] * x[45]; b1 -= mq[5][1] * y[45]; a0 -= mq[5][2] * x[46]; b0 -= mq[5][2] * y[46]; x[47] = a0 + a1; y[47] = b0 + b1; up[6016] = x[47]; wp[6016] = f2bf(-y[47]); mq[5] = *(const LAS f32x4*)(Mg + 3092);
            { const float br = betg[48]; a0 = bf2f(*(const LAS bf16_t*)(lg + P5_VS + 13056 + c * 2)) * br; b0 = bf2f(*(const LAS bf16_t*)(lg + P5_KS + 13056 + c * 2)) * br * __expf(decg[48]); a1 = 0.f; b1 = 0.f; } a0 -= mq[0][0] * x[0]; b0 -= mq[0][0] * y[0]; a1 -= mq[0][1] * x[1]; b1 -= mq[0][1] * y[1]; a0 -= mq[0][2] * x[2]; b0 -= mq[0][2] * y[2]; a1 -= mq[0][3] * x[3]; b1 -= mq[0][3] * y[3]; mq[0] = *(const LAS f32x4*)(Mg + 3096);
            a0 -= mq[1][0] * x[4]; b0 -= mq[1][0] * y[4]; a1 -= mq[1][1] * x[5]; b1 -= mq[1][1] * y[5]; a0 -= mq[1][2] * x[6]; b0 -= mq[1][2] * y[6]; a1 -= mq[1][3] * x[7]; b1 -= mq[1][3] * y[7]; mq[1] = *(const LAS f32x4*)(Mg + 3100);
            a0 -= mq[2][0] * x[8]; b0 -= mq[2][0] * y[8]; a1 -= mq[2][1] * x[9]; b1 -= mq[2][1] * y[9]; a0 -= mq[2][2] * x[10]; b0 -= mq[2][2] * y[10]; a1 -= mq[2][3] * x[11]; b1 -= mq[2][3] * y[11]; mq[2] = *(const LAS f32x4*)(Mg + 3104);
            a0 -= mq[3][0] * x[12]; b0 -= mq[3][0] * y[12]; a1 -= mq[3][1] * x[13]; b1 -= mq[3][1] * y[13]; a0 -= mq[3][2] * x[14]; b0 -= mq[3][2] * y[14]; a1 -= mq[3][3] * x[15]; b1 -= mq[3][3] * y[15]; mq[3] = *(const LAS f32x4*)(Mg + 3108);
            a0 -= mq[4][0] * x[16]; b0 -= mq[4][0] * y[16]; a1 -= mq[4][1] * x[17]; b1 -= mq[4][1] * y[17]; a0 -= mq[4][2] * x[18]; b0 -= mq[4][2] * y[18]; a1 -= mq[4][3] * x[19]; b1 -= mq[4][3] * y[19]; mq[4] = *(const LAS f32x4*)(Mg + 3112);
            a0 -= mq[5][0] * x[20]; b0 -= mq[5][0] * y[20]; a1 -= mq[5][1] * x[21]; b1 -= mq[5][1] * y[21]; a0 -= mq[5][2] * x[22]; b0 -= mq[5][2] * y[22]; a1 -= mq[5][3] * x[23]; b1 -= mq[5][3] * y[23]; mq[5] = *(const LAS f32x4*)(Mg + 3116);
            a0 -= mq[0][0] * x[24]; b0 -= mq[0][0] * y[24]; a1 -= mq[0][1] * x[25]; b1 -= mq[0][1] * y[25]; a0 -= mq[0][2] * x[26]; b0 -= mq[0][2] * y[26]; a1 -= mq[0][3] * x[27]; b1 -= mq[0][3] * y[27]; mq[0] = *(const LAS f32x4*)(Mg + 3136);
            a0 -= mq[1][0] * x[28]; b0 -= mq[1][0] * y[28]; a1 -= mq[1][1] * x[29]; b1 -= mq[1][1] * y[29]; a0 -= mq[1][2] * x[30]; b0 -= mq[1][2] * y[30]; a1 -= mq[1][3] * x[31]; b1 -= mq[1][3] * y[31]; mq[1] = *(const LAS f32x4*)(Mg + 3140);
            a0 -= mq[2][0] * x[32]; b0 -= mq[2][0] * y[32]; a1 -= mq[2][1] * x[33]; b1 -= mq[2][1] * y[33]; a0 -= mq[2][2] * x[34]; b0 -= mq[2][2] * y[34]; a1 -= mq[2][3] * x[35]; b1 -= mq[2][3] * y[35]; mq[2] = *(const LAS f32x4*)(Mg + 3144);
            a0 -= mq[3][0] * x[36]; b0 -= mq[3][0] * y[36]; a1 -= mq[3][1] * x[37]; b1 -= mq[3][1] * y[37]; a0 -= mq[3][2] * x[38]; b0 -= mq[3][2] * y[38]; a1 -= mq[3][3] * x[39]; b1 -= mq[3][3] * y[39]; mq[3] = *(const LAS f32x4*)(Mg + 3148);
            a0 -= mq[4][0] * x[40]; b0 -= mq[4][0] * y[40]; a1 -= mq[4][1] * x[41]; b1 -= mq[4][1] * y[41]; a0 -= mq[4][2] * x[42]; b0 -= mq[4][2] * y[42]; a1 -= mq[4][3] * x[43]; b1 -= mq[4][3] * y[43]; mq[4] = *(const LAS f32x4*)(Mg + 3152);
            a0 -= mq[5][0] * x[44]; b0 -= mq[5][0] * y[44]; a1 -= mq[5][1] * x[45]; b1 -= mq[5][1] * y[45]; a0 -= mq[5][2] * x[46]; b0 -= mq[5][2] * y[46]; a1 -= mq[5][3] * x[47]; b1 -= mq[5][3] * y[47]; x[48] = a0 + a1; y[48] = b0 + b1; up[6144] = x[48]; wp[6144] = f2bf(-y[48]); mq[5] = *(const LAS f32x4*)(Mg + 3156);
            { const float br = betg[49]; a0 = bf2f(*(const LAS bf16_t*)(lg + P5_VS + 13328 + c * 2)) * br; b0 = bf2f(*(const LAS bf16_t*)(lg + P5_KS + 13328 + c * 2)) * br * __expf(decg[49]); a1 = 0.f; b1 = 0.f; } a0 -= mq[0][0] * x[0]; b0 -= mq[0][0] * y[0]; a1 -= mq[0][1] * x[1]; b1 -= mq[0][1] * y[1]; a0 -= mq[0][2] * x[2]; b0 -= mq[0][2] * y[2]; a1 -= mq[0][3] * x[3]; b1 -= mq[0][3] * y[3]; mq[0] = *(const LAS f32x4*)(Mg + 3160);
            a0 -= mq[1][0] * x[4]; b0 -= mq[1][0] * y[4]; a1 -= mq[1][1] * x[5]; b1 -= mq[1][1] * y[5]; a0 -= mq[1][2] * x[6]; b0 -= mq[1][2] * y[6]; a1 -= mq[1][3] * x[7]; b1 -= mq[1][3] * y[7]; mq[1] = *(const LAS f32x4*)(Mg + 3164);
            a0 -= mq[2][0] * x[8]; b0 -= mq[2][0] * y[8]; a1 -= mq[2][1] * x[9]; b1 -= mq[2][1] * y[9]; a0 -= mq[2][2] * x[10]; b0 -= mq[2][2] * y[10]; a1 -= mq[2][3] * x[11]; b1 -= mq[2][3] * y[11]; mq[2] = *(const LAS f32x4*)(Mg + 3168);
            a0 -= mq[3][0] * x[12]; b0 -= mq[3][0] * y[12]; a1 -= mq[3][1] * x[13]; b1 -= mq[3][1] * y[13]; a0 -= mq[3][2] * x[14]; b0 -= mq[3][2] * y[14]; a1 -= mq[3][3] * x[15]; b1 -= mq[3][3] * y[15]; mq[3] = *(const LAS f32x4*)(Mg + 3172);
            a0 -= mq[4][0] * x[16]; b0 -= mq[4][0] * y[16]; a1 -= mq[4][1] * x[17]; b1 -= mq[4][1] * y[17]; a0 -= mq[4][2] * x[18]; b0 -= mq[4][2] * y[18]; a1 -= mq[4][3] * x[19]; b1 -= mq[4][3] * y[19]; mq[4] = *(const LAS f32x4*)(Mg + 3176);
            a0 -= mq[5][0] * x[20]; b0 -= mq[5][0] * y[20]; a1 -= mq[5][1] * x[21]; b1 -= mq[5][1] * y[21]; a0 -= mq[5][2] * x[22]; b0 -= mq[5][2] * y[22]; a1 -= mq[5][3] * x[23]; b1 -= mq[5][3] * y[23]; mq[5] = *(const LAS f32x4*)(Mg + 3180);
            a0 -= mq[0][0] * x[24]; b0 -= mq[0][0] * y[24]; a1 -= mq[0][1] * x[25]; b1 -= mq[0][1] * y[25]; a0 -= mq[0][2] * x[26]; b0 -= mq[0][2] * y[26]; a1 -= mq[0][3] * x[27]; b1 -= mq[0][3] * y[27]; mq[0] = *(const LAS f32x4*)(Mg + 3184);
            a0 -= mq[1][0] * x[28]; b0 -= mq[1][0] * y[28]; a1 -= mq[1][1] * x[29]; b1 -= mq[1][1] * y[29]; a0 -= mq[1][2] * x[30]; b0 -= mq[1][2] * y[30]; a1 -= mq[1][3] * x[31]; b1 -= mq[1][3] * y[31]; mq[1] = *(const LAS f32x4*)(Mg + 3200);
            a0 -= mq[2][0] * x[32]; b0 -= mq[2][0] * y[32]; a1 -= mq[2][1] * x[33]; b1 -= mq[2][1] * y[33]; a0 -= mq[2][2] * x[34]; b0 -= mq[2][2] * y[34]; a1 -= mq[2][3] * x[35]; b1 -= mq[2][3] * y[35]; mq[2] = *(const LAS f32x4*)(Mg + 3204);
            a0 -= mq[3][0] * x[36]; b0 -= mq[3][0] * y[36]; a1 -= mq[3][1] * x[37]; b1 -= mq[3][1] * y[37]; a0 -= mq[3][2] * x[38]; b0 -= mq[3][2] * y[38]; a1 -= mq[3][3] * x[39]; b1 -= mq[3][3] * y[39]; mq[3] = *(const LAS f32x4*)(Mg + 3208);
            a0 -= mq[4][0] * x[40]; b0 -= mq[4][0] * y[40]; a1 -= mq[4][1] * x[41]; b1 -= mq[4][1] * y[41]; a0 -= mq[4][2] * x[42]; b0 -= mq[4][2] * y[42]; a1 -= mq[4][3] * x[43]; b1 -= mq[4][3] * y[43]; mq[4] = *(const LAS f32x4*)(Mg + 3212);
            a0 -= mq[5][0] * x[44]; b0 -= mq[5][0] * y[44]; a1 -= mq[5][1] * x[45]; b1 -= mq[5][1] * y[45]; a0 -= mq[5][2] * x[46]; b0 -= mq[5][2] * y[46]; a1 -= mq[5][3] * x[47]; b1 -= mq[5][3] * y[47]; mq[5] = *(const LAS f32x4*)(Mg + 3216);
            a0 -= mq[0][0] * x[48]; b0 -= mq[0][0] * y[48]; x[49] = a0 + a1; y[49] = b0 + b1; up[6272] = x[49]; wp[6272] = f2bf(-y[49]); mq[0] = *(const LAS f32x4*)(Mg + 3220);
            { const float br = betg[50]; a0 = bf2f(*(const LAS bf16_t*)(lg + P5_VS + 13600 + c * 2)) * br; b0 = bf2f(*(const LAS bf16_t*)(lg + P5_KS + 13600 + c * 2)) * br * __expf(decg[50]); a1 = 0.f; b1 = 0.f; } a0 -= mq[1][0] * x[0]; b0 -= mq[1][0] * y[0]; a1 -= mq[1][1] * x[1]; b1 -= mq[1][1] * y[1]; a0 -= mq[1][2] * x[2]; b0 -= mq[1][2] * y[2]; a1 -= mq[1][3] * x[3]; b1 -= mq[1][3] * y[3]; mq[1] = *(const LAS f32x4*)(Mg + 3224);
            a0 -= mq[2][0] * x[4]; b0 -= mq[2][0] * y[4]; a1 -= mq[2][1] * x[5]; b1 -= mq[2][1] * y[5]; a0 -= mq[2][2] * x[6]; b0 -= mq[2][2] * y[6]; a1 -= mq[2][3] * x[7]; b1 -= mq[2][3] * y[7]; mq[2] = *(const LAS f32x4*)(Mg + 3228);
            a0 -= mq[3][0] * x[8]; b0 -= mq[3][0] * y[8]; a1 -= mq[3][1] * x[9]; b1 -= mq[3][1] * y[9]; a0 -= mq[3][2] * x[10]; b0 -= mq[3][2] * y[10]; a1 -= mq[3][3] * x[11]; b1 -= mq[3][3] * y[11]; mq[3] = *(const LAS f32x4*)(Mg + 3232);
            a0 -= mq[4][0] * x[12]; b0 -= mq[4][0] * y[12]; a1 -= mq[4][1] * x[13]; b1 -= mq[4][1] * y[13]; a0 -= mq[4][2] * x[14]; b0 -= mq[4][2] * y[14]; a1 -= mq[4][3] * x[15]; b1 -= mq[4][3] * y[15]; mq[4] = *(const LAS f32x4*)(Mg + 3236);
            a0 -= mq[5][0] * x[16]; b0 -= mq[5][0] * y[16]; a1 -= mq[5][1] * x[17]; b1 -= mq[5][1] * y[17]; a0 -= mq[5][2] * x[18]; b0 -= mq[5][2] * y[18]; a1 -= mq[5][3] * x[19]; b1 -= mq[5][3] * y[19]; mq[5] = *(const LAS f32x4*)(Mg + 3240);
            a0 -= mq[0][0] * x[20]; b0 -= mq[0][0] * y[20]; a1 -= mq[0][1] * x[21]; b1 -= mq[0][1] * y[21]; a0 -= mq[0][2] * x[22]; b0 -= mq[0][2] * y[22]; a1 -= mq[0][3] * x[23]; b1 -= mq[0][3] * y[23]; mq[0] = *(const LAS f32x4*)(Mg + 3244);
            a0 -= mq[1][0] * x[24]; b0 -= mq[1][0] * y[24]; a1 -= mq[1][1] * x[25]; b1 -= mq[1][1] * y[25]; a0 -= mq[1][2] * x[26]; b0 -= mq[1][2] * y[26]; a1 -= mq[1][3] * x[27]; b1 -= mq[1][3] * y[27]; mq[1] = *(const LAS f32x4*)(Mg + 3248);
            a0 -= mq[2][0] * x[28]; b0 -= mq[2][0] * y[28]; a1 -= mq[2][1] * x[29]; b1 -= mq[2][1] * y[29]; a0 -= mq[2][2] * x[30]; b0 -= mq[2][2] * y[30]; a1 -= mq[2][3] * x[31]; b1 -= mq[2][3] * y[31]; mq[2] = *(const LAS f32x4*)(Mg + 3264);
            a0 -= mq[3][0] * x[32]; b0 -= mq[3][0] * y[32]; a1 -= mq[3][1] * x[33]; b1 -= mq[3][1] * y[33]; a0 -= mq[3][2] * x[34]; b0 -= mq[3][2] * y[34]; a1 -= mq[3][3] * x[35]; b1 -= mq[3][3] * y[35]; mq[3] = *(const LAS f32x4*)(Mg + 3268);
            a0 -= mq[4][0] * x[36]; b0 -= mq[4][0] * y[36]; a1 -= mq[4][1] * x[37]; b1 -= mq[4][1] * y[37]; a0 -= mq[4][2] * x[38]; b0 -= mq[4][2] * y[38]; a1 -= mq[4][3] * x[39]; b1 -= mq[4][3] * y[39]; mq[4] = *(const LAS f32x4*)(Mg + 3272);
            a0 -= mq[5][0] * x[40]; b0 -= mq[5][0] * y[40]; a1 -= mq[5][1] * x[41]; b1 -= mq[5][1] * y[41]; a0 -= mq[5][2] * x[42]; b0 -= mq[5][2] * y[42]; a1 -= mq[5][3] * x[43]; b1 -= mq[5][3] * y[43]; mq[5] = *(const LAS f32x4*)(Mg + 3276);
            a0 -= mq[0][0] * x[44]; b0 -= mq[0][0] * y[44]; a1 -= mq[0][1] * x[45]; b1 -= mq[0][1] * y[45]; a0 -= mq[0][2] * x[46]; b0 -= mq[0][2] * y[46]; a1 -= mq[0][3] * x[47]; b1 -= mq[0][3] * y[47]; mq[0] = *(const LAS f32x4*)(Mg + 3280);
            a0 -= mq[1][0] * x[48]; b0 -= mq[1][0] * y[48]; a1 -= mq[1][1] * x[49]; b1 -= mq[1][1] * y[49]; x[50] = a0 + a1; y[50] = b0 + b1; up[6400] = x[50]; wp[6400] = f2bf(-y[50]); mq[1] = *(const LAS f32x4*)(Mg + 3284);
            { const float br = betg[51]; a0 = bf2f(*(const LAS bf16_t*)(lg + P5_VS + 13872 + c * 2)) * br; b0 = bf2f(*(const LAS bf16_t*)(lg + P5_KS + 13872 + c * 2)) * br * __expf(decg[51]); a1 = 0.f; b1 = 0.f; } a0 -= mq[2][0] * x[0]; b0 -= mq[2][0] * y[0]; a1 -= mq[2][1] * x[1]; b1 -= mq[2][1] * y[1]; a0 -= mq[2][2] * x[2]; b0 -= mq[2][2] * y[2]; a1 -= mq[2][3] * x[3]; b1 -= mq[2][3] * y[3]; mq[2] = *(const LAS f32x4*)(Mg + 3288);
            a0 -= mq[3][0] * x[4]; b0 -= mq[3][0] * y[4]; a1 -= mq[3][1] * x[5]; b1 -= mq[3][1] * y[5]; a0 -= mq[3][2] * x[6]; b0 -= mq[3][2] * y[6]; a1 -= mq[3][3] * x[7]; b1 -= mq[3][3] * y[7]; mq[3] = *(const LAS f32x4*)(Mg + 3292);
            a0 -= mq[4][0] * x[8]; b0 -= mq[4][0] * y[8]; a1 -= mq[4][1] * x[9]; b1 -= mq[4][1] * y[9]; a0 -= mq[4][2] * x[10]; b0 -= mq[4][2] * y[10]; a1 -= mq[4][3] * x[11]; b1 -= mq[4][3] * y[11]; mq[4] = *(const LAS f32x4*)(Mg + 3296);
            a0 -= mq[5][0] * x[12]; b0 -= mq[5][0] * y[12]; a1 -= mq[5][1] * x[13]; b1 -= mq[5][1] * y[13]; a0 -= mq[5][2] * x[14]; b0 -= mq[5][2] * y[14]; a1 -= mq[5][3] * x[15]; b1 -= mq[5][3] * y[15]; mq[5] = *(const LAS f32x4*)(Mg + 3300);
            a0 -= mq[0][0] * x[16]; b0 -= mq[0][0] * y[16]; a1 -= mq[0][1] * x[17]; b1 -= mq[0][1] * y[17]; a0 -= mq[0][2] * x[18]; b0 -= mq[0][2] * y[18]; a1 -= mq[0][3] * x[19]; b1 -= mq[0][3] * y[19]; mq[0] = *(const LAS f32x4*)(Mg + 3304);
            a0 -= mq[1][0] * x[20]; b0 -= mq[1][0] * y[20]; a1 -= mq[1][1] * x[21]; b1 -= mq[1][1] * y[21]; a0 -= mq[1][2] * x[22]; b0 -= mq[1][2] * y[22]; a1 -= mq[1][3] * x[23]; b1 -= mq[1][3] * y[23]; mq[1] = *(const LAS f32x4*)(Mg + 3308);
            a0 -= mq[2][0] * x[24]; b0 -= mq[2][0] * y[24]; a1 -= mq[2][1] * x[25]; b1 -= mq[2][1] * y[25]; a0 -= mq[2][2] * x[26]; b0 -= mq[2][2] * y[26]; a1 -= mq[2][3] * x[27]; b1 -= mq[2][3] * y[27]; mq[2] = *(const LAS f32x4*)(Mg + 3312);
            a0 -= mq[3][0] * x[28]; b0 -= mq[3][0] * y[28]; a1 -= mq[3][1] * x[29]; b1 -= mq[3][1] * y[29]; a0 -= mq[3][2] * x[30]; b0 -= mq[3][2] * y[30]; a1 -= mq[3][3] * x[31]; b1 -= mq[3][3] * y[31]; mq[3] = *(const LAS f32x4*)(Mg + 3328);
            a0 -= mq[4][0] * x[32]; b0 -= mq[4][0] * y[32]; a1 -= mq[4][1] * x[33]; b1 -= mq[4][1] * y[33]; a0 -= mq[4][2] * x[34]; b0 -= mq[4][2] * y[34]; a1 -= mq[4][3] * x[35]; b1 -= mq[4][3] * y[35]; mq[4] = *(const LAS f32x4*)(Mg + 3332);
            a0 -= mq[5][0] * x[36]; b0 -= mq[5][0] * y[36]; a1 -= mq[5][1] * x[37]; b1 -= mq[5][1] * y[37]; a0 -= mq[5][2] * x[38]; b0 -= mq[5][2] * y[38]; a1 -= mq[5][3] * x[39]; b1 -= mq[5][3] * y[39]; mq[5] = *(const LAS f32x4*)(Mg + 3336);
            a0 -= mq[0][0] * x[40]; b0 -= mq[0][0] * y[40]; a1 -= mq[0][1] * x[41]; b1 -= mq[0][1] * y[41]; a0 -= mq[0][2] * x[42]; b0 -= mq[0][2] * y[42]; a1 -= mq[0][3] * x[43]; b1 -= mq[0][3] * y[43]; mq[0] = *(const LAS f32x4*)(Mg + 3340);
            a0 -= mq[1][0] * x[44]; b0 -= mq[1][0] * y[44]; a1 -= mq[1][1] * x[45]; b1 -= mq[1][1] * y[45]; a0 -= mq[1][2] * x[46]; b0 -= mq[1][2] * y[46]; a1 -= mq[1][3] * x[47]; b1 -= mq[1][3] * y[47]; mq[1] = *(const LAS f32x4*)(Mg + 3344);
            a0 -= mq[2][0] * x[48]; b0 -= mq[2][0] * y[48]; a1 -= mq[2][1] * x[49]; b1 -= mq[2][1] * y[49]; a0 -= mq[2][2] * x[50]; b0 -= mq[2][2] * y[50]; x[51] = a0 + a1; y[51] = b0 + b1; up[6528] = x[51]; wp[6528] = f2bf(-y[51]); mq[2] = *(const LAS f32x4*)(Mg + 3348);
            { const float br = betg[52]; a0 = bf2f(*(const LAS bf16_t*)(lg + P5_VS + 14144 + c * 2)) * br; b0 = bf2f(*(const LAS bf16_t*)(lg + P5_KS + 14144 + c * 2)) * br * __expf(decg[52]); a1 = 0.f; b1 = 0.f; } a0 -= mq[3][0] * x[0]; b0 -= mq[3][0] * y[0]; a1 -= mq[3][1] * x[1]; b1 -= mq[3][1] * y[1]; a0 -= mq[3][2] * x[2]; b0 -= mq[3][2] * y[2]; a1 -= mq[3][3] * x[3]; b1 -= mq[3][3] * y[3]; mq[3] = *(const LAS f32x4*)(Mg + 3352);
            a0 -= mq[4][0] * x[4]; b0 -= mq[4][0] * y[4]; a1 -= mq[4][1] * x[5]; b1 -= mq[4][1] * y[5]; a0 -= mq[4][2] * x[6]; b0 -= mq[4][2] * y[6]; a1 -= mq[4][3] * x[7]; b1 -= mq[4][3] * y[7]; mq[4] = *(const LAS f32x4*)(Mg + 3356);
            a0 -= mq[5][0] * x[8]; b0 -= mq[5][0] * y[8]; a1 -= mq[5][1] * x[9]; b1 -= mq[5][1] * y[9]; a0 -= mq[5][2] * x[10]; b0 -= mq[5][2] * y[10]; a1 -= mq[5][3] * x[11]; b1 -= mq[5][3] * y[11]; mq[5] = *(const LAS f32x4*)(Mg + 3360);
            a0 -= mq[0][0] * x[12]; b0 -= mq[0][0] * y[12]; a1 -= mq[0][1] * x[13]; b1 -= mq[0][1] * y[13]; a0 -= mq[0][2] * x[14]; b0 -= mq[0][2] * y[14]; a1 -= mq[0][3] * x[15]; b1 -= mq[0][3] * y[15]; mq[0] = *(const LAS f32x4*)(Mg + 3364);
            a0 -= mq[1][0] * x[16]; b0 -= mq[1][0] * y[16]; a1 -= mq[1][1] * x[17]; b1 -= mq[1][1] * y[17]; a0 -= mq[1][2] * x[18]; b0 -= mq[1][2] * y[18]; a1 -= mq[1][3] * x[19]; b1 -= mq[1][3] * y[19]; mq[1] = *(const LAS f32x4*)(Mg + 3368);
            a0 -= mq[2][0] * x[20]; b0 -= mq[2][0] * y[20]; a1 -= mq[2][1] * x[21]; b1 -= mq[2][1] * y[21]; a0 -= mq[2][2] * x[22]; b0 -= mq[2][2] * y[22]; a1 -= mq[2][3] * x[23]; b1 -= mq[2][3] * y[23]; mq[2] = *(const LAS f32x4*)(Mg + 3372);
            a0 -= mq[3][0] * x[24]; b0 -= mq[3][0] * y[24]; a1 -= mq[3][1] * x[25]; b1 -= mq[3][1] * y[25]; a0 -= mq[3][2] * x[26]; b0 -= mq[3][2] * y[26]; a1 -= mq[3][3] * x[27]; b1 -= mq[3][3] * y[27]; mq[3] = *(const LAS f32x4*)(Mg + 3376);
            a0 -= mq[4][0] * x[28]; b0 -= mq[4][0] * y[28]; a1 -= mq[4][1] * x[29]; b1 -= mq[4][1] * y[29]; a0 -= mq[4][2] * x[30]; b0 -= mq[4][2] * y[30]; a1 -= mq[4][3] * x[31]; b1 -= mq[4][3] * y[31]; mq[4] = *(const LAS f32x4*)(Mg + 3392);
            a0 -= mq[5][0] * x[32]; b0 -= mq[5][0] * y[32]; a1 -= mq[5][1] * x[33]; b1 -= mq[5][1] * y[33]; a0 -= mq[5][2] * x[34]; b0 -= mq[5][2] * y[34]; a1 -= mq[5][3] * x[35]; b1 -= mq[5][3] * y[35]; mq[5] = *(const LAS f32x4*)(Mg + 3396);
            a0 -= mq[0][0] * x[36]; b0 -= mq[0][0] * y[36]; a1 -= mq[0][1] * x[37]; b1 -= mq[0][1] * y[37]; a0 -= mq[0][2] * x[38]; b0 -= mq[0][2] * y[38]; a1 -= mq[0][3] * x[39]; b1 -= mq[0][3] * y[39]; mq[0] = *(const LAS f32x4*)(Mg + 3400);
            a0 -= mq[1][0] * x[40]; b0 -= mq[1][0] * y[40]; a1 -= mq[1][1] * x[41]; b1 -= mq[1][1] * y[41]; a0 -= mq[1][2] * x[42]; b0 -= mq[1][2] * y[42]; a1 -= mq[1][3] * x[43]; b1 -= mq[1][3] * y[43]; mq[1] = *(const LAS f32x4*)(Mg + 3404);
            a0 -= mq[2][0] * x[44]; b0 -= mq[2][0] * y[44]; a1 -= mq[2][1] * x[45]; b1 -= mq[2][1] * y[45]; a0 -= mq[2][2] * x[46]; b0 -= mq[2][2] * y[46]; a1 -= mq[2][3] * x[47]; b1 -= mq[2][3] * y[47]; mq[2] = *(const LAS f32x4*)(Mg + 3408);
            a0 -= mq[3][0] * x[48]; b0 -= mq[3][0] * y[48]; a1 -= mq[3][1] * x[49]; b1 -= mq[3][1] * y[49]; a0 -= mq[3][2] * x[50]; b0 -= mq[3][2] * y[50]; a1 -= mq[3][3] * x[51]; b1 -= mq[3][3] * y[51]; x[52] = a0 + a1; y[52] = b0 + b1; up[6656] = x[52]; wp[6656] = f2bf(-y[52]); mq[3] = *(const LAS f32x4*)(Mg + 3412);
            { const float br = betg[53]; a0 = bf2f(*(const LAS bf16_t*)(lg + P5_VS + 14416 + c * 2)) * br; b0 = bf2f(*(const LAS bf16_t*)(lg + P5_KS + 14416 + c * 2)) * br * __expf(decg[53]); a1 = 0.f; b1 = 0.f; } a0 -= mq[4][0] * x[0]; b0 -= mq[4][0] * y[0]; a1 -= mq[4][1] * x[1]; b1 -= mq[4][1] * y[1]; a0 -= mq[4][2] * x[2]; b0 -= mq[4][2] * y[2]; a1 -= mq[4][3] * x[3]; b1 -= mq[4][3] * y[3]; mq[4] = *(const LAS f32x4*)(Mg + 3416);
            a0 -= mq[5][0] * x[4]; b0 -= mq[5][0] * y[4]; a1 -= mq[5][1] * x[5]; b1 -= mq[5][1] * y[5]; a0 -= mq[5][2] * x[6]; b0 -= mq[5][2] * y[6]; a1 -= mq[5][3] * x[7]; b1 -= mq[5][3] * y[7]; mq[5] = *(const LAS f32x4*)(Mg + 3420);
            a0 -= mq[0][0] * x[8]; b0 -= mq[0][0] * y[8]; a1 -= mq[0][1] * x[9]; b1 -= mq[0][1] * y[9]; a0 -= mq[0][2] * x[10]; b0 -= mq[0][2] * y[10]; a1 -= mq[0][3] * x[11]; b1 -= mq[0][3] * y[11]; mq[0] = *(const LAS f32x4*)(Mg + 3424);
            a0 -= mq[1][0] * x[12]; b0 -= mq[1][0] * y[12]; a1 -= mq[1][1] * x[13]; b1 -= mq[1][1] * y[13]; a0 -= mq[1][2] * x[14]; b0 -= mq[1][2] * y[14]; a1 -= mq[1][3] * x[15]; b1 -= mq[1][3] * y[15]; mq[1] = *(const LAS f32x4*)(Mg + 3428);
            a0 -= mq[2][0] * x[16]; b0 -= mq[2][0] * y[16]; a1 -= mq[2][1] * x[17]; b1 -= mq[2][1] * y[17]; a0 -= mq[2][2] * x[18]; b0 -= mq[2][2] * y[18]; a1 -= mq[2][3] * x[19]; b1 -= mq[2][3] * y[19]; mq[2] = *(const LAS f32x4*)(Mg + 3432);
            a0 -= mq[3][0] * x[20]; b0 -= mq[3][0] * y[20]; a1 -= mq[3][1] * x[21]; b1 -= mq[3][1] * y[21]; a0 -= mq[3][2] * x[22]; b0 -= mq[3][2] * y[22]; a1 -= mq[3][3] * x[23]; b1 -= mq[3][3] * y[23]; mq[3] = *(const LAS f32x4*)(Mg + 3436);
            a0 -= mq[4][0] * x[24]; b0 -= mq[4][0] * y[24]; a1 -= mq[4][1] * x[25]; b1 -= mq[4][1] * y[25]; a0 -= mq[4][2] * x[26]; b0 -= mq[4][2] * y[26]; a1 -= mq[4][3] * x[27]; b1 -= mq[4][3] * y[27]; mq[4] = *(const LAS f32x4*)(Mg + 3440);
            a0 -= mq[5][0] * x[28]; b0 -= mq[5][0] * y[28]; a1 -= mq[5][1] * x[29]; b1 -= mq[5][1] * y[29]; a0 -= mq[5][2] * x[30]; b0 -= mq[5][2] * y[30]; a1 -= mq[5][3] * x[31]; b1 -= mq[5][3] * y[31]; mq[5] = *(const LAS f32x4*)(Mg + 3444);
            a0 -= mq[0][0] * x[32]; b0 -= mq[0][0] * y[32]; a1 -= mq[0][1] * x[33]; b1 -= mq[0][1] * y[33]; a0 -= mq[0][2] * x[34]; b0 -= mq[0][2] * y[34]; a1 -= mq[0][3] * x[35]; b1 -= mq[0][3] * y[35]; mq[0] = *(const LAS f32x4*)(Mg + 3456);
            a0 -= mq[1][0] * x[36]; b0 -= mq[1][0] * y[36]; a1 -= mq[1][1] * x[37]; b1 -= mq[1][1] * y[37]; a0 -= mq[1][2] * x[38]; b0 -= mq[1][2] * y[38]; a1 -= mq[1][3] * x[39]; b1 -= mq[1][3] * y[39]; mq[1] = *(const LAS f32x4*)(Mg + 3460);
            a0 -= mq[2][0] * x[40]; b0 -= mq[2][0] * y[40]; a1 -= mq[2][1] * x[41]; b1 -= mq[2][1] * y[41]; a0 -= mq[2][2] * x[42]; b0 -= mq[2][2] * y[42]; a1 -= mq[2][3] * x[43]; b1 -= mq[2][3] * y[43]; mq[2] = *(const LAS f32x4*)(Mg + 3464);
            a0 -= mq[3][0] * x[44]; b0 -= mq[3][0] * y[44]; a1 -= mq[3][1] * x[45]; b1 -= mq[3][1] * y[45]; a0 -= mq[3][2] * x[46]; b0 -= mq[3][2] * y[46]; a1 -= mq[3][3] * x[47]; b1 -= mq[3][3] * y[47]; mq[3] = *(const LAS f32x4*)(Mg + 3468);
            a0 -= mq[4][0] * x[48]; b0 -= mq[4][0] * y[48]; a1 -= mq[4][1] * x[49]; b1 -= mq[4][1] * y[49]; a0 -= mq[4][2] * x[50]; b0 -= mq[4][2] * y[50]; a1 -= mq[4][3] * x[51]; b1 -= mq[4][3] * y[51]; mq[4] = *(const LAS f32x4*)(Mg + 3472);
            a0 -= mq[5][0] * x[52]; b0 -= mq[5][0] * y[52]; x[53] = a0 + a1; y[53] = b0 + b1; up[6784] = x[53]; wp[6784] = f2bf(-y[53]); mq[5] = *(const LAS f32x4*)(Mg + 3476);
            { const float br = betg[54]; a0 = bf2f(*(const LAS bf16_t*)(lg + P5_VS + 14688 + c * 2)) * br; b0 = bf2f(*(const LAS bf16_t*)(lg + P5_KS + 14688 + c * 2)) * br * __expf(decg[54]); a1 = 0.f; b1 = 0.f; } a0 -= mq[0][0] * x[0]; b0 -= mq[0][0] * y[0]; a1 -= mq[0][1] * x[1]; b1 -= mq[0][1] * y[1]; a0 -= mq[0][2] * x[2]; b0 -= mq[0][2] * y[2]; a1 -= mq[0][3] * x[3]; b1 -= mq[0][3] * y[3]; mq[0] = *(const LAS f32x4*)(Mg + 3480);
            a0 -= mq[1][0] * x[4]; b0 -= mq[1][0] * y[4]; a1 -= mq[1][1] * x[5]; b1 -= mq[1][1] * y[5]; a0 -= mq[1][2] * x[6]; b0 -= mq[1][2] * y[6]; a1 -= mq[1][3] * x[7]; b1 -= mq[1][3] * y[7]; mq[1] = *(const LAS f32x4*)(Mg + 3484);
            a0 -= mq[2][0] * x[8]; b0 -= mq[2][0] * y[8]; a1 -= mq[2][1] * x[9]; b1 -= mq[2][1] * y[9]; a0 -= mq[2][2] * x[10]; b0 -= mq[2][2] * y[10]; a1 -= mq[2][3] * x[11]; b1 -= mq[2][3] * y[11]; mq[2] = *(const LAS f32x4*)(Mg + 3488);
            a0 -= mq[3][0] * x[12]; b0 -= mq[3][0] * y[12]; a1 -= mq[3][1] * x[13]; b1 -= mq[3][1] * y[13]; a0 -= mq[3][2] * x[14]; b0 -= mq[3][2] * y[14]; a1 -= mq[3][3] * x[15]; b1 -= mq[3][3] * y[15]; mq[3] = *(const LAS f32x4*)(Mg + 3492);
            a0 -= mq[4][0] * x[16]; b0 -= mq[4][0] * y[16]; a1 -= mq[4][1] * x[17]; b1 -= mq[4][1] * y[17]; a0 -= mq[4][2] * x[18]; b0 -= mq[4][2] * y[18]; a1 -= mq[4][3] * x[19]; b1 -= mq[4][3] * y[19]; mq[4] = *(const LAS f32x4*)(Mg + 3496);
            a0 -= mq[5][0] * x[20]; b0 -= mq[5][0] * y[20]; a1 -= mq[5][1] * x[21]; b1 -= mq[5][1] * y[21]; a0 -= mq[5][2] * x[22]; b0 -= mq[5][2] * y[22]; a1 -= mq[5][3] * x[23]; b1 -= mq[5][3] * y[23]; mq[5] = *(const LAS f32x4*)(Mg + 3500);
            a0 -= mq[0][0] * x[24]; b0 -= mq[0][0] * y[24]; a1 -= mq[0][1] * x[25]; b1 -= mq[0][1] * y[25]; a0 -= mq[0][2] * x[26]; b0 -= mq[0][2] * y[26]; a1 -= mq[0][3] * x[27]; b1 -= mq[0][3] * y[27]; mq[0] = *(const LAS f32x4*)(Mg + 3504);
            a0 -= mq[1][0] * x[28]; b0 -= mq[1][0] * y[28]; a1 -= mq[1][1] * x[29]; b1 -= mq[1][1] * y[29]; a0 -= mq[1][2] * x[30]; b0 -= mq[1][2] * y[30]; a1 -= mq[1][3] * x[31]; b1 -= mq[1][3] * y[31]; mq[1] = *(const LAS f32x4*)(Mg + 3508);
            a0 -= mq[2][0] * x[32]; b0 -= mq[2][0] * y[32]; a1 -= mq[2][1] * x[33]; b1 -= mq[2][1] * y[33]; a0 -= mq[2][2] * x[34]; b0 -= mq[2][2] * y[34]; a1 -= mq[2][3] * x[35]; b1 -= mq[2][3] * y[35]; mq[2] = *(const LAS f32x4*)(Mg + 3520);
            a0 -= mq[3][0] * x[36]; b0 -= mq[3][0] * y[36]; a1 -= mq[3][1] * x[37]; b1 -= mq[3][1] * y[37]; a0 -= mq[3][2] * x[38]; b0 -= mq[3][2] * y[38]; a1 -= mq[3][3] * x[39]; b1 -= mq[3][3] * y[39]; mq[3] = *(const LAS f32x4*)(Mg + 3524);
            a0 -= mq[4][0] * x[40]; b0 -= mq[4][0] * y[40]; a1 -= mq[4][1] * x[41]; b1 -= mq[4][1] * y[41]; a0 -= mq[4][2] * x[42]; b0 -= mq[4][2] * y[42]; a1 -= mq[4][3] * x[43]; b1 -= mq[4][3] * y[43]; mq[4] = *(const LAS f32x4*)(Mg + 3528);
            a0 -= mq[5][0] * x[44]; b0 -= mq[5][0] * y[44]; a1 -= mq[5][1] * x[45]; b1 -= mq[5][1] * y[45]; a0 -= mq[5][2] * x[46]; b0 -= mq[5][2] * y[46]; a1 -= mq[5][3] * x[47]; b1 -= mq[5][3] * y[47]; mq[5] = *(const LAS f32x4*)(Mg + 3532);
            a0 -= mq[0][0] * x[48]; b0 -= mq[0][0] * y[48]; a1 -= mq[0][1] * x[49]; b1 -= mq[0][1] * y[49]; a0 -= mq[0][2] * x[50]; b0 -= mq[0][2] * y[50]; a1 -= mq[0][3] * x[51]; b1 -= mq[0][3] * y[51]; mq[0] = *(const LAS f32x4*)(Mg + 3536);
            a0 -= mq[1][0] * x[52]; b0 -= mq[1][0] * y[52]; a1 -= mq[1][1] * x[53]; b1 -= mq[1][1] * y[53]; x[54] = a0 + a1; y[54] = b0 + b1; up[6912] = x[54]; wp[6912] = f2bf(-y[54]); mq[1] = *(const LAS f32x4*)(Mg + 3540);
            { const float br = betg[55]; a0 = bf2f(*(const LAS bf16_t*)(lg + P5_VS + 14960 + c * 2)) * br; b0 = bf2f(*(const LAS bf16_t*)(lg + P5_KS + 14960 + c * 2)) * br * __expf(decg[55]); a1 = 0.f; b1 = 0.f; } a0 -= mq[2][0] * x[0]; b0 -= mq[2][0] * y[0]; a1 -= mq[2][1] * x[1]; b1 -= mq[2][1] * y[1]; a0 -= mq[2][2] * x[2]; b0 -= mq[2][2] * y[2]; a1 -= mq[2][3] * x[3]; b1 -= mq[2][3] * y[3]; mq[2] = *(const LAS f32x4*)(Mg + 3544);
            a0 -= mq[3][0] * x[4]; b0 -= mq[3][0] * y[4]; a1 -= mq[3][1] * x[5]; b1 -= mq[3][1] * y[5]; a0 -= mq[3][2] * x[6]; b0 -= mq[3][2] * y[6]; a1 -= mq[3][3] * x[7]; b1 -= mq[3][3] * y[7]; mq[3] = *(const LAS f32x4*)(Mg + 3548);
            a0 -= mq[4][0] * x[8]; b0 -= mq[4][0] * y[8]; a1 -= mq[4][1] * x[9]; b1 -= mq[4][1] * y[9]; a0 -= mq[4][2] * x[10]; b0 -= mq[4][2] * y[10]; a1 -= mq[4][3] * x[11]; b1 -= mq[4][3] * y[11]; mq[4] = *(const LAS f32x4*)(Mg + 3552);
            a0 -= mq[5][0] * x[12]; b0 -= mq[5][0] * y[12]; a1 -= mq[5][1] * x[13]; b1 -= mq[5][1] * y[13]; a0 -= mq[5][2] * x[14]; b0 -= mq[5][2] * y[14]; a1 -= mq[5][3] * x[15]; b1 -= mq[5][3] * y[15]; mq[5] = *(const LAS f32x4*)(Mg + 3556);
            a0 -= mq[0][0] * x[16]; b0 -= mq[0][0] * y[16]; a1 -= mq[0][1] * x[17]; b1 -= mq[0][1] * y[17]; a0 -= mq[0][2] * x[18]; b0 -= mq[0][2] * y[18]; a1 -= mq[0][3] * x[19]; b1 -= mq[0][3] * y[19]; mq[0] = *(const LAS f32x4*)(Mg + 3560);
            a0 -= mq[1][0] * x[20]; b0 -= mq[1][0] * y[20]; a1 -= mq[1][1] * x[21]; b1 -= mq[1][1] * y[21]; a0 -= mq[1][2] * x[22]; b0 -= mq[1][2] * y[22]; a1 -= mq[1][3] * x[23]; b1 -= mq[1][3] * y[23]; mq[1] = *(const LAS f32x4*)(Mg + 3564);
            a0 -= mq[2][0] * x[24]; b0 -= mq[2][0] * y[24]; a1 -= mq[2][1] * x[25]; b1 -= mq[2][1] * y[25]; a0 -= mq[2][2] * x[26]; b0 -= mq[2][2] * y[26]; a1 -= mq[2][3] * x[27]; b1 -= mq[2][3] * y[27]; mq[2] = *(const LAS f32x4*)(Mg + 3568);
            a0 -= mq[3][0] * x[28]; b0 -= mq[3][0] * y[28]; a1 -= mq[3][1] * x[29]; b1 -= mq[3][1] * y[29]; a0 -= mq[3][2] * x[30]; b0 -= mq[3][2] * y[30]; a1 -= mq[3][3] * x[31]; b1 -= mq[3][3] * y[31]; mq[3] = *(const LAS f32x4*)(Mg + 3572);
            a0 -= mq[4][0] * x[32]; b0 -= mq[4][0] * y[32]; a1 -= mq[4][1] * x[33]; b1 -= mq[4][1] * y[33]; a0 -= mq[4][2] * x[34]; b0 -= mq[4][2] * y[34]; a1 -= mq[4][3] * x[35]; b1 -= mq[4][3] * y[35]; mq[4] = *(const LAS f32x4*)(Mg + 3584);
            a0 -= mq[5][0] * x[36]; b0 -= mq[5][0] * y[36]; a1 -= mq[5][1] * x[37]; b1 -= mq[5][1] * y[37]; a0 -= mq[5][2] * x[38]; b0 -= mq[5][2] * y[38]; a1 -= mq[5][3] * x[39]; b1 -= mq[5][3] * y[39]; mq[5] = *(const LAS f32x4*)(Mg + 3588);
            a0 -= mq[0][0] * x[40]; b0 -= mq[0][0] * y[40]; a1 -= mq[0][1] * x[41]; b1 -= mq[0][1] * y[41]; a0 -= mq[0][2] * x[42]; b0 -= mq[0][2] * y[42]; a1 -= mq[0][3] * x[43]; b1 -= mq[0][3] * y[43]; mq[0] = *(const LAS f32x4*)(Mg + 3592);
            a0 -= mq[1][0] * x[44]; b0 -= mq[1][0] * y[44]; a1 -= mq[1][1] * x[45]; b1 -= mq[1][1] * y[45]; a0 -= mq[1][2] * x[46]; b0 -= mq[1][2] * y[46]; a1 -= mq[1][3] * x[47]; b1 -= mq[1][3] * y[47]; mq[1] = *(const LAS f32x4*)(Mg + 3596);
            a0 -= mq[2][0] * x[48]; b0 -= mq[2][0] * y[48]; a1 -= mq[2][1] * x[49]; b1 -= mq[2][1] * y[49]; a0 -= mq[2][2] * x[50]; b0 -= mq[2][2] * y[50]; a1 -= mq[2][3] * x[51]; b1 -= mq[2][3] * y[51]; mq[2] = *(const LAS f32x4*)(Mg + 3600);
            a0 -= mq[3][0] * x[52]; b0 -= mq[3][0] * y[52]; a1 -= mq[3][1] * x[53]; b1 -= mq[3][1] * y[53]; a0 -= mq[3][2] * x[54]; b0 -= mq[3][2] * y[54]; x[55] = a0 + a1; y[55] = b0 + b1; up[7040] = x[55]; wp[7040] = f2bf(-y[55]); mq[3] = *(const LAS f32x4*)(Mg + 3604);
            { const float br = betg[56]; a0 = bf2f(*(const LAS bf16_t*)(lg + P5_VS + 15232 + c * 2)) * br; b0 = bf2f(*(const LAS bf16_t*)(lg + P5_KS + 15232 + c * 2)) * br * __expf(decg[56]); a1 = 0.f; b1 = 0.f; } a0 -= mq[4][0] * x[0]; b0 -= mq[4][0] * y[0]; a1 -= mq[4][1] * x[1]; b1 -= mq[4][1] * y[1]; a0 -= mq[4][2] * x[2]; b0 -= mq[4][2] * y[2]; a1 -= mq[4][3] * x[3]; b1 -= mq[4][3] * y[3]; mq[4] = *(const LAS f32x4*)(Mg + 3608);
            a0 -= mq[5][0] * x[4]; b0 -= mq[5][0] * y[4]; a1 -= mq[5][1] * x[5]; b1 -= mq[5][1] * y[5]; a0 -= mq[5][2] * x[6]; b0 -= mq[5][2] * y[6]; a1 -= mq[5][3] * x[7]; b1 -= mq[5][3] * y[7]; mq[5] = *(const LAS f32x4*)(Mg + 3612);
            a0 -= mq[0][0] * x[8]; b0 -= mq[0][0] * y[8]; a1 -= mq[0][1] * x[9]; b1 -= mq[0][1] * y[9]; a0 -= mq[0][2] * x[10]; b0 -= mq[0][2] * y[10]; a1 -= mq[0][3] * x[11]; b1 -= mq[0][3] * y[11]; mq[0] = *(const LAS f32x4*)(Mg + 3616);
            a0 -= mq[1][0] * x[12]; b0 -= mq[1][0] * y[12]; a1 -= mq[1][1] * x[13]; b1 -= mq[1][1] * y[13]; a0 -= mq[1][2] * x[14]; b0 -= mq[1][2] * y[14]; a1 -= mq[1][3] * x[15]; b1 -= mq[1][3] * y[15]; mq[1] = *(const LAS f32x4*)(Mg + 3620);
            a0 -= mq[2][0] * x[16]; b0 -= mq[2][0] * y[16]; a1 -= mq[2][1] * x[17]; b1 -= mq[2][1] * y[17]; a0 -= mq[2][2] * x[18]; b0 -= mq[2][2] * y[18]; a1 -= mq[2][3] * x[19]; b1 -= mq[2][3] * y[19]; mq[2] = *(const LAS f32x4*)(Mg + 3624);
            a0 -= mq[3][0] * x[20]; b0 -= mq[3][0] * y[20]; a1 -= mq[3][1] * x[21]; b1 -= mq[3][1] * y[21]; a0 -= mq[3][2] * x[22]; b0 -= mq[3][2] * y[22]; a1 -= mq[3][3] * x[23]; b1 -= mq[3][3] * y[23]; mq[3] = *(const LAS f32x4*)(Mg + 3628);
            a0 -= mq[4][0] * x[24]; b0 -= mq[4][0] * y[24]; a1 -= mq[4][1] * x[25]; b1 -= mq[4][1] * y[25]; a0 -= mq[4][2] * x[26]; b0 -= mq[4][2] * y[26]; a1 -= mq[4][3] * x[27]; b1 -= mq[4][3] * y[27]; mq[4] = *(const LAS f32x4*)(Mg + 3632);
            a0 -= mq[5][0] * x[28]; b0 -= mq[5][0] * y[28]; a1 -= mq[5][1] * x[29]; b1 -= mq[5][1] * y[29]; a0 -= mq[5][2] * x[30]; b0 -= mq[5][2] * y[30]; a1 -= mq[5][3] * x[31]; b1 -= mq[5][3] * y[31]; mq[5] = *(const LAS f32x4*)(Mg + 3636);
            a0 -= mq[0][0] * x[32]; b0 -= mq[0][0] * y[32]; a1 -= mq[0][1] * x[33]; b1 -= mq[0][1] * y[33]; a0 -= mq[0][2] * x[34]; b0 -= mq[0][2] * y[34]; a1 -= mq[0][3] * x[35]; b1 -= mq[0][3] * y[35]; mq[0] = *(const LAS f32x4*)(Mg + 3648);
            a0 -= mq[1][0] * x[36]; b0 -= mq[1][0] * y[36]; a1 -= mq[1][1] * x[37]; b1 -= mq[1][1] * y[37]; a0 -= mq[1][2] * x[38]; b0 -= mq[1][2] * y[38]; a1 -= mq[1][3] * x[39]; b1 -= mq[1][3] * y[39]; mq[1] = *(const LAS f32x4*)(Mg + 3652);
            a0 -= mq[2][0] * x[40]; b0 -= mq[2][0] * y[40]; a1 -= mq[2][1] * x[41]; b1 -= mq[2][1] * y[41]; a0 -= mq[2][2] * x[42]; b0 -= mq[2][2] * y[42]; a1 -= mq[2][3] * x[43]; b1 -= mq[2][3] * y[43]; mq[2] = *(const LAS f32x4*)(Mg + 3656);
            a0 -= mq[3][0] * x[44]; b0 -= mq[3][0] * y[44]; a1 -= mq[3][1] * x[45]; b1 -= mq[3][1] * y[45]; a0 -= mq[3][2] * x[46]; b0 -= mq[3][2] * y[46]; a1 -= mq[3][3] * x[47]; b1 -= mq[3][3] * y[47]; mq[3] = *(const LAS f32x4*)(Mg + 3660);
            a0 -= mq[4][0] * x[48]; b0 -= mq[4][0] * y[48]; a1 -= mq[4][1] * x[49]; b1 -= mq[4][1] * y[49]; a0 -= mq[4][2] * x[50]; b0 -= mq[4][2] * y[50]; a1 -= mq[4][3] * x[51]; b1 -= mq[4][3] * y[51]; mq[4] = *(const LAS f32x4*)(Mg + 3664);
            a0 -= mq[5][0] * x[52]; b0 -= mq[5][0] * y[52]; a1 -= mq[5][1] * x[53]; b1 -= mq[5][1] * y[53]; a0 -= mq[5][2] * x[54]; b0 -= mq[5][2] * y[54]; a1 -= mq[5][3] * x[55]; b1 -= mq[5][3] * y[55]; x[56] = a0 + a1; y[56] = b0 + b1; up[7168] = x[56]; wp[7168] = f2bf(-y[56]); mq[5] = *(const LAS f32x4*)(Mg + 3668);
            { const float br = betg[57]; a0 = bf2f(*(const LAS bf16_t*)(lg + P5_VS + 15504 + c * 2)) * br; b0 = bf2f(*(const LAS bf16_t*)(lg + P5_KS + 15504 + c * 2)) * br * __expf(decg[57]); a1 = 0.f; b1 = 0.f; } a0 -= mq[0][0] * x[0]; b0 -= mq[0][0] * y[0]; a1 -= mq[0][1] * x[1]; b1 -= mq[0][1] * y[1]; a0 -= mq[0][2] * x[2]; b0 -= mq[0][2] * y[2]; a1 -= mq[0][3] * x[3]; b1 -= mq[0][3] * y[3]; mq[0] = *(const LAS f32x4*)(Mg + 3672);
            a0 -= mq[1][0] * x[4]; b0 -= mq[1][0] * y[4]; a1 -= mq[1][1] * x[5]; b1 -= mq[1][1] * y[5]; a0 -= mq[1][2] * x[6]; b0 -= mq[1][2] * y[6]; a1 -= mq[1][3] * x[7]; b1 -= mq[1][3] * y[7]; mq[1] = *(const LAS f32x4*)(Mg + 3676);
            a0 -= mq[2][0] * x[8]; b0 -= mq[2][0] * y[8]; a1 -= mq[2][1] * x[9]; b1 -= mq[2][1] * y[9]; a0 -= mq[2][2] * x[10]; b0 -= mq[2][2] * y[10]; a1 -= mq[2][3] * x[11]; b1 -= mq[2][3] * y[11]; mq[2] = *(const LAS f32x4*)(Mg + 3680);
            a0 -= mq[3][0] * x[12]; b0 -= mq[3][0] * y[12]; a1 -= mq[3][1] * x[13]; b1 -= mq[3][1] * y[13]; a0 -= mq[3][2] * x[14]; b0 -= mq[3][2] * y[14]; a1 -= mq[3][3] * x[15]; b1 -= mq[3][3] * y[15]; mq[3] = *(const LAS f32x4*)(Mg + 3684);
            a0 -= mq[4][0] * x[16]; b0 -= mq[4][0] * y[16]; a1 -= mq[4][1] * x[17]; b1 -= mq[4][1] * y[17]; a0 -= mq[4][2] * x[18]; b0 -= mq[4][2] * y[18]; a1 -= mq[4][3] * x[19]; b1 -= mq[4][3] * y[19]; mq[4] = *(const LAS f32x4*)(Mg + 3688);
            a0 -= mq[5][0] * x[20]; b0 -= mq[5][0] * y[20]; a1 -= mq[5][1] * x[21]; b1 -= mq[5][1] * y[21]; a0 -= mq[5][2] * x[22]; b0 -= mq[5][2] * y[22]; a1 -= mq[5][3] * x[23]; b1 -= mq[5][3] * y[23]; mq[5] = *(const LAS f32x4*)(Mg + 3692);
            a0 -= mq[0][0] * x[24]; b0 -= mq[0][0] * y[24]; a1 -= mq[0][1] * x[25]; b1 -= mq[0][1] * y[25]; a0 -= mq[0][2] * x[26]; b0 -= mq[0][2] * y[26]; a1 -= mq[0][3] * x[27]; b1 -= mq[0][3] * y[27]; mq[0] = *(const LAS f32x4*)(Mg + 3696);
            a0 -= mq[1][0] * x[28]; b0 -= mq[1][0] * y[28]; a1 -= mq[1][1] * x[29]; b1 -= mq[1][1] * y[29]; a0 -= mq[1][2] * x[30]; b0 -= mq[1][2] * y[30]; a1 -= mq[1][3] * x[31]; b1 -= mq[1][3] * y[31]; mq[1] = *(const LAS f32x4*)(Mg + 3700);
            a0 -= mq[2][0] * x[32]; b0 -= mq[2][0] * y[32]; a1 -= mq[2][1] * x[33]; b1 -= mq[2][1] * y[33]; a0 -= mq[2][2] * x[34]; b0 -= mq[2][2] * y[34]; a1 -= mq[2][3] * x[35]; b1 -= mq[2][3] * y[35]; mq[2] = *(const LAS f32x4*)(Mg + 3704);
            a0 -= mq[3][0] * x[36]; b0 -= mq[3][0] * y[36]; a1 -= mq[3][1] * x[37]; b1 -= mq[3][1] * y[37]; a0 -= mq[3][2] * x[38]; b0 -= mq[3][2] * y[38]; a1 -= mq[3][3] * x[39]; b1 -= mq[3][3] * y[39]; mq[3] = *(const LAS f32x4*)(Mg + 3712);
            a0 -= mq[4][0] * x[40]; b0 -= mq[4][0] * y[40]; a1 -= mq[4][1] * x[41]; b1 -= mq[4][1] * y[41]; a0 -= mq[4][2] * x[42]; b0 -= mq[4][2] * y[42]; a1 -= mq[4][3] * x[43]; b1 -= mq[4][3] * y[43]; mq[4] = *(const LAS f32x4*)(Mg + 3716);
            a0 -= mq[5][0] * x[44]; b0 -= mq[5][0] * y[44]; a1 -= mq[5][1] * x[45]; b1 -= mq[5][1] * y[45]; a0 -= mq[5][2] * x[46]; b0 -= mq[5][2] * y[46]; a1 -= mq[5][3] * x[47]; b1 -= mq[5][3] * y[47]; mq[5] = *(const LAS f32x4*)(Mg + 3720);
            a0 -= mq[0][0] * x[48]; b0 -= mq[0][0] * y[48]; a1 -= mq[0][1] * x[49]; b1 -= mq[0][1] * y[49]; a0 -= mq[0][2] * x[50]; b0 -= mq[0][2] * y[50]; a1 -= mq[0][3] * x[51]; b1 -= mq[0][3] * y[51]; mq[0] = *(const LAS f32x4*)(Mg + 3724);
            a0 -= mq[1][0] * x[52]; b0 -= mq[1][0] * y[52]; a1 -= mq[1][1] * x[53]; b1 -= mq[1][1] * y[53]; a0 -= mq[1][2] * x[54]; b0 -= mq[1][2] * y[54]; a1 -= mq[1][3] * x[55]; b1 -= mq[1][3] * y[55]; mq[1] = *(const LAS f32x4*)(Mg + 3728);
            a0 -= mq[2][0] * x[56]; b0 -= mq[2][0] * y[56]; x[57] = a0 + a1; y[57] = b0 + b1; up[7296] = x[57]; wp[7296] = f2bf(-y[57]); mq[2] = *(const LAS f32x4*)(Mg + 3732);
            { const float br = betg[58]; a0 = bf2f(*(const LAS bf16_t*)(lg + P5_VS + 15776 + c * 2)) * br; b0 = bf2f(*(const LAS bf16_t*)(lg + P5_KS + 15776 + c * 2)) * br * __expf(decg[58]); a1 = 0.f; b1 = 0.f; } a0 -= mq[3][0] * x[0]; b0 -= mq[3][0] * y[0]; a1 -= mq[3][1] * x[1]; b1 -= mq[3][1] * y[1]; a0 -= mq[3][2] * x[2]; b0 -= mq[3][2] * y[2]; a1 -= mq[3][3] * x[3]; b1 -= mq[3][3] * y[3]; mq[3] = *(const LAS f32x4*)(Mg + 3736);
            a0 -= mq[4][0] * x[4]; b0 -= mq[4][0] * y[4]; a1 -= mq[4][1] * x[5]; b1 -= mq[4][1] * y[5]; a0 -= mq[4][2] * x[6]; b0 -= mq[4][2] * y[6]; a1 -= mq[4][3] * x[7]; b1 -= mq[4][3] * y[7]; mq[4] = *(const LAS f32x4*)(Mg + 3740);
            a0 -= mq[5][0] * x[8]; b0 -= mq[5][0] * y[8]; a1 -= mq[5][1] * x[9]; b1 -= mq[5][1] * y[9]; a0 -= mq[5][2] * x[10]; b0 -= mq[5][2] * y[10]; a1 -= mq[5][3] * x[11]; b1 -= mq[5][3] * y[11]; mq[5] = *(const LAS f32x4*)(Mg + 3744);
            a0 -= mq[0][0] * x[12]; b0 -= mq[0][0] * y[12]; a1 -= mq[0][1] * x[13]; b1 -= mq[0][1] * y[13]; a0 -= mq[0][2] * x[14]; b0 -= mq[0][2] * y[14]; a1 -= mq[0][3] * x[15]; b1 -= mq[0][3] * y[15]; mq[0] = *(const LAS f32x4*)(Mg + 3748);
            a0 -= mq[1][0] * x[16]; b0 -= mq[1][0] * y[16]; a1 -= mq[1][1] * x[17]; b1 -= mq[1][1] * y[17]; a0 -= mq[1][2] * x[18]; b0 -= mq[1][2] * y[18]; a1 -= mq[1][3] * x[19]; b1 -= mq[1][3] * y[19]; mq[1] = *(const LAS f32x4*)(Mg + 3752);
            a0 -= mq[2][0] * x[20]; b0 -= mq[2][0] * y[20]; a1 -= mq[2][1] * x[21]; b1 -= mq[2][1] * y[21]; a0 -= mq[2][2] * x[22]; b0 -= mq[2][2] * y[22]; a1 -= mq[2][3] * x[23]; b1 -= mq[2][3] * y[23]; mq[2] = *(const LAS f32x4*)(Mg + 3756);
            a0 -= mq[3][0] * x[24]; b0 -= mq[3][0] * y[24]; a1 -= mq[3][1] * x[25]; b1 -= mq[3][1] * y[25]; a0 -= mq[3][2] * x[26]; b0 -= mq[3][2] * y[26]; a1 -= mq[3][3] * x[27]; b1 -= mq[3][3] * y[27]; mq[3] = *(const LAS f32x4*)(Mg + 3760);
            a0 -= mq[4][0] * x[28]; b0 -= mq[4][0] * y[28]; a1 -= mq[4][1] * x[29]; b1 -= mq[4][1] * y[29]; a0 -= mq[4][2] * x[30]; b0 -= mq[4][2] * y[30]; a1 -= mq[4][3] * x[31]; b1 -= mq[4][3] * y[31]; mq[4] = *(const LAS f32x4*)(Mg + 3764);
            a0 -= mq[5][0] * x[32]; b0 -= mq[5][0] * y[32]; a1 -= mq[5][1] * x[33]; b1 -= mq[5][1] * y[33]; a0 -= mq[5][2] * x[34]; b0 -= mq[5][2] * y[34]; a1 -= mq[5][3] * x[35]; b1 -= mq[5][3] * y[35]; mq[5] = *(const LAS f32x4*)(Mg + 3768);
            a0 -= mq[0][0] * x[36]; b0 -= mq[0][0] * y[36]; a1 -= mq[0][1] * x[37]; b1 -= mq[0][1] * y[37]; a0 -= mq[0][2] * x[38]; b0 -= mq[0][2] * y[38]; a1 -= mq[0][3] * x[39]; b1 -= mq[0][3] * y[39]; mq[0] = *(const LAS f32x4*)(Mg + 3776);
            a0 -= mq[1][0] * x[40]; b0 -= mq[1][0] * y[40]; a1 -= mq[1][1] * x[41]; b1 -= mq[1][1] * y[41]; a0 -= mq[1][2] * x[42]; b0 -= mq[1][2] * y[42]; a1 -= mq[1][3] * x[43]; b1 -= mq[1][3] * y[43]; mq[1] = *(const LAS f32x4*)(Mg + 3780);
            a0 -= mq[2][0] * x[44]; b0 -= mq[2][0] * y[44]; a1 -= mq[2][1] * x[45]; b1 -= mq[2][1] * y[45]; a0 -= mq[2][2] * x[46]; b0 -= mq[2][2] * y[46]; a1 -= mq[2][3] * x[47]; b1 -= mq[2][3] * y[47]; mq[2] = *(const LAS f32x4*)(Mg + 3784);
            a0 -= mq[3][0] * x[48]; b0 -= mq[3][0] * y[48]; a1 -= mq[3][1] * x[49]; b1 -= mq[3][1] * y[49]; a0 -= mq[3][2] * x[50]; b0 -= mq[3][2] * y[50]; a1 -= mq[3][3] * x[51]; b1 -= mq[3][3] * y[51]; mq[3] = *(const LAS f32x4*)(Mg + 3788);
            a0 -= mq[4][0] * x[52]; b0 -= mq[4][0] * y[52]; a1 -= mq[4][1] * x[53]; b1 -= mq[4][1] * y[53]; a0 -= mq[4][2] * x[54]; b0 -= mq[4][2] * y[54]; a1 -= mq[4][3] * x[55]; b1 -= mq[4][3] * y[55]; mq[4] = *(const LAS f32x4*)(Mg + 3792);
            a0 -= mq[5][0] * x[56]; b0 -= mq[5][0] * y[56]; a1 -= mq[5][1] * x[57]; b1 -= mq[5][1] * y[57]; x[58] = a0 + a1; y[58] = b0 + b1; up[7424] = x[58]; wp[7424] = f2bf(-y[58]); mq[5] = *(const LAS f32x4*)(Mg + 3796);
            { const float br = betg[59]; a0 = bf2f(*(const LAS bf16_t*)(lg + P5_VS + 16048 + c * 2)) * br; b0 = bf2f(*(const LAS bf16_t*)(lg + P5_KS + 16048 + c * 2)) * br * __expf(decg[59]); a1 = 0.f; b1 = 0.f; } a0 -= mq[0][0] * x[0]; b0 -= mq[0][0] * y[0]; a1 -= mq[0][1] * x[1]; b1 -= mq[0][1] * y[1]; a0 -= mq[0][2] * x[2]; b0 -= mq[0][2] * y[2]; a1 -= mq[0][3] * x[3]; b1 -= mq[0][3] * y[3]; mq[0] = *(const LAS f32x4*)(Mg + 3800);
            a0 -= mq[1][0] * x[4]; b0 -= mq[1][0] * y[4]; a1 -= mq[1][1] * x[5]; b1 -= mq[1][1] * y[5]; a0 -= mq[1][2] * x[6]; b0 -= mq[1][2] * y[6]; a1 -= mq[1][3] * x[7]; b1 -= mq[1][3] * y[7]; mq[1] = *(const LAS f32x4*)(Mg + 3804);
            a0 -= mq[2][0] * x[8]; b0 -= mq[2][0] * y[8]; a1 -= mq[2][1] * x[9]; b1 -= mq[2][1] * y[9]; a0 -= mq[2][2] * x[10]; b0 -= mq[2][2] * y[10]; a1 -= mq[2][3] * x[11]; b1 -= mq[2][3] * y[11]; mq[2] = *(const LAS f32x4*)(Mg + 3808);
            a0 -= mq[3][0] * x[12]; b0 -= mq[3][0] * y[12]; a1 -= mq[3][1] * x[13]; b1 -= mq[3][1] * y[13]; a0 -= mq[3][2] * x[14]; b0 -= mq[3][2] * y[14]; a1 -= mq[3][3] * x[15]; b1 -= mq[3][3] * y[15]; mq[3] = *(const LAS f32x4*)(Mg + 3812);
            a0 -= mq[4][0] * x[16]; b0 -= mq[4][0] * y[16]; a1 -= mq[4][1] * x[17]; b1 -= mq[4][1] * y[17]; a0 -= mq[4][2] * x[18]; b0 -= mq[4][2] * y[18]; a1 -= mq[4][3] * x[19]; b1 -= mq[4][3] * y[19]; mq[4] = *(const LAS f32x4*)(Mg + 3816);
            a0 -= mq[5][0] * x[20]; b0 -= mq[5][0] * y[20]; a1 -= mq[5][1] * x[21]; b1 -= mq[5][1] * y[21]; a0 -= mq[5][2] * x[22]; b0 -= mq[5][2] * y[22]; a1 -= mq[5][3] * x[23]; b1 -= mq[5][3] * y[23]; mq[5] = *(const LAS f32x4*)(Mg + 3820);
            a0 -= mq[0][0] * x[24]; b0 -= mq[0][0] * y[24]; a1 -= mq[0][1] * x[25]; b1 -= mq[0][1] * y[25]; a0 -= mq[0][2] * x[26]; b0 -= mq[0][2] * y[26]; a1 -= mq[0][3] * x[27]; b1 -= mq[0][3] * y[27]; mq[0] = *(const LAS f32x4*)(Mg + 3824);
            a0 -= mq[1][0] * x[28]; b0 -= mq[1][0] * y[28]; a1 -= mq[1][1] * x[29]; b1 -= mq[1][1] * y[29]; a0 -= mq[1][2] * x[30]; b0 -= mq[1][2] * y[30]; a1 -= mq[1][3] * x[31]; b1 -= mq[1][3] * y[31]; mq[1] = *(const LAS f32x4*)(Mg + 3828);
            a0 -= mq[2][0] * x[32]; b0 -= mq[2][0] * y[32]; a1 -= mq[2][1] * x[33]; b1 -= mq[2][1] * y[33]; a0 -= mq[2][2] * x[34]; b0 -= mq[2][2] * y[34]; a1 -= mq[2][3] * x[35]; b1 -= mq[2][3] * y[35]; mq[2] = *(const LAS f32x4*)(Mg + 3832);
            a0 -= mq[3][0] * x[36]; b0 -= mq[3][0] * y[36]; a1 -= mq[3][1] * x[37]; b1 -= mq[3][1] * y[37]; a0 -= mq[3][2] * x[38]; b0 -= mq[3][2] * y[38]; a1 -= mq[3][3] * x[39]; b1 -= mq[3][3] * y[39]; mq[3] = *(const LAS f32x4*)(Mg + 3840);
            a0 -= mq[4][0] * x[40]; b0 -= mq[4][0] * y[40]; a1 -= mq[4][1] * x[41]; b1 -= mq[4][1] * y[41]; a0 -= mq[4][2] * x[42]; b0 -= mq[4][2] * y[42]; a1 -= mq[4][3] * x[43]; b1 -= mq[4][3] * y[43]; mq[4] = *(const LAS f32x4*)(Mg + 3844);
            a0 -= mq[5][0] * x[44]; b0 -= mq[5][0] * y[44]; a1 -= mq[5][1] * x[45]; b1 -= mq[5][1] * y[45]; a0 -= mq[5][2] * x[46]; b0 -= mq[5][2] * y[46]; a1 -= mq[5][3] * x[47]; b1 -= mq[5][3] * y[47]; mq[5] = *(const LAS f32x4*)(Mg + 3848);
            a0 -= mq[0][0] * x[48]; b0 -= mq[0][0] * y[48]; a1 -= mq[0][1] * x[49]; b1 -= mq[0][1] * y[49]; a0 -= mq[0][2] * x[50]; b0 -= mq[0][2] * y[50]; a1 -= mq[0][3] * x[51]; b1 -= mq[0][3] * y[51]; mq[0] = *(const LAS f32x4*)(Mg + 3852);
            a0 -= mq[1][0] * x[52]; b0 -= mq[1][0] * y[52]; a1 -= mq[1][1] * x[53]; b1 -= mq[1][1] * y[53]; a0 -= mq[1][2] * x[54]; b0 -= mq[1][2] * y[54]; a1 -= mq[1][3] * x[55]; b1 -= mq[1][3] * y[55]; mq[1] = *(const LAS f32x4*)(Mg + 3856);
            a0 -= mq[2][0] * x[56]; b0 -= mq[2][0] * y[56]; a1 -= mq[2][1] * x[57]; b1 -= mq[2][1] * y[57]; a0 -= mq[2][2] * x[58]; b0 -= mq[2][2] * y[58]; x[59] = a0 + a1; y[59] = b0 + b1; up[7552] = x[59]; wp[7552] = f2bf(-y[59]); mq[2] = *(const LAS f32x4*)(Mg + 3860);
            { const float br = betg[60]; a0 = bf2f(*(const LAS bf16_t*)(lg + P5_VS + 16320 + c * 2)) * br; b0 = bf2f(*(const LAS bf16_t*)(lg + P5_KS + 16320 + c * 2)) * br * __expf(decg[60]); a1 = 0.f; b1 = 0.f; } a0 -= mq[3][0] * x[0]; b0 -= mq[3][0] * y[0]; a1 -= mq[3][1] * x[1]; b1 -= mq[3][1] * y[1]; a0 -= mq[3][2] * x[2]; b0 -= mq[3][2] * y[2]; a1 -= mq[3][3] * x[3]; b1 -= mq[3][3] * y[3]; mq[3] = *(const LAS f32x4*)(Mg + 3864);
            a0 -= mq[4][0] * x[4]; b0 -= mq[4][0] * y[4]; a1 -= mq[4][1] * x[5]; b1 -= mq[4][1] * y[5]; a0 -= mq[4][2] * x[6]; b0 -= mq[4][2] * y[6]; a1 -= mq[4][3] * x[7]; b1 -= mq[4][3] * y[7]; mq[4] = *(const LAS f32x4*)(Mg + 3868);
            a0 -= mq[5][0] * x[8]; b0 -= mq[5][0] * y[8]; a1 -= mq[5][1] * x[9]; b1 -= mq[5][1] * y[9]; a0 -= mq[5][2] * x[10]; b0 -= mq[5][2] * y[10]; a1 -= mq[5][3] * x[11]; b1 -= mq[5][3] * y[11]; mq[5] = *(const LAS f32x4*)(Mg + 3872);
            a0 -= mq[0][0] * x[12]; b0 -= mq[0][0] * y[12]; a1 -= mq[0][1] * x[13]; b1 -= mq[0][1] * y[13]; a0 -= mq[0][2] * x[14]; b0 -= mq[0][2] * y[14]; a1 -= mq[0][3] * x[15]; b1 -= mq[0][3] * y[15]; mq[0] = *(const LAS f32x4*)(Mg + 3876);
            a0 -= mq[1][0] * x[16]; b0 -= mq[1][0] * y[16]; a1 -= mq[1][1] * x[17]; b1 -= mq[1][1] * y[17]; a0 -= mq[1][2] * x[18]; b0 -= mq[1][2] * y[18]; a1 -= mq[1][3] * x[19]; b1 -= mq[1][3] * y[19]; mq[1] = *(const LAS f32x4*)(Mg + 3880);
            a0 -= mq[2][0] * x[20]; b0 -= mq[2][0] * y[20]; a1 -= mq[2][1] * x[21]; b1 -= mq[2][1] * y[21]; a0 -= mq[2][2] * x[22]; b0 -= mq[2][2] * y[22]; a1 -= mq[2][3] * x[23]; b1 -= mq[2][3] * y[23]; mq[2] = *(const LAS f32x4*)(Mg + 3884);
            a0 -= mq[3][0] * x[24]; b0 -= mq[3][0] * y[24]; a1 -= mq[3][1] * x[25]; b1 -= mq[3][1] * y[25]; a0 -= mq[3][2] * x[26]; b0 -= mq[3][2] * y[26]; a1 -= mq[3][3] * x[27]; b1 -= mq[3][3] * y[27]; mq[3] = *(const LAS f32x4*)(Mg + 3888);
            a0 -= mq[4][0] * x[28]; b0 -= mq[4][0] * y[28]; a1 -= mq[4][1] * x[29]; b1 -= mq[4][1] * y[29]; a0 -= mq[4][2] * x[30]; b0 -= mq[4][2] * y[30]; a1 -= mq[4][3] * x[31]; b1 -= mq[4][3] * y[31]; mq[4] = *(const LAS f32x4*)(Mg + 3892);
            a0 -= mq[5][0] * x[32]; b0 -= mq[5][0] * y[32]; a1 -= mq[5][1] * x[33]; b1 -= mq[5][1] * y[33]; a0 -= mq[5][2] * x[34]; b0 -= mq[5][2] * y[34]; a1 -= mq[5][3] * x[35]; b1 -= mq[5][3] * y[35]; mq[5] = *(const LAS f32x4*)(Mg + 3896);
            a0 -= mq[0][0] * x[36]; b0 -= mq[0][0] * y[36]; a1 -= mq[0][1] * x[37]; b1 -= mq[0][1] * y[37]; a0 -= mq[0][2] * x[38]; b0 -= mq[0][2] * y[38]; a1 -= mq[0][3] * x[39]; b1 -= mq[0][3] * y[39]; mq[0] = *(const LAS f32x4*)(Mg + 3904);
            a0 -= mq[1][0] * x[40]; b0 -= mq[1][0] * y[40]; a1 -= mq[1][1] * x[41]; b1 -= mq[1][1] * y[41]; a0 -= mq[1][2] * x[42]; b0 -= mq[1][2] * y[42]; a1 -= mq[1][3] * x[43]; b1 -= mq[1][3] * y[43]; mq[1] = *(const LAS f32x4*)(Mg + 3908);
            a0 -= mq[2][0] * x[44]; b0 -= mq[2][0] * y[44]; a1 -= mq[2][1] * x[45]; b1 -= mq[2][1] * y[45]; a0 -= mq[2][2] * x[46]; b0 -= mq[2][2] * y[46]; a1 -= mq[2][3] * x[47]; b1 -= mq[2][3] * y[47]; mq[2] = *(const LAS f32x4*)(Mg + 3912);
            a0 -= mq[3][0] * x[48]; b0 -= mq[3][0] * y[48]; a1 -= mq[3][1] * x[49]; b1 -= mq[3][1] * y[49]; a0 -= mq[3][2] * x[50]; b0 -= mq[3][2] * y[50]; a1 -= mq[3][3] * x[51]; b1 -= mq[3][3] * y[51]; mq[3] = *(const LAS f32x4*)(Mg + 3916);
            a0 -= mq[4][0] * x[52]; b0 -= mq[4][0] * y[52]; a1 -= mq[4][1] * x[53]; b1 -= mq[4][1] * y[53]; a0 -= mq[4][2] * x[54]; b0 -= mq[4][2] * y[54]; a1 -= mq[4][3] * x[55]; b1 -= mq[4][3] * y[55]; mq[4] = *(const LAS f32x4*)(Mg + 3920);
            a0 -= mq[5][0] * x[56]; b0 -= mq[5][0] * y[56]; a1 -= mq[5][1] * x[57]; b1 -= mq[5][1] * y[57]; a0 -= mq[5][2] * x[58]; b0 -= mq[5][2] * y[58]; a1 -= mq[5][3] * x[59]; b1 -= mq[5][3] * y[59]; x[60] = a0 + a1; y[60] = b0 + b1; up[7680] = x[60]; wp[7680] = f2bf(-y[60]); mq[5] = *(const LAS f32x4*)(Mg + 3924);
            { const float br = betg[61]; a0 = bf2f(*(const LAS bf16_t*)(lg + P5_VS + 16592 + c * 2)) * br; b0 = bf2f(*(const LAS bf16_t*)(lg + P5_KS + 16592 + c * 2)) * br * __expf(decg[61]); a1 = 0.f; b1 = 0.f; } a0 -= mq[0][0] * x[0]; b0 -= mq[0][0] * y[0]; a1 -= mq[0][1] * x[1]; b1 -= mq[0][1] * y[1]; a0 -= mq[0][2] * x[2]; b0 -= mq[0][2] * y[2]; a1 -= mq[0][3] * x[3]; b1 -= mq[0][3] * y[3]; mq[0] = *(const LAS f32x4*)(Mg + 3928);
            a0 -= mq[1][0] * x[4]; b0 -= mq[1][0] * y[4]; a1 -= mq[1][1] * x[5]; b1 -= mq[1][1] * y[5]; a0 -= mq[1][2] * x[6]; b0 -= mq[1][2] * y[6]; a1 -= mq[1][3] * x[7]; b1 -= mq[1][3] * y[7]; mq[1] = *(const LAS f32x4*)(Mg + 3932);
            a0 -= mq[2][0] * x[8]; b0 -= mq[2][0] * y[8]; a1 -= mq[2][1] * x[9]; b1 -= mq[2][1] * y[9]; a0 -= mq[2][2] * x[10]; b0 -= mq[2][2] * y[10]; a1 -= mq[2][3] * x[11]; b1 -= mq[2][3] * y[11]; mq[2] = *(const LAS f32x4*)(Mg + 3936);
            a0 -= mq[3][0] * x[12]; b0 -= mq[3][0] * y[12]; a1 -= mq[3][1] * x[13]; b1 -= mq[3][1] * y[13]; a0 -= mq[3][2] * x[14]; b0 -= mq[3][2] * y[14]; a1 -= mq[3][3] * x[15]; b1 -= mq[3][3] * y[15]; mq[3] = *(const LAS f32x4*)(Mg + 3940);
            a0 -= mq[4][0] * x[16]; b0 -= mq[4][0] * y[16]; a1 -= mq[4][1] * x[17]; b1 -= mq[4][1] * y[17]; a0 -= mq[4][2] * x[18]; b0 -= mq[4][2] * y[18]; a1 -= mq[4][3] * x[19]; b1 -= mq[4][3] * y[19]; mq[4] = *(const LAS f32x4*)(Mg + 3944);
            a0 -= mq[5][0] * x[20]; b0 -= mq[5][0] * y[20]; a1 -= mq[5][1] * x[21]; b1 -= mq[5][1] * y[21]; a0 -= mq[5][2] * x[22]; b0 -= mq[5][2] * y[22]; a1 -= mq[5][3] * x[23]; b1 -= mq[5][3] * y[23]; mq[5] = *(const LAS f32x4*)(Mg + 3948);
            a0 -= mq[0][0] * x[24]; b0 -= mq[0][0] * y[24]; a1 -= mq[0][1] * x[25]; b1 -= mq[0][1] * y[25]; a0 -= mq[0][2] * x[26]; b0 -= mq[0][2] * y[26]; a1 -= mq[0][3] * x[27]; b1 -= mq[0][3] * y[27]; mq[0] = *(const LAS f32x4*)(Mg + 3952);
            a0 -= mq[1][0] * x[28]; b0 -= mq[1][0] * y[28]; a1 -= mq[1][1] * x[29]; b1 -= mq[1][1] * y[29]; a0 -= mq[1][2] * x[30]; b0 -= mq[1][2] * y[30]; a1 -= mq[1][3] * x[31]; b1 -= mq[1][3] * y[31]; mq[1] = *(const LAS f32x4*)(Mg + 3956);
            a0 -= mq[2][0] * x[32]; b0 -= mq[2][0] * y[32]; a1 -= mq[2][1] * x[33]; b1 -= mq[2][1] * y[33]; a0 -= mq[2][2] * x[34]; b0 -= mq[2][2] * y[34]; a1 -= mq[2][3] * x[35]; b1 -= mq[2][3] * y[35]; mq[2] = *(const LAS f32x4*)(Mg + 3960);
            a0 -= mq[3][0] * x[36]; b0 -= mq[3][0] * y[36]; a1 -= mq[3][1] * x[37]; b1 -= mq[3][1] * y[37]; a0 -= mq[3][2] * x[38]; b0 -= mq[3][2] * y[38]; a1 -= mq[3][3] * x[39]; b1 -= mq[3][3] * y[39]; mq[3] = *(const LAS f32x4*)(Mg + 3964);
            a0 -= mq[4][0] * x[40]; b0 -= mq[4][0] * y[40]; a1 -= mq[4][1] * x[41]; b1 -= mq[4][1] * y[41]; a0 -= mq[4][2] * x[42]; b0 -= mq[4][2] * y[42]; a1 -= mq[4][3] * x[43]; b1 -= mq[4][3] * y[43]; mq[4] = *(const LAS f32x4*)(Mg + 3968);
            a0 -= mq[5][0] * x[44]; b0 -= mq[5][0] * y[44]; a1 -= mq[5][1] * x[45]; b1 -= mq[5][1] * y[45]; a0 -= mq[5][2] * x[46]; b0 -= mq[5][2] * y[46]; a1 -= mq[5][3] * x[47]; b1 -= mq[5][3] * y[47]; mq[5] = *(const LAS f32x4*)(Mg + 3972);
            a0 -= mq[0][0] * x[48]; b0 -= mq[0][0] * y[48]; a1 -= mq[0][1] * x[49]; b1 -= mq[0][1] * y[49]; a0 -= mq[0][2] * x[50]; b0 -= mq[0][2] * y[50]; a1 -= mq[0][3] * x[51]; b1 -= mq[0][3] * y[51]; mq[0] = *(const LAS f32x4*)(Mg + 3976);
            a0 -= mq[1][0] * x[52]; b0 -= mq[1][0] * y[52]; a1 -= mq[1][1] * x[53]; b1 -= mq[1][1] * y[53]; a0 -= mq[1][2] * x[54]; b0 -= mq[1][2] * y[54]; a1 -= mq[1][3] * x[55]; b1 -= mq[1][3] * y[55]; mq[1] = *(const LAS f32x4*)(Mg + 3980);
            a0 -= mq[2][0] * x[56]; b0 -= mq[2][0] * y[56]; a1 -= mq[2][1] * x[57]; b1 -= mq[2][1] * y[57]; a0 -= mq[2][2] * x[58]; b0 -= mq[2][2] * y[58]; a1 -= mq[2][3] * x[59]; b1 -= mq[2][3] * y[59]; mq[2] = *(const LAS f32x4*)(Mg + 3984);
            a0 -= mq[3][0] * x[60]; b0 -= mq[3][0] * y[60]; x[61] = a0 + a1; y[61] = b0 + b1; up[7808] = x[61]; wp[7808] = f2bf(-y[61]); mq[3] = *(const LAS f32x4*)(Mg + 3988);
            { const float br = betg[62]; a0 = bf2f(*(const LAS bf16_t*)(lg + P5_VS + 16864 + c * 2)) * br; b0 = bf2f(*(const LAS bf16_t*)(lg + P5_KS + 16864 + c * 2)) * br * __expf(decg[62]); a1 = 0.f; b1 = 0.f; } a0 -= mq[4][0] * x[0]; b0 -= mq[4][0] * y[0]; a1 -= mq[4][1] * x[1]; b1 -= mq[4][1] * y[1]; a0 -= mq[4][2] * x[2]; b0 -= mq[4][2] * y[2]; a1 -= mq[4][3] * x[3]; b1 -= mq[4][3] * y[3]; mq[4] = *(const LAS f32x4*)(Mg + 3992);
            a0 -= mq[5][0] * x[4]; b0 -= mq[5][0] * y[4]; a1 -= mq[5][1] * x[5]; b1 -= mq[5][1] * y[5]; a0 -= mq[5][2] * x[6]; b0 -= mq[5][2] * y[6]; a1 -= mq[5][3] * x[7]; b1 -= mq[5][3] * y[7]; mq[5] = *(const LAS f32x4*)(Mg + 3996);
            a0 -= mq[0][0] * x[8]; b0 -= mq[0][0] * y[8]; a1 -= mq[0][1] * x[9]; b1 -= mq[0][1] * y[9]; a0 -= mq[0][2] * x[10]; b0 -= mq[0][2] * y[10]; a1 -= mq[0][3] * x[11]; b1 -= mq[0][3] * y[11]; mq[0] = *(const LAS f32x4*)(Mg + 4000);
            a0 -= mq[1][0] * x[12]; b0 -= mq[1][0] * y[12]; a1 -= mq[1][1] * x[13]; b1 -= mq[1][1] * y[13]; a0 -= mq[1][2] * x[14]; b0 -= mq[1][2] * y[14]; a1 -= mq[1][3] * x[15]; b1 -= mq[1][3] * y[15]; mq[1] = *(const LAS f32x4*)(Mg + 4004);
            a0 -= mq[2][0] * x[16]; b0 -= mq[2][0] * y[16]; a1 -= mq[2][1] * x[17]; b1 -= mq[2][1] * y[17]; a0 -= mq[2][2] * x[18]; b0 -= mq[2][2] * y[18]; a1 -= mq[2][3] * x[19]; b1 -= mq[2][3] * y[19]; mq[2] = *(const LAS f32x4*)(Mg + 4008);
            a0 -= mq[3][0] * x[20]; b0 -= mq[3][0] * y[20]; a1 -= mq[3][1] * x[21]; b1 -= mq[3][1] * y[21]; a0 -= mq[3][2] * x[22]; b0 -= mq[3][2] * y[22]; a1 -= mq[3][3] * x[23]; b1 -= mq[3][3] * y[23]; mq[3] = *(const LAS f32x4*)(Mg + 4012);
            a0 -= mq[4][0] * x[24]; b0 -= mq[4][0] * y[24]; a1 -= mq[4][1] * x[25]; b1 -= mq[4][1] * y[25]; a0 -= mq[4][2] * x[26]; b0 -= mq[4][2] * y[26]; a1 -= mq[4][3] * x[27]; b1 -= mq[4][3] * y[27]; mq[4] = *(const LAS f32x4*)(Mg + 4016);
            a0 -= mq[5][0] * x[28]; b0 -= mq[5][0] * y[28]; a1 -= mq[5][1] * x[29]; b1 -= mq[5][1] * y[29]; a0 -= mq[5][2] * x[30]; b0 -= mq[5][2] * y[30]; a1 -= mq[5][3] * x[31]; b1 -= mq[5][3] * y[31]; mq[5] = *(const LAS f32x4*)(Mg + 4020);
            a0 -= mq[0][0] * x[32]; b0 -= mq[0][0] * y[32]; a1 -= mq[0][1] * x[33]; b1 -= mq[0][1] * y[33]; a0 -= mq[0][2] * x[34]; b0 -= mq[0][2] * y[34]; a1 -= mq[0][3] * x[35]; b1 -= mq[0][3] * y[35]; mq[0] = *(const LAS f32x4*)(Mg + 4024);
            a0 -= mq[1][0] * x[36]; b0 -= mq[1][0] * y[36]; a1 -= mq[1][1] * x[37]; b1 -= mq[1][1] * y[37]; a0 -= mq[1][2] * x[38]; b0 -= mq[1][2] * y[38]; a1 -= mq[1][3] * x[39]; b1 -= mq[1][3] * y[39]; mq[1] = *(const LAS f32x4*)(Mg + 4028);
            a0 -= mq[2][0] * x[40]; b0 -= mq[2][0] * y[40]; a1 -= mq[2][1] * x[41]; b1 -= mq[2][1] * y[41]; a0 -= mq[2][2] * x[42]; b0 -= mq[2][2] * y[42]; a1 -= mq[2][3] * x[43]; b1 -= mq[2][3] * y[43]; mq[2] = *(const LAS f32x4*)(Mg + 4032);
            a0 -= mq[3][0] * x[44]; b0 -= mq[3][0] * y[44]; a1 -= mq[3][1] * x[45]; b1 -= mq[3][1] * y[45]; a0 -= mq[3][2] * x[46]; b0 -= mq[3][2] * y[46]; a1 -= mq[3][3] * x[47]; b1 -= mq[3][3] * y[47]; mq[3] = *(const LAS f32x4*)(Mg + 4036);
            a0 -= mq[4][0] * x[48]; b0 -= mq[4][0] * y[48]; a1 -= mq[4][1] * x[49]; b1 -= mq[4][1] * y[49]; a0 -= mq[4][2] * x[50]; b0 -= mq[4][2] * y[50]; a1 -= mq[4][3] * x[51]; b1 -= mq[4][3] * y[51]; mq[4] = *(const LAS f32x4*)(Mg + 4040);
            a0 -= mq[5][0] * x[52]; b0 -= mq[5][0] * y[52]; a1 -= mq[5][1] * x[53]; b1 -= mq[5][1] * y[53]; a0 -= mq[5][2] * x[54]; b0 -= mq[5][2] * y[54]; a1 -= mq[5][3] * x[55]; b1 -= mq[5][3] * y[55]; mq[5] = *(const LAS f32x4*)(Mg + 4044);
            a0 -= mq[0][0] * x[56]; b0 -= mq[0][0] * y[56]; a1 -= mq[0][1] * x[57]; b1 -= mq[0][1] * y[57]; a0 -= mq[0][2] * x[58]; b0 -= mq[0][2] * y[58]; a1 -= mq[0][3] * x[59]; b1 -= mq[0][3] * y[59]; mq[0] = *(const LAS f32x4*)(Mg + 4048);
            a0 -= mq[1][0] * x[60]; b0 -= mq[1][0] * y[60]; a1 -= mq[1][1] * x[61]; b1 -= mq[1][1] * y[61]; x[62] = a0 + a1; y[62] = b0 + b1; up[7936] = x[62]; wp[7936] = f2bf(-y[62]); mq[1] = *(const LAS f32x4*)(Mg + 4052);
            { const float br = betg[63]; a0 = bf2f(*(const LAS bf16_t*)(lg + P5_VS + 17136 + c * 2)) * br; b0 = bf2f(*(const LAS bf16_t*)(lg + P5_KS + 17136 + c * 2)) * br * __expf(decg[63]); a1 = 0.f; b1 = 0.f; } a0 -= mq[2][0] * x[0]; b0 -= mq[2][0] * y[0]; a1 -= mq[2][1] * x[1]; b1 -= mq[2][1] * y[1]; a0 -= mq[2][2] * x[2]; b0 -= mq[2][2] * y[2]; a1 -= mq[2][3] * x[3]; b1 -= mq[2][3] * y[3]; mq[2] = *(const LAS f32x4*)(Mg + 4056);
            a0 -= mq[3][0] * x[4]; b0 -= mq[3][0] * y[4]; a1 -= mq[3][1] * x[5]; b1 -= mq[3][1] * y[5]; a0 -= mq[3][2] * x[6]; b0 -= mq[3][2] * y[6]; a1 -= mq[3][3] * x[7]; b1 -= mq[3][3] * y[7]; mq[3] = *(const LAS f32x4*)(Mg + 4060);
            a0 -= mq[4][0] * x[8]; b0 -= mq[4][0] * y[8]; a1 -= mq[4][1] * x[9]; b1 -= mq[4][1] * y[9]; a0 -= mq[4][2] * x[10]; b0 -= mq[4][2] * y[10]; a1 -= mq[4][3] * x[11]; b1 -= mq[4][3] * y[11]; mq[4] = *(const LAS f32x4*)(Mg + 4064);
            a0 -= mq[5][0] * x[12]; b0 -= mq[5][0] * y[12]; a1 -= mq[5][1] * x[13]; b1 -= mq[5][1] * y[13]; a0 -= mq[5][2] * x[14]; b0 -= mq[5][2] * y[14]; a1 -= mq[5][3] * x[15]; b1 -= mq[5][3] * y[15]; mq[5] = *(const LAS f32x4*)(Mg + 4068);
            a0 -= mq[0][0] * x[16]; b0 -= mq[0][0] * y[16]; a1 -= mq[0][1] * x[17]; b1 -= mq[0][1] * y[17]; a0 -= mq[0][2] * x[18]; b0 -= mq[0][2] * y[18]; a1 -= mq[0][3] * x[19]; b1 -= mq[0][3] * y[19]; mq[0] = *(const LAS f32x4*)(Mg + 4072);
            a0 -= mq[1][0] * x[20]; b0 -= mq[1][0] * y[20]; a1 -= mq[1][1] * x[21]; b1 -= mq[1][1] * y[21]; a0 -= mq[1][2] * x[22]; b0 -= mq[1][2] * y[22]; a1 -= mq[1][3] * x[23]; b1 -= mq[1][3] * y[23]; mq[1] = *(const LAS f32x4*)(Mg + 4076);
            a0 -= mq[2][0] * x[24]; b0 -= mq[2][0] * y[24]; a1 -= mq[2][1] * x[25]; b1 -= mq[2][1] * y[25]; a0 -= mq[2][2] * x[26]; b0 -= mq[2][2] * y[26]; a1 -= mq[2][3] * x[27]; b1 -= mq[2][3] * y[27]; mq[2] = *(const LAS f32x4*)(Mg + 4080);
            a0 -= mq[3][0] * x[28]; b0 -= mq[3][0] * y[28]; a1 -= mq[3][1] * x[29]; b1 -= mq[3][1] * y[29]; a0 -= mq[3][2] * x[30]; b0 -= mq[3][2] * y[30]; a1 -= mq[3][3] * x[31]; b1 -= mq[3][3] * y[31]; mq[3] = *(const LAS f32x4*)(Mg + 4084);
            a0 -= mq[4][0] * x[32]; b0 -= mq[4][0] * y[32]; a1 -= mq[4][1] * x[33]; b1 -= mq[4][1] * y[33]; a0 -= mq[4][2] * x[34]; b0 -= mq[4][2] * y[34]; a1 -= mq[4][3] * x[35]; b1 -= mq[4][3] * y[35]; mq[4] = *(const LAS f32x4*)(Mg + 4088);
            a0 -= mq[5][0] * x[36]; b0 -= mq[5][0] * y[36]; a1 -= mq[5][1] * x[37]; b1 -= mq[5][1] * y[37]; a0 -= mq[5][2] * x[38]; b0 -= mq[5][2] * y[38]; a1 -= mq[5][3] * x[39]; b1 -= mq[5][3] * y[39]; mq[5] = *(const LAS f32x4*)(Mg + 4092);
            a0 -= mq[0][0] * x[40]; b0 -= mq[0][0] * y[40]; a1 -= mq[0][1] * x[41]; b1 -= mq[0][1] * y[41]; a0 -= mq[0][2] * x[42]; b0 -= mq[0][2] * y[42]; a1 -= mq[0][3] * x[43]; b1 -= mq[0][3] * y[43];
            a0 -= mq[1][0] * x[44]; b0 -= mq[1][0] * y[44]; a1 -= mq[1][1] * x[45]; b1 -= mq[1][1] * y[45]; a0 -= mq[1][2] * x[46]; b0 -= mq[1][2] * y[46]; a1 -= mq[1][3] * x[47]; b1 -= mq[1][3] * y[47];
            a0 -= mq[2][0] * x[48]; b0 -= mq[2][0] * y[48]; a1 -= mq[2][1] * x[49]; b1 -= mq[2][1] * y[49]; a0 -= mq[2][2] * x[50]; b0 -= mq[2][2] * y[50]; a1 -= mq[2][3] * x[51]; b1 -= mq[2][3] * y[51];
            a0 -= mq[3][0] * x[52]; b0 -= mq[3][0] * y[52]; a1 -= mq[3][1] * x[53]; b1 -= mq[3][1] * y[53]; a0 -= mq[3][2] * x[54]; b0 -= mq[3][2] * y[54]; a1 -= mq[3][3] * x[55]; b1 -= mq[3][3] * y[55];
            a0 -= mq[4][0] * x[56]; b0 -= mq[4][0] * y[56]; a1 -= mq[4][1] * x[57]; b1 -= mq[4][1] * y[57]; a0 -= mq[4][2] * x[58]; b0 -= mq[4][2] * y[58]; a1 -= mq[4][3] * x[59]; b1 -= mq[4][3] * y[59];
            a0 -= mq[5][0] * x[60]; b0 -= mq[5][0] * y[60]; a1 -= mq[5][1] * x[61]; b1 -= mq[5][1] * y[61]; a0 -= mq[5][2] * x[62]; b0 -= mq[5][2] * y[62]; x[63] = a0 + a1; y[63] = b0 + b1; up[8064] = x[63]; wp[8064] = f2bf(-y[63]);
        } else {
            const int g2 = (w8 - 4) >> 1, tt = ((w8 - 4) & 1) * 64 + lane; const int item2 = it0 + g2;
            LAS unsigned char* lg = lds0 + g2 * P5_GRP; LAS float* decg = (LAS float*)(lg + P5_DEC);
            const float lastg = decg[63];
#pragma unroll
            for (int i = 0; i < 8; ++i) { const int vid = tt + 128 * i, r = vid >> 4, d0 = (vid & 15) * 8; float f[8]; unpack8(*(const LAS u32x4*)(lg + P5_QS + r * 272 + d0 * 2), f);
                const float e = scale * __expf(decg[r]);
#pragma unroll
                for (int q = 0; q < 8; ++q) f[q] *= e;
                *(u32x4*)(qd + (size_t)item2 * 8192 + r * 128 + d0) = pack8(f); }
#pragma unroll
            for (int i = 0; i < 8; ++i) { const int vid = tt + 128 * i, d = vid >> 3, rg = (vid & 7) * 8; float f[8];
#pragma unroll
                for (int q = 0; q < 8; ++q) f[q] = bf2f(*(const LAS bf16_t*)(lg + P5_KS + (rg + q) * 272 + d * 2)) * __expf(lastg - decg[rg + q]);
                *(u32x4*)(kt + (size_t)item2 * 8192 + d * 64 + rg) = pack8(f); }
            if (tt == 0) cdv[item2] = __expf(lastg);
        }
    }
    __syncthreads();
}

constexpr int SB_WD = 0, SB_QD = 17408, SB_KT = 34816, SB_QK = 53248, SB_UB = 62464, SB_SIZE = 66560;
constexpr int SC_ST = 2 * SB_SIZE, SC_UT = SC_ST + 4352, SC_END = SC_UT + 2304;
static_assert(SC_END <= LDS_BYTES, "lds");
__device__ __forceinline__ void scan_phase(const Params& p, int bid, int nblk, LAS unsigned char* lds) {
    const int tid = threadIdx.x, lane = tid & 63, wid = __builtin_amdgcn_readfirstlane(tid >> 6), fr = lane & 15, fq = lane >> 4;
    const bf16_t* wdc = (const bf16_t*)(p.ws + WS_WDC); const bf16_t* qd = (const bf16_t*)(p.ws + WS_QD); const bf16_t* kt = (const bf16_t*)(p.ws + WS_KT); const bf16_t* qk = (const bf16_t*)(p.ws + WS_QK);
    const float* cdv = (const float*)(p.ws + WS_CD); const float* ub = p.out + OS_UB; float* obuf = p.out + OS_O;
    for (int item = bid; item < 256; item += nblk) {
        const int xcd = item & 7, iq = item >> 3, bh = xcd * 4 + (iq >> 3), sl = iq & 7, h = bh & 7, b = bh >> 3;
        u32x4 r_wd[2], r_qd[2], r_kt[2], r_qk, r_ub;
        auto gload = [&](int n) {
            const size_t it = (size_t)(bh * 32 + n);
#pragma unroll
            for (int i = 0; i < 2; ++i) { const int ch = tid + 512 * i; r_wd[i] = *(const u32x4*)(wdc + it * 8192 + ch * 8); r_qd[i] = *(const u32x4*)(qd + it * 8192 + ch * 8); r_kt[i] = *(const u32x4*)(kt + it * 8192 + ch * 8); }
            r_qk = *(const u32x4*)(qk + it * 4096 + tid * 8);
            if (tid < 256) r_ub = *(const u32x4*)(ub + it * 8192 + (tid >> 2) * 128 + sl * 16 + (tid & 3) * 4);
        };
        auto lstore = [&](int buf) {
            LAS unsigned char* B = lds + buf * SB_SIZE;
#pragma unroll
            for (int i = 0; i < 2; ++i) { const int ch = tid + 512 * i; const int r = ch >> 4, c8 = (ch & 15) * 8; *(LAS u32x4*)(B + SB_WD + r * 272 + c8 * 2) = r_wd[i]; *(LAS u32x4*)(B + SB_QD + r * 272 + c8 * 2) = r_qd[i];
                const int d = ch >> 3, t8 = (ch & 7) * 8; *(LAS u32x4*)(B + SB_KT + d * 144 + t8 * 2) = r_kt[i]; }
            { const int r = tid >> 3, s8 = (tid & 7) * 8; *(LAS u32x4*)(B + SB_QK + r * 144 + s8 * 2) = r_qk; }
            if (tid < 256) *(LAS u32x4*)(B + SB_UB + (tid >> 2) * 64 + (tid & 3) * 16) = r_ub;
        };
        __syncthreads();
        gload(0);
        for (int i = tid; i < 4352 / 4; i += 512) *(LAS unsigned*)(lds + SC_ST + i * 4) = 0u;
        lstore(0);
        f32x4 sacc = (f32x4){0.f, 0.f, 0.f, 0.f};
        __syncthreads();
        for (int n = 0; n < 32; ++n) {
            const int cur = n & 1; LAS unsigned char* B = lds + cur * SB_SIZE;
            if (n + 1 < 32) gload(n + 1);
            const float cd = cdv[bh * 32 + n];
            f32x4 acc;
            const int tw = wid & 3;
            if (wid < 4) {
#pragma unroll
                for (int j = 0; j < 4; ++j) acc[j] = *(const LAS float*)(B + SB_UB + ((tw * 16 + fq * 4 + j) * 16 + fr) * 4);
#pragma unroll
                for (int kk = 0; kk < 4; ++kk) { const bf16x8 a = *(const LAS bf16x8*)(B + SB_WD + (tw * 16 + fr) * 272 + (kk * 32 + fq * 8) * 2); const bf16x8 bb = *(const LAS bf16x8*)(lds + SC_ST + fr * 272 + (kk * 32 + fq * 8) * 2);
                    acc = __builtin_amdgcn_mfma_f32_16x16x32_bf16(a, bb, acc, 0, 0, 0); }
                u32x2 w; w.x = pk2(acc[0], acc[1]); w.y = pk2(acc[2], acc[3]);
                *(LAS u32x2*)(lds + SC_UT + fr * 144 + (tw * 16 + fq * 4) * 2) = w;
            } else {
                acc = (f32x4){0.f, 0.f, 0.f, 0.f};
#pragma unroll
                for (int kk = 0; kk < 4; ++kk) { const bf16x8 a = *(const LAS bf16x8*)(B + SB_QD + (tw * 16 + fr) * 272 + (kk * 32 + fq * 8) * 2); const bf16x8 bb = *(const LAS bf16x8*)(lds + SC_ST + fr * 272 + (kk * 32 + fq * 8) * 2);
                    acc = __builtin_amdgcn_mfma_f32_16x16x32_bf16(a, bb, acc, 0, 0, 0); }
            }
            __syncthreads();
            sacc *= cd;
#pragma unroll
            for (int kk = 0; kk < 2; ++kk) { const bf16x8 a = *(const LAS bf16x8*)(B + SB_KT + (wid * 16 + fr) * 144 + (kk * 32 + fq * 8) * 2); const bf16x8 bb = *(const LAS bf16x8*)(lds + SC_UT + fr * 144 + (kk * 32 + fq * 8) * 2);
                sacc = __builtin_amdgcn_mfma_f32_16x16x32_bf16(a, bb, sacc, 0, 0, 0); }
            if (wid >= 4) {
#pragma unroll
                for (int kk = 0; kk < 2; ++kk) { const bf16x8 a = *(const LAS bf16x8*)(B + SB_QK + (tw * 16 + fr) * 144 + (kk * 32 + fq * 8) * 2); const bf16x8 bb = *(const LAS bf16x8*)(lds + SC_UT + fr * 144 + (kk * 32 + fq * 8) * 2);
                    acc = __builtin_amdgcn_mfma_f32_16x16x32_bf16(a, bb, acc, 0, 0, 0); }
#pragma unroll
                for (int j = 0; j < 4; ++j) obuf[(size_t)(b * 2048 + n * 64 + tw * 16 + fq * 4 + j) * 1024 + h * 128 + sl * 16 + fr] = acc[j];
            }
            { u32x2 w; w.x = pk2(sacc[0], sacc[1]); w.y = pk2(sacc[2], sacc[3]); *(LAS u32x2*)(lds + SC_ST + fr * 272 + (wid * 16 + fq * 4) * 2) = w; }
            if (n + 1 < 32) lstore(cur ^ 1);
            __syncthreads();
        }
#pragma unroll
        for (int j = 0; j < 4; ++j) p.out[O_DP + ((size_t)bh * 128 + wid * 16 + fq * 4 + j) * 128 + sl * 16 + fr] = sacc[j];
    }
    __syncthreads();
    {
        const bf16_t* qn = (const bf16_t*)(p.ws + WS_QN); const bf16_t* kn = (const bf16_t*)(p.ws + WS_KN); const bf16_t* vv = (const bf16_t*)(p.ws + WS_VV);
        const float* gbuf = (const float*)(p.ws + WS_G); const float* bbuf = (const float*)(p.ws + WS_BETA);
        const int grp = tid >> 8, w4 = __builtin_amdgcn_readfirstlane(tid >> 6) & 3, j = w4 * 32 + (lane & 31), half = lane >> 5;
        LAS float* qs = (LAS float*)lds + grp * 1024;
        LAS float* ks = qs + 512;
        const float scale = 0.08838834764831845f;
        for (int it0 = bid * 2; it0 < 1024; it0 += nblk * 2) {
            const int item = it0 + grp, sb = item >> 3, h = item & 7;
            __syncthreads();
#pragma unroll
            for (int i = 0; i < 4; ++i) { const int idx = (tid & 255) + 256 * i, tk = idx >> 7, c = idx & 127, t = tk & 3; const size_t go = (size_t)(TP + sb * 4 + t) * 1024 + h * 128 + c;
                if (tk < 4) qs[t * 128 + c] = bf2f(qn[go]); else ks[t * 128 + c] = bf2f(kn[go]); }
            float S[64];
            const float* s0 = p.in[4] + (size_t)item * 16384 + (size_t)half * 64 * 128 + j;
#pragma unroll
            for (int i = 0; i < 64; ++i) S[i] = __builtin_nontemporal_load(s0 + i * 128);
            __syncthreads();
#pragma unroll 1
            for (int t = 0; t < 4; ++t) {
                const int row = TP + sb * 4 + t;
                const float a = __expf(gbuf[row * 8 + h]), be = bbuf[row * 8 + h], v = bf2f(vv[(size_t)row * 1024 + h * 128 + j]);
                float kS = 0.f;
#pragma unroll
                for (int i4 = 0; i4 < 16; ++i4) { const f32x4 k4 = *(const LAS f32x4*)(ks + t * 128 + half * 64 + i4 * 4); kS += k4[0] * S[i4 * 4] + k4[1] * S[i4 * 4 + 1] + k4[2] * S[i4 * 4 + 2] + k4[3] * S[i4 * 4 + 3]; }
                kS += __shfl_xor(kS, 32);
                const float coef = be * (v - a * kS);
                float o = 0.f;
#pragma unroll
                for (int i4 = 0; i4 < 16; ++i4) { const f32x4 k4 = *(const LAS f32x4*)(ks + t * 128 + half * 64 + i4 * 4); const f32x4 q4 = *(const LAS f32x4*)(qs + t * 128 + half * 64 + i4 * 4);
#pragma unroll
                    for (int q = 0; q < 4; ++q) { S[i4 * 4 + q] = a * S[i4 * 4 + q] + k4[q] * coef; o += q4[q] * S[i4 * 4 + q]; } }
                o += __shfl_xor(o, 32);
                if (half == 0) obuf[(size_t)row * 1024 + h * 128 + j] = o * scale;
            }
            float* so = p.out + O_DS + (size_t)item * 16384 + (size_t)half * 64 * 128 + j;
#pragma unroll
            for (int i = 0; i < 64; ++i) so[i * 128] = S[i];
        }
    }
    __syncthreads();
}

__device__ __forceinline__ void onorm_phase(const Params& p, int bid, int nblk) {
    const int lane = threadIdx.x & 63, wid = __builtin_amdgcn_readfirstlane(threadIdx.x >> 6);
    const float* obuf = p.out + OS_O; const bf16_t* proj = (const bf16_t*)(p.ws + WS_PROJ); bf16_t* acat = (bf16_t*)(p.ws + WS_U); const float* og = p.in[14];
    for (int row = bid * 8 + wid; row < TT; row += nblk * 8) {
        const int c0 = lane * 16; float o[16], z[16], g[16];
#pragma unroll
        for (int i = 0; i < 4; ++i) { const f32x4 v = *(const f32x4*)(obuf + (size_t)row * 1024 + c0 + i * 4); o[i * 4] = v[0]; o[i * 4 + 1] = v[1]; o[i * 4 + 2] = v[2]; o[i * 4 + 3] = v[3];
            const f32x4 gg = *(const f32x4*)(og + (c0 & 127) + i * 4); g[i * 4] = gg[0]; g[i * 4 + 1] = gg[1]; g[i * 4 + 2] = gg[2]; g[i * 4 + 3] = gg[3]; }
        unpack8(*(const u32x4*)(proj + (size_t)row * NPROJ + C_Z + c0), z); unpack8(*(const u32x4*)(proj + (size_t)row * NPROJ + C_Z + c0 + 8), z + 8);
        float ss = 0.f;
#pragma unroll
        for (int i = 0; i < 16; ++i) ss += o[i] * o[i];
        ss += __shfl_xor(ss, 1); ss += __shfl_xor(ss, 2); ss += __shfl_xor(ss, 4);
        const float rstd = rsqrtf(ss * (1.0f / 128.0f) + EPS);
#pragma unroll
        for (int i = 0; i < 16; ++i) o[i] = o[i] * rstd * g[i] * siluf_(z[i]);
        *(u32x4*)(acat + (size_t)row * DM + c0) = pack8(o); *(u32x4*)(acat + (size_t)row * DM + c0 + 8) = pack8(o + 8);
    }
}

#define XB_TMO      128
#define XB_XCNT(j)  (256  + 64 * (j))
#define XB_XSUB(j)  (1280 + 64 * (j))
#define XB_XGEN(j)  (2304 + 64 * (j))
#define XB_TOP      3328
#define XB_TOPGEN   3392
#define XCD_BAR_WORDS 3456
#define XB_SPIN_CAP (1u << 18)

__device__ __forceinline__ unsigned xb_ld(unsigned* p)              { return __hip_atomic_load(p, __ATOMIC_RELAXED, __HIP_MEMORY_SCOPE_AGENT); }
__device__ __forceinline__ unsigned xb_add(unsigned* p, unsigned v) { return __hip_atomic_fetch_add(p, v, __ATOMIC_RELAXED, __HIP_MEMORY_SCOPE_AGENT); }
__device__ __forceinline__ unsigned xb_xcc_id() { return (unsigned)__builtin_amdgcn_s_getreg((3 << 11) | 20) & 0xFu; }
#define XB_SPIN(cond, bar) do { unsigned _sp = 0; while (cond) { __builtin_amdgcn_s_sleep(1); \
    if ((++_sp & 255u) == 0u) { if (xb_ld(&(bar)[XB_TMO])) break; if (_sp > XB_SPIN_CAP) { atomicAdd(&(bar)[XB_TMO], 1u); break; } } } } while (0)

struct XcdBarrier {
    unsigned* bar; unsigned x;
    volatile LAS unsigned* st;
};

__device__ __forceinline__ XcdBarrier xcd_barrier_post(unsigned* bar, volatile LAS unsigned* st) {
    XcdBarrier b; b.bar = bar; b.x = xb_xcc_id(); b.st = st;
    if (threadIdx.x == 0) (void)xb_add(&bar[XB_XCNT(b.x)], 1u);
    return b;
}
__device__ __forceinline__ void xcd_barrier_complete(unsigned* bar, unsigned x, unsigned& nloc, unsigned& nx) {
    const unsigned G = gridDim.x * gridDim.y * gridDim.z;
    unsigned sum, cnt, mine, sp = 0u;
    for (;;) {
        sum = 0u; cnt = 0u; mine = 0u;
#pragma unroll
        for (unsigned j = 0; j < 16; ++j) { const unsigned c = xb_ld(&bar[XB_XCNT(j)]); sum += c; cnt += (c > 0u) ? 1u : 0u; mine = (j == x) ? c : mine; }
        if (sum == G) break;
        __builtin_amdgcn_s_sleep(1);
        if ((++sp & 255u) == 0u) { if (xb_ld(&bar[XB_TMO])) break; if (sp > XB_SPIN_CAP) { atomicAdd(&bar[XB_TMO], 1u); break; } }
    }
    nloc = mine > 0u ? mine : 1u; nx = cnt > 0u ? cnt : 1u;
}

__device__ __forceinline__ void xcd_barrier(const XcdBarrier& b) {
    asm volatile("s_waitcnt vmcnt(0)" ::: "memory");
    __syncthreads();
    if (threadIdx.x == 0) {
        unsigned* bar = b.bar;
        __builtin_amdgcn_s_waitcnt(0);
        unsigned nloc = b.st[0], nx = b.st[1];
        if (nloc == 0u) { xcd_barrier_complete(bar, b.x, nloc, nx); b.st[0] = nloc; b.st[1] = nx; }
        const unsigned old = xb_add(&bar[XB_XSUB(b.x)], 1u);
        const unsigned gen = old / nloc;
        if (old + 1u == (gen + 1u) * nloc) {
            __builtin_amdgcn_fence(__ATOMIC_RELEASE, "agent");
            asm volatile("s_waitcnt vmcnt(0)" ::: "memory");
            const unsigned og = xb_add(&bar[XB_TOP], 1u);
            const unsigned tg = og / nx;
            if (og + 1u == (tg + 1u) * nx) xb_add(&bar[XB_TOPGEN], 1u);
            else XB_SPIN(xb_ld(&bar[XB_TOPGEN]) == tg, bar);
            __builtin_amdgcn_fence(__ATOMIC_ACQUIRE, "agent");
            xb_add(&bar[XB_XGEN(b.x)], 1u);
            asm volatile("s_waitcnt vmcnt(0)" ::: "memory");
        } else {
            XB_SPIN(xb_ld(&bar[XB_XGEN(b.x)]) == gen, bar);
            __builtin_amdgcn_fence(__ATOMIC_ACQUIRE, "agent");
            asm volatile("s_waitcnt vmcnt(0)" ::: "memory");
        }
    }
    __syncthreads();
}

constexpr size_t WS_BAR = WS_END;
constexpr int LDS_ST_OFF = LDS_BYTES - 16;
struct KArgs { Params p; TJob jobs[11]; };
constexpr int N_PHASES = 15;
#ifndef PH_MASK
#define PH_MASK 0xFFFF
#endif
#ifndef DUP_MASK
#define DUP_MASK 0
#endif

__global__ void __launch_bounds__(512, 2) fwd_megakernel(KArgs ka) {
    extern __shared__ __attribute__((aligned(16))) unsigned char lds_raw[];
    LAS unsigned char* lds = (LAS unsigned char*)lds_raw;
    const Params& p = ka.p;
    const int bid = blockIdx.x, nblk = gridDim.x;
    unsigned char* ws = p.ws;
    const int lo = p.ph_lo, hi = p.ph_hi;
    if (threadIdx.x < 4) ((LAS unsigned*)(lds + LDS_ST_OFF))[threadIdx.x] = 0u;
    __syncthreads();
    if (hi > 1000) cg::this_grid().sync();
    XcdBarrier xbar = xcd_barrier_post((unsigned*)(ws + WS_BAR), (volatile LAS unsigned*)(lds + LDS_ST_OFF));
#define IN(k) ((PH_MASK & (1 << (k))) && lo <= (k) && (k) < hi)
#define SEAM(k) do { if (lo <= (k) && (k) + 1 < hi) xcd_barrier(xbar); } while (0)
    if (IN(0)) for (int rep = 0; rep <= ((DUP_MASK >> 0) & 1); ++rep) {
            bf16_t* aada = (bf16_t*)(ws + WS_AADA);
            for (int idx = bid * 512 + threadIdx.x; idx < 256 * 2048; idx += nblk * 512) { const int row = idx >> 11, col = idx & 2047;
                const float v = row < 4 ? siluf_(p.in[2][row * 2048 + col]) : (row < NB ? siluf_(p.in[3][(row - 4) * 2048 + col]) : 0.f); aada[idx] = f2bf(v); }
            transpose_jobs(ka.jobs, 1, bid, nblk, lds);
        }
    SEAM(0);
    if (IN(1)) for (int rep = 0; rep <= ((DUP_MASK >> 1) & 1); ++rep) {
            if (bid < 48) { pg8::Gemm g{(const bf16_t*)(ws + WS_AADA), (const bf16_t*)(ws + WS_PROJ), 2048, 2048, 2048, 0}; pg8::OneUnitOrder S{48, bid, 32}; pg8::EpiAda E{(float*)(ws + WS_MOD), p.in[8]}; pg8::gemm_phase(lds, g, S, E); }
            else { transpose_jobs(ka.jobs + 1, 1, bid - 48, nblk - 48, lds); transpose_jobs(ka.jobs + 4, 7, bid - 48, nblk - 48, lds); }
        }
    SEAM(1);
    if (IN(2)) for (int rep = 0; rep <= ((DUP_MASK >> 2) & 1); ++rep) norm_phase<0>(p, bid, nblk);
    SEAM(2);
    if (IN(3)) for (int rep = 0; rep <= ((DUP_MASK >> 3) & 1); ++rep) { pg8::Gemm g{(const bf16_t*)(ws + WS_U), (const bf16_t*)(ws + WS_WIN), 2048, 2048, 2048, 0}; pg8::StaticOrder S; S.init(TT, NPROJ, 2048, nblk, bid); pg8::EpiBf16 E{(bf16_t*)(ws + WS_PROJ), NPROJ, 0, nullptr}; pg8::gemm_phase(lds, g, S, E); }
    SEAM(3);
    if (IN(4)) for (int rep = 0; rep <= ((DUP_MASK >> 4) & 1); ++rep) mixer_prep_phase(p, bid, nblk);
    SEAM(4);
    if (IN(5)) for (int rep = 0; rep <= ((DUP_MASK >> 5) & 1); ++rep) chunk_prep_phase(p, bid, nblk, lds);
    SEAM(5);
    if (IN(6)) for (int rep = 0; rep <= ((DUP_MASK >> 6) & 1); ++rep) scan_phase(p, bid, nblk, lds);
    SEAM(6);
    if (IN(7)) for (int rep = 0; rep <= ((DUP_MASK >> 7) & 1); ++rep) { onorm_phase(p, bid, nblk);
            pg8::Gemm g{(const bf16_t*)(ws + WS_YP), (const bf16_t*)(ws + WS_PW), 1024, 256, 256, 512}; pg8::StaticOrder S; S.init(TT, 1024, 256, nblk, bid); pg8::EpiBf16 E{(bf16_t*)(ws + WS_U), DM, 1024, p.in[16]}; pg8::gemm_phase(lds, g, S, E); }
    SEAM(7);
    if (IN(8)) for (int rep = 0; rep <= ((DUP_MASK >> 8) & 1); ++rep) { pg8::Gemm g{(const bf16_t*)(ws + WS_U), (const bf16_t*)(ws + WS_WAB), 2048, 2048, 1024, 0}; pg8::StaticOrder S; S.init(TT, 2048, 1024, nblk, bid); pg8::EpiG1 E{p.out + O_Y, (const bf16_t*)(ws + WS_PROJ)}; pg8::gemm_phase(lds, g, S, E);
            if (rep == 0) { if (nblk <= 16) transpose_jobs(ka.jobs + 2, 1, bid, nblk, lds); else if (bid >= 16) transpose_jobs(ka.jobs + 2, 1, bid - 16, nblk - 16, lds); } }
    SEAM(8);
    if (IN(9)) for (int rep = 0; rep <= ((DUP_MASK >> 9) & 1); ++rep) { pg8::Gemm g{(const bf16_t*)(ws + WS_U) + 1024, (const bf16_t*)(ws + WS_WAB) + 1024, 2048, 2048, 1024, 0}; pg8::StaticOrder S; S.init(TT, 2048, 1024, nblk, bid); pg8::EpiG2 E{(bf16_t*)(ws + WS_QN), p.out + O_Y, (const bf16_t*)(ws + WS_PROJ)}; pg8::gemm_phase(lds, g, S, E);
            if (rep == 0) { if (nblk <= 16) transpose_jobs(ka.jobs + 3, 1, bid, nblk, lds); else if (bid >= 16) transpose_jobs(ka.jobs + 3, 1, bid - 16, nblk - 16, lds); } }
    SEAM(9);
    if (IN(10)) for (int rep = 0; rep <= ((DUP_MASK >> 10) & 1); ++rep) { pg8::Gemm g{(const bf16_t*)(ws + WS_QN), (const bf16_t*)(ws + WS_WO), 2048, 2048, 2048, 0}; pg8::SplitOrder S{nblk, bid, 32, 4, 8}; pg8::EpiRes E{p.out + O_Y, p.in[0], p.in[1], (const float*)(ws + WS_MOD) + 4096, (float*)(ws + WS_PB10)}; pg8::gemm_phase(lds, g, S, E); }
    SEAM(10);
    if (IN(11)) for (int rep = 0; rep <= ((DUP_MASK >> 11) & 1); ++rep) norm_phase<1>(p, bid, nblk);
    SEAM(11);
    if (IN(12)) for (int rep = 0; rep <= ((DUP_MASK >> 12) & 1); ++rep) { pg8::Gemm g{(const bf16_t*)(ws + WS_U), (const bf16_t*)(ws + WS_WGU), 2048, 2048, 2048, 0}; pg8::StaticOrder S; S.init(TT, 11264, 2048, nblk, bid); pg8::EpiGU E{(bf16_t*)(ws + WS_PROJ)}; pg8::gemm_phase(lds, g, S, E); }
    SEAM(12);
    if (IN(13)) for (int rep = 0; rep <= ((DUP_MASK >> 13) & 1); ++rep) { pg8::Gemm g{(const bf16_t*)(ws + WS_PROJ), (const bf16_t*)(ws + WS_WD), DFF, DFF, DFF, 0}; pg8::SplitOrder S{nblk, bid, 88, 8, 11}; pg8::EpiRes E{p.out + O_Y, p.out + O_Y, p.out + O_Y + (size_t)TP * DM, (const float*)(ws + WS_MOD) + 10240, (float*)(ws + WS_PB13)}; pg8::gemm_phase(lds, g, S, E); }
    SEAM(13);
    if (IN(14)) for (int rep = 0; rep <= ((DUP_MASK >> 14) & 1); ++rep) norm_phase<2>(p, bid, nblk);
    SEAM(14);
}

extern "C" void kernel_launch(void* const* d_in, const int* in_sizes, int n_in, void* d_out, int out_size, void* d_ws, size_t ws_size, hipStream_t stream) {
    static int grid = 0;
    if (grid == 0) {
        if (n_in != 24 || ws_size < WS_BAR + XCD_BAR_WORDS * 4) { fprintf(stderr, "kernel_launch: unexpected n_in %d / ws_size %zu (need %zu)\n", n_in, ws_size, (size_t)WS_END); grid = -1; return; }
        int dev = 0, cus = 0, per_cu = 0;
        hipGetDevice(&dev); hipDeviceGetAttribute(&cus, hipDeviceAttributeMultiprocessorCount, dev);
        if (hipFuncSetAttribute((const void*)fwd_megakernel, hipFuncAttributeMaxDynamicSharedMemorySize, LDS_BYTES) != hipSuccess) { fprintf(stderr, "kernel_launch: hipFuncSetAttribute failed\n"); grid = -1; return; }
        if (hipOccupancyMaxActiveBlocksPerMultiprocessor(&per_cu, (const void*)fwd_megakernel, 512, LDS_BYTES) != hipSuccess || per_cu < 1) { fprintf(stderr, "kernel_launch: occupancy query says %d\n", per_cu); per_cu = 1; }
        (void)hipGetLastError();
        grid = cus > 0 ? cus : 256;
        if (grid < 64) grid = 64;
    }
    if (grid < 0) return;
    if (hipMemsetAsync((unsigned char*)d_ws + WS_BAR, 0, XCD_BAR_WORDS * 4, stream) != hipSuccess) { fprintf(stderr, "kernel_launch: memset failed\n"); return; }
    KArgs ka; memset(&ka, 0, sizeof(ka));
    for (int i = 0; i < 24; ++i) ka.p.in[i] = (const float*)d_in[i];
    ka.p.out = (float*)d_out; ka.p.ws = (unsigned char*)d_ws;
    unsigned char* ws = (unsigned char*)d_ws;
    auto setjob = [&](int i, const void* src, void* dst, int ld_src, int K, int Nout, int ld_dst, int map) { TJob& j = ka.jobs[i]; j.src = (const float*)src; j.dst = (bf16_t*)dst; j.ld_src = ld_src; j.K = K; j.Nout = Nout; j.ld_dst = ld_dst; j.map = map; j.pad = 0; };
    setjob(0, d_in[7], ws + WS_PROJ, MODW, 2048, MODW, 2048, 0);
    setjob(1, d_in[10], ws + WS_WIN, 9232, 2048, NPROJ, 2048, 1);
    setjob(2, d_in[21], ws + WS_WGU, 2 * DFF, 2048, 2 * DFF, 2048, 2);
    setjob(3, d_in[22], ws + WS_WD, 2048, DFF, 2048, DFF, 0);
    setjob(4, d_in[19], ws + WS_WO, 2048, 2048, 2048, 2048, 0);
    setjob(5, d_in[17], ws + WS_WAB, 2048, 1024, 2048, 2048, 0);
    setjob(6, d_in[18], ws + WS_WAB + 1024 * 2, 2048, 1024, 2048, 2048, 0);
    for (int g = 0; g < 4; ++g) setjob(7 + g, (const float*)d_in[15] + g * 65536, ws + WS_PW + (size_t)g * 65536 * 2, 256, 256, 256, 256, 0);
#if MK_PER_PHASE
    for (int ph = 0; ph < N_PHASES; ++ph) { ka.p.ph_lo = ph; ka.p.ph_hi = ph + 1; hipLaunchKernelGGL(fwd_megakernel, dim3(grid), dim3(512), LDS_BYTES, stream, ka); }
#else
    ka.p.ph_lo = 0; ka.p.ph_hi = N_PHASES;
    void* args[] = {&ka};
    hipError_t e = hipLaunchCooperativeKernel((const void*)fwd_megakernel, dim3(grid), dim3(512), args, LDS_BYTES, stream);
    if (e != hipSuccess) fprintf(stderr, "cooperative launch failed: %s (grid %d)\n", hipGetErrorString(e), grid);
#endif
}
```

```cpp
#include <hip/hip_runtime.h>
#include <hip/hip_cooperative_groups.h>
#include <cstdio>
#include <cstring>
namespace cg = cooperative_groups;

#ifndef MK_PER_PHASE
#define MK_PER_PHASE 0
#endif

#define LAS __attribute__((address_space(3)))
typedef unsigned short bf16_t;
typedef short bf16x8 __attribute__((ext_vector_type(8)));
typedef float f32x4 __attribute__((ext_vector_type(4)));
typedef float f32x2 __attribute__((ext_vector_type(2)));
typedef unsigned u32x4 __attribute__((ext_vector_type(4)));
typedef unsigned u32x2 __attribute__((ext_vector_type(2)));

constexpr int DM = 2048, TP = 8192, TS = 512, TT = 8704, NB = 132;
constexpr int NPROJ = 9472;
constexpr int DFF = 5632;
constexpr int MODW = 12288;
constexpr float EPS = 1e-6f;
constexpr int C_Q = 0, C_K = 1024, C_V = 2048, C_Z = 3072, C_XP = 4096, C_GA = 5120, C_GB = 7168, C_AB = 9216;
constexpr size_t O_Y = 0, O_DP = 17825792, O_CP = 18350080, O_PP = 18386944, O_DS = 18448384, O_CS = 35225600, O_PS = 36405248;
constexpr size_t OS_O = 0, OS_UB = 8912896;
constexpr size_t WS_WIN = 0;
constexpr size_t WS_WGU = WS_WIN + (size_t)NPROJ * 2048 * 2;
constexpr size_t WS_WD = WS_WGU + (size_t)11264 * 2048 * 2;
constexpr size_t WS_WO = WS_WD + (size_t)2048 * 5632 * 2;
constexpr size_t WS_WAB = WS_WO + (size_t)2048 * 2048 * 2;
constexpr size_t WS_PW = WS_WAB + (size_t)2048 * 2048 * 2;
constexpr size_t WS_AADA = WS_PW + (size_t)1024 * 256 * 2;
constexpr size_t WS_MOD = WS_AADA + (size_t)256 * 2048 * 2;
constexpr size_t WS_G = WS_MOD + (size_t)NB * MODW * 4;
constexpr size_t WS_BETA = WS_G + (size_t)TT * 8 * 4;
constexpr size_t WS_CD = WS_BETA + (size_t)TT * 8 * 4;
constexpr size_t WS_U = WS_CD + 4096;
constexpr size_t WS_QN = WS_U + (size_t)TT * 2048 * 2;
constexpr size_t WS_KN = WS_QN + (size_t)TT * 1024 * 2;
constexpr size_t WS_VV = WS_KN + (size_t)TT * 1024 * 2;
constexpr size_t WS_YP = WS_VV + (size_t)TT * 1024 * 2;
constexpr size_t WS_WDC = WS_YP + (size_t)TT * 1024 * 2;
constexpr size_t WS_QD = WS_WDC + (size_t)1024 * 64 * 128 * 2;
constexpr size_t WS_KT = WS_QD + (size_t)1024 * 64 * 128 * 2;
constexpr size_t WS_QK = WS_KT + (size_t)1024 * 64 * 128 * 2;
constexpr size_t WS_PROJ = WS_QK + (size_t)1024 * 64 * 64 * 2;
constexpr size_t WS_END = WS_PROJ + (size_t)TT * NPROJ * 2;
constexpr size_t WS_PB10 = WS_PROJ;
constexpr size_t WS_PB13 = WS_PROJ + (size_t)TT * DFF * 2;
static_assert(WS_PB13 + (size_t)11 * TS * DM * 4 <= WS_END && (WS_PB13 % 256) == 0, "partials");
static_assert(WS_END + 16384 <= 501510720ull, "workspace too large");
static_assert((WS_PROJ % 256) == 0 && (WS_QK % 256) == 0 && (WS_U % 256) == 0, "align");

constexpr int LDS_BYTES = 147456;

struct Params {
    const float* in[24];
    float* out;
    unsigned char* ws;
    int ph_lo, ph_hi;
};

__device__ __forceinline__ float bf2f(unsigned short x) { return __uint_as_float(((unsigned)x) << 16); }
__device__ __forceinline__ unsigned short f2bf(float f) { unsigned u = __float_as_uint(f); u += 0x7FFFu + ((u >> 16) & 1u); return (unsigned short)(u >> 16); }
typedef __bf16 bf16x2_hw __attribute__((ext_vector_type(2)));
__device__ __forceinline__ unsigned pk2(float lo, float hi) { const f32x2 v = {lo, hi}; const bf16x2_hw b = __builtin_convertvector(v, bf16x2_hw); return __builtin_bit_cast(unsigned, b); }
__device__ __forceinline__ void unpack8(const u32x4 w, float* f) {
    f[0] = __uint_as_float(w.x << 16); f[1] = __uint_as_float(w.x & 0xffff0000u);
    f[2] = __uint_as_float(w.y << 16); f[3] = __uint_as_float(w.y & 0xffff0000u);
    f[4] = __uint_as_float(w.z << 16); f[5] = __uint_as_float(w.z & 0xffff0000u);
    f[6] = __uint_as_float(w.w << 16); f[7] = __uint_as_float(w.w & 0xffff0000u);
}
__device__ __forceinline__ u32x4 pack8(const float* f) { u32x4 w; w.x = pk2(f[0], f[1]); w.y = pk2(f[2], f[3]); w.z = pk2(f[4], f[5]); w.w = pk2(f[6], f[7]); return w; }
__device__ __forceinline__ float sigmoidf_(float x) { return 1.0f / (1.0f + __expf(-x)); }
__device__ __forceinline__ float siluf_(float x) { return x / (1.0f + __expf(-x)); }
__device__ __forceinline__ int bidx_of_row(int row) { return row < TP ? (row >> 11) : 4 + ((row - TP) >> 2); }

namespace pg8 {
constexpr int BM = 256, BK = 64, HALF = 128, HTB = HALF * BK * 2, STAGE_BYTES = 8 * HTB, NXCD = 8, WGM = 8;
__host__ __device__ __forceinline__ int lds_byte(int r, int c) { const int st = (r >> 4) * 2 + (c >> 5), rr = r & 15, cc = c & 31, ob = rr * 64 + cc * 2; return st * 1024 + (ob ^ (((ob >> 9) & 1) << 5)); }
__host__ __device__ __forceinline__ void stage_rc(int b, int& R, int& C) { const int st = b / 1024, sb = b % 1024, swz = sb ^ (((sb >> 9) & 1) << 5); R = (st >> 1) * 16 + swz / 64; C = (st & 1) * 32 + (swz % 64) / 2; }
__host__ __device__ __forceinline__ int perm32(int rho) { const int n = rho >> 4, i = rho & 15; return 8 * (i >> 2) + 4 * n + (i & 3); }

struct Unit { int pm, pn, kt0, nkt, piece; };
struct Gemm { const bf16_t* A; const bf16_t* Bt; int lda, ldb, K; size_t a_pn_off; size_t a_half, b_half, a_tile, b_tile; };

__device__ __forceinline__ void tile_of(int wgid, int nM, int nN, Unit& u) {
    const int nwg = nM * nN;
    { const int q = nwg / NXCD, r = nwg % NXCD, xcd = wgid % NXCD, off = wgid / NXCD; wgid = (xcd < r ? xcd * (q + 1) : r * (q + 1) + (xcd - r) * q) + off; }
    const int nig = WGM * nN, gid = wgid / nig, fm = gid * WGM, gsz = (nM - fm) < WGM ? (nM - fm) : WGM;
    u.pm = fm + ((wgid % nig) % gsz); u.pn = (wgid % nig) / gsz;
}
struct StaticOrder {
    int nM, nN, nwg, G, c, ntk;
    __device__ __forceinline__ void init(int M, int N, int K, int G_, int c_) { nM = M / BM; nN = N / BM; nwg = nM * nN; G = G_; c = c_; ntk = K / BK; }
    __device__ __forceinline__ bool next(int i, Unit& u) const {
        const long L = (long)i * G + c; if (L >= nwg) return false;
        tile_of((int)L, nM, nN, u); u.kt0 = 0; u.nkt = ntk; u.piece = -1; return true;
    }
};
struct OneUnitOrder {
    int n, c, ntk;
    __device__ __forceinline__ bool next(int i, Unit& u) const { if (i != 0 || c >= n) return false; u.pm = 0; u.pn = c; u.kt0 = 0; u.nkt = ntk; u.piece = -1; return true; }
};
struct DoubleOrder {
    int G, c;
    __device__ __forceinline__ bool next(int i, Unit& u) const {
        const int L = (i >> 1) * G + c, half = i & 1; const bool ok = L < 272;
        tile_of(ok ? L : 0, 34, 8, u); u.kt0 = 16 * half; u.nkt = 16; u.piece = half; return ok;
    }
};
struct SplitOrder {
    int G, c, ntk, pk, npc;
    __device__ __forceinline__ bool next(int i, Unit& u) const {
        const int L = i * G + c;
        const bool full = L < 256;
        int fpm, fpn;
        { int wgid = full ? L : 0; const int xcd = wgid % NXCD, off = wgid / NXCD; wgid = xcd * 32 + off;
          const int nig = WGM * 8, gid = wgid / nig, fm = gid * WGM; fpm = fm + ((wgid % nig) % WGM); fpn = (wgid % nig) / WGM; }
        const int pidx = full ? 0 : L - 256, tile = pidx / npc, pc = pidx - tile * npc;
        u.pm = full ? fpm : 32 + (tile >> 3); u.pn = full ? fpn : (tile & 7); u.kt0 = full ? 0 : pc * pk; u.nkt = full ? ntk : pk; u.piece = full ? -1 : pc;
        return full || pidx < 16 * npc;
    }
};

template <class Epi, class Sched>
__device__ __forceinline__ void gemm_phase(LAS unsigned char* lds, const Gemm g, const Sched& S, const Epi& E) {
    const int tid = threadIdx.x, wid = __builtin_amdgcn_readfirstlane(tid >> 6), lane = tid & 63, wr = wid >> 2, wc = wid & 3, fr = lane & 15, fq = lane >> 4;
    unsigned voffA[2], voffB[2];
#pragma unroll
    for (int i = 0; i < 2; ++i) { int R, C; stage_rc(tid * 16 + i * 8192, R, C); const int Rb = Epi::PERM ? ((R & ~31) + perm32(R & 31)) : R;
        voffA[i] = (unsigned)(R * g.lda + C) * 2u; voffB[i] = (unsigned)(Rb * g.ldb + C) * 2u; }
    const size_t kstep = (size_t)(BK * 2);
    const size_t hstepA = g.a_half ? g.a_half : (size_t)HALF * g.lda * 2, hstepB = g.b_half ? g.b_half : (size_t)HALF * g.ldb * 2;
    const size_t tstepA = g.a_tile ? g.a_tile : (size_t)BM * g.lda * 2, tstepB = g.b_tile ? g.b_tile : (size_t)BM * g.ldb * 2;
    const unsigned ldsw = (unsigned)wid * 1024u;
    const int aoff = lds_byte(wr * 64 + fr, fq * 8), boff = lds_byte(wc * 32 + fr, fq * 8);
#define PG8_SA(b, h) (((b) * 2 + (h)) * HTB)
#define PG8_SB(b, h) ((4 + (b) * 2 + (h)) * HTB)
#define PG8_STAGE(bufoff, gbase, voff) do { _Pragma("unroll") for (int _i = 0; _i < 2; ++_i) \
        __builtin_amdgcn_global_load_lds((const unsigned*)((const char*)(gbase) + (voff)[_i]), (LAS unsigned*)(lds + (bufoff) + ldsw + _i * 8192), 16, 0, 0); } while (0)
#define PG8_LDA(dst, b, h) do { _Pragma("unroll") for (int m = 0; m < 4; ++m) _Pragma("unroll") for (int k = 0; k < 2; ++k) dst[m][k] = *(const LAS bf16x8*)(lds + PG8_SA(b, h) + aoff + m * 2048 + k * 1024); } while (0)
#define PG8_LDB(dst, b, h) do { _Pragma("unroll") for (int n = 0; n < 2; ++n) _Pragma("unroll") for (int k = 0; k < 2; ++k) dst[n][k] = *(const LAS bf16x8*)(lds + PG8_SB(b, h) + boff + n * 2048 + k * 1024); } while (0)
#define PG8_MMA(ai, bj, At, Bt) do { __builtin_amdgcn_s_setprio(1); _Pragma("unroll") for (int m = 0; m < 4; ++m) _Pragma("unroll") for (int n = 0; n < 2; ++n) _Pragma("unroll") for (int k = 0; k < 2; ++k) \
        acc[ai][bj][m][n] = __builtin_amdgcn_mfma_f32_16x16x32_bf16(Bt[n][k], At[m][k], acc[ai][bj][m][n], 0, 0, 0); __builtin_amdgcn_s_setprio(0); } while (0)
#define PG8_WAIT_V(n) asm volatile("s_waitcnt vmcnt(" #n ")" ::: "memory")
#define PG8_WAIT_L(n) asm volatile("s_waitcnt lgkmcnt(" #n ")" ::: "memory")
#define PG8_BAR __builtin_amdgcn_s_barrier()
#define PG8_SCHED __builtin_amdgcn_sched_barrier(0)
    Unit cur, nxt; int ui = 0;
    if (!S.next(0, cur)) return;
    f32x4 acc[2][2][4][2];
#pragma unroll
    for (int a = 0; a < 2; ++a)
#pragma unroll
        for (int b = 0; b < 2; ++b)
#pragma unroll
            for (int m = 0; m < 4; ++m)
#pragma unroll
                for (int n = 0; n < 2; ++n) acc[a][b][m][n] = (f32x4){0.f, 0.f, 0.f, 0.f};
    bf16x8 At[4][2], B0[2][2], B1[2][2];
    const char* cA = (const char*)g.A + (size_t)cur.pm * tstepA + (size_t)cur.pn * g.a_pn_off + (size_t)cur.kt0 * kstep; const char* cB = (const char*)g.Bt + (size_t)cur.pn * tstepB + (size_t)cur.kt0 * kstep;
    PG8_STAGE(PG8_SB(0, 0), cB, voffB); PG8_STAGE(PG8_SA(0, 0), cA, voffA); PG8_STAGE(PG8_SB(0, 1), cB + hstepB, voffB); PG8_STAGE(PG8_SA(0, 1), cA + hstepA, voffA);
    if (wr == 1) PG8_BAR;
    PG8_WAIT_V(4); PG8_BAR;
    PG8_STAGE(PG8_SB(1, 0), cB + kstep, voffB); PG8_STAGE(PG8_SA(1, 0), cA + kstep, voffA); PG8_STAGE(PG8_SB(1, 1), cB + hstepB + kstep, voffB);
    PG8_WAIT_V(6); PG8_BAR;
    for (;;) {
        const bool has_next = S.next(ui + 1, nxt);
        const char* nA = has_next ? (const char*)g.A + (size_t)nxt.pm * tstepA + (size_t)nxt.pn * g.a_pn_off + (size_t)nxt.kt0 * kstep : cA; const char* nB = has_next ? (const char*)g.Bt + (size_t)nxt.pn * tstepB + (size_t)nxt.kt0 * kstep : cB;
        const int nt = cur.nkt;
#pragma unroll 1
        for (int t = 0; t < nt; t += 2) {
            const bool last = (t == nt - 2);
            const char* a1 = cA + (size_t)(t + 1) * kstep;
            const char* a2 = last ? nA : cA + (size_t)(t + 2) * kstep; const char* b2 = last ? nB : cB + (size_t)(t + 2) * kstep;
            const char* a3 = a2 + kstep; const char* b3 = b2 + kstep;
            PG8_LDB(B0, 0, 0); PG8_SCHED; PG8_LDA(At, 0, 0); PG8_STAGE(PG8_SA(1, 1), a1 + hstepA, voffA);
            PG8_WAIT_L(8); PG8_BAR; PG8_WAIT_L(0); PG8_MMA(0, 0, At, B0); PG8_BAR; PG8_SCHED;
            PG8_LDB(B1, 0, 1); PG8_STAGE(PG8_SB(0, 0), b2, voffB);
            PG8_BAR; PG8_WAIT_L(0); if constexpr (!Epi::DIAG) PG8_MMA(0, 1, At, B1); PG8_BAR;
            PG8_LDA(At, 0, 1); PG8_STAGE(PG8_SA(0, 0), a2, voffA);
            PG8_BAR; PG8_WAIT_L(0); if constexpr (!Epi::DIAG) PG8_MMA(1, 0, At, B0); PG8_BAR; PG8_SCHED;
            PG8_STAGE(PG8_SB(0, 1), b2 + hstepB, voffB);
            PG8_WAIT_V(6); PG8_BAR; PG8_MMA(1, 1, At, B1); PG8_BAR;
            PG8_LDB(B0, 1, 0); PG8_SCHED; PG8_LDA(At, 1, 0); PG8_STAGE(PG8_SA(0, 1), a2 + hstepA, voffA);
            PG8_WAIT_L(8); PG8_BAR; PG8_WAIT_L(0); PG8_MMA(0, 0, At, B0); PG8_BAR; PG8_SCHED;
            PG8_LDB(B1, 1, 1); PG8_STAGE(PG8_SB(1, 0), b3, voffB);
            PG8_BAR; PG8_WAIT_L(0); if constexpr (!Epi::DIAG) PG8_MMA(0, 1, At, B1); PG8_BAR;
            PG8_LDA(At, 1, 1); PG8_STAGE(PG8_SA(1, 0), a3, voffA);
            PG8_BAR; PG8_WAIT_L(0); if constexpr (!Epi::DIAG) PG8_MMA(1, 0, At, B0); PG8_BAR; PG8_SCHED;
            PG8_STAGE(PG8_SB(1, 1), b3 + hstepB, voffB);
            PG8_WAIT_V(6); PG8_BAR; PG8_MMA(1, 1, At, B1); PG8_BAR;
        }
        E(acc, cur, wr, wc, fr, fq);
        if (!has_next) break;
#pragma unroll
        for (int a = 0; a < 2; ++a)
#pragma unroll
            for (int b = 0; b < 2; ++b)
#pragma unroll
                for (int m = 0; m < 4; ++m)
#pragma unroll
                    for (int n = 0; n < 2; ++n) acc[a][b][m][n] = (f32x4){0.f, 0.f, 0.f, 0.f};
        cur = nxt; cA = nA; cB = nB; ++ui;
    }
    PG8_WAIT_V(0);
    if (wr == 0) PG8_BAR;
    PG8_BAR;
#undef PG8_SA
#undef PG8_SB
#undef PG8_STAGE
#undef PG8_LDA
#undef PG8_LDB
#undef PG8_MMA
#undef PG8_WAIT_V
#undef PG8_WAIT_L
#undef PG8_BAR
#undef PG8_SCHED
}

typedef f32x4 Acc[2][2][4][2];

struct EpiAda {
    static constexpr bool PERM = false, MID = false, DIAG = false;
    float* C; const float* bias;
    __device__ __forceinline__ void operator()(const Acc& acc, const Unit& u, int wr, int wc, int fr, int fq) const {
        const int row0 = wr * 64 + fr, col0 = u.pn * BM + wc * 32 + 4 * fq;
#pragma unroll
        for (int ai = 0; ai < 2; ++ai)
#pragma unroll
            for (int m = 0; m < 4; ++m) { const int row = row0 + ai * HALF + m * 16; if (row < NB) {
#pragma unroll
                for (int bj = 0; bj < 2; ++bj)
#pragma unroll
                    for (int n = 0; n < 2; ++n) { const int c = col0 + bj * HALF + n * 16; *(f32x4*)(C + (size_t)row * MODW + c) = acc[ai][bj][m][n] + *(const f32x4*)(bias + c); } } }
    }
};
struct EpiBf16 {
    static constexpr bool PERM = true, MID = false, DIAG = false;
    bf16_t* O; int ldc; int col_off; const float* scale;
    __device__ __forceinline__ void operator()(const Acc& acc, const Unit& u, int wr, int wc, int fr, int fq) const {
        const int row0 = u.pm * BM + wr * 64 + fr, col0 = u.pn * BM + wc * 32 + 8 * fq;
#pragma unroll
        for (int ai = 0; ai < 2; ++ai)
#pragma unroll
            for (int m = 0; m < 4; ++m) { bf16_t* rowp = O + (size_t)(row0 + ai * HALF + m * 16) * ldc + col_off + col0;
#pragma unroll
                for (int bj = 0; bj < 2; ++bj) { f32x4 v0 = acc[ai][bj][m][0], v1 = acc[ai][bj][m][1];
                    if (scale) { v0 *= *(const f32x4*)(scale + col0 + bj * HALF); v1 *= *(const f32x4*)(scale + col0 + bj * HALF + 4); }
                    u32x4 w; w.x = pk2(v0[0], v0[1]); w.y = pk2(v0[2], v0[3]); w.z = pk2(v1[0], v1[1]); w.w = pk2(v1[2], v1[3]);
                    *(u32x4*)(rowp + bj * HALF) = w; }
                if (scale) asm volatile("" ::: "memory"); }
    }
};
struct EpiG1 {
    static constexpr bool PERM = true, MID = false, DIAG = false;
    float* T1; const bf16_t* proj;
    __device__ __forceinline__ void operator()(const Acc& acc, const Unit& u, int wr, int wc, int fr, int fq) const {
        const int row0 = u.pm * BM + wr * 64 + fr, col0 = u.pn * BM + wc * 32 + 8 * fq;
#pragma unroll
        for (int ai = 0; ai < 2; ++ai)
#pragma unroll
            for (int m = 0; m < 4; ++m) { const size_t row = (size_t)(row0 + ai * HALF + m * 16); const bf16_t* pr = proj + row * NPROJ + col0;
#pragma unroll
                for (int bj = 0; bj < 2; ++bj) { float ga[8]; unpack8(*(const u32x4*)(pr + C_GA + bj * HALF), ga); f32x4 v0, v1;
#pragma unroll
                    for (int j = 0; j < 4; ++j) { v0[j] = acc[ai][bj][m][0][j] * __builtin_amdgcn_rcpf(1.0f + __expf(-ga[j])); v1[j] = acc[ai][bj][m][1][j] * __builtin_amdgcn_rcpf(1.0f + __expf(-ga[4 + j])); }
                    float* o = T1 + row * DM + col0 + bj * HALF; *(f32x4*)o = v0; *(f32x4*)(o + 4) = v1; }
                }
    }
};
struct EpiG2 {
    static constexpr bool PERM = true, MID = false, DIAG = false;
    bf16_t* O; const float* T1; const bf16_t* proj;
    __device__ __forceinline__ void operator()(const Acc& acc, const Unit& u, int wr, int wc, int fr, int fq) const {
        const int row0 = u.pm * BM + wr * 64 + fr, col0 = u.pn * BM + wc * 32 + 8 * fq;
#pragma unroll
        for (int ai = 0; ai < 2; ++ai)
#pragma unroll
            for (int m = 0; m < 4; ++m) { const size_t row = (size_t)(row0 + ai * HALF + m * 16); const bf16_t* pr = proj + row * NPROJ + col0;
#pragma unroll
                for (int bj = 0; bj < 2; ++bj) { float gb[8], v[8]; unpack8(*(const u32x4*)(pr + C_GB + bj * HALF), gb);
                    const float* t = T1 + row * DM + col0 + bj * HALF; const f32x4 t0 = *(const f32x4*)t, t1 = *(const f32x4*)(t + 4);
#pragma unroll
                    for (int j = 0; j < 4; ++j) { v[j] = t0[j] + acc[ai][bj][m][0][j] * __builtin_amdgcn_rcpf(1.0f + __expf(-gb[j])); v[4 + j] = t1[j] + acc[ai][bj][m][1][j] * __builtin_amdgcn_rcpf(1.0f + __expf(-gb[4 + j])); }
                    *(u32x4*)(O + row * DM + col0 + bj * HALF) = pack8(v); }
                if (m & 1) asm volatile("" ::: "memory"); }
    }
};
struct EpiG12 {
    static constexpr bool PERM = true, MID = false, DIAG = false;
    EpiG1 e1; EpiG2 e2;
    __device__ __forceinline__ void operator()(const Acc& acc, const Unit& u, int wr, int wc, int fr, int fq) const { if (u.piece == 0) e1(acc, u, wr, wc, fr, fq); else e2(acc, u, wr, wc, fr, fq); }
};
struct EpiDiag {
    static constexpr bool PERM = true, MID = false, DIAG = true;
    bf16_t* O; const bf16_t* proj;
    __device__ __forceinline__ void operator()(const Acc& acc, const Unit& u, int wr, int wc, int fr, int fq) const {
        const int row0 = u.pm * HALF + wr * 64 + fr, col0 = u.pn * HALF + wc * 32 + 8 * fq;
#pragma unroll
        for (int m = 0; m < 4; ++m) { const size_t row = (size_t)(row0 + m * 16); const bf16_t* pr = proj + row * NPROJ + col0;
            float ga[8], gb[8], v[8]; unpack8(*(const u32x4*)(pr + C_GA), ga); unpack8(*(const u32x4*)(pr + C_GB), gb);
#pragma unroll
            for (int n = 0; n < 2; ++n)
#pragma unroll
                for (int j = 0; j < 4; ++j) v[4 * n + j] = acc[0][0][m][n][j] * __builtin_amdgcn_rcpf(1.0f + __expf(-ga[4 * n + j])) + acc[1][1][m][n][j] * __builtin_amdgcn_rcpf(1.0f + __expf(-gb[4 * n + j]));
            *(u32x4*)(O + row * DM + col0) = pack8(v); }
    }
};
struct EpiRes {
    static constexpr bool PERM = false, MID = false, DIAG = false;
    float* X1; const float* x0p; const float* x0s; const float* gate; float* PB;
    __device__ __forceinline__ void operator()(const Acc& acc, const Unit& u, int wr, int wc, int fr, int fq) const {
        const int row0 = u.pm * BM + wr * 64 + fr, col0 = u.pn * BM + wc * 32 + 4 * fq;
        if (u.piece >= 0) {
            float* pb = PB + (size_t)u.piece * TS * DM;
#pragma unroll
            for (int ai = 0; ai < 2; ++ai)
#pragma unroll
                for (int m = 0; m < 4; ++m) { float* orow = pb + (size_t)(row0 + ai * HALF + m * 16 - TP) * DM;
#pragma unroll
                    for (int bj = 0; bj < 2; ++bj)
#pragma unroll
                        for (int n = 0; n < 2; ++n) *(f32x4*)(orow + col0 + bj * HALF + n * 16) = acc[ai][bj][m][n]; }
            return;
        }
#pragma unroll
        for (int ai = 0; ai < 2; ++ai)
#pragma unroll
            for (int m = 0; m < 4; ++m) { const int row = row0 + ai * HALF + m * 16; const int b = bidx_of_row(row);
                const float* xr = (row < TP) ? x0p + (size_t)row * DM : x0s + (size_t)(row - TP) * DM; const float* gr = gate + (size_t)b * MODW; float* orow = X1 + (size_t)row * DM;
#pragma unroll
                for (int bj = 0; bj < 2; ++bj)
#pragma unroll
                    for (int n = 0; n < 2; ++n) { const int c = col0 + bj * HALF + n * 16; const f32x4 xv = *(const f32x4*)(xr + c), gv = *(const f32x4*)(gr + c);
                        *(f32x4*)(orow + c) = xv + gv * acc[ai][bj][m][n]; } }
    }
};
struct EpiGU {
    static constexpr bool PERM = true, MID = false, DIAG = false;
    bf16_t* O;
    __device__ __forceinline__ void operator()(const Acc& acc, const Unit& u, int wr, int wc, int fr, int fq) const {
        const int row0 = u.pm * BM + wr * 64 + fr, col0 = u.pn * HALF + wc * 32 + 8 * fq;
#pragma unroll
        for (int ai = 0; ai < 2; ++ai)
#pragma unroll
            for (int m = 0; m < 4; ++m) { float v[8];
#pragma unroll
                for (int n = 0; n < 2; ++n)
#pragma unroll
                    for (int j = 0; j < 4; ++j) { const float gt = acc[ai][0][m][n][j]; v[4 * n + j] = gt * __builtin_amdgcn_rcpf(1.0f + __expf(-gt)) * acc[ai][1][m][n][j]; }
                *(u32x4*)(O + (size_t)(row0 + ai * HALF + m * 16) * DFF + col0) = pack8(v); }
    }
};
}

struct TJob { const float* src; bf16_t* dst; int ld_src, K, Nout, ld_dst, map, pad; };
__device__ __forceinline__ int map_col(int map, int n) {
    if (map == 1) { if (n < 4096) return n; if (n < 5120) return 4112 + (n - 4096); if (n < 9216) return 5136 + (n - 5120); if (n < 9232) return 4096 + (n - 9216); return -1; }
    if (map == 2) { const int pn = n >> 8, w = n & 255; return w < 128 ? 128 * pn + w : DFF + 128 * pn + (w - 128); }
    return n;
}
__device__ __forceinline__ void tjob_load(const TJob& j, int tile, f32x4 (&v)[4]) {
    const int tid = threadIdx.x, nkt = j.K >> 7, tn = tile / nkt, tk = tile - tn * nkt;
    const int n = tn * 64 + (tid & 15) * 4, kr = tid >> 4, col = map_col(j.map, n);
#pragma unroll
    for (int i = 0; i < 4; ++i) v[i] = col >= 0 ? __builtin_nontemporal_load((const f32x4*)(j.src + (size_t)(tk * 128 + kr + 32 * i) * j.ld_src + col)) : (f32x4){0.f, 0.f, 0.f, 0.f};
}
__device__ __forceinline__ void tjob_store(const TJob& j, int tile, const f32x4 (&v)[4], LAS float* s) {
    const int tid = threadIdx.x, nkt = j.K >> 7, tn = tile / nkt, tk = tile - tn * nkt;
    const int nq = tid & 15, kr = tid >> 4;
    __syncthreads();
#pragma unroll
    for (int i = 0; i < 4; ++i)
#pragma unroll
        for (int q = 0; q < 4; ++q) s[(4 * nq + q) * 129 + kr + 32 * i] = v[i][q];
    __syncthreads();
    const int n = tid >> 3, k16 = (tid & 7) * 16;
    float f[16];
#pragma unroll
    for (int i = 0; i < 16; ++i) f[i] = s[n * 129 + k16 + i];
    bf16_t* d = j.dst + (size_t)(tn * 64 + n) * j.ld_dst + tk * 128 + k16;
    *(u32x4*)d = pack8(f); *(u32x4*)(d + 8) = pack8(f + 8);
}
__device__ __forceinline__ void transpose_jobs(const TJob* jobs, int njobs, int bi, int nblk, LAS unsigned char* lds) {
    LAS float* s = (LAS float*)lds;
    int total = 0;
    for (int q = 0; q < njobs; ++q) total += (jobs[q].Nout >> 6) * (jobs[q].K >> 7);
    f32x4 v[4]; int curj = 0, base = 0;
    int t = bi;
    auto locate = [&](int tt, int& jj, int& bb) { while (tt >= bb + (jobs[jj].Nout >> 6) * (jobs[jj].K >> 7)) { bb += (jobs[jj].Nout >> 6) * (jobs[jj].K >> 7); ++jj; } };
    if (t < total) { locate(t, curj, base); tjob_load(jobs[curj], t - base, v); }
    while (t < total) {
        const int tn = t + nblk; int nj = curj, nb = base; f32x4 w[4];
        if (tn < total) { locate(tn, nj, nb); tjob_load(jobs[nj], tn - nb, w); }
        tjob_store(jobs[curj], t - base, v, s);
        if (tn < total) {
#pragma unroll
            for (int i = 0; i < 4; ++i) v[i] = w[i]; }
        t = tn; curj = nj; base = nb;
    }
    __syncthreads();
}

template <int MODE>
__device__ __forceinline__ void norm_phase(const Params& p, int bid, int nblk) {
    const int lane = threadIdx.x & 63, wid = __builtin_amdgcn_readfirstlane(threadIdx.x >> 6);
    const float* mod = (const float*)(p.ws + WS_MOD);
    const float* gain = MODE == 0 ? p.in[9] : (MODE == 1 ? p.in[20] : p.in[23]);
    bf16_t* U = (bf16_t*)(p.ws + WS_U);
    for (int row = bid * 8 + wid; row < TT; row += nblk * 8) {
        const float* src = MODE == 0 ? (row < TP ? p.in[0] + (size_t)row * DM : p.in[1] + (size_t)(row - TP) * DM) : p.out + O_Y + (size_t)row * DM;
        if (MODE != 0 && row >= TP) {
            const float* xs = p.in[1] + (size_t)(row - TP) * DM;
            const float* pb = (const float*)(p.ws + (MODE == 1 ? WS_PB10 : WS_PB13)) + (size_t)(row - TP) * DM;
            const float* gt = mod + (size_t)bidx_of_row(row) * MODW + (MODE == 1 ? 4096 : 10240);
            float* xo = p.out + O_Y + (size_t)row * DM;
            constexpr int NPC = MODE == 1 ? 8 : 11;
#pragma unroll 1
            for (int i = 0; i < 8; ++i) { const int c = i * 256 + lane * 4; f32x4 s = *(const f32x4*)(pb + c);
#pragma unroll
                for (int q = 1; q < NPC; ++q) s += *(const f32x4*)(pb + (size_t)q * TS * DM + c);
                const f32x4 base = MODE == 1 ? *(const f32x4*)(xs + c) : *(const f32x4*)(xo + c);
                *(f32x4*)(xo + c) = base + *(const f32x4*)(gt + c) * s; }
            asm volatile("s_waitcnt vmcnt(0)" ::: "memory");
        }
        f32x4 v[8]; float ss = 0.f;
#pragma unroll
        for (int i = 0; i < 8; ++i) v[i] = *(const f32x4*)(src + i * 256 + lane * 4);
#pragma unroll
        for (int i = 0; i < 8; ++i) ss += v[i][0] * v[i][0] + v[i][1] * v[i][1] + v[i][2] * v[i][2] + v[i][3] * v[i][3];
#pragma unroll
        for (int o = 32; o >= 1; o >>= 1) ss += __shfl_xor(ss, o);
        const float rstd = rsqrtf(ss * (1.0f / DM) + EPS);
        if (MODE == 2) {
            float* dst = p.out + O_Y + (size_t)row * DM;
#pragma unroll
            for (int i = 0; i < 8; ++i) { const f32x4 g = *(const f32x4*)(gain + i * 256 + lane * 4); *(f32x4*)(dst + i * 256 + lane * 4) = v[i] * rstd * g; }
        } else {
            const float* sh = mod + (size_t)bidx_of_row(row) * MODW + (MODE == 0 ? 0 : 6144); const float* sc = sh + 2048;
#pragma unroll
            for (int i = 0; i < 8; ++i) { const int c = i * 256 + lane * 4; const f32x4 g = *(const f32x4*)(gain + c), s1 = *(const f32x4*)(sc + c), s0 = *(const f32x4*)(sh + c);
                const f32x4 y = (v[i] * rstd * g) * (1.0f + s1) + s0; u32x2 w; w.x = pk2(y[0], y[1]); w.y = pk2(y[2], y[3]); *(u32x2*)(U + (size_t)row * DM + c) = w; }
        }
    }
}

template <int NTOK, bool SMP>
__device__ __forceinline__ void mixer_item(const Params& p, int it) {
    const int tid = threadIdx.x;
    const bf16_t* proj = (const bf16_t*)(p.ws + WS_PROJ);
    bf16_t* qn = (bf16_t*)(p.ws + WS_QN); bf16_t* kn = (bf16_t*)(p.ws + WS_KN); bf16_t* vv = (bf16_t*)(p.ws + WS_VV); bf16_t* yp = (bf16_t*)(p.ws + WS_YP);
    float* gbuf = (float*)(p.ws + WS_G); float* bbuf = (float*)(p.ws + WS_BETA);
    const int sb = it - 512;
    const int b = SMP ? 0 : (it >> 7), t0 = SMP ? 0 : (it & 127) * 16;
    const int rowbase = SMP ? TP + sb * 4 : b * 2048 + t0;
    if (tid < 384) {
        const int c0 = tid * 8;
        float w0[8], w1[8], w2[8], w3[8], xm3[8], xm2[8], xm1[8];
        const float* cw = p.in[11];
#pragma unroll
        for (int i = 0; i < 8; ++i) { w0[i] = cw[c0 + i]; w1[i] = cw[3072 + c0 + i]; w2[i] = cw[6144 + c0 + i]; w3[i] = cw[9216 + c0 + i]; }
        if (SMP) { const float* sc = p.in[5] + (size_t)sb * 3 * 3072 + c0;
#pragma unroll
            for (int i = 0; i < 8; ++i) { xm3[i] = sc[i]; xm2[i] = sc[3072 + i]; xm1[i] = sc[6144 + i]; }
        } else if (t0 == 0) {
#pragma unroll
            for (int i = 0; i < 8; ++i) { xm3[i] = 0.f; xm2[i] = 0.f; xm1[i] = 0.f; }
        } else {
            unpack8(*(const u32x4*)(proj + (size_t)(rowbase - 3) * NPROJ + c0), xm3); unpack8(*(const u32x4*)(proj + (size_t)(rowbase - 2) * NPROJ + c0), xm2); unpack8(*(const u32x4*)(proj + (size_t)(rowbase - 1) * NPROJ + c0), xm1);
        }
        constexpr int CH = NTOK < 8 ? NTOK : 8;
#pragma unroll 1
        for (int tc = 0; tc < NTOK; tc += CH) {
        u32x4 xr[CH];
#pragma unroll
        for (int t = 0; t < CH; ++t) xr[t] = *(const u32x4*)(proj + (size_t)(rowbase + tc + t) * NPROJ + c0);
#pragma unroll
        for (int t2 = 0; t2 < CH; ++t2) {
            const int t = tc + t2;
            const int row = rowbase + t; float xt[8], y[8];
            unpack8(xr[t2], xt);
            float ss = 0.f;
#pragma unroll
            for (int i = 0; i < 8; ++i) { const float a = w0[i] * xm3[i] + w1[i] * xm2[i] + w2[i] * xm1[i] + w3[i] * xt[i]; y[i] = siluf_(a); ss += y[i] * y[i]; }
            if (c0 < 2048) {
                ss += __shfl_xor(ss, 1); ss += __shfl_xor(ss, 2); ss += __shfl_xor(ss, 4); ss += __shfl_xor(ss, 8);
                const float inv = rsqrtf(ss + EPS);
#pragma unroll
                for (int i = 0; i < 8; ++i) y[i] *= inv;
            }
            bf16_t* dst = c0 < 1024 ? qn + (size_t)row * 1024 + c0 : (c0 < 2048 ? kn + (size_t)row * 1024 + (c0 - 1024) : vv + (size_t)row * 1024 + (c0 - 2048));
            *(u32x4*)dst = pack8(y);
            if (SMP) { if (t >= 1) { float* o = p.out + O_CS + ((size_t)sb * 3 + (t - 1)) * 3072 + c0; *(f32x4*)o = (f32x4){xt[0], xt[1], xt[2], xt[3]}; *(f32x4*)(o + 4) = (f32x4){xt[4], xt[5], xt[6], xt[7]}; } }
            else if (t0 + t >= 2045) { float* o = p.out + O_CP + ((size_t)b * 3 + (t0 + t - 2045)) * 3072 + c0; *(f32x4*)o = (f32x4){xt[0], xt[1], xt[2], xt[3]}; *(f32x4*)(o + 4) = (f32x4){xt[4], xt[5], xt[6], xt[7]}; }
#pragma unroll
            for (int i = 0; i < 8; ++i) { xm3[i] = xm2[i]; xm2[i] = xm1[i]; xm1[i] = xt[i]; }
        }
        }
    } else {
        const int pc = (tid - 384) * 8, gi = pc >> 8, w = 2 << gi;
        const int seqrow0 = SMP ? TP + sb * 4 : b * 2048;
        const float* sp = p.in[6] + (size_t)sb * 15 * 1024 + pc;
        auto xpool = [&](int tt, float* f) {
            if (tt >= 0) unpack8(*(const u32x4*)(proj + (size_t)(seqrow0 + tt) * NPROJ + C_XP + pc), f);
            else if (SMP) { const float* s = sp + (size_t)(15 + tt) * 1024;
#pragma unroll
                for (int i = 0; i < 8; ++i) f[i] = s[i]; }
            else {
#pragma unroll
                for (int i = 0; i < 8; ++i) f[i] = 0.f; }
        };
        float s[8];
#pragma unroll
        for (int i = 0; i < 8; ++i) s[i] = 0.f;
#pragma unroll
        for (int q = 1; q < 16; ++q) if (q < w) { float f[8]; xpool(t0 - q, f);
#pragma unroll
            for (int i = 0; i < 8; ++i) s[i] += f[i]; }
#pragma unroll 4
        for (int t = 0; t < NTOK; ++t) {
            const int tt = t0 + t; float x[8], y[8], f[8];
            xpool(tt, x);
            const float cnt = SMP ? (float)w : (float)min(w, tt + 1); const float ic = 1.0f / cnt;
#pragma unroll
            for (int i = 0; i < 8; ++i) { s[i] += x[i]; y[i] = s[i] * ic - x[i]; }
            *(u32x4*)(yp + (size_t)(seqrow0 + tt) * 1024 + pc) = pack8(y);
            xpool(tt - w + 1, f);
#pragma unroll
            for (int i = 0; i < 8; ++i) s[i] -= f[i];
            if (SMP) { float* o = p.out + O_PS + ((size_t)sb * 15 + 11 + t) * 1024 + pc; *(f32x4*)o = (f32x4){x[0], x[1], x[2], x[3]}; *(f32x4*)(o + 4) = (f32x4){x[4], x[5], x[6], x[7]}; }
            else if (tt >= 2033) { float* o = p.out + O_PP + ((size_t)b * 15 + (tt - 2033)) * 1024 + pc; *(f32x4*)o = (f32x4){x[0], x[1], x[2], x[3]}; *(f32x4*)(o + 4) = (f32x4){x[4], x[5], x[6], x[7]}; }
        }
        if (SMP) {
#pragma unroll
            for (int r = 0; r < 11; ++r) { const float* s2 = sp + (size_t)(4 + r) * 1024; float* o = p.out + O_PS + ((size_t)sb * 15 + r) * 1024 + pc; *(f32x4*)o = *(const f32x4*)s2; *(f32x4*)(o + 4) = *(const f32x4*)(s2 + 4); } }
    }
    if (tid < 256) { const int tk = tid >> 4, jj = tid & 15;
        if (tk < NTOK) { const int row = rowbase + tk; const float val = bf2f(proj[(size_t)row * NPROJ + C_AB + jj]);
            if (jj < 8) { const float xx = val + p.in[13][jj]; const float spl = xx > 20.f ? xx : log1pf(__expf(xx)); gbuf[row * 8 + jj] = -__expf(p.in[12][jj]) * spl; }
            else bbuf[row * 8 + (jj - 8)] = sigmoidf_(val); } }
}
__device__ __forceinline__ void mixer_prep_phase(const Params& p, int bid, int nblk) {
    for (int it = bid; it < 640; it += nblk) { if (it >= 512) mixer_item<4, true>(p, it); else mixer_item<16, false>(p, it); }
}

constexpr int P5_QS = 0, P5_KS = 17408, P5_VS = 34816, P5_MM = 52224, P5_DEC = 68608, P5_BETA = 68864, P5_GRP = 69632;
static_assert(2 * P5_GRP <= LDS_BYTES - 16, "lds");
__device__ __forceinline__ void chunk_prep_phase(const Params& p, int bid, int nblk, LAS unsigned char* lds0) {
    const int tid = threadIdx.x, lane = tid & 63, grp = tid >> 8, lt = tid & 255, lw = __builtin_amdgcn_readfirstlane(tid >> 6) & 3;
    LAS unsigned char* lds = lds0 + grp * P5_GRP;
    const bf16_t* qn = (const bf16_t*)(p.ws + WS_QN); const bf16_t* kn = (const bf16_t*)(p.ws + WS_KN); const bf16_t* vv = (const bf16_t*)(p.ws + WS_VV);
    const float* gbuf = (const float*)(p.ws + WS_G); const float* bbuf = (const float*)(p.ws + WS_BETA);
    bf16_t* wdc = (bf16_t*)(p.ws + WS_WDC); bf16_t* qd = (bf16_t*)(p.ws + WS_QD); bf16_t* kt = (bf16_t*)(p.ws + WS_KT); bf16_t* qk = (bf16_t*)(p.ws + WS_QK);
    float* cdv = (float*)(p.ws + WS_CD); float* ub = p.out + OS_UB;
    LAS float* Mm = (LAS float*)(lds + P5_MM); LAS float* dec = (LAS float*)(lds + P5_DEC); LAS float* bet = (LAS float*)(lds + P5_BETA);
    const float scale = 0.08838834764831845f;
    for (int it0 = bid * 2; it0 < 1024; it0 += nblk * 2) {
        const int item = it0 + grp, n = item & 31, bh = item >> 5, h = bh & 7, b = bh >> 3;
        const int r0 = b * 2048 + n * 64;
        __syncthreads();
#pragma unroll
        for (int i = 0; i < 4; ++i) { const int ch = lt + 256 * i, r = ch >> 4, c8 = (ch & 15) * 8; const size_t go = (size_t)(r0 + r) * 1024 + h * 128 + c8; const int lo = r * 272 + c8 * 2;
            *(LAS u32x4*)(lds + P5_QS + lo) = *(const u32x4*)(qn + go); *(LAS u32x4*)(lds + P5_KS + lo) = *(const u32x4*)(kn + go); *(LAS u32x4*)(lds + P5_VS + lo) = *(const u32x4*)(vv + go); }
        if (lt < 64) {
            float g = gbuf[(r0 + lt) * 8 + h];
#pragma unroll
            for (int o = 1; o < 64; o <<= 1) { const float t = __shfl_up(g, o); if (lane >= o) g += t; }
            dec[lt] = g;
        } else if (lt < 128) bet[lt - 64] = bbuf[(r0 + lt - 64) * 8 + h];
        __syncthreads();
        {
            const int rt = lw, fr = lane & 15, fq = lane >> 4;
#pragma unroll
            for (int mat = 0; mat < 2; ++mat) {
                bf16x8 a[4];
#pragma unroll
                for (int kk = 0; kk < 4; ++kk) a[kk] = *(const LAS bf16x8*)(lds + (mat ? P5_QS : P5_KS) + (rt * 16 + fr) * 272 + (kk * 32 + fq * 8) * 2);
#pragma unroll
                for (int st = 0; st < 4; ++st) {
                    f32x4 d = (f32x4){0.f, 0.f, 0.f, 0.f};
#pragma unroll
                    for (int kk = 0; kk < 4; ++kk) { const bf16x8 bb = *(const LAS bf16x8*)(lds + P5_KS + (st * 16 + fr) * 272 + (kk * 32 + fq * 8) * 2); d = __builtin_amdgcn_mfma_f32_16x16x32_bf16(a[kk], bb, d, 0, 0, 0); }
                    const int s = st * 16 + fr; const float ds = dec[s];
#pragma unroll
                    for (int j = 0; j < 4; ++j) { const int r = rt * 16 + fq * 4 + j; const float dr = dec[r];
                        if (mat == 0) Mm[r * 64 + s] = (r > s) ? bet[r] * d[j] * __expf(dr - ds) : 0.f;
                        else qk[(size_t)item * 4096 + r * 64 + s] = f2bf((r >= s) ? scale * d[j] * __expf(dr - ds) : 0.f); }
                }
            }
        }
        __syncthreads();
        const int w8 = __builtin_amdgcn_readfirstlane(tid >> 6);
        if (w8 < 4) {
            const int g2 = w8 >> 1, c = (w8 & 1) * 64 + lane; const int item2 = it0 + g2;
            LAS unsigned char* lg = lds0 + g2 * P5_GRP; LAS float* Mg = (LAS float*)(lg + P5_MM); LAS float* decg = (LAS float*)(lg + P5_DEC); LAS float* betg = (LAS float*)(lg + P5_BETA);
            float x[64], y[64]; f32x4 mq[6]; float a0, a1, b0, b1;
            float* up = ub + (size_t)item2 * 8192 + c; bf16_t* wp = wdc + (size_t)item2 * 8192 + c;
            { const float br = betg[0]; a0 = bf2f(*(const LAS bf16_t*)(lg + P5_VS + 0 + c * 2)) * br; b0 = bf2f(*(const LAS bf16_t*)(lg + P5_KS + 0 + c * 2)) * br * __expf(decg[0]); a1 = 0.f; b1 = 0.f; } x[0] = a0; y[0] = b0; up[0] = x[0]; wp[0] = f2bf(-y[0]);
            mq[0] = *(const LAS f32x4*)(Mg + 64); mq[1] = *(const LAS f32x4*)(Mg + 128); mq[2] = *(const LAS f32x4*)(Mg + 192); mq[3] = *(const LAS f32x4*)(Mg + 256); mq[4] = *(const LAS f32x4*)(Mg + 320); mq[5] = *(const LAS f32x4*)(Mg + 324);
            { const float br = betg[1]; a0 = bf2f(*(const LAS bf16_t*)(lg + P5_VS + 272 + c * 2)) * br; b0 = bf2f(*(const LAS bf16_t*)(lg + P5_KS + 272 + c * 2)) * br * __expf(decg[1]); a1 = 0.f; b1 = 0.f; } a0 -= mq[0][0] * x[0]; b0 -= mq[0][0] * y[0]; x[1] = a0 + a1; y[1] = b0 + b1; up[128] = x[1]; wp[128] = f2bf(-y[1]); mq[0] = *(const LAS f32x4*)(Mg + 384);
            { const float br = betg[2]; a0 = bf2f(*(const LAS bf16_t*)(lg + P5_VS + 544 + c * 2)) * br; b0 = bf2f(*(const LAS bf16_t*)(lg + P5_KS + 544 + c * 2)) * br * __expf(decg[2]); a1 = 0.f; b1 = 0.f; } a0 -= mq[1][0] * x[0]; b0 -= mq[1][0] * y[0]; a1 -= mq[1][1] * x[1]; b1 -= mq[1][1] * y[1]; x[2] = a0 + a1; y[2] = b0 + b1; up[256] = x[2]; wp[256] = f2bf(-y[2]); mq[1] = *(const LAS f32x4*)(Mg + 388);
            { const float br = betg[3]; a0 = bf2f(*(const LAS bf16_t*)(lg + P5_VS + 816 + c * 2)) * br; b0 = bf2f(*(const LAS bf16_t*)(lg + P5_KS + 816 + c * 2)) * br * __expf(decg[3]); a1 = 0.f; b1 = 0.f; } a0 -= mq[2][0] * x[0]; b0 -= mq[2][0] * y[0]; a1 -= mq[2][1] * x[1]; b1 -= mq[2][1] * y[1]; a0 -= mq[2][2] * x[2]; b0 -= mq[2][2] * y[2]; x[3] = a0 + a1; y[3] = b0 + b1; up[384] = x[3]; wp[384] = f2bf(-y[3]); mq[2] = *(const LAS f32x4*)(Mg + 448);
            { const float br = betg[4]; a0 = bf2f(*(const LAS bf16_t*)(lg + P5_VS + 1088 + c * 2)) * br; b0 = bf2f(*(const LAS bf16_t*)(lg + P5_KS + 1088 + c * 2)) * br * __expf(decg[4]); a1 = 0.f; b1 = 0.f; } a0 -= mq[3][0] * x[0]; b0 -= mq[3][0] * y[0]; a1 -= mq[3][1] * x[1]; b1 -= mq[3][1] * y[1]; a0 -= mq[3][2] * x[2]; b0 -= mq[3][2] * y[2]; a1 -= mq[3][3] * x[3]; b1 -= mq[3][3] * y[3]; x[4] = a0 + a1; y[4] = b0 + b1; up[512] = x[4]; wp[512] = f2bf(-y[4]); mq[3] = *(const LAS f32x4*)(Mg + 452);
            { const float br = betg[5]; a0 = bf2f(*(const LAS bf16_t*)(lg + P5_VS + 1360 + c * 2)) * br; b0 = bf2f(*(const LAS bf16_t*)(lg + P5_KS + 1360 + c * 2)) * br * __expf(decg[5]); a1 = 0.f; b1 = 0.f; } a0 -= mq[4][0] * x[0]; b0 -= mq[4][0] * y[0]; a1 -= mq[4][1] * x[1]; b1 -= mq[4][1] * y[1]; a0 -= mq[4][2] * x[2]; b0 -= mq[4][2] * y[2]; a1 -= mq[4][3] * x[3]; b1 -= mq[4][3] * y[3]; mq[4] = *(const LAS f32x4*)(Mg + 512);
            a0 -= mq[5][0] * x[4]; b0 -= mq[5][0] * y[4]; x[5] = a0 + a1; y[5] = b0 + b1; up[640] = x[5]; wp[640] = f2bf(-y[5]); mq[5] = *(const LAS f32x4*)(Mg + 516);
            { const float br = betg[6]; a0 = bf2f(*(const LAS bf16_t*)(lg + P5_VS + 1632 + c * 2)) * br; b0 = bf2f(*(const LAS bf16_t*)(lg + P5_KS + 1632 + c * 2)) * br * __expf(decg[6]); a1 = 0.f; b1 = 0.f; } a0 -= mq[0][0] * x[0]; b0 -= mq[0][0] * y[0]; a1 -= mq[0][1] * x[1]; b1 -= mq[0][1] * y[1]; a0 -= mq[0][2] * x[2]; b0 -= mq[0][2] * y[2]; a1 -= mq[0][3] * x[3]; b1 -= mq[0][3] * y[3]; mq[0] = *(const LAS f32x4*)(Mg + 576);
            a0 -= mq[1][0] * x[4]; b0 -= mq[1][0] * y[4]; a1 -= mq[1][1] * x[5]; b1 -= mq[1][1] * y[5]; x[6] = a0 + a1; y[6] = b0 + b1; up[768] = x[6]; wp[768] = f2bf(-y[6]); mq[1] = *(const LAS f32x4*)(Mg + 580);
            { const float br = betg[7]; a0 = bf2f(*(const LAS bf16_t*)(lg + P5_VS + 1904 + c * 2)) * br; b0 = bf2f(*(const LAS bf16_t*)(lg + P5_KS + 1904 + c * 2)) * br * __expf(decg[7]); a1 = 0.f; b1 = 0.f; } a0 -= mq[2][0] * x[0]; b0 -= mq[2][0] * y[0]; a1 -= mq[2][1] * x[1]; b1 -= mq[2][1] * y[1]; a0 -= mq[2][2] * x[2]; b0 -= mq[2][2] * y[2]; a1 -= mq[2][3] * x[3]; b1 -= mq[2][3] * y[3]; mq[2] = *(const LAS f32x4*)(Mg + 584);
            a0 -= mq[3][0] * x[4]; b0 -= mq[3][0] * y[4]; a1 -= mq[3][1] * x[5]; b1 -= mq[3][1] * y[5]; a0 -= mq[3][2] * x[6]; b0 -= mq[3][2] * y[6]; x[7] = a0 + a1; y[7] = b0 + b1; up[896] = x[7]; wp[896] = f2bf(-y[7]); mq[3] = *(const LAS f32x4*)(Mg + 640);
            { const float br = betg[8]; a0 = bf2f(*(const LAS bf16_t*)(lg + P5_VS + 2176 + c * 2)) * br; b0 = bf2f(*(const LAS bf16_t*)(lg + P5_KS + 2176 + c * 2)) * br * __expf(decg[8]); a1 = 0.f; b1 = 0.f; } a0 -= mq[4][0] * x[0]; b0 -= mq[4][0] * y[0]; a1 -= mq[4][1] * x[1]; b1 -= mq[4][1] * y[1]; a0 -= mq[4][2] * x[2]; b0 -= mq[4][2] * y[2]; a1 -= mq[4][3] * x[3]; b1 -= mq[4][3] * y[3]; mq[4] = *(const LAS f32x4*)(Mg + 644);
            a0 -= mq[5][0] * x[4]; b0 -= mq[5][0] * y[4]; a1 -= mq[5][1] * x[5]; b1 -= mq[5][1] * y[5]; a0 -= mq[5][2] * x[6]; b0 -= mq[5][2] * y[6]; a1 -= mq[5][3] * x[7]; b1 -= mq[5][3] * y[7]; x[8] = a0 + a1; y[8] = b0 + b1; up[1024] = x[8]; wp[1024] = f2bf(-y[8]); mq[5] = *(const LAS f32x4*)(Mg + 648);
            { const float br = betg[9]; a0 = bf2f(*(const LAS bf16_t*)(lg + P5_VS + 2448 + c * 2)) * br; b0 = bf2f(*(const LAS bf16_t*)(lg + P5_KS + 2448 + c * 2)) * br * __expf(decg[9]); a1 = 0.f; b1 = 0.f; } a0 -= mq[0][0] * x[0]; b0 -= mq[0][0] * y[0]; a1 -= mq[0][1] * x[1]; b1 -= mq[0][1] * y[1]; a0 -= mq[0][2] * x[2]; b0 -= mq[0][2] * y[2]; a1 -= mq[0][3] * x[3]; b1 -= mq[0][3] * y[3]; mq[0] = *(const LAS f32x4*)(Mg + 704);
            a0 -= mq[1][0] * x[4]; b0 -= mq[1][0] * y[4]; a1 -= mq[1][1] * x[5]; b1 -= mq[1][1] * y[5]; a0 -= mq[1][2] * x[6]; b0 -= mq[1][2] * y[6]; a1 -= mq[1][3] * x[7]; b1 -= mq[1][3] * y[7]; mq[1] = *(const LAS f32x4*)(Mg + 708);
            a0 -= mq[2][0] * x[8]; b0 -= mq[2][0] * y[8]; x[9] = a0 + a1; y[9] = b0 + b1; up[1152] = x[9]; wp[1152] = f2bf(-y[9]); mq[2] = *(const LAS f32x4*)(Mg + 712);
            { const float br = betg[10]; a0 = bf2f(*(const LAS bf16_t*)(lg + P5_VS + 2720 + c * 2)) * br; b0 = bf2f(*(const LAS bf16_t*)(lg + P5_KS + 2720 + c * 2)) * br * __expf(decg[10]); a1 = 0.f; b1 = 0.f; } a0 -= mq[3][0] * x[0]; b0 -= mq[3][0] * y[0]; a1 -= mq[3][1] * x[1]; b1 -= mq[3][1] * y[1]; a0 -= mq[3][2] * x[2]; b0 -= mq[3][2] * y[2]; a1 -= mq[3][3] * x[3]; b1 -= mq[3][3] * y[3]; mq[3] = *(const LAS f32x4*)(Mg + 768);
            a0 -= mq[4][0] * x[4]; b0 -= mq[4][0] * y[4]; a1 -= mq[4][1] * x[5]; b1 -= mq[4][1] * y[5]; a0 -= mq[4][2] * x[6]; b0 -= mq[4][2] * y[6]; a1 -= mq[4][3] * x[7]; b1 -= mq[4][3] * y[7]; mq[4] = *(const LAS f32x4*)(Mg + 772);
            a0 -= mq[5][0] * x[8]; b0 -= mq[5][0] * y[8]; a1 -= mq[5][1] * x[9]; b1 -= mq[5][1] * y[9]; x[10] = a0 + a1; y[10] = b0 + b1; up[1280] = x[10]; wp[1280] = f2bf(-y[10]); mq[5] = *(const LAS f32x4*)(Mg + 776);
            { const float br = betg[11]; a0 = bf2f(*(const LAS bf16_t*)(lg + P5_VS + 2992 + c * 2)) * br; b0 = bf2f(*(const LAS bf16_t*)(lg + P5_KS + 2992 + c * 2)) * br * __expf(decg[11]); a1 = 0.f; b1 = 0.f; } a0 -= mq[0][0] * x[0]; b0 -= mq[0][0] * y[0]; a1 -= mq[0][1] * x[1]; b1 -= mq[0][1] * y[1]; a0 -= mq[0][2] * x[2]; b0 -= mq[0][2] * y[2]; a1 -= mq[0][3] * x[3]; b1 -= mq[0][3] * y[3]; mq[0] = *(const LAS f32x4*)(Mg + 832);
            a0 -= mq[1][0] * x[4]; b0 -= mq[1][0] * y[4]; a1 -= mq[1][1] * x[5]; b1 -= mq[1][1] * y[5]; a0 -= mq[1][2] * x[6]; b0 -= mq[1][2] * y[6]; a1 -= mq[1][3] * x[7]; b1 -= mq[1][3] * y[7]; mq[1] = *(const LAS f32x4*)(Mg + 836);
            a0 -= mq[2][0] * x[8]; b0 -= mq[2][0] * y[8]; a1 -= mq[2][1] * x[9]; b1 -= mq[2][1] * y[9]; a0 -= mq[2][2] * x[10]; b0 -= mq[2][2] * y[10]; x[11] = a0 + a1; y[11] = b0 + b1; up[1408] = x[11]; wp[1408] = f2bf(-y[11]); mq[2] = *(const LAS f32x4*)(Mg + 840);
            { const float br = betg[12]; a0 = bf2f(*(const LAS bf16_t*)(lg + P5_VS + 3264 + c * 2)) * br; b0 = bf2f(*(const LAS bf16_t*)(lg + P5_KS + 3264 + c * 2)) * br * __expf(decg[12]); a1 = 0.f; b1 = 0.f; } a0 -= mq[3][0] * x[0]; b0 -= mq[3][0] * y[0]; a1 -= mq[3][1] * x[1]; b1 -= mq[3][1] * y[1]; a0 -= mq[3][2] * x[2]; b0 -= mq[3][2] * y[2]; a1 -= mq[3][3] * x[3]; b1 -= mq[3][3] * y[3]; mq[3] = *(const LAS f32x4*)(Mg + 844);
            a0 -= mq[4][0] * x[4]; b0 -= mq[4][0] * y[4]; a1 -= mq[4][1] * x[5]; b1 -= mq[4][1] * y[5]; a0 -= mq[4][2] * x[6]; b0 -= mq[4][2] * y[6]; a1 -= mq[4][3] * x[7]; b1 -= mq[4][3] * y[7]; mq[4] = *(const LAS f32x4*)(Mg + 896);
            a0 -= mq[5][0] * x[8]; b0 -= mq[5][0] * y[8]; a1 -= mq[5][1] * x[9]; b1 -= mq[5][1] * y[9]; a0 -= mq[5][2] * x[10]; b0 -= mq[5][2] * y[10]; a1 -= mq[5][3] * x[11]; b1 -= mq[5][3] * y[11]; x[12] = a0 + a1; y[12] = b0 + b1; up[1536] = x[12]; wp[1536] = f2bf(-y[12]); mq[5] = *(const LAS f32x4*)(Mg + 900);
            { const float br = betg[13]; a0 = bf2f(*(const LAS bf16_t*)(lg + P5_VS + 3536 + c * 2)) * br; b0 = bf2f(*(const LAS bf16_t*)(lg + P5_KS + 3536 + c * 2)) * br * __expf(decg[13]); a1 = 0.f; b1 = 0.f; } a0 -= mq[0][0] * x[0]; b0 -= mq[0][0] * y[0]; a1 -= mq[0][1] * x[1]; b1 -= mq[0][1] * y[1]; a0 -= mq[0][2] * x[2]; b0 -= mq[0][2] * y[2]; a1 -= mq[0][3] * x[3]; b1 -= mq[0][3] * y[3]; mq[0] = *(const LAS f32x4*)(Mg + 904);
            a0 -= mq[1][0] * x[4]; b0 -= mq[1][0] * y[4]; a1 -= mq[1][1] * x[5]; b1 -= mq[1][1] * y[5]; a0 -= mq[1][2] * x[6]; b0 -= mq[1][2] * y[6]; a1 -= mq[1][3] * x[7]; b1 -= mq[1][3] * y[7]; mq[1] = *(const LAS f32x4*)(Mg + 908);
            a0 -= mq[2][0] * x[8]; b0 -= mq[2][0] * y[8]; a1 -= mq[2][1] * x[9]; b1 -= mq[2][1] * y[9]; a0 -= mq[2][2] * x[10]; b0 -= mq[2][2] * y[10]; a1 -= mq[2][3] * x[11]; b1 -= mq[2][3] * y[11]; mq[2] = *(const LAS f32x4*)(Mg + 960);
            a0 -= mq[3][0] * x[12]; b0 -= mq[3][0] * y[12]; x[13] = a0 + a1; y[13] = b0 + b1; up[1664] = x[13]; wp[1664] = f2bf(-y[13]); mq[3] = *(const LAS f32x4*)(Mg + 964);
            { const float br = betg[14]; a0 = bf2f(*(const LAS bf16_t*)(lg + P5_VS + 3808 + c * 2)) * br; b0 = bf2f(*(const LAS bf16_t*)(lg + P5_KS + 3808 + c * 2)) * br * __expf(decg[14]); a1 = 0.f; b1 = 0.f; } a0 -= mq[4][0] * x[0]; b0 -= mq[4][0] * y[0]; a1 -= mq[4][1] * x[1]; b1 -= mq[4][1] * y[1]; a0 -= mq[4][2] * x[2]; b0 -= mq[4][2] * y[2]; a1 -= mq[4][3] * x[3]; b1 -= mq[4][3] * y[3]; mq[4] = *(const LAS f32x4*)(Mg + 968);
            a0 -= mq[5][0] * x[4]; b0 -= mq[5][0] * y[4]; a1 -= mq[5][1] * x[5]; b1 -= mq[5][1] * y[5]; a0 -= mq[5][2] * x[6]; b0 -= mq[5][2] * y[6]; a1 -= mq[5][3] * x[7]; b1 -= mq[5][3] * y[7]; mq[5] = *(const LAS f32x4*)(Mg + 972);
            a0 -= mq[0][0] * x[8]; b0 -= mq[0][0] * y[8]; a1 -= mq[0][1] * x[9]; b1 -= mq[0][1] * y[9]; a0 -= mq[0][2] * x[10]; b0 -= mq[0][2] * y[10]; a1 -= mq[0][3] * x[11]; b1 -= mq[0][3] * y[11]; mq[0] = *(const LAS f32x4*)(Mg + 1024);
            a0 -= mq[1][0] * x[12]; b0 -= mq[1][0] * y[12]; a1 -= mq[1][1] * x[13]; b1 -= mq[1][1] * y[13]; x[14] = a0 + a1; y[14] = b0 + b1; up[1792] = x[14]; wp[1792] = f2bf(-y[14]); mq[1] = *(const LAS f32x4*)(Mg + 1028);
            { const float br = betg[15]; a0 = bf2f(*(const LAS bf16_t*)(lg + P5_VS + 4080 + c * 2)) * br; b0 = bf2f(*(const LAS bf16_t*)(lg + P5_KS + 4080 + c * 2)) * br * __expf(decg[15]); a1 = 0.f; b1 = 0.f; } a0 -= mq[2][0] * x[0]; b0 -= mq[2][0] * y[0]; a1 -= mq[2][1] * x[1]; b1 -= mq[2][1] * y[1]; a0 -= mq[2][2] * x[2]; b0 -= mq[2][2] * y[2]; a1 -= mq[2][3] * x[3]; b1 -= mq[2][3] * y[3]; mq[2] = *(const LAS f32x4*)(Mg + 1032);
            a0 -= mq[3][0] * x[4]; b0 -= mq[3][0] * y[4]; a1 -= mq[3][1] * x[5]; b1 -= mq[3][1] * y[5]; a0 -= mq[3][2] * x[6]; b0 -= mq[3][2] * y[6]; a1 -= mq[3][3] * x[7]; b1 -= mq[3][3] * y[7]; mq[3] = *(const LAS f32x4*)(Mg + 1036);
            a0 -= mq[4][0] * x[8]; b0 -= mq[4][0] * y[8]; a1 -= mq[4][1] * x[9]; b1 -= mq[4][1] * y[9]; a0 -= mq[4][2] * x[10]; b0 -= mq[4][2] * y[10]; a1 -= mq[4][3] * x[11]; b1 -= mq[4][3] * y[11]; mq[4] = *(const LAS f32x4*)(Mg + 1088);
            a0 -= mq[5][0] * x[12]; b0 -= mq[5][0] * y[12]; a1 -= mq[5][1] * x[13]; b1 -= mq[5][1] * y[13]; a0 -= mq[5][2] * x[14]; b0 -= mq[5][2] * y[14]; x[15] = a0 + a1; y[15] = b0 + b1; up[1920] = x[15]; wp[1920] = f2bf(-y[15]); mq[5] = *(const LAS f32x4*)(Mg + 1092);
            { const float br = betg[16]; a0 = bf2f(*(const LAS bf16_t*)(lg + P5_VS + 4352 + c * 2)) * br; b0 = bf2f(*(const LAS bf16_t*)(lg + P5_KS + 4352 + c * 2)) * br * __expf(decg[16]); a1 = 0.f; b1 = 0.f; } a0 -= mq[0][0] * x[0]; b0 -= mq[0][0] * y[0]; a1 -= mq[0][1] * x[1]; b1 -= mq[0][1] * y[1]; a0 -= mq[0][2] * x[2]; b0 -= mq[0][2] * y[2]; a1 -= mq[0][3] * x[3]; b1 -= mq[0][3] * y[3]; mq[0] = *(const LAS f32x4*)(Mg + 1096);
            a0 -= mq[1][0] * x[4]; b0 -= mq[1][0] * y[4]; a1 -= mq[1][1] * x[5]; b1 -= mq[1][1] * y[5]; a0 -= mq[1][2] * x[6]; b0 -= mq[1][2] * y[6]; a1 -= mq[1][3] * x[7]; b1 -= mq[1][3] * y[7]; mq[1] = *(const LAS f32x4*)(Mg + 1100);
            a0 -= mq[2][0] * x[8]; b0 -= mq[2][0] * y[8]; a1 -= mq[2][1] * x[9]; b1 -= mq[2][1] * y[9]; a0 -= mq[2][2] * x[10]; b0 -= mq[2][2] * y[10]; a1 -= mq[2][3] * x[11]; b1 -= mq[2][3] * y[11]; mq[2] = *(const LAS f32x4*)(Mg + 1104);
            a0 -= mq[3][0] * x[12]; b0 -= mq[3][0] * y[12]; a1 -= mq[3][1] * x[13]; b1 -= mq[3][1] * y[13]; a0 -= mq[3][2] * x[14]; b0 -= mq[3][2] * y[14]; a1 -= mq[3][3] * x[15]; b1 -= mq[3][3] * y[15]; x[16] = a0 + a1; y[16] = b0 + b1; up[2048] = x[16]; wp[2048] = f2bf(-y[16]); mq[3] = *(const LAS f32x4*)(Mg + 1152);
            { const float br = betg[17]; a0 = bf2f(*(const LAS bf16_t*)(lg + P5_VS + 4624 + c * 2)) * br; b0 = bf2f(*(const LAS bf16_t*)(lg + P5_KS + 4624 + c * 2)) * br * __expf(decg[17]); a1 = 0.f; b1 = 0.f; } a0 -= mq[4][0] * x[0]; b0 -= mq[4][0] * y[0]; a1 -= mq[4][1] * x[1]; b1 -= mq[4][1] * y[1]; a0 -= mq[4][2] * x[2]; b0 -= mq[4][2] * y[2]; a1 -= mq[4][3] * x[3]; b1 -= mq[4][3] * y[3]; mq[4] = *(const LAS f32x4*)(Mg + 1156);
            a0 -= mq[5][0] * x[4]; b0 -= mq[5][0] * y[4]; a1 -= mq[5][1] * x[5]; b1 -= mq[5][1] * y[5]; a0 -= mq[5][2] * x[6]; b0 -= mq[5][2] * y[6]; a1 -= mq[5][3] * x[7]; b1 -= mq[5][3] * y[7]; mq[5] = *(const LAS f32x4*)(Mg + 1160);
            a0 -= mq[0][0] * x[8]; b0 -= mq[0][0] * y[8]; a1 -= mq[0][1] * x[9]; b1 -= mq[0][1] * y[9]; a0 -= mq[0][2] * x[10]; b0 -= mq[0][2] * y[10]; a1 -= mq[0][3] * x[11]; b1 -= mq[0][3] * y[11]; mq[0] = *(const LAS f32x4*)(Mg + 1164);
            a0 -= mq[1][0] * x[12]; b0 -= mq[1][0] * y[12]; a1 -= mq[1][1] * x[13]; b1 -= mq[1][1] * y[13]; a0 -= mq[1][2] * x[14]; b0 -= mq[1][2] * y[14]; a1 -= mq[1][3] * x[15]; b1 -= mq[1][3] * y[15]; mq[1] = *(const LAS f32x4*)(Mg + 1168);
            a0 -= mq[2][0] * x[16]; b0 -= mq[2][0] * y[16]; x[17] = a0 + a1; y[17] = b0 + b1; up[2176] = x[17]; wp[2176] = f2bf(-y[17]); mq[2] = *(const LAS f32x4*)(Mg + 1216);
            { const float br = betg[18]; a0 = bf2f(*(const LAS bf16_t*)(lg + P5_VS + 4896 + c * 2)) * br; b0 = bf2f(*(const LAS bf16_t*)(lg + P5_KS + 4896 + c * 2)) * br * __expf(decg[18]); a1 = 0.f; b1 = 0.f; } a0 -= mq[3][0] * x[0]; b0 -= mq[3][0] * y[0]; a1 -= mq[3][1] * x[1]; b1 -= mq[3][1] * y[1]; a0 -= mq[3][2] * x[2]; b0 -= mq[3][2] * y[2]; a1 -= mq[3][3] * x[3]; b1 -= mq[3][3] * y[3]; mq[3] = *(const LAS f32x4*)(Mg + 1220);
            a0 -= mq[4][0] * x[4]; b0 -= mq[4][0] * y[4]; a1 -= mq[4][1] * x[5]; b1 -= mq[4][1] * y[5]; a0 -= mq[4][2] * x[6]; b0 -= mq[4][2] * y[6]; a1 -= mq[4][3] * x[7]; b1 -= mq[4][3] * y[7]; mq[4] = *(const LAS f32x4*)(Mg + 1224);
            a0 -= mq[5][0] * x[8]; b0 -= mq[5][0] * y[8]; a1 -= mq[5][1] * x[9]; b1 -= mq[5][1] * y[9]; a0 -= mq[5][2] * x[10]; b0 -= mq[5][2] * y[10]; a1 -= mq[5][3] * x[11]; b1 -= mq[5][3] * y[11]; mq[5] = *(const LAS f32x4*)(Mg + 1228);
            a0 -= mq[0][0] * x[12]; b0 -= mq[0][0] * y[12]; a1 -= mq[0][1] * x[13]; b1 -= mq[0][1] * y[13]; a0 -= mq[0][2] * x[14]; b0 -= mq[0][2] * y[14]; a1 -= mq[0][3] * x[15]; b1 -= mq[0][3] * y[15]; mq[0] = *(const LAS f32x4*)(Mg + 1232);
            a0 -= mq[1][0] * x[16]; b0 -= mq[1][0] * y[16]; a1 -= mq[1][1] * x[17]; b1 -= mq[1][1] * y[17]; x[18] = a0 + a1; y[18] = b0 + b1; up[2304] = x[18]; wp[2304] = f2bf(-y[18]); mq[1] = *(const LAS f32x4*)(Mg + 1280);
            { const float br = betg[19]; a0 = bf2f(*(const LAS bf16_t*)(lg + P5_VS + 5168 + c * 2)) * br; b0 = bf2f(*(const LAS bf16_t*)(lg + P5_KS + 5168 + c * 2)) * br * __expf(decg[19]); a1 = 0.f; b1 = 0.f; } a0 -= mq[2][0] * x[0]; b0 -= mq[2][0] * y[0]; a1 -= mq[2][1] * x[1]; b1 -= mq[2][1] * y[1]; a0 -= mq[2][2] * x[2]; b0 -= mq[2][2] * y[2]; a1 -= mq[2][3] * x[3]; b1 -= mq[2][3] * y[3]; mq[2] = *(const LAS f32x4*)(Mg + 1284);
            a0 -= mq[3][0] * x[4]; b0 -= mq[3][0] * y[4]; a1 -= mq[3][1] * x[5]; b1 -= mq[3][1] * y[5]; a0 -= mq[3][2] * x[6]; b0 -= mq[3][2] * y[6]; a1 -= mq[3][3] * x[7]; b1 -= mq[3][3] * y[7]; mq[3] = *(const LAS f32x4*)(Mg + 1288);
            a0 -= mq[4][0] * x[8]; b0 -= mq[4][0] * y[8]; a1 -= mq[4][1] * x[9]; b1 -= mq[4][1] * y[9]; a0 -= mq[4][2] * x[10]; b0 -= mq[4][2] * y[10]; a1 -= mq[4][3] * x[11]; b1 -= mq[4][3] * y[11]; mq[4] = *(const LAS f32x4*)(Mg + 1292);
            a0 -= mq[5][0] * x[12]; b0 -= mq[5][0] * y[12]; a1 -= mq[5][1] * x[13]; b1 -= mq[5][1] * y[13]; a0 -= mq[5][2] * x[14]; b0 -= mq[5][2] * y[14]; a1 -= mq[5][3] * x[15]; b1 -= mq[5][3] * y[15]; mq[5] = *(const LAS f32x4*)(Mg + 1296);
            a0 -= mq[0][0] * x[16]; b0 -= mq[0][0] * y[16]; a1 -= mq[0][1] * x[17]; b1 -= mq[0][1] * y[17]; a0 -= mq[0][2] * x[18]; b0 -= mq[0][2] * y[18]; x[19] = a0 + a1; y[19] = b0 + b1; up[2432] = x[19]; wp[2432] = f2bf(-y[19]); mq[0] = *(const LAS f32x4*)(Mg + 1344);
            { const float br = betg[20]; a0 = bf2f(*(const LAS bf16_t*)(lg + P5_VS + 5440 + c * 2)) * br; b0 = bf2f(*(const LAS bf16_t*)(lg + P5_KS + 5440 + c * 2)) * br * __expf(decg[20]); a1 = 0.f; b1 = 0.f; } a0 -= mq[1][0] * x[0]; b0 -= mq[1][0] * y[0]; a1 -= mq[1][1] * x[1]; b1 -= mq[1][1] * y[1]; a0 -= mq[1][2] * x[2]; b0 -= mq[1][2] * y[2]; a1 -= mq[1][3] * x[3]; b1 -= mq[1][3] * y[3]; mq[1] = *(const LAS f32x4*)(Mg + 1348);
            a0 -= mq[2][0] * x[4]; b0 -= mq[2][0] * y[4]; a1 -= mq[2][1] * x[5]; b1 -= mq[2][1] * y[5]; a0 -= mq[2][2] * x[6]; b0 -= mq[2][2] * y[6]; a1 -= mq[2][3] * x[7]; b1 -= mq[2][3] * y[7]; mq[2] = *(const LAS f32x4*)(Mg + 1352);
            a0 -= mq[3][0] * x[8]; b0 -= mq[3][0] * y[8]; a1 -= mq[3][1] * x[9]; b1 -= mq[3][1] * y[9]; a0 -= mq[3][2] * x[10]; b0 -= mq[3][2] * y[10]; a1 -= mq[3][3] * x[11]; b1 -= mq[3][3] * y[11]; mq[3] = *(const LAS f32x4*)(Mg + 1356);
            a0 -= mq[4][0] * x[12]; b0 -= mq[4][0] * y[12]; a1 -= mq[4][1] * x[13]; b1 -= mq[4][1] * y[13]; a0 -= mq[4][2] * x[14]; b0 -= mq[4][2] * y[14]; a1 -= mq[4][3] * x[15]; b1 -= mq[4][3] * y[15]; mq[4] = *(const LAS f32x4*)(Mg + 1360);
            a0 -= mq[5][0] * x[16]; b0 -= mq[5][0] * y[16]; a1 -= mq[5][1] * x[17]; b1 -= mq[5][1] * y[17]; a0 -= mq[5][2] * x[18]; b0 -= mq[5][2] * y[18]; a1 -= mq[5][3] * x[19]; b1 -= mq[5][3] * y[19]; x[20] = a0 + a1; y[20] = b0 + b1; up[2560] = x[20]; wp[2560] = f2bf(-y[20]); mq[5] = *(const LAS f32x4*)(Mg + 1364);
            { const float br = betg[21]; a0 = bf2f(*(const LAS bf16_t*)(lg + P5_VS + 5712 + c * 2)) * br; b0 = bf2f(*(const LAS bf16_t*)(lg + P5_KS + 5712 + c * 2)) * br * __expf(decg[21]); a1 = 0.f; b1 = 0.f; } a0 -= mq[0][0] * x[0]; b0 -= mq[0][0] * y[0]; a1 -= mq[0][1] * x[1]; b1 -= mq[0][1] * y[1]; a0 -= mq[0][2] * x[2]; b0 -= mq[0][2] * y[2]; a1 -= mq[0][3] * x[3]; b1 -= mq[0][3] * y[3]; mq[0] = *(const LAS f32x4*)(Mg + 1408);
            a0 -= mq[1][0] * x[4]; b0 -= mq[1][0] * y[4]; a1 -= mq[1][1] * x[5]; b1 -= mq[1][1] * y[5]; a0 -= mq[1][2] * x[6]; b0 -= mq[1][2] * y[6]; a1 -= mq[1][3] * x[7]; b1 -= mq[1][3] * y[7]; mq[1] = *(const LAS f32x4*)(Mg + 1412);
            a0 -= mq[2][0] * x[8]; b0 -= mq[2][0] * y[8]; a1 -= mq[2][1] * x[9]; b1 -= mq[2][1] * y[9]; a0 -= mq[2][2] * x[10]; b0 -= mq[2][2] * y[10]; a1 -= mq[2][3] * x[11]; b1 -= mq[2][3] * y[11]; mq[2] = *(const LAS f32x4*)(Mg + 1416);
            a0 -= mq[3][0] * x[12]; b0 -= mq[3][0] * y[12]; a1 -= mq[3][1] * x[13]; b1 -= mq[3][1] * y[13]; a0 -= mq[3][2] * x[14]; b0 -= mq[3][2] * y[14]; a1 -= mq[3][3] * x[15]; b1 -= mq[3][3] * y[15]; mq[3] = *(const LAS f32x4*)(Mg + 1420);
            a0 -= mq[4][0] * x[16]; b0 -= mq[4][0] * y[16]; a1 -= mq[4][1] * x[17]; b1 -= mq[4][1] * y[17]; a0 -= mq[4][2] * x[18]; b0 -= mq[4][2] * y[18]; a1 -= mq[4][3] * x[19]; b1 -= mq[4][3] * y[19]; mq[4] = *(const LAS f32x4*)(Mg + 1424);
            a0 -= mq[5][0] * x[20]; b0 -= mq[5][0] * y[20]; x[21] = a0 + a1; y[21] = b0 + b1; up[2688] = x[21]; wp[2688] = f2bf(-y[21]); mq[5] = *(const LAS f32x4*)(Mg + 1428);
            { const float br = betg[22]; a0 = bf2f(*(const LAS bf16_t*)(lg + P5_VS + 5984 + c * 2)) * br; b0 = bf2f(*(const LAS bf16_t*)(lg + P5_KS + 5984 + c * 2)) * br * __expf(decg[22]); a1 = 0.f; b1 = 0.f; } a0 -= mq[0][0] * x[0]; b0 -= mq[0][0] * y[0]; a1 -= mq[0][1] * x[1]; b1 -= mq[0][1] * y[1]; a0 -= mq[0][2] * x[2]; b0 -= mq[0][2] * y[2]; a1 -= mq[0][3] * x[3]; b1 -= mq[0][3] * y[3]; mq[0] = *(const LAS f32x4*)(Mg + 1472);
            a0 -= mq[1][0] * x[4]; b0 -= mq[1][0] * y[4]; a1 -= mq[1][1] * x[5]; b1 -= mq[1][1] * y[5]; a0 -= mq[1][2] * x[6]; b0 -= mq[1][2] * y[6]; a1 -= mq[1][3] * x[7]; b1 -= mq[1][3] * y[7]; mq[1] = *(const LAS f32x4*)(Mg + 1476);
            a0 -= mq[2][0] * x[8]; b0 -= mq[2][0] * y[8]; a1 -= mq[2][1] * x[9]; b1 -= mq[2][1] * y[9]; a0 -= mq[2][2] * x[10]; b0 -= mq[2][2] * y[10]; a1 -= mq[2][3] * x[11]; b1 -= mq[2][3] * y[11]; mq[2] = *(const LAS f32x4*)(Mg + 1480);
            a0 -= mq[3][0] * x[12]; b0 -= mq[3][0] * y[12]; a1 -= mq[3][1] * x[13]; b1 -= mq[3][1] * y[13]; a0 -= mq[3][2] * x[14]; b0 -= mq[3][2] * y[14]; a1 -= mq[3][3] * x[15]; b1 -= mq[3][3] * y[15]; mq[3] = *(const LAS f32x4*)(Mg + 1484);
            a0 -= mq[4][0] * x[16]; b0 -= mq[4][0] * y[16]; a1 -= mq[4][1] * x[17]; b1 -= mq[4][1] * y[17]; a0 -= mq[4][2] * x[18]; b0 -= mq[4][2] * y[18]; a1 -= mq[4][3] * x[19]; b1 -= mq[4][3] * y[19]; mq[4] = *(const LAS f32x4*)(Mg + 1488);
            a0 -= mq[5][0] * x[20]; b0 -= mq[5][0] * y[20]; a1 -= mq[5][1] * x[21]; b1 -= mq[5][1] * y[21]; x[22] = a0 + a1; y[22] = b0 + b1; up[2816] = x[22]; wp[2816] = f2bf(-y[22]); mq[5] = *(const LAS f32x4*)(Mg + 1492);
            { const float br = betg[23]; a0 = bf2f(*(const LAS bf16_t*)(lg + P5_VS + 6256 + c * 2)) * br; b0 = bf2f(*(const LAS bf16_t*)(lg + P5_KS + 6256 + c * 2)) * br * __expf(decg[23]); a1 = 0.f; b1 = 0.f; } a0 -= mq[0][0] * x[0]; b0 -= mq[0][0] * y[0]; a1 -= mq[0][1] * x[1]; b1 -= mq[0][1] * y[1]; a0 -= mq[0][2] * x[2]; b0 -= mq[0][2] * y[2]; a1 -= mq[0][3] * x[3]; b1 -= mq[0][3] * y[3]; mq[0] = *(const LAS f32x4*)(Mg + 1536);
            a0 -= mq[1][0] * x[4]; b0 -= mq[1][0] * y[4]; a1 -= mq[1][1] * x[5]; b1 -= mq[1][1] * y[5]; a0 -= mq[1][2] * x[6]; b0 -= mq[1][2] * y[6]; a1 -= mq[1][3] * x[7]; b1 -= mq[1][3] * y[7]; mq[1] = *(const LAS f32x4*)(Mg + 1540);
            a0 -= mq[2][0] * x[8]; b0 -= mq[2][0] * y[8]; a1 -= mq[2][1] * x[9]; b1 -= mq[2][1] * y[9]; a0 -= mq[2][2] * x[10]; b0 -= mq[2][2] * y[10]; a1 -= mq[2][3] * x[11]; b1 -= mq[2][3] * y[11]; mq[2] = *(const LAS f32x4*)(Mg + 1544);
            a0 -= mq[3][0] * x[12]; b0 -= mq[3][0] * y[12]; a1 -= mq[3][1] * x[13]; b1 -= mq[3][1] * y[13]; a0 -= mq[3][2] * x[14]; b0 -= mq[3][2] * y[14]; a1 -= mq[3][3] * x[15]; b1 -= mq[3][3] * y[15]; mq[3] = *(const LAS f32x4*)(Mg + 1548);
            a0 -= mq[4][0] * x[16]; b0 -= mq[4][0] * y[16]; a1 -= mq[4][1] * x[17]; b1 -= mq[4][1] * y[17]; a0 -= mq[4][2] * x[18]; b0 -= mq[4][2] * y[18]; a1 -= mq[4][3] * x[19]; b1 -= mq[4][3] * y[19]; mq[4] = *(const LAS f32x4*)(Mg + 1552);
            a0 -= mq[5][0] * x[20]; b0 -= mq[5][0] * y[20]; a1 -= mq[5][1] * x[21]; b1 -= mq[5][1] * y[21]; a0 -= mq[5][2] * x[22]; b0 -= mq[5][2] * y[22]; x[23] = a0 + a1; y[23] = b0 + b1; up[2944] = x[23]; wp[2944] = f2bf(-y[23]); mq[5] = *(const LAS f32x4*)(Mg + 1556);
            { const float br = betg[24]; a0 = bf2f(*(const LAS bf16_t*)(lg + P5_VS + 6528 + c * 2)) * br; b0 = bf2f(*(const LAS bf16_t*)(lg + P5_KS + 6528 + c * 2)) * br * __expf(decg[24]); a1 = 0.f; b1 = 0.f; } a0 -= mq[0][0] * x[0]; b0 -= mq[0][0] * y[0]; a1 -= mq[0][1] * x[1]; b1 -= mq[0][1] * y[1]; a0 -= mq[0][2] * x[2]; b0 -= mq[0][2] * y[2]; a1 -= mq[0][3] * x[3]; b1 -= mq[0][3] * y[3]; mq[0] = *(const LAS f32x4*)(Mg + 1600);
            a0 -= mq[1][0] * x[4]; b0 -= mq[1][0] * y[4]; a1 -= mq[1][1] * x[5]; b1 -= mq[1][1] * y[5]; a0 -= mq[1][2] * x[6]; b0 -= mq[1][2] * y[6]; a1 -= mq[1][3] * x[7]; b1 -= mq[1][3] * y[7]; mq[1] = *(const LAS f32x4*)(Mg + 1604);
            a0 -= mq[2][0] * x[8]; b0 -= mq[2][0] * y[8]; a1 -= mq[2][1] * x[9]; b1 -= mq[2][1] * y[9]; a0 -= mq[2][2] * x[10]; b0 -= mq[2][2] * y[10]; a1 -= mq[2][3] * x[11]; b1 -= mq[2][3] * y[11]; mq[2] = *(const LAS f32x4*)(Mg + 1608);
            a0 -= mq[3][0] * x[12]; b0 -= mq[3][0] * y[12]; a1 -= mq[3][1] * x[13]; b1 -= mq[3][1] * y[13]; a0 -= mq[3][2] * x[14]; b0 -= mq[3][2] * y[14]; a1 -= mq[3][3] * x[15]; b1 -= mq[3][3] * y[15]; mq[3] = *(const LAS f32x4*)(Mg + 1612);
            a0 -= mq[4][0] * x[16]; b0 -= mq[4][0] * y[16]; a1 -= mq[4][1] * x[17]; b1 -= mq[4][1] * y[17]; a0 -= mq[4][2] * x[18]; b0 -= mq[4][2] * y[18]; a1 -= mq[4][3] * x[19]; b1 -= mq[4][3] * y[19]; mq[4] = *(const LAS f32x4*)(Mg + 1616);
            a0 -= mq[5][0] * x[20]; b0 -= mq[5][0] * y[20]; a1 -= mq[5][1] * x[21]; b1 -= mq[5][1] * y[21]; a0 -= mq[5][2] * x[22]; b0 -= mq[5][2] * y[22]; a1 -= mq[5][3] * x[23]; b1 -= mq[5][3] * y[23]; x[24] = a0 + a1; y[24] = b0 + b1; up[3072] = x[24]; wp[3072] = f2bf(-y[24]); mq[5] = *(const LAS f32x4*)(Mg + 1620);
            { const float br = betg[25]; a0 = bf2f(*(const LAS bf16_t*)(lg + P5_VS + 6800 + c * 2)) * br; b0 = bf2f(*(const LAS bf16_t*)(lg + P5_KS + 6800 + c * 2)) * br * __expf(decg[25]); a1 = 0.f; b1 = 0.f; } a0 -= mq[0][0] * x[0]; b0 -= mq[0][0] * y[0]; a1 -= mq[0][1] * x[1]; b1 -= mq[0][1] * y[1]; a0 -= mq[0][2] * x[2]; b0 -= mq[0][2] * y[2]; a1 -= mq[0][3] * x[3]; b1 -= mq[0][3] * y[3]; mq[0] = *(const LAS f32x4*)(Mg + 1624);
            a0 -= mq[1][0] * x[4]; b0 -= mq[1][0] * y[4]; a1 -= mq[1][1] * x[5]; b1 -= mq[1][1] * y[5]; a0 -= mq[1][2] * x[6]; b0 -= mq[1][2] * y[6]; a1 -= mq[1][3] * x[7]; b1 -= mq[1][3] * y[7]; mq[1] = *(const LAS f32x4*)(Mg + 1664);
            a0 -= mq[2][0] * x[8]; b0 -= mq[2][0] * y[8]; a1 -= mq[2][1] * x[9]; b1 -= mq[2][1] * y[9]; a0 -= mq[2][2] * x[10]; b0 -= mq[2][2] * y[10]; a1 -= mq[2][3] * x[11]; b1 -= mq[2][3] * y[11]; mq[2] = *(const LAS f32x4*)(Mg + 1668);
            a0 -= mq[3][0] * x[12]; b0 -= mq[3][0] * y[12]; a1 -= mq[3][1] * x[13]; b1 -= mq[3][1] * y[13]; a0 -= mq[3][2] * x[14]; b0 -= mq[3][2] * y[14]; a1 -= mq[3][3] * x[15]; b1 -= mq[3][3] * y[15]; mq[3] = *(const LAS f32x4*)(Mg + 1672);
            a0 -= mq[4][0] * x[16]; b0 -= mq[4][0] * y[16]; a1 -= mq[4][1] * x[17]; b1 -= mq[4][1] * y[17]; a0 -= mq[4][2] * x[18]; b0 -= mq[4][2] * y[18]; a1 -= mq[4][3] * x[19]; b1 -= mq[4][3] * y[19]; mq[4] = *(const LAS f32x4*)(Mg + 1676);
            a0 -= mq[5][0] * x[20]; b0 -= mq[5][0] * y[20]; a1 -= mq[5][1] * x[21]; b1 -= mq[5][1] * y[21]; a0 -= mq[5][2] * x[22]; b0 -= mq[5][2] * y[22]; a1 -= mq[5][3] * x[23]; b1 -= mq[5][3] * y[23]; mq[5] = *(const LAS f32x4*)(Mg + 1680);
            a0 -= mq[0][0] * x[24]; b0 -= mq[0][0] * y[24]; x[25] = a0 + a1; y[25] = b0 + b1; up[3200] = x[25]; wp[3200] = f2bf(-y[25]); mq[0] = *(const LAS f32x4*)(Mg + 1684);
            { const float br = betg[26]; a0 = bf2f(*(const LAS bf16_t*)(lg + P5_VS + 7072 + c * 2)) * br; b0 = bf2f(*(const LAS bf16_t*)(lg + P5_KS + 7072 + c * 2)) * br * __expf(decg[26]); a1 = 0.f; b1 = 0.f; } a0 -= mq[1][0] * x[0]; b0 -= mq[1][0] * y[0]; a1 -= mq[1][1] * x[1]; b1 -= mq[1][1] * y[1]; a0 -= mq[1][2] * x[2]; b0 -= mq[1][2] * y[2]; a1 -= mq[1][3] * x[3]; b1 -= mq[1][3] * y[3]; mq[1] = *(const LAS f32x4*)(Mg + 1688);
            a0 -= mq[2][0] * x[4]; b0 -= mq[2][0] * y[4]; a1 -= mq[2][1] * x[5]; b1 -= mq[2][1] * y[5]; a0 -= mq[2][2] * x[6]; b0 -= mq[2][2] * y[6]; a1 -= mq[2][3] * x[7]; b1 -= mq[2][3] * y[7]; mq[2] = *(const LAS f32x4*)(Mg + 1728);
            a0 -= mq[3][0] * x[8]; b0 -= mq[3][0] * y[8]; a1 -= mq[3][1] * x[9]; b1 -= mq[3][1] * y[9]; a0 -= mq[3][2] * x[10]; b0 -= mq[3][2] * y[10]; a1 -= mq[3][3] * x[11]; b1 -= mq[3][3] * y[11]; mq[3] = *(const LAS f32x4*)(Mg + 1732);
            a0 -= mq[4][0] * x[12]; b0 -= mq[4][0] * y[12]; a1 -= mq[4][1] * x[13]; b1 -= mq[4][1] * y[13]; a0 -= mq[4][2] * x[14]; b0 -= mq[4][2] * y[14]; a1 -= mq[4][3] * x[15]; b1 -= mq[4][3] * y[15]; mq[4] = *(const LAS f32x4*)(Mg + 1736);
            a0 -= mq[5][0] * x[16]; b0 -= mq[5][0] * y[16]; a1 -= mq[5][1] * x[17]; b1 -= mq[5][1] * y[17]; a0 -= mq[5][2] * x[18]; b0 -= mq[5][2] * y[18]; a1 -= mq[5][3] * x[19]; b1 -= mq[5][3] * y[19]; mq[5] = *(const LAS f32x4*)(Mg + 1740);
            a0 -= mq[0][0] * x[20]; b0 -= mq[0][0] * y[20]; a1 -= mq[0][1] * x[21]; b1 -= mq[0][1] * y[21]; a0 -= mq[0][2] * x[22]; b0 -= mq[0][2] * y[22]; a1 -= mq[0][3] * x[23]; b1 -= mq[0][3] * y[23]; mq[0] = *(const LAS f32x4*)(Mg + 1744);
            a0 -= mq[1][0] * x[24]; b0 -= mq[1][0] * y[24]; a1 -= mq[1][1] * x[25]; b1 -= mq[1][1] * y[25]; x[26] = a0 + a1; y[26] = b0 + b1; up[3328] = x[26]; wp[3328] = f2bf(-y[26]); mq[1] = *(const LAS f32x4*)(Mg + 1748);
            { const float br = betg[27]; a0 = bf2f(*(const LAS bf16_t*)(lg + P5_VS + 7344 + c * 2)) * br; b0 = bf2f(*(const LAS bf16_t*)(lg + P5_KS + 7344 + c * 2)) * br * __expf(decg[27]); a1 = 0.f; b1 = 0.f; } a0 -= mq[2][0] * x[0]; b0 -= mq[2][0] * y[0]; a1 -= mq[2][1] * x[1]; b1 -= mq[2][1] * y[1]; a0 -= mq[2][2] * x[2]; b0 -= mq[2][2] * y[2]; a1 -= mq[2][3] * x[3]; b1 -= mq[2][3] * y[3]; mq[2] = *(const LAS f32x4*)(Mg + 1752);
            a0 -= mq[3][0] * x[4]; b0 -= mq[3][0] * y[4]; a1 -= mq[3][1] * x[5]; b1 -= mq[3][1] * y[5]; a0 -= mq[3][2] * x[6]; b0 -= mq[3][2] * y[6]; a1 -= mq[3][3] * x[7]; b1 -= mq[3][3] * y[7]; mq[3] = *(const LAS f32x4*)(Mg + 1792);
            a0 -= mq[4][0] * x[8]; b0 -= mq[4][0] * y[8]; a1 -= mq[4][1] * x[9]; b1 -= mq[4][1] * y[9]; a0 -= mq[4][2] * x[10]; b0 -= mq[4][2] * y[10]; a1 -= mq[4][3] * x[11]; b1 -= mq[4][3] * y[11]; mq[4] = *(const LAS f32x4*)(Mg + 1796);
            a0 -= mq[5][0] * x[12]; b0 -= mq[5][0] * y[12]; a1 -= mq[5][1] * x[13]; b1 -= mq[5][1] * y[13]; a0 -= mq[5][2] * x[14]; b0 -= mq[5][2] * y[14]; a1 -= mq[5][3] * x[15]; b1 -= mq[5][3] * y[15]; mq[5] = *(const LAS f32x4*)(Mg + 1800);
            a0 -= mq[0][0] * x[16]; b0 -= mq[0][0] * y[16]; a1 -= mq[0][1] * x[17]; b1 -= mq[0][1] * y[17]; a0 -= mq[0][2] * x[18]; b0 -= mq[0][2] * y[18]; a1 -= mq[0][3] * x[19]; b1 -= mq[0][3] * y[19]; mq[0] = *(const LAS f32x4*)(Mg + 1804);
            a0 -= mq[1][0] * x[20]; b0 -= mq[1][0] * y[20]; a1 -= mq[1][1] * x[21]; b1 -= mq[1][1] * y[21]; a0 -= mq[1][2] * x[22]; b0 -= mq[1][2] * y[22]; a1 -= mq[1][3] * x[23]; b1 -= mq[1][3] * y[23]; mq[1] = *(const LAS f32x4*)(Mg + 1808);
            a0 -= mq[2][0] * x[24]; b0 -= mq[2][0] * y[24]; a1 -= mq[2][1] * x[25]; b1 -= mq[2][1] * y[25]; a0 -= mq[2][2] * x[26]; b0 -= mq[2][2] * y[26]; x[27] = a0 + a1; y[27] = b0 + b1; up[3456] = x[27]; wp[3456] = f2bf(-y[27]); mq[2] = *(const LAS f32x4*)(Mg + 1812);
            { const float br = betg[28]; a0 = bf2f(*(const LAS bf16_t*)(lg + P5_VS + 7616 + c * 2)) * br; b0 = bf2f(*(const LAS bf16_t*)(lg + P5_KS + 7616 + c * 2)) * br * __expf(decg[28]); a1 = 0.f; b1 = 0.f; } a0 -= mq[3][0] * x[0]; b0 -= mq[3][0] * y[0]; a1 -= mq[3][1] * x[1]; b1 -= mq[3][1] * y[1]; a0 -= mq[3][2] * x[2]; b0 -= mq[3][2] * y[2]; a1 -= mq[3][3] * x[3]; b1 -= mq[3][3] * y[3]; mq[3] = *(const LAS f32x4*)(Mg + 1816);
            a0 -= mq[4][0] * x[4]; b0 -= mq[4][0] * y[4]; a1 -= mq[4][1] * x[5]; b1 -= mq[4][1] * y[5]; a0 -= mq[4][2] * x[6]; b0 -= mq[4][2] * y[6]; a1 -= mq[4][3] * x[7]; b1 -= mq[4][3] * y[7]; mq[4] = *(const LAS f32x4*)(Mg + 1856);
            a0 -= mq[5][0] * x[8]; b0 -= mq[5][0] * y[8]; a1 -= mq[5][1] * x[9]; b1 -= mq[5][1] * y[9]; a0 -= mq[5][2] * x[10]; b0 -= mq[5][2] * y[10]; a1 -= mq[5][3] * x[11]; b1 -= mq[5][3] * y[11]; mq[5] = *(const LAS f32x4*)(Mg + 1860);
            a0 -= mq[0][0] * x[12]; b0 -= mq[0][0] * y[12]; a1 -= mq[0][1] * x[13]; b1 -= mq[0][1] * y[13]; a0 -= mq[0][2] * x[14]; b0 -= mq[0][2] * y[14]; a1 -= mq[0][3] * x[15]; b1 -= mq[0][3] * y[15]; mq[0] = *(const LAS f32x4*)(Mg + 1864);
            a0 -= mq[1][0] * x[16]; b0 -= mq[1][0] * y[16]; a1 -= mq[1][1] * x[17]; b1 -= mq[1][1] * y[17]; a0 -= mq[1][2] * x[18]; b0 -= mq[1][2] * y[18]; a1 -= mq[1][3] * x[19]; b1 -= mq[1][3] * y[19]; mq[1] = *(const LAS f32x4*)(Mg + 1868);
            a0 -= mq[2][0] * x[20]; b0 -= mq[2][0] * y[20]; a1 -= mq[2][1] * x[21]; b1 -= mq[2][1] * y[21]; a0 -= mq[2][2] * x[22]; b0 -= mq[2][2] * y[22]; a1 -= mq[2][3] * x[23]; b1 -= mq[2][3] * y[23]; mq[2] = *(const LAS f32x4*)(Mg + 1872);
            a0 -= mq[3][0] * x[24]; b0 -= mq[3][0] * y[24]; a1 -= mq[3][1] * x[25]; b1 -= mq[3][1] * y[25]; a0 -= mq[3][2] * x[26]; b0 -= mq[3][2] * y[26]; a1 -= mq[3][3] * x[27]; b1 -= mq[3][3] * y[27]; x[28] = a0 + a1; y[28] = b0 + b1; up[3584] = x[28]; wp[3584] = f2bf(-y[28]); mq[3] = *(const LAS f32x4*)(Mg + 1876);
            { const float br = betg[29]; a0 = bf2f(*(const LAS bf16_t*)(lg + P5_VS + 7888 + c * 2)) * br; b0 = bf2f(*(const LAS bf16_t*)(lg + P5_KS + 7888 + c * 2)) * br * __expf(decg[29]); a1 = 0.f; b1 = 0.f; } a0 -= mq[4][0] * x[0]; b0 -= mq[4][0] * y[0]; a1 -= mq[4][1] * x[1]; b1 -= mq[4][1] * y[1]; a0 -= mq[4][2] * x[2]; b0 -= mq[4][2] * y[2]; a1 -= mq[4][3] * x[3]; b1 -= mq[4][3] * y[3]; mq[4] = *(const LAS f32x4*)(Mg + 1880);
            a0 -= mq[5][0] * x[4]; b0 -= mq[5][0] * y[4]; a1 -= mq[5][1] * x[5]; b1 -= mq[5][1] * y[5]; a0 -= mq[5][2] * x[6]; b0 -= mq[5][2] * y[6]; a1 -= mq[5][3] * x[7]; b1 -= mq[5][3] * y[7]; mq[5] = *(const LAS f32x4*)(Mg + 1884);
            a0 -= mq[0][0] * x[8]; b0 -= mq[0][0] * y[8]; a1 -= mq[0][1] * x[9]; b1 -= mq[0][1] * y[9]; a0 -= mq[0][2] * x[10]; b0 -= mq[0][2] * y[10]; a1 -= mq[0][3] * x[11]; b1 -= mq[0][3] * y[11]; mq[0] = *(const LAS f32x4*)(Mg + 1920);
            a0 -= mq[1][0] * x[12]; b0 -= mq[1][0] * y[12]; a1 -= mq[1][1] * x[13]; b1 -= mq[1][1] * y[13]; a0 -= mq[1][2] * x[14]; b0 -= mq[1][2] * y[14]; a1 -= mq[1][3] * x[15]; b1 -= mq[1][3] * y[15]; mq[1] = *(const LAS f32x4*)(Mg + 1924);
            a0 -= mq[2][0] * x[16]; b0 -= mq[2][0] * y[16]; a1 -= mq[2][1] * x[17]; b1 -= mq[2][1] * y[17]; a0 -= mq[2][2] * x[18]; b0 -= mq[2][2] * y[18]; a1 -= mq[2][3] * x[19]; b1 -= mq[2][3] * y[19]; mq[2] = *(const LAS f32x4*)(Mg + 1928);
            a0 -= mq[3][0] * x[20]; b0 -= mq[3][0] * y[20]; a1 -= mq[3][1] * x[21]; b1 -= mq[3][1] * y[21]; a0 -= mq[3][2] * x[22]; b0 -= mq[3][2] * y[22]; a1 -= mq[3][3] * x[23]; b1 -= mq[3][3] * y[23]; mq[3] = *(const LAS f32x4*)(Mg + 1932);
            a0 -= mq[4][0] * x[24]; b0 -= mq[4][0] * y[24]; a1 -= mq[4][1] * x[25]; b1 -= mq[4][1] * y[25]; a0 -= mq[4][2] * x[26]; b0 -= mq[4][2] * y[26]; a1 -= mq[4][3] * x[27]; b1 -= mq[4][3] * y[27]; mq[4] = *(const LAS f32x4*)(Mg + 1936);
            a0 -= mq[5][0] * x[28]; b0 -= mq[5][0] * y[28]; x[29] = a0 + a1; y[29] = b0 + b1; up[3712] = x[29]; wp[3712] = f2bf(-y[29]); mq[5] = *(const LAS f32x4*)(Mg + 1940);
            { const float br = betg[30]; a0 = bf2f(*(const LAS bf16_t*)(lg + P5_VS + 8160 + c * 2)) * br; b0 = bf2f(*(const LAS bf16_t*)(lg + P5_KS + 8160 + c * 2)) * br * __expf(decg[30]); a1 = 0.f; b1 = 0.f; } a0 -= mq[0][0] * x[0]; b0 -= mq[0][0] * y[0]; a1 -= mq[0][1] * x[1]; b1 -= mq[0][1] * y[1]; a0 -= mq[0][2] * x[2]; b0 -= mq[0][2] * y[2]; a1 -= mq[0][3] * x[3]; b1 -= mq[0][3] * y[3]; mq[0] = *(const LAS f32x4*)(Mg + 1944);
            a0 -= mq[1][0] * x[4]; b0 -= mq[1][0] * y[4]; a1 -= mq[1][1] * x[5]; b1 -= mq[1][1] * y[5]; a0 -= mq[1][2] * x[6]; b0 -= mq[1][2] * y[6]; a1 -= mq[1][3] * x[7]; b1 -= mq[1][3] * y[7]; mq[1] = *(const LAS f32x4*)(Mg + 1948);
            a0 -= mq[2][0] * x[8]; b0 -= mq[2][0] * y[8]; a1 -= mq[2][1] * x[9]; b1 -= mq[2][1] * y[9]; a0 -= mq[2][2] * x[10]; b0 -= mq[2][2] * y[10]; a1 -= mq[2][3] * x[11]; b1 -= mq[2][3] * y[11]; mq[2] = *(const LAS f32x4*)(Mg + 1984);
            a0 -= mq[3][0] * x[12]; b0 -= mq[3][0] * y[12]; a1 -= mq[3][1] * x[13]; b1 -= mq[3][1] * y[13]; a0 -= mq[3][2] * x[14]; b0 -= mq[3][2] * y[14]; a1 -= mq[3][3] * x[15]; b1 -= mq[3][3] * y[15]; mq[3] = *(const LAS f32x4*)(Mg + 1988);
            a0 -= mq[4][0] * x[16]; b0 -= mq[4][0] * y[16]; a1 -= mq[4][1] * x[17]; b1 -= mq[4][1] * y[17]; a0 -= mq[4][2] * x[18]; b0 -= mq[4][2] * y[18]; a1 -= mq[4][3] * x[19]; b1 -= mq[4][3] * y[19]; mq[4] = *(const LAS f32x4*)(Mg + 1992);
            a0 -= mq[5][0] * x[20]; b0 -= mq[5][0] * y[20]; a1 -= mq[5][1] * x[21]; b1 -= mq[5][1] * y[21]; a0 -= mq[5][2] * x[22]; b0 -= mq[5][2] * y[22]; a1 -= mq[5][3] * x[23]; b1 -= mq[5][3] * y[23]; mq[5] = *(const LAS f32x4*)(Mg + 1996);
            a0 -= mq[0][0] * x[24]; b0 -= mq[0][0] * y[24]; a1 -= mq[0][1] * x[25]; b1 -= mq[0][1] * y[25]; a0 -= mq[0][2] * x[26]; b0 -= mq[0][2] * y[26]; a1 -= mq[0][3] * x[27]; b1 -= mq[0][3] * y[27]; mq[0] = *(const LAS f32x4*)(Mg + 2000);
            a0 -= mq[1][0] * x[28]; b0 -= mq[1][0] * y[28]; a1 -= mq[1][1] * x[29]; b1 -= mq[1][1] * y[29]; x[30] = a0 + a1; y[30] = b0 + b1; up[3840] = x[30]; wp[3840] = f2bf(-y[30]); mq[1] = *(const LAS f32x4*)(Mg + 2004);
            { const float br = betg[31]; a0 = bf2f(*(const LAS bf16_t*)(lg + P5_VS + 8432 + c * 2)) * br; b0 = bf2f(*(const LAS bf16_t*)(lg + P5_KS + 8432 + c * 2)) * br * __expf(decg[31]); a1 = 0.f; b1 = 0.f; } a0 -= mq[2][0] * x[0]; b0 -= mq[2][0] * y[0]; a1 -= mq[2][1] * x[1]; b1 -= mq[2][1] * y[1]; a0 -= mq[2][2] * x[2]; b0 -= mq[2][2] * y[2]; a1 -= mq[2][3] * x[3]; b1 -= mq[2][3] * y[3]; mq[2] = *(const LAS f32x4*)(Mg + 2008);
            a0 -= mq[3][0] * x[4]; b0 -= mq[3][0] * y[4]; a1 -= mq[3][1] * x[5]; b1 -= mq[3][1] * y[5]; a0 -= mq[3][2] * x[6]; b0 -= mq[3][2] * y[6]; a1 -= mq[3][3] * x[7]; b1 -= mq[3][3] * y[7]; mq[3] = *(const LAS f32x4*)(Mg + 2012);
            a0 -= mq[4][0] * x[8]; b0 -= mq[4][0] * y[8]; a1 -= mq[4][1] * x[9]; b1 -= mq[4][1] * y[9]; a0 -= mq[4][2] * x[10]; b0 -= mq[4][2] * y[10]; a1 -= mq[4][3] * x[11]; b1 -= mq[4][3] * y[11]; mq[4] = *(const LAS f32x4*)(Mg + 2048);
            a0 -= mq[5][0] * x[12]; b0 -= mq[5][0] * y[12]; a1 -= mq[5][1] * x[13]; b1 -= mq[5][1] * y[13]; a0 -= mq[5][2] * x[14]; b0 -= mq[5][2] * y[14]; a1 -= mq[5][3] * x[15]; b1 -= mq[5][3] * y[15]; mq[5] = *(const LAS f32x4*)(Mg + 2052);
            a0 -= mq[0][0] * x[16]; b0 -= mq[0][0] * y[16]; a1 -= mq[0][1] * x[17]; b1 -= mq[0][1] * y[17]; a0 -= mq[0][2] * x[18]; b0 -= mq[0][2] * y[18]; a1 -= mq[0][3] * x[19]; b1 -= mq[0][3] * y[19]; mq[0] = *(const LAS f32x4*)(Mg + 2056);
            a0 -= mq[1][0] * x[20]; b0 -= mq[1][0] * y[20]; a1 -= mq[1][1] * x[21]; b1 -= mq[1][1] * y[21]; a0 -= mq[1][2] * x[22]; b0 -= mq[1][2] * y[22]; a1 -= mq[1][3] * x[23]; b1 -= mq[1][3] * y[23]; mq[1] = *(const LAS f32x4*)(Mg + 2060);
            a0 -= mq[2][0] * x[24]; b0 -= mq[2][0] * y[24]; a1 -= mq[2][1] * x[25]; b1 -= mq[2][1] * y[25]; a0 -= mq[2][2] * x[26]; b0 -= mq[2][2] * y[26]; a1 -= mq[2][3] * x[27]; b1 -= mq[2][3] * y[27]; mq[2] = *(const LAS f32x4*)(Mg + 2064);
            a0 -= mq[3][0] * x[28]; b0 -= mq[3][0] * y[28]; a1 -= mq[3][1] * x[29]; b1 -= mq[3][1] * y[29]; a0 -= mq[3][2] * x[30]; b0 -= mq[3][2] * y[30]; x[31] = a0 + a1; y[31] = b0 + b1; up[3968] = x[31]; wp[3968] = f2bf(-y[31]); mq[3] = *(const LAS f32x4*)(Mg + 2068);
            { const float br = betg[32]; a0 = bf2f(*(const LAS bf16_t*)(lg + P5_VS + 8704 + c * 2)) * br; b0 = bf2f(*(const LAS bf16_t*)(lg + P5_KS + 8704 + c * 2)) * br * __expf(decg[32]); a1 = 0.f; b1 = 0.f; } a0 -= mq[4][0] * x[0]; b0 -= mq[4][0] * y[0]; a1 -= mq[4][1] * x[1]; b1 -= mq[4][1] * y[1]; a0 -= mq[4][2] * x[2]; b0 -= mq[4][2] * y[2]; a1 -= mq[4][3] * x[3]; b1 -= mq[4][3] * y[3]; mq[4] = *(const LAS f32x4*)(Mg + 2072);
            a0 -= mq[5][0] * x[4]; b0 -= mq[5][0] * y[4]; a1 -= mq[5][1] * x[5]; b1 -= mq[5][1] * y[5]; a0 -= mq[5][2] * x[6]; b0 -= mq[5][2] * y[6]; a1 -= mq[5][3] * x[7]; b1 -= mq[5][3] * y[7]; mq[5] = *(const LAS f32x4*)(Mg + 2076);
            a0 -= mq[0][0] * x[8]; b0 -= mq[0][0] * y[8]; a1 -= mq[0][1] * x[9]; b1 -= mq[0][1] * y[9]; a0 -= mq[0][2] * x[10]; b0 -= mq[0][2] * y[10]; a1 -= mq[0][3] * x[11]; b1 -= mq[0][3] * y[11]; mq[0] = *(const LAS f32x4*)(Mg + 2112);
            a0 -= mq[1][0] * x[12]; b0 -= mq[1][0] * y[12]; a1 -= mq[1][1] * x[13]; b1 -= mq[1][1] * y[13]; a0 -= mq[1][2] * x[14]; b0 -= mq[1][2] * y[14]; a1 -= mq[1][3] * x[15]; b1 -= mq[1][3] * y[15]; mq[1] = *(const LAS f32x4*)(Mg + 2116);
            a0 -= mq[2][0] * x[16]; b0 -= mq[2][0] * y[16]; a1 -= mq[2][1] * x[17]; b1 -= mq[2][1] * y[17]; a0 -= mq[2][2] * x[18]; b0 -= mq[2][2] * y[18]; a1 -= mq[2][3] * x[19]; b1 -= mq[2][3] * y[19]; mq[2] = *(const LAS f32x4*)(Mg + 2120);
            a0 -= mq[3][0] * x[20]; b0 -= mq[3][0] * y[20]; a1 -= mq[3][1] * x[21]; b1 -= mq[3][1] * y[21]; a0 -= mq[3][2] * x[22]; b0 -= mq[3][2] * y[22]; a1 -= mq[3][3] * x[23]; b1 -= mq[3][3] * y[23]; mq[3] = *(const LAS f32x4*)(Mg + 2124);
            a0 -= mq[4][0] * x[24]; b0 -= mq[4][0] * y[24]; a1 -= mq[4][1] * x[25]; b1 -= mq[4][1] * y[25]; a0 -= mq[4][2] * x[26]; b0 -= mq[4][2] * y[26]; a1 -= mq[4][3] * x[27]; b1 -= mq[4][3] * y[27]; mq[4] = *(const LAS f32x4*)(Mg + 2128);
            a0 -= mq[5][0] * x[28]; b0 -= mq[5][0] * y[28]; a1 -= mq[5][1] * x[29]; b1 -= mq[5][1] * y[29]; a0 -= mq[5][2] * x[30]; b0 -= mq[5][2] * y[30]; a1 -= mq[5][3] * x[31]; b1 -= mq[5][3] * y[31]; x[32] = a0 + a1; y[32] = b0 + b1; up[4096] = x[32]; wp[4096] = f2bf(-y[32]); mq[5] = *(const LAS f32x4*)(Mg + 2132);
            { const float br = betg[33]; a0 = bf2f(*(const LAS bf16_t*)(lg + P5_VS + 8976 + c * 2)) * br; b0 = bf2f(*(const LAS bf16_t*)(lg + P5_KS + 8976 + c * 2)) * br * __expf(decg[33]); a1 = 0.f; b1 = 0.f; } a0 -= mq[0][0] * x[0]; b0 -= mq[0][0] * y[0]; a1 -= mq[0][1] * x[1]; b1 -= mq[0][1] * y[1]; a0 -= mq[0][2] * x[2]; b0 -= mq[0][2] * y[2]; a1 -= mq[0][3] * x[3]; b1 -= mq[0][3] * y[3]; mq[0] = *(const LAS f32x4*)(Mg + 2136);
            a0 -= mq[1][0] * x[4]; b0 -= mq[1][0] * y[4]; a1 -= mq[1][1] * x[5]; b1 -= mq[1][1] * y[5]; a0 -= mq[1][2] * x[6]; b0 -= mq[1][2] * y[6]; a1 -= mq[1][3] * x[7]; b1 -= mq[1][3] * y[7]; mq[1] = *(const LAS f32x4*)(Mg + 2140);
            a0 -= mq[2][0] * x[8]; b0 -= mq[2][0] * y[8]; a1 -= mq[2][1] * x[9]; b1 -= mq[2][1] * y[9]; a0 -= mq[2][2] * x[10]; b0 -= mq[2][2] * y[10]; a1 -= mq[2][3] * x[11]; b1 -= mq[2][3] * y[11]; mq[2] = *(const LAS f32x4*)(Mg + 2144);
            a0 -= mq[3][0] * x[12]; b0 -= mq[3][0] * y[12]; a1 -= mq[3][1] * x[13]; b1 -= mq[3][1] * y[13]; a0 -= mq[3][2] * x[14]; b0 -= mq[3][2] * y[14]; a1 -= mq[3][3] * x[15]; b1 -= mq[3][3] * y[15]; mq[3] = *(const LAS f32x4*)(Mg + 2176);
            a0 -= mq[4][0] * x[16]; b0 -= mq[4][0] * y[16]; a1 -= mq[4][1] * x[17]; b1 -= mq[4][1] * y[17]; a0 -= mq[4][2] * x[18]; b0 -= mq[4][2] * y[18]; a1 -= mq[4][3] * x[19]; b1 -= mq[4][3] * y[19]; mq[4] = *(const LAS f32x4*)(Mg + 2180);
            a0 -= mq[5][0] * x[20]; b0 -= mq[5][0] * y[20]; a1 -= mq[5][1] * x[21]; b1 -= mq[5][1] * y[21]; a0 -= mq[5][2] * x[22]; b0 -= mq[5][2] * y[22]; a1 -= mq[5][3] * x[23]; b1 -= mq[5][3] * y[23]; mq[5] = *(const LAS f32x4*)(Mg + 2184);
            a0 -= mq[0][0] * x[24]; b0 -= mq[0][0] * y[24]; a1 -= mq[0][1] * x[25]; b1 -= mq[0][1] * y[25]; a0 -= mq[0][2] * x[26]; b0 -= mq[0][2] * y[26]; a1 -= mq[0][3] * x[27]; b1 -= mq[0][3] * y[27]; mq[0] = *(const LAS f32x4*)(Mg + 2188);
            a0 -= mq[1][0] * x[28]; b0 -= mq[1][0] * y[28]; a1 -= mq[1][1] * x[29]; b1 -= mq[1][1] * y[29]; a0 -= mq[1][2] * x[30]; b0 -= mq[1][2] * y[30]; a1 -= mq[1][3] * x[31]; b1 -= mq[1][3] * y[31]; mq[1] = *(const LAS f32x4*)(Mg + 2192);
            a0 -= mq[2][0] * x[32]; b0 -= mq[2][0] * y[32]; x[33] = a0 + a1; y[33] = b0 + b1; up[4224] = x[33]; wp[4224] = f2bf(-y[33]); mq[2] = *(const LAS f32x4*)(Mg + 2196);
            { const float br = betg[34]; a0 = bf2f(*(const LAS bf16_t*)(lg + P5_VS + 9248 + c * 2)) * br; b0 = bf2f(*(const LAS bf16_t*)(lg + P5_KS + 9248 + c * 2)) * br * __expf(decg[34]); a1 = 0.f; b1 = 0.f; } a0 -= mq[3][0] * x[0]; b0 -= mq[3][0] * y[0]; a1 -= mq[3][1] * x[1]; b1 -= mq[3][1] * y[1]; a0 -= mq[3][2] * x[2]; b0 -= mq[3][2] * y[2]; a1 -= mq[3][3] * x[3]; b1 -= mq[3][3] * y[3]; mq[3] = *(const LAS f32x4*)(Mg + 2200);
            a0 -= mq[4][0] * x[4]; b0 -= mq[4][0] * y[4]; a1 -= mq[4][1] * x[5]; b1 -= mq[4][1] * y[5]; a0 -= mq[4][2] * x[6]; b0 -= mq[4][2] * y[6]; a1 -= mq[4][3] * x[7]; b1 -= mq[4][3] * y[7]; mq[4] = *(const LAS f32x4*)(Mg + 2204);
            a0 -= mq[5][0] * x[8]; b0 -= mq[5][0] * y[8]; a1 -= mq[5][1] * x[9]; b1 -= mq[5][1] * y[9]; a0 -= mq[5][2] * x[10]; b0 -= mq[5][2] * y[10]; a1 -= mq[5][3] * x[11]; b1 -= mq[5][3] * y[11]; mq[5] = *(const LAS f32x4*)(Mg + 2208);
            a0 -= mq[0][0] * x[12]; b0 -= mq[0][0] * y[12]; a1 -= mq[0][1] * x[13]; b1 -= mq[0][1] * y[13]; a0 -= mq[0][2] * x[14]; b0 -= mq[0][2] * y[14]; a1 -= mq[0][3] * x[15]; b1 -= mq[0][3] * y[15]; mq[0] = *(const LAS f32x4*)(Mg + 2240);
            a0 -= mq[1][0] * x[16]; b0 -= mq[1][0] * y[16]; a1 -= mq[1][1] * x[17]; b1 -= mq[1][1] * y[17]; a0 -= mq[1][2] * x[18]; b0 -= mq[1][2] * y[18]; a1 -= mq[1][3] * x[19]; b1 -= mq[1][3] * y[19]; mq[1] = *(const LAS f32x4*)(Mg + 2244);
            a0 -= mq[2][0] * x[20]; b0 -= mq[2][0] * y[20]; a1 -= mq[2][1] * x[21]; b1 -= mq[2][1] * y[21]; a0 -= mq[2][2] * x[22]; b0 -= mq[2][2] * y[22]; a1 -= mq[2][3] * x[23]; b1 -= mq[2][3] * y[23]; mq[2] = *(const LAS f32x4*)(Mg + 2248);
            a0 -= mq[3][0] * x[24]; b0 -= mq[3][0] * y[24]; a1 -= mq[3][1] * x[25]; b1 -= mq[3][1] * y[25]; a0 -= mq[3][2] * x[26]; b0 -= mq[3][2] * y[26]; a1 -= mq[3][3] * x[27]; b1 -= mq[3][3] * y[27]; mq[3] = *(const LAS f32x4*)(Mg + 2252);
            a0 -= mq[4][0] * x[28]; b0 -= mq[4][0] * y[28]; a1 -= mq[4][1] * x[29]; b1 -= mq[4][1] * y[29]; a0 -= mq[4][2] * x[30]; b0 -= mq[4][2] * y[30]; a1 -= mq[4][3] * x[31]; b1 -= mq[4][3] * y[31]; mq[4] = *(const LAS f32x4*)(Mg + 2256);
            a0 -= mq[5][0] * x[32]; b0 -= mq[5][0] * y[32]; a1 -= mq[5][1] * x[33]; b1 -= mq[5][1] * y[33]; x[34] = a0 + a1; y[34] = b0 + b1; up[4352] = x[34]; wp[4352] = f2bf(-y[34]); mq[5] = *(const LAS f32x4*)(Mg + 2260);
            { const float br = betg[35]; a0 = bf2f(*(const LAS bf16_t*)(lg + P5_VS + 9520 + c * 2)) * br; b0 = bf2f(*(const LAS bf16_t*)(lg + P5_KS + 9520 + c * 2)) * br * __expf(decg[35]); a1 = 0.f; b1 = 0.f; } a0 -= mq[0][0] * x[0]; b0 -= mq[0][0] * y[0]; a1 -= mq[0][1] * x[1]; b1 -= mq[0][1] * y[1]; a0 -= mq[0][2] * x[2]; b0 -= mq[0][2] * y[2]; a1 -= mq[0][3] * x[3]; b1 -= mq[0][3] * y[3]; mq[0] = *(const LAS f32x4*)(Mg + 2264);
            a0 -= mq[1][0] * x[4]; b0 -= mq[1][0] * y[4]; a1 -= mq[1][1] * x[5]; b1 -= mq[1][1] * y[5]; a0 -= mq[1][2] * x[6]; b0 -= mq[1][2] * y[6]; a1 -= mq[1][3] * x[7]; b1 -= mq[1][3] * y[7]; mq[1] = *(const LAS f32x4*)(Mg + 2268);
            a0 -= mq[2][0] * x[8]; b0 -= mq[2][0] * y[8]; a1 -= mq[2][1] * x[9]; b1 -= mq[2][1] * y[9]; a0 -= mq[2][2] * x[10]; b0 -= mq[2][2] * y[10]; a1 -= mq[2][3] * x[11]; b1 -= mq[2][3] * y[11]; mq[2] = *(const LAS f32x4*)(Mg + 2272);
            a0 -= mq[3][0] * x[12]; b0 -= mq[3][0] * y[12]; a1 -= mq[3][1] * x[13]; b1 -= mq[3][1] * y[13]; a0 -= mq[3][2] * x[14]; b0 -= mq[3][2] * y[14]; a1 -= mq[3][3] * x[15]; b1 -= mq[3][3] * y[15]; mq[3] = *(const LAS f32x4*)(Mg + 2304);
            a0 -= mq[4][0] * x[16]; b0 -= mq[4][0] * y[16]; a1 -= mq[4][1] * x[17]; b1 -= mq[4][1] * y[17]; a0 -= mq[4][2] * x[18]; b0 -= mq[4][2] * y[18]; a1 -= mq[4][3] * x[19]; b1 -= mq[4][3] * y[19]; mq[4] = *(const LAS f32x4*)(Mg + 2308);
            a0 -= mq[5][0] * x[20]; b0 -= mq[5][0] * y[20]; a1 -= mq[5][1] * x[21]; b1 -= mq[5][1] * y[21]; a0 -= mq[5][2] * x[22]; b0 -= mq[5][2] * y[22]; a1 -= mq[5][3] * x[23]; b1 -= mq[5][3] * y[23]; mq[5] = *(const LAS f32x4*)(Mg + 2312);
            a0 -= mq[0][0] * x[24]; b0 -= mq[0][0] * y[24]; a1 -= mq[0][1] * x[25]; b1 -= mq[0][1] * y[25]; a0 -= mq[0][2] * x[26]; b0 -= mq[0][2] * y[26]; a1 -= mq[0][3] * x[27]; b1 -= mq[0][3] * y[27]; mq[0] = *(const LAS f32x4*)(Mg + 2316);
            a0 -= mq[1][0] * x[28]; b0 -= mq[1][0] * y[28]; a1 -= mq[1][1] * x[29]; b1 -= mq[1][1] * y[29]; a0 -= mq[1][2] * x[30]; b0 -= mq[1][2] * y[30]; a1 -= mq[1][3] * x[31]; b1 -= mq[1][3] * y[31]; mq[1] = *(const LAS f32x4*)(Mg + 2320);
            a0 -= mq[2][0] * x[32]; b0 -= mq[2][0] * y[32]; a1 -= mq[2][1] * x[33]; b1 -= mq[2][1] * y[33]; a0 -= mq[2][2] * x[34]; b0 -= mq[2][2] * y[34]; x[35] = a0 + a1; y[35] = b0 + b1; up[4480] = x[35]; wp[4480] = f2bf(-y[35]); mq[2] = *(const LAS f32x4*)(Mg + 2324);
            { const float br = betg[36]; a0 = bf2f(*(const LAS bf16_t*)(lg + P5_VS + 9792 + c * 2)) * br; b0 = bf2f(*(const LAS bf16_t*)(lg + P5_KS + 9792 + c * 2)) * br * __expf(decg[36]); a1 = 0.f; b1 = 0.f; } a0 -= mq[3][0] * x[0]; b0 -= mq[3][0] * y[0]; a1 -= mq[3][1] * x[1]; b1 -= mq[3][1] * y[1]; a0 -= mq[3][2] * x[2]; b0 -= mq[3][2] * y[2]; a1 -= mq[3][3] * x[3]; b1 -= mq[3][3] * y[3]; mq[3] = *(const LAS f32x4*)(Mg + 2328);
            a0 -= mq[4][0] * x[4]; b0 -= mq[4][0] * y[4]; a1 -= mq[4][1] * x[5]; b1 -= mq[4][1] * y[5]; a0 -= mq[4][2] * x[6]; b0 -= mq[4][2] * y[6]; a1 -= mq[4][3] * x[7]; b1 -= mq[4][3] * y[7]; mq[4] = *(const LAS f32x4*)(Mg + 2332);
            a0 -= mq[5][0] * x[8]; b0 -= mq[5][0] * y[8]; a1 -= mq[5][1] * x[9]; b1 -= mq[5][1] * y[9]; a0 -= mq[5][2] * x[10]; b0 -= mq[5][2] * y[10]; a1 -= mq[5][3] * x[11]; b1 -= mq[5][3] * y[11]; mq[5] = *(const LAS f32x4*)(Mg + 2336);
            a0 -= mq[0][0] * x[12]; b0 -= mq[0][0] * y[12]; a1 -= mq[0][1] * x[13]; b1 -= mq[0][1] * y[13]; a0 -= mq[0][2] * x[14]; b0 -= mq[0][2] * y[14]; a1 -= mq[0][3] * x[15]; b1 -= mq[0][3] * y[15]; mq[0] = *(const LAS f32x4*)(Mg + 2368);
            a0 -= mq[1][0] * x[16]; b0 -= mq[1][0] * y[16]; a1 -= mq[1][1] * x[17]; b1 -= mq[1][1] * y[17]; a0 -= mq[1][2] * x[18]; b0 -= mq[1][2] * y[18]; a1 -= mq[1][3] * x[19]; b1 -= mq[1][3] * y[19]; mq[1] = *(const LAS f32x4*)(Mg + 2372);
            a0 -= mq[2][0] * x[20]; b0 -= mq[2][0] * y[20]; a1 -= mq[2][1] * x[21]; b1 -= mq[2][1] * y[21]; a0 -= mq[2][2] * x[22]; b0 -= mq[2][2] * y[22]; a1 -= mq[2][3] * x[23]; b1 -= mq[2][3] * y[23]; mq[2] = *(const LAS f32x4*)(Mg + 2376);
            a0 -= mq[3][0] * x[24]; b0 -= mq[3][0] * y[24]; a1 -= mq[3][1] * x[25]; b1 -= mq[3][1] * y[25]; a0 -= mq[3][2] * x[26]; b0 -= mq[3][2] * y[26]; a1 -= mq[3][3] * x[27]; b1 -= mq[3][3] * y[27]; mq[3] = *(const LAS f32x4*)(Mg + 2380);
            a0 -= mq[4][0] * x[28]; b0 -= mq[4][0] * y[28]; a1 -= mq[4][1] * x[29]; b1 -= mq[4][1] * y[29]; a0 -= mq[4][2] * x[30]; b0 -= mq[4][2] * y[30]; a1 -= mq[4][3] * x[31]; b1 -= mq[4][3] * y[31]; mq[4] = *(const LAS f32x4*)(Mg + 2384);
            a0 -= mq[5][0] * x[32]; b0 -= mq[5][0] * y[32]; a1 -= mq[5][1] * x[33]; b1 -= mq[5][1] * y[33]; a0 -= mq[5][2] * x[34]; b0 -= mq[5][2] * y[34]; a1 -= mq[5][3] * x[35]; b1 -= mq[5][3] * y[35]; x[36] = a0 + a1; y[36] = b0 + b1; up[4608] = x[36]; wp[4608] = f2bf(-y[36]); mq[5] = *(const LAS f32x4*)(Mg + 2388);
            { const float br = betg[37]; a0 = bf2f(*(const LAS bf16_t*)(lg + P5_VS + 10064 + c * 2)) * br; b0 = bf2f(*(const LAS bf16_t*)(lg + P5_KS + 10064 + c * 2)) * br * __expf(decg[37]); a1 = 0.f; b1 = 0.f; } a0 -= mq[0][0] * x[0]; b0 -= mq[0][0] * y[0]; a1 -= mq[0][1] * x[1]; b1 -= mq[0][1] * y[1]; a0 -= mq[0][2] * x[2]; b0 -= mq[0][2] * y[2]; a1 -= mq[0][3] * x[3]; b1 -= mq[0][3] * y[3]; mq[0] = *(const LAS f32x4*)(Mg + 2392);
            a0 -= mq[1][0] * x[4]; b0 -= mq[1][0] * y[4]; a1 -= mq[1][1] * x[5]; b1 -= mq[1][1] * y[5]; a0 -= mq[1][2] * x[6]; b0 -= mq[1][2] * y[6]; a1 -= mq[1][3] * x[7]; b1 -= mq[1][3] * y[7]; mq[1] = *(const LAS f32x4*)(Mg + 2396);
            a0 -= mq[2][0] * x[8]; b0 -= mq[2][0] * y[8]; a1 -= mq[2][1] * x[9]; b1 -= mq[2][1] * y[9]; a0 -= mq[2][2] * x[10]; b0 -= mq[2][2] * y[10]; a1 -= mq[2][3] * x[11]; b1 -= mq[2][3] * y[11]; mq[2] = *(const LAS f32x4*)(Mg + 2400);
            a0 -= mq[3][0] * x[12]; b0 -= mq[3][0] * y[12]; a1 -= mq[3][1] * x[13]; b1 -= mq[3][1] * y[13]; a0 -= mq[3][2] * x[14]; b0 -= mq[3][2] * y[14]; a1 -= mq[3][3] * x[15]; b1 -= mq[3][3] * y[15]; mq[3] = *(const LAS f32x4*)(Mg + 2404);
            a0 -= mq[4][0] * x[16]; b0 -= mq[4][0] * y[16]; a1 -= mq[4][1] * x[17]; b1 -= mq[4][1] * y[17]; a0 -= mq[4][2] * x[18]; b0 -= mq[4][2] * y[18]; a1 -= mq[4][3] * x[19]; b1 -= mq[4][3] * y[19]; mq[4] = *(const LAS f32x4*)(Mg + 2432);
            a0 -= mq[5][0] * x[20]; b0 -= mq[5][0] * y[20]; a1 -= mq[5][1] * x[21]; b1 -= mq[5][1] * y[21]; a0 -= mq[5][2] * x[22]; b0 -= mq[5][2] * y[22]; a1 -= mq[5][3] * x[23]; b1 -= mq[5][3] * y[23]; mq[5] = *(const LAS f32x4*)(Mg + 2436);
            a0 -= mq[0][0] * x[24]; b0 -= mq[0][0] * y[24]; a1 -= mq[0][1] * x[25]; b1 -= mq[0][1] * y[25]; a0 -= mq[0][2] * x[26]; b0 -= mq[0][2] * y[26]; a1 -= mq[0][3] * x[27]; b1 -= mq[0][3] * y[27]; mq[0] = *(const LAS f32x4*)(Mg + 2440);
            a0 -= mq[1][0] * x[28]; b0 -= mq[1][0] * y[28]; a1 -= mq[1][1] * x[29]; b1 -= mq[1][1] * y[29]; a0 -= mq[1][2] * x[30]; b0 -= mq[1][2] * y[30]; a1 -= mq[1][3] * x[31]; b1 -= mq[1][3] * y[31]; mq[1] = *(const LAS f32x4*)(Mg + 2444);
            a0 -= mq[2][0] * x[32]; b0 -= mq[2][0] * y[32]; a1 -= mq[2][1] * x[33]; b1 -= mq[2][1] * y[33]; a0 -= mq[2][2] * x[34]; b0 -= mq[2][2] * y[34]; a1 -= mq[2][3] * x[35]; b1 -= mq[2][3] * y[35]; mq[2] = *(const LAS f32x4*)(Mg + 2448);
            a0 -= mq[3][0] * x[36]; b0 -= mq[3][0] * y[36]; x[37] = a0 + a1; y[37] = b0 + b1; up[4736] = x[37]; wp[4736] = f2bf(-y[37]); mq[3] = *(const LAS f32x4*)(Mg + 2452);
            { const float br = betg[38]; a0 = bf2f(*(const LAS bf16_t*)(lg + P5_VS + 10336 + c * 2)) * br; b0 = bf2f(*(const LAS bf16_t*)(lg + P5_KS + 10336 + c * 2)) * br * __expf(decg[38]); a1 = 0.f; b1 = 0.f; } a0 -= mq[4][0] * x[0]; b0 -= mq[4][0] * y[0]; a1 -= mq[4][1] * x[1]; b1 -= mq[4][1] * y[1]; a0 -= mq[4][2] * x[2]; b0 -= mq[4][2] * y[2]; a1 -= mq[4][3] * x[3]; b1 -= mq[4][3] * y[3]; mq[4] = *(const LAS f32x4*)(Mg + 2456);
            a0 -= mq[5][0] * x[4]; b0 -= mq[5][0] * y[4]; a1 -= mq[5][1] * x[5]; b1 -= mq[5][1] * y[5]; a0 -= mq[5][2] * x[6]; b0 -= mq[5][2] * y[6]; a1 -= mq[5][3] * x[7]; b1 -= mq[5][3] * y[7]; mq[5] = *(const LAS f32x4*)(Mg + 2460);
            a0 -= mq[0][0] * x[8]; b0 -= mq[0][0] * y[8]; a1 -= mq[0][1] * x[9]; b1 -= mq[0][1] * y[9]; a0 -= mq[0][2] * x[10]; b0 -= mq[0][2] * y[10]; a1 -= mq[0][3] * x[11]; b1 -= mq[0][3] * y[11]; mq[0] = *(const LAS f32x4*)(Mg + 2464);
            a0 -= mq[1][0] * x[12]; b0 -= mq[1][0] * y[12]; a1 -= mq[1][1] * x[13]; b1 -= mq[1][1] * y[13]; a0 -= mq[1][2] * x[14]; b0 -= mq[1][2] * y[14]; a1 -= mq[1][3] * x[15]; b1 -= mq[1][3] * y[15]; mq[1] = *(const LAS f32x4*)(Mg + 2468);
            a0 -= mq[2][0] * x[16]; b0 -= mq[2][0] * y[16]; a1 -= mq[2][1] * x[17]; b1 -= mq[2][1] * y[17]; a0 -= mq[2][2] * x[18]; b0 -= mq[2][2] * y[18]; a1 -= mq[2][3] * x[19]; b1 -= mq[2][3] * y[19]; mq[2] = *(const LAS f32x4*)(Mg + 2496);
            a0 -= mq[3][0] * x[20]; b0 -= mq[3][0] * y[20]; a1 -= mq[3][1] * x[21]; b1 -= mq[3][1] * y[21]; a0 -= mq[3][2] * x[22]; b0 -= mq[3][2] * y[22]; a1 -= mq[3][3] * x[23]; b1 -= mq[3][3] * y[23]; mq[3] = *(const LAS f32x4*)(Mg + 2500);
            a0 -= mq[4][0] * x[24]; b0 -= mq[4][0] * y[24]; a1 -= mq[4][1] * x[25]; b1 -= mq[4][1] * y[25]; a0 -= mq[4][2] * x[26]; b0 -= mq[4][2] * y[26]; a1 -= mq[4][3] * x[27]; b1 -= mq[4][3] * y[27]; mq[4] = *(const LAS f32x4*)(Mg + 2504);
            a0 -= mq[5][0] * x[28]; b0 -= mq[5][0] * y[28]; a1 -= mq[5][1] * x[29]; b1 -= mq[5][1] * y[29]; a0 -= mq[5][2] * x[30]; b0 -= mq[5][2] * y[30]; a1 -= mq[5][3] * x[31]; b1 -= mq[5][3] * y[31]; mq[5] = *(const LAS f32x4*)(Mg + 2508);
            a0 -= mq[0][0] * x[32]; b0 -= mq[0][0] * y[32]; a1 -= mq[0][1] * x[33]; b1 -= mq[0][1] * y[33]; a0 -= mq[0][2] * x[34]; b0 -= mq[0][2] * y[34]; a1 -= mq[0][3] * x[35]; b1 -= mq[0][3] * y[35]; mq[0] = *(const LAS f32x4*)(Mg + 2512);
            a0 -= mq[1][0] * x[36]; b0 -= mq[1][0] * y[36]; a1 -= mq[1][1] * x[37]; b1 -= mq[1][1] * y[37]; x[38] = a0 + a1; y[38] = b0 + b1; up[4864] = x[38]; wp[4864] = f2bf(-y[38]); mq[1] = *(const LAS f32x4*)(Mg + 2516);
            { const float br = betg[39]; a0 = bf2f(*(const LAS bf16_t*)(lg + P5_VS + 10608 + c * 2)) * br; b0 = bf2f(*(const LAS bf16_t*)(lg + P5_KS + 10608 + c * 2)) * br * __expf(decg[39]); a1 = 0.f; b1 = 0.f; } a0 -= mq[2][0] * x[0]; b0 -= mq[2][0] * y[0]; a1 -= mq[2][1] * x[1]; b1 -= mq[2][1] * y[1]; a0 -= mq[2][2] * x[2]; b0 -= mq[2][2] * y[2]; a1 -= mq[2][3] * x[3]; b1 -= mq[2][3] * y[3]; mq[2] = *(const LAS f32x4*)(Mg + 2520);
            a0 -= mq[3][0] * x[4]; b0 -= mq[3][0] * y[4]; a1 -= mq[3][1] * x[5]; b1 -= mq[3][1] * y[5]; a0 -= mq[3][2] * x[6]; b0 -= mq[3][2] * y[6]; a1 -= mq[3][3] * x[7]; b1 -= mq[3][3] * y[7]; mq[3] = *(const LAS f32x4*)(Mg + 2524);
            a0 -= mq[4][0] * x[8]; b0 -= mq[4][0] * y[8]; a1 -= mq[4][1] * x[9]; b1 -= mq[4][1] * y[9]; a0 -= mq[4][2] * x[10]; b0 -= mq[4][2] * y[10]; a1 -= mq[4][3] * x[11]; b1 -= mq[4][3] * y[11]; mq[4] = *(const LAS f32x4*)(Mg + 2528);
            a0 -= mq[5][0] * x[12]; b0 -= mq[5][0] * y[12]; a1 -= mq[5][1] * x[13]; b1 -= mq[5][1] * y[13]; a0 -= mq[5][2] * x[14]; b0 -= mq[5][2] * y[14]; a1 -= mq[5][3] * x[15]; b1 -= mq[5][3] * y[15]; mq[5] = *(const LAS f32x4*)(Mg + 2532);
            a0 -= mq[0][0] * x[16]; b0 -= mq[0][0] * y[16]; a1 -= mq[0][1] * x[17]; b1 -= mq[0][1] * y[17]; a0 -= mq[0][2] * x[18]; b0 -= mq[0][2] * y[18]; a1 -= mq[0][3] * x[19]; b1 -= mq[0][3] * y[19]; mq[0] = *(const LAS f32x4*)(Mg + 2560);
            a0 -= mq[1][0] * x[20]; b0 -= mq[1][0] * y[20]; a1 -= mq[1][1] * x[21]; b1 -= mq[1][1] * y[21]; a0 -= mq[1][2] * x[22]; b0 -= mq[1][2] * y[22]; a1 -= mq[1][3] * x[23]; b1 -= mq[1][3] * y[23]; mq[1] = *(const LAS f32x4*)(Mg + 2564);
            a0 -= mq[2][0] * x[24]; b0 -= mq[2][0] * y[24]; a1 -= mq[2][1] * x[25]; b1 -= mq[2][1] * y[25]; a0 -= mq[2][2] * x[26]; b0 -= mq[2][2] * y[26]; a1 -= mq[2][3] * x[27]; b1 -= mq[2][3] * y[27]; mq[2] = *(const LAS f32x4*)(Mg + 2568);
            a0 -= mq[3][0] * x[28]; b0 -= mq[3][0] * y[28]; a1 -= mq[3][1] * x[29]; b1 -= mq[3][1] * y[29]; a0 -= mq[3][2] * x[30]; b0 -= mq[3][2] * y[30]; a1 -= mq[3][3] * x[31]; b1 -= mq[3][3] * y[31]; mq[3] = *(const LAS f32x4*)(Mg + 2572);
            a0 -= mq[4][0] * x[32]; b0 -= mq[4][0] * y[32]; a1 -= mq[4][1] * x[33]; b1 -= mq[4][1] * y[33]; a0 -= mq[4][2] * x[34]; b0 -= mq[4][2] * y[34]; a1 -= mq[4][3] * x[35]; b1 -= mq[4][3] * y[35]; mq[4] = *(const LAS f32x4*)(Mg + 2576);
            a0 -= mq[5][0] * x[36]; b0 -= mq[5][0] * y[36]; a1 -= mq[5][1] * x[37]; b1 -= mq[5][1] * y[37]; a0 -= mq[5][2] * x[38]; b0 -= mq[5][2] * y[38]; x[39] = a0 + a1; y[39] = b0 + b1; up[4992] = x[39]; wp[4992] = f2bf(-y[39]); mq[5] = *(const LAS f32x4*)(Mg + 2580);
            { const float br = betg[40]; a0 = bf2f(*(const LAS bf16_t*)(lg + P5_VS + 10880 + c * 2)) * br; b0 = bf2f(*(const LAS bf16_t*)(lg + P5_KS + 10880 + c * 2)) * br * __expf(decg[40]); a1 = 0.f; b1 = 0.f; } a0 -= mq[0][0] * x[0]; b0 -= mq[0][0] * y[0]; a1 -= mq[0][1] * x[1]; b1 -= mq[0][1] * y[1]; a0 -= mq[0][2] * x[2]; b0 -= mq[0][2] * y[2]; a1 -= mq[0][3] * x[3]; b1 -= mq[0][3] * y[3]; mq[0] = *(const LAS f32x4*)(Mg + 2584);
            a0 -= mq[1][0] * x[4]; b0 -= mq[1][0] * y[4]; a1 -= mq[1][1] * x[5]; b1 -= mq[1][1] * y[5]; a0 -= mq[1][2] * x[6]; b0 -= mq[1][2] * y[6]; a1 -= mq[1][3] * x[7]; b1 -= mq[1][3] * y[7]; mq[1] = *(const LAS f32x4*)(Mg + 2588);
            a0 -= mq[2][0] * x[8]; b0 -= mq[2][0] * y[8]; a1 -= mq[2][1] * x[9]; b1 -= mq[2][1] * y[9]; a0 -= mq[2][2] * x[10]; b0 -= mq[2][2] * y[10]; a1 -= mq[2][3] * x[11]; b1 -= mq[2][3] * y[11]; mq[2] = *(const LAS f32x4*)(Mg + 2592);
            a0 -= mq[3][0] * x[12]; b0 -= mq[3][0] * y[12]; a1 -= mq[3][1] * x[13]; b1 -= mq[3][1] * y[13]; a0 -= mq[3][2] * x[14]; b0 -= mq[3][2] * y[14]; a1 -= mq[3][3] * x[15]; b1 -= mq[3][3] * y[15]; mq[3] = *(const LAS f32x4*)(Mg + 2596);
            a0 -= mq[4][0] * x[16]; b0 -= mq[4][0] * y[16]; a1 -= mq[4][1] * x[17]; b1 -= mq[4][1] * y[17]; a0 -= mq[4][2] * x[18]; b0 -= mq[4][2] * y[18]; a1 -= mq[4][3] * x[19]; b1 -= mq[4][3] * y[19]; mq[4] = *(const LAS f32x4*)(Mg + 2624);
            a0 -= mq[5][0] * x[20]; b0 -= mq[5][0] * y[20]; a1 -= mq[5][1] * x[21]; b1 -= mq[5][1] * y[21]; a0 -= mq[5][2] * x[22]; b0 -= mq[5][2] * y[22]; a1 -= mq[5][3] * x[23]; b1 -= mq[5][3] * y[23]; mq[5] = *(const LAS f32x4*)(Mg + 2628);
            a0 -= mq[0][0] * x[24]; b0 -= mq[0][0] * y[24]; a1 -= mq[0][1] * x[25]; b1 -= mq[0][1] * y[25]; a0 -= mq[0][2] * x[26]; b0 -= mq[0][2] * y[26]; a1 -= mq[0][3] * x[27]; b1 -= mq[0][3] * y[27]; mq[0] = *(const LAS f32x4*)(Mg + 2632);
            a0 -= mq[1][0] * x[28]; b0 -= mq[1][0] * y[28]; a1 -= mq[1][1] * x[29]; b1 -= mq[1][1] * y[29]; a0 -= mq[1][2] * x[30]; b0 -= mq[1][2] * y[30]; a1 -= mq[1][3] * x[31]; b1 -= mq[1][3] * y[31]; mq[1] = *(const LAS f32x4*)(Mg + 2636);
            a0 -= mq[2][0] * x[32]; b0 -= mq[2][0] * y[32]; a1 -= mq[2][1] * x[33]; b1 -= mq[2][1] * y[33]; a0 -= mq[2][2] * x[34]; b0 -= mq[2][2] * y[34]; a1 -= mq[2][3] * x[35]; b1 -= mq[2][3] * y[35]; mq[2] = *(const LAS f32x4*)(Mg + 2640);
            a0 -= mq[3][0] * x[36]; b0 -= mq[3][0] * y[36]; a1 -= mq[3][1] * x[37]; b1 -= mq[3][1] * y[37]; a0 -= mq[3][2] * x[38]; b0 -= mq[3][2] * y[38]; a1 -= mq[3][3] * x[39]; b1 -= mq[3][3] * y[39]; x[40] = a0 + a1; y[40] = b0 + b1; up[5120] = x[40]; wp[5120] = f2bf(-y[40]); mq[3] = *(const LAS f32x4*)(Mg + 2644);
            { const float br = betg[41]; a0 = bf2f(*(const LAS bf16_t*)(lg + P5_VS + 11152 + c * 2)) * br; b0 = bf2f(*(const LAS bf16_t*)(lg + P5_KS + 11152 + c * 2)) * br * __expf(decg[41]); a1 = 0.f; b1 = 0.f; } a0 -= mq[4][0] * x[0]; b0 -= mq[4][0] * y[0]; a1 -= mq[4][1] * x[1]; b1 -= mq[4][1] * y[1]; a0 -= mq[4][2] * x[2]; b0 -= mq[4][2] * y[2]; a1 -= mq[4][3] * x[3]; b1 -= mq[4][3] * y[3]; mq[4] = *(const LAS f32x4*)(Mg + 2648);
            a0 -= mq[5][0] * x[4]; b0 -= mq[5][0] * y[4]; a1 -= mq[5][1] * x[5]; b1 -= mq[5][1] * y[5]; a0 -= mq[5][2] * x[6]; b0 -= mq[5][2] * y[6]; a1 -= mq[5][3] * x[7]; b1 -= mq[5][3] * y[7]; mq[5] = *(const LAS f32x4*)(Mg + 2652);
            a0 -= mq[0][0] * x[8]; b0 -= mq[0][0] * y[8]; a1 -= mq[0][1] * x[9]; b1 -= mq[0][1] * y[9]; a0 -= mq[0][2] * x[10]; b0 -= mq[0][2] * y[10]; a1 -= mq[0][3] * x[11]; b1 -= mq[0][3] * y[11]; mq[0] = *(const LAS f32x4*)(Mg + 2656);
            a0 -= mq[1][0] * x[12]; b0 -= mq[1][0] * y[12]; a1 -= mq[1][1] * x[13]; b1 -= mq[1][1] * y[13]; a0 -= mq[1][2] * x[14]; b0 -= mq[1][2] * y[14]; a1 -= mq[1][3] * x[15]; b1 -= mq[1][3] * y[15]; mq[1] = *(const LAS f32x4*)(Mg + 2660);
            a0 -= mq[2][0] * x[16]; b0 -= mq[2][0] * y[16]; a1 -= mq[2][1] * x[17]; b1 -= mq[2][1] * y[17]; a0 -= mq[2][2] * x[18]; b0 -= mq[2][2] * y[18]; a1 -= mq[2][3] * x[19]; b1 -= mq[2][3] * y[19]; mq[2] = *(const LAS f32x4*)(Mg + 2664);
            a0 -= mq[3][0] * x[20]; b0 -= mq[3][0] * y[20]; a1 -= mq[3][1] * x[21]; b1 -= mq[3][1] * y[21]; a0 -= mq[3][2] * x[22]; b0 -= mq[3][2] * y[22]; a1 -= mq[3][3] * x[23]; b1 -= mq[3][3] * y[23]; mq[3] = *(const LAS f32x4*)(Mg + 2688);
            a0 -= mq[4][0] * x[24]; b0 -= mq[4][0] * y[24]; a1 -= mq[4][1] * x[25]; b1 -= mq[4][1] * y[25]; a0 -= mq[4][2] * x[26]; b0 -= mq[4][2] * y[26]; a1 -= mq[4][3] * x[27]; b1 -= mq[4][3] * y[27]; mq[4] = *(const LAS f32x4*)(Mg + 2692);
            a0 -= mq[5][0] * x[28]; b0 -= mq[5][0] * y[28]; a1 -= mq[5][1] * x[29]; b1 -= mq[5][1] * y[29]; a0 -= mq[5][2] * x[30]; b0 -= mq[5][2] * y[30]; a1 -= mq[5][3] * x[31]; b1 -= mq[5][3] * y[31]; mq[5] = *(const LAS f32x4*)(Mg + 2696);
            a0 -= mq[0][0] * x[32]; b0 -= mq[0][0] * y[32]; a1 -= mq[0][1] * x[33]; b1 -= mq[0][1] * y[33]; a0 -= mq[0][2] * x[34]; b0 -= mq[0][2] * y[34]; a1 -= mq[0][3] * x[35]; b1 -= mq[0][3] * y[35]; mq[0] = *(const LAS f32x4*)(Mg + 2700);
            a0 -= mq[1][0] * x[36]; b0 -= mq[1][0] * y[36]; a1 -= mq[1][1] * x[37]; b1 -= mq[1][1] * y[37]; a0 -= mq[1][2] * x[38]; b0 -= mq[1][2] * y[38]; a1 -= mq[1][3] * x[39]; b1 -= mq[1][3] * y[39]; mq[1] = *(const LAS f32x4*)(Mg + 2704);
            a0 -= mq[2][0] * x[40]; b0 -= mq[2][0] * y[40]; x[41] = a0 + a1; y[41] = b0 + b1; up[5248] = x[41]; wp[5248] = f2bf(-y[41]); mq[2] = *(const LAS f32x4*)(Mg + 2708);
            { const float br = betg[42]; a0 = bf2f(*(const LAS bf16_t*)(lg + P5_VS + 11424 + c * 2)) * br; b0 = bf2f(*(const LAS bf16_t*)(lg + P5_KS + 11424 + c * 2)) * br * __expf(decg[42]); a1 = 0.f; b1 = 0.f; } a0 -= mq[3][0] * x[0]; b0 -= mq[3][0] * y[0]; a1 -= mq[3][1] * x[1]; b1 -= mq[3][1] * y[1]; a0 -= mq[3][2] * x[2]; b0 -= mq[3][2] * y[2]; a1 -= mq[3][3] * x[3]; b1 -= mq[3][3] * y[3]; mq[3] = *(const LAS f32x4*)(Mg + 2712);
            a0 -= mq[4][0] * x[4]; b0 -= mq[4][0] * y[4]; a1 -= mq[4][1] * x[5]; b1 -= mq[4][1] * y[5]; a0 -= mq[4][2] * x[6]; b0 -= mq[4][2] * y[6]; a1 -= mq[4][3] * x[7]; b1 -= mq[4][3] * y[7]; mq[4] = *(const LAS f32x4*)(Mg + 2716);
            a0 -= mq[5][0] * x[8]; b0 -= mq[5][0] * y[8]; a1 -= mq[5][1] * x[9]; b1 -= mq[5][1] * y[9]; a0 -= mq[5][2] * x[10]; b0 -= mq[5][2] * y[10]; a1 -= mq[5][3] * x[11]; b1 -= mq[5][3] * y[11]; mq[5] = *(const LAS f32x4*)(Mg + 2720);
            a0 -= mq[0][0] * x[12]; b0 -= mq[0][0] * y[12]; a1 -= mq[0][1] * x[13]; b1 -= mq[0][1] * y[13]; a0 -= mq[0][2] * x[14]; b0 -= mq[0][2] * y[14]; a1 -= mq[0][3] * x[15]; b1 -= mq[0][3] * y[15]; mq[0] = *(const LAS f32x4*)(Mg + 2724);
            a0 -= mq[1][0] * x[16]; b0 -= mq[1][0] * y[16]; a1 -= mq[1][1] * x[17]; b1 -= mq[1][1] * y[17]; a0 -= mq[1][2] * x[18]; b0 -= mq[1][2] * y[18]; a1 -= mq[1][3] * x[19]; b1 -= mq[1][3] * y[19]; mq[1] = *(const LAS f32x4*)(Mg + 2728);
            a0 -= mq[2][0] * x[20]; b0 -= mq[2][0] * y[20]; a1 -= mq[2][1] * x[21]; b1 -= mq[2][1] * y[21]; a0 -= mq[2][2] * x[22]; b0 -= mq[2][2] * y[22]; a1 -= mq[2][3] * x[23]; b1 -= mq[2][3] * y[23]; mq[2] = *(const LAS f32x4*)(Mg + 2752);
            a0 -= mq[3][0] * x[24]; b0 -= mq[3][0] * y[24]; a1 -= mq[3][1] * x[25]; b1 -= mq[3][1] * y[25]; a0 -= mq[3][2] * x[26]; b0 -= mq[3][2] * y[26]; a1 -= mq[3][3] * x[27]; b1 -= mq[3][3] * y[27]; mq[3] = *(const LAS f32x4*)(Mg + 2756);
            a0 -= mq[4][0] * x[28]; b0 -= mq[4][0] * y[28]; a1 -= mq[4][1] * x[29]; b1 -= mq[4][1] * y[29]; a0 -= mq[4][2] * x[30]; b0 -= mq[4][2] * y[30]; a1 -= mq[4][3] * x[31]; b1 -= mq[4][3] * y[31]; mq[4] = *(const LAS f32x4*)(Mg + 2760);
            a0 -= mq[5][0] * x[32]; b0 -= mq[5][0] * y[32]; a1 -= mq[5][1] * x[33]; b1 -= mq[5][1] * y[33]; a0 -= mq[5][2] * x[34]; b0 -= mq[5][2] * y[34]; a1 -= mq[5][3] * x[35]; b1 -= mq[5][3] * y[35]; mq[5] = *(const LAS f32x4*)(Mg + 2764);
            a0 -= mq[0][0] * x[36]; b0 -= mq[0][0] * y[36]; a1 -= mq[0][1] * x[37]; b1 -= mq[0][1] * y[37]; a0 -= mq[0][2] * x[38]; b0 -= mq[0][2] * y[38]; a1 -= mq[0][3] * x[39]; b1 -= mq[0][3] * y[39]; mq[0] = *(const LAS f32x4*)(Mg + 2768);
            a0 -= mq[1][0] * x[40]; b0 -= mq[1][0] * y[40]; a1 -= mq[1][1] * x[41]; b1 -= mq[1][1] * y[41]; x[42] = a0 + a1; y[42] = b0 + b1; up[5376] = x[42]; wp[5376] = f2bf(-y[42]); mq[1] = *(const LAS f32x4*)(Mg + 2772);
            { const float br = betg[43]; a0 = bf2f(*(const LAS bf16_t*)(lg + P5_VS + 11696 + c * 2)) * br; b0 = bf2f(*(const LAS bf16_t*)(lg + P5_KS + 11696 + c * 2)) * br * __expf(decg[43]); a1 = 0.f; b1 = 0.f; } a0 -= mq[2][0] * x[0]; b0 -= mq[2][0] * y[0]; a1 -= mq[2][1] * x[1]; b1 -= mq[2][1] * y[1]; a0 -= mq[2][2] * x[2]; b0 -= mq[2][2] * y[2]; a1 -= mq[2][3] * x[3]; b1 -= mq[2][3] * y[3]; mq[2] = *(const LAS f32x4*)(Mg + 2776);
            a0 -= mq[3][0] * x[4]; b0 -= mq[3][0] * y[4]; a1 -= mq[3][1] * x[5]; b1 -= mq[3][1] * y[5]; a0 -= mq[3][2] * x[6]; b0 -= mq[3][2] * y[6]; a1 -= mq[3][3] * x[7]; b1 -= mq[3][3] * y[7]; mq[3] = *(const LAS f32x4*)(Mg + 2780);
            a0 -= mq[4][0] * x[8]; b0 -= mq[4][0] * y[8]; a1 -= mq[4][1] * x[9]; b1 -= mq[4][1] * y[9]; a0 -= mq[4][2] * x[10]; b0 -= mq[4][2] * y[10]; a1 -= mq[4][3] * x[11]; b1 -= mq[4][3] * y[11]; mq[4] = *(const LAS f32x4*)(Mg + 2784);
            a0 -= mq[5][0] * x[12]; b0 -= mq[5][0] * y[12]; a1 -= mq[5][1] * x[13]; b1 -= mq[5][1] * y[13]; a0 -= mq[5][2] * x[14]; b0 -= mq[5][2] * y[14]; a1 -= mq[5][3] * x[15]; b1 -= mq[5][3] * y[15]; mq[5] = *(const LAS f32x4*)(Mg + 2788);
            a0 -= mq[0][0] * x[16]; b0 -= mq[0][0] * y[16]; a1 -= mq[0][1] * x[17]; b1 -= mq[0][1] * y[17]; a0 -= mq[0][2] * x[18]; b0 -= mq[0][2] * y[18]; a1 -= mq[0][3] * x[19]; b1 -= mq[0][3] * y[19]; mq[0] = *(const LAS f32x4*)(Mg + 2792);
            a0 -= mq[1][0] * x[20]; b0 -= mq[1][0] * y[20]; a1 -= mq[1][1] * x[21]; b1 -= mq[1][1] * y[21]; a0 -= mq[1][2] * x[22]; b0 -= mq[1][2] * y[22]; a1 -= mq[1][3] * x[23]; b1 -= mq[1][3] * y[23]; mq[1] = *(const LAS f32x4*)(Mg + 2816);
            a0 -= mq[2][0] * x[24]; b0 -= mq[2][0] * y[24]; a1 -= mq[2][1] * x[25]; b1 -= mq[2][1] * y[25]; a0 -= mq[2][2] * x[26]; b0 -= mq[2][2] * y[26]; a1 -= mq[2][3] * x[27]; b1 -= mq[2][3] * y[27]; mq[2] = *(const LAS f32x4*)(Mg + 2820);
            a0 -= mq[3][0] * x[28]; b0 -= mq[3][0] * y[28]; a1 -= mq[3][1] * x[29]; b1 -= mq[3][1] * y[29]; a0 -= mq[3][2] * x[30]; b0 -= mq[3][2] * y[30]; a1 -= mq[3][3] * x[31]; b1 -= mq[3][3] * y[31]; mq[3] = *(const LAS f32x4*)(Mg + 2824);
            a0 -= mq[4][0] * x[32]; b0 -= mq[4][0] * y[32]; a1 -= mq[4][1] * x[33]; b1 -= mq[4][1] * y[33]; a0 -= mq[4][2] * x[34]; b0 -= mq[4][2] * y[34]; a1 -= mq[4][3] * x[35]; b1 -= mq[4][3] * y[35]; mq[4] = *(const LAS f32x4*)(Mg + 2828);
            a0 -= mq[5][0] * x[36]; b0 -= mq[5][0] * y[36]; a1 -= mq[5][1] * x[37]; b1 -= mq[5][1] * y[37]; a0 -= mq[5][2] * x[38]; b0 -= mq[5][2] * y[38]; a1 -= mq[5][3] * x[39]; b1 -= mq[5][3] * y[39]; mq[5] = *(const LAS f32x4*)(Mg + 2832);
            a0 -= mq[0][0] * x[40]; b0 -= mq[0][0] * y[40]; a1 -= mq[0][1] * x[41]; b1 -= mq[0][1] * y[41]; a0 -= mq[0][2] * x[42]; b0 -= mq[0][2] * y[42]; x[43] = a0 + a1; y[43] = b0 + b1; up[5504] = x[43]; wp[5504] = f2bf(-y[43]); mq[0] = *(const LAS f32x4*)(Mg + 2836);
            { const float br = betg[44]; a0 = bf2f(*(const LAS bf16_t*)(lg + P5_VS + 11968 + c * 2)) * br; b0 = bf2f(*(const LAS bf16_t*)(lg + P5_KS + 11968 + c * 2)) * br * __expf(decg[44]); a1 = 0.f; b1 = 0.f; } a0 -= mq[1][0] * x[0]; b0 -= mq[1][0] * y[0]; a1 -= mq[1][1] * x[1]; b1 -= mq[1][1] * y[1]; a0 -= mq[1][2] * x[2]; b0 -= mq[1][2] * y[2]; a1 -= mq[1][3] * x[3]; b1 -= mq[1][3] * y[3]; mq[1] = *(const LAS f32x4*)(Mg + 2840);
            a0 -= mq[2][0] * x[4]; b0 -= mq[2][0] * y[4]; a1 -= mq[2][1] * x[5]; b1 -= mq[2][1] * y[5]; a0 -= mq[2][2] * x[6]; b0 -= mq[2][2] * y[6]; a1 -= mq[2][3] * x[7]; b1 -= mq[2][3] * y[7]; mq[2] = *(const LAS f32x4*)(Mg + 2844);
            a0 -= mq[3][0] * x[8]; b0 -= mq[3][0] * y[8]; a1 -= mq[3][1] * x[9]; b1 -= mq[3][1] * y[9]; a0 -= mq[3][2] * x[10]; b0 -= mq[3][2] * y[10]; a1 -= mq[3][3] * x[11]; b1 -= mq[3][3] * y[11]; mq[3] = *(const LAS f32x4*)(Mg + 2848);
            a0 -= mq[4][0] * x[12]; b0 -= mq[4][0] * y[12]; a1 -= mq[4][1] * x[13]; b1 -= mq[4][1] * y[13]; a0 -= mq[4][2] * x[14]; b0 -= mq[4][2] * y[14]; a1 -= mq[4][3] * x[15]; b1 -= mq[4][3] * y[15]; mq[4] = *(const LAS f32x4*)(Mg + 2852);
            a0 -= mq[5][0] * x[16]; b0 -= mq[5][0] * y[16]; a1 -= mq[5][1] * x[17]; b1 -= mq[5][1] * y[17]; a0 -= mq[5][2] * x[18]; b0 -= mq[5][2] * y[18]; a1 -= mq[5][3] * x[19]; b1 -= mq[5][3] * y[19]; mq[5] = *(const LAS f32x4*)(Mg + 2856);
            a0 -= mq[0][0] * x[20]; b0 -= mq[0][0] * y[20]; a1 -= mq[0][1] * x[21]; b1 -= mq[0][1] * y[21]; a0 -= mq[0][2] * x[22]; b0 -= mq[0][2] * y[22]; a1 -= mq[0][3] * x[23]; b1 -= mq[0][3] * y[23]; mq[0] = *(const LAS f32x4*)(Mg + 2880);
            a0 -= mq[1][0] * x[24]; b0 -= mq[1][0] * y[24]; a1 -= mq[1][1] * x[25]; b1 -= mq[1][1] * y[25]; a0 -= mq[1][2] * x[26]; b0 -= mq[1][2] * y[26]; a1 -= mq[1][3] * x[27]; b1 -= mq[1][3] * y[27]; mq[1] = *(const LAS f32x4*)(Mg + 2884);
            a0 -= mq[2][0] * x[28]; b0 -= mq[2][0] * y[28]; a1 -= mq[2][1] * x[29]; b1 -= mq[2][1] * y[29]; a0 -= mq[2][2] * x[30]; b0 -= mq[2][2] * y[30]; a1 -= mq[2][3] * x[31]; b1 -= mq[2][3] * y[31]; mq[2] = *(const LAS f32x4*)(Mg + 2888);
            a0 -= mq[3][0] * x[32]; b0 -= mq[3][0] * y[32]; a1 -= mq[3][1] * x[33]; b1 -= mq[3][1] * y[33]; a0 -= mq[3][2] * x[34]; b0 -= mq[3][2] * y[34]; a1 -= mq[3][3] * x[35]; b1 -= mq[3][3] * y[35]; mq[3] = *(const LAS f32x4*)(Mg + 2892);
            a0 -= mq[4][0] * x[36]; b0 -= mq[4][0] * y[36]; a1 -= mq[4][1] * x[37]; b1 -= mq[4][1] * y[37]; a0 -= mq[4][2] * x[38]; b0 -= mq[4][2] * y[38]; a1 -= mq[4][3] * x[39]; b1 -= mq[4][3] * y[39]; mq[4] = *(const LAS f32x4*)(Mg + 2896);
            a0 -= mq[5][0] * x[40]; b0 -= mq[5][0] * y[40]; a1 -= mq[5][1] * x[41]; b1 -= mq[5][1] * y[41]; a0 -= mq[5][2] * x[42]; b0 -= mq[5][2] * y[42]; a1 -= mq[5][3] * x[43]; b1 -= mq[5][3] * y[43]; x[44] = a0 + a1; y[44] = b0 + b1; up[5632] = x[44]; wp[5632] = f2bf(-y[44]); mq[5] = *(const LAS f32x4*)(Mg + 2900);
            { const float br = betg[45]; a0 = bf2f(*(const LAS bf16_t*)(lg + P5_VS + 12240 + c * 2)) * br; b0 = bf2f(*(const LAS bf16_t*)(lg + P5_KS + 12240 + c * 2)) * br * __expf(decg[45]); a1 = 0.f; b1 = 0.f; } a0 -= mq[0][0] * x[0]; b0 -= mq[0][0] * y[0]; a1 -= mq[0][1] * x[1]; b1 -= mq[0][1] * y[1]; a0 -= mq[0][2] * x[2]; b0 -= mq[0][2] * y[2]; a1 -= mq[0][3] * x[3]; b1 -= mq[0][3] * y[3]; mq[0] = *(const LAS f32x4*)(Mg + 2904);
            a0 -= mq[1][0] * x[4]; b0 -= mq[1][0] * y[4]; a1 -= mq[1][1] * x[5]; b1 -= mq[1][1] * y[5]; a0 -= mq[1][2] * x[6]; b0 -= mq[1][2] * y[6]; a1 -= mq[1][3] * x[7]; b1 -= mq[1][3] * y[7]; mq[1] = *(const LAS f32x4*)(Mg + 2908);
            a0 -= mq[2][0] * x[8]; b0 -= mq[2][0] * y[8]; a1 -= mq[2][1] * x[9]; b1 -= mq[2][1] * y[9]; a0 -= mq[2][2] * x[10]; b0 -= mq[2][2] * y[10]; a1 -= mq[2][3] * x[11]; b1 -= mq[2][3] * y[11]; mq[2] = *(const LAS f32x4*)(Mg + 2912);
            a0 -= mq[3][0] * x[12]; b0 -= mq[3][0] * y[12]; a1 -= mq[3][1] * x[13]; b1 -= mq[3][1] * y[13]; a0 -= mq[3][2] * x[14]; b0 -= mq[3][2] * y[14]; a1 -= mq[3][3] * x[15]; b1 -= mq[3][3] * y[15]; mq[3] = *(const LAS f32x4*)(Mg + 2916);
            a0 -= mq[4][0] * x[16]; b0 -= mq[4][0] * y[16]; a1 -= mq[4][1] * x[17]; b1 -= mq[4][1] * y[17]; a0 -= mq[4][2] * x[18]; b0 -= mq[4][2] * y[18]; a1 -= mq[4][3] * x[19]; b1 -= mq[4][3] * y[19]; mq[4] = *(const LAS f32x4*)(Mg + 2920);
            a0 -= mq[5][0] * x[20]; b0 -= mq[5][0] * y[20]; a1 -= mq[5][1] * x[21]; b1 -= mq[5][1] * y[21]; a0 -= mq[5][2] * x[22]; b0 -= mq[5][2] * y[22]; a1 -= mq[5][3] * x[23]; b1 -= mq[5][3] * y[23]; mq[5] = *(const LAS f32x4*)(Mg + 2924);
            a0 -= mq[0][0] * x[24]; b0 -= mq[0][0] * y[24]; a1 -= mq[0][1] * x[25]; b1 -= mq[0][1] * y[25]; a0 -= mq[0][2] * x[26]; b0 -= mq[0][2] * y[26]; a1 -= mq[0][3] * x[27]; b1 -= mq[0][3] * y[27]; mq[0] = *(const LAS f32x4*)(Mg + 2944);
            a0 -= mq[1][0] * x[28]; b0 -= mq[1][0] * y[28]; a1 -= mq[1][1] * x[29]; b1 -= mq[1][1] * y[29]; a0 -= mq[1][2] * x[30]; b0 -= mq[1][2] * y[30]; a1 -= mq[1][3] * x[31]; b1 -= mq[1][3] * y[31]; mq[1] = *(const LAS f32x4*)(Mg + 2948);
            a0 -= mq[2][0] * x[32]; b0 -= mq[2][0] * y[32]; a1 -= mq[2][1] * x[33]; b1 -= mq[2][1] * y[33]; a0 -= mq[2][2] * x[34]; b0 -= mq[2][2] * y[34]; a1 -= mq[2][3] * x[35]; b1 -= mq[2][3] * y[35]; mq[2] = *(const LAS f32x4*)(Mg + 2952);
            a0 -= mq[3][0] * x[36]; b0 -= mq[3][0] * y[36]; a1 -= mq[3][1] * x[37]; b1 -= mq[3][1] * y[37]; a0 -= mq[3][2] * x[38]; b0 -= mq[3][2] * y[38]; a1 -= mq[3][3] * x[39]; b1 -= mq[3][3] * y[39]; mq[3] = *(const LAS f32x4*)(Mg + 2956);
            a0 -= mq[4][0] * x[40]; b0 -= mq[4][0] * y[40]; a1 -= mq[4][1] * x[41]; b1 -= mq[4][1] * y[41]; a0 -= mq[4][2] * x[42]; b0 -= mq[4][2] * y[42]; a1 -= mq[4][3] * x[43]; b1 -= mq[4][3] * y[43]; mq[4] = *(const LAS f32x4*)(Mg + 2960);
            a0 -= mq[5][0] * x[44]; b0 -= mq[5][0] * y[44]; x[45] = a0 + a1; y[45] = b0 + b1; up[5760] = x[45]; wp[5760] = f2bf(-y[45]); mq[5] = *(const LAS f32x4*)(Mg + 2964);
            { const float br = betg[46]; a0 = bf2f(*(const LAS bf16_t*)(lg + P5_VS + 12512 + c * 2)) * br; b0 = bf2f(*(const LAS bf16_t*)(lg + P5_KS + 12512 + c * 2)) * br * __expf(decg[46]); a1 = 0.f; b1 = 0.f; } a0 -= mq[0][0] * x[0]; b0 -= mq[0][0] * y[0]; a1 -= mq[0][1] * x[1]; b1 -= mq[0][1] * y[1]; a0 -= mq[0][2] * x[2]; b0 -= mq[0][2] * y[2]; a1 -= mq[0][3] * x[3]; b1 -= mq[0][3] * y[3]; mq[0] = *(const LAS f32x4*)(Mg + 2968);
            a0 -= mq[1][0] * x[4]; b0 -= mq[1][0] * y[4]; a1 -= mq[1][1] * x[5]; b1 -= mq[1][1] * y[5]; a0 -= mq[1][2] * x[6]; b0 -= mq[1][2] * y[6]; a1 -= mq[1][3] * x[7]; b1 -= mq[1][3] * y[7]; mq[1] = *(const LAS f32x4*)(Mg + 2972);
            a0 -= mq[2][0] * x[8]; b0 -= mq[2][0] * y[8]; a1 -= mq[2][1] * x[9]; b1 -= mq[2][1] * y[9]; a0 -= mq[2][2] * x[10]; b0 -= mq[2][2] * y[10]; a1 -= mq[2][3] * x[11]; b1 -= mq[2][3] * y[11]; mq[2] = *(const LAS f32x4*)(Mg + 2976);
            a0 -= mq[3][0] * x[12]; b0 -= mq[3][0] * y[12]; a1 -= mq[3][1] * x[13]; b1 -= mq[3][1] * y[13]; a0 -= mq[3][2] * x[14]; b0 -= mq[3][2] * y[14]; a1 -= mq[3][3] * x[15]; b1 -= mq[3][3] * y[15]; mq[3] = *(const LAS f32x4*)(Mg + 2980);
            a0 -= mq[4][0] * x[16]; b0 -= mq[4][0] * y[16]; a1 -= mq[4][1] * x[17]; b1 -= mq[4][1] * y[17]; a0 -= mq[4][2] * x[18]; b0 -= mq[4][2] * y[18]; a1 -= mq[4][3] * x[19]; b1 -= mq[4][3] * y[19]; mq[4] = *(const LAS f32x4*)(Mg + 2984);
            a0 -= mq[5][0] * x[20]; b0 -= mq[5][0] * y[20]; a1 -= mq[5][1] * x[21]; b1 -= mq[5][1] * y[21]; a0 -= mq[5][2] * x[22]; b0 -= mq[5][2] * y[22]; a1 -= mq[5][3] * x[23]; b1 -= mq[5][3] * y[23]; mq[5] = *(const LAS f32x4*)(Mg + 2988);
            a0 -= mq[0][0] * x[24]; b0 -= mq[0][0] * y[24]; a1 -= mq[0][1] * x[25]; b1 -= mq[0][1] * y[25]; a0 -= mq[0][2] * x[26]; b0 -= mq[0][2] * y[26]; a1 -= mq[0][3] * x[27]; b1 -= mq[0][3] * y[27]; mq[0] = *(const LAS f32x4*)(Mg + 3008);
            a0 -= mq[1][0] * x[28]; b0 -= mq[1][0] * y[28]; a1 -= mq[1][1] * x[29]; b1 -= mq[1][1] * y[29]; a0 -= mq[1][2] * x[30]; b0 -= mq[1][2] * y[30]; a1 -= mq[1][3] * x[31]; b1 -= mq[1][3] * y[31]; mq[1] = *(const LAS f32x4*)(Mg + 3012);
            a0 -= mq[2][0] * x[32]; b0 -= mq[2][0] * y[32]; a1 -= mq[2][1] * x[33]; b1 -= mq[2][1] * y[33]; a0 -= mq[2][2] * x[34]; b0 -= mq[2][2] * y[34]; a1 -= mq[2][3] * x[35]; b1 -= mq[2][3] * y[35]; mq[2] = *(const LAS f32x4*)(Mg + 3016);
            a0 -= mq[3][0] * x[36]; b0 -= mq[3][0] * y[36]; a1 -= mq[3][1] * x[37]; b1 -= mq[3][1] * y[37]; a0 -= mq[3][2] * x[38]; b0 -= mq[3][2] * y[38]; a1 -= mq[3][3] * x[39]; b1 -= mq[3][3] * y[39]; mq[3] = *(const LAS f32x4*)(Mg + 3020);
            a0 -= mq[4][0] * x[40]; b0 -= mq[4][0] * y[40]; a1 -= mq[4][1] * x[41]; b1 -= mq[4][1] * y[41]; a0 -= mq[4][2] * x[42]; b0 -= mq[4][2] * y[42]; a1 -= mq[4][3] * x[43]; b1 -= mq[4][3] * y[43]; mq[4] = *(const LAS f32x4*)(Mg + 3024);
            a0 -= mq[5][0] * x[44]; b0 -= mq[5][0] * y[44]; a1 -= mq[5][1] * x[45]; b1 -= mq[5][1] * y[45]; x[46] = a0 + a1; y[46] = b0 + b1; up[5888] = x[46]; wp[5888] = f2bf(-y[46]); mq[5] = *(const LAS f32x4*)(Mg + 3028);
            { const float br = betg[47]; a0 = bf2f(*(const LAS bf16_t*)(lg + P5_VS + 12784 + c * 2)) * br; b0 = bf2f(*(const LAS bf16_t*)(lg + P5_KS + 12784 + c * 2)) * br * __expf(decg[47]); a1 = 0.f; b1 = 0.f; } a0 -= mq[0][0] * x[0]; b0 -= mq[0][0] * y[0]; a1 -= mq[0][1] * x[1]; b1 -= mq[0][1] * y[1]; a0 -= mq[0][2] * x[2]; b0 -= mq[0][2] * y[2]; a1 -= mq[0][3] * x[3]; b1 -= mq[0][3] * y[3]; mq[0] = *(const LAS f32x4*)(Mg + 3032);
            a0 -= mq[1][0] * x[4]; b0 -= mq[1][0] * y[4]; a1 -= mq[1][1] * x[5]; b1 -= mq[1][1] * y[5]; a0 -= mq[1][2] * x[6]; b0 -= mq[1][2] * y[6]; a1 -= mq[1][3] * x[7]; b1 -= mq[1][3] * y[7]; mq[1] = *(const LAS f32x4*)(Mg + 3036);
            a0 -= mq[2][0] * x[8]; b0 -= mq[2][0] * y[8]; a1 -= mq[2][1] * x[9]; b1 -= mq[2][1] * y[9]; a0 -= mq[2][2] * x[10]; b0 -= mq[2][2] * y[10]; a1 -= mq[2][3] * x[11]; b1 -= mq[2][3] * y[11]; mq[2] = *(const LAS f32x4*)(Mg + 3040);
            a0 -= mq[3][0] * x[12]; b0 -= mq[3][0] * y[12]; a1 -= mq[3][1] * x[13]; b1 -= mq[3][1] * y[13]; a0 -= mq[3][2] * x[14]; b0 -= mq[3][2] * y[14]; a1 -= mq[3][3] * x[15]; b1 -= mq[3][3] * y[15]; mq[3] = *(const LAS f32x4*)(Mg + 3044);
            a0 -= mq[4][0] * x[16]; b0 -= mq[4][0] * y[16]; a1 -= mq[4][1] * x[17]; b1 -= mq[4][1] * y[17]; a0 -= mq[4][2] * x[18]; b0 -= mq[4][2] * y[18]; a1 -= mq[4][3] * x[19]; b1 -= mq[4][3] * y[19]; mq[4] = *(const LAS f32x4*)(Mg + 3048);
            a0 -= mq[5][0] * x[20]; b0 -= mq[5][0] * y[20]; a1 -= mq[5][1] * x[21]; b1 -= mq[5][1] * y[21]; a0 -= mq[5][2] * x[22]; b0 -= mq[5][2] * y[22]; a1 -= mq[5][3] * x[23]; b1 -= mq[5][3] * y[23]; mq[5] = *(const LAS f32x4*)(Mg + 3052);
            a0 -= mq[0][0] * x[24]; b0 -= mq[0][0] * y[24]; a1 -= mq[0][1] * x[25]; b1 -= mq[0][1] * y[25]; a0 -= mq[0][2] * x[26]; b0 -= mq[0][2] * y[26]; a1 -= mq[0][3] * x[27]; b1 -= mq[0][3] * y[27]; mq[0] = *(const LAS f32x4*)(Mg + 3072);
            a0 -= mq[1][0] * x[28]; b0 -= mq[1][0] * y[28]; a1 -= mq[1][1] * x[29]; b1 -= mq[1][1] * y[29]; a0 -= mq[1][2] * x[30]; b0 -= mq[1][2] * y[30]; a1 -= mq[1][3] * x[31]; b1 -= mq[1][3] * y[31]; mq[1] = *(const LAS f32x4*)(Mg + 3076);
            a0 -= mq[2][0] * x[32]; b0 -= mq[2][0] * y[32]; a1 -= mq[2][1] * x[33]; b1 -= mq[2][1] * y[33]; a0 -= mq[2][2] * x[34]; b0 -= mq[2][2] * y[34]; a1 -= mq[2][3] * x[35]; b1 -= mq[2][3] * y[35]; mq[2] = *(const LAS f32x4*)(Mg + 3080);
            a0 -= mq[3][0] * x[36]; b0 -= mq[3][0] * y[36]; a1 -= mq[3][1] * x[37]; b1 -= mq[3][1] * y[37]; a0 -= mq[3][2] * x[38]; b0 -= mq[3][2] * y[38]; a1 -= mq[3][3] * x[39]; b1 -= mq[3][3] * y[39]; mq[3] = *(const LAS f32x4*)(Mg + 3084);
            a0 -= mq[4][0] * x[40]; b0 -= mq[4][0] * y[40]; a1 -= mq[4][1] * x[41]; b1 -= mq[4][1] * y[41]; a0 -= mq[4][2] * x[42]; b0 -= mq[4][2] * y[42]; a1 -= mq[4][3] * x[43]; b1 -= mq[4][3] * y[43]; mq[4] = *(const LAS f32x4*)(Mg + 3088);
            a0 -= mq[5][0] * x[44]; b0 -= mq[5][0] * y[44]; a1 -= mq[5][1] * x[45]; b1 -= mq[5][1] * y[45]; a0 -= mq[5][2] * x[46]; b0 -= mq[5][2] * y[46]; x[47] = a0 + a1; y[47] = b0 + b1; up[6016] = x[47]; wp[6016] = f2bf(-y[47]); mq[5] = *(const LAS f32x4*)(Mg + 3092);
            { const float br = betg[48]; a0 = bf2f(*(const LAS bf16_t*)(lg + P5_VS + 13056 + c * 2)) * br; b0 = bf2f(*(const LAS bf16_t*)(lg + P5_KS + 13056 + c * 2)) * br * __expf(decg[48]); a1 = 0.f; b1 = 0.f; } a0 -= mq[0][0] * x[0]; b0 -= mq[0][0] * y[0]; a1 -= mq[0][1] * x[1]; b1 -= mq[0][1] * y[1]; a0 -= mq[0][2] * x[2]; b0 -= mq[0][2] * y[2]; a1 -= mq[0][3] * x[3]; b1 -= mq[0][3] * y[3]; mq[0] = *(const LAS f32x4*)(Mg + 3096);
            a0 -= mq[1][0] * x[4]; b0 -= mq[1][0] * y[4]; a1 -= mq[1][1] * x[5]; b1 -= mq[1][1] * y[5]; a0 -= mq[1][2] * x[6]; b0 -= mq[1][2] * y[6]; a1 -= mq[1][3] * x[7]; b1 -= mq[1][3] * y[7]; mq[1] = *(const LAS f32x4*)(Mg + 3100);
            a0 -= mq[2][0] * x[8]; b0 -= mq[2][0] * y[8]; a1 -= mq[2][1] * x[9]; b1 -= mq[2][1] * y[9]; a0 -= mq[2][2] * x[10]; b0 -= mq[2][2] * y[10]; a1 -= mq[2][3] * x[11]; b1 -= mq[2][3] * y[11]; mq[2] = *(const LAS f32x4*)(Mg + 3104);
            a0 -= mq[3][0] * x[12]; b0 -= mq[3][0] * y[12]; a1 -= mq[3][1] * x[13]; b1 -= mq[3][1] * y[13]; a0 -= mq[3][2] * x[14]; b0 -= mq[3][2] * y[14]; a1 -= mq[3][3] * x[15]; b1 -= mq[3][3] * y[15]; mq[3] = *(const LAS f32x4*)(Mg + 3108);
            a0 -= mq[4][0] * x[16]; b0 -= mq[4][0] * y[16]; a1 -= mq[4][1] * x[17]; b1 -= mq[4][1] * y[17]; a0 -= mq[4][2] * x[18]; b0 -= mq[4][2] * y[18]; a1 -= mq[4][3] * x[19]; b1 -= mq[4][3] * y[19]; mq[4] = *(const LAS f32x4*)(Mg + 3112);
            a0 -= mq[5][0] * x[20]; b0 -= mq[5][0] * y[20]; a1 -= mq[5][1] * x[21]; b1 -= mq[5][1] * y[21]; a0 -= mq[5][2] * x[22]; b0 -= mq[5][2] * y[22]; a1 -= mq[5][3] * x[23]; b1 -= mq[5][3] * y[23]; mq[5] = *(const LAS f32x4*)(Mg + 3116);
            a0 -= mq[0][0] * x[24]; b0 -= mq[0][0] * y[24]; a1 -= mq[0][1] * x[25]; b1 -= mq[0][1] * y[25]; a0 -= mq[0][2] * x[26]; b0 -= mq[0][2] * y[26]; a1 -= mq[0][3] * x[27]; b1 -= mq[0][3] * y[27]; mq[0] = *(const LAS f32x4*)(Mg + 3136);
            a0 -= mq[1][0] * x[28]; b0 -= mq[1][0] * y[28]; a1 -= mq[1][1] * x[29]; b1 -= mq[1][1] * y[29]; a0 -= mq[1][2] * x[30]; b0 -= mq[1][2] * y[30]; a1 -= mq[1][3] * x[31]; b1 -= mq[1][3] * y[31]; mq[1] = *(const LAS f32x4*)(Mg + 3140);
            a0 -= mq[2][0] * x[32]; b0 -= mq[2][0] * y[32]; a1 -= mq[2][1] * x[33]; b1 -= mq[2][1] * y[33]; a0 -= mq[2][2] * x[34]; b0 -= mq[2][2] * y[34]; a1 -= mq[2][3] * x[35]; b1 -= mq[2][3] * y[35]; mq[2] = *(const LAS f32x4*)(Mg + 3144);
            a0 -= mq[3][0] * x[36]; b0 -= mq[3][0] * y[36]; a1 -= mq[3][1] * x[37]; b1 -= mq[3][1] * y[37]; a0 -= mq[3][2] * x[38]; b0 -= mq[3][2] * y[38]; a1 -= mq[3][3] * x[39]; b1 -= mq[3][3] * y[39]; mq[3] = *(const LAS f32x4*)(Mg + 3148);
            a0 -= mq[4][0] * x[40]; b0 -= mq[4][0] * y[40]; a1 -= mq[4][1] * x[41]; b1 -= mq[4][1] * y[41]; a0 -= mq[4][2] * x[42]; b0 -= mq[4][2] * y[42]; a1 -= mq[4][3] * x[43]; b1 -= mq[4][3] * y[43]; mq[4] = *(const LAS f32x4*)(Mg + 3152);
            a0 -= mq[5][0] * x[44]; b0 -= mq[5][0] * y[44]; a1 -= mq[5][1] * x[45]; b1 -= mq[5][1] * y[45]; a0 -= mq[5][2] * x[46]; b0 -= mq[5][2] * y[46]; a1 -= mq[5][3] * x[47]; b1 -= mq[5][3] * y[47]; x[48] = a0 + a1; y[48] = b0 + b1; up[6144] = x[48]; wp[6144] = f2bf(-y[48]); mq[5] = *(const LAS f32x4*)(Mg + 3156);
            { const float br = betg[49]; a0 = bf2f(*(const LAS bf16_t*)(lg + P5_VS + 13328 + c * 2)) * br; b0 = bf2f(*(const LAS bf16_t*)(lg + P5_KS + 13328 + c * 2)) * br * __expf(decg[49]); a1 = 0.f; b1 = 0.f; } a0 -= mq[0][0] * x[0]; b0 -= mq[0][0] * y[0]; a1 -= mq[0][1] * x[1]; b1 -= mq[0][1] * y[1]; a0 -= mq[0][2] * x[2]; b0 -= mq[0][2] * y[2]; a1 -= mq[0][3] * x[3]; b1 -= mq[0][3] * y[3]; mq[0] = *(const LAS f32x4*)(Mg + 3160);
            a0 -= mq[1][0] * x[4]; b0 -= mq[1][0] * y[4]; a1 -= mq[1][1] * x[5]; b1 -= mq[1][1] * y[5]; a0 -= mq[1][2] * x[6]; b0 -= mq[1][2] * y[6]; a1 -= mq[1][3] * x[7]; b1 -= mq[1][3] * y[7]; mq[1] = *(const LAS f32x4*)(Mg + 3164);
            a0 -= mq[2][0] * x[8]; b0 -= mq[2][0] * y[8]; a1 -= mq[2][1] * x[9]; b1 -= mq[2][1] * y[9]; a0 -= mq[2][2] * x[10]; b0 -= mq[2][2] * y[10]; a1 -= mq[2][3] * x[11]; b1 -= mq[2][3] * y[11]; mq[2] = *(const LAS f32x4*)(Mg + 3168);
            a0 -= mq[3][0] * x[12]; b0 -= mq[3][0] * y[12]; a1 -= mq[3][1] * x[13]; b1 -= mq[3][1] * y[13]; a0 -= mq[3][2] * x[14]; b0 -= mq[3][2] * y[14]; a1 -= mq[3][3] * x[15]; b1 -= mq[3][3] * y[15]; mq[3] = *(const LAS f32x4*)(Mg + 3172);
            a0 -= mq[4][0] * x[16]; b0 -= mq[4][0] * y[16]; a1 -= mq[4][1] * x[17]; b1 -= mq[4][1] * y[17]; a0 -= mq[4][2] * x[18]; b0 -= mq[4][2] * y[18]; a1 -= mq[4][3] * x[19]; b1 -= mq[4][3] * y[19]; mq[4] = *(const LAS f32x4*)(Mg + 3176);
            a0 -= mq[5][0] * x[20]; b0 -= mq[5][0] * y[20]; a1 -= mq[5][1] * x[21]; b1 -= mq[5][1] * y[21]; a0 -= mq[5][2] * x[22]; b0 -= mq[5][2] * y[22]; a1 -= mq[5][3] * x[23]; b1 -= mq[5][3] * y[23]; mq[5] = *(const LAS f32x4*)(Mg + 3180);
            a0 -= mq[0][0] * x[24]; b0 -= mq[0][0] * y[24]; a1 -= mq[0][1] * x[25]; b1 -= mq[0][1] * y[25]; a0 -= mq[0][2] * x[26]; b0 -= mq[0][2] * y[26]; a1 -= mq[0][3] * x[27]; b1 -= mq[0][3] * y[27]; mq[0] = *(const LAS f32x4*)(Mg + 3184);
            a0 -= mq[1][0] * x[28]; b0 -= mq[1][0] * y[28]; a1 -= mq[1][1] * x[29]; b1 -= mq[1][1] * y[29]; a0 -= mq[1][2] * x[30]; b0 -= mq[1][2] * y[30]; a1 -= mq[1][3] * x[31]; b1 -= mq[1][3] * y[31]; mq[1] = *(const LAS f32x4*)(Mg + 3200);
            a0 -= mq[2][0] * x[32]; b0 -= mq[2][0] * y[32]; a1 -= mq[2][1] * x[33]; b1 -= mq[2][1] * y[33]; a0 -= mq[2][2] * x[34]; b0 -= mq[2][2] * y[34]; a1 -= mq[2][3] * x[35]; b1 -= mq[2][3] * y[35]; mq[2] = *(const LAS f32x4*)(Mg + 3204);
            a0 -= mq[3][0] * x[36]; b0 -= mq[3][0] * y[36]; a1 -= mq[3][1] * x[37]; b1 -= mq[3][1] * y[37]; a0 -= mq[3][2] * x[38]; b0 -= mq[3][2] * y[38]; a1 -= mq[3][3] * x[39]; b1 -= mq[3][3] * y[39]; mq[3] = *(const LAS f32x4*)(Mg + 3208);
            a0 -= mq[4][0] * x[40]; b0 -= mq[4][0] * y[40]; a1 -= mq[4][1] * x[41]; b1 -= mq[4][1] * y[41]; a0 -= mq[4][2] * x[42]; b0 -= mq[4][2] * y[42]; a1 -= mq[4][3] * x[43]; b1 -= mq[4][3] * y[43]; mq[4] = *(const LAS f32x4*)(Mg + 3212);
            a0 -= mq[5][0] * x[44]; b0 -= mq[5][0] * y[44]; a1 -= mq[5][1] * x[45]; b1 -= mq[5][1] * y[45]; a0 -= mq[5][2] * x[46]; b0 -= mq[5][2] * y[46]; a1 -= mq[5][3] * x[47]; b1 -= mq[5][3] * y[47]; mq[5] = *(const LAS f32x4*)(Mg + 3216);
            a0 -= mq[0][0] * x[48]; b0 -= mq[0][0] * y[48]; x[49] = a0 + a1; y[49] = b0 + b1; up[6272] = x[49]; wp[6272] = f2bf(-y[49]); mq[0] = *(const LAS f32x4*)(Mg + 3220);
            { const float br = betg[50]; a0 = bf2f(*(const LAS bf16_t*)(lg + P5_VS + 13600 + c * 2)) * br; b0 = bf2f(*(const LAS bf16_t*)(lg + P5_KS + 13600 + c * 2)) * br * __expf(decg[50]); a1 = 0.f; b1 = 0.f; } a0 -= mq[1][0] * x[0]; b0 -= mq[1][0] * y[0]; a1 -= mq[1][1] * x[1]; b1 -= mq[1][1] * y[1]; a0 -= mq[1][2] * x[2]; b0 -= mq[1][2] * y[2]; a1 -= mq[1][3] * x[3]; b1 -= mq[1][3] * y[3]; mq[1] = *(const LAS f32x4*)(Mg + 3224);
            a0 -= mq[2][0] * x[4]; b0 -= mq[2][0] * y[4]; a1 -= mq[2][1] * x[5]; b1 -= mq[2][1] * y[5]; a0 -= mq[2][2] * x[6]; b0 -= mq[2][2] * y[6]; a1 -= mq[2][3] * x[7]; b1 -= mq[2][3] * y[7]; mq[2] = *(const LAS f32x4*)(Mg + 3228);
            a0 -= mq[3][0] * x[8]; b0 -= mq[3][0] * y[8]; a1 -= mq[3][1] * x[9]; b1 -= mq[3][1] * y[9]; a0 -= mq[3][2] * x[10]; b0 -= mq[3][2] * y[10]; a1 -= mq[3][3] * x[11]; b1 -= mq[3][3] * y[11]; mq[3] = *(const LAS f32x4*)(Mg + 3232);
            a0 -= mq[4][0] * x[12]; b0 -= mq[4][0] * y[12]; a1 -= mq[4][1] * x[13]; b1 -= mq[4][1] * y[13]; a0 -= mq[4][2] * x[14]; b0 -= mq[4][2] * y[14]; a1 -= mq[4][3] * x[15]; b1 -= mq[4][3] * y[15]; mq[4] = *(const LAS f32x4*)(Mg + 3236);
            a0 -= mq[5][0] * x[16]; b0 -= mq[5][0] * y[16]; a1 -= mq[5][1] * x[17]; b1 -= mq[5][1] * y[17]; a0 -= mq[5][2] * x[18]; b0 -= mq[5][2] * y[18]; a1 -= mq[5][3] * x[19]; b1 -= mq[5][3] * y[19]; mq[5] = *(const LAS f32x4*)(Mg + 3240);
            a0 -= mq[0][0] * x[20]; b0 -= mq[0][0] * y[20]; a1 -= mq[0][1] * x[21]; b1 -= mq[0][1] * y[21]; a0 -= mq[0][2] * x[22]; b0 -= mq[0][2] * y[22]; a1 -= mq[0][3] * x[23]; b1 -= mq[0][3] * y[23]; mq[0] = *(const LAS f32x4*)(Mg + 3244);
            a0 -= mq[1][0] * x[24]; b0 -= mq[1][0] * y[24]; a1 -= mq[1][1] * x[25]; b1 -= mq[1][1] * y[25]; a0 -= mq[1][2] * x[26]; b0 -= mq[1][2] * y[26]; a1 -= mq[1][3] * x[27]; b1 -= mq[1][3] * y[27]; mq[1] = *(const LAS f32x4*)(Mg + 3248);
            a0 -= mq[2][0] * x[28]; b0 -= mq[2][0] * y[28]; a1 -= mq[2][1] * x[29]; b1 -= mq[2][1] * y[29]; a0 -= mq[2][2] * x[30]; b0 -= mq[2][2] * y[30]; a1 -= mq[2][3] * x[31]; b1 -= mq[2][3] * y[31]; mq[2] = *(const LAS f32x4*)(Mg + 3264);
            a0 -= mq[3][0] * x[32]; b0 -= mq[3][0] * y[32]; a1 -= mq[3][1] * x[33]; b1 -= mq[3][1] * y[33]; a0 -= mq[3][2] * x[34]; b0 -= mq[3][2] * y[34]; a1 -= mq[3][3] * x[35]; b1 -= mq[3][3] * y[35]; mq[3] = *(const LAS f32x4*)(Mg + 3268);
            a0 -= mq[4][0] * x[36]; b0 -= mq[4][0] * y[36]; a1 -= mq[4][1] * x[37]; b1 -= mq[4][1] * y[37]; a0 -= mq[4][2] * x[38]; b0 -= mq[4][2] * y[38]; a1 -= mq[4][3] * x[39]; b1 -= mq[4][3] * y[39]; mq[4] = *(const LAS f32x4*)(Mg + 3272);
            a0 -= mq[5][0] * x[40]; b0 -= mq[5][0] * y[40]; a1 -= mq[5][1] * x[41]; b1 -= mq[5][1] * y[41]; a0 -= mq[5][2] * x[42]; b0 -= mq[5][2] * y[42]; a1 -= mq[5][3] * x[43]; b1 -= mq[5][3] * y[43]; mq[5] = *(const LAS f32x4*)(Mg + 3276);
            a0 -= mq[0][0] * x[44]; b0 -= mq[0][0] * y[44]; a1 -= mq[0][1] * x[45]; b1 -= mq[0][1] * y[45]; a0 -= mq[0][2] * x[46]; b0 -= mq[0][2] * y[46]; a1 -= mq[0][3] * x[47]; b1 -= mq[0][3] * y[47]; mq[0] = *(const LAS f32x4*)(Mg + 3280);
            a0 -= mq[1][0] * x[48]; b0 -= mq[1][0] * y[48]; a1 -= mq[1][1] * x[49]; b1 -= mq[1][1] * y[49]; x[50] = a0 + a1; y[50] = b0 + b1; up[6400] = x[50]; wp[6400] = f2bf(-y[50]); mq[1] = *(const LAS f32x4*)(Mg + 3284);
            { const float br = betg[51]; a0 = bf2f(*(const LAS bf16_t*)(lg + P5_VS + 13872 + c * 2)) * br; b0 = bf2f(*(const LAS bf16_t*)(lg + P5_KS + 13872 + c * 2)) * br * __expf(decg[51]); a1 = 0.f; b1 = 0.f; } a0 -= mq[2][0] * x[0]; b0 -= mq[2][0] * y[0]; a1 -= mq[2][1] * x[1]; b1 -= mq[2][1] * y[1]; a0 -= mq[2][2] * x[2]; b0 -= mq[2][2] * y[2]; a1 -= mq[2][3] * x[3]; b1 -= mq[2][3] * y[3]; mq[2] = *(const LAS f32x4*)(Mg + 3288);
            a0 -= mq[3][0] * x[4]; b0 -= mq[3][0] * y[4]; a1 -= mq[3][1] * x[5]; b1 -= mq[3][1] * y[5]; a0 -= mq[3][2] * x[6]; b0 -= mq[3][2] * y[6]; a1 -= mq[3][3] * x[7]; b1 -= mq[3][3] * y[7]; mq[3] = *(const LAS f32x4*)(Mg + 3292);
            a0 -= mq[4][0] * x[8]; b0 -= mq[4][0] * y[8]; a1 -= mq[4][1] * x[9]; b1 -= mq[4][1] * y[9]; a0 -= mq[4][2] * x[10]; b0 -= mq[4][2] * y[10]; a1 -= mq[4][3] * x[11]; b1 -= mq[4][3] * y[11]; mq[4] = *(const LAS f32x4*)(Mg + 3296);
            a0 -= mq[5][0] * x[12]; b0 -= mq[5][0] * y[12]; a1 -= mq[5][1] * x[13]; b1 -= mq[5][1] * y[13]; a0 -= mq[5][2] * x[14]; b0 -= mq[5][2] * y[14]; a1 -= mq[5][3] * x[15]; b1 -= mq[5][3] * y[15]; mq[5] = *(const LAS f32x4*)(Mg + 3300);
            a0 -= mq[0][0] * x[16]; b0 -= mq[0][0] * y[16]; a1 -= mq[0][1] * x[17]; b1 -= mq[0][1] * y[17]; a0 -= mq[0][2] * x[18]; b0 -= mq[0][2] * y[18]; a1 -= mq[0][3] * x[19]; b1 -= mq[0][3] * y[19]; mq[0] = *(const LAS f32x4*)(Mg + 3304);
            a0 -= mq[1][0] * x[20]; b0 -= mq[1][0] * y[20]; a1 -= mq[1][1] * x[21]; b1 -= mq[1][1] * y[21]; a0 -= mq[1][2] * x[22]; b0 -= mq[1][2] * y[22]; a1 -= mq[1][3] * x[23]; b1 -= mq[1][3] * y[23]; mq[1] = *(const LAS f32x4*)(Mg + 3308);
            a0 -= mq[2][0] * x[24]; b0 -= mq[2][0] * y[24]; a1 -= mq[2][1] * x[25]; b1 -= mq[2][1] * y[25]; a0 -= mq[2][2] * x[26]; b0 -= mq[2][2] * y[26]; a1 -= mq[2][3] * x[27]; b1 -= mq[2][3] * y[27]; mq[2] = *(const LAS f32x4*)(Mg + 3312);
            a0 -= mq[3][0] * x[28]; b0 -= mq[3][0] * y[28]; a1 -= mq[3][1] * x[29]; b1 -= mq[3][1] * y[29]; a0 -= mq[3][2] * x[30]; b0 -= mq[3][2] * y[30]; a1 -= mq[3][3] * x[31]; b1 -= mq[3][3] * y[31]; mq[3] = *(const LAS f32x4*)(Mg + 3328);
            a0 -= mq[4][0] * x[32]; b0 -= mq[4][0] * y[32]; a1 -= mq[4][1] * x[33]; b1 -= mq[4][1] * y[33]; a0 -= mq[4][2] * x[34]; b0 -= mq[4][2] * y[34]; a1 -= mq[4][3] * x[35]; b1 -= mq[4][3] * y[35]; mq[4] = *(const LAS f32x4*)(Mg + 3332);
            a0 -= mq[5][0] * x[36]; b0 -= mq[5][0] * y[36]; a1 -= mq[5][1] * x[37]; b1 -= mq[5][1] * y[37]; a0 -= mq[5][2] * x[38]; b0 -= mq[5][2] * y[38]; a1 -= mq[5][3] * x[39]; b1 -= mq[5][3] * y[39]; mq[5] = *(const LAS f32x4*)(Mg + 3336);
            a0 -= mq[0][0] * x[40]; b0 -= mq[0][0] * y[40]; a1 -= mq[0][1] * x[41]; b1 -= mq[0][1] * y[41]; a0 -= mq[0][2] * x[42]; b0 -= mq[0][2] * y[42]; a1 -= mq[0][3] * x[43]; b1 -= mq[0][3] * y[43]; mq[0] = *(const LAS f32x4*)(Mg + 3340);
            a0 -= mq[1][0] * x[44]; b0 -= mq[1][0] * y[44]; a1 -= mq[1][1] * x[45]; b1 -= mq[1][1] * y[45]; a0 -= mq[1][2] * x[46]; b0 -= mq[1][2] * y[46]; a1 -= mq[1][3] * x[47]; b1 -= mq[1][3] * y[47]; mq[1] = *(const LAS f32x4*)(Mg + 3344);
            a0 -= mq[2][0] * x[48]; b0 -= mq[2][0] * y[48]; a1 -= mq[2][1] * x[49]; b1 -= mq[2][1] * y[49]; a0 -= mq[2][2] * x[50]; b0 -= mq[2][2] * y[50]; x[51] = a0 + a1; y[51] = b0 + b1; up[6528] = x[51]; wp[6528] = f2bf(-y[51]); mq[2] = *(const LAS f32x4*)(Mg + 3348);
            { const float br = betg[52]; a0 = bf2f(*(const LAS bf16_t*)(lg + P5_VS + 14144 + c * 2)) * br; b0 = bf2f(*(const LAS bf16_t*)(lg + P5_KS + 14144 + c * 2)) * br * __expf(decg[52]); a1 = 0.f; b1 = 0.f; } a0 -= mq[3][0] * x[0]; b0 -= mq[3][0] * y[0]; a1 -= mq[3][1] * x[1]; b1 -= mq[3][1] * y[1]; a0 -= mq[3][2] * x[2]; b0 -= mq[3][2] * y[2]; a1 -= mq[3][3] * x[3]; b1 -= mq[3][3] * y[3]; mq[3] = *(const LAS f32x4*)(Mg + 3352);
            a0 -= mq[4][0] * x[4]; b0 -= mq[4][0] * y[4]; a1 -= mq[4][1] * x[5]; b1 -= mq[4][1] * y[5]; a0 -= mq[4][2] * x[6]; b0 -= mq[4][2] * y[6]; a1 -= mq[4][3] * x[7]; b1 -= mq[4][3] * y[7]; mq[4] = *(const LAS f32x4*)(Mg + 3356);
            a0 -= mq[5][0] * x[8]; b0 -= mq[5][0] * y[8]; a1 -= mq[5][1] * x[9]; b1 -= mq[5][1] * y[9]; a0 -= mq[5][2] * x[10]; b0 -= mq[5][2] * y[10]; a1 -= mq[5][3] * x[11]; b1 -= mq[5][3] * y[11]; mq[5] = *(const LAS f32x4*)(Mg + 3360);
            a0 -= mq[0][0] * x[12]; b0 -= mq[0][0] * y[12]; a1 -= mq[0][1] * x[13]; b1 -= mq[0][1] * y[13]; a0 -= mq[0][2] * x[14]; b0 -= mq[0][2] * y[14]; a1 -= mq[0][3] * x[15]; b1 -= mq[0][3] * y[15]; mq[0] = *(const LAS f32x4*)(Mg + 3364);
            a0 -= mq[1][0] * x[16]; b0 -= mq[1][0] * y[16]; a1 -= mq[1][1] * x[17]; b1 -= mq[1][1] * y[17]; a0 -= mq[1][2] * x[18]; b0 -= mq[1][2] * y[18]; a1 -= mq[1][3] * x[19]; b1 -= mq[1][3] * y[19]; mq[1] = *(const LAS f32x4*)(Mg + 3368);
            a0 -= mq[2][0] * x[20]; b0 -= mq[2][0] * y[20]; a1 -= mq[2][1] * x[21]; b1 -= mq[2][1] * y[21]; a0 -= mq[2][2] * x[22]; b0 -= mq[2][2] * y[22]; a1 -= mq[2][3] * x[23]; b1 -= mq[2][3] * y[23]; mq[2] = *(const LAS f32x4*)(Mg + 3372);
            a0 -= mq[3][0] * x[24]; b0 -= mq[3][0] * y[24]; a1 -= mq[3][1] * x[25]; b1 -= mq[3][1] * y[25]; a0 -= mq[3][2] * x[26]; b0 -= mq[3][2] * y[26]; a1 -= mq[3][3] * x[27]; b1 -= mq[3][3] * y[27]; mq[3] = *(const LAS f32x4*)(Mg + 3376);
            a0 -= mq[4][0] * x[28]; b0 -= mq[4][0] * y[28]; a1 -= mq[4][1] * x[29]; b1 -= mq[4][1] * y[29]; a0 -= mq[4][2] * x[30]; b0 -= mq[4][2] * y[30]; a1 -= mq[4][3] * x[31]; b1 -= mq[4][3] * y[31]; mq[4] = *(const LAS f32x4*)(Mg + 3392);
            a0 -= mq[5][0] * x[32]; b0 -= mq[5][0] * y[32]; a1 -= mq[5][1] * x[33]; b1 -= mq[5][1] * y[33]; a0 -= mq[5][2] * x[34]; b0 -= mq[5][2] * y[34]; a1 -= mq[5][3] * x[35]; b1 -= mq[5][3] * y[35]; mq[5] = *(const LAS f32x4*)(Mg + 3396);
            a0 -= mq[0][0] * x[36]; b0 -= mq[0][0] * y[36]; a1 -= mq[0][1] * x[37]; b1 -= mq[0][1] * y[37]; a0 -= mq[0][2] * x[38]; b0 -= mq[0][2] * y[38]; a1 -= mq[0][3] * x[39]; b1 -= mq[0][3] * y[39]; mq[0] = *(const LAS f32x4*)(Mg + 3400);
            a0 -= mq[1][0] * x[40]; b0 -= mq[1][0] * y[40]; a1 -= mq[1][1] * x[41]; b1 -= mq[1][1] * y[41]; a0 -= mq[1][2] * x[42]; b0 -= mq[1][2] * y[42]; a1 -= mq[1][3] * x[43]; b1 -= mq[1][3] * y[43]; mq[1] = *(const LAS f32x4*)(Mg + 3404);
            a0 -= mq[2][0] * x[44]; b0 -= mq[2][0] * y[44]; a1 -= mq[2][1] * x[45]; b1 -= mq[2][1] * y[45]; a0 -= mq[2][2] * x[46]; b0 -= mq[2][2] * y[46]; a1 -= mq[2][3] * x[47]; b1 -= mq[2][3] * y[47]; mq[2] = *(const LAS f32x4*)(Mg + 3408);
            a0 -= mq[3][0] * x[48]; b0 -= mq[3][0] * y[48]; a1 -= mq[3][1] * x[49]; b1 -= mq[3][1] * y[49]; a0 -= mq[3][2] * x[50]; b0 -= mq[3][2] * y[50]; a1 -= mq[3][3] * x[51]; b1 -= mq[3][3] * y[51]; x[52] = a0 + a1; y[52] = b0 + b1; up[6656] = x[52]; wp[6656] = f2bf(-y[52]); mq[3] = *(const LAS f32x4*)(Mg + 3412);
            { const float br = betg[53]; a0 = bf2f(*(const LAS bf16_t*)(lg + P5_VS + 14416 + c * 2)) * br; b0 = bf2f(*(const LAS bf16_t*)(lg + P5_KS + 14416 + c * 2)) * br * __expf(decg[53]); a1 = 0.f; b1 = 0.f; } a0 -= mq[4][0] * x[0]; b0 -= mq[4][0] * y[0]; a1 -= mq[4][1] * x[1]; b1 -= mq[4][1] * y[1]; a0 -= mq[4][2] * x[2]; b0 -= mq[4][2] * y[2]; a1 -= mq[4][3] * x[3]; b1 -= mq[4][3] * y[3]; mq[4] = *(const LAS f32x4*)(Mg + 3416);
            a0 -= mq[5][0] * x[4]; b0 -= mq[5][0] * y[4]; a1 -= mq[5][1] * x[5]; b1 -= mq[5][1] * y[5]; a0 -= mq[5][2] * x[6]; b0 -= mq[5][2] * y[6]; a1 -= mq[5][3] * x[7]; b1 -= mq[5][3] * y[7]; mq[5] = *(const LAS f32x4*)(Mg + 3420);
            a0 -= mq[0][0] * x[8]; b0 -= mq[0][0] * y[8]; a1 -= mq[0][1] * x[9]; b1 -= mq[0][1] * y[9]; a0 -= mq[0][2] * x[10]; b0 -= mq[0][2] * y[10]; a1 -= mq[0][3] * x[11]; b1 -= mq[0][3] * y[11]; mq[0] = *(const LAS f32x4*)(Mg + 3424);
            a0 -= mq[1][0] * x[12]; b0 -= mq[1][0] * y[12]; a1 -= mq[1][1] * x[13]; b1 -= mq[1][1] * y[13]; a0 -= mq[1][2] * x[14]; b0 -= mq[1][2] * y[14]; a1 -= mq[1][3] * x[15]; b1 -= mq[1][3] * y[15]; mq[1] = *(const LAS f32x4*)(Mg + 3428);
            a0 -= mq[2][0] * x[16]; b0 -= mq[2][0] * y[16]; a1 -= mq[2][1] * x[17]; b1 -= mq[2][1] * y[17]; a0 -= mq[2][2] * x[18]; b0 -= mq[2][2] * y[18]; a1 -= mq[2][3] * x[19]; b1 -= mq[2][3] * y[19]; mq[2] = *(const LAS f32x4*)(Mg + 3432);
            a0 -= mq[3][0] * x[20]; b0 -= mq[3][0] * y[20]; a1 -= mq[3][1] * x[21]; b1 -= mq[3][1] * y[21]; a0 -= mq[3][2] * x[22]; b0 -= mq[3][2] * y[22]; a1 -= mq[3][3] * x[23]; b1 -= mq[3][3] * y[23]; mq[3] = *(const LAS f32x4*)(Mg + 3436);
            a0 -= mq[4][0] * x[24]; b0 -= mq[4][0] * y[24]; a1 -= mq[4][1] * x[25]; b1 -= mq[4][1] * y[25]; a0 -= mq[4][2] * x[26]; b0 -= mq[4][2] * y[26]; a1 -= mq[4][3] * x[27]; b1 -= mq[4][3] * y[27]; mq[4] = *(const LAS f32x4*)(Mg + 3440);
            a0 -= mq[5][0] * x[28]; b0 -= mq[5][0] * y[28]; a1 -= mq[5][1] * x[29]; b1 -= mq[5][1] * y[29]; a0 -= mq[5][2] * x[30]; b0 -= mq[5][2] * y[30]; a1 -= mq[5][3] * x[31]; b1 -= mq[5][3] * y[31]; mq[5] = *(const LAS f32x4*)(Mg + 3444);
            a0 -= mq[0][0] * x[32]; b0 -= mq[0][0] * y[32]; a1 -= mq[0][1] * x[33]; b1 -= mq[0][1] * y[33]; a0 -= mq[0][2] * x[34]; b0 -= mq[0][2] * y[34]; a1 -= mq[0][3] * x[35]; b1 -= mq[0][3] * y[35]; mq[0] = *(const LAS f32x4*)(Mg + 3456);
            a0 -= mq[1][0] * x[36]; b0 -= mq[1][0] * y[36]; a1 -= mq[1][1] * x[37]; b1 -= mq[1][1] * y[37]; a0 -= mq[1][2] * x[38]; b0 -= mq[1][2] * y[38]; a1 -= mq[1][3] * x[39]; b1 -= mq[1][3] * y[39]; mq[1] = *(const LAS f32x4*)(Mg + 3460);
            a0 -= mq[2][0] * x[40]; b0 -= mq[2][0] * y[40]; a1 -= mq[2][1] * x[41]; b1 -= mq[2][1] * y[41]; a0 -= mq[2][2] * x[42]; b0 -= mq[2][2] * y[42]; a1 -= mq[2][3] * x[43]; b1 -= mq[2][3] * y[43]; mq[2] = *(const LAS f32x4*)(Mg + 3464);
            a0 -= mq[3][0] * x[44]; b0 -= mq[3][0] * y[44]; a1 -= mq[3][1] * x[45]; b1 -= mq[3][1] * y[45]; a0 -= mq[3][2] * x[46]; b0 -= mq[3][2] * y[46]; a1 -= mq[3][3] * x[47]; b1 -= mq[3][3] * y[47]; mq[3] = *(const LAS f32x4*)(Mg + 3468);
            a0 -= mq[4][0] * x[48]; b0 -= mq[4][0] * y[48]; a1 -= mq[4][1] * x[49]; b1 -= mq[4][1] * y[49]; a0 -= mq[4][2] * x[50]; b0 -= mq[4][2] * y[50]; a1 -= mq[4][3] * x[51]; b1 -= mq[4][3] * y[51]; mq[4] = *(const LAS f32x4*)(Mg + 3472);
            a0 -= mq[5][0] * x[52]; b0 -= mq[5][0] * y[52]; x[53] = a0 + a1; y[53] = b0 + b1; up[6784] = x[53]; wp[6784] = f2bf(-y[53]); mq[5] = *(const LAS f32x4*)(Mg + 3476);
            { const float br = betg[54]; a0 = bf2f(*(const LAS bf16_t*)(lg + P5_VS + 14688 + c * 2)) * br; b0 = bf2f(*(const LAS bf16_t*)(lg + P5_KS + 14688 + c * 2)) * br * __expf(decg[54]); a1 = 0.f; b1 = 0.f; } a0 -= mq[0][0] * x[0]; b0 -= mq[0][0] * y[0]; a1 -= mq[0][1] * x[1]; b1 -= mq[0][1] * y[1]; a0 -= mq[0][2] * x[2]; b0 -= mq[0][2] * y[2]; a1 -= mq[0][3] * x[3]; b1 -= mq[0][3] * y[3]; mq[0] = *(const LAS f32x4*)(Mg + 3480);
            a0 -= mq[1][0] * x[4]; b0 -= mq[1][0] * y[4]; a1 -= mq[1][1] * x[5]; b1 -= mq[1][1] * y[5]; a0 -= mq[1][2] * x[6]; b0 -= mq[1][2] * y[6]; a1 -= mq[1][3] * x[7]; b1 -= mq[1][3] * y[7]; mq[1] = *(const LAS f32x4*)(Mg + 3484);
            a0 -= mq[2][0] * x[8]; b0 -= mq[2][0] * y[8]; a1 -= mq[2][1] * x[9]; b1 -= mq[2][1] * y[9]; a0 -= mq[2][2] * x[10]; b0 -= mq[2][2] * y[10]; a1 -= mq[2][3] * x[11]; b1 -= mq[2][3] * y[11]; mq[2] = *(const LAS f32x4*)(Mg + 3488);
            a0 -= mq[3][0] * x[12]; b0 -= mq[3][0] * y[12]; a1 -= mq[3][1] * x[13]; b1 -= mq[3][1] * y[13]; a0 -= mq[3][2] * x[14]; b0 -= mq[3][2] * y[14]; a1 -= mq[3][3] * x[15]; b1 -= mq[3][3] * y[15]; mq[3] = *(const LAS f32x4*)(Mg + 3492);
            a0 -= mq[4][0] * x[16]; b0 -= mq[4][0] * y[16]; a1 -= mq[4][1] * x[17]; b1 -= mq[4][1] * y[17]; a0 -= mq[4][2] * x[18]; b0 -= mq[4][2] * y[18]; a1 -= mq[4][3] * x[19]; b1 -= mq[4][3] * y[19]; mq[4] = *(const LAS f32x4*)(Mg + 3496);
            a0 -= mq[5][0] * x[20]; b0 -= mq[5][0] * y[20]; a1 -= mq[5][1] * x[21]; b1 -= mq[5][1] * y[21]; a0 -= mq[5][2] * x[22]; b0 -= mq[5][2] * y[22]; a1 -= mq[5][3] * x[23]; b1 -= mq[5][3] * y[23]; mq[5] = *(const LAS f32x4*)(Mg + 3500);
            a0 -= mq[0][0] * x[24]; b0 -= mq[0][0] * y[24]; a1 -= mq[0][1] * x[25]; b1 -= mq[0][1] * y[25]; a0 -= mq[0][2] * x[26]; b0 -= mq[0][2] * y[26]; a1 -= mq[0][3] * x[27]; b1 -= mq[0][3] * y[27]; mq[0] = *(const LAS f32x4*)(Mg + 3504);
            a0 -= mq[1][0] * x[28]; b0 -= mq[1][0] * y[28]; a1 -= mq[1][1] * x[29]; b1 -= mq[1][1] * y[29]; a0 -= mq[1][2] * x[30]; b0 -= mq[1][2] * y[30]; a1 -= mq[1][3] * x[31]; b1 -= mq[1][3] * y[31]; mq[1] = *(const LAS f32x4*)(Mg + 3508);
            a0 -= mq[2][0] * x[32]; b0 -= mq[2][0] * y[32]; a1 -= mq[2][1] * x[33]; b1 -= mq[2][1] * y[33]; a0 -= mq[2][2] * x[34]; b0 -= mq[2][2] * y[34]; a1 -= mq[2][3] * x[35]; b1 -= mq[2][3] * y[35]; mq[2] = *(const LAS f32x4*)(Mg + 3520);
            a0 -= mq[3][0] * x[36]; b0 -= mq[3][0] * y[36]; a1 -= mq[3][1] * x[37]; b1 -= mq[3][1] * y[37]; a0 -= mq[3][2] * x[38]; b0 -= mq[3][2] * y[38]; a1 -= mq[3][3] * x[39]; b1 -= mq[3][3] * y[39]; mq[3] = *(const LAS f32x4*)(Mg + 3524);
            a0 -= mq[4][0] * x[40]; b0 -= mq[4][0] * y[40]; a1 -= mq[4][1] * x[41]; b1 -= mq[4][1] * y[41]; a0 -= mq[4][2] * x[42]; b0 -= mq[4][2] * y[42]; a1 -= mq[4][3] * x[43]; b1 -= mq[4][3] * y[43]; mq[4] = *(const LAS f32x4*)(Mg + 3528);
            a0 -= mq[5][0] * x[44]; b0 -= mq[5][0] * y[44]; a1 -= mq[5][1] * x[45]; b1 -= mq[5][1] * y[45]; a0 -= mq[5][2] * x[46]; b0 -= mq[5][2] * y[46]; a1 -= mq[5][3] * x[47]; b1 -= mq[5][3] * y[47]; mq[5] = *(const LAS f32x4*)(Mg + 3532);
            a0 -= mq[0][0] * x[48]; b0 -= mq[0][0] * y[48]; a1 -= mq[0][1] * x[49]; b1 -= mq[0][1] * y[49]; a0 -= mq[0][2] * x[50]; b0 -= mq[0][2] * y[50]; a1 -= mq[0][3] * x[51]; b1 -= mq[0][3] * y[51]; mq[0] = *(const LAS f32x4*)(Mg + 3536);
            a0 -= mq[1][0] * x[52]; b0 -= mq[1][0] * y[52]; a1 -= mq[1][1] * x[53]; b1 -= mq[1][1] * y[53]; x[54] = a0 + a1; y[54] = b0 + b1; up[6912] = x[54]; wp[6912] = f2bf(-y[54]); mq[1] = *(const LAS f32x4*)(Mg + 3540);
            { const float br = betg[55]; a0 = bf2f(*(const LAS bf16_t*)(lg + P5_VS + 14960 + c * 2)) * br; b0 = bf2f(*(const LAS bf16_t*)(lg + P5_KS + 14960 + c * 2)) * br * __expf(decg[55]); a1 = 0.f; b1 = 0.f; } a0 -= mq[2][0] * x[0]; b0 -= mq[2][0] * y[0]; a1 -= mq[2][1] * x[1]; b1 -= mq[2][1] * y[1]; a0 -= mq[2][2] * x[2]; b0 -= mq[2][2] * y[2]; a1 -= mq[2][3] * x[3]; b1 -= mq[2][3] * y[3]; mq[2] = *(const LAS f32x4*)(Mg + 3544);
            a0 -= mq[3][0] * x[4]; b0 -= mq[3][0] * y[4]; a1 -= mq[3][1] * x[5]; b1 -= mq[3][1] * y[5]; a0 -= mq[3][2] * x[6]; b0 -= mq[3][2] * y[6]; a1 -= mq[3][3] * x[7]; b1 -= mq[3][3] * y[7]; mq[3] = *(const LAS f32x4*)(Mg + 3548);
            a0 -= mq[4][0] * x[8]; b0 -= mq[4][0] * y[8]; a1 -= mq[4][1] * x[9]; b1 -= mq[4][1] * y[9]; a0 -= mq[4][2] * x[10]; b0 -= mq[4][2] * y[10]; a1 -= mq[4][3] * x[11]; b1 -= mq[4][3] * y[11]; mq[4] = *(const LAS f32x4*)(Mg + 3552);
            a0 -= mq[5][0] * x[12]; b0 -= mq[5][0] * y[12]; a1 -= mq[5][1] * x[13]; b1 -= mq[5][1] * y[13]; a0 -= mq[5][2] * x[14]; b0 -= mq[5][2] * y[14]; a1 -= mq[5][3] * x[15]; b1 -= mq[5][3] * y[15]; mq[5] = *(const LAS f32x4*)(Mg + 3556);
            a0 -= mq[0][0] * x[16]; b0 -= mq[0][0] * y[16]; a1 -= mq[0][1] * x[17]; b1 -= mq[0][1] * y[17]; a0 -= mq[0][2] * x[18]; b0 -= mq[0][2] * y[18]; a1 -= mq[0][3] * x[19]; b1 -= mq[0][3] * y[19]; mq[0] = *(const LAS f32x4*)(Mg + 3560);
            a0 -= mq[1][0] * x[20]; b0 -= mq[1][0] * y[20]; a1 -= mq[1][1] * x[21]; b1 -= mq[1][1] * y[21]; a0 -= mq[1][2] * x[22]; b0 -= mq[1][2] * y[22]; a1 -= mq[1][3] * x[23]; b1 -= mq[1][3] * y[23]; mq[1] = *(const LAS f32x4*)(Mg + 3564);
            a0 -= mq[2][0] * x[24]; b0 -= mq[2][0] * y[24]; a1 -= mq[2][1] * x[25]; b1 -= mq[2][1] * y[25]; a0 -= mq[2][2] * x[26]; b0 -= mq[2][2] * y[26]; a1 -= mq[2][3] * x[27]; b1 -= mq[2][3] * y[27]; mq[2] = *(const LAS f32x4*)(Mg + 3568);
            a0 -= mq[3][0] * x[28]; b0 -= mq[3][0] * y[28]; a1 -= mq[3][1] * x[29]; b1 -= mq[3][1] * y[29]; a0 -= mq[3][2] * x[30]; b0 -= mq[3][2] * y[30]; a1 -= mq[3][3] * x[31]; b1 -= mq[3][3] * y[31]; mq[3] = *(const LAS f32x4*)(Mg + 3572);
            a0 -= mq[4][0] * x[32]; b0 -= mq[4][0] * y[32]; a1 -= mq[4][1] * x[33]; b1 -= mq[4][1] * y[33]; a0 -= mq[4][2] * x[34]; b0 -= mq[4][2] * y[34]; a1 -= mq[4][3] * x[35]; b1 -= mq[4][3] * y[35]; mq[4] = *(const LAS f32x4*)(Mg + 3584);
            a0 -= mq[5][0] * x[36]; b0 -= mq[5][0] * y[36]; a1 -= mq[5][1] * x[37]; b1 -= mq[5][1] * y[37]; a0 -= mq[5][2] * x[38]; b0 -= mq[5][2] * y[38]; a1 -= mq[5][3] * x[39]; b1 -= mq[5][3] * y[39]; mq[5] = *(const LAS f32x4*)(Mg + 3588);
            a0 -= mq[0][0] * x[40]; b0 -= mq[0][0] * y[40]; a1 -= mq[0][1] * x[41]; b1 -= mq[0][1] * y[41]; a0 -= mq[0][2] * x[42]; b0 -= mq[0][2] * y[42]; a1 -= mq[0][3] * x[43]; b1 -= mq[0][3] * y[43]; mq[0] = *(const LAS f32x4*)(Mg + 3592);
            a0 -= mq[1][0] * x[44]; b0 -= mq[1][0] * y[44]; a1 -= mq[1][1] * x[45]; b1 -= mq[1][1] * y[45]; a0 -= mq[1][2] * x[46]; b0 -= mq[1][2] * y[46]; a1 -= mq[1][3] * x[47]; b1 -= mq[1][3] * y[47]; mq[1] = *(const LAS f32x4*)(Mg + 3596);
            a0 -= mq[2][0] * x[48]; b0 -= mq[2][0] * y[48]; a1 -= mq[2][1] * x[49]; b1 -= mq[2][1] * y[49]; a0 -= mq[2][2] * x[50]; b0 -= mq[2][2] * y[50]; a1 -= mq[2][3] * x[51]; b1 -= mq[2][3] * y[51]; mq[2] = *(const LAS f32x4*)(Mg + 3600);
            a0 -= mq[3][0] * x[52]; b0 -= mq[3][0] * y[52]; a1 -= mq[3][1] * x[53]; b1 -= mq[3][1] * y[53]; a0 -= mq[3][2] * x[54]; b0 -= mq[3][2] * y[54]; x[55] = a0 + a1; y[55] = b0 + b1; up[7040] = x[55]; wp[7040] = f2bf(-y[55]); mq[3] = *(const LAS f32x4*)(Mg + 3604);
            { const float br = betg[56]; a0 = bf2f(*(const LAS bf16_t*)(lg + P5_VS + 15232 + c * 2)) * br; b0 = bf2f(*(const LAS bf16_t*)(lg + P5_KS + 15232 + c * 2)) * br * __expf(decg[56]); a1 = 0.f; b1 = 0.f; } a0 -= mq[4][0] * x[0]; b0 -= mq[4][0] * y[0]; a1 -= mq[4][1] * x[1]; b1 -= mq[4][1] * y[1]; a0 -= mq[4][2] * x[2]; b0 -= mq[4][2] * y[2]; a1 -= mq[4][3] * x[3]; b1 -= mq[4][3] * y[3]; mq[4] = *(const LAS f32x4*)(Mg + 3608);
            a0 -= mq[5][0] * x[4]; b0 -= mq[5][0] * y[4]; a1 -= mq[5][1] * x[5]; b1 -= mq[5][1] * y[5]; a0 -= mq[5][2] * x[6]; b0 -= mq[5][2] * y[6]; a1 -= mq[5][3] * x[7]; b1 -= mq[5][3] * y[7]; mq[5] = *(const LAS f32x4*)(Mg + 3612);
            a0 -= mq[0][0] * x[8]; b0 -= mq[0][0] * y[8]; a1 -= mq[0][1] * x[9]; b1 -= mq[0][1] * y[9]; a0 -= mq[0][2] * x[10]; b0 -= mq[0][2] * y[10]; a1 -= mq[0][3] * x[11]; b1 -= mq[0][3] * y[11]; mq[0] = *(const LAS f32x4*)(Mg + 3616);
            a0 -= mq[1][0] * x[12]; b0 -= mq[1][0] * y[12]; a1 -= mq[1][1] * x[13]; b1 -= mq[1][1] * y[13]; a0 -= mq[1][2] * x[14]; b0 -= mq[1][2] * y[14]; a1 -= mq[1][3] * x[15]; b1 -= mq[1][3] * y[15]; mq[1] = *(const LAS f32x4*)(Mg + 3620);
            a0 -= mq[2][0] * x[16]; b0 -= mq[2][0] * y[16]; a1 -= mq[2][1] * x[17]; b1 -= mq[2][1] * y[17]; a0 -= mq[2][2] * x[18]; b0 -= mq[2][2] * y[18]; a1 -= mq[2][3] * x[19]; b1 -= mq[2][3] * y[19]; mq[2] = *(const LAS f32x4*)(Mg + 3624);
            a0 -= mq[3][0] * x[20]; b0 -= mq[3][0] * y[20]; a1 -= mq[3][1] * x[21]; b1 -= mq[3][1] * y[21]; a0 -= mq[3][2] * x[22]; b0 -= mq[3][2] * y[22]; a1 -= mq[3][3] * x[23]; b1 -= mq[3][3] * y[23]; mq[3] = *(const LAS f32x4*)(Mg + 3628);
            a0 -= mq[4][0] * x[24]; b0 -= mq[4][0] * y[24]; a1 -= mq[4][1] * x[25]; b1 -= mq[4][1] * y[25]; a0 -= mq[4][2] * x[26]; b0 -= mq[4][2] * y[26]; a1 -= mq[4][3] * x[27]; b1 -= mq[4][3] * y[27]; mq[4] = *(const LAS f32x4*)(Mg + 3632);
            a0 -= mq[5][0] * x[28]; b0 -= mq[5][0] * y[28]; a1 -= mq[5][1] * x[29]; b1 -= mq[5][1] * y[29]; a0 -= mq[5][2] * x[30]; b0 -= mq[5][2] * y[30]; a1 -= mq[5][3] * x[31]; b1 -= mq[5][3] * y[31]; mq[5] = *(const LAS f32x4*)(Mg + 3636);
            a0 -= mq[0][0] * x[32]; b0 -= mq[0][0] * y[32]; a1 -= mq[0][1] * x[33]; b1 -= mq[0][1] * y[33]; a0 -= mq[0][2] * x[34]; b0 -= mq[0][2] * y[34]; a1 -= mq[0][3] * x[35]; b1 -= mq[0][3] * y[35]; mq[0] = *(const LAS f32x4*)(Mg + 3648);
            a0 -= mq[1][0] * x[36]; b0 -= mq[1][0] * y[36]; a1 -= mq[1][1] * x[37]; b1 -= mq[1][1] * y[37]; a0 -= mq[1][2] * x[38]; b0 -= mq[1][2] * y[38]; a1 -= mq[1][3] * x[39]; b1 -= mq[1][3] * y[39]; mq[1] = *(const LAS f32x4*)(Mg + 3652);
            a0 -= mq[2][0] * x[40]; b0 -= mq[2][0] * y[40]; a1 -= mq[2][1] * x[41]; b1 -= mq[2][1] * y[41]; a0 -= mq[2][2] * x[42]; b0 -= mq[2][2] * y[42]; a1 -= mq[2][3] * x[43]; b1 -= mq[2][3] * y[43]; mq[2] = *(const LAS f32x4*)(Mg + 3656);
            a0 -= mq[3][0] * x[44]; b0 -= mq[3][0] * y[44]; a1 -= mq[3][1] * x[45]; b1 -= mq[3][1] * y[45]; a0 -= mq[3][2] * x[46]; b0 -= mq[3][2] * y[46]; a1 -= mq[3][3] * x[47]; b1 -= mq[3][3] * y[47]; mq[3] = *(const LAS f32x4*)(Mg + 3660);
            a0 -= mq[4][0] * x[48]; b0 -= mq[4][0] * y[48]; a1 -= mq[4][1] * x[49]; b1 -= mq[4][1] * y[49]; a0 -= mq[4][2] * x[50]; b0 -= mq[4][2] * y[50]; a1 -= mq[4][3] * x[51]; b1 -= mq[4][3] * y[51]; mq[4] = *(const LAS f32x4*)(Mg + 3664);
            a0 -= mq[5][0] * x[52]; b0 -= mq[5][0] * y[52]; a1 -= mq[5][1] * x[53]; b1 -= mq[5][1] * y[53]; a0 -= mq[5][2] * x[54]; b0 -= mq[5][2] * y[54]; a1 -= mq[5][3] * x[55]; b1 -= mq[5][3] * y[55]; x[56] = a0 + a1; y[56] = b0 + b1; up[7168] = x[56]; wp[7168] = f2bf(-y[56]); mq[5] = *(const LAS f32x4*)(Mg + 3668);
            { const float br = betg[57]; a0 = bf2f(*(const LAS bf16_t*)(lg + P5_VS + 15504 + c * 2)) * br; b0 = bf2f(*(const LAS bf16_t*)(lg + P5_KS + 15504 + c * 2)) * br * __expf(decg[57]); a1 = 0.f; b1 = 0.f; } a0 -= mq[0][0] * x[0]; b0 -= mq[0][0] * y[0]; a1 -= mq[0][1] * x[1]; b1 -= mq[0][1] * y[1]; a0 -= mq[0][2] * x[2]; b0 -= mq[0][2] * y[2]; a1 -= mq[0][3] * x[3]; b1 -= mq[0][3] * y[3]; mq[0] = *(const LAS f32x4*)(Mg + 3672);
            a0 -= mq[1][0] * x[4]; b0 -= mq[1][0] * y[4]; a1 -= mq[1][1] * x[5]; b1 -= mq[1][1] * y[5]; a0 -= mq[1][2] * x[6]; b0 -= mq[1][2] * y[6]; a1 -= mq[1][3] * x[7]; b1 -= mq[1][3] * y[7]; mq[1] = *(const LAS f32x4*)(Mg + 3676);
            a0 -= mq[2][0] * x[8]; b0 -= mq[2][0] * y[8]; a1 -= mq[2][1] * x[9]; b1 -= mq[2][1] * y[9]; a0 -= mq[2][2] * x[10]; b0 -= mq[2][2] * y[10]; a1 -= mq[2][3] * x[11]; b1 -= mq[2][3] * y[11]; mq[2] = *(const LAS f32x4*)(Mg + 3680);
            a0 -= mq[3][0] * x[12]; b0 -= mq[3][0] * y[12]; a1 -= mq[3][1] * x[13]; b1 -= mq[3][1] * y[13]; a0 -= mq[3][2] * x[14]; b0 -= mq[3][2] * y[14]; a1 -= mq[3][3] * x[15]; b1 -= mq[3][3] * y[15]; mq[3] = *(const LAS f32x4*)(Mg + 3684);
            a0 -= mq[4][0] * x[16]; b0 -= mq[4][0] * y[16]; a1 -= mq[4][1] * x[17]; b1 -= mq[4][1] * y[17]; a0 -= mq[4][2] * x[18]; b0 -= mq[4][2] * y[18]; a1 -= mq[4][3] * x[19]; b1 -= mq[4][3] * y[19]; mq[4] = *(const LAS f32x4*)(Mg + 3688);
            a0 -= mq[5][0] * x[20]; b0 -= mq[5][0] * y[20]; a1 -= mq[5][1] * x[21]; b1 -= mq[5][1] * y[21]; a0 -= mq[5][2] * x[22]; b0 -= mq[5][2] * y[22]; a1 -= mq[5][3] * x[23]; b1 -= mq[5][3] * y[23]; mq[5] = *(const LAS f32x4*)(Mg + 3692);
            a0 -= mq[0][0] * x[24]; b0 -= mq[0][0] * y[24]; a1 -= mq[0][1] * x[25]; b1 -= mq[0][1] * y[25]; a0 -= mq[0][2] * x[26]; b0 -= mq[0][2] * y[26]; a1 -= mq[0][3] * x[27]; b1 -= mq[0][3] * y[27]; mq[0] = *(const LAS f32x4*)(Mg + 3696);
            a0 -= mq[1][0] * x[28]; b0 -= mq[1][0] * y[28]; a1 -= mq[1][1] * x[29]; b1 -= mq[1][1] * y[29]; a0 -= mq[1][2] * x[30]; b0 -= mq[1][2] * y[30]; a1 -= mq[1][3] * x[31]; b1 -= mq[1][3] * y[31]; mq[1] = *(const LAS f32x4*)(Mg + 3700);
            a0 -= mq[2][0] * x[32]; b0 -= mq[2][0] * y[32]; a1 -= mq[2][1] * x[33]; b1 -= mq[2][1] * y[33]; a0 -= mq[2][2] * x[34]; b0 -= mq[2][2] * y[34]; a1 -= mq[2][3] * x[35]; b1 -= mq[2][3] * y[35]; mq[2] = *(const LAS f32x4*)(Mg + 3704);
            a0 -= mq[3][0] * x[36]; b0 -= mq[3][0] * y[36]; a1 -= mq[3][1] * x[37]; b1 -= mq[3][1] * y[37]; a0 -= mq[3][2] * x[38]; b0 -= mq[3][2] * y[38]; a1 -= mq[3][3] * x[39]; b1 -= mq[3][3] * y[39]; mq[3] = *(const LAS f32x4*)(Mg + 3712);
            a0 -= mq[4][0] * x[40]; b0 -= mq[4][0] * y[40]; a1 -= mq[4][1] * x[41]; b1 -= mq[4][1] * y[41]; a0 -= mq[4][2] * x[42]; b0 -= mq[4][2] * y[42]; a1 -= mq[4][3] * x[43]; b1 -= mq[4][3] * y[43]; mq[4] = *(const LAS f32x4*)(Mg + 3716);
            a0 -= mq[5][0] * x[44]; b0 -= mq[5][0] * y[44]; a1 -= mq[5][1] * x[45]; b1 -= mq[5][1] * y[45]; a0 -= mq[5][2] * x[46]; b0 -= mq[5][2] * y[46]; a1 -= mq[5][3] * x[47]; b1 -= mq[5][3] * y[47]; mq[5] = *(const LAS f32x4*)(Mg + 3720);
            a0 -= mq[0][0] * x[48]; b0 -= mq[0][0] * y[48]; a1 -= mq[0][1] * x[49]; b1 -= mq[0][1] * y[49]; a0 -= mq[0][2] * x[50]; b0 -= mq[0][2] * y[50]; a1 -= mq[0][3] * x[51]; b1 -= mq[0][3] * y[51]; mq[0] = *(const LAS f32x4*)(Mg + 3724);
            a0 -= mq[1][0] * x[52]; b0 -= mq[1][0] * y[52]; a1 -= mq[1][1] * x[53]; b1 -= mq[1][1] * y[53]; a0 -= mq[1][2] * x[54]; b0 -= mq[1][2] * y[54]; a1 -= mq[1][3] * x[55]; b1 -= mq[1][3] * y[55]; mq[1] = *(const LAS f32x4*)(Mg + 3728);
            a0 -= mq[2][0] * x[56]; b0 -= mq[2][0] * y[56]; x[57] = a0 + a1; y[57] = b0 + b1; up[7296] = x[57]; wp[7296] = f2bf(-y[57]); mq[2] = *(const LAS f32x4*)(Mg + 3732);
            { const float br = betg[58]; a0 = bf2f(*(const LAS bf16_t*)(lg + P5_VS + 15776 + c * 2)) * br; b0 = bf2f(*(const LAS bf16_t*)(lg + P5_KS + 15776 + c * 2)) * br * __expf(decg[58]); a1 = 0.f; b1 = 0.f; } a0 -= mq[3][0] * x[0]; b0 -= mq[3][0] * y[0]; a1 -= mq[3][1] * x[1]; b1 -= mq[3][1] * y[1]; a0 -= mq[3][2] * x[2]; b0 -= mq[3][2] * y[2]; a1 -= mq[3][3] * x[3]; b1 -= mq[3][3] * y[3]; mq[3] = *(const LAS f32x4*)(Mg + 3736);
            a0 -= mq[4][0] * x[4]; b0 -= mq[4][0] * y[4]; a1 -= mq[4][1] * x[5]; b1 -= mq[4][1] * y[5]; a0 -= mq[4][2] * x[6]; b0 -= mq[4][2] * y[6]; a1 -= mq[4][3] * x[7]; b1 -= mq[4][3] * y[7]; mq[4] = *(const LAS f32x4*)(Mg + 3740);
            a0 -= mq[5][0] * x[8]; b0 -= mq[5][0] * y[8]; a1 -= mq[5][1] * x[9]; b1 -= mq[5][1] * y[9]; a0 -= mq[5][2] * x[10]; b0 -= mq[5][2] * y[10]; a1 -= mq[5][3] * x[11]; b1 -= mq[5][3] * y[11]; mq[5] = *(const LAS f32x4*)(Mg + 3744);
            a0 -= mq[0][0] * x[12]; b0 -= mq[0][0] * y[12]; a1 -= mq[0][1] * x[13]; b1 -= mq[0][1] * y[13]; a0 -= mq[0][2] * x[14]; b0 -= mq[0][2] * y[14]; a1 -= mq[0][3] * x[15]; b1 -= mq[0][3] * y[15]; mq[0] = *(const LAS f32x4*)(Mg + 3748);
            a0 -= mq[1][0] * x[16]; b0 -= mq[1][0] * y[16]; a1 -= mq[1][1] * x[17]; b1 -= mq[1][1] * y[17]; a0 -= mq[1][2] * x[18]; b0 -= mq[1][2] * y[18]; a1 -= mq[1][3] * x[19]; b1 -= mq[1][3] * y[19]; mq[1] = *(const LAS f32x4*)(Mg + 3752);
            a0 -= mq[2][0] * x[20]; b0 -= mq[2][0] * y[20]; a1 -= mq[2][1] * x[21]; b1 -= mq[2][1] * y[21]; a0 -= mq[2][2] * x[22]; b0 -= mq[2][2] * y[22]; a1 -= mq[2][3] * x[23]; b1 -= mq[2][3] * y[23]; mq[2] = *(const LAS f32x4*)(Mg + 3756);
            a0 -= mq[3][0] * x[24]; b0 -= mq[3][0] * y[24]; a1 -= mq[3][1] * x[25]; b1 -= mq[3][1] * y[25]; a0 -= mq[3][2] * x[26]; b0 -= mq[3][2] * y[26]; a1 -= mq[3][3] * x[27]; b1 -= mq[3][3] * y[27]; mq[3] = *(const LAS f32x4*)(Mg + 3760);
            a0 -= mq[4][0] * x[28]; b0 -= mq[4][0] * y[28]; a1 -= mq[4][1] * x[29]; b1 -= mq[4][1] * y[29]; a0 -= mq[4][2] * x[30]; b0 -= mq[4][2] * y[30]; a1 -= mq[4][3] * x[31]; b1 -= mq[4][3] * y[31]; mq[4] = *(const LAS f32x4*)(Mg + 3764);
            a0 -= mq[5][0] * x[32]; b0 -= mq[5][0] * y[32]; a1 -= mq[5][1] * x[33]; b1 -= mq[5][1] * y[33]; a0 -= mq[5][2] * x[34]; b0 -= mq[5][2] * y[34]; a1 -= mq[5][3] * x[35]; b1 -= mq[5][3] * y[35]; mq[5] = *(const LAS f32x4*)(Mg + 3768);
            a0 -= mq[0][0] * x[36]; b0 -= mq[0][0] * y[36]; a1 -= mq[0][1] * x[37]; b1 -= mq[0][1] * y[37]; a0 -= mq[0][2] * x[38]; b0 -= mq[0][2] * y[38]; a1 -= mq[0][3] * x[39]; b1 -= mq[0][3] * y[39]; mq[0] = *(const LAS f32x4*)(Mg + 3776);
            a0 -= mq[1][0] * x[40]; b0 -= mq[1][0] * y[40]; a1 -= mq[1][1] * x[41]; b1 -= mq[1][1] * y[41]; a0 -= mq[1][2] * x[42]; b0 -= mq[1][2] * y[42]; a1 -= mq[1][3] * x[43]; b1 -= mq[1][3] * y[43]; mq[1] = *(const LAS f32x4*)(Mg + 3780);
            a0 -= mq[2][0] * x[44]; b0 -= mq[2][0] * y[44]; a1 -= mq[2][1] * x[45]; b1 -= mq[2][1] * y[45]; a0 -= mq[2][2] * x[46]; b0 -= mq[2][2] * y[46]; a1 -= mq[2][3] * x[47]; b1 -= mq[2][3] * y[47]; mq[2] = *(const LAS f32x4*)(Mg + 3784);
            a0 -= mq[3][0] * x[48]; b0 -= mq[3][0] * y[48]; a1 -= mq[3][1] * x[49]; b1 -= mq[3][1] * y[49]; a0 -= mq[3][2] * x[50]; b0 -= mq[3][2] * y[50]; a1 -= mq[3][3] * x[51]; b1 -= mq[3][3] * y[51]; mq[3] = *(const LAS f32x4*)(Mg + 3788);
            a0 -= mq[4][0] * x[52]; b0 -= mq[4][0] * y[52]; a1 -= mq[4][1] * x[53]; b1 -= mq[4][1] * y[53]; a0 -= mq[4][2] * x[54]; b0 -= mq[4][2] * y[54]; a1 -= mq[4][3] * x[55]; b1 -= mq[4][3] * y[55]; mq[4] = *(const LAS f32x4*)(Mg + 3792);
            a0 -= mq[5][0] * x[56]; b0 -= mq[5][0] * y[56]; a1 -= mq[5][1] * x[57]; b1 -= mq[5][1] * y[57]; x[58] = a0 + a1; y[58] = b0 + b1; up[7424] = x[58]; wp[7424] = f2bf(-y[58]); mq[5] = *(const LAS f32x4*)(Mg + 3796);
            { const float br = betg[59]; a0 = bf2f(*(const LAS bf16_t*)(lg + P5_VS + 16048 + c * 2)) * br; b0 = bf2f(*(const LAS bf16_t*)(lg + P5_KS + 16048 + c * 2)) * br * __expf(decg[59]); a1 = 0.f; b1 = 0.f; } a0 -= mq[0][0] * x[0]; b0 -= mq[0][0] * y[0]; a1 -= mq[0][1] * x[1]; b1 -= mq[0][1] * y[1]; a0 -= mq[0][2] * x[2]; b0 -= mq[0][2] * y[2]; a1 -= mq[0][3] * x[3]; b1 -= mq[0][3] * y[3]; mq[0] = *(const LAS f32x4*)(Mg + 3800);
            a0 -= mq[1][0] * x[4]; b0 -= mq[1][0] * y[4]; a1 -= mq[1][1] * x[5]; b1 -= mq[1][1] * y[5]; a0 -= mq[1][2] * x[6]; b0 -= mq[1][2] * y[6]; a1 -= mq[1][3] * x[7]; b1 -= mq[1][3] * y[7]; mq[1] = *(const LAS f32x4*)(Mg + 3804);
            a0 -= mq[2][0] * x[8]; b0 -= mq[2][0] * y[8]; a1 -= mq[2][1] * x[9]; b1 -= mq[2][1] * y[9]; a0 -= mq[2][2] * x[10]; b0 -= mq[2][2] * y[10]; a1 -= mq[2][3] * x[11]; b1 -= mq[2][3] * y[11]; mq[2] = *(const LAS f32x4*)(Mg + 3808);
            a0 -= mq[3][0] * x[12]; b0 -= mq[3][0] * y[12]; a1 -= mq[3][1] * x[13]; b1 -= mq[3][1] * y[13]; a0 -= mq[3][2] * x[14]; b0 -= mq[3][2] * y[14]; a1 -= mq[3][3] * x[15]; b1 -= mq[3][3] * y[15]; mq[3] = *(const LAS f32x4*)(Mg + 3812);
            a0 -= mq[4][0] * x[16]; b0 -= mq[4][0] * y[16]; a1 -= mq[4][1] * x[17]; b1 -= mq[4][1] * y[17]; a0 -= mq[4][2] * x[18]; b0 -= mq[4][2] * y[18]; a1 -= mq[4][3] * x[19]; b1 -= mq[4][3] * y[19]; mq[4] = *(const LAS f32x4*)(Mg + 3816);
            a0 -= mq[5][0] * x[20]; b0 -= mq[5][0] * y[20]; a1 -= mq[5][1] * x[21]; b1 -= mq[5][1] * y[21]; a0 -= mq[5][2] * x[22]; b0 -= mq[5][2] * y[22]; a1 -= mq[5][3] * x[23]; b1 -= mq[5][3] * y[23]; mq[5] = *(const LAS f32x4*)(Mg + 3820);
            a0 -= mq[0][0] * x[24]; b0 -= mq[0][0] * y[24]; a1 -= mq[0][1] * x[25]; b1 -= mq[0][1] * y[25]; a0 -= mq[0][2] * x[26]; b0 -= mq[0][2] * y[26]; a1 -= mq[0][3] * x[27]; b1 -= mq[0][3] * y[27]; mq[0] = *(const LAS f32x4*)(Mg + 3824);
            a0 -= mq[1][0] * x[28]; b0 -= mq[1][0] * y[28]; a1 -= mq[1][1] * x[29]; b1 -= mq[1][1] * y[29]; a0 -= mq[1][2] * x[30]; b0 -= mq[1][2] * y[30]; a1 -= mq[1][3] * x[31]; b1 -= mq[1][3] * y[31]; mq[1] = *(const LAS f32x4*)(Mg + 3828);
            a0 -= mq[2][0] * x[32]; b0 -= mq[2][0] * y[32]; a1 -= mq[2][1] * x[33]; b1 -= mq[2][1] * y[33]; a0 -= mq[2][2] * x[34]; b0 -= mq[2][2] * y[34]; a1 -= mq[2][3] * x[35]; b1 -= mq[2][3] * y[35]; mq[2] = *(const LAS f32x4*)(Mg + 3832);
            a0 -= mq[3][0] * x[36]; b0 -= mq[3][0] * y[36]; a1 -= mq[3][1] * x[37]; b1 -= mq[3][1] * y[37]; a0 -= mq[3][2] * x[38]; b0 -= mq[3][2] * y[38]; a1 -= mq[3][3] * x[39]; b1 -= mq[3][3] * y[39]; mq[3] = *(const LAS f32x4*)(Mg + 3840);
            a0 -= mq[4][0] * x[40]; b0 -= mq[4][0] * y[40]; a1 -= mq[4][1] * x[41]; b1 -= mq[4][1] * y[41]; a0 -= mq[4][2] * x[42]; b0 -= mq[4][2] * y[42]; a1 -= mq[4][3] * x[43]; b1 -= mq[4][3] * y[43]; mq[4] = *(const LAS f32x4*)(Mg + 3844);
            a0 -= mq[5][0] * x[44]; b0 -= mq[5][0] * y[44]; a1 -= mq[5][1] * x[45]; b1 -= mq[5][1] * y[45]; a0 -= mq[5][2] * x[46]; b0 -= mq[5][2] * y[46]; a1 -= mq[5][3] * x[47]; b1 -= mq[5][3] * y[47]; mq[5] = *(const LAS f32x4*)(Mg + 3848);
            a0 -= mq[0][0] * x[48]; b0 -= mq[0][0] * y[48]; a1 -= mq[0][1] * x[49]; b1 -= mq[0][1] * y[49]; a0 -= mq[0][2] * x[50]; b0 -= mq[0][2] * y[50]; a1 -= mq[0][3] * x[51]; b1 -= mq[0][3] * y[51]; mq[0] = *(const LAS f32x4*)(Mg + 3852);
            a0 -= mq[1][0] * x[52]; b0 -= mq[1][0] * y[52]; a1 -= mq[1][1] * x[53]; b1 -= mq[1][1] * y[53]; a0 -= mq[1][2] * x[54]; b0 -= mq[1][2] * y[54]; a1 -= mq[1][3] * x[55]; b1 -= mq[1][3] * y[55]; mq[1] = *(const LAS f32x4*)(Mg + 3856);
            a0 -= mq[2][0] * x[56]; b0 -= mq[2][0] * y[56]; a1 -= mq[2][1] * x[57]; b1 -= mq[2][1] * y[57]; a0 -= mq[2][2] * x[58]; b0 -= mq[2][2] * y[58]; x[59] = a0 + a1; y[59] = b0 + b1; up[7552] = x[59]; wp[7552] = f2bf(-y[59]); mq[2] = *(const LAS f32x4*)(Mg + 3860);
            { const float br = betg[60]; a0 = bf2f(*(const LAS bf16_t*)(lg + P5_VS + 16320 + c * 2)) * br; b0 = bf2f(*(const LAS bf16_t*)(lg + P5_KS + 16320 + c * 2)) * br * __expf(decg[60]); a1 = 0.f; b1 = 0.f; } a0 -= mq[3][0] * x[0]; b0 -= mq[3][0] * y[0]; a1 -= mq[3][1] * x[1]; b1 -= mq[3][1] * y[1]; a0 -= mq[3][2] * x[2]; b0 -= mq[3][2] * y[2]; a1 -= mq[3][3] * x[3]; b1 -= mq[3][3] * y[3]; mq[3] = *(const LAS f32x4*)(Mg + 3864);
            a0 -= mq[4][0] * x[4]; b0 -= mq[4][0] * y[4]; a1 -= mq[4][1] * x[5]; b1 -= mq[4][1] * y[5]; a0 -= mq[4][2] * x[6]; b0 -= mq[4][2] * y[6]; a1 -= mq[4][3] * x[7]; b1 -= mq[4][3] * y[7]; mq[4] = *(const LAS f32x4*)(Mg + 3868);
            a0 -= mq[5][0] * x[8]; b0 -= mq[5][0] * y[8]; a1 -= mq[5][1] * x[9]; b1 -= mq[5][1] * y[9]; a0 -= mq[5][2] * x[10]; b0 -= mq[5][2] * y[10]; a1 -= mq[5][3] * x[11]; b1 -= mq[5][3] * y[11]; mq[5] = *(const LAS f32x4*)(Mg + 3872);
            a0 -= mq[0][0] * x[12]; b0 -= mq[0][0] * y[12]; a1 -= mq[0][1] * x[13]; b1 -= mq[0][1] * y[13]; a0 -= mq[0][2] * x[14]; b0 -= mq[0][2] * y[14]; a1 -= mq[0][3] * x[15]; b1 -= mq[0][3] * y[15]; mq[0] = *(const LAS f32x4*)(Mg + 3876);
            a0 -= mq[1][0] * x[16]; b0 -= mq[1][0] * y[16]; a1 -= mq[1][1] * x[17]; b1 -= mq[1][1] * y[17]; a0 -= mq[1][2] * x[18]; b0 -= mq[1][2] * y[18]; a1 -= mq[1][3] * x[19]; b1 -= mq[1][3] * y[19]; mq[1] = *(const LAS f32x4*)(Mg + 3880);
            a0 -= mq[2][0] * x[20]; b0 -= mq[2][0] * y[20]; a1 -= mq[2][1] * x[21]; b1 -= mq[2][1] * y[21]; a0 -= mq[2][2] * x[22]; b0 -= mq[2][2] * y[22]; a1 -= mq[2][3] * x[23]; b1 -= mq[2][3] * y[23]; mq[2] = *(const LAS f32x4*)(Mg + 3884);
            a0 -= mq[3][0] * x[24]; b0 -= mq[3][0] * y[24]; a1 -= mq[3][1] * x[25]; b1 -= mq[3][1] * y[25]; a0 -= mq[3][2] * x[26]; b0 -= mq[3][2] * y[26]; a1 -= mq[3][3] * x[27]; b1 -= mq[3][3] * y[27]; mq[3] = *(const LAS f32x4*)(Mg + 3888);
            a0 -= mq[4][0] * x[28]; b0 -= mq[4][0] * y[28]; a1 -= mq[4][1] * x[29]; b1 -= mq[4][1] * y[29]; a0 -= mq[4][2] * x[30]; b0 -= mq[4][2] * y[30]; a1 -= mq[4][3] * x[31]; b1 -= mq[4][3] * y[31]; mq[4] = *(const LAS f32x4*)(Mg + 3892);
            a0 -= mq[5][0] * x[32]; b0 -= mq[5][0] * y[32]; a1 -= mq[5][1] * x[33]; b1 -= mq[5][1] * y[33]; a0 -= mq[5][2] * x[34]; b0 -= mq[5][2] * y[34]; a1 -= mq[5][3] * x[35]; b1 -= mq[5][3] * y[35]; mq[5] = *(const LAS f32x4*)(Mg + 3896);
            a0 -= mq[0][0] * x[36]; b0 -= mq[0][0] * y[36]; a1 -= mq[0][1] * x[37]; b1 -= mq[0][1] * y[37]; a0 -= mq[0][2] * x[38]; b0 -= mq[0][2] * y[38]; a1 -= mq[0][3] * x[39]; b1 -= mq[0][3] * y[39]; mq[0] = *(const LAS f32x4*)(Mg + 3904);
            a0 -= mq[1][0] * x[40]; b0 -= mq[1][0] * y[40]; a1 -= mq[1][1] * x[41]; b1 -= mq[1][1] * y[41]; a0 -= mq[1][2] * x[42]; b0 -= mq[1][2] * y[42]; a1 -= mq[1][3] * x[43]; b1 -= mq[1][3] * y[43]; mq[1] = *(const LAS f32x4*)(Mg + 3908);
            a0 -= mq[2][0] * x[44]; b0 -= mq[2][0] * y[44]; a1 -= mq[2][1] * x[45]; b1 -= mq[2][1] * y[45]; a0 -= mq[2][2] * x[46]; b0 -= mq[2][2] * y[46]; a1 -= mq[2][3] * x[47]; b1 -= mq[2][3] * y[47]; mq[2] = *(const LAS f32x4*)(Mg + 3912);
            a0 -= mq[3][0] * x[48]; b0 -= mq[3][0] * y[48]; a1 -= mq[3][1] * x[49]; b1 -= mq[3][1] * y[49]; a0 -= mq[3][2] * x[50]; b0 -= mq[3][2] * y[50]; a1 -= mq[3][3] * x[51]; b1 -= mq[3][3] * y[51]; mq[3] = *(const LAS f32x4*)(Mg + 3916);
            a0 -= mq[4][0] * x[52]; b0 -= mq[4][0] * y[52]; a1 -= mq[4][1] * x[53]; b1 -= mq[4][1] * y[53]; a0 -= mq[4][2] * x[54]; b0 -= mq[4][2] * y[54]; a1 -= mq[4][3] * x[55]; b1 -= mq[4][3] * y[55]; mq[4] = *(const LAS f32x4*)(Mg + 3920);
            a0 -= mq[5][0] * x[56]; b0 -= mq[5][0] * y[56]; a1 -= mq[5][1] * x[57]; b1 -= mq[5][1] * y[57]; a0 -= mq[5][2] * x[58]; b0 -= mq[5][2] * y[58]; a1 -= mq[5][3] * x[59]; b1 -= mq[5][3] * y[59]; x[60] = a0 + a1; y[60] = b0 + b1; up[7680] = x[60]; wp[7680] = f2bf(-y[60]); mq[5] = *(const LAS f32x4*)(Mg + 3924);
            { const float br = betg[61]; a0 = bf2f(*(const LAS bf16_t*)(lg + P5_VS + 16592 + c * 2)) * br; b0 = bf2f(*(const LAS bf16_t*)(lg + P5_KS + 16592 + c * 2)) * br * __expf(decg[61]); a1 = 0.f; b1 = 0.f; } a0 -= mq[0][0] * x[0]; b0 -= mq[0][0] * y[0]; a1 -= mq[0][1] * x[1]; b1 -= mq[0][1] * y[1]; a0 -= mq[0][2] * x[2]; b0 -= mq[0][2] * y[2]; a1 -= mq[0][3] * x[3]; b1 -= mq[0][3] * y[3]; mq[0] = *(const LAS f32x4*)(Mg + 3928);
            a0 -= mq[1][0] * x[4]; b0 -= mq[1][0] * y[4]; a1 -= mq[1][1] * x[5]; b1 -= mq[1][1] * y[5]; a0 -= mq[1][2] * x[6]; b0 -= mq[1][2] * y[6]; a1 -= mq[1][3] * x[7]; b1 -= mq[1][3] * y[7]; mq[1] = *(const LAS f32x4*)(Mg + 3932);
            a0 -= mq[2][0] * x[8]; b0 -= mq[2][0] * y[8]; a1 -= mq[2][1] * x[9]; b1 -= mq[2][1] * y[9]; a0 -= mq[2][2] * x[10]; b0 -= mq[2][2] * y[10]; a1 -= mq[2][3] * x[11]; b1 -= mq[2][3] * y[11]; mq[2] = *(const LAS f32x4*)(Mg + 3936);
            a0 -= mq[3][0] * x[12]; b0 -= mq[3][0] * y[12]; a1 -= mq[3][1] * x[13]; b1 -= mq[3][1] * y[13]; a0 -= mq[3][2] * x[14]; b0 -= mq[3][2] * y[14]; a1 -= mq[3][3] * x[15]; b1 -= mq[3][3] * y[15]; mq[3] = *(const LAS f32x4*)(Mg + 3940);
            a0 -= mq[4][0] * x[16]; b0 -= mq[4][0] * y[16]; a1 -= mq[4][1] * x[17]; b1 -= mq[4][1] * y[17]; a0 -= mq[4][2] * x[18]; b0 -= mq[4][2] * y[18]; a1 -= mq[4][3] * x[19]; b1 -= mq[4][3] * y[19]; mq[4] = *(const LAS f32x4*)(Mg + 3944);
            a0 -= mq[5][0] * x[20]; b0 -= mq[5][0] * y[20]; a1 -= mq[5][1] * x[21]; b1 -= mq[5][1] * y[21]; a0 -= mq[5][2] * x[22]; b0 -= mq[5][2] * y[22]; a1 -= mq[5][3] * x[23]; b1 -= mq[5][3] * y[23]; mq[5] = *(const LAS f32x4*)(Mg + 3948);
            a0 -= mq[0][0] * x[24]; b0 -= mq[0][0] * y[24]; a1 -= mq[0][1] * x[25]; b1 -= mq[0][1] * y[25]; a0 -= mq[0][2] * x[26]; b0 -= mq[0][2] * y[26]; a1 -= mq[0][3] * x[27]; b1 -= mq[0][3] * y[27]; mq[0] = *(const LAS f32x4*)(Mg + 3952);
            a0 -= mq[1][0] * x[28]; b0 -= mq[1][0] * y[28]; a1 -= mq[1][1] * x[29]; b1 -= mq[1][1] * y[29]; a0 -= mq[1][2] * x[30]; b0 -= mq[1][2] * y[30]; a1 -= mq[1][3] * x[31]; b1 -= mq[1][3] * y[31]; mq[1] = *(const LAS f32x4*)(Mg + 3956);
            a0 -= mq[2][0] * x[32]; b0 -= mq[2][0] * y[32]; a1 -= mq[2][1] * x[33]; b1 -= mq[2][1] * y[33]; a0 -= mq[2][2] * x[34]; b0 -= mq[2][2] * y[34]; a1 -= mq[2][3] * x[35]; b1 -= mq[2][3] * y[35]; mq[2] = *(const LAS f32x4*)(Mg + 3960);
            a0 -= mq[3][0] * x[36]; b0 -= mq[3][0] * y[36]; a1 -= mq[3][1] * x[37]; b1 -= mq[3][1] * y[37]; a0 -= mq[3][2] * x[38]; b0 -= mq[3][2] * y[38]; a1 -= mq[3][3] * x[39]; b1 -= mq[3][3] * y[39]; mq[3] = *(const LAS f32x4*)(Mg + 3964);
            a0 -= mq[4][0] * x[40]; b0 -= mq[4][0] * y[40]; a1 -= mq[4][1] * x[41]; b1 -= mq[4][1] * y[41]; a0 -= mq[4][2] * x[42]; b0 -= mq[4][2] * y[42]; a1 -= mq[4][3] * x[43]; b1 -= mq[4][3] * y[43]; mq[4] = *(const LAS f32x4*)(Mg + 3968);
            a0 -= mq[5][0] * x[44]; b0 -= mq[5][0] * y[44]; a1 -= mq[5][1] * x[45]; b1 -= mq[5][1] * y[45]; a0 -= mq[5][2] * x[46]; b0 -= mq[5][2] * y[46]; a1 -= mq[5][3] * x[47]; b1 -= mq[5][3] * y[47]; mq[5] = *(const LAS f32x4*)(Mg + 3972);
            a0 -= mq[0][0] * x[48]; b0 -= mq[0][0] * y[48]; a1 -= mq[0][1] * x[49]; b1 -= mq[0][1] * y[49]; a0 -= mq[0][2] * x[50]; b0 -= mq[0][2] * y[50]; a1 -= mq[0][3] * x[51]; b1 -= mq[0][3] * y[51]; mq[0] = *(const LAS f32x4*)(Mg + 3976);
            a0 -= mq[1][0] * x[52]; b0 -= mq[1][0] * y[52]; a1 -= mq[1][1] * x[53]; b1 -= mq[1][1] * y[53]; a0 -= mq[1][2] * x[54]; b0 -= mq[1][2] * y[54]; a1 -= mq[1][3] * x[55]; b1 -= mq[1][3] * y[55]; mq[1] = *(const LAS f32x4*)(Mg + 3980);
            a0 -= mq[2][0] * x[56]; b0 -= mq[2][0] * y[56]; a1 -= mq[2][1] * x[57]; b1 -= mq[2][1] * y[57]; a0 -= mq[2][2] * x[58]; b0 -= mq[2][2] * y[58]; a1 -= mq[2][3] * x[59]; b1 -= mq[2][3] * y[59]; mq[2] = *(const LAS f32x4*)(Mg + 3984);
            a0 -= mq[3][0] * x[60]; b0 -= mq[3][0] * y[60]; x[61] = a0 + a1; y[61] = b0 + b1; up[7808] = x[61]; wp[7808] = f2bf(-y[61]); mq[3] = *(const LAS f32x4*)(Mg + 3988);
            { const float br = betg[62]; a0 = bf2f(*(const LAS bf16_t*)(lg + P5_VS + 16864 + c * 2)) * br; b0 = bf2f(*(const LAS bf16_t*)(lg + P5_KS + 16864 + c * 2)) * br * __expf(decg[62]); a1 = 0.f; b1 = 0.f; } a0 -= mq[4][0] * x[0]; b0 -= mq[4][0] * y[0]; a1 -= mq[4][1] * x[1]; b1 -= mq[4][1] * y[1]; a0 -= mq[4][2] * x[2]; b0 -= mq[4][2] * y[2]; a1 -= mq[4][3] * x[3]; b1 -= mq[4][3] * y[3]; mq[4] = *(const LAS f32x4*)(Mg + 3992);
            a0 -= mq[5][0] * x[4]; b0 -= mq[5][0] * y[4]; a1 -= mq[5][1] * x[5]; b1 -= mq[5][1] * y[5]; a0 -= mq[5][2] * x[6]; b0 -= mq[5][2] * y[6]; a1 -= mq[5][3] * x[7]; b1 -= mq[5][3] * y[7]; mq[5] = *(const LAS f32x4*)(Mg + 3996);
            a0 -= mq[0][0] * x[8]; b0 -= mq[0][0] * y[8]; a1 -= mq[0][1] * x[9]; b1 -= mq[0][1] * y[9]; a0 -= mq[0][2] * x[10]; b0 -= mq[0][2] * y[10]; a1 -= mq[0][3] * x[11]; b1 -= mq[0][3] * y[11]; mq[0] = *(const LAS f32x4*)(Mg + 4000);
            a0 -= mq[1][0] * x[12]; b0 -= mq[1][0] * y[12]; a1 -= mq[1][1] * x[13]; b1 -= mq[1][1] * y[13]; a0 -= mq[1][2] * x[14]; b0 -= mq[1][2] * y[14]; a1 -= mq[1][3] * x[15]; b1 -= mq[1][3] * y[15]; mq[1] = *(const LAS f32x4*)(Mg + 4004);
            a0 -= mq[2][0] * x[16]; b0 -= mq[2][0] * y[16]; a1 -= mq[2][1] * x[17]; b1 -= mq[2][1] * y[17]; a0 -= mq[2][2] * x[18]; b0 -= mq[2][2] * y[18]; a1 -= mq[2][3] * x[19]; b1 -= mq[2][3] * y[19]; mq[2] = *(const LAS f32x4*)(Mg + 4008);
            a0 -= mq[3][0] * x[20]; b0 -= mq[3][0] * y[20]; a1 -= mq[3][1] * x[21]; b1 -= mq[3][1] * y[21]; a0 -= mq[3][2] * x[22]; b0 -= mq[3][2] * y[22]; a1 -= mq[3][3] * x[23]; b1 -= mq[3][3] * y[23]; mq[3] = *(const LAS f32x4*)(Mg + 4012);
            a0 -= mq[4][0] * x[24]; b0 -= mq[4][0] * y[24]; a1 -= mq[4][1] * x[25]; b1 -= mq[4][1] * y[25]; a0 -= mq[4][2] * x[26]; b0 -= mq[4][2] * y[26]; a1 -= mq[4][3] * x[27]; b1 -= mq[4][3] * y[27]; mq[4] = *(const LAS f32x4*)(Mg + 4016);
            a0 -= mq[5][0] * x[28]; b0 -= mq[5][0] * y[28]; a1 -= mq[5][1] * x[29]; b1 -= mq[5][1] * y[29]; a0 -= mq[5][2] * x[30]; b0 -= mq[5][2] * y[30]; a1 -= mq[5][3] * x[31]; b1 -= mq[5][3] * y[31]; mq[5] = *(const LAS f32x4*)(Mg + 4020);
            a0 -= mq[0][0] * x[32]; b0 -= mq[0][0] * y[32]; a1 -= mq[0][1] * x[33]; b1 -= mq[0][1] * y[33]; a0 -= mq[0][2] * x[34]; b0 -= mq[0][2] * y[34]; a1 -= mq[0][3] * x[35]; b1 -= mq[0][3] * y[35]; mq[0] = *(const LAS f32x4*)(Mg + 4024);
            a0 -= mq[1][0] * x[36]; b0 -= mq[1][0] * y[36]; a1 -= mq[1][1] * x[37]; b1 -= mq[1][1] * y[37]; a0 -= mq[1][2] * x[38]; b0 -= mq[1][2] * y[38]; a1 -= mq[1][3] * x[39]; b1 -= mq[1][3] * y[39]; mq[1] = *(const LAS f32x4*)(Mg + 4028);
            a0 -= mq[2][0] * x[40]; b0 -= mq[2][0] * y[40]; a1 -= mq[2][1] * x[41]; b1 -= mq[2][1] * y[41]; a0 -= mq[2][2] * x[42]; b0 -= mq[2][2] * y[42]; a1 -= mq[2][3] * x[43]; b1 -= mq[2][3] * y[43]; mq[2] = *(const LAS f32x4*)(Mg + 4032);
            a0 -= mq[3][0] * x[44]; b0 -= mq[3][0] * y[44]; a1 -= mq[3][1] * x[45]; b1 -= mq[3][1] * y[45]; a0 -= mq[3][2] * x[46]; b0 -= mq[3][2] * y[46]; a1 -= mq[3][3] * x[47]; b1 -= mq[3][3] * y[47]; mq[3] = *(const LAS f32x4*)(Mg + 4036);
            a0 -= mq[4][0] * x[48]; b0 -= mq[4][0] * y[48]; a1 -= mq[4][1] * x[49]; b1 -= mq[4][1] * y[49]; a0 -= mq[4][2] * x[50]; b0 -= mq[4][2] * y[50]; a1 -= mq[4][3] * x[51]; b1 -= mq[4][3] * y[51]; mq[4] = *(const LAS f32x4*)(Mg + 4040);
            a0 -= mq[5][0] * x[52]; b0 -= mq[5][0] * y[52]; a1 -= mq[5][1] * x[53]; b1 -= mq[5][1] * y[53]; a0 -= mq[5][2] * x[54]; b0 -= mq[5][2] * y[54]; a1 -= mq[5][3] * x[55]; b1 -= mq[5][3] * y[55]; mq[5] = *(const LAS f32x4*)(Mg + 4044);
            a0 -= mq[0][0] * x[56]; b0 -= mq[0][0] * y[56]; a1 -= mq[0][1] * x[57]; b1 -= mq[0][1] * y[57]; a0 -= mq[0][2] * x[58]; b0 -= mq[0][2] * y[58]; a1 -= mq[0][3] * x[59]; b1 -= mq[0][3] * y[59]; mq[0] = *(const LAS f32x4*)(Mg + 4048);
            a0 -= mq[1][0] * x[60]; b0 -= mq[1][0] * y[60]; a1 -= mq[1][1] * x[61]; b1 -= mq[1][1] * y[61]; x[62] = a0 + a1; y[62] = b0 + b1; up[7936] = x[62]; wp[7936] = f2bf(-y[62]); mq[1] = *(const LAS f32x4*)(Mg + 4052);
            { const float br = betg[63]; a0 = bf2f(*(const LAS bf16_t*)(lg + P5_VS + 17136 + c * 2)) * br; b0 = bf2f(*(const LAS bf16_t*)(lg + P5_KS + 17136 + c * 2)) * br * __expf(decg[63]); a1 = 0.f; b1 = 0.f; } a0 -= mq[2][0] * x[0]; b0 -= mq[2][0] * y[0]; a1 -= mq[2][1] * x[1]; b1 -= mq[2][1] * y[1]; a0 -= mq[2][2] * x[2]; b0 -= mq[2][2] * y[2]; a1 -= mq[2][3] * x[3]; b1 -= mq[2][3] * y[3]; mq[2] = *(const LAS f32x4*)(Mg + 4056);
            a0 -= mq[3][0] * x[4]; b0 -= mq[3][0] * y[4]; a1 -= mq[3][1] * x[5]; b1 -= mq[3][1] * y[5]; a0 -= mq[3][2] * x[6]; b0 -= mq[3][2] * y[6]; a1 -= mq[3][3] * x[7]; b1 -= mq[3][3] * y[7]; mq[3] = *(const LAS f32x4*)(Mg + 4060);
            a0 -= mq[4][0] * x[8]; b0 -= mq[4][0] * y[8]; a1 -= mq[4][1] * x[9]; b1 -= mq[4][1] * y[9]; a0 -= mq[4][2] * x[10]; b0 -= mq[4][2] * y[10]; a1 -= mq[4][3] * x[11]; b1 -= mq[4][3] * y[11]; mq[4] = *(const LAS f32x4*)(Mg + 4064);
            a0 -= mq[5][0] * x[12]; b0 -= mq[5][0] * y[12]; a1 -= mq[5][1] * x[13]; b1 -= mq[5][1] * y[13]; a0 -= mq[5][2] * x[14]; b0 -= mq[5][2] * y[14]; a1 -= mq[5][3] * x[15]; b1 -= mq[5][3] * y[15]; mq[5] = *(const LAS f32x4*)(Mg + 4068);
            a0 -= mq[0][0] * x[16]; b0 -= mq[0][0] * y[16]; a1 -= mq[0][1] * x[17]; b1 -= mq[0][1] * y[17]; a0 -= mq[0][2] * x[18]; b0 -= mq[0][2] * y[18]; a1 -= mq[0][3] * x[19]; b1 -= mq[0][3] * y[19]; mq[0] = *(const LAS f32x4*)(Mg + 4072);
            a0 -= mq[1][0] * x[20]; b0 -= mq[1][0] * y[20]; a1 -= mq[1][1] * x[21]; b1 -= mq[1][1] * y[21]; a0 -= mq[1][2] * x[22]; b0 -= mq[1][2] * y[22]; a1 -= mq[1][3] * x[23]; b1 -= mq[1][3] * y[23]; mq[1] = *(const LAS f32x4*)(Mg + 4076);
            a0 -= mq[2][0] * x[24]; b0 -= mq[2][0] * y[24]; a1 -= mq[2][1] * x[25]; b1 -= mq[2][1] * y[25]; a0 -= mq[2][2] * x[26]; b0 -= mq[2][2] * y[26]; a1 -= mq[2][3] * x[27]; b1 -= mq[2][3] * y[27]; mq[2] = *(const LAS f32x4*)(Mg + 4080);
            a0 -= mq[3][0] * x[28]; b0 -= mq[3][0] * y[28]; a1 -= mq[3][1] * x[29]; b1 -= mq[3][1] * y[29]; a0 -= mq[3][2] * x[30]; b0 -= mq[3][2] * y[30]; a1 -= mq[3][3] * x[31]; b1 -= mq[3][3] * y[31]; mq[3] = *(const LAS f32x4*)(Mg + 4084);
            a0 -= mq[4][0] * x[32]; b0 -= mq[4][0] * y[32]; a1 -= mq[4][1] * x[33]; b1 -= mq[4][1] * y[33]; a0 -= mq[4][2] * x[34]; b0 -= mq[4][2] * y[34]; a1 -= mq[4][3] * x[35]; b1 -= mq[4][3] * y[35]; mq[4] = *(const LAS f32x4*)(Mg + 4088);
            a0 -= mq[5][0] * x[36]; b0 -= mq[5][0] * y[36]; a1 -= mq[5][1] * x[37]; b1 -= mq[5][1] * y[37]; a0 -= mq[5][2] * x[38]; b0 -= mq[5][2] * y[38]; a1 -= mq[5][3] * x[39]; b1 -= mq[5][3] * y[39]; mq[5] = *(const LAS f32x4*)(Mg + 4092);
            a0 -= mq[0][0] * x[40]; b0 -= mq[0][0] * y[40]; a1 -= mq[0][1] * x[41]; b1 -= mq[0][1] * y[41]; a0 -= mq[0][2] * x[42]; b0 -= mq[0][2] * y[42]; a1 -= mq[0][3] * x[43]; b1 -= mq[0][3] * y[43];
            a0 -= mq[1][0] * x[44]; b0 -= mq[1][0] * y[44]; a1 -= mq[1][1] * x[45]; b1 -= mq[1][1] * y[45]; a0 -= mq[1][2] * x[46]; b0 -= mq[1][2] * y[46]; a1 -= mq[1][3] * x[47]; b1 -= mq[1][3] * y[47];
            a0 -= mq[2][0] * x[48]; b0 -= mq[2][0] * y[48]; a1 -= mq[2][1] * x[49]; b1 -= mq[2][1] * y[49]; a0 -= mq[2][2] * x[50]; b0 -= mq[2][2] * y[50]; a1 -= mq[2][3] * x[51]; b1 -= mq[2][3] * y[51];
            a0 -= mq[3][0] * x[52]; b0 -= mq[3][0] * y[52]; a1 -= mq[3][1] * x[53]; b1 -= mq[3][1] * y[53]; a0 -= mq[3][2] * x[54]; b0 -= mq[3][2] * y[54]; a1 -= mq[3][3] * x[55]; b1 -= mq[3][3] * y[55];
            a0 -= mq[4][0] * x[56]; b0 -= mq[4][0] * y[56]; a1 -= mq[4][1] * x[57]; b1 -= mq[4][1] * y[57]; a0 -= mq[4][2] * x[58]; b0 -= mq[4][2] * y[58]; a1 -= mq[4][3] * x[59]; b1 -= mq[4][3] * y[59];
            a0 -= mq[5][0] * x[60]; b0 -= mq[5][0] * y[60]; a1 -= mq[5][1] * x[61]; b1 -= mq[5][1] * y[61]; a0 -= mq[5][2] * x[62]; b0 -= mq[5][2] * y[62]; x[63] = a0 + a1; y[63] = b0 + b1; up[8064] = x[63]; wp[8064] = f2bf(-y[63]);
        } else {
            const int g2 = (w8 - 4) >> 1, tt = ((w8 - 4) & 1) * 64 + lane; const int item2 = it0 + g2;
            LAS unsigned char* lg = lds0 + g2 * P5_GRP; LAS float* decg = (LAS float*)(lg + P5_DEC);
            const float lastg = decg[63];
#pragma unroll
            for (int i = 0; i < 8; ++i) { const int vid = tt + 128 * i, r = vid >> 4, d0 = (vid & 15) * 8; float f[8]; unpack8(*(const LAS u32x4*)(lg + P5_QS + r * 272 + d0 * 2), f);
                const float e = scale * __expf(decg[r]);
#pragma unroll
                for (int q = 0; q < 8; ++q) f[q] *= e;
                *(u32x4*)(qd + (size_t)item2 * 8192 + r * 128 + d0) = pack8(f); }
#pragma unroll
            for (int i = 0; i < 8; ++i) { const int vid = tt + 128 * i, d = vid >> 3, rg = (vid & 7) * 8; float f[8];
#pragma unroll
                for (int q = 0; q < 8; ++q) f[q] = bf2f(*(const LAS bf16_t*)(lg + P5_KS + (rg + q) * 272 + d * 2)) * __expf(lastg - decg[rg + q]);
                *(u32x4*)(kt + (size_t)item2 * 8192 + d * 64 + rg) = pack8(f); }
            if (tt == 0) cdv[item2] = __expf(lastg);
        }
    }
    __syncthreads();
}

constexpr int SB_WD = 0, SB_QD = 17408, SB_KT = 34816, SB_QK = 53248, SB_UB = 62464, SB_SIZE = 66560;
constexpr int SC_ST = 2 * SB_SIZE, SC_UT = SC_ST + 4352, SC_END = SC_UT + 2304;
static_assert(SC_END <= LDS_BYTES, "lds");
__device__ __forceinline__ void scan_phase(const Params& p, int bid, int nblk, LAS unsigned char* lds) {
    const int tid = threadIdx.x, lane = tid & 63, wid = __builtin_amdgcn_readfirstlane(tid >> 6), fr = lane & 15, fq = lane >> 4;
    const bf16_t* wdc = (const bf16_t*)(p.ws + WS_WDC); const bf16_t* qd = (const bf16_t*)(p.ws + WS_QD); const bf16_t* kt = (const bf16_t*)(p.ws + WS_KT); const bf16_t* qk = (const bf16_t*)(p.ws + WS_QK);
    const float* cdv = (const float*)(p.ws + WS_CD); const float* ub = p.out + OS_UB; float* obuf = p.out + OS_O;
    for (int item = bid; item < 256; item += nblk) {
        const int xcd = item & 7, iq = item >> 3, bh = xcd * 4 + (iq >> 3), sl = iq & 7, h = bh & 7, b = bh >> 3;
        u32x4 r_wd[2], r_qd[2], r_kt[2], r_qk, r_ub;
        auto gload = [&](int n) {
            const size_t it = (size_t)(bh * 32 + n);
#pragma unroll
            for (int i = 0; i < 2; ++i) { const int ch = tid + 512 * i; r_wd[i] = *(const u32x4*)(wdc + it * 8192 + ch * 8); r_qd[i] = *(const u32x4*)(qd + it * 8192 + ch * 8); r_kt[i] = *(const u32x4*)(kt + it * 8192 + ch * 8); }
            r_qk = *(const u32x4*)(qk + it * 4096 + tid * 8);
            if (tid < 256) r_ub = *(const u32x4*)(ub + it * 8192 + (tid >> 2) * 128 + sl * 16 + (tid & 3) * 4);
        };
        auto lstore = [&](int buf) {
            LAS unsigned char* B = lds + buf * SB_SIZE;
#pragma unroll
            for (int i = 0; i < 2; ++i) { const int ch = tid + 512 * i; const int r = ch >> 4, c8 = (ch & 15) * 8; *(LAS u32x4*)(B + SB_WD + r * 272 + c8 * 2) = r_wd[i]; *(LAS u32x4*)(B + SB_QD + r * 272 + c8 * 2) = r_qd[i];
                const int d = ch >> 3, t8 = (ch & 7) * 8; *(LAS u32x4*)(B + SB_KT + d * 144 + t8 * 2) = r_kt[i]; }
            { const int r = tid >> 3, s8 = (tid & 7) * 8; *(LAS u32x4*)(B + SB_QK + r * 144 + s8 * 2) = r_qk; }
            if (tid < 256) *(LAS u32x4*)(B + SB_UB + (tid >> 2) * 64 + (tid & 3) * 16) = r_ub;
        };
        __syncthreads();
        gload(0);
        for (int i = tid; i < 4352 / 4; i += 512) *(LAS unsigned*)(lds + SC_ST + i * 4) = 0u;
        lstore(0);
        f32x4 sacc = (f32x4){0.f, 0.f, 0.f, 0.f};
        __syncthreads();
        for (int n = 0; n < 32; ++n) {
            const int cur = n & 1; LAS unsigned char* B = lds + cur * SB_SIZE;
            if (n + 1 < 32) gload(n + 1);
            const float cd = cdv[bh * 32 + n];
            f32x4 acc;
            const int tw = wid & 3;
            if (wid < 4) {
#pragma unroll
                for (int j = 0; j < 4; ++j) acc[j] = *(const LAS float*)(B + SB_UB + ((tw * 16 + fq * 4 + j) * 16 + fr) * 4);
#pragma unroll
                for (int kk = 0; kk < 4; ++kk) { const bf16x8 a = *(const LAS bf16x8*)(B + SB_WD + (tw * 16 + fr) * 272 + (kk * 32 + fq * 8) * 2); const bf16x8 bb = *(const LAS bf16x8*)(lds + SC_ST + fr * 272 + (kk * 32 + fq * 8) * 2);
                    acc = __builtin_amdgcn_mfma_f32_16x16x32_bf16(a, bb, acc, 0, 0, 0); }
                u32x2 w; w.x = pk2(acc[0], acc[1]); w.y = pk2(acc[2], acc[3]);
                *(LAS u32x2*)(lds + SC_UT + fr * 144 + (tw * 16 + fq * 4) * 2) = w;
            } else {
                acc = (f32x4){0.f, 0.f, 0.f, 0.f};
#pragma unroll
                for (int kk = 0; kk < 4; ++kk) { const bf16x8 a = *(const LAS bf16x8*)(B + SB_QD + (tw * 16 + fr) * 272 + (kk * 32 + fq * 8) * 2); const bf16x8 bb = *(const LAS bf16x8*)(lds + SC_ST + fr * 272 + (kk * 32 + fq * 8) * 2);
                    acc = __builtin_amdgcn_mfma_f32_16x16x32_bf16(a, bb, acc, 0, 0, 0); }
            }
            __syncthreads();
            sacc *= cd;
#pragma unroll
            for (int kk = 0; kk < 2; ++kk) { const bf16x8 a = *(const LAS bf16x8*)(B + SB_KT + (wid * 16 + fr) * 144 + (kk * 32 + fq * 8) * 2); const bf16x8 bb = *(const LAS bf16x8*)(lds + SC_UT + fr * 144 + (kk * 32 + fq * 8) * 2);
                sacc = __builtin_amdgcn_mfma_f32_16x16x32_bf16(a, bb, sacc, 0, 0, 0); }
            if (wid >= 4) {
#pragma unroll
                for (int kk = 0; kk < 2; ++kk) { const bf16x8 a = *(const LAS bf16x8*)(B + SB_QK + (tw * 16 + fr) * 144 + (kk * 32 + fq * 8) * 2); const bf16x8 bb = *(const LAS bf16x8*)(lds + SC_UT + fr * 144 + (kk * 32 + fq * 8) * 2);
                    acc = __builtin_amdgcn_mfma_f32_16x16x32_bf16(a, bb, acc, 0, 0, 0); }
#pragma unroll
                for (int j = 0; j < 4; ++j) obuf[(size_t)(b * 2048 + n * 64 + tw * 16 + fq * 4 + j) * 1024 + h * 128 + sl * 16 + fr] = acc[j];
            }
            { u32x2 w; w.x = pk2(sacc[0], sacc[1]); w.y = pk2(sacc[2], sacc[3]); *(LAS u32x2*)(lds + SC_ST + fr * 272 + (wid * 16 + fq * 4) * 2) = w; }
            if (n + 1 < 32) lstore(cur ^ 1);
            __syncthreads();
        }
#pragma unroll
        for (int j = 0; j < 4; ++j) p.out[O_DP + ((size_t)bh * 128 + wid * 16 + fq * 4 + j) * 128 + sl * 16 + fr] = sacc[j];
    }
    __syncthreads();
    {
        const bf16_t* qn = (const bf16_t*)(p.ws + WS_QN); const bf16_t* kn = (const bf16_t*)(p.ws + WS_KN); const bf16_t* vv = (const bf16_t*)(p.ws + WS_VV);
        const float* gbuf = (const float*)(p.ws + WS_G); const float* bbuf = (const float*)(p.ws + WS_BETA);
        const int grp = tid >> 8, w4 = __builtin_amdgcn_readfirstlane(tid >> 6) & 3, j = w4 * 32 + (lane & 31), half = lane >> 5;
        LAS float* qs = (LAS float*)lds + grp * 1024;
        LAS float* ks = qs + 512;
        const float scale = 0.08838834764831845f;
        for (int it0 = bid * 2; it0 < 1024; it0 += nblk * 2) {
            const int item = it0 + grp, sb = item >> 3, h = item & 7;
            __syncthreads();
#pragma unroll
            for (int i = 0; i < 4; ++i) { const int idx = (tid & 255) + 256 * i, tk = idx >> 7, c = idx & 127, t = tk & 3; const size_t go = (size_t)(TP + sb * 4 + t) * 1024 + h * 128 + c;
                if (tk < 4) qs[t * 128 + c] = bf2f(qn[go]); else ks[t * 128 + c] = bf2f(kn[go]); }
            float S[64];
            const float* s0 = p.in[4] + (size_t)item * 16384 + (size_t)half * 64 * 128 + j;
#pragma unroll
            for (int i = 0; i < 64; ++i) S[i] = __builtin_nontemporal_load(s0 + i * 128);
            __syncthreads();
#pragma unroll 1
            for (int t = 0; t < 4; ++t) {
                const int row = TP + sb * 4 + t;
                const float a = __expf(gbuf[row * 8 + h]), be = bbuf[row * 8 + h], v = bf2f(vv[(size_t)row * 1024 + h * 128 + j]);
                float kS = 0.f;
#pragma unroll
                for (int i4 = 0; i4 < 16; ++i4) { const f32x4 k4 = *(const LAS f32x4*)(ks + t * 128 + half * 64 + i4 * 4); kS += k4[0] * S[i4 * 4] + k4[1] * S[i4 * 4 + 1] + k4[2] * S[i4 * 4 + 2] + k4[3] * S[i4 * 4 + 3]; }
                kS += __shfl_xor(kS, 32);
                const float coef = be * (v - a * kS);
                float o = 0.f;
#pragma unroll
                for (int i4 = 0; i4 < 16; ++i4) { const f32x4 k4 = *(const LAS f32x4*)(ks + t * 128 + half * 64 + i4 * 4); const f32x4 q4 = *(const LAS f32x4*)(qs + t * 128 + half * 64 + i4 * 4);
#pragma unroll
                    for (int q = 0; q < 4; ++q) { S[i4 * 4 + q] = a * S[i4 * 4 + q] + k4[q] * coef; o += q4[q] * S[i4 * 4 + q]; } }
                o += __shfl_xor(o, 32);
                if (half == 0) obuf[(size_t)row * 1024 + h * 128 + j] = o * scale;
            }
            float* so = p.out + O_DS + (size_t)item * 16384 + (size_t)half * 64 * 128 + j;
#pragma unroll
            for (int i = 0; i < 64; ++i) so[i * 128] = S[i];
        }
    }
    __syncthreads();
}

__device__ __forceinline__ void onorm_phase(const Params& p, int bid, int nblk) {
    const int lane = threadIdx.x & 63, wid = __builtin_amdgcn_readfirstlane(threadIdx.x >> 6);
    const float* obuf = p.out + OS_O; const bf16_t* proj = (const bf16_t*)(p.ws + WS_PROJ); bf16_t* acat = (bf16_t*)(p.ws + WS_U); const float* og = p.in[14];
    for (int row = bid * 8 + wid; row < TT; row += nblk * 8) {
        const int c0 = lane * 16; float o[16], z[16], g[16];
#pragma unroll
        for (int i = 0; i < 4; ++i) { const f32x4 v = *(const f32x4*)(obuf + (size_t)row * 1024 + c0 + i * 4); o[i * 4] = v[0]; o[i * 4 + 1] = v[1]; o[i * 4 + 2] = v[2]; o[i * 4 + 3] = v[3];
            const f32x4 gg = *(const f32x4*)(og + (c0 & 127) + i * 4); g[i * 4] = gg[0]; g[i * 4 + 1] = gg[1]; g[i * 4 + 2] = gg[2]; g[i * 4 + 3] = gg[3]; }
        unpack8(*(const u32x4*)(proj + (size_t)row * NPROJ + C_Z + c0), z); unpack8(*(const u32x4*)(proj + (size_t)row * NPROJ + C_Z + c0 + 8), z + 8);
        float ss = 0.f;
#pragma unroll
        for (int i = 0; i < 16; ++i) ss += o[i] * o[i];
        ss += __shfl_xor(ss, 1); ss += __shfl_xor(ss, 2); ss += __shfl_xor(ss, 4);
        const float rstd = rsqrtf(ss * (1.0f / 128.0f) + EPS);
#pragma unroll
        for (int i = 0; i < 16; ++i) o[i] = o[i] * rstd * g[i] * siluf_(z[i]);
        *(u32x4*)(acat + (size_t)row * DM + c0) = pack8(o); *(u32x4*)(acat + (size_t)row * DM + c0 + 8) = pack8(o + 8);
    }
}

#define XB_TMO      128
#define XB_XCNT(j)  (256  + 64 * (j))
#define XB_XSUB(j)  (1280 + 64 * (j))
#define XB_XGEN(j)  (2304 + 64 * (j))
#define XB_TOP      3328
#define XB_TOPGEN   3392
#define XCD_BAR_WORDS 3456
#define XB_SPIN_CAP (1u << 18)

__device__ __forceinline__ unsigned xb_ld(unsigned* p)              { return __hip_atomic_load(p, __ATOMIC_RELAXED, __HIP_MEMORY_SCOPE_AGENT); }
__device__ __forceinline__ unsigned xb_add(unsigned* p, unsigned v) { return __hip_atomic_fetch_add(p, v, __ATOMIC_RELAXED, __HIP_MEMORY_SCOPE_AGENT); }
__device__ __forceinline__ unsigned xb_xcc_id() { return (unsigned)__builtin_amdgcn_s_getreg((3 << 11) | 20) & 0xFu; }
#define XB_SPIN(cond, bar) do { unsigned _sp = 0; while (cond) { __builtin_amdgcn_s_sleep(1); \
    if ((++_sp & 255u) == 0u) { if (xb_ld(&(bar)[XB_TMO])) break; if (_sp > XB_SPIN_CAP) { atomicAdd(&(bar)[XB_TMO], 1u); break; } } } } while (0)

struct XcdBarrier {
    unsigned* bar; unsigned x;
    volatile LAS unsigned* st;
};

__device__ __forceinline__ XcdBarrier xcd_barrier_post(unsigned* bar, volatile LAS unsigned* st) {
    XcdBarrier b; b.bar = bar; b.x = xb_xcc_id(); b.st = st;
    if (threadIdx.x == 0) (void)xb_add(&bar[XB_XCNT(b.x)], 1u);
    return b;
}
__device__ __forceinline__ void xcd_barrier_complete(unsigned* bar, unsigned x, unsigned& nloc, unsigned& nx) {
    const unsigned G = gridDim.x * gridDim.y * gridDim.z;
    unsigned sum, cnt, mine, sp = 0u;
    for (;;) {
        sum = 0u; cnt = 0u; mine = 0u;
#pragma unroll
        for (unsigned j = 0; j < 16; ++j) { const unsigned c = xb_ld(&bar[XB_XCNT(j)]); sum += c; cnt += (c > 0u) ? 1u : 0u; mine = (j == x) ? c : mine; }
        if (sum == G) break;
        __builtin_amdgcn_s_sleep(1);
        if ((++sp & 255u) == 0u) { if (xb_ld(&bar[XB_TMO])) break; if (sp > XB_SPIN_CAP) { atomicAdd(&bar[XB_TMO], 1u); break; } }
    }
    nloc = mine > 0u ? mine : 1u; nx = cnt > 0u ? cnt : 1u;
}

__device__ __forceinline__ void xcd_barrier(const XcdBarrier& b) {
    asm volatile("s_waitcnt vmcnt(0)" ::: "memory");
    __syncthreads();
    if (threadIdx.x == 0) {
        unsigned* bar = b.bar;
        __builtin_amdgcn_s_waitcnt(0);
        unsigned nloc = b.st[0], nx = b.st[1];
        if (nloc == 0u) { xcd_barrier_complete(bar, b.x, nloc, nx); b.st[0] = nloc; b.st[1] = nx; }
        const unsigned old = xb_add(&bar[XB_XSUB(b.x)], 1u);
        const unsigned gen = old / nloc;
        if (old + 1u == (gen + 1u) * nloc) {
            __builtin_amdgcn_fence(__ATOMIC_RELEASE, "agent");
            asm volatile("s_waitcnt vmcnt(0)" ::: "memory");
            const unsigned og = xb_add(&bar[XB_TOP], 1u);
            const unsigned tg = og / nx;
            if (og + 1u == (tg + 1u) * nx) xb_add(&bar[XB_TOPGEN], 1u);
            else XB_SPIN(xb_ld(&bar[XB_TOPGEN]) == tg, bar);
            __builtin_amdgcn_fence(__ATOMIC_ACQUIRE, "agent");
            xb_add(&bar[XB_XGEN(b.x)], 1u);
            asm volatile("s_waitcnt vmcnt(0)" ::: "memory");
        } else {
            XB_SPIN(xb_ld(&bar[XB_XGEN(b.x)]) == gen, bar);
            __builtin_amdgcn_fence(__ATOMIC_ACQUIRE, "agent");
            asm volatile("s_waitcnt vmcnt(0)" ::: "memory");
        }
    }
    __syncthreads();
}

constexpr size_t WS_BAR = WS_END;
constexpr int LDS_ST_OFF = LDS_BYTES - 16;
struct KArgs { Params p; TJob jobs[11]; };
constexpr int N_PHASES = 15;
#ifndef PH_MASK
#define PH_MASK 0xFFFF
#endif
#ifndef DUP_MASK
#define DUP_MASK 0
#endif

__global__ void __launch_bounds__(512, 2) fwd_megakernel(KArgs ka) {
    extern __shared__ __attribute__((aligned(16))) unsigned char lds_raw[];
    LAS unsigned char* lds = (LAS unsigned char*)lds_raw;
    const Params& p = ka.p;
    const int bid = blockIdx.x, nblk = gridDim.x;
    unsigned char* ws = p.ws;
    const int lo = p.ph_lo, hi = p.ph_hi;
    if (threadIdx.x < 4) ((LAS unsigned*)(lds + LDS_ST_OFF))[threadIdx.x] = 0u;
    __syncthreads();
    if (hi > 1000) cg::this_grid().sync();
    XcdBarrier xbar = xcd_barrier_post((unsigned*)(ws + WS_BAR), (volatile LAS unsigned*)(lds + LDS_ST_OFF));
#define IN(k) ((PH_MASK & (1 << (k))) && lo <= (k) && (k) < hi)
#define SEAM(k) do { if (lo <= (k) && (k) + 1 < hi) xcd_barrier(xbar); } while (0)
    if (IN(0)) for (int rep = 0; rep <= ((DUP_MASK >> 0) & 1); ++rep) {
            bf16_t* aada = (bf16_t*)(ws + WS_AADA);
            for (int idx = bid * 512 + threadIdx.x; idx < 256 * 2048; idx += nblk * 512) { const int row = idx >> 11, col = idx & 2047;
                const float v = row < 4 ? siluf_(p.in[2][row * 2048 + col]) : (row < NB ? siluf_(p.in[3][(row - 4) * 2048 + col]) : 0.f); aada[idx] = f2bf(v); }
            transpose_jobs(ka.jobs, 1, bid, nblk, lds);
        }
    SEAM(0);
    if (IN(1)) for (int rep = 0; rep <= ((DUP_MASK >> 1) & 1); ++rep) {
            if (bid < 48) { pg8::Gemm g{(const bf16_t*)(ws + WS_AADA), (const bf16_t*)(ws + WS_PROJ), 2048, 2048, 2048, 0, 0, 0, 0, 0}; pg8::OneUnitOrder S{48, bid, 32}; pg8::EpiAda E{(float*)(ws + WS_MOD), p.in[8]}; pg8::gemm_phase(lds, g, S, E); }
            else { transpose_jobs(ka.jobs + 1, 1, bid - 48, nblk - 48, lds); transpose_jobs(ka.jobs + 4, 7, bid - 48, nblk - 48, lds); }
        }
    SEAM(1);
    if (IN(2)) for (int rep = 0; rep <= ((DUP_MASK >> 2) & 1); ++rep) norm_phase<0>(p, bid, nblk);
    SEAM(2);
    if (IN(3)) for (int rep = 0; rep <= ((DUP_MASK >> 3) & 1); ++rep) { pg8::Gemm g{(const bf16_t*)(ws + WS_U), (const bf16_t*)(ws + WS_WIN), 2048, 2048, 2048, 0, 0, 0, 0, 0}; pg8::StaticOrder S; S.init(TT, NPROJ, 2048, nblk, bid); pg8::EpiBf16 E{(bf16_t*)(ws + WS_PROJ), NPROJ, 0, nullptr}; pg8::gemm_phase(lds, g, S, E); }
    SEAM(3);
    if (IN(4)) for (int rep = 0; rep <= ((DUP_MASK >> 4) & 1); ++rep) mixer_prep_phase(p, bid, nblk);
    SEAM(4);
    if (IN(5)) for (int rep = 0; rep <= ((DUP_MASK >> 5) & 1); ++rep) chunk_prep_phase(p, bid, nblk, lds);
    SEAM(5);
    if (IN(6)) for (int rep = 0; rep <= ((DUP_MASK >> 6) & 1); ++rep) scan_phase(p, bid, nblk, lds);
    SEAM(6);
    if (IN(7)) for (int rep = 0; rep <= ((DUP_MASK >> 7) & 1); ++rep) { onorm_phase(p, bid, nblk);
            pg8::Gemm g{(const bf16_t*)(ws + WS_YP), (const bf16_t*)(ws + WS_PW), 1024, 256, 256, 512, 0, 0, 0, 0}; pg8::StaticOrder S; S.init(TT, 1024, 256, nblk, bid); pg8::EpiBf16 E{(bf16_t*)(ws + WS_U), DM, 1024, p.in[16]}; pg8::gemm_phase(lds, g, S, E);
            if (rep == 0) { if (nblk <= 136) transpose_jobs(ka.jobs + 3, 1, bid, nblk, lds); else if (bid >= 136) transpose_jobs(ka.jobs + 3, 1, bid - 136, nblk - 136, lds); } }
    SEAM(7);
    if (IN(8)) for (int rep = 0; rep <= ((DUP_MASK >> 8) & 1); ++rep) {
            pg8::Gemm g{(const bf16_t*)(ws + WS_U), (const bf16_t*)(ws + WS_WAB), 2048, 2048, 1024, 0, 2048, 2048, (size_t)128 * 2048 * 2, (size_t)128 * 2048 * 2}; pg8::StaticOrder S; S.init(68 * 256, 16 * 256, 1024, nblk, bid);
            pg8::EpiDiag E{(bf16_t*)(ws + WS_QN), (const bf16_t*)(ws + WS_PROJ)}; pg8::gemm_phase(lds, g, S, E);
            if (rep == 0) transpose_jobs(ka.jobs + 2, 1, bid, nblk, lds); }
    SEAM(9);
    if (IN(10)) for (int rep = 0; rep <= ((DUP_MASK >> 10) & 1); ++rep) { pg8::Gemm g{(const bf16_t*)(ws + WS_QN), (const bf16_t*)(ws + WS_WO), 2048, 2048, 2048, 0, 0, 0, 0, 0}; pg8::SplitOrder S{nblk, bid, 32, 4, 8}; pg8::EpiRes E{p.out + O_Y, p.in[0], p.in[1], (const float*)(ws + WS_MOD) + 4096, (float*)(ws + WS_PB10)}; pg8::gemm_phase(lds, g, S, E); }
    SEAM(10);
    if (IN(11)) for (int rep = 0; rep <= ((DUP_MASK >> 11) & 1); ++rep) norm_phase<1>(p, bid, nblk);
    SEAM(11);
    if (IN(12)) for (int rep = 0; rep <= ((DUP_MASK >> 12) & 1); ++rep) { pg8::Gemm g{(const bf16_t*)(ws + WS_U), (const bf16_t*)(ws + WS_WGU), 2048, 2048, 2048, 0, 0, 0, 0, 0}; pg8::StaticOrder S; S.init(TT, 11264, 2048, nblk, bid); pg8::EpiGU E{(bf16_t*)(ws + WS_PROJ)}; pg8::gemm_phase(lds, g, S, E); }
    SEAM(12);
    if (IN(13)) for (int rep = 0; rep <= ((DUP_MASK >> 13) & 1); ++rep) { pg8::Gemm g{(const bf16_t*)(ws + WS_PROJ), (const bf16_t*)(ws + WS_WD), DFF, DFF, DFF, 0, 0, 0, 0, 0}; pg8::SplitOrder S{nblk, bid, 88, 8, 11}; pg8::EpiRes E{p.out + O_Y, p.out + O_Y, p.out + O_Y + (size_t)TP * DM, (const float*)(ws + WS_MOD) + 10240, (float*)(ws + WS_PB13)}; pg8::gemm_phase(lds, g, S, E); }
    SEAM(13);
    if (IN(14)) for (int rep = 0; rep <= ((DUP_MASK >> 14) & 1); ++rep) norm_phase<2>(p, bid, nblk);
    SEAM(14);
}

extern "C" void kernel_launch(void* const* d_in, const int* in_sizes, int n_in, void* d_out, int out_size, void* d_ws, size_t ws_size, hipStream_t stream) {
    static int grid = 0;
    if (grid == 0) {
        if (n_in != 24 || ws_size < WS_BAR + XCD_BAR_WORDS * 4) { fprintf(stderr, "kernel_launch: unexpected n_in %d / ws_size %zu (need %zu)\n", n_in, ws_size, (size_t)WS_END); grid = -1; return; }
        int dev = 0, cus = 0, per_cu = 0;
        hipGetDevice(&dev); hipDeviceGetAttribute(&cus, hipDeviceAttributeMultiprocessorCount, dev);
        if (hipFuncSetAttribute((const void*)fwd_megakernel, hipFuncAttributeMaxDynamicSharedMemorySize, LDS_BYTES) != hipSuccess) { fprintf(stderr, "kernel_launch: hipFuncSetAttribute failed\n"); grid = -1; return; }
        if (hipOccupancyMaxActiveBlocksPerMultiprocessor(&per_cu, (const void*)fwd_megakernel, 512, LDS_BYTES) != hipSuccess || per_cu < 1) { fprintf(stderr, "kernel_launch: occupancy query says %d\n", per_cu); per_cu = 1; }
        (void)hipGetLastError();
        grid = cus > 0 ? cus : 256;
        if (grid < 64) grid = 64;
    }
    if (grid < 0) return;
    if (hipMemsetAsync((unsigned char*)d_ws + WS_BAR, 0, XCD_BAR_WORDS * 4, stream) != hipSuccess) { fprintf(stderr, "kernel_launch: memset failed\n"); return; }
    KArgs ka; memset(&ka, 0, sizeof(ka));
    for (int i = 0; i < 24; ++i) ka.p.in[i] = (const float*)d_in[i];
    ka.p.out = (float*)d_out; ka.p.ws = (unsigned char*)d_ws;
    unsigned char* ws = (unsigned char*)d_ws;
    auto setjob = [&](int i, const void* src, void* dst, int ld_src, int K, int Nout, int ld_dst, int map) { TJob& j = ka.jobs[i]; j.src = (const float*)src; j.dst = (bf16_t*)dst; j.ld_src = ld_src; j.K = K; j.Nout = Nout; j.ld_dst = ld_dst; j.map = map; j.pad = 0; };
    setjob(0, d_in[7], ws + WS_PROJ, MODW, 2048, MODW, 2048, 0);
    setjob(1, d_in[10], ws + WS_WIN, 9232, 2048, NPROJ, 2048, 1);
    setjob(2, d_in[21], ws + WS_WGU, 2 * DFF, 2048, 2 * DFF, 2048, 2);
    setjob(3, d_in[22], ws + WS_WD, 2048, DFF, 2048, DFF, 0);
    setjob(4, d_in[19], ws + WS_WO, 2048, 2048, 2048, 2048, 0);
    setjob(5, d_in[17], ws + WS_WAB, 2048, 1024, 2048, 2048, 0);
    setjob(6, d_in[18], ws + WS_WAB + 1024 * 2, 2048, 1024, 2048, 2048, 0);
    for (int g = 0; g < 4; ++g) setjob(7 + g, (const float*)d_in[15] + g * 65536, ws + WS_PW + (size_t)g * 65536 * 2, 256, 256, 256, 256, 0);
#if MK_PER_PHASE
    for (int ph = 0; ph < N_PHASES; ++ph) { ka.p.ph_lo = ph; ka.p.ph_hi = ph + 1; hipLaunchKernelGGL(fwd_megakernel, dim3(grid), dim3(512), LDS_BYTES, stream, ka); }
#else
    ka.p.ph_lo = 0; ka.p.ph_hi = N_PHASES;
    void* args[] = {&ka};
    hipError_t e = hipLaunchCooperativeKernel((const void*)fwd_megakernel, dim3(grid), dim3(512), args, LDS_BYTES, stream);
    if (e != hipSuccess) fprintf(stderr, "cooperative launch failed: %s (grid %d)\n", hipGetErrorString(e), grid);
#endif
}
```

```cpp
#include <hip/hip_runtime.h>
#include <hip/hip_cooperative_groups.h>
#include <cstdio>
#include <cstring>
namespace cg = cooperative_groups;

#ifndef MK_PER_PHASE
#define MK_PER_PHASE 0
#endif

#define LAS __attribute__((address_space(3)))
typedef unsigned short bf16_t;
typedef short bf16x8 __attribute__((ext_vector_type(8)));
typedef float f32x4 __attribute__((ext_vector_type(4)));
typedef float f32x2 __attribute__((ext_vector_type(2)));
typedef unsigned u32x4 __attribute__((ext_vector_type(4)));
typedef unsigned u32x2 __attribute__((ext_vector_type(2)));

constexpr int DM = 2048, TP = 8192, TS = 512, TT = 8704, NB = 132;
constexpr int NPROJ = 9472;
constexpr int DFF = 5632;
constexpr int MODW = 12288;
constexpr float EPS = 1e-6f;
constexpr int C_Q = 0, C_K = 1024, C_V = 2048, C_Z = 3072, C_XP = 4096, C_GA = 5120, C_GB = 7168, C_AB = 9216;
constexpr size_t O_Y = 0, O_DP = 17825792, O_CP = 18350080, O_PP = 18386944, O_DS = 18448384, O_CS = 35225600, O_PS = 36405248;
constexpr size_t OS_O = 0, OS_UB = 8912896;
constexpr size_t WS_WIN = 0;
constexpr size_t WS_WGU = WS_WIN + (size_t)NPROJ * 2048 * 2;
constexpr size_t WS_WD = WS_WGU + (size_t)11264 * 2048 * 2;
constexpr size_t WS_WO = WS_WD + (size_t)2048 * 5632 * 2;
constexpr size_t WS_WAB = WS_WO + (size_t)2048 * 2048 * 2;
constexpr size_t WS_PW = WS_WAB + (size_t)2048 * 2048 * 2;
constexpr size_t WS_AADA = WS_PW + (size_t)1024 * 256 * 2;
constexpr size_t WS_MOD = WS_AADA + (size_t)256 * 2048 * 2;
constexpr size_t WS_G = WS_MOD + (size_t)NB * MODW * 4;
constexpr size_t WS_BETA = WS_G + (size_t)TT * 8 * 4;
constexpr size_t WS_CD = WS_BETA + (size_t)TT * 8 * 4;
constexpr size_t WS_U = WS_CD + 4096;
constexpr size_t WS_QN = WS_U + (size_t)TT * 2048 * 2;
constexpr size_t WS_KN = WS_QN + (size_t)TT * 1024 * 2;
constexpr size_t WS_VV = WS_KN + (size_t)TT * 1024 * 2;
constexpr size_t WS_YP = WS_VV + (size_t)TT * 1024 * 2;
constexpr size_t WS_WDC = WS_YP + (size_t)TT * 1024 * 2;
constexpr size_t WS_QD = WS_WDC + (size_t)1024 * 64 * 128 * 2;
constexpr size_t WS_KT = WS_QD + (size_t)1024 * 64 * 128 * 2;
constexpr size_t WS_QK = WS_KT + (size_t)1024 * 64 * 128 * 2;
constexpr size_t WS_PROJ = WS_QK + (size_t)1024 * 64 * 64 * 2;
constexpr size_t WS_END = WS_PROJ + (size_t)TT * NPROJ * 2;
constexpr size_t WS_PB10 = WS_PROJ;
constexpr size_t WS_PB13 = WS_PROJ + (size_t)TT * DFF * 2;
static_assert(WS_PB13 + (size_t)11 * TS * DM * 4 <= WS_END && (WS_PB13 % 256) == 0, "partials");
static_assert(WS_END + 16384 <= 501510720ull, "workspace too large");
static_assert((WS_PROJ % 256) == 0 && (WS_QK % 256) == 0 && (WS_U % 256) == 0, "align");

constexpr int LDS_BYTES = 147456;

struct Params {
    const float* in[24];
    float* out;
    unsigned char* ws;
    int ph_lo, ph_hi;
};

__device__ __forceinline__ float bf2f(unsigned short x) { return __uint_as_float(((unsigned)x) << 16); }
__device__ __forceinline__ unsigned short f2bf(float f) { unsigned u = __float_as_uint(f); u += 0x7FFFu + ((u >> 16) & 1u); return (unsigned short)(u >> 16); }
typedef __bf16 bf16x2_hw __attribute__((ext_vector_type(2)));
__device__ __forceinline__ unsigned pk2(float lo, float hi) { const f32x2 v = {lo, hi}; const bf16x2_hw b = __builtin_convertvector(v, bf16x2_hw); return __builtin_bit_cast(unsigned, b); }
__device__ __forceinline__ void unpack8(const u32x4 w, float* f) {
    f[0] = __uint_as_float(w.x << 16); f[1] = __uint_as_float(w.x & 0xffff0000u);
    f[2] = __uint_as_float(w.y << 16); f[3] = __uint_as_float(w.y & 0xffff0000u);
    f[4] = __uint_as_float(w.z << 16); f[5] = __uint_as_float(w.z & 0xffff0000u);
    f[6] = __uint_as_float(w.w << 16); f[7] = __uint_as_float(w.w & 0xffff0000u);
}
__device__ __forceinline__ u32x4 pack8(const float* f) { u32x4 w; w.x = pk2(f[0], f[1]); w.y = pk2(f[2], f[3]); w.z = pk2(f[4], f[5]); w.w = pk2(f[6], f[7]); return w; }
__device__ __forceinline__ float sigmoidf_(float x) { return 1.0f / (1.0f + __expf(-x)); }
__device__ __forceinline__ float siluf_(float x) { return x / (1.0f + __expf(-x)); }
__device__ __forceinline__ int bidx_of_row(int row) { return row < TP ? (row >> 11) : 4 + ((row - TP) >> 2); }

namespace pg8 {
constexpr int BM = 256, BK = 64, HALF = 128, HTB = HALF * BK * 2, STAGE_BYTES = 8 * HTB, NXCD = 8, WGM = 8;
__host__ __device__ __forceinline__ int lds_byte(int r, int c) { const int st = (r >> 4) * 2 + (c >> 5), rr = r & 15, cc = c & 31, ob = rr * 64 + cc * 2; return st * 1024 + (ob ^ (((ob >> 9) & 1) << 5)); }
__host__ __device__ __forceinline__ void stage_rc(int b, int& R, int& C) { const int st = b / 1024, sb = b % 1024, swz = sb ^ (((sb >> 9) & 1) << 5); R = (st >> 1) * 16 + swz / 64; C = (st & 1) * 32 + (swz % 64) / 2; }
__host__ __device__ __forceinline__ int perm32(int rho) { const int n = rho >> 4, i = rho & 15; return 8 * (i >> 2) + 4 * n + (i & 3); }

struct Unit { int pm, pn, kt0, nkt, piece; };
struct Gemm { const bf16_t* A; const bf16_t* Bt; int lda, ldb, K; size_t a_pn_off; size_t a_half, b_half, a_tile, b_tile; };

__device__ __forceinline__ void tile_of(int wgid, int nM, int nN, Unit& u) {
    const int nwg = nM * nN;
    { const int q = nwg / NXCD, r = nwg % NXCD, xcd = wgid % NXCD, off = wgid / NXCD; wgid = (xcd < r ? xcd * (q + 1) : r * (q + 1) + (xcd - r) * q) + off; }
    const int nig = WGM * nN, gid = wgid / nig, fm = gid * WGM, gsz = (nM - fm) < WGM ? (nM - fm) : WGM;
    u.pm = fm + ((wgid % nig) % gsz); u.pn = (wgid % nig) / gsz;
}
struct StaticOrder {
    int nM, nN, nwg, G, c, ntk;
    __device__ __forceinline__ void init(int M, int N, int K, int G_, int c_) { nM = M / BM; nN = N / BM; nwg = nM * nN; G = G_; c = c_; ntk = K / BK; }
    __device__ __forceinline__ bool next(int i, Unit& u) const {
        const long L = (long)i * G + c; if (L >= nwg) return false;
        tile_of((int)L, nM, nN, u); u.kt0 = 0; u.nkt = ntk; u.piece = -1; return true;
    }
};
struct OneUnitOrder {
    int n, c, ntk;
    __device__ __forceinline__ bool next(int i, Unit& u) const { if (i != 0 || c >= n) return false; u.pm = 0; u.pn = c; u.kt0 = 0; u.nkt = ntk; u.piece = -1; return true; }
};
struct DoubleOrder {
    int G, c;
    __device__ __forceinline__ bool next(int i, Unit& u) const {
        const int L = (i >> 1) * G + c, half = i & 1; const bool ok = L < 272;
        tile_of(ok ? L : 0, 34, 8, u); u.kt0 = 16 * half; u.nkt = 16; u.piece = half; return ok;
    }
};
struct SplitOrder {
    int G, c, ntk, pk, npc;
    __device__ __forceinline__ bool next(int i, Unit& u) const {
        const int L = i * G + c;
        const bool full = L < 256;
        int fpm, fpn;
        { int wgid = full ? L : 0; const int xcd = wgid % NXCD, off = wgid / NXCD; wgid = xcd * 32 + off;
          const int nig = WGM * 8, gid = wgid / nig, fm = gid * WGM; fpm = fm + ((wgid % nig) % WGM); fpn = (wgid % nig) / WGM; }
        const int pidx = full ? 0 : L - 256, tile = pidx / npc, pc = pidx - tile * npc;
        u.pm = full ? fpm : 32 + (tile >> 3); u.pn = full ? fpn : (tile & 7); u.kt0 = full ? 0 : pc * pk; u.nkt = full ? ntk : pk; u.piece = full ? -1 : pc;
        return full || pidx < 16 * npc;
    }
};

template <class Epi, class Sched>
__device__ __forceinline__ void gemm_phase(LAS unsigned char* lds, const Gemm g, const Sched& S, const Epi& E) {
    const int tid = threadIdx.x, wid = __builtin_amdgcn_readfirstlane(tid >> 6), lane = tid & 63, wr = wid >> 2, wc = wid & 3, fr = lane & 15, fq = lane >> 4;
    unsigned voffA[2], voffB[2];
#pragma unroll
    for (int i = 0; i < 2; ++i) { int R, C; stage_rc(tid * 16 + i * 8192, R, C); const int Rb = Epi::PERM ? ((R & ~31) + perm32(R & 31)) : R;
        voffA[i] = (unsigned)(R * g.lda + C) * 2u; voffB[i] = (unsigned)(Rb * g.ldb + C) * 2u; }
    const size_t kstep = (size_t)(BK * 2);
    const size_t hstepA = g.a_half ? g.a_half : (size_t)HALF * g.lda * 2, hstepB = g.b_half ? g.b_half : (size_t)HALF * g.ldb * 2;
    const size_t tstepA = g.a_tile ? g.a_tile : (size_t)BM * g.lda * 2, tstepB = g.b_tile ? g.b_tile : (size_t)BM * g.ldb * 2;
    const unsigned ldsw = (unsigned)wid * 1024u;
    const int aoff = lds_byte(wr * 64 + fr, fq * 8), boff = lds_byte(wc * 32 + fr, fq * 8);
#define PG8_SA(b, h) (((b) * 2 + (h)) * HTB)
#define PG8_SB(b, h) ((4 + (b) * 2 + (h)) * HTB)
#define PG8_STAGE(bufoff, gbase, voff) do { _Pragma("unroll") for (int _i = 0; _i < 2; ++_i) \
        __builtin_amdgcn_global_load_lds((const unsigned*)((const char*)(gbase) + (voff)[_i]), (LAS unsigned*)(lds + (bufoff) + ldsw + _i * 8192), 16, 0, 0); } while (0)
#define PG8_LDA(dst, b, h) do { _Pragma("unroll") for (int m = 0; m < 4; ++m) _Pragma("unroll") for (int k = 0; k < 2; ++k) dst[m][k] = *(const LAS bf16x8*)(lds + PG8_SA(b, h) + aoff + m * 2048 + k * 1024); } while (0)
#define PG8_LDB(dst, b, h) do { _Pragma("unroll") for (int n = 0; n < 2; ++n) _Pragma("unroll") for (int k = 0; k < 2; ++k) dst[n][k] = *(const LAS bf16x8*)(lds + PG8_SB(b, h) + boff + n * 2048 + k * 1024); } while (0)
#define PG8_MMA(ai, bj, At, Bt) do { __builtin_amdgcn_s_setprio(1); _Pragma("unroll") for (int m = 0; m < 4; ++m) _Pragma("unroll") for (int n = 0; n < 2; ++n) _Pragma("unroll") for (int k = 0; k < 2; ++k) \
        acc[ai][bj][m][n] = __builtin_amdgcn_mfma_f32_16x16x32_bf16(Bt[n][k], At[m][k], acc[ai][bj][m][n], 0, 0, 0); __builtin_amdgcn_s_setprio(0); } while (0)
#define PG8_WAIT_V(n) asm volatile("s_waitcnt vmcnt(" #n ")" ::: "memory")
#define PG8_WAIT_L(n) asm volatile("s_waitcnt lgkmcnt(" #n ")" ::: "memory")
#define PG8_BAR __builtin_amdgcn_s_barrier()
#define PG8_SCHED __builtin_amdgcn_sched_barrier(0)
    Unit cur, nxt; int ui = 0;
    if (!S.next(0, cur)) return;
    f32x4 acc[2][2][4][2];
#pragma unroll
    for (int a = 0; a < 2; ++a)
#pragma unroll
        for (int b = 0; b < 2; ++b)
#pragma unroll
            for (int m = 0; m < 4; ++m)
#pragma unroll
                for (int n = 0; n < 2; ++n) acc[a][b][m][n] = (f32x4){0.f, 0.f, 0.f, 0.f};
    bf16x8 At[4][2], B0[2][2], B1[2][2];
    const char* cA = (const char*)g.A + (size_t)cur.pm * tstepA + (size_t)cur.pn * g.a_pn_off + (size_t)cur.kt0 * kstep; const char* cB = (const char*)g.Bt + (size_t)cur.pn * tstepB + (size_t)cur.kt0 * kstep;
    PG8_STAGE(PG8_SB(0, 0), cB, voffB); PG8_STAGE(PG8_SA(0, 0), cA, voffA); PG8_STAGE(PG8_SB(0, 1), cB + hstepB, voffB); PG8_STAGE(PG8_SA(0, 1), cA + hstepA, voffA);
    if (wr == 1) PG8_BAR;
    PG8_WAIT_V(4); PG8_BAR;
    PG8_STAGE(PG8_SB(1, 0), cB + kstep, voffB); PG8_STAGE(PG8_SA(1, 0), cA + kstep, voffA); PG8_STAGE(PG8_SB(1, 1), cB + hstepB + kstep, voffB);
    PG8_WAIT_V(6); PG8_BAR;
    for (;;) {
        const bool has_next = S.next(ui + 1, nxt);
        const char* nA = has_next ? (const char*)g.A + (size_t)nxt.pm * tstepA + (size_t)nxt.pn * g.a_pn_off + (size_t)nxt.kt0 * kstep : cA; const char* nB = has_next ? (const char*)g.Bt + (size_t)nxt.pn * tstepB + (size_t)nxt.kt0 * kstep : cB;
        const int nt = cur.nkt;
#pragma unroll 1
        for (int t = 0; t < nt; t += 2) {
            const bool last = (t == nt - 2);
            const char* a1 = cA + (size_t)(t + 1) * kstep;
            const char* a2 = last ? nA : cA + (size_t)(t + 2) * kstep; const char* b2 = last ? nB : cB + (size_t)(t + 2) * kstep;
            const char* a3 = a2 + kstep; const char* b3 = b2 + kstep;
            PG8_LDB(B0, 0, 0); PG8_SCHED; PG8_LDA(At, 0, 0); PG8_STAGE(PG8_SA(1, 1), a1 + hstepA, voffA);
            PG8_WAIT_L(8); PG8_BAR; PG8_WAIT_L(0); PG8_MMA(0, 0, At, B0); PG8_BAR; PG8_SCHED;
            PG8_LDB(B1, 0, 1); PG8_STAGE(PG8_SB(0, 0), b2, voffB);
            PG8_BAR; PG8_WAIT_L(0); if constexpr (!Epi::DIAG) PG8_MMA(0, 1, At, B1); PG8_BAR;
            PG8_LDA(At, 0, 1); PG8_STAGE(PG8_SA(0, 0), a2, voffA);
            PG8_BAR; PG8_WAIT_L(0); if constexpr (!Epi::DIAG) PG8_MMA(1, 0, At, B0); PG8_BAR; PG8_SCHED;
            PG8_STAGE(PG8_SB(0, 1), b2 + hstepB, voffB);
            PG8_WAIT_V(6); PG8_BAR; PG8_MMA(1, 1, At, B1); PG8_BAR;
            PG8_LDB(B0, 1, 0); PG8_SCHED; PG8_LDA(At, 1, 0); PG8_STAGE(PG8_SA(0, 1), a2 + hstepA, voffA);
            PG8_WAIT_L(8); PG8_BAR; PG8_WAIT_L(0); PG8_MMA(0, 0, At, B0); PG8_BAR; PG8_SCHED;
            PG8_LDB(B1, 1, 1); PG8_STAGE(PG8_SB(1, 0), b3, voffB);
            PG8_BAR; PG8_WAIT_L(0); if constexpr (!Epi::DIAG) PG8_MMA(0, 1, At, B1); PG8_BAR;
            PG8_LDA(At, 1, 1); PG8_STAGE(PG8_SA(1, 0), a3, voffA);
            PG8_BAR; PG8_WAIT_L(0); if constexpr (!Epi::DIAG) PG8_MMA(1, 0, At, B0); PG8_BAR; PG8_SCHED;
            PG8_STAGE(PG8_SB(1, 1), b3 + hstepB, voffB);
            PG8_WAIT_V(6); PG8_BAR; PG8_MMA(1, 1, At, B1); PG8_BAR;
        }
        E(acc, cur, wr, wc, fr, fq);
        if (!has_next) break;
#pragma unroll
        for (int a = 0; a < 2; ++a)
#pragma unroll
            for (int b = 0; b < 2; ++b)
#pragma unroll
                for (int m = 0; m < 4; ++m)
#pragma unroll
                    for (int n = 0; n < 2; ++n) acc[a][b][m][n] = (f32x4){0.f, 0.f, 0.f, 0.f};
        cur = nxt; cA = nA; cB = nB; ++ui;
    }
    PG8_WAIT_V(0);
    if (wr == 0) PG8_BAR;
    PG8_BAR;
#undef PG8_SA
#undef PG8_SB
#undef PG8_STAGE
#undef PG8_LDA
#undef PG8_LDB
#undef PG8_MMA
#undef PG8_WAIT_V
#undef PG8_WAIT_L
#undef PG8_BAR
#undef PG8_SCHED
}

typedef f32x4 Acc[2][2][4][2];

struct EpiAda {
    static constexpr bool PERM = false, MID = false, DIAG = false;
    float* C; const float* bias;
    __device__ __forceinline__ void operator()(const Acc& acc, const Unit& u, int wr, int wc, int fr, int fq) const {
        const int row0 = wr * 64 + fr, col0 = u.pn * BM + wc * 32 + 4 * fq;
#pragma unroll
        for (int ai = 0; ai < 2; ++ai)
#pragma unroll
            for (int m = 0; m < 4; ++m) { const int row = row0 + ai * HALF + m * 16; if (row < NB) {
#pragma unroll
                for (int bj = 0; bj < 2; ++bj)
#pragma unroll
                    for (int n = 0; n < 2; ++n) { const int c = col0 + bj * HALF + n * 16; *(f32x4*)(C + (size_t)row * MODW + c) = acc[ai][bj][m][n] + *(const f32x4*)(bias + c); } } }
    }
};
struct EpiBf16 {
    static constexpr bool PERM = true, MID = false, DIAG = false;
    bf16_t* O; int ldc; int col_off; const float* scale;
    __device__ __forceinline__ void operator()(const Acc& acc, const Unit& u, int wr, int wc, int fr, int fq) const {
        const int row0 = u.pm * BM + wr * 64 + fr, col0 = u.pn * BM + wc * 32 + 8 * fq;
#pragma unroll
        for (int ai = 0; ai < 2; ++ai)
#pragma unroll
            for (int m = 0; m < 4; ++m) { bf16_t* rowp = O + (size_t)(row0 + ai * HALF + m * 16) * ldc + col_off + col0;
#pragma unroll
                for (int bj = 0; bj < 2; ++bj) { f32x4 v0 = acc[ai][bj][m][0], v1 = acc[ai][bj][m][1];
                    if (scale) { v0 *= *(const f32x4*)(scale + col0 + bj * HALF); v1 *= *(const f32x4*)(scale + col0 + bj * HALF + 4); }
                    u32x4 w; w.x = pk2(v0[0], v0[1]); w.y = pk2(v0[2], v0[3]); w.z = pk2(v1[0], v1[1]); w.w = pk2(v1[2], v1[3]);
                    *(u32x4*)(rowp + bj * HALF) = w; }
                if (scale) asm volatile("" ::: "memory"); }
    }
};
struct EpiG1 {
    static constexpr bool PERM = true, MID = false, DIAG = false;
    float* T1; const bf16_t* proj;
    __device__ __forceinline__ void operator()(const Acc& acc, const Unit& u, int wr, int wc, int fr, int fq) const {
        const int row0 = u.pm * BM + wr * 64 + fr, col0 = u.pn * BM + wc * 32 + 8 * fq;
#pragma unroll
        for (int ai = 0; ai < 2; ++ai)
#pragma unroll
            for (int m = 0; m < 4; ++m) { const size_t row = (size_t)(row0 + ai * HALF + m * 16); const bf16_t* pr = proj + row * NPROJ + col0;
#pragma unroll
                for (int bj = 0; bj < 2; ++bj) { float ga[8]; unpack8(*(const u32x4*)(pr + C_GA + bj * HALF), ga); f32x4 v0, v1;
#pragma unroll
                    for (int j = 0; j < 4; ++j) { v0[j] = acc[ai][bj][m][0][j] * __builtin_amdgcn_rcpf(1.0f + __expf(-ga[j])); v1[j] = acc[ai][bj][m][1][j] * __builtin_amdgcn_rcpf(1.0f + __expf(-ga[4 + j])); }
                    float* o = T1 + row * DM + col0 + bj * HALF; *(f32x4*)o = v0; *(f32x4*)(o + 4) = v1; }
                }
    }
};
struct EpiG2 {
    static constexpr bool PERM = true, MID = false, DIAG = false;
    bf16_t* O; const float* T1; const bf16_t* proj;
    __device__ __forceinline__ void operator()(const Acc& acc, const Unit& u, int wr, int wc, int fr, int fq) const {
        const int row0 = u.pm * BM + wr * 64 + fr, col0 = u.pn * BM + wc * 32 + 8 * fq;
#pragma unroll
        for (int ai = 0; ai < 2; ++ai)
#pragma unroll
            for (int m = 0; m < 4; ++m) { const size_t row = (size_t)(row0 + ai * HALF + m * 16); const bf16_t* pr = proj + row * NPROJ + col0;
#pragma unroll
                for (int bj = 0; bj < 2; ++bj) { float gb[8], v[8]; unpack8(*(const u32x4*)(pr + C_GB + bj * HALF), gb);
                    const float* t = T1 + row * DM + col0 + bj * HALF; const f32x4 t0 = *(const f32x4*)t, t1 = *(const f32x4*)(t + 4);
#pragma unroll
                    for (int j = 0; j < 4; ++j) { v[j] = t0[j] + acc[ai][bj][m][0][j] * __builtin_amdgcn_rcpf(1.0f + __expf(-gb[j])); v[4 + j] = t1[j] + acc[ai][bj][m][1][j] * __builtin_amdgcn_rcpf(1.0f + __expf(-gb[4 + j])); }
                    *(u32x4*)(O + row * DM + col0 + bj * HALF) = pack8(v); }
                if (m & 1) asm volatile("" ::: "memory"); }
    }
};
struct EpiG12 {
    static constexpr bool PERM = true, MID = false, DIAG = false;
    EpiG1 e1; EpiG2 e2;
    __device__ __forceinline__ void operator()(const Acc& acc, const Unit& u, int wr, int wc, int fr, int fq) const { if (u.piece == 0) e1(acc, u, wr, wc, fr, fq); else e2(acc, u, wr, wc, fr, fq); }
};
struct EpiDiag {
    static constexpr bool PERM = true, MID = false, DIAG = true;
    bf16_t* O; const bf16_t* proj;
    __device__ __forceinline__ void operator()(const Acc& acc, const Unit& u, int wr, int wc, int fr, int fq) const {
        const int row0 = u.pm * HALF + wr * 64 + fr, col0 = u.pn * HALF + wc * 32 + 8 * fq;
#pragma unroll
        for (int m = 0; m < 4; ++m) { const size_t row = (size_t)(row0 + m * 16); const bf16_t* pr = proj + row * NPROJ + col0;
            float ga[8], gb[8], v[8]; unpack8(*(const u32x4*)(pr + C_GA), ga); unpack8(*(const u32x4*)(pr + C_GB), gb);
#pragma unroll
            for (int n = 0; n < 2; ++n)
#pragma unroll
                for (int j = 0; j < 4; ++j) v[4 * n + j] = acc[0][0][m][n][j] * __builtin_amdgcn_rcpf(1.0f + __expf(-ga[4 * n + j])) + acc[1][1][m][n][j] * __builtin_amdgcn_rcpf(1.0f + __expf(-gb[4 * n + j]));
            *(u32x4*)(O + row * DM + col0) = pack8(v); }
    }
};
struct EpiRes {
    static constexpr bool PERM = false, MID = false, DIAG = false;
    float* X1; const float* x0p; const float* x0s; const float* gate; float* PB;
    __device__ __forceinline__ void operator()(const Acc& acc, const Unit& u, int wr, int wc, int fr, int fq) const {
        const int row0 = u.pm * BM + wr * 64 + fr, col0 = u.pn * BM + wc * 32 + 4 * fq;
        if (u.piece >= 0) {
            float* pb = PB + (size_t)u.piece * TS * DM;
#pragma unroll
            for (int ai = 0; ai < 2; ++ai)
#pragma unroll
                for (int m = 0; m < 4; ++m) { float* orow = pb + (size_t)(row0 + ai * HALF + m * 16 - TP) * DM;
#pragma unroll
                    for (int bj = 0; bj < 2; ++bj)
#pragma unroll
                        for (int n = 0; n < 2; ++n) *(f32x4*)(orow + col0 + bj * HALF + n * 16) = acc[ai][bj][m][n]; }
            return;
        }
#pragma unroll
        for (int ai = 0; ai < 2; ++ai)
#pragma unroll
            for (int m = 0; m < 4; ++m) { const int row = row0 + ai * HALF + m * 16; const int b = bidx_of_row(row);
                const float* xr = (row < TP) ? x0p + (size_t)row * DM : x0s + (size_t)(row - TP) * DM; const float* gr = gate + (size_t)b * MODW; float* orow = X1 + (size_t)row * DM;
#pragma unroll
                for (int bj = 0; bj < 2; ++bj)
#pragma unroll
                    for (int n = 0; n < 2; ++n) { const int c = col0 + bj * HALF + n * 16; const f32x4 xv = *(const f32x4*)(xr + c), gv = *(const f32x4*)(gr + c);
                        *(f32x4*)(orow + c) = xv + gv * acc[ai][bj][m][n]; } }
    }
};
struct EpiGU {
    static constexpr bool PERM = true, MID = false, DIAG = false;
    bf16_t* O;
    __device__ __forceinline__ void operator()(const Acc& acc, const Unit& u, int wr, int wc, int fr, int fq) const {
        const int row0 = u.pm * BM + wr * 64 + fr, col0 = u.pn * HALF + wc * 32 + 8 * fq;
#pragma unroll
        for (int ai = 0; ai < 2; ++ai)
#pragma unroll
            for (int m = 0; m < 4; ++m) { float v[8];
#pragma unroll
                for (int n = 0; n < 2; ++n)
#pragma unroll
                    for (int j = 0; j < 4; ++j) { const float gt = acc[ai][0][m][n][j]; v[4 * n + j] = gt * __builtin_amdgcn_rcpf(1.0f + __expf(-gt)) * acc[ai][1][m][n][j]; }
                *(u32x4*)(O + (size_t)(row0 + ai * HALF + m * 16) * DFF + col0) = pack8(v); }
    }
};
}

struct TJob { const float* src; bf16_t* dst; int ld_src, K, Nout, ld_dst, map, pad; };
__device__ __forceinline__ int map_col(int map, int n) {
    if (map == 1) { if (n < 4096) return n; if (n < 5120) return 4112 + (n - 4096); if (n < 9216) return 5136 + (n - 5120); if (n < 9232) return 4096 + (n - 9216); return -1; }
    if (map == 2) { const int pn = n >> 8, w = n & 255; return w < 128 ? 128 * pn + w : DFF + 128 * pn + (w - 128); }
    return n;
}
__device__ __forceinline__ void tjob_load(const TJob& j, int tile, f32x4 (&v)[4]) {
    const int tid = threadIdx.x, nkt = j.K >> 7, tn = tile / nkt, tk = tile - tn * nkt;
    const int n = tn * 64 + (tid & 15) * 4, kr = tid >> 4, col = map_col(j.map, n);
#pragma unroll
    for (int i = 0; i < 4; ++i) v[i] = col >= 0 ? __builtin_nontemporal_load((const f32x4*)(j.src + (size_t)(tk * 128 + kr + 32 * i) * j.ld_src + col)) : (f32x4){0.f, 0.f, 0.f, 0.f};
}
__device__ __forceinline__ void tjob_store(const TJob& j, int tile, const f32x4 (&v)[4], LAS float* s) {
    const int tid = threadIdx.x, nkt = j.K >> 7, tn = tile / nkt, tk = tile - tn * nkt;
    const int nq = tid & 15, kr = tid >> 4;
    __syncthreads();
#pragma unroll
    for (int i = 0; i < 4; ++i)
#pragma unroll
        for (int q = 0; q < 4; ++q) s[(4 * nq + q) * 129 + kr + 32 * i] = v[i][q];
    __syncthreads();
    const int n = tid >> 3, k16 = (tid & 7) * 16;
    float f[16];
#pragma unroll
    for (int i = 0; i < 16; ++i) f[i] = s[n * 129 + k16 + i];
    bf16_t* d = j.dst + (size_t)(tn * 64 + n) * j.ld_dst + tk * 128 + k16;
    *(u32x4*)d = pack8(f); *(u32x4*)(d + 8) = pack8(f + 8);
}
__device__ __forceinline__ void transpose_jobs(const TJob* jobs, int njobs, int bi, int nblk, LAS unsigned char* lds) {
    LAS float* s = (LAS float*)lds;
    int total = 0;
    for (int q = 0; q < njobs; ++q) total += (jobs[q].Nout >> 6) * (jobs[q].K >> 7);
    f32x4 v[4]; int curj = 0, base = 0;
    int t = bi;
    auto locate = [&](int tt, int& jj, int& bb) { while (tt >= bb + (jobs[jj].Nout >> 6) * (jobs[jj].K >> 7)) { bb += (jobs[jj].Nout >> 6) * (jobs[jj].K >> 7); ++jj; } };
    if (t < total) { locate(t, curj, base); tjob_load(jobs[curj], t - base, v); }
    while (t < total) {
        const int tn = t + nblk; int nj = curj, nb = base; f32x4 w[4];
        if (tn < total) { locate(tn, nj, nb); tjob_load(jobs[nj], tn - nb, w); }
        tjob_store(jobs[curj], t - base, v, s);
        if (tn < total) {
#pragma unroll
            for (int i = 0; i < 4; ++i) v[i] = w[i]; }
        t = tn; curj = nj; base = nb;
    }
    __syncthreads();
}

template <int MODE>
__device__ __forceinline__ void norm_phase(const Params& p, int bid, int nblk) {
    const int lane = threadIdx.x & 63, wid = __builtin_amdgcn_readfirstlane(threadIdx.x >> 6);
    const float* mod = (const float*)(p.ws + WS_MOD);
    const float* gain = MODE == 0 ? p.in[9] : (MODE == 1 ? p.in[20] : p.in[23]);
    bf16_t* U = (bf16_t*)(p.ws + WS_U);
    for (int row = bid * 8 + wid; row < TT; row += nblk * 8) {
        const float* src = MODE == 0 ? (row < TP ? p.in[0] + (size_t)row * DM : p.in[1] + (size_t)(row - TP) * DM) : p.out + O_Y + (size_t)row * DM;
        if (MODE != 0 && row >= TP) {
            const float* xs = p.in[1] + (size_t)(row - TP) * DM;
            const float* pb = (const float*)(p.ws + (MODE == 1 ? WS_PB10 : WS_PB13)) + (size_t)(row - TP) * DM;
            const float* gt = mod + (size_t)bidx_of_row(row) * MODW + (MODE == 1 ? 4096 : 10240);
            float* xo = p.out + O_Y + (size_t)row * DM;
            constexpr int NPC = MODE == 1 ? 8 : 11;
#pragma unroll 1
            for (int i = 0; i < 8; ++i) { const int c = i * 256 + lane * 4; f32x4 s = *(const f32x4*)(pb + c);
#pragma unroll
                for (int q = 1; q < NPC; ++q) s += *(const f32x4*)(pb + (size_t)q * TS * DM + c);
                const f32x4 base = MODE == 1 ? *(const f32x4*)(xs + c) : *(const f32x4*)(xo + c);
                *(f32x4*)(xo + c) = base + *(const f32x4*)(gt + c) * s; }
            asm volatile("s_waitcnt vmcnt(0)" ::: "memory");
        }
        f32x4 v[8]; float ss = 0.f;
#pragma unroll
        for (int i = 0; i < 8; ++i) v[i] = *(const f32x4*)(src + i * 256 + lane * 4);
#pragma unroll
        for (int i = 0; i < 8; ++i) ss += v[i][0] * v[i][0] + v[i][1] * v[i][1] + v[i][2] * v[i][2] + v[i][3] * v[i][3];
#pragma unroll
        for (int o = 32; o >= 1; o >>= 1) ss += __shfl_xor(ss, o);
        const float rstd = rsqrtf(ss * (1.0f / DM) + EPS);
        if (MODE == 2) {
            float* dst = p.out + O_Y + (size_t)row * DM;
#pragma unroll
            for (int i = 0; i < 8; ++i) { const f32x4 g = *(const f32x4*)(gain + i * 256 + lane * 4); *(f32x4*)(dst + i * 256 + lane * 4) = v[i] * rstd * g; }
        } else {
            const float* sh = mod + (size_t)bidx_of_row(row) * MODW + (MODE == 0 ? 0 : 6144); const float* sc = sh + 2048;
#pragma unroll
            for (int i = 0; i < 8; ++i) { const int c = i * 256 + lane * 4; const f32x4 g = *(const f32x4*)(gain + c), s1 = *(const f32x4*)(sc + c), s0 = *(const f32x4*)(sh + c);
                const f32x4 y = (v[i] * rstd * g) * (1.0f + s1) + s0; u32x2 w; w.x = pk2(y[0], y[1]); w.y = pk2(y[2], y[3]); *(u32x2*)(U + (size_t)row * DM + c) = w; }
        }
    }
}

template <int NTOK, bool SMP>
__device__ __forceinline__ void mixer_item(const Params& p, int it) {
    const int tid = threadIdx.x;
    const bf16_t* proj = (const bf16_t*)(p.ws + WS_PROJ);
    bf16_t* qn = (bf16_t*)(p.ws + WS_QN); bf16_t* kn = (bf16_t*)(p.ws + WS_KN); bf16_t* vv = (bf16_t*)(p.ws + WS_VV); bf16_t* yp = (bf16_t*)(p.ws + WS_YP);
    float* gbuf = (float*)(p.ws + WS_G); float* bbuf = (float*)(p.ws + WS_BETA);
    const int sb = it - 512;
    const int b = SMP ? 0 : (it >> 7), t0 = SMP ? 0 : (it & 127) * 16;
    const int rowbase = SMP ? TP + sb * 4 : b * 2048 + t0;
    if (tid < 384) {
        const int c0 = tid * 8;
        float w0[8], w1[8], w2[8], w3[8], xm3[8], xm2[8], xm1[8];
        const float* cw = p.in[11];
#pragma unroll
        for (int i = 0; i < 8; ++i) { w0[i] = cw[c0 + i]; w1[i] = cw[3072 + c0 + i]; w2[i] = cw[6144 + c0 + i]; w3[i] = cw[9216 + c0 + i]; }
        if (SMP) { const float* sc = p.in[5] + (size_t)sb * 3 * 3072 + c0;
#pragma unroll
            for (int i = 0; i < 8; ++i) { xm3[i] = sc[i]; xm2[i] = sc[3072 + i]; xm1[i] = sc[6144 + i]; }
        } else if (t0 == 0) {
#pragma unroll
            for (int i = 0; i < 8; ++i) { xm3[i] = 0.f; xm2[i] = 0.f; xm1[i] = 0.f; }
        } else {
            unpack8(*(const u32x4*)(proj + (size_t)(rowbase - 3) * NPROJ + c0), xm3); unpack8(*(const u32x4*)(proj + (size_t)(rowbase - 2) * NPROJ + c0), xm2); unpack8(*(const u32x4*)(proj + (size_t)(rowbase - 1) * NPROJ + c0), xm1);
        }
        constexpr int CH = NTOK < 8 ? NTOK : 8;
#pragma unroll 1
        for (int tc = 0; tc < NTOK; tc += CH) {
        u32x4 xr[CH];
#pragma unroll
        for (int t = 0; t < CH; ++t) xr[t] = *(const u32x4*)(proj + (size_t)(rowbase + tc + t) * NPROJ + c0);
#pragma unroll
        for (int t2 = 0; t2 < CH; ++t2) {
            const int t = tc + t2;
            const int row = rowbase + t; float xt[8], y[8];
            unpack8(xr[t2], xt);
            float ss = 0.f;
#pragma unroll
            for (int i = 0; i < 8; ++i) { const float a = w0[i] * xm3[i] + w1[i] * xm2[i] + w2[i] * xm1[i] + w3[i] * xt[i]; y[i] = siluf_(a); ss += y[i] * y[i]; }
            if (c0 < 2048) {
                ss += __shfl_xor(ss, 1); ss += __shfl_xor(ss, 2); ss += __shfl_xor(ss, 4); ss += __shfl_xor(ss, 8);
                const float inv = rsqrtf(ss + EPS);
#pragma unroll
                for (int i = 0; i < 8; ++i) y[i] *= inv;
            }
            bf16_t* dst = c0 < 1024 ? qn + (size_t)row * 1024 + c0 : (c0 < 2048 ? kn + (size_t)row * 1024 + (c0 - 1024) : vv + (size_t)row * 1024 + (c0 - 2048));
            *(u32x4*)dst = pack8(y);
            if (SMP) { if (t >= 1) { float* o = p.out + O_CS + ((size_t)sb * 3 + (t - 1)) * 3072 + c0; *(f32x4*)o = (f32x4){xt[0], xt[1], xt[2], xt[3]}; *(f32x4*)(o + 4) = (f32x4){xt[4], xt[5], xt[6], xt[7]}; } }
            else if (t0 + t >= 2045) { float* o = p.out + O_CP + ((size_t)b * 3 + (t0 + t - 2045)) * 3072 + c0; *(f32x4*)o = (f32x4){xt[0], xt[1], xt[2], xt[3]}; *(f32x4*)(o + 4) = (f32x4){xt[4], xt[5], xt[6], xt[7]}; }
#pragma unroll
            for (int i = 0; i < 8; ++i) { xm3[i] = xm2[i]; xm2[i] = xm1[i]; xm1[i] = xt[i]; }
        }
        }
    } else {
        const int pc = (tid - 384) * 8, gi = pc >> 8, w = 2 << gi;
        const int seqrow0 = SMP ? TP + sb * 4 : b * 2048;
        const float* sp = p.in[6] + (size_t)sb * 15 * 1024 + pc;
        auto xpool = [&](int tt, float* f) {
            if (tt >= 0) unpack8(*(const u32x4*)(proj + (size_t)(seqrow0 + tt) * NPROJ + C_XP + pc), f);
            else if (SMP) { const float* s = sp + (size_t)(15 + tt) * 1024;
#pragma unroll
                for (int i = 0; i < 8; ++i) f[i] = s[i]; }
            else {
#pragma unroll
                for (int i = 0; i < 8; ++i) f[i] = 0.f; }
        };
        float s[8];
#pragma unroll
        for (int i = 0; i < 8; ++i) s[i] = 0.f;
#pragma unroll
        for (int q = 1; q < 16; ++q) if (q < w) { float f[8]; xpool(t0 - q, f);
#pragma unroll
            for (int i = 0; i < 8; ++i) s[i] += f[i]; }
#pragma unroll 4
        for (int t = 0; t < NTOK; ++t) {
            const int tt = t0 + t; float x[8], y[8], f[8];
            xpool(tt, x);
            const float cnt = SMP ? (float)w : (float)min(w, tt + 1); const float ic = 1.0f / cnt;
#pragma unroll
            for (int i = 0; i < 8; ++i) { s[i] += x[i]; y[i] = s[i] * ic - x[i]; }
            *(u32x4*)(yp + (size_t)(seqrow0 + tt) * 1024 + pc) = pack8(y);
            xpool(tt - w + 1, f);
#pragma unroll
            for (int i = 0; i < 8; ++i) s[i] -= f[i];
            if (SMP) { float* o = p.out + O_PS + ((size_t)sb * 15 + 11 + t) * 1024 + pc; *(f32x4*)o = (f32x4){x[0], x[1], x[2], x[3]}; *(f32x4*)(o + 4) = (f32x4){x[4], x[5], x[6], x[7]}; }
            else if (tt >= 2033) { float* o = p.out + O_PP + ((size_t)b * 15 + (tt - 2033)) * 1024 + pc; *(f32x4*)o = (f32x4){x[0], x[1], x[2], x[3]}; *(f32x4*)(o + 4) = (f32x4){x[4], x[5], x[6], x[7]}; }
        }
        if (SMP) {
#pragma unroll
            for (int r = 0; r < 11; ++r) { const float* s2 = sp + (size_t)(4 + r) * 1024; float* o = p.out + O_PS + ((size_t)sb * 15 + r) * 1024 + pc; *(f32x4*)o = *(const f32x4*)s2; *(f32x4*)(o + 4) = *(const f32x4*)(s2 + 4); } }
    }
    if (tid < 256) { const int tk = tid >> 4, jj = tid & 15;
        if (tk < NTOK) { const int row = rowbase + tk; const float val = bf2f(proj[(size_t)row * NPROJ + C_AB + jj]);
            if (jj < 8) { const float xx = val + p.in[13][jj]; const float spl = xx > 20.f ? xx : log1pf(__expf(xx)); gbuf[row * 8 + jj] = -__expf(p.in[12][jj]) * spl; }
            else bbuf[row * 8 + (jj - 8)] = sigmoidf_(val); } }
}
__device__ __forceinline__ void mixer_prep_phase(const Params& p, int bid, int nblk) {
    for (int it = bid; it < 640; it += nblk) { if (it >= 512) mixer_item<4, true>(p, it); else mixer_item<16, false>(p, it); }
}

constexpr int P5_QS = 0, P5_KS = 17408, P5_VS = 34816, P5_MM = 52224, P5_DEC = 68608, P5_BETA = 68864, P5_GRP = 69632;
static_assert(2 * P5_GRP <= LDS_BYTES - 16, "lds");
__device__ __forceinline__ void chunk_prep_phase(const Params& p, int bid, int nblk, LAS unsigned char* lds0) {
    const int tid = threadIdx.x, lane = tid & 63, grp = tid >> 8, lt = tid & 255, lw = __builtin_amdgcn_readfirstlane(tid >> 6) & 3;
    LAS unsigned char* lds = lds0 + grp * P5_GRP;
    const bf16_t* qn = (const bf16_t*)(p.ws + WS_QN); const bf16_t* kn = (const bf16_t*)(p.ws + WS_KN); const bf16_t* vv = (const bf16_t*)(p.ws + WS_VV);
    const float* gbuf = (const float*)(p.ws + WS_G); const float* bbuf = (const float*)(p.ws + WS_BETA);
    bf16_t* wdc = (bf16_t*)(p.ws + WS_WDC); bf16_t* qd = (bf16_t*)(p.ws + WS_QD); bf16_t* kt = (bf16_t*)(p.ws + WS_KT); bf16_t* qk = (bf16_t*)(p.ws + WS_QK);
    float* cdv = (float*)(p.ws + WS_CD); float* ub = p.out + OS_UB;
    LAS float* Mm = (LAS float*)(lds + P5_MM); LAS float* dec = (LAS float*)(lds + P5_DEC); LAS float* bet = (LAS float*)(lds + P5_BETA);
    const float scale = 0.08838834764831845f;
    for (int it0 = bid * 2; it0 < 1024; it0 += nblk * 2) {
        const int item = it0 + grp, n = item & 31, bh = item >> 5, h = bh & 7, b = bh >> 3;
        const int r0 = b * 2048 + n * 64;
        __syncthreads();
#pragma unroll
        for (int i = 0; i < 4; ++i) { const int ch = lt + 256 * i, r = ch >> 4, c8 = (ch & 15) * 8; const size_t go = (size_t)(r0 + r) * 1024 + h * 128 + c8; const int lo = r * 272 + c8 * 2;
            *(LAS u32x4*)(lds + P5_QS + lo) = *(const u32x4*)(qn + go); *(LAS u32x4*)(lds + P5_KS + lo) = *(const u32x4*)(kn + go); *(LAS u32x4*)(lds + P5_VS + lo) = *(const u32x4*)(vv + go); }
        if (lt < 64) {
            float g = gbuf[(r0 + lt) * 8 + h];
#pragma unroll
            for (int o = 1; o < 64; o <<= 1) { const float t = __shfl_up(g, o); if (lane >= o) g += t; }
            dec[lt] = g;
        } else if (lt < 128) bet[lt - 64] = bbuf[(r0 + lt - 64) * 8 + h];
        __syncthreads();
        {
            const int rt = lw, fr = lane & 15, fq = lane >> 4;
#pragma unroll
            for (int mat = 0; mat < 2; ++mat) {
                bf16x8 a[4];
#pragma unroll
                for (int kk = 0; kk < 4; ++kk) a[kk] = *(const LAS bf16x8*)(lds + (mat ? P5_QS : P5_KS) + (rt * 16 + fr) * 272 + (kk * 32 + fq * 8) * 2);
#pragma unroll
                for (int st = 0; st < 4; ++st) {
                    f32x4 d = (f32x4){0.f, 0.f, 0.f, 0.f};
#pragma unroll
                    for (int kk = 0; kk < 4; ++kk) { const bf16x8 bb = *(const LAS bf16x8*)(lds + P5_KS + (st * 16 + fr) * 272 + (kk * 32 + fq * 8) * 2); d = __builtin_amdgcn_mfma_f32_16x16x32_bf16(a[kk], bb, d, 0, 0, 0); }
                    const int s = st * 16 + fr; const float ds = dec[s];
#pragma unroll
                    for (int j = 0; j < 4; ++j) { const int r = rt * 16 + fq * 4 + j; const float dr = dec[r];
                        if (mat == 0) Mm[r * 64 + s] = (r > s) ? bet[r] * d[j] * __expf(dr - ds) : 0.f;
                        else qk[(size_t)item * 4096 + r * 64 + s] = f2bf((r >= s) ? scale * d[j] * __expf(dr - ds) : 0.f); }
                }
            }
        }
        __syncthreads();
        const int w8 = __builtin_amdgcn_readfirstlane(tid >> 6);
        if (w8 < 4) {
            const int g2 = w8 >> 1, c = (w8 & 1) * 64 + lane; const int item2 = it0 + g2;
            LAS unsigned char* lg = lds0 + g2 * P5_GRP; LAS float* Mg = (LAS float*)(lg + P5_MM); LAS float* decg = (LAS float*)(lg + P5_DEC); LAS float* betg = (LAS float*)(lg + P5_BETA);
            float x[64], y[64]; f32x4 mq[6]; float a0, a1, b0, b1;
            float* up = ub + (size_t)item2 * 8192 + c; bf16_t* wp = wdc + (size_t)item2 * 8192 + c;
            { const float br = betg[0]; a0 = bf2f(*(const LAS bf16_t*)(lg + P5_VS + 0 + c * 2)) * br; b0 = bf2f(*(const LAS bf16_t*)(lg + P5_KS + 0 + c * 2)) * br * __expf(decg[0]); a1 = 0.f; b1 = 0.f; } x[0] = a0; y[0] = b0; up[0] = x[0]; wp[0] = f2bf(-y[0]);
            mq[0] = *(const LAS f32x4*)(Mg + 64); mq[1] = *(const LAS f32x4*)(Mg + 128); mq[2] = *(const LAS f32x4*)(Mg + 192); mq[3] = *(const LAS f32x4*)(Mg + 256); mq[4] = *(const LAS f32x4*)(Mg + 320); mq[5] = *(const LAS f32x4*)(Mg + 324);
            { const float br = betg[1]; a0 = bf2f(*(const LAS bf16_t*)(lg + P5_VS + 272 + c * 2)) * br; b0 = bf2f(*(const LAS bf16_t*)(lg + P5_KS + 272 + c * 2)) * br * __expf(decg[1]); a1 = 0.f; b1 = 0.f; } a0 -= mq[0][0] * x[0]; b0 -= mq[0][0] * y[0]; x[1] = a0 + a1; y[1] = b0 + b1; up[128] = x[1]; wp[128] = f2bf(-y[1]); mq[0] = *(const LAS f32x4*)(Mg + 384);
            { const float br = betg[2]; a0 = bf2f(*(const LAS bf16_t*)(lg + P5_VS + 544 + c * 2)) * br; b0 = bf2f(*(const LAS bf16_t*)(lg + P5_KS + 544 + c * 2)) * br * __expf(decg[2]); a1 = 0.f; b1 = 0.f; } a0 -= mq[1][0] * x[0]; b0 -= mq[1][0] * y[0]; a1 -= mq[1][1] * x[1]; b1 -= mq[1][1] * y[1]; x[2] = a0 + a1; y[2] = b0 + b1; up[256] = x[2]; wp[256] = f2bf(-y[2]); mq[1] = *(const LAS f32x4*)(Mg + 388);
            { const float br = betg[3]; a0 = bf2f(*(const LAS bf16_t*)(lg + P5_VS + 816 + c * 2)) * br; b0 = bf2f(*(const LAS bf16_t*)(lg + P5_KS + 816 + c * 2)) * br * __expf(decg[3]); a1 = 0.f; b1 = 0.f; } a0 -= mq[2][0] * x[0]; b0 -= mq[2][0] * y[0]; a1 -= mq[2][1] * x[1]; b1 -= mq[2][1] * y[1]; a0 -= mq[2][2] * x[2]; b0 -= mq[2][2] * y[2]; x[3] = a0 + a1; y[3] = b0 + b1; up[384] = x[3]; wp[384] = f2bf(-y[3]); mq[2] = *(const LAS f32x4*)(Mg + 448);
            { const float br = betg[4]; a0 = bf2f(*(const LAS bf16_t*)(lg + P5_VS + 1088 + c * 2)) * br; b0 = bf2f(*(const LAS bf16_t*)(lg + P5_KS + 1088 + c * 2)) * br * __expf(decg[4]); a1 = 0.f; b1 = 0.f; } a0 -= mq[3][0] * x[0]; b0 -= mq[3][0] * y[0]; a1 -= mq[3][1] * x[1]; b1 -= mq[3][1] * y[1]; a0 -= mq[3][2] * x[2]; b0 -= mq[3][2] * y[2]; a1 -= mq[3][3] * x[3]; b1 -= mq[3][3] * y[3]; x[4] = a0 + a1; y[4] = b0 + b1; up[512] = x[4]; wp[512] = f2bf(-y[4]); mq[3] = *(const LAS f32x4*)(Mg + 452);
            { const float br = betg[5]; a0 = bf2f(*(const LAS bf16_t*)(lg + P5_VS + 1360 + c * 2)) * br; b0 = bf2f(*(const LAS bf16_t*)(lg + P5_KS + 1360 + c * 2)) * br * __expf(decg[5]); a1 = 0.f; b1 = 0.f; } a0 -= mq[4][0] * x[0]; b0 -= mq[4][0] * y[0]; a1 -= mq[4][1] * x[1]; b1 -= mq[4][1] * y[1]; a0 -= mq[4][2] * x[2]; b0 -= mq[4][2] * y[2]; a1 -= mq[4][3] * x[3]; b1 -= mq[4][3] * y[3]; mq[4] = *(const LAS f32x4*)(Mg + 512);
            a0 -= mq[5][0] * x[4]; b0 -= mq[5][0] * y[4]; x[5] = a0 + a1; y[5] = b0 + b1; up[640] = x[5]; wp[640] = f2bf(-y[5]); mq[5] = *(const LAS f32x4*)(Mg + 516);
            { const float br = betg[6]; a0 = bf2f(*(const LAS bf16_t*)(lg + P5_VS + 1632 + c * 2)) * br; b0 = bf2f(*(const LAS bf16_t*)(lg + P5_KS + 1632 + c * 2)) * br * __expf(decg[6]); a1 = 0.f; b1 = 0.f; } a0 -= mq[0][0] * x[0]; b0 -= mq[0][0] * y[0]; a1 -= mq[0][1] * x[1]; b1 -= mq[0][1] * y[1]; a0 -= mq[0][2] * x[2]; b0 -= mq[0][2] * y[2]; a1 -= mq[0][3] * x[3]; b1 -= mq[0][3] * y[3]; mq[0] = *(const LAS f32x4*)(Mg + 576);
            a0 -= mq[1][0] * x[4]; b0 -= mq[1][0] * y[4]; a1 -= mq[1][1] * x[5]; b1 -= mq[1][1] * y[5]; x[6] = a0 + a1; y[6] = b0 + b1; up[768] = x[6]; wp[768] = f2bf(-y[6]); mq[1] = *(const LAS f32x4*)(Mg + 580);
            { const float br = betg[7]; a0 = bf2f(*(const LAS bf16_t*)(lg + P5_VS + 1904 + c * 2)) * br; b0 = bf2f(*(const LAS bf16_t*)(lg + P5_KS + 1904 + c * 2)) * br * __expf(decg[7]); a1 = 0.f; b1 = 0.f; } a0 -= mq[2][0] * x[0]; b0 -= mq[2][0] * y[0]; a1 -= mq[2][1] * x[1]; b1 -= mq[2][1] * y[1]; a0 -= mq[2][2] * x[2]; b0 -= mq[2][2] * y[2]; a1 -= mq[2][3] * x[3]; b1 -= mq[2][3] * y[3]; mq[2] = *(const LAS f32x4*)(Mg + 584);
            a0 -= mq[3][0] * x[4]; b0 -= mq[3][0] * y[4]; a1 -= mq[3][1] * x[5]; b1 -= mq[3][1] * y[5]; a0 -= mq[3][2] * x[6]; b0 -= mq[3][2] * y[6]; x[7] = a0 + a1; y[7] = b0 + b1; up[896] = x[7]; wp[896] = f2bf(-y[7]); mq[3] = *(const LAS f32x4*)(Mg + 640);
            { const float br = betg[8]; a0 = bf2f(*(const LAS bf16_t*)(lg + P5_VS + 2176 + c * 2)) * br; b0 = bf2f(*(const LAS bf16_t*)(lg + P5_KS + 2176 + c * 2)) * br * __expf(decg[8]); a1 = 0.f; b1 = 0.f; } a0 -= mq[4][0] * x[0]; b0 -= mq[4][0] * y[0]; a1 -= mq[4][1] * x[1]; b1 -= mq[4][1] * y[1]; a0 -= mq[4][2] * x[2]; b0 -= mq[4][2] * y[2]; a1 -= mq[4][3] * x[3]; b1 -= mq[4][3] * y[3]; mq[4] = *(const LAS f32x4*)(Mg + 644);
            a0 -= mq[5][0] * x[4]; b0 -= mq[5][0] * y[4]; a1 -= mq[5][1] * x[5]; b1 -= mq[5][1] * y[5]; a0 -= mq[5][2] * x[6]; b0 -= mq[5][2] * y[6]; a1 -= mq[5][3] * x[7]; b1 -= mq[5][3] * y[7]; x[8] = a0 + a1; y[8] = b0 + b1; up[1024] = x[8]; wp[1024] = f2bf(-y[8]); mq[5] = *(const LAS f32x4*)(Mg + 648);
            { const float br = betg[9]; a0 = bf2f(*(const LAS bf16_t*)(lg + P5_VS + 2448 + c * 2)) * br; b0 = bf2f(*(const LAS bf16_t*)(lg + P5_KS + 2448 + c * 2)) * br * __expf(decg[9]); a1 = 0.f; b1 = 0.f; } a0 -= mq[0][0] * x[0]; b0 -= mq[0][0] * y[0]; a1 -= mq[0][1] * x[1]; b1 -= mq[0][1] * y[1]; a0 -= mq[0][2] * x[2]; b0 -= mq[0][2] * y[2]; a1 -= mq[0][3] * x[3]; b1 -= mq[0][3] * y[3]; mq[0] = *(const LAS f32x4*)(Mg + 704);
            a0 -= mq[1][0] * x[4]; b0 -= mq[1][0] * y[4]; a1 -= mq[1][1] * x[5]; b1 -= mq[1][1] * y[5]; a0 -= mq[1][2] * x[6]; b0 -= mq[1][2] * y[6]; a1 -= mq[1][3] * x[7]; b1 -= mq[1][3] * y[7]; mq[1] = *(const LAS f32x4*)(Mg + 708);
            a0 -= mq[2][0] * x[8]; b0 -= mq[2][0] * y[8]; x[9] = a0 + a1; y[9] = b0 + b1; up[1152] = x[9]; wp[1152] = f2bf(-y[9]); mq[2] = *(const LAS f32x4*)(Mg + 712);
            { const float br = betg[10]; a0 = bf2f(*(const LAS bf16_t*)(lg + P5_VS + 2720 + c * 2)) * br; b0 = bf2f(*(const LAS bf16_t*)(lg + P5_KS + 2720 + c * 2)) * br * __expf(decg[10]); a1 = 0.f; b1 = 0.f; } a0 -= mq[3][0] * x[0]; b0 -= mq[3][0] * y[0]; a1 -= mq[3][1] * x[1]; b1 -= mq[3][1] * y[1]; a0 -= mq[3][2] * x[2]; b0 -= mq[3][2] * y[2]; a1 -= mq[3][3] * x[3]; b1 -= mq[3][3] * y[3]; mq[3] = *(const LAS f32x4*)(Mg + 768);
            a0 -= mq[4][0] * x[4]; b0 -= mq[4][0] * y[4]; a1 -= mq[4][1] * x[5]; b1 -= mq[4][1] * y[5]; a0 -= mq[4][2] * x[6]; b0 -= mq[4][2] * y[6]; a1 -= mq[4][3] * x[7]; b1 -= mq[4][3] * y[7]; mq[4] = *(const LAS f32x4*)(Mg + 772);
            a0 -= mq[5][0] * x[8]; b0 -= mq[5][0] * y[8]; a1 -= mq[5][1] * x[9]; b1 -= mq[5][1] * y[9]; x[10] = a0 + a1; y[10] = b0 + b1; up[1280] = x[10]; wp[1280] = f2bf(-y[10]); mq[5] = *(const LAS f32x4*)(Mg + 776);
            { const float br = betg[11]; a0 = bf2f(*(const LAS bf16_t*)(lg + P5_VS + 2992 + c * 2)) * br; b0 = bf2f(*(const LAS bf16_t*)(lg + P5_KS + 2992 + c * 2)) * br * __expf(decg[11]); a1 = 0.f; b1 = 0.f; } a0 -= mq[0][0] * x[0]; b0 -= mq[0][0] * y[0]; a1 -= mq[0][1] * x[1]; b1 -= mq[0][1] * y[1]; a0 -= mq[0][2] * x[2]; b0 -= mq[0][2] * y[2]; a1 -= mq[0][3] * x[3]; b1 -= mq[0][3] * y[3]; mq[0] = *(const LAS f32x4*)(Mg + 832);
            a0 -= mq[1][0] * x[4]; b0 -= mq[1][0] * y[4]; a1 -= mq[1][1] * x[5]; b1 -= mq[1][1] * y[5]; a0 -= mq[1][2] * x[6]; b0 -= mq[1][2] * y[6]; a1 -= mq[1][3] * x[7]; b1 -= mq[1][3] * y[7]; mq[1] = *(const LAS f32x4*)(Mg + 836);
            a0 -= mq[2][0] * x[8]; b0 -= mq[2][0] * y[8]; a1 -= mq[2][1] * x[9]; b1 -= mq[2][1] * y[9]; a0 -= mq[2][2] * x[10]; b0 -= mq[2][2] * y[10]; x[11] = a0 + a1; y[11] = b0 + b1; up[1408] = x[11]; wp[1408] = f2bf(-y[11]); mq[2] = *(const LAS f32x4*)(Mg + 840);
            { const float br = betg[12]; a0 = bf2f(*(const LAS bf16_t*)(lg + P5_VS + 3264 + c * 2)) * br; b0 = bf2f(*(const LAS bf16_t*)(lg + P5_KS + 3264 + c * 2)) * br * __expf(decg[12]); a1 = 0.f; b1 = 0.f; } a0 -= mq[3][0] * x[0]; b0 -= mq[3][0] * y[0]; a1 -= mq[3][1] * x[1]; b1 -= mq[3][1] * y[1]; a0 -= mq[3][2] * x[2]; b0 -= mq[3][2] * y[2]; a1 -= mq[3][3] * x[3]; b1 -= mq[3][3] * y[3]; mq[3] = *(const LAS f32x4*)(Mg + 844);
            a0 -= mq[4][0] * x[4]; b0 -= mq[4][0] * y[4]; a1 -= mq[4][1] * x[5]; b1 -= mq[4][1] * y[5]; a0 -= mq[4][2] * x[6]; b0 -= mq[4][2] * y[6]; a1 -= mq[4][3] * x[7]; b1 -= mq[4][3] * y[7]; mq[4] = *(const LAS f32x4*)(Mg + 896);
            a0 -= mq[5][0] * x[8]; b0 -= mq[5][0] * y[8]; a1 -= mq[5][1] * x[9]; b1 -= mq[5][1] * y[9]; a0 -= mq[5][2] * x[10]; b0 -= mq[5][2] * y[10]; a1 -= mq[5][3] * x[11]; b1 -= mq[5][3] * y[11]; x[12] = a0 + a1; y[12] = b0 + b1; up[1536] = x[12]; wp[1536] = f2bf(-y[12]); mq[5] = *(const LAS f32x4*)(Mg + 900);
            { const float br = betg[13]; a0 = bf2f(*(const LAS bf16_t*)(lg + P5_VS + 3536 + c * 2)) * br; b0 = bf2f(*(const LAS bf16_t*)(lg + P5_KS + 3536 + c * 2)) * br * __expf(decg[13]); a1 = 0.f; b1 = 0.f; } a0 -= mq[0][0] * x[0]; b0 -= mq[0][0] * y[0]; a1 -= mq[0][1] * x[1]; b1 -= mq[0][1] * y[1]; a0 -= mq[0][2] * x[2]; b0 -= mq[0][2] * y[2]; a1 -= mq[0][3] * x[3]; b1 -= mq[0][3] * y[3]; mq[0] = *(const LAS f32x4*)(Mg + 904);
            a0 -= mq[1][0] * x[4]; b0 -= mq[1][0] * y[4]; a1 -= mq[1][1] * x[5]; b1 -= mq[1][1] * y[5]; a0 -= mq[1][2] * x[6]; b0 -= mq[1][2] * y[6]; a1 -= mq[1][3] * x[7]; b1 -= mq[1][3] * y[7]; mq[1] = *(const LAS f32x4*)(Mg + 908);
            a0 -= mq[2][0] * x[8]; b0 -= mq[2][0] * y[8]; a1 -= mq[2][1] * x[9]; b1 -= mq[2][1] * y[9]; a0 -= mq[2][2] * x[10]; b0 -= mq[2][2] * y[10]; a1 -= mq[2][3] * x[11]; b1 -= mq[2][3] * y[11]; mq[2] = *(const LAS f32x4*)(Mg + 960);
            a0 -= mq[3][0] * x[12]; b0 -= mq[3][0] * y[12]; x[13] = a0 + a1; y[13] = b0 + b1; up[1664] = x[13]; wp[1664] = f2bf(-y[13]); mq[3] = *(const LAS f32x4*)(Mg + 964);
            { const float br = betg[14]; a0 = bf2f(*(const LAS bf16_t*)(lg + P5_VS + 3808 + c * 2)) * br; b0 = bf2f(*(const LAS bf16_t*)(lg + P5_KS + 3808 + c * 2)) * br * __expf(decg[14]); a1 = 0.f; b1 = 0.f; } a0 -= mq[4][0] * x[0]; b0 -= mq[4][0] * y[0]; a1 -= mq[4][1] * x[1]; b1 -= mq[4][1] * y[1]; a0 -= mq[4][2] * x[2]; b0 -= mq[4][2] * y[2]; a1 -= mq[4][3] * x[3]; b1 -= mq[4][3] * y[3]; mq[4] = *(const LAS f32x4*)(Mg + 968);
            a0 -= mq[5][0] * x[4]; b0 -= mq[5][0] * y[4]; a1 -= mq[5][1] * x[5]; b1 -= mq[5][1] * y[5]; a0 -= mq[5][2] * x[6]; b0 -= mq[5][2] * y[6]; a1 -= mq[5][3] * x[7]; b1 -= mq[5][3] * y[7]; mq[5] = *(const LAS f32x4*)(Mg + 972);
            a0 -= mq[0][0] * x[8]; b0 -= mq[0][0] * y[8]; a1 -= mq[0][1] * x[9]; b1 -= mq[0][1] * y[9]; a0 -= mq[0][2] * x[10]; b0 -= mq[0][2] * y[10]; a1 -= mq[0][3] * x[11]; b1 -= mq[0][3] * y[11]; mq[0] = *(const LAS f32x4*)(Mg + 1024);
            a0 -= mq[1][0] * x[12]; b0 -= mq[1][0] * y[12]; a1 -= mq[1][1] * x[13]; b1 -= mq[1][1] * y[13]; x[14] = a0 + a1; y[14] = b0 + b1; up[1792] = x[14]; wp[1792] = f2bf(-y[14]); mq[1] = *(const LAS f32x4*)(Mg + 1028);
            { const float br = betg[15]; a0 = bf2f(*(const LAS bf16_t*)(lg + P5_VS + 4080 + c * 2)) * br; b0 = bf2f(*(const LAS bf16_t*)(lg + P5_KS + 4080 + c * 2)) * br * __expf(decg[15]); a1 = 0.f; b1 = 0.f; } a0 -= mq[2][0] * x[0]; b0 -= mq[2][0] * y[0]; a1 -= mq[2][1] * x[1]; b1 -= mq[2][1] * y[1]; a0 -= mq[2][2] * x[2]; b0 -= mq[2][2] * y[2]; a1 -= mq[2][3] * x[3]; b1 -= mq[2][3] * y[3]; mq[2] = *(const LAS f32x4*)(Mg + 1032);
            a0 -= mq[3][0] * x[4]; b0 -= mq[3][0] * y[4]; a1 -= mq[3][1] * x[5]; b1 -= mq[3][1] * y[5]; a0 -= mq[3][2] * x[6]; b0 -= mq[3][2] * y[6]; a1 -= mq[3][3] * x[7]; b1 -= mq[3][3] * y[7]; mq[3] = *(const LAS f32x4*)(Mg + 1036);
            a0 -= mq[4][0] * x[8]; b0 -= mq[4][0] * y[8]; a1 -= mq[4][1] * x[9]; b1 -= mq[4][1] * y[9]; a0 -= mq[4][2] * x[10]; b0 -= mq[4][2] * y[10]; a1 -= mq[4][3] * x[11]; b1 -= mq[4][3] * y[11]; mq[4] = *(const LAS f32x4*)(Mg + 1088);
            a0 -= mq[5][0] * x[12]; b0 -= mq[5][0] * y[12]; a1 -= mq[5][1] * x[13]; b1 -= mq[5][1] * y[13]; a0 -= mq[5][2] * x[14]; b0 -= mq[5][2] * y[14]; x[15] = a0 + a1; y[15] = b0 + b1; up[1920] = x[15]; wp[1920] = f2bf(-y[15]); mq[5] = *(const LAS f32x4*)(Mg + 1092);
            { const float br = betg[16]; a0 = bf2f(*(const LAS bf16_t*)(lg + P5_VS + 4352 + c * 2)) * br; b0 = bf2f(*(const LAS bf16_t*)(lg + P5_KS + 4352 + c * 2)) * br * __expf(decg[16]); a1 = 0.f; b1 = 0.f; } a0 -= mq[0][0] * x[0]; b0 -= mq[0][0] * y[0]; a1 -= mq[0][1] * x[1]; b1 -= mq[0][1] * y[1]; a0 -= mq[0][2] * x[2]; b0 -= mq[0][2] * y[2]; a1 -= mq[0][3] * x[3]; b1 -= mq[0][3] * y[3]; mq[0] = *(const LAS f32x4*)(Mg + 1096);
            a0 -= mq[1][0] * x[4]; b0 -= mq[1][0] * y[4]; a1 -= mq[1][1] * x[5]; b1 -= mq[1][1] * y[5]; a0 -= mq[1][2] * x[6]; b0 -= mq[1][2] * y[6]; a1 -= mq[1][3] * x[7]; b1 -= mq[1][3] * y[7]; mq[1] = *(const LAS f32x4*)(Mg + 1100);
            a0 -= mq[2][0] * x[8]; b0 -= mq[2][0] * y[8]; a1 -= mq[2][1] * x[9]; b1 -= mq[2][1] * y[9]; a0 -= mq[2][2] * x[10]; b0 -= mq[2][2] * y[10]; a1 -= mq[2][3] * x[11]; b1 -= mq[2][3] * y[11]; mq[2] = *(const LAS f32x4*)(Mg + 1104);
            a0 -= mq[3][0] * x[12]; b0 -= mq[3][0] * y[12]; a1 -= mq[3][1] * x[13]; b1 -= mq[3][1] * y[13]; a0 -= mq[3][2] * x[14]; b0 -= mq[3][2] * y[14]; a1 -= mq[3][3] * x[15]; b1 -= mq[3][3] * y[15]; x[16] = a0 + a1; y[16] = b0 + b1; up[2048] = x[16]; wp[2048] = f2bf(-y[16]); mq[3] = *(const LAS f32x4*)(Mg + 1152);
            { const float br = betg[17]; a0 = bf2f(*(const LAS bf16_t*)(lg + P5_VS + 4624 + c * 2)) * br; b0 = bf2f(*(const LAS bf16_t*)(lg + P5_KS + 4624 + c * 2)) * br * __expf(decg[17]); a1 = 0.f; b1 = 0.f; } a0 -= mq[4][0] * x[0]; b0 -= mq[4][0] * y[0]; a1 -= mq[4][1] * x[1]; b1 -= mq[4][1] * y[1]; a0 -= mq[4][2] * x[2]; b0 -= mq[4][2] * y[2]; a1 -= mq[4][3] * x[3]; b1 -= mq[4][3] * y[3]; mq[4] = *(const LAS f32x4*)(Mg + 1156);
            a0 -= mq[5][0] * x[4]; b0 -= mq[5][0] * y[4]; a1 -= mq[5][1] * x[5]; b1 -= mq[5][1] * y[5]; a0 -= mq[5][2] * x[6]; b0 -= mq[5][2] * y[6]; a1 -= mq[5][3] * x[7]; b1 -= mq[5][3] * y[7]; mq[5] = *(const LAS f32x4*)(Mg + 1160);
            a0 -= mq[0][0] * x[8]; b0 -= mq[0][0] * y[8]; a1 -= mq[0][1] * x[9]; b1 -= mq[0][1] * y[9]; a0 -= mq[0][2] * x[10]; b0 -= mq[0][2] * y[10]; a1 -= mq[0][3] * x[11]; b1 -= mq[0][3] * y[11]; mq[0] = *(const LAS f32x4*)(Mg + 1164);
            a0 -= mq[1][0] * x[12]; b0 -= mq[1][0] * y[12]; a1 -= mq[1][1] * x[13]; b1 -= mq[1][1] * y[13]; a0 -= mq[1][2] * x[14]; b0 -= mq[1][2] * y[14]; a1 -= mq[1][3] * x[15]; b1 -= mq[1][3] * y[15]; mq[1] = *(const LAS f32x4*)(Mg + 1168);
            a0 -= mq[2][0] * x[16]; b0 -= mq[2][0] * y[16]; x[17] = a0 + a1; y[17] = b0 + b1; up[2176] = x[17]; wp[2176] = f2bf(-y[17]); mq[2] = *(const LAS f32x4*)(Mg + 1216);
            { const float br = betg[18]; a0 = bf2f(*(const LAS bf16_t*)(lg + P5_VS + 4896 + c * 2)) * br; b0 = bf2f(*(const LAS bf16_t*)(lg + P5_KS + 4896 + c * 2)) * br * __expf(decg[18]); a1 = 0.f; b1 = 0.f; } a0 -= mq[3][0] * x[0]; b0 -= mq[3][0] * y[0]; a1 -= mq[3][1] * x[1]; b1 -= mq[3][1] * y[1]; a0 -= mq[3][2] * x[2]; b0 -= mq[3][2] * y[2]; a1 -= mq[3][3] * x[3]; b1 -= mq[3][3] * y[3]; mq[3] = *(const LAS f32x4*)(Mg + 1220);
            a0 -= mq[4][0] * x[4]; b0 -= mq[4][0] * y[4]; a1 -= mq[4][1] * x[5]; b1 -= mq[4][1] * y[5]; a0 -= mq[4][2] * x[6]; b0 -= mq[4][2] * y[6]; a1 -= mq[4][3] * x[7]; b1 -= mq[4][3] * y[7]; mq[4] = *(const LAS f32x4*)(Mg + 1224);
            a0 -= mq[5][0] * x[8]; b0 -= mq[5][0] * y[8]; a1 -= mq[5][1] * x[9]; b1 -= mq[5][1] * y[9]; a0 -= mq[5][2] * x[10]; b0 -= mq[5][2] * y[10]; a1 -= mq[5][3] * x[11]; b1 -= mq[5][3] * y[11]; mq[5] = *(const LAS f32x4*)(Mg + 1228);
            a0 -= mq[0][0] * x[12]; b0 -= mq[0][0] * y[12]; a1 -= mq[0][1] * x[13]; b1 -= mq[0][1] * y[13]; a0 -= mq[0][2] * x[14]; b0 -= mq[0][2] * y[14]; a1 -= mq[0][3] * x[15]; b1 -= mq[0][3] * y[15]; mq[0] = *(const LAS f32x4*)(Mg + 1232);
            a0 -= mq[1][0] * x[16]; b0 -= mq[1][0] * y[16]; a1 -= mq[1][1] * x[17]; b1 -= mq[1][1] * y[17]; x[18] = a0 + a1; y[18] = b0 + b1; up[2304] = x[18]; wp[2304] = f2bf(-y[18]); mq[1] = *(const LAS f32x4*)(Mg + 1280);
            { const float br = betg[19]; a0 = bf2f(*(const LAS bf16_t*)(lg + P5_VS + 5168 + c * 2)) * br; b0 = bf2f(*(const LAS bf16_t*)(lg + P5_KS + 5168 + c * 2)) * br * __expf(decg[19]); a1 = 0.f; b1 = 0.f; } a0 -= mq[2][0] * x[0]; b0 -= mq[2][0] * y[0]; a1 -= mq[2][1] * x[1]; b1 -= mq[2][1] * y[1]; a0 -= mq[2][2] * x[2]; b0 -= mq[2][2] * y[2]; a1 -= mq[2][3] * x[3]; b1 -= mq[2][3] * y[3]; mq[2] = *(const LAS f32x4*)(Mg + 1284);
            a0 -= mq[3][0] * x[4]; b0 -= mq[3][0] * y[4]; a1 -= mq[3][1] * x[5]; b1 -= mq[3][1] * y[5]; a0 -= mq[3][2] * x[6]; b0 -= mq[3][2] * y[6]; a1 -= mq[3][3] * x[7]; b1 -= mq[3][3] * y[7]; mq[3] = *(const LAS f32x4*)(Mg + 1288);
            a0 -= mq[4][0] * x[8]; b0 -= mq[4][0] * y[8]; a1 -= mq[4][1] * x[9]; b1 -= mq[4][1] * y[9]; a0 -= mq[4][2] * x[10]; b0 -= mq[4][2] * y[10]; a1 -= mq[4][3] * x[11]; b1 -= mq[4][3] * y[11]; mq[4] = *(const LAS f32x4*)(Mg + 1292);
            a0 -= mq[5][0] * x[12]; b0 -= mq[5][0] * y[12]; a1 -= mq[5][1] * x[13]; b1 -= mq[5][1] * y[13]; a0 -= mq[5][2] * x[14]; b0 -= mq[5][2] * y[14]; a1 -= mq[5][3] * x[15]; b1 -= mq[5][3] * y[15]; mq[5] = *(const LAS f32x4*)(Mg + 1296);
            a0 -= mq[0][0] * x[16]; b0 -= mq[0][0] * y[16]; a1 -= mq[0][1] * x[17]; b1 -= mq[0][1] * y[17]; a0 -= mq[0][2] * x[18]; b0 -= mq[0][2] * y[18]; x[19] = a0 + a1; y[19] = b0 + b1; up[2432] = x[19]; wp[2432] = f2bf(-y[19]); mq[0] = *(const LAS f32x4*)(Mg + 1344);
            { const float br = betg[20]; a0 = bf2f(*(const LAS bf16_t*)(lg + P5_VS + 5440 + c * 2)) * br; b0 = bf2f(*(const LAS bf16_t*)(lg + P5_KS + 5440 + c * 2)) * br * __expf(decg[20]); a1 = 0.f; b1 = 0.f; } a0 -= mq[1][0] * x[0]; b0 -= mq[1][0] * y[0]; a1 -= mq[1][1] * x[1]; b1 -= mq[1][1] * y[1]; a0 -= mq[1][2] * x[2]; b0 -= mq[1][2] * y[2]; a1 -= mq[1][3] * x[3]; b1 -= mq[1][3] * y[3]; mq[1] = *(const LAS f32x4*)(Mg + 1348);
            a0 -= mq[2][0] * x[4]; b0 -= mq[2][0] * y[4]; a1 -= mq[2][1] * x[5]; b1 -= mq[2][1] * y[5]; a0 -= mq[2][2] * x[6]; b0 -= mq[2][2] * y[6]; a1 -= mq[2][3] * x[7]; b1 -= mq[2][3] * y[7]; mq[2] = *(const LAS f32x4*)(Mg + 1352);
            a0 -= mq[3][0] * x[8]; b0 -= mq[3][0] * y[8]; a1 -= mq[3][1] * x[9]; b1 -= mq[3][1] * y[9]; a0 -= mq[3][2] * x[10]; b0 -= mq[3][2] * y[10]; a1 -= mq[3][3] * x[11]; b1 -= mq[3][3] * y[11]; mq[3] = *(const LAS f32x4*)(Mg + 1356);
            a0 -= mq[4][0] * x[12]; b0 -= mq[4][0] * y[12]; a1 -= mq[4][1] * x[13]; b1 -= mq[4][1] * y[13]; a0 -= mq[4][2] * x[14]; b0 -= mq[4][2] * y[14]; a1 -= mq[4][3] * x[15]; b1 -= mq[4][3] * y[15]; mq[4] = *(const LAS f32x4*)(Mg + 1360);
            a0 -= mq[5][0] * x[16]; b0 -= mq[5][0] * y[16]; a1 -= mq[5][1] * x[17]; b1 -= mq[5][1] * y[17]; a0 -= mq[5][2] * x[18]; b0 -= mq[5][2] * y[18]; a1 -= mq[5][3] * x[19]; b1 -= mq[5][3] * y[19]; x[20] = a0 + a1; y[20] = b0 + b1; up[2560] = x[20]; wp[2560] = f2bf(-y[20]); mq[5] = *(const LAS f32x4*)(Mg + 1364);
            { const float br = betg[21]; a0 = bf2f(*(const LAS bf16_t*)(lg + P5_VS + 5712 + c * 2)) * br; b0 = bf2f(*(const LAS bf16_t*)(lg + P5_KS + 5712 + c * 2)) * br * __expf(decg[21]); a1 = 0.f; b1 = 0.f; } a0 -= mq[0][0] * x[0]; b0 -= mq[0][0] * y[0]; a1 -= mq[0][1] * x[1]; b1 -= mq[0][1] * y[1]; a0 -= mq[0][2] * x[2]; b0 -= mq[0][2] * y[2]; a1 -= mq[0][3] * x[3]; b1 -= mq[0][3] * y[3]; mq[0] = *(const LAS f32x4*)(Mg + 1408);
            a0 -= mq[1][0] * x[4]; b0 -= mq[1][0] * y[4]; a1 -= mq[1][1] * x[5]; b1 -= mq[1][1] * y[5]; a0 -= mq[1][2] * x[6]; b0 -= mq[1][2] * y[6]; a1 -= mq[1][3] * x[7]; b1 -= mq[1][3] * y[7]; mq[1] = *(const LAS f32x4*)(Mg + 1412);
            a0 -= mq[2][0] * x[8]; b0 -= mq[2][0] * y[8]; a1 -= mq[2][1] * x[9]; b1 -= mq[2][1] * y[9]; a0 -= mq[2][2] * x[10]; b0 -= mq[2][2] * y[10]; a1 -= mq[2][3] * x[11]; b1 -= mq[2][3] * y[11]; mq[2] = *(const LAS f32x4*)(Mg + 1416);
            a0 -= mq[3][0] * x[12]; b0 -= mq[3][0] * y[12]; a1 -= mq[3][1] * x[13]; b1 -= mq[3][1] * y[13]; a0 -= mq[3][2] * x[14]; b0 -= mq[3][2] * y[14]; a1 -= mq[3][3] * x[15]; b1 -= mq[3][3] * y[15]; mq[3] = *(const LAS f32x4*)(Mg + 1420);
            a0 -= mq[4][0] * x[16]; b0 -= mq[4][0] * y[16]; a1 -= mq[4][1] * x[17]; b1 -= mq[4][1] * y[17]; a0 -= mq[4][2] * x[18]; b0 -= mq[4][2] * y[18]; a1 -= mq[4][3] * x[19]; b1 -= mq[4][3] * y[19]; mq[4] = *(const LAS f32x4*)(Mg + 1424);
            a0 -= mq[5][0] * x[20]; b0 -= mq[5][0] * y[20]; x[21] = a0 + a1; y[21] = b0 + b1; up[2688] = x[21]; wp[2688] = f2bf(-y[21]); mq[5] = *(const LAS f32x4*)(Mg + 1428);
            { const float br = betg[22]; a0 = bf2f(*(const LAS bf16_t*)(lg + P5_VS + 5984 + c * 2)) * br; b0 = bf2f(*(const LAS bf16_t*)(lg + P5_KS + 5984 + c * 2)) * br * __expf(decg[22]); a1 = 0.f; b1 = 0.f; } a0 -= mq[0][0] * x[0]; b0 -= mq[0][0] * y[0]; a1 -= mq[0][1] * x[1]; b1 -= mq[0][1] * y[1]; a0 -= mq[0][2] * x[2]; b0 -= mq[0][2] * y[2]; a1 -= mq[0][3] * x[3]; b1 -= mq[0][3] * y[3]; mq[0] = *(const LAS f32x4*)(Mg + 1472);
            a0 -= mq[1][0] * x[4]; b0 -= mq[1][0] * y[4]; a1 -= mq[1][1] * x[5]; b1 -= mq[1][1] * y[5]; a0 -= mq[1][2] * x[6]; b0 -= mq[1][2] * y[6]; a1 -= mq[1][3] * x[7]; b1 -= mq[1][3] * y[7]; mq[1] = *(const LAS f32x4*)(Mg + 1476);
            a0 -= mq[2][0] * x[8]; b0 -= mq[2][0] * y[8]; a1 -= mq[2][1] * x[9]; b1 -= mq[2][1] * y[9]; a0 -= mq[2][2] * x[10]; b0 -= mq[2][2] * y[10]; a1 -= mq[2][3] * x[11]; b1 -= mq[2][3] * y[11]; mq[2] = *(const LAS f32x4*)(Mg + 1480);
            a0 -= mq[3][0] * x[12]; b0 -= mq[3][0] * y[12]; a1 -= mq[3][1] * x[13]; b1 -= mq[3][1] * y[13]; a0 -= mq[3][2] * x[14]; b0 -= mq[3][2] * y[14]; a1 -= mq[3][3] * x[15]; b1 -= mq[3][3] * y[15]; mq[3] = *(const LAS f32x4*)(Mg + 1484);
            a0 -= mq[4][0] * x[16]; b0 -= mq[4][0] * y[16]; a1 -= mq[4][1] * x[17]; b1 -= mq[4][1] * y[17]; a0 -= mq[4][2] * x[18]; b0 -= mq[4][2] * y[18]; a1 -= mq[4][3] * x[19]; b1 -= mq[4][3] * y[19]; mq[4] = *(const LAS f32x4*)(Mg + 1488);
            a0 -= mq[5][0] * x[20]; b0 -= mq[5][0] * y[20]; a1 -= mq[5][1] * x[21]; b1 -= mq[5][1] * y[21]; x[22] = a0 + a1; y[22] = b0 + b1; up[2816] = x[22]; wp[2816] = f2bf(-y[22]); mq[5] = *(const LAS f32x4*)(Mg + 1492);
            { const float br = betg[23]; a0 = bf2f(*(const LAS bf16_t*)(lg + P5_VS + 6256 + c * 2)) * br; b0 = bf2f(*(const LAS bf16_t*)(lg + P5_KS + 6256 + c * 2)) * br * __expf(decg[23]); a1 = 0.f; b1 = 0.f; } a0 -= mq[0][0] * x[0]; b0 -= mq[0][0] * y[0]; a1 -= mq[0][1] * x[1]; b1 -= mq[0][1] * y[1]; a0 -= mq[0][2] * x[2]; b0 -= mq[0][2] * y[2]; a1 -= mq[0][3] * x[3]; b1 -= mq[0][3] * y[3]; mq[0] = *(const LAS f32x4*)(Mg + 1536);
            a0 -= mq[1][0] * x[4]; b0 -= mq[1][0] * y[4]; a1 -= mq[1][1] * x[5]; b1 -= mq[1][1] * y[5]; a0 -= mq[1][2] * x[6]; b0 -= mq[1][2] * y[6]; a1 -= mq[1][3] * x[7]; b1 -= mq[1][3] * y[7]; mq[1] = *(const LAS f32x4*)(Mg + 1540);
            a0 -= mq[2][0] * x[8]; b0 -= mq[2][0] * y[8]; a1 -= mq[2][1] * x[9]; b1 -= mq[2][1] * y[9]; a0 -= mq[2][2] * x[10]; b0 -= mq[2][2] * y[10]; a1 -= mq[2][3] * x[11]; b1 -= mq[2][3] * y[11]; mq[2] = *(const LAS f32x4*)(Mg + 1544);
            a0 -= mq[3][0] * x[12]; b0 -= mq[3][0] * y[12]; a1 -= mq[3][1] * x[13]; b1 -= mq[3][1] * y[13]; a0 -= mq[3][2] * x[14]; b0 -= mq[3][2] * y[14]; a1 -= mq[3][3] * x[15]; b1 -= mq[3][3] * y[15]; mq[3] = *(const LAS f32x4*)(Mg + 1548);
            a0 -= mq[4][0] * x[16]; b0 -= mq[4][0] * y[16]; a1 -= mq[4][1] * x[17]; b1 -= mq[4][1] * y[17]; a0 -= mq[4][2] * x[18]; b0 -= mq[4][2] * y[18]; a1 -= mq[4][3] * x[19]; b1 -= mq[4][3] * y[19]; mq[4] = *(const LAS f32x4*)(Mg + 1552);
            a0 -= mq[5][0] * x[20]; b0 -= mq[5][0] * y[20]; a1 -= mq[5][1] * x[21]; b1 -= mq[5][1] * y[21]; a0 -= mq[5][2] * x[22]; b0 -= mq[5][2] * y[22]; x[23] = a0 + a1; y[23] = b0 + b1; up[2944] = x[23]; wp[2944] = f2bf(-y[23]); mq[5] = *(const LAS f32x4*)(Mg + 1556);
            { const float br = betg[24]; a0 = bf2f(*(const LAS bf16_t*)(lg + P5_VS + 6528 + c * 2)) * br; b0 = bf2f(*(const LAS bf16_t*)(lg + P5_KS + 6528 + c * 2)) * br * __expf(decg[24]); a1 = 0.f; b1 = 0.f; } a0 -= mq[0][0] * x[0]; b0 -= mq[0][0] * y[0]; a1 -= mq[0][1] * x[1]; b1 -= mq[0][1] * y[1]; a0 -= mq[0][2] * x[2]; b0 -= mq[0][2] * y[2]; a1 -= mq[0][3] * x[3]; b1 -= mq[0][3] * y[3]; mq[0] = *(const LAS f32x4*)(Mg + 1600);
            a0 -= mq[1][0] * x[4]; b0 -= mq[1][0] * y[4]; a1 -= mq[1][1] * x[5]; b1 -= mq[1][1] * y[5]; a0 -= mq[1][2] * x[6]; b0 -= mq[1][2] * y[6]; a1 -= mq[1][3] * x[7]; b1 -= mq[1][3] * y[7]; mq[1] = *(const LAS f32x4*)(Mg + 1604);
            a0 -= mq[2][0] * x[8]; b0 -= mq[2][0] * y[8]; a1 -= mq[2][1] * x[9]; b1 -= mq[2][1] * y[9]; a0 -= mq[2][2] * x[10]; b0 -= mq[2][2] * y[10]; a1 -= mq[2][3] * x[11]; b1 -= mq[2][3] * y[11]; mq[2] = *(const LAS f32x4*)(Mg + 1608);
            a0 -= mq[3][0] * x[12]; b0 -= mq[3][0] * y[12]; a1 -= mq[3][1] * x[13]; b1 -= mq[3][1] * y[13]; a0 -= mq[3][2] * x[14]; b0 -= mq[3][2] * y[14]; a1 -= mq[3][3] * x[15]; b1 -= mq[3][3] * y[15]; mq[3] = *(const LAS f32x4*)(Mg + 1612);
            a0 -= mq[4][0] * x[16]; b0 -= mq[4][0] * y[16]; a1 -= mq[4][1] * x[17]; b1 -= mq[4][1] * y[17]; a0 -= mq[4][2] * x[18]; b0 -= mq[4][2] * y[18]; a1 -= mq[4][3] * x[19]; b1 -= mq[4][3] * y[19]; mq[4] = *(const LAS f32x4*)(Mg + 1616);
            a0 -= mq[5][0] * x[20]; b0 -= mq[5][0] * y[20]; a1 -= mq[5][1] * x[21]; b1 -= mq[5][1] * y[21]; a0 -= mq[5][2] * x[22]; b0 -= mq[5][2] * y[22]; a1 -= mq[5][3] * x[23]; b1 -= mq[5][3] * y[23]; x[24] = a0 + a1; y[24] = b0 + b1; up[3072] = x[24]; wp[3072] = f2bf(-y[24]); mq[5] = *(const LAS f32x4*)(Mg + 1620);
            { const float br = betg[25]; a0 = bf2f(*(const LAS bf16_t*)(lg + P5_VS + 6800 + c * 2)) * br; b0 = bf2f(*(const LAS bf16_t*)(lg + P5_KS + 6800 + c * 2)) * br * __expf(decg[25]); a1 = 0.f; b1 = 0.f; } a0 -= mq[0][0] * x[0]; b0 -= mq[0][0] * y[0]; a1 -= mq[0][1] * x[1]; b1 -= mq[0][1] * y[1]; a0 -= mq[0][2] * x[2]; b0 -= mq[0][2] * y[2]; a1 -= mq[0][3] * x[3]; b1 -= mq[0][3] * y[3]; mq[0] = *(const LAS f32x4*)(Mg + 1624);
            a0 -= mq[1][0] * x[4]; b0 -= mq[1][0] * y[4]; a1 -= mq[1][1] * x[5]; b1 -= mq[1][1] * y[5]; a0 -= mq[1][2] * x[6]; b0 -= mq[1][2] * y[6]; a1 -= mq[1][3] * x[7]; b1 -= mq[1][3] * y[7]; mq[1] = *(const LAS f32x4*)(Mg + 1664);
            a0 -= mq[2][0] * x[8]; b0 -= mq[2][0] * y[8]; a1 -= mq[2][1] * x[9]; b1 -= mq[2][1] * y[9]; a0 -= mq[2][2] * x[10]; b0 -= mq[2][2] * y[10]; a1 -= mq[2][3] * x[11]; b1 -= mq[2][3] * y[11]; mq[2] = *(const LAS f32x4*)(Mg + 1668);
            a0 -= mq[3][0] * x[12]; b0 -= mq[3][0] * y[12]; a1 -= mq[3][1] * x[13]; b1 -= mq[3][1] * y[13]; a0 -= mq[3][2] * x[14]; b0 -= mq[3][2] * y[14]; a1 -= mq[3][3] * x[15]; b1 -= mq[3][3] * y[15]; mq[3] = *(const LAS f32x4*)(Mg + 1672);
            a0 -= mq[4][0] * x[16]; b0 -= mq[4][0] * y[16]; a1 -= mq[4][1] * x[17]; b1 -= mq[4][1] * y[17]; a0 -= mq[4][2] * x[18]; b0 -= mq[4][2] * y[18]; a1 -= mq[4][3] * x[19]; b1 -= mq[4][3] * y[19]; mq[4] = *(const LAS f32x4*)(Mg + 1676);
            a0 -= mq[5][0] * x[20]; b0 -= mq[5][0] * y[20]; a1 -= mq[5][1] * x[21]; b1 -= mq[5][1] * y[21]; a0 -= mq[5][2] * x[22]; b0 -= mq[5][2] * y[22]; a1 -= mq[5][3] * x[23]; b1 -= mq[5][3] * y[23]; mq[5] = *(const LAS f32x4*)(Mg + 1680);
            a0 -= mq[0][0] * x[24]; b0 -= mq[0][0] * y[24]; x[25] = a0 + a1; y[25] = b0 + b1; up[3200] = x[25]; wp[3200] = f2bf(-y[25]); mq[0] = *(const LAS f32x4*)(Mg + 1684);
            { const float br = betg[26]; a0 = bf2f(*(const LAS bf16_t*)(lg + P5_VS + 7072 + c * 2)) * br; b0 = bf2f(*(const LAS bf16_t*)(lg + P5_KS + 7072 + c * 2)) * br * __expf(decg[26]); a1 = 0.f; b1 = 0.f; } a0 -= mq[1][0] * x[0]; b0 -= mq[1][0] * y[0]; a1 -= mq[1][1] * x[1]; b1 -= mq[1][1] * y[1]; a0 -= mq[1][2] * x[2]; b0 -= mq[1][2] * y[2]; a1 -= mq[1][3] * x[3]; b1 -= mq[1][3] * y[3]; mq[1] = *(const LAS f32x4*)(Mg + 1688);
            a0 -= mq[2][0] * x[4]; b0 -= mq[2][0] * y[4]; a1 -= mq[2][1] * x[5]; b1 -= mq[2][1] * y[5]; a0 -= mq[2][2] * x[6]; b0 -= mq[2][2] * y[6]; a1 -= mq[2][3] * x[7]; b1 -= mq[2][3] * y[7]; mq[2] = *(const LAS f32x4*)(Mg + 1728);
            a0 -= mq[3][0] * x[8]; b0 -= mq[3][0] * y[8]; a1 -= mq[3][1] * x[9]; b1 -= mq[3][1] * y[9]; a0 -= mq[3][2] * x[10]; b0 -= mq[3][2] * y[10]; a1 -= mq[3][3] * x[11]; b1 -= mq[3][3] * y[11]; mq[3] = *(const LAS f32x4*)(Mg + 1732);
            a0 -= mq[4][0] * x[12]; b0 -= mq[4][0] * y[12]; a1 -= mq[4][1] * x[13]; b1 -= mq[4][1] * y[13]; a0 -= mq[4][2] * x[14]; b0 -= mq[4][2] * y[14]; a1 -= mq[4][3] * x[15]; b1 -= mq[4][3] * y[15]; mq[4] = *(const LAS f32x4*)(Mg + 1736);
            a0 -= mq[5][0] * x[16]; b0 -= mq[5][0] * y[16]; a1 -= mq[5][1] * x[17]; b1 -= mq[5][1] * y[17]; a0 -= mq[5][2] * x[18]; b0 -= mq[5][2] * y[18]; a1 -= mq[5][3] * x[19]; b1 -= mq[5][3] * y[19]; mq[5] = *(const LAS f32x4*)(Mg + 1740);
            a0 -= mq[0][0] * x[20]; b0 -= mq[0][0] * y[20]; a1 -= mq[0][1] * x[21]; b1 -= mq[0][1] * y[21]; a0 -= mq[0][2] * x[22]; b0 -= mq[0][2] * y[22]; a1 -= mq[0][3] * x[23]; b1 -= mq[0][3] * y[23]; mq[0] = *(const LAS f32x4*)(Mg + 1744);
            a0 -= mq[1][0] * x[24]; b0 -= mq[1][0] * y[24]; a1 -= mq[1][1] * x[25]; b1 -= mq[1][1] * y[25]; x[26] = a0 + a1; y[26] = b0 + b1; up[3328] = x[26]; wp[3328] = f2bf(-y[26]); mq[1] = *(const LAS f32x4*)(Mg + 1748);
            { const float br = betg[27]; a0 = bf2f(*(const LAS bf16_t*)(lg + P5_VS + 7344 + c * 2)) * br; b0 = bf2f(*(const LAS bf16_t*)(lg + P5_KS + 7344 + c * 2)) * br * __expf(decg[27]); a1 = 0.f; b1 = 0.f; } a0 -= mq[2][0] * x[0]; b0 -= mq[2][0] * y[0]; a1 -= mq[2][1] * x[1]; b1 -= mq[2][1] * y[1]; a0 -= mq[2][2] * x[2]; b0 -= mq[2][2] * y[2]; a1 -= mq[2][3] * x[3]; b1 -= mq[2][3] * y[3]; mq[2] = *(const LAS f32x4*)(Mg + 1752);
            a0 -= mq[3][0] * x[4]; b0 -= mq[3][0] * y[4]; a1 -= mq[3][1] * x[5]; b1 -= mq[3][1] * y[5]; a0 -= mq[3][2] * x[6]; b0 -= mq[3][2] * y[6]; a1 -= mq[3][3] * x[7]; b1 -= mq[3][3] * y[7]; mq[3] = *(const LAS f32x4*)(Mg + 1792);
            a0 -= mq[4][0] * x[8]; b0 -= mq[4][0] * y[8]; a1 -= mq[4][1] * x[9]; b1 -= mq[4][1] * y[9]; a0 -= mq[4][2] * x[10]; b0 -= mq[4][2] * y[10]; a1 -= mq[4][3] * x[11]; b1 -= mq[4][3] * y[11]; mq[4] = *(const LAS f32x4*)(Mg + 1796);
            a0 -= mq[5][0] * x[12]; b0 -= mq[5][0] * y[12]; a1 -= mq[5][1] * x[13]; b1 -= mq[5][1] * y[13]; a0 -= mq[5][2] * x[14]; b0 -= mq[5][2] * y[14]; a1 -= mq[5][3] * x[15]; b1 -= mq[5][3] * y[15]; mq[5] = *(const LAS f32x4*)(Mg + 1800);
            a0 -= mq[0][0] * x[16]; b0 -= mq[0][0] * y[16]; a1 -= mq[0][1] * x[17]; b1 -= mq[0][1] * y[17]; a0 -= mq[0][2] * x[18]; b0 -= mq[0][2] * y[18]; a1 -= mq[0][3] * x[19]; b1 -= mq[0][3] * y[19]; mq[0] = *(const LAS f32x4*)(Mg + 1804);
            a0 -= mq[1][0] * x[20]; b0 -= mq[1][0] * y[20]; a1 -= mq[1][1] * x[21]; b1 -= mq[1][1] * y[21]; a0 -= mq[1][2] * x[22]; b0 -= mq[1][2] * y[22]; a1 -= mq[1][3] * x[23]; b1 -= mq[1][3] * y[23]; mq[1] = *(const LAS f32x4*)(Mg + 1808);
            a0 -= mq[2][0] * x[24]; b0 -= mq[2][0] * y[24]; a1 -= mq[2][1] * x[25]; b1 -= mq[2][1] * y[25]; a0 -= mq[2][2] * x[26]; b0 -= mq[2][2] * y[26]; x[27] = a0 + a1; y[27] = b0 + b1; up[3456] = x[27]; wp[3456] = f2bf(-y[27]); mq[2] = *(const LAS f32x4*)(Mg + 1812);
            { const float br = betg[28]; a0 = bf2f(*(const LAS bf16_t*)(lg + P5_VS + 7616 + c * 2)) * br; b0 = bf2f(*(const LAS bf16_t*)(lg + P5_KS + 7616 + c * 2)) * br * __expf(decg[28]); a1 = 0.f; b1 = 0.f; } a0 -= mq[3][0] * x[0]; b0 -= mq[3][0] * y[0]; a1 -= mq[3][1] * x[1]; b1 -= mq[3][1] * y[1]; a0 -= mq[3][2] * x[2]; b0 -= mq[3][2] * y[2]; a1 -= mq[3][3] * x[3]; b1 -= mq[3][3] * y[3]; mq[3] = *(const LAS f32x4*)(Mg + 1816);
            a0 -= mq[4][0] * x[4]; b0 -= mq[4][0] * y[4]; a1 -= mq[4][1] * x[5]; b1 -= mq[4][1] * y[5]; a0 -= mq[4][2] * x[6]; b0 -= mq[4][2] * y[6]; a1 -= mq[4][3] * x[7]; b1 -= mq[4][3] * y[7]; mq[4] = *(const LAS f32x4*)(Mg + 1856);
            a0 -= mq[5][0] * x[8]; b0 -= mq[5][0] * y[8]; a1 -= mq[5][1] * x[9]; b1 -= mq[5][1] * y[9]; a0 -= mq[5][2] * x[10]; b0 -= mq[5][2] * y[10]; a1 -= mq[5][3] * x[11]; b1 -= mq[5][3] * y[11]; mq[5] = *(const LAS f32x4*)(Mg + 1860);
            a0 -= mq[0][0] * x[12]; b0 -= mq[0][0] * y[12]; a1 -= mq[0][1] * x[13]; b1 -= mq[0][1] * y[13]; a0 -= mq[0][2] * x[14]; b0 -= mq[0][2] * y[14]; a1 -= mq[0][3] * x[15]; b1 -= mq[0][3] * y[15]; mq[0] = *(const LAS f32x4*)(Mg + 1864);
            a0 -= mq[1][0] * x[16]; b0 -= mq[1][0] * y[16]; a1 -= mq[1][1] * x[17]; b1 -= mq[1][1] * y[17]; a0 -= mq[1][2] * x[18]; b0 -= mq[1][2] * y[18]; a1 -= mq[1][3] * x[19]; b1 -= mq[1][3] * y[19]; mq[1] = *(const LAS f32x4*)(Mg + 1868);
            a0 -= mq[2][0] * x[20]; b0 -= mq[2][0] * y[20]; a1 -= mq[2][1] * x[21]; b1 -= mq[2][1] * y[21]; a0 -= mq[2][2] * x[22]; b0 -= mq[2][2] * y[22]; a1 -= mq[2][3] * x[23]; b1 -= mq[2][3] * y[23]; mq[2] = *(const LAS f32x4*)(Mg + 1872);
            a0 -= mq[3][0] * x[24]; b0 -= mq[3][0] * y[24]; a1 -= mq[3][1] * x[25]; b1 -= mq[3][1] * y[25]; a0 -= mq[3][2] * x[26]; b0 -= mq[3][2] * y[26]; a1 -= mq[3][3] * x[27]; b1 -= mq[3][3] * y[27]; x[28] = a0 + a1; y[28] = b0 + b1; up[3584] = x[28]; wp[3584] = f2bf(-y[28]); mq[3] = *(const LAS f32x4*)(Mg + 1876);
            { const float br = betg[29]; a0 = bf2f(*(const LAS bf16_t*)(lg + P5_VS + 7888 + c * 2)) * br; b0 = bf2f(*(const LAS bf16_t*)(lg + P5_KS + 7888 + c * 2)) * br * __expf(decg[29]); a1 = 0.f; b1 = 0.f; } a0 -= mq[4][0] * x[0]; b0 -= mq[4][0] * y[0]; a1 -= mq[4][1] * x[1]; b1 -= mq[4][1] * y[1]; a0 -= mq[4][2] * x[2]; b0 -= mq[4][2] * y[2]; a1 -= mq[4][3] * x[3]; b1 -= mq[4][3] * y[3]; mq[4] = *(const LAS f32x4*)(Mg + 1880);
            a0 -= mq[5][0] * x[4]; b0 -= mq[5][0] * y[4]; a1 -= mq[5][1] * x[5]; b1 -= mq[5][1] * y[5]; a0 -= mq[5][2] * x[6]; b0 -= mq[5][2] * y[6]; a1 -= mq[5][3] * x[7]; b1 -= mq[5][3] * y[7]; mq[5] = *(const LAS f32x4*)(Mg + 1884);
            a0 -= mq[0][0] * x[8]; b0 -= mq[0][0] * y[8]; a1 -= mq[0][1] * x[9]; b1 -= mq[0][1] * y[9]; a0 -= mq[0][2] * x[10]; b0 -= mq[0][2] * y[10]; a1 -= mq[0][3] * x[11]; b1 -= mq[0][3] * y[11]; mq[0] = *(const LAS f32x4*)(Mg + 1920);
            a0 -= mq[1][0] * x[12]; b0 -= mq[1][0] * y[12]; a1 -= mq[1][1] * x[13]; b1 -= mq[1][1] * y[13]; a0 -= mq[1][2] * x[14]; b0 -= mq[1][2] * y[14]; a1 -= mq[1][3] * x[15]; b1 -= mq[1][3] * y[15]; mq[1] = *(const LAS f32x4*)(Mg + 1924);
            a0 -= mq[2][0] * x[16]; b0 -= mq[2][0] * y[16]; a1 -= mq[2][1] * x[17]; b1 -= mq[2][1] * y[17]; a0 -= mq[2][2] * x[18]; b0 -= mq[2][2] * y[18]; a1 -= mq[2][3] * x[19]; b1 -= mq[2][3] * y[19]; mq[2] = *(const LAS f32x4*)(Mg + 1928);
            a0 -= mq[3][0] * x[20]; b0 -= mq[3][0] * y[20]; a1 -= mq[3][1] * x[21]; b1 -= mq[3][1] * y[21]; a0 -= mq[3][2] * x[22]; b0 -= mq[3][2] * y[22]; a1 -= mq[3][3] * x[23]; b1 -= mq[3][3] * y[23]; mq[3] = *(const LAS f32x4*)(Mg + 1932);
            a0 -= mq[4][0] * x[24]; b0 -= mq[4][0] * y[24]; a1 -= mq[4][1] * x[25]; b1 -= mq[4][1] * y[25]; a0 -= mq[4][2] * x[26]; b0 -= mq[4][2] * y[26]; a1 -= mq[4][3] * x[27]; b1 -= mq[4][3] * y[27]; mq[4] = *(const LAS f32x4*)(Mg + 1936);
            a0 -= mq[5][0] * x[28]; b0 -= mq[5][0] * y[28]; x[29] = a0 + a1; y[29] = b0 + b1; up[3712] = x[29]; wp[3712] = f2bf(-y[29]); mq[5] = *(const LAS f32x4*)(Mg + 1940);
            { const float br = betg[30]; a0 = bf2f(*(const LAS bf16_t*)(lg + P5_VS + 8160 + c * 2)) * br; b0 = bf2f(*(const LAS bf16_t*)(lg + P5_KS + 8160 + c * 2)) * br * __expf(decg[30]); a1 = 0.f; b1 = 0.f; } a0 -= mq[0][0] * x[0]; b0 -= mq[0][0] * y[0]; a1 -= mq[0][1] * x[1]; b1 -= mq[0][1] * y[1]; a0 -= mq[0][2] * x[2]; b0 -= mq[0][2] * y[2]; a1 -= mq[0][3] * x[3]; b1 -= mq[0][3] * y[3]; mq[0] = *(const LAS f32x4*)(Mg + 1944);
            a0 -= mq[1][0] * x[4]; b0 -= mq[1][0] * y[4]; a1 -= mq[1][1] * x[5]; b1 -= mq[1][1] * y[5]; a0 -= mq[1][2] * x[6]; b0 -= mq[1][2] * y[6]; a1 -= mq[1][3] * x[7]; b1 -= mq[1][3] * y[7]; mq[1] = *(const LAS f32x4*)(Mg + 1948);
            a0 -= mq[2][0] * x[8]; b0 -= mq[2][0] * y[8]; a1 -= mq[2][1] * x[9]; b1 -= mq[2][1] * y[9]; a0 -= mq[2][2] * x[10]; b0 -= mq[2][2] * y[10]; a1 -= mq[2][3] * x[11]; b1 -= mq[2][3] * y[11]; mq[2] = *(const LAS f32x4*)(Mg + 1984);
            a0 -= mq[3][0] * x[12]; b0 -= mq[3][0] * y[12]; a1 -= mq[3][1] * x[13]; b1 -= mq[3][1] * y[13]; a0 -= mq[3][2] * x[14]; b0 -= mq[3][2] * y[14]; a1 -= mq[3][3] * x[15]; b1 -= mq[3][3] * y[15]; mq[3] = *(const LAS f32x4*)(Mg + 1988);
            a0 -= mq[4][0] * x[16]; b0 -= mq[4][0] * y[16]; a1 -= mq[4][1] * x[17]; b1 -= mq[4][1] * y[17]; a0 -= mq[4][2] * x[18]; b0 -= mq[4][2] * y[18]; a1 -= mq[4][3] * x[19]; b1 -= mq[4][3] * y[19]; mq[4] = *(const LAS f32x4*)(Mg + 1992);
            a0 -= mq[5][0] * x[20]; b0 -= mq[5][0] * y[20]; a1 -= mq[5][1] * x[21]; b1 -= mq[5][1] * y[21]; a0 -= mq[5][2] * x[22]; b0 -= mq[5][2] * y[22]; a1 -= mq[5][3] * x[23]; b1 -= mq[5][3] * y[23]; mq[5] = *(const LAS f32x4*)(Mg + 1996);
            a0 -= mq[0][0] * x[24]; b0 -= mq[0][0] * y[24]; a1 -= mq[0][1] * x[25]; b1 -= mq[0][1] * y[25]; a0 -= mq[0][2] * x[26]; b0 -= mq[0][2] * y[26]; a1 -= mq[0][3] * x[27]; b1 -= mq[0][3] * y[27]; mq[0] = *(const LAS f32x4*)(Mg + 2000);
            a0 -= mq[1][0] * x[28]; b0 -= mq[1][0] * y[28]; a1 -= mq[1][1] * x[29]; b1 -= mq[1][1] * y[29]; x[30] = a0 + a1; y[30] = b0 + b1; up[3840] = x[30]; wp[3840] = f2bf(-y[30]); mq[1] = *(const LAS f32x4*)(Mg + 2004);
            { const float br = betg[31]; a0 = bf2f(*(const LAS bf16_t*)(lg + P5_VS + 8432 + c * 2)) * br; b0 = bf2f(*(const LAS bf16_t*)(lg + P5_KS + 8432 + c * 2)) * br * __expf(decg[31]); a1 = 0.f; b1 = 0.f; } a0 -= mq[2][0] * x[0]; b0 -= mq[2][0] * y[0]; a1 -= mq[2][1] * x[1]; b1 -= mq[2][1] * y[1]; a0 -= mq[2][2] * x[2]; b0 -= mq[2][2] * y[2]; a1 -= mq[2][3] * x[3]; b1 -= mq[2][3] * y[3]; mq[2] = *(const LAS f32x4*)(Mg + 2008);
            a0 -= mq[3][0] * x[4]; b0 -= mq[3][0] * y[4]; a1 -= mq[3][1] * x[5]; b1 -= mq[3][1] * y[5]; a0 -= mq[3][2] * x[6]; b0 -= mq[3][2] * y[6]; a1 -= mq[3][3] * x[7]; b1 -= mq[3][3] * y[7]; mq[3] = *(const LAS f32x4*)(Mg + 2012);
            a0 -= mq[4][0] * x[8]; b0 -= mq[4][0] * y[8]; a1 -= mq[4][1] * x[9]; b1 -= mq[4][1] * y[9]; a0 -= mq[4][2] * x[10]; b0 -= mq[4][2] * y[10]; a1 -= mq[4][3] * x[11]; b1 -= mq[4][3] * y[11]; mq[4] = *(const LAS f32x4*)(Mg + 2048);
            a0 -= mq[5][0] * x[12]; b0 -= mq[5][0] * y[12]; a1 -= mq[5][1] * x[13]; b1 -= mq[5][1] * y[13]; a0 -= mq[5][2] * x[14]; b0 -= mq[5][2] * y[14]; a1 -= mq[5][3] * x[15]; b1 -= mq[5][3] * y[15]; mq[5] = *(const LAS f32x4*)(Mg + 2052);
            a0 -= mq[0][0] * x[16]; b0 -= mq[0][0] * y[16]; a1 -= mq[0][1] * x[17]; b1 -= mq[0][1] * y[17]; a0 -= mq[0][2] * x[18]; b0 -= mq[0][2] * y[18]; a1 -= mq[0][3] * x[19]; b1 -= mq[0][3] * y[19]; mq[0] = *(const LAS f32x4*)(Mg + 2056);
            a0 -= mq[1][0] * x[20]; b0 -= mq[1][0] * y[20]; a1 -= mq[1][1] * x[21]; b1 -= mq[1][1] * y[21]; a0 -= mq[1][2] * x[22]; b0 -= mq[1][2] * y[22]; a1 -= mq[1][3] * x[23]; b1 -= mq[1][3] * y[23]; mq[1] = *(const LAS f32x4*)(Mg + 2060);
            a0 -= mq[2][0] * x[24]; b0 -= mq[2][0] * y[24]; a1 -= mq[2][1] * x[25]; b1 -= mq[2][1] * y[25]; a0 -= mq[2][2] * x[26]; b0 -= mq[2][2] * y[26]; a1 -= mq[2][3] * x[27]; b1 -= mq[2][3] * y[27]; mq[2] = *(const LAS f32x4*)(Mg + 2064);
            a0 -= mq[3][0] * x[28]; b0 -= mq[3][0] * y[28]; a1 -= mq[3][1] * x[29]; b1 -= mq[3][1] * y[29]; a0 -= mq[3][2] * x[30]; b0 -= mq[3][2] * y[30]; x[31] = a0 + a1; y[31] = b0 + b1; up[3968] = x[31]; wp[3968] = f2bf(-y[31]); mq[3] = *(const LAS f32x4*)(Mg + 2068);
            { const float br = betg[32]; a0 = bf2f(*(const LAS bf16_t*)(lg + P5_VS + 8704 + c * 2)) * br; b0 = bf2f(*(const LAS bf16_t*)(lg + P5_KS + 8704 + c * 2)) * br * __expf(decg[32]); a1 = 0.f; b1 = 0.f; } a0 -= mq[4][0] * x[0]; b0 -= mq[4][0] * y[0]; a1 -= mq[4][1] * x[1]; b1 -= mq[4][1] * y[1]; a0 -= mq[4][2] * x[2]; b0 -= mq[4][2] * y[2]; a1 -= mq[4][3] * x[3]; b1 -= mq[4][3] * y[3]; mq[4] = *(const LAS f32x4*)(Mg + 2072);
            a0 -= mq[5][0] * x[4]; b0 -= mq[5][0] * y[4]; a1 -= mq[5][1] * x[5]; b1 -= mq[5][1] * y[5]; a0 -= mq[5][2] * x[6]; b0 -= mq[5][2] * y[6]; a1 -= mq[5][3] * x[7]; b1 -= mq[5][3] * y[7]; mq[5] = *(const LAS f32x4*)(Mg + 2076);
            a0 -= mq[0][0] * x[8]; b0 -= mq[0][0] * y[8]; a1 -= mq[0][1] * x[9]; b1 -= mq[0][1] * y[9]; a0 -= mq[0][2] * x[10]; b0 -= mq[0][2] * y[10]; a1 -= mq[0][3] * x[11]; b1 -= mq[0][3] * y[11]; mq[0] = *(const LAS f32x4*)(Mg + 2112);
            a0 -= mq[1][0] * x[12]; b0 -= mq[1][0] * y[12]; a1 -= mq[1][1] * x[13]; b1 -= mq[1][1] * y[13]; a0 -= mq[1][2] * x[14]; b0 -= mq[1][2] * y[14]; a1 -= mq[1][3] * x[15]; b1 -= mq[1][3] * y[15]; mq[1] = *(const LAS f32x4*)(Mg + 2116);
            a0 -= mq[2][0] * x[16]; b0 -= mq[2][0] * y[16]; a1 -= mq[2][1] * x[17]; b1 -= mq[2][1] * y[17]; a0 -= mq[2][2] * x[18]; b0 -= mq[2][2] * y[18]; a1 -= mq[2][3] * x[19]; b1 -= mq[2][3] * y[19]; mq[2] = *(const LAS f32x4*)(Mg + 2120);
            a0 -= mq[3][0] * x[20]; b0 -= mq[3][0] * y[20]; a1 -= mq[3][1] * x[21]; b1 -= mq[3][1] * y[21]; a0 -= mq[3][2] * x[22]; b0 -= mq[3][2] * y[22]; a1 -= mq[3][3] * x[23]; b1 -= mq[3][3] * y[23]; mq[3] = *(const LAS f32x4*)(Mg + 2124);
            a0 -= mq[4][0] * x[24]; b0 -= mq[4][0] * y[24]; a1 -= mq[4][1] * x[25]; b1 -= mq[4][1] * y[25]; a0 -= mq[4][2] * x[26]; b0 -= mq[4][2] * y[26]; a1 -= mq[4][3] * x[27]; b1 -= mq[4][3] * y[27]; mq[4] = *(const LAS f32x4*)(Mg + 2128);
            a0 -= mq[5][0] * x[28]; b0 -= mq[5][0] * y[28]; a1 -= mq[5][1] * x[29]; b1 -= mq[5][1] * y[29]; a0 -= mq[5][2] * x[30]; b0 -= mq[5][2] * y[30]; a1 -= mq[5][3] * x[31]; b1 -= mq[5][3] * y[31]; x[32] = a0 + a1; y[32] = b0 + b1; up[4096] = x[32]; wp[4096] = f2bf(-y[32]); mq[5] = *(const LAS f32x4*)(Mg + 2132);
            { const float br = betg[33]; a0 = bf2f(*(const LAS bf16_t*)(lg + P5_VS + 8976 + c * 2)) * br; b0 = bf2f(*(const LAS bf16_t*)(lg + P5_KS + 8976 + c * 2)) * br * __expf(decg[33]); a1 = 0.f; b1 = 0.f; } a0 -= mq[0][0] * x[0]; b0 -= mq[0][0] * y[0]; a1 -= mq[0][1] * x[1]; b1 -= mq[0][1] * y[1]; a0 -= mq[0][2] * x[2]; b0 -= mq[0][2] * y[2]; a1 -= mq[0][3] * x[3]; b1 -= mq[0][3] * y[3]; mq[0] = *(const LAS f32x4*)(Mg + 2136);
            a0 -= mq[1][0] * x[4]; b0 -= mq[1][0] * y[4]; a1 -= mq[1][1] * x[5]; b1 -= mq[1][1] * y[5]; a0 -= mq[1][2] * x[6]; b0 -= mq[1][2] * y[6]; a1 -= mq[1][3] * x[7]; b1 -= mq[1][3] * y[7]; mq[1] = *(const LAS f32x4*)(Mg + 2140);
            a0 -= mq[2][0] * x[8]; b0 -= mq[2][0] * y[8]; a1 -= mq[2][1] * x[9]; b1 -= mq[2][1] * y[9]; a0 -= mq[2][2] * x[10]; b0 -= mq[2][2] * y[10]; a1 -= mq[2][3] * x[11]; b1 -= mq[2][3] * y[11]; mq[2] = *(const LAS f32x4*)(Mg + 2144);
            a0 -= mq[3][0] * x[12]; b0 -= mq[3][0] * y[12]; a1 -= mq[3][1] * x[13]; b1 -= mq[3][1] * y[13]; a0 -= mq[3][2] * x[14]; b0 -= mq[3][2] * y[14]; a1 -= mq[3][3] * x[15]; b1 -= mq[3][3] * y[15]; mq[3] = *(const LAS f32x4*)(Mg + 2176);
            a0 -= mq[4][0] * x[16]; b0 -= mq[4][0] * y[16]; a1 -= mq[4][1] * x[17]; b1 -= mq[4][1] * y[17]; a0 -= mq[4][2] * x[18]; b0 -= mq[4][2] * y[18]; a1 -= mq[4][3] * x[19]; b1 -= mq[4][3] * y[19]; mq[4] = *(const LAS f32x4*)(Mg + 2180);
            a0 -= mq[5][0] * x[20]; b0 -= mq[5][0] * y[20]; a1 -= mq[5][1] * x[21]; b1 -= mq[5][1] * y[21]; a0 -= mq[5][2] * x[22]; b0 -= mq[5][2] * y[22]; a1 -= mq[5][3] * x[23]; b1 -= mq[5][3] * y[23]; mq[5] = *(const LAS f32x4*)(Mg + 2184);
            a0 -= mq[0][0] * x[24]; b0 -= mq[0][0] * y[24]; a1 -= mq[0][1] * x[25]; b1 -= mq[0][1] * y[25]; a0 -= mq[0][2] * x[26]; b0 -= mq[0][2] * y[26]; a1 -= mq[0][3] * x[27]; b1 -= mq[0][3] * y[27]; mq[0] = *(const LAS f32x4*)(Mg + 2188);
            a0 -= mq[1][0] * x[28]; b0 -= mq[1][0] * y[28]; a1 -= mq[1][1] * x[29]; b1 -= mq[1][1] * y[29]; a0 -= mq[1][2] * x[30]; b0 -= mq[1][2] * y[30]; a1 -= mq[1][3] * x[31]; b1 -= mq[1][3] * y[31]; mq[1] = *(const LAS f32x4*)(Mg + 2192);
            a0 -= mq[2][0] * x[32]; b0 -= mq[2][0] * y[32]; x[33] = a0 + a1; y[33] = b0 + b1; up[4224] = x[33]; wp[4224] = f2bf(-y[33]); mq[2] = *(const LAS f32x4*)(Mg + 2196);
            { const float br = betg[34]; a0 = bf2f(*(const LAS bf16_t*)(lg + P5_VS + 9248 + c * 2)) * br; b0 = bf2f(*(const LAS bf16_t*)(lg + P5_KS + 9248 + c * 2)) * br * __expf(decg[34]); a1 = 0.f; b1 = 0.f; } a0 -= mq[3][0] * x[0]; b0 -= mq[3][0] * y[0]; a1 -= mq[3][1] * x[1]; b1 -= mq[3][1] * y[1]; a0 -= mq[3][2] * x[2]; b0 -= mq[3][2] * y[2]; a1 -= mq[3][3] * x[3]; b1 -= mq[3][3] * y[3]; mq[3] = *(const LAS f32x4*)(Mg + 2200);
            a0 -= mq[4][0] * x[4]; b0 -= mq[4][0] * y[4]; a1 -= mq[4][1] * x[5]; b1 -= mq[4][1] * y[5]; a0 -= mq[4][2] * x[6]; b0 -= mq[4][2] * y[6]; a1 -= mq[4][3] * x[7]; b1 -= mq[4][3] * y[7]; mq[4] = *(const LAS f32x4*)(Mg + 2204);
            a0 -= mq[5][0] * x[8]; b0 -= mq[5][0] * y[8]; a1 -= mq[5][1] * x[9]; b1 -= mq[5][1] * y[9]; a0 -= mq[5][2] * x[10]; b0 -= mq[5][2] * y[10]; a1 -= mq[5][3] * x[11]; b1 -= mq[5][3] * y[11]; mq[5] = *(const LAS f32x4*)(Mg + 2208);
            a0 -= mq[0][0] * x[12]; b0 -= mq[0][0] * y[12]; a1 -= mq[0][1] * x[13]; b1 -= mq[0][1] * y[13]; a0 -= mq[0][2] * x[14]; b0 -= mq[0][2] * y[14]; a1 -= mq[0][3] * x[15]; b1 -= mq[0][3] * y[15]; mq[0] = *(const LAS f32x4*)(Mg + 2240);
            a0 -= mq[1][0] * x[16]; b0 -= mq[1][0] * y[16]; a1 -= mq[1][1] * x[17]; b1 -= mq[1][1] * y[17]; a0 -= mq[1][2] * x[18]; b0 -= mq[1][2] * y[18]; a1 -= mq[1][3] * x[19]; b1 -= mq[1][3] * y[19]; mq[1] = *(const LAS f32x4*)(Mg + 2244);
            a0 -= mq[2][0] * x[20]; b0 -= mq[2][0] * y[20]; a1 -= mq[2][1] * x[21]; b1 -= mq[2][1] * y[21]; a0 -= mq[2][2] * x[22]; b0 -= mq[2][2] * y[22]; a1 -= mq[2][3] * x[23]; b1 -= mq[2][3] * y[23]; mq[2] = *(const LAS f32x4*)(Mg + 2248);
            a0 -= mq[3][0] * x[24]; b0 -= mq[3][0] * y[24]; a1 -= mq[3][1] * x[25]; b1 -= mq[3][1] * y[25]; a0 -= mq[3][2] * x[26]; b0 -= mq[3][2] * y[26]; a1 -= mq[3][3] * x[27]; b1 -= mq[3][3] * y[27]; mq[3] = *(const LAS f32x4*)(Mg + 2252);
            a0 -= mq[4][0] * x[28]; b0 -= mq[4][0] * y[28]; a1 -= mq[4][1] * x[29]; b1 -= mq[4][1] * y[29]; a0 -= mq[4][2] * x[30]; b0 -= mq[4][2] * y[30]; a1 -= mq[4][3] * x[31]; b1 -= mq[4][3] * y[31]; mq[4] = *(const LAS f32x4*)(Mg + 2256);
            a0 -= mq[5][0] * x[32]; b0 -= mq[5][0] * y[32]; a1 -= mq[5][1] * x[33]; b1 -= mq[5][1] * y[33]; x[34] = a0 + a1; y[34] = b0 + b1; up[4352] = x[34]; wp[4352] = f2bf(-y[34]); mq[5] = *(const LAS f32x4*)(Mg + 2260);
            { const float br = betg[35]; a0 = bf2f(*(const LAS bf16_t*)(lg + P5_VS + 9520 + c * 2)) * br; b0 = bf2f(*(const LAS bf16_t*)(lg + P5_KS + 9520 + c * 2)) * br * __expf(decg[35]); a1 = 0.f; b1 = 0.f; } a0 -= mq[0][0] * x[0]; b0 -= mq[0][0] * y[0]; a1 -= mq[0][1] * x[1]; b1 -= mq[0][1] * y[1]; a0 -= mq[0][2] * x[2]; b0 -= mq[0][2] * y[2]; a1 -= mq[0][3] * x[3]; b1 -= mq[0][3] * y[3]; mq[0] = *(const LAS f32x4*)(Mg + 2264);
            a0 -= mq[1][0] * x[4]; b0 -= mq[1][0] * y[4]; a1 -= mq[1][1] * x[5]; b1 -= mq[1][1] * y[5]; a0 -= mq[1][2] * x[6]; b0 -= mq[1][2] * y[6]; a1 -= mq[1][3] * x[7]; b1 -= mq[1][3] * y[7]; mq[1] = *(const LAS f32x4*)(Mg + 2268);
            a0 -= mq[2][0] * x[8]; b0 -= mq[2][0] * y[8]; a1 -= mq[2][1] * x[9]; b1 -= mq[2][1] * y[9]; a0 -= mq[2][2] * x[10]; b0 -= mq[2][2] * y[10]; a1 -= mq[2][3] * x[11]; b1 -= mq[2][3] * y[11]; mq[2] = *(const LAS f32x4*)(Mg + 2272);
            a0 -= mq[3][0] * x[12]; b0 -= mq[3][0] * y[12]; a1 -= mq[3][1] * x[13]; b1 -= mq[3][1] * y[13]; a0 -= mq[3][2] * x[14]; b0 -= mq[3][2] * y[14]; a1 -= mq[3][3] * x[15]; b1 -= mq[3][3] * y[15]; mq[3] = *(const LAS f32x4*)(Mg + 2304);
            a0 -= mq[4][0] * x[16]; b0 -= mq[4][0] * y[16]; a1 -= mq[4][1] * x[17]; b1 -= mq[4][1] * y[17]; a0 -= mq[4][2] * x[18]; b0 -= mq[4][2] * y[18]; a1 -= mq[4][3] * x[19]; b1 -= mq[4][3] * y[19]; mq[4] = *(const LAS f32x4*)(Mg + 2308);
            a0 -= mq[5][0] * x[20]; b0 -= mq[5][0] * y[20]; a1 -= mq[5][1] * x[21]; b1 -= mq[5][1] * y[21]; a0 -= mq[5][2] * x[22]; b0 -= mq[5][2] * y[22]; a1 -= mq[5][3] * x[23]; b1 -= mq[5][3] * y[23]; mq[5] = *(const LAS f32x4*)(Mg + 2312);
            a0 -= mq[0][0] * x[24]; b0 -= mq[0][0] * y[24]; a1 -= mq[0][1] * x[25]; b1 -= mq[0][1] * y[25]; a0 -= mq[0][2] * x[26]; b0 -= mq[0][2] * y[26]; a1 -= mq[0][3] * x[27]; b1 -= mq[0][3] * y[27]; mq[0] = *(const LAS f32x4*)(Mg + 2316);
            a0 -= mq[1][0] * x[28]; b0 -= mq[1][0] * y[28]; a1 -= mq[1][1] * x[29]; b1 -= mq[1][1] * y[29]; a0 -= mq[1][2] * x[30]; b0 -= mq[1][2] * y[30]; a1 -= mq[1][3] * x[31]; b1 -= mq[1][3] * y[31]; mq[1] = *(const LAS f32x4*)(Mg + 2320);
            a0 -= mq[2][0] * x[32]; b0 -= mq[2][0] * y[32]; a1 -= mq[2][1] * x[33]; b1 -= mq[2][1] * y[33]; a0 -= mq[2][2] * x[34]; b0 -= mq[2][2] * y[34]; x[35] = a0 + a1; y[35] = b0 + b1; up[4480] = x[35]; wp[4480] = f2bf(-y[35]); mq[2] = *(const LAS f32x4*)(Mg + 2324);
            { const float br = betg[36]; a0 = bf2f(*(const LAS bf16_t*)(lg + P5_VS + 9792 + c * 2)) * br; b0 = bf2f(*(const LAS bf16_t*)(lg + P5_KS + 9792 + c * 2)) * br * __expf(decg[36]); a1 = 0.f; b1 = 0.f; } a0 -= mq[3][0] * x[0]; b0 -= mq[3][0] * y[0]; a1 -= mq[3][1] * x[1]; b1 -= mq[3][1] * y[1]; a0 -= mq[3][2] * x[2]; b0 -= mq[3][2] * y[2]; a1 -= mq[3][3] * x[3]; b1 -= mq[3][3] * y[3]; mq[3] = *(const LAS f32x4*)(Mg + 2328);
            a0 -= mq[4][0] * x[4]; b0 -= mq[4][0] * y[4]; a1 -= mq[4][1] * x[5]; b1 -= mq[4][1] * y[5]; a0 -= mq[4][2] * x[6]; b0 -= mq[4][2] * y[6]; a1 -= mq[4][3] * x[7]; b1 -= mq[4][3] * y[7]; mq[4] = *(const LAS f32x4*)(Mg + 2332);
            a0 -= mq[5][0] * x[8]; b0 -= mq[5][0] * y[8]; a1 -= mq[5][1] * x[9]; b1 -= mq[5][1] * y[9]; a0 -= mq[5][2] * x[10]; b0 -= mq[5][2] * y[10]; a1 -= mq[5][3] * x[11]; b1 -= mq[5][3] * y[11]; mq[5] = *(const LAS f32x4*)(Mg + 2336);
            a0 -= mq[0][0] * x[12]; b0 -= mq[0][0] * y[12]; a1 -= mq[0][1] * x[13]; b1 -= mq[0][1] * y[13]; a0 -= mq[0][2] * x[14]; b0 -= mq[0][2] * y[14]; a1 -= mq[0][3] * x[15]; b1 -= mq[0][3] * y[15]; mq[0] = *(const LAS f32x4*)(Mg + 2368);
            a0 -= mq[1][0] * x[16]; b0 -= mq[1][0] * y[16]; a1 -= mq[1][1] * x[17]; b1 -= mq[1][1] * y[17]; a0 -= mq[1][2] * x[18]; b0 -= mq[1][2] * y[18]; a1 -= mq[1][3] * x[19]; b1 -= mq[1][3] * y[19]; mq[1] = *(const LAS f32x4*)(Mg + 2372);
            a0 -= mq[2][0] * x[20]; b0 -= mq[2][0] * y[20]; a1 -= mq[2][1] * x[21]; b1 -= mq[2][1] * y[21]; a0 -= mq[2][2] * x[22]; b0 -= mq[2][2] * y[22]; a1 -= mq[2][3] * x[23]; b1 -= mq[2][3] * y[23]; mq[2] = *(const LAS f32x4*)(Mg + 2376);
            a0 -= mq[3][0] * x[24]; b0 -= mq[3][0] * y[24]; a1 -= mq[3][1] * x[25]; b1 -= mq[3][1] * y[25]; a0 -= mq[3][2] * x[26]; b0 -= mq[3][2] * y[26]; a1 -= mq[3][3] * x[27]; b1 -= mq[3][3] * y[27]; mq[3] = *(const LAS f32x4*)(Mg + 2380);
            a0 -= mq[4][0] * x[28]; b0 -= mq[4][0] * y[28]; a1 -= mq[4][1] * x[29]; b1 -= mq[4][1] * y[29]; a0 -= mq[4][2] * x[30]; b0 -= mq[4][2] * y[30]; a1 -= mq[4][3] * x[31]; b1 -= mq[4][3] * y[31]; mq[4] = *(const LAS f32x4*)(Mg + 2384);
            a0 -= mq[5][0] * x[32]; b0 -= mq[5][0] * y[32]; a1 -= mq[5][1] * x[33]; b1 -= mq[5][1] * y[33]; a0 -= mq[5][2] * x[34]; b0 -= mq[5][2] * y[34]; a1 -= mq[5][3] * x[35]; b1 -= mq[5][3] * y[35]; x[36] = a0 + a1; y[36] = b0 + b1; up[4608] = x[36]; wp[4608] = f2bf(-y[36]); mq[5] = *(const LAS f32x4*)(Mg + 2388);
            { const float br = betg[37]; a0 = bf2f(*(const LAS bf16_t*)(lg + P5_VS + 10064 + c * 2)) * br; b0 = bf2f(*(const LAS bf16_t*)(lg + P5_KS + 10064 + c * 2)) * br * __expf(decg[37]); a1 = 0.f; b1 = 0.f; } a0 -= mq[0][0] * x[0]; b0 -= mq[0][0] * y[0]; a1 -= mq[0][1] * x[1]; b1 -= mq[0][1] * y[1]; a0 -= mq[0][2] * x[2]; b0 -= mq[0][2] * y[2]; a1 -= mq[0][3] * x[3]; b1 -= mq[0][3] * y[3]; mq[0] = *(const LAS f32x4*)(Mg + 2392);
            a0 -= mq[1][0] * x[4]; b0 -= mq[1][0] * y[4]; a1 -= mq[1][1] * x[5]; b1 -= mq[1][1] * y[5]; a0 -= mq[1][2] * x[6]; b0 -= mq[1][2] * y[6]; a1 -= mq[1][3] * x[7]; b1 -= mq[1][3] * y[7]; mq[1] = *(const LAS f32x4*)(Mg + 2396);
            a0 -= mq[2][0] * x[8]; b0 -= mq[2][0] * y[8]; a1 -= mq[2][1] * x[9]; b1 -= mq[2][1] * y[9]; a0 -= mq[2][2] * x[10]; b0 -= mq[2][2] * y[10]; a1 -= mq[2][3] * x[11]; b1 -= mq[2][3] * y[11]; mq[2] = *(const LAS f32x4*)(Mg + 2400);
            a0 -= mq[3][0] * x[12]; b0 -= mq[3][0] * y[12]; a1 -= mq[3][1] * x[13]; b1 -= mq[3][1] * y[13]; a0 -= mq[3][2] * x[14]; b0 -= mq[3][2] * y[14]; a1 -= mq[3][3] * x[15]; b1 -= mq[3][3] * y[15]; mq[3] = *(const LAS f32x4*)(Mg + 2404);
            a0 -= mq[4][0] * x[16]; b0 -= mq[4][0] * y[16]; a1 -= mq[4][1] * x[17]; b1 -= mq[4][1] * y[17]; a0 -= mq[4][2] * x[18]; b0 -= mq[4][2] * y[18]; a1 -= mq[4][3] * x[19]; b1 -= mq[4][3] * y[19]; mq[4] = *(const LAS f32x4*)(Mg + 2432);
            a0 -= mq[5][0] * x[20]; b0 -= mq[5][0] * y[20]; a1 -= mq[5][1] * x[21]; b1 -= mq[5][1] * y[21]; a0 -= mq[5][2] * x[22]; b0 -= mq[5][2] * y[22]; a1 -= mq[5][3] * x[23]; b1 -= mq[5][3] * y[23]; mq[5] = *(const LAS f32x4*)(Mg + 2436);
            a0 -= mq[0][0] * x[24]; b0 -= mq[0][0] * y[24]; a1 -= mq[0][1] * x[25]; b1 -= mq[0][1] * y[25]; a0 -= mq[0][2] * x[26]; b0 -= mq[0][2] * y[26]; a1 -= mq[0][3] * x[27]; b1 -= mq[0][3] * y[27]; mq[0] = *(const LAS f32x4*)(Mg + 2440);
            a0 -= mq[1][0] * x[28]; b0 -= mq[1][0] * y[28]; a1 -= mq[1][1] * x[29]; b1 -= mq[1][1] * y[29]; a0 -= mq[1][2] * x[30]; b0 -= mq[1][2] * y[30]; a1 -= mq[1][3] * x[31]; b1 -= mq[1][3] * y[31]; mq[1] = *(const LAS f32x4*)(Mg + 2444);
            a0 -= mq[2][0] * x[32]; b0 -= mq[2][0] * y[32]; a1 -= mq[2][1] * x[33]; b1 -= mq[2][1] * y[33]; a0 -= mq[2][2] * x[34]; b0 -= mq[2][2] * y[34]; a1 -= mq[2][3] * x[35]; b1 -= mq[2][3] * y[35]; mq[2] = *(const LAS f32x4*)(Mg + 2448);
            a0 -= mq[3][0] * x[36]; b0 -= mq[3][0] * y[36]; x[37] = a0 + a1; y[37] = b0 + b1; up[4736] = x[37]; wp[4736] = f2bf(-y[37]); mq[3] = *(const LAS f32x4*)(Mg + 2452);
            { const float br = betg[38]; a0 = bf2f(*(const LAS bf16_t*)(lg + P5_VS + 10336 + c * 2)) * br; b0 = bf2f(*(const LAS bf16_t*)(lg + P5_KS + 10336 + c * 2)) * br * __expf(decg[38]); a1 = 0.f; b1 = 0.f; } a0 -= mq[4][0] * x[0]; b0 -= mq[4][0] * y[0]; a1 -= mq[4][1] * x[1]; b1 -= mq[4][1] * y[1]; a0 -= mq[4][2] * x[2]; b0 -= mq[4][2] * y[2]; a1 -= mq[4][3] * x[3]; b1 -= mq[4][3] * y[3]; mq[4] = *(const LAS f32x4*)(Mg + 2456);
            a0 -= mq[5][0] * x[4]; b0 -= mq[5][0] * y[4]; a1 -= mq[5][1] * x[5]; b1 -= mq[5][1] * y[5]; a0 -= mq[5][2] * x[6]; b0 -= mq[5][2] * y[6]; a1 -= mq[5][3] * x[7]; b1 -= mq[5][3] * y[7]; mq[5] = *(const LAS f32x4*)(Mg + 2460);
            a0 -= mq[0][0] * x[8]; b0 -= mq[0][0] * y[8]; a1 -= mq[0][1] * x[9]; b1 -= mq[0][1] * y[9]; a0 -= mq[0][2] * x[10]; b0 -= mq[0][2] * y[10]; a1 -= mq[0][3] * x[11]; b1 -= mq[0][3] * y[11]; mq[0] = *(const LAS f32x4*)(Mg + 2464);
            a0 -= mq[1][0] * x[12]; b0 -= mq[1][0] * y[12]; a1 -= mq[1][1] * x[13]; b1 -= mq[1][1] * y[13]; a0 -= mq[1][2] * x[14]; b0 -= mq[1][2] * y[14]; a1 -= mq[1][3] * x[15]; b1 -= mq[1][3] * y[15]; mq[1] = *(const LAS f32x4*)(Mg + 2468);
            a0 -= mq[2][0] * x[16]; b0 -= mq[2][0] * y[16]; a1 -= mq[2][1] * x[17]; b1 -= mq[2][1] * y[17]; a0 -= mq[2][2] * x[18]; b0 -= mq[2][2] * y[18]; a1 -= mq[2][3] * x[19]; b1 -= mq[2][3] * y[19]; mq[2] = *(const LAS f32x4*)(Mg + 2496);
            a0 -= mq[3][0] * x[20]; b0 -= mq[3][0] * y[20]; a1 -= mq[3][1] * x[21]; b1 -= mq[3][1] * y[21]; a0 -= mq[3][2] * x[22]; b0 -= mq[3][2] * y[22]; a1 -= mq[3][3] * x[23]; b1 -= mq[3][3] * y[23]; mq[3] = *(const LAS f32x4*)(Mg + 2500);
            a0 -= mq[4][0] * x[24]; b0 -= mq[4][0] * y[24]; a1 -= mq[4][1] * x[25]; b1 -= mq[4][1] * y[25]; a0 -= mq[4][2] * x[26]; b0 -= mq[4][2] * y[26]; a1 -= mq[4][3] * x[27]; b1 -= mq[4][3] * y[27]; mq[4] = *(const LAS f32x4*)(Mg + 2504);
            a0 -= mq[5][0] * x[28]; b0 -= mq[5][0] * y[28]; a1 -= mq[5][1] * x[29]; b1 -= mq[5][1] * y[29]; a0 -= mq[5][2] * x[30]; b0 -= mq[5][2] * y[30]; a1 -= mq[5][3] * x[31]; b1 -= mq[5][3] * y[31]; mq[5] = *(const LAS f32x4*)(Mg + 2508);
            a0 -= mq[0][0] * x[32]; b0 -= mq[0][0] * y[32]; a1 -= mq[0][1] * x[33]; b1 -= mq[0][1] * y[33]; a0 -= mq[0][2] * x[34]; b0 -= mq[0][2] * y[34]; a1 -= mq[0][3] * x[35]; b1 -= mq[0][3] * y[35]; mq[0] = *(const LAS f32x4*)(Mg + 2512);
            a0 -= mq[1][0] * x[36]; b0 -= mq[1][0] * y[36]; a1 -= mq[1][1] * x[37]; b1 -= mq[1][1] * y[37]; x[38] = a0 + a1; y[38] = b0 + b1; up[4864] = x[38]; wp[4864] = f2bf(-y[38]); mq[1] = *(const LAS f32x4*)(Mg + 2516);
            { const float br = betg[39]; a0 = bf2f(*(const LAS bf16_t*)(lg + P5_VS + 10608 + c * 2)) * br; b0 = bf2f(*(const LAS bf16_t*)(lg + P5_KS + 10608 + c * 2)) * br * __expf(decg[39]); a1 = 0.f; b1 = 0.f; } a0 -= mq[2][0] * x[0]; b0 -= mq[2][0] * y[0]; a1 -= mq[2][1] * x[1]; b1 -= mq[2][1] * y[1]; a0 -= mq[2][2] * x[2]; b0 -= mq[2][2] * y[2]; a1 -= mq[2][3] * x[3]; b1 -= mq[2][3] * y[3]; mq[2] = *(const LAS f32x4*)(Mg + 2520);
            a0 -= mq[3][0] * x[4]; b0 -= mq[3][0] * y[4]; a1 -= mq[3][1] * x[5]; b1 -= mq[3][1] * y[5]; a0 -= mq[3][2] * x[6]; b0 -= mq[3][2] * y[6]; a1 -= mq[3][3] * x[7]; b1 -= mq[3][3] * y[7]; mq[3] = *(const LAS f32x4*)(Mg + 2524);
            a0 -= mq[4][0] * x[8]; b0 -= mq[4][0] * y[8]; a1 -= mq[4][1] * x[9]; b1 -= mq[4][1] * y[9]; a0 -= mq[4][2] * x[10]; b0 -= mq[4][2] * y[10]; a1 -= mq[4][3] * x[11]; b1 -= mq[4][3] * y[11]; mq[4] = *(const LAS f32x4*)(Mg + 2528);
            a0 -= mq[5][0] * x[12]; b0 -= mq[5][0] * y[12]; a1 -= mq[5][1] * x[13]; b1 -= mq[5][1] * y[13]; a0 -= mq[5][2] * x[14]; b0 -= mq[5][2] * y[14]; a1 -= mq[5][3] * x[15]; b1 -= mq[5][3] * y[15]; mq[5] = *(const LAS f32x4*)(Mg + 2532);
            a0 -= mq[0][0] * x[16]; b0 -= mq[0][0] * y[16]; a1 -= mq[0][1] * x[17]; b1 -= mq[0][1] * y[17]; a0 -= mq[0][2] * x[18]; b0 -= mq[0][2] * y[18]; a1 -= mq[0][3] * x[19]; b1 -= mq[0][3] * y[19]; mq[0] = *(const LAS f32x4*)(Mg + 2560);
            a0 -= mq[1][0] * x[20]; b0 -= mq[1][0] * y[20]; a1 -= mq[1][1] * x[21]; b1 -= mq[1][1] * y[21]; a0 -= mq[1][2] * x[22]; b0 -= mq[1][2] * y[22]; a1 -= mq[1][3] * x[23]; b1 -= mq[1][3] * y[23]; mq[1] = *(const LAS f32x4*)(Mg + 2564);
            a0 -= mq[2][0] * x[24]; b0 -= mq[2][0] * y[24]; a1 -= mq[2][1] * x[25]; b1 -= mq[2][1] * y[25]; a0 -= mq[2][2] * x[26]; b0 -= mq[2][2] * y[26]; a1 -= mq[2][3] * x[27]; b1 -= mq[2][3] * y[27]; mq[2] = *(const LAS f32x4*)(Mg + 2568);
            a0 -= mq[3][0] * x[28]; b0 -= mq[3][0] * y[28]; a1 -= mq[3][1] * x[29]; b1 -= mq[3][1] * y[29]; a0 -= mq[3][2] * x[30]; b0 -= mq[3][2] * y[30]; a1 -= mq[3][3] * x[31]; b1 -= mq[3][3] * y[31]; mq[3] = *(const LAS f32x4*)(Mg + 2572);
            a0 -= mq[4][0] * x[32]; b0 -= mq[4][0] * y[32]; a1 -= mq[4][1] * x[33]; b1 -= mq[4][1] * y[33]; a0 -= mq[4][2] * x[34]; b0 -= mq[4][2] * y[34]; a1 -= mq[4][3] * x[35]; b1 -= mq[4][3] * y[35]; mq[4] = *(const LAS f32x4*)(Mg + 2576);
            a0 -= mq[5][0] * x[36]; b0 -= mq[5][0] * y[36]; a1 -= mq[5][1] * x[37]; b1 -= mq[5][1] * y[37]; a0 -= mq[5][2] * x[38]; b0 -= mq[5][2] * y[38]; x[39] = a0 + a1; y[39] = b0 + b1; up[4992] = x[39]; wp[4992] = f2bf(-y[39]); mq[5] = *(const LAS f32x4*)(Mg + 2580);
            { const float br = betg[40]; a0 = bf2f(*(const LAS bf16_t*)(lg + P5_VS + 10880 + c * 2)) * br; b0 = bf2f(*(const LAS bf16_t*)(lg + P5_KS + 10880 + c * 2)) * br * __expf(decg[40]); a1 = 0.f; b1 = 0.f; } a0 -= mq[0][0] * x[0]; b0 -= mq[0][0] * y[0]; a1 -= mq[0][1] * x[1]; b1 -= mq[0][1] * y[1]; a0 -= mq[0][2] * x[2]; b0 -= mq[0][2] * y[2]; a1 -= mq[0][3] * x[3]; b1 -= mq[0][3] * y[3]; mq[0] = *(const LAS f32x4*)(Mg + 2584);
            a0 -= mq[1][0] * x[4]; b0 -= mq[1][0] * y[4]; a1 -= mq[1][1] * x[5]; b1 -= mq[1][1] * y[5]; a0 -= mq[1][2] * x[6]; b0 -= mq[1][2] * y[6]; a1 -= mq[1][3] * x[7]; b1 -= mq[1][3] * y[7]; mq[1] = *(const LAS f32x4*)(Mg + 2588);
            a0 -= mq[2][0] * x[8]; b0 -= mq[2][0] * y[8]; a1 -= mq[2][1] * x[9]; b1 -= mq[2][1] * y[9]; a0 -= mq[2][2] * x[10]; b0 -= mq[2][2] * y[10]; a1 -= mq[2][3] * x[11]; b1 -= mq[2][3] * y[11]; mq[2] = *(const LAS f32x4*)(Mg + 2592);
            a0 -= mq[3][0] * x[12]; b0 -= mq[3][0] * y[12]; a1 -= mq[3][1] * x[13]; b1 -= mq[3][1] * y[13]; a0 -= mq[3][2] * x[14]; b0 -= mq[3][2] * y[14]; a1 -= mq[3][3] * x[15]; b1 -= mq[3][3] * y[15]; mq[3] = *(const LAS f32x4*)(Mg + 2596);
            a0 -= mq[4][0] * x[16]; b0 -= mq[4][0] * y[16]; a1 -= mq[4][1] * x[17]; b1 -= mq[4][1] * y[17]; a0 -= mq[4][2] * x[18]; b0 -= mq[4][2] * y[18]; a1 -= mq[4][3] * x[19]; b1 -= mq[4][3] * y[19]; mq[4] = *(const LAS f32x4*)(Mg + 2624);
            a0 -= mq[5][0] * x[20]; b0 -= mq[5][0] * y[20]; a1 -= mq[5][1] * x[21]; b1 -= mq[5][1] * y[21]; a0 -= mq[5][2] * x[22]; b0 -= mq[5][2] * y[22]; a1 -= mq[5][3] * x[23]; b1 -= mq[5][3] * y[23]; mq[5] = *(const LAS f32x4*)(Mg + 2628);
            a0 -= mq[0][0] * x[24]; b0 -= mq[0][0] * y[24]; a1 -= mq[0][1] * x[25]; b1 -= mq[0][1] * y[25]; a0 -= mq[0][2] * x[26]; b0 -= mq[0][2] * y[26]; a1 -= mq[0][3] * x[27]; b1 -= mq[0][3] * y[27]; mq[0] = *(const LAS f32x4*)(Mg + 2632);
            a0 -= mq[1][0] * x[28]; b0 -= mq[1][0] * y[28]; a1 -= mq[1][1] * x[29]; b1 -= mq[1][1] * y[29]; a0 -= mq[1][2] * x[30]; b0 -= mq[1][2] * y[30]; a1 -= mq[1][3] * x[31]; b1 -= mq[1][3] * y[31]; mq[1] = *(const LAS f32x4*)(Mg + 2636);
            a0 -= mq[2][0] * x[32]; b0 -= mq[2][0] * y[32]; a1 -= mq[2][1] * x[33]; b1 -= mq[2][1] * y[33]; a0 -= mq[2][2] * x[34]; b0 -= mq[2][2] * y[34]; a1 -= mq[2][3] * x[35]; b1 -= mq[2][3] * y[35]; mq[2] = *(const LAS f32x4*)(Mg + 2640);
            a0 -= mq[3][0] * x[36]; b0 -= mq[3][0] * y[36]; a1 -= mq[3][1] * x[37]; b1 -= mq[3][1] * y[37]; a0 -= mq[3][2] * x[38]; b0 -= mq[3][2] * y[38]; a1 -= mq[3][3] * x[39]; b1 -= mq[3][3] * y[39]; x[40] = a0 + a1; y[40] = b0 + b1; up[5120] = x[40]; wp[5120] = f2bf(-y[40]); mq[3] = *(const LAS f32x4*)(Mg + 2644);
            { const float br = betg[41]; a0 = bf2f(*(const LAS bf16_t*)(lg + P5_VS + 11152 + c * 2)) * br; b0 = bf2f(*(const LAS bf16_t*)(lg + P5_KS + 11152 + c * 2)) * br * __expf(decg[41]); a1 = 0.f; b1 = 0.f; } a0 -= mq[4][0] * x[0]; b0 -= mq[4][0] * y[0]; a1 -= mq[4][1] * x[1]; b1 -= mq[4][1] * y[1]; a0 -= mq[4][2] * x[2]; b0 -= mq[4][2] * y[2]; a1 -= mq[4][3] * x[3]; b1 -= mq[4][3] * y[3]; mq[4] = *(const LAS f32x4*)(Mg + 2648);
            a0 -= mq[5][0] * x[4]; b0 -= mq[5][0] * y[4]; a1 -= mq[5][1] * x[5]; b1 -= mq[5][1] * y[5]; a0 -= mq[5][2] * x[6]; b0 -= mq[5][2] * y[6]; a1 -= mq[5][3] * x[7]; b1 -= mq[5][3] * y[7]; mq[5] = *(const LAS f32x4*)(Mg + 2652);
            a0 -= mq[0][0] * x[8]; b0 -= mq[0][0] * y[8]; a1 -= mq[0][1] * x[9]; b1 -= mq[0][1] * y[9]; a0 -= mq[0][2] * x[10]; b0 -= mq[0][2] * y[10]; a1 -= mq[0][3] * x[11]; b1 -= mq[0][3] * y[11]; mq[0] = *(const LAS f32x4*)(Mg + 2656);
            a0 -= mq[1][0] * x[12]; b0 -= mq[1][0] * y[12]; a1 -= mq[1][1] * x[13]; b1 -= mq[1][1] * y[13]; a0 -= mq[1][2] * x[14]; b0 -= mq[1][2] * y[14]; a1 -= mq[1][3] * x[15]; b1 -= mq[1][3] * y[15]; mq[1] = *(const LAS f32x4*)(Mg + 2660);
            a0 -= mq[2][0] * x[16]; b0 -= mq[2][0] * y[16]; a1 -= mq[2][1] * x[17]; b1 -= mq[2][1] * y[17]; a0 -= mq[2][2] * x[18]; b0 -= mq[2][2] * y[18]; a1 -= mq[2][3] * x[19]; b1 -= mq[2][3] * y[19]; mq[2] = *(const LAS f32x4*)(Mg + 2664);
            a0 -= mq[3][0] * x[20]; b0 -= mq[3][0] * y[20]; a1 -= mq[3][1] * x[21]; b1 -= mq[3][1] * y[21]; a0 -= mq[3][2] * x[22]; b0 -= mq[3][2] * y[22]; a1 -= mq[3][3] * x[23]; b1 -= mq[3][3] * y[23]; mq[3] = *(const LAS f32x4*)(Mg + 2688);
            a0 -= mq[4][0] * x[24]; b0 -= mq[4][0] * y[24]; a1 -= mq[4][1] * x[25]; b1 -= mq[4][1] * y[25]; a0 -= mq[4][2] * x[26]; b0 -= mq[4][2] * y[26]; a1 -= mq[4][3] * x[27]; b1 -= mq[4][3] * y[27]; mq[4] = *(const LAS f32x4*)(Mg + 2692);
            a0 -= mq[5][0] * x[28]; b0 -= mq[5][0] * y[28]; a1 -= mq[5][1] * x[29]; b1 -= mq[5][1] * y[29]; a0 -= mq[5][2] * x[30]; b0 -= mq[5][2] * y[30]; a1 -= mq[5][3] * x[31]; b1 -= mq[5][3] * y[31]; mq[5] = *(const LAS f32x4*)(Mg + 2696);
            a0 -= mq[0][0] * x[32]; b0 -= mq[0][0] * y[32]; a1 -= mq[0][1] * x[33]; b1 -= mq[0][1] * y[33]; a0 -= mq[0][2] * x[34]; b0 -= mq[0][2] * y[34]; a1 -= mq[0][3] * x[35]; b1 -= mq[0][3] * y[35]; mq[0] = *(const LAS f32x4*)(Mg + 2700);
            a0 -= mq[1][0] * x[36]; b0 -= mq[1][0] * y[36]; a1 -= mq[1][1] * x[37]; b1 -= mq[1][1] * y[37]; a0 -= mq[1][2] * x[38]; b0 -= mq[1][2] * y[38]; a1 -= mq[1][3] * x[39]; b1 -= mq[1][3] * y[39]; mq[1] = *(const LAS f32x4*)(Mg + 2704);
            a0 -= mq[2][0] * x[40]; b0 -= mq[2][0] * y[40]; x[41] = a0 + a1; y[41] = b0 + b1; up[5248] = x[41]; wp[5248] = f2bf(-y[41]); mq[2] = *(const LAS f32x4*)(Mg + 2708);
            { const float br = betg[42]; a0 = bf2f(*(const LAS bf16_t*)(lg + P5_VS + 11424 + c * 2)) * br; b0 = bf2f(*(const LAS bf16_t*)(lg + P5_KS + 11424 + c * 2)) * br * __expf(decg[42]); a1 = 0.f; b1 = 0.f; } a0 -= mq[3][0] * x[0]; b0 -= mq[3][0] * y[0]; a1 -= mq[3][1] * x[1]; b1 -= mq[3][1] * y[1]; a0 -= mq[3][2] * x[2]; b0 -= mq[3][2] * y[2]; a1 -= mq[3][3] * x[3]; b1 -= mq[3][3] * y[3]; mq[3] = *(const LAS f32x4*)(Mg + 2712);
            a0 -= mq[4][0] * x[4]; b0 -= mq[4][0] * y[4]; a1 -= mq[4][1] * x[5]; b1 -= mq[4][1] * y[5]; a0 -= mq[4][2] * x[6]; b0 -= mq[4][2] * y[6]; a1 -= mq[4][3] * x[7]; b1 -= mq[4][3] * y[7]; mq[4] = *(const LAS f32x4*)(Mg + 2716);
            a0 -= mq[5][0] * x[8]; b0 -= mq[5][0] * y[8]; a1 -= mq[5][1] * x[9]; b1 -= mq[5][1] * y[9]; a0 -= mq[5][2] * x[10]; b0 -= mq[5][2] * y[10]; a1 -= mq[5][3] * x[11]; b1 -= mq[5][3] * y[11]; mq[5] = *(const LAS f32x4*)(Mg + 2720);
            a0 -= mq[0][0] * x[12]; b0 -= mq[0][0] * y[12]; a1 -= mq[0][1] * x[13]; b1 -= mq[0][1] * y[13]; a0 -= mq[0][2] * x[14]; b0 -= mq[0][2] * y[14]; a1 -= mq[0][3] * x[15]; b1 -= mq[0][3] * y[15]; mq[0] = *(const LAS f32x4*)(Mg + 2724);
            a0 -= mq[1][0] * x[16]; b0 -= mq[1][0] * y[16]; a1 -= mq[1][1] * x[17]; b1 -= mq[1][1] * y[17]; a0 -= mq[1][2] * x[18]; b0 -= mq[1][2] * y[18]; a1 -= mq[1][3] * x[19]; b1 -= mq[1][3] * y[19]; mq[1] = *(const LAS f32x4*)(Mg + 2728);
            a0 -= mq[2][0] * x[20]; b0 -= mq[2][0] * y[20]; a1 -= mq[2][1] * x[21]; b1 -= mq[2][1] * y[21]; a0 -= mq[2][2] * x[22]; b0 -= mq[2][2] * y[22]; a1 -= mq[2][3] * x[23]; b1 -= mq[2][3] * y[23]; mq[2] = *(const LAS f32x4*)(Mg + 2752);
            a0 -= mq[3][0] * x[24]; b0 -= mq[3][0] * y[24]; a1 -= mq[3][1] * x[25]; b1 -= mq[3][1] * y[25]; a0 -= mq[3][2] * x[26]; b0 -= mq[3][2] * y[26]; a1 -= mq[3][3] * x[27]; b1 -= mq[3][3] * y[27]; mq[3] = *(const LAS f32x4*)(Mg + 2756);
            a0 -= mq[4][0] * x[28]; b0 -= mq[4][0] * y[28]; a1 -= mq[4][1] * x[29]; b1 -= mq[4][1] * y[29]; a0 -= mq[4][2] * x[30]; b0 -= mq[4][2] * y[30]; a1 -= mq[4][3] * x[31]; b1 -= mq[4][3] * y[31]; mq[4] = *(const LAS f32x4*)(Mg + 2760);
            a0 -= mq[5][0] * x[32]; b0 -= mq[5][0] * y[32]; a1 -= mq[5][1] * x[33]; b1 -= mq[5][1] * y[33]; a0 -= mq[5][2] * x[34]; b0 -= mq[5][2] * y[34]; a1 -= mq[5][3] * x[35]; b1 -= mq[5][3] * y[35]; mq[5] = *(const LAS f32x4*)(Mg + 2764);
            a0 -= mq[0][0] * x[36]; b0 -= mq[0][0] * y[36]; a1 -= mq[0][1] * x[37]; b1 -= mq[0][1] * y[37]; a0 -= mq[0][2] * x[38]; b0 -= mq[0][2] * y[38]; a1 -= mq[0][3] * x[39]; b1 -= mq[0][3] * y[39]; mq[0] = *(const LAS f32x4*)(Mg + 2768);
            a0 -= mq[1][0] * x[40]; b0 -= mq[1][0] * y[40]; a1 -= mq[1][1] * x[41]; b1 -= mq[1][1] * y[41]; x[42] = a0 + a1; y[42] = b0 + b1; up[5376] = x[42]; wp[5376] = f2bf(-y[42]); mq[1] = *(const LAS f32x4*)(Mg + 2772);
            { const float br = betg[43]; a0 = bf2f(*(const LAS bf16_t*)(lg + P5_VS + 11696 + c * 2)) * br; b0 = bf2f(*(const LAS bf16_t*)(lg + P5_KS + 11696 + c * 2)) * br * __expf(decg[43]); a1 = 0.f; b1 = 0.f; } a0 -= mq[2][0] * x[0]; b0 -= mq[2][0] * y[0]; a1 -= mq[2][1] * x[1]; b1 -= mq[2][1] * y[1]; a0 -= mq[2][2] * x[2]; b0 -= mq[2][2] * y[2]; a1 -= mq[2][3] * x[3]; b1 -= mq[2][3] * y[3]; mq[2] = *(const LAS f32x4*)(Mg + 2776);
            a0 -= mq[3][0] * x[4]; b0 -= mq[3][0] * y[4]; a1 -= mq[3][1] * x[5]; b1 -= mq[3][1] * y[5]; a0 -= mq[3][2] * x[6]; b0 -= mq[3][2] * y[6]; a1 -= mq[3][3] * x[7]; b1 -= mq[3][3] * y[7]; mq[3] = *(const LAS f32x4*)(Mg + 2780);
            a0 -= mq[4][0] * x[8]; b0 -= mq[4][0] * y[8]; a1 -= mq[4][1] * x[9]; b1 -= mq[4][1] * y[9]; a0 -= mq[4][2] * x[10]; b0 -= mq[4][2] * y[10]; a1 -= mq[4][3] * x[11]; b1 -= mq[4][3] * y[11]; mq[4] = *(const LAS f32x4*)(Mg + 2784);
            a0 -= mq[5][0] * x[12]; b0 -= mq[5][0] * y[12]; a1 -= mq[5][1] * x[13]; b1 -= mq[5][1] * y[13]; a0 -= mq[5][2] * x[14]; b0 -= mq[5][2] * y[14]; a1 -= mq[5][3] * x[15]; b1 -= mq[5][3] * y[15]; mq[5] = *(const LAS f32x4*)(Mg + 2788);
            a0 -= mq[0][0] * x[16]; b0 -= mq[0][0] * y[16]; a1 -= mq[0][1] * x[17]; b1 -= mq[0][1] * y[17]; a0 -= mq[0][2] * x[18]; b0 -= mq[0][2] * y[18]; a1 -= mq[0][3] * x[19]; b1 -= mq[0][3] * y[19]; mq[0] = *(const LAS f32x4*)(Mg + 2792);
            a0 -= mq[1][0] * x[20]; b0 -= mq[1][0] * y[20]; a1 -= mq[1][1] * x[21]; b1 -= mq[1][1] * y[21]; a0 -= mq[1][2] * x[22]; b0 -= mq[1][2] * y[22]; a1 -= mq[1][3] * x[23]; b1 -= mq[1][3] * y[23]; mq[1] = *(const LAS f32x4*)(Mg + 2816);
            a0 -= mq[2][0] * x[24]; b0 -= mq[2][0] * y[24]; a1 -= mq[2][1] * x[25]; b1 -= mq[2][1] * y[25]; a0 -= mq[2][2] * x[26]; b0 -= mq[2][2] * y[26]; a1 -= mq[2][3] * x[27]; b1 -= mq[2][3] * y[27]; mq[2] = *(const LAS f32x4*)(Mg + 2820);
            a0 -= mq[3][0] * x[28]; b0 -= mq[3][0] * y[28]; a1 -= mq[3][1] * x[29]; b1 -= mq[3][1] * y[29]; a0 -= mq[3][2] * x[30]; b0 -= mq[3][2] * y[30]; a1 -= mq[3][3] * x[31]; b1 -= mq[3][3] * y[31]; mq[3] = *(const LAS f32x4*)(Mg + 2824);
            a0 -= mq[4][0] * x[32]; b0 -= mq[4][0] * y[32]; a1 -= mq[4][1] * x[33]; b1 -= mq[4][1] * y[33]; a0 -= mq[4][2] * x[34]; b0 -= mq[4][2] * y[34]; a1 -= mq[4][3] * x[35]; b1 -= mq[4][3] * y[35]; mq[4] = *(const LAS f32x4*)(Mg + 2828);
            a0 -= mq[5][0] * x[36]; b0 -= mq[5][0] * y[36]; a1 -= mq[5][1] * x[37]; b1 -= mq[5][1] * y[37]; a0 -= mq[5][2] * x[38]; b0 -= mq[5][2] * y[38]; a1 -= mq[5][3] * x[39]; b1 -= mq[5][3] * y[39]; mq[5] = *(const LAS f32x4*)(Mg + 2832);
            a0 -= mq[0][0] * x[40]; b0 -= mq[0][0] * y[40]; a1 -= mq[0][1] * x[41]; b1 -= mq[0][1] * y[41]; a0 -= mq[0][2] * x[42]; b0 -= mq[0][2] * y[42]; x[43] = a0 + a1; y[43] = b0 + b1; up[5504] = x[43]; wp[5504] = f2bf(-y[43]); mq[0] = *(const LAS f32x4*)(Mg + 2836);
            { const float br = betg[44]; a0 = bf2f(*(const LAS bf16_t*)(lg + P5_VS + 11968 + c * 2)) * br; b0 = bf2f(*(const LAS bf16_t*)(lg + P5_KS + 11968 + c * 2)) * br * __expf(decg[44]); a1 = 0.f; b1 = 0.f; } a0 -= mq[1][0] * x[0]; b0 -= mq[1][0] * y[0]; a1 -= mq[1][1] * x[1]; b1 -= mq[1][1] * y[1]; a0 -= mq[1][2] * x[2]; b0 -= mq[1][2] * y[2]; a1 -= mq[1][3] * x[3]; b1 -= mq[1][3] * y[3]; mq[1] = *(const LAS f32x4*)(Mg + 2840);
            a0 -= mq[2][0] * x[4]; b0 -= mq[2][0] * y[4]; a1 -= mq[2][1] * x[5]; b1 -= mq[2][1] * y[5]; a0 -= mq[2][2] * x[6]; b0 -= mq[2][2] * y[6]; a1 -= mq[2][3] * x[7]; b1 -= mq[2][3] * y[7]; mq[2] = *(const LAS f32x4*)(Mg + 2844);
            a0 -= mq[3][0] * x[8]; b0 -= mq[3][0] * y[8]; a1 -= mq[3][1] * x[9]; b1 -= mq[3][1] * y[9]; a0 -= mq[3][2] * x[10]; b0 -= mq[3][2] * y[10]; a1 -= mq[3][3] * x[11]; b1 -= mq[3][3] * y[11]; mq[3] = *(const LAS f32x4*)(Mg + 2848);
            a0 -= mq[4][0] * x[12]; b0 -= mq[4][0] * y[12]; a1 -= mq[4][1] * x[13]; b1 -= mq[4][1] * y[13]; a0 -= mq[4][2] * x[14]; b0 -= mq[4][2] * y[14]; a1 -= mq[4][3] * x[15]; b1 -= mq[4][3] * y[15]; mq[4] = *(const LAS f32x4*)(Mg + 2852);
            a0 -= mq[5][0] * x[16]; b0 -= mq[5][0] * y[16]; a1 -= mq[5][1] * x[17]; b1 -= mq[5][1] * y[17]; a0 -= mq[5][2] * x[18]; b0 -= mq[5][2] * y[18]; a1 -= mq[5][3] * x[19]; b1 -= mq[5][3] * y[19]; mq[5] = *(const LAS f32x4*)(Mg + 2856);
            a0 -= mq[0][0] * x[20]; b0 -= mq[0][0] * y[20]; a1 -= mq[0][1] * x[21]; b1 -= mq[0][1] * y[21]; a0 -= mq[0][2] * x[22]; b0 -= mq[0][2] * y[22]; a1 -= mq[0][3] * x[23]; b1 -= mq[0][3] * y[23]; mq[0] = *(const LAS f32x4*)(Mg + 2880);
            a0 -= mq[1][0] * x[24]; b0 -= mq[1][0] * y[24]; a1 -= mq[1][1] * x[25]; b1 -= mq[1][1] * y[25]; a0 -= mq[1][2] * x[26]; b0 -= mq[1][2] * y[26]; a1 -= mq[1][3] * x[27]; b1 -= mq[1][3] * y[27]; mq[1] = *(const LAS f32x4*)(Mg + 2884);
            a0 -= mq[2][0] * x[28]; b0 -= mq[2][0] * y[28]; a1 -= mq[2][1] * x[29]; b1 -= mq[2][1] * y[29]; a0 -= mq[2][2] * x[30]; b0 -= mq[2][2] * y[30]; a1 -= mq[2][3] * x[31]; b1 -= mq[2][3] * y[31]; mq[2] = *(const LAS f32x4*)(Mg + 2888);
            a0 -= mq[3][0] * x[32]; b0 -= mq[3][0] * y[32]; a1 -= mq[3][1] * x[33]; b1 -= mq[3][1] * y[33]; a0 -= mq[3][2] * x[34]; b0 -= mq[3][2] * y[34]; a1 -= mq[3][3] * x[35]; b1 -= mq[3][3] * y[35]; mq[3] = *(const LAS f32x4*)(Mg + 2892);
            a0 -= mq[4][0] * x[36]; b0 -= mq[4][0] * y[36]; a1 -= mq[4][1] * x[37]; b1 -= mq[4][1] * y[37]; a0 -= mq[4][2] * x[38]; b0 -= mq[4][2] * y[38]; a1 -= mq[4][3] * x[39]; b1 -= mq[4][3] * y[39]; mq[4] = *(const LAS f32x4*)(Mg + 2896);
            a0 -= mq[5][0] * x[40]; b0 -= mq[5][0] * y[40]; a1 -= mq[5][1] * x[41]; b1 -= mq[5][1] * y[41]; a0 -= mq[5][2] * x[42]; b0 -= mq[5][2] * y[42]; a1 -= mq[5][3] * x[43]; b1 -= mq[5][3] * y[43]; x[44] = a0 + a1; y[44] = b0 + b1; up[5632] = x[44]; wp[5632] = f2bf(-y[44]); mq[5] = *(const LAS f32x4*)(Mg + 2900);
            { const float br = betg[45]; a0 = bf2f(*(const LAS bf16_t*)(lg + P5_VS + 12240 + c * 2)) * br; b0 = bf2f(*(const LAS bf16_t*)(lg + P5_KS + 12240 + c * 2)) * br * __expf(decg[45]); a1 = 0.f; b1 = 0.f; } a0 -= mq[0][0] * x[0]; b0 -= mq[0][0] * y[0]; a1 -= mq[0][1] * x[1]; b1 -= mq[0][1] * y[1]; a0 -= mq[0][2] * x[2]; b0 -= mq[0][2] * y[2]; a1 -= mq[0][3] * x[3]; b1 -= mq[0][3] * y[3]; mq[0] = *(const LAS f32x4*)(Mg + 2904);
            a0 -= mq[1][0] * x[4]; b0 -= mq[1][0] * y[4]; a1 -= mq[1][1] * x[5]; b1 -= mq[1][1] * y[5]; a0 -= mq[1][2] * x[6]; b0 -= mq[1][2] * y[6]; a1 -= mq[1][3] * x[7]; b1 -= mq[1][3] * y[7]; mq[1] = *(const LAS f32x4*)(Mg + 2908);
            a0 -= mq[2][0] * x[8]; b0 -= mq[2][0] * y[8]; a1 -= mq[2][1] * x[9]; b1 -= mq[2][1] * y[9]; a0 -= mq[2][2] * x[10]; b0 -= mq[2][2] * y[10]; a1 -= mq[2][3] * x[11]; b1 -= mq[2][3] * y[11]; mq[2] = *(const LAS f32x4*)(Mg + 2912);
            a0 -= mq[3][0] * x[12]; b0 -= mq[3][0] * y[12]; a1 -= mq[3][1] * x[13]; b1 -= mq[3][1] * y[13]; a0 -= mq[3][2] * x[14]; b0 -= mq[3][2] * y[14]; a1 -= mq[3][3] * x[15]; b1 -= mq[3][3] * y[15]; mq[3] = *(const LAS f32x4*)(Mg + 2916);
            a0 -= mq[4][0] * x[16]; b0 -= mq[4][0] * y[16]; a1 -= mq[4][1] * x[17]; b1 -= mq[4][1] * y[17]; a0 -= mq[4][2] * x[18]; b0 -= mq[4][2] * y[18]; a1 -= mq[4][3] * x[19]; b1 -= mq[4][3] * y[19]; mq[4] = *(const LAS f32x4*)(Mg + 2920);
            a0 -= mq[5][0] * x[20]; b0 -= mq[5][0] * y[20]; a1 -= mq[5][1] * x[21]; b1 -= mq[5][1] * y[21]; a0 -= mq[5][2] * x[22]; b0 -= mq[5][2] * y[22]; a1 -= mq[5][3] * x[23]; b1 -= mq[5][3] * y[23]; mq[5] = *(const LAS f32x4*)(Mg + 2924);
            a0 -= mq[0][0] * x[24]; b0 -= mq[0][0] * y[24]; a1 -= mq[0][1] * x[25]; b1 -= mq[0][1] * y[25]; a0 -= mq[0][2] * x[26]; b0 -= mq[0][2] * y[26]; a1 -= mq[0][3] * x[27]; b1 -= mq[0][3] * y[27]; mq[0] = *(const LAS f32x4*)(Mg + 2944);
            a0 -= mq[1][0] * x[28]; b0 -= mq[1][0] * y[28]; a1 -= mq[1][1] * x[29]; b1 -= mq[1][1] * y[29]; a0 -= mq[1][2] * x[30]; b0 -= mq[1][2] * y[30]; a1 -= mq[1][3] * x[31]; b1 -= mq[1][3] * y[31]; mq[1] = *(const LAS f32x4*)(Mg + 2948);
            a0 -= mq[2][0] * x[32]; b0 -= mq[2][0] * y[32]; a1 -= mq[2][1] * x[33]; b1 -= mq[2][1] * y[33]; a0 -= mq[2][2] * x[34]; b0 -= mq[2][2] * y[34]; a1 -= mq[2][3] * x[35]; b1 -= mq[2][3] * y[35]; mq[2] = *(const LAS f32x4*)(Mg + 2952);
            a0 -= mq[3][0] * x[36]; b0 -= mq[3][0] * y[36]; a1 -= mq[3][1] * x[37]; b1 -= mq[3][1] * y[37]; a0 -= mq[3][2] * x[38]; b0 -= mq[3][2] * y[38]; a1 -= mq[3][3] * x[39]; b1 -= mq[3][3] * y[39]; mq[3] = *(const LAS f32x4*)(Mg + 2956);
            a0 -= mq[4][0] * x[40]; b0 -= mq[4][0] * y[40]; a1 -= mq[4][1] * x[41]; b1 -= mq[4][1] * y[41]; a0 -= mq[4][2] * x[42]; b0 -= mq[4][2] * y[42]; a1 -= mq[4][3] * x[43]; b1 -= mq[4][3] * y[43]; mq[4] = *(const LAS f32x4*)(Mg + 2960);
            a0 -= mq[5][0] * x[44]; b0 -= mq[5][0] * y[44]; x[45] = a0 + a1; y[45] = b0 + b1; up[5760] = x[45]; wp[5760] = f2bf(-y[45]); mq[5] = *(const LAS f32x4*)(Mg + 2964);
            { const float br = betg[46]; a0 = bf2f(*(const LAS bf16_t*)(lg + P5_VS + 12512 + c * 2)) * br; b0 = bf2f(*(const LAS bf16_t*)(lg + P5_KS + 12512 + c * 2)) * br * __expf(decg[46]); a1 = 0.f; b1 = 0.f; } a0 -= mq[0][0] * x[0]; b0 -= mq[0][0] * y[0]; a1 -= mq[0][1] * x[1]; b1 -= mq[0][1] * y[1]; a0 -= mq[0][2] * x[2]; b0 -= mq[0][2] * y[2]; a1 -= mq[0][3] * x[3]; b1 -= mq[0][3] * y[3]; mq[0] = *(const LAS f32x4*)(Mg + 2968);
            a0 -= mq[1][0] * x[4]; b0 -= mq[1][0] * y[4]; a1 -= mq[1][1] * x[5]; b1 -= mq[1][1] * y[5]; a0 -= mq[1][2] * x[6]; b0 -= mq[1][2] * y[6]; a1 -= mq[1][3] * x[7]; b1 -= mq[1][3] * y[7]; mq[1] = *(const LAS f32x4*)(Mg + 2972);
            a0 -= mq[2][0] * x[8]; b0 -= mq[2][0] * y[8]; a1 -= mq[2][1] * x[9]; b1 -= mq[2][1] * y[9]; a0 -= mq[2][2] * x[10]; b0 -= mq[2][2] * y[10]; a1 -= mq[2][3] * x[11]; b1 -= mq[2][3] * y[11]; mq[2] = *(const LAS f32x4*)(Mg + 2976);
            a0 -= mq[3][0] * x[12]; b0 -= mq[3][0] * y[12]; a1 -= mq[3][1] * x[13]; b1 -= mq[3][1] * y[13]; a0 -= mq[3][2] * x[14]; b0 -= mq[3][2] * y[14]; a1 -= mq[3][3] * x[15]; b1 -= mq[3][3] * y[15]; mq[3] = *(const LAS f32x4*)(Mg + 2980);
            a0 -= mq[4][0] * x[16]; b0 -= mq[4][0] * y[16]; a1 -= mq[4][1] * x[17]; b1 -= mq[4][1] * y[17]; a0 -= mq[4][2] * x[18]; b0 -= mq[4][2] * y[18]; a1 -= mq[4][3] * x[19]; b1 -= mq[4][3] * y[19]; mq[4] = *(const LAS f32x4*)(Mg + 2984);
            a0 -= mq[5][0] * x[20]; b0 -= mq[5][0] * y[20]; a1 -= mq[5][1] * x[21]; b1 -= mq[5][1] * y[21]; a0 -= mq[5][2] * x[22]; b0 -= mq[5][2] * y[22]; a1 -= mq[5][3] * x[23]; b1 -= mq[5][3] * y[23]; mq[5] = *(const LAS f32x4*)(Mg + 2988);
            a0 -= mq[0][0] * x[24]; b0 -= mq[0][0] * y[24]; a1 -= mq[0][1] * x[25]; b1 -= mq[0][1] * y[25]; a0 -= mq[0][2] * x[26]; b0 -= mq[0][2] * y[26]; a1 -= mq[0][3] * x[27]; b1 -= mq[0][3] * y[27]; mq[0] = *(const LAS f32x4*)(Mg + 3008);
            a0 -= mq[1][0] * x[28]; b0 -= mq[1][0] * y[28]; a1 -= mq[1][1] * x[29]; b1 -= mq[1][1] * y[29]; a0 -= mq[1][2] * x[30]; b0 -= mq[1][2] * y[30]; a1 -= mq[1][3] * x[31]; b1 -= mq[1][3] * y[31]; mq[1] = *(const LAS f32x4*)(Mg + 3012);
            a0 -= mq[2][0] * x[32]; b0 -= mq[2][0] * y[32]; a1 -= mq[2][1] * x[33]; b1 -= mq[2][1] * y[33]; a0 -= mq[2][2] * x[34]; b0 -= mq[2][2] * y[34]; a1 -= mq[2][3] * x[35]; b1 -= mq[2][3] * y[35]; mq[2] = *(const LAS f32x4*)(Mg + 3016);
            a0 -= mq[3][0] * x[36]; b0 -= mq[3][0] * y[36]; a1 -= mq[3][1] * x[37]; b1 -= mq[3][1] * y[37]; a0 -= mq[3][2] * x[38]; b0 -= mq[3][2] * y[38]; a1 -= mq[3][3] * x[39]; b1 -= mq[3][3] * y[39]; mq[3] = *(const LAS f32x4*)(Mg + 3020);
            a0 -= mq[4][0] * x[40]; b0 -= mq[4][0] * y[40]; a1 -= mq[4][1] * x[41]; b1 -= mq[4][1] * y[41]; a0 -= mq[4][2] * x[42]; b0 -= mq[4][2] * y[42]; a1 -= mq[4][3] * x[43]; b1 -= mq[4][3] * y[43]; mq[4] = *(const LAS f32x4*)(Mg + 3024);
            a0 -= mq[5][0] * x[44]; b0 -= mq[5][0] * y[44]; a1 -= mq[5][1] * x[45]; b1 -= mq[5][1] * y[45]; x[46] = a0 + a1; y[46] = b0 + b1; up[5888] = x[46]; wp[5888] = f2bf(-y[46]); mq[5] = *(const LAS f32x4*)(Mg + 3028);
            { const float br = betg[47]; a0 = bf2f(*(const LAS bf16_t*)(lg + P5_VS + 12784 + c * 2)) * br; b0 = bf2f(*(const LAS bf16_t*)(lg + P5_KS + 12784 + c * 2)) * br * __expf(decg[47]); a1 = 0.f; b1 = 0.f; } a0 -= mq[0][0] * x[0]; b0 -= mq[0][0] * y[0]; a1 -= mq[0][1] * x[1]; b1 -= mq[0][1] * y[1]; a0 -= mq[0][2] * x[2]; b0 -= mq[0][2] * y[2]; a1 -= mq[0][3] * x[3]; b1 -= mq[0][3] * y[3]; mq[0] = *(const LAS f32x4*)(Mg + 3032);
            a0 -= mq[1][0] * x[4]; b0 -= mq[1][0] * y[4]; a1 -= mq[1][1] * x[5]; b1 -= mq[1][1] * y[5]; a0 -= mq[1][2] * x[6]; b0 -= mq[1][2] * y[6]; a1 -= mq[1][3] * x[7]; b1 -= mq[1][3] * y[7]; mq[1] = *(const LAS f32x4*)(Mg + 3036);
            a0 -= mq[2][0] * x[8]; b0 -= mq[2][0] * y[8]; a1 -= mq[2][1] * x[9]; b1 -= mq[2][1] * y[9]; a0 -= mq[2][2] * x[10]; b0 -= mq[2][2] * y[10]; a1 -= mq[2][3] * x[11]; b1 -= mq[2][3] * y[11]; mq[2] = *(const LAS f32x4*)(Mg + 3040);
            a0 -= mq[3][0] * x[12]; b0 -= mq[3][0] * y[12]; a1 -= mq[3][1] * x[13]; b1 -= mq[3][1] * y[13]; a0 -= mq[3][2] * x[14]; b0 -= mq[3][2] * y[14]; a1 -= mq[3][3] * x[15]; b1 -= mq[3][3] * y[15]; mq[3] = *(const LAS f32x4*)(Mg + 3044);
            a0 -= mq[4][0] * x[16]; b0 -= mq[4][0] * y[16]; a1 -= mq[4][1] * x[17]; b1 -= mq[4][1] * y[17]; a0 -= mq[4][2] * x[18]; b0 -= mq[4][2] * y[18]; a1 -= mq[4][3] * x[19]; b1 -= mq[4][3] * y[19]; mq[4] = *(const LAS f32x4*)(Mg + 3048);
            a0 -= mq[5][0] * x[20]; b0 -= mq[5][0] * y[20]; a1 -= mq[5][1] * x[21]; b1 -= mq[5][1] * y[21]; a0 -= mq[5][2] * x[22]; b0 -= mq[5][2] * y[22]; a1 -= mq[5][3] * x[23]; b1 -= mq[5][3] * y[23]; mq[5] = *(const LAS f32x4*)(Mg + 3052);
            a0 -= mq[0][0] * x[24]; b0 -= mq[0][0] * y[24]; a1 -= mq[0][1] * x[25]; b1 -= mq[0][1] * y[25]; a0 -= mq[0][2] * x[26]; b0 -= mq[0][2] * y[26]; a1 -= mq[0][3] * x[27]; b1 -= mq[0][3] * y[27]; mq[0] = *(const LAS f32x4*)(Mg + 3072);
            a0 -= mq[1][0] * x[28]; b0 -= mq[1][0] * y[28]; a1 -= mq[1][1] * x[29]; b1 -= mq[1][1] * y[29]; a0 -= mq[1][2] * x[30]; b0 -= mq[1][2] * y[30]; a1 -= mq[1][3] * x[31]; b1 -= mq[1][3] * y[31]; mq[1] = *(const LAS f32x4*)(Mg + 3076);
            a0 -= mq[2][0] * x[32]; b0 -= mq[2][0] * y[32]; a1 -= mq[2][1] * x[33]; b1 -= mq[2][1] * y[33]; a0 -= mq[2][2] * x[34]; b0 -= mq[2][2] * y[34]; a1 -= mq[2][3] * x[35]; b1 -= mq[2][3] * y[35]; mq[2] = *(const LAS f32x4*)(Mg + 3080);
            a0 -= mq[3][0] * x[36]; b0 -= mq[3][0] * y[36]; a1 -= mq[3][1] * x[37]; b1 -= mq[3][1] * y[37]; a0 -= mq[3][2] * x[38]; b0 -= mq[3][2] * y[38]; a1 -= mq[3][3] * x[39]; b1 -= mq[3][3] * y[39]; mq[3] = *(const LAS f32x4*)(Mg + 3084);
            a0 -= mq[4][0] * x[40]; b0 -= mq[4][0] * y[40]; a1 -= mq[4][1] * x[41]; b1 -= mq[4][1] * y[41]; a0 -= mq[4][2] * x[42]; b0 -= mq[4][2] * y[42]; a1 -= mq[4][3] * x[43]; b1 -= mq[4][3] * y[43]; mq[4] = *(const LAS f32x4*)(Mg + 3088);
            a0 -= mq[5][0] * x[44]; b0 -= mq[5][0] * y[44]; a1 -= mq[5][1] * x[45]; b1 -= mq[5][1] * y[45]; a0 -= mq[5][2] * x[46]; b0 -= mq[5][2] * y[46]; x[47] = a0 + a1; y[47] = b0 + b1; up[6016] = x[47]; wp[6016] = f2bf(-y[47]); mq[5] = *(const LAS f32x4*)(Mg + 3092);
            { const float br = betg[48]; a0 = bf2f(*(const LAS bf16_t*)(lg + P5_VS + 13056 + c * 2)) * br; b0 = bf2f(*(const LAS bf16_t*)(lg + P5_KS + 13056 + c * 2)) * br * __expf(decg[48]); a1 = 0.f; b1 = 0.f; } a0 -= mq[0][0] * x[0]; b0 -= mq[0][0] * y[0]; a1 -= mq[0][1] * x[1]; b1 -= mq[0][1] * y[1]; a0 -= mq[0][2] * x[2]; b0 -= mq[0][2] * y[2]; a1 -= mq[0][3] * x[3]; b1 -= mq[0][3] * y[3]; mq[0] = *(const LAS f32x4*)(Mg + 3096);
            a0 -= mq[1][0] * x[4]; b0 -= mq[1][0] * y[4]; a1 -= mq[1][1] * x[5]; b1 -= mq[1][1] * y[5]; a0 -= mq[1][2] * x[6]; b0 -= mq[1][2] * y[6]; a1 -= mq[1][3] * x[7]; b1 -= mq[1][3] * y[7]; mq[1] = *(const LAS f32x4*)(Mg + 3100);
            a0 -= mq[2][0] * x[8]; b0 -= mq[2][0] * y[8]; a1 -= mq[2][1] * x[9]; b1 -= mq[2][1] * y[9]; a0 -= mq[2][2] * x[10]; b0 -= mq[2][2] * y[10]; a1 -= mq[2][3] * x[11]; b1 -= mq[2][3] * y[11]; mq[2] = *(const LAS f32x4*)(Mg + 3104);
            a0 -= mq[3][0] * x[12]; b0 -= mq[3][0] * y[12]; a1 -= mq[3][1] * x[13]; b1 -= mq[3][1] * y[13]; a0 -= mq[3][2] * x[14]; b0 -= mq[3][2] * y[14]; a1 -= mq[3][3] * x[15]; b1 -= mq[3][3] * y[15]; mq[3] = *(const LAS f32x4*)(Mg + 3108);
            a0 -= mq[4][0] * x[16]; b0 -= mq[4][0] * y[16]; a1 -= mq[4][1] * x[17]; b1 -= mq[4][1] * y[17]; a0 -= mq[4][2] * x[18]; b0 -= mq[4][2] * y[18]; a1 -= mq[4][3] * x[19]; b1 -= mq[4][3] * y[19]; mq[4] = *(const LAS f32x4*)(Mg + 3112);
            a0 -= mq[5][0] * x[20]; b0 -= mq[5][0] * y[20]; a1 -= mq[5][1] * x[21]; b1 -= mq[5][1] * y[21]; a0 -= mq[5][2] * x[22]; b0 -= mq[5][2] * y[22]; a1 -= mq[5][3] * x[23]; b1 -= mq[5][3] * y[23]; mq[5] = *(const LAS f32x4*)(Mg + 3116);
            a0 -= mq[0][0] * x[24]; b0 -= mq[0][0] * y[24]; a1 -= mq[0][1] * x[25]; b1 -= mq[0][1] * y[25]; a0 -= mq[0][2] * x[26]; b0 -= mq[0][2] * y[26]; a1 -= mq[0][3] * x[27]; b1 -= mq[0][3] * y[27]; mq[0] = *(const LAS f32x4*)(Mg + 3136);
            a0 -= mq[1][0] * x[28]; b0 -= mq[1][0] * y[28]; a1 -= mq[1][1] * x[29]; b1 -= mq[1][1] * y[29]; a0 -= mq[1][2] * x[30]; b0 -= mq[1][2] * y[30]; a1 -= mq[1][3] * x[31]; b1 -= mq[1][3] * y[31]; mq[1] = *(const LAS f32x4*)(Mg + 3140);
            a0 -= mq[2][0] * x[32]; b0 -= mq[2][0] * y[32]; a1 -= mq[2][1] * x[33]; b1 -= mq[2][1] * y[33]; a0 -= mq[2][2] * x[34]; b0 -= mq[2][2] * y[34]; a1 -= mq[2][3] * x[35]; b1 -= mq[2][3] * y[35]; mq[2] = *(const LAS f32x4*)(Mg + 3144);
            a0 -= mq[3][0] * x[36]; b0 -= mq[3][0] * y[36]; a1 -= mq[3][1] * x[37]; b1 -= mq[3][1] * y[37]; a0 -= mq[3][2] * x[38]; b0 -= mq[3][2] * y[38]; a1 -= mq[3][3] * x[39]; b1 -= mq[3][3] * y[39]; mq[3] = *(const LAS f32x4*)(Mg + 3148);
            a0 -= mq[4][0] * x[40]; b0 -= mq[4][0] * y[40]; a1 -= mq[4][1] * x[41]; b1 -= mq[4][1] * y[41]; a0 -= mq[4][2] * x[42]; b0 -= mq[4][2] * y[42]; a1 -= mq[4][3] * x[43]; b1 -= mq[4][3] * y[43]; mq[4] = *(const LAS f32x4*)(Mg + 3152);
            a0 -= mq[5][0] * x[44]; b0 -= mq[5][0] * y[44]; a1 -= mq[5][1] * x[45]; b1 -= mq[5][1] * y[45]; a0 -= mq[5][2] * x[46]; b0 -= mq[5][2] * y[46]; a1 -= mq[5][3] * x[47]; b1 -= mq[5][3] * y[47]; x[48] = a0 + a1; y[48] = b0 + b1; up[6144] = x[48]; wp[6144] = f2bf(-y[48]); mq[5] = *(const LAS f32x4*)(Mg + 3156);
            { const float br = betg[49]; a0 = bf2f(*(const LAS bf16_t*)(lg + P5_VS + 13328 + c * 2)) * br; b0 = bf2f(*(const LAS bf16_t*)(lg + P5_KS + 13328 + c * 2)) * br * __expf(decg[49]); a1 = 0.f; b1 = 0.f; } a0 -= mq[0][0] * x[0]; b0 -= mq[0][0] * y[0]; a1 -= mq[0][1] * x[1]; b1 -= mq[0][1] * y[1]; a0 -= mq[0][2] * x[2]; b0 -= mq[0][2] * y[2]; a1 -= mq[0][3] * x[3]; b1 -= mq[0][3] * y[3]; mq[0] = *(const LAS f32x4*)(Mg + 3160);
            a0 -= mq[1][0] * x[4]; b0 -= mq[1][0] * y[4]; a1 -= mq[1][1] * x[5]; b1 -= mq[1][1] * y[5]; a0 -= mq[1][2] * x[6]; b0 -= mq[1][2] * y[6]; a1 -= mq[1][3] * x[7]; b1 -= mq[1][3] * y[7]; mq[1] = *(const LAS f32x4*)(Mg + 3164);
            a0 -= mq[2][0] * x[8]; b0 -= mq[2][0] * y[8]; a1 -= mq[2][1] * x[9]; b1 -= mq[2][1] * y[9]; a0 -= mq[2][2] * x[10]; b0 -= mq[2][2] * y[10]; a1 -= mq[2][3] * x[11]; b1 -= mq[2][3] * y[11]; mq[2] = *(const LAS f32x4*)(Mg + 3168);
            a0 -= mq[3][0] * x[12]; b0 -= mq[3][0] * y[12]; a1 -= mq[3][1] * x[13]; b1 -= mq[3][1] * y[13]; a0 -= mq[3][2] * x[14]; b0 -= mq[3][2] * y[14]; a1 -= mq[3][3] * x[15]; b1 -= mq[3][3] * y[15]; mq[3] = *(const LAS f32x4*)(Mg + 3172);
            a0 -= mq[4][0] * x[16]; b0 -= mq[4][0] * y[16]; a1 -= mq[4][1] * x[17]; b1 -= mq[4][1] * y[17]; a0 -= mq[4][2] * x[18]; b0 -= mq[4][2] * y[18]; a1 -= mq[4][3] * x[19]; b1 -= mq[4][3] * y[19]; mq[4] = *(const LAS f32x4*)(Mg + 3176);
            a0 -= mq[5][0] * x[20]; b0 -= mq[5][0] * y[20]; a1 -= mq[5][1] * x[21]; b1 -= mq[5][1] * y[21]; a0 -= mq[5][2] * x[22]; b0 -= mq[5][2] * y[22]; a1 -= mq[5][3] * x[23]; b1 -= mq[5][3] * y[23]; mq[5] = *(const LAS f32x4*)(Mg + 3180);
            a0 -= mq[0][0] * x[24]; b0 -= mq[0][0] * y[24]; a1 -= mq[0][1] * x[25]; b1 -= mq[0][1] * y[25]; a0 -= mq[0][2] * x[26]; b0 -= mq[0][2] * y[26]; a1 -= mq[0][3] * x[27]; b1 -= mq[0][3] * y[27]; mq[0] = *(const LAS f32x4*)(Mg + 3184);
            a0 -= mq[1][0] * x[28]; b0 -= mq[1][0] * y[28]; a1 -= mq[1][1] * x[29]; b1 -= mq[1][1] * y[29]; a0 -= mq[1][2] * x[30]; b0 -= mq[1][2] * y[30]; a1 -= mq[1][3] * x[31]; b1 -= mq[1][3] * y[31]; mq[1] = *(const LAS f32x4*)(Mg + 3200);
            a0 -= mq[2][0] * x[32]; b0 -= mq[2][0] * y[32]; a1 -= mq[2][1] * x[33]; b1 -= mq[2][1] * y[33]; a0 -= mq[2][2] * x[34]; b0 -= mq[2][2] * y[34]; a1 -= mq[2][3] * x[35]; b1 -= mq[2][3] * y[35]; mq[2] = *(const LAS f32x4*)(Mg + 3204);
            a0 -= mq[3][0] * x[36]; b0 -= mq[3][0] * y[36]; a1 -= mq[3][1] * x[37]; b1 -= mq[3][1] * y[37]; a0 -= mq[3][2] * x[38]; b0 -= mq[3][2] * y[38]; a1 -= mq[3][3] * x[39]; b1 -= mq[3][3] * y[39]; mq[3] = *(const LAS f32x4*)(Mg + 3208);
            a0 -= mq[4][0] * x[40]; b0 -= mq[4][0] * y[40]; a1 -= mq[4][1] * x[41]; b1 -= mq[4][1] * y[41]; a0 -= mq[4][2] * x[42]; b0 -= mq[4][2] * y[42]; a1 -= mq[4][3] * x[43]; b1 -= mq[4][3] * y[43]; mq[4] = *(const LAS f32x4*)(Mg + 3212);
            a0 -= mq[5][0] * x[44]; b0 -= mq[5][0] * y[44]; a1 -= mq[5][1] * x[45]; b1 -= mq[5][1] * y[45]; a0 -= mq[5][2] * x[46]; b0 -= mq[5][2] * y[46]; a1 -= mq[5][3] * x[47]; b1 -= mq[5][3] * y[47]; mq[5] = *(const LAS f32x4*)(Mg + 3216);
            a0 -= mq[0][0] * x[48]; b0 -= mq[0][0] * y[48]; x[49] = a0 + a1; y[49] = b0 + b1; up[6272] = x[49]; wp[6272] = f2bf(-y[49]); mq[0] = *(const LAS f32x4*)(Mg + 3220);
            { const float br = betg[50]; a0 = bf2f(*(const LAS bf16_t*)(lg + P5_VS + 13600 + c * 2)) * br; b0 = bf2f(*(const LAS bf16_t*)(lg + P5_KS + 13600 + c * 2)) * br * __expf(decg[50]); a1 = 0.f; b1 = 0.f; } a0 -= mq[1][0] * x[0]; b0 -= mq[1][0] * y[0]; a1 -= mq[1][1] * x[1]; b1 -= mq[1][1] * y[1]; a0 -= mq[1][2] * x[2]; b0 -= mq[1][2] * y[2]; a1 -= mq[1][3] * x[3]; b1 -= mq[1][3] * y[3]; mq[1] = *(const LAS f32x4*)(Mg + 3224);
            a0 -= mq[2][0] * x[4]; b0 -= mq[2][0] * y[4]; a1 -= mq[2][1] * x[5]; b1 -= mq[2][1] * y[5]; a0 -= mq[2][2] * x[6]; b0 -= mq[2][2] * y[6]; a1 -= mq[2][3] * x[7]; b1 -= mq[2][3] * y[7]; mq[2] = *(const LAS f32x4*)(Mg + 3228);
            a0 -= mq[3][0] * x[8]; b0 -= mq[3][0] * y[8]; a1 -= mq[3][1] * x[9]; b1 -= mq[3][1] * y[9]; a0 -= mq[3][2] * x[10]; b0 -= mq[3][2] * y[10]; a1 -= mq[3][3] * x[11]; b1 -= mq[3][3] * y[11]; mq[3] = *(const LAS f32x4*)(Mg + 3232);
            a0 -= mq[4][0] * x[12]; b0 -= mq[4][0] * y[12]; a1 -= mq[4][1] * x[13]; b1 -= mq[4][1] * y[13]; a0 -= mq[4][2] * x[14]; b0 -= mq[4][2] * y[14]; a1 -= mq[4][3] * x[15]; b1 -= mq[4][3] * y[15]; mq[4] = *(const LAS f32x4*)(Mg + 3236);
            a0 -= mq[5][0] * x[16]; b0 -= mq[5][0] * y[16]; a1 -= mq[5][1] * x[17]; b1 -= mq[5][1] * y[17]; a0 -= mq[5][2] * x[18]; b0 -= mq[5][2] * y[18]; a1 -= mq[5][3] * x[19]; b1 -= mq[5][3] * y[19]; mq[5] = *(const LAS f32x4*)(Mg + 3240);
            a0 -= mq[0][0] * x[20]; b0 -= mq[0][0] * y[20]; a1 -= mq[0][1] * x[21]; b1 -= mq[0][1] * y[21]; a0 -= mq[0][2] * x[22]; b0 -= mq[0][2] * y[22]; a1 -= mq[0][3] * x[23]; b1 -= mq[0][3] * y[23]; mq[0] = *(const LAS f32x4*)(Mg + 3244);
            a0 -= mq[1][0] * x[24]; b0 -= mq[1][0] * y[24]; a1 -= mq[1][1] * x[25]; b1 -= mq[1][1] * y[25]; a0 -= mq[1][2] * x[26]; b0 -= mq[1][2] * y[26]; a1 -= mq[1][3] * x[27]; b1 -= mq[1][3] * y[27]; mq[1] = *(const LAS f32x4*)(Mg + 3248);
            a0 -= mq[2][0] * x[28]; b0 -= mq[2][0] * y[28]; a1 -= mq[2][1] * x[29]; b1 -= mq[2][1] * y[29]; a0 -= mq[2][2] * x[30]; b0 -= mq[2][2] * y[30]; a1 -= mq[2][3] * x[31]; b1 -= mq[2][3] * y[31]; mq[2] = *(const LAS f32x4*)(Mg + 3264);
            a0 -= mq[3][0] * x[32]; b0 -= mq[3][0] * y[32]; a1 -= mq[3][1] * x[33]; b1 -= mq[3][1] * y[33]; a0 -= mq[3][2] * x[34]; b0 -= mq[3][2] * y[34]; a1 -= mq[3][3] * x[35]; b1 -= mq[3][3] * y[35]; mq[3] = *(const LAS f32x4*)(Mg + 3268);
            a0 -= mq[4][0] * x[36]; b0 -= mq[4][0] * y[36]; a1 -= mq[4][1] * x[37]; b1 -= mq[4][1] * y[37]; a0 -= mq[4][2] * x[38]; b0 -= mq[4][2] * y[38]; a1 -= mq[4][3] * x[39]; b1 -= mq[4][3] * y[39]; mq[4] = *(const LAS f32x4*)(Mg + 3272);
            a0 -= mq[5][0] * x[40]; b0 -= mq[5][0] * y[40]; a1 -= mq[5][1] * x[41]; b1 -= mq[5][1] * y[41]; a0 -= mq[5][2] * x[42]; b0 -= mq[5][2] * y[42]; a1 -= mq[5][3] * x[43]; b1 -= mq[5][3] * y[43]; mq[5] = *(const LAS f32x4*)(Mg + 3276);
            a0 -= mq[0][0] * x[44]; b0 -= mq[0][0] * y[44]; a1 -= mq[0][1] * x[45]; b1 -= mq[0][1] * y[45]; a0 -= mq[0][2] * x[46]; b0 -= mq[0][2] * y[46]; a1 -= mq[0][3] * x[47]; b1 -= mq[0][3] * y[47]; mq[0] = *(const LAS f32x4*)(Mg + 3280);
            a0 -= mq[1][0] * x[48]; b0 -= mq[1][0] * y[48]; a1 -= mq[1][1] * x[49]; b1 -= mq[1][1] * y[49]; x[50] = a0 + a1; y[50] = b0 + b1; up[6400] = x[50]; wp[6400] = f2bf(-y[50]); mq[1] = *(const LAS f32x4*)(Mg + 3284);
            { const float br = betg[51]; a0 = bf2f(*(const LAS bf16_t*)(lg + P5_VS + 13872 + c * 2)) * br; b0 = bf2f(*(const LAS bf16_t*)(lg + P5_KS + 13872 + c * 2)) * br * __expf(decg[51]); a1 = 0.f; b1 = 0.f; } a0 -= mq[2][0] * x[0]; b0 -= mq[2][0] * y[0]; a1 -= mq[2][1] * x[1]; b1 -= mq[2][1] * y[1]; a0 -= mq[2][2] * x[2]; b0 -= mq[2][2] * y[2]; a1 -= mq[2][3] * x[3]; b1 -= mq[2][3] * y[3]; mq[2] = *(const LAS f32x4*)(Mg + 3288);
            a0 -= mq[3][0] * x[4]; b0 -= mq[3][0] * y[4]; a1 -= mq[3][1] * x[5]; b1 -= mq[3][1] * y[5]; a0 -= mq[3][2] * x[6]; b0 -= mq[3][2] * y[6]; a1 -= mq[3][3] * x[7]; b1 -= mq[3][3] * y[7]; mq[3] = *(const LAS f32x4*)(Mg + 3292);
            a0 -= mq[4][0] * x[8]; b0 -= mq[4][0] * y[8]; a1 -= mq[4][1] * x[9]; b1 -= mq[4][1] * y[9]; a0 -= mq[4][2] * x[10]; b0 -= mq[4][2] * y[10]; a1 -= mq[4][3] * x[11]; b1 -= mq[4][3] * y[11]; mq[4] = *(const LAS f32x4*)(Mg + 3296);
            a0 -= mq[5][0] * x[12]; b0 -= mq[5][0] * y[12]; a1 -= mq[5][1] * x[13]; b1 -= mq[5][1] * y[13]; a0 -= mq[5][2] * x[14]; b0 -= mq[5][2] * y[14]; a1 -= mq[5][3] * x[15]; b1 -= mq[5][3] * y[15]; mq[5] = *(const LAS f32x4*)(Mg + 3300);
            a0 -= mq[0][0] * x[16]; b0 -= mq[0][0] * y[16]; a1 -= mq[0][1] * x[17]; b1 -= mq[0][1] * y[17]; a0 -= mq[0][2] * x[18]; b0 -= mq[0][2] * y[18]; a1 -= mq[0][3] * x[19]; b1 -= mq[0][3] * y[19]; mq[0] = *(const LAS f32x4*)(Mg + 3304);
            a0 -= mq[1][0] * x[20]; b0 -= mq[1][0] * y[20]; a1 -= mq[1][1] * x[21]; b1 -= mq[1][1] * y[21]; a0 -= mq[1][2] * x[22]; b0 -= mq[1][2] * y[22]; a1 -= mq[1][3] * x[23]; b1 -= mq[1][3] * y[23]; mq[1] = *(const LAS f32x4*)(Mg + 3308);
            a0 -= mq[2][0] * x[24]; b0 -= mq[2][0] * y[24]; a1 -= mq[2][1] * x[25]; b1 -= mq[2][1] * y[25]; a0 -= mq[2][2] * x[26]; b0 -= mq[2][2] * y[26]; a1 -= mq[2][3] * x[27]; b1 -= mq[2][3] * y[27]; mq[2] = *(const LAS f32x4*)(Mg + 3312);
            a0 -= mq[3][0] * x[28]; b0 -= mq[3][0] * y[28]; a1 -= mq[3][1] * x[29]; b1 -= mq[3][1] * y[29]; a0 -= mq[3][2] * x[30]; b0 -= mq[3][2] * y[30]; a1 -= mq[3][3] * x[31]; b1 -= mq[3][3] * y[31]; mq[3] = *(const LAS f32x4*)(Mg + 3328);
            a0 -= mq[4][0] * x[32]; b0 -= mq[4][0] * y[32]; a1 -= mq[4][1] * x[33]; b1 -= mq[4][1] * y[33]; a0 -= mq[4][2] * x[34]; b0 -= mq[4][2] * y[34]; a1 -= mq[4][3] * x[35]; b1 -= mq[4][3] * y[35]; mq[4] = *(const LAS f32x4*)(Mg + 3332);
            a0 -= mq[5][0] * x[36]; b0 -= mq[5][0] * y[36]; a1 -= mq[5][1] * x[37]; b1 -= mq[5][1] * y[37]; a0 -= mq[5][2] * x[38]; b0 -= mq[5][2] * y[38]; a1 -= mq[5][3] * x[39]; b1 -= mq[5][3] * y[39]; mq[5] = *(const LAS f32x4*)(Mg + 3336);
            a0 -= mq[0][0] * x[40]; b0 -= mq[0][0] * y[40]; a1 -= mq[0][1] * x[41]; b1 -= mq[0][1] * y[41]; a0 -= mq[0][2] * x[42]; b0 -= mq[0][2] * y[42]; a1 -= mq[0][3] * x[43]; b1 -= mq[0][3] * y[43]; mq[0] = *(const LAS f32x4*)(Mg + 3340);
            a0 -= mq[1][0] * x[44]; b0 -= mq[1][0] * y[44]; a1 -= mq[1][1] * x[45]; b1 -= mq[1][1] * y[45]; a0 -= mq[1][2] * x[46]; b0 -= mq[1][2] * y[46]; a1 -= mq[1][3] * x[47]; b1 -= mq[1][3] * y[47]; mq[1] = *(const LAS f32x4*)(Mg + 3344);
            a0 -= mq[2][0] * x[48]; b0 -= mq[2][0] * y[48]; a1 -= mq[2][1] * x[49]; b1 -= mq[2][1] * y[49]; a0 -= mq[2][2] * x[50]; b0 -= mq[2][2] * y[50]; x[51] = a0 + a1; y[51] = b0 + b1; up[6528] = x[51]; wp[6528] = f2bf(-y[51]); mq[2] = *(const LAS f32x4*)(Mg + 3348);
            { const float br = betg[52]; a0 = bf2f(*(const LAS bf16_t*)(lg + P5_VS + 14144 + c * 2)) * br; b0 = bf2f(*(const LAS bf16_t*)(lg + P5_KS + 14144 + c * 2)) * br * __expf(decg[52]); a1 = 0.f; b1 = 0.f; } a0 -= mq[3][0] * x[0]; b0 -= mq[3][0] * y[0]; a1 -= mq[3][1] * x[1]; b1 -= mq[3][1] * y[1]; a0 -= mq[3][2] * x[2]; b0 -= mq[3][2] * y[2]; a1 -= mq[3][3] * x[3]; b1 -= mq[3][3] * y[3]; mq[3] = *(const LAS f32x4*)(Mg + 3352);
            a0 -= mq[4][0] * x[4]; b0 -= mq[4][0] * y[4]; a1 -= mq[4][1] * x[5]; b1 -= mq[4][1] * y[5]; a0 -= mq[4][2] * x[6]; b0 -= mq[4][2] * y[6]; a1 -= mq[4][3] * x[7]; b1 -= mq[4][3] * y[7]; mq[4] = *(const LAS f32x4*)(Mg + 3356);
            a0 -= mq[5][0] * x[8]; b0 -= mq[5][0] * y[8]; a1 -= mq[5][1] * x[9]; b1 -= mq[5][1] * y[9]; a0 -= mq[5][2] * x[10]; b0 -= mq[5][2] * y[10]; a1 -= mq[5][3] * x[11]; b1 -= mq[5][3] * y[11]; mq[5] = *(const LAS f32x4*)(Mg + 3360);
            a0 -= mq[0][0] * x[12]; b0 -= mq[0][0] * y[12]; a1 -= mq[0][1] * x[13]; b1 -= mq[0][1] * y[13]; a0 -= mq[0][2] * x[14]; b0 -= mq[0][2] * y[14]; a1 -= mq[0][3] * x[15]; b1 -= mq[0][3] * y[15]; mq[0] = *(const LAS f32x4*)(Mg + 3364);
            a0 -= mq[1][0] * x[16]; b0 -= mq[1][0] * y[16]; a1 -= mq[1][1] * x[17]; b1 -= mq[1][1] * y[17]; a0 -= mq[1][2] * x[18]; b0 -= mq[1][2] * y[18]; a1 -= mq[1][3] * x[19]; b1 -= mq[1][3] * y[19]; mq[1] = *(const LAS f32x4*)(Mg + 3368);
            a0 -= mq[2][0] * x[20]; b0 -= mq[2][0] * y[20]; a1 -= mq[2][1] * x[21]; b1 -= mq[2][1] * y[21]; a0 -= mq[2][2] * x[22]; b0 -= mq[2][2] * y[22]; a1 -= mq[2][3] * x[23]; b1 -= mq[2][3] * y[23]; mq[2] = *(const LAS f32x4*)(Mg + 3372);
            a0 -= mq[3][0] * x[24]; b0 -= mq[3][0] * y[24]; a1 -= mq[3][1] * x[25]; b1 -= mq[3][1] * y[25]; a0 -= mq[3][2] * x[26]; b0 -= mq[3][2] * y[26]; a1 -= mq[3][3] * x[27]; b1 -= mq[3][3] * y[27]; mq[3] = *(const LAS f32x4*)(Mg + 3376);
            a0 -= mq[4][0] * x[28]; b0 -= mq[4][0] * y[28]; a1 -= mq[4][1] * x[29]; b1 -= mq[4][1] * y[29]; a0 -= mq[4][2] * x[30]; b0 -= mq[4][2] * y[30]; a1 -= mq[4][3] * x[31]; b1 -= mq[4][3] * y[31]; mq[4] = *(const LAS f32x4*)(Mg + 3392);
            a0 -= mq[5][0] * x[32]; b0 -= mq[5][0] * y[32]; a1 -= mq[5][1] * x[33]; b1 -= mq[5][1] * y[33]; a0 -= mq[5][2] * x[34]; b0 -= mq[5][2] * y[34]; a1 -= mq[5][3] * x[35]; b1 -= mq[5][3] * y[35]; mq[5] = *(const LAS f32x4*)(Mg + 3396);
            a0 -= mq[0][0] * x[36]; b0 -= mq[0][0] * y[36]; a1 -= mq[0][1] * x[37]; b1 -= mq[0][1] * y[37]; a0 -= mq[0][2] * x[38]; b0 -= mq[0][2] * y[38]; a1 -= mq[0][3] * x[39]; b1 -= mq[0][3] * y[39]; mq[0] = *(const LAS f32x4*)(Mg + 3400);
            a0 -= mq[1][0] * x[40]; b0 -= mq[1][0] * y[40]; a1 -= mq[1][1] * x[41]; b1 -= mq[1][1] * y[41]; a0 -= mq[1][2] * x[42]; b0 -= mq[1][2] * y[42]; a1 -= mq[1][3] * x[43]; b1 -= mq[1][3] * y[43]; mq[1] = *(const LAS f32x4*)(Mg + 3404);
            a0 -= mq[2][0] * x[44]; b0 -= mq[2][0] * y[44]; a1 -= mq[2][1] * x[45]; b1 -= mq[2][1] * y[45]; a0 -= mq[2][2] * x[46]; b0 -= mq[2][2] * y[46]; a1 -= mq[2][3] * x[47]; b1 -= mq[2][3] * y[47]; mq[2] = *(const LAS f32x4*)(Mg + 3408);
            a0 -= mq[3][0] * x[48]; b0 -= mq[3][0] * y[48]; a1 -= mq[3][1] * x[49]; b1 -= mq[3][1] * y[49]; a0 -= mq[3][2] * x[50]; b0 -= mq[3][2] * y[50]; a1 -= mq[3][3] * x[51]; b1 -= mq[3][3] * y[51]; x[52] = a0 + a1; y[52] = b0 + b1; up[6656] = x[52]; wp[6656] = f2bf(-y[52]); mq[3] = *(const LAS f32x4*)(Mg + 3412);
            { const float br = betg[53]; a0 = bf2f(*(const LAS bf16_t*)(lg + P5_VS + 14416 + c * 2)) * br; b0 = bf2f(*(const LAS bf16_t*)(lg + P5_KS + 14416 + c * 2)) * br * __expf(decg[53]); a1 = 0.f; b1 = 0.f; } a0 -= mq[4][0] * x[0]; b0 -= mq[4][0] * y[0]; a1 -= mq[4][1] * x[1]; b1 -= mq[4][1] * y[1]; a0 -= mq[4][2] * x[2]; b0 -= mq[4][2] * y[2]; a1 -= mq[4][3] * x[3]; b1 -= mq[4][3] * y[3]; mq[4] = *(const LAS f32x4*)(Mg + 3416);
            a0 -= mq[5][0] * x[4]; b0 -= mq[5][0] * y[4]; a1 -= mq[5][1] * x[5]; b1 -= mq[5][1] * y[5]; a0 -= mq[5][2] * x[6]; b0 -= mq[5][2] * y[6]; a1 -= mq[5][3] * x[7]; b1 -= mq[5][3] * y[7]; mq[5] = *(const LAS f32x4*)(Mg + 3420);
            a0 -= mq[0][0] * x[8]; b0 -= mq[0][0] * y[8]; a1 -= mq[0][1] * x[9]; b1 -= mq[0][1] * y[9]; a0 -= mq[0][2] * x[10]; b0 -= mq[0][2] * y[10]; a1 -= mq[0][3] * x[11]; b1 -= mq[0][3] * y[11]; mq[0] = *(const LAS f32x4*)(Mg + 3424);
            a0 -= mq[1][0] * x[12]; b0 -= mq[1][0] * y[12]; a1 -= mq[1][1] * x[13]; b1 -= mq[1][1] * y[13]; a0 -= mq[1][2] * x[14]; b0 -= mq[1][2] * y[14]; a1 -= mq[1][3] * x[15]; b1 -= mq[1][3] * y[15]; mq[1] = *(const LAS f32x4*)(Mg + 3428);
            a0 -= mq[2][0] * x[16]; b0 -= mq[2][0] * y[16]; a1 -= mq[2][1] * x[17]; b1 -= mq[2][1] * y[17]; a0 -= mq[2][2] * x[18]; b0 -= mq[2][2] * y[18]; a1 -= mq[2][3] * x[19]; b1 -= mq[2][3] * y[19]; mq[2] = *(const LAS f32x4*)(Mg + 3432);
            a0 -= mq[3][0] * x[20]; b0 -= mq[3][0] * y[20]; a1 -= mq[3][1] * x[21]; b1 -= mq[3][1] * y[21]; a0 -= mq[3][2] * x[22]; b0 -= mq[3][2] * y[22]; a1 -= mq[3][3] * x[23]; b1 -= mq[3][3] * y[23]; mq[3] = *(const LAS f32x4*)(Mg + 3436);
            a0 -= mq[4][0] * x[24]; b0 -= mq[4][0] * y[24]; a1 -= mq[4][1] * x[25]; b1 -= mq[4][1] * y[25]; a0 -= mq[4][2] * x[26]; b0 -= mq[4][2] * y[26]; a1 -= mq[4][3] * x[27]; b1 -= mq[4][3] * y[27]; mq[4] = *(const LAS f32x4*)(Mg + 3440);
            a0 -= mq[5][0] * x[28]; b0 -= mq[5][0] * y[28]; a1 -= mq[5][1] * x[29]; b1 -= mq[5][1] * y[29]; a0 -= mq[5][2] * x[30]; b0 -= mq[5][2] * y[30]; a1 -= mq[5][3] * x[31]; b1 -= mq[5][3] * y[31]; mq[5] = *(const LAS f32x4*)(Mg + 3444);
            a0 -= mq[0][0] * x[32]; b0 -= mq[0][0] * y[32]; a1 -= mq[0][1] * x[33]; b1 -= mq[0][1] * y[33]; a0 -= mq[0][2] * x[34]; b0 -= mq[0][2] * y[34]; a1 -= mq[0][3] * x[35]; b1 -= mq[0][3] * y[35]; mq[0] = *(const LAS f32x4*)(Mg + 3456);
            a0 -= mq[1][0] * x[36]; b0 -= mq[1][0] * y[36]; a1 -= mq[1][1] * x[37]; b1 -= mq[1][1] * y[37]; a0 -= mq[1][2] * x[38]; b0 -= mq[1][2] * y[38]; a1 -= mq[1][3] * x[39]; b1 -= mq[1][3] * y[39]; mq[1] = *(const LAS f32x4*)(Mg + 3460);
            a0 -= mq[2][0] * x[40]; b0 -= mq[2][0] * y[40]; a1 -= mq[2][1] * x[41]; b1 -= mq[2][1] * y[41]; a0 -= mq[2][2] * x[42]; b0 -= mq[2][2] * y[42]; a1 -= mq[2][3] * x[43]; b1 -= mq[2][3] * y[43]; mq[2] = *(const LAS f32x4*)(Mg + 3464);
            a0 -= mq[3][0] * x[44]; b0 -= mq[3][0] * y[44]; a1 -= mq[3][1] * x[45]; b1 -= mq[3][1] * y[45]; a0 -= mq[3][2] * x[46]; b0 -= mq[3][2] * y[46]; a1 -= mq[3][3] * x[47]; b1 -= mq[3][3] * y[47]; mq[3] = *(const LAS f32x4*)(Mg + 3468);
            a0 -= mq[4][0] * x[48]; b0 -= mq[4][0] * y[48]; a1 -= mq[4][1] * x[49]; b1 -= mq[4][1] * y[49]; a0 -= mq[4][2] * x[50]; b0 -= mq[4][2] * y[50]; a1 -= mq[4][3] * x[51]; b1 -= mq[4][3] * y[51]; mq[4] = *(const LAS f32x4*)(Mg + 3472);
            a0 -= mq[5][0] * x[52]; b0 -= mq[5][0] * y[52]; x[53] = a0 + a1; y[53] = b0 + b1; up[6784] = x[53]; wp[6784] = f2bf(-y[53]); mq[5] = *(const LAS f32x4*)(Mg + 3476);
            { const float br = betg[54]; a0 = bf2f(*(const LAS bf16_t*)(lg + P5_VS + 14688 + c * 2)) * br; b0 = bf2f(*(const LAS bf16_t*)(lg + P5_KS + 14688 + c * 2)) * br * __expf(decg[54]); a1 = 0.f; b1 = 0.f; } a0 -= mq[0][0] * x[0]; b0 -= mq[0][0] * y[0]; a1 -= mq[0][1] * x[1]; b1 -= mq[0][1] * y[1]; a0 -= mq[0][2] * x[2]; b0 -= mq[0][2] * y[2]; a1 -= mq[0][3] * x[3]; b1 -= mq[0][3] * y[3]; mq[0] = *(const LAS f32x4*)(Mg + 3480);
            a0 -= mq[1][0] * x[4]; b0 -= mq[1][0] * y[4]; a1 -= mq[1][1] * x[5]; b1 -= mq[1][1] * y[5]; a0 -= mq[1][2] * x[6]; b0 -= mq[1][2] * y[6]; a1 -= mq[1][3] * x[7]; b1 -= mq[1][3] * y[7]; mq[1] = *(const LAS f32x4*)(Mg + 3484);
            a0 -= mq[2][0] * x[8]; b0 -= mq[2][0] * y[8]; a1 -= mq[2][1] * x[9]; b1 -= mq[2][1] * y[9]; a0 -= mq[2][2] * x[10]; b0 -= mq[2][2] * y[10]; a1 -= mq[2][3] * x[11]; b1 -= mq[2][3] * y[11]; mq[2] = *(const LAS f32x4*)(Mg + 3488);
            a0 -= mq[3][0] * x[12]; b0 -= mq[3][0] * y[12]; a1 -= mq[3][1] * x[13]; b1 -= mq[3][1] * y[13]; a0 -= mq[3][2] * x[14]; b0 -= mq[3][2] * y[14]; a1 -= mq[3][3] * x[15]; b1 -= mq[3][3] * y[15]; mq[3] = *(const LAS f32x4*)(Mg + 3492);
            a0 -= mq[4][0] * x[16]; b0 -= mq[4][0] * y[16]; a1 -= mq[4][1] * x[17]; b1 -= mq[4][1] * y[17]; a0 -= mq[4][2] * x[18]; b0 -= mq[4][2] * y[18]; a1 -= mq[4][3] * x[19]; b1 -= mq[4][3] * y[19]; mq[4] = *(const LAS f32x4*)(Mg + 3496);
            a0 -= mq[5][0] * x[20]; b0 -= mq[5][0] * y[20]; a1 -= mq[5][1] * x[21]; b1 -= mq[5][1] * y[21]; a0 -= mq[5][2] * x[22]; b0 -= mq[5][2] * y[22]; a1 -= mq[5][3] * x[23]; b1 -= mq[5][3] * y[23]; mq[5] = *(const LAS f32x4*)(Mg + 3500);
            a0 -= mq[0][0] * x[24]; b0 -= mq[0][0] * y[24]; a1 -= mq[0][1] * x[25]; b1 -= mq[0][1] * y[25]; a0 -= mq[0][2] * x[26]; b0 -= mq[0][2] * y[26]; a1 -= mq[0][3] * x[27]; b1 -= mq[0][3] * y[27]; mq[0] = *(const LAS f32x4*)(Mg + 3504);
            a0 -= mq[1][0] * x[28]; b0 -= mq[1][0] * y[28]; a1 -= mq[1][1] * x[29]; b1 -= mq[1][1] * y[29]; a0 -= mq[1][2] * x[30]; b0 -= mq[1][2] * y[30]; a1 -= mq[1][3] * x[31]; b1 -= mq[1][3] * y[31]; mq[1] = *(const LAS f32x4*)(Mg + 3508);
            a0 -= mq[2][0] * x[32]; b0 -= mq[2][0] * y[32]; a1 -= mq[2][1] * x[33]; b1 -= mq[2][1] * y[33]; a0 -= mq[2][2] * x[34]; b0 -= mq[2][2] * y[34]; a1 -= mq[2][3] * x[35]; b1 -= mq[2][3] * y[35]; mq[2] = *(const LAS f32x4*)(Mg + 3520);
            a0 -= mq[3][0] * x[36]; b0 -= mq[3][0] * y[36]; a1 -= mq[3][1] * x[37]; b1 -= mq[3][1] * y[37]; a0 -= mq[3][2] * x[38]; b0 -= mq[3][2] * y[38]; a1 -= mq[3][3] * x[39]; b1 -= mq[3][3] * y[39]; mq[3] = *(const LAS f32x4*)(Mg + 3524);
            a0 -= mq[4][0] * x[40]; b0 -= mq[4][0] * y[40]; a1 -= mq[4][1] * x[41]; b1 -= mq[4][1] * y[41]; a0 -= mq[4][2] * x[42]; b0 -= mq[4][2] * y[42]; a1 -= mq[4][3] * x[43]; b1 -= mq[4][3] * y[43]; mq[4] = *(const LAS f32x4*)(Mg + 3528);
            a0 -= mq[5][0] * x[44]; b0 -= mq[5][0] * y[44]; a1 -= mq[5][1] * x[45]; b1 -= mq[5][1] * y[45]; a0 -= mq[5][2] * x[46]; b0 -= mq[5][2] * y[46]; a1 -= mq[5][3] * x[47]; b1 -= mq[5][3] * y[47]; mq[5] = *(const LAS f32x4*)(Mg + 3532);
            a0 -= mq[0][0] * x[48]; b0 -= mq[0][0] * y[48]; a1 -= mq[0][1] * x[49]; b1 -= mq[0][1] * y[49]; a0 -= mq[0][2] * x[50]; b0 -= mq[0][2] * y[50]; a1 -= mq[0][3] * x[51]; b1 -= mq[0][3] * y[51]; mq[0] = *(const LAS f32x4*)(Mg + 3536);
            a0 -= mq[1][0] * x[52]; b0 -= mq[1][0] * y[52]; a1 -= mq[1][1] * x[53]; b1 -= mq[1][1] * y[53]; x[54] = a0 + a1; y[54] = b0 + b1; up[6912] = x[54]; wp[6912] = f2bf(-y[54]); mq[1] = *(const LAS f32x4*)(Mg + 3540);
            { const float br = betg[55]; a0 = bf2f(*(const LAS bf16_t*)(lg + P5_VS + 14960 + c * 2)) * br; b0 = bf2f(*(const LAS bf16_t*)(lg + P5_KS + 14960 + c * 2)) * br * __expf(decg[55]); a1 = 0.f; b1 = 0.f; } a0 -= mq[2][0] * x[0]; b0 -= mq[2][0] * y[0]; a1 -= mq[2][1] * x[1]; b1 -= mq[2][1] * y[1]; a0 -= mq[2][2] * x[2]; b0 -= mq[2][2] * y[2]; a1 -= mq[2][3] * x[3]; b1 -= mq[2][3] * y[3]; mq[2] = *(const LAS f32x4*)(Mg + 3544);
            a0 -= mq[3][0] * x[4]; b0 -= mq[3][0] * y[4]; a1 -= mq[3][1] * x[5]; b1 -= mq[3][1] * y[5]; a0 -= mq[3][2] * x[6]; b0 -= mq[3][2] * y[6]; a1 -= mq[3][3] * x[7]; b1 -= mq[3][3] * y[7]; mq[3] = *(const LAS f32x4*)(Mg + 3548);
            a0 -= mq[4][0] * x[8]; b0 -= mq[4][0] * y[8]; a1 -= mq[4][1] * x[9]; b1 -= mq[4][1] * y[9]; a0 -= mq[4][2] * x[10]; b0 -= mq[4][2] * y[10]; a1 -= mq[4][3] * x[11]; b1 -= mq[4][3] * y[11]; mq[4] = *(const LAS f32x4*)(Mg + 3552);
            a0 -= mq[5][0] * x[12]; b0 -= mq[5][0] * y[12]; a1 -= mq[5][1] * x[13]; b1 -= mq[5][1] * y[13]; a0 -= mq[5][2] * x[14]; b0 -= mq[5][2] * y[14]; a1 -= mq[5][3] * x[15]; b1 -= mq[5][3] * y[15]; mq[5] = *(const LAS f32x4*)(Mg + 3556);
            a0 -= mq[0][0] * x[16]; b0 -= mq[0][0] * y[16]; a1 -= mq[0][1] * x[17]; b1 -= mq[0][1] * y[17]; a0 -= mq[0][2] * x[18]; b0 -= mq[0][2] * y[18]; a1 -= mq[0][3] * x[19]; b1 -= mq[0][3] * y[19]; mq[0] = *(const LAS f32x4*)(Mg + 3560);
            a0 -= mq[1][0] * x[20]; b0 -= mq[1][0] * y[20]; a1 -= mq[1][1] * x[21]; b1 -= mq[1][1] * y[21]; a0 -= mq[1][2] * x[22]; b0 -= mq[1][2] * y[22]; a1 -= mq[1][3] * x[23]; b1 -= mq[1][3] * y[23]; mq[1] = *(const LAS f32x4*)(Mg + 3564);
            a0 -= mq[2][0] * x[24]; b0 -= mq[2][0] * y[24]; a1 -= mq[2][1] * x[25]; b1 -= mq[2][1] * y[25]; a0 -= mq[2][2] * x[26]; b0 -= mq[2][2] * y[26]; a1 -= mq[2][3] * x[27]; b1 -= mq[2][3] * y[27]; mq[2] = *(const LAS f32x4*)(Mg + 3568);
            a0 -= mq[3][0] * x[28]; b0 -= mq[3][0] * y[28]; a1 -= mq[3][1] * x[29]; b1 -= mq[3][1] * y[29]; a0 -= mq[3][2] * x[30]; b0 -= mq[3][2] * y[30]; a1 -= mq[3][3] * x[31]; b1 -= mq[3][3] * y[31]; mq[3] = *(const LAS f32x4*)(Mg + 3572);
            a0 -= mq[4][0] * x[32]; b0 -= mq[4][0] * y[32]; a1 -= mq[4][1] * x[33]; b1 -= mq[4][1] * y[33]; a0 -= mq[4][2] * x[34]; b0 -= mq[4][2] * y[34]; a1 -= mq[4][3] * x[35]; b1 -= mq[4][3] * y[35]; mq[4] = *(const LAS f32x4*)(Mg + 3584);
            a0 -= mq[5][0] * x[36]; b0 -= mq[5][0] * y[36]; a1 -= mq[5][1] * x[37]; b1 -= mq[5][1] * y[37]; a0 -= mq[5][2] * x[38]; b0 -= mq[5][2] * y[38]; a1 -= mq[5][3] * x[39]; b1 -= mq[5][3] * y[39]; mq[5] = *(const LAS f32x4*)(Mg + 3588);
            a0 -= mq[0][0] * x[40]; b0 -= mq[0][0] * y[40]; a1 -= mq[0][1] * x[41]; b1 -= mq[0][1] * y[41]; a0 -= mq[0][2] * x[42]; b0 -= mq[0][2] * y[42]; a1 -= mq[0][3] * x[43]; b1 -= mq[0][3] * y[43]; mq[0] = *(const LAS f32x4*)(Mg + 3592);
            a0 -= mq[1][0] * x[44]; b0 -= mq[1][0] * y[44]; a1 -= mq[1][1] * x[45]; b1 -= mq[1][1] * y[45]; a0 -= mq[1][2] * x[46]; b0 -= mq[1][2] * y[46]; a1 -= mq[1][3] * x[47]; b1 -= mq[1][3] * y[47]; mq[1] = *(const LAS f32x4*)(Mg + 3596);
            a0 -= mq[2][0] * x[48]; b0 -= mq[2][0] * y[48]; a1 -= mq[2][1] * x[49]; b1 -= mq[2][1] * y[49]; a0 -= mq[2][2] * x[50]; b0 -= mq[2][2] * y[50]; a1 -= mq[2][3] * x[51]; b1 -= mq[2][3] * y[51]; mq[2] = *(const LAS f32x4*)(Mg + 3600);
            a0 -= mq[3][0] * x[52]; b0 -= mq[3][0] * y[52]; a1 -= mq[3][1] * x[53]; b1 -= mq[3][1] * y[53]; a0 -= mq[3][2] * x[54]; b0 -= mq[3][2] * y[54]; x[55] = a0 + a1; y[55] = b0 + b1; up[7040] = x[55]; wp[7040] = f2bf(-y[55]); mq[3] = *(const LAS f32x4*)(Mg + 3604);
            { const float br = betg[56]; a0 = bf2f(*(const LAS bf16_t*)(lg + P5_VS + 15232 + c * 2)) * br; b0 = bf2f(*(const LAS bf16_t*)(lg + P5_KS + 15232 + c * 2)) * br * __expf(decg[56]); a1 = 0.f; b1 = 0.f; } a0 -= mq[4][0] * x[0]; b0 -= mq[4][0] * y[0]; a1 -= mq[4][1] * x[1]; b1 -= mq[4][1] * y[1]; a0 -= mq[4][2] * x[2]; b0 -= mq[4][2] * y[2]; a1 -= mq[4][3] * x[3]; b1 -= mq[4][3] * y[3]; mq[4] = *(const LAS f32x4*)(Mg + 3608);
            a0 -= mq[5][0] * x[4]; b0 -= mq[5][0] * y[4]; a1 -= mq[5][1] * x[5]; b1 -= mq[5][1] * y[5]; a0 -= mq[5][2] * x[6]; b0 -= mq[5][2] * y[6]; a1 -= mq[5][3] * x[7]; b1 -= mq[5][3] * y[7]; mq[5] = *(const LAS f32x4*)(Mg + 3612);
            a0 -= mq[0][0] * x[8]; b0 -= mq[0][0] * y[8]; a1 -= mq[0][1] * x[9]; b1 -= mq[0][1] * y[9]; a0 -= mq[0][2] * x[10]; b0 -= mq[0][2] * y[10]; a1 -= mq[0][3] * x[11]; b1 -= mq[0][3] * y[11]; mq[0] = *(const LAS f32x4*)(Mg + 3616);
            a0 -= mq[1][0] * x[12]; b0 -= mq[1][0] * y[12]; a1 -= mq[1][1] * x[13]; b1 -= mq[1][1] * y[13]; a0 -= mq[1][2] * x[14]; b0 -= mq[1][2] * y[14]; a1 -= mq[1][3] * x[15]; b1 -= mq[1][3] * y[15]; mq[1] = *(const LAS f32x4*)(Mg + 3620);
            a0 -= mq[2][0] * x[16]; b0 -= mq[2][0] * y[16]; a1 -= mq[2][1] * x[17]; b1 -= mq[2][1] * y[17]; a0 -= mq[2][2] * x[18]; b0 -= mq[2][2] * y[18]; a1 -= mq[2][3] * x[19]; b1 -= mq[2][3] * y[19]; mq[2] = *(const LAS f32x4*)(Mg + 3624);
            a0 -= mq[3][0] * x[20]; b0 -= mq[3][0] * y[20]; a1 -= mq[3][1] * x[21]; b1 -= mq[3][1] * y[21]; a0 -= mq[3][2] * x[22]; b0 -= mq[3][2] * y[22]; a1 -= mq[3][3] * x[23]; b1 -= mq[3][3] * y[23]; mq[3] = *(const LAS f32x4*)(Mg + 3628);
            a0 -= mq[4][0] * x[24]; b0 -= mq[4][0] * y[24]; a1 -= mq[4][1] * x[25]; b1 -= mq[4][1] * y[25]; a0 -= mq[4][2] * x[26]; b0 -= mq[4][2] * y[26]; a1 -= mq[4][3] * x[27]; b1 -= mq[4][3] * y[27]; mq[4] = *(const LAS f32x4*)(Mg + 3632);
            a0 -= mq[5][0] * x[28]; b0 -= mq[5][0] * y[28]; a1 -= mq[5][1] * x[29]; b1 -= mq[5][1] * y[29]; a0 -= mq[5][2] * x[30]; b0 -= mq[5][2] * y[30]; a1 -= mq[5][3] * x[31]; b1 -= mq[5][3] * y[31]; mq[5] = *(const LAS f32x4*)(Mg + 3636);
            a0 -= mq[0][0] * x[32]; b0 -= mq[0][0] * y[32]; a1 -= mq[0][1] * x[33]; b1 -= mq[0][1] * y[33]; a0 -= mq[0][2] * x[34]; b0 -= mq[0][2] * y[34]; a1 -= mq[0][3] * x[35]; b1 -= mq[0][3] * y[35]; mq[0] = *(const LAS f32x4*)(Mg + 3648);
            a0 -= mq[1][0] * x[36]; b0 -= mq[1][0] * y[36]; a1 -= mq[1][1] * x[37]; b1 -= mq[1][1] * y[37]; a0 -= mq[1][2] * x[38]; b0 -= mq[1][2] * y[38]; a1 -= mq[1][3] * x[39]; b1 -= mq[1][3] * y[39]; mq[1] = *(const LAS f32x4*)(Mg + 3652);
            a0 -= mq[2][0] * x[40]; b0 -= mq[2][0] * y[40]; a1 -= mq[2][1] * x[41]; b1 -= mq[2][1] * y[41]; a0 -= mq[2][2] * x[42]; b0 -= mq[2][2] * y[42]; a1 -= mq[2][3] * x[43]; b1 -= mq[2][3] * y[43]; mq[2] = *(const LAS f32x4*)(Mg + 3656);
            a0 -= mq[3][0] * x[44]; b0 -= mq[3][0] * y[44]; a1 -= mq[3][1] * x[45]; b1 -= mq[3][1] * y[45]; a0 -= mq[3][2] * x[46]; b0 -= mq[3][2] * y[46]; a1 -= mq[3][3] * x[47]; b1 -= mq[3][3] * y[47]; mq[3] = *(const LAS f32x4*)(Mg + 3660);
            a0 -= mq[4][0] * x[48]; b0 -= mq[4][0] * y[48]; a1 -= mq[4][1] * x[49]; b1 -= mq[4][1] * y[49]; a0 -= mq[4][2] * x[50]; b0 -= mq[4][2] * y[50]; a1 -= mq[4][3] * x[51]; b1 -= mq[4][3] * y[51]; mq[4] = *(const LAS f32x4*)(Mg + 3664);
            a0 -= mq[5][0] * x[52]; b0 -= mq[5][0] * y[52]; a1 -= mq[5][1] * x[53]; b1 -= mq[5][1] * y[53]; a0 -= mq[5][2] * x[54]; b0 -= mq[5][2] * y[54]; a1 -= mq[5][3] * x[55]; b1 -= mq[5][3] * y[55]; x[56] = a0 + a1; y[56] = b0 + b1; up[7168] = x[56]; wp[7168] = f2bf(-y[56]); mq[5] = *(const LAS f32x4*)(Mg + 3668);
            { const float br = betg[57]; a0 = bf2f(*(const LAS bf16_t*)(lg + P5_VS + 15504 + c * 2)) * br; b0 = bf2f(*(const LAS bf16_t*)(lg + P5_KS + 15504 + c * 2)) * br * __expf(decg[57]); a1 = 0.f; b1 = 0.f; } a0 -= mq[0][0] * x[0]; b0 -= mq[0][0] * y[0]; a1 -= mq[0][1] * x[1]; b1 -= mq[0][1] * y[1]; a0 -= mq[0][2] * x[2]; b0 -= mq[0][2] * y[2]; a1 -= mq[0][3] * x[3]; b1 -= mq[0][3] * y[3]; mq[0] = *(const LAS f32x4*)(Mg + 3672);
            a0 -= mq[1][0] * x[4]; b0 -= mq[1][0] * y[4]; a1 -= mq[1][1] * x[5]; b1 -= mq[1][1] * y[5]; a0 -= mq[1][2] * x[6]; b0 -= mq[1][2] * y[6]; a1 -= mq[1][3] * x[7]; b1 -= mq[1][3] * y[7]; mq[1] = *(const LAS f32x4*)(Mg + 3676);
            a0 -= mq[2][0] * x[8]; b0 -= mq[2][0] * y[8]; a1 -= mq[2][1] * x[9]; b1 -= mq[2][1] * y[9]; a0 -= mq[2][2] * x[10]; b0 -= mq[2][2] * y[10]; a1 -= mq[2][3] * x[11]; b1 -= mq[2][3] * y[11]; mq[2] = *(const LAS f32x4*)(Mg + 3680);
            a0 -= mq[3][0] * x[12]; b0 -= mq[3][0] * y[12]; a1 -= mq[3][1] * x[13]; b1 -= mq[3][1] * y[13]; a0 -= mq[3][2] * x[14]; b0 -= mq[3][2] * y[14]; a1 -= mq[3][3] * x[15]; b1 -= mq[3][3] * y[15]; mq[3] = *(const LAS f32x4*)(Mg + 3684);
            a0 -= mq[4][0] * x[16]; b0 -= mq[4][0] * y[16]; a1 -= mq[4][1] * x[17]; b1 -= mq[4][1] * y[17]; a0 -= mq[4][2] * x[18]; b0 -= mq[4][2] * y[18]; a1 -= mq[4][3] * x[19]; b1 -= mq[4][3] * y[19]; mq[4] = *(const LAS f32x4*)(Mg + 3688);
            a0 -= mq[5][0] * x[20]; b0 -= mq[5][0] * y[20]; a1 -= mq[5][1] * x[21]; b1 -= mq[5][1] * y[21]; a0 -= mq[5][2] * x[22]; b0 -= mq[5][2] * y[22]; a1 -= mq[5][3] * x[23]; b1 -= mq[5][3] * y[23]; mq[5] = *(const LAS f32x4*)(Mg + 3692);
            a0 -= mq[0][0] * x[24]; b0 -= mq[0][0] * y[24]; a1 -= mq[0][1] * x[25]; b1 -= mq[0][1] * y[25]; a0 -= mq[0][2] * x[26]; b0 -= mq[0][2] * y[26]; a1 -= mq[0][3] * x[27]; b1 -= mq[0][3] * y[27]; mq[0] = *(const LAS f32x4*)(Mg + 3696);
            a0 -= mq[1][0] * x[28]; b0 -= mq[1][0] * y[28]; a1 -= mq[1][1] * x[29]; b1 -= mq[1][1] * y[29]; a0 -= mq[1][2] * x[30]; b0 -= mq[1][2] * y[30]; a1 -= mq[1][3] * x[31]; b1 -= mq[1][3] * y[31]; mq[1] = *(const LAS f32x4*)(Mg + 3700);
            a0 -= mq[2][0] * x[32]; b0 -= mq[2][0] * y[32]; a1 -= mq[2][1] * x[33]; b1 -= mq[2][1] * y[33]; a0 -= mq[2][2] * x[34]; b0 -= mq[2][2] * y[34]; a1 -= mq[2][3] * x[35]; b1 -= mq[2][3] * y[35]; mq[2] = *(const LAS f32x4*)(Mg + 3704);
            a0 -= mq[3][0] * x[36]; b0 -= mq[3][0] * y[36]; a1 -= mq[3][1] * x[37]; b1 -= mq[3][1] * y[37]; a0 -= mq[3][2] * x[38]; b0 -= mq[3][2] * y[38]; a1 -= mq[3][3] * x[39]; b1 -= mq[3][3] * y[39]; mq[3] = *(const LAS f32x4*)(Mg + 3712);
            a0 -= mq[4][0] * x[40]; b0 -= mq[4][0] * y[40]; a1 -= mq[4][1] * x[41]; b1 -= mq[4][1] * y[41]; a0 -= mq[4][2] * x[42]; b0 -= mq[4][2] * y[42]; a1 -= mq[4][3] * x[43]; b1 -= mq[4][3] * y[43]; mq[4] = *(const LAS f32x4*)(Mg + 3716);
            a0 -= mq[5][0] * x[44]; b0 -= mq[5][0] * y[44]; a1 -= mq[5][1] * x[45]; b1 -= mq[5][1] * y[45]; a0 -= mq[5][2] * x[46]; b0 -= mq[5][2] * y[46]; a1 -= mq[5][3] * x[47]; b1 -= mq[5][3] * y[47]; mq[5] = *(const LAS f32x4*)(Mg + 3720);
            a0 -= mq[0][0] * x[48]; b0 -= mq[0][0] * y[48]; a1 -= mq[0][1] * x[49]; b1 -= mq[0][1] * y[49]; a0 -= mq[0][2] * x[50]; b0 -= mq[0][2] * y[50]; a1 -= mq[0][3] * x[51]; b1 -= mq[0][3] * y[51]; mq[0] = *(const LAS f32x4*)(Mg + 3724);
            a0 -= mq[1][0] * x[52]; b0 -= mq[1][0] * y[52]; a1 -= mq[1][1] * x[53]; b1 -= mq[1][1] * y[53]; a0 -= mq[1][2] * x[54]; b0 -= mq[1][2] * y[54]; a1 -= mq[1][3] * x[55]; b1 -= mq[1][3] * y[55]; mq[1] = *(const LAS f32x4*)(Mg + 3728);
            a0 -= mq[2][0] * x[56]; b0 -= mq[2][0] * y[56]; x[57] = a0 + a1; y[57] = b0 + b1; up[7296] = x[57]; wp[7296] = f2bf(-y[57]); mq[2] = *(const LAS f32x4*)(Mg + 3732);
            { const float br = betg[58]; a0 = bf2f(*(const LAS bf16_t*)(lg + P5_VS + 15776 + c * 2)) * br; b0 = bf2f(*(const LAS bf16_t*)(lg + P5_KS + 15776 + c * 2)) * br * __expf(decg[58]); a1 = 0.f; b1 = 0.f; } a0 -= mq[3][0] * x[0]; b0 -= mq[3][0] * y[0]; a1 -= mq[3][1] * x[1]; b1 -= mq[3][1] * y[1]; a0 -= mq[3][2] * x[2]; b0 -= mq[3][2] * y[2]; a1 -= mq[3][3] * x[3]; b1 -= mq[3][3] * y[3]; mq[3] = *(const LAS f32x4*)(Mg + 3736);
            a0 -= mq[4][0] * x[4]; b0 -= mq[4][0] * y[4]; a1 -= mq[4][1] * x[5]; b1 -= mq[4][1] * y[5]; a0 -= mq[4][2] * x[6]; b0 -= mq[4][2] * y[6]; a1 -= mq[4][3] * x[7]; b1 -= mq[4][3] * y[7]; mq[4] = *(const LAS f32x4*)(Mg + 3740);
            a0 -= mq[5][0] * x[8]; b0 -= mq[5][0] * y[8]; a1 -= mq[5][1] * x[9]; b1 -= mq[5][1] * y[9]; a0 -= mq[5][2] * x[10]; b0 -= mq[5][2] * y[10]; a1 -= mq[5][3] * x[11]; b1 -= mq[5][3] * y[11]; mq[5] = *(const LAS f32x4*)(Mg + 3744);
            a0 -= mq[0][0] * x[12]; b0 -= mq[0][0] * y[12]; a1 -= mq[0][1] * x[13]; b1 -= mq[0][1] * y[13]; a0 -= mq[0][2] * x[14]; b0 -= mq[0][2] * y[14]; a1 -= mq[0][3] * x[15]; b1 -= mq[0][3] * y[15]; mq[0] = *(const LAS f32x4*)(Mg + 3748);
            a0 -= mq[1][0] * x[16]; b0 -= mq[1][0] * y[16]; a1 -= mq[1][1] * x[17]; b1 -= mq[1][1] * y[17]; a0 -= mq[1][2] * x[18]; b0 -= mq[1][2] * y[18]; a1 -= mq[1][3] * x[19]; b1 -= mq[1][3] * y[19]; mq[1] = *(const LAS f32x4*)(Mg + 3752);
            a0 -= mq[2][0] * x[20]; b0 -= mq[2][0] * y[20]; a1 -= mq[2][1] * x[21]; b1 -= mq[2][1] * y[21]; a0 -= mq[2][2] * x[22]; b0 -= mq[2][2] * y[22]; a1 -= mq[2][3] * x[23]; b1 -= mq[2][3] * y[23]; mq[2] = *(const LAS f32x4*)(Mg + 3756);
            a0 -= mq[3][0] * x[24]; b0 -= mq[3][0] * y[24]; a1 -= mq[3][1] * x[25]; b1 -= mq[3][1] * y[25]; a0 -= mq[3][2] * x[26]; b0 -= mq[3][2] * y[26]; a1 -= mq[3][3] * x[27]; b1 -= mq[3][3] * y[27]; mq[3] = *(const LAS f32x4*)(Mg + 3760);
            a0 -= mq[4][0] * x[28]; b0 -= mq[4][0] * y[28]; a1 -= mq[4][1] * x[29]; b1 -= mq[4][1] * y[29]; a0 -= mq[4][2] * x[30]; b0 -= mq[4][2] * y[30]; a1 -= mq[4][3] * x[31]; b1 -= mq[4][3] * y[31]; mq[4] = *(const LAS f32x4*)(Mg + 3764);
            a0 -= mq[5][0] * x[32]; b0 -= mq[5][0] * y[32]; a1 -= mq[5][1] * x[33]; b1 -= mq[5][1] * y[33]; a0 -= mq[5][2] * x[34]; b0 -= mq[5][2] * y[34]; a1 -= mq[5][3] * x[35]; b1 -= mq[5][3] * y[35]; mq[5] = *(const LAS f32x4*)(Mg + 3768);
            a0 -= mq[0][0] * x[36]; b0 -= mq[0][0] * y[36]; a1 -= mq[0][1] * x[37]; b1 -= mq[0][1] * y[37]; a0 -= mq[0][2] * x[38]; b0 -= mq[0][2] * y[38]; a1 -= mq[0][3] * x[39]; b1 -= mq[0][3] * y[39]; mq[0] = *(const LAS f32x4*)(Mg + 3776);
            a0 -= mq[1][0] * x[40]; b0 -= mq[1][0] * y[40]; a1 -= mq[1][1] * x[41]; b1 -= mq[1][1] * y[41]; a0 -= mq[1][2] * x[42]; b0 -= mq[1][2] * y[42]; a1 -= mq[1][3] * x[43]; b1 -= mq[1][3] * y[43]; mq[1] = *(const LAS f32x4*)(Mg + 3780);
            a0 -= mq[2][0] * x[44]; b0 -= mq[2][0] * y[44]; a1 -= mq[2][1] * x[45]; b1 -= mq[2][1] * y[45]; a0 -= mq[2][2] * x[46]; b0 -= mq[2][2] * y[46]; a1 -= mq[2][3] * x[47]; b1 -= mq[2][3] * y[47]; mq[2] = *(const LAS f32x4*)(Mg + 3784);
            a0 -= mq[3][0] * x[48]; b0 -= mq[3][0] * y[48]; a1 -= mq[3][1] * x[49]; b1 -= mq[3][1] * y[49]; a0 -= mq[3][2] * x[50]; b0 -= mq[3][2] * y[50]; a1 -= mq[3][3] * x[51]; b1 -= mq[3][3] * y[51]; mq[3] = *(const LAS f32x4*)(Mg + 3788);
            a0 -= mq[4][0] * x[52]; b0 -= mq[4][0] * y[52]; a1 -= mq[4][1] * x[53]; b1 -= mq[4][1] * y[53]; a0 -= mq[4][2] * x[54]; b0 -= mq[4][2] * y[54]; a1 -= mq[4][3] * x[55]; b1 -= mq[4][3] * y[55]; mq[4] = *(const LAS f32x4*)(Mg + 3792);
            a0 -= mq[5][0] * x[56]; b0 -= mq[5][0] * y[56]; a1 -= mq[5][1] * x[57]; b1 -= mq[5][1] * y[57]; x[58] = a0 + a1; y[58] = b0 + b1; up[7424] = x[58]; wp[7424] = f2bf(-y[58]); mq[5] = *(const LAS f32x4*)(Mg + 3796);
            { const float br = betg[59]; a0 = bf2f(*(const LAS bf16_t*)(lg + P5_VS + 16048 + c * 2)) * br; b0 = bf2f(*(const LAS bf16_t*)(lg + P5_KS + 16048 + c * 2)) * br * __expf(decg[59]); a1 = 0.f; b1 = 0.f; } a0 -= mq[0][0] * x[0]; b0 -= mq[0][0] * y[0]; a1 -= mq[0][1] * x[1]; b1 -= mq[0][1] * y[1]; a0 -= mq[0][2] * x[2]; b0 -= mq[0][2] * y[2]; a1 -= mq[0][3] * x[3]; b1 -= mq[0][3] * y[3]; mq[0] = *(const LAS f32x4*)(Mg + 3800);
            a0 -= mq[1][0] * x[4]; b0 -= mq[1][0] * y[4]; a1 -= mq[1][1] * x[5]; b1 -= mq[1][1] * y[5]; a0 -= mq[1][2] * x[6]; b0 -= mq[1][2] * y[6]; a1 -= mq[1][3] * x[7]; b1 -= mq[1][3] * y[7]; mq[1] = *(const LAS f32x4*)(Mg + 3804);
            a0 -= mq[2][0] * x[8]; b0 -= mq[2][0] * y[8]; a1 -= mq[2][1] * x[9]; b1 -= mq[2][1] * y[9]; a0 -= mq[2][2] * x[10]; b0 -= mq[2][2] * y[10]; a1 -= mq[2][3] * x[11]; b1 -= mq[2][3] * y[11]; mq[2] = *(const LAS f32x4*)(Mg + 3808);
            a0 -= mq[3][0] * x[12]; b0 -= mq[3][0] * y[12]; a1 -= mq[3][1] * x[13]; b1 -= mq[3][1] * y[13]; a0 -= mq[3][2] * x[14]; b0 -= mq[3][2] * y[14]; a1 -= mq[3][3] * x[15]; b1 -= mq[3][3] * y[15]; mq[3] = *(const LAS f32x4*)(Mg + 3812);
            a0 -= mq[4][0] * x[16]; b0 -= mq[4][0] * y[16]; a1 -= mq[4][1] * x[17]; b1 -= mq[4][1] * y[17]; a0 -= mq[4][2] * x[18]; b0 -= mq[4][2] * y[18]; a1 -= mq[4][3] * x[19]; b1 -= mq[4][3] * y[19]; mq[4] = *(const LAS f32x4*)(Mg + 3816);
            a0 -= mq[5][0] * x[20]; b0 -= mq[5][0] * y[20]; a1 -= mq[5][1] * x[21]; b1 -= mq[5][1] * y[21]; a0 -= mq[5][2] * x[22]; b0 -= mq[5][2] * y[22]; a1 -= mq[5][3] * x[23]; b1 -= mq[5][3] * y[23]; mq[5] = *(const LAS f32x4*)(Mg + 3820);
            a0 -= mq[0][0] * x[24]; b0 -= mq[0][0] * y[24]; a1 -= mq[0][1] * x[25]; b1 -= mq[0][1] * y[25]; a0 -= mq[0][2] * x[26]; b0 -= mq[0][2] * y[26]; a1 -= mq[0][3] * x[27]; b1 -= mq[0][3] * y[27]; mq[0] = *(const LAS f32x4*)(Mg + 3824);
            a0 -= mq[1][0] * x[28]; b0 -= mq[1][0] * y[28]; a1 -= mq[1][1] * x[29]; b1 -= mq[1][1] * y[29]; a0 -= mq[1][2] * x[30]; b0 -= mq[1][2] * y[30]; a1 -= mq[1][3] * x[31]; b1 -= mq[1][3] * y[31]; mq[1] = *(const LAS f32x4*)(Mg + 3828);
            a0 -= mq[2][0] * x[32]; b0 -= mq[2][0] * y[32]; a1 -= mq[2][1] * x[33]; b1 -= mq[2][1] * y[33]; a0 -= mq[2][2] * x[34]; b0 -= mq[2][2] * y[34]; a1 -= mq[2][3] * x[35]; b1 -= mq[2][3] * y[35]; mq[2] = *(const LAS f32x4*)(Mg + 3832);
            a0 -= mq[3][0] * x[36]; b0 -= mq[3][0] * y[36]; a1 -= mq[3][1] * x[37]; b1 -= mq[3][1] * y[37]; a0 -= mq[3][2] * x[38]; b0 -= mq[3][2] * y[38]; a1 -= mq[3][3] * x[39]; b1 -= mq[3][3] * y[39]; mq[3] = *(const LAS f32x4*)(Mg + 3840);
            a0 -= mq[4][0] * x[40]; b0 -= mq[4][0] * y[40]; a1 -= mq[4][1] * x[41]; b1 -= mq[4][1] * y[41]; a0 -= mq[4][2] * x[42]; b0 -= mq[4][2] * y[42]; a1 -= mq[4][3] * x[43]; b1 -= mq[4][3] * y[43]; mq[4] = *(const LAS f32x4*)(Mg + 3844);
            a0 -= mq[5][0] * x[44]; b0 -= mq[5][0] * y[44]; a1 -= mq[5][1] * x[45]; b1 -= mq[5][1] * y[45]; a0 -= mq[5][2] * x[46]; b0 -= mq[5][2] * y[46]; a1 -= mq[5][3] * x[47]; b1 -= mq[5][3] * y[47]; mq[5] = *(const LAS f32x4*)(Mg + 3848);
            a0 -= mq[0][0] * x[48]; b0 -= mq[0][0] * y[48]; a1 -= mq[0][1] * x[49]; b1 -= mq[0][1] * y[49]; a0 -= mq[0][2] * x[50]; b0 -= mq[0][2] * y[50]; a1 -= mq[0][3] * x[51]; b1 -= mq[0][3] * y[51]; mq[0] = *(const LAS f32x4*)(Mg + 3852);
            a0 -= mq[1][0] * x[52]; b0 -= mq[1][0] * y[52]; a1 -= mq[1][1] * x[53]; b1 -= mq[1][1] * y[53]; a0 -= mq[1][2] * x[54]; b0 -= mq[1][2] * y[54]; a1 -= mq[1][3] * x[55]; b1 -= mq[1][3] * y[55]; mq[1] = *(const LAS f32x4*)(Mg + 3856);
            a0 -= mq[2][0] * x[56]; b0 -= mq[2][0] * y[56]; a1 -= mq[2][1] * x[57]; b1 -= mq[2][1] * y[57]; a0 -= mq[2][2] * x[58]; b0 -= mq[2][2] * y[58]; x[59] = a0 + a1; y[59] = b0 + b1; up[7552] = x[59]; wp[7552] = f2bf(-y[59]); mq[2] = *(const LAS f32x4*)(Mg + 3860);
            { const float br = betg[60]; a0 = bf2f(*(const LAS bf16_t*)(lg + P5_VS + 16320 + c * 2)) * br; b0 = bf2f(*(const LAS bf16_t*)(lg + P5_KS + 16320 + c * 2)) * br * __expf(decg[60]); a1 = 0.f; b1 = 0.f; } a0 -= mq[3][0] * x[0]; b0 -= mq[3][0] * y[0]; a1 -= mq[3][1] * x[1]; b1 -= mq[3][1] * y[1]; a0 -= mq[3][2] * x[2]; b0 -= mq[3][2] * y[2]; a1 -= mq[3][3] * x[3]; b1 -= mq[3][3] * y[3]; mq[3] = *(const LAS f32x4*)(Mg + 3864);
            a0 -= mq[4][0] * x[4]; b0 -= mq[4][0] * y[4]; a1 -= mq[4][1] * x[5]; b1 -= mq[4][1] * y[5]; a0 -= mq[4][2] * x[6]; b0 -= mq[4][2] * y[6]; a1 -= mq[4][3] * x[7]; b1 -= mq[4][3] * y[7]; mq[4] = *(const LAS f32x4*)(Mg + 3868);
            a0 -= mq[5][0] * x[8]; b0 -= mq[5][0] * y[8]; a1 -= mq[5][1] * x[9]; b1 -= mq[5][1] * y[9]; a0 -= mq[5][2] * x[10]; b0 -= mq[5][2] * y[10]; a1 -= mq[5][3] * x[11]; b1 -= mq[5][3] * y[11]; mq[5] = *(const LAS f32x4*)(Mg + 3872);
            a0 -= mq[0][0] * x[12]; b0 -= mq[0][0] * y[12]; a1 -= mq[0][1] * x[13]; b1 -= mq[0][1] * y[13]; a0 -= mq[0][2] * x[14]; b0 -= mq[0][2] * y[14]; a1 -= mq[0][3] * x[15]; b1 -= mq[0][3] * y[15]; mq[0] = *(const LAS f32x4*)(Mg + 3876);
            a0 -= mq[1][0] * x[16]; b0 -= mq[1][0] * y[16]; a1 -= mq[1][1] * x[17]; b1 -= mq[1][1] * y[17]; a0 -= mq[1][2] * x[18]; b0 -= mq[1][2] * y[18]; a1 -= mq[1][3] * x[19]; b1 -= mq[1][3] * y[19]; mq[1] = *(const LAS f32x4*)(Mg + 3880);
            a0 -= mq[2][0] * x[20]; b0 -= mq[2][0] * y[20]; a1 -= mq[2][1] * x[21]; b1 -= mq[2][1] * y[21]; a0 -= mq[2][2] * x[22]; b0 -= mq[2][2] * y[22]; a1 -= mq[2][3] * x[23]; b1 -= mq[2][3] * y[23]; mq[2] = *(const LAS f32x4*)(Mg + 3884);
            a0 -= mq[3][0] * x[24]; b0 -= mq[3][0] * y[24]; a1 -= mq[3][1] * x[25]; b1 -= mq[3][1] * y[25]; a0 -= mq[3][2] * x[26]; b0 -= mq[3][2] * y[26]; a1 -= mq[3][3] * x[27]; b1 -= mq[3][3] * y[27]; mq[3] = *(const LAS f32x4*)(Mg + 3888);
            a0 -= mq[4][0] * x[28]; b0 -= mq[4][0] * y[28]; a1 -= mq[4][1] * x[29]; b1 -= mq[4][1] * y[29]; a0 -= mq[4][2] * x[30]; b0 -= mq[4][2] * y[30]; a1 -= mq[4][3] * x[31]; b1 -= mq[4][3] * y[31]; mq[4] = *(const LAS f32x4*)(Mg + 3892);
            a0 -= mq[5][0] * x[32]; b0 -= mq[5][0] * y[32]; a1 -= mq[5][1] * x[33]; b1 -= mq[5][1] * y[33]; a0 -= mq[5][2] * x[34]; b0 -= mq[5][2] * y[34]; a1 -= mq[5][3] * x[35]; b1 -= mq[5][3] * y[35]; mq[5] = *(const LAS f32x4*)(Mg + 3896);
            a0 -= mq[0][0] * x[36]; b0 -= mq[0][0] * y[36]; a1 -= mq[0][1] * x[37]; b1 -= mq[0][1] * y[37]; a0 -= mq[0][2] * x[38]; b0 -= mq[0][2] * y[38]; a1 -= mq[0][3] * x[39]; b1 -= mq[0][3] * y[39]; mq[0] = *(const LAS f32x4*)(Mg + 3904);
            a0 -= mq[1][0] * x[40]; b0 -= mq[1][0] * y[40]; a1 -= mq[1][1] * x[41]; b1 -= mq[1][1] * y[41]; a0 -= mq[1][2] * x[42]; b0 -= mq[1][2] * y[42]; a1 -= mq[1][3] * x[43]; b1 -= mq[1][3] * y[43]; mq[1] = *(const LAS f32x4*)(Mg + 3908);
            a0 -= mq[2][0] * x[44]; b0 -= mq[2][0] * y[44]; a1 -= mq[2][1] * x[45]; b1 -= mq[2][1] * y[45]; a0 -= mq[2][2] * x[46]; b0 -= mq[2][2] * y[46]; a1 -= mq[2][3] * x[47]; b1 -= mq[2][3] * y[47]; mq[2] = *(const LAS f32x4*)(Mg + 3912);
            a0 -= mq[3][0] * x[48]; b0 -= mq[3][0] * y[48]; a1 -= mq[3][1] * x[49]; b1 -= mq[3][1] * y[49]; a0 -= mq[3][2] * x[50]; b0 -= mq[3][2] * y[50]; a1 -= mq[3][3] * x[51]; b1 -= mq[3][3] * y[51]; mq[3] = *(const LAS f32x4*)(Mg + 3916);
            a0 -= mq[4][0] * x[52]; b0 -= mq[4][0] * y[52]; a1 -= mq[4][1] * x[53]; b1 -= mq[4][1] * y[53]; a0 -= mq[4][2] * x[54]; b0 -= mq[4][2] * y[54]; a1 -= mq[4][3] * x[55]; b1 -= mq[4][3] * y[55]; mq[4] = *(const LAS f32x4*)(Mg + 3920);
            a0 -= mq[5][0] * x[56]; b0 -= mq[5][0] * y[56]; a1 -= mq[5][1] * x[57]; b1 -= mq[5][1] * y[57]; a0 -= mq[5][2] * x[58]; b0 -= mq[5][2] * y[58]; a1 -= mq[5][3] * x[59]; b1 -= mq[5][3] * y[59]; x[60] = a0 + a1; y[60] = b0 + b1; up[7680] = x[60]; wp[7680] = f2bf(-y[60]); mq[5] = *(const LAS f32x4*)(Mg + 3924);
            { const float br = betg[61]; a0 = bf2f(*(const LAS bf16_t*)(lg + P5_VS + 16592 + c * 2)) * br; b0 = bf2f(*(const LAS bf16_t*)(lg + P5_KS + 16592 + c * 2)) * br * __expf(decg[61]); a1 = 0.f; b1 = 0.f; } a0 -= mq[0][0] * x[0]; b0 -= mq[0][0] * y[0]; a1 -= mq[0][1] * x[1]; b1 -= mq[0][1] * y[1]; a0 -= mq[0][2] * x[2]; b0 -= mq[0][2] * y[2]; a1 -= mq[0][3] * x[3]; b1 -= mq[0][3] * y[3]; mq[0] = *(const LAS f32x4*)(Mg + 3928);
            a0 -= mq[1][0] * x[4]; b0 -= mq[1][0] * y[4]; a1 -= mq[1][1] * x[5]; b1 -= mq[1][1] * y[5]; a0 -= mq[1][2] * x[6]; b0 -= mq[1][2] * y[6]; a1 -= mq[1][3] * x[7]; b1 -= mq[1][3] * y[7]; mq[1] = *(const LAS f32x4*)(Mg + 3932);
            a0 -= mq[2][0] * x[8]; b0 -= mq[2][0] * y[8]; a1 -= mq[2][1] * x[9]; b1 -= mq[2][1] * y[9]; a0 -= mq[2][2] * x[10]; b0 -= mq[2][2] * y[10]; a1 -= mq[2][3] * x[11]; b1 -= mq[2][3] * y[11]; mq[2] = *(const LAS f32x4*)(Mg + 3936);
            a0 -= mq[3][0] * x[12]; b0 -= mq[3][0] * y[12]; a1 -= mq[3][1] * x[13]; b1 -= mq[3][1] * y[13]; a0 -= mq[3][2] * x[14]; b0 -= mq[3][2] * y[14]; a1 -= mq[3][3] * x[15]; b1 -= mq[3][3] * y[15]; mq[3] = *(const LAS f32x4*)(Mg + 3940);
            a0 -= mq[4][0] * x[16]; b0 -= mq[4][0] * y[16]; a1 -= mq[4][1] * x[17]; b1 -= mq[4][1] * y[17]; a0 -= mq[4][2] * x[18]; b0 -= mq[4][2] * y[18]; a1 -= mq[4][3] * x[19]; b1 -= mq[4][3] * y[19]; mq[4] = *(const LAS f32x4*)(Mg + 3944);
            a0 -= mq[5][0] * x[20]; b0 -= mq[5][0] * y[20]; a1 -= mq[5][1] * x[21]; b1 -= mq[5][1] * y[21]; a0 -= mq[5][2] * x[22]; b0 -= mq[5][2] * y[22]; a1 -= mq[5][3] * x[23]; b1 -= mq[5][3] * y[23]; mq[5] = *(const LAS f32x4*)(Mg + 3948);
            a0 -= mq[0][0] * x[24]; b0 -= mq[0][0] * y[24]; a1 -= mq[0][1] * x[25]; b1 -= mq[0][1] * y[25]; a0 -= mq[0][2] * x[26]; b0 -= mq[0][2] * y[26]; a1 -= mq[0][3] * x[27]; b1 -= mq[0][3] * y[27]; mq[0] = *(const LAS f32x4*)(Mg + 3952);
            a0 -= mq[1][0] * x[28]; b0 -= mq[1][0] * y[28]; a1 -= mq[1][1] * x[29]; b1 -= mq[1][1] * y[29]; a0 -= mq[1][2] * x[30]; b0 -= mq[1][2] * y[30]; a1 -= mq[1][3] * x[31]; b1 -= mq[1][3] * y[31]; mq[1] = *(const LAS f32x4*)(Mg + 3956);
            a0 -= mq[2][0] * x[32]; b0 -= mq[2][0] * y[32]; a1 -= mq[2][1] * x[33]; b1 -= mq[2][1] * y[33]; a0 -= mq[2][2] * x[34]; b0 -= mq[2][2] * y[34]; a1 -= mq[2][3] * x[35]; b1 -= mq[2][3] * y[35]; mq[2] = *(const LAS f32x4*)(Mg + 3960);
            a0 -= mq[3][0] * x[36]; b0 -= mq[3][0] * y[36]; a1 -= mq[3][1] * x[37]; b1 -= mq[3][1] * y[37]; a0 -= mq[3][2] * x[38]; b0 -= mq[3][2] * y[38]; a1 -= mq[3][3] * x[39]; b1 -= mq[3][3] * y[39]; mq[3] = *(const LAS f32x4*)(Mg + 3964);
            a0 -= mq[4][0] * x[40]; b0 -= mq[4][0] * y[40]; a1 -= mq[4][1] * x[41]; b1 -= mq[4][1] * y[41]; a0 -= mq[4][2] * x[42]; b0 -= mq[4][2] * y[42]; a1 -= mq[4][3] * x[43]; b1 -= mq[4][3] * y[43]; mq[4] = *(const LAS f32x4*)(Mg + 3968);
            a0 -= mq[5][0] * x[44]; b0 -= mq[5][0] * y[44]; a1 -= mq[5][1] * x[45]; b1 -= mq[5][1] * y[45]; a0 -= mq[5][2] * x[46]; b0 -= mq[5][2] * y[46]; a1 -= mq[5][3] * x[47]; b1 -= mq[5][3] * y[47]; mq[5] = *(const LAS f32x4*)(Mg + 3972);
            a0 -= mq[0][0] * x[48]; b0 -= mq[0][0] * y[48]; a1 -= mq[0][1] * x[49]; b1 -= mq[0][1] * y[49]; a0 -= mq[0][2] * x[50]; b0 -= mq[0][2] * y[50]; a1 -= mq[0][3] * x[51]; b1 -= mq[0][3] * y[51]; mq[0] = *(const LAS f32x4*)(Mg + 3976);
            a0 -= mq[1][0] * x[52]; b0 -= mq[1][0] * y[52]; a1 -= mq[1][1] * x[53]; b1 -= mq[1][1] * y[53]; a0 -= mq[1][2] * x[54]; b0 -= mq[1][2] * y[54]; a1 -= mq[1][3] * x[55]; b1 -= mq[1][3] * y[55]; mq[1] = *(const LAS f32x4*)(Mg + 3980);
            a0 -= mq[2][0] * x[56]; b0 -= mq[2][0] * y[56]; a1 -= mq[2][1] * x[57]; b1 -= mq[2][1] * y[57]; a0 -= mq[2][2] * x[58]; b0 -= mq[2][2] * y[58]; a1 -= mq[2][3] * x[59]; b1 -= mq[2][3] * y[59]; mq[2] = *(const LAS f32x4*)(Mg + 3984);
            a0 -= mq[3][0] * x[60]; b0 -= mq[3][0] * y[60]; x[61] = a0 + a1; y[61] = b0 + b1; up[7808] = x[61]; wp[7808] = f2bf(-y[61]); mq[3] = *(const LAS f32x4*)(Mg + 3988);
            { const float br = betg[62]; a0 = bf2f(*(const LAS bf16_t*)(lg + P5_VS + 16864 + c * 2)) * br; b0 = bf2f(*(const LAS bf16_t*)(lg + P5_KS + 16864 + c * 2)) * br * __expf(decg[62]); a1 = 0.f; b1 = 0.f; } a0 -= mq[4][0] * x[0]; b0 -= mq[4][0] * y[0]; a1 -= mq[4][1] * x[1]; b1 -= mq[4][1] * y[1]; a0 -= mq[4][2] * x[2]; b0 -= mq[4][2] * y[2]; a1 -= mq[4][3] * x[3]; b1 -= mq[4][3] * y[3]; mq[4] = *(const LAS f32x4*)(Mg + 3992);
            a0 -= mq[5][0] * x[4]; b0 -= mq[5][0] * y[4]; a1 -= mq[5][1] * x[5]; b1 -= mq[5][1] * y[5]; a0 -= mq[5][2] * x[6]; b0 -= mq[5][2] * y[6]; a1 -= mq[5][3] * x[7]; b1 -= mq[5][3] * y[7]; mq[5] = *(const LAS f32x4*)(Mg + 3996);
            a0 -= mq[0][0] * x[8]; b0 -= mq[0][0] * y[8]; a1 -= mq[0][1] * x[9]; b1 -= mq[0][1] * y[9]; a0 -= mq[0][2] * x[10]; b0 -= mq[0][2] * y[10]; a1 -= mq[0][3] * x[11]; b1 -= mq[0][3] * y[11]; mq[0] = *(const LAS f32x4*)(Mg + 4000);
            a0 -= mq[1][0] * x[12]; b0 -= mq[1][0] * y[12]; a1 -= mq[1][1] * x[13]; b1 -= mq[1][1] * y[13]; a0 -= mq[1][2] * x[14]; b0 -= mq[1][2] * y[14]; a1 -= mq[1][3] * x[15]; b1 -= mq[1][3] * y[15]; mq[1] = *(const LAS f32x4*)(Mg + 4004);
            a0 -= mq[2][0] * x[16]; b0 -= mq[2][0] * y[16]; a1 -= mq[2][1] * x[17]; b1 -= mq[2][1] * y[17]; a0 -= mq[2][2] * x[18]; b0 -= mq[2][2] * y[18]; a1 -= mq[2][3] * x[19]; b1 -= mq[2][3] * y[19]; mq[2] = *(const LAS f32x4*)(Mg + 4008);
            a0 -= mq[3][0] * x[20]; b0 -= mq[3][0] * y[20]; a1 -= mq[3][1] * x[21]; b1 -= mq[3][1] * y[21]; a0 -= mq[3][2] * x[22]; b0 -= mq[3][2] * y[22]; a1 -= mq[3][3] * x[23]; b1 -= mq[3][3] * y[23]; mq[3] = *(const LAS f32x4*)(Mg + 4012);
            a0 -= mq[4][0] * x[24]; b0 -= mq[4][0] * y[24]; a1 -= mq[4][1] * x[25]; b1 -= mq[4][1] * y[25]; a0 -= mq[4][2] * x[26]; b0 -= mq[4][2] * y[26]; a1 -= mq[4][3] * x[27]; b1 -= mq[4][3] * y[27]; mq[4] = *(const LAS f32x4*)(Mg + 4016);
            a0 -= mq[5][0] * x[28]; b0 -= mq[5][0] * y[28]; a1 -= mq[5][1] * x[29]; b1 -= mq[5][1] * y[29]; a0 -= mq[5][2] * x[30]; b0 -= mq[5][2] * y[30]; a1 -= mq[5][3] * x[31]; b1 -= mq[5][3] * y[31]; mq[5] = *(const LAS f32x4*)(Mg + 4020);
            a0 -= mq[0][0] * x[32]; b0 -= mq[0][0] * y[32]; a1 -= mq[0][1] * x[33]; b1 -= mq[0][1] * y[33]; a0 -= mq[0][2] * x[34]; b0 -= mq[0][2] * y[34]; a1 -= mq[0][3] * x[35]; b1 -= mq[0][3] * y[35]; mq[0] = *(const LAS f32x4*)(Mg + 4024);
            a0 -= mq[1][0] * x[36]; b0 -= mq[1][0] * y[36]; a1 -= mq[1][1] * x[37]; b1 -= mq[1][1] * y[37]; a0 -= mq[1][2] * x[38]; b0 -= mq[1][2] * y[38]; a1 -= mq[1][3] * x[39]; b1 -= mq[1][3] * y[39]; mq[1] = *(const LAS f32x4*)(Mg + 4028);
            a0 -= mq[2][0] * x[40]; b0 -= mq[2][0] * y[40]; a1 -= mq[2][1] * x[41]; b1 -= mq[2][1] * y[41]; a0 -= mq[2][2] * x[42]; b0 -= mq[2][2] * y[42]; a1 -= mq[2][3] * x[43]; b1 -= mq[2][3] * y[43]; mq[2] = *(const LAS f32x4*)(Mg + 4032);
            a0 -= mq[3][0] * x[44]; b0 -= mq[3][0] * y[44]; a1 -= mq[3][1] * x[45]; b1 -= mq[3][1] * y[45]; a0 -= mq[3][2] * x[46]; b0 -= mq[3][2] * y[46]; a1 -= mq[3][3] * x[47]; b1 -= mq[3][3] * y[47]; mq[3] = *(const LAS f32x4*)(Mg + 4036);
            a0 -= mq[4][0] * x[48]; b0 -= mq[4][0] * y[48]; a1 -= mq[4][1] * x[49]; b1 -= mq[4][1] * y[49]; a0 -= mq[4][2] * x[50]; b0 -= mq[4][2] * y[50]; a1 -= mq[4][3] * x[51]; b1 -= mq[4][3] * y[51]; mq[4] = *(const LAS f32x4*)(Mg + 4040);
            a0 -= mq[5][0] * x[52]; b0 -= mq[5][0] * y[52]; a1 -= mq[5][1] * x[53]; b1 -= mq[5][1] * y[53]; a0 -= mq[5][2] * x[54]; b0 -= mq[5][2] * y[54]; a1 -= mq[5][3] * x[55]; b1 -= mq[5][3] * y[55]; mq[5] = *(const LAS f32x4*)(Mg + 4044);
            a0 -= mq[0][0] * x[56]; b0 -= mq[0][0] * y[56]; a1 -= mq[0][1] * x[57]; b1 -= mq[0][1] * y[57]; a0 -= mq[0][2] * x[58]; b0 -= mq[0][2] * y[58]; a1 -= mq[0][3] * x[59]; b1 -= mq[0][3] * y[59]; mq[0] = *(const LAS f32x4*)(Mg + 4048);
            a0 -= mq[1][0] * x[60]; b0 -= mq[1][0] * y[60]; a1 -= mq[1][1] * x[61]; b1 -= mq[1][1] * y[61]; x[62] = a0 + a1; y[62] = b0 + b1; up[7936] = x[62]; wp[7936] = f2bf(-y[62]); mq[1] = *(const LAS f32x4*)(Mg + 4052);
            { const float br = betg[63]; a0 = bf2f(*(const LAS bf16_t*)(lg + P5_VS + 17136 + c * 2)) * br; b0 = bf2f(*(const LAS bf16_t*)(lg + P5_KS + 17136 + c * 2)) * br * __expf(decg[63]); a1 = 0.f; b1 = 0.f; } a0 -= mq[2][0] * x[0]; b0 -= mq[2][0] * y[0]; a1 -= mq[2][1] * x[1]; b1 -= mq[2][1] * y[1]; a0 -= mq[2][2] * x[2]; b0 -= mq[2][2] * y[2]; a1 -= mq[2][3] * x[3]; b1 -= mq[2][3] * y[3]; mq[2] = *(const LAS f32x4*)(Mg + 4056);
            a0 -= mq[3][0] * x[4]; b0 -= mq[3][0] * y[4]; a1 -= mq[3][1] * x[5]; b1 -= mq[3][1] * y[5]; a0 -= mq[3][2] * x[6]; b0 -= mq[3][2] * y[6]; a1 -= mq[3][3] * x[7]; b1 -= mq[3][3] * y[7]; mq[3] = *(const LAS f32x4*)(Mg + 4060);
            a0 -= mq[4][0] * x[8]; b0 -= mq[4][0] * y[8]; a1 -= mq[4][1] * x[9]; b1 -= mq[4][1] * y[9]; a0 -= mq[4][2] * x[10]; b0 -= mq[4][2] * y[10]; a1 -= mq[4][3] * x[11]; b1 -= mq[4][3] * y[11]; mq[4] = *(const LAS f32x4*)(Mg + 4064);
            a0 -= mq[5][0] * x[12]; b0 -= mq[5][0] * y[12]; a1 -= mq[5][1] * x[13]; b1 -= mq[5][1] * y[13]; a0 -= mq[5][2] * x[14]; b0 -= mq[5][2] * y[14]; a1 -= mq[5][3] * x[15]; b1 -= mq[5][3] * y[15]; mq[5] = *(const LAS f32x4*)(Mg + 4068);
            a0 -= mq[0][0] * x[16]; b0 -= mq[0][0] * y[16]; a1 -= mq[0][1] * x[17]; b1 -= mq[0][1] * y[17]; a0 -= mq[0][2] * x[18]; b0 -= mq[0][2] * y[18]; a1 -= mq[0][3] * x[19]; b1 -= mq[0][3] * y[19]; mq[0] = *(const LAS f32x4*)(Mg + 4072);
            a0 -= mq[1][0] * x[20]; b0 -= mq[1][0] * y[20]; a1 -= mq[1][1] * x[21]; b1 -= mq[1][1] * y[21]; a0 -= mq[1][2] * x[22]; b0 -= mq[1][2] * y[22]; a1 -= mq[1][3] * x[23]; b1 -= mq[1][3] * y[23]; mq[1] = *(const LAS f32x4*)(Mg + 4076);
            a0 -= mq[2][0] * x[24]; b0 -= mq[2][0] * y[24]; a1 -= mq[2][1] * x[25]; b1 -= mq[2][1] * y[25]; a0 -= mq[2][2] * x[26]; b0 -= mq[2][2] * y[26]; a1 -= mq[2][3] * x[27]; b1 -= mq[2][3] * y[27]; mq[2] = *(const LAS f32x4*)(Mg + 4080);
            a0 -= mq[3][0] * x[28]; b0 -= mq[3][0] * y[28]; a1 -= mq[3][1] * x[29]; b1 -= mq[3][1] * y[29]; a0 -= mq[3][2] * x[30]; b0 -= mq[3][2] * y[30]; a1 -= mq[3][3] * x[31]; b1 -= mq[3][3] * y[31]; mq[3] = *(const LAS f32x4*)(Mg + 4084);
            a0 -= mq[4][0] * x[32]; b0 -= mq[4][0] * y[32]; a1 -= mq[4][1] * x[33]; b1 -= mq[4][1] * y[33]; a0 -= mq[4][2] * x[34]; b0 -= mq[4][2] * y[34]; a1 -= mq[4][3] * x[35]; b1 -= mq[4][3] * y[35]; mq[4] = *(const LAS f32x4*)(Mg + 4088);
            a0 -= mq[5][0] * x[36]; b0 -= mq[5][0] * y[36]; a1 -= mq[5][1] * x[37]; b1 -= mq[5][1] * y[37]; a0 -= mq[5][2] * x[38]; b0 -= mq[5][2] * y[38]; a1 -= mq[5][3] * x[39]; b1 -= mq[5][3] * y[39]; mq[5] = *(const LAS f32x4*)(Mg + 4092);
            a0 -= mq[0][0] * x[40]; b0 -= mq[0][0] * y[40]; a1 -= mq[0][1] * x[41]; b1 -= mq[0][1] * y[41]; a0 -= mq[0][2] * x[42]; b0 -= mq[0][2] * y[42]; a1 -= mq[0][3] * x[43]; b1 -= mq[0][3] * y[43];
            a0 -= mq[1][0] * x[44]; b0 -= mq[1][0] * y[44]; a1 -= mq[1][1] * x[45]; b1 -= mq[1][1] * y[45]; a0 -= mq[1][2] * x[46]; b0 -= mq[1][2] * y[46]; a1 -= mq[1][3] * x[47]; b1 -= mq[1][3] * y[47];
            a0 -= mq[2][0] * x[48]; b0 -= mq[2][0] * y[48]; a1 -= mq[2][1] * x[49]; b1 -= mq[2][1] * y[49]; a0 -= mq[2][2] * x[50]; b0 -= mq[2][2] * y[50]; a1 -= mq[2][3] * x[51]; b1 -= mq[2][3] * y[51];
            a0 -= mq[3][0] * x[52]; b0 -= mq[3][0] * y[52]; a1 -= mq[3][1] * x[53]; b1 -= mq[3][1] * y[53]; a0 -= mq[3][2] * x[54]; b0 -= mq[3][2] * y[54]; a1 -= mq[3][3] * x[55]; b1 -= mq[3][3] * y[55];
            a0 -= mq[4][0] * x[56]; b0 -= mq[4][0] * y[56]; a1 -= mq[4][1] * x[57]; b1 -= mq[4][1] * y[57]; a0 -= mq[4][2] * x[58]; b0 -= mq[4][2] * y[58]; a1 -= mq[4][3] * x[59]; b1 -= mq[4][3] * y[59];
            a0 -= mq[5][0] * x[60]; b0 -= mq[5][0] * y[60]; a1 -= mq[5][1] * x[61]; b1 -= mq[5][1] * y[61]; a0 -= mq[5][2] * x[62]; b0 -= mq[5][2] * y[62]; x[63] = a0 + a1; y[63] = b0 + b1; up[8064] = x[63]; wp[8064] = f2bf(-y[63]);
        } else {
            const int g2 = (w8 - 4) >> 1, tt = ((w8 - 4) & 1) * 64 + lane; const int item2 = it0 + g2;
            LAS unsigned char* lg = lds0 + g2 * P5_GRP; LAS float* decg = (LAS float*)(lg + P5_DEC);
            const float lastg = decg[63];
#pragma unroll
            for (int i = 0; i < 8; ++i) { const int vid = tt + 128 * i, r = vid >> 4, d0 = (vid & 15) * 8; float f[8]; unpack8(*(const LAS u32x4*)(lg + P5_QS + r * 272 + d0 * 2), f);
                const float e = scale * __expf(decg[r]);
#pragma unroll
                for (int q = 0; q < 8; ++q) f[q] *= e;
                *(u32x4*)(qd + (size_t)item2 * 8192 + r * 128 + d0) = pack8(f); }
#pragma unroll
            for (int i = 0; i < 8; ++i) { const int vid = tt + 128 * i, d = vid >> 3, rg = (vid & 7) * 8; float f[8];
#pragma unroll
                for (int q = 0; q < 8; ++q) f[q] = bf2f(*(const LAS bf16_t*)(lg + P5_KS + (rg + q) * 272 + d * 2)) * __expf(lastg - decg[rg + q]);
                *(u32x4*)(kt + (size_t)item2 * 8192 + d * 64 + rg) = pack8(f); }
            if (tt == 0) cdv[item2] = __expf(lastg);
        }
    }
    __syncthreads();
}

constexpr int SB_WD = 0, SB_QD = 17408, SB_KT = 34816, SB_QK = 53248, SB_UB = 62464, SB_SIZE = 66560;
constexpr int SC_ST = 2 * SB_SIZE, SC_UT = SC_ST + 4352, SC_END = SC_UT + 2304;
static_assert(SC_END <= LDS_BYTES, "lds");
__device__ __forceinline__ void scan_phase(const Params& p, int bid, int nblk, LAS unsigned char* lds) {
    const int tid = threadIdx.x, lane = tid & 63, wid = __builtin_amdgcn_readfirstlane(tid >> 6), fr = lane & 15, fq = lane >> 4;
    const bf16_t* wdc = (const bf16_t*)(p.ws + WS_WDC); const bf16_t* qd = (const bf16_t*)(p.ws + WS_QD); const bf16_t* kt = (const bf16_t*)(p.ws + WS_KT); const bf16_t* qk = (const bf16_t*)(p.ws + WS_QK);
    const float* cdv = (const float*)(p.ws + WS_CD); const float* ub = p.out + OS_UB; float* obuf = p.out + OS_O;
    for (int item = bid; item < 256; item += nblk) {
        const int xcd = item & 7, iq = item >> 3, bh = xcd * 4 + (iq >> 3), sl = iq & 7, h = bh & 7, b = bh >> 3;
        u32x4 r_wd[2], r_qd[2], r_kt[2], r_qk, r_ub;
        auto gload = [&](int n) {
            const size_t it = (size_t)(bh * 32 + n);
#pragma unroll
            for (int i = 0; i < 2; ++i) { const int ch = tid + 512 * i; r_wd[i] = *(const u32x4*)(wdc + it * 8192 + ch * 8); r_qd[i] = *(const u32x4*)(qd + it * 8192 + ch * 8); r_kt[i] = *(const u32x4*)(kt + it * 8192 + ch * 8); }
            r_qk = *(const u32x4*)(qk + it * 4096 + tid * 8);
            if (tid < 256) r_ub = *(const u32x4*)(ub + it * 8192 + (tid >> 2) * 128 + sl * 16 + (tid & 3) * 4);
        };
        auto lstore = [&](int buf) {
            LAS unsigned char* B = lds + buf * SB_SIZE;
#pragma unroll
            for (int i = 0; i < 2; ++i) { const int ch = tid + 512 * i; const int r = ch >> 4, c8 = (ch & 15) * 8; *(LAS u32x4*)(B + SB_WD + r * 272 + c8 * 2) = r_wd[i]; *(LAS u32x4*)(B + SB_QD + r * 272 + c8 * 2) = r_qd[i];
                const int d = ch >> 3, t8 = (ch & 7) * 8; *(LAS u32x4*)(B + SB_KT + d * 144 + t8 * 2) = r_kt[i]; }
            { const int r = tid >> 3, s8 = (tid & 7) * 8; *(LAS u32x4*)(B + SB_QK + r * 144 + s8 * 2) = r_qk; }
            if (tid < 256) *(LAS u32x4*)(B + SB_UB + (tid >> 2) * 64 + (tid & 3) * 16) = r_ub;
        };
        __syncthreads();
        gload(0);
        for (int i = tid; i < 4352 / 4; i += 512) *(LAS unsigned*)(lds + SC_ST + i * 4) = 0u;
        lstore(0);
        f32x4 sacc = (f32x4){0.f, 0.f, 0.f, 0.f};
        __syncthreads();
        for (int n = 0; n < 32; ++n) {
            const int cur = n & 1; LAS unsigned char* B = lds + cur * SB_SIZE;
            if (n + 1 < 32) gload(n + 1);
            const float cd = cdv[bh * 32 + n];
            f32x4 acc;
            const int tw = wid & 3;
            if (wid < 4) {
#pragma unroll
                for (int j = 0; j < 4; ++j) acc[j] = *(const LAS float*)(B + SB_UB + ((tw * 16 + fq * 4 + j) * 16 + fr) * 4);
#pragma unroll
                for (int kk = 0; kk < 4; ++kk) { const bf16x8 a = *(const LAS bf16x8*)(B + SB_WD + (tw * 16 + fr) * 272 + (kk * 32 + fq * 8) * 2); const bf16x8 bb = *(const LAS bf16x8*)(lds + SC_ST + fr * 272 + (kk * 32 + fq * 8) * 2);
                    acc = __builtin_amdgcn_mfma_f32_16x16x32_bf16(a, bb, acc, 0, 0, 0); }
                u32x2 w; w.x = pk2(acc[0], acc[1]); w.y = pk2(acc[2], acc[3]);
                *(LAS u32x2*)(lds + SC_UT + fr * 144 + (tw * 16 + fq * 4) * 2) = w;
            } else {
                acc = (f32x4){0.f, 0.f, 0.f, 0.f};
#pragma unroll
                for (int kk = 0; kk < 4; ++kk) { const bf16x8 a = *(const LAS bf16x8*)(B + SB_QD + (tw * 16 + fr) * 272 + (kk * 32 + fq * 8) * 2); const bf16x8 bb = *(const LAS bf16x8*)(lds + SC_ST + fr * 272 + (kk * 32 + fq * 8) * 2);
                    acc = __builtin_amdgcn_mfma_f32_16x16x32_bf16(a, bb, acc, 0, 0, 0); }
            }
            __syncthreads();
            sacc *= cd;
#pragma unroll
            for (int kk = 0; kk < 2; ++kk) { const bf16x8 a = *(const LAS bf16x8*)(B + SB_KT + (wid * 16 + fr) * 144 + (kk * 32 + fq * 8) * 2); const bf16x8 bb = *(const LAS bf16x8*)(lds + SC_UT + fr * 144 + (kk * 32 + fq * 8) * 2);
                sacc = __builtin_amdgcn_mfma_f32_16x16x32_bf16(a, bb, sacc, 0, 0, 0); }
            if (wid >= 4) {
#pragma unroll
                for (int kk = 0; kk < 2; ++kk) { const bf16x8 a = *(const LAS bf16x8*)(B + SB_QK + (tw * 16 + fr) * 144 + (kk * 32 + fq * 8) * 2); const bf16x8 bb = *(const LAS bf16x8*)(lds + SC_UT + fr * 144 + (kk * 32 + fq * 8) * 2);
                    acc = __builtin_amdgcn_mfma_f32_16x16x32_bf16(a, bb, acc, 0, 0, 0); }
#pragma unroll
                for (int j = 0; j < 4; ++j) obuf[(size_t)(b * 2048 + n * 64 + tw * 16 + fq * 4 + j) * 1024 + h * 128 + sl * 16 + fr] = acc[j];
            }
            { u32x2 w; w.x = pk2(sacc[0], sacc[1]); w.y = pk2(sacc[2], sacc[3]); *(LAS u32x2*)(lds + SC_ST + fr * 272 + (wid * 16 + fq * 4) * 2) = w; }
            if (n + 1 < 32) lstore(cur ^ 1);
            __syncthreads();
        }
#pragma unroll
        for (int j = 0; j < 4; ++j) p.out[O_DP + ((size_t)bh * 128 + wid * 16 + fq * 4 + j) * 128 + sl * 16 + fr] = sacc[j];
    }
    __syncthreads();
    {
        const bf16_t* qn = (const bf16_t*)(p.ws + WS_QN); const bf16_t* kn = (const bf16_t*)(p.ws + WS_KN); const bf16_t* vv = (const bf16_t*)(p.ws + WS_VV);
        const float* gbuf = (const float*)(p.ws + WS_G); const float* bbuf = (const float*)(p.ws + WS_BETA);
        const int grp = tid >> 8, w4 = __builtin_amdgcn_readfirstlane(tid >> 6) & 3, j = w4 * 32 + (lane & 31), half = lane >> 5;
        LAS float* qs = (LAS float*)lds + grp * 1024;
        LAS float* ks = qs + 512;
        const float scale = 0.08838834764831845f;
        for (int it0 = bid * 2; it0 < 1024; it0 += nblk * 2) {
            const int item = it0 + grp, sb = item >> 3, h = item & 7;
            __syncthreads();
#pragma unroll
            for (int i = 0; i < 4; ++i) { const int idx = (tid & 255) + 256 * i, tk = idx >> 7, c = idx & 127, t = tk & 3; const size_t go = (size_t)(TP + sb * 4 + t) * 1024 + h * 128 + c;
                if (tk < 4) qs[t * 128 + c] = bf2f(qn[go]); else ks[t * 128 + c] = bf2f(kn[go]); }
            float S[64];
            const float* s0 = p.in[4] + (size_t)item * 16384 + (size_t)half * 64 * 128 + j;
#pragma unroll
            for (int i = 0; i < 64; ++i) S[i] = __builtin_nontemporal_load(s0 + i * 128);
            __syncthreads();
#pragma unroll 1
            for (int t = 0; t < 4; ++t) {
                const int row = TP + sb * 4 + t;
                const float a = __expf(gbuf[row * 8 + h]), be = bbuf[row * 8 + h], v = bf2f(vv[(size_t)row * 1024 + h * 128 + j]);
                float kS = 0.f;
#pragma unroll
                for (int i4 = 0; i4 < 16; ++i4) { const f32x4 k4 = *(const LAS f32x4*)(ks + t * 128 + half * 64 + i4 * 4); kS += k4[0] * S[i4 * 4] + k4[1] * S[i4 * 4 + 1] + k4[2] * S[i4 * 4 + 2] + k4[3] * S[i4 * 4 + 3]; }
                kS += __shfl_xor(kS, 32);
                const float coef = be * (v - a * kS);
                float o = 0.f;
#pragma unroll
                for (int i4 = 0; i4 < 16; ++i4) { const f32x4 k4 = *(const LAS f32x4*)(ks + t * 128 + half * 64 + i4 * 4); const f32x4 q4 = *(const LAS f32x4*)(qs + t * 128 + half * 64 + i4 * 4);
#pragma unroll
                    for (int q = 0; q < 4; ++q) { S[i4 * 4 + q] = a * S[i4 * 4 + q] + k4[q] * coef; o += q4[q] * S[i4 * 4 + q]; } }
                o += __shfl_xor(o, 32);
                if (half == 0) obuf[(size_t)row * 1024 + h * 128 + j] = o * scale;
            }
            float* so = p.out + O_DS + (size_t)item * 16384 + (size_t)half * 64 * 128 + j;
#pragma unroll
            for (int i = 0; i < 64; ++i) so[i * 128] = S[i];
        }
    }
    __syncthreads();
}

__device__ __forceinline__ void onorm_phase(const Params& p, int bid, int nblk) {
    const int lane = threadIdx.x & 63, wid = __builtin_amdgcn_readfirstlane(threadIdx.x >> 6);
    const float* obuf = p.out + OS_O; const bf16_t* proj = (const bf16_t*)(p.ws + WS_PROJ); bf16_t* acat = (bf16_t*)(p.ws + WS_U); const float* og = p.in[14];
    for (int row = bid * 8 + wid; row < TT; row += nblk * 8) {
        const int c0 = lane * 16; float o[16], z[16], g[16];
#pragma unroll
        for (int i = 0; i < 4; ++i) { const f32x4 v = *(const f32x4*)(obuf + (size_t)row * 1024 + c0 + i * 4); o[i * 4] = v[0]; o[i * 4 + 1] = v[1]; o[i * 4 + 2] = v[2]; o[i * 4 + 3] = v[3];
            const f32x4 gg = *(const f32x4*)(og + (c0 & 127) + i * 4); g[i * 4] = gg[0]; g[i * 4 + 1] = gg[1]; g[i * 4 + 2] = gg[2]; g[i * 4 + 3] = gg[3]; }
        unpack8(*(const u32x4*)(proj + (size_t)row * NPROJ + C_Z + c0), z); unpack8(*(const u32x4*)(proj + (size_t)row * NPROJ + C_Z + c0 + 8), z + 8);
        float ss = 0.f;
#pragma unroll
        for (int i = 0; i < 16; ++i) ss += o[i] * o[i];
        ss += __shfl_xor(ss, 1); ss += __shfl_xor(ss, 2); ss += __shfl_xor(ss, 4);
        const float rstd = rsqrtf(ss * (1.0f / 128.0f) + EPS);
#pragma unroll
        for (int i = 0; i < 16; ++i) o[i] = o[i] * rstd * g[i] * siluf_(z[i]);
        *(u32x4*)(acat + (size_t)row * DM + c0) = pack8(o); *(u32x4*)(acat + (size_t)row * DM + c0 + 8) = pack8(o + 8);
    }
}

#define XB_TMO      128
#define XB_XCNT(j)  (256  + 64 * (j))
#define XB_XSUB(j)  (1280 + 64 * (j))
#define XB_XGEN(j)  (2304 + 64 * (j))
#define XB_TOP      3328
#define XB_TOPGEN   3392
#define XCD_BAR_WORDS 3456
#define XB_SPIN_CAP (1u << 18)

__device__ __forceinline__ unsigned xb_ld(unsigned* p)              { return __hip_atomic_load(p, __ATOMIC_RELAXED, __HIP_MEMORY_SCOPE_AGENT); }
__device__ __forceinline__ unsigned xb_add(unsigned* p, unsigned v) { return __hip_atomic_fetch_add(p, v, __ATOMIC_RELAXED, __HIP_MEMORY_SCOPE_AGENT); }
__device__ __forceinline__ unsigned xb_xcc_id() { return (unsigned)__builtin_amdgcn_s_getreg((3 << 11) | 20) & 0xFu; }
#define XB_SPIN(cond, bar) do { unsigned _sp = 0; while (cond) { __builtin_amdgcn_s_sleep(1); \
    if ((++_sp & 255u) == 0u) { if (xb_ld(&(bar)[XB_TMO])) break; if (_sp > XB_SPIN_CAP) { atomicAdd(&(bar)[XB_TMO], 1u); break; } } } } while (0)

struct XcdBarrier {
    unsigned* bar; unsigned x;
    volatile LAS unsigned* st;
};

__device__ __forceinline__ XcdBarrier xcd_barrier_post(unsigned* bar, volatile LAS unsigned* st) {
    XcdBarrier b; b.bar = bar; b.x = xb_xcc_id(); b.st = st;
    if (threadIdx.x == 0) (void)xb_add(&bar[XB_XCNT(b.x)], 1u);
    return b;
}
__device__ __forceinline__ void xcd_barrier_complete(unsigned* bar, unsigned x, unsigned& nloc, unsigned& nx) {
    const unsigned G = gridDim.x * gridDim.y * gridDim.z;
    unsigned sum, cnt, mine, sp = 0u;
    for (;;) {
        sum = 0u; cnt = 0u; mine = 0u;
#pragma unroll
        for (unsigned j = 0; j < 16; ++j) { const unsigned c = xb_ld(&bar[XB_XCNT(j)]); sum += c; cnt += (c > 0u) ? 1u : 0u; mine = (j == x) ? c : mine; }
        if (sum == G) break;
        __builtin_amdgcn_s_sleep(1);
        if ((++sp & 255u) == 0u) { if (xb_ld(&bar[XB_TMO])) break; if (sp > XB_SPIN_CAP) { atomicAdd(&bar[XB_TMO], 1u); break; } }
    }
    nloc = mine > 0u ? mine : 1u; nx = cnt > 0u ? cnt : 1u;
}

__device__ __forceinline__ void xcd_barrier(const XcdBarrier& b) {
    asm volatile("s_waitcnt vmcnt(0)" ::: "memory");
    __syncthreads();
    if (threadIdx.x == 0) {
        unsigned* bar = b.bar;
        __builtin_amdgcn_s_waitcnt(0);
        unsigned nloc = b.st[0], nx = b.st[1];
        if (nloc == 0u) { xcd_barrier_complete(bar, b.x, nloc, nx); b.st[0] = nloc; b.st[1] = nx; }
        const unsigned old = xb_add(&bar[XB_XSUB(b.x)], 1u);
        const unsigned gen = old / nloc;
        if (old + 1u == (gen + 1u) * nloc) {
            __builtin_amdgcn_fence(__ATOMIC_RELEASE, "agent");
            asm volatile("s_waitcnt vmcnt(0)" ::: "memory");
            const unsigned og = xb_add(&bar[XB_TOP], 1u);
            const unsigned tg = og / nx;
            if (og + 1u == (tg + 1u) * nx) xb_add(&bar[XB_TOPGEN], 1u);
            else XB_SPIN(xb_ld(&bar[XB_TOPGEN]) == tg, bar);
            __builtin_amdgcn_fence(__ATOMIC_ACQUIRE, "agent");
            xb_add(&bar[XB_XGEN(b.x)], 1u);
            asm volatile("s_waitcnt vmcnt(0)" ::: "memory");
        } else {
            XB_SPIN(xb_ld(&bar[XB_XGEN(b.x)]) == gen, bar);
            __builtin_amdgcn_fence(__ATOMIC_ACQUIRE, "agent");
            asm volatile("s_waitcnt vmcnt(0)" ::: "memory");
        }
    }
    __syncthreads();
}

constexpr size_t WS_BAR = WS_END;
constexpr int LDS_ST_OFF = LDS_BYTES - 16;
struct KArgs { Params p; TJob jobs[11]; };
constexpr int N_PHASES = 15;
#ifndef PH_MASK
#define PH_MASK 0xFFFF
#endif
#ifndef DUP_MASK
#define DUP_MASK 0
#endif

__global__ void __launch_bounds__(512, 2) fwd_megakernel(KArgs ka) {
    extern __shared__ __attribute__((aligned(16))) unsigned char lds_raw[];
    LAS unsigned char* lds = (LAS unsigned char*)lds_raw;
    const Params& p = ka.p;
    const int bid = blockIdx.x, nblk = gridDim.x;
    unsigned char* ws = p.ws;
    const int lo = p.ph_lo, hi = p.ph_hi;
    if (threadIdx.x < 4) ((LAS unsigned*)(lds + LDS_ST_OFF))[threadIdx.x] = 0u;
    __syncthreads();
    if (hi > 1000) cg::this_grid().sync();
    XcdBarrier xbar = xcd_barrier_post((unsigned*)(ws + WS_BAR), (volatile LAS unsigned*)(lds + LDS_ST_OFF));
#define IN(k) ((PH_MASK & (1 << (k))) && lo <= (k) && (k) < hi)
#define SEAM(k) do { if (lo <= (k) && (k) + 1 < hi) xcd_barrier(xbar); } while (0)
    if (IN(0)) for (int rep = 0; rep <= ((DUP_MASK >> 0) & 1); ++rep) {
            bf16_t* aada = (bf16_t*)(ws + WS_AADA);
            for (int idx = bid * 512 + threadIdx.x; idx < 256 * 2048; idx += nblk * 512) { const int row = idx >> 11, col = idx & 2047;
                const float v = row < 4 ? siluf_(p.in[2][row * 2048 + col]) : (row < NB ? siluf_(p.in[3][(row - 4) * 2048 + col]) : 0.f); aada[idx] = f2bf(v); }
            transpose_jobs(ka.jobs, 1, bid, nblk, lds);
        }
    SEAM(0);
    if (IN(1)) for (int rep = 0; rep <= ((DUP_MASK >> 1) & 1); ++rep) {
            if (bid < 48) { pg8::Gemm g{(const bf16_t*)(ws + WS_AADA), (const bf16_t*)(ws + WS_PROJ), 2048, 2048, 2048, 0, 0, 0, 0, 0}; pg8::OneUnitOrder S{48, bid, 32}; pg8::EpiAda E{(float*)(ws + WS_MOD), p.in[8]}; pg8::gemm_phase(lds, g, S, E); }
            else { transpose_jobs(ka.jobs + 1, 1, bid - 48, nblk - 48, lds); transpose_jobs(ka.jobs + 4, 7, bid - 48, nblk - 48, lds); }
        }
    SEAM(1);
    if (IN(2)) for (int rep = 0; rep <= ((DUP_MASK >> 2) & 1); ++rep) norm_phase<0>(p, bid, nblk);
    SEAM(2);
    if (IN(3)) for (int rep = 0; rep <= ((DUP_MASK >> 3) & 1); ++rep) { pg8::Gemm g{(const bf16_t*)(ws + WS_U), (const bf16_t*)(ws + WS_WIN), 2048, 2048, 2048, 0, 0, 0, 0, 0}; pg8::StaticOrder S; S.init(TT, NPROJ, 2048, nblk, bid); pg8::EpiBf16 E{(bf16_t*)(ws + WS_PROJ), NPROJ, 0, nullptr}; pg8::gemm_phase(lds, g, S, E); }
    SEAM(3);
    if (IN(4)) for (int rep = 0; rep <= ((DUP_MASK >> 4) & 1); ++rep) mixer_prep_phase(p, bid, nblk);
    SEAM(4);
    if (IN(5)) for (int rep = 0; rep <= ((DUP_MASK >> 5) & 1); ++rep) chunk_prep_phase(p, bid, nblk, lds);
    SEAM(5);
    if (IN(6)) for (int rep = 0; rep <= ((DUP_MASK >> 6) & 1); ++rep) scan_phase(p, bid, nblk, lds);
    SEAM(6);
    if (IN(7)) for (int rep = 0; rep <= ((DUP_MASK >> 7) & 1); ++rep) { onorm_phase(p, bid, nblk);
            pg8::Gemm g{(const bf16_t*)(ws + WS_YP), (const bf16_t*)(ws + WS_PW), 1024, 256, 256, 512, 0, 0, 0, 0}; pg8::StaticOrder S; S.init(TT, 1024, 256, nblk, bid); pg8::EpiBf16 E{(bf16_t*)(ws + WS_U), DM, 1024, p.in[16]}; pg8::gemm_phase(lds, g, S, E);
            if (rep == 0) { if (nblk <= 136) transpose_jobs(ka.jobs + 3, 1, bid, nblk, lds); else if (bid >= 136) transpose_jobs(ka.jobs + 3, 1, bid - 136, nblk - 136, lds); } }
    SEAM(7);
    if (IN(8)) for (int rep = 0; rep <= ((DUP_MASK >> 8) & 1); ++rep) {
            pg8::Gemm g{(const bf16_t*)(ws + WS_U), (const bf16_t*)(ws + WS_WAB), 2048, 2048, 1024, 0, 2048, 2048, (size_t)128 * 2048 * 2, (size_t)128 * 2048 * 2}; pg8::StaticOrder S; S.init(68 * 256, 16 * 256, 1024, nblk, bid);
            pg8::EpiDiag E{(bf16_t*)(ws + WS_QN), (const bf16_t*)(ws + WS_PROJ)}; pg8::gemm_phase(lds, g, S, E);
            if (rep == 0) { const int nfull = 1088 % nblk; if (nfull == 0 || nfull >= nblk) transpose_jobs(ka.jobs + 2, 1, bid, nblk, lds); else if (bid >= nfull) transpose_jobs(ka.jobs + 2, 1, bid - nfull, nblk - nfull, lds); } }
    SEAM(9);
    if (IN(10)) for (int rep = 0; rep <= ((DUP_MASK >> 10) & 1); ++rep) { pg8::Gemm g{(const bf16_t*)(ws + WS_QN), (const bf16_t*)(ws + WS_WO), 2048, 2048, 2048, 0, 0, 0, 0, 0}; pg8::SplitOrder S{nblk, bid, 32, 4, 8}; pg8::EpiRes E{p.out + O_Y, p.in[0], p.in[1], (const float*)(ws + WS_MOD) + 4096, (float*)(ws + WS_PB10)}; pg8::gemm_phase(lds, g, S, E); }
    SEAM(10);
    if (IN(11)) for (int rep = 0; rep <= ((DUP_MASK >> 11) & 1); ++rep) norm_phase<1>(p, bid, nblk);
    SEAM(11);
    if (IN(12)) for (int rep = 0; rep <= ((DUP_MASK >> 12) & 1); ++rep) { pg8::Gemm g{(const bf16_t*)(ws + WS_U), (const bf16_t*)(ws + WS_WGU), 2048, 2048, 2048, 0, 0, 0, 0, 0}; pg8::StaticOrder S; S.init(TT, 11264, 2048, nblk, bid); pg8::EpiGU E{(bf16_t*)(ws + WS_PROJ)}; pg8::gemm_phase(lds, g, S, E); }
    SEAM(12);
    if (IN(13)) for (int rep = 0; rep <= ((DUP_MASK >> 13) & 1); ++rep) { pg8::Gemm g{(const bf16_t*)(ws + WS_PROJ), (const bf16_t*)(ws + WS_WD), DFF, DFF, DFF, 0, 0, 0, 0, 0}; pg8::SplitOrder S{nblk, bid, 88, 8, 11}; pg8::EpiRes E{p.out + O_Y, p.out + O_Y, p.out + O_Y + (size_t)TP * DM, (const float*)(ws + WS_MOD) + 10240, (float*)(ws + WS_PB13)}; pg8::gemm_phase(lds, g, S, E); }
    SEAM(13);
    if (IN(14)) for (int rep = 0; rep <= ((DUP_MASK >> 14) & 1); ++rep) norm_phase<2>(p, bid, nblk);
    SEAM(14);
}

extern "C" void kernel_launch(void* const* d_in, const int* in_sizes, int n_in, void* d_out, int out_size, void* d_ws, size_t ws_size, hipStream_t stream) {
    static int grid = 0;
    if (grid == 0) {
        if (n_in != 24 || ws_size < WS_BAR + XCD_BAR_WORDS * 4) { fprintf(stderr, "kernel_launch: unexpected n_in %d / ws_size %zu (need %zu)\n", n_in, ws_size, (size_t)WS_END); grid = -1; return; }
        int dev = 0, cus = 0, per_cu = 0;
        hipGetDevice(&dev); hipDeviceGetAttribute(&cus, hipDeviceAttributeMultiprocessorCount, dev);
        if (hipFuncSetAttribute((const void*)fwd_megakernel, hipFuncAttributeMaxDynamicSharedMemorySize, LDS_BYTES) != hipSuccess) { fprintf(stderr, "kernel_launch: hipFuncSetAttribute failed\n"); grid = -1; return; }
        if (hipOccupancyMaxActiveBlocksPerMultiprocessor(&per_cu, (const void*)fwd_megakernel, 512, LDS_BYTES) != hipSuccess || per_cu < 1) { fprintf(stderr, "kernel_launch: occupancy query says %d\n", per_cu); per_cu = 1; }
        (void)hipGetLastError();
        grid = cus > 0 ? cus : 256;
        if (grid < 64) grid = 64;
    }
    if (grid < 0) return;
    if (hipMemsetAsync((unsigned char*)d_ws + WS_BAR, 0, XCD_BAR_WORDS * 4, stream) != hipSuccess) { fprintf(stderr, "kernel_launch: memset failed\n"); return; }
    KArgs ka; memset(&ka, 0, sizeof(ka));
    for (int i = 0; i < 24; ++i) ka.p.in[i] = (const float*)d_in[i];
    ka.p.out = (float*)d_out; ka.p.ws = (unsigned char*)d_ws;
    unsigned char* ws = (unsigned char*)d_ws;
    auto setjob = [&](int i, const void* src, void* dst, int ld_src, int K, int Nout, int ld_dst, int map) { TJob& j = ka.jobs[i]; j.src = (const float*)src; j.dst = (bf16_t*)dst; j.ld_src = ld_src; j.K = K; j.Nout = Nout; j.ld_dst = ld_dst; j.map = map; j.pad = 0; };
    setjob(0, d_in[7], ws + WS_PROJ, MODW, 2048, MODW, 2048, 0);
    setjob(1, d_in[10], ws + WS_WIN, 9232, 2048, NPROJ, 2048, 1);
    setjob(2, d_in[21], ws + WS_WGU, 2 * DFF, 2048, 2 * DFF, 2048, 2);
    setjob(3, d_in[22], ws + WS_WD, 2048, DFF, 2048, DFF, 0);
    setjob(4, d_in[19], ws + WS_WO, 2048, 2048, 2048, 2048, 0);
    setjob(5, d_in[17], ws + WS_WAB, 2048, 1024, 2048, 2048, 0);
    setjob(6, d_in[18], ws + WS_WAB + 1024 * 2, 2048, 1024, 2048, 2048, 0);
    for (int g = 0; g < 4; ++g) setjob(7 + g, (const float*)d_in[15] + g * 65536, ws + WS_PW + (size_t)g * 65536 * 2, 256, 256, 256, 256, 0);
#if MK_PER_PHASE
    for (int ph = 0; ph < N_PHASES; ++ph) { ka.p.ph_lo = ph; ka.p.ph_hi = ph + 1; hipLaunchKernelGGL(fwd_megakernel, dim3(grid), dim3(512), LDS_BYTES, stream, ka); }
#else
    ka.p.ph_lo = 0; ka.p.ph_hi = N_PHASES;
    void* args[] = {&ka};
    hipError_t e = hipLaunchCooperativeKernel((const void*)fwd_megakernel, dim3(grid), dim3(512), args, LDS_BYTES, stream);
    if (e != hipSuccess) fprintf(stderr, "cooperative launch failed: %s (grid %d)\n", hipGetErrorString(e), grid);
#endif
}
```

```cpp
#include <hip/hip_runtime.h>
#include <hip/hip_cooperative_groups.h>
#include <cstdio>
#include <cstring>
namespace cg = cooperative_groups;

#ifndef MK_PER_PHASE
#define MK_PER_PHASE 0
#endif

#define LAS __attribute__((address_space(3)))
typedef unsigned short bf16_t;
typedef short bf16x8 __attribute__((ext_vector_type(8)));
typedef float f32x4 __attribute__((ext_vector_type(4)));
typedef float f32x2 __attribute__((ext_vector_type(2)));
typedef unsigned u32x4 __attribute__((ext_vector_type(4)));
typedef unsigned u32x2 __attribute__((ext_vector_type(2)));

constexpr int DM = 2048, TP = 8192, TS = 512, TT = 8704, NB = 132;
constexpr int NPROJ = 9472;
constexpr int DFF = 5632;
constexpr int MODW = 12288;
constexpr float EPS = 1e-6f;
constexpr int C_Q = 0, C_K = 1024, C_V = 2048, C_Z = 3072, C_XP = 4096, C_GA = 5120, C_GB = 7168, C_AB = 9216;
constexpr size_t O_Y = 0, O_DP = 17825792, O_CP = 18350080, O_PP = 18386944, O_DS = 18448384, O_CS = 35225600, O_PS = 36405248;
constexpr size_t OS_O = 0, OS_UB = 8912896;
constexpr size_t WS_WIN = 0;
constexpr size_t WS_WGU = WS_WIN + (size_t)NPROJ * 2048 * 2;
constexpr size_t WS_WD = WS_WGU + (size_t)11264 * 2048 * 2;
constexpr size_t WS_WO = WS_WD + (size_t)2048 * 5632 * 2;
constexpr size_t WS_WAB = WS_WO + (size_t)2048 * 2048 * 2;
constexpr size_t WS_PW = WS_WAB + (size_t)2048 * 2048 * 2;
constexpr size_t WS_AADA = WS_PW + (size_t)1024 * 256 * 2;
constexpr size_t WS_MOD = WS_AADA + (size_t)256 * 2048 * 2;
constexpr size_t WS_G = WS_MOD + (size_t)NB * MODW * 4;
constexpr size_t WS_BETA = WS_G + (size_t)TT * 8 * 4;
constexpr size_t WS_CD = WS_BETA + (size_t)TT * 8 * 4;
constexpr size_t WS_U = WS_CD + 4096;
constexpr size_t WS_QN = WS_U + (size_t)TT * 2048 * 2;
constexpr size_t WS_KN = WS_QN + (size_t)TT * 1024 * 2;
constexpr size_t WS_VV = WS_KN + (size_t)TT * 1024 * 2;
constexpr size_t WS_YP = WS_VV + (size_t)TT * 1024 * 2;
constexpr size_t WS_WDC = WS_YP + (size_t)TT * 1024 * 2;
constexpr size_t WS_QD = WS_WDC + (size_t)1024 * 64 * 128 * 2;
constexpr size_t WS_KT = WS_QD + (size_t)1024 * 64 * 128 * 2;
constexpr size_t WS_QK = WS_KT + (size_t)1024 * 64 * 128 * 2;
constexpr size_t WS_PROJ = WS_QK + (size_t)1024 * 64 * 64 * 2;
constexpr size_t WS_END = WS_PROJ + (size_t)TT * NPROJ * 2;
constexpr size_t WS_PB10 = WS_PROJ;
constexpr size_t WS_PB13 = WS_PROJ + (size_t)TT * DFF * 2;
static_assert(WS_PB13 + (size_t)11 * TS * DM * 4 <= WS_END && (WS_PB13 % 256) == 0, "partials");
static_assert(WS_END + 16384 <= 501510720ull, "workspace too large");
static_assert((WS_PROJ % 256) == 0 && (WS_QK % 256) == 0 && (WS_U % 256) == 0, "align");

constexpr int LDS_BYTES = 147456;

struct Params {
    const float* in[24];
    float* out;
    unsigned char* ws;
    int ph_lo, ph_hi;
};

__device__ __forceinline__ float bf2f(unsigned short x) { return __uint_as_float(((unsigned)x) << 16); }
__device__ __forceinline__ unsigned short f2bf(float f) { unsigned u = __float_as_uint(f); u += 0x7FFFu + ((u >> 16) & 1u); return (unsigned short)(u >> 16); }
typedef __bf16 bf16x2_hw __attribute__((ext_vector_type(2)));
__device__ __forceinline__ unsigned pk2(float lo, float hi) { const f32x2 v = {lo, hi}; const bf16x2_hw b = __builtin_convertvector(v, bf16x2_hw); return __builtin_bit_cast(unsigned, b); }
__device__ __forceinline__ void unpack8(const u32x4 w, float* f) {
    f[0] = __uint_as_float(w.x << 16); f[1] = __uint_as_float(w.x & 0xffff0000u);
    f[2] = __uint_as_float(w.y << 16); f[3] = __uint_as_float(w.y & 0xffff0000u);
    f[4] = __uint_as_float(w.z << 16); f[5] = __uint_as_float(w.z & 0xffff0000u);
    f[6] = __uint_as_float(w.w << 16); f[7] = __uint_as_float(w.w & 0xffff0000u);
}
__device__ __forceinline__ u32x4 pack8(const float* f) { u32x4 w; w.x = pk2(f[0], f[1]); w.y = pk2(f[2], f[3]); w.z = pk2(f[4], f[5]); w.w = pk2(f[6], f[7]); return w; }
__device__ __forceinline__ float sigmoidf_(float x) { return 1.0f / (1.0f + __expf(-x)); }
__device__ __forceinline__ float siluf_(float x) { return x / (1.0f + __expf(-x)); }
__device__ __forceinline__ int bidx_of_row(int row) { return row < TP ? (row >> 11) : 4 + ((row - TP) >> 2); }

namespace pg8 {
constexpr int BM = 256, BK = 64, HALF = 128, HTB = HALF * BK * 2, STAGE_BYTES = 8 * HTB, NXCD = 8, WGM = 8;
__host__ __device__ __forceinline__ int lds_byte(int r, int c) { const int st = (r >> 4) * 2 + (c >> 5), rr = r & 15, cc = c & 31, ob = rr * 64 + cc * 2; return st * 1024 + (ob ^ (((ob >> 9) & 1) << 5)); }
__host__ __device__ __forceinline__ void stage_rc(int b, int& R, int& C) { const int st = b / 1024, sb = b % 1024, swz = sb ^ (((sb >> 9) & 1) << 5); R = (st >> 1) * 16 + swz / 64; C = (st & 1) * 32 + (swz % 64) / 2; }
__host__ __device__ __forceinline__ int perm32(int rho) { const int n = rho >> 4, i = rho & 15; return 8 * (i >> 2) + 4 * n + (i & 3); }

struct Unit { int pm, pn, kt0, nkt, piece; };
struct Gemm { const bf16_t* A; const bf16_t* Bt; int lda, ldb, K; size_t a_pn_off; size_t a_half, b_half, a_tile, b_tile; };

__device__ __forceinline__ void tile_of(int wgid, int nM, int nN, Unit& u) {
    const int nwg = nM * nN;
    { const int q = nwg / NXCD, r = nwg % NXCD, xcd = wgid % NXCD, off = wgid / NXCD; wgid = (xcd < r ? xcd * (q + 1) : r * (q + 1) + (xcd - r) * q) + off; }
    const int nig = WGM * nN, gid = wgid / nig, fm = gid * WGM, gsz = (nM - fm) < WGM ? (nM - fm) : WGM;
    u.pm = fm + ((wgid % nig) % gsz); u.pn = (wgid % nig) / gsz;
}
struct StaticOrder {
    int nM, nN, nwg, G, c, ntk;
    __device__ __forceinline__ void init(int M, int N, int K, int G_, int c_) { nM = M / BM; nN = N / BM; nwg = nM * nN; G = G_; c = c_; ntk = K / BK; }
    __device__ __forceinline__ bool next(int i, Unit& u) const {
        const long L = (long)i * G + c; if (L >= nwg) return false;
        tile_of((int)L, nM, nN, u); u.kt0 = 0; u.nkt = ntk; u.piece = -1; return true;
    }
};
struct OneUnitOrder {
    int n, c, ntk;
    __device__ __forceinline__ bool next(int i, Unit& u) const { if (i != 0 || c >= n) return false; u.pm = 0; u.pn = c; u.kt0 = 0; u.nkt = ntk; u.piece = -1; return true; }
};
struct DoubleOrder {
    int G, c;
    __device__ __forceinline__ bool next(int i, Unit& u) const {
        const int L = (i >> 1) * G + c, half = i & 1; const bool ok = L < 272;
        tile_of(ok ? L : 0, 34, 8, u); u.kt0 = 16 * half; u.nkt = 16; u.piece = half; return ok;
    }
};
struct SplitOrder {
    int G, c, ntk, pk, npc;
    __device__ __forceinline__ bool next(int i, Unit& u) const {
        const int L = i * G + c;
        const bool full = L < 256;
        int fpm, fpn;
        { int wgid = full ? L : 0; const int xcd = wgid % NXCD, off = wgid / NXCD; wgid = xcd * 32 + off;
          const int nig = WGM * 8, gid = wgid / nig, fm = gid * WGM; fpm = fm + ((wgid % nig) % WGM); fpn = (wgid % nig) / WGM; }
        const int pidx = full ? 0 : L - 256, tile = pidx / npc, pc = pidx - tile * npc;
        u.pm = full ? fpm : 32 + (tile >> 3); u.pn = full ? fpn : (tile & 7); u.kt0 = full ? 0 : pc * pk; u.nkt = full ? ntk : pk; u.piece = full ? -1 : pc;
        return full || pidx < 16 * npc;
    }
};

template <class Epi, class Sched>
__device__ __forceinline__ void gemm_phase(LAS unsigned char* lds, const Gemm g, const Sched& S, const Epi& E) {
    const int tid = threadIdx.x, wid = __builtin_amdgcn_readfirstlane(tid >> 6), lane = tid & 63, wr = wid >> 2, wc = wid & 3, fr = lane & 15, fq = lane >> 4;
    unsigned voffA[2], voffB[2];
#pragma unroll
    for (int i = 0; i < 2; ++i) { int R, C; stage_rc(tid * 16 + i * 8192, R, C); const int Rb = Epi::PERM ? ((R & ~31) + perm32(R & 31)) : R;
        voffA[i] = (unsigned)(R * g.lda + C) * 2u; voffB[i] = (unsigned)(Rb * g.ldb + C) * 2u; }
    const size_t kstep = (size_t)(BK * 2);
    const size_t hstepA = g.a_half ? g.a_half : (size_t)HALF * g.lda * 2, hstepB = g.b_half ? g.b_half : (size_t)HALF * g.ldb * 2;
    const size_t tstepA = g.a_tile ? g.a_tile : (size_t)BM * g.lda * 2, tstepB = g.b_tile ? g.b_tile : (size_t)BM * g.ldb * 2;
    const unsigned ldsw = (unsigned)wid * 1024u;
    const int aoff = lds_byte(wr * 64 + fr, fq * 8), boff = lds_byte(wc * 32 + fr, fq * 8);
#define PG8_SA(b, h) (((b) * 2 + (h)) * HTB)
#define PG8_SB(b, h) ((4 + (b) * 2 + (h)) * HTB)
#define PG8_STAGE(bufoff, gbase, voff) do { _Pragma("unroll") for (int _i = 0; _i < 2; ++_i) \
        __builtin_amdgcn_global_load_lds((const unsigned*)((const char*)(gbase) + (voff)[_i]), (LAS unsigned*)(lds + (bufoff) + ldsw + _i * 8192), 16, 0, 0); } while (0)
#define PG8_LDA(dst, b, h) do { _Pragma("unroll") for (int m = 0; m < 4; ++m) _Pragma("unroll") for (int k = 0; k < 2; ++k) dst[m][k] = *(const LAS bf16x8*)(lds + PG8_SA(b, h) + aoff + m * 2048 + k * 1024); } while (0)
#define PG8_LDB(dst, b, h) do { _Pragma("unroll") for (int n = 0; n < 2; ++n) _Pragma("unroll") for (int k = 0; k < 2; ++k) dst[n][k] = *(const LAS bf16x8*)(lds + PG8_SB(b, h) + boff + n * 2048 + k * 1024); } while (0)
#define PG8_MMA(ai, bj, At, Bt) do { __builtin_amdgcn_s_setprio(1); _Pragma("unroll") for (int m = 0; m < 4; ++m) _Pragma("unroll") for (int n = 0; n < 2; ++n) _Pragma("unroll") for (int k = 0; k < 2; ++k) \
        acc[ai][bj][m][n] = __builtin_amdgcn_mfma_f32_16x16x32_bf16(Bt[n][k], At[m][k], acc[ai][bj][m][n], 0, 0, 0); __builtin_amdgcn_s_setprio(0); } while (0)
#define PG8_WAIT_V(n) asm volatile("s_waitcnt vmcnt(" #n ")" ::: "memory")
#define PG8_WAIT_L(n) asm volatile("s_waitcnt lgkmcnt(" #n ")" ::: "memory")
#define PG8_BAR __builtin_amdgcn_s_barrier()
#define PG8_SCHED __builtin_amdgcn_sched_barrier(0)
    Unit cur, nxt; int ui = 0;
    if (!S.next(0, cur)) return;
    f32x4 acc[2][2][4][2];
#pragma unroll
    for (int a = 0; a < 2; ++a)
#pragma unroll
        for (int b = 0; b < 2; ++b)
#pragma unroll
            for (int m = 0; m < 4; ++m)
#pragma unroll
                for (int n = 0; n < 2; ++n) acc[a][b][m][n] = (f32x4){0.f, 0.f, 0.f, 0.f};
    bf16x8 At[4][2], B0[2][2], B1[2][2];
    const char* cA = (const char*)g.A + (size_t)cur.pm * tstepA + (size_t)cur.pn * g.a_pn_off + (size_t)cur.kt0 * kstep; const char* cB = (const char*)g.Bt + (size_t)cur.pn * tstepB + (size_t)cur.kt0 * kstep;
    PG8_STAGE(PG8_SB(0, 0), cB, voffB); PG8_STAGE(PG8_SA(0, 0), cA, voffA); PG8_STAGE(PG8_SB(0, 1), cB + hstepB, voffB); PG8_STAGE(PG8_SA(0, 1), cA + hstepA, voffA);
    if (wr == 1) PG8_BAR;
    PG8_WAIT_V(4); PG8_BAR;
    PG8_STAGE(PG8_SB(1, 0), cB + kstep, voffB); PG8_STAGE(PG8_SA(1, 0), cA + kstep, voffA); PG8_STAGE(PG8_SB(1, 1), cB + hstepB + kstep, voffB);
    PG8_WAIT_V(6); PG8_BAR;
    for (;;) {
        const bool has_next = S.next(ui + 1, nxt);
        const char* nA = has_next ? (const char*)g.A + (size_t)nxt.pm * tstepA + (size_t)nxt.pn * g.a_pn_off + (size_t)nxt.kt0 * kstep : cA; const char* nB = has_next ? (const char*)g.Bt + (size_t)nxt.pn * tstepB + (size_t)nxt.kt0 * kstep : cB;
        const int nt = cur.nkt;
#pragma unroll 1
        for (int t = 0; t < nt; t += 2) {
            const bool last = (t == nt - 2);
            const char* a1 = cA + (size_t)(t + 1) * kstep;
            const char* a2 = last ? nA : cA + (size_t)(t + 2) * kstep; const char* b2 = last ? nB : cB + (size_t)(t + 2) * kstep;
            const char* a3 = a2 + kstep; const char* b3 = b2 + kstep;
            PG8_LDB(B0, 0, 0); PG8_SCHED; PG8_LDA(At, 0, 0); PG8_STAGE(PG8_SA(1, 1), a1 + hstepA, voffA);
            PG8_WAIT_L(8); PG8_BAR; PG8_WAIT_L(0); PG8_MMA(0, 0, At, B0); PG8_BAR; PG8_SCHED;
            PG8_LDB(B1, 0, 1); PG8_STAGE(PG8_SB(0, 0), b2, voffB);
            PG8_BAR; PG8_WAIT_L(0); if constexpr (!Epi::DIAG) PG8_MMA(0, 1, At, B1); PG8_BAR;
            PG8_LDA(At, 0, 1); PG8_STAGE(PG8_SA(0, 0), a2, voffA);
            PG8_BAR; PG8_WAIT_L(0); if constexpr (!Epi::DIAG) PG8_MMA(1, 0, At, B0); PG8_BAR; PG8_SCHED;
            PG8_STAGE(PG8_SB(0, 1), b2 + hstepB, voffB);
            PG8_WAIT_V(6); PG8_BAR; PG8_MMA(1, 1, At, B1); PG8_BAR;
            PG8_LDB(B0, 1, 0); PG8_SCHED; PG8_LDA(At, 1, 0); PG8_STAGE(PG8_SA(0, 1), a2 + hstepA, voffA);
            PG8_WAIT_L(8); PG8_BAR; PG8_WAIT_L(0); PG8_MMA(0, 0, At, B0); PG8_BAR; PG8_SCHED;
            PG8_LDB(B1, 1, 1); PG8_STAGE(PG8_SB(1, 0), b3, voffB);
            PG8_BAR; PG8_WAIT_L(0); if constexpr (!Epi::DIAG) PG8_MMA(0, 1, At, B1); PG8_BAR;
            PG8_LDA(At, 1, 1); PG8_STAGE(PG8_SA(1, 0), a3, voffA);
            PG8_BAR; PG8_WAIT_L(0); if constexpr (!Epi::DIAG) PG8_MMA(1, 0, At, B0); PG8_BAR; PG8_SCHED;
            PG8_STAGE(PG8_SB(1, 1), b3 + hstepB, voffB);
            PG8_WAIT_V(6); PG8_BAR; PG8_MMA(1, 1, At, B1); PG8_BAR;
        }
        E(acc, cur, wr, wc, fr, fq);
        if (!has_next) break;
#pragma unroll
        for (int a = 0; a < 2; ++a)
#pragma unroll
            for (int b = 0; b < 2; ++b)
#pragma unroll
                for (int m = 0; m < 4; ++m)
#pragma unroll
                    for (int n = 0; n < 2; ++n) acc[a][b][m][n] = (f32x4){0.f, 0.f, 0.f, 0.f};
        cur = nxt; cA = nA; cB = nB; ++ui;
    }
    PG8_WAIT_V(0);
    if (wr == 0) PG8_BAR;
    PG8_BAR;
#undef PG8_SA
#undef PG8_SB
#undef PG8_STAGE
#undef PG8_LDA
#undef PG8_LDB
#undef PG8_MMA
#undef PG8_WAIT_V
#undef PG8_WAIT_L
#undef PG8_BAR
#undef PG8_SCHED
}

typedef f32x4 Acc[2][2][4][2];

struct EpiAda {
    static constexpr bool PERM = false, MID = false, DIAG = false;
    float* C; const float* bias;
    __device__ __forceinline__ void operator()(const Acc& acc, const Unit& u, int wr, int wc, int fr, int fq) const {
        const int row0 = wr * 64 + fr, col0 = u.pn * BM + wc * 32 + 4 * fq;
#pragma unroll
        for (int ai = 0; ai < 2; ++ai)
#pragma unroll
            for (int m = 0; m < 4; ++m) { const int row = row0 + ai * HALF + m * 16; if (row < NB) {
#pragma unroll
                for (int bj = 0; bj < 2; ++bj)
#pragma unroll
                    for (int n = 0; n < 2; ++n) { const int c = col0 + bj * HALF + n * 16; *(f32x4*)(C + (size_t)row * MODW + c) = acc[ai][bj][m][n] + *(const f32x4*)(bias + c); } } }
    }
};
struct EpiBf16 {
    static constexpr bool PERM = true, MID = false, DIAG = false;
    bf16_t* O; int ldc; int col_off; const float* scale;
    __device__ __forceinline__ void operator()(const Acc& acc, const Unit& u, int wr, int wc, int fr, int fq) const {
        const int row0 = u.pm * BM + wr * 64 + fr, col0 = u.pn * BM + wc * 32 + 8 * fq;
#pragma unroll
        for (int ai = 0; ai < 2; ++ai)
#pragma unroll
            for (int m = 0; m < 4; ++m) { bf16_t* rowp = O + (size_t)(row0 + ai * HALF + m * 16) * ldc + col_off + col0;
#pragma unroll
                for (int bj = 0; bj < 2; ++bj) { f32x4 v0 = acc[ai][bj][m][0], v1 = acc[ai][bj][m][1];
                    if (scale) { v0 *= *(const f32x4*)(scale + col0 + bj * HALF); v1 *= *(const f32x4*)(scale + col0 + bj * HALF + 4); }
                    u32x4 w; w.x = pk2(v0[0], v0[1]); w.y = pk2(v0[2], v0[3]); w.z = pk2(v1[0], v1[1]); w.w = pk2(v1[2], v1[3]);
                    *(u32x4*)(rowp + bj * HALF) = w; }
                if (scale) asm volatile("" ::: "memory"); }
    }
};
struct EpiG1 {
    static constexpr bool PERM = true, MID = false, DIAG = false;
    float* T1; const bf16_t* proj;
    __device__ __forceinline__ void operator()(const Acc& acc, const Unit& u, int wr, int wc, int fr, int fq) const {
        const int row0 = u.pm * BM + wr * 64 + fr, col0 = u.pn * BM + wc * 32 + 8 * fq;
#pragma unroll
        for (int ai = 0; ai < 2; ++ai)
#pragma unroll
            for (int m = 0; m < 4; ++m) { const size_t row = (size_t)(row0 + ai * HALF + m * 16); const bf16_t* pr = proj + row * NPROJ + col0;
#pragma unroll
                for (int bj = 0; bj < 2; ++bj) { float ga[8]; unpack8(*(const u32x4*)(pr + C_GA + bj * HALF), ga); f32x4 v0, v1;
#pragma unroll
                    for (int j = 0; j < 4; ++j) { v0[j] = acc[ai][bj][m][0][j] * __builtin_amdgcn_rcpf(1.0f + __expf(-ga[j])); v1[j] = acc[ai][bj][m][1][j] * __builtin_amdgcn_rcpf(1.0f + __expf(-ga[4 + j])); }
                    float* o = T1 + row * DM + col0 + bj * HALF; *(f32x4*)o = v0; *(f32x4*)(o + 4) = v1; }
                }
    }
};
struct EpiG2 {
    static constexpr bool PERM = true, MID = false, DIAG = false;
    bf16_t* O; const float* T1; const bf16_t* proj;
    __device__ __forceinline__ void operator()(const Acc& acc, const Unit& u, int wr, int wc, int fr, int fq) const {
        const int row0 = u.pm * BM + wr * 64 + fr, col0 = u.pn * BM + wc * 32 + 8 * fq;
#pragma unroll
        for (int ai = 0; ai < 2; ++ai)
#pragma unroll
            for (int m = 0; m < 4; ++m) { const size_t row = (size_t)(row0 + ai * HALF + m * 16); const bf16_t* pr = proj + row * NPROJ + col0;
#pragma unroll
                for (int bj = 0; bj < 2; ++bj) { float gb[8], v[8]; unpack8(*(const u32x4*)(pr + C_GB + bj * HALF), gb);
                    const float* t = T1 + row * DM + col0 + bj * HALF; const f32x4 t0 = *(const f32x4*)t, t1 = *(const f32x4*)(t + 4);
#pragma unroll
                    for (int j = 0; j < 4; ++j) { v[j] = t0[j] + acc[ai][bj][m][0][j] * __builtin_amdgcn_rcpf(1.0f + __expf(-gb[j])); v[4 + j] = t1[j] + acc[ai][bj][m][1][j] * __builtin_amdgcn_rcpf(1.0f + __expf(-gb[4 + j])); }
                    *(u32x4*)(O + row * DM + col0 + bj * HALF) = pack8(v); }
                if (m & 1) asm volatile("" ::: "memory"); }
    }
};
struct EpiG12 {
    static constexpr bool PERM = true, MID = false, DIAG = false;
    EpiG1 e1; EpiG2 e2;
    __device__ __forceinline__ void operator()(const Acc& acc, const Unit& u, int wr, int wc, int fr, int fq) const { if (u.piece == 0) e1(acc, u, wr, wc, fr, fq); else e2(acc, u, wr, wc, fr, fq); }
};
struct EpiDiag {
    static constexpr bool PERM = true, MID = false, DIAG = true;
    bf16_t* O; const bf16_t* proj;
    __device__ __forceinline__ void operator()(const Acc& acc, const Unit& u, int wr, int wc, int fr, int fq) const {
        const int row0 = u.pm * HALF + wr * 64 + fr, col0 = u.pn * HALF + wc * 32 + 8 * fq;
#pragma unroll
        for (int m = 0; m < 4; ++m) { const size_t row = (size_t)(row0 + m * 16); const bf16_t* pr = proj + row * NPROJ + col0;
            float ga[8], gb[8], v[8]; unpack8(*(const u32x4*)(pr + C_GA), ga); unpack8(*(const u32x4*)(pr + C_GB), gb);
#pragma unroll
            for (int n = 0; n < 2; ++n)
#pragma unroll
                for (int j = 0; j < 4; ++j) v[4 * n + j] = acc[0][0][m][n][j] * __builtin_amdgcn_rcpf(1.0f + __expf(-ga[4 * n + j])) + acc[1][1][m][n][j] * __builtin_amdgcn_rcpf(1.0f + __expf(-gb[4 * n + j]));
            *(u32x4*)(O + row * DM + col0) = pack8(v); }
    }
};
struct EpiRes {
    static constexpr bool PERM = false, MID = false, DIAG = false;
    float* X1; const float* x0p; const float* x0s; const float* gate; float* PB;
    __device__ __forceinline__ void operator()(const Acc& acc, const Unit& u, int wr, int wc, int fr, int fq) const {
        const int row0 = u.pm * BM + wr * 64 + fr, col0 = u.pn * BM + wc * 32 + 4 * fq;
        if (u.piece >= 0) {
            float* pb = PB + (size_t)u.piece * TS * DM;
#pragma unroll
            for (int ai = 0; ai < 2; ++ai)
#pragma unroll
                for (int m = 0; m < 4; ++m) { float* orow = pb + (size_t)(row0 + ai * HALF + m * 16 - TP) * DM;
#pragma unroll
                    for (int bj = 0; bj < 2; ++bj)
#pragma unroll
                        for (int n = 0; n < 2; ++n) *(f32x4*)(orow + col0 + bj * HALF + n * 16) = acc[ai][bj][m][n]; }
            return;
        }
#pragma unroll
        for (int ai = 0; ai < 2; ++ai)
#pragma unroll
            for (int m = 0; m < 4; ++m) { const int row = row0 + ai * HALF + m * 16; const int b = bidx_of_row(row);
                const float* xr = (row < TP) ? x0p + (size_t)row * DM : x0s + (size_t)(row - TP) * DM; const float* gr = gate + (size_t)b * MODW; float* orow = X1 + (size_t)row * DM;
#pragma unroll
                for (int bj = 0; bj < 2; ++bj)
#pragma unroll
                    for (int n = 0; n < 2; ++n) { const int c = col0 + bj * HALF + n * 16; const f32x4 xv = *(const f32x4*)(xr + c), gv = *(const f32x4*)(gr + c);
                        *(f32x4*)(orow + c) = xv + gv * acc[ai][bj][m][n]; } }
    }
};
struct EpiGU {
    static constexpr bool PERM = true, MID = false, DIAG = false;
    bf16_t* O;
    __device__ __forceinline__ void operator()(const Acc& acc, const Unit& u, int wr, int wc, int fr, int fq) const {
        const int row0 = u.pm * BM + wr * 64 + fr, col0 = u.pn * HALF + wc * 32 + 8 * fq;
#pragma unroll
        for (int ai = 0; ai < 2; ++ai)
#pragma unroll
            for (int m = 0; m < 4; ++m) { float v[8];
#pragma unroll
                for (int n = 0; n < 2; ++n)
#pragma unroll
                    for (int j = 0; j < 4; ++j) { const float gt = acc[ai][0][m][n][j]; v[4 * n + j] = gt * __builtin_amdgcn_rcpf(1.0f + __expf(-gt)) * acc[ai][1][m][n][j]; }
                *(u32x4*)(O + (size_t)(row0 + ai * HALF + m * 16) * DFF + col0) = pack8(v); }
    }
};
}

struct TJob { const float* src; bf16_t* dst; int ld_src, K, Nout, ld_dst, map, pad; };
__device__ __forceinline__ int map_col(int map, int n) {
    if (map == 1) { if (n < 4096) return n; if (n < 5120) return 4112 + (n - 4096); if (n < 9216) return 5136 + (n - 5120); if (n < 9232) return 4096 + (n - 9216); return -1; }
    if (map == 2) { const int pn = n >> 8, w = n & 255; return w < 128 ? 128 * pn + w : DFF + 128 * pn + (w - 128); }
    return n;
}
__device__ __forceinline__ void tjob_load(const TJob& j, int tile, f32x4 (&v)[4]) {
    const int tid = threadIdx.x, nkt = j.K >> 7, tn = tile / nkt, tk = tile - tn * nkt;
    const int n = tn * 64 + (tid & 15) * 4, kr = tid >> 4, col = map_col(j.map, n);
#pragma unroll
    for (int i = 0; i < 4; ++i) v[i] = col >= 0 ? __builtin_nontemporal_load((const f32x4*)(j.src + (size_t)(tk * 128 + kr + 32 * i) * j.ld_src + col)) : (f32x4){0.f, 0.f, 0.f, 0.f};
}
__device__ __forceinline__ void tjob_store(const TJob& j, int tile, const f32x4 (&v)[4], LAS float* s) {
    const int tid = threadIdx.x, nkt = j.K >> 7, tn = tile / nkt, tk = tile - tn * nkt;
    const int nq = tid & 15, kr = tid >> 4;
    __syncthreads();
#pragma unroll
    for (int i = 0; i < 4; ++i)
#pragma unroll
        for (int q = 0; q < 4; ++q) s[(4 * nq + q) * 129 + kr + 32 * i] = v[i][q];
    __syncthreads();
    const int n = tid >> 3, k16 = (tid & 7) * 16;
    float f[16];
#pragma unroll
    for (int i = 0; i < 16; ++i) f[i] = s[n * 129 + k16 + i];
    bf16_t* d = j.dst + (size_t)(tn * 64 + n) * j.ld_dst + tk * 128 + k16;
    *(u32x4*)d = pack8(f); *(u32x4*)(d + 8) = pack8(f + 8);
}
__device__ __forceinline__ void transpose_jobs(const TJob* jobs, int njobs, int bi, int nblk, LAS unsigned char* lds) {
    LAS float* s = (LAS float*)lds;
    int total = 0;
    for (int q = 0; q < njobs; ++q) total += (jobs[q].Nout >> 6) * (jobs[q].K >> 7);
    f32x4 v[4]; int curj = 0, base = 0;
    int t = bi;
    auto locate = [&](int tt, int& jj, int& bb) { while (tt >= bb + (jobs[jj].Nout >> 6) * (jobs[jj].K >> 7)) { bb += (jobs[jj].Nout >> 6) * (jobs[jj].K >> 7); ++jj; } };
    if (t < total) { locate(t, curj, base); tjob_load(jobs[curj], t - base, v); }
    while (t < total) {
        const int tn = t + nblk; int nj = curj, nb = base; f32x4 w[4];
        if (tn < total) { locate(tn, nj, nb); tjob_load(jobs[nj], tn - nb, w); }
        tjob_store(jobs[curj], t - base, v, s);
        if (tn < total) {
#pragma unroll
            for (int i = 0; i < 4; ++i) v[i] = w[i]; }
        t = tn; curj = nj; base = nb;
    }
    __syncthreads();
}

template <int MODE>
__device__ __forceinline__ void norm_phase(const Params& p, int bid, int nblk) {
    const int lane = threadIdx.x & 63, wid = __builtin_amdgcn_readfirstlane(threadIdx.x >> 6);
    const float* mod = (const float*)(p.ws + WS_MOD);
    const float* gain = MODE == 0 ? p.in[9] : (MODE == 1 ? p.in[20] : p.in[23]);
    bf16_t* U = (bf16_t*)(p.ws + WS_U);
    for (int row = bid * 8 + wid; row < TT; row += nblk * 8) {
        const float* src = MODE == 0 ? (row < TP ? p.in[0] + (size_t)row * DM : p.in[1] + (size_t)(row - TP) * DM) : p.out + O_Y + (size_t)row * DM;
        if (MODE != 0 && row >= TP) {
            const float* xs = p.in[1] + (size_t)(row - TP) * DM;
            const float* pb = (const float*)(p.ws + (MODE == 1 ? WS_PB10 : WS_PB13)) + (size_t)(row - TP) * DM;
            const float* gt = mod + (size_t)bidx_of_row(row) * MODW + (MODE == 1 ? 4096 : 10240);
            float* xo = p.out + O_Y + (size_t)row * DM;
            constexpr int NPC = MODE == 1 ? 8 : 11;
#pragma unroll 1
            for (int i = 0; i < 8; ++i) { const int c = i * 256 + lane * 4; f32x4 s = *(const f32x4*)(pb + c);
#pragma unroll
                for (int q = 1; q < NPC; ++q) s += *(const f32x4*)(pb + (size_t)q * TS * DM + c);
                const f32x4 base = MODE == 1 ? *(const f32x4*)(xs + c) : *(const f32x4*)(xo + c);
                *(f32x4*)(xo + c) = base + *(const f32x4*)(gt + c) * s; }
            asm volatile("s_waitcnt vmcnt(0)" ::: "memory");
        }
        f32x4 v[8]; float ss = 0.f;
#pragma unroll
        for (int i = 0; i < 8; ++i) v[i] = *(const f32x4*)(src + i * 256 + lane * 4);
#pragma unroll
        for (int i = 0; i < 8; ++i) ss += v[i][0] * v[i][0] + v[i][1] * v[i][1] + v[i][2] * v[i][2] + v[i][3] * v[i][3];
#pragma unroll
        for (int o = 32; o >= 1; o >>= 1) ss += __shfl_xor(ss, o);
        const float rstd = rsqrtf(ss * (1.0f / DM) + EPS);
        if (MODE == 2) {
            float* dst = p.out + O_Y + (size_t)row * DM;
#pragma unroll
            for (int i = 0; i < 8; ++i) { const f32x4 g = *(const f32x4*)(gain + i * 256 + lane * 4); *(f32x4*)(dst + i * 256 + lane * 4) = v[i] * rstd * g; }
        } else {
            const float* sh = mod + (size_t)bidx_of_row(row) * MODW + (MODE == 0 ? 0 : 6144); const float* sc = sh + 2048;
#pragma unroll
            for (int i = 0; i < 8; ++i) { const int c = i * 256 + lane * 4; const f32x4 g = *(const f32x4*)(gain + c), s1 = *(const f32x4*)(sc + c), s0 = *(const f32x4*)(sh + c);
                const f32x4 y = (v[i] * rstd * g) * (1.0f + s1) + s0; u32x2 w; w.x = pk2(y[0], y[1]); w.y = pk2(y[2], y[3]); *(u32x2*)(U + (size_t)row * DM + c) = w; }
        }
    }
}

template <int NTOK, bool SMP>
__device__ __forceinline__ void mixer_item(const Params& p, int it) {
    const int tid = threadIdx.x;
    const bf16_t* proj = (const bf16_t*)(p.ws + WS_PROJ);
    bf16_t* qn = (bf16_t*)(p.ws + WS_QN); bf16_t* kn = (bf16_t*)(p.ws + WS_KN); bf16_t* vv = (bf16_t*)(p.ws + WS_VV); bf16_t* yp = (bf16_t*)(p.ws + WS_YP);
    float* gbuf = (float*)(p.ws + WS_G); float* bbuf = (float*)(p.ws + WS_BETA);
    const int sb = it - 512;
    const int b = SMP ? 0 : (it >> 7), t0 = SMP ? 0 : (it & 127) * 16;
    const int rowbase = SMP ? TP + sb * 4 : b * 2048 + t0;
    if (tid < 384) {
        const int c0 = tid * 8;
        float w0[8], w1[8], w2[8], w3[8], xm3[8], xm2[8], xm1[8];
        const float* cw = p.in[11];
#pragma unroll
        for (int i = 0; i < 8; ++i) { w0[i] = cw[c0 + i]; w1[i] = cw[3072 + c0 + i]; w2[i] = cw[6144 + c0 + i]; w3[i] = cw[9216 + c0 + i]; }
        if (SMP) { const float* sc = p.in[5] + (size_t)sb * 3 * 3072 + c0;
#pragma unroll
            for (int i = 0; i < 8; ++i) { xm3[i] = sc[i]; xm2[i] = sc[3072 + i]; xm1[i] = sc[6144 + i]; }
        } else if (t0 == 0) {
#pragma unroll
            for (int i = 0; i < 8; ++i) { xm3[i] = 0.f; xm2[i] = 0.f; xm1[i] = 0.f; }
        } else {
            unpack8(*(const u32x4*)(proj + (size_t)(rowbase - 3) * NPROJ + c0), xm3); unpack8(*(const u32x4*)(proj + (size_t)(rowbase - 2) * NPROJ + c0), xm2); unpack8(*(const u32x4*)(proj + (size_t)(rowbase - 1) * NPROJ + c0), xm1);
        }
        constexpr int CH = NTOK < 8 ? NTOK : 8;
#pragma unroll
        for (int tc = 0; tc < NTOK; tc += CH) {
        u32x4 xr[CH];
#pragma unroll
        for (int t = 0; t < CH; ++t) xr[t] = *(const u32x4*)(proj + (size_t)(rowbase + tc + t) * NPROJ + c0);
#pragma unroll
        for (int t2 = 0; t2 < CH; ++t2) {
            const int t = tc + t2;
            const int row = rowbase + t; float xt[8], y[8];
            unpack8(xr[t2], xt);
            float ss = 0.f;
#pragma unroll
            for (int i = 0; i < 8; ++i) { const float a = w0[i] * xm3[i] + w1[i] * xm2[i] + w2[i] * xm1[i] + w3[i] * xt[i]; y[i] = siluf_(a); ss += y[i] * y[i]; }
            if (c0 < 2048) {
                ss += __shfl_xor(ss, 1); ss += __shfl_xor(ss, 2); ss += __shfl_xor(ss, 4); ss += __shfl_xor(ss, 8);
                const float inv = rsqrtf(ss + EPS);
#pragma unroll
                for (int i = 0; i < 8; ++i) y[i] *= inv;
            }
            bf16_t* dst = c0 < 1024 ? qn + (size_t)row * 1024 + c0 : (c0 < 2048 ? kn + (size_t)row * 1024 + (c0 - 1024) : vv + (size_t)row * 1024 + (c0 - 2048));
            *(u32x4*)dst = pack8(y);
            if (SMP) { if (t >= 1) { float* o = p.out + O_CS + ((size_t)sb * 3 + (t - 1)) * 3072 + c0; *(f32x4*)o = (f32x4){xt[0], xt[1], xt[2], xt[3]}; *(f32x4*)(o + 4) = (f32x4){xt[4], xt[5], xt[6], xt[7]}; } }
            else if (t0 + t >= 2045) { float* o = p.out + O_CP + ((size_t)b * 3 + (t0 + t - 2045)) * 3072 + c0; *(f32x4*)o = (f32x4){xt[0], xt[1], xt[2], xt[3]}; *(f32x4*)(o + 4) = (f32x4){xt[4], xt[5], xt[6], xt[7]}; }
#pragma unroll
            for (int i = 0; i < 8; ++i) { xm3[i] = xm2[i]; xm2[i] = xm1[i]; xm1[i] = xt[i]; }
        }
        }
    } else {
        const int pc = (tid - 384) * 8, gi = pc >> 8, w = 2 << gi;
        const int seqrow0 = SMP ? TP + sb * 4 : b * 2048;
        const float* sp = p.in[6] + (size_t)sb * 15 * 1024 + pc;
        auto xpool = [&](int tt, float* f) {
            if (tt >= 0) unpack8(*(const u32x4*)(proj + (size_t)(seqrow0 + tt) * NPROJ + C_XP + pc), f);
            else if (SMP) { const float* s = sp + (size_t)(15 + tt) * 1024;
#pragma unroll
                for (int i = 0; i < 8; ++i) f[i] = s[i]; }
            else {
#pragma unroll
                for (int i = 0; i < 8; ++i) f[i] = 0.f; }
        };
        float s[8];
#pragma unroll
        for (int i = 0; i < 8; ++i) s[i] = 0.f;
#pragma unroll
        for (int q = 1; q < 16; ++q) if (q < w) { float f[8]; xpool(t0 - q, f);
#pragma unroll
            for (int i = 0; i < 8; ++i) s[i] += f[i]; }
#pragma unroll 4
        for (int t = 0; t < NTOK; ++t) {
            const int tt = t0 + t; float x[8], y[8], f[8];
            xpool(tt, x);
            const float cnt = SMP ? (float)w : (float)min(w, tt + 1); const float ic = 1.0f / cnt;
#pragma unroll
            for (int i = 0; i < 8; ++i) { s[i] += x[i]; y[i] = s[i] * ic - x[i]; }
            *(u32x4*)(yp + (size_t)(seqrow0 + tt) * 1024 + pc) = pack8(y);
            xpool(tt - w + 1, f);
#pragma unroll
            for (int i = 0; i < 8; ++i) s[i] -= f[i];
            if (SMP) { float* o = p.out + O_PS + ((size_t)sb * 15 + 11 + t) * 1024 + pc; *(f32x4*)o = (f32x4){x[0], x[1], x[2], x[3]}; *(f32x4*)(o + 4) = (f32x4){x[4], x[5], x[6], x[7]}; }
            else if (tt >= 2033) { float* o = p.out + O_PP + ((size_t)b * 15 + (tt - 2033)) * 1024 + pc; *(f32x4*)o = (f32x4){x[0], x[1], x[2], x[3]}; *(f32x4*)(o + 4) = (f32x4){x[4], x[5], x[6], x[7]}; }
        }
        if (SMP) {
#pragma unroll
            for (int r = 0; r < 11; ++r) { const float* s2 = sp + (size_t)(4 + r) * 1024; float* o = p.out + O_PS + ((size_t)sb * 15 + r) * 1024 + pc; *(f32x4*)o = *(const f32x4*)s2; *(f32x4*)(o + 4) = *(const f32x4*)(s2 + 4); } }
    }
    if (tid < 256) { const int tk = tid >> 4, jj = tid & 15;
        if (tk < NTOK) { const int row = rowbase + tk; const float val = bf2f(proj[(size_t)row * NPROJ + C_AB + jj]);
            if (jj < 8) { const float xx = val + p.in[13][jj]; const float spl = xx > 20.f ? xx : log1pf(__expf(xx)); gbuf[row * 8 + jj] = -__expf(p.in[12][jj]) * spl; }
            else bbuf[row * 8 + (jj - 8)] = sigmoidf_(val); } }
}
__device__ __forceinline__ void mixer_prep_phase(const Params& p, int bid, int nblk) {
    for (int it = bid; it < 640; it += nblk) { if (it >= 512) mixer_item<4, true>(p, it); else mixer_item<16, false>(p, it); }
}

constexpr int P5_QS = 0, P5_KS = 17408, P5_VS = 34816, P5_MM = 52224, P5_DEC = 68608, P5_BETA = 68864, P5_GRP = 69632;
static_assert(2 * P5_GRP <= LDS_BYTES - 16, "lds");
__device__ __forceinline__ void chunk_prep_phase(const Params& p, int bid, int nblk, LAS unsigned char* lds0) {
    const int tid = threadIdx.x, lane = tid & 63, grp = tid >> 8, lt = tid & 255, lw = __builtin_amdgcn_readfirstlane(tid >> 6) & 3;
    LAS unsigned char* lds = lds0 + grp * P5_GRP;
    const bf16_t* qn = (const bf16_t*)(p.ws + WS_QN); const bf16_t* kn = (const bf16_t*)(p.ws + WS_KN); const bf16_t* vv = (const bf16_t*)(p.ws + WS_VV);
    const float* gbuf = (const float*)(p.ws + WS_G); const float* bbuf = (const float*)(p.ws + WS_BETA);
    bf16_t* wdc = (bf16_t*)(p.ws + WS_WDC); bf16_t* qd = (bf16_t*)(p.ws + WS_QD); bf16_t* kt = (bf16_t*)(p.ws + WS_KT); bf16_t* qk = (bf16_t*)(p.ws + WS_QK);
    float* cdv = (float*)(p.ws + WS_CD); float* ub = p.out + OS_UB;
    LAS float* Mm = (LAS float*)(lds + P5_MM); LAS float* dec = (LAS float*)(lds + P5_DEC); LAS float* bet = (LAS float*)(lds + P5_BETA);
    const float scale = 0.08838834764831845f;
    for (int it0 = bid * 2; it0 < 1024; it0 += nblk * 2) {
        const int item = it0 + grp, n = item & 31, bh = item >> 5, h = bh & 7, b = bh >> 3;
        const int r0 = b * 2048 + n * 64;
        __syncthreads();
#pragma unroll
        for (int i = 0; i < 4; ++i) { const int ch = lt + 256 * i, r = ch >> 4, c8 = (ch & 15) * 8; const size_t go = (size_t)(r0 + r) * 1024 + h * 128 + c8; const int lo = r * 272 + c8 * 2;
            *(LAS u32x4*)(lds + P5_QS + lo) = *(const u32x4*)(qn + go); *(LAS u32x4*)(lds + P5_KS + lo) = *(const u32x4*)(kn + go); *(LAS u32x4*)(lds + P5_VS + lo) = *(const u32x4*)(vv + go); }
        if (lt < 64) {
            float g = gbuf[(r0 + lt) * 8 + h];
#pragma unroll
            for (int o = 1; o < 64; o <<= 1) { const float t = __shfl_up(g, o); if (lane >= o) g += t; }
            dec[lt] = g;
        } else if (lt < 128) bet[lt - 64] = bbuf[(r0 + lt - 64) * 8 + h];
        __syncthreads();
        {
            const int rt = lw, fr = lane & 15, fq = lane >> 4;
#pragma unroll
            for (int mat = 0; mat < 2; ++mat) {
                bf16x8 a[4];
#pragma unroll
                for (int kk = 0; kk < 4; ++kk) a[kk] = *(const LAS bf16x8*)(lds + (mat ? P5_QS : P5_KS) + (rt * 16 + fr) * 272 + (kk * 32 + fq * 8) * 2);
#pragma unroll
                for (int st = 0; st < 4; ++st) {
                    f32x4 d = (f32x4){0.f, 0.f, 0.f, 0.f};
#pragma unroll
                    for (int kk = 0; kk < 4; ++kk) { const bf16x8 bb = *(const LAS bf16x8*)(lds + P5_KS + (st * 16 + fr) * 272 + (kk * 32 + fq * 8) * 2); d = __builtin_amdgcn_mfma_f32_16x16x32_bf16(a[kk], bb, d, 0, 0, 0); }
                    const int s = st * 16 + fr; const float ds = dec[s];
#pragma unroll
                    for (int j = 0; j < 4; ++j) { const int r = rt * 16 + fq * 4 + j; const float dr = dec[r];
                        if (mat == 0) Mm[r * 64 + s] = (r > s) ? bet[r] * d[j] * __expf(dr - ds) : 0.f;
                        else qk[(size_t)item * 4096 + r * 64 + s] = f2bf((r >= s) ? scale * d[j] * __expf(dr - ds) : 0.f); }
                }
            }
        }
        __syncthreads();
        const int w8 = __builtin_amdgcn_readfirstlane(tid >> 6);
        if (w8 < 4) {
            const int g2 = w8 >> 1, c = (w8 & 1) * 64 + lane; const int item2 = it0 + g2;
            LAS unsigned char* lg = lds0 + g2 * P5_GRP; LAS float* Mg = (LAS float*)(lg + P5_MM); LAS float* decg = (LAS float*)(lg + P5_DEC); LAS float* betg = (LAS float*)(lg + P5_BETA);
            float x[64], y[64]; f32x4 mq[6]; float a0, a1, b0, b1;
            float* up = ub + (size_t)item2 * 8192 + c; bf16_t* wp = wdc + (size_t)item2 * 8192 + c;
            { const float br = betg[0]; a0 = bf2f(*(const LAS bf16_t*)(lg + P5_VS + 0 + c * 2)) * br; b0 = bf2f(*(const LAS bf16_t*)(lg + P5_KS + 0 + c * 2)) * br * __expf(decg[0]); a1 = 0.f; b1 = 0.f; } x[0] = a0; y[0] = b0; up[0] = x[0]; wp[0] = f2bf(-y[0]);
            mq[0] = *(const LAS f32x4*)(Mg + 64); mq[1] = *(const LAS f32x4*)(Mg + 128); mq[2] = *(const LAS f32x4*)(Mg + 192); mq[3] = *(const LAS f32x4*)(Mg + 256); mq[4] = *(const LAS f32x4*)(Mg + 320); mq[5] = *(const LAS f32x4*)(Mg + 324);
            { const float br = betg[1]; a0 = bf2f(*(const LAS bf16_t*)(lg + P5_VS + 272 + c * 2)) * br; b0 = bf2f(*(const LAS bf16_t*)(lg + P5_KS + 272 + c * 2)) * br * __expf(decg[1]); a1 = 0.f; b1 = 0.f; } a0 -= mq[0][0] * x[0]; b0 -= mq[0][0] * y[0]; x[1] = a0 + a1; y[1] = b0 + b1; up[128] = x[1]; wp[128] = f2bf(-y[1]); mq[0] = *(const LAS f32x4*)(Mg + 384);
            { const float br = betg[2]; a0 = bf2f(*(const LAS bf16_t*)(lg + P5_VS + 544 + c * 2)) * br; b0 = bf2f(*(const LAS bf16_t*)(lg + P5_KS + 544 + c * 2)) * br * __expf(decg[2]); a1 = 0.f; b1 = 0.f; } a0 -= mq[1][0] * x[0]; b0 -= mq[1][0] * y[0]; a1 -= mq[1][1] * x[1]; b1 -= mq[1][1] * y[1]; x[2] = a0 + a1; y[2] = b0 + b1; up[256] = x[2]; wp[256] = f2bf(-y[2]); mq[1] = *(const LAS f32x4*)(Mg + 388);
            { const float br = betg[3]; a0 = bf2f(*(const LAS bf16_t*)(lg + P5_VS + 816 + c * 2)) * br; b0 = bf2f(*(const LAS bf16_t*)(lg + P5_KS + 816 + c * 2)) * br * __expf(decg[3]); a1 = 0.f; b1 = 0.f; } a0 -= mq[2][0] * x[0]; b0 -= mq[2][0] * y[0]; a1 -= mq[2][1] * x[1]; b1 -= mq[2][1] * y[1]; a0 -= mq[2][2] * x[2]; b0 -= mq[2][2] * y[2]; x[3] = a0 + a1; y[3] = b0 + b1; up[384] = x[3]; wp[384] = f2bf(-y[3]); mq[2] = *(const LAS f32x4*)(Mg + 448);
            { const float br = betg[4]; a0 = bf2f(*(const LAS bf16_t*)(lg + P5_VS + 1088 + c * 2)) * br; b0 = bf2f(*(const LAS bf16_t*)(lg + P5_KS + 1088 + c * 2)) * br * __expf(decg[4]); a1 = 0.f; b1 = 0.f; } a0 -= mq[3][0] * x[0]; b0 -= mq[3][0] * y[0]; a1 -= mq[3][1] * x[1]; b1 -= mq[3][1] * y[1]; a0 -= mq[3][2] * x[2]; b0 -= mq[3][2] * y[2]; a1 -= mq[3][3] * x[3]; b1 -= mq[3][3] * y[3]; x[4] = a0 + a1; y[4] = b0 + b1; up[512] = x[4]; wp[512] = f2bf(-y[4]); mq[3] = *(const LAS f32x4*)(Mg + 452);
            { const float br = betg[5]; a0 = bf2f(*(const LAS bf16_t*)(lg + P5_VS + 1360 + c * 2)) * br; b0 = bf2f(*(const LAS bf16_t*)(lg + P5_KS + 1360 + c * 2)) * br * __expf(decg[5]); a1 = 0.f; b1 = 0.f; } a0 -= mq[4][0] * x[0]; b0 -= mq[4][0] * y[0]; a1 -= mq[4][1] * x[1]; b1 -= mq[4][1] * y[1]; a0 -= mq[4][2] * x[2]; b0 -= mq[4][2] * y[2]; a1 -= mq[4][3] * x[3]; b1 -= mq[4][3] * y[3]; mq[4] = *(const LAS f32x4*)(Mg + 512);
            a0 -= mq[5][0] * x[4]; b0 -= mq[5][0] * y[4]; x[5] = a0 + a1; y[5] = b0 + b1; up[640] = x[5]; wp[640] = f2bf(-y[5]); mq[5] = *(const LAS f32x4*)(Mg + 516);
            { const float br = betg[6]; a0 = bf2f(*(const LAS bf16_t*)(lg + P5_VS + 1632 + c * 2)) * br; b0 = bf2f(*(const LAS bf16_t*)(lg + P5_KS + 1632 + c * 2)) * br * __expf(decg[6]); a1 = 0.f; b1 = 0.f; } a0 -= mq[0][0] * x[0]; b0 -= mq[0][0] * y[0]; a1 -= mq[0][1] * x[1]; b1 -= mq[0][1] * y[1]; a0 -= mq[0][2] * x[2]; b0 -= mq[0][2] * y[2]; a1 -= mq[0][3] * x[3]; b1 -= mq[0][3] * y[3]; mq[0] = *(const LAS f32x4*)(Mg + 576);
            a0 -= mq[1][0] * x[4]; b0 -= mq[1][0] * y[4]; a1 -= mq[1][1] * x[5]; b1 -= mq[1][1] * y[5]; x[6] = a0 + a1; y[6] = b0 + b1; up[768] = x[6]; wp[768] = f2bf(-y[6]); mq[1] = *(const LAS f32x4*)(Mg + 580);
            { const float br = betg[7]; a0 = bf2f(*(const LAS bf16_t*)(lg + P5_VS + 1904 + c * 2)) * br; b0 = bf2f(*(const LAS bf16_t*)(lg + P5_KS + 1904 + c * 2)) * br * __expf(decg[7]); a1 = 0.f; b1 = 0.f; } a0 -= mq[2][0] * x[0]; b0 -= mq[2][0] * y[0]; a1 -= mq[2][1] * x[1]; b1 -= mq[2][1] * y[1]; a0 -= mq[2][2] * x[2]; b0 -= mq[2][2] * y[2]; a1 -= mq[2][3] * x[3]; b1 -= mq[2][3] * y[3]; mq[2] = *(const LAS f32x4*)(Mg + 584);
            a0 -= mq[3][0] * x[4]; b0 -= mq[3][0] * y[4]; a1 -= mq[3][1] * x[5]; b1 -= mq[3][1] * y[5]; a0 -= mq[3][2] * x[6]; b0 -= mq[3][2] * y[6]; x[7] = a0 + a1; y[7] = b0 + b1; up[896] = x[7]; wp[896] = f2bf(-y[7]); mq[3] = *(const LAS f32x4*)(Mg + 640);
            { const float br = betg[8]; a0 = bf2f(*(const LAS bf16_t*)(lg + P5_VS + 2176 + c * 2)) * br; b0 = bf2f(*(const LAS bf16_t*)(lg + P5_KS + 2176 + c * 2)) * br * __expf(decg[8]); a1 = 0.f; b1 = 0.f; } a0 -= mq[4][0] * x[0]; b0 -= mq[4][0] * y[0]; a1 -= mq[4][1] * x[1]; b1 -= mq[4][1] * y[1]; a0 -= mq[4][2] * x[2]; b0 -= mq[4][2] * y[2]; a1 -= mq[4][3] * x[3]; b1 -= mq[4][3] * y[3]; mq[4] = *(const LAS f32x4*)(Mg + 644);
            a0 -= mq[5][0] * x[4]; b0 -= mq[5][0] * y[4]; a1 -= mq[5][1] * x[5]; b1 -= mq[5][1] * y[5]; a0 -= mq[5][2] * x[6]; b0 -= mq[5][2] * y[6]; a1 -= mq[5][3] * x[7]; b1 -= mq[5][3] * y[7]; x[8] = a0 + a1; y[8] = b0 + b1; up[1024] = x[8]; wp[1024] = f2bf(-y[8]); mq[5] = *(const LAS f32x4*)(Mg + 648);
            { const float br = betg[9]; a0 = bf2f(*(const LAS bf16_t*)(lg + P5_VS + 2448 + c * 2)) * br; b0 = bf2f(*(const LAS bf16_t*)(lg + P5_KS + 2448 + c * 2)) * br * __expf(decg[9]); a1 = 0.f; b1 = 0.f; } a0 -= mq[0][0] * x[0]; b0 -= mq[0][0] * y[0]; a1 -= mq[0][1] * x[1]; b1 -= mq[0][1] * y[1]; a0 -= mq[0][2] * x[2]; b0 -= mq[0][2] * y[2]; a1 -= mq[0][3] * x[3]; b1 -= mq[0][3] * y[3]; mq[0] = *(const LAS f32x4*)(Mg + 704);
            a0 -= mq[1][0] * x[4]; b0 -= mq[1][0] * y[4]; a1 -= mq[1][1] * x[5]; b1 -= mq[1][1] * y[5]; a0 -= mq[1][2] * x[6]; b0 -= mq[1][2] * y[6]; a1 -= mq[1][3] * x[7]; b1 -= mq[1][3] * y[7]; mq[1] = *(const LAS f32x4*)(Mg + 708);
            a0 -= mq[2][0] * x[8]; b0 -= mq[2][0] * y[8]; x[9] = a0 + a1; y[9] = b0 + b1; up[1152] = x[9]; wp[1152] = f2bf(-y[9]); mq[2] = *(const LAS f32x4*)(Mg + 712);
            { const float br = betg[10]; a0 = bf2f(*(const LAS bf16_t*)(lg + P5_VS + 2720 + c * 2)) * br; b0 = bf2f(*(const LAS bf16_t*)(lg + P5_KS + 2720 + c * 2)) * br * __expf(decg[10]); a1 = 0.f; b1 = 0.f; } a0 -= mq[3][0] * x[0]; b0 -= mq[3][0] * y[0]; a1 -= mq[3][1] * x[1]; b1 -= mq[3][1] * y[1]; a0 -= mq[3][2] * x[2]; b0 -= mq[3][2] * y[2]; a1 -= mq[3][3] * x[3]; b1 -= mq[3][3] * y[3]; mq[3] = *(const LAS f32x4*)(Mg + 768);
            a0 -= mq[4][0] * x[4]; b0 -= mq[4][0] * y[4]; a1 -= mq[4][1] * x[5]; b1 -= mq[4][1] * y[5]; a0 -= mq[4][2] * x[6]; b0 -= mq[4][2] * y[6]; a1 -= mq[4][3] * x[7]; b1 -= mq[4][3] * y[7]; mq[4] = *(const LAS f32x4*)(Mg + 772);
            a0 -= mq[5][0] * x[8]; b0 -= mq[5][0] * y[8]; a1 -= mq[5][1] * x[9]; b1 -= mq[5][1] * y[9]; x[10] = a0 + a1; y[10] = b0 + b1; up[1280] = x[10]; wp[1280] = f2bf(-y[10]); mq[5] = *(const LAS f32x4*)(Mg + 776);
            { const float br = betg[11]; a0 = bf2f(*(const LAS bf16_t*)(lg + P5_VS + 2992 + c * 2)) * br; b0 = bf2f(*(const LAS bf16_t*)(lg + P5_KS + 2992 + c * 2)) * br * __expf(decg[11]); a1 = 0.f; b1 = 0.f; } a0 -= mq[0][0] * x[0]; b0 -= mq[0][0] * y[0]; a1 -= mq[0][1] * x[1]; b1 -= mq[0][1] * y[1]; a0 -= mq[0][2] * x[2]; b0 -= mq[0][2] * y[2]; a1 -= mq[0][3] * x[3]; b1 -= mq[0][3] * y[3]; mq[0] = *(const LAS f32x4*)(Mg + 832);
            a0 -= mq[1][0] * x[4]; b0 -= mq[1][0] * y[4]; a1 -= mq[1][1] * x[5]; b1 -= mq[1][1] * y[5]; a0 -= mq[1][2] * x[6]; b0 -= mq[1][2] * y[6]; a1 -= mq[1][3] * x[7]; b1 -= mq[1][3] * y[7]; mq[1] = *(const LAS f32x4*)(Mg + 836);
            a0 -= mq[2][0] * x[8]; b0 -= mq[2][0] * y[8]; a1 -= mq[2][1] * x[9]; b1 -= mq[2][1] * y[9]; a0 -= mq[2][2] * x[10]; b0 -= mq[2][2] * y[10]; x[11] = a0 + a1; y[11] = b0 + b1; up[1408] = x[11]; wp[1408] = f2bf(-y[11]); mq[2] = *(const LAS f32x4*)(Mg + 840);
            { const float br = betg[12]; a0 = bf2f(*(const LAS bf16_t*)(lg + P5_VS + 3264 + c * 2)) * br; b0 = bf2f(*(const LAS bf16_t*)(lg + P5_KS + 3264 + c * 2)) * br * __expf(decg[12]); a1 = 0.f; b1 = 0.f; } a0 -= mq[3][0] * x[0]; b0 -= mq[3][0] * y[0]; a1 -= mq[3][1] * x[1]; b1 -= mq[3][1] * y[1]; a0 -= mq[3][2] * x[2]; b0 -= mq[3][2] * y[2]; a1 -= mq[3][3] * x[3]; b1 -= mq[3][3] * y[3]; mq[3] = *(const LAS f32x4*)(Mg + 844);
            a0 -= mq[4][0] * x[4]; b0 -= mq[4][0] * y[4]; a1 -= mq[4][1] * x[5]; b1 -= mq[4][1] * y[5]; a0 -= mq[4][2] * x[6]; b0 -= mq[4][2] * y[6]; a1 -= mq[4][3] * x[7]; b1 -= mq[4][3] * y[7]; mq[4] = *(const LAS f32x4*)(Mg + 896);
            a0 -= mq[5][0] * x[8]; b0 -= mq[5][0] * y[8]; a1 -= mq[5][1] * x[9]; b1 -= mq[5][1] * y[9]; a0 -= mq[5][2] * x[10]; b0 -= mq[5][2] * y[10]; a1 -= mq[5][3] * x[11]; b1 -= mq[5][3] * y[11]; x[12] = a0 + a1; y[12] = b0 + b1; up[1536] = x[12]; wp[1536] = f2bf(-y[12]); mq[5] = *(const LAS f32x4*)(Mg + 900);
            { const float br = betg[13]; a0 = bf2f(*(const LAS bf16_t*)(lg + P5_VS + 3536 + c * 2)) * br; b0 = bf2f(*(const LAS bf16_t*)(lg + P5_KS + 3536 + c * 2)) * br * __expf(decg[13]); a1 = 0.f; b1 = 0.f; } a0 -= mq[0][0] * x[0]; b0 -= mq[0][0] * y[0]; a1 -= mq[0][1] * x[1]; b1 -= mq[0][1] * y[1]; a0 -= mq[0][2] * x[2]; b0 -= mq[0][2] * y[2]; a1 -= mq[0][3] * x[3]; b1 -= mq[0][3] * y[3]; mq[0] = *(const LAS f32x4*)(Mg + 904);
            a0 -= mq[1][0] * x[4]; b0 -= mq[1][0] * y[4]; a1 -= mq[1][1] * x[5]; b1 -= mq[1][1] * y[5]; a0 -= mq[1][2] * x[6]; b0 -= mq[1][2] * y[6]; a1 -= mq[1][3] * x[7]; b1 -= mq[1][3] * y[7]; mq[1] = *(const LAS f32x4*)(Mg + 908);
            a0 -= mq[2][0] * x[8]; b0 -= mq[2][0] * y[8]; a1 -= mq[2][1] * x[9]; b1 -= mq[2][1] * y[9]; a0 -= mq[2][2] * x[10]; b0 -= mq[2][2] * y[10]; a1 -= mq[2][3] * x[11]; b1 -= mq[2][3] * y[11]; mq[2] = *(const LAS f32x4*)(Mg + 960);
            a0 -= mq[3][0] * x[12]; b0 -= mq[3][0] * y[12]; x[13] = a0 + a1; y[13] = b0 + b1; up[1664] = x[13]; wp[1664] = f2bf(-y[13]); mq[3] = *(const LAS f32x4*)(Mg + 964);
            { const float br = betg[14]; a0 = bf2f(*(const LAS bf16_t*)(lg + P5_VS + 3808 + c * 2)) * br; b0 = bf2f(*(const LAS bf16_t*)(lg + P5_KS + 3808 + c * 2)) * br * __expf(decg[14]); a1 = 0.f; b1 = 0.f; } a0 -= mq[4][0] * x[0]; b0 -= mq[4][0] * y[0]; a1 -= mq[4][1] * x[1]; b1 -= mq[4][1] * y[1]; a0 -= mq[4][2] * x[2]; b0 -= mq[4][2] * y[2]; a1 -= mq[4][3] * x[3]; b1 -= mq[4][3] * y[3]; mq[4] = *(const LAS f32x4*)(Mg + 968);
            a0 -= mq[5][0] * x[4]; b0 -= mq[5][0] * y[4]; a1 -= mq[5][1] * x[5]; b1 -= mq[5][1] * y[5]; a0 -= mq[5][2] * x[6]; b0 -= mq[5][2] * y[6]; a1 -= mq[5][3] * x[7]; b1 -= mq[5][3] * y[7]; mq[5] = *(const LAS f32x4*)(Mg + 972);
            a0 -= mq[0][0] * x[8]; b0 -= mq[0][0] * y[8]; a1 -= mq[0][1] * x[9]; b1 -= mq[0][1] * y[9]; a0 -= mq[0][2] * x[10]; b0 -= mq[0][2] * y[10]; a1 -= mq[0][3] * x[11]; b1 -= mq[0][3] * y[11]; mq[0] = *(const LAS f32x4*)(Mg + 1024);
            a0 -= mq[1][0] * x[12]; b0 -= mq[1][0] * y[12]; a1 -= mq[1][1] * x[13]; b1 -= mq[1][1] * y[13]; x[14] = a0 + a1; y[14] = b0 + b1; up[1792] = x[14]; wp[1792] = f2bf(-y[14]); mq[1] = *(const LAS f32x4*)(Mg + 1028);
            { const float br = betg[15]; a0 = bf2f(*(const LAS bf16_t*)(lg + P5_VS + 4080 + c * 2)) * br; b0 = bf2f(*(const LAS bf16_t*)(lg + P5_KS + 4080 + c * 2)) * br * __expf(decg[15]); a1 = 0.f; b1 = 0.f; } a0 -= mq[2][0] * x[0]; b0 -= mq[2][0] * y[0]; a1 -= mq[2][1] * x[1]; b1 -= mq[2][1] * y[1]; a0 -= mq[2][2] * x[2]; b0 -= mq[2][2] * y[2]; a1 -= mq[2][3] * x[3]; b1 -= mq[2][3] * y[3]; mq[2] = *(const LAS f32x4*)(Mg + 1032);
            a0 -= mq[3][0] * x[4]; b0 -= mq[3][0] * y[4]; a1 -= mq[3][1] * x[5]; b1 -= mq[3][1] * y[5]; a0 -= mq[3][2] * x[6]; b0 -= mq[3][2] * y[6]; a1 -= mq[3][3] * x[7]; b1 -= mq[3][3] * y[7]; mq[3] = *(const LAS f32x4*)(Mg + 1036);
            a0 -= mq[4][0] * x[8]; b0 -= mq[4][0] * y[8]; a1 -= mq[4][1] * x[9]; b1 -= mq[4][1] * y[9]; a0 -= mq[4][2] * x[10]; b0 -= mq[4][2] * y[10]; a1 -= mq[4][3] * x[11]; b1 -= mq[4][3] * y[11]; mq[4] = *(const LAS f32x4*)(Mg + 1088);
            a0 -= mq[5][0] * x[12]; b0 -= mq[5][0] * y[12]; a1 -= mq[5][1] * x[13]; b1 -= mq[5][1] * y[13]; a0 -= mq[5][2] * x[14]; b0 -= mq[5][2] * y[14]; x[15] = a0 + a1; y[15] = b0 + b1; up[1920] = x[15]; wp[1920] = f2bf(-y[15]); mq[5] = *(const LAS f32x4*)(Mg + 1092);
            { const float br = betg[16]; a0 = bf2f(*(const LAS bf16_t*)(lg + P5_VS + 4352 + c * 2)) * br; b0 = bf2f(*(const LAS bf16_t*)(lg + P5_KS + 4352 + c * 2)) * br * __expf(decg[16]); a1 = 0.f; b1 = 0.f; } a0 -= mq[0][0] * x[0]; b0 -= mq[0][0] * y[0]; a1 -= mq[0][1] * x[1]; b1 -= mq[0][1] * y[1]; a0 -= mq[0][2] * x[2]; b0 -= mq[0][2] * y[2]; a1 -= mq[0][3] * x[3]; b1 -= mq[0][3] * y[3]; mq[0] = *(const LAS f32x4*)(Mg + 1096);
            a0 -= mq[1][0] * x[4]; b0 -= mq[1][0] * y[4]; a1 -= mq[1][1] * x[5]; b1 -= mq[1][1] * y[5]; a0 -= mq[1][2] * x[6]; b0 -= mq[1][2] * y[6]; a1 -= mq[1][3] * x[7]; b1 -= mq[1][3] * y[7]; mq[1] = *(const LAS f32x4*)(Mg + 1100);
            a0 -= mq[2][0] * x[8]; b0 -= mq[2][0] * y[8]; a1 -= mq[2][1] * x[9]; b1 -= mq[2][1] * y[9]; a0 -= mq[2][2] * x[10]; b0 -= mq[2][2] * y[10]; a1 -= mq[2][3] * x[11]; b1 -= mq[2][3] * y[11]; mq[2] = *(const LAS f32x4*)(Mg + 1104);
            a0 -= mq[3][0] * x[12]; b0 -= mq[3][0] * y[12]; a1 -= mq[3][1] * x[13]; b1 -= mq[3][1] * y[13]; a0 -= mq[3][2] * x[14]; b0 -= mq[3][2] * y[14]; a1 -= mq[3][3] * x[15]; b1 -= mq[3][3] * y[15]; x[16] = a0 + a1; y[16] = b0 + b1; up[2048] = x[16]; wp[2048] = f2bf(-y[16]); mq[3] = *(const LAS f32x4*)(Mg + 1152);
            { const float br = betg[17]; a0 = bf2f(*(const LAS bf16_t*)(lg + P5_VS + 4624 + c * 2)) * br; b0 = bf2f(*(const LAS bf16_t*)(lg + P5_KS + 4624 + c * 2)) * br * __expf(decg[17]); a1 = 0.f; b1 = 0.f; } a0 -= mq[4][0] * x[0]; b0 -= mq[4][0] * y[0]; a1 -= mq[4][1] * x[1]; b1 -= mq[4][1] * y[1]; a0 -= mq[4][2] * x[2]; b0 -= mq[4][2] * y[2]; a1 -= mq[4][3] * x[3]; b1 -= mq[4][3] * y[3]; mq[4] = *(const LAS f32x4*)(Mg + 1156);
            a0 -= mq[5][0] * x[4]; b0 -= mq[5][0] * y[4]; a1 -= mq[5][1] * x[5]; b1 -= mq[5][1] * y[5]; a0 -= mq[5][2] * x[6]; b0 -= mq[5][2] * y[6]; a1 -= mq[5][3] * x[7]; b1 -= mq[5][3] * y[7]; mq[5] = *(const LAS f32x4*)(Mg + 1160);
            a0 -= mq[0][0] * x[8]; b0 -= mq[0][0] * y[8]; a1 -= mq[0][1] * x[9]; b1 -= mq[0][1] * y[9]; a0 -= mq[0][2] * x[10]; b0 -= mq[0][2] * y[10]; a1 -= mq[0][3] * x[11]; b1 -= mq[0][3] * y[11]; mq[0] = *(const LAS f32x4*)(Mg + 1164);
            a0 -= mq[1][0] * x[12]; b0 -= mq[1][0] * y[12]; a1 -= mq[1][1] * x[13]; b1 -= mq[1][1] * y[13]; a0 -= mq[1][2] * x[14]; b0 -= mq[1][2] * y[14]; a1 -= mq[1][3] * x[15]; b1 -= mq[1][3] * y[15]; mq[1] = *(const LAS f32x4*)(Mg + 1168);
            a0 -= mq[2][0] * x[16]; b0 -= mq[2][0] * y[16]; x[17] = a0 + a1; y[17] = b0 + b1; up[2176] = x[17]; wp[2176] = f2bf(-y[17]); mq[2] = *(const LAS f32x4*)(Mg + 1216);
            { const float br = betg[18]; a0 = bf2f(*(const LAS bf16_t*)(lg + P5_VS + 4896 + c * 2)) * br; b0 = bf2f(*(const LAS bf16_t*)(lg + P5_KS + 4896 + c * 2)) * br * __expf(decg[18]); a1 = 0.f; b1 = 0.f; } a0 -= mq[3][0] * x[0]; b0 -= mq[3][0] * y[0]; a1 -= mq[3][1] * x[1]; b1 -= mq[3][1] * y[1]; a0 -= mq[3][2] * x[2]; b0 -= mq[3][2] * y[2]; a1 -= mq[3][3] * x[3]; b1 -= mq[3][3] * y[3]; mq[3] = *(const LAS f32x4*)(Mg + 1220);
            a0 -= mq[4][0] * x[4]; b0 -= mq[4][0] * y[4]; a1 -= mq[4][1] * x[5]; b1 -= mq[4][1] * y[5]; a0 -= mq[4][2] * x[6]; b0 -= mq[4][2] * y[6]; a1 -= mq[4][3] * x[7]; b1 -= mq[4][3] * y[7]; mq[4] = *(const LAS f32x4*)(Mg + 1224);
            a0 -= mq[5][0] * x[8]; b0 -= mq[5][0] * y[8]; a1 -= mq[5][1] * x[9]; b1 -= mq[5][1] * y[9]; a0 -= mq[5][2] * x[10]; b0 -= mq[5][2] * y[10]; a1 -= mq[5][3] * x[11]; b1 -= mq[5][3] * y[11]; mq[5] = *(const LAS f32x4*)(Mg + 1228);
            a0 -= mq[0][0] * x[12]; b0 -= mq[0][0] * y[12]; a1 -= mq[0][1] * x[13]; b1 -= mq[0][1] * y[13]; a0 -= mq[0][2] * x[14]; b0 -= mq[0][2] * y[14]; a1 -= mq[0][3] * x[15]; b1 -= mq[0][3] * y[15]; mq[0] = *(const LAS f32x4*)(Mg + 1232);
            a0 -= mq[1][0] * x[16]; b0 -= mq[1][0] * y[16]; a1 -= mq[1][1] * x[17]; b1 -= mq[1][1] * y[17]; x[18] = a0 + a1; y[18] = b0 + b1; up[2304] = x[18]; wp[2304] = f2bf(-y[18]); mq[1] = *(const LAS f32x4*)(Mg + 1280);
            { const float br = betg[19]; a0 = bf2f(*(const LAS bf16_t*)(lg + P5_VS + 5168 + c * 2)) * br; b0 = bf2f(*(const LAS bf16_t*)(lg + P5_KS + 5168 + c * 2)) * br * __expf(decg[19]); a1 = 0.f; b1 = 0.f; } a0 -= mq[2][0] * x[0]; b0 -= mq[2][0] * y[0]; a1 -= mq[2][1] * x[1]; b1 -= mq[2][1] * y[1]; a0 -= mq[2][2] * x[2]; b0 -= mq[2][2] * y[2]; a1 -= mq[2][3] * x[3]; b1 -= mq[2][3] * y[3]; mq[2] = *(const LAS f32x4*)(Mg + 1284);
            a0 -= mq[3][0] * x[4]; b0 -= mq[3][0] * y[4]; a1 -= mq[3][1] * x[5]; b1 -= mq[3][1] * y[5]; a0 -= mq[3][2] * x[6]; b0 -= mq[3][2] * y[6]; a1 -= mq[3][3] * x[7]; b1 -= mq[3][3] * y[7]; mq[3] = *(const LAS f32x4*)(Mg + 1288);
            a0 -= mq[4][0] * x[8]; b0 -= mq[4][0] * y[8]; a1 -= mq[4][1] * x[9]; b1 -= mq[4][1] * y[9]; a0 -= mq[4][2] * x[10]; b0 -= mq[4][2] * y[10]; a1 -= mq[4][3] * x[11]; b1 -= mq[4][3] * y[11]; mq[4] = *(const LAS f32x4*)(Mg + 1292);
            a0 -= mq[5][0] * x[12]; b0 -= mq[5][0] * y[12]; a1 -= mq[5][1] * x[13]; b1 -= mq[5][1] * y[13]; a0 -= mq[5][2] * x[14]; b0 -= mq[5][2] * y[14]; a1 -= mq[5][3] * x[15]; b1 -= mq[5][3] * y[15]; mq[5] = *(const LAS f32x4*)(Mg + 1296);
            a0 -= mq[0][0] * x[16]; b0 -= mq[0][0] * y[16]; a1 -= mq[0][1] * x[17]; b1 -= mq[0][1] * y[17]; a0 -= mq[0][2] * x[18]; b0 -= mq[0][2] * y[18]; x[19] = a0 + a1; y[19] = b0 + b1; up[2432] = x[19]; wp[2432] = f2bf(-y[19]); mq[0] = *(const LAS f32x4*)(Mg + 1344);
            { const float br = betg[20]; a0 = bf2f(*(const LAS bf16_t*)(lg + P5_VS + 5440 + c * 2)) * br; b0 = bf2f(*(const LAS bf16_t*)(lg + P5_KS + 5440 + c * 2)) * br * __expf(decg[20]); a1 = 0.f; b1 = 0.f; } a0 -= mq[1][0] * x[0]; b0 -= mq[1][0] * y[0]; a1 -= mq[1][1] * x[1]; b1 -= mq[1][1] * y[1]; a0 -= mq[1][2] * x[2]; b0 -= mq[1][2] * y[2]; a1 -= mq[1][3] * x[3]; b1 -= mq[1][3] * y[3]; mq[1] = *(const LAS f32x4*)(Mg + 1348);
            a0 -= mq[2][0] * x[4]; b0 -= mq[2][0] * y[4]; a1 -= mq[2][1] * x[5]; b1 -= mq[2][1] * y[5]; a0 -= mq[2][2] * x[6]; b0 -= mq[2][2] * y[6]; a1 -= mq[2][3] * x[7]; b1 -= mq[2][3] * y[7]; mq[2] = *(const LAS f32x4*)(Mg + 1352);
            a0 -= mq[3][0] * x[8]; b0 -= mq[3][0] * y[8]; a1 -= mq[3][1] * x[9]; b1 -= mq[3][1] * y[9]; a0 -= mq[3][2] * x[10]; b0 -= mq[3][2] * y[10]; a1 -= mq[3][3] * x[11]; b1 -= mq[3][3] * y[11]; mq[3] = *(const LAS f32x4*)(Mg + 1356);
            a0 -= mq[4][0] * x[12]; b0 -= mq[4][0] * y[12]; a1 -= mq[4][1] * x[13]; b1 -= mq[4][1] * y[13]; a0 -= mq[4][2] * x[14]; b0 -= mq[4][2] * y[14]; a1 -= mq[4][3] * x[15]; b1 -= mq[4][3] * y[15]; mq[4] = *(const LAS f32x4*)(Mg + 1360);
            a0 -= mq[5][0] * x[16]; b0 -= mq[5][0] * y[16]; a1 -= mq[5][1] * x[17]; b1 -= mq[5][1] * y[17]; a0 -= mq[5][2] * x[18]; b0 -= mq[5][2] * y[18]; a1 -= mq[5][3] * x[19]; b1 -= mq[5][3] * y[19]; x[20] = a0 + a1; y[20] = b0 + b1; up[2560] = x[20]; wp[2560] = f2bf(-y[20]); mq[5] = *(const LAS f32x4*)(Mg + 1364);
            { const float br = betg[21]; a0 = bf2f(*(const LAS bf16_t*)(lg + P5_VS + 5712 + c * 2)) * br; b0 = bf2f(*(const LAS bf16_t*)(lg + P5_KS + 5712 + c * 2)) * br * __expf(decg[21]); a1 = 0.f; b1 = 0.f; } a0 -= mq[0][0] * x[0]; b0 -= mq[0][0] * y[0]; a1 -= mq[0][1] * x[1]; b1 -= mq[0][1] * y[1]; a0 -= mq[0][2] * x[2]; b0 -= mq[0][2] * y[2]; a1 -= mq[0][3] * x[3]; b1 -= mq[0][3] * y[3]; mq[0] = *(const LAS f32x4*)(Mg + 1408);
            a0 -= mq[1][0] * x[4]; b0 -= mq[1][0] * y[4]; a1 -= mq[1][1] * x[5]; b1 -= mq[1][1] * y[5]; a0 -= mq[1][2] * x[6]; b0 -= mq[1][2] * y[6]; a1 -= mq[1][3] * x[7]; b1 -= mq[1][3] * y[7]; mq[1] = *(const LAS f32x4*)(Mg + 1412);
            a0 -= mq[2][0] * x[8]; b0 -= mq[2][0] * y[8]; a1 -= mq[2][1] * x[9]; b1 -= mq[2][1] * y[9]; a0 -= mq[2][2] * x[10]; b0 -= mq[2][2] * y[10]; a1 -= mq[2][3] * x[11]; b1 -= mq[2][3] * y[11]; mq[2] = *(const LAS f32x4*)(Mg + 1416);
            a0 -= mq[3][0] * x[12]; b0 -= mq[3][0] * y[12]; a1 -= mq[3][1] * x[13]; b1 -= mq[3][1] * y[13]; a0 -= mq[3][2] * x[14]; b0 -= mq[3][2] * y[14]; a1 -= mq[3][3] * x[15]; b1 -= mq[3][3] * y[15]; mq[3] = *(const LAS f32x4*)(Mg + 1420);
            a0 -= mq[4][0] * x[16]; b0 -= mq[4][0] * y[16]; a1 -= mq[4][1] * x[17]; b1 -= mq[4][1] * y[17]; a0 -= mq[4][2] * x[18]; b0 -= mq[4][2] * y[18]; a1 -= mq[4][3] * x[19]; b1 -= mq[4][3] * y[19]; mq[4] = *(const LAS f32x4*)(Mg + 1424);
            a0 -= mq[5][0] * x[20]; b0 -= mq[5][0] * y[20]; x[21] = a0 + a1; y[21] = b0 + b1; up[2688] = x[21]; wp[2688] = f2bf(-y[21]); mq[5] = *(const LAS f32x4*)(Mg + 1428);
            { const float br = betg[22]; a0 = bf2f(*(const LAS bf16_t*)(lg + P5_VS + 5984 + c * 2)) * br; b0 = bf2f(*(const LAS bf16_t*)(lg + P5_KS + 5984 + c * 2)) * br * __expf(decg[22]); a1 = 0.f; b1 = 0.f; } a0 -= mq[0][0] * x[0]; b0 -= mq[0][0] * y[0]; a1 -= mq[0][1] * x[1]; b1 -= mq[0][1] * y[1]; a0 -= mq[0][2] * x[2]; b0 -= mq[0][2] * y[2]; a1 -= mq[0][3] * x[3]; b1 -= mq[0][3] * y[3]; mq[0] = *(const LAS f32x4*)(Mg + 1472);
            a0 -= mq[1][0] * x[4]; b0 -= mq[1][0] * y[4]; a1 -= mq[1][1] * x[5]; b1 -= mq[1][1] * y[5]; a0 -= mq[1][2] * x[6]; b0 -= mq[1][2] * y[6]; a1 -= mq[1][3] * x[7]; b1 -= mq[1][3] * y[7]; mq[1] = *(const LAS f32x4*)(Mg + 1476);
            a0 -= mq[2][0] * x[8]; b0 -= mq[2][0] * y[8]; a1 -= mq[2][1] * x[9]; b1 -= mq[2][1] * y[9]; a0 -= mq[2][2] * x[10]; b0 -= mq[2][2] * y[10]; a1 -= mq[2][3] * x[11]; b1 -= mq[2][3] * y[11]; mq[2] = *(const LAS f32x4*)(Mg + 1480);
            a0 -= mq[3][0] * x[12]; b0 -= mq[3][0] * y[12]; a1 -= mq[3][1] * x[13]; b1 -= mq[3][1] * y[13]; a0 -= mq[3][2] * x[14]; b0 -= mq[3][2] * y[14]; a1 -= mq[3][3] * x[15]; b1 -= mq[3][3] * y[15]; mq[3] = *(const LAS f32x4*)(Mg + 1484);
            a0 -= mq[4][0] * x[16]; b0 -= mq[4][0] * y[16]; a1 -= mq[4][1] * x[17]; b1 -= mq[4][1] * y[17]; a0 -= mq[4][2] * x[18]; b0 -= mq[4][2] * y[18]; a1 -= mq[4][3] * x[19]; b1 -= mq[4][3] * y[19]; mq[4] = *(const LAS f32x4*)(Mg + 1488);
            a0 -= mq[5][0] * x[20]; b0 -= mq[5][0] * y[20]; a1 -= mq[5][1] * x[21]; b1 -= mq[5][1] * y[21]; x[22] = a0 + a1; y[22] = b0 + b1; up[2816] = x[22]; wp[2816] = f2bf(-y[22]); mq[5] = *(const LAS f32x4*)(Mg + 1492);
            { const float br = betg[23]; a0 = bf2f(*(const LAS bf16_t*)(lg + P5_VS + 6256 + c * 2)) * br; b0 = bf2f(*(const LAS bf16_t*)(lg + P5_KS + 6256 + c * 2)) * br * __expf(decg[23]); a1 = 0.f; b1 = 0.f; } a0 -= mq[0][0] * x[0]; b0 -= mq[0][0] * y[0]; a1 -= mq[0][1] * x[1]; b1 -= mq[0][1] * y[1]; a0 -= mq[0][2] * x[2]; b0 -= mq[0][2] * y[2]; a1 -= mq[0][3] * x[3]; b1 -= mq[0][3] * y[3]; mq[0] = *(const LAS f32x4*)(Mg + 1536);
            a0 -= mq[1][0] * x[4]; b0 -= mq[1][0] * y[4]; a1 -= mq[1][1] * x[5]; b1 -= mq[1][1] * y[5]; a0 -= mq[1][2] * x[6]; b0 -= mq[1][2] * y[6]; a1 -= mq[1][3] * x[7]; b1 -= mq[1][3] * y[7]; mq[1] = *(const LAS f32x4*)(Mg + 1540);
            a0 -= mq[2][0] * x[8]; b0 -= mq[2][0] * y[8]; a1 -= mq[2][1] * x[9]; b1 -= mq[2][1] * y[9]; a0 -= mq[2][2] * x[10]; b0 -= mq[2][2] * y[10]; a1 -= mq[2][3] * x[11]; b1 -= mq[2][3] * y[11]; mq[2] = *(const LAS f32x4*)(Mg + 1544);
            a0 -= mq[3][0] * x[12]; b0 -= mq[3][0] * y[12]; a1 -= mq[3][1] * x[13]; b1 -= mq[3][1] * y[13]; a0 -= mq[3][2] * x[14]; b0 -= mq[3][2] * y[14]; a1 -= mq[3][3] * x[15]; b1 -= mq[3][3] * y[15]; mq[3] = *(const LAS f32x4*)(Mg + 1548);
            a0 -= mq[4][0] * x[16]; b0 -= mq[4][0] * y[16]; a1 -= mq[4][1] * x[17]; b1 -= mq[4][1] * y[17]; a0 -= mq[4][2] * x[18]; b0 -= mq[4][2] * y[18]; a1 -= mq[4][3] * x[19]; b1 -= mq[4][3] * y[19]; mq[4] = *(const LAS f32x4*)(Mg + 1552);
            a0 -= mq[5][0] * x[20]; b0 -= mq[5][0] * y[20]; a1 -= mq[5][1] * x[21]; b1 -= mq[5][1] * y[21]; a0 -= mq[5][2] * x[22]; b0 -= mq[5][2] * y[22]; x[23] = a0 + a1; y[23] = b0 + b1; up[2944] = x[23]; wp[2944] = f2bf(-y[23]); mq[5] = *(const LAS f32x4*)(Mg + 1556);
            { const float br = betg[24]; a0 = bf2f(*(const LAS bf16_t*)(lg + P5_VS + 6528 + c * 2)) * br; b0 = bf2f(*(const LAS bf16_t*)(lg + P5_KS + 6528 + c * 2)) * br * __expf(decg[24]); a1 = 0.f; b1 = 0.f; } a0 -= mq[0][0] * x[0]; b0 -= mq[0][0] * y[0]; a1 -= mq[0][1] * x[1]; b1 -= mq[0][1] * y[1]; a0 -= mq[0][2] * x[2]; b0 -= mq[0][2] * y[2]; a1 -= mq[0][3] * x[3]; b1 -= mq[0][3] * y[3]; mq[0] = *(const LAS f32x4*)(Mg + 1600);
            a0 -= mq[1][0] * x[4]; b0 -= mq[1][0] * y[4]; a1 -= mq[1][1] * x[5]; b1 -= mq[1][1] * y[5]; a0 -= mq[1][2] * x[6]; b0 -= mq[1][2] * y[6]; a1 -= mq[1][3] * x[7]; b1 -= mq[1][3] * y[7]; mq[1] = *(const LAS f32x4*)(Mg + 1604);
            a0 -= mq[2][0] * x[8]; b0 -= mq[2][0] * y[8]; a1 -= mq[2][1] * x[9]; b1 -= mq[2][1] * y[9]; a0 -= mq[2][2] * x[10]; b0 -= mq[2][2] * y[10]; a1 -= mq[2][3] * x[11]; b1 -= mq[2][3] * y[11]; mq[2] = *(const LAS f32x4*)(Mg + 1608);
            a0 -= mq[3][0] * x[12]; b0 -= mq[3][0] * y[12]; a1 -= mq[3][1] * x[13]; b1 -= mq[3][1] * y[13]; a0 -= mq[3][2] * x[14]; b0 -= mq[3][2] * y[14]; a1 -= mq[3][3] * x[15]; b1 -= mq[3][3] * y[15]; mq[3] = *(const LAS f32x4*)(Mg + 1612);
            a0 -= mq[4][0] * x[16]; b0 -= mq[4][0] * y[16]; a1 -= mq[4][1] * x[17]; b1 -= mq[4][1] * y[17]; a0 -= mq[4][2] * x[18]; b0 -= mq[4][2] * y[18]; a1 -= mq[4][3] * x[19]; b1 -= mq[4][3] * y[19]; mq[4] = *(const LAS f32x4*)(Mg + 1616);
            a0 -= mq[5][0] * x[20]; b0 -= mq[5][0] * y[20]; a1 -= mq[5][1] * x[21]; b1 -= mq[5][1] * y[21]; a0 -= mq[5][2] * x[22]; b0 -= mq[5][2] * y[22]; a1 -= mq[5][3] * x[23]; b1 -= mq[5][3] * y[23]; x[24] = a0 + a1; y[24] = b0 + b1; up[3072] = x[24]; wp[3072] = f2bf(-y[24]); mq[5] = *(const LAS f32x4*)(Mg + 1620);
            { const float br = betg[25]; a0 = bf2f(*(const LAS bf16_t*)(lg + P5_VS + 6800 + c * 2)) * br; b0 = bf2f(*(const LAS bf16_t*)(lg + P5_KS + 6800 + c * 2)) * br * __expf(decg[25]); a1 = 0.f; b1 = 0.f; } a0 -= mq[0][0] * x[0]; b0 -= mq[0][0] * y[0]; a1 -= mq[0][1] * x[1]; b1 -= mq[0][1] * y[1]; a0 -= mq[0][2] * x[2]; b0 -= mq[0][2] * y[2]; a1 -= mq[0][3] * x[3]; b1 -= mq[0][3] * y[3]; mq[0] = *(const LAS f32x4*)(Mg + 1624);
            a0 -= mq[1][0] * x[4]; b0 -= mq[1][0] * y[4]; a1 -= mq[1][1] * x[5]; b1 -= mq[1][1] * y[5]; a0 -= mq[1][2] * x[6]; b0 -= mq[1][2] * y[6]; a1 -= mq[1][3] * x[7]; b1 -= mq[1][3] * y[7]; mq[1] = *(const LAS f32x4*)(Mg + 1664);
            a0 -= mq[2][0] * x[8]; b0 -= mq[2][0] * y[8]; a1 -= mq[2][1] * x[9]; b1 -= mq[2][1] * y[9]; a0 -= mq[2][2] * x[10]; b0 -= mq[2][2] * y[10]; a1 -= mq[2][3] * x[11]; b1 -= mq[2][3] * y[11]; mq[2] = *(const LAS f32x4*)(Mg + 1668);
            a0 -= mq[3][0] * x[12]; b0 -= mq[3][0] * y[12]; a1 -= mq[3][1] * x[13]; b1 -= mq[3][1] * y[13]; a0 -= mq[3][2] * x[14]; b0 -= mq[3][2] * y[14]; a1 -= mq[3][3] * x[15]; b1 -= mq[3][3] * y[15]; mq[3] = *(const LAS f32x4*)(Mg + 1672);
            a0 -= mq[4][0] * x[16]; b0 -= mq[4][0] * y[16]; a1 -= mq[4][1] * x[17]; b1 -= mq[4][1] * y[17]; a0 -= mq[4][2] * x[18]; b0 -= mq[4][2] * y[18]; a1 -= mq[4][3] * x[19]; b1 -= mq[4][3] * y[19]; mq[4] = *(const LAS f32x4*)(Mg + 1676);
            a0 -= mq[5][0] * x[20]; b0 -= mq[5][0] * y[20]; a1 -= mq[5][1] * x[21]; b1 -= mq[5][1] * y[21]; a0 -= mq[5][2] * x[22]; b0 -= mq[5][2] * y[22]; a1 -= mq[5][3] * x[23]; b1 -= mq[5][3] * y[23]; mq[5] = *(const LAS f32x4*)(Mg + 1680);
            a0 -= mq[0][0] * x[24]; b0 -= mq[0][0] * y[24]; x[25] = a0 + a1; y[25] = b0 + b1; up[3200] = x[25]; wp[3200] = f2bf(-y[25]); mq[0] = *(const LAS f32x4*)(Mg + 1684);
            { const float br = betg[26]; a0 = bf2f(*(const LAS bf16_t*)(lg + P5_VS + 7072 + c * 2)) * br; b0 = bf2f(*(const LAS bf16_t*)(lg + P5_KS + 7072 + c * 2)) * br * __expf(decg[26]); a1 = 0.f; b1 = 0.f; } a0 -= mq[1][0] * x[0]; b0 -= mq[1][0] * y[0]; a1 -= mq[1][1] * x[1]; b1 -= mq[1][1] * y[1]; a0 -= mq[1][2] * x[2]; b0 -= mq[1][2] * y[2]; a1 -= mq[1][3] * x[3]; b1 -= mq[1][3] * y[3]; mq[1] = *(const LAS f32x4*)(Mg + 1688);
            a0 -= mq[2][0] * x[4]; b0 -= mq[2][0] * y[4]; a1 -= mq[2][1] * x[5]; b1 -= mq[2][1] * y[5]; a0 -= mq[2][2] * x[6]; b0 -= mq[2][2] * y[6]; a1 -= mq[2][3] * x[7]; b1 -= mq[2][3] * y[7]; mq[2] = *(const LAS f32x4*)(Mg + 1728);
            a0 -= mq[3][0] * x[8]; b0 -= mq[3][0] * y[8]; a1 -= mq[3][1] * x[9]; b1 -= mq[3][1] * y[9]; a0 -= mq[3][2] * x[10]; b0 -= mq[3][2] * y[10]; a1 -= mq[3][3] * x[11]; b1 -= mq[3][3] * y[11]; mq[3] = *(const LAS f32x4*)(Mg + 1732);
            a0 -= mq[4][0] * x[12]; b0 -= mq[4][0] * y[12]; a1 -= mq[4][1] * x[13]; b1 -= mq[4][1] * y[13]; a0 -= mq[4][2] * x[14]; b0 -= mq[4][2] * y[14]; a1 -= mq[4][3] * x[15]; b1 -= mq[4][3] * y[15]; mq[4] = *(const LAS f32x4*)(Mg + 1736);
            a0 -= mq[5][0] * x[16]; b0 -= mq[5][0] * y[16]; a1 -= mq[5][1] * x[17]; b1 -= mq[5][1] * y[17]; a0 -= mq[5][2] * x[18]; b0 -= mq[5][2] * y[18]; a1 -= mq[5][3] * x[19]; b1 -= mq[5][3] * y[19]; mq[5] = *(const LAS f32x4*)(Mg + 1740);
            a0 -= mq[0][0] * x[20]; b0 -= mq[0][0] * y[20]; a1 -= mq[0][1] * x[21]; b1 -= mq[0][1] * y[21]; a0 -= mq[0][2] * x[22]; b0 -= mq[0][2] * y[22]; a1 -= mq[0][3] * x[23]; b1 -= mq[0][3] * y[23]; mq[0] = *(const LAS f32x4*)(Mg + 1744);
            a0 -= mq[1][0] * x[24]; b0 -= mq[1][0] * y[24]; a1 -= mq[1][1] * x[25]; b1 -= mq[1][1] * y[25]; x[26] = a0 + a1; y[26] = b0 + b1; up[3328] = x[26]; wp[3328] = f2bf(-y[26]); mq[1] = *(const LAS f32x4*)(Mg + 1748);
            { const float br = betg[27]; a0 = bf2f(*(const LAS bf16_t*)(lg + P5_VS + 7344 + c * 2)) * br; b0 = bf2f(*(const LAS bf16_t*)(lg + P5_KS + 7344 + c * 2)) * br * __expf(decg[27]); a1 = 0.f; b1 = 0.f; } a0 -= mq[2][0] * x[0]; b0 -= mq[2][0] * y[0]; a1 -= mq[2][1] * x[1]; b1 -= mq[2][1] * y[1]; a0 -= mq[2][2] * x[2]; b0 -= mq[2][2] * y[2]; a1 -= mq[2][3] * x[3]; b1 -= mq[2][3] * y[3]; mq[2] = *(const LAS f32x4*)(Mg + 1752);
            a0 -= mq[3][0] * x[4]; b0 -= mq[3][0] * y[4]; a1 -= mq[3][1] * x[5]; b1 -= mq[3][1] * y[5]; a0 -= mq[3][2] * x[6]; b0 -= mq[3][2] * y[6]; a1 -= mq[3][3] * x[7]; b1 -= mq[3][3] * y[7]; mq[3] = *(const LAS f32x4*)(Mg + 1792);
            a0 -= mq[4][0] * x[8]; b0 -= mq[4][0] * y[8]; a1 -= mq[4][1] * x[9]; b1 -= mq[4][1] * y[9]; a0 -= mq[4][2] * x[10]; b0 -= mq[4][2] * y[10]; a1 -= mq[4][3] * x[11]; b1 -= mq[4][3] * y[11]; mq[4] = *(const LAS f32x4*)(Mg + 1796);
            a0 -= mq[5][0] * x[12]; b0 -= mq[5][0] * y[12]; a1 -= mq[5][1] * x[13]; b1 -= mq[5][1] * y[13]; a0 -= mq[5][2] * x[14]; b0 -= mq[5][2] * y[14]; a1 -= mq[5][3] * x[15]; b1 -= mq[5][3] * y[15]; mq[5] = *(const LAS f32x4*)(Mg + 1800);
            a0 -= mq[0][0] * x[16]; b0 -= mq[0][0] * y[16]; a1 -= mq[0][1] * x[17]; b1 -= mq[0][1] * y[17]; a0 -= mq[0][2] * x[18]; b0 -= mq[0][2] * y[18]; a1 -= mq[0][3] * x[19]; b1 -= mq[0][3] * y[19]; mq[0] = *(const LAS f32x4*)(Mg + 1804);
            a0 -= mq[1][0] * x[20]; b0 -= mq[1][0] * y[20]; a1 -= mq[1][1] * x[21]; b1 -= mq[1][1] * y[21]; a0 -= mq[1][2] * x[22]; b0 -= mq[1][2] * y[22]; a1 -= mq[1][3] * x[23]; b1 -= mq[1][3] * y[23]; mq[1] = *(const LAS f32x4*)(Mg + 1808);
            a0 -= mq[2][0] * x[24]; b0 -= mq[2][0] * y[24]; a1 -= mq[2][1] * x[25]; b1 -= mq[2][1] * y[25]; a0 -= mq[2][2] * x[26]; b0 -= mq[2][2] * y[26]; x[27] = a0 + a1; y[27] = b0 + b1; up[3456] = x[27]; wp[3456] = f2bf(-y[27]); mq[2] = *(const LAS f32x4*)(Mg + 1812);
            { const float br = betg[28]; a0 = bf2f(*(const LAS bf16_t*)(lg + P5_VS + 7616 + c * 2)) * br; b0 = bf2f(*(const LAS bf16_t*)(lg + P5_KS + 7616 + c * 2)) * br * __expf(decg[28]); a1 = 0.f; b1 = 0.f; } a0 -= mq[3][0] * x[0]; b0 -= mq[3][0] * y[0]; a1 -= mq[3][1] * x[1]; b1 -= mq[3][1] * y[1]; a0 -= mq[3][2] * x[2]; b0 -= mq[3][2] * y[2]; a1 -= mq[3][3] * x[3]; b1 -= mq[3][3] * y[3]; mq[3] = *(const LAS f32x4*)(Mg + 1816);
            a0 -= mq[4][0] * x[4]; b0 -= mq[4][0] * y[4]; a1 -= mq[4][1] * x[5]; b1 -= mq[4][1] * y[5]; a0 -= mq[4][2] * x[6]; b0 -= mq[4][2] * y[6]; a1 -= mq[4][3] * x[7]; b1 -= mq[4][3] * y[7]; mq[4] = *(const LAS f32x4*)(Mg + 1856);
            a0 -= mq[5][0] * x[8]; b0 -= mq[5][0] * y[8]; a1 -= mq[5][1] * x[9]; b1 -= mq[5][1] * y[9]; a0 -= mq[5][2] * x[10]; b0 -= mq[5][2] * y[10]; a1 -= mq[5][3] * x[11]; b1 -= mq[5][3] * y[11]; mq[5] = *(const LAS f32x4*)(Mg + 1860);
            a0 -= mq[0][0] * x[12]; b0 -= mq[0][0] * y[12]; a1 -= mq[0][1] * x[13]; b1 -= mq[0][1] * y[13]; a0 -= mq[0][2] * x[14]; b0 -= mq[0][2] * y[14]; a1 -= mq[0][3] * x[15]; b1 -= mq[0][3] * y[15]; mq[0] = *(const LAS f32x4*)(Mg + 1864);
            a0 -= mq[1][0] * x[16]; b0 -= mq[1][0] * y[16]; a1 -= mq[1][1] * x[17]; b1 -= mq[1][1] * y[17]; a0 -= mq[1][2] * x[18]; b0 -= mq[1][2] * y[18]; a1 -= mq[1][3] * x[19]; b1 -= mq[1][3] * y[19]; mq[1] = *(const LAS f32x4*)(Mg + 1868);
            a0 -= mq[2][0] * x[20]; b0 -= mq[2][0] * y[20]; a1 -= mq[2][1] * x[21]; b1 -= mq[2][1] * y[21]; a0 -= mq[2][2] * x[22]; b0 -= mq[2][2] * y[22]; a1 -= mq[2][3] * x[23]; b1 -= mq[2][3] * y[23]; mq[2] = *(const LAS f32x4*)(Mg + 1872);
            a0 -= mq[3][0] * x[24]; b0 -= mq[3][0] * y[24]; a1 -= mq[3][1] * x[25]; b1 -= mq[3][1] * y[25]; a0 -= mq[3][2] * x[26]; b0 -= mq[3][2] * y[26]; a1 -= mq[3][3] * x[27]; b1 -= mq[3][3] * y[27]; x[28] = a0 + a1; y[28] = b0 + b1; up[3584] = x[28]; wp[3584] = f2bf(-y[28]); mq[3] = *(const LAS f32x4*)(Mg + 1876);
            { const float br = betg[29]; a0 = bf2f(*(const LAS bf16_t*)(lg + P5_VS + 7888 + c * 2)) * br; b0 = bf2f(*(const LAS bf16_t*)(lg + P5_KS + 7888 + c * 2)) * br * __expf(decg[29]); a1 = 0.f; b1 = 0.f; } a0 -= mq[4][0] * x[0]; b0 -= mq[4][0] * y[0]; a1 -= mq[4][1] * x[1]; b1 -= mq[4][1] * y[1]; a0 -= mq[4][2] * x[2]; b0 -= mq[4][2] * y[2]; a1 -= mq[4][3] * x[3]; b1 -= mq[4][3] * y[3]; mq[4] = *(const LAS f32x4*)(Mg + 1880);
            a0 -= mq[5][0] * x[4]; b0 -= mq[5][0] * y[4]; a1 -= mq[5][1] * x[5]; b1 -= mq[5][1] * y[5]; a0 -= mq[5][2] * x[6]; b0 -= mq[5][2] * y[6]; a1 -= mq[5][3] * x[7]; b1 -= mq[5][3] * y[7]; mq[5] = *(const LAS f32x4*)(Mg + 1884);
            a0 -= mq[0][0] * x[8]; b0 -= mq[0][0] * y[8]; a1 -= mq[0][1] * x[9]; b1 -= mq[0][1] * y[9]; a0 -= mq[0][2] * x[10]; b0 -= mq[0][2] * y[10]; a1 -= mq[0][3] * x[11]; b1 -= mq[0][3] * y[11]; mq[0] = *(const LAS f32x4*)(Mg + 1920);
            a0 -= mq[1][0] * x[12]; b0 -= mq[1][0] * y[12]; a1 -= mq[1][1] * x[13]; b1 -= mq[1][1] * y[13]; a0 -= mq[1][2] * x[14]; b0 -= mq[1][2] * y[14]; a1 -= mq[1][3] * x[15]; b1 -= mq[1][3] * y[15]; mq[1] = *(const LAS f32x4*)(Mg + 1924);
            a0 -= mq[2][0] * x[16]; b0 -= mq[2][0] * y[16]; a1 -= mq[2][1] * x[17]; b1 -= mq[2][1] * y[17]; a0 -= mq[2][2] * x[18]; b0 -= mq[2][2] * y[18]; a1 -= mq[2][3] * x[19]; b1 -= mq[2][3] * y[19]; mq[2] = *(const LAS f32x4*)(Mg + 1928);
            a0 -= mq[3][0] * x[20]; b0 -= mq[3][0] * y[20]; a1 -= mq[3][1] * x[21]; b1 -= mq[3][1] * y[21]; a0 -= mq[3][2] * x[22]; b0 -= mq[3][2] * y[22]; a1 -= mq[3][3] * x[23]; b1 -= mq[3][3] * y[23]; mq[3] = *(const LAS f32x4*)(Mg + 1932);
            a0 -= mq[4][0] * x[24]; b0 -= mq[4][0] * y[24]; a1 -= mq[4][1] * x[25]; b1 -= mq[4][1] * y[25]; a0 -= mq[4][2] * x[26]; b0 -= mq[4][2] * y[26]; a1 -= mq[4][3] * x[27]; b1 -= mq[4][3] * y[27]; mq[4] = *(const LAS f32x4*)(Mg + 1936);
            a0 -= mq[5][0] * x[28]; b0 -= mq[5][0] * y[28]; x[29] = a0 + a1; y[29] = b0 + b1; up[3712] = x[29]; wp[3712] = f2bf(-y[29]); mq[5] = *(const LAS f32x4*)(Mg + 1940);
            { const float br = betg[30]; a0 = bf2f(*(const LAS bf16_t*)(lg + P5_VS + 8160 + c * 2)) * br; b0 = bf2f(*(const LAS bf16_t*)(lg + P5_KS + 8160 + c * 2)) * br * __expf(decg[30]); a1 = 0.f; b1 = 0.f; } a0 -= mq[0][0] * x[0]; b0 -= mq[0][0] * y[0]; a1 -= mq[0][1] * x[1]; b1 -= mq[0][1] * y[1]; a0 -= mq[0][2] * x[2]; b0 -= mq[0][2] * y[2]; a1 -= mq[0][3] * x[3]; b1 -= mq[0][3] * y[3]; mq[0] = *(const LAS f32x4*)(Mg + 1944);
            a0 -= mq[1][0] * x[4]; b0 -= mq[1][0] * y[4]; a1 -= mq[1][1] * x[5]; b1 -= mq[1][1] * y[5]; a0 -= mq[1][2] * x[6]; b0 -= mq[1][2] * y[6]; a1 -= mq[1][3] * x[7]; b1 -= mq[1][3] * y[7]; mq[1] = *(const LAS f32x4*)(Mg + 1948);
            a0 -= mq[2][0] * x[8]; b0 -= mq[2][0] * y[8]; a1 -= mq[2][1] * x[9]; b1 -= mq[2][1] * y[9]; a0 -= mq[2][2] * x[10]; b0 -= mq[2][2] * y[10]; a1 -= mq[2][3] * x[11]; b1 -= mq[2][3] * y[11]; mq[2] = *(const LAS f32x4*)(Mg + 1984);
            a0 -= mq[3][0] * x[12]; b0 -= mq[3][0] * y[12]; a1 -= mq[3][1] * x[13]; b1 -= mq[3][1] * y[13]; a0 -= mq[3][2] * x[14]; b0 -= mq[3][2] * y[14]; a1 -= mq[3][3] * x[15]; b1 -= mq[3][3] * y[15]; mq[3] = *(const LAS f32x4*)(Mg + 1988);
            a0 -= mq[4][0] * x[16]; b0 -= mq[4][0] * y[16]; a1 -= mq[4][1] * x[17]; b1 -= mq[4][1] * y[17]; a0 -= mq[4][2] * x[18]; b0 -= mq[4][2] * y[18]; a1 -= mq[4][3] * x[19]; b1 -= mq[4][3] * y[19]; mq[4] = *(const LAS f32x4*)(Mg + 1992);
            a0 -= mq[5][0] * x[20]; b0 -= mq[5][0] * y[20]; a1 -= mq[5][1] * x[21]; b1 -= mq[5][1] * y[21]; a0 -= mq[5][2] * x[22]; b0 -= mq[5][2] * y[22]; a1 -= mq[5][3] * x[23]; b1 -= mq[5][3] * y[23]; mq[5] = *(const LAS f32x4*)(Mg + 1996);
            a0 -= mq[0][0] * x[24]; b0 -= mq[0][0] * y[24]; a1 -= mq[0][1] * x[25]; b1 -= mq[0][1] * y[25]; a0 -= mq[0][2] * x[26]; b0 -= mq[0][2] * y[26]; a1 -= mq[0][3] * x[27]; b1 -= mq[0][3] * y[27]; mq[0] = *(const LAS f32x4*)(Mg + 2000);
            a0 -= mq[1][0] * x[28]; b0 -= mq[1][0] * y[28]; a1 -= mq[1][1] * x[29]; b1 -= mq[1][1] * y[29]; x[30] = a0 + a1; y[30] = b0 + b1; up[3840] = x[30]; wp[3840] = f2bf(-y[30]); mq[1] = *(const LAS f32x4*)(Mg + 2004);
            { const float br = betg[31]; a0 = bf2f(*(const LAS bf16_t*)(lg + P5_VS + 8432 + c * 2)) * br; b0 = bf2f(*(const LAS bf16_t*)(lg + P5_KS + 8432 + c * 2)) * br * __expf(decg[31]); a1 = 0.f; b1 = 0.f; } a0 -= mq[2][0] * x[0]; b0 -= mq[2][0] * y[0]; a1 -= mq[2][1] * x[1]; b1 -= mq[2][1] * y[1]; a0 -= mq[2][2] * x[2]; b0 -= mq[2][2] * y[2]; a1 -= mq[2][3] * x[3]; b1 -= mq[2][3] * y[3]; mq[2] = *(const LAS f32x4*)(Mg + 2008);
            a0 -= mq[3][0] * x[4]; b0 -= mq[3][0] * y[4]; a1 -= mq[3][1] * x[5]; b1 -= mq[3][1] * y[5]; a0 -= mq[3][2] * x[6]; b0 -= mq[3][2] * y[6]; a1 -= mq[3][3] * x[7]; b1 -= mq[3][3] * y[7]; mq[3] = *(const LAS f32x4*)(Mg + 2012);
            a0 -= mq[4][0] * x[8]; b0 -= mq[4][0] * y[8]; a1 -= mq[4][1] * x[9]; b1 -= mq[4][1] * y[9]; a0 -= mq[4][2] * x[10]; b0 -= mq[4][2] * y[10]; a1 -= mq[4][3] * x[11]; b1 -= mq[4][3] * y[11]; mq[4] = *(const LAS f32x4*)(Mg + 2048);
            a0 -= mq[5][0] * x[12]; b0 -= mq[5][0] * y[12]; a1 -= mq[5][1] * x[13]; b1 -= mq[5][1] * y[13]; a0 -= mq[5][2] * x[14]; b0 -= mq[5][2] * y[14]; a1 -= mq[5][3] * x[15]; b1 -= mq[5][3] * y[15]; mq[5] = *(const LAS f32x4*)(Mg + 2052);
            a0 -= mq[0][0] * x[16]; b0 -= mq[0][0] * y[16]; a1 -= mq[0][1] * x[17]; b1 -= mq[0][1] * y[17]; a0 -= mq[0][2] * x[18]; b0 -= mq[0][2] * y[18]; a1 -= mq[0][3] * x[19]; b1 -= mq[0][3] * y[19]; mq[0] = *(const LAS f32x4*)(Mg + 2056);
            a0 -= mq[1][0] * x[20]; b0 -= mq[1][0] * y[20]; a1 -= mq[1][1] * x[21]; b1 -= mq[1][1] * y[21]; a0 -= mq[1][2] * x[22]; b0 -= mq[1][2] * y[22]; a1 -= mq[1][3] * x[23]; b1 -= mq[1][3] * y[23]; mq[1] = *(const LAS f32x4*)(Mg + 2060);
            a0 -= mq[2][0] * x[24]; b0 -= mq[2][0] * y[24]; a1 -= mq[2][1] * x[25]; b1 -= mq[2][1] * y[25]; a0 -= mq[2][2] * x[26]; b0 -= mq[2][2] * y[26]; a1 -= mq[2][3] * x[27]; b1 -= mq[2][3] * y[27]; mq[2] = *(const LAS f32x4*)(Mg + 2064);
            a0 -= mq[3][0] * x[28]; b0 -= mq[3][0] * y[28]; a1 -= mq[3][1] * x[29]; b1 -= mq[3][1] * y[29]; a0 -= mq[3][2] * x[30]; b0 -= mq[3][2] * y[30]; x[31] = a0 + a1; y[31] = b0 + b1; up[3968] = x[31]; wp[3968] = f2bf(-y[31]); mq[3] = *(const LAS f32x4*)(Mg + 2068);
            { const float br = betg[32]; a0 = bf2f(*(const LAS bf16_t*)(lg + P5_VS + 8704 + c * 2)) * br; b0 = bf2f(*(const LAS bf16_t*)(lg + P5_KS + 8704 + c * 2)) * br * __expf(decg[32]); a1 = 0.f; b1 = 0.f; } a0 -= mq[4][0] * x[0]; b0 -= mq[4][0] * y[0]; a1 -= mq[4][1] * x[1]; b1 -= mq[4][1] * y[1]; a0 -= mq[4][2] * x[2]; b0 -= mq[4][2] * y[2]; a1 -= mq[4][3] * x[3]; b1 -= mq[4][3] * y[3]; mq[4] = *(const LAS f32x4*)(Mg + 2072);
            a0 -= mq[5][0] * x[4]; b0 -= mq[5][0] * y[4]; a1 -= mq[5][1] * x[5]; b1 -= mq[5][1] * y[5]; a0 -= mq[5][2] * x[6]; b0 -= mq[5][2] * y[6]; a1 -= mq[5][3] * x[7]; b1 -= mq[5][3] * y[7]; mq[5] = *(const LAS f32x4*)(Mg + 2076);
            a0 -= mq[0][0] * x[8]; b0 -= mq[0][0] * y[8]; a1 -= mq[0][1] * x[9]; b1 -= mq[0][1] * y[9]; a0 -= mq[0][2] * x[10]; b0 -= mq[0][2] * y[10]; a1 -= mq[0][3] * x[11]; b1 -= mq[0][3] * y[11]; mq[0] = *(const LAS f32x4*)(Mg + 2112);
            a0 -= mq[1][0] * x[12]; b0 -= mq[1][0] * y[12]; a1 -= mq[1][1] * x[13]; b1 -= mq[1][1] * y[13]; a0 -= mq[1][2] * x[14]; b0 -= mq[1][2] * y[14]; a1 -= mq[1][3] * x[15]; b1 -= mq[1][3] * y[15]; mq[1] = *(const LAS f32x4*)(Mg + 2116);
            a0 -= mq[2][0] * x[16]; b0 -= mq[2][0] * y[16]; a1 -= mq[2][1] * x[17]; b1 -= mq[2][1] * y[17]; a0 -= mq[2][2] * x[18]; b0 -= mq[2][2] * y[18]; a1 -= mq[2][3] * x[19]; b1 -= mq[2][3] * y[19]; mq[2] = *(const LAS f32x4*)(Mg + 2120);
            a0 -= mq[3][0] * x[20]; b0 -= mq[3][0] * y[20]; a1 -= mq[3][1] * x[21]; b1 -= mq[3][1] * y[21]; a0 -= mq[3][2] * x[22]; b0 -= mq[3][2] * y[22]; a1 -= mq[3][3] * x[23]; b1 -= mq[3][3] * y[23]; mq[3] = *(const LAS f32x4*)(Mg + 2124);
            a0 -= mq[4][0] * x[24]; b0 -= mq[4][0] * y[24]; a1 -= mq[4][1] * x[25]; b1 -= mq[4][1] * y[25]; a0 -= mq[4][2] * x[26]; b0 -= mq[4][2] * y[26]; a1 -= mq[4][3] * x[27]; b1 -= mq[4][3] * y[27]; mq[4] = *(const LAS f32x4*)(Mg + 2128);
            a0 -= mq[5][0] * x[28]; b0 -= mq[5][0] * y[28]; a1 -= mq[5][1] * x[29]; b1 -= mq[5][1] * y[29]; a0 -= mq[5][2] * x[30]; b0 -= mq[5][2] * y[30]; a1 -= mq[5][3] * x[31]; b1 -= mq[5][3] * y[31]; x[32] = a0 + a1; y[32] = b0 + b1; up[4096] = x[32]; wp[4096] = f2bf(-y[32]); mq[5] = *(const LAS f32x4*)(Mg + 2132);
            { const float br = betg[33]; a0 = bf2f(*(const LAS bf16_t*)(lg + P5_VS + 8976 + c * 2)) * br; b0 = bf2f(*(const LAS bf16_t*)(lg + P5_KS + 8976 + c * 2)) * br * __expf(decg[33]); a1 = 0.f; b1 = 0.f; } a0 -= mq[0][0] * x[0]; b0 -= mq[0][0] * y[0]; a1 -= mq[0][1] * x[1]; b1 -= mq[0][1] * y[1]; a0 -= mq[0][2] * x[2]; b0 -= mq[0][2] * y[2]; a1 -= mq[0][3] * x[3]; b1 -= mq[0][3] * y[3]; mq[0] = *(const LAS f32x4*)(Mg + 2136);
            a0 -= mq[1][0] * x[4]; b0 -= mq[1][0] * y[4]; a1 -= mq[1][1] * x[5]; b1 -= mq[1][1] * y[5]; a0 -= mq[1][2] * x[6]; b0 -= mq[1][2] * y[6]; a1 -= mq[1][3] * x[7]; b1 -= mq[1][3] * y[7]; mq[1] = *(const LAS f32x4*)(Mg + 2140);
            a0 -= mq[2][0] * x[8]; b0 -= mq[2][0] * y[8]; a1 -= mq[2][1] * x[9]; b1 -= mq[2][1] * y[9]; a0 -= mq[2][2] * x[10]; b0 -= mq[2][2] * y[10]; a1 -= mq[2][3] * x[11]; b1 -= mq[2][3] * y[11]; mq[2] = *(const LAS f32x4*)(Mg + 2144);
            a0 -= mq[3][0] * x[12]; b0 -= mq[3][0] * y[12]; a1 -= mq[3][1] * x[13]; b1 -= mq[3][1] * y[13]; a0 -= mq[3][2] * x[14]; b0 -= mq[3][2] * y[14]; a1 -= mq[3][3] * x[15]; b1 -= mq[3][3] * y[15]; mq[3] = *(const LAS f32x4*)(Mg + 2176);
            a0 -= mq[4][0] * x[16]; b0 -= mq[4][0] * y[16]; a1 -= mq[4][1] * x[17]; b1 -= mq[4][1] * y[17]; a0 -= mq[4][2] * x[18]; b0 -= mq[4][2] * y[18]; a1 -= mq[4][3] * x[19]; b1 -= mq[4][3] * y[19]; mq[4] = *(const LAS f32x4*)(Mg + 2180);
            a0 -= mq[5][0] * x[20]; b0 -= mq[5][0] * y[20]; a1 -= mq[5][1] * x[21]; b1 -= mq[5][1] * y[21]; a0 -= mq[5][2] * x[22]; b0 -= mq[5][2] * y[22]; a1 -= mq[5][3] * x[23]; b1 -= mq[5][3] * y[23]; mq[5] = *(const LAS f32x4*)(Mg + 2184);
            a0 -= mq[0][0] * x[24]; b0 -= mq[0][0] * y[24]; a1 -= mq[0][1] * x[25]; b1 -= mq[0][1] * y[25]; a0 -= mq[0][2] * x[26]; b0 -= mq[0][2] * y[26]; a1 -= mq[0][3] * x[27]; b1 -= mq[0][3] * y[27]; mq[0] = *(const LAS f32x4*)(Mg + 2188);
            a0 -= mq[1][0] * x[28]; b0 -= mq[1][0] * y[28]; a1 -= mq[1][1] * x[29]; b1 -= mq[1][1] * y[29]; a0 -= mq[1][2] * x[30]; b0 -= mq[1][2] * y[30]; a1 -= mq[1][3] * x[31]; b1 -= mq[1][3] * y[31]; mq[1] = *(const LAS f32x4*)(Mg + 2192);
            a0 -= mq[2][0] * x[32]; b0 -= mq[2][0] * y[32]; x[33] = a0 + a1; y[33] = b0 + b1; up[4224] = x[33]; wp[4224] = f2bf(-y[33]); mq[2] = *(const LAS f32x4*)(Mg + 2196);
            { const float br = betg[34]; a0 = bf2f(*(const LAS bf16_t*)(lg + P5_VS + 9248 + c * 2)) * br; b0 = bf2f(*(const LAS bf16_t*)(lg + P5_KS + 9248 + c * 2)) * br * __expf(decg[34]); a1 = 0.f; b1 = 0.f; } a0 -= mq[3][0] * x[0]; b0 -= mq[3][0] * y[0]; a1 -= mq[3][1] * x[1]; b1 -= mq[3][1] * y[1]; a0 -= mq[3][2] * x[2]; b0 -= mq[3][2] * y[2]; a1 -= mq[3][3] * x[3]; b1 -= mq[3][3] * y[3]; mq[3] = *(const LAS f32x4*)(Mg + 2200);
            a0 -= mq[4][0] * x[4]; b0 -= mq[4][0] * y[4]; a1 -= mq[4][1] * x[5]; b1 -= mq[4][1] * y[5]; a0 -= mq[4][2] * x[6]; b0 -= mq[4][2] * y[6]; a1 -= mq[4][3] * x[7]; b1 -= mq[4][3] * y[7]; mq[4] = *(const LAS f32x4*)(Mg + 2204);
            a0 -= mq[5][0] * x[8]; b0 -= mq[5][0] * y[8]; a1 -= mq[5][1] * x[9]; b1 -= mq[5][1] * y[9]; a0 -= mq[5][2] * x[10]; b0 -= mq[5][2] * y[10]; a1 -= mq[5][3] * x[11]; b1 -= mq[5][3] * y[11]; mq[5] = *(const LAS f32x4*)(Mg + 2208);
            a0 -= mq[0][0] * x[12]; b0 -= mq[0][0] * y[12]; a1 -= mq[0][1] * x[13]; b1 -= mq[0][1] * y[13]; a0 -= mq[0][2] * x[14]; b0 -= mq[0][2] * y[14]; a1 -= mq[0][3] * x[15]; b1 -= mq[0][3] * y[15]; mq[0] = *(const LAS f32x4*)(Mg + 2240);
            a0 -= mq[1][0] * x[16]; b0 -= mq[1][0] * y[16]; a1 -= mq[1][1] * x[17]; b1 -= mq[1][1] * y[17]; a0 -= mq[1][2] * x[18]; b0 -= mq[1][2] * y[18]; a1 -= mq[1][3] * x[19]; b1 -= mq[1][3] * y[19]; mq[1] = *(const LAS f32x4*)(Mg + 2244);
            a0 -= mq[2][0] * x[20]; b0 -= mq[2][0] * y[20]; a1 -= mq[2][1] * x[21]; b1 -= mq[2][1] * y[21]; a0 -= mq[2][2] * x[22]; b0 -= mq[2][2] * y[22]; a1 -= mq[2][3] * x[23]; b1 -= mq[2][3] * y[23]; mq[2] = *(const LAS f32x4*)(Mg + 2248);
            a0 -= mq[3][0] * x[24]; b0 -= mq[3][0] * y[24]; a1 -= mq[3][1] * x[25]; b1 -= mq[3][1] * y[25]; a0 -= mq[3][2] * x[26]; b0 -= mq[3][2] * y[26]; a1 -= mq[3][3] * x[27]; b1 -= mq[3][3] * y[27]; mq[3] = *(const LAS f32x4*)(Mg + 2252);
            a0 -= mq[4][0] * x[28]; b0 -= mq[4][0] * y[28]; a1 -= mq[4][1] * x[29]; b1 -= mq[4][1] * y[29]; a0 -= mq[4][2] * x[30]; b0 -= mq[4][2] * y[30]; a1 -= mq[4][3] * x[31]; b1 -= mq[4][3] * y[31]; mq[4] = *(const LAS f32x4*)(Mg + 2256);
            a0 -= mq[5][0] * x[32]; b0 -= mq[5][0] * y[32]; a1 -= mq[5][1] * x[33]; b1 -= mq[5][1] * y[33]; x[34] = a0 + a1; y[34] = b0 + b1; up[4352] = x[34]; wp[4352] = f2bf(-y[34]); mq[5] = *(const LAS f32x4*)(Mg + 2260);
            { const float br = betg[35]; a0 = bf2f(*(const LAS bf16_t*)(lg + P5_VS + 9520 + c * 2)) * br; b0 = bf2f(*(const LAS bf16_t*)(lg + P5_KS + 9520 + c * 2)) * br * __expf(decg[35]); a1 = 0.f; b1 = 0.f; } a0 -= mq[0][0] * x[0]; b0 -= mq[0][0] * y[0]; a1 -= mq[0][1] * x[1]; b1 -= mq[0][1] * y[1]; a0 -= mq[0][2] * x[2]; b0 -= mq[0][2] * y[2]; a1 -= mq[0][3] * x[3]; b1 -= mq[0][3] * y[3]; mq[0] = *(const LAS f32x4*)(Mg + 2264);
            a0 -= mq[1][0] * x[4]; b0 -= mq[1][0] * y[4]; a1 -= mq[1][1] * x[5]; b1 -= mq[1][1] * y[5]; a0 -= mq[1][2] * x[6]; b0 -= mq[1][2] * y[6]; a1 -= mq[1][3] * x[7]; b1 -= mq[1][3] * y[7]; mq[1] = *(const LAS f32x4*)(Mg + 2268);
            a0 -= mq[2][0] * x[8]; b0 -= mq[2][0] * y[8]; a1 -= mq[2][1] * x[9]; b1 -= mq[2][1] * y[9]; a0 -= mq[2][2] * x[10]; b0 -= mq[2][2] * y[10]; a1 -= mq[2][3] * x[11]; b1 -= mq[2][3] * y[11]; mq[2] = *(const LAS f32x4*)(Mg + 2272);
            a0 -= mq[3][0] * x[12]; b0 -= mq[3][0] * y[12]; a1 -= mq[3][1] * x[13]; b1 -= mq[3][1] * y[13]; a0 -= mq[3][2] * x[14]; b0 -= mq[3][2] * y[14]; a1 -= mq[3][3] * x[15]; b1 -= mq[3][3] * y[15]; mq[3] = *(const LAS f32x4*)(Mg + 2304);
            a0 -= mq[4][0] * x[16]; b0 -= mq[4][0] * y[16]; a1 -= mq[4][1] * x[17]; b1 -= mq[4][1] * y[17]; a0 -= mq[4][2] * x[18]; b0 -= mq[4][2] * y[18]; a1 -= mq[4][3] * x[19]; b1 -= mq[4][3] * y[19]; mq[4] = *(const LAS f32x4*)(Mg + 2308);
            a0 -= mq[5][0] * x[20]; b0 -= mq[5][0] * y[20]; a1 -= mq[5][1] * x[21]; b1 -= mq[5][1] * y[21]; a0 -= mq[5][2] * x[22]; b0 -= mq[5][2] * y[22]; a1 -= mq[5][3] * x[23]; b1 -= mq[5][3] * y[23]; mq[5] = *(const LAS f32x4*)(Mg + 2312);
            a0 -= mq[0][0] * x[24]; b0 -= mq[0][0] * y[24]; a1 -= mq[0][1] * x[25]; b1 -= mq[0][1] * y[25]; a0 -= mq[0][2] * x[26]; b0 -= mq[0][2] * y[26]; a1 -= mq[0][3] * x[27]; b1 -= mq[0][3] * y[27]; mq[0] = *(const LAS f32x4*)(Mg + 2316);
            a0 -= mq[1][0] * x[28]; b0 -= mq[1][0] * y[28]; a1 -= mq[1][1] * x[29]; b1 -= mq[1][1] * y[29]; a0 -= mq[1][2] * x[30]; b0 -= mq[1][2] * y[30]; a1 -= mq[1][3] * x[31]; b1 -= mq[1][3] * y[31]; mq[1] = *(const LAS f32x4*)(Mg + 2320);
            a0 -= mq[2][0] * x[32]; b0 -= mq[2][0] * y[32]; a1 -= mq[2][1] * x[33]; b1 -= mq[2][1] * y[33]; a0 -= mq[2][2] * x[34]; b0 -= mq[2][2] * y[34]; x[35] = a0 + a1; y[35] = b0 + b1; up[4480] = x[35]; wp[4480] = f2bf(-y[35]); mq[2] = *(const LAS f32x4*)(Mg + 2324);
            { const float br = betg[36]; a0 = bf2f(*(const LAS bf16_t*)(lg + P5_VS + 9792 + c * 2)) * br; b0 = bf2f(*(const LAS bf16_t*)(lg + P5_KS + 9792 + c * 2)) * br * __expf(decg[36]); a1 = 0.f; b1 = 0.f; } a0 -= mq[3][0] * x[0]; b0 -= mq[3][0] * y[0]; a1 -= mq[3][1] * x[1]; b1 -= mq[3][1] * y[1]; a0 -= mq[3][2] * x[2]; b0 -= mq[3][2] * y[2]; a1 -= mq[3][3] * x[3]; b1 -= mq[3][3] * y[3]; mq[3] = *(const LAS f32x4*)(Mg + 2328);
            a0 -= mq[4][0] * x[4]; b0 -= mq[4][0] * y[4]; a1 -= mq[4][1] * x[5]; b1 -= mq[4][1] * y[5]; a0 -= mq[4][2] * x[6]; b0 -= mq[4][2] * y[6]; a1 -= mq[4][3] * x[7]; b1 -= mq[4][3] * y[7]; mq[4] = *(const LAS f32x4*)(Mg + 2332);
            a0 -= mq[5][0] * x[8]; b0 -= mq[5][0] * y[8]; a1 -= mq[5][1] * x[9]; b1 -= mq[5][1] * y[9]; a0 -= mq[5][2] * x[10]; b0 -= mq[5][2] * y[10]; a1 -= mq[5][3] * x[11]; b1 -= mq[5][3] * y[11]; mq[5] = *(const LAS f32x4*)(Mg + 2336);
            a0 -= mq[0][0] * x[12]; b0 -= mq[0][0] * y[12]; a1 -= mq[0][1] * x[13]; b1 -= mq[0][1] * y[13]; a0 -= mq[0][2] * x[14]; b0 -= mq[0][2] * y[14]; a1 -= mq[0][3] * x[15]; b1 -= mq[0][3] * y[15]; mq[0] = *(const LAS f32x4*)(Mg + 2368);
            a0 -= mq[1][0] * x[16]; b0 -= mq[1][0] * y[16]; a1 -= mq[1][1] * x[17]; b1 -= mq[1][1] * y[17]; a0 -= mq[1][2] * x[18]; b0 -= mq[1][2] * y[18]; a1 -= mq[1][3] * x[19]; b1 -= mq[1][3] * y[19]; mq[1] = *(const LAS f32x4*)(Mg + 2372);
            a0 -= mq[2][0] * x[20]; b0 -= mq[2][0] * y[20]; a1 -= mq[2][1] * x[21]; b1 -= mq[2][1] * y[21]; a0 -= mq[2][2] * x[22]; b0 -= mq[2][2] * y[22]; a1 -= mq[2][3] * x[23]; b1 -= mq[2][3] * y[23]; mq[2] = *(const LAS f32x4*)(Mg + 2376);
            a0 -= mq[3][0] * x[24]; b0 -= mq[3][0] * y[24]; a1 -= mq[3][1] * x[25]; b1 -= mq[3][1] * y[25]; a0 -= mq[3][2] * x[26]; b0 -= mq[3][2] * y[26]; a1 -= mq[3][3] * x[27]; b1 -= mq[3][3] * y[27]; mq[3] = *(const LAS f32x4*)(Mg + 2380);
            a0 -= mq[4][0] * x[28]; b0 -= mq[4][0] * y[28]; a1 -= mq[4][1] * x[29]; b1 -= mq[4][1] * y[29]; a0 -= mq[4][2] * x[30]; b0 -= mq[4][2] * y[30]; a1 -= mq[4][3] * x[31]; b1 -= mq[4][3] * y[31]; mq[4] = *(const LAS f32x4*)(Mg + 2384);
            a0 -= mq[5][0] * x[32]; b0 -= mq[5][0] * y[32]; a1 -= mq[5][1] * x[33]; b1 -= mq[5][1] * y[33]; a0 -= mq[5][2] * x[34]; b0 -= mq[5][2] * y[34]; a1 -= mq[5][3] * x[35]; b1 -= mq[5][3] * y[35]; x[36] = a0 + a1; y[36] = b0 + b1; up[4608] = x[36]; wp[4608] = f2bf(-y[36]); mq[5] = *(const LAS f32x4*)(Mg + 2388);
            { const float br = betg[37]; a0 = bf2f(*(const LAS bf16_t*)(lg + P5_VS + 10064 + c * 2)) * br; b0 = bf2f(*(const LAS bf16_t*)(lg + P5_KS + 10064 + c * 2)) * br * __expf(decg[37]); a1 = 0.f; b1 = 0.f; } a0 -= mq[0][0] * x[0]; b0 -= mq[0][0] * y[0]; a1 -= mq[0][1] * x[1]; b1 -= mq[0][1] * y[1]; a0 -= mq[0][2] * x[2]; b0 -= mq[0][2] * y[2]; a1 -= mq[0][3] * x[3]; b1 -= mq[0][3] * y[3]; mq[0] = *(const LAS f32x4*)(Mg + 2392);
            a0 -= mq[1][0] * x[4]; b0 -= mq[1][0] * y[4]; a1 -= mq[1][1] * x[5]; b1 -= mq[1][1] * y[5]; a0 -= mq[1][2] * x[6]; b0 -= mq[1][2] * y[6]; a1 -= mq[1][3] * x[7]; b1 -= mq[1][3] * y[7]; mq[1] = *(const LAS f32x4*)(Mg + 2396);
            a0 -= mq[2][0] * x[8]; b0 -= mq[2][0] * y[8]; a1 -= mq[2][1] * x[9]; b1 -= mq[2][1] * y[9]; a0 -= mq[2][2] * x[10]; b0 -= mq[2][2] * y[10]; a1 -= mq[2][3] * x[11]; b1 -= mq[2][3] * y[11]; mq[2] = *(const LAS f32x4*)(Mg + 2400);
            a0 -= mq[3][0] * x[12]; b0 -= mq[3][0] * y[12]; a1 -= mq[3][1] * x[13]; b1 -= mq[3][1] * y[13]; a0 -= mq[3][2] * x[14]; b0 -= mq[3][2] * y[14]; a1 -= mq[3][3] * x[15]; b1 -= mq[3][3] * y[15]; mq[3] = *(const LAS f32x4*)(Mg + 2404);
            a0 -= mq[4][0] * x[16]; b0 -= mq[4][0] * y[16]; a1 -= mq[4][1] * x[17]; b1 -= mq[4][1] * y[17]; a0 -= mq[4][2] * x[18]; b0 -= mq[4][2] * y[18]; a1 -= mq[4][3] * x[19]; b1 -= mq[4][3] * y[19]; mq[4] = *(const LAS f32x4*)(Mg + 2432);
            a0 -= mq[5][0] * x[20]; b0 -= mq[5][0] * y[20]; a1 -= mq[5][1] * x[21]; b1 -= mq[5][1] * y[21]; a0 -= mq[5][2] * x[22]; b0 -= mq[5][2] * y[22]; a1 -= mq[5][3] * x[23]; b1 -= mq[5][3] * y[23]; mq[5] = *(const LAS f32x4*)(Mg + 2436);
            a0 -= mq[0][0] * x[24]; b0 -= mq[0][0] * y[24]; a1 -= mq[0][1] * x[25]; b1 -= mq[0][1] * y[25]; a0 -= mq[0][2] * x[26]; b0 -= mq[0][2] * y[26]; a1 -= mq[0][3] * x[27]; b1 -= mq[0][3] * y[27]; mq[0] = *(const LAS f32x4*)(Mg + 2440);
            a0 -= mq[1][0] * x[28]; b0 -= mq[1][0] * y[28]; a1 -= mq[1][1] * x[29]; b1 -= mq[1][1] * y[29]; a0 -= mq[1][2] * x[30]; b0 -= mq[1][2] * y[30]; a1 -= mq[1][3] * x[31]; b1 -= mq[1][3] * y[31]; mq[1] = *(const LAS f32x4*)(Mg + 2444);
            a0 -= mq[2][0] * x[32]; b0 -= mq[2][0] * y[32]; a1 -= mq[2][1] * x[33]; b1 -= mq[2][1] * y[33]; a0 -= mq[2][2] * x[34]; b0 -= mq[2][2] * y[34]; a1 -= mq[2][3] * x[35]; b1 -= mq[2][3] * y[35]; mq[2] = *(const LAS f32x4*)(Mg + 2448);
            a0 -= mq[3][0] * x[36]; b0 -= mq[3][0] * y[36]; x[37] = a0 + a1; y[37] = b0 + b1; up[4736] = x[37]; wp[4736] = f2bf(-y[37]); mq[3] = *(const LAS f32x4*)(Mg + 2452);
            { const float br = betg[38]; a0 = bf2f(*(const LAS bf16_t*)(lg + P5_VS + 10336 + c * 2)) * br; b0 = bf2f(*(const LAS bf16_t*)(lg + P5_KS + 10336 + c * 2)) * br * __expf(decg[38]); a1 = 0.f; b1 = 0.f; } a0 -= mq[4][0] * x[0]; b0 -= mq[4][0] * y[0]; a1 -= mq[4][1] * x[1]; b1 -= mq[4][1] * y[1]; a0 -= mq[4][2] * x[2]; b0 -= mq[4][2] * y[2]; a1 -= mq[4][3] * x[3]; b1 -= mq[4][3] * y[3]; mq[4] = *(const LAS f32x4*)(Mg + 2456);
            a0 -= mq[5][0] * x[4]; b0 -= mq[5][0] * y[4]; a1 -= mq[5][1] * x[5]; b1 -= mq[5][1] * y[5]; a0 -= mq[5][2] * x[6]; b0 -= mq[5][2] * y[6]; a1 -= mq[5][3] * x[7]; b1 -= mq[5][3] * y[7]; mq[5] = *(const LAS f32x4*)(Mg + 2460);
            a0 -= mq[0][0] * x[8]; b0 -= mq[0][0] * y[8]; a1 -= mq[0][1] * x[9]; b1 -= mq[0][1] * y[9]; a0 -= mq[0][2] * x[10]; b0 -= mq[0][2] * y[10]; a1 -= mq[0][3] * x[11]; b1 -= mq[0][3] * y[11]; mq[0] = *(const LAS f32x4*)(Mg + 2464);
            a0 -= mq[1][0] * x[12]; b0 -= mq[1][0] * y[12]; a1 -= mq[1][1] * x[13]; b1 -= mq[1][1] * y[13]; a0 -= mq[1][2] * x[14]; b0 -= mq[1][2] * y[14]; a1 -= mq[1][3] * x[15]; b1 -= mq[1][3] * y[15]; mq[1] = *(const LAS f32x4*)(Mg + 2468);
            a0 -= mq[2][0] * x[16]; b0 -= mq[2][0] * y[16]; a1 -= mq[2][1] * x[17]; b1 -= mq[2][1] * y[17]; a0 -= mq[2][2] * x[18]; b0 -= mq[2][2] * y[18]; a1 -= mq[2][3] * x[19]; b1 -= mq[2][3] * y[19]; mq[2] = *(const LAS f32x4*)(Mg + 2496);
            a0 -= mq[3][0] * x[20]; b0 -= mq[3][0] * y[20]; a1 -= mq[3][1] * x[21]; b1 -= mq[3][1] * y[21]; a0 -= mq[3][2] * x[22]; b0 -= mq[3][2] * y[22]; a1 -= mq[3][3] * x[23]; b1 -= mq[3][3] * y[23]; mq[3] = *(const LAS f32x4*)(Mg + 2500);
            a0 -= mq[4][0] * x[24]; b0 -= mq[4][0] * y[24]; a1 -= mq[4][1] * x[25]; b1 -= mq[4][1] * y[25]; a0 -= mq[4][2] * x[26]; b0 -= mq[4][2] * y[26]; a1 -= mq[4][3] * x[27]; b1 -= mq[4][3] * y[27]; mq[4] = *(const LAS f32x4*)(Mg + 2504);
            a0 -= mq[5][0] * x[28]; b0 -= mq[5][0] * y[28]; a1 -= mq[5][1] * x[29]; b1 -= mq[5][1] * y[29]; a0 -= mq[5][2] * x[30]; b0 -= mq[5][2] * y[30]; a1 -= mq[5][3] * x[31]; b1 -= mq[5][3] * y[31]; mq[5] = *(const LAS f32x4*)(Mg + 2508);
            a0 -= mq[0][0] * x[32]; b0 -= mq[0][0] * y[32]; a1 -= mq[0][1] * x[33]; b1 -= mq[0][1] * y[33]; a0 -= mq[0][2] * x[34]; b0 -= mq[0][2] * y[34]; a1 -= mq[0][3] * x[35]; b1 -= mq[0][3] * y[35]; mq[0] = *(const LAS f32x4*)(Mg + 2512);
            a0 -= mq[1][0] * x[36]; b0 -= mq[1][0] * y[36]; a1 -= mq[1][1] * x[37]; b1 -= mq[1][1] * y[37]; x[38] = a0 + a1; y[38] = b0 + b1; up[4864] = x[38]; wp[4864] = f2bf(-y[38]); mq[1] = *(const LAS f32x4*)(Mg + 2516);
            { const float br = betg[39]; a0 = bf2f(*(const LAS bf16_t*)(lg + P5_VS + 10608 + c * 2)) * br; b0 = bf2f(*(const LAS bf16_t*)(lg + P5_KS + 10608 + c * 2)) * br * __expf(decg[39]); a1 = 0.f; b1 = 0.f; } a0 -= mq[2][0] * x[0]; b0 -= mq[2][0] * y[0]; a1 -= mq[2][1] * x[1]; b1 -= mq[2][1] * y[1]; a0 -= mq[2][2] * x[2]; b0 -= mq[2][2] * y[2]; a1 -= mq[2][3] * x[3]; b1 -= mq[2][3] * y[3]; mq[2] = *(const LAS f32x4*)(Mg + 2520);
            a0 -= mq[3][0] * x[4]; b0 -= mq[3][0] * y[4]; a1 -= mq[3][1] * x[5]; b1 -= mq[3][1] * y[5]; a0 -= mq[3][2] * x[6]; b0 -= mq[3][2] * y[6]; a1 -= mq[3][3] * x[7]; b1 -= mq[3][3] * y[7]; mq[3] = *(const LAS f32x4*)(Mg + 2524);
            a0 -= mq[4][0] * x[8]; b0 -= mq[4][0] * y[8]; a1 -= mq[4][1] * x[9]; b1 -= mq[4][1] * y[9]; a0 -= mq[4][2] * x[10]; b0 -= mq[4][2] * y[10]; a1 -= mq[4][3] * x[11]; b1 -= mq[4][3] * y[11]; mq[4] = *(const LAS f32x4*)(Mg + 2528);
            a0 -= mq[5][0] * x[12]; b0 -= mq[5][0] * y[12]; a1 -= mq[5][1] * x[13]; b1 -= mq[5][1] * y[13]; a0 -= mq[5][2] * x[14]; b0 -= mq[5][2] * y[14]; a1 -= mq[5][3] * x[15]; b1 -= mq[5][3] * y[15]; mq[5] = *(const LAS f32x4*)(Mg + 2532);
            a0 -= mq[0][0] * x[16]; b0 -= mq[0][0] * y[16]; a1 -= mq[0][1] * x[17]; b1 -= mq[0][1] * y[17]; a0 -= mq[0][2] * x[18]; b0 -= mq[0][2] * y[18]; a1 -= mq[0][3] * x[19]; b1 -= mq[0][3] * y[19]; mq[0] = *(const LAS f32x4*)(Mg + 2560);
            a0 -= mq[1][0] * x[20]; b0 -= mq[1][0] * y[20]; a1 -= mq[1][1] * x[21]; b1 -= mq[1][1] * y[21]; a0 -= mq[1][2] * x[22]; b0 -= mq[1][2] * y[22]; a1 -= mq[1][3] * x[23]; b1 -= mq[1][3] * y[23]; mq[1] = *(const LAS f32x4*)(Mg + 2564);
            a0 -= mq[2][0] * x[24]; b0 -= mq[2][0] * y[24]; a1 -= mq[2][1] * x[25]; b1 -= mq[2][1] * y[25]; a0 -= mq[2][2] * x[26]; b0 -= mq[2][2] * y[26]; a1 -= mq[2][3] * x[27]; b1 -= mq[2][3] * y[27]; mq[2] = *(const LAS f32x4*)(Mg + 2568);
            a0 -= mq[3][0] * x[28]; b0 -= mq[3][0] * y[28]; a1 -= mq[3][1] * x[29]; b1 -= mq[3][1] * y[29]; a0 -= mq[3][2] * x[30]; b0 -= mq[3][2] * y[30]; a1 -= mq[3][3] * x[31]; b1 -= mq[3][3] * y[31]; mq[3] = *(const LAS f32x4*)(Mg + 2572);
            a0 -= mq[4][0] * x[32]; b0 -= mq[4][0] * y[32]; a1 -= mq[4][1] * x[33]; b1 -= mq[4][1] * y[33]; a0 -= mq[4][2] * x[34]; b0 -= mq[4][2] * y[34]; a1 -= mq[4][3] * x[35]; b1 -= mq[4][3] * y[35]; mq[4] = *(const LAS f32x4*)(Mg + 2576);
            a0 -= mq[5][0] * x[36]; b0 -= mq[5][0] * y[36]; a1 -= mq[5][1] * x[37]; b1 -= mq[5][1] * y[37]; a0 -= mq[5][2] * x[38]; b0 -= mq[5][2] * y[38]; x[39] = a0 + a1; y[39] = b0 + b1; up[4992] = x[39]; wp[4992] = f2bf(-y[39]); mq[5] = *(const LAS f32x4*)(Mg + 2580);
            { const float br = betg[40]; a0 = bf2f(*(const LAS bf16_t*)(lg + P5_VS + 10880 + c * 2)) * br; b0 = bf2f(*(const LAS bf16_t*)(lg + P5_KS + 10880 + c * 2)) * br * __expf(decg[40]); a1 = 0.f; b1 = 0.f; } a0 -= mq[0][0] * x[0]; b0 -= mq[0][0] * y[0]; a1 -= mq[0][1] * x[1]; b1 -= mq[0][1] * y[1]; a0 -= mq[0][2] * x[2]; b0 -= mq[0][2] * y[2]; a1 -= mq[0][3] * x[3]; b1 -= mq[0][3] * y[3]; mq[0] = *(const LAS f32x4*)(Mg + 2584);
            a0 -= mq[1][0] * x[4]; b0 -= mq[1][0] * y[4]; a1 -= mq[1][1] * x[5]; b1 -= mq[1][1] * y[5]; a0 -= mq[1][2] * x[6]; b0 -= mq[1][2] * y[6]; a1 -= mq[1][3] * x[7]; b1 -= mq[1][3] * y[7]; mq[1] = *(const LAS f32x4*)(Mg + 2588);
            a0 -= mq[2][0] * x[8]; b0 -= mq[2][0] * y[8]; a1 -= mq[2][1] * x[9]; b1 -= mq[2][1] * y[9]; a0 -= mq[2][2] * x[10]; b0 -= mq[2][2] * y[10]; a1 -= mq[2][3] * x[11]; b1 -= mq[2][3] * y[11]; mq[2] = *(const LAS f32x4*)(Mg + 2592);
            a0 -= mq[3][0] * x[12]; b0 -= mq[3][0] * y[12]; a1 -= mq[3][1] * x[13]; b1 -= mq[3][1] * y[13]; a0 -= mq[3][2] * x[14]; b0 -= mq[3][2] * y[14]; a1 -= mq[3][3] * x[15]; b1 -= mq[3][3] * y[15]; mq[3] = *(const LAS f32x4*)(Mg + 2596);
            a0 -= mq[4][0] * x[16]; b0 -= mq[4][0] * y[16]; a1 -= mq[4][1] * x[17]; b1 -= mq[4][1] * y[17]; a0 -= mq[4][2] * x[18]; b0 -= mq[4][2] * y[18]; a1 -= mq[4][3] * x[19]; b1 -= mq[4][3] * y[19]; mq[4] = *(const LAS f32x4*)(Mg + 2624);
            a0 -= mq[5][0] * x[20]; b0 -= mq[5][0] * y[20]; a1 -= mq[5][1] * x[21]; b1 -= mq[5][1] * y[21]; a0 -= mq[5][2] * x[22]; b0 -= mq[5][2] * y[22]; a1 -= mq[5][3] * x[23]; b1 -= mq[5][3] * y[23]; mq[5] = *(const LAS f32x4*)(Mg + 2628);
            a0 -= mq[0][0] * x[24]; b0 -= mq[0][0] * y[24]; a1 -= mq[0][1] * x[25]; b1 -= mq[0][1] * y[25]; a0 -= mq[0][2] * x[26]; b0 -= mq[0][2] * y[26]; a1 -= mq[0][3] * x[27]; b1 -= mq[0][3] * y[27]; mq[0] = *(const LAS f32x4*)(Mg + 2632);
            a0 -= mq[1][0] * x[28]; b0 -= mq[1][0] * y[28]; a1 -= mq[1][1] * x[29]; b1 -= mq[1][1] * y[29]; a0 -= mq[1][2] * x[30]; b0 -= mq[1][2] * y[30]; a1 -= mq[1][3] * x[31]; b1 -= mq[1][3] * y[31]; mq[1] = *(const LAS f32x4*)(Mg + 2636);
            a0 -= mq[2][0] * x[32]; b0 -= mq[2][0] * y[32]; a1 -= mq[2][1] * x[33]; b1 -= mq[2][1] * y[33]; a0 -= mq[2][2] * x[34]; b0 -= mq[2][2] * y[34]; a1 -= mq[2][3] * x[35]; b1 -= mq[2][3] * y[35]; mq[2] = *(const LAS f32x4*)(Mg + 2640);
            a0 -= mq[3][0] * x[36]; b0 -= mq[3][0] * y[36]; a1 -= mq[3][1] * x[37]; b1 -= mq[3][1] * y[37]; a0 -= mq[3][2] * x[38]; b0 -= mq[3][2] * y[38]; a1 -= mq[3][3] * x[39]; b1 -= mq[3][3] * y[39]; x[40] = a0 + a1; y[40] = b0 + b1; up[5120] = x[40]; wp[5120] = f2bf(-y[40]); mq[3] = *(const LAS f32x4*)(Mg + 2644);
            { const float br = betg[41]; a0 = bf2f(*(const LAS bf16_t*)(lg + P5_VS + 11152 + c * 2)) * br; b0 = bf2f(*(const LAS bf16_t*)(lg + P5_KS + 11152 + c * 2)) * br * __expf(decg[41]); a1 = 0.f; b1 = 0.f; } a0 -= mq[4][0] * x[0]; b0 -= mq[4][0] * y[0]; a1 -= mq[4][1] * x[1]; b1 -= mq[4][1] * y[1]; a0 -= mq[4][2] * x[2]; b0 -= mq[4][2] * y[2]; a1 -= mq[4][3] * x[3]; b1 -= mq[4][3] * y[3]; mq[4] = *(const LAS f32x4*)(Mg + 2648);
            a0 -= mq[5][0] * x[4]; b0 -= mq[5][0] * y[4]; a1 -= mq[5][1] * x[5]; b1 -= mq[5][1] * y[5]; a0 -= mq[5][2] * x[6]; b0 -= mq[5][2] * y[6]; a1 -= mq[5][3] * x[7]; b1 -= mq[5][3] * y[7]; mq[5] = *(const LAS f32x4*)(Mg + 2652);
            a0 -= mq[0][0] * x[8]; b0 -= mq[0][0] * y[8]; a1 -= mq[0][1] * x[9]; b1 -= mq[0][1] * y[9]; a0 -= mq[0][2] * x[10]; b0 -= mq[0][2] * y[10]; a1 -= mq[0][3] * x[11]; b1 -= mq[0][3] * y[11]; mq[0] = *(const LAS f32x4*)(Mg + 2656);
            a0 -= mq[1][0] * x[12]; b0 -= mq[1][0] * y[12]; a1 -= mq[1][1] * x[13]; b1 -= mq[1][1] * y[13]; a0 -= mq[1][2] * x[14]; b0 -= mq[1][2] * y[14]; a1 -= mq[1][3] * x[15]; b1 -= mq[1][3] * y[15]; mq[1] = *(const LAS f32x4*)(Mg + 2660);
            a0 -= mq[2][0] * x[16]; b0 -= mq[2][0] * y[16]; a1 -= mq[2][1] * x[17]; b1 -= mq[2][1] * y[17]; a0 -= mq[2][2] * x[18]; b0 -= mq[2][2] * y[18]; a1 -= mq[2][3] * x[19]; b1 -= mq[2][3] * y[19]; mq[2] = *(const LAS f32x4*)(Mg + 2664);
            a0 -= mq[3][0] * x[20]; b0 -= mq[3][0] * y[20]; a1 -= mq[3][1] * x[21]; b1 -= mq[3][1] * y[21]; a0 -= mq[3][2] * x[22]; b0 -= mq[3][2] * y[22]; a1 -= mq[3][3] * x[23]; b1 -= mq[3][3] * y[23]; mq[3] = *(const LAS f32x4*)(Mg + 2688);
            a0 -= mq[4][0] * x[24]; b0 -= mq[4][0] * y[24]; a1 -= mq[4][1] * x[25]; b1 -= mq[4][1] * y[25]; a0 -= mq[4][2] * x[26]; b0 -= mq[4][2] * y[26]; a1 -= mq[4][3] * x[27]; b1 -= mq[4][3] * y[27]; mq[4] = *(const LAS f32x4*)(Mg + 2692);
            a0 -= mq[5][0] * x[28]; b0 -= mq[5][0] * y[28]; a1 -= mq[5][1] * x[29]; b1 -= mq[5][1] * y[29]; a0 -= mq[5][2] * x[30]; b0 -= mq[5][2] * y[30]; a1 -= mq[5][3] * x[31]; b1 -= mq[5][3] * y[31]; mq[5] = *(const LAS f32x4*)(Mg + 2696);
            a0 -= mq[0][0] * x[32]; b0 -= mq[0][0] * y[32]; a1 -= mq[0][1] * x[33]; b1 -= mq[0][1] * y[33]; a0 -= mq[0][2] * x[34]; b0 -= mq[0][2] * y[34]; a1 -= mq[0][3] * x[35]; b1 -= mq[0][3] * y[35]; mq[0] = *(const LAS f32x4*)(Mg + 2700);
            a0 -= mq[1][0] * x[36]; b0 -= mq[1][0] * y[36]; a1 -= mq[1][1] * x[37]; b1 -= mq[1][1] * y[37]; a0 -= mq[1][2] * x[38]; b0 -= mq[1][2] * y[38]; a1 -= mq[1][3] * x[39]; b1 -= mq[1][3] * y[39]; mq[1] = *(const LAS f32x4*)(Mg + 2704);
            a0 -= mq[2][0] * x[40]; b0 -= mq[2][0] * y[40]; x[41] = a0 + a1; y[41] = b0 + b1; up[5248] = x[41]; wp[5248] = f2bf(-y[41]); mq[2] = *(const LAS f32x4*)(Mg + 2708);
            { const float br = betg[42]; a0 = bf2f(*(const LAS bf16_t*)(lg + P5_VS + 11424 + c * 2)) * br; b0 = bf2f(*(const LAS bf16_t*)(lg + P5_KS + 11424 + c * 2)) * br * __expf(decg[42]); a1 = 0.f; b1 = 0.f; } a0 -= mq[3][0] * x[0]; b0 -= mq[3][0] * y[0]; a1 -= mq[3][1] * x[1]; b1 -= mq[3][1] * y[1]; a0 -= mq[3][2] * x[2]; b0 -= mq[3][2] * y[2]; a1 -= mq[3][3] * x[3]; b1 -= mq[3][3] * y[3]; mq[3] = *(const LAS f32x4*)(Mg + 2712);
            a0 -= mq[4][0] * x[4]; b0 -= mq[4][0] * y[4]; a1 -= mq[4][1] * x[5]; b1 -= mq[4][1] * y[5]; a0 -= mq[4][2] * x[6]; b0 -= mq[4][2] * y[6]; a1 -= mq[4][3] * x[7]; b1 -= mq[4][3] * y[7]; mq[4] = *(const LAS f32x4*)(Mg + 2716);
            a0 -= mq[5][0] * x[8]; b0 -= mq[5][0] * y[8]; a1 -= mq[5][1] * x[9]; b1 -= mq[5][1] * y[9]; a0 -= mq[5][2] * x[10]; b0 -= mq[5][2] * y[10]; a1 -= mq[5][3] * x[11]; b1 -= mq[5][3] * y[11]; mq[5] = *(const LAS f32x4*)(Mg + 2720);
            a0 -= mq[0][0] * x[12]; b0 -= mq[0][0] * y[12]; a1 -= mq[0][1] * x[13]; b1 -= mq[0][1] * y[13]; a0 -= mq[0][2] * x[14]; b0 -= mq[0][2] * y[14]; a1 -= mq[0][3] * x[15]; b1 -= mq[0][3] * y[15]; mq[0] = *(const LAS f32x4*)(Mg + 2724);
            a0 -= mq[1][0] * x[16]; b0 -= mq[1][0] * y[16]; a1 -= mq[1][1] * x[17]; b1 -= mq[1][1] * y[17]; a0 -= mq[1][2] * x[18]; b0 -= mq[1][2] * y[18]; a1 -= mq[1][3] * x[19]; b1 -= mq[1][3] * y[19]; mq[1] = *(const LAS f32x4*)(Mg + 2728);
            a0 -= mq[2][0] * x[20]; b0 -= mq[2][0] * y[20]; a1 -= mq[2][1] * x[21]; b1 -= mq[2][1] * y[21]; a0 -= mq[2][2] * x[22]; b0 -= mq[2][2] * y[22]; a1 -= mq[2][3] * x[23]; b1 -= mq[2][3] * y[23]; mq[2] = *(const LAS f32x4*)(Mg + 2752);
            a0 -= mq[3][0] * x[24]; b0 -= mq[3][0] * y[24]; a1 -= mq[3][1] * x[25]; b1 -= mq[3][1] * y[25]; a0 -= mq[3][2] * x[26]; b0 -= mq[3][2] * y[26]; a1 -= mq[3][3] * x[27]; b1 -= mq[3][3] * y[27]; mq[3] = *(const LAS f32x4*)(Mg + 2756);
            a0 -= mq[4][0] * x[28]; b0 -= mq[4][0] * y[28]; a1 -= mq[4][1] * x[29]; b1 -= mq[4][1] * y[29]; a0 -= mq[4][2] * x[30]; b0 -= mq[4][2] * y[30]; a1 -= mq[4][3] * x[31]; b1 -= mq[4][3] * y[31]; mq[4] = *(const LAS f32x4*)(Mg + 2760);
            a0 -= mq[5][0] * x[32]; b0 -= mq[5][0] * y[32]; a1 -= mq[5][1] * x[33]; b1 -= mq[5][1] * y[33]; a0 -= mq[5][2] * x[34]; b0 -= mq[5][2] * y[34]; a1 -= mq[5][3] * x[35]; b1 -= mq[5][3] * y[35]; mq[5] = *(const LAS f32x4*)(Mg + 2764);
            a0 -= mq[0][0] * x[36]; b0 -= mq[0][0] * y[36]; a1 -= mq[0][1] * x[37]; b1 -= mq[0][1] * y[37]; a0 -= mq[0][2] * x[38]; b0 -= mq[0][2] * y[38]; a1 -= mq[0][3] * x[39]; b1 -= mq[0][3] * y[39]; mq[0] = *(const LAS f32x4*)(Mg + 2768);
            a0 -= mq[1][0] * x[40]; b0 -= mq[1][0] * y[40]; a1 -= mq[1][1] * x[41]; b1 -= mq[1][1] * y[41]; x[42] = a0 + a1; y[42] = b0 + b1; up[5376] = x[42]; wp[5376] = f2bf(-y[42]); mq[1] = *(const LAS f32x4*)(Mg + 2772);
            { const float br = betg[43]; a0 = bf2f(*(const LAS bf16_t*)(lg + P5_VS + 11696 + c * 2)) * br; b0 = bf2f(*(const LAS bf16_t*)(lg + P5_KS + 11696 + c * 2)) * br * __expf(decg[43]); a1 = 0.f; b1 = 0.f; } a0 -= mq[2][0] * x[0]; b0 -= mq[2][0] * y[0]; a1 -= mq[2][1] * x[1]; b1 -= mq[2][1] * y[1]; a0 -= mq[2][2] * x[2]; b0 -= mq[2][2] * y[2]; a1 -= mq[2][3] * x[3]; b1 -= mq[2][3] * y[3]; mq[2] = *(const LAS f32x4*)(Mg + 2776);
            a0 -= mq[3][0] * x[4]; b0 -= mq[3][0] * y[4]; a1 -= mq[3][1] * x[5]; b1 -= mq[3][1] * y[5]; a0 -= mq[3][2] * x[6]; b0 -= mq[3][2] * y[6]; a1 -= mq[3][3] * x[7]; b1 -= mq[3][3] * y[7]; mq[3] = *(const LAS f32x4*)(Mg + 2780);
            a0 -= mq[4][0] * x[8]; b0 -= mq[4][0] * y[8]; a1 -= mq[4][1] * x[9]; b1 -= mq[4][1] * y[9]; a0 -= mq[4][2] * x[10]; b0 -= mq[4][2] * y[10]; a1 -= mq[4][3] * x[11]; b1 -= mq[4][3] * y[11]; mq[4] = *(const LAS f32x4*)(Mg + 2784);
            a0 -= mq[5][0] * x[12]; b0 -= mq[5][0] * y[12]; a1 -= mq[5][1] * x[13]; b1 -= mq[5][1] * y[13]; a0 -= mq[5][2] * x[14]; b0 -= mq[5][2] * y[14]; a1 -= mq[5][3] * x[15]; b1 -= mq[5][3] * y[15]; mq[5] = *(const LAS f32x4*)(Mg + 2788);
            a0 -= mq[0][0] * x[16]; b0 -= mq[0][0] * y[16]; a1 -= mq[0][1] * x[17]; b1 -= mq[0][1] * y[17]; a0 -= mq[0][2] * x[18]; b0 -= mq[0][2] * y[18]; a1 -= mq[0][3] * x[19]; b1 -= mq[0][3] * y[19]; mq[0] = *(const LAS f32x4*)(Mg + 2792);
            a0 -= mq[1][0] * x[20]; b0 -= mq[1][0] * y[20]; a1 -= mq[1][1] * x[21]; b1 -= mq[1][1] * y[21]; a0 -= mq[1][2] * x[22]; b0 -= mq[1][2] * y[22]; a1 -= mq[1][3] * x[23]; b1 -= mq[1][3] * y[23]; mq[1] = *(const LAS f32x4*)(Mg + 2816);
            a0 -= mq[2][0] * x[24]; b0 -= mq[2][0] * y[24]; a1 -= mq[2][1] * x[25]; b1 -= mq[2][1] * y[25]; a0 -= mq[2][2] * x[26]; b0 -= mq[2][2] * y[26]; a1 -= mq[2][3] * x[27]; b1 -= mq[2][3] * y[27]; mq[2] = *(const LAS f32x4*)(Mg + 2820);
            a0 -= mq[3][0] * x[28]; b0 -= mq[3][0] * y[28]; a1 -= mq[3][1] * x[29]; b1 -= mq[3][1] * y[29]; a0 -= mq[3][2] * x[30]; b0 -= mq[3][2] * y[30]; a1 -= mq[3][3] * x[31]; b1 -= mq[3][3] * y[31]; mq[3] = *(const LAS f32x4*)(Mg + 2824);
            a0 -= mq[4][0] * x[32]; b0 -= mq[4][0] * y[32]; a1 -= mq[4][1] * x[33]; b1 -= mq[4][1] * y[33]; a0 -= mq[4][2] * x[34]; b0 -= mq[4][2] * y[34]; a1 -= mq[4][3] * x[35]; b1 -= mq[4][3] * y[35]; mq[4] = *(const LAS f32x4*)(Mg + 2828);
            a0 -= mq[5][0] * x[36]; b0 -= mq[5][0] * y[36]; a1 -= mq[5][1] * x[37]; b1 -= mq[5][1] * y[37]; a0 -= mq[5][2] * x[38]; b0 -= mq[5][2] * y[38]; a1 -= mq[5][3] * x[39]; b1 -= mq[5][3] * y[39]; mq[5] = *(const LAS f32x4*)(Mg + 2832);
            a0 -= mq[0][0] * x[40]; b0 -= mq[0][0] * y[40]; a1 -= mq[0][1] * x[41]; b1 -= mq[0][1] * y[41]; a0 -= mq[0][2] * x[42]; b0 -= mq[0][2] * y[42]; x[43] = a0 + a1; y[43] = b0 + b1; up[5504] = x[43]; wp[5504] = f2bf(-y[43]); mq[0] = *(const LAS f32x4*)(Mg + 2836);
            { const float br = betg[44]; a0 = bf2f(*(const LAS bf16_t*)(lg + P5_VS + 11968 + c * 2)) * br; b0 = bf2f(*(const LAS bf16_t*)(lg + P5_KS + 11968 + c * 2)) * br * __expf(decg[44]); a1 = 0.f; b1 = 0.f; } a0 -= mq[1][0] * x[0]; b0 -= mq[1][0] * y[0]; a1 -= mq[1][1] * x[1]; b1 -= mq[1][1] * y[1]; a0 -= mq[1][2] * x[2]; b0 -= mq[1][2] * y[2]; a1 -= mq[1][3] * x[3]; b1 -= mq[1][3] * y[3]; mq[1] = *(const LAS f32x4*)(Mg + 2840);
            a0 -= mq[2][0] * x[4]; b0 -= mq[2][0] * y[4]; a1 -= mq[2][1] * x[5]; b1 -= mq[2][1] * y[5]; a0 -= mq[2][2] * x[6]; b0 -= mq[2][2] * y[6]; a1 -= mq[2][3] * x[7]; b1 -= mq[2][3] * y[7]; mq[2] = *(const LAS f32x4*)(Mg + 2844);
            a0 -= mq[3][0] * x[8]; b0 -= mq[3][0] * y[8]; a1 -= mq[3][1] * x[9]; b1 -= mq[3][1] * y[9]; a0 -= mq[3][2] * x[10]; b0 -= mq[3][2] * y[10]; a1 -= mq[3][3] * x[11]; b1 -= mq[3][3] * y[11]; mq[3] = *(const LAS f32x4*)(Mg + 2848);
            a0 -= mq[4][0] * x[12]; b0 -= mq[4][0] * y[12]; a1 -= mq[4][1] * x[13]; b1 -= mq[4][1] * y[13]; a0 -= mq[4][2] * x[14]; b0 -= mq[4][2] * y[14]; a1 -= mq[4][3] * x[15]; b1 -= mq[4][3] * y[15]; mq[4] = *(const LAS f32x4*)(Mg + 2852);
            a0 -= mq[5][0] * x[16]; b0 -= mq[5][0] * y[16]; a1 -= mq[5][1] * x[17]; b1 -= mq[5][1] * y[17]; a0 -= mq[5][2] * x[18]; b0 -= mq[5][2] * y[18]; a1 -= mq[5][3] * x[19]; b1 -= mq[5][3] * y[19]; mq[5] = *(const LAS f32x4*)(Mg + 2856);
            a0 -= mq[0][0] * x[20]; b0 -= mq[0][0] * y[20]; a1 -= mq[0][1] * x[21]; b1 -= mq[0][1] * y[21]; a0 -= mq[0][2] * x[22]; b0 -= mq[0][2] * y[22]; a1 -= mq[0][3] * x[23]; b1 -= mq[0][3] * y[23]; mq[0] = *(const LAS f32x4*)(Mg + 2880);
            a0 -= mq[1][0] * x[24]; b0 -= mq[1][0] * y[24]; a1 -= mq[1][1] * x[25]; b1 -= mq[1][1] * y[25]; a0 -= mq[1][2] * x[26]; b0 -= mq[1][2] * y[26]; a1 -= mq[1][3] * x[27]; b1 -= mq[1][3] * y[27]; mq[1] = *(const LAS f32x4*)(Mg + 2884);
            a0 -= mq[2][0] * x[28]; b0 -= mq[2][0] * y[28]; a1 -= mq[2][1] * x[29]; b1 -= mq[2][1] * y[29]; a0 -= mq[2][2] * x[30]; b0 -= mq[2][2] * y[30]; a1 -= mq[2][3] * x[31]; b1 -= mq[2][3] * y[31]; mq[2] = *(const LAS f32x4*)(Mg + 2888);
            a0 -= mq[3][0] * x[32]; b0 -= mq[3][0] * y[32]; a1 -= mq[3][1] * x[33]; b1 -= mq[3][1] * y[33]; a0 -= mq[3][2] * x[34]; b0 -= mq[3][2] * y[34]; a1 -= mq[3][3] * x[35]; b1 -= mq[3][3] * y[35]; mq[3] = *(const LAS f32x4*)(Mg + 2892);
            a0 -= mq[4][0] * x[36]; b0 -= mq[4][0] * y[36]; a1 -= mq[4][1] * x[37]; b1 -= mq[4][1] * y[37]; a0 -= mq[4][2] * x[38]; b0 -= mq[4][2] * y[38]; a1 -= mq[4][3] * x[39]; b1 -= mq[4][3] * y[39]; mq[4] = *(const LAS f32x4*)(Mg + 2896);
            a0 -= mq[5][0] * x[40]; b0 -= mq[5][0] * y[40]; a1 -= mq[5][1] * x[41]; b1 -= mq[5][1] * y[41]; a0 -= mq[5][2] * x[42]; b0 -= mq[5][2] * y[42]; a1 -= mq[5][3] * x[43]; b1 -= mq[5][3] * y[43]; x[44] = a0 + a1; y[44] = b0 + b1; up[5632] = x[44]; wp[5632] = f2bf(-y[44]); mq[5] = *(const LAS f32x4*)(Mg + 2900);
            { const float br = betg[45]; a0 = bf2f(*(const LAS bf16_t*)(lg + P5_VS + 12240 + c * 2)) * br; b0 = bf2f(*(const LAS bf16_t*)(lg + P5_KS + 12240 + c * 2)) * br * __expf(decg[45]); a1 = 0.f; b1 = 0.f; } a0 -= mq[0][0] * x[0]; b0 -= mq[0][0] * y[0]; a1 -= mq[0][1] * x[1]; b1 -= mq[0][1] * y[1]; a0 -= mq[0][2] * x[2]; b0 -= mq[0][2] * y[2]; a1 -= mq[0][3] * x[3]; b1 -= mq[0][3] * y[3]; mq[0] = *(const LAS f32x4*)(Mg + 2904);
            a0 -= mq[1][0] * x[4]; b0 -= mq[1][0] * y[4]; a1 -= mq[1][1] * x[5]; b1 -= mq[1][1] * y[5]; a0 -= mq[1][2] * x[6]; b0 -= mq[1][2] * y[6]; a1 -= mq[1][3] * x[7]; b1 -= mq[1][3] * y[7]; mq[1] = *(const LAS f32x4*)(Mg + 2908);
            a0 -= mq[2][0] * x[8]; b0 -= mq[2][0] * y[8]; a1 -= mq[2][1] * x[9]; b1 -= mq[2][1] * y[9]; a0 -= mq[2][2] * x[10]; b0 -= mq[2][2] * y[10]; a1 -= mq[2][3] * x[11]; b1 -= mq[2][3] * y[11]; mq[2] = *(const LAS f32x4*)(Mg + 2912);
            a0 -= mq[3][0] * x[12]; b0 -= mq[3][0] * y[12]; a1 -= mq[3][1] * x[13]; b1 -= mq[3][1] * y[13]; a0 -= mq[3][2] * x[14]; b0 -= mq[3][2] * y[14]; a1 -= mq[3][3] * x[15]; b1 -= mq[3][3] * y[15]; mq[3] = *(const LAS f32x4*)(Mg + 2916);
            a0 -= mq[4][0] * x[16]; b0 -= mq[4][0] * y[16]; a1 -= mq[4][1] * x[17]; b1 -= mq[4][1] * y[17]; a0 -= mq[4][2] * x[18]; b0 -= mq[4][2] * y[18]; a1 -= mq[4][3] * x[19]; b1 -= mq[4][3] * y[19]; mq[4] = *(const LAS f32x4*)(Mg + 2920);
            a0 -= mq[5][0] * x[20]; b0 -= mq[5][0] * y[20]; a1 -= mq[5][1] * x[21]; b1 -= mq[5][1] * y[21]; a0 -= mq[5][2] * x[22]; b0 -= mq[5][2] * y[22]; a1 -= mq[5][3] * x[23]; b1 -= mq[5][3] * y[23]; mq[5] = *(const LAS f32x4*)(Mg + 2924);
            a0 -= mq[0][0] * x[24]; b0 -= mq[0][0] * y[24]; a1 -= mq[0][1] * x[25]; b1 -= mq[0][1] * y[25]; a0 -= mq[0][2] * x[26]; b0 -= mq[0][2] * y[26]; a1 -= mq[0][3] * x[27]; b1 -= mq[0][3] * y[27]; mq[0] = *(const LAS f32x4*)(Mg + 2944);
            a0 -= mq[1][0] * x[28]; b0 -= mq[1][0] * y[28]; a1 -= mq[1][1] * x[29]; b1 -= mq[1][1] * y[29]; a0 -= mq[1][2] * x[30]; b0 -= mq[1][2] * y[30]; a1 -= mq[1][3] * x[31]; b1 -= mq[1][3] * y[31]; mq[1] = *(const LAS f32x4*)(Mg + 2948);
            a0 -= mq[2][0] * x[32]; b0 -= mq[2][0] * y[32]; a1 -= mq[2][1] * x[33]; b1 -= mq[2][1] * y[33]; a0 -= mq[2][2] * x[34]; b0 -= mq[2][2] * y[34]; a1 -= mq[2][3] * x[35]; b1 -= mq[2][3] * y[35]; mq[2] = *(const LAS f32x4*)(Mg + 2952);
            a0 -= mq[3][0] * x[36]; b0 -= mq[3][0] * y[36]; a1 -= mq[3][1] * x[37]; b1 -= mq[3][1] * y[37]; a0 -= mq[3][2] * x[38]; b0 -= mq[3][2] * y[38]; a1 -= mq[3][3] * x[39]; b1 -= mq[3][3] * y[39]; mq[3] = *(const LAS f32x4*)(Mg + 2956);
            a0 -= mq[4][0] * x[40]; b0 -= mq[4][0] * y[40]; a1 -= mq[4][1] * x[41]; b1 -= mq[4][1] * y[41]; a0 -= mq[4][2] * x[42]; b0 -= mq[4][2] * y[42]; a1 -= mq[4][3] * x[43]; b1 -= mq[4][3] * y[43]; mq[4] = *(const LAS f32x4*)(Mg + 2960);
            a0 -= mq[5][0] * x[44]; b0 -= mq[5][0] * y[44]; x[45] = a0 + a1; y[45] = b0 + b1; up[5760] = x[45]; wp[5760] = f2bf(-y[45]); mq[5] = *(const LAS f32x4*)(Mg + 2964);
            { const float br = betg[46]; a0 = bf2f(*(const LAS bf16_t*)(lg + P5_VS + 12512 + c * 2)) * br; b0 = bf2f(*(const LAS bf16_t*)(lg + P5_KS + 12512 + c * 2)) * br * __expf(decg[46]); a1 = 0.f; b1 = 0.f; } a0 -= mq[0][0] * x[0]; b0 -= mq[0][0] * y[0]; a1 -= mq[0][1] * x[1]; b1 -= mq[0][1] * y[1]; a0 -= mq[0][2] * x[2]; b0 -= mq[0][2] * y[2]; a1 -= mq[0][3] * x[3]; b1 -= mq[0][3] * y[3]; mq[0] = *(const LAS f32x4*)(Mg + 2968);
            a0 -= mq[1][0] * x[4]; b0 -= mq[1][0] * y[4]; a1 -= mq[1][1] * x[5]; b1 -= mq[1][1] * y[5]; a0 -= mq[1][2] * x[6]; b0 -= mq[1][2] * y[6]; a1 -= mq[1][3] * x[7]; b1 -= mq[1][3] * y[7]; mq[1] = *(const LAS f32x4*)(Mg + 2972);
            a0 -= mq[2][0] * x[8]; b0 -= mq[2][0] * y[8]; a1 -= mq[2][1] * x[9]; b1 -= mq[2][1] * y[9]; a0 -= mq[2][2] * x[10]; b0 -= mq[2][2] * y[10]; a1 -= mq[2][3] * x[11]; b1 -= mq[2][3] * y[11]; mq[2] = *(const LAS f32x4*)(Mg + 2976);
            a0 -= mq[3][0] * x[12]; b0 -= mq[3][0] * y[12]; a1 -= mq[3][1] * x[13]; b1 -= mq[3][1] * y[13]; a0 -= mq[3][2] * x[14]; b0 -= mq[3][2] * y[14]; a1 -= mq[3][3] * x[15]; b1 -= mq[3][3] * y[15]; mq[3] = *(const LAS f32x4*)(Mg + 2980);
            a0 -= mq[4][0] * x[16]; b0 -= mq[4][0] * y[16]; a1 -= mq[4][1] * x[17]; b1 -= mq[4][1] * y[17]; a0 -= mq[4][2] * x[18]; b0 -= mq[4][2] * y[18]; a1 -= mq[4][3] * x[19]; b1 -= mq[4][3] * y[19]; mq[4] = *(const LAS f32x4*)(Mg + 2984);
            a0 -= mq[5][0] * x[20]; b0 -= mq[5][0] * y[20]; a1 -= mq[5][1] * x[21]; b1 -= mq[5][1] * y[21]; a0 -= mq[5][2] * x[22]; b0 -= mq[5][2] * y[22]; a1 -= mq[5][3] * x[23]; b1 -= mq[5][3] * y[23]; mq[5] = *(const LAS f32x4*)(Mg + 2988);
            a0 -= mq[0][0] * x[24]; b0 -= mq[0][0] * y[24]; a1 -= mq[0][1] * x[25]; b1 -= mq[0][1] * y[25]; a0 -= mq[0][2] * x[26]; b0 -= mq[0][2] * y[26]; a1 -= mq[0][3] * x[27]; b1 -= mq[0][3] * y[27]; mq[0] = *(const LAS f32x4*)(Mg + 3008);
            a0 -= mq[1][0] * x[28]; b0 -= mq[1][0] * y[28]; a1 -= mq[1][1] * x[29]; b1 -= mq[1][1] * y[29]; a0 -= mq[1][2] * x[30]; b0 -= mq[1][2] * y[30]; a1 -= mq[1][3] * x[31]; b1 -= mq[1][3] * y[31]; mq[1] = *(const LAS f32x4*)(Mg + 3012);
            a0 -= mq[2][0] * x[32]; b0 -= mq[2][0] * y[32]; a1 -= mq[2][1] * x[33]; b1 -= mq[2][1] * y[33]; a0 -= mq[2][2] * x[34]; b0 -= mq[2][2] * y[34]; a1 -= mq[2][3] * x[35]; b1 -= mq[2][3] * y[35]; mq[2] = *(const LAS f32x4*)(Mg + 3016);
            a0 -= mq[3][0] * x[36]; b0 -= mq[3][0] * y[36]; a1 -= mq[3][1] * x[37]; b1 -= mq[3][1] * y[37]; a0 -= mq[3][2] * x[38]; b0 -= mq[3][2] * y[38]; a1 -= mq[3][3] * x[39]; b1 -= mq[3][3] * y[39]; mq[3] = *(const LAS f32x4*)(Mg + 3020);
            a0 -= mq[4][0] * x[40]; b0 -= mq[4][0] * y[40]; a1 -= mq[4][1] * x[41]; b1 -= mq[4][1] * y[41]; a0 -= mq[4][2] * x[42]; b0 -= mq[4][2] * y[42]; a1 -= mq[4][3] * x[43]; b1 -= mq[4][3] * y[43]; mq[4] = *(const LAS f32x4*)(Mg + 3024);
            a0 -= mq[5][0] * x[44]; b0 -= mq[5][0] * y[44]; a1 -= mq[5][1] * x[45]; b1 -= mq[5][1] * y[45]; x[46] = a0 + a1; y[46] = b0 + b1; up[5888] = x[46]; wp[5888] = f2bf(-y[46]); mq[5] = *(const LAS f32x4*)(Mg + 3028);
            { const float br = betg[47]; a0 = bf2f(*(const LAS bf16_t*)(lg + P5_VS + 12784 + c * 2)) * br; b0 = bf2f(*(const LAS bf16_t*)(lg + P5_KS + 12784 + c * 2)) * br * __expf(decg[47]); a1 = 0.f; b1 = 0.f; } a0 -= mq[0][0] * x[0]; b0 -= mq[0][0] * y[0]; a1 -= mq[0][1] * x[1]; b1 -= mq[0][1] * y[1]; a0 -= mq[0][2] * x[2]; b0 -= mq[0][2] * y[2]; a1 -= mq[0][3] * x[3]; b1 -= mq[0][3] * y[3]; mq[0] = *(const LAS f32x4*)(Mg + 3032);
            a0 -= mq[1][0] * x[4]; b0 -= mq[1][0] * y[4]; a1 -= mq[1][1] * x[5]; b1 -= mq[1][1] * y[5]; a0 -= mq[1][2] * x[6]; b0 -= mq[1][2] * y[6]; a1 -= mq[1][3] * x[7]; b1 -= mq[1][3] * y[7]; mq[1] = *(const LAS f32x4*)(Mg + 3036);
            a0 -= mq[2][0] * x[8]; b0 -= mq[2][0] * y[8]; a1 -= mq[2][1] * x[9]; b1 -= mq[2][1] * y[9]; a0 -= mq[2][2] * x[10]; b0 -= mq[2][2] * y[10]; a1 -= mq[2][3] * x[11]; b1 -= mq[2][3] * y[11]; mq[2] = *(const LAS f32x4*)(Mg + 3040);
            a0 -= mq[3][0] * x[12]; b0 -= mq[3][0] * y[12]; a1 -= mq[3][1] * x[13]; b1 -= mq[3][1] * y[13]; a0 -= mq[3][2] * x[14]; b0 -= mq[3][2] * y[14]; a1 -= mq[3][3] * x[15]; b1 -= mq[3][3] * y[15]; mq[3] = *(const LAS f32x4*)(Mg + 3044);
            a0 -= mq[4][0] * x[16]; b0 -= mq[4][0] * y[16]; a1 -= mq[4][1] * x[17]; b1 -= mq[4][1] * y[17]; a0 -= mq[4][2] * x[18]; b0 -= mq[4][2] * y[18]; a1 -= mq[4][3] * x[19]; b1 -= mq[4][3] * y[19]; mq[4] = *(const LAS f32x4*)(Mg + 3048);
            a0 -= mq[5][0] * x[20]; b0 -= mq[5][0] * y[20]; a1 -= mq[5][1] * x[21]; b1 -= mq[5][1] * y[21]; a0 -= mq[5][2] * x[22]; b0 -= mq[5][2] * y[22]; a1 -= mq[5][3] * x[23]; b1 -= mq[5][3] * y[23]; mq[5] = *(const LAS f32x4*)(Mg + 3052);
            a0 -= mq[0][0] * x[24]; b0 -= mq[0][0] * y[24]; a1 -= mq[0][1] * x[25]; b1 -= mq[0][1] * y[25]; a0 -= mq[0][2] * x[26]; b0 -= mq[0][2] * y[26]; a1 -= mq[0][3] * x[27]; b1 -= mq[0][3] * y[27]; mq[0] = *(const LAS f32x4*)(Mg + 3072);
            a0 -= mq[1][0] * x[28]; b0 -= mq[1][0] * y[28]; a1 -= mq[1][1] * x[29]; b1 -= mq[1][1] * y[29]; a0 -= mq[1][2] * x[30]; b0 -= mq[1][2] * y[30]; a1 -= mq[1][3] * x[31]; b1 -= mq[1][3] * y[31]; mq[1] = *(const LAS f32x4*)(Mg + 3076);
            a0 -= mq[2][0] * x[32]; b0 -= mq[2][0] * y[32]; a1 -= mq[2][1] * x[33]; b1 -= mq[2][1] * y[33]; a0 -= mq[2][2] * x[34]; b0 -= mq[2][2] * y[34]; a1 -= mq[2][3] * x[35]; b1 -= mq[2][3] * y[35]; mq[2] = *(const LAS f32x4*)(Mg + 3080);
            a0 -= mq[3][0] * x[36]; b0 -= mq[3][0] * y[36]; a1 -= mq[3][1] * x[37]; b1 -= mq[3][1] * y[37]; a0 -= mq[3][2] * x[38]; b0 -= mq[3][2] * y[38]; a1 -= mq[3][3] * x[39]; b1 -= mq[3][3] * y[39]; mq[3] = *(const LAS f32x4*)(Mg + 3084);
            a0 -= mq[4][0] * x[40]; b0 -= mq[4][0] * y[40]; a1 -= mq[4][1] * x[41]; b1 -= mq[4][1] * y[41]; a0 -= mq[4][2] * x[42]; b0 -= mq[4][2] * y[42]; a1 -= mq[4][3] * x[43]; b1 -= mq[4][3] * y[43]; mq[4] = *(const LAS f32x4*)(Mg + 3088);
            a0 -= mq[5][0] * x[44]; b0 -= mq[5][0] * y[44]; a1 -= mq[5][1] * x[45]; b1 -= mq[5][1] * y[45]; a0 -= mq[5][2] * x[46]; b0 -= mq[5][2] * y[46]; x[47] = a0 + a1; y[47] = b0 + b1; up[6016] = x[47]; wp[6016] = f2bf(-y[47]); mq[5] = *(const LAS f32x4*)(Mg + 3092);
            { const float br = betg[48]; a0 = bf2f(*(const LAS bf16_t*)(lg + P5_VS + 13056 + c * 2)) * br; b0 = bf2f(*(const LAS bf16_t*)(lg + P5_KS + 13056 + c * 2)) * br * __expf(decg[48]); a1 = 0.f; b1 = 0.f; } a0 -= mq[0][0] * x[0]; b0 -= mq[0][0] * y[0]; a1 -= mq[0][1] * x[1]; b1 -= mq[0][1] * y[1]; a0 -= mq[0][2] * x[2]; b0 -= mq[0][2] * y[2]; a1 -= mq[0][3] * x[3]; b1 -= mq[0][3] * y[3]; mq[0] = *(const LAS f32x4*)(Mg + 3096);
            a0 -= mq[1][0] * x[4]; b0 -= mq[1][0] * y[4]; a1 -= mq[1][1] * x[5]; b1 -= mq[1][1] * y[5]; a0 -= mq[1][2] * x[6]; b0 -= mq[1][2] * y[6]; a1 -= mq[1][3] * x[7]; b1 -= mq[1][3] * y[7]; mq[1] = *(const LAS f32x4*)(Mg + 3100);
            a0 -= mq[2][0] * x[8]; b0 -= mq[2][0] * y[8]; a1 -= mq[2][1] * x[9]; b1 -= mq[2][1] * y[9]; a0 -= mq[2][2] * x[10]; b0 -= mq[2][2] * y[10]; a1 -= mq[2][3] * x[11]; b1 -= mq[2][3] * y[11]; mq[2] = *(const LAS f32x4*)(Mg + 3104);
            a0 -= mq[3][0] * x[12]; b0 -= mq[3][0] * y[12]; a1 -= mq[3][1] * x[13]; b1 -= mq[3][1] * y[13]; a0 -= mq[3][2] * x[14]; b0 -= mq[3][2] * y[14]; a1 -= mq[3][3] * x[15]; b1 -= mq[3][3] * y[15]; mq[3] = *(const LAS f32x4*)(Mg + 3108);
            a0 -= mq[4][0] * x[16]; b0 -= mq[4][0] * y[16]; a1 -= mq[4][1] * x[17]; b1 -= mq[4][1] * y[17]; a0 -= mq[4][2] * x[18]; b0 -= mq[4][2] * y[18]; a1 -= mq[4][3] * x[19]; b1 -= mq[4][3] * y[19]; mq[4] = *(const LAS f32x4*)(Mg + 3112);
            a0 -= mq[5][0] * x[20]; b0 -= mq[5][0] * y[20]; a1 -= mq[5][1] * x[21]; b1 -= mq[5][1] * y[21]; a0 -= mq[5][2] * x[22]; b0 -= mq[5][2] * y[22]; a1 -= mq[5][3] * x[23]; b1 -= mq[5][3] * y[23]; mq[5] = *(const LAS f32x4*)(Mg + 3116);
            a0 -= mq[0][0] * x[24]; b0 -= mq[0][0] * y[24]; a1 -= mq[0][1] * x[25]; b1 -= mq[0][1] * y[25]; a0 -= mq[0][2] * x[26]; b0 -= mq[0][2] * y[26]; a1 -= mq[0][3] * x[27]; b1 -= mq[0][3] * y[27]; mq[0] = *(const LAS f32x4*)(Mg + 3136);
            a0 -= mq[1][0] * x[28]; b0 -= mq[1][0] * y[28]; a1 -= mq[1][1] * x[29]; b1 -= mq[1][1] * y[29]; a0 -= mq[1][2] * x[30]; b0 -= mq[1][2] * y[30]; a1 -= mq[1][3] * x[31]; b1 -= mq[1][3] * y[31]; mq[1] = *(const LAS f32x4*)(Mg + 3140);
            a0 -= mq[2][0] * x[32]; b0 -= mq[2][0] * y[32]; a1 -= mq[2][1] * x[33]; b1 -= mq[2][1] * y[33]; a0 -= mq[2][2] * x[34]; b0 -= mq[2][2] * y[34]; a1 -= mq[2][3] * x[35]; b1 -= mq[2][3] * y[35]; mq[2] = *(const LAS f32x4*)(Mg + 3144);
            a0 -= mq[3][0] * x[36]; b0 -= mq[3][0] * y[36]; a1 -= mq[3][1] * x[37]; b1 -= mq[3][1] * y[37]; a0 -= mq[3][2] * x[38]; b0 -= mq[3][2] * y[38]; a1 -= mq[3][3] * x[39]; b1 -= mq[3][3] * y[39]; mq[3] = *(const LAS f32x4*)(Mg + 3148);
            a0 -= mq[4][0] * x[40]; b0 -= mq[4][0] * y[40]; a1 -= mq[4][1] * x[41]; b1 -= mq[4][1] * y[41]; a0 -= mq[4][2] * x[42]; b0 -= mq[4][2] * y[42]; a1 -= mq[4][3] * x[43]; b1 -= mq[4][3] * y[43]; mq[4] = *(const LAS f32x4*)(Mg + 3152);
            a0 -= mq[5][0] * x[44]; b0 -= mq[5][0] * y[44]; a1 -= mq[5][1] * x[45]; b1 -= mq[5][1] * y[45]; a0 -= mq[5][2] * x[46]; b0 -= mq[5][2] * y[46]; a1 -= mq[5][3] * x[47]; b1 -= mq[5][3] * y[47]; x[48] = a0 + a1; y[48] = b0 + b1; up[6144] = x[48]; wp[6144] = f2bf(-y[48]); mq[5] = *(const LAS f32x4*)(Mg + 3156);
            { const float br = betg[49]; a0 = bf2f(*(const LAS bf16_t*)(lg + P5_VS + 13328 + c * 2)) * br; b0 = bf2f(*(const LAS bf16_t*)(lg + P5_KS + 13328 + c * 2)) * br * __expf(decg[49]); a1 = 0.f; b1 = 0.f; } a0 -= mq[0][0] * x[0]; b0 -= mq[0][0] * y[0]; a1 -= mq[0][1] * x[1]; b1 -= mq[0][1] * y[1]; a0 -= mq[0][2] * x[2]; b0 -= mq[0][2] * y[2]; a1 -= mq[0][3] * x[3]; b1 -= mq[0][3] * y[3]; mq[0] = *(const LAS f32x4*)(Mg + 3160);
            a0 -= mq[1][0] * x[4]; b0 -= mq[1][0] * y[4]; a1 -= mq[1][1] * x[5]; b1 -= mq[1][1] * y[5]; a0 -= mq[1][2] * x[6]; b0 -= mq[1][2] * y[6]; a1 -= mq[1][3] * x[7]; b1 -= mq[1][3] * y[7]; mq[1] = *(const LAS f32x4*)(Mg + 3164);
            a0 -= mq[2][0] * x[8]; b0 -= mq[2][0] * y[8]; a1 -= mq[2][1] * x[9]; b1 -= mq[2][1] * y[9]; a0 -= mq[2][2] * x[10]; b0 -= mq[2][2] * y[10]; a1 -= mq[2][3] * x[11]; b1 -= mq[2][3] * y[11]; mq[2] = *(const LAS f32x4*)(Mg + 3168);
            a0 -= mq[3][0] * x[12]; b0 -= mq[3][0] * y[12]; a1 -= mq[3][1] * x[13]; b1 -= mq[3][1] * y[13]; a0 -= mq[3][2] * x[14]; b0 -= mq[3][2] * y[14]; a1 -= mq[3][3] * x[15]; b1 -= mq[3][3] * y[15]; mq[3] = *(const LAS f32x4*)(Mg + 3172);
            a0 -= mq[4][0] * x[16]; b0 -= mq[4][0] * y[16]; a1 -= mq[4][1] * x[17]; b1 -= mq[4][1] * y[17]; a0 -= mq[4][2] * x[18]; b0 -= mq[4][2] * y[18]; a1 -= mq[4][3] * x[19]; b1 -= mq[4][3] * y[19]; mq[4] = *(const LAS f32x4*)(Mg + 3176);
            a0 -= mq[5][0] * x[20]; b0 -= mq[5][0] * y[20]; a1 -= mq[5][1] * x[21]; b1 -= mq[5][1] * y[21]; a0 -= mq[5][2] * x[22]; b0 -= mq[5][2] * y[22]; a1 -= mq[5][3] * x[23]; b1 -= mq[5][3] * y[23]; mq[5] = *(const LAS f32x4*)(Mg + 3180);
            a0 -= mq[0][0] * x[24]; b0 -= mq[0][0] * y[24]; a1 -= mq[0][1] * x[25]; b1 -= mq[0][1] * y[25]; a0 -= mq[0][2] * x[26]; b0 -= mq[0][2] * y[26]; a1 -= mq[0][3] * x[27]; b1 -= mq[0][3] * y[27]; mq[0] = *(const LAS f32x4*)(Mg + 3184);
            a0 -= mq[1][0] * x[28]; b0 -= mq[1][0] * y[28]; a1 -= mq[1][1] * x[29]; b1 -= mq[1][1] * y[29]; a0 -= mq[1][2] * x[30]; b0 -= mq[1][2] * y[30]; a1 -= mq[1][3] * x[31]; b1 -= mq[1][3] * y[31]; mq[1] = *(const LAS f32x4*)(Mg + 3200);
            a0 -= mq[2][0] * x[32]; b0 -= mq[2][0] * y[32]; a1 -= mq[2][1] * x[33]; b1 -= mq[2][1] * y[33]; a0 -= mq[2][2] * x[34]; b0 -= mq[2][2] * y[34]; a1 -= mq[2][3] * x[35]; b1 -= mq[2][3] * y[35]; mq[2] = *(const LAS f32x4*)(Mg + 3204);
            a0 -= mq[3][0] * x[36]; b0 -= mq[3][0] * y[36]; a1 -= mq[3][1] * x[37]; b1 -= mq[3][1] * y[37]; a0 -= mq[3][2] * x[38]; b0 -= mq[3][2] * y[38]; a1 -= mq[3][3] * x[39]; b1 -= mq[3][3] * y[39]; mq[3] = *(const LAS f32x4*)(Mg + 3208);
            a0 -= mq[4][0] * x[40]; b0 -= mq[4][0] * y[40]; a1 -= mq[4][1] * x[41]; b1 -= mq[4][1] * y[41]; a0 -= mq[4][2] * x[42]; b0 -= mq[4][2] * y[42]; a1 -= mq[4][3] * x[43]; b1 -= mq[4][3] * y[43]; mq[4] = *(const LAS f32x4*)(Mg + 3212);
            a0 -= mq[5][0] * x[44]; b0 -= mq[5][0] * y[44]; a1 -= mq[5][1] * x[45]; b1 -= mq[5][1] * y[45]; a0 -= mq[5][2] * x[46]; b0 -= mq[5][2] * y[46]; a1 -= mq[5][3] * x[47]; b1 -= mq[5][3] * y[47]; mq[5] = *(const LAS f32x4*)(Mg + 3216);
            a0 -= mq[0][0] * x[48]; b0 -= mq[0][0] * y[48]; x[49] = a0 + a1; y[49] = b0 + b1; up[6272] = x[49]; wp[6272] = f2bf(-y[49]); mq[0] = *(const LAS f32x4*)(Mg + 3220);
            { const float br = betg[50]; a0 = bf2f(*(const LAS bf16_t*)(lg + P5_VS + 13600 + c * 2)) * br; b0 = bf2f(*(const LAS bf16_t*)(lg + P5_KS + 13600 + c * 2)) * br * __expf(decg[50]); a1 = 0.f; b1 = 0.f; } a0 -= mq[1][0] * x[0]; b0 -= mq[1][0] * y[0]; a1 -= mq[1][1] * x[1]; b1 -= mq[1][1] * y[1]; a0 -= mq[1][2] * x[2]; b0 -= mq[1][2] * y[2]; a1 -= mq[1][3] * x[3]; b1 -= mq[1][3] * y[3]; mq[1] = *(const LAS f32x4*)(Mg + 3224);
            a0 -= mq[2][0] * x[4]; b0 -= mq[2][0] * y[4]; a1 -= mq[2][1] * x[5]; b1 -= mq[2][1] * y[5]; a0 -= mq[2][2] * x[6]; b0 -= mq[2][2] * y[6]; a1 -= mq[2][3] * x[7]; b1 -= mq[2][3] * y[7]; mq[2] = *(const LAS f32x4*)(Mg + 3228);
            a0 -= mq[3][0] * x[8]; b0 -= mq[3][0] * y[8]; a1 -= mq[3][1] * x[9]; b1 -= mq[3][1] * y[9]; a0 -= mq[3][2] * x[10]; b0 -= mq[3][2] * y[10]; a1 -= mq[3][3] * x[11]; b1 -= mq[3][3] * y[11]; mq[3] = *(const LAS f32x4*)(Mg + 3232);
            a0 -= mq[4][0] * x[12]; b0 -= mq[4][0] * y[12]; a1 -= mq[4][1] * x[13]; b1 -= mq[4][1] * y[13]; a0 -= mq[4][2] * x[14]; b0 -= mq[4][2] * y[14]; a1 -= mq[4][3] * x[15]; b1 -= mq[4][3] * y[15]; mq[4] = *(const LAS f32x4*)(Mg + 3236);
            a0 -= mq[5][0] * x[16]; b0 -= mq[5][0] * y[16]; a1 -= mq[5][1] * x[17]; b1 -= mq[5][1] * y[17]; a0 -= mq[5][2] * x[18]; b0 -= mq[5][2] * y[18]; a1 -= mq[5][3] * x[19]; b1 -= mq[5][3] * y[19]; mq[5] = *(const LAS f32x4*)(Mg + 3240);
            a0 -= mq[0][0] * x[20]; b0 -= mq[0][0] * y[20]; a1 -= mq[0][1] * x[21]; b1 -= mq[0][1] * y[21]; a0 -= mq[0][2] * x[22]; b0 -= mq[0][2] * y[22]; a1 -= mq[0][3] * x[23]; b1 -= mq[0][3] * y[23]; mq[0] = *(const LAS f32x4*)(Mg + 3244);
            a0 -= mq[1][0] * x[24]; b0 -= mq[1][0] * y[24]; a1 -= mq[1][1] * x[25]; b1 -= mq[1][1] * y[25]; a0 -= mq[1][2] * x[26]; b0 -= mq[1][2] * y[26]; a1 -= mq[1][3] * x[27]; b1 -= mq[1][3] * y[27]; mq[1] = *(const LAS f32x4*)(Mg + 3248);
            a0 -= mq[2][0] * x[28]; b0 -= mq[2][0] * y[28]; a1 -= mq[2][1] * x[29]; b1 -= mq[2][1] * y[29]; a0 -= mq[2][2] * x[30]; b0 -= mq[2][2] * y[30]; a1 -= mq[2][3] * x[31]; b1 -= mq[2][3] * y[31]; mq[2] = *(const LAS f32x4*)(Mg + 3264);
            a0 -= mq[3][0] * x[32]; b0 -= mq[3][0] * y[32]; a1 -= mq[3][1] * x[33]; b1 -= mq[3][1] * y[33]; a0 -= mq[3][2] * x[34]; b0 -= mq[3][2] * y[34]; a1 -= mq[3][3] * x[35]; b1 -= mq[3][3] * y[35]; mq[3] = *(const LAS f32x4*)(Mg + 3268);
            a0 -= mq[4][0] * x[36]; b0 -= mq[4][0] * y[36]; a1 -= mq[4][1] * x[37]; b1 -= mq[4][1] * y[37]; a0 -= mq[4][2] * x[38]; b0 -= mq[4][2] * y[38]; a1 -= mq[4][3] * x[39]; b1 -= mq[4][3] * y[39]; mq[4] = *(const LAS f32x4*)(Mg + 3272);
            a0 -= mq[5][0] * x[40]; b0 -= mq[5][0] * y[40]; a1 -= mq[5][1] * x[41]; b1 -= mq[5][1] * y[41]; a0 -= mq[5][2] * x[42]; b0 -= mq[5][2] * y[42]; a1 -= mq[5][3] * x[43]; b1 -= mq[5][3] * y[43]; mq[5] = *(const LAS f32x4*)(Mg + 3276);
            a0 -= mq[0][0] * x[44]; b0 -= mq[0][0] * y[44]; a1 -= mq[0][1] * x[45]; b1 -= mq[0][1] * y[45]; a0 -= mq[0][2] * x[46]; b0 -= mq[0][2] * y[46]; a1 -= mq[0][3] * x[47]; b1 -= mq[0][3] * y[47]; mq[0] = *(const LAS f32x4*)(Mg + 3280);
            a0 -= mq[1][0] * x[48]; b0 -= mq[1][0] * y[48]; a1 -= mq[1][1] * x[49]; b1 -= mq[1][1] * y[49]; x[50] = a0 + a1; y[50] = b0 + b1; up[6400] = x[50]; wp[6400] = f2bf(-y[50]); mq[1] = *(const LAS f32x4*)(Mg + 3284);
            { const float br = betg[51]; a0 = bf2f(*(const LAS bf16_t*)(lg + P5_VS + 13872 + c * 2)) * br; b0 = bf2f(*(const LAS bf16_t*)(lg + P5_KS + 13872 + c * 2)) * br * __expf(decg[51]); a1 = 0.f; b1 = 0.f; } a0 -= mq[2][0] * x[0]; b0 -= mq[2][0] * y[0]; a1 -= mq[2][1] * x[1]; b1 -= mq[2][1] * y[1]; a0 -= mq[2][2] * x[2]; b0 -= mq[2][2] * y[2]; a1 -= mq[2][3] * x[3]; b1 -= mq[2][3] * y[3]; mq[2] = *(const LAS f32x4*)(Mg + 3288);
            a0 -= mq[3][0] * x[4]; b0 -= mq[3][0] * y[4]; a1 -= mq[3][1] * x[5]; b1 -= mq[3][1] * y[5]; a0 -= mq[3][2] * x[6]; b0 -= mq[3][2] * y[6]; a1 -= mq[3][3] * x[7]; b1 -= mq[3][3] * y[7]; mq[3] = *(const LAS f32x4*)(Mg + 3292);
            a0 -= mq[4][0] * x[8]; b0 -= mq[4][0] * y[8]; a1 -= mq[4][1] * x[9]; b1 -= mq[4][1] * y[9]; a0 -= mq[4][2] * x[10]; b0 -= mq[4][2] * y[10]; a1 -= mq[4][3] * x[11]; b1 -= mq[4][3] * y[11]; mq[4] = *(const LAS f32x4*)(Mg + 3296);
            a0 -= mq[5][0] * x[12]; b0 -= mq[5][0] * y[12]; a1 -= mq[5][1] * x[13]; b1 -= mq[5][1] * y[13]; a0 -= mq[5][2] * x[14]; b0 -= mq[5][2] * y[14]; a1 -= mq[5][3] * x[15]; b1 -= mq[5][3] * y[15]; mq[5] = *(const LAS f32x4*)(Mg + 3300);
            a0 -= mq[0][0] * x[16]; b0 -= mq[0][0] * y[16]; a1 -= mq[0][1] * x[17]; b1 -= mq[0][1] * y[17]; a0 -= mq[0][2] * x[18]; b0 -= mq[0][2] * y[18]; a1 -= mq[0][3] * x[19]; b1 -= mq[0][3] * y[19]; mq[0] = *(const LAS f32x4*)(Mg + 3304);
            a0 -= mq[1][0] * x[20]; b0 -= mq[1][0] * y[20]; a1 -= mq[1][1] * x[21]; b1 -= mq[1][1] * y[21]; a0 -= mq[1][2] * x[22]; b0 -= mq[1][2] * y[22]; a1 -= mq[1][3] * x[23]; b1 -= mq[1][3] * y[23]; mq[1] = *(const LAS f32x4*)(Mg + 3308);
            a0 -= mq[2][0] * x[24]; b0 -= mq[2][0] * y[24]; a1 -= mq[2][1] * x[25]; b1 -= mq[2][1] * y[25]; a0 -= mq[2][2] * x[26]; b0 -= mq[2][2] * y[26]; a1 -= mq[2][3] * x[27]; b1 -= mq[2][3] * y[27]; mq[2] = *(const LAS f32x4*)(Mg + 3312);
            a0 -= mq[3][0] * x[28]; b0 -= mq[3][0] * y[28]; a1 -= mq[3][1] * x[29]; b1 -= mq[3][1] * y[29]; a0 -= mq[3][2] * x[30]; b0 -= mq[3][2] * y[30]; a1 -= mq[3][3] * x[31]; b1 -= mq[3][3] * y[31]; mq[3] = *(const LAS f32x4*)(Mg + 3328);
            a0 -= mq[4][0] * x[32]; b0 -= mq[4][0] * y[32]; a1 -= mq[4][1] * x[33]; b1 -= mq[4][1] * y[33]; a0 -= mq[4][2] * x[34]; b0 -= mq[4][2] * y[34]; a1 -= mq[4][3] * x[35]; b1 -= mq[4][3] * y[35]; mq[4] = *(const LAS f32x4*)(Mg + 3332);
            a0 -= mq[5][0] * x[36]; b0 -= mq[5][0] * y[36]; a1 -= mq[5][1] * x[37]; b1 -= mq[5][1] * y[37]; a0 -= mq[5][2] * x[38]; b0 -= mq[5][2] * y[38]; a1 -= mq[5][3] * x[39]; b1 -= mq[5][3] * y[39]; mq[5] = *(const LAS f32x4*)(Mg + 3336);
            a0 -= mq[0][0] * x[40]; b0 -= mq[0][0] * y[40]; a1 -= mq[0][1] * x[41]; b1 -= mq[0][1] * y[41]; a0 -= mq[0][2] * x[42]; b0 -= mq[0][2] * y[42]; a1 -= mq[0][3] * x[43]; b1 -= mq[0][3] * y[43]; mq[0] = *(const LAS f32x4*)(Mg + 3340);
            a0 -= mq[1][0] * x[44]; b0 -= mq[1][0] * y[44]; a1 -= mq[1][1] * x[45]; b1 -= mq[1][1] * y[45]; a0 -= mq[1][2] * x[46]; b0 -= mq[1][2] * y[46]; a1 -= mq[1][3] * x[47]; b1 -= mq[1][3] * y[47]; mq[1] = *(const LAS f32x4*)(Mg + 3344);
            a0 -= mq[2][0] * x[48]; b0 -= mq[2][0] * y[48]; a1 -= mq[2][1] * x[49]; b1 -= mq[2][1] * y[49]; a0 -= mq[2][2] * x[50]; b0 -= mq[2][2] * y[50]; x[51] = a0 + a1; y[51] = b0 + b1; up[6528] = x[51]; wp[6528] = f2bf(-y[51]); mq[2] = *(const LAS f32x4*)(Mg + 3348);
            { const float br = betg[52]; a0 = bf2f(*(const LAS bf16_t*)(lg + P5_VS + 14144 + c * 2)) * br; b0 = bf2f(*(const LAS bf16_t*)(lg + P5_KS + 14144 + c * 2)) * br * __expf(decg[52]); a1 = 0.f; b1 = 0.f; } a0 -= mq[3][0] * x[0]; b0 -= mq[3][0] * y[0]; a1 -= mq[3][1] * x[1]; b1 -= mq[3][1] * y[1]; a0 -= mq[3][2] * x[2]; b0 -= mq[3][2] * y[2]; a1 -= mq[3][3] * x[3]; b1 -= mq[3][3] * y[3]; mq[3] = *(const LAS f32x4*)(Mg + 3352);
            a0 -= mq[4][0] * x[4]; b0 -= mq[4][0] * y[4]; a1 -= mq[4][1] * x[5]; b1 -= mq[4][1] * y[5]; a0 -= mq[4][2] * x[6]; b0 -= mq[4][2] * y[6]; a1 -= mq[4][3] * x[7]; b1 -= mq[4][3] * y[7]; mq[4] = *(const LAS f32x4*)(Mg + 3356);
            a0 -= mq[5][0] * x[8]; b0 -= mq[5][0] * y[8]; a1 -= mq[5][1] * x[9]; b1 -= mq[5][1] * y[9]; a0 -= mq[5][2] * x[10]; b0 -= mq[5][2] * y[10]; a1 -= mq[5][3] * x[11]; b1 -= mq[5][3] * y[11]; mq[5] = *(const LAS f32x4*)(Mg + 3360);
            a0 -= mq[0][0] * x[12]; b0 -= mq[0][0] * y[12]; a1 -= mq[0][1] * x[13]; b1 -= mq[0][1] * y[13]; a0 -= mq[0][2] * x[14]; b0 -= mq[0][2] * y[14]; a1 -= mq[0][3] * x[15]; b1 -= mq[0][3] * y[15]; mq[0] = *(const LAS f32x4*)(Mg + 3364);
            a0 -= mq[1][0] * x[16]; b0 -= mq[1][0] * y[16]; a1 -= mq[1][1] * x[17]; b1 -= mq[1][1] * y[17]; a0 -= mq[1][2] * x[18]; b0 -= mq[1][2] * y[18]; a1 -= mq[1][3] * x[19]; b1 -= mq[1][3] * y[19]; mq[1] = *(const LAS f32x4*)(Mg + 3368);
            a0 -= mq[2][0] * x[20]; b0 -= mq[2][0] * y[20]; a1 -= mq[2][1] * x[21]; b1 -= mq[2][1] * y[21]; a0 -= mq[2][2] * x[22]; b0 -= mq[2][2] * y[22]; a1 -= mq[2][3] * x[23]; b1 -= mq[2][3] * y[23]; mq[2] = *(const LAS f32x4*)(Mg + 3372);
            a0 -= mq[3][0] * x[24]; b0 -= mq[3][0] * y[24]; a1 -= mq[3][1] * x[25]; b1 -= mq[3][1] * y[25]; a0 -= mq[3][2] * x[26]; b0 -= mq[3][2] * y[26]; a1 -= mq[3][3] * x[27]; b1 -= mq[3][3] * y[27]; mq[3] = *(const LAS f32x4*)(Mg + 3376);
            a0 -= mq[4][0] * x[28]; b0 -= mq[4][0] * y[28]; a1 -= mq[4][1] * x[29]; b1 -= mq[4][1] * y[29]; a0 -= mq[4][2] * x[30]; b0 -= mq[4][2] * y[30]; a1 -= mq[4][3] * x[31]; b1 -= mq[4][3] * y[31]; mq[4] = *(const LAS f32x4*)(Mg + 3392);
            a0 -= mq[5][0] * x[32]; b0 -= mq[5][0] * y[32]; a1 -= mq[5][1] * x[33]; b1 -= mq[5][1] * y[33]; a0 -= mq[5][2] * x[34]; b0 -= mq[5][2] * y[34]; a1 -= mq[5][3] * x[35]; b1 -= mq[5][3] * y[35]; mq[5] = *(const LAS f32x4*)(Mg + 3396);
            a0 -= mq[0][0] * x[36]; b0 -= mq[0][0] * y[36]; a1 -= mq[0][1] * x[37]; b1 -= mq[0][1] * y[37]; a0 -= mq[0][2] * x[38]; b0 -= mq[0][2] * y[38]; a1 -= mq[0][3] * x[39]; b1 -= mq[0][3] * y[39]; mq[0] = *(const LAS f32x4*)(Mg + 3400);
            a0 -= mq[1][0] * x[40]; b0 -= mq[1][0] * y[40]; a1 -= mq[1][1] * x[41]; b1 -= mq[1][1] * y[41]; a0 -= mq[1][2] * x[42]; b0 -= mq[1][2] * y[42]; a1 -= mq[1][3] * x[43]; b1 -= mq[1][3] * y[43]; mq[1] = *(const LAS f32x4*)(Mg + 3404);
            a0 -= mq[2][0] * x[44]; b0 -= mq[2][0] * y[44]; a1 -= mq[2][1] * x[45]; b1 -= mq[2][1] * y[45]; a0 -= mq[2][2] * x[46]; b0 -= mq[2][2] * y[46]; a1 -= mq[2][3] * x[47]; b1 -= mq[2][3] * y[47]; mq[2] = *(const LAS f32x4*)(Mg + 3408);
            a0 -= mq[3][0] * x[48]; b0 -= mq[3][0] * y[48]; a1 -= mq[3][1] * x[49]; b1 -= mq[3][1] * y[49]; a0 -= mq[3][2] * x[50]; b0 -= mq[3][2] * y[50]; a1 -= mq[3][3] * x[51]; b1 -= mq[3][3] * y[51]; x[52] = a0 + a1; y[52] = b0 + b1; up[6656] = x[52]; wp[6656] = f2bf(-y[52]); mq[3] = *(const LAS f32x4*)(Mg + 3412);
            { const float br = betg[53]; a0 = bf2f(*(const LAS bf16_t*)(lg + P5_VS + 14416 + c * 2)) * br; b0 = bf2f(*(const LAS bf16_t*)(lg + P5_KS + 14416 + c * 2)) * br * __expf(decg[53]); a1 = 0.f; b1 = 0.f; } a0 -= mq[4][0] * x[0]; b0 -= mq[4][0] * y[0]; a1 -= mq[4][1] * x[1]; b1 -= mq[4][1] * y[1]; a0 -= mq[4][2] * x[2]; b0 -= mq[4][2] * y[2]; a1 -= mq[4][3] * x[3]; b1 -= mq[4][3] * y[3]; mq[4] = *(const LAS f32x4*)(Mg + 3416);
            a0 -= mq[5][0] * x[4]; b0 -= mq[5][0] * y[4]; a1 -= mq[5][1] * x[5]; b1 -= mq[5][1] * y[5]; a0 -= mq[5][2] * x[6]; b0 -= mq[5][2] * y[6]; a1 -= mq[5][3] * x[7]; b1 -= mq[5][3] * y[7]; mq[5] = *(const LAS f32x4*)(Mg + 3420);
            a0 -= mq[0][0] * x[8]; b0 -= mq[0][0] * y[8]; a1 -= mq[0][1] * x[9]; b1 -= mq[0][1] * y[9]; a0 -= mq[0][2] * x[10]; b0 -= mq[0][2] * y[10]; a1 -= mq[0][3] * x[11]; b1 -= mq[0][3] * y[11]; mq[0] = *(const LAS f32x4*)(Mg + 3424);
            a0 -= mq[1][0] * x[12]; b0 -= mq[1][0] * y[12]; a1 -= mq[1][1] * x[13]; b1 -= mq[1][1] * y[13]; a0 -= mq[1][2] * x[14]; b0 -= mq[1][2] * y[14]; a1 -= mq[1][3] * x[15]; b1 -= mq[1][3] * y[15]; mq[1] = *(const LAS f32x4*)(Mg + 3428);
            a0 -= mq[2][0] * x[16]; b0 -= mq[2][0] * y[16]; a1 -= mq[2][1] * x[17]; b1 -= mq[2][1] * y[17]; a0 -= mq[2][2] * x[18]; b0 -= mq[2][2] * y[18]; a1 -= mq[2][3] * x[19]; b1 -= mq[2][3] * y[19]; mq[2] = *(const LAS f32x4*)(Mg + 3432);
            a0 -= mq[3][0] * x[20]; b0 -= mq[3][0] * y[20]; a1 -= mq[3][1] * x[21]; b1 -= mq[3][1] * y[21]; a0 -= mq[3][2] * x[22]; b0 -= mq[3][2] * y[22]; a1 -= mq[3][3] * x[23]; b1 -= mq[3][3] * y[23]; mq[3] = *(const LAS f32x4*)(Mg + 3436);
            a0 -= mq[4][0] * x[24]; b0 -= mq[4][0] * y[24]; a1 -= mq[4][1] * x[25]; b1 -= mq[4][1] * y[25]; a0 -= mq[4][2] * x[26]; b0 -= mq[4][2] * y[26]; a1 -= mq[4][3] * x[27]; b1 -= mq[4][3] * y[27]; mq[4] = *(const LAS f32x4*)(Mg + 3440);
            a0 -= mq[5][0] * x[28]; b0 -= mq[5][0] * y[28]; a1 -= mq[5][1] * x[29]; b1 -= mq[5][1] * y[29]; a0 -= mq[5][2] * x[30]; b0 -= mq[5][2] * y[30]; a1 -= mq[5][3] * x[31]; b1 -= mq[5][3] * y[31]; mq[5] = *(const LAS f32x4*)(Mg + 3444);
            a0 -= mq[0][0] * x[32]; b0 -= mq[0][0] * y[32]; a1 -= mq[0][1] * x[33]; b1 -= mq[0][1] * y[33]; a0 -= mq[0][2] * x[34]; b0 -= mq[0][2] * y[34]; a1 -= mq[0][3] * x[35]; b1 -= mq[0][3] * y[35]; mq[0] = *(const LAS f32x4*)(Mg + 3456);
            a0 -= mq[1][0] * x[36]; b0 -= mq[1][0] * y[36]; a1 -= mq[1][1] * x[37]; b1 -= mq[1][1] * y[37]; a0 -= mq[1][2] * x[38]; b0 -= mq[1][2] * y[38]; a1 -= mq[1][3] * x[39]; b1 -= mq[1][3] * y[39]; mq[1] = *(const LAS f32x4*)(Mg + 3460);
            a0 -= mq[2][0] * x[40]; b0 -= mq[2][0] * y[40]; a1 -= mq[2][1] * x[41]; b1 -= mq[2][1] * y[41]; a0 -= mq[2][2] * x[42]; b0 -= mq[2][2] * y[42]; a1 -= mq[2][3] * x[43]; b1 -= mq[2][3] * y[43]; mq[2] = *(const LAS f32x4*)(Mg + 3464);
            a0 -= mq[3][0] * x[44]; b0 -= mq[3][0] * y[44]; a1 -= mq[3][1] * x[45]; b1 -= mq[3][1] * y[45]; a0 -= mq[3][2] * x[46]; b0 -= mq[3][2] * y[46]; a1 -= mq[3][3] * x[47]; b1 -= mq[3][3] * y[47]; mq[3] = *(const LAS f32x4*)(Mg + 3468);
            a0 -= mq[4][0] * x[48]; b0 -= mq[4][0] * y[48]; a1 -= mq[4][1] * x[49]; b1 -= mq[4][1] * y[49]; a0 -= mq[4][2] * x[50]; b0 -= mq[4][2] * y[50]; a1 -= mq[4][3] * x[51]; b1 -= mq[4][3] * y[51]; mq[4] = *(const LAS f32x4*)(Mg + 3472);
            a0 -= mq[5][0] * x[52]; b0 -= mq[5][0] * y[52]; x[53] = a0 + a1; y[53] = b0 + b1; up[6784] = x[53]; wp[6784] = f2bf(-y[53]); mq[5] = *(const LAS f32x4*)(Mg + 3476);
            { const float br = betg[54]; a0 = bf2f(*(const LAS bf16_t*)(lg + P5_VS + 14688 + c * 2)) * br; b0 = bf2f(*(const LAS bf16_t*)(lg + P5_KS + 14688 + c * 2)) * br * __expf(decg[54]); a1 = 0.f; b1 = 0.f; } a0 -= mq[0][0] * x[0]; b0 -= mq[0][0] * y[0]; a1 -= mq[0][1] * x[1]; b1 -= mq[0][1] * y[1]; a0 -= mq[0][2] * x[2]; b0 -= mq[0][2] * y[2]; a1 -= mq[0][3] * x[3]; b1 -= mq[0][3] * y[3]; mq[0] = *(const LAS f32x4*)(Mg + 3480);
            a0 -= mq[1][0] * x[4]; b0 -= mq[1][0] * y[4]; a1 -= mq[1][1] * x[5]; b1 -= mq[1][1] * y[5]; a0 -= mq[1][2] * x[6]; b0 -= mq[1][2] * y[6]; a1 -= mq[1][3] * x[7]; b1 -= mq[1][3] * y[7]; mq[1] = *(const LAS f32x4*)(Mg + 3484);
            a0 -= mq[2][0] * x[8]; b0 -= mq[2][0] * y[8]; a1 -= mq[2][1] * x[9]; b1 -= mq[2][1] * y[9]; a0 -= mq[2][2] * x[10]; b0 -= mq[2][2] * y[10]; a1 -= mq[2][3] * x[11]; b1 -= mq[2][3] * y[11]; mq[2] = *(const LAS f32x4*)(Mg + 3488);
            a0 -= mq[3][0] * x[12]; b0 -= mq[3][0] * y[12]; a1 -= mq[3][1] * x[13]; b1 -= mq[3][1] * y[13]; a0 -= mq[3][2] * x[14]; b0 -= mq[3][2] * y[14]; a1 -= mq[3][3] * x[15]; b1 -= mq[3][3] * y[15]; mq[3] = *(const LAS f32x4*)(Mg + 3492);
            a0 -= mq[4][0] * x[16]; b0 -= mq[4][0] * y[16]; a1 -= mq[4][1] * x[17]; b1 -= mq[4][1] * y[17]; a0 -= mq[4][2] * x[18]; b0 -= mq[4][2] * y[18]; a1 -= mq[4][3] * x[19]; b1 -= mq[4][3] * y[19]; mq[4] = *(const LAS f32x4*)(Mg + 3496);
            a0 -= mq[5][0] * x[20]; b0 -= mq[5][0] * y[20]; a1 -= mq[5][1] * x[21]; b1 -= mq[5][1] * y[21]; a0 -= mq[5][2] * x[22]; b0 -= mq[5][2] * y[22]; a1 -= mq[5][3] * x[23]; b1 -= mq[5][3] * y[23]; mq[5] = *(const LAS f32x4*)(Mg + 3500);
            a0 -= mq[0][0] * x[24]; b0 -= mq[0][0] * y[24]; a1 -= mq[0][1] * x[25]; b1 -= mq[0][1] * y[25]; a0 -= mq[0][2] * x[26]; b0 -= mq[0][2] * y[26]; a1 -= mq[0][3] * x[27]; b1 -= mq[0][3] * y[27]; mq[0] = *(const LAS f32x4*)(Mg + 3504);
            a0 -= mq[1][0] * x[28]; b0 -= mq[1][0] * y[28]; a1 -= mq[1][1] * x[29]; b1 -= mq[1][1] * y[29]; a0 -= mq[1][2] * x[30]; b0 -= mq[1][2] * y[30]; a1 -= mq[1][3] * x[31]; b1 -= mq[1][3] * y[31]; mq[1] = *(const LAS f32x4*)(Mg + 3508);
            a0 -= mq[2][0] * x[32]; b0 -= mq[2][0] * y[32]; a1 -= mq[2][1] * x[33]; b1 -= mq[2][1] * y[33]; a0 -= mq[2][2] * x[34]; b0 -= mq[2][2] * y[34]; a1 -= mq[2][3] * x[35]; b1 -= mq[2][3] * y[35]; mq[2] = *(const LAS f32x4*)(Mg + 3520);
            a0 -= mq[3][0] * x[36]; b0 -= mq[3][0] * y[36]; a1 -= mq[3][1] * x[37]; b1 -= mq[3][1] * y[37]; a0 -= mq[3][2] * x[38]; b0 -= mq[3][2] * y[38]; a1 -= mq[3][3] * x[39]; b1 -= mq[3][3] * y[39]; mq[3] = *(const LAS f32x4*)(Mg + 3524);
            a0 -= mq[4][0] * x[40]; b0 -= mq[4][0] * y[40]; a1 -= mq[4][1] * x[41]; b1 -= mq[4][1] * y[41]; a0 -= mq[4][2] * x[42]; b0 -= mq[4][2] * y[42]; a1 -= mq[4][3] * x[43]; b1 -= mq[4][3] * y[43]; mq[4] = *(const LAS f32x4*)(Mg + 3528);
            a0 -= mq[5][0] * x[44]; b0 -= mq[5][0] * y[44]; a1 -= mq[5][1] * x[45]; b1 -= mq[5][1] * y[45]; a0 -= mq[5][2] * x[46]; b0 -= mq[5][2] * y[46]; a1 -= mq[5][3] * x[47]; b1 -= mq[5][3] * y[47]; mq[5] = *(const LAS f32x4*)(Mg + 3532);
            a0 -= mq[0][0] * x[48]; b0 -= mq[0][0] * y[48]; a1 -= mq[0][1] * x[49]; b1 -= mq[0][1] * y[49]; a0 -= mq[0][2] * x[50]; b0 -= mq[0][2] * y[50]; a1 -= mq[0][3] * x[51]; b1 -= mq[0][3] * y[51]; mq[0] = *(const LAS f32x4*)(Mg + 3536);
            a0 -= mq[1][0] * x[52]; b0 -= mq[1][0] * y[52]; a1 -= mq[1][1] * x[53]; b1 -= mq[1][1] * y[53]; x[54] = a0 + a1; y[54] = b0 + b1; up[6912] = x[54]; wp[6912] = f2bf(-y[54]); mq[1] = *(const LAS f32x4*)(Mg + 3540);
            { const float br = betg[55]; a0 = bf2f(*(const LAS bf16_t*)(lg + P5_VS + 14960 + c * 2)) * br; b0 = bf2f(*(const LAS bf16_t*)(lg + P5_KS + 14960 + c * 2)) * br * __expf(decg[55]); a1 = 0.f; b1 = 0.f; } a0 -= mq[2][0] * x[0]; b0 -= mq[2][0] * y[0]; a1 -= mq[2][1] * x[1]; b1 -= mq[2][1] * y[1]; a0 -= mq[2][2] * x[2]; b0 -= mq[2][2] * y[2]; a1 -= mq[2][3] * x[3]; b1 -= mq[2][3] * y[3]; mq[2] = *(const LAS f32x4*)(Mg + 3544);
            a0 -= mq[3][0] * x[4]; b0 -= mq[3][0] * y[4]; a1 -= mq[3][1] * x[5]; b1 -= mq[3][1] * y[5]; a0 -= mq[3][2] * x[6]; b0 -= mq[3][2] * y[6]; a1 -= mq[3][3] * x[7]; b1 -= mq[3][3] * y[7]; mq[3] = *(const LAS f32x4*)(Mg + 3548);
            a0 -= mq[4][0] * x[8]; b0 -= mq[4][0] * y[8]; a1 -= mq[4][1] * x[9]; b1 -= mq[4][1] * y[9]; a0 -= mq[4][2] * x[10]; b0 -= mq[4][2] * y[10]; a1 -= mq[4][3] * x[11]; b1 -= mq[4][3] * y[11]; mq[4] = *(const LAS f32x4*)(Mg + 3552);
            a0 -= mq[5][0] * x[12]; b0 -= mq[5][0] * y[12]; a1 -= mq[5][1] * x[13]; b1 -= mq[5][1] * y[13]; a0 -= mq[5][2] * x[14]; b0 -= mq[5][2] * y[14]; a1 -= mq[5][3] * x[15]; b1 -= mq[5][3] * y[15]; mq[5] = *(const LAS f32x4*)(Mg + 3556);
            a0 -= mq[0][0] * x[16]; b0 -= mq[0][0] * y[16]; a1 -= mq[0][1] * x[17]; b1 -= mq[0][1] * y[17]; a0 -= mq[0][2] * x[18]; b0 -= mq[0][2] * y[18]; a1 -= mq[0][3] * x[19]; b1 -= mq[0][3] * y[19]; mq[0] = *(const LAS f32x4*)(Mg + 3560);
            a0 -= mq[1][0] * x[20]; b0 -= mq[1][0] * y[20]; a1 -= mq[1][1] * x[21]; b1 -= mq[1][1] * y[21]; a0 -= mq[1][2] * x[22]; b0 -= mq[1][2] * y[22]; a1 -= mq[1][3] * x[23]; b1 -= mq[1][3] * y[23]; mq[1] = *(const LAS f32x4*)(Mg + 3564);
            a0 -= mq[2][0] * x[24]; b0 -= mq[2][0] * y[24]; a1 -= mq[2][1] * x[25]; b1 -= mq[2][1] * y[25]; a0 -= mq[2][2] * x[26]; b0 -= mq[2][2] * y[26]; a1 -= mq[2][3] * x[27]; b1 -= mq[2][3] * y[27]; mq[2] = *(const LAS f32x4*)(Mg + 3568);
            a0 -= mq[3][0] * x[28]; b0 -= mq[3][0] * y[28]; a1 -= mq[3][1] * x[29]; b1 -= mq[3][1] * y[29]; a0 -= mq[3][2] * x[30]; b0 -= mq[3][2] * y[30]; a1 -= mq[3][3] * x[31]; b1 -= mq[3][3] * y[31]; mq[3] = *(const LAS f32x4*)(Mg + 3572);
            a0 -= mq[4][0] * x[32]; b0 -= mq[4][0] * y[32]; a1 -= mq[4][1] * x[33]; b1 -= mq[4][1] * y[33]; a0 -= mq[4][2] * x[34]; b0 -= mq[4][2] * y[34]; a1 -= mq[4][3] * x[35]; b1 -= mq[4][3] * y[35]; mq[4] = *(const LAS f32x4*)(Mg + 3584);
            a0 -= mq[5][0] * x[36]; b0 -= mq[5][0] * y[36]; a1 -= mq[5][1] * x[37]; b1 -= mq[5][1] * y[37]; a0 -= mq[5][2] * x[38]; b0 -= mq[5][2] * y[38]; a1 -= mq[5][3] * x[39]; b1 -= mq[5][3] * y[39]; mq[5] = *(const LAS f32x4*)(Mg + 3588);
            a0 -= mq[0][0] * x[40]; b0 -= mq[0][0] * y[40]; a1 -= mq[0][1] * x[41]; b1 -= mq[0][1] * y[41]; a0 -= mq[0][2] * x[42]; b0 -= mq[0][2] * y[42]; a1 -= mq[0][3] * x[43]; b1 -= mq[0][3] * y[43]; mq[0] = *(const LAS f32x4*)(Mg + 3592);
            a0 -= mq[1][0] * x[44]; b0 -= mq[1][0] * y[44]; a1 -= mq[1][1] * x[45]; b1 -= mq[1][1] * y[45]; a0 -= mq[1][2] * x[46]; b0 -= mq[1][2] * y[46]; a1 -= mq[1][3] * x[47]; b1 -= mq[1][3] * y[47]; mq[1] = *(const LAS f32x4*)(Mg + 3596);
            a0 -= mq[2][0] * x[48]; b0 -= mq[2][0] * y[48]; a1 -= mq[2][1] * x[49]; b1 -= mq[2][1] * y[49]; a0 -= mq[2][2] * x[50]; b0 -= mq[2][2] * y[50]; a1 -= mq[2][3] * x[51]; b1 -= mq[2][3] * y[51]; mq[2] = *(const LAS f32x4*)(Mg + 3600);
            a0 -= mq[3][0] * x[52]; b0 -= mq[3][0] * y[52]; a1 -= mq[3][1] * x[53]; b1 -= mq[3][1] * y[53]; a0 -= mq[3][2] * x[54]; b0 -= mq[3][2] * y[54]; x[55] = a0 + a1; y[55] = b0 + b1; up[7040] = x[55]; wp[7040] = f2bf(-y[55]); mq[3] = *(const LAS f32x4*)(Mg + 3604);
            { const float br = betg[56]; a0 = bf2f(*(const LAS bf16_t*)(lg + P5_VS + 15232 + c * 2)) * br; b0 = bf2f(*(const LAS bf16_t*)(lg + P5_KS + 15232 + c * 2)) * br * __expf(decg[56]); a1 = 0.f; b1 = 0.f; } a0 -= mq[4][0] * x[0]; b0 -= mq[4][0] * y[0]; a1 -= mq[4][1] * x[1]; b1 -= mq[4][1] * y[1]; a0 -= mq[4][2] * x[2]; b0 -= mq[4][2] * y[2]; a1 -= mq[4][3] * x[3]; b1 -= mq[4][3] * y[3]; mq[4] = *(const LAS f32x4*)(Mg + 3608);
            a0 -= mq[5][0] * x[4]; b0 -= mq[5][0] * y[4]; a1 -= mq[5][1] * x[5]; b1 -= mq[5][1] * y[5]; a0 -= mq[5][2] * x[6]; b0 -= mq[5][2] * y[6]; a1 -= mq[5][3] * x[7]; b1 -= mq[5][3] * y[7]; mq[5] = *(const LAS f32x4*)(Mg + 3612);
            a0 -= mq[0][0] * x[8]; b0 -= mq[0][0] * y[8]; a1 -= mq[0][1] * x[9]; b1 -= mq[0][1] * y[9]; a0 -= mq[0][2] * x[10]; b0 -= mq[0][2] * y[10]; a1 -= mq[0][3] * x[11]; b1 -= mq[0][3] * y[11]; mq[0] = *(const LAS f32x4*)(Mg + 3616);
            a0 -= mq[1][0] * x[12]; b0 -= mq[1][0] * y[12]; a1 -= mq[1][1] * x[13]; b1 -= mq[1][1] * y[13]; a0 -= mq[1][2] * x[14]; b0 -= mq[1][2] * y[14]; a1 -= mq[1][3] * x[15]; b1 -= mq[1][3] * y[15]; mq[1] = *(const LAS f32x4*)(Mg + 3620);
            a0 -= mq[2][0] * x[16]; b0 -= mq[2][0] * y[16]; a1 -= mq[2][1] * x[17]; b1 -= mq[2][1] * y[17]; a0 -= mq[2][2] * x[18]; b0 -= mq[2][2] * y[18]; a1 -= mq[2][3] * x[19]; b1 -= mq[2][3] * y[19]; mq[2] = *(const LAS f32x4*)(Mg + 3624);
            a0 -= mq[3][0] * x[20]; b0 -= mq[3][0] * y[20]; a1 -= mq[3][1] * x[21]; b1 -= mq[3][1] * y[21]; a0 -= mq[3][2] * x[22]; b0 -= mq[3][2] * y[22]; a1 -= mq[3][3] * x[23]; b1 -= mq[3][3] * y[23]; mq[3] = *(const LAS f32x4*)(Mg + 3628);
            a0 -= mq[4][0] * x[24]; b0 -= mq[4][0] * y[24]; a1 -= mq[4][1] * x[25]; b1 -= mq[4][1] * y[25]; a0 -= mq[4][2] * x[26]; b0 -= mq[4][2] * y[26]; a1 -= mq[4][3] * x[27]; b1 -= mq[4][3] * y[27]; mq[4] = *(const LAS f32x4*)(Mg + 3632);
            a0 -= mq[5][0] * x[28]; b0 -= mq[5][0] * y[28]; a1 -= mq[5][1] * x[29]; b1 -= mq[5][1] * y[29]; a0 -= mq[5][2] * x[30]; b0 -= mq[5][2] * y[30]; a1 -= mq[5][3] * x[31]; b1 -= mq[5][3] * y[31]; mq[5] = *(const LAS f32x4*)(Mg + 3636);
            a0 -= mq[0][0] * x[32]; b0 -= mq[0][0] * y[32]; a1 -= mq[0][1] * x[33]; b1 -= mq[0][1] * y[33]; a0 -= mq[0][2] * x[34]; b0 -= mq[0][2] * y[34]; a1 -= mq[0][3] * x[35]; b1 -= mq[0][3] * y[35]; mq[0] = *(const LAS f32x4*)(Mg + 3648);
            a0 -= mq[1][0] * x[36]; b0 -= mq[1][0] * y[36]; a1 -= mq[1][1] * x[37]; b1 -= mq[1][1] * y[37]; a0 -= mq[1][2] * x[38]; b0 -= mq[1][2] * y[38]; a1 -= mq[1][3] * x[39]; b1 -= mq[1][3] * y[39]; mq[1] = *(const LAS f32x4*)(Mg + 3652);
            a0 -= mq[2][0] * x[40]; b0 -= mq[2][0] * y[40]; a1 -= mq[2][1] * x[41]; b1 -= mq[2][1] * y[41]; a0 -= mq[2][2] * x[42]; b0 -= mq[2][2] * y[42]; a1 -= mq[2][3] * x[43]; b1 -= mq[2][3] * y[43]; mq[2] = *(const LAS f32x4*)(Mg + 3656);
            a0 -= mq[3][0] * x[44]; b0 -= mq[3][0] * y[44]; a1 -= mq[3][1] * x[45]; b1 -= mq[3][1] * y[45]; a0 -= mq[3][2] * x[46]; b0 -= mq[3][2] * y[46]; a1 -= mq[3][3] * x[47]; b1 -= mq[3][3] * y[47]; mq[3] = *(const LAS f32x4*)(Mg + 3660);
            a0 -= mq[4][0] * x[48]; b0 -= mq[4][0] * y[48]; a1 -= mq[4][1] * x[49]; b1 -= mq[4][1] * y[49]; a0 -= mq[4][2] * x[50]; b0 -= mq[4][2] * y[50]; a1 -= mq[4][3] * x[51]; b1 -= mq[4][3] * y[51]; mq[4] = *(const LAS f32x4*)(Mg + 3664);
            a0 -= mq[5][0] * x[52]; b0 -= mq[5][0] * y[52]; a1 -= mq[5][1] * x[53]; b1 -= mq[5][1] * y[53]; a0 -= mq[5][2] * x[54]; b0 -= mq[5][2] * y[54]; a1 -= mq[5][3] * x[55]; b1 -= mq[5][3] * y[55]; x[56] = a0 + a1; y[56] = b0 + b1; up[7168] = x[56]; wp[7168] = f2bf(-y[56]); mq[5] = *(const LAS f32x4*)(Mg + 3668);
            { const float br = betg[57]; a0 = bf2f(*(const LAS bf16_t*)(lg + P5_VS + 15504 + c * 2)) * br; b0 = bf2f(*(const LAS bf16_t*)(lg + P5_KS + 15504 + c * 2)) * br * __expf(decg[57]); a1 = 0.f; b1 = 0.f; } a0 -= mq[0][0] * x[0]; b0 -= mq[0][0] * y[0]; a1 -= mq[0][1] * x[1]; b1 -= mq[0][1] * y[1]; a0 -= mq[0][2] * x[2]; b0 -= mq[0][2] * y[2]; a1 -= mq[0][3] * x[3]; b1 -= mq[0][3] * y[3]; mq[0] = *(const LAS f32x4*)(Mg + 3672);
            a0 -= mq[1][0] * x[4]; b0 -= mq[1][0] * y[4]; a1 -= mq[1][1] * x[5]; b1 -= mq[1][1] * y[5]; a0 -= mq[1][2] * x[6]; b0 -= mq[1][2] * y[6]; a1 -= mq[1][3] * x[7]; b1 -= mq[1][3] * y[7]; mq[1] = *(const LAS f32x4*)(Mg + 3676);
            a0 -= mq[2][0] * x[8]; b0 -= mq[2][0] * y[8]; a1 -= mq[2][1] * x[9]; b1 -= mq[2][1] * y[9]; a0 -= mq[2][2] * x[10]; b0 -= mq[2][2] * y[10]; a1 -= mq[2][3] * x[11]; b1 -= mq[2][3] * y[11]; mq[2] = *(const LAS f32x4*)(Mg + 3680);
            a0 -= mq[3][0] * x[12]; b0 -= mq[3][0] * y[12]; a1 -= mq[3][1] * x[13]; b1 -= mq[3][1] * y[13]; a0 -= mq[3][2] * x[14]; b0 -= mq[3][2] * y[14]; a1 -= mq[3][3] * x[15]; b1 -= mq[3][3] * y[15]; mq[3] = *(const LAS f32x4*)(Mg + 3684);
            a0 -= mq[4][0] * x[16]; b0 -= mq[4][0] * y[16]; a1 -= mq[4][1] * x[17]; b1 -= mq[4][1] * y[17]; a0 -= mq[4][2] * x[18]; b0 -= mq[4][2] * y[18]; a1 -= mq[4][3] * x[19]; b1 -= mq[4][3] * y[19]; mq[4] = *(const LAS f32x4*)(Mg + 3688);
            a0 -= mq[5][0] * x[20]; b0 -= mq[5][0] * y[20]; a1 -= mq[5][1] * x[21]; b1 -= mq[5][1] * y[21]; a0 -= mq[5][2] * x[22]; b0 -= mq[5][2] * y[22]; a1 -= mq[5][3] * x[23]; b1 -= mq[5][3] * y[23]; mq[5] = *(const LAS f32x4*)(Mg + 3692);
            a0 -= mq[0][0] * x[24]; b0 -= mq[0][0] * y[24]; a1 -= mq[0][1] * x[25]; b1 -= mq[0][1] * y[25]; a0 -= mq[0][2] * x[26]; b0 -= mq[0][2] * y[26]; a1 -= mq[0][3] * x[27]; b1 -= mq[0][3] * y[27]; mq[0] = *(const LAS f32x4*)(Mg + 3696);
            a0 -= mq[1][0] * x[28]; b0 -= mq[1][0] * y[28]; a1 -= mq[1][1] * x[29]; b1 -= mq[1][1] * y[29]; a0 -= mq[1][2] * x[30]; b0 -= mq[1][2] * y[30]; a1 -= mq[1][3] * x[31]; b1 -= mq[1][3] * y[31]; mq[1] = *(const LAS f32x4*)(Mg + 3700);
            a0 -= mq[2][0] * x[32]; b0 -= mq[2][0] * y[32]; a1 -= mq[2][1] * x[33]; b1 -= mq[2][1] * y[33]; a0 -= mq[2][2] * x[34]; b0 -= mq[2][2] * y[34]; a1 -= mq[2][3] * x[35]; b1 -= mq[2][3] * y[35]; mq[2] = *(const LAS f32x4*)(Mg + 3704);
            a0 -= mq[3][0] * x[36]; b0 -= mq[3][0] * y[36]; a1 -= mq[3][1] * x[37]; b1 -= mq[3][1] * y[37]; a0 -= mq[3][2] * x[38]; b0 -= mq[3][2] * y[38]; a1 -= mq[3][3] * x[39]; b1 -= mq[3][3] * y[39]; mq[3] = *(const LAS f32x4*)(Mg + 3712);
            a0 -= mq[4][0] * x[40]; b0 -= mq[4][0] * y[40]; a1 -= mq[4][1] * x[41]; b1 -= mq[4][1] * y[41]; a0 -= mq[4][2] * x[42]; b0 -= mq[4][2] * y[42]; a1 -= mq[4][3] * x[43]; b1 -= mq[4][3] * y[43]; mq[4] = *(const LAS f32x4*)(Mg + 3716);
            a0 -= mq[5][0] * x[44]; b0 -= mq[5][0] * y[44]; a1 -= mq[5][1] * x[45]; b1 -= mq[5][1] * y[45]; a0 -= mq[5][2] * x[46]; b0 -= mq[5][2] * y[46]; a1 -= mq[5][3] * x[47]; b1 -= mq[5][3] * y[47]; mq[5] = *(const LAS f32x4*)(Mg + 3720);
            a0 -= mq[0][0] * x[48]; b0 -= mq[0][0] * y[48]; a1 -= mq[0][1] * x[49]; b1 -= mq[0][1] * y[49]; a0 -= mq[0][2] * x[50]; b0 -= mq[0][2] * y[50]; a1 -= mq[0][3] * x[51]; b1 -= mq[0][3] * y[51]; mq[0] = *(const LAS f32x4*)(Mg + 3724);
            a0 -= mq[1][0] * x[52]; b0 -= mq[1][0] * y[52]; a1 -= mq[1][1] * x[53]; b1 -= mq[1][1] * y[53]; a0 -= mq[1][2] * x[54]; b0 -= mq[1][2] * y[54]; a1 -= mq[1][3] * x[55]; b1 -= mq[1][3] * y[55]; mq[1] = *(const LAS f32x4*)(Mg + 3728);
            a0 -= mq[2][0] * x[56]; b0 -= mq[2][0] * y[56]; x[57] = a0 + a1; y[57] = b0 + b1; up[7296] = x[57]; wp[7296] = f2bf(-y[57]); mq[2] = *(const LAS f32x4*)(Mg + 3732);
            { const float br = betg[58]; a0 = bf2f(*(const LAS bf16_t*)(lg + P5_VS + 15776 + c * 2)) * br; b0 = bf2f(*(const LAS bf16_t*)(lg + P5_KS + 15776 + c * 2)) * br * __expf(decg[58]); a1 = 0.f; b1 = 0.f; } a0 -= mq[3][0] * x[0]; b0 -= mq[3][0] * y[0]; a1 -= mq[3][1] * x[1]; b1 -= mq[3][1] * y[1]; a0 -= mq[3][2] * x[2]; b0 -= mq[3][2] * y[2]; a1 -= mq[3][3] * x[3]; b1 -= mq[3][3] * y[3]; mq[3] = *(const LAS f32x4*)(Mg + 3736);
            a0 -= mq[4][0] * x[4]; b0 -= mq[4][0] * y[4]; a1 -= mq[4][1] * x[5]; b1 -= mq[4][1] * y[5]; a0 -= mq[4][2] * x[6]; b0 -= mq[4][2] * y[6]; a1 -= mq[4][3] * x[7]; b1 -= mq[4][3] * y[7]; mq[4] = *(const LAS f32x4*)(Mg + 3740);
            a0 -= mq[5][0] * x[8]; b0 -= mq[5][0] * y[8]; a1 -= mq[5][1] * x[9]; b1 -= mq[5][1] * y[9]; a0 -= mq[5][2] * x[10]; b0 -= mq[5][2] * y[10]; a1 -= mq[5][3] * x[11]; b1 -= mq[5][3] * y[11]; mq[5] = *(const LAS f32x4*)(Mg + 3744);
            a0 -= mq[0][0] * x[12]; b0 -= mq[0][0] * y[12]; a1 -= mq[0][1] * x[13]; b1 -= mq[0][1] * y[13]; a0 -= mq[0][2] * x[14]; b0 -= mq[0][2] * y[14]; a1 -= mq[0][3] * x[15]; b1 -= mq[0][3] * y[15]; mq[0] = *(const LAS f32x4*)(Mg + 3748);
            a0 -= mq[1][0] * x[16]; b0 -= mq[1][0] * y[16]; a1 -= mq[1][1] * x[17]; b1 -= mq[1][1] * y[17]; a0 -= mq[1][2] * x[18]; b0 -= mq[1][2] * y[18]; a1 -= mq[1][3] * x[19]; b1 -= mq[1][3] * y[19]; mq[1] = *(const LAS f32x4*)(Mg + 3752);
            a0 -= mq[2][0] * x[20]; b0 -= mq[2][0] * y[20]; a1 -= mq[2][1] * x[21]; b1 -= mq[2][1] * y[21]; a0 -= mq[2][2] * x[22]; b0 -= mq[2][2] * y[22]; a1 -= mq[2][3] * x[23]; b1 -= mq[2][3] * y[23]; mq[2] = *(const LAS f32x4*)(Mg + 3756);
            a0 -= mq[3][0] * x[24]; b0 -= mq[3][0] * y[24]; a1 -= mq[3][1] * x[25]; b1 -= mq[3][1] * y[25]; a0 -= mq[3][2] * x[26]; b0 -= mq[3][2] * y[26]; a1 -= mq[3][3] * x[27]; b1 -= mq[3][3] * y[27]; mq[3] = *(const LAS f32x4*)(Mg + 3760);
            a0 -= mq[4][0] * x[28]; b0 -= mq[4][0] * y[28]; a1 -= mq[4][1] * x[29]; b1 -= mq[4][1] * y[29]; a0 -= mq[4][2] * x[30]; b0 -= mq[4][2] * y[30]; a1 -= mq[4][3] * x[31]; b1 -= mq[4][3] * y[31]; mq[4] = *(const LAS f32x4*)(Mg + 3764);
            a0 -= mq[5][0] * x[32]; b0 -= mq[5][0] * y[32]; a1 -= mq[5][1] * x[33]; b1 -= mq[5][1] * y[33]; a0 -= mq[5][2] * x[34]; b0 -= mq[5][2] * y[34]; a1 -= mq[5][3] * x[35]; b1 -= mq[5][3] * y[35]; mq[5] = *(const LAS f32x4*)(Mg + 3768);
            a0 -= mq[0][0] * x[36]; b0 -= mq[0][0] * y[36]; a1 -= mq[0][1] * x[37]; b1 -= mq[0][1] * y[37]; a0 -= mq[0][2] * x[38]; b0 -= mq[0][2] * y[38]; a1 -= mq[0][3] * x[39]; b1 -= mq[0][3] * y[39]; mq[0] = *(const LAS f32x4*)(Mg + 3776);
            a0 -= mq[1][0] * x[40]; b0 -= mq[1][0] * y[40]; a1 -= mq[1][1] * x[41]; b1 -= mq[1][1] * y[41]; a0 -= mq[1][2] * x[42]; b0 -= mq[1][2] * y[42]; a1 -= mq[1][3] * x[43]; b1 -= mq[1][3] * y[43]; mq[1] = *(const LAS f32x4*)(Mg + 3780);
            a0 -= mq[2][0] * x[44]; b0 -= mq[2][0] * y[44]; a1 -= mq[2][1] * x[45]; b1 -= mq[2][1] * y[45]; a0 -= mq[2][2] * x[46]; b0 -= mq[2][2] * y[46]; a1 -= mq[2][3] * x[47]; b1 -= mq[2][3] * y[47]; mq[2] = *(const LAS f32x4*)(Mg + 3784);
            a0 -= mq[3][0] * x[48]; b0 -= mq[3][0] * y[48]; a1 -= mq[3][1] * x[49]; b1 -= mq[3][1] * y[49]; a0 -= mq[3][2] * x[50]; b0 -= mq[3][2] * y[50]; a1 -= mq[3][3] * x[51]; b1 -= mq[3][3] * y[51]; mq[3] = *(const LAS f32x4*)(Mg + 3788);
            a0 -= mq[4][0] * x[52]; b0 -= mq[4][0] * y[52]; a1 -= mq[4][1] * x[53]; b1 -= mq[4][1] * y[53]; a0 -= mq[4][2] * x[54]; b0 -= mq[4][2] * y[54]; a1 -= mq[4][3] * x[55]; b1 -= mq[4][3] * y[55]; mq[4] = *(const LAS f32x4*)(Mg + 3792);
            a0 -= mq[5][0] * x[56]; b0 -= mq[5][0] * y[56]; a1 -= mq[5][1] * x[57]; b1 -= mq[5][1] * y[57]; x[58] = a0 + a1; y[58] = b0 + b1; up[7424] = x[58]; wp[7424] = f2bf(-y[58]); mq[5] = *(const LAS f32x4*)(Mg + 3796);
            { const float br = betg[59]; a0 = bf2f(*(const LAS bf16_t*)(lg + P5_VS + 16048 + c * 2)) * br; b0 = bf2f(*(const LAS bf16_t*)(lg + P5_KS + 16048 + c * 2)) * br * __expf(decg[59]); a1 = 0.f; b1 = 0.f; } a0 -= mq[0][0] * x[0]; b0 -= mq[0][0] * y[0]; a1 -= mq[0][1] * x[1]; b1 -= mq[0][1] * y[1]; a0 -= mq[0][2] * x[2]; b0 -= mq[0][2] * y[2]; a1 -= mq[0][3] * x[3]; b1 -= mq[0][3] * y[3]; mq[0] = *(const LAS f32x4*)(Mg + 3800);
            a0 -= mq[1][0] * x[4]; b0 -= mq[1][0] * y[4]; a1 -= mq[1][1] * x[5]; b1 -= mq[1][1] * y[5]; a0 -= mq[1][2] * x[6]; b0 -= mq[1][2] * y[6]; a1 -= mq[1][3] * x[7]; b1 -= mq[1][3] * y[7]; mq[1] = *(const LAS f32x4*)(Mg + 3804);
            a0 -= mq[2][0] * x[8]; b0 -= mq[2][0] * y[8]; a1 -= mq[2][1] * x[9]; b1 -= mq[2][1] * y[9]; a0 -= mq[2][2] * x[10]; b0 -= mq[2][2] * y[10]; a1 -= mq[2][3] * x[11]; b1 -= mq[2][3] * y[11]; mq[2] = *(const LAS f32x4*)(Mg + 3808);
            a0 -= mq[3][0] * x[12]; b0 -= mq[3][0] * y[12]; a1 -= mq[3][1] * x[13]; b1 -= mq[3][1] * y[13]; a0 -= mq[3][2] * x[14]; b0 -= mq[3][2] * y[14]; a1 -= mq[3][3] * x[15]; b1 -= mq[3][3] * y[15]; mq[3] = *(const LAS f32x4*)(Mg + 3812);
            a0 -= mq[4][0] * x[16]; b0 -= mq[4][0] * y[16]; a1 -= mq[4][1] * x[17]; b1 -= mq[4][1] * y[17]; a0 -= mq[4][2] * x[18]; b0 -= mq[4][2] * y[18]; a1 -= mq[4][3] * x[19]; b1 -= mq[4][3] * y[19]; mq[4] = *(const LAS f32x4*)(Mg + 3816);
            a0 -= mq[5][0] * x[20]; b0 -= mq[5][0] * y[20]; a1 -= mq[5][1] * x[21]; b1 -= mq[5][1] * y[21]; a0 -= mq[5][2] * x[22]; b0 -= mq[5][2] * y[22]; a1 -= mq[5][3] * x[23]; b1 -= mq[5][3] * y[23]; mq[5] = *(const LAS f32x4*)(Mg + 3820);
            a0 -= mq[0][0] * x[24]; b0 -= mq[0][0] * y[24]; a1 -= mq[0][1] * x[25]; b1 -= mq[0][1] * y[25]; a0 -= mq[0][2] * x[26]; b0 -= mq[0][2] * y[26]; a1 -= mq[0][3] * x[27]; b1 -= mq[0][3] * y[27]; mq[0] = *(const LAS f32x4*)(Mg + 3824);
            a0 -= mq[1][0] * x[28]; b0 -= mq[1][0] * y[28]; a1 -= mq[1][1] * x[29]; b1 -= mq[1][1] * y[29]; a0 -= mq[1][2] * x[30]; b0 -= mq[1][2] * y[30]; a1 -= mq[1][3] * x[31]; b1 -= mq[1][3] * y[31]; mq[1] = *(const LAS f32x4*)(Mg + 3828);
            a0 -= mq[2][0] * x[32]; b0 -= mq[2][0] * y[32]; a1 -= mq[2][1] * x[33]; b1 -= mq[2][1] * y[33]; a0 -= mq[2][2] * x[34]; b0 -= mq[2][2] * y[34]; a1 -= mq[2][3] * x[35]; b1 -= mq[2][3] * y[35]; mq[2] = *(const LAS f32x4*)(Mg + 3832);
            a0 -= mq[3][0] * x[36]; b0 -= mq[3][0] * y[36]; a1 -= mq[3][1] * x[37]; b1 -= mq[3][1] * y[37]; a0 -= mq[3][2] * x[38]; b0 -= mq[3][2] * y[38]; a1 -= mq[3][3] * x[39]; b1 -= mq[3][3] * y[39]; mq[3] = *(const LAS f32x4*)(Mg + 3840);
            a0 -= mq[4][0] * x[40]; b0 -= mq[4][0] * y[40]; a1 -= mq[4][1] * x[41]; b1 -= mq[4][1] * y[41]; a0 -= mq[4][2] * x[42]; b0 -= mq[4][2] * y[42]; a1 -= mq[4][3] * x[43]; b1 -= mq[4][3] * y[43]; mq[4] = *(const LAS f32x4*)(Mg + 3844);
            a0 -= mq[5][0] * x[44]; b0 -= mq[5][0] * y[44]; a1 -= mq[5][1] * x[45]; b1 -= mq[5][1] * y[45]; a0 -= mq[5][2] * x[46]; b0 -= mq[5][2] * y[46]; a1 -= mq[5][3] * x[47]; b1 -= mq[5][3] * y[47]; mq[5] = *(const LAS f32x4*)(Mg + 3848);
            a0 -= mq[0][0] * x[48]; b0 -= mq[0][0] * y[48]; a1 -= mq[0][1] * x[49]; b1 -= mq[0][1] * y[49]; a0 -= mq[0][2] * x[50]; b0 -= mq[0][2] * y[50]; a1 -= mq[0][3] * x[51]; b1 -= mq[0][3] * y[51]; mq[0] = *(const LAS f32x4*)(Mg + 3852);
            a0 -= mq[1][0] * x[52]; b0 -= mq[1][0] * y[52]; a1 -= mq[1][1] * x[53]; b1 -= mq[1][1] * y[53]; a0 -= mq[1][2] * x[54]; b0 -= mq[1][2] * y[54]; a1 -= mq[1][3] * x[55]; b1 -= mq[1][3] * y[55]; mq[1] = *(const LAS f32x4*)(Mg + 3856);
            a0 -= mq[2][0] * x[56]; b0 -= mq[2][0] * y[56]; a1 -= mq[2][1] * x[57]; b1 -= mq[2][1] * y[57]; a0 -= mq[2][2] * x[58]; b0 -= mq[2][2] * y[58]; x[59] = a0 + a1; y[59] = b0 + b1; up[7552] = x[59]; wp[7552] = f2bf(-y[59]); mq[2] = *(const LAS f32x4*)(Mg + 3860);
            { const float br = betg[60]; a0 = bf2f(*(const LAS bf16_t*)(lg + P5_VS + 16320 + c * 2)) * br; b0 = bf2f(*(const LAS bf16_t*)(lg + P5_KS + 16320 + c * 2)) * br * __expf(decg[60]); a1 = 0.f; b1 = 0.f; } a0 -= mq[3][0] * x[0]; b0 -= mq[3][0] * y[0]; a1 -= mq[3][1] * x[1]; b1 -= mq[3][1] * y[1]; a0 -= mq[3][2] * x[2]; b0 -= mq[3][2] * y[2]; a1 -= mq[3][3] * x[3]; b1 -= mq[3][3] * y[3]; mq[3] = *(const LAS f32x4*)(Mg + 3864);
            a0 -= mq[4][0] * x[4]; b0 -= mq[4][0] * y[4]; a1 -= mq[4][1] * x[5]; b1 -= mq[4][1] * y[5]; a0 -= mq[4][2] * x[6]; b0 -= mq[4][2] * y[6]; a1 -= mq[4][3] * x[7]; b1 -= mq[4][3] * y[7]; mq[4] = *(const LAS f32x4*)(Mg + 3868);
            a0 -= mq[5][0] * x[8]; b0 -= mq[5][0] * y[8]; a1 -= mq[5][1] * x[9]; b1 -= mq[5][1] * y[9]; a0 -= mq[5][2] * x[10]; b0 -= mq[5][2] * y[10]; a1 -= mq[5][3] * x[11]; b1 -= mq[5][3] * y[11]; mq[5] = *(const LAS f32x4*)(Mg + 3872);
            a0 -= mq[0][0] * x[12]; b0 -= mq[0][0] * y[12]; a1 -= mq[0][1] * x[13]; b1 -= mq[0][1] * y[13]; a0 -= mq[0][2] * x[14]; b0 -= mq[0][2] * y[14]; a1 -= mq[0][3] * x[15]; b1 -= mq[0][3] * y[15]; mq[0] = *(const LAS f32x4*)(Mg + 3876);
            a0 -= mq[1][0] * x[16]; b0 -= mq[1][0] * y[16]; a1 -= mq[1][1] * x[17]; b1 -= mq[1][1] * y[17]; a0 -= mq[1][2] * x[18]; b0 -= mq[1][2] * y[18]; a1 -= mq[1][3] * x[19]; b1 -= mq[1][3] * y[19]; mq[1] = *(const LAS f32x4*)(Mg + 3880);
            a0 -= mq[2][0] * x[20]; b0 -= mq[2][0] * y[20]; a1 -= mq[2][1] * x[21]; b1 -= mq[2][1] * y[21]; a0 -= mq[2][2] * x[22]; b0 -= mq[2][2] * y[22]; a1 -= mq[2][3] * x[23]; b1 -= mq[2][3] * y[23]; mq[2] = *(const LAS f32x4*)(Mg + 3884);
            a0 -= mq[3][0] * x[24]; b0 -= mq[3][0] * y[24]; a1 -= mq[3][1] * x[25]; b1 -= mq[3][1] * y[25]; a0 -= mq[3][2] * x[26]; b0 -= mq[3][2] * y[26]; a1 -= mq[3][3] * x[27]; b1 -= mq[3][3] * y[27]; mq[3] = *(const LAS f32x4*)(Mg + 3888);
            a0 -= mq[4][0] * x[28]; b0 -= mq[4][0] * y[28]; a1 -= mq[4][1] * x[29]; b1 -= mq[4][1] * y[29]; a0 -= mq[4][2] * x[30]; b0 -= mq[4][2] * y[30]; a1 -= mq[4][3] * x[31]; b1 -= mq[4][3] * y[31]; mq[4] = *(const LAS f32x4*)(Mg + 3892);
            a0 -= mq[5][0] * x[32]; b0 -= mq[5][0] * y[32]; a1 -= mq[5][1] * x[33]; b1 -= mq[5][1] * y[33]; a0 -= mq[5][2] * x[34]; b0 -= mq[5][2] * y[34]; a1 -= mq[5][3] * x[35]; b1 -= mq[5][3] * y[35]; mq[5] = *(const LAS f32x4*)(Mg + 3896);
            a0 -= mq[0][0] * x[36]; b0 -= mq[0][0] * y[36]; a1 -= mq[0][1] * x[37]; b1 -= mq[0][1] * y[37]; a0 -= mq[0][2] * x[38]; b0 -= mq[0][2] * y[38]; a1 -= mq[0][3] * x[39]; b1 -= mq[0][3] * y[39]; mq[0] = *(const LAS f32x4*)(Mg + 3904);
            a0 -= mq[1][0] * x[40]; b0 -= mq[1][0] * y[40]; a1 -= mq[1][1] * x[41]; b1 -= mq[1][1] * y[41]; a0 -= mq[1][2] * x[42]; b0 -= mq[1][2] * y[42]; a1 -= mq[1][3] * x[43]; b1 -= mq[1][3] * y[43]; mq[1] = *(const LAS f32x4*)(Mg + 3908);
            a0 -= mq[2][0] * x[44]; b0 -= mq[2][0] * y[44]; a1 -= mq[2][1] * x[45]; b1 -= mq[2][1] * y[45]; a0 -= mq[2][2] * x[46]; b0 -= mq[2][2] * y[46]; a1 -= mq[2][3] * x[47]; b1 -= mq[2][3] * y[47]; mq[2] = *(const LAS f32x4*)(Mg + 3912);
            a0 -= mq[3][0] * x[48]; b0 -= mq[3][0] * y[48]; a1 -= mq[3][1] * x[49]; b1 -= mq[3][1] * y[49]; a0 -= mq[3][2] * x[50]; b0 -= mq[3][2] * y[50]; a1 -= mq[3][3] * x[51]; b1 -= mq[3][3] * y[51]; mq[3] = *(const LAS f32x4*)(Mg + 3916);
            a0 -= mq[4][0] * x[52]; b0 -= mq[4][0] * y[52]; a1 -= mq[4][1] * x[53]; b1 -= mq[4][1] * y[53]; a0 -= mq[4][2] * x[54]; b0 -= mq[4][2] * y[54]; a1 -= mq[4][3] * x[55]; b1 -= mq[4][3] * y[55]; mq[4] = *(const LAS f32x4*)(Mg + 3920);
            a0 -= mq[5][0] * x[56]; b0 -= mq[5][0] * y[56]; a1 -= mq[5][1] * x[57]; b1 -= mq[5][1] * y[57]; a0 -= mq[5][2] * x[58]; b0 -= mq[5][2] * y[58]; a1 -= mq[5][3] * x[59]; b1 -= mq[5][3] * y[59]; x[60] = a0 + a1; y[60] = b0 + b1; up[7680] = x[60]; wp[7680] = f2bf(-y[60]); mq[5] = *(const LAS f32x4*)(Mg + 3924);
            { const float br = betg[61]; a0 = bf2f(*(const LAS bf16_t*)(lg + P5_VS + 16592 + c * 2)) * br; b0 = bf2f(*(const LAS bf16_t*)(lg + P5_KS + 16592 + c * 2)) * br * __expf(decg[61]); a1 = 0.f; b1 = 0.f; } a0 -= mq[0][0] * x[0]; b0 -= mq[0][0] * y[0]; a1 -= mq[0][1] * x[1]; b1 -= mq[0][1] * y[1]; a0 -= mq[0][2] * x[2]; b0 -= mq[0][2] * y[2]; a1 -= mq[0][3] * x[3]; b1 -= mq[0][3] * y[3]; mq[0] = *(const LAS f32x4*)(Mg + 3928);
            a0 -= mq[1][0] * x[4]; b0 -= mq[1][0] * y[4]; a1 -= mq[1][1] * x[5]; b1 -= mq[1][1] * y[5]; a0 -= mq[1][2] * x[6]; b0 -= mq[1][2] * y[6]; a1 -= mq[1][3] * x[7]; b1 -= mq[1][3] * y[7]; mq[1] = *(const LAS f32x4*)(Mg + 3932);
            a0 -= mq[2][0] * x[8]; b0 -= mq[2][0] * y[8]; a1 -= mq[2][1] * x[9]; b1 -= mq[2][1] * y[9]; a0 -= mq[2][2] * x[10]; b0 -= mq[2][2] * y[10]; a1 -= mq[2][3] * x[11]; b1 -= mq[2][3] * y[11]; mq[2] = *(const LAS f32x4*)(Mg + 3936);
            a0 -= mq[3][0] * x[12]; b0 -= mq[3][0] * y[12]; a1 -= mq[3][1] * x[13]; b1 -= mq[3][1] * y[13]; a0 -= mq[3][2] * x[14]; b0 -= mq[3][2] * y[14]; a1 -= mq[3][3] * x[15]; b1 -= mq[3][3] * y[15]; mq[3] = *(const LAS f32x4*)(Mg + 3940);
            a0 -= mq[4][0] * x[16]; b0 -= mq[4][0] * y[16]; a1 -= mq[4][1] * x[17]; b1 -= mq[4][1] * y[17]; a0 -= mq[4][2] * x[18]; b0 -= mq[4][2] * y[18]; a1 -= mq[4][3] * x[19]; b1 -= mq[4][3] * y[19]; mq[4] = *(const LAS f32x4*)(Mg + 3944);
            a0 -= mq[5][0] * x[20]; b0 -= mq[5][0] * y[20]; a1 -= mq[5][1] * x[21]; b1 -= mq[5][1] * y[21]; a0 -= mq[5][2] * x[22]; b0 -= mq[5][2] * y[22]; a1 -= mq[5][3] * x[23]; b1 -= mq[5][3] * y[23]; mq[5] = *(const LAS f32x4*)(Mg + 3948);
            a0 -= mq[0][0] * x[24]; b0 -= mq[0][0] * y[24]; a1 -= mq[0][1] * x[25]; b1 -= mq[0][1] * y[25]; a0 -= mq[0][2] * x[26]; b0 -= mq[0][2] * y[26]; a1 -= mq[0][3] * x[27]; b1 -= mq[0][3] * y[27]; mq[0] = *(const LAS f32x4*)(Mg + 3952);
            a0 -= mq[1][0] * x[28]; b0 -= mq[1][0] * y[28]; a1 -= mq[1][1] * x[29]; b1 -= mq[1][1] * y[29]; a0 -= mq[1][2] * x[30]; b0 -= mq[1][2] * y[30]; a1 -= mq[1][3] * x[31]; b1 -= mq[1][3] * y[31]; mq[1] = *(const LAS f32x4*)(Mg + 3956);
            a0 -= mq[2][0] * x[32]; b0 -= mq[2][0] * y[32]; a1 -= mq[2][1] * x[33]; b1 -= mq[2][1] * y[33]; a0 -= mq[2][2] * x[34]; b0 -= mq[2][2] * y[34]; a1 -= mq[2][3] * x[35]; b1 -= mq[2][3] * y[35]; mq[2] = *(const LAS f32x4*)(Mg + 3960);
            a0 -= mq[3][0] * x[36]; b0 -= mq[3][0] * y[36]; a1 -= mq[3][1] * x[37]; b1 -= mq[3][1] * y[37]; a0 -= mq[3][2] * x[38]; b0 -= mq[3][2] * y[38]; a1 -= mq[3][3] * x[39]; b1 -= mq[3][3] * y[39]; mq[3] = *(const LAS f32x4*)(Mg + 3964);
            a0 -= mq[4][0] * x[40]; b0 -= mq[4][0] * y[40]; a1 -= mq[4][1] * x[41]; b1 -= mq[4][1] * y[41]; a0 -= mq[4][2] * x[42]; b0 -= mq[4][2] * y[42]; a1 -= mq[4][3] * x[43]; b1 -= mq[4][3] * y[43]; mq[4] = *(const LAS f32x4*)(Mg + 3968);
            a0 -= mq[5][0] * x[44]; b0 -= mq[5][0] * y[44]; a1 -= mq[5][1] * x[45]; b1 -= mq[5][1] * y[45]; a0 -= mq[5][2] * x[46]; b0 -= mq[5][2] * y[46]; a1 -= mq[5][3] * x[47]; b1 -= mq[5][3] * y[47]; mq[5] = *(const LAS f32x4*)(Mg + 3972);
            a0 -= mq[0][0] * x[48]; b0 -= mq[0][0] * y[48]; a1 -= mq[0][1] * x[49]; b1 -= mq[0][1] * y[49]; a0 -= mq[0][2] * x[50]; b0 -= mq[0][2] * y[50]; a1 -= mq[0][3] * x[51]; b1 -= mq[0][3] * y[51]; mq[0] = *(const LAS f32x4*)(Mg + 3976);
            a0 -= mq[1][0] * x[52]; b0 -= mq[1][0] * y[52]; a1 -= mq[1][1] * x[53]; b1 -= mq[1][1] * y[53]; a0 -= mq[1][2] * x[54]; b0 -= mq[1][2] * y[54]; a1 -= mq[1][3] * x[55]; b1 -= mq[1][3] * y[55]; mq[1] = *(const LAS f32x4*)(Mg + 3980);
            a0 -= mq[2][0] * x[56]; b0 -= mq[2][0] * y[56]; a1 -= mq[2][1] * x[57]; b1 -= mq[2][1] * y[57]; a0 -= mq[2][2] * x[58]; b0 -= mq[2][2] * y[58]; a1 -= mq[2][3] * x[59]; b1 -= mq[2][3] * y[59]; mq[2] = *(const LAS f32x4*)(Mg + 3984);
            a0 -= mq[3][0] * x[60]; b0 -= mq[3][0] * y[60]; x[61] = a0 + a1; y[61] = b0 + b1; up[7808] = x[61]; wp[7808] = f2bf(-y[61]); mq[3] = *(const LAS f32x4*)(Mg + 3988);
            { const float br = betg[62]; a0 = bf2f(*(const LAS bf16_t*)(lg + P5_VS + 16864 + c * 2)) * br; b0 = bf2f(*(const LAS bf16_t*)(lg + P5_KS + 16864 + c * 2)) * br * __expf(decg[62]); a1 = 0.f; b1 = 0.f; } a0 -= mq[4][0] * x[0]; b0 -= mq[4][0] * y[0]; a1 -= mq[4][1] * x[1]; b1 -= mq[4][1] * y[1]; a0 -= mq[4][2] * x[2]; b0 -= mq[4][2] * y[2]; a1 -= mq[4][3] * x[3]; b1 -= mq[4][3] * y[3]; mq[4] = *(const LAS f32x4*)(Mg + 3992);
            a0 -= mq[5][0] * x[4]; b0 -= mq[5][0] * y[4]; a1 -= mq[5][1] * x[5]; b1 -= mq[5][1] * y[5]; a0 -= mq[5][2] * x[6]; b0 -= mq[5][2] * y[6]; a1 -= mq[5][3] * x[7]; b1 -= mq[5][3] * y[7]; mq[5] = *(const LAS f32x4*)(Mg + 3996);
            a0 -= mq[0][0] * x[8]; b0 -= mq[0][0] * y[8]; a1 -= mq[0][1] * x[9]; b1 -= mq[0][1] * y[9]; a0 -= mq[0][2] * x[10]; b0 -= mq[0][2] * y[10]; a1 -= mq[0][3] * x[11]; b1 -= mq[0][3] * y[11]; mq[0] = *(const LAS f32x4*)(Mg + 4000);
            a0 -= mq[1][0] * x[12]; b0 -= mq[1][0] * y[12]; a1 -= mq[1][1] * x[13]; b1 -= mq[1][1] * y[13]; a0 -= mq[1][2] * x[14]; b0 -= mq[1][2] * y[14]; a1 -= mq[1][3] * x[15]; b1 -= mq[1][3] * y[15]; mq[1] = *(const LAS f32x4*)(Mg + 4004);
            a0 -= mq[2][0] * x[16]; b0 -= mq[2][0] * y[16]; a1 -= mq[2][1] * x[17]; b1 -= mq[2][1] * y[17]; a0 -= mq[2][2] * x[18]; b0 -= mq[2][2] * y[18]; a1 -= mq[2][3] * x[19]; b1 -= mq[2][3] * y[19]; mq[2] = *(const LAS f32x4*)(Mg + 4008);
            a0 -= mq[3][0] * x[20]; b0 -= mq[3][0] * y[20]; a1 -= mq[3][1] * x[21]; b1 -= mq[3][1] * y[21]; a0 -= mq[3][2] * x[22]; b0 -= mq[3][2] * y[22]; a1 -= mq[3][3] * x[23]; b1 -= mq[3][3] * y[23]; mq[3] = *(const LAS f32x4*)(Mg + 4012);
            a0 -= mq[4][0] * x[24]; b0 -= mq[4][0] * y[24]; a1 -= mq[4][1] * x[25]; b1 -= mq[4][1] * y[25]; a0 -= mq[4][2] * x[26]; b0 -= mq[4][2] * y[26]; a1 -= mq[4][3] * x[27]; b1 -= mq[4][3] * y[27]; mq[4] = *(const LAS f32x4*)(Mg + 4016);
            a0 -= mq[5][0] * x[28]; b0 -= mq[5][0] * y[28]; a1 -= mq[5][1] * x[29]; b1 -= mq[5][1] * y[29]; a0 -= mq[5][2] * x[30]; b0 -= mq[5][2] * y[30]; a1 -= mq[5][3] * x[31]; b1 -= mq[5][3] * y[31]; mq[5] = *(const LAS f32x4*)(Mg + 4020);
            a0 -= mq[0][0] * x[32]; b0 -= mq[0][0] * y[32]; a1 -= mq[0][1] * x[33]; b1 -= mq[0][1] * y[33]; a0 -= mq[0][2] * x[34]; b0 -= mq[0][2] * y[34]; a1 -= mq[0][3] * x[35]; b1 -= mq[0][3] * y[35]; mq[0] = *(const LAS f32x4*)(Mg + 4024);
            a0 -= mq[1][0] * x[36]; b0 -= mq[1][0] * y[36]; a1 -= mq[1][1] * x[37]; b1 -= mq[1][1] * y[37]; a0 -= mq[1][2] * x[38]; b0 -= mq[1][2] * y[38]; a1 -= mq[1][3] * x[39]; b1 -= mq[1][3] * y[39]; mq[1] = *(const LAS f32x4*)(Mg + 4028);
            a0 -= mq[2][0] * x[40]; b0 -= mq[2][0] * y[40]; a1 -= mq[2][1] * x[41]; b1 -= mq[2][1] * y[41]; a0 -= mq[2][2] * x[42]; b0 -= mq[2][2] * y[42]; a1 -= mq[2][3] * x[43]; b1 -= mq[2][3] * y[43]; mq[2] = *(const LAS f32x4*)(Mg + 4032);
            a0 -= mq[3][0] * x[44]; b0 -= mq[3][0] * y[44]; a1 -= mq[3][1] * x[45]; b1 -= mq[3][1] * y[45]; a0 -= mq[3][2] * x[46]; b0 -= mq[3][2] * y[46]; a1 -= mq[3][3] * x[47]; b1 -= mq[3][3] * y[47]; mq[3] = *(const LAS f32x4*)(Mg + 4036);
            a0 -= mq[4][0] * x[48]; b0 -= mq[4][0] * y[48]; a1 -= mq[4][1] * x[49]; b1 -= mq[4][1] * y[49]; a0 -= mq[4][2] * x[50]; b0 -= mq[4][2] * y[50]; a1 -= mq[4][3] * x[51]; b1 -= mq[4][3] * y[51]; mq[4] = *(const LAS f32x4*)(Mg + 4040);
            a0 -= mq[5][0] * x[52]; b0 -= mq[5][0] * y[52]; a1 -= mq[5][1] * x[53]; b1 -= mq[5][1] * y[53]; a0 -= mq[5][2] * x[54]; b0 -= mq[5][2] * y[54]; a1 -= mq[5][3] * x[55]; b1 -= mq[5][3] * y[55]; mq[5] = *(const LAS f32x4*)(Mg + 4044);
            a0 -= mq[0][0] * x[56]; b0 -= mq[0][0] * y[56]; a1 -= mq[0][1] * x[57]; b1 -= mq[0][1] * y[57]; a0 -= mq[0][2] * x[58]; b0 -= mq[0][2] * y[58]; a1 -= mq[0][3] * x[59]; b1 -= mq[0][3] * y[59]; mq[0] = *(const LAS f32x4*)(Mg + 4048);
            a0 -= mq[1][0] * x[60]; b0 -= mq[1][0] * y[60]; a1 -= mq[1][1] * x[61]; b1 -= mq[1][1] * y[61]; x[62] = a0 + a1; y[62] = b0 + b1; up[7936] = x[62]; wp[7936] = f2bf(-y[62]); mq[1] = *(const LAS f32x4*)(Mg + 4052);
            { const float br = betg[63]; a0 = bf2f(*(const LAS bf16_t*)(lg + P5_VS + 17136 + c * 2)) * br; b0 = bf2f(*(const LAS bf16_t*)(lg + P5_KS + 17136 + c * 2)) * br * __expf(decg[63]); a1 = 0.f; b1 = 0.f; } a0 -= mq[2][0] * x[0]; b0 -= mq[2][0] * y[0]; a1 -= mq[2][1] * x[1]; b1 -= mq[2][1] * y[1]; a0 -= mq[2][2] * x[2]; b0 -= mq[2][2] * y[2]; a1 -= mq[2][3] * x[3]; b1 -= mq[2][3] * y[3]; mq[2] = *(const LAS f32x4*)(Mg + 4056);
            a0 -= mq[3][0] * x[4]; b0 -= mq[3][0] * y[4]; a1 -= mq[3][1] * x[5]; b1 -= mq[3][1] * y[5]; a0 -= mq[3][2] * x[6]; b0 -= mq[3][2] * y[6]; a1 -= mq[3][3] * x[7]; b1 -= mq[3][3] * y[7]; mq[3] = *(const LAS f32x4*)(Mg + 4060);
            a0 -= mq[4][0] * x[8]; b0 -= mq[4][0] * y[8]; a1 -= mq[4][1] * x[9]; b1 -= mq[4][1] * y[9]; a0 -= mq[4][2] * x[10]; b0 -= mq[4][2] * y[10]; a1 -= mq[4][3] * x[11]; b1 -= mq[4][3] * y[11]; mq[4] = *(const LAS f32x4*)(Mg + 4064);
            a0 -= mq[5][0] * x[12]; b0 -= mq[5][0] * y[12]; a1 -= mq[5][1] * x[13]; b1 -= mq[5][1] * y[13]; a0 -= mq[5][2] * x[14]; b0 -= mq[5][2] * y[14]; a1 -= mq[5][3] * x[15]; b1 -= mq[5][3] * y[15]; mq[5] = *(const LAS f32x4*)(Mg + 4068);
            a0 -= mq[0][0] * x[16]; b0 -= mq[0][0] * y[16]; a1 -= mq[0][1] * x[17]; b1 -= mq[0][1] * y[17]; a0 -= mq[0][2] * x[18]; b0 -= mq[0][2] * y[18]; a1 -= mq[0][3] * x[19]; b1 -= mq[0][3] * y[19]; mq[0] = *(const LAS f32x4*)(Mg + 4072);
            a0 -= mq[1][0] * x[20]; b0 -= mq[1][0] * y[20]; a1 -= mq[1][1] * x[21]; b1 -= mq[1][1] * y[21]; a0 -= mq[1][2] * x[22]; b0 -= mq[1][2] * y[22]; a1 -= mq[1][3] * x[23]; b1 -= mq[1][3] * y[23]; mq[1] = *(const LAS f32x4*)(Mg + 4076);
            a0 -= mq[2][0] * x[24]; b0 -= mq[2][0] * y[24]; a1 -= mq[2][1] * x[25]; b1 -= mq[2][1] * y[25]; a0 -= mq[2][2] * x[26]; b0 -= mq[2][2] * y[26]; a1 -= mq[2][3] * x[27]; b1 -= mq[2][3] * y[27]; mq[2] = *(const LAS f32x4*)(Mg + 4080);
            a0 -= mq[3][0] * x[28]; b0 -= mq[3][0] * y[28]; a1 -= mq[3][1] * x[29]; b1 -= mq[3][1] * y[29]; a0 -= mq[3][2] * x[30]; b0 -= mq[3][2] * y[30]; a1 -= mq[3][3] * x[31]; b1 -= mq[3][3] * y[31]; mq[3] = *(const LAS f32x4*)(Mg + 4084);
            a0 -= mq[4][0] * x[32]; b0 -= mq[4][0] * y[32]; a1 -= mq[4][1] * x[33]; b1 -= mq[4][1] * y[33]; a0 -= mq[4][2] * x[34]; b0 -= mq[4][2] * y[34]; a1 -= mq[4][3] * x[35]; b1 -= mq[4][3] * y[35]; mq[4] = *(const LAS f32x4*)(Mg + 4088);
            a0 -= mq[5][0] * x[36]; b0 -= mq[5][0] * y[36]; a1 -= mq[5][1] * x[37]; b1 -= mq[5][1] * y[37]; a0 -= mq[5][2] * x[38]; b0 -= mq[5][2] * y[38]; a1 -= mq[5][3] * x[39]; b1 -= mq[5][3] * y[39]; mq[5] = *(const LAS f32x4*)(Mg + 4092);
            a0 -= mq[0][0] * x[40]; b0 -= mq[0][0] * y[40]; a1 -= mq[0][1] * x[41]; b1 -= mq[0][1] * y[41]; a0 -= mq[0][2] * x[42]; b0 -= mq[0][2] * y[42]; a1 -= mq[0][3] * x[43]; b1 -= mq[0][3] * y[43];
            a0 -= mq[1][0] * x[44]; b0 -= mq[1][0] * y[44]; a1 -= mq[1][1] * x[45]; b1 -= mq[1][1] * y[45]; a0 -= mq[1][2] * x[46]; b0 -= mq[1][2] * y[46]; a1 -= mq[1][3] * x[47]; b1 -= mq[1][3] * y[47];
            a0 -= mq[2][0] * x[48]; b0 -= mq[2][0] * y[48]; a1 -= mq[2][1] * x[49]; b1 -= mq[2][1] * y[49]; a0 -= mq[2][2] * x[50]; b0 -= mq[2][2] * y[50]; a1 -= mq[2][3] * x[51]; b1 -= mq[2][3] * y[51];
            a0 -= mq[3][0] * x[52]; b0 -= mq[3][0] * y[52]; a1 -= mq[3][1] * x[53]; b1 -= mq[3][1] * y[53]; a0 -= mq[3][2] * x[54]; b0 -= mq[3][2] * y[54]; a1 -= mq[3][3] * x[55]; b1 -= mq[3][3] * y[55];
            a0 -= mq[4][0] * x[56]; b0 -= mq[4][0] * y[56]; a1 -= mq[4][1] * x[57]; b1 -= mq[4][1] * y[57]; a0 -= mq[4][2] * x[58]; b0 -= mq[4][2] * y[58]; a1 -= mq[4][3] * x[59]; b1 -= mq[4][3] * y[59];
            a0 -= mq[5][0] * x[60]; b0 -= mq[5][0] * y[60]; a1 -= mq[5][1] * x[61]; b1 -= mq[5][1] * y[61]; a0 -= mq[5][2] * x[62]; b0 -= mq[5][2] * y[62]; x[63] = a0 + a1; y[63] = b0 + b1; up[8064] = x[63]; wp[8064] = f2bf(-y[63]);
        } else {
            const int g2 = (w8 - 4) >> 1, tt = ((w8 - 4) & 1) * 64 + lane; const int item2 = it0 + g2;
            LAS unsigned char* lg = lds0 + g2 * P5_GRP; LAS float* decg = (LAS float*)(lg + P5_DEC);
            const float lastg = decg[63];
#pragma unroll
            for (int i = 0; i < 8; ++i) { const int vid = tt + 128 * i, r = vid >> 4, d0 = (vid & 15) * 8; float f[8]; unpack8(*(const LAS u32x4*)(lg + P5_QS + r * 272 + d0 * 2), f);
                const float e = scale * __expf(decg[r]);
#pragma unroll
                for (int q = 0; q < 8; ++q) f[q] *= e;
                *(u32x4*)(qd + (size_t)item2 * 8192 + r * 128 + d0) = pack8(f); }
#pragma unroll
            for (int i = 0; i < 8; ++i) { const int vid = tt + 128 * i, d = vid >> 3, rg = (vid & 7) * 8; float f[8];
#pragma unroll
                for (int q = 0; q < 8; ++q) f[q] = bf2f(*(const LAS bf16_t*)(lg + P5_KS + (rg + q) * 272 + d * 2)) * __expf(lastg - decg[rg + q]);
                *(u32x4*)(kt + (size_t)item2 * 8192 + d * 64 + rg) = pack8(f); }
            if (tt == 0) cdv[item2] = __expf(lastg);
        }
    }
    __syncthreads();
}

constexpr int SB_WD = 0, SB_QD = 17408, SB_KT = 34816, SB_QK = 53248, SB_UB = 62464, SB_SIZE = 66560;
constexpr int SC_ST = 2 * SB_SIZE, SC_UT = SC_ST + 4352, SC_END = SC_UT + 2304;
static_assert(SC_END <= LDS_BYTES, "lds");
__device__ __forceinline__ void scan_phase(const Params& p, int bid, int nblk, LAS unsigned char* lds) {
    const int tid = threadIdx.x, lane = tid & 63, wid = __builtin_amdgcn_readfirstlane(tid >> 6), fr = lane & 15, fq = lane >> 4;
    const bf16_t* wdc = (const bf16_t*)(p.ws + WS_WDC); const bf16_t* qd = (const bf16_t*)(p.ws + WS_QD); const bf16_t* kt = (const bf16_t*)(p.ws + WS_KT); const bf16_t* qk = (const bf16_t*)(p.ws + WS_QK);
    const float* cdv = (const float*)(p.ws + WS_CD); const float* ub = p.out + OS_UB; float* obuf = p.out + OS_O;
    for (int item = bid; item < 256; item += nblk) {
        const int xcd = item & 7, iq = item >> 3, bh = xcd * 4 + (iq >> 3), sl = iq & 7, h = bh & 7, b = bh >> 3;
        u32x4 r_wd[2], r_qd[2], r_kt[2], r_qk, r_ub;
        auto gload = [&](int n) {
            const size_t it = (size_t)(bh * 32 + n);
#pragma unroll
            for (int i = 0; i < 2; ++i) { const int ch = tid + 512 * i; r_wd[i] = *(const u32x4*)(wdc + it * 8192 + ch * 8); r_qd[i] = *(const u32x4*)(qd + it * 8192 + ch * 8); r_kt[i] = *(const u32x4*)(kt + it * 8192 + ch * 8); }
            r_qk = *(const u32x4*)(qk + it * 4096 + tid * 8);
            if (tid < 256) r_ub = *(const u32x4*)(ub + it * 8192 + (tid >> 2) * 128 + sl * 16 + (tid & 3) * 4);
        };
        auto lstore = [&](int buf) {
            LAS unsigned char* B = lds + buf * SB_SIZE;
#pragma unroll
            for (int i = 0; i < 2; ++i) { const int ch = tid + 512 * i; const int r = ch >> 4, c8 = (ch & 15) * 8; *(LAS u32x4*)(B + SB_WD + r * 272 + c8 * 2) = r_wd[i]; *(LAS u32x4*)(B + SB_QD + r * 272 + c8 * 2) = r_qd[i];
                const int d = ch >> 3, t8 = (ch & 7) * 8; *(LAS u32x4*)(B + SB_KT + d * 144 + t8 * 2) = r_kt[i]; }
            { const int r = tid >> 3, s8 = (tid & 7) * 8; *(LAS u32x4*)(B + SB_QK + r * 144 + s8 * 2) = r_qk; }
            if (tid < 256) *(LAS u32x4*)(B + SB_UB + (tid >> 2) * 64 + (tid & 3) * 16) = r_ub;
        };
        __syncthreads();
        gload(0);
        for (int i = tid; i < 4352 / 4; i += 512) *(LAS unsigned*)(lds + SC_ST + i * 4) = 0u;
        lstore(0);
        f32x4 sacc = (f32x4){0.f, 0.f, 0.f, 0.f};
        __syncthreads();
        for (int n = 0; n < 32; ++n) {
            const int cur = n & 1; LAS unsigned char* B = lds + cur * SB_SIZE;
            if (n + 1 < 32) gload(n + 1);
            const float cd = cdv[bh * 32 + n];
            f32x4 acc;
            const int tw = wid & 3;
            if (wid < 4) {
#pragma unroll
                for (int j = 0; j < 4; ++j) acc[j] = *(const LAS float*)(B + SB_UB + ((tw * 16 + fq * 4 + j) * 16 + fr) * 4);
#pragma unroll
                for (int kk = 0; kk < 4; ++kk) { const bf16x8 a = *(const LAS bf16x8*)(B + SB_WD + (tw * 16 + fr) * 272 + (kk * 32 + fq * 8) * 2); const bf16x8 bb = *(const LAS bf16x8*)(lds + SC_ST + fr * 272 + (kk * 32 + fq * 8) * 2);
                    acc = __builtin_amdgcn_mfma_f32_16x16x32_bf16(a, bb, acc, 0, 0, 0); }
                u32x2 w; w.x = pk2(acc[0], acc[1]); w.y = pk2(acc[2], acc[3]);
                *(LAS u32x2*)(lds + SC_UT + fr * 144 + (tw * 16 + fq * 4) * 2) = w;
            } else {
                acc = (f32x4){0.f, 0.f, 0.f, 0.f};
#pragma unroll
                for (int kk = 0; kk < 4; ++kk) { const bf16x8 a = *(const LAS bf16x8*)(B + SB_QD + (tw * 16 + fr) * 272 + (kk * 32 + fq * 8) * 2); const bf16x8 bb = *(const LAS bf16x8*)(lds + SC_ST + fr * 272 + (kk * 32 + fq * 8) * 2);
                    acc = __builtin_amdgcn_mfma_f32_16x16x32_bf16(a, bb, acc, 0, 0, 0); }
            }
            __syncthreads();
            sacc *= cd;
#pragma unroll
            for (int kk = 0; kk < 2; ++kk) { const bf16x8 a = *(const LAS bf16x8*)(B + SB_KT + (wid * 16 + fr) * 144 + (kk * 32 + fq * 8) * 2); const bf16x8 bb = *(const LAS bf16x8*)(lds + SC_UT + fr * 144 + (kk * 32 + fq * 8) * 2);
                sacc = __builtin_amdgcn_mfma_f32_16x16x32_bf16(a, bb, sacc, 0, 0, 0); }
            if (wid >= 4) {
#pragma unroll
                for (int kk = 0; kk < 2; ++kk) { const bf16x8 a = *(const LAS bf16x8*)(B + SB_QK + (tw * 16 + fr) * 144 + (kk * 32 + fq * 8) * 2); const bf16x8 bb = *(const LAS bf16x8*)(lds + SC_UT + fr * 144 + (kk * 32 + fq * 8) * 2);
                    acc = __builtin_amdgcn_mfma_f32_16x16x32_bf16(a, bb, acc, 0, 0, 0); }
#pragma unroll
                for (int j = 0; j < 4; ++j) obuf[(size_t)(b * 2048 + n * 64 + tw * 16 + fq * 4 + j) * 1024 + h * 128 + sl * 16 + fr] = acc[j];
            }
            { u32x2 w; w.x = pk2(sacc[0], sacc[1]); w.y = pk2(sacc[2], sacc[3]); *(LAS u32x2*)(lds + SC_ST + fr * 272 + (wid * 16 + fq * 4) * 2) = w; }
            if (n + 1 < 32) lstore(cur ^ 1);
            __syncthreads();
        }
#pragma unroll
        for (int j = 0; j < 4; ++j) p.out[O_DP + ((size_t)bh * 128 + wid * 16 + fq * 4 + j) * 128 + sl * 16 + fr] = sacc[j];
    }
    __syncthreads();
    {
        const bf16_t* qn = (const bf16_t*)(p.ws + WS_QN); const bf16_t* kn = (const bf16_t*)(p.ws + WS_KN); const bf16_t* vv = (const bf16_t*)(p.ws + WS_VV);
        const float* gbuf = (const float*)(p.ws + WS_G); const float* bbuf = (const float*)(p.ws + WS_BETA);
        const int grp = tid >> 8, w4 = __builtin_amdgcn_readfirstlane(tid >> 6) & 3, j = w4 * 32 + (lane & 31), half = lane >> 5;
        LAS float* qs = (LAS float*)lds + grp * 1024;
        LAS float* ks = qs + 512;
        const float scale = 0.08838834764831845f;
        for (int it0 = bid * 2; it0 < 1024; it0 += nblk * 2) {
            const int item = it0 + grp, sb = item >> 3, h = item & 7;
            __syncthreads();
#pragma unroll
            for (int i = 0; i < 4; ++i) { const int idx = (tid & 255) + 256 * i, tk = idx >> 7, c = idx & 127, t = tk & 3; const size_t go = (size_t)(TP + sb * 4 + t) * 1024 + h * 128 + c;
                if (tk < 4) qs[t * 128 + c] = bf2f(qn[go]); else ks[t * 128 + c] = bf2f(kn[go]); }
            float S[64];
            const float* s0 = p.in[4] + (size_t)item * 16384 + (size_t)half * 64 * 128 + j;
#pragma unroll
            for (int i = 0; i < 64; ++i) S[i] = __builtin_nontemporal_load(s0 + i * 128);
            __syncthreads();
#pragma unroll 1
            for (int t = 0; t < 4; ++t) {
                const int row = TP + sb * 4 + t;
                const float a = __expf(gbuf[row * 8 + h]), be = bbuf[row * 8 + h], v = bf2f(vv[(size_t)row * 1024 + h * 128 + j]);
                float kS = 0.f;
#pragma unroll
                for (int i4 = 0; i4 < 16; ++i4) { const f32x4 k4 = *(const LAS f32x4*)(ks + t * 128 + half * 64 + i4 * 4); kS += k4[0] * S[i4 * 4] + k4[1] * S[i4 * 4 + 1] + k4[2] * S[i4 * 4 + 2] + k4[3] * S[i4 * 4 + 3]; }
                kS += __shfl_xor(kS, 32);
                const float coef = be * (v - a * kS);
                float o = 0.f;
#pragma unroll
                for (int i4 = 0; i4 < 16; ++i4) { const f32x4 k4 = *(const LAS f32x4*)(ks + t * 128 + half * 64 + i4 * 4); const f32x4 q4 = *(const LAS f32x4*)(qs + t * 128 + half * 64 + i4 * 4);
#pragma unroll
                    for (int q = 0; q < 4; ++q) { S[i4 * 4 + q] = a * S[i4 * 4 + q] + k4[q] * coef; o += q4[q] * S[i4 * 4 + q]; } }
                o += __shfl_xor(o, 32);
                if (half == 0) obuf[(size_t)row * 1024 + h * 128 + j] = o * scale;
            }
            float* so = p.out + O_DS + (size_t)item * 16384 + (size_t)half * 64 * 128 + j;
#pragma unroll
            for (int i = 0; i < 64; ++i) so[i * 128] = S[i];
        }
    }
    __syncthreads();
}

__device__ __forceinline__ void onorm_phase(const Params& p, int bid, int nblk) {
    const int lane = threadIdx.x & 63, wid = __builtin_amdgcn_readfirstlane(threadIdx.x >> 6);
    const float* obuf = p.out + OS_O; const bf16_t* proj = (const bf16_t*)(p.ws + WS_PROJ); bf16_t* acat = (bf16_t*)(p.ws + WS_U); const float* og = p.in[14];
    for (int row = bid * 8 + wid; row < TT; row += nblk * 8) {
        const int c0 = lane * 16; float o[16], z[16], g[16];
#pragma unroll
        for (int i = 0; i < 4; ++i) { const f32x4 v = *(const f32x4*)(obuf + (size_t)row * 1024 + c0 + i * 4); o[i * 4] = v[0]; o[i * 4 + 1] = v[1]; o[i * 4 + 2] = v[2]; o[i * 4 + 3] = v[3];
            const f32x4 gg = *(const f32x4*)(og + (c0 & 127) + i * 4); g[i * 4] = gg[0]; g[i * 4 + 1] = gg[1]; g[i * 4 + 2] = gg[2]; g[i * 4 + 3] = gg[3]; }
        unpack8(*(const u32x4*)(proj + (size_t)row * NPROJ + C_Z + c0), z); unpack8(*(const u32x4*)(proj + (size_t)row * NPROJ + C_Z + c0 + 8), z + 8);
        float ss = 0.f;
#pragma unroll
        for (int i = 0; i < 16; ++i) ss += o[i] * o[i];
        ss += __shfl_xor(ss, 1); ss += __shfl_xor(ss, 2); ss += __shfl_xor(ss, 4);
        const float rstd = rsqrtf(ss * (1.0f / 128.0f) + EPS);
#pragma unroll
        for (int i = 0; i < 16; ++i) o[i] = o[i] * rstd * g[i] * siluf_(z[i]);
        *(u32x4*)(acat + (size_t)row * DM + c0) = pack8(o); *(u32x4*)(acat + (size_t)row * DM + c0 + 8) = pack8(o + 8);
    }
}

#define XB_TMO      128
#define XB_XCNT(j)  (256  + 64 * (j))
#define XB_XSUB(j)  (1280 + 64 * (j))
#define XB_XGEN(j)  (2304 + 64 * (j))
#define XB_TOP      3328
#define XB_TOPGEN   3392
#define XCD_BAR_WORDS 3456
#define XB_SPIN_CAP (1u << 18)

__device__ __forceinline__ unsigned xb_ld(unsigned* p)              { return __hip_atomic_load(p, __ATOMIC_RELAXED, __HIP_MEMORY_SCOPE_AGENT); }
__device__ __forceinline__ unsigned xb_add(unsigned* p, unsigned v) { return __hip_atomic_fetch_add(p, v, __ATOMIC_RELAXED, __HIP_MEMORY_SCOPE_AGENT); }
__device__ __forceinline__ unsigned xb_xcc_id() { return (unsigned)__builtin_amdgcn_s_getreg((3 << 11) | 20) & 0xFu; }
#define XB_SPIN(cond, bar) do { unsigned _sp = 0; while (cond) { __builtin_amdgcn_s_sleep(1); \
    if ((++_sp & 255u) == 0u) { if (xb_ld(&(bar)[XB_TMO])) break; if (_sp > XB_SPIN_CAP) { atomicAdd(&(bar)[XB_TMO], 1u); break; } } } } while (0)

struct XcdBarrier {
    unsigned* bar; unsigned x;
    volatile LAS unsigned* st;
};

__device__ __forceinline__ XcdBarrier xcd_barrier_post(unsigned* bar, volatile LAS unsigned* st) {
    XcdBarrier b; b.bar = bar; b.x = xb_xcc_id(); b.st = st;
    if (threadIdx.x == 0) (void)xb_add(&bar[XB_XCNT(b.x)], 1u);
    return b;
}
__device__ __forceinline__ void xcd_barrier_complete(unsigned* bar, unsigned x, unsigned& nloc, unsigned& nx) {
    const unsigned G = gridDim.x * gridDim.y * gridDim.z;
    unsigned sum, cnt, mine, sp = 0u;
    for (;;) {
        sum = 0u; cnt = 0u; mine = 0u;
#pragma unroll
        for (unsigned j = 0; j < 16; ++j) { const unsigned c = xb_ld(&bar[XB_XCNT(j)]); sum += c; cnt += (c > 0u) ? 1u : 0u; mine = (j == x) ? c : mine; }
        if (sum == G) break;
        __builtin_amdgcn_s_sleep(1);
        if ((++sp & 255u) == 0u) { if (xb_ld(&bar[XB_TMO])) break; if (sp > XB_SPIN_CAP) { atomicAdd(&bar[XB_TMO], 1u); break; } }
    }
    nloc = mine > 0u ? mine : 1u; nx = cnt > 0u ? cnt : 1u;
}

__device__ __forceinline__ void xcd_barrier(const XcdBarrier& b) {
    asm volatile("s_waitcnt vmcnt(0)" ::: "memory");
    __syncthreads();
    if (threadIdx.x == 0) {
        unsigned* bar = b.bar;
        __builtin_amdgcn_s_waitcnt(0);
        unsigned nloc = b.st[0], nx = b.st[1];
        if (nloc == 0u) { xcd_barrier_complete(bar, b.x, nloc, nx); b.st[0] = nloc; b.st[1] = nx; }
        const unsigned old = xb_add(&bar[XB_XSUB(b.x)], 1u);
        const unsigned gen = old / nloc;
        if (old + 1u == (gen + 1u) * nloc) {
            __builtin_amdgcn_fence(__ATOMIC_RELEASE, "agent");
            asm volatile("s_waitcnt vmcnt(0)" ::: "memory");
            const unsigned og = xb_add(&bar[XB_TOP], 1u);
            const unsigned tg = og / nx;
            if (og + 1u == (tg + 1u) * nx) xb_add(&bar[XB_TOPGEN], 1u);
            else XB_SPIN(xb_ld(&bar[XB_TOPGEN]) == tg, bar);
            __builtin_amdgcn_fence(__ATOMIC_ACQUIRE, "agent");
            xb_add(&bar[XB_XGEN(b.x)], 1u);
            asm volatile("s_waitcnt vmcnt(0)" ::: "memory");
        } else {
            XB_SPIN(xb_ld(&bar[XB_XGEN(b.x)]) == gen, bar);
            __builtin_amdgcn_fence(__ATOMIC_ACQUIRE, "agent");
            asm volatile("s_waitcnt vmcnt(0)" ::: "memory");
        }
    }
    __syncthreads();
}

constexpr size_t WS_BAR = WS_END;
constexpr int LDS_ST_OFF = LDS_BYTES - 16;
struct KArgs { Params p; TJob jobs[11]; };
constexpr int N_PHASES = 15;
#ifndef PH_MASK
#define PH_MASK 0xFFFF
#endif
#ifndef DUP_MASK
#define DUP_MASK 0
#endif

__global__ void __launch_bounds__(512, 2) fwd_megakernel(KArgs ka) {
    extern __shared__ __attribute__((aligned(16))) unsigned char lds_raw[];
    LAS unsigned char* lds = (LAS unsigned char*)lds_raw;
    const Params& p = ka.p;
    const int bid = blockIdx.x, nblk = gridDim.x;
    unsigned char* ws = p.ws;
    const int lo = p.ph_lo, hi = p.ph_hi;
    if (threadIdx.x < 4) ((LAS unsigned*)(lds + LDS_ST_OFF))[threadIdx.x] = 0u;
    __syncthreads();
    if (hi > 1000) cg::this_grid().sync();
    XcdBarrier xbar = xcd_barrier_post((unsigned*)(ws + WS_BAR), (volatile LAS unsigned*)(lds + LDS_ST_OFF));
#define IN(k) ((PH_MASK & (1 << (k))) && lo <= (k) && (k) < hi)
#define SEAM(k) do { if (lo <= (k) && (k) + 1 < hi) xcd_barrier(xbar); } while (0)
    if (IN(0)) for (int rep = 0; rep <= ((DUP_MASK >> 0) & 1); ++rep) {
            bf16_t* aada = (bf16_t*)(ws + WS_AADA);
            for (int idx = bid * 512 + threadIdx.x; idx < 256 * 2048; idx += nblk * 512) { const int row = idx >> 11, col = idx & 2047;
                const float v = row < 4 ? siluf_(p.in[2][row * 2048 + col]) : (row < NB ? siluf_(p.in[3][(row - 4) * 2048 + col]) : 0.f); aada[idx] = f2bf(v); }
            transpose_jobs(ka.jobs, 1, bid, nblk, lds);
        }
    SEAM(0);
    if (IN(1)) for (int rep = 0; rep <= ((DUP_MASK >> 1) & 1); ++rep) {
            if (bid < 48) { pg8::Gemm g{(const bf16_t*)(ws + WS_AADA), (const bf16_t*)(ws + WS_PROJ), 2048, 2048, 2048, 0, 0, 0, 0, 0}; pg8::OneUnitOrder S{48, bid, 32}; pg8::EpiAda E{(float*)(ws + WS_MOD), p.in[8]}; pg8::gemm_phase(lds, g, S, E); }
            else { transpose_jobs(ka.jobs + 1, 1, bid - 48, nblk - 48, lds); transpose_jobs(ka.jobs + 4, 7, bid - 48, nblk - 48, lds); }
        }
    SEAM(1);
    if (IN(2)) for (int rep = 0; rep <= ((DUP_MASK >> 2) & 1); ++rep) norm_phase<0>(p, bid, nblk);
    SEAM(2);
    if (IN(3)) for (int rep = 0; rep <= ((DUP_MASK >> 3) & 1); ++rep) { pg8::Gemm g{(const bf16_t*)(ws + WS_U), (const bf16_t*)(ws + WS_WIN), 2048, 2048, 2048, 0, 0, 0, 0, 0}; pg8::StaticOrder S; S.init(TT, NPROJ, 2048, nblk, bid); pg8::EpiBf16 E{(bf16_t*)(ws + WS_PROJ), NPROJ, 0, nullptr}; pg8::gemm_phase(lds, g, S, E); }
    SEAM(3);
    if (IN(4)) for (int rep = 0; rep <= ((DUP_MASK >> 4) & 1); ++rep) mixer_prep_phase(p, bid, nblk);
    SEAM(4);
    if (IN(5)) for (int rep = 0; rep <= ((DUP_MASK >> 5) & 1); ++rep) chunk_prep_phase(p, bid, nblk, lds);
    SEAM(5);
    if (IN(6)) for (int rep = 0; rep <= ((DUP_MASK >> 6) & 1); ++rep) scan_phase(p, bid, nblk, lds);
    SEAM(6);
    if (IN(7)) for (int rep = 0; rep <= ((DUP_MASK >> 7) & 1); ++rep) { onorm_phase(p, bid, nblk);
            pg8::Gemm g{(const bf16_t*)(ws + WS_YP), (const bf16_t*)(ws + WS_PW), 1024, 256, 256, 512, 0, 0, 0, 0}; pg8::StaticOrder S; S.init(TT, 1024, 256, nblk, bid); pg8::EpiBf16 E{(bf16_t*)(ws + WS_U), DM, 1024, p.in[16]}; pg8::gemm_phase(lds, g, S, E);
            if (rep == 0) { if (nblk <= 136) transpose_jobs(ka.jobs + 3, 1, bid, nblk, lds); else if (bid >= 136) transpose_jobs(ka.jobs + 3, 1, bid - 136, nblk - 136, lds); } }
    SEAM(7);
    if (IN(8)) for (int rep = 0; rep <= ((DUP_MASK >> 8) & 1); ++rep) {
            pg8::Gemm g{(const bf16_t*)(ws + WS_U), (const bf16_t*)(ws + WS_WAB), 2048, 2048, 1024, 0, 2048, 2048, (size_t)128 * 2048 * 2, (size_t)128 * 2048 * 2}; pg8::StaticOrder S; S.init(68 * 256, 16 * 256, 1024, nblk, bid);
            pg8::EpiDiag E{(bf16_t*)(ws + WS_QN), (const bf16_t*)(ws + WS_PROJ)}; pg8::gemm_phase(lds, g, S, E);
            if (rep == 0) { const int nfull = 1088 % nblk; if (nfull == 0 || nfull >= nblk) transpose_jobs(ka.jobs + 2, 1, bid, nblk, lds); else if (bid >= nfull) transpose_jobs(ka.jobs + 2, 1, bid - nfull, nblk - nfull, lds); } }
    SEAM(9);
    if (IN(10)) for (int rep = 0; rep <= ((DUP_MASK >> 10) & 1); ++rep) { pg8::Gemm g{(const bf16_t*)(ws + WS_QN), (const bf16_t*)(ws + WS_WO), 2048, 2048, 2048, 0, 0, 0, 0, 0}; pg8::SplitOrder S{nblk, bid, 32, 4, 8}; pg8::EpiRes E{p.out + O_Y, p.in[0], p.in[1], (const float*)(ws + WS_MOD) + 4096, (float*)(ws + WS_PB10)}; pg8::gemm_phase(lds, g, S, E); }
    SEAM(10);
    if (IN(11)) for (int rep = 0; rep <= ((DUP_MASK >> 11) & 1); ++rep) norm_phase<1>(p, bid, nblk);
    SEAM(11);
    if (IN(12)) for (int rep = 0; rep <= ((DUP_MASK >> 12) & 1); ++rep) { pg8::Gemm g{(const bf16_t*)(ws + WS_U), (const bf16_t*)(ws + WS_WGU), 2048, 2048, 2048, 0, 0, 0, 0, 0}; pg8::StaticOrder S; S.init(TT, 11264, 2048, nblk, bid); pg8::EpiGU E{(bf16_t*)(ws + WS_PROJ)}; pg8::gemm_phase(lds, g, S, E); }
    SEAM(12);
    if (IN(13)) for (int rep = 0; rep <= ((DUP_MASK >> 13) & 1); ++rep) { pg8::Gemm g{(const bf16_t*)(ws + WS_PROJ), (const bf16_t*)(ws + WS_WD), DFF, DFF, DFF, 0, 0, 0, 0, 0}; pg8::SplitOrder S{nblk, bid, 88, 8, 11}; pg8::EpiRes E{p.out + O_Y, p.out + O_Y, p.out + O_Y + (size_t)TP * DM, (const float*)(ws + WS_MOD) + 10240, (float*)(ws + WS_PB13)}; pg8::gemm_phase(lds, g, S, E); }
    SEAM(13);
    if (IN(14)) for (int rep = 0; rep <= ((DUP_MASK >> 14) & 1); ++rep) norm_phase<2>(p, bid, nblk);
    SEAM(14);
}

extern "C" void kernel_launch(void* const* d_in, const int* in_sizes, int n_in, void* d_out, int out_size, void* d_ws, size_t ws_size, hipStream_t stream) {
    static int grid = 0;
    if (grid == 0) {
        if (n_in != 24 || ws_size < WS_BAR + XCD_BAR_WORDS * 4) { fprintf(stderr, "kernel_launch: unexpected n_in %d / ws_size %zu (need %zu)\n", n_in, ws_size, (size_t)WS_END); grid = -1; return; }
        int dev = 0, cus = 0, per_cu = 0;
        hipGetDevice(&dev); hipDeviceGetAttribute(&cus, hipDeviceAttributeMultiprocessorCount, dev);
        if (hipFuncSetAttribute((const void*)fwd_megakernel, hipFuncAttributeMaxDynamicSharedMemorySize, LDS_BYTES) != hipSuccess) { fprintf(stderr, "kernel_launch: hipFuncSetAttribute failed\n"); grid = -1; return; }
        if (hipOccupancyMaxActiveBlocksPerMultiprocessor(&per_cu, (const void*)fwd_megakernel, 512, LDS_BYTES) != hipSuccess || per_cu < 1) { fprintf(stderr, "kernel_launch: occupancy query says %d\n", per_cu); per_cu = 1; }
        (void)hipGetLastError();
        grid = cus > 0 ? cus : 256;
        if (grid < 64) grid = 64;
    }
    if (grid < 0) return;
    if (hipMemsetAsync((unsigned char*)d_ws + WS_BAR, 0, XCD_BAR_WORDS * 4, stream) != hipSuccess) { fprintf(stderr, "kernel_launch: memset failed\n"); return; }
    KArgs ka; memset(&ka, 0, sizeof(ka));
    for (int i = 0; i < 24; ++i) ka.p.in[i] = (const float*)d_in[i];
    ka.p.out = (float*)d_out; ka.p.ws = (unsigned char*)d_ws;
    unsigned char* ws = (unsigned char*)d_ws;
    auto setjob = [&](int i, const void* src, void* dst, int ld_src, int K, int Nout, int ld_dst, int map) { TJob& j = ka.jobs[i]; j.src = (const float*)src; j.dst = (bf16_t*)dst; j.ld_src = ld_src; j.K = K; j.Nout = Nout; j.ld_dst = ld_dst; j.map = map; j.pad = 0; };
    setjob(0, d_in[7], ws + WS_PROJ, MODW, 2048, MODW, 2048, 0);
    setjob(1, d_in[10], ws + WS_WIN, 9232, 2048, NPROJ, 2048, 1);
    setjob(2, d_in[21], ws + WS_WGU, 2 * DFF, 2048, 2 * DFF, 2048, 2);
    setjob(3, d_in[22], ws + WS_WD, 2048, DFF, 2048, DFF, 0);
    setjob(4, d_in[19], ws + WS_WO, 2048, 2048, 2048, 2048, 0);
    setjob(5, d_in[17], ws + WS_WAB, 2048, 1024, 2048, 2048, 0);
    setjob(6, d_in[18], ws + WS_WAB + 1024 * 2, 2048, 1024, 2048, 2048, 0);
    for (int g = 0; g < 4; ++g) setjob(7 + g, (const float*)d_in[15] + g * 65536, ws + WS_PW + (size_t)g * 65536 * 2, 256, 256, 256, 256, 0);
#if MK_PER_PHASE
    for (int ph = 0; ph < N_PHASES; ++ph) { ka.p.ph_lo = ph; ka.p.ph_hi = ph + 1; hipLaunchKernelGGL(fwd_megakernel, dim3(grid), dim3(512), LDS_BYTES, stream, ka); }
#else
    ka.p.ph_lo = 0; ka.p.ph_hi = N_PHASES;
    void* args[] = {&ka};
    hipError_t e = hipLaunchCooperativeKernel((const void*)fwd_megakernel, dim3(grid), dim3(512), args, LDS_BYTES, stream);
    if (e != hipSuccess) fprintf(stderr, "cooperative launch failed: %s (grid %d)\n", hipGetErrorString(e), grid);
#endif
}
```

```cpp
#include <hip/hip_runtime.h>
#include <hip/hip_cooperative_groups.h>
#include <cstdio>
#include <cstring>
namespace cg = cooperative_groups;

#ifndef MK_PER_PHASE
#define MK_PER_PHASE 0
#endif

#define LAS __attribute__((address_space(3)))
typedef unsigned short bf16_t;
typedef short bf16x8 __attribute__((ext_vector_type(8)));
typedef float f32x4 __attribute__((ext_vector_type(4)));
typedef float f32x2 __attribute__((ext_vector_type(2)));
typedef unsigned u32x4 __attribute__((ext_vector_type(4)));
typedef unsigned u32x2 __attribute__((ext_vector_type(2)));

constexpr int DM = 2048, TP = 8192, TS = 512, TT = 8704, NB = 132;
constexpr int NPROJ = 9472;
constexpr int DFF = 5632;
constexpr int MODW = 12288;
constexpr float EPS = 1e-6f;
constexpr int C_Q = 0, C_K = 1024, C_V = 2048, C_Z = 3072, C_XP = 4096, C_GA = 5120, C_GB = 7168, C_AB = 9216;
constexpr size_t O_Y = 0, O_DP = 17825792, O_CP = 18350080, O_PP = 18386944, O_DS = 18448384, O_CS = 35225600, O_PS = 36405248;
constexpr size_t OS_O = 0, OS_UB = 8912896;
constexpr size_t WS_WIN = 0;
constexpr size_t WS_WGU = WS_WIN + (size_t)NPROJ * 2048 * 2;
constexpr size_t WS_WD = WS_WGU + (size_t)11264 * 2048 * 2;
constexpr size_t WS_WO = WS_WD + (size_t)2048 * 5632 * 2;
constexpr size_t WS_WAB = WS_WO + (size_t)2048 * 2048 * 2;
constexpr size_t WS_PW = WS_WAB + (size_t)2048 * 2048 * 2;
constexpr size_t WS_AADA = WS_PW + (size_t)1024 * 256 * 2;
constexpr size_t WS_MOD = WS_AADA + (size_t)256 * 2048 * 2;
constexpr size_t WS_G = WS_MOD + (size_t)NB * MODW * 4;
constexpr size_t WS_BETA = WS_G + (size_t)TT * 8 * 4;
constexpr size_t WS_CD = WS_BETA + (size_t)TT * 8 * 4;
constexpr size_t WS_U = WS_CD + 4096;
constexpr size_t WS_QN = WS_U + (size_t)TT * 2048 * 2;
constexpr size_t WS_KN = WS_QN + (size_t)TT * 1024 * 2;
constexpr size_t WS_VV = WS_KN + (size_t)TT * 1024 * 2;
constexpr size_t WS_YP = WS_VV + (size_t)TT * 1024 * 2;
constexpr size_t WS_WDC = WS_YP + (size_t)TT * 1024 * 2;
constexpr size_t WS_QD = WS_WDC + (size_t)1024 * 64 * 128 * 2;
constexpr size_t WS_KT = WS_QD + (size_t)1024 * 64 * 128 * 2;
constexpr size_t WS_QK = WS_KT + (size_t)1024 * 64 * 128 * 2;
constexpr size_t WS_PROJ = WS_QK + (size_t)1024 * 64 * 64 * 2;
constexpr size_t WS_END = WS_PROJ + (size_t)TT * NPROJ * 2;
constexpr size_t WS_PB10 = WS_PROJ;
constexpr size_t WS_PB13 = WS_PROJ + (size_t)TT * DFF * 2;
static_assert(WS_PB13 + (size_t)11 * TS * DM * 4 <= WS_END && (WS_PB13 % 256) == 0, "partials");
static_assert(WS_END + 16384 <= 501510720ull, "workspace too large");
static_assert((WS_PROJ % 256) == 0 && (WS_QK % 256) == 0 && (WS_U % 256) == 0, "align");

constexpr int LDS_BYTES = 147456;

struct Params {
    const float* in[24];
    float* out;
    unsigned char* ws;
    int ph_lo, ph_hi;
};

__device__ __forceinline__ float bf2f(unsigned short x) { return __uint_as_float(((unsigned)x) << 16); }
__device__ __forceinline__ unsigned short f2bf(float f) { unsigned u = __float_as_uint(f); u += 0x7FFFu + ((u >> 16) & 1u); return (unsigned short)(u >> 16); }
typedef __bf16 bf16x2_hw __attribute__((ext_vector_type(2)));
__device__ __forceinline__ unsigned pk2(float lo, float hi) { const f32x2 v = {lo, hi}; const bf16x2_hw b = __builtin_convertvector(v, bf16x2_hw); return __builtin_bit_cast(unsigned, b); }
__device__ __forceinline__ void unpack8(const u32x4 w, float* f) {
    f[0] = __uint_as_float(w.x << 16); f[1] = __uint_as_float(w.x & 0xffff0000u);
    f[2] = __uint_as_float(w.y << 16); f[3] = __uint_as_float(w.y & 0xffff0000u);
    f[4] = __uint_as_float(w.z << 16); f[5] = __uint_as_float(w.z & 0xffff0000u);
    f[6] = __uint_as_float(w.w << 16); f[7] = __uint_as_float(w.w & 0xffff0000u);
}
__device__ __forceinline__ u32x4 pack8(const float* f) { u32x4 w; w.x = pk2(f[0], f[1]); w.y = pk2(f[2], f[3]); w.z = pk2(f[4], f[5]); w.w = pk2(f[6], f[7]); return w; }
__device__ __forceinline__ float sigmoidf_(float x) { return 1.0f / (1.0f + __expf(-x)); }
__device__ __forceinline__ float siluf_(float x) { return x / (1.0f + __expf(-x)); }
__device__ __forceinline__ int bidx_of_row(int row) { return row < TP ? (row >> 11) : 4 + ((row - TP) >> 2); }

namespace pg8 {
constexpr int BM = 256, BK = 64, HALF = 128, HTB = HALF * BK * 2, STAGE_BYTES = 8 * HTB, NXCD = 8, WGM = 8;
__host__ __device__ __forceinline__ int lds_byte(int r, int c) { const int st = (r >> 4) * 2 + (c >> 5), rr = r & 15, cc = c & 31, ob = rr * 64 + cc * 2; return st * 1024 + (ob ^ (((ob >> 9) & 1) << 5)); }
__host__ __device__ __forceinline__ void stage_rc(int b, int& R, int& C) { const int st = b / 1024, sb = b % 1024, swz = sb ^ (((sb >> 9) & 1) << 5); R = (st >> 1) * 16 + swz / 64; C = (st & 1) * 32 + (swz % 64) / 2; }
__host__ __device__ __forceinline__ int perm32(int rho) { const int n = rho >> 4, i = rho & 15; return 8 * (i >> 2) + 4 * n + (i & 3); }

struct Unit { int pm, pn, kt0, nkt, piece; };
struct Gemm { const bf16_t* A; const bf16_t* Bt; int lda, ldb, K; size_t a_pn_off; size_t a_half, b_half, a_tile, b_tile; };

__device__ __forceinline__ void tile_of(int wgid, int nM, int nN, Unit& u) {
    const int nwg = nM * nN;
    { const int q = nwg / NXCD, r = nwg % NXCD, xcd = wgid % NXCD, off = wgid / NXCD; wgid = (xcd < r ? xcd * (q + 1) : r * (q + 1) + (xcd - r) * q) + off; }
    const int nig = WGM * nN, gid = wgid / nig, fm = gid * WGM, gsz = (nM - fm) < WGM ? (nM - fm) : WGM;
    u.pm = fm + ((wgid % nig) % gsz); u.pn = (wgid % nig) / gsz;
}
struct StaticOrder {
    int nM, nN, nwg, G, c, ntk;
    __device__ __forceinline__ void init(int M, int N, int K, int G_, int c_) { nM = M / BM; nN = N / BM; nwg = nM * nN; G = G_; c = c_; ntk = K / BK; }
    __device__ __forceinline__ bool next(int i, Unit& u) const {
        const long L = (long)i * G + c; if (L >= nwg) return false;
        tile_of((int)L, nM, nN, u); u.kt0 = 0; u.nkt = ntk; u.piece = -1; return true;
    }
};
struct OneUnitOrder {
    int n, c, ntk;
    __device__ __forceinline__ bool next(int i, Unit& u) const { if (i != 0 || c >= n) return false; u.pm = 0; u.pn = c; u.kt0 = 0; u.nkt = ntk; u.piece = -1; return true; }
};
struct DoubleOrder {
    int G, c;
    __device__ __forceinline__ bool next(int i, Unit& u) const {
        const int L = (i >> 1) * G + c, half = i & 1; const bool ok = L < 272;
        tile_of(ok ? L : 0, 34, 8, u); u.kt0 = 16 * half; u.nkt = 16; u.piece = half; return ok;
    }
};
struct SplitOrder {
    int G, c, ntk, pk, npc;
    __device__ __forceinline__ bool next(int i, Unit& u) const {
        const int L = i * G + c;
        const bool full = L < 256;
        int fpm, fpn;
        { int wgid = full ? L : 0; const int xcd = wgid % NXCD, off = wgid / NXCD; wgid = xcd * 32 + off;
          const int nig = WGM * 8, gid = wgid / nig, fm = gid * WGM; fpm = fm + ((wgid % nig) % WGM); fpn = (wgid % nig) / WGM; }
        const int pidx = full ? 0 : L - 256, tile = pidx / npc, pc = pidx - tile * npc;
        u.pm = full ? fpm : 32 + (tile >> 3); u.pn = full ? fpn : (tile & 7); u.kt0 = full ? 0 : pc * pk; u.nkt = full ? ntk : pk; u.piece = full ? -1 : pc;
        return full || pidx < 16 * npc;
    }
};

template <class Epi, class Sched>
__device__ __forceinline__ void gemm_phase(LAS unsigned char* lds, const Gemm g, const Sched& S, const Epi& E) {
    const int tid = threadIdx.x, wid = __builtin_amdgcn_readfirstlane(tid >> 6), lane = tid & 63, wr = wid >> 2, wc = wid & 3, fr = lane & 15, fq = lane >> 4;
    unsigned voffA[2], voffB[2];
#pragma unroll
    for (int i = 0; i < 2; ++i) { int R, C; stage_rc(tid * 16 + i * 8192, R, C); const int Rb = Epi::PERM ? ((R & ~31) + perm32(R & 31)) : R;
        voffA[i] = (unsigned)(R * g.lda + C) * 2u; voffB[i] = (unsigned)(Rb * g.ldb + C) * 2u; }
    const size_t kstep = (size_t)(BK * 2);
    const size_t hstepA = g.a_half ? g.a_half : (size_t)HALF * g.lda * 2, hstepB = g.b_half ? g.b_half : (size_t)HALF * g.ldb * 2;
    const size_t tstepA = g.a_tile ? g.a_tile : (size_t)BM * g.lda * 2, tstepB = g.b_tile ? g.b_tile : (size_t)BM * g.ldb * 2;
    const unsigned ldsw = (unsigned)wid * 1024u;
    const int aoff = lds_byte(wr * 64 + fr, fq * 8), boff = lds_byte(wc * 32 + fr, fq * 8);
#define PG8_SA(b, h) (((b) * 2 + (h)) * HTB)
#define PG8_SB(b, h) ((4 + (b) * 2 + (h)) * HTB)
#define PG8_STAGE(bufoff, gbase, voff) do { _Pragma("unroll") for (int _i = 0; _i < 2; ++_i) \
        __builtin_amdgcn_global_load_lds((const unsigned*)((const char*)(gbase) + (voff)[_i]), (LAS unsigned*)(lds + (bufoff) + ldsw + _i * 8192), 16, 0, 0); } while (0)
#define PG8_LDA(dst, b, h) do { _Pragma("unroll") for (int m = 0; m < 4; ++m) _Pragma("unroll") for (int k = 0; k < 2; ++k) dst[m][k] = *(const LAS bf16x8*)(lds + PG8_SA(b, h) + aoff + m * 2048 + k * 1024); } while (0)
#define PG8_LDB(dst, b, h) do { _Pragma("unroll") for (int n = 0; n < 2; ++n) _Pragma("unroll") for (int k = 0; k < 2; ++k) dst[n][k] = *(const LAS bf16x8*)(lds + PG8_SB(b, h) + boff + n * 2048 + k * 1024); } while (0)
#define PG8_MMA(ai, bj, At, Bt) do { __builtin_amdgcn_s_setprio(1); _Pragma("unroll") for (int m = 0; m < 4; ++m) _Pragma("unroll") for (int n = 0; n < 2; ++n) _Pragma("unroll") for (int k = 0; k < 2; ++k) \
        acc[ai][bj][m][n] = __builtin_amdgcn_mfma_f32_16x16x32_bf16(Bt[n][k], At[m][k], acc[ai][bj][m][n], 0, 0, 0); __builtin_amdgcn_s_setprio(0); } while (0)
#define PG8_WAIT_V(n) asm volatile("s_waitcnt vmcnt(" #n ")" ::: "memory")
#define PG8_WAIT_L(n) asm volatile("s_waitcnt lgkmcnt(" #n ")" ::: "memory")
#define PG8_BAR __builtin_amdgcn_s_barrier()
#define PG8_SCHED __builtin_amdgcn_sched_barrier(0)
    Unit cur, nxt; int ui = 0;
    if (!S.next(0, cur)) return;
    f32x4 acc[2][2][4][2];
#pragma unroll
    for (int a = 0; a < 2; ++a)
#pragma unroll
        for (int b = 0; b < 2; ++b)
#pragma unroll
            for (int m = 0; m < 4; ++m)
#pragma unroll
                for (int n = 0; n < 2; ++n) acc[a][b][m][n] = (f32x4){0.f, 0.f, 0.f, 0.f};
    bf16x8 At[4][2], B0[2][2], B1[2][2];
    const char* cA = (const char*)g.A + (size_t)cur.pm * tstepA + (size_t)cur.pn * g.a_pn_off + (size_t)cur.kt0 * kstep; const char* cB = (const char*)g.Bt + (size_t)cur.pn * tstepB + (size_t)cur.kt0 * kstep;
    PG8_STAGE(PG8_SB(0, 0), cB, voffB); PG8_STAGE(PG8_SA(0, 0), cA, voffA); PG8_STAGE(PG8_SB(0, 1), cB + hstepB, voffB); PG8_STAGE(PG8_SA(0, 1), cA + hstepA, voffA);
    if (wr == 1) PG8_BAR;
    PG8_WAIT_V(4); PG8_BAR;
    PG8_STAGE(PG8_SB(1, 0), cB + kstep, voffB); PG8_STAGE(PG8_SA(1, 0), cA + kstep, voffA); PG8_STAGE(PG8_SB(1, 1), cB + hstepB + kstep, voffB);
    PG8_WAIT_V(6); PG8_BAR;
    for (;;) {
        const bool has_next = S.next(ui + 1, nxt);
        const char* nA = has_next ? (const char*)g.A + (size_t)nxt.pm * tstepA + (size_t)nxt.pn * g.a_pn_off + (size_t)nxt.kt0 * kstep : cA; const char* nB = has_next ? (const char*)g.Bt + (size_t)nxt.pn * tstepB + (size_t)nxt.kt0 * kstep : cB;
        const int nt = cur.nkt;
#pragma unroll 1
        for (int t = 0; t < nt; t += 2) {
            const bool last = (t == nt - 2);
            const char* a1 = cA + (size_t)(t + 1) * kstep;
            const char* a2 = last ? nA : cA + (size_t)(t + 2) * kstep; const char* b2 = last ? nB : cB + (size_t)(t + 2) * kstep;
            const char* a3 = a2 + kstep; const char* b3 = b2 + kstep;
            PG8_LDB(B0, 0, 0); PG8_SCHED; PG8_LDA(At, 0, 0); PG8_STAGE(PG8_SA(1, 1), a1 + hstepA, voffA);
            PG8_WAIT_L(8); PG8_BAR; PG8_WAIT_L(0); PG8_MMA(0, 0, At, B0); PG8_BAR; PG8_SCHED;
            PG8_LDB(B1, 0, 1); PG8_STAGE(PG8_SB(0, 0), b2, voffB);
            PG8_BAR; PG8_WAIT_L(0); if constexpr (!Epi::DIAG) PG8_MMA(0, 1, At, B1); PG8_BAR;
            PG8_LDA(At, 0, 1); PG8_STAGE(PG8_SA(0, 0), a2, voffA);
            PG8_BAR; PG8_WAIT_L(0); if constexpr (!Epi::DIAG) PG8_MMA(1, 0, At, B0); PG8_BAR; PG8_SCHED;
            PG8_STAGE(PG8_SB(0, 1), b2 + hstepB, voffB);
            PG8_WAIT_V(6); PG8_BAR; PG8_MMA(1, 1, At, B1); PG8_BAR;
            PG8_LDB(B0, 1, 0); PG8_SCHED; PG8_LDA(At, 1, 0); PG8_STAGE(PG8_SA(0, 1), a2 + hstepA, voffA);
            PG8_WAIT_L(8); PG8_BAR; PG8_WAIT_L(0); PG8_MMA(0, 0, At, B0); PG8_BAR; PG8_SCHED;
            PG8_LDB(B1, 1, 1); PG8_STAGE(PG8_SB(1, 0), b3, voffB);
            PG8_BAR; PG8_WAIT_L(0); if constexpr (!Epi::DIAG) PG8_MMA(0, 1, At, B1); PG8_BAR;
            PG8_LDA(At, 1, 1); PG8_STAGE(PG8_SA(1, 0), a3, voffA);
            PG8_BAR; PG8_WAIT_L(0); if constexpr (!Epi::DIAG) PG8_MMA(1, 0, At, B0); PG8_BAR; PG8_SCHED;
            PG8_STAGE(PG8_SB(1, 1), b3 + hstepB, voffB);
            PG8_WAIT_V(6); PG8_BAR; PG8_MMA(1, 1, At, B1); PG8_BAR;
        }
        E(acc, cur, wr, wc, fr, fq);
        if (!has_next) break;
#pragma unroll
        for (int a = 0; a < 2; ++a)
#pragma unroll
            for (int b = 0; b < 2; ++b)
#pragma unroll
                for (int m = 0; m < 4; ++m)
#pragma unroll
                    for (int n = 0; n < 2; ++n) acc[a][b][m][n] = (f32x4){0.f, 0.f, 0.f, 0.f};
        cur = nxt; cA = nA; cB = nB; ++ui;
    }
    PG8_WAIT_V(0);
    if (wr == 0) PG8_BAR;
    PG8_BAR;
#undef PG8_SA
#undef PG8_SB
#undef PG8_STAGE
#undef PG8_LDA
#undef PG8_LDB
#undef PG8_MMA
#undef PG8_WAIT_V
#undef PG8_WAIT_L
#undef PG8_BAR
#undef PG8_SCHED
}

typedef f32x4 Acc[2][2][4][2];

struct EpiAda {
    static constexpr bool PERM = false, MID = false, DIAG = false;
    float* C; const float* bias;
    __device__ __forceinline__ void operator()(const Acc& acc, const Unit& u, int wr, int wc, int fr, int fq) const {
        const int row0 = wr * 64 + fr, col0 = u.pn * BM + wc * 32 + 4 * fq;
#pragma unroll
        for (int ai = 0; ai < 2; ++ai)
#pragma unroll
            for (int m = 0; m < 4; ++m) { const int row = row0 + ai * HALF + m * 16; if (row < NB) {
#pragma unroll
                for (int bj = 0; bj < 2; ++bj)
#pragma unroll
                    for (int n = 0; n < 2; ++n) { const int c = col0 + bj * HALF + n * 16; *(f32x4*)(C + (size_t)row * MODW + c) = acc[ai][bj][m][n] + *(const f32x4*)(bias + c); } } }
    }
};
struct EpiBf16 {
    static constexpr bool PERM = true, MID = false, DIAG = false;
    bf16_t* O; int ldc; int col_off; const float* scale;
    __device__ __forceinline__ void operator()(const Acc& acc, const Unit& u, int wr, int wc, int fr, int fq) const {
        const int row0 = u.pm * BM + wr * 64 + fr, col0 = u.pn * BM + wc * 32 + 8 * fq;
#pragma unroll
        for (int ai = 0; ai < 2; ++ai)
#pragma unroll
            for (int m = 0; m < 4; ++m) { bf16_t* rowp = O + (size_t)(row0 + ai * HALF + m * 16) * ldc + col_off + col0;
#pragma unroll
                for (int bj = 0; bj < 2; ++bj) { f32x4 v0 = acc[ai][bj][m][0], v1 = acc[ai][bj][m][1];
                    if (scale) { v0 *= *(const f32x4*)(scale + col0 + bj * HALF); v1 *= *(const f32x4*)(scale + col0 + bj * HALF + 4); }
                    u32x4 w; w.x = pk2(v0[0], v0[1]); w.y = pk2(v0[2], v0[3]); w.z = pk2(v1[0], v1[1]); w.w = pk2(v1[2], v1[3]);
                    *(u32x4*)(rowp + bj * HALF) = w; }
                if (scale) asm volatile("" ::: "memory"); }
    }
};
struct EpiG1 {
    static constexpr bool PERM = true, MID = false, DIAG = false;
    float* T1; const bf16_t* proj;
    __device__ __forceinline__ void operator()(const Acc& acc, const Unit& u, int wr, int wc, int fr, int fq) const {
        const int row0 = u.pm * BM + wr * 64 + fr, col0 = u.pn * BM + wc * 32 + 8 * fq;
#pragma unroll
        for (int ai = 0; ai < 2; ++ai)
#pragma unroll
            for (int m = 0; m < 4; ++m) { const size_t row = (size_t)(row0 + ai * HALF + m * 16); const bf16_t* pr = proj + row * NPROJ + col0;
#pragma unroll
                for (int bj = 0; bj < 2; ++bj) { float ga[8]; unpack8(*(const u32x4*)(pr + C_GA + bj * HALF), ga); f32x4 v0, v1;
#pragma unroll
                    for (int j = 0; j < 4; ++j) { v0[j] = acc[ai][bj][m][0][j] * __builtin_amdgcn_rcpf(1.0f + __expf(-ga[j])); v1[j] = acc[ai][bj][m][1][j] * __builtin_amdgcn_rcpf(1.0f + __expf(-ga[4 + j])); }
                    float* o = T1 + row * DM + col0 + bj * HALF; *(f32x4*)o = v0; *(f32x4*)(o + 4) = v1; }
                }
    }
};
struct EpiG2 {
    static constexpr bool PERM = true, MID = false, DIAG = false;
    bf16_t* O; const float* T1; const bf16_t* proj;
    __device__ __forceinline__ void operator()(const Acc& acc, const Unit& u, int wr, int wc, int fr, int fq) const {
        const int row0 = u.pm * BM + wr * 64 + fr, col0 = u.pn * BM + wc * 32 + 8 * fq;
#pragma unroll
        for (int ai = 0; ai < 2; ++ai)
#pragma unroll
            for (int m = 0; m < 4; ++m) { const size_t row = (size_t)(row0 + ai * HALF + m * 16); const bf16_t* pr = proj + row * NPROJ + col0;
#pragma unroll
                for (int bj = 0; bj < 2; ++bj) { float gb[8], v[8]; unpack8(*(const u32x4*)(pr + C_GB + bj * HALF), gb);
                    const float* t = T1 + row * DM + col0 + bj * HALF; const f32x4 t0 = *(const f32x4*)t, t1 = *(const f32x4*)(t + 4);
#pragma unroll
                    for (int j = 0; j < 4; ++j) { v[j] = t0[j] + acc[ai][bj][m][0][j] * __builtin_amdgcn_rcpf(1.0f + __expf(-gb[j])); v[4 + j] = t1[j] + acc[ai][bj][m][1][j] * __builtin_amdgcn_rcpf(1.0f + __expf(-gb[4 + j])); }
                    *(u32x4*)(O + row * DM + col0 + bj * HALF) = pack8(v); }
                if (m & 1) asm volatile("" ::: "memory"); }
    }
};
struct EpiG12 {
    static constexpr bool PERM = true, MID = false, DIAG = false;
    EpiG1 e1; EpiG2 e2;
    __device__ __forceinline__ void operator()(const Acc& acc, const Unit& u, int wr, int wc, int fr, int fq) const { if (u.piece == 0) e1(acc, u, wr, wc, fr, fq); else e2(acc, u, wr, wc, fr, fq); }
};
struct EpiDiag {
    static constexpr bool PERM = true, MID = false, DIAG = true;
    bf16_t* O; const bf16_t* proj;
    __device__ __forceinline__ void operator()(const Acc& acc, const Unit& u, int wr, int wc, int fr, int fq) const {
        const int row0 = u.pm * HALF + wr * 64 + fr, col0 = u.pn * HALF + wc * 32 + 8 * fq;
#pragma unroll
        for (int m = 0; m < 4; ++m) { const size_t row = (size_t)(row0 + m * 16); const bf16_t* pr = proj + row * NPROJ + col0;
            float ga[8], gb[8], v[8]; unpack8(*(const u32x4*)(pr + C_GA), ga); unpack8(*(const u32x4*)(pr + C_GB), gb);
#pragma unroll
            for (int n = 0; n < 2; ++n)
#pragma unroll
                for (int j = 0; j < 4; ++j) v[4 * n + j] = acc[0][0][m][n][j] * __builtin_amdgcn_rcpf(1.0f + __expf(-ga[4 * n + j])) + acc[1][1][m][n][j] * __builtin_amdgcn_rcpf(1.0f + __expf(-gb[4 * n + j]));
            *(u32x4*)(O + row * DM + col0) = pack8(v); }
    }
};
struct EpiRes {
    static constexpr bool PERM = false, MID = false, DIAG = false;
    float* X1; const float* x0p; const float* x0s; const float* gate; float* PB;
    __device__ __forceinline__ void operator()(const Acc& acc, const Unit& u, int wr, int wc, int fr, int fq) const {
        const int row0 = u.pm * BM + wr * 64 + fr, col0 = u.pn * BM + wc * 32 + 4 * fq;
        if (u.piece >= 0) {
            float* pb = PB + (size_t)u.piece * TS * DM;
#pragma unroll
            for (int ai = 0; ai < 2; ++ai)
#pragma unroll
                for (int m = 0; m < 4; ++m) { float* orow = pb + (size_t)(row0 + ai * HALF + m * 16 - TP) * DM;
#pragma unroll
                    for (int bj = 0; bj < 2; ++bj)
#pragma unroll
                        for (int n = 0; n < 2; ++n) *(f32x4*)(orow + col0 + bj * HALF + n * 16) = acc[ai][bj][m][n]; }
            return;
        }
#pragma unroll
        for (int ai = 0; ai < 2; ++ai)
#pragma unroll
            for (int m = 0; m < 4; ++m) { const int row = row0 + ai * HALF + m * 16; const int b = bidx_of_row(row);
                const float* xr = (row < TP) ? x0p + (size_t)row * DM : x0s + (size_t)(row - TP) * DM; const float* gr = gate + (size_t)b * MODW; float* orow = X1 + (size_t)row * DM;
#pragma unroll
                for (int bj = 0; bj < 2; ++bj)
#pragma unroll
                    for (int n = 0; n < 2; ++n) { const int c = col0 + bj * HALF + n * 16; const f32x4 xv = *(const f32x4*)(xr + c), gv = *(const f32x4*)(gr + c);
                        *(f32x4*)(orow + c) = xv + gv * acc[ai][bj][m][n]; } }
    }
};
struct EpiGU {
    static constexpr bool PERM = true, MID = false, DIAG = false;
    bf16_t* O;
    __device__ __forceinline__ void operator()(const Acc& acc, const Unit& u, int wr, int wc, int fr, int fq) const {
        const int row0 = u.pm * BM + wr * 64 + fr, col0 = u.pn * HALF + wc * 32 + 8 * fq;
#pragma unroll
        for (int ai = 0; ai < 2; ++ai)
#pragma unroll
            for (int m = 0; m < 4; ++m) { float v[8];
#pragma unroll
                for (int n = 0; n < 2; ++n)
#pragma unroll
                    for (int j = 0; j < 4; ++j) { const float gt = acc[ai][0][m][n][j]; v[4 * n + j] = gt * __builtin_amdgcn_rcpf(1.0f + __expf(-gt)) * acc[ai][1][m][n][j]; }
                *(u32x4*)(O + (size_t)(row0 + ai * HALF + m * 16) * DFF + col0) = pack8(v); }
    }
};
}

struct TJob { const float* src; bf16_t* dst; int ld_src, K, Nout, ld_dst, map, pad; };
__device__ __forceinline__ int map_col(int map, int n) {
    if (map == 1) { if (n < 4096) return n; if (n < 5120) return 4112 + (n - 4096); if (n < 9216) return 5136 + (n - 5120); if (n < 9232) return 4096 + (n - 9216); return -1; }
    if (map == 2) { const int pn = n >> 8, w = n & 255; return w < 128 ? 128 * pn + w : DFF + 128 * pn + (w - 128); }
    return n;
}
__device__ __forceinline__ void tjob_load(const TJob& j, int tile, f32x4 (&v)[4]) {
    const int tid = threadIdx.x, nkt = j.K >> 7, tn = tile / nkt, tk = tile - tn * nkt;
    const int n = tn * 64 + (tid & 15) * 4, kr = tid >> 4, col = map_col(j.map, n);
#pragma unroll
    for (int i = 0; i < 4; ++i) v[i] = col >= 0 ? __builtin_nontemporal_load((const f32x4*)(j.src + (size_t)(tk * 128 + kr + 32 * i) * j.ld_src + col)) : (f32x4){0.f, 0.f, 0.f, 0.f};
}
__device__ __forceinline__ void tjob_store(const TJob& j, int tile, const f32x4 (&v)[4], LAS float* s) {
    const int tid = threadIdx.x, nkt = j.K >> 7, tn = tile / nkt, tk = tile - tn * nkt;
    const int nq = tid & 15, kr = tid >> 4;
    __syncthreads();
#pragma unroll
    for (int i = 0; i < 4; ++i)
#pragma unroll
        for (int q = 0; q < 4; ++q) s[(4 * nq + q) * 129 + kr + 32 * i] = v[i][q];
    __syncthreads();
    const int n = tid >> 3, k16 = (tid & 7) * 16;
    float f[16];
#pragma unroll
    for (int i = 0; i < 16; ++i) f[i] = s[n * 129 + k16 + i];
    bf16_t* d = j.dst + (size_t)(tn * 64 + n) * j.ld_dst + tk * 128 + k16;
    *(u32x4*)d = pack8(f); *(u32x4*)(d + 8) = pack8(f + 8);
}
__device__ __forceinline__ void transpose_jobs(const TJob* jobs, int njobs, int bi, int nblk, LAS unsigned char* lds) {
    LAS float* s = (LAS float*)lds;
    int total = 0;
    for (int q = 0; q < njobs; ++q) total += (jobs[q].Nout >> 6) * (jobs[q].K >> 7);
    f32x4 v[4]; int curj = 0, base = 0;
    int t = bi;
    auto locate = [&](int tt, int& jj, int& bb) { while (tt >= bb + (jobs[jj].Nout >> 6) * (jobs[jj].K >> 7)) { bb += (jobs[jj].Nout >> 6) * (jobs[jj].K >> 7); ++jj; } };
    if (t < total) { locate(t, curj, base); tjob_load(jobs[curj], t - base, v); }
    while (t < total) {
        const int tn = t + nblk; int nj = curj, nb = base; f32x4 w[4];
        if (tn < total) { locate(tn, nj, nb); tjob_load(jobs[nj], tn - nb, w); }
        tjob_store(jobs[curj], t - base, v, s);
        if (tn < total) {
#pragma unroll
            for (int i = 0; i < 4; ++i) v[i] = w[i]; }
        t = tn; curj = nj; base = nb;
    }
    __syncthreads();
}

template <int MODE>
__device__ __forceinline__ void norm_phase(const Params& p, int bid, int nblk) {
    const int lane = threadIdx.x & 63, wid = __builtin_amdgcn_readfirstlane(threadIdx.x >> 6);
    const float* mod = (const float*)(p.ws + WS_MOD);
    const float* gain = MODE == 0 ? p.in[9] : (MODE == 1 ? p.in[20] : p.in[23]);
    bf16_t* U = (bf16_t*)(p.ws + WS_U);
    for (int row = bid * 8 + wid; row < TT; row += nblk * 8) {
        const float* src = MODE == 0 ? (row < TP ? p.in[0] + (size_t)row * DM : p.in[1] + (size_t)(row - TP) * DM) : p.out + O_Y + (size_t)row * DM;
        if (MODE != 0 && row >= TP) {
            const float* xs = p.in[1] + (size_t)(row - TP) * DM;
            const float* pb = (const float*)(p.ws + (MODE == 1 ? WS_PB10 : WS_PB13)) + (size_t)(row - TP) * DM;
            const float* gt = mod + (size_t)bidx_of_row(row) * MODW + (MODE == 1 ? 4096 : 10240);
            float* xo = p.out + O_Y + (size_t)row * DM;
            constexpr int NPC = MODE == 1 ? 8 : 11;
#pragma unroll 1
            for (int i = 0; i < 8; ++i) { const int c = i * 256 + lane * 4; f32x4 s = *(const f32x4*)(pb + c);
#pragma unroll
                for (int q = 1; q < NPC; ++q) s += *(const f32x4*)(pb + (size_t)q * TS * DM + c);
                const f32x4 base = MODE == 1 ? *(const f32x4*)(xs + c) : *(const f32x4*)(xo + c);
                *(f32x4*)(xo + c) = base + *(const f32x4*)(gt + c) * s; }
            asm volatile("s_waitcnt vmcnt(0)" ::: "memory");
        }
        f32x4 v[8]; float ss = 0.f;
#pragma unroll
        for (int i = 0; i < 8; ++i) v[i] = *(const f32x4*)(src + i * 256 + lane * 4);
#pragma unroll
        for (int i = 0; i < 8; ++i) ss += v[i][0] * v[i][0] + v[i][1] * v[i][1] + v[i][2] * v[i][2] + v[i][3] * v[i][3];
#pragma unroll
        for (int o = 32; o >= 1; o >>= 1) ss += __shfl_xor(ss, o);
        const float rstd = rsqrtf(ss * (1.0f / DM) + EPS);
        if (MODE == 2) {
            float* dst = p.out + O_Y + (size_t)row * DM;
#pragma unroll
            for (int i = 0; i < 8; ++i) { const f32x4 g = *(const f32x4*)(gain + i * 256 + lane * 4); *(f32x4*)(dst + i * 256 + lane * 4) = v[i] * rstd * g; }
        } else {
            const float* sh = mod + (size_t)bidx_of_row(row) * MODW + (MODE == 0 ? 0 : 6144); const float* sc = sh + 2048;
#pragma unroll
            for (int i = 0; i < 8; ++i) { const int c = i * 256 + lane * 4; const f32x4 g = *(const f32x4*)(gain + c), s1 = *(const f32x4*)(sc + c), s0 = *(const f32x4*)(sh + c);
                const f32x4 y = (v[i] * rstd * g) * (1.0f + s1) + s0; u32x2 w; w.x = pk2(y[0], y[1]); w.y = pk2(y[2], y[3]); *(u32x2*)(U + (size_t)row * DM + c) = w; }
        }
    }
}

template <int NTOK, bool SMP>
__device__ __forceinline__ void mixer_item(const Params& p, int it) {
    const int tid = threadIdx.x;
    const bf16_t* proj = (const bf16_t*)(p.ws + WS_PROJ);
    bf16_t* qn = (bf16_t*)(p.ws + WS_QN); bf16_t* kn = (bf16_t*)(p.ws + WS_KN); bf16_t* vv = (bf16_t*)(p.ws + WS_VV); bf16_t* yp = (bf16_t*)(p.ws + WS_YP);
    float* gbuf = (float*)(p.ws + WS_G); float* bbuf = (float*)(p.ws + WS_BETA);
    const int sb = it - 512;
    const int b = SMP ? 0 : (it >> 7), t0 = SMP ? 0 : (it & 127) * 16;
    const int rowbase = SMP ? TP + sb * 4 : b * 2048 + t0;
    if (tid < 384) {
        const int c0 = tid * 8;
        float w0[8], w1[8], w2[8], w3[8], xm3[8], xm2[8], xm1[8];
        const float* cw = p.in[11];
#pragma unroll
        for (int i = 0; i < 8; ++i) { w0[i] = cw[c0 + i]; w1[i] = cw[3072 + c0 + i]; w2[i] = cw[6144 + c0 + i]; w3[i] = cw[9216 + c0 + i]; }
        if (SMP) { const float* sc = p.in[5] + (size_t)sb * 3 * 3072 + c0;
#pragma unroll
            for (int i = 0; i < 8; ++i) { xm3[i] = sc[i]; xm2[i] = sc[3072 + i]; xm1[i] = sc[6144 + i]; }
        } else if (t0 == 0) {
#pragma unroll
            for (int i = 0; i < 8; ++i) { xm3[i] = 0.f; xm2[i] = 0.f; xm1[i] = 0.f; }
        } else {
            unpack8(*(const u32x4*)(proj + (size_t)(rowbase - 3) * NPROJ + c0), xm3); unpack8(*(const u32x4*)(proj + (size_t)(rowbase - 2) * NPROJ + c0), xm2); unpack8(*(const u32x4*)(proj + (size_t)(rowbase - 1) * NPROJ + c0), xm1);
        }
        constexpr int CH = NTOK < 8 ? NTOK : 8;
#pragma unroll
        for (int tc = 0; tc < NTOK; tc += CH) {
        u32x4 xr[CH];
#pragma unroll
        for (int t = 0; t < CH; ++t) xr[t] = *(const u32x4*)(proj + (size_t)(rowbase + tc + t) * NPROJ + c0);
#pragma unroll
        for (int t2 = 0; t2 < CH; ++t2) {
            const int t = tc + t2;
            const int row = rowbase + t; float xt[8], y[8];
            unpack8(xr[t2], xt);
            float ss = 0.f;
#pragma unroll
            for (int i = 0; i < 8; ++i) { const float a = w0[i] * xm3[i] + w1[i] * xm2[i] + w2[i] * xm1[i] + w3[i] * xt[i]; y[i] = siluf_(a); ss += y[i] * y[i]; }
            if (c0 < 2048) {
                ss += __shfl_xor(ss, 1); ss += __shfl_xor(ss, 2); ss += __shfl_xor(ss, 4); ss += __shfl_xor(ss, 8);
                const float inv = rsqrtf(ss + EPS);
#pragma unroll
                for (int i = 0; i < 8; ++i) y[i] *= inv;
            }
            bf16_t* dst = c0 < 1024 ? qn + (size_t)row * 1024 + c0 : (c0 < 2048 ? kn + (size_t)row * 1024 + (c0 - 1024) : vv + (size_t)row * 1024 + (c0 - 2048));
            *(u32x4*)dst = pack8(y);
            if (SMP) { if (t >= 1) { float* o = p.out + O_CS + ((size_t)sb * 3 + (t - 1)) * 3072 + c0; *(f32x4*)o = (f32x4){xt[0], xt[1], xt[2], xt[3]}; *(f32x4*)(o + 4) = (f32x4){xt[4], xt[5], xt[6], xt[7]}; } }
            else if (t0 + t >= 2045) { float* o = p.out + O_CP + ((size_t)b * 3 + (t0 + t - 2045)) * 3072 + c0; *(f32x4*)o = (f32x4){xt[0], xt[1], xt[2], xt[3]}; *(f32x4*)(o + 4) = (f32x4){xt[4], xt[5], xt[6], xt[7]}; }
#pragma unroll
            for (int i = 0; i < 8; ++i) { xm3[i] = xm2[i]; xm2[i] = xm1[i]; xm1[i] = xt[i]; }
        }
        }
    } else {
        const int pc = (tid - 384) * 8, gi = pc >> 8, w = 2 << gi;
        const int seqrow0 = SMP ? TP + sb * 4 : b * 2048;
        const float* sp = p.in[6] + (size_t)sb * 15 * 1024 + pc;
        auto xpool = [&](int tt, float* f) {
            if (tt >= 0) unpack8(*(const u32x4*)(proj + (size_t)(seqrow0 + tt) * NPROJ + C_XP + pc), f);
            else if (SMP) { const float* s = sp + (size_t)(15 + tt) * 1024;
#pragma unroll
                for (int i = 0; i < 8; ++i) f[i] = s[i]; }
            else {
#pragma unroll
                for (int i = 0; i < 8; ++i) f[i] = 0.f; }
        };
        float s[8];
#pragma unroll
        for (int i = 0; i < 8; ++i) s[i] = 0.f;
#pragma unroll
        for (int q = 1; q < 16; ++q) if (q < w) { float f[8]; xpool(t0 - q, f);
#pragma unroll
            for (int i = 0; i < 8; ++i) s[i] += f[i]; }
#pragma unroll 4
        for (int t = 0; t < NTOK; ++t) {
            const int tt = t0 + t; float x[8], y[8], f[8];
            xpool(tt, x);
            const float cnt = SMP ? (float)w : (float)min(w, tt + 1); const float ic = 1.0f / cnt;
#pragma unroll
            for (int i = 0; i < 8; ++i) { s[i] += x[i]; y[i] = s[i] * ic - x[i]; }
            *(u32x4*)(yp + (size_t)(seqrow0 + tt) * 1024 + pc) = pack8(y);
            xpool(tt - w + 1, f);
#pragma unroll
            for (int i = 0; i < 8; ++i) s[i] -= f[i];
            if (SMP) { float* o = p.out + O_PS + ((size_t)sb * 15 + 11 + t) * 1024 + pc; *(f32x4*)o = (f32x4){x[0], x[1], x[2], x[3]}; *(f32x4*)(o + 4) = (f32x4){x[4], x[5], x[6], x[7]}; }
            else if (tt >= 2033) { float* o = p.out + O_PP + ((size_t)b * 15 + (tt - 2033)) * 1024 + pc; *(f32x4*)o = (f32x4){x[0], x[1], x[2], x[3]}; *(f32x4*)(o + 4) = (f32x4){x[4], x[5], x[6], x[7]}; }
        }
        if (SMP) {
#pragma unroll
            for (int r = 0; r < 11; ++r) { const float* s2 = sp + (size_t)(4 + r) * 1024; float* o = p.out + O_PS + ((size_t)sb * 15 + r) * 1024 + pc; *(f32x4*)o = *(const f32x4*)s2; *(f32x4*)(o + 4) = *(const f32x4*)(s2 + 4); } }
    }
    if (tid < 256) { const int tk = tid >> 4, jj = tid & 15;
        if (tk < NTOK) { const int row = rowbase + tk; const float val = bf2f(proj[(size_t)row * NPROJ + C_AB + jj]);
            if (jj < 8) { const float xx = val + p.in[13][jj]; const float spl = xx > 20.f ? xx : log1pf(__expf(xx)); gbuf[row * 8 + jj] = -__expf(p.in[12][jj]) * spl; }
            else bbuf[row * 8 + (jj - 8)] = sigmoidf_(val); } }
}
__device__ __forceinline__ void mixer_prep_phase(const Params& p, int bid, int nblk) {
    for (int it = bid; it < 640; it += nblk) { if (it >= 512) mixer_item<4, true>(p, it); else mixer_item<16, false>(p, it); }
}

constexpr int P5_QS = 0, P5_KS = 17408, P5_VS = 34816, P5_MM = 52224, P5_DEC = 68608, P5_BETA = 68864, P5_GRP = 69632;
static_assert(2 * P5_GRP <= LDS_BYTES - 16, "lds");
__device__ __forceinline__ void chunk_prep_phase(const Params& p, int bid, int nblk, LAS unsigned char* lds0) {
    const int tid = threadIdx.x, lane = tid & 63, grp = tid >> 8, lt = tid & 255, lw = __builtin_amdgcn_readfirstlane(tid >> 6) & 3;
    LAS unsigned char* lds = lds0 + grp * P5_GRP;
    const bf16_t* qn = (const bf16_t*)(p.ws + WS_QN); const bf16_t* kn = (const bf16_t*)(p.ws + WS_KN); const bf16_t* vv = (const bf16_t*)(p.ws + WS_VV);
    const float* gbuf = (const float*)(p.ws + WS_G); const float* bbuf = (const float*)(p.ws + WS_BETA);
    bf16_t* wdc = (bf16_t*)(p.ws + WS_WDC); bf16_t* qd = (bf16_t*)(p.ws + WS_QD); bf16_t* kt = (bf16_t*)(p.ws + WS_KT); bf16_t* qk = (bf16_t*)(p.ws + WS_QK);
    float* cdv = (float*)(p.ws + WS_CD); float* ub = p.out + OS_UB;
    LAS float* Mm = (LAS float*)(lds + P5_MM); LAS float* dec = (LAS float*)(lds + P5_DEC); LAS float* bet = (LAS float*)(lds + P5_BETA);
    const float scale = 0.08838834764831845f;
    for (int it0 = bid * 2; it0 < 1024; it0 += nblk * 2) {
        const int item = it0 + grp, n = item & 31, bh = item >> 5, h = bh & 7, b = bh >> 3;
        const int r0 = b * 2048 + n * 64;
        __syncthreads();
#pragma unroll
        for (int i = 0; i < 4; ++i) { const int ch = lt + 256 * i, r = ch >> 4, c8 = (ch & 15) * 8; const size_t go = (size_t)(r0 + r) * 1024 + h * 128 + c8; const int lo = r * 272 + c8 * 2;
            *(LAS u32x4*)(lds + P5_QS + lo) = *(const u32x4*)(qn + go); *(LAS u32x4*)(lds + P5_KS + lo) = *(const u32x4*)(kn + go); *(LAS u32x4*)(lds + P5_VS + lo) = *(const u32x4*)(vv + go); }
        if (lt < 64) {
            float g = gbuf[(r0 + lt) * 8 + h];
#pragma unroll
            for (int o = 1; o < 64; o <<= 1) { const float t = __shfl_up(g, o); if (lane >= o) g += t; }
            dec[lt] = g;
        } else if (lt < 128) bet[lt - 64] = bbuf[(r0 + lt - 64) * 8 + h];
        __syncthreads();
        {
            const int rt = lw, fr = lane & 15, fq = lane >> 4;
#pragma unroll
            for (int mat = 0; mat < 2; ++mat) {
                bf16x8 a[4];
#pragma unroll
                for (int kk = 0; kk < 4; ++kk) a[kk] = *(const LAS bf16x8*)(lds + (mat ? P5_QS : P5_KS) + (rt * 16 + fr) * 272 + (kk * 32 + fq * 8) * 2);
#pragma unroll
                for (int st = 0; st < 4; ++st) {
                    f32x4 d = (f32x4){0.f, 0.f, 0.f, 0.f};
#pragma unroll
                    for (int kk = 0; kk < 4; ++kk) { const bf16x8 bb = *(const LAS bf16x8*)(lds + P5_KS + (st * 16 + fr) * 272 + (kk * 32 + fq * 8) * 2); d = __builtin_amdgcn_mfma_f32_16x16x32_bf16(a[kk], bb, d, 0, 0, 0); }
                    const int s = st * 16 + fr; const float ds = dec[s];
#pragma unroll
                    for (int j = 0; j < 4; ++j) { const int r = rt * 16 + fq * 4 + j; const float dr = dec[r];
                        if (mat == 0) Mm[r * 64 + s] = (r > s) ? bet[r] * d[j] * __expf(dr - ds) : 0.f;
                        else qk[(size_t)item * 4096 + r * 64 + s] = f2bf((r >= s) ? scale * d[j] * __expf(dr - ds) : 0.f); }
                }
            }
        }
        __syncthreads();
        const int w8 = __builtin_amdgcn_readfirstlane(tid >> 6);
        if (w8 < 4) {
            const int g2 = w8 >> 1, c = (w8 & 1) * 64 + lane; const int item2 = it0 + g2;
            LAS unsigned char* lg = lds0 + g2 * P5_GRP; LAS float* Mg = (LAS float*)(lg + P5_MM); LAS float* decg = (LAS float*)(lg + P5_DEC); LAS float* betg = (LAS float*)(lg + P5_BETA);
            f32x2 xy[64]; f32x4 mq[6]; f32x2 ab0, ab1;
            float* up = ub + (size_t)item2 * 8192 + c; bf16_t* wp = wdc + (size_t)item2 * 8192 + c;
            { const float br = betg[0]; ab0 = (f32x2){bf2f(*(const LAS bf16_t*)(lg + P5_VS + 0 + c * 2)) * br, bf2f(*(const LAS bf16_t*)(lg + P5_KS + 0 + c * 2)) * br * __expf(decg[0])}; ab1 = (f32x2){0.f, 0.f}; } xy[0] = ab0; up[0] = xy[0][0]; wp[0] = f2bf(-xy[0][1]);
            mq[0] = *(const LAS f32x4*)(Mg + 64); mq[1] = *(const LAS f32x4*)(Mg + 128); mq[2] = *(const LAS f32x4*)(Mg + 192); mq[3] = *(const LAS f32x4*)(Mg + 256); mq[4] = *(const LAS f32x4*)(Mg + 320); mq[5] = *(const LAS f32x4*)(Mg + 324);
            { const float br = betg[1]; ab0 = (f32x2){bf2f(*(const LAS bf16_t*)(lg + P5_VS + 272 + c * 2)) * br, bf2f(*(const LAS bf16_t*)(lg + P5_KS + 272 + c * 2)) * br * __expf(decg[1])}; ab1 = (f32x2){0.f, 0.f}; } ab0 -= mq[0][0] * xy[0]; xy[1] = ab0 + ab1; up[128] = xy[1][0]; wp[128] = f2bf(-xy[1][1]); mq[0] = *(const LAS f32x4*)(Mg + 384);
            { const float br = betg[2]; ab0 = (f32x2){bf2f(*(const LAS bf16_t*)(lg + P5_VS + 544 + c * 2)) * br, bf2f(*(const LAS bf16_t*)(lg + P5_KS + 544 + c * 2)) * br * __expf(decg[2])}; ab1 = (f32x2){0.f, 0.f}; } ab0 -= mq[1][0] * xy[0]; ab1 -= mq[1][1] * xy[1]; xy[2] = ab0 + ab1; up[256] = xy[2][0]; wp[256] = f2bf(-xy[2][1]); mq[1] = *(const LAS f32x4*)(Mg + 388);
            { const float br = betg[3]; ab0 = (f32x2){bf2f(*(const LAS bf16_t*)(lg + P5_VS + 816 + c * 2)) * br, bf2f(*(const LAS bf16_t*)(lg + P5_KS + 816 + c * 2)) * br * __expf(decg[3])}; ab1 = (f32x2){0.f, 0.f}; } ab0 -= mq[2][0] * xy[0]; ab1 -= mq[2][1] * xy[1]; ab0 -= mq[2][2] * xy[2]; xy[3] = ab0 + ab1; up[384] = xy[3][0]; wp[384] = f2bf(-xy[3][1]); mq[2] = *(const LAS f32x4*)(Mg + 448);
            { const float br = betg[4]; ab0 = (f32x2){bf2f(*(const LAS bf16_t*)(lg + P5_VS + 1088 + c * 2)) * br, bf2f(*(const LAS bf16_t*)(lg + P5_KS + 1088 + c * 2)) * br * __expf(decg[4])}; ab1 = (f32x2){0.f, 0.f}; } ab0 -= mq[3][0] * xy[0]; ab1 -= mq[3][1] * xy[1]; ab0 -= mq[3][2] * xy[2]; ab1 -= mq[3][3] * xy[3]; xy[4] = ab0 + ab1; up[512] = xy[4][0]; wp[512] = f2bf(-xy[4][1]); mq[3] = *(const LAS f32x4*)(Mg + 452);
            { const float br = betg[5]; ab0 = (f32x2){bf2f(*(const LAS bf16_t*)(lg + P5_VS + 1360 + c * 2)) * br, bf2f(*(const LAS bf16_t*)(lg + P5_KS + 1360 + c * 2)) * br * __expf(decg[5])}; ab1 = (f32x2){0.f, 0.f}; } ab0 -= mq[4][0] * xy[0]; ab1 -= mq[4][1] * xy[1]; ab0 -= mq[4][2] * xy[2]; ab1 -= mq[4][3] * xy[3]; mq[4] = *(const LAS f32x4*)(Mg + 512);
            ab0 -= mq[5][0] * xy[4]; xy[5] = ab0 + ab1; up[640] = xy[5][0]; wp[640] = f2bf(-xy[5][1]); mq[5] = *(const LAS f32x4*)(Mg + 516);
            { const float br = betg[6]; ab0 = (f32x2){bf2f(*(const LAS bf16_t*)(lg + P5_VS + 1632 + c * 2)) * br, bf2f(*(const LAS bf16_t*)(lg + P5_KS + 1632 + c * 2)) * br * __expf(decg[6])}; ab1 = (f32x2){0.f, 0.f}; } ab0 -= mq[0][0] * xy[0]; ab1 -= mq[0][1] * xy[1]; ab0 -= mq[0][2] * xy[2]; ab1 -= mq[0][3] * xy[3]; mq[0] = *(const LAS f32x4*)(Mg + 576);
            ab0 -= mq[1][0] * xy[4]; ab1 -= mq[1][1] * xy[5]; xy[6] = ab0 + ab1; up[768] = xy[6][0]; wp[768] = f2bf(-xy[6][1]); mq[1] = *(const LAS f32x4*)(Mg + 580);
            { const float br = betg[7]; ab0 = (f32x2){bf2f(*(const LAS bf16_t*)(lg + P5_VS + 1904 + c * 2)) * br, bf2f(*(const LAS bf16_t*)(lg + P5_KS + 1904 + c * 2)) * br * __expf(decg[7])}; ab1 = (f32x2){0.f, 0.f}; } ab0 -= mq[2][0] * xy[0]; ab1 -= mq[2][1] * xy[1]; ab0 -= mq[2][2] * xy[2]; ab1 -= mq[2][3] * xy[3]; mq[2] = *(const LAS f32x4*)(Mg + 584);
            ab0 -= mq[3][0] * xy[4]; ab1 -= mq[3][1] * xy[5]; ab0 -= mq[3][2] * xy[6]; xy[7] = ab0 + ab1; up[896] = xy[7][0]; wp[896] = f2bf(-xy[7][1]); mq[3] = *(const LAS f32x4*)(Mg + 640);
            { const float br = betg[8]; ab0 = (f32x2){bf2f(*(const LAS bf16_t*)(lg + P5_VS + 2176 + c * 2)) * br, bf2f(*(const LAS bf16_t*)(lg + P5_KS + 2176 + c * 2)) * br * __expf(decg[8])}; ab1 = (f32x2){0.f, 0.f}; } ab0 -= mq[4][0] * xy[0]; ab1 -= mq[4][1] * xy[1]; ab0 -= mq[4][2] * xy[2]; ab1 -= mq[4][3] * xy[3]; mq[4] = *(const LAS f32x4*)(Mg + 644);
            ab0 -= mq[5][0] * xy[4]; ab1 -= mq[5][1] * xy[5]; ab0 -= mq[5][2] * xy[6]; ab1 -= mq[5][3] * xy[7]; xy[8] = ab0 + ab1; up[1024] = xy[8][0]; wp[1024] = f2bf(-xy[8][1]); mq[5] = *(const LAS f32x4*)(Mg + 648);
            { const float br = betg[9]; ab0 = (f32x2){bf2f(*(const LAS bf16_t*)(lg + P5_VS + 2448 + c * 2)) * br, bf2f(*(const LAS bf16_t*)(lg + P5_KS + 2448 + c * 2)) * br * __expf(decg[9])}; ab1 = (f32x2){0.f, 0.f}; } ab0 -= mq[0][0] * xy[0]; ab1 -= mq[0][1] * xy[1]; ab0 -= mq[0][2] * xy[2]; ab1 -= mq[0][3] * xy[3]; mq[0] = *(const LAS f32x4*)(Mg + 704);
            ab0 -= mq[1][0] * xy[4]; ab1 -= mq[1][1] * xy[5]; ab0 -= mq[1][2] * xy[6]; ab1 -= mq[1][3] * xy[7]; mq[1] = *(const LAS f32x4*)(Mg + 708);
            ab0 -= mq[2][0] * xy[8]; xy[9] = ab0 + ab1; up[1152] = xy[9][0]; wp[1152] = f2bf(-xy[9][1]); mq[2] = *(const LAS f32x4*)(Mg + 712);
            { const float br = betg[10]; ab0 = (f32x2){bf2f(*(const LAS bf16_t*)(lg + P5_VS + 2720 + c * 2)) * br, bf2f(*(const LAS bf16_t*)(lg + P5_KS + 2720 + c * 2)) * br * __expf(decg[10])}; ab1 = (f32x2){0.f, 0.f}; } ab0 -= mq[3][0] * xy[0]; ab1 -= mq[3][1] * xy[1]; ab0 -= mq[3][2] * xy[2]; ab1 -= mq[3][3] * xy[3]; mq[3] = *(const LAS f32x4*)(Mg + 768);
            ab0 -= mq[4][0] * xy[4]; ab1 -= mq[4][1] * xy[5]; ab0 -= mq[4][2] * xy[6]; ab1 -= mq[4][3] * xy[7]; mq[4] = *(const LAS f32x4*)(Mg + 772);
            ab0 -= mq[5][0] * xy[8]; ab1 -= mq[5][1] * xy[9]; xy[10] = ab0 + ab1; up[1280] = xy[10][0]; wp[1280] = f2bf(-xy[10][1]); mq[5] = *(const LAS f32x4*)(Mg + 776);
            { const float br = betg[11]; ab0 = (f32x2){bf2f(*(const LAS bf16_t*)(lg + P5_VS + 2992 + c * 2)) * br, bf2f(*(const LAS bf16_t*)(lg + P5_KS + 2992 + c * 2)) * br * __expf(decg[11])}; ab1 = (f32x2){0.f, 0.f}; } ab0 -= mq[0][0] * xy[0]; ab1 -= mq[0][1] * xy[1]; ab0 -= mq[0][2] * xy[2]; ab1 -= mq[0][3] * xy[3]; mq[0] = *(const LAS f32x4*)(Mg + 832);
            ab0 -= mq[1][0] * xy[4]; ab1 -= mq[1][1] * xy[5]; ab0 -= mq[1][2] * xy[6]; ab1 -= mq[1][3] * xy[7]; mq[1] = *(const LAS f32x4*)(Mg + 836);
            ab0 -= mq[2][0] * xy[8]; ab1 -= mq[2][1] * xy[9]; ab0 -= mq[2][2] * xy[10]; xy[11] = ab0 + ab1; up[1408] = xy[11][0]; wp[1408] = f2bf(-xy[11][1]); mq[2] = *(const LAS f32x4*)(Mg + 840);
            { const float br = betg[12]; ab0 = (f32x2){bf2f(*(const LAS bf16_t*)(lg + P5_VS + 3264 + c * 2)) * br, bf2f(*(const LAS bf16_t*)(lg + P5_KS + 3264 + c * 2)) * br * __expf(decg[12])}; ab1 = (f32x2){0.f, 0.f}; } ab0 -= mq[3][0] * xy[0]; ab1 -= mq[3][1] * xy[1]; ab0 -= mq[3][2] * xy[2]; ab1 -= mq[3][3] * xy[3]; mq[3] = *(const LAS f32x4*)(Mg + 844);
            ab0 -= mq[4][0] * xy[4]; ab1 -= mq[4][1] * xy[5]; ab0 -= mq[4][2] * xy[6]; ab1 -= mq[4][3] * xy[7]; mq[4] = *(const LAS f32x4*)(Mg + 896);
            ab0 -= mq[5][0] * xy[8]; ab1 -= mq[5][1] * xy[9]; ab0 -= mq[5][2] * xy[10]; ab1 -= mq[5][3] * xy[11]; xy[12] = ab0 + ab1; up[1536] = xy[12][0]; wp[1536] = f2bf(-xy[12][1]); mq[5] = *(const LAS f32x4*)(Mg + 900);
            { const float br = betg[13]; ab0 = (f32x2){bf2f(*(const LAS bf16_t*)(lg + P5_VS + 3536 + c * 2)) * br, bf2f(*(const LAS bf16_t*)(lg + P5_KS + 3536 + c * 2)) * br * __expf(decg[13])}; ab1 = (f32x2){0.f, 0.f}; } ab0 -= mq[0][0] * xy[0]; ab1 -= mq[0][1] * xy[1]; ab0 -= mq[0][2] * xy[2]; ab1 -= mq[0][3] * xy[3]; mq[0] = *(const LAS f32x4*)(Mg + 904);
            ab0 -= mq[1][0] * xy[4]; ab1 -= mq[1][1] * xy[5]; ab0 -= mq[1][2] * xy[6]; ab1 -= mq[1][3] * xy[7]; mq[1] = *(const LAS f32x4*)(Mg + 908);
            ab0 -= mq[2][0] * xy[8]; ab1 -= mq[2][1] * xy[9]; ab0 -= mq[2][2] * xy[10]; ab1 -= mq[2][3] * xy[11]; mq[2] = *(const LAS f32x4*)(Mg + 960);
            ab0 -= mq[3][0] * xy[12]; xy[13] = ab0 + ab1; up[1664] = xy[13][0]; wp[1664] = f2bf(-xy[13][1]); mq[3] = *(const LAS f32x4*)(Mg + 964);
            { const float br = betg[14]; ab0 = (f32x2){bf2f(*(const LAS bf16_t*)(lg + P5_VS + 3808 + c * 2)) * br, bf2f(*(const LAS bf16_t*)(lg + P5_KS + 3808 + c * 2)) * br * __expf(decg[14])}; ab1 = (f32x2){0.f, 0.f}; } ab0 -= mq[4][0] * xy[0]; ab1 -= mq[4][1] * xy[1]; ab0 -= mq[4][2] * xy[2]; ab1 -= mq[4][3] * xy[3]; mq[4] = *(const LAS f32x4*)(Mg + 968);
            ab0 -= mq[5][0] * xy[4]; ab1 -= mq[5][1] * xy[5]; ab0 -= mq[5][2] * xy[6]; ab1 -= mq[5][3] * xy[7]; mq[5] = *(const LAS f32x4*)(Mg + 972);
            ab0 -= mq[0][0] * xy[8]; ab1 -= mq[0][1] * xy[9]; ab0 -= mq[0][2] * xy[10]; ab1 -= mq[0][3] * xy[11]; mq[0] = *(const LAS f32x4*)(Mg + 1024);
            ab0 -= mq[1][0] * xy[12]; ab1 -= mq[1][1] * xy[13]; xy[14] = ab0 + ab1; up[1792] = xy[14][0]; wp[1792] = f2bf(-xy[14][1]); mq[1] = *(const LAS f32x4*)(Mg + 1028);
            { const float br = betg[15]; ab0 = (f32x2){bf2f(*(const LAS bf16_t*)(lg + P5_VS + 4080 + c * 2)) * br, bf2f(*(const LAS bf16_t*)(lg + P5_KS + 4080 + c * 2)) * br * __expf(decg[15])}; ab1 = (f32x2){0.f, 0.f}; } ab0 -= mq[2][0] * xy[0]; ab1 -= mq[2][1] * xy[1]; ab0 -= mq[2][2] * xy[2]; ab1 -= mq[2][3] * xy[3]; mq[2] = *(const LAS f32x4*)(Mg + 1032);
            ab0 -= mq[3][0] * xy[4]; ab1 -= mq[3][1] * xy[5]; ab0 -= mq[3][2] * xy[6]; ab1 -= mq[3][3] * xy[7]; mq[3] = *(const LAS f32x4*)(Mg + 1036);
            ab0 -= mq[4][0] * xy[8]; ab1 -= mq[4][1] * xy[9]; ab0 -= mq[4][2] * xy[10]; ab1 -= mq[4][3] * xy[11]; mq[4] = *(const LAS f32x4*)(Mg + 1088);
            ab0 -= mq[5][0] * xy[12]; ab1 -= mq[5][1] * xy[13]; ab0 -= mq[5][2] * xy[14]; xy[15] = ab0 + ab1; up[1920] = xy[15][0]; wp[1920] = f2bf(-xy[15][1]); mq[5] = *(const LAS f32x4*)(Mg + 1092);
            { const float br = betg[16]; ab0 = (f32x2){bf2f(*(const LAS bf16_t*)(lg + P5_VS + 4352 + c * 2)) * br, bf2f(*(const LAS bf16_t*)(lg + P5_KS + 4352 + c * 2)) * br * __expf(decg[16])}; ab1 = (f32x2){0.f, 0.f}; } ab0 -= mq[0][0] * xy[0]; ab1 -= mq[0][1] * xy[1]; ab0 -= mq[0][2] * xy[2]; ab1 -= mq[0][3] * xy[3]; mq[0] = *(const LAS f32x4*)(Mg + 1096);
            ab0 -= mq[1][0] * xy[4]; ab1 -= mq[1][1] * xy[5]; ab0 -= mq[1][2] * xy[6]; ab1 -= mq[1][3] * xy[7]; mq[1] = *(const LAS f32x4*)(Mg + 1100);
            ab0 -= mq[2][0] * xy[8]; ab1 -= mq[2][1] * xy[9]; ab0 -= mq[2][2] * xy[10]; ab1 -= mq[2][3] * xy[11]; mq[2] = *(const LAS f32x4*)(Mg + 1104);
            ab0 -= mq[3][0] * xy[12]; ab1 -= mq[3][1] * xy[13]; ab0 -= mq[3][2] * xy[14]; ab1 -= mq[3][3] * xy[15]; xy[16] = ab0 + ab1; up[2048] = xy[16][0]; wp[2048] = f2bf(-xy[16][1]); mq[3] = *(const LAS f32x4*)(Mg + 1152);
            { const float br = betg[17]; ab0 = (f32x2){bf2f(*(const LAS bf16_t*)(lg + P5_VS + 4624 + c * 2)) * br, bf2f(*(const LAS bf16_t*)(lg + P5_KS + 4624 + c * 2)) * br * __expf(decg[17])}; ab1 = (f32x2){0.f, 0.f}; } ab0 -= mq[4][0] * xy[0]; ab1 -= mq[4][1] * xy[1]; ab0 -= mq[4][2] * xy[2]; ab1 -= mq[4][3] * xy[3]; mq[4] = *(const LAS f32x4*)(Mg + 1156);
            ab0 -= mq[5][0] * xy[4]; ab1 -= mq[5][1] * xy[5]; ab0 -= mq[5][2] * xy[6]; ab1 -= mq[5][3] * xy[7]; mq[5] = *(const LAS f32x4*)(Mg + 1160);
            ab0 -= mq[0][0] * xy[8]; ab1 -= mq[0][1] * xy[9]; ab0 -= mq[0][2] * xy[10]; ab1 -= mq[0][3] * xy[11]; mq[0] = *(const LAS f32x4*)(Mg + 1164);
            ab0 -= mq[1][0] * xy[12]; ab1 -= mq[1][1] * xy[13]; ab0 -= mq[1][2] * xy[14]; ab1 -= mq[1][3] * xy[15]; mq[1] = *(const LAS f32x4*)(Mg + 1168);
            ab0 -= mq[2][0] * xy[16]; xy[17] = ab0 + ab1; up[2176] = xy[17][0]; wp[2176] = f2bf(-xy[17][1]); mq[2] = *(const LAS f32x4*)(Mg + 1216);
            { const float br = betg[18]; ab0 = (f32x2){bf2f(*(const LAS bf16_t*)(lg + P5_VS + 4896 + c * 2)) * br, bf2f(*(const LAS bf16_t*)(lg + P5_KS + 4896 + c * 2)) * br * __expf(decg[18])}; ab1 = (f32x2){0.f, 0.f}; } ab0 -= mq[3][0] * xy[0]; ab1 -= mq[3][1] * xy[1]; ab0 -= mq[3][2] * xy[2]; ab1 -= mq[3][3] * xy[3]; mq[3] = *(const LAS f32x4*)(Mg + 1220);
            ab0 -= mq[4][0] * xy[4]; ab1 -= mq[4][1] * xy[5]; ab0 -= mq[4][2] * xy[6]; ab1 -= mq[4][3] * xy[7]; mq[4] = *(const LAS f32x4*)(Mg + 1224);
            ab0 -= mq[5][0] * xy[8]; ab1 -= mq[5][1] * xy[9]; ab0 -= mq[5][2] * xy[10]; ab1 -= mq[5][3] * xy[11]; mq[5] = *(const LAS f32x4*)(Mg + 1228);
            ab0 -= mq[0][0] * xy[12]; ab1 -= mq[0][1] * xy[13]; ab0 -= mq[0][2] * xy[14]; ab1 -= mq[0][3] * xy[15]; mq[0] = *(const LAS f32x4*)(Mg + 1232);
            ab0 -= mq[1][0] * xy[16]; ab1 -= mq[1][1] * xy[17]; xy[18] = ab0 + ab1; up[2304] = xy[18][0]; wp[2304] = f2bf(-xy[18][1]); mq[1] = *(const LAS f32x4*)(Mg + 1280);
            { const float br = betg[19]; ab0 = (f32x2){bf2f(*(const LAS bf16_t*)(lg + P5_VS + 5168 + c * 2)) * br, bf2f(*(const LAS bf16_t*)(lg + P5_KS + 5168 + c * 2)) * br * __expf(decg[19])}; ab1 = (f32x2){0.f, 0.f}; } ab0 -= mq[2][0] * xy[0]; ab1 -= mq[2][1] * xy[1]; ab0 -= mq[2][2] * xy[2]; ab1 -= mq[2][3] * xy[3]; mq[2] = *(const LAS f32x4*)(Mg + 1284);
            ab0 -= mq[3][0] * xy[4]; ab1 -= mq[3][1] * xy[5]; ab0 -= mq[3][2] * xy[6]; ab1 -= mq[3][3] * xy[7]; mq[3] = *(const LAS f32x4*)(Mg + 1288);
            ab0 -= mq[4][0] * xy[8]; ab1 -= mq[4][1] * xy[9]; ab0 -= mq[4][2] * xy[10]; ab1 -= mq[4][3] * xy[11]; mq[4] = *(const LAS f32x4*)(Mg + 1292);
            ab0 -= mq[5][0] * xy[12]; ab1 -= mq[5][1] * xy[13]; ab0 -= mq[5][2] * xy[14]; ab1 -= mq[5][3] * xy[15]; mq[5] = *(const LAS f32x4*)(Mg + 1296);
            ab0 -= mq[0][0] * xy[16]; ab1 -= mq[0][1] * xy[17]; ab0 -= mq[0][2] * xy[18]; xy[19] = ab0 + ab1; up[2432] = xy[19][0]; wp[2432] = f2bf(-xy[19][1]); mq[0] = *(const LAS f32x4*)(Mg + 1344);
            { const float br = betg[20]; ab0 = (f32x2){bf2f(*(const LAS bf16_t*)(lg + P5_VS + 5440 + c * 2)) * br, bf2f(*(const LAS bf16_t*)(lg + P5_KS + 5440 + c * 2)) * br * __expf(decg[20])}; ab1 = (f32x2){0.f, 0.f}; } ab0 -= mq[1][0] * xy[0]; ab1 -= mq[1][1] * xy[1]; ab0 -= mq[1][2] * xy[2]; ab1 -= mq[1][3] * xy[3]; mq[1] = *(const LAS f32x4*)(Mg + 1348);
            ab0 -= mq[2][0] * xy[4]; ab1 -= mq[2][1] * xy[5]; ab0 -= mq[2][2] * xy[6]; ab1 -= mq[2][3] * xy[7]; mq[2] = *(const LAS f32x4*)(Mg + 1352);
            ab0 -= mq[3][0] * xy[8]; ab1 -= mq[3][1] * xy[9]; ab0 -= mq[3][2] * xy[10]; ab1 -= mq[3][3] * xy[11]; mq[3] = *(const LAS f32x4*)(Mg + 1356);
            ab0 -= mq[4][0] * xy[12]; ab1 -= mq[4][1] * xy[13]; ab0 -= mq[4][2] * xy[14]; ab1 -= mq[4][3] * xy[15]; mq[4] = *(const LAS f32x4*)(Mg + 1360);
            ab0 -= mq[5][0] * xy[16]; ab1 -= mq[5][1] * xy[17]; ab0 -= mq[5][2] * xy[18]; ab1 -= mq[5][3] * xy[19]; xy[20] = ab0 + ab1; up[2560] = xy[20][0]; wp[2560] = f2bf(-xy[20][1]); mq[5] = *(const LAS f32x4*)(Mg + 1364);
            { const float br = betg[21]; ab0 = (f32x2){bf2f(*(const LAS bf16_t*)(lg + P5_VS + 5712 + c * 2)) * br, bf2f(*(const LAS bf16_t*)(lg + P5_KS + 5712 + c * 2)) * br * __expf(decg[21])}; ab1 = (f32x2){0.f, 0.f}; } ab0 -= mq[0][0] * xy[0]; ab1 -= mq[0][1] * xy[1]; ab0 -= mq[0][2] * xy[2]; ab1 -= mq[0][3] * xy[3]; mq[0] = *(const LAS f32x4*)(Mg + 1408);
            ab0 -= mq[1][0] * xy[4]; ab1 -= mq[1][1] * xy[5]; ab0 -= mq[1][2] * xy[6]; ab1 -= mq[1][3] * xy[7]; mq[1] = *(const LAS f32x4*)(Mg + 1412);
            ab0 -= mq[2][0] * xy[8]; ab1 -= mq[2][1] * xy[9]; ab0 -= mq[2][2] * xy[10]; ab1 -= mq[2][3] * xy[11]; mq[2] = *(const LAS f32x4*)(Mg + 1416);
            ab0 -= mq[3][0] * xy[12]; ab1 -= mq[3][1] * xy[13]; ab0 -= mq[3][2] * xy[14]; ab1 -= mq[3][3] * xy[15]; mq[3] = *(const LAS f32x4*)(Mg + 1420);
            ab0 -= mq[4][0] * xy[16]; ab1 -= mq[4][1] * xy[17]; ab0 -= mq[4][2] * xy[18]; ab1 -= mq[4][3] * xy[19]; mq[4] = *(const LAS f32x4*)(Mg + 1424);
            ab0 -= mq[5][0] * xy[20]; xy[21] = ab0 + ab1; up[2688] = xy[21][0]; wp[2688] = f2bf(-xy[21][1]); mq[5] = *(const LAS f32x4*)(Mg + 1428);
            { const float br = betg[22]; ab0 = (f32x2){bf2f(*(const LAS bf16_t*)(lg + P5_VS + 5984 + c * 2)) * br, bf2f(*(const LAS bf16_t*)(lg + P5_KS + 5984 + c * 2)) * br * __expf(decg[22])}; ab1 = (f32x2){0.f, 0.f}; } ab0 -= mq[0][0] * xy[0]; ab1 -= mq[0][1] * xy[1]; ab0 -= mq[0][2] * xy[2]; ab1 -= mq[0][3] * xy[3]; mq[0] = *(const LAS f32x4*)(Mg + 1472);
            ab0 -= mq[1][0] * xy[4]; ab1 -= mq[1][1] * xy[5]; ab0 -= mq[1][2] * xy[6]; ab1 -= mq[1][3] * xy[7]; mq[1] = *(const LAS f32x4*)(Mg + 1476);
            ab0 -= mq[2][0] * xy[8]; ab1 -= mq[2][1] * xy[9]; ab0 -= mq[2][2] * xy[10]; ab1 -= mq[2][3] * xy[11]; mq[2] = *(const LAS f32x4*)(Mg + 1480);
            ab0 -= mq[3][0] * xy[12]; ab1 -= mq[3][1] * xy[13]; ab0 -= mq[3][2] * xy[14]; ab1 -= mq[3][3] * xy[15]; mq[3] = *(const LAS f32x4*)(Mg + 1484);
            ab0 -= mq[4][0] * xy[16]; ab1 -= mq[4][1] * xy[17]; ab0 -= mq[4][2] * xy[18]; ab1 -= mq[4][3] * xy[19]; mq[4] = *(const LAS f32x4*)(Mg + 1488);
            ab0 -= mq[5][0] * xy[20]; ab1 -= mq[5][1] * xy[21]; xy[22] = ab0 + ab1; up[2816] = xy[22][0]; wp[2816] = f2bf(-xy[22][1]); mq[5] = *(const LAS f32x4*)(Mg + 1492);
            { const float br = betg[23]; ab0 = (f32x2){bf2f(*(const LAS bf16_t*)(lg + P5_VS + 6256 + c * 2)) * br, bf2f(*(const LAS bf16_t*)(lg + P5_KS + 6256 + c * 2)) * br * __expf(decg[23])}; ab1 = (f32x2){0.f, 0.f}; } ab0 -= mq[0][0] * xy[0]; ab1 -= mq[0][1] * xy[1]; ab0 -= mq[0][2] * xy[2]; ab1 -= mq[0][3] * xy[3]; mq[0] = *(const LAS f32x4*)(Mg + 1536);
            ab0 -= mq[1][0] * xy[4]; ab1 -= mq[1][1] * xy[5]; ab0 -= mq[1][2] * xy[6]; ab1 -= mq[1][3] * xy[7]; mq[1] = *(const LAS f32x4*)(Mg + 1540);
            ab0 -= mq[2][0] * xy[8]; ab1 -= mq[2][1] * xy[9]; ab0 -= mq[2][2] * xy[10]; ab1 -= mq[2][3] * xy[11]; mq[2] = *(const LAS f32x4*)(Mg + 1544);
            ab0 -= mq[3][0] * xy[12]; ab1 -= mq[3][1] * xy[13]; ab0 -= mq[3][2] * xy[14]; ab1 -= mq[3][3] * xy[15]; mq[3] = *(const LAS f32x4*)(Mg + 1548);
            ab0 -= mq[4][0] * xy[16]; ab1 -= mq[4][1] * xy[17]; ab0 -= mq[4][2] * xy[18]; ab1 -= mq[4][3] * xy[19]; mq[4] = *(const LAS f32x4*)(Mg + 1552);
            ab0 -= mq[5][0] * xy[20]; ab1 -= mq[5][1] * xy[21]; ab0 -= mq[5][2] * xy[22]; xy[23] = ab0 + ab1; up[2944] = xy[23][0]; wp[2944] = f2bf(-xy[23][1]); mq[5] = *(const LAS f32x4*)(Mg + 1556);
            { const float br = betg[24]; ab0 = (f32x2){bf2f(*(const LAS bf16_t*)(lg + P5_VS + 6528 + c * 2)) * br, bf2f(*(const LAS bf16_t*)(lg + P5_KS + 6528 + c * 2)) * br * __expf(decg[24])}; ab1 = (f32x2){0.f, 0.f}; } ab0 -= mq[0][0] * xy[0]; ab1 -= mq[0][1] * xy[1]; ab0 -= mq[0][2] * xy[2]; ab1 -= mq[0][3] * xy[3]; mq[0] = *(const LAS f32x4*)(Mg + 1600);
            ab0 -= mq[1][0] * xy[4]; ab1 -= mq[1][1] * xy[5]; ab0 -= mq[1][2] * xy[6]; ab1 -= mq[1][3] * xy[7]; mq[1] = *(const LAS f32x4*)(Mg + 1604);
            ab0 -= mq[2][0] * xy[8]; ab1 -= mq[2][1] * xy[9]; ab0 -= mq[2][2] * xy[10]; ab1 -= mq[2][3] * xy[11]; mq[2] = *(const LAS f32x4*)(Mg + 1608);
            ab0 -= mq[3][0] * xy[12]; ab1 -= mq[3][1] * xy[13]; ab0 -= mq[3][2] * xy[14]; ab1 -= mq[3][3] * xy[15]; mq[3] = *(const LAS f32x4*)(Mg + 1612);
            ab0 -= mq[4][0] * xy[16]; ab1 -= mq[4][1] * xy[17]; ab0 -= mq[4][2] * xy[18]; ab1 -= mq[4][3] * xy[19]; mq[4] = *(const LAS f32x4*)(Mg + 1616);
            ab0 -= mq[5][0] * xy[20]; ab1 -= mq[5][1] * xy[21]; ab0 -= mq[5][2] * xy[22]; ab1 -= mq[5][3] * xy[23]; xy[24] = ab0 + ab1; up[3072] = xy[24][0]; wp[3072] = f2bf(-xy[24][1]); mq[5] = *(const LAS f32x4*)(Mg + 1620);
            { const float br = betg[25]; ab0 = (f32x2){bf2f(*(const LAS bf16_t*)(lg + P5_VS + 6800 + c * 2)) * br, bf2f(*(const LAS bf16_t*)(lg + P5_KS + 6800 + c * 2)) * br * __expf(decg[25])}; ab1 = (f32x2){0.f, 0.f}; } ab0 -= mq[0][0] * xy[0]; ab1 -= mq[0][1] * xy[1]; ab0 -= mq[0][2] * xy[2]; ab1 -= mq[0][3] * xy[3]; mq[0] = *(const LAS f32x4*)(Mg + 1624);
            ab0 -= mq[1][0] * xy[4]; ab1 -= mq[1][1] * xy[5]; ab0 -= mq[1][2] * xy[6]; ab1 -= mq[1][3] * xy[7]; mq[1] = *(const LAS f32x4*)(Mg + 1664);
            ab0 -= mq[2][0] * xy[8]; ab1 -= mq[2][1] * xy[9]; ab0 -= mq[2][2] * xy[10]; ab1 -= mq[2][3] * xy[11]; mq[2] = *(const LAS f32x4*)(Mg + 1668);
            ab0 -= mq[3][0] * xy[12]; ab1 -= mq[3][1] * xy[13]; ab0 -= mq[3][2] * xy[14]; ab1 -= mq[3][3] * xy[15]; mq[3] = *(const LAS f32x4*)(Mg + 1672);
            ab0 -= mq[4][0] * xy[16]; ab1 -= mq[4][1] * xy[17]; ab0 -= mq[4][2] * xy[18]; ab1 -= mq[4][3] * xy[19]; mq[4] = *(const LAS f32x4*)(Mg + 1676);
            ab0 -= mq[5][0] * xy[20]; ab1 -= mq[5][1] * xy[21]; ab0 -= mq[5][2] * xy[22]; ab1 -= mq[5][3] * xy[23]; mq[5] = *(const LAS f32x4*)(Mg + 1680);
            ab0 -= mq[0][0] * xy[24]; xy[25] = ab0 + ab1; up[3200] = xy[25][0]; wp[3200] = f2bf(-xy[25][1]); mq[0] = *(const LAS f32x4*)(Mg + 1684);
            { const float br = betg[26]; ab0 = (f32x2){bf2f(*(const LAS bf16_t*)(lg + P5_VS + 7072 + c * 2)) * br, bf2f(*(const LAS bf16_t*)(lg + P5_KS + 7072 + c * 2)) * br * __expf(decg[26])}; ab1 = (f32x2){0.f, 0.f}; } ab0 -= mq[1][0] * xy[0]; ab1 -= mq[1][1] * xy[1]; ab0 -= mq[1][2] * xy[2]; ab1 -= mq[1][3] * xy[3]; mq[1] = *(const LAS f32x4*)(Mg + 1688);
            ab0 -= mq[2][0] * xy[4]; ab1 -= mq[2][1] * xy[5]; ab0 -= mq[2][2] * xy[6]; ab1 -= mq[2][3] * xy[7]; mq[2] = *(const LAS f32x4*)(Mg + 1728);
            ab0 -= mq[3][0] * xy[8]; ab1 -= mq[3][1] * xy[9]; ab0 -= mq[3][2] * xy[10]; ab1 -= mq[3][3] * xy[11]; mq[3] = *(const LAS f32x4*)(Mg + 1732);
            ab0 -= mq[4][0] * xy[12]; ab1 -= mq[4][1] * xy[13]; ab0 -= mq[4][2] * xy[14]; ab1 -= mq[4][3] * xy[15]; mq[4] = *(const LAS f32x4*)(Mg + 1736);
            ab0 -= mq[5][0] * xy[16]; ab1 -= mq[5][1] * xy[17]; ab0 -= mq[5][2] * xy[18]; ab1 -= mq[5][3] * xy[19]; mq[5] = *(const LAS f32x4*)(Mg + 1740);
            ab0 -= mq[0][0] * xy[20]; ab1 -= mq[0][1] * xy[21]; ab0 -= mq[0][2] * xy[22]; ab1 -= mq[0][3] * xy[23]; mq[0] = *(const LAS f32x4*)(Mg + 1744);
            ab0 -= mq[1][0] * xy[24]; ab1 -= mq[1][1] * xy[25]; xy[26] = ab0 + ab1; up[3328] = xy[26][0]; wp[3328] = f2bf(-xy[26][1]); mq[1] = *(const LAS f32x4*)(Mg + 1748);
            { const float br = betg[27]; ab0 = (f32x2){bf2f(*(const LAS bf16_t*)(lg + P5_VS + 7344 + c * 2)) * br, bf2f(*(const LAS bf16_t*)(lg + P5_KS + 7344 + c * 2)) * br * __expf(decg[27])}; ab1 = (f32x2){0.f, 0.f}; } ab0 -= mq[2][0] * xy[0]; ab1 -= mq[2][1] * xy[1]; ab0 -= mq[2][2] * xy[2]; ab1 -= mq[2][3] * xy[3]; mq[2] = *(const LAS f32x4*)(Mg + 1752);
            ab0 -= mq[3][0] * xy[4]; ab1 -= mq[3][1] * xy[5]; ab0 -= mq[3][2] * xy[6]; ab1 -= mq[3][3] * xy[7]; mq[3] = *(const LAS f32x4*)(Mg + 1792);
            ab0 -= mq[4][0] * xy[8]; ab1 -= mq[4][1] * xy[9]; ab0 -= mq[4][2] * xy[10]; ab1 -= mq[4][3] * xy[11]; mq[4] = *(const LAS f32x4*)(Mg + 1796);
            ab0 -= mq[5][0] * xy[12]; ab1 -= mq[5][1] * xy[13]; ab0 -= mq[5][2] * xy[14]; ab1 -= mq[5][3] * xy[15]; mq[5] = *(const LAS f32x4*)(Mg + 1800);
            ab0 -= mq[0][0] * xy[16]; ab1 -= mq[0][1] * xy[17]; ab0 -= mq[0][2] * xy[18]; ab1 -= mq[0][3] * xy[19]; mq[0] = *(const LAS f32x4*)(Mg + 1804);
            ab0 -= mq[1][0] * xy[20]; ab1 -= mq[1][1] * xy[21]; ab0 -= mq[1][2] * xy[22]; ab1 -= mq[1][3] * xy[23]; mq[1] = *(const LAS f32x4*)(Mg + 1808);
            ab0 -= mq[2][0] * xy[24]; ab1 -= mq[2][1] * xy[25]; ab0 -= mq[2][2] * xy[26]; xy[27] = ab0 + ab1; up[3456] = xy[27][0]; wp[3456] = f2bf(-xy[27][1]); mq[2] = *(const LAS f32x4*)(Mg + 1812);
            { const float br = betg[28]; ab0 = (f32x2){bf2f(*(const LAS bf16_t*)(lg + P5_VS + 7616 + c * 2)) * br, bf2f(*(const LAS bf16_t*)(lg + P5_KS + 7616 + c * 2)) * br * __expf(decg[28])}; ab1 = (f32x2){0.f, 0.f}; } ab0 -= mq[3][0] * xy[0]; ab1 -= mq[3][1] * xy[1]; ab0 -= mq[3][2] * xy[2]; ab1 -= mq[3][3] * xy[3]; mq[3] = *(const LAS f32x4*)(Mg + 1816);
            ab0 -= mq[4][0] * xy[4]; ab1 -= mq[4][1] * xy[5]; ab0 -= mq[4][2] * xy[6]; ab1 -= mq[4][3] * xy[7]; mq[4] = *(const LAS f32x4*)(Mg + 1856);
            ab0 -= mq[5][0] * xy[8]; ab1 -= mq[5][1] * xy[9]; ab0 -= mq[5][2] * xy[10]; ab1 -= mq[5][3] * xy[11]; mq[5] = *(const LAS f32x4*)(Mg + 1860);
            ab0 -= mq[0][0] * xy[12]; ab1 -= mq[0][1] * xy[13]; ab0 -= mq[0][2] * xy[14]; ab1 -= mq[0][3] * xy[15]; mq[0] = *(const LAS f32x4*)(Mg + 1864);
            ab0 -= mq[1][0] * xy[16]; ab1 -= mq[1][1] * xy[17]; ab0 -= mq[1][2] * xy[18]; ab1 -= mq[1][3] * xy[19]; mq[1] = *(const LAS f32x4*)(Mg + 1868);
            ab0 -= mq[2][0] * xy[20]; ab1 -= mq[2][1] * xy[21]; ab0 -= mq[2][2] * xy[22]; ab1 -= mq[2][3] * xy[23]; mq[2] = *(const LAS f32x4*)(Mg + 1872);
            ab0 -= mq[3][0] * xy[24]; ab1 -= mq[3][1] * xy[25]; ab0 -= mq[3][2] * xy[26]; ab1 -= mq[3][3] * xy[27]; xy[28] = ab0 + ab1; up[3584] = xy[28][0]; wp[3584] = f2bf(-xy[28][1]); mq[3] = *(const LAS f32x4*)(Mg + 1876);
            { const float br = betg[29]; ab0 = (f32x2){bf2f(*(const LAS bf16_t*)(lg + P5_VS + 7888 + c * 2)) * br, bf2f(*(const LAS bf16_t*)(lg + P5_KS + 7888 + c * 2)) * br * __expf(decg[29])}; ab1 = (f32x2){0.f, 0.f}; } ab0 -= mq[4][0] * xy[0]; ab1 -= mq[4][1] * xy[1]; ab0 -= mq[4][2] * xy[2]; ab1 -= mq[4][3] * xy[3]; mq[4] = *(const LAS f32x4*)(Mg + 1880);
            ab0 -= mq[5][0] * xy[4]; ab1 -= mq[5][1] * xy[5]; ab0 -= mq[5][2] * xy[6]; ab1 -= mq[5][3] * xy[7]; mq[5] = *(const LAS f32x4*)(Mg + 1884);
            ab0 -= mq[0][0] * xy[8]; ab1 -= mq[0][1] * xy[9]; ab0 -= mq[0][2] * xy[10]; ab1 -= mq[0][3] * xy[11]; mq[0] = *(const LAS f32x4*)(Mg + 1920);
            ab0 -= mq[1][0] * xy[12]; ab1 -= mq[1][1] * xy[13]; ab0 -= mq[1][2] * xy[14]; ab1 -= mq[1][3] * xy[15]; mq[1] = *(const LAS f32x4*)(Mg + 1924);
            ab0 -= mq[2][0] * xy[16]; ab1 -= mq[2][1] * xy[17]; ab0 -= mq[2][2] * xy[18]; ab1 -= mq[2][3] * xy[19]; mq[2] = *(const LAS f32x4*)(Mg + 1928);
            ab0 -= mq[3][0] * xy[20]; ab1 -= mq[3][1] * xy[21]; ab0 -= mq[3][2] * xy[22]; ab1 -= mq[3][3] * xy[23]; mq[3] = *(const LAS f32x4*)(Mg + 1932);
            ab0 -= mq[4][0] * xy[24]; ab1 -= mq[4][1] * xy[25]; ab0 -= mq[4][2] * xy[26]; ab1 -= mq[4][3] * xy[27]; mq[4] = *(const LAS f32x4*)(Mg + 1936);
            ab0 -= mq[5][0] * xy[28]; xy[29] = ab0 + ab1; up[3712] = xy[29][0]; wp[3712] = f2bf(-xy[29][1]); mq[5] = *(const LAS f32x4*)(Mg + 1940);
            { const float br = betg[30]; ab0 = (f32x2){bf2f(*(const LAS bf16_t*)(lg + P5_VS + 8160 + c * 2)) * br, bf2f(*(const LAS bf16_t*)(lg + P5_KS + 8160 + c * 2)) * br * __expf(decg[30])}; ab1 = (f32x2){0.f, 0.f}; } ab0 -= mq[0][0] * xy[0]; ab1 -= mq[0][1] * xy[1]; ab0 -= mq[0][2] * xy[2]; ab1 -= mq[0][3] * xy[3]; mq[0] = *(const LAS f32x4*)(Mg + 1944);
            ab0 -= mq[1][0] * xy[4]; ab1 -= mq[1][1] * xy[5]; ab0 -= mq[1][2] * xy[6]; ab1 -= mq[1][3] * xy[7]; mq[1] = *(const LAS f32x4*)(Mg + 1948);
            ab0 -= mq[2][0] * xy[8]; ab1 -= mq[2][1] * xy[9]; ab0 -= mq[2][2] * xy[10]; ab1 -= mq[2][3] * xy[11]; mq[2] = *(const LAS f32x4*)(Mg + 1984);
            ab0 -= mq[3][0] * xy[12]; ab1 -= mq[3][1] * xy[13]; ab0 -= mq[3][2] * xy[14]; ab1 -= mq[3][3] * xy[15]; mq[3] = *(const LAS f32x4*)(Mg + 1988);
            ab0 -= mq[4][0] * xy[16]; ab1 -= mq[4][1] * xy[17]; ab0 -= mq[4][2] * xy[18]; ab1 -= mq[4][3] * xy[19]; mq[4] = *(const LAS f32x4*)(Mg + 1992);
            ab0 -= mq[5][0] * xy[20]; ab1 -= mq[5][1] * xy[21]; ab0 -= mq[5][2] * xy[22]; ab1 -= mq[5][3] * xy[23]; mq[5] = *(const LAS f32x4*)(Mg + 1996);
            ab0 -= mq[0][0] * xy[24]; ab1 -= mq[0][1] * xy[25]; ab0 -= mq[0][2] * xy[26]; ab1 -= mq[0][3] * xy[27]; mq[0] = *(const LAS f32x4*)(Mg + 2000);
            ab0 -= mq[1][0] * xy[28]; ab1 -= mq[1][1] * xy[29]; xy[30] = ab0 + ab1; up[3840] = xy[30][0]; wp[3840] = f2bf(-xy[30][1]); mq[1] = *(const LAS f32x4*)(Mg + 2004);
            { const float br = betg[31]; ab0 = (f32x2){bf2f(*(const LAS bf16_t*)(lg + P5_VS + 8432 + c * 2)) * br, bf2f(*(const LAS bf16_t*)(lg + P5_KS + 8432 + c * 2)) * br * __expf(decg[31])}; ab1 = (f32x2){0.f, 0.f}; } ab0 -= mq[2][0] * xy[0]; ab1 -= mq[2][1] * xy[1]; ab0 -= mq[2][2] * xy[2]; ab1 -= mq[2][3] * xy[3]; mq[2] = *(const LAS f32x4*)(Mg + 2008);
            ab0 -= mq[3][0] * xy[4]; ab1 -= mq[3][1] * xy[5]; ab0 -= mq[3][2] * xy[6]; ab1 -= mq[3][3] * xy[7]; mq[3] = *(const LAS f32x4*)(Mg + 2012);
            ab0 -= mq[4][0] * xy[8]; ab1 -= mq[4][1] * xy[9]; ab0 -= mq[4][2] * xy[10]; ab1 -= mq[4][3] * xy[11]; mq[4] = *(const LAS f32x4*)(Mg + 2048);
            ab0 -= mq[5][0] * xy[12]; ab1 -= mq[5][1] * xy[13]; ab0 -= mq[5][2] * xy[14]; ab1 -= mq[5][3] * xy[15]; mq[5] = *(const LAS f32x4*)(Mg + 2052);
            ab0 -= mq[0][0] * xy[16]; ab1 -= mq[0][1] * xy[17]; ab0 -= mq[0][2] * xy[18]; ab1 -= mq[0][3] * xy[19]; mq[0] = *(const LAS f32x4*)(Mg + 2056);
            ab0 -= mq[1][0] * xy[20]; ab1 -= mq[1][1] * xy[21]; ab0 -= mq[1][2] * xy[22]; ab1 -= mq[1][3] * xy[23]; mq[1] = *(const LAS f32x4*)(Mg + 2060);
            ab0 -= mq[2][0] * xy[24]; ab1 -= mq[2][1] * xy[25]; ab0 -= mq[2][2] * xy[26]; ab1 -= mq[2][3] * xy[27]; mq[2] = *(const LAS f32x4*)(Mg + 2064);
            ab0 -= mq[3][0] * xy[28]; ab1 -= mq[3][1] * xy[29]; ab0 -= mq[3][2] * xy[30]; xy[31] = ab0 + ab1; up[3968] = xy[31][0]; wp[3968] = f2bf(-xy[31][1]); mq[3] = *(const LAS f32x4*)(Mg + 2068);
            { const float br = betg[32]; ab0 = (f32x2){bf2f(*(const LAS bf16_t*)(lg + P5_VS + 8704 + c * 2)) * br, bf2f(*(const LAS bf16_t*)(lg + P5_KS + 8704 + c * 2)) * br * __expf(decg[32])}; ab1 = (f32x2){0.f, 0.f}; } ab0 -= mq[4][0] * xy[0]; ab1 -= mq[4][1] * xy[1]; ab0 -= mq[4][2] * xy[2]; ab1 -= mq[4][3] * xy[3]; mq[4] = *(const LAS f32x4*)(Mg + 2072);
            ab0 -= mq[5][0] * xy[4]; ab1 -= mq[5][1] * xy[5]; ab0 -= mq[5][2] * xy[6]; ab1 -= mq[5][3] * xy[7]; mq[5] = *(const LAS f32x4*)(Mg + 2076);
            ab0 -= mq[0][0] * xy[8]; ab1 -= mq[0][1] * xy[9]; ab0 -= mq[0][2] * xy[10]; ab1 -= mq[0][3] * xy[11]; mq[0] = *(const LAS f32x4*)(Mg + 2112);
            ab0 -= mq[1][0] * xy[12]; ab1 -= mq[1][1] * xy[13]; ab0 -= mq[1][2] * xy[14]; ab1 -= mq[1][3] * xy[15]; mq[1] = *(const LAS f32x4*)(Mg + 2116);
            ab0 -= mq[2][0] * xy[16]; ab1 -= mq[2][1] * xy[17]; ab0 -= mq[2][2] * xy[18]; ab1 -= mq[2][3] * xy[19]; mq[2] = *(const LAS f32x4*)(Mg + 2120);
            ab0 -= mq[3][0] * xy[20]; ab1 -= mq[3][1] * xy[21]; ab0 -= mq[3][2] * xy[22]; ab1 -= mq[3][3] * xy[23]; mq[3] = *(const LAS f32x4*)(Mg + 2124);
            ab0 -= mq[4][0] * xy[24]; ab1 -= mq[4][1] * xy[25]; ab0 -= mq[4][2] * xy[26]; ab1 -= mq[4][3] * xy[27]; mq[4] = *(const LAS f32x4*)(Mg + 2128);
            ab0 -= mq[5][0] * xy[28]; ab1 -= mq[5][1] * xy[29]; ab0 -= mq[5][2] * xy[30]; ab1 -= mq[5][3] * xy[31]; xy[32] = ab0 + ab1; up[4096] = xy[32][0]; wp[4096] = f2bf(-xy[32][1]); mq[5] = *(const LAS f32x4*)(Mg + 2132);
            { const float br = betg[33]; ab0 = (f32x2){bf2f(*(const LAS bf16_t*)(lg + P5_VS + 8976 + c * 2)) * br, bf2f(*(const LAS bf16_t*)(lg + P5_KS + 8976 + c * 2)) * br * __expf(decg[33])}; ab1 = (f32x2){0.f, 0.f}; } ab0 -= mq[0][0] * xy[0]; ab1 -= mq[0][1] * xy[1]; ab0 -= mq[0][2] * xy[2]; ab1 -= mq[0][3] * xy[3]; mq[0] = *(const LAS f32x4*)(Mg + 2136);
            ab0 -= mq[1][0] * xy[4]; ab1 -= mq[1][1] * xy[5]; ab0 -= mq[1][2] * xy[6]; ab1 -= mq[1][3] * xy[7]; mq[1] = *(const LAS f32x4*)(Mg + 2140);
            ab0 -= mq[2][0] * xy[8]; ab1 -= mq[2][1] * xy[9]; ab0 -= mq[2][2] * xy[10]; ab1 -= mq[2][3] * xy[11]; mq[2] = *(const LAS f32x4*)(Mg + 2144);
            ab0 -= mq[3][0] * xy[12]; ab1 -= mq[3][1] * xy[13]; ab0 -= mq[3][2] * xy[14]; ab1 -= mq[3][3] * xy[15]; mq[3] = *(const LAS f32x4*)(Mg + 2176);
            ab0 -= mq[4][0] * xy[16]; ab1 -= mq[4][1] * xy[17]; ab0 -= mq[4][2] * xy[18]; ab1 -= mq[4][3] * xy[19]; mq[4] = *(const LAS f32x4*)(Mg + 2180);
            ab0 -= mq[5][0] * xy[20]; ab1 -= mq[5][1] * xy[21]; ab0 -= mq[5][2] * xy[22]; ab1 -= mq[5][3] * xy[23]; mq[5] = *(const LAS f32x4*)(Mg + 2184);
            ab0 -= mq[0][0] * xy[24]; ab1 -= mq[0][1] * xy[25]; ab0 -= mq[0][2] * xy[26]; ab1 -= mq[0][3] * xy[27]; mq[0] = *(const LAS f32x4*)(Mg + 2188);
            ab0 -= mq[1][0] * xy[28]; ab1 -= mq[1][1] * xy[29]; ab0 -= mq[1][2] * xy[30]; ab1 -= mq[1][3] * xy[31]; mq[1] = *(const LAS f32x4*)(Mg + 2192);
            ab0 -= mq[2][0] * xy[32]; xy[33] = ab0 + ab1; up[4224] = xy[33][0]; wp[4224] = f2bf(-xy[33][1]); mq[2] = *(const LAS f32x4*)(Mg + 2196);
            { const float br = betg[34]; ab0 = (f32x2){bf2f(*(const LAS bf16_t*)(lg + P5_VS + 9248 + c * 2)) * br, bf2f(*(const LAS bf16_t*)(lg + P5_KS + 9248 + c * 2)) * br * __expf(decg[34])}; ab1 = (f32x2){0.f, 0.f}; } ab0 -= mq[3][0] * xy[0]; ab1 -= mq[3][1] * xy[1]; ab0 -= mq[3][2] * xy[2]; ab1 -= mq[3][3] * xy[3]; mq[3] = *(const LAS f32x4*)(Mg + 2200);
            ab0 -= mq[4][0] * xy[4]; ab1 -= mq[4][1] * xy[5]; ab0 -= mq[4][2] * xy[6]; ab1 -= mq[4][3] * xy[7]; mq[4] = *(const LAS f32x4*)(Mg + 2204);
            ab0 -= mq[5][0] * xy[8]; ab1 -= mq[5][1] * xy[9]; ab0 -= mq[5][2] * xy[10]; ab1 -= mq[5][3] * xy[11]; mq[5] = *(const LAS f32x4*)(Mg + 2208);
            ab0 -= mq[0][0] * xy[12]; ab1 -= mq[0][1] * xy[13]; ab0 -= mq[0][2] * xy[14]; ab1 -= mq[0][3] * xy[15]; mq[0] = *(const LAS f32x4*)(Mg + 2240);
            ab0 -= mq[1][0] * xy[16]; ab1 -= mq[1][1] * xy[17]; ab0 -= mq[1][2] * xy[18]; ab1 -= mq[1][3] * xy[19]; mq[1] = *(const LAS f32x4*)(Mg + 2244);
            ab0 -= mq[2][0] * xy[20]; ab1 -= mq[2][1] * xy[21]; ab0 -= mq[2][2] * xy[22]; ab1 -= mq[2][3] * xy[23]; mq[2] = *(const LAS f32x4*)(Mg + 2248);
            ab0 -= mq[3][0] * xy[24]; ab1 -= mq[3][1] * xy[25]; ab0 -= mq[3][2] * xy[26]; ab1 -= mq[3][3] * xy[27]; mq[3] = *(const LAS f32x4*)(Mg + 2252);
            ab0 -= mq[4][0] * xy[28]; ab1 -= mq[4][1] * xy[29]; ab0 -= mq[4][2] * xy[30]; ab1 -= mq[4][3] * xy[31]; mq[4] = *(const LAS f32x4*)(Mg + 2256);
            ab0 -= mq[5][0] * xy[32]; ab1 -= mq[5][1] * xy[33]; xy[34] = ab0 + ab1; up[4352] = xy[34][0]; wp[4352] = f2bf(-xy[34][1]); mq[5] = *(const LAS f32x4*)(Mg + 2260);
            { const float br = betg[35]; ab0 = (f32x2){bf2f(*(const LAS bf16_t*)(lg + P5_VS + 9520 + c * 2)) * br, bf2f(*(const LAS bf16_t*)(lg + P5_KS + 9520 + c * 2)) * br * __expf(decg[35])}; ab1 = (f32x2){0.f, 0.f}; } ab0 -= mq[0][0] * xy[0]; ab1 -= mq[0][1] * xy[1]; ab0 -= mq[0][2] * xy[2]; ab1 -= mq[0][3] * xy[3]; mq[0] = *(const LAS f32x4*)(Mg + 2264);
            ab0 -= mq[1][0] * xy[4]; ab1 -= mq[1][1] * xy[5]; ab0 -= mq[1][2] * xy[6]; ab1 -= mq[1][3] * xy[7]; mq[1] = *(const LAS f32x4*)(Mg + 2268);
            ab0 -= mq[2][0] * xy[8]; ab1 -= mq[2][1] * xy[9]; ab0 -= mq[2][2] * xy[10]; ab1 -= mq[2][3] * xy[11]; mq[2] = *(const LAS f32x4*)(Mg + 2272);
            ab0 -= mq[3][0] * xy[12]; ab1 -= mq[3][1] * xy[13]; ab0 -= mq[3][2] * xy[14]; ab1 -= mq[3][3] * xy[15]; mq[3] = *(const LAS f32x4*)(Mg + 2304);
            ab0 -= mq[4][0] * xy[16]; ab1 -= mq[4][1] * xy[17]; ab0 -= mq[4][2] * xy[18]; ab1 -= mq[4][3] * xy[19]; mq[4] = *(const LAS f32x4*)(Mg + 2308);
            ab0 -= mq[5][0] * xy[20]; ab1 -= mq[5][1] * xy[21]; ab0 -= mq[5][2] * xy[22]; ab1 -= mq[5][3] * xy[23]; mq[5] = *(const LAS f32x4*)(Mg + 2312);
            ab0 -= mq[0][0] * xy[24]; ab1 -= mq[0][1] * xy[25]; ab0 -= mq[0][2] * xy[26]; ab1 -= mq[0][3] * xy[27]; mq[0] = *(const LAS f32x4*)(Mg + 2316);
            ab0 -= mq[1][0] * xy[28]; ab1 -= mq[1][1] * xy[29]; ab0 -= mq[1][2] * xy[30]; ab1 -= mq[1][3] * xy[31]; mq[1] = *(const LAS f32x4*)(Mg + 2320);
            ab0 -= mq[2][0] * xy[32]; ab1 -= mq[2][1] * xy[33]; ab0 -= mq[2][2] * xy[34]; xy[35] = ab0 + ab1; up[4480] = xy[35][0]; wp[4480] = f2bf(-xy[35][1]); mq[2] = *(const LAS f32x4*)(Mg + 2324);
            { const float br = betg[36]; ab0 = (f32x2){bf2f(*(const LAS bf16_t*)(lg + P5_VS + 9792 + c * 2)) * br, bf2f(*(const LAS bf16_t*)(lg + P5_KS + 9792 + c * 2)) * br * __expf(decg[36])}; ab1 = (f32x2){0.f, 0.f}; } ab0 -= mq[3][0] * xy[0]; ab1 -= mq[3][1] * xy[1]; ab0 -= mq[3][2] * xy[2]; ab1 -= mq[3][3] * xy[3]; mq[3] = *(const LAS f32x4*)(Mg + 2328);
            ab0 -= mq[4][0] * xy[4]; ab1 -= mq[4][1] * xy[5]; ab0 -= mq[4][2] * xy[6]; ab1 -= mq[4][3] * xy[7]; mq[4] = *(const LAS f32x4*)(Mg + 2332);
            ab0 -= mq[5][0] * xy[8]; ab1 -= mq[5][1] * xy[9]; ab0 -= mq[5][2] * xy[10]; ab1 -= mq[5][3] * xy[11]; mq[5] = *(const LAS f32x4*)(Mg + 2336);
            ab0 -= mq[0][0] * xy[12]; ab1 -= mq[0][1] * xy[13]; ab0 -= mq[0][2] * xy[14]; ab1 -= mq[0][3] * xy[15]; mq[0] = *(const LAS f32x4*)(Mg + 2368);
            ab0 -= mq[1][0] * xy[16]; ab1 -= mq[1][1] * xy[17]; ab0 -= mq[1][2] * xy[18]; ab1 -= mq[1][3] * xy[19]; mq[1] = *(const LAS f32x4*)(Mg + 2372);
            ab0 -= mq[2][0] * xy[20]; ab1 -= mq[2][1] * xy[21]; ab0 -= mq[2][2] * xy[22]; ab1 -= mq[2][3] * xy[23]; mq[2] = *(const LAS f32x4*)(Mg + 2376);
            ab0 -= mq[3][0] * xy[24]; ab1 -= mq[3][1] * xy[25]; ab0 -= mq[3][2] * xy[26]; ab1 -= mq[3][3] * xy[27]; mq[3] = *(const LAS f32x4*)(Mg + 2380);
            ab0 -= mq[4][0] * xy[28]; ab1 -= mq[4][1] * xy[29]; ab0 -= mq[4][2] * xy[30]; ab1 -= mq[4][3] * xy[31]; mq[4] = *(const LAS f32x4*)(Mg + 2384);
            ab0 -= mq[5][0] * xy[32]; ab1 -= mq[5][1] * xy[33]; ab0 -= mq[5][2] * xy[34]; ab1 -= mq[5][3] * xy[35]; xy[36] = ab0 + ab1; up[4608] = xy[36][0]; wp[4608] = f2bf(-xy[36][1]); mq[5] = *(const LAS f32x4*)(Mg + 2388);
            { const float br = betg[37]; ab0 = (f32x2){bf2f(*(const LAS bf16_t*)(lg + P5_VS + 10064 + c * 2)) * br, bf2f(*(const LAS bf16_t*)(lg + P5_KS + 10064 + c * 2)) * br * __expf(decg[37])}; ab1 = (f32x2){0.f, 0.f}; } ab0 -= mq[0][0] * xy[0]; ab1 -= mq[0][1] * xy[1]; ab0 -= mq[0][2] * xy[2]; ab1 -= mq[0][3] * xy[3]; mq[0] = *(const LAS f32x4*)(Mg + 2392);
            ab0 -= mq[1][0] * xy[4]; ab1 -= mq[1][1] * xy[5]; ab0 -= mq[1][2] * xy[6]; ab1 -= mq[1][3] * xy[7]; mq[1] = *(const LAS f32x4*)(Mg + 2396);
            ab0 -= mq[2][0] * xy[8]; ab1 -= mq[2][1] * xy[9]; ab0 -= mq[2][2] * xy[10]; ab1 -= mq[2][3] * xy[11]; mq[2] = *(const LAS f32x4*)(Mg + 2400);
            ab0 -= mq[3][0] * xy[12]; ab1 -= mq[3][1] * xy[13]; ab0 -= mq[3][2] * xy[14]; ab1 -= mq[3][3] * xy[15]; mq[3] = *(const LAS f32x4*)(Mg + 2404);
            ab0 -= mq[4][0] * xy[16]; ab1 -= mq[4][1] * xy[17]; ab0 -= mq[4][2] * xy[18]; ab1 -= mq[4][3] * xy[19]; mq[4] = *(const LAS f32x4*)(Mg + 2432);
            ab0 -= mq[5][0] * xy[20]; ab1 -= mq[5][1] * xy[21]; ab0 -= mq[5][2] * xy[22]; ab1 -= mq[5][3] * xy[23]; mq[5] = *(const LAS f32x4*)(Mg + 2436);
            ab0 -= mq[0][0] * xy[24]; ab1 -= mq[0][1] * xy[25]; ab0 -= mq[0][2] * xy[26]; ab1 -= mq[0][3] * xy[27]; mq[0] = *(const LAS f32x4*)(Mg + 2440);
            ab0 -= mq[1][0] * xy[28]; ab1 -= mq[1][1] * xy[29]; ab0 -= mq[1][2] * xy[30]; ab1 -= mq[1][3] * xy[31]; mq[1] = *(const LAS f32x4*)(Mg + 2444);
            ab0 -= mq[2][0] * xy[32]; ab1 -= mq[2][1] * xy[33]; ab0 -= mq[2][2] * xy[34]; ab1 -= mq[2][3] * xy[35]; mq[2] = *(const LAS f32x4*)(Mg + 2448);
            ab0 -= mq[3][0] * xy[36]; xy[37] = ab0 + ab1; up[4736] = xy[37][0]; wp[4736] = f2bf(-xy[37][1]); mq[3] = *(const LAS f32x4*)(Mg + 2452);
            { const float br = betg[38]; ab0 = (f32x2){bf2f(*(const LAS bf16_t*)(lg + P5_VS + 10336 + c * 2)) * br, bf2f(*(const LAS bf16_t*)(lg + P5_KS + 10336 + c * 2)) * br * __expf(decg[38])}; ab1 = (f32x2){0.f, 0.f}; } ab0 -= mq[4][0] * xy[0]; ab1 -= mq[4][1] * xy[1]; ab0 -= mq[4][2] * xy[2]; ab1 -= mq[4][3] * xy[3]; mq[4] = *(const LAS f32x4*)(Mg + 2456);
            ab0 -= mq[5][0] * xy[4]; ab1 -= mq[5][1] * xy[5]; ab0 -= mq[5][2] * xy[6]; ab1 -= mq[5][3] * xy[7]; mq[5] = *(const LAS f32x4*)(Mg + 2460);
            ab0 -= mq[0][0] * xy[8]; ab1 -= mq[0][1] * xy[9]; ab0 -= mq[0][2] * xy[10]; ab1 -= mq[0][3] * xy[11]; mq[0] = *(const LAS f32x4*)(Mg + 2464);
            ab0 -= mq[1][0] * xy[12]; ab1 -= mq[1][1] * xy[13]; ab0 -= mq[1][2] * xy[14]; ab1 -= mq[1][3] * xy[15]; mq[1] = *(const LAS f32x4*)(Mg + 2468);
            ab0 -= mq[2][0] * xy[16]; ab1 -= mq[2][1] * xy[17]; ab0 -= mq[2][2] * xy[18]; ab1 -= mq[2][3] * xy[19]; mq[2] = *(const LAS f32x4*)(Mg + 2496);
            ab0 -= mq[3][0] * xy[20]; ab1 -= mq[3][1] * xy[21]; ab0 -= mq[3][2] * xy[22]; ab1 -= mq[3][3] * xy[23]; mq[3] = *(const LAS f32x4*)(Mg + 2500);
            ab0 -= mq[4][0] * xy[24]; ab1 -= mq[4][1] * xy[25]; ab0 -= mq[4][2] * xy[26]; ab1 -= mq[4][3] * xy[27]; mq[4] = *(const LAS f32x4*)(Mg + 2504);
            ab0 -= mq[5][0] * xy[28]; ab1 -= mq[5][1] * xy[29]; ab0 -= mq[5][2] * xy[30]; ab1 -= mq[5][3] * xy[31]; mq[5] = *(const LAS f32x4*)(Mg + 2508);
            ab0 -= mq[0][0] * xy[32]; ab1 -= mq[0][1] * xy[33]; ab0 -= mq[0][2] * xy[34]; ab1 -= mq[0][3] * xy[35]; mq[0] = *(const LAS f32x4*)(Mg + 2512);
            ab0 -= mq[1][0] * xy[36]; ab1 -= mq[1][1] * xy[37]; xy[38] = ab0 + ab1; up[4864] = xy[38][0]; wp[4864] = f2bf(-xy[38][1]); mq[1] = *(const LAS f32x4*)(Mg + 2516);
            { const float br = betg[39]; ab0 = (f32x2){bf2f(*(const LAS bf16_t*)(lg + P5_VS + 10608 + c * 2)) * br, bf2f(*(const LAS bf16_t*)(lg + P5_KS + 10608 + c * 2)) * br * __expf(decg[39])}; ab1 = (f32x2){0.f, 0.f}; } ab0 -= mq[2][0] * xy[0]; ab1 -= mq[2][1] * xy[1]; ab0 -= mq[2][2] * xy[2]; ab1 -= mq[2][3] * xy[3]; mq[2] = *(const LAS f32x4*)(Mg + 2520);
            ab0 -= mq[3][0] * xy[4]; ab1 -= mq[3][1] * xy[5]; ab0 -= mq[3][2] * xy[6]; ab1 -= mq[3][3] * xy[7]; mq[3] = *(const LAS f32x4*)(Mg + 2524);
            ab0 -= mq[4][0] * xy[8]; ab1 -= mq[4][1] * xy[9]; ab0 -= mq[4][2] * xy[10]; ab1 -= mq[4][3] * xy[11]; mq[4] = *(const LAS f32x4*)(Mg + 2528);
            ab0 -= mq[5][0] * xy[12]; ab1 -= mq[5][1] * xy[13]; ab0 -= mq[5][2] * xy[14]; ab1 -= mq[5][3] * xy[15]; mq[5] = *(const LAS f32x4*)(Mg + 2532);
            ab0 -= mq[0][0] * xy[16]; ab1 -= mq[0][1] * xy[17]; ab0 -= mq[0][2] * xy[18]; ab1 -= mq[0][3] * xy[19]; mq[0] = *(const LAS f32x4*)(Mg + 2560);
            ab0 -= mq[1][0] * xy[20]; ab1 -= mq[1][1] * xy[21]; ab0 -= mq[1][2] * xy[22]; ab1 -= mq[1][3] * xy[23]; mq[1] = *(const LAS f32x4*)(Mg + 2564);
            ab0 -= mq[2][0] * xy[24]; ab1 -= mq[2][1] * xy[25]; ab0 -= mq[2][2] * xy[26]; ab1 -= mq[2][3] * xy[27]; mq[2] = *(const LAS f32x4*)(Mg + 2568);
            ab0 -= mq[3][0] * xy[28]; ab1 -= mq[3][1] * xy[29]; ab0 -= mq[3][2] * xy[30]; ab1 -= mq[3][3] * xy[31]; mq[3] = *(const LAS f32x4*)(Mg + 2572);
            ab0 -= mq[4][0] * xy[32]; ab1 -= mq[4][1] * xy[33]; ab0 -= mq[4][2] * xy[34]; ab1 -= mq[4][3] * xy[35]; mq[4] = *(const LAS f32x4*)(Mg + 2576);
            ab0 -= mq[5][0] * xy[36]; ab1 -= mq[5][1] * xy[37]; ab0 -= mq[5][2] * xy[38]; xy[39] = ab0 + ab1; up[4992] = xy[39][0]; wp[4992] = f2bf(-xy[39][1]); mq[5] = *(const LAS f32x4*)(Mg + 2580);
            { const float br = betg[40]; ab0 = (f32x2){bf2f(*(const LAS bf16_t*)(lg + P5_VS + 10880 + c * 2)) * br, bf2f(*(const LAS bf16_t*)(lg + P5_KS + 10880 + c * 2)) * br * __expf(decg[40])}; ab1 = (f32x2){0.f, 0.f}; } ab0 -= mq[0][0] * xy[0]; ab1 -= mq[0][1] * xy[1]; ab0 -= mq[0][2] * xy[2]; ab1 -= mq[0][3] * xy[3]; mq[0] = *(const LAS f32x4*)(Mg + 2584);
            ab0 -= mq[1][0] * xy[4]; ab1 -= mq[1][1] * xy[5]; ab0 -= mq[1][2] * xy[6]; ab1 -= mq[1][3] * xy[7]; mq[1] = *(const LAS f32x4*)(Mg + 2588);
            ab0 -= mq[2][0] * xy[8]; ab1 -= mq[2][1] * xy[9]; ab0 -= mq[2][2] * xy[10]; ab1 -= mq[2][3] * xy[11]; mq[2] = *(const LAS f32x4*)(Mg + 2592);
            ab0 -= mq[3][0] * xy[12]; ab1 -= mq[3][1] * xy[13]; ab0 -= mq[3][2] * xy[14]; ab1 -= mq[3][3] * xy[15]; mq[3] = *(const LAS f32x4*)(Mg + 2596);
            ab0 -= mq[4][0] * xy[16]; ab1 -= mq[4][1] * xy[17]; ab0 -= mq[4][2] * xy[18]; ab1 -= mq[4][3] * xy[19]; mq[4] = *(const LAS f32x4*)(Mg + 2624);
            ab0 -= mq[5][0] * xy[20]; ab1 -= mq[5][1] * xy[21]; ab0 -= mq[5][2] * xy[22]; ab1 -= mq[5][3] * xy[23]; mq[5] = *(const LAS f32x4*)(Mg + 2628);
            ab0 -= mq[0][0] * xy[24]; ab1 -= mq[0][1] * xy[25]; ab0 -= mq[0][2] * xy[26]; ab1 -= mq[0][3] * xy[27]; mq[0] = *(const LAS f32x4*)(Mg + 2632);
            ab0 -= mq[1][0] * xy[28]; ab1 -= mq[1][1] * xy[29]; ab0 -= mq[1][2] * xy[30]; ab1 -= mq[1][3] * xy[31]; mq[1] = *(const LAS f32x4*)(Mg + 2636);
            ab0 -= mq[2][0] * xy[32]; ab1 -= mq[2][1] * xy[33]; ab0 -= mq[2][2] * xy[34]; ab1 -= mq[2][3] * xy[35]; mq[2] = *(const LAS f32x4*)(Mg + 2640);
            ab0 -= mq[3][0] * xy[36]; ab1 -= mq[3][1] * xy[37]; ab0 -= mq[3][2] * xy[38]; ab1 -= mq[3][3] * xy[39]; xy[40] = ab0 + ab1; up[5120] = xy[40][0]; wp[5120] = f2bf(-xy[40][1]); mq[3] = *(const LAS f32x4*)(Mg + 2644);
            { const float br = betg[41]; ab0 = (f32x2){bf2f(*(const LAS bf16_t*)(lg + P5_VS + 11152 + c * 2)) * br, bf2f(*(const LAS bf16_t*)(lg + P5_KS + 11152 + c * 2)) * br * __expf(decg[41])}; ab1 = (f32x2){0.f, 0.f}; } ab0 -= mq[4][0] * xy[0]; ab1 -= mq[4][1] * xy[1]; ab0 -= mq[4][2] * xy[2]; ab1 -= mq[4][3] * xy[3]; mq[4] = *(const LAS f32x4*)(Mg + 2648);
            ab0 -= mq[5][0] * xy[4]; ab1 -= mq[5][1] * xy[5]; ab0 -= mq[5][2] * xy[6]; ab1 -= mq[5][3] * xy[7]; mq[5] = *(const LAS f32x4*)(Mg + 2652);
            ab0 -= mq[0][0] * xy[8]; ab1 -= mq[0][1] * xy[9]; ab0 -= mq[0][2] * xy[10]; ab1 -= mq[0][3] * xy[11]; mq[0] = *(const LAS f32x4*)(Mg + 2656);
            ab0 -= mq[1][0] * xy[12]; ab1 -= mq[1][1] * xy[13]; ab0 -= mq[1][2] * xy[14]; ab1 -= mq[1][3] * xy[15]; mq[1] = *(const LAS f32x4*)(Mg + 2660);
            ab0 -= mq[2][0] * xy[16]; ab1 -= mq[2][1] * xy[17]; ab0 -= mq[2][2] * xy[18]; ab1 -= mq[2][3] * xy[19]; mq[2] = *(const LAS f32x4*)(Mg + 2664);
            ab0 -= mq[3][0] * xy[20]; ab1 -= mq[3][1] * xy[21]; ab0 -= mq[3][2] * xy[22]; ab1 -= mq[3][3] * xy[23]; mq[3] = *(const LAS f32x4*)(Mg + 2688);
            ab0 -= mq[4][0] * xy[24]; ab1 -= mq[4][1] * xy[25]; ab0 -= mq[4][2] * xy[26]; ab1 -= mq[4][3] * xy[27]; mq[4] = *(const LAS f32x4*)(Mg + 2692);
            ab0 -= mq[5][0] * xy[28]; ab1 -= mq[5][1] * xy[29]; ab0 -= mq[5][2] * xy[30]; ab1 -= mq[5][3] * xy[31]; mq[5] = *(const LAS f32x4*)(Mg + 2696);
            ab0 -= mq[0][0] * xy[32]; ab1 -= mq[0][1] * xy[33]; ab0 -= mq[0][2] * xy[34]; ab1 -= mq[0][3] * xy[35]; mq[0] = *(const LAS f32x4*)(Mg + 2700);
            ab0 -= mq[1][0] * xy[36]; ab1 -= mq[1][1] * xy[37]; ab0 -= mq[1][2] * xy[38]; ab1 -= mq[1][3] * xy[39]; mq[1] = *(const LAS f32x4*)(Mg + 2704);
            ab0 -= mq[2][0] * xy[40]; xy[41] = ab0 + ab1; up[5248] = xy[41][0]; wp[5248] = f2bf(-xy[41][1]); mq[2] = *(const LAS f32x4*)(Mg + 2708);
            { const float br = betg[42]; ab0 = (f32x2){bf2f(*(const LAS bf16_t*)(lg + P5_VS + 11424 + c * 2)) * br, bf2f(*(const LAS bf16_t*)(lg + P5_KS + 11424 + c * 2)) * br * __expf(decg[42])}; ab1 = (f32x2){0.f, 0.f}; } ab0 -= mq[3][0] * xy[0]; ab1 -= mq[3][1] * xy[1]; ab0 -= mq[3][2] * xy[2]; ab1 -= mq[3][3] * xy[3]; mq[3] = *(const LAS f32x4*)(Mg + 2712);
            ab0 -= mq[4][0] * xy[4]; ab1 -= mq[4][1] * xy[5]; ab0 -= mq[4][2] * xy[6]; ab1 -= mq[4][3] * xy[7]; mq[4] = *(const LAS f32x4*)(Mg + 2716);
            ab0 -= mq[5][0] * xy[8]; ab1 -= mq[5][1] * xy[9]; ab0 -= mq[5][2] * xy[10]; ab1 -= mq[5][3] * xy[11]; mq[5] = *(const LAS f32x4*)(Mg + 2720);
            ab0 -= mq[0][0] * xy[12]; ab1 -= mq[0][1] * xy[13]; ab0 -= mq[0][2] * xy[14]; ab1 -= mq[0][3] * xy[15]; mq[0] = *(const LAS f32x4*)(Mg + 2724);
            ab0 -= mq[1][0] * xy[16]; ab1 -= mq[1][1] * xy[17]; ab0 -= mq[1][2] * xy[18]; ab1 -= mq[1][3] * xy[19]; mq[1] = *(const LAS f32x4*)(Mg + 2728);
            ab0 -= mq[2][0] * xy[20]; ab1 -= mq[2][1] * xy[21]; ab0 -= mq[2][2] * xy[22]; ab1 -= mq[2][3] * xy[23]; mq[2] = *(const LAS f32x4*)(Mg + 2752);
            ab0 -= mq[3][0] * xy[24]; ab1 -= mq[3][1] * xy[25]; ab0 -= mq[3][2] * xy[26]; ab1 -= mq[3][3] * xy[27]; mq[3] = *(const LAS f32x4*)(Mg + 2756);
            ab0 -= mq[4][0] * xy[28]; ab1 -= mq[4][1] * xy[29]; ab0 -= mq[4][2] * xy[30]; ab1 -= mq[4][3] * xy[31]; mq[4] = *(const LAS f32x4*)(Mg + 2760);
            ab0 -= mq[5][0] * xy[32]; ab1 -= mq[5][1] * xy[33]; ab0 -= mq[5][2] * xy[34]; ab1 -= mq[5][3] * xy[35]; mq[5] = *(const LAS f32x4*)(Mg + 2764);
            ab0 -= mq[0][0] * xy[36]; ab1 -= mq[0][1] * xy[37]; ab0 -= mq[0][2] * xy[38]; ab1 -= mq[0][3] * xy[39]; mq[0] = *(const LAS f32x4*)(Mg + 2768);
            ab0 -= mq[1][0] * xy[40]; ab1 -= mq[1][1] * xy[41]; xy[42] = ab0 + ab1; up[5376] = xy[42][0]; wp[5376] = f2bf(-xy[42][1]); mq[1] = *(const LAS f32x4*)(Mg + 2772);
            { const float br = betg[43]; ab0 = (f32x2){bf2f(*(const LAS bf16_t*)(lg + P5_VS + 11696 + c * 2)) * br, bf2f(*(const LAS bf16_t*)(lg + P5_KS + 11696 + c * 2)) * br * __expf(decg[43])}; ab1 = (f32x2){0.f, 0.f}; } ab0 -= mq[2][0] * xy[0]; ab1 -= mq[2][1] * xy[1]; ab0 -= mq[2][2] * xy[2]; ab1 -= mq[2][3] * xy[3]; mq[2] = *(const LAS f32x4*)(Mg + 2776);
            ab0 -= mq[3][0] * xy[4]; ab1 -= mq[3][1] * xy[5]; ab0 -= mq[3][2] * xy[6]; ab1 -= mq[3][3] * xy[7]; mq[3] = *(const LAS f32x4*)(Mg + 2780);
            ab0 -= mq[4][0] * xy[8]; ab1 -= mq[4][1] * xy[9]; ab0 -= mq[4][2] * xy[10]; ab1 -= mq[4][3] * xy[11]; mq[4] = *(const LAS f32x4*)(Mg + 2784);
            ab0 -= mq[5][0] * xy[12]; ab1 -= mq[5][1] * xy[13]; ab0 -= mq[5][2] * xy[14]; ab1 -= mq[5][3] * xy[15]; mq[5] = *(const LAS f32x4*)(Mg + 2788);
            ab0 -= mq[0][0] * xy[16]; ab1 -= mq[0][1] * xy[17]; ab0 -= mq[0][2] * xy[18]; ab1 -= mq[0][3] * xy[19]; mq[0] = *(const LAS f32x4*)(Mg + 2792);
            ab0 -= mq[1][0] * xy[20]; ab1 -= mq[1][1] * xy[21]; ab0 -= mq[1][2] * xy[22]; ab1 -= mq[1][3] * xy[23]; mq[1] = *(const LAS f32x4*)(Mg + 2816);
            ab0 -= mq[2][0] * xy[24]; ab1 -= mq[2][1] * xy[25]; ab0 -= mq[2][2] * xy[26]; ab1 -= mq[2][3] * xy[27]; mq[2] = *(const LAS f32x4*)(Mg + 2820);
            ab0 -= mq[3][0] * xy[28]; ab1 -= mq[3][1] * xy[29]; ab0 -= mq[3][2] * xy[30]; ab1 -= mq[3][3] * xy[31]; mq[3] = *(const LAS f32x4*)(Mg + 2824);
            ab0 -= mq[4][0] * xy[32]; ab1 -= mq[4][1] * xy[33]; ab0 -= mq[4][2] * xy[34]; ab1 -= mq[4][3] * xy[35]; mq[4] = *(const LAS f32x4*)(Mg + 2828);
            ab0 -= mq[5][0] * xy[36]; ab1 -= mq[5][1] * xy[37]; ab0 -= mq[5][2] * xy[38]; ab1 -= mq[5][3] * xy[39]; mq[5] = *(const LAS f32x4*)(Mg + 2832);
            ab0 -= mq[0][0] * xy[40]; ab1 -= mq[0][1] * xy[41]; ab0 -= mq[0][2] * xy[42]; xy[43] = ab0 + ab1; up[5504] = xy[43][0]; wp[5504] = f2bf(-xy[43][1]); mq[0] = *(const LAS f32x4*)(Mg + 2836);
            { const float br = betg[44]; ab0 = (f32x2){bf2f(*(const LAS bf16_t*)(lg + P5_VS + 11968 + c * 2)) * br, bf2f(*(const LAS bf16_t*)(lg + P5_KS + 11968 + c * 2)) * br * __expf(decg[44])}; ab1 = (f32x2){0.f, 0.f}; } ab0 -= mq[1][0] * xy[0]; ab1 -= mq[1][1] * xy[1]; ab0 -= mq[1][2] * xy[2]; ab1 -= mq[1][3] * xy[3]; mq[1] = *(const LAS f32x4*)(Mg + 2840);
            ab0 -= mq[2][0] * xy[4]; ab1 -= mq[2][1] * xy[5]; ab0 -= mq[2][2] * xy[6]; ab1 -= mq[2][3] * xy[7]; mq[2] = *(const LAS f32x4*)(Mg + 2844);
            ab0 -= mq[3][0] * xy[8]; ab1 -= mq[3][1] * xy[9]; ab0 -= mq[3][2] * xy[10]; ab1 -= mq[3][3] * xy[11]; mq[3] = *(const LAS f32x4*)(Mg + 2848);
            ab0 -= mq[4][0] * xy[12]; ab1 -= mq[4][1] * xy[13]; ab0 -= mq[4][2] * xy[14]; ab1 -= mq[4][3] * xy[15]; mq[4] = *(const LAS f32x4*)(Mg + 2852);
            ab0 -= mq[5][0] * xy[16]; ab1 -= mq[5][1] * xy[17]; ab0 -= mq[5][2] * xy[18]; ab1 -= mq[5][3] * xy[19]; mq[5] = *(const LAS f32x4*)(Mg + 2856);
            ab0 -= mq[0][0] * xy[20]; ab1 -= mq[0][1] * xy[21]; ab0 -= mq[0][2] * xy[22]; ab1 -= mq[0][3] * xy[23]; mq[0] = *(const LAS f32x4*)(Mg + 2880);
            ab0 -= mq[1][0] * xy[24]; ab1 -= mq[1][1] * xy[25]; ab0 -= mq[1][2] * xy[26]; ab1 -= mq[1][3] * xy[27]; mq[1] = *(const LAS f32x4*)(Mg + 2884);
            ab0 -= mq[2][0] * xy[28]; ab1 -= mq[2][1] * xy[29]; ab0 -= mq[2][2] * xy[30]; ab1 -= mq[2][3] * xy[31]; mq[2] = *(const LAS f32x4*)(Mg + 2888);
            ab0 -= mq[3][0] * xy[32]; ab1 -= mq[3][1] * xy[33]; ab0 -= mq[3][2] * xy[34]; ab1 -= mq[3][3] * xy[35]; mq[3] = *(const LAS f32x4*)(Mg + 2892);
            ab0 -= mq[4][0] * xy[36]; ab1 -= mq[4][1] * xy[37]; ab0 -= mq[4][2] * xy[38]; ab1 -= mq[4][3] * xy[39]; mq[4] = *(const LAS f32x4*)(Mg + 2896);
            ab0 -= mq[5][0] * xy[40]; ab1 -= mq[5][1] * xy[41]; ab0 -= mq[5][2] * xy[42]; ab1 -= mq[5][3] * xy[43]; xy[44] = ab0 + ab1; up[5632] = xy[44][0]; wp[5632] = f2bf(-xy[44][1]); mq[5] = *(const LAS f32x4*)(Mg + 2900);
            { const float br = betg[45]; ab0 = (f32x2){bf2f(*(const LAS bf16_t*)(lg + P5_VS + 12240 + c * 2)) * br, bf2f(*(const LAS bf16_t*)(lg + P5_KS + 12240 + c * 2)) * br * __expf(decg[45])}; ab1 = (f32x2){0.f, 0.f}; } ab0 -= mq[0][0] * xy[0]; ab1 -= mq[0][1] * xy[1]; ab0 -= mq[0][2] * xy[2]; ab1 -= mq[0][3] * xy[3]; mq[0] = *(const LAS f32x4*)(Mg + 2904);
            ab0 -= mq[1][0] * xy[4]; ab1 -= mq[1][1] * xy[5]; ab0 -= mq[1][2] * xy[6]; ab1 -= mq[1][3] * xy[7]; mq[1] = *(const LAS f32x4*)(Mg + 2908);
            ab0 -= mq[2][0] * xy[8]; ab1 -= mq[2][1] * xy[9]; ab0 -= mq[2][2] * xy[10]; ab1 -= mq[2][3] * xy[11]; mq[2] = *(const LAS f32x4*)(Mg + 2912);
            ab0 -= mq[3][0] * xy[12]; ab1 -= mq[3][1] * xy[13]; ab0 -= mq[3][2] * xy[14]; ab1 -= mq[3][3] * xy[15]; mq[3] = *(const LAS f32x4*)(Mg + 2916);
            ab0 -= mq[4][0] * xy[16]; ab1 -= mq[4][1] * xy[17]; ab0 -= mq[4][2] * xy[18]; ab1 -= mq[4][3] * xy[19]; mq[4] = *(const LAS f32x4*)(Mg + 2920);
            ab0 -= mq[5][0] * xy[20]; ab1 -= mq[5][1] * xy[21]; ab0 -= mq[5][2] * xy[22]; ab1 -= mq[5][3] * xy[23]; mq[5] = *(const LAS f32x4*)(Mg + 2924);
            ab0 -= mq[0][0] * xy[24]; ab1 -= mq[0][1] * xy[25]; ab0 -= mq[0][2] * xy[26]; ab1 -= mq[0][3] * xy[27]; mq[0] = *(const LAS f32x4*)(Mg + 2944);
            ab0 -= mq[1][0] * xy[28]; ab1 -= mq[1][1] * xy[29]; ab0 -= mq[1][2] * xy[30]; ab1 -= mq[1][3] * xy[31]; mq[1] = *(const LAS f32x4*)(Mg + 2948);
            ab0 -= mq[2][0] * xy[32]; ab1 -= mq[2][1] * xy[33]; ab0 -= mq[2][2] * xy[34]; ab1 -= mq[2][3] * xy[35]; mq[2] = *(const LAS f32x4*)(Mg + 2952);
            ab0 -= mq[3][0] * xy[36]; ab1 -= mq[3][1] * xy[37]; ab0 -= mq[3][2] * xy[38]; ab1 -= mq[3][3] * xy[39]; mq[3] = *(const LAS f32x4*)(Mg + 2956);
            ab0 -= mq[4][0] * xy[40]; ab1 -= mq[4][1] * xy[41]; ab0 -= mq[4][2] * xy[42]; ab1 -= mq[4][3] * xy[43]; mq[4] = *(const LAS f32x4*)(Mg + 2960);
            ab0 -= mq[5][0] * xy[44]; xy[45] = ab0 + ab1; up[5760] = xy[45][0]; wp[5760] = f2bf(-xy[45][1]); mq[5] = *(const LAS f32x4*)(Mg + 2964);
            { const float br = betg[46]; ab0 = (f32x2){bf2f(*(const LAS bf16_t*)(lg + P5_VS + 12512 + c * 2)) * br, bf2f(*(const LAS bf16_t*)(lg + P5_KS + 12512 + c * 2)) * br * __expf(decg[46])}; ab1 = (f32x2){0.f, 0.f}; } ab0 -= mq[0][0] * xy[0]; ab1 -= mq[0][1] * xy[1]; ab0 -= mq[0][2] * xy[2]; ab1 -= mq[0][3] * xy[3]; mq[0] = *(const LAS f32x4*)(Mg + 2968);
            ab0 -= mq[1][0] * xy[4]; ab1 -= mq[1][1] * xy[5]; ab0 -= mq[1][2] * xy[6]; ab1 -= mq[1][3] * xy[7]; mq[1] = *(const LAS f32x4*)(Mg + 2972);
            ab0 -= mq[2][0] * xy[8]; ab1 -= mq[2][1] * xy[9]; ab0 -= mq[2][2] * xy[10]; ab1 -= mq[2][3] * xy[11]; mq[2] = *(const LAS f32x4*)(Mg + 2976);
            ab0 -= mq[3][0] * xy[12]; ab1 -= mq[3][1] * xy[13]; ab0 -= mq[3][2] * xy[14]; ab1 -= mq[3][3] * xy[15]; mq[3] = *(const LAS f32x4*)(Mg + 2980);
            ab0 -= mq[4][0] * xy[16]; ab1 -= mq[4][1] * xy[17]; ab0 -= mq[4][2] * xy[18]; ab1 -= mq[4][3] * xy[19]; mq[4] = *(const LAS f32x4*)(Mg + 2984);
            ab0 -= mq[5][0] * xy[20]; ab1 -= mq[5][1] * xy[21]; ab0 -= mq[5][2] * xy[22]; ab1 -= mq[5][3] * xy[23]; mq[5] = *(const LAS f32x4*)(Mg + 2988);
            ab0 -= mq[0][0] * xy[24]; ab1 -= mq[0][1] * xy[25]; ab0 -= mq[0][2] * xy[26]; ab1 -= mq[0][3] * xy[27]; mq[0] = *(const LAS f32x4*)(Mg + 3008);
            ab0 -= mq[1][0] * xy[28]; ab1 -= mq[1][1] * xy[29]; ab0 -= mq[1][2] * xy[30]; ab1 -= mq[1][3] * xy[31]; mq[1] = *(const LAS f32x4*)(Mg + 3012);
            ab0 -= mq[2][0] * xy[32]; ab1 -= mq[2][1] * xy[33]; ab0 -= mq[2][2] * xy[34]; ab1 -= mq[2][3] * xy[35]; mq[2] = *(const LAS f32x4*)(Mg + 3016);
            ab0 -= mq[3][0] * xy[36]; ab1 -= mq[3][1] * xy[37]; ab0 -= mq[3][2] * xy[38]; ab1 -= mq[3][3] * xy[39]; mq[3] = *(const LAS f32x4*)(Mg + 3020);
            ab0 -= mq[4][0] * xy[40]; ab1 -= mq[4][1] * xy[41]; ab0 -= mq[4][2] * xy[42]; ab1 -= mq[4][3] * xy[43]; mq[4] = *(const LAS f32x4*)(Mg + 3024);
            ab0 -= mq[5][0] * xy[44]; ab1 -= mq[5][1] * xy[45]; xy[46] = ab0 + ab1; up[5888] = xy[46][0]; wp[5888] = f2bf(-xy[46][1]); mq[5] = *(const LAS f32x4*)(Mg + 3028);
            { const float br = betg[47]; ab0 = (f32x2){bf2f(*(const LAS bf16_t*)(lg + P5_VS + 12784 + c * 2)) * br, bf2f(*(const LAS bf16_t*)(lg + P5_KS + 12784 + c * 2)) * br * __expf(decg[47])}; ab1 = (f32x2){0.f, 0.f}; } ab0 -= mq[0][0] * xy[0]; ab1 -= mq[0][1] * xy[1]; ab0 -= mq[0][2] * xy[2]; ab1 -= mq[0][3] * xy[3]; mq[0] = *(const LAS f32x4*)(Mg + 3032);
            ab0 -= mq[1][0] * xy[4]; ab1 -= mq[1][1] * xy[5]; ab0 -= mq[1][2] * xy[6]; ab1 -= mq[1][3] * xy[7]; mq[1] = *(const LAS f32x4*)(Mg + 3036);
            ab0 -= mq[2][0] * xy[8]; ab1 -= mq[2][1] * xy[9]; ab0 -= mq[2][2] * xy[10]; ab1 -= mq[2][3] * xy[11]; mq[2] = *(const LAS f32x4*)(Mg + 3040);
            ab0 -= mq[3][0] * xy[12]; ab1 -= mq[3][1] * xy[13]; ab0 -= mq[3][2] * xy[14]; ab1 -= mq[3][3] * xy[15]; mq[3] = *(const LAS f32x4*)(Mg + 3044);
            ab0 -= mq[4][0] * xy[16]; ab1 -= mq[4][1] * xy[17]; ab0 -= mq[4][2] * xy[18]; ab1 -= mq[4][3] * xy[19]; mq[4] = *(const LAS f32x4*)(Mg + 3048);
            ab0 -= mq[5][0] * xy[20]; ab1 -= mq[5][1] * xy[21]; ab0 -= mq[5][2] * xy[22]; ab1 -= mq[5][3] * xy[23]; mq[5] = *(const LAS f32x4*)(Mg + 3052);
            ab0 -= mq[0][0] * xy[24]; ab1 -= mq[0][1] * xy[25]; ab0 -= mq[0][2] * xy[26]; ab1 -= mq[0][3] * xy[27]; mq[0] = *(const LAS f32x4*)(Mg + 3072);
            ab0 -= mq[1][0] * xy[28]; ab1 -= mq[1][1] * xy[29]; ab0 -= mq[1][2] * xy[30]; ab1 -= mq[1][3] * xy[31]; mq[1] = *(const LAS f32x4*)(Mg + 3076);
            ab0 -= mq[2][0] * xy[32]; ab1 -= mq[2][1] * xy[33]; ab0 -= mq[2][2] * xy[34]; ab1 -= mq[2][3] * xy[35]; mq[2] = *(const LAS f32x4*)(Mg + 3080);
            ab0 -= mq[3][0] * xy[36]; ab1 -= mq[3][1] * xy[37]; ab0 -= mq[3][2] * xy[38]; ab1 -= mq[3][3] * xy[39]; mq[3] = *(const LAS f32x4*)(Mg + 3084);
            ab0 -= mq[4][0] * xy[40]; ab1 -= mq[4][1] * xy[41]; ab0 -= mq[4][2] * xy[42]; ab1 -= mq[4][3] * xy[43]; mq[4] = *(const LAS f32x4*)(Mg + 3088);
            ab0 -= mq[5][0] * xy[44]; ab1 -= mq[5][1] * xy[45]; ab0 -= mq[5][2] * xy[46]; xy[47] = ab0 + ab1; up[6016] = xy[47][0]; wp[6016] = f2bf(-xy[47][1]); mq[5] = *(const LAS f32x4*)(Mg + 3092);
            { const float br = betg[48]; ab0 = (f32x2){bf2f(*(const LAS bf16_t*)(lg + P5_VS + 13056 + c * 2)) * br, bf2f(*(const LAS bf16_t*)(lg + P5_KS + 13056 + c * 2)) * br * __expf(decg[48])}; ab1 = (f32x2){0.f, 0.f}; } ab0 -= mq[0][0] * xy[0]; ab1 -= mq[0][1] * xy[1]; ab0 -= mq[0][2] * xy[2]; ab1 -= mq[0][3] * xy[3]; mq[0] = *(const LAS f32x4*)(Mg + 3096);
            ab0 -= mq[1][0] * xy[4]; ab1 -= mq[1][1] * xy[5]; ab0 -= mq[1][2] * xy[6]; ab1 -= mq[1][3] * xy[7]; mq[1] = *(const LAS f32x4*)(Mg + 3100);
            ab0 -= mq[2][0] * xy[8]; ab1 -= mq[2][1] * xy[9]; ab0 -= mq[2][2] * xy[10]; ab1 -= mq[2][3] * xy[11]; mq[2] = *(const LAS f32x4*)(Mg + 3104);
            ab0 -= mq[3][0] * xy[12]; ab1 -= mq[3][1] * xy[13]; ab0 -= mq[3][2] * xy[14]; ab1 -= mq[3][3] * xy[15]; mq[3] = *(const LAS f32x4*)(Mg + 3108);
            ab0 -= mq[4][0] * xy[16]; ab1 -= mq[4][1] * xy[17]; ab0 -= mq[4][2] * xy[18]; ab1 -= mq[4][3] * xy[19]; mq[4] = *(const LAS f32x4*)(Mg + 3112);
            ab0 -= mq[5][0] * xy[20]; ab1 -= mq[5][1] * xy[21]; ab0 -= mq[5][2] * xy[22]; ab1 -= mq[5][3] * xy[23]; mq[5] = *(const LAS f32x4*)(Mg + 3116);
            ab0 -= mq[0][0] * xy[24]; ab1 -= mq[0][1] * xy[25]; ab0 -= mq[0][2] * xy[26]; ab1 -= mq[0][3] * xy[27]; mq[0] = *(const LAS f32x4*)(Mg + 3136);
            ab0 -= mq[1][0] * xy[28]; ab1 -= mq[1][1] * xy[29]; ab0 -= mq[1][2] * xy[30]; ab1 -= mq[1][3] * xy[31]; mq[1] = *(const LAS f32x4*)(Mg + 3140);
            ab0 -= mq[2][0] * xy[32]; ab1 -= mq[2][1] * xy[33]; ab0 -= mq[2][2] * xy[34]; ab1 -= mq[2][3] * xy[35]; mq[2] = *(const LAS f32x4*)(Mg + 3144);
            ab0 -= mq[3][0] * xy[36]; ab1 -= mq[3][1] * xy[37]; ab0 -= mq[3][2] * xy[38]; ab1 -= mq[3][3] * xy[39]; mq[3] = *(const LAS f32x4*)(Mg + 3148);
            ab0 -= mq[4][0] * xy[40]; ab1 -= mq[4][1] * xy[41]; ab0 -= mq[4][2] * xy[42]; ab1 -= mq[4][3] * xy[43]; mq[4] = *(const LAS f32x4*)(Mg + 3152);
            ab0 -= mq[5][0] * xy[44]; ab1 -= mq[5][1] * xy[45]; ab0 -= mq[5][2] * xy[46]; ab1 -= mq[5][3] * xy[47]; xy[48] = ab0 + ab1; up[6144] = xy[48][0]; wp[6144] = f2bf(-xy[48][1]); mq[5] = *(const LAS f32x4*)(Mg + 3156);
            { const float br = betg[49]; ab0 = (f32x2){bf2f(*(const LAS bf16_t*)(lg + P5_VS + 13328 + c * 2)) * br, bf2f(*(const LAS bf16_t*)(lg + P5_KS + 13328 + c * 2)) * br * __expf(decg[49])}; ab1 = (f32x2){0.f, 0.f}; } ab0 -= mq[0][0] * xy[0]; ab1 -= mq[0][1] * xy[1]; ab0 -= mq[0][2] * xy[2]; ab1 -= mq[0][3] * xy[3]; mq[0] = *(const LAS f32x4*)(Mg + 3160);
            ab0 -= mq[1][0] * xy[4]; ab1 -= mq[1][1] * xy[5]; ab0 -= mq[1][2] * xy[6]; ab1 -= mq[1][3] * xy[7]; mq[1] = *(const LAS f32x4*)(Mg + 3164);
            ab0 -= mq[2][0] * xy[8]; ab1 -= mq[2][1] * xy[9]; ab0 -= mq[2][2] * xy[10]; ab1 -= mq[2][3] * xy[11]; mq[2] = *(const LAS f32x4*)(Mg + 3168);
            ab0 -= mq[3][0] * xy[12]; ab1 -= mq[3][1] * xy[13]; ab0 -= mq[3][2] * xy[14]; ab1 -= mq[3][3] * xy[15]; mq[3] = *(const LAS f32x4*)(Mg + 3172);
            ab0 -= mq[4][0] * xy[16]; ab1 -= mq[4][1] * xy[17]; ab0 -= mq[4][2] * xy[18]; ab1 -= mq[4][3] * xy[19]; mq[4] = *(const LAS f32x4*)(Mg + 3176);
            ab0 -= mq[5][0] * xy[20]; ab1 -= mq[5][1] * xy[21]; ab0 -= mq[5][2] * xy[22]; ab1 -= mq[5][3] * xy[23]; mq[5] = *(const LAS f32x4*)(Mg + 3180);
            ab0 -= mq[0][0] * xy[24]; ab1 -= mq[0][1] * xy[25]; ab0 -= mq[0][2] * xy[26]; ab1 -= mq[0][3] * xy[27]; mq[0] = *(const LAS f32x4*)(Mg + 3184);
            ab0 -= mq[1][0] * xy[28]; ab1 -= mq[1][1] * xy[29]; ab0 -= mq[1][2] * xy[30]; ab1 -= mq[1][3] * xy[31]; mq[1] = *(const LAS f32x4*)(Mg + 3200);
            ab0 -= mq[2][0] * xy[32]; ab1 -= mq[2][1] * xy[33]; ab0 -= mq[2][2] * xy[34]; ab1 -= mq[2][3] * xy[35]; mq[2] = *(const LAS f32x4*)(Mg + 3204);
            ab0 -= mq[3][0] * xy[36]; ab1 -= mq[3][1] * xy[37]; ab0 -= mq[3][2] * xy[38]; ab1 -= mq[3][3] * xy[39]; mq[3] = *(const LAS f32x4*)(Mg + 3208);
            ab0 -= mq[4][0] * xy[40]; ab1 -= mq[4][1] * xy[41]; ab0 -= mq[4][2] * xy[42]; ab1 -= mq[4][3] * xy[43]; mq[4] = *(const LAS f32x4*)(Mg + 3212);
            ab0 -= mq[5][0] * xy[44]; ab1 -= mq[5][1] * xy[45]; ab0 -= mq[5][2] * xy[46]; ab1 -= mq[5][3] * xy[47]; mq[5] = *(const LAS f32x4*)(Mg + 3216);
            ab0 -= mq[0][0] * xy[48]; xy[49] = ab0 + ab1; up[6272] = xy[49][0]; wp[6272] = f2bf(-xy[49][1]); mq[0] = *(const LAS f32x4*)(Mg + 3220);
            { const float br = betg[50]; ab0 = (f32x2){bf2f(*(const LAS bf16_t*)(lg + P5_VS + 13600 + c * 2)) * br, bf2f(*(const LAS bf16_t*)(lg + P5_KS + 13600 + c * 2)) * br * __expf(decg[50])}; ab1 = (f32x2){0.f, 0.f}; } ab0 -= mq[1][0] * xy[0]; ab1 -= mq[1][1] * xy[1]; ab0 -= mq[1][2] * xy[2]; ab1 -= mq[1][3] * xy[3]; mq[1] = *(const LAS f32x4*)(Mg + 3224);
            ab0 -= mq[2][0] * xy[4]; ab1 -= mq[2][1] * xy[5]; ab0 -= mq[2][2] * xy[6]; ab1 -= mq[2][3] * xy[7]; mq[2] = *(const LAS f32x4*)(Mg + 3228);
            ab0 -= mq[3][0] * xy[8]; ab1 -= mq[3][1] * xy[9]; ab0 -= mq[3][2] * xy[10]; ab1 -= mq[3][3] * xy[11]; mq[3] = *(const LAS f32x4*)(Mg + 3232);
            ab0 -= mq[4][0] * xy[12]; ab1 -= mq[4][1] * xy[13]; ab0 -= mq[4][2] * xy[14]; ab1 -= mq[4][3] * xy[15]; mq[4] = *(const LAS f32x4*)(Mg + 3236);
            ab0 -= mq[5][0] * xy[16]; ab1 -= mq[5][1] * xy[17]; ab0 -= mq[5][2] * xy[18]; ab1 -= mq[5][3] * xy[19]; mq[5] = *(const LAS f32x4*)(Mg + 3240);
            ab0 -= mq[0][0] * xy[20]; ab1 -= mq[0][1] * xy[21]; ab0 -= mq[0][2] * xy[22]; ab1 -= mq[0][3] * xy[23]; mq[0] = *(const LAS f32x4*)(Mg + 3244);
            ab0 -= mq[1][0] * xy[24]; ab1 -= mq[1][1] * xy[25]; ab0 -= mq[1][2] * xy[26]; ab1 -= mq[1][3] * xy[27]; mq[1] = *(const LAS f32x4*)(Mg + 3248);
            ab0 -= mq[2][0] * xy[28]; ab1 -= mq[2][1] * xy[29]; ab0 -= mq[2][2] * xy[30]; ab1 -= mq[2][3] * xy[31]; mq[2] = *(const LAS f32x4*)(Mg + 3264);
            ab0 -= mq[3][0] * xy[32]; ab1 -= mq[3][1] * xy[33]; ab0 -= mq[3][2] * xy[34]; ab1 -= mq[3][3] * xy[35]; mq[3] = *(const LAS f32x4*)(Mg + 3268);
            ab0 -= mq[4][0] * xy[36]; ab1 -= mq[4][1] * xy[37]; ab0 -= mq[4][2] * xy[38]; ab1 -= mq[4][3] * xy[39]; mq[4] = *(const LAS f32x4*)(Mg + 3272);
            ab0 -= mq[5][0] * xy[40]; ab1 -= mq[5][1] * xy[41]; ab0 -= mq[5][2] * xy[42]; ab1 -= mq[5][3] * xy[43]; mq[5] = *(const LAS f32x4*)(Mg + 3276);
            ab0 -= mq[0][0] * xy[44]; ab1 -= mq[0][1] * xy[45]; ab0 -= mq[0][2] * xy[46]; ab1 -= mq[0][3] * xy[47]; mq[0] = *(const LAS f32x4*)(Mg + 3280);
            ab0 -= mq[1][0] * xy[48]; ab1 -= mq[1][1] * xy[49]; xy[50] = ab0 + ab1; up[6400] = xy[50][0]; wp[6400] = f2bf(-xy[50][1]); mq[1] = *(const LAS f32x4*)(Mg + 3284);
            { const float br = betg[51]; ab0 = (f32x2){bf2f(*(const LAS bf16_t*)(lg + P5_VS + 13872 + c * 2)) * br, bf2f(*(const LAS bf16_t*)(lg + P5_KS + 13872 + c * 2)) * br * __expf(decg[51])}; ab1 = (f32x2){0.f, 0.f}; } ab0 -= mq[2][0] * xy[0]; ab1 -= mq[2][1] * xy[1]; ab0 -= mq[2][2] * xy[2]; ab1 -= mq[2][3] * xy[3]; mq[2] = *(const LAS f32x4*)(Mg + 3288);
            ab0 -= mq[3][0] * xy[4]; ab1 -= mq[3][1] * xy[5]; ab0 -= mq[3][2] * xy[6]; ab1 -= mq[3][3] * xy[7]; mq[3] = *(const LAS f32x4*)(Mg + 3292);
            ab0 -= mq[4][0] * xy[8]; ab1 -= mq[4][1] * xy[9]; ab0 -= mq[4][2] * xy[10]; ab1 -= mq[4][3] * xy[11]; mq[4] = *(const LAS f32x4*)(Mg + 3296);
            ab0 -= mq[5][0] * xy[12]; ab1 -= mq[5][1] * xy[13]; ab0 -= mq[5][2] * xy[14]; ab1 -= mq[5][3] * xy[15]; mq[5] = *(const LAS f32x4*)(Mg + 3300);
            ab0 -= mq[0][0] * xy[16]; ab1 -= mq[0][1] * xy[17]; ab0 -= mq[0][2] * xy[18]; ab1 -= mq[0][3] * xy[19]; mq[0] = *(const LAS f32x4*)(Mg + 3304);
            ab0 -= mq[1][0] * xy[20]; ab1 -= mq[1][1] * xy[21]; ab0 -= mq[1][2] * xy[22]; ab1 -= mq[1][3] * xy[23]; mq[1] = *(const LAS f32x4*)(Mg + 3308);
            ab0 -= mq[2][0] * xy[24]; ab1 -= mq[2][1] * xy[25]; ab0 -= mq[2][2] * xy[26]; ab1 -= mq[2][3] * xy[27]; mq[2] = *(const LAS f32x4*)(Mg + 3312);
            ab0 -= mq[3][0] * xy[28]; ab1 -= mq[3][1] * xy[29]; ab0 -= mq[3][2] * xy[30]; ab1 -= mq[3][3] * xy[31]; mq[3] = *(const LAS f32x4*)(Mg + 3328);
            ab0 -= mq[4][0] * xy[32]; ab1 -= mq[4][1] * xy[33]; ab0 -= mq[4][2] * xy[34]; ab1 -= mq[4][3] * xy[35]; mq[4] = *(const LAS f32x4*)(Mg + 3332);
            ab0 -= mq[5][0] * xy[36]; ab1 -= mq[5][1] * xy[37]; ab0 -= mq[5][2] * xy[38]; ab1 -= mq[5][3] * xy[39]; mq[5] = *(const LAS f32x4*)(Mg + 3336);
            ab0 -= mq[0][0] * xy[40]; ab1 -= mq[0][1] * xy[41]; ab0 -= mq[0][2] * xy[42]; ab1 -= mq[0][3] * xy[43]; mq[0] = *(const LAS f32x4*)(Mg + 3340);
            ab0 -= mq[1][0] * xy[44]; ab1 -= mq[1][1] * xy[45]; ab0 -= mq[1][2] * xy[46]; ab1 -= mq[1][3] * xy[47]; mq[1] = *(const LAS f32x4*)(Mg + 3344);
            ab0 -= mq[2][0] * xy[48]; ab1 -= mq[2][1] * xy[49]; ab0 -= mq[2][2] * xy[50]; xy[51] = ab0 + ab1; up[6528] = xy[51][0]; wp[6528] = f2bf(-xy[51][1]); mq[2] = *(const LAS f32x4*)(Mg + 3348);
            { const float br = betg[52]; ab0 = (f32x2){bf2f(*(const LAS bf16_t*)(lg + P5_VS + 14144 + c * 2)) * br, bf2f(*(const LAS bf16_t*)(lg + P5_KS + 14144 + c * 2)) * br * __expf(decg[52])}; ab1 = (f32x2){0.f, 0.f}; } ab0 -= mq[3][0] * xy[0]; ab1 -= mq[3][1] * xy[1]; ab0 -= mq[3][2] * xy[2]; ab1 -= mq[3][3] * xy[3]; mq[3] = *(const LAS f32x4*)(Mg + 3352);
            ab0 -= mq[4][0] * xy[4]; ab1 -= mq[4][1] * xy[5]; ab0 -= mq[4][2] * xy[6]; ab1 -= mq[4][3] * xy[7]; mq[4] = *(const LAS f32x4*)(Mg + 3356);
            ab0 -= mq[5][0] * xy[8]; ab1 -= mq[5][1] * xy[9]; ab0 -= mq[5][2] * xy[10]; ab1 -= mq[5][3] * xy[11]; mq[5] = *(const LAS f32x4*)(Mg + 3360);
            ab0 -= mq[0][0] * xy[12]; ab1 -= mq[0][1] * xy[13]; ab0 -= mq[0][2] * xy[14]; ab1 -= mq[0][3] * xy[15]; mq[0] = *(const LAS f32x4*)(Mg + 3364);
            ab0 -= mq[1][0] * xy[16]; ab1 -= mq[1][1] * xy[17]; ab0 -= mq[1][2] * xy[18]; ab1 -= mq[1][3] * xy[19]; mq[1] = *(const LAS f32x4*)(Mg + 3368);
            ab0 -= mq[2][0] * xy[20]; ab1 -= mq[2][1] * xy[21]; ab0 -= mq[2][2] * xy[22]; ab1 -= mq[2][3] * xy[23]; mq[2] = *(const LAS f32x4*)(Mg + 3372);
            ab0 -= mq[3][0] * xy[24]; ab1 -= mq[3][1] * xy[25]; ab0 -= mq[3][2] * xy[26]; ab1 -= mq[3][3] * xy[27]; mq[3] = *(const LAS f32x4*)(Mg + 3376);
            ab0 -= mq[4][0] * xy[28]; ab1 -= mq[4][1] * xy[29]; ab0 -= mq[4][2] * xy[30]; ab1 -= mq[4][3] * xy[31]; mq[4] = *(const LAS f32x4*)(Mg + 3392);
            ab0 -= mq[5][0] * xy[32]; ab1 -= mq[5][1] * xy[33]; ab0 -= mq[5][2] * xy[34]; ab1 -= mq[5][3] * xy[35]; mq[5] = *(const LAS f32x4*)(Mg + 3396);
            ab0 -= mq[0][0] * xy[36]; ab1 -= mq[0][1] * xy[37]; ab0 -= mq[0][2] * xy[38]; ab1 -= mq[0][3] * xy[39]; mq[0] = *(const LAS f32x4*)(Mg + 3400);
            ab0 -= mq[1][0] * xy[40]; ab1 -= mq[1][1] * xy[41]; ab0 -= mq[1][2] * xy[42]; ab1 -= mq[1][3] * xy[43]; mq[1] = *(const LAS f32x4*)(Mg + 3404);
            ab0 -= mq[2][0] * xy[44]; ab1 -= mq[2][1] * xy[45]; ab0 -= mq[2][2] * xy[46]; ab1 -= mq[2][3] * xy[47]; mq[2] = *(const LAS f32x4*)(Mg + 3408);
            ab0 -= mq[3][0] * xy[48]; ab1 -= mq[3][1] * xy[49]; ab0 -= mq[3][2] * xy[50]; ab1 -= mq[3][3] * xy[51]; xy[52] = ab0 + ab1; up[6656] = xy[52][0]; wp[6656] = f2bf(-xy[52][1]); mq[3] = *(const LAS f32x4*)(Mg + 3412);
            { const float br = betg[53]; ab0 = (f32x2){bf2f(*(const LAS bf16_t*)(lg + P5_VS + 14416 + c * 2)) * br, bf2f(*(const LAS bf16_t*)(lg + P5_KS + 14416 + c * 2)) * br * __expf(decg[53])}; ab1 = (f32x2){0.f, 0.f}; } ab0 -= mq[4][0] * xy[0]; ab1 -= mq[4][1] * xy[1]; ab0 -= mq[4][2] * xy[2]; ab1 -= mq[4][3] * xy[3]; mq[4] = *(const LAS f32x4*)(Mg + 3416);
            ab0 -= mq[5][0] * xy[4]; ab1 -= mq[5][1] * xy[5]; ab0 -= mq[5][2] * xy[6]; ab1 -= mq[5][3] * xy[7]; mq[5] = *(const LAS f32x4*)(Mg + 3420);
            ab0 -= mq[0][0] * xy[8]; ab1 -= mq[0][1] * xy[9]; ab0 -= mq[0][2] * xy[10]; ab1 -= mq[0][3] * xy[11]; mq[0] = *(const LAS f32x4*)(Mg + 3424);
            ab0 -= mq[1][0] * xy[12]; ab1 -= mq[1][1] * xy[13]; ab0 -= mq[1][2] * xy[14]; ab1 -= mq[1][3] * xy[15]; mq[1] = *(const LAS f32x4*)(Mg + 3428);
            ab0 -= mq[2][0] * xy[16]; ab1 -= mq[2][1] * xy[17]; ab0 -= mq[2][2] * xy[18]; ab1 -= mq[2][3] * xy[19]; mq[2] = *(const LAS f32x4*)(Mg + 3432);
            ab0 -= mq[3][0] * xy[20]; ab1 -= mq[3][1] * xy[21]; ab0 -= mq[3][2] * xy[22]; ab1 -= mq[3][3] * xy[23]; mq[3] = *(const LAS f32x4*)(Mg + 3436);
            ab0 -= mq[4][0] * xy[24]; ab1 -= mq[4][1] * xy[25]; ab0 -= mq[4][2] * xy[26]; ab1 -= mq[4][3] * xy[27]; mq[4] = *(const LAS f32x4*)(Mg + 3440);
            ab0 -= mq[5][0] * xy[28]; ab1 -= mq[5][1] * xy[29]; ab0 -= mq[5][2] * xy[30]; ab1 -= mq[5][3] * xy[31]; mq[5] = *(const LAS f32x4*)(Mg + 3444);
            ab0 -= mq[0][0] * xy[32]; ab1 -= mq[0][1] * xy[33]; ab0 -= mq[0][2] * xy[34]; ab1 -= mq[0][3] * xy[35]; mq[0] = *(const LAS f32x4*)(Mg + 3456);
            ab0 -= mq[1][0] * xy[36]; ab1 -= mq[1][1] * xy[37]; ab0 -= mq[1][2] * xy[38]; ab1 -= mq[1][3] * xy[39]; mq[1] = *(const LAS f32x4*)(Mg + 3460);
            ab0 -= mq[2][0] * xy[40]; ab1 -= mq[2][1] * xy[41]; ab0 -= mq[2][2] * xy[42]; ab1 -= mq[2][3] * xy[43]; mq[2] = *(const LAS f32x4*)(Mg + 3464);
            ab0 -= mq[3][0] * xy[44]; ab1 -= mq[3][1] * xy[45]; ab0 -= mq[3][2] * xy[46]; ab1 -= mq[3][3] * xy[47]; mq[3] = *(const LAS f32x4*)(Mg + 3468);
            ab0 -= mq[4][0] * xy[48]; ab1 -= mq[4][1] * xy[49]; ab0 -= mq[4][2] * xy[50]; ab1 -= mq[4][3] * xy[51]; mq[4] = *(const LAS f32x4*)(Mg + 3472);
            ab0 -= mq[5][0] * xy[52]; xy[53] = ab0 + ab1; up[6784] = xy[53][0]; wp[6784] = f2bf(-xy[53][1]); mq[5] = *(const LAS f32x4*)(Mg + 3476);
            { const float br = betg[54]; ab0 = (f32x2){bf2f(*(const LAS bf16_t*)(lg + P5_VS + 14688 + c * 2)) * br, bf2f(*(const LAS bf16_t*)(lg + P5_KS + 14688 + c * 2)) * br * __expf(decg[54])}; ab1 = (f32x2){0.f, 0.f}; } ab0 -= mq[0][0] * xy[0]; ab1 -= mq[0][1] * xy[1]; ab0 -= mq[0][2] * xy[2]; ab1 -= mq[0][3] * xy[3]; mq[0] = *(const LAS f32x4*)(Mg + 3480);
            ab0 -= mq[1][0] * xy[4]; ab1 -= mq[1][1] * xy[5]; ab0 -= mq[1][2] * xy[6]; ab1 -= mq[1][3] * xy[7]; mq[1] = *(const LAS f32x4*)(Mg + 3484);
            ab0 -= mq[2][0] * xy[8]; ab1 -= mq[2][1] * xy[9]; ab0 -= mq[2][2] * xy[10]; ab1 -= mq[2][3] * xy[11]; mq[2] = *(const LAS f32x4*)(Mg + 3488);
            ab0 -= mq[3][0] * xy[12]; ab1 -= mq[3][1] * xy[13]; ab0 -= mq[3][2] * xy[14]; ab1 -= mq[3][3] * xy[15]; mq[3] = *(const LAS f32x4*)(Mg + 3492);
            ab0 -= mq[4][0] * xy[16]; ab1 -= mq[4][1] * xy[17]; ab0 -= mq[4][2] * xy[18]; ab1 -= mq[4][3] * xy[19]; mq[4] = *(const LAS f32x4*)(Mg + 3496);
            ab0 -= mq[5][0] * xy[20]; ab1 -= mq[5][1] * xy[21]; ab0 -= mq[5][2] * xy[22]; ab1 -= mq[5][3] * xy[23]; mq[5] = *(const LAS f32x4*)(Mg + 3500);
            ab0 -= mq[0][0] * xy[24]; ab1 -= mq[0][1] * xy[25]; ab0 -= mq[0][2] * xy[26]; ab1 -= mq[0][3] * xy[27]; mq[0] = *(const LAS f32x4*)(Mg + 3504);
            ab0 -= mq[1][0] * xy[28]; ab1 -= mq[1][1] * xy[29]; ab0 -= mq[1][2] * xy[30]; ab1 -= mq[1][3] * xy[31]; mq[1] = *(const LAS f32x4*)(Mg + 3508);
            ab0 -= mq[2][0] * xy[32]; ab1 -= mq[2][1] * xy[33]; ab0 -= mq[2][2] * xy[34]; ab1 -= mq[2][3] * xy[35]; mq[2] = *(const LAS f32x4*)(Mg + 3520);
            ab0 -= mq[3][0] * xy[36]; ab1 -= mq[3][1] * xy[37]; ab0 -= mq[3][2] * xy[38]; ab1 -= mq[3][3] * xy[39]; mq[3] = *(const LAS f32x4*)(Mg + 3524);
            ab0 -= mq[4][0] * xy[40]; ab1 -= mq[4][1] * xy[41]; ab0 -= mq[4][2] * xy[42]; ab1 -= mq[4][3] * xy[43]; mq[4] = *(const LAS f32x4*)(Mg + 3528);
            ab0 -= mq[5][0] * xy[44]; ab1 -= mq[5][1] * xy[45]; ab0 -= mq[5][2] * xy[46]; ab1 -= mq[5][3] * xy[47]; mq[5] = *(const LAS f32x4*)(Mg + 3532);
            ab0 -= mq[0][0] * xy[48]; ab1 -= mq[0][1] * xy[49]; ab0 -= mq[0][2] * xy[50]; ab1 -= mq[0][3] * xy[51]; mq[0] = *(const LAS f32x4*)(Mg + 3536);
            ab0 -= mq[1][0] * xy[52]; ab1 -= mq[1][1] * xy[53]; xy[54] = ab0 + ab1; up[6912] = xy[54][0]; wp[6912] = f2bf(-xy[54][1]); mq[1] = *(const LAS f32x4*)(Mg + 3540);
            { const float br = betg[55]; ab0 = (f32x2){bf2f(*(const LAS bf16_t*)(lg + P5_VS + 14960 + c * 2)) * br, bf2f(*(const LAS bf16_t*)(lg + P5_KS + 14960 + c * 2)) * br * __expf(decg[55])}; ab1 = (f32x2){0.f, 0.f}; } ab0 -= mq[2][0] * xy[0]; ab1 -= mq[2][1] * xy[1]; ab0 -= mq[2][2] * xy[2]; ab1 -= mq[2][3] * xy[3]; mq[2] = *(const LAS f32x4*)(Mg + 3544);
            ab0 -= mq[3][0] * xy[4]; ab1 -= mq[3][1] * xy[5]; ab0 -= mq[3][2] * xy[6]; ab1 -= mq[3][3] * xy[7]; mq[3] = *(const LAS f32x4*)(Mg + 3548);
            ab0 -= mq[4][0] * xy[8]; ab1 -= mq[4][1] * xy[9]; ab0 -= mq[4][2] * xy[10]; ab1 -= mq[4][3] * xy[11]; mq[4] = *(const LAS f32x4*)(Mg + 3552);
            ab0 -= mq[5][0] * xy[12]; ab1 -= mq[5][1] * xy[13]; ab0 -= mq[5][2] * xy[14]; ab1 -= mq[5][3] * xy[15]; mq[5] = *(const LAS f32x4*)(Mg + 3556);
            ab0 -= mq[0][0] * xy[16]; ab1 -= mq[0][1] * xy[17]; ab0 -= mq[0][2] * xy[18]; ab1 -= mq[0][3] * xy[19]; mq[0] = *(const LAS f32x4*)(Mg + 3560);
            ab0 -= mq[1][0] * xy[20]; ab1 -= mq[1][1] * xy[21]; ab0 -= mq[1][2] * xy[22]; ab1 -= mq[1][3] * xy[23]; mq[1] = *(const LAS f32x4*)(Mg + 3564);
            ab0 -= mq[2][0] * xy[24]; ab1 -= mq[2][1] * xy[25]; ab0 -= mq[2][2] * xy[26]; ab1 -= mq[2][3] * xy[27]; mq[2] = *(const LAS f32x4*)(Mg + 3568);
            ab0 -= mq[3][0] * xy[28]; ab1 -= mq[3][1] * xy[29]; ab0 -= mq[3][2] * xy[30]; ab1 -= mq[3][3] * xy[31]; mq[3] = *(const LAS f32x4*)(Mg + 3572);
            ab0 -= mq[4][0] * xy[32]; ab1 -= mq[4][1] * xy[33]; ab0 -= mq[4][2] * xy[34]; ab1 -= mq[4][3] * xy[35]; mq[4] = *(const LAS f32x4*)(Mg + 3584);
            ab0 -= mq[5][0] * xy[36]; ab1 -= mq[5][1] * xy[37]; ab0 -= mq[5][2] * xy[38]; ab1 -= mq[5][3] * xy[39]; mq[5] = *(const LAS f32x4*)(Mg + 3588);
            ab0 -= mq[0][0] * xy[40]; ab1 -= mq[0][1] * xy[41]; ab0 -= mq[0][2] * xy[42]; ab1 -= mq[0][3] * xy[43]; mq[0] = *(const LAS f32x4*)(Mg + 3592);
            ab0 -= mq[1][0] * xy[44]; ab1 -= mq[1][1] * xy[45]; ab0 -= mq[1][2] * xy[46]; ab1 -= mq[1][3] * xy[47]; mq[1] = *(const LAS f32x4*)(Mg + 3596);
            ab0 -= mq[2][0] * xy[48]; ab1 -= mq[2][1] * xy[49]; ab0 -= mq[2][2] * xy[50]; ab1 -= mq[2][3] * xy[51]; mq[2] = *(const LAS f32x4*)(Mg + 3600);
            ab0 -= mq[3][0] * xy[52]; ab1 -= mq[3][1] * xy[53]; ab0 -= mq[3][2] * xy[54]; xy[55] = ab0 + ab1; up[7040] = xy[55][0]; wp[7040] = f2bf(-xy[55][1]); mq[3] = *(const LAS f32x4*)(Mg + 3604);
            { const float br = betg[56]; ab0 = (f32x2){bf2f(*(const LAS bf16_t*)(lg + P5_VS + 15232 + c * 2)) * br, bf2f(*(const LAS bf16_t*)(lg + P5_KS + 15232 + c * 2)) * br * __expf(decg[56])}; ab1 = (f32x2){0.f, 0.f}; } ab0 -= mq[4][0] * xy[0]; ab1 -= mq[4][1] * xy[1]; ab0 -= mq[4][2] * xy[2]; ab1 -= mq[4][3] * xy[3]; mq[4] = *(const LAS f32x4*)(Mg + 3608);
            ab0 -= mq[5][0] * xy[4]; ab1 -= mq[5][1] * xy[5]; ab0 -= mq[5][2] * xy[6]; ab1 -= mq[5][3] * xy[7]; mq[5] = *(const LAS f32x4*)(Mg + 3612);
            ab0 -= mq[0][0] * xy[8]; ab1 -= mq[0][1] * xy[9]; ab0 -= mq[0][2] * xy[10]; ab1 -= mq[0][3] * xy[11]; mq[0] = *(const LAS f32x4*)(Mg + 3616);
            ab0 -= mq[1][0] * xy[12]; ab1 -= mq[1][1] * xy[13]; ab0 -= mq[1][2] * xy[14]; ab1 -= mq[1][3] * xy[15]; mq[1] = *(const LAS f32x4*)(Mg + 3620);
            ab0 -= mq[2][0] * xy[16]; ab1 -= mq[2][1] * xy[17]; ab0 -= mq[2][2] * xy[18]; ab1 -= mq[2][3] * xy[19]; mq[2] = *(const LAS f32x4*)(Mg + 3624);
            ab0 -= mq[3][0] * xy[20]; ab1 -= mq[3][1] * xy[21]; ab0 -= mq[3][2] * xy[22]; ab1 -= mq[3][3] * xy[23]; mq[3] = *(const LAS f32x4*)(Mg + 3628);
            ab0 -= mq[4][0] * xy[24]; ab1 -= mq[4][1] * xy[25]; ab0 -= mq[4][2] * xy[26]; ab1 -= mq[4][3] * xy[27]; mq[4] = *(const LAS f32x4*)(Mg + 3632);
            ab0 -= mq[5][0] * xy[28]; ab1 -= mq[5][1] * xy[29]; ab0 -= mq[5][2] * xy[30]; ab1 -= mq[5][3] * xy[31]; mq[5] = *(const LAS f32x4*)(Mg + 3636);
            ab0 -= mq[0][0] * xy[32]; ab1 -= mq[0][1] * xy[33]; ab0 -= mq[0][2] * xy[34]; ab1 -= mq[0][3] * xy[35]; mq[0] = *(const LAS f32x4*)(Mg + 3648);
            ab0 -= mq[1][0] * xy[36]; ab1 -= mq[1][1] * xy[37]; ab0 -= mq[1][2] * xy[38]; ab1 -= mq[1][3] * xy[39]; mq[1] = *(const LAS f32x4*)(Mg + 3652);
            ab0 -= mq[2][0] * xy[40]; ab1 -= mq[2][1] * xy[41]; ab0 -= mq[2][2] * xy[42]; ab1 -= mq[2][3] * xy[43]; mq[2] = *(const LAS f32x4*)(Mg + 3656);
            ab0 -= mq[3][0] * xy[44]; ab1 -= mq[3][1] * xy[45]; ab0 -= mq[3][2] * xy[46]; ab1 -= mq[3][3] * xy[47]; mq[3] = *(const LAS f32x4*)(Mg + 3660);
            ab0 -= mq[4][0] * xy[48]; ab1 -= mq[4][1] * xy[49]; ab0 -= mq[4][2] * xy[50]; ab1 -= mq[4][3] * xy[51]; mq[4] = *(const LAS f32x4*)(Mg + 3664);
            ab0 -= mq[5][0] * xy[52]; ab1 -= mq[5][1] * xy[53]; ab0 -= mq[5][2] * xy[54]; ab1 -= mq[5][3] * xy[55]; xy[56] = ab0 + ab1; up[7168] = xy[56][0]; wp[7168] = f2bf(-xy[56][1]); mq[5] = *(const LAS f32x4*)(Mg + 3668);
            { const float br = betg[57]; ab0 = (f32x2){bf2f(*(const LAS bf16_t*)(lg + P5_VS + 15504 + c * 2)) * br, bf2f(*(const LAS bf16_t*)(lg + P5_KS + 15504 + c * 2)) * br * __expf(decg[57])}; ab1 = (f32x2){0.f, 0.f}; } ab0 -= mq[0][0] * xy[0]; ab1 -= mq[0][1] * xy[1]; ab0 -= mq[0][2] * xy[2]; ab1 -= mq[0][3] * xy[3]; mq[0] = *(const LAS f32x4*)(Mg + 3672);
            ab0 -= mq[1][0] * xy[4]; ab1 -= mq[1][1] * xy[5]; ab0 -= mq[1][2] * xy[6]; ab1 -= mq[1][3] * xy[7]; mq[1] = *(const LAS f32x4*)(Mg + 3676);
            ab0 -= mq[2][0] * xy[8]; ab1 -= mq[2][1] * xy[9]; ab0 -= mq[2][2] * xy[10]; ab1 -= mq[2][3] * xy[11]; mq[2] = *(const LAS f32x4*)(Mg + 3680);
            ab0 -= mq[3][0] * xy[12]; ab1 -= mq[3][1] * xy[13]; ab0 -= mq[3][2] * xy[14]; ab1 -= mq[3][3] * xy[15]; mq[3] = *(const LAS f32x4*)(Mg + 3684);
            ab0 -= mq[4][0] * xy[16]; ab1 -= mq[4][1] * xy[17]; ab0 -= mq[4][2] * xy[18]; ab1 -= mq[4][3] * xy[19]; mq[4] = *(const LAS f32x4*)(Mg + 3688);
            ab0 -= mq[5][0] * xy[20]; ab1 -= mq[5][1] * xy[21]; ab0 -= mq[5][2] * xy[22]; ab1 -= mq[5][3] * xy[23]; mq[5] = *(const LAS f32x4*)(Mg + 3692);
            ab0 -= mq[0][0] * xy[24]; ab1 -= mq[0][1] * xy[25]; ab0 -= mq[0][2] * xy[26]; ab1 -= mq[0][3] * xy[27]; mq[0] = *(const LAS f32x4*)(Mg + 3696);
            ab0 -= mq[1][0] * xy[28]; ab1 -= mq[1][1] * xy[29]; ab0 -= mq[1][2] * xy[30]; ab1 -= mq[1][3] * xy[31]; mq[1] = *(const LAS f32x4*)(Mg + 3700);
            ab0 -= mq[2][0] * xy[32]; ab1 -= mq[2][1] * xy[33]; ab0 -= mq[2][2] * xy[34]; ab1 -= mq[2][3] * xy[35]; mq[2] = *(const LAS f32x4*)(Mg + 3704);
            ab0 -= mq[3][0] * xy[36]; ab1 -= mq[3][1] * xy[37]; ab0 -= mq[3][2] * xy[38]; ab1 -= mq[3][3] * xy[39]; mq[3] = *(const LAS f32x4*)(Mg + 3712);
            ab0 -= mq[4][0] * xy[40]; ab1 -= mq[4][1] * xy[41]; ab0 -= mq[4][2] * xy[42]; ab1 -= mq[4][3] * xy[43]; mq[4] = *(const LAS f32x4*)(Mg + 3716);
            ab0 -= mq[5][0] * xy[44]; ab1 -= mq[5][1] * xy[45]; ab0 -= mq[5][2] * xy[46]; ab1 -= mq[5][3] * xy[47]; mq[5] = *(const LAS f32x4*)(Mg + 3720);
            ab0 -= mq[0][0] * xy[48]; ab1 -= mq[0][1] * xy[49]; ab0 -= mq[0][2] * xy[50]; ab1 -= mq[0][3] * xy[51]; mq[0] = *(const LAS f32x4*)(Mg + 3724);
            ab0 -= mq[1][0] * xy[52]; ab1 -= mq[1][1] * xy[53]; ab0 -= mq[1][2] * xy[54]; ab1 -= mq[1][3] * xy[55]; mq[1] = *(const LAS f32x4*)(Mg + 3728);
            ab0 -= mq[2][0] * xy[56]; xy[57] = ab0 + ab1; up[7296] = xy[57][0]; wp[7296] = f2bf(-xy[57][1]); mq[2] = *(const LAS f32x4*)(Mg + 3732);
            { const float br = betg[58]; ab0 = (f32x2){bf2f(*(const LAS bf16_t*)(lg + P5_VS + 15776 + c * 2)) * br, bf2f(*(const LAS bf16_t*)(lg + P5_KS + 15776 + c * 2)) * br * __expf(decg[58])}; ab1 = (f32x2){0.f, 0.f}; } ab0 -= mq[3][0] * xy[0]; ab1 -= mq[3][1] * xy[1]; ab0 -= mq[3][2] * xy[2]; ab1 -= mq[3][3] * xy[3]; mq[3] = *(const LAS f32x4*)(Mg + 3736);
            ab0 -= mq[4][0] * xy[4]; ab1 -= mq[4][1] * xy[5]; ab0 -= mq[4][2] * xy[6]; ab1 -= mq[4][3] * xy[7]; mq[4] = *(const LAS f32x4*)(Mg + 3740);
            ab0 -= mq[5][0] * xy[8]; ab1 -= mq[5][1] * xy[9]; ab0 -= mq[5][2] * xy[10]; ab1 -= mq[5][3] * xy[11]; mq[5] = *(const LAS f32x4*)(Mg + 3744);
            ab0 -= mq[0][0] * xy[12]; ab1 -= mq[0][1] * xy[13]; ab0 -= mq[0][2] * xy[14]; ab1 -= mq[0][3] * xy[15]; mq[0] = *(const LAS f32x4*)(Mg + 3748);
            ab0 -= mq[1][0] * xy[16]; ab1 -= mq[1][1] * xy[17]; ab0 -= mq[1][2] * xy[18]; ab1 -= mq[1][3] * xy[19]; mq[1] = *(const LAS f32x4*)(Mg + 3752);
            ab0 -= mq[2][0] * xy[20]; ab1 -= mq[2][1] * xy[21]; ab0 -= mq[2][2] * xy[22]; ab1 -= mq[2][3] * xy[23]; mq[2] = *(const LAS f32x4*)(Mg + 3756);
            ab0 -= mq[3][0] * xy[24]; ab1 -= mq[3][1] * xy[25]; ab0 -= mq[3][2] * xy[26]; ab1 -= mq[3][3] * xy[27]; mq[3] = *(const LAS f32x4*)(Mg + 3760);
            ab0 -= mq[4][0] * xy[28]; ab1 -= mq[4][1] * xy[29]; ab0 -= mq[4][2] * xy[30]; ab1 -= mq[4][3] * xy[31]; mq[4] = *(const LAS f32x4*)(Mg + 3764);
            ab0 -= mq[5][0] * xy[32]; ab1 -= mq[5][1] * xy[33]; ab0 -= mq[5][2] * xy[34]; ab1 -= mq[5][3] * xy[35]; mq[5] = *(const LAS f32x4*)(Mg + 3768);
            ab0 -= mq[0][0] * xy[36]; ab1 -= mq[0][1] * xy[37]; ab0 -= mq[0][2] * xy[38]; ab1 -= mq[0][3] * xy[39]; mq[0] = *(const LAS f32x4*)(Mg + 3776);
            ab0 -= mq[1][0] * xy[40]; ab1 -= mq[1][1] * xy[41]; ab0 -= mq[1][2] * xy[42]; ab1 -= mq[1][3] * xy[43]; mq[1] = *(const LAS f32x4*)(Mg + 3780);
            ab0 -= mq[2][0] * xy[44]; ab1 -= mq[2][1] * xy[45]; ab0 -= mq[2][2] * xy[46]; ab1 -= mq[2][3] * xy[47]; mq[2] = *(const LAS f32x4*)(Mg + 3784);
            ab0 -= mq[3][0] * xy[48]; ab1 -= mq[3][1] * xy[49]; ab0 -= mq[3][2] * xy[50]; ab1 -= mq[3][3] * xy[51]; mq[3] = *(const LAS f32x4*)(Mg + 3788);
            ab0 -= mq[4][0] * xy[52]; ab1 -= mq[4][1] * xy[53]; ab0 -= mq[4][2] * xy[54]; ab1 -= mq[4][3] * xy[55]; mq[4] = *(const LAS f32x4*)(Mg + 3792);
            ab0 -= mq[5][0] * xy[56]; ab1 -= mq[5][1] * xy[57]; xy[58] = ab0 + ab1; up[7424] = xy[58][0]; wp[7424] = f2bf(-xy[58][1]); mq[5] = *(const LAS f32x4*)(Mg + 3796);
            { const float br = betg[59]; ab0 = (f32x2){bf2f(*(const LAS bf16_t*)(lg + P5_VS + 16048 + c * 2)) * br, bf2f(*(const LAS bf16_t*)(lg + P5_KS + 16048 + c * 2)) * br * __expf(decg[59])}; ab1 = (f32x2){0.f, 0.f}; } ab0 -= mq[0][0] * xy[0]; ab1 -= mq[0][1] * xy[1]; ab0 -= mq[0][2] * xy[2]; ab1 -= mq[0][3] * xy[3]; mq[0] = *(const LAS f32x4*)(Mg + 3800);
            ab0 -= mq[1][0] * xy[4]; ab1 -= mq[1][1] * xy[5]; ab0 -= mq[1][2] * xy[6]; ab1 -= mq[1][3] * xy[7]; mq[1] = *(const LAS f32x4*)(Mg + 3804);
            ab0 -= mq[2][0] * xy[8]; ab1 -= mq[2][1] * xy[9]; ab0 -= mq[2][2] * xy[10]; ab1 -= mq[2][3] * xy[11]; mq[2] = *(const LAS f32x4*)(Mg + 3808);
            ab0 -= mq[3][0] * xy[12]; ab1 -= mq[3][1] * xy[13]; ab0 -= mq[3][2] * xy[14]; ab1 -= mq[3][3] * xy[15]; mq[3] = *(const LAS f32x4*)(Mg + 3812);
            ab0 -= mq[4][0] * xy[16]; ab1 -= mq[4][1] * xy[17]; ab0 -= mq[4][2] * xy[18]; ab1 -= mq[4][3] * xy[19]; mq[4] = *(const LAS f32x4*)(Mg + 3816);
            ab0 -= mq[5][0] * xy[20]; ab1 -= mq[5][1] * xy[21]; ab0 -= mq[5][2] * xy[22]; ab1 -= mq[5][3] * xy[23]; mq[5] = *(const LAS f32x4*)(Mg + 3820);
            ab0 -= mq[0][0] * xy[24]; ab1 -= mq[0][1] * xy[25]; ab0 -= mq[0][2] * xy[26]; ab1 -= mq[0][3] * xy[27]; mq[0] = *(const LAS f32x4*)(Mg + 3824);
            ab0 -= mq[1][0] * xy[28]; ab1 -= mq[1][1] * xy[29]; ab0 -= mq[1][2] * xy[30]; ab1 -= mq[1][3] * xy[31]; mq[1] = *(const LAS f32x4*)(Mg + 3828);
            ab0 -= mq[2][0] * xy[32]; ab1 -= mq[2][1] * xy[33]; ab0 -= mq[2][2] * xy[34]; ab1 -= mq[2][3] * xy[35]; mq[2] = *(const LAS f32x4*)(Mg + 3832);
            ab0 -= mq[3][0] * xy[36]; ab1 -= mq[3][1] * xy[37]; ab0 -= mq[3][2] * xy[38]; ab1 -= mq[3][3] * xy[39]; mq[3] = *(const LAS f32x4*)(Mg + 3840);
            ab0 -= mq[4][0] * xy[40]; ab1 -= mq[4][1] * xy[41]; ab0 -= mq[4][2] * xy[42]; ab1 -= mq[4][3] * xy[43]; mq[4] = *(const LAS f32x4*)(Mg + 3844);
            ab0 -= mq[5][0] * xy[44]; ab1 -= mq[5][1] * xy[45]; ab0 -= mq[5][2] * xy[46]; ab1 -= mq[5][3] * xy[47]; mq[5] = *(const LAS f32x4*)(Mg + 3848);
            ab0 -= mq[0][0] * xy[48]; ab1 -= mq[0][1] * xy[49]; ab0 -= mq[0][2] * xy[50]; ab1 -= mq[0][3] * xy[51]; mq[0] = *(const LAS f32x4*)(Mg + 3852);
            ab0 -= mq[1][0] * xy[52]; ab1 -= mq[1][1] * xy[53]; ab0 -= mq[1][2] * xy[54]; ab1 -= mq[1][3] * xy[55]; mq[1] = *(const LAS f32x4*)(Mg + 3856);
            ab0 -= mq[2][0] * xy[56]; ab1 -= mq[2][1] * xy[57]; ab0 -= mq[2][2] * xy[58]; xy[59] = ab0 + ab1; up[7552] = xy[59][0]; wp[7552] = f2bf(-xy[59][1]); mq[2] = *(const LAS f32x4*)(Mg + 3860);
            { const float br = betg[60]; ab0 = (f32x2){bf2f(*(const LAS bf16_t*)(lg + P5_VS + 16320 + c * 2)) * br, bf2f(*(const LAS bf16_t*)(lg + P5_KS + 16320 + c * 2)) * br * __expf(decg[60])}; ab1 = (f32x2){0.f, 0.f}; } ab0 -= mq[3][0] * xy[0]; ab1 -= mq[3][1] * xy[1]; ab0 -= mq[3][2] * xy[2]; ab1 -= mq[3][3] * xy[3]; mq[3] = *(const LAS f32x4*)(Mg + 3864);
            ab0 -= mq[4][0] * xy[4]; ab1 -= mq[4][1] * xy[5]; ab0 -= mq[4][2] * xy[6]; ab1 -= mq[4][3] * xy[7]; mq[4] = *(const LAS f32x4*)(Mg + 3868);
            ab0 -= mq[5][0] * xy[8]; ab1 -= mq[5][1] * xy[9]; ab0 -= mq[5][2] * xy[10]; ab1 -= mq[5][3] * xy[11]; mq[5] = *(const LAS f32x4*)(Mg + 3872);
            ab0 -= mq[0][0] * xy[12]; ab1 -= mq[0][1] * xy[13]; ab0 -= mq[0][2] * xy[14]; ab1 -= mq[0][3] * xy[15]; mq[0] = *(const LAS f32x4*)(Mg + 3876);
            ab0 -= mq[1][0] * xy[16]; ab1 -= mq[1][1] * xy[17]; ab0 -= mq[1][2] * xy[18]; ab1 -= mq[1][3] * xy[19]; mq[1] = *(const LAS f32x4*)(Mg + 3880);
            ab0 -= mq[2][0] * xy[20]; ab1 -= mq[2][1] * xy[21]; ab0 -= mq[2][2] * xy[22]; ab1 -= mq[2][3] * xy[23]; mq[2] = *(const LAS f32x4*)(Mg + 3884);
            ab0 -= mq[3][0] * xy[24]; ab1 -= mq[3][1] * xy[25]; ab0 -= mq[3][2] * xy[26]; ab1 -= mq[3][3] * xy[27]; mq[3] = *(const LAS f32x4*)(Mg + 3888);
            ab0 -= mq[4][0] * xy[28]; ab1 -= mq[4][1] * xy[29]; ab0 -= mq[4][2] * xy[30]; ab1 -= mq[4][3] * xy[31]; mq[4] = *(const LAS f32x4*)(Mg + 3892);
            ab0 -= mq[5][0] * xy[32]; ab1 -= mq[5][1] * xy[33]; ab0 -= mq[5][2] * xy[34]; ab1 -= mq[5][3] * xy[35]; mq[5] = *(const LAS f32x4*)(Mg + 3896);
            ab0 -= mq[0][0] * xy[36]; ab1 -= mq[0][1] * xy[37]; ab0 -= mq[0][2] * xy[38]; ab1 -= mq[0][3] * xy[39]; mq[0] = *(const LAS f32x4*)(Mg + 3904);
            ab0 -= mq[1][0] * xy[40]; ab1 -= mq[1][1] * xy[41]; ab0 -= mq[1][2] * xy[42]; ab1 -= mq[1][3] * xy[43]; mq[1] = *(const LAS f32x4*)(Mg + 3908);
            ab0 -= mq[2][0] * xy[44]; ab1 -= mq[2][1] * xy[45]; ab0 -= mq[2][2] * xy[46]; ab1 -= mq[2][3] * xy[47]; mq[2] = *(const LAS f32x4*)(Mg + 3912);
            ab0 -= mq[3][0] * xy[48]; ab1 -= mq[3][1] * xy[49]; ab0 -= mq[3][2] * xy[50]; ab1 -= mq[3][3] * xy[51]; mq[3] = *(const LAS f32x4*)(Mg + 3916);
            ab0 -= mq[4][0] * xy[52]; ab1 -= mq[4][1] * xy[53]; ab0 -= mq[4][2] * xy[54]; ab1 -= mq[4][3] * xy[55]; mq[4] = *(const LAS f32x4*)(Mg + 3920);
            ab0 -= mq[5][0] * xy[56]; ab1 -= mq[5][1] * xy[57]; ab0 -= mq[5][2] * xy[58]; ab1 -= mq[5][3] * xy[59]; xy[60] = ab0 + ab1; up[7680] = xy[60][0]; wp[7680] = f2bf(-xy[60][1]); mq[5] = *(const LAS f32x4*)(Mg + 3924);
            { const float br = betg[61]; ab0 = (f32x2){bf2f(*(const LAS bf16_t*)(lg + P5_VS + 16592 + c * 2)) * br, bf2f(*(const LAS bf16_t*)(lg + P5_KS + 16592 + c * 2)) * br * __expf(decg[61])}; ab1 = (f32x2){0.f, 0.f}; } ab0 -= mq[0][0] * xy[0]; ab1 -= mq[0][1] * xy[1]; ab0 -= mq[0][2] * xy[2]; ab1 -= mq[0][3] * xy[3]; mq[0] = *(const LAS f32x4*)(Mg + 3928);
            ab0 -= mq[1][0] * xy[4]; ab1 -= mq[1][1] * xy[5]; ab0 -= mq[1][2] * xy[6]; ab1 -= mq[1][3] * xy[7]; mq[1] = *(const LAS f32x4*)(Mg + 3932);
            ab0 -= mq[2][0] * xy[8]; ab1 -= mq[2][1] * xy[9]; ab0 -= mq[2][2] * xy[10]; ab1 -= mq[2][3] * xy[11]; mq[2] = *(const LAS f32x4*)(Mg + 3936);
            ab0 -= mq[3][0] * xy[12]; ab1 -= mq[3][1] * xy[13]; ab0 -= mq[3][2] * xy[14]; ab1 -= mq[3][3] * xy[15]; mq[3] = *(const LAS f32x4*)(Mg + 3940);
            ab0 -= mq[4][0] * xy[16]; ab1 -= mq[4][1] * xy[17]; ab0 -= mq[4][2] * xy[18]; ab1 -= mq[4][3] * xy[19]; mq[4] = *(const LAS f32x4*)(Mg + 3944);
            ab0 -= mq[5][0] * xy[20]; ab1 -= mq[5][1] * xy[21]; ab0 -= mq[5][2] * xy[22]; ab1 -= mq[5][3] * xy[23]; mq[5] = *(const LAS f32x4*)(Mg + 3948);
            ab0 -= mq[0][0] * xy[24]; ab1 -= mq[0][1] * xy[25]; ab0 -= mq[0][2] * xy[26]; ab1 -= mq[0][3] * xy[27]; mq[0] = *(const LAS f32x4*)(Mg + 3952);
            ab0 -= mq[1][0] * xy[28]; ab1 -= mq[1][1] * xy[29]; ab0 -= mq[1][2] * xy[30]; ab1 -= mq[1][3] * xy[31]; mq[1] = *(const LAS f32x4*)(Mg + 3956);
            ab0 -= mq[2][0] * xy[32]; ab1 -= mq[2][1] * xy[33]; ab0 -= mq[2][2] * xy[34]; ab1 -= mq[2][3] * xy[35]; mq[2] = *(const LAS f32x4*)(Mg + 3960);
            ab0 -= mq[3][0] * xy[36]; ab1 -= mq[3][1] * xy[37]; ab0 -= mq[3][2] * xy[38]; ab1 -= mq[3][3] * xy[39]; mq[3] = *(const LAS f32x4*)(Mg + 3964);
            ab0 -= mq[4][0] * xy[40]; ab1 -= mq[4][1] * xy[41]; ab0 -= mq[4][2] * xy[42]; ab1 -= mq[4][3] * xy[43]; mq[4] = *(const LAS f32x4*)(Mg + 3968);
            ab0 -= mq[5][0] * xy[44]; ab1 -= mq[5][1] * xy[45]; ab0 -= mq[5][2] * xy[46]; ab1 -= mq[5][3] * xy[47]; mq[5] = *(const LAS f32x4*)(Mg + 3972);
            ab0 -= mq[0][0] * xy[48]; ab1 -= mq[0][1] * xy[49]; ab0 -= mq[0][2] * xy[50]; ab1 -= mq[0][3] * xy[51]; mq[0] = *(const LAS f32x4*)(Mg + 3976);
            ab0 -= mq[1][0] * xy[52]; ab1 -= mq[1][1] * xy[53]; ab0 -= mq[1][2] * xy[54]; ab1 -= mq[1][3] * xy[55]; mq[1] = *(const LAS f32x4*)(Mg + 3980);
            ab0 -= mq[2][0] * xy[56]; ab1 -= mq[2][1] * xy[57]; ab0 -= mq[2][2] * xy[58]; ab1 -= mq[2][3] * xy[59]; mq[2] = *(const LAS f32x4*)(Mg + 3984);
            ab0 -= mq[3][0] * xy[60]; xy[61] = ab0 + ab1; up[7808] = xy[61][0]; wp[7808] = f2bf(-xy[61][1]); mq[3] = *(const LAS f32x4*)(Mg + 3988);
            { const float br = betg[62]; ab0 = (f32x2){bf2f(*(const LAS bf16_t*)(lg + P5_VS + 16864 + c * 2)) * br, bf2f(*(const LAS bf16_t*)(lg + P5_KS + 16864 + c * 2)) * br * __expf(decg[62])}; ab1 = (f32x2){0.f, 0.f}; } ab0 -= mq[4][0] * xy[0]; ab1 -= mq[4][1] * xy[1]; ab0 -= mq[4][2] * xy[2]; ab1 -= mq[4][3] * xy[3]; mq[4] = *(const LAS f32x4*)(Mg + 3992);
            ab0 -= mq[5][0] * xy[4]; ab1 -= mq[5][1] * xy[5]; ab0 -= mq[5][2] * xy[6]; ab1 -= mq[5][3] * xy[7]; mq[5] = *(const LAS f32x4*)(Mg + 3996);
            ab0 -= mq[0][0] * xy[8]; ab1 -= mq[0][1] * xy[9]; ab0 -= mq[0][2] * xy[10]; ab1 -= mq[0][3] * xy[11]; mq[0] = *(const LAS f32x4*)(Mg + 4000);
            ab0 -= mq[1][0] * xy[12]; ab1 -= mq[1][1] * xy[13]; ab0 -= mq[1][2] * xy[14]; ab1 -= mq[1][3] * xy[15]; mq[1] = *(const LAS f32x4*)(Mg + 4004);
            ab0 -= mq[2][0] * xy[16]; ab1 -= mq[2][1] * xy[17]; ab0 -= mq[2][2] * xy[18]; ab1 -= mq[2][3] * xy[19]; mq[2] = *(const LAS f32x4*)(Mg + 4008);
            ab0 -= mq[3][0] * xy[20]; ab1 -= mq[3][1] * xy[21]; ab0 -= mq[3][2] * xy[22]; ab1 -= mq[3][3] * xy[23]; mq[3] = *(const LAS f32x4*)(Mg + 4012);
            ab0 -= mq[4][0] * xy[24]; ab1 -= mq[4][1] * xy[25]; ab0 -= mq[4][2] * xy[26]; ab1 -= mq[4][3] * xy[27]; mq[4] = *(const LAS f32x4*)(Mg + 4016);
            ab0 -= mq[5][0] * xy[28]; ab1 -= mq[5][1] * xy[29]; ab0 -= mq[5][2] * xy[30]; ab1 -= mq[5][3] * xy[31]; mq[5] = *(const LAS f32x4*)(Mg + 4020);
            ab0 -= mq[0][0] * xy[32]; ab1 -= mq[0][1] * xy[33]; ab0 -= mq[0][2] * xy[34]; ab1 -= mq[0][3] * xy[35]; mq[0] = *(const LAS f32x4*)(Mg + 4024);
            ab0 -= mq[1][0] * xy[36]; ab1 -= mq[1][1] * xy[37]; ab0 -= mq[1][2] * xy[38]; ab1 -= mq[1][3] * xy[39]; mq[1] = *(const LAS f32x4*)(Mg + 4028);
            ab0 -= mq[2][0] * xy[40]; ab1 -= mq[2][1] * xy[41]; ab0 -= mq[2][2] * xy[42]; ab1 -= mq[2][3] * xy[43]; mq[2] = *(const LAS f32x4*)(Mg + 4032);
            ab0 -= mq[3][0] * xy[44]; ab1 -= mq[3][1] * xy[45]; ab0 -= mq[3][2] * xy[46]; ab1 -= mq[3][3] * xy[47]; mq[3] = *(const LAS f32x4*)(Mg + 4036);
            ab0 -= mq[4][0] * xy[48]; ab1 -= mq[4][1] * xy[49]; ab0 -= mq[4][2] * xy[50]; ab1 -= mq[4][3] * xy[51]; mq[4] = *(const LAS f32x4*)(Mg + 4040);
            ab0 -= mq[5][0] * xy[52]; ab1 -= mq[5][1] * xy[53]; ab0 -= mq[5][2] * xy[54]; ab1 -= mq[5][3] * xy[55]; mq[5] = *(const LAS f32x4*)(Mg + 4044);
            ab0 -= mq[0][0] * xy[56]; ab1 -= mq[0][1] * xy[57]; ab0 -= mq[0][2] * xy[58]; ab1 -= mq[0][3] * xy[59]; mq[0] = *(const LAS f32x4*)(Mg + 4048);
            ab0 -= mq[1][0] * xy[60]; ab1 -= mq[1][1] * xy[61]; xy[62] = ab0 + ab1; up[7936] = xy[62][0]; wp[7936] = f2bf(-xy[62][1]); mq[1] = *(const LAS f32x4*)(Mg + 4052);
            { const float br = betg[63]; ab0 = (f32x2){bf2f(*(const LAS bf16_t*)(lg + P5_VS + 17136 + c * 2)) * br, bf2f(*(const LAS bf16_t*)(lg + P5_KS + 17136 + c * 2)) * br * __expf(decg[63])}; ab1 = (f32x2){0.f, 0.f}; } ab0 -= mq[2][0] * xy[0]; ab1 -= mq[2][1] * xy[1]; ab0 -= mq[2][2] * xy[2]; ab1 -= mq[2][3] * xy[3]; mq[2] = *(const LAS f32x4*)(Mg + 4056);
            ab0 -= mq[3][0] * xy[4]; ab1 -= mq[3][1] * xy[5]; ab0 -= mq[3][2] * xy[6]; ab1 -= mq[3][3] * xy[7]; mq[3] = *(const LAS f32x4*)(Mg + 4060);
            ab0 -= mq[4][0] * xy[8]; ab1 -= mq[4][1] * xy[9]; ab0 -= mq[4][2] * xy[10]; ab1 -= mq[4][3] * xy[11]; mq[4] = *(const LAS f32x4*)(Mg + 4064);
            ab0 -= mq[5][0] * xy[12]; ab1 -= mq[5][1] * xy[13]; ab0 -= mq[5][2] * xy[14]; ab1 -= mq[5][3] * xy[15]; mq[5] = *(const LAS f32x4*)(Mg + 4068);
            ab0 -= mq[0][0] * xy[16]; ab1 -= mq[0][1] * xy[17]; ab0 -= mq[0][2] * xy[18]; ab1 -= mq[0][3] * xy[19]; mq[0] = *(const LAS f32x4*)(Mg + 4072);
            ab0 -= mq[1][0] * xy[20]; ab1 -= mq[1][1] * xy[21]; ab0 -= mq[1][2] * xy[22]; ab1 -= mq[1][3] * xy[23]; mq[1] = *(const LAS f32x4*)(Mg + 4076);
            ab0 -= mq[2][0] * xy[24]; ab1 -= mq[2][1] * xy[25]; ab0 -= mq[2][2] * xy[26]; ab1 -= mq[2][3] * xy[27]; mq[2] = *(const LAS f32x4*)(Mg + 4080);
            ab0 -= mq[3][0] * xy[28]; ab1 -= mq[3][1] * xy[29]; ab0 -= mq[3][2] * xy[30]; ab1 -= mq[3][3] * xy[31]; mq[3] = *(const LAS f32x4*)(Mg + 4084);
            ab0 -= mq[4][0] * xy[32]; ab1 -= mq[4][1] * xy[33]; ab0 -= mq[4][2] * xy[34]; ab1 -= mq[4][3] * xy[35]; mq[4] = *(const LAS f32x4*)(Mg + 4088);
            ab0 -= mq[5][0] * xy[36]; ab1 -= mq[5][1] * xy[37]; ab0 -= mq[5][2] * xy[38]; ab1 -= mq[5][3] * xy[39]; mq[5] = *(const LAS f32x4*)(Mg + 4092);
            ab0 -= mq[0][0] * xy[40]; ab1 -= mq[0][1] * xy[41]; ab0 -= mq[0][2] * xy[42]; ab1 -= mq[0][3] * xy[43];
            ab0 -= mq[1][0] * xy[44]; ab1 -= mq[1][1] * xy[45]; ab0 -= mq[1][2] * xy[46]; ab1 -= mq[1][3] * xy[47];
            ab0 -= mq[2][0] * xy[48]; ab1 -= mq[2][1] * xy[49]; ab0 -= mq[2][2] * xy[50]; ab1 -= mq[2][3] * xy[51];
            ab0 -= mq[3][0] * xy[52]; ab1 -= mq[3][1] * xy[53]; ab0 -= mq[3][2] * xy[54]; ab1 -= mq[3][3] * xy[55];
            ab0 -= mq[4][0] * xy[56]; ab1 -= mq[4][1] * xy[57]; ab0 -= mq[4][2] * xy[58]; ab1 -= mq[4][3] * xy[59];
            ab0 -= mq[5][0] * xy[60]; ab1 -= mq[5][1] * xy[61]; ab0 -= mq[5][2] * xy[62]; xy[63] = ab0 + ab1; up[8064] = xy[63][0]; wp[8064] = f2bf(-xy[63][1]);
        } else {
            const int g2 = (w8 - 4) >> 1, tt = ((w8 - 4) & 1) * 64 + lane; const int item2 = it0 + g2;
            LAS unsigned char* lg = lds0 + g2 * P5_GRP; LAS float* decg = (LAS float*)(lg + P5_DEC);
            const float lastg = decg[63];
#pragma unroll
            for (int i = 0; i < 8; ++i) { const int vid = tt + 128 * i, r = vid >> 4, d0 = (vid & 15) * 8; float f[8]; unpack8(*(const LAS u32x4*)(lg + P5_QS + r * 272 + d0 * 2), f);
                const float e = scale * __expf(decg[r]);
#pragma unroll
                for (int q = 0; q < 8; ++q) f[q] *= e;
                *(u32x4*)(qd + (size_t)item2 * 8192 + r * 128 + d0) = pack8(f); }
#pragma unroll
            for (int i = 0; i < 8; ++i) { const int vid = tt + 128 * i, d = vid >> 3, rg = (vid & 7) * 8; float f[8];
#pragma unroll
                for (int q = 0; q < 8; ++q) f[q] = bf2f(*(const LAS bf16_t*)(lg + P5_KS + (rg + q) * 272 + d * 2)) * __expf(lastg - decg[rg + q]);
                *(u32x4*)(kt + (size_t)item2 * 8192 + d * 64 + rg) = pack8(f); }
            if (tt == 0) cdv[item2] = __expf(lastg);
        }
    }
    __syncthreads();
}

constexpr int SB_WD = 0, SB_QD = 17408, SB_KT = 34816, SB_QK = 53248, SB_UB = 62464, SB_SIZE = 66560;
constexpr int SC_ST = 2 * SB_SIZE, SC_UT = SC_ST + 4352, SC_END = SC_UT + 2304;
static_assert(SC_END <= LDS_BYTES, "lds");
__device__ __forceinline__ void scan_phase(const Params& p, int bid, int nblk, LAS unsigned char* lds) {
    const int tid = threadIdx.x, lane = tid & 63, wid = __builtin_amdgcn_readfirstlane(tid >> 6), fr = lane & 15, fq = lane >> 4;
    const bf16_t* wdc = (const bf16_t*)(p.ws + WS_WDC); const bf16_t* qd = (const bf16_t*)(p.ws + WS_QD); const bf16_t* kt = (const bf16_t*)(p.ws + WS_KT); const bf16_t* qk = (const bf16_t*)(p.ws + WS_QK);
    const float* cdv = (const float*)(p.ws + WS_CD); const float* ub = p.out + OS_UB; float* obuf = p.out + OS_O;
    for (int item = bid; item < 256; item += nblk) {
        const int xcd = item & 7, iq = item >> 3, bh = xcd * 4 + (iq >> 3), sl = iq & 7, h = bh & 7, b = bh >> 3;
        u32x4 r_wd[2], r_qd[2], r_kt[2], r_qk, r_ub;
        auto gload = [&](int n) {
            const size_t it = (size_t)(bh * 32 + n);
#pragma unroll
            for (int i = 0; i < 2; ++i) { const int ch = tid + 512 * i; r_wd[i] = *(const u32x4*)(wdc + it * 8192 + ch * 8); r_qd[i] = *(const u32x4*)(qd + it * 8192 + ch * 8); r_kt[i] = *(const u32x4*)(kt + it * 8192 + ch * 8); }
            r_qk = *(const u32x4*)(qk + it * 4096 + tid * 8);
            if (tid < 256) r_ub = *(const u32x4*)(ub + it * 8192 + (tid >> 2) * 128 + sl * 16 + (tid & 3) * 4);
        };
        auto lstore = [&](int buf) {
            LAS unsigned char* B = lds + buf * SB_SIZE;
#pragma unroll
            for (int i = 0; i < 2; ++i) { const int ch = tid + 512 * i; const int r = ch >> 4, c8 = (ch & 15) * 8; *(LAS u32x4*)(B + SB_WD + r * 272 + c8 * 2) = r_wd[i]; *(LAS u32x4*)(B + SB_QD + r * 272 + c8 * 2) = r_qd[i];
                const int d = ch >> 3, t8 = (ch & 7) * 8; *(LAS u32x4*)(B + SB_KT + d * 144 + t8 * 2) = r_kt[i]; }
            { const int r = tid >> 3, s8 = (tid & 7) * 8; *(LAS u32x4*)(B + SB_QK + r * 144 + s8 * 2) = r_qk; }
            if (tid < 256) *(LAS u32x4*)(B + SB_UB + (tid >> 2) * 64 + (tid & 3) * 16) = r_ub;
        };
        __syncthreads();
        gload(0);
        for (int i = tid; i < 4352 / 4; i += 512) *(LAS unsigned*)(lds + SC_ST + i * 4) = 0u;
        lstore(0);
        f32x4 sacc = (f32x4){0.f, 0.f, 0.f, 0.f};
        __syncthreads();
        for (int n = 0; n < 32; ++n) {
            const int cur = n & 1; LAS unsigned char* B = lds + cur * SB_SIZE;
            if (n + 1 < 32) gload(n + 1);
            const float cd = cdv[bh * 32 + n];
            f32x4 acc;
            const int tw = wid & 3;
            if (wid < 4) {
#pragma unroll
                for (int j = 0; j < 4; ++j) acc[j] = *(const LAS float*)(B + SB_UB + ((tw * 16 + fq * 4 + j) * 16 + fr) * 4);
#pragma unroll
                for (int kk = 0; kk < 4; ++kk) { const bf16x8 a = *(const LAS bf16x8*)(B + SB_WD + (tw * 16 + fr) * 272 + (kk * 32 + fq * 8) * 2); const bf16x8 bb = *(const LAS bf16x8*)(lds + SC_ST + fr * 272 + (kk * 32 + fq * 8) * 2);
                    acc = __builtin_amdgcn_mfma_f32_16x16x32_bf16(a, bb, acc, 0, 0, 0); }
                u32x2 w; w.x = pk2(acc[0], acc[1]); w.y = pk2(acc[2], acc[3]);
                *(LAS u32x2*)(lds + SC_UT + fr * 144 + (tw * 16 + fq * 4) * 2) = w;
            } else {
                acc = (f32x4){0.f, 0.f, 0.f, 0.f};
#pragma unroll
                for (int kk = 0; kk < 4; ++kk) { const bf16x8 a = *(const LAS bf16x8*)(B + SB_QD + (tw * 16 + fr) * 272 + (kk * 32 + fq * 8) * 2); const bf16x8 bb = *(const LAS bf16x8*)(lds + SC_ST + fr * 272 + (kk * 32 + fq * 8) * 2);
                    acc = __builtin_amdgcn_mfma_f32_16x16x32_bf16(a, bb, acc, 0, 0, 0); }
            }
            __syncthreads();
            sacc *= cd;
#pragma unroll
            for (int kk = 0; kk < 2; ++kk) { const bf16x8 a = *(const LAS bf16x8*)(B + SB_KT + (wid * 16 + fr) * 144 + (kk * 32 + fq * 8) * 2); const bf16x8 bb = *(const LAS bf16x8*)(lds + SC_UT + fr * 144 + (kk * 32 + fq * 8) * 2);
                sacc = __builtin_amdgcn_mfma_f32_16x16x32_bf16(a, bb, sacc, 0, 0, 0); }
            if (wid >= 4) {
#pragma unroll
                for (int kk = 0; kk < 2; ++kk) { const bf16x8 a = *(const LAS bf16x8*)(B + SB_QK + (tw * 16 + fr) * 144 + (kk * 32 + fq * 8) * 2); const bf16x8 bb = *(const LAS bf16x8*)(lds + SC_UT + fr * 144 + (kk * 32 + fq * 8) * 2);
                    acc = __builtin_amdgcn_mfma_f32_16x16x32_bf16(a, bb, acc, 0, 0, 0); }
#pragma unroll
                for (int j = 0; j < 4; ++j) obuf[(size_t)(b * 2048 + n * 64 + tw * 16 + fq * 4 + j) * 1024 + h * 128 + sl * 16 + fr] = acc[j];
            }
            { u32x2 w; w.x = pk2(sacc[0], sacc[1]); w.y = pk2(sacc[2], sacc[3]); *(LAS u32x2*)(lds + SC_ST + fr * 272 + (wid * 16 + fq * 4) * 2) = w; }
            if (n + 1 < 32) lstore(cur ^ 1);
            __syncthreads();
        }
#pragma unroll
        for (int j = 0; j < 4; ++j) p.out[O_DP + ((size_t)bh * 128 + wid * 16 + fq * 4 + j) * 128 + sl * 16 + fr] = sacc[j];
    }
    __syncthreads();
    {
        const bf16_t* qn = (const bf16_t*)(p.ws + WS_QN); const bf16_t* kn = (const bf16_t*)(p.ws + WS_KN); const bf16_t* vv = (const bf16_t*)(p.ws + WS_VV);
        const float* gbuf = (const float*)(p.ws + WS_G); const float* bbuf = (const float*)(p.ws + WS_BETA);
        const int grp = tid >> 8, w4 = __builtin_amdgcn_readfirstlane(tid >> 6) & 3, j = w4 * 32 + (lane & 31), half = lane >> 5;
        LAS float* qs = (LAS float*)lds + grp * 1024;
        LAS float* ks = qs + 512;
        const float scale = 0.08838834764831845f;
        for (int it0 = bid * 2; it0 < 1024; it0 += nblk * 2) {
            const int item = it0 + grp, sb = item >> 3, h = item & 7;
            __syncthreads();
#pragma unroll
            for (int i = 0; i < 4; ++i) { const int idx = (tid & 255) + 256 * i, tk = idx >> 7, c = idx & 127, t = tk & 3; const size_t go = (size_t)(TP + sb * 4 + t) * 1024 + h * 128 + c;
                if (tk < 4) qs[t * 128 + c] = bf2f(qn[go]); else ks[t * 128 + c] = bf2f(kn[go]); }
            float S[64];
            const float* s0 = p.in[4] + (size_t)item * 16384 + (size_t)half * 64 * 128 + j;
#pragma unroll
            for (int i = 0; i < 64; ++i) S[i] = __builtin_nontemporal_load(s0 + i * 128);
            __syncthreads();
#pragma unroll 1
            for (int t = 0; t < 4; ++t) {
                const int row = TP + sb * 4 + t;
                const float a = __expf(gbuf[row * 8 + h]), be = bbuf[row * 8 + h], v = bf2f(vv[(size_t)row * 1024 + h * 128 + j]);
                float kS = 0.f;
#pragma unroll
                for (int i4 = 0; i4 < 16; ++i4) { const f32x4 k4 = *(const LAS f32x4*)(ks + t * 128 + half * 64 + i4 * 4); kS += k4[0] * S[i4 * 4] + k4[1] * S[i4 * 4 + 1] + k4[2] * S[i4 * 4 + 2] + k4[3] * S[i4 * 4 + 3]; }
                kS += __shfl_xor(kS, 32);
                const float coef = be * (v - a * kS);
                float o = 0.f;
#pragma unroll
                for (int i4 = 0; i4 < 16; ++i4) { const f32x4 k4 = *(const LAS f32x4*)(ks + t * 128 + half * 64 + i4 * 4); const f32x4 q4 = *(const LAS f32x4*)(qs + t * 128 + half * 64 + i4 * 4);
#pragma unroll
                    for (int q = 0; q < 4; ++q) { S[i4 * 4 + q] = a * S[i4 * 4 + q] + k4[q] * coef; o += q4[q] * S[i4 * 4 + q]; } }
                o += __shfl_xor(o, 32);
                if (half == 0) obuf[(size_t)row * 1024 + h * 128 + j] = o * scale;
            }
            float* so = p.out + O_DS + (size_t)item * 16384 + (size_t)half * 64 * 128 + j;
#pragma unroll
            for (int i = 0; i < 64; ++i) so[i * 128] = S[i];
        }
    }
    __syncthreads();
}

__device__ __forceinline__ void onorm_phase(const Params& p, int bid, int nblk) {
    const int lane = threadIdx.x & 63, wid = __builtin_amdgcn_readfirstlane(threadIdx.x >> 6);
    const float* obuf = p.out + OS_O; const bf16_t* proj = (const bf16_t*)(p.ws + WS_PROJ); bf16_t* acat = (bf16_t*)(p.ws + WS_U); const float* og = p.in[14];
    for (int row = bid * 8 + wid; row < TT; row += nblk * 8) {
        const int c0 = lane * 16; float o[16], z[16], g[16];
#pragma unroll
        for (int i = 0; i < 4; ++i) { const f32x4 v = *(const f32x4*)(obuf + (size_t)row * 1024 + c0 + i * 4); o[i * 4] = v[0]; o[i * 4 + 1] = v[1]; o[i * 4 + 2] = v[2]; o[i * 4 + 3] = v[3];
            const f32x4 gg = *(const f32x4*)(og + (c0 & 127) + i * 4); g[i * 4] = gg[0]; g[i * 4 + 1] = gg[1]; g[i * 4 + 2] = gg[2]; g[i * 4 + 3] = gg[3]; }
        unpack8(*(const u32x4*)(proj + (size_t)row * NPROJ + C_Z + c0), z); unpack8(*(const u32x4*)(proj + (size_t)row * NPROJ + C_Z + c0 + 8), z + 8);
        float ss = 0.f;
#pragma unroll
        for (int i = 0; i < 16; ++i) ss += o[i] * o[i];
        ss += __shfl_xor(ss, 1); ss += __shfl_xor(ss, 2); ss += __shfl_xor(ss, 4);
        const float rstd = rsqrtf(ss * (1.0f / 128.0f) + EPS);
#pragma unroll
        for (int i = 0; i < 16; ++i) o[i] = o[i] * rstd * g[i] * siluf_(z[i]);
        *(u32x4*)(acat + (size_t)row * DM + c0) = pack8(o); *(u32x4*)(acat + (size_t)row * DM + c0 + 8) = pack8(o + 8);
    }
}

#define XB_TMO      128
#define XB_XCNT(j)  (256  + 64 * (j))
#define XB_XSUB(j)  (1280 + 64 * (j))
#define XB_XGEN(j)  (2304 + 64 * (j))
#define XB_TOP      3328
#define XB_TOPGEN   3392
#define XCD_BAR_WORDS 3456
#define XB_SPIN_CAP (1u << 18)

__device__ __forceinline__ unsigned xb_ld(unsigned* p)              { return __hip_atomic_load(p, __ATOMIC_RELAXED, __HIP_MEMORY_SCOPE_AGENT); }
__device__ __forceinline__ unsigned xb_add(unsigned* p, unsigned v) { return __hip_atomic_fetch_add(p, v, __ATOMIC_RELAXED, __HIP_MEMORY_SCOPE_AGENT); }
__device__ __forceinline__ unsigned xb_xcc_id() { return (unsigned)__builtin_amdgcn_s_getreg((3 << 11) | 20) & 0xFu; }
#define XB_SPIN(cond, bar) do { unsigned _sp = 0; while (cond) { __builtin_amdgcn_s_sleep(1); \
    if ((++_sp & 255u) == 0u) { if (xb_ld(&(bar)[XB_TMO])) break; if (_sp > XB_SPIN_CAP) { atomicAdd(&(bar)[XB_TMO], 1u); break; } } } } while (0)

struct XcdBarrier {
    unsigned* bar; unsigned x;
    volatile LAS unsigned* st;
};

__device__ __forceinline__ XcdBarrier xcd_barrier_post(unsigned* bar, volatile LAS unsigned* st) {
    XcdBarrier b; b.bar = bar; b.x = xb_xcc_id(); b.st = st;
    if (threadIdx.x == 0) (void)xb_add(&bar[XB_XCNT(b.x)], 1u);
    return b;
}
__device__ __forceinline__ void xcd_barrier_complete(unsigned* bar, unsigned x, unsigned& nloc, unsigned& nx) {
    const unsigned G = gridDim.x * gridDim.y * gridDim.z;
    unsigned sum, cnt, mine, sp = 0u;
    for (;;) {
        sum = 0u; cnt = 0u; mine = 0u;
#pragma unroll
        for (unsigned j = 0; j < 16; ++j) { const unsigned c = xb_ld(&bar[XB_XCNT(j)]); sum += c; cnt += (c > 0u) ? 1u : 0u; mine = (j == x) ? c : mine; }
        if (sum == G) break;
        __builtin_amdgcn_s_sleep(1);
        if ((++sp & 255u) == 0u) { if (xb_ld(&bar[XB_TMO])) break; if (sp > XB_SPIN_CAP) { atomicAdd(&bar[XB_TMO], 1u); break; } }
    }
    nloc = mine > 0u ? mine : 1u; nx = cnt > 0u ? cnt : 1u;
}

__device__ __forceinline__ void xcd_barrier(const XcdBarrier& b) {
    asm volatile("s_waitcnt vmcnt(0)" ::: "memory");
    __syncthreads();
    if (threadIdx.x == 0) {
        unsigned* bar = b.bar;
        __builtin_amdgcn_s_waitcnt(0);
        unsigned nloc = b.st[0], nx = b.st[1];
        if (nloc == 0u) { xcd_barrier_complete(bar, b.x, nloc, nx); b.st[0] = nloc; b.st[1] = nx; }
        const unsigned old = xb_add(&bar[XB_XSUB(b.x)], 1u);
        const unsigned gen = old / nloc;
        if (old + 1u == (gen + 1u) * nloc) {
            __builtin_amdgcn_fence(__ATOMIC_RELEASE, "agent");
            asm volatile("s_waitcnt vmcnt(0)" ::: "memory");
            const unsigned og = xb_add(&bar[XB_TOP], 1u);
            const unsigned tg = og / nx;
            if (og + 1u == (tg + 1u) * nx) xb_add(&bar[XB_TOPGEN], 1u);
            else XB_SPIN(xb_ld(&bar[XB_TOPGEN]) == tg, bar);
            __builtin_amdgcn_fence(__ATOMIC_ACQUIRE, "agent");
            xb_add(&bar[XB_XGEN(b.x)], 1u);
            asm volatile("s_waitcnt vmcnt(0)" ::: "memory");
        } else {
            XB_SPIN(xb_ld(&bar[XB_XGEN(b.x)]) == gen, bar);
            __builtin_amdgcn_fence(__ATOMIC_ACQUIRE, "agent");
            asm volatile("s_waitcnt vmcnt(0)" ::: "memory");
        }
    }
    __syncthreads();
}

constexpr size_t WS_BAR = WS_END;
constexpr int LDS_ST_OFF = LDS_BYTES - 16;
struct KArgs { Params p; TJob jobs[11]; };
constexpr int N_PHASES = 15;
#ifndef PH_MASK
#define PH_MASK 0xFFFF
#endif
#ifndef DUP_MASK
#define DUP_MASK 0
#endif

__global__ void __launch_bounds__(512, 2) fwd_megakernel(KArgs ka) {
    extern __shared__ __attribute__((aligned(16))) unsigned char lds_raw[];
    LAS unsigned char* lds = (LAS unsigned char*)lds_raw;
    const Params& p = ka.p;
    const int bid = blockIdx.x, nblk = gridDim.x;
    unsigned char* ws = p.ws;
    const int lo = p.ph_lo, hi = p.ph_hi;
    if (threadIdx.x < 4) ((LAS unsigned*)(lds + LDS_ST_OFF))[threadIdx.x] = 0u;
    __syncthreads();
    if (hi > 1000) cg::this_grid().sync();
    XcdBarrier xbar = xcd_barrier_post((unsigned*)(ws + WS_BAR), (volatile LAS unsigned*)(lds + LDS_ST_OFF));
#define IN(k) ((PH_MASK & (1 << (k))) && lo <= (k) && (k) < hi)
#define SEAM(k) do { if (lo <= (k) && (k) + 1 < hi) xcd_barrier(xbar); } while (0)
    if (IN(0)) for (int rep = 0; rep <= ((DUP_MASK >> 0) & 1); ++rep) {
            bf16_t* aada = (bf16_t*)(ws + WS_AADA);
            for (int idx = bid * 512 + threadIdx.x; idx < 256 * 2048; idx += nblk * 512) { const int row = idx >> 11, col = idx & 2047;
                const float v = row < 4 ? siluf_(p.in[2][row * 2048 + col]) : (row < NB ? siluf_(p.in[3][(row - 4) * 2048 + col]) : 0.f); aada[idx] = f2bf(v); }
            transpose_jobs(ka.jobs, 1, bid, nblk, lds);
        }
    SEAM(0);
    if (IN(1)) for (int rep = 0; rep <= ((DUP_MASK >> 1) & 1); ++rep) {
            if (bid < 48) { pg8::Gemm g{(const bf16_t*)(ws + WS_AADA), (const bf16_t*)(ws + WS_PROJ), 2048, 2048, 2048, 0, 0, 0, 0, 0}; pg8::OneUnitOrder S{48, bid, 32}; pg8::EpiAda E{(float*)(ws + WS_MOD), p.in[8]}; pg8::gemm_phase(lds, g, S, E); }
            else { transpose_jobs(ka.jobs + 1, 1, bid - 48, nblk - 48, lds); transpose_jobs(ka.jobs + 4, 7, bid - 48, nblk - 48, lds); }
        }
    SEAM(1);
    if (IN(2)) for (int rep = 0; rep <= ((DUP_MASK >> 2) & 1); ++rep) norm_phase<0>(p, bid, nblk);
    SEAM(2);
    if (IN(3)) for (int rep = 0; rep <= ((DUP_MASK >> 3) & 1); ++rep) { pg8::Gemm g{(const bf16_t*)(ws + WS_U), (const bf16_t*)(ws + WS_WIN), 2048, 2048, 2048, 0, 0, 0, 0, 0}; pg8::StaticOrder S; S.init(TT, NPROJ, 2048, nblk, bid); pg8::EpiBf16 E{(bf16_t*)(ws + WS_PROJ), NPROJ, 0, nullptr}; pg8::gemm_phase(lds, g, S, E); }
    SEAM(3);
    if (IN(4)) for (int rep = 0; rep <= ((DUP_MASK >> 4) & 1); ++rep) mixer_prep_phase(p, bid, nblk);
    SEAM(4);
    if (IN(5)) for (int rep = 0; rep <= ((DUP_MASK >> 5) & 1); ++rep) chunk_prep_phase(p, bid, nblk, lds);
    SEAM(5);
    if (IN(6)) for (int rep = 0; rep <= ((DUP_MASK >> 6) & 1); ++rep) scan_phase(p, bid, nblk, lds);
    SEAM(6);
    if (IN(7)) for (int rep = 0; rep <= ((DUP_MASK >> 7) & 1); ++rep) { onorm_phase(p, bid, nblk);
            pg8::Gemm g{(const bf16_t*)(ws + WS_YP), (const bf16_t*)(ws + WS_PW), 1024, 256, 256, 512, 0, 0, 0, 0}; pg8::StaticOrder S; S.init(TT, 1024, 256, nblk, bid); pg8::EpiBf16 E{(bf16_t*)(ws + WS_U), DM, 1024, p.in[16]}; pg8::gemm_phase(lds, g, S, E);
            if (rep == 0) { if (nblk <= 136) transpose_jobs(ka.jobs + 3, 1, bid, nblk, lds); else if (bid >= 136) transpose_jobs(ka.jobs + 3, 1, bid - 136, nblk - 136, lds); } }
    SEAM(7);
    if (IN(8)) for (int rep = 0; rep <= ((DUP_MASK >> 8) & 1); ++rep) {
            pg8::Gemm g{(const bf16_t*)(ws + WS_U), (const bf16_t*)(ws + WS_WAB), 2048, 2048, 1024, 0, 2048, 2048, (size_t)128 * 2048 * 2, (size_t)128 * 2048 * 2}; pg8::StaticOrder S; S.init(68 * 256, 16 * 256, 1024, nblk, bid);
            pg8::EpiDiag E{(bf16_t*)(ws + WS_QN), (const bf16_t*)(ws + WS_PROJ)}; pg8::gemm_phase(lds, g, S, E);
            if (rep == 0) { const int nfull = 1088 % nblk; if (nfull == 0 || nfull >= nblk) transpose_jobs(ka.jobs + 2, 1, bid, nblk, lds); else if (bid >= nfull) transpose_jobs(ka.jobs + 2, 1, bid - nfull, nblk - nfull, lds); } }
    SEAM(9);
    if (IN(10)) for (int rep = 0; rep <= ((DUP_MASK >> 10) & 1); ++rep) { pg8::Gemm g{(const bf16_t*)(ws + WS_QN), (const bf16_t*)(ws + WS_WO), 2048, 2048, 2048, 0, 0, 0, 0, 0}; pg8::SplitOrder S{nblk, bid, 32, 4, 8}; pg8::EpiRes E{p.out + O_Y, p.in[0], p.in[1], (const float*)(ws + WS_MOD) + 4096, (float*)(ws + WS_PB10)}; pg8::gemm_phase(lds, g, S, E); }
    SEAM(10);
    if (IN(11)) for (int rep = 0; rep <= ((DUP_MASK >> 11) & 1); ++rep) norm_phase<1>(p, bid, nblk);
    SEAM(11);
    if (IN(12)) for (int rep = 0; rep <= ((DUP_MASK >> 12) & 1); ++rep) { pg8::Gemm g{(const bf16_t*)(ws + WS_U), (const bf16_t*)(ws + WS_WGU), 2048, 2048, 2048, 0, 0, 0, 0, 0}; pg8::StaticOrder S; S.init(TT, 11264, 2048, nblk, bid); pg8::EpiGU E{(bf16_t*)(ws + WS_PROJ)}; pg8::gemm_phase(lds, g, S, E); }
    SEAM(12);
    if (IN(13)) for (int rep = 0; rep <= ((DUP_MASK >> 13) & 1); ++rep) { pg8::Gemm g{(const bf16_t*)(ws + WS_PROJ), (const bf16_t*)(ws + WS_WD), DFF, DFF, DFF, 0, 0, 0, 0, 0}; pg8::SplitOrder S{nblk, bid, 88, 8, 11}; pg8::EpiRes E{p.out + O_Y, p.out + O_Y, p.out + O_Y + (size_t)TP * DM, (const float*)(ws + WS_MOD) + 10240, (float*)(ws + WS_PB13)}; pg8::gemm_phase(lds, g, S, E); }
    SEAM(13);
    if (IN(14)) for (int rep = 0; rep <= ((DUP_MASK >> 14) & 1); ++rep) norm_phase<2>(p, bid, nblk);
    SEAM(14);
}

extern "C" void kernel_launch(void* const* d_in, const int* in_sizes, int n_in, void* d_out, int out_size, void* d_ws, size_t ws_size, hipStream_t stream) {
    static int grid = 0;
    if (grid == 0) {
        if (n_in != 24 || ws_size < WS_BAR + XCD_BAR_WORDS * 4) { fprintf(stderr, "kernel_launch: unexpected n_in %d / ws_size %zu (need %zu)\n", n_in, ws_size, (size_t)WS_END); grid = -1; return; }
        int dev = 0, cus = 0, per_cu = 0;
        hipGetDevice(&dev); hipDeviceGetAttribute(&cus, hipDeviceAttributeMultiprocessorCount, dev);
        if (hipFuncSetAttribute((const void*)fwd_megakernel, hipFuncAttributeMaxDynamicSharedMemorySize, LDS_BYTES) != hipSuccess) { fprintf(stderr, "kernel_launch: hipFuncSetAttribute failed\n"); grid = -1; return; }
        if (hipOccupancyMaxActiveBlocksPerMultiprocessor(&per_cu, (const void*)fwd_megakernel, 512, LDS_BYTES) != hipSuccess || per_cu < 1) { fprintf(stderr, "kernel_launch: occupancy query says %d\n", per_cu); per_cu = 1; }
        (void)hipGetLastError();
        grid = cus > 0 ? cus : 256;
        if (grid < 64) grid = 64;
    }
    if (grid < 0) return;
    if (hipMemsetAsync((unsigned char*)d_ws + WS_BAR, 0, XCD_BAR_WORDS * 4, stream) != hipSuccess) { fprintf(stderr, "kernel_launch: memset failed\n"); return; }
    KArgs ka; memset(&ka, 0, sizeof(ka));
    for (int i = 0; i < 24; ++i) ka.p.in[i] = (const float*)d_in[i];
    ka.p.out = (float*)d_out; ka.p.ws = (unsigned char*)d_ws;
    unsigned char* ws = (unsigned char*)d_ws;
    auto setjob = [&](int i, const void* src, void* dst, int ld_src, int K, int Nout, int ld_dst, int map) { TJob& j = ka.jobs[i]; j.src = (const float*)src; j.dst = (bf16_t*)dst; j.ld_src = ld_src; j.K = K; j.Nout = Nout; j.ld_dst = ld_dst; j.map = map; j.pad = 0; };
    setjob(0, d_in[7], ws + WS_PROJ, MODW, 2048, MODW, 2048, 0);
    setjob(1, d_in[10], ws + WS_WIN, 9232, 2048, NPROJ, 2048, 1);
    setjob(2, d_in[21], ws + WS_WGU, 2 * DFF, 2048, 2 * DFF, 2048, 2);
    setjob(3, d_in[22], ws + WS_WD, 2048, DFF, 2048, DFF, 0);
    setjob(4, d_in[19], ws + WS_WO, 2048, 2048, 2048, 2048, 0);
    setjob(5, d_in[17], ws + WS_WAB, 2048, 1024, 2048, 2048, 0);
    setjob(6, d_in[18], ws + WS_WAB + 1024 * 2, 2048, 1024, 2048, 2048, 0);
    for (int g = 0; g < 4; ++g) setjob(7 + g, (const float*)d_in[15] + g * 65536, ws + WS_PW + (size_t)g * 65536 * 2, 256, 256, 256, 256, 0);
#if MK_PER_PHASE
    for (int ph = 0; ph < N_PHASES; ++ph) { ka.p.ph_lo = ph; ka.p.ph_hi = ph + 1; hipLaunchKernelGGL(fwd_megakernel, dim3(grid), dim3(512), LDS_BYTES, stream, ka); }
#else
    ka.p.ph_lo = 0; ka.p.ph_hi = N_PHASES;
    void* args[] = {&ka};
    hipError_t e = hipLaunchCooperativeKernel((const void*)fwd_megakernel, dim3(grid), dim3(512), args, LDS_BYTES, stream);
    if (e != hipSuccess) fprintf(stderr, "cooperative launch failed: %s (grid %d)\n", hipGetErrorString(e), grid);
#endif
}
```

```cpp
#include <hip/hip_runtime.h>
#include <hip/hip_cooperative_groups.h>
#include <cstdio>
#include <cstring>
namespace cg = cooperative_groups;

#ifndef MK_PER_PHASE
#define MK_PER_PHASE 0
#endif

#define LAS __attribute__((address_space(3)))
typedef unsigned short bf16_t;
typedef short bf16x8 __attribute__((ext_vector_type(8)));
typedef float f32x4 __attribute__((ext_vector_type(4)));
typedef float f32x2 __attribute__((ext_vector_type(2)));
typedef unsigned u32x4 __attribute__((ext_vector_type(4)));
typedef unsigned u32x2 __attribute__((ext_vector_type(2)));

constexpr int DM = 2048, TP = 8192, TS = 512, TT = 8704, NB = 132;
constexpr int NPROJ = 9472;
constexpr int DFF = 5632;
constexpr int MODW = 12288;
constexpr float EPS = 1e-6f;
constexpr int C_Q = 0, C_K = 1024, C_V = 2048, C_Z = 3072, C_XP = 4096, C_GA = 5120, C_GB = 7168, C_AB = 9216;
constexpr size_t O_Y = 0, O_DP = 17825792, O_CP = 18350080, O_PP = 18386944, O_DS = 18448384, O_CS = 35225600, O_PS = 36405248;
constexpr size_t OS_O = 0, OS_UB = 8912896;
constexpr size_t WS_WIN = 0;
constexpr size_t WS_WGU = WS_WIN + (size_t)NPROJ * 2048 * 2;
constexpr size_t WS_WD = WS_WGU + (size_t)11264 * 2048 * 2;
constexpr size_t WS_WO = WS_WD + (size_t)2048 * 5632 * 2;
constexpr size_t WS_WAB = WS_WO + (size_t)2048 * 2048 * 2;
constexpr size_t WS_PW = WS_WAB + (size_t)2048 * 2048 * 2;
constexpr size_t WS_AADA = WS_PW + (size_t)1024 * 256 * 2;
constexpr size_t WS_MOD = WS_AADA + (size_t)256 * 2048 * 2;
constexpr size_t WS_G = WS_MOD + (size_t)NB * MODW * 4;
constexpr size_t WS_BETA = WS_G + (size_t)TT * 8 * 4;
constexpr size_t WS_CD = WS_BETA + (size_t)TT * 8 * 4;
constexpr size_t WS_U = WS_CD + 4096;
constexpr size_t WS_QN = WS_U + (size_t)TT * 2048 * 2;
constexpr size_t WS_KN = WS_QN + (size_t)TT * 1024 * 2;
constexpr size_t WS_VV = WS_KN + (size_t)TT * 1024 * 2;
constexpr size_t WS_YP = WS_VV + (size_t)TT * 1024 * 2;
constexpr size_t WS_WDC = WS_YP + (size_t)TT * 1024 * 2;
constexpr size_t WS_QD = WS_WDC + (size_t)1024 * 64 * 128 * 2;
constexpr size_t WS_KT = WS_QD + (size_t)1024 * 64 * 128 * 2;
constexpr size_t WS_QK = WS_KT + (size_t)1024 * 64 * 128 * 2;
constexpr size_t WS_PROJ = WS_QK + (size_t)1024 * 64 * 64 * 2;
constexpr size_t WS_END = WS_PROJ + (size_t)TT * NPROJ * 2;
constexpr size_t WS_PB10 = WS_PROJ;
constexpr size_t WS_PB13 = WS_PROJ + (size_t)TT * DFF * 2;
static_assert(WS_PB13 + (size_t)11 * TS * DM * 4 <= WS_END && (WS_PB13 % 256) == 0, "partials");
static_assert(WS_END + 16384 <= 501510720ull, "workspace too large");
static_assert((WS_PROJ % 256) == 0 && (WS_QK % 256) == 0 && (WS_U % 256) == 0, "align");

constexpr int LDS_BYTES = 147456;

struct Params {
    const float* in[24];
    float* out;
    unsigned char* ws;
    int ph_lo, ph_hi;
};

__device__ __forceinline__ float bf2f(unsigned short x) { return __uint_as_float(((unsigned)x) << 16); }
__device__ __forceinline__ unsigned short f2bf(float f) { const __bf16 b = (__bf16)f; return __builtin_bit_cast(unsigned short, b); }
typedef __bf16 bf16x2_hw __attribute__((ext_vector_type(2)));
__device__ __forceinline__ unsigned pk2(float lo, float hi) { const f32x2 v = {lo, hi}; const bf16x2_hw b = __builtin_convertvector(v, bf16x2_hw); return __builtin_bit_cast(unsigned, b); }
__device__ __forceinline__ void unpack8(const u32x4 w, float* f) {
    f[0] = __uint_as_float(w.x << 16); f[1] = __uint_as_float(w.x & 0xffff0000u);
    f[2] = __uint_as_float(w.y << 16); f[3] = __uint_as_float(w.y & 0xffff0000u);
    f[4] = __uint_as_float(w.z << 16); f[5] = __uint_as_float(w.z & 0xffff0000u);
    f[6] = __uint_as_float(w.w << 16); f[7] = __uint_as_float(w.w & 0xffff0000u);
}
__device__ __forceinline__ u32x4 pack8(const float* f) { u32x4 w; w.x = pk2(f[0], f[1]); w.y = pk2(f[2], f[3]); w.z = pk2(f[4], f[5]); w.w = pk2(f[6], f[7]); return w; }
__device__ __forceinline__ float sigmoidf_(float x) { return __builtin_amdgcn_rcpf(1.0f + __expf(-x)); }
__device__ __forceinline__ float siluf_(float x) { return x * __builtin_amdgcn_rcpf(1.0f + __expf(-x)); }
__device__ __forceinline__ int bidx_of_row(int row) { return row < TP ? (row >> 11) : 4 + ((row - TP) >> 2); }

namespace pg8 {
constexpr int BM = 256, BK = 64, HALF = 128, HTB = HALF * BK * 2, STAGE_BYTES = 8 * HTB, NXCD = 8, WGM = 8;
__host__ __device__ __forceinline__ int lds_byte(int r, int c) { const int st = (r >> 4) * 2 + (c >> 5), rr = r & 15, cc = c & 31, ob = rr * 64 + cc * 2; return st * 1024 + (ob ^ (((ob >> 9) & 1) << 5)); }
__host__ __device__ __forceinline__ void stage_rc(int b, int& R, int& C) { const int st = b / 1024, sb = b % 1024, swz = sb ^ (((sb >> 9) & 1) << 5); R = (st >> 1) * 16 + swz / 64; C = (st & 1) * 32 + (swz % 64) / 2; }
__host__ __device__ __forceinline__ int perm32(int rho) { const int n = rho >> 4, i = rho & 15; return 8 * (i >> 2) + 4 * n + (i & 3); }

struct Unit { int pm, pn, kt0, nkt, piece; };
struct Gemm { const bf16_t* A; const bf16_t* Bt; int lda, ldb, K; size_t a_pn_off; size_t a_half, b_half, a_tile, b_tile; };

__device__ __forceinline__ void tile_of(int wgid, int nM, int nN, Unit& u) {
    const int nwg = nM * nN;
    { const int q = nwg / NXCD, r = nwg % NXCD, xcd = wgid % NXCD, off = wgid / NXCD; wgid = (xcd < r ? xcd * (q + 1) : r * (q + 1) + (xcd - r) * q) + off; }
    const int nig = WGM * nN, gid = wgid / nig, fm = gid * WGM, gsz = (nM - fm) < WGM ? (nM - fm) : WGM;
    u.pm = fm + ((wgid % nig) % gsz); u.pn = (wgid % nig) / gsz;
}
struct StaticOrder {
    int nM, nN, nwg, G, c, ntk;
    __device__ __forceinline__ void init(int M, int N, int K, int G_, int c_) { nM = M / BM; nN = N / BM; nwg = nM * nN; G = G_; c = c_; ntk = K / BK; }
    __device__ __forceinline__ bool next(int i, Unit& u) const {
        const long L = (long)i * G + c; if (L >= nwg) return false;
        tile_of((int)L, nM, nN, u); u.kt0 = 0; u.nkt = ntk; u.piece = -1; return true;
    }
};
struct OneUnitOrder {
    int n, c, ntk;
    __device__ __forceinline__ bool next(int i, Unit& u) const { if (i != 0 || c >= n) return false; u.pm = 0; u.pn = c; u.kt0 = 0; u.nkt = ntk; u.piece = -1; return true; }
};
struct DoubleOrder {
    int G, c;
    __device__ __forceinline__ bool next(int i, Unit& u) const {
        const int L = (i >> 1) * G + c, half = i & 1; const bool ok = L < 272;
        tile_of(ok ? L : 0, 34, 8, u); u.kt0 = 16 * half; u.nkt = 16; u.piece = half; return ok;
    }
};
struct SplitOrder {
    int G, c, ntk, pk, npc;
    __device__ __forceinline__ bool next(int i, Unit& u) const {
        const int L = i * G + c;
        const bool full = L < 256;
        int fpm, fpn;
        { int wgid = full ? L : 0; const int xcd = wgid % NXCD, off = wgid / NXCD; wgid = xcd * 32 + off;
          const int nig = WGM * 8, gid = wgid / nig, fm = gid * WGM; fpm = fm + ((wgid % nig) % WGM); fpn = (wgid % nig) / WGM; }
        const int pidx = full ? 0 : L - 256, tile = pidx / npc, pc = pidx - tile * npc;
        u.pm = full ? fpm : 32 + (tile >> 3); u.pn = full ? fpn : (tile & 7); u.kt0 = full ? 0 : pc * pk; u.nkt = full ? ntk : pk; u.piece = full ? -1 : pc;
        return full || pidx < 16 * npc;
    }
};

template <class Epi, class Sched>
__device__ __forceinline__ void gemm_phase(LAS unsigned char* lds, const Gemm g, const Sched& S, const Epi& E) {
    const int tid = threadIdx.x, wid = __builtin_amdgcn_readfirstlane(tid >> 6), lane = tid & 63, wr = wid >> 2, wc = wid & 3, fr = lane & 15, fq = lane >> 4;
    unsigned voffA[2], voffB[2];
#pragma unroll
    for (int i = 0; i < 2; ++i) { int R, C; stage_rc(tid * 16 + i * 8192, R, C); const int Rb = Epi::PERM ? ((R & ~31) + perm32(R & 31)) : R;
        voffA[i] = (unsigned)(R * g.lda + C) * 2u; voffB[i] = (unsigned)(Rb * g.ldb + C) * 2u; }
    const size_t kstep = (size_t)(BK * 2);
    const size_t hstepA = g.a_half ? g.a_half : (size_t)HALF * g.lda * 2, hstepB = g.b_half ? g.b_half : (size_t)HALF * g.ldb * 2;
    const size_t tstepA = g.a_tile ? g.a_tile : (size_t)BM * g.lda * 2, tstepB = g.b_tile ? g.b_tile : (size_t)BM * g.ldb * 2;
    const unsigned ldsw = (unsigned)wid * 1024u;
    const int aoff = lds_byte(wr * 64 + fr, fq * 8), boff = lds_byte(wc * 32 + fr, fq * 8);
#define PG8_SA(b, h) (((b) * 2 + (h)) * HTB)
#define PG8_SB(b, h) ((4 + (b) * 2 + (h)) * HTB)
#define PG8_STAGE(bufoff, gbase, voff) do { _Pragma("unroll") for (int _i = 0; _i < 2; ++_i) \
        __builtin_amdgcn_global_load_lds((const unsigned*)((const char*)(gbase) + (voff)[_i]), (LAS unsigned*)(lds + (bufoff) + ldsw + _i * 8192), 16, 0, 0); } while (0)
#define PG8_LDA(dst, b, h) do { _Pragma("unroll") for (int m = 0; m < 4; ++m) _Pragma("unroll") for (int k = 0; k < 2; ++k) dst[m][k] = *(const LAS bf16x8*)(lds + PG8_SA(b, h) + aoff + m * 2048 + k * 1024); } while (0)
#define PG8_LDB(dst, b, h) do { _Pragma("unroll") for (int n = 0; n < 2; ++n) _Pragma("unroll") for (int k = 0; k < 2; ++k) dst[n][k] = *(const LAS bf16x8*)(lds + PG8_SB(b, h) + boff + n * 2048 + k * 1024); } while (0)
#define PG8_MMA(ai, bj, At, Bt) do { __builtin_amdgcn_s_setprio(1); _Pragma("unroll") for (int m = 0; m < 4; ++m) _Pragma("unroll") for (int n = 0; n < 2; ++n) _Pragma("unroll") for (int k = 0; k < 2; ++k) \
        acc[ai][bj][m][n] = __builtin_amdgcn_mfma_f32_16x16x32_bf16(Bt[n][k], At[m][k], acc[ai][bj][m][n], 0, 0, 0); __builtin_amdgcn_s_setprio(0); } while (0)
#define PG8_WAIT_V(n) asm volatile("s_waitcnt vmcnt(" #n ")" ::: "memory")
#define PG8_WAIT_L(n) asm volatile("s_waitcnt lgkmcnt(" #n ")" ::: "memory")
#define PG8_BAR __builtin_amdgcn_s_barrier()
#define PG8_SCHED __builtin_amdgcn_sched_barrier(0)
    Unit cur, nxt; int ui = 0;
    if (!S.next(0, cur)) return;
    f32x4 acc[2][2][4][2];
#pragma unroll
    for (int a = 0; a < 2; ++a)
#pragma unroll
        for (int b = 0; b < 2; ++b)
#pragma unroll
            for (int m = 0; m < 4; ++m)
#pragma unroll
                for (int n = 0; n < 2; ++n) acc[a][b][m][n] = (f32x4){0.f, 0.f, 0.f, 0.f};
    bf16x8 At[4][2], B0[2][2], B1[2][2];
    const char* cA = (const char*)g.A + (size_t)cur.pm * tstepA + (size_t)cur.pn * g.a_pn_off + (size_t)cur.kt0 * kstep; const char* cB = (const char*)g.Bt + (size_t)cur.pn * tstepB + (size_t)cur.kt0 * kstep;
    PG8_STAGE(PG8_SB(0, 0), cB, voffB); PG8_STAGE(PG8_SA(0, 0), cA, voffA); PG8_STAGE(PG8_SB(0, 1), cB + hstepB, voffB); PG8_STAGE(PG8_SA(0, 1), cA + hstepA, voffA);
    if (wr == 1) PG8_BAR;
    PG8_WAIT_V(4); PG8_BAR;
    PG8_STAGE(PG8_SB(1, 0), cB + kstep, voffB); PG8_STAGE(PG8_SA(1, 0), cA + kstep, voffA); PG8_STAGE(PG8_SB(1, 1), cB + hstepB + kstep, voffB);
    PG8_WAIT_V(6); PG8_BAR;
    for (;;) {
        const bool has_next = S.next(ui + 1, nxt);
        const char* nA = has_next ? (const char*)g.A + (size_t)nxt.pm * tstepA + (size_t)nxt.pn * g.a_pn_off + (size_t)nxt.kt0 * kstep : cA; const char* nB = has_next ? (const char*)g.Bt + (size_t)nxt.pn * tstepB + (size_t)nxt.kt0 * kstep : cB;
        const int nt = cur.nkt;
#pragma unroll 1
        for (int t = 0; t < nt; t += 2) {
            const bool last = (t == nt - 2);
            const char* a1 = cA + (size_t)(t + 1) * kstep;
            const char* a2 = last ? nA : cA + (size_t)(t + 2) * kstep; const char* b2 = last ? nB : cB + (size_t)(t + 2) * kstep;
            const char* a3 = a2 + kstep; const char* b3 = b2 + kstep;
            PG8_LDB(B0, 0, 0); PG8_SCHED; PG8_LDA(At, 0, 0); PG8_STAGE(PG8_SA(1, 1), a1 + hstepA, voffA);
            PG8_WAIT_L(8); PG8_BAR; PG8_WAIT_L(0); PG8_MMA(0, 0, At, B0); PG8_BAR; PG8_SCHED;
            PG8_LDB(B1, 0, 1); PG8_STAGE(PG8_SB(0, 0), b2, voffB);
            PG8_BAR; PG8_WAIT_L(0); if constexpr (!Epi::DIAG) PG8_MMA(0, 1, At, B1); PG8_BAR;
            PG8_LDA(At, 0, 1); PG8_STAGE(PG8_SA(0, 0), a2, voffA);
            PG8_BAR; PG8_WAIT_L(0); if constexpr (!Epi::DIAG) PG8_MMA(1, 0, At, B0); PG8_BAR; PG8_SCHED;
            PG8_STAGE(PG8_SB(0, 1), b2 + hstepB, voffB);
            PG8_WAIT_V(6); PG8_BAR; PG8_MMA(1, 1, At, B1); PG8_BAR;
            PG8_LDB(B0, 1, 0); PG8_SCHED; PG8_LDA(At, 1, 0); PG8_STAGE(PG8_SA(0, 1), a2 + hstepA, voffA);
            PG8_WAIT_L(8); PG8_BAR; PG8_WAIT_L(0); PG8_MMA(0, 0, At, B0); PG8_BAR; PG8_SCHED;
            PG8_LDB(B1, 1, 1); PG8_STAGE(PG8_SB(1, 0), b3, voffB);
            PG8_BAR; PG8_WAIT_L(0); if constexpr (!Epi::DIAG) PG8_MMA(0, 1, At, B1); PG8_BAR;
            PG8_LDA(At, 1, 1); PG8_STAGE(PG8_SA(1, 0), a3, voffA);
            PG8_BAR; PG8_WAIT_L(0); if constexpr (!Epi::DIAG) PG8_MMA(1, 0, At, B0); PG8_BAR; PG8_SCHED;
            PG8_STAGE(PG8_SB(1, 1), b3 + hstepB, voffB);
            PG8_WAIT_V(6); PG8_BAR; PG8_MMA(1, 1, At, B1); PG8_BAR;
        }
        E(acc, cur, wr, wc, fr, fq);
        if (!has_next) break;
#pragma unroll
        for (int a = 0; a < 2; ++a)
#pragma unroll
            for (int b = 0; b < 2; ++b)
#pragma unroll
                for (int m = 0; m < 4; ++m)
#pragma unroll
                    for (int n = 0; n < 2; ++n) acc[a][b][m][n] = (f32x4){0.f, 0.f, 0.f, 0.f};
        cur = nxt; cA = nA; cB = nB; ++ui;
    }
    PG8_WAIT_V(0);
    if (wr == 0) PG8_BAR;
    PG8_BAR;
#undef PG8_SA
#undef PG8_SB
#undef PG8_STAGE
#undef PG8_LDA
#undef PG8_LDB
#undef PG8_MMA
#undef PG8_WAIT_V
#undef PG8_WAIT_L
#undef PG8_BAR
#undef PG8_SCHED
}

typedef f32x4 Acc[2][2][4][2];

struct EpiAda {
    static constexpr bool PERM = false, MID = false, DIAG = false;
    float* C; const float* bias;
    __device__ __forceinline__ void operator()(const Acc& acc, const Unit& u, int wr, int wc, int fr, int fq) const {
        const int row0 = wr * 64 + fr, col0 = u.pn * BM + wc * 32 + 4 * fq;
#pragma unroll
        for (int ai = 0; ai < 2; ++ai)
#pragma unroll
            for (int m = 0; m < 4; ++m) { const int row = row0 + ai * HALF + m * 16; if (row < NB) {
#pragma unroll
                for (int bj = 0; bj < 2; ++bj)
#pragma unroll
                    for (int n = 0; n < 2; ++n) { const int c = col0 + bj * HALF + n * 16; *(f32x4*)(C + (size_t)row * MODW + c) = acc[ai][bj][m][n] + *(const f32x4*)(bias + c); } } }
    }
};
struct EpiBf16 {
    static constexpr bool PERM = true, MID = false, DIAG = false;
    bf16_t* O; int ldc; int col_off; const float* scale;
    __device__ __forceinline__ void operator()(const Acc& acc, const Unit& u, int wr, int wc, int fr, int fq) const {
        const int row0 = u.pm * BM + wr * 64 + fr, col0 = u.pn * BM + wc * 32 + 8 * fq;
#pragma unroll
        for (int ai = 0; ai < 2; ++ai)
#pragma unroll
            for (int m = 0; m < 4; ++m) { bf16_t* rowp = O + (size_t)(row0 + ai * HALF + m * 16) * ldc + col_off + col0;
#pragma unroll
                for (int bj = 0; bj < 2; ++bj) { f32x4 v0 = acc[ai][bj][m][0], v1 = acc[ai][bj][m][1];
                    if (scale) { v0 *= *(const f32x4*)(scale + col0 + bj * HALF); v1 *= *(const f32x4*)(scale + col0 + bj * HALF + 4); }
                    u32x4 w; w.x = pk2(v0[0], v0[1]); w.y = pk2(v0[2], v0[3]); w.z = pk2(v1[0], v1[1]); w.w = pk2(v1[2], v1[3]);
                    *(u32x4*)(rowp + bj * HALF) = w; }
                if (scale) asm volatile("" ::: "memory"); }
    }
};
struct EpiG1 {
    static constexpr bool PERM = true, MID = false, DIAG = false;
    float* T1; const bf16_t* proj;
    __device__ __forceinline__ void operator()(const Acc& acc, const Unit& u, int wr, int wc, int fr, int fq) const {
        const int row0 = u.pm * BM + wr * 64 + fr, col0 = u.pn * BM + wc * 32 + 8 * fq;
#pragma unroll
        for (int ai = 0; ai < 2; ++ai)
#pragma unroll
            for (int m = 0; m < 4; ++m) { const size_t row = (size_t)(row0 + ai * HALF + m * 16); const bf16_t* pr = proj + row * NPROJ + col0;
#pragma unroll
                for (int bj = 0; bj < 2; ++bj) { float ga[8]; unpack8(*(const u32x4*)(pr + C_GA + bj * HALF), ga); f32x4 v0, v1;
#pragma unroll
                    for (int j = 0; j < 4; ++j) { v0[j] = acc[ai][bj][m][0][j] * __builtin_amdgcn_rcpf(1.0f + __expf(-ga[j])); v1[j] = acc[ai][bj][m][1][j] * __builtin_amdgcn_rcpf(1.0f + __expf(-ga[4 + j])); }
                    float* o = T1 + row * DM + col0 + bj * HALF; *(f32x4*)o = v0; *(f32x4*)(o + 4) = v1; }
                }
    }
};
struct EpiG2 {
    static constexpr bool PERM = true, MID = false, DIAG = false;
    bf16_t* O; const float* T1; const bf16_t* proj;
    __device__ __forceinline__ void operator()(const Acc& acc, const Unit& u, int wr, int wc, int fr, int fq) const {
        const int row0 = u.pm * BM + wr * 64 + fr, col0 = u.pn * BM + wc * 32 + 8 * fq;
#pragma unroll
        for (int ai = 0; ai < 2; ++ai)
#pragma unroll
            for (int m = 0; m < 4; ++m) { const size_t row = (size_t)(row0 + ai * HALF + m * 16); const bf16_t* pr = proj + row * NPROJ + col0;
#pragma unroll
                for (int bj = 0; bj < 2; ++bj) { float gb[8], v[8]; unpack8(*(const u32x4*)(pr + C_GB + bj * HALF), gb);
                    const float* t = T1 + row * DM + col0 + bj * HALF; const f32x4 t0 = *(const f32x4*)t, t1 = *(const f32x4*)(t + 4);
#pragma unroll
                    for (int j = 0; j < 4; ++j) { v[j] = t0[j] + acc[ai][bj][m][0][j] * __builtin_amdgcn_rcpf(1.0f + __expf(-gb[j])); v[4 + j] = t1[j] + acc[ai][bj][m][1][j] * __builtin_amdgcn_rcpf(1.0f + __expf(-gb[4 + j])); }
                    *(u32x4*)(O + row * DM + col0 + bj * HALF) = pack8(v); }
                if (m & 1) asm volatile("" ::: "memory"); }
    }
};
struct EpiG12 {
    static constexpr bool PERM = true, MID = false, DIAG = false;
    EpiG1 e1; EpiG2 e2;
    __device__ __forceinline__ void operator()(const Acc& acc, const Unit& u, int wr, int wc, int fr, int fq) const { if (u.piece == 0) e1(acc, u, wr, wc, fr, fq); else e2(acc, u, wr, wc, fr, fq); }
};
struct EpiDiag {
    static constexpr bool PERM = true, MID = false, DIAG = true;
    bf16_t* O; const bf16_t* proj;
    __device__ __forceinline__ void operator()(const Acc& acc, const Unit& u, int wr, int wc, int fr, int fq) const {
        const int row0 = u.pm * HALF + wr * 64 + fr, col0 = u.pn * HALF + wc * 32 + 8 * fq;
#pragma unroll
        for (int m = 0; m < 4; ++m) { const size_t row = (size_t)(row0 + m * 16); const bf16_t* pr = proj + row * NPROJ + col0;
            float ga[8], gb[8], v[8]; unpack8(*(const u32x4*)(pr + C_GA), ga); unpack8(*(const u32x4*)(pr + C_GB), gb);
#pragma unroll
            for (int n = 0; n < 2; ++n)
#pragma unroll
                for (int j = 0; j < 4; ++j) v[4 * n + j] = acc[0][0][m][n][j] * __builtin_amdgcn_rcpf(1.0f + __expf(-ga[4 * n + j])) + acc[1][1][m][n][j] * __builtin_amdgcn_rcpf(1.0f + __expf(-gb[4 * n + j]));
            *(u32x4*)(O + row * DM + col0) = pack8(v); }
    }
};
struct EpiRes {
    static constexpr bool PERM = false, MID = false, DIAG = false;
    float* X1; const float* x0p; const float* x0s; const float* gate; float* PB;
    __device__ __forceinline__ void operator()(const Acc& acc, const Unit& u, int wr, int wc, int fr, int fq) const {
        const int row0 = u.pm * BM + wr * 64 + fr, col0 = u.pn * BM + wc * 32 + 4 * fq;
        if (u.piece >= 0) {
            float* pb = PB + (size_t)u.piece * TS * DM;
#pragma unroll
            for (int ai = 0; ai < 2; ++ai)
#pragma unroll
                for (int m = 0; m < 4; ++m) { float* orow = pb + (size_t)(row0 + ai * HALF + m * 16 - TP) * DM;
#pragma unroll
                    for (int bj = 0; bj < 2; ++bj)
#pragma unroll
                        for (int n = 0; n < 2; ++n) *(f32x4*)(orow + col0 + bj * HALF + n * 16) = acc[ai][bj][m][n]; }
            return;
        }
#pragma unroll
        for (int ai = 0; ai < 2; ++ai)
#pragma unroll
            for (int m = 0; m < 4; ++m) { const int row = row0 + ai * HALF + m * 16; const int b = bidx_of_row(row);
                const float* xr = (row < TP) ? x0p + (size_t)row * DM : x0s + (size_t)(row - TP) * DM; const float* gr = gate + (size_t)b * MODW; float* orow = X1 + (size_t)row * DM;
#pragma unroll
                for (int bj = 0; bj < 2; ++bj)
#pragma unroll
                    for (int n = 0; n < 2; ++n) { const int c = col0 + bj * HALF + n * 16; const f32x4 xv = *(const f32x4*)(xr + c), gv = *(const f32x4*)(gr + c);
                        *(f32x4*)(orow + c) = xv + gv * acc[ai][bj][m][n]; } }
    }
};
struct EpiGU {
    static constexpr bool PERM = true, MID = false, DIAG = false;
    bf16_t* O;
    __device__ __forceinline__ void operator()(const Acc& acc, const Unit& u, int wr, int wc, int fr, int fq) const {
        const int row0 = u.pm * BM + wr * 64 + fr, col0 = u.pn * HALF + wc * 32 + 8 * fq;
#pragma unroll
        for (int ai = 0; ai < 2; ++ai)
#pragma unroll
            for (int m = 0; m < 4; ++m) { float v[8];
#pragma unroll
                for (int n = 0; n < 2; ++n)
#pragma unroll
                    for (int j = 0; j < 4; ++j) { const float gt = acc[ai][0][m][n][j]; v[4 * n + j] = gt * __builtin_amdgcn_rcpf(1.0f + __expf(-gt)) * acc[ai][1][m][n][j]; }
                *(u32x4*)(O + (size_t)(row0 + ai * HALF + m * 16) * DFF + col0) = pack8(v); }
    }
};
}

struct TJob { const float* src; bf16_t* dst; int ld_src, K, Nout, ld_dst, map, pad; };
__device__ __forceinline__ int map_col(int map, int n) {
    if (map == 1) { if (n < 4096) return n; if (n < 5120) return 4112 + (n - 4096); if (n < 9216) return 5136 + (n - 5120); if (n < 9232) return 4096 + (n - 9216); return -1; }
    if (map == 2) { const int pn = n >> 8, w = n & 255; return w < 128 ? 128 * pn + w : DFF + 128 * pn + (w - 128); }
    return n;
}
__device__ __forceinline__ void tjob_load(const TJob& j, int tile, f32x4 (&v)[4]) {
    const int tid = threadIdx.x, nkt = j.K >> 7, tn = tile / nkt, tk = tile - tn * nkt;
    const int n = tn * 64 + (tid & 15) * 4, kr = tid >> 4, col = map_col(j.map, n);
#pragma unroll
    for (int i = 0; i < 4; ++i) v[i] = col >= 0 ? __builtin_nontemporal_load((const f32x4*)(j.src + (size_t)(tk * 128 + kr + 32 * i) * j.ld_src + col)) : (f32x4){0.f, 0.f, 0.f, 0.f};
}
__device__ __forceinline__ void tjob_store(const TJob& j, int tile, const f32x4 (&v)[4], LAS float* s) {
    const int tid = threadIdx.x, nkt = j.K >> 7, tn = tile / nkt, tk = tile - tn * nkt;
    const int nq = tid & 15, kr = tid >> 4;
    __syncthreads();
#pragma unroll
    for (int i = 0; i < 4; ++i)
#pragma unroll
        for (int q = 0; q < 4; ++q) s[(4 * nq + q) * 129 + kr + 32 * i] = v[i][q];
    __syncthreads();
    const int n = tid >> 3, k16 = (tid & 7) * 16;
    float f[16];
#pragma unroll
    for (int i = 0; i < 16; ++i) f[i] = s[n * 129 + k16 + i];
    bf16_t* d = j.dst + (size_t)(tn * 64 + n) * j.ld_dst + tk * 128 + k16;
    *(u32x4*)d = pack8(f); *(u32x4*)(d + 8) = pack8(f + 8);
}
__device__ __forceinline__ void transpose_jobs(const TJob* jobs, int njobs, int bi, int nblk, LAS unsigned char* lds) {
    LAS float* s = (LAS float*)lds;
    int total = 0;
    for (int q = 0; q < njobs; ++q) total += (jobs[q].Nout >> 6) * (jobs[q].K >> 7);
    f32x4 v[4]; int curj = 0, base = 0;
    int t = bi;
    auto locate = [&](int tt, int& jj, int& bb) { while (tt >= bb + (jobs[jj].Nout >> 6) * (jobs[jj].K >> 7)) { bb += (jobs[jj].Nout >> 6) * (jobs[jj].K >> 7); ++jj; } };
    if (t < total) { locate(t, curj, base); tjob_load(jobs[curj], t - base, v); }
    while (t < total) {
        const int tn = t + nblk; int nj = curj, nb = base; f32x4 w[4];
        if (tn < total) { locate(tn, nj, nb); tjob_load(jobs[nj], tn - nb, w); }
        tjob_store(jobs[curj], t - base, v, s);
        if (tn < total) {
#pragma unroll
            for (int i = 0; i < 4; ++i) v[i] = w[i]; }
        t = tn; curj = nj; base = nb;
    }
    __syncthreads();
}

template <int MODE>
__device__ __forceinline__ void norm_phase(const Params& p, int bid, int nblk) {
    const int lane = threadIdx.x & 63, wid = __builtin_amdgcn_readfirstlane(threadIdx.x >> 6);
    const float* mod = (const float*)(p.ws + WS_MOD);
    const float* gain = MODE == 0 ? p.in[9] : (MODE == 1 ? p.in[20] : p.in[23]);
    bf16_t* U = (bf16_t*)(p.ws + WS_U);
    for (int row = bid * 8 + wid; row < TT; row += nblk * 8) {
        const float* src = MODE == 0 ? (row < TP ? p.in[0] + (size_t)row * DM : p.in[1] + (size_t)(row - TP) * DM) : p.out + O_Y + (size_t)row * DM;
        if (MODE != 0 && row >= TP) {
            const float* xs = p.in[1] + (size_t)(row - TP) * DM;
            const float* pb = (const float*)(p.ws + (MODE == 1 ? WS_PB10 : WS_PB13)) + (size_t)(row - TP) * DM;
            const float* gt = mod + (size_t)bidx_of_row(row) * MODW + (MODE == 1 ? 4096 : 10240);
            float* xo = p.out + O_Y + (size_t)row * DM;
            constexpr int NPC = MODE == 1 ? 8 : 11;
#pragma unroll 1
            for (int i = 0; i < 8; ++i) { const int c = i * 256 + lane * 4; f32x4 s = *(const f32x4*)(pb + c);
#pragma unroll
                for (int q = 1; q < NPC; ++q) s += *(const f32x4*)(pb + (size_t)q * TS * DM + c);
                const f32x4 base = MODE == 1 ? *(const f32x4*)(xs + c) : *(const f32x4*)(xo + c);
                *(f32x4*)(xo + c) = base + *(const f32x4*)(gt + c) * s; }
            asm volatile("s_waitcnt vmcnt(0)" ::: "memory");
        }
        f32x4 v[8]; float ss = 0.f;
#pragma unroll
        for (int i = 0; i < 8; ++i) v[i] = *(const f32x4*)(src + i * 256 + lane * 4);
#pragma unroll
        for (int i = 0; i < 8; ++i) ss += v[i][0] * v[i][0] + v[i][1] * v[i][1] + v[i][2] * v[i][2] + v[i][3] * v[i][3];
#pragma unroll
        for (int o = 32; o >= 1; o >>= 1) ss += __shfl_xor(ss, o);
        const float rstd = rsqrtf(ss * (1.0f / DM) + EPS);
        if (MODE == 2) {
            float* dst = p.out + O_Y + (size_t)row * DM;
#pragma unroll
            for (int i = 0; i < 8; ++i) { const f32x4 g = *(const f32x4*)(gain + i * 256 + lane * 4); *(f32x4*)(dst + i * 256 + lane * 4) = v[i] * rstd * g; }
        } else {
            const float* sh = mod + (size_t)bidx_of_row(row) * MODW + (MODE == 0 ? 0 : 6144); const float* sc = sh + 2048;
#pragma unroll
            for (int i = 0; i < 8; ++i) { const int c = i * 256 + lane * 4; const f32x4 g = *(const f32x4*)(gain + c), s1 = *(const f32x4*)(sc + c), s0 = *(const f32x4*)(sh + c);
                const f32x4 y = (v[i] * rstd * g) * (1.0f + s1) + s0; u32x2 w; w.x = pk2(y[0], y[1]); w.y = pk2(y[2], y[3]); *(u32x2*)(U + (size_t)row * DM + c) = w; }
        }
    }
}

template <int NTOK, bool SMP>
__device__ __forceinline__ void mixer_item(const Params& p, int it) {
    const int tid = threadIdx.x;
    const bf16_t* proj = (const bf16_t*)(p.ws + WS_PROJ);
    bf16_t* qn = (bf16_t*)(p.ws + WS_QN); bf16_t* kn = (bf16_t*)(p.ws + WS_KN); bf16_t* vv = (bf16_t*)(p.ws + WS_VV); bf16_t* yp = (bf16_t*)(p.ws + WS_YP);
    float* gbuf = (float*)(p.ws + WS_G); float* bbuf = (float*)(p.ws + WS_BETA);
    const int sb = it - 512;
    const int b = SMP ? 0 : (it >> 7), t0 = SMP ? 0 : (it & 127) * 16;
    const int rowbase = SMP ? TP + sb * 4 : b * 2048 + t0;
    if (tid < 384) {
        const int c0 = tid * 8;
        float w0[8], w1[8], w2[8], w3[8], xm3[8], xm2[8], xm1[8];
        const float* cw = p.in[11];
#pragma unroll
        for (int i = 0; i < 8; ++i) { w0[i] = cw[c0 + i]; w1[i] = cw[3072 + c0 + i]; w2[i] = cw[6144 + c0 + i]; w3[i] = cw[9216 + c0 + i]; }
        if (SMP) { const float* sc = p.in[5] + (size_t)sb * 3 * 3072 + c0;
#pragma unroll
            for (int i = 0; i < 8; ++i) { xm3[i] = sc[i]; xm2[i] = sc[3072 + i]; xm1[i] = sc[6144 + i]; }
        } else if (t0 == 0) {
#pragma unroll
            for (int i = 0; i < 8; ++i) { xm3[i] = 0.f; xm2[i] = 0.f; xm1[i] = 0.f; }
        } else {
            unpack8(*(const u32x4*)(proj + (size_t)(rowbase - 3) * NPROJ + c0), xm3); unpack8(*(const u32x4*)(proj + (size_t)(rowbase - 2) * NPROJ + c0), xm2); unpack8(*(const u32x4*)(proj + (size_t)(rowbase - 1) * NPROJ + c0), xm1);
        }
        constexpr int CH = NTOK < 8 ? NTOK : 8;
#pragma unroll
        for (int tc = 0; tc < NTOK; tc += CH) {
        u32x4 xr[CH];
#pragma unroll
        for (int t = 0; t < CH; ++t) xr[t] = *(const u32x4*)(proj + (size_t)(rowbase + tc + t) * NPROJ + c0);
#pragma unroll
        for (int t2 = 0; t2 < CH; ++t2) {
            const int t = tc + t2;
            const int row = rowbase + t; float xt[8], y[8];
            unpack8(xr[t2], xt);
            float ss = 0.f;
#pragma unroll
            for (int i = 0; i < 8; ++i) { const float a = w0[i] * xm3[i] + w1[i] * xm2[i] + w2[i] * xm1[i] + w3[i] * xt[i]; y[i] = siluf_(a); ss += y[i] * y[i]; }
            if (c0 < 2048) {
                ss += __shfl_xor(ss, 1); ss += __shfl_xor(ss, 2); ss += __shfl_xor(ss, 4); ss += __shfl_xor(ss, 8);
                const float inv = rsqrtf(ss + EPS);
#pragma unroll
                for (int i = 0; i < 8; ++i) y[i] *= inv;
            }
            bf16_t* dst = c0 < 1024 ? qn + (size_t)row * 1024 + c0 : (c0 < 2048 ? kn + (size_t)row * 1024 + (c0 - 1024) : vv + (size_t)row * 1024 + (c0 - 2048));
            *(u32x4*)dst = pack8(y);
            if (SMP) { if (t >= 1) { float* o = p.out + O_CS + ((size_t)sb * 3 + (t - 1)) * 3072 + c0; *(f32x4*)o = (f32x4){xt[0], xt[1], xt[2], xt[3]}; *(f32x4*)(o + 4) = (f32x4){xt[4], xt[5], xt[6], xt[7]}; } }
            else if (t0 + t >= 2045) { float* o = p.out + O_CP + ((size_t)b * 3 + (t0 + t - 2045)) * 3072 + c0; *(f32x4*)o = (f32x4){xt[0], xt[1], xt[2], xt[3]}; *(f32x4*)(o + 4) = (f32x4){xt[4], xt[5], xt[6], xt[7]}; }
#pragma unroll
            for (int i = 0; i < 8; ++i) { xm3[i] = xm2[i]; xm2[i] = xm1[i]; xm1[i] = xt[i]; }
        }
        }
    } else {
        const int pc = (tid - 384) * 8, gi = pc >> 8, w = 2 << gi;
        const int seqrow0 = SMP ? TP + sb * 4 : b * 2048;
        const float* sp = p.in[6] + (size_t)sb * 15 * 1024 + pc;
        auto xpool = [&](int tt, float* f) {
            if (tt >= 0) unpack8(*(const u32x4*)(proj + (size_t)(seqrow0 + tt) * NPROJ + C_XP + pc), f);
            else if (SMP) { const float* s = sp + (size_t)(15 + tt) * 1024;
#pragma unroll
                for (int i = 0; i < 8; ++i) f[i] = s[i]; }
            else {
#pragma unroll
                for (int i = 0; i < 8; ++i) f[i] = 0.f; }
        };
        float s[8];
#pragma unroll
        for (int i = 0; i < 8; ++i) s[i] = 0.f;
#pragma unroll
        for (int q = 1; q < 16; ++q) if (q < w) { float f[8]; xpool(t0 - q, f);
#pragma unroll
            for (int i = 0; i < 8; ++i) s[i] += f[i]; }
#pragma unroll 4
        for (int t = 0; t < NTOK; ++t) {
            const int tt = t0 + t; float x[8], y[8], f[8];
            xpool(tt, x);
            const float cnt = SMP ? (float)w : (float)min(w, tt + 1); const float ic = 1.0f / cnt;
#pragma unroll
            for (int i = 0; i < 8; ++i) { s[i] += x[i]; y[i] = s[i] * ic - x[i]; }
            *(u32x4*)(yp + (size_t)(seqrow0 + tt) * 1024 + pc) = pack8(y);
            xpool(tt - w + 1, f);
#pragma unroll
            for (int i = 0; i < 8; ++i) s[i] -= f[i];
            if (SMP) { float* o = p.out + O_PS + ((size_t)sb * 15 + 11 + t) * 1024 + pc; *(f32x4*)o = (f32x4){x[0], x[1], x[2], x[3]}; *(f32x4*)(o + 4) = (f32x4){x[4], x[5], x[6], x[7]}; }
            else if (tt >= 2033) { float* o = p.out + O_PP + ((size_t)b * 15 + (tt - 2033)) * 1024 + pc; *(f32x4*)o = (f32x4){x[0], x[1], x[2], x[3]}; *(f32x4*)(o + 4) = (f32x4){x[4], x[5], x[6], x[7]}; }
        }
        if (SMP) {
#pragma unroll
            for (int r = 0; r < 11; ++r) { const float* s2 = sp + (size_t)(4 + r) * 1024; float* o = p.out + O_PS + ((size_t)sb * 15 + r) * 1024 + pc; *(f32x4*)o = *(const f32x4*)s2; *(f32x4*)(o + 4) = *(const f32x4*)(s2 + 4); } }
    }
    if (tid < 256) { const int tk = tid >> 4, jj = tid & 15;
        if (tk < NTOK) { const int row = rowbase + tk; const float val = bf2f(proj[(size_t)row * NPROJ + C_AB + jj]);
            if (jj < 8) { const float xx = val + p.in[13][jj]; const float spl = xx > 20.f ? xx : log1pf(__expf(xx)); gbuf[row * 8 + jj] = -__expf(p.in[12][jj]) * spl; }
            else bbuf[row * 8 + (jj - 8)] = sigmoidf_(val); } }
}
__device__ __forceinline__ void mixer_prep_phase(const Params& p, int bid, int nblk) {
    for (int it = bid; it < 640; it += nblk) { if (it >= 512) mixer_item<4, true>(p, it); else mixer_item<16, false>(p, it); }
}

constexpr int P5_QS = 0, P5_KS = 17408, P5_VS = 34816, P5_MM = 52224, P5_DEC = 68608, P5_BETA = 68864, P5_GRP = 69632;
static_assert(2 * P5_GRP <= LDS_BYTES - 16, "lds");
__device__ __forceinline__ void chunk_prep_phase(const Params& p, int bid, int nblk, LAS unsigned char* lds0) {
    const int tid = threadIdx.x, lane = tid & 63, grp = tid >> 8, lt = tid & 255, lw = __builtin_amdgcn_readfirstlane(tid >> 6) & 3;
    LAS unsigned char* lds = lds0 + grp * P5_GRP;
    const bf16_t* qn = (const bf16_t*)(p.ws + WS_QN); const bf16_t* kn = (const bf16_t*)(p.ws + WS_KN); const bf16_t* vv = (const bf16_t*)(p.ws + WS_VV);
    const float* gbuf = (const float*)(p.ws + WS_G); const float* bbuf = (const float*)(p.ws + WS_BETA);
    bf16_t* wdc = (bf16_t*)(p.ws + WS_WDC); bf16_t* qd = (bf16_t*)(p.ws + WS_QD); bf16_t* kt = (bf16_t*)(p.ws + WS_KT); bf16_t* qk = (bf16_t*)(p.ws + WS_QK);
    float* cdv = (float*)(p.ws + WS_CD); float* ub = p.out + OS_UB;
    LAS float* Mm = (LAS float*)(lds + P5_MM); LAS float* dec = (LAS float*)(lds + P5_DEC); LAS float* bet = (LAS float*)(lds + P5_BETA);
    const float scale = 0.08838834764831845f;
    for (int it0 = bid * 2; it0 < 1024; it0 += nblk * 2) {
        const int item = it0 + grp, n = item & 31, bh = item >> 5, h = bh & 7, b = bh >> 3;
        const int r0 = b * 2048 + n * 64;
        __syncthreads();
#pragma unroll
        for (int i = 0; i < 4; ++i) { const int ch = lt + 256 * i, r = ch >> 4, c8 = (ch & 15) * 8; const size_t go = (size_t)(r0 + r) * 1024 + h * 128 + c8; const int lo = r * 272 + c8 * 2;
            *(LAS u32x4*)(lds + P5_QS + lo) = *(const u32x4*)(qn + go); *(LAS u32x4*)(lds + P5_KS + lo) = *(const u32x4*)(kn + go); *(LAS u32x4*)(lds + P5_VS + lo) = *(const u32x4*)(vv + go); }
        if (lt < 64) {
            float g = gbuf[(r0 + lt) * 8 + h];
#pragma unroll
            for (int o = 1; o < 64; o <<= 1) { const float t = __shfl_up(g, o); if (lane >= o) g += t; }
            dec[lt] = g;
        } else if (lt < 128) bet[lt - 64] = bbuf[(r0 + lt - 64) * 8 + h];
        __syncthreads();
        {
            const int rt = lw, fr = lane & 15, fq = lane >> 4;
#pragma unroll
            for (int mat = 0; mat < 2; ++mat) {
                bf16x8 a[4];
#pragma unroll
                for (int kk = 0; kk < 4; ++kk) a[kk] = *(const LAS bf16x8*)(lds + (mat ? P5_QS : P5_KS) + (rt * 16 + fr) * 272 + (kk * 32 + fq * 8) * 2);
#pragma unroll
                for (int st = 0; st < 4; ++st) {
                    f32x4 d = (f32x4){0.f, 0.f, 0.f, 0.f};
#pragma unroll
                    for (int kk = 0; kk < 4; ++kk) { const bf16x8 bb = *(const LAS bf16x8*)(lds + P5_KS + (st * 16 + fr) * 272 + (kk * 32 + fq * 8) * 2); d = __builtin_amdgcn_mfma_f32_16x16x32_bf16(a[kk], bb, d, 0, 0, 0); }
                    const int s = st * 16 + fr; const float ds = dec[s];
#pragma unroll
                    for (int j = 0; j < 4; ++j) { const int r = rt * 16 + fq * 4 + j; const float dr = dec[r];
                        if (mat == 0) Mm[r * 64 + s] = (r > s) ? bet[r] * d[j] * __expf(dr - ds) : 0.f;
                        else qk[(size_t)item * 4096 + r * 64 + s] = f2bf((r >= s) ? scale * d[j] * __expf(dr - ds) : 0.f); }
                }
            }
        }
        __syncthreads();
        const int w8 = __builtin_amdgcn_readfirstlane(tid >> 6);
        if (w8 < 4) {
            const int g2 = w8 >> 1, c = (w8 & 1) * 64 + lane; const int item2 = it0 + g2;
            LAS unsigned char* lg = lds0 + g2 * P5_GRP; LAS float* Mg = (LAS float*)(lg + P5_MM); LAS float* decg = (LAS float*)(lg + P5_DEC); LAS float* betg = (LAS float*)(lg + P5_BETA);
            f32x2 xy[64]; f32x4 mq[6]; f32x2 ab0, ab1;
            float* up = ub + (size_t)item2 * 8192 + c; bf16_t* wp = wdc + (size_t)item2 * 8192 + c;
            { const float br = betg[0]; ab0 = (f32x2){bf2f(*(const LAS bf16_t*)(lg + P5_VS + 0 + c * 2)) * br, bf2f(*(const LAS bf16_t*)(lg + P5_KS + 0 + c * 2)) * br * __expf(decg[0])}; ab1 = (f32x2){0.f, 0.f}; } xy[0] = ab0; up[0] = xy[0][0]; wp[0] = f2bf(-xy[0][1]);
            mq[0] = *(const LAS f32x4*)(Mg + 64); mq[1] = *(const LAS f32x4*)(Mg + 128); mq[2] = *(const LAS f32x4*)(Mg + 192); mq[3] = *(const LAS f32x4*)(Mg + 256); mq[4] = *(const LAS f32x4*)(Mg + 320); mq[5] = *(const LAS f32x4*)(Mg + 324);
            { const float br = betg[1]; ab0 = (f32x2){bf2f(*(const LAS bf16_t*)(lg + P5_VS + 272 + c * 2)) * br, bf2f(*(const LAS bf16_t*)(lg + P5_KS + 272 + c * 2)) * br * __expf(decg[1])}; ab1 = (f32x2){0.f, 0.f}; } ab0 -= mq[0][0] * xy[0]; xy[1] = ab0 + ab1; up[128] = xy[1][0]; wp[128] = f2bf(-xy[1][1]); mq[0] = *(const LAS f32x4*)(Mg + 384);
            { const float br = betg[2]; ab0 = (f32x2){bf2f(*(const LAS bf16_t*)(lg + P5_VS + 544 + c * 2)) * br, bf2f(*(const LAS bf16_t*)(lg + P5_KS + 544 + c * 2)) * br * __expf(decg[2])}; ab1 = (f32x2){0.f, 0.f}; } ab0 -= mq[1][0] * xy[0]; ab1 -= mq[1][1] * xy[1]; xy[2] = ab0 + ab1; up[256] = xy[2][0]; wp[256] = f2bf(-xy[2][1]); mq[1] = *(const LAS f32x4*)(Mg + 388);
            { const float br = betg[3]; ab0 = (f32x2){bf2f(*(const LAS bf16_t*)(lg + P5_VS + 816 + c * 2)) * br, bf2f(*(const LAS bf16_t*)(lg + P5_KS + 816 + c * 2)) * br * __expf(decg[3])}; ab1 = (f32x2){0.f, 0.f}; } ab0 -= mq[2][0] * xy[0]; ab1 -= mq[2][1] * xy[1]; ab0 -= mq[2][2] * xy[2]; xy[3] = ab0 + ab1; up[384] = xy[3][0]; wp[384] = f2bf(-xy[3][1]); mq[2] = *(const LAS f32x4*)(Mg + 448);
            { const float br = betg[4]; ab0 = (f32x2){bf2f(*(const LAS bf16_t*)(lg + P5_VS + 1088 + c * 2)) * br, bf2f(*(const LAS bf16_t*)(lg + P5_KS + 1088 + c * 2)) * br * __expf(decg[4])}; ab1 = (f32x2){0.f, 0.f}; } ab0 -= mq[3][0] * xy[0]; ab1 -= mq[3][1] * xy[1]; ab0 -= mq[3][2] * xy[2]; ab1 -= mq[3][3] * xy[3]; xy[4] = ab0 + ab1; up[512] = xy[4][0]; wp[512] = f2bf(-xy[4][1]); mq[3] = *(const LAS f32x4*)(Mg + 452);
            { const float br = betg[5]; ab0 = (f32x2){bf2f(*(const LAS bf16_t*)(lg + P5_VS + 1360 + c * 2)) * br, bf2f(*(const LAS bf16_t*)(lg + P5_KS + 1360 + c * 2)) * br * __expf(decg[5])}; ab1 = (f32x2){0.f, 0.f}; } ab0 -= mq[4][0] * xy[0]; ab1 -= mq[4][1] * xy[1]; ab0 -= mq[4][2] * xy[2]; ab1 -= mq[4][3] * xy[3]; mq[4] = *(const LAS f32x4*)(Mg + 512);
            ab0 -= mq[5][0] * xy[4]; xy[5] = ab0 + ab1; up[640] = xy[5][0]; wp[640] = f2bf(-xy[5][1]); mq[5] = *(const LAS f32x4*)(Mg + 516);
            { const float br = betg[6]; ab0 = (f32x2){bf2f(*(const LAS bf16_t*)(lg + P5_VS + 1632 + c * 2)) * br, bf2f(*(const LAS bf16_t*)(lg + P5_KS + 1632 + c * 2)) * br * __expf(decg[6])}; ab1 = (f32x2){0.f, 0.f}; } ab0 -= mq[0][0] * xy[0]; ab1 -= mq[0][1] * xy[1]; ab0 -= mq[0][2] * xy[2]; ab1 -= mq[0][3] * xy[3]; mq[0] = *(const LAS f32x4*)(Mg + 576);
            ab0 -= mq[1][0] * xy[4]; ab1 -= mq[1][1] * xy[5]; xy[6] = ab0 + ab1; up[768] = xy[6][0]; wp[768] = f2bf(-xy[6][1]); mq[1] = *(const LAS f32x4*)(Mg + 580);
            { const float br = betg[7]; ab0 = (f32x2){bf2f(*(const LAS bf16_t*)(lg + P5_VS + 1904 + c * 2)) * br, bf2f(*(const LAS bf16_t*)(lg + P5_KS + 1904 + c * 2)) * br * __expf(decg[7])}; ab1 = (f32x2){0.f, 0.f}; } ab0 -= mq[2][0] * xy[0]; ab1 -= mq[2][1] * xy[1]; ab0 -= mq[2][2] * xy[2]; ab1 -= mq[2][3] * xy[3]; mq[2] = *(const LAS f32x4*)(Mg + 584);
            ab0 -= mq[3][0] * xy[4]; ab1 -= mq[3][1] * xy[5]; ab0 -= mq[3][2] * xy[6]; xy[7] = ab0 + ab1; up[896] = xy[7][0]; wp[896] = f2bf(-xy[7][1]); mq[3] = *(const LAS f32x4*)(Mg + 640);
            { const float br = betg[8]; ab0 = (f32x2){bf2f(*(const LAS bf16_t*)(lg + P5_VS + 2176 + c * 2)) * br, bf2f(*(const LAS bf16_t*)(lg + P5_KS + 2176 + c * 2)) * br * __expf(decg[8])}; ab1 = (f32x2){0.f, 0.f}; } ab0 -= mq[4][0] * xy[0]; ab1 -= mq[4][1] * xy[1]; ab0 -= mq[4][2] * xy[2]; ab1 -= mq[4][3] * xy[3]; mq[4] = *(const LAS f32x4*)(Mg + 644);
            ab0 -= mq[5][0] * xy[4]; ab1 -= mq[5][1] * xy[5]; ab0 -= mq[5][2] * xy[6]; ab1 -= mq[5][3] * xy[7]; xy[8] = ab0 + ab1; up[1024] = xy[8][0]; wp[1024] = f2bf(-xy[8][1]); mq[5] = *(const LAS f32x4*)(Mg + 648);
            { const float br = betg[9]; ab0 = (f32x2){bf2f(*(const LAS bf16_t*)(lg + P5_VS + 2448 + c * 2)) * br, bf2f(*(const LAS bf16_t*)(lg + P5_KS + 2448 + c * 2)) * br * __expf(decg[9])}; ab1 = (f32x2){0.f, 0.f}; } ab0 -= mq[0][0] * xy[0]; ab1 -= mq[0][1] * xy[1]; ab0 -= mq[0][2] * xy[2]; ab1 -= mq[0][3] * xy[3]; mq[0] = *(const LAS f32x4*)(Mg + 704);
            ab0 -= mq[1][0] * xy[4]; ab1 -= mq[1][1] * xy[5]; ab0 -= mq[1][2] * xy[6]; ab1 -= mq[1][3] * xy[7]; mq[1] = *(const LAS f32x4*)(Mg + 708);
            ab0 -= mq[2][0] * xy[8]; xy[9] = ab0 + ab1; up[1152] = xy[9][0]; wp[1152] = f2bf(-xy[9][1]); mq[2] = *(const LAS f32x4*)(Mg + 712);
            { const float br = betg[10]; ab0 = (f32x2){bf2f(*(const LAS bf16_t*)(lg + P5_VS + 2720 + c * 2)) * br, bf2f(*(const LAS bf16_t*)(lg + P5_KS + 2720 + c * 2)) * br * __expf(decg[10])}; ab1 = (f32x2){0.f, 0.f}; } ab0 -= mq[3][0] * xy[0]; ab1 -= mq[3][1] * xy[1]; ab0 -= mq[3][2] * xy[2]; ab1 -= mq[3][3] * xy[3]; mq[3] = *(const LAS f32x4*)(Mg + 768);
            ab0 -= mq[4][0] * xy[4]; ab1 -= mq[4][1] * xy[5]; ab0 -= mq[4][2] * xy[6]; ab1 -= mq[4][3] * xy[7]; mq[4] = *(const LAS f32x4*)(Mg + 772);
            ab0 -= mq[5][0] * xy[8]; ab1 -= mq[5][1] * xy[9]; xy[10] = ab0 + ab1; up[1280] = xy[10][0]; wp[1280] = f2bf(-xy[10][1]); mq[5] = *(const LAS f32x4*)(Mg + 776);
            { const float br = betg[11]; ab0 = (f32x2){bf2f(*(const LAS bf16_t*)(lg + P5_VS + 2992 + c * 2)) * br, bf2f(*(const LAS bf16_t*)(lg + P5_KS + 2992 + c * 2)) * br * __expf(decg[11])}; ab1 = (f32x2){0.f, 0.f}; } ab0 -= mq[0][0] * xy[0]; ab1 -= mq[0][1] * xy[1]; ab0 -= mq[0][2] * xy[2]; ab1 -= mq[0][3] * xy[3]; mq[0] = *(const LAS f32x4*)(Mg + 832);
            ab0 -= mq[1][0] * xy[4]; ab1 -= mq[1][1] * xy[5]; ab0 -= mq[1][2] * xy[6]; ab1 -= mq[1][3] * xy[7]; mq[1] = *(const LAS f32x4*)(Mg + 836);
            ab0 -= mq[2][0] * xy[8]; ab1 -= mq[2][1] * xy[9]; ab0 -= mq[2][2] * xy[10]; xy[11] = ab0 + ab1; up[1408] = xy[11][0]; wp[1408] = f2bf(-xy[11][1]); mq[2] = *(const LAS f32x4*)(Mg + 840);
            { const float br = betg[12]; ab0 = (f32x2){bf2f(*(const LAS bf16_t*)(lg + P5_VS + 3264 + c * 2)) * br, bf2f(*(const LAS bf16_t*)(lg + P5_KS + 3264 + c * 2)) * br * __expf(decg[12])}; ab1 = (f32x2){0.f, 0.f}; } ab0 -= mq[3][0] * xy[0]; ab1 -= mq[3][1] * xy[1]; ab0 -= mq[3][2] * xy[2]; ab1 -= mq[3][3] * xy[3]; mq[3] = *(const LAS f32x4*)(Mg + 844);
            ab0 -= mq[4][0] * xy[4]; ab1 -= mq[4][1] * xy[5]; ab0 -= mq[4][2] * xy[6]; ab1 -= mq[4][3] * xy[7]; mq[4] = *(const LAS f32x4*)(Mg + 896);
            ab0 -= mq[5][0] * xy[8]; ab1 -= mq[5][1] * xy[9]; ab0 -= mq[5][2] * xy[10]; ab1 -= mq[5][3] * xy[11]; xy[12] = ab0 + ab1; up[1536] = xy[12][0]; wp[1536] = f2bf(-xy[12][1]); mq[5] = *(const LAS f32x4*)(Mg + 900);
            { const float br = betg[13]; ab0 = (f32x2){bf2f(*(const LAS bf16_t*)(lg + P5_VS + 3536 + c * 2)) * br, bf2f(*(const LAS bf16_t*)(lg + P5_KS + 3536 + c * 2)) * br * __expf(decg[13])}; ab1 = (f32x2){0.f, 0.f}; } ab0 -= mq[0][0] * xy[0]; ab1 -= mq[0][1] * xy[1]; ab0 -= mq[0][2] * xy[2]; ab1 -= mq[0][3] * xy[3]; mq[0] = *(const LAS f32x4*)(Mg + 904);
            ab0 -= mq[1][0] * xy[4]; ab1 -= mq[1][1] * xy[5]; ab0 -= mq[1][2] * xy[6]; ab1 -= mq[1][3] * xy[7]; mq[1] = *(const LAS f32x4*)(Mg + 908);
            ab0 -= mq[2][0] * xy[8]; ab1 -= mq[2][1] * xy[9]; ab0 -= mq[2][2] * xy[10]; ab1 -= mq[2][3] * xy[11]; mq[2] = *(const LAS f32x4*)(Mg + 960);
            ab0 -= mq[3][0] * xy[12]; xy[13] = ab0 + ab1; up[1664] = xy[13][0]; wp[1664] = f2bf(-xy[13][1]); mq[3] = *(const LAS f32x4*)(Mg + 964);
            { const float br = betg[14]; ab0 = (f32x2){bf2f(*(const LAS bf16_t*)(lg + P5_VS + 3808 + c * 2)) * br, bf2f(*(const LAS bf16_t*)(lg + P5_KS + 3808 + c * 2)) * br * __expf(decg[14])}; ab1 = (f32x2){0.f, 0.f}; } ab0 -= mq[4][0] * xy[0]; ab1 -= mq[4][1] * xy[1]; ab0 -= mq[4][2] * xy[2]; ab1 -= mq[4][3] * xy[3]; mq[4] = *(const LAS f32x4*)(Mg + 968);
            ab0 -= mq[5][0] * xy[4]; ab1 -= mq[5][1] * xy[5]; ab0 -= mq[5][2] * xy[6]; ab1 -= mq[5][3] * xy[7]; mq[5] = *(const LAS f32x4*)(Mg + 972);
            ab0 -= mq[0][0] * xy[8]; ab1 -= mq[0][1] * xy[9]; ab0 -= mq[0][2] * xy[10]; ab1 -= mq[0][3] * xy[11]; mq[0] = *(const LAS f32x4*)(Mg + 1024);
            ab0 -= mq[1][0] * xy[12]; ab1 -= mq[1][1] * xy[13]; xy[14] = ab0 + ab1; up[1792] = xy[14][0]; wp[1792] = f2bf(-xy[14][1]); mq[1] = *(const LAS f32x4*)(Mg + 1028);
            { const float br = betg[15]; ab0 = (f32x2){bf2f(*(const LAS bf16_t*)(lg + P5_VS + 4080 + c * 2)) * br, bf2f(*(const LAS bf16_t*)(lg + P5_KS + 4080 + c * 2)) * br * __expf(decg[15])}; ab1 = (f32x2){0.f, 0.f}; } ab0 -= mq[2][0] * xy[0]; ab1 -= mq[2][1] * xy[1]; ab0 -= mq[2][2] * xy[2]; ab1 -= mq[2][3] * xy[3]; mq[2] = *(const LAS f32x4*)(Mg + 1032);
            ab0 -= mq[3][0] * xy[4]; ab1 -= mq[3][1] * xy[5]; ab0 -= mq[3][2] * xy[6]; ab1 -= mq[3][3] * xy[7]; mq[3] = *(const LAS f32x4*)(Mg + 1036);
            ab0 -= mq[4][0] * xy[8]; ab1 -= mq[4][1] * xy[9]; ab0 -= mq[4][2] * xy[10]; ab1 -= mq[4][3] * xy[11]; mq[4] = *(const LAS f32x4*)(Mg + 1088);
            ab0 -= mq[5][0] * xy[12]; ab1 -= mq[5][1] * xy[13]; ab0 -= mq[5][2] * xy[14]; xy[15] = ab0 + ab1; up[1920] = xy[15][0]; wp[1920] = f2bf(-xy[15][1]); mq[5] = *(const LAS f32x4*)(Mg + 1092);
            { const float br = betg[16]; ab0 = (f32x2){bf2f(*(const LAS bf16_t*)(lg + P5_VS + 4352 + c * 2)) * br, bf2f(*(const LAS bf16_t*)(lg + P5_KS + 4352 + c * 2)) * br * __expf(decg[16])}; ab1 = (f32x2){0.f, 0.f}; } ab0 -= mq[0][0] * xy[0]; ab1 -= mq[0][1] * xy[1]; ab0 -= mq[0][2] * xy[2]; ab1 -= mq[0][3] * xy[3]; mq[0] = *(const LAS f32x4*)(Mg + 1096);
            ab0 -= mq[1][0] * xy[4]; ab1 -= mq[1][1] * xy[5]; ab0 -= mq[1][2] * xy[6]; ab1 -= mq[1][3] * xy[7]; mq[1] = *(const LAS f32x4*)(Mg + 1100);
            ab0 -= mq[2][0] * xy[8]; ab1 -= mq[2][1] * xy[9]; ab0 -= mq[2][2] * xy[10]; ab1 -= mq[2][3] * xy[11]; mq[2] = *(const LAS f32x4*)(Mg + 1104);
            ab0 -= mq[3][0] * xy[12]; ab1 -= mq[3][1] * xy[13]; ab0 -= mq[3][2] * xy[14]; ab1 -= mq[3][3] * xy[15]; xy[16] = ab0 + ab1; up[2048] = xy[16][0]; wp[2048] = f2bf(-xy[16][1]); mq[3] = *(const LAS f32x4*)(Mg + 1152);
            { const float br = betg[17]; ab0 = (f32x2){bf2f(*(const LAS bf16_t*)(lg + P5_VS + 4624 + c * 2)) * br, bf2f(*(const LAS bf16_t*)(lg + P5_KS + 4624 + c * 2)) * br * __expf(decg[17])}; ab1 = (f32x2){0.f, 0.f}; } ab0 -= mq[4][0] * xy[0]; ab1 -= mq[4][1] * xy[1]; ab0 -= mq[4][2] * xy[2]; ab1 -= mq[4][3] * xy[3]; mq[4] = *(const LAS f32x4*)(Mg + 1156);
            ab0 -= mq[5][0] * xy[4]; ab1 -= mq[5][1] * xy[5]; ab0 -= mq[5][2] * xy[6]; ab1 -= mq[5][3] * xy[7]; mq[5] = *(const LAS f32x4*)(Mg + 1160);
            ab0 -= mq[0][0] * xy[8]; ab1 -= mq[0][1] * xy[9]; ab0 -= mq[0][2] * xy[10]; ab1 -= mq[0][3] * xy[11]; mq[0] = *(const LAS f32x4*)(Mg + 1164);
            ab0 -= mq[1][0] * xy[12]; ab1 -= mq[1][1] * xy[13]; ab0 -= mq[1][2] * xy[14]; ab1 -= mq[1][3] * xy[15]; mq[1] = *(const LAS f32x4*)(Mg + 1168);
            ab0 -= mq[2][0] * xy[16]; xy[17] = ab0 + ab1; up[2176] = xy[17][0]; wp[2176] = f2bf(-xy[17][1]); mq[2] = *(const LAS f32x4*)(Mg + 1216);
            { const float br = betg[18]; ab0 = (f32x2){bf2f(*(const LAS bf16_t*)(lg + P5_VS + 4896 + c * 2)) * br, bf2f(*(const LAS bf16_t*)(lg + P5_KS + 4896 + c * 2)) * br * __expf(decg[18])}; ab1 = (f32x2){0.f, 0.f}; } ab0 -= mq[3][0] * xy[0]; ab1 -= mq[3][1] * xy[1]; ab0 -= mq[3][2] * xy[2]; ab1 -= mq[3][3] * xy[3]; mq[3] = *(const LAS f32x4*)(Mg + 1220);
            ab0 -= mq[4][0] * xy[4]; ab1 -= mq[4][1] * xy[5]; ab0 -= mq[4][2] * xy[6]; ab1 -= mq[4][3] * xy[7]; mq[4] = *(const LAS f32x4*)(Mg + 1224);
            ab0 -= mq[5][0] * xy[8]; ab1 -= mq[5][1] * xy[9]; ab0 -= mq[5][2] * xy[10]; ab1 -= mq[5][3] * xy[11]; mq[5] = *(const LAS f32x4*)(Mg + 1228);
            ab0 -= mq[0][0] * xy[12]; ab1 -= mq[0][1] * xy[13]; ab0 -= mq[0][2] * xy[14]; ab1 -= mq[0][3] * xy[15]; mq[0] = *(const LAS f32x4*)(Mg + 1232);
            ab0 -= mq[1][0] * xy[16]; ab1 -= mq[1][1] * xy[17]; xy[18] = ab0 + ab1; up[2304] = xy[18][0]; wp[2304] = f2bf(-xy[18][1]); mq[1] = *(const LAS f32x4*)(Mg + 1280);
            { const float br = betg[19]; ab0 = (f32x2){bf2f(*(const LAS bf16_t*)(lg + P5_VS + 5168 + c * 2)) * br, bf2f(*(const LAS bf16_t*)(lg + P5_KS + 5168 + c * 2)) * br * __expf(decg[19])}; ab1 = (f32x2){0.f, 0.f}; } ab0 -= mq[2][0] * xy[0]; ab1 -= mq[2][1] * xy[1]; ab0 -= mq[2][2] * xy[2]; ab1 -= mq[2][3] * xy[3]; mq[2] = *(const LAS f32x4*)(Mg + 1284);
            ab0 -= mq[3][0] * xy[4]; ab1 -= mq[3][1] * xy[5]; ab0 -= mq[3][2] * xy[6]; ab1 -= mq[3][3] * xy[7]; mq[3] = *(const LAS f32x4*)(Mg + 1288);
            ab0 -= mq[4][0] * xy[8]; ab1 -= mq[4][1] * xy[9]; ab0 -= mq[4][2] * xy[10]; ab1 -= mq[4][3] * xy[11]; mq[4] = *(const LAS f32x4*)(Mg + 1292);
            ab0 -= mq[5][0] * xy[12]; ab1 -= mq[5][1] * xy[13]; ab0 -= mq[5][2] * xy[14]; ab1 -= mq[5][3] * xy[15]; mq[5] = *(const LAS f32x4*)(Mg + 1296);
            ab0 -= mq[0][0] * xy[16]; ab1 -= mq[0][1] * xy[17]; ab0 -= mq[0][2] * xy[18]; xy[19] = ab0 + ab1; up[2432] = xy[19][0]; wp[2432] = f2bf(-xy[19][1]); mq[0] = *(const LAS f32x4*)(Mg + 1344);
            { const float br = betg[20]; ab0 = (f32x2){bf2f(*(const LAS bf16_t*)(lg + P5_VS + 5440 + c * 2)) * br, bf2f(*(const LAS bf16_t*)(lg + P5_KS + 5440 + c * 2)) * br * __expf(decg[20])}; ab1 = (f32x2){0.f, 0.f}; } ab0 -= mq[1][0] * xy[0]; ab1 -= mq[1][1] * xy[1]; ab0 -= mq[1][2] * xy[2]; ab1 -= mq[1][3] * xy[3]; mq[1] = *(const LAS f32x4*)(Mg + 1348);
            ab0 -= mq[2][0] * xy[4]; ab1 -= mq[2][1] * xy[5]; ab0 -= mq[2][2] * xy[6]; ab1 -= mq[2][3] * xy[7]; mq[2] = *(const LAS f32x4*)(Mg + 1352);
            ab0 -= mq[3][0] * xy[8]; ab1 -= mq[3][1] * xy[9]; ab0 -= mq[3][2] * xy[10]; ab1 -= mq[3][3] * xy[11]; mq[3] = *(const LAS f32x4*)(Mg + 1356);
            ab0 -= mq[4][0] * xy[12]; ab1 -= mq[4][1] * xy[13]; ab0 -= mq[4][2] * xy[14]; ab1 -= mq[4][3] * xy[15]; mq[4] = *(const LAS f32x4*)(Mg + 1360);
            ab0 -= mq[5][0] * xy[16]; ab1 -= mq[5][1] * xy[17]; ab0 -= mq[5][2] * xy[18]; ab1 -= mq[5][3] * xy[19]; xy[20] = ab0 + ab1; up[2560] = xy[20][0]; wp[2560] = f2bf(-xy[20][1]); mq[5] = *(const LAS f32x4*)(Mg + 1364);
            { const float br = betg[21]; ab0 = (f32x2){bf2f(*(const LAS bf16_t*)(lg + P5_VS + 5712 + c * 2)) * br, bf2f(*(const LAS bf16_t*)(lg + P5_KS + 5712 + c * 2)) * br * __expf(decg[21])}; ab1 = (f32x2){0.f, 0.f}; } ab0 -= mq[0][0] * xy[0]; ab1 -= mq[0][1] * xy[1]; ab0 -= mq[0][2] * xy[2]; ab1 -= mq[0][3] * xy[3]; mq[0] = *(const LAS f32x4*)(Mg + 1408);
            ab0 -= mq[1][0] * xy[4]; ab1 -= mq[1][1] * xy[5]; ab0 -= mq[1][2] * xy[6]; ab1 -= mq[1][3] * xy[7]; mq[1] = *(const LAS f32x4*)(Mg + 1412);
            ab0 -= mq[2][0] * xy[8]; ab1 -= mq[2][1] * xy[9]; ab0 -= mq[2][2] * xy[10]; ab1 -= mq[2][3] * xy[11]; mq[2] = *(const LAS f32x4*)(Mg + 1416);
            ab0 -= mq[3][0] * xy[12]; ab1 -= mq[3][1] * xy[13]; ab0 -= mq[3][2] * xy[14]; ab1 -= mq[3][3] * xy[15]; mq[3] = *(const LAS f32x4*)(Mg + 1420);
            ab0 -= mq[4][0] * xy[16]; ab1 -= mq[4][1] * xy[17]; ab0 -= mq[4][2] * xy[18]; ab1 -= mq[4][3] * xy[19]; mq[4] = *(const LAS f32x4*)(Mg + 1424);
            ab0 -= mq[5][0] * xy[20]; xy[21] = ab0 + ab1; up[2688] = xy[21][0]; wp[2688] = f2bf(-xy[21][1]); mq[5] = *(const LAS f32x4*)(Mg + 1428);
            { const float br = betg[22]; ab0 = (f32x2){bf2f(*(const LAS bf16_t*)(lg + P5_VS + 5984 + c * 2)) * br, bf2f(*(const LAS bf16_t*)(lg + P5_KS + 5984 + c * 2)) * br * __expf(decg[22])}; ab1 = (f32x2){0.f, 0.f}; } ab0 -= mq[0][0] * xy[0]; ab1 -= mq[0][1] * xy[1]; ab0 -= mq[0][2] * xy[2]; ab1 -= mq[0][3] * xy[3]; mq[0] = *(const LAS f32x4*)(Mg + 1472);
            ab0 -= mq[1][0] * xy[4]; ab1 -= mq[1][1] * xy[5]; ab0 -= mq[1][2] * xy[6]; ab1 -= mq[1][3] * xy[7]; mq[1] = *(const LAS f32x4*)(Mg + 1476);
            ab0 -= mq[2][0] * xy[8]; ab1 -= mq[2][1] * xy[9]; ab0 -= mq[2][2] * xy[10]; ab1 -= mq[2][3] * xy[11]; mq[2] = *(const LAS f32x4*)(Mg + 1480);
            ab0 -= mq[3][0] * xy[12]; ab1 -= mq[3][1] * xy[13]; ab0 -= mq[3][2] * xy[14]; ab1 -= mq[3][3] * xy[15]; mq[3] = *(const LAS f32x4*)(Mg + 1484);
            ab0 -= mq[4][0] * xy[16]; ab1 -= mq[4][1] * xy[17]; ab0 -= mq[4][2] * xy[18]; ab1 -= mq[4][3] * xy[19]; mq[4] = *(const LAS f32x4*)(Mg + 1488);
            ab0 -= mq[5][0] * xy[20]; ab1 -= mq[5][1] * xy[21]; xy[22] = ab0 + ab1; up[2816] = xy[22][0]; wp[2816] = f2bf(-xy[22][1]); mq[5] = *(const LAS f32x4*)(Mg + 1492);
            { const float br = betg[23]; ab0 = (f32x2){bf2f(*(const LAS bf16_t*)(lg + P5_VS + 6256 + c * 2)) * br, bf2f(*(const LAS bf16_t*)(lg + P5_KS + 6256 + c * 2)) * br * __expf(decg[23])}; ab1 = (f32x2){0.f, 0.f}; } ab0 -= mq[0][0] * xy[0]; ab1 -= mq[0][1] * xy[1]; ab0 -= mq[0][2] * xy[2]; ab1 -= mq[0][3] * xy[3]; mq[0] = *(const LAS f32x4*)(Mg + 1536);
            ab0 -= mq[1][0] * xy[4]; ab1 -= mq[1][1] * xy[5]; ab0 -= mq[1][2] * xy[6]; ab1 -= mq[1][3] * xy[7]; mq[1] = *(const LAS f32x4*)(Mg + 1540);
            ab0 -= mq[2][0] * xy[8]; ab1 -= mq[2][1] * xy[9]; ab0 -= mq[2][2] * xy[10]; ab1 -= mq[2][3] * xy[11]; mq[2] = *(const LAS f32x4*)(Mg + 1544);
            ab0 -= mq[3][0] * xy[12]; ab1 -= mq[3][1] * xy[13]; ab0 -= mq[3][2] * xy[14]; ab1 -= mq[3][3] * xy[15]; mq[3] = *(const LAS f32x4*)(Mg + 1548);
            ab0 -= mq[4][0] * xy[16]; ab1 -= mq[4][1] * xy[17]; ab0 -= mq[4][2] * xy[18]; ab1 -= mq[4][3] * xy[19]; mq[4] = *(const LAS f32x4*)(Mg + 1552);
            ab0 -= mq[5][0] * xy[20]; ab1 -= mq[5][1] * xy[21]; ab0 -= mq[5][2] * xy[22]; xy[23] = ab0 + ab1; up[2944] = xy[23][0]; wp[2944] = f2bf(-xy[23][1]); mq[5] = *(const LAS f32x4*)(Mg + 1556);
            { const float br = betg[24]; ab0 = (f32x2){bf2f(*(const LAS bf16_t*)(lg + P5_VS + 6528 + c * 2)) * br, bf2f(*(const LAS bf16_t*)(lg + P5_KS + 6528 + c * 2)) * br * __expf(decg[24])}; ab1 = (f32x2){0.f, 0.f}; } ab0 -= mq[0][0] * xy[0]; ab1 -= mq[0][1] * xy[1]; ab0 -= mq[0][2] * xy[2]; ab1 -= mq[0][3] * xy[3]; mq[0] = *(const LAS f32x4*)(Mg + 1600);
            ab0 -= mq[1][0] * xy[4]; ab1 -= mq[1][1] * xy[5]; ab0 -= mq[1][2] * xy[6]; ab1 -= mq[1][3] * xy[7]; mq[1] = *(const LAS f32x4*)(Mg + 1604);
            ab0 -= mq[2][0] * xy[8]; ab1 -= mq[2][1] * xy[9]; ab0 -= mq[2][2] * xy[10]; ab1 -= mq[2][3] * xy[11]; mq[2] = *(const LAS f32x4*)(Mg + 1608);
            ab0 -= mq[3][0] * xy[12]; ab1 -= mq[3][1] * xy[13]; ab0 -= mq[3][2] * xy[14]; ab1 -= mq[3][3] * xy[15]; mq[3] = *(const LAS f32x4*)(Mg + 1612);
            ab0 -= mq[4][0] * xy[16]; ab1 -= mq[4][1] * xy[17]; ab0 -= mq[4][2] * xy[18]; ab1 -= mq[4][3] * xy[19]; mq[4] = *(const LAS f32x4*)(Mg + 1616);
            ab0 -= mq[5][0] * xy[20]; ab1 -= mq[5][1] * xy[21]; ab0 -= mq[5][2] * xy[22]; ab1 -= mq[5][3] * xy[23]; xy[24] = ab0 + ab1; up[3072] = xy[24][0]; wp[3072] = f2bf(-xy[24][1]); mq[5] = *(const LAS f32x4*)(Mg + 1620);
            { const float br = betg[25]; ab0 = (f32x2){bf2f(*(const LAS bf16_t*)(lg + P5_VS + 6800 + c * 2)) * br, bf2f(*(const LAS bf16_t*)(lg + P5_KS + 6800 + c * 2)) * br * __expf(decg[25])}; ab1 = (f32x2){0.f, 0.f}; } ab0 -= mq[0][0] * xy[0]; ab1 -= mq[0][1] * xy[1]; ab0 -= mq[0][2] * xy[2]; ab1 -= mq[0][3] * xy[3]; mq[0] = *(const LAS f32x4*)(Mg + 1624);
            ab0 -= mq[1][0] * xy[4]; ab1 -= mq[1][1] * xy[5]; ab0 -= mq[1][2] * xy[6]; ab1 -= mq[1][3] * xy[7]; mq[1] = *(const LAS f32x4*)(Mg + 1664);
            ab0 -= mq[2][0] * xy[8]; ab1 -= mq[2][1] * xy[9]; ab0 -= mq[2][2] * xy[10]; ab1 -= mq[2][3] * xy[11]; mq[2] = *(const LAS f32x4*)(Mg + 1668);
            ab0 -= mq[3][0] * xy[12]; ab1 -= mq[3][1] * xy[13]; ab0 -= mq[3][2] * xy[14]; ab1 -= mq[3][3] * xy[15]; mq[3] = *(const LAS f32x4*)(Mg + 1672);
            ab0 -= mq[4][0] * xy[16]; ab1 -= mq[4][1] * xy[17]; ab0 -= mq[4][2] * xy[18]; ab1 -= mq[4][3] * xy[19]; mq[4] = *(const LAS f32x4*)(Mg + 1676);
            ab0 -= mq[5][0] * xy[20]; ab1 -= mq[5][1] * xy[21]; ab0 -= mq[5][2] * xy[22]; ab1 -= mq[5][3] * xy[23]; mq[5] = *(const LAS f32x4*)(Mg + 1680);
            ab0 -= mq[0][0] * xy[24]; xy[25] = ab0 + ab1; up[3200] = xy[25][0]; wp[3200] = f2bf(-xy[25][1]); mq[0] = *(const LAS f32x4*)(Mg + 1684);
            { const float br = betg[26]; ab0 = (f32x2){bf2f(*(const LAS bf16_t*)(lg + P5_VS + 7072 + c * 2)) * br, bf2f(*(const LAS bf16_t*)(lg + P5_KS + 7072 + c * 2)) * br * __expf(decg[26])}; ab1 = (f32x2){0.f, 0.f}; } ab0 -= mq[1][0] * xy[0]; ab1 -= mq[1][1] * xy[1]; ab0 -= mq[1][2] * xy[2]; ab1 -= mq[1][3] * xy[3]; mq[1] = *(const LAS f32x4*)(Mg + 1688);
            ab0 -= mq[2][0] * xy[4]; ab1 -= mq[2][1] * xy[5]; ab0 -= mq[2][2] * xy[6]; ab1 -= mq[2][3] * xy[7]; mq[2] = *(const LAS f32x4*)(Mg + 1728);
            ab0 -= mq[3][0] * xy[8]; ab1 -= mq[3][1] * xy[9]; ab0 -= mq[3][2] * xy[10]; ab1 -= mq[3][3] * xy[11]; mq[3] = *(const LAS f32x4*)(Mg + 1732);
            ab0 -= mq[4][0] * xy[12]; ab1 -= mq[4][1] * xy[13]; ab0 -= mq[4][2] * xy[14]; ab1 -= mq[4][3] * xy[15]; mq[4] = *(const LAS f32x4*)(Mg + 1736);
            ab0 -= mq[5][0] * xy[16]; ab1 -= mq[5][1] * xy[17]; ab0 -= mq[5][2] * xy[18]; ab1 -= mq[5][3] * xy[19]; mq[5] = *(const LAS f32x4*)(Mg + 1740);
            ab0 -= mq[0][0] * xy[20]; ab1 -= mq[0][1] * xy[21]; ab0 -= mq[0][2] * xy[22]; ab1 -= mq[0][3] * xy[23]; mq[0] = *(const LAS f32x4*)(Mg + 1744);
            ab0 -= mq[1][0] * xy[24]; ab1 -= mq[1][1] * xy[25]; xy[26] = ab0 + ab1; up[3328] = xy[26][0]; wp[3328] = f2bf(-xy[26][1]); mq[1] = *(const LAS f32x4*)(Mg + 1748);
            { const float br = betg[27]; ab0 = (f32x2){bf2f(*(const LAS bf16_t*)(lg + P5_VS + 7344 + c * 2)) * br, bf2f(*(const LAS bf16_t*)(lg + P5_KS + 7344 + c * 2)) * br * __expf(decg[27])}; ab1 = (f32x2){0.f, 0.f}; } ab0 -= mq[2][0] * xy[0]; ab1 -= mq[2][1] * xy[1]; ab0 -= mq[2][2] * xy[2]; ab1 -= mq[2][3] * xy[3]; mq[2] = *(const LAS f32x4*)(Mg + 1752);
            ab0 -= mq[3][0] * xy[4]; ab1 -= mq[3][1] * xy[5]; ab0 -= mq[3][2] * xy[6]; ab1 -= mq[3][3] * xy[7]; mq[3] = *(const LAS f32x4*)(Mg + 1792);
            ab0 -= mq[4][0] * xy[8]; ab1 -= mq[4][1] * xy[9]; ab0 -= mq[4][2] * xy[10]; ab1 -= mq[4][3] * xy[11]; mq[4] = *(const LAS f32x4*)(Mg + 1796);
            ab0 -= mq[5][0] * xy[12]; ab1 -= mq[5][1] * xy[13]; ab0 -= mq[5][2] * xy[14]; ab1 -= mq[5][3] * xy[15]; mq[5] = *(const LAS f32x4*)(Mg + 1800);
            ab0 -= mq[0][0] * xy[16]; ab1 -= mq[0][1] * xy[17]; ab0 -= mq[0][2] * xy[18]; ab1 -= mq[0][3] * xy[19]; mq[0] = *(const LAS f32x4*)(Mg + 1804);
            ab0 -= mq[1][0] * xy[20]; ab1 -= mq[1][1] * xy[21]; ab0 -= mq[1][2] * xy[22]; ab1 -= mq[1][3] * xy[23]; mq[1] = *(const LAS f32x4*)(Mg + 1808);
            ab0 -= mq[2][0] * xy[24]; ab1 -= mq[2][1] * xy[25]; ab0 -= mq[2][2] * xy[26]; xy[27] = ab0 + ab1; up[3456] = xy[27][0]; wp[3456] = f2bf(-xy[27][1]); mq[2] = *(const LAS f32x4*)(Mg + 1812);
            { const float br = betg[28]; ab0 = (f32x2){bf2f(*(const LAS bf16_t*)(lg + P5_VS + 7616 + c * 2)) * br, bf2f(*(const LAS bf16_t*)(lg + P5_KS + 7616 + c * 2)) * br * __expf(decg[28])}; ab1 = (f32x2){0.f, 0.f}; } ab0 -= mq[3][0] * xy[0]; ab1 -= mq[3][1] * xy[1]; ab0 -= mq[3][2] * xy[2]; ab1 -= mq[3][3] * xy[3]; mq[3] = *(const LAS f32x4*)(Mg + 1816);
            ab0 -= mq[4][0] * xy[4]; ab1 -= mq[4][1] * xy[5]; ab0 -= mq[4][2] * xy[6]; ab1 -= mq[4][3] * xy[7]; mq[4] = *(const LAS f32x4*)(Mg + 1856);
            ab0 -= mq[5][0] * xy[8]; ab1 -= mq[5][1] * xy[9]; ab0 -= mq[5][2] * xy[10]; ab1 -= mq[5][3] * xy[11]; mq[5] = *(const LAS f32x4*)(Mg + 1860);
            ab0 -= mq[0][0] * xy[12]; ab1 -= mq[0][1] * xy[13]; ab0 -= mq[0][2] * xy[14]; ab1 -= mq[0][3] * xy[15]; mq[0] = *(const LAS f32x4*)(Mg + 1864);
            ab0 -= mq[1][0] * xy[16]; ab1 -= mq[1][1] * xy[17]; ab0 -= mq[1][2] * xy[18]; ab1 -= mq[1][3] * xy[19]; mq[1] = *(const LAS f32x4*)(Mg + 1868);
            ab0 -= mq[2][0] * xy[20]; ab1 -= mq[2][1] * xy[21]; ab0 -= mq[2][2] * xy[22]; ab1 -= mq[2][3] * xy[23]; mq[2] = *(const LAS f32x4*)(Mg + 1872);
            ab0 -= mq[3][0] * xy[24]; ab1 -= mq[3][1] * xy[25]; ab0 -= mq[3][2] * xy[26]; ab1 -= mq[3][3] * xy[27]; xy[28] = ab0 + ab1; up[3584] = xy[28][0]; wp[3584] = f2bf(-xy[28][1]); mq[3] = *(const LAS f32x4*)(Mg + 1876);
            { const float br = betg[29]; ab0 = (f32x2){bf2f(*(const LAS bf16_t*)(lg + P5_VS + 7888 + c * 2)) * br, bf2f(*(const LAS bf16_t*)(lg + P5_KS + 7888 + c * 2)) * br * __expf(decg[29])}; ab1 = (f32x2){0.f, 0.f}; } ab0 -= mq[4][0] * xy[0]; ab1 -= mq[4][1] * xy[1]; ab0 -= mq[4][2] * xy[2]; ab1 -= mq[4][3] * xy[3]; mq[4] = *(const LAS f32x4*)(Mg + 1880);
            ab0 -= mq[5][0] * xy[4]; ab1 -= mq[5][1] * xy[5]; ab0 -= mq[5][2] * xy[6]; ab1 -= mq[5][3] * xy[7]; mq[5] = *(const LAS f32x4*)(Mg + 1884);
            ab0 -= mq[0][0] * xy[8]; ab1 -= mq[0][1] * xy[9]; ab0 -= mq[0][2] * xy[10]; ab1 -= mq[0][3] * xy[11]; mq[0] = *(const LAS f32x4*)(Mg + 1920);
            ab0 -= mq[1][0] * xy[12]; ab1 -= mq[1][1] * xy[13]; ab0 -= mq[1][2] * xy[14]; ab1 -= mq[1][3] * xy[15]; mq[1] = *(const LAS f32x4*)(Mg + 1924);
            ab0 -= mq[2][0] * xy[16]; ab1 -= mq[2][1] * xy[17]; ab0 -= mq[2][2] * xy[18]; ab1 -= mq[2][3] * xy[19]; mq[2] = *(const LAS f32x4*)(Mg + 1928);
            ab0 -= mq[3][0] * xy[20]; ab1 -= mq[3][1] * xy[21]; ab0 -= mq[3][2] * xy[22]; ab1 -= mq[3][3] * xy[23]; mq[3] = *(const LAS f32x4*)(Mg + 1932);
            ab0 -= mq[4][0] * xy[24]; ab1 -= mq[4][1] * xy[25]; ab0 -= mq[4][2] * xy[26]; ab1 -= mq[4][3] * xy[27]; mq[4] = *(const LAS f32x4*)(Mg + 1936);
            ab0 -= mq[5][0] * xy[28]; xy[29] = ab0 + ab1; up[3712] = xy[29][0]; wp[3712] = f2bf(-xy[29][1]); mq[5] = *(const LAS f32x4*)(Mg + 1940);
            { const float br = betg[30]; ab0 = (f32x2){bf2f(*(const LAS bf16_t*)(lg + P5_VS + 8160 + c * 2)) * br, bf2f(*(const LAS bf16_t*)(lg + P5_KS + 8160 + c * 2)) * br * __expf(decg[30])}; ab1 = (f32x2){0.f, 0.f}; } ab0 -= mq[0][0] * xy[0]; ab1 -= mq[0][1] * xy[1]; ab0 -= mq[0][2] * xy[2]; ab1 -= mq[0][3] * xy[3]; mq[0] = *(const LAS f32x4*)(Mg + 1944);
            ab0 -= mq[1][0] * xy[4]; ab1 -= mq[1][1] * xy[5]; ab0 -= mq[1][2] * xy[6]; ab1 -= mq[1][3] * xy[7]; mq[1] = *(const LAS f32x4*)(Mg + 1948);
            ab0 -= mq[2][0] * xy[8]; ab1 -= mq[2][1] * xy[9]; ab0 -= mq[2][2] * xy[10]; ab1 -= mq[2][3] * xy[11]; mq[2] = *(const LAS f32x4*)(Mg + 1984);
            ab0 -= mq[3][0] * xy[12]; ab1 -= mq[3][1] * xy[13]; ab0 -= mq[3][2] * xy[14]; ab1 -= mq[3][3] * xy[15]; mq[3] = *(const LAS f32x4*)(Mg + 1988);
            ab0 -= mq[4][0] * xy[16]; ab1 -= mq[4][1] * xy[17]; ab0 -= mq[4][2] * xy[18]; ab1 -= mq[4][3] * xy[19]; mq[4] = *(const LAS f32x4*)(Mg + 1992);
            ab0 -= mq[5][0] * xy[20]; ab1 -= mq[5][1] * xy[21]; ab0 -= mq[5][2] * xy[22]; ab1 -= mq[5][3] * xy[23]; mq[5] = *(const LAS f32x4*)(Mg + 1996);
            ab0 -= mq[0][0] * xy[24]; ab1 -= mq[0][1] * xy[25]; ab0 -= mq[0][2] * xy[26]; ab1 -= mq[0][3] * xy[27]; mq[0] = *(const LAS f32x4*)(Mg + 2000);
            ab0 -= mq[1][0] * xy[28]; ab1 -= mq[1][1] * xy[29]; xy[30] = ab0 + ab1; up[3840] = xy[30][0]; wp[3840] = f2bf(-xy[30][1]); mq[1] = *(const LAS f32x4*)(Mg + 2004);
            { const float br = betg[31]; ab0 = (f32x2){bf2f(*(const LAS bf16_t*)(lg + P5_VS + 8432 + c * 2)) * br, bf2f(*(const LAS bf16_t*)(lg + P5_KS + 8432 + c * 2)) * br * __expf(decg[31])}; ab1 = (f32x2){0.f, 0.f}; } ab0 -= mq[2][0] * xy[0]; ab1 -= mq[2][1] * xy[1]; ab0 -= mq[2][2] * xy[2]; ab1 -= mq[2][3] * xy[3]; mq[2] = *(const LAS f32x4*)(Mg + 2008);
            ab0 -= mq[3][0] * xy[4]; ab1 -= mq[3][1] * xy[5]; ab0 -= mq[3][2] * xy[6]; ab1 -= mq[3][3] * xy[7]; mq[3] = *(const LAS f32x4*)(Mg + 2012);
            ab0 -= mq[4][0] * xy[8]; ab1 -= mq[4][1] * xy[9]; ab0 -= mq[4][2] * xy[10]; ab1 -= mq[4][3] * xy[11]; mq[4] = *(const LAS f32x4*)(Mg + 2048);
            ab0 -= mq[5][0] * xy[12]; ab1 -= mq[5][1] * xy[13]; ab0 -= mq[5][2] * xy[14]; ab1 -= mq[5][3] * xy[15]; mq[5] = *(const LAS f32x4*)(Mg + 2052);
            ab0 -= mq[0][0] * xy[16]; ab1 -= mq[0][1] * xy[17]; ab0 -= mq[0][2] * xy[18]; ab1 -= mq[0][3] * xy[19]; mq[0] = *(const LAS f32x4*)(Mg + 2056);
            ab0 -= mq[1][0] * xy[20]; ab1 -= mq[1][1] * xy[21]; ab0 -= mq[1][2] * xy[22]; ab1 -= mq[1][3] * xy[23]; mq[1] = *(const LAS f32x4*)(Mg + 2060);
            ab0 -= mq[2][0] * xy[24]; ab1 -= mq[2][1] * xy[25]; ab0 -= mq[2][2] * xy[26]; ab1 -= mq[2][3] * xy[27]; mq[2] = *(const LAS f32x4*)(Mg + 2064);
            ab0 -= mq[3][0] * xy[28]; ab1 -= mq[3][1] * xy[29]; ab0 -= mq[3][2] * xy[30]; xy[31] = ab0 + ab1; up[3968] = xy[31][0]; wp[3968] = f2bf(-xy[31][1]); mq[3] = *(const LAS f32x4*)(Mg + 2068);
            { const float br = betg[32]; ab0 = (f32x2){bf2f(*(const LAS bf16_t*)(lg + P5_VS + 8704 + c * 2)) * br, bf2f(*(const LAS bf16_t*)(lg + P5_KS + 8704 + c * 2)) * br * __expf(decg[32])}; ab1 = (f32x2){0.f, 0.f}; } ab0 -= mq[4][0] * xy[0]; ab1 -= mq[4][1] * xy[1]; ab0 -= mq[4][2] * xy[2]; ab1 -= mq[4][3] * xy[3]; mq[4] = *(const LAS f32x4*)(Mg + 2072);
            ab0 -= mq[5][0] * xy[4]; ab1 -= mq[5][1] * xy[5]; ab0 -= mq[5][2] * xy[6]; ab1 -= mq[5][3] * xy[7]; mq[5] = *(const LAS f32x4*)(Mg + 2076);
            ab0 -= mq[0][0] * xy[8]; ab1 -= mq[0][1] * xy[9]; ab0 -= mq[0][2] * xy[10]; ab1 -= mq[0][3] * xy[11]; mq[0] = *(const LAS f32x4*)(Mg + 2112);
            ab0 -= mq[1][0] * xy[12]; ab1 -= mq[1][1] * xy[13]; ab0 -= mq[1][2] * xy[14]; ab1 -= mq[1][3] * xy[15]; mq[1] = *(const LAS f32x4*)(Mg + 2116);
            ab0 -= mq[2][0] * xy[16]; ab1 -= mq[2][1] * xy[17]; ab0 -= mq[2][2] * xy[18]; ab1 -= mq[2][3] * xy[19]; mq[2] = *(const LAS f32x4*)(Mg + 2120);
            ab0 -= mq[3][0] * xy[20]; ab1 -= mq[3][1] * xy[21]; ab0 -= mq[3][2] * xy[22]; ab1 -= mq[3][3] * xy[23]; mq[3] = *(const LAS f32x4*)(Mg + 2124);
            ab0 -= mq[4][0] * xy[24]; ab1 -= mq[4][1] * xy[25]; ab0 -= mq[4][2] * xy[26]; ab1 -= mq[4][3] * xy[27]; mq[4] = *(const LAS f32x4*)(Mg + 2128);
            ab0 -= mq[5][0] * xy[28]; ab1 -= mq[5][1] * xy[29]; ab0 -= mq[5][2] * xy[30]; ab1 -= mq[5][3] * xy[31]; xy[32] = ab0 + ab1; up[4096] = xy[32][0]; wp[4096] = f2bf(-xy[32][1]); mq[5] = *(const LAS f32x4*)(Mg + 2132);
            { const float br = betg[33]; ab0 = (f32x2){bf2f(*(const LAS bf16_t*)(lg + P5_VS + 8976 + c * 2)) * br, bf2f(*(const LAS bf16_t*)(lg + P5_KS + 8976 + c * 2)) * br * __expf(decg[33])}; ab1 = (f32x2){0.f, 0.f}; } ab0 -= mq[0][0] * xy[0]; ab1 -= mq[0][1] * xy[1]; ab0 -= mq[0][2] * xy[2]; ab1 -= mq[0][3] * xy[3]; mq[0] = *(const LAS f32x4*)(Mg + 2136);
            ab0 -= mq[1][0] * xy[4]; ab1 -= mq[1][1] * xy[5]; ab0 -= mq[1][2] * xy[6]; ab1 -= mq[1][3] * xy[7]; mq[1] = *(const LAS f32x4*)(Mg + 2140);
            ab0 -= mq[2][0] * xy[8]; ab1 -= mq[2][1] * xy[9]; ab0 -= mq[2][2] * xy[10]; ab1 -= mq[2][3] * xy[11]; mq[2] = *(const LAS f32x4*)(Mg + 2144);
            ab0 -= mq[3][0] * xy[12]; ab1 -= mq[3][1] * xy[13]; ab0 -= mq[3][2] * xy[14]; ab1 -= mq[3][3] * xy[15]; mq[3] = *(const LAS f32x4*)(Mg + 2176);
            ab0 -= mq[4][0] * xy[16]; ab1 -= mq[4][1] * xy[17]; ab0 -= mq[4][2] * xy[18]; ab1 -= mq[4][3] * xy[19]; mq[4] = *(const LAS f32x4*)(Mg + 2180);
            ab0 -= mq[5][0] * xy[20]; ab1 -= mq[5][1] * xy[21]; ab0 -= mq[5][2] * xy[22]; ab1 -= mq[5][3] * xy[23]; mq[5] = *(const LAS f32x4*)(Mg + 2184);
            ab0 -= mq[0][0] * xy[24]; ab1 -= mq[0][1] * xy[25]; ab0 -= mq[0][2] * xy[26]; ab1 -= mq[0][3] * xy[27]; mq[0] = *(const LAS f32x4*)(Mg + 2188);
            ab0 -= mq[1][0] * xy[28]; ab1 -= mq[1][1] * xy[29]; ab0 -= mq[1][2] * xy[30]; ab1 -= mq[1][3] * xy[31]; mq[1] = *(const LAS f32x4*)(Mg + 2192);
            ab0 -= mq[2][0] * xy[32]; xy[33] = ab0 + ab1; up[4224] = xy[33][0]; wp[4224] = f2bf(-xy[33][1]); mq[2] = *(const LAS f32x4*)(Mg + 2196);
            { const float br = betg[34]; ab0 = (f32x2){bf2f(*(const LAS bf16_t*)(lg + P5_VS + 9248 + c * 2)) * br, bf2f(*(const LAS bf16_t*)(lg + P5_KS + 9248 + c * 2)) * br * __expf(decg[34])}; ab1 = (f32x2){0.f, 0.f}; } ab0 -= mq[3][0] * xy[0]; ab1 -= mq[3][1] * xy[1]; ab0 -= mq[3][2] * xy[2]; ab1 -= mq[3][3] * xy[3]; mq[3] = *(const LAS f32x4*)(Mg + 2200);
            ab0 -= mq[4][0] * xy[4]; ab1 -= mq[4][1] * xy[5]; ab0 -= mq[4][2] * xy[6]; ab1 -= mq[4][3] * xy[7]; mq[4] = *(const LAS f32x4*)(Mg + 2204);
            ab0 -= mq[5][0] * xy[8]; ab1 -= mq[5][1] * xy[9]; ab0 -= mq[5][2] * xy[10]; ab1 -= mq[5][3] * xy[11]; mq[5] = *(const LAS f32x4*)(Mg + 2208);
            ab0 -= mq[0][0] * xy[12]; ab1 -= mq[0][1] * xy[13]; ab0 -= mq[0][2] * xy[14]; ab1 -= mq[0][3] * xy[15]; mq[0] = *(const LAS f32x4*)(Mg + 2240);
            ab0 -= mq[1][0] * xy[16]; ab1 -= mq[1][1] * xy[17]; ab0 -= mq[1][2] * xy[18]; ab1 -= mq[1][3] * xy[19]; mq[1] = *(const LAS f32x4*)(Mg + 2244);
            ab0 -= mq[2][0] * xy[20]; ab1 -= mq[2][1] * xy[21]; ab0 -= mq[2][2] * xy[22]; ab1 -= mq[2][3] * xy[23]; mq[2] = *(const LAS f32x4*)(Mg + 2248);
            ab0 -= mq[3][0] * xy[24]; ab1 -= mq[3][1] * xy[25]; ab0 -= mq[3][2] * xy[26]; ab1 -= mq[3][3] * xy[27]; mq[3] = *(const LAS f32x4*)(Mg + 2252);
            ab0 -= mq[4][0] * xy[28]; ab1 -= mq[4][1] * xy[29]; ab0 -= mq[4][2] * xy[30]; ab1 -= mq[4][3] * xy[31]; mq[4] = *(const LAS f32x4*)(Mg + 2256);
            ab0 -= mq[5][0] * xy[32]; ab1 -= mq[5][1] * xy[33]; xy[34] = ab0 + ab1; up[4352] = xy[34][0]; wp[4352] = f2bf(-xy[34][1]); mq[5] = *(const LAS f32x4*)(Mg + 2260);
            { const float br = betg[35]; ab0 = (f32x2){bf2f(*(const LAS bf16_t*)(lg + P5_VS + 9520 + c * 2)) * br, bf2f(*(const LAS bf16_t*)(lg + P5_KS + 9520 + c * 2)) * br * __expf(decg[35])}; ab1 = (f32x2){0.f, 0.f}; } ab0 -= mq[0][0] * xy[0]; ab1 -= mq[0][1] * xy[1]; ab0 -= mq[0][2] * xy[2]; ab1 -= mq[0][3] * xy[3]; mq[0] = *(const LAS f32x4*)(Mg + 2264);
            ab0 -= mq[1][0] * xy[4]; ab1 -= mq[1][1] * xy[5]; ab0 -= mq[1][2] * xy[6]; ab1 -= mq[1][3] * xy[7]; mq[1] = *(const LAS f32x4*)(Mg + 2268);
            ab0 -= mq[2][0] * xy[8]; ab1 -= mq[2][1] * xy[9]; ab0 -= mq[2][2] * xy[10]; ab1 -= mq[2][3] * xy[11]; mq[2] = *(const LAS f32x4*)(Mg + 2272);
            ab0 -= mq[3][0] * xy[12]; ab1 -= mq[3][1] * xy[13]; ab0 -= mq[3][2] * xy[14]; ab1 -= mq[3][3] * xy[15]; mq[3] = *(const LAS f32x4*)(Mg + 2304);
            ab0 -= mq[4][0] * xy[16]; ab1 -= mq[4][1] * xy[17]; ab0 -= mq[4][2] * xy[18]; ab1 -= mq[4][3] * xy[19]; mq[4] = *(const LAS f32x4*)(Mg + 2308);
            ab0 -= mq[5][0] * xy[20]; ab1 -= mq[5][1] * xy[21]; ab0 -= mq[5][2] * xy[22]; ab1 -= mq[5][3] * xy[23]; mq[5] = *(const LAS f32x4*)(Mg + 2312);
            ab0 -= mq[0][0] * xy[24]; ab1 -= mq[0][1] * xy[25]; ab0 -= mq[0][2] * xy[26]; ab1 -= mq[0][3] * xy[27]; mq[0] = *(const LAS f32x4*)(Mg + 2316);
            ab0 -= mq[1][0] * xy[28]; ab1 -= mq[1][1] * xy[29]; ab0 -= mq[1][2] * xy[30]; ab1 -= mq[1][3] * xy[31]; mq[1] = *(const LAS f32x4*)(Mg + 2320);
            ab0 -= mq[2][0] * xy[32]; ab1 -= mq[2][1] * xy[33]; ab0 -= mq[2][2] * xy[34]; xy[35] = ab0 + ab1; up[4480] = xy[35][0]; wp[4480] = f2bf(-xy[35][1]); mq[2] = *(const LAS f32x4*)(Mg + 2324);
            { const float br = betg[36]; ab0 = (f32x2){bf2f(*(const LAS bf16_t*)(lg + P5_VS + 9792 + c * 2)) * br, bf2f(*(const LAS bf16_t*)(lg + P5_KS + 9792 + c * 2)) * br * __expf(decg[36])}; ab1 = (f32x2){0.f, 0.f}; } ab0 -= mq[3][0] * xy[0]; ab1 -= mq[3][1] * xy[1]; ab0 -= mq[3][2] * xy[2]; ab1 -= mq[3][3] * xy[3]; mq[3] = *(const LAS f32x4*)(Mg + 2328);
            ab0 -= mq[4][0] * xy[4]; ab1 -= mq[4][1] * xy[5]; ab0 -= mq[4][2] * xy[6]; ab1 -= mq[4][3] * xy[7]; mq[4] = *(const LAS f32x4*)(Mg + 2332);
            ab0 -= mq[5][0] * xy[8]; ab1 -= mq[5][1] * xy[9]; ab0 -= mq[5][2] * xy[10]; ab1 -= mq[5][3] * xy[11]; mq[5] = *(const LAS f32x4*)(Mg + 2336);
            ab0 -= mq[0][0] * xy[12]; ab1 -= mq[0][1] * xy[13]; ab0 -= mq[0][2] * xy[14]; ab1 -= mq[0][3] * xy[15]; mq[0] = *(const LAS f32x4*)(Mg + 2368);
            ab0 -= mq[1][0] * xy[16]; ab1 -= mq[1][1] * xy[17]; ab0 -= mq[1][2] * xy[18]; ab1 -= mq[1][3] * xy[19]; mq[1] = *(const LAS f32x4*)(Mg + 2372);
            ab0 -= mq[2][0] * xy[20]; ab1 -= mq[2][1] * xy[21]; ab0 -= mq[2][2] * xy[22]; ab1 -= mq[2][3] * xy[23]; mq[2] = *(const LAS f32x4*)(Mg + 2376);
            ab0 -= mq[3][0] * xy[24]; ab1 -= mq[3][1] * xy[25]; ab0 -= mq[3][2] * xy[26]; ab1 -= mq[3][3] * xy[27]; mq[3] = *(const LAS f32x4*)(Mg + 2380);
            ab0 -= mq[4][0] * xy[28]; ab1 -= mq[4][1] * xy[29]; ab0 -= mq[4][2] * xy[30]; ab1 -= mq[4][3] * xy[31]; mq[4] = *(const LAS f32x4*)(Mg + 2384);
            ab0 -= mq[5][0] * xy[32]; ab1 -= mq[5][1] * xy[33]; ab0 -= mq[5][2] * xy[34]; ab1 -= mq[5][3] * xy[35]; xy[36] = ab0 + ab1; up[4608] = xy[36][0]; wp[4608] = f2bf(-xy[36][1]); mq[5] = *(const LAS f32x4*)(Mg + 2388);
            { const float br = betg[37]; ab0 = (f32x2){bf2f(*(const LAS bf16_t*)(lg + P5_VS + 10064 + c * 2)) * br, bf2f(*(const LAS bf16_t*)(lg + P5_KS + 10064 + c * 2)) * br * __expf(decg[37])}; ab1 = (f32x2){0.f, 0.f}; } ab0 -= mq[0][0] * xy[0]; ab1 -= mq[0][1] * xy[1]; ab0 -= mq[0][2] * xy[2]; ab1 -= mq[0][3] * xy[3]; mq[0] = *(const LAS f32x4*)(Mg + 2392);
            ab0 -= mq[1][0] * xy[4]; ab1 -= mq[1][1] * xy[5]; ab0 -= mq[1][2] * xy[6]; ab1 -= mq[1][3] * xy[7]; mq[1] = *(const LAS f32x4*)(Mg + 2396);
            ab0 -= mq[2][0] * xy[8]; ab1 -= mq[2][1] * xy[9]; ab0 -= mq[2][2] * xy[10]; ab1 -= mq[2][3] * xy[11]; mq[2] = *(const LAS f32x4*)(Mg + 2400);
            ab0 -= mq[3][0] * xy[12]; ab1 -= mq[3][1] * xy[13]; ab0 -= mq[3][2] * xy[14]; ab1 -= mq[3][3] * xy[15]; mq[3] = *(const LAS f32x4*)(Mg + 2404);
            ab0 -= mq[4][0] * xy[16]; ab1 -= mq[4][1] * xy[17]; ab0 -= mq[4][2] * xy[18]; ab1 -= mq[4][3] * xy[19]; mq[4] = *(const LAS f32x4*)(Mg + 2432);
            ab0 -= mq[5][0] * xy[20]; ab1 -= mq[5][1] * xy[21]; ab0 -= mq[5][2] * xy[22]; ab1 -= mq[5][3] * xy[23]; mq[5] = *(const LAS f32x4*)(Mg + 2436);
            ab0 -= mq[0][0] * xy[24]; ab1 -= mq[0][1] * xy[25]; ab0 -= mq[0][2] * xy[26]; ab1 -= mq[0][3] * xy[27]; mq[0] = *(const LAS f32x4*)(Mg + 2440);
            ab0 -= mq[1][0] * xy[28]; ab1 -= mq[1][1] * xy[29]; ab0 -= mq[1][2] * xy[30]; ab1 -= mq[1][3] * xy[31]; mq[1] = *(const LAS f32x4*)(Mg + 2444);
            ab0 -= mq[2][0] * xy[32]; ab1 -= mq[2][1] * xy[33]; ab0 -= mq[2][2] * xy[34]; ab1 -= mq[2][3] * xy[35]; mq[2] = *(const LAS f32x4*)(Mg + 2448);
            ab0 -= mq[3][0] * xy[36]; xy[37] = ab0 + ab1; up[4736] = xy[37][0]; wp[4736] = f2bf(-xy[37][1]); mq[3] = *(const LAS f32x4*)(Mg + 2452);
            { const float br = betg[38]; ab0 = (f32x2){bf2f(*(const LAS bf16_t*)(lg + P5_VS + 10336 + c * 2)) * br, bf2f(*(const LAS bf16_t*)(lg + P5_KS + 10336 + c * 2)) * br * __expf(decg[38])}; ab1 = (f32x2){0.f, 0.f}; } ab0 -= mq[4][0] * xy[0]; ab1 -= mq[4][1] * xy[1]; ab0 -= mq[4][2] * xy[2]; ab1 -= mq[4][3] * xy[3]; mq[4] = *(const LAS f32x4*)(Mg + 2456);
            ab0 -= mq[5][0] * xy[4]; ab1 -= mq[5][1] * xy[5]; ab0 -= mq[5][2] * xy[6]; ab1 -= mq[5][3] * xy[7]; mq[5] = *(const LAS f32x4*)(Mg + 2460);
            ab0 -= mq[0][0] * xy[8]; ab1 -= mq[0][1] * xy[9]; ab0 -= mq[0][2] * xy[10]; ab1 -= mq[0][3] * xy[11]; mq[0] = *(const LAS f32x4*)(Mg + 2464);
            ab0 -= mq[1][0] * xy[12]; ab1 -= mq[1][1] * xy[13]; ab0 -= mq[1][2] * xy[14]; ab1 -= mq[1][3] * xy[15]; mq[1] = *(const LAS f32x4*)(Mg + 2468);
            ab0 -= mq[2][0] * xy[16]; ab1 -= mq[2][1] * xy[17]; ab0 -= mq[2][2] * xy[18]; ab1 -= mq[2][3] * xy[19]; mq[2] = *(const LAS f32x4*)(Mg + 2496);
            ab0 -= mq[3][0] * xy[20]; ab1 -= mq[3][1] * xy[21]; ab0 -= mq[3][2] * xy[22]; ab1 -= mq[3][3] * xy[23]; mq[3] = *(const LAS f32x4*)(Mg + 2500);
            ab0 -= mq[4][0] * xy[24]; ab1 -= mq[4][1] * xy[25]; ab0 -= mq[4][2] * xy[26]; ab1 -= mq[4][3] * xy[27]; mq[4] = *(const LAS f32x4*)(Mg + 2504);
            ab0 -= mq[5][0] * xy[28]; ab1 -= mq[5][1] * xy[29]; ab0 -= mq[5][2] * xy[30]; ab1 -= mq[5][3] * xy[31]; mq[5] = *(const LAS f32x4*)(Mg + 2508);
            ab0 -= mq[0][0] * xy[32]; ab1 -= mq[0][1] * xy[33]; ab0 -= mq[0][2] * xy[34]; ab1 -= mq[0][3] * xy[35]; mq[0] = *(const LAS f32x4*)(Mg + 2512);
            ab0 -= mq[1][0] * xy[36]; ab1 -= mq[1][1] * xy[37]; xy[38] = ab0 + ab1; up[4864] = xy[38][0]; wp[4864] = f2bf(-xy[38][1]); mq[1] = *(const LAS f32x4*)(Mg + 2516);
            { const float br = betg[39]; ab0 = (f32x2){bf2f(*(const LAS bf16_t*)(lg + P5_VS + 10608 + c * 2)) * br, bf2f(*(const LAS bf16_t*)(lg + P5_KS + 10608 + c * 2)) * br * __expf(decg[39])}; ab1 = (f32x2){0.f, 0.f}; } ab0 -= mq[2][0] * xy[0]; ab1 -= mq[2][1] * xy[1]; ab0 -= mq[2][2] * xy[2]; ab1 -= mq[2][3] * xy[3]; mq[2] = *(const LAS f32x4*)(Mg + 2520);
            ab0 -= mq[3][0] * xy[4]; ab1 -= mq[3][1] * xy[5]; ab0 -= mq[3][2] * xy[6]; ab1 -= mq[3][3] * xy[7]; mq[3] = *(const LAS f32x4*)(Mg + 2524);
            ab0 -= mq[4][0] * xy[8]; ab1 -= mq[4][1] * xy[9]; ab0 -= mq[4][2] * xy[10]; ab1 -= mq[4][3] * xy[11]; mq[4] = *(const LAS f32x4*)(Mg + 2528);
            ab0 -= mq[5][0] * xy[12]; ab1 -= mq[5][1] * xy[13]; ab0 -= mq[5][2] * xy[14]; ab1 -= mq[5][3] * xy[15]; mq[5] = *(const LAS f32x4*)(Mg + 2532);
            ab0 -= mq[0][0] * xy[16]; ab1 -= mq[0][1] * xy[17]; ab0 -= mq[0][2] * xy[18]; ab1 -= mq[0][3] * xy[19]; mq[0] = *(const LAS f32x4*)(Mg + 2560);
            ab0 -= mq[1][0] * xy[20]; ab1 -= mq[1][1] * xy[21]; ab0 -= mq[1][2] * xy[22]; ab1 -= mq[1][3] * xy[23]; mq[1] = *(const LAS f32x4*)(Mg + 2564);
            ab0 -= mq[2][0] * xy[24]; ab1 -= mq[2][1] * xy[25]; ab0 -= mq[2][2] * xy[26]; ab1 -= mq[2][3] * xy[27]; mq[2] = *(const LAS f32x4*)(Mg + 2568);
            ab0 -= mq[3][0] * xy[28]; ab1 -= mq[3][1] * xy[29]; ab0 -= mq[3][2] * xy[30]; ab1 -= mq[3][3] * xy[31]; mq[3] = *(const LAS f32x4*)(Mg + 2572);
            ab0 -= mq[4][0] * xy[32]; ab1 -= mq[4][1] * xy[33]; ab0 -= mq[4][2] * xy[34]; ab1 -= mq[4][3] * xy[35]; mq[4] = *(const LAS f32x4*)(Mg + 2576);
            ab0 -= mq[5][0] * xy[36]; ab1 -= mq[5][1] * xy[37]; ab0 -= mq[5][2] * xy[38]; xy[39] = ab0 + ab1; up[4992] = xy[39][0]; wp[4992] = f2bf(-xy[39][1]); mq[5] = *(const LAS f32x4*)(Mg + 2580);
            { const float br = betg[40]; ab0 = (f32x2){bf2f(*(const LAS bf16_t*)(lg + P5_VS + 10880 + c * 2)) * br, bf2f(*(const LAS bf16_t*)(lg + P5_KS + 10880 + c * 2)) * br * __expf(decg[40])}; ab1 = (f32x2){0.f, 0.f}; } ab0 -= mq[0][0] * xy[0]; ab1 -= mq[0][1] * xy[1]; ab0 -= mq[0][2] * xy[2]; ab1 -= mq[0][3] * xy[3]; mq[0] = *(const LAS f32x4*)(Mg + 2584);
            ab0 -= mq[1][0] * xy[4]; ab1 -= mq[1][1] * xy[5]; ab0 -= mq[1][2] * xy[6]; ab1 -= mq[1][3] * xy[7]; mq[1] = *(const LAS f32x4*)(Mg + 2588);
            ab0 -= mq[2][0] * xy[8]; ab1 -= mq[2][1] * xy[9]; ab0 -= mq[2][2] * xy[10]; ab1 -= mq[2][3] * xy[11]; mq[2] = *(const LAS f32x4*)(Mg + 2592);
            ab0 -= mq[3][0] * xy[12]; ab1 -= mq[3][1] * xy[13]; ab0 -= mq[3][2] * xy[14]; ab1 -= mq[3][3] * xy[15]; mq[3] = *(const LAS f32x4*)(Mg + 2596);
            ab0 -= mq[4][0] * xy[16]; ab1 -= mq[4][1] * xy[17]; ab0 -= mq[4][2] * xy[18]; ab1 -= mq[4][3] * xy[19]; mq[4] = *(const LAS f32x4*)(Mg + 2624);
            ab0 -= mq[5][0] * xy[20]; ab1 -= mq[5][1] * xy[21]; ab0 -= mq[5][2] * xy[22]; ab1 -= mq[5][3] * xy[23]; mq[5] = *(const LAS f32x4*)(Mg + 2628);
            ab0 -= mq[0][0] * xy[24]; ab1 -= mq[0][1] * xy[25]; ab0 -= mq[0][2] * xy[26]; ab1 -= mq[0][3] * xy[27]; mq[0] = *(const LAS f32x4*)(Mg + 2632);
            ab0 -= mq[1][0] * xy[28]; ab1 -= mq[1][1] * xy[29]; ab0 -= mq[1][2] * xy[30]; ab1 -= mq[1][3] * xy[31]; mq[1] = *(const LAS f32x4*)(Mg + 2636);
            ab0 -= mq[2][0] * xy[32]; ab1 -= mq[2][1] * xy[33]; ab0 -= mq[2][2] * xy[34]; ab1 -= mq[2][3] * xy[35]; mq[2] = *(const LAS f32x4*)(Mg + 2640);
            ab0 -= mq[3][0] * xy[36]; ab1 -= mq[3][1] * xy[37]; ab0 -= mq[3][2] * xy[38]; ab1 -= mq[3][3] * xy[39]; xy[40] = ab0 + ab1; up[5120] = xy[40][0]; wp[5120] = f2bf(-xy[40][1]); mq[3] = *(const LAS f32x4*)(Mg + 2644);
            { const float br = betg[41]; ab0 = (f32x2){bf2f(*(const LAS bf16_t*)(lg + P5_VS + 11152 + c * 2)) * br, bf2f(*(const LAS bf16_t*)(lg + P5_KS + 11152 + c * 2)) * br * __expf(decg[41])}; ab1 = (f32x2){0.f, 0.f}; } ab0 -= mq[4][0] * xy[0]; ab1 -= mq[4][1] * xy[1]; ab0 -= mq[4][2] * xy[2]; ab1 -= mq[4][3] * xy[3]; mq[4] = *(const LAS f32x4*)(Mg + 2648);
            ab0 -= mq[5][0] * xy[4]; ab1 -= mq[5][1] * xy[5]; ab0 -= mq[5][2] * xy[6]; ab1 -= mq[5][3] * xy[7]; mq[5] = *(const LAS f32x4*)(Mg + 2652);
            ab0 -= mq[0][0] * xy[8]; ab1 -= mq[0][1] * xy[9]; ab0 -= mq[0][2] * xy[10]; ab1 -= mq[0][3] * xy[11]; mq[0] = *(const LAS f32x4*)(Mg + 2656);
            ab0 -= mq[1][0] * xy[12]; ab1 -= mq[1][1] * xy[13]; ab0 -= mq[1][2] * xy[14]; ab1 -= mq[1][3] * xy[15]; mq[1] = *(const LAS f32x4*)(Mg + 2660);
            ab0 -= mq[2][0] * xy[16]; ab1 -= mq[2][1] * xy[17]; ab0 -= mq[2][2] * xy[18]; ab1 -= mq[2][3] * xy[19]; mq[2] = *(const LAS f32x4*)(Mg + 2664);
            ab0 -= mq[3][0] * xy[20]; ab1 -= mq[3][1] * xy[21]; ab0 -= mq[3][2] * xy[22]; ab1 -= mq[3][3] * xy[23]; mq[3] = *(const LAS f32x4*)(Mg + 2688);
            ab0 -= mq[4][0] * xy[24]; ab1 -= mq[4][1] * xy[25]; ab0 -= mq[4][2] * xy[26]; ab1 -= mq[4][3] * xy[27]; mq[4] = *(const LAS f32x4*)(Mg + 2692);
            ab0 -= mq[5][0] * xy[28]; ab1 -= mq[5][1] * xy[29]; ab0 -= mq[5][2] * xy[30]; ab1 -= mq[5][3] * xy[31]; mq[5] = *(const LAS f32x4*)(Mg + 2696);
            ab0 -= mq[0][0] * xy[32]; ab1 -= mq[0][1] * xy[33]; ab0 -= mq[0][2] * xy[34]; ab1 -= mq[0][3] * xy[35]; mq[0] = *(const LAS f32x4*)(Mg + 2700);
            ab0 -= mq[1][0] * xy[36]; ab1 -= mq[1][1] * xy[37]; ab0 -= mq[1][2] * xy[38]; ab1 -= mq[1][3] * xy[39]; mq[1] = *(const LAS f32x4*)(Mg + 2704);
            ab0 -= mq[2][0] * xy[40]; xy[41] = ab0 + ab1; up[5248] = xy[41][0]; wp[5248] = f2bf(-xy[41][1]); mq[2] = *(const LAS f32x4*)(Mg + 2708);
            { const float br = betg[42]; ab0 = (f32x2){bf2f(*(const LAS bf16_t*)(lg + P5_VS + 11424 + c * 2)) * br, bf2f(*(const LAS bf16_t*)(lg + P5_KS + 11424 + c * 2)) * br * __expf(decg[42])}; ab1 = (f32x2){0.f, 0.f}; } ab0 -= mq[3][0] * xy[0]; ab1 -= mq[3][1] * xy[1]; ab0 -= mq[3][2] * xy[2]; ab1 -= mq[3][3] * xy[3]; mq[3] = *(const LAS f32x4*)(Mg + 2712);
            ab0 -= mq[4][0] * xy[4]; ab1 -= mq[4][1] * xy[5]; ab0 -= mq[4][2] * xy[6]; ab1 -= mq[4][3] * xy[7]; mq[4] = *(const LAS f32x4*)(Mg + 2716);
            ab0 -= mq[5][0] * xy[8]; ab1 -= mq[5][1] * xy[9]; ab0 -= mq[5][2] * xy[10]; ab1 -= mq[5][3] * xy[11]; mq[5] = *(const LAS f32x4*)(Mg + 2720);
            ab0 -= mq[0][0] * xy[12]; ab1 -= mq[0][1] * xy[13]; ab0 -= mq[0][2] * xy[14]; ab1 -= mq[0][3] * xy[15]; mq[0] = *(const LAS f32x4*)(Mg + 2724);
            ab0 -= mq[1][0] * xy[16]; ab1 -= mq[1][1] * xy[17]; ab0 -= mq[1][2] * xy[18]; ab1 -= mq[1][3] * xy[19]; mq[1] = *(const LAS f32x4*)(Mg + 2728);
            ab0 -= mq[2][0] * xy[20]; ab1 -= mq[2][1] * xy[21]; ab0 -= mq[2][2] * xy[22]; ab1 -= mq[2][3] * xy[23]; mq[2] = *(const LAS f32x4*)(Mg + 2752);
            ab0 -= mq[3][0] * xy[24]; ab1 -= mq[3][1] * xy[25]; ab0 -= mq[3][2] * xy[26]; ab1 -= mq[3][3] * xy[27]; mq[3] = *(const LAS f32x4*)(Mg + 2756);
            ab0 -= mq[4][0] * xy[28]; ab1 -= mq[4][1] * xy[29]; ab0 -= mq[4][2] * xy[30]; ab1 -= mq[4][3] * xy[31]; mq[4] = *(const LAS f32x4*)(Mg + 2760);
            ab0 -= mq[5][0] * xy[32]; ab1 -= mq[5][1] * xy[33]; ab0 -= mq[5][2] * xy[34]; ab1 -= mq[5][3] * xy[35]; mq[5] = *(const LAS f32x4*)(Mg + 2764);
            ab0 -= mq[0][0] * xy[36]; ab1 -= mq[0][1] * xy[37]; ab0 -= mq[0][2] * xy[38]; ab1 -= mq[0][3] * xy[39]; mq[0] = *(const LAS f32x4*)(Mg + 2768);
            ab0 -= mq[1][0] * xy[40]; ab1 -= mq[1][1] * xy[41]; xy[42] = ab0 + ab1; up[5376] = xy[42][0]; wp[5376] = f2bf(-xy[42][1]); mq[1] = *(const LAS f32x4*)(Mg + 2772);
            { const float br = betg[43]; ab0 = (f32x2){bf2f(*(const LAS bf16_t*)(lg + P5_VS + 11696 + c * 2)) * br, bf2f(*(const LAS bf16_t*)(lg + P5_KS + 11696 + c * 2)) * br * __expf(decg[43])}; ab1 = (f32x2){0.f, 0.f}; } ab0 -= mq[2][0] * xy[0]; ab1 -= mq[2][1] * xy[1]; ab0 -= mq[2][2] * xy[2]; ab1 -= mq[2][3] * xy[3]; mq[2] = *(const LAS f32x4*)(Mg + 2776);
            ab0 -= mq[3][0] * xy[4]; ab1 -= mq[3][1] * xy[5]; ab0 -= mq[3][2] * xy[6]; ab1 -= mq[3][3] * xy[7]; mq[3] = *(const LAS f32x4*)(Mg + 2780);
            ab0 -= mq[4][0] * xy[8]; ab1 -= mq[4][1] * xy[9]; ab0 -= mq[4][2] * xy[10]; ab1 -= mq[4][3] * xy[11]; mq[4] = *(const LAS f32x4*)(Mg + 2784);
            ab0 -= mq[5][0] * xy[12]; ab1 -= mq[5][1] * xy[13]; ab0 -= mq[5][2] * xy[14]; ab1 -= mq[5][3] * xy[15]; mq[5] = *(const LAS f32x4*)(Mg + 2788);
            ab0 -= mq[0][0] * xy[16]; ab1 -= mq[0][1] * xy[17]; ab0 -= mq[0][2] * xy[18]; ab1 -= mq[0][3] * xy[19]; mq[0] = *(const LAS f32x4*)(Mg + 2792);
            ab0 -= mq[1][0] * xy[20]; ab1 -= mq[1][1] * xy[21]; ab0 -= mq[1][2] * xy[22]; ab1 -= mq[1][3] * xy[23]; mq[1] = *(const LAS f32x4*)(Mg + 2816);
            ab0 -= mq[2][0] * xy[24]; ab1 -= mq[2][1] * xy[25]; ab0 -= mq[2][2] * xy[26]; ab1 -= mq[2][3] * xy[27]; mq[2] = *(const LAS f32x4*)(Mg + 2820);
            ab0 -= mq[3][0] * xy[28]; ab1 -= mq[3][1] * xy[29]; ab0 -= mq[3][2] * xy[30]; ab1 -= mq[3][3] * xy[31]; mq[3] = *(const LAS f32x4*)(Mg + 2824);
            ab0 -= mq[4][0] * xy[32]; ab1 -= mq[4][1] * xy[33]; ab0 -= mq[4][2] * xy[34]; ab1 -= mq[4][3] * xy[35]; mq[4] = *(const LAS f32x4*)(Mg + 2828);
            ab0 -= mq[5][0] * xy[36]; ab1 -= mq[5][1] * xy[37]; ab0 -= mq[5][2] * xy[38]; ab1 -= mq[5][3] * xy[39]; mq[5] = *(const LAS f32x4*)(Mg + 2832);
            ab0 -= mq[0][0] * xy[40]; ab1 -= mq[0][1] * xy[41]; ab0 -= mq[0][2] * xy[42]; xy[43] = ab0 + ab1; up[5504] = xy[43][0]; wp[5504] = f2bf(-xy[43][1]); mq[0] = *(const LAS f32x4*)(Mg + 2836);
            { const float br = betg[44]; ab0 = (f32x2){bf2f(*(const LAS bf16_t*)(lg + P5_VS + 11968 + c * 2)) * br, bf2f(*(const LAS bf16_t*)(lg + P5_KS + 11968 + c * 2)) * br * __expf(decg[44])}; ab1 = (f32x2){0.f, 0.f}; } ab0 -= mq[1][0] * xy[0]; ab1 -= mq[1][1] * xy[1]; ab0 -= mq[1][2] * xy[2]; ab1 -= mq[1][3] * xy[3]; mq[1] = *(const LAS f32x4*)(Mg + 2840);
            ab0 -= mq[2][0] * xy[4]; ab1 -= mq[2][1] * xy[5]; ab0 -= mq[2][2] * xy[6]; ab1 -= mq[2][3] * xy[7]; mq[2] = *(const LAS f32x4*)(Mg + 2844);
            ab0 -= mq[3][0] * xy[8]; ab1 -= mq[3][1] * xy[9]; ab0 -= mq[3][2] * xy[10]; ab1 -= mq[3][3] * xy[11]; mq[3] = *(const LAS f32x4*)(Mg + 2848);
            ab0 -= mq[4][0] * xy[12]; ab1 -= mq[4][1] * xy[13]; ab0 -= mq[4][2] * xy[14]; ab1 -= mq[4][3] * xy[15]; mq[4] = *(const LAS f32x4*)(Mg + 2852);
            ab0 -= mq[5][0] * xy[16]; ab1 -= mq[5][1] * xy[17]; ab0 -= mq[5][2] * xy[18]; ab1 -= mq[5][3] * xy[19]; mq[5] = *(const LAS f32x4*)(Mg + 2856);
            ab0 -= mq[0][0] * xy[20]; ab1 -= mq[0][1] * xy[21]; ab0 -= mq[0][2] * xy[22]; ab1 -= mq[0][3] * xy[23]; mq[0] = *(const LAS f32x4*)(Mg + 2880);
            ab0 -= mq[1][0] * xy[24]; ab1 -= mq[1][1] * xy[25]; ab0 -= mq[1][2] * xy[26]; ab1 -= mq[1][3] * xy[27]; mq[1] = *(const LAS f32x4*)(Mg + 2884);
            ab0 -= mq[2][0] * xy[28]; ab1 -= mq[2][1] * xy[29]; ab0 -= mq[2][2] * xy[30]; ab1 -= mq[2][3] * xy[31]; mq[2] = *(const LAS f32x4*)(Mg + 2888);
            ab0 -= mq[3][0] * xy[32]; ab1 -= mq[3][1] * xy[33]; ab0 -= mq[3][2] * xy[34]; ab1 -= mq[3][3] * xy[35]; mq[3] = *(const LAS f32x4*)(Mg + 2892);
            ab0 -= mq[4][0] * xy[36]; ab1 -= mq[4][1] * xy[37]; ab0 -= mq[4][2] * xy[38]; ab1 -= mq[4][3] * xy[39]; mq[4] = *(const LAS f32x4*)(Mg + 2896);
            ab0 -= mq[5][0] * xy[40]; ab1 -= mq[5][1] * xy[41]; ab0 -= mq[5][2] * xy[42]; ab1 -= mq[5][3] * xy[43]; xy[44] = ab0 + ab1; up[5632] = xy[44][0]; wp[5632] = f2bf(-xy[44][1]); mq[5] = *(const LAS f32x4*)(Mg + 2900);
            { const float br = betg[45]; ab0 = (f32x2){bf2f(*(const LAS bf16_t*)(lg + P5_VS + 12240 + c * 2)) * br, bf2f(*(const LAS bf16_t*)(lg + P5_KS + 12240 + c * 2)) * br * __expf(decg[45])}; ab1 = (f32x2){0.f, 0.f}; } ab0 -= mq[0][0] * xy[0]; ab1 -= mq[0][1] * xy[1]; ab0 -= mq[0][2] * xy[2]; ab1 -= mq[0][3] * xy[3]; mq[0] = *(const LAS f32x4*)(Mg + 2904);
            ab0 -= mq[1][0] * xy[4]; ab1 -= mq[1][1] * xy[5]; ab0 -= mq[1][2] * xy[6]; ab1 -= mq[1][3] * xy[7]; mq[1] = *(const LAS f32x4*)(Mg + 2908);
            ab0 -= mq[2][0] * xy[8]; ab1 -= mq[2][1] * xy[9]; ab0 -= mq[2][2] * xy[10]; ab1 -= mq[2][3] * xy[11]; mq[2] = *(const LAS f32x4*)(Mg + 2912);
            ab0 -= mq[3][0] * xy[12]; ab1 -= mq[3][1] * xy[13]; ab0 -= mq[3][2] * xy[14]; ab1 -= mq[3][3] * xy[15]; mq[3] = *(const LAS f32x4*)(Mg + 2916);
            ab0 -= mq[4][0] * xy[16]; ab1 -= mq[4][1] * xy[17]; ab0 -= mq[4][2] * xy[18]; ab1 -= mq[4][3] * xy[19]; mq[4] = *(const LAS f32x4*)(Mg + 2920);
            ab0 -= mq[5][0] * xy[20]; ab1 -= mq[5][1] * xy[21]; ab0 -= mq[5][2] * xy[22]; ab1 -= mq[5][3] * xy[23]; mq[5] = *(const LAS f32x4*)(Mg + 2924);
            ab0 -= mq[0][0] * xy[24]; ab1 -= mq[0][1] * xy[25]; ab0 -= mq[0][2] * xy[26]; ab1 -= mq[0][3] * xy[27]; mq[0] = *(const LAS f32x4*)(Mg + 2944);
            ab0 -= mq[1][0] * xy[28]; ab1 -= mq[1][1] * xy[29]; ab0 -= mq[1][2] * xy[30]; ab1 -= mq[1][3] * xy[31]; mq[1] = *(const LAS f32x4*)(Mg + 2948);
            ab0 -= mq[2][0] * xy[32]; ab1 -= mq[2][1] * xy[33]; ab0 -= mq[2][2] * xy[34]; ab1 -= mq[2][3] * xy[35]; mq[2] = *(const LAS f32x4*)(Mg + 2952);
            ab0 -= mq[3][0] * xy[36]; ab1 -= mq[3][1] * xy[37]; ab0 -= mq[3][2] * xy[38]; ab1 -= mq[3][3] * xy[39]; mq[3] = *(const LAS f32x4*)(Mg + 2956);
            ab0 -= mq[4][0] * xy[40]; ab1 -= mq[4][1] * xy[41]; ab0 -= mq[4][2] * xy[42]; ab1 -= mq[4][3] * xy[43]; mq[4] = *(const LAS f32x4*)(Mg + 2960);
            ab0 -= mq[5][0] * xy[44]; xy[45] = ab0 + ab1; up[5760] = xy[45][0]; wp[5760] = f2bf(-xy[45][1]); mq[5] = *(const LAS f32x4*)(Mg + 2964);
            { const float br = betg[46]; ab0 = (f32x2){bf2f(*(const LAS bf16_t*)(lg + P5_VS + 12512 + c * 2)) * br, bf2f(*(const LAS bf16_t*)(lg + P5_KS + 12512 + c * 2)) * br * __expf(decg[46])}; ab1 = (f32x2){0.f, 0.f}; } ab0 -= mq[0][0] * xy[0]; ab1 -= mq[0][1] * xy[1]; ab0 -= mq[0][2] * xy[2]; ab1 -= mq[0][3] * xy[3]; mq[0] = *(const LAS f32x4*)(Mg + 2968);
            ab0 -= mq[1][0] * xy[4]; ab1 -= mq[1][1] * xy[5]; ab0 -= mq[1][2] * xy[6]; ab1 -= mq[1][3] * xy[7]; mq[1] = *(const LAS f32x4*)(Mg + 2972);
            ab0 -= mq[2][0] * xy[8]; ab1 -= mq[2][1] * xy[9]; ab0 -= mq[2][2] * xy[10]; ab1 -= mq[2][3] * xy[11]; mq[2] = *(const LAS f32x4*)(Mg + 2976);
            ab0 -= mq[3][0] * xy[12]; ab1 -= mq[3][1] * xy[13]; ab0 -= mq[3][2] * xy[14]; ab1 -= mq[3][3] * xy[15]; mq[3] = *(const LAS f32x4*)(Mg + 2980);
            ab0 -= mq[4][0] * xy[16]; ab1 -= mq[4][1] * xy[17]; ab0 -= mq[4][2] * xy[18]; ab1 -= mq[4][3] * xy[19]; mq[4] = *(const LAS f32x4*)(Mg + 2984);
            ab0 -= mq[5][0] * xy[20]; ab1 -= mq[5][1] * xy[21]; ab0 -= mq[5][2] * xy[22]; ab1 -= mq[5][3] * xy[23]; mq[5] = *(const LAS f32x4*)(Mg + 2988);
            ab0 -= mq[0][0] * xy[24]; ab1 -= mq[0][1] * xy[25]; ab0 -= mq[0][2] * xy[26]; ab1 -= mq[0][3] * xy[27]; mq[0] = *(const LAS f32x4*)(Mg + 3008);
            ab0 -= mq[1][0] * xy[28]; ab1 -= mq[1][1] * xy[29]; ab0 -= mq[1][2] * xy[30]; ab1 -= mq[1][3] * xy[31]; mq[1] = *(const LAS f32x4*)(Mg + 3012);
            ab0 -= mq[2][0] * xy[32]; ab1 -= mq[2][1] * xy[33]; ab0 -= mq[2][2] * xy[34]; ab1 -= mq[2][3] * xy[35]; mq[2] = *(const LAS f32x4*)(Mg + 3016);
            ab0 -= mq[3][0] * xy[36]; ab1 -= mq[3][1] * xy[37]; ab0 -= mq[3][2] * xy[38]; ab1 -= mq[3][3] * xy[39]; mq[3] = *(const LAS f32x4*)(Mg + 3020);
            ab0 -= mq[4][0] * xy[40]; ab1 -= mq[4][1] * xy[41]; ab0 -= mq[4][2] * xy[42]; ab1 -= mq[4][3] * xy[43]; mq[4] = *(const LAS f32x4*)(Mg + 3024);
            ab0 -= mq[5][0] * xy[44]; ab1 -= mq[5][1] * xy[45]; xy[46] = ab0 + ab1; up[5888] = xy[46][0]; wp[5888] = f2bf(-xy[46][1]); mq[5] = *(const LAS f32x4*)(Mg + 3028);
            { const float br = betg[47]; ab0 = (f32x2){bf2f(*(const LAS bf16_t*)(lg + P5_VS + 12784 + c * 2)) * br, bf2f(*(const LAS bf16_t*)(lg + P5_KS + 12784 + c * 2)) * br * __expf(decg[47])}; ab1 = (f32x2){0.f, 0.f}; } ab0 -= mq[0][0] * xy[0]; ab1 -= mq[0][1] * xy[1]; ab0 -= mq[0][2] * xy[2]; ab1 -= mq[0][3] * xy[3]; mq[0] = *(const LAS f32x4*)(Mg + 3032);
            ab0 -= mq[1][0] * xy[4]; ab1 -= mq[1][1] * xy[5]; ab0 -= mq[1][2] * xy[6]; ab1 -= mq[1][3] * xy[7]; mq[1] = *(const LAS f32x4*)(Mg + 3036);
            ab0 -= mq[2][0] * xy[8]; ab1 -= mq[2][1] * xy[9]; ab0 -= mq[2][2] * xy[10]; ab1 -= mq[2][3] * xy[11]; mq[2] = *(const LAS f32x4*)(Mg + 3040);
            ab0 -= mq[3][0] * xy[12]; ab1 -= mq[3][1] * xy[13]; ab0 -= mq[3][2] * xy[14]; ab1 -= mq[3][3] * xy[15]; mq[3] = *(const LAS f32x4*)(Mg + 3044);
            ab0 -= mq[4][0] * xy[16]; ab1 -= mq[4][1] * xy[17]; ab0 -= mq[4][2] * xy[18]; ab1 -= mq[4][3] * xy[19]; mq[4] = *(const LAS f32x4*)(Mg + 3048);
            ab0 -= mq[5][0] * xy[20]; ab1 -= mq[5][1] * xy[21]; ab0 -= mq[5][2] * xy[22]; ab1 -= mq[5][3] * xy[23]; mq[5] = *(const LAS f32x4*)(Mg + 3052);
            ab0 -= mq[0][0] * xy[24]; ab1 -= mq[0][1] * xy[25]; ab0 -= mq[0][2] * xy[26]; ab1 -= mq[0][3] * xy[27]; mq[0] = *(const LAS f32x4*)(Mg + 3072);
            ab0 -= mq[1][0] * xy[28]; ab1 -= mq[1][1] * xy[29]; ab0 -= mq[1][2] * xy[30]; ab1 -= mq[1][3] * xy[31]; mq[1] = *(const LAS f32x4*)(Mg + 3076);
            ab0 -= mq[2][0] * xy[32]; ab1 -= mq[2][1] * xy[33]; ab0 -= mq[2][2] * xy[34]; ab1 -= mq[2][3] * xy[35]; mq[2] = *(const LAS f32x4*)(Mg + 3080);
            ab0 -= mq[3][0] * xy[36]; ab1 -= mq[3][1] * xy[37]; ab0 -= mq[3][2] * xy[38]; ab1 -= mq[3][3] * xy[39]; mq[3] = *(const LAS f32x4*)(Mg + 3084);
            ab0 -= mq[4][0] * xy[40]; ab1 -= mq[4][1] * xy[41]; ab0 -= mq[4][2] * xy[42]; ab1 -= mq[4][3] * xy[43]; mq[4] = *(const LAS f32x4*)(Mg + 3088);
            ab0 -= mq[5][0] * xy[44]; ab1 -= mq[5][1] * xy[45]; ab0 -= mq[5][2] * xy[46]; xy[47] = ab0 + ab1; up[6016] = xy[47][0]; wp[6016] = f2bf(-xy[47][1]); mq[5] = *(const LAS f32x4*)(Mg + 3092);
            { const float br = betg[48]; ab0 = (f32x2){bf2f(*(const LAS bf16_t*)(lg + P5_VS + 13056 + c * 2)) * br, bf2f(*(const LAS bf16_t*)(lg + P5_KS + 13056 + c * 2)) * br * __expf(decg[48])}; ab1 = (f32x2){0.f, 0.f}; } ab0 -= mq[0][0] * xy[0]; ab1 -= mq[0][1] * xy[1]; ab0 -= mq[0][2] * xy[2]; ab1 -= mq[0][3] * xy[3]; mq[0] = *(const LAS f32x4*)(Mg + 3096);
            ab0 -= mq[1][0] * xy[4]; ab1 -= mq[1][1] * xy[5]; ab0 -= mq[1][2] * xy[6]; ab1 -= mq[1][3] * xy[7]; mq[1] = *(const LAS f32x4*)(Mg + 3100);
            ab0 -= mq[2][0] * xy[8]; ab1 -= mq[2][1] * xy[9]; ab0 -= mq[2][2] * xy[10]; ab1 -= mq[2][3] * xy[11]; mq[2] = *(const LAS f32x4*)(Mg + 3104);
            ab0 -= mq[3][0] * xy[12]; ab1 -= mq[3][1] * xy[13]; ab0 -= mq[3][2] * xy[14]; ab1 -= mq[3][3] * xy[15]; mq[3] = *(const LAS f32x4*)(Mg + 3108);
            ab0 -= mq[4][0] * xy[16]; ab1 -= mq[4][1] * xy[17]; ab0 -= mq[4][2] * xy[18]; ab1 -= mq[4][3] * xy[19]; mq[4] = *(const LAS f32x4*)(Mg + 3112);
            ab0 -= mq[5][0] * xy[20]; ab1 -= mq[5][1] * xy[21]; ab0 -= mq[5][2] * xy[22]; ab1 -= mq[5][3] * xy[23]; mq[5] = *(const LAS f32x4*)(Mg + 3116);
            ab0 -= mq[0][0] * xy[24]; ab1 -= mq[0][1] * xy[25]; ab0 -= mq[0][2] * xy[26]; ab1 -= mq[0][3] * xy[27]; mq[0] = *(const LAS f32x4*)(Mg + 3136);
            ab0 -= mq[1][0] * xy[28]; ab1 -= mq[1][1] * xy[29]; ab0 -= mq[1][2] * xy[30]; ab1 -= mq[1][3] * xy[31]; mq[1] = *(const LAS f32x4*)(Mg + 3140);
            ab0 -= mq[2][0] * xy[32]; ab1 -= mq[2][1] * xy[33]; ab0 -= mq[2][2] * xy[34]; ab1 -= mq[2][3] * xy[35]; mq[2] = *(const LAS f32x4*)(Mg + 3144);
            ab0 -= mq[3][0] * xy[36]; ab1 -= mq[3][1] * xy[37]; ab0 -= mq[3][2] * xy[38]; ab1 -= mq[3][3] * xy[39]; mq[3] = *(const LAS f32x4*)(Mg + 3148);
            ab0 -= mq[4][0] * xy[40]; ab1 -= mq[4][1] * xy[41]; ab0 -= mq[4][2] * xy[42]; ab1 -= mq[4][3] * xy[43]; mq[4] = *(const LAS f32x4*)(Mg + 3152);
            ab0 -= mq[5][0] * xy[44]; ab1 -= mq[5][1] * xy[45]; ab0 -= mq[5][2] * xy[46]; ab1 -= mq[5][3] * xy[47]; xy[48] = ab0 + ab1; up[6144] = xy[48][0]; wp[6144] = f2bf(-xy[48][1]); mq[5] = *(const LAS f32x4*)(Mg + 3156);
            { const float br = betg[49]; ab0 = (f32x2){bf2f(*(const LAS bf16_t*)(lg + P5_VS + 13328 + c * 2)) * br, bf2f(*(const LAS bf16_t*)(lg + P5_KS + 13328 + c * 2)) * br * __expf(decg[49])}; ab1 = (f32x2){0.f, 0.f}; } ab0 -= mq[0][0] * xy[0]; ab1 -= mq[0][1] * xy[1]; ab0 -= mq[0][2] * xy[2]; ab1 -= mq[0][3] * xy[3]; mq[0] = *(const LAS f32x4*)(Mg + 3160);
            ab0 -= mq[1][0] * xy[4]; ab1 -= mq[1][1] * xy[5]; ab0 -= mq[1][2] * xy[6]; ab1 -= mq[1][3] * xy[7]; mq[1] = *(const LAS f32x4*)(Mg + 3164);
            ab0 -= mq[2][0] * xy[8]; ab1 -= mq[2][1] * xy[9]; ab0 -= mq[2][2] * xy[10]; ab1 -= mq[2][3] * xy[11]; mq[2] = *(const LAS f32x4*)(Mg + 3168);
            ab0 -= mq[3][0] * xy[12]; ab1 -= mq[3][1] * xy[13]; ab0 -= mq[3][2] * xy[14]; ab1 -= mq[3][3] * xy[15]; mq[3] = *(const LAS f32x4*)(Mg + 3172);
            ab0 -= mq[4][0] * xy[16]; ab1 -= mq[4][1] * xy[17]; ab0 -= mq[4][2] * xy[18]; ab1 -= mq[4][3] * xy[19]; mq[4] = *(const LAS f32x4*)(Mg + 3176);
            ab0 -= mq[5][0] * xy[20]; ab1 -= mq[5][1] * xy[21]; ab0 -= mq[5][2] * xy[22]; ab1 -= mq[5][3] * xy[23]; mq[5] = *(const LAS f32x4*)(Mg + 3180);
            ab0 -= mq[0][0] * xy[24]; ab1 -= mq[0][1] * xy[25]; ab0 -= mq[0][2] * xy[26]; ab1 -= mq[0][3] * xy[27]; mq[0] = *(const LAS f32x4*)(Mg + 3184);
            ab0 -= mq[1][0] * xy[28]; ab1 -= mq[1][1] * xy[29]; ab0 -= mq[1][2] * xy[30]; ab1 -= mq[1][3] * xy[31]; mq[1] = *(const LAS f32x4*)(Mg + 3200);
            ab0 -= mq[2][0] * xy[32]; ab1 -= mq[2][1] * xy[33]; ab0 -= mq[2][2] * xy[34]; ab1 -= mq[2][3] * xy[35]; mq[2] = *(const LAS f32x4*)(Mg + 3204);
            ab0 -= mq[3][0] * xy[36]; ab1 -= mq[3][1] * xy[37]; ab0 -= mq[3][2] * xy[38]; ab1 -= mq[3][3] * xy[39]; mq[3] = *(const LAS f32x4*)(Mg + 3208);
            ab0 -= mq[4][0] * xy[40]; ab1 -= mq[4][1] * xy[41]; ab0 -= mq[4][2] * xy[42]; ab1 -= mq[4][3] * xy[43]; mq[4] = *(const LAS f32x4*)(Mg + 3212);
            ab0 -= mq[5][0] * xy[44]; ab1 -= mq[5][1] * xy[45]; ab0 -= mq[5][2] * xy[46]; ab1 -= mq[5][3] * xy[47]; mq[5] = *(const LAS f32x4*)(Mg + 3216);
            ab0 -= mq[0][0] * xy[48]; xy[49] = ab0 + ab1; up[6272] = xy[49][0]; wp[6272] = f2bf(-xy[49][1]); mq[0] = *(const LAS f32x4*)(Mg + 3220);
            { const float br = betg[50]; ab0 = (f32x2){bf2f(*(const LAS bf16_t*)(lg + P5_VS + 13600 + c * 2)) * br, bf2f(*(const LAS bf16_t*)(lg + P5_KS + 13600 + c * 2)) * br * __expf(decg[50])}; ab1 = (f32x2){0.f, 0.f}; } ab0 -= mq[1][0] * xy[0]; ab1 -= mq[1][1] * xy[1]; ab0 -= mq[1][2] * xy[2]; ab1 -= mq[1][3] * xy[3]; mq[1] = *(const LAS f32x4*)(Mg + 3224);
            ab0 -= mq[2][0] * xy[4]; ab1 -= mq[2][1] * xy[5]; ab0 -= mq[2][2] * xy[6]; ab1 -= mq[2][3] * xy[7]; mq[2] = *(const LAS f32x4*)(Mg + 3228);
            ab0 -= mq[3][0] * xy[8]; ab1 -= mq[3][1] * xy[9]; ab0 -= mq[3][2] * xy[10]; ab1 -= mq[3][3] * xy[11]; mq[3] = *(const LAS f32x4*)(Mg + 3232);
            ab0 -= mq[4][0] * xy[12]; ab1 -= mq[4][1] * xy[13]; ab0 -= mq[4][2] * xy[14]; ab1 -= mq[4][3] * xy[15]; mq[4] = *(const LAS f32x4*)(Mg + 3236);
            ab0 -= mq[5][0] * xy[16]; ab1 -= mq[5][1] * xy[17]; ab0 -= mq[5][2] * xy[18]; ab1 -= mq[5][3] * xy[19]; mq[5] = *(const LAS f32x4*)(Mg + 3240);
            ab0 -= mq[0][0] * xy[20]; ab1 -= mq[0][1] * xy[21]; ab0 -= mq[0][2] * xy[22]; ab1 -= mq[0][3] * xy[23]; mq[0] = *(const LAS f32x4*)(Mg + 3244);
            ab0 -= mq[1][0] * xy[24]; ab1 -= mq[1][1] * xy[25]; ab0 -= mq[1][2] * xy[26]; ab1 -= mq[1][3] * xy[27]; mq[1] = *(const LAS f32x4*)(Mg + 3248);
            ab0 -= mq[2][0] * xy[28]; ab1 -= mq[2][1] * xy[29]; ab0 -= mq[2][2] * xy[30]; ab1 -= mq[2][3] * xy[31]; mq[2] = *(const LAS f32x4*)(Mg + 3264);
            ab0 -= mq[3][0] * xy[32]; ab1 -= mq[3][1] * xy[33]; ab0 -= mq[3][2] * xy[34]; ab1 -= mq[3][3] * xy[35]; mq[3] = *(const LAS f32x4*)(Mg + 3268);
            ab0 -= mq[4][0] * xy[36]; ab1 -= mq[4][1] * xy[37]; ab0 -= mq[4][2] * xy[38]; ab1 -= mq[4][3] * xy[39]; mq[4] = *(const LAS f32x4*)(Mg + 3272);
            ab0 -= mq[5][0] * xy[40]; ab1 -= mq[5][1] * xy[41]; ab0 -= mq[5][2] * xy[42]; ab1 -= mq[5][3] * xy[43]; mq[5] = *(const LAS f32x4*)(Mg + 3276);
            ab0 -= mq[0][0] * xy[44]; ab1 -= mq[0][1] * xy[45]; ab0 -= mq[0][2] * xy[46]; ab1 -= mq[0][3] * xy[47]; mq[0] = *(const LAS f32x4*)(Mg + 3280);
            ab0 -= mq[1][0] * xy[48]; ab1 -= mq[1][1] * xy[49]; xy[50] = ab0 + ab1; up[6400] = xy[50][0]; wp[6400] = f2bf(-xy[50][1]); mq[1] = *(const LAS f32x4*)(Mg + 3284);
            { const float br = betg[51]; ab0 = (f32x2){bf2f(*(const LAS bf16_t*)(lg + P5_VS + 13872 + c * 2)) * br, bf2f(*(const LAS bf16_t*)(lg + P5_KS + 13872 + c * 2)) * br * __expf(decg[51])}; ab1 = (f32x2){0.f, 0.f}; } ab0 -= mq[2][0] * xy[0]; ab1 -= mq[2][1] * xy[1]; ab0 -= mq[2][2] * xy[2]; ab1 -= mq[2][3] * xy[3]; mq[2] = *(const LAS f32x4*)(Mg + 3288);
            ab0 -= mq[3][0] * xy[4]; ab1 -= mq[3][1] * xy[5]; ab0 -= mq[3][2] * xy[6]; ab1 -= mq[3][3] * xy[7]; mq[3] = *(const LAS f32x4*)(Mg + 3292);
            ab0 -= mq[4][0] * xy[8]; ab1 -= mq[4][1] * xy[9]; ab0 -= mq[4][2] * xy[10]; ab1 -= mq[4][3] * xy[11]; mq[4] = *(const LAS f32x4*)(Mg + 3296);
            ab0 -= mq[5][0] * xy[12]; ab1 -= mq[5][1] * xy[13]; ab0 -= mq[5][2] * xy[14]; ab1 -= mq[5][3] * xy[15]; mq[5] = *(const LAS f32x4*)(Mg + 3300);
            ab0 -= mq[0][0] * xy[16]; ab1 -= mq[0][1] * xy[17]; ab0 -= mq[0][2] * xy[18]; ab1 -= mq[0][3] * xy[19]; mq[0] = *(const LAS f32x4*)(Mg + 3304);
            ab0 -= mq[1][0] * xy[20]; ab1 -= mq[1][1] * xy[21]; ab0 -= mq[1][2] * xy[22]; ab1 -= mq[1][3] * xy[23]; mq[1] = *(const LAS f32x4*)(Mg + 3308);
            ab0 -= mq[2][0] * xy[24]; ab1 -= mq[2][1] * xy[25]; ab0 -= mq[2][2] * xy[26]; ab1 -= mq[2][3] * xy[27]; mq[2] = *(const LAS f32x4*)(Mg + 3312);
            ab0 -= mq[3][0] * xy[28]; ab1 -= mq[3][1] * xy[29]; ab0 -= mq[3][2] * xy[30]; ab1 -= mq[3][3] * xy[31]; mq[3] = *(const LAS f32x4*)(Mg + 3328);
            ab0 -= mq[4][0] * xy[32]; ab1 -= mq[4][1] * xy[33]; ab0 -= mq[4][2] * xy[34]; ab1 -= mq[4][3] * xy[35]; mq[4] = *(const LAS f32x4*)(Mg + 3332);
            ab0 -= mq[5][0] * xy[36]; ab1 -= mq[5][1] * xy[37]; ab0 -= mq[5][2] * xy[38]; ab1 -= mq[5][3] * xy[39]; mq[5] = *(const LAS f32x4*)(Mg + 3336);
            ab0 -= mq[0][0] * xy[40]; ab1 -= mq[0][1] * xy[41]; ab0 -= mq[0][2] * xy[42]; ab1 -= mq[0][3] * xy[43]; mq[0] = *(const LAS f32x4*)(Mg + 3340);
            ab0 -= mq[1][0] * xy[44]; ab1 -= mq[1][1] * xy[45]; ab0 -= mq[1][2] * xy[46]; ab1 -= mq[1][3] * xy[47]; mq[1] = *(const LAS f32x4*)(Mg + 3344);
            ab0 -= mq[2][0] * xy[48]; ab1 -= mq[2][1] * xy[49]; ab0 -= mq[2][2] * xy[50]; xy[51] = ab0 + ab1; up[6528] = xy[51][0]; wp[6528] = f2bf(-xy[51][1]); mq[2] = *(const LAS f32x4*)(Mg + 3348);
            { const float br = betg[52]; ab0 = (f32x2){bf2f(*(const LAS bf16_t*)(lg + P5_VS + 14144 + c * 2)) * br, bf2f(*(const LAS bf16_t*)(lg + P5_KS + 14144 + c * 2)) * br * __expf(decg[52])}; ab1 = (f32x2){0.f, 0.f}; } ab0 -= mq[3][0] * xy[0]; ab1 -= mq[3][1] * xy[1]; ab0 -= mq[3][2] * xy[2]; ab1 -= mq[3][3] * xy[3]; mq[3] = *(const LAS f32x4*)(Mg + 3352);
            ab0 -= mq[4][0] * xy[4]; ab1 -= mq[4][1] * xy[5]; ab0 -= mq[4][2] * xy[6]; ab1 -= mq[4][3] * xy[7]; mq[4] = *(const LAS f32x4*)(Mg + 3356);
            ab0 -= mq[5][0] * xy[8]; ab1 -= mq[5][1] * xy[9]; ab0 -= mq[5][2] * xy[10]; ab1 -= mq[5][3] * xy[11]; mq[5] = *(const LAS f32x4*)(Mg + 3360);
            ab0 -= mq[0][0] * xy[12]; ab1 -= mq[0][1] * xy[13]; ab0 -= mq[0][2] * xy[14]; ab1 -= mq[0][3] * xy[15]; mq[0] = *(const LAS f32x4*)(Mg + 3364);
            ab0 -= mq[1][0] * xy[16]; ab1 -= mq[1][1] * xy[17]; ab0 -= mq[1][2] * xy[18]; ab1 -= mq[1][3] * xy[19]; mq[1] = *(const LAS f32x4*)(Mg + 3368);
            ab0 -= mq[2][0] * xy[20]; ab1 -= mq[2][1] * xy[21]; ab0 -= mq[2][2] * xy[22]; ab1 -= mq[2][3] * xy[23]; mq[2] = *(const LAS f32x4*)(Mg + 3372);
            ab0 -= mq[3][0] * xy[24]; ab1 -= mq[3][1] * xy[25]; ab0 -= mq[3][2] * xy[26]; ab1 -= mq[3][3] * xy[27]; mq[3] = *(const LAS f32x4*)(Mg + 3376);
            ab0 -= mq[4][0] * xy[28]; ab1 -= mq[4][1] * xy[29]; ab0 -= mq[4][2] * xy[30]; ab1 -= mq[4][3] * xy[31]; mq[4] = *(const LAS f32x4*)(Mg + 3392);
            ab0 -= mq[5][0] * xy[32]; ab1 -= mq[5][1] * xy[33]; ab0 -= mq[5][2] * xy[34]; ab1 -= mq[5][3] * xy[35]; mq[5] = *(const LAS f32x4*)(Mg + 3396);
            ab0 -= mq[0][0] * xy[36]; ab1 -= mq[0][1] * xy[37]; ab0 -= mq[0][2] * xy[38]; ab1 -= mq[0][3] * xy[39]; mq[0] = *(const LAS f32x4*)(Mg + 3400);
            ab0 -= mq[1][0] * xy[40]; ab1 -= mq[1][1] * xy[41]; ab0 -= mq[1][2] * xy[42]; ab1 -= mq[1][3] * xy[43]; mq[1] = *(const LAS f32x4*)(Mg + 3404);
            ab0 -= mq[2][0] * xy[44]; ab1 -= mq[2][1] * xy[45]; ab0 -= mq[2][2] * xy[46]; ab1 -= mq[2][3] * xy[47]; mq[2] = *(const LAS f32x4*)(Mg + 3408);
            ab0 -= mq[3][0] * xy[48]; ab1 -= mq[3][1] * xy[49]; ab0 -= mq[3][2] * xy[50]; ab1 -= mq[3][3] * xy[51]; xy[52] = ab0 + ab1; up[6656] = xy[52][0]; wp[6656] = f2bf(-xy[52][1]); mq[3] = *(const LAS f32x4*)(Mg + 3412);
            { const float br = betg[53]; ab0 = (f32x2){bf2f(*(const LAS bf16_t*)(lg + P5_VS + 14416 + c * 2)) * br, bf2f(*(const LAS bf16_t*)(lg + P5_KS + 14416 + c * 2)) * br * __expf(decg[53])}; ab1 = (f32x2){0.f, 0.f}; } ab0 -= mq[4][0] * xy[0]; ab1 -= mq[4][1] * xy[1]; ab0 -= mq[4][2] * xy[2]; ab1 -= mq[4][3] * xy[3]; mq[4] = *(const LAS f32x4*)(Mg + 3416);
            ab0 -= mq[5][0] * xy[4]; ab1 -= mq[5][1] * xy[5]; ab0 -= mq[5][2] * xy[6]; ab1 -= mq[5][3] * xy[7]; mq[5] = *(const LAS f32x4*)(Mg + 3420);
            ab0 -= mq[0][0] * xy[8]; ab1 -= mq[0][1] * xy[9]; ab0 -= mq[0][2] * xy[10]; ab1 -= mq[0][3] * xy[11]; mq[0] = *(const LAS f32x4*)(Mg + 3424);
            ab0 -= mq[1][0] * xy[12]; ab1 -= mq[1][1] * xy[13]; ab0 -= mq[1][2] * xy[14]; ab1 -= mq[1][3] * xy[15]; mq[1] = *(const LAS f32x4*)(Mg + 3428);
            ab0 -= mq[2][0] * xy[16]; ab1 -= mq[2][1] * xy[17]; ab0 -= mq[2][2] * xy[18]; ab1 -= mq[2][3] * xy[19]; mq[2] = *(const LAS f32x4*)(Mg + 3432);
            ab0 -= mq[3][0] * xy[20]; ab1 -= mq[3][1] * xy[21]; ab0 -= mq[3][2] * xy[22]; ab1 -= mq[3][3] * xy[23]; mq[3] = *(const LAS f32x4*)(Mg + 3436);
            ab0 -= mq[4][0] * xy[24]; ab1 -= mq[4][1] * xy[25]; ab0 -= mq[4][2] * xy[26]; ab1 -= mq[4][3] * xy[27]; mq[4] = *(const LAS f32x4*)(Mg + 3440);
            ab0 -= mq[5][0] * xy[28]; ab1 -= mq[5][1] * xy[29]; ab0 -= mq[5][2] * xy[30]; ab1 -= mq[5][3] * xy[31]; mq[5] = *(const LAS f32x4*)(Mg + 3444);
            ab0 -= mq[0][0] * xy[32]; ab1 -= mq[0][1] * xy[33]; ab0 -= mq[0][2] * xy[34]; ab1 -= mq[0][3] * xy[35]; mq[0] = *(const LAS f32x4*)(Mg + 3456);
            ab0 -= mq[1][0] * xy[36]; ab1 -= mq[1][1] * xy[37]; ab0 -= mq[1][2] * xy[38]; ab1 -= mq[1][3] * xy[39]; mq[1] = *(const LAS f32x4*)(Mg + 3460);
            ab0 -= mq[2][0] * xy[40]; ab1 -= mq[2][1] * xy[41]; ab0 -= mq[2][2] * xy[42]; ab1 -= mq[2][3] * xy[43]; mq[2] = *(const LAS f32x4*)(Mg + 3464);
            ab0 -= mq[3][0] * xy[44]; ab1 -= mq[3][1] * xy[45]; ab0 -= mq[3][2] * xy[46]; ab1 -= mq[3][3] * xy[47]; mq[3] = *(const LAS f32x4*)(Mg + 3468);
            ab0 -= mq[4][0] * xy[48]; ab1 -= mq[4][1] * xy[49]; ab0 -= mq[4][2] * xy[50]; ab1 -= mq[4][3] * xy[51]; mq[4] = *(const LAS f32x4*)(Mg + 3472);
            ab0 -= mq[5][0] * xy[52]; xy[53] = ab0 + ab1; up[6784] = xy[53][0]; wp[6784] = f2bf(-xy[53][1]); mq[5] = *(const LAS f32x4*)(Mg + 3476);
            { const float br = betg[54]; ab0 = (f32x2){bf2f(*(const LAS bf16_t*)(lg + P5_VS + 14688 + c * 2)) * br, bf2f(*(const LAS bf16_t*)(lg + P5_KS + 14688 + c * 2)) * br * __expf(decg[54])}; ab1 = (f32x2){0.f, 0.f}; } ab0 -= mq[0][0] * xy[0]; ab1 -= mq[0][1] * xy[1]; ab0 -= mq[0][2] * xy[2]; ab1 -= mq[0][3] * xy[3]; mq[0] = *(const LAS f32x4*)(Mg + 3480);
            ab0 -= mq[1][0] * xy[4]; ab1 -= mq[1][1] * xy[5]; ab0 -= mq[1][2] * xy[6]; ab1 -= mq[1][3] * xy[7]; mq[1] = *(const LAS f32x4*)(Mg + 3484);
            ab0 -= mq[2][0] * xy[8]; ab1 -= mq[2][1] * xy[9]; ab0 -= mq[2][2] * xy[10]; ab1 -= mq[2][3] * xy[11]; mq[2] = *(const LAS f32x4*)(Mg + 3488);
            ab0 -= mq[3][0] * xy[12]; ab1 -= mq[3][1] * xy[13]; ab0 -= mq[3][2] * xy[14]; ab1 -= mq[3][3] * xy[15]; mq[3] = *(const LAS f32x4*)(Mg + 3492);
            ab0 -= mq[4][0] * xy[16]; ab1 -= mq[4][1] * xy[17]; ab0 -= mq[4][2] * xy[18]; ab1 -= mq[4][3] * xy[19]; mq[4] = *(const LAS f32x4*)(Mg + 3496);
            ab0 -= mq[5][0] * xy[20]; ab1 -= mq[5][1] * xy[21]; ab0 -= mq[5][2] * xy[22]; ab1 -= mq[5][3] * xy[23]; mq[5] = *(const LAS f32x4*)(Mg + 3500);
            ab0 -= mq[0][0] * xy[24]; ab1 -= mq[0][1] * xy[25]; ab0 -= mq[0][2] * xy[26]; ab1 -= mq[0][3] * xy[27]; mq[0] = *(const LAS f32x4*)(Mg + 3504);
            ab0 -= mq[1][0] * xy[28]; ab1 -= mq[1][1] * xy[29]; ab0 -= mq[1][2] * xy[30]; ab1 -= mq[1][3] * xy[31]; mq[1] = *(const LAS f32x4*)(Mg + 3508);
            ab0 -= mq[2][0] * xy[32]; ab1 -= mq[2][1] * xy[33]; ab0 -= mq[2][2] * xy[34]; ab1 -= mq[2][3] * xy[35]; mq[2] = *(const LAS f32x4*)(Mg + 3520);
            ab0 -= mq[3][0] * xy[36]; ab1 -= mq[3][1] * xy[37]; ab0 -= mq[3][2] * xy[38]; ab1 -= mq[3][3] * xy[39]; mq[3] = *(const LAS f32x4*)(Mg + 3524);
            ab0 -= mq[4][0] * xy[40]; ab1 -= mq[4][1] * xy[41]; ab0 -= mq[4][2] * xy[42]; ab1 -= mq[4][3] * xy[43]; mq[4] = *(const LAS f32x4*)(Mg + 3528);
            ab0 -= mq[5][0] * xy[44]; ab1 -= mq[5][1] * xy[45]; ab0 -= mq[5][2] * xy[46]; ab1 -= mq[5][3] * xy[47]; mq[5] = *(const LAS f32x4*)(Mg + 3532);
            ab0 -= mq[0][0] * xy[48]; ab1 -= mq[0][1] * xy[49]; ab0 -= mq[0][2] * xy[50]; ab1 -= mq[0][3] * xy[51]; mq[0] = *(const LAS f32x4*)(Mg + 3536);
            ab0 -= mq[1][0] * xy[52]; ab1 -= mq[1][1] * xy[53]; xy[54] = ab0 + ab1; up[6912] = xy[54][0]; wp[6912] = f2bf(-xy[54][1]); mq[1] = *(const LAS f32x4*)(Mg + 3540);
            { const float br = betg[55]; ab0 = (f32x2){bf2f(*(const LAS bf16_t*)(lg + P5_VS + 14960 + c * 2)) * br, bf2f(*(const LAS bf16_t*)(lg + P5_KS + 14960 + c * 2)) * br * __expf(decg[55])}; ab1 = (f32x2){0.f, 0.f}; } ab0 -= mq[2][0] * xy[0]; ab1 -= mq[2][1] * xy[1]; ab0 -= mq[2][2] * xy[2]; ab1 -= mq[2][3] * xy[3]; mq[2] = *(const LAS f32x4*)(Mg + 3544);
            ab0 -= mq[3][0] * xy[4]; ab1 -= mq[3][1] * xy[5]; ab0 -= mq[3][2] * xy[6]; ab1 -= mq[3][3] * xy[7]; mq[3] = *(const LAS f32x4*)(Mg + 3548);
            ab0 -= mq[4][0] * xy[8]; ab1 -= mq[4][1] * xy[9]; ab0 -= mq[4][2] * xy[10]; ab1 -= mq[4][3] * xy[11]; mq[4] = *(const LAS f32x4*)(Mg + 3552);
            ab0 -= mq[5][0] * xy[12]; ab1 -= mq[5][1] * xy[13]; ab0 -= mq[5][2] * xy[14]; ab1 -= mq[5][3] * xy[15]; mq[5] = *(const LAS f32x4*)(Mg + 3556);
            ab0 -= mq[0][0] * xy[16]; ab1 -= mq[0][1] * xy[17]; ab0 -= mq[0][2] * xy[18]; ab1 -= mq[0][3] * xy[19]; mq[0] = *(const LAS f32x4*)(Mg + 3560);
            ab0 -= mq[1][0] * xy[20]; ab1 -= mq[1][1] * xy[21]; ab0 -= mq[1][2] * xy[22]; ab1 -= mq[1][3] * xy[23]; mq[1] = *(const LAS f32x4*)(Mg + 3564);
            ab0 -= mq[2][0] * xy[24]; ab1 -= mq[2][1] * xy[25]; ab0 -= mq[2][2] * xy[26]; ab1 -= mq[2][3] * xy[27]; mq[2] = *(const LAS f32x4*)(Mg + 3568);
            ab0 -= mq[3][0] * xy[28]; ab1 -= mq[3][1] * xy[29]; ab0 -= mq[3][2] * xy[30]; ab1 -= mq[3][3] * xy[31]; mq[3] = *(const LAS f32x4*)(Mg + 3572);
            ab0 -= mq[4][0] * xy[32]; ab1 -= mq[4][1] * xy[33]; ab0 -= mq[4][2] * xy[34]; ab1 -= mq[4][3] * xy[35]; mq[4] = *(const LAS f32x4*)(Mg + 3584);
            ab0 -= mq[5][0] * xy[36]; ab1 -= mq[5][1] * xy[37]; ab0 -= mq[5][2] * xy[38]; ab1 -= mq[5][3] * xy[39]; mq[5] = *(const LAS f32x4*)(Mg + 3588);
            ab0 -= mq[0][0] * xy[40]; ab1 -= mq[0][1] * xy[41]; ab0 -= mq[0][2] * xy[42]; ab1 -= mq[0][3] * xy[43]; mq[0] = *(const LAS f32x4*)(Mg + 3592);
            ab0 -= mq[1][0] * xy[44]; ab1 -= mq[1][1] * xy[45]; ab0 -= mq[1][2] * xy[46]; ab1 -= mq[1][3] * xy[47]; mq[1] = *(const LAS f32x4*)(Mg + 3596);
            ab0 -= mq[2][0] * xy[48]; ab1 -= mq[2][1] * xy[49]; ab0 -= mq[2][2] * xy[50]; ab1 -= mq[2][3] * xy[51]; mq[2] = *(const LAS f32x4*)(Mg + 3600);
            ab0 -= mq[3][0] * xy[52]; ab1 -= mq[3][1] * xy[53]; ab0 -= mq[3][2] * xy[54]; xy[55] = ab0 + ab1; up[7040] = xy[55][0]; wp[7040] = f2bf(-xy[55][1]); mq[3] = *(const LAS f32x4*)(Mg + 3604);
            { const float br = betg[56]; ab0 = (f32x2){bf2f(*(const LAS bf16_t*)(lg + P5_VS + 15232 + c * 2)) * br, bf2f(*(const LAS bf16_t*)(lg + P5_KS + 15232 + c * 2)) * br * __expf(decg[56])}; ab1 = (f32x2){0.f, 0.f}; } ab0 -= mq[4][0] * xy[0]; ab1 -= mq[4][1] * xy[1]; ab0 -= mq[4][2] * xy[2]; ab1 -= mq[4][3] * xy[3]; mq[4] = *(const LAS f32x4*)(Mg + 3608);
            ab0 -= mq[5][0] * xy[4]; ab1 -= mq[5][1] * xy[5]; ab0 -= mq[5][2] * xy[6]; ab1 -= mq[5][3] * xy[7]; mq[5] = *(const LAS f32x4*)(Mg + 3612);
            ab0 -= mq[0][0] * xy[8]; ab1 -= mq[0][1] * xy[9]; ab0 -= mq[0][2] * xy[10]; ab1 -= mq[0][3] * xy[11]; mq[0] = *(const LAS f32x4*)(Mg + 3616);
            ab0 -= mq[1][0] * xy[12]; ab1 -= mq[1][1] * xy[13]; ab0 -= mq[1][2] * xy[14]; ab1 -= mq[1][3] * xy[15]; mq[1] = *(const LAS f32x4*)(Mg + 3620);
            ab0 -= mq[2][0] * xy[16]; ab1 -= mq[2][1] * xy[17]; ab0 -= mq[2][2] * xy[18]; ab1 -= mq[2][3] * xy[19]; mq[2] = *(const LAS f32x4*)(Mg + 3624);
            ab0 -= mq[3][0] * xy[20]; ab1 -= mq[3][1] * xy[21]; ab0 -= mq[3][2] * xy[22]; ab1 -= mq[3][3] * xy[23]; mq[3] = *(const LAS f32x4*)(Mg + 3628);
            ab0 -= mq[4][0] * xy[24]; ab1 -= mq[4][1] * xy[25]; ab0 -= mq[4][2] * xy[26]; ab1 -= mq[4][3] * xy[27]; mq[4] = *(const LAS f32x4*)(Mg + 3632);
            ab0 -= mq[5][0] * xy[28]; ab1 -= mq[5][1] * xy[29]; ab0 -= mq[5][2] * xy[30]; ab1 -= mq[5][3] * xy[31]; mq[5] = *(const LAS f32x4*)(Mg + 3636);
            ab0 -= mq[0][0] * xy[32]; ab1 -= mq[0][1] * xy[33]; ab0 -= mq[0][2] * xy[34]; ab1 -= mq[0][3] * xy[35]; mq[0] = *(const LAS f32x4*)(Mg + 3648);
            ab0 -= mq[1][0] * xy[36]; ab1 -= mq[1][1] * xy[37]; ab0 -= mq[1][2] * xy[38]; ab1 -= mq[1][3] * xy[39]; mq[1] = *(const LAS f32x4*)(Mg + 3652);
            ab0 -= mq[2][0] * xy[40]; ab1 -= mq[2][1] * xy[41]; ab0 -= mq[2][2] * xy[42]; ab1 -= mq[2][3] * xy[43]; mq[2] = *(const LAS f32x4*)(Mg + 3656);
            ab0 -= mq[3][0] * xy[44]; ab1 -= mq[3][1] * xy[45]; ab0 -= mq[3][2] * xy[46]; ab1 -= mq[3][3] * xy[47]; mq[3] = *(const LAS f32x4*)(Mg + 3660);
            ab0 -= mq[4][0] * xy[48]; ab1 -= mq[4][1] * xy[49]; ab0 -= mq[4][2] * xy[50]; ab1 -= mq[4][3] * xy[51]; mq[4] = *(const LAS f32x4*)(Mg + 3664);
            ab0 -= mq[5][0] * xy[52]; ab1 -= mq[5][1] * xy[53]; ab0 -= mq[5][2] * xy[54]; ab1 -= mq[5][3] * xy[55]; xy[56] = ab0 + ab1; up[7168] = xy[56][0]; wp[7168] = f2bf(-xy[56][1]); mq[5] = *(const LAS f32x4*)(Mg + 3668);
            { const float br = betg[57]; ab0 = (f32x2){bf2f(*(const LAS bf16_t*)(lg + P5_VS + 15504 + c * 2)) * br, bf2f(*(const LAS bf16_t*)(lg + P5_KS + 15504 + c * 2)) * br * __expf(decg[57])}; ab1 = (f32x2){0.f, 0.f}; } ab0 -= mq[0][0] * xy[0]; ab1 -= mq[0][1] * xy[1]; ab0 -= mq[0][2] * xy[2]; ab1 -= mq[0][3] * xy[3]; mq[0] = *(const LAS f32x4*)(Mg + 3672);
            ab0 -= mq[1][0] * xy[4]; ab1 -= mq[1][1] * xy[5]; ab0 -= mq[1][2] * xy[6]; ab1 -= mq[1][3] * xy[7]; mq[1] = *(const LAS f32x4*)(Mg + 3676);
            ab0 -= mq[2][0] * xy[8]; ab1 -= mq[2][1] * xy[9]; ab0 -= mq[2][2] * xy[10]; ab1 -= mq[2][3] * xy[11]; mq[2] = *(const LAS f32x4*)(Mg + 3680);
            ab0 -= mq[3][0] * xy[12]; ab1 -= mq[3][1] * xy[13]; ab0 -= mq[3][2] * xy[14]; ab1 -= mq[3][3] * xy[15]; mq[3] = *(const LAS f32x4*)(Mg + 3684);
            ab0 -= mq[4][0] * xy[16]; ab1 -= mq[4][1] * xy[17]; ab0 -= mq[4][2] * xy[18]; ab1 -= mq[4][3] * xy[19]; mq[4] = *(const LAS f32x4*)(Mg + 3688);
            ab0 -= mq[5][0] * xy[20]; ab1 -= mq[5][1] * xy[21]; ab0 -= mq[5][2] * xy[22]; ab1 -= mq[5][3] * xy[23]; mq[5] = *(const LAS f32x4*)(Mg + 3692);
            ab0 -= mq[0][0] * xy[24]; ab1 -= mq[0][1] * xy[25]; ab0 -= mq[0][2] * xy[26]; ab1 -= mq[0][3] * xy[27]; mq[0] = *(const LAS f32x4*)(Mg + 3696);
            ab0 -= mq[1][0] * xy[28]; ab1 -= mq[1][1] * xy[29]; ab0 -= mq[1][2] * xy[30]; ab1 -= mq[1][3] * xy[31]; mq[1] = *(const LAS f32x4*)(Mg + 3700);
            ab0 -= mq[2][0] * xy[32]; ab1 -= mq[2][1] * xy[33]; ab0 -= mq[2][2] * xy[34]; ab1 -= mq[2][3] * xy[35]; mq[2] = *(const LAS f32x4*)(Mg + 3704);
            ab0 -= mq[3][0] * xy[36]; ab1 -= mq[3][1] * xy[37]; ab0 -= mq[3][2] * xy[38]; ab1 -= mq[3][3] * xy[39]; mq[3] = *(const LAS f32x4*)(Mg + 3712);
            ab0 -= mq[4][0] * xy[40]; ab1 -= mq[4][1] * xy[41]; ab0 -= mq[4][2] * xy[42]; ab1 -= mq[4][3] * xy[43]; mq[4] = *(const LAS f32x4*)(Mg + 3716);
            ab0 -= mq[5][0] * xy[44]; ab1 -= mq[5][1] * xy[45]; ab0 -= mq[5][2] * xy[46]; ab1 -= mq[5][3] * xy[47]; mq[5] = *(const LAS f32x4*)(Mg + 3720);
            ab0 -= mq[0][0] * xy[48]; ab1 -= mq[0][1] * xy[49]; ab0 -= mq[0][2] * xy[50]; ab1 -= mq[0][3] * xy[51]; mq[0] = *(const LAS f32x4*)(Mg + 3724);
            ab0 -= mq[1][0] * xy[52]; ab1 -= mq[1][1] * xy[53]; ab0 -= mq[1][2] * xy[54]; ab1 -= mq[1][3] * xy[55]; mq[1] = *(const LAS f32x4*)(Mg + 3728);
            ab0 -= mq[2][0] * xy[56]; xy[57] = ab0 + ab1; up[7296] = xy[57][0]; wp[7296] = f2bf(-xy[57][1]); mq[2] = *(const LAS f32x4*)(Mg + 3732);
            { const float br = betg[58]; ab0 = (f32x2){bf2f(*(const LAS bf16_t*)(lg + P5_VS + 15776 + c * 2)) * br, bf2f(*(const LAS bf16_t*)(lg + P5_KS + 15776 + c * 2)) * br * __expf(decg[58])}; ab1 = (f32x2){0.f, 0.f}; } ab0 -= mq[3][0] * xy[0]; ab1 -= mq[3][1] * xy[1]; ab0 -= mq[3][2] * xy[2]; ab1 -= mq[3][3] * xy[3]; mq[3] = *(const LAS f32x4*)(Mg + 3736);
            ab0 -= mq[4][0] * xy[4]; ab1 -= mq[4][1] * xy[5]; ab0 -= mq[4][2] * xy[6]; ab1 -= mq[4][3] * xy[7]; mq[4] = *(const LAS f32x4*)(Mg + 3740);
            ab0 -= mq[5][0] * xy[8]; ab1 -= mq[5][1] * xy[9]; ab0 -= mq[5][2] * xy[10]; ab1 -= mq[5][3] * xy[11]; mq[5] = *(const LAS f32x4*)(Mg + 3744);
            ab0 -= mq[0][0] * xy[12]; ab1 -= mq[0][1] * xy[13]; ab0 -= mq[0][2] * xy[14]; ab1 -= mq[0][3] * xy[15]; mq[0] = *(const LAS f32x4*)(Mg + 3748);
            ab0 -= mq[1][0] * xy[16]; ab1 -= mq[1][1] * xy[17]; ab0 -= mq[1][2] * xy[18]; ab1 -= mq[1][3] * xy[19]; mq[1] = *(const LAS f32x4*)(Mg + 3752);
            ab0 -= mq[2][0] * xy[20]; ab1 -= mq[2][1] * xy[21]; ab0 -= mq[2][2] * xy[22]; ab1 -= mq[2][3] * xy[23]; mq[2] = *(const LAS f32x4*)(Mg + 3756);
            ab0 -= mq[3][0] * xy[24]; ab1 -= mq[3][1] * xy[25]; ab0 -= mq[3][2] * xy[26]; ab1 -= mq[3][3] * xy[27]; mq[3] = *(const LAS f32x4*)(Mg + 3760);
            ab0 -= mq[4][0] * xy[28]; ab1 -= mq[4][1] * xy[29]; ab0 -= mq[4][2] * xy[30]; ab1 -= mq[4][3] * xy[31]; mq[4] = *(const LAS f32x4*)(Mg + 3764);
            ab0 -= mq[5][0] * xy[32]; ab1 -= mq[5][1] * xy[33]; ab0 -= mq[5][2] * xy[34]; ab1 -= mq[5][3] * xy[35]; mq[5] = *(const LAS f32x4*)(Mg + 3768);
            ab0 -= mq[0][0] * xy[36]; ab1 -= mq[0][1] * xy[37]; ab0 -= mq[0][2] * xy[38]; ab1 -= mq[0][3] * xy[39]; mq[0] = *(const LAS f32x4*)(Mg + 3776);
            ab0 -= mq[1][0] * xy[40]; ab1 -= mq[1][1] * xy[41]; ab0 -= mq[1][2] * xy[42]; ab1 -= mq[1][3] * xy[43]; mq[1] = *(const LAS f32x4*)(Mg + 3780);
            ab0 -= mq[2][0] * xy[44]; ab1 -= mq[2][1] * xy[45]; ab0 -= mq[2][2] * xy[46]; ab1 -= mq[2][3] * xy[47]; mq[2] = *(const LAS f32x4*)(Mg + 3784);
            ab0 -= mq[3][0] * xy[48]; ab1 -= mq[3][1] * xy[49]; ab0 -= mq[3][2] * xy[50]; ab1 -= mq[3][3] * xy[51]; mq[3] = *(const LAS f32x4*)(Mg + 3788);
            ab0 -= mq[4][0] * xy[52]; ab1 -= mq[4][1] * xy[53]; ab0 -= mq[4][2] * xy[54]; ab1 -= mq[4][3] * xy[55]; mq[4] = *(const LAS f32x4*)(Mg + 3792);
            ab0 -= mq[5][0] * xy[56]; ab1 -= mq[5][1] * xy[57]; xy[58] = ab0 + ab1; up[7424] = xy[58][0]; wp[7424] = f2bf(-xy[58][1]); mq[5] = *(const LAS f32x4*)(Mg + 3796);
            { const float br = betg[59]; ab0 = (f32x2){bf2f(*(const LAS bf16_t*)(lg + P5_VS + 16048 + c * 2)) * br, bf2f(*(const LAS bf16_t*)(lg + P5_KS + 16048 + c * 2)) * br * __expf(decg[59])}; ab1 = (f32x2){0.f, 0.f}; } ab0 -= mq[0][0] * xy[0]; ab1 -= mq[0][1] * xy[1]; ab0 -= mq[0][2] * xy[2]; ab1 -= mq[0][3] * xy[3]; mq[0] = *(const LAS f32x4*)(Mg + 3800);
            ab0 -= mq[1][0] * xy[4]; ab1 -= mq[1][1] * xy[5]; ab0 -= mq[1][2] * xy[6]; ab1 -= mq[1][3] * xy[7]; mq[1] = *(const LAS f32x4*)(Mg + 3804);
            ab0 -= mq[2][0] * xy[8]; ab1 -= mq[2][1] * xy[9]; ab0 -= mq[2][2] * xy[10]; ab1 -= mq[2][3] * xy[11]; mq[2] = *(const LAS f32x4*)(Mg + 3808);
            ab0 -= mq[3][0] * xy[12]; ab1 -= mq[3][1] * xy[13]; ab0 -= mq[3][2] * xy[14]; ab1 -= mq[3][3] * xy[15]; mq[3] = *(const LAS f32x4*)(Mg + 3812);
            ab0 -= mq[4][0] * xy[16]; ab1 -= mq[4][1] * xy[17]; ab0 -= mq[4][2] * xy[18]; ab1 -= mq[4][3] * xy[19]; mq[4] = *(const LAS f32x4*)(Mg + 3816);
            ab0 -= mq[5][0] * xy[20]; ab1 -= mq[5][1] * xy[21]; ab0 -= mq[5][2] * xy[22]; ab1 -= mq[5][3] * xy[23]; mq[5] = *(const LAS f32x4*)(Mg + 3820);
            ab0 -= mq[0][0] * xy[24]; ab1 -= mq[0][1] * xy[25]; ab0 -= mq[0][2] * xy[26]; ab1 -= mq[0][3] * xy[27]; mq[0] = *(const LAS f32x4*)(Mg + 3824);
            ab0 -= mq[1][0] * xy[28]; ab1 -= mq[1][1] * xy[29]; ab0 -= mq[1][2] * xy[30]; ab1 -= mq[1][3] * xy[31]; mq[1] = *(const LAS f32x4*)(Mg + 3828);
            ab0 -= mq[2][0] * xy[32]; ab1 -= mq[2][1] * xy[33]; ab0 -= mq[2][2] * xy[34]; ab1 -= mq[2][3] * xy[35]; mq[2] = *(const LAS f32x4*)(Mg + 3832);
            ab0 -= mq[3][0] * xy[36]; ab1 -= mq[3][1] * xy[37]; ab0 -= mq[3][2] * xy[38]; ab1 -= mq[3][3] * xy[39]; mq[3] = *(const LAS f32x4*)(Mg + 3840);
            ab0 -= mq[4][0] * xy[40]; ab1 -= mq[4][1] * xy[41]; ab0 -= mq[4][2] * xy[42]; ab1 -= mq[4][3] * xy[43]; mq[4] = *(const LAS f32x4*)(Mg + 3844);
            ab0 -= mq[5][0] * xy[44]; ab1 -= mq[5][1] * xy[45]; ab0 -= mq[5][2] * xy[46]; ab1 -= mq[5][3] * xy[47]; mq[5] = *(const LAS f32x4*)(Mg + 3848);
            ab0 -= mq[0][0] * xy[48]; ab1 -= mq[0][1] * xy[49]; ab0 -= mq[0][2] * xy[50]; ab1 -= mq[0][3] * xy[51]; mq[0] = *(const LAS f32x4*)(Mg + 3852);
            ab0 -= mq[1][0] * xy[52]; ab1 -= mq[1][1] * xy[53]; ab0 -= mq[1][2] * xy[54]; ab1 -= mq[1][3] * xy[55]; mq[1] = *(const LAS f32x4*)(Mg + 3856);
            ab0 -= mq[2][0] * xy[56]; ab1 -= mq[2][1] * xy[57]; ab0 -= mq[2][2] * xy[58]; xy[59] = ab0 + ab1; up[7552] = xy[59][0]; wp[7552] = f2bf(-xy[59][1]); mq[2] = *(const LAS f32x4*)(Mg + 3860);
            { const float br = betg[60]; ab0 = (f32x2){bf2f(*(const LAS bf16_t*)(lg + P5_VS + 16320 + c * 2)) * br, bf2f(*(const LAS bf16_t*)(lg + P5_KS + 16320 + c * 2)) * br * __expf(decg[60])}; ab1 = (f32x2){0.f, 0.f}; } ab0 -= mq[3][0] * xy[0]; ab1 -= mq[3][1] * xy[1]; ab0 -= mq[3][2] * xy[2]; ab1 -= mq[3][3] * xy[3]; mq[3] = *(const LAS f32x4*)(Mg + 3864);
            ab0 -= mq[4][0] * xy[4]; ab1 -= mq[4][1] * xy[5]; ab0 -= mq[4][2] * xy[6]; ab1 -= mq[4][3] * xy[7]; mq[4] = *(const LAS f32x4*)(Mg + 3868);
            ab0 -= mq[5][0] * xy[8]; ab1 -= mq[5][1] * xy[9]; ab0 -= mq[5][2] * xy[10]; ab1 -= mq[5][3] * xy[11]; mq[5] = *(const LAS f32x4*)(Mg + 3872);
            ab0 -= mq[0][0] * xy[12]; ab1 -= mq[0][1] * xy[13]; ab0 -= mq[0][2] * xy[14]; ab1 -= mq[0][3] * xy[15]; mq[0] = *(const LAS f32x4*)(Mg + 3876);
            ab0 -= mq[1][0] * xy[16]; ab1 -= mq[1][1] * xy[17]; ab0 -= mq[1][2] * xy[18]; ab1 -= mq[1][3] * xy[19]; mq[1] = *(const LAS f32x4*)(Mg + 3880);
            ab0 -= mq[2][0] * xy[20]; ab1 -= mq[2][1] * xy[21]; ab0 -= mq[2][2] * xy[22]; ab1 -= mq[2][3] * xy[23]; mq[2] = *(const LAS f32x4*)(Mg + 3884);
            ab0 -= mq[3][0] * xy[24]; ab1 -= mq[3][1] * xy[25]; ab0 -= mq[3][2] * xy[26]; ab1 -= mq[3][3] * xy[27]; mq[3] = *(const LAS f32x4*)(Mg + 3888);
            ab0 -= mq[4][0] * xy[28]; ab1 -= mq[4][1] * xy[29]; ab0 -= mq[4][2] * xy[30]; ab1 -= mq[4][3] * xy[31]; mq[4] = *(const LAS f32x4*)(Mg + 3892);
            ab0 -= mq[5][0] * xy[32]; ab1 -= mq[5][1] * xy[33]; ab0 -= mq[5][2] * xy[34]; ab1 -= mq[5][3] * xy[35]; mq[5] = *(const LAS f32x4*)(Mg + 3896);
            ab0 -= mq[0][0] * xy[36]; ab1 -= mq[0][1] * xy[37]; ab0 -= mq[0][2] * xy[38]; ab1 -= mq[0][3] * xy[39]; mq[0] = *(const LAS f32x4*)(Mg + 3904);
            ab0 -= mq[1][0] * xy[40]; ab1 -= mq[1][1] * xy[41]; ab0 -= mq[1][2] * xy[42]; ab1 -= mq[1][3] * xy[43]; mq[1] = *(const LAS f32x4*)(Mg + 3908);
            ab0 -= mq[2][0] * xy[44]; ab1 -= mq[2][1] * xy[45]; ab0 -= mq[2][2] * xy[46]; ab1 -= mq[2][3] * xy[47]; mq[2] = *(const LAS f32x4*)(Mg + 3912);
            ab0 -= mq[3][0] * xy[48]; ab1 -= mq[3][1] * xy[49]; ab0 -= mq[3][2] * xy[50]; ab1 -= mq[3][3] * xy[51]; mq[3] = *(const LAS f32x4*)(Mg + 3916);
            ab0 -= mq[4][0] * xy[52]; ab1 -= mq[4][1] * xy[53]; ab0 -= mq[4][2] * xy[54]; ab1 -= mq[4][3] * xy[55]; mq[4] = *(const LAS f32x4*)(Mg + 3920);
            ab0 -= mq[5][0] * xy[56]; ab1 -= mq[5][1] * xy[57]; ab0 -= mq[5][2] * xy[58]; ab1 -= mq[5][3] * xy[59]; xy[60] = ab0 + ab1; up[7680] = xy[60][0]; wp[7680] = f2bf(-xy[60][1]); mq[5] = *(const LAS f32x4*)(Mg + 3924);
            { const float br = betg[61]; ab0 = (f32x2){bf2f(*(const LAS bf16_t*)(lg + P5_VS + 16592 + c * 2)) * br, bf2f(*(const LAS bf16_t*)(lg + P5_KS + 16592 + c * 2)) * br * __expf(decg[61])}; ab1 = (f32x2){0.f, 0.f}; } ab0 -= mq[0][0] * xy[0]; ab1 -= mq[0][1] * xy[1]; ab0 -= mq[0][2] * xy[2]; ab1 -= mq[0][3] * xy[3]; mq[0] = *(const LAS f32x4*)(Mg + 3928);
            ab0 -= mq[1][0] * xy[4]; ab1 -= mq[1][1] * xy[5]; ab0 -= mq[1][2] * xy[6]; ab1 -= mq[1][3] * xy[7]; mq[1] = *(const LAS f32x4*)(Mg + 3932);
            ab0 -= mq[2][0] * xy[8]; ab1 -= mq[2][1] * xy[9]; ab0 -= mq[2][2] * xy[10]; ab1 -= mq[2][3] * xy[11]; mq[2] = *(const LAS f32x4*)(Mg + 3936);
            ab0 -= mq[3][0] * xy[12]; ab1 -= mq[3][1] * xy[13]; ab0 -= mq[3][2] * xy[14]; ab1 -= mq[3][3] * xy[15]; mq[3] = *(const LAS f32x4*)(Mg + 3940);
            ab0 -= mq[4][0] * xy[16]; ab1 -= mq[4][1] * xy[17]; ab0 -= mq[4][2] * xy[18]; ab1 -= mq[4][3] * xy[19]; mq[4] = *(const LAS f32x4*)(Mg + 3944);
            ab0 -= mq[5][0] * xy[20]; ab1 -= mq[5][1] * xy[21]; ab0 -= mq[5][2] * xy[22]; ab1 -= mq[5][3] * xy[23]; mq[5] = *(const LAS f32x4*)(Mg + 3948);
            ab0 -= mq[0][0] * xy[24]; ab1 -= mq[0][1] * xy[25]; ab0 -= mq[0][2] * xy[26]; ab1 -= mq[0][3] * xy[27]; mq[0] = *(const LAS f32x4*)(Mg + 3952);
            ab0 -= mq[1][0] * xy[28]; ab1 -= mq[1][1] * xy[29]; ab0 -= mq[1][2] * xy[30]; ab1 -= mq[1][3] * xy[31]; mq[1] = *(const LAS f32x4*)(Mg + 3956);
            ab0 -= mq[2][0] * xy[32]; ab1 -= mq[2][1] * xy[33]; ab0 -= mq[2][2] * xy[34]; ab1 -= mq[2][3] * xy[35]; mq[2] = *(const LAS f32x4*)(Mg + 3960);
            ab0 -= mq[3][0] * xy[36]; ab1 -= mq[3][1] * xy[37]; ab0 -= mq[3][2] * xy[38]; ab1 -= mq[3][3] * xy[39]; mq[3] = *(const LAS f32x4*)(Mg + 3964);
            ab0 -= mq[4][0] * xy[40]; ab1 -= mq[4][1] * xy[41]; ab0 -= mq[4][2] * xy[42]; ab1 -= mq[4][3] * xy[43]; mq[4] = *(const LAS f32x4*)(Mg + 3968);
            ab0 -= mq[5][0] * xy[44]; ab1 -= mq[5][1] * xy[45]; ab0 -= mq[5][2] * xy[46]; ab1 -= mq[5][3] * xy[47]; mq[5] = *(const LAS f32x4*)(Mg + 3972);
            ab0 -= mq[0][0] * xy[48]; ab1 -= mq[0][1] * xy[49]; ab0 -= mq[0][2] * xy[50]; ab1 -= mq[0][3] * xy[51]; mq[0] = *(const LAS f32x4*)(Mg + 3976);
            ab0 -= mq[1][0] * xy[52]; ab1 -= mq[1][1] * xy[53]; ab0 -= mq[1][2] * xy[54]; ab1 -= mq[1][3] * xy[55]; mq[1] = *(const LAS f32x4*)(Mg + 3980);
            ab0 -= mq[2][0] * xy[56]; ab1 -= mq[2][1] * xy[57]; ab0 -= mq[2][2] * xy[58]; ab1 -= mq[2][3] * xy[59]; mq[2] = *(const LAS f32x4*)(Mg + 3984);
            ab0 -= mq[3][0] * xy[60]; xy[61] = ab0 + ab1; up[7808] = xy[61][0]; wp[7808] = f2bf(-xy[61][1]); mq[3] = *(const LAS f32x4*)(Mg + 3988);
            { const float br = betg[62]; ab0 = (f32x2){bf2f(*(const LAS bf16_t*)(lg + P5_VS + 16864 + c * 2)) * br, bf2f(*(const LAS bf16_t*)(lg + P5_KS + 16864 + c * 2)) * br * __expf(decg[62])}; ab1 = (f32x2){0.f, 0.f}; } ab0 -= mq[4][0] * xy[0]; ab1 -= mq[4][1] * xy[1]; ab0 -= mq[4][2] * xy[2]; ab1 -= mq[4][3] * xy[3]; mq[4] = *(const LAS f32x4*)(Mg + 3992);
            ab0 -= mq[5][0] * xy[4]; ab1 -= mq[5][1] * xy[5]; ab0 -= mq[5][2] * xy[6]; ab1 -= mq[5][3] * xy[7]; mq[5] = *(const LAS f32x4*)(Mg + 3996);
            ab0 -= mq[0][0] * xy[8]; ab1 -= mq[0][1] * xy[9]; ab0 -= mq[0][2] * xy[10]; ab1 -= mq[0][3] * xy[11]; mq[0] = *(const LAS f32x4*)(Mg + 4000);
            ab0 -= mq[1][0] * xy[12]; ab1 -= mq[1][1] * xy[13]; ab0 -= mq[1][2] * xy[14]; ab1 -= mq[1][3] * xy[15]; mq[1] = *(const LAS f32x4*)(Mg + 4004);
            ab0 -= mq[2][0] * xy[16]; ab1 -= mq[2][1] * xy[17]; ab0 -= mq[2][2] * xy[18]; ab1 -= mq[2][3] * xy[19]; mq[2] = *(const LAS f32x4*)(Mg + 4008);
            ab0 -= mq[3][0] * xy[20]; ab1 -= mq[3][1] * xy[21]; ab0 -= mq[3][2] * xy[22]; ab1 -= mq[3][3] * xy[23]; mq[3] = *(const LAS f32x4*)(Mg + 4012);
            ab0 -= mq[4][0] * xy[24]; ab1 -= mq[4][1] * xy[25]; ab0 -= mq[4][2] * xy[26]; ab1 -= mq[4][3] * xy[27]; mq[4] = *(const LAS f32x4*)(Mg + 4016);
            ab0 -= mq[5][0] * xy[28]; ab1 -= mq[5][1] * xy[29]; ab0 -= mq[5][2] * xy[30]; ab1 -= mq[5][3] * xy[31]; mq[5] = *(const LAS f32x4*)(Mg + 4020);
            ab0 -= mq[0][0] * xy[32]; ab1 -= mq[0][1] * xy[33]; ab0 -= mq[0][2] * xy[34]; ab1 -= mq[0][3] * xy[35]; mq[0] = *(const LAS f32x4*)(Mg + 4024);
            ab0 -= mq[1][0] * xy[36]; ab1 -= mq[1][1] * xy[37]; ab0 -= mq[1][2] * xy[38]; ab1 -= mq[1][3] * xy[39]; mq[1] = *(const LAS f32x4*)(Mg + 4028);
            ab0 -= mq[2][0] * xy[40]; ab1 -= mq[2][1] * xy[41]; ab0 -= mq[2][2] * xy[42]; ab1 -= mq[2][3] * xy[43]; mq[2] = *(const LAS f32x4*)(Mg + 4032);
            ab0 -= mq[3][0] * xy[44]; ab1 -= mq[3][1] * xy[45]; ab0 -= mq[3][2] * xy[46]; ab1 -= mq[3][3] * xy[47]; mq[3] = *(const LAS f32x4*)(Mg + 4036);
            ab0 -= mq[4][0] * xy[48]; ab1 -= mq[4][1] * xy[49]; ab0 -= mq[4][2] * xy[50]; ab1 -= mq[4][3] * xy[51]; mq[4] = *(const LAS f32x4*)(Mg + 4040);
            ab0 -= mq[5][0] * xy[52]; ab1 -= mq[5][1] * xy[53]; ab0 -= mq[5][2] * xy[54]; ab1 -= mq[5][3] * xy[55]; mq[5] = *(const LAS f32x4*)(Mg + 4044);
            ab0 -= mq[0][0] * xy[56]; ab1 -= mq[0][1] * xy[57]; ab0 -= mq[0][2] * xy[58]; ab1 -= mq[0][3] * xy[59]; mq[0] = *(const LAS f32x4*)(Mg + 4048);
            ab0 -= mq[1][0] * xy[60]; ab1 -= mq[1][1] * xy[61]; xy[62] = ab0 + ab1; up[7936] = xy[62][0]; wp[7936] = f2bf(-xy[62][1]); mq[1] = *(const LAS f32x4*)(Mg + 4052);
            { const float br = betg[63]; ab0 = (f32x2){bf2f(*(const LAS bf16_t*)(lg + P5_VS + 17136 + c * 2)) * br, bf2f(*(const LAS bf16_t*)(lg + P5_KS + 17136 + c * 2)) * br * __expf(decg[63])}; ab1 = (f32x2){0.f, 0.f}; } ab0 -= mq[2][0] * xy[0]; ab1 -= mq[2][1] * xy[1]; ab0 -= mq[2][2] * xy[2]; ab1 -= mq[2][3] * xy[3]; mq[2] = *(const LAS f32x4*)(Mg + 4056);
            ab0 -= mq[3][0] * xy[4]; ab1 -= mq[3][1] * xy[5]; ab0 -= mq[3][2] * xy[6]; ab1 -= mq[3][3] * xy[7]; mq[3] = *(const LAS f32x4*)(Mg + 4060);
            ab0 -= mq[4][0] * xy[8]; ab1 -= mq[4][1] * xy[9]; ab0 -= mq[4][2] * xy[10]; ab1 -= mq[4][3] * xy[11]; mq[4] = *(const LAS f32x4*)(Mg + 4064);
            ab0 -= mq[5][0] * xy[12]; ab1 -= mq[5][1] * xy[13]; ab0 -= mq[5][2] * xy[14]; ab1 -= mq[5][3] * xy[15]; mq[5] = *(const LAS f32x4*)(Mg + 4068);
            ab0 -= mq[0][0] * xy[16]; ab1 -= mq[0][1] * xy[17]; ab0 -= mq[0][2] * xy[18]; ab1 -= mq[0][3] * xy[19]; mq[0] = *(const LAS f32x4*)(Mg + 4072);
            ab0 -= mq[1][0] * xy[20]; ab1 -= mq[1][1] * xy[21]; ab0 -= mq[1][2] * xy[22]; ab1 -= mq[1][3] * xy[23]; mq[1] = *(const LAS f32x4*)(Mg + 4076);
            ab0 -= mq[2][0] * xy[24]; ab1 -= mq[2][1] * xy[25]; ab0 -= mq[2][2] * xy[26]; ab1 -= mq[2][3] * xy[27]; mq[2] = *(const LAS f32x4*)(Mg + 4080);
            ab0 -= mq[3][0] * xy[28]; ab1 -= mq[3][1] * xy[29]; ab0 -= mq[3][2] * xy[30]; ab1 -= mq[3][3] * xy[31]; mq[3] = *(const LAS f32x4*)(Mg + 4084);
            ab0 -= mq[4][0] * xy[32]; ab1 -= mq[4][1] * xy[33]; ab0 -= mq[4][2] * xy[34]; ab1 -= mq[4][3] * xy[35]; mq[4] = *(const LAS f32x4*)(Mg + 4088);
            ab0 -= mq[5][0] * xy[36]; ab1 -= mq[5][1] * xy[37]; ab0 -= mq[5][2] * xy[38]; ab1 -= mq[5][3] * xy[39]; mq[5] = *(const LAS f32x4*)(Mg + 4092);
            ab0 -= mq[0][0] * xy[40]; ab1 -= mq[0][1] * xy[41]; ab0 -= mq[0][2] * xy[42]; ab1 -= mq[0][3] * xy[43];
            ab0 -= mq[1][0] * xy[44]; ab1 -= mq[1][1] * xy[45]; ab0 -= mq[1][2] * xy[46]; ab1 -= mq[1][3] * xy[47];
            ab0 -= mq[2][0] * xy[48]; ab1 -= mq[2][1] * xy[49]; ab0 -= mq[2][2] * xy[50]; ab1 -= mq[2][3] * xy[51];
            ab0 -= mq[3][0] * xy[52]; ab1 -= mq[3][1] * xy[53]; ab0 -= mq[3][2] * xy[54]; ab1 -= mq[3][3] * xy[55];
            ab0 -= mq[4][0] * xy[56]; ab1 -= mq[4][1] * xy[57]; ab0 -= mq[4][2] * xy[58]; ab1 -= mq[4][3] * xy[59];
            ab0 -= mq[5][0] * xy[60]; ab1 -= mq[5][1] * xy[61]; ab0 -= mq[5][2] * xy[62]; xy[63] = ab0 + ab1; up[8064] = xy[63][0]; wp[8064] = f2bf(-xy[63][1]);
        } else {
            const int g2 = (w8 - 4) >> 1, tt = ((w8 - 4) & 1) * 64 + lane; const int item2 = it0 + g2;
            LAS unsigned char* lg = lds0 + g2 * P5_GRP; LAS float* decg = (LAS float*)(lg + P5_DEC);
            const float lastg = decg[63];
#pragma unroll
            for (int i = 0; i < 8; ++i) { const int vid = tt + 128 * i, r = vid >> 4, d0 = (vid & 15) * 8; float f[8]; unpack8(*(const LAS u32x4*)(lg + P5_QS + r * 272 + d0 * 2), f);
                const float e = scale * __expf(decg[r]);
#pragma unroll
                for (int q = 0; q < 8; ++q) f[q] *= e;
                *(u32x4*)(qd + (size_t)item2 * 8192 + r * 128 + d0) = pack8(f); }
#pragma unroll
            for (int i = 0; i < 8; ++i) { const int vid = tt + 128 * i, d = vid >> 3, rg = (vid & 7) * 8; float f[8];
#pragma unroll
                for (int q = 0; q < 8; ++q) f[q] = bf2f(*(const LAS bf16_t*)(lg + P5_KS + (rg + q) * 272 + d * 2)) * __expf(lastg - decg[rg + q]);
                *(u32x4*)(kt + (size_t)item2 * 8192 + d * 64 + rg) = pack8(f); }
            if (tt == 0) cdv[item2] = __expf(lastg);
        }
    }
    __syncthreads();
}

constexpr int SB_WD = 0, SB_QD = 17408, SB_KT = 34816, SB_QK = 53248, SB_UB = 62464, SB_SIZE = 66560;
constexpr int SC_ST = 2 * SB_SIZE, SC_UT = SC_ST + 4352, SC_END = SC_UT + 2304;
static_assert(SC_END <= LDS_BYTES, "lds");
__device__ __forceinline__ void scan_phase(const Params& p, int bid, int nblk, LAS unsigned char* lds) {
    const int tid = threadIdx.x, lane = tid & 63, wid = __builtin_amdgcn_readfirstlane(tid >> 6), fr = lane & 15, fq = lane >> 4;
    const bf16_t* wdc = (const bf16_t*)(p.ws + WS_WDC); const bf16_t* qd = (const bf16_t*)(p.ws + WS_QD); const bf16_t* kt = (const bf16_t*)(p.ws + WS_KT); const bf16_t* qk = (const bf16_t*)(p.ws + WS_QK);
    const float* cdv = (const float*)(p.ws + WS_CD); const float* ub = p.out + OS_UB; float* obuf = p.out + OS_O;
    for (int item = bid; item < 256; item += nblk) {
        const int xcd = item & 7, iq = item >> 3, bh = xcd * 4 + (iq >> 3), sl = iq & 7, h = bh & 7, b = bh >> 3;
        u32x4 r_wd[2], r_qd[2], r_kt[2], r_qk, r_ub;
        auto gload = [&](int n) {
            const size_t it = (size_t)(bh * 32 + n);
#pragma unroll
            for (int i = 0; i < 2; ++i) { const int ch = tid + 512 * i; r_wd[i] = *(const u32x4*)(wdc + it * 8192 + ch * 8); r_qd[i] = *(const u32x4*)(qd + it * 8192 + ch * 8); r_kt[i] = *(const u32x4*)(kt + it * 8192 + ch * 8); }
            r_qk = *(const u32x4*)(qk + it * 4096 + tid * 8);
            if (tid < 256) r_ub = *(const u32x4*)(ub + it * 8192 + (tid >> 2) * 128 + sl * 16 + (tid & 3) * 4);
        };
        auto lstore = [&](int buf) {
            LAS unsigned char* B = lds + buf * SB_SIZE;
#pragma unroll
            for (int i = 0; i < 2; ++i) { const int ch = tid + 512 * i; const int r = ch >> 4, c8 = (ch & 15) * 8; *(LAS u32x4*)(B + SB_WD + r * 272 + c8 * 2) = r_wd[i]; *(LAS u32x4*)(B + SB_QD + r * 272 + c8 * 2) = r_qd[i];
                const int d = ch >> 3, t8 = (ch & 7) * 8; *(LAS u32x4*)(B + SB_KT + d * 144 + t8 * 2) = r_kt[i]; }
            { const int r = tid >> 3, s8 = (tid & 7) * 8; *(LAS u32x4*)(B + SB_QK + r * 144 + s8 * 2) = r_qk; }
            if (tid < 256) *(LAS u32x4*)(B + SB_UB + (tid >> 2) * 64 + (tid & 3) * 16) = r_ub;
        };
        __syncthreads();
        gload(0);
        for (int i = tid; i < 4352 / 4; i += 512) *(LAS unsigned*)(lds + SC_ST + i * 4) = 0u;
        lstore(0);
        f32x4 sacc = (f32x4){0.f, 0.f, 0.f, 0.f};
        __syncthreads();
        for (int n = 0; n < 32; ++n) {
            const int cur = n & 1; LAS unsigned char* B = lds + cur * SB_SIZE;
            if (n + 1 < 32) gload(n + 1);
            const float cd = cdv[bh * 32 + n];
            f32x4 acc;
            const int tw = wid & 3;
            if (wid < 4) {
#pragma unroll
                for (int j = 0; j < 4; ++j) acc[j] = *(const LAS float*)(B + SB_UB + ((tw * 16 + fq * 4 + j) * 16 + fr) * 4);
#pragma unroll
                for (int kk = 0; kk < 4; ++kk) { const bf16x8 a = *(const LAS bf16x8*)(B + SB_WD + (tw * 16 + fr) * 272 + (kk * 32 + fq * 8) * 2); const bf16x8 bb = *(const LAS bf16x8*)(lds + SC_ST + fr * 272 + (kk * 32 + fq * 8) * 2);
                    acc = __builtin_amdgcn_mfma_f32_16x16x32_bf16(a, bb, acc, 0, 0, 0); }
                u32x2 w; w.x = pk2(acc[0], acc[1]); w.y = pk2(acc[2], acc[3]);
                *(LAS u32x2*)(lds + SC_UT + fr * 144 + (tw * 16 + fq * 4) * 2) = w;
            } else {
                acc = (f32x4){0.f, 0.f, 0.f, 0.f};
#pragma unroll
                for (int kk = 0; kk < 4; ++kk) { const bf16x8 a = *(const LAS bf16x8*)(B + SB_QD + (tw * 16 + fr) * 272 + (kk * 32 + fq * 8) * 2); const bf16x8 bb = *(const LAS bf16x8*)(lds + SC_ST + fr * 272 + (kk * 32 + fq * 8) * 2);
                    acc = __builtin_amdgcn_mfma_f32_16x16x32_bf16(a, bb, acc, 0, 0, 0); }
            }
            __syncthreads();
            sacc *= cd;
#pragma unroll
            for (int kk = 0; kk < 2; ++kk) { const bf16x8 a = *(const LAS bf16x8*)(B + SB_KT + (wid * 16 + fr) * 144 + (kk * 32 + fq * 8) * 2); const bf16x8 bb = *(const LAS bf16x8*)(lds + SC_UT + fr * 144 + (kk * 32 + fq * 8) * 2);
                sacc = __builtin_amdgcn_mfma_f32_16x16x32_bf16(a, bb, sacc, 0, 0, 0); }
            if (wid >= 4) {
#pragma unroll
                for (int kk = 0; kk < 2; ++kk) { const bf16x8 a = *(const LAS bf16x8*)(B + SB_QK + (tw * 16 + fr) * 144 + (kk * 32 + fq * 8) * 2); const bf16x8 bb = *(const LAS bf16x8*)(lds + SC_UT + fr * 144 + (kk * 32 + fq * 8) * 2);
                    acc = __builtin_amdgcn_mfma_f32_16x16x32_bf16(a, bb, acc, 0, 0, 0); }
#pragma unroll
                for (int j = 0; j < 4; ++j) obuf[(size_t)(b * 2048 + n * 64 + tw * 16 + fq * 4 + j) * 1024 + h * 128 + sl * 16 + fr] = acc[j];
            }
            { u32x2 w; w.x = pk2(sacc[0], sacc[1]); w.y = pk2(sacc[2], sacc[3]); *(LAS u32x2*)(lds + SC_ST + fr * 272 + (wid * 16 + fq * 4) * 2) = w; }
            if (n + 1 < 32) lstore(cur ^ 1);
            __syncthreads();
        }
#pragma unroll
        for (int j = 0; j < 4; ++j) p.out[O_DP + ((size_t)bh * 128 + wid * 16 + fq * 4 + j) * 128 + sl * 16 + fr] = sacc[j];
    }
    __syncthreads();
    {
        const bf16_t* qn = (const bf16_t*)(p.ws + WS_QN); const bf16_t* kn = (const bf16_t*)(p.ws + WS_KN); const bf16_t* vv = (const bf16_t*)(p.ws + WS_VV);
        const float* gbuf = (const float*)(p.ws + WS_G); const float* bbuf = (const float*)(p.ws + WS_BETA);
        const int grp = tid >> 8, w4 = __builtin_amdgcn_readfirstlane(tid >> 6) & 3, j = w4 * 32 + (lane & 31), half = lane >> 5;
        LAS float* qs = (LAS float*)lds + grp * 1024;
        LAS float* ks = qs + 512;
        const float scale = 0.08838834764831845f;
        for (int it0 = bid * 2; it0 < 1024; it0 += nblk * 2) {
            const int item = it0 + grp, sb = item >> 3, h = item & 7;
            __syncthreads();
#pragma unroll
            for (int i = 0; i < 4; ++i) { const int idx = (tid & 255) + 256 * i, tk = idx >> 7, c = idx & 127, t = tk & 3; const size_t go = (size_t)(TP + sb * 4 + t) * 1024 + h * 128 + c;
                if (tk < 4) qs[t * 128 + c] = bf2f(qn[go]); else ks[t * 128 + c] = bf2f(kn[go]); }
            float S[64];
            const float* s0 = p.in[4] + (size_t)item * 16384 + (size_t)half * 64 * 128 + j;
#pragma unroll
            for (int i = 0; i < 64; ++i) S[i] = __builtin_nontemporal_load(s0 + i * 128);
            __syncthreads();
#pragma unroll 1
            for (int t = 0; t < 4; ++t) {
                const int row = TP + sb * 4 + t;
                const float a = __expf(gbuf[row * 8 + h]), be = bbuf[row * 8 + h], v = bf2f(vv[(size_t)row * 1024 + h * 128 + j]);
                float kS = 0.f;
#pragma unroll
                for (int i4 = 0; i4 < 16; ++i4) { const f32x4 k4 = *(const LAS f32x4*)(ks + t * 128 + half * 64 + i4 * 4); kS += k4[0] * S[i4 * 4] + k4[1] * S[i4 * 4 + 1] + k4[2] * S[i4 * 4 + 2] + k4[3] * S[i4 * 4 + 3]; }
                kS += __shfl_xor(kS, 32);
                const float coef = be * (v - a * kS);
                float o = 0.f;
#pragma unroll
                for (int i4 = 0; i4 < 16; ++i4) { const f32x4 k4 = *(const LAS f32x4*)(ks + t * 128 + half * 64 + i4 * 4); const f32x4 q4 = *(const LAS f32x4*)(qs + t * 128 + half * 64 + i4 * 4);
#pragma unroll
                    for (int q = 0; q < 4; ++q) { S[i4 * 4 + q] = a * S[i4 * 4 + q] + k4[q] * coef; o += q4[q] * S[i4 * 4 + q]; } }
                o += __shfl_xor(o, 32);
                if (half == 0) obuf[(size_t)row * 1024 + h * 128 + j] = o * scale;
            }
            float* so = p.out + O_DS + (size_t)item * 16384 + (size_t)half * 64 * 128 + j;
#pragma unroll
            for (int i = 0; i < 64; ++i) so[i * 128] = S[i];
        }
    }
    __syncthreads();
}

__device__ __forceinline__ void onorm_phase(const Params& p, int bid, int nblk) {
    const int lane = threadIdx.x & 63, wid = __builtin_amdgcn_readfirstlane(threadIdx.x >> 6);
    const float* obuf = p.out + OS_O; const bf16_t* proj = (const bf16_t*)(p.ws + WS_PROJ); bf16_t* acat = (bf16_t*)(p.ws + WS_U); const float* og = p.in[14];
    for (int row = bid * 8 + wid; row < TT; row += nblk * 8) {
        const int c0 = lane * 16; float o[16], z[16], g[16];
#pragma unroll
        for (int i = 0; i < 4; ++i) { const f32x4 v = *(const f32x4*)(obuf + (size_t)row * 1024 + c0 + i * 4); o[i * 4] = v[0]; o[i * 4 + 1] = v[1]; o[i * 4 + 2] = v[2]; o[i * 4 + 3] = v[3];
            const f32x4 gg = *(const f32x4*)(og + (c0 & 127) + i * 4); g[i * 4] = gg[0]; g[i * 4 + 1] = gg[1]; g[i * 4 + 2] = gg[2]; g[i * 4 + 3] = gg[3]; }
        unpack8(*(const u32x4*)(proj + (size_t)row * NPROJ + C_Z + c0), z); unpack8(*(const u32x4*)(proj + (size_t)row * NPROJ + C_Z + c0 + 8), z + 8);
        float ss = 0.f;
#pragma unroll
        for (int i = 0; i < 16; ++i) ss += o[i] * o[i];
        ss += __shfl_xor(ss, 1); ss += __shfl_xor(ss, 2); ss += __shfl_xor(ss, 4);
        const float rstd = rsqrtf(ss * (1.0f / 128.0f) + EPS);
#pragma unroll
        for (int i = 0; i < 16; ++i) o[i] = o[i] * rstd * g[i] * siluf_(z[i]);
        *(u32x4*)(acat + (size_t)row * DM + c0) = pack8(o); *(u32x4*)(acat + (size_t)row * DM + c0 + 8) = pack8(o + 8);
    }
}

#define XB_TMO      128
#define XB_XCNT(j)  (256  + 64 * (j))
#define XB_XSUB(j)  (1280 + 64 * (j))
#define XB_XGEN(j)  (2304 + 64 * (j))
#define XB_TOP      3328
#define XB_TOPGEN   3392
#define XCD_BAR_WORDS 3456
#define XB_SPIN_CAP (1u << 18)

__device__ __forceinline__ unsigned xb_ld(unsigned* p)              { return __hip_atomic_load(p, __ATOMIC_RELAXED, __HIP_MEMORY_SCOPE_AGENT); }
__device__ __forceinline__ unsigned xb_add(unsigned* p, unsigned v) { return __hip_atomic_fetch_add(p, v, __ATOMIC_RELAXED, __HIP_MEMORY_SCOPE_AGENT); }
__device__ __forceinline__ unsigned xb_xcc_id() { return (unsigned)__builtin_amdgcn_s_getreg((3 << 11) | 20) & 0xFu; }
#define XB_SPIN(cond, bar) do { unsigned _sp = 0; while (cond) { __builtin_amdgcn_s_sleep(1); \
    if ((++_sp & 255u) == 0u) { if (xb_ld(&(bar)[XB_TMO])) break; if (_sp > XB_SPIN_CAP) { atomicAdd(&(bar)[XB_TMO], 1u); break; } } } } while (0)

struct XcdBarrier {
    unsigned* bar; unsigned x;
    volatile LAS unsigned* st;
};

__device__ __forceinline__ XcdBarrier xcd_barrier_post(unsigned* bar, volatile LAS unsigned* st) {
    XcdBarrier b; b.bar = bar; b.x = xb_xcc_id(); b.st = st;
    if (threadIdx.x == 0) (void)xb_add(&bar[XB_XCNT(b.x)], 1u);
    return b;
}
__device__ __forceinline__ void xcd_barrier_complete(unsigned* bar, unsigned x, unsigned& nloc, unsigned& nx) {
    const unsigned G = gridDim.x * gridDim.y * gridDim.z;
    unsigned sum, cnt, mine, sp = 0u;
    for (;;) {
        sum = 0u; cnt = 0u; mine = 0u;
#pragma unroll
        for (unsigned j = 0; j < 16; ++j) { const unsigned c = xb_ld(&bar[XB_XCNT(j)]); sum += c; cnt += (c > 0u) ? 1u : 0u; mine = (j == x) ? c : mine; }
        if (sum == G) break;
        __builtin_amdgcn_s_sleep(1);
        if ((++sp & 255u) == 0u) { if (xb_ld(&bar[XB_TMO])) break; if (sp > XB_SPIN_CAP) { atomicAdd(&bar[XB_TMO], 1u); break; } }
    }
    nloc = mine > 0u ? mine : 1u; nx = cnt > 0u ? cnt : 1u;
}

__device__ __forceinline__ void xcd_barrier(const XcdBarrier& b) {
    asm volatile("s_waitcnt vmcnt(0)" ::: "memory");
    __syncthreads();
    if (threadIdx.x == 0) {
        unsigned* bar = b.bar;
        __builtin_amdgcn_s_waitcnt(0);
        unsigned nloc = b.st[0], nx = b.st[1];
        if (nloc == 0u) { xcd_barrier_complete(bar, b.x, nloc, nx); b.st[0] = nloc; b.st[1] = nx; }
        const unsigned old = xb_add(&bar[XB_XSUB(b.x)], 1u);
        const unsigned gen = old / nloc;
        if (old + 1u == (gen + 1u) * nloc) {
            __builtin_amdgcn_fence(__ATOMIC_RELEASE, "agent");
            asm volatile("s_waitcnt vmcnt(0)" ::: "memory");
            const unsigned og = xb_add(&bar[XB_TOP], 1u);
            const unsigned tg = og / nx;
            if (og + 1u == (tg + 1u) * nx) xb_add(&bar[XB_TOPGEN], 1u);
            else XB_SPIN(xb_ld(&bar[XB_TOPGEN]) == tg, bar);
            __builtin_amdgcn_fence(__ATOMIC_ACQUIRE, "agent");
            xb_add(&bar[XB_XGEN(b.x)], 1u);
            asm volatile("s_waitcnt vmcnt(0)" ::: "memory");
        } else {
            XB_SPIN(xb_ld(&bar[XB_XGEN(b.x)]) == gen, bar);
            __builtin_amdgcn_fence(__ATOMIC_ACQUIRE, "agent");
            asm volatile("s_waitcnt vmcnt(0)" ::: "memory");
        }
    }
    __syncthreads();
}

constexpr size_t WS_BAR = WS_END;
constexpr int LDS_ST_OFF = LDS_BYTES - 16;
struct KArgs { Params p; TJob jobs[11]; };
constexpr int N_PHASES = 15;
#ifndef PH_MASK
#define PH_MASK 0xFFFF
#endif
#ifndef DUP_MASK
#define DUP_MASK 0
#endif

__global__ void __launch_bounds__(512, 2) fwd_megakernel(KArgs ka) {
    extern __shared__ __attribute__((aligned(16))) unsigned char lds_raw[];
    LAS unsigned char* lds = (LAS unsigned char*)lds_raw;
    const Params& p = ka.p;
    const int bid = blockIdx.x, nblk = gridDim.x;
    unsigned char* ws = p.ws;
    const int lo = p.ph_lo, hi = p.ph_hi;
    if (threadIdx.x < 4) ((LAS unsigned*)(lds + LDS_ST_OFF))[threadIdx.x] = 0u;
    __syncthreads();
    if (hi > 1000) cg::this_grid().sync();
    XcdBarrier xbar = xcd_barrier_post((unsigned*)(ws + WS_BAR), (volatile LAS unsigned*)(lds + LDS_ST_OFF));
#define IN(k) ((PH_MASK & (1 << (k))) && lo <= (k) && (k) < hi)
#define SEAM(k) do { if (lo <= (k) && (k) + 1 < hi) xcd_barrier(xbar); } while (0)
    if (IN(0)) for (int rep = 0; rep <= ((DUP_MASK >> 0) & 1); ++rep) {
            bf16_t* aada = (bf16_t*)(ws + WS_AADA);
            for (int idx = bid * 512 + threadIdx.x; idx < 256 * 2048; idx += nblk * 512) { const int row = idx >> 11, col = idx & 2047;
                const float v = row < 4 ? siluf_(p.in[2][row * 2048 + col]) : (row < NB ? siluf_(p.in[3][(row - 4) * 2048 + col]) : 0.f); aada[idx] = f2bf(v); }
            transpose_jobs(ka.jobs, 1, bid, nblk, lds);
        }
    SEAM(0);
    if (IN(1)) for (int rep = 0; rep <= ((DUP_MASK >> 1) & 1); ++rep) {
            if (bid < 48) { pg8::Gemm g{(const bf16_t*)(ws + WS_AADA), (const bf16_t*)(ws + WS_PROJ), 2048, 2048, 2048, 0, 0, 0, 0, 0}; pg8::OneUnitOrder S{48, bid, 32}; pg8::EpiAda E{(float*)(ws + WS_MOD), p.in[8]}; pg8::gemm_phase(lds, g, S, E); }
            else { transpose_jobs(ka.jobs + 1, 1, bid - 48, nblk - 48, lds); transpose_jobs(ka.jobs + 4, 7, bid - 48, nblk - 48, lds); }
        }
    SEAM(1);
    if (IN(2)) for (int rep = 0; rep <= ((DUP_MASK >> 2) & 1); ++rep) norm_phase<0>(p, bid, nblk);
    SEAM(2);
    if (IN(3)) for (int rep = 0; rep <= ((DUP_MASK >> 3) & 1); ++rep) { pg8::Gemm g{(const bf16_t*)(ws + WS_U), (const bf16_t*)(ws + WS_WIN), 2048, 2048, 2048, 0, 0, 0, 0, 0}; pg8::StaticOrder S; S.init(TT, NPROJ, 2048, nblk, bid); pg8::EpiBf16 E{(bf16_t*)(ws + WS_PROJ), NPROJ, 0, nullptr}; pg8::gemm_phase(lds, g, S, E); }
    SEAM(3);
    if (IN(4)) for (int rep = 0; rep <= ((DUP_MASK >> 4) & 1); ++rep) mixer_prep_phase(p, bid, nblk);
    SEAM(4);
    if (IN(5)) for (int rep = 0; rep <= ((DUP_MASK >> 5) & 1); ++rep) chunk_prep_phase(p, bid, nblk, lds);
    SEAM(5);
    if (IN(6)) for (int rep = 0; rep <= ((DUP_MASK >> 6) & 1); ++rep) scan_phase(p, bid, nblk, lds);
    SEAM(6);
    if (IN(7)) for (int rep = 0; rep <= ((DUP_MASK >> 7) & 1); ++rep) { onorm_phase(p, bid, nblk);
            pg8::Gemm g{(const bf16_t*)(ws + WS_YP), (const bf16_t*)(ws + WS_PW), 1024, 256, 256, 512, 0, 0, 0, 0}; pg8::StaticOrder S; S.init(TT, 1024, 256, nblk, bid); pg8::EpiBf16 E{(bf16_t*)(ws + WS_U), DM, 1024, p.in[16]}; pg8::gemm_phase(lds, g, S, E);
            if (rep == 0) { if (nblk <= 136) transpose_jobs(ka.jobs + 3, 1, bid, nblk, lds); else if (bid >= 136) transpose_jobs(ka.jobs + 3, 1, bid - 136, nblk - 136, lds); } }
    SEAM(7);
    if (IN(8)) for (int rep = 0; rep <= ((DUP_MASK >> 8) & 1); ++rep) {
            pg8::Gemm g{(const bf16_t*)(ws + WS_U), (const bf16_t*)(ws + WS_WAB), 2048, 2048, 1024, 0, 2048, 2048, (size_t)128 * 2048 * 2, (size_t)128 * 2048 * 2}; pg8::StaticOrder S; S.init(68 * 256, 16 * 256, 1024, nblk, bid);
            pg8::EpiDiag E{(bf16_t*)(ws + WS_QN), (const bf16_t*)(ws + WS_PROJ)}; pg8::gemm_phase(lds, g, S, E);
            if (rep == 0) { const int nfull = 1088 % nblk; if (nfull == 0 || nfull >= nblk) transpose_jobs(ka.jobs + 2, 1, bid, nblk, lds); else if (bid >= nfull) transpose_jobs(ka.jobs + 2, 1, bid - nfull, nblk - nfull, lds); } }
    SEAM(9);
    if (IN(10)) for (int rep = 0; rep <= ((DUP_MASK >> 10) & 1); ++rep) { pg8::Gemm g{(const bf16_t*)(ws + WS_QN), (const bf16_t*)(ws + WS_WO), 2048, 2048, 2048, 0, 0, 0, 0, 0}; pg8::SplitOrder S{nblk, bid, 32, 4, 8}; pg8::EpiRes E{p.out + O_Y, p.in[0], p.in[1], (const float*)(ws + WS_MOD) + 4096, (float*)(ws + WS_PB10)}; pg8::gemm_phase(lds, g, S, E); }
    SEAM(10);
    if (IN(11)) for (int rep = 0; rep <= ((DUP_MASK >> 11) & 1); ++rep) norm_phase<1>(p, bid, nblk);
    SEAM(11);
    if (IN(12)) for (int rep = 0; rep <= ((DUP_MASK >> 12) & 1); ++rep) { pg8::Gemm g{(const bf16_t*)(ws + WS_U), (const bf16_t*)(ws + WS_WGU), 2048, 2048, 2048, 0, 0, 0, 0, 0}; pg8::StaticOrder S; S.init(TT, 11264, 2048, nblk, bid); pg8::EpiGU E{(bf16_t*)(ws + WS_PROJ)}; pg8::gemm_phase(lds, g, S, E); }
    SEAM(12);
    if (IN(13)) for (int rep = 0; rep <= ((DUP_MASK >> 13) & 1); ++rep) { pg8::Gemm g{(const bf16_t*)(ws + WS_PROJ), (const bf16_t*)(ws + WS_WD), DFF, DFF, DFF, 0, 0, 0, 0, 0}; pg8::SplitOrder S{nblk, bid, 88, 8, 11}; pg8::EpiRes E{p.out + O_Y, p.out + O_Y, p.out + O_Y + (size_t)TP * DM, (const float*)(ws + WS_MOD) + 10240, (float*)(ws + WS_PB13)}; pg8::gemm_phase(lds, g, S, E); }
    SEAM(13);
    if (IN(14)) for (int rep = 0; rep <= ((DUP_MASK >> 14) & 1); ++rep) norm_phase<2>(p, bid, nblk);
    SEAM(14);
}

extern "C" void kernel_launch(void* const* d_in, const int* in_sizes, int n_in, void* d_out, int out_size, void* d_ws, size_t ws_size, hipStream_t stream) {
    static int grid = 0;
    if (grid == 0) {
        if (n_in != 24 || ws_size < WS_BAR + XCD_BAR_WORDS * 4) { fprintf(stderr, "kernel_launch: unexpected n_in %d / ws_size %zu (need %zu)\n", n_in, ws_size, (size_t)WS_END); grid = -1; return; }
        int dev = 0, cus = 0, per_cu = 0;
        hipGetDevice(&dev); hipDeviceGetAttribute(&cus, hipDeviceAttributeMultiprocessorCount, dev);
        if (hipFuncSetAttribute((const void*)fwd_megakernel, hipFuncAttributeMaxDynamicSharedMemorySize, LDS_BYTES) != hipSuccess) { fprintf(stderr, "kernel_launch: hipFuncSetAttribute failed\n"); grid = -1; return; }
        if (hipOccupancyMaxActiveBlocksPerMultiprocessor(&per_cu, (const void*)fwd_megakernel, 512, LDS_BYTES) != hipSuccess || per_cu < 1) { fprintf(stderr, "kernel_launch: occupancy query says %d\n", per_cu); per_cu = 1; }
        (void)hipGetLastError();
        grid = cus > 0 ? cus : 256;
        if (grid < 64) grid = 64;
    }
    if (grid < 0) return;
    if (hipMemsetAsync((unsigned char*)d_ws + WS_BAR, 0, XCD_BAR_WORDS * 4, stream) != hipSuccess) { fprintf(stderr, "kernel_launch: memset failed\n"); return; }
    KArgs ka; memset(&ka, 0, sizeof(ka));
    for (int i = 0; i < 24; ++i) ka.p.in[i] = (const float*)d_in[i];
    ka.p.out = (float*)d_out; ka.p.ws = (unsigned char*)d_ws;
    unsigned char* ws = (unsigned char*)d_ws;
    auto setjob = [&](int i, const void* src, void* dst, int ld_src, int K, int Nout, int ld_dst, int map) { TJob& j = ka.jobs[i]; j.src = (const float*)src; j.dst = (bf16_t*)dst; j.ld_src = ld_src; j.K = K; j.Nout = Nout; j.ld_dst = ld_dst; j.map = map; j.pad = 0; };
    setjob(0, d_in[7], ws + WS_PROJ, MODW, 2048, MODW, 2048, 0);
    setjob(1, d_in[10], ws + WS_WIN, 9232, 2048, NPROJ, 2048, 1);
    setjob(2, d_in[21], ws + WS_WGU, 2 * DFF, 2048, 2 * DFF, 2048, 2);
    setjob(3, d_in[22], ws + WS_WD, 2048, DFF, 2048, DFF, 0);
    setjob(4, d_in[19], ws + WS_WO, 2048, 2048, 2048, 2048, 0);
    setjob(5, d_in[17], ws + WS_WAB, 2048, 1024, 2048, 2048, 0);
    setjob(6, d_in[18], ws + WS_WAB + 1024 * 2, 2048, 1024, 2048, 2048, 0);
    for (int g = 0; g < 4; ++g) setjob(7 + g, (const float*)d_in[15] + g * 65536, ws + WS_PW + (size_t)g * 65536 * 2, 256, 256, 256, 256, 0);
#if MK_PER_PHASE
    for (int ph = 0; ph < N_PHASES; ++ph) { ka.p.ph_lo = ph; ka.p.ph_hi = ph + 1; hipLaunchKernelGGL(fwd_megakernel, dim3(grid), dim3(512), LDS_BYTES, stream, ka); }
#else
    ka.p.ph_lo = 0; ka.p.ph_hi = N_PHASES;
    void* args[] = {&ka};
    hipError_t e = hipLaunchCooperativeKernel((const void*)fwd_megakernel, dim3(grid), dim3(512), args, LDS_BYTES, stream);
    if (e != hipSuccess) fprintf(stderr, "cooperative launch failed: %s (grid %d)\n", hipGetErrorString(e), grid);
#endif
}
```

```cpp
#include <hip/hip_runtime.h>
#include <hip/hip_cooperative_groups.h>
#include <cstdio>
#include <cstring>
namespace cg = cooperative_groups;

#ifndef MK_PER_PHASE
#define MK_PER_PHASE 0
#endif

#define LAS __attribute__((address_space(3)))
typedef unsigned short bf16_t;
typedef short bf16x8 __attribute__((ext_vector_type(8)));
typedef float f32x4 __attribute__((ext_vector_type(4)));
typedef float f32x2 __attribute__((ext_vector_type(2)));
typedef unsigned u32x4 __attribute__((ext_vector_type(4)));
typedef unsigned u32x2 __attribute__((ext_vector_type(2)));

constexpr int DM = 2048, TP = 8192, TS = 512, TT = 8704, NB = 132;
constexpr int NPROJ = 9472;
constexpr int DFF = 5632;
constexpr int MODW = 12288;
constexpr float EPS = 1e-6f;
constexpr int C_Q = 0, C_K = 1024, C_V = 2048, C_Z = 3072, C_XP = 4096, C_GA = 5120, C_GB = 7168, C_AB = 9216;
constexpr size_t O_Y = 0, O_DP = 17825792, O_CP = 18350080, O_PP = 18386944, O_DS = 18448384, O_CS = 35225600, O_PS = 36405248;
constexpr size_t OS_O = 0, OS_UB = 8912896;
constexpr size_t WS_WIN = 0;
constexpr size_t WS_WGU = WS_WIN + (size_t)NPROJ * 2048 * 2;
constexpr size_t WS_WD = WS_WGU + (size_t)11264 * 2048 * 2;
constexpr size_t WS_WO = WS_WD + (size_t)2048 * 5632 * 2;
constexpr size_t WS_WAB = WS_WO + (size_t)2048 * 2048 * 2;
constexpr size_t WS_PW = WS_WAB + (size_t)2048 * 2048 * 2;
constexpr size_t WS_AADA = WS_PW + (size_t)1024 * 256 * 2;
constexpr size_t WS_MOD = WS_AADA + (size_t)256 * 2048 * 2;
constexpr size_t WS_G = WS_MOD + (size_t)NB * MODW * 4;
constexpr size_t WS_BETA = WS_G + (size_t)TT * 8 * 4;
constexpr size_t WS_CD = WS_BETA + (size_t)TT * 8 * 4;
constexpr size_t WS_U = WS_CD + 4096;
constexpr size_t WS_QN = WS_U + (size_t)TT * 2048 * 2;
constexpr size_t WS_KN = WS_QN + (size_t)TT * 1024 * 2;
constexpr size_t WS_VV = WS_KN + (size_t)TT * 1024 * 2;
constexpr size_t WS_YP = WS_VV + (size_t)TT * 1024 * 2;
constexpr size_t WS_WDC = WS_YP + (size_t)TT * 1024 * 2;
constexpr size_t WS_QD = WS_WDC + (size_t)1024 * 64 * 128 * 2;
constexpr size_t WS_KT = WS_QD + (size_t)1024 * 64 * 128 * 2;
constexpr size_t WS_QK = WS_KT + (size_t)1024 * 64 * 128 * 2;
constexpr size_t WS_PROJ = WS_QK + (size_t)1024 * 64 * 64 * 2;
constexpr size_t WS_END = WS_PROJ + (size_t)TT * NPROJ * 2;
constexpr size_t WS_PB10 = WS_PROJ;
constexpr size_t WS_PB13 = WS_PROJ + (size_t)TT * DFF * 2;
static_assert(WS_PB13 + (size_t)11 * TS * DM * 4 <= WS_END && (WS_PB13 % 256) == 0, "partials");
static_assert(WS_END + 16384 <= 501510720ull, "workspace too large");
static_assert((WS_PROJ % 256) == 0 && (WS_QK % 256) == 0 && (WS_U % 256) == 0, "align");

constexpr int LDS_BYTES = 147456;

struct Params {
    const float* in[24];
    float* out;
    unsigned char* ws;
    int ph_lo, ph_hi;
};

__device__ __forceinline__ float bf2f(unsigned short x) { return __uint_as_float(((unsigned)x) << 16); }
__device__ __forceinline__ unsigned short f2bf(float f) { const __bf16 b = (__bf16)f; return __builtin_bit_cast(unsigned short, b); }
typedef __bf16 bf16x2_hw __attribute__((ext_vector_type(2)));
__device__ __forceinline__ unsigned pk2(float lo, float hi) { const f32x2 v = {lo, hi}; const bf16x2_hw b = __builtin_convertvector(v, bf16x2_hw); return __builtin_bit_cast(unsigned, b); }
__device__ __forceinline__ void unpack8(const u32x4 w, float* f) {
    f[0] = __uint_as_float(w.x << 16); f[1] = __uint_as_float(w.x & 0xffff0000u);
    f[2] = __uint_as_float(w.y << 16); f[3] = __uint_as_float(w.y & 0xffff0000u);
    f[4] = __uint_as_float(w.z << 16); f[5] = __uint_as_float(w.z & 0xffff0000u);
    f[6] = __uint_as_float(w.w << 16); f[7] = __uint_as_float(w.w & 0xffff0000u);
}
__device__ __forceinline__ u32x4 pack8(const float* f) { u32x4 w; w.x = pk2(f[0], f[1]); w.y = pk2(f[2], f[3]); w.z = pk2(f[4], f[5]); w.w = pk2(f[6], f[7]); return w; }
__device__ __forceinline__ float sigmoidf_(float x) { return __builtin_amdgcn_rcpf(1.0f + __expf(-x)); }
__device__ __forceinline__ float siluf_(float x) { return x * __builtin_amdgcn_rcpf(1.0f + __expf(-x)); }
__device__ __forceinline__ int bidx_of_row(int row) { return row < TP ? (row >> 11) : 4 + ((row - TP) >> 2); }

namespace pg8 {
constexpr int BM = 256, BK = 64, HALF = 128, HTB = HALF * BK * 2, STAGE_BYTES = 8 * HTB, NXCD = 8, WGM = 8;
__host__ __device__ __forceinline__ int lds_byte(int r, int c) { const int st = (r >> 4) * 2 + (c >> 5), rr = r & 15, cc = c & 31, ob = rr * 64 + cc * 2; return st * 1024 + (ob ^ (((ob >> 9) & 1) << 5)); }
__host__ __device__ __forceinline__ void stage_rc(int b, int& R, int& C) { const int st = b / 1024, sb = b % 1024, swz = sb ^ (((sb >> 9) & 1) << 5); R = (st >> 1) * 16 + swz / 64; C = (st & 1) * 32 + (swz % 64) / 2; }
__host__ __device__ __forceinline__ int perm32(int rho) { const int n = rho >> 4, i = rho & 15; return 8 * (i >> 2) + 4 * n + (i & 3); }

struct Unit { int pm, pn, kt0, nkt, piece; };
struct Gemm { const bf16_t* A; const bf16_t* Bt; int lda, ldb, K; size_t a_pn_off; size_t a_half, b_half, a_tile, b_tile; };

__device__ __forceinline__ void tile_of(int wgid, int nM, int nN, Unit& u) {
    const int nwg = nM * nN;
    { const int q = nwg / NXCD, r = nwg % NXCD, xcd = wgid % NXCD, off = wgid / NXCD; wgid = (xcd < r ? xcd * (q + 1) : r * (q + 1) + (xcd - r) * q) + off; }
    const int nig = WGM * nN, gid = wgid / nig, fm = gid * WGM, gsz = (nM - fm) < WGM ? (nM - fm) : WGM;
    u.pm = fm + ((wgid % nig) % gsz); u.pn = (wgid % nig) / gsz;
}
struct StaticOrder {
    int nM, nN, nwg, G, c, ntk;
    __device__ __forceinline__ void init(int M, int N, int K, int G_, int c_) { nM = M / BM; nN = N / BM; nwg = nM * nN; G = G_; c = c_; ntk = K / BK; }
    __device__ __forceinline__ bool next(int i, Unit& u) const {
        const long L = (long)i * G + c; if (L >= nwg) return false;
        tile_of((int)L, nM, nN, u); u.kt0 = 0; u.nkt = ntk; u.piece = -1; return true;
    }
};
struct OneUnitOrder {
    int n, c, ntk;
    __device__ __forceinline__ bool next(int i, Unit& u) const { if (i != 0 || c >= n) return false; u.pm = 0; u.pn = c; u.kt0 = 0; u.nkt = ntk; u.piece = -1; return true; }
};
struct DoubleOrder {
    int G, c;
    __device__ __forceinline__ bool next(int i, Unit& u) const {
        const int L = (i >> 1) * G + c, half = i & 1; const bool ok = L < 272;
        tile_of(ok ? L : 0, 34, 8, u); u.kt0 = 16 * half; u.nkt = 16; u.piece = half; return ok;
    }
};
struct SplitOrder {
    int G, c, ntk, pk, npc;
    __device__ __forceinline__ bool next(int i, Unit& u) const {
        const int L = i * G + c;
        const bool full = L < 256;
        int fpm, fpn;
        { int wgid = full ? L : 0; const int xcd = wgid % NXCD, off = wgid / NXCD; wgid = xcd * 32 + off;
          const int nig = WGM * 8, gid = wgid / nig, fm = gid * WGM; fpm = fm + ((wgid % nig) % WGM); fpn = (wgid % nig) / WGM; }
        const int pidx = full ? 0 : L - 256, tile = pidx / npc, pc = pidx - tile * npc;
        u.pm = full ? fpm : 32 + (tile >> 3); u.pn = full ? fpn : (tile & 7); u.kt0 = full ? 0 : pc * pk; u.nkt = full ? ntk : pk; u.piece = full ? -1 : pc;
        return full || pidx < 16 * npc;
    }
};

template <class Epi, class Sched>
__device__ __forceinline__ void gemm_phase(LAS unsigned char* lds, const Gemm g, const Sched& S, const Epi& E) {
    const int tid = threadIdx.x, wid = __builtin_amdgcn_readfirstlane(tid >> 6), lane = tid & 63, wr = wid >> 2, wc = wid & 3, fr = lane & 15, fq = lane >> 4;
    unsigned voffA[2], voffB[2];
#pragma unroll
    for (int i = 0; i < 2; ++i) { int R, C; stage_rc(tid * 16 + i * 8192, R, C); const int Rb = Epi::PERM ? ((R & ~31) + perm32(R & 31)) : R;
        voffA[i] = (unsigned)(R * g.lda + C) * 2u; voffB[i] = (unsigned)(Rb * g.ldb + C) * 2u; }
    const size_t kstep = (size_t)(BK * 2);
    const size_t hstepA = g.a_half ? g.a_half : (size_t)HALF * g.lda * 2, hstepB = g.b_half ? g.b_half : (size_t)HALF * g.ldb * 2;
    const size_t tstepA = g.a_tile ? g.a_tile : (size_t)BM * g.lda * 2, tstepB = g.b_tile ? g.b_tile : (size_t)BM * g.ldb * 2;
    const unsigned ldsw = (unsigned)wid * 1024u;
    const int aoff = lds_byte(wr * 64 + fr, fq * 8), boff = lds_byte(wc * 32 + fr, fq * 8);
#define PG8_SA(b, h) (((b) * 2 + (h)) * HTB)
#define PG8_SB(b, h) ((4 + (b) * 2 + (h)) * HTB)
#define PG8_STAGE(bufoff, gbase, voff) do { _Pragma("unroll") for (int _i = 0; _i < 2; ++_i) \
        __builtin_amdgcn_global_load_lds((const unsigned*)((const char*)(gbase) + (voff)[_i]), (LAS unsigned*)(lds + (bufoff) + ldsw + _i * 8192), 16, 0, 0); } while (0)
#define PG8_LDA(dst, b, h) do { _Pragma("unroll") for (int m = 0; m < 4; ++m) _Pragma("unroll") for (int k = 0; k < 2; ++k) dst[m][k] = *(const LAS bf16x8*)(lds + PG8_SA(b, h) + aoff + m * 2048 + k * 1024); } while (0)
#define PG8_LDB(dst, b, h) do { _Pragma("unroll") for (int n = 0; n < 2; ++n) _Pragma("unroll") for (int k = 0; k < 2; ++k) dst[n][k] = *(const LAS bf16x8*)(lds + PG8_SB(b, h) + boff + n * 2048 + k * 1024); } while (0)
#define PG8_MMA(ai, bj, At, Bt) do { __builtin_amdgcn_s_setprio(1); _Pragma("unroll") for (int m = 0; m < 4; ++m) _Pragma("unroll") for (int n = 0; n < 2; ++n) _Pragma("unroll") for (int k = 0; k < 2; ++k) \
        acc[ai][bj][m][n] = __builtin_amdgcn_mfma_f32_16x16x32_bf16(Bt[n][k], At[m][k], acc[ai][bj][m][n], 0, 0, 0); __builtin_amdgcn_s_setprio(0); } while (0)
#define PG8_WAIT_V(n) asm volatile("s_waitcnt vmcnt(" #n ")" ::: "memory")
#define PG8_WAIT_L(n) asm volatile("s_waitcnt lgkmcnt(" #n ")" ::: "memory")
#define PG8_BAR __builtin_amdgcn_s_barrier()
#define PG8_SCHED __builtin_amdgcn_sched_barrier(0)
    Unit cur, nxt; int ui = 0;
    if (!S.next(0, cur)) return;
    f32x4 acc[2][2][4][2];
#pragma unroll
    for (int a = 0; a < 2; ++a)
#pragma unroll
        for (int b = 0; b < 2; ++b)
#pragma unroll
            for (int m = 0; m < 4; ++m)
#pragma unroll
                for (int n = 0; n < 2; ++n) acc[a][b][m][n] = (f32x4){0.f, 0.f, 0.f, 0.f};
    bf16x8 At[4][2], B0[2][2], B1[2][2];
    const char* cA = (const char*)g.A + (size_t)cur.pm * tstepA + (size_t)cur.pn * g.a_pn_off + (size_t)cur.kt0 * kstep; const char* cB = (const char*)g.Bt + (size_t)cur.pn * tstepB + (size_t)cur.kt0 * kstep;
    PG8_STAGE(PG8_SB(0, 0), cB, voffB); PG8_STAGE(PG8_SA(0, 0), cA, voffA); PG8_STAGE(PG8_SB(0, 1), cB + hstepB, voffB); PG8_STAGE(PG8_SA(0, 1), cA + hstepA, voffA);
    if (wr == 1) PG8_BAR;
    PG8_WAIT_V(4); PG8_BAR;
    PG8_STAGE(PG8_SB(1, 0), cB + kstep, voffB); PG8_STAGE(PG8_SA(1, 0), cA + kstep, voffA); PG8_STAGE(PG8_SB(1, 1), cB + hstepB + kstep, voffB);
    PG8_WAIT_V(6); PG8_BAR;
    for (;;) {
        const bool has_next = S.next(ui + 1, nxt);
        const char* nA = has_next ? (const char*)g.A + (size_t)nxt.pm * tstepA + (size_t)nxt.pn * g.a_pn_off + (size_t)nxt.kt0 * kstep : cA; const char* nB = has_next ? (const char*)g.Bt + (size_t)nxt.pn * tstepB + (size_t)nxt.kt0 * kstep : cB;
        const int nt = cur.nkt;
#pragma unroll 1
        for (int t = 0; t < nt; t += 2) {
            const bool last = (t == nt - 2);
            const char* a1 = cA + (size_t)(t + 1) * kstep;
            const char* a2 = last ? nA : cA + (size_t)(t + 2) * kstep; const char* b2 = last ? nB : cB + (size_t)(t + 2) * kstep;
            const char* a3 = a2 + kstep; const char* b3 = b2 + kstep;
            PG8_LDB(B0, 0, 0); PG8_SCHED; PG8_LDA(At, 0, 0); PG8_STAGE(PG8_SA(1, 1), a1 + hstepA, voffA);
            PG8_WAIT_L(8); PG8_BAR; PG8_WAIT_L(0); PG8_MMA(0, 0, At, B0); PG8_BAR; PG8_SCHED;
            PG8_LDB(B1, 0, 1); PG8_STAGE(PG8_SB(0, 0), b2, voffB);
            PG8_BAR; PG8_WAIT_L(0); if constexpr (!Epi::DIAG) PG8_MMA(0, 1, At, B1); PG8_BAR;
            PG8_LDA(At, 0, 1); PG8_STAGE(PG8_SA(0, 0), a2, voffA);
            PG8_BAR; PG8_WAIT_L(0); if constexpr (!Epi::DIAG) PG8_MMA(1, 0, At, B0); PG8_BAR; PG8_SCHED;
            PG8_STAGE(PG8_SB(0, 1), b2 + hstepB, voffB);
            PG8_WAIT_V(6); PG8_BAR; PG8_MMA(1, 1, At, B1); PG8_BAR;
            PG8_LDB(B0, 1, 0); PG8_SCHED; PG8_LDA(At, 1, 0); PG8_STAGE(PG8_SA(0, 1), a2 + hstepA, voffA);
            PG8_WAIT_L(8); PG8_BAR; PG8_WAIT_L(0); PG8_MMA(0, 0, At, B0); PG8_BAR; PG8_SCHED;
            PG8_LDB(B1, 1, 1); PG8_STAGE(PG8_SB(1, 0), b3, voffB);
            PG8_BAR; PG8_WAIT_L(0); if constexpr (!Epi::DIAG) PG8_MMA(0, 1, At, B1); PG8_BAR;
            PG8_LDA(At, 1, 1); PG8_STAGE(PG8_SA(1, 0), a3, voffA);
            PG8_BAR; PG8_WAIT_L(0); if constexpr (!Epi::DIAG) PG8_MMA(1, 0, At, B0); PG8_BAR; PG8_SCHED;
            PG8_STAGE(PG8_SB(1, 1), b3 + hstepB, voffB);
            PG8_WAIT_V(6); PG8_BAR; PG8_MMA(1, 1, At, B1); PG8_BAR;
        }
        E(acc, cur, wr, wc, fr, fq);
        if (!has_next) break;
#pragma unroll
        for (int a = 0; a < 2; ++a)
#pragma unroll
            for (int b = 0; b < 2; ++b)
#pragma unroll
                for (int m = 0; m < 4; ++m)
#pragma unroll
                    for (int n = 0; n < 2; ++n) acc[a][b][m][n] = (f32x4){0.f, 0.f, 0.f, 0.f};
        cur = nxt; cA = nA; cB = nB; ++ui;
    }
    PG8_WAIT_V(0);
    if (wr == 0) PG8_BAR;
    PG8_BAR;
#undef PG8_SA
#undef PG8_SB
#undef PG8_STAGE
#undef PG8_LDA
#undef PG8_LDB
#undef PG8_MMA
#undef PG8_WAIT_V
#undef PG8_WAIT_L
#undef PG8_BAR
#undef PG8_SCHED
}

typedef f32x4 Acc[2][2][4][2];

struct EpiAda {
    static constexpr bool PERM = false, MID = false, DIAG = false;
    float* C; const float* bias;
    __device__ __forceinline__ void operator()(const Acc& acc, const Unit& u, int wr, int wc, int fr, int fq) const {
        const int row0 = wr * 64 + fr, col0 = u.pn * BM + wc * 32 + 4 * fq;
#pragma unroll
        for (int ai = 0; ai < 2; ++ai)
#pragma unroll
            for (int m = 0; m < 4; ++m) { const int row = row0 + ai * HALF + m * 16; if (row < NB) {
#pragma unroll
                for (int bj = 0; bj < 2; ++bj)
#pragma unroll
                    for (int n = 0; n < 2; ++n) { const int c = col0 + bj * HALF + n * 16; *(f32x4*)(C + (size_t)row * MODW + c) = acc[ai][bj][m][n] + *(const f32x4*)(bias + c); } } }
    }
};
struct EpiBf16 {
    static constexpr bool PERM = true, MID = false, DIAG = false;
    bf16_t* O; int ldc; int col_off; const float* scale;
    __device__ __forceinline__ void operator()(const Acc& acc, const Unit& u, int wr, int wc, int fr, int fq) const {
        const int row0 = u.pm * BM + wr * 64 + fr, col0 = u.pn * BM + wc * 32 + 8 * fq;
#pragma unroll
        for (int ai = 0; ai < 2; ++ai)
#pragma unroll
            for (int m = 0; m < 4; ++m) { bf16_t* rowp = O + (size_t)(row0 + ai * HALF + m * 16) * ldc + col_off + col0;
#pragma unroll
                for (int bj = 0; bj < 2; ++bj) { f32x4 v0 = acc[ai][bj][m][0], v1 = acc[ai][bj][m][1];
                    if (scale) { v0 *= *(const f32x4*)(scale + col0 + bj * HALF); v1 *= *(const f32x4*)(scale + col0 + bj * HALF + 4); }
                    u32x4 w; w.x = pk2(v0[0], v0[1]); w.y = pk2(v0[2], v0[3]); w.z = pk2(v1[0], v1[1]); w.w = pk2(v1[2], v1[3]);
                    *(u32x4*)(rowp + bj * HALF) = w; }
                if (scale) asm volatile("" ::: "memory"); }
    }
};
struct EpiG1 {
    static constexpr bool PERM = true, MID = false, DIAG = false;
    float* T1; const bf16_t* proj;
    __device__ __forceinline__ void operator()(const Acc& acc, const Unit& u, int wr, int wc, int fr, int fq) const {
        const int row0 = u.pm * BM + wr * 64 + fr, col0 = u.pn * BM + wc * 32 + 8 * fq;
#pragma unroll
        for (int ai = 0; ai < 2; ++ai)
#pragma unroll
            for (int m = 0; m < 4; ++m) { const size_t row = (size_t)(row0 + ai * HALF + m * 16); const bf16_t* pr = proj + row * NPROJ + col0;
#pragma unroll
                for (int bj = 0; bj < 2; ++bj) { float ga[8]; unpack8(*(const u32x4*)(pr + C_GA + bj * HALF), ga); f32x4 v0, v1;
#pragma unroll
                    for (int j = 0; j < 4; ++j) { v0[j] = acc[ai][bj][m][0][j] * __builtin_amdgcn_rcpf(1.0f + __expf(-ga[j])); v1[j] = acc[ai][bj][m][1][j] * __builtin_amdgcn_rcpf(1.0f + __expf(-ga[4 + j])); }
                    float* o = T1 + row * DM + col0 + bj * HALF; *(f32x4*)o = v0; *(f32x4*)(o + 4) = v1; }
                }
    }
};
struct EpiG2 {
    static constexpr bool PERM = true, MID = false, DIAG = false;
    bf16_t* O; const float* T1; const bf16_t* proj;
    __device__ __forceinline__ void operator()(const Acc& acc, const Unit& u, int wr, int wc, int fr, int fq) const {
        const int row0 = u.pm * BM + wr * 64 + fr, col0 = u.pn * BM + wc * 32 + 8 * fq;
#pragma unroll
        for (int ai = 0; ai < 2; ++ai)
#pragma unroll
            for (int m = 0; m < 4; ++m) { const size_t row = (size_t)(row0 + ai * HALF + m * 16); const bf16_t* pr = proj + row * NPROJ + col0;
#pragma unroll
                for (int bj = 0; bj < 2; ++bj) { float gb[8], v[8]; unpack8(*(const u32x4*)(pr + C_GB + bj * HALF), gb);
                    const float* t = T1 + row * DM + col0 + bj * HALF; const f32x4 t0 = *(const f32x4*)t, t1 = *(const f32x4*)(t + 4);
#pragma unroll
                    for (int j = 0; j < 4; ++j) { v[j] = t0[j] + acc[ai][bj][m][0][j] * __builtin_amdgcn_rcpf(1.0f + __expf(-gb[j])); v[4 + j] = t1[j] + acc[ai][bj][m][1][j] * __builtin_amdgcn_rcpf(1.0f + __expf(-gb[4 + j])); }
                    *(u32x4*)(O + row * DM + col0 + bj * HALF) = pack8(v); }
                if (m & 1) asm volatile("" ::: "memory"); }
    }
};
struct EpiG12 {
    static constexpr bool PERM = true, MID = false, DIAG = false;
    EpiG1 e1; EpiG2 e2;
    __device__ __forceinline__ void operator()(const Acc& acc, const Unit& u, int wr, int wc, int fr, int fq) const { if (u.piece == 0) e1(acc, u, wr, wc, fr, fq); else e2(acc, u, wr, wc, fr, fq); }
};
struct EpiDiag {
    static constexpr bool PERM = true, MID = false, DIAG = true;
    bf16_t* O; const bf16_t* proj;
    __device__ __forceinline__ void operator()(const Acc& acc, const Unit& u, int wr, int wc, int fr, int fq) const {
        const int row0 = u.pm * HALF + wr * 64 + fr, col0 = u.pn * HALF + wc * 32 + 8 * fq;
#pragma unroll
        for (int m = 0; m < 4; ++m) { const size_t row = (size_t)(row0 + m * 16); const bf16_t* pr = proj + row * NPROJ + col0;
            float ga[8], gb[8], v[8]; unpack8(*(const u32x4*)(pr + C_GA), ga); unpack8(*(const u32x4*)(pr + C_GB), gb);
#pragma unroll
            for (int n = 0; n < 2; ++n)
#pragma unroll
                for (int j = 0; j < 4; ++j) v[4 * n + j] = acc[0][0][m][n][j] * __builtin_amdgcn_rcpf(1.0f + __expf(-ga[4 * n + j])) + acc[1][1][m][n][j] * __builtin_amdgcn_rcpf(1.0f + __expf(-gb[4 * n + j]));
            *(u32x4*)(O + row * DM + col0) = pack8(v); }
    }
};
struct EpiRes {
    static constexpr bool PERM = false, MID = false, DIAG = false;
    float* X1; const float* x0p; const float* x0s; const float* gate; float* PB;
    __device__ __forceinline__ void operator()(const Acc& acc, const Unit& u, int wr, int wc, int fr, int fq) const {
        const int row0 = u.pm * BM + wr * 64 + fr, col0 = u.pn * BM + wc * 32 + 4 * fq;
        if (u.piece >= 0) {
            float* pb = PB + (size_t)u.piece * TS * DM;
#pragma unroll
            for (int ai = 0; ai < 2; ++ai)
#pragma unroll
                for (int m = 0; m < 4; ++m) { float* orow = pb + (size_t)(row0 + ai * HALF + m * 16 - TP) * DM;
#pragma unroll
                    for (int bj = 0; bj < 2; ++bj)
#pragma unroll
                        for (int n = 0; n < 2; ++n) *(f32x4*)(orow + col0 + bj * HALF + n * 16) = acc[ai][bj][m][n]; }
            return;
        }
#pragma unroll
        for (int ai = 0; ai < 2; ++ai)
#pragma unroll
            for (int m = 0; m < 4; ++m) { const int row = row0 + ai * HALF + m * 16; const int b = bidx_of_row(row);
                const float* xr = (row < TP) ? x0p + (size_t)row * DM : x0s + (size_t)(row - TP) * DM; const float* gr = gate + (size_t)b * MODW; float* orow = X1 + (size_t)row * DM;
#pragma unroll
                for (int bj = 0; bj < 2; ++bj)
#pragma unroll
                    for (int n = 0; n < 2; ++n) { const int c = col0 + bj * HALF + n * 16; const f32x4 xv = *(const f32x4*)(xr + c), gv = *(const f32x4*)(gr + c);
                        *(f32x4*)(orow + c) = xv + gv * acc[ai][bj][m][n]; } }
    }
};
struct EpiGU {
    static constexpr bool PERM = true, MID = false, DIAG = false;
    bf16_t* O;
    __device__ __forceinline__ void operator()(const Acc& acc, const Unit& u, int wr, int wc, int fr, int fq) const {
        const int row0 = u.pm * BM + wr * 64 + fr, col0 = u.pn * HALF + wc * 32 + 8 * fq;
#pragma unroll
        for (int ai = 0; ai < 2; ++ai)
#pragma unroll
            for (int m = 0; m < 4; ++m) { float v[8];
#pragma unroll
                for (int n = 0; n < 2; ++n)
#pragma unroll
                    for (int j = 0; j < 4; ++j) { const float gt = acc[ai][0][m][n][j]; v[4 * n + j] = gt * __builtin_amdgcn_rcpf(1.0f + __expf(-gt)) * acc[ai][1][m][n][j]; }
                *(u32x4*)(O + (size_t)(row0 + ai * HALF + m * 16) * DFF + col0) = pack8(v); }
    }
};
}

struct TJob { const float* src; bf16_t* dst; int ld_src, K, Nout, ld_dst, map, pad; };
__device__ __forceinline__ int map_col(int map, int n) {
    if (map == 1) { if (n < 4096) return n; if (n < 5120) return 4112 + (n - 4096); if (n < 9216) return 5136 + (n - 5120); if (n < 9232) return 4096 + (n - 9216); return -1; }
    if (map == 2) { const int pn = n >> 8, w = n & 255; return w < 128 ? 128 * pn + w : DFF + 128 * pn + (w - 128); }
    return n;
}
__device__ __forceinline__ void tjob_load(const TJob& j, int tile, f32x4 (&v)[4]) {
    const int tid = threadIdx.x, nkt = j.K >> 7, tn = tile / nkt, tk = tile - tn * nkt;
    const int n = tn * 64 + (tid & 15) * 4, kr = tid >> 4, col = map_col(j.map, n);
#pragma unroll
    for (int i = 0; i < 4; ++i) v[i] = col >= 0 ? __builtin_nontemporal_load((const f32x4*)(j.src + (size_t)(tk * 128 + kr + 32 * i) * j.ld_src + col)) : (f32x4){0.f, 0.f, 0.f, 0.f};
}
__device__ __forceinline__ void tjob_store(const TJob& j, int tile, const f32x4 (&v)[4], LAS float* s) {
    const int tid = threadIdx.x, nkt = j.K >> 7, tn = tile / nkt, tk = tile - tn * nkt;
    const int nq = tid & 15, kr = tid >> 4;
    __syncthreads();
#pragma unroll
    for (int i = 0; i < 4; ++i)
#pragma unroll
        for (int q = 0; q < 4; ++q) s[(4 * nq + q) * 129 + kr + 32 * i] = v[i][q];
    __syncthreads();
    const int n = tid >> 3, k16 = (tid & 7) * 16;
    float f[16];
#pragma unroll
    for (int i = 0; i < 16; ++i) f[i] = s[n * 129 + k16 + i];
    bf16_t* d = j.dst + (size_t)(tn * 64 + n) * j.ld_dst + tk * 128 + k16;
    *(u32x4*)d = pack8(f); *(u32x4*)(d + 8) = pack8(f + 8);
}
__device__ __forceinline__ void transpose_jobs(const TJob* jobs, int njobs, int bi, int nblk, LAS unsigned char* lds) {
    LAS float* s = (LAS float*)lds;
    int total = 0;
    for (int q = 0; q < njobs; ++q) total += (jobs[q].Nout >> 6) * (jobs[q].K >> 7);
    f32x4 v[4]; int curj = 0, base = 0;
    int t = bi;
    auto locate = [&](int tt, int& jj, int& bb) { while (tt >= bb + (jobs[jj].Nout >> 6) * (jobs[jj].K >> 7)) { bb += (jobs[jj].Nout >> 6) * (jobs[jj].K >> 7); ++jj; } };
    if (t < total) { locate(t, curj, base); tjob_load(jobs[curj], t - base, v); }
    while (t < total) {
        const int tn = t + nblk; int nj = curj, nb = base; f32x4 w[4];
        if (tn < total) { locate(tn, nj, nb); tjob_load(jobs[nj], tn - nb, w); }
        tjob_store(jobs[curj], t - base, v, s);
        if (tn < total) {
#pragma unroll
            for (int i = 0; i < 4; ++i) v[i] = w[i]; }
        t = tn; curj = nj; base = nb;
    }
    __syncthreads();
}

template <int MODE>
__device__ __forceinline__ void norm_phase(const Params& p, int bid, int nblk) {
    const int lane = threadIdx.x & 63, wid = __builtin_amdgcn_readfirstlane(threadIdx.x >> 6);
    const float* mod = (const float*)(p.ws + WS_MOD);
    const float* gain = MODE == 0 ? p.in[9] : (MODE == 1 ? p.in[20] : p.in[23]);
    bf16_t* U = (bf16_t*)(p.ws + WS_U);
    for (int row = bid * 8 + wid; row < TT; row += nblk * 8) {
        const float* src = MODE == 0 ? (row < TP ? p.in[0] + (size_t)row * DM : p.in[1] + (size_t)(row - TP) * DM) : p.out + O_Y + (size_t)row * DM;
        if (MODE != 0 && row >= TP) {
            const float* xs = p.in[1] + (size_t)(row - TP) * DM;
            const float* pb = (const float*)(p.ws + (MODE == 1 ? WS_PB10 : WS_PB13)) + (size_t)(row - TP) * DM;
            const float* gt = mod + (size_t)bidx_of_row(row) * MODW + (MODE == 1 ? 4096 : 10240);
            float* xo = p.out + O_Y + (size_t)row * DM;
            constexpr int NPC = MODE == 1 ? 8 : 11;
#pragma unroll 1
            for (int i = 0; i < 8; ++i) { const int c = i * 256 + lane * 4; f32x4 s = *(const f32x4*)(pb + c);
#pragma unroll
                for (int q = 1; q < NPC; ++q) s += *(const f32x4*)(pb + (size_t)q * TS * DM + c);
                const f32x4 base = MODE == 1 ? *(const f32x4*)(xs + c) : *(const f32x4*)(xo + c);
                *(f32x4*)(xo + c) = base + *(const f32x4*)(gt + c) * s; }
            asm volatile("s_waitcnt vmcnt(0)" ::: "memory");
        }
        f32x4 v[8], g[8], s1[8], s0[8]; float ss = 0.f;
        const float* sh = mod + (size_t)bidx_of_row(row) * MODW + (MODE == 0 ? 0 : 6144); const float* sc = sh + 2048;
#pragma unroll
        for (int i = 0; i < 8; ++i) v[i] = *(const f32x4*)(src + i * 256 + lane * 4);
#pragma unroll
        for (int i = 0; i < 8; ++i) { const int c = i * 256 + lane * 4; g[i] = *(const f32x4*)(gain + c); if (MODE != 2) { s1[i] = *(const f32x4*)(sc + c); s0[i] = *(const f32x4*)(sh + c); } }
        asm volatile("" ::: "memory");
#pragma unroll
        for (int i = 0; i < 8; ++i) ss += v[i][0] * v[i][0] + v[i][1] * v[i][1] + v[i][2] * v[i][2] + v[i][3] * v[i][3];
#pragma unroll
        for (int o = 32; o >= 1; o >>= 1) ss += __shfl_xor(ss, o);
        const float rstd = rsqrtf(ss * (1.0f / DM) + EPS);
        if (MODE == 2) {
            float* dst = p.out + O_Y + (size_t)row * DM;
#pragma unroll
            for (int i = 0; i < 8; ++i) *(f32x4*)(dst + i * 256 + lane * 4) = v[i] * rstd * g[i];
        } else {
#pragma unroll
            for (int i = 0; i < 8; ++i) { const int c = i * 256 + lane * 4;
                const f32x4 y = (v[i] * rstd * g[i]) * (1.0f + s1[i]) + s0[i]; u32x2 w; w.x = pk2(y[0], y[1]); w.y = pk2(y[2], y[3]); *(u32x2*)(U + (size_t)row * DM + c) = w; }
        }
    }
}

template <int NTOK, bool SMP>
__device__ __forceinline__ void mixer_item(const Params& p, int it) {
    const int tid = threadIdx.x;
    const bf16_t* proj = (const bf16_t*)(p.ws + WS_PROJ);
    bf16_t* qn = (bf16_t*)(p.ws + WS_QN); bf16_t* kn = (bf16_t*)(p.ws + WS_KN); bf16_t* vv = (bf16_t*)(p.ws + WS_VV); bf16_t* yp = (bf16_t*)(p.ws + WS_YP);
    float* gbuf = (float*)(p.ws + WS_G); float* bbuf = (float*)(p.ws + WS_BETA);
    const int sb = it - 512;
    const int b = SMP ? 0 : (it >> 7), t0 = SMP ? 0 : (it & 127) * 16;
    const int rowbase = SMP ? TP + sb * 4 : b * 2048 + t0;
    if (tid < 384) {
        const int c0 = tid * 8;
        float w0[8], w1[8], w2[8], w3[8], xm3[8], xm2[8], xm1[8];
        const float* cw = p.in[11];
#pragma unroll
        for (int i = 0; i < 8; ++i) { w0[i] = cw[c0 + i]; w1[i] = cw[3072 + c0 + i]; w2[i] = cw[6144 + c0 + i]; w3[i] = cw[9216 + c0 + i]; }
        if (SMP) { const float* sc = p.in[5] + (size_t)sb * 3 * 3072 + c0;
#pragma unroll
            for (int i = 0; i < 8; ++i) { xm3[i] = sc[i]; xm2[i] = sc[3072 + i]; xm1[i] = sc[6144 + i]; }
        } else if (t0 == 0) {
#pragma unroll
            for (int i = 0; i < 8; ++i) { xm3[i] = 0.f; xm2[i] = 0.f; xm1[i] = 0.f; }
        } else {
            unpack8(*(const u32x4*)(proj + (size_t)(rowbase - 3) * NPROJ + c0), xm3); unpack8(*(const u32x4*)(proj + (size_t)(rowbase - 2) * NPROJ + c0), xm2); unpack8(*(const u32x4*)(proj + (size_t)(rowbase - 1) * NPROJ + c0), xm1);
        }
        constexpr int CH = NTOK < 8 ? NTOK : 8;
#pragma unroll
        for (int tc = 0; tc < NTOK; tc += CH) {
        u32x4 xr[CH];
#pragma unroll
        for (int t = 0; t < CH; ++t) xr[t] = *(const u32x4*)(proj + (size_t)(rowbase + tc + t) * NPROJ + c0);
#pragma unroll
        for (int t2 = 0; t2 < CH; ++t2) {
            const int t = tc + t2;
            const int row = rowbase + t; float xt[8], y[8];
            unpack8(xr[t2], xt);
            float ss = 0.f;
#pragma unroll
            for (int i = 0; i < 8; ++i) { const float a = w0[i] * xm3[i] + w1[i] * xm2[i] + w2[i] * xm1[i] + w3[i] * xt[i]; y[i] = siluf_(a); ss += y[i] * y[i]; }
            if (c0 < 2048) {
                ss += __shfl_xor(ss, 1); ss += __shfl_xor(ss, 2); ss += __shfl_xor(ss, 4); ss += __shfl_xor(ss, 8);
                const float inv = rsqrtf(ss + EPS);
#pragma unroll
                for (int i = 0; i < 8; ++i) y[i] *= inv;
            }
            bf16_t* dst = c0 < 1024 ? qn + (size_t)row * 1024 + c0 : (c0 < 2048 ? kn + (size_t)row * 1024 + (c0 - 1024) : vv + (size_t)row * 1024 + (c0 - 2048));
            *(u32x4*)dst = pack8(y);
            if (SMP) { if (t >= 1) { float* o = p.out + O_CS + ((size_t)sb * 3 + (t - 1)) * 3072 + c0; *(f32x4*)o = (f32x4){xt[0], xt[1], xt[2], xt[3]}; *(f32x4*)(o + 4) = (f32x4){xt[4], xt[5], xt[6], xt[7]}; } }
            else if (t0 + t >= 2045) { float* o = p.out + O_CP + ((size_t)b * 3 + (t0 + t - 2045)) * 3072 + c0; *(f32x4*)o = (f32x4){xt[0], xt[1], xt[2], xt[3]}; *(f32x4*)(o + 4) = (f32x4){xt[4], xt[5], xt[6], xt[7]}; }
#pragma unroll
            for (int i = 0; i < 8; ++i) { xm3[i] = xm2[i]; xm2[i] = xm1[i]; xm1[i] = xt[i]; }
        }
        }
    } else {
        const int pc = (tid - 384) * 8, gi = pc >> 8, w = 2 << gi;
        const int seqrow0 = SMP ? TP + sb * 4 : b * 2048;
        const float* sp = p.in[6] + (size_t)sb * 15 * 1024 + pc;
        auto xpool = [&](int tt, float* f) {
            if (tt >= 0) unpack8(*(const u32x4*)(proj + (size_t)(seqrow0 + tt) * NPROJ + C_XP + pc), f);
            else if (SMP) { const float* s = sp + (size_t)(15 + tt) * 1024;
#pragma unroll
                for (int i = 0; i < 8; ++i) f[i] = s[i]; }
            else {
#pragma unroll
                for (int i = 0; i < 8; ++i) f[i] = 0.f; }
        };
        float s[8];
#pragma unroll
        for (int i = 0; i < 8; ++i) s[i] = 0.f;
#pragma unroll
        for (int q = 1; q < 16; ++q) if (q < w) { float f[8]; xpool(t0 - q, f);
#pragma unroll
            for (int i = 0; i < 8; ++i) s[i] += f[i]; }
#pragma unroll 4
        for (int t = 0; t < NTOK; ++t) {
            const int tt = t0 + t; float x[8], y[8], f[8];
            xpool(tt, x);
            const float cnt = SMP ? (float)w : (float)min(w, tt + 1); const float ic = 1.0f / cnt;
#pragma unroll
            for (int i = 0; i < 8; ++i) { s[i] += x[i]; y[i] = s[i] * ic - x[i]; }
            *(u32x4*)(yp + (size_t)(seqrow0 + tt) * 1024 + pc) = pack8(y);
            xpool(tt - w + 1, f);
#pragma unroll
            for (int i = 0; i < 8; ++i) s[i] -= f[i];
            if (SMP) { float* o = p.out + O_PS + ((size_t)sb * 15 + 11 + t) * 1024 + pc; *(f32x4*)o = (f32x4){x[0], x[1], x[2], x[3]}; *(f32x4*)(o + 4) = (f32x4){x[4], x[5], x[6], x[7]}; }
            else if (tt >= 2033) { float* o = p.out + O_PP + ((size_t)b * 15 + (tt - 2033)) * 1024 + pc; *(f32x4*)o = (f32x4){x[0], x[1], x[2], x[3]}; *(f32x4*)(o + 4) = (f32x4){x[4], x[5], x[6], x[7]}; }
        }
        if (SMP) {
#pragma unroll
            for (int r = 0; r < 11; ++r) { const float* s2 = sp + (size_t)(4 + r) * 1024; float* o = p.out + O_PS + ((size_t)sb * 15 + r) * 1024 + pc; *(f32x4*)o = *(const f32x4*)s2; *(f32x4*)(o + 4) = *(const f32x4*)(s2 + 4); } }
    }
    if (tid < 256) { const int tk = tid >> 4, jj = tid & 15;
        if (tk < NTOK) { const int row = rowbase + tk; const float val = bf2f(proj[(size_t)row * NPROJ + C_AB + jj]);
            if (jj < 8) { const float xx = val + p.in[13][jj]; const float spl = xx > 20.f ? xx : log1pf(__expf(xx)); gbuf[row * 8 + jj] = -__expf(p.in[12][jj]) * spl; }
            else bbuf[row * 8 + (jj - 8)] = sigmoidf_(val); } }
}
__device__ __forceinline__ void mixer_prep_phase(const Params& p, int bid, int nblk) {
    for (int it = bid; it < 640; it += nblk) { if (it >= 512) mixer_item<4, true>(p, it); else mixer_item<16, false>(p, it); }
}

constexpr int P5_QS = 0, P5_KS = 17408, P5_VS = 34816, P5_MM = 52224, P5_DEC = 68608, P5_BETA = 68864, P5_GRP = 69632;
static_assert(2 * P5_GRP <= LDS_BYTES - 16, "lds");
__device__ __forceinline__ void chunk_prep_phase(const Params& p, int bid, int nblk, LAS unsigned char* lds0) {
    const int tid = threadIdx.x, lane = tid & 63, grp = tid >> 8, lt = tid & 255, lw = __builtin_amdgcn_readfirstlane(tid >> 6) & 3;
    LAS unsigned char* lds = lds0 + grp * P5_GRP;
    const bf16_t* qn = (const bf16_t*)(p.ws + WS_QN); const bf16_t* kn = (const bf16_t*)(p.ws + WS_KN); const bf16_t* vv = (const bf16_t*)(p.ws + WS_VV);
    const float* gbuf = (const float*)(p.ws + WS_G); const float* bbuf = (const float*)(p.ws + WS_BETA);
    bf16_t* wdc = (bf16_t*)(p.ws + WS_WDC); bf16_t* qd = (bf16_t*)(p.ws + WS_QD); bf16_t* kt = (bf16_t*)(p.ws + WS_KT); bf16_t* qk = (bf16_t*)(p.ws + WS_QK);
    float* cdv = (float*)(p.ws + WS_CD); float* ub = p.out + OS_UB;
    LAS float* Mm = (LAS float*)(lds + P5_MM); LAS float* dec = (LAS float*)(lds + P5_DEC); LAS float* bet = (LAS float*)(lds + P5_BETA);
    const float scale = 0.08838834764831845f;
    for (int it0 = bid * 2; it0 < 1024; it0 += nblk * 2) {
        const int item = it0 + grp, n = item & 31, bh = item >> 5, h = bh & 7, b = bh >> 3;
        const int r0 = b * 2048 + n * 64;
        __syncthreads();
#pragma unroll
        for (int i = 0; i < 4; ++i) { const int ch = lt + 256 * i, r = ch >> 4, c8 = (ch & 15) * 8; const size_t go = (size_t)(r0 + r) * 1024 + h * 128 + c8; const int lo = r * 272 + c8 * 2;
            *(LAS u32x4*)(lds + P5_QS + lo) = *(const u32x4*)(qn + go); *(LAS u32x4*)(lds + P5_KS + lo) = *(const u32x4*)(kn + go); *(LAS u32x4*)(lds + P5_VS + lo) = *(const u32x4*)(vv + go); }
        if (lt < 64) {
            float g = gbuf[(r0 + lt) * 8 + h];
#pragma unroll
            for (int o = 1; o < 64; o <<= 1) { const float t = __shfl_up(g, o); if (lane >= o) g += t; }
            dec[lt] = g;
        } else if (lt < 128) bet[lt - 64] = bbuf[(r0 + lt - 64) * 8 + h];
        __syncthreads();
        {
            const int rt = lw, fr = lane & 15, fq = lane >> 4;
#pragma unroll
            for (int mat = 0; mat < 2; ++mat) {
                bf16x8 a[4];
#pragma unroll
                for (int kk = 0; kk < 4; ++kk) a[kk] = *(const LAS bf16x8*)(lds + (mat ? P5_QS : P5_KS) + (rt * 16 + fr) * 272 + (kk * 32 + fq * 8) * 2);
#pragma unroll
                for (int st = 0; st < 4; ++st) {
                    f32x4 d = (f32x4){0.f, 0.f, 0.f, 0.f};
#pragma unroll
                    for (int kk = 0; kk < 4; ++kk) { const bf16x8 bb = *(const LAS bf16x8*)(lds + P5_KS + (st * 16 + fr) * 272 + (kk * 32 + fq * 8) * 2); d = __builtin_amdgcn_mfma_f32_16x16x32_bf16(a[kk], bb, d, 0, 0, 0); }
                    const int s = st * 16 + fr; const float ds = dec[s];
#pragma unroll
                    for (int j = 0; j < 4; ++j) { const int r = rt * 16 + fq * 4 + j; const float dr = dec[r];
                        if (mat == 0) Mm[r * 64 + s] = (r > s) ? bet[r] * d[j] * __expf(dr - ds) : 0.f;
                        else qk[(size_t)item * 4096 + r * 64 + s] = f2bf((r >= s) ? scale * d[j] * __expf(dr - ds) : 0.f); }
                }
            }
        }
        __syncthreads();
        const int w8 = __builtin_amdgcn_readfirstlane(tid >> 6);
        if (w8 < 4) {
            const int g2 = w8 >> 1, c = (w8 & 1) * 64 + lane; const int item2 = it0 + g2;
            LAS unsigned char* lg = lds0 + g2 * P5_GRP; LAS float* Mg = (LAS float*)(lg + P5_MM); LAS float* decg = (LAS float*)(lg + P5_DEC); LAS float* betg = (LAS float*)(lg + P5_BETA);
            f32x2 xy[64]; f32x4 mq[6]; f32x2 ab0, ab1;
            float* up = ub + (size_t)item2 * 8192 + c; bf16_t* wp = wdc + (size_t)item2 * 8192 + c;
            { const float br = betg[0]; ab0 = (f32x2){bf2f(*(const LAS bf16_t*)(lg + P5_VS + 0 + c * 2)) * br, bf2f(*(const LAS bf16_t*)(lg + P5_KS + 0 + c * 2)) * br * __expf(decg[0])}; ab1 = (f32x2){0.f, 0.f}; } xy[0] = ab0; up[0] = xy[0][0]; wp[0] = f2bf(-xy[0][1]);
            mq[0] = *(const LAS f32x4*)(Mg + 64); mq[1] = *(const LAS f32x4*)(Mg + 128); mq[2] = *(const LAS f32x4*)(Mg + 192); mq[3] = *(const LAS f32x4*)(Mg + 256); mq[4] = *(const LAS f32x4*)(Mg + 320); mq[5] = *(const LAS f32x4*)(Mg + 324);
            { const float br = betg[1]; ab0 = (f32x2){bf2f(*(const LAS bf16_t*)(lg + P5_VS + 272 + c * 2)) * br, bf2f(*(const LAS bf16_t*)(lg + P5_KS + 272 + c * 2)) * br * __expf(decg[1])}; ab1 = (f32x2){0.f, 0.f}; } ab0 -= mq[0][0] * xy[0]; xy[1] = ab0 + ab1; up[128] = xy[1][0]; wp[128] = f2bf(-xy[1][1]); mq[0] = *(const LAS f32x4*)(Mg + 384);
            { const float br = betg[2]; ab0 = (f32x2){bf2f(*(const LAS bf16_t*)(lg + P5_VS + 544 + c * 2)) * br, bf2f(*(const LAS bf16_t*)(lg + P5_KS + 544 + c * 2)) * br * __expf(decg[2])}; ab1 = (f32x2){0.f, 0.f}; } ab0 -= mq[1][0] * xy[0]; ab1 -= mq[1][1] * xy[1]; xy[2] = ab0 + ab1; up[256] = xy[2][0]; wp[256] = f2bf(-xy[2][1]); mq[1] = *(const LAS f32x4*)(Mg + 388);
            { const float br = betg[3]; ab0 = (f32x2){bf2f(*(const LAS bf16_t*)(lg + P5_VS + 816 + c * 2)) * br, bf2f(*(const LAS bf16_t*)(lg + P5_KS + 816 + c * 2)) * br * __expf(decg[3])}; ab1 = (f32x2){0.f, 0.f}; } ab0 -= mq[2][0] * xy[0]; ab1 -= mq[2][1] * xy[1]; ab0 -= mq[2][2] * xy[2]; xy[3] = ab0 + ab1; up[384] = xy[3][0]; wp[384] = f2bf(-xy[3][1]); mq[2] = *(const LAS f32x4*)(Mg + 448);
            { const float br = betg[4]; ab0 = (f32x2){bf2f(*(const LAS bf16_t*)(lg + P5_VS + 1088 + c * 2)) * br, bf2f(*(const LAS bf16_t*)(lg + P5_KS + 1088 + c * 2)) * br * __expf(decg[4])}; ab1 = (f32x2){0.f, 0.f}; } ab0 -= mq[3][0] * xy[0]; ab1 -= mq[3][1] * xy[1]; ab0 -= mq[3][2] * xy[2]; ab1 -= mq[3][3] * xy[3]; xy[4] = ab0 + ab1; up[512] = xy[4][0]; wp[512] = f2bf(-xy[4][1]); mq[3] = *(const LAS f32x4*)(Mg + 452);
            { const float br = betg[5]; ab0 = (f32x2){bf2f(*(const LAS bf16_t*)(lg + P5_VS + 1360 + c * 2)) * br, bf2f(*(const LAS bf16_t*)(lg + P5_KS + 1360 + c * 2)) * br * __expf(decg[5])}; ab1 = (f32x2){0.f, 0.f}; } ab0 -= mq[4][0] * xy[0]; ab1 -= mq[4][1] * xy[1]; ab0 -= mq[4][2] * xy[2]; ab1 -= mq[4][3] * xy[3]; mq[4] = *(const LAS f32x4*)(Mg + 512);
            ab0 -= mq[5][0] * xy[4]; xy[5] = ab0 + ab1; up[640] = xy[5][0]; wp[640] = f2bf(-xy[5][1]); mq[5] = *(const LAS f32x4*)(Mg + 516);
            { const float br = betg[6]; ab0 = (f32x2){bf2f(*(const LAS bf16_t*)(lg + P5_VS + 1632 + c * 2)) * br, bf2f(*(const LAS bf16_t*)(lg + P5_KS + 1632 + c * 2)) * br * __expf(decg[6])}; ab1 = (f32x2){0.f, 0.f}; } ab0 -= mq[0][0] * xy[0]; ab1 -= mq[0][1] * xy[1]; ab0 -= mq[0][2] * xy[2]; ab1 -= mq[0][3] * xy[3]; mq[0] = *(const LAS f32x4*)(Mg + 576);
            ab0 -= mq[1][0] * xy[4]; ab1 -= mq[1][1] * xy[5]; xy[6] = ab0 + ab1; up[768] = xy[6][0]; wp[768] = f2bf(-xy[6][1]); mq[1] = *(const LAS f32x4*)(Mg + 580);
            { const float br = betg[7]; ab0 = (f32x2){bf2f(*(const LAS bf16_t*)(lg + P5_VS + 1904 + c * 2)) * br, bf2f(*(const LAS bf16_t*)(lg + P5_KS + 1904 + c * 2)) * br * __expf(decg[7])}; ab1 = (f32x2){0.f, 0.f}; } ab0 -= mq[2][0] * xy[0]; ab1 -= mq[2][1] * xy[1]; ab0 -= mq[2][2] * xy[2]; ab1 -= mq[2][3] * xy[3]; mq[2] = *(const LAS f32x4*)(Mg + 584);
            ab0 -= mq[3][0] * xy[4]; ab1 -= mq[3][1] * xy[5]; ab0 -= mq[3][2] * xy[6]; xy[7] = ab0 + ab1; up[896] = xy[7][0]; wp[896] = f2bf(-xy[7][1]); mq[3] = *(const LAS f32x4*)(Mg + 640);
            { const float br = betg[8]; ab0 = (f32x2){bf2f(*(const LAS bf16_t*)(lg + P5_VS + 2176 + c * 2)) * br, bf2f(*(const LAS bf16_t*)(lg + P5_KS + 2176 + c * 2)) * br * __expf(decg[8])}; ab1 = (f32x2){0.f, 0.f}; } ab0 -= mq[4][0] * xy[0]; ab1 -= mq[4][1] * xy[1]; ab0 -= mq[4][2] * xy[2]; ab1 -= mq[4][3] * xy[3]; mq[4] = *(const LAS f32x4*)(Mg + 644);
            ab0 -= mq[5][0] * xy[4]; ab1 -= mq[5][1] * xy[5]; ab0 -= mq[5][2] * xy[6]; ab1 -= mq[5][3] * xy[7]; xy[8] = ab0 + ab1; up[1024] = xy[8][0]; wp[1024] = f2bf(-xy[8][1]); mq[5] = *(const LAS f32x4*)(Mg + 648);
            { const float br = betg[9]; ab0 = (f32x2){bf2f(*(const LAS bf16_t*)(lg + P5_VS + 2448 + c * 2)) * br, bf2f(*(const LAS bf16_t*)(lg + P5_KS + 2448 + c * 2)) * br * __expf(decg[9])}; ab1 = (f32x2){0.f, 0.f}; } ab0 -= mq[0][0] * xy[0]; ab1 -= mq[0][1] * xy[1]; ab0 -= mq[0][2] * xy[2]; ab1 -= mq[0][3] * xy[3]; mq[0] = *(const LAS f32x4*)(Mg + 704);
            ab0 -= mq[1][0] * xy[4]; ab1 -= mq[1][1] * xy[5]; ab0 -= mq[1][2] * xy[6]; ab1 -= mq[1][3] * xy[7]; mq[1] = *(const LAS f32x4*)(Mg + 708);
            ab0 -= mq[2][0] * xy[8]; xy[9] = ab0 + ab1; up[1152] = xy[9][0]; wp[1152] = f2bf(-xy[9][1]); mq[2] = *(const LAS f32x4*)(Mg + 712);
            { const float br = betg[10]; ab0 = (f32x2){bf2f(*(const LAS bf16_t*)(lg + P5_VS + 2720 + c * 2)) * br, bf2f(*(const LAS bf16_t*)(lg + P5_KS + 2720 + c * 2)) * br * __expf(decg[10])}; ab1 = (f32x2){0.f, 0.f}; } ab0 -= mq[3][0] * xy[0]; ab1 -= mq[3][1] * xy[1]; ab0 -= mq[3][2] * xy[2]; ab1 -= mq[3][3] * xy[3]; mq[3] = *(const LAS f32x4*)(Mg + 768);
            ab0 -= mq[4][0] * xy[4]; ab1 -= mq[4][1] * xy[5]; ab0 -= mq[4][2] * xy[6]; ab1 -= mq[4][3] * xy[7]; mq[4] = *(const LAS f32x4*)(Mg + 772);
            ab0 -= mq[5][0] * xy[8]; ab1 -= mq[5][1] * xy[9]; xy[10] = ab0 + ab1; up[1280] = xy[10][0]; wp[1280] = f2bf(-xy[10][1]); mq[5] = *(const LAS f32x4*)(Mg + 776);
            { const float br = betg[11]; ab0 = (f32x2){bf2f(*(const LAS bf16_t*)(lg + P5_VS + 2992 + c * 2)) * br, bf2f(*(const LAS bf16_t*)(lg + P5_KS + 2992 + c * 2)) * br * __expf(decg[11])}; ab1 = (f32x2){0.f, 0.f}; } ab0 -= mq[0][0] * xy[0]; ab1 -= mq[0][1] * xy[1]; ab0 -= mq[0][2] * xy[2]; ab1 -= mq[0][3] * xy[3]; mq[0] = *(const LAS f32x4*)(Mg + 832);
            ab0 -= mq[1][0] * xy[4]; ab1 -= mq[1][1] * xy[5]; ab0 -= mq[1][2] * xy[6]; ab1 -= mq[1][3] * xy[7]; mq[1] = *(const LAS f32x4*)(Mg + 836);
            ab0 -= mq[2][0] * xy[8]; ab1 -= mq[2][1] * xy[9]; ab0 -= mq[2][2] * xy[10]; xy[11] = ab0 + ab1; up[1408] = xy[11][0]; wp[1408] = f2bf(-xy[11][1]); mq[2] = *(const LAS f32x4*)(Mg + 840);
            { const float br = betg[12]; ab0 = (f32x2){bf2f(*(const LAS bf16_t*)(lg + P5_VS + 3264 + c * 2)) * br, bf2f(*(const LAS bf16_t*)(lg + P5_KS + 3264 + c * 2)) * br * __expf(decg[12])}; ab1 = (f32x2){0.f, 0.f}; } ab0 -= mq[3][0] * xy[0]; ab1 -= mq[3][1] * xy[1]; ab0 -= mq[3][2] * xy[2]; ab1 -= mq[3][3] * xy[3]; mq[3] = *(const LAS f32x4*)(Mg + 844);
            ab0 -= mq[4][0] * xy[4]; ab1 -= mq[4][1] * xy[5]; ab0 -= mq[4][2] * xy[6]; ab1 -= mq[4][3] * xy[7]; mq[4] = *(const LAS f32x4*)(Mg + 896);
            ab0 -= mq[5][0] * xy[8]; ab1 -= mq[5][1] * xy[9]; ab0 -= mq[5][2] * xy[10]; ab1 -= mq[5][3] * xy[11]; xy[12] = ab0 + ab1; up[1536] = xy[12][0]; wp[1536] = f2bf(-xy[12][1]); mq[5] = *(const LAS f32x4*)(Mg + 900);
            { const float br = betg[13]; ab0 = (f32x2){bf2f(*(const LAS bf16_t*)(lg + P5_VS + 3536 + c * 2)) * br, bf2f(*(const LAS bf16_t*)(lg + P5_KS + 3536 + c * 2)) * br * __expf(decg[13])}; ab1 = (f32x2){0.f, 0.f}; } ab0 -= mq[0][0] * xy[0]; ab1 -= mq[0][1] * xy[1]; ab0 -= mq[0][2] * xy[2]; ab1 -= mq[0][3] * xy[3]; mq[0] = *(const LAS f32x4*)(Mg + 904);
            ab0 -= mq[1][0] * xy[4]; ab1 -= mq[1][1] * xy[5]; ab0 -= mq[1][2] * xy[6]; ab1 -= mq[1][3] * xy[7]; mq[1] = *(const LAS f32x4*)(Mg + 908);
            ab0 -= mq[2][0] * xy[8]; ab1 -= mq[2][1] * xy[9]; ab0 -= mq[2][2] * xy[10]; ab1 -= mq[2][3] * xy[11]; mq[2] = *(const LAS f32x4*)(Mg + 960);
            ab0 -= mq[3][0] * xy[12]; xy[13] = ab0 + ab1; up[1664] = xy[13][0]; wp[1664] = f2bf(-xy[13][1]); mq[3] = *(const LAS f32x4*)(Mg + 964);
            { const float br = betg[14]; ab0 = (f32x2){bf2f(*(const LAS bf16_t*)(lg + P5_VS + 3808 + c * 2)) * br, bf2f(*(const LAS bf16_t*)(lg + P5_KS + 3808 + c * 2)) * br * __expf(decg[14])}; ab1 = (f32x2){0.f, 0.f}; } ab0 -= mq[4][0] * xy[0]; ab1 -= mq[4][1] * xy[1]; ab0 -= mq[4][2] * xy[2]; ab1 -= mq[4][3] * xy[3]; mq[4] = *(const LAS f32x4*)(Mg + 968);
            ab0 -= mq[5][0] * xy[4]; ab1 -= mq[5][1] * xy[5]; ab0 -= mq[5][2] * xy[6]; ab1 -= mq[5][3] * xy[7]; mq[5] = *(const LAS f32x4*)(Mg + 972);
            ab0 -= mq[0][0] * xy[8]; ab1 -= mq[0][1] * xy[9]; ab0 -= mq[0][2] * xy[10]; ab1 -= mq[0][3] * xy[11]; mq[0] = *(const LAS f32x4*)(Mg + 1024);
            ab0 -= mq[1][0] * xy[12]; ab1 -= mq[1][1] * xy[13]; xy[14] = ab0 + ab1; up[1792] = xy[14][0]; wp[1792] = f2bf(-xy[14][1]); mq[1] = *(const LAS f32x4*)(Mg + 1028);
            { const float br = betg[15]; ab0 = (f32x2){bf2f(*(const LAS bf16_t*)(lg + P5_VS + 4080 + c * 2)) * br, bf2f(*(const LAS bf16_t*)(lg + P5_KS + 4080 + c * 2)) * br * __expf(decg[15])}; ab1 = (f32x2){0.f, 0.f}; } ab0 -= mq[2][0] * xy[0]; ab1 -= mq[2][1] * xy[1]; ab0 -= mq[2][2] * xy[2]; ab1 -= mq[2][3] * xy[3]; mq[2] = *(const LAS f32x4*)(Mg + 1032);
            ab0 -= mq[3][0] * xy[4]; ab1 -= mq[3][1] * xy[5]; ab0 -= mq[3][2] * xy[6]; ab1 -= mq[3][3] * xy[7]; mq[3] = *(const LAS f32x4*)(Mg + 1036);
            ab0 -= mq[4][0] * xy[8]; ab1 -= mq[4][1] * xy[9]; ab0 -= mq[4][2] * xy[10]; ab1 -= mq[4][3] * xy[11]; mq[4] = *(const LAS f32x4*)(Mg + 1088);
            ab0 -= mq[5][0] * xy[12]; ab1 -= mq[5][1] * xy[13]; ab0 -= mq[5][2] * xy[14]; xy[15] = ab0 + ab1; up[1920] = xy[15][0]; wp[1920] = f2bf(-xy[15][1]); mq[5] = *(const LAS f32x4*)(Mg + 1092);
            { const float br = betg[16]; ab0 = (f32x2){bf2f(*(const LAS bf16_t*)(lg + P5_VS + 4352 + c * 2)) * br, bf2f(*(const LAS bf16_t*)(lg + P5_KS + 4352 + c * 2)) * br * __expf(decg[16])}; ab1 = (f32x2){0.f, 0.f}; } ab0 -= mq[0][0] * xy[0]; ab1 -= mq[0][1] * xy[1]; ab0 -= mq[0][2] * xy[2]; ab1 -= mq[0][3] * xy[3]; mq[0] = *(const LAS f32x4*)(Mg + 1096);
            ab0 -= mq[1][0] * xy[4]; ab1 -= mq[1][1] * xy[5]; ab0 -= mq[1][2] * xy[6]; ab1 -= mq[1][3] * xy[7]; mq[1] = *(const LAS f32x4*)(Mg + 1100);
            ab0 -= mq[2][0] * xy[8]; ab1 -= mq[2][1] * xy[9]; ab0 -= mq[2][2] * xy[10]; ab1 -= mq[2][3] * xy[11]; mq[2] = *(const LAS f32x4*)(Mg + 1104);
            ab0 -= mq[3][0] * xy[12]; ab1 -= mq[3][1] * xy[13]; ab0 -= mq[3][2] * xy[14]; ab1 -= mq[3][3] * xy[15]; xy[16] = ab0 + ab1; up[2048] = xy[16][0]; wp[2048] = f2bf(-xy[16][1]); mq[3] = *(const LAS f32x4*)(Mg + 1152);
            { const float br = betg[17]; ab0 = (f32x2){bf2f(*(const LAS bf16_t*)(lg + P5_VS + 4624 + c * 2)) * br, bf2f(*(const LAS bf16_t*)(lg + P5_KS + 4624 + c * 2)) * br * __expf(decg[17])}; ab1 = (f32x2){0.f, 0.f}; } ab0 -= mq[4][0] * xy[0]; ab1 -= mq[4][1] * xy[1]; ab0 -= mq[4][2] * xy[2]; ab1 -= mq[4][3] * xy[3]; mq[4] = *(const LAS f32x4*)(Mg + 1156);
            ab0 -= mq[5][0] * xy[4]; ab1 -= mq[5][1] * xy[5]; ab0 -= mq[5][2] * xy[6]; ab1 -= mq[5][3] * xy[7]; mq[5] = *(const LAS f32x4*)(Mg + 1160);
            ab0 -= mq[0][0] * xy[8]; ab1 -= mq[0][1] * xy[9]; ab0 -= mq[0][2] * xy[10]; ab1 -= mq[0][3] * xy[11]; mq[0] = *(const LAS f32x4*)(Mg + 1164);
            ab0 -= mq[1][0] * xy[12]; ab1 -= mq[1][1] * xy[13]; ab0 -= mq[1][2] * xy[14]; ab1 -= mq[1][3] * xy[15]; mq[1] = *(const LAS f32x4*)(Mg + 1168);
            ab0 -= mq[2][0] * xy[16]; xy[17] = ab0 + ab1; up[2176] = xy[17][0]; wp[2176] = f2bf(-xy[17][1]); mq[2] = *(const LAS f32x4*)(Mg + 1216);
            { const float br = betg[18]; ab0 = (f32x2){bf2f(*(const LAS bf16_t*)(lg + P5_VS + 4896 + c * 2)) * br, bf2f(*(const LAS bf16_t*)(lg + P5_KS + 4896 + c * 2)) * br * __expf(decg[18])}; ab1 = (f32x2){0.f, 0.f}; } ab0 -= mq[3][0] * xy[0]; ab1 -= mq[3][1] * xy[1]; ab0 -= mq[3][2] * xy[2]; ab1 -= mq[3][3] * xy[3]; mq[3] = *(const LAS f32x4*)(Mg + 1220);
            ab0 -= mq[4][0] * xy[4]; ab1 -= mq[4][1] * xy[5]; ab0 -= mq[4][2] * xy[6]; ab1 -= mq[4][3] * xy[7]; mq[4] = *(const LAS f32x4*)(Mg + 1224);
            ab0 -= mq[5][0] * xy[8]; ab1 -= mq[5][1] * xy[9]; ab0 -= mq[5][2] * xy[10]; ab1 -= mq[5][3] * xy[11]; mq[5] = *(const LAS f32x4*)(Mg + 1228);
            ab0 -= mq[0][0] * xy[12]; ab1 -= mq[0][1] * xy[13]; ab0 -= mq[0][2] * xy[14]; ab1 -= mq[0][3] * xy[15]; mq[0] = *(const LAS f32x4*)(Mg + 1232);
            ab0 -= mq[1][0] * xy[16]; ab1 -= mq[1][1] * xy[17]; xy[18] = ab0 + ab1; up[2304] = xy[18][0]; wp[2304] = f2bf(-xy[18][1]); mq[1] = *(const LAS f32x4*)(Mg + 1280);
            { const float br = betg[19]; ab0 = (f32x2){bf2f(*(const LAS bf16_t*)(lg + P5_VS + 5168 + c * 2)) * br, bf2f(*(const LAS bf16_t*)(lg + P5_KS + 5168 + c * 2)) * br * __expf(decg[19])}; ab1 = (f32x2){0.f, 0.f}; } ab0 -= mq[2][0] * xy[0]; ab1 -= mq[2][1] * xy[1]; ab0 -= mq[2][2] * xy[2]; ab1 -= mq[2][3] * xy[3]; mq[2] = *(const LAS f32x4*)(Mg + 1284);
            ab0 -= mq[3][0] * xy[4]; ab1 -= mq[3][1] * xy[5]; ab0 -= mq[3][2] * xy[6]; ab1 -= mq[3][3] * xy[7]; mq[3] = *(const LAS f32x4*)(Mg + 1288);
            ab0 -= mq[4][0] * xy[8]; ab1 -= mq[4][1] * xy[9]; ab0 -= mq[4][2] * xy[10]; ab1 -= mq[4][3] * xy[11]; mq[4] = *(const LAS f32x4*)(Mg + 1292);
            ab0 -= mq[5][0] * xy[12]; ab1 -= mq[5][1] * xy[13]; ab0 -= mq[5][2] * xy[14]; ab1 -= mq[5][3] * xy[15]; mq[5] = *(const LAS f32x4*)(Mg + 1296);
            ab0 -= mq[0][0] * xy[16]; ab1 -= mq[0][1] * xy[17]; ab0 -= mq[0][2] * xy[18]; xy[19] = ab0 + ab1; up[2432] = xy[19][0]; wp[2432] = f2bf(-xy[19][1]); mq[0] = *(const LAS f32x4*)(Mg + 1344);
            { const float br = betg[20]; ab0 = (f32x2){bf2f(*(const LAS bf16_t*)(lg + P5_VS + 5440 + c * 2)) * br, bf2f(*(const LAS bf16_t*)(lg + P5_KS + 5440 + c * 2)) * br * __expf(decg[20])}; ab1 = (f32x2){0.f, 0.f}; } ab0 -= mq[1][0] * xy[0]; ab1 -= mq[1][1] * xy[1]; ab0 -= mq[1][2] * xy[2]; ab1 -= mq[1][3] * xy[3]; mq[1] = *(const LAS f32x4*)(Mg + 1348);
            ab0 -= mq[2][0] * xy[4]; ab1 -= mq[2][1] * xy[5]; ab0 -= mq[2][2] * xy[6]; ab1 -= mq[2][3] * xy[7]; mq[2] = *(const LAS f32x4*)(Mg + 1352);
            ab0 -= mq[3][0] * xy[8]; ab1 -= mq[3][1] * xy[9]; ab0 -= mq[3][2] * xy[10]; ab1 -= mq[3][3] * xy[11]; mq[3] = *(const LAS f32x4*)(Mg + 1356);
            ab0 -= mq[4][0] * xy[12]; ab1 -= mq[4][1] * xy[13]; ab0 -= mq[4][2] * xy[14]; ab1 -= mq[4][3] * xy[15]; mq[4] = *(const LAS f32x4*)(Mg + 1360);
            ab0 -= mq[5][0] * xy[16]; ab1 -= mq[5][1] * xy[17]; ab0 -= mq[5][2] * xy[18]; ab1 -= mq[5][3] * xy[19]; xy[20] = ab0 + ab1; up[2560] = xy[20][0]; wp[2560] = f2bf(-xy[20][1]); mq[5] = *(const LAS f32x4*)(Mg + 1364);
            { const float br = betg[21]; ab0 = (f32x2){bf2f(*(const LAS bf16_t*)(lg + P5_VS + 5712 + c * 2)) * br, bf2f(*(const LAS bf16_t*)(lg + P5_KS + 5712 + c * 2)) * br * __expf(decg[21])}; ab1 = (f32x2){0.f, 0.f}; } ab0 -= mq[0][0] * xy[0]; ab1 -= mq[0][1] * xy[1]; ab0 -= mq[0][2] * xy[2]; ab1 -= mq[0][3] * xy[3]; mq[0] = *(const LAS f32x4*)(Mg + 1408);
            ab0 -= mq[1][0] * xy[4]; ab1 -= mq[1][1] * xy[5]; ab0 -= mq[1][2] * xy[6]; ab1 -= mq[1][3] * xy[7]; mq[1] = *(const LAS f32x4*)(Mg + 1412);
            ab0 -= mq[2][0] * xy[8]; ab1 -= mq[2][1] * xy[9]; ab0 -= mq[2][2] * xy[10]; ab1 -= mq[2][3] * xy[11]; mq[2] = *(const LAS f32x4*)(Mg + 1416);
            ab0 -= mq[3][0] * xy[12]; ab1 -= mq[3][1] * xy[13]; ab0 -= mq[3][2] * xy[14]; ab1 -= mq[3][3] * xy[15]; mq[3] = *(const LAS f32x4*)(Mg + 1420);
            ab0 -= mq[4][0] * xy[16]; ab1 -= mq[4][1] * xy[17]; ab0 -= mq[4][2] * xy[18]; ab1 -= mq[4][3] * xy[19]; mq[4] = *(const LAS f32x4*)(Mg + 1424);
            ab0 -= mq[5][0] * xy[20]; xy[21] = ab0 + ab1; up[2688] = xy[21][0]; wp[2688] = f2bf(-xy[21][1]); mq[5] = *(const LAS f32x4*)(Mg + 1428);
            { const float br = betg[22]; ab0 = (f32x2){bf2f(*(const LAS bf16_t*)(lg + P5_VS + 5984 + c * 2)) * br, bf2f(*(const LAS bf16_t*)(lg + P5_KS + 5984 + c * 2)) * br * __expf(decg[22])}; ab1 = (f32x2){0.f, 0.f}; } ab0 -= mq[0][0] * xy[0]; ab1 -= mq[0][1] * xy[1]; ab0 -= mq[0][2] * xy[2]; ab1 -= mq[0][3] * xy[3]; mq[0] = *(const LAS f32x4*)(Mg + 1472);
            ab0 -= mq[1][0] * xy[4]; ab1 -= mq[1][1] * xy[5]; ab0 -= mq[1][2] * xy[6]; ab1 -= mq[1][3] * xy[7]; mq[1] = *(const LAS f32x4*)(Mg + 1476);
            ab0 -= mq[2][0] * xy[8]; ab1 -= mq[2][1] * xy[9]; ab0 -= mq[2][2] * xy[10]; ab1 -= mq[2][3] * xy[11]; mq[2] = *(const LAS f32x4*)(Mg + 1480);
            ab0 -= mq[3][0] * xy[12]; ab1 -= mq[3][1] * xy[13]; ab0 -= mq[3][2] * xy[14]; ab1 -= mq[3][3] * xy[15]; mq[3] = *(const LAS f32x4*)(Mg + 1484);
            ab0 -= mq[4][0] * xy[16]; ab1 -= mq[4][1] * xy[17]; ab0 -= mq[4][2] * xy[18]; ab1 -= mq[4][3] * xy[19]; mq[4] = *(const LAS f32x4*)(Mg + 1488);
            ab0 -= mq[5][0] * xy[20]; ab1 -= mq[5][1] * xy[21]; xy[22] = ab0 + ab1; up[2816] = xy[22][0]; wp[2816] = f2bf(-xy[22][1]); mq[5] = *(const LAS f32x4*)(Mg + 1492);
            { const float br = betg[23]; ab0 = (f32x2){bf2f(*(const LAS bf16_t*)(lg + P5_VS + 6256 + c * 2)) * br, bf2f(*(const LAS bf16_t*)(lg + P5_KS + 6256 + c * 2)) * br * __expf(decg[23])}; ab1 = (f32x2){0.f, 0.f}; } ab0 -= mq[0][0] * xy[0]; ab1 -= mq[0][1] * xy[1]; ab0 -= mq[0][2] * xy[2]; ab1 -= mq[0][3] * xy[3]; mq[0] = *(const LAS f32x4*)(Mg + 1536);
            ab0 -= mq[1][0] * xy[4]; ab1 -= mq[1][1] * xy[5]; ab0 -= mq[1][2] * xy[6]; ab1 -= mq[1][3] * xy[7]; mq[1] = *(const LAS f32x4*)(Mg + 1540);
            ab0 -= mq[2][0] * xy[8]; ab1 -= mq[2][1] * xy[9]; ab0 -= mq[2][2] * xy[10]; ab1 -= mq[2][3] * xy[11]; mq[2] = *(const LAS f32x4*)(Mg + 1544);
            ab0 -= mq[3][0] * xy[12]; ab1 -= mq[3][1] * xy[13]; ab0 -= mq[3][2] * xy[14]; ab1 -= mq[3][3] * xy[15]; mq[3] = *(const LAS f32x4*)(Mg + 1548);
            ab0 -= mq[4][0] * xy[16]; ab1 -= mq[4][1] * xy[17]; ab0 -= mq[4][2] * xy[18]; ab1 -= mq[4][3] * xy[19]; mq[4] = *(const LAS f32x4*)(Mg + 1552);
            ab0 -= mq[5][0] * xy[20]; ab1 -= mq[5][1] * xy[21]; ab0 -= mq[5][2] * xy[22]; xy[23] = ab0 + ab1; up[2944] = xy[23][0]; wp[2944] = f2bf(-xy[23][1]); mq[5] = *(const LAS f32x4*)(Mg + 1556);
            { const float br = betg[24]; ab0 = (f32x2){bf2f(*(const LAS bf16_t*)(lg + P5_VS + 6528 + c * 2)) * br, bf2f(*(const LAS bf16_t*)(lg + P5_KS + 6528 + c * 2)) * br * __expf(decg[24])}; ab1 = (f32x2){0.f, 0.f}; } ab0 -= mq[0][0] * xy[0]; ab1 -= mq[0][1] * xy[1]; ab0 -= mq[0][2] * xy[2]; ab1 -= mq[0][3] * xy[3]; mq[0] = *(const LAS f32x4*)(Mg + 1600);
            ab0 -= mq[1][0] * xy[4]; ab1 -= mq[1][1] * xy[5]; ab0 -= mq[1][2] * xy[6]; ab1 -= mq[1][3] * xy[7]; mq[1] = *(const LAS f32x4*)(Mg + 1604);
            ab0 -= mq[2][0] * xy[8]; ab1 -= mq[2][1] * xy[9]; ab0 -= mq[2][2] * xy[10]; ab1 -= mq[2][3] * xy[11]; mq[2] = *(const LAS f32x4*)(Mg + 1608);
            ab0 -= mq[3][0] * xy[12]; ab1 -= mq[3][1] * xy[13]; ab0 -= mq[3][2] * xy[14]; ab1 -= mq[3][3] * xy[15]; mq[3] = *(const LAS f32x4*)(Mg + 1612);
            ab0 -= mq[4][0] * xy[16]; ab1 -= mq[4][1] * xy[17]; ab0 -= mq[4][2] * xy[18]; ab1 -= mq[4][3] * xy[19]; mq[4] = *(const LAS f32x4*)(Mg + 1616);
            ab0 -= mq[5][0] * xy[20]; ab1 -= mq[5][1] * xy[21]; ab0 -= mq[5][2] * xy[22]; ab1 -= mq[5][3] * xy[23]; xy[24] = ab0 + ab1; up[3072] = xy[24][0]; wp[3072] = f2bf(-xy[24][1]); mq[5] = *(const LAS f32x4*)(Mg + 1620);
            { const float br = betg[25]; ab0 = (f32x2){bf2f(*(const LAS bf16_t*)(lg + P5_VS + 6800 + c * 2)) * br, bf2f(*(const LAS bf16_t*)(lg + P5_KS + 6800 + c * 2)) * br * __expf(decg[25])}; ab1 = (f32x2){0.f, 0.f}; } ab0 -= mq[0][0] * xy[0]; ab1 -= mq[0][1] * xy[1]; ab0 -= mq[0][2] * xy[2]; ab1 -= mq[0][3] * xy[3]; mq[0] = *(const LAS f32x4*)(Mg + 1624);
            ab0 -= mq[1][0] * xy[4]; ab1 -= mq[1][1] * xy[5]; ab0 -= mq[1][2] * xy[6]; ab1 -= mq[1][3] * xy[7]; mq[1] = *(const LAS f32x4*)(Mg + 1664);
            ab0 -= mq[2][0] * xy[8]; ab1 -= mq[2][1] * xy[9]; ab0 -= mq[2][2] * xy[10]; ab1 -= mq[2][3] * xy[11]; mq[2] = *(const LAS f32x4*)(Mg + 1668);
            ab0 -= mq[3][0] * xy[12]; ab1 -= mq[3][1] * xy[13]; ab0 -= mq[3][2] * xy[14]; ab1 -= mq[3][3] * xy[15]; mq[3] = *(const LAS f32x4*)(Mg + 1672);
            ab0 -= mq[4][0] * xy[16]; ab1 -= mq[4][1] * xy[17]; ab0 -= mq[4][2] * xy[18]; ab1 -= mq[4][3] * xy[19]; mq[4] = *(const LAS f32x4*)(Mg + 1676);
            ab0 -= mq[5][0] * xy[20]; ab1 -= mq[5][1] * xy[21]; ab0 -= mq[5][2] * xy[22]; ab1 -= mq[5][3] * xy[23]; mq[5] = *(const LAS f32x4*)(Mg + 1680);
            ab0 -= mq[0][0] * xy[24]; xy[25] = ab0 + ab1; up[3200] = xy[25][0]; wp[3200] = f2bf(-xy[25][1]); mq[0] = *(const LAS f32x4*)(Mg + 1684);
            { const float br = betg[26]; ab0 = (f32x2){bf2f(*(const LAS bf16_t*)(lg + P5_VS + 7072 + c * 2)) * br, bf2f(*(const LAS bf16_t*)(lg + P5_KS + 7072 + c * 2)) * br * __expf(decg[26])}; ab1 = (f32x2){0.f, 0.f}; } ab0 -= mq[1][0] * xy[0]; ab1 -= mq[1][1] * xy[1]; ab0 -= mq[1][2] * xy[2]; ab1 -= mq[1][3] * xy[3]; mq[1] = *(const LAS f32x4*)(Mg + 1688);
            ab0 -= mq[2][0] * xy[4]; ab1 -= mq[2][1] * xy[5]; ab0 -= mq[2][2] * xy[6]; ab1 -= mq[2][3] * xy[7]; mq[2] = *(const LAS f32x4*)(Mg + 1728);
            ab0 -= mq[3][0] * xy[8]; ab1 -= mq[3][1] * xy[9]; ab0 -= mq[3][2] * xy[10]; ab1 -= mq[3][3] * xy[11]; mq[3] = *(const LAS f32x4*)(Mg + 1732);
            ab0 -= mq[4][0] * xy[12]; ab1 -= mq[4][1] * xy[13]; ab0 -= mq[4][2] * xy[14]; ab1 -= mq[4][3] * xy[15]; mq[4] = *(const LAS f32x4*)(Mg + 1736);
            ab0 -= mq[5][0] * xy[16]; ab1 -= mq[5][1] * xy[17]; ab0 -= mq[5][2] * xy[18]; ab1 -= mq[5][3] * xy[19]; mq[5] = *(const LAS f32x4*)(Mg + 1740);
            ab0 -= mq[0][0] * xy[20]; ab1 -= mq[0][1] * xy[21]; ab0 -= mq[0][2] * xy[22]; ab1 -= mq[0][3] * xy[23]; mq[0] = *(const LAS f32x4*)(Mg + 1744);
            ab0 -= mq[1][0] * xy[24]; ab1 -= mq[1][1] * xy[25]; xy[26] = ab0 + ab1; up[3328] = xy[26][0]; wp[3328] = f2bf(-xy[26][1]); mq[1] = *(const LAS f32x4*)(Mg + 1748);
            { const float br = betg[27]; ab0 = (f32x2){bf2f(*(const LAS bf16_t*)(lg + P5_VS + 7344 + c * 2)) * br, bf2f(*(const LAS bf16_t*)(lg + P5_KS + 7344 + c * 2)) * br * __expf(decg[27])}; ab1 = (f32x2){0.f, 0.f}; } ab0 -= mq[2][0] * xy[0]; ab1 -= mq[2][1] * xy[1]; ab0 -= mq[2][2] * xy[2]; ab1 -= mq[2][3] * xy[3]; mq[2] = *(const LAS f32x4*)(Mg + 1752);
            ab0 -= mq[3][0] * xy[4]; ab1 -= mq[3][1] * xy[5]; ab0 -= mq[3][2] * xy[6]; ab1 -= mq[3][3] * xy[7]; mq[3] = *(const LAS f32x4*)(Mg + 1792);
            ab0 -= mq[4][0] * xy[8]; ab1 -= mq[4][1] * xy[9]; ab0 -= mq[4][2] * xy[10]; ab1 -= mq[4][3] * xy[11]; mq[4] = *(const LAS f32x4*)(Mg + 1796);
            ab0 -= mq[5][0] * xy[12]; ab1 -= mq[5][1] * xy[13]; ab0 -= mq[5][2] * xy[14]; ab1 -= mq[5][3] * xy[15]; mq[5] = *(const LAS f32x4*)(Mg + 1800);
            ab0 -= mq[0][0] * xy[16]; ab1 -= mq[0][1] * xy[17]; ab0 -= mq[0][2] * xy[18]; ab1 -= mq[0][3] * xy[19]; mq[0] = *(const LAS f32x4*)(Mg + 1804);
            ab0 -= mq[1][0] * xy[20]; ab1 -= mq[1][1] * xy[21]; ab0 -= mq[1][2] * xy[22]; ab1 -= mq[1][3] * xy[23]; mq[1] = *(const LAS f32x4*)(Mg + 1808);
            ab0 -= mq[2][0] * xy[24]; ab1 -= mq[2][1] * xy[25]; ab0 -= mq[2][2] * xy[26]; xy[27] = ab0 + ab1; up[3456] = xy[27][0]; wp[3456] = f2bf(-xy[27][1]); mq[2] = *(const LAS f32x4*)(Mg + 1812);
            { const float br = betg[28]; ab0 = (f32x2){bf2f(*(const LAS bf16_t*)(lg + P5_VS + 7616 + c * 2)) * br, bf2f(*(const LAS bf16_t*)(lg + P5_KS + 7616 + c * 2)) * br * __expf(decg[28])}; ab1 = (f32x2){0.f, 0.f}; } ab0 -= mq[3][0] * xy[0]; ab1 -= mq[3][1] * xy[1]; ab0 -= mq[3][2] * xy[2]; ab1 -= mq[3][3] * xy[3]; mq[3] = *(const LAS f32x4*)(Mg + 1816);
            ab0 -= mq[4][0] * xy[4]; ab1 -= mq[4][1] * xy[5]; ab0 -= mq[4][2] * xy[6]; ab1 -= mq[4][3] * xy[7]; mq[4] = *(const LAS f32x4*)(Mg + 1856);
            ab0 -= mq[5][0] * xy[8]; ab1 -= mq[5][1] * xy[9]; ab0 -= mq[5][2] * xy[10]; ab1 -= mq[5][3] * xy[11]; mq[5] = *(const LAS f32x4*)(Mg + 1860);
            ab0 -= mq[0][0] * xy[12]; ab1 -= mq[0][1] * xy[13]; ab0 -= mq[0][2] * xy[14]; ab1 -= mq[0][3] * xy[15]; mq[0] = *(const LAS f32x4*)(Mg + 1864);
            ab0 -= mq[1][0] * xy[16]; ab1 -= mq[1][1] * xy[17]; ab0 -= mq[1][2] * xy[18]; ab1 -= mq[1][3] * xy[19]; mq[1] = *(const LAS f32x4*)(Mg + 1868);
            ab0 -= mq[2][0] * xy[20]; ab1 -= mq[2][1] * xy[21]; ab0 -= mq[2][2] * xy[22]; ab1 -= mq[2][3] * xy[23]; mq[2] = *(const LAS f32x4*)(Mg + 1872);
            ab0 -= mq[3][0] * xy[24]; ab1 -= mq[3][1] * xy[25]; ab0 -= mq[3][2] * xy[26]; ab1 -= mq[3][3] * xy[27]; xy[28] = ab0 + ab1; up[3584] = xy[28][0]; wp[3584] = f2bf(-xy[28][1]); mq[3] = *(const LAS f32x4*)(Mg + 1876);
            { const float br = betg[29]; ab0 = (f32x2){bf2f(*(const LAS bf16_t*)(lg + P5_VS + 7888 + c * 2)) * br, bf2f(*(const LAS bf16_t*)(lg + P5_KS + 7888 + c * 2)) * br * __expf(decg[29])}; ab1 = (f32x2){0.f, 0.f}; } ab0 -= mq[4][0] * xy[0]; ab1 -= mq[4][1] * xy[1]; ab0 -= mq[4][2] * xy[2]; ab1 -= mq[4][3] * xy[3]; mq[4] = *(const LAS f32x4*)(Mg + 1880);
            ab0 -= mq[5][0] * xy[4]; ab1 -= mq[5][1] * xy[5]; ab0 -= mq[5][2] * xy[6]; ab1 -= mq[5][3] * xy[7]; mq[5] = *(const LAS f32x4*)(Mg + 1884);
            ab0 -= mq[0][0] * xy[8]; ab1 -= mq[0][1] * xy[9]; ab0 -= mq[0][2] * xy[10]; ab1 -= mq[0][3] * xy[11]; mq[0] = *(const LAS f32x4*)(Mg + 1920);
            ab0 -= mq[1][0] * xy[12]; ab1 -= mq[1][1] * xy[13]; ab0 -= mq[1][2] * xy[14]; ab1 -= mq[1][3] * xy[15]; mq[1] = *(const LAS f32x4*)(Mg + 1924);
            ab0 -= mq[2][0] * xy[16]; ab1 -= mq[2][1] * xy[17]; ab0 -= mq[2][2] * xy[18]; ab1 -= mq[2][3] * xy[19]; mq[2] = *(const LAS f32x4*)(Mg + 1928);
            ab0 -= mq[3][0] * xy[20]; ab1 -= mq[3][1] * xy[21]; ab0 -= mq[3][2] * xy[22]; ab1 -= mq[3][3] * xy[23]; mq[3] = *(const LAS f32x4*)(Mg + 1932);
            ab0 -= mq[4][0] * xy[24]; ab1 -= mq[4][1] * xy[25]; ab0 -= mq[4][2] * xy[26]; ab1 -= mq[4][3] * xy[27]; mq[4] = *(const LAS f32x4*)(Mg + 1936);
            ab0 -= mq[5][0] * xy[28]; xy[29] = ab0 + ab1; up[3712] = xy[29][0]; wp[3712] = f2bf(-xy[29][1]); mq[5] = *(const LAS f32x4*)(Mg + 1940);
            { const float br = betg[30]; ab0 = (f32x2){bf2f(*(const LAS bf16_t*)(lg + P5_VS + 8160 + c * 2)) * br, bf2f(*(const LAS bf16_t*)(lg + P5_KS + 8160 + c * 2)) * br * __expf(decg[30])}; ab1 = (f32x2){0.f, 0.f}; } ab0 -= mq[0][0] * xy[0]; ab1 -= mq[0][1] * xy[1]; ab0 -= mq[0][2] * xy[2]; ab1 -= mq[0][3] * xy[3]; mq[0] = *(const LAS f32x4*)(Mg + 1944);
            ab0 -= mq[1][0] * xy[4]; ab1 -= mq[1][1] * xy[5]; ab0 -= mq[1][2] * xy[6]; ab1 -= mq[1][3] * xy[7]; mq[1] = *(const LAS f32x4*)(Mg + 1948);
            ab0 -= mq[2][0] * xy[8]; ab1 -= mq[2][1] * xy[9]; ab0 -= mq[2][2] * xy[10]; ab1 -= mq[2][3] * xy[11]; mq[2] = *(const LAS f32x4*)(Mg + 1984);
            ab0 -= mq[3][0] * xy[12]; ab1 -= mq[3][1] * xy[13]; ab0 -= mq[3][2] * xy[14]; ab1 -= mq[3][3] * xy[15]; mq[3] = *(const LAS f32x4*)(Mg + 1988);
            ab0 -= mq[4][0] * xy[16]; ab1 -= mq[4][1] * xy[17]; ab0 -= mq[4][2] * xy[18]; ab1 -= mq[4][3] * xy[19]; mq[4] = *(const LAS f32x4*)(Mg + 1992);
            ab0 -= mq[5][0] * xy[20]; ab1 -= mq[5][1] * xy[21]; ab0 -= mq[5][2] * xy[22]; ab1 -= mq[5][3] * xy[23]; mq[5] = *(const LAS f32x4*)(Mg + 1996);
            ab0 -= mq[0][0] * xy[24]; ab1 -= mq[0][1] * xy[25]; ab0 -= mq[0][2] * xy[26]; ab1 -= mq[0][3] * xy[27]; mq[0] = *(const LAS f32x4*)(Mg + 2000);
            ab0 -= mq[1][0] * xy[28]; ab1 -= mq[1][1] * xy[29]; xy[30] = ab0 + ab1; up[3840] = xy[30][0]; wp[3840] = f2bf(-xy[30][1]); mq[1] = *(const LAS f32x4*)(Mg + 2004);
            { const float br = betg[31]; ab0 = (f32x2){bf2f(*(const LAS bf16_t*)(lg + P5_VS + 8432 + c * 2)) * br, bf2f(*(const LAS bf16_t*)(lg + P5_KS + 8432 + c * 2)) * br * __expf(decg[31])}; ab1 = (f32x2){0.f, 0.f}; } ab0 -= mq[2][0] * xy[0]; ab1 -= mq[2][1] * xy[1]; ab0 -= mq[2][2] * xy[2]; ab1 -= mq[2][3] * xy[3]; mq[2] = *(const LAS f32x4*)(Mg + 2008);
            ab0 -= mq[3][0] * xy[4]; ab1 -= mq[3][1] * xy[5]; ab0 -= mq[3][2] * xy[6]; ab1 -= mq[3][3] * xy[7]; mq[3] = *(const LAS f32x4*)(Mg + 2012);
            ab0 -= mq[4][0] * xy[8]; ab1 -= mq[4][1] * xy[9]; ab0 -= mq[4][2] * xy[10]; ab1 -= mq[4][3] * xy[11]; mq[4] = *(const LAS f32x4*)(Mg + 2048);
            ab0 -= mq[5][0] * xy[12]; ab1 -= mq[5][1] * xy[13]; ab0 -= mq[5][2] * xy[14]; ab1 -= mq[5][3] * xy[15]; mq[5] = *(const LAS f32x4*)(Mg + 2052);
            ab0 -= mq[0][0] * xy[16]; ab1 -= mq[0][1] * xy[17]; ab0 -= mq[0][2] * xy[18]; ab1 -= mq[0][3] * xy[19]; mq[0] = *(const LAS f32x4*)(Mg + 2056);
            ab0 -= mq[1][0] * xy[20]; ab1 -= mq[1][1] * xy[21]; ab0 -= mq[1][2] * xy[22]; ab1 -= mq[1][3] * xy[23]; mq[1] = *(const LAS f32x4*)(Mg + 2060);
            ab0 -= mq[2][0] * xy[24]; ab1 -= mq[2][1] * xy[25]; ab0 -= mq[2][2] * xy[26]; ab1 -= mq[2][3] * xy[27]; mq[2] = *(const LAS f32x4*)(Mg + 2064);
            ab0 -= mq[3][0] * xy[28]; ab1 -= mq[3][1] * xy[29]; ab0 -= mq[3][2] * xy[30]; xy[31] = ab0 + ab1; up[3968] = xy[31][0]; wp[3968] = f2bf(-xy[31][1]); mq[3] = *(const LAS f32x4*)(Mg + 2068);
            { const float br = betg[32]; ab0 = (f32x2){bf2f(*(const LAS bf16_t*)(lg + P5_VS + 8704 + c * 2)) * br, bf2f(*(const LAS bf16_t*)(lg + P5_KS + 8704 + c * 2)) * br * __expf(decg[32])}; ab1 = (f32x2){0.f, 0.f}; } ab0 -= mq[4][0] * xy[0]; ab1 -= mq[4][1] * xy[1]; ab0 -= mq[4][2] * xy[2]; ab1 -= mq[4][3] * xy[3]; mq[4] = *(const LAS f32x4*)(Mg + 2072);
            ab0 -= mq[5][0] * xy[4]; ab1 -= mq[5][1] * xy[5]; ab0 -= mq[5][2] * xy[6]; ab1 -= mq[5][3] * xy[7]; mq[5] = *(const LAS f32x4*)(Mg + 2076);
            ab0 -= mq[0][0] * xy[8]; ab1 -= mq[0][1] * xy[9]; ab0 -= mq[0][2] * xy[10]; ab1 -= mq[0][3] * xy[11]; mq[0] = *(const LAS f32x4*)(Mg + 2112);
            ab0 -= mq[1][0] * xy[12]; ab1 -= mq[1][1] * xy[13]; ab0 -= mq[1][2] * xy[14]; ab1 -= mq[1][3] * xy[15]; mq[1] = *(const LAS f32x4*)(Mg + 2116);
            ab0 -= mq[2][0] * xy[16]; ab1 -= mq[2][1] * xy[17]; ab0 -= mq[2][2] * xy[18]; ab1 -= mq[2][3] * xy[19]; mq[2] = *(const LAS f32x4*)(Mg + 2120);
            ab0 -= mq[3][0] * xy[20]; ab1 -= mq[3][1] * xy[21]; ab0 -= mq[3][2] * xy[22]; ab1 -= mq[3][3] * xy[23]; mq[3] = *(const LAS f32x4*)(Mg + 2124);
            ab0 -= mq[4][0] * xy[24]; ab1 -= mq[4][1] * xy[25]; ab0 -= mq[4][2] * xy[26]; ab1 -= mq[4][3] * xy[27]; mq[4] = *(const LAS f32x4*)(Mg + 2128);
            ab0 -= mq[5][0] * xy[28]; ab1 -= mq[5][1] * xy[29]; ab0 -= mq[5][2] * xy[30]; ab1 -= mq[5][3] * xy[31]; xy[32] = ab0 + ab1; up[4096] = xy[32][0]; wp[4096] = f2bf(-xy[32][1]); mq[5] = *(const LAS f32x4*)(Mg + 2132);
            { const float br = betg[33]; ab0 = (f32x2){bf2f(*(const LAS bf16_t*)(lg + P5_VS + 8976 + c * 2)) * br, bf2f(*(const LAS bf16_t*)(lg + P5_KS + 8976 + c * 2)) * br * __expf(decg[33])}; ab1 = (f32x2){0.f, 0.f}; } ab0 -= mq[0][0] * xy[0]; ab1 -= mq[0][1] * xy[1]; ab0 -= mq[0][2] * xy[2]; ab1 -= mq[0][3] * xy[3]; mq[0] = *(const LAS f32x4*)(Mg + 2136);
            ab0 -= mq[1][0] * xy[4]; ab1 -= mq[1][1] * xy[5]; ab0 -= mq[1][2] * xy[6]; ab1 -= mq[1][3] * xy[7]; mq[1] = *(const LAS f32x4*)(Mg + 2140);
            ab0 -= mq[2][0] * xy[8]; ab1 -= mq[2][1] * xy[9]; ab0 -= mq[2][2] * xy[10]; ab1 -= mq[2][3] * xy[11]; mq[2] = *(const LAS f32x4*)(Mg + 2144);
            ab0 -= mq[3][0] * xy[12]; ab1 -= mq[3][1] * xy[13]; ab0 -= mq[3][2] * xy[14]; ab1 -= mq[3][3] * xy[15]; mq[3] = *(const LAS f32x4*)(Mg + 2176);
            ab0 -= mq[4][0] * xy[16]; ab1 -= mq[4][1] * xy[17]; ab0 -= mq[4][2] * xy[18]; ab1 -= mq[4][3] * xy[19]; mq[4] = *(const LAS f32x4*)(Mg + 2180);
            ab0 -= mq[5][0] * xy[20]; ab1 -= mq[5][1] * xy[21]; ab0 -= mq[5][2] * xy[22]; ab1 -= mq[5][3] * xy[23]; mq[5] = *(const LAS f32x4*)(Mg + 2184);
            ab0 -= mq[0][0] * xy[24]; ab1 -= mq[0][1] * xy[25]; ab0 -= mq[0][2] * xy[26]; ab1 -= mq[0][3] * xy[27]; mq[0] = *(const LAS f32x4*)(Mg + 2188);
            ab0 -= mq[1][0] * xy[28]; ab1 -= mq[1][1] * xy[29]; ab0 -= mq[1][2] * xy[30]; ab1 -= mq[1][3] * xy[31]; mq[1] = *(const LAS f32x4*)(Mg + 2192);
            ab0 -= mq[2][0] * xy[32]; xy[33] = ab0 + ab1; up[4224] = xy[33][0]; wp[4224] = f2bf(-xy[33][1]); mq[2] = *(const LAS f32x4*)(Mg + 2196);
            { const float br = betg[34]; ab0 = (f32x2){bf2f(*(const LAS bf16_t*)(lg + P5_VS + 9248 + c * 2)) * br, bf2f(*(const LAS bf16_t*)(lg + P5_KS + 9248 + c * 2)) * br * __expf(decg[34])}; ab1 = (f32x2){0.f, 0.f}; } ab0 -= mq[3][0] * xy[0]; ab1 -= mq[3][1] * xy[1]; ab0 -= mq[3][2] * xy[2]; ab1 -= mq[3][3] * xy[3]; mq[3] = *(const LAS f32x4*)(Mg + 2200);
            ab0 -= mq[4][0] * xy[4]; ab1 -= mq[4][1] * xy[5]; ab0 -= mq[4][2] * xy[6]; ab1 -= mq[4][3] * xy[7]; mq[4] = *(const LAS f32x4*)(Mg + 2204);
            ab0 -= mq[5][0] * xy[8]; ab1 -= mq[5][1] * xy[9]; ab0 -= mq[5][2] * xy[10]; ab1 -= mq[5][3] * xy[11]; mq[5] = *(const LAS f32x4*)(Mg + 2208);
            ab0 -= mq[0][0] * xy[12]; ab1 -= mq[0][1] * xy[13]; ab0 -= mq[0][2] * xy[14]; ab1 -= mq[0][3] * xy[15]; mq[0] = *(const LAS f32x4*)(Mg + 2240);
            ab0 -= mq[1][0] * xy[16]; ab1 -= mq[1][1] * xy[17]; ab0 -= mq[1][2] * xy[18]; ab1 -= mq[1][3] * xy[19]; mq[1] = *(const LAS f32x4*)(Mg + 2244);
            ab0 -= mq[2][0] * xy[20]; ab1 -= mq[2][1] * xy[21]; ab0 -= mq[2][2] * xy[22]; ab1 -= mq[2][3] * xy[23]; mq[2] = *(const LAS f32x4*)(Mg + 2248);
            ab0 -= mq[3][0] * xy[24]; ab1 -= mq[3][1] * xy[25]; ab0 -= mq[3][2] * xy[26]; ab1 -= mq[3][3] * xy[27]; mq[3] = *(const LAS f32x4*)(Mg + 2252);
            ab0 -= mq[4][0] * xy[28]; ab1 -= mq[4][1] * xy[29]; ab0 -= mq[4][2] * xy[30]; ab1 -= mq[4][3] * xy[31]; mq[4] = *(const LAS f32x4*)(Mg + 2256);
            ab0 -= mq[5][0] * xy[32]; ab1 -= mq[5][1] * xy[33]; xy[34] = ab0 + ab1; up[4352] = xy[34][0]; wp[4352] = f2bf(-xy[34][1]); mq[5] = *(const LAS f32x4*)(Mg + 2260);
            { const float br = betg[35]; ab0 = (f32x2){bf2f(*(const LAS bf16_t*)(lg + P5_VS + 9520 + c * 2)) * br, bf2f(*(const LAS bf16_t*)(lg + P5_KS + 9520 + c * 2)) * br * __expf(decg[35])}; ab1 = (f32x2){0.f, 0.f}; } ab0 -= mq[0][0] * xy[0]; ab1 -= mq[0][1] * xy[1]; ab0 -= mq[0][2] * xy[2]; ab1 -= mq[0][3] * xy[3]; mq[0] = *(const LAS f32x4*)(Mg + 2264);
            ab0 -= mq[1][0] * xy[4]; ab1 -= mq[1][1] * xy[5]; ab0 -= mq[1][2] * xy[6]; ab1 -= mq[1][3] * xy[7]; mq[1] = *(const LAS f32x4*)(Mg + 2268);
            ab0 -= mq[2][0] * xy[8]; ab1 -= mq[2][1] * xy[9]; ab0 -= mq[2][2] * xy[10]; ab1 -= mq[2][3] * xy[11]; mq[2] = *(const LAS f32x4*)(Mg + 2272);
            ab0 -= mq[3][0] * xy[12]; ab1 -= mq[3][1] * xy[13]; ab0 -= mq[3][2] * xy[14]; ab1 -= mq[3][3] * xy[15]; mq[3] = *(const LAS f32x4*)(Mg + 2304);
            ab0 -= mq[4][0] * xy[16]; ab1 -= mq[4][1] * xy[17]; ab0 -= mq[4][2] * xy[18]; ab1 -= mq[4][3] * xy[19]; mq[4] = *(const LAS f32x4*)(Mg + 2308);
            ab0 -= mq[5][0] * xy[20]; ab1 -= mq[5][1] * xy[21]; ab0 -= mq[5][2] * xy[22]; ab1 -= mq[5][3] * xy[23]; mq[5] = *(const LAS f32x4*)(Mg + 2312);
            ab0 -= mq[0][0] * xy[24]; ab1 -= mq[0][1] * xy[25]; ab0 -= mq[0][2] * xy[26]; ab1 -= mq[0][3] * xy[27]; mq[0] = *(const LAS f32x4*)(Mg + 2316);
            ab0 -= mq[1][0] * xy[28]; ab1 -= mq[1][1] * xy[29]; ab0 -= mq[1][2] * xy[30]; ab1 -= mq[1][3] * xy[31]; mq[1] = *(const LAS f32x4*)(Mg + 2320);
            ab0 -= mq[2][0] * xy[32]; ab1 -= mq[2][1] * xy[33]; ab0 -= mq[2][2] * xy[34]; xy[35] = ab0 + ab1; up[4480] = xy[35][0]; wp[4480] = f2bf(-xy[35][1]); mq[2] = *(const LAS f32x4*)(Mg + 2324);
            { const float br = betg[36]; ab0 = (f32x2){bf2f(*(const LAS bf16_t*)(lg + P5_VS + 9792 + c * 2)) * br, bf2f(*(const LAS bf16_t*)(lg + P5_KS + 9792 + c * 2)) * br * __expf(decg[36])}; ab1 = (f32x2){0.f, 0.f}; } ab0 -= mq[3][0] * xy[0]; ab1 -= mq[3][1] * xy[1]; ab0 -= mq[3][2] * xy[2]; ab1 -= mq[3][3] * xy[3]; mq[3] = *(const LAS f32x4*)(Mg + 2328);
            ab0 -= mq[4][0] * xy[4]; ab1 -= mq[4][1] * xy[5]; ab0 -= mq[4][2] * xy[6]; ab1 -= mq[4][3] * xy[7]; mq[4] = *(const LAS f32x4*)(Mg + 2332);
            ab0 -= mq[5][0] * xy[8]; ab1 -= mq[5][1] * xy[9]; ab0 -= mq[5][2] * xy[10]; ab1 -= mq[5][3] * xy[11]; mq[5] = *(const LAS f32x4*)(Mg + 2336);
            ab0 -= mq[0][0] * xy[12]; ab1 -= mq[0][1] * xy[13]; ab0 -= mq[0][2] * xy[14]; ab1 -= mq[0][3] * xy[15]; mq[0] = *(const LAS f32x4*)(Mg + 2368);
            ab0 -= mq[1][0] * xy[16]; ab1 -= mq[1][1] * xy[17]; ab0 -= mq[1][2] * xy[18]; ab1 -= mq[1][3] * xy[19]; mq[1] = *(const LAS f32x4*)(Mg + 2372);
            ab0 -= mq[2][0] * xy[20]; ab1 -= mq[2][1] * xy[21]; ab0 -= mq[2][2] * xy[22]; ab1 -= mq[2][3] * xy[23]; mq[2] = *(const LAS f32x4*)(Mg + 2376);
            ab0 -= mq[3][0] * xy[24]; ab1 -= mq[3][1] * xy[25]; ab0 -= mq[3][2] * xy[26]; ab1 -= mq[3][3] * xy[27]; mq[3] = *(const LAS f32x4*)(Mg + 2380);
            ab0 -= mq[4][0] * xy[28]; ab1 -= mq[4][1] * xy[29]; ab0 -= mq[4][2] * xy[30]; ab1 -= mq[4][3] * xy[31]; mq[4] = *(const LAS f32x4*)(Mg + 2384);
            ab0 -= mq[5][0] * xy[32]; ab1 -= mq[5][1] * xy[33]; ab0 -= mq[5][2] * xy[34]; ab1 -= mq[5][3] * xy[35]; xy[36] = ab0 + ab1; up[4608] = xy[36][0]; wp[4608] = f2bf(-xy[36][1]); mq[5] = *(const LAS f32x4*)(Mg + 2388);
            { const float br = betg[37]; ab0 = (f32x2){bf2f(*(const LAS bf16_t*)(lg + P5_VS + 10064 + c * 2)) * br, bf2f(*(const LAS bf16_t*)(lg + P5_KS + 10064 + c * 2)) * br * __expf(decg[37])}; ab1 = (f32x2){0.f, 0.f}; } ab0 -= mq[0][0] * xy[0]; ab1 -= mq[0][1] * xy[1]; ab0 -= mq[0][2] * xy[2]; ab1 -= mq[0][3] * xy[3]; mq[0] = *(const LAS f32x4*)(Mg + 2392);
            ab0 -= mq[1][0] * xy[4]; ab1 -= mq[1][1] * xy[5]; ab0 -= mq[1][2] * xy[6]; ab1 -= mq[1][3] * xy[7]; mq[1] = *(const LAS f32x4*)(Mg + 2396);
            ab0 -= mq[2][0] * xy[8]; ab1 -= mq[2][1] * xy[9]; ab0 -= mq[2][2] * xy[10]; ab1 -= mq[2][3] * xy[11]; mq[2] = *(const LAS f32x4*)(Mg + 2400);
            ab0 -= mq[3][0] * xy[12]; ab1 -= mq[3][1] * xy[13]; ab0 -= mq[3][2] * xy[14]; ab1 -= mq[3][3] * xy[15]; mq[3] = *(const LAS f32x4*)(Mg + 2404);
            ab0 -= mq[4][0] * xy[16]; ab1 -= mq[4][1] * xy[17]; ab0 -= mq[4][2] * xy[18]; ab1 -= mq[4][3] * xy[19]; mq[4] = *(const LAS f32x4*)(Mg + 2432);
            ab0 -= mq[5][0] * xy[20]; ab1 -= mq[5][1] * xy[21]; ab0 -= mq[5][2] * xy[22]; ab1 -= mq[5][3] * xy[23]; mq[5] = *(const LAS f32x4*)(Mg + 2436);
            ab0 -= mq[0][0] * xy[24]; ab1 -= mq[0][1] * xy[25]; ab0 -= mq[0][2] * xy[26]; ab1 -= mq[0][3] * xy[27]; mq[0] = *(const LAS f32x4*)(Mg + 2440);
            ab0 -= mq[1][0] * xy[28]; ab1 -= mq[1][1] * xy[29]; ab0 -= mq[1][2] * xy[30]; ab1 -= mq[1][3] * xy[31]; mq[1] = *(const LAS f32x4*)(Mg + 2444);
            ab0 -= mq[2][0] * xy[32]; ab1 -= mq[2][1] * xy[33]; ab0 -= mq[2][2] * xy[34]; ab1 -= mq[2][3] * xy[35]; mq[2] = *(const LAS f32x4*)(Mg + 2448);
            ab0 -= mq[3][0] * xy[36]; xy[37] = ab0 + ab1; up[4736] = xy[37][0]; wp[4736] = f2bf(-xy[37][1]); mq[3] = *(const LAS f32x4*)(Mg + 2452);
            { const float br = betg[38]; ab0 = (f32x2){bf2f(*(const LAS bf16_t*)(lg + P5_VS + 10336 + c * 2)) * br, bf2f(*(const LAS bf16_t*)(lg + P5_KS + 10336 + c * 2)) * br * __expf(decg[38])}; ab1 = (f32x2){0.f, 0.f}; } ab0 -= mq[4][0] * xy[0]; ab1 -= mq[4][1] * xy[1]; ab0 -= mq[4][2] * xy[2]; ab1 -= mq[4][3] * xy[3]; mq[4] = *(const LAS f32x4*)(Mg + 2456);
            ab0 -= mq[5][0] * xy[4]; ab1 -= mq[5][1] * xy[5]; ab0 -= mq[5][2] * xy[6]; ab1 -= mq[5][3] * xy[7]; mq[5] = *(const LAS f32x4*)(Mg + 2460);
            ab0 -= mq[0][0] * xy[8]; ab1 -= mq[0][1] * xy[9]; ab0 -= mq[0][2] * xy[10]; ab1 -= mq[0][3] * xy[11]; mq[0] = *(const LAS f32x4*)(Mg + 2464);
            ab0 -= mq[1][0] * xy[12]; ab1 -= mq[1][1] * xy[13]; ab0 -= mq[1][2] * xy[14]; ab1 -= mq[1][3] * xy[15]; mq[1] = *(const LAS f32x4*)(Mg + 2468);
            ab0 -= mq[2][0] * xy[16]; ab1 -= mq[2][1] * xy[17]; ab0 -= mq[2][2] * xy[18]; ab1 -= mq[2][3] * xy[19]; mq[2] = *(const LAS f32x4*)(Mg + 2496);
            ab0 -= mq[3][0] * xy[20]; ab1 -= mq[3][1] * xy[21]; ab0 -= mq[3][2] * xy[22]; ab1 -= mq[3][3] * xy[23]; mq[3] = *(const LAS f32x4*)(Mg + 2500);
            ab0 -= mq[4][0] * xy[24]; ab1 -= mq[4][1] * xy[25]; ab0 -= mq[4][2] * xy[26]; ab1 -= mq[4][3] * xy[27]; mq[4] = *(const LAS f32x4*)(Mg + 2504);
            ab0 -= mq[5][0] * xy[28]; ab1 -= mq[5][1] * xy[29]; ab0 -= mq[5][2] * xy[30]; ab1 -= mq[5][3] * xy[31]; mq[5] = *(const LAS f32x4*)(Mg + 2508);
            ab0 -= mq[0][0] * xy[32]; ab1 -= mq[0][1] * xy[33]; ab0 -= mq[0][2] * xy[34]; ab1 -= mq[0][3] * xy[35]; mq[0] = *(const LAS f32x4*)(Mg + 2512);
            ab0 -= mq[1][0] * xy[36]; ab1 -= mq[1][1] * xy[37]; xy[38] = ab0 + ab1; up[4864] = xy[38][0]; wp[4864] = f2bf(-xy[38][1]); mq[1] = *(const LAS f32x4*)(Mg + 2516);
            { const float br = betg[39]; ab0 = (f32x2){bf2f(*(const LAS bf16_t*)(lg + P5_VS + 10608 + c * 2)) * br, bf2f(*(const LAS bf16_t*)(lg + P5_KS + 10608 + c * 2)) * br * __expf(decg[39])}; ab1 = (f32x2){0.f, 0.f}; } ab0 -= mq[2][0] * xy[0]; ab1 -= mq[2][1] * xy[1]; ab0 -= mq[2][2] * xy[2]; ab1 -= mq[2][3] * xy[3]; mq[2] = *(const LAS f32x4*)(Mg + 2520);
            ab0 -= mq[3][0] * xy[4]; ab1 -= mq[3][1] * xy[5]; ab0 -= mq[3][2] * xy[6]; ab1 -= mq[3][3] * xy[7]; mq[3] = *(const LAS f32x4*)(Mg + 2524);
            ab0 -= mq[4][0] * xy[8]; ab1 -= mq[4][1] * xy[9]; ab0 -= mq[4][2] * xy[10]; ab1 -= mq[4][3] * xy[11]; mq[4] = *(const LAS f32x4*)(Mg + 2528);
            ab0 -= mq[5][0] * xy[12]; ab1 -= mq[5][1] * xy[13]; ab0 -= mq[5][2] * xy[14]; ab1 -= mq[5][3] * xy[15]; mq[5] = *(const LAS f32x4*)(Mg + 2532);
            ab0 -= mq[0][0] * xy[16]; ab1 -= mq[0][1] * xy[17]; ab0 -= mq[0][2] * xy[18]; ab1 -= mq[0][3] * xy[19]; mq[0] = *(const LAS f32x4*)(Mg + 2560);
            ab0 -= mq[1][0] * xy[20]; ab1 -= mq[1][1] * xy[21]; ab0 -= mq[1][2] * xy[22]; ab1 -= mq[1][3] * xy[23]; mq[1] = *(const LAS f32x4*)(Mg + 2564);
            ab0 -= mq[2][0] * xy[24]; ab1 -= mq[2][1] * xy[25]; ab0 -= mq[2][2] * xy[26]; ab1 -= mq[2][3] * xy[27]; mq[2] = *(const LAS f32x4*)(Mg + 2568);
            ab0 -= mq[3][0] * xy[28]; ab1 -= mq[3][1] * xy[29]; ab0 -= mq[3][2] * xy[30]; ab1 -= mq[3][3] * xy[31]; mq[3] = *(const LAS f32x4*)(Mg + 2572);
            ab0 -= mq[4][0] * xy[32]; ab1 -= mq[4][1] * xy[33]; ab0 -= mq[4][2] * xy[34]; ab1 -= mq[4][3] * xy[35]; mq[4] = *(const LAS f32x4*)(Mg + 2576);
            ab0 -= mq[5][0] * xy[36]; ab1 -= mq[5][1] * xy[37]; ab0 -= mq[5][2] * xy[38]; xy[39] = ab0 + ab1; up[4992] = xy[39][0]; wp[4992] = f2bf(-xy[39][1]); mq[5] = *(const LAS f32x4*)(Mg + 2580);
            { const float br = betg[40]; ab0 = (f32x2){bf2f(*(const LAS bf16_t*)(lg + P5_VS + 10880 + c * 2)) * br, bf2f(*(const LAS bf16_t*)(lg + P5_KS + 10880 + c * 2)) * br * __expf(decg[40])}; ab1 = (f32x2){0.f, 0.f}; } ab0 -= mq[0][0] * xy[0]; ab1 -= mq[0][1] * xy[1]; ab0 -= mq[0][2] * xy[2]; ab1 -= mq[0][3] * xy[3]; mq[0] = *(const LAS f32x4*)(Mg + 2584);
            ab0 -= mq[1][0] * xy[4]; ab1 -= mq[1][1] * xy[5]; ab0 -= mq[1][2] * xy[6]; ab1 -= mq[1][3] * xy[7]; mq[1] = *(const LAS f32x4*)(Mg + 2588);
            ab0 -= mq[2][0] * xy[8]; ab1 -= mq[2][1] * xy[9]; ab0 -= mq[2][2] * xy[10]; ab1 -= mq[2][3] * xy[11]; mq[2] = *(const LAS f32x4*)(Mg + 2592);
            ab0 -= mq[3][0] * xy[12]; ab1 -= mq[3][1] * xy[13]; ab0 -= mq[3][2] * xy[14]; ab1 -= mq[3][3] * xy[15]; mq[3] = *(const LAS f32x4*)(Mg + 2596);
            ab0 -= mq[4][0] * xy[16]; ab1 -= mq[4][1] * xy[17]; ab0 -= mq[4][2] * xy[18]; ab1 -= mq[4][3] * xy[19]; mq[4] = *(const LAS f32x4*)(Mg + 2624);
            ab0 -= mq[5][0] * xy[20]; ab1 -= mq[5][1] * xy[21]; ab0 -= mq[5][2] * xy[22]; ab1 -= mq[5][3] * xy[23]; mq[5] = *(const LAS f32x4*)(Mg + 2628);
            ab0 -= mq[0][0] * xy[24]; ab1 -= mq[0][1] * xy[25]; ab0 -= mq[0][2] * xy[26]; ab1 -= mq[0][3] * xy[27]; mq[0] = *(const LAS f32x4*)(Mg + 2632);
            ab0 -= mq[1][0] * xy[28]; ab1 -= mq[1][1] * xy[29]; ab0 -= mq[1][2] * xy[30]; ab1 -= mq[1][3] * xy[31]; mq[1] = *(const LAS f32x4*)(Mg + 2636);
            ab0 -= mq[2][0] * xy[32]; ab1 -= mq[2][1] * xy[33]; ab0 -= mq[2][2] * xy[34]; ab1 -= mq[2][3] * xy[35]; mq[2] = *(const LAS f32x4*)(Mg + 2640);
            ab0 -= mq[3][0] * xy[36]; ab1 -= mq[3][1] * xy[37]; ab0 -= mq[3][2] * xy[38]; ab1 -= mq[3][3] * xy[39]; xy[40] = ab0 + ab1; up[5120] = xy[40][0]; wp[5120] = f2bf(-xy[40][1]); mq[3] = *(const LAS f32x4*)(Mg + 2644);
            { const float br = betg[41]; ab0 = (f32x2){bf2f(*(const LAS bf16_t*)(lg + P5_VS + 11152 + c * 2)) * br, bf2f(*(const LAS bf16_t*)(lg + P5_KS + 11152 + c * 2)) * br * __expf(decg[41])}; ab1 = (f32x2){0.f, 0.f}; } ab0 -= mq[4][0] * xy[0]; ab1 -= mq[4][1] * xy[1]; ab0 -= mq[4][2] * xy[2]; ab1 -= mq[4][3] * xy[3]; mq[4] = *(const LAS f32x4*)(Mg + 2648);
            ab0 -= mq[5][0] * xy[4]; ab1 -= mq[5][1] * xy[5]; ab0 -= mq[5][2] * xy[6]; ab1 -= mq[5][3] * xy[7]; mq[5] = *(const LAS f32x4*)(Mg + 2652);
            ab0 -= mq[0][0] * xy[8]; ab1 -= mq[0][1] * xy[9]; ab0 -= mq[0][2] * xy[10]; ab1 -= mq[0][3] * xy[11]; mq[0] = *(const LAS f32x4*)(Mg + 2656);
            ab0 -= mq[1][0] * xy[12]; ab1 -= mq[1][1] * xy[13]; ab0 -= mq[1][2] * xy[14]; ab1 -= mq[1][3] * xy[15]; mq[1] = *(const LAS f32x4*)(Mg + 2660);
            ab0 -= mq[2][0] * xy[16]; ab1 -= mq[2][1] * xy[17]; ab0 -= mq[2][2] * xy[18]; ab1 -= mq[2][3] * xy[19]; mq[2] = *(const LAS f32x4*)(Mg + 2664);
            ab0 -= mq[3][0] * xy[20]; ab1 -= mq[3][1] * xy[21]; ab0 -= mq[3][2] * xy[22]; ab1 -= mq[3][3] * xy[23]; mq[3] = *(const LAS f32x4*)(Mg + 2688);
            ab0 -= mq[4][0] * xy[24]; ab1 -= mq[4][1] * xy[25]; ab0 -= mq[4][2] * xy[26]; ab1 -= mq[4][3] * xy[27]; mq[4] = *(const LAS f32x4*)(Mg + 2692);
            ab0 -= mq[5][0] * xy[28]; ab1 -= mq[5][1] * xy[29]; ab0 -= mq[5][2] * xy[30]; ab1 -= mq[5][3] * xy[31]; mq[5] = *(const LAS f32x4*)(Mg + 2696);
            ab0 -= mq[0][0] * xy[32]; ab1 -= mq[0][1] * xy[33]; ab0 -= mq[0][2] * xy[34]; ab1 -= mq[0][3] * xy[35]; mq[0] = *(const LAS f32x4*)(Mg + 2700);
            ab0 -= mq[1][0] * xy[36]; ab1 -= mq[1][1] * xy[37]; ab0 -= mq[1][2] * xy[38]; ab1 -= mq[1][3] * xy[39]; mq[1] = *(const LAS f32x4*)(Mg + 2704);
            ab0 -= mq[2][0] * xy[40]; xy[41] = ab0 + ab1; up[5248] = xy[41][0]; wp[5248] = f2bf(-xy[41][1]); mq[2] = *(const LAS f32x4*)(Mg + 2708);
            { const float br = betg[42]; ab0 = (f32x2){bf2f(*(const LAS bf16_t*)(lg + P5_VS + 11424 + c * 2)) * br, bf2f(*(const LAS bf16_t*)(lg + P5_KS + 11424 + c * 2)) * br * __expf(decg[42])}; ab1 = (f32x2){0.f, 0.f}; } ab0 -= mq[3][0] * xy[0]; ab1 -= mq[3][1] * xy[1]; ab0 -= mq[3][2] * xy[2]; ab1 -= mq[3][3] * xy[3]; mq[3] = *(const LAS f32x4*)(Mg + 2712);
            ab0 -= mq[4][0] * xy[4]; ab1 -= mq[4][1] * xy[5]; ab0 -= mq[4][2] * xy[6]; ab1 -= mq[4][3] * xy[7]; mq[4] = *(const LAS f32x4*)(Mg + 2716);
            ab0 -= mq[5][0] * xy[8]; ab1 -= mq[5][1] * xy[9]; ab0 -= mq[5][2] * xy[10]; ab1 -= mq[5][3] * xy[11]; mq[5] = *(const LAS f32x4*)(Mg + 2720);
            ab0 -= mq[0][0] * xy[12]; ab1 -= mq[0][1] * xy[13]; ab0 -= mq[0][2] * xy[14]; ab1 -= mq[0][3] * xy[15]; mq[0] = *(const LAS f32x4*)(Mg + 2724);
            ab0 -= mq[1][0] * xy[16]; ab1 -= mq[1][1] * xy[17]; ab0 -= mq[1][2] * xy[18]; ab1 -= mq[1][3] * xy[19]; mq[1] = *(const LAS f32x4*)(Mg + 2728);
            ab0 -= mq[2][0] * xy[20]; ab1 -= mq[2][1] * xy[21]; ab0 -= mq[2][2] * xy[22]; ab1 -= mq[2][3] * xy[23]; mq[2] = *(const LAS f32x4*)(Mg + 2752);
            ab0 -= mq[3][0] * xy[24]; ab1 -= mq[3][1] * xy[25]; ab0 -= mq[3][2] * xy[26]; ab1 -= mq[3][3] * xy[27]; mq[3] = *(const LAS f32x4*)(Mg + 2756);
            ab0 -= mq[4][0] * xy[28]; ab1 -= mq[4][1] * xy[29]; ab0 -= mq[4][2] * xy[30]; ab1 -= mq[4][3] * xy[31]; mq[4] = *(const LAS f32x4*)(Mg + 2760);
            ab0 -= mq[5][0] * xy[32]; ab1 -= mq[5][1] * xy[33]; ab0 -= mq[5][2] * xy[34]; ab1 -= mq[5][3] * xy[35]; mq[5] = *(const LAS f32x4*)(Mg + 2764);
            ab0 -= mq[0][0] * xy[36]; ab1 -= mq[0][1] * xy[37]; ab0 -= mq[0][2] * xy[38]; ab1 -= mq[0][3] * xy[39]; mq[0] = *(const LAS f32x4*)(Mg + 2768);
            ab0 -= mq[1][0] * xy[40]; ab1 -= mq[1][1] * xy[41]; xy[42] = ab0 + ab1; up[5376] = xy[42][0]; wp[5376] = f2bf(-xy[42][1]); mq[1] = *(const LAS f32x4*)(Mg + 2772);
            { const float br = betg[43]; ab0 = (f32x2){bf2f(*(const LAS bf16_t*)(lg + P5_VS + 11696 + c * 2)) * br, bf2f(*(const LAS bf16_t*)(lg + P5_KS + 11696 + c * 2)) * br * __expf(decg[43])}; ab1 = (f32x2){0.f, 0.f}; } ab0 -= mq[2][0] * xy[0]; ab1 -= mq[2][1] * xy[1]; ab0 -= mq[2][2] * xy[2]; ab1 -= mq[2][3] * xy[3]; mq[2] = *(const LAS f32x4*)(Mg + 2776);
            ab0 -= mq[3][0] * xy[4]; ab1 -= mq[3][1] * xy[5]; ab0 -= mq[3][2] * xy[6]; ab1 -= mq[3][3] * xy[7]; mq[3] = *(const LAS f32x4*)(Mg + 2780);
            ab0 -= mq[4][0] * xy[8]; ab1 -= mq[4][1] * xy[9]; ab0 -= mq[4][2] * xy[10]; ab1 -= mq[4][3] * xy[11]; mq[4] = *(const LAS f32x4*)(Mg + 2784);
            ab0 -= mq[5][0] * xy[12]; ab1 -= mq[5][1] * xy[13]; ab0 -= mq[5][2] * xy[14]; ab1 -= mq[5][3] * xy[15]; mq[5] = *(const LAS f32x4*)(Mg + 2788);
            ab0 -= mq[0][0] * xy[16]; ab1 -= mq[0][1] * xy[17]; ab0 -= mq[0][2] * xy[18]; ab1 -= mq[0][3] * xy[19]; mq[0] = *(const LAS f32x4*)(Mg + 2792);
            ab0 -= mq[1][0] * xy[20]; ab1 -= mq[1][1] * xy[21]; ab0 -= mq[1][2] * xy[22]; ab1 -= mq[1][3] * xy[23]; mq[1] = *(const LAS f32x4*)(Mg + 2816);
            ab0 -= mq[2][0] * xy[24]; ab1 -= mq[2][1] * xy[25]; ab0 -= mq[2][2] * xy[26]; ab1 -= mq[2][3] * xy[27]; mq[2] = *(const LAS f32x4*)(Mg + 2820);
            ab0 -= mq[3][0] * xy[28]; ab1 -= mq[3][1] * xy[29]; ab0 -= mq[3][2] * xy[30]; ab1 -= mq[3][3] * xy[31]; mq[3] = *(const LAS f32x4*)(Mg + 2824);
            ab0 -= mq[4][0] * xy[32]; ab1 -= mq[4][1] * xy[33]; ab0 -= mq[4][2] * xy[34]; ab1 -= mq[4][3] * xy[35]; mq[4] = *(const LAS f32x4*)(Mg + 2828);
            ab0 -= mq[5][0] * xy[36]; ab1 -= mq[5][1] * xy[37]; ab0 -= mq[5][2] * xy[38]; ab1 -= mq[5][3] * xy[39]; mq[5] = *(const LAS f32x4*)(Mg + 2832);
            ab0 -= mq[0][0] * xy[40]; ab1 -= mq[0][1] * xy[41]; ab0 -= mq[0][2] * xy[42]; xy[43] = ab0 + ab1; up[5504] = xy[43][0]; wp[5504] = f2bf(-xy[43][1]); mq[0] = *(const LAS f32x4*)(Mg + 2836);
            { const float br = betg[44]; ab0 = (f32x2){bf2f(*(const LAS bf16_t*)(lg + P5_VS + 11968 + c * 2)) * br, bf2f(*(const LAS bf16_t*)(lg + P5_KS + 11968 + c * 2)) * br * __expf(decg[44])}; ab1 = (f32x2){0.f, 0.f}; } ab0 -= mq[1][0] * xy[0]; ab1 -= mq[1][1] * xy[1]; ab0 -= mq[1][2] * xy[2]; ab1 -= mq[1][3] * xy[3]; mq[1] = *(const LAS f32x4*)(Mg + 2840);
            ab0 -= mq[2][0] * xy[4]; ab1 -= mq[2][1] * xy[5]; ab0 -= mq[2][2] * xy[6]; ab1 -= mq[2][3] * xy[7]; mq[2] = *(const LAS f32x4*)(Mg + 2844);
            ab0 -= mq[3][0] * xy[8]; ab1 -= mq[3][1] * xy[9]; ab0 -= mq[3][2] * xy[10]; ab1 -= mq[3][3] * xy[11]; mq[3] = *(const LAS f32x4*)(Mg + 2848);
            ab0 -= mq[4][0] * xy[12]; ab1 -= mq[4][1] * xy[13]; ab0 -= mq[4][2] * xy[14]; ab1 -= mq[4][3] * xy[15]; mq[4] = *(const LAS f32x4*)(Mg + 2852);
            ab0 -= mq[5][0] * xy[16]; ab1 -= mq[5][1] * xy[17]; ab0 -= mq[5][2] * xy[18]; ab1 -= mq[5][3] * xy[19]; mq[5] = *(const LAS f32x4*)(Mg + 2856);
            ab0 -= mq[0][0] * xy[20]; ab1 -= mq[0][1] * xy[21]; ab0 -= mq[0][2] * xy[22]; ab1 -= mq[0][3] * xy[23]; mq[0] = *(const LAS f32x4*)(Mg + 2880);
            ab0 -= mq[1][0] * xy[24]; ab1 -= mq[1][1] * xy[25]; ab0 -= mq[1][2] * xy[26]; ab1 -= mq[1][3] * xy[27]; mq[1] = *(const LAS f32x4*)(Mg + 2884);
            ab0 -= mq[2][0] * xy[28]; ab1 -= mq[2][1] * xy[29]; ab0 -= mq[2][2] * xy[30]; ab1 -= mq[2][3] * xy[31]; mq[2] = *(const LAS f32x4*)(Mg + 2888);
            ab0 -= mq[3][0] * xy[32]; ab1 -= mq[3][1] * xy[33]; ab0 -= mq[3][2] * xy[34]; ab1 -= mq[3][3] * xy[35]; mq[3] = *(const LAS f32x4*)(Mg + 2892);
            ab0 -= mq[4][0] * xy[36]; ab1 -= mq[4][1] * xy[37]; ab0 -= mq[4][2] * xy[38]; ab1 -= mq[4][3] * xy[39]; mq[4] = *(const LAS f32x4*)(Mg + 2896);
            ab0 -= mq[5][0] * xy[40]; ab1 -= mq[5][1] * xy[41]; ab0 -= mq[5][2] * xy[42]; ab1 -= mq[5][3] * xy[43]; xy[44] = ab0 + ab1; up[5632] = xy[44][0]; wp[5632] = f2bf(-xy[44][1]); mq[5] = *(const LAS f32x4*)(Mg + 2900);
            { const float br = betg[45]; ab0 = (f32x2){bf2f(*(const LAS bf16_t*)(lg + P5_VS + 12240 + c * 2)) * br, bf2f(*(const LAS bf16_t*)(lg + P5_KS + 12240 + c * 2)) * br * __expf(decg[45])}; ab1 = (f32x2){0.f, 0.f}; } ab0 -= mq[0][0] * xy[0]; ab1 -= mq[0][1] * xy[1]; ab0 -= mq[0][2] * xy[2]; ab1 -= mq[0][3] * xy[3]; mq[0] = *(const LAS f32x4*)(Mg + 2904);
            ab0 -= mq[1][0] * xy[4]; ab1 -= mq[1][1] * xy[5]; ab0 -= mq[1][2] * xy[6]; ab1 -= mq[1][3] * xy[7]; mq[1] = *(const LAS f32x4*)(Mg + 2908);
            ab0 -= mq[2][0] * xy[8]; ab1 -= mq[2][1] * xy[9]; ab0 -= mq[2][2] * xy[10]; ab1 -= mq[2][3] * xy[11]; mq[2] = *(const LAS f32x4*)(Mg + 2912);
            ab0 -= mq[3][0] * xy[12]; ab1 -= mq[3][1] * xy[13]; ab0 -= mq[3][2] * xy[14]; ab1 -= mq[3][3] * xy[15]; mq[3] = *(const LAS f32x4*)(Mg + 2916);
            ab0 -= mq[4][0] * xy[16]; ab1 -= mq[4][1] * xy[17]; ab0 -= mq[4][2] * xy[18]; ab1 -= mq[4][3] * xy[19]; mq[4] = *(const LAS f32x4*)(Mg + 2920);
            ab0 -= mq[5][0] * xy[20]; ab1 -= mq[5][1] * xy[21]; ab0 -= mq[5][2] * xy[22]; ab1 -= mq[5][3] * xy[23]; mq[5] = *(const LAS f32x4*)(Mg + 2924);
            ab0 -= mq[0][0] * xy[24]; ab1 -= mq[0][1] * xy[25]; ab0 -= mq[0][2] * xy[26]; ab1 -= mq[0][3] * xy[27]; mq[0] = *(const LAS f32x4*)(Mg + 2944);
            ab0 -= mq[1][0] * xy[28]; ab1 -= mq[1][1] * xy[29]; ab0 -= mq[1][2] * xy[30]; ab1 -= mq[1][3] * xy[31]; mq[1] = *(const LAS f32x4*)(Mg + 2948);
            ab0 -= mq[2][0] * xy[32]; ab1 -= mq[2][1] * xy[33]; ab0 -= mq[2][2] * xy[34]; ab1 -= mq[2][3] * xy[35]; mq[2] = *(const LAS f32x4*)(Mg + 2952);
            ab0 -= mq[3][0] * xy[36]; ab1 -= mq[3][1] * xy[37]; ab0 -= mq[3][2] * xy[38]; ab1 -= mq[3][3] * xy[39]; mq[3] = *(const LAS f32x4*)(Mg + 2956);
            ab0 -= mq[4][0] * xy[40]; ab1 -= mq[4][1] * xy[41]; ab0 -= mq[4][2] * xy[42]; ab1 -= mq[4][3] * xy[43]; mq[4] = *(const LAS f32x4*)(Mg + 2960);
            ab0 -= mq[5][0] * xy[44]; xy[45] = ab0 + ab1; up[5760] = xy[45][0]; wp[5760] = f2bf(-xy[45][1]); mq[5] = *(const LAS f32x4*)(Mg + 2964);
            { const float br = betg[46]; ab0 = (f32x2){bf2f(*(const LAS bf16_t*)(lg + P5_VS + 12512 + c * 2)) * br, bf2f(*(const LAS bf16_t*)(lg + P5_KS + 12512 + c * 2)) * br * __expf(decg[46])}; ab1 = (f32x2){0.f, 0.f}; } ab0 -= mq[0][0] * xy[0]; ab1 -= mq[0][1] * xy[1]; ab0 -= mq[0][2] * xy[2]; ab1 -= mq[0][3] * xy[3]; mq[0] = *(const LAS f32x4*)(Mg + 2968);
            ab0 -= mq[1][0] * xy[4]; ab1 -= mq[1][1] * xy[5]; ab0 -= mq[1][2] * xy[6]; ab1 -= mq[1][3] * xy[7]; mq[1] = *(const LAS f32x4*)(Mg + 2972);
            ab0 -= mq[2][0] * xy[8]; ab1 -= mq[2][1] * xy[9]; ab0 -= mq[2][2] * xy[10]; ab1 -= mq[2][3] * xy[11]; mq[2] = *(const LAS f32x4*)(Mg + 2976);
            ab0 -= mq[3][0] * xy[12]; ab1 -= mq[3][1] * xy[13]; ab0 -= mq[3][2] * xy[14]; ab1 -= mq[3][3] * xy[15]; mq[3] = *(const LAS f32x4*)(Mg + 2980);
            ab0 -= mq[4][0] * xy[16]; ab1 -= mq[4][1] * xy[17]; ab0 -= mq[4][2] * xy[18]; ab1 -= mq[4][3] * xy[19]; mq[4] = *(const LAS f32x4*)(Mg + 2984);
            ab0 -= mq[5][0] * xy[20]; ab1 -= mq[5][1] * xy[21]; ab0 -= mq[5][2] * xy[22]; ab1 -= mq[5][3] * xy[23]; mq[5] = *(const LAS f32x4*)(Mg + 2988);
            ab0 -= mq[0][0] * xy[24]; ab1 -= mq[0][1] * xy[25]; ab0 -= mq[0][2] * xy[26]; ab1 -= mq[0][3] * xy[27]; mq[0] = *(const LAS f32x4*)(Mg + 3008);
            ab0 -= mq[1][0] * xy[28]; ab1 -= mq[1][1] * xy[29]; ab0 -= mq[1][2] * xy[30]; ab1 -= mq[1][3] * xy[31]; mq[1] = *(const LAS f32x4*)(Mg + 3012);
            ab0 -= mq[2][0] * xy[32]; ab1 -= mq[2][1] * xy[33]; ab0 -= mq[2][2] * xy[34]; ab1 -= mq[2][3] * xy[35]; mq[2] = *(const LAS f32x4*)(Mg + 3016);
            ab0 -= mq[3][0] * xy[36]; ab1 -= mq[3][1] * xy[37]; ab0 -= mq[3][2] * xy[38]; ab1 -= mq[3][3] * xy[39]; mq[3] = *(const LAS f32x4*)(Mg + 3020);
            ab0 -= mq[4][0] * xy[40]; ab1 -= mq[4][1] * xy[41]; ab0 -= mq[4][2] * xy[42]; ab1 -= mq[4][3] * xy[43]; mq[4] = *(const LAS f32x4*)(Mg + 3024);
            ab0 -= mq[5][0] * xy[44]; ab1 -= mq[5][1] * xy[45]; xy[46] = ab0 + ab1; up[5888] = xy[46][0]; wp[5888] = f2bf(-xy[46][1]); mq[5] = *(const LAS f32x4*)(Mg + 3028);
            { const float br = betg[47]; ab0 = (f32x2){bf2f(*(const LAS bf16_t*)(lg + P5_VS + 12784 + c * 2)) * br, bf2f(*(const LAS bf16_t*)(lg + P5_KS + 12784 + c * 2)) * br * __expf(decg[47])}; ab1 = (f32x2){0.f, 0.f}; } ab0 -= mq[0][0] * xy[0]; ab1 -= mq[0][1] * xy[1]; ab0 -= mq[0][2] * xy[2]; ab1 -= mq[0][3] * xy[3]; mq[0] = *(const LAS f32x4*)(Mg + 3032);
            ab0 -= mq[1][0] * xy[4]; ab1 -= mq[1][1] * xy[5]; ab0 -= mq[1][2] * xy[6]; ab1 -= mq[1][3] * xy[7]; mq[1] = *(const LAS f32x4*)(Mg + 3036);
            ab0 -= mq[2][0] * xy[8]; ab1 -= mq[2][1] * xy[9]; ab0 -= mq[2][2] * xy[10]; ab1 -= mq[2][3] * xy[11]; mq[2] = *(const LAS f32x4*)(Mg + 3040);
            ab0 -= mq[3][0] * xy[12]; ab1 -= mq[3][1] * xy[13]; ab0 -= mq[3][2] * xy[14]; ab1 -= mq[3][3] * xy[15]; mq[3] = *(const LAS f32x4*)(Mg + 3044);
            ab0 -= mq[4][0] * xy[16]; ab1 -= mq[4][1] * xy[17]; ab0 -= mq[4][2] * xy[18]; ab1 -= mq[4][3] * xy[19]; mq[4] = *(const LAS f32x4*)(Mg + 3048);
            ab0 -= mq[5][0] * xy[20]; ab1 -= mq[5][1] * xy[21]; ab0 -= mq[5][2] * xy[22]; ab1 -= mq[5][3] * xy[23]; mq[5] = *(const LAS f32x4*)(Mg + 3052);
            ab0 -= mq[0][0] * xy[24]; ab1 -= mq[0][1] * xy[25]; ab0 -= mq[0][2] * xy[26]; ab1 -= mq[0][3] * xy[27]; mq[0] = *(const LAS f32x4*)(Mg + 3072);
            ab0 -= mq[1][0] * xy[28]; ab1 -= mq[1][1] * xy[29]; ab0 -= mq[1][2] * xy[30]; ab1 -= mq[1][3] * xy[31]; mq[1] = *(const LAS f32x4*)(Mg + 3076);
            ab0 -= mq[2][0] * xy[32]; ab1 -= mq[2][1] * xy[33]; ab0 -= mq[2][2] * xy[34]; ab1 -= mq[2][3] * xy[35]; mq[2] = *(const LAS f32x4*)(Mg + 3080);
            ab0 -= mq[3][0] * xy[36]; ab1 -= mq[3][1] * xy[37]; ab0 -= mq[3][2] * xy[38]; ab1 -= mq[3][3] * xy[39]; mq[3] = *(const LAS f32x4*)(Mg + 3084);
            ab0 -= mq[4][0] * xy[40]; ab1 -= mq[4][1] * xy[41]; ab0 -= mq[4][2] * xy[42]; ab1 -= mq[4][3] * xy[43]; mq[4] = *(const LAS f32x4*)(Mg + 3088);
            ab0 -= mq[5][0] * xy[44]; ab1 -= mq[5][1] * xy[45]; ab0 -= mq[5][2] * xy[46]; xy[47] = ab0 + ab1; up[6016] = xy[47][0]; wp[6016] = f2bf(-xy[47][1]); mq[5] = *(const LAS f32x4*)(Mg + 3092);
            { const float br = betg[48]; ab0 = (f32x2){bf2f(*(const LAS bf16_t*)(lg + P5_VS + 13056 + c * 2)) * br, bf2f(*(const LAS bf16_t*)(lg + P5_KS + 13056 + c * 2)) * br * __expf(decg[48])}; ab1 = (f32x2){0.f, 0.f}; } ab0 -= mq[0][0] * xy[0]; ab1 -= mq[0][1] * xy[1]; ab0 -= mq[0][2] * xy[2]; ab1 -= mq[0][3] * xy[3]; mq[0] = *(const LAS f32x4*)(Mg + 3096);
            ab0 -= mq[1][0] * xy[4]; ab1 -= mq[1][1] * xy[5]; ab0 -= mq[1][2] * xy[6]; ab1 -= mq[1][3] * xy[7]; mq[1] = *(const LAS f32x4*)(Mg + 3100);
            ab0 -= mq[2][0] * xy[8]; ab1 -= mq[2][1] * xy[9]; ab0 -= mq[2][2] * xy[10]; ab1 -= mq[2][3] * xy[11]; mq[2] = *(const LAS f32x4*)(Mg + 3104);
            ab0 -= mq[3][0] * xy[12]; ab1 -= mq[3][1] * xy[13]; ab0 -= mq[3][2] * xy[14]; ab1 -= mq[3][3] * xy[15]; mq[3] = *(const LAS f32x4*)(Mg + 3108);
            ab0 -= mq[4][0] * xy[16]; ab1 -= mq[4][1] * xy[17]; ab0 -= mq[4][2] * xy[18]; ab1 -= mq[4][3] * xy[19]; mq[4] = *(const LAS f32x4*)(Mg + 3112);
            ab0 -= mq[5][0] * xy[20]; ab1 -= mq[5][1] * xy[21]; ab0 -= mq[5][2] * xy[22]; ab1 -= mq[5][3] * xy[23]; mq[5] = *(const LAS f32x4*)(Mg + 3116);
            ab0 -= mq[0][0] * xy[24]; ab1 -= mq[0][1] * xy[25]; ab0 -= mq[0][2] * xy[26]; ab1 -= mq[0][3] * xy[27]; mq[0] = *(const LAS f32x4*)(Mg + 3136);
            ab0 -= mq[1][0] * xy[28]; ab1 -= mq[1][1] * xy[29]; ab0 -= mq[1][2] * xy[30]; ab1 -= mq[1][3] * xy[31]; mq[1] = *(const LAS f32x4*)(Mg + 3140);
            ab0 -= mq[2][0] * xy[32]; ab1 -= mq[2][1] * xy[33]; ab0 -= mq[2][2] * xy[34]; ab1 -= mq[2][3] * xy[35]; mq[2] = *(const LAS f32x4*)(Mg + 3144);
            ab0 -= mq[3][0] * xy[36]; ab1 -= mq[3][1] * xy[37]; ab0 -= mq[3][2] * xy[38]; ab1 -= mq[3][3] * xy[39]; mq[3] = *(const LAS f32x4*)(Mg + 3148);
            ab0 -= mq[4][0] * xy[40]; ab1 -= mq[4][1] * xy[41]; ab0 -= mq[4][2] * xy[42]; ab1 -= mq[4][3] * xy[43]; mq[4] = *(const LAS f32x4*)(Mg + 3152);
            ab0 -= mq[5][0] * xy[44]; ab1 -= mq[5][1] * xy[45]; ab0 -= mq[5][2] * xy[46]; ab1 -= mq[5][3] * xy[47]; xy[48] = ab0 + ab1; up[6144] = xy[48][0]; wp[6144] = f2bf(-xy[48][1]); mq[5] = *(const LAS f32x4*)(Mg + 3156);
            { const float br = betg[49]; ab0 = (f32x2){bf2f(*(const LAS bf16_t*)(lg + P5_VS + 13328 + c * 2)) * br, bf2f(*(const LAS bf16_t*)(lg + P5_KS + 13328 + c * 2)) * br * __expf(decg[49])}; ab1 = (f32x2){0.f, 0.f}; } ab0 -= mq[0][0] * xy[0]; ab1 -= mq[0][1] * xy[1]; ab0 -= mq[0][2] * xy[2]; ab1 -= mq[0][3] * xy[3]; mq[0] = *(const LAS f32x4*)(Mg + 3160);
            ab0 -= mq[1][0] * xy[4]; ab1 -= mq[1][1] * xy[5]; ab0 -= mq[1][2] * xy[6]; ab1 -= mq[1][3] * xy[7]; mq[1] = *(const LAS f32x4*)(Mg + 3164);
            ab0 -= mq[2][0] * xy[8]; ab1 -= mq[2][1] * xy[9]; ab0 -= mq[2][2] * xy[10]; ab1 -= mq[2][3] * xy[11]; mq[2] = *(const LAS f32x4*)(Mg + 3168);
            ab0 -= mq[3][0] * xy[12]; ab1 -= mq[3][1] * xy[13]; ab0 -= mq[3][2] * xy[14]; ab1 -= mq[3][3] * xy[15]; mq[3] = *(const LAS f32x4*)(Mg + 3172);
            ab0 -= mq[4][0] * xy[16]; ab1 -= mq[4][1] * xy[17]; ab0 -= mq[4][2] * xy[18]; ab1 -= mq[4][3] * xy[19]; mq[4] = *(const LAS f32x4*)(Mg + 3176);
            ab0 -= mq[5][0] * xy[20]; ab1 -= mq[5][1] * xy[21]; ab0 -= mq[5][2] * xy[22]; ab1 -= mq[5][3] * xy[23]; mq[5] = *(const LAS f32x4*)(Mg + 3180);
            ab0 -= mq[0][0] * xy[24]; ab1 -= mq[0][1] * xy[25]; ab0 -= mq[0][2] * xy[26]; ab1 -= mq[0][3] * xy[27]; mq[0] = *(const LAS f32x4*)(Mg + 3184);
            ab0 -= mq[1][0] * xy[28]; ab1 -= mq[1][1] * xy[29]; ab0 -= mq[1][2] * xy[30]; ab1 -= mq[1][3] * xy[31]; mq[1] = *(const LAS f32x4*)(Mg + 3200);
            ab0 -= mq[2][0] * xy[32]; ab1 -= mq[2][1] * xy[33]; ab0 -= mq[2][2] * xy[34]; ab1 -= mq[2][3] * xy[35]; mq[2] = *(const LAS f32x4*)(Mg + 3204);
            ab0 -= mq[3][0] * xy[36]; ab1 -= mq[3][1] * xy[37]; ab0 -= mq[3][2] * xy[38]; ab1 -= mq[3][3] * xy[39]; mq[3] = *(const LAS f32x4*)(Mg + 3208);
            ab0 -= mq[4][0] * xy[40]; ab1 -= mq[4][1] * xy[41]; ab0 -= mq[4][2] * xy[42]; ab1 -= mq[4][3] * xy[43]; mq[4] = *(const LAS f32x4*)(Mg + 3212);
            ab0 -= mq[5][0] * xy[44]; ab1 -= mq[5][1] * xy[45]; ab0 -= mq[5][2] * xy[46]; ab1 -= mq[5][3] * xy[47]; mq[5] = *(const LAS f32x4*)(Mg + 3216);
            ab0 -= mq[0][0] * xy[48]; xy[49] = ab0 + ab1; up[6272] = xy[49][0]; wp[6272] = f2bf(-xy[49][1]); mq[0] = *(const LAS f32x4*)(Mg + 3220);
            { const float br = betg[50]; ab0 = (f32x2){bf2f(*(const LAS bf16_t*)(lg + P5_VS + 13600 + c * 2)) * br, bf2f(*(const LAS bf16_t*)(lg + P5_KS + 13600 + c * 2)) * br * __expf(decg[50])}; ab1 = (f32x2){0.f, 0.f}; } ab0 -= mq[1][0] * xy[0]; ab1 -= mq[1][1] * xy[1]; ab0 -= mq[1][2] * xy[2]; ab1 -= mq[1][3] * xy[3]; mq[1] = *(const LAS f32x4*)(Mg + 3224);
            ab0 -= mq[2][0] * xy[4]; ab1 -= mq[2][1] * xy[5]; ab0 -= mq[2][2] * xy[6]; ab1 -= mq[2][3] * xy[7]; mq[2] = *(const LAS f32x4*)(Mg + 3228);
            ab0 -= mq[3][0] * xy[8]; ab1 -= mq[3][1] * xy[9]; ab0 -= mq[3][2] * xy[10]; ab1 -= mq[3][3] * xy[11]; mq[3] = *(const LAS f32x4*)(Mg + 3232);
            ab0 -= mq[4][0] * xy[12]; ab1 -= mq[4][1] * xy[13]; ab0 -= mq[4][2] * xy[14]; ab1 -= mq[4][3] * xy[15]; mq[4] = *(const LAS f32x4*)(Mg + 3236);
            ab0 -= mq[5][0] * xy[16]; ab1 -= mq[5][1] * xy[17]; ab0 -= mq[5][2] * xy[18]; ab1 -= mq[5][3] * xy[19]; mq[5] = *(const LAS f32x4*)(Mg + 3240);
            ab0 -= mq[0][0] * xy[20]; ab1 -= mq[0][1] * xy[21]; ab0 -= mq[0][2] * xy[22]; ab1 -= mq[0][3] * xy[23]; mq[0] = *(const LAS f32x4*)(Mg + 3244);
            ab0 -= mq[1][0] * xy[24]; ab1 -= mq[1][1] * xy[25]; ab0 -= mq[1][2] * xy[26]; ab1 -= mq[1][3] * xy[27]; mq[1] = *(const LAS f32x4*)(Mg + 3248);
            ab0 -= mq[2][0] * xy[28]; ab1 -= mq[2][1] * xy[29]; ab0 -= mq[2][2] * xy[30]; ab1 -= mq[2][3] * xy[31]; mq[2] = *(const LAS f32x4*)(Mg + 3264);
            ab0 -= mq[3][0] * xy[32]; ab1 -= mq[3][1] * xy[33]; ab0 -= mq[3][2] * xy[34]; ab1 -= mq[3][3] * xy[35]; mq[3] = *(const LAS f32x4*)(Mg + 3268);
            ab0 -= mq[4][0] * xy[36]; ab1 -= mq[4][1] * xy[37]; ab0 -= mq[4][2] * xy[38]; ab1 -= mq[4][3] * xy[39]; mq[4] = *(const LAS f32x4*)(Mg + 3272);
            ab0 -= mq[5][0] * xy[40]; ab1 -= mq[5][1] * xy[41]; ab0 -= mq[5][2] * xy[42]; ab1 -= mq[5][3] * xy[43]; mq[5] = *(const LAS f32x4*)(Mg + 3276);
            ab0 -= mq[0][0] * xy[44]; ab1 -= mq[0][1] * xy[45]; ab0 -= mq[0][2] * xy[46]; ab1 -= mq[0][3] * xy[47]; mq[0] = *(const LAS f32x4*)(Mg + 3280);
            ab0 -= mq[1][0] * xy[48]; ab1 -= mq[1][1] * xy[49]; xy[50] = ab0 + ab1; up[6400] = xy[50][0]; wp[6400] = f2bf(-xy[50][1]); mq[1] = *(const LAS f32x4*)(Mg + 3284);
            { const float br = betg[51]; ab0 = (f32x2){bf2f(*(const LAS bf16_t*)(lg + P5_VS + 13872 + c * 2)) * br, bf2f(*(const LAS bf16_t*)(lg + P5_KS + 13872 + c * 2)) * br * __expf(decg[51])}; ab1 = (f32x2){0.f, 0.f}; } ab0 -= mq[2][0] * xy[0]; ab1 -= mq[2][1] * xy[1]; ab0 -= mq[2][2] * xy[2]; ab1 -= mq[2][3] * xy[3]; mq[2] = *(const LAS f32x4*)(Mg + 3288);
            ab0 -= mq[3][0] * xy[4]; ab1 -= mq[3][1] * xy[5]; ab0 -= mq[3][2] * xy[6]; ab1 -= mq[3][3] * xy[7]; mq[3] = *(const LAS f32x4*)(Mg + 3292);
            ab0 -= mq[4][0] * xy[8]; ab1 -= mq[4][1] * xy[9]; ab0 -= mq[4][2] * xy[10]; ab1 -= mq[4][3] * xy[11]; mq[4] = *(const LAS f32x4*)(Mg + 3296);
            ab0 -= mq[5][0] * xy[12]; ab1 -= mq[5][1] * xy[13]; ab0 -= mq[5][2] * xy[14]; ab1 -= mq[5][3] * xy[15]; mq[5] = *(const LAS f32x4*)(Mg + 3300);
            ab0 -= mq[0][0] * xy[16]; ab1 -= mq[0][1] * xy[17]; ab0 -= mq[0][2] * xy[18]; ab1 -= mq[0][3] * xy[19]; mq[0] = *(const LAS f32x4*)(Mg + 3304);
            ab0 -= mq[1][0] * xy[20]; ab1 -= mq[1][1] * xy[21]; ab0 -= mq[1][2] * xy[22]; ab1 -= mq[1][3] * xy[23]; mq[1] = *(const LAS f32x4*)(Mg + 3308);
            ab0 -= mq[2][0] * xy[24]; ab1 -= mq[2][1] * xy[25]; ab0 -= mq[2][2] * xy[26]; ab1 -= mq[2][3] * xy[27]; mq[2] = *(const LAS f32x4*)(Mg + 3312);
            ab0 -= mq[3][0] * xy[28]; ab1 -= mq[3][1] * xy[29]; ab0 -= mq[3][2] * xy[30]; ab1 -= mq[3][3] * xy[31]; mq[3] = *(const LAS f32x4*)(Mg + 3328);
            ab0 -= mq[4][0] * xy[32]; ab1 -= mq[4][1] * xy[33]; ab0 -= mq[4][2] * xy[34]; ab1 -= mq[4][3] * xy[35]; mq[4] = *(const LAS f32x4*)(Mg + 3332);
            ab0 -= mq[5][0] * xy[36]; ab1 -= mq[5][1] * xy[37]; ab0 -= mq[5][2] * xy[38]; ab1 -= mq[5][3] * xy[39]; mq[5] = *(const LAS f32x4*)(Mg + 3336);
            ab0 -= mq[0][0] * xy[40]; ab1 -= mq[0][1] * xy[41]; ab0 -= mq[0][2] * xy[42]; ab1 -= mq[0][3] * xy[43]; mq[0] = *(const LAS f32x4*)(Mg + 3340);
            ab0 -= mq[1][0] * xy[44]; ab1 -= mq[1][1] * xy[45]; ab0 -= mq[1][2] * xy[46]; ab1 -= mq[1][3] * xy[47]; mq[1] = *(const LAS f32x4*)(Mg + 3344);
            ab0 -= mq[2][0] * xy[48]; ab1 -= mq[2][1] * xy[49]; ab0 -= mq[2][2] * xy[50]; xy[51] = ab0 + ab1; up[6528] = xy[51][0]; wp[6528] = f2bf(-xy[51][1]); mq[2] = *(const LAS f32x4*)(Mg + 3348);
            { const float br = betg[52]; ab0 = (f32x2){bf2f(*(const LAS bf16_t*)(lg + P5_VS + 14144 + c * 2)) * br, bf2f(*(const LAS bf16_t*)(lg + P5_KS + 14144 + c * 2)) * br * __expf(decg[52])}; ab1 = (f32x2){0.f, 0.f}; } ab0 -= mq[3][0] * xy[0]; ab1 -= mq[3][1] * xy[1]; ab0 -= mq[3][2] * xy[2]; ab1 -= mq[3][3] * xy[3]; mq[3] = *(const LAS f32x4*)(Mg + 3352);
            ab0 -= mq[4][0] * xy[4]; ab1 -= mq[4][1] * xy[5]; ab0 -= mq[4][2] * xy[6]; ab1 -= mq[4][3] * xy[7]; mq[4] = *(const LAS f32x4*)(Mg + 3356);
            ab0 -= mq[5][0] * xy[8]; ab1 -= mq[5][1] * xy[9]; ab0 -= mq[5][2] * xy[10]; ab1 -= mq[5][3] * xy[11]; mq[5] = *(const LAS f32x4*)(Mg + 3360);
            ab0 -= mq[0][0] * xy[12]; ab1 -= mq[0][1] * xy[13]; ab0 -= mq[0][2] * xy[14]; ab1 -= mq[0][3] * xy[15]; mq[0] = *(const LAS f32x4*)(Mg + 3364);
            ab0 -= mq[1][0] * xy[16]; ab1 -= mq[1][1] * xy[17]; ab0 -= mq[1][2] * xy[18]; ab1 -= mq[1][3] * xy[19]; mq[1] = *(const LAS f32x4*)(Mg + 3368);
            ab0 -= mq[2][0] * xy[20]; ab1 -= mq[2][1] * xy[21]; ab0 -= mq[2][2] * xy[22]; ab1 -= mq[2][3] * xy[23]; mq[2] = *(const LAS f32x4*)(Mg + 3372);
            ab0 -= mq[3][0] * xy[24]; ab1 -= mq[3][1] * xy[25]; ab0 -= mq[3][2] * xy[26]; ab1 -= mq[3][3] * xy[27]; mq[3] = *(const LAS f32x4*)(Mg + 3376);
            ab0 -= mq[4][0] * xy[28]; ab1 -= mq[4][1] * xy[29]; ab0 -= mq[4][2] * xy[30]; ab1 -= mq[4][3] * xy[31]; mq[4] = *(const LAS f32x4*)(Mg + 3392);
            ab0 -= mq[5][0] * xy[32]; ab1 -= mq[5][1] * xy[33]; ab0 -= mq[5][2] * xy[34]; ab1 -= mq[5][3] * xy[35]; mq[5] = *(const LAS f32x4*)(Mg + 3396);
            ab0 -= mq[0][0] * xy[36]; ab1 -= mq[0][1] * xy[37]; ab0 -= mq[0][2] * xy[38]; ab1 -= mq[0][3] * xy[39]; mq[0] = *(const LAS f32x4*)(Mg + 3400);
            ab0 -= mq[1][0] * xy[40]; ab1 -= mq[1][1] * xy[41]; ab0 -= mq[1][2] * xy[42]; ab1 -= mq[1][3] * xy[43]; mq[1] = *(const LAS f32x4*)(Mg + 3404);
            ab0 -= mq[2][0] * xy[44]; ab1 -= mq[2][1] * xy[45]; ab0 -= mq[2][2] * xy[46]; ab1 -= mq[2][3] * xy[47]; mq[2] = *(const LAS f32x4*)(Mg + 3408);
            ab0 -= mq[3][0] * xy[48]; ab1 -= mq[3][1] * xy[49]; ab0 -= mq[3][2] * xy[50]; ab1 -= mq[3][3] * xy[51]; xy[52] = ab0 + ab1; up[6656] = xy[52][0]; wp[6656] = f2bf(-xy[52][1]); mq[3] = *(const LAS f32x4*)(Mg + 3412);
            { const float br = betg[53]; ab0 = (f32x2){bf2f(*(const LAS bf16_t*)(lg + P5_VS + 14416 + c * 2)) * br, bf2f(*(const LAS bf16_t*)(lg + P5_KS + 14416 + c * 2)) * br * __expf(decg[53])}; ab1 = (f32x2){0.f, 0.f}; } ab0 -= mq[4][0] * xy[0]; ab1 -= mq[4][1] * xy[1]; ab0 -= mq[4][2] * xy[2]; ab1 -= mq[4][3] * xy[3]; mq[4] = *(const LAS f32x4*)(Mg + 3416);
            ab0 -= mq[5][0] * xy[4]; ab1 -= mq[5][1] * xy[5]; ab0 -= mq[5][2] * xy[6]; ab1 -= mq[5][3] * xy[7]; mq[5] = *(const LAS f32x4*)(Mg + 3420);
            ab0 -= mq[0][0] * xy[8]; ab1 -= mq[0][1] * xy[9]; ab0 -= mq[0][2] * xy[10]; ab1 -= mq[0][3] * xy[11]; mq[0] = *(const LAS f32x4*)(Mg + 3424);
            ab0 -= mq[1][0] * xy[12]; ab1 -= mq[1][1] * xy[13]; ab0 -= mq[1][2] * xy[14]; ab1 -= mq[1][3] * xy[15]; mq[1] = *(const LAS f32x4*)(Mg + 3428);
            ab0 -= mq[2][0] * xy[16]; ab1 -= mq[2][1] * xy[17]; ab0 -= mq[2][2] * xy[18]; ab1 -= mq[2][3] * xy[19]; mq[2] = *(const LAS f32x4*)(Mg + 3432);
            ab0 -= mq[3][0] * xy[20]; ab1 -= mq[3][1] * xy[21]; ab0 -= mq[3][2] * xy[22]; ab1 -= mq[3][3] * xy[23]; mq[3] = *(const LAS f32x4*)(Mg + 3436);
            ab0 -= mq[4][0] * xy[24]; ab1 -= mq[4][1] * xy[25]; ab0 -= mq[4][2] * xy[26]; ab1 -= mq[4][3] * xy[27]; mq[4] = *(const LAS f32x4*)(Mg + 3440);
            ab0 -= mq[5][0] * xy[28]; ab1 -= mq[5][1] * xy[29]; ab0 -= mq[5][2] * xy[30]; ab1 -= mq[5][3] * xy[31]; mq[5] = *(const LAS f32x4*)(Mg + 3444);
            ab0 -= mq[0][0] * xy[32]; ab1 -= mq[0][1] * xy[33]; ab0 -= mq[0][2] * xy[34]; ab1 -= mq[0][3] * xy[35]; mq[0] = *(const LAS f32x4*)(Mg + 3456);
            ab0 -= mq[1][0] * xy[36]; ab1 -= mq[1][1] * xy[37]; ab0 -= mq[1][2] * xy[38]; ab1 -= mq[1][3] * xy[39]; mq[1] = *(const LAS f32x4*)(Mg + 3460);
            ab0 -= mq[2][0] * xy[40]; ab1 -= mq[2][1] * xy[41]; ab0 -= mq[2][2] * xy[42]; ab1 -= mq[2][3] * xy[43]; mq[2] = *(const LAS f32x4*)(Mg + 3464);
            ab0 -= mq[3][0] * xy[44]; ab1 -= mq[3][1] * xy[45]; ab0 -= mq[3][2] * xy[46]; ab1 -= mq[3][3] * xy[47]; mq[3] = *(const LAS f32x4*)(Mg + 3468);
            ab0 -= mq[4][0] * xy[48]; ab1 -= mq[4][1] * xy[49]; ab0 -= mq[4][2] * xy[50]; ab1 -= mq[4][3] * xy[51]; mq[4] = *(const LAS f32x4*)(Mg + 3472);
            ab0 -= mq[5][0] * xy[52]; xy[53] = ab0 + ab1; up[6784] = xy[53][0]; wp[6784] = f2bf(-xy[53][1]); mq[5] = *(const LAS f32x4*)(Mg + 3476);
            { const float br = betg[54]; ab0 = (f32x2){bf2f(*(const LAS bf16_t*)(lg + P5_VS + 14688 + c * 2)) * br, bf2f(*(const LAS bf16_t*)(lg + P5_KS + 14688 + c * 2)) * br * __expf(decg[54])}; ab1 = (f32x2){0.f, 0.f}; } ab0 -= mq[0][0] * xy[0]; ab1 -= mq[0][1] * xy[1]; ab0 -= mq[0][2] * xy[2]; ab1 -= mq[0][3] * xy[3]; mq[0] = *(const LAS f32x4*)(Mg + 3480);
            ab0 -= mq[1][0] * xy[4]; ab1 -= mq[1][1] * xy[5]; ab0 -= mq[1][2] * xy[6]; ab1 -= mq[1][3] * xy[7]; mq[1] = *(const LAS f32x4*)(Mg + 3484);
            ab0 -= mq[2][0] * xy[8]; ab1 -= mq[2][1] * xy[9]; ab0 -= mq[2][2] * xy[10]; ab1 -= mq[2][3] * xy[11]; mq[2] = *(const LAS f32x4*)(Mg + 3488);
            ab0 -= mq[3][0] * xy[12]; ab1 -= mq[3][1] * xy[13]; ab0 -= mq[3][2] * xy[14]; ab1 -= mq[3][3] * xy[15]; mq[3] = *(const LAS f32x4*)(Mg + 3492);
            ab0 -= mq[4][0] * xy[16]; ab1 -= mq[4][1] * xy[17]; ab0 -= mq[4][2] * xy[18]; ab1 -= mq[4][3] * xy[19]; mq[4] = *(const LAS f32x4*)(Mg + 3496);
            ab0 -= mq[5][0] * xy[20]; ab1 -= mq[5][1] * xy[21]; ab0 -= mq[5][2] * xy[22]; ab1 -= mq[5][3] * xy[23]; mq[5] = *(const LAS f32x4*)(Mg + 3500);
            ab0 -= mq[0][0] * xy[24]; ab1 -= mq[0][1] * xy[25]; ab0 -= mq[0][2] * xy[26]; ab1 -= mq[0][3] * xy[27]; mq[0] = *(const LAS f32x4*)(Mg + 3504);
            ab0 -= mq[1][0] * xy[28]; ab1 -= mq[1][1] * xy[29]; ab0 -= mq[1][2] * xy[30]; ab1 -= mq[1][3] * xy[31]; mq[1] = *(const LAS f32x4*)(Mg + 3508);
            ab0 -= mq[2][0] * xy[32]; ab1 -= mq[2][1] * xy[33]; ab0 -= mq[2][2] * xy[34]; ab1 -= mq[2][3] * xy[35]; mq[2] = *(const LAS f32x4*)(Mg + 3520);
            ab0 -= mq[3][0] * xy[36]; ab1 -= mq[3][1] * xy[37]; ab0 -= mq[3][2] * xy[38]; ab1 -= mq[3][3] * xy[39]; mq[3] = *(const LAS f32x4*)(Mg + 3524);
            ab0 -= mq[4][0] * xy[40]; ab1 -= mq[4][1] * xy[41]; ab0 -= mq[4][2] * xy[42]; ab1 -= mq[4][3] * xy[43]; mq[4] = *(const LAS f32x4*)(Mg + 3528);
            ab0 -= mq[5][0] * xy[44]; ab1 -= mq[5][1] * xy[45]; ab0 -= mq[5][2] * xy[46]; ab1 -= mq[5][3] * xy[47]; mq[5] = *(const LAS f32x4*)(Mg + 3532);
            ab0 -= mq[0][0] * xy[48]; ab1 -= mq[0][1] * xy[49]; ab0 -= mq[0][2] * xy[50]; ab1 -= mq[0][3] * xy[51]; mq[0] = *(const LAS f32x4*)(Mg + 3536);
            ab0 -= mq[1][0] * xy[52]; ab1 -= mq[1][1] * xy[53]; xy[54] = ab0 + ab1; up[6912] = xy[54][0]; wp[6912] = f2bf(-xy[54][1]); mq[1] = *(const LAS f32x4*)(Mg + 3540);
            { const float br = betg[55]; ab0 = (f32x2){bf2f(*(const LAS bf16_t*)(lg + P5_VS + 14960 + c * 2)) * br, bf2f(*(const LAS bf16_t*)(lg + P5_KS + 14960 + c * 2)) * br * __expf(decg[55])}; ab1 = (f32x2){0.f, 0.f}; } ab0 -= mq[2][0] * xy[0]; ab1 -= mq[2][1] * xy[1]; ab0 -= mq[2][2] * xy[2]; ab1 -= mq[2][3] * xy[3]; mq[2] = *(const LAS f32x4*)(Mg + 3544);
            ab0 -= mq[3][0] * xy[4]; ab1 -= mq[3][1] * xy[5]; ab0 -= mq[3][2] * xy[6]; ab1 -= mq[3][3] * xy[7]; mq[3] = *(const LAS f32x4*)(Mg + 3548);
            ab0 -= mq[4][0] * xy[8]; ab1 -= mq[4][1] * xy[9]; ab0 -= mq[4][2] * xy[10]; ab1 -= mq[4][3] * xy[11]; mq[4] = *(const LAS f32x4*)(Mg + 3552);
            ab0 -= mq[5][0] * xy[12]; ab1 -= mq[5][1] * xy[13]; ab0 -= mq[5][2] * xy[14]; ab1 -= mq[5][3] * xy[15]; mq[5] = *(const LAS f32x4*)(Mg + 3556);
            ab0 -= mq[0][0] * xy[16]; ab1 -= mq[0][1] * xy[17]; ab0 -= mq[0][2] * xy[18]; ab1 -= mq[0][3] * xy[19]; mq[0] = *(const LAS f32x4*)(Mg + 3560);
            ab0 -= mq[1][0] * xy[20]; ab1 -= mq[1][1] * xy[21]; ab0 -= mq[1][2] * xy[22]; ab1 -= mq[1][3] * xy[23]; mq[1] = *(const LAS f32x4*)(Mg + 3564);
            ab0 -= mq[2][0] * xy[24]; ab1 -= mq[2][1] * xy[25]; ab0 -= mq[2][2] * xy[26]; ab1 -= mq[2][3] * xy[27]; mq[2] = *(const LAS f32x4*)(Mg + 3568);
            ab0 -= mq[3][0] * xy[28]; ab1 -= mq[3][1] * xy[29]; ab0 -= mq[3][2] * xy[30]; ab1 -= mq[3][3] * xy[31]; mq[3] = *(const LAS f32x4*)(Mg + 3572);
            ab0 -= mq[4][0] * xy[32]; ab1 -= mq[4][1] * xy[33]; ab0 -= mq[4][2] * xy[34]; ab1 -= mq[4][3] * xy[35]; mq[4] = *(const LAS f32x4*)(Mg + 3584);
            ab0 -= mq[5][0] * xy[36]; ab1 -= mq[5][1] * xy[37]; ab0 -= mq[5][2] * xy[38]; ab1 -= mq[5][3] * xy[39]; mq[5] = *(const LAS f32x4*)(Mg + 3588);
            ab0 -= mq[0][0] * xy[40]; ab1 -= mq[0][1] * xy[41]; ab0 -= mq[0][2] * xy[42]; ab1 -= mq[0][3] * xy[43]; mq[0] = *(const LAS f32x4*)(Mg + 3592);
            ab0 -= mq[1][0] * xy[44]; ab1 -= mq[1][1] * xy[45]; ab0 -= mq[1][2] * xy[46]; ab1 -= mq[1][3] * xy[47]; mq[1] = *(const LAS f32x4*)(Mg + 3596);
            ab0 -= mq[2][0] * xy[48]; ab1 -= mq[2][1] * xy[49]; ab0 -= mq[2][2] * xy[50]; ab1 -= mq[2][3] * xy[51]; mq[2] = *(const LAS f32x4*)(Mg + 3600);
            ab0 -= mq[3][0] * xy[52]; ab1 -= mq[3][1] * xy[53]; ab0 -= mq[3][2] * xy[54]; xy[55] = ab0 + ab1; up[7040] = xy[55][0]; wp[7040] = f2bf(-xy[55][1]); mq[3] = *(const LAS f32x4*)(Mg + 3604);
            { const float br = betg[56]; ab0 = (f32x2){bf2f(*(const LAS bf16_t*)(lg + P5_VS + 15232 + c * 2)) * br, bf2f(*(const LAS bf16_t*)(lg + P5_KS + 15232 + c * 2)) * br * __expf(decg[56])}; ab1 = (f32x2){0.f, 0.f}; } ab0 -= mq[4][0] * xy[0]; ab1 -= mq[4][1] * xy[1]; ab0 -= mq[4][2] * xy[2]; ab1 -= mq[4][3] * xy[3]; mq[4] = *(const LAS f32x4*)(Mg + 3608);
            ab0 -= mq[5][0] * xy[4]; ab1 -= mq[5][1] * xy[5]; ab0 -= mq[5][2] * xy[6]; ab1 -= mq[5][3] * xy[7]; mq[5] = *(const LAS f32x4*)(Mg + 3612);
            ab0 -= mq[0][0] * xy[8]; ab1 -= mq[0][1] * xy[9]; ab0 -= mq[0][2] * xy[10]; ab1 -= mq[0][3] * xy[11]; mq[0] = *(const LAS f32x4*)(Mg + 3616);
            ab0 -= mq[1][0] * xy[12]; ab1 -= mq[1][1] * xy[13]; ab0 -= mq[1][2] * xy[14]; ab1 -= mq[1][3] * xy[15]; mq[1] = *(const LAS f32x4*)(Mg + 3620);
            ab0 -= mq[2][0] * xy[16]; ab1 -= mq[2][1] * xy[17]; ab0 -= mq[2][2] * xy[18]; ab1 -= mq[2][3] * xy[19]; mq[2] = *(const LAS f32x4*)(Mg + 3624);
            ab0 -= mq[3][0] * xy[20]; ab1 -= mq[3][1] * xy[21]; ab0 -= mq[3][2] * xy[22]; ab1 -= mq[3][3] * xy[23]; mq[3] = *(const LAS f32x4*)(Mg + 3628);
            ab0 -= mq[4][0] * xy[24]; ab1 -= mq[4][1] * xy[25]; ab0 -= mq[4][2] * xy[26]; ab1 -= mq[4][3] * xy[27]; mq[4] = *(const LAS f32x4*)(Mg + 3632);
            ab0 -= mq[5][0] * xy[28]; ab1 -= mq[5][1] * xy[29]; ab0 -= mq[5][2] * xy[30]; ab1 -= mq[5][3] * xy[31]; mq[5] = *(const LAS f32x4*)(Mg + 3636);
            ab0 -= mq[0][0] * xy[32]; ab1 -= mq[0][1] * xy[33]; ab0 -= mq[0][2] * xy[34]; ab1 -= mq[0][3] * xy[35]; mq[0] = *(const LAS f32x4*)(Mg + 3648);
            ab0 -= mq[1][0] * xy[36]; ab1 -= mq[1][1] * xy[37]; ab0 -= mq[1][2] * xy[38]; ab1 -= mq[1][3] * xy[39]; mq[1] = *(const LAS f32x4*)(Mg + 3652);
            ab0 -= mq[2][0] * xy[40]; ab1 -= mq[2][1] * xy[41]; ab0 -= mq[2][2] * xy[42]; ab1 -= mq[2][3] * xy[43]; mq[2] = *(const LAS f32x4*)(Mg + 3656);
            ab0 -= mq[3][0] * xy[44]; ab1 -= mq[3][1] * xy[45]; ab0 -= mq[3][2] * xy[46]; ab1 -= mq[3][3] * xy[47]; mq[3] = *(const LAS f32x4*)(Mg + 3660);
            ab0 -= mq[4][0] * xy[48]; ab1 -= mq[4][1] * xy[49]; ab0 -= mq[4][2] * xy[50]; ab1 -= mq[4][3] * xy[51]; mq[4] = *(const LAS f32x4*)(Mg + 3664);
            ab0 -= mq[5][0] * xy[52]; ab1 -= mq[5][1] * xy[53]; ab0 -= mq[5][2] * xy[54]; ab1 -= mq[5][3] * xy[55]; xy[56] = ab0 + ab1; up[7168] = xy[56][0]; wp[7168] = f2bf(-xy[56][1]); mq[5] = *(const LAS f32x4*)(Mg + 3668);
            { const float br = betg[57]; ab0 = (f32x2){bf2f(*(const LAS bf16_t*)(lg + P5_VS + 15504 + c * 2)) * br, bf2f(*(const LAS bf16_t*)(lg + P5_KS + 15504 + c * 2)) * br * __expf(decg[57])}; ab1 = (f32x2){0.f, 0.f}; } ab0 -= mq[0][0] * xy[0]; ab1 -= mq[0][1] * xy[1]; ab0 -= mq[0][2] * xy[2]; ab1 -= mq[0][3] * xy[3]; mq[0] = *(const LAS f32x4*)(Mg + 3672);
            ab0 -= mq[1][0] * xy[4]; ab1 -= mq[1][1] * xy[5]; ab0 -= mq[1][2] * xy[6]; ab1 -= mq[1][3] * xy[7]; mq[1] = *(const LAS f32x4*)(Mg + 3676);
            ab0 -= mq[2][0] * xy[8]; ab1 -= mq[2][1] * xy[9]; ab0 -= mq[2][2] * xy[10]; ab1 -= mq[2][3] * xy[11]; mq[2] = *(const LAS f32x4*)(Mg + 3680);
            ab0 -= mq[3][0] * xy[12]; ab1 -= mq[3][1] * xy[13]; ab0 -= mq[3][2] * xy[14]; ab1 -= mq[3][3] * xy[15]; mq[3] = *(const LAS f32x4*)(Mg + 3684);
            ab0 -= mq[4][0] * xy[16]; ab1 -= mq[4][1] * xy[17]; ab0 -= mq[4][2] * xy[18]; ab1 -= mq[4][3] * xy[19]; mq[4] = *(const LAS f32x4*)(Mg + 3688);
            ab0 -= mq[5][0] * xy[20]; ab1 -= mq[5][1] * xy[21]; ab0 -= mq[5][2] * xy[22]; ab1 -= mq[5][3] * xy[23]; mq[5] = *(const LAS f32x4*)(Mg + 3692);
            ab0 -= mq[0][0] * xy[24]; ab1 -= mq[0][1] * xy[25]; ab0 -= mq[0][2] * xy[26]; ab1 -= mq[0][3] * xy[27]; mq[0] = *(const LAS f32x4*)(Mg + 3696);
            ab0 -= mq[1][0] * xy[28]; ab1 -= mq[1][1] * xy[29]; ab0 -= mq[1][2] * xy[30]; ab1 -= mq[1][3] * xy[31]; mq[1] = *(const LAS f32x4*)(Mg + 3700);
            ab0 -= mq[2][0] * xy[32]; ab1 -= mq[2][1] * xy[33]; ab0 -= mq[2][2] * xy[34]; ab1 -= mq[2][3] * xy[35]; mq[2] = *(const LAS f32x4*)(Mg + 3704);
            ab0 -= mq[3][0] * xy[36]; ab1 -= mq[3][1] * xy[37]; ab0 -= mq[3][2] * xy[38]; ab1 -= mq[3][3] * xy[39]; mq[3] = *(const LAS f32x4*)(Mg + 3712);
            ab0 -= mq[4][0] * xy[40]; ab1 -= mq[4][1] * xy[41]; ab0 -= mq[4][2] * xy[42]; ab1 -= mq[4][3] * xy[43]; mq[4] = *(const LAS f32x4*)(Mg + 3716);
            ab0 -= mq[5][0] * xy[44]; ab1 -= mq[5][1] * xy[45]; ab0 -= mq[5][2] * xy[46]; ab1 -= mq[5][3] * xy[47]; mq[5] = *(const LAS f32x4*)(Mg + 3720);
            ab0 -= mq[0][0] * xy[48]; ab1 -= mq[0][1] * xy[49]; ab0 -= mq[0][2] * xy[50]; ab1 -= mq[0][3] * xy[51]; mq[0] = *(const LAS f32x4*)(Mg + 3724);
            ab0 -= mq[1][0] * xy[52]; ab1 -= mq[1][1] * xy[53]; ab0 -= mq[1][2] * xy[54]; ab1 -= mq[1][3] * xy[55]; mq[1] = *(const LAS f32x4*)(Mg + 3728);
            ab0 -= mq[2][0] * xy[56]; xy[57] = ab0 + ab1; up[7296] = xy[57][0]; wp[7296] = f2bf(-xy[57][1]); mq[2] = *(const LAS f32x4*)(Mg + 3732);
            { const float br = betg[58]; ab0 = (f32x2){bf2f(*(const LAS bf16_t*)(lg + P5_VS + 15776 + c * 2)) * br, bf2f(*(const LAS bf16_t*)(lg + P5_KS + 15776 + c * 2)) * br * __expf(decg[58])}; ab1 = (f32x2){0.f, 0.f}; } ab0 -= mq[3][0] * xy[0]; ab1 -= mq[3][1] * xy[1]; ab0 -= mq[3][2] * xy[2]; ab1 -= mq[3][3] * xy[3]; mq[3] = *(const LAS f32x4*)(Mg + 3736);
            ab0 -= mq[4][0] * xy[4]; ab1 -= mq[4][1] * xy[5]; ab0 -= mq[4][2] * xy[6]; ab1 -= mq[4][3] * xy[7]; mq[4] = *(const LAS f32x4*)(Mg + 3740);
            ab0 -= mq[5][0] * xy[8]; ab1 -= mq[5][1] * xy[9]; ab0 -= mq[5][2] * xy[10]; ab1 -= mq[5][3] * xy[11]; mq[5] = *(const LAS f32x4*)(Mg + 3744);
            ab0 -= mq[0][0] * xy[12]; ab1 -= mq[0][1] * xy[13]; ab0 -= mq[0][2] * xy[14]; ab1 -= mq[0][3] * xy[15]; mq[0] = *(const LAS f32x4*)(Mg + 3748);
            ab0 -= mq[1][0] * xy[16]; ab1 -= mq[1][1] * xy[17]; ab0 -= mq[1][2] * xy[18]; ab1 -= mq[1][3] * xy[19]; mq[1] = *(const LAS f32x4*)(Mg + 3752);
            ab0 -= mq[2][0] * xy[20]; ab1 -= mq[2][1] * xy[21]; ab0 -= mq[2][2] * xy[22]; ab1 -= mq[2][3] * xy[23]; mq[2] = *(const LAS f32x4*)(Mg + 3756);
            ab0 -= mq[3][0] * xy[24]; ab1 -= mq[3][1] * xy[25]; ab0 -= mq[3][2] * xy[26]; ab1 -= mq[3][3] * xy[27]; mq[3] = *(const LAS f32x4*)(Mg + 3760);
            ab0 -= mq[4][0] * xy[28]; ab1 -= mq[4][1] * xy[29]; ab0 -= mq[4][2] * xy[30]; ab1 -= mq[4][3] * xy[31]; mq[4] = *(const LAS f32x4*)(Mg + 3764);
            ab0 -= mq[5][0] * xy[32]; ab1 -= mq[5][1] * xy[33]; ab0 -= mq[5][2] * xy[34]; ab1 -= mq[5][3] * xy[35]; mq[5] = *(const LAS f32x4*)(Mg + 3768);
            ab0 -= mq[0][0] * xy[36]; ab1 -= mq[0][1] * xy[37]; ab0 -= mq[0][2] * xy[38]; ab1 -= mq[0][3] * xy[39]; mq[0] = *(const LAS f32x4*)(Mg + 3776);
            ab0 -= mq[1][0] * xy[40]; ab1 -= mq[1][1] * xy[41]; ab0 -= mq[1][2] * xy[42]; ab1 -= mq[1][3] * xy[43]; mq[1] = *(const LAS f32x4*)(Mg + 3780);
            ab0 -= mq[2][0] * xy[44]; ab1 -= mq[2][1] * xy[45]; ab0 -= mq[2][2] * xy[46]; ab1 -= mq[2][3] * xy[47]; mq[2] = *(const LAS f32x4*)(Mg + 3784);
            ab0 -= mq[3][0] * xy[48]; ab1 -= mq[3][1] * xy[49]; ab0 -= mq[3][2] * xy[50]; ab1 -= mq[3][3] * xy[51]; mq[3] = *(const LAS f32x4*)(Mg + 3788);
            ab0 -= mq[4][0] * xy[52]; ab1 -= mq[4][1] * xy[53]; ab0 -= mq[4][2] * xy[54]; ab1 -= mq[4][3] * xy[55]; mq[4] = *(const LAS f32x4*)(Mg + 3792);
            ab0 -= mq[5][0] * xy[56]; ab1 -= mq[5][1] * xy[57]; xy[58] = ab0 + ab1; up[7424] = xy[58][0]; wp[7424] = f2bf(-xy[58][1]); mq[5] = *(const LAS f32x4*)(Mg + 3796);
            { const float br = betg[59]; ab0 = (f32x2){bf2f(*(const LAS bf16_t*)(lg + P5_VS + 16048 + c * 2)) * br, bf2f(*(const LAS bf16_t*)(lg + P5_KS + 16048 + c * 2)) * br * __expf(decg[59])}; ab1 = (f32x2){0.f, 0.f}; } ab0 -= mq[0][0] * xy[0]; ab1 -= mq[0][1] * xy[1]; ab0 -= mq[0][2] * xy[2]; ab1 -= mq[0][3] * xy[3]; mq[0] = *(const LAS f32x4*)(Mg + 3800);
            ab0 -= mq[1][0] * xy[4]; ab1 -= mq[1][1] * xy[5]; ab0 -= mq[1][2] * xy[6]; ab1 -= mq[1][3] * xy[7]; mq[1] = *(const LAS f32x4*)(Mg + 3804);
            ab0 -= mq[2][0] * xy[8]; ab1 -= mq[2][1] * xy[9]; ab0 -= mq[2][2] * xy[10]; ab1 -= mq[2][3] * xy[11]; mq[2] = *(const LAS f32x4*)(Mg + 3808);
            ab0 -= mq[3][0] * xy[12]; ab1 -= mq[3][1] * xy[13]; ab0 -= mq[3][2] * xy[14]; ab1 -= mq[3][3] * xy[15]; mq[3] = *(const LAS f32x4*)(Mg + 3812);
            ab0 -= mq[4][0] * xy[16]; ab1 -= mq[4][1] * xy[17]; ab0 -= mq[4][2] * xy[18]; ab1 -= mq[4][3] * xy[19]; mq[4] = *(const LAS f32x4*)(Mg + 3816);
            ab0 -= mq[5][0] * xy[20]; ab1 -= mq[5][1] * xy[21]; ab0 -= mq[5][2] * xy[22]; ab1 -= mq[5][3] * xy[23]; mq[5] = *(const LAS f32x4*)(Mg + 3820);
            ab0 -= mq[0][0] * xy[24]; ab1 -= mq[0][1] * xy[25]; ab0 -= mq[0][2] * xy[26]; ab1 -= mq[0][3] * xy[27]; mq[0] = *(const LAS f32x4*)(Mg + 3824);
            ab0 -= mq[1][0] * xy[28]; ab1 -= mq[1][1] * xy[29]; ab0 -= mq[1][2] * xy[30]; ab1 -= mq[1][3] * xy[31]; mq[1] = *(const LAS f32x4*)(Mg + 3828);
            ab0 -= mq[2][0] * xy[32]; ab1 -= mq[2][1] * xy[33]; ab0 -= mq[2][2] * xy[34]; ab1 -= mq[2][3] * xy[35]; mq[2] = *(const LAS f32x4*)(Mg + 3832);
            ab0 -= mq[3][0] * xy[36]; ab1 -= mq[3][1] * xy[37]; ab0 -= mq[3][2] * xy[38]; ab1 -= mq[3][3] * xy[39]; mq[3] = *(const LAS f32x4*)(Mg + 3840);
            ab0 -= mq[4][0] * xy[40]; ab1 -= mq[4][1] * xy[41]; ab0 -= mq[4][2] * xy[42]; ab1 -= mq[4][3] * xy[43]; mq[4] = *(const LAS f32x4*)(Mg + 3844);
            ab0 -= mq[5][0] * xy[44]; ab1 -= mq[5][1] * xy[45]; ab0 -= mq[5][2] * xy[46]; ab1 -= mq[5][3] * xy[47]; mq[5] = *(const LAS f32x4*)(Mg + 3848);
            ab0 -= mq[0][0] * xy[48]; ab1 -= mq[0][1] * xy[49]; ab0 -= mq[0][2] * xy[50]; ab1 -= mq[0][3] * xy[51]; mq[0] = *(const LAS f32x4*)(Mg + 3852);
            ab0 -= mq[1][0] * xy[52]; ab1 -= mq[1][1] * xy[53]; ab0 -= mq[1][2] * xy[54]; ab1 -= mq[1][3] * xy[55]; mq[1] = *(const LAS f32x4*)(Mg + 3856);
            ab0 -= mq[2][0] * xy[56]; ab1 -= mq[2][1] * xy[57]; ab0 -= mq[2][2] * xy[58]; xy[59] = ab0 + ab1; up[7552] = xy[59][0]; wp[7552] = f2bf(-xy[59][1]); mq[2] = *(const LAS f32x4*)(Mg + 3860);
            { const float br = betg[60]; ab0 = (f32x2){bf2f(*(const LAS bf16_t*)(lg + P5_VS + 16320 + c * 2)) * br, bf2f(*(const LAS bf16_t*)(lg + P5_KS + 16320 + c * 2)) * br * __expf(decg[60])}; ab1 = (f32x2){0.f, 0.f}; } ab0 -= mq[3][0] * xy[0]; ab1 -= mq[3][1] * xy[1]; ab0 -= mq[3][2] * xy[2]; ab1 -= mq[3][3] * xy[3]; mq[3] = *(const LAS f32x4*)(Mg + 3864);
            ab0 -= mq[4][0] * xy[4]; ab1 -= mq[4][1] * xy[5]; ab0 -= mq[4][2] * xy[6]; ab1 -= mq[4][3] * xy[7]; mq[4] = *(const LAS f32x4*)(Mg + 3868);
            ab0 -= mq[5][0] * xy[8]; ab1 -= mq[5][1] * xy[9]; ab0 -= mq[5][2] * xy[10]; ab1 -= mq[5][3] * xy[11]; mq[5] = *(const LAS f32x4*)(Mg + 3872);
            ab0 -= mq[0][0] * xy[12]; ab1 -= mq[0][1] * xy[13]; ab0 -= mq[0][2] * xy[14]; ab1 -= mq[0][3] * xy[15]; mq[0] = *(const LAS f32x4*)(Mg + 3876);
            ab0 -= mq[1][0] * xy[16]; ab1 -= mq[1][1] * xy[17]; ab0 -= mq[1][2] * xy[18]; ab1 -= mq[1][3] * xy[19]; mq[1] = *(const LAS f32x4*)(Mg + 3880);
            ab0 -= mq[2][0] * xy[20]; ab1 -= mq[2][1] * xy[21]; ab0 -= mq[2][2] * xy[22]; ab1 -= mq[2][3] * xy[23]; mq[2] = *(const LAS f32x4*)(Mg + 3884);
            ab0 -= mq[3][0] * xy[24]; ab1 -= mq[3][1] * xy[25]; ab0 -= mq[3][2] * xy[26]; ab1 -= mq[3][3] * xy[27]; mq[3] = *(const LAS f32x4*)(Mg + 3888);
            ab0 -= mq[4][0] * xy[28]; ab1 -= mq[4][1] * xy[29]; ab0 -= mq[4][2] * xy[30]; ab1 -= mq[4][3] * xy[31]; mq[4] = *(const LAS f32x4*)(Mg + 3892);
            ab0 -= mq[5][0] * xy[32]; ab1 -= mq[5][1] * xy[33]; ab0 -= mq[5][2] * xy[34]; ab1 -= mq[5][3] * xy[35]; mq[5] = *(const LAS f32x4*)(Mg + 3896);
            ab0 -= mq[0][0] * xy[36]; ab1 -= mq[0][1] * xy[37]; ab0 -= mq[0][2] * xy[38]; ab1 -= mq[0][3] * xy[39]; mq[0] = *(const LAS f32x4*)(Mg + 3904);
            ab0 -= mq[1][0] * xy[40]; ab1 -= mq[1][1] * xy[41]; ab0 -= mq[1][2] * xy[42]; ab1 -= mq[1][3] * xy[43]; mq[1] = *(const LAS f32x4*)(Mg + 3908);
            ab0 -= mq[2][0] * xy[44]; ab1 -= mq[2][1] * xy[45]; ab0 -= mq[2][2] * xy[46]; ab1 -= mq[2][3] * xy[47]; mq[2] = *(const LAS f32x4*)(Mg + 3912);
            ab0 -= mq[3][0] * xy[48]; ab1 -= mq[3][1] * xy[49]; ab0 -= mq[3][2] * xy[50]; ab1 -= mq[3][3] * xy[51]; mq[3] = *(const LAS f32x4*)(Mg + 3916);
            ab0 -= mq[4][0] * xy[52]; ab1 -= mq[4][1] * xy[53]; ab0 -= mq[4][2] * xy[54]; ab1 -= mq[4][3] * xy[55]; mq[4] = *(const LAS f32x4*)(Mg + 3920);
            ab0 -= mq[5][0] * xy[56]; ab1 -= mq[5][1] * xy[57]; ab0 -= mq[5][2] * xy[58]; ab1 -= mq[5][3] * xy[59]; xy[60] = ab0 + ab1; up[7680] = xy[60][0]; wp[7680] = f2bf(-xy[60][1]); mq[5] = *(const LAS f32x4*)(Mg + 3924);
            { const float br = betg[61]; ab0 = (f32x2){bf2f(*(const LAS bf16_t*)(lg + P5_VS + 16592 + c * 2)) * br, bf2f(*(const LAS bf16_t*)(lg + P5_KS + 16592 + c * 2)) * br * __expf(decg[61])}; ab1 = (f32x2){0.f, 0.f}; } ab0 -= mq[0][0] * xy[0]; ab1 -= mq[0][1] * xy[1]; ab0 -= mq[0][2] * xy[2]; ab1 -= mq[0][3] * xy[3]; mq[0] = *(const LAS f32x4*)(Mg + 3928);
            ab0 -= mq[1][0] * xy[4]; ab1 -= mq[1][1] * xy[5]; ab0 -= mq[1][2] * xy[6]; ab1 -= mq[1][3] * xy[7]; mq[1] = *(const LAS f32x4*)(Mg + 3932);
            ab0 -= mq[2][0] * xy[8]; ab1 -= mq[2][1] * xy[9]; ab0 -= mq[2][2] * xy[10]; ab1 -= mq[2][3] * xy[11]; mq[2] = *(const LAS f32x4*)(Mg + 3936);
            ab0 -= mq[3][0] * xy[12]; ab1 -= mq[3][1] * xy[13]; ab0 -= mq[3][2] * xy[14]; ab1 -= mq[3][3] * xy[15]; mq[3] = *(const LAS f32x4*)(Mg + 3940);
            ab0 -= mq[4][0] * xy[16]; ab1 -= mq[4][1] * xy[17]; ab0 -= mq[4][2] * xy[18]; ab1 -= mq[4][3] * xy[19]; mq[4] = *(const LAS f32x4*)(Mg + 3944);
            ab0 -= mq[5][0] * xy[20]; ab1 -= mq[5][1] * xy[21]; ab0 -= mq[5][2] * xy[22]; ab1 -= mq[5][3] * xy[23]; mq[5] = *(const LAS f32x4*)(Mg + 3948);
            ab0 -= mq[0][0] * xy[24]; ab1 -= mq[0][1] * xy[25]; ab0 -= mq[0][2] * xy[26]; ab1 -= mq[0][3] * xy[27]; mq[0] = *(const LAS f32x4*)(Mg + 3952);
            ab0 -= mq[1][0] * xy[28]; ab1 -= mq[1][1] * xy[29]; ab0 -= mq[1][2] * xy[30]; ab1 -= mq[1][3] * xy[31]; mq[1] = *(const LAS f32x4*)(Mg + 3956);
            ab0 -= mq[2][0] * xy[32]; ab1 -= mq[2][1] * xy[33]; ab0 -= mq[2][2] * xy[34]; ab1 -= mq[2][3] * xy[35]; mq[2] = *(const LAS f32x4*)(Mg + 3960);
            ab0 -= mq[3][0] * xy[36]; ab1 -= mq[3][1] * xy[37]; ab0 -= mq[3][2] * xy[38]; ab1 -= mq[3][3] * xy[39]; mq[3] = *(const LAS f32x4*)(Mg + 3964);
            ab0 -= mq[4][0] * xy[40]; ab1 -= mq[4][1] * xy[41]; ab0 -= mq[4][2] * xy[42]; ab1 -= mq[4][3] * xy[43]; mq[4] = *(const LAS f32x4*)(Mg + 3968);
            ab0 -= mq[5][0] * xy[44]; ab1 -= mq[5][1] * xy[45]; ab0 -= mq[5][2] * xy[46]; ab1 -= mq[5][3] * xy[47]; mq[5] = *(const LAS f32x4*)(Mg + 3972);
            ab0 -= mq[0][0] * xy[48]; ab1 -= mq[0][1] * xy[49]; ab0 -= mq[0][2] * xy[50]; ab1 -= mq[0][3] * xy[51]; mq[0] = *(const LAS f32x4*)(Mg + 3976);
            ab0 -= mq[1][0] * xy[52]; ab1 -= mq[1][1] * xy[53]; ab0 -= mq[1][2] * xy[54]; ab1 -= mq[1][3] * xy[55]; mq[1] = *(const LAS f32x4*)(Mg + 3980);
            ab0 -= mq[2][0] * xy[56]; ab1 -= mq[2][1] * xy[57]; ab0 -= mq[2][2] * xy[58]; ab1 -= mq[2][3] * xy[59]; mq[2] = *(const LAS f32x4*)(Mg + 3984);
            ab0 -= mq[3][0] * xy[60]; xy[61] = ab0 + ab1; up[7808] = xy[61][0]; wp[7808] = f2bf(-xy[61][1]); mq[3] = *(const LAS f32x4*)(Mg + 3988);
            { const float br = betg[62]; ab0 = (f32x2){bf2f(*(const LAS bf16_t*)(lg + P5_VS + 16864 + c * 2)) * br, bf2f(*(const LAS bf16_t*)(lg + P5_KS + 16864 + c * 2)) * br * __expf(decg[62])}; ab1 = (f32x2){0.f, 0.f}; } ab0 -= mq[4][0] * xy[0]; ab1 -= mq[4][1] * xy[1]; ab0 -= mq[4][2] * xy[2]; ab1 -= mq[4][3] * xy[3]; mq[4] = *(const LAS f32x4*)(Mg + 3992);
            ab0 -= mq[5][0] * xy[4]; ab1 -= mq[5][1] * xy[5]; ab0 -= mq[5][2] * xy[6]; ab1 -= mq[5][3] * xy[7]; mq[5] = *(const LAS f32x4*)(Mg + 3996);
            ab0 -= mq[0][0] * xy[8]; ab1 -= mq[0][1] * xy[9]; ab0 -= mq[0][2] * xy[10]; ab1 -= mq[0][3] * xy[11]; mq[0] = *(const LAS f32x4*)(Mg + 4000);
            ab0 -= mq[1][0] * xy[12]; ab1 -= mq[1][1] * xy[13]; ab0 -= mq[1][2] * xy[14]; ab1 -= mq[1][3] * xy[15]; mq[1] = *(const LAS f32x4*)(Mg + 4004);
            ab0 -= mq[2][0] * xy[16]; ab1 -= mq[2][1] * xy[17]; ab0 -= mq[2][2] * xy[18]; ab1 -= mq[2][3] * xy[19]; mq[2] = *(const LAS f32x4*)(Mg + 4008);
            ab0 -= mq[3][0] * xy[20]; ab1 -= mq[3][1] * xy[21]; ab0 -= mq[3][2] * xy[22]; ab1 -= mq[3][3] * xy[23]; mq[3] = *(const LAS f32x4*)(Mg + 4012);
            ab0 -= mq[4][0] * xy[24]; ab1 -= mq[4][1] * xy[25]; ab0 -= mq[4][2] * xy[26]; ab1 -= mq[4][3] * xy[27]; mq[4] = *(const LAS f32x4*)(Mg + 4016);
            ab0 -= mq[5][0] * xy[28]; ab1 -= mq[5][1] * xy[29]; ab0 -= mq[5][2] * xy[30]; ab1 -= mq[5][3] * xy[31]; mq[5] = *(const LAS f32x4*)(Mg + 4020);
            ab0 -= mq[0][0] * xy[32]; ab1 -= mq[0][1] * xy[33]; ab0 -= mq[0][2] * xy[34]; ab1 -= mq[0][3] * xy[35]; mq[0] = *(const LAS f32x4*)(Mg + 4024);
            ab0 -= mq[1][0] * xy[36]; ab1 -= mq[1][1] * xy[37]; ab0 -= mq[1][2] * xy[38]; ab1 -= mq[1][3] * xy[39]; mq[1] = *(const LAS f32x4*)(Mg + 4028);
            ab0 -= mq[2][0] * xy[40]; ab1 -= mq[2][1] * xy[41]; ab0 -= mq[2][2] * xy[42]; ab1 -= mq[2][3] * xy[43]; mq[2] = *(const LAS f32x4*)(Mg + 4032);
            ab0 -= mq[3][0] * xy[44]; ab1 -= mq[3][1] * xy[45]; ab0 -= mq[3][2] * xy[46]; ab1 -= mq[3][3] * xy[47]; mq[3] = *(const LAS f32x4*)(Mg + 4036);
            ab0 -= mq[4][0] * xy[48]; ab1 -= mq[4][1] * xy[49]; ab0 -= mq[4][2] * xy[50]; ab1 -= mq[4][3] * xy[51]; mq[4] = *(const LAS f32x4*)(Mg + 4040);
            ab0 -= mq[5][0] * xy[52]; ab1 -= mq[5][1] * xy[53]; ab0 -= mq[5][2] * xy[54]; ab1 -= mq[5][3] * xy[55]; mq[5] = *(const LAS f32x4*)(Mg + 4044);
            ab0 -= mq[0][0] * xy[56]; ab1 -= mq[0][1] * xy[57]; ab0 -= mq[0][2] * xy[58]; ab1 -= mq[0][3] * xy[59]; mq[0] = *(const LAS f32x4*)(Mg + 4048);
            ab0 -= mq[1][0] * xy[60]; ab1 -= mq[1][1] * xy[61]; xy[62] = ab0 + ab1; up[7936] = xy[62][0]; wp[7936] = f2bf(-xy[62][1]); mq[1] = *(const LAS f32x4*)(Mg + 4052);
            { const float br = betg[63]; ab0 = (f32x2){bf2f(*(const LAS bf16_t*)(lg + P5_VS + 17136 + c * 2)) * br, bf2f(*(const LAS bf16_t*)(lg + P5_KS + 17136 + c * 2)) * br * __expf(decg[63])}; ab1 = (f32x2){0.f, 0.f}; } ab0 -= mq[2][0] * xy[0]; ab1 -= mq[2][1] * xy[1]; ab0 -= mq[2][2] * xy[2]; ab1 -= mq[2][3] * xy[3]; mq[2] = *(const LAS f32x4*)(Mg + 4056);
            ab0 -= mq[3][0] * xy[4]; ab1 -= mq[3][1] * xy[5]; ab0 -= mq[3][2] * xy[6]; ab1 -= mq[3][3] * xy[7]; mq[3] = *(const LAS f32x4*)(Mg + 4060);
            ab0 -= mq[4][0] * xy[8]; ab1 -= mq[4][1] * xy[9]; ab0 -= mq[4][2] * xy[10]; ab1 -= mq[4][3] * xy[11]; mq[4] = *(const LAS f32x4*)(Mg + 4064);
            ab0 -= mq[5][0] * xy[12]; ab1 -= mq[5][1] * xy[13]; ab0 -= mq[5][2] * xy[14]; ab1 -= mq[5][3] * xy[15]; mq[5] = *(const LAS f32x4*)(Mg + 4068);
            ab0 -= mq[0][0] * xy[16]; ab1 -= mq[0][1] * xy[17]; ab0 -= mq[0][2] * xy[18]; ab1 -= mq[0][3] * xy[19]; mq[0] = *(const LAS f32x4*)(Mg + 4072);
            ab0 -= mq[1][0] * xy[20]; ab1 -= mq[1][1] * xy[21]; ab0 -= mq[1][2] * xy[22]; ab1 -= mq[1][3] * xy[23]; mq[1] = *(const LAS f32x4*)(Mg + 4076);
            ab0 -= mq[2][0] * xy[24]; ab1 -= mq[2][1] * xy[25]; ab0 -= mq[2][2] * xy[26]; ab1 -= mq[2][3] * xy[27]; mq[2] = *(const LAS f32x4*)(Mg + 4080);
            ab0 -= mq[3][0] * xy[28]; ab1 -= mq[3][1] * xy[29]; ab0 -= mq[3][2] * xy[30]; ab1 -= mq[3][3] * xy[31]; mq[3] = *(const LAS f32x4*)(Mg + 4084);
            ab0 -= mq[4][0] * xy[32]; ab1 -= mq[4][1] * xy[33]; ab0 -= mq[4][2] * xy[34]; ab1 -= mq[4][3] * xy[35]; mq[4] = *(const LAS f32x4*)(Mg + 4088);
            ab0 -= mq[5][0] * xy[36]; ab1 -= mq[5][1] * xy[37]; ab0 -= mq[5][2] * xy[38]; ab1 -= mq[5][3] * xy[39]; mq[5] = *(const LAS f32x4*)(Mg + 4092);
            ab0 -= mq[0][0] * xy[40]; ab1 -= mq[0][1] * xy[41]; ab0 -= mq[0][2] * xy[42]; ab1 -= mq[0][3] * xy[43];
            ab0 -= mq[1][0] * xy[44]; ab1 -= mq[1][1] * xy[45]; ab0 -= mq[1][2] * xy[46]; ab1 -= mq[1][3] * xy[47];
            ab0 -= mq[2][0] * xy[48]; ab1 -= mq[2][1] * xy[49]; ab0 -= mq[2][2] * xy[50]; ab1 -= mq[2][3] * xy[51];
            ab0 -= mq[3][0] * xy[52]; ab1 -= mq[3][1] * xy[53]; ab0 -= mq[3][2] * xy[54]; ab1 -= mq[3][3] * xy[55];
            ab0 -= mq[4][0] * xy[56]; ab1 -= mq[4][1] * xy[57]; ab0 -= mq[4][2] * xy[58]; ab1 -= mq[4][3] * xy[59];
            ab0 -= mq[5][0] * xy[60]; ab1 -= mq[5][1] * xy[61]; ab0 -= mq[5][2] * xy[62]; xy[63] = ab0 + ab1; up[8064] = xy[63][0]; wp[8064] = f2bf(-xy[63][1]);
        } else {
            const int g2 = (w8 - 4) >> 1, tt = ((w8 - 4) & 1) * 64 + lane; const int item2 = it0 + g2;
            LAS unsigned char* lg = lds0 + g2 * P5_GRP; LAS float* decg = (LAS float*)(lg + P5_DEC);
            const float lastg = decg[63];
#pragma unroll
            for (int i = 0; i < 8; ++i) { const int vid = tt + 128 * i, r = vid >> 4, d0 = (vid & 15) * 8; float f[8]; unpack8(*(const LAS u32x4*)(lg + P5_QS + r * 272 + d0 * 2), f);
                const float e = scale * __expf(decg[r]);
#pragma unroll
                for (int q = 0; q < 8; ++q) f[q] *= e;
                *(u32x4*)(qd + (size_t)item2 * 8192 + r * 128 + d0) = pack8(f); }
#pragma unroll
            for (int i = 0; i < 8; ++i) { const int vid = tt + 128 * i, d = vid >> 3, rg = (vid & 7) * 8; float f[8];
#pragma unroll
                for (int q = 0; q < 8; ++q) f[q] = bf2f(*(const LAS bf16_t*)(lg + P5_KS + (rg + q) * 272 + d * 2)) * __expf(lastg - decg[rg + q]);
                *(u32x4*)(kt + (size_t)item2 * 8192 + d * 64 + rg) = pack8(f); }
            if (tt == 0) cdv[item2] = __expf(lastg);
        }
    }
    __syncthreads();
}

constexpr int SB_WD = 0, SB_QD = 17408, SB_KT = 34816, SB_QK = 53248, SB_UB = 62464, SB_SIZE = 66560;
constexpr int SC_ST = 2 * SB_SIZE, SC_UT = SC_ST + 4352, SC_END = SC_UT + 2304;
static_assert(SC_END <= LDS_BYTES, "lds");
__device__ __forceinline__ void scan_phase(const Params& p, int bid, int nblk, LAS unsigned char* lds) {
    const int tid = threadIdx.x, lane = tid & 63, wid = __builtin_amdgcn_readfirstlane(tid >> 6), fr = lane & 15, fq = lane >> 4;
    const bf16_t* wdc = (const bf16_t*)(p.ws + WS_WDC); const bf16_t* qd = (const bf16_t*)(p.ws + WS_QD); const bf16_t* kt = (const bf16_t*)(p.ws + WS_KT); const bf16_t* qk = (const bf16_t*)(p.ws + WS_QK);
    const float* cdv = (const float*)(p.ws + WS_CD); const float* ub = p.out + OS_UB; float* obuf = p.out + OS_O;
    for (int item = bid; item < 256; item += nblk) {
        const int xcd = item & 7, iq = item >> 3, bh = xcd * 4 + (iq >> 3), sl = iq & 7, h = bh & 7, b = bh >> 3;
        u32x4 r_wd[2], r_qd[2], r_kt[2], r_qk, r_ub;
        auto gload = [&](int n) {
            const size_t it = (size_t)(bh * 32 + n);
#pragma unroll
            for (int i = 0; i < 2; ++i) { const int ch = tid + 512 * i; r_wd[i] = *(const u32x4*)(wdc + it * 8192 + ch * 8); r_qd[i] = *(const u32x4*)(qd + it * 8192 + ch * 8); r_kt[i] = *(const u32x4*)(kt + it * 8192 + ch * 8); }
            r_qk = *(const u32x4*)(qk + it * 4096 + tid * 8);
            if (tid < 256) r_ub = *(const u32x4*)(ub + it * 8192 + (tid >> 2) * 128 + sl * 16 + (tid & 3) * 4);
        };
        auto lstore = [&](int buf) {
            LAS unsigned char* B = lds + buf * SB_SIZE;
#pragma unroll
            for (int i = 0; i < 2; ++i) { const int ch = tid + 512 * i; const int r = ch >> 4, c8 = (ch & 15) * 8; *(LAS u32x4*)(B + SB_WD + r * 272 + c8 * 2) = r_wd[i]; *(LAS u32x4*)(B + SB_QD + r * 272 + c8 * 2) = r_qd[i];
                const int d = ch >> 3, t8 = (ch & 7) * 8; *(LAS u32x4*)(B + SB_KT + d * 144 + t8 * 2) = r_kt[i]; }
            { const int r = tid >> 3, s8 = (tid & 7) * 8; *(LAS u32x4*)(B + SB_QK + r * 144 + s8 * 2) = r_qk; }
            if (tid < 256) *(LAS u32x4*)(B + SB_UB + (tid >> 2) * 64 + (tid & 3) * 16) = r_ub;
        };
        __syncthreads();
        gload(0);
        for (int i = tid; i < 4352 / 4; i += 512) *(LAS unsigned*)(lds + SC_ST + i * 4) = 0u;
        lstore(0);
        f32x4 sacc = (f32x4){0.f, 0.f, 0.f, 0.f};
        __syncthreads();
        for (int n = 0; n < 32; ++n) {
            const int cur = n & 1; LAS unsigned char* B = lds + cur * SB_SIZE;
            if (n + 1 < 32) gload(n + 1);
            const float cd = cdv[bh * 32 + n];
            f32x4 acc;
            const int tw = wid & 3;
            if (wid < 4) {
#pragma unroll
                for (int j = 0; j < 4; ++j) acc[j] = *(const LAS float*)(B + SB_UB + ((tw * 16 + fq * 4 + j) * 16 + fr) * 4);
#pragma unroll
                for (int kk = 0; kk < 4; ++kk) { const bf16x8 a = *(const LAS bf16x8*)(B + SB_WD + (tw * 16 + fr) * 272 + (kk * 32 + fq * 8) * 2); const bf16x8 bb = *(const LAS bf16x8*)(lds + SC_ST + fr * 272 + (kk * 32 + fq * 8) * 2);
                    acc = __builtin_amdgcn_mfma_f32_16x16x32_bf16(a, bb, acc, 0, 0, 0); }
                u32x2 w; w.x = pk2(acc[0], acc[1]); w.y = pk2(acc[2], acc[3]);
                *(LAS u32x2*)(lds + SC_UT + fr * 144 + (tw * 16 + fq * 4) * 2) = w;
            } else {
                acc = (f32x4){0.f, 0.f, 0.f, 0.f};
#pragma unroll
                for (int kk = 0; kk < 4; ++kk) { const bf16x8 a = *(const LAS bf16x8*)(B + SB_QD + (tw * 16 + fr) * 272 + (kk * 32 + fq * 8) * 2); const bf16x8 bb = *(const LAS bf16x8*)(lds + SC_ST + fr * 272 + (kk * 32 + fq * 8) * 2);
                    acc = __builtin_amdgcn_mfma_f32_16x16x32_bf16(a, bb, acc, 0, 0, 0); }
            }
            __syncthreads();
            sacc *= cd;
#pragma unroll
            for (int kk = 0; kk < 2; ++kk) { const bf16x8 a = *(const LAS bf16x8*)(B + SB_KT + (wid * 16 + fr) * 144 + (kk * 32 + fq * 8) * 2); const bf16x8 bb = *(const LAS bf16x8*)(lds + SC_UT + fr * 144 + (kk * 32 + fq * 8) * 2);
                sacc = __builtin_amdgcn_mfma_f32_16x16x32_bf16(a, bb, sacc, 0, 0, 0); }
            if (wid >= 4) {
#pragma unroll
                for (int kk = 0; kk < 2; ++kk) { const bf16x8 a = *(const LAS bf16x8*)(B + SB_QK + (tw * 16 + fr) * 144 + (kk * 32 + fq * 8) * 2); const bf16x8 bb = *(const LAS bf16x8*)(lds + SC_UT + fr * 144 + (kk * 32 + fq * 8) * 2);
                    acc = __builtin_amdgcn_mfma_f32_16x16x32_bf16(a, bb, acc, 0, 0, 0); }
#pragma unroll
                for (int j = 0; j < 4; ++j) obuf[(size_t)(b * 2048 + n * 64 + tw * 16 + fq * 4 + j) * 1024 + h * 128 + sl * 16 + fr] = acc[j];
            }
            { u32x2 w; w.x = pk2(sacc[0], sacc[1]); w.y = pk2(sacc[2], sacc[3]); *(LAS u32x2*)(lds + SC_ST + fr * 272 + (wid * 16 + fq * 4) * 2) = w; }
            if (n + 1 < 32) lstore(cur ^ 1);
            __syncthreads();
        }
#pragma unroll
        for (int j = 0; j < 4; ++j) p.out[O_DP + ((size_t)bh * 128 + wid * 16 + fq * 4 + j) * 128 + sl * 16 + fr] = sacc[j];
    }
    __syncthreads();
    {
        const bf16_t* qn = (const bf16_t*)(p.ws + WS_QN); const bf16_t* kn = (const bf16_t*)(p.ws + WS_KN); const bf16_t* vv = (const bf16_t*)(p.ws + WS_VV);
        const float* gbuf = (const float*)(p.ws + WS_G); const float* bbuf = (const float*)(p.ws + WS_BETA);
        const int grp = tid >> 8, w4 = __builtin_amdgcn_readfirstlane(tid >> 6) & 3, j = w4 * 32 + (lane & 31), half = lane >> 5;
        LAS float* qs = (LAS float*)lds + grp * 1024;
        LAS float* ks = qs + 512;
        const float scale = 0.08838834764831845f;
        for (int it0 = bid * 2; it0 < 1024; it0 += nblk * 2) {
            const int item = it0 + grp, sb = item >> 3, h = item & 7;
            __syncthreads();
#pragma unroll
            for (int i = 0; i < 4; ++i) { const int idx = (tid & 255) + 256 * i, tk = idx >> 7, c = idx & 127, t = tk & 3; const size_t go = (size_t)(TP + sb * 4 + t) * 1024 + h * 128 + c;
                if (tk < 4) qs[t * 128 + c] = bf2f(qn[go]); else ks[t * 128 + c] = bf2f(kn[go]); }
            float S[64];
            const float* s0 = p.in[4] + (size_t)item * 16384 + (size_t)half * 64 * 128 + j;
#pragma unroll
            for (int i = 0; i < 64; ++i) S[i] = __builtin_nontemporal_load(s0 + i * 128);
            __syncthreads();
#pragma unroll 1
            for (int t = 0; t < 4; ++t) {
                const int row = TP + sb * 4 + t;
                const float a = __expf(gbuf[row * 8 + h]), be = bbuf[row * 8 + h], v = bf2f(vv[(size_t)row * 1024 + h * 128 + j]);
                float kS = 0.f;
#pragma unroll
                for (int i4 = 0; i4 < 16; ++i4) { const f32x4 k4 = *(const LAS f32x4*)(ks + t * 128 + half * 64 + i4 * 4); kS += k4[0] * S[i4 * 4] + k4[1] * S[i4 * 4 + 1] + k4[2] * S[i4 * 4 + 2] + k4[3] * S[i4 * 4 + 3]; }
                kS += __shfl_xor(kS, 32);
                const float coef = be * (v - a * kS);
                float o = 0.f;
#pragma unroll
                for (int i4 = 0; i4 < 16; ++i4) { const f32x4 k4 = *(const LAS f32x4*)(ks + t * 128 + half * 64 + i4 * 4); const f32x4 q4 = *(const LAS f32x4*)(qs + t * 128 + half * 64 + i4 * 4);
#pragma unroll
                    for (int q = 0; q < 4; ++q) { S[i4 * 4 + q] = a * S[i4 * 4 + q] + k4[q] * coef; o += q4[q] * S[i4 * 4 + q]; } }
                o += __shfl_xor(o, 32);
                if (half == 0) obuf[(size_t)row * 1024 + h * 128 + j] = o * scale;
            }
            float* so = p.out + O_DS + (size_t)item * 16384 + (size_t)half * 64 * 128 + j;
#pragma unroll
            for (int i = 0; i < 64; ++i) so[i * 128] = S[i];
        }
    }
    __syncthreads();
}

__device__ __forceinline__ void onorm_phase(const Params& p, int bid, int nblk) {
    const int lane = threadIdx.x & 63, wid = __builtin_amdgcn_readfirstlane(threadIdx.x >> 6);
    const float* obuf = p.out + OS_O; const bf16_t* proj = (const bf16_t*)(p.ws + WS_PROJ); bf16_t* acat = (bf16_t*)(p.ws + WS_U); const float* og = p.in[14];
    for (int row = bid * 8 + wid; row < TT; row += nblk * 8) {
        const int c0 = lane * 16; float o[16], z[16], g[16];
#pragma unroll
        for (int i = 0; i < 4; ++i) { const f32x4 v = *(const f32x4*)(obuf + (size_t)row * 1024 + c0 + i * 4); o[i * 4] = v[0]; o[i * 4 + 1] = v[1]; o[i * 4 + 2] = v[2]; o[i * 4 + 3] = v[3];
            const f32x4 gg = *(const f32x4*)(og + (c0 & 127) + i * 4); g[i * 4] = gg[0]; g[i * 4 + 1] = gg[1]; g[i * 4 + 2] = gg[2]; g[i * 4 + 3] = gg[3]; }
        unpack8(*(const u32x4*)(proj + (size_t)row * NPROJ + C_Z + c0), z); unpack8(*(const u32x4*)(proj + (size_t)row * NPROJ + C_Z + c0 + 8), z + 8);
        float ss = 0.f;
#pragma unroll
        for (int i = 0; i < 16; ++i) ss += o[i] * o[i];
        ss += __shfl_xor(ss, 1); ss += __shfl_xor(ss, 2); ss += __shfl_xor(ss, 4);
        const float rstd = rsqrtf(ss * (1.0f / 128.0f) + EPS);
#pragma unroll
        for (int i = 0; i < 16; ++i) o[i] = o[i] * rstd * g[i] * siluf_(z[i]);
        *(u32x4*)(acat + (size_t)row * DM + c0) = pack8(o); *(u32x4*)(acat + (size_t)row * DM + c0 + 8) = pack8(o + 8);
    }
}

#define XB_TMO      128
#define XB_XCNT(j)  (256  + 64 * (j))
#define XB_XSUB(j)  (1280 + 64 * (j))
#define XB_XGEN(j)  (2304 + 64 * (j))
#define XB_TOP      3328
#define XB_TOPGEN   3392
#define XCD_BAR_WORDS 3456
#define XB_SPIN_CAP (1u << 18)

__device__ __forceinline__ unsigned xb_ld(unsigned* p)              { return __hip_atomic_load(p, __ATOMIC_RELAXED, __HIP_MEMORY_SCOPE_AGENT); }
__device__ __forceinline__ unsigned xb_add(unsigned* p, unsigned v) { return __hip_atomic_fetch_add(p, v, __ATOMIC_RELAXED, __HIP_MEMORY_SCOPE_AGENT); }
__device__ __forceinline__ unsigned xb_xcc_id() { return (unsigned)__builtin_amdgcn_s_getreg((3 << 11) | 20) & 0xFu; }
#define XB_SPIN(cond, bar) do { unsigned _sp = 0; while (cond) { __builtin_amdgcn_s_sleep(1); \
    if ((++_sp & 255u) == 0u) { if (xb_ld(&(bar)[XB_TMO])) break; if (_sp > XB_SPIN_CAP) { atomicAdd(&(bar)[XB_TMO], 1u); break; } } } } while (0)

struct XcdBarrier {
    unsigned* bar; unsigned x;
    volatile LAS unsigned* st;
};

__device__ __forceinline__ XcdBarrier xcd_barrier_post(unsigned* bar, volatile LAS unsigned* st) {
    XcdBarrier b; b.bar = bar; b.x = xb_xcc_id(); b.st = st;
    if (threadIdx.x == 0) (void)xb_add(&bar[XB_XCNT(b.x)], 1u);
    return b;
}
__device__ __forceinline__ void xcd_barrier_complete(unsigned* bar, unsigned x, unsigned& nloc, unsigned& nx) {
    const unsigned G = gridDim.x * gridDim.y * gridDim.z;
    unsigned sum, cnt, mine, sp = 0u;
    for (;;) {
        sum = 0u; cnt = 0u; mine = 0u;
#pragma unroll
        for (unsigned j = 0; j < 16; ++j) { const unsigned c = xb_ld(&bar[XB_XCNT(j)]); sum += c; cnt += (c > 0u) ? 1u : 0u; mine = (j == x) ? c : mine; }
        if (sum == G) break;
        __builtin_amdgcn_s_sleep(1);
        if ((++sp & 255u) == 0u) { if (xb_ld(&bar[XB_TMO])) break; if (sp > XB_SPIN_CAP) { atomicAdd(&bar[XB_TMO], 1u); break; } }
    }
    nloc = mine > 0u ? mine : 1u; nx = cnt > 0u ? cnt : 1u;
}

__device__ __forceinline__ void xcd_barrier(const XcdBarrier& b) {
    asm volatile("s_waitcnt vmcnt(0)" ::: "memory");
    __syncthreads();
    if (threadIdx.x == 0) {
        unsigned* bar = b.bar;
        __builtin_amdgcn_s_waitcnt(0);
        unsigned nloc = b.st[0], nx = b.st[1];
        if (nloc == 0u) { xcd_barrier_complete(bar, b.x, nloc, nx); b.st[0] = nloc; b.st[1] = nx; }
        const unsigned old = xb_add(&bar[XB_XSUB(b.x)], 1u);
        const unsigned gen = old / nloc;
        if (old + 1u == (gen + 1u) * nloc) {
            __builtin_amdgcn_fence(__ATOMIC_RELEASE, "agent");
            asm volatile("s_waitcnt vmcnt(0)" ::: "memory");
            const unsigned og = xb_add(&bar[XB_TOP], 1u);
            const unsigned tg = og / nx;
            if (og + 1u == (tg + 1u) * nx) xb_add(&bar[XB_TOPGEN], 1u);
            else XB_SPIN(xb_ld(&bar[XB_TOPGEN]) == tg, bar);
            __builtin_amdgcn_fence(__ATOMIC_ACQUIRE, "agent");
            xb_add(&bar[XB_XGEN(b.x)], 1u);
            asm volatile("s_waitcnt vmcnt(0)" ::: "memory");
        } else {
            XB_SPIN(xb_ld(&bar[XB_XGEN(b.x)]) == gen, bar);
            __builtin_amdgcn_fence(__ATOMIC_ACQUIRE, "agent");
            asm volatile("s_waitcnt vmcnt(0)" ::: "memory");
        }
    }
    __syncthreads();
}

constexpr size_t WS_BAR = WS_END;
constexpr int LDS_ST_OFF = LDS_BYTES - 16;
struct KArgs { Params p; TJob jobs[11]; };
constexpr int N_PHASES = 15;
#ifndef PH_MASK
#define PH_MASK 0xFFFF
#endif
#ifndef DUP_MASK
#define DUP_MASK 0
#endif

__global__ void __launch_bounds__(512, 2) fwd_megakernel(KArgs ka) {
    extern __shared__ __attribute__((aligned(16))) unsigned char lds_raw[];
    LAS unsigned char* lds = (LAS unsigned char*)lds_raw;
    const Params& p = ka.p;
    const int bid = blockIdx.x, nblk = gridDim.x;
    unsigned char* ws = p.ws;
    const int lo = p.ph_lo, hi = p.ph_hi;
    if (threadIdx.x < 4) ((LAS unsigned*)(lds + LDS_ST_OFF))[threadIdx.x] = 0u;
    __syncthreads();
    if (hi > 1000) cg::this_grid().sync();
    XcdBarrier xbar = xcd_barrier_post((unsigned*)(ws + WS_BAR), (volatile LAS unsigned*)(lds + LDS_ST_OFF));
#define IN(k) ((PH_MASK & (1 << (k))) && lo <= (k) && (k) < hi)
#define SEAM(k) do { if (lo <= (k) && (k) + 1 < hi) xcd_barrier(xbar); } while (0)
    if (IN(0)) for (int rep = 0; rep <= ((DUP_MASK >> 0) & 1); ++rep) {
            bf16_t* aada = (bf16_t*)(ws + WS_AADA);
            for (int idx = bid * 512 + threadIdx.x; idx < 256 * 2048; idx += nblk * 512) { const int row = idx >> 11, col = idx & 2047;
                const float v = row < 4 ? siluf_(p.in[2][row * 2048 + col]) : (row < NB ? siluf_(p.in[3][(row - 4) * 2048 + col]) : 0.f); aada[idx] = f2bf(v); }
            transpose_jobs(ka.jobs, 1, bid, nblk, lds);
        }
    SEAM(0);
    if (IN(1)) for (int rep = 0; rep <= ((DUP_MASK >> 1) & 1); ++rep) {
            if (bid < 48) { pg8::Gemm g{(const bf16_t*)(ws + WS_AADA), (const bf16_t*)(ws + WS_PROJ), 2048, 2048, 2048, 0, 0, 0, 0, 0}; pg8::OneUnitOrder S{48, bid, 32}; pg8::EpiAda E{(float*)(ws + WS_MOD), p.in[8]}; pg8::gemm_phase(lds, g, S, E); }
            else { transpose_jobs(ka.jobs + 1, 1, bid - 48, nblk - 48, lds); transpose_jobs(ka.jobs + 4, 7, bid - 48, nblk - 48, lds); }
        }
    SEAM(1);
    if (IN(2)) for (int rep = 0; rep <= ((DUP_MASK >> 2) & 1); ++rep) norm_phase<0>(p, bid, nblk);
    SEAM(2);
    if (IN(3)) for (int rep = 0; rep <= ((DUP_MASK >> 3) & 1); ++rep) { pg8::Gemm g{(const bf16_t*)(ws + WS_U), (const bf16_t*)(ws + WS_WIN), 2048, 2048, 2048, 0, 0, 0, 0, 0}; pg8::StaticOrder S; S.init(TT, NPROJ, 2048, nblk, bid); pg8::EpiBf16 E{(bf16_t*)(ws + WS_PROJ), NPROJ, 0, nullptr}; pg8::gemm_phase(lds, g, S, E); }
    SEAM(3);
    if (IN(4)) for (int rep = 0; rep <= ((DUP_MASK >> 4) & 1); ++rep) mixer_prep_phase(p, bid, nblk);
    SEAM(4);
    if (IN(5)) for (int rep = 0; rep <= ((DUP_MASK >> 5) & 1); ++rep) chunk_prep_phase(p, bid, nblk, lds);
    SEAM(5);
    if (IN(6)) for (int rep = 0; rep <= ((DUP_MASK >> 6) & 1); ++rep) scan_phase(p, bid, nblk, lds);
    SEAM(6);
    if (IN(7)) for (int rep = 0; rep <= ((DUP_MASK >> 7) & 1); ++rep) { onorm_phase(p, bid, nblk);
            pg8::Gemm g{(const bf16_t*)(ws + WS_YP), (const bf16_t*)(ws + WS_PW), 1024, 256, 256, 512, 0, 0, 0, 0}; pg8::StaticOrder S; S.init(TT, 1024, 256, nblk, bid); pg8::EpiBf16 E{(bf16_t*)(ws + WS_U), DM, 1024, p.in[16]}; pg8::gemm_phase(lds, g, S, E);
            if (rep == 0) { if (nblk <= 136) transpose_jobs(ka.jobs + 3, 1, bid, nblk, lds); else if (bid >= 136) transpose_jobs(ka.jobs + 3, 1, bid - 136, nblk - 136, lds); } }
    SEAM(7);
    if (IN(8)) for (int rep = 0; rep <= ((DUP_MASK >> 8) & 1); ++rep) {
            pg8::Gemm g{(const bf16_t*)(ws + WS_U), (const bf16_t*)(ws + WS_WAB), 2048, 2048, 1024, 0, 2048, 2048, (size_t)128 * 2048 * 2, (size_t)128 * 2048 * 2}; pg8::StaticOrder S; S.init(68 * 256, 16 * 256, 1024, nblk, bid);
            pg8::EpiDiag E{(bf16_t*)(ws + WS_QN), (const bf16_t*)(ws + WS_PROJ)}; pg8::gemm_phase(lds, g, S, E);
            if (rep == 0) { const int nfull = 1088 % nblk; if (nfull == 0 || nfull >= nblk) transpose_jobs(ka.jobs + 2, 1, bid, nblk, lds); else if (bid >= nfull) transpose_jobs(ka.jobs + 2, 1, bid - nfull, nblk - nfull, lds); } }
    SEAM(9);
    if (IN(10)) for (int rep = 0; rep <= ((DUP_MASK >> 10) & 1); ++rep) { pg8::Gemm g{(const bf16_t*)(ws + WS_QN), (const bf16_t*)(ws + WS_WO), 2048, 2048, 2048, 0, 0, 0, 0, 0}; pg8::SplitOrder S{nblk, bid, 32, 4, 8}; pg8::EpiRes E{p.out + O_Y, p.in[0], p.in[1], (const float*)(ws + WS_MOD) + 4096, (float*)(ws + WS_PB10)}; pg8::gemm_phase(lds, g, S, E); }
    SEAM(10);
    if (IN(11)) for (int rep = 0; rep <= ((DUP_MASK >> 11) & 1); ++rep) norm_phase<1>(p, bid, nblk);
    SEAM(11);
    if (IN(12)) for (int rep = 0; rep <= ((DUP_MASK >> 12) & 1); ++rep) { pg8::Gemm g{(const bf16_t*)(ws + WS_U), (const bf16_t*)(ws + WS_WGU), 2048, 2048, 2048, 0, 0, 0, 0, 0}; pg8::StaticOrder S; S.init(TT, 11264, 2048, nblk, bid); pg8::EpiGU E{(bf16_t*)(ws + WS_PROJ)}; pg8::gemm_phase(lds, g, S, E); }
    SEAM(12);
    if (IN(13)) for (int rep = 0; rep <= ((DUP_MASK >> 13) & 1); ++rep) { pg8::Gemm g{(const bf16_t*)(ws + WS_PROJ), (const bf16_t*)(ws + WS_WD), DFF, DFF, DFF, 0, 0, 0, 0, 0}; pg8::SplitOrder S{nblk, bid, 88, 8, 11}; pg8::EpiRes E{p.out + O_Y, p.out + O_Y, p.out + O_Y + (size_t)TP * DM, (const float*)(ws + WS_MOD) + 10240, (float*)(ws + WS_PB13)}; pg8::gemm_phase(lds, g, S, E); }
    SEAM(13);
    if (IN(14)) for (int rep = 0; rep <= ((DUP_MASK >> 14) & 1); ++rep) norm_phase<2>(p, bid, nblk);
    SEAM(14);
}

extern "C" void kernel_launch(void* const* d_in, const int* in_sizes, int n_in, void* d_out, int out_size, void* d_ws, size_t ws_size, hipStream_t stream) {
    static int grid = 0;
    if (grid == 0) {
        if (n_in != 24 || ws_size < WS_BAR + XCD_BAR_WORDS * 4) { fprintf(stderr, "kernel_launch: unexpected n_in %d / ws_size %zu (need %zu)\n", n_in, ws_size, (size_t)WS_END); grid = -1; return; }
        int dev = 0, cus = 0, per_cu = 0;
        hipGetDevice(&dev); hipDeviceGetAttribute(&cus, hipDeviceAttributeMultiprocessorCount, dev);
        if (hipFuncSetAttribute((const void*)fwd_megakernel, hipFuncAttributeMaxDynamicSharedMemorySize, LDS_BYTES) != hipSuccess) { fprintf(stderr, "kernel_launch: hipFuncSetAttribute failed\n"); grid = -1; return; }
        if (hipOccupancyMaxActiveBlocksPerMultiprocessor(&per_cu, (const void*)fwd_megakernel, 512, LDS_BYTES) != hipSuccess || per_cu < 1) { fprintf(stderr, "kernel_launch: occupancy query says %d\n", per_cu); per_cu = 1; }
        (void)hipGetLastError();
        grid = cus > 0 ? cus : 256;
        if (grid < 64) grid = 64;
    }
    if (grid < 0) return;
    if (hipMemsetAsync((unsigned char*)d_ws + WS_BAR, 0, XCD_BAR_WORDS * 4, stream) != hipSuccess) { fprintf(stderr, "kernel_launch: memset failed\n"); return; }
    KArgs ka; memset(&ka, 0, sizeof(ka));
    for (int i = 0; i < 24; ++i) ka.p.in[i] = (const float*)d_in[i];
    ka.p.out = (float*)d_out; ka.p.ws = (unsigned char*)d_ws;
    unsigned char* ws = (unsigned char*)d_ws;
    auto setjob = [&](int i, const void* src, void* dst, int ld_src, int K, int Nout, int ld_dst, int map) { TJob& j = ka.jobs[i]; j.src = (const float*)src; j.dst = (bf16_t*)dst; j.ld_src = ld_src; j.K = K; j.Nout = Nout; j.ld_dst = ld_dst; j.map = map; j.pad = 0; };
    setjob(0, d_in[7], ws + WS_PROJ, MODW, 2048, MODW, 2048, 0);
    setjob(1, d_in[10], ws + WS_WIN, 9232, 2048, NPROJ, 2048, 1);
    setjob(2, d_in[21], ws + WS_WGU, 2 * DFF, 2048, 2 * DFF, 2048, 2);
    setjob(3, d_in[22], ws + WS_WD, 2048, DFF, 2048, DFF, 0);
    setjob(4, d_in[19], ws + WS_WO, 2048, 2048, 2048, 2048, 0);
    setjob(5, d_in[17], ws + WS_WAB, 2048, 1024, 2048, 2048, 0);
    setjob(6, d_in[18], ws + WS_WAB + 1024 * 2, 2048, 1024, 2048, 2048, 0);
    for (int g = 0; g < 4; ++g) setjob(7 + g, (const float*)d_in[15] + g * 65536, ws + WS_PW + (size_t)g * 65536 * 2, 256, 256, 256, 256, 0);
#if MK_PER_PHASE
    for (int ph = 0; ph < N_PHASES; ++ph) { ka.p.ph_lo = ph; ka.p.ph_hi = ph + 1; hipLaunchKernelGGL(fwd_megakernel, dim3(grid), dim3(512), LDS_BYTES, stream, ka); }
#else
    ka.p.ph_lo = 0; ka.p.ph_hi = N_PHASES;
    void* args[] = {&ka};
    hipError_t e = hipLaunchCooperativeKernel((const void*)fwd_megakernel, dim3(grid), dim3(512), args, LDS_BYTES, stream);
    if (e != hipSuccess) fprintf(stderr, "cooperative launch failed: %s (grid %d)\n", hipGetErrorString(e), grid);
#endif
}
```

```cpp
#include <hip/hip_runtime.h>
#include <hip/hip_cooperative_groups.h>
#include <cstdio>
#include <cstring>
namespace cg = cooperative_groups;

#ifndef MK_PER_PHASE
#define MK_PER_PHASE 0
#endif

#define LAS __attribute__((address_space(3)))
typedef unsigned short bf16_t;
typedef short bf16x8 __attribute__((ext_vector_type(8)));
typedef float f32x4 __attribute__((ext_vector_type(4)));
typedef float f32x2 __attribute__((ext_vector_type(2)));
typedef unsigned u32x4 __attribute__((ext_vector_type(4)));
typedef unsigned u32x2 __attribute__((ext_vector_type(2)));

constexpr int DM = 2048, TP = 8192, TS = 512, TT = 8704, NB = 132;
constexpr int NPROJ = 9472;
constexpr int DFF = 5632;
constexpr int MODW = 12288;
constexpr float EPS = 1e-6f;
constexpr int C_Q = 0, C_K = 1024, C_V = 2048, C_Z = 3072, C_XP = 4096, C_GA = 5120, C_GB = 7168, C_AB = 9216;
constexpr size_t O_Y = 0, O_DP = 17825792, O_CP = 18350080, O_PP = 18386944, O_DS = 18448384, O_CS = 35225600, O_PS = 36405248;
constexpr size_t OS_O = 0, OS_UB = 8912896;
constexpr size_t WS_WIN = 0;
constexpr size_t WS_WGU = WS_WIN + (size_t)NPROJ * 2048 * 2;
constexpr size_t WS_WD = WS_WGU + (size_t)11264 * 2048 * 2;
constexpr size_t WS_WO = WS_WD + (size_t)2048 * 5632 * 2;
constexpr size_t WS_WAB = WS_WO + (size_t)2048 * 2048 * 2;
constexpr size_t WS_PW = WS_WAB + (size_t)2048 * 2048 * 2;
constexpr size_t WS_AADA = WS_PW + (size_t)1024 * 256 * 2;
constexpr size_t WS_MOD = WS_AADA + (size_t)256 * 2048 * 2;
constexpr size_t WS_G = WS_MOD + (size_t)NB * MODW * 4;
constexpr size_t WS_BETA = WS_G + (size_t)TT * 8 * 4;
constexpr size_t WS_CD = WS_BETA + (size_t)TT * 8 * 4;
constexpr size_t WS_U = WS_CD + 4096;
constexpr size_t WS_QN = WS_U + (size_t)TT * 2048 * 2;
constexpr size_t WS_KN = WS_QN + (size_t)TT * 1024 * 2;
constexpr size_t WS_VV = WS_KN + (size_t)TT * 1024 * 2;
constexpr size_t WS_YP = WS_VV + (size_t)TT * 1024 * 2;
constexpr size_t WS_WDC = WS_YP + (size_t)TT * 1024 * 2;
constexpr size_t WS_QD = WS_WDC + (size_t)1024 * 64 * 128 * 2;
constexpr size_t WS_KT = WS_QD + (size_t)1024 * 64 * 128 * 2;
constexpr size_t WS_QK = WS_KT + (size_t)1024 * 64 * 128 * 2;
constexpr size_t WS_PROJ = WS_QK + (size_t)1024 * 64 * 64 * 2;
constexpr size_t WS_END = WS_PROJ + (size_t)TT * NPROJ * 2;
constexpr size_t WS_PB10 = WS_PROJ;
constexpr size_t WS_PB13 = WS_PROJ + (size_t)TT * DFF * 2;
static_assert(WS_PB13 + (size_t)11 * TS * DM * 4 <= WS_END && (WS_PB13 % 256) == 0, "partials");
static_assert(WS_END + 16384 <= 501510720ull, "workspace too large");
static_assert((WS_PROJ % 256) == 0 && (WS_QK % 256) == 0 && (WS_U % 256) == 0, "align");

constexpr int LDS_BYTES = 147456;

struct Params {
    const float* in[24];
    float* out;
    unsigned char* ws;
    int ph_lo, ph_hi;
};

__device__ __forceinline__ float bf2f(unsigned short x) { return __uint_as_float(((unsigned)x) << 16); }
__device__ __forceinline__ unsigned short f2bf(float f) { const __bf16 b = (__bf16)f; return __builtin_bit_cast(unsigned short, b); }
typedef __bf16 bf16x2_hw __attribute__((ext_vector_type(2)));
__device__ __forceinline__ unsigned pk2(float lo, float hi) { const f32x2 v = {lo, hi}; const bf16x2_hw b = __builtin_convertvector(v, bf16x2_hw); return __builtin_bit_cast(unsigned, b); }
__device__ __forceinline__ void unpack8(const u32x4 w, float* f) {
    f[0] = __uint_as_float(w.x << 16); f[1] = __uint_as_float(w.x & 0xffff0000u);
    f[2] = __uint_as_float(w.y << 16); f[3] = __uint_as_float(w.y & 0xffff0000u);
    f[4] = __uint_as_float(w.z << 16); f[5] = __uint_as_float(w.z & 0xffff0000u);
    f[6] = __uint_as_float(w.w << 16); f[7] = __uint_as_float(w.w & 0xffff0000u);
}
__device__ __forceinline__ u32x4 pack8(const float* f) { u32x4 w; w.x = pk2(f[0], f[1]); w.y = pk2(f[2], f[3]); w.z = pk2(f[4], f[5]); w.w = pk2(f[6], f[7]); return w; }
__device__ __forceinline__ float sigmoidf_(float x) { return __builtin_amdgcn_rcpf(1.0f + __expf(-x)); }
__device__ __forceinline__ float siluf_(float x) { return x * __builtin_amdgcn_rcpf(1.0f + __expf(-x)); }
__device__ __forceinline__ int bidx_of_row(int row) { return row < TP ? (row >> 11) : 4 + ((row - TP) >> 2); }

namespace pg8 {
constexpr int BM = 256, BK = 64, HALF = 128, HTB = HALF * BK * 2, STAGE_BYTES = 8 * HTB, NXCD = 8, WGM = 8;
__host__ __device__ __forceinline__ int lds_byte(int r, int c) { const int st = (r >> 4) * 2 + (c >> 5), rr = r & 15, cc = c & 31, ob = rr * 64 + cc * 2; return st * 1024 + (ob ^ (((ob >> 9) & 1) << 5)); }
__host__ __device__ __forceinline__ void stage_rc(int b, int& R, int& C) { const int st = b / 1024, sb = b % 1024, swz = sb ^ (((sb >> 9) & 1) << 5); R = (st >> 1) * 16 + swz / 64; C = (st & 1) * 32 + (swz % 64) / 2; }
__host__ __device__ __forceinline__ int perm32(int rho) { const int n = rho >> 4, i = rho & 15; return 8 * (i >> 2) + 4 * n + (i & 3); }

struct Unit { int pm, pn, kt0, nkt, piece; };
struct Gemm { const bf16_t* A; const bf16_t* Bt; int lda, ldb, K; size_t a_pn_off; size_t a_half, b_half, a_tile, b_tile; };

__device__ __forceinline__ void tile_of(int wgid, int nM, int nN, Unit& u) {
    const int nwg = nM * nN;
    { const int q = nwg / NXCD, r = nwg % NXCD, xcd = wgid % NXCD, off = wgid / NXCD; wgid = (xcd < r ? xcd * (q + 1) : r * (q + 1) + (xcd - r) * q) + off; }
    const int nig = WGM * nN, gid = wgid / nig, fm = gid * WGM, gsz = (nM - fm) < WGM ? (nM - fm) : WGM;
    u.pm = fm + ((wgid % nig) % gsz); u.pn = (wgid % nig) / gsz;
}
struct StaticOrder {
    int nM, nN, nwg, G, c, ntk;
    __device__ __forceinline__ void init(int M, int N, int K, int G_, int c_) { nM = M / BM; nN = N / BM; nwg = nM * nN; G = G_; c = c_; ntk = K / BK; }
    __device__ __forceinline__ bool next(int i, Unit& u) const {
        const long L = (long)i * G + c; if (L >= nwg) return false;
        tile_of((int)L, nM, nN, u); u.kt0 = 0; u.nkt = ntk; u.piece = -1; return true;
    }
};
struct OneUnitOrder {
    int n, c, ntk;
    __device__ __forceinline__ bool next(int i, Unit& u) const { if (i != 0 || c >= n) return false; u.pm = 0; u.pn = c; u.kt0 = 0; u.nkt = ntk; u.piece = -1; return true; }
};
struct DoubleOrder {
    int G, c;
    __device__ __forceinline__ bool next(int i, Unit& u) const {
        const int L = (i >> 1) * G + c, half = i & 1; const bool ok = L < 272;
        tile_of(ok ? L : 0, 34, 8, u); u.kt0 = 16 * half; u.nkt = 16; u.piece = half; return ok;
    }
};
struct SplitOrder {
    int G, c, ntk, pk, npc;
    __device__ __forceinline__ bool next(int i, Unit& u) const {
        const int L = i * G + c;
        const bool full = L < 256;
        int fpm, fpn;
        { int wgid = full ? L : 0; const int xcd = wgid % NXCD, off = wgid / NXCD; wgid = xcd * 32 + off;
          const int nig = WGM * 8, gid = wgid / nig, fm = gid * WGM; fpm = fm + ((wgid % nig) % WGM); fpn = (wgid % nig) / WGM; }
        const int pidx = full ? 0 : L - 256, tile = pidx / npc, pc = pidx - tile * npc;
        u.pm = full ? fpm : 32 + (tile >> 3); u.pn = full ? fpn : (tile & 7); u.kt0 = full ? 0 : pc * pk; u.nkt = full ? ntk : pk; u.piece = full ? -1 : pc;
        return full || pidx < 16 * npc;
    }
};

template <class Epi, class Sched>
__device__ __forceinline__ void gemm_phase(LAS unsigned char* lds, const Gemm g, const Sched& S, const Epi& E) {
    const int tid = threadIdx.x, wid = __builtin_amdgcn_readfirstlane(tid >> 6), lane = tid & 63, wr = wid >> 2, wc = wid & 3, fr = lane & 15, fq = lane >> 4;
    unsigned voffA[2], voffB[2];
#pragma unroll
    for (int i = 0; i < 2; ++i) { int R, C; stage_rc(tid * 16 + i * 8192, R, C); const int Rb = Epi::PERM ? ((R & ~31) + perm32(R & 31)) : R;
        voffA[i] = (unsigned)(R * g.lda + C) * 2u; voffB[i] = (unsigned)(Rb * g.ldb + C) * 2u; }
    const size_t kstep = (size_t)(BK * 2);
    const size_t hstepA = g.a_half ? g.a_half : (size_t)HALF * g.lda * 2, hstepB = g.b_half ? g.b_half : (size_t)HALF * g.ldb * 2;
    const size_t tstepA = g.a_tile ? g.a_tile : (size_t)BM * g.lda * 2, tstepB = g.b_tile ? g.b_tile : (size_t)BM * g.ldb * 2;
    const unsigned ldsw = (unsigned)wid * 1024u;
    const int aoff = lds_byte(wr * 64 + fr, fq * 8), boff = lds_byte(wc * 32 + fr, fq * 8);
#define PG8_SA(b, h) (((b) * 2 + (h)) * HTB)
#define PG8_SB(b, h) ((4 + (b) * 2 + (h)) * HTB)
#define PG8_STAGE(bufoff, gbase, voff) do { _Pragma("unroll") for (int _i = 0; _i < 2; ++_i) \
        __builtin_amdgcn_global_load_lds((const unsigned*)((const char*)(gbase) + (voff)[_i]), (LAS unsigned*)(lds + (bufoff) + ldsw + _i * 8192), 16, 0, 0); } while (0)
#define PG8_LDA(dst, b, h) do { _Pragma("unroll") for (int m = 0; m < 4; ++m) _Pragma("unroll") for (int k = 0; k < 2; ++k) dst[m][k] = *(const LAS bf16x8*)(lds + PG8_SA(b, h) + aoff + m * 2048 + k * 1024); } while (0)
#define PG8_LDB(dst, b, h) do { _Pragma("unroll") for (int n = 0; n < 2; ++n) _Pragma("unroll") for (int k = 0; k < 2; ++k) dst[n][k] = *(const LAS bf16x8*)(lds + PG8_SB(b, h) + boff + n * 2048 + k * 1024); } while (0)
#define PG8_MMA(ai, bj, At, Bt) do { __builtin_amdgcn_s_setprio(1); _Pragma("unroll") for (int m = 0; m < 4; ++m) _Pragma("unroll") for (int n = 0; n < 2; ++n) _Pragma("unroll") for (int k = 0; k < 2; ++k) \
        acc[ai][bj][m][n] = __builtin_amdgcn_mfma_f32_16x16x32_bf16(Bt[n][k], At[m][k], acc[ai][bj][m][n], 0, 0, 0); __builtin_amdgcn_s_setprio(0); } while (0)
#define PG8_WAIT_V(n) asm volatile("s_waitcnt vmcnt(" #n ")" ::: "memory")
#define PG8_WAIT_L(n) asm volatile("s_waitcnt lgkmcnt(" #n ")" ::: "memory")
#define PG8_BAR __builtin_amdgcn_s_barrier()
#define PG8_SCHED __builtin_amdgcn_sched_barrier(0)
    Unit cur, nxt; int ui = 0;
    if (!S.next(0, cur)) return;
    f32x4 acc[2][2][4][2];
#pragma unroll
    for (int a = 0; a < 2; ++a)
#pragma unroll
        for (int b = 0; b < 2; ++b)
#pragma unroll
            for (int m = 0; m < 4; ++m)
#pragma unroll
                for (int n = 0; n < 2; ++n) acc[a][b][m][n] = (f32x4){0.f, 0.f, 0.f, 0.f};
    bf16x8 At[4][2], B0[2][2], B1[2][2];
    const char* cA = (const char*)g.A + (size_t)cur.pm * tstepA + (size_t)cur.pn * g.a_pn_off + (size_t)cur.kt0 * kstep; const char* cB = (const char*)g.Bt + (size_t)cur.pn * tstepB + (size_t)cur.kt0 * kstep;
    PG8_STAGE(PG8_SB(0, 0), cB, voffB); PG8_STAGE(PG8_SA(0, 0), cA, voffA); PG8_STAGE(PG8_SB(0, 1), cB + hstepB, voffB); PG8_STAGE(PG8_SA(0, 1), cA + hstepA, voffA);
    if (wr == 1) PG8_BAR;
    PG8_WAIT_V(4); PG8_BAR;
    PG8_STAGE(PG8_SB(1, 0), cB + kstep, voffB); PG8_STAGE(PG8_SA(1, 0), cA + kstep, voffA); PG8_STAGE(PG8_SB(1, 1), cB + hstepB + kstep, voffB);
    PG8_WAIT_V(6); PG8_BAR;
    for (;;) {
        const bool has_next = S.next(ui + 1, nxt);
        const char* nA = has_next ? (const char*)g.A + (size_t)nxt.pm * tstepA + (size_t)nxt.pn * g.a_pn_off + (size_t)nxt.kt0 * kstep : cA; const char* nB = has_next ? (const char*)g.Bt + (size_t)nxt.pn * tstepB + (size_t)nxt.kt0 * kstep : cB;
        const int nt = cur.nkt;
#pragma unroll 1
        for (int t = 0; t < nt; t += 2) {
            const bool last = (t == nt - 2);
            const char* a1 = cA + (size_t)(t + 1) * kstep;
            const char* a2 = last ? nA : cA + (size_t)(t + 2) * kstep; const char* b2 = last ? nB : cB + (size_t)(t + 2) * kstep;
            const char* a3 = a2 + kstep; const char* b3 = b2 + kstep;
            PG8_LDB(B0, 0, 0); PG8_SCHED; PG8_LDA(At, 0, 0); PG8_STAGE(PG8_SA(1, 1), a1 + hstepA, voffA);
            PG8_WAIT_L(8); PG8_BAR; PG8_WAIT_L(0); PG8_MMA(0, 0, At, B0); PG8_BAR; PG8_SCHED;
            PG8_LDB(B1, 0, 1); PG8_STAGE(PG8_SB(0, 0), b2, voffB);
            PG8_BAR; PG8_WAIT_L(0); if constexpr (!Epi::DIAG) PG8_MMA(0, 1, At, B1); PG8_BAR;
            PG8_LDA(At, 0, 1); PG8_STAGE(PG8_SA(0, 0), a2, voffA);
            PG8_BAR; PG8_WAIT_L(0); if constexpr (!Epi::DIAG) PG8_MMA(1, 0, At, B0); PG8_BAR; PG8_SCHED;
            PG8_STAGE(PG8_SB(0, 1), b2 + hstepB, voffB);
            PG8_WAIT_V(6); PG8_BAR; PG8_MMA(1, 1, At, B1); PG8_BAR;
            PG8_LDB(B0, 1, 0); PG8_SCHED; PG8_LDA(At, 1, 0); PG8_STAGE(PG8_SA(0, 1), a2 + hstepA, voffA);
            PG8_WAIT_L(8); PG8_BAR; PG8_WAIT_L(0); PG8_MMA(0, 0, At, B0); PG8_BAR; PG8_SCHED;
            PG8_LDB(B1, 1, 1); PG8_STAGE(PG8_SB(1, 0), b3, voffB);
            PG8_BAR; PG8_WAIT_L(0); if constexpr (!Epi::DIAG) PG8_MMA(0, 1, At, B1); PG8_BAR;
            PG8_LDA(At, 1, 1); PG8_STAGE(PG8_SA(1, 0), a3, voffA);
            PG8_BAR; PG8_WAIT_L(0); if constexpr (!Epi::DIAG) PG8_MMA(1, 0, At, B0); PG8_BAR; PG8_SCHED;
            PG8_STAGE(PG8_SB(1, 1), b3 + hstepB, voffB);
            PG8_WAIT_V(6); PG8_BAR; PG8_MMA(1, 1, At, B1); PG8_BAR;
        }
        E(acc, cur, wr, wc, fr, fq);
        if (!has_next) break;
#pragma unroll
        for (int a = 0; a < 2; ++a)
#pragma unroll
            for (int b = 0; b < 2; ++b)
#pragma unroll
                for (int m = 0; m < 4; ++m)
#pragma unroll
                    for (int n = 0; n < 2; ++n) acc[a][b][m][n] = (f32x4){0.f, 0.f, 0.f, 0.f};
        cur = nxt; cA = nA; cB = nB; ++ui;
    }
    PG8_WAIT_V(0);
    if (wr == 0) PG8_BAR;
    PG8_BAR;
#undef PG8_SA
#undef PG8_SB
#undef PG8_STAGE
#undef PG8_LDA
#undef PG8_LDB
#undef PG8_MMA
#undef PG8_WAIT_V
#undef PG8_WAIT_L
#undef PG8_BAR
#undef PG8_SCHED
}

typedef f32x4 Acc[2][2][4][2];

struct EpiAda {
    static constexpr bool PERM = false, MID = false, DIAG = false;
    float* C; const float* bias;
    __device__ __forceinline__ void operator()(const Acc& acc, const Unit& u, int wr, int wc, int fr, int fq) const {
        const int row0 = wr * 64 + fr, col0 = u.pn * BM + wc * 32 + 4 * fq;
#pragma unroll
        for (int ai = 0; ai < 2; ++ai)
#pragma unroll
            for (int m = 0; m < 4; ++m) { const int row = row0 + ai * HALF + m * 16; if (row < NB) {
#pragma unroll
                for (int bj = 0; bj < 2; ++bj)
#pragma unroll
                    for (int n = 0; n < 2; ++n) { const int c = col0 + bj * HALF + n * 16; *(f32x4*)(C + (size_t)row * MODW + c) = acc[ai][bj][m][n] + *(const f32x4*)(bias + c); } } }
    }
};
struct EpiBf16 {
    static constexpr bool PERM = true, MID = false, DIAG = false;
    bf16_t* O; int ldc; int col_off; const float* scale;
    __device__ __forceinline__ void operator()(const Acc& acc, const Unit& u, int wr, int wc, int fr, int fq) const {
        const int row0 = u.pm * BM + wr * 64 + fr, col0 = u.pn * BM + wc * 32 + 8 * fq;
#pragma unroll
        for (int ai = 0; ai < 2; ++ai)
#pragma unroll
            for (int m = 0; m < 4; ++m) { bf16_t* rowp = O + (size_t)(row0 + ai * HALF + m * 16) * ldc + col_off + col0;
#pragma unroll
                for (int bj = 0; bj < 2; ++bj) { f32x4 v0 = acc[ai][bj][m][0], v1 = acc[ai][bj][m][1];
                    if (scale) { v0 *= *(const f32x4*)(scale + col0 + bj * HALF); v1 *= *(const f32x4*)(scale + col0 + bj * HALF + 4); }
                    u32x4 w; w.x = pk2(v0[0], v0[1]); w.y = pk2(v0[2], v0[3]); w.z = pk2(v1[0], v1[1]); w.w = pk2(v1[2], v1[3]);
                    *(u32x4*)(rowp + bj * HALF) = w; }
                if (scale) asm volatile("" ::: "memory"); }
    }
};
struct EpiG1 {
    static constexpr bool PERM = true, MID = false, DIAG = false;
    float* T1; const bf16_t* proj;
    __device__ __forceinline__ void operator()(const Acc& acc, const Unit& u, int wr, int wc, int fr, int fq) const {
        const int row0 = u.pm * BM + wr * 64 + fr, col0 = u.pn * BM + wc * 32 + 8 * fq;
#pragma unroll
        for (int ai = 0; ai < 2; ++ai)
#pragma unroll
            for (int m = 0; m < 4; ++m) { const size_t row = (size_t)(row0 + ai * HALF + m * 16); const bf16_t* pr = proj + row * NPROJ + col0;
#pragma unroll
                for (int bj = 0; bj < 2; ++bj) { float ga[8]; unpack8(*(const u32x4*)(pr + C_GA + bj * HALF), ga); f32x4 v0, v1;
#pragma unroll
                    for (int j = 0; j < 4; ++j) { v0[j] = acc[ai][bj][m][0][j] * __builtin_amdgcn_rcpf(1.0f + __expf(-ga[j])); v1[j] = acc[ai][bj][m][1][j] * __builtin_amdgcn_rcpf(1.0f + __expf(-ga[4 + j])); }
                    float* o = T1 + row * DM + col0 + bj * HALF; *(f32x4*)o = v0; *(f32x4*)(o + 4) = v1; }
                }
    }
};
struct EpiG2 {
    static constexpr bool PERM = true, MID = false, DIAG = false;
    bf16_t* O; const float* T1; const bf16_t* proj;
    __device__ __forceinline__ void operator()(const Acc& acc, const Unit& u, int wr, int wc, int fr, int fq) const {
        const int row0 = u.pm * BM + wr * 64 + fr, col0 = u.pn * BM + wc * 32 + 8 * fq;
#pragma unroll
        for (int ai = 0; ai < 2; ++ai)
#pragma unroll
            for (int m = 0; m < 4; ++m) { const size_t row = (size_t)(row0 + ai * HALF + m * 16); const bf16_t* pr = proj + row * NPROJ + col0;
#pragma unroll
                for (int bj = 0; bj < 2; ++bj) { float gb[8], v[8]; unpack8(*(const u32x4*)(pr + C_GB + bj * HALF), gb);
                    const float* t = T1 + row * DM + col0 + bj * HALF; const f32x4 t0 = *(const f32x4*)t, t1 = *(const f32x4*)(t + 4);
#pragma unroll
                    for (int j = 0; j < 4; ++j) { v[j] = t0[j] + acc[ai][bj][m][0][j] * __builtin_amdgcn_rcpf(1.0f + __expf(-gb[j])); v[4 + j] = t1[j] + acc[ai][bj][m][1][j] * __builtin_amdgcn_rcpf(1.0f + __expf(-gb[4 + j])); }
                    *(u32x4*)(O + row * DM + col0 + bj * HALF) = pack8(v); }
                if (m & 1) asm volatile("" ::: "memory"); }
    }
};
struct EpiG12 {
    static constexpr bool PERM = true, MID = false, DIAG = false;
    EpiG1 e1; EpiG2 e2;
    __device__ __forceinline__ void operator()(const Acc& acc, const Unit& u, int wr, int wc, int fr, int fq) const { if (u.piece == 0) e1(acc, u, wr, wc, fr, fq); else e2(acc, u, wr, wc, fr, fq); }
};
struct EpiDiag {
    static constexpr bool PERM = true, MID = false, DIAG = true;
    bf16_t* O; const bf16_t* proj;
    __device__ __forceinline__ void operator()(const Acc& acc, const Unit& u, int wr, int wc, int fr, int fq) const {
        const int row0 = u.pm * HALF + wr * 64 + fr, col0 = u.pn * HALF + wc * 32 + 8 * fq;
#pragma unroll
        for (int m = 0; m < 4; ++m) { const size_t row = (size_t)(row0 + m * 16); const bf16_t* pr = proj + row * NPROJ + col0;
            float ga[8], gb[8], v[8]; unpack8(*(const u32x4*)(pr + C_GA), ga); unpack8(*(const u32x4*)(pr + C_GB), gb);
#pragma unroll
            for (int n = 0; n < 2; ++n)
#pragma unroll
                for (int j = 0; j < 4; ++j) v[4 * n + j] = acc[0][0][m][n][j] * __builtin_amdgcn_rcpf(1.0f + __expf(-ga[4 * n + j])) + acc[1][1][m][n][j] * __builtin_amdgcn_rcpf(1.0f + __expf(-gb[4 * n + j]));
            *(u32x4*)(O + row * DM + col0) = pack8(v); }
    }
};
struct EpiRes {
    static constexpr bool PERM = false, MID = false, DIAG = false;
    float* X1; const float* x0p; const float* x0s; const float* gate; float* PB;
    __device__ __forceinline__ void operator()(const Acc& acc, const Unit& u, int wr, int wc, int fr, int fq) const {
        const int row0 = u.pm * BM + wr * 64 + fr, col0 = u.pn * BM + wc * 32 + 4 * fq;
        if (u.piece >= 0) {
            float* pb = PB + (size_t)u.piece * TS * DM;
#pragma unroll
            for (int ai = 0; ai < 2; ++ai)
#pragma unroll
                for (int m = 0; m < 4; ++m) { float* orow = pb + (size_t)(row0 + ai * HALF + m * 16 - TP) * DM;
#pragma unroll
                    for (int bj = 0; bj < 2; ++bj)
#pragma unroll
                        for (int n = 0; n < 2; ++n) *(f32x4*)(orow + col0 + bj * HALF + n * 16) = acc[ai][bj][m][n]; }
            return;
        }
#pragma unroll
        for (int ai = 0; ai < 2; ++ai)
#pragma unroll
            for (int m = 0; m < 4; ++m) { const int row = row0 + ai * HALF + m * 16; const int b = bidx_of_row(row);
                const float* xr = (row < TP) ? x0p + (size_t)row * DM : x0s + (size_t)(row - TP) * DM; const float* gr = gate + (size_t)b * MODW; float* orow = X1 + (size_t)row * DM;
#pragma unroll
                for (int bj = 0; bj < 2; ++bj)
#pragma unroll
                    for (int n = 0; n < 2; ++n) { const int c = col0 + bj * HALF + n * 16; const f32x4 xv = *(const f32x4*)(xr + c), gv = *(const f32x4*)(gr + c);
                        *(f32x4*)(orow + c) = xv + gv * acc[ai][bj][m][n]; } }
    }
};
struct EpiGU {
    static constexpr bool PERM = true, MID = false, DIAG = false;
    bf16_t* O;
    __device__ __forceinline__ void operator()(const Acc& acc, const Unit& u, int wr, int wc, int fr, int fq) const {
        const int row0 = u.pm * BM + wr * 64 + fr, col0 = u.pn * HALF + wc * 32 + 8 * fq;
#pragma unroll
        for (int ai = 0; ai < 2; ++ai)
#pragma unroll
            for (int m = 0; m < 4; ++m) { float v[8];
#pragma unroll
                for (int n = 0; n < 2; ++n)
#pragma unroll
                    for (int j = 0; j < 4; ++j) { const float gt = acc[ai][0][m][n][j]; v[4 * n + j] = gt * __builtin_amdgcn_rcpf(1.0f + __expf(-gt)) * acc[ai][1][m][n][j]; }
                *(u32x4*)(O + (size_t)(row0 + ai * HALF + m * 16) * DFF + col0) = pack8(v); }
    }
};
}

struct TJob { const float* src; bf16_t* dst; int ld_src, K, Nout, ld_dst, map, pad; };
__device__ __forceinline__ int map_col(int map, int n) {
    if (map == 1) { if (n < 4096) return n; if (n < 5120) return 4112 + (n - 4096); if (n < 9216) return 5136 + (n - 5120); if (n < 9232) return 4096 + (n - 9216); return -1; }
    if (map == 2) { const int pn = n >> 8, w = n & 255; return w < 128 ? 128 * pn + w : DFF + 128 * pn + (w - 128); }
    return n;
}
__device__ __forceinline__ void tjob_load(const TJob& j, int tile, f32x4 (&v)[4]) {
    const int tid = threadIdx.x, nkt = j.K >> 7, tn = tile / nkt, tk = tile - tn * nkt;
    const int n = tn * 64 + (tid & 15) * 4, kr = tid >> 4, col = map_col(j.map, n);
#pragma unroll
    for (int i = 0; i < 4; ++i) v[i] = col >= 0 ? __builtin_nontemporal_load((const f32x4*)(j.src + (size_t)(tk * 128 + kr + 32 * i) * j.ld_src + col)) : (f32x4){0.f, 0.f, 0.f, 0.f};
}
__device__ __forceinline__ void tjob_store(const TJob& j, int tile, const f32x4 (&v)[4], LAS float* s) {
    const int tid = threadIdx.x, nkt = j.K >> 7, tn = tile / nkt, tk = tile - tn * nkt;
    const int nq = tid & 15, kr = tid >> 4;
    __syncthreads();
#pragma unroll
    for (int i = 0; i < 4; ++i)
#pragma unroll
        for (int q = 0; q < 4; ++q) s[(4 * nq + q) * 129 + kr + 32 * i] = v[i][q];
    __syncthreads();
    const int n = tid >> 3, k16 = (tid & 7) * 16;
    float f[16];
#pragma unroll
    for (int i = 0; i < 16; ++i) f[i] = s[n * 129 + k16 + i];
    bf16_t* d = j.dst + (size_t)(tn * 64 + n) * j.ld_dst + tk * 128 + k16;
    *(u32x4*)d = pack8(f); *(u32x4*)(d + 8) = pack8(f + 8);
}
__device__ __forceinline__ void transpose_jobs(const TJob* jobs, int njobs, int bi, int nblk, LAS unsigned char* lds) {
    LAS float* s = (LAS float*)lds;
    int total = 0;
    for (int q = 0; q < njobs; ++q) total += (jobs[q].Nout >> 6) * (jobs[q].K >> 7);
    f32x4 v[4]; int curj = 0, base = 0;
    int t = bi;
    auto locate = [&](int tt, int& jj, int& bb) { while (tt >= bb + (jobs[jj].Nout >> 6) * (jobs[jj].K >> 7)) { bb += (jobs[jj].Nout >> 6) * (jobs[jj].K >> 7); ++jj; } };
    if (t < total) { locate(t, curj, base); tjob_load(jobs[curj], t - base, v); }
    while (t < total) {
        const int tn = t + nblk; int nj = curj, nb = base; f32x4 w[4];
        if (tn < total) { locate(tn, nj, nb); tjob_load(jobs[nj], tn - nb, w); }
        tjob_store(jobs[curj], t - base, v, s);
        if (tn < total) {
#pragma unroll
            for (int i = 0; i < 4; ++i) v[i] = w[i]; }
        t = tn; curj = nj; base = nb;
    }
    __syncthreads();
}

template <int MODE>
__device__ __forceinline__ void norm_phase(const Params& p, int bid, int nblk) {
    const int lane = threadIdx.x & 63, wid = __builtin_amdgcn_readfirstlane(threadIdx.x >> 6);
    const float* mod = (const float*)(p.ws + WS_MOD);
    const float* gain = MODE == 0 ? p.in[9] : (MODE == 1 ? p.in[20] : p.in[23]);
    bf16_t* U = (bf16_t*)(p.ws + WS_U);
    auto srcrow = [&](int row) -> const float* { return MODE == 0 ? (row < TP ? p.in[0] + (size_t)row * DM : p.in[1] + (size_t)(row - TP) * DM) : p.out + O_Y + (size_t)row * DM; };
    const int stride = nblk * 8;
    f32x4 g[8];
#pragma unroll
    for (int i = 0; i < 8; ++i) g[i] = *(const f32x4*)(gain + i * 256 + lane * 4);
    f32x4 v[8], vn[8];
    bool have = false;
    for (int row = bid * 8 + wid; row < TT; row += stride) {
        const float* src = srcrow(row);
        if (MODE != 0 && row >= TP) {
            const float* xs = p.in[1] + (size_t)(row - TP) * DM;
            const float* pb = (const float*)(p.ws + (MODE == 1 ? WS_PB10 : WS_PB13)) + (size_t)(row - TP) * DM;
            const float* gt = mod + (size_t)bidx_of_row(row) * MODW + (MODE == 1 ? 4096 : 10240);
            float* xo = p.out + O_Y + (size_t)row * DM;
            constexpr int NPC = MODE == 1 ? 8 : 11;
#pragma unroll 1
            for (int i = 0; i < 8; ++i) { const int c = i * 256 + lane * 4; f32x4 s = *(const f32x4*)(pb + c);
#pragma unroll
                for (int q = 1; q < NPC; ++q) s += *(const f32x4*)(pb + (size_t)q * TS * DM + c);
                const f32x4 base = MODE == 1 ? *(const f32x4*)(xs + c) : *(const f32x4*)(xo + c);
                *(f32x4*)(xo + c) = base + *(const f32x4*)(gt + c) * s; }
            asm volatile("s_waitcnt vmcnt(0)" ::: "memory");
        }
        f32x4 s1[8], s0[8]; float ss = 0.f;
        const float* sh = mod + (size_t)bidx_of_row(row) * MODW + (MODE == 0 ? 0 : 6144); const float* sc = sh + 2048;
        if (!have) {
#pragma unroll
            for (int i = 0; i < 8; ++i) v[i] = *(const f32x4*)(src + i * 256 + lane * 4);
        }
        if (MODE != 2) {
#pragma unroll
            for (int i = 0; i < 8; ++i) { const int c = i * 256 + lane * 4; s1[i] = *(const f32x4*)(sc + c); s0[i] = *(const f32x4*)(sh + c); }
        }
        const int nrow = row + stride;
        const bool pre = nrow < TT && (MODE == 0 || nrow < TP);
        if (pre) { const float* ns = srcrow(nrow);
#pragma unroll
            for (int i = 0; i < 8; ++i) vn[i] = *(const f32x4*)(ns + i * 256 + lane * 4); }
        asm volatile("" ::: "memory");
#pragma unroll
        for (int i = 0; i < 8; ++i) ss += v[i][0] * v[i][0] + v[i][1] * v[i][1] + v[i][2] * v[i][2] + v[i][3] * v[i][3];
#pragma unroll
        for (int o = 32; o >= 1; o >>= 1) ss += __shfl_xor(ss, o);
        const float rstd = rsqrtf(ss * (1.0f / DM) + EPS);
        if (MODE == 2) {
            float* dst = p.out + O_Y + (size_t)row * DM;
#pragma unroll
            for (int i = 0; i < 8; ++i) *(f32x4*)(dst + i * 256 + lane * 4) = v[i] * rstd * g[i];
        } else {
#pragma unroll
            for (int i = 0; i < 8; ++i) { const int c = i * 256 + lane * 4;
                const f32x4 y = (v[i] * rstd * g[i]) * (1.0f + s1[i]) + s0[i]; u32x2 w; w.x = pk2(y[0], y[1]); w.y = pk2(y[2], y[3]); *(u32x2*)(U + (size_t)row * DM + c) = w; }
        }
        have = pre;
        if (pre) {
#pragma unroll
            for (int i = 0; i < 8; ++i) v[i] = vn[i]; }
    }
}

template <int NTOK, bool SMP>
__device__ __forceinline__ void mixer_item(const Params& p, int it) {
    const int tid = threadIdx.x;
    const bf16_t* proj = (const bf16_t*)(p.ws + WS_PROJ);
    bf16_t* qn = (bf16_t*)(p.ws + WS_QN); bf16_t* kn = (bf16_t*)(p.ws + WS_KN); bf16_t* vv = (bf16_t*)(p.ws + WS_VV); bf16_t* yp = (bf16_t*)(p.ws + WS_YP);
    float* gbuf = (float*)(p.ws + WS_G); float* bbuf = (float*)(p.ws + WS_BETA);
    const int sb = it - 512;
    const int b = SMP ? 0 : (it >> 7), t0 = SMP ? 0 : (it & 127) * 16;
    const int rowbase = SMP ? TP + sb * 4 : b * 2048 + t0;
    if (tid < 384) {
        const int c0 = tid * 8;
        float w0[8], w1[8], w2[8], w3[8], xm3[8], xm2[8], xm1[8];
        const float* cw = p.in[11];
#pragma unroll
        for (int i = 0; i < 8; ++i) { w0[i] = cw[c0 + i]; w1[i] = cw[3072 + c0 + i]; w2[i] = cw[6144 + c0 + i]; w3[i] = cw[9216 + c0 + i]; }
        if (SMP) { const float* sc = p.in[5] + (size_t)sb * 3 * 3072 + c0;
#pragma unroll
            for (int i = 0; i < 8; ++i) { xm3[i] = sc[i]; xm2[i] = sc[3072 + i]; xm1[i] = sc[6144 + i]; }
        } else if (t0 == 0) {
#pragma unroll
            for (int i = 0; i < 8; ++i) { xm3[i] = 0.f; xm2[i] = 0.f; xm1[i] = 0.f; }
        } else {
            unpack8(*(const u32x4*)(proj + (size_t)(rowbase - 3) * NPROJ + c0), xm3); unpack8(*(const u32x4*)(proj + (size_t)(rowbase - 2) * NPROJ + c0), xm2); unpack8(*(const u32x4*)(proj + (size_t)(rowbase - 1) * NPROJ + c0), xm1);
        }
        constexpr int CH = NTOK < 8 ? NTOK : 8;
#pragma unroll
        for (int tc = 0; tc < NTOK; tc += CH) {
        u32x4 xr[CH];
#pragma unroll
        for (int t = 0; t < CH; ++t) xr[t] = *(const u32x4*)(proj + (size_t)(rowbase + tc + t) * NPROJ + c0);
#pragma unroll
        for (int t2 = 0; t2 < CH; ++t2) {
            const int t = tc + t2;
            const int row = rowbase + t; float xt[8], y[8];
            unpack8(xr[t2], xt);
            float ss = 0.f;
#pragma unroll
            for (int i = 0; i < 8; ++i) { const float a = w0[i] * xm3[i] + w1[i] * xm2[i] + w2[i] * xm1[i] + w3[i] * xt[i]; y[i] = siluf_(a); ss += y[i] * y[i]; }
            if (c0 < 2048) {
                ss += __shfl_xor(ss, 1); ss += __shfl_xor(ss, 2); ss += __shfl_xor(ss, 4); ss += __shfl_xor(ss, 8);
                const float inv = rsqrtf(ss + EPS);
#pragma unroll
                for (int i = 0; i < 8; ++i) y[i] *= inv;
            }
            bf16_t* dst = c0 < 1024 ? qn + (size_t)row * 1024 + c0 : (c0 < 2048 ? kn + (size_t)row * 1024 + (c0 - 1024) : vv + (size_t)row * 1024 + (c0 - 2048));
            *(u32x4*)dst = pack8(y);
            if (SMP) { if (t >= 1) { float* o = p.out + O_CS + ((size_t)sb * 3 + (t - 1)) * 3072 + c0; *(f32x4*)o = (f32x4){xt[0], xt[1], xt[2], xt[3]}; *(f32x4*)(o + 4) = (f32x4){xt[4], xt[5], xt[6], xt[7]}; } }
            else if (t0 + t >= 2045) { float* o = p.out + O_CP + ((size_t)b * 3 + (t0 + t - 2045)) * 3072 + c0; *(f32x4*)o = (f32x4){xt[0], xt[1], xt[2], xt[3]}; *(f32x4*)(o + 4) = (f32x4){xt[4], xt[5], xt[6], xt[7]}; }
#pragma unroll
            for (int i = 0; i < 8; ++i) { xm3[i] = xm2[i]; xm2[i] = xm1[i]; xm1[i] = xt[i]; }
        }
        }
    } else {
        const int pc = (tid - 384) * 8, gi = pc >> 8, w = 2 << gi;
        const int seqrow0 = SMP ? TP + sb * 4 : b * 2048;
        const float* sp = p.in[6] + (size_t)sb * 15 * 1024 + pc;
        auto xpool = [&](int tt, float* f) {
            if (tt >= 0) unpack8(*(const u32x4*)(proj + (size_t)(seqrow0 + tt) * NPROJ + C_XP + pc), f);
            else if (SMP) { const float* s = sp + (size_t)(15 + tt) * 1024;
#pragma unroll
                for (int i = 0; i < 8; ++i) f[i] = s[i]; }
            else {
#pragma unroll
                for (int i = 0; i < 8; ++i) f[i] = 0.f; }
        };
        float s[8];
#pragma unroll
        for (int i = 0; i < 8; ++i) s[i] = 0.f;
#pragma unroll
        for (int q = 1; q < 16; ++q) if (q < w) { float f[8]; xpool(t0 - q, f);
#pragma unroll
            for (int i = 0; i < 8; ++i) s[i] += f[i]; }
#pragma unroll 4
        for (int t = 0; t < NTOK; ++t) {
            const int tt = t0 + t; float x[8], y[8], f[8];
            xpool(tt, x);
            const float cnt = SMP ? (float)w : (float)min(w, tt + 1); const float ic = 1.0f / cnt;
#pragma unroll
            for (int i = 0; i < 8; ++i) { s[i] += x[i]; y[i] = s[i] * ic - x[i]; }
            *(u32x4*)(yp + (size_t)(seqrow0 + tt) * 1024 + pc) = pack8(y);
            xpool(tt - w + 1, f);
#pragma unroll
            for (int i = 0; i < 8; ++i) s[i] -= f[i];
            if (SMP) { float* o = p.out + O_PS + ((size_t)sb * 15 + 11 + t) * 1024 + pc; *(f32x4*)o = (f32x4){x[0], x[1], x[2], x[3]}; *(f32x4*)(o + 4) = (f32x4){x[4], x[5], x[6], x[7]}; }
            else if (tt >= 2033) { float* o = p.out + O_PP + ((size_t)b * 15 + (tt - 2033)) * 1024 + pc; *(f32x4*)o = (f32x4){x[0], x[1], x[2], x[3]}; *(f32x4*)(o + 4) = (f32x4){x[4], x[5], x[6], x[7]}; }
        }
        if (SMP) {
#pragma unroll
            for (int r = 0; r < 11; ++r) { const float* s2 = sp + (size_t)(4 + r) * 1024; float* o = p.out + O_PS + ((size_t)sb * 15 + r) * 1024 + pc; *(f32x4*)o = *(const f32x4*)s2; *(f32x4*)(o + 4) = *(const f32x4*)(s2 + 4); } }
    }
    if (tid < 256) { const int tk = tid >> 4, jj = tid & 15;
        if (tk < NTOK) { const int row = rowbase + tk; const float val = bf2f(proj[(size_t)row * NPROJ + C_AB + jj]);
            if (jj < 8) { const float xx = val + p.in[13][jj]; const float spl = xx > 20.f ? xx : log1pf(__expf(xx)); gbuf[row * 8 + jj] = -__expf(p.in[12][jj]) * spl; }
            else bbuf[row * 8 + (jj - 8)] = sigmoidf_(val); } }
}
__device__ __forceinline__ void mixer_prep_phase(const Params& p, int bid, int nblk) {
    for (int it = bid; it < 640; it += nblk) { if (it >= 512) mixer_item<4, true>(p, it); else mixer_item<16, false>(p, it); }
}

constexpr int P5_QS = 0, P5_KS = 17408, P5_VS = 34816, P5_MM = 52224, P5_DEC = 68608, P5_BETA = 68864, P5_GRP = 69632;
static_assert(2 * P5_GRP <= LDS_BYTES - 16, "lds");
__device__ __forceinline__ void chunk_prep_phase(const Params& p, int bid, int nblk, LAS unsigned char* lds0) {
    const int tid = threadIdx.x, lane = tid & 63, grp = tid >> 8, lt = tid & 255, lw = __builtin_amdgcn_readfirstlane(tid >> 6) & 3;
    LAS unsigned char* lds = lds0 + grp * P5_GRP;
    const bf16_t* qn = (const bf16_t*)(p.ws + WS_QN); const bf16_t* kn = (const bf16_t*)(p.ws + WS_KN); const bf16_t* vv = (const bf16_t*)(p.ws + WS_VV);
    const float* gbuf = (const float*)(p.ws + WS_G); const float* bbuf = (const float*)(p.ws + WS_BETA);
    bf16_t* wdc = (bf16_t*)(p.ws + WS_WDC); bf16_t* qd = (bf16_t*)(p.ws + WS_QD); bf16_t* kt = (bf16_t*)(p.ws + WS_KT); bf16_t* qk = (bf16_t*)(p.ws + WS_QK);
    float* cdv = (float*)(p.ws + WS_CD); float* ub = p.out + OS_UB;
    LAS float* Mm = (LAS float*)(lds + P5_MM); LAS float* dec = (LAS float*)(lds + P5_DEC); LAS float* bet = (LAS float*)(lds + P5_BETA);
    const float scale = 0.08838834764831845f;
    for (int it0 = bid * 2; it0 < 1024; it0 += nblk * 2) {
        const int item = it0 + grp, n = item & 31, bh = item >> 5, h = bh & 7, b = bh >> 3;
        const int r0 = b * 2048 + n * 64;
        __syncthreads();
#pragma unroll
        for (int i = 0; i < 4; ++i) { const int ch = lt + 256 * i, r = ch >> 4, c8 = (ch & 15) * 8; const size_t go = (size_t)(r0 + r) * 1024 + h * 128 + c8; const int lo = r * 272 + c8 * 2;
            *(LAS u32x4*)(lds + P5_QS + lo) = *(const u32x4*)(qn + go); *(LAS u32x4*)(lds + P5_KS + lo) = *(const u32x4*)(kn + go); *(LAS u32x4*)(lds + P5_VS + lo) = *(const u32x4*)(vv + go); }
        if (lt < 64) {
            float g = gbuf[(r0 + lt) * 8 + h];
#pragma unroll
            for (int o = 1; o < 64; o <<= 1) { const float t = __shfl_up(g, o); if (lane >= o) g += t; }
            dec[lt] = g;
        } else if (lt < 128) bet[lt - 64] = bbuf[(r0 + lt - 64) * 8 + h];
        __syncthreads();
        {
            const int rt = lw, fr = lane & 15, fq = lane >> 4;
#pragma unroll
            for (int mat = 0; mat < 2; ++mat) {
                bf16x8 a[4];
#pragma unroll
                for (int kk = 0; kk < 4; ++kk) a[kk] = *(const LAS bf16x8*)(lds + (mat ? P5_QS : P5_KS) + (rt * 16 + fr) * 272 + (kk * 32 + fq * 8) * 2);
#pragma unroll
                for (int st = 0; st < 4; ++st) {
                    f32x4 d = (f32x4){0.f, 0.f, 0.f, 0.f};
#pragma unroll
                    for (int kk = 0; kk < 4; ++kk) { const bf16x8 bb = *(const LAS bf16x8*)(lds + P5_KS + (st * 16 + fr) * 272 + (kk * 32 + fq * 8) * 2); d = __builtin_amdgcn_mfma_f32_16x16x32_bf16(a[kk], bb, d, 0, 0, 0); }
                    const int s = st * 16 + fr; const float ds = dec[s];
#pragma unroll
                    for (int j = 0; j < 4; ++j) { const int r = rt * 16 + fq * 4 + j; const float dr = dec[r];
                        if (mat == 0) Mm[r * 64 + s] = (r > s) ? bet[r] * d[j] * __expf(dr - ds) : 0.f;
                        else qk[(size_t)item * 4096 + r * 64 + s] = f2bf((r >= s) ? scale * d[j] * __expf(dr - ds) : 0.f); }
                }
            }
        }
        __syncthreads();
        const int w8 = __builtin_amdgcn_readfirstlane(tid >> 6);
        if (w8 < 4) {
            const int g2 = w8 >> 1, c = (w8 & 1) * 64 + lane; const int item2 = it0 + g2;
            LAS unsigned char* lg = lds0 + g2 * P5_GRP; LAS float* Mg = (LAS float*)(lg + P5_MM); LAS float* decg = (LAS float*)(lg + P5_DEC); LAS float* betg = (LAS float*)(lg + P5_BETA);
            f32x2 xy[64]; f32x4 mq[6]; f32x2 ab0, ab1;
            float* up = ub + (size_t)item2 * 8192 + c; bf16_t* wp = wdc + (size_t)item2 * 8192 + c;
            { const float br = betg[0]; ab0 = (f32x2){bf2f(*(const LAS bf16_t*)(lg + P5_VS + 0 + c * 2)) * br, bf2f(*(const LAS bf16_t*)(lg + P5_KS + 0 + c * 2)) * br * __expf(decg[0])}; ab1 = (f32x2){0.f, 0.f}; } xy[0] = ab0; up[0] = xy[0][0]; wp[0] = f2bf(-xy[0][1]);
            mq[0] = *(const LAS f32x4*)(Mg + 64); mq[1] = *(const LAS f32x4*)(Mg + 128); mq[2] = *(const LAS f32x4*)(Mg + 192); mq[3] = *(const LAS f32x4*)(Mg + 256); mq[4] = *(const LAS f32x4*)(Mg + 320); mq[5] = *(const LAS f32x4*)(Mg + 324);
            { const float br = betg[1]; ab0 = (f32x2){bf2f(*(const LAS bf16_t*)(lg + P5_VS + 272 + c * 2)) * br, bf2f(*(const LAS bf16_t*)(lg + P5_KS + 272 + c * 2)) * br * __expf(decg[1])}; ab1 = (f32x2){0.f, 0.f}; } ab0 -= mq[0][0] * xy[0]; xy[1] = ab0 + ab1; up[128] = xy[1][0]; wp[128] = f2bf(-xy[1][1]); mq[0] = *(const LAS f32x4*)(Mg + 384);
            { const float br = betg[2]; ab0 = (f32x2){bf2f(*(const LAS bf16_t*)(lg + P5_VS + 544 + c * 2)) * br, bf2f(*(const LAS bf16_t*)(lg + P5_KS + 544 + c * 2)) * br * __expf(decg[2])}; ab1 = (f32x2){0.f, 0.f}; } ab0 -= mq[1][0] * xy[0]; ab1 -= mq[1][1] * xy[1]; xy[2] = ab0 + ab1; up[256] = xy[2][0]; wp[256] = f2bf(-xy[2][1]); mq[1] = *(const LAS f32x4*)(Mg + 388);
            { const float br = betg[3]; ab0 = (f32x2){bf2f(*(const LAS bf16_t*)(lg + P5_VS + 816 + c * 2)) * br, bf2f(*(const LAS bf16_t*)(lg + P5_KS + 816 + c * 2)) * br * __expf(decg[3])}; ab1 = (f32x2){0.f, 0.f}; } ab0 -= mq[2][0] * xy[0]; ab1 -= mq[2][1] * xy[1]; ab0 -= mq[2][2] * xy[2]; xy[3] = ab0 + ab1; up[384] = xy[3][0]; wp[384] = f2bf(-xy[3][1]); mq[2] = *(const LAS f32x4*)(Mg + 448);
            { const float br = betg[4]; ab0 = (f32x2){bf2f(*(const LAS bf16_t*)(lg + P5_VS + 1088 + c * 2)) * br, bf2f(*(const LAS bf16_t*)(lg + P5_KS + 1088 + c * 2)) * br * __expf(decg[4])}; ab1 = (f32x2){0.f, 0.f}; } ab0 -= mq[3][0] * xy[0]; ab1 -= mq[3][1] * xy[1]; ab0 -= mq[3][2] * xy[2]; ab1 -= mq[3][3] * xy[3]; xy[4] = ab0 + ab1; up[512] = xy[4][0]; wp[512] = f2bf(-xy[4][1]); mq[3] = *(const LAS f32x4*)(Mg + 452);
            { const float br = betg[5]; ab0 = (f32x2){bf2f(*(const LAS bf16_t*)(lg + P5_VS + 1360 + c * 2)) * br, bf2f(*(const LAS bf16_t*)(lg + P5_KS + 1360 + c * 2)) * br * __expf(decg[5])}; ab1 = (f32x2){0.f, 0.f}; } ab0 -= mq[4][0] * xy[0]; ab1 -= mq[4][1] * xy[1]; ab0 -= mq[4][2] * xy[2]; ab1 -= mq[4][3] * xy[3]; mq[4] = *(const LAS f32x4*)(Mg + 512);
            ab0 -= mq[5][0] * xy[4]; xy[5] = ab0 + ab1; up[640] = xy[5][0]; wp[640] = f2bf(-xy[5][1]); mq[5] = *(const LAS f32x4*)(Mg + 516);
            { const float br = betg[6]; ab0 = (f32x2){bf2f(*(const LAS bf16_t*)(lg + P5_VS + 1632 + c * 2)) * br, bf2f(*(const LAS bf16_t*)(lg + P5_KS + 1632 + c * 2)) * br * __expf(decg[6])}; ab1 = (f32x2){0.f, 0.f}; } ab0 -= mq[0][0] * xy[0]; ab1 -= mq[0][1] * xy[1]; ab0 -= mq[0][2] * xy[2]; ab1 -= mq[0][3] * xy[3]; mq[0] = *(const LAS f32x4*)(Mg + 576);
            ab0 -= mq[1][0] * xy[4]; ab1 -= mq[1][1] * xy[5]; xy[6] = ab0 + ab1; up[768] = xy[6][0]; wp[768] = f2bf(-xy[6][1]); mq[1] = *(const LAS f32x4*)(Mg + 580);
            { const float br = betg[7]; ab0 = (f32x2){bf2f(*(const LAS bf16_t*)(lg + P5_VS + 1904 + c * 2)) * br, bf2f(*(const LAS bf16_t*)(lg + P5_KS + 1904 + c * 2)) * br * __expf(decg[7])}; ab1 = (f32x2){0.f, 0.f}; } ab0 -= mq[2][0] * xy[0]; ab1 -= mq[2][1] * xy[1]; ab0 -= mq[2][2] * xy[2]; ab1 -= mq[2][3] * xy[3]; mq[2] = *(const LAS f32x4*)(Mg + 584);
            ab0 -= mq[3][0] * xy[4]; ab1 -= mq[3][1] * xy[5]; ab0 -= mq[3][2] * xy[6]; xy[7] = ab0 + ab1; up[896] = xy[7][0]; wp[896] = f2bf(-xy[7][1]); mq[3] = *(const LAS f32x4*)(Mg + 640);
            { const float br = betg[8]; ab0 = (f32x2){bf2f(*(const LAS bf16_t*)(lg + P5_VS + 2176 + c * 2)) * br, bf2f(*(const LAS bf16_t*)(lg + P5_KS + 2176 + c * 2)) * br * __expf(decg[8])}; ab1 = (f32x2){0.f, 0.f}; } ab0 -= mq[4][0] * xy[0]; ab1 -= mq[4][1] * xy[1]; ab0 -= mq[4][2] * xy[2]; ab1 -= mq[4][3] * xy[3]; mq[4] = *(const LAS f32x4*)(Mg + 644);
            ab0 -= mq[5][0] * xy[4]; ab1 -= mq[5][1] * xy[5]; ab0 -= mq[5][2] * xy[6]; ab1 -= mq[5][3] * xy[7]; xy[8] = ab0 + ab1; up[1024] = xy[8][0]; wp[1024] = f2bf(-xy[8][1]); mq[5] = *(const LAS f32x4*)(Mg + 648);
            { const float br = betg[9]; ab0 = (f32x2){bf2f(*(const LAS bf16_t*)(lg + P5_VS + 2448 + c * 2)) * br, bf2f(*(const LAS bf16_t*)(lg + P5_KS + 2448 + c * 2)) * br * __expf(decg[9])}; ab1 = (f32x2){0.f, 0.f}; } ab0 -= mq[0][0] * xy[0]; ab1 -= mq[0][1] * xy[1]; ab0 -= mq[0][2] * xy[2]; ab1 -= mq[0][3] * xy[3]; mq[0] = *(const LAS f32x4*)(Mg + 704);
            ab0 -= mq[1][0] * xy[4]; ab1 -= mq[1][1] * xy[5]; ab0 -= mq[1][2] * xy[6]; ab1 -= mq[1][3] * xy[7]; mq[1] = *(const LAS f32x4*)(Mg + 708);
            ab0 -= mq[2][0] * xy[8]; xy[9] = ab0 + ab1; up[1152] = xy[9][0]; wp[1152] = f2bf(-xy[9][1]); mq[2] = *(const LAS f32x4*)(Mg + 712);
            { const float br = betg[10]; ab0 = (f32x2){bf2f(*(const LAS bf16_t*)(lg + P5_VS + 2720 + c * 2)) * br, bf2f(*(const LAS bf16_t*)(lg + P5_KS + 2720 + c * 2)) * br * __expf(decg[10])}; ab1 = (f32x2){0.f, 0.f}; } ab0 -= mq[3][0] * xy[0]; ab1 -= mq[3][1] * xy[1]; ab0 -= mq[3][2] * xy[2]; ab1 -= mq[3][3] * xy[3]; mq[3] = *(const LAS f32x4*)(Mg + 768);
            ab0 -= mq[4][0] * xy[4]; ab1 -= mq[4][1] * xy[5]; ab0 -= mq[4][2] * xy[6]; ab1 -= mq[4][3] * xy[7]; mq[4] = *(const LAS f32x4*)(Mg + 772);
            ab0 -= mq[5][0] * xy[8]; ab1 -= mq[5][1] * xy[9]; xy[10] = ab0 + ab1; up[1280] = xy[10][0]; wp[1280] = f2bf(-xy[10][1]); mq[5] = *(const LAS f32x4*)(Mg + 776);
            { const float br = betg[11]; ab0 = (f32x2){bf2f(*(const LAS bf16_t*)(lg + P5_VS + 2992 + c * 2)) * br, bf2f(*(const LAS bf16_t*)(lg + P5_KS + 2992 + c * 2)) * br * __expf(decg[11])}; ab1 = (f32x2){0.f, 0.f}; } ab0 -= mq[0][0] * xy[0]; ab1 -= mq[0][1] * xy[1]; ab0 -= mq[0][2] * xy[2]; ab1 -= mq[0][3] * xy[3]; mq[0] = *(const LAS f32x4*)(Mg + 832);
            ab0 -= mq[1][0] * xy[4]; ab1 -= mq[1][1] * xy[5]; ab0 -= mq[1][2] * xy[6]; ab1 -= mq[1][3] * xy[7]; mq[1] = *(const LAS f32x4*)(Mg + 836);
            ab0 -= mq[2][0] * xy[8]; ab1 -= mq[2][1] * xy[9]; ab0 -= mq[2][2] * xy[10]; xy[11] = ab0 + ab1; up[1408] = xy[11][0]; wp[1408] = f2bf(-xy[11][1]); mq[2] = *(const LAS f32x4*)(Mg + 840);
            { const float br = betg[12]; ab0 = (f32x2){bf2f(*(const LAS bf16_t*)(lg + P5_VS + 3264 + c * 2)) * br, bf2f(*(const LAS bf16_t*)(lg + P5_KS + 3264 + c * 2)) * br * __expf(decg[12])}; ab1 = (f32x2){0.f, 0.f}; } ab0 -= mq[3][0] * xy[0]; ab1 -= mq[3][1] * xy[1]; ab0 -= mq[3][2] * xy[2]; ab1 -= mq[3][3] * xy[3]; mq[3] = *(const LAS f32x4*)(Mg + 844);
            ab0 -= mq[4][0] * xy[4]; ab1 -= mq[4][1] * xy[5]; ab0 -= mq[4][2] * xy[6]; ab1 -= mq[4][3] * xy[7]; mq[4] = *(const LAS f32x4*)(Mg + 896);
            ab0 -= mq[5][0] * xy[8]; ab1 -= mq[5][1] * xy[9]; ab0 -= mq[5][2] * xy[10]; ab1 -= mq[5][3] * xy[11]; xy[12] = ab0 + ab1; up[1536] = xy[12][0]; wp[1536] = f2bf(-xy[12][1]); mq[5] = *(const LAS f32x4*)(Mg + 900);
            { const float br = betg[13]; ab0 = (f32x2){bf2f(*(const LAS bf16_t*)(lg + P5_VS + 3536 + c * 2)) * br, bf2f(*(const LAS bf16_t*)(lg + P5_KS + 3536 + c * 2)) * br * __expf(decg[13])}; ab1 = (f32x2){0.f, 0.f}; } ab0 -= mq[0][0] * xy[0]; ab1 -= mq[0][1] * xy[1]; ab0 -= mq[0][2] * xy[2]; ab1 -= mq[0][3] * xy[3]; mq[0] = *(const LAS f32x4*)(Mg + 904);
            ab0 -= mq[1][0] * xy[4]; ab1 -= mq[1][1] * xy[5]; ab0 -= mq[1][2] * xy[6]; ab1 -= mq[1][3] * xy[7]; mq[1] = *(const LAS f32x4*)(Mg + 908);
            ab0 -= mq[2][0] * xy[8]; ab1 -= mq[2][1] * xy[9]; ab0 -= mq[2][2] * xy[10]; ab1 -= mq[2][3] * xy[11]; mq[2] = *(const LAS f32x4*)(Mg + 960);
            ab0 -= mq[3][0] * xy[12]; xy[13] = ab0 + ab1; up[1664] = xy[13][0]; wp[1664] = f2bf(-xy[13][1]); mq[3] = *(const LAS f32x4*)(Mg + 964);
            { const float br = betg[14]; ab0 = (f32x2){bf2f(*(const LAS bf16_t*)(lg + P5_VS + 3808 + c * 2)) * br, bf2f(*(const LAS bf16_t*)(lg + P5_KS + 3808 + c * 2)) * br * __expf(decg[14])}; ab1 = (f32x2){0.f, 0.f}; } ab0 -= mq[4][0] * xy[0]; ab1 -= mq[4][1] * xy[1]; ab0 -= mq[4][2] * xy[2]; ab1 -= mq[4][3] * xy[3]; mq[4] = *(const LAS f32x4*)(Mg + 968);
            ab0 -= mq[5][0] * xy[4]; ab1 -= mq[5][1] * xy[5]; ab0 -= mq[5][2] * xy[6]; ab1 -= mq[5][3] * xy[7]; mq[5] = *(const LAS f32x4*)(Mg + 972);
            ab0 -= mq[0][0] * xy[8]; ab1 -= mq[0][1] * xy[9]; ab0 -= mq[0][2] * xy[10]; ab1 -= mq[0][3] * xy[11]; mq[0] = *(const LAS f32x4*)(Mg + 1024);
            ab0 -= mq[1][0] * xy[12]; ab1 -= mq[1][1] * xy[13]; xy[14] = ab0 + ab1; up[1792] = xy[14][0]; wp[1792] = f2bf(-xy[14][1]); mq[1] = *(const LAS f32x4*)(Mg + 1028);
            { const float br = betg[15]; ab0 = (f32x2){bf2f(*(const LAS bf16_t*)(lg + P5_VS + 4080 + c * 2)) * br, bf2f(*(const LAS bf16_t*)(lg + P5_KS + 4080 + c * 2)) * br * __expf(decg[15])}; ab1 = (f32x2){0.f, 0.f}; } ab0 -= mq[2][0] * xy[0]; ab1 -= mq[2][1] * xy[1]; ab0 -= mq[2][2] * xy[2]; ab1 -= mq[2][3] * xy[3]; mq[2] = *(const LAS f32x4*)(Mg + 1032);
            ab0 -= mq[3][0] * xy[4]; ab1 -= mq[3][1] * xy[5]; ab0 -= mq[3][2] * xy[6]; ab1 -= mq[3][3] * xy[7]; mq[3] = *(const LAS f32x4*)(Mg + 1036);
            ab0 -= mq[4][0] * xy[8]; ab1 -= mq[4][1] * xy[9]; ab0 -= mq[4][2] * xy[10]; ab1 -= mq[4][3] * xy[11]; mq[4] = *(const LAS f32x4*)(Mg + 1088);
            ab0 -= mq[5][0] * xy[12]; ab1 -= mq[5][1] * xy[13]; ab0 -= mq[5][2] * xy[14]; xy[15] = ab0 + ab1; up[1920] = xy[15][0]; wp[1920] = f2bf(-xy[15][1]); mq[5] = *(const LAS f32x4*)(Mg + 1092);
            { const float br = betg[16]; ab0 = (f32x2){bf2f(*(const LAS bf16_t*)(lg + P5_VS + 4352 + c * 2)) * br, bf2f(*(const LAS bf16_t*)(lg + P5_KS + 4352 + c * 2)) * br * __expf(decg[16])}; ab1 = (f32x2){0.f, 0.f}; } ab0 -= mq[0][0] * xy[0]; ab1 -= mq[0][1] * xy[1]; ab0 -= mq[0][2] * xy[2]; ab1 -= mq[0][3] * xy[3]; mq[0] = *(const LAS f32x4*)(Mg + 1096);
            ab0 -= mq[1][0] * xy[4]; ab1 -= mq[1][1] * xy[5]; ab0 -= mq[1][2] * xy[6]; ab1 -= mq[1][3] * xy[7]; mq[1] = *(const LAS f32x4*)(Mg + 1100);
            ab0 -= mq[2][0] * xy[8]; ab1 -= mq[2][1] * xy[9]; ab0 -= mq[2][2] * xy[10]; ab1 -= mq[2][3] * xy[11]; mq[2] = *(const LAS f32x4*)(Mg + 1104);
            ab0 -= mq[3][0] * xy[12]; ab1 -= mq[3][1] * xy[13]; ab0 -= mq[3][2] * xy[14]; ab1 -= mq[3][3] * xy[15]; xy[16] = ab0 + ab1; up[2048] = xy[16][0]; wp[2048] = f2bf(-xy[16][1]); mq[3] = *(const LAS f32x4*)(Mg + 1152);
            { const float br = betg[17]; ab0 = (f32x2){bf2f(*(const LAS bf16_t*)(lg + P5_VS + 4624 + c * 2)) * br, bf2f(*(const LAS bf16_t*)(lg + P5_KS + 4624 + c * 2)) * br * __expf(decg[17])}; ab1 = (f32x2){0.f, 0.f}; } ab0 -= mq[4][0] * xy[0]; ab1 -= mq[4][1] * xy[1]; ab0 -= mq[4][2] * xy[2]; ab1 -= mq[4][3] * xy[3]; mq[4] = *(const LAS f32x4*)(Mg + 1156);
            ab0 -= mq[5][0] * xy[4]; ab1 -= mq[5][1] * xy[5]; ab0 -= mq[5][2] * xy[6]; ab1 -= mq[5][3] * xy[7]; mq[5] = *(const LAS f32x4*)(Mg + 1160);
            ab0 -= mq[0][0] * xy[8]; ab1 -= mq[0][1] * xy[9]; ab0 -= mq[0][2] * xy[10]; ab1 -= mq[0][3] * xy[11]; mq[0] = *(const LAS f32x4*)(Mg + 1164);
            ab0 -= mq[1][0] * xy[12]; ab1 -= mq[1][1] * xy[13]; ab0 -= mq[1][2] * xy[14]; ab1 -= mq[1][3] * xy[15]; mq[1] = *(const LAS f32x4*)(Mg + 1168);
            ab0 -= mq[2][0] * xy[16]; xy[17] = ab0 + ab1; up[2176] = xy[17][0]; wp[2176] = f2bf(-xy[17][1]); mq[2] = *(const LAS f32x4*)(Mg + 1216);
            { const float br = betg[18]; ab0 = (f32x2){bf2f(*(const LAS bf16_t*)(lg + P5_VS + 4896 + c * 2)) * br, bf2f(*(const LAS bf16_t*)(lg + P5_KS + 4896 + c * 2)) * br * __expf(decg[18])}; ab1 = (f32x2){0.f, 0.f}; } ab0 -= mq[3][0] * xy[0]; ab1 -= mq[3][1] * xy[1]; ab0 -= mq[3][2] * xy[2]; ab1 -= mq[3][3] * xy[3]; mq[3] = *(const LAS f32x4*)(Mg + 1220);
            ab0 -= mq[4][0] * xy[4]; ab1 -= mq[4][1] * xy[5]; ab0 -= mq[4][2] * xy[6]; ab1 -= mq[4][3] * xy[7]; mq[4] = *(const LAS f32x4*)(Mg + 1224);
            ab0 -= mq[5][0] * xy[8]; ab1 -= mq[5][1] * xy[9]; ab0 -= mq[5][2] * xy[10]; ab1 -= mq[5][3] * xy[11]; mq[5] = *(const LAS f32x4*)(Mg + 1228);
            ab0 -= mq[0][0] * xy[12]; ab1 -= mq[0][1] * xy[13]; ab0 -= mq[0][2] * xy[14]; ab1 -= mq[0][3] * xy[15]; mq[0] = *(const LAS f32x4*)(Mg + 1232);
            ab0 -= mq[1][0] * xy[16]; ab1 -= mq[1][1] * xy[17]; xy[18] = ab0 + ab1; up[2304] = xy[18][0]; wp[2304] = f2bf(-xy[18][1]); mq[1] = *(const LAS f32x4*)(Mg + 1280);
            { const float br = betg[19]; ab0 = (f32x2){bf2f(*(const LAS bf16_t*)(lg + P5_VS + 5168 + c * 2)) * br, bf2f(*(const LAS bf16_t*)(lg + P5_KS + 5168 + c * 2)) * br * __expf(decg[19])}; ab1 = (f32x2){0.f, 0.f}; } ab0 -= mq[2][0] * xy[0]; ab1 -= mq[2][1] * xy[1]; ab0 -= mq[2][2] * xy[2]; ab1 -= mq[2][3] * xy[3]; mq[2] = *(const LAS f32x4*)(Mg + 1284);
            ab0 -= mq[3][0] * xy[4]; ab1 -= mq[3][1] * xy[5]; ab0 -= mq[3][2] * xy[6]; ab1 -= mq[3][3] * xy[7]; mq[3] = *(const LAS f32x4*)(Mg + 1288);
            ab0 -= mq[4][0] * xy[8]; ab1 -= mq[4][1] * xy[9]; ab0 -= mq[4][2] * xy[10]; ab1 -= mq[4][3] * xy[11]; mq[4] = *(const LAS f32x4*)(Mg + 1292);
            ab0 -= mq[5][0] * xy[12]; ab1 -= mq[5][1] * xy[13]; ab0 -= mq[5][2] * xy[14]; ab1 -= mq[5][3] * xy[15]; mq[5] = *(const LAS f32x4*)(Mg + 1296);
            ab0 -= mq[0][0] * xy[16]; ab1 -= mq[0][1] * xy[17]; ab0 -= mq[0][2] * xy[18]; xy[19] = ab0 + ab1; up[2432] = xy[19][0]; wp[2432] = f2bf(-xy[19][1]); mq[0] = *(const LAS f32x4*)(Mg + 1344);
            { const float br = betg[20]; ab0 = (f32x2){bf2f(*(const LAS bf16_t*)(lg + P5_VS + 5440 + c * 2)) * br, bf2f(*(const LAS bf16_t*)(lg + P5_KS + 5440 + c * 2)) * br * __expf(decg[20])}; ab1 = (f32x2){0.f, 0.f}; } ab0 -= mq[1][0] * xy[0]; ab1 -= mq[1][1] * xy[1]; ab0 -= mq[1][2] * xy[2]; ab1 -= mq[1][3] * xy[3]; mq[1] = *(const LAS f32x4*)(Mg + 1348);
            ab0 -= mq[2][0] * xy[4]; ab1 -= mq[2][1] * xy[5]; ab0 -= mq[2][2] * xy[6]; ab1 -= mq[2][3] * xy[7]; mq[2] = *(const LAS f32x4*)(Mg + 1352);
            ab0 -= mq[3][0] * xy[8]; ab1 -= mq[3][1] * xy[9]; ab0 -= mq[3][2] * xy[10]; ab1 -= mq[3][3] * xy[11]; mq[3] = *(const LAS f32x4*)(Mg + 1356);
            ab0 -= mq[4][0] * xy[12]; ab1 -= mq[4][1] * xy[13]; ab0 -= mq[4][2] * xy[14]; ab1 -= mq[4][3] * xy[15]; mq[4] = *(const LAS f32x4*)(Mg + 1360);
            ab0 -= mq[5][0] * xy[16]; ab1 -= mq[5][1] * xy[17]; ab0 -= mq[5][2] * xy[18]; ab1 -= mq[5][3] * xy[19]; xy[20] = ab0 + ab1; up[2560] = xy[20][0]; wp[2560] = f2bf(-xy[20][1]); mq[5] = *(const LAS f32x4*)(Mg + 1364);
            { const float br = betg[21]; ab0 = (f32x2){bf2f(*(const LAS bf16_t*)(lg + P5_VS + 5712 + c * 2)) * br, bf2f(*(const LAS bf16_t*)(lg + P5_KS + 5712 + c * 2)) * br * __expf(decg[21])}; ab1 = (f32x2){0.f, 0.f}; } ab0 -= mq[0][0] * xy[0]; ab1 -= mq[0][1] * xy[1]; ab0 -= mq[0][2] * xy[2]; ab1 -= mq[0][3] * xy[3]; mq[0] = *(const LAS f32x4*)(Mg + 1408);
            ab0 -= mq[1][0] * xy[4]; ab1 -= mq[1][1] * xy[5]; ab0 -= mq[1][2] * xy[6]; ab1 -= mq[1][3] * xy[7]; mq[1] = *(const LAS f32x4*)(Mg + 1412);
            ab0 -= mq[2][0] * xy[8]; ab1 -= mq[2][1] * xy[9]; ab0 -= mq[2][2] * xy[10]; ab1 -= mq[2][3] * xy[11]; mq[2] = *(const LAS f32x4*)(Mg + 1416);
            ab0 -= mq[3][0] * xy[12]; ab1 -= mq[3][1] * xy[13]; ab0 -= mq[3][2] * xy[14]; ab1 -= mq[3][3] * xy[15]; mq[3] = *(const LAS f32x4*)(Mg + 1420);
            ab0 -= mq[4][0] * xy[16]; ab1 -= mq[4][1] * xy[17]; ab0 -= mq[4][2] * xy[18]; ab1 -= mq[4][3] * xy[19]; mq[4] = *(const LAS f32x4*)(Mg + 1424);
            ab0 -= mq[5][0] * xy[20]; xy[21] = ab0 + ab1; up[2688] = xy[21][0]; wp[2688] = f2bf(-xy[21][1]); mq[5] = *(const LAS f32x4*)(Mg + 1428);
            { const float br = betg[22]; ab0 = (f32x2){bf2f(*(const LAS bf16_t*)(lg + P5_VS + 5984 + c * 2)) * br, bf2f(*(const LAS bf16_t*)(lg + P5_KS + 5984 + c * 2)) * br * __expf(decg[22])}; ab1 = (f32x2){0.f, 0.f}; } ab0 -= mq[0][0] * xy[0]; ab1 -= mq[0][1] * xy[1]; ab0 -= mq[0][2] * xy[2]; ab1 -= mq[0][3] * xy[3]; mq[0] = *(const LAS f32x4*)(Mg + 1472);
            ab0 -= mq[1][0] * xy[4]; ab1 -= mq[1][1] * xy[5]; ab0 -= mq[1][2] * xy[6]; ab1 -= mq[1][3] * xy[7]; mq[1] = *(const LAS f32x4*)(Mg + 1476);
            ab0 -= mq[2][0] * xy[8]; ab1 -= mq[2][1] * xy[9]; ab0 -= mq[2][2] * xy[10]; ab1 -= mq[2][3] * xy[11]; mq[2] = *(const LAS f32x4*)(Mg + 1480);
            ab0 -= mq[3][0] * xy[12]; ab1 -= mq[3][1] * xy[13]; ab0 -= mq[3][2] * xy[14]; ab1 -= mq[3][3] * xy[15]; mq[3] = *(const LAS f32x4*)(Mg + 1484);
            ab0 -= mq[4][0] * xy[16]; ab1 -= mq[4][1] * xy[17]; ab0 -= mq[4][2] * xy[18]; ab1 -= mq[4][3] * xy[19]; mq[4] = *(const LAS f32x4*)(Mg + 1488);
            ab0 -= mq[5][0] * xy[20]; ab1 -= mq[5][1] * xy[21]; xy[22] = ab0 + ab1; up[2816] = xy[22][0]; wp[2816] = f2bf(-xy[22][1]); mq[5] = *(const LAS f32x4*)(Mg + 1492);
            { const float br = betg[23]; ab0 = (f32x2){bf2f(*(const LAS bf16_t*)(lg + P5_VS + 6256 + c * 2)) * br, bf2f(*(const LAS bf16_t*)(lg + P5_KS + 6256 + c * 2)) * br * __expf(decg[23])}; ab1 = (f32x2){0.f, 0.f}; } ab0 -= mq[0][0] * xy[0]; ab1 -= mq[0][1] * xy[1]; ab0 -= mq[0][2] * xy[2]; ab1 -= mq[0][3] * xy[3]; mq[0] = *(const LAS f32x4*)(Mg + 1536);
            ab0 -= mq[1][0] * xy[4]; ab1 -= mq[1][1] * xy[5]; ab0 -= mq[1][2] * xy[6]; ab1 -= mq[1][3] * xy[7]; mq[1] = *(const LAS f32x4*)(Mg + 1540);
            ab0 -= mq[2][0] * xy[8]; ab1 -= mq[2][1] * xy[9]; ab0 -= mq[2][2] * xy[10]; ab1 -= mq[2][3] * xy[11]; mq[2] = *(const LAS f32x4*)(Mg + 1544);
            ab0 -= mq[3][0] * xy[12]; ab1 -= mq[3][1] * xy[13]; ab0 -= mq[3][2] * xy[14]; ab1 -= mq[3][3] * xy[15]; mq[3] = *(const LAS f32x4*)(Mg + 1548);
            ab0 -= mq[4][0] * xy[16]; ab1 -= mq[4][1] * xy[17]; ab0 -= mq[4][2] * xy[18]; ab1 -= mq[4][3] * xy[19]; mq[4] = *(const LAS f32x4*)(Mg + 1552);
            ab0 -= mq[5][0] * xy[20]; ab1 -= mq[5][1] * xy[21]; ab0 -= mq[5][2] * xy[22]; xy[23] = ab0 + ab1; up[2944] = xy[23][0]; wp[2944] = f2bf(-xy[23][1]); mq[5] = *(const LAS f32x4*)(Mg + 1556);
            { const float br = betg[24]; ab0 = (f32x2){bf2f(*(const LAS bf16_t*)(lg + P5_VS + 6528 + c * 2)) * br, bf2f(*(const LAS bf16_t*)(lg + P5_KS + 6528 + c * 2)) * br * __expf(decg[24])}; ab1 = (f32x2){0.f, 0.f}; } ab0 -= mq[0][0] * xy[0]; ab1 -= mq[0][1] * xy[1]; ab0 -= mq[0][2] * xy[2]; ab1 -= mq[0][3] * xy[3]; mq[0] = *(const LAS f32x4*)(Mg + 1600);
            ab0 -= mq[1][0] * xy[4]; ab1 -= mq[1][1] * xy[5]; ab0 -= mq[1][2] * xy[6]; ab1 -= mq[1][3] * xy[7]; mq[1] = *(const LAS f32x4*)(Mg + 1604);
            ab0 -= mq[2][0] * xy[8]; ab1 -= mq[2][1] * xy[9]; ab0 -= mq[2][2] * xy[10]; ab1 -= mq[2][3] * xy[11]; mq[2] = *(const LAS f32x4*)(Mg + 1608);
            ab0 -= mq[3][0] * xy[12]; ab1 -= mq[3][1] * xy[13]; ab0 -= mq[3][2] * xy[14]; ab1 -= mq[3][3] * xy[15]; mq[3] = *(const LAS f32x4*)(Mg + 1612);
            ab0 -= mq[4][0] * xy[16]; ab1 -= mq[4][1] * xy[17]; ab0 -= mq[4][2] * xy[18]; ab1 -= mq[4][3] * xy[19]; mq[4] = *(const LAS f32x4*)(Mg + 1616);
            ab0 -= mq[5][0] * xy[20]; ab1 -= mq[5][1] * xy[21]; ab0 -= mq[5][2] * xy[22]; ab1 -= mq[5][3] * xy[23]; xy[24] = ab0 + ab1; up[3072] = xy[24][0]; wp[3072] = f2bf(-xy[24][1]); mq[5] = *(const LAS f32x4*)(Mg + 1620);
            { const float br = betg[25]; ab0 = (f32x2){bf2f(*(const LAS bf16_t*)(lg + P5_VS + 6800 + c * 2)) * br, bf2f(*(const LAS bf16_t*)(lg + P5_KS + 6800 + c * 2)) * br * __expf(decg[25])}; ab1 = (f32x2){0.f, 0.f}; } ab0 -= mq[0][0] * xy[0]; ab1 -= mq[0][1] * xy[1]; ab0 -= mq[0][2] * xy[2]; ab1 -= mq[0][3] * xy[3]; mq[0] = *(const LAS f32x4*)(Mg + 1624);
            ab0 -= mq[1][0] * xy[4]; ab1 -= mq[1][1] * xy[5]; ab0 -= mq[1][2] * xy[6]; ab1 -= mq[1][3] * xy[7]; mq[1] = *(const LAS f32x4*)(Mg + 1664);
            ab0 -= mq[2][0] * xy[8]; ab1 -= mq[2][1] * xy[9]; ab0 -= mq[2][2] * xy[10]; ab1 -= mq[2][3] * xy[11]; mq[2] = *(const LAS f32x4*)(Mg + 1668);
            ab0 -= mq[3][0] * xy[12]; ab1 -= mq[3][1] * xy[13]; ab0 -= mq[3][2] * xy[14]; ab1 -= mq[3][3] * xy[15]; mq[3] = *(const LAS f32x4*)(Mg + 1672);
            ab0 -= mq[4][0] * xy[16]; ab1 -= mq[4][1] * xy[17]; ab0 -= mq[4][2] * xy[18]; ab1 -= mq[4][3] * xy[19]; mq[4] = *(const LAS f32x4*)(Mg + 1676);
            ab0 -= mq[5][0] * xy[20]; ab1 -= mq[5][1] * xy[21]; ab0 -= mq[5][2] * xy[22]; ab1 -= mq[5][3] * xy[23]; mq[5] = *(const LAS f32x4*)(Mg + 1680);
            ab0 -= mq[0][0] * xy[24]; xy[25] = ab0 + ab1; up[3200] = xy[25][0]; wp[3200] = f2bf(-xy[25][1]); mq[0] = *(const LAS f32x4*)(Mg + 1684);
            { const float br = betg[26]; ab0 = (f32x2){bf2f(*(const LAS bf16_t*)(lg + P5_VS + 7072 + c * 2)) * br, bf2f(*(const LAS bf16_t*)(lg + P5_KS + 7072 + c * 2)) * br * __expf(decg[26])}; ab1 = (f32x2){0.f, 0.f}; } ab0 -= mq[1][0] * xy[0]; ab1 -= mq[1][1] * xy[1]; ab0 -= mq[1][2] * xy[2]; ab1 -= mq[1][3] * xy[3]; mq[1] = *(const LAS f32x4*)(Mg + 1688);
            ab0 -= mq[2][0] * xy[4]; ab1 -= mq[2][1] * xy[5]; ab0 -= mq[2][2] * xy[6]; ab1 -= mq[2][3] * xy[7]; mq[2] = *(const LAS f32x4*)(Mg + 1728);
            ab0 -= mq[3][0] * xy[8]; ab1 -= mq[3][1] * xy[9]; ab0 -= mq[3][2] * xy[10]; ab1 -= mq[3][3] * xy[11]; mq[3] = *(const LAS f32x4*)(Mg + 1732);
            ab0 -= mq[4][0] * xy[12]; ab1 -= mq[4][1] * xy[13]; ab0 -= mq[4][2] * xy[14]; ab1 -= mq[4][3] * xy[15]; mq[4] = *(const LAS f32x4*)(Mg + 1736);
            ab0 -= mq[5][0] * xy[16]; ab1 -= mq[5][1] * xy[17]; ab0 -= mq[5][2] * xy[18]; ab1 -= mq[5][3] * xy[19]; mq[5] = *(const LAS f32x4*)(Mg + 1740);
            ab0 -= mq[0][0] * xy[20]; ab1 -= mq[0][1] * xy[21]; ab0 -= mq[0][2] * xy[22]; ab1 -= mq[0][3] * xy[23]; mq[0] = *(const LAS f32x4*)(Mg + 1744);
            ab0 -= mq[1][0] * xy[24]; ab1 -= mq[1][1] * xy[25]; xy[26] = ab0 + ab1; up[3328] = xy[26][0]; wp[3328] = f2bf(-xy[26][1]); mq[1] = *(const LAS f32x4*)(Mg + 1748);
            { const float br = betg[27]; ab0 = (f32x2){bf2f(*(const LAS bf16_t*)(lg + P5_VS + 7344 + c * 2)) * br, bf2f(*(const LAS bf16_t*)(lg + P5_KS + 7344 + c * 2)) * br * __expf(decg[27])}; ab1 = (f32x2){0.f, 0.f}; } ab0 -= mq[2][0] * xy[0]; ab1 -= mq[2][1] * xy[1]; ab0 -= mq[2][2] * xy[2]; ab1 -= mq[2][3] * xy[3]; mq[2] = *(const LAS f32x4*)(Mg + 1752);
            ab0 -= mq[3][0] * xy[4]; ab1 -= mq[3][1] * xy[5]; ab0 -= mq[3][2] * xy[6]; ab1 -= mq[3][3] * xy[7]; mq[3] = *(const LAS f32x4*)(Mg + 1792);
            ab0 -= mq[4][0] * xy[8]; ab1 -= mq[4][1] * xy[9]; ab0 -= mq[4][2] * xy[10]; ab1 -= mq[4][3] * xy[11]; mq[4] = *(const LAS f32x4*)(Mg + 1796);
            ab0 -= mq[5][0] * xy[12]; ab1 -= mq[5][1] * xy[13]; ab0 -= mq[5][2] * xy[14]; ab1 -= mq[5][3] * xy[15]; mq[5] = *(const LAS f32x4*)(Mg + 1800);
            ab0 -= mq[0][0] * xy[16]; ab1 -= mq[0][1] * xy[17]; ab0 -= mq[0][2] * xy[18]; ab1 -= mq[0][3] * xy[19]; mq[0] = *(const LAS f32x4*)(Mg + 1804);
            ab0 -= mq[1][0] * xy[20]; ab1 -= mq[1][1] * xy[21]; ab0 -= mq[1][2] * xy[22]; ab1 -= mq[1][3] * xy[23]; mq[1] = *(const LAS f32x4*)(Mg + 1808);
            ab0 -= mq[2][0] * xy[24]; ab1 -= mq[2][1] * xy[25]; ab0 -= mq[2][2] * xy[26]; xy[27] = ab0 + ab1; up[3456] = xy[27][0]; wp[3456] = f2bf(-xy[27][1]); mq[2] = *(const LAS f32x4*)(Mg + 1812);
            { const float br = betg[28]; ab0 = (f32x2){bf2f(*(const LAS bf16_t*)(lg + P5_VS + 7616 + c * 2)) * br, bf2f(*(const LAS bf16_t*)(lg + P5_KS + 7616 + c * 2)) * br * __expf(decg[28])}; ab1 = (f32x2){0.f, 0.f}; } ab0 -= mq[3][0] * xy[0]; ab1 -= mq[3][1] * xy[1]; ab0 -= mq[3][2] * xy[2]; ab1 -= mq[3][3] * xy[3]; mq[3] = *(const LAS f32x4*)(Mg + 1816);
            ab0 -= mq[4][0] * xy[4]; ab1 -= mq[4][1] * xy[5]; ab0 -= mq[4][2] * xy[6]; ab1 -= mq[4][3] * xy[7]; mq[4] = *(const LAS f32x4*)(Mg + 1856);
            ab0 -= mq[5][0] * xy[8]; ab1 -= mq[5][1] * xy[9]; ab0 -= mq[5][2] * xy[10]; ab1 -= mq[5][3] * xy[11]; mq[5] = *(const LAS f32x4*)(Mg + 1860);
            ab0 -= mq[0][0] * xy[12]; ab1 -= mq[0][1] * xy[13]; ab0 -= mq[0][2] * xy[14]; ab1 -= mq[0][3] * xy[15]; mq[0] = *(const LAS f32x4*)(Mg + 1864);
            ab0 -= mq[1][0] * xy[16]; ab1 -= mq[1][1] * xy[17]; ab0 -= mq[1][2] * xy[18]; ab1 -= mq[1][3] * xy[19]; mq[1] = *(const LAS f32x4*)(Mg + 1868);
            ab0 -= mq[2][0] * xy[20]; ab1 -= mq[2][1] * xy[21]; ab0 -= mq[2][2] * xy[22]; ab1 -= mq[2][3] * xy[23]; mq[2] = *(const LAS f32x4*)(Mg + 1872);
            ab0 -= mq[3][0] * xy[24]; ab1 -= mq[3][1] * xy[25]; ab0 -= mq[3][2] * xy[26]; ab1 -= mq[3][3] * xy[27]; xy[28] = ab0 + ab1; up[3584] = xy[28][0]; wp[3584] = f2bf(-xy[28][1]); mq[3] = *(const LAS f32x4*)(Mg + 1876);
            { const float br = betg[29]; ab0 = (f32x2){bf2f(*(const LAS bf16_t*)(lg + P5_VS + 7888 + c * 2)) * br, bf2f(*(const LAS bf16_t*)(lg + P5_KS + 7888 + c * 2)) * br * __expf(decg[29])}; ab1 = (f32x2){0.f, 0.f}; } ab0 -= mq[4][0] * xy[0]; ab1 -= mq[4][1] * xy[1]; ab0 -= mq[4][2] * xy[2]; ab1 -= mq[4][3] * xy[3]; mq[4] = *(const LAS f32x4*)(Mg + 1880);
            ab0 -= mq[5][0] * xy[4]; ab1 -= mq[5][1] * xy[5]; ab0 -= mq[5][2] * xy[6]; ab1 -= mq[5][3] * xy[7]; mq[5] = *(const LAS f32x4*)(Mg + 1884);
            ab0 -= mq[0][0] * xy[8]; ab1 -= mq[0][1] * xy[9]; ab0 -= mq[0][2] * xy[10]; ab1 -= mq[0][3] * xy[11]; mq[0] = *(const LAS f32x4*)(Mg + 1920);
            ab0 -= mq[1][0] * xy[12]; ab1 -= mq[1][1] * xy[13]; ab0 -= mq[1][2] * xy[14]; ab1 -= mq[1][3] * xy[15]; mq[1] = *(const LAS f32x4*)(Mg + 1924);
            ab0 -= mq[2][0] * xy[16]; ab1 -= mq[2][1] * xy[17]; ab0 -= mq[2][2] * xy[18]; ab1 -= mq[2][3] * xy[19]; mq[2] = *(const LAS f32x4*)(Mg + 1928);
            ab0 -= mq[3][0] * xy[20]; ab1 -= mq[3][1] * xy[21]; ab0 -= mq[3][2] * xy[22]; ab1 -= mq[3][3] * xy[23]; mq[3] = *(const LAS f32x4*)(Mg + 1932);
            ab0 -= mq[4][0] * xy[24]; ab1 -= mq[4][1] * xy[25]; ab0 -= mq[4][2] * xy[26]; ab1 -= mq[4][3] * xy[27]; mq[4] = *(const LAS f32x4*)(Mg + 1936);
            ab0 -= mq[5][0] * xy[28]; xy[29] = ab0 + ab1; up[3712] = xy[29][0]; wp[3712] = f2bf(-xy[29][1]); mq[5] = *(const LAS f32x4*)(Mg + 1940);
            { const float br = betg[30]; ab0 = (f32x2){bf2f(*(const LAS bf16_t*)(lg + P5_VS + 8160 + c * 2)) * br, bf2f(*(const LAS bf16_t*)(lg + P5_KS + 8160 + c * 2)) * br * __expf(decg[30])}; ab1 = (f32x2){0.f, 0.f}; } ab0 -= mq[0][0] * xy[0]; ab1 -= mq[0][1] * xy[1]; ab0 -= mq[0][2] * xy[2]; ab1 -= mq[0][3] * xy[3]; mq[0] = *(const LAS f32x4*)(Mg + 1944);
            ab0 -= mq[1][0] * xy[4]; ab1 -= mq[1][1] * xy[5]; ab0 -= mq[1][2] * xy[6]; ab1 -= mq[1][3] * xy[7]; mq[1] = *(const LAS f32x4*)(Mg + 1948);
            ab0 -= mq[2][0] * xy[8]; ab1 -= mq[2][1] * xy[9]; ab0 -= mq[2][2] * xy[10]; ab1 -= mq[2][3] * xy[11]; mq[2] = *(const LAS f32x4*)(Mg + 1984);
            ab0 -= mq[3][0] * xy[12]; ab1 -= mq[3][1] * xy[13]; ab0 -= mq[3][2] * xy[14]; ab1 -= mq[3][3] * xy[15]; mq[3] = *(const LAS f32x4*)(Mg + 1988);
            ab0 -= mq[4][0] * xy[16]; ab1 -= mq[4][1] * xy[17]; ab0 -= mq[4][2] * xy[18]; ab1 -= mq[4][3] * xy[19]; mq[4] = *(const LAS f32x4*)(Mg + 1992);
            ab0 -= mq[5][0] * xy[20]; ab1 -= mq[5][1] * xy[21]; ab0 -= mq[5][2] * xy[22]; ab1 -= mq[5][3] * xy[23]; mq[5] = *(const LAS f32x4*)(Mg + 1996);
            ab0 -= mq[0][0] * xy[24]; ab1 -= mq[0][1] * xy[25]; ab0 -= mq[0][2] * xy[26]; ab1 -= mq[0][3] * xy[27]; mq[0] = *(const LAS f32x4*)(Mg + 2000);
            ab0 -= mq[1][0] * xy[28]; ab1 -= mq[1][1] * xy[29]; xy[30] = ab0 + ab1; up[3840] = xy[30][0]; wp[3840] = f2bf(-xy[30][1]); mq[1] = *(const LAS f32x4*)(Mg + 2004);
            { const float br = betg[31]; ab0 = (f32x2){bf2f(*(const LAS bf16_t*)(lg + P5_VS + 8432 + c * 2)) * br, bf2f(*(const LAS bf16_t*)(lg + P5_KS + 8432 + c * 2)) * br * __expf(decg[31])}; ab1 = (f32x2){0.f, 0.f}; } ab0 -= mq[2][0] * xy[0]; ab1 -= mq[2][1] * xy[1]; ab0 -= mq[2][2] * xy[2]; ab1 -= mq[2][3] * xy[3]; mq[2] = *(const LAS f32x4*)(Mg + 2008);
            ab0 -= mq[3][0] * xy[4]; ab1 -= mq[3][1] * xy[5]; ab0 -= mq[3][2] * xy[6]; ab1 -= mq[3][3] * xy[7]; mq[3] = *(const LAS f32x4*)(Mg + 2012);
            ab0 -= mq[4][0] * xy[8]; ab1 -= mq[4][1] * xy[9]; ab0 -= mq[4][2] * xy[10]; ab1 -= mq[4][3] * xy[11]; mq[4] = *(const LAS f32x4*)(Mg + 2048);
            ab0 -= mq[5][0] * xy[12]; ab1 -= mq[5][1] * xy[13]; ab0 -= mq[5][2] * xy[14]; ab1 -= mq[5][3] * xy[15]; mq[5] = *(const LAS f32x4*)(Mg + 2052);
            ab0 -= mq[0][0] * xy[16]; ab1 -= mq[0][1] * xy[17]; ab0 -= mq[0][2] * xy[18]; ab1 -= mq[0][3] * xy[19]; mq[0] = *(const LAS f32x4*)(Mg + 2056);
            ab0 -= mq[1][0] * xy[20]; ab1 -= mq[1][1] * xy[21]; ab0 -= mq[1][2] * xy[22]; ab1 -= mq[1][3] * xy[23]; mq[1] = *(const LAS f32x4*)(Mg + 2060);
            ab0 -= mq[2][0] * xy[24]; ab1 -= mq[2][1] * xy[25]; ab0 -= mq[2][2] * xy[26]; ab1 -= mq[2][3] * xy[27]; mq[2] = *(const LAS f32x4*)(Mg + 2064);
            ab0 -= mq[3][0] * xy[28]; ab1 -= mq[3][1] * xy[29]; ab0 -= mq[3][2] * xy[30]; xy[31] = ab0 + ab1; up[3968] = xy[31][0]; wp[3968] = f2bf(-xy[31][1]); mq[3] = *(const LAS f32x4*)(Mg + 2068);
            { const float br = betg[32]; ab0 = (f32x2){bf2f(*(const LAS bf16_t*)(lg + P5_VS + 8704 + c * 2)) * br, bf2f(*(const LAS bf16_t*)(lg + P5_KS + 8704 + c * 2)) * br * __expf(decg[32])}; ab1 = (f32x2){0.f, 0.f}; } ab0 -= mq[4][0] * xy[0]; ab1 -= mq[4][1] * xy[1]; ab0 -= mq[4][2] * xy[2]; ab1 -= mq[4][3] * xy[3]; mq[4] = *(const LAS f32x4*)(Mg + 2072);
            ab0 -= mq[5][0] * xy[4]; ab1 -= mq[5][1] * xy[5]; ab0 -= mq[5][2] * xy[6]; ab1 -= mq[5][3] * xy[7]; mq[5] = *(const LAS f32x4*)(Mg + 2076);
            ab0 -= mq[0][0] * xy[8]; ab1 -= mq[0][1] * xy[9]; ab0 -= mq[0][2] * xy[10]; ab1 -= mq[0][3] * xy[11]; mq[0] = *(const LAS f32x4*)(Mg + 2112);
            ab0 -= mq[1][0] * xy[12]; ab1 -= mq[1][1] * xy[13]; ab0 -= mq[1][2] * xy[14]; ab1 -= mq[1][3] * xy[15]; mq[1] = *(const LAS f32x4*)(Mg + 2116);
            ab0 -= mq[2][0] * xy[16]; ab1 -= mq[2][1] * xy[17]; ab0 -= mq[2][2] * xy[18]; ab1 -= mq[2][3] * xy[19]; mq[2] = *(const LAS f32x4*)(Mg + 2120);
            ab0 -= mq[3][0] * xy[20]; ab1 -= mq[3][1] * xy[21]; ab0 -= mq[3][2] * xy[22]; ab1 -= mq[3][3] * xy[23]; mq[3] = *(const LAS f32x4*)(Mg + 2124);
            ab0 -= mq[4][0] * xy[24]; ab1 -= mq[4][1] * xy[25]; ab0 -= mq[4][2] * xy[26]; ab1 -= mq[4][3] * xy[27]; mq[4] = *(const LAS f32x4*)(Mg + 2128);
            ab0 -= mq[5][0] * xy[28]; ab1 -= mq[5][1] * xy[29]; ab0 -= mq[5][2] * xy[30]; ab1 -= mq[5][3] * xy[31]; xy[32] = ab0 + ab1; up[4096] = xy[32][0]; wp[4096] = f2bf(-xy[32][1]); mq[5] = *(const LAS f32x4*)(Mg + 2132);
            { const float br = betg[33]; ab0 = (f32x2){bf2f(*(const LAS bf16_t*)(lg + P5_VS + 8976 + c * 2)) * br, bf2f(*(const LAS bf16_t*)(lg + P5_KS + 8976 + c * 2)) * br * __expf(decg[33])}; ab1 = (f32x2){0.f, 0.f}; } ab0 -= mq[0][0] * xy[0]; ab1 -= mq[0][1] * xy[1]; ab0 -= mq[0][2] * xy[2]; ab1 -= mq[0][3] * xy[3]; mq[0] = *(const LAS f32x4*)(Mg + 2136);
            ab0 -= mq[1][0] * xy[4]; ab1 -= mq[1][1] * xy[5]; ab0 -= mq[1][2] * xy[6]; ab1 -= mq[1][3] * xy[7]; mq[1] = *(const LAS f32x4*)(Mg + 2140);
            ab0 -= mq[2][0] * xy[8]; ab1 -= mq[2][1] * xy[9]; ab0 -= mq[2][2] * xy[10]; ab1 -= mq[2][3] * xy[11]; mq[2] = *(const LAS f32x4*)(Mg + 2144);
            ab0 -= mq[3][0] * xy[12]; ab1 -= mq[3][1] * xy[13]; ab0 -= mq[3][2] * xy[14]; ab1 -= mq[3][3] * xy[15]; mq[3] = *(const LAS f32x4*)(Mg + 2176);
            ab0 -= mq[4][0] * xy[16]; ab1 -= mq[4][1] * xy[17]; ab0 -= mq[4][2] * xy[18]; ab1 -= mq[4][3] * xy[19]; mq[4] = *(const LAS f32x4*)(Mg + 2180);
            ab0 -= mq[5][0] * xy[20]; ab1 -= mq[5][1] * xy[21]; ab0 -= mq[5][2] * xy[22]; ab1 -= mq[5][3] * xy[23]; mq[5] = *(const LAS f32x4*)(Mg + 2184);
            ab0 -= mq[0][0] * xy[24]; ab1 -= mq[0][1] * xy[25]; ab0 -= mq[0][2] * xy[26]; ab1 -= mq[0][3] * xy[27]; mq[0] = *(const LAS f32x4*)(Mg + 2188);
            ab0 -= mq[1][0] * xy[28]; ab1 -= mq[1][1] * xy[29]; ab0 -= mq[1][2] * xy[30]; ab1 -= mq[1][3] * xy[31]; mq[1] = *(const LAS f32x4*)(Mg + 2192);
            ab0 -= mq[2][0] * xy[32]; xy[33] = ab0 + ab1; up[4224] = xy[33][0]; wp[4224] = f2bf(-xy[33][1]); mq[2] = *(const LAS f32x4*)(Mg + 2196);
            { const float br = betg[34]; ab0 = (f32x2){bf2f(*(const LAS bf16_t*)(lg + P5_VS + 9248 + c * 2)) * br, bf2f(*(const LAS bf16_t*)(lg + P5_KS + 9248 + c * 2)) * br * __expf(decg[34])}; ab1 = (f32x2){0.f, 0.f}; } ab0 -= mq[3][0] * xy[0]; ab1 -= mq[3][1] * xy[1]; ab0 -= mq[3][2] * xy[2]; ab1 -= mq[3][3] * xy[3]; mq[3] = *(const LAS f32x4*)(Mg + 2200);
            ab0 -= mq[4][0] * xy[4]; ab1 -= mq[4][1] * xy[5]; ab0 -= mq[4][2] * xy[6]; ab1 -= mq[4][3] * xy[7]; mq[4] = *(const LAS f32x4*)(Mg + 2204);
            ab0 -= mq[5][0] * xy[8]; ab1 -= mq[5][1] * xy[9]; ab0 -= mq[5][2] * xy[10]; ab1 -= mq[5][3] * xy[11]; mq[5] = *(const LAS f32x4*)(Mg + 2208);
            ab0 -= mq[0][0] * xy[12]; ab1 -= mq[0][1] * xy[13]; ab0 -= mq[0][2] * xy[14]; ab1 -= mq[0][3] * xy[15]; mq[0] = *(const LAS f32x4*)(Mg + 2240);
            ab0 -= mq[1][0] * xy[16]; ab1 -= mq[1][1] * xy[17]; ab0 -= mq[1][2] * xy[18]; ab1 -= mq[1][3] * xy[19]; mq[1] = *(const LAS f32x4*)(Mg + 2244);
            ab0 -= mq[2][0] * xy[20]; ab1 -= mq[2][1] * xy[21]; ab0 -= mq[2][2] * xy[22]; ab1 -= mq[2][3] * xy[23]; mq[2] = *(const LAS f32x4*)(Mg + 2248);
            ab0 -= mq[3][0] * xy[24]; ab1 -= mq[3][1] * xy[25]; ab0 -= mq[3][2] * xy[26]; ab1 -= mq[3][3] * xy[27]; mq[3] = *(const LAS f32x4*)(Mg + 2252);
            ab0 -= mq[4][0] * xy[28]; ab1 -= mq[4][1] * xy[29]; ab0 -= mq[4][2] * xy[30]; ab1 -= mq[4][3] * xy[31]; mq[4] = *(const LAS f32x4*)(Mg + 2256);
            ab0 -= mq[5][0] * xy[32]; ab1 -= mq[5][1] * xy[33]; xy[34] = ab0 + ab1; up[4352] = xy[34][0]; wp[4352] = f2bf(-xy[34][1]); mq[5] = *(const LAS f32x4*)(Mg + 2260);
            { const float br = betg[35]; ab0 = (f32x2){bf2f(*(const LAS bf16_t*)(lg + P5_VS + 9520 + c * 2)) * br, bf2f(*(const LAS bf16_t*)(lg + P5_KS + 9520 + c * 2)) * br * __expf(decg[35])}; ab1 = (f32x2){0.f, 0.f}; } ab0 -= mq[0][0] * xy[0]; ab1 -= mq[0][1] * xy[1]; ab0 -= mq[0][2] * xy[2]; ab1 -= mq[0][3] * xy[3]; mq[0] = *(const LAS f32x4*)(Mg + 2264);
            ab0 -= mq[1][0] * xy[4]; ab1 -= mq[1][1] * xy[5]; ab0 -= mq[1][2] * xy[6]; ab1 -= mq[1][3] * xy[7]; mq[1] = *(const LAS f32x4*)(Mg + 2268);
            ab0 -= mq[2][0] * xy[8]; ab1 -= mq[2][1] * xy[9]; ab0 -= mq[2][2] * xy[10]; ab1 -= mq[2][3] * xy[11]; mq[2] = *(const LAS f32x4*)(Mg + 2272);
            ab0 -= mq[3][0] * xy[12]; ab1 -= mq[3][1] * xy[13]; ab0 -= mq[3][2] * xy[14]; ab1 -= mq[3][3] * xy[15]; mq[3] = *(const LAS f32x4*)(Mg + 2304);
            ab0 -= mq[4][0] * xy[16]; ab1 -= mq[4][1] * xy[17]; ab0 -= mq[4][2] * xy[18]; ab1 -= mq[4][3] * xy[19]; mq[4] = *(const LAS f32x4*)(Mg + 2308);
            ab0 -= mq[5][0] * xy[20]; ab1 -= mq[5][1] * xy[21]; ab0 -= mq[5][2] * xy[22]; ab1 -= mq[5][3] * xy[23]; mq[5] = *(const LAS f32x4*)(Mg + 2312);
            ab0 -= mq[0][0] * xy[24]; ab1 -= mq[0][1] * xy[25]; ab0 -= mq[0][2] * xy[26]; ab1 -= mq[0][3] * xy[27]; mq[0] = *(const LAS f32x4*)(Mg + 2316);
            ab0 -= mq[1][0] * xy[28]; ab1 -= mq[1][1] * xy[29]; ab0 -= mq[1][2] * xy[30]; ab1 -= mq[1][3] * xy[31]; mq[1] = *(const LAS f32x4*)(Mg + 2320);
            ab0 -= mq[2][0] * xy[32]; ab1 -= mq[2][1] * xy[33]; ab0 -= mq[2][2] * xy[34]; xy[35] = ab0 + ab1; up[4480] = xy[35][0]; wp[4480] = f2bf(-xy[35][1]); mq[2] = *(const LAS f32x4*)(Mg + 2324);
            { const float br = betg[36]; ab0 = (f32x2){bf2f(*(const LAS bf16_t*)(lg + P5_VS + 9792 + c * 2)) * br, bf2f(*(const LAS bf16_t*)(lg + P5_KS + 9792 + c * 2)) * br * __expf(decg[36])}; ab1 = (f32x2){0.f, 0.f}; } ab0 -= mq[3][0] * xy[0]; ab1 -= mq[3][1] * xy[1]; ab0 -= mq[3][2] * xy[2]; ab1 -= mq[3][3] * xy[3]; mq[3] = *(const LAS f32x4*)(Mg + 2328);
            ab0 -= mq[4][0] * xy[4]; ab1 -= mq[4][1] * xy[5]; ab0 -= mq[4][2] * xy[6]; ab1 -= mq[4][3] * xy[7]; mq[4] = *(const LAS f32x4*)(Mg + 2332);
            ab0 -= mq[5][0] * xy[8]; ab1 -= mq[5][1] * xy[9]; ab0 -= mq[5][2] * xy[10]; ab1 -= mq[5][3] * xy[11]; mq[5] = *(const LAS f32x4*)(Mg + 2336);
            ab0 -= mq[0][0] * xy[12]; ab1 -= mq[0][1] * xy[13]; ab0 -= mq[0][2] * xy[14]; ab1 -= mq[0][3] * xy[15]; mq[0] = *(const LAS f32x4*)(Mg + 2368);
            ab0 -= mq[1][0] * xy[16]; ab1 -= mq[1][1] * xy[17]; ab0 -= mq[1][2] * xy[18]; ab1 -= mq[1][3] * xy[19]; mq[1] = *(const LAS f32x4*)(Mg + 2372);
            ab0 -= mq[2][0] * xy[20]; ab1 -= mq[2][1] * xy[21]; ab0 -= mq[2][2] * xy[22]; ab1 -= mq[2][3] * xy[23]; mq[2] = *(const LAS f32x4*)(Mg + 2376);
            ab0 -= mq[3][0] * xy[24]; ab1 -= mq[3][1] * xy[25]; ab0 -= mq[3][2] * xy[26]; ab1 -= mq[3][3] * xy[27]; mq[3] = *(const LAS f32x4*)(Mg + 2380);
            ab0 -= mq[4][0] * xy[28]; ab1 -= mq[4][1] * xy[29]; ab0 -= mq[4][2] * xy[30]; ab1 -= mq[4][3] * xy[31]; mq[4] = *(const LAS f32x4*)(Mg + 2384);
            ab0 -= mq[5][0] * xy[32]; ab1 -= mq[5][1] * xy[33]; ab0 -= mq[5][2] * xy[34]; ab1 -= mq[5][3] * xy[35]; xy[36] = ab0 + ab1; up[4608] = xy[36][0]; wp[4608] = f2bf(-xy[36][1]); mq[5] = *(const LAS f32x4*)(Mg + 2388);
            { const float br = betg[37]; ab0 = (f32x2){bf2f(*(const LAS bf16_t*)(lg + P5_VS + 10064 + c * 2)) * br, bf2f(*(const LAS bf16_t*)(lg + P5_KS + 10064 + c * 2)) * br * __expf(decg[37])}; ab1 = (f32x2){0.f, 0.f}; } ab0 -= mq[0][0] * xy[0]; ab1 -= mq[0][1] * xy[1]; ab0 -= mq[0][2] * xy[2]; ab1 -= mq[0][3] * xy[3]; mq[0] = *(const LAS f32x4*)(Mg + 2392);
            ab0 -= mq[1][0] * xy[4]; ab1 -= mq[1][1] * xy[5]; ab0 -= mq[1][2] * xy[6]; ab1 -= mq[1][3] * xy[7]; mq[1] = *(const LAS f32x4*)(Mg + 2396);
            ab0 -= mq[2][0] * xy[8]; ab1 -= mq[2][1] * xy[9]; ab0 -= mq[2][2] * xy[10]; ab1 -= mq[2][3] * xy[11]; mq[2] = *(const LAS f32x4*)(Mg + 2400);
            ab0 -= mq[3][0] * xy[12]; ab1 -= mq[3][1] * xy[13]; ab0 -= mq[3][2] * xy[14]; ab1 -= mq[3][3] * xy[15]; mq[3] = *(const LAS f32x4*)(Mg + 2404);
            ab0 -= mq[4][0] * xy[16]; ab1 -= mq[4][1] * xy[17]; ab0 -= mq[4][2] * xy[18]; ab1 -= mq[4][3] * xy[19]; mq[4] = *(const LAS f32x4*)(Mg + 2432);
            ab0 -= mq[5][0] * xy[20]; ab1 -= mq[5][1] * xy[21]; ab0 -= mq[5][2] * xy[22]; ab1 -= mq[5][3] * xy[23]; mq[5] = *(const LAS f32x4*)(Mg + 2436);
            ab0 -= mq[0][0] * xy[24]; ab1 -= mq[0][1] * xy[25]; ab0 -= mq[0][2] * xy[26]; ab1 -= mq[0][3] * xy[27]; mq[0] = *(const LAS f32x4*)(Mg + 2440);
            ab0 -= mq[1][0] * xy[28]; ab1 -= mq[1][1] * xy[29]; ab0 -= mq[1][2] * xy[30]; ab1 -= mq[1][3] * xy[31]; mq[1] = *(const LAS f32x4*)(Mg + 2444);
            ab0 -= mq[2][0] * xy[32]; ab1 -= mq[2][1] * xy[33]; ab0 -= mq[2][2] * xy[34]; ab1 -= mq[2][3] * xy[35]; mq[2] = *(const LAS f32x4*)(Mg + 2448);
            ab0 -= mq[3][0] * xy[36]; xy[37] = ab0 + ab1; up[4736] = xy[37][0]; wp[4736] = f2bf(-xy[37][1]); mq[3] = *(const LAS f32x4*)(Mg + 2452);
            { const float br = betg[38]; ab0 = (f32x2){bf2f(*(const LAS bf16_t*)(lg + P5_VS + 10336 + c * 2)) * br, bf2f(*(const LAS bf16_t*)(lg + P5_KS + 10336 + c * 2)) * br * __expf(decg[38])}; ab1 = (f32x2){0.f, 0.f}; } ab0 -= mq[4][0] * xy[0]; ab1 -= mq[4][1] * xy[1]; ab0 -= mq[4][2] * xy[2]; ab1 -= mq[4][3] * xy[3]; mq[4] = *(const LAS f32x4*)(Mg + 2456);
            ab0 -= mq[5][0] * xy[4]; ab1 -= mq[5][1] * xy[5]; ab0 -= mq[5][2] * xy[6]; ab1 -= mq[5][3] * xy[7]; mq[5] = *(const LAS f32x4*)(Mg + 2460);
            ab0 -= mq[0][0] * xy[8]; ab1 -= mq[0][1] * xy[9]; ab0 -= mq[0][2] * xy[10]; ab1 -= mq[0][3] * xy[11]; mq[0] = *(const LAS f32x4*)(Mg + 2464);
            ab0 -= mq[1][0] * xy[12]; ab1 -= mq[1][1] * xy[13]; ab0 -= mq[1][2] * xy[14]; ab1 -= mq[1][3] * xy[15]; mq[1] = *(const LAS f32x4*)(Mg + 2468);
            ab0 -= mq[2][0] * xy[16]; ab1 -= mq[2][1] * xy[17]; ab0 -= mq[2][2] * xy[18]; ab1 -= mq[2][3] * xy[19]; mq[2] = *(const LAS f32x4*)(Mg + 2496);
            ab0 -= mq[3][0] * xy[20]; ab1 -= mq[3][1] * xy[21]; ab0 -= mq[3][2] * xy[22]; ab1 -= mq[3][3] * xy[23]; mq[3] = *(const LAS f32x4*)(Mg + 2500);
            ab0 -= mq[4][0] * xy[24]; ab1 -= mq[4][1] * xy[25]; ab0 -= mq[4][2] * xy[26]; ab1 -= mq[4][3] * xy[27]; mq[4] = *(const LAS f32x4*)(Mg + 2504);
            ab0 -= mq[5][0] * xy[28]; ab1 -= mq[5][1] * xy[29]; ab0 -= mq[5][2] * xy[30]; ab1 -= mq[5][3] * xy[31]; mq[5] = *(const LAS f32x4*)(Mg + 2508);
            ab0 -= mq[0][0] * xy[32]; ab1 -= mq[0][1] * xy[33]; ab0 -= mq[0][2] * xy[34]; ab1 -= mq[0][3] * xy[35]; mq[0] = *(const LAS f32x4*)(Mg + 2512);
            ab0 -= mq[1][0] * xy[36]; ab1 -= mq[1][1] * xy[37]; xy[38] = ab0 + ab1; up[4864] = xy[38][0]; wp[4864] = f2bf(-xy[38][1]); mq[1] = *(const LAS f32x4*)(Mg + 2516);
            { const float br = betg[39]; ab0 = (f32x2){bf2f(*(const LAS bf16_t*)(lg + P5_VS + 10608 + c * 2)) * br, bf2f(*(const LAS bf16_t*)(lg + P5_KS + 10608 + c * 2)) * br * __expf(decg[39])}; ab1 = (f32x2){0.f, 0.f}; } ab0 -= mq[2][0] * xy[0]; ab1 -= mq[2][1] * xy[1]; ab0 -= mq[2][2] * xy[2]; ab1 -= mq[2][3] * xy[3]; mq[2] = *(const LAS f32x4*)(Mg + 2520);
            ab0 -= mq[3][0] * xy[4]; ab1 -= mq[3][1] * xy[5]; ab0 -= mq[3][2] * xy[6]; ab1 -= mq[3][3] * xy[7]; mq[3] = *(const LAS f32x4*)(Mg + 2524);
            ab0 -= mq[4][0] * xy[8]; ab1 -= mq[4][1] * xy[9]; ab0 -= mq[4][2] * xy[10]; ab1 -= mq[4][3] * xy[11]; mq[4] = *(const LAS f32x4*)(Mg + 2528);
            ab0 -= mq[5][0] * xy[12]; ab1 -= mq[5][1] * xy[13]; ab0 -= mq[5][2] * xy[14]; ab1 -= mq[5][3] * xy[15]; mq[5] = *(const LAS f32x4*)(Mg + 2532);
            ab0 -= mq[0][0] * xy[16]; ab1 -= mq[0][1] * xy[17]; ab0 -= mq[0][2] * xy[18]; ab1 -= mq[0][3] * xy[19]; mq[0] = *(const LAS f32x4*)(Mg + 2560);
            ab0 -= mq[1][0] * xy[20]; ab1 -= mq[1][1] * xy[21]; ab0 -= mq[1][2] * xy[22]; ab1 -= mq[1][3] * xy[23]; mq[1] = *(const LAS f32x4*)(Mg + 2564);
            ab0 -= mq[2][0] * xy[24]; ab1 -= mq[2][1] * xy[25]; ab0 -= mq[2][2] * xy[26]; ab1 -= mq[2][3] * xy[27]; mq[2] = *(const LAS f32x4*)(Mg + 2568);
            ab0 -= mq[3][0] * xy[28]; ab1 -= mq[3][1] * xy[29]; ab0 -= mq[3][2] * xy[30]; ab1 -= mq[3][3] * xy[31]; mq[3] = *(const LAS f32x4*)(Mg + 2572);
            ab0 -= mq[4][0] * xy[32]; ab1 -= mq[4][1] * xy[33]; ab0 -= mq[4][2] * xy[34]; ab1 -= mq[4][3] * xy[35]; mq[4] = *(const LAS f32x4*)(Mg + 2576);
            ab0 -= mq[5][0] * xy[36]; ab1 -= mq[5][1] * xy[37]; ab0 -= mq[5][2] * xy[38]; xy[39] = ab0 + ab1; up[4992] = xy[39][0]; wp[4992] = f2bf(-xy[39][1]); mq[5] = *(const LAS f32x4*)(Mg + 2580);
            { const float br = betg[40]; ab0 = (f32x2){bf2f(*(const LAS bf16_t*)(lg + P5_VS + 10880 + c * 2)) * br, bf2f(*(const LAS bf16_t*)(lg + P5_KS + 10880 + c * 2)) * br * __expf(decg[40])}; ab1 = (f32x2){0.f, 0.f}; } ab0 -= mq[0][0] * xy[0]; ab1 -= mq[0][1] * xy[1]; ab0 -= mq[0][2] * xy[2]; ab1 -= mq[0][3] * xy[3]; mq[0] = *(const LAS f32x4*)(Mg + 2584);
            ab0 -= mq[1][0] * xy[4]; ab1 -= mq[1][1] * xy[5]; ab0 -= mq[1][2] * xy[6]; ab1 -= mq[1][3] * xy[7]; mq[1] = *(const LAS f32x4*)(Mg + 2588);
            ab0 -= mq[2][0] * xy[8]; ab1 -= mq[2][1] * xy[9]; ab0 -= mq[2][2] * xy[10]; ab1 -= mq[2][3] * xy[11]; mq[2] = *(const LAS f32x4*)(Mg + 2592);
            ab0 -= mq[3][0] * xy[12]; ab1 -= mq[3][1] * xy[13]; ab0 -= mq[3][2] * xy[14]; ab1 -= mq[3][3] * xy[15]; mq[3] = *(const LAS f32x4*)(Mg + 2596);
            ab0 -= mq[4][0] * xy[16]; ab1 -= mq[4][1] * xy[17]; ab0 -= mq[4][2] * xy[18]; ab1 -= mq[4][3] * xy[19]; mq[4] = *(const LAS f32x4*)(Mg + 2624);
            ab0 -= mq[5][0] * xy[20]; ab1 -= mq[5][1] * xy[21]; ab0 -= mq[5][2] * xy[22]; ab1 -= mq[5][3] * xy[23]; mq[5] = *(const LAS f32x4*)(Mg + 2628);
            ab0 -= mq[0][0] * xy[24]; ab1 -= mq[0][1] * xy[25]; ab0 -= mq[0][2] * xy[26]; ab1 -= mq[0][3] * xy[27]; mq[0] = *(const LAS f32x4*)(Mg + 2632);
            ab0 -= mq[1][0] * xy[28]; ab1 -= mq[1][1] * xy[29]; ab0 -= mq[1][2] * xy[30]; ab1 -= mq[1][3] * xy[31]; mq[1] = *(const LAS f32x4*)(Mg + 2636);
            ab0 -= mq[2][0] * xy[32]; ab1 -= mq[2][1] * xy[33]; ab0 -= mq[2][2] * xy[34]; ab1 -= mq[2][3] * xy[35]; mq[2] = *(const LAS f32x4*)(Mg + 2640);
            ab0 -= mq[3][0] * xy[36]; ab1 -= mq[3][1] * xy[37]; ab0 -= mq[3][2] * xy[38]; ab1 -= mq[3][3] * xy[39]; xy[40] = ab0 + ab1; up[5120] = xy[40][0]; wp[5120] = f2bf(-xy[40][1]); mq[3] = *(const LAS f32x4*)(Mg + 2644);
            { const float br = betg[41]; ab0 = (f32x2){bf2f(*(const LAS bf16_t*)(lg + P5_VS + 11152 + c * 2)) * br, bf2f(*(const LAS bf16_t*)(lg + P5_KS + 11152 + c * 2)) * br * __expf(decg[41])}; ab1 = (f32x2){0.f, 0.f}; } ab0 -= mq[4][0] * xy[0]; ab1 -= mq[4][1] * xy[1]; ab0 -= mq[4][2] * xy[2]; ab1 -= mq[4][3] * xy[3]; mq[4] = *(const LAS f32x4*)(Mg + 2648);
            ab0 -= mq[5][0] * xy[4]; ab1 -= mq[5][1] * xy[5]; ab0 -= mq[5][2] * xy[6]; ab1 -= mq[5][3] * xy[7]; mq[5] = *(const LAS f32x4*)(Mg + 2652);
            ab0 -= mq[0][0] * xy[8]; ab1 -= mq[0][1] * xy[9]; ab0 -= mq[0][2] * xy[10]; ab1 -= mq[0][3] * xy[11]; mq[0] = *(const LAS f32x4*)(Mg + 2656);
            ab0 -= mq[1][0] * xy[12]; ab1 -= mq[1][1] * xy[13]; ab0 -= mq[1][2] * xy[14]; ab1 -= mq[1][3] * xy[15]; mq[1] = *(const LAS f32x4*)(Mg + 2660);
            ab0 -= mq[2][0] * xy[16]; ab1 -= mq[2][1] * xy[17]; ab0 -= mq[2][2] * xy[18]; ab1 -= mq[2][3] * xy[19]; mq[2] = *(const LAS f32x4*)(Mg + 2664);
            ab0 -= mq[3][0] * xy[20]; ab1 -= mq[3][1] * xy[21]; ab0 -= mq[3][2] * xy[22]; ab1 -= mq[3][3] * xy[23]; mq[3] = *(const LAS f32x4*)(Mg + 2688);
            ab0 -= mq[4][0] * xy[24]; ab1 -= mq[4][1] * xy[25]; ab0 -= mq[4][2] * xy[26]; ab1 -= mq[4][3] * xy[27]; mq[4] = *(const LAS f32x4*)(Mg + 2692);
            ab0 -= mq[5][0] * xy[28]; ab1 -= mq[5][1] * xy[29]; ab0 -= mq[5][2] * xy[30]; ab1 -= mq[5][3] * xy[31]; mq[5] = *(const LAS f32x4*)(Mg + 2696);
            ab0 -= mq[0][0] * xy[32]; ab1 -= mq[0][1] * xy[33]; ab0 -= mq[0][2] * xy[34]; ab1 -= mq[0][3] * xy[35]; mq[0] = *(const LAS f32x4*)(Mg + 2700);
            ab0 -= mq[1][0] * xy[36]; ab1 -= mq[1][1] * xy[37]; ab0 -= mq[1][2] * xy[38]; ab1 -= mq[1][3] * xy[39]; mq[1] = *(const LAS f32x4*)(Mg + 2704);
            ab0 -= mq[2][0] * xy[40]; xy[41] = ab0 + ab1; up[5248] = xy[41][0]; wp[5248] = f2bf(-xy[41][1]); mq[2] = *(const LAS f32x4*)(Mg + 2708);
            { const float br = betg[42]; ab0 = (f32x2){bf2f(*(const LAS bf16_t*)(lg + P5_VS + 11424 + c * 2)) * br, bf2f(*(const LAS bf16_t*)(lg + P5_KS + 11424 + c * 2)) * br * __expf(decg[42])}; ab1 = (f32x2){0.f, 0.f}; } ab0 -= mq[3][0] * xy[0]; ab1 -= mq[3][1] * xy[1]; ab0 -= mq[3][2] * xy[2]; ab1 -= mq[3][3] * xy[3]; mq[3] = *(const LAS f32x4*)(Mg + 2712);
            ab0 -= mq[4][0] * xy[4]; ab1 -= mq[4][1] * xy[5]; ab0 -= mq[4][2] * xy[6]; ab1 -= mq[4][3] * xy[7]; mq[4] = *(const LAS f32x4*)(Mg + 2716);
            ab0 -= mq[5][0] * xy[8]; ab1 -= mq[5][1] * xy[9]; ab0 -= mq[5][2] * xy[10]; ab1 -= mq[5][3] * xy[11]; mq[5] = *(const LAS f32x4*)(Mg + 2720);
            ab0 -= mq[0][0] * xy[12]; ab1 -= mq[0][1] * xy[13]; ab0 -= mq[0][2] * xy[14]; ab1 -= mq[0][3] * xy[15]; mq[0] = *(const LAS f32x4*)(Mg + 2724);
            ab0 -= mq[1][0] * xy[16]; ab1 -= mq[1][1] * xy[17]; ab0 -= mq[1][2] * xy[18]; ab1 -= mq[1][3] * xy[19]; mq[1] = *(const LAS f32x4*)(Mg + 2728);
            ab0 -= mq[2][0] * xy[20]; ab1 -= mq[2][1] * xy[21]; ab0 -= mq[2][2] * xy[22]; ab1 -= mq[2][3] * xy[23]; mq[2] = *(const LAS f32x4*)(Mg + 2752);
            ab0 -= mq[3][0] * xy[24]; ab1 -= mq[3][1] * xy[25]; ab0 -= mq[3][2] * xy[26]; ab1 -= mq[3][3] * xy[27]; mq[3] = *(const LAS f32x4*)(Mg + 2756);
            ab0 -= mq[4][0] * xy[28]; ab1 -= mq[4][1] * xy[29]; ab0 -= mq[4][2] * xy[30]; ab1 -= mq[4][3] * xy[31]; mq[4] = *(const LAS f32x4*)(Mg + 2760);
            ab0 -= mq[5][0] * xy[32]; ab1 -= mq[5][1] * xy[33]; ab0 -= mq[5][2] * xy[34]; ab1 -= mq[5][3] * xy[35]; mq[5] = *(const LAS f32x4*)(Mg + 2764);
            ab0 -= mq[0][0] * xy[36]; ab1 -= mq[0][1] * xy[37]; ab0 -= mq[0][2] * xy[38]; ab1 -= mq[0][3] * xy[39]; mq[0] = *(const LAS f32x4*)(Mg + 2768);
            ab0 -= mq[1][0] * xy[40]; ab1 -= mq[1][1] * xy[41]; xy[42] = ab0 + ab1; up[5376] = xy[42][0]; wp[5376] = f2bf(-xy[42][1]); mq[1] = *(const LAS f32x4*)(Mg + 2772);
            { const float br = betg[43]; ab0 = (f32x2){bf2f(*(const LAS bf16_t*)(lg + P5_VS + 11696 + c * 2)) * br, bf2f(*(const LAS bf16_t*)(lg + P5_KS + 11696 + c * 2)) * br * __expf(decg[43])}; ab1 = (f32x2){0.f, 0.f}; } ab0 -= mq[2][0] * xy[0]; ab1 -= mq[2][1] * xy[1]; ab0 -= mq[2][2] * xy[2]; ab1 -= mq[2][3] * xy[3]; mq[2] = *(const LAS f32x4*)(Mg + 2776);
            ab0 -= mq[3][0] * xy[4]; ab1 -= mq[3][1] * xy[5]; ab0 -= mq[3][2] * xy[6]; ab1 -= mq[3][3] * xy[7]; mq[3] = *(const LAS f32x4*)(Mg + 2780);
            ab0 -= mq[4][0] * xy[8]; ab1 -= mq[4][1] * xy[9]; ab0 -= mq[4][2] * xy[10]; ab1 -= mq[4][3] * xy[11]; mq[4] = *(const LAS f32x4*)(Mg + 2784);
            ab0 -= mq[5][0] * xy[12]; ab1 -= mq[5][1] * xy[13]; ab0 -= mq[5][2] * xy[14]; ab1 -= mq[5][3] * xy[15]; mq[5] = *(const LAS f32x4*)(Mg + 2788);
            ab0 -= mq[0][0] * xy[16]; ab1 -= mq[0][1] * xy[17]; ab0 -= mq[0][2] * xy[18]; ab1 -= mq[0][3] * xy[19]; mq[0] = *(const LAS f32x4*)(Mg + 2792);
            ab0 -= mq[1][0] * xy[20]; ab1 -= mq[1][1] * xy[21]; ab0 -= mq[1][2] * xy[22]; ab1 -= mq[1][3] * xy[23]; mq[1] = *(const LAS f32x4*)(Mg + 2816);
            ab0 -= mq[2][0] * xy[24]; ab1 -= mq[2][1] * xy[25]; ab0 -= mq[2][2] * xy[26]; ab1 -= mq[2][3] * xy[27]; mq[2] = *(const LAS f32x4*)(Mg + 2820);
            ab0 -= mq[3][0] * xy[28]; ab1 -= mq[3][1] * xy[29]; ab0 -= mq[3][2] * xy[30]; ab1 -= mq[3][3] * xy[31]; mq[3] = *(const LAS f32x4*)(Mg + 2824);
            ab0 -= mq[4][0] * xy[32]; ab1 -= mq[4][1] * xy[33]; ab0 -= mq[4][2] * xy[34]; ab1 -= mq[4][3] * xy[35]; mq[4] = *(const LAS f32x4*)(Mg + 2828);
            ab0 -= mq[5][0] * xy[36]; ab1 -= mq[5][1] * xy[37]; ab0 -= mq[5][2] * xy[38]; ab1 -= mq[5][3] * xy[39]; mq[5] = *(const LAS f32x4*)(Mg + 2832);
            ab0 -= mq[0][0] * xy[40]; ab1 -= mq[0][1] * xy[41]; ab0 -= mq[0][2] * xy[42]; xy[43] = ab0 + ab1; up[5504] = xy[43][0]; wp[5504] = f2bf(-xy[43][1]); mq[0] = *(const LAS f32x4*)(Mg + 2836);
            { const float br = betg[44]; ab0 = (f32x2){bf2f(*(const LAS bf16_t*)(lg + P5_VS + 11968 + c * 2)) * br, bf2f(*(const LAS bf16_t*)(lg + P5_KS + 11968 + c * 2)) * br * __expf(decg[44])}; ab1 = (f32x2){0.f, 0.f}; } ab0 -= mq[1][0] * xy[0]; ab1 -= mq[1][1] * xy[1]; ab0 -= mq[1][2] * xy[2]; ab1 -= mq[1][3] * xy[3]; mq[1] = *(const LAS f32x4*)(Mg + 2840);
            ab0 -= mq[2][0] * xy[4]; ab1 -= mq[2][1] * xy[5]; ab0 -= mq[2][2] * xy[6]; ab1 -= mq[2][3] * xy[7]; mq[2] = *(const LAS f32x4*)(Mg + 2844);
            ab0 -= mq[3][0] * xy[8]; ab1 -= mq[3][1] * xy[9]; ab0 -= mq[3][2] * xy[10]; ab1 -= mq[3][3] * xy[11]; mq[3] = *(const LAS f32x4*)(Mg + 2848);
            ab0 -= mq[4][0] * xy[12]; ab1 -= mq[4][1] * xy[13]; ab0 -= mq[4][2] * xy[14]; ab1 -= mq[4][3] * xy[15]; mq[4] = *(const LAS f32x4*)(Mg + 2852);
            ab0 -= mq[5][0] * xy[16]; ab1 -= mq[5][1] * xy[17]; ab0 -= mq[5][2] * xy[18]; ab1 -= mq[5][3] * xy[19]; mq[5] = *(const LAS f32x4*)(Mg + 2856);
            ab0 -= mq[0][0] * xy[20]; ab1 -= mq[0][1] * xy[21]; ab0 -= mq[0][2] * xy[22]; ab1 -= mq[0][3] * xy[23]; mq[0] = *(const LAS f32x4*)(Mg + 2880);
            ab0 -= mq[1][0] * xy[24]; ab1 -= mq[1][1] * xy[25]; ab0 -= mq[1][2] * xy[26]; ab1 -= mq[1][3] * xy[27]; mq[1] = *(const LAS f32x4*)(Mg + 2884);
            ab0 -= mq[2][0] * xy[28]; ab1 -= mq[2][1] * xy[29]; ab0 -= mq[2][2] * xy[30]; ab1 -= mq[2][3] * xy[31]; mq[2] = *(const LAS f32x4*)(Mg + 2888);
            ab0 -= mq[3][0] * xy[32]; ab1 -= mq[3][1] * xy[33]; ab0 -= mq[3][2] * xy[34]; ab1 -= mq[3][3] * xy[35]; mq[3] = *(const LAS f32x4*)(Mg + 2892);
            ab0 -= mq[4][0] * xy[36]; ab1 -= mq[4][1] * xy[37]; ab0 -= mq[4][2] * xy[38]; ab1 -= mq[4][3] * xy[39]; mq[4] = *(const LAS f32x4*)(Mg + 2896);
            ab0 -= mq[5][0] * xy[40]; ab1 -= mq[5][1] * xy[41]; ab0 -= mq[5][2] * xy[42]; ab1 -= mq[5][3] * xy[43]; xy[44] = ab0 + ab1; up[5632] = xy[44][0]; wp[5632] = f2bf(-xy[44][1]); mq[5] = *(const LAS f32x4*)(Mg + 2900);
            { const float br = betg[45]; ab0 = (f32x2){bf2f(*(const LAS bf16_t*)(lg + P5_VS + 12240 + c * 2)) * br, bf2f(*(const LAS bf16_t*)(lg + P5_KS + 12240 + c * 2)) * br * __expf(decg[45])}; ab1 = (f32x2){0.f, 0.f}; } ab0 -= mq[0][0] * xy[0]; ab1 -= mq[0][1] * xy[1]; ab0 -= mq[0][2] * xy[2]; ab1 -= mq[0][3] * xy[3]; mq[0] = *(const LAS f32x4*)(Mg + 2904);
            ab0 -= mq[1][0] * xy[4]; ab1 -= mq[1][1] * xy[5]; ab0 -= mq[1][2] * xy[6]; ab1 -= mq[1][3] * xy[7]; mq[1] = *(const LAS f32x4*)(Mg + 2908);
            ab0 -= mq[2][0] * xy[8]; ab1 -= mq[2][1] * xy[9]; ab0 -= mq[2][2] * xy[10]; ab1 -= mq[2][3] * xy[11]; mq[2] = *(const LAS f32x4*)(Mg + 2912);
            ab0 -= mq[3][0] * xy[12]; ab1 -= mq[3][1] * xy[13]; ab0 -= mq[3][2] * xy[14]; ab1 -= mq[3][3] * xy[15]; mq[3] = *(const LAS f32x4*)(Mg + 2916);
            ab0 -= mq[4][0] * xy[16]; ab1 -= mq[4][1] * xy[17]; ab0 -= mq[4][2] * xy[18]; ab1 -= mq[4][3] * xy[19]; mq[4] = *(const LAS f32x4*)(Mg + 2920);
            ab0 -= mq[5][0] * xy[20]; ab1 -= mq[5][1] * xy[21]; ab0 -= mq[5][2] * xy[22]; ab1 -= mq[5][3] * xy[23]; mq[5] = *(const LAS f32x4*)(Mg + 2924);
            ab0 -= mq[0][0] * xy[24]; ab1 -= mq[0][1] * xy[25]; ab0 -= mq[0][2] * xy[26]; ab1 -= mq[0][3] * xy[27]; mq[0] = *(const LAS f32x4*)(Mg + 2944);
            ab0 -= mq[1][0] * xy[28]; ab1 -= mq[1][1] * xy[29]; ab0 -= mq[1][2] * xy[30]; ab1 -= mq[1][3] * xy[31]; mq[1] = *(const LAS f32x4*)(Mg + 2948);
            ab0 -= mq[2][0] * xy[32]; ab1 -= mq[2][1] * xy[33]; ab0 -= mq[2][2] * xy[34]; ab1 -= mq[2][3] * xy[35]; mq[2] = *(const LAS f32x4*)(Mg + 2952);
            ab0 -= mq[3][0] * xy[36]; ab1 -= mq[3][1] * xy[37]; ab0 -= mq[3][2] * xy[38]; ab1 -= mq[3][3] * xy[39]; mq[3] = *(const LAS f32x4*)(Mg + 2956);
            ab0 -= mq[4][0] * xy[40]; ab1 -= mq[4][1] * xy[41]; ab0 -= mq[4][2] * xy[42]; ab1 -= mq[4][3] * xy[43]; mq[4] = *(const LAS f32x4*)(Mg + 2960);
            ab0 -= mq[5][0] * xy[44]; xy[45] = ab0 + ab1; up[5760] = xy[45][0]; wp[5760] = f2bf(-xy[45][1]); mq[5] = *(const LAS f32x4*)(Mg + 2964);
            { const float br = betg[46]; ab0 = (f32x2){bf2f(*(const LAS bf16_t*)(lg + P5_VS + 12512 + c * 2)) * br, bf2f(*(const LAS bf16_t*)(lg + P5_KS + 12512 + c * 2)) * br * __expf(decg[46])}; ab1 = (f32x2){0.f, 0.f}; } ab0 -= mq[0][0] * xy[0]; ab1 -= mq[0][1] * xy[1]; ab0 -= mq[0][2] * xy[2]; ab1 -= mq[0][3] * xy[3]; mq[0] = *(const LAS f32x4*)(Mg + 2968);
            ab0 -= mq[1][0] * xy[4]; ab1 -= mq[1][1] * xy[5]; ab0 -= mq[1][2] * xy[6]; ab1 -= mq[1][3] * xy[7]; mq[1] = *(const LAS f32x4*)(Mg + 2972);
            ab0 -= mq[2][0] * xy[8]; ab1 -= mq[2][1] * xy[9]; ab0 -= mq[2][2] * xy[10]; ab1 -= mq[2][3] * xy[11]; mq[2] = *(const LAS f32x4*)(Mg + 2976);
            ab0 -= mq[3][0] * xy[12]; ab1 -= mq[3][1] * xy[13]; ab0 -= mq[3][2] * xy[14]; ab1 -= mq[3][3] * xy[15]; mq[3] = *(const LAS f32x4*)(Mg + 2980);
            ab0 -= mq[4][0] * xy[16]; ab1 -= mq[4][1] * xy[17]; ab0 -= mq[4][2] * xy[18]; ab1 -= mq[4][3] * xy[19]; mq[4] = *(const LAS f32x4*)(Mg + 2984);
            ab0 -= mq[5][0] * xy[20]; ab1 -= mq[5][1] * xy[21]; ab0 -= mq[5][2] * xy[22]; ab1 -= mq[5][3] * xy[23]; mq[5] = *(const LAS f32x4*)(Mg + 2988);
            ab0 -= mq[0][0] * xy[24]; ab1 -= mq[0][1] * xy[25]; ab0 -= mq[0][2] * xy[26]; ab1 -= mq[0][3] * xy[27]; mq[0] = *(const LAS f32x4*)(Mg + 3008);
            ab0 -= mq[1][0] * xy[28]; ab1 -= mq[1][1] * xy[29]; ab0 -= mq[1][2] * xy[30]; ab1 -= mq[1][3] * xy[31]; mq[1] = *(const LAS f32x4*)(Mg + 3012);
            ab0 -= mq[2][0] * xy[32]; ab1 -= mq[2][1] * xy[33]; ab0 -= mq[2][2] * xy[34]; ab1 -= mq[2][3] * xy[35]; mq[2] = *(const LAS f32x4*)(Mg + 3016);
            ab0 -= mq[3][0] * xy[36]; ab1 -= mq[3][1] * xy[37]; ab0 -= mq[3][2] * xy[38]; ab1 -= mq[3][3] * xy[39]; mq[3] = *(const LAS f32x4*)(Mg + 3020);
            ab0 -= mq[4][0] * xy[40]; ab1 -= mq[4][1] * xy[41]; ab0 -= mq[4][2] * xy[42]; ab1 -= mq[4][3] * xy[43]; mq[4] = *(const LAS f32x4*)(Mg + 3024);
            ab0 -= mq[5][0] * xy[44]; ab1 -= mq[5][1] * xy[45]; xy[46] = ab0 + ab1; up[5888] = xy[46][0]; wp[5888] = f2bf(-xy[46][1]); mq[5] = *(const LAS f32x4*)(Mg + 3028);
            { const float br = betg[47]; ab0 = (f32x2){bf2f(*(const LAS bf16_t*)(lg + P5_VS + 12784 + c * 2)) * br, bf2f(*(const LAS bf16_t*)(lg + P5_KS + 12784 + c * 2)) * br * __expf(decg[47])}; ab1 = (f32x2){0.f, 0.f}; } ab0 -= mq[0][0] * xy[0]; ab1 -= mq[0][1] * xy[1]; ab0 -= mq[0][2] * xy[2]; ab1 -= mq[0][3] * xy[3]; mq[0] = *(const LAS f32x4*)(Mg + 3032);
            ab0 -= mq[1][0] * xy[4]; ab1 -= mq[1][1] * xy[5]; ab0 -= mq[1][2] * xy[6]; ab1 -= mq[1][3] * xy[7]; mq[1] = *(const LAS f32x4*)(Mg + 3036);
            ab0 -= mq[2][0] * xy[8]; ab1 -= mq[2][1] * xy[9]; ab0 -= mq[2][2] * xy[10]; ab1 -= mq[2][3] * xy[11]; mq[2] = *(const LAS f32x4*)(Mg + 3040);
            ab0 -= mq[3][0] * xy[12]; ab1 -= mq[3][1] * xy[13]; ab0 -= mq[3][2] * xy[14]; ab1 -= mq[3][3] * xy[15]; mq[3] = *(const LAS f32x4*)(Mg + 3044);
            ab0 -= mq[4][0] * xy[16]; ab1 -= mq[4][1] * xy[17]; ab0 -= mq[4][2] * xy[18]; ab1 -= mq[4][3] * xy[19]; mq[4] = *(const LAS f32x4*)(Mg + 3048);
            ab0 -= mq[5][0] * xy[20]; ab1 -= mq[5][1] * xy[21]; ab0 -= mq[5][2] * xy[22]; ab1 -= mq[5][3] * xy[23]; mq[5] = *(const LAS f32x4*)(Mg + 3052);
            ab0 -= mq[0][0] * xy[24]; ab1 -= mq[0][1] * xy[25]; ab0 -= mq[0][2] * xy[26]; ab1 -= mq[0][3] * xy[27]; mq[0] = *(const LAS f32x4*)(Mg + 3072);
            ab0 -= mq[1][0] * xy[28]; ab1 -= mq[1][1] * xy[29]; ab0 -= mq[1][2] * xy[30]; ab1 -= mq[1][3] * xy[31]; mq[1] = *(const LAS f32x4*)(Mg + 3076);
            ab0 -= mq[2][0] * xy[32]; ab1 -= mq[2][1] * xy[33]; ab0 -= mq[2][2] * xy[34]; ab1 -= mq[2][3] * xy[35]; mq[2] = *(const LAS f32x4*)(Mg + 3080);
            ab0 -= mq[3][0] * xy[36]; ab1 -= mq[3][1] * xy[37]; ab0 -= mq[3][2] * xy[38]; ab1 -= mq[3][3] * xy[39]; mq[3] = *(const LAS f32x4*)(Mg + 3084);
            ab0 -= mq[4][0] * xy[40]; ab1 -= mq[4][1] * xy[41]; ab0 -= mq[4][2] * xy[42]; ab1 -= mq[4][3] * xy[43]; mq[4] = *(const LAS f32x4*)(Mg + 3088);
            ab0 -= mq[5][0] * xy[44]; ab1 -= mq[5][1] * xy[45]; ab0 -= mq[5][2] * xy[46]; xy[47] = ab0 + ab1; up[6016] = xy[47][0]; wp[6016] = f2bf(-xy[47][1]); mq[5] = *(const LAS f32x4*)(Mg + 3092);
            { const float br = betg[48]; ab0 = (f32x2){bf2f(*(const LAS bf16_t*)(lg + P5_VS + 13056 + c * 2)) * br, bf2f(*(const LAS bf16_t*)(lg + P5_KS + 13056 + c * 2)) * br * __expf(decg[48])}; ab1 = (f32x2){0.f, 0.f}; } ab0 -= mq[0][0] * xy[0]; ab1 -= mq[0][1] * xy[1]; ab0 -= mq[0][2] * xy[2]; ab1 -= mq[0][3] * xy[3]; mq[0] = *(const LAS f32x4*)(Mg + 3096);
            ab0 -= mq[1][0] * xy[4]; ab1 -= mq[1][1] * xy[5]; ab0 -= mq[1][2] * xy[6]; ab1 -= mq[1][3] * xy[7]; mq[1] = *(const LAS f32x4*)(Mg + 3100);
            ab0 -= mq[2][0] * xy[8]; ab1 -= mq[2][1] * xy[9]; ab0 -= mq[2][2] * xy[10]; ab1 -= mq[2][3] * xy[11]; mq[2] = *(const LAS f32x4*)(Mg + 3104);
            ab0 -= mq[3][0] * xy[12]; ab1 -= mq[3][1] * xy[13]; ab0 -= mq[3][2] * xy[14]; ab1 -= mq[3][3] * xy[15]; mq[3] = *(const LAS f32x4*)(Mg + 3108);
            ab0 -= mq[4][0] * xy[16]; ab1 -= mq[4][1] * xy[17]; ab0 -= mq[4][2] * xy[18]; ab1 -= mq[4][3] * xy[19]; mq[4] = *(const LAS f32x4*)(Mg + 3112);
            ab0 -= mq[5][0] * xy[20]; ab1 -= mq[5][1] * xy[21]; ab0 -= mq[5][2] * xy[22]; ab1 -= mq[5][3] * xy[23]; mq[5] = *(const LAS f32x4*)(Mg + 3116);
            ab0 -= mq[0][0] * xy[24]; ab1 -= mq[0][1] * xy[25]; ab0 -= mq[0][2] * xy[26]; ab1 -= mq[0][3] * xy[27]; mq[0] = *(const LAS f32x4*)(Mg + 3136);
            ab0 -= mq[1][0] * xy[28]; ab1 -= mq[1][1] * xy[29]; ab0 -= mq[1][2] * xy[30]; ab1 -= mq[1][3] * xy[31]; mq[1] = *(const LAS f32x4*)(Mg + 3140);
            ab0 -= mq[2][0] * xy[32]; ab1 -= mq[2][1] * xy[33]; ab0 -= mq[2][2] * xy[34]; ab1 -= mq[2][3] * xy[35]; mq[2] = *(const LAS f32x4*)(Mg + 3144);
            ab0 -= mq[3][0] * xy[36]; ab1 -= mq[3][1] * xy[37]; ab0 -= mq[3][2] * xy[38]; ab1 -= mq[3][3] * xy[39]; mq[3] = *(const LAS f32x4*)(Mg + 3148);
            ab0 -= mq[4][0] * xy[40]; ab1 -= mq[4][1] * xy[41]; ab0 -= mq[4][2] * xy[42]; ab1 -= mq[4][3] * xy[43]; mq[4] = *(const LAS f32x4*)(Mg + 3152);
            ab0 -= mq[5][0] * xy[44]; ab1 -= mq[5][1] * xy[45]; ab0 -= mq[5][2] * xy[46]; ab1 -= mq[5][3] * xy[47]; xy[48] = ab0 + ab1; up[6144] = xy[48][0]; wp[6144] = f2bf(-xy[48][1]); mq[5] = *(const LAS f32x4*)(Mg + 3156);
            { const float br = betg[49]; ab0 = (f32x2){bf2f(*(const LAS bf16_t*)(lg + P5_VS + 13328 + c * 2)) * br, bf2f(*(const LAS bf16_t*)(lg + P5_KS + 13328 + c * 2)) * br * __expf(decg[49])}; ab1 = (f32x2){0.f, 0.f}; } ab0 -= mq[0][0] * xy[0]; ab1 -= mq[0][1] * xy[1]; ab0 -= mq[0][2] * xy[2]; ab1 -= mq[0][3] * xy[3]; mq[0] = *(const LAS f32x4*)(Mg + 3160);
            ab0 -= mq[1][0] * xy[4]; ab1 -= mq[1][1] * xy[5]; ab0 -= mq[1][2] * xy[6]; ab1 -= mq[1][3] * xy[7]; mq[1] = *(const LAS f32x4*)(Mg + 3164);
            ab0 -= mq[2][0] * xy[8]; ab1 -= mq[2][1] * xy[9]; ab0 -= mq[2][2] * xy[10]; ab1 -= mq[2][3] * xy[11]; mq[2] = *(const LAS f32x4*)(Mg + 3168);
            ab0 -= mq[3][0] * xy[12]; ab1 -= mq[3][1] * xy[13]; ab0 -= mq[3][2] * xy[14]; ab1 -= mq[3][3] * xy[15]; mq[3] = *(const LAS f32x4*)(Mg + 3172);
            ab0 -= mq[4][0] * xy[16]; ab1 -= mq[4][1] * xy[17]; ab0 -= mq[4][2] * xy[18]; ab1 -= mq[4][3] * xy[19]; mq[4] = *(const LAS f32x4*)(Mg + 3176);
            ab0 -= mq[5][0] * xy[20]; ab1 -= mq[5][1] * xy[21]; ab0 -= mq[5][2] * xy[22]; ab1 -= mq[5][3] * xy[23]; mq[5] = *(const LAS f32x4*)(Mg + 3180);
            ab0 -= mq[0][0] * xy[24]; ab1 -= mq[0][1] * xy[25]; ab0 -= mq[0][2] * xy[26]; ab1 -= mq[0][3] * xy[27]; mq[0] = *(const LAS f32x4*)(Mg + 3184);
            ab0 -= mq[1][0] * xy[28]; ab1 -= mq[1][1] * xy[29]; ab0 -= mq[1][2] * xy[30]; ab1 -= mq[1][3] * xy[31]; mq[1] = *(const LAS f32x4*)(Mg + 3200);
            ab0 -= mq[2][0] * xy[32]; ab1 -= mq[2][1] * xy[33]; ab0 -= mq[2][2] * xy[34]; ab1 -= mq[2][3] * xy[35]; mq[2] = *(const LAS f32x4*)(Mg + 3204);
            ab0 -= mq[3][0] * xy[36]; ab1 -= mq[3][1] * xy[37]; ab0 -= mq[3][2] * xy[38]; ab1 -= mq[3][3] * xy[39]; mq[3] = *(const LAS f32x4*)(Mg + 3208);
            ab0 -= mq[4][0] * xy[40]; ab1 -= mq[4][1] * xy[41]; ab0 -= mq[4][2] * xy[42]; ab1 -= mq[4][3] * xy[43]; mq[4] = *(const LAS f32x4*)(Mg + 3212);
            ab0 -= mq[5][0] * xy[44]; ab1 -= mq[5][1] * xy[45]; ab0 -= mq[5][2] * xy[46]; ab1 -= mq[5][3] * xy[47]; mq[5] = *(const LAS f32x4*)(Mg + 3216);
            ab0 -= mq[0][0] * xy[48]; xy[49] = ab0 + ab1; up[6272] = xy[49][0]; wp[6272] = f2bf(-xy[49][1]); mq[0] = *(const LAS f32x4*)(Mg + 3220);
            { const float br = betg[50]; ab0 = (f32x2){bf2f(*(const LAS bf16_t*)(lg + P5_VS + 13600 + c * 2)) * br, bf2f(*(const LAS bf16_t*)(lg + P5_KS + 13600 + c * 2)) * br * __expf(decg[50])}; ab1 = (f32x2){0.f, 0.f}; } ab0 -= mq[1][0] * xy[0]; ab1 -= mq[1][1] * xy[1]; ab0 -= mq[1][2] * xy[2]; ab1 -= mq[1][3] * xy[3]; mq[1] = *(const LAS f32x4*)(Mg + 3224);
            ab0 -= mq[2][0] * xy[4]; ab1 -= mq[2][1] * xy[5]; ab0 -= mq[2][2] * xy[6]; ab1 -= mq[2][3] * xy[7]; mq[2] = *(const LAS f32x4*)(Mg + 3228);
            ab0 -= mq[3][0] * xy[8]; ab1 -= mq[3][1] * xy[9]; ab0 -= mq[3][2] * xy[10]; ab1 -= mq[3][3] * xy[11]; mq[3] = *(const LAS f32x4*)(Mg + 3232);
            ab0 -= mq[4][0] * xy[12]; ab1 -= mq[4][1] * xy[13]; ab0 -= mq[4][2] * xy[14]; ab1 -= mq[4][3] * xy[15]; mq[4] = *(const LAS f32x4*)(Mg + 3236);
            ab0 -= mq[5][0] * xy[16]; ab1 -= mq[5][1] * xy[17]; ab0 -= mq[5][2] * xy[18]; ab1 -= mq[5][3] * xy[19]; mq[5] = *(const LAS f32x4*)(Mg + 3240);
            ab0 -= mq[0][0] * xy[20]; ab1 -= mq[0][1] * xy[21]; ab0 -= mq[0][2] * xy[22]; ab1 -= mq[0][3] * xy[23]; mq[0] = *(const LAS f32x4*)(Mg + 3244);
            ab0 -= mq[1][0] * xy[24]; ab1 -= mq[1][1] * xy[25]; ab0 -= mq[1][2] * xy[26]; ab1 -= mq[1][3] * xy[27]; mq[1] = *(const LAS f32x4*)(Mg + 3248);
            ab0 -= mq[2][0] * xy[28]; ab1 -= mq[2][1] * xy[29]; ab0 -= mq[2][2] * xy[30]; ab1 -= mq[2][3] * xy[31]; mq[2] = *(const LAS f32x4*)(Mg + 3264);
            ab0 -= mq[3][0] * xy[32]; ab1 -= mq[3][1] * xy[33]; ab0 -= mq[3][2] * xy[34]; ab1 -= mq[3][3] * xy[35]; mq[3] = *(const LAS f32x4*)(Mg + 3268);
            ab0 -= mq[4][0] * xy[36]; ab1 -= mq[4][1] * xy[37]; ab0 -= mq[4][2] * xy[38]; ab1 -= mq[4][3] * xy[39]; mq[4] = *(const LAS f32x4*)(Mg + 3272);
            ab0 -= mq[5][0] * xy[40]; ab1 -= mq[5][1] * xy[41]; ab0 -= mq[5][2] * xy[42]; ab1 -= mq[5][3] * xy[43]; mq[5] = *(const LAS f32x4*)(Mg + 3276);
            ab0 -= mq[0][0] * xy[44]; ab1 -= mq[0][1] * xy[45]; ab0 -= mq[0][2] * xy[46]; ab1 -= mq[0][3] * xy[47]; mq[0] = *(const LAS f32x4*)(Mg + 3280);
            ab0 -= mq[1][0] * xy[48]; ab1 -= mq[1][1] * xy[49]; xy[50] = ab0 + ab1; up[6400] = xy[50][0]; wp[6400] = f2bf(-xy[50][1]); mq[1] = *(const LAS f32x4*)(Mg + 3284);
            { const float br = betg[51]; ab0 = (f32x2){bf2f(*(const LAS bf16_t*)(lg + P5_VS + 13872 + c * 2)) * br, bf2f(*(const LAS bf16_t*)(lg + P5_KS + 13872 + c * 2)) * br * __expf(decg[51])}; ab1 = (f32x2){0.f, 0.f}; } ab0 -= mq[2][0] * xy[0]; ab1 -= mq[2][1] * xy[1]; ab0 -= mq[2][2] * xy[2]; ab1 -= mq[2][3] * xy[3]; mq[2] = *(const LAS f32x4*)(Mg + 3288);
            ab0 -= mq[3][0] * xy[4]; ab1 -= mq[3][1] * xy[5]; ab0 -= mq[3][2] * xy[6]; ab1 -= mq[3][3] * xy[7]; mq[3] = *(const LAS f32x4*)(Mg + 3292);
            ab0 -= mq[4][0] * xy[8]; ab1 -= mq[4][1] * xy[9]; ab0 -= mq[4][2] * xy[10]; ab1 -= mq[4][3] * xy[11]; mq[4] = *(const LAS f32x4*)(Mg + 3296);
            ab0 -= mq[5][0] * xy[12]; ab1 -= mq[5][1] * xy[13]; ab0 -= mq[5][2] * xy[14]; ab1 -= mq[5][3] * xy[15]; mq[5] = *(const LAS f32x4*)(Mg + 3300);
            ab0 -= mq[0][0] * xy[16]; ab1 -= mq[0][1] * xy[17]; ab0 -= mq[0][2] * xy[18]; ab1 -= mq[0][3] * xy[19]; mq[0] = *(const LAS f32x4*)(Mg + 3304);
            ab0 -= mq[1][0] * xy[20]; ab1 -= mq[1][1] * xy[21]; ab0 -= mq[1][2] * xy[22]; ab1 -= mq[1][3] * xy[23]; mq[1] = *(const LAS f32x4*)(Mg + 3308);
            ab0 -= mq[2][0] * xy[24]; ab1 -= mq[2][1] * xy[25]; ab0 -= mq[2][2] * xy[26]; ab1 -= mq[2][3] * xy[27]; mq[2] = *(const LAS f32x4*)(Mg + 3312);
            ab0 -= mq[3][0] * xy[28]; ab1 -= mq[3][1] * xy[29]; ab0 -= mq[3][2] * xy[30]; ab1 -= mq[3][3] * xy[31]; mq[3] = *(const LAS f32x4*)(Mg + 3328);
            ab0 -= mq[4][0] * xy[32]; ab1 -= mq[4][1] * xy[33]; ab0 -= mq[4][2] * xy[34]; ab1 -= mq[4][3] * xy[35]; mq[4] = *(const LAS f32x4*)(Mg + 3332);
            ab0 -= mq[5][0] * xy[36]; ab1 -= mq[5][1] * xy[37]; ab0 -= mq[5][2] * xy[38]; ab1 -= mq[5][3] * xy[39]; mq[5] = *(const LAS f32x4*)(Mg + 3336);
            ab0 -= mq[0][0] * xy[40]; ab1 -= mq[0][1] * xy[41]; ab0 -= mq[0][2] * xy[42]; ab1 -= mq[0][3] * xy[43]; mq[0] = *(const LAS f32x4*)(Mg + 3340);
            ab0 -= mq[1][0] * xy[44]; ab1 -= mq[1][1] * xy[45]; ab0 -= mq[1][2] * xy[46]; ab1 -= mq[1][3] * xy[47]; mq[1] = *(const LAS f32x4*)(Mg + 3344);
            ab0 -= mq[2][0] * xy[48]; ab1 -= mq[2][1] * xy[49]; ab0 -= mq[2][2] * xy[50]; xy[51] = ab0 + ab1; up[6528] = xy[51][0]; wp[6528] = f2bf(-xy[51][1]); mq[2] = *(const LAS f32x4*)(Mg + 3348);
            { const float br = betg[52]; ab0 = (f32x2){bf2f(*(const LAS bf16_t*)(lg + P5_VS + 14144 + c * 2)) * br, bf2f(*(const LAS bf16_t*)(lg + P5_KS + 14144 + c * 2)) * br * __expf(decg[52])}; ab1 = (f32x2){0.f, 0.f}; } ab0 -= mq[3][0] * xy[0]; ab1 -= mq[3][1] * xy[1]; ab0 -= mq[3][2] * xy[2]; ab1 -= mq[3][3] * xy[3]; mq[3] = *(const LAS f32x4*)(Mg + 3352);
            ab0 -= mq[4][0] * xy[4]; ab1 -= mq[4][1] * xy[5]; ab0 -= mq[4][2] * xy[6]; ab1 -= mq[4][3] * xy[7]; mq[4] = *(const LAS f32x4*)(Mg + 3356);
            ab0 -= mq[5][0] * xy[8]; ab1 -= mq[5][1] * xy[9]; ab0 -= mq[5][2] * xy[10]; ab1 -= mq[5][3] * xy[11]; mq[5] = *(const LAS f32x4*)(Mg + 3360);
            ab0 -= mq[0][0] * xy[12]; ab1 -= mq[0][1] * xy[13]; ab0 -= mq[0][2] * xy[14]; ab1 -= mq[0][3] * xy[15]; mq[0] = *(const LAS f32x4*)(Mg + 3364);
            ab0 -= mq[1][0] * xy[16]; ab1 -= mq[1][1] * xy[17]; ab0 -= mq[1][2] * xy[18]; ab1 -= mq[1][3] * xy[19]; mq[1] = *(const LAS f32x4*)(Mg + 3368);
            ab0 -= mq[2][0] * xy[20]; ab1 -= mq[2][1] * xy[21]; ab0 -= mq[2][2] * xy[22]; ab1 -= mq[2][3] * xy[23]; mq[2] = *(const LAS f32x4*)(Mg + 3372);
            ab0 -= mq[3][0] * xy[24]; ab1 -= mq[3][1] * xy[25]; ab0 -= mq[3][2] * xy[26]; ab1 -= mq[3][3] * xy[27]; mq[3] = *(const LAS f32x4*)(Mg + 3376);
            ab0 -= mq[4][0] * xy[28]; ab1 -= mq[4][1] * xy[29]; ab0 -= mq[4][2] * xy[30]; ab1 -= mq[4][3] * xy[31]; mq[4] = *(const LAS f32x4*)(Mg + 3392);
            ab0 -= mq[5][0] * xy[32]; ab1 -= mq[5][1] * xy[33]; ab0 -= mq[5][2] * xy[34]; ab1 -= mq[5][3] * xy[35]; mq[5] = *(const LAS f32x4*)(Mg + 3396);
            ab0 -= mq[0][0] * xy[36]; ab1 -= mq[0][1] * xy[37]; ab0 -= mq[0][2] * xy[38]; ab1 -= mq[0][3] * xy[39]; mq[0] = *(const LAS f32x4*)(Mg + 3400);
            ab0 -= mq[1][0] * xy[40]; ab1 -= mq[1][1] * xy[41]; ab0 -= mq[1][2] * xy[42]; ab1 -= mq[1][3] * xy[43]; mq[1] = *(const LAS f32x4*)(Mg + 3404);
            ab0 -= mq[2][0] * xy[44]; ab1 -= mq[2][1] * xy[45]; ab0 -= mq[2][2] * xy[46]; ab1 -= mq[2][3] * xy[47]; mq[2] = *(const LAS f32x4*)(Mg + 3408);
            ab0 -= mq[3][0] * xy[48]; ab1 -= mq[3][1] * xy[49]; ab0 -= mq[3][2] * xy[50]; ab1 -= mq[3][3] * xy[51]; xy[52] = ab0 + ab1; up[6656] = xy[52][0]; wp[6656] = f2bf(-xy[52][1]); mq[3] = *(const LAS f32x4*)(Mg + 3412);
            { const float br = betg[53]; ab0 = (f32x2){bf2f(*(const LAS bf16_t*)(lg + P5_VS + 14416 + c * 2)) * br, bf2f(*(const LAS bf16_t*)(lg + P5_KS + 14416 + c * 2)) * br * __expf(decg[53])}; ab1 = (f32x2){0.f, 0.f}; } ab0 -= mq[4][0] * xy[0]; ab1 -= mq[4][1] * xy[1]; ab0 -= mq[4][2] * xy[2]; ab1 -= mq[4][3] * xy[3]; mq[4] = *(const LAS f32x4*)(Mg + 3416);
            ab0 -= mq[5][0] * xy[4]; ab1 -= mq[5][1] * xy[5]; ab0 -= mq[5][2] * xy[6]; ab1 -= mq[5][3] * xy[7]; mq[5] = *(const LAS f32x4*)(Mg + 3420);
            ab0 -= mq[0][0] * xy[8]; ab1 -= mq[0][1] * xy[9]; ab0 -= mq[0][2] * xy[10]; ab1 -= mq[0][3] * xy[11]; mq[0] = *(const LAS f32x4*)(Mg + 3424);
            ab0 -= mq[1][0] * xy[12]; ab1 -= mq[1][1] * xy[13]; ab0 -= mq[1][2] * xy[14]; ab1 -= mq[1][3] * xy[15]; mq[1] = *(const LAS f32x4*)(Mg + 3428);
            ab0 -= mq[2][0] * xy[16]; ab1 -= mq[2][1] * xy[17]; ab0 -= mq[2][2] * xy[18]; ab1 -= mq[2][3] * xy[19]; mq[2] = *(const LAS f32x4*)(Mg + 3432);
            ab0 -= mq[3][0] * xy[20]; ab1 -= mq[3][1] * xy[21]; ab0 -= mq[3][2] * xy[22]; ab1 -= mq[3][3] * xy[23]; mq[3] = *(const LAS f32x4*)(Mg + 3436);
            ab0 -= mq[4][0] * xy[24]; ab1 -= mq[4][1] * xy[25]; ab0 -= mq[4][2] * xy[26]; ab1 -= mq[4][3] * xy[27]; mq[4] = *(const LAS f32x4*)(Mg + 3440);
            ab0 -= mq[5][0] * xy[28]; ab1 -= mq[5][1] * xy[29]; ab0 -= mq[5][2] * xy[30]; ab1 -= mq[5][3] * xy[31]; mq[5] = *(const LAS f32x4*)(Mg + 3444);
            ab0 -= mq[0][0] * xy[32]; ab1 -= mq[0][1] * xy[33]; ab0 -= mq[0][2] * xy[34]; ab1 -= mq[0][3] * xy[35]; mq[0] = *(const LAS f32x4*)(Mg + 3456);
            ab0 -= mq[1][0] * xy[36]; ab1 -= mq[1][1] * xy[37]; ab0 -= mq[1][2] * xy[38]; ab1 -= mq[1][3] * xy[39]; mq[1] = *(const LAS f32x4*)(Mg + 3460);
            ab0 -= mq[2][0] * xy[40]; ab1 -= mq[2][1] * xy[41]; ab0 -= mq[2][2] * xy[42]; ab1 -= mq[2][3] * xy[43]; mq[2] = *(const LAS f32x4*)(Mg + 3464);
            ab0 -= mq[3][0] * xy[44]; ab1 -= mq[3][1] * xy[45]; ab0 -= mq[3][2] * xy[46]; ab1 -= mq[3][3] * xy[47]; mq[3] = *(const LAS f32x4*)(Mg + 3468);
            ab0 -= mq[4][0] * xy[48]; ab1 -= mq[4][1] * xy[49]; ab0 -= mq[4][2] * xy[50]; ab1 -= mq[4][3] * xy[51]; mq[4] = *(const LAS f32x4*)(Mg + 3472);
            ab0 -= mq[5][0] * xy[52]; xy[53] = ab0 + ab1; up[6784] = xy[53][0]; wp[6784] = f2bf(-xy[53][1]); mq[5] = *(const LAS f32x4*)(Mg + 3476);
            { const float br = betg[54]; ab0 = (f32x2){bf2f(*(const LAS bf16_t*)(lg + P5_VS + 14688 + c * 2)) * br, bf2f(*(const LAS bf16_t*)(lg + P5_KS + 14688 + c * 2)) * br * __expf(decg[54])}; ab1 = (f32x2){0.f, 0.f}; } ab0 -= mq[0][0] * xy[0]; ab1 -= mq[0][1] * xy[1]; ab0 -= mq[0][2] * xy[2]; ab1 -= mq[0][3] * xy[3]; mq[0] = *(const LAS f32x4*)(Mg + 3480);
            ab0 -= mq[1][0] * xy[4]; ab1 -= mq[1][1] * xy[5]; ab0 -= mq[1][2] * xy[6]; ab1 -= mq[1][3] * xy[7]; mq[1] = *(const LAS f32x4*)(Mg + 3484);
            ab0 -= mq[2][0] * xy[8]; ab1 -= mq[2][1] * xy[9]; ab0 -= mq[2][2] * xy[10]; ab1 -= mq[2][3] * xy[11]; mq[2] = *(const LAS f32x4*)(Mg + 3488);
            ab0 -= mq[3][0] * xy[12]; ab1 -= mq[3][1] * xy[13]; ab0 -= mq[3][2] * xy[14]; ab1 -= mq[3][3] * xy[15]; mq[3] = *(const LAS f32x4*)(Mg + 3492);
            ab0 -= mq[4][0] * xy[16]; ab1 -= mq[4][1] * xy[17]; ab0 -= mq[4][2] * xy[18]; ab1 -= mq[4][3] * xy[19]; mq[4] = *(const LAS f32x4*)(Mg + 3496);
            ab0 -= mq[5][0] * xy[20]; ab1 -= mq[5][1] * xy[21]; ab0 -= mq[5][2] * xy[22]; ab1 -= mq[5][3] * xy[23]; mq[5] = *(const LAS f32x4*)(Mg + 3500);
            ab0 -= mq[0][0] * xy[24]; ab1 -= mq[0][1] * xy[25]; ab0 -= mq[0][2] * xy[26]; ab1 -= mq[0][3] * xy[27]; mq[0] = *(const LAS f32x4*)(Mg + 3504);
            ab0 -= mq[1][0] * xy[28]; ab1 -= mq[1][1] * xy[29]; ab0 -= mq[1][2] * xy[30]; ab1 -= mq[1][3] * xy[31]; mq[1] = *(const LAS f32x4*)(Mg + 3508);
            ab0 -= mq[2][0] * xy[32]; ab1 -= mq[2][1] * xy[33]; ab0 -= mq[2][2] * xy[34]; ab1 -= mq[2][3] * xy[35]; mq[2] = *(const LAS f32x4*)(Mg + 3520);
            ab0 -= mq[3][0] * xy[36]; ab1 -= mq[3][1] * xy[37]; ab0 -= mq[3][2] * xy[38]; ab1 -= mq[3][3] * xy[39]; mq[3] = *(const LAS f32x4*)(Mg + 3524);
            ab0 -= mq[4][0] * xy[40]; ab1 -= mq[4][1] * xy[41]; ab0 -= mq[4][2] * xy[42]; ab1 -= mq[4][3] * xy[43]; mq[4] = *(const LAS f32x4*)(Mg + 3528);
            ab0 -= mq[5][0] * xy[44]; ab1 -= mq[5][1] * xy[45]; ab0 -= mq[5][2] * xy[46]; ab1 -= mq[5][3] * xy[47]; mq[5] = *(const LAS f32x4*)(Mg + 3532);
            ab0 -= mq[0][0] * xy[48]; ab1 -= mq[0][1] * xy[49]; ab0 -= mq[0][2] * xy[50]; ab1 -= mq[0][3] * xy[51]; mq[0] = *(const LAS f32x4*)(Mg + 3536);
            ab0 -= mq[1][0] * xy[52]; ab1 -= mq[1][1] * xy[53]; xy[54] = ab0 + ab1; up[6912] = xy[54][0]; wp[6912] = f2bf(-xy[54][1]); mq[1] = *(const LAS f32x4*)(Mg + 3540);
            { const float br = betg[55]; ab0 = (f32x2){bf2f(*(const LAS bf16_t*)(lg + P5_VS + 14960 + c * 2)) * br, bf2f(*(const LAS bf16_t*)(lg + P5_KS + 14960 + c * 2)) * br * __expf(decg[55])}; ab1 = (f32x2){0.f, 0.f}; } ab0 -= mq[2][0] * xy[0]; ab1 -= mq[2][1] * xy[1]; ab0 -= mq[2][2] * xy[2]; ab1 -= mq[2][3] * xy[3]; mq[2] = *(const LAS f32x4*)(Mg + 3544);
            ab0 -= mq[3][0] * xy[4]; ab1 -= mq[3][1] * xy[5]; ab0 -= mq[3][2] * xy[6]; ab1 -= mq[3][3] * xy[7]; mq[3] = *(const LAS f32x4*)(Mg + 3548);
            ab0 -= mq[4][0] * xy[8]; ab1 -= mq[4][1] * xy[9]; ab0 -= mq[4][2] * xy[10]; ab1 -= mq[4][3] * xy[11]; mq[4] = *(const LAS f32x4*)(Mg + 3552);
            ab0 -= mq[5][0] * xy[12]; ab1 -= mq[5][1] * xy[13]; ab0 -= mq[5][2] * xy[14]; ab1 -= mq[5][3] * xy[15]; mq[5] = *(const LAS f32x4*)(Mg + 3556);
            ab0 -= mq[0][0] * xy[16]; ab1 -= mq[0][1] * xy[17]; ab0 -= mq[0][2] * xy[18]; ab1 -= mq[0][3] * xy[19]; mq[0] = *(const LAS f32x4*)(Mg + 3560);
            ab0 -= mq[1][0] * xy[20]; ab1 -= mq[1][1] * xy[21]; ab0 -= mq[1][2] * xy[22]; ab1 -= mq[1][3] * xy[23]; mq[1] = *(const LAS f32x4*)(Mg + 3564);
            ab0 -= mq[2][0] * xy[24]; ab1 -= mq[2][1] * xy[25]; ab0 -= mq[2][2] * xy[26]; ab1 -= mq[2][3] * xy[27]; mq[2] = *(const LAS f32x4*)(Mg + 3568);
            ab0 -= mq[3][0] * xy[28]; ab1 -= mq[3][1] * xy[29]; ab0 -= mq[3][2] * xy[30]; ab1 -= mq[3][3] * xy[31]; mq[3] = *(const LAS f32x4*)(Mg + 3572);
            ab0 -= mq[4][0] * xy[32]; ab1 -= mq[4][1] * xy[33]; ab0 -= mq[4][2] * xy[34]; ab1 -= mq[4][3] * xy[35]; mq[4] = *(const LAS f32x4*)(Mg + 3584);
            ab0 -= mq[5][0] * xy[36]; ab1 -= mq[5][1] * xy[37]; ab0 -= mq[5][2] * xy[38]; ab1 -= mq[5][3] * xy[39]; mq[5] = *(const LAS f32x4*)(Mg + 3588);
            ab0 -= mq[0][0] * xy[40]; ab1 -= mq[0][1] * xy[41]; ab0 -= mq[0][2] * xy[42]; ab1 -= mq[0][3] * xy[43]; mq[0] = *(const LAS f32x4*)(Mg + 3592);
            ab0 -= mq[1][0] * xy[44]; ab1 -= mq[1][1] * xy[45]; ab0 -= mq[1][2] * xy[46]; ab1 -= mq[1][3] * xy[47]; mq[1] = *(const LAS f32x4*)(Mg + 3596);
            ab0 -= mq[2][0] * xy[48]; ab1 -= mq[2][1] * xy[49]; ab0 -= mq[2][2] * xy[50]; ab1 -= mq[2][3] * xy[51]; mq[2] = *(const LAS f32x4*)(Mg + 3600);
            ab0 -= mq[3][0] * xy[52]; ab1 -= mq[3][1] * xy[53]; ab0 -= mq[3][2] * xy[54]; xy[55] = ab0 + ab1; up[7040] = xy[55][0]; wp[7040] = f2bf(-xy[55][1]); mq[3] = *(const LAS f32x4*)(Mg + 3604);
            { const float br = betg[56]; ab0 = (f32x2){bf2f(*(const LAS bf16_t*)(lg + P5_VS + 15232 + c * 2)) * br, bf2f(*(const LAS bf16_t*)(lg + P5_KS + 15232 + c * 2)) * br * __expf(decg[56])}; ab1 = (f32x2){0.f, 0.f}; } ab0 -= mq[4][0] * xy[0]; ab1 -= mq[4][1] * xy[1]; ab0 -= mq[4][2] * xy[2]; ab1 -= mq[4][3] * xy[3]; mq[4] = *(const LAS f32x4*)(Mg + 3608);
            ab0 -= mq[5][0] * xy[4]; ab1 -= mq[5][1] * xy[5]; ab0 -= mq[5][2] * xy[6]; ab1 -= mq[5][3] * xy[7]; mq[5] = *(const LAS f32x4*)(Mg + 3612);
            ab0 -= mq[0][0] * xy[8]; ab1 -= mq[0][1] * xy[9]; ab0 -= mq[0][2] * xy[10]; ab1 -= mq[0][3] * xy[11]; mq[0] = *(const LAS f32x4*)(Mg + 3616);
            ab0 -= mq[1][0] * xy[12]; ab1 -= mq[1][1] * xy[13]; ab0 -= mq[1][2] * xy[14]; ab1 -= mq[1][3] * xy[15]; mq[1] = *(const LAS f32x4*)(Mg + 3620);
            ab0 -= mq[2][0] * xy[16]; ab1 -= mq[2][1] * xy[17]; ab0 -= mq[2][2] * xy[18]; ab1 -= mq[2][3] * xy[19]; mq[2] = *(const LAS f32x4*)(Mg + 3624);
            ab0 -= mq[3][0] * xy[20]; ab1 -= mq[3][1] * xy[21]; ab0 -= mq[3][2] * xy[22]; ab1 -= mq[3][3] * xy[23]; mq[3] = *(const LAS f32x4*)(Mg + 3628);
            ab0 -= mq[4][0] * xy[24]; ab1 -= mq[4][1] * xy[25]; ab0 -= mq[4][2] * xy[26]; ab1 -= mq[4][3] * xy[27]; mq[4] = *(const LAS f32x4*)(Mg + 3632);
            ab0 -= mq[5][0] * xy[28]; ab1 -= mq[5][1] * xy[29]; ab0 -= mq[5][2] * xy[30]; ab1 -= mq[5][3] * xy[31]; mq[5] = *(const LAS f32x4*)(Mg + 3636);
            ab0 -= mq[0][0] * xy[32]; ab1 -= mq[0][1] * xy[33]; ab0 -= mq[0][2] * xy[34]; ab1 -= mq[0][3] * xy[35]; mq[0] = *(const LAS f32x4*)(Mg + 3648);
            ab0 -= mq[1][0] * xy[36]; ab1 -= mq[1][1] * xy[37]; ab0 -= mq[1][2] * xy[38]; ab1 -= mq[1][3] * xy[39]; mq[1] = *(const LAS f32x4*)(Mg + 3652);
            ab0 -= mq[2][0] * xy[40]; ab1 -= mq[2][1] * xy[41]; ab0 -= mq[2][2] * xy[42]; ab1 -= mq[2][3] * xy[43]; mq[2] = *(const LAS f32x4*)(Mg + 3656);
            ab0 -= mq[3][0] * xy[44]; ab1 -= mq[3][1] * xy[45]; ab0 -= mq[3][2] * xy[46]; ab1 -= mq[3][3] * xy[47]; mq[3] = *(const LAS f32x4*)(Mg + 3660);
            ab0 -= mq[4][0] * xy[48]; ab1 -= mq[4][1] * xy[49]; ab0 -= mq[4][2] * xy[50]; ab1 -= mq[4][3] * xy[51]; mq[4] = *(const LAS f32x4*)(Mg + 3664);
            ab0 -= mq[5][0] * xy[52]; ab1 -= mq[5][1] * xy[53]; ab0 -= mq[5][2] * xy[54]; ab1 -= mq[5][3] * xy[55]; xy[56] = ab0 + ab1; up[7168] = xy[56][0]; wp[7168] = f2bf(-xy[56][1]); mq[5] = *(const LAS f32x4*)(Mg + 3668);
            { const float br = betg[57]; ab0 = (f32x2){bf2f(*(const LAS bf16_t*)(lg + P5_VS + 15504 + c * 2)) * br, bf2f(*(const LAS bf16_t*)(lg + P5_KS + 15504 + c * 2)) * br * __expf(decg[57])}; ab1 = (f32x2){0.f, 0.f}; } ab0 -= mq[0][0] * xy[0]; ab1 -= mq[0][1] * xy[1]; ab0 -= mq[0][2] * xy[2]; ab1 -= mq[0][3] * xy[3]; mq[0] = *(const LAS f32x4*)(Mg + 3672);
            ab0 -= mq[1][0] * xy[4]; ab1 -= mq[1][1] * xy[5]; ab0 -= mq[1][2] * xy[6]; ab1 -= mq[1][3] * xy[7]; mq[1] = *(const LAS f32x4*)(Mg + 3676);
            ab0 -= mq[2][0] * xy[8]; ab1 -= mq[2][1] * xy[9]; ab0 -= mq[2][2] * xy[10]; ab1 -= mq[2][3] * xy[11]; mq[2] = *(const LAS f32x4*)(Mg + 3680);
            ab0 -= mq[3][0] * xy[12]; ab1 -= mq[3][1] * xy[13]; ab0 -= mq[3][2] * xy[14]; ab1 -= mq[3][3] * xy[15]; mq[3] = *(const LAS f32x4*)(Mg + 3684);
            ab0 -= mq[4][0] * xy[16]; ab1 -= mq[4][1] * xy[17]; ab0 -= mq[4][2] * xy[18]; ab1 -= mq[4][3] * xy[19]; mq[4] = *(const LAS f32x4*)(Mg + 3688);
            ab0 -= mq[5][0] * xy[20]; ab1 -= mq[5][1] * xy[21]; ab0 -= mq[5][2] * xy[22]; ab1 -= mq[5][3] * xy[23]; mq[5] = *(const LAS f32x4*)(Mg + 3692);
            ab0 -= mq[0][0] * xy[24]; ab1 -= mq[0][1] * xy[25]; ab0 -= mq[0][2] * xy[26]; ab1 -= mq[0][3] * xy[27]; mq[0] = *(const LAS f32x4*)(Mg + 3696);
            ab0 -= mq[1][0] * xy[28]; ab1 -= mq[1][1] * xy[29]; ab0 -= mq[1][2] * xy[30]; ab1 -= mq[1][3] * xy[31]; mq[1] = *(const LAS f32x4*)(Mg + 3700);
            ab0 -= mq[2][0] * xy[32]; ab1 -= mq[2][1] * xy[33]; ab0 -= mq[2][2] * xy[34]; ab1 -= mq[2][3] * xy[35]; mq[2] = *(const LAS f32x4*)(Mg + 3704);
            ab0 -= mq[3][0] * xy[36]; ab1 -= mq[3][1] * xy[37]; ab0 -= mq[3][2] * xy[38]; ab1 -= mq[3][3] * xy[39]; mq[3] = *(const LAS f32x4*)(Mg + 3712);
            ab0 -= mq[4][0] * xy[40]; ab1 -= mq[4][1] * xy[41]; ab0 -= mq[4][2] * xy[42]; ab1 -= mq[4][3] * xy[43]; mq[4] = *(const LAS f32x4*)(Mg + 3716);
            ab0 -= mq[5][0] * xy[44]; ab1 -= mq[5][1] * xy[45]; ab0 -= mq[5][2] * xy[46]; ab1 -= mq[5][3] * xy[47]; mq[5] = *(const LAS f32x4*)(Mg + 3720);
            ab0 -= mq[0][0] * xy[48]; ab1 -= mq[0][1] * xy[49]; ab0 -= mq[0][2] * xy[50]; ab1 -= mq[0][3] * xy[51]; mq[0] = *(const LAS f32x4*)(Mg + 3724);
            ab0 -= mq[1][0] * xy[52]; ab1 -= mq[1][1] * xy[53]; ab0 -= mq[1][2] * xy[54]; ab1 -= mq[1][3] * xy[55]; mq[1] = *(const LAS f32x4*)(Mg + 3728);
            ab0 -= mq[2][0] * xy[56]; xy[57] = ab0 + ab1; up[7296] = xy[57][0]; wp[7296] = f2bf(-xy[57][1]); mq[2] = *(const LAS f32x4*)(Mg + 3732);
            { const float br = betg[58]; ab0 = (f32x2){bf2f(*(const LAS bf16_t*)(lg + P5_VS + 15776 + c * 2)) * br, bf2f(*(const LAS bf16_t*)(lg + P5_KS + 15776 + c * 2)) * br * __expf(decg[58])}; ab1 = (f32x2){0.f, 0.f}; } ab0 -= mq[3][0] * xy[0]; ab1 -= mq[3][1] * xy[1]; ab0 -= mq[3][2] * xy[2]; ab1 -= mq[3][3] * xy[3]; mq[3] = *(const LAS f32x4*)(Mg + 3736);
            ab0 -= mq[4][0] * xy[4]; ab1 -= mq[4][1] * xy[5]; ab0 -= mq[4][2] * xy[6]; ab1 -= mq[4][3] * xy[7]; mq[4] = *(const LAS f32x4*)(Mg + 3740);
            ab0 -= mq[5][0] * xy[8]; ab1 -= mq[5][1] * xy[9]; ab0 -= mq[5][2] * xy[10]; ab1 -= mq[5][3] * xy[11]; mq[5] = *(const LAS f32x4*)(Mg + 3744);
            ab0 -= mq[0][0] * xy[12]; ab1 -= mq[0][1] * xy[13]; ab0 -= mq[0][2] * xy[14]; ab1 -= mq[0][3] * xy[15]; mq[0] = *(const LAS f32x4*)(Mg + 3748);
            ab0 -= mq[1][0] * xy[16]; ab1 -= mq[1][1] * xy[17]; ab0 -= mq[1][2] * xy[18]; ab1 -= mq[1][3] * xy[19]; mq[1] = *(const LAS f32x4*)(Mg + 3752);
            ab0 -= mq[2][0] * xy[20]; ab1 -= mq[2][1] * xy[21]; ab0 -= mq[2][2] * xy[22]; ab1 -= mq[2][3] * xy[23]; mq[2] = *(const LAS f32x4*)(Mg + 3756);
            ab0 -= mq[3][0] * xy[24]; ab1 -= mq[3][1] * xy[25]; ab0 -= mq[3][2] * xy[26]; ab1 -= mq[3][3] * xy[27]; mq[3] = *(const LAS f32x4*)(Mg + 3760);
            ab0 -= mq[4][0] * xy[28]; ab1 -= mq[4][1] * xy[29]; ab0 -= mq[4][2] * xy[30]; ab1 -= mq[4][3] * xy[31]; mq[4] = *(const LAS f32x4*)(Mg + 3764);
            ab0 -= mq[5][0] * xy[32]; ab1 -= mq[5][1] * xy[33]; ab0 -= mq[5][2] * xy[34]; ab1 -= mq[5][3] * xy[35]; mq[5] = *(const LAS f32x4*)(Mg + 3768);
            ab0 -= mq[0][0] * xy[36]; ab1 -= mq[0][1] * xy[37]; ab0 -= mq[0][2] * xy[38]; ab1 -= mq[0][3] * xy[39]; mq[0] = *(const LAS f32x4*)(Mg + 3776);
            ab0 -= mq[1][0] * xy[40]; ab1 -= mq[1][1] * xy[41]; ab0 -= mq[1][2] * xy[42]; ab1 -= mq[1][3] * xy[43]; mq[1] = *(const LAS f32x4*)(Mg + 3780);
            ab0 -= mq[2][0] * xy[44]; ab1 -= mq[2][1] * xy[45]; ab0 -= mq[2][2] * xy[46]; ab1 -= mq[2][3] * xy[47]; mq[2] = *(const LAS f32x4*)(Mg + 3784);
            ab0 -= mq[3][0] * xy[48]; ab1 -= mq[3][1] * xy[49]; ab0 -= mq[3][2] * xy[50]; ab1 -= mq[3][3] * xy[51]; mq[3] = *(const LAS f32x4*)(Mg + 3788);
            ab0 -= mq[4][0] * xy[52]; ab1 -= mq[4][1] * xy[53]; ab0 -= mq[4][2] * xy[54]; ab1 -= mq[4][3] * xy[55]; mq[4] = *(const LAS f32x4*)(Mg + 3792);
            ab0 -= mq[5][0] * xy[56]; ab1 -= mq[5][1] * xy[57]; xy[58] = ab0 + ab1; up[7424] = xy[58][0]; wp[7424] = f2bf(-xy[58][1]); mq[5] = *(const LAS f32x4*)(Mg + 3796);
            { const float br = betg[59]; ab0 = (f32x2){bf2f(*(const LAS bf16_t*)(lg + P5_VS + 16048 + c * 2)) * br, bf2f(*(const LAS bf16_t*)(lg + P5_KS + 16048 + c * 2)) * br * __expf(decg[59])}; ab1 = (f32x2){0.f, 0.f}; } ab0 -= mq[0][0] * xy[0]; ab1 -= mq[0][1] * xy[1]; ab0 -= mq[0][2] * xy[2]; ab1 -= mq[0][3] * xy[3]; mq[0] = *(const LAS f32x4*)(Mg + 3800);
            ab0 -= mq[1][0] * xy[4]; ab1 -= mq[1][1] * xy[5]; ab0 -= mq[1][2] * xy[6]; ab1 -= mq[1][3] * xy[7]; mq[1] = *(const LAS f32x4*)(Mg + 3804);
            ab0 -= mq[2][0] * xy[8]; ab1 -= mq[2][1] * xy[9]; ab0 -= mq[2][2] * xy[10]; ab1 -= mq[2][3] * xy[11]; mq[2] = *(const LAS f32x4*)(Mg + 3808);
            ab0 -= mq[3][0] * xy[12]; ab1 -= mq[3][1] * xy[13]; ab0 -= mq[3][2] * xy[14]; ab1 -= mq[3][3] * xy[15]; mq[3] = *(const LAS f32x4*)(Mg + 3812);
            ab0 -= mq[4][0] * xy[16]; ab1 -= mq[4][1] * xy[17]; ab0 -= mq[4][2] * xy[18]; ab1 -= mq[4][3] * xy[19]; mq[4] = *(const LAS f32x4*)(Mg + 3816);
            ab0 -= mq[5][0] * xy[20]; ab1 -= mq[5][1] * xy[21]; ab0 -= mq[5][2] * xy[22]; ab1 -= mq[5][3] * xy[23]; mq[5] = *(const LAS f32x4*)(Mg + 3820);
            ab0 -= mq[0][0] * xy[24]; ab1 -= mq[0][1] * xy[25]; ab0 -= mq[0][2] * xy[26]; ab1 -= mq[0][3] * xy[27]; mq[0] = *(const LAS f32x4*)(Mg + 3824);
            ab0 -= mq[1][0] * xy[28]; ab1 -= mq[1][1] * xy[29]; ab0 -= mq[1][2] * xy[30]; ab1 -= mq[1][3] * xy[31]; mq[1] = *(const LAS f32x4*)(Mg + 3828);
            ab0 -= mq[2][0] * xy[32]; ab1 -= mq[2][1] * xy[33]; ab0 -= mq[2][2] * xy[34]; ab1 -= mq[2][3] * xy[35]; mq[2] = *(const LAS f32x4*)(Mg + 3832);
            ab0 -= mq[3][0] * xy[36]; ab1 -= mq[3][1] * xy[37]; ab0 -= mq[3][2] * xy[38]; ab1 -= mq[3][3] * xy[39]; mq[3] = *(const LAS f32x4*)(Mg + 3840);
            ab0 -= mq[4][0] * xy[40]; ab1 -= mq[4][1] * xy[41]; ab0 -= mq[4][2] * xy[42]; ab1 -= mq[4][3] * xy[43]; mq[4] = *(const LAS f32x4*)(Mg + 3844);
            ab0 -= mq[5][0] * xy[44]; ab1 -= mq[5][1] * xy[45]; ab0 -= mq[5][2] * xy[46]; ab1 -= mq[5][3] * xy[47]; mq[5] = *(const LAS f32x4*)(Mg + 3848);
            ab0 -= mq[0][0] * xy[48]; ab1 -= mq[0][1] * xy[49]; ab0 -= mq[0][2] * xy[50]; ab1 -= mq[0][3] * xy[51]; mq[0] = *(const LAS f32x4*)(Mg + 3852);
            ab0 -= mq[1][0] * xy[52]; ab1 -= mq[1][1] * xy[53]; ab0 -= mq[1][2] * xy[54]; ab1 -= mq[1][3] * xy[55]; mq[1] = *(const LAS f32x4*)(Mg + 3856);
            ab0 -= mq[2][0] * xy[56]; ab1 -= mq[2][1] * xy[57]; ab0 -= mq[2][2] * xy[58]; xy[59] = ab0 + ab1; up[7552] = xy[59][0]; wp[7552] = f2bf(-xy[59][1]); mq[2] = *(const LAS f32x4*)(Mg + 3860);
            { const float br = betg[60]; ab0 = (f32x2){bf2f(*(const LAS bf16_t*)(lg + P5_VS + 16320 + c * 2)) * br, bf2f(*(const LAS bf16_t*)(lg + P5_KS + 16320 + c * 2)) * br * __expf(decg[60])}; ab1 = (f32x2){0.f, 0.f}; } ab0 -= mq[3][0] * xy[0]; ab1 -= mq[3][1] * xy[1]; ab0 -= mq[3][2] * xy[2]; ab1 -= mq[3][3] * xy[3]; mq[3] = *(const LAS f32x4*)(Mg + 3864);
            ab0 -= mq[4][0] * xy[4]; ab1 -= mq[4][1] * xy[5]; ab0 -= mq[4][2] * xy[6]; ab1 -= mq[4][3] * xy[7]; mq[4] = *(const LAS f32x4*)(Mg + 3868);
            ab0 -= mq[5][0] * xy[8]; ab1 -= mq[5][1] * xy[9]; ab0 -= mq[5][2] * xy[10]; ab1 -= mq[5][3] * xy[11]; mq[5] = *(const LAS f32x4*)(Mg + 3872);
            ab0 -= mq[0][0] * xy[12]; ab1 -= mq[0][1] * xy[13]; ab0 -= mq[0][2] * xy[14]; ab1 -= mq[0][3] * xy[15]; mq[0] = *(const LAS f32x4*)(Mg + 3876);
            ab0 -= mq[1][0] * xy[16]; ab1 -= mq[1][1] * xy[17]; ab0 -= mq[1][2] * xy[18]; ab1 -= mq[1][3] * xy[19]; mq[1] = *(const LAS f32x4*)(Mg + 3880);
            ab0 -= mq[2][0] * xy[20]; ab1 -= mq[2][1] * xy[21]; ab0 -= mq[2][2] * xy[22]; ab1 -= mq[2][3] * xy[23]; mq[2] = *(const LAS f32x4*)(Mg + 3884);
            ab0 -= mq[3][0] * xy[24]; ab1 -= mq[3][1] * xy[25]; ab0 -= mq[3][2] * xy[26]; ab1 -= mq[3][3] * xy[27]; mq[3] = *(const LAS f32x4*)(Mg + 3888);
            ab0 -= mq[4][0] * xy[28]; ab1 -= mq[4][1] * xy[29]; ab0 -= mq[4][2] * xy[30]; ab1 -= mq[4][3] * xy[31]; mq[4] = *(const LAS f32x4*)(Mg + 3892);
            ab0 -= mq[5][0] * xy[32]; ab1 -= mq[5][1] * xy[33]; ab0 -= mq[5][2] * xy[34]; ab1 -= mq[5][3] * xy[35]; mq[5] = *(const LAS f32x4*)(Mg + 3896);
            ab0 -= mq[0][0] * xy[36]; ab1 -= mq[0][1] * xy[37]; ab0 -= mq[0][2] * xy[38]; ab1 -= mq[0][3] * xy[39]; mq[0] = *(const LAS f32x4*)(Mg + 3904);
            ab0 -= mq[1][0] * xy[40]; ab1 -= mq[1][1] * xy[41]; ab0 -= mq[1][2] * xy[42]; ab1 -= mq[1][3] * xy[43]; mq[1] = *(const LAS f32x4*)(Mg + 3908);
            ab0 -= mq[2][0] * xy[44]; ab1 -= mq[2][1] * xy[45]; ab0 -= mq[2][2] * xy[46]; ab1 -= mq[2][3] * xy[47]; mq[2] = *(const LAS f32x4*)(Mg + 3912);
            ab0 -= mq[3][0] * xy[48]; ab1 -= mq[3][1] * xy[49]; ab0 -= mq[3][2] * xy[50]; ab1 -= mq[3][3] * xy[51]; mq[3] = *(const LAS f32x4*)(Mg + 3916);
            ab0 -= mq[4][0] * xy[52]; ab1 -= mq[4][1] * xy[53]; ab0 -= mq[4][2] * xy[54]; ab1 -= mq[4][3] * xy[55]; mq[4] = *(const LAS f32x4*)(Mg + 3920);
            ab0 -= mq[5][0] * xy[56]; ab1 -= mq[5][1] * xy[57]; ab0 -= mq[5][2] * xy[58]; ab1 -= mq[5][3] * xy[59]; xy[60] = ab0 + ab1; up[7680] = xy[60][0]; wp[7680] = f2bf(-xy[60][1]); mq[5] = *(const LAS f32x4*)(Mg + 3924);
            { const float br = betg[61]; ab0 = (f32x2){bf2f(*(const LAS bf16_t*)(lg + P5_VS + 16592 + c * 2)) * br, bf2f(*(const LAS bf16_t*)(lg + P5_KS + 16592 + c * 2)) * br * __expf(decg[61])}; ab1 = (f32x2){0.f, 0.f}; } ab0 -= mq[0][0] * xy[0]; ab1 -= mq[0][1] * xy[1]; ab0 -= mq[0][2] * xy[2]; ab1 -= mq[0][3] * xy[3]; mq[0] = *(const LAS f32x4*)(Mg + 3928);
            ab0 -= mq[1][0] * xy[4]; ab1 -= mq[1][1] * xy[5]; ab0 -= mq[1][2] * xy[6]; ab1 -= mq[1][3] * xy[7]; mq[1] = *(const LAS f32x4*)(Mg + 3932);
            ab0 -= mq[2][0] * xy[8]; ab1 -= mq[2][1] * xy[9]; ab0 -= mq[2][2] * xy[10]; ab1 -= mq[2][3] * xy[11]; mq[2] = *(const LAS f32x4*)(Mg + 3936);
            ab0 -= mq[3][0] * xy[12]; ab1 -= mq[3][1] * xy[13]; ab0 -= mq[3][2] * xy[14]; ab1 -= mq[3][3] * xy[15]; mq[3] = *(const LAS f32x4*)(Mg + 3940);
            ab0 -= mq[4][0] * xy[16]; ab1 -= mq[4][1] * xy[17]; ab0 -= mq[4][2] * xy[18]; ab1 -= mq[4][3] * xy[19]; mq[4] = *(const LAS f32x4*)(Mg + 3944);
            ab0 -= mq[5][0] * xy[20]; ab1 -= mq[5][1] * xy[21]; ab0 -= mq[5][2] * xy[22]; ab1 -= mq[5][3] * xy[23]; mq[5] = *(const LAS f32x4*)(Mg + 3948);
            ab0 -= mq[0][0] * xy[24]; ab1 -= mq[0][1] * xy[25]; ab0 -= mq[0][2] * xy[26]; ab1 -= mq[0][3] * xy[27]; mq[0] = *(const LAS f32x4*)(Mg + 3952);
            ab0 -= mq[1][0] * xy[28]; ab1 -= mq[1][1] * xy[29]; ab0 -= mq[1][2] * xy[30]; ab1 -= mq[1][3] * xy[31]; mq[1] = *(const LAS f32x4*)(Mg + 3956);
            ab0 -= mq[2][0] * xy[32]; ab1 -= mq[2][1] * xy[33]; ab0 -= mq[2][2] * xy[34]; ab1 -= mq[2][3] * xy[35]; mq[2] = *(const LAS f32x4*)(Mg + 3960);
            ab0 -= mq[3][0] * xy[36]; ab1 -= mq[3][1] * xy[37]; ab0 -= mq[3][2] * xy[38]; ab1 -= mq[3][3] * xy[39]; mq[3] = *(const LAS f32x4*)(Mg + 3964);
            ab0 -= mq[4][0] * xy[40]; ab1 -= mq[4][1] * xy[41]; ab0 -= mq[4][2] * xy[42]; ab1 -= mq[4][3] * xy[43]; mq[4] = *(const LAS f32x4*)(Mg + 3968);
            ab0 -= mq[5][0] * xy[44]; ab1 -= mq[5][1] * xy[45]; ab0 -= mq[5][2] * xy[46]; ab1 -= mq[5][3] * xy[47]; mq[5] = *(const LAS f32x4*)(Mg + 3972);
            ab0 -= mq[0][0] * xy[48]; ab1 -= mq[0][1] * xy[49]; ab0 -= mq[0][2] * xy[50]; ab1 -= mq[0][3] * xy[51]; mq[0] = *(const LAS f32x4*)(Mg + 3976);
            ab0 -= mq[1][0] * xy[52]; ab1 -= mq[1][1] * xy[53]; ab0 -= mq[1][2] * xy[54]; ab1 -= mq[1][3] * xy[55]; mq[1] = *(const LAS f32x4*)(Mg + 3980);
            ab0 -= mq[2][0] * xy[56]; ab1 -= mq[2][1] * xy[57]; ab0 -= mq[2][2] * xy[58]; ab1 -= mq[2][3] * xy[59]; mq[2] = *(const LAS f32x4*)(Mg + 3984);
            ab0 -= mq[3][0] * xy[60]; xy[61] = ab0 + ab1; up[7808] = xy[61][0]; wp[7808] = f2bf(-xy[61][1]); mq[3] = *(const LAS f32x4*)(Mg + 3988);
            { const float br = betg[62]; ab0 = (f32x2){bf2f(*(const LAS bf16_t*)(lg + P5_VS + 16864 + c * 2)) * br, bf2f(*(const LAS bf16_t*)(lg + P5_KS + 16864 + c * 2)) * br * __expf(decg[62])}; ab1 = (f32x2){0.f, 0.f}; } ab0 -= mq[4][0] * xy[0]; ab1 -= mq[4][1] * xy[1]; ab0 -= mq[4][2] * xy[2]; ab1 -= mq[4][3] * xy[3]; mq[4] = *(const LAS f32x4*)(Mg + 3992);
            ab0 -= mq[5][0] * xy[4]; ab1 -= mq[5][1] * xy[5]; ab0 -= mq[5][2] * xy[6]; ab1 -= mq[5][3] * xy[7]; mq[5] = *(const LAS f32x4*)(Mg + 3996);
            ab0 -= mq[0][0] * xy[8]; ab1 -= mq[0][1] * xy[9]; ab0 -= mq[0][2] * xy[10]; ab1 -= mq[0][3] * xy[11]; mq[0] = *(const LAS f32x4*)(Mg + 4000);
            ab0 -= mq[1][0] * xy[12]; ab1 -= mq[1][1] * xy[13]; ab0 -= mq[1][2] * xy[14]; ab1 -= mq[1][3] * xy[15]; mq[1] = *(const LAS f32x4*)(Mg + 4004);
            ab0 -= mq[2][0] * xy[16]; ab1 -= mq[2][1] * xy[17]; ab0 -= mq[2][2] * xy[18]; ab1 -= mq[2][3] * xy[19]; mq[2] = *(const LAS f32x4*)(Mg + 4008);
            ab0 -= mq[3][0] * xy[20]; ab1 -= mq[3][1] * xy[21]; ab0 -= mq[3][2] * xy[22]; ab1 -= mq[3][3] * xy[23]; mq[3] = *(const LAS f32x4*)(Mg + 4012);
            ab0 -= mq[4][0] * xy[24]; ab1 -= mq[4][1] * xy[25]; ab0 -= mq[4][2] * xy[26]; ab1 -= mq[4][3] * xy[27]; mq[4] = *(const LAS f32x4*)(Mg + 4016);
            ab0 -= mq[5][0] * xy[28]; ab1 -= mq[5][1] * xy[29]; ab0 -= mq[5][2] * xy[30]; ab1 -= mq[5][3] * xy[31]; mq[5] = *(const LAS f32x4*)(Mg + 4020);
            ab0 -= mq[0][0] * xy[32]; ab1 -= mq[0][1] * xy[33]; ab0 -= mq[0][2] * xy[34]; ab1 -= mq[0][3] * xy[35]; mq[0] = *(const LAS f32x4*)(Mg + 4024);
            ab0 -= mq[1][0] * xy[36]; ab1 -= mq[1][1] * xy[37]; ab0 -= mq[1][2] * xy[38]; ab1 -= mq[1][3] * xy[39]; mq[1] = *(const LAS f32x4*)(Mg + 4028);
            ab0 -= mq[2][0] * xy[40]; ab1 -= mq[2][1] * xy[41]; ab0 -= mq[2][2] * xy[42]; ab1 -= mq[2][3] * xy[43]; mq[2] = *(const LAS f32x4*)(Mg + 4032);
            ab0 -= mq[3][0] * xy[44]; ab1 -= mq[3][1] * xy[45]; ab0 -= mq[3][2] * xy[46]; ab1 -= mq[3][3] * xy[47]; mq[3] = *(const LAS f32x4*)(Mg + 4036);
            ab0 -= mq[4][0] * xy[48]; ab1 -= mq[4][1] * xy[49]; ab0 -= mq[4][2] * xy[50]; ab1 -= mq[4][3] * xy[51]; mq[4] = *(const LAS f32x4*)(Mg + 4040);
            ab0 -= mq[5][0] * xy[52]; ab1 -= mq[5][1] * xy[53]; ab0 -= mq[5][2] * xy[54]; ab1 -= mq[5][3] * xy[55]; mq[5] = *(const LAS f32x4*)(Mg + 4044);
            ab0 -= mq[0][0] * xy[56]; ab1 -= mq[0][1] * xy[57]; ab0 -= mq[0][2] * xy[58]; ab1 -= mq[0][3] * xy[59]; mq[0] = *(const LAS f32x4*)(Mg + 4048);
            ab0 -= mq[1][0] * xy[60]; ab1 -= mq[1][1] * xy[61]; xy[62] = ab0 + ab1; up[7936] = xy[62][0]; wp[7936] = f2bf(-xy[62][1]); mq[1] = *(const LAS f32x4*)(Mg + 4052);
            { const float br = betg[63]; ab0 = (f32x2){bf2f(*(const LAS bf16_t*)(lg + P5_VS + 17136 + c * 2)) * br, bf2f(*(const LAS bf16_t*)(lg + P5_KS + 17136 + c * 2)) * br * __expf(decg[63])}; ab1 = (f32x2){0.f, 0.f}; } ab0 -= mq[2][0] * xy[0]; ab1 -= mq[2][1] * xy[1]; ab0 -= mq[2][2] * xy[2]; ab1 -= mq[2][3] * xy[3]; mq[2] = *(const LAS f32x4*)(Mg + 4056);
            ab0 -= mq[3][0] * xy[4]; ab1 -= mq[3][1] * xy[5]; ab0 -= mq[3][2] * xy[6]; ab1 -= mq[3][3] * xy[7]; mq[3] = *(const LAS f32x4*)(Mg + 4060);
            ab0 -= mq[4][0] * xy[8]; ab1 -= mq[4][1] * xy[9]; ab0 -= mq[4][2] * xy[10]; ab1 -= mq[4][3] * xy[11]; mq[4] = *(const LAS f32x4*)(Mg + 4064);
            ab0 -= mq[5][0] * xy[12]; ab1 -= mq[5][1] * xy[13]; ab0 -= mq[5][2] * xy[14]; ab1 -= mq[5][3] * xy[15]; mq[5] = *(const LAS f32x4*)(Mg + 4068);
            ab0 -= mq[0][0] * xy[16]; ab1 -= mq[0][1] * xy[17]; ab0 -= mq[0][2] * xy[18]; ab1 -= mq[0][3] * xy[19]; mq[0] = *(const LAS f32x4*)(Mg + 4072);
            ab0 -= mq[1][0] * xy[20]; ab1 -= mq[1][1] * xy[21]; ab0 -= mq[1][2] * xy[22]; ab1 -= mq[1][3] * xy[23]; mq[1] = *(const LAS f32x4*)(Mg + 4076);
            ab0 -= mq[2][0] * xy[24]; ab1 -= mq[2][1] * xy[25]; ab0 -= mq[2][2] * xy[26]; ab1 -= mq[2][3] * xy[27]; mq[2] = *(const LAS f32x4*)(Mg + 4080);
            ab0 -= mq[3][0] * xy[28]; ab1 -= mq[3][1] * xy[29]; ab0 -= mq[3][2] * xy[30]; ab1 -= mq[3][3] * xy[31]; mq[3] = *(const LAS f32x4*)(Mg + 4084);
            ab0 -= mq[4][0] * xy[32]; ab1 -= mq[4][1] * xy[33]; ab0 -= mq[4][2] * xy[34]; ab1 -= mq[4][3] * xy[35]; mq[4] = *(const LAS f32x4*)(Mg + 4088);
            ab0 -= mq[5][0] * xy[36]; ab1 -= mq[5][1] * xy[37]; ab0 -= mq[5][2] * xy[38]; ab1 -= mq[5][3] * xy[39]; mq[5] = *(const LAS f32x4*)(Mg + 4092);
            ab0 -= mq[0][0] * xy[40]; ab1 -= mq[0][1] * xy[41]; ab0 -= mq[0][2] * xy[42]; ab1 -= mq[0][3] * xy[43];
            ab0 -= mq[1][0] * xy[44]; ab1 -= mq[1][1] * xy[45]; ab0 -= mq[1][2] * xy[46]; ab1 -= mq[1][3] * xy[47];
            ab0 -= mq[2][0] * xy[48]; ab1 -= mq[2][1] * xy[49]; ab0 -= mq[2][2] * xy[50]; ab1 -= mq[2][3] * xy[51];
            ab0 -= mq[3][0] * xy[52]; ab1 -= mq[3][1] * xy[53]; ab0 -= mq[3][2] * xy[54]; ab1 -= mq[3][3] * xy[55];
            ab0 -= mq[4][0] * xy[56]; ab1 -= mq[4][1] * xy[57]; ab0 -= mq[4][2] * xy[58]; ab1 -= mq[4][3] * xy[59];
            ab0 -= mq[5][0] * xy[60]; ab1 -= mq[5][1] * xy[61]; ab0 -= mq[5][2] * xy[62]; xy[63] = ab0 + ab1; up[8064] = xy[63][0]; wp[8064] = f2bf(-xy[63][1]);
        } else {
            const int g2 = (w8 - 4) >> 1, tt = ((w8 - 4) & 1) * 64 + lane; const int item2 = it0 + g2;
            LAS unsigned char* lg = lds0 + g2 * P5_GRP; LAS float* decg = (LAS float*)(lg + P5_DEC);
            const float lastg = decg[63];
#pragma unroll
            for (int i = 0; i < 8; ++i) { const int vid = tt + 128 * i, r = vid >> 4, d0 = (vid & 15) * 8; float f[8]; unpack8(*(const LAS u32x4*)(lg + P5_QS + r * 272 + d0 * 2), f);
                const float e = scale * __expf(decg[r]);
#pragma unroll
                for (int q = 0; q < 8; ++q) f[q] *= e;
                *(u32x4*)(qd + (size_t)item2 * 8192 + r * 128 + d0) = pack8(f); }
#pragma unroll
            for (int i = 0; i < 8; ++i) { const int vid = tt + 128 * i, d = vid >> 3, rg = (vid & 7) * 8; float f[8];
#pragma unroll
                for (int q = 0; q < 8; ++q) f[q] = bf2f(*(const LAS bf16_t*)(lg + P5_KS + (rg + q) * 272 + d * 2)) * __expf(lastg - decg[rg + q]);
                *(u32x4*)(kt + (size_t)item2 * 8192 + d * 64 + rg) = pack8(f); }
            if (tt == 0) cdv[item2] = __expf(lastg);
        }
    }
    __syncthreads();
}

constexpr int SB_WD = 0, SB_QD = 17408, SB_KT = 34816, SB_QK = 53248, SB_UB = 62464, SB_SIZE = 66560;
constexpr int SC_ST = 2 * SB_SIZE, SC_UT = SC_ST + 4352, SC_END = SC_UT + 2304;
static_assert(SC_END <= LDS_BYTES, "lds");
__device__ __forceinline__ void scan_phase(const Params& p, int bid, int nblk, LAS unsigned char* lds) {
    const int tid = threadIdx.x, lane = tid & 63, wid = __builtin_amdgcn_readfirstlane(tid >> 6), fr = lane & 15, fq = lane >> 4;
    const bf16_t* wdc = (const bf16_t*)(p.ws + WS_WDC); const bf16_t* qd = (const bf16_t*)(p.ws + WS_QD); const bf16_t* kt = (const bf16_t*)(p.ws + WS_KT); const bf16_t* qk = (const bf16_t*)(p.ws + WS_QK);
    const float* cdv = (const float*)(p.ws + WS_CD); const float* ub = p.out + OS_UB; float* obuf = p.out + OS_O;
    for (int item = bid; item < 256; item += nblk) {
        const int xcd = item & 7, iq = item >> 3, bh = xcd * 4 + (iq >> 3), sl = iq & 7, h = bh & 7, b = bh >> 3;
        u32x4 r_wd[2], r_qd[2], r_kt[2], r_qk, r_ub;
        auto gload = [&](int n) {
            const size_t it = (size_t)(bh * 32 + n);
#pragma unroll
            for (int i = 0; i < 2; ++i) { const int ch = tid + 512 * i; r_wd[i] = *(const u32x4*)(wdc + it * 8192 + ch * 8); r_qd[i] = *(const u32x4*)(qd + it * 8192 + ch * 8); r_kt[i] = *(const u32x4*)(kt + it * 8192 + ch * 8); }
            r_qk = *(const u32x4*)(qk + it * 4096 + tid * 8);
            if (tid < 256) r_ub = *(const u32x4*)(ub + it * 8192 + (tid >> 2) * 128 + sl * 16 + (tid & 3) * 4);
        };
        auto lstore = [&](int buf) {
            LAS unsigned char* B = lds + buf * SB_SIZE;
#pragma unroll
            for (int i = 0; i < 2; ++i) { const int ch = tid + 512 * i; const int r = ch >> 4, c8 = (ch & 15) * 8; *(LAS u32x4*)(B + SB_WD + r * 272 + c8 * 2) = r_wd[i]; *(LAS u32x4*)(B + SB_QD + r * 272 + c8 * 2) = r_qd[i];
                const int d = ch >> 3, t8 = (ch & 7) * 8; *(LAS u32x4*)(B + SB_KT + d * 144 + t8 * 2) = r_kt[i]; }
            { const int r = tid >> 3, s8 = (tid & 7) * 8; *(LAS u32x4*)(B + SB_QK + r * 144 + s8 * 2) = r_qk; }
            if (tid < 256) *(LAS u32x4*)(B + SB_UB + (tid >> 2) * 64 + (tid & 3) * 16) = r_ub;
        };
        __syncthreads();
        gload(0);
        for (int i = tid; i < 4352 / 4; i += 512) *(LAS unsigned*)(lds + SC_ST + i * 4) = 0u;
        lstore(0);
        f32x4 sacc = (f32x4){0.f, 0.f, 0.f, 0.f};
        __syncthreads();
        for (int n = 0; n < 32; ++n) {
            const int cur = n & 1; LAS unsigned char* B = lds + cur * SB_SIZE;
            if (n + 1 < 32) gload(n + 1);
            const float cd = cdv[bh * 32 + n];
            f32x4 acc;
            const int tw = wid & 3;
            if (wid < 4) {
#pragma unroll
                for (int j = 0; j < 4; ++j) acc[j] = *(const LAS float*)(B + SB_UB + ((tw * 16 + fq * 4 + j) * 16 + fr) * 4);
#pragma unroll
                for (int kk = 0; kk < 4; ++kk) { const bf16x8 a = *(const LAS bf16x8*)(B + SB_WD + (tw * 16 + fr) * 272 + (kk * 32 + fq * 8) * 2); const bf16x8 bb = *(const LAS bf16x8*)(lds + SC_ST + fr * 272 + (kk * 32 + fq * 8) * 2);
                    acc = __builtin_amdgcn_mfma_f32_16x16x32_bf16(a, bb, acc, 0, 0, 0); }
                u32x2 w; w.x = pk2(acc[0], acc[1]); w.y = pk2(acc[2], acc[3]);
                *(LAS u32x2*)(lds + SC_UT + fr * 144 + (tw * 16 + fq * 4) * 2) = w;
            } else {
                acc = (f32x4){0.f, 0.f, 0.f, 0.f};
#pragma unroll
                for (int kk = 0; kk < 4; ++kk) { const bf16x8 a = *(const LAS bf16x8*)(B + SB_QD + (tw * 16 + fr) * 272 + (kk * 32 + fq * 8) * 2); const bf16x8 bb = *(const LAS bf16x8*)(lds + SC_ST + fr * 272 + (kk * 32 + fq * 8) * 2);
                    acc = __builtin_amdgcn_mfma_f32_16x16x32_bf16(a, bb, acc, 0, 0, 0); }
            }
            __syncthreads();
            sacc *= cd;
#pragma unroll
            for (int kk = 0; kk < 2; ++kk) { const bf16x8 a = *(const LAS bf16x8*)(B + SB_KT + (wid * 16 + fr) * 144 + (kk * 32 + fq * 8) * 2); const bf16x8 bb = *(const LAS bf16x8*)(lds + SC_UT + fr * 144 + (kk * 32 + fq * 8) * 2);
                sacc = __builtin_amdgcn_mfma_f32_16x16x32_bf16(a, bb, sacc, 0, 0, 0); }
            if (wid >= 4) {
#pragma unroll
                for (int kk = 0; kk < 2; ++kk) { const bf16x8 a = *(const LAS bf16x8*)(B + SB_QK + (tw * 16 + fr) * 144 + (kk * 32 + fq * 8) * 2); const bf16x8 bb = *(const LAS bf16x8*)(lds + SC_UT + fr * 144 + (kk * 32 + fq * 8) * 2);
                    acc = __builtin_amdgcn_mfma_f32_16x16x32_bf16(a, bb, acc, 0, 0, 0); }
#pragma unroll
                for (int j = 0; j < 4; ++j) obuf[(size_t)(b * 2048 + n * 64 + tw * 16 + fq * 4 + j) * 1024 + h * 128 + sl * 16 + fr] = acc[j];
            }
            { u32x2 w; w.x = pk2(sacc[0], sacc[1]); w.y = pk2(sacc[2], sacc[3]); *(LAS u32x2*)(lds + SC_ST + fr * 272 + (wid * 16 + fq * 4) * 2) = w; }
            if (n + 1 < 32) lstore(cur ^ 1);
            __syncthreads();
        }
#pragma unroll
        for (int j = 0; j < 4; ++j) p.out[O_DP + ((size_t)bh * 128 + wid * 16 + fq * 4 + j) * 128 + sl * 16 + fr] = sacc[j];
    }
    __syncthreads();
    {
        const bf16_t* qn = (const bf16_t*)(p.ws + WS_QN); const bf16_t* kn = (const bf16_t*)(p.ws + WS_KN); const bf16_t* vv = (const bf16_t*)(p.ws + WS_VV);
        const float* gbuf = (const float*)(p.ws + WS_G); const float* bbuf = (const float*)(p.ws + WS_BETA);
        const int grp = tid >> 8, w4 = __builtin_amdgcn_readfirstlane(tid >> 6) & 3, j = w4 * 32 + (lane & 31), half = lane >> 5;
        LAS float* qs = (LAS float*)lds + grp * 1024;
        LAS float* ks = qs + 512;
        const float scale = 0.08838834764831845f;
        for (int it0 = bid * 2; it0 < 1024; it0 += nblk * 2) {
            const int item = it0 + grp, sb = item >> 3, h = item & 7;
            __syncthreads();
#pragma unroll
            for (int i = 0; i < 4; ++i) { const int idx = (tid & 255) + 256 * i, tk = idx >> 7, c = idx & 127, t = tk & 3; const size_t go = (size_t)(TP + sb * 4 + t) * 1024 + h * 128 + c;
                if (tk < 4) qs[t * 128 + c] = bf2f(qn[go]); else ks[t * 128 + c] = bf2f(kn[go]); }
            float S[64];
            const float* s0 = p.in[4] + (size_t)item * 16384 + (size_t)half * 64 * 128 + j;
#pragma unroll
            for (int i = 0; i < 64; ++i) S[i] = __builtin_nontemporal_load(s0 + i * 128);
            __syncthreads();
#pragma unroll 1
            for (int t = 0; t < 4; ++t) {
                const int row = TP + sb * 4 + t;
                const float a = __expf(gbuf[row * 8 + h]), be = bbuf[row * 8 + h], v = bf2f(vv[(size_t)row * 1024 + h * 128 + j]);
                float kS = 0.f;
#pragma unroll
                for (int i4 = 0; i4 < 16; ++i4) { const f32x4 k4 = *(const LAS f32x4*)(ks + t * 128 + half * 64 + i4 * 4); kS += k4[0] * S[i4 * 4] + k4[1] * S[i4 * 4 + 1] + k4[2] * S[i4 * 4 + 2] + k4[3] * S[i4 * 4 + 3]; }
                kS += __shfl_xor(kS, 32);
                const float coef = be * (v - a * kS);
                float o = 0.f;
#pragma unroll
                for (int i4 = 0; i4 < 16; ++i4) { const f32x4 k4 = *(const LAS f32x4*)(ks + t * 128 + half * 64 + i4 * 4); const f32x4 q4 = *(const LAS f32x4*)(qs + t * 128 + half * 64 + i4 * 4);
#pragma unroll
                    for (int q = 0; q < 4; ++q) { S[i4 * 4 + q] = a * S[i4 * 4 + q] + k4[q] * coef; o += q4[q] * S[i4 * 4 + q]; } }
                o += __shfl_xor(o, 32);
                if (half == 0) obuf[(size_t)row * 1024 + h * 128 + j] = o * scale;
            }
            float* so = p.out + O_DS + (size_t)item * 16384 + (size_t)half * 64 * 128 + j;
#pragma unroll
            for (int i = 0; i < 64; ++i) so[i * 128] = S[i];
        }
    }
    __syncthreads();
}

__device__ __forceinline__ void onorm_phase(const Params& p, int bid, int nblk) {
    const int lane = threadIdx.x & 63, wid = __builtin_amdgcn_readfirstlane(threadIdx.x >> 6);
    const float* obuf = p.out + OS_O; const bf16_t* proj = (const bf16_t*)(p.ws + WS_PROJ); bf16_t* acat = (bf16_t*)(p.ws + WS_U); const float* og = p.in[14];
    for (int row = bid * 8 + wid; row < TT; row += nblk * 8) {
        const int c0 = lane * 16; float o[16], z[16], g[16];
#pragma unroll
        for (int i = 0; i < 4; ++i) { const f32x4 v = *(const f32x4*)(obuf + (size_t)row * 1024 + c0 + i * 4); o[i * 4] = v[0]; o[i * 4 + 1] = v[1]; o[i * 4 + 2] = v[2]; o[i * 4 + 3] = v[3];
            const f32x4 gg = *(const f32x4*)(og + (c0 & 127) + i * 4); g[i * 4] = gg[0]; g[i * 4 + 1] = gg[1]; g[i * 4 + 2] = gg[2]; g[i * 4 + 3] = gg[3]; }
        unpack8(*(const u32x4*)(proj + (size_t)row * NPROJ + C_Z + c0), z); unpack8(*(const u32x4*)(proj + (size_t)row * NPROJ + C_Z + c0 + 8), z + 8);
        float ss = 0.f;
#pragma unroll
        for (int i = 0; i < 16; ++i) ss += o[i] * o[i];
        ss += __shfl_xor(ss, 1); ss += __shfl_xor(ss, 2); ss += __shfl_xor(ss, 4);
        const float rstd = rsqrtf(ss * (1.0f / 128.0f) + EPS);
#pragma unroll
        for (int i = 0; i < 16; ++i) o[i] = o[i] * rstd * g[i] * siluf_(z[i]);
        *(u32x4*)(acat + (size_t)row * DM + c0) = pack8(o); *(u32x4*)(acat + (size_t)row * DM + c0 + 8) = pack8(o + 8);
    }
}

#define XB_TMO      128
#define XB_XCNT(j)  (256  + 64 * (j))
#define XB_XSUB(j)  (1280 + 64 * (j))
#define XB_XGEN(j)  (2304 + 64 * (j))
#define XB_TOP      3328
#define XB_TOPGEN   3392
#define XCD_BAR_WORDS 3456
#define XB_SPIN_CAP (1u << 18)

__device__ __forceinline__ unsigned xb_ld(unsigned* p)              { return __hip_atomic_load(p, __ATOMIC_RELAXED, __HIP_MEMORY_SCOPE_AGENT); }
__device__ __forceinline__ unsigned xb_add(unsigned* p, unsigned v) { return __hip_atomic_fetch_add(p, v, __ATOMIC_RELAXED, __HIP_MEMORY_SCOPE_AGENT); }
__device__ __forceinline__ unsigned xb_xcc_id() { return (unsigned)__builtin_amdgcn_s_getreg((3 << 11) | 20) & 0xFu; }
#define XB_SPIN(cond, bar) do { unsigned _sp = 0; while (cond) { __builtin_amdgcn_s_sleep(1); \
    if ((++_sp & 255u) == 0u) { if (xb_ld(&(bar)[XB_TMO])) break; if (_sp > XB_SPIN_CAP) { atomicAdd(&(bar)[XB_TMO], 1u); break; } } } } while (0)

struct XcdBarrier {
    unsigned* bar; unsigned x;
    volatile LAS unsigned* st;
};

__device__ __forceinline__ XcdBarrier xcd_barrier_post(unsigned* bar, volatile LAS unsigned* st) {
    XcdBarrier b; b.bar = bar; b.x = xb_xcc_id(); b.st = st;
    if (threadIdx.x == 0) (void)xb_add(&bar[XB_XCNT(b.x)], 1u);
    return b;
}
__device__ __forceinline__ void xcd_barrier_complete(unsigned* bar, unsigned x, unsigned& nloc, unsigned& nx) {
    const unsigned G = gridDim.x * gridDim.y * gridDim.z;
    unsigned sum, cnt, mine, sp = 0u;
    for (;;) {
        sum = 0u; cnt = 0u; mine = 0u;
#pragma unroll
        for (unsigned j = 0; j < 16; ++j) { const unsigned c = xb_ld(&bar[XB_XCNT(j)]); sum += c; cnt += (c > 0u) ? 1u : 0u; mine = (j == x) ? c : mine; }
        if (sum == G) break;
        __builtin_amdgcn_s_sleep(1);
        if ((++sp & 255u) == 0u) { if (xb_ld(&bar[XB_TMO])) break; if (sp > XB_SPIN_CAP) { atomicAdd(&bar[XB_TMO], 1u); break; } }
    }
    nloc = mine > 0u ? mine : 1u; nx = cnt > 0u ? cnt : 1u;
}

__device__ __forceinline__ void xcd_barrier(const XcdBarrier& b) {
    asm volatile("s_waitcnt vmcnt(0)" ::: "memory");
    __syncthreads();
    if (threadIdx.x == 0) {
        unsigned* bar = b.bar;
        __builtin_amdgcn_s_waitcnt(0);
        unsigned nloc = b.st[0], nx = b.st[1];
        if (nloc == 0u) { xcd_barrier_complete(bar, b.x, nloc, nx); b.st[0] = nloc; b.st[1] = nx; }
        const unsigned old = xb_add(&bar[XB_XSUB(b.x)], 1u);
        const unsigned gen = old / nloc;
        if (old + 1u == (gen + 1u) * nloc) {
            __builtin_amdgcn_fence(__ATOMIC_RELEASE, "agent");
            asm volatile("s_waitcnt vmcnt(0)" ::: "memory");
            const unsigned og = xb_add(&bar[XB_TOP], 1u);
            const unsigned tg = og / nx;
            if (og + 1u == (tg + 1u) * nx) xb_add(&bar[XB_TOPGEN], 1u);
            else XB_SPIN(xb_ld(&bar[XB_TOPGEN]) == tg, bar);
            __builtin_amdgcn_fence(__ATOMIC_ACQUIRE, "agent");
            xb_add(&bar[XB_XGEN(b.x)], 1u);
            asm volatile("s_waitcnt vmcnt(0)" ::: "memory");
        } else {
            XB_SPIN(xb_ld(&bar[XB_XGEN(b.x)]) == gen, bar);
            __builtin_amdgcn_fence(__ATOMIC_ACQUIRE, "agent");
            asm volatile("s_waitcnt vmcnt(0)" ::: "memory");
        }
    }
    __syncthreads();
}

constexpr size_t WS_BAR = WS_END;
constexpr int LDS_ST_OFF = LDS_BYTES - 16;
struct KArgs { Params p; TJob jobs[11]; };
constexpr int N_PHASES = 15;
#ifndef PH_MASK
#define PH_MASK 0xFFFF
#endif
#ifndef DUP_MASK
#define DUP_MASK 0
#endif

__global__ void __launch_bounds__(512, 2) fwd_megakernel(KArgs ka) {
    extern __shared__ __attribute__((aligned(16))) unsigned char lds_raw[];
    LAS unsigned char* lds = (LAS unsigned char*)lds_raw;
    const Params& p = ka.p;
    const int bid = blockIdx.x, nblk = gridDim.x;
    unsigned char* ws = p.ws;
    const int lo = p.ph_lo, hi = p.ph_hi;
    if (threadIdx.x < 4) ((LAS unsigned*)(lds + LDS_ST_OFF))[threadIdx.x] = 0u;
    __syncthreads();
    if (hi > 1000) cg::this_grid().sync();
    XcdBarrier xbar = xcd_barrier_post((unsigned*)(ws + WS_BAR), (volatile LAS unsigned*)(lds + LDS_ST_OFF));
#define IN(k) ((PH_MASK & (1 << (k))) && lo <= (k) && (k) < hi)
#define SEAM(k) do { if (lo <= (k) && (k) + 1 < hi) xcd_barrier(xbar); } while (0)
    if (IN(0)) for (int rep = 0; rep <= ((DUP_MASK >> 0) & 1); ++rep) {
            bf16_t* aada = (bf16_t*)(ws + WS_AADA);
            for (int idx = bid * 512 + threadIdx.x; idx < 256 * 2048; idx += nblk * 512) { const int row = idx >> 11, col = idx & 2047;
                const float v = row < 4 ? siluf_(p.in[2][row * 2048 + col]) : (row < NB ? siluf_(p.in[3][(row - 4) * 2048 + col]) : 0.f); aada[idx] = f2bf(v); }
            transpose_jobs(ka.jobs, 1, bid, nblk, lds);
        }
    SEAM(0);
    if (IN(1)) for (int rep = 0; rep <= ((DUP_MASK >> 1) & 1); ++rep) {
            if (bid < 48) { pg8::Gemm g{(const bf16_t*)(ws + WS_AADA), (const bf16_t*)(ws + WS_PROJ), 2048, 2048, 2048, 0, 0, 0, 0, 0}; pg8::OneUnitOrder S{48, bid, 32}; pg8::EpiAda E{(float*)(ws + WS_MOD), p.in[8]}; pg8::gemm_phase(lds, g, S, E); }
            else { transpose_jobs(ka.jobs + 1, 1, bid - 48, nblk - 48, lds); transpose_jobs(ka.jobs + 4, 7, bid - 48, nblk - 48, lds); }
        }
    SEAM(1);
    if (IN(2)) for (int rep = 0; rep <= ((DUP_MASK >> 2) & 1); ++rep) norm_phase<0>(p, bid, nblk);
    SEAM(2);
    if (IN(3)) for (int rep = 0; rep <= ((DUP_MASK >> 3) & 1); ++rep) { pg8::Gemm g{(const bf16_t*)(ws + WS_U), (const bf16_t*)(ws + WS_WIN), 2048, 2048, 2048, 0, 0, 0, 0, 0}; pg8::StaticOrder S; S.init(TT, NPROJ, 2048, nblk, bid); pg8::EpiBf16 E{(bf16_t*)(ws + WS_PROJ), NPROJ, 0, nullptr}; pg8::gemm_phase(lds, g, S, E); }
    SEAM(3);
    if (IN(4)) for (int rep = 0; rep <= ((DUP_MASK >> 4) & 1); ++rep) mixer_prep_phase(p, bid, nblk);
    SEAM(4);
    if (IN(5)) for (int rep = 0; rep <= ((DUP_MASK >> 5) & 1); ++rep) chunk_prep_phase(p, bid, nblk, lds);
    SEAM(5);
    if (IN(6)) for (int rep = 0; rep <= ((DUP_MASK >> 6) & 1); ++rep) scan_phase(p, bid, nblk, lds);
    SEAM(6);
    if (IN(7)) for (int rep = 0; rep <= ((DUP_MASK >> 7) & 1); ++rep) { onorm_phase(p, bid, nblk);
            pg8::Gemm g{(const bf16_t*)(ws + WS_YP), (const bf16_t*)(ws + WS_PW), 1024, 256, 256, 512, 0, 0, 0, 0}; pg8::StaticOrder S; S.init(TT, 1024, 256, nblk, bid); pg8::EpiBf16 E{(bf16_t*)(ws + WS_U), DM, 1024, p.in[16]}; pg8::gemm_phase(lds, g, S, E);
            if (rep == 0) { if (nblk <= 136) transpose_jobs(ka.jobs + 3, 1, bid, nblk, lds); else if (bid >= 136) transpose_jobs(ka.jobs + 3, 1, bid - 136, nblk - 136, lds); } }
    SEAM(7);
    if (IN(8)) for (int rep = 0; rep <= ((DUP_MASK >> 8) & 1); ++rep) {
            pg8::Gemm g{(const bf16_t*)(ws + WS_U), (const bf16_t*)(ws + WS_WAB), 2048, 2048, 1024, 0, 2048, 2048, (size_t)128 * 2048 * 2, (size_t)128 * 2048 * 2}; pg8::StaticOrder S; S.init(68 * 256, 16 * 256, 1024, nblk, bid);
            pg8::EpiDiag E{(bf16_t*)(ws + WS_QN), (const bf16_t*)(ws + WS_PROJ)}; pg8::gemm_phase(lds, g, S, E);
            if (rep == 0) { const int nfull = 1088 % nblk; if (nfull == 0 || nfull >= nblk) transpose_jobs(ka.jobs + 2, 1, bid, nblk, lds); else if (bid >= nfull) transpose_jobs(ka.jobs + 2, 1, bid - nfull, nblk - nfull, lds); } }
    SEAM(9);
    if (IN(10)) for (int rep = 0; rep <= ((DUP_MASK >> 10) & 1); ++rep) { pg8::Gemm g{(const bf16_t*)(ws + WS_QN), (const bf16_t*)(ws + WS_WO), 2048, 2048, 2048, 0, 0, 0, 0, 0}; pg8::SplitOrder S{nblk, bid, 32, 4, 8}; pg8::EpiRes E{p.out + O_Y, p.in[0], p.in[1], (const float*)(ws + WS_MOD) + 4096, (float*)(ws + WS_PB10)}; pg8::gemm_phase(lds, g, S, E); }
    SEAM(10);
    if (IN(11)) for (int rep = 0; rep <= ((DUP_MASK >> 11) & 1); ++rep) norm_phase<1>(p, bid, nblk);
    SEAM(11);
    if (IN(12)) for (int rep = 0; rep <= ((DUP_MASK >> 12) & 1); ++rep) { pg8::Gemm g{(const bf16_t*)(ws + WS_U), (const bf16_t*)(ws + WS_WGU), 2048, 2048, 2048, 0, 0, 0, 0, 0}; pg8::StaticOrder S; S.init(TT, 11264, 2048, nblk, bid); pg8::EpiGU E{(bf16_t*)(ws + WS_PROJ)}; pg8::gemm_phase(lds, g, S, E); }
    SEAM(12);
    if (IN(13)) for (int rep = 0; rep <= ((DUP_MASK >> 13) & 1); ++rep) { pg8::Gemm g{(const bf16_t*)(ws + WS_PROJ), (const bf16_t*)(ws + WS_WD), DFF, DFF, DFF, 0, 0, 0, 0, 0}; pg8::SplitOrder S{nblk, bid, 88, 8, 11}; pg8::EpiRes E{p.out + O_Y, p.out + O_Y, p.out + O_Y + (size_t)TP * DM, (const float*)(ws + WS_MOD) + 10240, (float*)(ws + WS_PB13)}; pg8::gemm_phase(lds, g, S, E); }
    SEAM(13);
    if (IN(14)) for (int rep = 0; rep <= ((DUP_MASK >> 14) & 1); ++rep) norm_phase<2>(p, bid, nblk);
    SEAM(14);
}

extern "C" void kernel_launch(void* const* d_in, const int* in_sizes, int n_in, void* d_out, int out_size, void* d_ws, size_t ws_size, hipStream_t stream) {
    static int grid = 0;
    if (grid == 0) {
        if (n_in != 24 || ws_size < WS_BAR + XCD_BAR_WORDS * 4) { fprintf(stderr, "kernel_launch: unexpected n_in %d / ws_size %zu (need %zu)\n", n_in, ws_size, (size_t)WS_END); grid = -1; return; }
        int dev = 0, cus = 0, per_cu = 0;
        hipGetDevice(&dev); hipDeviceGetAttribute(&cus, hipDeviceAttributeMultiprocessorCount, dev);
        if (hipFuncSetAttribute((const void*)fwd_megakernel, hipFuncAttributeMaxDynamicSharedMemorySize, LDS_BYTES) != hipSuccess) { fprintf(stderr, "kernel_launch: hipFuncSetAttribute failed\n"); grid = -1; return; }
        if (hipOccupancyMaxActiveBlocksPerMultiprocessor(&per_cu, (const void*)fwd_megakernel, 512, LDS_BYTES) != hipSuccess || per_cu < 1) { fprintf(stderr, "kernel_launch: occupancy query says %d\n", per_cu); per_cu = 1; }
        (void)hipGetLastError();
        grid = cus > 0 ? cus : 256;
        if (grid < 64) grid = 64;
    }
    if (grid < 0) return;
    if (hipMemsetAsync((unsigned char*)d_ws + WS_BAR, 0, XCD_BAR_WORDS * 4, stream) != hipSuccess) { fprintf(stderr, "kernel_launch: memset failed\n"); return; }
    KArgs ka; memset(&ka, 0, sizeof(ka));
    for (int i = 0; i < 24; ++i) ka.p.in[i] = (const float*)d_in[i];
    ka.p.out = (float*)d_out; ka.p.ws = (unsigned char*)d_ws;
    unsigned char* ws = (unsigned char*)d_ws;
    auto setjob = [&](int i, const void* src, void* dst, int ld_src, int K, int Nout, int ld_dst, int map) { TJob& j = ka.jobs[i]; j.src = (const float*)src; j.dst = (bf16_t*)dst; j.ld_src = ld_src; j.K = K; j.Nout = Nout; j.ld_dst = ld_dst; j.map = map; j.pad = 0; };
    setjob(0, d_in[7], ws + WS_PROJ, MODW, 2048, MODW, 2048, 0);
    setjob(1, d_in[10], ws + WS_WIN, 9232, 2048, NPROJ, 2048, 1);
    setjob(2, d_in[21], ws + WS_WGU, 2 * DFF, 2048, 2 * DFF, 2048, 2);
    setjob(3, d_in[22], ws + WS_WD, 2048, DFF, 2048, DFF, 0);
    setjob(4, d_in[19], ws + WS_WO, 2048, 2048, 2048, 2048, 0);
    setjob(5, d_in[17], ws + WS_WAB, 2048, 1024, 2048, 2048, 0);
    setjob(6, d_in[18], ws + WS_WAB + 1024 * 2, 2048, 1024, 2048, 2048, 0);
    for (int g = 0; g < 4; ++g) setjob(7 + g, (const float*)d_in[15] + g * 65536, ws + WS_PW + (size_t)g * 65536 * 2, 256, 256, 256, 256, 0);
#if MK_PER_PHASE
    for (int ph = 0; ph < N_PHASES; ++ph) { ka.p.ph_lo = ph; ka.p.ph_hi = ph + 1; hipLaunchKernelGGL(fwd_megakernel, dim3(grid), dim3(512), LDS_BYTES, stream, ka); }
#else
    ka.p.ph_lo = 0; ka.p.ph_hi = N_PHASES;
    void* args[] = {&ka};
    hipError_t e = hipLaunchCooperativeKernel((const void*)fwd_megakernel, dim3(grid), dim3(512), args, LDS_BYTES, stream);
    if (e != hipSuccess) fprintf(stderr, "cooperative launch failed: %s (grid %d)\n", hipGetErrorString(e), grid);
#endif
}
```

```cpp
#include <hip/hip_runtime.h>
#include <hip/hip_cooperative_groups.h>
#include <cstdio>
#include <cstring>
namespace cg = cooperative_groups;

#ifndef MK_PER_PHASE
#define MK_PER_PHASE 0
#endif

#define LAS __attribute__((address_space(3)))
typedef unsigned short bf16_t;
typedef short bf16x8 __attribute__((ext_vector_type(8)));
typedef float f32x4 __attribute__((ext_vector_type(4)));
typedef float f32x2 __attribute__((ext_vector_type(2)));
typedef unsigned u32x4 __attribute__((ext_vector_type(4)));
typedef unsigned u32x2 __attribute__((ext_vector_type(2)));

constexpr int DM = 2048, TP = 8192, TS = 512, TT = 8704, NB = 132;
constexpr int NPROJ = 9472;
constexpr int DFF = 5632;
constexpr int MODW = 12288;
constexpr float EPS = 1e-6f;
constexpr int C_Q = 0, C_K = 1024, C_V = 2048, C_Z = 3072, C_XP = 4096, C_GA = 5120, C_GB = 7168, C_AB = 9216;
constexpr size_t O_Y = 0, O_DP = 17825792, O_CP = 18350080, O_PP = 18386944, O_DS = 18448384, O_CS = 35225600, O_PS = 36405248;
constexpr size_t OS_O = 0, OS_UB = 8912896;
constexpr size_t WS_WIN = 0;
constexpr size_t WS_WGU = WS_WIN + (size_t)NPROJ * 2048 * 2;
constexpr size_t WS_WD = WS_WGU + (size_t)11264 * 2048 * 2;
constexpr size_t WS_WO = WS_WD + (size_t)2048 * 5632 * 2;
constexpr size_t WS_WAB = WS_WO + (size_t)2048 * 2048 * 2;
constexpr size_t WS_PW = WS_WAB + (size_t)2048 * 2048 * 2;
constexpr size_t WS_AADA = WS_PW + (size_t)1024 * 256 * 2;
constexpr size_t WS_MOD = WS_AADA + (size_t)256 * 2048 * 2;
constexpr size_t WS_G = WS_MOD + (size_t)NB * MODW * 4;
constexpr size_t WS_BETA = WS_G + (size_t)TT * 8 * 4;
constexpr size_t WS_CD = WS_BETA + (size_t)TT * 8 * 4;
constexpr size_t WS_U = WS_CD + 4096;
constexpr size_t WS_QN = WS_U + (size_t)TT * 2048 * 2;
constexpr size_t WS_KN = WS_QN + (size_t)TT * 1024 * 2;
constexpr size_t WS_VV = WS_KN + (size_t)TT * 1024 * 2;
constexpr size_t WS_YP = WS_VV + (size_t)TT * 1024 * 2;
constexpr size_t WS_WDC = WS_YP + (size_t)TT * 1024 * 2;
constexpr size_t WS_QD = WS_WDC + (size_t)1024 * 64 * 128 * 2;
constexpr size_t WS_KT = WS_QD + (size_t)1024 * 64 * 128 * 2;
constexpr size_t WS_QK = WS_KT + (size_t)1024 * 64 * 128 * 2;
constexpr size_t WS_PROJ = WS_QK + (size_t)1024 * 64 * 64 * 2;
constexpr size_t WS_END = WS_PROJ + (size_t)TT * NPROJ * 2;
constexpr size_t WS_PB10 = WS_PROJ;
constexpr size_t WS_PB13 = WS_PROJ + (size_t)TT * DFF * 2;
static_assert(WS_PB13 + (size_t)11 * TS * DM * 4 <= WS_END && (WS_PB13 % 256) == 0, "partials");
static_assert(WS_END + 16384 <= 501510720ull, "workspace too large");
static_assert((WS_PROJ % 256) == 0 && (WS_QK % 256) == 0 && (WS_U % 256) == 0, "align");

constexpr int LDS_BYTES = 147456;

struct Params {
    const float* in[24];
    float* out;
    unsigned char* ws;
    int ph_lo, ph_hi;
};

__device__ __forceinline__ float bf2f(unsigned short x) { return __uint_as_float(((unsigned)x) << 16); }
__device__ __forceinline__ unsigned short f2bf(float f) { const __bf16 b = (__bf16)f; return __builtin_bit_cast(unsigned short, b); }
typedef __bf16 bf16x2_hw __attribute__((ext_vector_type(2)));
__device__ __forceinline__ unsigned pk2(float lo, float hi) { const f32x2 v = {lo, hi}; const bf16x2_hw b = __builtin_convertvector(v, bf16x2_hw); return __builtin_bit_cast(unsigned, b); }
__device__ __forceinline__ void unpack8(const u32x4 w, float* f) {
    f[0] = __uint_as_float(w.x << 16); f[1] = __uint_as_float(w.x & 0xffff0000u);
    f[2] = __uint_as_float(w.y << 16); f[3] = __uint_as_float(w.y & 0xffff0000u);
    f[4] = __uint_as_float(w.z << 16); f[5] = __uint_as_float(w.z & 0xffff0000u);
    f[6] = __uint_as_float(w.w << 16); f[7] = __uint_as_float(w.w & 0xffff0000u);
}
__device__ __forceinline__ u32x4 pack8(const float* f) { u32x4 w; w.x = pk2(f[0], f[1]); w.y = pk2(f[2], f[3]); w.z = pk2(f[4], f[5]); w.w = pk2(f[6], f[7]); return w; }
__device__ __forceinline__ float sigmoidf_(float x) { return __builtin_amdgcn_rcpf(1.0f + __expf(-x)); }
__device__ __forceinline__ float siluf_(float x) { return x * __builtin_amdgcn_rcpf(1.0f + __expf(-x)); }
__device__ __forceinline__ int bidx_of_row(int row) { return row < TP ? (row >> 11) : 4 + ((row - TP) >> 2); }

namespace pg8 {
constexpr int BM = 256, BK = 64, HALF = 128, HTB = HALF * BK * 2, STAGE_BYTES = 8 * HTB, NXCD = 8, WGM = 8;
__host__ __device__ __forceinline__ int lds_byte(int r, int c) { const int st = (r >> 4) * 2 + (c >> 5), rr = r & 15, cc = c & 31, ob = rr * 64 + cc * 2; return st * 1024 + (ob ^ (((ob >> 9) & 1) << 5)); }
__host__ __device__ __forceinline__ void stage_rc(int b, int& R, int& C) { const int st = b / 1024, sb = b % 1024, swz = sb ^ (((sb >> 9) & 1) << 5); R = (st >> 1) * 16 + swz / 64; C = (st & 1) * 32 + (swz % 64) / 2; }
__host__ __device__ __forceinline__ int perm32(int rho) { const int n = rho >> 4, i = rho & 15; return 8 * (i >> 2) + 4 * n + (i & 3); }

struct Unit { int pm, pn, kt0, nkt, piece; };
struct Gemm { const bf16_t* A; const bf16_t* Bt; int lda, ldb, K; size_t a_pn_off; size_t a_half, b_half, a_tile, b_tile; };

__device__ __forceinline__ void tile_of(int wgid, int nM, int nN, Unit& u) {
    const int nwg = nM * nN;
    { const int q = nwg / NXCD, r = nwg % NXCD, xcd = wgid % NXCD, off = wgid / NXCD; wgid = (xcd < r ? xcd * (q + 1) : r * (q + 1) + (xcd - r) * q) + off; }
    const int nig = WGM * nN, gid = wgid / nig, fm = gid * WGM, gsz = (nM - fm) < WGM ? (nM - fm) : WGM;
    u.pm = fm + ((wgid % nig) % gsz); u.pn = (wgid % nig) / gsz;
}
struct StaticOrder {
    int nM, nN, nwg, G, c, ntk;
    __device__ __forceinline__ void init(int M, int N, int K, int G_, int c_) { nM = M / BM; nN = N / BM; nwg = nM * nN; G = G_; c = c_; ntk = K / BK; }
    __device__ __forceinline__ bool next(int i, Unit& u) const {
        const long L = (long)i * G + c; if (L >= nwg) return false;
        tile_of((int)L, nM, nN, u); u.kt0 = 0; u.nkt = ntk; u.piece = -1; return true;
    }
};
struct OneUnitOrder {
    int n, c, ntk;
    __device__ __forceinline__ bool next(int i, Unit& u) const { if (i != 0 || c >= n) return false; u.pm = 0; u.pn = c; u.kt0 = 0; u.nkt = ntk; u.piece = -1; return true; }
};
struct DoubleOrder {
    int G, c;
    __device__ __forceinline__ bool next(int i, Unit& u) const {
        const int L = (i >> 1) * G + c, half = i & 1; const bool ok = L < 272;
        tile_of(ok ? L : 0, 34, 8, u); u.kt0 = 16 * half; u.nkt = 16; u.piece = half; return ok;
    }
};
struct SplitOrder {
    int G, c, ntk, pk, npc;
    __device__ __forceinline__ bool next(int i, Unit& u) const {
        const int L = i * G + c;
        const bool full = L < 256;
        int fpm, fpn;
        { int wgid = full ? L : 0; const int xcd = wgid % NXCD, off = wgid / NXCD; wgid = xcd * 32 + off;
          const int nig = WGM * 8, gid = wgid / nig, fm = gid * WGM; fpm = fm + ((wgid % nig) % WGM); fpn = (wgid % nig) / WGM; }
        const int pidx = full ? 0 : L - 256, tile = pidx / npc, pc = pidx - tile * npc;
        u.pm = full ? fpm : 32 + (tile >> 3); u.pn = full ? fpn : (tile & 7); u.kt0 = full ? 0 : pc * pk; u.nkt = full ? ntk : pk; u.piece = full ? -1 : pc;
        return full || pidx < 16 * npc;
    }
};

template <class Epi, class Sched>
__device__ __forceinline__ void gemm_phase(LAS unsigned char* lds, const Gemm g, const Sched& S, const Epi& E) {
    const int tid = threadIdx.x, wid = __builtin_amdgcn_readfirstlane(tid >> 6), lane = tid & 63, wr = wid >> 2, wc = wid & 3, fr = lane & 15, fq = lane >> 4;
    unsigned voffA[2], voffB[2];
#pragma unroll
    for (int i = 0; i < 2; ++i) { int R, C; stage_rc(tid * 16 + i * 8192, R, C); const int Rb = Epi::PERM ? ((R & ~31) + perm32(R & 31)) : R;
        voffA[i] = (unsigned)(R * g.lda + C) * 2u; voffB[i] = (unsigned)(Rb * g.ldb + C) * 2u; }
    const size_t kstep = (size_t)(BK * 2);
    const size_t hstepA = g.a_half ? g.a_half : (size_t)HALF * g.lda * 2, hstepB = g.b_half ? g.b_half : (size_t)HALF * g.ldb * 2;
    const size_t tstepA = g.a_tile ? g.a_tile : (size_t)BM * g.lda * 2, tstepB = g.b_tile ? g.b_tile : (size_t)BM * g.ldb * 2;
    const unsigned ldsw = (unsigned)wid * 1024u;
    const int aoff = lds_byte(wr * 64 + fr, fq * 8), boff = lds_byte(wc * 32 + fr, fq * 8);
#define PG8_SA(b, h) (((b) * 2 + (h)) * HTB)
#define PG8_SB(b, h) ((4 + (b) * 2 + (h)) * HTB)
#define PG8_STAGE(bufoff, gbase, voff) do { _Pragma("unroll") for (int _i = 0; _i < 2; ++_i) \
        __builtin_amdgcn_global_load_lds((const unsigned*)((const char*)(gbase) + (voff)[_i]), (LAS unsigned*)(lds + (bufoff) + ldsw + _i * 8192), 16, 0, 0); } while (0)
#define PG8_LDA(dst, b, h) do { _Pragma("unroll") for (int m = 0; m < 4; ++m) _Pragma("unroll") for (int k = 0; k < 2; ++k) dst[m][k] = *(const LAS bf16x8*)(lds + PG8_SA(b, h) + aoff + m * 2048 + k * 1024); } while (0)
#define PG8_LDB(dst, b, h) do { _Pragma("unroll") for (int n = 0; n < 2; ++n) _Pragma("unroll") for (int k = 0; k < 2; ++k) dst[n][k] = *(const LAS bf16x8*)(lds + PG8_SB(b, h) + boff + n * 2048 + k * 1024); } while (0)
#define PG8_MMA(ai, bj, At, Bt) do { __builtin_amdgcn_s_setprio(1); _Pragma("unroll") for (int m = 0; m < 4; ++m) _Pragma("unroll") for (int n = 0; n < 2; ++n) _Pragma("unroll") for (int k = 0; k < 2; ++k) \
        acc[ai][bj][m][n] = __builtin_amdgcn_mfma_f32_16x16x32_bf16(Bt[n][k], At[m][k], acc[ai][bj][m][n], 0, 0, 0); __builtin_amdgcn_s_setprio(0); } while (0)
#define PG8_WAIT_V(n) asm volatile("s_waitcnt vmcnt(" #n ")" ::: "memory")
#define PG8_WAIT_L(n) asm volatile("s_waitcnt lgkmcnt(" #n ")" ::: "memory")
#define PG8_BAR __builtin_amdgcn_s_barrier()
#define PG8_SCHED __builtin_amdgcn_sched_barrier(0)
    Unit cur, nxt; int ui = 0;
    if (!S.next(0, cur)) return;
    f32x4 acc[2][2][4][2];
#pragma unroll
    for (int a = 0; a < 2; ++a)
#pragma unroll
        for (int b = 0; b < 2; ++b)
#pragma unroll
            for (int m = 0; m < 4; ++m)
#pragma unroll
                for (int n = 0; n < 2; ++n) acc[a][b][m][n] = (f32x4){0.f, 0.f, 0.f, 0.f};
    bf16x8 At[4][2], B0[2][2], B1[2][2];
    const char* cA = (const char*)g.A + (size_t)cur.pm * tstepA + (size_t)cur.pn * g.a_pn_off + (size_t)cur.kt0 * kstep; const char* cB = (const char*)g.Bt + (size_t)cur.pn * tstepB + (size_t)cur.kt0 * kstep;
    PG8_STAGE(PG8_SB(0, 0), cB, voffB); PG8_STAGE(PG8_SA(0, 0), cA, voffA); PG8_STAGE(PG8_SB(0, 1), cB + hstepB, voffB); PG8_STAGE(PG8_SA(0, 1), cA + hstepA, voffA);
    if (wr == 1) PG8_BAR;
    PG8_WAIT_V(4); PG8_BAR;
    PG8_STAGE(PG8_SB(1, 0), cB + kstep, voffB); PG8_STAGE(PG8_SA(1, 0), cA + kstep, voffA); PG8_STAGE(PG8_SB(1, 1), cB + hstepB + kstep, voffB);
    PG8_WAIT_V(6); PG8_BAR;
    for (;;) {
        const bool has_next = S.next(ui + 1, nxt);
        const char* nA = has_next ? (const char*)g.A + (size_t)nxt.pm * tstepA + (size_t)nxt.pn * g.a_pn_off + (size_t)nxt.kt0 * kstep : cA; const char* nB = has_next ? (const char*)g.Bt + (size_t)nxt.pn * tstepB + (size_t)nxt.kt0 * kstep : cB;
        const int nt = cur.nkt;
#pragma unroll 1
        for (int t = 0; t < nt; t += 2) {
            const bool last = (t == nt - 2);
            const char* a1 = cA + (size_t)(t + 1) * kstep;
            const char* a2 = last ? nA : cA + (size_t)(t + 2) * kstep; const char* b2 = last ? nB : cB + (size_t)(t + 2) * kstep;
            const char* a3 = a2 + kstep; const char* b3 = b2 + kstep;
            PG8_LDB(B0, 0, 0); PG8_SCHED; PG8_LDA(At, 0, 0); PG8_STAGE(PG8_SA(1, 1), a1 + hstepA, voffA);
            PG8_WAIT_L(8); PG8_BAR; PG8_WAIT_L(0); PG8_MMA(0, 0, At, B0); PG8_BAR; PG8_SCHED;
            PG8_LDB(B1, 0, 1); PG8_STAGE(PG8_SB(0, 0), b2, voffB);
            PG8_BAR; PG8_WAIT_L(0); if constexpr (!Epi::DIAG) PG8_MMA(0, 1, At, B1); PG8_BAR;
            PG8_LDA(At, 0, 1); PG8_STAGE(PG8_SA(0, 0), a2, voffA);
            PG8_BAR; PG8_WAIT_L(0); if constexpr (!Epi::DIAG) PG8_MMA(1, 0, At, B0); PG8_BAR; PG8_SCHED;
            PG8_STAGE(PG8_SB(0, 1), b2 + hstepB, voffB);
            PG8_WAIT_V(6); PG8_BAR; PG8_MMA(1, 1, At, B1); PG8_BAR;
            PG8_LDB(B0, 1, 0); PG8_SCHED; PG8_LDA(At, 1, 0); PG8_STAGE(PG8_SA(0, 1), a2 + hstepA, voffA);
            PG8_WAIT_L(8); PG8_BAR; PG8_WAIT_L(0); PG8_MMA(0, 0, At, B0); PG8_BAR; PG8_SCHED;
            PG8_LDB(B1, 1, 1); PG8_STAGE(PG8_SB(1, 0), b3, voffB);
            PG8_BAR; PG8_WAIT_L(0); if constexpr (!Epi::DIAG) PG8_MMA(0, 1, At, B1); PG8_BAR;
            PG8_LDA(At, 1, 1); PG8_STAGE(PG8_SA(1, 0), a3, voffA);
            PG8_BAR; PG8_WAIT_L(0); if constexpr (!Epi::DIAG) PG8_MMA(1, 0, At, B0); PG8_BAR; PG8_SCHED;
            PG8_STAGE(PG8_SB(1, 1), b3 + hstepB, voffB);
            PG8_WAIT_V(6); PG8_BAR; PG8_MMA(1, 1, At, B1); PG8_BAR;
        }
        E(acc, cur, wr, wc, fr, fq);
        if (!has_next) break;
#pragma unroll
        for (int a = 0; a < 2; ++a)
#pragma unroll
            for (int b = 0; b < 2; ++b)
#pragma unroll
                for (int m = 0; m < 4; ++m)
#pragma unroll
                    for (int n = 0; n < 2; ++n) acc[a][b][m][n] = (f32x4){0.f, 0.f, 0.f, 0.f};
        cur = nxt; cA = nA; cB = nB; ++ui;
    }
    PG8_WAIT_V(0);
    if (wr == 0) PG8_BAR;
    PG8_BAR;
#undef PG8_SA
#undef PG8_SB
#undef PG8_STAGE
#undef PG8_LDA
#undef PG8_LDB
#undef PG8_MMA
#undef PG8_WAIT_V
#undef PG8_WAIT_L
#undef PG8_BAR
#undef PG8_SCHED
}

typedef f32x4 Acc[2][2][4][2];

struct EpiAda {
    static constexpr bool PERM = false, MID = false, DIAG = false;
    float* C; const float* bias;
    __device__ __forceinline__ void operator()(const Acc& acc, const Unit& u, int wr, int wc, int fr, int fq) const {
        const int row0 = wr * 64 + fr, col0 = u.pn * BM + wc * 32 + 4 * fq;
#pragma unroll
        for (int ai = 0; ai < 2; ++ai)
#pragma unroll
            for (int m = 0; m < 4; ++m) { const int row = row0 + ai * HALF + m * 16; if (row < NB) {
#pragma unroll
                for (int bj = 0; bj < 2; ++bj)
#pragma unroll
                    for (int n = 0; n < 2; ++n) { const int c = col0 + bj * HALF + n * 16; *(f32x4*)(C + (size_t)row * MODW + c) = acc[ai][bj][m][n] + *(const f32x4*)(bias + c); } } }
    }
};
struct EpiBf16 {
    static constexpr bool PERM = true, MID = false, DIAG = false;
    bf16_t* O; int ldc; int col_off; const float* scale;
    __device__ __forceinline__ void operator()(const Acc& acc, const Unit& u, int wr, int wc, int fr, int fq) const {
        const int row0 = u.pm * BM + wr * 64 + fr, col0 = u.pn * BM + wc * 32 + 8 * fq;
#pragma unroll
        for (int ai = 0; ai < 2; ++ai)
#pragma unroll
            for (int m = 0; m < 4; ++m) { bf16_t* rowp = O + (size_t)(row0 + ai * HALF + m * 16) * ldc + col_off + col0;
#pragma unroll
                for (int bj = 0; bj < 2; ++bj) { f32x4 v0 = acc[ai][bj][m][0], v1 = acc[ai][bj][m][1];
                    if (scale) { v0 *= *(const f32x4*)(scale + col0 + bj * HALF); v1 *= *(const f32x4*)(scale + col0 + bj * HALF + 4); }
                    u32x4 w; w.x = pk2(v0[0], v0[1]); w.y = pk2(v0[2], v0[3]); w.z = pk2(v1[0], v1[1]); w.w = pk2(v1[2], v1[3]);
                    *(u32x4*)(rowp + bj * HALF) = w; }
                if (scale) asm volatile("" ::: "memory"); }
    }
};
struct EpiG1 {
    static constexpr bool PERM = true, MID = false, DIAG = false;
    float* T1; const bf16_t* proj;
    __device__ __forceinline__ void operator()(const Acc& acc, const Unit& u, int wr, int wc, int fr, int fq) const {
        const int row0 = u.pm * BM + wr * 64 + fr, col0 = u.pn * BM + wc * 32 + 8 * fq;
#pragma unroll
        for (int ai = 0; ai < 2; ++ai)
#pragma unroll
            for (int m = 0; m < 4; ++m) { const size_t row = (size_t)(row0 + ai * HALF + m * 16); const bf16_t* pr = proj + row * NPROJ + col0;
#pragma unroll
                for (int bj = 0; bj < 2; ++bj) { float ga[8]; unpack8(*(const u32x4*)(pr + C_GA + bj * HALF), ga); f32x4 v0, v1;
#pragma unroll
                    for (int j = 0; j < 4; ++j) { v0[j] = acc[ai][bj][m][0][j] * __builtin_amdgcn_rcpf(1.0f + __expf(-ga[j])); v1[j] = acc[ai][bj][m][1][j] * __builtin_amdgcn_rcpf(1.0f + __expf(-ga[4 + j])); }
                    float* o = T1 + row * DM + col0 + bj * HALF; *(f32x4*)o = v0; *(f32x4*)(o + 4) = v1; }
                }
    }
};
struct EpiG2 {
    static constexpr bool PERM = true, MID = false, DIAG = false;
    bf16_t* O; const float* T1; const bf16_t* proj;
    __device__ __forceinline__ void operator()(const Acc& acc, const Unit& u, int wr, int wc, int fr, int fq) const {
        const int row0 = u.pm * BM + wr * 64 + fr, col0 = u.pn * BM + wc * 32 + 8 * fq;
#pragma unroll
        for (int ai = 0; ai < 2; ++ai)
#pragma unroll
            for (int m = 0; m < 4; ++m) { const size_t row = (size_t)(row0 + ai * HALF + m * 16); const bf16_t* pr = proj + row * NPROJ + col0;
#pragma unroll
                for (int bj = 0; bj < 2; ++bj) { float gb[8], v[8]; unpack8(*(const u32x4*)(pr + C_GB + bj * HALF), gb);
                    const float* t = T1 + row * DM + col0 + bj * HALF; const f32x4 t0 = *(const f32x4*)t, t1 = *(const f32x4*)(t + 4);
#pragma unroll
                    for (int j = 0; j < 4; ++j) { v[j] = t0[j] + acc[ai][bj][m][0][j] * __builtin_amdgcn_rcpf(1.0f + __expf(-gb[j])); v[4 + j] = t1[j] + acc[ai][bj][m][1][j] * __builtin_amdgcn_rcpf(1.0f + __expf(-gb[4 + j])); }
                    *(u32x4*)(O + row * DM + col0 + bj * HALF) = pack8(v); }
                if (m & 1) asm volatile("" ::: "memory"); }
    }
};
struct EpiG12 {
    static constexpr bool PERM = true, MID = false, DIAG = false;
    EpiG1 e1; EpiG2 e2;
    __device__ __forceinline__ void operator()(const Acc& acc, const Unit& u, int wr, int wc, int fr, int fq) const { if (u.piece == 0) e1(acc, u, wr, wc, fr, fq); else e2(acc, u, wr, wc, fr, fq); }
};
struct EpiDiag {
    static constexpr bool PERM = true, MID = false, DIAG = true;
    bf16_t* O; const bf16_t* proj;
    __device__ __forceinline__ void operator()(const Acc& acc, const Unit& u, int wr, int wc, int fr, int fq) const {
        const int row0 = u.pm * HALF + wr * 64 + fr, col0 = u.pn * HALF + wc * 32 + 8 * fq;
#pragma unroll
        for (int m = 0; m < 4; ++m) { const size_t row = (size_t)(row0 + m * 16); const bf16_t* pr = proj + row * NPROJ + col0;
            float ga[8], gb[8], v[8]; unpack8(*(const u32x4*)(pr + C_GA), ga); unpack8(*(const u32x4*)(pr + C_GB), gb);
#pragma unroll
            for (int n = 0; n < 2; ++n)
#pragma unroll
                for (int j = 0; j < 4; ++j) v[4 * n + j] = acc[0][0][m][n][j] * __builtin_amdgcn_rcpf(1.0f + __expf(-ga[4 * n + j])) + acc[1][1][m][n][j] * __builtin_amdgcn_rcpf(1.0f + __expf(-gb[4 * n + j]));
            *(u32x4*)(O + row * DM + col0) = pack8(v); }
    }
};
struct EpiRes {
    static constexpr bool PERM = false, MID = false, DIAG = false;
    float* X1; const float* x0p; const float* x0s; const float* gate; float* PB;
    __device__ __forceinline__ void operator()(const Acc& acc, const Unit& u, int wr, int wc, int fr, int fq) const {
        const int row0 = u.pm * BM + wr * 64 + fr, col0 = u.pn * BM + wc * 32 + 4 * fq;
        if (u.piece >= 0) {
            float* pb = PB + (size_t)u.piece * TS * DM;
#pragma unroll
            for (int ai = 0; ai < 2; ++ai)
#pragma unroll
                for (int m = 0; m < 4; ++m) { float* orow = pb + (size_t)(row0 + ai * HALF + m * 16 - TP) * DM;
#pragma unroll
                    for (int bj = 0; bj < 2; ++bj)
#pragma unroll
                        for (int n = 0; n < 2; ++n) *(f32x4*)(orow + col0 + bj * HALF + n * 16) = acc[ai][bj][m][n]; }
            return;
        }
#pragma unroll
        for (int ai = 0; ai < 2; ++ai)
#pragma unroll
            for (int m = 0; m < 4; ++m) { const int row = row0 + ai * HALF + m * 16; const int b = bidx_of_row(row);
                const float* xr = (row < TP) ? x0p + (size_t)row * DM : x0s + (size_t)(row - TP) * DM; const float* gr = gate + (size_t)b * MODW; float* orow = X1 + (size_t)row * DM;
#pragma unroll
                for (int bj = 0; bj < 2; ++bj)
#pragma unroll
                    for (int n = 0; n < 2; ++n) { const int c = col0 + bj * HALF + n * 16; const f32x4 xv = *(const f32x4*)(xr + c), gv = *(const f32x4*)(gr + c);
                        *(f32x4*)(orow + c) = xv + gv * acc[ai][bj][m][n]; } }
    }
};
struct EpiGU {
    static constexpr bool PERM = true, MID = false, DIAG = false;
    bf16_t* O;
    __device__ __forceinline__ void operator()(const Acc& acc, const Unit& u, int wr, int wc, int fr, int fq) const {
        const int row0 = u.pm * BM + wr * 64 + fr, col0 = u.pn * HALF + wc * 32 + 8 * fq;
#pragma unroll
        for (int ai = 0; ai < 2; ++ai)
#pragma unroll
            for (int m = 0; m < 4; ++m) { float v[8];
#pragma unroll
                for (int n = 0; n < 2; ++n)
#pragma unroll
                    for (int j = 0; j < 4; ++j) { const float gt = acc[ai][0][m][n][j]; v[4 * n + j] = gt * __builtin_amdgcn_rcpf(1.0f + __expf(-gt)) * acc[ai][1][m][n][j]; }
                *(u32x4*)(O + (size_t)(row0 + ai * HALF + m * 16) * DFF + col0) = pack8(v); }
    }
};
}

struct TJob { const float* src; bf16_t* dst; int ld_src, K, Nout, ld_dst, map, pad; };
__device__ __forceinline__ int map_col(int map, int n) {
    if (map == 1) { if (n < 4096) return n; if (n < 5120) return 4112 + (n - 4096); if (n < 9216) return 5136 + (n - 5120); if (n < 9232) return 4096 + (n - 9216); return -1; }
    if (map == 2) { const int pn = n >> 8, w = n & 255; return w < 128 ? 128 * pn + w : DFF + 128 * pn + (w - 128); }
    return n;
}
__device__ __forceinline__ void tjob_load(const TJob& j, int tile, f32x4 (&v)[4]) {
    const int tid = threadIdx.x, nkt = j.K >> 7, tn = tile / nkt, tk = tile - tn * nkt;
    const int n = tn * 64 + (tid & 15) * 4, kr = tid >> 4, col = map_col(j.map, n);
#pragma unroll
    for (int i = 0; i < 4; ++i) v[i] = col >= 0 ? __builtin_nontemporal_load((const f32x4*)(j.src + (size_t)(tk * 128 + kr + 32 * i) * j.ld_src + col)) : (f32x4){0.f, 0.f, 0.f, 0.f};
}
__device__ __forceinline__ void tjob_store(const TJob& j, int tile, const f32x4 (&v)[4], LAS float* s) {
    const int tid = threadIdx.x, nkt = j.K >> 7, tn = tile / nkt, tk = tile - tn * nkt;
    const int nq = tid & 15, kr = tid >> 4;
    __syncthreads();
#pragma unroll
    for (int i = 0; i < 4; ++i)
#pragma unroll
        for (int q = 0; q < 4; ++q) s[(4 * nq + q) * 129 + kr + 32 * i] = v[i][q];
    __syncthreads();
    const int n = tid >> 3, k16 = (tid & 7) * 16;
    float f[16];
#pragma unroll
    for (int i = 0; i < 16; ++i) f[i] = s[n * 129 + k16 + i];
    bf16_t* d = j.dst + (size_t)(tn * 64 + n) * j.ld_dst + tk * 128 + k16;
    *(u32x4*)d = pack8(f); *(u32x4*)(d + 8) = pack8(f + 8);
}
__device__ __forceinline__ void transpose_jobs(const TJob* jobs, int njobs, int bi, int nblk, LAS unsigned char* lds) {
    LAS float* s = (LAS float*)lds;
    int total = 0;
    for (int q = 0; q < njobs; ++q) total += (jobs[q].Nout >> 6) * (jobs[q].K >> 7);
    f32x4 v[4]; int curj = 0, base = 0;
    int t = bi;
    auto locate = [&](int tt, int& jj, int& bb) { while (tt >= bb + (jobs[jj].Nout >> 6) * (jobs[jj].K >> 7)) { bb += (jobs[jj].Nout >> 6) * (jobs[jj].K >> 7); ++jj; } };
    if (t < total) { locate(t, curj, base); tjob_load(jobs[curj], t - base, v); }
    while (t < total) {
        const int tn = t + nblk; int nj = curj, nb = base; f32x4 w[4];
        if (tn < total) { locate(tn, nj, nb); tjob_load(jobs[nj], tn - nb, w); }
        tjob_store(jobs[curj], t - base, v, s);
        if (tn < total) {
#pragma unroll
            for (int i = 0; i < 4; ++i) v[i] = w[i]; }
        t = tn; curj = nj; base = nb;
    }
    __syncthreads();
}

template <int MODE>
__device__ __forceinline__ void norm_phase(const Params& p, int bid, int nblk) {
    const int lane = threadIdx.x & 63, wid = __builtin_amdgcn_readfirstlane(threadIdx.x >> 6);
    const float* mod = (const float*)(p.ws + WS_MOD);
    const float* gain = MODE == 0 ? p.in[9] : (MODE == 1 ? p.in[20] : p.in[23]);
    bf16_t* U = (bf16_t*)(p.ws + WS_U);
    auto srcrow = [&](int row) -> const float* { return MODE == 0 ? (row < TP ? p.in[0] + (size_t)row * DM : p.in[1] + (size_t)(row - TP) * DM) : p.out + O_Y + (size_t)row * DM; };
    const int stride = nblk * 8;
    f32x4 g[8];
#pragma unroll
    for (int i = 0; i < 8; ++i) g[i] = *(const f32x4*)(gain + i * 256 + lane * 4);
    f32x4 v[8], vn[8];
    bool have = false;
    const bool weighted = (MODE != 0) && nblk == 256;
    const int first = bid * 8 + wid;
    const int nrows = weighted ? (wid < 2 ? 2 : 5) : (first < TT ? (TT - first + stride - 1) / stride : 0);
    auto rowat = [&](int k) -> int { return weighted ? (wid < 2 ? (k == 0 ? TP + bid * 2 + wid : bid * 32 + wid) : bid * 32 + 2 + (wid - 2) * 5 + k) : first + k * stride; };
    for (int k = 0; k < nrows; ++k) {
        const int row = rowat(k);
        const float* src = srcrow(row);
        if (MODE != 0 && row >= TP) {
            const float* xs = p.in[1] + (size_t)(row - TP) * DM;
            const float* pb = (const float*)(p.ws + (MODE == 1 ? WS_PB10 : WS_PB13)) + (size_t)(row - TP) * DM;
            const float* gt = mod + (size_t)bidx_of_row(row) * MODW + (MODE == 1 ? 4096 : 10240);
            float* xo = p.out + O_Y + (size_t)row * DM;
            constexpr int NPC = MODE == 1 ? 8 : 11;
#pragma unroll 1
            for (int i = 0; i < 8; ++i) { const int c = i * 256 + lane * 4; f32x4 s = *(const f32x4*)(pb + c);
#pragma unroll
                for (int q = 1; q < NPC; ++q) s += *(const f32x4*)(pb + (size_t)q * TS * DM + c);
                const f32x4 base = MODE == 1 ? *(const f32x4*)(xs + c) : *(const f32x4*)(xo + c);
                *(f32x4*)(xo + c) = base + *(const f32x4*)(gt + c) * s; }
            asm volatile("s_waitcnt vmcnt(0)" ::: "memory");
        }
        f32x4 s1[8], s0[8]; float ss = 0.f;
        const float* sh = mod + (size_t)bidx_of_row(row) * MODW + (MODE == 0 ? 0 : 6144); const float* sc = sh + 2048;
        if (!have) {
#pragma unroll
            for (int i = 0; i < 8; ++i) v[i] = *(const f32x4*)(src + i * 256 + lane * 4);
        }
        if (MODE != 2) {
#pragma unroll
            for (int i = 0; i < 8; ++i) { const int c = i * 256 + lane * 4; s1[i] = *(const f32x4*)(sc + c); s0[i] = *(const f32x4*)(sh + c); }
        }
        const int nrow = (k + 1 < nrows) ? rowat(k + 1) : TT;
        const bool pre = nrow < TT && (MODE == 0 || nrow < TP);
        if (pre) { const float* ns = srcrow(nrow);
#pragma unroll
            for (int i = 0; i < 8; ++i) vn[i] = *(const f32x4*)(ns + i * 256 + lane * 4); }
        asm volatile("" ::: "memory");
#pragma unroll
        for (int i = 0; i < 8; ++i) ss += v[i][0] * v[i][0] + v[i][1] * v[i][1] + v[i][2] * v[i][2] + v[i][3] * v[i][3];
#pragma unroll
        for (int o = 32; o >= 1; o >>= 1) ss += __shfl_xor(ss, o);
        const float rstd = rsqrtf(ss * (1.0f / DM) + EPS);
        if (MODE == 2) {
            float* dst = p.out + O_Y + (size_t)row * DM;
#pragma unroll
            for (int i = 0; i < 8; ++i) *(f32x4*)(dst + i * 256 + lane * 4) = v[i] * rstd * g[i];
        } else {
#pragma unroll
            for (int i = 0; i < 8; ++i) { const int c = i * 256 + lane * 4;
                const f32x4 y = (v[i] * rstd * g[i]) * (1.0f + s1[i]) + s0[i]; u32x2 w; w.x = pk2(y[0], y[1]); w.y = pk2(y[2], y[3]); *(u32x2*)(U + (size_t)row * DM + c) = w; }
        }
        have = pre;
        if (pre) {
#pragma unroll
            for (int i = 0; i < 8; ++i) v[i] = vn[i]; }
    }
}

template <int NTOK, bool SMP>
__device__ __forceinline__ void mixer_item(const Params& p, int it) {
    const int tid = threadIdx.x;
    const bf16_t* proj = (const bf16_t*)(p.ws + WS_PROJ);
    bf16_t* qn = (bf16_t*)(p.ws + WS_QN); bf16_t* kn = (bf16_t*)(p.ws + WS_KN); bf16_t* vv = (bf16_t*)(p.ws + WS_VV); bf16_t* yp = (bf16_t*)(p.ws + WS_YP);
    float* gbuf = (float*)(p.ws + WS_G); float* bbuf = (float*)(p.ws + WS_BETA);
    const int sb = it - 512;
    const int b = SMP ? 0 : (it >> 7), t0 = SMP ? 0 : (it & 127) * 16;
    const int rowbase = SMP ? TP + sb * 4 : b * 2048 + t0;
    if (tid < 384) {
        const int c0 = tid * 8;
        float w0[8], w1[8], w2[8], w3[8], xm3[8], xm2[8], xm1[8];
        const float* cw = p.in[11];
#pragma unroll
        for (int i = 0; i < 8; ++i) { w0[i] = cw[c0 + i]; w1[i] = cw[3072 + c0 + i]; w2[i] = cw[6144 + c0 + i]; w3[i] = cw[9216 + c0 + i]; }
        if (SMP) { const float* sc = p.in[5] + (size_t)sb * 3 * 3072 + c0;
#pragma unroll
            for (int i = 0; i < 8; ++i) { xm3[i] = sc[i]; xm2[i] = sc[3072 + i]; xm1[i] = sc[6144 + i]; }
        } else if (t0 == 0) {
#pragma unroll
            for (int i = 0; i < 8; ++i) { xm3[i] = 0.f; xm2[i] = 0.f; xm1[i] = 0.f; }
        } else {
            unpack8(*(const u32x4*)(proj + (size_t)(rowbase - 3) * NPROJ + c0), xm3); unpack8(*(const u32x4*)(proj + (size_t)(rowbase - 2) * NPROJ + c0), xm2); unpack8(*(const u32x4*)(proj + (size_t)(rowbase - 1) * NPROJ + c0), xm1);
        }
        constexpr int CH = NTOK < 8 ? NTOK : 8;
#pragma unroll
        for (int tc = 0; tc < NTOK; tc += CH) {
        u32x4 xr[CH];
#pragma unroll
        for (int t = 0; t < CH; ++t) xr[t] = *(const u32x4*)(proj + (size_t)(rowbase + tc + t) * NPROJ + c0);
#pragma unroll
        for (int t2 = 0; t2 < CH; ++t2) {
            const int t = tc + t2;
            const int row = rowbase + t; float xt[8], y[8];
            unpack8(xr[t2], xt);
            float ss = 0.f;
#pragma unroll
            for (int i = 0; i < 8; ++i) { const float a = w0[i] * xm3[i] + w1[i] * xm2[i] + w2[i] * xm1[i] + w3[i] * xt[i]; y[i] = siluf_(a); ss += y[i] * y[i]; }
            if (c0 < 2048) {
                ss += __shfl_xor(ss, 1); ss += __shfl_xor(ss, 2); ss += __shfl_xor(ss, 4); ss += __shfl_xor(ss, 8);
                const float inv = rsqrtf(ss + EPS);
#pragma unroll
                for (int i = 0; i < 8; ++i) y[i] *= inv;
            }
            bf16_t* dst = c0 < 1024 ? qn + (size_t)row * 1024 + c0 : (c0 < 2048 ? kn + (size_t)row * 1024 + (c0 - 1024) : vv + (size_t)row * 1024 + (c0 - 2048));
            *(u32x4*)dst = pack8(y);
            if (SMP) { if (t >= 1) { float* o = p.out + O_CS + ((size_t)sb * 3 + (t - 1)) * 3072 + c0; *(f32x4*)o = (f32x4){xt[0], xt[1], xt[2], xt[3]}; *(f32x4*)(o + 4) = (f32x4){xt[4], xt[5], xt[6], xt[7]}; } }
            else if (t0 + t >= 2045) { float* o = p.out + O_CP + ((size_t)b * 3 + (t0 + t - 2045)) * 3072 + c0; *(f32x4*)o = (f32x4){xt[0], xt[1], xt[2], xt[3]}; *(f32x4*)(o + 4) = (f32x4){xt[4], xt[5], xt[6], xt[7]}; }
#pragma unroll
            for (int i = 0; i < 8; ++i) { xm3[i] = xm2[i]; xm2[i] = xm1[i]; xm1[i] = xt[i]; }
        }
        }
    } else {
        const int pc = (tid - 384) * 8, gi = pc >> 8, w = 2 << gi;
        const int seqrow0 = SMP ? TP + sb * 4 : b * 2048;
        const float* sp = p.in[6] + (size_t)sb * 15 * 1024 + pc;
        auto xpool = [&](int tt, float* f) {
            if (tt >= 0) unpack8(*(const u32x4*)(proj + (size_t)(seqrow0 + tt) * NPROJ + C_XP + pc), f);
            else if (SMP) { const float* s = sp + (size_t)(15 + tt) * 1024;
#pragma unroll
                for (int i = 0; i < 8; ++i) f[i] = s[i]; }
            else {
#pragma unroll
                for (int i = 0; i < 8; ++i) f[i] = 0.f; }
        };
        float s[8];
#pragma unroll
        for (int i = 0; i < 8; ++i) s[i] = 0.f;
#pragma unroll
        for (int q = 1; q < 16; ++q) if (q < w) { float f[8]; xpool(t0 - q, f);
#pragma unroll
            for (int i = 0; i < 8; ++i) s[i] += f[i]; }
#pragma unroll 4
        for (int t = 0; t < NTOK; ++t) {
            const int tt = t0 + t; float x[8], y[8], f[8];
            xpool(tt, x);
            const float cnt = SMP ? (float)w : (float)min(w, tt + 1); const float ic = 1.0f / cnt;
#pragma unroll
            for (int i = 0; i < 8; ++i) { s[i] += x[i]; y[i] = s[i] * ic - x[i]; }
            *(u32x4*)(yp + (size_t)(seqrow0 + tt) * 1024 + pc) = pack8(y);
            xpool(tt - w + 1, f);
#pragma unroll
            for (int i = 0; i < 8; ++i) s[i] -= f[i];
            if (SMP) { float* o = p.out + O_PS + ((size_t)sb * 15 + 11 + t) * 1024 + pc; *(f32x4*)o = (f32x4){x[0], x[1], x[2], x[3]}; *(f32x4*)(o + 4) = (f32x4){x[4], x[5], x[6], x[7]}; }
            else if (tt >= 2033) { float* o = p.out + O_PP + ((size_t)b * 15 + (tt - 2033)) * 1024 + pc; *(f32x4*)o = (f32x4){x[0], x[1], x[2], x[3]}; *(f32x4*)(o + 4) = (f32x4){x[4], x[5], x[6], x[7]}; }
        }
        if (SMP) {
#pragma unroll
            for (int r = 0; r < 11; ++r) { const float* s2 = sp + (size_t)(4 + r) * 1024; float* o = p.out + O_PS + ((size_t)sb * 15 + r) * 1024 + pc; *(f32x4*)o = *(const f32x4*)s2; *(f32x4*)(o + 4) = *(const f32x4*)(s2 + 4); } }
    }
    if (tid < 256) { const int tk = tid >> 4, jj = tid & 15;
        if (tk < NTOK) { const int row = rowbase + tk; const float val = bf2f(proj[(size_t)row * NPROJ + C_AB + jj]);
            if (jj < 8) { const float xx = val + p.in[13][jj]; const float spl = xx > 20.f ? xx : log1pf(__expf(xx)); gbuf[row * 8 + jj] = -__expf(p.in[12][jj]) * spl; }
            else bbuf[row * 8 + (jj - 8)] = sigmoidf_(val); } }
}
__device__ __forceinline__ void mixer_prep_phase(const Params& p, int bid, int nblk) {
    for (int it = bid; it < 640; it += nblk) { if (it >= 512) mixer_item<4, true>(p, it); else mixer_item<16, false>(p, it); }
}

constexpr int P5_QS = 0, P5_KS = 17408, P5_VS = 34816, P5_MM = 52224, P5_DEC = 68608, P5_BETA = 68864, P5_GRP = 69632;
static_assert(2 * P5_GRP <= LDS_BYTES - 16, "lds");
__device__ __forceinline__ void chunk_prep_phase(const Params& p, int bid, int nblk, LAS unsigned char* lds0) {
    const int tid = threadIdx.x, lane = tid & 63, grp = tid >> 8, lt = tid & 255, lw = __builtin_amdgcn_readfirstlane(tid >> 6) & 3;
    LAS unsigned char* lds = lds0 + grp * P5_GRP;
    const bf16_t* qn = (const bf16_t*)(p.ws + WS_QN); const bf16_t* kn = (const bf16_t*)(p.ws + WS_KN); const bf16_t* vv = (const bf16_t*)(p.ws + WS_VV);
    const float* gbuf = (const float*)(p.ws + WS_G); const float* bbuf = (const float*)(p.ws + WS_BETA);
    bf16_t* wdc = (bf16_t*)(p.ws + WS_WDC); bf16_t* qd = (bf16_t*)(p.ws + WS_QD); bf16_t* kt = (bf16_t*)(p.ws + WS_KT); bf16_t* qk = (bf16_t*)(p.ws + WS_QK);
    float* cdv = (float*)(p.ws + WS_CD); float* ub = p.out + OS_UB;
    LAS float* Mm = (LAS float*)(lds + P5_MM); LAS float* dec = (LAS float*)(lds + P5_DEC); LAS float* bet = (LAS float*)(lds + P5_BETA);
    const float scale = 0.08838834764831845f;
    for (int it0 = bid * 2; it0 < 1024; it0 += nblk * 2) {
        const int item = it0 + grp, n = item & 31, bh = item >> 5, h = bh & 7, b = bh >> 3;
        const int r0 = b * 2048 + n * 64;
        __syncthreads();
#pragma unroll
        for (int i = 0; i < 4; ++i) { const int ch = lt + 256 * i, r = ch >> 4, c8 = (ch & 15) * 8; const size_t go = (size_t)(r0 + r) * 1024 + h * 128 + c8; const int lo = r * 272 + c8 * 2;
            *(LAS u32x4*)(lds + P5_QS + lo) = *(const u32x4*)(qn + go); *(LAS u32x4*)(lds + P5_KS + lo) = *(const u32x4*)(kn + go); *(LAS u32x4*)(lds + P5_VS + lo) = *(const u32x4*)(vv + go); }
        if (lt < 64) {
            float g = gbuf[(r0 + lt) * 8 + h];
#pragma unroll
            for (int o = 1; o < 64; o <<= 1) { const float t = __shfl_up(g, o); if (lane >= o) g += t; }
            dec[lt] = g;
        } else if (lt < 128) bet[lt - 64] = bbuf[(r0 + lt - 64) * 8 + h];
        __syncthreads();
        {
            const int rt = lw, fr = lane & 15, fq = lane >> 4;
#pragma unroll
            for (int mat = 0; mat < 2; ++mat) {
                bf16x8 a[4];
#pragma unroll
                for (int kk = 0; kk < 4; ++kk) a[kk] = *(const LAS bf16x8*)(lds + (mat ? P5_QS : P5_KS) + (rt * 16 + fr) * 272 + (kk * 32 + fq * 8) * 2);
#pragma unroll
                for (int st = 0; st < 4; ++st) {
                    f32x4 d = (f32x4){0.f, 0.f, 0.f, 0.f};
#pragma unroll
                    for (int kk = 0; kk < 4; ++kk) { const bf16x8 bb = *(const LAS bf16x8*)(lds + P5_KS + (st * 16 + fr) * 272 + (kk * 32 + fq * 8) * 2); d = __builtin_amdgcn_mfma_f32_16x16x32_bf16(a[kk], bb, d, 0, 0, 0); }
                    const int s = st * 16 + fr; const float ds = dec[s];
#pragma unroll
                    for (int j = 0; j < 4; ++j) { const int r = rt * 16 + fq * 4 + j; const float dr = dec[r];
                        if (mat == 0) Mm[r * 64 + s] = (r > s) ? bet[r] * d[j] * __expf(dr - ds) : 0.f;
                        else qk[(size_t)item * 4096 + r * 64 + s] = f2bf((r >= s) ? scale * d[j] * __expf(dr - ds) : 0.f); }
                }
            }
        }
        __syncthreads();
        const int w8 = __builtin_amdgcn_readfirstlane(tid >> 6);
        if (w8 < 4) {
            const int g2 = w8 >> 1, c = (w8 & 1) * 64 + lane; const int item2 = it0 + g2;
            LAS unsigned char* lg = lds0 + g2 * P5_GRP; LAS float* Mg = (LAS float*)(lg + P5_MM); LAS float* decg = (LAS float*)(lg + P5_DEC); LAS float* betg = (LAS float*)(lg + P5_BETA);
            f32x2 xy[64]; f32x4 mq[6]; f32x2 ab0, ab1;
            float* up = ub + (size_t)item2 * 8192 + c; bf16_t* wp = wdc + (size_t)item2 * 8192 + c;
            { const float br = betg[0]; ab0 = (f32x2){bf2f(*(const LAS bf16_t*)(lg + P5_VS + 0 + c * 2)) * br, bf2f(*(const LAS bf16_t*)(lg + P5_KS + 0 + c * 2)) * br * __expf(decg[0])}; ab1 = (f32x2){0.f, 0.f}; } xy[0] = ab0; up[0] = xy[0][0]; wp[0] = f2bf(-xy[0][1]);
            mq[0] = *(const LAS f32x4*)(Mg + 64); mq[1] = *(const LAS f32x4*)(Mg + 128); mq[2] = *(const LAS f32x4*)(Mg + 192); mq[3] = *(const LAS f32x4*)(Mg + 256); mq[4] = *(const LAS f32x4*)(Mg + 320); mq[5] = *(const LAS f32x4*)(Mg + 324);
            { const float br = betg[1]; ab0 = (f32x2){bf2f(*(const LAS bf16_t*)(lg + P5_VS + 272 + c * 2)) * br, bf2f(*(const LAS bf16_t*)(lg + P5_KS + 272 + c * 2)) * br * __expf(decg[1])}; ab1 = (f32x2){0.f, 0.f}; } ab0 -= mq[0][0] * xy[0]; xy[1] = ab0 + ab1; up[128] = xy[1][0]; wp[128] = f2bf(-xy[1][1]); mq[0] = *(const LAS f32x4*)(Mg + 384);
            { const float br = betg[2]; ab0 = (f32x2){bf2f(*(const LAS bf16_t*)(lg + P5_VS + 544 + c * 2)) * br, bf2f(*(const LAS bf16_t*)(lg + P5_KS + 544 + c * 2)) * br * __expf(decg[2])}; ab1 = (f32x2){0.f, 0.f}; } ab0 -= mq[1][0] * xy[0]; ab1 -= mq[1][1] * xy[1]; xy[2] = ab0 + ab1; up[256] = xy[2][0]; wp[256] = f2bf(-xy[2][1]); mq[1] = *(const LAS f32x4*)(Mg + 388);
            { const float br = betg[3]; ab0 = (f32x2){bf2f(*(const LAS bf16_t*)(lg + P5_VS + 816 + c * 2)) * br, bf2f(*(const LAS bf16_t*)(lg + P5_KS + 816 + c * 2)) * br * __expf(decg[3])}; ab1 = (f32x2){0.f, 0.f}; } ab0 -= mq[2][0] * xy[0]; ab1 -= mq[2][1] * xy[1]; ab0 -= mq[2][2] * xy[2]; xy[3] = ab0 + ab1; up[384] = xy[3][0]; wp[384] = f2bf(-xy[3][1]); mq[2] = *(const LAS f32x4*)(Mg + 448);
            { const float br = betg[4]; ab0 = (f32x2){bf2f(*(const LAS bf16_t*)(lg + P5_VS + 1088 + c * 2)) * br, bf2f(*(const LAS bf16_t*)(lg + P5_KS + 1088 + c * 2)) * br * __expf(decg[4])}; ab1 = (f32x2){0.f, 0.f}; } ab0 -= mq[3][0] * xy[0]; ab1 -= mq[3][1] * xy[1]; ab0 -= mq[3][2] * xy[2]; ab1 -= mq[3][3] * xy[3]; xy[4] = ab0 + ab1; up[512] = xy[4][0]; wp[512] = f2bf(-xy[4][1]); mq[3] = *(const LAS f32x4*)(Mg + 452);
            { const float br = betg[5]; ab0 = (f32x2){bf2f(*(const LAS bf16_t*)(lg + P5_VS + 1360 + c * 2)) * br, bf2f(*(const LAS bf16_t*)(lg + P5_KS + 1360 + c * 2)) * br * __expf(decg[5])}; ab1 = (f32x2){0.f, 0.f}; } ab0 -= mq[4][0] * xy[0]; ab1 -= mq[4][1] * xy[1]; ab0 -= mq[4][2] * xy[2]; ab1 -= mq[4][3] * xy[3]; mq[4] = *(const LAS f32x4*)(Mg + 512);
            ab0 -= mq[5][0] * xy[4]; xy[5] = ab0 + ab1; up[640] = xy[5][0]; wp[640] = f2bf(-xy[5][1]); mq[5] = *(const LAS f32x4*)(Mg + 516);
            { const float br = betg[6]; ab0 = (f32x2){bf2f(*(const LAS bf16_t*)(lg + P5_VS + 1632 + c * 2)) * br, bf2f(*(const LAS bf16_t*)(lg + P5_KS + 1632 + c * 2)) * br * __expf(decg[6])}; ab1 = (f32x2){0.f, 0.f}; } ab0 -= mq[0][0] * xy[0]; ab1 -= mq[0][1] * xy[1]; ab0 -= mq[0][2] * xy[2]; ab1 -= mq[0][3] * xy[3]; mq[0] = *(const LAS f32x4*)(Mg + 576);
            ab0 -= mq[1][0] * xy[4]; ab1 -= mq[1][1] * xy[5]; xy[6] = ab0 + ab1; up[768] = xy[6][0]; wp[768] = f2bf(-xy[6][1]); mq[1] = *(const LAS f32x4*)(Mg + 580);
            { const float br = betg[7]; ab0 = (f32x2){bf2f(*(const LAS bf16_t*)(lg + P5_VS + 1904 + c * 2)) * br, bf2f(*(const LAS bf16_t*)(lg + P5_KS + 1904 + c * 2)) * br * __expf(decg[7])}; ab1 = (f32x2){0.f, 0.f}; } ab0 -= mq[2][0] * xy[0]; ab1 -= mq[2][1] * xy[1]; ab0 -= mq[2][2] * xy[2]; ab1 -= mq[2][3] * xy[3]; mq[2] = *(const LAS f32x4*)(Mg + 584);
            ab0 -= mq[3][0] * xy[4]; ab1 -= mq[3][1] * xy[5]; ab0 -= mq[3][2] * xy[6]; xy[7] = ab0 + ab1; up[896] = xy[7][0]; wp[896] = f2bf(-xy[7][1]); mq[3] = *(const LAS f32x4*)(Mg + 640);
            { const float br = betg[8]; ab0 = (f32x2){bf2f(*(const LAS bf16_t*)(lg + P5_VS + 2176 + c * 2)) * br, bf2f(*(const LAS bf16_t*)(lg + P5_KS + 2176 + c * 2)) * br * __expf(decg[8])}; ab1 = (f32x2){0.f, 0.f}; } ab0 -= mq[4][0] * xy[0]; ab1 -= mq[4][1] * xy[1]; ab0 -= mq[4][2] * xy[2]; ab1 -= mq[4][3] * xy[3]; mq[4] = *(const LAS f32x4*)(Mg + 644);
            ab0 -= mq[5][0] * xy[4]; ab1 -= mq[5][1] * xy[5]; ab0 -= mq[5][2] * xy[6]; ab1 -= mq[5][3] * xy[7]; xy[8] = ab0 + ab1; up[1024] = xy[8][0]; wp[1024] = f2bf(-xy[8][1]); mq[5] = *(const LAS f32x4*)(Mg + 648);
            { const float br = betg[9]; ab0 = (f32x2){bf2f(*(const LAS bf16_t*)(lg + P5_VS + 2448 + c * 2)) * br, bf2f(*(const LAS bf16_t*)(lg + P5_KS + 2448 + c * 2)) * br * __expf(decg[9])}; ab1 = (f32x2){0.f, 0.f}; } ab0 -= mq[0][0] * xy[0]; ab1 -= mq[0][1] * xy[1]; ab0 -= mq[0][2] * xy[2]; ab1 -= mq[0][3] * xy[3]; mq[0] = *(const LAS f32x4*)(Mg + 704);
            ab0 -= mq[1][0] * xy[4]; ab1 -= mq[1][1] * xy[5]; ab0 -= mq[1][2] * xy[6]; ab1 -= mq[1][3] * xy[7]; mq[1] = *(const LAS f32x4*)(Mg + 708);
            ab0 -= mq[2][0] * xy[8]; xy[9] = ab0 + ab1; up[1152] = xy[9][0]; wp[1152] = f2bf(-xy[9][1]); mq[2] = *(const LAS f32x4*)(Mg + 712);
            { const float br = betg[10]; ab0 = (f32x2){bf2f(*(const LAS bf16_t*)(lg + P5_VS + 2720 + c * 2)) * br, bf2f(*(const LAS bf16_t*)(lg + P5_KS + 2720 + c * 2)) * br * __expf(decg[10])}; ab1 = (f32x2){0.f, 0.f}; } ab0 -= mq[3][0] * xy[0]; ab1 -= mq[3][1] * xy[1]; ab0 -= mq[3][2] * xy[2]; ab1 -= mq[3][3] * xy[3]; mq[3] = *(const LAS f32x4*)(Mg + 768);
            ab0 -= mq[4][0] * xy[4]; ab1 -= mq[4][1] * xy[5]; ab0 -= mq[4][2] * xy[6]; ab1 -= mq[4][3] * xy[7]; mq[4] = *(const LAS f32x4*)(Mg + 772);
            ab0 -= mq[5][0] * xy[8]; ab1 -= mq[5][1] * xy[9]; xy[10] = ab0 + ab1; up[1280] = xy[10][0]; wp[1280] = f2bf(-xy[10][1]); mq[5] = *(const LAS f32x4*)(Mg + 776);
            { const float br = betg[11]; ab0 = (f32x2){bf2f(*(const LAS bf16_t*)(lg + P5_VS + 2992 + c * 2)) * br, bf2f(*(const LAS bf16_t*)(lg + P5_KS + 2992 + c * 2)) * br * __expf(decg[11])}; ab1 = (f32x2){0.f, 0.f}; } ab0 -= mq[0][0] * xy[0]; ab1 -= mq[0][1] * xy[1]; ab0 -= mq[0][2] * xy[2]; ab1 -= mq[0][3] * xy[3]; mq[0] = *(const LAS f32x4*)(Mg + 832);
            ab0 -= mq[1][0] * xy[4]; ab1 -= mq[1][1] * xy[5]; ab0 -= mq[1][2] * xy[6]; ab1 -= mq[1][3] * xy[7]; mq[1] = *(const LAS f32x4*)(Mg + 836);
            ab0 -= mq[2][0] * xy[8]; ab1 -= mq[2][1] * xy[9]; ab0 -= mq[2][2] * xy[10]; xy[11] = ab0 + ab1; up[1408] = xy[11][0]; wp[1408] = f2bf(-xy[11][1]); mq[2] = *(const LAS f32x4*)(Mg + 840);
            { const float br = betg[12]; ab0 = (f32x2){bf2f(*(const LAS bf16_t*)(lg + P5_VS + 3264 + c * 2)) * br, bf2f(*(const LAS bf16_t*)(lg + P5_KS + 3264 + c * 2)) * br * __expf(decg[12])}; ab1 = (f32x2){0.f, 0.f}; } ab0 -= mq[3][0] * xy[0]; ab1 -= mq[3][1] * xy[1]; ab0 -= mq[3][2] * xy[2]; ab1 -= mq[3][3] * xy[3]; mq[3] = *(const LAS f32x4*)(Mg + 844);
            ab0 -= mq[4][0] * xy[4]; ab1 -= mq[4][1] * xy[5]; ab0 -= mq[4][2] * xy[6]; ab1 -= mq[4][3] * xy[7]; mq[4] = *(const LAS f32x4*)(Mg + 896);
            ab0 -= mq[5][0] * xy[8]; ab1 -= mq[5][1] * xy[9]; ab0 -= mq[5][2] * xy[10]; ab1 -= mq[5][3] * xy[11]; xy[12] = ab0 + ab1; up[1536] = xy[12][0]; wp[1536] = f2bf(-xy[12][1]); mq[5] = *(const LAS f32x4*)(Mg + 900);
            { const float br = betg[13]; ab0 = (f32x2){bf2f(*(const LAS bf16_t*)(lg + P5_VS + 3536 + c * 2)) * br, bf2f(*(const LAS bf16_t*)(lg + P5_KS + 3536 + c * 2)) * br * __expf(decg[13])}; ab1 = (f32x2){0.f, 0.f}; } ab0 -= mq[0][0] * xy[0]; ab1 -= mq[0][1] * xy[1]; ab0 -= mq[0][2] * xy[2]; ab1 -= mq[0][3] * xy[3]; mq[0] = *(const LAS f32x4*)(Mg + 904);
            ab0 -= mq[1][0] * xy[4]; ab1 -= mq[1][1] * xy[5]; ab0 -= mq[1][2] * xy[6]; ab1 -= mq[1][3] * xy[7]; mq[1] = *(const LAS f32x4*)(Mg + 908);
            ab0 -= mq[2][0] * xy[8]; ab1 -= mq[2][1] * xy[9]; ab0 -= mq[2][2] * xy[10]; ab1 -= mq[2][3] * xy[11]; mq[2] = *(const LAS f32x4*)(Mg + 960);
            ab0 -= mq[3][0] * xy[12]; xy[13] = ab0 + ab1; up[1664] = xy[13][0]; wp[1664] = f2bf(-xy[13][1]); mq[3] = *(const LAS f32x4*)(Mg + 964);
            { const float br = betg[14]; ab0 = (f32x2){bf2f(*(const LAS bf16_t*)(lg + P5_VS + 3808 + c * 2)) * br, bf2f(*(const LAS bf16_t*)(lg + P5_KS + 3808 + c * 2)) * br * __expf(decg[14])}; ab1 = (f32x2){0.f, 0.f}; } ab0 -= mq[4][0] * xy[0]; ab1 -= mq[4][1] * xy[1]; ab0 -= mq[4][2] * xy[2]; ab1 -= mq[4][3] * xy[3]; mq[4] = *(const LAS f32x4*)(Mg + 968);
            ab0 -= mq[5][0] * xy[4]; ab1 -= mq[5][1] * xy[5]; ab0 -= mq[5][2] * xy[6]; ab1 -= mq[5][3] * xy[7]; mq[5] = *(const LAS f32x4*)(Mg + 972);
            ab0 -= mq[0][0] * xy[8]; ab1 -= mq[0][1] * xy[9]; ab0 -= mq[0][2] * xy[10]; ab1 -= mq[0][3] * xy[11]; mq[0] = *(const LAS f32x4*)(Mg + 1024);
            ab0 -= mq[1][0] * xy[12]; ab1 -= mq[1][1] * xy[13]; xy[14] = ab0 + ab1; up[1792] = xy[14][0]; wp[1792] = f2bf(-xy[14][1]); mq[1] = *(const LAS f32x4*)(Mg + 1028);
            { const float br = betg[15]; ab0 = (f32x2){bf2f(*(const LAS bf16_t*)(lg + P5_VS + 4080 + c * 2)) * br, bf2f(*(const LAS bf16_t*)(lg + P5_KS + 4080 + c * 2)) * br * __expf(decg[15])}; ab1 = (f32x2){0.f, 0.f}; } ab0 -= mq[2][0] * xy[0]; ab1 -= mq[2][1] * xy[1]; ab0 -= mq[2][2] * xy[2]; ab1 -= mq[2][3] * xy[3]; mq[2] = *(const LAS f32x4*)(Mg + 1032);
            ab0 -= mq[3][0] * xy[4]; ab1 -= mq[3][1] * xy[5]; ab0 -= mq[3][2] * xy[6]; ab1 -= mq[3][3] * xy[7]; mq[3] = *(const LAS f32x4*)(Mg + 1036);
            ab0 -= mq[4][0] * xy[8]; ab1 -= mq[4][1] * xy[9]; ab0 -= mq[4][2] * xy[10]; ab1 -= mq[4][3] * xy[11]; mq[4] = *(const LAS f32x4*)(Mg + 1088);
            ab0 -= mq[5][0] * xy[12]; ab1 -= mq[5][1] * xy[13]; ab0 -= mq[5][2] * xy[14]; xy[15] = ab0 + ab1; up[1920] = xy[15][0]; wp[1920] = f2bf(-xy[15][1]); mq[5] = *(const LAS f32x4*)(Mg + 1092);
            { const float br = betg[16]; ab0 = (f32x2){bf2f(*(const LAS bf16_t*)(lg + P5_VS + 4352 + c * 2)) * br, bf2f(*(const LAS bf16_t*)(lg + P5_KS + 4352 + c * 2)) * br * __expf(decg[16])}; ab1 = (f32x2){0.f, 0.f}; } ab0 -= mq[0][0] * xy[0]; ab1 -= mq[0][1] * xy[1]; ab0 -= mq[0][2] * xy[2]; ab1 -= mq[0][3] * xy[3]; mq[0] = *(const LAS f32x4*)(Mg + 1096);
            ab0 -= mq[1][0] * xy[4]; ab1 -= mq[1][1] * xy[5]; ab0 -= mq[1][2] * xy[6]; ab1 -= mq[1][3] * xy[7]; mq[1] = *(const LAS f32x4*)(Mg + 1100);
            ab0 -= mq[2][0] * xy[8]; ab1 -= mq[2][1] * xy[9]; ab0 -= mq[2][2] * xy[10]; ab1 -= mq[2][3] * xy[11]; mq[2] = *(const LAS f32x4*)(Mg + 1104);
            ab0 -= mq[3][0] * xy[12]; ab1 -= mq[3][1] * xy[13]; ab0 -= mq[3][2] * xy[14]; ab1 -= mq[3][3] * xy[15]; xy[16] = ab0 + ab1; up[2048] = xy[16][0]; wp[2048] = f2bf(-xy[16][1]); mq[3] = *(const LAS f32x4*)(Mg + 1152);
            { const float br = betg[17]; ab0 = (f32x2){bf2f(*(const LAS bf16_t*)(lg + P5_VS + 4624 + c * 2)) * br, bf2f(*(const LAS bf16_t*)(lg + P5_KS + 4624 + c * 2)) * br * __expf(decg[17])}; ab1 = (f32x2){0.f, 0.f}; } ab0 -= mq[4][0] * xy[0]; ab1 -= mq[4][1] * xy[1]; ab0 -= mq[4][2] * xy[2]; ab1 -= mq[4][3] * xy[3]; mq[4] = *(const LAS f32x4*)(Mg + 1156);
            ab0 -= mq[5][0] * xy[4]; ab1 -= mq[5][1] * xy[5]; ab0 -= mq[5][2] * xy[6]; ab1 -= mq[5][3] * xy[7]; mq[5] = *(const LAS f32x4*)(Mg + 1160);
            ab0 -= mq[0][0] * xy[8]; ab1 -= mq[0][1] * xy[9]; ab0 -= mq[0][2] * xy[10]; ab1 -= mq[0][3] * xy[11]; mq[0] = *(const LAS f32x4*)(Mg + 1164);
            ab0 -= mq[1][0] * xy[12]; ab1 -= mq[1][1] * xy[13]; ab0 -= mq[1][2] * xy[14]; ab1 -= mq[1][3] * xy[15]; mq[1] = *(const LAS f32x4*)(Mg + 1168);
            ab0 -= mq[2][0] * xy[16]; xy[17] = ab0 + ab1; up[2176] = xy[17][0]; wp[2176] = f2bf(-xy[17][1]); mq[2] = *(const LAS f32x4*)(Mg + 1216);
            { const float br = betg[18]; ab0 = (f32x2){bf2f(*(const LAS bf16_t*)(lg + P5_VS + 4896 + c * 2)) * br, bf2f(*(const LAS bf16_t*)(lg + P5_KS + 4896 + c * 2)) * br * __expf(decg[18])}; ab1 = (f32x2){0.f, 0.f}; } ab0 -= mq[3][0] * xy[0]; ab1 -= mq[3][1] * xy[1]; ab0 -= mq[3][2] * xy[2]; ab1 -= mq[3][3] * xy[3]; mq[3] = *(const LAS f32x4*)(Mg + 1220);
            ab0 -= mq[4][0] * xy[4]; ab1 -= mq[4][1] * xy[5]; ab0 -= mq[4][2] * xy[6]; ab1 -= mq[4][3] * xy[7]; mq[4] = *(const LAS f32x4*)(Mg + 1224);
            ab0 -= mq[5][0] * xy[8]; ab1 -= mq[5][1] * xy[9]; ab0 -= mq[5][2] * xy[10]; ab1 -= mq[5][3] * xy[11]; mq[5] = *(const LAS f32x4*)(Mg + 1228);
            ab0 -= mq[0][0] * xy[12]; ab1 -= mq[0][1] * xy[13]; ab0 -= mq[0][2] * xy[14]; ab1 -= mq[0][3] * xy[15]; mq[0] = *(const LAS f32x4*)(Mg + 1232);
            ab0 -= mq[1][0] * xy[16]; ab1 -= mq[1][1] * xy[17]; xy[18] = ab0 + ab1; up[2304] = xy[18][0]; wp[2304] = f2bf(-xy[18][1]); mq[1] = *(const LAS f32x4*)(Mg + 1280);
            { const float br = betg[19]; ab0 = (f32x2){bf2f(*(const LAS bf16_t*)(lg + P5_VS + 5168 + c * 2)) * br, bf2f(*(const LAS bf16_t*)(lg + P5_KS + 5168 + c * 2)) * br * __expf(decg[19])}; ab1 = (f32x2){0.f, 0.f}; } ab0 -= mq[2][0] * xy[0]; ab1 -= mq[2][1] * xy[1]; ab0 -= mq[2][2] * xy[2]; ab1 -= mq[2][3] * xy[3]; mq[2] = *(const LAS f32x4*)(Mg + 1284);
            ab0 -= mq[3][0] * xy[4]; ab1 -= mq[3][1] * xy[5]; ab0 -= mq[3][2] * xy[6]; ab1 -= mq[3][3] * xy[7]; mq[3] = *(const LAS f32x4*)(Mg + 1288);
            ab0 -= mq[4][0] * xy[8]; ab1 -= mq[4][1] * xy[9]; ab0 -= mq[4][2] * xy[10]; ab1 -= mq[4][3] * xy[11]; mq[4] = *(const LAS f32x4*)(Mg + 1292);
            ab0 -= mq[5][0] * xy[12]; ab1 -= mq[5][1] * xy[13]; ab0 -= mq[5][2] * xy[14]; ab1 -= mq[5][3] * xy[15]; mq[5] = *(const LAS f32x4*)(Mg + 1296);
            ab0 -= mq[0][0] * xy[16]; ab1 -= mq[0][1] * xy[17]; ab0 -= mq[0][2] * xy[18]; xy[19] = ab0 + ab1; up[2432] = xy[19][0]; wp[2432] = f2bf(-xy[19][1]); mq[0] = *(const LAS f32x4*)(Mg + 1344);
            { const float br = betg[20]; ab0 = (f32x2){bf2f(*(const LAS bf16_t*)(lg + P5_VS + 5440 + c * 2)) * br, bf2f(*(const LAS bf16_t*)(lg + P5_KS + 5440 + c * 2)) * br * __expf(decg[20])}; ab1 = (f32x2){0.f, 0.f}; } ab0 -= mq[1][0] * xy[0]; ab1 -= mq[1][1] * xy[1]; ab0 -= mq[1][2] * xy[2]; ab1 -= mq[1][3] * xy[3]; mq[1] = *(const LAS f32x4*)(Mg + 1348);
            ab0 -= mq[2][0] * xy[4]; ab1 -= mq[2][1] * xy[5]; ab0 -= mq[2][2] * xy[6]; ab1 -= mq[2][3] * xy[7]; mq[2] = *(const LAS f32x4*)(Mg + 1352);
            ab0 -= mq[3][0] * xy[8]; ab1 -= mq[3][1] * xy[9]; ab0 -= mq[3][2] * xy[10]; ab1 -= mq[3][3] * xy[11]; mq[3] = *(const LAS f32x4*)(Mg + 1356);
            ab0 -= mq[4][0] * xy[12]; ab1 -= mq[4][1] * xy[13]; ab0 -= mq[4][2] * xy[14]; ab1 -= mq[4][3] * xy[15]; mq[4] = *(const LAS f32x4*)(Mg + 1360);
            ab0 -= mq[5][0] * xy[16]; ab1 -= mq[5][1] * xy[17]; ab0 -= mq[5][2] * xy[18]; ab1 -= mq[5][3] * xy[19]; xy[20] = ab0 + ab1; up[2560] = xy[20][0]; wp[2560] = f2bf(-xy[20][1]); mq[5] = *(const LAS f32x4*)(Mg + 1364);
            { const float br = betg[21]; ab0 = (f32x2){bf2f(*(const LAS bf16_t*)(lg + P5_VS + 5712 + c * 2)) * br, bf2f(*(const LAS bf16_t*)(lg + P5_KS + 5712 + c * 2)) * br * __expf(decg[21])}; ab1 = (f32x2){0.f, 0.f}; } ab0 -= mq[0][0] * xy[0]; ab1 -= mq[0][1] * xy[1]; ab0 -= mq[0][2] * xy[2]; ab1 -= mq[0][3] * xy[3]; mq[0] = *(const LAS f32x4*)(Mg + 1408);
            ab0 -= mq[1][0] * xy[4]; ab1 -= mq[1][1] * xy[5]; ab0 -= mq[1][2] * xy[6]; ab1 -= mq[1][3] * xy[7]; mq[1] = *(const LAS f32x4*)(Mg + 1412);
            ab0 -= mq[2][0] * xy[8]; ab1 -= mq[2][1] * xy[9]; ab0 -= mq[2][2] * xy[10]; ab1 -= mq[2][3] * xy[11]; mq[2] = *(const LAS f32x4*)(Mg + 1416);
            ab0 -= mq[3][0] * xy[12]; ab1 -= mq[3][1] * xy[13]; ab0 -= mq[3][2] * xy[14]; ab1 -= mq[3][3] * xy[15]; mq[3] = *(const LAS f32x4*)(Mg + 1420);
            ab0 -= mq[4][0] * xy[16]; ab1 -= mq[4][1] * xy[17]; ab0 -= mq[4][2] * xy[18]; ab1 -= mq[4][3] * xy[19]; mq[4] = *(const LAS f32x4*)(Mg + 1424);
            ab0 -= mq[5][0] * xy[20]; xy[21] = ab0 + ab1; up[2688] = xy[21][0]; wp[2688] = f2bf(-xy[21][1]); mq[5] = *(const LAS f32x4*)(Mg + 1428);
            { const float br = betg[22]; ab0 = (f32x2){bf2f(*(const LAS bf16_t*)(lg + P5_VS + 5984 + c * 2)) * br, bf2f(*(const LAS bf16_t*)(lg + P5_KS + 5984 + c * 2)) * br * __expf(decg[22])}; ab1 = (f32x2){0.f, 0.f}; } ab0 -= mq[0][0] * xy[0]; ab1 -= mq[0][1] * xy[1]; ab0 -= mq[0][2] * xy[2]; ab1 -= mq[0][3] * xy[3]; mq[0] = *(const LAS f32x4*)(Mg + 1472);
            ab0 -= mq[1][0] * xy[4]; ab1 -= mq[1][1] * xy[5]; ab0 -= mq[1][2] * xy[6]; ab1 -= mq[1][3] * xy[7]; mq[1] = *(const LAS f32x4*)(Mg + 1476);
            ab0 -= mq[2][0] * xy[8]; ab1 -= mq[2][1] * xy[9]; ab0 -= mq[2][2] * xy[10]; ab1 -= mq[2][3] * xy[11]; mq[2] = *(const LAS f32x4*)(Mg + 1480);
            ab0 -= mq[3][0] * xy[12]; ab1 -= mq[3][1] * xy[13]; ab0 -= mq[3][2] * xy[14]; ab1 -= mq[3][3] * xy[15]; mq[3] = *(const LAS f32x4*)(Mg + 1484);
            ab0 -= mq[4][0] * xy[16]; ab1 -= mq[4][1] * xy[17]; ab0 -= mq[4][2] * xy[18]; ab1 -= mq[4][3] * xy[19]; mq[4] = *(const LAS f32x4*)(Mg + 1488);
            ab0 -= mq[5][0] * xy[20]; ab1 -= mq[5][1] * xy[21]; xy[22] = ab0 + ab1; up[2816] = xy[22][0]; wp[2816] = f2bf(-xy[22][1]); mq[5] = *(const LAS f32x4*)(Mg + 1492);
            { const float br = betg[23]; ab0 = (f32x2){bf2f(*(const LAS bf16_t*)(lg + P5_VS + 6256 + c * 2)) * br, bf2f(*(const LAS bf16_t*)(lg + P5_KS + 6256 + c * 2)) * br * __expf(decg[23])}; ab1 = (f32x2){0.f, 0.f}; } ab0 -= mq[0][0] * xy[0]; ab1 -= mq[0][1] * xy[1]; ab0 -= mq[0][2] * xy[2]; ab1 -= mq[0][3] * xy[3]; mq[0] = *(const LAS f32x4*)(Mg + 1536);
            ab0 -= mq[1][0] * xy[4]; ab1 -= mq[1][1] * xy[5]; ab0 -= mq[1][2] * xy[6]; ab1 -= mq[1][3] * xy[7]; mq[1] = *(const LAS f32x4*)(Mg + 1540);
            ab0 -= mq[2][0] * xy[8]; ab1 -= mq[2][1] * xy[9]; ab0 -= mq[2][2] * xy[10]; ab1 -= mq[2][3] * xy[11]; mq[2] = *(const LAS f32x4*)(Mg + 1544);
            ab0 -= mq[3][0] * xy[12]; ab1 -= mq[3][1] * xy[13]; ab0 -= mq[3][2] * xy[14]; ab1 -= mq[3][3] * xy[15]; mq[3] = *(const LAS f32x4*)(Mg + 1548);
            ab0 -= mq[4][0] * xy[16]; ab1 -= mq[4][1] * xy[17]; ab0 -= mq[4][2] * xy[18]; ab1 -= mq[4][3] * xy[19]; mq[4] = *(const LAS f32x4*)(Mg + 1552);
            ab0 -= mq[5][0] * xy[20]; ab1 -= mq[5][1] * xy[21]; ab0 -= mq[5][2] * xy[22]; xy[23] = ab0 + ab1; up[2944] = xy[23][0]; wp[2944] = f2bf(-xy[23][1]); mq[5] = *(const LAS f32x4*)(Mg + 1556);
            { const float br = betg[24]; ab0 = (f32x2){bf2f(*(const LAS bf16_t*)(lg + P5_VS + 6528 + c * 2)) * br, bf2f(*(const LAS bf16_t*)(lg + P5_KS + 6528 + c * 2)) * br * __expf(decg[24])}; ab1 = (f32x2){0.f, 0.f}; } ab0 -= mq[0][0] * xy[0]; ab1 -= mq[0][1] * xy[1]; ab0 -= mq[0][2] * xy[2]; ab1 -= mq[0][3] * xy[3]; mq[0] = *(const LAS f32x4*)(Mg + 1600);
            ab0 -= mq[1][0] * xy[4]; ab1 -= mq[1][1] * xy[5]; ab0 -= mq[1][2] * xy[6]; ab1 -= mq[1][3] * xy[7]; mq[1] = *(const LAS f32x4*)(Mg + 1604);
            ab0 -= mq[2][0] * xy[8]; ab1 -= mq[2][1] * xy[9]; ab0 -= mq[2][2] * xy[10]; ab1 -= mq[2][3] * xy[11]; mq[2] = *(const LAS f32x4*)(Mg + 1608);
            ab0 -= mq[3][0] * xy[12]; ab1 -= mq[3][1] * xy[13]; ab0 -= mq[3][2] * xy[14]; ab1 -= mq[3][3] * xy[15]; mq[3] = *(const LAS f32x4*)(Mg + 1612);
            ab0 -= mq[4][0] * xy[16]; ab1 -= mq[4][1] * xy[17]; ab0 -= mq[4][2] * xy[18]; ab1 -= mq[4][3] * xy[19]; mq[4] = *(const LAS f32x4*)(Mg + 1616);
            ab0 -= mq[5][0] * xy[20]; ab1 -= mq[5][1] * xy[21]; ab0 -= mq[5][2] * xy[22]; ab1 -= mq[5][3] * xy[23]; xy[24] = ab0 + ab1; up[3072] = xy[24][0]; wp[3072] = f2bf(-xy[24][1]); mq[5] = *(const LAS f32x4*)(Mg + 1620);
            { const float br = betg[25]; ab0 = (f32x2){bf2f(*(const LAS bf16_t*)(lg + P5_VS + 6800 + c * 2)) * br, bf2f(*(const LAS bf16_t*)(lg + P5_KS + 6800 + c * 2)) * br * __expf(decg[25])}; ab1 = (f32x2){0.f, 0.f}; } ab0 -= mq[0][0] * xy[0]; ab1 -= mq[0][1] * xy[1]; ab0 -= mq[0][2] * xy[2]; ab1 -= mq[0][3] * xy[3]; mq[0] = *(const LAS f32x4*)(Mg + 1624);
            ab0 -= mq[1][0] * xy[4]; ab1 -= mq[1][1] * xy[5]; ab0 -= mq[1][2] * xy[6]; ab1 -= mq[1][3] * xy[7]; mq[1] = *(const LAS f32x4*)(Mg + 1664);
            ab0 -= mq[2][0] * xy[8]; ab1 -= mq[2][1] * xy[9]; ab0 -= mq[2][2] * xy[10]; ab1 -= mq[2][3] * xy[11]; mq[2] = *(const LAS f32x4*)(Mg + 1668);
            ab0 -= mq[3][0] * xy[12]; ab1 -= mq[3][1] * xy[13]; ab0 -= mq[3][2] * xy[14]; ab1 -= mq[3][3] * xy[15]; mq[3] = *(const LAS f32x4*)(Mg + 1672);
            ab0 -= mq[4][0] * xy[16]; ab1 -= mq[4][1] * xy[17]; ab0 -= mq[4][2] * xy[18]; ab1 -= mq[4][3] * xy[19]; mq[4] = *(const LAS f32x4*)(Mg + 1676);
            ab0 -= mq[5][0] * xy[20]; ab1 -= mq[5][1] * xy[21]; ab0 -= mq[5][2] * xy[22]; ab1 -= mq[5][3] * xy[23]; mq[5] = *(const LAS f32x4*)(Mg + 1680);
            ab0 -= mq[0][0] * xy[24]; xy[25] = ab0 + ab1; up[3200] = xy[25][0]; wp[3200] = f2bf(-xy[25][1]); mq[0] = *(const LAS f32x4*)(Mg + 1684);
            { const float br = betg[26]; ab0 = (f32x2){bf2f(*(const LAS bf16_t*)(lg + P5_VS + 7072 + c * 2)) * br, bf2f(*(const LAS bf16_t*)(lg + P5_KS + 7072 + c * 2)) * br * __expf(decg[26])}; ab1 = (f32x2){0.f, 0.f}; } ab0 -= mq[1][0] * xy[0]; ab1 -= mq[1][1] * xy[1]; ab0 -= mq[1][2] * xy[2]; ab1 -= mq[1][3] * xy[3]; mq[1] = *(const LAS f32x4*)(Mg + 1688);
            ab0 -= mq[2][0] * xy[4]; ab1 -= mq[2][1] * xy[5]; ab0 -= mq[2][2] * xy[6]; ab1 -= mq[2][3] * xy[7]; mq[2] = *(const LAS f32x4*)(Mg + 1728);
            ab0 -= mq[3][0] * xy[8]; ab1 -= mq[3][1] * xy[9]; ab0 -= mq[3][2] * xy[10]; ab1 -= mq[3][3] * xy[11]; mq[3] = *(const LAS f32x4*)(Mg + 1732);
            ab0 -= mq[4][0] * xy[12]; ab1 -= mq[4][1] * xy[13]; ab0 -= mq[4][2] * xy[14]; ab1 -= mq[4][3] * xy[15]; mq[4] = *(const LAS f32x4*)(Mg + 1736);
            ab0 -= mq[5][0] * xy[16]; ab1 -= mq[5][1] * xy[17]; ab0 -= mq[5][2] * xy[18]; ab1 -= mq[5][3] * xy[19]; mq[5] = *(const LAS f32x4*)(Mg + 1740);
            ab0 -= mq[0][0] * xy[20]; ab1 -= mq[0][1] * xy[21]; ab0 -= mq[0][2] * xy[22]; ab1 -= mq[0][3] * xy[23]; mq[0] = *(const LAS f32x4*)(Mg + 1744);
            ab0 -= mq[1][0] * xy[24]; ab1 -= mq[1][1] * xy[25]; xy[26] = ab0 + ab1; up[3328] = xy[26][0]; wp[3328] = f2bf(-xy[26][1]); mq[1] = *(const LAS f32x4*)(Mg + 1748);
            { const float br = betg[27]; ab0 = (f32x2){bf2f(*(const LAS bf16_t*)(lg + P5_VS + 7344 + c * 2)) * br, bf2f(*(const LAS bf16_t*)(lg + P5_KS + 7344 + c * 2)) * br * __expf(decg[27])}; ab1 = (f32x2){0.f, 0.f}; } ab0 -= mq[2][0] * xy[0]; ab1 -= mq[2][1] * xy[1]; ab0 -= mq[2][2] * xy[2]; ab1 -= mq[2][3] * xy[3]; mq[2] = *(const LAS f32x4*)(Mg + 1752);
            ab0 -= mq[3][0] * xy[4]; ab1 -= mq[3][1] * xy[5]; ab0 -= mq[3][2] * xy[6]; ab1 -= mq[3][3] * xy[7]; mq[3] = *(const LAS f32x4*)(Mg + 1792);
            ab0 -= mq[4][0] * xy[8]; ab1 -= mq[4][1] * xy[9]; ab0 -= mq[4][2] * xy[10]; ab1 -= mq[4][3] * xy[11]; mq[4] = *(const LAS f32x4*)(Mg + 1796);
            ab0 -= mq[5][0] * xy[12]; ab1 -= mq[5][1] * xy[13]; ab0 -= mq[5][2] * xy[14]; ab1 -= mq[5][3] * xy[15]; mq[5] = *(const LAS f32x4*)(Mg + 1800);
            ab0 -= mq[0][0] * xy[16]; ab1 -= mq[0][1] * xy[17]; ab0 -= mq[0][2] * xy[18]; ab1 -= mq[0][3] * xy[19]; mq[0] = *(const LAS f32x4*)(Mg + 1804);
            ab0 -= mq[1][0] * xy[20]; ab1 -= mq[1][1] * xy[21]; ab0 -= mq[1][2] * xy[22]; ab1 -= mq[1][3] * xy[23]; mq[1] = *(const LAS f32x4*)(Mg + 1808);
            ab0 -= mq[2][0] * xy[24]; ab1 -= mq[2][1] * xy[25]; ab0 -= mq[2][2] * xy[26]; xy[27] = ab0 + ab1; up[3456] = xy[27][0]; wp[3456] = f2bf(-xy[27][1]); mq[2] = *(const LAS f32x4*)(Mg + 1812);
            { const float br = betg[28]; ab0 = (f32x2){bf2f(*(const LAS bf16_t*)(lg + P5_VS + 7616 + c * 2)) * br, bf2f(*(const LAS bf16_t*)(lg + P5_KS + 7616 + c * 2)) * br * __expf(decg[28])}; ab1 = (f32x2){0.f, 0.f}; } ab0 -= mq[3][0] * xy[0]; ab1 -= mq[3][1] * xy[1]; ab0 -= mq[3][2] * xy[2]; ab1 -= mq[3][3] * xy[3]; mq[3] = *(const LAS f32x4*)(Mg + 1816);
            ab0 -= mq[4][0] * xy[4]; ab1 -= mq[4][1] * xy[5]; ab0 -= mq[4][2] * xy[6]; ab1 -= mq[4][3] * xy[7]; mq[4] = *(const LAS f32x4*)(Mg + 1856);
            ab0 -= mq[5][0] * xy[8]; ab1 -= mq[5][1] * xy[9]; ab0 -= mq[5][2] * xy[10]; ab1 -= mq[5][3] * xy[11]; mq[5] = *(const LAS f32x4*)(Mg + 1860);
            ab0 -= mq[0][0] * xy[12]; ab1 -= mq[0][1] * xy[13]; ab0 -= mq[0][2] * xy[14]; ab1 -= mq[0][3] * xy[15]; mq[0] = *(const LAS f32x4*)(Mg + 1864);
            ab0 -= mq[1][0] * xy[16]; ab1 -= mq[1][1] * xy[17]; ab0 -= mq[1][2] * xy[18]; ab1 -= mq[1][3] * xy[19]; mq[1] = *(const LAS f32x4*)(Mg + 1868);
            ab0 -= mq[2][0] * xy[20]; ab1 -= mq[2][1] * xy[21]; ab0 -= mq[2][2] * xy[22]; ab1 -= mq[2][3] * xy[23]; mq[2] = *(const LAS f32x4*)(Mg + 1872);
            ab0 -= mq[3][0] * xy[24]; ab1 -= mq[3][1] * xy[25]; ab0 -= mq[3][2] * xy[26]; ab1 -= mq[3][3] * xy[27]; xy[28] = ab0 + ab1; up[3584] = xy[28][0]; wp[3584] = f2bf(-xy[28][1]); mq[3] = *(const LAS f32x4*)(Mg + 1876);
            { const float br = betg[29]; ab0 = (f32x2){bf2f(*(const LAS bf16_t*)(lg + P5_VS + 7888 + c * 2)) * br, bf2f(*(const LAS bf16_t*)(lg + P5_KS + 7888 + c * 2)) * br * __expf(decg[29])}; ab1 = (f32x2){0.f, 0.f}; } ab0 -= mq[4][0] * xy[0]; ab1 -= mq[4][1] * xy[1]; ab0 -= mq[4][2] * xy[2]; ab1 -= mq[4][3] * xy[3]; mq[4] = *(const LAS f32x4*)(Mg + 1880);
            ab0 -= mq[5][0] * xy[4]; ab1 -= mq[5][1] * xy[5]; ab0 -= mq[5][2] * xy[6]; ab1 -= mq[5][3] * xy[7]; mq[5] = *(const LAS f32x4*)(Mg + 1884);
            ab0 -= mq[0][0] * xy[8]; ab1 -= mq[0][1] * xy[9]; ab0 -= mq[0][2] * xy[10]; ab1 -= mq[0][3] * xy[11]; mq[0] = *(const LAS f32x4*)(Mg + 1920);
            ab0 -= mq[1][0] * xy[12]; ab1 -= mq[1][1] * xy[13]; ab0 -= mq[1][2] * xy[14]; ab1 -= mq[1][3] * xy[15]; mq[1] = *(const LAS f32x4*)(Mg + 1924);
            ab0 -= mq[2][0] * xy[16]; ab1 -= mq[2][1] * xy[17]; ab0 -= mq[2][2] * xy[18]; ab1 -= mq[2][3] * xy[19]; mq[2] = *(const LAS f32x4*)(Mg + 1928);
            ab0 -= mq[3][0] * xy[20]; ab1 -= mq[3][1] * xy[21]; ab0 -= mq[3][2] * xy[22]; ab1 -= mq[3][3] * xy[23]; mq[3] = *(const LAS f32x4*)(Mg + 1932);
            ab0 -= mq[4][0] * xy[24]; ab1 -= mq[4][1] * xy[25]; ab0 -= mq[4][2] * xy[26]; ab1 -= mq[4][3] * xy[27]; mq[4] = *(const LAS f32x4*)(Mg + 1936);
            ab0 -= mq[5][0] * xy[28]; xy[29] = ab0 + ab1; up[3712] = xy[29][0]; wp[3712] = f2bf(-xy[29][1]); mq[5] = *(const LAS f32x4*)(Mg + 1940);
            { const float br = betg[30]; ab0 = (f32x2){bf2f(*(const LAS bf16_t*)(lg + P5_VS + 8160 + c * 2)) * br, bf2f(*(const LAS bf16_t*)(lg + P5_KS + 8160 + c * 2)) * br * __expf(decg[30])}; ab1 = (f32x2){0.f, 0.f}; } ab0 -= mq[0][0] * xy[0]; ab1 -= mq[0][1] * xy[1]; ab0 -= mq[0][2] * xy[2]; ab1 -= mq[0][3] * xy[3]; mq[0] = *(const LAS f32x4*)(Mg + 1944);
            ab0 -= mq[1][0] * xy[4]; ab1 -= mq[1][1] * xy[5]; ab0 -= mq[1][2] * xy[6]; ab1 -= mq[1][3] * xy[7]; mq[1] = *(const LAS f32x4*)(Mg + 1948);
            ab0 -= mq[2][0] * xy[8]; ab1 -= mq[2][1] * xy[9]; ab0 -= mq[2][2] * xy[10]; ab1 -= mq[2][3] * xy[11]; mq[2] = *(const LAS f32x4*)(Mg + 1984);
            ab0 -= mq[3][0] * xy[12]; ab1 -= mq[3][1] * xy[13]; ab0 -= mq[3][2] * xy[14]; ab1 -= mq[3][3] * xy[15]; mq[3] = *(const LAS f32x4*)(Mg + 1988);
            ab0 -= mq[4][0] * xy[16]; ab1 -= mq[4][1] * xy[17]; ab0 -= mq[4][2] * xy[18]; ab1 -= mq[4][3] * xy[19]; mq[4] = *(const LAS f32x4*)(Mg + 1992);
            ab0 -= mq[5][0] * xy[20]; ab1 -= mq[5][1] * xy[21]; ab0 -= mq[5][2] * xy[22]; ab1 -= mq[5][3] * xy[23]; mq[5] = *(const LAS f32x4*)(Mg + 1996);
            ab0 -= mq[0][0] * xy[24]; ab1 -= mq[0][1] * xy[25]; ab0 -= mq[0][2] * xy[26]; ab1 -= mq[0][3] * xy[27]; mq[0] = *(const LAS f32x4*)(Mg + 2000);
            ab0 -= mq[1][0] * xy[28]; ab1 -= mq[1][1] * xy[29]; xy[30] = ab0 + ab1; up[3840] = xy[30][0]; wp[3840] = f2bf(-xy[30][1]); mq[1] = *(const LAS f32x4*)(Mg + 2004);
            { const float br = betg[31]; ab0 = (f32x2){bf2f(*(const LAS bf16_t*)(lg + P5_VS + 8432 + c * 2)) * br, bf2f(*(const LAS bf16_t*)(lg + P5_KS + 8432 + c * 2)) * br * __expf(decg[31])}; ab1 = (f32x2){0.f, 0.f}; } ab0 -= mq[2][0] * xy[0]; ab1 -= mq[2][1] * xy[1]; ab0 -= mq[2][2] * xy[2]; ab1 -= mq[2][3] * xy[3]; mq[2] = *(const LAS f32x4*)(Mg + 2008);
            ab0 -= mq[3][0] * xy[4]; ab1 -= mq[3][1] * xy[5]; ab0 -= mq[3][2] * xy[6]; ab1 -= mq[3][3] * xy[7]; mq[3] = *(const LAS f32x4*)(Mg + 2012);
            ab0 -= mq[4][0] * xy[8]; ab1 -= mq[4][1] * xy[9]; ab0 -= mq[4][2] * xy[10]; ab1 -= mq[4][3] * xy[11]; mq[4] = *(const LAS f32x4*)(Mg + 2048);
            ab0 -= mq[5][0] * xy[12]; ab1 -= mq[5][1] * xy[13]; ab0 -= mq[5][2] * xy[14]; ab1 -= mq[5][3] * xy[15]; mq[5] = *(const LAS f32x4*)(Mg + 2052);
            ab0 -= mq[0][0] * xy[16]; ab1 -= mq[0][1] * xy[17]; ab0 -= mq[0][2] * xy[18]; ab1 -= mq[0][3] * xy[19]; mq[0] = *(const LAS f32x4*)(Mg + 2056);
            ab0 -= mq[1][0] * xy[20]; ab1 -= mq[1][1] * xy[21]; ab0 -= mq[1][2] * xy[22]; ab1 -= mq[1][3] * xy[23]; mq[1] = *(const LAS f32x4*)(Mg + 2060);
            ab0 -= mq[2][0] * xy[24]; ab1 -= mq[2][1] * xy[25]; ab0 -= mq[2][2] * xy[26]; ab1 -= mq[2][3] * xy[27]; mq[2] = *(const LAS f32x4*)(Mg + 2064);
            ab0 -= mq[3][0] * xy[28]; ab1 -= mq[3][1] * xy[29]; ab0 -= mq[3][2] * xy[30]; xy[31] = ab0 + ab1; up[3968] = xy[31][0]; wp[3968] = f2bf(-xy[31][1]); mq[3] = *(const LAS f32x4*)(Mg + 2068);
            { const float br = betg[32]; ab0 = (f32x2){bf2f(*(const LAS bf16_t*)(lg + P5_VS + 8704 + c * 2)) * br, bf2f(*(const LAS bf16_t*)(lg + P5_KS + 8704 + c * 2)) * br * __expf(decg[32])}; ab1 = (f32x2){0.f, 0.f}; } ab0 -= mq[4][0] * xy[0]; ab1 -= mq[4][1] * xy[1]; ab0 -= mq[4][2] * xy[2]; ab1 -= mq[4][3] * xy[3]; mq[4] = *(const LAS f32x4*)(Mg + 2072);
            ab0 -= mq[5][0] * xy[4]; ab1 -= mq[5][1] * xy[5]; ab0 -= mq[5][2] * xy[6]; ab1 -= mq[5][3] * xy[7]; mq[5] = *(const LAS f32x4*)(Mg + 2076);
            ab0 -= mq[0][0] * xy[8]; ab1 -= mq[0][1] * xy[9]; ab0 -= mq[0][2] * xy[10]; ab1 -= mq[0][3] * xy[11]; mq[0] = *(const LAS f32x4*)(Mg + 2112);
            ab0 -= mq[1][0] * xy[12]; ab1 -= mq[1][1] * xy[13]; ab0 -= mq[1][2] * xy[14]; ab1 -= mq[1][3] * xy[15]; mq[1] = *(const LAS f32x4*)(Mg + 2116);
            ab0 -= mq[2][0] * xy[16]; ab1 -= mq[2][1] * xy[17]; ab0 -= mq[2][2] * xy[18]; ab1 -= mq[2][3] * xy[19]; mq[2] = *(const LAS f32x4*)(Mg + 2120);
            ab0 -= mq[3][0] * xy[20]; ab1 -= mq[3][1] * xy[21]; ab0 -= mq[3][2] * xy[22]; ab1 -= mq[3][3] * xy[23]; mq[3] = *(const LAS f32x4*)(Mg + 2124);
            ab0 -= mq[4][0] * xy[24]; ab1 -= mq[4][1] * xy[25]; ab0 -= mq[4][2] * xy[26]; ab1 -= mq[4][3] * xy[27]; mq[4] = *(const LAS f32x4*)(Mg + 2128);
            ab0 -= mq[5][0] * xy[28]; ab1 -= mq[5][1] * xy[29]; ab0 -= mq[5][2] * xy[30]; ab1 -= mq[5][3] * xy[31]; xy[32] = ab0 + ab1; up[4096] = xy[32][0]; wp[4096] = f2bf(-xy[32][1]); mq[5] = *(const LAS f32x4*)(Mg + 2132);
            { const float br = betg[33]; ab0 = (f32x2){bf2f(*(const LAS bf16_t*)(lg + P5_VS + 8976 + c * 2)) * br, bf2f(*(const LAS bf16_t*)(lg + P5_KS + 8976 + c * 2)) * br * __expf(decg[33])}; ab1 = (f32x2){0.f, 0.f}; } ab0 -= mq[0][0] * xy[0]; ab1 -= mq[0][1] * xy[1]; ab0 -= mq[0][2] * xy[2]; ab1 -= mq[0][3] * xy[3]; mq[0] = *(const LAS f32x4*)(Mg + 2136);
            ab0 -= mq[1][0] * xy[4]; ab1 -= mq[1][1] * xy[5]; ab0 -= mq[1][2] * xy[6]; ab1 -= mq[1][3] * xy[7]; mq[1] = *(const LAS f32x4*)(Mg + 2140);
            ab0 -= mq[2][0] * xy[8]; ab1 -= mq[2][1] * xy[9]; ab0 -= mq[2][2] * xy[10]; ab1 -= mq[2][3] * xy[11]; mq[2] = *(const LAS f32x4*)(Mg + 2144);
            ab0 -= mq[3][0] * xy[12]; ab1 -= mq[3][1] * xy[13]; ab0 -= mq[3][2] * xy[14]; ab1 -= mq[3][3] * xy[15]; mq[3] = *(const LAS f32x4*)(Mg + 2176);
            ab0 -= mq[4][0] * xy[16]; ab1 -= mq[4][1] * xy[17]; ab0 -= mq[4][2] * xy[18]; ab1 -= mq[4][3] * xy[19]; mq[4] = *(const LAS f32x4*)(Mg + 2180);
            ab0 -= mq[5][0] * xy[20]; ab1 -= mq[5][1] * xy[21]; ab0 -= mq[5][2] * xy[22]; ab1 -= mq[5][3] * xy[23]; mq[5] = *(const LAS f32x4*)(Mg + 2184);
            ab0 -= mq[0][0] * xy[24]; ab1 -= mq[0][1] * xy[25]; ab0 -= mq[0][2] * xy[26]; ab1 -= mq[0][3] * xy[27]; mq[0] = *(const LAS f32x4*)(Mg + 2188);
            ab0 -= mq[1][0] * xy[28]; ab1 -= mq[1][1] * xy[29]; ab0 -= mq[1][2] * xy[30]; ab1 -= mq[1][3] * xy[31]; mq[1] = *(const LAS f32x4*)(Mg + 2192);
            ab0 -= mq[2][0] * xy[32]; xy[33] = ab0 + ab1; up[4224] = xy[33][0]; wp[4224] = f2bf(-xy[33][1]); mq[2] = *(const LAS f32x4*)(Mg + 2196);
            { const float br = betg[34]; ab0 = (f32x2){bf2f(*(const LAS bf16_t*)(lg + P5_VS + 9248 + c * 2)) * br, bf2f(*(const LAS bf16_t*)(lg + P5_KS + 9248 + c * 2)) * br * __expf(decg[34])}; ab1 = (f32x2){0.f, 0.f}; } ab0 -= mq[3][0] * xy[0]; ab1 -= mq[3][1] * xy[1]; ab0 -= mq[3][2] * xy[2]; ab1 -= mq[3][3] * xy[3]; mq[3] = *(const LAS f32x4*)(Mg + 2200);
            ab0 -= mq[4][0] * xy[4]; ab1 -= mq[4][1] * xy[5]; ab0 -= mq[4][2] * xy[6]; ab1 -= mq[4][3] * xy[7]; mq[4] = *(const LAS f32x4*)(Mg + 2204);
            ab0 -= mq[5][0] * xy[8]; ab1 -= mq[5][1] * xy[9]; ab0 -= mq[5][2] * xy[10]; ab1 -= mq[5][3] * xy[11]; mq[5] = *(const LAS f32x4*)(Mg + 2208);
            ab0 -= mq[0][0] * xy[12]; ab1 -= mq[0][1] * xy[13]; ab0 -= mq[0][2] * xy[14]; ab1 -= mq[0][3] * xy[15]; mq[0] = *(const LAS f32x4*)(Mg + 2240);
            ab0 -= mq[1][0] * xy[16]; ab1 -= mq[1][1] * xy[17]; ab0 -= mq[1][2] * xy[18]; ab1 -= mq[1][3] * xy[19]; mq[1] = *(const LAS f32x4*)(Mg + 2244);
            ab0 -= mq[2][0] * xy[20]; ab1 -= mq[2][1] * xy[21]; ab0 -= mq[2][2] * xy[22]; ab1 -= mq[2][3] * xy[23]; mq[2] = *(const LAS f32x4*)(Mg + 2248);
            ab0 -= mq[3][0] * xy[24]; ab1 -= mq[3][1] * xy[25]; ab0 -= mq[3][2] * xy[26]; ab1 -= mq[3][3] * xy[27]; mq[3] = *(const LAS f32x4*)(Mg + 2252);
            ab0 -= mq[4][0] * xy[28]; ab1 -= mq[4][1] * xy[29]; ab0 -= mq[4][2] * xy[30]; ab1 -= mq[4][3] * xy[31]; mq[4] = *(const LAS f32x4*)(Mg + 2256);
            ab0 -= mq[5][0] * xy[32]; ab1 -= mq[5][1] * xy[33]; xy[34] = ab0 + ab1; up[4352] = xy[34][0]; wp[4352] = f2bf(-xy[34][1]); mq[5] = *(const LAS f32x4*)(Mg + 2260);
            { const float br = betg[35]; ab0 = (f32x2){bf2f(*(const LAS bf16_t*)(lg + P5_VS + 9520 + c * 2)) * br, bf2f(*(const LAS bf16_t*)(lg + P5_KS + 9520 + c * 2)) * br * __expf(decg[35])}; ab1 = (f32x2){0.f, 0.f}; } ab0 -= mq[0][0] * xy[0]; ab1 -= mq[0][1] * xy[1]; ab0 -= mq[0][2] * xy[2]; ab1 -= mq[0][3] * xy[3]; mq[0] = *(const LAS f32x4*)(Mg + 2264);
            ab0 -= mq[1][0] * xy[4]; ab1 -= mq[1][1] * xy[5]; ab0 -= mq[1][2] * xy[6]; ab1 -= mq[1][3] * xy[7]; mq[1] = *(const LAS f32x4*)(Mg + 2268);
            ab0 -= mq[2][0] * xy[8]; ab1 -= mq[2][1] * xy[9]; ab0 -= mq[2][2] * xy[10]; ab1 -= mq[2][3] * xy[11]; mq[2] = *(const LAS f32x4*)(Mg + 2272);
            ab0 -= mq[3][0] * xy[12]; ab1 -= mq[3][1] * xy[13]; ab0 -= mq[3][2] * xy[14]; ab1 -= mq[3][3] * xy[15]; mq[3] = *(const LAS f32x4*)(Mg + 2304);
            ab0 -= mq[4][0] * xy[16]; ab1 -= mq[4][1] * xy[17]; ab0 -= mq[4][2] * xy[18]; ab1 -= mq[4][3] * xy[19]; mq[4] = *(const LAS f32x4*)(Mg + 2308);
            ab0 -= mq[5][0] * xy[20]; ab1 -= mq[5][1] * xy[21]; ab0 -= mq[5][2] * xy[22]; ab1 -= mq[5][3] * xy[23]; mq[5] = *(const LAS f32x4*)(Mg + 2312);
            ab0 -= mq[0][0] * xy[24]; ab1 -= mq[0][1] * xy[25]; ab0 -= mq[0][2] * xy[26]; ab1 -= mq[0][3] * xy[27]; mq[0] = *(const LAS f32x4*)(Mg + 2316);
            ab0 -= mq[1][0] * xy[28]; ab1 -= mq[1][1] * xy[29]; ab0 -= mq[1][2] * xy[30]; ab1 -= mq[1][3] * xy[31]; mq[1] = *(const LAS f32x4*)(Mg + 2320);
            ab0 -= mq[2][0] * xy[32]; ab1 -= mq[2][1] * xy[33]; ab0 -= mq[2][2] * xy[34]; xy[35] = ab0 + ab1; up[4480] = xy[35][0]; wp[4480] = f2bf(-xy[35][1]); mq[2] = *(const LAS f32x4*)(Mg + 2324);
            { const float br = betg[36]; ab0 = (f32x2){bf2f(*(const LAS bf16_t*)(lg + P5_VS + 9792 + c * 2)) * br, bf2f(*(const LAS bf16_t*)(lg + P5_KS + 9792 + c * 2)) * br * __expf(decg[36])}; ab1 = (f32x2){0.f, 0.f}; } ab0 -= mq[3][0] * xy[0]; ab1 -= mq[3][1] * xy[1]; ab0 -= mq[3][2] * xy[2]; ab1 -= mq[3][3] * xy[3]; mq[3] = *(const LAS f32x4*)(Mg + 2328);
            ab0 -= mq[4][0] * xy[4]; ab1 -= mq[4][1] * xy[5]; ab0 -= mq[4][2] * xy[6]; ab1 -= mq[4][3] * xy[7]; mq[4] = *(const LAS f32x4*)(Mg + 2332);
            ab0 -= mq[5][0] * xy[8]; ab1 -= mq[5][1] * xy[9]; ab0 -= mq[5][2] * xy[10]; ab1 -= mq[5][3] * xy[11]; mq[5] = *(const LAS f32x4*)(Mg + 2336);
            ab0 -= mq[0][0] * xy[12]; ab1 -= mq[0][1] * xy[13]; ab0 -= mq[0][2] * xy[14]; ab1 -= mq[0][3] * xy[15]; mq[0] = *(const LAS f32x4*)(Mg + 2368);
            ab0 -= mq[1][0] * xy[16]; ab1 -= mq[1][1] * xy[17]; ab0 -= mq[1][2] * xy[18]; ab1 -= mq[1][3] * xy[19]; mq[1] = *(const LAS f32x4*)(Mg + 2372);
            ab0 -= mq[2][0] * xy[20]; ab1 -= mq[2][1] * xy[21]; ab0 -= mq[2][2] * xy[22]; ab1 -= mq[2][3] * xy[23]; mq[2] = *(const LAS f32x4*)(Mg + 2376);
            ab0 -= mq[3][0] * xy[24]; ab1 -= mq[3][1] * xy[25]; ab0 -= mq[3][2] * xy[26]; ab1 -= mq[3][3] * xy[27]; mq[3] = *(const LAS f32x4*)(Mg + 2380);
            ab0 -= mq[4][0] * xy[28]; ab1 -= mq[4][1] * xy[29]; ab0 -= mq[4][2] * xy[30]; ab1 -= mq[4][3] * xy[31]; mq[4] = *(const LAS f32x4*)(Mg + 2384);
            ab0 -= mq[5][0] * xy[32]; ab1 -= mq[5][1] * xy[33]; ab0 -= mq[5][2] * xy[34]; ab1 -= mq[5][3] * xy[35]; xy[36] = ab0 + ab1; up[4608] = xy[36][0]; wp[4608] = f2bf(-xy[36][1]); mq[5] = *(const LAS f32x4*)(Mg + 2388);
            { const float br = betg[37]; ab0 = (f32x2){bf2f(*(const LAS bf16_t*)(lg + P5_VS + 10064 + c * 2)) * br, bf2f(*(const LAS bf16_t*)(lg + P5_KS + 10064 + c * 2)) * br * __expf(decg[37])}; ab1 = (f32x2){0.f, 0.f}; } ab0 -= mq[0][0] * xy[0]; ab1 -= mq[0][1] * xy[1]; ab0 -= mq[0][2] * xy[2]; ab1 -= mq[0][3] * xy[3]; mq[0] = *(const LAS f32x4*)(Mg + 2392);
            ab0 -= mq[1][0] * xy[4]; ab1 -= mq[1][1] * xy[5]; ab0 -= mq[1][2] * xy[6]; ab1 -= mq[1][3] * xy[7]; mq[1] = *(const LAS f32x4*)(Mg + 2396);
            ab0 -= mq[2][0] * xy[8]; ab1 -= mq[2][1] * xy[9]; ab0 -= mq[2][2] * xy[10]; ab1 -= mq[2][3] * xy[11]; mq[2] = *(const LAS f32x4*)(Mg + 2400);
            ab0 -= mq[3][0] * xy[12]; ab1 -= mq[3][1] * xy[13]; ab0 -= mq[3][2] * xy[14]; ab1 -= mq[3][3] * xy[15]; mq[3] = *(const LAS f32x4*)(Mg + 2404);
            ab0 -= mq[4][0] * xy[16]; ab1 -= mq[4][1] * xy[17]; ab0 -= mq[4][2] * xy[18]; ab1 -= mq[4][3] * xy[19]; mq[4] = *(const LAS f32x4*)(Mg + 2432);
            ab0 -= mq[5][0] * xy[20]; ab1 -= mq[5][1] * xy[21]; ab0 -= mq[5][2] * xy[22]; ab1 -= mq[5][3] * xy[23]; mq[5] = *(const LAS f32x4*)(Mg + 2436);
            ab0 -= mq[0][0] * xy[24]; ab1 -= mq[0][1] * xy[25]; ab0 -= mq[0][2] * xy[26]; ab1 -= mq[0][3] * xy[27]; mq[0] = *(const LAS f32x4*)(Mg + 2440);
            ab0 -= mq[1][0] * xy[28]; ab1 -= mq[1][1] * xy[29]; ab0 -= mq[1][2] * xy[30]; ab1 -= mq[1][3] * xy[31]; mq[1] = *(const LAS f32x4*)(Mg + 2444);
            ab0 -= mq[2][0] * xy[32]; ab1 -= mq[2][1] * xy[33]; ab0 -= mq[2][2] * xy[34]; ab1 -= mq[2][3] * xy[35]; mq[2] = *(const LAS f32x4*)(Mg + 2448);
            ab0 -= mq[3][0] * xy[36]; xy[37] = ab0 + ab1; up[4736] = xy[37][0]; wp[4736] = f2bf(-xy[37][1]); mq[3] = *(const LAS f32x4*)(Mg + 2452);
            { const float br = betg[38]; ab0 = (f32x2){bf2f(*(const LAS bf16_t*)(lg + P5_VS + 10336 + c * 2)) * br, bf2f(*(const LAS bf16_t*)(lg + P5_KS + 10336 + c * 2)) * br * __expf(decg[38])}; ab1 = (f32x2){0.f, 0.f}; } ab0 -= mq[4][0] * xy[0]; ab1 -= mq[4][1] * xy[1]; ab0 -= mq[4][2] * xy[2]; ab1 -= mq[4][3] * xy[3]; mq[4] = *(const LAS f32x4*)(Mg + 2456);
            ab0 -= mq[5][0] * xy[4]; ab1 -= mq[5][1] * xy[5]; ab0 -= mq[5][2] * xy[6]; ab1 -= mq[5][3] * xy[7]; mq[5] = *(const LAS f32x4*)(Mg + 2460);
            ab0 -= mq[0][0] * xy[8]; ab1 -= mq[0][1] * xy[9]; ab0 -= mq[0][2] * xy[10]; ab1 -= mq[0][3] * xy[11]; mq[0] = *(const LAS f32x4*)(Mg + 2464);
            ab0 -= mq[1][0] * xy[12]; ab1 -= mq[1][1] * xy[13]; ab0 -= mq[1][2] * xy[14]; ab1 -= mq[1][3] * xy[15]; mq[1] = *(const LAS f32x4*)(Mg + 2468);
            ab0 -= mq[2][0] * xy[16]; ab1 -= mq[2][1] * xy[17]; ab0 -= mq[2][2] * xy[18]; ab1 -= mq[2][3] * xy[19]; mq[2] = *(const LAS f32x4*)(Mg + 2496);
            ab0 -= mq[3][0] * xy[20]; ab1 -= mq[3][1] * xy[21]; ab0 -= mq[3][2] * xy[22]; ab1 -= mq[3][3] * xy[23]; mq[3] = *(const LAS f32x4*)(Mg + 2500);
            ab0 -= mq[4][0] * xy[24]; ab1 -= mq[4][1] * xy[25]; ab0 -= mq[4][2] * xy[26]; ab1 -= mq[4][3] * xy[27]; mq[4] = *(const LAS f32x4*)(Mg + 2504);
            ab0 -= mq[5][0] * xy[28]; ab1 -= mq[5][1] * xy[29]; ab0 -= mq[5][2] * xy[30]; ab1 -= mq[5][3] * xy[31]; mq[5] = *(const LAS f32x4*)(Mg + 2508);
            ab0 -= mq[0][0] * xy[32]; ab1 -= mq[0][1] * xy[33]; ab0 -= mq[0][2] * xy[34]; ab1 -= mq[0][3] * xy[35]; mq[0] = *(const LAS f32x4*)(Mg + 2512);
            ab0 -= mq[1][0] * xy[36]; ab1 -= mq[1][1] * xy[37]; xy[38] = ab0 + ab1; up[4864] = xy[38][0]; wp[4864] = f2bf(-xy[38][1]); mq[1] = *(const LAS f32x4*)(Mg + 2516);
            { const float br = betg[39]; ab0 = (f32x2){bf2f(*(const LAS bf16_t*)(lg + P5_VS + 10608 + c * 2)) * br, bf2f(*(const LAS bf16_t*)(lg + P5_KS + 10608 + c * 2)) * br * __expf(decg[39])}; ab1 = (f32x2){0.f, 0.f}; } ab0 -= mq[2][0] * xy[0]; ab1 -= mq[2][1] * xy[1]; ab0 -= mq[2][2] * xy[2]; ab1 -= mq[2][3] * xy[3]; mq[2] = *(const LAS f32x4*)(Mg + 2520);
            ab0 -= mq[3][0] * xy[4]; ab1 -= mq[3][1] * xy[5]; ab0 -= mq[3][2] * xy[6]; ab1 -= mq[3][3] * xy[7]; mq[3] = *(const LAS f32x4*)(Mg + 2524);
            ab0 -= mq[4][0] * xy[8]; ab1 -= mq[4][1] * xy[9]; ab0 -= mq[4][2] * xy[10]; ab1 -= mq[4][3] * xy[11]; mq[4] = *(const LAS f32x4*)(Mg + 2528);
            ab0 -= mq[5][0] * xy[12]; ab1 -= mq[5][1] * xy[13]; ab0 -= mq[5][2] * xy[14]; ab1 -= mq[5][3] * xy[15]; mq[5] = *(const LAS f32x4*)(Mg + 2532);
            ab0 -= mq[0][0] * xy[16]; ab1 -= mq[0][1] * xy[17]; ab0 -= mq[0][2] * xy[18]; ab1 -= mq[0][3] * xy[19]; mq[0] = *(const LAS f32x4*)(Mg + 2560);
            ab0 -= mq[1][0] * xy[20]; ab1 -= mq[1][1] * xy[21]; ab0 -= mq[1][2] * xy[22]; ab1 -= mq[1][3] * xy[23]; mq[1] = *(const LAS f32x4*)(Mg + 2564);
            ab0 -= mq[2][0] * xy[24]; ab1 -= mq[2][1] * xy[25]; ab0 -= mq[2][2] * xy[26]; ab1 -= mq[2][3] * xy[27]; mq[2] = *(const LAS f32x4*)(Mg + 2568);
            ab0 -= mq[3][0] * xy[28]; ab1 -= mq[3][1] * xy[29]; ab0 -= mq[3][2] * xy[30]; ab1 -= mq[3][3] * xy[31]; mq[3] = *(const LAS f32x4*)(Mg + 2572);
            ab0 -= mq[4][0] * xy[32]; ab1 -= mq[4][1] * xy[33]; ab0 -= mq[4][2] * xy[34]; ab1 -= mq[4][3] * xy[35]; mq[4] = *(const LAS f32x4*)(Mg + 2576);
            ab0 -= mq[5][0] * xy[36]; ab1 -= mq[5][1] * xy[37]; ab0 -= mq[5][2] * xy[38]; xy[39] = ab0 + ab1; up[4992] = xy[39][0]; wp[4992] = f2bf(-xy[39][1]); mq[5] = *(const LAS f32x4*)(Mg + 2580);
            { const float br = betg[40]; ab0 = (f32x2){bf2f(*(const LAS bf16_t*)(lg + P5_VS + 10880 + c * 2)) * br, bf2f(*(const LAS bf16_t*)(lg + P5_KS + 10880 + c * 2)) * br * __expf(decg[40])}; ab1 = (f32x2){0.f, 0.f}; } ab0 -= mq[0][0] * xy[0]; ab1 -= mq[0][1] * xy[1]; ab0 -= mq[0][2] * xy[2]; ab1 -= mq[0][3] * xy[3]; mq[0] = *(const LAS f32x4*)(Mg + 2584);
            ab0 -= mq[1][0] * xy[4]; ab1 -= mq[1][1] * xy[5]; ab0 -= mq[1][2] * xy[6]; ab1 -= mq[1][3] * xy[7]; mq[1] = *(const LAS f32x4*)(Mg + 2588);
            ab0 -= mq[2][0] * xy[8]; ab1 -= mq[2][1] * xy[9]; ab0 -= mq[2][2] * xy[10]; ab1 -= mq[2][3] * xy[11]; mq[2] = *(const LAS f32x4*)(Mg + 2592);
            ab0 -= mq[3][0] * xy[12]; ab1 -= mq[3][1] * xy[13]; ab0 -= mq[3][2] * xy[14]; ab1 -= mq[3][3] * xy[15]; mq[3] = *(const LAS f32x4*)(Mg + 2596);
            ab0 -= mq[4][0] * xy[16]; ab1 -= mq[4][1] * xy[17]; ab0 -= mq[4][2] * xy[18]; ab1 -= mq[4][3] * xy[19]; mq[4] = *(const LAS f32x4*)(Mg + 2624);
            ab0 -= mq[5][0] * xy[20]; ab1 -= mq[5][1] * xy[21]; ab0 -= mq[5][2] * xy[22]; ab1 -= mq[5][3] * xy[23]; mq[5] = *(const LAS f32x4*)(Mg + 2628);
            ab0 -= mq[0][0] * xy[24]; ab1 -= mq[0][1] * xy[25]; ab0 -= mq[0][2] * xy[26]; ab1 -= mq[0][3] * xy[27]; mq[0] = *(const LAS f32x4*)(Mg + 2632);
            ab0 -= mq[1][0] * xy[28]; ab1 -= mq[1][1] * xy[29]; ab0 -= mq[1][2] * xy[30]; ab1 -= mq[1][3] * xy[31]; mq[1] = *(const LAS f32x4*)(Mg + 2636);
            ab0 -= mq[2][0] * xy[32]; ab1 -= mq[2][1] * xy[33]; ab0 -= mq[2][2] * xy[34]; ab1 -= mq[2][3] * xy[35]; mq[2] = *(const LAS f32x4*)(Mg + 2640);
            ab0 -= mq[3][0] * xy[36]; ab1 -= mq[3][1] * xy[37]; ab0 -= mq[3][2] * xy[38]; ab1 -= mq[3][3] * xy[39]; xy[40] = ab0 + ab1; up[5120] = xy[40][0]; wp[5120] = f2bf(-xy[40][1]); mq[3] = *(const LAS f32x4*)(Mg + 2644);
            { const float br = betg[41]; ab0 = (f32x2){bf2f(*(const LAS bf16_t*)(lg + P5_VS + 11152 + c * 2)) * br, bf2f(*(const LAS bf16_t*)(lg + P5_KS + 11152 + c * 2)) * br * __expf(decg[41])}; ab1 = (f32x2){0.f, 0.f}; } ab0 -= mq[4][0] * xy[0]; ab1 -= mq[4][1] * xy[1]; ab0 -= mq[4][2] * xy[2]; ab1 -= mq[4][3] * xy[3]; mq[4] = *(const LAS f32x4*)(Mg + 2648);
            ab0 -= mq[5][0] * xy[4]; ab1 -= mq[5][1] * xy[5]; ab0 -= mq[5][2] * xy[6]; ab1 -= mq[5][3] * xy[7]; mq[5] = *(const LAS f32x4*)(Mg + 2652);
            ab0 -= mq[0][0] * xy[8]; ab1 -= mq[0][1] * xy[9]; ab0 -= mq[0][2] * xy[10]; ab1 -= mq[0][3] * xy[11]; mq[0] = *(const LAS f32x4*)(Mg + 2656);
            ab0 -= mq[1][0] * xy[12]; ab1 -= mq[1][1] * xy[13]; ab0 -= mq[1][2] * xy[14]; ab1 -= mq[1][3] * xy[15]; mq[1] = *(const LAS f32x4*)(Mg + 2660);
            ab0 -= mq[2][0] * xy[16]; ab1 -= mq[2][1] * xy[17]; ab0 -= mq[2][2] * xy[18]; ab1 -= mq[2][3] * xy[19]; mq[2] = *(const LAS f32x4*)(Mg + 2664);
            ab0 -= mq[3][0] * xy[20]; ab1 -= mq[3][1] * xy[21]; ab0 -= mq[3][2] * xy[22]; ab1 -= mq[3][3] * xy[23]; mq[3] = *(const LAS f32x4*)(Mg + 2688);
            ab0 -= mq[4][0] * xy[24]; ab1 -= mq[4][1] * xy[25]; ab0 -= mq[4][2] * xy[26]; ab1 -= mq[4][3] * xy[27]; mq[4] = *(const LAS f32x4*)(Mg + 2692);
            ab0 -= mq[5][0] * xy[28]; ab1 -= mq[5][1] * xy[29]; ab0 -= mq[5][2] * xy[30]; ab1 -= mq[5][3] * xy[31]; mq[5] = *(const LAS f32x4*)(Mg + 2696);
            ab0 -= mq[0][0] * xy[32]; ab1 -= mq[0][1] * xy[33]; ab0 -= mq[0][2] * xy[34]; ab1 -= mq[0][3] * xy[35]; mq[0] = *(const LAS f32x4*)(Mg + 2700);
            ab0 -= mq[1][0] * xy[36]; ab1 -= mq[1][1] * xy[37]; ab0 -= mq[1][2] * xy[38]; ab1 -= mq[1][3] * xy[39]; mq[1] = *(const LAS f32x4*)(Mg + 2704);
            ab0 -= mq[2][0] * xy[40]; xy[41] = ab0 + ab1; up[5248] = xy[41][0]; wp[5248] = f2bf(-xy[41][1]); mq[2] = *(const LAS f32x4*)(Mg + 2708);
            { const float br = betg[42]; ab0 = (f32x2){bf2f(*(const LAS bf16_t*)(lg + P5_VS + 11424 + c * 2)) * br, bf2f(*(const LAS bf16_t*)(lg + P5_KS + 11424 + c * 2)) * br * __expf(decg[42])}; ab1 = (f32x2){0.f, 0.f}; } ab0 -= mq[3][0] * xy[0]; ab1 -= mq[3][1] * xy[1]; ab0 -= mq[3][2] * xy[2]; ab1 -= mq[3][3] * xy[3]; mq[3] = *(const LAS f32x4*)(Mg + 2712);
            ab0 -= mq[4][0] * xy[4]; ab1 -= mq[4][1] * xy[5]; ab0 -= mq[4][2] * xy[6]; ab1 -= mq[4][3] * xy[7]; mq[4] = *(const LAS f32x4*)(Mg + 2716);
            ab0 -= mq[5][0] * xy[8]; ab1 -= mq[5][1] * xy[9]; ab0 -= mq[5][2] * xy[10]; ab1 -= mq[5][3] * xy[11]; mq[5] = *(const LAS f32x4*)(Mg + 2720);
            ab0 -= mq[0][0] * xy[12]; ab1 -= mq[0][1] * xy[13]; ab0 -= mq[0][2] * xy[14]; ab1 -= mq[0][3] * xy[15]; mq[0] = *(const LAS f32x4*)(Mg + 2724);
            ab0 -= mq[1][0] * xy[16]; ab1 -= mq[1][1] * xy[17]; ab0 -= mq[1][2] * xy[18]; ab1 -= mq[1][3] * xy[19]; mq[1] = *(const LAS f32x4*)(Mg + 2728);
            ab0 -= mq[2][0] * xy[20]; ab1 -= mq[2][1] * xy[21]; ab0 -= mq[2][2] * xy[22]; ab1 -= mq[2][3] * xy[23]; mq[2] = *(const LAS f32x4*)(Mg + 2752);
            ab0 -= mq[3][0] * xy[24]; ab1 -= mq[3][1] * xy[25]; ab0 -= mq[3][2] * xy[26]; ab1 -= mq[3][3] * xy[27]; mq[3] = *(const LAS f32x4*)(Mg + 2756);
            ab0 -= mq[4][0] * xy[28]; ab1 -= mq[4][1] * xy[29]; ab0 -= mq[4][2] * xy[30]; ab1 -= mq[4][3] * xy[31]; mq[4] = *(const LAS f32x4*)(Mg + 2760);
            ab0 -= mq[5][0] * xy[32]; ab1 -= mq[5][1] * xy[33]; ab0 -= mq[5][2] * xy[34]; ab1 -= mq[5][3] * xy[35]; mq[5] = *(const LAS f32x4*)(Mg + 2764);
            ab0 -= mq[0][0] * xy[36]; ab1 -= mq[0][1] * xy[37]; ab0 -= mq[0][2] * xy[38]; ab1 -= mq[0][3] * xy[39]; mq[0] = *(const LAS f32x4*)(Mg + 2768);
            ab0 -= mq[1][0] * xy[40]; ab1 -= mq[1][1] * xy[41]; xy[42] = ab0 + ab1; up[5376] = xy[42][0]; wp[5376] = f2bf(-xy[42][1]); mq[1] = *(const LAS f32x4*)(Mg + 2772);
            { const float br = betg[43]; ab0 = (f32x2){bf2f(*(const LAS bf16_t*)(lg + P5_VS + 11696 + c * 2)) * br, bf2f(*(const LAS bf16_t*)(lg + P5_KS + 11696 + c * 2)) * br * __expf(decg[43])}; ab1 = (f32x2){0.f, 0.f}; } ab0 -= mq[2][0] * xy[0]; ab1 -= mq[2][1] * xy[1]; ab0 -= mq[2][2] * xy[2]; ab1 -= mq[2][3] * xy[3]; mq[2] = *(const LAS f32x4*)(Mg + 2776);
            ab0 -= mq[3][0] * xy[4]; ab1 -= mq[3][1] * xy[5]; ab0 -= mq[3][2] * xy[6]; ab1 -= mq[3][3] * xy[7]; mq[3] = *(const LAS f32x4*)(Mg + 2780);
            ab0 -= mq[4][0] * xy[8]; ab1 -= mq[4][1] * xy[9]; ab0 -= mq[4][2] * xy[10]; ab1 -= mq[4][3] * xy[11]; mq[4] = *(const LAS f32x4*)(Mg + 2784);
            ab0 -= mq[5][0] * xy[12]; ab1 -= mq[5][1] * xy[13]; ab0 -= mq[5][2] * xy[14]; ab1 -= mq[5][3] * xy[15]; mq[5] = *(const LAS f32x4*)(Mg + 2788);
            ab0 -= mq[0][0] * xy[16]; ab1 -= mq[0][1] * xy[17]; ab0 -= mq[0][2] * xy[18]; ab1 -= mq[0][3] * xy[19]; mq[0] = *(const LAS f32x4*)(Mg + 2792);
            ab0 -= mq[1][0] * xy[20]; ab1 -= mq[1][1] * xy[21]; ab0 -= mq[1][2] * xy[22]; ab1 -= mq[1][3] * xy[23]; mq[1] = *(const LAS f32x4*)(Mg + 2816);
            ab0 -= mq[2][0] * xy[24]; ab1 -= mq[2][1] * xy[25]; ab0 -= mq[2][2] * xy[26]; ab1 -= mq[2][3] * xy[27]; mq[2] = *(const LAS f32x4*)(Mg + 2820);
            ab0 -= mq[3][0] * xy[28]; ab1 -= mq[3][1] * xy[29]; ab0 -= mq[3][2] * xy[30]; ab1 -= mq[3][3] * xy[31]; mq[3] = *(const LAS f32x4*)(Mg + 2824);
            ab0 -= mq[4][0] * xy[32]; ab1 -= mq[4][1] * xy[33]; ab0 -= mq[4][2] * xy[34]; ab1 -= mq[4][3] * xy[35]; mq[4] = *(const LAS f32x4*)(Mg + 2828);
            ab0 -= mq[5][0] * xy[36]; ab1 -= mq[5][1] * xy[37]; ab0 -= mq[5][2] * xy[38]; ab1 -= mq[5][3] * xy[39]; mq[5] = *(const LAS f32x4*)(Mg + 2832);
            ab0 -= mq[0][0] * xy[40]; ab1 -= mq[0][1] * xy[41]; ab0 -= mq[0][2] * xy[42]; xy[43] = ab0 + ab1; up[5504] = xy[43][0]; wp[5504] = f2bf(-xy[43][1]); mq[0] = *(const LAS f32x4*)(Mg + 2836);
            { const float br = betg[44]; ab0 = (f32x2){bf2f(*(const LAS bf16_t*)(lg + P5_VS + 11968 + c * 2)) * br, bf2f(*(const LAS bf16_t*)(lg + P5_KS + 11968 + c * 2)) * br * __expf(decg[44])}; ab1 = (f32x2){0.f, 0.f}; } ab0 -= mq[1][0] * xy[0]; ab1 -= mq[1][1] * xy[1]; ab0 -= mq[1][2] * xy[2]; ab1 -= mq[1][3] * xy[3]; mq[1] = *(const LAS f32x4*)(Mg + 2840);
            ab0 -= mq[2][0] * xy[4]; ab1 -= mq[2][1] * xy[5]; ab0 -= mq[2][2] * xy[6]; ab1 -= mq[2][3] * xy[7]; mq[2] = *(const LAS f32x4*)(Mg + 2844);
            ab0 -= mq[3][0] * xy[8]; ab1 -= mq[3][1] * xy[9]; ab0 -= mq[3][2] * xy[10]; ab1 -= mq[3][3] * xy[11]; mq[3] = *(const LAS f32x4*)(Mg + 2848);
            ab0 -= mq[4][0] * xy[12]; ab1 -= mq[4][1] * xy[13]; ab0 -= mq[4][2] * xy[14]; ab1 -= mq[4][3] * xy[15]; mq[4] = *(const LAS f32x4*)(Mg + 2852);
            ab0 -= mq[5][0] * xy[16]; ab1 -= mq[5][1] * xy[17]; ab0 -= mq[5][2] * xy[18]; ab1 -= mq[5][3] * xy[19]; mq[5] = *(const LAS f32x4*)(Mg + 2856);
            ab0 -= mq[0][0] * xy[20]; ab1 -= mq[0][1] * xy[21]; ab0 -= mq[0][2] * xy[22]; ab1 -= mq[0][3] * xy[23]; mq[0] = *(const LAS f32x4*)(Mg + 2880);
            ab0 -= mq[1][0] * xy[24]; ab1 -= mq[1][1] * xy[25]; ab0 -= mq[1][2] * xy[26]; ab1 -= mq[1][3] * xy[27]; mq[1] = *(const LAS f32x4*)(Mg + 2884);
            ab0 -= mq[2][0] * xy[28]; ab1 -= mq[2][1] * xy[29]; ab0 -= mq[2][2] * xy[30]; ab1 -= mq[2][3] * xy[31]; mq[2] = *(const LAS f32x4*)(Mg + 2888);
            ab0 -= mq[3][0] * xy[32]; ab1 -= mq[3][1] * xy[33]; ab0 -= mq[3][2] * xy[34]; ab1 -= mq[3][3] * xy[35]; mq[3] = *(const LAS f32x4*)(Mg + 2892);
            ab0 -= mq[4][0] * xy[36]; ab1 -= mq[4][1] * xy[37]; ab0 -= mq[4][2] * xy[38]; ab1 -= mq[4][3] * xy[39]; mq[4] = *(const LAS f32x4*)(Mg + 2896);
            ab0 -= mq[5][0] * xy[40]; ab1 -= mq[5][1] * xy[41]; ab0 -= mq[5][2] * xy[42]; ab1 -= mq[5][3] * xy[43]; xy[44] = ab0 + ab1; up[5632] = xy[44][0]; wp[5632] = f2bf(-xy[44][1]); mq[5] = *(const LAS f32x4*)(Mg + 2900);
            { const float br = betg[45]; ab0 = (f32x2){bf2f(*(const LAS bf16_t*)(lg + P5_VS + 12240 + c * 2)) * br, bf2f(*(const LAS bf16_t*)(lg + P5_KS + 12240 + c * 2)) * br * __expf(decg[45])}; ab1 = (f32x2){0.f, 0.f}; } ab0 -= mq[0][0] * xy[0]; ab1 -= mq[0][1] * xy[1]; ab0 -= mq[0][2] * xy[2]; ab1 -= mq[0][3] * xy[3]; mq[0] = *(const LAS f32x4*)(Mg + 2904);
            ab0 -= mq[1][0] * xy[4]; ab1 -= mq[1][1] * xy[5]; ab0 -= mq[1][2] * xy[6]; ab1 -= mq[1][3] * xy[7]; mq[1] = *(const LAS f32x4*)(Mg + 2908);
            ab0 -= mq[2][0] * xy[8]; ab1 -= mq[2][1] * xy[9]; ab0 -= mq[2][2] * xy[10]; ab1 -= mq[2][3] * xy[11]; mq[2] = *(const LAS f32x4*)(Mg + 2912);
            ab0 -= mq[3][0] * xy[12]; ab1 -= mq[3][1] * xy[13]; ab0 -= mq[3][2] * xy[14]; ab1 -= mq[3][3] * xy[15]; mq[3] = *(const LAS f32x4*)(Mg + 2916);
            ab0 -= mq[4][0] * xy[16]; ab1 -= mq[4][1] * xy[17]; ab0 -= mq[4][2] * xy[18]; ab1 -= mq[4][3] * xy[19]; mq[4] = *(const LAS f32x4*)(Mg + 2920);
            ab0 -= mq[5][0] * xy[20]; ab1 -= mq[5][1] * xy[21]; ab0 -= mq[5][2] * xy[22]; ab1 -= mq[5][3] * xy[23]; mq[5] = *(const LAS f32x4*)(Mg + 2924);
            ab0 -= mq[0][0] * xy[24]; ab1 -= mq[0][1] * xy[25]; ab0 -= mq[0][2] * xy[26]; ab1 -= mq[0][3] * xy[27]; mq[0] = *(const LAS f32x4*)(Mg + 2944);
            ab0 -= mq[1][0] * xy[28]; ab1 -= mq[1][1] * xy[29]; ab0 -= mq[1][2] * xy[30]; ab1 -= mq[1][3] * xy[31]; mq[1] = *(const LAS f32x4*)(Mg + 2948);
            ab0 -= mq[2][0] * xy[32]; ab1 -= mq[2][1] * xy[33]; ab0 -= mq[2][2] * xy[34]; ab1 -= mq[2][3] * xy[35]; mq[2] = *(const LAS f32x4*)(Mg + 2952);
            ab0 -= mq[3][0] * xy[36]; ab1 -= mq[3][1] * xy[37]; ab0 -= mq[3][2] * xy[38]; ab1 -= mq[3][3] * xy[39]; mq[3] = *(const LAS f32x4*)(Mg + 2956);
            ab0 -= mq[4][0] * xy[40]; ab1 -= mq[4][1] * xy[41]; ab0 -= mq[4][2] * xy[42]; ab1 -= mq[4][3] * xy[43]; mq[4] = *(const LAS f32x4*)(Mg + 2960);
            ab0 -= mq[5][0] * xy[44]; xy[45] = ab0 + ab1; up[5760] = xy[45][0]; wp[5760] = f2bf(-xy[45][1]); mq[5] = *(const LAS f32x4*)(Mg + 2964);
            { const float br = betg[46]; ab0 = (f32x2){bf2f(*(const LAS bf16_t*)(lg + P5_VS + 12512 + c * 2)) * br, bf2f(*(const LAS bf16_t*)(lg + P5_KS + 12512 + c * 2)) * br * __expf(decg[46])}; ab1 = (f32x2){0.f, 0.f}; } ab0 -= mq[0][0] * xy[0]; ab1 -= mq[0][1] * xy[1]; ab0 -= mq[0][2] * xy[2]; ab1 -= mq[0][3] * xy[3]; mq[0] = *(const LAS f32x4*)(Mg + 2968);
            ab0 -= mq[1][0] * xy[4]; ab1 -= mq[1][1] * xy[5]; ab0 -= mq[1][2] * xy[6]; ab1 -= mq[1][3] * xy[7]; mq[1] = *(const LAS f32x4*)(Mg + 2972);
            ab0 -= mq[2][0] * xy[8]; ab1 -= mq[2][1] * xy[9]; ab0 -= mq[2][2] * xy[10]; ab1 -= mq[2][3] * xy[11]; mq[2] = *(const LAS f32x4*)(Mg + 2976);
            ab0 -= mq[3][0] * xy[12]; ab1 -= mq[3][1] * xy[13]; ab0 -= mq[3][2] * xy[14]; ab1 -= mq[3][3] * xy[15]; mq[3] = *(const LAS f32x4*)(Mg + 2980);
            ab0 -= mq[4][0] * xy[16]; ab1 -= mq[4][1] * xy[17]; ab0 -= mq[4][2] * xy[18]; ab1 -= mq[4][3] * xy[19]; mq[4] = *(const LAS f32x4*)(Mg + 2984);
            ab0 -= mq[5][0] * xy[20]; ab1 -= mq[5][1] * xy[21]; ab0 -= mq[5][2] * xy[22]; ab1 -= mq[5][3] * xy[23]; mq[5] = *(const LAS f32x4*)(Mg + 2988);
            ab0 -= mq[0][0] * xy[24]; ab1 -= mq[0][1] * xy[25]; ab0 -= mq[0][2] * xy[26]; ab1 -= mq[0][3] * xy[27]; mq[0] = *(const LAS f32x4*)(Mg + 3008);
            ab0 -= mq[1][0] * xy[28]; ab1 -= mq[1][1] * xy[29]; ab0 -= mq[1][2] * xy[30]; ab1 -= mq[1][3] * xy[31]; mq[1] = *(const LAS f32x4*)(Mg + 3012);
            ab0 -= mq[2][0] * xy[32]; ab1 -= mq[2][1] * xy[33]; ab0 -= mq[2][2] * xy[34]; ab1 -= mq[2][3] * xy[35]; mq[2] = *(const LAS f32x4*)(Mg + 3016);
            ab0 -= mq[3][0] * xy[36]; ab1 -= mq[3][1] * xy[37]; ab0 -= mq[3][2] * xy[38]; ab1 -= mq[3][3] * xy[39]; mq[3] = *(const LAS f32x4*)(Mg + 3020);
            ab0 -= mq[4][0] * xy[40]; ab1 -= mq[4][1] * xy[41]; ab0 -= mq[4][2] * xy[42]; ab1 -= mq[4][3] * xy[43]; mq[4] = *(const LAS f32x4*)(Mg + 3024);
            ab0 -= mq[5][0] * xy[44]; ab1 -= mq[5][1] * xy[45]; xy[46] = ab0 + ab1; up[5888] = xy[46][0]; wp[5888] = f2bf(-xy[46][1]); mq[5] = *(const LAS f32x4*)(Mg + 3028);
            { const float br = betg[47]; ab0 = (f32x2){bf2f(*(const LAS bf16_t*)(lg + P5_VS + 12784 + c * 2)) * br, bf2f(*(const LAS bf16_t*)(lg + P5_KS + 12784 + c * 2)) * br * __expf(decg[47])}; ab1 = (f32x2){0.f, 0.f}; } ab0 -= mq[0][0] * xy[0]; ab1 -= mq[0][1] * xy[1]; ab0 -= mq[0][2] * xy[2]; ab1 -= mq[0][3] * xy[3]; mq[0] = *(const LAS f32x4*)(Mg + 3032);
            ab0 -= mq[1][0] * xy[4]; ab1 -= mq[1][1] * xy[5]; ab0 -= mq[1][2] * xy[6]; ab1 -= mq[1][3] * xy[7]; mq[1] = *(const LAS f32x4*)(Mg + 3036);
            ab0 -= mq[2][0] * xy[8]; ab1 -= mq[2][1] * xy[9]; ab0 -= mq[2][2] * xy[10]; ab1 -= mq[2][3] * xy[11]; mq[2] = *(const LAS f32x4*)(Mg + 3040);
            ab0 -= mq[3][0] * xy[12]; ab1 -= mq[3][1] * xy[13]; ab0 -= mq[3][2] * xy[14]; ab1 -= mq[3][3] * xy[15]; mq[3] = *(const LAS f32x4*)(Mg + 3044);
            ab0 -= mq[4][0] * xy[16]; ab1 -= mq[4][1] * xy[17]; ab0 -= mq[4][2] * xy[18]; ab1 -= mq[4][3] * xy[19]; mq[4] = *(const LAS f32x4*)(Mg + 3048);
            ab0 -= mq[5][0] * xy[20]; ab1 -= mq[5][1] * xy[21]; ab0 -= mq[5][2] * xy[22]; ab1 -= mq[5][3] * xy[23]; mq[5] = *(const LAS f32x4*)(Mg + 3052);
            ab0 -= mq[0][0] * xy[24]; ab1 -= mq[0][1] * xy[25]; ab0 -= mq[0][2] * xy[26]; ab1 -= mq[0][3] * xy[27]; mq[0] = *(const LAS f32x4*)(Mg + 3072);
            ab0 -= mq[1][0] * xy[28]; ab1 -= mq[1][1] * xy[29]; ab0 -= mq[1][2] * xy[30]; ab1 -= mq[1][3] * xy[31]; mq[1] = *(const LAS f32x4*)(Mg + 3076);
            ab0 -= mq[2][0] * xy[32]; ab1 -= mq[2][1] * xy[33]; ab0 -= mq[2][2] * xy[34]; ab1 -= mq[2][3] * xy[35]; mq[2] = *(const LAS f32x4*)(Mg + 3080);
            ab0 -= mq[3][0] * xy[36]; ab1 -= mq[3][1] * xy[37]; ab0 -= mq[3][2] * xy[38]; ab1 -= mq[3][3] * xy[39]; mq[3] = *(const LAS f32x4*)(Mg + 3084);
            ab0 -= mq[4][0] * xy[40]; ab1 -= mq[4][1] * xy[41]; ab0 -= mq[4][2] * xy[42]; ab1 -= mq[4][3] * xy[43]; mq[4] = *(const LAS f32x4*)(Mg + 3088);
            ab0 -= mq[5][0] * xy[44]; ab1 -= mq[5][1] * xy[45]; ab0 -= mq[5][2] * xy[46]; xy[47] = ab0 + ab1; up[6016] = xy[47][0]; wp[6016] = f2bf(-xy[47][1]); mq[5] = *(const LAS f32x4*)(Mg + 3092);
            { const float br = betg[48]; ab0 = (f32x2){bf2f(*(const LAS bf16_t*)(lg + P5_VS + 13056 + c * 2)) * br, bf2f(*(const LAS bf16_t*)(lg + P5_KS + 13056 + c * 2)) * br * __expf(decg[48])}; ab1 = (f32x2){0.f, 0.f}; } ab0 -= mq[0][0] * xy[0]; ab1 -= mq[0][1] * xy[1]; ab0 -= mq[0][2] * xy[2]; ab1 -= mq[0][3] * xy[3]; mq[0] = *(const LAS f32x4*)(Mg + 3096);
            ab0 -= mq[1][0] * xy[4]; ab1 -= mq[1][1] * xy[5]; ab0 -= mq[1][2] * xy[6]; ab1 -= mq[1][3] * xy[7]; mq[1] = *(const LAS f32x4*)(Mg + 3100);
            ab0 -= mq[2][0] * xy[8]; ab1 -= mq[2][1] * xy[9]; ab0 -= mq[2][2] * xy[10]; ab1 -= mq[2][3] * xy[11]; mq[2] = *(const LAS f32x4*)(Mg + 3104);
            ab0 -= mq[3][0] * xy[12]; ab1 -= mq[3][1] * xy[13]; ab0 -= mq[3][2] * xy[14]; ab1 -= mq[3][3] * xy[15]; mq[3] = *(const LAS f32x4*)(Mg + 3108);
            ab0 -= mq[4][0] * xy[16]; ab1 -= mq[4][1] * xy[17]; ab0 -= mq[4][2] * xy[18]; ab1 -= mq[4][3] * xy[19]; mq[4] = *(const LAS f32x4*)(Mg + 3112);
            ab0 -= mq[5][0] * xy[20]; ab1 -= mq[5][1] * xy[21]; ab0 -= mq[5][2] * xy[22]; ab1 -= mq[5][3] * xy[23]; mq[5] = *(const LAS f32x4*)(Mg + 3116);
            ab0 -= mq[0][0] * xy[24]; ab1 -= mq[0][1] * xy[25]; ab0 -= mq[0][2] * xy[26]; ab1 -= mq[0][3] * xy[27]; mq[0] = *(const LAS f32x4*)(Mg + 3136);
            ab0 -= mq[1][0] * xy[28]; ab1 -= mq[1][1] * xy[29]; ab0 -= mq[1][2] * xy[30]; ab1 -= mq[1][3] * xy[31]; mq[1] = *(const LAS f32x4*)(Mg + 3140);
            ab0 -= mq[2][0] * xy[32]; ab1 -= mq[2][1] * xy[33]; ab0 -= mq[2][2] * xy[34]; ab1 -= mq[2][3] * xy[35]; mq[2] = *(const LAS f32x4*)(Mg + 3144);
            ab0 -= mq[3][0] * xy[36]; ab1 -= mq[3][1] * xy[37]; ab0 -= mq[3][2] * xy[38]; ab1 -= mq[3][3] * xy[39]; mq[3] = *(const LAS f32x4*)(Mg + 3148);
            ab0 -= mq[4][0] * xy[40]; ab1 -= mq[4][1] * xy[41]; ab0 -= mq[4][2] * xy[42]; ab1 -= mq[4][3] * xy[43]; mq[4] = *(const LAS f32x4*)(Mg + 3152);
            ab0 -= mq[5][0] * xy[44]; ab1 -= mq[5][1] * xy[45]; ab0 -= mq[5][2] * xy[46]; ab1 -= mq[5][3] * xy[47]; xy[48] = ab0 + ab1; up[6144] = xy[48][0]; wp[6144] = f2bf(-xy[48][1]); mq[5] = *(const LAS f32x4*)(Mg + 3156);
            { const float br = betg[49]; ab0 = (f32x2){bf2f(*(const LAS bf16_t*)(lg + P5_VS + 13328 + c * 2)) * br, bf2f(*(const LAS bf16_t*)(lg + P5_KS + 13328 + c * 2)) * br * __expf(decg[49])}; ab1 = (f32x2){0.f, 0.f}; } ab0 -= mq[0][0] * xy[0]; ab1 -= mq[0][1] * xy[1]; ab0 -= mq[0][2] * xy[2]; ab1 -= mq[0][3] * xy[3]; mq[0] = *(const LAS f32x4*)(Mg + 3160);
            ab0 -= mq[1][0] * xy[4]; ab1 -= mq[1][1] * xy[5]; ab0 -= mq[1][2] * xy[6]; ab1 -= mq[1][3] * xy[7]; mq[1] = *(const LAS f32x4*)(Mg + 3164);
            ab0 -= mq[2][0] * xy[8]; ab1 -= mq[2][1] * xy[9]; ab0 -= mq[2][2] * xy[10]; ab1 -= mq[2][3] * xy[11]; mq[2] = *(const LAS f32x4*)(Mg + 3168);
            ab0 -= mq[3][0] * xy[12]; ab1 -= mq[3][1] * xy[13]; ab0 -= mq[3][2] * xy[14]; ab1 -= mq[3][3] * xy[15]; mq[3] = *(const LAS f32x4*)(Mg + 3172);
            ab0 -= mq[4][0] * xy[16]; ab1 -= mq[4][1] * xy[17]; ab0 -= mq[4][2] * xy[18]; ab1 -= mq[4][3] * xy[19]; mq[4] = *(const LAS f32x4*)(Mg + 3176);
            ab0 -= mq[5][0] * xy[20]; ab1 -= mq[5][1] * xy[21]; ab0 -= mq[5][2] * xy[22]; ab1 -= mq[5][3] * xy[23]; mq[5] = *(const LAS f32x4*)(Mg + 3180);
            ab0 -= mq[0][0] * xy[24]; ab1 -= mq[0][1] * xy[25]; ab0 -= mq[0][2] * xy[26]; ab1 -= mq[0][3] * xy[27]; mq[0] = *(const LAS f32x4*)(Mg + 3184);
            ab0 -= mq[1][0] * xy[28]; ab1 -= mq[1][1] * xy[29]; ab0 -= mq[1][2] * xy[30]; ab1 -= mq[1][3] * xy[31]; mq[1] = *(const LAS f32x4*)(Mg + 3200);
            ab0 -= mq[2][0] * xy[32]; ab1 -= mq[2][1] * xy[33]; ab0 -= mq[2][2] * xy[34]; ab1 -= mq[2][3] * xy[35]; mq[2] = *(const LAS f32x4*)(Mg + 3204);
            ab0 -= mq[3][0] * xy[36]; ab1 -= mq[3][1] * xy[37]; ab0 -= mq[3][2] * xy[38]; ab1 -= mq[3][3] * xy[39]; mq[3] = *(const LAS f32x4*)(Mg + 3208);
            ab0 -= mq[4][0] * xy[40]; ab1 -= mq[4][1] * xy[41]; ab0 -= mq[4][2] * xy[42]; ab1 -= mq[4][3] * xy[43]; mq[4] = *(const LAS f32x4*)(Mg + 3212);
            ab0 -= mq[5][0] * xy[44]; ab1 -= mq[5][1] * xy[45]; ab0 -= mq[5][2] * xy[46]; ab1 -= mq[5][3] * xy[47]; mq[5] = *(const LAS f32x4*)(Mg + 3216);
            ab0 -= mq[0][0] * xy[48]; xy[49] = ab0 + ab1; up[6272] = xy[49][0]; wp[6272] = f2bf(-xy[49][1]); mq[0] = *(const LAS f32x4*)(Mg + 3220);
            { const float br = betg[50]; ab0 = (f32x2){bf2f(*(const LAS bf16_t*)(lg + P5_VS + 13600 + c * 2)) * br, bf2f(*(const LAS bf16_t*)(lg + P5_KS + 13600 + c * 2)) * br * __expf(decg[50])}; ab1 = (f32x2){0.f, 0.f}; } ab0 -= mq[1][0] * xy[0]; ab1 -= mq[1][1] * xy[1]; ab0 -= mq[1][2] * xy[2]; ab1 -= mq[1][3] * xy[3]; mq[1] = *(const LAS f32x4*)(Mg + 3224);
            ab0 -= mq[2][0] * xy[4]; ab1 -= mq[2][1] * xy[5]; ab0 -= mq[2][2] * xy[6]; ab1 -= mq[2][3] * xy[7]; mq[2] = *(const LAS f32x4*)(Mg + 3228);
            ab0 -= mq[3][0] * xy[8]; ab1 -= mq[3][1] * xy[9]; ab0 -= mq[3][2] * xy[10]; ab1 -= mq[3][3] * xy[11]; mq[3] = *(const LAS f32x4*)(Mg + 3232);
            ab0 -= mq[4][0] * xy[12]; ab1 -= mq[4][1] * xy[13]; ab0 -= mq[4][2] * xy[14]; ab1 -= mq[4][3] * xy[15]; mq[4] = *(const LAS f32x4*)(Mg + 3236);
            ab0 -= mq[5][0] * xy[16]; ab1 -= mq[5][1] * xy[17]; ab0 -= mq[5][2] * xy[18]; ab1 -= mq[5][3] * xy[19]; mq[5] = *(const LAS f32x4*)(Mg + 3240);
            ab0 -= mq[0][0] * xy[20]; ab1 -= mq[0][1] * xy[21]; ab0 -= mq[0][2] * xy[22]; ab1 -= mq[0][3] * xy[23]; mq[0] = *(const LAS f32x4*)(Mg + 3244);
            ab0 -= mq[1][0] * xy[24]; ab1 -= mq[1][1] * xy[25]; ab0 -= mq[1][2] * xy[26]; ab1 -= mq[1][3] * xy[27]; mq[1] = *(const LAS f32x4*)(Mg + 3248);
            ab0 -= mq[2][0] * xy[28]; ab1 -= mq[2][1] * xy[29]; ab0 -= mq[2][2] * xy[30]; ab1 -= mq[2][3] * xy[31]; mq[2] = *(const LAS f32x4*)(Mg + 3264);
            ab0 -= mq[3][0] * xy[32]; ab1 -= mq[3][1] * xy[33]; ab0 -= mq[3][2] * xy[34]; ab1 -= mq[3][3] * xy[35]; mq[3] = *(const LAS f32x4*)(Mg + 3268);
            ab0 -= mq[4][0] * xy[36]; ab1 -= mq[4][1] * xy[37]; ab0 -= mq[4][2] * xy[38]; ab1 -= mq[4][3] * xy[39]; mq[4] = *(const LAS f32x4*)(Mg + 3272);
            ab0 -= mq[5][0] * xy[40]; ab1 -= mq[5][1] * xy[41]; ab0 -= mq[5][2] * xy[42]; ab1 -= mq[5][3] * xy[43]; mq[5] = *(const LAS f32x4*)(Mg + 3276);
            ab0 -= mq[0][0] * xy[44]; ab1 -= mq[0][1] * xy[45]; ab0 -= mq[0][2] * xy[46]; ab1 -= mq[0][3] * xy[47]; mq[0] = *(const LAS f32x4*)(Mg + 3280);
            ab0 -= mq[1][0] * xy[48]; ab1 -= mq[1][1] * xy[49]; xy[50] = ab0 + ab1; up[6400] = xy[50][0]; wp[6400] = f2bf(-xy[50][1]); mq[1] = *(const LAS f32x4*)(Mg + 3284);
            { const float br = betg[51]; ab0 = (f32x2){bf2f(*(const LAS bf16_t*)(lg + P5_VS + 13872 + c * 2)) * br, bf2f(*(const LAS bf16_t*)(lg + P5_KS + 13872 + c * 2)) * br * __expf(decg[51])}; ab1 = (f32x2){0.f, 0.f}; } ab0 -= mq[2][0] * xy[0]; ab1 -= mq[2][1] * xy[1]; ab0 -= mq[2][2] * xy[2]; ab1 -= mq[2][3] * xy[3]; mq[2] = *(const LAS f32x4*)(Mg + 3288);
            ab0 -= mq[3][0] * xy[4]; ab1 -= mq[3][1] * xy[5]; ab0 -= mq[3][2] * xy[6]; ab1 -= mq[3][3] * xy[7]; mq[3] = *(const LAS f32x4*)(Mg + 3292);
            ab0 -= mq[4][0] * xy[8]; ab1 -= mq[4][1] * xy[9]; ab0 -= mq[4][2] * xy[10]; ab1 -= mq[4][3] * xy[11]; mq[4] = *(const LAS f32x4*)(Mg + 3296);
            ab0 -= mq[5][0] * xy[12]; ab1 -= mq[5][1] * xy[13]; ab0 -= mq[5][2] * xy[14]; ab1 -= mq[5][3] * xy[15]; mq[5] = *(const LAS f32x4*)(Mg + 3300);
            ab0 -= mq[0][0] * xy[16]; ab1 -= mq[0][1] * xy[17]; ab0 -= mq[0][2] * xy[18]; ab1 -= mq[0][3] * xy[19]; mq[0] = *(const LAS f32x4*)(Mg + 3304);
            ab0 -= mq[1][0] * xy[20]; ab1 -= mq[1][1] * xy[21]; ab0 -= mq[1][2] * xy[22]; ab1 -= mq[1][3] * xy[23]; mq[1] = *(const LAS f32x4*)(Mg + 3308);
            ab0 -= mq[2][0] * xy[24]; ab1 -= mq[2][1] * xy[25]; ab0 -= mq[2][2] * xy[26]; ab1 -= mq[2][3] * xy[27]; mq[2] = *(const LAS f32x4*)(Mg + 3312);
            ab0 -= mq[3][0] * xy[28]; ab1 -= mq[3][1] * xy[29]; ab0 -= mq[3][2] * xy[30]; ab1 -= mq[3][3] * xy[31]; mq[3] = *(const LAS f32x4*)(Mg + 3328);
            ab0 -= mq[4][0] * xy[32]; ab1 -= mq[4][1] * xy[33]; ab0 -= mq[4][2] * xy[34]; ab1 -= mq[4][3] * xy[35]; mq[4] = *(const LAS f32x4*)(Mg + 3332);
            ab0 -= mq[5][0] * xy[36]; ab1 -= mq[5][1] * xy[37]; ab0 -= mq[5][2] * xy[38]; ab1 -= mq[5][3] * xy[39]; mq[5] = *(const LAS f32x4*)(Mg + 3336);
            ab0 -= mq[0][0] * xy[40]; ab1 -= mq[0][1] * xy[41]; ab0 -= mq[0][2] * xy[42]; ab1 -= mq[0][3] * xy[43]; mq[0] = *(const LAS f32x4*)(Mg + 3340);
            ab0 -= mq[1][0] * xy[44]; ab1 -= mq[1][1] * xy[45]; ab0 -= mq[1][2] * xy[46]; ab1 -= mq[1][3] * xy[47]; mq[1] = *(const LAS f32x4*)(Mg + 3344);
            ab0 -= mq[2][0] * xy[48]; ab1 -= mq[2][1] * xy[49]; ab0 -= mq[2][2] * xy[50]; xy[51] = ab0 + ab1; up[6528] = xy[51][0]; wp[6528] = f2bf(-xy[51][1]); mq[2] = *(const LAS f32x4*)(Mg + 3348);
            { const float br = betg[52]; ab0 = (f32x2){bf2f(*(const LAS bf16_t*)(lg + P5_VS + 14144 + c * 2)) * br, bf2f(*(const LAS bf16_t*)(lg + P5_KS + 14144 + c * 2)) * br * __expf(decg[52])}; ab1 = (f32x2){0.f, 0.f}; } ab0 -= mq[3][0] * xy[0]; ab1 -= mq[3][1] * xy[1]; ab0 -= mq[3][2] * xy[2]; ab1 -= mq[3][3] * xy[3]; mq[3] = *(const LAS f32x4*)(Mg + 3352);
            ab0 -= mq[4][0] * xy[4]; ab1 -= mq[4][1] * xy[5]; ab0 -= mq[4][2] * xy[6]; ab1 -= mq[4][3] * xy[7]; mq[4] = *(const LAS f32x4*)(Mg + 3356);
            ab0 -= mq[5][0] * xy[8]; ab1 -= mq[5][1] * xy[9]; ab0 -= mq[5][2] * xy[10]; ab1 -= mq[5][3] * xy[11]; mq[5] = *(const LAS f32x4*)(Mg + 3360);
            ab0 -= mq[0][0] * xy[12]; ab1 -= mq[0][1] * xy[13]; ab0 -= mq[0][2] * xy[14]; ab1 -= mq[0][3] * xy[15]; mq[0] = *(const LAS f32x4*)(Mg + 3364);
            ab0 -= mq[1][0] * xy[16]; ab1 -= mq[1][1] * xy[17]; ab0 -= mq[1][2] * xy[18]; ab1 -= mq[1][3] * xy[19]; mq[1] = *(const LAS f32x4*)(Mg + 3368);
            ab0 -= mq[2][0] * xy[20]; ab1 -= mq[2][1] * xy[21]; ab0 -= mq[2][2] * xy[22]; ab1 -= mq[2][3] * xy[23]; mq[2] = *(const LAS f32x4*)(Mg + 3372);
            ab0 -= mq[3][0] * xy[24]; ab1 -= mq[3][1] * xy[25]; ab0 -= mq[3][2] * xy[26]; ab1 -= mq[3][3] * xy[27]; mq[3] = *(const LAS f32x4*)(Mg + 3376);
            ab0 -= mq[4][0] * xy[28]; ab1 -= mq[4][1] * xy[29]; ab0 -= mq[4][2] * xy[30]; ab1 -= mq[4][3] * xy[31]; mq[4] = *(const LAS f32x4*)(Mg + 3392);
            ab0 -= mq[5][0] * xy[32]; ab1 -= mq[5][1] * xy[33]; ab0 -= mq[5][2] * xy[34]; ab1 -= mq[5][3] * xy[35]; mq[5] = *(const LAS f32x4*)(Mg + 3396);
            ab0 -= mq[0][0] * xy[36]; ab1 -= mq[0][1] * xy[37]; ab0 -= mq[0][2] * xy[38]; ab1 -= mq[0][3] * xy[39]; mq[0] = *(const LAS f32x4*)(Mg + 3400);
            ab0 -= mq[1][0] * xy[40]; ab1 -= mq[1][1] * xy[41]; ab0 -= mq[1][2] * xy[42]; ab1 -= mq[1][3] * xy[43]; mq[1] = *(const LAS f32x4*)(Mg + 3404);
            ab0 -= mq[2][0] * xy[44]; ab1 -= mq[2][1] * xy[45]; ab0 -= mq[2][2] * xy[46]; ab1 -= mq[2][3] * xy[47]; mq[2] = *(const LAS f32x4*)(Mg + 3408);
            ab0 -= mq[3][0] * xy[48]; ab1 -= mq[3][1] * xy[49]; ab0 -= mq[3][2] * xy[50]; ab1 -= mq[3][3] * xy[51]; xy[52] = ab0 + ab1; up[6656] = xy[52][0]; wp[6656] = f2bf(-xy[52][1]); mq[3] = *(const LAS f32x4*)(Mg + 3412);
            { const float br = betg[53]; ab0 = (f32x2){bf2f(*(const LAS bf16_t*)(lg + P5_VS + 14416 + c * 2)) * br, bf2f(*(const LAS bf16_t*)(lg + P5_KS + 14416 + c * 2)) * br * __expf(decg[53])}; ab1 = (f32x2){0.f, 0.f}; } ab0 -= mq[4][0] * xy[0]; ab1 -= mq[4][1] * xy[1]; ab0 -= mq[4][2] * xy[2]; ab1 -= mq[4][3] * xy[3]; mq[4] = *(const LAS f32x4*)(Mg + 3416);
            ab0 -= mq[5][0] * xy[4]; ab1 -= mq[5][1] * xy[5]; ab0 -= mq[5][2] * xy[6]; ab1 -= mq[5][3] * xy[7]; mq[5] = *(const LAS f32x4*)(Mg + 3420);
            ab0 -= mq[0][0] * xy[8]; ab1 -= mq[0][1] * xy[9]; ab0 -= mq[0][2] * xy[10]; ab1 -= mq[0][3] * xy[11]; mq[0] = *(const LAS f32x4*)(Mg + 3424);
            ab0 -= mq[1][0] * xy[12]; ab1 -= mq[1][1] * xy[13]; ab0 -= mq[1][2] * xy[14]; ab1 -= mq[1][3] * xy[15]; mq[1] = *(const LAS f32x4*)(Mg + 3428);
            ab0 -= mq[2][0] * xy[16]; ab1 -= mq[2][1] * xy[17]; ab0 -= mq[2][2] * xy[18]; ab1 -= mq[2][3] * xy[19]; mq[2] = *(const LAS f32x4*)(Mg + 3432);
            ab0 -= mq[3][0] * xy[20]; ab1 -= mq[3][1] * xy[21]; ab0 -= mq[3][2] * xy[22]; ab1 -= mq[3][3] * xy[23]; mq[3] = *(const LAS f32x4*)(Mg + 3436);
            ab0 -= mq[4][0] * xy[24]; ab1 -= mq[4][1] * xy[25]; ab0 -= mq[4][2] * xy[26]; ab1 -= mq[4][3] * xy[27]; mq[4] = *(const LAS f32x4*)(Mg + 3440);
            ab0 -= mq[5][0] * xy[28]; ab1 -= mq[5][1] * xy[29]; ab0 -= mq[5][2] * xy[30]; ab1 -= mq[5][3] * xy[31]; mq[5] = *(const LAS f32x4*)(Mg + 3444);
            ab0 -= mq[0][0] * xy[32]; ab1 -= mq[0][1] * xy[33]; ab0 -= mq[0][2] * xy[34]; ab1 -= mq[0][3] * xy[35]; mq[0] = *(const LAS f32x4*)(Mg + 3456);
            ab0 -= mq[1][0] * xy[36]; ab1 -= mq[1][1] * xy[37]; ab0 -= mq[1][2] * xy[38]; ab1 -= mq[1][3] * xy[39]; mq[1] = *(const LAS f32x4*)(Mg + 3460);
            ab0 -= mq[2][0] * xy[40]; ab1 -= mq[2][1] * xy[41]; ab0 -= mq[2][2] * xy[42]; ab1 -= mq[2][3] * xy[43]; mq[2] = *(const LAS f32x4*)(Mg + 3464);
            ab0 -= mq[3][0] * xy[44]; ab1 -= mq[3][1] * xy[45]; ab0 -= mq[3][2] * xy[46]; ab1 -= mq[3][3] * xy[47]; mq[3] = *(const LAS f32x4*)(Mg + 3468);
            ab0 -= mq[4][0] * xy[48]; ab1 -= mq[4][1] * xy[49]; ab0 -= mq[4][2] * xy[50]; ab1 -= mq[4][3] * xy[51]; mq[4] = *(const LAS f32x4*)(Mg + 3472);
            ab0 -= mq[5][0] * xy[52]; xy[53] = ab0 + ab1; up[6784] = xy[53][0]; wp[6784] = f2bf(-xy[53][1]); mq[5] = *(const LAS f32x4*)(Mg + 3476);
            { const float br = betg[54]; ab0 = (f32x2){bf2f(*(const LAS bf16_t*)(lg + P5_VS + 14688 + c * 2)) * br, bf2f(*(const LAS bf16_t*)(lg + P5_KS + 14688 + c * 2)) * br * __expf(decg[54])}; ab1 = (f32x2){0.f, 0.f}; } ab0 -= mq[0][0] * xy[0]; ab1 -= mq[0][1] * xy[1]; ab0 -= mq[0][2] * xy[2]; ab1 -= mq[0][3] * xy[3]; mq[0] = *(const LAS f32x4*)(Mg + 3480);
            ab0 -= mq[1][0] * xy[4]; ab1 -= mq[1][1] * xy[5]; ab0 -= mq[1][2] * xy[6]; ab1 -= mq[1][3] * xy[7]; mq[1] = *(const LAS f32x4*)(Mg + 3484);
            ab0 -= mq[2][0] * xy[8]; ab1 -= mq[2][1] * xy[9]; ab0 -= mq[2][2] * xy[10]; ab1 -= mq[2][3] * xy[11]; mq[2] = *(const LAS f32x4*)(Mg + 3488);
            ab0 -= mq[3][0] * xy[12]; ab1 -= mq[3][1] * xy[13]; ab0 -= mq[3][2] * xy[14]; ab1 -= mq[3][3] * xy[15]; mq[3] = *(const LAS f32x4*)(Mg + 3492);
            ab0 -= mq[4][0] * xy[16]; ab1 -= mq[4][1] * xy[17]; ab0 -= mq[4][2] * xy[18]; ab1 -= mq[4][3] * xy[19]; mq[4] = *(const LAS f32x4*)(Mg + 3496);
            ab0 -= mq[5][0] * xy[20]; ab1 -= mq[5][1] * xy[21]; ab0 -= mq[5][2] * xy[22]; ab1 -= mq[5][3] * xy[23]; mq[5] = *(const LAS f32x4*)(Mg + 3500);
            ab0 -= mq[0][0] * xy[24]; ab1 -= mq[0][1] * xy[25]; ab0 -= mq[0][2] * xy[26]; ab1 -= mq[0][3] * xy[27]; mq[0] = *(const LAS f32x4*)(Mg + 3504);
            ab0 -= mq[1][0] * xy[28]; ab1 -= mq[1][1] * xy[29]; ab0 -= mq[1][2] * xy[30]; ab1 -= mq[1][3] * xy[31]; mq[1] = *(const LAS f32x4*)(Mg + 3508);
            ab0 -= mq[2][0] * xy[32]; ab1 -= mq[2][1] * xy[33]; ab0 -= mq[2][2] * xy[34]; ab1 -= mq[2][3] * xy[35]; mq[2] = *(const LAS f32x4*)(Mg + 3520);
            ab0 -= mq[3][0] * xy[36]; ab1 -= mq[3][1] * xy[37]; ab0 -= mq[3][2] * xy[38]; ab1 -= mq[3][3] * xy[39]; mq[3] = *(const LAS f32x4*)(Mg + 3524);
            ab0 -= mq[4][0] * xy[40]; ab1 -= mq[4][1] * xy[41]; ab0 -= mq[4][2] * xy[42]; ab1 -= mq[4][3] * xy[43]; mq[4] = *(const LAS f32x4*)(Mg + 3528);
            ab0 -= mq[5][0] * xy[44]; ab1 -= mq[5][1] * xy[45]; ab0 -= mq[5][2] * xy[46]; ab1 -= mq[5][3] * xy[47]; mq[5] = *(const LAS f32x4*)(Mg + 3532);
            ab0 -= mq[0][0] * xy[48]; ab1 -= mq[0][1] * xy[49]; ab0 -= mq[0][2] * xy[50]; ab1 -= mq[0][3] * xy[51]; mq[0] = *(const LAS f32x4*)(Mg + 3536);
            ab0 -= mq[1][0] * xy[52]; ab1 -= mq[1][1] * xy[53]; xy[54] = ab0 + ab1; up[6912] = xy[54][0]; wp[6912] = f2bf(-xy[54][1]); mq[1] = *(const LAS f32x4*)(Mg + 3540);
            { const float br = betg[55]; ab0 = (f32x2){bf2f(*(const LAS bf16_t*)(lg + P5_VS + 14960 + c * 2)) * br, bf2f(*(const LAS bf16_t*)(lg + P5_KS + 14960 + c * 2)) * br * __expf(decg[55])}; ab1 = (f32x2){0.f, 0.f}; } ab0 -= mq[2][0] * xy[0]; ab1 -= mq[2][1] * xy[1]; ab0 -= mq[2][2] * xy[2]; ab1 -= mq[2][3] * xy[3]; mq[2] = *(const LAS f32x4*)(Mg + 3544);
            ab0 -= mq[3][0] * xy[4]; ab1 -= mq[3][1] * xy[5]; ab0 -= mq[3][2] * xy[6]; ab1 -= mq[3][3] * xy[7]; mq[3] = *(const LAS f32x4*)(Mg + 3548);
            ab0 -= mq[4][0] * xy[8]; ab1 -= mq[4][1] * xy[9]; ab0 -= mq[4][2] * xy[10]; ab1 -= mq[4][3] * xy[11]; mq[4] = *(const LAS f32x4*)(Mg + 3552);
            ab0 -= mq[5][0] * xy[12]; ab1 -= mq[5][1] * xy[13]; ab0 -= mq[5][2] * xy[14]; ab1 -= mq[5][3] * xy[15]; mq[5] = *(const LAS f32x4*)(Mg + 3556);
            ab0 -= mq[0][0] * xy[16]; ab1 -= mq[0][1] * xy[17]; ab0 -= mq[0][2] * xy[18]; ab1 -= mq[0][3] * xy[19]; mq[0] = *(const LAS f32x4*)(Mg + 3560);
            ab0 -= mq[1][0] * xy[20]; ab1 -= mq[1][1] * xy[21]; ab0 -= mq[1][2] * xy[22]; ab1 -= mq[1][3] * xy[23]; mq[1] = *(const LAS f32x4*)(Mg + 3564);
            ab0 -= mq[2][0] * xy[24]; ab1 -= mq[2][1] * xy[25]; ab0 -= mq[2][2] * xy[26]; ab1 -= mq[2][3] * xy[27]; mq[2] = *(const LAS f32x4*)(Mg + 3568);
            ab0 -= mq[3][0] * xy[28]; ab1 -= mq[3][1] * xy[29]; ab0 -= mq[3][2] * xy[30]; ab1 -= mq[3][3] * xy[31]; mq[3] = *(const LAS f32x4*)(Mg + 3572);
            ab0 -= mq[4][0] * xy[32]; ab1 -= mq[4][1] * xy[33]; ab0 -= mq[4][2] * xy[34]; ab1 -= mq[4][3] * xy[35]; mq[4] = *(const LAS f32x4*)(Mg + 3584);
            ab0 -= mq[5][0] * xy[36]; ab1 -= mq[5][1] * xy[37]; ab0 -= mq[5][2] * xy[38]; ab1 -= mq[5][3] * xy[39]; mq[5] = *(const LAS f32x4*)(Mg + 3588);
            ab0 -= mq[0][0] * xy[40]; ab1 -= mq[0][1] * xy[41]; ab0 -= mq[0][2] * xy[42]; ab1 -= mq[0][3] * xy[43]; mq[0] = *(const LAS f32x4*)(Mg + 3592);
            ab0 -= mq[1][0] * xy[44]; ab1 -= mq[1][1] * xy[45]; ab0 -= mq[1][2] * xy[46]; ab1 -= mq[1][3] * xy[47]; mq[1] = *(const LAS f32x4*)(Mg + 3596);
            ab0 -= mq[2][0] * xy[48]; ab1 -= mq[2][1] * xy[49]; ab0 -= mq[2][2] * xy[50]; ab1 -= mq[2][3] * xy[51]; mq[2] = *(const LAS f32x4*)(Mg + 3600);
            ab0 -= mq[3][0] * xy[52]; ab1 -= mq[3][1] * xy[53]; ab0 -= mq[3][2] * xy[54]; xy[55] = ab0 + ab1; up[7040] = xy[55][0]; wp[7040] = f2bf(-xy[55][1]); mq[3] = *(const LAS f32x4*)(Mg + 3604);
            { const float br = betg[56]; ab0 = (f32x2){bf2f(*(const LAS bf16_t*)(lg + P5_VS + 15232 + c * 2)) * br, bf2f(*(const LAS bf16_t*)(lg + P5_KS + 15232 + c * 2)) * br * __expf(decg[56])}; ab1 = (f32x2){0.f, 0.f}; } ab0 -= mq[4][0] * xy[0]; ab1 -= mq[4][1] * xy[1]; ab0 -= mq[4][2] * xy[2]; ab1 -= mq[4][3] * xy[3]; mq[4] = *(const LAS f32x4*)(Mg + 3608);
            ab0 -= mq[5][0] * xy[4]; ab1 -= mq[5][1] * xy[5]; ab0 -= mq[5][2] * xy[6]; ab1 -= mq[5][3] * xy[7]; mq[5] = *(const LAS f32x4*)(Mg + 3612);
            ab0 -= mq[0][0] * xy[8]; ab1 -= mq[0][1] * xy[9]; ab0 -= mq[0][2] * xy[10]; ab1 -= mq[0][3] * xy[11]; mq[0] = *(const LAS f32x4*)(Mg + 3616);
            ab0 -= mq[1][0] * xy[12]; ab1 -= mq[1][1] * xy[13]; ab0 -= mq[1][2] * xy[14]; ab1 -= mq[1][3] * xy[15]; mq[1] = *(const LAS f32x4*)(Mg + 3620);
            ab0 -= mq[2][0] * xy[16]; ab1 -= mq[2][1] * xy[17]; ab0 -= mq[2][2] * xy[18]; ab1 -= mq[2][3] * xy[19]; mq[2] = *(const LAS f32x4*)(Mg + 3624);
            ab0 -= mq[3][0] * xy[20]; ab1 -= mq[3][1] * xy[21]; ab0 -= mq[3][2] * xy[22]; ab1 -= mq[3][3] * xy[23]; mq[3] = *(const LAS f32x4*)(Mg + 3628);
            ab0 -= mq[4][0] * xy[24]; ab1 -= mq[4][1] * xy[25]; ab0 -= mq[4][2] * xy[26]; ab1 -= mq[4][3] * xy[27]; mq[4] = *(const LAS f32x4*)(Mg + 3632);
            ab0 -= mq[5][0] * xy[28]; ab1 -= mq[5][1] * xy[29]; ab0 -= mq[5][2] * xy[30]; ab1 -= mq[5][3] * xy[31]; mq[5] = *(const LAS f32x4*)(Mg + 3636);
            ab0 -= mq[0][0] * xy[32]; ab1 -= mq[0][1] * xy[33]; ab0 -= mq[0][2] * xy[34]; ab1 -= mq[0][3] * xy[35]; mq[0] = *(const LAS f32x4*)(Mg + 3648);
            ab0 -= mq[1][0] * xy[36]; ab1 -= mq[1][1] * xy[37]; ab0 -= mq[1][2] * xy[38]; ab1 -= mq[1][3] * xy[39]; mq[1] = *(const LAS f32x4*)(Mg + 3652);
            ab0 -= mq[2][0] * xy[40]; ab1 -= mq[2][1] * xy[41]; ab0 -= mq[2][2] * xy[42]; ab1 -= mq[2][3] * xy[43]; mq[2] = *(const LAS f32x4*)(Mg + 3656);
            ab0 -= mq[3][0] * xy[44]; ab1 -= mq[3][1] * xy[45]; ab0 -= mq[3][2] * xy[46]; ab1 -= mq[3][3] * xy[47]; mq[3] = *(const LAS f32x4*)(Mg + 3660);
            ab0 -= mq[4][0] * xy[48]; ab1 -= mq[4][1] * xy[49]; ab0 -= mq[4][2] * xy[50]; ab1 -= mq[4][3] * xy[51]; mq[4] = *(const LAS f32x4*)(Mg + 3664);
            ab0 -= mq[5][0] * xy[52]; ab1 -= mq[5][1] * xy[53]; ab0 -= mq[5][2] * xy[54]; ab1 -= mq[5][3] * xy[55]; xy[56] = ab0 + ab1; up[7168] = xy[56][0]; wp[7168] = f2bf(-xy[56][1]); mq[5] = *(const LAS f32x4*)(Mg + 3668);
            { const float br = betg[57]; ab0 = (f32x2){bf2f(*(const LAS bf16_t*)(lg + P5_VS + 15504 + c * 2)) * br, bf2f(*(const LAS bf16_t*)(lg + P5_KS + 15504 + c * 2)) * br * __expf(decg[57])}; ab1 = (f32x2){0.f, 0.f}; } ab0 -= mq[0][0] * xy[0]; ab1 -= mq[0][1] * xy[1]; ab0 -= mq[0][2] * xy[2]; ab1 -= mq[0][3] * xy[3]; mq[0] = *(const LAS f32x4*)(Mg + 3672);
            ab0 -= mq[1][0] * xy[4]; ab1 -= mq[1][1] * xy[5]; ab0 -= mq[1][2] * xy[6]; ab1 -= mq[1][3] * xy[7]; mq[1] = *(const LAS f32x4*)(Mg + 3676);
            ab0 -= mq[2][0] * xy[8]; ab1 -= mq[2][1] * xy[9]; ab0 -= mq[2][2] * xy[10]; ab1 -= mq[2][3] * xy[11]; mq[2] = *(const LAS f32x4*)(Mg + 3680);
            ab0 -= mq[3][0] * xy[12]; ab1 -= mq[3][1] * xy[13]; ab0 -= mq[3][2] * xy[14]; ab1 -= mq[3][3] * xy[15]; mq[3] = *(const LAS f32x4*)(Mg + 3684);
            ab0 -= mq[4][0] * xy[16]; ab1 -= mq[4][1] * xy[17]; ab0 -= mq[4][2] * xy[18]; ab1 -= mq[4][3] * xy[19]; mq[4] = *(const LAS f32x4*)(Mg + 3688);
            ab0 -= mq[5][0] * xy[20]; ab1 -= mq[5][1] * xy[21]; ab0 -= mq[5][2] * xy[22]; ab1 -= mq[5][3] * xy[23]; mq[5] = *(const LAS f32x4*)(Mg + 3692);
            ab0 -= mq[0][0] * xy[24]; ab1 -= mq[0][1] * xy[25]; ab0 -= mq[0][2] * xy[26]; ab1 -= mq[0][3] * xy[27]; mq[0] = *(const LAS f32x4*)(Mg + 3696);
            ab0 -= mq[1][0] * xy[28]; ab1 -= mq[1][1] * xy[29]; ab0 -= mq[1][2] * xy[30]; ab1 -= mq[1][3] * xy[31]; mq[1] = *(const LAS f32x4*)(Mg + 3700);
            ab0 -= mq[2][0] * xy[32]; ab1 -= mq[2][1] * xy[33]; ab0 -= mq[2][2] * xy[34]; ab1 -= mq[2][3] * xy[35]; mq[2] = *(const LAS f32x4*)(Mg + 3704);
            ab0 -= mq[3][0] * xy[36]; ab1 -= mq[3][1] * xy[37]; ab0 -= mq[3][2] * xy[38]; ab1 -= mq[3][3] * xy[39]; mq[3] = *(const LAS f32x4*)(Mg + 3712);
            ab0 -= mq[4][0] * xy[40]; ab1 -= mq[4][1] * xy[41]; ab0 -= mq[4][2] * xy[42]; ab1 -= mq[4][3] * xy[43]; mq[4] = *(const LAS f32x4*)(Mg + 3716);
            ab0 -= mq[5][0] * xy[44]; ab1 -= mq[5][1] * xy[45]; ab0 -= mq[5][2] * xy[46]; ab1 -= mq[5][3] * xy[47]; mq[5] = *(const LAS f32x4*)(Mg + 3720);
            ab0 -= mq[0][0] * xy[48]; ab1 -= mq[0][1] * xy[49]; ab0 -= mq[0][2] * xy[50]; ab1 -= mq[0][3] * xy[51]; mq[0] = *(const LAS f32x4*)(Mg + 3724);
            ab0 -= mq[1][0] * xy[52]; ab1 -= mq[1][1] * xy[53]; ab0 -= mq[1][2] * xy[54]; ab1 -= mq[1][3] * xy[55]; mq[1] = *(const LAS f32x4*)(Mg + 3728);
            ab0 -= mq[2][0] * xy[56]; xy[57] = ab0 + ab1; up[7296] = xy[57][0]; wp[7296] = f2bf(-xy[57][1]); mq[2] = *(const LAS f32x4*)(Mg + 3732);
            { const float br = betg[58]; ab0 = (f32x2){bf2f(*(const LAS bf16_t*)(lg + P5_VS + 15776 + c * 2)) * br, bf2f(*(const LAS bf16_t*)(lg + P5_KS + 15776 + c * 2)) * br * __expf(decg[58])}; ab1 = (f32x2){0.f, 0.f}; } ab0 -= mq[3][0] * xy[0]; ab1 -= mq[3][1] * xy[1]; ab0 -= mq[3][2] * xy[2]; ab1 -= mq[3][3] * xy[3]; mq[3] = *(const LAS f32x4*)(Mg + 3736);
            ab0 -= mq[4][0] * xy[4]; ab1 -= mq[4][1] * xy[5]; ab0 -= mq[4][2] * xy[6]; ab1 -= mq[4][3] * xy[7]; mq[4] = *(const LAS f32x4*)(Mg + 3740);
            ab0 -= mq[5][0] * xy[8]; ab1 -= mq[5][1] * xy[9]; ab0 -= mq[5][2] * xy[10]; ab1 -= mq[5][3] * xy[11]; mq[5] = *(const LAS f32x4*)(Mg + 3744);
            ab0 -= mq[0][0] * xy[12]; ab1 -= mq[0][1] * xy[13]; ab0 -= mq[0][2] * xy[14]; ab1 -= mq[0][3] * xy[15]; mq[0] = *(const LAS f32x4*)(Mg + 3748);
            ab0 -= mq[1][0] * xy[16]; ab1 -= mq[1][1] * xy[17]; ab0 -= mq[1][2] * xy[18]; ab1 -= mq[1][3] * xy[19]; mq[1] = *(const LAS f32x4*)(Mg + 3752);
            ab0 -= mq[2][0] * xy[20]; ab1 -= mq[2][1] * xy[21]; ab0 -= mq[2][2] * xy[22]; ab1 -= mq[2][3] * xy[23]; mq[2] = *(const LAS f32x4*)(Mg + 3756);
            ab0 -= mq[3][0] * xy[24]; ab1 -= mq[3][1] * xy[25]; ab0 -= mq[3][2] * xy[26]; ab1 -= mq[3][3] * xy[27]; mq[3] = *(const LAS f32x4*)(Mg + 3760);
            ab0 -= mq[4][0] * xy[28]; ab1 -= mq[4][1] * xy[29]; ab0 -= mq[4][2] * xy[30]; ab1 -= mq[4][3] * xy[31]; mq[4] = *(const LAS f32x4*)(Mg + 3764);
            ab0 -= mq[5][0] * xy[32]; ab1 -= mq[5][1] * xy[33]; ab0 -= mq[5][2] * xy[34]; ab1 -= mq[5][3] * xy[35]; mq[5] = *(const LAS f32x4*)(Mg + 3768);
            ab0 -= mq[0][0] * xy[36]; ab1 -= mq[0][1] * xy[37]; ab0 -= mq[0][2] * xy[38]; ab1 -= mq[0][3] * xy[39]; mq[0] = *(const LAS f32x4*)(Mg + 3776);
            ab0 -= mq[1][0] * xy[40]; ab1 -= mq[1][1] * xy[41]; ab0 -= mq[1][2] * xy[42]; ab1 -= mq[1][3] * xy[43]; mq[1] = *(const LAS f32x4*)(Mg + 3780);
            ab0 -= mq[2][0] * xy[44]; ab1 -= mq[2][1] * xy[45]; ab0 -= mq[2][2] * xy[46]; ab1 -= mq[2][3] * xy[47]; mq[2] = *(const LAS f32x4*)(Mg + 3784);
            ab0 -= mq[3][0] * xy[48]; ab1 -= mq[3][1] * xy[49]; ab0 -= mq[3][2] * xy[50]; ab1 -= mq[3][3] * xy[51]; mq[3] = *(const LAS f32x4*)(Mg + 3788);
            ab0 -= mq[4][0] * xy[52]; ab1 -= mq[4][1] * xy[53]; ab0 -= mq[4][2] * xy[54]; ab1 -= mq[4][3] * xy[55]; mq[4] = *(const LAS f32x4*)(Mg + 3792);
            ab0 -= mq[5][0] * xy[56]; ab1 -= mq[5][1] * xy[57]; xy[58] = ab0 + ab1; up[7424] = xy[58][0]; wp[7424] = f2bf(-xy[58][1]); mq[5] = *(const LAS f32x4*)(Mg + 3796);
            { const float br = betg[59]; ab0 = (f32x2){bf2f(*(const LAS bf16_t*)(lg + P5_VS + 16048 + c * 2)) * br, bf2f(*(const LAS bf16_t*)(lg + P5_KS + 16048 + c * 2)) * br * __expf(decg[59])}; ab1 = (f32x2){0.f, 0.f}; } ab0 -= mq[0][0] * xy[0]; ab1 -= mq[0][1] * xy[1]; ab0 -= mq[0][2] * xy[2]; ab1 -= mq[0][3] * xy[3]; mq[0] = *(const LAS f32x4*)(Mg + 3800);
            ab0 -= mq[1][0] * xy[4]; ab1 -= mq[1][1] * xy[5]; ab0 -= mq[1][2] * xy[6]; ab1 -= mq[1][3] * xy[7]; mq[1] = *(const LAS f32x4*)(Mg + 3804);
            ab0 -= mq[2][0] * xy[8]; ab1 -= mq[2][1] * xy[9]; ab0 -= mq[2][2] * xy[10]; ab1 -= mq[2][3] * xy[11]; mq[2] = *(const LAS f32x4*)(Mg + 3808);
            ab0 -= mq[3][0] * xy[12]; ab1 -= mq[3][1] * xy[13]; ab0 -= mq[3][2] * xy[14]; ab1 -= mq[3][3] * xy[15]; mq[3] = *(const LAS f32x4*)(Mg + 3812);
            ab0 -= mq[4][0] * xy[16]; ab1 -= mq[4][1] * xy[17]; ab0 -= mq[4][2] * xy[18]; ab1 -= mq[4][3] * xy[19]; mq[4] = *(const LAS f32x4*)(Mg + 3816);
            ab0 -= mq[5][0] * xy[20]; ab1 -= mq[5][1] * xy[21]; ab0 -= mq[5][2] * xy[22]; ab1 -= mq[5][3] * xy[23]; mq[5] = *(const LAS f32x4*)(Mg + 3820);
            ab0 -= mq[0][0] * xy[24]; ab1 -= mq[0][1] * xy[25]; ab0 -= mq[0][2] * xy[26]; ab1 -= mq[0][3] * xy[27]; mq[0] = *(const LAS f32x4*)(Mg + 3824);
            ab0 -= mq[1][0] * xy[28]; ab1 -= mq[1][1] * xy[29]; ab0 -= mq[1][2] * xy[30]; ab1 -= mq[1][3] * xy[31]; mq[1] = *(const LAS f32x4*)(Mg + 3828);
            ab0 -= mq[2][0] * xy[32]; ab1 -= mq[2][1] * xy[33]; ab0 -= mq[2][2] * xy[34]; ab1 -= mq[2][3] * xy[35]; mq[2] = *(const LAS f32x4*)(Mg + 3832);
            ab0 -= mq[3][0] * xy[36]; ab1 -= mq[3][1] * xy[37]; ab0 -= mq[3][2] * xy[38]; ab1 -= mq[3][3] * xy[39]; mq[3] = *(const LAS f32x4*)(Mg + 3840);
            ab0 -= mq[4][0] * xy[40]; ab1 -= mq[4][1] * xy[41]; ab0 -= mq[4][2] * xy[42]; ab1 -= mq[4][3] * xy[43]; mq[4] = *(const LAS f32x4*)(Mg + 3844);
            ab0 -= mq[5][0] * xy[44]; ab1 -= mq[5][1] * xy[45]; ab0 -= mq[5][2] * xy[46]; ab1 -= mq[5][3] * xy[47]; mq[5] = *(const LAS f32x4*)(Mg + 3848);
            ab0 -= mq[0][0] * xy[48]; ab1 -= mq[0][1] * xy[49]; ab0 -= mq[0][2] * xy[50]; ab1 -= mq[0][3] * xy[51]; mq[0] = *(const LAS f32x4*)(Mg + 3852);
            ab0 -= mq[1][0] * xy[52]; ab1 -= mq[1][1] * xy[53]; ab0 -= mq[1][2] * xy[54]; ab1 -= mq[1][3] * xy[55]; mq[1] = *(const LAS f32x4*)(Mg + 3856);
            ab0 -= mq[2][0] * xy[56]; ab1 -= mq[2][1] * xy[57]; ab0 -= mq[2][2] * xy[58]; xy[59] = ab0 + ab1; up[7552] = xy[59][0]; wp[7552] = f2bf(-xy[59][1]); mq[2] = *(const LAS f32x4*)(Mg + 3860);
            { const float br = betg[60]; ab0 = (f32x2){bf2f(*(const LAS bf16_t*)(lg + P5_VS + 16320 + c * 2)) * br, bf2f(*(const LAS bf16_t*)(lg + P5_KS + 16320 + c * 2)) * br * __expf(decg[60])}; ab1 = (f32x2){0.f, 0.f}; } ab0 -= mq[3][0] * xy[0]; ab1 -= mq[3][1] * xy[1]; ab0 -= mq[3][2] * xy[2]; ab1 -= mq[3][3] * xy[3]; mq[3] = *(const LAS f32x4*)(Mg + 3864);
            ab0 -= mq[4][0] * xy[4]; ab1 -= mq[4][1] * xy[5]; ab0 -= mq[4][2] * xy[6]; ab1 -= mq[4][3] * xy[7]; mq[4] = *(const LAS f32x4*)(Mg + 3868);
            ab0 -= mq[5][0] * xy[8]; ab1 -= mq[5][1] * xy[9]; ab0 -= mq[5][2] * xy[10]; ab1 -= mq[5][3] * xy[11]; mq[5] = *(const LAS f32x4*)(Mg + 3872);
            ab0 -= mq[0][0] * xy[12]; ab1 -= mq[0][1] * xy[13]; ab0 -= mq[0][2] * xy[14]; ab1 -= mq[0][3] * xy[15]; mq[0] = *(const LAS f32x4*)(Mg + 3876);
            ab0 -= mq[1][0] * xy[16]; ab1 -= mq[1][1] * xy[17]; ab0 -= mq[1][2] * xy[18]; ab1 -= mq[1][3] * xy[19]; mq[1] = *(const LAS f32x4*)(Mg + 3880);
            ab0 -= mq[2][0] * xy[20]; ab1 -= mq[2][1] * xy[21]; ab0 -= mq[2][2] * xy[22]; ab1 -= mq[2][3] * xy[23]; mq[2] = *(const LAS f32x4*)(Mg + 3884);
            ab0 -= mq[3][0] * xy[24]; ab1 -= mq[3][1] * xy[25]; ab0 -= mq[3][2] * xy[26]; ab1 -= mq[3][3] * xy[27]; mq[3] = *(const LAS f32x4*)(Mg + 3888);
            ab0 -= mq[4][0] * xy[28]; ab1 -= mq[4][1] * xy[29]; ab0 -= mq[4][2] * xy[30]; ab1 -= mq[4][3] * xy[31]; mq[4] = *(const LAS f32x4*)(Mg + 3892);
            ab0 -= mq[5][0] * xy[32]; ab1 -= mq[5][1] * xy[33]; ab0 -= mq[5][2] * xy[34]; ab1 -= mq[5][3] * xy[35]; mq[5] = *(const LAS f32x4*)(Mg + 3896);
            ab0 -= mq[0][0] * xy[36]; ab1 -= mq[0][1] * xy[37]; ab0 -= mq[0][2] * xy[38]; ab1 -= mq[0][3] * xy[39]; mq[0] = *(const LAS f32x4*)(Mg + 3904);
            ab0 -= mq[1][0] * xy[40]; ab1 -= mq[1][1] * xy[41]; ab0 -= mq[1][2] * xy[42]; ab1 -= mq[1][3] * xy[43]; mq[1] = *(const LAS f32x4*)(Mg + 3908);
            ab0 -= mq[2][0] * xy[44]; ab1 -= mq[2][1] * xy[45]; ab0 -= mq[2][2] * xy[46]; ab1 -= mq[2][3] * xy[47]; mq[2] = *(const LAS f32x4*)(Mg + 3912);
            ab0 -= mq[3][0] * xy[48]; ab1 -= mq[3][1] * xy[49]; ab0 -= mq[3][2] * xy[50]; ab1 -= mq[3][3] * xy[51]; mq[3] = *(const LAS f32x4*)(Mg + 3916);
            ab0 -= mq[4][0] * xy[52]; ab1 -= mq[4][1] * xy[53]; ab0 -= mq[4][2] * xy[54]; ab1 -= mq[4][3] * xy[55]; mq[4] = *(const LAS f32x4*)(Mg + 3920);
            ab0 -= mq[5][0] * xy[56]; ab1 -= mq[5][1] * xy[57]; ab0 -= mq[5][2] * xy[58]; ab1 -= mq[5][3] * xy[59]; xy[60] = ab0 + ab1; up[7680] = xy[60][0]; wp[7680] = f2bf(-xy[60][1]); mq[5] = *(const LAS f32x4*)(Mg + 3924);
            { const float br = betg[61]; ab0 = (f32x2){bf2f(*(const LAS bf16_t*)(lg + P5_VS + 16592 + c * 2)) * br, bf2f(*(const LAS bf16_t*)(lg + P5_KS + 16592 + c * 2)) * br * __expf(decg[61])}; ab1 = (f32x2){0.f, 0.f}; } ab0 -= mq[0][0] * xy[0]; ab1 -= mq[0][1] * xy[1]; ab0 -= mq[0][2] * xy[2]; ab1 -= mq[0][3] * xy[3]; mq[0] = *(const LAS f32x4*)(Mg + 3928);
            ab0 -= mq[1][0] * xy[4]; ab1 -= mq[1][1] * xy[5]; ab0 -= mq[1][2] * xy[6]; ab1 -= mq[1][3] * xy[7]; mq[1] = *(const LAS f32x4*)(Mg + 3932);
            ab0 -= mq[2][0] * xy[8]; ab1 -= mq[2][1] * xy[9]; ab0 -= mq[2][2] * xy[10]; ab1 -= mq[2][3] * xy[11]; mq[2] = *(const LAS f32x4*)(Mg + 3936);
            ab0 -= mq[3][0] * xy[12]; ab1 -= mq[3][1] * xy[13]; ab0 -= mq[3][2] * xy[14]; ab1 -= mq[3][3] * xy[15]; mq[3] = *(const LAS f32x4*)(Mg + 3940);
            ab0 -= mq[4][0] * xy[16]; ab1 -= mq[4][1] * xy[17]; ab0 -= mq[4][2] * xy[18]; ab1 -= mq[4][3] * xy[19]; mq[4] = *(const LAS f32x4*)(Mg + 3944);
            ab0 -= mq[5][0] * xy[20]; ab1 -= mq[5][1] * xy[21]; ab0 -= mq[5][2] * xy[22]; ab1 -= mq[5][3] * xy[23]; mq[5] = *(const LAS f32x4*)(Mg + 3948);
            ab0 -= mq[0][0] * xy[24]; ab1 -= mq[0][1] * xy[25]; ab0 -= mq[0][2] * xy[26]; ab1 -= mq[0][3] * xy[27]; mq[0] = *(const LAS f32x4*)(Mg + 3952);
            ab0 -= mq[1][0] * xy[28]; ab1 -= mq[1][1] * xy[29]; ab0 -= mq[1][2] * xy[30]; ab1 -= mq[1][3] * xy[31]; mq[1] = *(const LAS f32x4*)(Mg + 3956);
            ab0 -= mq[2][0] * xy[32]; ab1 -= mq[2][1] * xy[33]; ab0 -= mq[2][2] * xy[34]; ab1 -= mq[2][3] * xy[35]; mq[2] = *(const LAS f32x4*)(Mg + 3960);
            ab0 -= mq[3][0] * xy[36]; ab1 -= mq[3][1] * xy[37]; ab0 -= mq[3][2] * xy[38]; ab1 -= mq[3][3] * xy[39]; mq[3] = *(const LAS f32x4*)(Mg + 3964);
            ab0 -= mq[4][0] * xy[40]; ab1 -= mq[4][1] * xy[41]; ab0 -= mq[4][2] * xy[42]; ab1 -= mq[4][3] * xy[43]; mq[4] = *(const LAS f32x4*)(Mg + 3968);
            ab0 -= mq[5][0] * xy[44]; ab1 -= mq[5][1] * xy[45]; ab0 -= mq[5][2] * xy[46]; ab1 -= mq[5][3] * xy[47]; mq[5] = *(const LAS f32x4*)(Mg + 3972);
            ab0 -= mq[0][0] * xy[48]; ab1 -= mq[0][1] * xy[49]; ab0 -= mq[0][2] * xy[50]; ab1 -= mq[0][3] * xy[51]; mq[0] = *(const LAS f32x4*)(Mg + 3976);
            ab0 -= mq[1][0] * xy[52]; ab1 -= mq[1][1] * xy[53]; ab0 -= mq[1][2] * xy[54]; ab1 -= mq[1][3] * xy[55]; mq[1] = *(const LAS f32x4*)(Mg + 3980);
            ab0 -= mq[2][0] * xy[56]; ab1 -= mq[2][1] * xy[57]; ab0 -= mq[2][2] * xy[58]; ab1 -= mq[2][3] * xy[59]; mq[2] = *(const LAS f32x4*)(Mg + 3984);
            ab0 -= mq[3][0] * xy[60]; xy[61] = ab0 + ab1; up[7808] = xy[61][0]; wp[7808] = f2bf(-xy[61][1]); mq[3] = *(const LAS f32x4*)(Mg + 3988);
            { const float br = betg[62]; ab0 = (f32x2){bf2f(*(const LAS bf16_t*)(lg + P5_VS + 16864 + c * 2)) * br, bf2f(*(const LAS bf16_t*)(lg + P5_KS + 16864 + c * 2)) * br * __expf(decg[62])}; ab1 = (f32x2){0.f, 0.f}; } ab0 -= mq[4][0] * xy[0]; ab1 -= mq[4][1] * xy[1]; ab0 -= mq[4][2] * xy[2]; ab1 -= mq[4][3] * xy[3]; mq[4] = *(const LAS f32x4*)(Mg + 3992);
            ab0 -= mq[5][0] * xy[4]; ab1 -= mq[5][1] * xy[5]; ab0 -= mq[5][2] * xy[6]; ab1 -= mq[5][3] * xy[7]; mq[5] = *(const LAS f32x4*)(Mg + 3996);
            ab0 -= mq[0][0] * xy[8]; ab1 -= mq[0][1] * xy[9]; ab0 -= mq[0][2] * xy[10]; ab1 -= mq[0][3] * xy[11]; mq[0] = *(const LAS f32x4*)(Mg + 4000);
            ab0 -= mq[1][0] * xy[12]; ab1 -= mq[1][1] * xy[13]; ab0 -= mq[1][2] * xy[14]; ab1 -= mq[1][3] * xy[15]; mq[1] = *(const LAS f32x4*)(Mg + 4004);
            ab0 -= mq[2][0] * xy[16]; ab1 -= mq[2][1] * xy[17]; ab0 -= mq[2][2] * xy[18]; ab1 -= mq[2][3] * xy[19]; mq[2] = *(const LAS f32x4*)(Mg + 4008);
            ab0 -= mq[3][0] * xy[20]; ab1 -= mq[3][1] * xy[21]; ab0 -= mq[3][2] * xy[22]; ab1 -= mq[3][3] * xy[23]; mq[3] = *(const LAS f32x4*)(Mg + 4012);
            ab0 -= mq[4][0] * xy[24]; ab1 -= mq[4][1] * xy[25]; ab0 -= mq[4][2] * xy[26]; ab1 -= mq[4][3] * xy[27]; mq[4] = *(const LAS f32x4*)(Mg + 4016);
            ab0 -= mq[5][0] * xy[28]; ab1 -= mq[5][1] * xy[29]; ab0 -= mq[5][2] * xy[30]; ab1 -= mq[5][3] * xy[31]; mq[5] = *(const LAS f32x4*)(Mg + 4020);
            ab0 -= mq[0][0] * xy[32]; ab1 -= mq[0][1] * xy[33]; ab0 -= mq[0][2] * xy[34]; ab1 -= mq[0][3] * xy[35]; mq[0] = *(const LAS f32x4*)(Mg + 4024);
            ab0 -= mq[1][0] * xy[36]; ab1 -= mq[1][1] * xy[37]; ab0 -= mq[1][2] * xy[38]; ab1 -= mq[1][3] * xy[39]; mq[1] = *(const LAS f32x4*)(Mg + 4028);
            ab0 -= mq[2][0] * xy[40]; ab1 -= mq[2][1] * xy[41]; ab0 -= mq[2][2] * xy[42]; ab1 -= mq[2][3] * xy[43]; mq[2] = *(const LAS f32x4*)(Mg + 4032);
            ab0 -= mq[3][0] * xy[44]; ab1 -= mq[3][1] * xy[45]; ab0 -= mq[3][2] * xy[46]; ab1 -= mq[3][3] * xy[47]; mq[3] = *(const LAS f32x4*)(Mg + 4036);
            ab0 -= mq[4][0] * xy[48]; ab1 -= mq[4][1] * xy[49]; ab0 -= mq[4][2] * xy[50]; ab1 -= mq[4][3] * xy[51]; mq[4] = *(const LAS f32x4*)(Mg + 4040);
            ab0 -= mq[5][0] * xy[52]; ab1 -= mq[5][1] * xy[53]; ab0 -= mq[5][2] * xy[54]; ab1 -= mq[5][3] * xy[55]; mq[5] = *(const LAS f32x4*)(Mg + 4044);
            ab0 -= mq[0][0] * xy[56]; ab1 -= mq[0][1] * xy[57]; ab0 -= mq[0][2] * xy[58]; ab1 -= mq[0][3] * xy[59]; mq[0] = *(const LAS f32x4*)(Mg + 4048);
            ab0 -= mq[1][0] * xy[60]; ab1 -= mq[1][1] * xy[61]; xy[62] = ab0 + ab1; up[7936] = xy[62][0]; wp[7936] = f2bf(-xy[62][1]); mq[1] = *(const LAS f32x4*)(Mg + 4052);
            { const float br = betg[63]; ab0 = (f32x2){bf2f(*(const LAS bf16_t*)(lg + P5_VS + 17136 + c * 2)) * br, bf2f(*(const LAS bf16_t*)(lg + P5_KS + 17136 + c * 2)) * br * __expf(decg[63])}; ab1 = (f32x2){0.f, 0.f}; } ab0 -= mq[2][0] * xy[0]; ab1 -= mq[2][1] * xy[1]; ab0 -= mq[2][2] * xy[2]; ab1 -= mq[2][3] * xy[3]; mq[2] = *(const LAS f32x4*)(Mg + 4056);
            ab0 -= mq[3][0] * xy[4]; ab1 -= mq[3][1] * xy[5]; ab0 -= mq[3][2] * xy[6]; ab1 -= mq[3][3] * xy[7]; mq[3] = *(const LAS f32x4*)(Mg + 4060);
            ab0 -= mq[4][0] * xy[8]; ab1 -= mq[4][1] * xy[9]; ab0 -= mq[4][2] * xy[10]; ab1 -= mq[4][3] * xy[11]; mq[4] = *(const LAS f32x4*)(Mg + 4064);
            ab0 -= mq[5][0] * xy[12]; ab1 -= mq[5][1] * xy[13]; ab0 -= mq[5][2] * xy[14]; ab1 -= mq[5][3] * xy[15]; mq[5] = *(const LAS f32x4*)(Mg + 4068);
            ab0 -= mq[0][0] * xy[16]; ab1 -= mq[0][1] * xy[17]; ab0 -= mq[0][2] * xy[18]; ab1 -= mq[0][3] * xy[19]; mq[0] = *(const LAS f32x4*)(Mg + 4072);
            ab0 -= mq[1][0] * xy[20]; ab1 -= mq[1][1] * xy[21]; ab0 -= mq[1][2] * xy[22]; ab1 -= mq[1][3] * xy[23]; mq[1] = *(const LAS f32x4*)(Mg + 4076);
            ab0 -= mq[2][0] * xy[24]; ab1 -= mq[2][1] * xy[25]; ab0 -= mq[2][2] * xy[26]; ab1 -= mq[2][3] * xy[27]; mq[2] = *(const LAS f32x4*)(Mg + 4080);
            ab0 -= mq[3][0] * xy[28]; ab1 -= mq[3][1] * xy[29]; ab0 -= mq[3][2] * xy[30]; ab1 -= mq[3][3] * xy[31]; mq[3] = *(const LAS f32x4*)(Mg + 4084);
            ab0 -= mq[4][0] * xy[32]; ab1 -= mq[4][1] * xy[33]; ab0 -= mq[4][2] * xy[34]; ab1 -= mq[4][3] * xy[35]; mq[4] = *(const LAS f32x4*)(Mg + 4088);
            ab0 -= mq[5][0] * xy[36]; ab1 -= mq[5][1] * xy[37]; ab0 -= mq[5][2] * xy[38]; ab1 -= mq[5][3] * xy[39]; mq[5] = *(const LAS f32x4*)(Mg + 4092);
            ab0 -= mq[0][0] * xy[40]; ab1 -= mq[0][1] * xy[41]; ab0 -= mq[0][2] * xy[42]; ab1 -= mq[0][3] * xy[43];
            ab0 -= mq[1][0] * xy[44]; ab1 -= mq[1][1] * xy[45]; ab0 -= mq[1][2] * xy[46]; ab1 -= mq[1][3] * xy[47];
            ab0 -= mq[2][0] * xy[48]; ab1 -= mq[2][1] * xy[49]; ab0 -= mq[2][2] * xy[50]; ab1 -= mq[2][3] * xy[51];
            ab0 -= mq[3][0] * xy[52]; ab1 -= mq[3][1] * xy[53]; ab0 -= mq[3][2] * xy[54]; ab1 -= mq[3][3] * xy[55];
            ab0 -= mq[4][0] * xy[56]; ab1 -= mq[4][1] * xy[57]; ab0 -= mq[4][2] * xy[58]; ab1 -= mq[4][3] * xy[59];
            ab0 -= mq[5][0] * xy[60]; ab1 -= mq[5][1] * xy[61]; ab0 -= mq[5][2] * xy[62]; xy[63] = ab0 + ab1; up[8064] = xy[63][0]; wp[8064] = f2bf(-xy[63][1]);
        } else {
            const int g2 = (w8 - 4) >> 1, tt = ((w8 - 4) & 1) * 64 + lane; const int item2 = it0 + g2;
            LAS unsigned char* lg = lds0 + g2 * P5_GRP; LAS float* decg = (LAS float*)(lg + P5_DEC);
            const float lastg = decg[63];
#pragma unroll
            for (int i = 0; i < 8; ++i) { const int vid = tt + 128 * i, r = vid >> 4, d0 = (vid & 15) * 8; float f[8]; unpack8(*(const LAS u32x4*)(lg + P5_QS + r * 272 + d0 * 2), f);
                const float e = scale * __expf(decg[r]);
#pragma unroll
                for (int q = 0; q < 8; ++q) f[q] *= e;
                *(u32x4*)(qd + (size_t)item2 * 8192 + r * 128 + d0) = pack8(f); }
#pragma unroll
            for (int i = 0; i < 8; ++i) { const int vid = tt + 128 * i, d = vid >> 3, rg = (vid & 7) * 8; float f[8];
#pragma unroll
                for (int q = 0; q < 8; ++q) f[q] = bf2f(*(const LAS bf16_t*)(lg + P5_KS + (rg + q) * 272 + d * 2)) * __expf(lastg - decg[rg + q]);
                *(u32x4*)(kt + (size_t)item2 * 8192 + d * 64 + rg) = pack8(f); }
            if (tt == 0) cdv[item2] = __expf(lastg);
        }
    }
    __syncthreads();
}

constexpr int SB_WD = 0, SB_QD = 17408, SB_KT = 34816, SB_QK = 53248, SB_UB = 62464, SB_SIZE = 66560;
constexpr int SC_ST = 2 * SB_SIZE, SC_UT = SC_ST + 4352, SC_END = SC_UT + 2304;
static_assert(SC_END <= LDS_BYTES, "lds");
__device__ __forceinline__ void scan_phase(const Params& p, int bid, int nblk, LAS unsigned char* lds) {
    const int tid = threadIdx.x, lane = tid & 63, wid = __builtin_amdgcn_readfirstlane(tid >> 6), fr = lane & 15, fq = lane >> 4;
    const bf16_t* wdc = (const bf16_t*)(p.ws + WS_WDC); const bf16_t* qd = (const bf16_t*)(p.ws + WS_QD); const bf16_t* kt = (const bf16_t*)(p.ws + WS_KT); const bf16_t* qk = (const bf16_t*)(p.ws + WS_QK);
    const float* cdv = (const float*)(p.ws + WS_CD); const float* ub = p.out + OS_UB; float* obuf = p.out + OS_O;
    for (int item = bid; item < 256; item += nblk) {
        const int xcd = item & 7, iq = item >> 3, bh = xcd * 4 + (iq >> 3), sl = iq & 7, h = bh & 7, b = bh >> 3;
        u32x4 r_wd[2], r_qd[2], r_kt[2], r_qk, r_ub;
        auto gload = [&](int n) {
            const size_t it = (size_t)(bh * 32 + n);
#pragma unroll
            for (int i = 0; i < 2; ++i) { const int ch = tid + 512 * i; r_wd[i] = *(const u32x4*)(wdc + it * 8192 + ch * 8); r_qd[i] = *(const u32x4*)(qd + it * 8192 + ch * 8); r_kt[i] = *(const u32x4*)(kt + it * 8192 + ch * 8); }
            r_qk = *(const u32x4*)(qk + it * 4096 + tid * 8);
            if (tid < 256) r_ub = *(const u32x4*)(ub + it * 8192 + (tid >> 2) * 128 + sl * 16 + (tid & 3) * 4);
        };
        auto lstore = [&](int buf) {
            LAS unsigned char* B = lds + buf * SB_SIZE;
#pragma unroll
            for (int i = 0; i < 2; ++i) { const int ch = tid + 512 * i; const int r = ch >> 4, c8 = (ch & 15) * 8; *(LAS u32x4*)(B + SB_WD + r * 272 + c8 * 2) = r_wd[i]; *(LAS u32x4*)(B + SB_QD + r * 272 + c8 * 2) = r_qd[i];
                const int d = ch >> 3, t8 = (ch & 7) * 8; *(LAS u32x4*)(B + SB_KT + d * 144 + t8 * 2) = r_kt[i]; }
            { const int r = tid >> 3, s8 = (tid & 7) * 8; *(LAS u32x4*)(B + SB_QK + r * 144 + s8 * 2) = r_qk; }
            if (tid < 256) *(LAS u32x4*)(B + SB_UB + (tid >> 2) * 64 + (tid & 3) * 16) = r_ub;
        };
        __syncthreads();
        gload(0);
        for (int i = tid; i < 4352 / 4; i += 512) *(LAS unsigned*)(lds + SC_ST + i * 4) = 0u;
        lstore(0);
        f32x4 sacc = (f32x4){0.f, 0.f, 0.f, 0.f};
        __syncthreads();
        for (int n = 0; n < 32; ++n) {
            const int cur = n & 1; LAS unsigned char* B = lds + cur * SB_SIZE;
            if (n + 1 < 32) gload(n + 1);
            const float cd = cdv[bh * 32 + n];
            f32x4 acc;
            const int tw = wid & 3;
            if (wid < 4) {
#pragma unroll
                for (int j = 0; j < 4; ++j) acc[j] = *(const LAS float*)(B + SB_UB + ((tw * 16 + fq * 4 + j) * 16 + fr) * 4);
#pragma unroll
                for (int kk = 0; kk < 4; ++kk) { const bf16x8 a = *(const LAS bf16x8*)(B + SB_WD + (tw * 16 + fr) * 272 + (kk * 32 + fq * 8) * 2); const bf16x8 bb = *(const LAS bf16x8*)(lds + SC_ST + fr * 272 + (kk * 32 + fq * 8) * 2);
                    acc = __builtin_amdgcn_mfma_f32_16x16x32_bf16(a, bb, acc, 0, 0, 0); }
                u32x2 w; w.x = pk2(acc[0], acc[1]); w.y = pk2(acc[2], acc[3]);
                *(LAS u32x2*)(lds + SC_UT + fr * 144 + (tw * 16 + fq * 4) * 2) = w;
            } else {
                acc = (f32x4){0.f, 0.f, 0.f, 0.f};
#pragma unroll
                for (int kk = 0; kk < 4; ++kk) { const bf16x8 a = *(const LAS bf16x8*)(B + SB_QD + (tw * 16 + fr) * 272 + (kk * 32 + fq * 8) * 2); const bf16x8 bb = *(const LAS bf16x8*)(lds + SC_ST + fr * 272 + (kk * 32 + fq * 8) * 2);
                    acc = __builtin_amdgcn_mfma_f32_16x16x32_bf16(a, bb, acc, 0, 0, 0); }
            }
            __syncthreads();
            sacc *= cd;
#pragma unroll
            for (int kk = 0; kk < 2; ++kk) { const bf16x8 a = *(const LAS bf16x8*)(B + SB_KT + (wid * 16 + fr) * 144 + (kk * 32 + fq * 8) * 2); const bf16x8 bb = *(const LAS bf16x8*)(lds + SC_UT + fr * 144 + (kk * 32 + fq * 8) * 2);
                sacc = __builtin_amdgcn_mfma_f32_16x16x32_bf16(a, bb, sacc, 0, 0, 0); }
            if (wid >= 4) {
#pragma unroll
                for (int kk = 0; kk < 2; ++kk) { const bf16x8 a = *(const LAS bf16x8*)(B + SB_QK + (tw * 16 + fr) * 144 + (kk * 32 + fq * 8) * 2); const bf16x8 bb = *(const LAS bf16x8*)(lds + SC_UT + fr * 144 + (kk * 32 + fq * 8) * 2);
                    acc = __builtin_amdgcn_mfma_f32_16x16x32_bf16(a, bb, acc, 0, 0, 0); }
#pragma unroll
                for (int j = 0; j < 4; ++j) obuf[(size_t)(b * 2048 + n * 64 + tw * 16 + fq * 4 + j) * 1024 + h * 128 + sl * 16 + fr] = acc[j];
            }
            { u32x2 w; w.x = pk2(sacc[0], sacc[1]); w.y = pk2(sacc[2], sacc[3]); *(LAS u32x2*)(lds + SC_ST + fr * 272 + (wid * 16 + fq * 4) * 2) = w; }
            if (n + 1 < 32) lstore(cur ^ 1);
            __syncthreads();
        }
#pragma unroll
        for (int j = 0; j < 4; ++j) p.out[O_DP + ((size_t)bh * 128 + wid * 16 + fq * 4 + j) * 128 + sl * 16 + fr] = sacc[j];
    }
    __syncthreads();
    {
        const bf16_t* qn = (const bf16_t*)(p.ws + WS_QN); const bf16_t* kn = (const bf16_t*)(p.ws + WS_KN); const bf16_t* vv = (const bf16_t*)(p.ws + WS_VV);
        const float* gbuf = (const float*)(p.ws + WS_G); const float* bbuf = (const float*)(p.ws + WS_BETA);
        const int grp = tid >> 8, w4 = __builtin_amdgcn_readfirstlane(tid >> 6) & 3, j = w4 * 32 + (lane & 31), half = lane >> 5;
        LAS float* qs = (LAS float*)lds + grp * 1024;
        LAS float* ks = qs + 512;
        const float scale = 0.08838834764831845f;
        for (int it0 = bid * 2; it0 < 1024; it0 += nblk * 2) {
            const int item = it0 + grp, sb = item >> 3, h = item & 7;
            __syncthreads();
#pragma unroll
            for (int i = 0; i < 4; ++i) { const int idx = (tid & 255) + 256 * i, tk = idx >> 7, c = idx & 127, t = tk & 3; const size_t go = (size_t)(TP + sb * 4 + t) * 1024 + h * 128 + c;
                if (tk < 4) qs[t * 128 + c] = bf2f(qn[go]); else ks[t * 128 + c] = bf2f(kn[go]); }
            float S[64];
            const float* s0 = p.in[4] + (size_t)item * 16384 + (size_t)half * 64 * 128 + j;
#pragma unroll
            for (int i = 0; i < 64; ++i) S[i] = __builtin_nontemporal_load(s0 + i * 128);
            __syncthreads();
#pragma unroll 1
            for (int t = 0; t < 4; ++t) {
                const int row = TP + sb * 4 + t;
                const float a = __expf(gbuf[row * 8 + h]), be = bbuf[row * 8 + h], v = bf2f(vv[(size_t)row * 1024 + h * 128 + j]);
                float kS = 0.f;
#pragma unroll
                for (int i4 = 0; i4 < 16; ++i4) { const f32x4 k4 = *(const LAS f32x4*)(ks + t * 128 + half * 64 + i4 * 4); kS += k4[0] * S[i4 * 4] + k4[1] * S[i4 * 4 + 1] + k4[2] * S[i4 * 4 + 2] + k4[3] * S[i4 * 4 + 3]; }
                kS += __shfl_xor(kS, 32);
                const float coef = be * (v - a * kS);
                float o = 0.f;
#pragma unroll
                for (int i4 = 0; i4 < 16; ++i4) { const f32x4 k4 = *(const LAS f32x4*)(ks + t * 128 + half * 64 + i4 * 4); const f32x4 q4 = *(const LAS f32x4*)(qs + t * 128 + half * 64 + i4 * 4);
#pragma unroll
                    for (int q = 0; q < 4; ++q) { S[i4 * 4 + q] = a * S[i4 * 4 + q] + k4[q] * coef; o += q4[q] * S[i4 * 4 + q]; } }
                o += __shfl_xor(o, 32);
                if (half == 0) obuf[(size_t)row * 1024 + h * 128 + j] = o * scale;
            }
            float* so = p.out + O_DS + (size_t)item * 16384 + (size_t)half * 64 * 128 + j;
#pragma unroll
            for (int i = 0; i < 64; ++i) so[i * 128] = S[i];
        }
    }
    __syncthreads();
}

__device__ __forceinline__ void onorm_phase(const Params& p, int bid, int nblk) {
    const int lane = threadIdx.x & 63, wid = __builtin_amdgcn_readfirstlane(threadIdx.x >> 6);
    const float* obuf = p.out + OS_O; const bf16_t* proj = (const bf16_t*)(p.ws + WS_PROJ); bf16_t* acat = (bf16_t*)(p.ws + WS_U); const float* og = p.in[14];
    for (int row = bid * 8 + wid; row < TT; row += nblk * 8) {
        const int c0 = lane * 16; float o[16], z[16], g[16];
#pragma unroll
        for (int i = 0; i < 4; ++i) { const f32x4 v = *(const f32x4*)(obuf + (size_t)row * 1024 + c0 + i * 4); o[i * 4] = v[0]; o[i * 4 + 1] = v[1]; o[i * 4 + 2] = v[2]; o[i * 4 + 3] = v[3];
            const f32x4 gg = *(const f32x4*)(og + (c0 & 127) + i * 4); g[i * 4] = gg[0]; g[i * 4 + 1] = gg[1]; g[i * 4 + 2] = gg[2]; g[i * 4 + 3] = gg[3]; }
        unpack8(*(const u32x4*)(proj + (size_t)row * NPROJ + C_Z + c0), z); unpack8(*(const u32x4*)(proj + (size_t)row * NPROJ + C_Z + c0 + 8), z + 8);
        float ss = 0.f;
#pragma unroll
        for (int i = 0; i < 16; ++i) ss += o[i] * o[i];
        ss += __shfl_xor(ss, 1); ss += __shfl_xor(ss, 2); ss += __shfl_xor(ss, 4);
        const float rstd = rsqrtf(ss * (1.0f / 128.0f) + EPS);
#pragma unroll
        for (int i = 0; i < 16; ++i) o[i] = o[i] * rstd * g[i] * siluf_(z[i]);
        *(u32x4*)(acat + (size_t)row * DM + c0) = pack8(o); *(u32x4*)(acat + (size_t)row * DM + c0 + 8) = pack8(o + 8);
    }
}

#define XB_TMO      128
#define XB_XCNT(j)  (256  + 64 * (j))
#define XB_XSUB(j)  (1280 + 64 * (j))
#define XB_XGEN(j)  (2304 + 64 * (j))
#define XB_TOP      3328
#define XB_TOPGEN   3392
#define XCD_BAR_WORDS 3456
#define XB_SPIN_CAP (1u << 18)

__device__ __forceinline__ unsigned xb_ld(unsigned* p)              { return __hip_atomic_load(p, __ATOMIC_RELAXED, __HIP_MEMORY_SCOPE_AGENT); }
__device__ __forceinline__ unsigned xb_add(unsigned* p, unsigned v) { return __hip_atomic_fetch_add(p, v, __ATOMIC_RELAXED, __HIP_MEMORY_SCOPE_AGENT); }
__device__ __forceinline__ unsigned xb_xcc_id() { return (unsigned)__builtin_amdgcn_s_getreg((3 << 11) | 20) & 0xFu; }
#define XB_SPIN(cond, bar) do { unsigned _sp = 0; while (cond) { __builtin_amdgcn_s_sleep(1); \
    if ((++_sp & 255u) == 0u) { if (xb_ld(&(bar)[XB_TMO])) break; if (_sp > XB_SPIN_CAP) { atomicAdd(&(bar)[XB_TMO], 1u); break; } } } } while (0)

struct XcdBarrier {
    unsigned* bar; unsigned x;
    volatile LAS unsigned* st;
};

__device__ __forceinline__ XcdBarrier xcd_barrier_post(unsigned* bar, volatile LAS unsigned* st) {
    XcdBarrier b; b.bar = bar; b.x = xb_xcc_id(); b.st = st;
    if (threadIdx.x == 0) (void)xb_add(&bar[XB_XCNT(b.x)], 1u);
    return b;
}
__device__ __forceinline__ void xcd_barrier_complete(unsigned* bar, unsigned x, unsigned& nloc, unsigned& nx) {
    const unsigned G = gridDim.x * gridDim.y * gridDim.z;
    unsigned sum, cnt, mine, sp = 0u;
    for (;;) {
        sum = 0u; cnt = 0u; mine = 0u;
#pragma unroll
        for (unsigned j = 0; j < 16; ++j) { const unsigned c = xb_ld(&bar[XB_XCNT(j)]); sum += c; cnt += (c > 0u) ? 1u : 0u; mine = (j == x) ? c : mine; }
        if (sum == G) break;
        __builtin_amdgcn_s_sleep(1);
        if ((++sp & 255u) == 0u) { if (xb_ld(&bar[XB_TMO])) break; if (sp > XB_SPIN_CAP) { atomicAdd(&bar[XB_TMO], 1u); break; } }
    }
    nloc = mine > 0u ? mine : 1u; nx = cnt > 0u ? cnt : 1u;
}

__device__ __forceinline__ void xcd_barrier(const XcdBarrier& b) {
    asm volatile("s_waitcnt vmcnt(0)" ::: "memory");
    __syncthreads();
    if (threadIdx.x == 0) {
        unsigned* bar = b.bar;
        __builtin_amdgcn_s_waitcnt(0);
        unsigned nloc = b.st[0], nx = b.st[1];
        if (nloc == 0u) { xcd_barrier_complete(bar, b.x, nloc, nx); b.st[0] = nloc; b.st[1] = nx; }
        const unsigned old = xb_add(&bar[XB_XSUB(b.x)], 1u);
        const unsigned gen = old / nloc;
        if (old + 1u == (gen + 1u) * nloc) {
            __builtin_amdgcn_fence(__ATOMIC_RELEASE, "agent");
            asm volatile("s_waitcnt vmcnt(0)" ::: "memory");
            const unsigned og = xb_add(&bar[XB_TOP], 1u);
            const unsigned tg = og / nx;
            if (og + 1u == (tg + 1u) * nx) xb_add(&bar[XB_TOPGEN], 1u);
            else XB_SPIN(xb_ld(&bar[XB_TOPGEN]) == tg, bar);
            __builtin_amdgcn_fence(__ATOMIC_ACQUIRE, "agent");
            xb_add(&bar[XB_XGEN(b.x)], 1u);
            asm volatile("s_waitcnt vmcnt(0)" ::: "memory");
        } else {
            XB_SPIN(xb_ld(&bar[XB_XGEN(b.x)]) == gen, bar);
            __builtin_amdgcn_fence(__ATOMIC_ACQUIRE, "agent");
            asm volatile("s_waitcnt vmcnt(0)" ::: "memory");
        }
    }
    __syncthreads();
}

constexpr size_t WS_BAR = WS_END;
constexpr int LDS_ST_OFF = LDS_BYTES - 16;
struct KArgs { Params p; TJob jobs[11]; };
constexpr int N_PHASES = 15;
#ifndef PH_MASK
#define PH_MASK 0xFFFF
#endif
#ifndef DUP_MASK
#define DUP_MASK 0
#endif

__global__ void __launch_bounds__(512, 2) fwd_megakernel(KArgs ka) {
    extern __shared__ __attribute__((aligned(16))) unsigned char lds_raw[];
    LAS unsigned char* lds = (LAS unsigned char*)lds_raw;
    const Params& p = ka.p;
    const int bid = blockIdx.x, nblk = gridDim.x;
    unsigned char* ws = p.ws;
    const int lo = p.ph_lo, hi = p.ph_hi;
    if (threadIdx.x < 4) ((LAS unsigned*)(lds + LDS_ST_OFF))[threadIdx.x] = 0u;
    __syncthreads();
    if (hi > 1000) cg::this_grid().sync();
    XcdBarrier xbar = xcd_barrier_post((unsigned*)(ws + WS_BAR), (volatile LAS unsigned*)(lds + LDS_ST_OFF));
#define IN(k) ((PH_MASK & (1 << (k))) && lo <= (k) && (k) < hi)
#define SEAM(k) do { if (lo <= (k) && (k) + 1 < hi) xcd_barrier(xbar); } while (0)
    if (IN(0)) for (int rep = 0; rep <= ((DUP_MASK >> 0) & 1); ++rep) {
            bf16_t* aada = (bf16_t*)(ws + WS_AADA);
            for (int idx = bid * 512 + threadIdx.x; idx < 256 * 2048; idx += nblk * 512) { const int row = idx >> 11, col = idx & 2047;
                const float v = row < 4 ? siluf_(p.in[2][row * 2048 + col]) : (row < NB ? siluf_(p.in[3][(row - 4) * 2048 + col]) : 0.f); aada[idx] = f2bf(v); }
            transpose_jobs(ka.jobs, 1, bid, nblk, lds);
        }
    SEAM(0);
    if (IN(1)) for (int rep = 0; rep <= ((DUP_MASK >> 1) & 1); ++rep) {
            if (bid < 48) { pg8::Gemm g{(const bf16_t*)(ws + WS_AADA), (const bf16_t*)(ws + WS_PROJ), 2048, 2048, 2048, 0, 0, 0, 0, 0}; pg8::OneUnitOrder S{48, bid, 32}; pg8::EpiAda E{(float*)(ws + WS_MOD), p.in[8]}; pg8::gemm_phase(lds, g, S, E); }
            else { transpose_jobs(ka.jobs + 1, 1, bid - 48, nblk - 48, lds); transpose_jobs(ka.jobs + 4, 7, bid - 48, nblk - 48, lds); }
        }
    SEAM(1);
    if (IN(2)) for (int rep = 0; rep <= ((DUP_MASK >> 2) & 1); ++rep) norm_phase<0>(p, bid, nblk);
    SEAM(2);
    if (IN(3)) for (int rep = 0; rep <= ((DUP_MASK >> 3) & 1); ++rep) { pg8::Gemm g{(const bf16_t*)(ws + WS_U), (const bf16_t*)(ws + WS_WIN), 2048, 2048, 2048, 0, 0, 0, 0, 0}; pg8::StaticOrder S; S.init(TT, NPROJ, 2048, nblk, bid); pg8::EpiBf16 E{(bf16_t*)(ws + WS_PROJ), NPROJ, 0, nullptr}; pg8::gemm_phase(lds, g, S, E); }
    SEAM(3);
    if (IN(4)) for (int rep = 0; rep <= ((DUP_MASK >> 4) & 1); ++rep) mixer_prep_phase(p, bid, nblk);
    SEAM(4);
    if (IN(5)) for (int rep = 0; rep <= ((DUP_MASK >> 5) & 1); ++rep) chunk_prep_phase(p, bid, nblk, lds);
    SEAM(5);
    if (IN(6)) for (int rep = 0; rep <= ((DUP_MASK >> 6) & 1); ++rep) scan_phase(p, bid, nblk, lds);
    SEAM(6);
    if (IN(7)) for (int rep = 0; rep <= ((DUP_MASK >> 7) & 1); ++rep) { onorm_phase(p, bid, nblk);
            pg8::Gemm g{(const bf16_t*)(ws + WS_YP), (const bf16_t*)(ws + WS_PW), 1024, 256, 256, 512, 0, 0, 0, 0}; pg8::StaticOrder S; S.init(TT, 1024, 256, nblk, bid); pg8::EpiBf16 E{(bf16_t*)(ws + WS_U), DM, 1024, p.in[16]}; pg8::gemm_phase(lds, g, S, E);
            if (rep == 0) { if (nblk <= 136) transpose_jobs(ka.jobs + 3, 1, bid, nblk, lds); else if (bid >= 136) transpose_jobs(ka.jobs + 3, 1, bid - 136, nblk - 136, lds); } }
    SEAM(7);
    if (IN(8)) for (int rep = 0; rep <= ((DUP_MASK >> 8) & 1); ++rep) {
            pg8::Gemm g{(const bf16_t*)(ws + WS_U), (const bf16_t*)(ws + WS_WAB), 2048, 2048, 1024, 0, 2048, 2048, (size_t)128 * 2048 * 2, (size_t)128 * 2048 * 2}; pg8::StaticOrder S; S.init(68 * 256, 16 * 256, 1024, nblk, bid);
            pg8::EpiDiag E{(bf16_t*)(ws + WS_QN), (const bf16_t*)(ws + WS_PROJ)}; pg8::gemm_phase(lds, g, S, E);
            if (rep == 0) { const int nfull = 1088 % nblk; if (nfull == 0 || nfull >= nblk) transpose_jobs(ka.jobs + 2, 1, bid, nblk, lds); else if (bid >= nfull) transpose_jobs(ka.jobs + 2, 1, bid - nfull, nblk - nfull, lds); } }
    SEAM(9);
    if (IN(10)) for (int rep = 0; rep <= ((DUP_MASK >> 10) & 1); ++rep) { pg8::Gemm g{(const bf16_t*)(ws + WS_QN), (const bf16_t*)(ws + WS_WO), 2048, 2048, 2048, 0, 0, 0, 0, 0}; pg8::SplitOrder S{nblk, bid, 32, 4, 8}; pg8::EpiRes E{p.out + O_Y, p.in[0], p.in[1], (const float*)(ws + WS_MOD) + 4096, (float*)(ws + WS_PB10)}; pg8::gemm_phase(lds, g, S, E); }
    SEAM(10);
    if (IN(11)) for (int rep = 0; rep <= ((DUP_MASK >> 11) & 1); ++rep) norm_phase<1>(p, bid, nblk);
    SEAM(11);
    if (IN(12)) for (int rep = 0; rep <= ((DUP_MASK >> 12) & 1); ++rep) { pg8::Gemm g{(const bf16_t*)(ws + WS_U), (const bf16_t*)(ws + WS_WGU), 2048, 2048, 2048, 0, 0, 0, 0, 0}; pg8::StaticOrder S; S.init(TT, 11264, 2048, nblk, bid); pg8::EpiGU E{(bf16_t*)(ws + WS_PROJ)}; pg8::gemm_phase(lds, g, S, E); }
    SEAM(12);
    if (IN(13)) for (int rep = 0; rep <= ((DUP_MASK >> 13) & 1); ++rep) { pg8::Gemm g{(const bf16_t*)(ws + WS_PROJ), (const bf16_t*)(ws + WS_WD), DFF, DFF, DFF, 0, 0, 0, 0, 0}; pg8::SplitOrder S{nblk, bid, 88, 8, 11}; pg8::EpiRes E{p.out + O_Y, p.out + O_Y, p.out + O_Y + (size_t)TP * DM, (const float*)(ws + WS_MOD) + 10240, (float*)(ws + WS_PB13)}; pg8::gemm_phase(lds, g, S, E); }
    SEAM(13);
    if (IN(14)) for (int rep = 0; rep <= ((DUP_MASK >> 14) & 1); ++rep) norm_phase<2>(p, bid, nblk);
    SEAM(14);
}

extern "C" void kernel_launch(void* const* d_in, const int* in_sizes, int n_in, void* d_out, int out_size, void* d_ws, size_t ws_size, hipStream_t stream) {
    static int grid = 0;
    if (grid == 0) {
        if (n_in != 24 || ws_size < WS_BAR + XCD_BAR_WORDS * 4) { fprintf(stderr, "kernel_launch: unexpected n_in %d / ws_size %zu (need %zu)\n", n_in, ws_size, (size_t)WS_END); grid = -1; return; }
        int dev = 0, cus = 0, per_cu = 0;
        hipGetDevice(&dev); hipDeviceGetAttribute(&cus, hipDeviceAttributeMultiprocessorCount, dev);
        if (hipFuncSetAttribute((const void*)fwd_megakernel, hipFuncAttributeMaxDynamicSharedMemorySize, LDS_BYTES) != hipSuccess) { fprintf(stderr, "kernel_launch: hipFuncSetAttribute failed\n"); grid = -1; return; }
        if (hipOccupancyMaxActiveBlocksPerMultiprocessor(&per_cu, (const void*)fwd_megakernel, 512, LDS_BYTES) != hipSuccess || per_cu < 1) { fprintf(stderr, "kernel_launch: occupancy query says %d\n", per_cu); per_cu = 1; }
        (void)hipGetLastError();
        grid = cus > 0 ? cus : 256;
        if (grid < 64) grid = 64;
    }
    if (grid < 0) return;
    if (hipMemsetAsync((unsigned char*)d_ws + WS_BAR, 0, XCD_BAR_WORDS * 4, stream) != hipSuccess) { fprintf(stderr, "kernel_launch: memset failed\n"); return; }
    KArgs ka; memset(&ka, 0, sizeof(ka));
    for (int i = 0; i < 24; ++i) ka.p.in[i] = (const float*)d_in[i];
    ka.p.out = (float*)d_out; ka.p.ws = (unsigned char*)d_ws;
    unsigned char* ws = (unsigned char*)d_ws;
    auto setjob = [&](int i, const void* src, void* dst, int ld_src, int K, int Nout, int ld_dst, int map) { TJob& j = ka.jobs[i]; j.src = (const float*)src; j.dst = (bf16_t*)dst; j.ld_src = ld_src; j.K = K; j.Nout = Nout; j.ld_dst = ld_dst; j.map = map; j.pad = 0; };
    setjob(0, d_in[7], ws + WS_PROJ, MODW, 2048, MODW, 2048, 0);
    setjob(1, d_in[10], ws + WS_WIN, 9232, 2048, NPROJ, 2048, 1);
    setjob(2, d_in[21], ws + WS_WGU, 2 * DFF, 2048, 2 * DFF, 2048, 2);
    setjob(3, d_in[22], ws + WS_WD, 2048, DFF, 2048, DFF, 0);
    setjob(4, d_in[19], ws + WS_WO, 2048, 2048, 2048, 2048, 0);
    setjob(5, d_in[17], ws + WS_WAB, 2048, 1024, 2048, 2048, 0);
    setjob(6, d_in[18], ws + WS_WAB + 1024 * 2, 2048, 1024, 2048, 2048, 0);
    for (int g = 0; g < 4; ++g) setjob(7 + g, (const float*)d_in[15] + g * 65536, ws + WS_PW + (size_t)g * 65536 * 2, 256, 256, 256, 256, 0);
#if MK_PER_PHASE
    for (int ph = 0; ph < N_PHASES; ++ph) { ka.p.ph_lo = ph; ka.p.ph_hi = ph + 1; hipLaunchKernelGGL(fwd_megakernel, dim3(grid), dim3(512), LDS_BYTES, stream, ka); }
#else
    ka.p.ph_lo = 0; ka.p.ph_hi = N_PHASES;
    void* args[] = {&ka};
    hipError_t e = hipLaunchCooperativeKernel((const void*)fwd_megakernel, dim3(grid), dim3(512), args, LDS_BYTES, stream);
    if (e != hipSuccess) fprintf(stderr, "cooperative launch failed: %s (grid %d)\n", hipGetErrorString(e), grid);
#endif
}
```

```cpp
#include <hip/hip_runtime.h>
#include <hip/hip_cooperative_groups.h>
#include <cstdio>
#include <cstring>
namespace cg = cooperative_groups;

#ifndef MK_PER_PHASE
#define MK_PER_PHASE 0
#endif

#define LAS __attribute__((address_space(3)))
typedef unsigned short bf16_t;
typedef short bf16x8 __attribute__((ext_vector_type(8)));
typedef float f32x4 __attribute__((ext_vector_type(4)));
typedef float f32x2 __attribute__((ext_vector_type(2)));
typedef unsigned u32x4 __attribute__((ext_vector_type(4)));
typedef unsigned u32x2 __attribute__((ext_vector_type(2)));

constexpr int DM = 2048, TP = 8192, TS = 512, TT = 8704, NB = 132;
constexpr int NPROJ = 9472;
constexpr int DFF = 5632;
constexpr int MODW = 12288;
constexpr float EPS = 1e-6f;
constexpr int C_Q = 0, C_K = 1024, C_V = 2048, C_Z = 3072, C_XP = 4096, C_GA = 5120, C_GB = 7168, C_AB = 9216;
constexpr size_t O_Y = 0, O_DP = 17825792, O_CP = 18350080, O_PP = 18386944, O_DS = 18448384, O_CS = 35225600, O_PS = 36405248;
constexpr size_t OS_O = 0, OS_UB = 8912896;
constexpr size_t WS_WIN = 0;
constexpr size_t WS_WGU = WS_WIN + (size_t)NPROJ * 2048 * 2;
constexpr size_t WS_WD = WS_WGU + (size_t)11264 * 2048 * 2;
constexpr size_t WS_WO = WS_WD + (size_t)2048 * 5632 * 2;
constexpr size_t WS_WAB = WS_WO + (size_t)2048 * 2048 * 2;
constexpr size_t WS_PW = WS_WAB + (size_t)2048 * 2048 * 2;
constexpr size_t WS_AADA = WS_PW + (size_t)1024 * 256 * 2;
constexpr size_t WS_MOD = WS_AADA + (size_t)256 * 2048 * 2;
constexpr size_t WS_G = WS_MOD + (size_t)NB * MODW * 4;
constexpr size_t WS_BETA = WS_G + (size_t)TT * 8 * 4;
constexpr size_t WS_CD = WS_BETA + (size_t)TT * 8 * 4;
constexpr size_t WS_U = WS_CD + 4096;
constexpr size_t WS_QN = WS_U + (size_t)TT * 2048 * 2;
constexpr size_t WS_KN = WS_QN + (size_t)TT * 1024 * 2;
constexpr size_t WS_VV = WS_KN + (size_t)TT * 1024 * 2;
constexpr size_t WS_YP = WS_VV + (size_t)TT * 1024 * 2;
constexpr size_t WS_WDC = WS_YP + (size_t)TT * 1024 * 2;
constexpr size_t WS_QD = WS_WDC + (size_t)1024 * 64 * 128 * 2;
constexpr size_t WS_KT = WS_QD + (size_t)1024 * 64 * 128 * 2;
constexpr size_t WS_QK = WS_KT + (size_t)1024 * 64 * 128 * 2;
constexpr size_t WS_PROJ = WS_QK + (size_t)1024 * 64 * 64 * 2;
constexpr size_t WS_END = WS_PROJ + (size_t)TT * NPROJ * 2;
constexpr size_t WS_PB10 = WS_PROJ;
constexpr size_t WS_PB13 = WS_PROJ + (size_t)TT * DFF * 2;
static_assert(WS_PB13 + (size_t)11 * TS * DM * 4 <= WS_END && (WS_PB13 % 256) == 0, "partials");
static_assert(WS_END + 16384 <= 501510720ull, "workspace too large");
static_assert((WS_PROJ % 256) == 0 && (WS_QK % 256) == 0 && (WS_U % 256) == 0, "align");

constexpr int LDS_BYTES = 147456;

struct Params {
    const float* in[24];
    float* out;
    unsigned char* ws;
    int ph_lo, ph_hi;
};

__device__ __forceinline__ float bf2f(unsigned short x) { return __uint_as_float(((unsigned)x) << 16); }
__device__ __forceinline__ unsigned short f2bf(float f) { const __bf16 b = (__bf16)f; return __builtin_bit_cast(unsigned short, b); }
typedef __bf16 bf16x2_hw __attribute__((ext_vector_type(2)));
__device__ __forceinline__ unsigned pk2(float lo, float hi) { const f32x2 v = {lo, hi}; const bf16x2_hw b = __builtin_convertvector(v, bf16x2_hw); return __builtin_bit_cast(unsigned, b); }
__device__ __forceinline__ void unpack8(const u32x4 w, float* f) {
    f[0] = __uint_as_float(w.x << 16); f[1] = __uint_as_float(w.x & 0xffff0000u);
    f[2] = __uint_as_float(w.y << 16); f[3] = __uint_as_float(w.y & 0xffff0000u);
    f[4] = __uint_as_float(w.z << 16); f[5] = __uint_as_float(w.z & 0xffff0000u);
    f[6] = __uint_as_float(w.w << 16); f[7] = __uint_as_float(w.w & 0xffff0000u);
}
__device__ __forceinline__ u32x4 pack8(const float* f) { u32x4 w; w.x = pk2(f[0], f[1]); w.y = pk2(f[2], f[3]); w.z = pk2(f[4], f[5]); w.w = pk2(f[6], f[7]); return w; }
__device__ __forceinline__ float sigmoidf_(float x) { return __builtin_amdgcn_rcpf(1.0f + __expf(-x)); }
__device__ __forceinline__ float siluf_(float x) { return x * __builtin_amdgcn_rcpf(1.0f + __expf(-x)); }
__device__ __forceinline__ int bidx_of_row(int row) { return row < TP ? (row >> 11) : 4 + ((row - TP) >> 2); }

namespace pg8 {
constexpr int BM = 256, BK = 64, HALF = 128, HTB = HALF * BK * 2, STAGE_BYTES = 8 * HTB, NXCD = 8, WGM = 8;
__host__ __device__ __forceinline__ int lds_byte(int r, int c) { const int st = (r >> 4) * 2 + (c >> 5), rr = r & 15, cc = c & 31, ob = rr * 64 + cc * 2; return st * 1024 + (ob ^ (((ob >> 9) & 1) << 5)); }
__host__ __device__ __forceinline__ void stage_rc(int b, int& R, int& C) { const int st = b / 1024, sb = b % 1024, swz = sb ^ (((sb >> 9) & 1) << 5); R = (st >> 1) * 16 + swz / 64; C = (st & 1) * 32 + (swz % 64) / 2; }
__host__ __device__ __forceinline__ int perm32(int rho) { const int n = rho >> 4, i = rho & 15; return 8 * (i >> 2) + 4 * n + (i & 3); }

struct Unit { int pm, pn, kt0, nkt, piece; };
struct Gemm { const bf16_t* A; const bf16_t* Bt; int lda, ldb, K; size_t a_pn_off; size_t a_half, b_half, a_tile, b_tile; };

__device__ __forceinline__ void tile_of(int wgid, int nM, int nN, Unit& u) {
    const int nwg = nM * nN;
    { const int q = nwg / NXCD, r = nwg % NXCD, xcd = wgid % NXCD, off = wgid / NXCD; wgid = (xcd < r ? xcd * (q + 1) : r * (q + 1) + (xcd - r) * q) + off; }
    const int nig = WGM * nN, gid = wgid / nig, fm = gid * WGM, gsz = (nM - fm) < WGM ? (nM - fm) : WGM;
    u.pm = fm + ((wgid % nig) % gsz); u.pn = (wgid % nig) / gsz;
}
struct StaticOrder {
    int nM, nN, nwg, G, c, ntk;
    __device__ __forceinline__ void init(int M, int N, int K, int G_, int c_) { nM = M / BM; nN = N / BM; nwg = nM * nN; G = G_; c = c_; ntk = K / BK; }
    __device__ __forceinline__ bool next(int i, Unit& u) const {
        const long L = (long)i * G + c; if (L >= nwg) return false;
        tile_of((int)L, nM, nN, u); u.kt0 = 0; u.nkt = ntk; u.piece = -1; return true;
    }
};
struct OneUnitOrder {
    int n, c, ntk;
    __device__ __forceinline__ bool next(int i, Unit& u) const { if (i != 0 || c >= n) return false; u.pm = 0; u.pn = c; u.kt0 = 0; u.nkt = ntk; u.piece = -1; return true; }
};
struct DoubleOrder {
    int G, c;
    __device__ __forceinline__ bool next(int i, Unit& u) const {
        const int L = (i >> 1) * G + c, half = i & 1; const bool ok = L < 272;
        tile_of(ok ? L : 0, 34, 8, u); u.kt0 = 16 * half; u.nkt = 16; u.piece = half; return ok;
    }
};
struct SplitOrder {
    int G, c, ntk, pk, npc;
    __device__ __forceinline__ bool next(int i, Unit& u) const {
        const int L = i * G + c;
        const bool full = L < 256;
        int fpm, fpn;
        { int wgid = full ? L : 0; const int xcd = wgid % NXCD, off = wgid / NXCD; wgid = xcd * 32 + off;
          const int nig = WGM * 8, gid = wgid / nig, fm = gid * WGM; fpm = fm + ((wgid % nig) % WGM); fpn = (wgid % nig) / WGM; }
        const int pidx = full ? 0 : L - 256, tile = pidx / npc, pc = pidx - tile * npc;
        u.pm = full ? fpm : 32 + (tile >> 3); u.pn = full ? fpn : (tile & 7); u.kt0 = full ? 0 : pc * pk; u.nkt = full ? ntk : pk; u.piece = full ? -1 : pc;
        return full || pidx < 16 * npc;
    }
};

template <class Epi, class Sched>
__device__ __forceinline__ void gemm_phase(LAS unsigned char* lds, const Gemm g, const Sched& S, const Epi& E) {
    const int tid = threadIdx.x, wid = __builtin_amdgcn_readfirstlane(tid >> 6), lane = tid & 63, wr = wid >> 2, wc = wid & 3, fr = lane & 15, fq = lane >> 4;
    unsigned voffA[2], voffB[2];
#pragma unroll
    for (int i = 0; i < 2; ++i) { int R, C; stage_rc(tid * 16 + i * 8192, R, C); const int Rb = Epi::PERM ? ((R & ~31) + perm32(R & 31)) : R;
        voffA[i] = (unsigned)(R * g.lda + C) * 2u; voffB[i] = (unsigned)(Rb * g.ldb + C) * 2u; }
    const size_t kstep = (size_t)(BK * 2);
    const size_t hstepA = g.a_half ? g.a_half : (size_t)HALF * g.lda * 2, hstepB = g.b_half ? g.b_half : (size_t)HALF * g.ldb * 2;
    const size_t tstepA = g.a_tile ? g.a_tile : (size_t)BM * g.lda * 2, tstepB = g.b_tile ? g.b_tile : (size_t)BM * g.ldb * 2;
    const unsigned ldsw = (unsigned)wid * 1024u;
    const int aoff = lds_byte(wr * 64 + fr, fq * 8), boff = lds_byte(wc * 32 + fr, fq * 8);
#define PG8_SA(b, h) (((b) * 2 + (h)) * HTB)
#define PG8_SB(b, h) ((4 + (b) * 2 + (h)) * HTB)
#define PG8_STAGE(bufoff, gbase, voff) do { _Pragma("unroll") for (int _i = 0; _i < 2; ++_i) \
        __builtin_amdgcn_global_load_lds((const unsigned*)((const char*)(gbase) + (voff)[_i]), (LAS unsigned*)(lds + (bufoff) + ldsw + _i * 8192), 16, 0, 0); } while (0)
#define PG8_LDA(dst, b, h) do { _Pragma("unroll") for (int m = 0; m < 4; ++m) _Pragma("unroll") for (int k = 0; k < 2; ++k) dst[m][k] = *(const LAS bf16x8*)(lds + PG8_SA(b, h) + aoff + m * 2048 + k * 1024); } while (0)
#define PG8_LDB(dst, b, h) do { _Pragma("unroll") for (int n = 0; n < 2; ++n) _Pragma("unroll") for (int k = 0; k < 2; ++k) dst[n][k] = *(const LAS bf16x8*)(lds + PG8_SB(b, h) + boff + n * 2048 + k * 1024); } while (0)
#define PG8_MMA(ai, bj, At, Bt) do { __builtin_amdgcn_s_setprio(1); _Pragma("unroll") for (int m = 0; m < 4; ++m) _Pragma("unroll") for (int n = 0; n < 2; ++n) _Pragma("unroll") for (int k = 0; k < 2; ++k) \
        acc[ai][bj][m][n] = __builtin_amdgcn_mfma_f32_16x16x32_bf16(Bt[n][k], At[m][k], acc[ai][bj][m][n], 0, 0, 0); __builtin_amdgcn_s_setprio(0); } while (0)
#define PG8_WAIT_V(n) asm volatile("s_waitcnt vmcnt(" #n ")" ::: "memory")
#define PG8_WAIT_L(n) asm volatile("s_waitcnt lgkmcnt(" #n ")" ::: "memory")
#define PG8_BAR __builtin_amdgcn_s_barrier()
#define PG8_SCHED __builtin_amdgcn_sched_barrier(0)
    Unit cur, nxt; int ui = 0;
    if (!S.next(0, cur)) return;
    f32x4 acc[2][2][4][2];
#pragma unroll
    for (int a = 0; a < 2; ++a)
#pragma unroll
        for (int b = 0; b < 2; ++b)
#pragma unroll
            for (int m = 0; m < 4; ++m)
#pragma unroll
                for (int n = 0; n < 2; ++n) acc[a][b][m][n] = (f32x4){0.f, 0.f, 0.f, 0.f};
    bf16x8 At[4][2], B0[2][2], B1[2][2];
    const char* cA = (const char*)g.A + (size_t)cur.pm * tstepA + (size_t)cur.pn * g.a_pn_off + (size_t)cur.kt0 * kstep; const char* cB = (const char*)g.Bt + (size_t)cur.pn * tstepB + (size_t)cur.kt0 * kstep;
    PG8_STAGE(PG8_SB(0, 0), cB, voffB); PG8_STAGE(PG8_SA(0, 0), cA, voffA); PG8_STAGE(PG8_SB(0, 1), cB + hstepB, voffB); PG8_STAGE(PG8_SA(0, 1), cA + hstepA, voffA);
    if (wr == 1) PG8_BAR;
    PG8_WAIT_V(4); PG8_BAR;
    PG8_STAGE(PG8_SB(1, 0), cB + kstep, voffB); PG8_STAGE(PG8_SA(1, 0), cA + kstep, voffA); PG8_STAGE(PG8_SB(1, 1), cB + hstepB + kstep, voffB);
    PG8_WAIT_V(6); PG8_BAR;
    for (;;) {
        const bool has_next = S.next(ui + 1, nxt);
        const char* nA = has_next ? (const char*)g.A + (size_t)nxt.pm * tstepA + (size_t)nxt.pn * g.a_pn_off + (size_t)nxt.kt0 * kstep : cA; const char* nB = has_next ? (const char*)g.Bt + (size_t)nxt.pn * tstepB + (size_t)nxt.kt0 * kstep : cB;
        const int nt = cur.nkt;
#pragma unroll 1
        for (int t = 0; t < nt; t += 2) {
            const bool last = (t == nt - 2);
            const char* a1 = cA + (size_t)(t + 1) * kstep;
            const char* a2 = last ? nA : cA + (size_t)(t + 2) * kstep; const char* b2 = last ? nB : cB + (size_t)(t + 2) * kstep;
            const char* a3 = a2 + kstep; const char* b3 = b2 + kstep;
            PG8_LDB(B0, 0, 0); PG8_SCHED; PG8_LDA(At, 0, 0); PG8_STAGE(PG8_SA(1, 1), a1 + hstepA, voffA);
            PG8_WAIT_L(8); PG8_BAR; PG8_WAIT_L(0); PG8_MMA(0, 0, At, B0); PG8_BAR; PG8_SCHED;
            PG8_LDB(B1, 0, 1); PG8_STAGE(PG8_SB(0, 0), b2, voffB);
            PG8_BAR; PG8_WAIT_L(0); if constexpr (!Epi::DIAG) PG8_MMA(0, 1, At, B1); PG8_BAR;
            PG8_LDA(At, 0, 1); PG8_STAGE(PG8_SA(0, 0), a2, voffA);
            PG8_BAR; PG8_WAIT_L(0); if constexpr (!Epi::DIAG) PG8_MMA(1, 0, At, B0); PG8_BAR; PG8_SCHED;
            PG8_STAGE(PG8_SB(0, 1), b2 + hstepB, voffB);
            PG8_WAIT_V(6); PG8_BAR; PG8_MMA(1, 1, At, B1); PG8_BAR;
            PG8_LDB(B0, 1, 0); PG8_SCHED; PG8_LDA(At, 1, 0); PG8_STAGE(PG8_SA(0, 1), a2 + hstepA, voffA);
            PG8_WAIT_L(8); PG8_BAR; PG8_WAIT_L(0); PG8_MMA(0, 0, At, B0); PG8_BAR; PG8_SCHED;
            PG8_LDB(B1, 1, 1); PG8_STAGE(PG8_SB(1, 0), b3, voffB);
            PG8_BAR; PG8_WAIT_L(0); if constexpr (!Epi::DIAG) PG8_MMA(0, 1, At, B1); PG8_BAR;
            PG8_LDA(At, 1, 1); PG8_STAGE(PG8_SA(1, 0), a3, voffA);
            PG8_BAR; PG8_WAIT_L(0); if constexpr (!Epi::DIAG) PG8_MMA(1, 0, At, B0); PG8_BAR; PG8_SCHED;
            PG8_STAGE(PG8_SB(1, 1), b3 + hstepB, voffB);
            PG8_WAIT_V(6); PG8_BAR; PG8_MMA(1, 1, At, B1); PG8_BAR;
        }
        E(acc, cur, wr, wc, fr, fq);
        if (!has_next) break;
#pragma unroll
        for (int a = 0; a < 2; ++a)
#pragma unroll
            for (int b = 0; b < 2; ++b)
#pragma unroll
                for (int m = 0; m < 4; ++m)
#pragma unroll
                    for (int n = 0; n < 2; ++n) acc[a][b][m][n] = (f32x4){0.f, 0.f, 0.f, 0.f};
        cur = nxt; cA = nA; cB = nB; ++ui;
    }
    PG8_WAIT_V(0);
    if (wr == 0) PG8_BAR;
    PG8_BAR;
#undef PG8_SA
#undef PG8_SB
#undef PG8_STAGE
#undef PG8_LDA
#undef PG8_LDB
#undef PG8_MMA
#undef PG8_WAIT_V
#undef PG8_WAIT_L
#undef PG8_BAR
#undef PG8_SCHED
}

typedef f32x4 Acc[2][2][4][2];

struct EpiAda {
    static constexpr bool PERM = false, MID = false, DIAG = false;
    float* C; const float* bias;
    __device__ __forceinline__ void operator()(const Acc& acc, const Unit& u, int wr, int wc, int fr, int fq) const {
        const int row0 = wr * 64 + fr, col0 = u.pn * BM + wc * 32 + 4 * fq;
#pragma unroll
        for (int ai = 0; ai < 2; ++ai)
#pragma unroll
            for (int m = 0; m < 4; ++m) { const int row = row0 + ai * HALF + m * 16; if (row < NB) {
#pragma unroll
                for (int bj = 0; bj < 2; ++bj)
#pragma unroll
                    for (int n = 0; n < 2; ++n) { const int c = col0 + bj * HALF + n * 16; *(f32x4*)(C + (size_t)row * MODW + c) = acc[ai][bj][m][n] + *(const f32x4*)(bias + c); } } }
    }
};
struct EpiBf16 {
    static constexpr bool PERM = true, MID = false, DIAG = false;
    bf16_t* O; int ldc; int col_off; const float* scale;
    __device__ __forceinline__ void operator()(const Acc& acc, const Unit& u, int wr, int wc, int fr, int fq) const {
        const int row0 = u.pm * BM + wr * 64 + fr, col0 = u.pn * BM + wc * 32 + 8 * fq;
#pragma unroll
        for (int ai = 0; ai < 2; ++ai)
#pragma unroll
            for (int m = 0; m < 4; ++m) { bf16_t* rowp = O + (size_t)(row0 + ai * HALF + m * 16) * ldc + col_off + col0;
#pragma unroll
                for (int bj = 0; bj < 2; ++bj) { f32x4 v0 = acc[ai][bj][m][0], v1 = acc[ai][bj][m][1];
                    if (scale) { v0 *= *(const f32x4*)(scale + col0 + bj * HALF); v1 *= *(const f32x4*)(scale + col0 + bj * HALF + 4); }
                    u32x4 w; w.x = pk2(v0[0], v0[1]); w.y = pk2(v0[2], v0[3]); w.z = pk2(v1[0], v1[1]); w.w = pk2(v1[2], v1[3]);
                    *(u32x4*)(rowp + bj * HALF) = w; }
                if (scale) asm volatile("" ::: "memory"); }
    }
};
struct EpiG1 {
    static constexpr bool PERM = true, MID = false, DIAG = false;
    float* T1; const bf16_t* proj;
    __device__ __forceinline__ void operator()(const Acc& acc, const Unit& u, int wr, int wc, int fr, int fq) const {
        const int row0 = u.pm * BM + wr * 64 + fr, col0 = u.pn * BM + wc * 32 + 8 * fq;
#pragma unroll
        for (int ai = 0; ai < 2; ++ai)
#pragma unroll
            for (int m = 0; m < 4; ++m) { const size_t row = (size_t)(row0 + ai * HALF + m * 16); const bf16_t* pr = proj + row * NPROJ + col0;
#pragma unroll
                for (int bj = 0; bj < 2; ++bj) { float ga[8]; unpack8(*(const u32x4*)(pr + C_GA + bj * HALF), ga); f32x4 v0, v1;
#pragma unroll
                    for (int j = 0; j < 4; ++j) { v0[j] = acc[ai][bj][m][0][j] * __builtin_amdgcn_rcpf(1.0f + __expf(-ga[j])); v1[j] = acc[ai][bj][m][1][j] * __builtin_amdgcn_rcpf(1.0f + __expf(-ga[4 + j])); }
                    float* o = T1 + row * DM + col0 + bj * HALF; *(f32x4*)o = v0; *(f32x4*)(o + 4) = v1; }
                }
    }
};
struct EpiG2 {
    static constexpr bool PERM = true, MID = false, DIAG = false;
    bf16_t* O; const float* T1; const bf16_t* proj;
    __device__ __forceinline__ void operator()(const Acc& acc, const Unit& u, int wr, int wc, int fr, int fq) const {
        const int row0 = u.pm * BM + wr * 64 + fr, col0 = u.pn * BM + wc * 32 + 8 * fq;
#pragma unroll
        for (int ai = 0; ai < 2; ++ai)
#pragma unroll
            for (int m = 0; m < 4; ++m) { const size_t row = (size_t)(row0 + ai * HALF + m * 16); const bf16_t* pr = proj + row * NPROJ + col0;
#pragma unroll
                for (int bj = 0; bj < 2; ++bj) { float gb[8], v[8]; unpack8(*(const u32x4*)(pr + C_GB + bj * HALF), gb);
                    const float* t = T1 + row * DM + col0 + bj * HALF; const f32x4 t0 = *(const f32x4*)t, t1 = *(const f32x4*)(t + 4);
#pragma unroll
                    for (int j = 0; j < 4; ++j) { v[j] = t0[j] + acc[ai][bj][m][0][j] * __builtin_amdgcn_rcpf(1.0f + __expf(-gb[j])); v[4 + j] = t1[j] + acc[ai][bj][m][1][j] * __builtin_amdgcn_rcpf(1.0f + __expf(-gb[4 + j])); }
                    *(u32x4*)(O + row * DM + col0 + bj * HALF) = pack8(v); }
                if (m & 1) asm volatile("" ::: "memory"); }
    }
};
struct EpiG12 {
    static constexpr bool PERM = true, MID = false, DIAG = false;
    EpiG1 e1; EpiG2 e2;
    __device__ __forceinline__ void operator()(const Acc& acc, const Unit& u, int wr, int wc, int fr, int fq) const { if (u.piece == 0) e1(acc, u, wr, wc, fr, fq); else e2(acc, u, wr, wc, fr, fq); }
};
struct EpiDiag {
    static constexpr bool PERM = true, MID = false, DIAG = true;
    bf16_t* O; const bf16_t* proj;
    __device__ __forceinline__ void operator()(const Acc& acc, const Unit& u, int wr, int wc, int fr, int fq) const {
        const int row0 = u.pm * HALF + wr * 64 + fr, col0 = u.pn * HALF + wc * 32 + 8 * fq;
#pragma unroll
        for (int m = 0; m < 4; ++m) { const size_t row = (size_t)(row0 + m * 16); const bf16_t* pr = proj + row * NPROJ + col0;
            float ga[8], gb[8], v[8]; unpack8(*(const u32x4*)(pr + C_GA), ga); unpack8(*(const u32x4*)(pr + C_GB), gb);
#pragma unroll
            for (int n = 0; n < 2; ++n)
#pragma unroll
                for (int j = 0; j < 4; ++j) v[4 * n + j] = acc[0][0][m][n][j] * __builtin_amdgcn_rcpf(1.0f + __expf(-ga[4 * n + j])) + acc[1][1][m][n][j] * __builtin_amdgcn_rcpf(1.0f + __expf(-gb[4 * n + j]));
            *(u32x4*)(O + row * DM + col0) = pack8(v); }
    }
};
struct EpiRes {
    static constexpr bool PERM = false, MID = false, DIAG = false;
    float* X1; const float* x0p; const float* x0s; const float* gate; float* PB;
    __device__ __forceinline__ void operator()(const Acc& acc, const Unit& u, int wr, int wc, int fr, int fq) const {
        const int row0 = u.pm * BM + wr * 64 + fr, col0 = u.pn * BM + wc * 32 + 4 * fq;
        if (u.piece >= 0) {
            float* pb = PB + (size_t)u.piece * TS * DM;
#pragma unroll
            for (int ai = 0; ai < 2; ++ai)
#pragma unroll
                for (int m = 0; m < 4; ++m) { float* orow = pb + (size_t)(row0 + ai * HALF + m * 16 - TP) * DM;
#pragma unroll
                    for (int bj = 0; bj < 2; ++bj)
#pragma unroll
                        for (int n = 0; n < 2; ++n) *(f32x4*)(orow + col0 + bj * HALF + n * 16) = acc[ai][bj][m][n]; }
            return;
        }
#pragma unroll
        for (int ai = 0; ai < 2; ++ai)
#pragma unroll
            for (int m = 0; m < 4; ++m) { const int row = row0 + ai * HALF + m * 16; const int b = bidx_of_row(row);
                const float* xr = (row < TP) ? x0p + (size_t)row * DM : x0s + (size_t)(row - TP) * DM; const float* gr = gate + (size_t)b * MODW; float* orow = X1 + (size_t)row * DM;
#pragma unroll
                for (int bj = 0; bj < 2; ++bj)
#pragma unroll
                    for (int n = 0; n < 2; ++n) { const int c = col0 + bj * HALF + n * 16; const f32x4 xv = *(const f32x4*)(xr + c), gv = *(const f32x4*)(gr + c);
                        *(f32x4*)(orow + c) = xv + gv * acc[ai][bj][m][n]; } }
    }
};
struct EpiGU {
    static constexpr bool PERM = true, MID = false, DIAG = false;
    bf16_t* O;
    __device__ __forceinline__ void operator()(const Acc& acc, const Unit& u, int wr, int wc, int fr, int fq) const {
        const int row0 = u.pm * BM + wr * 64 + fr, col0 = u.pn * HALF + wc * 32 + 8 * fq;
#pragma unroll
        for (int ai = 0; ai < 2; ++ai)
#pragma unroll
            for (int m = 0; m < 4; ++m) { float v[8];
#pragma unroll
                for (int n = 0; n < 2; ++n)
#pragma unroll
                    for (int j = 0; j < 4; ++j) { const float gt = acc[ai][0][m][n][j]; v[4 * n + j] = gt * __builtin_amdgcn_rcpf(1.0f + __expf(-gt)) * acc[ai][1][m][n][j]; }
                *(u32x4*)(O + (size_t)(row0 + ai * HALF + m * 16) * DFF + col0) = pack8(v); }
    }
};
}

struct TJob { const float* src; bf16_t* dst; int ld_src, K, Nout, ld_dst, map, pad; };
__device__ __forceinline__ int map_col(int map, int n) {
    if (map == 1) { if (n < 4096) return n; if (n < 5120) return 4112 + (n - 4096); if (n < 9216) return 5136 + (n - 5120); if (n < 9232) return 4096 + (n - 9216); return -1; }
    if (map == 2) { const int pn = n >> 8, w = n & 255; return w < 128 ? 128 * pn + w : DFF + 128 * pn + (w - 128); }
    return n;
}
__device__ __forceinline__ void tjob_load(const TJob& j, int tile, f32x4 (&v)[4]) {
    const int tid = threadIdx.x, nkt = j.K >> 7, tn = tile / nkt, tk = tile - tn * nkt;
    const int n = tn * 64 + (tid & 15) * 4, kr = tid >> 4, col = map_col(j.map, n);
#pragma unroll
    for (int i = 0; i < 4; ++i) v[i] = col >= 0 ? __builtin_nontemporal_load((const f32x4*)(j.src + (size_t)(tk * 128 + kr + 32 * i) * j.ld_src + col)) : (f32x4){0.f, 0.f, 0.f, 0.f};
}
__device__ __forceinline__ void tjob_store(const TJob& j, int tile, const f32x4 (&v)[4], LAS float* s) {
    const int tid = threadIdx.x, nkt = j.K >> 7, tn = tile / nkt, tk = tile - tn * nkt;
    const int nq = tid & 15, kr = tid >> 4;
    __syncthreads();
#pragma unroll
    for (int i = 0; i < 4; ++i)
#pragma unroll
        for (int q = 0; q < 4; ++q) s[(4 * nq + q) * 129 + kr + 32 * i] = v[i][q];
    __syncthreads();
    const int n = tid >> 3, k16 = (tid & 7) * 16;
    float f[16];
#pragma unroll
    for (int i = 0; i < 16; ++i) f[i] = s[n * 129 + k16 + i];
    bf16_t* d = j.dst + (size_t)(tn * 64 + n) * j.ld_dst + tk * 128 + k16;
    *(u32x4*)d = pack8(f); *(u32x4*)(d + 8) = pack8(f + 8);
}
__device__ __forceinline__ void transpose_jobs(const TJob* jobs, int njobs, int bi, int nblk, LAS unsigned char* lds) {
    LAS float* s = (LAS float*)lds;
    int total = 0;
    for (int q = 0; q < njobs; ++q) total += (jobs[q].Nout >> 6) * (jobs[q].K >> 7);
    f32x4 v[4]; int curj = 0, base = 0;
    int t = bi;
    auto locate = [&](int tt, int& jj, int& bb) { while (tt >= bb + (jobs[jj].Nout >> 6) * (jobs[jj].K >> 7)) { bb += (jobs[jj].Nout >> 6) * (jobs[jj].K >> 7); ++jj; } };
    if (t < total) { locate(t, curj, base); tjob_load(jobs[curj], t - base, v); }
    while (t < total) {
        const int tn = t + nblk; int nj = curj, nb = base; f32x4 w[4];
        if (tn < total) { locate(tn, nj, nb); tjob_load(jobs[nj], tn - nb, w); }
        tjob_store(jobs[curj], t - base, v, s);
        if (tn < total) {
#pragma unroll
            for (int i = 0; i < 4; ++i) v[i] = w[i]; }
        t = tn; curj = nj; base = nb;
    }
    __syncthreads();
}

template <int MODE>
__device__ __forceinline__ void norm_phase(const Params& p, int bid, int nblk) {
    const int lane = threadIdx.x & 63, wid = __builtin_amdgcn_readfirstlane(threadIdx.x >> 6);
    const float* mod = (const float*)(p.ws + WS_MOD);
    const float* gain = MODE == 0 ? p.in[9] : (MODE == 1 ? p.in[20] : p.in[23]);
    bf16_t* U = (bf16_t*)(p.ws + WS_U);
    auto srcrow = [&](int row) -> const float* { return MODE == 0 ? (row < TP ? p.in[0] + (size_t)row * DM : p.in[1] + (size_t)(row - TP) * DM) : p.out + O_Y + (size_t)row * DM; };
    const int stride = nblk * 8;
    f32x4 g[8];
#pragma unroll
    for (int i = 0; i < 8; ++i) g[i] = *(const f32x4*)(gain + i * 256 + lane * 4);
    f32x4 v[8], vn[8];
    bool have = false;
    const bool weighted = nblk == 256;
    const int first = bid * 8 + wid;
    const int nrows = weighted ? (MODE == 0 ? (wid < 2 ? 5 : 4) : (wid < 2 ? 2 : 5)) : (first < TT ? (TT - first + stride - 1) / stride : 0);
    auto rowat = [&](int k) -> int {
        if (!weighted) return first + k * stride;
        if (MODE == 0) return wid < 2 ? (k == 0 ? TP + bid * 2 + wid : bid * 32 + wid * 4 + (k - 1)) : bid * 32 + 8 + (wid - 2) * 4 + k;
        return wid < 2 ? (k == 0 ? TP + bid * 2 + wid : bid * 32 + wid) : bid * 32 + 2 + (wid - 2) * 5 + k; };
    int cur_b = -1; f32x4 s1[8], s0[8];
    for (int k = 0; k < nrows; ++k) {
        const int row = rowat(k);
        const float* src = srcrow(row);
        if (MODE != 0 && row >= TP) {
            const float* xs = p.in[1] + (size_t)(row - TP) * DM;
            const float* pb = (const float*)(p.ws + (MODE == 1 ? WS_PB10 : WS_PB13)) + (size_t)(row - TP) * DM;
            const float* gt = mod + (size_t)bidx_of_row(row) * MODW + (MODE == 1 ? 4096 : 10240);
            float* xo = p.out + O_Y + (size_t)row * DM;
            constexpr int NPC = MODE == 1 ? 8 : 11;
#pragma unroll 1
            for (int i = 0; i < 8; ++i) { const int c = i * 256 + lane * 4; f32x4 s = *(const f32x4*)(pb + c);
#pragma unroll
                for (int q = 1; q < NPC; ++q) s += *(const f32x4*)(pb + (size_t)q * TS * DM + c);
                const f32x4 base = MODE == 1 ? *(const f32x4*)(xs + c) : *(const f32x4*)(xo + c);
                *(f32x4*)(xo + c) = base + *(const f32x4*)(gt + c) * s; }
            asm volatile("s_waitcnt vmcnt(0)" ::: "memory");
        }
        float ss = 0.f;
        const int b_row = bidx_of_row(row);
        const float* sh = mod + (size_t)b_row * MODW + (MODE == 0 ? 0 : 6144); const float* sc = sh + 2048;
        if (!have) {
#pragma unroll
            for (int i = 0; i < 8; ++i) v[i] = *(const f32x4*)(src + i * 256 + lane * 4);
        }
        if (MODE != 2 && b_row != cur_b) {
#pragma unroll
            for (int i = 0; i < 8; ++i) { const int c = i * 256 + lane * 4; s1[i] = *(const f32x4*)(sc + c); s0[i] = *(const f32x4*)(sh + c); }
            cur_b = b_row;
        }
        const int nrow = (k + 1 < nrows) ? rowat(k + 1) : TT;
        const bool pre = nrow < TT && (MODE == 0 || nrow < TP);
        if (pre) { const float* ns = srcrow(nrow);
#pragma unroll
            for (int i = 0; i < 8; ++i) vn[i] = *(const f32x4*)(ns + i * 256 + lane * 4); }
        asm volatile("" ::: "memory");
#pragma unroll
        for (int i = 0; i < 8; ++i) ss += v[i][0] * v[i][0] + v[i][1] * v[i][1] + v[i][2] * v[i][2] + v[i][3] * v[i][3];
#pragma unroll
        for (int o = 32; o >= 1; o >>= 1) ss += __shfl_xor(ss, o);
        const float rstd = rsqrtf(ss * (1.0f / DM) + EPS);
        if (MODE == 2) {
            float* dst = p.out + O_Y + (size_t)row * DM;
#pragma unroll
            for (int i = 0; i < 8; ++i) *(f32x4*)(dst + i * 256 + lane * 4) = v[i] * rstd * g[i];
        } else {
#pragma unroll
            for (int i = 0; i < 8; ++i) { const int c = i * 256 + lane * 4;
                const f32x4 y = (v[i] * rstd * g[i]) * (1.0f + s1[i]) + s0[i]; u32x2 w; w.x = pk2(y[0], y[1]); w.y = pk2(y[2], y[3]); *(u32x2*)(U + (size_t)row * DM + c) = w; }
        }
        have = pre;
        if (pre) {
#pragma unroll
            for (int i = 0; i < 8; ++i) v[i] = vn[i]; }
    }
}

template <int NTOK, bool SMP>
__device__ __forceinline__ void mixer_item(const Params& p, int it) {
    const int tid = threadIdx.x;
    const bf16_t* proj = (const bf16_t*)(p.ws + WS_PROJ);
    bf16_t* qn = (bf16_t*)(p.ws + WS_QN); bf16_t* kn = (bf16_t*)(p.ws + WS_KN); bf16_t* vv = (bf16_t*)(p.ws + WS_VV); bf16_t* yp = (bf16_t*)(p.ws + WS_YP);
    float* gbuf = (float*)(p.ws + WS_G); float* bbuf = (float*)(p.ws + WS_BETA);
    const int sb = it - 512;
    const int b = SMP ? 0 : (it >> 7), t0 = SMP ? 0 : (it & 127) * 16;
    const int rowbase = SMP ? TP + sb * 4 : b * 2048 + t0;
    unsigned short gate_raw = 0;
    if (tid < 256 && (tid >> 4) < NTOK) gate_raw = proj[(size_t)(rowbase + (tid >> 4)) * NPROJ + C_AB + (tid & 15)];
    if (tid < 384) {
        const int c0 = tid * 8;
        float w0[8], w1[8], w2[8], w3[8], xm3[8], xm2[8], xm1[8];
        const float* cw = p.in[11];
#pragma unroll
        for (int i = 0; i < 8; ++i) { w0[i] = cw[c0 + i]; w1[i] = cw[3072 + c0 + i]; w2[i] = cw[6144 + c0 + i]; w3[i] = cw[9216 + c0 + i]; }
        if (SMP) { const float* sc = p.in[5] + (size_t)sb * 3 * 3072 + c0;
#pragma unroll
            for (int i = 0; i < 8; ++i) { xm3[i] = sc[i]; xm2[i] = sc[3072 + i]; xm1[i] = sc[6144 + i]; }
        } else if (t0 == 0) {
#pragma unroll
            for (int i = 0; i < 8; ++i) { xm3[i] = 0.f; xm2[i] = 0.f; xm1[i] = 0.f; }
        } else {
            unpack8(*(const u32x4*)(proj + (size_t)(rowbase - 3) * NPROJ + c0), xm3); unpack8(*(const u32x4*)(proj + (size_t)(rowbase - 2) * NPROJ + c0), xm2); unpack8(*(const u32x4*)(proj + (size_t)(rowbase - 1) * NPROJ + c0), xm1);
        }
        constexpr int CH = NTOK < 8 ? NTOK : 8;
#pragma unroll
        for (int tc = 0; tc < NTOK; tc += CH) {
        u32x4 xr[CH];
#pragma unroll
        for (int t = 0; t < CH; ++t) xr[t] = *(const u32x4*)(proj + (size_t)(rowbase + tc + t) * NPROJ + c0);
#pragma unroll
        for (int t2 = 0; t2 < CH; ++t2) {
            const int t = tc + t2;
            const int row = rowbase + t; float xt[8], y[8];
            unpack8(xr[t2], xt);
            float ss = 0.f;
#pragma unroll
            for (int i = 0; i < 8; ++i) { const float a = w0[i] * xm3[i] + w1[i] * xm2[i] + w2[i] * xm1[i] + w3[i] * xt[i]; y[i] = siluf_(a); ss += y[i] * y[i]; }
            if (c0 < 2048) {
                ss += __shfl_xor(ss, 1); ss += __shfl_xor(ss, 2); ss += __shfl_xor(ss, 4); ss += __shfl_xor(ss, 8);
                const float inv = rsqrtf(ss + EPS);
#pragma unroll
                for (int i = 0; i < 8; ++i) y[i] *= inv;
            }
            bf16_t* dst = c0 < 1024 ? qn + (size_t)row * 1024 + c0 : (c0 < 2048 ? kn + (size_t)row * 1024 + (c0 - 1024) : vv + (size_t)row * 1024 + (c0 - 2048));
            *(u32x4*)dst = pack8(y);
            if (SMP) { if (t >= 1) { float* o = p.out + O_CS + ((size_t)sb * 3 + (t - 1)) * 3072 + c0; *(f32x4*)o = (f32x4){xt[0], xt[1], xt[2], xt[3]}; *(f32x4*)(o + 4) = (f32x4){xt[4], xt[5], xt[6], xt[7]}; } }
            else if (t0 + t >= 2045) { float* o = p.out + O_CP + ((size_t)b * 3 + (t0 + t - 2045)) * 3072 + c0; *(f32x4*)o = (f32x4){xt[0], xt[1], xt[2], xt[3]}; *(f32x4*)(o + 4) = (f32x4){xt[4], xt[5], xt[6], xt[7]}; }
#pragma unroll
            for (int i = 0; i < 8; ++i) { xm3[i] = xm2[i]; xm2[i] = xm1[i]; xm1[i] = xt[i]; }
        }
        }
    } else {
        const int pc = (tid - 384) * 8, gi = pc >> 8, w = 2 << gi;
        const int seqrow0 = SMP ? TP + sb * 4 : b * 2048;
        const float* sp = p.in[6] + (size_t)sb * 15 * 1024 + pc;
        auto xpool = [&](int tt, float* f) {
            if (tt >= 0) unpack8(*(const u32x4*)(proj + (size_t)(seqrow0 + tt) * NPROJ + C_XP + pc), f);
            else if (SMP) { const float* s = sp + (size_t)(15 + tt) * 1024;
#pragma unroll
                for (int i = 0; i < 8; ++i) f[i] = s[i]; }
            else {
#pragma unroll
                for (int i = 0; i < 8; ++i) f[i] = 0.f; }
        };
        float s[8];
#pragma unroll
        for (int i = 0; i < 8; ++i) s[i] = 0.f;
#pragma unroll
        for (int q = 1; q < 16; ++q) if (q < w) { float f[8]; xpool(t0 - q, f);
#pragma unroll
            for (int i = 0; i < 8; ++i) s[i] += f[i]; }
#pragma unroll 4
        for (int t = 0; t < NTOK; ++t) {
            const int tt = t0 + t; float x[8], y[8], f[8];
            xpool(tt, x);
            const float cnt = SMP ? (float)w : (float)min(w, tt + 1); const float ic = 1.0f / cnt;
#pragma unroll
            for (int i = 0; i < 8; ++i) { s[i] += x[i]; y[i] = s[i] * ic - x[i]; }
            *(u32x4*)(yp + (size_t)(seqrow0 + tt) * 1024 + pc) = pack8(y);
            xpool(tt - w + 1, f);
#pragma unroll
            for (int i = 0; i < 8; ++i) s[i] -= f[i];
            if (SMP) { float* o = p.out + O_PS + ((size_t)sb * 15 + 11 + t) * 1024 + pc; *(f32x4*)o = (f32x4){x[0], x[1], x[2], x[3]}; *(f32x4*)(o + 4) = (f32x4){x[4], x[5], x[6], x[7]}; }
            else if (tt >= 2033) { float* o = p.out + O_PP + ((size_t)b * 15 + (tt - 2033)) * 1024 + pc; *(f32x4*)o = (f32x4){x[0], x[1], x[2], x[3]}; *(f32x4*)(o + 4) = (f32x4){x[4], x[5], x[6], x[7]}; }
        }
        if (SMP) {
#pragma unroll
            for (int r = 0; r < 11; ++r) { const float* s2 = sp + (size_t)(4 + r) * 1024; float* o = p.out + O_PS + ((size_t)sb * 15 + r) * 1024 + pc; *(f32x4*)o = *(const f32x4*)s2; *(f32x4*)(o + 4) = *(const f32x4*)(s2 + 4); } }
    }
    if (tid < 256) { const int tk = tid >> 4, jj = tid & 15;
        if (tk < NTOK) { const int row = rowbase + tk; const float val = bf2f(gate_raw);
            if (jj < 8) { const float xx = val + p.in[13][jj]; const float spl = xx > 20.f ? xx : log1pf(__expf(xx)); gbuf[row * 8 + jj] = -__expf(p.in[12][jj]) * spl; }
            else bbuf[row * 8 + (jj - 8)] = sigmoidf_(val); } }
}
__device__ __forceinline__ void mixer_prep_phase(const Params& p, int bid, int nblk) {
    for (int it = bid; it < 640; it += nblk) { if (it >= 512) mixer_item<4, true>(p, it); else mixer_item<16, false>(p, it); }
}

constexpr int P5_QS = 0, P5_KS = 17408, P5_VS = 34816, P5_MM = 52224, P5_DEC = 68608, P5_BETA = 68864, P5_GRP = 69632;
static_assert(2 * P5_GRP <= LDS_BYTES - 16, "lds");
__device__ __forceinline__ void chunk_prep_phase(const Params& p, int bid, int nblk, LAS unsigned char* lds0) {
    const int tid = threadIdx.x, lane = tid & 63, grp = tid >> 8, lt = tid & 255, lw = __builtin_amdgcn_readfirstlane(tid >> 6) & 3;
    LAS unsigned char* lds = lds0 + grp * P5_GRP;
    const bf16_t* qn = (const bf16_t*)(p.ws + WS_QN); const bf16_t* kn = (const bf16_t*)(p.ws + WS_KN); const bf16_t* vv = (const bf16_t*)(p.ws + WS_VV);
    const float* gbuf = (const float*)(p.ws + WS_G); const float* bbuf = (const float*)(p.ws + WS_BETA);
    bf16_t* wdc = (bf16_t*)(p.ws + WS_WDC); bf16_t* qd = (bf16_t*)(p.ws + WS_QD); bf16_t* kt = (bf16_t*)(p.ws + WS_KT); bf16_t* qk = (bf16_t*)(p.ws + WS_QK);
    float* cdv = (float*)(p.ws + WS_CD); float* ub = p.out + OS_UB;
    LAS float* Mm = (LAS float*)(lds + P5_MM); LAS float* dec = (LAS float*)(lds + P5_DEC); LAS float* bet = (LAS float*)(lds + P5_BETA);
    const float scale = 0.08838834764831845f;
    for (int it0 = bid * 2; it0 < 1024; it0 += nblk * 2) {
        const int item = it0 + grp, n = item & 31, bh = item >> 5, h = bh & 7, b = bh >> 3;
        const int r0 = b * 2048 + n * 64;
        __syncthreads();
        const float gb_raw = lt < 64 ? gbuf[(r0 + lt) * 8 + h] : (lt < 128 ? bbuf[(r0 + lt - 64) * 8 + h] : 0.f);
#pragma unroll
        for (int i = 0; i < 4; ++i) { const int ch = lt + 256 * i, r = ch >> 4, c8 = (ch & 15) * 8; const size_t go = (size_t)(r0 + r) * 1024 + h * 128 + c8; const int lo = r * 272 + c8 * 2;
            *(LAS u32x4*)(lds + P5_QS + lo) = *(const u32x4*)(qn + go); *(LAS u32x4*)(lds + P5_KS + lo) = *(const u32x4*)(kn + go); *(LAS u32x4*)(lds + P5_VS + lo) = *(const u32x4*)(vv + go); }
        if (lt < 64) {
            float g = gb_raw;
#pragma unroll
            for (int o = 1; o < 64; o <<= 1) { const float t = __shfl_up(g, o); if (lane >= o) g += t; }
            dec[lt] = g;
        } else if (lt < 128) bet[lt - 64] = gb_raw;
        __syncthreads();
        {
            const int rt = lw, fr = lane & 15, fq = lane >> 4;
#pragma unroll
            for (int mat = 0; mat < 2; ++mat) {
                bf16x8 a[4];
#pragma unroll
                for (int kk = 0; kk < 4; ++kk) a[kk] = *(const LAS bf16x8*)(lds + (mat ? P5_QS : P5_KS) + (rt * 16 + fr) * 272 + (kk * 32 + fq * 8) * 2);
#pragma unroll
                for (int st = 0; st < 4; ++st) {
                    f32x4 d = (f32x4){0.f, 0.f, 0.f, 0.f};
#pragma unroll
                    for (int kk = 0; kk < 4; ++kk) { const bf16x8 bb = *(const LAS bf16x8*)(lds + P5_KS + (st * 16 + fr) * 272 + (kk * 32 + fq * 8) * 2); d = __builtin_amdgcn_mfma_f32_16x16x32_bf16(a[kk], bb, d, 0, 0, 0); }
                    const int s = st * 16 + fr; const float ds = dec[s];
#pragma unroll
                    for (int j = 0; j < 4; ++j) { const int r = rt * 16 + fq * 4 + j; const float dr = dec[r];
                        if (mat == 0) Mm[r * 64 + s] = (r > s) ? bet[r] * d[j] * __expf(dr - ds) : 0.f;
                        else qk[(size_t)item * 4096 + r * 64 + s] = f2bf((r >= s) ? scale * d[j] * __expf(dr - ds) : 0.f); }
                }
            }
        }
        __syncthreads();
        const int w8 = __builtin_amdgcn_readfirstlane(tid >> 6);
        if (w8 < 4) {
            const int g2 = w8 >> 1, c = (w8 & 1) * 64 + lane; const int item2 = it0 + g2;
            LAS unsigned char* lg = lds0 + g2 * P5_GRP; LAS float* Mg = (LAS float*)(lg + P5_MM); LAS float* decg = (LAS float*)(lg + P5_DEC); LAS float* betg = (LAS float*)(lg + P5_BETA);
            f32x2 xy[64]; f32x4 mq[6]; f32x2 ab0, ab1;
            float* up = ub + (size_t)item2 * 8192 + c; bf16_t* wp = wdc + (size_t)item2 * 8192 + c;
            { const float br = betg[0]; ab0 = (f32x2){bf2f(*(const LAS bf16_t*)(lg + P5_VS + 0 + c * 2)) * br, bf2f(*(const LAS bf16_t*)(lg + P5_KS + 0 + c * 2)) * br * __expf(decg[0])}; ab1 = (f32x2){0.f, 0.f}; } xy[0] = ab0; up[0] = xy[0][0]; wp[0] = f2bf(-xy[0][1]);
            mq[0] = *(const LAS f32x4*)(Mg + 64); mq[1] = *(const LAS f32x4*)(Mg + 128); mq[2] = *(const LAS f32x4*)(Mg + 192); mq[3] = *(const LAS f32x4*)(Mg + 256); mq[4] = *(const LAS f32x4*)(Mg + 320); mq[5] = *(const LAS f32x4*)(Mg + 324);
            { const float br = betg[1]; ab0 = (f32x2){bf2f(*(const LAS bf16_t*)(lg + P5_VS + 272 + c * 2)) * br, bf2f(*(const LAS bf16_t*)(lg + P5_KS + 272 + c * 2)) * br * __expf(decg[1])}; ab1 = (f32x2){0.f, 0.f}; } ab0 -= mq[0][0] * xy[0]; xy[1] = ab0 + ab1; up[128] = xy[1][0]; wp[128] = f2bf(-xy[1][1]); mq[0] = *(const LAS f32x4*)(Mg + 384);
            { const float br = betg[2]; ab0 = (f32x2){bf2f(*(const LAS bf16_t*)(lg + P5_VS + 544 + c * 2)) * br, bf2f(*(const LAS bf16_t*)(lg + P5_KS + 544 + c * 2)) * br * __expf(decg[2])}; ab1 = (f32x2){0.f, 0.f}; } ab0 -= mq[1][0] * xy[0]; ab1 -= mq[1][1] * xy[1]; xy[2] = ab0 + ab1; up[256] = xy[2][0]; wp[256] = f2bf(-xy[2][1]); mq[1] = *(const LAS f32x4*)(Mg + 388);
            { const float br = betg[3]; ab0 = (f32x2){bf2f(*(const LAS bf16_t*)(lg + P5_VS + 816 + c * 2)) * br, bf2f(*(const LAS bf16_t*)(lg + P5_KS + 816 + c * 2)) * br * __expf(decg[3])}; ab1 = (f32x2){0.f, 0.f}; } ab0 -= mq[2][0] * xy[0]; ab1 -= mq[2][1] * xy[1]; ab0 -= mq[2][2] * xy[2]; xy[3] = ab0 + ab1; up[384] = xy[3][0]; wp[384] = f2bf(-xy[3][1]); mq[2] = *(const LAS f32x4*)(Mg + 448);
            { const float br = betg[4]; ab0 = (f32x2){bf2f(*(const LAS bf16_t*)(lg + P5_VS + 1088 + c * 2)) * br, bf2f(*(const LAS bf16_t*)(lg + P5_KS + 1088 + c * 2)) * br * __expf(decg[4])}; ab1 = (f32x2){0.f, 0.f}; } ab0 -= mq[3][0] * xy[0]; ab1 -= mq[3][1] * xy[1]; ab0 -= mq[3][2] * xy[2]; ab1 -= mq[3][3] * xy[3]; xy[4] = ab0 + ab1; up[512] = xy[4][0]; wp[512] = f2bf(-xy[4][1]); mq[3] = *(const LAS f32x4*)(Mg + 452);
            { const float br = betg[5]; ab0 = (f32x2){bf2f(*(const LAS bf16_t*)(lg + P5_VS + 1360 + c * 2)) * br, bf2f(*(const LAS bf16_t*)(lg + P5_KS + 1360 + c * 2)) * br * __expf(decg[5])}; ab1 = (f32x2){0.f, 0.f}; } ab0 -= mq[4][0] * xy[0]; ab1 -= mq[4][1] * xy[1]; ab0 -= mq[4][2] * xy[2]; ab1 -= mq[4][3] * xy[3]; mq[4] = *(const LAS f32x4*)(Mg + 512);
            ab0 -= mq[5][0] * xy[4]; xy[5] = ab0 + ab1; up[640] = xy[5][0]; wp[640] = f2bf(-xy[5][1]); mq[5] = *(const LAS f32x4*)(Mg + 516);
            { const float br = betg[6]; ab0 = (f32x2){bf2f(*(const LAS bf16_t*)(lg + P5_VS + 1632 + c * 2)) * br, bf2f(*(const LAS bf16_t*)(lg + P5_KS + 1632 + c * 2)) * br * __expf(decg[6])}; ab1 = (f32x2){0.f, 0.f}; } ab0 -= mq[0][0] * xy[0]; ab1 -= mq[0][1] * xy[1]; ab0 -= mq[0][2] * xy[2]; ab1 -= mq[0][3] * xy[3]; mq[0] = *(const LAS f32x4*)(Mg + 576);
            ab0 -= mq[1][0] * xy[4]; ab1 -= mq[1][1] * xy[5]; xy[6] = ab0 + ab1; up[768] = xy[6][0]; wp[768] = f2bf(-xy[6][1]); mq[1] = *(const LAS f32x4*)(Mg + 580);
            { const float br = betg[7]; ab0 = (f32x2){bf2f(*(const LAS bf16_t*)(lg + P5_VS + 1904 + c * 2)) * br, bf2f(*(const LAS bf16_t*)(lg + P5_KS + 1904 + c * 2)) * br * __expf(decg[7])}; ab1 = (f32x2){0.f, 0.f}; } ab0 -= mq[2][0] * xy[0]; ab1 -= mq[2][1] * xy[1]; ab0 -= mq[2][2] * xy[2]; ab1 -= mq[2][3] * xy[3]; mq[2] = *(const LAS f32x4*)(Mg + 584);
            ab0 -= mq[3][0] * xy[4]; ab1 -= mq[3][1] * xy[5]; ab0 -= mq[3][2] * xy[6]; xy[7] = ab0 + ab1; up[896] = xy[7][0]; wp[896] = f2bf(-xy[7][1]); mq[3] = *(const LAS f32x4*)(Mg + 640);
            { const float br = betg[8]; ab0 = (f32x2){bf2f(*(const LAS bf16_t*)(lg + P5_VS + 2176 + c * 2)) * br, bf2f(*(const LAS bf16_t*)(lg + P5_KS + 2176 + c * 2)) * br * __expf(decg[8])}; ab1 = (f32x2){0.f, 0.f}; } ab0 -= mq[4][0] * xy[0]; ab1 -= mq[4][1] * xy[1]; ab0 -= mq[4][2] * xy[2]; ab1 -= mq[4][3] * xy[3]; mq[4] = *(const LAS f32x4*)(Mg + 644);
            ab0 -= mq[5][0] * xy[4]; ab1 -= mq[5][1] * xy[5]; ab0 -= mq[5][2] * xy[6]; ab1 -= mq[5][3] * xy[7]; xy[8] = ab0 + ab1; up[1024] = xy[8][0]; wp[1024] = f2bf(-xy[8][1]); mq[5] = *(const LAS f32x4*)(Mg + 648);
            { const float br = betg[9]; ab0 = (f32x2){bf2f(*(const LAS bf16_t*)(lg + P5_VS + 2448 + c * 2)) * br, bf2f(*(const LAS bf16_t*)(lg + P5_KS + 2448 + c * 2)) * br * __expf(decg[9])}; ab1 = (f32x2){0.f, 0.f}; } ab0 -= mq[0][0] * xy[0]; ab1 -= mq[0][1] * xy[1]; ab0 -= mq[0][2] * xy[2]; ab1 -= mq[0][3] * xy[3]; mq[0] = *(const LAS f32x4*)(Mg + 704);
            ab0 -= mq[1][0] * xy[4]; ab1 -= mq[1][1] * xy[5]; ab0 -= mq[1][2] * xy[6]; ab1 -= mq[1][3] * xy[7]; mq[1] = *(const LAS f32x4*)(Mg + 708);
            ab0 -= mq[2][0] * xy[8]; xy[9] = ab0 + ab1; up[1152] = xy[9][0]; wp[1152] = f2bf(-xy[9][1]); mq[2] = *(const LAS f32x4*)(Mg + 712);
            { const float br = betg[10]; ab0 = (f32x2){bf2f(*(const LAS bf16_t*)(lg + P5_VS + 2720 + c * 2)) * br, bf2f(*(const LAS bf16_t*)(lg + P5_KS + 2720 + c * 2)) * br * __expf(decg[10])}; ab1 = (f32x2){0.f, 0.f}; } ab0 -= mq[3][0] * xy[0]; ab1 -= mq[3][1] * xy[1]; ab0 -= mq[3][2] * xy[2]; ab1 -= mq[3][3] * xy[3]; mq[3] = *(const LAS f32x4*)(Mg + 768);
            ab0 -= mq[4][0] * xy[4]; ab1 -= mq[4][1] * xy[5]; ab0 -= mq[4][2] * xy[6]; ab1 -= mq[4][3] * xy[7]; mq[4] = *(const LAS f32x4*)(Mg + 772);
            ab0 -= mq[5][0] * xy[8]; ab1 -= mq[5][1] * xy[9]; xy[10] = ab0 + ab1; up[1280] = xy[10][0]; wp[1280] = f2bf(-xy[10][1]); mq[5] = *(const LAS f32x4*)(Mg + 776);
            { const float br = betg[11]; ab0 = (f32x2){bf2f(*(const LAS bf16_t*)(lg + P5_VS + 2992 + c * 2)) * br, bf2f(*(const LAS bf16_t*)(lg + P5_KS + 2992 + c * 2)) * br * __expf(decg[11])}; ab1 = (f32x2){0.f, 0.f}; } ab0 -= mq[0][0] * xy[0]; ab1 -= mq[0][1] * xy[1]; ab0 -= mq[0][2] * xy[2]; ab1 -= mq[0][3] * xy[3]; mq[0] = *(const LAS f32x4*)(Mg + 832);
            ab0 -= mq[1][0] * xy[4]; ab1 -= mq[1][1] * xy[5]; ab0 -= mq[1][2] * xy[6]; ab1 -= mq[1][3] * xy[7]; mq[1] = *(const LAS f32x4*)(Mg + 836);
            ab0 -= mq[2][0] * xy[8]; ab1 -= mq[2][1] * xy[9]; ab0 -= mq[2][2] * xy[10]; xy[11] = ab0 + ab1; up[1408] = xy[11][0]; wp[1408] = f2bf(-xy[11][1]); mq[2] = *(const LAS f32x4*)(Mg + 840);
            { const float br = betg[12]; ab0 = (f32x2){bf2f(*(const LAS bf16_t*)(lg + P5_VS + 3264 + c * 2)) * br, bf2f(*(const LAS bf16_t*)(lg + P5_KS + 3264 + c * 2)) * br * __expf(decg[12])}; ab1 = (f32x2){0.f, 0.f}; } ab0 -= mq[3][0] * xy[0]; ab1 -= mq[3][1] * xy[1]; ab0 -= mq[3][2] * xy[2]; ab1 -= mq[3][3] * xy[3]; mq[3] = *(const LAS f32x4*)(Mg + 844);
            ab0 -= mq[4][0] * xy[4]; ab1 -= mq[4][1] * xy[5]; ab0 -= mq[4][2] * xy[6]; ab1 -= mq[4][3] * xy[7]; mq[4] = *(const LAS f32x4*)(Mg + 896);
            ab0 -= mq[5][0] * xy[8]; ab1 -= mq[5][1] * xy[9]; ab0 -= mq[5][2] * xy[10]; ab1 -= mq[5][3] * xy[11]; xy[12] = ab0 + ab1; up[1536] = xy[12][0]; wp[1536] = f2bf(-xy[12][1]); mq[5] = *(const LAS f32x4*)(Mg + 900);
            { const float br = betg[13]; ab0 = (f32x2){bf2f(*(const LAS bf16_t*)(lg + P5_VS + 3536 + c * 2)) * br, bf2f(*(const LAS bf16_t*)(lg + P5_KS + 3536 + c * 2)) * br * __expf(decg[13])}; ab1 = (f32x2){0.f, 0.f}; } ab0 -= mq[0][0] * xy[0]; ab1 -= mq[0][1] * xy[1]; ab0 -= mq[0][2] * xy[2]; ab1 -= mq[0][3] * xy[3]; mq[0] = *(const LAS f32x4*)(Mg + 904);
            ab0 -= mq[1][0] * xy[4]; ab1 -= mq[1][1] * xy[5]; ab0 -= mq[1][2] * xy[6]; ab1 -= mq[1][3] * xy[7]; mq[1] = *(const LAS f32x4*)(Mg + 908);
            ab0 -= mq[2][0] * xy[8]; ab1 -= mq[2][1] * xy[9]; ab0 -= mq[2][2] * xy[10]; ab1 -= mq[2][3] * xy[11]; mq[2] = *(const LAS f32x4*)(Mg + 960);
            ab0 -= mq[3][0] * xy[12]; xy[13] = ab0 + ab1; up[1664] = xy[13][0]; wp[1664] = f2bf(-xy[13][1]); mq[3] = *(const LAS f32x4*)(Mg + 964);
            { const float br = betg[14]; ab0 = (f32x2){bf2f(*(const LAS bf16_t*)(lg + P5_VS + 3808 + c * 2)) * br, bf2f(*(const LAS bf16_t*)(lg + P5_KS + 3808 + c * 2)) * br * __expf(decg[14])}; ab1 = (f32x2){0.f, 0.f}; } ab0 -= mq[4][0] * xy[0]; ab1 -= mq[4][1] * xy[1]; ab0 -= mq[4][2] * xy[2]; ab1 -= mq[4][3] * xy[3]; mq[4] = *(const LAS f32x4*)(Mg + 968);
            ab0 -= mq[5][0] * xy[4]; ab1 -= mq[5][1] * xy[5]; ab0 -= mq[5][2] * xy[6]; ab1 -= mq[5][3] * xy[7]; mq[5] = *(const LAS f32x4*)(Mg + 972);
            ab0 -= mq[0][0] * xy[8]; ab1 -= mq[0][1] * xy[9]; ab0 -= mq[0][2] * xy[10]; ab1 -= mq[0][3] * xy[11]; mq[0] = *(const LAS f32x4*)(Mg + 1024);
            ab0 -= mq[1][0] * xy[12]; ab1 -= mq[1][1] * xy[13]; xy[14] = ab0 + ab1; up[1792] = xy[14][0]; wp[1792] = f2bf(-xy[14][1]); mq[1] = *(const LAS f32x4*)(Mg + 1028);
            { const float br = betg[15]; ab0 = (f32x2){bf2f(*(const LAS bf16_t*)(lg + P5_VS + 4080 + c * 2)) * br, bf2f(*(const LAS bf16_t*)(lg + P5_KS + 4080 + c * 2)) * br * __expf(decg[15])}; ab1 = (f32x2){0.f, 0.f}; } ab0 -= mq[2][0] * xy[0]; ab1 -= mq[2][1] * xy[1]; ab0 -= mq[2][2] * xy[2]; ab1 -= mq[2][3] * xy[3]; mq[2] = *(const LAS f32x4*)(Mg + 1032);
            ab0 -= mq[3][0] * xy[4]; ab1 -= mq[3][1] * xy[5]; ab0 -= mq[3][2] * xy[6]; ab1 -= mq[3][3] * xy[7]; mq[3] = *(const LAS f32x4*)(Mg + 1036);
            ab0 -= mq[4][0] * xy[8]; ab1 -= mq[4][1] * xy[9]; ab0 -= mq[4][2] * xy[10]; ab1 -= mq[4][3] * xy[11]; mq[4] = *(const LAS f32x4*)(Mg + 1088);
            ab0 -= mq[5][0] * xy[12]; ab1 -= mq[5][1] * xy[13]; ab0 -= mq[5][2] * xy[14]; xy[15] = ab0 + ab1; up[1920] = xy[15][0]; wp[1920] = f2bf(-xy[15][1]); mq[5] = *(const LAS f32x4*)(Mg + 1092);
            { const float br = betg[16]; ab0 = (f32x2){bf2f(*(const LAS bf16_t*)(lg + P5_VS + 4352 + c * 2)) * br, bf2f(*(const LAS bf16_t*)(lg + P5_KS + 4352 + c * 2)) * br * __expf(decg[16])}; ab1 = (f32x2){0.f, 0.f}; } ab0 -= mq[0][0] * xy[0]; ab1 -= mq[0][1] * xy[1]; ab0 -= mq[0][2] * xy[2]; ab1 -= mq[0][3] * xy[3]; mq[0] = *(const LAS f32x4*)(Mg + 1096);
            ab0 -= mq[1][0] * xy[4]; ab1 -= mq[1][1] * xy[5]; ab0 -= mq[1][2] * xy[6]; ab1 -= mq[1][3] * xy[7]; mq[1] = *(const LAS f32x4*)(Mg + 1100);
            ab0 -= mq[2][0] * xy[8]; ab1 -= mq[2][1] * xy[9]; ab0 -= mq[2][2] * xy[10]; ab1 -= mq[2][3] * xy[11]; mq[2] = *(const LAS f32x4*)(Mg + 1104);
            ab0 -= mq[3][0] * xy[12]; ab1 -= mq[3][1] * xy[13]; ab0 -= mq[3][2] * xy[14]; ab1 -= mq[3][3] * xy[15]; xy[16] = ab0 + ab1; up[2048] = xy[16][0]; wp[2048] = f2bf(-xy[16][1]); mq[3] = *(const LAS f32x4*)(Mg + 1152);
            { const float br = betg[17]; ab0 = (f32x2){bf2f(*(const LAS bf16_t*)(lg + P5_VS + 4624 + c * 2)) * br, bf2f(*(const LAS bf16_t*)(lg + P5_KS + 4624 + c * 2)) * br * __expf(decg[17])}; ab1 = (f32x2){0.f, 0.f}; } ab0 -= mq[4][0] * xy[0]; ab1 -= mq[4][1] * xy[1]; ab0 -= mq[4][2] * xy[2]; ab1 -= mq[4][3] * xy[3]; mq[4] = *(const LAS f32x4*)(Mg + 1156);
            ab0 -= mq[5][0] * xy[4]; ab1 -= mq[5][1] * xy[5]; ab0 -= mq[5][2] * xy[6]; ab1 -= mq[5][3] * xy[7]; mq[5] = *(const LAS f32x4*)(Mg + 1160);
            ab0 -= mq[0][0] * xy[8]; ab1 -= mq[0][1] * xy[9]; ab0 -= mq[0][2] * xy[10]; ab1 -= mq[0][3] * xy[11]; mq[0] = *(const LAS f32x4*)(Mg + 1164);
            ab0 -= mq[1][0] * xy[12]; ab1 -= mq[1][1] * xy[13]; ab0 -= mq[1][2] * xy[14]; ab1 -= mq[1][3] * xy[15]; mq[1] = *(const LAS f32x4*)(Mg + 1168);
            ab0 -= mq[2][0] * xy[16]; xy[17] = ab0 + ab1; up[2176] = xy[17][0]; wp[2176] = f2bf(-xy[17][1]); mq[2] = *(const LAS f32x4*)(Mg + 1216);
            { const float br = betg[18]; ab0 = (f32x2){bf2f(*(const LAS bf16_t*)(lg + P5_VS + 4896 + c * 2)) * br, bf2f(*(const LAS bf16_t*)(lg + P5_KS + 4896 + c * 2)) * br * __expf(decg[18])}; ab1 = (f32x2){0.f, 0.f}; } ab0 -= mq[3][0] * xy[0]; ab1 -= mq[3][1] * xy[1]; ab0 -= mq[3][2] * xy[2]; ab1 -= mq[3][3] * xy[3]; mq[3] = *(const LAS f32x4*)(Mg + 1220);
            ab0 -= mq[4][0] * xy[4]; ab1 -= mq[4][1] * xy[5]; ab0 -= mq[4][2] * xy[6]; ab1 -= mq[4][3] * xy[7]; mq[4] = *(const LAS f32x4*)(Mg + 1224);
            ab0 -= mq[5][0] * xy[8]; ab1 -= mq[5][1] * xy[9]; ab0 -= mq[5][2] * xy[10]; ab1 -= mq[5][3] * xy[11]; mq[5] = *(const LAS f32x4*)(Mg + 1228);
            ab0 -= mq[0][0] * xy[12]; ab1 -= mq[0][1] * xy[13]; ab0 -= mq[0][2] * xy[14]; ab1 -= mq[0][3] * xy[15]; mq[0] = *(const LAS f32x4*)(Mg + 1232);
            ab0 -= mq[1][0] * xy[16]; ab1 -= mq[1][1] * xy[17]; xy[18] = ab0 + ab1; up[2304] = xy[18][0]; wp[2304] = f2bf(-xy[18][1]); mq[1] = *(const LAS f32x4*)(Mg + 1280);
            { const float br = betg[19]; ab0 = (f32x2){bf2f(*(const LAS bf16_t*)(lg + P5_VS + 5168 + c * 2)) * br, bf2f(*(const LAS bf16_t*)(lg + P5_KS + 5168 + c * 2)) * br * __expf(decg[19])}; ab1 = (f32x2){0.f, 0.f}; } ab0 -= mq[2][0] * xy[0]; ab1 -= mq[2][1] * xy[1]; ab0 -= mq[2][2] * xy[2]; ab1 -= mq[2][3] * xy[3]; mq[2] = *(const LAS f32x4*)(Mg + 1284);
            ab0 -= mq[3][0] * xy[4]; ab1 -= mq[3][1] * xy[5]; ab0 -= mq[3][2] * xy[6]; ab1 -= mq[3][3] * xy[7]; mq[3] = *(const LAS f32x4*)(Mg + 1288);
            ab0 -= mq[4][0] * xy[8]; ab1 -= mq[4][1] * xy[9]; ab0 -= mq[4][2] * xy[10]; ab1 -= mq[4][3] * xy[11]; mq[4] = *(const LAS f32x4*)(Mg + 1292);
            ab0 -= mq[5][0] * xy[12]; ab1 -= mq[5][1] * xy[13]; ab0 -= mq[5][2] * xy[14]; ab1 -= mq[5][3] * xy[15]; mq[5] = *(const LAS f32x4*)(Mg + 1296);
            ab0 -= mq[0][0] * xy[16]; ab1 -= mq[0][1] * xy[17]; ab0 -= mq[0][2] * xy[18]; xy[19] = ab0 + ab1; up[2432] = xy[19][0]; wp[2432] = f2bf(-xy[19][1]); mq[0] = *(const LAS f32x4*)(Mg + 1344);
            { const float br = betg[20]; ab0 = (f32x2){bf2f(*(const LAS bf16_t*)(lg + P5_VS + 5440 + c * 2)) * br, bf2f(*(const LAS bf16_t*)(lg + P5_KS + 5440 + c * 2)) * br * __expf(decg[20])}; ab1 = (f32x2){0.f, 0.f}; } ab0 -= mq[1][0] * xy[0]; ab1 -= mq[1][1] * xy[1]; ab0 -= mq[1][2] * xy[2]; ab1 -= mq[1][3] * xy[3]; mq[1] = *(const LAS f32x4*)(Mg + 1348);
            ab0 -= mq[2][0] * xy[4]; ab1 -= mq[2][1] * xy[5]; ab0 -= mq[2][2] * xy[6]; ab1 -= mq[2][3] * xy[7]; mq[2] = *(const LAS f32x4*)(Mg + 1352);
            ab0 -= mq[3][0] * xy[8]; ab1 -= mq[3][1] * xy[9]; ab0 -= mq[3][2] * xy[10]; ab1 -= mq[3][3] * xy[11]; mq[3] = *(const LAS f32x4*)(Mg + 1356);
            ab0 -= mq[4][0] * xy[12]; ab1 -= mq[4][1] * xy[13]; ab0 -= mq[4][2] * xy[14]; ab1 -= mq[4][3] * xy[15]; mq[4] = *(const LAS f32x4*)(Mg + 1360);
            ab0 -= mq[5][0] * xy[16]; ab1 -= mq[5][1] * xy[17]; ab0 -= mq[5][2] * xy[18]; ab1 -= mq[5][3] * xy[19]; xy[20] = ab0 + ab1; up[2560] = xy[20][0]; wp[2560] = f2bf(-xy[20][1]); mq[5] = *(const LAS f32x4*)(Mg + 1364);
            { const float br = betg[21]; ab0 = (f32x2){bf2f(*(const LAS bf16_t*)(lg + P5_VS + 5712 + c * 2)) * br, bf2f(*(const LAS bf16_t*)(lg + P5_KS + 5712 + c * 2)) * br * __expf(decg[21])}; ab1 = (f32x2){0.f, 0.f}; } ab0 -= mq[0][0] * xy[0]; ab1 -= mq[0][1] * xy[1]; ab0 -= mq[0][2] * xy[2]; ab1 -= mq[0][3] * xy[3]; mq[0] = *(const LAS f32x4*)(Mg + 1408);
            ab0 -= mq[1][0] * xy[4]; ab1 -= mq[1][1] * xy[5]; ab0 -= mq[1][2] * xy[6]; ab1 -= mq[1][3] * xy[7]; mq[1] = *(const LAS f32x4*)(Mg + 1412);
            ab0 -= mq[2][0] * xy[8]; ab1 -= mq[2][1] * xy[9]; ab0 -= mq[2][2] * xy[10]; ab1 -= mq[2][3] * xy[11]; mq[2] = *(const LAS f32x4*)(Mg + 1416);
            ab0 -= mq[3][0] * xy[12]; ab1 -= mq[3][1] * xy[13]; ab0 -= mq[3][2] * xy[14]; ab1 -= mq[3][3] * xy[15]; mq[3] = *(const LAS f32x4*)(Mg + 1420);
            ab0 -= mq[4][0] * xy[16]; ab1 -= mq[4][1] * xy[17]; ab0 -= mq[4][2] * xy[18]; ab1 -= mq[4][3] * xy[19]; mq[4] = *(const LAS f32x4*)(Mg + 1424);
            ab0 -= mq[5][0] * xy[20]; xy[21] = ab0 + ab1; up[2688] = xy[21][0]; wp[2688] = f2bf(-xy[21][1]); mq[5] = *(const LAS f32x4*)(Mg + 1428);
            { const float br = betg[22]; ab0 = (f32x2){bf2f(*(const LAS bf16_t*)(lg + P5_VS + 5984 + c * 2)) * br, bf2f(*(const LAS bf16_t*)(lg + P5_KS + 5984 + c * 2)) * br * __expf(decg[22])}; ab1 = (f32x2){0.f, 0.f}; } ab0 -= mq[0][0] * xy[0]; ab1 -= mq[0][1] * xy[1]; ab0 -= mq[0][2] * xy[2]; ab1 -= mq[0][3] * xy[3]; mq[0] = *(const LAS f32x4*)(Mg + 1472);
            ab0 -= mq[1][0] * xy[4]; ab1 -= mq[1][1] * xy[5]; ab0 -= mq[1][2] * xy[6]; ab1 -= mq[1][3] * xy[7]; mq[1] = *(const LAS f32x4*)(Mg + 1476);
            ab0 -= mq[2][0] * xy[8]; ab1 -= mq[2][1] * xy[9]; ab0 -= mq[2][2] * xy[10]; ab1 -= mq[2][3] * xy[11]; mq[2] = *(const LAS f32x4*)(Mg + 1480);
            ab0 -= mq[3][0] * xy[12]; ab1 -= mq[3][1] * xy[13]; ab0 -= mq[3][2] * xy[14]; ab1 -= mq[3][3] * xy[15]; mq[3] = *(const LAS f32x4*)(Mg + 1484);
            ab0 -= mq[4][0] * xy[16]; ab1 -= mq[4][1] * xy[17]; ab0 -= mq[4][2] * xy[18]; ab1 -= mq[4][3] * xy[19]; mq[4] = *(const LAS f32x4*)(Mg + 1488);
            ab0 -= mq[5][0] * xy[20]; ab1 -= mq[5][1] * xy[21]; xy[22] = ab0 + ab1; up[2816] = xy[22][0]; wp[2816] = f2bf(-xy[22][1]); mq[5] = *(const LAS f32x4*)(Mg + 1492);
            { const float br = betg[23]; ab0 = (f32x2){bf2f(*(const LAS bf16_t*)(lg + P5_VS + 6256 + c * 2)) * br, bf2f(*(const LAS bf16_t*)(lg + P5_KS + 6256 + c * 2)) * br * __expf(decg[23])}; ab1 = (f32x2){0.f, 0.f}; } ab0 -= mq[0][0] * xy[0]; ab1 -= mq[0][1] * xy[1]; ab0 -= mq[0][2] * xy[2]; ab1 -= mq[0][3] * xy[3]; mq[0] = *(const LAS f32x4*)(Mg + 1536);
            ab0 -= mq[1][0] * xy[4]; ab1 -= mq[1][1] * xy[5]; ab0 -= mq[1][2] * xy[6]; ab1 -= mq[1][3] * xy[7]; mq[1] = *(const LAS f32x4*)(Mg + 1540);
            ab0 -= mq[2][0] * xy[8]; ab1 -= mq[2][1] * xy[9]; ab0 -= mq[2][2] * xy[10]; ab1 -= mq[2][3] * xy[11]; mq[2] = *(const LAS f32x4*)(Mg + 1544);
            ab0 -= mq[3][0] * xy[12]; ab1 -= mq[3][1] * xy[13]; ab0 -= mq[3][2] * xy[14]; ab1 -= mq[3][3] * xy[15]; mq[3] = *(const LAS f32x4*)(Mg + 1548);
            ab0 -= mq[4][0] * xy[16]; ab1 -= mq[4][1] * xy[17]; ab0 -= mq[4][2] * xy[18]; ab1 -= mq[4][3] * xy[19]; mq[4] = *(const LAS f32x4*)(Mg + 1552);
            ab0 -= mq[5][0] * xy[20]; ab1 -= mq[5][1] * xy[21]; ab0 -= mq[5][2] * xy[22]; xy[23] = ab0 + ab1; up[2944] = xy[23][0]; wp[2944] = f2bf(-xy[23][1]); mq[5] = *(const LAS f32x4*)(Mg + 1556);
            { const float br = betg[24]; ab0 = (f32x2){bf2f(*(const LAS bf16_t*)(lg + P5_VS + 6528 + c * 2)) * br, bf2f(*(const LAS bf16_t*)(lg + P5_KS + 6528 + c * 2)) * br * __expf(decg[24])}; ab1 = (f32x2){0.f, 0.f}; } ab0 -= mq[0][0] * xy[0]; ab1 -= mq[0][1] * xy[1]; ab0 -= mq[0][2] * xy[2]; ab1 -= mq[0][3] * xy[3]; mq[0] = *(const LAS f32x4*)(Mg + 1600);
            ab0 -= mq[1][0] * xy[4]; ab1 -= mq[1][1] * xy[5]; ab0 -= mq[1][2] * xy[6]; ab1 -= mq[1][3] * xy[7]; mq[1] = *(const LAS f32x4*)(Mg + 1604);
            ab0 -= mq[2][0] * xy[8]; ab1 -= mq[2][1] * xy[9]; ab0 -= mq[2][2] * xy[10]; ab1 -= mq[2][3] * xy[11]; mq[2] = *(const LAS f32x4*)(Mg + 1608);
            ab0 -= mq[3][0] * xy[12]; ab1 -= mq[3][1] * xy[13]; ab0 -= mq[3][2] * xy[14]; ab1 -= mq[3][3] * xy[15]; mq[3] = *(const LAS f32x4*)(Mg + 1612);
            ab0 -= mq[4][0] * xy[16]; ab1 -= mq[4][1] * xy[17]; ab0 -= mq[4][2] * xy[18]; ab1 -= mq[4][3] * xy[19]; mq[4] = *(const LAS f32x4*)(Mg + 1616);
            ab0 -= mq[5][0] * xy[20]; ab1 -= mq[5][1] * xy[21]; ab0 -= mq[5][2] * xy[22]; ab1 -= mq[5][3] * xy[23]; xy[24] = ab0 + ab1; up[3072] = xy[24][0]; wp[3072] = f2bf(-xy[24][1]); mq[5] = *(const LAS f32x4*)(Mg + 1620);
            { const float br = betg[25]; ab0 = (f32x2){bf2f(*(const LAS bf16_t*)(lg + P5_VS + 6800 + c * 2)) * br, bf2f(*(const LAS bf16_t*)(lg + P5_KS + 6800 + c * 2)) * br * __expf(decg[25])}; ab1 = (f32x2){0.f, 0.f}; } ab0 -= mq[0][0] * xy[0]; ab1 -= mq[0][1] * xy[1]; ab0 -= mq[0][2] * xy[2]; ab1 -= mq[0][3] * xy[3]; mq[0] = *(const LAS f32x4*)(Mg + 1624);
            ab0 -= mq[1][0] * xy[4]; ab1 -= mq[1][1] * xy[5]; ab0 -= mq[1][2] * xy[6]; ab1 -= mq[1][3] * xy[7]; mq[1] = *(const LAS f32x4*)(Mg + 1664);
            ab0 -= mq[2][0] * xy[8]; ab1 -= mq[2][1] * xy[9]; ab0 -= mq[2][2] * xy[10]; ab1 -= mq[2][3] * xy[11]; mq[2] = *(const LAS f32x4*)(Mg + 1668);
            ab0 -= mq[3][0] * xy[12]; ab1 -= mq[3][1] * xy[13]; ab0 -= mq[3][2] * xy[14]; ab1 -= mq[3][3] * xy[15]; mq[3] = *(const LAS f32x4*)(Mg + 1672);
            ab0 -= mq[4][0] * xy[16]; ab1 -= mq[4][1] * xy[17]; ab0 -= mq[4][2] * xy[18]; ab1 -= mq[4][3] * xy[19]; mq[4] = *(const LAS f32x4*)(Mg + 1676);
            ab0 -= mq[5][0] * xy[20]; ab1 -= mq[5][1] * xy[21]; ab0 -= mq[5][2] * xy[22]; ab1 -= mq[5][3] * xy[23]; mq[5] = *(const LAS f32x4*)(Mg + 1680);
            ab0 -= mq[0][0] * xy[24]; xy[25] = ab0 + ab1; up[3200] = xy[25][0]; wp[3200] = f2bf(-xy[25][1]); mq[0] = *(const LAS f32x4*)(Mg + 1684);
            { const float br = betg[26]; ab0 = (f32x2){bf2f(*(const LAS bf16_t*)(lg + P5_VS + 7072 + c * 2)) * br, bf2f(*(const LAS bf16_t*)(lg + P5_KS + 7072 + c * 2)) * br * __expf(decg[26])}; ab1 = (f32x2){0.f, 0.f}; } ab0 -= mq[1][0] * xy[0]; ab1 -= mq[1][1] * xy[1]; ab0 -= mq[1][2] * xy[2]; ab1 -= mq[1][3] * xy[3]; mq[1] = *(const LAS f32x4*)(Mg + 1688);
            ab0 -= mq[2][0] * xy[4]; ab1 -= mq[2][1] * xy[5]; ab0 -= mq[2][2] * xy[6]; ab1 -= mq[2][3] * xy[7]; mq[2] = *(const LAS f32x4*)(Mg + 1728);
            ab0 -= mq[3][0] * xy[8]; ab1 -= mq[3][1] * xy[9]; ab0 -= mq[3][2] * xy[10]; ab1 -= mq[3][3] * xy[11]; mq[3] = *(const LAS f32x4*)(Mg + 1732);
            ab0 -= mq[4][0] * xy[12]; ab1 -= mq[4][1] * xy[13]; ab0 -= mq[4][2] * xy[14]; ab1 -= mq[4][3] * xy[15]; mq[4] = *(const LAS f32x4*)(Mg + 1736);
            ab0 -= mq[5][0] * xy[16]; ab1 -= mq[5][1] * xy[17]; ab0 -= mq[5][2] * xy[18]; ab1 -= mq[5][3] * xy[19]; mq[5] = *(const LAS f32x4*)(Mg + 1740);
            ab0 -= mq[0][0] * xy[20]; ab1 -= mq[0][1] * xy[21]; ab0 -= mq[0][2] * xy[22]; ab1 -= mq[0][3] * xy[23]; mq[0] = *(const LAS f32x4*)(Mg + 1744);
            ab0 -= mq[1][0] * xy[24]; ab1 -= mq[1][1] * xy[25]; xy[26] = ab0 + ab1; up[3328] = xy[26][0]; wp[3328] = f2bf(-xy[26][1]); mq[1] = *(const LAS f32x4*)(Mg + 1748);
            { const float br = betg[27]; ab0 = (f32x2){bf2f(*(const LAS bf16_t*)(lg + P5_VS + 7344 + c * 2)) * br, bf2f(*(const LAS bf16_t*)(lg + P5_KS + 7344 + c * 2)) * br * __expf(decg[27])}; ab1 = (f32x2){0.f, 0.f}; } ab0 -= mq[2][0] * xy[0]; ab1 -= mq[2][1] * xy[1]; ab0 -= mq[2][2] * xy[2]; ab1 -= mq[2][3] * xy[3]; mq[2] = *(const LAS f32x4*)(Mg + 1752);
            ab0 -= mq[3][0] * xy[4]; ab1 -= mq[3][1] * xy[5]; ab0 -= mq[3][2] * xy[6]; ab1 -= mq[3][3] * xy[7]; mq[3] = *(const LAS f32x4*)(Mg + 1792);
            ab0 -= mq[4][0] * xy[8]; ab1 -= mq[4][1] * xy[9]; ab0 -= mq[4][2] * xy[10]; ab1 -= mq[4][3] * xy[11]; mq[4] = *(const LAS f32x4*)(Mg + 1796);
            ab0 -= mq[5][0] * xy[12]; ab1 -= mq[5][1] * xy[13]; ab0 -= mq[5][2] * xy[14]; ab1 -= mq[5][3] * xy[15]; mq[5] = *(const LAS f32x4*)(Mg + 1800);
            ab0 -= mq[0][0] * xy[16]; ab1 -= mq[0][1] * xy[17]; ab0 -= mq[0][2] * xy[18]; ab1 -= mq[0][3] * xy[19]; mq[0] = *(const LAS f32x4*)(Mg + 1804);
            ab0 -= mq[1][0] * xy[20]; ab1 -= mq[1][1] * xy[21]; ab0 -= mq[1][2] * xy[22]; ab1 -= mq[1][3] * xy[23]; mq[1] = *(const LAS f32x4*)(Mg + 1808);
            ab0 -= mq[2][0] * xy[24]; ab1 -= mq[2][1] * xy[25]; ab0 -= mq[2][2] * xy[26]; xy[27] = ab0 + ab1; up[3456] = xy[27][0]; wp[3456] = f2bf(-xy[27][1]); mq[2] = *(const LAS f32x4*)(Mg + 1812);
            { const float br = betg[28]; ab0 = (f32x2){bf2f(*(const LAS bf16_t*)(lg + P5_VS + 7616 + c * 2)) * br, bf2f(*(const LAS bf16_t*)(lg + P5_KS + 7616 + c * 2)) * br * __expf(decg[28])}; ab1 = (f32x2){0.f, 0.f}; } ab0 -= mq[3][0] * xy[0]; ab1 -= mq[3][1] * xy[1]; ab0 -= mq[3][2] * xy[2]; ab1 -= mq[3][3] * xy[3]; mq[3] = *(const LAS f32x4*)(Mg + 1816);
            ab0 -= mq[4][0] * xy[4]; ab1 -= mq[4][1] * xy[5]; ab0 -= mq[4][2] * xy[6]; ab1 -= mq[4][3] * xy[7]; mq[4] = *(const LAS f32x4*)(Mg + 1856);
            ab0 -= mq[5][0] * xy[8]; ab1 -= mq[5][1] * xy[9]; ab0 -= mq[5][2] * xy[10]; ab1 -= mq[5][3] * xy[11]; mq[5] = *(const LAS f32x4*)(Mg + 1860);
            ab0 -= mq[0][0] * xy[12]; ab1 -= mq[0][1] * xy[13]; ab0 -= mq[0][2] * xy[14]; ab1 -= mq[0][3] * xy[15]; mq[0] = *(const LAS f32x4*)(Mg + 1864);
            ab0 -= mq[1][0] * xy[16]; ab1 -= mq[1][1] * xy[17]; ab0 -= mq[1][2] * xy[18]; ab1 -= mq[1][3] * xy[19]; mq[1] = *(const LAS f32x4*)(Mg + 1868);
            ab0 -= mq[2][0] * xy[20]; ab1 -= mq[2][1] * xy[21]; ab0 -= mq[2][2] * xy[22]; ab1 -= mq[2][3] * xy[23]; mq[2] = *(const LAS f32x4*)(Mg + 1872);
            ab0 -= mq[3][0] * xy[24]; ab1 -= mq[3][1] * xy[25]; ab0 -= mq[3][2] * xy[26]; ab1 -= mq[3][3] * xy[27]; xy[28] = ab0 + ab1; up[3584] = xy[28][0]; wp[3584] = f2bf(-xy[28][1]); mq[3] = *(const LAS f32x4*)(Mg + 1876);
            { const float br = betg[29]; ab0 = (f32x2){bf2f(*(const LAS bf16_t*)(lg + P5_VS + 7888 + c * 2)) * br, bf2f(*(const LAS bf16_t*)(lg + P5_KS + 7888 + c * 2)) * br * __expf(decg[29])}; ab1 = (f32x2){0.f, 0.f}; } ab0 -= mq[4][0] * xy[0]; ab1 -= mq[4][1] * xy[1]; ab0 -= mq[4][2] * xy[2]; ab1 -= mq[4][3] * xy[3]; mq[4] = *(const LAS f32x4*)(Mg + 1880);
            ab0 -= mq[5][0] * xy[4]; ab1 -= mq[5][1] * xy[5]; ab0 -= mq[5][2] * xy[6]; ab1 -= mq[5][3] * xy[7]; mq[5] = *(const LAS f32x4*)(Mg + 1884);
            ab0 -= mq[0][0] * xy[8]; ab1 -= mq[0][1] * xy[9]; ab0 -= mq[0][2] * xy[10]; ab1 -= mq[0][3] * xy[11]; mq[0] = *(const LAS f32x4*)(Mg + 1920);
            ab0 -= mq[1][0] * xy[12]; ab1 -= mq[1][1] * xy[13]; ab0 -= mq[1][2] * xy[14]; ab1 -= mq[1][3] * xy[15]; mq[1] = *(const LAS f32x4*)(Mg + 1924);
            ab0 -= mq[2][0] * xy[16]; ab1 -= mq[2][1] * xy[17]; ab0 -= mq[2][2] * xy[18]; ab1 -= mq[2][3] * xy[19]; mq[2] = *(const LAS f32x4*)(Mg + 1928);
            ab0 -= mq[3][0] * xy[20]; ab1 -= mq[3][1] * xy[21]; ab0 -= mq[3][2] * xy[22]; ab1 -= mq[3][3] * xy[23]; mq[3] = *(const LAS f32x4*)(Mg + 1932);
            ab0 -= mq[4][0] * xy[24]; ab1 -= mq[4][1] * xy[25]; ab0 -= mq[4][2] * xy[26]; ab1 -= mq[4][3] * xy[27]; mq[4] = *(const LAS f32x4*)(Mg + 1936);
            ab0 -= mq[5][0] * xy[28]; xy[29] = ab0 + ab1; up[3712] = xy[29][0]; wp[3712] = f2bf(-xy[29][1]); mq[5] = *(const LAS f32x4*)(Mg + 1940);
            { const float br = betg[30]; ab0 = (f32x2){bf2f(*(const LAS bf16_t*)(lg + P5_VS + 8160 + c * 2)) * br, bf2f(*(const LAS bf16_t*)(lg + P5_KS + 8160 + c * 2)) * br * __expf(decg[30])}; ab1 = (f32x2){0.f, 0.f}; } ab0 -= mq[0][0] * xy[0]; ab1 -= mq[0][1] * xy[1]; ab0 -= mq[0][2] * xy[2]; ab1 -= mq[0][3] * xy[3]; mq[0] = *(const LAS f32x4*)(Mg + 1944);
            ab0 -= mq[1][0] * xy[4]; ab1 -= mq[1][1] * xy[5]; ab0 -= mq[1][2] * xy[6]; ab1 -= mq[1][3] * xy[7]; mq[1] = *(const LAS f32x4*)(Mg + 1948);
            ab0 -= mq[2][0] * xy[8]; ab1 -= mq[2][1] * xy[9]; ab0 -= mq[2][2] * xy[10]; ab1 -= mq[2][3] * xy[11]; mq[2] = *(const LAS f32x4*)(Mg + 1984);
            ab0 -= mq[3][0] * xy[12]; ab1 -= mq[3][1] * xy[13]; ab0 -= mq[3][2] * xy[14]; ab1 -= mq[3][3] * xy[15]; mq[3] = *(const LAS f32x4*)(Mg + 1988);
            ab0 -= mq[4][0] * xy[16]; ab1 -= mq[4][1] * xy[17]; ab0 -= mq[4][2] * xy[18]; ab1 -= mq[4][3] * xy[19]; mq[4] = *(const LAS f32x4*)(Mg + 1992);
            ab0 -= mq[5][0] * xy[20]; ab1 -= mq[5][1] * xy[21]; ab0 -= mq[5][2] * xy[22]; ab1 -= mq[5][3] * xy[23]; mq[5] = *(const LAS f32x4*)(Mg + 1996);
            ab0 -= mq[0][0] * xy[24]; ab1 -= mq[0][1] * xy[25]; ab0 -= mq[0][2] * xy[26]; ab1 -= mq[0][3] * xy[27]; mq[0] = *(const LAS f32x4*)(Mg + 2000);
            ab0 -= mq[1][0] * xy[28]; ab1 -= mq[1][1] * xy[29]; xy[30] = ab0 + ab1; up[3840] = xy[30][0]; wp[3840] = f2bf(-xy[30][1]); mq[1] = *(const LAS f32x4*)(Mg + 2004);
            { const float br = betg[31]; ab0 = (f32x2){bf2f(*(const LAS bf16_t*)(lg + P5_VS + 8432 + c * 2)) * br, bf2f(*(const LAS bf16_t*)(lg + P5_KS + 8432 + c * 2)) * br * __expf(decg[31])}; ab1 = (f32x2){0.f, 0.f}; } ab0 -= mq[2][0] * xy[0]; ab1 -= mq[2][1] * xy[1]; ab0 -= mq[2][2] * xy[2]; ab1 -= mq[2][3] * xy[3]; mq[2] = *(const LAS f32x4*)(Mg + 2008);
            ab0 -= mq[3][0] * xy[4]; ab1 -= mq[3][1] * xy[5]; ab0 -= mq[3][2] * xy[6]; ab1 -= mq[3][3] * xy[7]; mq[3] = *(const LAS f32x4*)(Mg + 2012);
            ab0 -= mq[4][0] * xy[8]; ab1 -= mq[4][1] * xy[9]; ab0 -= mq[4][2] * xy[10]; ab1 -= mq[4][3] * xy[11]; mq[4] = *(const LAS f32x4*)(Mg + 2048);
            ab0 -= mq[5][0] * xy[12]; ab1 -= mq[5][1] * xy[13]; ab0 -= mq[5][2] * xy[14]; ab1 -= mq[5][3] * xy[15]; mq[5] = *(const LAS f32x4*)(Mg + 2052);
            ab0 -= mq[0][0] * xy[16]; ab1 -= mq[0][1] * xy[17]; ab0 -= mq[0][2] * xy[18]; ab1 -= mq[0][3] * xy[19]; mq[0] = *(const LAS f32x4*)(Mg + 2056);
            ab0 -= mq[1][0] * xy[20]; ab1 -= mq[1][1] * xy[21]; ab0 -= mq[1][2] * xy[22]; ab1 -= mq[1][3] * xy[23]; mq[1] = *(const LAS f32x4*)(Mg + 2060);
            ab0 -= mq[2][0] * xy[24]; ab1 -= mq[2][1] * xy[25]; ab0 -= mq[2][2] * xy[26]; ab1 -= mq[2][3] * xy[27]; mq[2] = *(const LAS f32x4*)(Mg + 2064);
            ab0 -= mq[3][0] * xy[28]; ab1 -= mq[3][1] * xy[29]; ab0 -= mq[3][2] * xy[30]; xy[31] = ab0 + ab1; up[3968] = xy[31][0]; wp[3968] = f2bf(-xy[31][1]); mq[3] = *(const LAS f32x4*)(Mg + 2068);
            { const float br = betg[32]; ab0 = (f32x2){bf2f(*(const LAS bf16_t*)(lg + P5_VS + 8704 + c * 2)) * br, bf2f(*(const LAS bf16_t*)(lg + P5_KS + 8704 + c * 2)) * br * __expf(decg[32])}; ab1 = (f32x2){0.f, 0.f}; } ab0 -= mq[4][0] * xy[0]; ab1 -= mq[4][1] * xy[1]; ab0 -= mq[4][2] * xy[2]; ab1 -= mq[4][3] * xy[3]; mq[4] = *(const LAS f32x4*)(Mg + 2072);
            ab0 -= mq[5][0] * xy[4]; ab1 -= mq[5][1] * xy[5]; ab0 -= mq[5][2] * xy[6]; ab1 -= mq[5][3] * xy[7]; mq[5] = *(const LAS f32x4*)(Mg + 2076);
            ab0 -= mq[0][0] * xy[8]; ab1 -= mq[0][1] * xy[9]; ab0 -= mq[0][2] * xy[10]; ab1 -= mq[0][3] * xy[11]; mq[0] = *(const LAS f32x4*)(Mg + 2112);
            ab0 -= mq[1][0] * xy[12]; ab1 -= mq[1][1] * xy[13]; ab0 -= mq[1][2] * xy[14]; ab1 -= mq[1][3] * xy[15]; mq[1] = *(const LAS f32x4*)(Mg + 2116);
            ab0 -= mq[2][0] * xy[16]; ab1 -= mq[2][1] * xy[17]; ab0 -= mq[2][2] * xy[18]; ab1 -= mq[2][3] * xy[19]; mq[2] = *(const LAS f32x4*)(Mg + 2120);
            ab0 -= mq[3][0] * xy[20]; ab1 -= mq[3][1] * xy[21]; ab0 -= mq[3][2] * xy[22]; ab1 -= mq[3][3] * xy[23]; mq[3] = *(const LAS f32x4*)(Mg + 2124);
            ab0 -= mq[4][0] * xy[24]; ab1 -= mq[4][1] * xy[25]; ab0 -= mq[4][2] * xy[26]; ab1 -= mq[4][3] * xy[27]; mq[4] = *(const LAS f32x4*)(Mg + 2128);
            ab0 -= mq[5][0] * xy[28]; ab1 -= mq[5][1] * xy[29]; ab0 -= mq[5][2] * xy[30]; ab1 -= mq[5][3] * xy[31]; xy[32] = ab0 + ab1; up[4096] = xy[32][0]; wp[4096] = f2bf(-xy[32][1]); mq[5] = *(const LAS f32x4*)(Mg + 2132);
            { const float br = betg[33]; ab0 = (f32x2){bf2f(*(const LAS bf16_t*)(lg + P5_VS + 8976 + c * 2)) * br, bf2f(*(const LAS bf16_t*)(lg + P5_KS + 8976 + c * 2)) * br * __expf(decg[33])}; ab1 = (f32x2){0.f, 0.f}; } ab0 -= mq[0][0] * xy[0]; ab1 -= mq[0][1] * xy[1]; ab0 -= mq[0][2] * xy[2]; ab1 -= mq[0][3] * xy[3]; mq[0] = *(const LAS f32x4*)(Mg + 2136);
            ab0 -= mq[1][0] * xy[4]; ab1 -= mq[1][1] * xy[5]; ab0 -= mq[1][2] * xy[6]; ab1 -= mq[1][3] * xy[7]; mq[1] = *(const LAS f32x4*)(Mg + 2140);
            ab0 -= mq[2][0] * xy[8]; ab1 -= mq[2][1] * xy[9]; ab0 -= mq[2][2] * xy[10]; ab1 -= mq[2][3] * xy[11]; mq[2] = *(const LAS f32x4*)(Mg + 2144);
            ab0 -= mq[3][0] * xy[12]; ab1 -= mq[3][1] * xy[13]; ab0 -= mq[3][2] * xy[14]; ab1 -= mq[3][3] * xy[15]; mq[3] = *(const LAS f32x4*)(Mg + 2176);
            ab0 -= mq[4][0] * xy[16]; ab1 -= mq[4][1] * xy[17]; ab0 -= mq[4][2] * xy[18]; ab1 -= mq[4][3] * xy[19]; mq[4] = *(const LAS f32x4*)(Mg + 2180);
            ab0 -= mq[5][0] * xy[20]; ab1 -= mq[5][1] * xy[21]; ab0 -= mq[5][2] * xy[22]; ab1 -= mq[5][3] * xy[23]; mq[5] = *(const LAS f32x4*)(Mg + 2184);
            ab0 -= mq[0][0] * xy[24]; ab1 -= mq[0][1] * xy[25]; ab0 -= mq[0][2] * xy[26]; ab1 -= mq[0][3] * xy[27]; mq[0] = *(const LAS f32x4*)(Mg + 2188);
            ab0 -= mq[1][0] * xy[28]; ab1 -= mq[1][1] * xy[29]; ab0 -= mq[1][2] * xy[30]; ab1 -= mq[1][3] * xy[31]; mq[1] = *(const LAS f32x4*)(Mg + 2192);
            ab0 -= mq[2][0] * xy[32]; xy[33] = ab0 + ab1; up[4224] = xy[33][0]; wp[4224] = f2bf(-xy[33][1]); mq[2] = *(const LAS f32x4*)(Mg + 2196);
            { const float br = betg[34]; ab0 = (f32x2){bf2f(*(const LAS bf16_t*)(lg + P5_VS + 9248 + c * 2)) * br, bf2f(*(const LAS bf16_t*)(lg + P5_KS + 9248 + c * 2)) * br * __expf(decg[34])}; ab1 = (f32x2){0.f, 0.f}; } ab0 -= mq[3][0] * xy[0]; ab1 -= mq[3][1] * xy[1]; ab0 -= mq[3][2] * xy[2]; ab1 -= mq[3][3] * xy[3]; mq[3] = *(const LAS f32x4*)(Mg + 2200);
            ab0 -= mq[4][0] * xy[4]; ab1 -= mq[4][1] * xy[5]; ab0 -= mq[4][2] * xy[6]; ab1 -= mq[4][3] * xy[7]; mq[4] = *(const LAS f32x4*)(Mg + 2204);
            ab0 -= mq[5][0] * xy[8]; ab1 -= mq[5][1] * xy[9]; ab0 -= mq[5][2] * xy[10]; ab1 -= mq[5][3] * xy[11]; mq[5] = *(const LAS f32x4*)(Mg + 2208);
            ab0 -= mq[0][0] * xy[12]; ab1 -= mq[0][1] * xy[13]; ab0 -= mq[0][2] * xy[14]; ab1 -= mq[0][3] * xy[15]; mq[0] = *(const LAS f32x4*)(Mg + 2240);
            ab0 -= mq[1][0] * xy[16]; ab1 -= mq[1][1] * xy[17]; ab0 -= mq[1][2] * xy[18]; ab1 -= mq[1][3] * xy[19]; mq[1] = *(const LAS f32x4*)(Mg + 2244);
            ab0 -= mq[2][0] * xy[20]; ab1 -= mq[2][1] * xy[21]; ab0 -= mq[2][2] * xy[22]; ab1 -= mq[2][3] * xy[23]; mq[2] = *(const LAS f32x4*)(Mg + 2248);
            ab0 -= mq[3][0] * xy[24]; ab1 -= mq[3][1] * xy[25]; ab0 -= mq[3][2] * xy[26]; ab1 -= mq[3][3] * xy[27]; mq[3] = *(const LAS f32x4*)(Mg + 2252);
            ab0 -= mq[4][0] * xy[28]; ab1 -= mq[4][1] * xy[29]; ab0 -= mq[4][2] * xy[30]; ab1 -= mq[4][3] * xy[31]; mq[4] = *(const LAS f32x4*)(Mg + 2256);
            ab0 -= mq[5][0] * xy[32]; ab1 -= mq[5][1] * xy[33]; xy[34] = ab0 + ab1; up[4352] = xy[34][0]; wp[4352] = f2bf(-xy[34][1]); mq[5] = *(const LAS f32x4*)(Mg + 2260);
            { const float br = betg[35]; ab0 = (f32x2){bf2f(*(const LAS bf16_t*)(lg + P5_VS + 9520 + c * 2)) * br, bf2f(*(const LAS bf16_t*)(lg + P5_KS + 9520 + c * 2)) * br * __expf(decg[35])}; ab1 = (f32x2){0.f, 0.f}; } ab0 -= mq[0][0] * xy[0]; ab1 -= mq[0][1] * xy[1]; ab0 -= mq[0][2] * xy[2]; ab1 -= mq[0][3] * xy[3]; mq[0] = *(const LAS f32x4*)(Mg + 2264);
            ab0 -= mq[1][0] * xy[4]; ab1 -= mq[1][1] * xy[5]; ab0 -= mq[1][2] * xy[6]; ab1 -= mq[1][3] * xy[7]; mq[1] = *(const LAS f32x4*)(Mg + 2268);
            ab0 -= mq[2][0] * xy[8]; ab1 -= mq[2][1] * xy[9]; ab0 -= mq[2][2] * xy[10]; ab1 -= mq[2][3] * xy[11]; mq[2] = *(const LAS f32x4*)(Mg + 2272);
            ab0 -= mq[3][0] * xy[12]; ab1 -= mq[3][1] * xy[13]; ab0 -= mq[3][2] * xy[14]; ab1 -= mq[3][3] * xy[15]; mq[3] = *(const LAS f32x4*)(Mg + 2304);
            ab0 -= mq[4][0] * xy[16]; ab1 -= mq[4][1] * xy[17]; ab0 -= mq[4][2] * xy[18]; ab1 -= mq[4][3] * xy[19]; mq[4] = *(const LAS f32x4*)(Mg + 2308);
            ab0 -= mq[5][0] * xy[20]; ab1 -= mq[5][1] * xy[21]; ab0 -= mq[5][2] * xy[22]; ab1 -= mq[5][3] * xy[23]; mq[5] = *(const LAS f32x4*)(Mg + 2312);
            ab0 -= mq[0][0] * xy[24]; ab1 -= mq[0][1] * xy[25]; ab0 -= mq[0][2] * xy[26]; ab1 -= mq[0][3] * xy[27]; mq[0] = *(const LAS f32x4*)(Mg + 2316);
            ab0 -= mq[1][0] * xy[28]; ab1 -= mq[1][1] * xy[29]; ab0 -= mq[1][2] * xy[30]; ab1 -= mq[1][3] * xy[31]; mq[1] = *(const LAS f32x4*)(Mg + 2320);
            ab0 -= mq[2][0] * xy[32]; ab1 -= mq[2][1] * xy[33]; ab0 -= mq[2][2] * xy[34]; xy[35] = ab0 + ab1; up[4480] = xy[35][0]; wp[4480] = f2bf(-xy[35][1]); mq[2] = *(const LAS f32x4*)(Mg + 2324);
            { const float br = betg[36]; ab0 = (f32x2){bf2f(*(const LAS bf16_t*)(lg + P5_VS + 9792 + c * 2)) * br, bf2f(*(const LAS bf16_t*)(lg + P5_KS + 9792 + c * 2)) * br * __expf(decg[36])}; ab1 = (f32x2){0.f, 0.f}; } ab0 -= mq[3][0] * xy[0]; ab1 -= mq[3][1] * xy[1]; ab0 -= mq[3][2] * xy[2]; ab1 -= mq[3][3] * xy[3]; mq[3] = *(const LAS f32x4*)(Mg + 2328);
            ab0 -= mq[4][0] * xy[4]; ab1 -= mq[4][1] * xy[5]; ab0 -= mq[4][2] * xy[6]; ab1 -= mq[4][3] * xy[7]; mq[4] = *(const LAS f32x4*)(Mg + 2332);
            ab0 -= mq[5][0] * xy[8]; ab1 -= mq[5][1] * xy[9]; ab0 -= mq[5][2] * xy[10]; ab1 -= mq[5][3] * xy[11]; mq[5] = *(const LAS f32x4*)(Mg + 2336);
            ab0 -= mq[0][0] * xy[12]; ab1 -= mq[0][1] * xy[13]; ab0 -= mq[0][2] * xy[14]; ab1 -= mq[0][3] * xy[15]; mq[0] = *(const LAS f32x4*)(Mg + 2368);
            ab0 -= mq[1][0] * xy[16]; ab1 -= mq[1][1] * xy[17]; ab0 -= mq[1][2] * xy[18]; ab1 -= mq[1][3] * xy[19]; mq[1] = *(const LAS f32x4*)(Mg + 2372);
            ab0 -= mq[2][0] * xy[20]; ab1 -= mq[2][1] * xy[21]; ab0 -= mq[2][2] * xy[22]; ab1 -= mq[2][3] * xy[23]; mq[2] = *(const LAS f32x4*)(Mg + 2376);
            ab0 -= mq[3][0] * xy[24]; ab1 -= mq[3][1] * xy[25]; ab0 -= mq[3][2] * xy[26]; ab1 -= mq[3][3] * xy[27]; mq[3] = *(const LAS f32x4*)(Mg + 2380);
            ab0 -= mq[4][0] * xy[28]; ab1 -= mq[4][1] * xy[29]; ab0 -= mq[4][2] * xy[30]; ab1 -= mq[4][3] * xy[31]; mq[4] = *(const LAS f32x4*)(Mg + 2384);
            ab0 -= mq[5][0] * xy[32]; ab1 -= mq[5][1] * xy[33]; ab0 -= mq[5][2] * xy[34]; ab1 -= mq[5][3] * xy[35]; xy[36] = ab0 + ab1; up[4608] = xy[36][0]; wp[4608] = f2bf(-xy[36][1]); mq[5] = *(const LAS f32x4*)(Mg + 2388);
            { const float br = betg[37]; ab0 = (f32x2){bf2f(*(const LAS bf16_t*)(lg + P5_VS + 10064 + c * 2)) * br, bf2f(*(const LAS bf16_t*)(lg + P5_KS + 10064 + c * 2)) * br * __expf(decg[37])}; ab1 = (f32x2){0.f, 0.f}; } ab0 -= mq[0][0] * xy[0]; ab1 -= mq[0][1] * xy[1]; ab0 -= mq[0][2] * xy[2]; ab1 -= mq[0][3] * xy[3]; mq[0] = *(const LAS f32x4*)(Mg + 2392);
            ab0 -= mq[1][0] * xy[4]; ab1 -= mq[1][1] * xy[5]; ab0 -= mq[1][2] * xy[6]; ab1 -= mq[1][3] * xy[7]; mq[1] = *(const LAS f32x4*)(Mg + 2396);
            ab0 -= mq[2][0] * xy[8]; ab1 -= mq[2][1] * xy[9]; ab0 -= mq[2][2] * xy[10]; ab1 -= mq[2][3] * xy[11]; mq[2] = *(const LAS f32x4*)(Mg + 2400);
            ab0 -= mq[3][0] * xy[12]; ab1 -= mq[3][1] * xy[13]; ab0 -= mq[3][2] * xy[14]; ab1 -= mq[3][3] * xy[15]; mq[3] = *(const LAS f32x4*)(Mg + 2404);
            ab0 -= mq[4][0] * xy[16]; ab1 -= mq[4][1] * xy[17]; ab0 -= mq[4][2] * xy[18]; ab1 -= mq[4][3] * xy[19]; mq[4] = *(const LAS f32x4*)(Mg + 2432);
            ab0 -= mq[5][0] * xy[20]; ab1 -= mq[5][1] * xy[21]; ab0 -= mq[5][2] * xy[22]; ab1 -= mq[5][3] * xy[23]; mq[5] = *(const LAS f32x4*)(Mg + 2436);
            ab0 -= mq[0][0] * xy[24]; ab1 -= mq[0][1] * xy[25]; ab0 -= mq[0][2] * xy[26]; ab1 -= mq[0][3] * xy[27]; mq[0] = *(const LAS f32x4*)(Mg + 2440);
            ab0 -= mq[1][0] * xy[28]; ab1 -= mq[1][1] * xy[29]; ab0 -= mq[1][2] * xy[30]; ab1 -= mq[1][3] * xy[31]; mq[1] = *(const LAS f32x4*)(Mg + 2444);
            ab0 -= mq[2][0] * xy[32]; ab1 -= mq[2][1] * xy[33]; ab0 -= mq[2][2] * xy[34]; ab1 -= mq[2][3] * xy[35]; mq[2] = *(const LAS f32x4*)(Mg + 2448);
            ab0 -= mq[3][0] * xy[36]; xy[37] = ab0 + ab1; up[4736] = xy[37][0]; wp[4736] = f2bf(-xy[37][1]); mq[3] = *(const LAS f32x4*)(Mg + 2452);
            { const float br = betg[38]; ab0 = (f32x2){bf2f(*(const LAS bf16_t*)(lg + P5_VS + 10336 + c * 2)) * br, bf2f(*(const LAS bf16_t*)(lg + P5_KS + 10336 + c * 2)) * br * __expf(decg[38])}; ab1 = (f32x2){0.f, 0.f}; } ab0 -= mq[4][0] * xy[0]; ab1 -= mq[4][1] * xy[1]; ab0 -= mq[4][2] * xy[2]; ab1 -= mq[4][3] * xy[3]; mq[4] = *(const LAS f32x4*)(Mg + 2456);
            ab0 -= mq[5][0] * xy[4]; ab1 -= mq[5][1] * xy[5]; ab0 -= mq[5][2] * xy[6]; ab1 -= mq[5][3] * xy[7]; mq[5] = *(const LAS f32x4*)(Mg + 2460);
            ab0 -= mq[0][0] * xy[8]; ab1 -= mq[0][1] * xy[9]; ab0 -= mq[0][2] * xy[10]; ab1 -= mq[0][3] * xy[11]; mq[0] = *(const LAS f32x4*)(Mg + 2464);
            ab0 -= mq[1][0] * xy[12]; ab1 -= mq[1][1] * xy[13]; ab0 -= mq[1][2] * xy[14]; ab1 -= mq[1][3] * xy[15]; mq[1] = *(const LAS f32x4*)(Mg + 2468);
            ab0 -= mq[2][0] * xy[16]; ab1 -= mq[2][1] * xy[17]; ab0 -= mq[2][2] * xy[18]; ab1 -= mq[2][3] * xy[19]; mq[2] = *(const LAS f32x4*)(Mg + 2496);
            ab0 -= mq[3][0] * xy[20]; ab1 -= mq[3][1] * xy[21]; ab0 -= mq[3][2] * xy[22]; ab1 -= mq[3][3] * xy[23]; mq[3] = *(const LAS f32x4*)(Mg + 2500);
            ab0 -= mq[4][0] * xy[24]; ab1 -= mq[4][1] * xy[25]; ab0 -= mq[4][2] * xy[26]; ab1 -= mq[4][3] * xy[27]; mq[4] = *(const LAS f32x4*)(Mg + 2504);
            ab0 -= mq[5][0] * xy[28]; ab1 -= mq[5][1] * xy[29]; ab0 -= mq[5][2] * xy[30]; ab1 -= mq[5][3] * xy[31]; mq[5] = *(const LAS f32x4*)(Mg + 2508);
            ab0 -= mq[0][0] * xy[32]; ab1 -= mq[0][1] * xy[33]; ab0 -= mq[0][2] * xy[34]; ab1 -= mq[0][3] * xy[35]; mq[0] = *(const LAS f32x4*)(Mg + 2512);
            ab0 -= mq[1][0] * xy[36]; ab1 -= mq[1][1] * xy[37]; xy[38] = ab0 + ab1; up[4864] = xy[38][0]; wp[4864] = f2bf(-xy[38][1]); mq[1] = *(const LAS f32x4*)(Mg + 2516);
            { const float br = betg[39]; ab0 = (f32x2){bf2f(*(const LAS bf16_t*)(lg + P5_VS + 10608 + c * 2)) * br, bf2f(*(const LAS bf16_t*)(lg + P5_KS + 10608 + c * 2)) * br * __expf(decg[39])}; ab1 = (f32x2){0.f, 0.f}; } ab0 -= mq[2][0] * xy[0]; ab1 -= mq[2][1] * xy[1]; ab0 -= mq[2][2] * xy[2]; ab1 -= mq[2][3] * xy[3]; mq[2] = *(const LAS f32x4*)(Mg + 2520);
            ab0 -= mq[3][0] * xy[4]; ab1 -= mq[3][1] * xy[5]; ab0 -= mq[3][2] * xy[6]; ab1 -= mq[3][3] * xy[7]; mq[3] = *(const LAS f32x4*)(Mg + 2524);
            ab0 -= mq[4][0] * xy[8]; ab1 -= mq[4][1] * xy[9]; ab0 -= mq[4][2] * xy[10]; ab1 -= mq[4][3] * xy[11]; mq[4] = *(const LAS f32x4*)(Mg + 2528);
            ab0 -= mq[5][0] * xy[12]; ab1 -= mq[5][1] * xy[13]; ab0 -= mq[5][2] * xy[14]; ab1 -= mq[5][3] * xy[15]; mq[5] = *(const LAS f32x4*)(Mg + 2532);
            ab0 -= mq[0][0] * xy[16]; ab1 -= mq[0][1] * xy[17]; ab0 -= mq[0][2] * xy[18]; ab1 -= mq[0][3] * xy[19]; mq[0] = *(const LAS f32x4*)(Mg + 2560);
            ab0 -= mq[1][0] * xy[20]; ab1 -= mq[1][1] * xy[21]; ab0 -= mq[1][2] * xy[22]; ab1 -= mq[1][3] * xy[23]; mq[1] = *(const LAS f32x4*)(Mg + 2564);
            ab0 -= mq[2][0] * xy[24]; ab1 -= mq[2][1] * xy[25]; ab0 -= mq[2][2] * xy[26]; ab1 -= mq[2][3] * xy[27]; mq[2] = *(const LAS f32x4*)(Mg + 2568);
            ab0 -= mq[3][0] * xy[28]; ab1 -= mq[3][1] * xy[29]; ab0 -= mq[3][2] * xy[30]; ab1 -= mq[3][3] * xy[31]; mq[3] = *(const LAS f32x4*)(Mg + 2572);
            ab0 -= mq[4][0] * xy[32]; ab1 -= mq[4][1] * xy[33]; ab0 -= mq[4][2] * xy[34]; ab1 -= mq[4][3] * xy[35]; mq[4] = *(const LAS f32x4*)(Mg + 2576);
            ab0 -= mq[5][0] * xy[36]; ab1 -= mq[5][1] * xy[37]; ab0 -= mq[5][2] * xy[38]; xy[39] = ab0 + ab1; up[4992] = xy[39][0]; wp[4992] = f2bf(-xy[39][1]); mq[5] = *(const LAS f32x4*)(Mg + 2580);
            { const float br = betg[40]; ab0 = (f32x2){bf2f(*(const LAS bf16_t*)(lg + P5_VS + 10880 + c * 2)) * br, bf2f(*(const LAS bf16_t*)(lg + P5_KS + 10880 + c * 2)) * br * __expf(decg[40])}; ab1 = (f32x2){0.f, 0.f}; } ab0 -= mq[0][0] * xy[0]; ab1 -= mq[0][1] * xy[1]; ab0 -= mq[0][2] * xy[2]; ab1 -= mq[0][3] * xy[3]; mq[0] = *(const LAS f32x4*)(Mg + 2584);
            ab0 -= mq[1][0] * xy[4]; ab1 -= mq[1][1] * xy[5]; ab0 -= mq[1][2] * xy[6]; ab1 -= mq[1][3] * xy[7]; mq[1] = *(const LAS f32x4*)(Mg + 2588);
            ab0 -= mq[2][0] * xy[8]; ab1 -= mq[2][1] * xy[9]; ab0 -= mq[2][2] * xy[10]; ab1 -= mq[2][3] * xy[11]; mq[2] = *(const LAS f32x4*)(Mg + 2592);
            ab0 -= mq[3][0] * xy[12]; ab1 -= mq[3][1] * xy[13]; ab0 -= mq[3][2] * xy[14]; ab1 -= mq[3][3] * xy[15]; mq[3] = *(const LAS f32x4*)(Mg + 2596);
            ab0 -= mq[4][0] * xy[16]; ab1 -= mq[4][1] * xy[17]; ab0 -= mq[4][2] * xy[18]; ab1 -= mq[4][3] * xy[19]; mq[4] = *(const LAS f32x4*)(Mg + 2624);
            ab0 -= mq[5][0] * xy[20]; ab1 -= mq[5][1] * xy[21]; ab0 -= mq[5][2] * xy[22]; ab1 -= mq[5][3] * xy[23]; mq[5] = *(const LAS f32x4*)(Mg + 2628);
            ab0 -= mq[0][0] * xy[24]; ab1 -= mq[0][1] * xy[25]; ab0 -= mq[0][2] * xy[26]; ab1 -= mq[0][3] * xy[27]; mq[0] = *(const LAS f32x4*)(Mg + 2632);
            ab0 -= mq[1][0] * xy[28]; ab1 -= mq[1][1] * xy[29]; ab0 -= mq[1][2] * xy[30]; ab1 -= mq[1][3] * xy[31]; mq[1] = *(const LAS f32x4*)(Mg + 2636);
            ab0 -= mq[2][0] * xy[32]; ab1 -= mq[2][1] * xy[33]; ab0 -= mq[2][2] * xy[34]; ab1 -= mq[2][3] * xy[35]; mq[2] = *(const LAS f32x4*)(Mg + 2640);
            ab0 -= mq[3][0] * xy[36]; ab1 -= mq[3][1] * xy[37]; ab0 -= mq[3][2] * xy[38]; ab1 -= mq[3][3] * xy[39]; xy[40] = ab0 + ab1; up[5120] = xy[40][0]; wp[5120] = f2bf(-xy[40][1]); mq[3] = *(const LAS f32x4*)(Mg + 2644);
            { const float br = betg[41]; ab0 = (f32x2){bf2f(*(const LAS bf16_t*)(lg + P5_VS + 11152 + c * 2)) * br, bf2f(*(const LAS bf16_t*)(lg + P5_KS + 11152 + c * 2)) * br * __expf(decg[41])}; ab1 = (f32x2){0.f, 0.f}; } ab0 -= mq[4][0] * xy[0]; ab1 -= mq[4][1] * xy[1]; ab0 -= mq[4][2] * xy[2]; ab1 -= mq[4][3] * xy[3]; mq[4] = *(const LAS f32x4*)(Mg + 2648);
            ab0 -= mq[5][0] * xy[4]; ab1 -= mq[5][1] * xy[5]; ab0 -= mq[5][2] * xy[6]; ab1 -= mq[5][3] * xy[7]; mq[5] = *(const LAS f32x4*)(Mg + 2652);
            ab0 -= mq[0][0] * xy[8]; ab1 -= mq[0][1] * xy[9]; ab0 -= mq[0][2] * xy[10]; ab1 -= mq[0][3] * xy[11]; mq[0] = *(const LAS f32x4*)(Mg + 2656);
            ab0 -= mq[1][0] * xy[12]; ab1 -= mq[1][1] * xy[13]; ab0 -= mq[1][2] * xy[14]; ab1 -= mq[1][3] * xy[15]; mq[1] = *(const LAS f32x4*)(Mg + 2660);
            ab0 -= mq[2][0] * xy[16]; ab1 -= mq[2][1] * xy[17]; ab0 -= mq[2][2] * xy[18]; ab1 -= mq[2][3] * xy[19]; mq[2] = *(const LAS f32x4*)(Mg + 2664);
            ab0 -= mq[3][0] * xy[20]; ab1 -= mq[3][1] * xy[21]; ab0 -= mq[3][2] * xy[22]; ab1 -= mq[3][3] * xy[23]; mq[3] = *(const LAS f32x4*)(Mg + 2688);
            ab0 -= mq[4][0] * xy[24]; ab1 -= mq[4][1] * xy[25]; ab0 -= mq[4][2] * xy[26]; ab1 -= mq[4][3] * xy[27]; mq[4] = *(const LAS f32x4*)(Mg + 2692);
            ab0 -= mq[5][0] * xy[28]; ab1 -= mq[5][1] * xy[29]; ab0 -= mq[5][2] * xy[30]; ab1 -= mq[5][3] * xy[31]; mq[5] = *(const LAS f32x4*)(Mg + 2696);
            ab0 -= mq[0][0] * xy[32]; ab1 -= mq[0][1] * xy[33]; ab0 -= mq[0][2] * xy[34]; ab1 -= mq[0][3] * xy[35]; mq[0] = *(const LAS f32x4*)(Mg + 2700);
            ab0 -= mq[1][0] * xy[36]; ab1 -= mq[1][1] * xy[37]; ab0 -= mq[1][2] * xy[38]; ab1 -= mq[1][3] * xy[39]; mq[1] = *(const LAS f32x4*)(Mg + 2704);
            ab0 -= mq[2][0] * xy[40]; xy[41] = ab0 + ab1; up[5248] = xy[41][0]; wp[5248] = f2bf(-xy[41][1]); mq[2] = *(const LAS f32x4*)(Mg + 2708);
            { const float br = betg[42]; ab0 = (f32x2){bf2f(*(const LAS bf16_t*)(lg + P5_VS + 11424 + c * 2)) * br, bf2f(*(const LAS bf16_t*)(lg + P5_KS + 11424 + c * 2)) * br * __expf(decg[42])}; ab1 = (f32x2){0.f, 0.f}; } ab0 -= mq[3][0] * xy[0]; ab1 -= mq[3][1] * xy[1]; ab0 -= mq[3][2] * xy[2]; ab1 -= mq[3][3] * xy[3]; mq[3] = *(const LAS f32x4*)(Mg + 2712);
            ab0 -= mq[4][0] * xy[4]; ab1 -= mq[4][1] * xy[5]; ab0 -= mq[4][2] * xy[6]; ab1 -= mq[4][3] * xy[7]; mq[4] = *(const LAS f32x4*)(Mg + 2716);
            ab0 -= mq[5][0] * xy[8]; ab1 -= mq[5][1] * xy[9]; ab0 -= mq[5][2] * xy[10]; ab1 -= mq[5][3] * xy[11]; mq[5] = *(const LAS f32x4*)(Mg + 2720);
            ab0 -= mq[0][0] * xy[12]; ab1 -= mq[0][1] * xy[13]; ab0 -= mq[0][2] * xy[14]; ab1 -= mq[0][3] * xy[15]; mq[0] = *(const LAS f32x4*)(Mg + 2724);
            ab0 -= mq[1][0] * xy[16]; ab1 -= mq[1][1] * xy[17]; ab0 -= mq[1][2] * xy[18]; ab1 -= mq[1][3] * xy[19]; mq[1] = *(const LAS f32x4*)(Mg + 2728);
            ab0 -= mq[2][0] * xy[20]; ab1 -= mq[2][1] * xy[21]; ab0 -= mq[2][2] * xy[22]; ab1 -= mq[2][3] * xy[23]; mq[2] = *(const LAS f32x4*)(Mg + 2752);
            ab0 -= mq[3][0] * xy[24]; ab1 -= mq[3][1] * xy[25]; ab0 -= mq[3][2] * xy[26]; ab1 -= mq[3][3] * xy[27]; mq[3] = *(const LAS f32x4*)(Mg + 2756);
            ab0 -= mq[4][0] * xy[28]; ab1 -= mq[4][1] * xy[29]; ab0 -= mq[4][2] * xy[30]; ab1 -= mq[4][3] * xy[31]; mq[4] = *(const LAS f32x4*)(Mg + 2760);
            ab0 -= mq[5][0] * xy[32]; ab1 -= mq[5][1] * xy[33]; ab0 -= mq[5][2] * xy[34]; ab1 -= mq[5][3] * xy[35]; mq[5] = *(const LAS f32x4*)(Mg + 2764);
            ab0 -= mq[0][0] * xy[36]; ab1 -= mq[0][1] * xy[37]; ab0 -= mq[0][2] * xy[38]; ab1 -= mq[0][3] * xy[39]; mq[0] = *(const LAS f32x4*)(Mg + 2768);
            ab0 -= mq[1][0] * xy[40]; ab1 -= mq[1][1] * xy[41]; xy[42] = ab0 + ab1; up[5376] = xy[42][0]; wp[5376] = f2bf(-xy[42][1]); mq[1] = *(const LAS f32x4*)(Mg + 2772);
            { const float br = betg[43]; ab0 = (f32x2){bf2f(*(const LAS bf16_t*)(lg + P5_VS + 11696 + c * 2)) * br, bf2f(*(const LAS bf16_t*)(lg + P5_KS + 11696 + c * 2)) * br * __expf(decg[43])}; ab1 = (f32x2){0.f, 0.f}; } ab0 -= mq[2][0] * xy[0]; ab1 -= mq[2][1] * xy[1]; ab0 -= mq[2][2] * xy[2]; ab1 -= mq[2][3] * xy[3]; mq[2] = *(const LAS f32x4*)(Mg + 2776);
            ab0 -= mq[3][0] * xy[4]; ab1 -= mq[3][1] * xy[5]; ab0 -= mq[3][2] * xy[6]; ab1 -= mq[3][3] * xy[7]; mq[3] = *(const LAS f32x4*)(Mg + 2780);
            ab0 -= mq[4][0] * xy[8]; ab1 -= mq[4][1] * xy[9]; ab0 -= mq[4][2] * xy[10]; ab1 -= mq[4][3] * xy[11]; mq[4] = *(const LAS f32x4*)(Mg + 2784);
            ab0 -= mq[5][0] * xy[12]; ab1 -= mq[5][1] * xy[13]; ab0 -= mq[5][2] * xy[14]; ab1 -= mq[5][3] * xy[15]; mq[5] = *(const LAS f32x4*)(Mg + 2788);
            ab0 -= mq[0][0] * xy[16]; ab1 -= mq[0][1] * xy[17]; ab0 -= mq[0][2] * xy[18]; ab1 -= mq[0][3] * xy[19]; mq[0] = *(const LAS f32x4*)(Mg + 2792);
            ab0 -= mq[1][0] * xy[20]; ab1 -= mq[1][1] * xy[21]; ab0 -= mq[1][2] * xy[22]; ab1 -= mq[1][3] * xy[23]; mq[1] = *(const LAS f32x4*)(Mg + 2816);
            ab0 -= mq[2][0] * xy[24]; ab1 -= mq[2][1] * xy[25]; ab0 -= mq[2][2] * xy[26]; ab1 -= mq[2][3] * xy[27]; mq[2] = *(const LAS f32x4*)(Mg + 2820);
            ab0 -= mq[3][0] * xy[28]; ab1 -= mq[3][1] * xy[29]; ab0 -= mq[3][2] * xy[30]; ab1 -= mq[3][3] * xy[31]; mq[3] = *(const LAS f32x4*)(Mg + 2824);
            ab0 -= mq[4][0] * xy[32]; ab1 -= mq[4][1] * xy[33]; ab0 -= mq[4][2] * xy[34]; ab1 -= mq[4][3] * xy[35]; mq[4] = *(const LAS f32x4*)(Mg + 2828);
            ab0 -= mq[5][0] * xy[36]; ab1 -= mq[5][1] * xy[37]; ab0 -= mq[5][2] * xy[38]; ab1 -= mq[5][3] * xy[39]; mq[5] = *(const LAS f32x4*)(Mg + 2832);
            ab0 -= mq[0][0] * xy[40]; ab1 -= mq[0][1] * xy[41]; ab0 -= mq[0][2] * xy[42]; xy[43] = ab0 + ab1; up[5504] = xy[43][0]; wp[5504] = f2bf(-xy[43][1]); mq[0] = *(const LAS f32x4*)(Mg + 2836);
            { const float br = betg[44]; ab0 = (f32x2){bf2f(*(const LAS bf16_t*)(lg + P5_VS + 11968 + c * 2)) * br, bf2f(*(const LAS bf16_t*)(lg + P5_KS + 11968 + c * 2)) * br * __expf(decg[44])}; ab1 = (f32x2){0.f, 0.f}; } ab0 -= mq[1][0] * xy[0]; ab1 -= mq[1][1] * xy[1]; ab0 -= mq[1][2] * xy[2]; ab1 -= mq[1][3] * xy[3]; mq[1] = *(const LAS f32x4*)(Mg + 2840);
            ab0 -= mq[2][0] * xy[4]; ab1 -= mq[2][1] * xy[5]; ab0 -= mq[2][2] * xy[6]; ab1 -= mq[2][3] * xy[7]; mq[2] = *(const LAS f32x4*)(Mg + 2844);
            ab0 -= mq[3][0] * xy[8]; ab1 -= mq[3][1] * xy[9]; ab0 -= mq[3][2] * xy[10]; ab1 -= mq[3][3] * xy[11]; mq[3] = *(const LAS f32x4*)(Mg + 2848);
            ab0 -= mq[4][0] * xy[12]; ab1 -= mq[4][1] * xy[13]; ab0 -= mq[4][2] * xy[14]; ab1 -= mq[4][3] * xy[15]; mq[4] = *(const LAS f32x4*)(Mg + 2852);
            ab0 -= mq[5][0] * xy[16]; ab1 -= mq[5][1] * xy[17]; ab0 -= mq[5][2] * xy[18]; ab1 -= mq[5][3] * xy[19]; mq[5] = *(const LAS f32x4*)(Mg + 2856);
            ab0 -= mq[0][0] * xy[20]; ab1 -= mq[0][1] * xy[21]; ab0 -= mq[0][2] * xy[22]; ab1 -= mq[0][3] * xy[23]; mq[0] = *(const LAS f32x4*)(Mg + 2880);
            ab0 -= mq[1][0] * xy[24]; ab1 -= mq[1][1] * xy[25]; ab0 -= mq[1][2] * xy[26]; ab1 -= mq[1][3] * xy[27]; mq[1] = *(const LAS f32x4*)(Mg + 2884);
            ab0 -= mq[2][0] * xy[28]; ab1 -= mq[2][1] * xy[29]; ab0 -= mq[2][2] * xy[30]; ab1 -= mq[2][3] * xy[31]; mq[2] = *(const LAS f32x4*)(Mg + 2888);
            ab0 -= mq[3][0] * xy[32]; ab1 -= mq[3][1] * xy[33]; ab0 -= mq[3][2] * xy[34]; ab1 -= mq[3][3] * xy[35]; mq[3] = *(const LAS f32x4*)(Mg + 2892);
            ab0 -= mq[4][0] * xy[36]; ab1 -= mq[4][1] * xy[37]; ab0 -= mq[4][2] * xy[38]; ab1 -= mq[4][3] * xy[39]; mq[4] = *(const LAS f32x4*)(Mg + 2896);
            ab0 -= mq[5][0] * xy[40]; ab1 -= mq[5][1] * xy[41]; ab0 -= mq[5][2] * xy[42]; ab1 -= mq[5][3] * xy[43]; xy[44] = ab0 + ab1; up[5632] = xy[44][0]; wp[5632] = f2bf(-xy[44][1]); mq[5] = *(const LAS f32x4*)(Mg + 2900);
            { const float br = betg[45]; ab0 = (f32x2){bf2f(*(const LAS bf16_t*)(lg + P5_VS + 12240 + c * 2)) * br, bf2f(*(const LAS bf16_t*)(lg + P5_KS + 12240 + c * 2)) * br * __expf(decg[45])}; ab1 = (f32x2){0.f, 0.f}; } ab0 -= mq[0][0] * xy[0]; ab1 -= mq[0][1] * xy[1]; ab0 -= mq[0][2] * xy[2]; ab1 -= mq[0][3] * xy[3]; mq[0] = *(const LAS f32x4*)(Mg + 2904);
            ab0 -= mq[1][0] * xy[4]; ab1 -= mq[1][1] * xy[5]; ab0 -= mq[1][2] * xy[6]; ab1 -= mq[1][3] * xy[7]; mq[1] = *(const LAS f32x4*)(Mg + 2908);
            ab0 -= mq[2][0] * xy[8]; ab1 -= mq[2][1] * xy[9]; ab0 -= mq[2][2] * xy[10]; ab1 -= mq[2][3] * xy[11]; mq[2] = *(const LAS f32x4*)(Mg + 2912);
            ab0 -= mq[3][0] * xy[12]; ab1 -= mq[3][1] * xy[13]; ab0 -= mq[3][2] * xy[14]; ab1 -= mq[3][3] * xy[15]; mq[3] = *(const LAS f32x4*)(Mg + 2916);
            ab0 -= mq[4][0] * xy[16]; ab1 -= mq[4][1] * xy[17]; ab0 -= mq[4][2] * xy[18]; ab1 -= mq[4][3] * xy[19]; mq[4] = *(const LAS f32x4*)(Mg + 2920);
            ab0 -= mq[5][0] * xy[20]; ab1 -= mq[5][1] * xy[21]; ab0 -= mq[5][2] * xy[22]; ab1 -= mq[5][3] * xy[23]; mq[5] = *(const LAS f32x4*)(Mg + 2924);
            ab0 -= mq[0][0] * xy[24]; ab1 -= mq[0][1] * xy[25]; ab0 -= mq[0][2] * xy[26]; ab1 -= mq[0][3] * xy[27]; mq[0] = *(const LAS f32x4*)(Mg + 2944);
            ab0 -= mq[1][0] * xy[28]; ab1 -= mq[1][1] * xy[29]; ab0 -= mq[1][2] * xy[30]; ab1 -= mq[1][3] * xy[31]; mq[1] = *(const LAS f32x4*)(Mg + 2948);
            ab0 -= mq[2][0] * xy[32]; ab1 -= mq[2][1] * xy[33]; ab0 -= mq[2][2] * xy[34]; ab1 -= mq[2][3] * xy[35]; mq[2] = *(const LAS f32x4*)(Mg + 2952);
            ab0 -= mq[3][0] * xy[36]; ab1 -= mq[3][1] * xy[37]; ab0 -= mq[3][2] * xy[38]; ab1 -= mq[3][3] * xy[39]; mq[3] = *(const LAS f32x4*)(Mg + 2956);
            ab0 -= mq[4][0] * xy[40]; ab1 -= mq[4][1] * xy[41]; ab0 -= mq[4][2] * xy[42]; ab1 -= mq[4][3] * xy[43]; mq[4] = *(const LAS f32x4*)(Mg + 2960);
            ab0 -= mq[5][0] * xy[44]; xy[45] = ab0 + ab1; up[5760] = xy[45][0]; wp[5760] = f2bf(-xy[45][1]); mq[5] = *(const LAS f32x4*)(Mg + 2964);
            { const float br = betg[46]; ab0 = (f32x2){bf2f(*(const LAS bf16_t*)(lg + P5_VS + 12512 + c * 2)) * br, bf2f(*(const LAS bf16_t*)(lg + P5_KS + 12512 + c * 2)) * br * __expf(decg[46])}; ab1 = (f32x2){0.f, 0.f}; } ab0 -= mq[0][0] * xy[0]; ab1 -= mq[0][1] * xy[1]; ab0 -= mq[0][2] * xy[2]; ab1 -= mq[0][3] * xy[3]; mq[0] = *(const LAS f32x4*)(Mg + 2968);
            ab0 -= mq[1][0] * xy[4]; ab1 -= mq[1][1] * xy[5]; ab0 -= mq[1][2] * xy[6]; ab1 -= mq[1][3] * xy[7]; mq[1] = *(const LAS f32x4*)(Mg + 2972);
            ab0 -= mq[2][0] * xy[8]; ab1 -= mq[2][1] * xy[9]; ab0 -= mq[2][2] * xy[10]; ab1 -= mq[2][3] * xy[11]; mq[2] = *(const LAS f32x4*)(Mg + 2976);
            ab0 -= mq[3][0] * xy[12]; ab1 -= mq[3][1] * xy[13]; ab0 -= mq[3][2] * xy[14]; ab1 -= mq[3][3] * xy[15]; mq[3] = *(const LAS f32x4*)(Mg + 2980);
            ab0 -= mq[4][0] * xy[16]; ab1 -= mq[4][1] * xy[17]; ab0 -= mq[4][2] * xy[18]; ab1 -= mq[4][3] * xy[19]; mq[4] = *(const LAS f32x4*)(Mg + 2984);
            ab0 -= mq[5][0] * xy[20]; ab1 -= mq[5][1] * xy[21]; ab0 -= mq[5][2] * xy[22]; ab1 -= mq[5][3] * xy[23]; mq[5] = *(const LAS f32x4*)(Mg + 2988);
            ab0 -= mq[0][0] * xy[24]; ab1 -= mq[0][1] * xy[25]; ab0 -= mq[0][2] * xy[26]; ab1 -= mq[0][3] * xy[27]; mq[0] = *(const LAS f32x4*)(Mg + 3008);
            ab0 -= mq[1][0] * xy[28]; ab1 -= mq[1][1] * xy[29]; ab0 -= mq[1][2] * xy[30]; ab1 -= mq[1][3] * xy[31]; mq[1] = *(const LAS f32x4*)(Mg + 3012);
            ab0 -= mq[2][0] * xy[32]; ab1 -= mq[2][1] * xy[33]; ab0 -= mq[2][2] * xy[34]; ab1 -= mq[2][3] * xy[35]; mq[2] = *(const LAS f32x4*)(Mg + 3016);
            ab0 -= mq[3][0] * xy[36]; ab1 -= mq[3][1] * xy[37]; ab0 -= mq[3][2] * xy[38]; ab1 -= mq[3][3] * xy[39]; mq[3] = *(const LAS f32x4*)(Mg + 3020);
            ab0 -= mq[4][0] * xy[40]; ab1 -= mq[4][1] * xy[41]; ab0 -= mq[4][2] * xy[42]; ab1 -= mq[4][3] * xy[43]; mq[4] = *(const LAS f32x4*)(Mg + 3024);
            ab0 -= mq[5][0] * xy[44]; ab1 -= mq[5][1] * xy[45]; xy[46] = ab0 + ab1; up[5888] = xy[46][0]; wp[5888] = f2bf(-xy[46][1]); mq[5] = *(const LAS f32x4*)(Mg + 3028);
            { const float br = betg[47]; ab0 = (f32x2){bf2f(*(const LAS bf16_t*)(lg + P5_VS + 12784 + c * 2)) * br, bf2f(*(const LAS bf16_t*)(lg + P5_KS + 12784 + c * 2)) * br * __expf(decg[47])}; ab1 = (f32x2){0.f, 0.f}; } ab0 -= mq[0][0] * xy[0]; ab1 -= mq[0][1] * xy[1]; ab0 -= mq[0][2] * xy[2]; ab1 -= mq[0][3] * xy[3]; mq[0] = *(const LAS f32x4*)(Mg + 3032);
            ab0 -= mq[1][0] * xy[4]; ab1 -= mq[1][1] * xy[5]; ab0 -= mq[1][2] * xy[6]; ab1 -= mq[1][3] * xy[7]; mq[1] = *(const LAS f32x4*)(Mg + 3036);
            ab0 -= mq[2][0] * xy[8]; ab1 -= mq[2][1] * xy[9]; ab0 -= mq[2][2] * xy[10]; ab1 -= mq[2][3] * xy[11]; mq[2] = *(const LAS f32x4*)(Mg + 3040);
            ab0 -= mq[3][0] * xy[12]; ab1 -= mq[3][1] * xy[13]; ab0 -= mq[3][2] * xy[14]; ab1 -= mq[3][3] * xy[15]; mq[3] = *(const LAS f32x4*)(Mg + 3044);
            ab0 -= mq[4][0] * xy[16]; ab1 -= mq[4][1] * xy[17]; ab0 -= mq[4][2] * xy[18]; ab1 -= mq[4][3] * xy[19]; mq[4] = *(const LAS f32x4*)(Mg + 3048);
            ab0 -= mq[5][0] * xy[20]; ab1 -= mq[5][1] * xy[21]; ab0 -= mq[5][2] * xy[22]; ab1 -= mq[5][3] * xy[23]; mq[5] = *(const LAS f32x4*)(Mg + 3052);
            ab0 -= mq[0][0] * xy[24]; ab1 -= mq[0][1] * xy[25]; ab0 -= mq[0][2] * xy[26]; ab1 -= mq[0][3] * xy[27]; mq[0] = *(const LAS f32x4*)(Mg + 3072);
            ab0 -= mq[1][0] * xy[28]; ab1 -= mq[1][1] * xy[29]; ab0 -= mq[1][2] * xy[30]; ab1 -= mq[1][3] * xy[31]; mq[1] = *(const LAS f32x4*)(Mg + 3076);
            ab0 -= mq[2][0] * xy[32]; ab1 -= mq[2][1] * xy[33]; ab0 -= mq[2][2] * xy[34]; ab1 -= mq[2][3] * xy[35]; mq[2] = *(const LAS f32x4*)(Mg + 3080);
            ab0 -= mq[3][0] * xy[36]; ab1 -= mq[3][1] * xy[37]; ab0 -= mq[3][2] * xy[38]; ab1 -= mq[3][3] * xy[39]; mq[3] = *(const LAS f32x4*)(Mg + 3084);
            ab0 -= mq[4][0] * xy[40]; ab1 -= mq[4][1] * xy[41]; ab0 -= mq[4][2] * xy[42]; ab1 -= mq[4][3] * xy[43]; mq[4] = *(const LAS f32x4*)(Mg + 3088);
            ab0 -= mq[5][0] * xy[44]; ab1 -= mq[5][1] * xy[45]; ab0 -= mq[5][2] * xy[46]; xy[47] = ab0 + ab1; up[6016] = xy[47][0]; wp[6016] = f2bf(-xy[47][1]); mq[5] = *(const LAS f32x4*)(Mg + 3092);
            { const float br = betg[48]; ab0 = (f32x2){bf2f(*(const LAS bf16_t*)(lg + P5_VS + 13056 + c * 2)) * br, bf2f(*(const LAS bf16_t*)(lg + P5_KS + 13056 + c * 2)) * br * __expf(decg[48])}; ab1 = (f32x2){0.f, 0.f}; } ab0 -= mq[0][0] * xy[0]; ab1 -= mq[0][1] * xy[1]; ab0 -= mq[0][2] * xy[2]; ab1 -= mq[0][3] * xy[3]; mq[0] = *(const LAS f32x4*)(Mg + 3096);
            ab0 -= mq[1][0] * xy[4]; ab1 -= mq[1][1] * xy[5]; ab0 -= mq[1][2] * xy[6]; ab1 -= mq[1][3] * xy[7]; mq[1] = *(const LAS f32x4*)(Mg + 3100);
            ab0 -= mq[2][0] * xy[8]; ab1 -= mq[2][1] * xy[9]; ab0 -= mq[2][2] * xy[10]; ab1 -= mq[2][3] * xy[11]; mq[2] = *(const LAS f32x4*)(Mg + 3104);
            ab0 -= mq[3][0] * xy[12]; ab1 -= mq[3][1] * xy[13]; ab0 -= mq[3][2] * xy[14]; ab1 -= mq[3][3] * xy[15]; mq[3] = *(const LAS f32x4*)(Mg + 3108);
            ab0 -= mq[4][0] * xy[16]; ab1 -= mq[4][1] * xy[17]; ab0 -= mq[4][2] * xy[18]; ab1 -= mq[4][3] * xy[19]; mq[4] = *(const LAS f32x4*)(Mg + 3112);
            ab0 -= mq[5][0] * xy[20]; ab1 -= mq[5][1] * xy[21]; ab0 -= mq[5][2] * xy[22]; ab1 -= mq[5][3] * xy[23]; mq[5] = *(const LAS f32x4*)(Mg + 3116);
            ab0 -= mq[0][0] * xy[24]; ab1 -= mq[0][1] * xy[25]; ab0 -= mq[0][2] * xy[26]; ab1 -= mq[0][3] * xy[27]; mq[0] = *(const LAS f32x4*)(Mg + 3136);
            ab0 -= mq[1][0] * xy[28]; ab1 -= mq[1][1] * xy[29]; ab0 -= mq[1][2] * xy[30]; ab1 -= mq[1][3] * xy[31]; mq[1] = *(const LAS f32x4*)(Mg + 3140);
            ab0 -= mq[2][0] * xy[32]; ab1 -= mq[2][1] * xy[33]; ab0 -= mq[2][2] * xy[34]; ab1 -= mq[2][3] * xy[35]; mq[2] = *(const LAS f32x4*)(Mg + 3144);
            ab0 -= mq[3][0] * xy[36]; ab1 -= mq[3][1] * xy[37]; ab0 -= mq[3][2] * xy[38]; ab1 -= mq[3][3] * xy[39]; mq[3] = *(const LAS f32x4*)(Mg + 3148);
            ab0 -= mq[4][0] * xy[40]; ab1 -= mq[4][1] * xy[41]; ab0 -= mq[4][2] * xy[42]; ab1 -= mq[4][3] * xy[43]; mq[4] = *(const LAS f32x4*)(Mg + 3152);
            ab0 -= mq[5][0] * xy[44]; ab1 -= mq[5][1] * xy[45]; ab0 -= mq[5][2] * xy[46]; ab1 -= mq[5][3] * xy[47]; xy[48] = ab0 + ab1; up[6144] = xy[48][0]; wp[6144] = f2bf(-xy[48][1]); mq[5] = *(const LAS f32x4*)(Mg + 3156);
            { const float br = betg[49]; ab0 = (f32x2){bf2f(*(const LAS bf16_t*)(lg + P5_VS + 13328 + c * 2)) * br, bf2f(*(const LAS bf16_t*)(lg + P5_KS + 13328 + c * 2)) * br * __expf(decg[49])}; ab1 = (f32x2){0.f, 0.f}; } ab0 -= mq[0][0] * xy[0]; ab1 -= mq[0][1] * xy[1]; ab0 -= mq[0][2] * xy[2]; ab1 -= mq[0][3] * xy[3]; mq[0] = *(const LAS f32x4*)(Mg + 3160);
            ab0 -= mq[1][0] * xy[4]; ab1 -= mq[1][1] * xy[5]; ab0 -= mq[1][2] * xy[6]; ab1 -= mq[1][3] * xy[7]; mq[1] = *(const LAS f32x4*)(Mg + 3164);
            ab0 -= mq[2][0] * xy[8]; ab1 -= mq[2][1] * xy[9]; ab0 -= mq[2][2] * xy[10]; ab1 -= mq[2][3] * xy[11]; mq[2] = *(const LAS f32x4*)(Mg + 3168);
            ab0 -= mq[3][0] * xy[12]; ab1 -= mq[3][1] * xy[13]; ab0 -= mq[3][2] * xy[14]; ab1 -= mq[3][3] * xy[15]; mq[3] = *(const LAS f32x4*)(Mg + 3172);
            ab0 -= mq[4][0] * xy[16]; ab1 -= mq[4][1] * xy[17]; ab0 -= mq[4][2] * xy[18]; ab1 -= mq[4][3] * xy[19]; mq[4] = *(const LAS f32x4*)(Mg + 3176);
            ab0 -= mq[5][0] * xy[20]; ab1 -= mq[5][1] * xy[21]; ab0 -= mq[5][2] * xy[22]; ab1 -= mq[5][3] * xy[23]; mq[5] = *(const LAS f32x4*)(Mg + 3180);
            ab0 -= mq[0][0] * xy[24]; ab1 -= mq[0][1] * xy[25]; ab0 -= mq[0][2] * xy[26]; ab1 -= mq[0][3] * xy[27]; mq[0] = *(const LAS f32x4*)(Mg + 3184);
            ab0 -= mq[1][0] * xy[28]; ab1 -= mq[1][1] * xy[29]; ab0 -= mq[1][2] * xy[30]; ab1 -= mq[1][3] * xy[31]; mq[1] = *(const LAS f32x4*)(Mg + 3200);
            ab0 -= mq[2][0] * xy[32]; ab1 -= mq[2][1] * xy[33]; ab0 -= mq[2][2] * xy[34]; ab1 -= mq[2][3] * xy[35]; mq[2] = *(const LAS f32x4*)(Mg + 3204);
            ab0 -= mq[3][0] * xy[36]; ab1 -= mq[3][1] * xy[37]; ab0 -= mq[3][2] * xy[38]; ab1 -= mq[3][3] * xy[39]; mq[3] = *(const LAS f32x4*)(Mg + 3208);
            ab0 -= mq[4][0] * xy[40]; ab1 -= mq[4][1] * xy[41]; ab0 -= mq[4][2] * xy[42]; ab1 -= mq[4][3] * xy[43]; mq[4] = *(const LAS f32x4*)(Mg + 3212);
            ab0 -= mq[5][0] * xy[44]; ab1 -= mq[5][1] * xy[45]; ab0 -= mq[5][2] * xy[46]; ab1 -= mq[5][3] * xy[47]; mq[5] = *(const LAS f32x4*)(Mg + 3216);
            ab0 -= mq[0][0] * xy[48]; xy[49] = ab0 + ab1; up[6272] = xy[49][0]; wp[6272] = f2bf(-xy[49][1]); mq[0] = *(const LAS f32x4*)(Mg + 3220);
            { const float br = betg[50]; ab0 = (f32x2){bf2f(*(const LAS bf16_t*)(lg + P5_VS + 13600 + c * 2)) * br, bf2f(*(const LAS bf16_t*)(lg + P5_KS + 13600 + c * 2)) * br * __expf(decg[50])}; ab1 = (f32x2){0.f, 0.f}; } ab0 -= mq[1][0] * xy[0]; ab1 -= mq[1][1] * xy[1]; ab0 -= mq[1][2] * xy[2]; ab1 -= mq[1][3] * xy[3]; mq[1] = *(const LAS f32x4*)(Mg + 3224);
            ab0 -= mq[2][0] * xy[4]; ab1 -= mq[2][1] * xy[5]; ab0 -= mq[2][2] * xy[6]; ab1 -= mq[2][3] * xy[7]; mq[2] = *(const LAS f32x4*)(Mg + 3228);
            ab0 -= mq[3][0] * xy[8]; ab1 -= mq[3][1] * xy[9]; ab0 -= mq[3][2] * xy[10]; ab1 -= mq[3][3] * xy[11]; mq[3] = *(const LAS f32x4*)(Mg + 3232);
            ab0 -= mq[4][0] * xy[12]; ab1 -= mq[4][1] * xy[13]; ab0 -= mq[4][2] * xy[14]; ab1 -= mq[4][3] * xy[15]; mq[4] = *(const LAS f32x4*)(Mg + 3236);
            ab0 -= mq[5][0] * xy[16]; ab1 -= mq[5][1] * xy[17]; ab0 -= mq[5][2] * xy[18]; ab1 -= mq[5][3] * xy[19]; mq[5] = *(const LAS f32x4*)(Mg + 3240);
            ab0 -= mq[0][0] * xy[20]; ab1 -= mq[0][1] * xy[21]; ab0 -= mq[0][2] * xy[22]; ab1 -= mq[0][3] * xy[23]; mq[0] = *(const LAS f32x4*)(Mg + 3244);
            ab0 -= mq[1][0] * xy[24]; ab1 -= mq[1][1] * xy[25]; ab0 -= mq[1][2] * xy[26]; ab1 -= mq[1][3] * xy[27]; mq[1] = *(const LAS f32x4*)(Mg + 3248);
            ab0 -= mq[2][0] * xy[28]; ab1 -= mq[2][1] * xy[29]; ab0 -= mq[2][2] * xy[30]; ab1 -= mq[2][3] * xy[31]; mq[2] = *(const LAS f32x4*)(Mg + 3264);
            ab0 -= mq[3][0] * xy[32]; ab1 -= mq[3][1] * xy[33]; ab0 -= mq[3][2] * xy[34]; ab1 -= mq[3][3] * xy[35]; mq[3] = *(const LAS f32x4*)(Mg + 3268);
            ab0 -= mq[4][0] * xy[36]; ab1 -= mq[4][1] * xy[37]; ab0 -= mq[4][2] * xy[38]; ab1 -= mq[4][3] * xy[39]; mq[4] = *(const LAS f32x4*)(Mg + 3272);
            ab0 -= mq[5][0] * xy[40]; ab1 -= mq[5][1] * xy[41]; ab0 -= mq[5][2] * xy[42]; ab1 -= mq[5][3] * xy[43]; mq[5] = *(const LAS f32x4*)(Mg + 3276);
            ab0 -= mq[0][0] * xy[44]; ab1 -= mq[0][1] * xy[45]; ab0 -= mq[0][2] * xy[46]; ab1 -= mq[0][3] * xy[47]; mq[0] = *(const LAS f32x4*)(Mg + 3280);
            ab0 -= mq[1][0] * xy[48]; ab1 -= mq[1][1] * xy[49]; xy[50] = ab0 + ab1; up[6400] = xy[50][0]; wp[6400] = f2bf(-xy[50][1]); mq[1] = *(const LAS f32x4*)(Mg + 3284);
            { const float br = betg[51]; ab0 = (f32x2){bf2f(*(const LAS bf16_t*)(lg + P5_VS + 13872 + c * 2)) * br, bf2f(*(const LAS bf16_t*)(lg + P5_KS + 13872 + c * 2)) * br * __expf(decg[51])}; ab1 = (f32x2){0.f, 0.f}; } ab0 -= mq[2][0] * xy[0]; ab1 -= mq[2][1] * xy[1]; ab0 -= mq[2][2] * xy[2]; ab1 -= mq[2][3] * xy[3]; mq[2] = *(const LAS f32x4*)(Mg + 3288);
            ab0 -= mq[3][0] * xy[4]; ab1 -= mq[3][1] * xy[5]; ab0 -= mq[3][2] * xy[6]; ab1 -= mq[3][3] * xy[7]; mq[3] = *(const LAS f32x4*)(Mg + 3292);
            ab0 -= mq[4][0] * xy[8]; ab1 -= mq[4][1] * xy[9]; ab0 -= mq[4][2] * xy[10]; ab1 -= mq[4][3] * xy[11]; mq[4] = *(const LAS f32x4*)(Mg + 3296);
            ab0 -= mq[5][0] * xy[12]; ab1 -= mq[5][1] * xy[13]; ab0 -= mq[5][2] * xy[14]; ab1 -= mq[5][3] * xy[15]; mq[5] = *(const LAS f32x4*)(Mg + 3300);
            ab0 -= mq[0][0] * xy[16]; ab1 -= mq[0][1] * xy[17]; ab0 -= mq[0][2] * xy[18]; ab1 -= mq[0][3] * xy[19]; mq[0] = *(const LAS f32x4*)(Mg + 3304);
            ab0 -= mq[1][0] * xy[20]; ab1 -= mq[1][1] * xy[21]; ab0 -= mq[1][2] * xy[22]; ab1 -= mq[1][3] * xy[23]; mq[1] = *(const LAS f32x4*)(Mg + 3308);
            ab0 -= mq[2][0] * xy[24]; ab1 -= mq[2][1] * xy[25]; ab0 -= mq[2][2] * xy[26]; ab1 -= mq[2][3] * xy[27]; mq[2] = *(const LAS f32x4*)(Mg + 3312);
            ab0 -= mq[3][0] * xy[28]; ab1 -= mq[3][1] * xy[29]; ab0 -= mq[3][2] * xy[30]; ab1 -= mq[3][3] * xy[31]; mq[3] = *(const LAS f32x4*)(Mg + 3328);
            ab0 -= mq[4][0] * xy[32]; ab1 -= mq[4][1] * xy[33]; ab0 -= mq[4][2] * xy[34]; ab1 -= mq[4][3] * xy[35]; mq[4] = *(const LAS f32x4*)(Mg + 3332);
            ab0 -= mq[5][0] * xy[36]; ab1 -= mq[5][1] * xy[37]; ab0 -= mq[5][2] * xy[38]; ab1 -= mq[5][3] * xy[39]; mq[5] = *(const LAS f32x4*)(Mg + 3336);
            ab0 -= mq[0][0] * xy[40]; ab1 -= mq[0][1] * xy[41]; ab0 -= mq[0][2] * xy[42]; ab1 -= mq[0][3] * xy[43]; mq[0] = *(const LAS f32x4*)(Mg + 3340);
            ab0 -= mq[1][0] * xy[44]; ab1 -= mq[1][1] * xy[45]; ab0 -= mq[1][2] * xy[46]; ab1 -= mq[1][3] * xy[47]; mq[1] = *(const LAS f32x4*)(Mg + 3344);
            ab0 -= mq[2][0] * xy[48]; ab1 -= mq[2][1] * xy[49]; ab0 -= mq[2][2] * xy[50]; xy[51] = ab0 + ab1; up[6528] = xy[51][0]; wp[6528] = f2bf(-xy[51][1]); mq[2] = *(const LAS f32x4*)(Mg + 3348);
            { const float br = betg[52]; ab0 = (f32x2){bf2f(*(const LAS bf16_t*)(lg + P5_VS + 14144 + c * 2)) * br, bf2f(*(const LAS bf16_t*)(lg + P5_KS + 14144 + c * 2)) * br * __expf(decg[52])}; ab1 = (f32x2){0.f, 0.f}; } ab0 -= mq[3][0] * xy[0]; ab1 -= mq[3][1] * xy[1]; ab0 -= mq[3][2] * xy[2]; ab1 -= mq[3][3] * xy[3]; mq[3] = *(const LAS f32x4*)(Mg + 3352);
            ab0 -= mq[4][0] * xy[4]; ab1 -= mq[4][1] * xy[5]; ab0 -= mq[4][2] * xy[6]; ab1 -= mq[4][3] * xy[7]; mq[4] = *(const LAS f32x4*)(Mg + 3356);
            ab0 -= mq[5][0] * xy[8]; ab1 -= mq[5][1] * xy[9]; ab0 -= mq[5][2] * xy[10]; ab1 -= mq[5][3] * xy[11]; mq[5] = *(const LAS f32x4*)(Mg + 3360);
            ab0 -= mq[0][0] * xy[12]; ab1 -= mq[0][1] * xy[13]; ab0 -= mq[0][2] * xy[14]; ab1 -= mq[0][3] * xy[15]; mq[0] = *(const LAS f32x4*)(Mg + 3364);
            ab0 -= mq[1][0] * xy[16]; ab1 -= mq[1][1] * xy[17]; ab0 -= mq[1][2] * xy[18]; ab1 -= mq[1][3] * xy[19]; mq[1] = *(const LAS f32x4*)(Mg + 3368);
            ab0 -= mq[2][0] * xy[20]; ab1 -= mq[2][1] * xy[21]; ab0 -= mq[2][2] * xy[22]; ab1 -= mq[2][3] * xy[23]; mq[2] = *(const LAS f32x4*)(Mg + 3372);
            ab0 -= mq[3][0] * xy[24]; ab1 -= mq[3][1] * xy[25]; ab0 -= mq[3][2] * xy[26]; ab1 -= mq[3][3] * xy[27]; mq[3] = *(const LAS f32x4*)(Mg + 3376);
            ab0 -= mq[4][0] * xy[28]; ab1 -= mq[4][1] * xy[29]; ab0 -= mq[4][2] * xy[30]; ab1 -= mq[4][3] * xy[31]; mq[4] = *(const LAS f32x4*)(Mg + 3392);
            ab0 -= mq[5][0] * xy[32]; ab1 -= mq[5][1] * xy[33]; ab0 -= mq[5][2] * xy[34]; ab1 -= mq[5][3] * xy[35]; mq[5] = *(const LAS f32x4*)(Mg + 3396);
            ab0 -= mq[0][0] * xy[36]; ab1 -= mq[0][1] * xy[37]; ab0 -= mq[0][2] * xy[38]; ab1 -= mq[0][3] * xy[39]; mq[0] = *(const LAS f32x4*)(Mg + 3400);
            ab0 -= mq[1][0] * xy[40]; ab1 -= mq[1][1] * xy[41]; ab0 -= mq[1][2] * xy[42]; ab1 -= mq[1][3] * xy[43]; mq[1] = *(const LAS f32x4*)(Mg + 3404);
            ab0 -= mq[2][0] * xy[44]; ab1 -= mq[2][1] * xy[45]; ab0 -= mq[2][2] * xy[46]; ab1 -= mq[2][3] * xy[47]; mq[2] = *(const LAS f32x4*)(Mg + 3408);
            ab0 -= mq[3][0] * xy[48]; ab1 -= mq[3][1] * xy[49]; ab0 -= mq[3][2] * xy[50]; ab1 -= mq[3][3] * xy[51]; xy[52] = ab0 + ab1; up[6656] = xy[52][0]; wp[6656] = f2bf(-xy[52][1]); mq[3] = *(const LAS f32x4*)(Mg + 3412);
            { const float br = betg[53]; ab0 = (f32x2){bf2f(*(const LAS bf16_t*)(lg + P5_VS + 14416 + c * 2)) * br, bf2f(*(const LAS bf16_t*)(lg + P5_KS + 14416 + c * 2)) * br * __expf(decg[53])}; ab1 = (f32x2){0.f, 0.f}; } ab0 -= mq[4][0] * xy[0]; ab1 -= mq[4][1] * xy[1]; ab0 -= mq[4][2] * xy[2]; ab1 -= mq[4][3] * xy[3]; mq[4] = *(const LAS f32x4*)(Mg + 3416);
            ab0 -= mq[5][0] * xy[4]; ab1 -= mq[5][1] * xy[5]; ab0 -= mq[5][2] * xy[6]; ab1 -= mq[5][3] * xy[7]; mq[5] = *(const LAS f32x4*)(Mg + 3420);
            ab0 -= mq[0][0] * xy[8]; ab1 -= mq[0][1] * xy[9]; ab0 -= mq[0][2] * xy[10]; ab1 -= mq[0][3] * xy[11]; mq[0] = *(const LAS f32x4*)(Mg + 3424);
            ab0 -= mq[1][0] * xy[12]; ab1 -= mq[1][1] * xy[13]; ab0 -= mq[1][2] * xy[14]; ab1 -= mq[1][3] * xy[15]; mq[1] = *(const LAS f32x4*)(Mg + 3428);
            ab0 -= mq[2][0] * xy[16]; ab1 -= mq[2][1] * xy[17]; ab0 -= mq[2][2] * xy[18]; ab1 -= mq[2][3] * xy[19]; mq[2] = *(const LAS f32x4*)(Mg + 3432);
            ab0 -= mq[3][0] * xy[20]; ab1 -= mq[3][1] * xy[21]; ab0 -= mq[3][2] * xy[22]; ab1 -= mq[3][3] * xy[23]; mq[3] = *(const LAS f32x4*)(Mg + 3436);
            ab0 -= mq[4][0] * xy[24]; ab1 -= mq[4][1] * xy[25]; ab0 -= mq[4][2] * xy[26]; ab1 -= mq[4][3] * xy[27]; mq[4] = *(const LAS f32x4*)(Mg + 3440);
            ab0 -= mq[5][0] * xy[28]; ab1 -= mq[5][1] * xy[29]; ab0 -= mq[5][2] * xy[30]; ab1 -= mq[5][3] * xy[31]; mq[5] = *(const LAS f32x4*)(Mg + 3444);
            ab0 -= mq[0][0] * xy[32]; ab1 -= mq[0][1] * xy[33]; ab0 -= mq[0][2] * xy[34]; ab1 -= mq[0][3] * xy[35]; mq[0] = *(const LAS f32x4*)(Mg + 3456);
            ab0 -= mq[1][0] * xy[36]; ab1 -= mq[1][1] * xy[37]; ab0 -= mq[1][2] * xy[38]; ab1 -= mq[1][3] * xy[39]; mq[1] = *(const LAS f32x4*)(Mg + 3460);
            ab0 -= mq[2][0] * xy[40]; ab1 -= mq[2][1] * xy[41]; ab0 -= mq[2][2] * xy[42]; ab1 -= mq[2][3] * xy[43]; mq[2] = *(const LAS f32x4*)(Mg + 3464);
            ab0 -= mq[3][0] * xy[44]; ab1 -= mq[3][1] * xy[45]; ab0 -= mq[3][2] * xy[46]; ab1 -= mq[3][3] * xy[47]; mq[3] = *(const LAS f32x4*)(Mg + 3468);
            ab0 -= mq[4][0] * xy[48]; ab1 -= mq[4][1] * xy[49]; ab0 -= mq[4][2] * xy[50]; ab1 -= mq[4][3] * xy[51]; mq[4] = *(const LAS f32x4*)(Mg + 3472);
            ab0 -= mq[5][0] * xy[52]; xy[53] = ab0 + ab1; up[6784] = xy[53][0]; wp[6784] = f2bf(-xy[53][1]); mq[5] = *(const LAS f32x4*)(Mg + 3476);
            { const float br = betg[54]; ab0 = (f32x2){bf2f(*(const LAS bf16_t*)(lg + P5_VS + 14688 + c * 2)) * br, bf2f(*(const LAS bf16_t*)(lg + P5_KS + 14688 + c * 2)) * br * __expf(decg[54])}; ab1 = (f32x2){0.f, 0.f}; } ab0 -= mq[0][0] * xy[0]; ab1 -= mq[0][1] * xy[1]; ab0 -= mq[0][2] * xy[2]; ab1 -= mq[0][3] * xy[3]; mq[0] = *(const LAS f32x4*)(Mg + 3480);
            ab0 -= mq[1][0] * xy[4]; ab1 -= mq[1][1] * xy[5]; ab0 -= mq[1][2] * xy[6]; ab1 -= mq[1][3] * xy[7]; mq[1] = *(const LAS f32x4*)(Mg + 3484);
            ab0 -= mq[2][0] * xy[8]; ab1 -= mq[2][1] * xy[9]; ab0 -= mq[2][2] * xy[10]; ab1 -= mq[2][3] * xy[11]; mq[2] = *(const LAS f32x4*)(Mg + 3488);
            ab0 -= mq[3][0] * xy[12]; ab1 -= mq[3][1] * xy[13]; ab0 -= mq[3][2] * xy[14]; ab1 -= mq[3][3] * xy[15]; mq[3] = *(const LAS f32x4*)(Mg + 3492);
            ab0 -= mq[4][0] * xy[16]; ab1 -= mq[4][1] * xy[17]; ab0 -= mq[4][2] * xy[18]; ab1 -= mq[4][3] * xy[19]; mq[4] = *(const LAS f32x4*)(Mg + 3496);
            ab0 -= mq[5][0] * xy[20]; ab1 -= mq[5][1] * xy[21]; ab0 -= mq[5][2] * xy[22]; ab1 -= mq[5][3] * xy[23]; mq[5] = *(const LAS f32x4*)(Mg + 3500);
            ab0 -= mq[0][0] * xy[24]; ab1 -= mq[0][1] * xy[25]; ab0 -= mq[0][2] * xy[26]; ab1 -= mq[0][3] * xy[27]; mq[0] = *(const LAS f32x4*)(Mg + 3504);
            ab0 -= mq[1][0] * xy[28]; ab1 -= mq[1][1] * xy[29]; ab0 -= mq[1][2] * xy[30]; ab1 -= mq[1][3] * xy[31]; mq[1] = *(const LAS f32x4*)(Mg + 3508);
            ab0 -= mq[2][0] * xy[32]; ab1 -= mq[2][1] * xy[33]; ab0 -= mq[2][2] * xy[34]; ab1 -= mq[2][3] * xy[35]; mq[2] = *(const LAS f32x4*)(Mg + 3520);
            ab0 -= mq[3][0] * xy[36]; ab1 -= mq[3][1] * xy[37]; ab0 -= mq[3][2] * xy[38]; ab1 -= mq[3][3] * xy[39]; mq[3] = *(const LAS f32x4*)(Mg + 3524);
            ab0 -= mq[4][0] * xy[40]; ab1 -= mq[4][1] * xy[41]; ab0 -= mq[4][2] * xy[42]; ab1 -= mq[4][3] * xy[43]; mq[4] = *(const LAS f32x4*)(Mg + 3528);
            ab0 -= mq[5][0] * xy[44]; ab1 -= mq[5][1] * xy[45]; ab0 -= mq[5][2] * xy[46]; ab1 -= mq[5][3] * xy[47]; mq[5] = *(const LAS f32x4*)(Mg + 3532);
            ab0 -= mq[0][0] * xy[48]; ab1 -= mq[0][1] * xy[49]; ab0 -= mq[0][2] * xy[50]; ab1 -= mq[0][3] * xy[51]; mq[0] = *(const LAS f32x4*)(Mg + 3536);
            ab0 -= mq[1][0] * xy[52]; ab1 -= mq[1][1] * xy[53]; xy[54] = ab0 + ab1; up[6912] = xy[54][0]; wp[6912] = f2bf(-xy[54][1]); mq[1] = *(const LAS f32x4*)(Mg + 3540);
            { const float br = betg[55]; ab0 = (f32x2){bf2f(*(const LAS bf16_t*)(lg + P5_VS + 14960 + c * 2)) * br, bf2f(*(const LAS bf16_t*)(lg + P5_KS + 14960 + c * 2)) * br * __expf(decg[55])}; ab1 = (f32x2){0.f, 0.f}; } ab0 -= mq[2][0] * xy[0]; ab1 -= mq[2][1] * xy[1]; ab0 -= mq[2][2] * xy[2]; ab1 -= mq[2][3] * xy[3]; mq[2] = *(const LAS f32x4*)(Mg + 3544);
            ab0 -= mq[3][0] * xy[4]; ab1 -= mq[3][1] * xy[5]; ab0 -= mq[3][2] * xy[6]; ab1 -= mq[3][3] * xy[7]; mq[3] = *(const LAS f32x4*)(Mg + 3548);
            ab0 -= mq[4][0] * xy[8]; ab1 -= mq[4][1] * xy[9]; ab0 -= mq[4][2] * xy[10]; ab1 -= mq[4][3] * xy[11]; mq[4] = *(const LAS f32x4*)(Mg + 3552);
            ab0 -= mq[5][0] * xy[12]; ab1 -= mq[5][1] * xy[13]; ab0 -= mq[5][2] * xy[14]; ab1 -= mq[5][3] * xy[15]; mq[5] = *(const LAS f32x4*)(Mg + 3556);
            ab0 -= mq[0][0] * xy[16]; ab1 -= mq[0][1] * xy[17]; ab0 -= mq[0][2] * xy[18]; ab1 -= mq[0][3] * xy[19]; mq[0] = *(const LAS f32x4*)(Mg + 3560);
            ab0 -= mq[1][0] * xy[20]; ab1 -= mq[1][1] * xy[21]; ab0 -= mq[1][2] * xy[22]; ab1 -= mq[1][3] * xy[23]; mq[1] = *(const LAS f32x4*)(Mg + 3564);
            ab0 -= mq[2][0] * xy[24]; ab1 -= mq[2][1] * xy[25]; ab0 -= mq[2][2] * xy[26]; ab1 -= mq[2][3] * xy[27]; mq[2] = *(const LAS f32x4*)(Mg + 3568);
            ab0 -= mq[3][0] * xy[28]; ab1 -= mq[3][1] * xy[29]; ab0 -= mq[3][2] * xy[30]; ab1 -= mq[3][3] * xy[31]; mq[3] = *(const LAS f32x4*)(Mg + 3572);
            ab0 -= mq[4][0] * xy[32]; ab1 -= mq[4][1] * xy[33]; ab0 -= mq[4][2] * xy[34]; ab1 -= mq[4][3] * xy[35]; mq[4] = *(const LAS f32x4*)(Mg + 3584);
            ab0 -= mq[5][0] * xy[36]; ab1 -= mq[5][1] * xy[37]; ab0 -= mq[5][2] * xy[38]; ab1 -= mq[5][3] * xy[39]; mq[5] = *(const LAS f32x4*)(Mg + 3588);
            ab0 -= mq[0][0] * xy[40]; ab1 -= mq[0][1] * xy[41]; ab0 -= mq[0][2] * xy[42]; ab1 -= mq[0][3] * xy[43]; mq[0] = *(const LAS f32x4*)(Mg + 3592);
            ab0 -= mq[1][0] * xy[44]; ab1 -= mq[1][1] * xy[45]; ab0 -= mq[1][2] * xy[46]; ab1 -= mq[1][3] * xy[47]; mq[1] = *(const LAS f32x4*)(Mg + 3596);
            ab0 -= mq[2][0] * xy[48]; ab1 -= mq[2][1] * xy[49]; ab0 -= mq[2][2] * xy[50]; ab1 -= mq[2][3] * xy[51]; mq[2] = *(const LAS f32x4*)(Mg + 3600);
            ab0 -= mq[3][0] * xy[52]; ab1 -= mq[3][1] * xy[53]; ab0 -= mq[3][2] * xy[54]; xy[55] = ab0 + ab1; up[7040] = xy[55][0]; wp[7040] = f2bf(-xy[55][1]); mq[3] = *(const LAS f32x4*)(Mg + 3604);
            { const float br = betg[56]; ab0 = (f32x2){bf2f(*(const LAS bf16_t*)(lg + P5_VS + 15232 + c * 2)) * br, bf2f(*(const LAS bf16_t*)(lg + P5_KS + 15232 + c * 2)) * br * __expf(decg[56])}; ab1 = (f32x2){0.f, 0.f}; } ab0 -= mq[4][0] * xy[0]; ab1 -= mq[4][1] * xy[1]; ab0 -= mq[4][2] * xy[2]; ab1 -= mq[4][3] * xy[3]; mq[4] = *(const LAS f32x4*)(Mg + 3608);
            ab0 -= mq[5][0] * xy[4]; ab1 -= mq[5][1] * xy[5]; ab0 -= mq[5][2] * xy[6]; ab1 -= mq[5][3] * xy[7]; mq[5] = *(const LAS f32x4*)(Mg + 3612);
            ab0 -= mq[0][0] * xy[8]; ab1 -= mq[0][1] * xy[9]; ab0 -= mq[0][2] * xy[10]; ab1 -= mq[0][3] * xy[11]; mq[0] = *(const LAS f32x4*)(Mg + 3616);
            ab0 -= mq[1][0] * xy[12]; ab1 -= mq[1][1] * xy[13]; ab0 -= mq[1][2] * xy[14]; ab1 -= mq[1][3] * xy[15]; mq[1] = *(const LAS f32x4*)(Mg + 3620);
            ab0 -= mq[2][0] * xy[16]; ab1 -= mq[2][1] * xy[17]; ab0 -= mq[2][2] * xy[18]; ab1 -= mq[2][3] * xy[19]; mq[2] = *(const LAS f32x4*)(Mg + 3624);
            ab0 -= mq[3][0] * xy[20]; ab1 -= mq[3][1] * xy[21]; ab0 -= mq[3][2] * xy[22]; ab1 -= mq[3][3] * xy[23]; mq[3] = *(const LAS f32x4*)(Mg + 3628);
            ab0 -= mq[4][0] * xy[24]; ab1 -= mq[4][1] * xy[25]; ab0 -= mq[4][2] * xy[26]; ab1 -= mq[4][3] * xy[27]; mq[4] = *(const LAS f32x4*)(Mg + 3632);
            ab0 -= mq[5][0] * xy[28]; ab1 -= mq[5][1] * xy[29]; ab0 -= mq[5][2] * xy[30]; ab1 -= mq[5][3] * xy[31]; mq[5] = *(const LAS f32x4*)(Mg + 3636);
            ab0 -= mq[0][0] * xy[32]; ab1 -= mq[0][1] * xy[33]; ab0 -= mq[0][2] * xy[34]; ab1 -= mq[0][3] * xy[35]; mq[0] = *(const LAS f32x4*)(Mg + 3648);
            ab0 -= mq[1][0] * xy[36]; ab1 -= mq[1][1] * xy[37]; ab0 -= mq[1][2] * xy[38]; ab1 -= mq[1][3] * xy[39]; mq[1] = *(const LAS f32x4*)(Mg + 3652);
            ab0 -= mq[2][0] * xy[40]; ab1 -= mq[2][1] * xy[41]; ab0 -= mq[2][2] * xy[42]; ab1 -= mq[2][3] * xy[43]; mq[2] = *(const LAS f32x4*)(Mg + 3656);
            ab0 -= mq[3][0] * xy[44]; ab1 -= mq[3][1] * xy[45]; ab0 -= mq[3][2] * xy[46]; ab1 -= mq[3][3] * xy[47]; mq[3] = *(const LAS f32x4*)(Mg + 3660);
            ab0 -= mq[4][0] * xy[48]; ab1 -= mq[4][1] * xy[49]; ab0 -= mq[4][2] * xy[50]; ab1 -= mq[4][3] * xy[51]; mq[4] = *(const LAS f32x4*)(Mg + 3664);
            ab0 -= mq[5][0] * xy[52]; ab1 -= mq[5][1] * xy[53]; ab0 -= mq[5][2] * xy[54]; ab1 -= mq[5][3] * xy[55]; xy[56] = ab0 + ab1; up[7168] = xy[56][0]; wp[7168] = f2bf(-xy[56][1]); mq[5] = *(const LAS f32x4*)(Mg + 3668);
            { const float br = betg[57]; ab0 = (f32x2){bf2f(*(const LAS bf16_t*)(lg + P5_VS + 15504 + c * 2)) * br, bf2f(*(const LAS bf16_t*)(lg + P5_KS + 15504 + c * 2)) * br * __expf(decg[57])}; ab1 = (f32x2){0.f, 0.f}; } ab0 -= mq[0][0] * xy[0]; ab1 -= mq[0][1] * xy[1]; ab0 -= mq[0][2] * xy[2]; ab1 -= mq[0][3] * xy[3]; mq[0] = *(const LAS f32x4*)(Mg + 3672);
            ab0 -= mq[1][0] * xy[4]; ab1 -= mq[1][1] * xy[5]; ab0 -= mq[1][2] * xy[6]; ab1 -= mq[1][3] * xy[7]; mq[1] = *(const LAS f32x4*)(Mg + 3676);
            ab0 -= mq[2][0] * xy[8]; ab1 -= mq[2][1] * xy[9]; ab0 -= mq[2][2] * xy[10]; ab1 -= mq[2][3] * xy[11]; mq[2] = *(const LAS f32x4*)(Mg + 3680);
            ab0 -= mq[3][0] * xy[12]; ab1 -= mq[3][1] * xy[13]; ab0 -= mq[3][2] * xy[14]; ab1 -= mq[3][3] * xy[15]; mq[3] = *(const LAS f32x4*)(Mg + 3684);
            ab0 -= mq[4][0] * xy[16]; ab1 -= mq[4][1] * xy[17]; ab0 -= mq[4][2] * xy[18]; ab1 -= mq[4][3] * xy[19]; mq[4] = *(const LAS f32x4*)(Mg + 3688);
            ab0 -= mq[5][0] * xy[20]; ab1 -= mq[5][1] * xy[21]; ab0 -= mq[5][2] * xy[22]; ab1 -= mq[5][3] * xy[23]; mq[5] = *(const LAS f32x4*)(Mg + 3692);
            ab0 -= mq[0][0] * xy[24]; ab1 -= mq[0][1] * xy[25]; ab0 -= mq[0][2] * xy[26]; ab1 -= mq[0][3] * xy[27]; mq[0] = *(const LAS f32x4*)(Mg + 3696);
            ab0 -= mq[1][0] * xy[28]; ab1 -= mq[1][1] * xy[29]; ab0 -= mq[1][2] * xy[30]; ab1 -= mq[1][3] * xy[31]; mq[1] = *(const LAS f32x4*)(Mg + 3700);
            ab0 -= mq[2][0] * xy[32]; ab1 -= mq[2][1] * xy[33]; ab0 -= mq[2][2] * xy[34]; ab1 -= mq[2][3] * xy[35]; mq[2] = *(const LAS f32x4*)(Mg + 3704);
            ab0 -= mq[3][0] * xy[36]; ab1 -= mq[3][1] * xy[37]; ab0 -= mq[3][2] * xy[38]; ab1 -= mq[3][3] * xy[39]; mq[3] = *(const LAS f32x4*)(Mg + 3712);
            ab0 -= mq[4][0] * xy[40]; ab1 -= mq[4][1] * xy[41]; ab0 -= mq[4][2] * xy[42]; ab1 -= mq[4][3] * xy[43]; mq[4] = *(const LAS f32x4*)(Mg + 3716);
            ab0 -= mq[5][0] * xy[44]; ab1 -= mq[5][1] * xy[45]; ab0 -= mq[5][2] * xy[46]; ab1 -= mq[5][3] * xy[47]; mq[5] = *(const LAS f32x4*)(Mg + 3720);
            ab0 -= mq[0][0] * xy[48]; ab1 -= mq[0][1] * xy[49]; ab0 -= mq[0][2] * xy[50]; ab1 -= mq[0][3] * xy[51]; mq[0] = *(const LAS f32x4*)(Mg + 3724);
            ab0 -= mq[1][0] * xy[52]; ab1 -= mq[1][1] * xy[53]; ab0 -= mq[1][2] * xy[54]; ab1 -= mq[1][3] * xy[55]; mq[1] = *(const LAS f32x4*)(Mg + 3728);
            ab0 -= mq[2][0] * xy[56]; xy[57] = ab0 + ab1; up[7296] = xy[57][0]; wp[7296] = f2bf(-xy[57][1]); mq[2] = *(const LAS f32x4*)(Mg + 3732);
            { const float br = betg[58]; ab0 = (f32x2){bf2f(*(const LAS bf16_t*)(lg + P5_VS + 15776 + c * 2)) * br, bf2f(*(const LAS bf16_t*)(lg + P5_KS + 15776 + c * 2)) * br * __expf(decg[58])}; ab1 = (f32x2){0.f, 0.f}; } ab0 -= mq[3][0] * xy[0]; ab1 -= mq[3][1] * xy[1]; ab0 -= mq[3][2] * xy[2]; ab1 -= mq[3][3] * xy[3]; mq[3] = *(const LAS f32x4*)(Mg + 3736);
            ab0 -= mq[4][0] * xy[4]; ab1 -= mq[4][1] * xy[5]; ab0 -= mq[4][2] * xy[6]; ab1 -= mq[4][3] * xy[7]; mq[4] = *(const LAS f32x4*)(Mg + 3740);
            ab0 -= mq[5][0] * xy[8]; ab1 -= mq[5][1] * xy[9]; ab0 -= mq[5][2] * xy[10]; ab1 -= mq[5][3] * xy[11]; mq[5] = *(const LAS f32x4*)(Mg + 3744);
            ab0 -= mq[0][0] * xy[12]; ab1 -= mq[0][1] * xy[13]; ab0 -= mq[0][2] * xy[14]; ab1 -= mq[0][3] * xy[15]; mq[0] = *(const LAS f32x4*)(Mg + 3748);
            ab0 -= mq[1][0] * xy[16]; ab1 -= mq[1][1] * xy[17]; ab0 -= mq[1][2] * xy[18]; ab1 -= mq[1][3] * xy[19]; mq[1] = *(const LAS f32x4*)(Mg + 3752);
            ab0 -= mq[2][0] * xy[20]; ab1 -= mq[2][1] * xy[21]; ab0 -= mq[2][2] * xy[22]; ab1 -= mq[2][3] * xy[23]; mq[2] = *(const LAS f32x4*)(Mg + 3756);
            ab0 -= mq[3][0] * xy[24]; ab1 -= mq[3][1] * xy[25]; ab0 -= mq[3][2] * xy[26]; ab1 -= mq[3][3] * xy[27]; mq[3] = *(const LAS f32x4*)(Mg + 3760);
            ab0 -= mq[4][0] * xy[28]; ab1 -= mq[4][1] * xy[29]; ab0 -= mq[4][2] * xy[30]; ab1 -= mq[4][3] * xy[31]; mq[4] = *(const LAS f32x4*)(Mg + 3764);
            ab0 -= mq[5][0] * xy[32]; ab1 -= mq[5][1] * xy[33]; ab0 -= mq[5][2] * xy[34]; ab1 -= mq[5][3] * xy[35]; mq[5] = *(const LAS f32x4*)(Mg + 3768);
            ab0 -= mq[0][0] * xy[36]; ab1 -= mq[0][1] * xy[37]; ab0 -= mq[0][2] * xy[38]; ab1 -= mq[0][3] * xy[39]; mq[0] = *(const LAS f32x4*)(Mg + 3776);
            ab0 -= mq[1][0] * xy[40]; ab1 -= mq[1][1] * xy[41]; ab0 -= mq[1][2] * xy[42]; ab1 -= mq[1][3] * xy[43]; mq[1] = *(const LAS f32x4*)(Mg + 3780);
            ab0 -= mq[2][0] * xy[44]; ab1 -= mq[2][1] * xy[45]; ab0 -= mq[2][2] * xy[46]; ab1 -= mq[2][3] * xy[47]; mq[2] = *(const LAS f32x4*)(Mg + 3784);
            ab0 -= mq[3][0] * xy[48]; ab1 -= mq[3][1] * xy[49]; ab0 -= mq[3][2] * xy[50]; ab1 -= mq[3][3] * xy[51]; mq[3] = *(const LAS f32x4*)(Mg + 3788);
            ab0 -= mq[4][0] * xy[52]; ab1 -= mq[4][1] * xy[53]; ab0 -= mq[4][2] * xy[54]; ab1 -= mq[4][3] * xy[55]; mq[4] = *(const LAS f32x4*)(Mg + 3792);
            ab0 -= mq[5][0] * xy[56]; ab1 -= mq[5][1] * xy[57]; xy[58] = ab0 + ab1; up[7424] = xy[58][0]; wp[7424] = f2bf(-xy[58][1]); mq[5] = *(const LAS f32x4*)(Mg + 3796);
            { const float br = betg[59]; ab0 = (f32x2){bf2f(*(const LAS bf16_t*)(lg + P5_VS + 16048 + c * 2)) * br, bf2f(*(const LAS bf16_t*)(lg + P5_KS + 16048 + c * 2)) * br * __expf(decg[59])}; ab1 = (f32x2){0.f, 0.f}; } ab0 -= mq[0][0] * xy[0]; ab1 -= mq[0][1] * xy[1]; ab0 -= mq[0][2] * xy[2]; ab1 -= mq[0][3] * xy[3]; mq[0] = *(const LAS f32x4*)(Mg + 3800);
            ab0 -= mq[1][0] * xy[4]; ab1 -= mq[1][1] * xy[5]; ab0 -= mq[1][2] * xy[6]; ab1 -= mq[1][3] * xy[7]; mq[1] = *(const LAS f32x4*)(Mg + 3804);
            ab0 -= mq[2][0] * xy[8]; ab1 -= mq[2][1] * xy[9]; ab0 -= mq[2][2] * xy[10]; ab1 -= mq[2][3] * xy[11]; mq[2] = *(const LAS f32x4*)(Mg + 3808);
            ab0 -= mq[3][0] * xy[12]; ab1 -= mq[3][1] * xy[13]; ab0 -= mq[3][2] * xy[14]; ab1 -= mq[3][3] * xy[15]; mq[3] = *(const LAS f32x4*)(Mg + 3812);
            ab0 -= mq[4][0] * xy[16]; ab1 -= mq[4][1] * xy[17]; ab0 -= mq[4][2] * xy[18]; ab1 -= mq[4][3] * xy[19]; mq[4] = *(const LAS f32x4*)(Mg + 3816);
            ab0 -= mq[5][0] * xy[20]; ab1 -= mq[5][1] * xy[21]; ab0 -= mq[5][2] * xy[22]; ab1 -= mq[5][3] * xy[23]; mq[5] = *(const LAS f32x4*)(Mg + 3820);
            ab0 -= mq[0][0] * xy[24]; ab1 -= mq[0][1] * xy[25]; ab0 -= mq[0][2] * xy[26]; ab1 -= mq[0][3] * xy[27]; mq[0] = *(const LAS f32x4*)(Mg + 3824);
            ab0 -= mq[1][0] * xy[28]; ab1 -= mq[1][1] * xy[29]; ab0 -= mq[1][2] * xy[30]; ab1 -= mq[1][3] * xy[31]; mq[1] = *(const LAS f32x4*)(Mg + 3828);
            ab0 -= mq[2][0] * xy[32]; ab1 -= mq[2][1] * xy[33]; ab0 -= mq[2][2] * xy[34]; ab1 -= mq[2][3] * xy[35]; mq[2] = *(const LAS f32x4*)(Mg + 3832);
            ab0 -= mq[3][0] * xy[36]; ab1 -= mq[3][1] * xy[37]; ab0 -= mq[3][2] * xy[38]; ab1 -= mq[3][3] * xy[39]; mq[3] = *(const LAS f32x4*)(Mg + 3840);
            ab0 -= mq[4][0] * xy[40]; ab1 -= mq[4][1] * xy[41]; ab0 -= mq[4][2] * xy[42]; ab1 -= mq[4][3] * xy[43]; mq[4] = *(const LAS f32x4*)(Mg + 3844);
            ab0 -= mq[5][0] * xy[44]; ab1 -= mq[5][1] * xy[45]; ab0 -= mq[5][2] * xy[46]; ab1 -= mq[5][3] * xy[47]; mq[5] = *(const LAS f32x4*)(Mg + 3848);
            ab0 -= mq[0][0] * xy[48]; ab1 -= mq[0][1] * xy[49]; ab0 -= mq[0][2] * xy[50]; ab1 -= mq[0][3] * xy[51]; mq[0] = *(const LAS f32x4*)(Mg + 3852);
            ab0 -= mq[1][0] * xy[52]; ab1 -= mq[1][1] * xy[53]; ab0 -= mq[1][2] * xy[54]; ab1 -= mq[1][3] * xy[55]; mq[1] = *(const LAS f32x4*)(Mg + 3856);
            ab0 -= mq[2][0] * xy[56]; ab1 -= mq[2][1] * xy[57]; ab0 -= mq[2][2] * xy[58]; xy[59] = ab0 + ab1; up[7552] = xy[59][0]; wp[7552] = f2bf(-xy[59][1]); mq[2] = *(const LAS f32x4*)(Mg + 3860);
            { const float br = betg[60]; ab0 = (f32x2){bf2f(*(const LAS bf16_t*)(lg + P5_VS + 16320 + c * 2)) * br, bf2f(*(const LAS bf16_t*)(lg + P5_KS + 16320 + c * 2)) * br * __expf(decg[60])}; ab1 = (f32x2){0.f, 0.f}; } ab0 -= mq[3][0] * xy[0]; ab1 -= mq[3][1] * xy[1]; ab0 -= mq[3][2] * xy[2]; ab1 -= mq[3][3] * xy[3]; mq[3] = *(const LAS f32x4*)(Mg + 3864);
            ab0 -= mq[4][0] * xy[4]; ab1 -= mq[4][1] * xy[5]; ab0 -= mq[4][2] * xy[6]; ab1 -= mq[4][3] * xy[7]; mq[4] = *(const LAS f32x4*)(Mg + 3868);
            ab0 -= mq[5][0] * xy[8]; ab1 -= mq[5][1] * xy[9]; ab0 -= mq[5][2] * xy[10]; ab1 -= mq[5][3] * xy[11]; mq[5] = *(const LAS f32x4*)(Mg + 3872);
            ab0 -= mq[0][0] * xy[12]; ab1 -= mq[0][1] * xy[13]; ab0 -= mq[0][2] * xy[14]; ab1 -= mq[0][3] * xy[15]; mq[0] = *(const LAS f32x4*)(Mg + 3876);
            ab0 -= mq[1][0] * xy[16]; ab1 -= mq[1][1] * xy[17]; ab0 -= mq[1][2] * xy[18]; ab1 -= mq[1][3] * xy[19]; mq[1] = *(const LAS f32x4*)(Mg + 3880);
            ab0 -= mq[2][0] * xy[20]; ab1 -= mq[2][1] * xy[21]; ab0 -= mq[2][2] * xy[22]; ab1 -= mq[2][3] * xy[23]; mq[2] = *(const LAS f32x4*)(Mg + 3884);
            ab0 -= mq[3][0] * xy[24]; ab1 -= mq[3][1] * xy[25]; ab0 -= mq[3][2] * xy[26]; ab1 -= mq[3][3] * xy[27]; mq[3] = *(const LAS f32x4*)(Mg + 3888);
            ab0 -= mq[4][0] * xy[28]; ab1 -= mq[4][1] * xy[29]; ab0 -= mq[4][2] * xy[30]; ab1 -= mq[4][3] * xy[31]; mq[4] = *(const LAS f32x4*)(Mg + 3892);
            ab0 -= mq[5][0] * xy[32]; ab1 -= mq[5][1] * xy[33]; ab0 -= mq[5][2] * xy[34]; ab1 -= mq[5][3] * xy[35]; mq[5] = *(const LAS f32x4*)(Mg + 3896);
            ab0 -= mq[0][0] * xy[36]; ab1 -= mq[0][1] * xy[37]; ab0 -= mq[0][2] * xy[38]; ab1 -= mq[0][3] * xy[39]; mq[0] = *(const LAS f32x4*)(Mg + 3904);
            ab0 -= mq[1][0] * xy[40]; ab1 -= mq[1][1] * xy[41]; ab0 -= mq[1][2] * xy[42]; ab1 -= mq[1][3] * xy[43]; mq[1] = *(const LAS f32x4*)(Mg + 3908);
            ab0 -= mq[2][0] * xy[44]; ab1 -= mq[2][1] * xy[45]; ab0 -= mq[2][2] * xy[46]; ab1 -= mq[2][3] * xy[47]; mq[2] = *(const LAS f32x4*)(Mg + 3912);
            ab0 -= mq[3][0] * xy[48]; ab1 -= mq[3][1] * xy[49]; ab0 -= mq[3][2] * xy[50]; ab1 -= mq[3][3] * xy[51]; mq[3] = *(const LAS f32x4*)(Mg + 3916);
            ab0 -= mq[4][0] * xy[52]; ab1 -= mq[4][1] * xy[53]; ab0 -= mq[4][2] * xy[54]; ab1 -= mq[4][3] * xy[55]; mq[4] = *(const LAS f32x4*)(Mg + 3920);
            ab0 -= mq[5][0] * xy[56]; ab1 -= mq[5][1] * xy[57]; ab0 -= mq[5][2] * xy[58]; ab1 -= mq[5][3] * xy[59]; xy[60] = ab0 + ab1; up[7680] = xy[60][0]; wp[7680] = f2bf(-xy[60][1]); mq[5] = *(const LAS f32x4*)(Mg + 3924);
            { const float br = betg[61]; ab0 = (f32x2){bf2f(*(const LAS bf16_t*)(lg + P5_VS + 16592 + c * 2)) * br, bf2f(*(const LAS bf16_t*)(lg + P5_KS + 16592 + c * 2)) * br * __expf(decg[61])}; ab1 = (f32x2){0.f, 0.f}; } ab0 -= mq[0][0] * xy[0]; ab1 -= mq[0][1] * xy[1]; ab0 -= mq[0][2] * xy[2]; ab1 -= mq[0][3] * xy[3]; mq[0] = *(const LAS f32x4*)(Mg + 3928);
            ab0 -= mq[1][0] * xy[4]; ab1 -= mq[1][1] * xy[5]; ab0 -= mq[1][2] * xy[6]; ab1 -= mq[1][3] * xy[7]; mq[1] = *(const LAS f32x4*)(Mg + 3932);
            ab0 -= mq[2][0] * xy[8]; ab1 -= mq[2][1] * xy[9]; ab0 -= mq[2][2] * xy[10]; ab1 -= mq[2][3] * xy[11]; mq[2] = *(const LAS f32x4*)(Mg + 3936);
            ab0 -= mq[3][0] * xy[12]; ab1 -= mq[3][1] * xy[13]; ab0 -= mq[3][2] * xy[14]; ab1 -= mq[3][3] * xy[15]; mq[3] = *(const LAS f32x4*)(Mg + 3940);
            ab0 -= mq[4][0] * xy[16]; ab1 -= mq[4][1] * xy[17]; ab0 -= mq[4][2] * xy[18]; ab1 -= mq[4][3] * xy[19]; mq[4] = *(const LAS f32x4*)(Mg + 3944);
            ab0 -= mq[5][0] * xy[20]; ab1 -= mq[5][1] * xy[21]; ab0 -= mq[5][2] * xy[22]; ab1 -= mq[5][3] * xy[23]; mq[5] = *(const LAS f32x4*)(Mg + 3948);
            ab0 -= mq[0][0] * xy[24]; ab1 -= mq[0][1] * xy[25]; ab0 -= mq[0][2] * xy[26]; ab1 -= mq[0][3] * xy[27]; mq[0] = *(const LAS f32x4*)(Mg + 3952);
            ab0 -= mq[1][0] * xy[28]; ab1 -= mq[1][1] * xy[29]; ab0 -= mq[1][2] * xy[30]; ab1 -= mq[1][3] * xy[31]; mq[1] = *(const LAS f32x4*)(Mg + 3956);
            ab0 -= mq[2][0] * xy[32]; ab1 -= mq[2][1] * xy[33]; ab0 -= mq[2][2] * xy[34]; ab1 -= mq[2][3] * xy[35]; mq[2] = *(const LAS f32x4*)(Mg + 3960);
            ab0 -= mq[3][0] * xy[36]; ab1 -= mq[3][1] * xy[37]; ab0 -= mq[3][2] * xy[38]; ab1 -= mq[3][3] * xy[39]; mq[3] = *(const LAS f32x4*)(Mg + 3964);
            ab0 -= mq[4][0] * xy[40]; ab1 -= mq[4][1] * xy[41]; ab0 -= mq[4][2] * xy[42]; ab1 -= mq[4][3] * xy[43]; mq[4] = *(const LAS f32x4*)(Mg + 3968);
            ab0 -= mq[5][0] * xy[44]; ab1 -= mq[5][1] * xy[45]; ab0 -= mq[5][2] * xy[46]; ab1 -= mq[5][3] * xy[47]; mq[5] = *(const LAS f32x4*)(Mg + 3972);
            ab0 -= mq[0][0] * xy[48]; ab1 -= mq[0][1] * xy[49]; ab0 -= mq[0][2] * xy[50]; ab1 -= mq[0][3] * xy[51]; mq[0] = *(const LAS f32x4*)(Mg + 3976);
            ab0 -= mq[1][0] * xy[52]; ab1 -= mq[1][1] * xy[53]; ab0 -= mq[1][2] * xy[54]; ab1 -= mq[1][3] * xy[55]; mq[1] = *(const LAS f32x4*)(Mg + 3980);
            ab0 -= mq[2][0] * xy[56]; ab1 -= mq[2][1] * xy[57]; ab0 -= mq[2][2] * xy[58]; ab1 -= mq[2][3] * xy[59]; mq[2] = *(const LAS f32x4*)(Mg + 3984);
            ab0 -= mq[3][0] * xy[60]; xy[61] = ab0 + ab1; up[7808] = xy[61][0]; wp[7808] = f2bf(-xy[61][1]); mq[3] = *(const LAS f32x4*)(Mg + 3988);
            { const float br = betg[62]; ab0 = (f32x2){bf2f(*(const LAS bf16_t*)(lg + P5_VS + 16864 + c * 2)) * br, bf2f(*(const LAS bf16_t*)(lg + P5_KS + 16864 + c * 2)) * br * __expf(decg[62])}; ab1 = (f32x2){0.f, 0.f}; } ab0 -= mq[4][0] * xy[0]; ab1 -= mq[4][1] * xy[1]; ab0 -= mq[4][2] * xy[2]; ab1 -= mq[4][3] * xy[3]; mq[4] = *(const LAS f32x4*)(Mg + 3992);
            ab0 -= mq[5][0] * xy[4]; ab1 -= mq[5][1] * xy[5]; ab0 -= mq[5][2] * xy[6]; ab1 -= mq[5][3] * xy[7]; mq[5] = *(const LAS f32x4*)(Mg + 3996);
            ab0 -= mq[0][0] * xy[8]; ab1 -= mq[0][1] * xy[9]; ab0 -= mq[0][2] * xy[10]; ab1 -= mq[0][3] * xy[11]; mq[0] = *(const LAS f32x4*)(Mg + 4000);
            ab0 -= mq[1][0] * xy[12]; ab1 -= mq[1][1] * xy[13]; ab0 -= mq[1][2] * xy[14]; ab1 -= mq[1][3] * xy[15]; mq[1] = *(const LAS f32x4*)(Mg + 4004);
            ab0 -= mq[2][0] * xy[16]; ab1 -= mq[2][1] * xy[17]; ab0 -= mq[2][2] * xy[18]; ab1 -= mq[2][3] * xy[19]; mq[2] = *(const LAS f32x4*)(Mg + 4008);
            ab0 -= mq[3][0] * xy[20]; ab1 -= mq[3][1] * xy[21]; ab0 -= mq[3][2] * xy[22]; ab1 -= mq[3][3] * xy[23]; mq[3] = *(const LAS f32x4*)(Mg + 4012);
            ab0 -= mq[4][0] * xy[24]; ab1 -= mq[4][1] * xy[25]; ab0 -= mq[4][2] * xy[26]; ab1 -= mq[4][3] * xy[27]; mq[4] = *(const LAS f32x4*)(Mg + 4016);
            ab0 -= mq[5][0] * xy[28]; ab1 -= mq[5][1] * xy[29]; ab0 -= mq[5][2] * xy[30]; ab1 -= mq[5][3] * xy[31]; mq[5] = *(const LAS f32x4*)(Mg + 4020);
            ab0 -= mq[0][0] * xy[32]; ab1 -= mq[0][1] * xy[33]; ab0 -= mq[0][2] * xy[34]; ab1 -= mq[0][3] * xy[35]; mq[0] = *(const LAS f32x4*)(Mg + 4024);
            ab0 -= mq[1][0] * xy[36]; ab1 -= mq[1][1] * xy[37]; ab0 -= mq[1][2] * xy[38]; ab1 -= mq[1][3] * xy[39]; mq[1] = *(const LAS f32x4*)(Mg + 4028);
            ab0 -= mq[2][0] * xy[40]; ab1 -= mq[2][1] * xy[41]; ab0 -= mq[2][2] * xy[42]; ab1 -= mq[2][3] * xy[43]; mq[2] = *(const LAS f32x4*)(Mg + 4032);
            ab0 -= mq[3][0] * xy[44]; ab1 -= mq[3][1] * xy[45]; ab0 -= mq[3][2] * xy[46]; ab1 -= mq[3][3] * xy[47]; mq[3] = *(const LAS f32x4*)(Mg + 4036);
            ab0 -= mq[4][0] * xy[48]; ab1 -= mq[4][1] * xy[49]; ab0 -= mq[4][2] * xy[50]; ab1 -= mq[4][3] * xy[51]; mq[4] = *(const LAS f32x4*)(Mg + 4040);
            ab0 -= mq[5][0] * xy[52]; ab1 -= mq[5][1] * xy[53]; ab0 -= mq[5][2] * xy[54]; ab1 -= mq[5][3] * xy[55]; mq[5] = *(const LAS f32x4*)(Mg + 4044);
            ab0 -= mq[0][0] * xy[56]; ab1 -= mq[0][1] * xy[57]; ab0 -= mq[0][2] * xy[58]; ab1 -= mq[0][3] * xy[59]; mq[0] = *(const LAS f32x4*)(Mg + 4048);
            ab0 -= mq[1][0] * xy[60]; ab1 -= mq[1][1] * xy[61]; xy[62] = ab0 + ab1; up[7936] = xy[62][0]; wp[7936] = f2bf(-xy[62][1]); mq[1] = *(const LAS f32x4*)(Mg + 4052);
            { const float br = betg[63]; ab0 = (f32x2){bf2f(*(const LAS bf16_t*)(lg + P5_VS + 17136 + c * 2)) * br, bf2f(*(const LAS bf16_t*)(lg + P5_KS + 17136 + c * 2)) * br * __expf(decg[63])}; ab1 = (f32x2){0.f, 0.f}; } ab0 -= mq[2][0] * xy[0]; ab1 -= mq[2][1] * xy[1]; ab0 -= mq[2][2] * xy[2]; ab1 -= mq[2][3] * xy[3]; mq[2] = *(const LAS f32x4*)(Mg + 4056);
            ab0 -= mq[3][0] * xy[4]; ab1 -= mq[3][1] * xy[5]; ab0 -= mq[3][2] * xy[6]; ab1 -= mq[3][3] * xy[7]; mq[3] = *(const LAS f32x4*)(Mg + 4060);
            ab0 -= mq[4][0] * xy[8]; ab1 -= mq[4][1] * xy[9]; ab0 -= mq[4][2] * xy[10]; ab1 -= mq[4][3] * xy[11]; mq[4] = *(const LAS f32x4*)(Mg + 4064);
            ab0 -= mq[5][0] * xy[12]; ab1 -= mq[5][1] * xy[13]; ab0 -= mq[5][2] * xy[14]; ab1 -= mq[5][3] * xy[15]; mq[5] = *(const LAS f32x4*)(Mg + 4068);
            ab0 -= mq[0][0] * xy[16]; ab1 -= mq[0][1] * xy[17]; ab0 -= mq[0][2] * xy[18]; ab1 -= mq[0][3] * xy[19]; mq[0] = *(const LAS f32x4*)(Mg + 4072);
            ab0 -= mq[1][0] * xy[20]; ab1 -= mq[1][1] * xy[21]; ab0 -= mq[1][2] * xy[22]; ab1 -= mq[1][3] * xy[23]; mq[1] = *(const LAS f32x4*)(Mg + 4076);
            ab0 -= mq[2][0] * xy[24]; ab1 -= mq[2][1] * xy[25]; ab0 -= mq[2][2] * xy[26]; ab1 -= mq[2][3] * xy[27]; mq[2] = *(const LAS f32x4*)(Mg + 4080);
            ab0 -= mq[3][0] * xy[28]; ab1 -= mq[3][1] * xy[29]; ab0 -= mq[3][2] * xy[30]; ab1 -= mq[3][3] * xy[31]; mq[3] = *(const LAS f32x4*)(Mg + 4084);
            ab0 -= mq[4][0] * xy[32]; ab1 -= mq[4][1] * xy[33]; ab0 -= mq[4][2] * xy[34]; ab1 -= mq[4][3] * xy[35]; mq[4] = *(const LAS f32x4*)(Mg + 4088);
            ab0 -= mq[5][0] * xy[36]; ab1 -= mq[5][1] * xy[37]; ab0 -= mq[5][2] * xy[38]; ab1 -= mq[5][3] * xy[39]; mq[5] = *(const LAS f32x4*)(Mg + 4092);
            ab0 -= mq[0][0] * xy[40]; ab1 -= mq[0][1] * xy[41]; ab0 -= mq[0][2] * xy[42]; ab1 -= mq[0][3] * xy[43];
            ab0 -= mq[1][0] * xy[44]; ab1 -= mq[1][1] * xy[45]; ab0 -= mq[1][2] * xy[46]; ab1 -= mq[1][3] * xy[47];
            ab0 -= mq[2][0] * xy[48]; ab1 -= mq[2][1] * xy[49]; ab0 -= mq[2][2] * xy[50]; ab1 -= mq[2][3] * xy[51];
            ab0 -= mq[3][0] * xy[52]; ab1 -= mq[3][1] * xy[53]; ab0 -= mq[3][2] * xy[54]; ab1 -= mq[3][3] * xy[55];
            ab0 -= mq[4][0] * xy[56]; ab1 -= mq[4][1] * xy[57]; ab0 -= mq[4][2] * xy[58]; ab1 -= mq[4][3] * xy[59];
            ab0 -= mq[5][0] * xy[60]; ab1 -= mq[5][1] * xy[61]; ab0 -= mq[5][2] * xy[62]; xy[63] = ab0 + ab1; up[8064] = xy[63][0]; wp[8064] = f2bf(-xy[63][1]);
        } else {
            const int g2 = (w8 - 4) >> 1, tt = ((w8 - 4) & 1) * 64 + lane; const int item2 = it0 + g2;
            LAS unsigned char* lg = lds0 + g2 * P5_GRP; LAS float* decg = (LAS float*)(lg + P5_DEC);
            const float lastg = decg[63];
#pragma unroll
            for (int i = 0; i < 8; ++i) { const int vid = tt + 128 * i, r = vid >> 4, d0 = (vid & 15) * 8; float f[8]; unpack8(*(const LAS u32x4*)(lg + P5_QS + r * 272 + d0 * 2), f);
                const float e = scale * __expf(decg[r]);
#pragma unroll
                for (int q = 0; q < 8; ++q) f[q] *= e;
                *(u32x4*)(qd + (size_t)item2 * 8192 + r * 128 + d0) = pack8(f); }
#pragma unroll
            for (int i = 0; i < 8; ++i) { const int vid = tt + 128 * i, d = vid >> 3, rg = (vid & 7) * 8; float f[8];
#pragma unroll
                for (int q = 0; q < 8; ++q) f[q] = bf2f(*(const LAS bf16_t*)(lg + P5_KS + (rg + q) * 272 + d * 2)) * __expf(lastg - decg[rg + q]);
                *(u32x4*)(kt + (size_t)item2 * 8192 + d * 64 + rg) = pack8(f); }
            if (tt == 0) cdv[item2] = __expf(lastg);
        }
    }
    __syncthreads();
}

constexpr int SB_WD = 0, SB_QD = 17408, SB_KT = 34816, SB_QK = 53248, SB_UB = 62464, SB_SIZE = 66560;
constexpr int SC_ST = 2 * SB_SIZE, SC_UT = SC_ST + 4352, SC_END = SC_UT + 2304;
static_assert(SC_END <= LDS_BYTES, "lds");
__device__ __forceinline__ void scan_phase(const Params& p, int bid, int nblk, LAS unsigned char* lds) {
    const int tid = threadIdx.x, lane = tid & 63, wid = __builtin_amdgcn_readfirstlane(tid >> 6), fr = lane & 15, fq = lane >> 4;
    const bf16_t* wdc = (const bf16_t*)(p.ws + WS_WDC); const bf16_t* qd = (const bf16_t*)(p.ws + WS_QD); const bf16_t* kt = (const bf16_t*)(p.ws + WS_KT); const bf16_t* qk = (const bf16_t*)(p.ws + WS_QK);
    const float* cdv = (const float*)(p.ws + WS_CD); const float* ub = p.out + OS_UB; float* obuf = p.out + OS_O;
    for (int item = bid; item < 256; item += nblk) {
        const int xcd = item & 7, iq = item >> 3, bh = xcd * 4 + (iq >> 3), sl = iq & 7, h = bh & 7, b = bh >> 3;
        u32x4 r_wd[2], r_qd[2], r_kt[2], r_qk, r_ub;
        auto gload = [&](int n) {
            const size_t it = (size_t)(bh * 32 + n);
#pragma unroll
            for (int i = 0; i < 2; ++i) { const int ch = tid + 512 * i; r_wd[i] = *(const u32x4*)(wdc + it * 8192 + ch * 8); r_qd[i] = *(const u32x4*)(qd + it * 8192 + ch * 8); r_kt[i] = *(const u32x4*)(kt + it * 8192 + ch * 8); }
            r_qk = *(const u32x4*)(qk + it * 4096 + tid * 8);
            if (tid < 256) r_ub = *(const u32x4*)(ub + it * 8192 + (tid >> 2) * 128 + sl * 16 + (tid & 3) * 4);
        };
        auto lstore = [&](int buf) {
            LAS unsigned char* B = lds + buf * SB_SIZE;
#pragma unroll
            for (int i = 0; i < 2; ++i) { const int ch = tid + 512 * i; const int r = ch >> 4, c8 = (ch & 15) * 8; *(LAS u32x4*)(B + SB_WD + r * 272 + c8 * 2) = r_wd[i]; *(LAS u32x4*)(B + SB_QD + r * 272 + c8 * 2) = r_qd[i];
                const int d = ch >> 3, t8 = (ch & 7) * 8; *(LAS u32x4*)(B + SB_KT + d * 144 + t8 * 2) = r_kt[i]; }
            { const int r = tid >> 3, s8 = (tid & 7) * 8; *(LAS u32x4*)(B + SB_QK + r * 144 + s8 * 2) = r_qk; }
            if (tid < 256) *(LAS u32x4*)(B + SB_UB + (tid >> 2) * 64 + (tid & 3) * 16) = r_ub;
        };
        __syncthreads();
        gload(0);
        for (int i = tid; i < 4352 / 4; i += 512) *(LAS unsigned*)(lds + SC_ST + i * 4) = 0u;
        lstore(0);
        f32x4 sacc = (f32x4){0.f, 0.f, 0.f, 0.f};
        const float cdall = cdv[bh * 32 + (lane & 31)];
        __syncthreads();
        for (int n = 0; n < 32; ++n) {
            const int cur = n & 1; LAS unsigned char* B = lds + cur * SB_SIZE;
            if (n + 1 < 32) gload(n + 1);
            const float cd = __builtin_bit_cast(float, __builtin_amdgcn_readlane(__builtin_bit_cast(int, cdall), n));
            f32x4 acc;
            const int tw = wid & 3;
            if (wid < 4) {
#pragma unroll
                for (int j = 0; j < 4; ++j) acc[j] = *(const LAS float*)(B + SB_UB + ((tw * 16 + fq * 4 + j) * 16 + fr) * 4);
#pragma unroll
                for (int kk = 0; kk < 4; ++kk) { const bf16x8 a = *(const LAS bf16x8*)(B + SB_WD + (tw * 16 + fr) * 272 + (kk * 32 + fq * 8) * 2); const bf16x8 bb = *(const LAS bf16x8*)(lds + SC_ST + fr * 272 + (kk * 32 + fq * 8) * 2);
                    acc = __builtin_amdgcn_mfma_f32_16x16x32_bf16(a, bb, acc, 0, 0, 0); }
                u32x2 w; w.x = pk2(acc[0], acc[1]); w.y = pk2(acc[2], acc[3]);
                *(LAS u32x2*)(lds + SC_UT + fr * 144 + (tw * 16 + fq * 4) * 2) = w;
            } else {
                acc = (f32x4){0.f, 0.f, 0.f, 0.f};
#pragma unroll
                for (int kk = 0; kk < 4; ++kk) { const bf16x8 a = *(const LAS bf16x8*)(B + SB_QD + (tw * 16 + fr) * 272 + (kk * 32 + fq * 8) * 2); const bf16x8 bb = *(const LAS bf16x8*)(lds + SC_ST + fr * 272 + (kk * 32 + fq * 8) * 2);
                    acc = __builtin_amdgcn_mfma_f32_16x16x32_bf16(a, bb, acc, 0, 0, 0); }
            }
            __syncthreads();
            sacc *= cd;
#pragma unroll
            for (int kk = 0; kk < 2; ++kk) { const bf16x8 a = *(const LAS bf16x8*)(B + SB_KT + (wid * 16 + fr) * 144 + (kk * 32 + fq * 8) * 2); const bf16x8 bb = *(const LAS bf16x8*)(lds + SC_UT + fr * 144 + (kk * 32 + fq * 8) * 2);
                sacc = __builtin_amdgcn_mfma_f32_16x16x32_bf16(a, bb, sacc, 0, 0, 0); }
            if (wid >= 4) {
#pragma unroll
                for (int kk = 0; kk < 2; ++kk) { const bf16x8 a = *(const LAS bf16x8*)(B + SB_QK + (tw * 16 + fr) * 144 + (kk * 32 + fq * 8) * 2); const bf16x8 bb = *(const LAS bf16x8*)(lds + SC_UT + fr * 144 + (kk * 32 + fq * 8) * 2);
                    acc = __builtin_amdgcn_mfma_f32_16x16x32_bf16(a, bb, acc, 0, 0, 0); }
#pragma unroll
                for (int j = 0; j < 4; ++j) obuf[(size_t)(b * 2048 + n * 64 + tw * 16 + fq * 4 + j) * 1024 + h * 128 + sl * 16 + fr] = acc[j];
            }
            { u32x2 w; w.x = pk2(sacc[0], sacc[1]); w.y = pk2(sacc[2], sacc[3]); *(LAS u32x2*)(lds + SC_ST + fr * 272 + (wid * 16 + fq * 4) * 2) = w; }
            if (n + 1 < 32) lstore(cur ^ 1);
            __syncthreads();
        }
#pragma unroll
        for (int j = 0; j < 4; ++j) p.out[O_DP + ((size_t)bh * 128 + wid * 16 + fq * 4 + j) * 128 + sl * 16 + fr] = sacc[j];
    }
    __syncthreads();
    {
        const bf16_t* qn = (const bf16_t*)(p.ws + WS_QN); const bf16_t* kn = (const bf16_t*)(p.ws + WS_KN); const bf16_t* vv = (const bf16_t*)(p.ws + WS_VV);
        const float* gbuf = (const float*)(p.ws + WS_G); const float* bbuf = (const float*)(p.ws + WS_BETA);
        const int grp = tid >> 8, w4 = __builtin_amdgcn_readfirstlane(tid >> 6) & 3, j = w4 * 32 + (lane & 31), half = lane >> 5;
        LAS float* qs = (LAS float*)lds + grp * 1024;
        LAS float* ks = qs + 512;
        const float scale = 0.08838834764831845f;
        for (int it0 = bid * 2; it0 < 1024; it0 += nblk * 2) {
            const int item = it0 + grp, sb = item >> 3, h = item & 7;
            __syncthreads();
#pragma unroll
            for (int i = 0; i < 4; ++i) { const int idx = (tid & 255) + 256 * i, tk = idx >> 7, c = idx & 127, t = tk & 3; const size_t go = (size_t)(TP + sb * 4 + t) * 1024 + h * 128 + c;
                if (tk < 4) qs[t * 128 + c] = bf2f(qn[go]); else ks[t * 128 + c] = bf2f(kn[go]); }
            float S[64];
            const float* s0 = p.in[4] + (size_t)item * 16384 + (size_t)half * 64 * 128 + j;
#pragma unroll
            for (int i = 0; i < 64; ++i) S[i] = __builtin_nontemporal_load(s0 + i * 128);
            __syncthreads();
#pragma unroll 1
            for (int t = 0; t < 4; ++t) {
                const int row = TP + sb * 4 + t;
                const float a = __expf(gbuf[row * 8 + h]), be = bbuf[row * 8 + h], v = bf2f(vv[(size_t)row * 1024 + h * 128 + j]);
                float kS = 0.f;
#pragma unroll
                for (int i4 = 0; i4 < 16; ++i4) { const f32x4 k4 = *(const LAS f32x4*)(ks + t * 128 + half * 64 + i4 * 4); kS += k4[0] * S[i4 * 4] + k4[1] * S[i4 * 4 + 1] + k4[2] * S[i4 * 4 + 2] + k4[3] * S[i4 * 4 + 3]; }
                kS += __shfl_xor(kS, 32);
                const float coef = be * (v - a * kS);
                float o = 0.f;
#pragma unroll
                for (int i4 = 0; i4 < 16; ++i4) { const f32x4 k4 = *(const LAS f32x4*)(ks + t * 128 + half * 64 + i4 * 4); const f32x4 q4 = *(const LAS f32x4*)(qs + t * 128 + half * 64 + i4 * 4);
#pragma unroll
                    for (int q = 0; q < 4; ++q) { S[i4 * 4 + q] = a * S[i4 * 4 + q] + k4[q] * coef; o += q4[q] * S[i4 * 4 + q]; } }
                o += __shfl_xor(o, 32);
                if (half == 0) obuf[(size_t)row * 1024 + h * 128 + j] = o * scale;
            }
            float* so = p.out + O_DS + (size_t)item * 16384 + (size_t)half * 64 * 128 + j;
#pragma unroll
            for (int i = 0; i < 64; ++i) so[i * 128] = S[i];
        }
    }
    __syncthreads();
}

__device__ __forceinline__ void onorm_phase(const Params& p, int bid, int nblk) {
    const int lane = threadIdx.x & 63, wid = __builtin_amdgcn_readfirstlane(threadIdx.x >> 6);
    const float* obuf = p.out + OS_O; const bf16_t* proj = (const bf16_t*)(p.ws + WS_PROJ); bf16_t* acat = (bf16_t*)(p.ws + WS_U); const float* og = p.in[14];
    const int c0 = lane * 16; float g[16];
#pragma unroll
    for (int i = 0; i < 4; ++i) { const f32x4 gg = *(const f32x4*)(og + (c0 & 127) + i * 4); g[i * 4] = gg[0]; g[i * 4 + 1] = gg[1]; g[i * 4 + 2] = gg[2]; g[i * 4 + 3] = gg[3]; }
    for (int row = bid * 8 + wid; row < TT; row += nblk * 8) {
        float o[16], z[16];
#pragma unroll
        for (int i = 0; i < 4; ++i) { const f32x4 v = *(const f32x4*)(obuf + (size_t)row * 1024 + c0 + i * 4); o[i * 4] = v[0]; o[i * 4 + 1] = v[1]; o[i * 4 + 2] = v[2]; o[i * 4 + 3] = v[3]; }
        unpack8(*(const u32x4*)(proj + (size_t)row * NPROJ + C_Z + c0), z); unpack8(*(const u32x4*)(proj + (size_t)row * NPROJ + C_Z + c0 + 8), z + 8);
        float ss = 0.f;
#pragma unroll
        for (int i = 0; i < 16; ++i) ss += o[i] * o[i];
        ss += __shfl_xor(ss, 1); ss += __shfl_xor(ss, 2); ss += __shfl_xor(ss, 4);
        const float rstd = rsqrtf(ss * (1.0f / 128.0f) + EPS);
#pragma unroll
        for (int i = 0; i < 16; ++i) o[i] = o[i] * rstd * g[i] * siluf_(z[i]);
        *(u32x4*)(acat + (size_t)row * DM + c0) = pack8(o); *(u32x4*)(acat + (size_t)row * DM + c0 + 8) = pack8(o + 8);
    }
}

#define XB_TMO      128
#define XB_XCNT(j)  (256  + 64 * (j))
#define XB_XSUB(j)  (1280 + 64 * (j))
#define XB_XGEN(j)  (2304 + 64 * (j))
#define XB_TOP      3328
#define XB_TOPGEN   3392
#define XCD_BAR_WORDS 3456
#define XB_SPIN_CAP (1u << 18)

__device__ __forceinline__ unsigned xb_ld(unsigned* p)              { return __hip_atomic_load(p, __ATOMIC_RELAXED, __HIP_MEMORY_SCOPE_AGENT); }
__device__ __forceinline__ unsigned xb_add(unsigned* p, unsigned v) { return __hip_atomic_fetch_add(p, v, __ATOMIC_RELAXED, __HIP_MEMORY_SCOPE_AGENT); }
__device__ __forceinline__ unsigned xb_xcc_id() { return (unsigned)__builtin_amdgcn_s_getreg((3 << 11) | 20) & 0xFu; }
#define XB_SPIN(cond, bar) do { unsigned _sp = 0; while (cond) { __builtin_amdgcn_s_sleep(1); \
    if ((++_sp & 255u) == 0u) { if (xb_ld(&(bar)[XB_TMO])) break; if (_sp > XB_SPIN_CAP) { atomicAdd(&(bar)[XB_TMO], 1u); break; } } } } while (0)

struct XcdBarrier {
    unsigned* bar; unsigned x;
    volatile LAS unsigned* st;
};

__device__ __forceinline__ XcdBarrier xcd_barrier_post(unsigned* bar, volatile LAS unsigned* st) {
    XcdBarrier b; b.bar = bar; b.x = xb_xcc_id(); b.st = st;
    if (threadIdx.x == 0) (void)xb_add(&bar[XB_XCNT(b.x)], 1u);
    return b;
}
__device__ __forceinline__ void xcd_barrier_complete(unsigned* bar, unsigned x, unsigned& nloc, unsigned& nx) {
    const unsigned G = gridDim.x * gridDim.y * gridDim.z;
    unsigned sum, cnt, mine, sp = 0u;
    for (;;) {
        sum = 0u; cnt = 0u; mine = 0u;
#pragma unroll
        for (unsigned j = 0; j < 16; ++j) { const unsigned c = xb_ld(&bar[XB_XCNT(j)]); sum += c; cnt += (c > 0u) ? 1u : 0u; mine = (j == x) ? c : mine; }
        if (sum == G) break;
        __builtin_amdgcn_s_sleep(1);
        if ((++sp & 255u) == 0u) { if (xb_ld(&bar[XB_TMO])) break; if (sp > XB_SPIN_CAP) { atomicAdd(&bar[XB_TMO], 1u); break; } }
    }
    nloc = mine > 0u ? mine : 1u; nx = cnt > 0u ? cnt : 1u;
}

__device__ __forceinline__ void xcd_barrier(const XcdBarrier& b) {
    asm volatile("s_waitcnt vmcnt(0)" ::: "memory");
    __syncthreads();
    if (threadIdx.x == 0) {
        unsigned* bar = b.bar;
        __builtin_amdgcn_s_waitcnt(0);
        unsigned nloc = b.st[0], nx = b.st[1];
        if (nloc == 0u) { xcd_barrier_complete(bar, b.x, nloc, nx); b.st[0] = nloc; b.st[1] = nx; }
        const unsigned old = xb_add(&bar[XB_XSUB(b.x)], 1u);
        const unsigned gen = old / nloc;
        if (old + 1u == (gen + 1u) * nloc) {
            __builtin_amdgcn_fence(__ATOMIC_RELEASE, "agent");
            asm volatile("s_waitcnt vmcnt(0)" ::: "memory");
            const unsigned og = xb_add(&bar[XB_TOP], 1u);
            const unsigned tg = og / nx;
            if (og + 1u == (tg + 1u) * nx) xb_add(&bar[XB_TOPGEN], 1u);
            else XB_SPIN(xb_ld(&bar[XB_TOPGEN]) == tg, bar);
            __builtin_amdgcn_fence(__ATOMIC_ACQUIRE, "agent");
            xb_add(&bar[XB_XGEN(b.x)], 1u);
            asm volatile("s_waitcnt vmcnt(0)" ::: "memory");
        } else {
            XB_SPIN(xb_ld(&bar[XB_XGEN(b.x)]) == gen, bar);
            __builtin_amdgcn_fence(__ATOMIC_ACQUIRE, "agent");
            asm volatile("s_waitcnt vmcnt(0)" ::: "memory");
        }
    }
    __syncthreads();
}

constexpr size_t WS_BAR = WS_END;
constexpr int LDS_ST_OFF = LDS_BYTES - 16;
struct KArgs { Params p; TJob jobs[11]; };
constexpr int N_PHASES = 15;
#ifndef PH_MASK
#define PH_MASK 0xFFFF
#endif
#ifndef DUP_MASK
#define DUP_MASK 0
#endif

__global__ void __launch_bounds__(512, 2) fwd_megakernel(KArgs ka) {
    extern __shared__ __attribute__((aligned(16))) unsigned char lds_raw[];
    LAS unsigned char* lds = (LAS unsigned char*)lds_raw;
    const Params& p = ka.p;
    const int bid = blockIdx.x, nblk = gridDim.x;
    unsigned char* ws = p.ws;
    const int lo = p.ph_lo, hi = p.ph_hi;
    if (threadIdx.x < 4) ((LAS unsigned*)(lds + LDS_ST_OFF))[threadIdx.x] = 0u;
    __syncthreads();
    if (hi > 1000) cg::this_grid().sync();
    XcdBarrier xbar = xcd_barrier_post((unsigned*)(ws + WS_BAR), (volatile LAS unsigned*)(lds + LDS_ST_OFF));
#define IN(k) ((PH_MASK & (1 << (k))) && lo <= (k) && (k) < hi)
#define SEAM(k) do { if (lo <= (k) && (k) + 1 < hi) xcd_barrier(xbar); } while (0)
    if (IN(0)) for (int rep = 0; rep <= ((DUP_MASK >> 0) & 1); ++rep) {
            bf16_t* aada = (bf16_t*)(ws + WS_AADA);
            for (int idx = bid * 512 + threadIdx.x; idx < 256 * 2048; idx += nblk * 512) { const int row = idx >> 11, col = idx & 2047;
                const float v = row < 4 ? siluf_(p.in[2][row * 2048 + col]) : (row < NB ? siluf_(p.in[3][(row - 4) * 2048 + col]) : 0.f); aada[idx] = f2bf(v); }
            transpose_jobs(ka.jobs, 1, bid, nblk, lds);
        }
    SEAM(0);
    if (IN(1)) for (int rep = 0; rep <= ((DUP_MASK >> 1) & 1); ++rep) {
            if (bid < 48) { pg8::Gemm g{(const bf16_t*)(ws + WS_AADA), (const bf16_t*)(ws + WS_PROJ), 2048, 2048, 2048, 0, 0, 0, 0, 0}; pg8::OneUnitOrder S{48, bid, 32}; pg8::EpiAda E{(float*)(ws + WS_MOD), p.in[8]}; pg8::gemm_phase(lds, g, S, E); }
            else { transpose_jobs(ka.jobs + 1, 1, bid - 48, nblk - 48, lds); transpose_jobs(ka.jobs + 4, 7, bid - 48, nblk - 48, lds); }
        }
    SEAM(1);
    if (IN(2)) for (int rep = 0; rep <= ((DUP_MASK >> 2) & 1); ++rep) norm_phase<0>(p, bid, nblk);
    SEAM(2);
    if (IN(3)) for (int rep = 0; rep <= ((DUP_MASK >> 3) & 1); ++rep) { pg8::Gemm g{(const bf16_t*)(ws + WS_U), (const bf16_t*)(ws + WS_WIN), 2048, 2048, 2048, 0, 0, 0, 0, 0}; pg8::StaticOrder S; S.init(TT, NPROJ, 2048, nblk, bid); pg8::EpiBf16 E{(bf16_t*)(ws + WS_PROJ), NPROJ, 0, nullptr}; pg8::gemm_phase(lds, g, S, E); }
    SEAM(3);
    if (IN(4)) for (int rep = 0; rep <= ((DUP_MASK >> 4) & 1); ++rep) mixer_prep_phase(p, bid, nblk);
    SEAM(4);
    if (IN(5)) for (int rep = 0; rep <= ((DUP_MASK >> 5) & 1); ++rep) chunk_prep_phase(p, bid, nblk, lds);
    SEAM(5);
    if (IN(6)) for (int rep = 0; rep <= ((DUP_MASK >> 6) & 1); ++rep) scan_phase(p, bid, nblk, lds);
    SEAM(6);
    if (IN(7)) for (int rep = 0; rep <= ((DUP_MASK >> 7) & 1); ++rep) { onorm_phase(p, bid, nblk);
            pg8::Gemm g{(const bf16_t*)(ws + WS_YP), (const bf16_t*)(ws + WS_PW), 1024, 256, 256, 512, 0, 0, 0, 0}; pg8::StaticOrder S; S.init(TT, 1024, 256, nblk, bid); pg8::EpiBf16 E{(bf16_t*)(ws + WS_U), DM, 1024, p.in[16]}; pg8::gemm_phase(lds, g, S, E);
            if (rep == 0) { if (nblk <= 136) transpose_jobs(ka.jobs + 3, 1, bid, nblk, lds); else if (bid >= 136) transpose_jobs(ka.jobs + 3, 1, bid - 136, nblk - 136, lds); } }
    SEAM(7);
    if (IN(8)) for (int rep = 0; rep <= ((DUP_MASK >> 8) & 1); ++rep) {
            pg8::Gemm g{(const bf16_t*)(ws + WS_U), (const bf16_t*)(ws + WS_WAB), 2048, 2048, 1024, 0, 2048, 2048, (size_t)128 * 2048 * 2, (size_t)128 * 2048 * 2}; pg8::StaticOrder S; S.init(68 * 256, 16 * 256, 1024, nblk, bid);
            pg8::EpiDiag E{(bf16_t*)(ws + WS_QN), (const bf16_t*)(ws + WS_PROJ)}; pg8::gemm_phase(lds, g, S, E);
            if (rep == 0) { const int nfull = 1088 % nblk; if (nfull == 0 || nfull >= nblk) transpose_jobs(ka.jobs + 2, 1, bid, nblk, lds); else if (bid >= nfull) transpose_jobs(ka.jobs + 2, 1, bid - nfull, nblk - nfull, lds); } }
    SEAM(9);
    if (IN(10)) for (int rep = 0; rep <= ((DUP_MASK >> 10) & 1); ++rep) { pg8::Gemm g{(const bf16_t*)(ws + WS_QN), (const bf16_t*)(ws + WS_WO), 2048, 2048, 2048, 0, 0, 0, 0, 0}; pg8::SplitOrder S{nblk, bid, 32, 4, 8}; pg8::EpiRes E{p.out + O_Y, p.in[0], p.in[1], (const float*)(ws + WS_MOD) + 4096, (float*)(ws + WS_PB10)}; pg8::gemm_phase(lds, g, S, E); }
    SEAM(10);
    if (IN(11)) for (int rep = 0; rep <= ((DUP_MASK >> 11) & 1); ++rep) norm_phase<1>(p, bid, nblk);
    SEAM(11);
    if (IN(12)) for (int rep = 0; rep <= ((DUP_MASK >> 12) & 1); ++rep) { pg8::Gemm g{(const bf16_t*)(ws + WS_U), (const bf16_t*)(ws + WS_WGU), 2048, 2048, 2048, 0, 0, 0, 0, 0}; pg8::StaticOrder S; S.init(TT, 11264, 2048, nblk, bid); pg8::EpiGU E{(bf16_t*)(ws + WS_PROJ)}; pg8::gemm_phase(lds, g, S, E); }
    SEAM(12);
    if (IN(13)) for (int rep = 0; rep <= ((DUP_MASK >> 13) & 1); ++rep) { pg8::Gemm g{(const bf16_t*)(ws + WS_PROJ), (const bf16_t*)(ws + WS_WD), DFF, DFF, DFF, 0, 0, 0, 0, 0}; pg8::SplitOrder S{nblk, bid, 88, 8, 11}; pg8::EpiRes E{p.out + O_Y, p.out + O_Y, p.out + O_Y + (size_t)TP * DM, (const float*)(ws + WS_MOD) + 10240, (float*)(ws + WS_PB13)}; pg8::gemm_phase(lds, g, S, E); }
    SEAM(13);
    if (IN(14)) for (int rep = 0; rep <= ((DUP_MASK >> 14) & 1); ++rep) norm_phase<2>(p, bid, nblk);
    SEAM(14);
}

extern "C" void kernel_launch(void* const* d_in, const int* in_sizes, int n_in, void* d_out, int out_size, void* d_ws, size_t ws_size, hipStream_t stream) {
    static int grid = 0;
    if (grid == 0) {
        if (n_in != 24 || ws_size < WS_BAR + XCD_BAR_WORDS * 4) { fprintf(stderr, "kernel_launch: unexpected n_in %d / ws_size %zu (need %zu)\n", n_in, ws_size, (size_t)WS_END); grid = -1; return; }
        int dev = 0, cus = 0, per_cu = 0;
        hipGetDevice(&dev); hipDeviceGetAttribute(&cus, hipDeviceAttributeMultiprocessorCount, dev);
        if (hipFuncSetAttribute((const void*)fwd_megakernel, hipFuncAttributeMaxDynamicSharedMemorySize, LDS_BYTES) != hipSuccess) { fprintf(stderr, "kernel_launch: hipFuncSetAttribute failed\n"); grid = -1; return; }
        if (hipOccupancyMaxActiveBlocksPerMultiprocessor(&per_cu, (const void*)fwd_megakernel, 512, LDS_BYTES) != hipSuccess || per_cu < 1) { fprintf(stderr, "kernel_launch: occupancy query says %d\n", per_cu); per_cu = 1; }
        (void)hipGetLastError();
        grid = cus > 0 ? cus : 256;
        if (grid < 64) grid = 64;
    }
    if (grid < 0) return;
    if (hipMemsetAsync((unsigned char*)d_ws + WS_BAR, 0, XCD_BAR_WORDS * 4, stream) != hipSuccess) { fprintf(stderr, "kernel_launch: memset failed\n"); return; }
    KArgs ka; memset(&ka, 0, sizeof(ka));
    for (int i = 0; i < 24; ++i) ka.p.in[i] = (const float*)d_in[i];
    ka.p.out = (float*)d_out; ka.p.ws = (unsigned char*)d_ws;
    unsigned char* ws = (unsigned char*)d_ws;
    auto setjob = [&](int i, const void* src, void* dst, int ld_src, int K, int Nout, int ld_dst, int map) { TJob& j = ka.jobs[i]; j.src = (const float*)src; j.dst = (bf16_t*)dst; j.ld_src = ld_src; j.K = K; j.Nout = Nout; j.ld_dst = ld_dst; j.map = map; j.pad = 0; };
    setjob(0, d_in[7], ws + WS_PROJ, MODW, 2048, MODW, 2048, 0);
    setjob(1, d_in[10], ws + WS_WIN, 9232, 2048, NPROJ, 2048, 1);
    setjob(2, d_in[21], ws + WS_WGU, 2 * DFF, 2048, 2 * DFF, 2048, 2);
    setjob(3, d_in[22], ws + WS_WD, 2048, DFF, 2048, DFF, 0);
    setjob(4, d_in[19], ws + WS_WO, 2048, 2048, 2048, 2048, 0);
    setjob(5, d_in[17], ws + WS_WAB, 2048, 1024, 2048, 2048, 0);
    setjob(6, d_in[18], ws + WS_WAB + 1024 * 2, 2048, 1024, 2048, 2048, 0);
    for (int g = 0; g < 4; ++g) setjob(7 + g, (const float*)d_in[15] + g * 65536, ws + WS_PW + (size_t)g * 65536 * 2, 256, 256, 256, 256, 0);
#if MK_PER_PHASE
    for (int ph = 0; ph < N_PHASES; ++ph) { ka.p.ph_lo = ph; ka.p.ph_hi = ph + 1; hipLaunchKernelGGL(fwd_megakernel, dim3(grid), dim3(512), LDS_BYTES, stream, ka); }
#else
    ka.p.ph_lo = 0; ka.p.ph_hi = N_PHASES;
    void* args[] = {&ka};
    hipError_t e = hipLaunchCooperativeKernel((const void*)fwd_megakernel, dim3(grid), dim3(512), args, LDS_BYTES, stream);
    if (e != hipSuccess) fprintf(stderr, "cooperative launch failed: %s (grid %d)\n", hipGetErrorString(e), grid);
#endif
}
```

```cpp
#include <hip/hip_runtime.h>
#include <hip/hip_cooperative_groups.h>
#include <cstdio>
#include <cstring>
namespace cg = cooperative_groups;

#ifndef MK_PER_PHASE
#define MK_PER_PHASE 0
#endif

#define LAS __attribute__((address_space(3)))
typedef unsigned short bf16_t;
typedef short bf16x8 __attribute__((ext_vector_type(8)));
typedef float f32x4 __attribute__((ext_vector_type(4)));
typedef float f32x2 __attribute__((ext_vector_type(2)));
typedef unsigned u32x4 __attribute__((ext_vector_type(4)));
typedef unsigned u32x2 __attribute__((ext_vector_type(2)));

constexpr int DM = 2048, TP = 8192, TS = 512, TT = 8704, NB = 132;
constexpr int NPROJ = 9472;
constexpr int DFF = 5632;
constexpr int MODW = 12288;
constexpr float EPS = 1e-6f;
constexpr int C_Q = 0, C_K = 1024, C_V = 2048, C_Z = 3072, C_XP = 4096, C_GA = 5120, C_GB = 7168, C_AB = 9216;
constexpr size_t O_Y = 0, O_DP = 17825792, O_CP = 18350080, O_PP = 18386944, O_DS = 18448384, O_CS = 35225600, O_PS = 36405248;
constexpr size_t OS_O = 0, OS_UB = 8912896;
constexpr size_t WS_WIN = 0;
constexpr size_t WS_WGU = WS_WIN + (size_t)NPROJ * 2048 * 2;
constexpr size_t WS_WD = WS_WGU + (size_t)11264 * 2048 * 2;
constexpr size_t WS_WO = WS_WD + (size_t)2048 * 5632 * 2;
constexpr size_t WS_WAB = WS_WO + (size_t)2048 * 2048 * 2;
constexpr size_t WS_PW = WS_WAB + (size_t)2048 * 2048 * 2;
constexpr size_t WS_AADA = WS_PW + (size_t)1024 * 256 * 2;
constexpr size_t WS_MOD = WS_AADA + (size_t)256 * 2048 * 2;
constexpr size_t WS_G = WS_MOD + (size_t)NB * MODW * 4;
constexpr size_t WS_BETA = WS_G + (size_t)TT * 8 * 4;
constexpr size_t WS_CD = WS_BETA + (size_t)TT * 8 * 4;
constexpr size_t WS_U = WS_CD + 4096;
constexpr size_t WS_QN = WS_U + (size_t)TT * 2048 * 2;
constexpr size_t WS_KN = WS_QN + (size_t)TT * 1024 * 2;
constexpr size_t WS_VV = WS_KN + (size_t)TT * 1024 * 2;
constexpr size_t WS_YP = WS_VV + (size_t)TT * 1024 * 2;
constexpr size_t WS_WDC = WS_YP + (size_t)TT * 1024 * 2;
constexpr size_t WS_QD = WS_WDC + (size_t)1024 * 64 * 128 * 2;
constexpr size_t WS_KT = WS_QD + (size_t)1024 * 64 * 128 * 2;
constexpr size_t WS_QK = WS_KT + (size_t)1024 * 64 * 128 * 2;
constexpr size_t WS_PROJ = WS_QK + (size_t)1024 * 64 * 64 * 2;
constexpr size_t WS_END = WS_PROJ + (size_t)TT * NPROJ * 2;
constexpr size_t WS_PB10 = WS_PROJ;
constexpr size_t WS_PB13 = WS_PROJ + (size_t)TT * DFF * 2;
static_assert(WS_PB13 + (size_t)11 * TS * DM * 4 <= WS_END && (WS_PB13 % 256) == 0, "partials");
static_assert(WS_END + 16384 <= 501510720ull, "workspace too large");
static_assert((WS_PROJ % 256) == 0 && (WS_QK % 256) == 0 && (WS_U % 256) == 0, "align");

constexpr int LDS_BYTES = 147456;

struct Params {
    const float* in[24];
    float* out;
    unsigned char* ws;
    int ph_lo, ph_hi;
};

__device__ __forceinline__ float bf2f(unsigned short x) { return __uint_as_float(((unsigned)x) << 16); }
__device__ __forceinline__ unsigned short f2bf(float f) { const __bf16 b = (__bf16)f; return __builtin_bit_cast(unsigned short, b); }
typedef __bf16 bf16x2_hw __attribute__((ext_vector_type(2)));
__device__ __forceinline__ unsigned pk2(float lo, float hi) { const f32x2 v = {lo, hi}; const bf16x2_hw b = __builtin_convertvector(v, bf16x2_hw); return __builtin_bit_cast(unsigned, b); }
__device__ __forceinline__ void unpack8(const u32x4 w, float* f) {
    f[0] = __uint_as_float(w.x << 16); f[1] = __uint_as_float(w.x & 0xffff0000u);
    f[2] = __uint_as_float(w.y << 16); f[3] = __uint_as_float(w.y & 0xffff0000u);
    f[4] = __uint_as_float(w.z << 16); f[5] = __uint_as_float(w.z & 0xffff0000u);
    f[6] = __uint_as_float(w.w << 16); f[7] = __uint_as_float(w.w & 0xffff0000u);
}
__device__ __forceinline__ u32x4 pack8(const float* f) { u32x4 w; w.x = pk2(f[0], f[1]); w.y = pk2(f[2], f[3]); w.z = pk2(f[4], f[5]); w.w = pk2(f[6], f[7]); return w; }
__device__ __forceinline__ float sigmoidf_(float x) { return __builtin_amdgcn_rcpf(1.0f + __expf(-x)); }
__device__ __forceinline__ float siluf_(float x) { return x * __builtin_amdgcn_rcpf(1.0f + __expf(-x)); }
__device__ __forceinline__ int bidx_of_row(int row) { return row < TP ? (row >> 11) : 4 + ((row - TP) >> 2); }

namespace pg8 {
constexpr int BM = 256, BK = 64, HALF = 128, HTB = HALF * BK * 2, STAGE_BYTES = 8 * HTB, NXCD = 8, WGM = 8;
__host__ __device__ __forceinline__ int lds_byte(int r, int c) { const int st = (r >> 4) * 2 + (c >> 5), rr = r & 15, cc = c & 31, ob = rr * 64 + cc * 2; return st * 1024 + (ob ^ (((ob >> 9) & 1) << 5)); }
__host__ __device__ __forceinline__ void stage_rc(int b, int& R, int& C) { const int st = b / 1024, sb = b % 1024, swz = sb ^ (((sb >> 9) & 1) << 5); R = (st >> 1) * 16 + swz / 64; C = (st & 1) * 32 + (swz % 64) / 2; }
__host__ __device__ __forceinline__ int perm32(int rho) { const int n = rho >> 4, i = rho & 15; return 8 * (i >> 2) + 4 * n + (i & 3); }

struct Unit { int pm, pn, kt0, nkt, piece; };
struct Gemm { const bf16_t* A; const bf16_t* Bt; int lda, ldb, K; size_t a_pn_off; size_t a_half, b_half, a_tile, b_tile; };

__device__ __forceinline__ void tile_of(int wgid, int nM, int nN, Unit& u) {
    const int nwg = nM * nN;
    { const int q = nwg / NXCD, r = nwg % NXCD, xcd = wgid % NXCD, off = wgid / NXCD; wgid = (xcd < r ? xcd * (q + 1) : r * (q + 1) + (xcd - r) * q) + off; }
    const int nig = WGM * nN, gid = wgid / nig, fm = gid * WGM, gsz = (nM - fm) < WGM ? (nM - fm) : WGM;
    u.pm = fm + ((wgid % nig) % gsz); u.pn = (wgid % nig) / gsz;
}
struct StaticOrder {
    int nM, nN, nwg, G, c, ntk;
    __device__ __forceinline__ void init(int M, int N, int K, int G_, int c_) { nM = M / BM; nN = N / BM; nwg = nM * nN; G = G_; c = c_; ntk = K / BK; }
    __device__ __forceinline__ bool next(int i, Unit& u) const {
        const long L = (long)i * G + c; if (L >= nwg) return false;
        tile_of((int)L, nM, nN, u); u.kt0 = 0; u.nkt = ntk; u.piece = -1; return true;
    }
};
struct OneUnitOrder {
    int n, c, ntk;
    __device__ __forceinline__ bool next(int i, Unit& u) const { if (i != 0 || c >= n) return false; u.pm = 0; u.pn = c; u.kt0 = 0; u.nkt = ntk; u.piece = -1; return true; }
};
struct DoubleOrder {
    int G, c;
    __device__ __forceinline__ bool next(int i, Unit& u) const {
        const int L = (i >> 1) * G + c, half = i & 1; const bool ok = L < 272;
        tile_of(ok ? L : 0, 34, 8, u); u.kt0 = 16 * half; u.nkt = 16; u.piece = half; return ok;
    }
};
struct SplitOrder {
    int G, c, ntk, pk, npc;
    __device__ __forceinline__ bool next(int i, Unit& u) const {
        const int L = i * G + c;
        const bool full = L < 256;
        int fpm, fpn;
        { int wgid = full ? L : 0; const int xcd = wgid % NXCD, off = wgid / NXCD; wgid = xcd * 32 + off;
          const int nig = WGM * 8, gid = wgid / nig, fm = gid * WGM; fpm = fm + ((wgid % nig) % WGM); fpn = (wgid % nig) / WGM; }
        const int pidx = full ? 0 : L - 256, tile = pidx / npc, pc = pidx - tile * npc;
        u.pm = full ? fpm : 32 + (tile >> 3); u.pn = full ? fpn : (tile & 7); u.kt0 = full ? 0 : pc * pk; u.nkt = full ? ntk : pk; u.piece = full ? -1 : pc;
        return full || pidx < 16 * npc;
    }
};

template <class Epi, class Sched>
__device__ __forceinline__ void gemm_phase(LAS unsigned char* lds, const Gemm g, const Sched& S, const Epi& E) {
    const int tid = threadIdx.x, wid = __builtin_amdgcn_readfirstlane(tid >> 6), lane = tid & 63, wr = wid >> 2, wc = wid & 3, fr = lane & 15, fq = lane >> 4;
    unsigned voffA[2], voffB[2];
#pragma unroll
    for (int i = 0; i < 2; ++i) { int R, C; stage_rc(tid * 16 + i * 8192, R, C); const int Rb = Epi::PERM ? ((R & ~31) + perm32(R & 31)) : R;
        voffA[i] = (unsigned)(R * g.lda + C) * 2u; voffB[i] = (unsigned)(Rb * g.ldb + C) * 2u; }
    const size_t kstep = (size_t)(BK * 2);
    const size_t hstepA = g.a_half ? g.a_half : (size_t)HALF * g.lda * 2, hstepB = g.b_half ? g.b_half : (size_t)HALF * g.ldb * 2;
    const size_t tstepA = g.a_tile ? g.a_tile : (size_t)BM * g.lda * 2, tstepB = g.b_tile ? g.b_tile : (size_t)BM * g.ldb * 2;
    const unsigned ldsw = (unsigned)wid * 1024u;
    const int aoff = lds_byte(wr * 64 + fr, fq * 8), boff = lds_byte(wc * 32 + fr, fq * 8);
#define PG8_SA(b, h) (((b) * 2 + (h)) * HTB)
#define PG8_SB(b, h) ((4 + (b) * 2 + (h)) * HTB)
#define PG8_STAGE(bufoff, gbase, voff) do { _Pragma("unroll") for (int _i = 0; _i < 2; ++_i) \
        __builtin_amdgcn_global_load_lds((const unsigned*)((const char*)(gbase) + (voff)[_i]), (LAS unsigned*)(lds + (bufoff) + ldsw + _i * 8192), 16, 0, 0); } while (0)
#define PG8_LDA(dst, b, h) do { _Pragma("unroll") for (int m = 0; m < 4; ++m) _Pragma("unroll") for (int k = 0; k < 2; ++k) dst[m][k] = *(const LAS bf16x8*)(lds + PG8_SA(b, h) + aoff + m * 2048 + k * 1024); } while (0)
#define PG8_LDB(dst, b, h) do { _Pragma("unroll") for (int n = 0; n < 2; ++n) _Pragma("unroll") for (int k = 0; k < 2; ++k) dst[n][k] = *(const LAS bf16x8*)(lds + PG8_SB(b, h) + boff + n * 2048 + k * 1024); } while (0)
#define PG8_MMA(ai, bj, At, Bt) do { __builtin_amdgcn_s_setprio(1); _Pragma("unroll") for (int m = 0; m < 4; ++m) _Pragma("unroll") for (int n = 0; n < 2; ++n) _Pragma("unroll") for (int k = 0; k < 2; ++k) \
        acc[ai][bj][m][n] = __builtin_amdgcn_mfma_f32_16x16x32_bf16(Bt[n][k], At[m][k], acc[ai][bj][m][n], 0, 0, 0); __builtin_amdgcn_s_setprio(0); } while (0)
#define PG8_WAIT_V(n) asm volatile("s_waitcnt vmcnt(" #n ")" ::: "memory")
#define PG8_WAIT_L(n) asm volatile("s_waitcnt lgkmcnt(" #n ")" ::: "memory")
#define PG8_BAR __builtin_amdgcn_s_barrier()
#define PG8_SCHED __builtin_amdgcn_sched_barrier(0)
    Unit cur, nxt; int ui = 0;
    if (!S.next(0, cur)) return;
    f32x4 acc[2][2][4][2];
#pragma unroll
    for (int a = 0; a < 2; ++a)
#pragma unroll
        for (int b = 0; b < 2; ++b)
#pragma unroll
            for (int m = 0; m < 4; ++m)
#pragma unroll
                for (int n = 0; n < 2; ++n) acc[a][b][m][n] = (f32x4){0.f, 0.f, 0.f, 0.f};
    bf16x8 At[4][2], B0[2][2], B1[2][2];
    const char* cA = (const char*)g.A + (size_t)cur.pm * tstepA + (size_t)cur.pn * g.a_pn_off + (size_t)cur.kt0 * kstep; const char* cB = (const char*)g.Bt + (size_t)cur.pn * tstepB + (size_t)cur.kt0 * kstep;
    PG8_STAGE(PG8_SB(0, 0), cB, voffB); PG8_STAGE(PG8_SA(0, 0), cA, voffA); PG8_STAGE(PG8_SB(0, 1), cB + hstepB, voffB); PG8_STAGE(PG8_SA(0, 1), cA + hstepA, voffA);
    if (wr == 1) PG8_BAR;
    PG8_WAIT_V(4); PG8_BAR;
    PG8_STAGE(PG8_SB(1, 0), cB + kstep, voffB); PG8_STAGE(PG8_SA(1, 0), cA + kstep, voffA); PG8_STAGE(PG8_SB(1, 1), cB + hstepB + kstep, voffB);
    PG8_WAIT_V(6); PG8_BAR;
    for (;;) {
        const bool has_next = S.next(ui + 1, nxt);
        const char* nA = has_next ? (const char*)g.A + (size_t)nxt.pm * tstepA + (size_t)nxt.pn * g.a_pn_off + (size_t)nxt.kt0 * kstep : cA; const char* nB = has_next ? (const char*)g.Bt + (size_t)nxt.pn * tstepB + (size_t)nxt.kt0 * kstep : cB;
        const int nt = cur.nkt;
#pragma unroll 1
        for (int t = 0; t < nt; t += 2) {
            const bool last = (t == nt - 2);
            const char* a1 = cA + (size_t)(t + 1) * kstep;
            const char* a2 = last ? nA : cA + (size_t)(t + 2) * kstep; const char* b2 = last ? nB : cB + (size_t)(t + 2) * kstep;
            const char* a3 = a2 + kstep; const char* b3 = b2 + kstep;
            PG8_LDB(B0, 0, 0); PG8_SCHED; PG8_LDA(At, 0, 0); PG8_STAGE(PG8_SA(1, 1), a1 + hstepA, voffA);
            PG8_WAIT_L(8); PG8_BAR; PG8_WAIT_L(0); PG8_MMA(0, 0, At, B0); PG8_BAR; PG8_SCHED;
            PG8_LDB(B1, 0, 1); PG8_STAGE(PG8_SB(0, 0), b2, voffB);
            PG8_BAR; PG8_WAIT_L(0); if constexpr (!Epi::DIAG) PG8_MMA(0, 1, At, B1); PG8_BAR;
            PG8_LDA(At, 0, 1); PG8_STAGE(PG8_SA(0, 0), a2, voffA);
            PG8_BAR; PG8_WAIT_L(0); if constexpr (!Epi::DIAG) PG8_MMA(1, 0, At, B0); PG8_BAR; PG8_SCHED;
            PG8_STAGE(PG8_SB(0, 1), b2 + hstepB, voffB);
            PG8_WAIT_V(6); PG8_BAR; PG8_MMA(1, 1, At, B1); PG8_BAR;
            PG8_LDB(B0, 1, 0); PG8_SCHED; PG8_LDA(At, 1, 0); PG8_STAGE(PG8_SA(0, 1), a2 + hstepA, voffA);
            PG8_WAIT_L(8); PG8_BAR; PG8_WAIT_L(0); PG8_MMA(0, 0, At, B0); PG8_BAR; PG8_SCHED;
            PG8_LDB(B1, 1, 1); PG8_STAGE(PG8_SB(1, 0), b3, voffB);
            PG8_BAR; PG8_WAIT_L(0); if constexpr (!Epi::DIAG) PG8_MMA(0, 1, At, B1); PG8_BAR;
            PG8_LDA(At, 1, 1); PG8_STAGE(PG8_SA(1, 0), a3, voffA);
            PG8_BAR; PG8_WAIT_L(0); if constexpr (!Epi::DIAG) PG8_MMA(1, 0, At, B0); PG8_BAR; PG8_SCHED;
            PG8_STAGE(PG8_SB(1, 1), b3 + hstepB, voffB);
            PG8_WAIT_V(6); PG8_BAR; PG8_MMA(1, 1, At, B1); PG8_BAR;
        }
        E(acc, cur, wr, wc, fr, fq);
        if (!has_next) break;
#pragma unroll
        for (int a = 0; a < 2; ++a)
#pragma unroll
            for (int b = 0; b < 2; ++b)
#pragma unroll
                for (int m = 0; m < 4; ++m)
#pragma unroll
                    for (int n = 0; n < 2; ++n) acc[a][b][m][n] = (f32x4){0.f, 0.f, 0.f, 0.f};
        cur = nxt; cA = nA; cB = nB; ++ui;
    }
    PG8_WAIT_V(0);
    if (wr == 0) PG8_BAR;
    PG8_BAR;
#undef PG8_SA
#undef PG8_SB
#undef PG8_STAGE
#undef PG8_LDA
#undef PG8_LDB
#undef PG8_MMA
#undef PG8_WAIT_V
#undef PG8_WAIT_L
#undef PG8_BAR
#undef PG8_SCHED
}

typedef f32x4 Acc[2][2][4][2];

struct EpiAda {
    static constexpr bool PERM = false, MID = false, DIAG = false;
    float* C; const float* bias;
    __device__ __forceinline__ void operator()(const Acc& acc, const Unit& u, int wr, int wc, int fr, int fq) const {
        const int row0 = wr * 64 + fr, col0 = u.pn * BM + wc * 32 + 4 * fq;
#pragma unroll
        for (int ai = 0; ai < 2; ++ai)
#pragma unroll
            for (int m = 0; m < 4; ++m) { const int row = row0 + ai * HALF + m * 16; if (row < NB) {
#pragma unroll
                for (int bj = 0; bj < 2; ++bj)
#pragma unroll
                    for (int n = 0; n < 2; ++n) { const int c = col0 + bj * HALF + n * 16; *(f32x4*)(C + (size_t)row * MODW + c) = acc[ai][bj][m][n] + *(const f32x4*)(bias + c); } } }
    }
};
struct EpiBf16 {
    static constexpr bool PERM = true, MID = false, DIAG = false;
    bf16_t* O; int ldc; int col_off; const float* scale;
    __device__ __forceinline__ void operator()(const Acc& acc, const Unit& u, int wr, int wc, int fr, int fq) const {
        const int row0 = u.pm * BM + wr * 64 + fr, col0 = u.pn * BM + wc * 32 + 8 * fq;
#pragma unroll
        for (int ai = 0; ai < 2; ++ai)
#pragma unroll
            for (int m = 0; m < 4; ++m) { bf16_t* rowp = O + (size_t)(row0 + ai * HALF + m * 16) * ldc + col_off + col0;
#pragma unroll
                for (int bj = 0; bj < 2; ++bj) { f32x4 v0 = acc[ai][bj][m][0], v1 = acc[ai][bj][m][1];
                    if (scale) { v0 *= *(const f32x4*)(scale + col0 + bj * HALF); v1 *= *(const f32x4*)(scale + col0 + bj * HALF + 4); }
                    u32x4 w; w.x = pk2(v0[0], v0[1]); w.y = pk2(v0[2], v0[3]); w.z = pk2(v1[0], v1[1]); w.w = pk2(v1[2], v1[3]);
                    *(u32x4*)(rowp + bj * HALF) = w; }
                if (scale) asm volatile("" ::: "memory"); }
    }
};
struct EpiG1 {
    static constexpr bool PERM = true, MID = false, DIAG = false;
    float* T1; const bf16_t* proj;
    __device__ __forceinline__ void operator()(const Acc& acc, const Unit& u, int wr, int wc, int fr, int fq) const {
        const int row0 = u.pm * BM + wr * 64 + fr, col0 = u.pn * BM + wc * 32 + 8 * fq;
#pragma unroll
        for (int ai = 0; ai < 2; ++ai)
#pragma unroll
            for (int m = 0; m < 4; ++m) { const size_t row = (size_t)(row0 + ai * HALF + m * 16); const bf16_t* pr = proj + row * NPROJ + col0;
#pragma unroll
                for (int bj = 0; bj < 2; ++bj) { float ga[8]; unpack8(*(const u32x4*)(pr + C_GA + bj * HALF), ga); f32x4 v0, v1;
#pragma unroll
                    for (int j = 0; j < 4; ++j) { v0[j] = acc[ai][bj][m][0][j] * __builtin_amdgcn_rcpf(1.0f + __expf(-ga[j])); v1[j] = acc[ai][bj][m][1][j] * __builtin_amdgcn_rcpf(1.0f + __expf(-ga[4 + j])); }
                    float* o = T1 + row * DM + col0 + bj * HALF; *(f32x4*)o = v0; *(f32x4*)(o + 4) = v1; }
                }
    }
};
struct EpiG2 {
    static constexpr bool PERM = true, MID = false, DIAG = false;
    bf16_t* O; const float* T1; const bf16_t* proj;
    __device__ __forceinline__ void operator()(const Acc& acc, const Unit& u, int wr, int wc, int fr, int fq) const {
        const int row0 = u.pm * BM + wr * 64 + fr, col0 = u.pn * BM + wc * 32 + 8 * fq;
#pragma unroll
        for (int ai = 0; ai < 2; ++ai)
#pragma unroll
            for (int m = 0; m < 4; ++m) { const size_t row = (size_t)(row0 + ai * HALF + m * 16); const bf16_t* pr = proj + row * NPROJ + col0;
#pragma unroll
                for (int bj = 0; bj < 2; ++bj) { float gb[8], v[8]; unpack8(*(const u32x4*)(pr + C_GB + bj * HALF), gb);
                    const float* t = T1 + row * DM + col0 + bj * HALF; const f32x4 t0 = *(const f32x4*)t, t1 = *(const f32x4*)(t + 4);
#pragma unroll
                    for (int j = 0; j < 4; ++j) { v[j] = t0[j] + acc[ai][bj][m][0][j] * __builtin_amdgcn_rcpf(1.0f + __expf(-gb[j])); v[4 + j] = t1[j] + acc[ai][bj][m][1][j] * __builtin_amdgcn_rcpf(1.0f + __expf(-gb[4 + j])); }
                    *(u32x4*)(O + row * DM + col0 + bj * HALF) = pack8(v); }
                if (m & 1) asm volatile("" ::: "memory"); }
    }
};
struct EpiG12 {
    static constexpr bool PERM = true, MID = false, DIAG = false;
    EpiG1 e1; EpiG2 e2;
    __device__ __forceinline__ void operator()(const Acc& acc, const Unit& u, int wr, int wc, int fr, int fq) const { if (u.piece == 0) e1(acc, u, wr, wc, fr, fq); else e2(acc, u, wr, wc, fr, fq); }
};
struct EpiDiag {
    static constexpr bool PERM = true, MID = false, DIAG = true;
    bf16_t* O; const bf16_t* proj;
    __device__ __forceinline__ void operator()(const Acc& acc, const Unit& u, int wr, int wc, int fr, int fq) const {
        const int row0 = u.pm * HALF + wr * 64 + fr, col0 = u.pn * HALF + wc * 32 + 8 * fq;
#pragma unroll
        for (int m = 0; m < 4; ++m) { const size_t row = (size_t)(row0 + m * 16); const bf16_t* pr = proj + row * NPROJ + col0;
            float ga[8], gb[8], v[8]; unpack8(*(const u32x4*)(pr + C_GA), ga); unpack8(*(const u32x4*)(pr + C_GB), gb);
#pragma unroll
            for (int n = 0; n < 2; ++n)
#pragma unroll
                for (int j = 0; j < 4; ++j) v[4 * n + j] = acc[0][0][m][n][j] * __builtin_amdgcn_rcpf(1.0f + __expf(-ga[4 * n + j])) + acc[1][1][m][n][j] * __builtin_amdgcn_rcpf(1.0f + __expf(-gb[4 * n + j]));
            *(u32x4*)(O + row * DM + col0) = pack8(v); }
    }
};
struct EpiRes {
    static constexpr bool PERM = false, MID = false, DIAG = false;
    float* X1; const float* x0p; const float* x0s; const float* gate; float* PB;
    __device__ __forceinline__ void operator()(const Acc& acc, const Unit& u, int wr, int wc, int fr, int fq) const {
        const int row0 = u.pm * BM + wr * 64 + fr, col0 = u.pn * BM + wc * 32 + 4 * fq;
        if (u.piece >= 0) {
            float* pb = PB + (size_t)u.piece * TS * DM;
#pragma unroll
            for (int ai = 0; ai < 2; ++ai)
#pragma unroll
                for (int m = 0; m < 4; ++m) { float* orow = pb + (size_t)(row0 + ai * HALF + m * 16 - TP) * DM;
#pragma unroll
                    for (int bj = 0; bj < 2; ++bj)
#pragma unroll
                        for (int n = 0; n < 2; ++n) *(f32x4*)(orow + col0 + bj * HALF + n * 16) = acc[ai][bj][m][n]; }
            return;
        }
#pragma unroll
        for (int ai = 0; ai < 2; ++ai)
#pragma unroll
            for (int m = 0; m < 4; ++m) { const int row = row0 + ai * HALF + m * 16; const int b = bidx_of_row(row);
                const float* xr = (row < TP) ? x0p + (size_t)row * DM : x0s + (size_t)(row - TP) * DM; const float* gr = gate + (size_t)b * MODW; float* orow = X1 + (size_t)row * DM;
#pragma unroll
                for (int bj = 0; bj < 2; ++bj)
#pragma unroll
                    for (int n = 0; n < 2; ++n) { const int c = col0 + bj * HALF + n * 16; const f32x4 xv = *(const f32x4*)(xr + c), gv = *(const f32x4*)(gr + c);
                        *(f32x4*)(orow + c) = xv + gv * acc[ai][bj][m][n]; } }
    }
};
struct EpiGU {
    static constexpr bool PERM = true, MID = false, DIAG = false;
    bf16_t* O;
    __device__ __forceinline__ void operator()(const Acc& acc, const Unit& u, int wr, int wc, int fr, int fq) const {
        const int row0 = u.pm * BM + wr * 64 + fr, col0 = u.pn * HALF + wc * 32 + 8 * fq;
#pragma unroll
        for (int ai = 0; ai < 2; ++ai)
#pragma unroll
            for (int m = 0; m < 4; ++m) { float v[8];
#pragma unroll
                for (int n = 0; n < 2; ++n) {
                    const f32x4 gt = acc[ai][0][m][n], arg = gt * (-1.4426950408889634f), gu = gt * acc[ai][1][m][n];
                    f32x4 t;
#pragma unroll
                    for (int j = 0; j < 4; ++j) t[j] = __builtin_amdgcn_exp2f(arg[j]);
                    t = t + 1.0f;
#pragma unroll
                    for (int j = 0; j < 4; ++j) t[j] = __builtin_amdgcn_rcpf(t[j]);
                    const f32x4 r = gu * t;
#pragma unroll
                    for (int j = 0; j < 4; ++j) v[4 * n + j] = r[j]; }
                *(u32x4*)(O + (size_t)(row0 + ai * HALF + m * 16) * DFF + col0) = pack8(v); }
    }
};
}

struct TJob { const float* src; bf16_t* dst; int ld_src, K, Nout, ld_dst, map, pad; };
__device__ __forceinline__ int map_col(int map, int n) {
    if (map == 1) { if (n < 4096) return n; if (n < 5120) return 4112 + (n - 4096); if (n < 9216) return 5136 + (n - 5120); if (n < 9232) return 4096 + (n - 9216); return -1; }
    if (map == 2) { const int pn = n >> 8, w = n & 255; return w < 128 ? 128 * pn + w : DFF + 128 * pn + (w - 128); }
    return n;
}
__device__ __forceinline__ void tjob_load(const TJob& j, int tile, f32x4 (&v)[4]) {
    const int tid = threadIdx.x, nkt = j.K >> 7, tn = tile / nkt, tk = tile - tn * nkt;
    const int n = tn * 64 + (tid & 15) * 4, kr = tid >> 4, col = map_col(j.map, n);
#pragma unroll
    for (int i = 0; i < 4; ++i) v[i] = col >= 0 ? __builtin_nontemporal_load((const f32x4*)(j.src + (size_t)(tk * 128 + kr + 32 * i) * j.ld_src + col)) : (f32x4){0.f, 0.f, 0.f, 0.f};
}
__device__ __forceinline__ void tjob_store(const TJob& j, int tile, const f32x4 (&v)[4], LAS float* s) {
    const int tid = threadIdx.x, nkt = j.K >> 7, tn = tile / nkt, tk = tile - tn * nkt;
    const int nq = tid & 15, kr = tid >> 4;
    __syncthreads();
#pragma unroll
    for (int i = 0; i < 4; ++i)
#pragma unroll
        for (int q = 0; q < 4; ++q) s[(4 * nq + q) * 129 + kr + 32 * i] = v[i][q];
    __syncthreads();
    const int n = tid >> 3, k16 = (tid & 7) * 16;
    float f[16];
#pragma unroll
    for (int i = 0; i < 16; ++i) f[i] = s[n * 129 + k16 + i];
    bf16_t* d = j.dst + (size_t)(tn * 64 + n) * j.ld_dst + tk * 128 + k16;
    *(u32x4*)d = pack8(f); *(u32x4*)(d + 8) = pack8(f + 8);
}
__device__ __forceinline__ void transpose_jobs(const TJob* jobs, int njobs, int bi, int nblk, LAS unsigned char* lds) {
    LAS float* s = (LAS float*)lds;
    int total = 0;
    for (int q = 0; q < njobs; ++q) total += (jobs[q].Nout >> 6) * (jobs[q].K >> 7);
    f32x4 v[4]; int curj = 0, base = 0;
    int t = bi;
    auto locate = [&](int tt, int& jj, int& bb) { while (tt >= bb + (jobs[jj].Nout >> 6) * (jobs[jj].K >> 7)) { bb += (jobs[jj].Nout >> 6) * (jobs[jj].K >> 7); ++jj; } };
    if (t < total) { locate(t, curj, base); tjob_load(jobs[curj], t - base, v); }
    while (t < total) {
        const int tn = t + nblk; int nj = curj, nb = base; f32x4 w[4];
        if (tn < total) { locate(tn, nj, nb); tjob_load(jobs[nj], tn - nb, w); }
        tjob_store(jobs[curj], t - base, v, s);
        if (tn < total) {
#pragma unroll
            for (int i = 0; i < 4; ++i) v[i] = w[i]; }
        t = tn; curj = nj; base = nb;
    }
    __syncthreads();
}

template <int MODE>
__device__ __forceinline__ void norm_phase(const Params& p, int bid, int nblk) {
    const int lane = threadIdx.x & 63, wid = __builtin_amdgcn_readfirstlane(threadIdx.x >> 6);
    const float* mod = (const float*)(p.ws + WS_MOD);
    const float* gain = MODE == 0 ? p.in[9] : (MODE == 1 ? p.in[20] : p.in[23]);
    bf16_t* U = (bf16_t*)(p.ws + WS_U);
    auto srcrow = [&](int row) -> const float* { return MODE == 0 ? (row < TP ? p.in[0] + (size_t)row * DM : p.in[1] + (size_t)(row - TP) * DM) : p.out + O_Y + (size_t)row * DM; };
    const int stride = nblk * 8;
    f32x4 g[8];
#pragma unroll
    for (int i = 0; i < 8; ++i) g[i] = *(const f32x4*)(gain + i * 256 + lane * 4);
    f32x4 v[8], vn[8];
    bool have = false;
    const bool weighted = nblk == 256;
    const int first = bid * 8 + wid;
    const int nrows = weighted ? (MODE == 0 ? (wid < 2 ? 5 : 4) : (wid < 2 ? 2 : 5)) : (first < TT ? (TT - first + stride - 1) / stride : 0);
    auto rowat = [&](int k) -> int {
        if (!weighted) return first + k * stride;
        if (MODE == 0) return wid < 2 ? (k == 0 ? TP + bid * 2 + wid : bid * 32 + wid * 4 + (k - 1)) : bid * 32 + 8 + (wid - 2) * 4 + k;
        return wid < 2 ? (k == 0 ? TP + bid * 2 + wid : bid * 32 + wid) : bid * 32 + 2 + (wid - 2) * 5 + k; };
    int cur_b = -1; f32x4 s1[8], s0[8];
    for (int k = 0; k < nrows; ++k) {
        const int row = rowat(k);
        const float* src = srcrow(row);
        if (MODE != 0 && row >= TP) {
            const float* xs = p.in[1] + (size_t)(row - TP) * DM;
            const float* pb = (const float*)(p.ws + (MODE == 1 ? WS_PB10 : WS_PB13)) + (size_t)(row - TP) * DM;
            const float* gt = mod + (size_t)bidx_of_row(row) * MODW + (MODE == 1 ? 4096 : 10240);
            float* xo = p.out + O_Y + (size_t)row * DM;
            constexpr int NPC = MODE == 1 ? 8 : 11;
#pragma unroll 1
            for (int i = 0; i < 8; ++i) { const int c = i * 256 + lane * 4; f32x4 s = *(const f32x4*)(pb + c);
#pragma unroll
                for (int q = 1; q < NPC; ++q) s += *(const f32x4*)(pb + (size_t)q * TS * DM + c);
                const f32x4 base = MODE == 1 ? *(const f32x4*)(xs + c) : *(const f32x4*)(xo + c);
                *(f32x4*)(xo + c) = base + *(const f32x4*)(gt + c) * s; }
            asm volatile("s_waitcnt vmcnt(0)" ::: "memory");
        }
        float ss = 0.f;
        const int b_row = bidx_of_row(row);
        const float* sh = mod + (size_t)b_row * MODW + (MODE == 0 ? 0 : 6144); const float* sc = sh + 2048;
        if (!have) {
#pragma unroll
            for (int i = 0; i < 8; ++i) v[i] = *(const f32x4*)(src + i * 256 + lane * 4);
        }
        if (MODE != 2 && b_row != cur_b) {
#pragma unroll
            for (int i = 0; i < 8; ++i) { const int c = i * 256 + lane * 4; s1[i] = *(const f32x4*)(sc + c); s0[i] = *(const f32x4*)(sh + c); }
            cur_b = b_row;
        }
        const int nrow = (k + 1 < nrows) ? rowat(k + 1) : TT;
        const bool pre = nrow < TT && (MODE == 0 || nrow < TP);
        if (pre) { const float* ns = srcrow(nrow);
#pragma unroll
            for (int i = 0; i < 8; ++i) vn[i] = *(const f32x4*)(ns + i * 256 + lane * 4); }
        asm volatile("" ::: "memory");
#pragma unroll
        for (int i = 0; i < 8; ++i) ss += v[i][0] * v[i][0] + v[i][1] * v[i][1] + v[i][2] * v[i][2] + v[i][3] * v[i][3];
#pragma unroll
        for (int o = 32; o >= 1; o >>= 1) ss += __shfl_xor(ss, o);
        const float rstd = rsqrtf(ss * (1.0f / DM) + EPS);
        if (MODE == 2) {
            float* dst = p.out + O_Y + (size_t)row * DM;
#pragma unroll
            for (int i = 0; i < 8; ++i) *(f32x4*)(dst + i * 256 + lane * 4) = v[i] * rstd * g[i];
        } else {
#pragma unroll
            for (int i = 0; i < 8; ++i) { const int c = i * 256 + lane * 4;
                const f32x4 y = (v[i] * rstd * g[i]) * (1.0f + s1[i]) + s0[i]; u32x2 w; w.x = pk2(y[0], y[1]); w.y = pk2(y[2], y[3]); *(u32x2*)(U + (size_t)row * DM + c) = w; }
        }
        have = pre;
        if (pre) {
#pragma unroll
            for (int i = 0; i < 8; ++i) v[i] = vn[i]; }
    }
}

template <int NTOK, bool SMP>
__device__ __forceinline__ void mixer_item(const Params& p, int it) {
    const int tid = threadIdx.x;
    const bf16_t* proj = (const bf16_t*)(p.ws + WS_PROJ);
    bf16_t* qn = (bf16_t*)(p.ws + WS_QN); bf16_t* kn = (bf16_t*)(p.ws + WS_KN); bf16_t* vv = (bf16_t*)(p.ws + WS_VV); bf16_t* yp = (bf16_t*)(p.ws + WS_YP);
    float* gbuf = (float*)(p.ws + WS_G); float* bbuf = (float*)(p.ws + WS_BETA);
    const int sb = it - 512;
    const int b = SMP ? 0 : (it >> 7), t0 = SMP ? 0 : (it & 127) * 16;
    const int rowbase = SMP ? TP + sb * 4 : b * 2048 + t0;
    unsigned short gate_raw = 0;
    if (tid < 256 && (tid >> 4) < NTOK) gate_raw = proj[(size_t)(rowbase + (tid >> 4)) * NPROJ + C_AB + (tid & 15)];
    if (tid < 384) {
        const int c0 = tid * 8;
        float w0[8], w1[8], w2[8], w3[8], xm3[8], xm2[8], xm1[8];
        const float* cw = p.in[11];
#pragma unroll
        for (int i = 0; i < 8; ++i) { w0[i] = cw[c0 + i]; w1[i] = cw[3072 + c0 + i]; w2[i] = cw[6144 + c0 + i]; w3[i] = cw[9216 + c0 + i]; }
        if (SMP) { const float* sc = p.in[5] + (size_t)sb * 3 * 3072 + c0;
#pragma unroll
            for (int i = 0; i < 8; ++i) { xm3[i] = sc[i]; xm2[i] = sc[3072 + i]; xm1[i] = sc[6144 + i]; }
        } else if (t0 == 0) {
#pragma unroll
            for (int i = 0; i < 8; ++i) { xm3[i] = 0.f; xm2[i] = 0.f; xm1[i] = 0.f; }
        } else {
            unpack8(*(const u32x4*)(proj + (size_t)(rowbase - 3) * NPROJ + c0), xm3); unpack8(*(const u32x4*)(proj + (size_t)(rowbase - 2) * NPROJ + c0), xm2); unpack8(*(const u32x4*)(proj + (size_t)(rowbase - 1) * NPROJ + c0), xm1);
        }
        constexpr int CH = NTOK < 8 ? NTOK : 8;
#pragma unroll
        for (int tc = 0; tc < NTOK; tc += CH) {
        u32x4 xr[CH];
#pragma unroll
        for (int t = 0; t < CH; ++t) xr[t] = *(const u32x4*)(proj + (size_t)(rowbase + tc + t) * NPROJ + c0);
#pragma unroll
        for (int t2 = 0; t2 < CH; ++t2) {
            const int t = tc + t2;
            const int row = rowbase + t; float xt[8], y[8];
            unpack8(xr[t2], xt);
            float ss = 0.f;
#pragma unroll
            for (int i = 0; i < 8; ++i) { const float a = w0[i] * xm3[i] + w1[i] * xm2[i] + w2[i] * xm1[i] + w3[i] * xt[i]; y[i] = siluf_(a); ss += y[i] * y[i]; }
            if (c0 < 2048) {
                ss += __shfl_xor(ss, 1); ss += __shfl_xor(ss, 2); ss += __shfl_xor(ss, 4); ss += __shfl_xor(ss, 8);
                const float inv = rsqrtf(ss + EPS);
#pragma unroll
                for (int i = 0; i < 8; ++i) y[i] *= inv;
            }
            bf16_t* dst = c0 < 1024 ? qn + (size_t)row * 1024 + c0 : (c0 < 2048 ? kn + (size_t)row * 1024 + (c0 - 1024) : vv + (size_t)row * 1024 + (c0 - 2048));
            *(u32x4*)dst = pack8(y);
            if (SMP) { if (t >= 1) { float* o = p.out + O_CS + ((size_t)sb * 3 + (t - 1)) * 3072 + c0; *(f32x4*)o = (f32x4){xt[0], xt[1], xt[2], xt[3]}; *(f32x4*)(o + 4) = (f32x4){xt[4], xt[5], xt[6], xt[7]}; } }
            else if (t0 + t >= 2045) { float* o = p.out + O_CP + ((size_t)b * 3 + (t0 + t - 2045)) * 3072 + c0; *(f32x4*)o = (f32x4){xt[0], xt[1], xt[2], xt[3]}; *(f32x4*)(o + 4) = (f32x4){xt[4], xt[5], xt[6], xt[7]}; }
#pragma unroll
            for (int i = 0; i < 8; ++i) { xm3[i] = xm2[i]; xm2[i] = xm1[i]; xm1[i] = xt[i]; }
        }
        }
    } else {
        const int pc = (tid - 384) * 8, gi = pc >> 8, w = 2 << gi;
        const int seqrow0 = SMP ? TP + sb * 4 : b * 2048;
        const float* sp = p.in[6] + (size_t)sb * 15 * 1024 + pc;
        auto xpool = [&](int tt, float* f) {
            if (tt >= 0) unpack8(*(const u32x4*)(proj + (size_t)(seqrow0 + tt) * NPROJ + C_XP + pc), f);
            else if (SMP) { const float* s = sp + (size_t)(15 + tt) * 1024;
#pragma unroll
                for (int i = 0; i < 8; ++i) f[i] = s[i]; }
            else {
#pragma unroll
                for (int i = 0; i < 8; ++i) f[i] = 0.f; }
        };
        float s[8];
#pragma unroll
        for (int i = 0; i < 8; ++i) s[i] = 0.f;
#pragma unroll
        for (int q = 1; q < 16; ++q) if (q < w) { float f[8]; xpool(t0 - q, f);
#pragma unroll
            for (int i = 0; i < 8; ++i) s[i] += f[i]; }
#pragma unroll 4
        for (int t = 0; t < NTOK; ++t) {
            const int tt = t0 + t; float x[8], y[8], f[8];
            xpool(tt, x);
            const float cnt = SMP ? (float)w : (float)min(w, tt + 1); const float ic = 1.0f / cnt;
#pragma unroll
            for (int i = 0; i < 8; ++i) { s[i] += x[i]; y[i] = s[i] * ic - x[i]; }
            *(u32x4*)(yp + (size_t)(seqrow0 + tt) * 1024 + pc) = pack8(y);
            xpool(tt - w + 1, f);
#pragma unroll
            for (int i = 0; i < 8; ++i) s[i] -= f[i];
            if (SMP) { float* o = p.out + O_PS + ((size_t)sb * 15 + 11 + t) * 1024 + pc; *(f32x4*)o = (f32x4){x[0], x[1], x[2], x[3]}; *(f32x4*)(o + 4) = (f32x4){x[4], x[5], x[6], x[7]}; }
            else if (tt >= 2033) { float* o = p.out + O_PP + ((size_t)b * 15 + (tt - 2033)) * 1024 + pc; *(f32x4*)o = (f32x4){x[0], x[1], x[2], x[3]}; *(f32x4*)(o + 4) = (f32x4){x[4], x[5], x[6], x[7]}; }
        }
        if (SMP) {
#pragma unroll
            for (int r = 0; r < 11; ++r) { const float* s2 = sp + (size_t)(4 + r) * 1024; float* o = p.out + O_PS + ((size_t)sb * 15 + r) * 1024 + pc; *(f32x4*)o = *(const f32x4*)s2; *(f32x4*)(o + 4) = *(const f32x4*)(s2 + 4); } }
    }
    if (tid < 256) { const int tk = tid >> 4, jj = tid & 15;
        if (tk < NTOK) { const int row = rowbase + tk; const float val = bf2f(gate_raw);
            if (jj < 8) { const float xx = val + p.in[13][jj]; const float spl = xx > 20.f ? xx : log1pf(__expf(xx)); gbuf[row * 8 + jj] = -__expf(p.in[12][jj]) * spl; }
            else bbuf[row * 8 + (jj - 8)] = sigmoidf_(val); } }
}
__device__ __forceinline__ void mixer_prep_phase(const Params& p, int bid, int nblk) {
    for (int it = bid; it < 640; it += nblk) { if (it >= 512) mixer_item<4, true>(p, it); else mixer_item<16, false>(p, it); }
}

constexpr int P5_QS = 0, P5_KS = 17408, P5_VS = 34816, P5_MM = 52224, P5_DEC = 68608, P5_BETA = 68864, P5_GRP = 69632;
static_assert(2 * P5_GRP <= LDS_BYTES - 16, "lds");
__device__ __forceinline__ void chunk_prep_phase(const Params& p, int bid, int nblk, LAS unsigned char* lds0) {
    const int tid = threadIdx.x, lane = tid & 63, grp = tid >> 8, lt = tid & 255, lw = __builtin_amdgcn_readfirstlane(tid >> 6) & 3;
    LAS unsigned char* lds = lds0 + grp * P5_GRP;
    const bf16_t* qn = (const bf16_t*)(p.ws + WS_QN); const bf16_t* kn = (const bf16_t*)(p.ws + WS_KN); const bf16_t* vv = (const bf16_t*)(p.ws + WS_VV);
    const float* gbuf = (const float*)(p.ws + WS_G); const float* bbuf = (const float*)(p.ws + WS_BETA);
    bf16_t* wdc = (bf16_t*)(p.ws + WS_WDC); bf16_t* qd = (bf16_t*)(p.ws + WS_QD); bf16_t* kt = (bf16_t*)(p.ws + WS_KT); bf16_t* qk = (bf16_t*)(p.ws + WS_QK);
    float* cdv = (float*)(p.ws + WS_CD); float* ub = p.out + OS_UB;
    LAS float* Mm = (LAS float*)(lds + P5_MM); LAS float* dec = (LAS float*)(lds + P5_DEC); LAS float* bet = (LAS float*)(lds + P5_BETA);
    const float scale = 0.08838834764831845f;
    for (int it0 = bid * 2; it0 < 1024; it0 += nblk * 2) {
        const int item = it0 + grp, n = item & 31, bh = item >> 5, h = bh & 7, b = bh >> 3;
        const int r0 = b * 2048 + n * 64;
        __syncthreads();
#pragma unroll
        for (int i = 0; i < 4; ++i) { const int ch = lt + 256 * i, r = ch >> 4, c8 = (ch & 15) * 8; const size_t go = (size_t)(r0 + r) * 1024 + h * 128 + c8; const int lo = r * 272 + c8 * 2;
            *(LAS u32x4*)(lds + P5_QS + lo) = *(const u32x4*)(qn + go); *(LAS u32x4*)(lds + P5_KS + lo) = *(const u32x4*)(kn + go); *(LAS u32x4*)(lds + P5_VS + lo) = *(const u32x4*)(vv + go); }
        if (lt < 64) {
            float g = gbuf[(r0 + lt) * 8 + h];
#pragma unroll
            for (int o = 1; o < 64; o <<= 1) { const float t = __shfl_up(g, o); if (lane >= o) g += t; }
            dec[lt] = g;
        } else if (lt < 128) bet[lt - 64] = bbuf[(r0 + lt - 64) * 8 + h];
        __syncthreads();
        {
            const int rt = lw, fr = lane & 15, fq = lane >> 4;
#pragma unroll
            for (int mat = 0; mat < 2; ++mat) {
                bf16x8 a[4];
#pragma unroll
                for (int kk = 0; kk < 4; ++kk) a[kk] = *(const LAS bf16x8*)(lds + (mat ? P5_QS : P5_KS) + (rt * 16 + fr) * 272 + (kk * 32 + fq * 8) * 2);
#pragma unroll
                for (int st = 0; st < 4; ++st) {
                    f32x4 d = (f32x4){0.f, 0.f, 0.f, 0.f};
#pragma unroll
                    for (int kk = 0; kk < 4; ++kk) { const bf16x8 bb = *(const LAS bf16x8*)(lds + P5_KS + (st * 16 + fr) * 272 + (kk * 32 + fq * 8) * 2); d = __builtin_amdgcn_mfma_f32_16x16x32_bf16(a[kk], bb, d, 0, 0, 0); }
                    const int s = st * 16 + fr; const float ds = dec[s];
#pragma unroll
                    for (int j = 0; j < 4; ++j) { const int r = rt * 16 + fq * 4 + j; const float dr = dec[r];
                        if (mat == 0) Mm[r * 64 + s] = (r > s) ? bet[r] * d[j] * __expf(dr - ds) : 0.f;
                        else qk[(size_t)item * 4096 + r * 64 + s] = f2bf((r >= s) ? scale * d[j] * __expf(dr - ds) : 0.f); }
                }
            }
        }
        __syncthreads();
        const int w8 = __builtin_amdgcn_readfirstlane(tid >> 6);
        if (w8 < 4) {
            const int g2 = w8 >> 1, c = (w8 & 1) * 64 + lane; const int item2 = it0 + g2;
            LAS unsigned char* lg = lds0 + g2 * P5_GRP; LAS float* Mg = (LAS float*)(lg + P5_MM); LAS float* decg = (LAS float*)(lg + P5_DEC); LAS float* betg = (LAS float*)(lg + P5_BETA);
            f32x2 xy[64]; f32x4 mq[6]; f32x2 ab0, ab1;
            float* up = ub + (size_t)item2 * 8192 + c; bf16_t* wp = wdc + (size_t)item2 * 8192 + c;
            { const float br = betg[0]; ab0 = (f32x2){bf2f(*(const LAS bf16_t*)(lg + P5_VS + 0 + c * 2)) * br, bf2f(*(const LAS bf16_t*)(lg + P5_KS + 0 + c * 2)) * br * __expf(decg[0])}; ab1 = (f32x2){0.f, 0.f}; } xy[0] = ab0; up[0] = xy[0][0]; wp[0] = f2bf(-xy[0][1]);
            mq[0] = *(const LAS f32x4*)(Mg + 64); mq[1] = *(const LAS f32x4*)(Mg + 128); mq[2] = *(const LAS f32x4*)(Mg + 192); mq[3] = *(const LAS f32x4*)(Mg + 256); mq[4] = *(const LAS f32x4*)(Mg + 320); mq[5] = *(const LAS f32x4*)(Mg + 324);
            { const float br = betg[1]; ab0 = (f32x2){bf2f(*(const LAS bf16_t*)(lg + P5_VS + 272 + c * 2)) * br, bf2f(*(const LAS bf16_t*)(lg + P5_KS + 272 + c * 2)) * br * __expf(decg[1])}; ab1 = (f32x2){0.f, 0.f}; } ab0 -= mq[0][0] * xy[0]; xy[1] = ab0 + ab1; up[128] = xy[1][0]; wp[128] = f2bf(-xy[1][1]); mq[0] = *(const LAS f32x4*)(Mg + 384);
            { const float br = betg[2]; ab0 = (f32x2){bf2f(*(const LAS bf16_t*)(lg + P5_VS + 544 + c * 2)) * br, bf2f(*(const LAS bf16_t*)(lg + P5_KS + 544 + c * 2)) * br * __expf(decg[2])}; ab1 = (f32x2){0.f, 0.f}; } ab0 -= mq[1][0] * xy[0]; ab1 -= mq[1][1] * xy[1]; xy[2] = ab0 + ab1; up[256] = xy[2][0]; wp[256] = f2bf(-xy[2][1]); mq[1] = *(const LAS f32x4*)(Mg + 388);
            { const float br = betg[3]; ab0 = (f32x2){bf2f(*(const LAS bf16_t*)(lg + P5_VS + 816 + c * 2)) * br, bf2f(*(const LAS bf16_t*)(lg + P5_KS + 816 + c * 2)) * br * __expf(decg[3])}; ab1 = (f32x2){0.f, 0.f}; } ab0 -= mq[2][0] * xy[0]; ab1 -= mq[2][1] * xy[1]; ab0 -= mq[2][2] * xy[2]; xy[3] = ab0 + ab1; up[384] = xy[3][0]; wp[384] = f2bf(-xy[3][1]); mq[2] = *(const LAS f32x4*)(Mg + 448);
            { const float br = betg[4]; ab0 = (f32x2){bf2f(*(const LAS bf16_t*)(lg + P5_VS + 1088 + c * 2)) * br, bf2f(*(const LAS bf16_t*)(lg + P5_KS + 1088 + c * 2)) * br * __expf(decg[4])}; ab1 = (f32x2){0.f, 0.f}; } ab0 -= mq[3][0] * xy[0]; ab1 -= mq[3][1] * xy[1]; ab0 -= mq[3][2] * xy[2]; ab1 -= mq[3][3] * xy[3]; xy[4] = ab0 + ab1; up[512] = xy[4][0]; wp[512] = f2bf(-xy[4][1]); mq[3] = *(const LAS f32x4*)(Mg + 452);
            { const float br = betg[5]; ab0 = (f32x2){bf2f(*(const LAS bf16_t*)(lg + P5_VS + 1360 + c * 2)) * br, bf2f(*(const LAS bf16_t*)(lg + P5_KS + 1360 + c * 2)) * br * __expf(decg[5])}; ab1 = (f32x2){0.f, 0.f}; } ab0 -= mq[4][0] * xy[0]; ab1 -= mq[4][1] * xy[1]; ab0 -= mq[4][2] * xy[2]; ab1 -= mq[4][3] * xy[3]; mq[4] = *(const LAS f32x4*)(Mg + 512);
            ab0 -= mq[5][0] * xy[4]; xy[5] = ab0 + ab1; up[640] = xy[5][0]; wp[640] = f2bf(-xy[5][1]); mq[5] = *(const LAS f32x4*)(Mg + 516);
            { const float br = betg[6]; ab0 = (f32x2){bf2f(*(const LAS bf16_t*)(lg + P5_VS + 1632 + c * 2)) * br, bf2f(*(const LAS bf16_t*)(lg + P5_KS + 1632 + c * 2)) * br * __expf(decg[6])}; ab1 = (f32x2){0.f, 0.f}; } ab0 -= mq[0][0] * xy[0]; ab1 -= mq[0][1] * xy[1]; ab0 -= mq[0][2] * xy[2]; ab1 -= mq[0][3] * xy[3]; mq[0] = *(const LAS f32x4*)(Mg + 576);
            ab0 -= mq[1][0] * xy[4]; ab1 -= mq[1][1] * xy[5]; xy[6] = ab0 + ab1; up[768] = xy[6][0]; wp[768] = f2bf(-xy[6][1]); mq[1] = *(const LAS f32x4*)(Mg + 580);
            { const float br = betg[7]; ab0 = (f32x2){bf2f(*(const LAS bf16_t*)(lg + P5_VS + 1904 + c * 2)) * br, bf2f(*(const LAS bf16_t*)(lg + P5_KS + 1904 + c * 2)) * br * __expf(decg[7])}; ab1 = (f32x2){0.f, 0.f}; } ab0 -= mq[2][0] * xy[0]; ab1 -= mq[2][1] * xy[1]; ab0 -= mq[2][2] * xy[2]; ab1 -= mq[2][3] * xy[3]; mq[2] = *(const LAS f32x4*)(Mg + 584);
            ab0 -= mq[3][0] * xy[4]; ab1 -= mq[3][1] * xy[5]; ab0 -= mq[3][2] * xy[6]; xy[7] = ab0 + ab1; up[896] = xy[7][0]; wp[896] = f2bf(-xy[7][1]); mq[3] = *(const LAS f32x4*)(Mg + 640);
            { const float br = betg[8]; ab0 = (f32x2){bf2f(*(const LAS bf16_t*)(lg + P5_VS + 2176 + c * 2)) * br, bf2f(*(const LAS bf16_t*)(lg + P5_KS + 2176 + c * 2)) * br * __expf(decg[8])}; ab1 = (f32x2){0.f, 0.f}; } ab0 -= mq[4][0] * xy[0]; ab1 -= mq[4][1] * xy[1]; ab0 -= mq[4][2] * xy[2]; ab1 -= mq[4][3] * xy[3]; mq[4] = *(const LAS f32x4*)(Mg + 644);
            ab0 -= mq[5][0] * xy[4]; ab1 -= mq[5][1] * xy[5]; ab0 -= mq[5][2] * xy[6]; ab1 -= mq[5][3] * xy[7]; xy[8] = ab0 + ab1; up[1024] = xy[8][0]; wp[1024] = f2bf(-xy[8][1]); mq[5] = *(const LAS f32x4*)(Mg + 648);
            { const float br = betg[9]; ab0 = (f32x2){bf2f(*(const LAS bf16_t*)(lg + P5_VS + 2448 + c * 2)) * br, bf2f(*(const LAS bf16_t*)(lg + P5_KS + 2448 + c * 2)) * br * __expf(decg[9])}; ab1 = (f32x2){0.f, 0.f}; } ab0 -= mq[0][0] * xy[0]; ab1 -= mq[0][1] * xy[1]; ab0 -= mq[0][2] * xy[2]; ab1 -= mq[0][3] * xy[3]; mq[0] = *(const LAS f32x4*)(Mg + 704);
            ab0 -= mq[1][0] * xy[4]; ab1 -= mq[1][1] * xy[5]; ab0 -= mq[1][2] * xy[6]; ab1 -= mq[1][3] * xy[7]; mq[1] = *(const LAS f32x4*)(Mg + 708);
            ab0 -= mq[2][0] * xy[8]; xy[9] = ab0 + ab1; up[1152] = xy[9][0]; wp[1152] = f2bf(-xy[9][1]); mq[2] = *(const LAS f32x4*)(Mg + 712);
            { const float br = betg[10]; ab0 = (f32x2){bf2f(*(const LAS bf16_t*)(lg + P5_VS + 2720 + c * 2)) * br, bf2f(*(const LAS bf16_t*)(lg + P5_KS + 2720 + c * 2)) * br * __expf(decg[10])}; ab1 = (f32x2){0.f, 0.f}; } ab0 -= mq[3][0] * xy[0]; ab1 -= mq[3][1] * xy[1]; ab0 -= mq[3][2] * xy[2]; ab1 -= mq[3][3] * xy[3]; mq[3] = *(const LAS f32x4*)(Mg + 768);
            ab0 -= mq[4][0] * xy[4]; ab1 -= mq[4][1] * xy[5]; ab0 -= mq[4][2] * xy[6]; ab1 -= mq[4][3] * xy[7]; mq[4] = *(const LAS f32x4*)(Mg + 772);
            ab0 -= mq[5][0] * xy[8]; ab1 -= mq[5][1] * xy[9]; xy[10] = ab0 + ab1; up[1280] = xy[10][0]; wp[1280] = f2bf(-xy[10][1]); mq[5] = *(const LAS f32x4*)(Mg + 776);
            { const float br = betg[11]; ab0 = (f32x2){bf2f(*(const LAS bf16_t*)(lg + P5_VS + 2992 + c * 2)) * br, bf2f(*(const LAS bf16_t*)(lg + P5_KS + 2992 + c * 2)) * br * __expf(decg[11])}; ab1 = (f32x2){0.f, 0.f}; } ab0 -= mq[0][0] * xy[0]; ab1 -= mq[0][1] * xy[1]; ab0 -= mq[0][2] * xy[2]; ab1 -= mq[0][3] * xy[3]; mq[0] = *(const LAS f32x4*)(Mg + 832);
            ab0 -= mq[1][0] * xy[4]; ab1 -= mq[1][1] * xy[5]; ab0 -= mq[1][2] * xy[6]; ab1 -= mq[1][3] * xy[7]; mq[1] = *(const LAS f32x4*)(Mg + 836);
            ab0 -= mq[2][0] * xy[8]; ab1 -= mq[2][1] * xy[9]; ab0 -= mq[2][2] * xy[10]; xy[11] = ab0 + ab1; up[1408] = xy[11][0]; wp[1408] = f2bf(-xy[11][1]); mq[2] = *(const LAS f32x4*)(Mg + 840);
            { const float br = betg[12]; ab0 = (f32x2){bf2f(*(const LAS bf16_t*)(lg + P5_VS + 3264 + c * 2)) * br, bf2f(*(const LAS bf16_t*)(lg + P5_KS + 3264 + c * 2)) * br * __expf(decg[12])}; ab1 = (f32x2){0.f, 0.f}; } ab0 -= mq[3][0] * xy[0]; ab1 -= mq[3][1] * xy[1]; ab0 -= mq[3][2] * xy[2]; ab1 -= mq[3][3] * xy[3]; mq[3] = *(const LAS f32x4*)(Mg + 844);
            ab0 -= mq[4][0] * xy[4]; ab1 -= mq[4][1] * xy[5]; ab0 -= mq[4][2] * xy[6]; ab1 -= mq[4][3] * xy[7]; mq[4] = *(const LAS f32x4*)(Mg + 896);
            ab0 -= mq[5][0] * xy[8]; ab1 -= mq[5][1] * xy[9]; ab0 -= mq[5][2] * xy[10]; ab1 -= mq[5][3] * xy[11]; xy[12] = ab0 + ab1; up[1536] = xy[12][0]; wp[1536] = f2bf(-xy[12][1]); mq[5] = *(const LAS f32x4*)(Mg + 900);
            { const float br = betg[13]; ab0 = (f32x2){bf2f(*(const LAS bf16_t*)(lg + P5_VS + 3536 + c * 2)) * br, bf2f(*(const LAS bf16_t*)(lg + P5_KS + 3536 + c * 2)) * br * __expf(decg[13])}; ab1 = (f32x2){0.f, 0.f}; } ab0 -= mq[0][0] * xy[0]; ab1 -= mq[0][1] * xy[1]; ab0 -= mq[0][2] * xy[2]; ab1 -= mq[0][3] * xy[3]; mq[0] = *(const LAS f32x4*)(Mg + 904);
            ab0 -= mq[1][0] * xy[4]; ab1 -= mq[1][1] * xy[5]; ab0 -= mq[1][2] * xy[6]; ab1 -= mq[1][3] * xy[7]; mq[1] = *(const LAS f32x4*)(Mg + 908);
            ab0 -= mq[2][0] * xy[8]; ab1 -= mq[2][1] * xy[9]; ab0 -= mq[2][2] * xy[10]; ab1 -= mq[2][3] * xy[11]; mq[2] = *(const LAS f32x4*)(Mg + 960);
            ab0 -= mq[3][0] * xy[12]; xy[13] = ab0 + ab1; up[1664] = xy[13][0]; wp[1664] = f2bf(-xy[13][1]); mq[3] = *(const LAS f32x4*)(Mg + 964);
            { const float br = betg[14]; ab0 = (f32x2){bf2f(*(const LAS bf16_t*)(lg + P5_VS + 3808 + c * 2)) * br, bf2f(*(const LAS bf16_t*)(lg + P5_KS + 3808 + c * 2)) * br * __expf(decg[14])}; ab1 = (f32x2){0.f, 0.f}; } ab0 -= mq[4][0] * xy[0]; ab1 -= mq[4][1] * xy[1]; ab0 -= mq[4][2] * xy[2]; ab1 -= mq[4][3] * xy[3]; mq[4] = *(const LAS f32x4*)(Mg + 968);
            ab0 -= mq[5][0] * xy[4]; ab1 -= mq[5][1] * xy[5]; ab0 -= mq[5][2] * xy[6]; ab1 -= mq[5][3] * xy[7]; mq[5] = *(const LAS f32x4*)(Mg + 972);
            ab0 -= mq[0][0] * xy[8]; ab1 -= mq[0][1] * xy[9]; ab0 -= mq[0][2] * xy[10]; ab1 -= mq[0][3] * xy[11]; mq[0] = *(const LAS f32x4*)(Mg + 1024);
            ab0 -= mq[1][0] * xy[12]; ab1 -= mq[1][1] * xy[13]; xy[14] = ab0 + ab1; up[1792] = xy[14][0]; wp[1792] = f2bf(-xy[14][1]); mq[1] = *(const LAS f32x4*)(Mg + 1028);
            { const float br = betg[15]; ab0 = (f32x2){bf2f(*(const LAS bf16_t*)(lg + P5_VS + 4080 + c * 2)) * br, bf2f(*(const LAS bf16_t*)(lg + P5_KS + 4080 + c * 2)) * br * __expf(decg[15])}; ab1 = (f32x2){0.f, 0.f}; } ab0 -= mq[2][0] * xy[0]; ab1 -= mq[2][1] * xy[1]; ab0 -= mq[2][2] * xy[2]; ab1 -= mq[2][3] * xy[3]; mq[2] = *(const LAS f32x4*)(Mg + 1032);
            ab0 -= mq[3][0] * xy[4]; ab1 -= mq[3][1] * xy[5]; ab0 -= mq[3][2] * xy[6]; ab1 -= mq[3][3] * xy[7]; mq[3] = *(const LAS f32x4*)(Mg + 1036);
            ab0 -= mq[4][0] * xy[8]; ab1 -= mq[4][1] * xy[9]; ab0 -= mq[4][2] * xy[10]; ab1 -= mq[4][3] * xy[11]; mq[4] = *(const LAS f32x4*)(Mg + 1088);
            ab0 -= mq[5][0] * xy[12]; ab1 -= mq[5][1] * xy[13]; ab0 -= mq[5][2] * xy[14]; xy[15] = ab0 + ab1; up[1920] = xy[15][0]; wp[1920] = f2bf(-xy[15][1]); mq[5] = *(const LAS f32x4*)(Mg + 1092);
            { const float br = betg[16]; ab0 = (f32x2){bf2f(*(const LAS bf16_t*)(lg + P5_VS + 4352 + c * 2)) * br, bf2f(*(const LAS bf16_t*)(lg + P5_KS + 4352 + c * 2)) * br * __expf(decg[16])}; ab1 = (f32x2){0.f, 0.f}; } ab0 -= mq[0][0] * xy[0]; ab1 -= mq[0][1] * xy[1]; ab0 -= mq[0][2] * xy[2]; ab1 -= mq[0][3] * xy[3]; mq[0] = *(const LAS f32x4*)(Mg + 1096);
            ab0 -= mq[1][0] * xy[4]; ab1 -= mq[1][1] * xy[5]; ab0 -= mq[1][2] * xy[6]; ab1 -= mq[1][3] * xy[7]; mq[1] = *(const LAS f32x4*)(Mg + 1100);
            ab0 -= mq[2][0] * xy[8]; ab1 -= mq[2][1] * xy[9]; ab0 -= mq[2][2] * xy[10]; ab1 -= mq[2][3] * xy[11]; mq[2] = *(const LAS f32x4*)(Mg + 1104);
            ab0 -= mq[3][0] * xy[12]; ab1 -= mq[3][1] * xy[13]; ab0 -= mq[3][2] * xy[14]; ab1 -= mq[3][3] * xy[15]; xy[16] = ab0 + ab1; up[2048] = xy[16][0]; wp[2048] = f2bf(-xy[16][1]); mq[3] = *(const LAS f32x4*)(Mg + 1152);
            { const float br = betg[17]; ab0 = (f32x2){bf2f(*(const LAS bf16_t*)(lg + P5_VS + 4624 + c * 2)) * br, bf2f(*(const LAS bf16_t*)(lg + P5_KS + 4624 + c * 2)) * br * __expf(decg[17])}; ab1 = (f32x2){0.f, 0.f}; } ab0 -= mq[4][0] * xy[0]; ab1 -= mq[4][1] * xy[1]; ab0 -= mq[4][2] * xy[2]; ab1 -= mq[4][3] * xy[3]; mq[4] = *(const LAS f32x4*)(Mg + 1156);
            ab0 -= mq[5][0] * xy[4]; ab1 -= mq[5][1] * xy[5]; ab0 -= mq[5][2] * xy[6]; ab1 -= mq[5][3] * xy[7]; mq[5] = *(const LAS f32x4*)(Mg + 1160);
            ab0 -= mq[0][0] * xy[8]; ab1 -= mq[0][1] * xy[9]; ab0 -= mq[0][2] * xy[10]; ab1 -= mq[0][3] * xy[11]; mq[0] = *(const LAS f32x4*)(Mg + 1164);
            ab0 -= mq[1][0] * xy[12]; ab1 -= mq[1][1] * xy[13]; ab0 -= mq[1][2] * xy[14]; ab1 -= mq[1][3] * xy[15]; mq[1] = *(const LAS f32x4*)(Mg + 1168);
            ab0 -= mq[2][0] * xy[16]; xy[17] = ab0 + ab1; up[2176] = xy[17][0]; wp[2176] = f2bf(-xy[17][1]); mq[2] = *(const LAS f32x4*)(Mg + 1216);
            { const float br = betg[18]; ab0 = (f32x2){bf2f(*(const LAS bf16_t*)(lg + P5_VS + 4896 + c * 2)) * br, bf2f(*(const LAS bf16_t*)(lg + P5_KS + 4896 + c * 2)) * br * __expf(decg[18])}; ab1 = (f32x2){0.f, 0.f}; } ab0 -= mq[3][0] * xy[0]; ab1 -= mq[3][1] * xy[1]; ab0 -= mq[3][2] * xy[2]; ab1 -= mq[3][3] * xy[3]; mq[3] = *(const LAS f32x4*)(Mg + 1220);
            ab0 -= mq[4][0] * xy[4]; ab1 -= mq[4][1] * xy[5]; ab0 -= mq[4][2] * xy[6]; ab1 -= mq[4][3] * xy[7]; mq[4] = *(const LAS f32x4*)(Mg + 1224);
            ab0 -= mq[5][0] * xy[8]; ab1 -= mq[5][1] * xy[9]; ab0 -= mq[5][2] * xy[10]; ab1 -= mq[5][3] * xy[11]; mq[5] = *(const LAS f32x4*)(Mg + 1228);
            ab0 -= mq[0][0] * xy[12]; ab1 -= mq[0][1] * xy[13]; ab0 -= mq[0][2] * xy[14]; ab1 -= mq[0][3] * xy[15]; mq[0] = *(const LAS f32x4*)(Mg + 1232);
            ab0 -= mq[1][0] * xy[16]; ab1 -= mq[1][1] * xy[17]; xy[18] = ab0 + ab1; up[2304] = xy[18][0]; wp[2304] = f2bf(-xy[18][1]); mq[1] = *(const LAS f32x4*)(Mg + 1280);
            { const float br = betg[19]; ab0 = (f32x2){bf2f(*(const LAS bf16_t*)(lg + P5_VS + 5168 + c * 2)) * br, bf2f(*(const LAS bf16_t*)(lg + P5_KS + 5168 + c * 2)) * br * __expf(decg[19])}; ab1 = (f32x2){0.f, 0.f}; } ab0 -= mq[2][0] * xy[0]; ab1 -= mq[2][1] * xy[1]; ab0 -= mq[2][2] * xy[2]; ab1 -= mq[2][3] * xy[3]; mq[2] = *(const LAS f32x4*)(Mg + 1284);
            ab0 -= mq[3][0] * xy[4]; ab1 -= mq[3][1] * xy[5]; ab0 -= mq[3][2] * xy[6]; ab1 -= mq[3][3] * xy[7]; mq[3] = *(const LAS f32x4*)(Mg + 1288);
            ab0 -= mq[4][0] * xy[8]; ab1 -= mq[4][1] * xy[9]; ab0 -= mq[4][2] * xy[10]; ab1 -= mq[4][3] * xy[11]; mq[4] = *(const LAS f32x4*)(Mg + 1292);
            ab0 -= mq[5][0] * xy[12]; ab1 -= mq[5][1] * xy[13]; ab0 -= mq[5][2] * xy[14]; ab1 -= mq[5][3] * xy[15]; mq[5] = *(const LAS f32x4*)(Mg + 1296);
            ab0 -= mq[0][0] * xy[16]; ab1 -= mq[0][1] * xy[17]; ab0 -= mq[0][2] * xy[18]; xy[19] = ab0 + ab1; up[2432] = xy[19][0]; wp[2432] = f2bf(-xy[19][1]); mq[0] = *(const LAS f32x4*)(Mg + 1344);
            { const float br = betg[20]; ab0 = (f32x2){bf2f(*(const LAS bf16_t*)(lg + P5_VS + 5440 + c * 2)) * br, bf2f(*(const LAS bf16_t*)(lg + P5_KS + 5440 + c * 2)) * br * __expf(decg[20])}; ab1 = (f32x2){0.f, 0.f}; } ab0 -= mq[1][0] * xy[0]; ab1 -= mq[1][1] * xy[1]; ab0 -= mq[1][2] * xy[2]; ab1 -= mq[1][3] * xy[3]; mq[1] = *(const LAS f32x4*)(Mg + 1348);
            ab0 -= mq[2][0] * xy[4]; ab1 -= mq[2][1] * xy[5]; ab0 -= mq[2][2] * xy[6]; ab1 -= mq[2][3] * xy[7]; mq[2] = *(const LAS f32x4*)(Mg + 1352);
            ab0 -= mq[3][0] * xy[8]; ab1 -= mq[3][1] * xy[9]; ab0 -= mq[3][2] * xy[10]; ab1 -= mq[3][3] * xy[11]; mq[3] = *(const LAS f32x4*)(Mg + 1356);
            ab0 -= mq[4][0] * xy[12]; ab1 -= mq[4][1] * xy[13]; ab0 -= mq[4][2] * xy[14]; ab1 -= mq[4][3] * xy[15]; mq[4] = *(const LAS f32x4*)(Mg + 1360);
            ab0 -= mq[5][0] * xy[16]; ab1 -= mq[5][1] * xy[17]; ab0 -= mq[5][2] * xy[18]; ab1 -= mq[5][3] * xy[19]; xy[20] = ab0 + ab1; up[2560] = xy[20][0]; wp[2560] = f2bf(-xy[20][1]); mq[5] = *(const LAS f32x4*)(Mg + 1364);
            { const float br = betg[21]; ab0 = (f32x2){bf2f(*(const LAS bf16_t*)(lg + P5_VS + 5712 + c * 2)) * br, bf2f(*(const LAS bf16_t*)(lg + P5_KS + 5712 + c * 2)) * br * __expf(decg[21])}; ab1 = (f32x2){0.f, 0.f}; } ab0 -= mq[0][0] * xy[0]; ab1 -= mq[0][1] * xy[1]; ab0 -= mq[0][2] * xy[2]; ab1 -= mq[0][3] * xy[3]; mq[0] = *(const LAS f32x4*)(Mg + 1408);
            ab0 -= mq[1][0] * xy[4]; ab1 -= mq[1][1] * xy[5]; ab0 -= mq[1][2] * xy[6]; ab1 -= mq[1][3] * xy[7]; mq[1] = *(const LAS f32x4*)(Mg + 1412);
            ab0 -= mq[2][0] * xy[8]; ab1 -= mq[2][1] * xy[9]; ab0 -= mq[2][2] * xy[10]; ab1 -= mq[2][3] * xy[11]; mq[2] = *(const LAS f32x4*)(Mg + 1416);
            ab0 -= mq[3][0] * xy[12]; ab1 -= mq[3][1] * xy[13]; ab0 -= mq[3][2] * xy[14]; ab1 -= mq[3][3] * xy[15]; mq[3] = *(const LAS f32x4*)(Mg + 1420);
            ab0 -= mq[4][0] * xy[16]; ab1 -= mq[4][1] * xy[17]; ab0 -= mq[4][2] * xy[18]; ab1 -= mq[4][3] * xy[19]; mq[4] = *(const LAS f32x4*)(Mg + 1424);
            ab0 -= mq[5][0] * xy[20]; xy[21] = ab0 + ab1; up[2688] = xy[21][0]; wp[2688] = f2bf(-xy[21][1]); mq[5] = *(const LAS f32x4*)(Mg + 1428);
            { const float br = betg[22]; ab0 = (f32x2){bf2f(*(const LAS bf16_t*)(lg + P5_VS + 5984 + c * 2)) * br, bf2f(*(const LAS bf16_t*)(lg + P5_KS + 5984 + c * 2)) * br * __expf(decg[22])}; ab1 = (f32x2){0.f, 0.f}; } ab0 -= mq[0][0] * xy[0]; ab1 -= mq[0][1] * xy[1]; ab0 -= mq[0][2] * xy[2]; ab1 -= mq[0][3] * xy[3]; mq[0] = *(const LAS f32x4*)(Mg + 1472);
            ab0 -= mq[1][0] * xy[4]; ab1 -= mq[1][1] * xy[5]; ab0 -= mq[1][2] * xy[6]; ab1 -= mq[1][3] * xy[7]; mq[1] = *(const LAS f32x4*)(Mg + 1476);
            ab0 -= mq[2][0] * xy[8]; ab1 -= mq[2][1] * xy[9]; ab0 -= mq[2][2] * xy[10]; ab1 -= mq[2][3] * xy[11]; mq[2] = *(const LAS f32x4*)(Mg + 1480);
            ab0 -= mq[3][0] * xy[12]; ab1 -= mq[3][1] * xy[13]; ab0 -= mq[3][2] * xy[14]; ab1 -= mq[3][3] * xy[15]; mq[3] = *(const LAS f32x4*)(Mg + 1484);
            ab0 -= mq[4][0] * xy[16]; ab1 -= mq[4][1] * xy[17]; ab0 -= mq[4][2] * xy[18]; ab1 -= mq[4][3] * xy[19]; mq[4] = *(const LAS f32x4*)(Mg + 1488);
            ab0 -= mq[5][0] * xy[20]; ab1 -= mq[5][1] * xy[21]; xy[22] = ab0 + ab1; up[2816] = xy[22][0]; wp[2816] = f2bf(-xy[22][1]); mq[5] = *(const LAS f32x4*)(Mg + 1492);
            { const float br = betg[23]; ab0 = (f32x2){bf2f(*(const LAS bf16_t*)(lg + P5_VS + 6256 + c * 2)) * br, bf2f(*(const LAS bf16_t*)(lg + P5_KS + 6256 + c * 2)) * br * __expf(decg[23])}; ab1 = (f32x2){0.f, 0.f}; } ab0 -= mq[0][0] * xy[0]; ab1 -= mq[0][1] * xy[1]; ab0 -= mq[0][2] * xy[2]; ab1 -= mq[0][3] * xy[3]; mq[0] = *(const LAS f32x4*)(Mg + 1536);
            ab0 -= mq[1][0] * xy[4]; ab1 -= mq[1][1] * xy[5]; ab0 -= mq[1][2] * xy[6]; ab1 -= mq[1][3] * xy[7]; mq[1] = *(const LAS f32x4*)(Mg + 1540);
            ab0 -= mq[2][0] * xy[8]; ab1 -= mq[2][1] * xy[9]; ab0 -= mq[2][2] * xy[10]; ab1 -= mq[2][3] * xy[11]; mq[2] = *(const LAS f32x4*)(Mg + 1544);
            ab0 -= mq[3][0] * xy[12]; ab1 -= mq[3][1] * xy[13]; ab0 -= mq[3][2] * xy[14]; ab1 -= mq[3][3] * xy[15]; mq[3] = *(const LAS f32x4*)(Mg + 1548);
            ab0 -= mq[4][0] * xy[16]; ab1 -= mq[4][1] * xy[17]; ab0 -= mq[4][2] * xy[18]; ab1 -= mq[4][3] * xy[19]; mq[4] = *(const LAS f32x4*)(Mg + 1552);
            ab0 -= mq[5][0] * xy[20]; ab1 -= mq[5][1] * xy[21]; ab0 -= mq[5][2] * xy[22]; xy[23] = ab0 + ab1; up[2944] = xy[23][0]; wp[2944] = f2bf(-xy[23][1]); mq[5] = *(const LAS f32x4*)(Mg + 1556);
            { const float br = betg[24]; ab0 = (f32x2){bf2f(*(const LAS bf16_t*)(lg + P5_VS + 6528 + c * 2)) * br, bf2f(*(const LAS bf16_t*)(lg + P5_KS + 6528 + c * 2)) * br * __expf(decg[24])}; ab1 = (f32x2){0.f, 0.f}; } ab0 -= mq[0][0] * xy[0]; ab1 -= mq[0][1] * xy[1]; ab0 -= mq[0][2] * xy[2]; ab1 -= mq[0][3] * xy[3]; mq[0] = *(const LAS f32x4*)(Mg + 1600);
            ab0 -= mq[1][0] * xy[4]; ab1 -= mq[1][1] * xy[5]; ab0 -= mq[1][2] * xy[6]; ab1 -= mq[1][3] * xy[7]; mq[1] = *(const LAS f32x4*)(Mg + 1604);
            ab0 -= mq[2][0] * xy[8]; ab1 -= mq[2][1] * xy[9]; ab0 -= mq[2][2] * xy[10]; ab1 -= mq[2][3] * xy[11]; mq[2] = *(const LAS f32x4*)(Mg + 1608);
            ab0 -= mq[3][0] * xy[12]; ab1 -= mq[3][1] * xy[13]; ab0 -= mq[3][2] * xy[14]; ab1 -= mq[3][3] * xy[15]; mq[3] = *(const LAS f32x4*)(Mg + 1612);
            ab0 -= mq[4][0] * xy[16]; ab1 -= mq[4][1] * xy[17]; ab0 -= mq[4][2] * xy[18]; ab1 -= mq[4][3] * xy[19]; mq[4] = *(const LAS f32x4*)(Mg + 1616);
            ab0 -= mq[5][0] * xy[20]; ab1 -= mq[5][1] * xy[21]; ab0 -= mq[5][2] * xy[22]; ab1 -= mq[5][3] * xy[23]; xy[24] = ab0 + ab1; up[3072] = xy[24][0]; wp[3072] = f2bf(-xy[24][1]); mq[5] = *(const LAS f32x4*)(Mg + 1620);
            { const float br = betg[25]; ab0 = (f32x2){bf2f(*(const LAS bf16_t*)(lg + P5_VS + 6800 + c * 2)) * br, bf2f(*(const LAS bf16_t*)(lg + P5_KS + 6800 + c * 2)) * br * __expf(decg[25])}; ab1 = (f32x2){0.f, 0.f}; } ab0 -= mq[0][0] * xy[0]; ab1 -= mq[0][1] * xy[1]; ab0 -= mq[0][2] * xy[2]; ab1 -= mq[0][3] * xy[3]; mq[0] = *(const LAS f32x4*)(Mg + 1624);
            ab0 -= mq[1][0] * xy[4]; ab1 -= mq[1][1] * xy[5]; ab0 -= mq[1][2] * xy[6]; ab1 -= mq[1][3] * xy[7]; mq[1] = *(const LAS f32x4*)(Mg + 1664);
            ab0 -= mq[2][0] * xy[8]; ab1 -= mq[2][1] * xy[9]; ab0 -= mq[2][2] * xy[10]; ab1 -= mq[2][3] * xy[11]; mq[2] = *(const LAS f32x4*)(Mg + 1668);
            ab0 -= mq[3][0] * xy[12]; ab1 -= mq[3][1] * xy[13]; ab0 -= mq[3][2] * xy[14]; ab1 -= mq[3][3] * xy[15]; mq[3] = *(const LAS f32x4*)(Mg + 1672);
            ab0 -= mq[4][0] * xy[16]; ab1 -= mq[4][1] * xy[17]; ab0 -= mq[4][2] * xy[18]; ab1 -= mq[4][3] * xy[19]; mq[4] = *(const LAS f32x4*)(Mg + 1676);
            ab0 -= mq[5][0] * xy[20]; ab1 -= mq[5][1] * xy[21]; ab0 -= mq[5][2] * xy[22]; ab1 -= mq[5][3] * xy[23]; mq[5] = *(const LAS f32x4*)(Mg + 1680);
            ab0 -= mq[0][0] * xy[24]; xy[25] = ab0 + ab1; up[3200] = xy[25][0]; wp[3200] = f2bf(-xy[25][1]); mq[0] = *(const LAS f32x4*)(Mg + 1684);
            { const float br = betg[26]; ab0 = (f32x2){bf2f(*(const LAS bf16_t*)(lg + P5_VS + 7072 + c * 2)) * br, bf2f(*(const LAS bf16_t*)(lg + P5_KS + 7072 + c * 2)) * br * __expf(decg[26])}; ab1 = (f32x2){0.f, 0.f}; } ab0 -= mq[1][0] * xy[0]; ab1 -= mq[1][1] * xy[1]; ab0 -= mq[1][2] * xy[2]; ab1 -= mq[1][3] * xy[3]; mq[1] = *(const LAS f32x4*)(Mg + 1688);
            ab0 -= mq[2][0] * xy[4]; ab1 -= mq[2][1] * xy[5]; ab0 -= mq[2][2] * xy[6]; ab1 -= mq[2][3] * xy[7]; mq[2] = *(const LAS f32x4*)(Mg + 1728);
            ab0 -= mq[3][0] * xy[8]; ab1 -= mq[3][1] * xy[9]; ab0 -= mq[3][2] * xy[10]; ab1 -= mq[3][3] * xy[11]; mq[3] = *(const LAS f32x4*)(Mg + 1732);
            ab0 -= mq[4][0] * xy[12]; ab1 -= mq[4][1] * xy[13]; ab0 -= mq[4][2] * xy[14]; ab1 -= mq[4][3] * xy[15]; mq[4] = *(const LAS f32x4*)(Mg + 1736);
            ab0 -= mq[5][0] * xy[16]; ab1 -= mq[5][1] * xy[17]; ab0 -= mq[5][2] * xy[18]; ab1 -= mq[5][3] * xy[19]; mq[5] = *(const LAS f32x4*)(Mg + 1740);
            ab0 -= mq[0][0] * xy[20]; ab1 -= mq[0][1] * xy[21]; ab0 -= mq[0][2] * xy[22]; ab1 -= mq[0][3] * xy[23]; mq[0] = *(const LAS f32x4*)(Mg + 1744);
            ab0 -= mq[1][0] * xy[24]; ab1 -= mq[1][1] * xy[25]; xy[26] = ab0 + ab1; up[3328] = xy[26][0]; wp[3328] = f2bf(-xy[26][1]); mq[1] = *(const LAS f32x4*)(Mg + 1748);
            { const float br = betg[27]; ab0 = (f32x2){bf2f(*(const LAS bf16_t*)(lg + P5_VS + 7344 + c * 2)) * br, bf2f(*(const LAS bf16_t*)(lg + P5_KS + 7344 + c * 2)) * br * __expf(decg[27])}; ab1 = (f32x2){0.f, 0.f}; } ab0 -= mq[2][0] * xy[0]; ab1 -= mq[2][1] * xy[1]; ab0 -= mq[2][2] * xy[2]; ab1 -= mq[2][3] * xy[3]; mq[2] = *(const LAS f32x4*)(Mg + 1752);
            ab0 -= mq[3][0] * xy[4]; ab1 -= mq[3][1] * xy[5]; ab0 -= mq[3][2] * xy[6]; ab1 -= mq[3][3] * xy[7]; mq[3] = *(const LAS f32x4*)(Mg + 1792);
            ab0 -= mq[4][0] * xy[8]; ab1 -= mq[4][1] * xy[9]; ab0 -= mq[4][2] * xy[10]; ab1 -= mq[4][3] * xy[11]; mq[4] = *(const LAS f32x4*)(Mg + 1796);
            ab0 -= mq[5][0] * xy[12]; ab1 -= mq[5][1] * xy[13]; ab0 -= mq[5][2] * xy[14]; ab1 -= mq[5][3] * xy[15]; mq[5] = *(const LAS f32x4*)(Mg + 1800);
            ab0 -= mq[0][0] * xy[16]; ab1 -= mq[0][1] * xy[17]; ab0 -= mq[0][2] * xy[18]; ab1 -= mq[0][3] * xy[19]; mq[0] = *(const LAS f32x4*)(Mg + 1804);
            ab0 -= mq[1][0] * xy[20]; ab1 -= mq[1][1] * xy[21]; ab0 -= mq[1][2] * xy[22]; ab1 -= mq[1][3] * xy[23]; mq[1] = *(const LAS f32x4*)(Mg + 1808);
            ab0 -= mq[2][0] * xy[24]; ab1 -= mq[2][1] * xy[25]; ab0 -= mq[2][2] * xy[26]; xy[27] = ab0 + ab1; up[3456] = xy[27][0]; wp[3456] = f2bf(-xy[27][1]); mq[2] = *(const LAS f32x4*)(Mg + 1812);
            { const float br = betg[28]; ab0 = (f32x2){bf2f(*(const LAS bf16_t*)(lg + P5_VS + 7616 + c * 2)) * br, bf2f(*(const LAS bf16_t*)(lg + P5_KS + 7616 + c * 2)) * br * __expf(decg[28])}; ab1 = (f32x2){0.f, 0.f}; } ab0 -= mq[3][0] * xy[0]; ab1 -= mq[3][1] * xy[1]; ab0 -= mq[3][2] * xy[2]; ab1 -= mq[3][3] * xy[3]; mq[3] = *(const LAS f32x4*)(Mg + 1816);
            ab0 -= mq[4][0] * xy[4]; ab1 -= mq[4][1] * xy[5]; ab0 -= mq[4][2] * xy[6]; ab1 -= mq[4][3] * xy[7]; mq[4] = *(const LAS f32x4*)(Mg + 1856);
            ab0 -= mq[5][0] * xy[8]; ab1 -= mq[5][1] * xy[9]; ab0 -= mq[5][2] * xy[10]; ab1 -= mq[5][3] * xy[11]; mq[5] = *(const LAS f32x4*)(Mg + 1860);
            ab0 -= mq[0][0] * xy[12]; ab1 -= mq[0][1] * xy[13]; ab0 -= mq[0][2] * xy[14]; ab1 -= mq[0][3] * xy[15]; mq[0] = *(const LAS f32x4*)(Mg + 1864);
            ab0 -= mq[1][0] * xy[16]; ab1 -= mq[1][1] * xy[17]; ab0 -= mq[1][2] * xy[18]; ab1 -= mq[1][3] * xy[19]; mq[1] = *(const LAS f32x4*)(Mg + 1868);
            ab0 -= mq[2][0] * xy[20]; ab1 -= mq[2][1] * xy[21]; ab0 -= mq[2][2] * xy[22]; ab1 -= mq[2][3] * xy[23]; mq[2] = *(const LAS f32x4*)(Mg + 1872);
            ab0 -= mq[3][0] * xy[24]; ab1 -= mq[3][1] * xy[25]; ab0 -= mq[3][2] * xy[26]; ab1 -= mq[3][3] * xy[27]; xy[28] = ab0 + ab1; up[3584] = xy[28][0]; wp[3584] = f2bf(-xy[28][1]); mq[3] = *(const LAS f32x4*)(Mg + 1876);
            { const float br = betg[29]; ab0 = (f32x2){bf2f(*(const LAS bf16_t*)(lg + P5_VS + 7888 + c * 2)) * br, bf2f(*(const LAS bf16_t*)(lg + P5_KS + 7888 + c * 2)) * br * __expf(decg[29])}; ab1 = (f32x2){0.f, 0.f}; } ab0 -= mq[4][0] * xy[0]; ab1 -= mq[4][1] * xy[1]; ab0 -= mq[4][2] * xy[2]; ab1 -= mq[4][3] * xy[3]; mq[4] = *(const LAS f32x4*)(Mg + 1880);
            ab0 -= mq[5][0] * xy[4]; ab1 -= mq[5][1] * xy[5]; ab0 -= mq[5][2] * xy[6]; ab1 -= mq[5][3] * xy[7]; mq[5] = *(const LAS f32x4*)(Mg + 1884);
            ab0 -= mq[0][0] * xy[8]; ab1 -= mq[0][1] * xy[9]; ab0 -= mq[0][2] * xy[10]; ab1 -= mq[0][3] * xy[11]; mq[0] = *(const LAS f32x4*)(Mg + 1920);
            ab0 -= mq[1][0] * xy[12]; ab1 -= mq[1][1] * xy[13]; ab0 -= mq[1][2] * xy[14]; ab1 -= mq[1][3] * xy[15]; mq[1] = *(const LAS f32x4*)(Mg + 1924);
            ab0 -= mq[2][0] * xy[16]; ab1 -= mq[2][1] * xy[17]; ab0 -= mq[2][2] * xy[18]; ab1 -= mq[2][3] * xy[19]; mq[2] = *(const LAS f32x4*)(Mg + 1928);
            ab0 -= mq[3][0] * xy[20]; ab1 -= mq[3][1] * xy[21]; ab0 -= mq[3][2] * xy[22]; ab1 -= mq[3][3] * xy[23]; mq[3] = *(const LAS f32x4*)(Mg + 1932);
            ab0 -= mq[4][0] * xy[24]; ab1 -= mq[4][1] * xy[25]; ab0 -= mq[4][2] * xy[26]; ab1 -= mq[4][3] * xy[27]; mq[4] = *(const LAS f32x4*)(Mg + 1936);
            ab0 -= mq[5][0] * xy[28]; xy[29] = ab0 + ab1; up[3712] = xy[29][0]; wp[3712] = f2bf(-xy[29][1]); mq[5] = *(const LAS f32x4*)(Mg + 1940);
            { const float br = betg[30]; ab0 = (f32x2){bf2f(*(const LAS bf16_t*)(lg + P5_VS + 8160 + c * 2)) * br, bf2f(*(const LAS bf16_t*)(lg + P5_KS + 8160 + c * 2)) * br * __expf(decg[30])}; ab1 = (f32x2){0.f, 0.f}; } ab0 -= mq[0][0] * xy[0]; ab1 -= mq[0][1] * xy[1]; ab0 -= mq[0][2] * xy[2]; ab1 -= mq[0][3] * xy[3]; mq[0] = *(const LAS f32x4*)(Mg + 1944);
            ab0 -= mq[1][0] * xy[4]; ab1 -= mq[1][1] * xy[5]; ab0 -= mq[1][2] * xy[6]; ab1 -= mq[1][3] * xy[7]; mq[1] = *(const LAS f32x4*)(Mg + 1948);
            ab0 -= mq[2][0] * xy[8]; ab1 -= mq[2][1] * xy[9]; ab0 -= mq[2][2] * xy[10]; ab1 -= mq[2][3] * xy[11]; mq[2] = *(const LAS f32x4*)(Mg + 1984);
            ab0 -= mq[3][0] * xy[12]; ab1 -= mq[3][1] * xy[13]; ab0 -= mq[3][2] * xy[14]; ab1 -= mq[3][3] * xy[15]; mq[3] = *(const LAS f32x4*)(Mg + 1988);
            ab0 -= mq[4][0] * xy[16]; ab1 -= mq[4][1] * xy[17]; ab0 -= mq[4][2] * xy[18]; ab1 -= mq[4][3] * xy[19]; mq[4] = *(const LAS f32x4*)(Mg + 1992);
            ab0 -= mq[5][0] * xy[20]; ab1 -= mq[5][1] * xy[21]; ab0 -= mq[5][2] * xy[22]; ab1 -= mq[5][3] * xy[23]; mq[5] = *(const LAS f32x4*)(Mg + 1996);
            ab0 -= mq[0][0] * xy[24]; ab1 -= mq[0][1] * xy[25]; ab0 -= mq[0][2] * xy[26]; ab1 -= mq[0][3] * xy[27]; mq[0] = *(const LAS f32x4*)(Mg + 2000);
            ab0 -= mq[1][0] * xy[28]; ab1 -= mq[1][1] * xy[29]; xy[30] = ab0 + ab1; up[3840] = xy[30][0]; wp[3840] = f2bf(-xy[30][1]); mq[1] = *(const LAS f32x4*)(Mg + 2004);
            { const float br = betg[31]; ab0 = (f32x2){bf2f(*(const LAS bf16_t*)(lg + P5_VS + 8432 + c * 2)) * br, bf2f(*(const LAS bf16_t*)(lg + P5_KS + 8432 + c * 2)) * br * __expf(decg[31])}; ab1 = (f32x2){0.f, 0.f}; } ab0 -= mq[2][0] * xy[0]; ab1 -= mq[2][1] * xy[1]; ab0 -= mq[2][2] * xy[2]; ab1 -= mq[2][3] * xy[3]; mq[2] = *(const LAS f32x4*)(Mg + 2008);
            ab0 -= mq[3][0] * xy[4]; ab1 -= mq[3][1] * xy[5]; ab0 -= mq[3][2] * xy[6]; ab1 -= mq[3][3] * xy[7]; mq[3] = *(const LAS f32x4*)(Mg + 2012);
            ab0 -= mq[4][0] * xy[8]; ab1 -= mq[4][1] * xy[9]; ab0 -= mq[4][2] * xy[10]; ab1 -= mq[4][3] * xy[11]; mq[4] = *(const LAS f32x4*)(Mg + 2048);
            ab0 -= mq[5][0] * xy[12]; ab1 -= mq[5][1] * xy[13]; ab0 -= mq[5][2] * xy[14]; ab1 -= mq[5][3] * xy[15]; mq[5] = *(const LAS f32x4*)(Mg + 2052);
            ab0 -= mq[0][0] * xy[16]; ab1 -= mq[0][1] * xy[17]; ab0 -= mq[0][2] * xy[18]; ab1 -= mq[0][3] * xy[19]; mq[0] = *(const LAS f32x4*)(Mg + 2056);
            ab0 -= mq[1][0] * xy[20]; ab1 -= mq[1][1] * xy[21]; ab0 -= mq[1][2] * xy[22]; ab1 -= mq[1][3] * xy[23]; mq[1] = *(const LAS f32x4*)(Mg + 2060);
            ab0 -= mq[2][0] * xy[24]; ab1 -= mq[2][1] * xy[25]; ab0 -= mq[2][2] * xy[26]; ab1 -= mq[2][3] * xy[27]; mq[2] = *(const LAS f32x4*)(Mg + 2064);
            ab0 -= mq[3][0] * xy[28]; ab1 -= mq[3][1] * xy[29]; ab0 -= mq[3][2] * xy[30]; xy[31] = ab0 + ab1; up[3968] = xy[31][0]; wp[3968] = f2bf(-xy[31][1]); mq[3] = *(const LAS f32x4*)(Mg + 2068);
            { const float br = betg[32]; ab0 = (f32x2){bf2f(*(const LAS bf16_t*)(lg + P5_VS + 8704 + c * 2)) * br, bf2f(*(const LAS bf16_t*)(lg + P5_KS + 8704 + c * 2)) * br * __expf(decg[32])}; ab1 = (f32x2){0.f, 0.f}; } ab0 -= mq[4][0] * xy[0]; ab1 -= mq[4][1] * xy[1]; ab0 -= mq[4][2] * xy[2]; ab1 -= mq[4][3] * xy[3]; mq[4] = *(const LAS f32x4*)(Mg + 2072);
            ab0 -= mq[5][0] * xy[4]; ab1 -= mq[5][1] * xy[5]; ab0 -= mq[5][2] * xy[6]; ab1 -= mq[5][3] * xy[7]; mq[5] = *(const LAS f32x4*)(Mg + 2076);
            ab0 -= mq[0][0] * xy[8]; ab1 -= mq[0][1] * xy[9]; ab0 -= mq[0][2] * xy[10]; ab1 -= mq[0][3] * xy[11]; mq[0] = *(const LAS f32x4*)(Mg + 2112);
            ab0 -= mq[1][0] * xy[12]; ab1 -= mq[1][1] * xy[13]; ab0 -= mq[1][2] * xy[14]; ab1 -= mq[1][3] * xy[15]; mq[1] = *(const LAS f32x4*)(Mg + 2116);
            ab0 -= mq[2][0] * xy[16]; ab1 -= mq[2][1] * xy[17]; ab0 -= mq[2][2] * xy[18]; ab1 -= mq[2][3] * xy[19]; mq[2] = *(const LAS f32x4*)(Mg + 2120);
            ab0 -= mq[3][0] * xy[20]; ab1 -= mq[3][1] * xy[21]; ab0 -= mq[3][2] * xy[22]; ab1 -= mq[3][3] * xy[23]; mq[3] = *(const LAS f32x4*)(Mg + 2124);
            ab0 -= mq[4][0] * xy[24]; ab1 -= mq[4][1] * xy[25]; ab0 -= mq[4][2] * xy[26]; ab1 -= mq[4][3] * xy[27]; mq[4] = *(const LAS f32x4*)(Mg + 2128);
            ab0 -= mq[5][0] * xy[28]; ab1 -= mq[5][1] * xy[29]; ab0 -= mq[5][2] * xy[30]; ab1 -= mq[5][3] * xy[31]; xy[32] = ab0 + ab1; up[4096] = xy[32][0]; wp[4096] = f2bf(-xy[32][1]); mq[5] = *(const LAS f32x4*)(Mg + 2132);
            { const float br = betg[33]; ab0 = (f32x2){bf2f(*(const LAS bf16_t*)(lg + P5_VS + 8976 + c * 2)) * br, bf2f(*(const LAS bf16_t*)(lg + P5_KS + 8976 + c * 2)) * br * __expf(decg[33])}; ab1 = (f32x2){0.f, 0.f}; } ab0 -= mq[0][0] * xy[0]; ab1 -= mq[0][1] * xy[1]; ab0 -= mq[0][2] * xy[2]; ab1 -= mq[0][3] * xy[3]; mq[0] = *(const LAS f32x4*)(Mg + 2136);
            ab0 -= mq[1][0] * xy[4]; ab1 -= mq[1][1] * xy[5]; ab0 -= mq[1][2] * xy[6]; ab1 -= mq[1][3] * xy[7]; mq[1] = *(const LAS f32x4*)(Mg + 2140);
            ab0 -= mq[2][0] * xy[8]; ab1 -= mq[2][1] * xy[9]; ab0 -= mq[2][2] * xy[10]; ab1 -= mq[2][3] * xy[11]; mq[2] = *(const LAS f32x4*)(Mg + 2144);
            ab0 -= mq[3][0] * xy[12]; ab1 -= mq[3][1] * xy[13]; ab0 -= mq[3][2] * xy[14]; ab1 -= mq[3][3] * xy[15]; mq[3] = *(const LAS f32x4*)(Mg + 2176);
            ab0 -= mq[4][0] * xy[16]; ab1 -= mq[4][1] * xy[17]; ab0 -= mq[4][2] * xy[18]; ab1 -= mq[4][3] * xy[19]; mq[4] = *(const LAS f32x4*)(Mg + 2180);
            ab0 -= mq[5][0] * xy[20]; ab1 -= mq[5][1] * xy[21]; ab0 -= mq[5][2] * xy[22]; ab1 -= mq[5][3] * xy[23]; mq[5] = *(const LAS f32x4*)(Mg + 2184);
            ab0 -= mq[0][0] * xy[24]; ab1 -= mq[0][1] * xy[25]; ab0 -= mq[0][2] * xy[26]; ab1 -= mq[0][3] * xy[27]; mq[0] = *(const LAS f32x4*)(Mg + 2188);
            ab0 -= mq[1][0] * xy[28]; ab1 -= mq[1][1] * xy[29]; ab0 -= mq[1][2] * xy[30]; ab1 -= mq[1][3] * xy[31]; mq[1] = *(const LAS f32x4*)(Mg + 2192);
            ab0 -= mq[2][0] * xy[32]; xy[33] = ab0 + ab1; up[4224] = xy[33][0]; wp[4224] = f2bf(-xy[33][1]); mq[2] = *(const LAS f32x4*)(Mg + 2196);
            { const float br = betg[34]; ab0 = (f32x2){bf2f(*(const LAS bf16_t*)(lg + P5_VS + 9248 + c * 2)) * br, bf2f(*(const LAS bf16_t*)(lg + P5_KS + 9248 + c * 2)) * br * __expf(decg[34])}; ab1 = (f32x2){0.f, 0.f}; } ab0 -= mq[3][0] * xy[0]; ab1 -= mq[3][1] * xy[1]; ab0 -= mq[3][2] * xy[2]; ab1 -= mq[3][3] * xy[3]; mq[3] = *(const LAS f32x4*)(Mg + 2200);
            ab0 -= mq[4][0] * xy[4]; ab1 -= mq[4][1] * xy[5]; ab0 -= mq[4][2] * xy[6]; ab1 -= mq[4][3] * xy[7]; mq[4] = *(const LAS f32x4*)(Mg + 2204);
            ab0 -= mq[5][0] * xy[8]; ab1 -= mq[5][1] * xy[9]; ab0 -= mq[5][2] * xy[10]; ab1 -= mq[5][3] * xy[11]; mq[5] = *(const LAS f32x4*)(Mg + 2208);
            ab0 -= mq[0][0] * xy[12]; ab1 -= mq[0][1] * xy[13]; ab0 -= mq[0][2] * xy[14]; ab1 -= mq[0][3] * xy[15]; mq[0] = *(const LAS f32x4*)(Mg + 2240);
            ab0 -= mq[1][0] * xy[16]; ab1 -= mq[1][1] * xy[17]; ab0 -= mq[1][2] * xy[18]; ab1 -= mq[1][3] * xy[19]; mq[1] = *(const LAS f32x4*)(Mg + 2244);
            ab0 -= mq[2][0] * xy[20]; ab1 -= mq[2][1] * xy[21]; ab0 -= mq[2][2] * xy[22]; ab1 -= mq[2][3] * xy[23]; mq[2] = *(const LAS f32x4*)(Mg + 2248);
            ab0 -= mq[3][0] * xy[24]; ab1 -= mq[3][1] * xy[25]; ab0 -= mq[3][2] * xy[26]; ab1 -= mq[3][3] * xy[27]; mq[3] = *(const LAS f32x4*)(Mg + 2252);
            ab0 -= mq[4][0] * xy[28]; ab1 -= mq[4][1] * xy[29]; ab0 -= mq[4][2] * xy[30]; ab1 -= mq[4][3] * xy[31]; mq[4] = *(const LAS f32x4*)(Mg + 2256);
            ab0 -= mq[5][0] * xy[32]; ab1 -= mq[5][1] * xy[33]; xy[34] = ab0 + ab1; up[4352] = xy[34][0]; wp[4352] = f2bf(-xy[34][1]); mq[5] = *(const LAS f32x4*)(Mg + 2260);
            { const float br = betg[35]; ab0 = (f32x2){bf2f(*(const LAS bf16_t*)(lg + P5_VS + 9520 + c * 2)) * br, bf2f(*(const LAS bf16_t*)(lg + P5_KS + 9520 + c * 2)) * br * __expf(decg[35])}; ab1 = (f32x2){0.f, 0.f}; } ab0 -= mq[0][0] * xy[0]; ab1 -= mq[0][1] * xy[1]; ab0 -= mq[0][2] * xy[2]; ab1 -= mq[0][3] * xy[3]; mq[0] = *(const LAS f32x4*)(Mg + 2264);
            ab0 -= mq[1][0] * xy[4]; ab1 -= mq[1][1] * xy[5]; ab0 -= mq[1][2] * xy[6]; ab1 -= mq[1][3] * xy[7]; mq[1] = *(const LAS f32x4*)(Mg + 2268);
            ab0 -= mq[2][0] * xy[8]; ab1 -= mq[2][1] * xy[9]; ab0 -= mq[2][2] * xy[10]; ab1 -= mq[2][3] * xy[11]; mq[2] = *(const LAS f32x4*)(Mg + 2272);
            ab0 -= mq[3][0] * xy[12]; ab1 -= mq[3][1] * xy[13]; ab0 -= mq[3][2] * xy[14]; ab1 -= mq[3][3] * xy[15]; mq[3] = *(const LAS f32x4*)(Mg + 2304);
            ab0 -= mq[4][0] * xy[16]; ab1 -= mq[4][1] * xy[17]; ab0 -= mq[4][2] * xy[18]; ab1 -= mq[4][3] * xy[19]; mq[4] = *(const LAS f32x4*)(Mg + 2308);
            ab0 -= mq[5][0] * xy[20]; ab1 -= mq[5][1] * xy[21]; ab0 -= mq[5][2] * xy[22]; ab1 -= mq[5][3] * xy[23]; mq[5] = *(const LAS f32x4*)(Mg + 2312);
            ab0 -= mq[0][0] * xy[24]; ab1 -= mq[0][1] * xy[25]; ab0 -= mq[0][2] * xy[26]; ab1 -= mq[0][3] * xy[27]; mq[0] = *(const LAS f32x4*)(Mg + 2316);
            ab0 -= mq[1][0] * xy[28]; ab1 -= mq[1][1] * xy[29]; ab0 -= mq[1][2] * xy[30]; ab1 -= mq[1][3] * xy[31]; mq[1] = *(const LAS f32x4*)(Mg + 2320);
            ab0 -= mq[2][0] * xy[32]; ab1 -= mq[2][1] * xy[33]; ab0 -= mq[2][2] * xy[34]; xy[35] = ab0 + ab1; up[4480] = xy[35][0]; wp[4480] = f2bf(-xy[35][1]); mq[2] = *(const LAS f32x4*)(Mg + 2324);
            { const float br = betg[36]; ab0 = (f32x2){bf2f(*(const LAS bf16_t*)(lg + P5_VS + 9792 + c * 2)) * br, bf2f(*(const LAS bf16_t*)(lg + P5_KS + 9792 + c * 2)) * br * __expf(decg[36])}; ab1 = (f32x2){0.f, 0.f}; } ab0 -= mq[3][0] * xy[0]; ab1 -= mq[3][1] * xy[1]; ab0 -= mq[3][2] * xy[2]; ab1 -= mq[3][3] * xy[3]; mq[3] = *(const LAS f32x4*)(Mg + 2328);
            ab0 -= mq[4][0] * xy[4]; ab1 -= mq[4][1] * xy[5]; ab0 -= mq[4][2] * xy[6]; ab1 -= mq[4][3] * xy[7]; mq[4] = *(const LAS f32x4*)(Mg + 2332);
            ab0 -= mq[5][0] * xy[8]; ab1 -= mq[5][1] * xy[9]; ab0 -= mq[5][2] * xy[10]; ab1 -= mq[5][3] * xy[11]; mq[5] = *(const LAS f32x4*)(Mg + 2336);
            ab0 -= mq[0][0] * xy[12]; ab1 -= mq[0][1] * xy[13]; ab0 -= mq[0][2] * xy[14]; ab1 -= mq[0][3] * xy[15]; mq[0] = *(const LAS f32x4*)(Mg + 2368);
            ab0 -= mq[1][0] * xy[16]; ab1 -= mq[1][1] * xy[17]; ab0 -= mq[1][2] * xy[18]; ab1 -= mq[1][3] * xy[19]; mq[1] = *(const LAS f32x4*)(Mg + 2372);
            ab0 -= mq[2][0] * xy[20]; ab1 -= mq[2][1] * xy[21]; ab0 -= mq[2][2] * xy[22]; ab1 -= mq[2][3] * xy[23]; mq[2] = *(const LAS f32x4*)(Mg + 2376);
            ab0 -= mq[3][0] * xy[24]; ab1 -= mq[3][1] * xy[25]; ab0 -= mq[3][2] * xy[26]; ab1 -= mq[3][3] * xy[27]; mq[3] = *(const LAS f32x4*)(Mg + 2380);
            ab0 -= mq[4][0] * xy[28]; ab1 -= mq[4][1] * xy[29]; ab0 -= mq[4][2] * xy[30]; ab1 -= mq[4][3] * xy[31]; mq[4] = *(const LAS f32x4*)(Mg + 2384);
            ab0 -= mq[5][0] * xy[32]; ab1 -= mq[5][1] * xy[33]; ab0 -= mq[5][2] * xy[34]; ab1 -= mq[5][3] * xy[35]; xy[36] = ab0 + ab1; up[4608] = xy[36][0]; wp[4608] = f2bf(-xy[36][1]); mq[5] = *(const LAS f32x4*)(Mg + 2388);
            { const float br = betg[37]; ab0 = (f32x2){bf2f(*(const LAS bf16_t*)(lg + P5_VS + 10064 + c * 2)) * br, bf2f(*(const LAS bf16_t*)(lg + P5_KS + 10064 + c * 2)) * br * __expf(decg[37])}; ab1 = (f32x2){0.f, 0.f}; } ab0 -= mq[0][0] * xy[0]; ab1 -= mq[0][1] * xy[1]; ab0 -= mq[0][2] * xy[2]; ab1 -= mq[0][3] * xy[3]; mq[0] = *(const LAS f32x4*)(Mg + 2392);
            ab0 -= mq[1][0] * xy[4]; ab1 -= mq[1][1] * xy[5]; ab0 -= mq[1][2] * xy[6]; ab1 -= mq[1][3] * xy[7]; mq[1] = *(const LAS f32x4*)(Mg + 2396);
            ab0 -= mq[2][0] * xy[8]; ab1 -= mq[2][1] * xy[9]; ab0 -= mq[2][2] * xy[10]; ab1 -= mq[2][3] * xy[11]; mq[2] = *(const LAS f32x4*)(Mg + 2400);
            ab0 -= mq[3][0] * xy[12]; ab1 -= mq[3][1] * xy[13]; ab0 -= mq[3][2] * xy[14]; ab1 -= mq[3][3] * xy[15]; mq[3] = *(const LAS f32x4*)(Mg + 2404);
            ab0 -= mq[4][0] * xy[16]; ab1 -= mq[4][1] * xy[17]; ab0 -= mq[4][2] * xy[18]; ab1 -= mq[4][3] * xy[19]; mq[4] = *(const LAS f32x4*)(Mg + 2432);
            ab0 -= mq[5][0] * xy[20]; ab1 -= mq[5][1] * xy[21]; ab0 -= mq[5][2] * xy[22]; ab1 -= mq[5][3] * xy[23]; mq[5] = *(const LAS f32x4*)(Mg + 2436);
            ab0 -= mq[0][0] * xy[24]; ab1 -= mq[0][1] * xy[25]; ab0 -= mq[0][2] * xy[26]; ab1 -= mq[0][3] * xy[27]; mq[0] = *(const LAS f32x4*)(Mg + 2440);
            ab0 -= mq[1][0] * xy[28]; ab1 -= mq[1][1] * xy[29]; ab0 -= mq[1][2] * xy[30]; ab1 -= mq[1][3] * xy[31]; mq[1] = *(const LAS f32x4*)(Mg + 2444);
            ab0 -= mq[2][0] * xy[32]; ab1 -= mq[2][1] * xy[33]; ab0 -= mq[2][2] * xy[34]; ab1 -= mq[2][3] * xy[35]; mq[2] = *(const LAS f32x4*)(Mg + 2448);
            ab0 -= mq[3][0] * xy[36]; xy[37] = ab0 + ab1; up[4736] = xy[37][0]; wp[4736] = f2bf(-xy[37][1]); mq[3] = *(const LAS f32x4*)(Mg + 2452);
            { const float br = betg[38]; ab0 = (f32x2){bf2f(*(const LAS bf16_t*)(lg + P5_VS + 10336 + c * 2)) * br, bf2f(*(const LAS bf16_t*)(lg + P5_KS + 10336 + c * 2)) * br * __expf(decg[38])}; ab1 = (f32x2){0.f, 0.f}; } ab0 -= mq[4][0] * xy[0]; ab1 -= mq[4][1] * xy[1]; ab0 -= mq[4][2] * xy[2]; ab1 -= mq[4][3] * xy[3]; mq[4] = *(const LAS f32x4*)(Mg + 2456);
            ab0 -= mq[5][0] * xy[4]; ab1 -= mq[5][1] * xy[5]; ab0 -= mq[5][2] * xy[6]; ab1 -= mq[5][3] * xy[7]; mq[5] = *(const LAS f32x4*)(Mg + 2460);
            ab0 -= mq[0][0] * xy[8]; ab1 -= mq[0][1] * xy[9]; ab0 -= mq[0][2] * xy[10]; ab1 -= mq[0][3] * xy[11]; mq[0] = *(const LAS f32x4*)(Mg + 2464);
            ab0 -= mq[1][0] * xy[12]; ab1 -= mq[1][1] * xy[13]; ab0 -= mq[1][2] * xy[14]; ab1 -= mq[1][3] * xy[15]; mq[1] = *(const LAS f32x4*)(Mg + 2468);
            ab0 -= mq[2][0] * xy[16]; ab1 -= mq[2][1] * xy[17]; ab0 -= mq[2][2] * xy[18]; ab1 -= mq[2][3] * xy[19]; mq[2] = *(const LAS f32x4*)(Mg + 2496);
            ab0 -= mq[3][0] * xy[20]; ab1 -= mq[3][1] * xy[21]; ab0 -= mq[3][2] * xy[22]; ab1 -= mq[3][3] * xy[23]; mq[3] = *(const LAS f32x4*)(Mg + 2500);
            ab0 -= mq[4][0] * xy[24]; ab1 -= mq[4][1] * xy[25]; ab0 -= mq[4][2] * xy[26]; ab1 -= mq[4][3] * xy[27]; mq[4] = *(const LAS f32x4*)(Mg + 2504);
            ab0 -= mq[5][0] * xy[28]; ab1 -= mq[5][1] * xy[29]; ab0 -= mq[5][2] * xy[30]; ab1 -= mq[5][3] * xy[31]; mq[5] = *(const LAS f32x4*)(Mg + 2508);
            ab0 -= mq[0][0] * xy[32]; ab1 -= mq[0][1] * xy[33]; ab0 -= mq[0][2] * xy[34]; ab1 -= mq[0][3] * xy[35]; mq[0] = *(const LAS f32x4*)(Mg + 2512);
            ab0 -= mq[1][0] * xy[36]; ab1 -= mq[1][1] * xy[37]; xy[38] = ab0 + ab1; up[4864] = xy[38][0]; wp[4864] = f2bf(-xy[38][1]); mq[1] = *(const LAS f32x4*)(Mg + 2516);
            { const float br = betg[39]; ab0 = (f32x2){bf2f(*(const LAS bf16_t*)(lg + P5_VS + 10608 + c * 2)) * br, bf2f(*(const LAS bf16_t*)(lg + P5_KS + 10608 + c * 2)) * br * __expf(decg[39])}; ab1 = (f32x2){0.f, 0.f}; } ab0 -= mq[2][0] * xy[0]; ab1 -= mq[2][1] * xy[1]; ab0 -= mq[2][2] * xy[2]; ab1 -= mq[2][3] * xy[3]; mq[2] = *(const LAS f32x4*)(Mg + 2520);
            ab0 -= mq[3][0] * xy[4]; ab1 -= mq[3][1] * xy[5]; ab0 -= mq[3][2] * xy[6]; ab1 -= mq[3][3] * xy[7]; mq[3] = *(const LAS f32x4*)(Mg + 2524);
            ab0 -= mq[4][0] * xy[8]; ab1 -= mq[4][1] * xy[9]; ab0 -= mq[4][2] * xy[10]; ab1 -= mq[4][3] * xy[11]; mq[4] = *(const LAS f32x4*)(Mg + 2528);
            ab0 -= mq[5][0] * xy[12]; ab1 -= mq[5][1] * xy[13]; ab0 -= mq[5][2] * xy[14]; ab1 -= mq[5][3] * xy[15]; mq[5] = *(const LAS f32x4*)(Mg + 2532);
            ab0 -= mq[0][0] * xy[16]; ab1 -= mq[0][1] * xy[17]; ab0 -= mq[0][2] * xy[18]; ab1 -= mq[0][3] * xy[19]; mq[0] = *(const LAS f32x4*)(Mg + 2560);
            ab0 -= mq[1][0] * xy[20]; ab1 -= mq[1][1] * xy[21]; ab0 -= mq[1][2] * xy[22]; ab1 -= mq[1][3] * xy[23]; mq[1] = *(const LAS f32x4*)(Mg + 2564);
            ab0 -= mq[2][0] * xy[24]; ab1 -= mq[2][1] * xy[25]; ab0 -= mq[2][2] * xy[26]; ab1 -= mq[2][3] * xy[27]; mq[2] = *(const LAS f32x4*)(Mg + 2568);
            ab0 -= mq[3][0] * xy[28]; ab1 -= mq[3][1] * xy[29]; ab0 -= mq[3][2] * xy[30]; ab1 -= mq[3][3] * xy[31]; mq[3] = *(const LAS f32x4*)(Mg + 2572);
            ab0 -= mq[4][0] * xy[32]; ab1 -= mq[4][1] * xy[33]; ab0 -= mq[4][2] * xy[34]; ab1 -= mq[4][3] * xy[35]; mq[4] = *(const LAS f32x4*)(Mg + 2576);
            ab0 -= mq[5][0] * xy[36]; ab1 -= mq[5][1] * xy[37]; ab0 -= mq[5][2] * xy[38]; xy[39] = ab0 + ab1; up[4992] = xy[39][0]; wp[4992] = f2bf(-xy[39][1]); mq[5] = *(const LAS f32x4*)(Mg + 2580);
            { const float br = betg[40]; ab0 = (f32x2){bf2f(*(const LAS bf16_t*)(lg + P5_VS + 10880 + c * 2)) * br, bf2f(*(const LAS bf16_t*)(lg + P5_KS + 10880 + c * 2)) * br * __expf(decg[40])}; ab1 = (f32x2){0.f, 0.f}; } ab0 -= mq[0][0] * xy[0]; ab1 -= mq[0][1] * xy[1]; ab0 -= mq[0][2] * xy[2]; ab1 -= mq[0][3] * xy[3]; mq[0] = *(const LAS f32x4*)(Mg + 2584);
            ab0 -= mq[1][0] * xy[4]; ab1 -= mq[1][1] * xy[5]; ab0 -= mq[1][2] * xy[6]; ab1 -= mq[1][3] * xy[7]; mq[1] = *(const LAS f32x4*)(Mg + 2588);
            ab0 -= mq[2][0] * xy[8]; ab1 -= mq[2][1] * xy[9]; ab0 -= mq[2][2] * xy[10]; ab1 -= mq[2][3] * xy[11]; mq[2] = *(const LAS f32x4*)(Mg + 2592);
            ab0 -= mq[3][0] * xy[12]; ab1 -= mq[3][1] * xy[13]; ab0 -= mq[3][2] * xy[14]; ab1 -= mq[3][3] * xy[15]; mq[3] = *(const LAS f32x4*)(Mg + 2596);
            ab0 -= mq[4][0] * xy[16]; ab1 -= mq[4][1] * xy[17]; ab0 -= mq[4][2] * xy[18]; ab1 -= mq[4][3] * xy[19]; mq[4] = *(const LAS f32x4*)(Mg + 2624);
            ab0 -= mq[5][0] * xy[20]; ab1 -= mq[5][1] * xy[21]; ab0 -= mq[5][2] * xy[22]; ab1 -= mq[5][3] * xy[23]; mq[5] = *(const LAS f32x4*)(Mg + 2628);
            ab0 -= mq[0][0] * xy[24]; ab1 -= mq[0][1] * xy[25]; ab0 -= mq[0][2] * xy[26]; ab1 -= mq[0][3] * xy[27]; mq[0] = *(const LAS f32x4*)(Mg + 2632);
            ab0 -= mq[1][0] * xy[28]; ab1 -= mq[1][1] * xy[29]; ab0 -= mq[1][2] * xy[30]; ab1 -= mq[1][3] * xy[31]; mq[1] = *(const LAS f32x4*)(Mg + 2636);
            ab0 -= mq[2][0] * xy[32]; ab1 -= mq[2][1] * xy[33]; ab0 -= mq[2][2] * xy[34]; ab1 -= mq[2][3] * xy[35]; mq[2] = *(const LAS f32x4*)(Mg + 2640);
            ab0 -= mq[3][0] * xy[36]; ab1 -= mq[3][1] * xy[37]; ab0 -= mq[3][2] * xy[38]; ab1 -= mq[3][3] * xy[39]; xy[40] = ab0 + ab1; up[5120] = xy[40][0]; wp[5120] = f2bf(-xy[40][1]); mq[3] = *(const LAS f32x4*)(Mg + 2644);
            { const float br = betg[41]; ab0 = (f32x2){bf2f(*(const LAS bf16_t*)(lg + P5_VS + 11152 + c * 2)) * br, bf2f(*(const LAS bf16_t*)(lg + P5_KS + 11152 + c * 2)) * br * __expf(decg[41])}; ab1 = (f32x2){0.f, 0.f}; } ab0 -= mq[4][0] * xy[0]; ab1 -= mq[4][1] * xy[1]; ab0 -= mq[4][2] * xy[2]; ab1 -= mq[4][3] * xy[3]; mq[4] = *(const LAS f32x4*)(Mg + 2648);
            ab0 -= mq[5][0] * xy[4]; ab1 -= mq[5][1] * xy[5]; ab0 -= mq[5][2] * xy[6]; ab1 -= mq[5][3] * xy[7]; mq[5] = *(const LAS f32x4*)(Mg + 2652);
            ab0 -= mq[0][0] * xy[8]; ab1 -= mq[0][1] * xy[9]; ab0 -= mq[0][2] * xy[10]; ab1 -= mq[0][3] * xy[11]; mq[0] = *(const LAS f32x4*)(Mg + 2656);
            ab0 -= mq[1][0] * xy[12]; ab1 -= mq[1][1] * xy[13]; ab0 -= mq[1][2] * xy[14]; ab1 -= mq[1][3] * xy[15]; mq[1] = *(const LAS f32x4*)(Mg + 2660);
            ab0 -= mq[2][0] * xy[16]; ab1 -= mq[2][1] * xy[17]; ab0 -= mq[2][2] * xy[18]; ab1 -= mq[2][3] * xy[19]; mq[2] = *(const LAS f32x4*)(Mg + 2664);
            ab0 -= mq[3][0] * xy[20]; ab1 -= mq[3][1] * xy[21]; ab0 -= mq[3][2] * xy[22]; ab1 -= mq[3][3] * xy[23]; mq[3] = *(const LAS f32x4*)(Mg + 2688);
            ab0 -= mq[4][0] * xy[24]; ab1 -= mq[4][1] * xy[25]; ab0 -= mq[4][2] * xy[26]; ab1 -= mq[4][3] * xy[27]; mq[4] = *(const LAS f32x4*)(Mg + 2692);
            ab0 -= mq[5][0] * xy[28]; ab1 -= mq[5][1] * xy[29]; ab0 -= mq[5][2] * xy[30]; ab1 -= mq[5][3] * xy[31]; mq[5] = *(const LAS f32x4*)(Mg + 2696);
            ab0 -= mq[0][0] * xy[32]; ab1 -= mq[0][1] * xy[33]; ab0 -= mq[0][2] * xy[34]; ab1 -= mq[0][3] * xy[35]; mq[0] = *(const LAS f32x4*)(Mg + 2700);
            ab0 -= mq[1][0] * xy[36]; ab1 -= mq[1][1] * xy[37]; ab0 -= mq[1][2] * xy[38]; ab1 -= mq[1][3] * xy[39]; mq[1] = *(const LAS f32x4*)(Mg + 2704);
            ab0 -= mq[2][0] * xy[40]; xy[41] = ab0 + ab1; up[5248] = xy[41][0]; wp[5248] = f2bf(-xy[41][1]); mq[2] = *(const LAS f32x4*)(Mg + 2708);
            { const float br = betg[42]; ab0 = (f32x2){bf2f(*(const LAS bf16_t*)(lg + P5_VS + 11424 + c * 2)) * br, bf2f(*(const LAS bf16_t*)(lg + P5_KS + 11424 + c * 2)) * br * __expf(decg[42])}; ab1 = (f32x2){0.f, 0.f}; } ab0 -= mq[3][0] * xy[0]; ab1 -= mq[3][1] * xy[1]; ab0 -= mq[3][2] * xy[2]; ab1 -= mq[3][3] * xy[3]; mq[3] = *(const LAS f32x4*)(Mg + 2712);
            ab0 -= mq[4][0] * xy[4]; ab1 -= mq[4][1] * xy[5]; ab0 -= mq[4][2] * xy[6]; ab1 -= mq[4][3] * xy[7]; mq[4] = *(const LAS f32x4*)(Mg + 2716);
            ab0 -= mq[5][0] * xy[8]; ab1 -= mq[5][1] * xy[9]; ab0 -= mq[5][2] * xy[10]; ab1 -= mq[5][3] * xy[11]; mq[5] = *(const LAS f32x4*)(Mg + 2720);
            ab0 -= mq[0][0] * xy[12]; ab1 -= mq[0][1] * xy[13]; ab0 -= mq[0][2] * xy[14]; ab1 -= mq[0][3] * xy[15]; mq[0] = *(const LAS f32x4*)(Mg + 2724);
            ab0 -= mq[1][0] * xy[16]; ab1 -= mq[1][1] * xy[17]; ab0 -= mq[1][2] * xy[18]; ab1 -= mq[1][3] * xy[19]; mq[1] = *(const LAS f32x4*)(Mg + 2728);
            ab0 -= mq[2][0] * xy[20]; ab1 -= mq[2][1] * xy[21]; ab0 -= mq[2][2] * xy[22]; ab1 -= mq[2][3] * xy[23]; mq[2] = *(const LAS f32x4*)(Mg + 2752);
            ab0 -= mq[3][0] * xy[24]; ab1 -= mq[3][1] * xy[25]; ab0 -= mq[3][2] * xy[26]; ab1 -= mq[3][3] * xy[27]; mq[3] = *(const LAS f32x4*)(Mg + 2756);
            ab0 -= mq[4][0] * xy[28]; ab1 -= mq[4][1] * xy[29]; ab0 -= mq[4][2] * xy[30]; ab1 -= mq[4][3] * xy[31]; mq[4] = *(const LAS f32x4*)(Mg + 2760);
            ab0 -= mq[5][0] * xy[32]; ab1 -= mq[5][1] * xy[33]; ab0 -= mq[5][2] * xy[34]; ab1 -= mq[5][3] * xy[35]; mq[5] = *(const LAS f32x4*)(Mg + 2764);
            ab0 -= mq[0][0] * xy[36]; ab1 -= mq[0][1] * xy[37]; ab0 -= mq[0][2] * xy[38]; ab1 -= mq[0][3] * xy[39]; mq[0] = *(const LAS f32x4*)(Mg + 2768);
            ab0 -= mq[1][0] * xy[40]; ab1 -= mq[1][1] * xy[41]; xy[42] = ab0 + ab1; up[5376] = xy[42][0]; wp[5376] = f2bf(-xy[42][1]); mq[1] = *(const LAS f32x4*)(Mg + 2772);
            { const float br = betg[43]; ab0 = (f32x2){bf2f(*(const LAS bf16_t*)(lg + P5_VS + 11696 + c * 2)) * br, bf2f(*(const LAS bf16_t*)(lg + P5_KS + 11696 + c * 2)) * br * __expf(decg[43])}; ab1 = (f32x2){0.f, 0.f}; } ab0 -= mq[2][0] * xy[0]; ab1 -= mq[2][1] * xy[1]; ab0 -= mq[2][2] * xy[2]; ab1 -= mq[2][3] * xy[3]; mq[2] = *(const LAS f32x4*)(Mg + 2776);
            ab0 -= mq[3][0] * xy[4]; ab1 -= mq[3][1] * xy[5]; ab0 -= mq[3][2] * xy[6]; ab1 -= mq[3][3] * xy[7]; mq[3] = *(const LAS f32x4*)(Mg + 2780);
            ab0 -= mq[4][0] * xy[8]; ab1 -= mq[4][1] * xy[9]; ab0 -= mq[4][2] * xy[10]; ab1 -= mq[4][3] * xy[11]; mq[4] = *(const LAS f32x4*)(Mg + 2784);
            ab0 -= mq[5][0] * xy[12]; ab1 -= mq[5][1] * xy[13]; ab0 -= mq[5][2] * xy[14]; ab1 -= mq[5][3] * xy[15]; mq[5] = *(const LAS f32x4*)(Mg + 2788);
            ab0 -= mq[0][0] * xy[16]; ab1 -= mq[0][1] * xy[17]; ab0 -= mq[0][2] * xy[18]; ab1 -= mq[0][3] * xy[19]; mq[0] = *(const LAS f32x4*)(Mg + 2792);
            ab0 -= mq[1][0] * xy[20]; ab1 -= mq[1][1] * xy[21]; ab0 -= mq[1][2] * xy[22]; ab1 -= mq[1][3] * xy[23]; mq[1] = *(const LAS f32x4*)(Mg + 2816);
            ab0 -= mq[2][0] * xy[24]; ab1 -= mq[2][1] * xy[25]; ab0 -= mq[2][2] * xy[26]; ab1 -= mq[2][3] * xy[27]; mq[2] = *(const LAS f32x4*)(Mg + 2820);
            ab0 -= mq[3][0] * xy[28]; ab1 -= mq[3][1] * xy[29]; ab0 -= mq[3][2] * xy[30]; ab1 -= mq[3][3] * xy[31]; mq[3] = *(const LAS f32x4*)(Mg + 2824);
            ab0 -= mq[4][0] * xy[32]; ab1 -= mq[4][1] * xy[33]; ab0 -= mq[4][2] * xy[34]; ab1 -= mq[4][3] * xy[35]; mq[4] = *(const LAS f32x4*)(Mg + 2828);
            ab0 -= mq[5][0] * xy[36]; ab1 -= mq[5][1] * xy[37]; ab0 -= mq[5][2] * xy[38]; ab1 -= mq[5][3] * xy[39]; mq[5] = *(const LAS f32x4*)(Mg + 2832);
            ab0 -= mq[0][0] * xy[40]; ab1 -= mq[0][1] * xy[41]; ab0 -= mq[0][2] * xy[42]; xy[43] = ab0 + ab1; up[5504] = xy[43][0]; wp[5504] = f2bf(-xy[43][1]); mq[0] = *(const LAS f32x4*)(Mg + 2836);
            { const float br = betg[44]; ab0 = (f32x2){bf2f(*(const LAS bf16_t*)(lg + P5_VS + 11968 + c * 2)) * br, bf2f(*(const LAS bf16_t*)(lg + P5_KS + 11968 + c * 2)) * br * __expf(decg[44])}; ab1 = (f32x2){0.f, 0.f}; } ab0 -= mq[1][0] * xy[0]; ab1 -= mq[1][1] * xy[1]; ab0 -= mq[1][2] * xy[2]; ab1 -= mq[1][3] * xy[3]; mq[1] = *(const LAS f32x4*)(Mg + 2840);
            ab0 -= mq[2][0] * xy[4]; ab1 -= mq[2][1] * xy[5]; ab0 -= mq[2][2] * xy[6]; ab1 -= mq[2][3] * xy[7]; mq[2] = *(const LAS f32x4*)(Mg + 2844);
            ab0 -= mq[3][0] * xy[8]; ab1 -= mq[3][1] * xy[9]; ab0 -= mq[3][2] * xy[10]; ab1 -= mq[3][3] * xy[11]; mq[3] = *(const LAS f32x4*)(Mg + 2848);
            ab0 -= mq[4][0] * xy[12]; ab1 -= mq[4][1] * xy[13]; ab0 -= mq[4][2] * xy[14]; ab1 -= mq[4][3] * xy[15]; mq[4] = *(const LAS f32x4*)(Mg + 2852);
            ab0 -= mq[5][0] * xy[16]; ab1 -= mq[5][1] * xy[17]; ab0 -= mq[5][2] * xy[18]; ab1 -= mq[5][3] * xy[19]; mq[5] = *(const LAS f32x4*)(Mg + 2856);
            ab0 -= mq[0][0] * xy[20]; ab1 -= mq[0][1] * xy[21]; ab0 -= mq[0][2] * xy[22]; ab1 -= mq[0][3] * xy[23]; mq[0] = *(const LAS f32x4*)(Mg + 2880);
            ab0 -= mq[1][0] * xy[24]; ab1 -= mq[1][1] * xy[25]; ab0 -= mq[1][2] * xy[26]; ab1 -= mq[1][3] * xy[27]; mq[1] = *(const LAS f32x4*)(Mg + 2884);
            ab0 -= mq[2][0] * xy[28]; ab1 -= mq[2][1] * xy[29]; ab0 -= mq[2][2] * xy[30]; ab1 -= mq[2][3] * xy[31]; mq[2] = *(const LAS f32x4*)(Mg + 2888);
            ab0 -= mq[3][0] * xy[32]; ab1 -= mq[3][1] * xy[33]; ab0 -= mq[3][2] * xy[34]; ab1 -= mq[3][3] * xy[35]; mq[3] = *(const LAS f32x4*)(Mg + 2892);
            ab0 -= mq[4][0] * xy[36]; ab1 -= mq[4][1] * xy[37]; ab0 -= mq[4][2] * xy[38]; ab1 -= mq[4][3] * xy[39]; mq[4] = *(const LAS f32x4*)(Mg + 2896);
            ab0 -= mq[5][0] * xy[40]; ab1 -= mq[5][1] * xy[41]; ab0 -= mq[5][2] * xy[42]; ab1 -= mq[5][3] * xy[43]; xy[44] = ab0 + ab1; up[5632] = xy[44][0]; wp[5632] = f2bf(-xy[44][1]); mq[5] = *(const LAS f32x4*)(Mg + 2900);
            { const float br = betg[45]; ab0 = (f32x2){bf2f(*(const LAS bf16_t*)(lg + P5_VS + 12240 + c * 2)) * br, bf2f(*(const LAS bf16_t*)(lg + P5_KS + 12240 + c * 2)) * br * __expf(decg[45])}; ab1 = (f32x2){0.f, 0.f}; } ab0 -= mq[0][0] * xy[0]; ab1 -= mq[0][1] * xy[1]; ab0 -= mq[0][2] * xy[2]; ab1 -= mq[0][3] * xy[3]; mq[0] = *(const LAS f32x4*)(Mg + 2904);
            ab0 -= mq[1][0] * xy[4]; ab1 -= mq[1][1] * xy[5]; ab0 -= mq[1][2] * xy[6]; ab1 -= mq[1][3] * xy[7]; mq[1] = *(const LAS f32x4*)(Mg + 2908);
            ab0 -= mq[2][0] * xy[8]; ab1 -= mq[2][1] * xy[9]; ab0 -= mq[2][2] * xy[10]; ab1 -= mq[2][3] * xy[11]; mq[2] = *(const LAS f32x4*)(Mg + 2912);
            ab0 -= mq[3][0] * xy[12]; ab1 -= mq[3][1] * xy[13]; ab0 -= mq[3][2] * xy[14]; ab1 -= mq[3][3] * xy[15]; mq[3] = *(const LAS f32x4*)(Mg + 2916);
            ab0 -= mq[4][0] * xy[16]; ab1 -= mq[4][1] * xy[17]; ab0 -= mq[4][2] * xy[18]; ab1 -= mq[4][3] * xy[19]; mq[4] = *(const LAS f32x4*)(Mg + 2920);
            ab0 -= mq[5][0] * xy[20]; ab1 -= mq[5][1] * xy[21]; ab0 -= mq[5][2] * xy[22]; ab1 -= mq[5][3] * xy[23]; mq[5] = *(const LAS f32x4*)(Mg + 2924);
            ab0 -= mq[0][0] * xy[24]; ab1 -= mq[0][1] * xy[25]; ab0 -= mq[0][2] * xy[26]; ab1 -= mq[0][3] * xy[27]; mq[0] = *(const LAS f32x4*)(Mg + 2944);
            ab0 -= mq[1][0] * xy[28]; ab1 -= mq[1][1] * xy[29]; ab0 -= mq[1][2] * xy[30]; ab1 -= mq[1][3] * xy[31]; mq[1] = *(const LAS f32x4*)(Mg + 2948);
            ab0 -= mq[2][0] * xy[32]; ab1 -= mq[2][1] * xy[33]; ab0 -= mq[2][2] * xy[34]; ab1 -= mq[2][3] * xy[35]; mq[2] = *(const LAS f32x4*)(Mg + 2952);
            ab0 -= mq[3][0] * xy[36]; ab1 -= mq[3][1] * xy[37]; ab0 -= mq[3][2] * xy[38]; ab1 -= mq[3][3] * xy[39]; mq[3] = *(const LAS f32x4*)(Mg + 2956);
            ab0 -= mq[4][0] * xy[40]; ab1 -= mq[4][1] * xy[41]; ab0 -= mq[4][2] * xy[42]; ab1 -= mq[4][3] * xy[43]; mq[4] = *(const LAS f32x4*)(Mg + 2960);
            ab0 -= mq[5][0] * xy[44]; xy[45] = ab0 + ab1; up[5760] = xy[45][0]; wp[5760] = f2bf(-xy[45][1]); mq[5] = *(const LAS f32x4*)(Mg + 2964);
            { const float br = betg[46]; ab0 = (f32x2){bf2f(*(const LAS bf16_t*)(lg + P5_VS + 12512 + c * 2)) * br, bf2f(*(const LAS bf16_t*)(lg + P5_KS + 12512 + c * 2)) * br * __expf(decg[46])}; ab1 = (f32x2){0.f, 0.f}; } ab0 -= mq[0][0] * xy[0]; ab1 -= mq[0][1] * xy[1]; ab0 -= mq[0][2] * xy[2]; ab1 -= mq[0][3] * xy[3]; mq[0] = *(const LAS f32x4*)(Mg + 2968);
            ab0 -= mq[1][0] * xy[4]; ab1 -= mq[1][1] * xy[5]; ab0 -= mq[1][2] * xy[6]; ab1 -= mq[1][3] * xy[7]; mq[1] = *(const LAS f32x4*)(Mg + 2972);
            ab0 -= mq[2][0] * xy[8]; ab1 -= mq[2][1] * xy[9]; ab0 -= mq[2][2] * xy[10]; ab1 -= mq[2][3] * xy[11]; mq[2] = *(const LAS f32x4*)(Mg + 2976);
            ab0 -= mq[3][0] * xy[12]; ab1 -= mq[3][1] * xy[13]; ab0 -= mq[3][2] * xy[14]; ab1 -= mq[3][3] * xy[15]; mq[3] = *(const LAS f32x4*)(Mg + 2980);
            ab0 -= mq[4][0] * xy[16]; ab1 -= mq[4][1] * xy[17]; ab0 -= mq[4][2] * xy[18]; ab1 -= mq[4][3] * xy[19]; mq[4] = *(const LAS f32x4*)(Mg + 2984);
            ab0 -= mq[5][0] * xy[20]; ab1 -= mq[5][1] * xy[21]; ab0 -= mq[5][2] * xy[22]; ab1 -= mq[5][3] * xy[23]; mq[5] = *(const LAS f32x4*)(Mg + 2988);
            ab0 -= mq[0][0] * xy[24]; ab1 -= mq[0][1] * xy[25]; ab0 -= mq[0][2] * xy[26]; ab1 -= mq[0][3] * xy[27]; mq[0] = *(const LAS f32x4*)(Mg + 3008);
            ab0 -= mq[1][0] * xy[28]; ab1 -= mq[1][1] * xy[29]; ab0 -= mq[1][2] * xy[30]; ab1 -= mq[1][3] * xy[31]; mq[1] = *(const LAS f32x4*)(Mg + 3012);
            ab0 -= mq[2][0] * xy[32]; ab1 -= mq[2][1] * xy[33]; ab0 -= mq[2][2] * xy[34]; ab1 -= mq[2][3] * xy[35]; mq[2] = *(const LAS f32x4*)(Mg + 3016);
            ab0 -= mq[3][0] * xy[36]; ab1 -= mq[3][1] * xy[37]; ab0 -= mq[3][2] * xy[38]; ab1 -= mq[3][3] * xy[39]; mq[3] = *(const LAS f32x4*)(Mg + 3020);
            ab0 -= mq[4][0] * xy[40]; ab1 -= mq[4][1] * xy[41]; ab0 -= mq[4][2] * xy[42]; ab1 -= mq[4][3] * xy[43]; mq[4] = *(const LAS f32x4*)(Mg + 3024);
            ab0 -= mq[5][0] * xy[44]; ab1 -= mq[5][1] * xy[45]; xy[46] = ab0 + ab1; up[5888] = xy[46][0]; wp[5888] = f2bf(-xy[46][1]); mq[5] = *(const LAS f32x4*)(Mg + 3028);
            { const float br = betg[47]; ab0 = (f32x2){bf2f(*(const LAS bf16_t*)(lg + P5_VS + 12784 + c * 2)) * br, bf2f(*(const LAS bf16_t*)(lg + P5_KS + 12784 + c * 2)) * br * __expf(decg[47])}; ab1 = (f32x2){0.f, 0.f}; } ab0 -= mq[0][0] * xy[0]; ab1 -= mq[0][1] * xy[1]; ab0 -= mq[0][2] * xy[2]; ab1 -= mq[0][3] * xy[3]; mq[0] = *(const LAS f32x4*)(Mg + 3032);
            ab0 -= mq[1][0] * xy[4]; ab1 -= mq[1][1] * xy[5]; ab0 -= mq[1][2] * xy[6]; ab1 -= mq[1][3] * xy[7]; mq[1] = *(const LAS f32x4*)(Mg + 3036);
            ab0 -= mq[2][0] * xy[8]; ab1 -= mq[2][1] * xy[9]; ab0 -= mq[2][2] * xy[10]; ab1 -= mq[2][3] * xy[11]; mq[2] = *(const LAS f32x4*)(Mg + 3040);
            ab0 -= mq[3][0] * xy[12]; ab1 -= mq[3][1] * xy[13]; ab0 -= mq[3][2] * xy[14]; ab1 -= mq[3][3] * xy[15]; mq[3] = *(const LAS f32x4*)(Mg + 3044);
            ab0 -= mq[4][0] * xy[16]; ab1 -= mq[4][1] * xy[17]; ab0 -= mq[4][2] * xy[18]; ab1 -= mq[4][3] * xy[19]; mq[4] = *(const LAS f32x4*)(Mg + 3048);
            ab0 -= mq[5][0] * xy[20]; ab1 -= mq[5][1] * xy[21]; ab0 -= mq[5][2] * xy[22]; ab1 -= mq[5][3] * xy[23]; mq[5] = *(const LAS f32x4*)(Mg + 3052);
            ab0 -= mq[0][0] * xy[24]; ab1 -= mq[0][1] * xy[25]; ab0 -= mq[0][2] * xy[26]; ab1 -= mq[0][3] * xy[27]; mq[0] = *(const LAS f32x4*)(Mg + 3072);
            ab0 -= mq[1][0] * xy[28]; ab1 -= mq[1][1] * xy[29]; ab0 -= mq[1][2] * xy[30]; ab1 -= mq[1][3] * xy[31]; mq[1] = *(const LAS f32x4*)(Mg + 3076);
            ab0 -= mq[2][0] * xy[32]; ab1 -= mq[2][1] * xy[33]; ab0 -= mq[2][2] * xy[34]; ab1 -= mq[2][3] * xy[35]; mq[2] = *(const LAS f32x4*)(Mg + 3080);
            ab0 -= mq[3][0] * xy[36]; ab1 -= mq[3][1] * xy[37]; ab0 -= mq[3][2] * xy[38]; ab1 -= mq[3][3] * xy[39]; mq[3] = *(const LAS f32x4*)(Mg + 3084);
            ab0 -= mq[4][0] * xy[40]; ab1 -= mq[4][1] * xy[41]; ab0 -= mq[4][2] * xy[42]; ab1 -= mq[4][3] * xy[43]; mq[4] = *(const LAS f32x4*)(Mg + 3088);
            ab0 -= mq[5][0] * xy[44]; ab1 -= mq[5][1] * xy[45]; ab0 -= mq[5][2] * xy[46]; xy[47] = ab0 + ab1; up[6016] = xy[47][0]; wp[6016] = f2bf(-xy[47][1]); mq[5] = *(const LAS f32x4*)(Mg + 3092);
            { const float br = betg[48]; ab0 = (f32x2){bf2f(*(const LAS bf16_t*)(lg + P5_VS + 13056 + c * 2)) * br, bf2f(*(const LAS bf16_t*)(lg + P5_KS + 13056 + c * 2)) * br * __expf(decg[48])}; ab1 = (f32x2){0.f, 0.f}; } ab0 -= mq[0][0] * xy[0]; ab1 -= mq[0][1] * xy[1]; ab0 -= mq[0][2] * xy[2]; ab1 -= mq[0][3] * xy[3]; mq[0] = *(const LAS f32x4*)(Mg + 3096);
            ab0 -= mq[1][0] * xy[4]; ab1 -= mq[1][1] * xy[5]; ab0 -= mq[1][2] * xy[6]; ab1 -= mq[1][3] * xy[7]; mq[1] = *(const LAS f32x4*)(Mg + 3100);
            ab0 -= mq[2][0] * xy[8]; ab1 -= mq[2][1] * xy[9]; ab0 -= mq[2][2] * xy[10]; ab1 -= mq[2][3] * xy[11]; mq[2] = *(const LAS f32x4*)(Mg + 3104);
            ab0 -= mq[3][0] * xy[12]; ab1 -= mq[3][1] * xy[13]; ab0 -= mq[3][2] * xy[14]; ab1 -= mq[3][3] * xy[15]; mq[3] = *(const LAS f32x4*)(Mg + 3108);
            ab0 -= mq[4][0] * xy[16]; ab1 -= mq[4][1] * xy[17]; ab0 -= mq[4][2] * xy[18]; ab1 -= mq[4][3] * xy[19]; mq[4] = *(const LAS f32x4*)(Mg + 3112);
            ab0 -= mq[5][0] * xy[20]; ab1 -= mq[5][1] * xy[21]; ab0 -= mq[5][2] * xy[22]; ab1 -= mq[5][3] * xy[23]; mq[5] = *(const LAS f32x4*)(Mg + 3116);
            ab0 -= mq[0][0] * xy[24]; ab1 -= mq[0][1] * xy[25]; ab0 -= mq[0][2] * xy[26]; ab1 -= mq[0][3] * xy[27]; mq[0] = *(const LAS f32x4*)(Mg + 3136);
            ab0 -= mq[1][0] * xy[28]; ab1 -= mq[1][1] * xy[29]; ab0 -= mq[1][2] * xy[30]; ab1 -= mq[1][3] * xy[31]; mq[1] = *(const LAS f32x4*)(Mg + 3140);
            ab0 -= mq[2][0] * xy[32]; ab1 -= mq[2][1] * xy[33]; ab0 -= mq[2][2] * xy[34]; ab1 -= mq[2][3] * xy[35]; mq[2] = *(const LAS f32x4*)(Mg + 3144);
            ab0 -= mq[3][0] * xy[36]; ab1 -= mq[3][1] * xy[37]; ab0 -= mq[3][2] * xy[38]; ab1 -= mq[3][3] * xy[39]; mq[3] = *(const LAS f32x4*)(Mg + 3148);
            ab0 -= mq[4][0] * xy[40]; ab1 -= mq[4][1] * xy[41]; ab0 -= mq[4][2] * xy[42]; ab1 -= mq[4][3] * xy[43]; mq[4] = *(const LAS f32x4*)(Mg + 3152);
            ab0 -= mq[5][0] * xy[44]; ab1 -= mq[5][1] * xy[45]; ab0 -= mq[5][2] * xy[46]; ab1 -= mq[5][3] * xy[47]; xy[48] = ab0 + ab1; up[6144] = xy[48][0]; wp[6144] = f2bf(-xy[48][1]); mq[5] = *(const LAS f32x4*)(Mg + 3156);
            { const float br = betg[49]; ab0 = (f32x2){bf2f(*(const LAS bf16_t*)(lg + P5_VS + 13328 + c * 2)) * br, bf2f(*(const LAS bf16_t*)(lg + P5_KS + 13328 + c * 2)) * br * __expf(decg[49])}; ab1 = (f32x2){0.f, 0.f}; } ab0 -= mq[0][0] * xy[0]; ab1 -= mq[0][1] * xy[1]; ab0 -= mq[0][2] * xy[2]; ab1 -= mq[0][3] * xy[3]; mq[0] = *(const LAS f32x4*)(Mg + 3160);
            ab0 -= mq[1][0] * xy[4]; ab1 -= mq[1][1] * xy[5]; ab0 -= mq[1][2] * xy[6]; ab1 -= mq[1][3] * xy[7]; mq[1] = *(const LAS f32x4*)(Mg + 3164);
            ab0 -= mq[2][0] * xy[8]; ab1 -= mq[2][1] * xy[9]; ab0 -= mq[2][2] * xy[10]; ab1 -= mq[2][3] * xy[11]; mq[2] = *(const LAS f32x4*)(Mg + 3168);
            ab0 -= mq[3][0] * xy[12]; ab1 -= mq[3][1] * xy[13]; ab0 -= mq[3][2] * xy[14]; ab1 -= mq[3][3] * xy[15]; mq[3] = *(const LAS f32x4*)(Mg + 3172);
            ab0 -= mq[4][0] * xy[16]; ab1 -= mq[4][1] * xy[17]; ab0 -= mq[4][2] * xy[18]; ab1 -= mq[4][3] * xy[19]; mq[4] = *(const LAS f32x4*)(Mg + 3176);
            ab0 -= mq[5][0] * xy[20]; ab1 -= mq[5][1] * xy[21]; ab0 -= mq[5][2] * xy[22]; ab1 -= mq[5][3] * xy[23]; mq[5] = *(const LAS f32x4*)(Mg + 3180);
            ab0 -= mq[0][0] * xy[24]; ab1 -= mq[0][1] * xy[25]; ab0 -= mq[0][2] * xy[26]; ab1 -= mq[0][3] * xy[27]; mq[0] = *(const LAS f32x4*)(Mg + 3184);
            ab0 -= mq[1][0] * xy[28]; ab1 -= mq[1][1] * xy[29]; ab0 -= mq[1][2] * xy[30]; ab1 -= mq[1][3] * xy[31]; mq[1] = *(const LAS f32x4*)(Mg + 3200);
            ab0 -= mq[2][0] * xy[32]; ab1 -= mq[2][1] * xy[33]; ab0 -= mq[2][2] * xy[34]; ab1 -= mq[2][3] * xy[35]; mq[2] = *(const LAS f32x4*)(Mg + 3204);
            ab0 -= mq[3][0] * xy[36]; ab1 -= mq[3][1] * xy[37]; ab0 -= mq[3][2] * xy[38]; ab1 -= mq[3][3] * xy[39]; mq[3] = *(const LAS f32x4*)(Mg + 3208);
            ab0 -= mq[4][0] * xy[40]; ab1 -= mq[4][1] * xy[41]; ab0 -= mq[4][2] * xy[42]; ab1 -= mq[4][3] * xy[43]; mq[4] = *(const LAS f32x4*)(Mg + 3212);
            ab0 -= mq[5][0] * xy[44]; ab1 -= mq[5][1] * xy[45]; ab0 -= mq[5][2] * xy[46]; ab1 -= mq[5][3] * xy[47]; mq[5] = *(const LAS f32x4*)(Mg + 3216);
            ab0 -= mq[0][0] * xy[48]; xy[49] = ab0 + ab1; up[6272] = xy[49][0]; wp[6272] = f2bf(-xy[49][1]); mq[0] = *(const LAS f32x4*)(Mg + 3220);
            { const float br = betg[50]; ab0 = (f32x2){bf2f(*(const LAS bf16_t*)(lg + P5_VS + 13600 + c * 2)) * br, bf2f(*(const LAS bf16_t*)(lg + P5_KS + 13600 + c * 2)) * br * __expf(decg[50])}; ab1 = (f32x2){0.f, 0.f}; } ab0 -= mq[1][0] * xy[0]; ab1 -= mq[1][1] * xy[1]; ab0 -= mq[1][2] * xy[2]; ab1 -= mq[1][3] * xy[3]; mq[1] = *(const LAS f32x4*)(Mg + 3224);
            ab0 -= mq[2][0] * xy[4]; ab1 -= mq[2][1] * xy[5]; ab0 -= mq[2][2] * xy[6]; ab1 -= mq[2][3] * xy[7]; mq[2] = *(const LAS f32x4*)(Mg + 3228);
            ab0 -= mq[3][0] * xy[8]; ab1 -= mq[3][1] * xy[9]; ab0 -= mq[3][2] * xy[10]; ab1 -= mq[3][3] * xy[11]; mq[3] = *(const LAS f32x4*)(Mg + 3232);
            ab0 -= mq[4][0] * xy[12]; ab1 -= mq[4][1] * xy[13]; ab0 -= mq[4][2] * xy[14]; ab1 -= mq[4][3] * xy[15]; mq[4] = *(const LAS f32x4*)(Mg + 3236);
            ab0 -= mq[5][0] * xy[16]; ab1 -= mq[5][1] * xy[17]; ab0 -= mq[5][2] * xy[18]; ab1 -= mq[5][3] * xy[19]; mq[5] = *(const LAS f32x4*)(Mg + 3240);
            ab0 -= mq[0][0] * xy[20]; ab1 -= mq[0][1] * xy[21]; ab0 -= mq[0][2] * xy[22]; ab1 -= mq[0][3] * xy[23]; mq[0] = *(const LAS f32x4*)(Mg + 3244);
            ab0 -= mq[1][0] * xy[24]; ab1 -= mq[1][1] * xy[25]; ab0 -= mq[1][2] * xy[26]; ab1 -= mq[1][3] * xy[27]; mq[1] = *(const LAS f32x4*)(Mg + 3248);
            ab0 -= mq[2][0] * xy[28]; ab1 -= mq[2][1] * xy[29]; ab0 -= mq[2][2] * xy[30]; ab1 -= mq[2][3] * xy[31]; mq[2] = *(const LAS f32x4*)(Mg + 3264);
            ab0 -= mq[3][0] * xy[32]; ab1 -= mq[3][1] * xy[33]; ab0 -= mq[3][2] * xy[34]; ab1 -= mq[3][3] * xy[35]; mq[3] = *(const LAS f32x4*)(Mg + 3268);
            ab0 -= mq[4][0] * xy[36]; ab1 -= mq[4][1] * xy[37]; ab0 -= mq[4][2] * xy[38]; ab1 -= mq[4][3] * xy[39]; mq[4] = *(const LAS f32x4*)(Mg + 3272);
            ab0 -= mq[5][0] * xy[40]; ab1 -= mq[5][1] * xy[41]; ab0 -= mq[5][2] * xy[42]; ab1 -= mq[5][3] * xy[43]; mq[5] = *(const LAS f32x4*)(Mg + 3276);
            ab0 -= mq[0][0] * xy[44]; ab1 -= mq[0][1] * xy[45]; ab0 -= mq[0][2] * xy[46]; ab1 -= mq[0][3] * xy[47]; mq[0] = *(const LAS f32x4*)(Mg + 3280);
            ab0 -= mq[1][0] * xy[48]; ab1 -= mq[1][1] * xy[49]; xy[50] = ab0 + ab1; up[6400] = xy[50][0]; wp[6400] = f2bf(-xy[50][1]); mq[1] = *(const LAS f32x4*)(Mg + 3284);
            { const float br = betg[51]; ab0 = (f32x2){bf2f(*(const LAS bf16_t*)(lg + P5_VS + 13872 + c * 2)) * br, bf2f(*(const LAS bf16_t*)(lg + P5_KS + 13872 + c * 2)) * br * __expf(decg[51])}; ab1 = (f32x2){0.f, 0.f}; } ab0 -= mq[2][0] * xy[0]; ab1 -= mq[2][1] * xy[1]; ab0 -= mq[2][2] * xy[2]; ab1 -= mq[2][3] * xy[3]; mq[2] = *(const LAS f32x4*)(Mg + 3288);
            ab0 -= mq[3][0] * xy[4]; ab1 -= mq[3][1] * xy[5]; ab0 -= mq[3][2] * xy[6]; ab1 -= mq[3][3] * xy[7]; mq[3] = *(const LAS f32x4*)(Mg + 3292);
            ab0 -= mq[4][0] * xy[8]; ab1 -= mq[4][1] * xy[9]; ab0 -= mq[4][2] * xy[10]; ab1 -= mq[4][3] * xy[11]; mq[4] = *(const LAS f32x4*)(Mg + 3296);
            ab0 -= mq[5][0] * xy[12]; ab1 -= mq[5][1] * xy[13]; ab0 -= mq[5][2] * xy[14]; ab1 -= mq[5][3] * xy[15]; mq[5] = *(const LAS f32x4*)(Mg + 3300);
            ab0 -= mq[0][0] * xy[16]; ab1 -= mq[0][1] * xy[17]; ab0 -= mq[0][2] * xy[18]; ab1 -= mq[0][3] * xy[19]; mq[0] = *(const LAS f32x4*)(Mg + 3304);
            ab0 -= mq[1][0] * xy[20]; ab1 -= mq[1][1] * xy[21]; ab0 -= mq[1][2] * xy[22]; ab1 -= mq[1][3] * xy[23]; mq[1] = *(const LAS f32x4*)(Mg + 3308);
            ab0 -= mq[2][0] * xy[24]; ab1 -= mq[2][1] * xy[25]; ab0 -= mq[2][2] * xy[26]; ab1 -= mq[2][3] * xy[27]; mq[2] = *(const LAS f32x4*)(Mg + 3312);
            ab0 -= mq[3][0] * xy[28]; ab1 -= mq[3][1] * xy[29]; ab0 -= mq[3][2] * xy[30]; ab1 -= mq[3][3] * xy[31]; mq[3] = *(const LAS f32x4*)(Mg + 3328);
            ab0 -= mq[4][0] * xy[32]; ab1 -= mq[4][1] * xy[33]; ab0 -= mq[4][2] * xy[34]; ab1 -= mq[4][3] * xy[35]; mq[4] = *(const LAS f32x4*)(Mg + 3332);
            ab0 -= mq[5][0] * xy[36]; ab1 -= mq[5][1] * xy[37]; ab0 -= mq[5][2] * xy[38]; ab1 -= mq[5][3] * xy[39]; mq[5] = *(const LAS f32x4*)(Mg + 3336);
            ab0 -= mq[0][0] * xy[40]; ab1 -= mq[0][1] * xy[41]; ab0 -= mq[0][2] * xy[42]; ab1 -= mq[0][3] * xy[43]; mq[0] = *(const LAS f32x4*)(Mg + 3340);
            ab0 -= mq[1][0] * xy[44]; ab1 -= mq[1][1] * xy[45]; ab0 -= mq[1][2] * xy[46]; ab1 -= mq[1][3] * xy[47]; mq[1] = *(const LAS f32x4*)(Mg + 3344);
            ab0 -= mq[2][0] * xy[48]; ab1 -= mq[2][1] * xy[49]; ab0 -= mq[2][2] * xy[50]; xy[51] = ab0 + ab1; up[6528] = xy[51][0]; wp[6528] = f2bf(-xy[51][1]); mq[2] = *(const LAS f32x4*)(Mg + 3348);
            { const float br = betg[52]; ab0 = (f32x2){bf2f(*(const LAS bf16_t*)(lg + P5_VS + 14144 + c * 2)) * br, bf2f(*(const LAS bf16_t*)(lg + P5_KS + 14144 + c * 2)) * br * __expf(decg[52])}; ab1 = (f32x2){0.f, 0.f}; } ab0 -= mq[3][0] * xy[0]; ab1 -= mq[3][1] * xy[1]; ab0 -= mq[3][2] * xy[2]; ab1 -= mq[3][3] * xy[3]; mq[3] = *(const LAS f32x4*)(Mg + 3352);
            ab0 -= mq[4][0] * xy[4]; ab1 -= mq[4][1] * xy[5]; ab0 -= mq[4][2] * xy[6]; ab1 -= mq[4][3] * xy[7]; mq[4] = *(const LAS f32x4*)(Mg + 3356);
            ab0 -= mq[5][0] * xy[8]; ab1 -= mq[5][1] * xy[9]; ab0 -= mq[5][2] * xy[10]; ab1 -= mq[5][3] * xy[11]; mq[5] = *(const LAS f32x4*)(Mg + 3360);
            ab0 -= mq[0][0] * xy[12]; ab1 -= mq[0][1] * xy[13]; ab0 -= mq[0][2] * xy[14]; ab1 -= mq[0][3] * xy[15]; mq[0] = *(const LAS f32x4*)(Mg + 3364);
            ab0 -= mq[1][0] * xy[16]; ab1 -= mq[1][1] * xy[17]; ab0 -= mq[1][2] * xy[18]; ab1 -= mq[1][3] * xy[19]; mq[1] = *(const LAS f32x4*)(Mg + 3368);
            ab0 -= mq[2][0] * xy[20]; ab1 -= mq[2][1] * xy[21]; ab0 -= mq[2][2] * xy[22]; ab1 -= mq[2][3] * xy[23]; mq[2] = *(const LAS f32x4*)(Mg + 3372);
            ab0 -= mq[3][0] * xy[24]; ab1 -= mq[3][1] * xy[25]; ab0 -= mq[3][2] * xy[26]; ab1 -= mq[3][3] * xy[27]; mq[3] = *(const LAS f32x4*)(Mg + 3376);
            ab0 -= mq[4][0] * xy[28]; ab1 -= mq[4][1] * xy[29]; ab0 -= mq[4][2] * xy[30]; ab1 -= mq[4][3] * xy[31]; mq[4] = *(const LAS f32x4*)(Mg + 3392);
            ab0 -= mq[5][0] * xy[32]; ab1 -= mq[5][1] * xy[33]; ab0 -= mq[5][2] * xy[34]; ab1 -= mq[5][3] * xy[35]; mq[5] = *(const LAS f32x4*)(Mg + 3396);
            ab0 -= mq[0][0] * xy[36]; ab1 -= mq[0][1] * xy[37]; ab0 -= mq[0][2] * xy[38]; ab1 -= mq[0][3] * xy[39]; mq[0] = *(const LAS f32x4*)(Mg + 3400);
            ab0 -= mq[1][0] * xy[40]; ab1 -= mq[1][1] * xy[41]; ab0 -= mq[1][2] * xy[42]; ab1 -= mq[1][3] * xy[43]; mq[1] = *(const LAS f32x4*)(Mg + 3404);
            ab0 -= mq[2][0] * xy[44]; ab1 -= mq[2][1] * xy[45]; ab0 -= mq[2][2] * xy[46]; ab1 -= mq[2][3] * xy[47]; mq[2] = *(const LAS f32x4*)(Mg + 3408);
            ab0 -= mq[3][0] * xy[48]; ab1 -= mq[3][1] * xy[49]; ab0 -= mq[3][2] * xy[50]; ab1 -= mq[3][3] * xy[51]; xy[52] = ab0 + ab1; up[6656] = xy[52][0]; wp[6656] = f2bf(-xy[52][1]); mq[3] = *(const LAS f32x4*)(Mg + 3412);
            { const float br = betg[53]; ab0 = (f32x2){bf2f(*(const LAS bf16_t*)(lg + P5_VS + 14416 + c * 2)) * br, bf2f(*(const LAS bf16_t*)(lg + P5_KS + 14416 + c * 2)) * br * __expf(decg[53])}; ab1 = (f32x2){0.f, 0.f}; } ab0 -= mq[4][0] * xy[0]; ab1 -= mq[4][1] * xy[1]; ab0 -= mq[4][2] * xy[2]; ab1 -= mq[4][3] * xy[3]; mq[4] = *(const LAS f32x4*)(Mg + 3416);
            ab0 -= mq[5][0] * xy[4]; ab1 -= mq[5][1] * xy[5]; ab0 -= mq[5][2] * xy[6]; ab1 -= mq[5][3] * xy[7]; mq[5] = *(const LAS f32x4*)(Mg + 3420);
            ab0 -= mq[0][0] * xy[8]; ab1 -= mq[0][1] * xy[9]; ab0 -= mq[0][2] * xy[10]; ab1 -= mq[0][3] * xy[11]; mq[0] = *(const LAS f32x4*)(Mg + 3424);
            ab0 -= mq[1][0] * xy[12]; ab1 -= mq[1][1] * xy[13]; ab0 -= mq[1][2] * xy[14]; ab1 -= mq[1][3] * xy[15]; mq[1] = *(const LAS f32x4*)(Mg + 3428);
            ab0 -= mq[2][0] * xy[16]; ab1 -= mq[2][1] * xy[17]; ab0 -= mq[2][2] * xy[18]; ab1 -= mq[2][3] * xy[19]; mq[2] = *(const LAS f32x4*)(Mg + 3432);
            ab0 -= mq[3][0] * xy[20]; ab1 -= mq[3][1] * xy[21]; ab0 -= mq[3][2] * xy[22]; ab1 -= mq[3][3] * xy[23]; mq[3] = *(const LAS f32x4*)(Mg + 3436);
            ab0 -= mq[4][0] * xy[24]; ab1 -= mq[4][1] * xy[25]; ab0 -= mq[4][2] * xy[26]; ab1 -= mq[4][3] * xy[27]; mq[4] = *(const LAS f32x4*)(Mg + 3440);
            ab0 -= mq[5][0] * xy[28]; ab1 -= mq[5][1] * xy[29]; ab0 -= mq[5][2] * xy[30]; ab1 -= mq[5][3] * xy[31]; mq[5] = *(const LAS f32x4*)(Mg + 3444);
            ab0 -= mq[0][0] * xy[32]; ab1 -= mq[0][1] * xy[33]; ab0 -= mq[0][2] * xy[34]; ab1 -= mq[0][3] * xy[35]; mq[0] = *(const LAS f32x4*)(Mg + 3456);
            ab0 -= mq[1][0] * xy[36]; ab1 -= mq[1][1] * xy[37]; ab0 -= mq[1][2] * xy[38]; ab1 -= mq[1][3] * xy[39]; mq[1] = *(const LAS f32x4*)(Mg + 3460);
            ab0 -= mq[2][0] * xy[40]; ab1 -= mq[2][1] * xy[41]; ab0 -= mq[2][2] * xy[42]; ab1 -= mq[2][3] * xy[43]; mq[2] = *(const LAS f32x4*)(Mg + 3464);
            ab0 -= mq[3][0] * xy[44]; ab1 -= mq[3][1] * xy[45]; ab0 -= mq[3][2] * xy[46]; ab1 -= mq[3][3] * xy[47]; mq[3] = *(const LAS f32x4*)(Mg + 3468);
            ab0 -= mq[4][0] * xy[48]; ab1 -= mq[4][1] * xy[49]; ab0 -= mq[4][2] * xy[50]; ab1 -= mq[4][3] * xy[51]; mq[4] = *(const LAS f32x4*)(Mg + 3472);
            ab0 -= mq[5][0] * xy[52]; xy[53] = ab0 + ab1; up[6784] = xy[53][0]; wp[6784] = f2bf(-xy[53][1]); mq[5] = *(const LAS f32x4*)(Mg + 3476);
            { const float br = betg[54]; ab0 = (f32x2){bf2f(*(const LAS bf16_t*)(lg + P5_VS + 14688 + c * 2)) * br, bf2f(*(const LAS bf16_t*)(lg + P5_KS + 14688 + c * 2)) * br * __expf(decg[54])}; ab1 = (f32x2){0.f, 0.f}; } ab0 -= mq[0][0] * xy[0]; ab1 -= mq[0][1] * xy[1]; ab0 -= mq[0][2] * xy[2]; ab1 -= mq[0][3] * xy[3]; mq[0] = *(const LAS f32x4*)(Mg + 3480);
            ab0 -= mq[1][0] * xy[4]; ab1 -= mq[1][1] * xy[5]; ab0 -= mq[1][2] * xy[6]; ab1 -= mq[1][3] * xy[7]; mq[1] = *(const LAS f32x4*)(Mg + 3484);
            ab0 -= mq[2][0] * xy[8]; ab1 -= mq[2][1] * xy[9]; ab0 -= mq[2][2] * xy[10]; ab1 -= mq[2][3] * xy[11]; mq[2] = *(const LAS f32x4*)(Mg + 3488);
            ab0 -= mq[3][0] * xy[12]; ab1 -= mq[3][1] * xy[13]; ab0 -= mq[3][2] * xy[14]; ab1 -= mq[3][3] * xy[15]; mq[3] = *(const LAS f32x4*)(Mg + 3492);
            ab0 -= mq[4][0] * xy[16]; ab1 -= mq[4][1] * xy[17]; ab0 -= mq[4][2] * xy[18]; ab1 -= mq[4][3] * xy[19]; mq[4] = *(const LAS f32x4*)(Mg + 3496);
            ab0 -= mq[5][0] * xy[20]; ab1 -= mq[5][1] * xy[21]; ab0 -= mq[5][2] * xy[22]; ab1 -= mq[5][3] * xy[23]; mq[5] = *(const LAS f32x4*)(Mg + 3500);
            ab0 -= mq[0][0] * xy[24]; ab1 -= mq[0][1] * xy[25]; ab0 -= mq[0][2] * xy[26]; ab1 -= mq[0][3] * xy[27]; mq[0] = *(const LAS f32x4*)(Mg + 3504);
            ab0 -= mq[1][0] * xy[28]; ab1 -= mq[1][1] * xy[29]; ab0 -= mq[1][2] * xy[30]; ab1 -= mq[1][3] * xy[31]; mq[1] = *(const LAS f32x4*)(Mg + 3508);
            ab0 -= mq[2][0] * xy[32]; ab1 -= mq[2][1] * xy[33]; ab0 -= mq[2][2] * xy[34]; ab1 -= mq[2][3] * xy[35]; mq[2] = *(const LAS f32x4*)(Mg + 3520);
            ab0 -= mq[3][0] * xy[36]; ab1 -= mq[3][1] * xy[37]; ab0 -= mq[3][2] * xy[38]; ab1 -= mq[3][3] * xy[39]; mq[3] = *(const LAS f32x4*)(Mg + 3524);
            ab0 -= mq[4][0] * xy[40]; ab1 -= mq[4][1] * xy[41]; ab0 -= mq[4][2] * xy[42]; ab1 -= mq[4][3] * xy[43]; mq[4] = *(const LAS f32x4*)(Mg + 3528);
            ab0 -= mq[5][0] * xy[44]; ab1 -= mq[5][1] * xy[45]; ab0 -= mq[5][2] * xy[46]; ab1 -= mq[5][3] * xy[47]; mq[5] = *(const LAS f32x4*)(Mg + 3532);
            ab0 -= mq[0][0] * xy[48]; ab1 -= mq[0][1] * xy[49]; ab0 -= mq[0][2] * xy[50]; ab1 -= mq[0][3] * xy[51]; mq[0] = *(const LAS f32x4*)(Mg + 3536);
            ab0 -= mq[1][0] * xy[52]; ab1 -= mq[1][1] * xy[53]; xy[54] = ab0 + ab1; up[6912] = xy[54][0]; wp[6912] = f2bf(-xy[54][1]); mq[1] = *(const LAS f32x4*)(Mg + 3540);
            { const float br = betg[55]; ab0 = (f32x2){bf2f(*(const LAS bf16_t*)(lg + P5_VS + 14960 + c * 2)) * br, bf2f(*(const LAS bf16_t*)(lg + P5_KS + 14960 + c * 2)) * br * __expf(decg[55])}; ab1 = (f32x2){0.f, 0.f}; } ab0 -= mq[2][0] * xy[0]; ab1 -= mq[2][1] * xy[1]; ab0 -= mq[2][2] * xy[2]; ab1 -= mq[2][3] * xy[3]; mq[2] = *(const LAS f32x4*)(Mg + 3544);
            ab0 -= mq[3][0] * xy[4]; ab1 -= mq[3][1] * xy[5]; ab0 -= mq[3][2] * xy[6]; ab1 -= mq[3][3] * xy[7]; mq[3] = *(const LAS f32x4*)(Mg + 3548);
            ab0 -= mq[4][0] * xy[8]; ab1 -= mq[4][1] * xy[9]; ab0 -= mq[4][2] * xy[10]; ab1 -= mq[4][3] * xy[11]; mq[4] = *(const LAS f32x4*)(Mg + 3552);
            ab0 -= mq[5][0] * xy[12]; ab1 -= mq[5][1] * xy[13]; ab0 -= mq[5][2] * xy[14]; ab1 -= mq[5][3] * xy[15]; mq[5] = *(const LAS f32x4*)(Mg + 3556);
            ab0 -= mq[0][0] * xy[16]; ab1 -= mq[0][1] * xy[17]; ab0 -= mq[0][2] * xy[18]; ab1 -= mq[0][3] * xy[19]; mq[0] = *(const LAS f32x4*)(Mg + 3560);
            ab0 -= mq[1][0] * xy[20]; ab1 -= mq[1][1] * xy[21]; ab0 -= mq[1][2] * xy[22]; ab1 -= mq[1][3] * xy[23]; mq[1] = *(const LAS f32x4*)(Mg + 3564);
            ab0 -= mq[2][0] * xy[24]; ab1 -= mq[2][1] * xy[25]; ab0 -= mq[2][2] * xy[26]; ab1 -= mq[2][3] * xy[27]; mq[2] = *(const LAS f32x4*)(Mg + 3568);
            ab0 -= mq[3][0] * xy[28]; ab1 -= mq[3][1] * xy[29]; ab0 -= mq[3][2] * xy[30]; ab1 -= mq[3][3] * xy[31]; mq[3] = *(const LAS f32x4*)(Mg + 3572);
            ab0 -= mq[4][0] * xy[32]; ab1 -= mq[4][1] * xy[33]; ab0 -= mq[4][2] * xy[34]; ab1 -= mq[4][3] * xy[35]; mq[4] = *(const LAS f32x4*)(Mg + 3584);
            ab0 -= mq[5][0] * xy[36]; ab1 -= mq[5][1] * xy[37]; ab0 -= mq[5][2] * xy[38]; ab1 -= mq[5][3] * xy[39]; mq[5] = *(const LAS f32x4*)(Mg + 3588);
            ab0 -= mq[0][0] * xy[40]; ab1 -= mq[0][1] * xy[41]; ab0 -= mq[0][2] * xy[42]; ab1 -= mq[0][3] * xy[43]; mq[0] = *(const LAS f32x4*)(Mg + 3592);
            ab0 -= mq[1][0] * xy[44]; ab1 -= mq[1][1] * xy[45]; ab0 -= mq[1][2] * xy[46]; ab1 -= mq[1][3] * xy[47]; mq[1] = *(const LAS f32x4*)(Mg + 3596);
            ab0 -= mq[2][0] * xy[48]; ab1 -= mq[2][1] * xy[49]; ab0 -= mq[2][2] * xy[50]; ab1 -= mq[2][3] * xy[51]; mq[2] = *(const LAS f32x4*)(Mg + 3600);
            ab0 -= mq[3][0] * xy[52]; ab1 -= mq[3][1] * xy[53]; ab0 -= mq[3][2] * xy[54]; xy[55] = ab0 + ab1; up[7040] = xy[55][0]; wp[7040] = f2bf(-xy[55][1]); mq[3] = *(const LAS f32x4*)(Mg + 3604);
            { const float br = betg[56]; ab0 = (f32x2){bf2f(*(const LAS bf16_t*)(lg + P5_VS + 15232 + c * 2)) * br, bf2f(*(const LAS bf16_t*)(lg + P5_KS + 15232 + c * 2)) * br * __expf(decg[56])}; ab1 = (f32x2){0.f, 0.f}; } ab0 -= mq[4][0] * xy[0]; ab1 -= mq[4][1] * xy[1]; ab0 -= mq[4][2] * xy[2]; ab1 -= mq[4][3] * xy[3]; mq[4] = *(const LAS f32x4*)(Mg + 3608);
            ab0 -= mq[5][0] * xy[4]; ab1 -= mq[5][1] * xy[5]; ab0 -= mq[5][2] * xy[6]; ab1 -= mq[5][3] * xy[7]; mq[5] = *(const LAS f32x4*)(Mg + 3612);
            ab0 -= mq[0][0] * xy[8]; ab1 -= mq[0][1] * xy[9]; ab0 -= mq[0][2] * xy[10]; ab1 -= mq[0][3] * xy[11]; mq[0] = *(const LAS f32x4*)(Mg + 3616);
            ab0 -= mq[1][0] * xy[12]; ab1 -= mq[1][1] * xy[13]; ab0 -= mq[1][2] * xy[14]; ab1 -= mq[1][3] * xy[15]; mq[1] = *(const LAS f32x4*)(Mg + 3620);
            ab0 -= mq[2][0] * xy[16]; ab1 -= mq[2][1] * xy[17]; ab0 -= mq[2][2] * xy[18]; ab1 -= mq[2][3] * xy[19]; mq[2] = *(const LAS f32x4*)(Mg + 3624);
            ab0 -= mq[3][0] * xy[20]; ab1 -= mq[3][1] * xy[21]; ab0 -= mq[3][2] * xy[22]; ab1 -= mq[3][3] * xy[23]; mq[3] = *(const LAS f32x4*)(Mg + 3628);
            ab0 -= mq[4][0] * xy[24]; ab1 -= mq[4][1] * xy[25]; ab0 -= mq[4][2] * xy[26]; ab1 -= mq[4][3] * xy[27]; mq[4] = *(const LAS f32x4*)(Mg + 3632);
            ab0 -= mq[5][0] * xy[28]; ab1 -= mq[5][1] * xy[29]; ab0 -= mq[5][2] * xy[30]; ab1 -= mq[5][3] * xy[31]; mq[5] = *(const LAS f32x4*)(Mg + 3636);
            ab0 -= mq[0][0] * xy[32]; ab1 -= mq[0][1] * xy[33]; ab0 -= mq[0][2] * xy[34]; ab1 -= mq[0][3] * xy[35]; mq[0] = *(const LAS f32x4*)(Mg + 3648);
            ab0 -= mq[1][0] * xy[36]; ab1 -= mq[1][1] * xy[37]; ab0 -= mq[1][2] * xy[38]; ab1 -= mq[1][3] * xy[39]; mq[1] = *(const LAS f32x4*)(Mg + 3652);
            ab0 -= mq[2][0] * xy[40]; ab1 -= mq[2][1] * xy[41]; ab0 -= mq[2][2] * xy[42]; ab1 -= mq[2][3] * xy[43]; mq[2] = *(const LAS f32x4*)(Mg + 3656);
            ab0 -= mq[3][0] * xy[44]; ab1 -= mq[3][1] * xy[45]; ab0 -= mq[3][2] * xy[46]; ab1 -= mq[3][3] * xy[47]; mq[3] = *(const LAS f32x4*)(Mg + 3660);
            ab0 -= mq[4][0] * xy[48]; ab1 -= mq[4][1] * xy[49]; ab0 -= mq[4][2] * xy[50]; ab1 -= mq[4][3] * xy[51]; mq[4] = *(const LAS f32x4*)(Mg + 3664);
            ab0 -= mq[5][0] * xy[52]; ab1 -= mq[5][1] * xy[53]; ab0 -= mq[5][2] * xy[54]; ab1 -= mq[5][3] * xy[55]; xy[56] = ab0 + ab1; up[7168] = xy[56][0]; wp[7168] = f2bf(-xy[56][1]); mq[5] = *(const LAS f32x4*)(Mg + 3668);
            { const float br = betg[57]; ab0 = (f32x2){bf2f(*(const LAS bf16_t*)(lg + P5_VS + 15504 + c * 2)) * br, bf2f(*(const LAS bf16_t*)(lg + P5_KS + 15504 + c * 2)) * br * __expf(decg[57])}; ab1 = (f32x2){0.f, 0.f}; } ab0 -= mq[0][0] * xy[0]; ab1 -= mq[0][1] * xy[1]; ab0 -= mq[0][2] * xy[2]; ab1 -= mq[0][3] * xy[3]; mq[0] = *(const LAS f32x4*)(Mg + 3672);
            ab0 -= mq[1][0] * xy[4]; ab1 -= mq[1][1] * xy[5]; ab0 -= mq[1][2] * xy[6]; ab1 -= mq[1][3] * xy[7]; mq[1] = *(const LAS f32x4*)(Mg + 3676);
            ab0 -= mq[2][0] * xy[8]; ab1 -= mq[2][1] * xy[9]; ab0 -= mq[2][2] * xy[10]; ab1 -= mq[2][3] * xy[11]; mq[2] = *(const LAS f32x4*)(Mg + 3680);
            ab0 -= mq[3][0] * xy[12]; ab1 -= mq[3][1] * xy[13]; ab0 -= mq[3][2] * xy[14]; ab1 -= mq[3][3] * xy[15]; mq[3] = *(const LAS f32x4*)(Mg + 3684);
            ab0 -= mq[4][0] * xy[16]; ab1 -= mq[4][1] * xy[17]; ab0 -= mq[4][2] * xy[18]; ab1 -= mq[4][3] * xy[19]; mq[4] = *(const LAS f32x4*)(Mg + 3688);
            ab0 -= mq[5][0] * xy[20]; ab1 -= mq[5][1] * xy[21]; ab0 -= mq[5][2] * xy[22]; ab1 -= mq[5][3] * xy[23]; mq[5] = *(const LAS f32x4*)(Mg + 3692);
            ab0 -= mq[0][0] * xy[24]; ab1 -= mq[0][1] * xy[25]; ab0 -= mq[0][2] * xy[26]; ab1 -= mq[0][3] * xy[27]; mq[0] = *(const LAS f32x4*)(Mg + 3696);
            ab0 -= mq[1][0] * xy[28]; ab1 -= mq[1][1] * xy[29]; ab0 -= mq[1][2] * xy[30]; ab1 -= mq[1][3] * xy[31]; mq[1] = *(const LAS f32x4*)(Mg + 3700);
            ab0 -= mq[2][0] * xy[32]; ab1 -= mq[2][1] * xy[33]; ab0 -= mq[2][2] * xy[34]; ab1 -= mq[2][3] * xy[35]; mq[2] = *(const LAS f32x4*)(Mg + 3704);
            ab0 -= mq[3][0] * xy[36]; ab1 -= mq[3][1] * xy[37]; ab0 -= mq[3][2] * xy[38]; ab1 -= mq[3][3] * xy[39]; mq[3] = *(const LAS f32x4*)(Mg + 3712);
            ab0 -= mq[4][0] * xy[40]; ab1 -= mq[4][1] * xy[41]; ab0 -= mq[4][2] * xy[42]; ab1 -= mq[4][3] * xy[43]; mq[4] = *(const LAS f32x4*)(Mg + 3716);
            ab0 -= mq[5][0] * xy[44]; ab1 -= mq[5][1] * xy[45]; ab0 -= mq[5][2] * xy[46]; ab1 -= mq[5][3] * xy[47]; mq[5] = *(const LAS f32x4*)(Mg + 3720);
            ab0 -= mq[0][0] * xy[48]; ab1 -= mq[0][1] * xy[49]; ab0 -= mq[0][2] * xy[50]; ab1 -= mq[0][3] * xy[51]; mq[0] = *(const LAS f32x4*)(Mg + 3724);
            ab0 -= mq[1][0] * xy[52]; ab1 -= mq[1][1] * xy[53]; ab0 -= mq[1][2] * xy[54]; ab1 -= mq[1][3] * xy[55]; mq[1] = *(const LAS f32x4*)(Mg + 3728);
            ab0 -= mq[2][0] * xy[56]; xy[57] = ab0 + ab1; up[7296] = xy[57][0]; wp[7296] = f2bf(-xy[57][1]); mq[2] = *(const LAS f32x4*)(Mg + 3732);
            { const float br = betg[58]; ab0 = (f32x2){bf2f(*(const LAS bf16_t*)(lg + P5_VS + 15776 + c * 2)) * br, bf2f(*(const LAS bf16_t*)(lg + P5_KS + 15776 + c * 2)) * br * __expf(decg[58])}; ab1 = (f32x2){0.f, 0.f}; } ab0 -= mq[3][0] * xy[0]; ab1 -= mq[3][1] * xy[1]; ab0 -= mq[3][2] * xy[2]; ab1 -= mq[3][3] * xy[3]; mq[3] = *(const LAS f32x4*)(Mg + 3736);
            ab0 -= mq[4][0] * xy[4]; ab1 -= mq[4][1] * xy[5]; ab0 -= mq[4][2] * xy[6]; ab1 -= mq[4][3] * xy[7]; mq[4] = *(const LAS f32x4*)(Mg + 3740);
            ab0 -= mq[5][0] * xy[8]; ab1 -= mq[5][1] * xy[9]; ab0 -= mq[5][2] * xy[10]; ab1 -= mq[5][3] * xy[11]; mq[5] = *(const LAS f32x4*)(Mg + 3744);
            ab0 -= mq[0][0] * xy[12]; ab1 -= mq[0][1] * xy[13]; ab0 -= mq[0][2] * xy[14]; ab1 -= mq[0][3] * xy[15]; mq[0] = *(const LAS f32x4*)(Mg + 3748);
            ab0 -= mq[1][0] * xy[16]; ab1 -= mq[1][1] * xy[17]; ab0 -= mq[1][2] * xy[18]; ab1 -= mq[1][3] * xy[19]; mq[1] = *(const LAS f32x4*)(Mg + 3752);
            ab0 -= mq[2][0] * xy[20]; ab1 -= mq[2][1] * xy[21]; ab0 -= mq[2][2] * xy[22]; ab1 -= mq[2][3] * xy[23]; mq[2] = *(const LAS f32x4*)(Mg + 3756);
            ab0 -= mq[3][0] * xy[24]; ab1 -= mq[3][1] * xy[25]; ab0 -= mq[3][2] * xy[26]; ab1 -= mq[3][3] * xy[27]; mq[3] = *(const LAS f32x4*)(Mg + 3760);
            ab0 -= mq[4][0] * xy[28]; ab1 -= mq[4][1] * xy[29]; ab0 -= mq[4][2] * xy[30]; ab1 -= mq[4][3] * xy[31]; mq[4] = *(const LAS f32x4*)(Mg + 3764);
            ab0 -= mq[5][0] * xy[32]; ab1 -= mq[5][1] * xy[33]; ab0 -= mq[5][2] * xy[34]; ab1 -= mq[5][3] * xy[35]; mq[5] = *(const LAS f32x4*)(Mg + 3768);
            ab0 -= mq[0][0] * xy[36]; ab1 -= mq[0][1] * xy[37]; ab0 -= mq[0][2] * xy[38]; ab1 -= mq[0][3] * xy[39]; mq[0] = *(const LAS f32x4*)(Mg + 3776);
            ab0 -= mq[1][0] * xy[40]; ab1 -= mq[1][1] * xy[41]; ab0 -= mq[1][2] * xy[42]; ab1 -= mq[1][3] * xy[43]; mq[1] = *(const LAS f32x4*)(Mg + 3780);
            ab0 -= mq[2][0] * xy[44]; ab1 -= mq[2][1] * xy[45]; ab0 -= mq[2][2] * xy[46]; ab1 -= mq[2][3] * xy[47]; mq[2] = *(const LAS f32x4*)(Mg + 3784);
            ab0 -= mq[3][0] * xy[48]; ab1 -= mq[3][1] * xy[49]; ab0 -= mq[3][2] * xy[50]; ab1 -= mq[3][3] * xy[51]; mq[3] = *(const LAS f32x4*)(Mg + 3788);
            ab0 -= mq[4][0] * xy[52]; ab1 -= mq[4][1] * xy[53]; ab0 -= mq[4][2] * xy[54]; ab1 -= mq[4][3] * xy[55]; mq[4] = *(const LAS f32x4*)(Mg + 3792);
            ab0 -= mq[5][0] * xy[56]; ab1 -= mq[5][1] * xy[57]; xy[58] = ab0 + ab1; up[7424] = xy[58][0]; wp[7424] = f2bf(-xy[58][1]); mq[5] = *(const LAS f32x4*)(Mg + 3796);
            { const float br = betg[59]; ab0 = (f32x2){bf2f(*(const LAS bf16_t*)(lg + P5_VS + 16048 + c * 2)) * br, bf2f(*(const LAS bf16_t*)(lg + P5_KS + 16048 + c * 2)) * br * __expf(decg[59])}; ab1 = (f32x2){0.f, 0.f}; } ab0 -= mq[0][0] * xy[0]; ab1 -= mq[0][1] * xy[1]; ab0 -= mq[0][2] * xy[2]; ab1 -= mq[0][3] * xy[3]; mq[0] = *(const LAS f32x4*)(Mg + 3800);
            ab0 -= mq[1][0] * xy[4]; ab1 -= mq[1][1] * xy[5]; ab0 -= mq[1][2] * xy[6]; ab1 -= mq[1][3] * xy[7]; mq[1] = *(const LAS f32x4*)(Mg + 3804);
            ab0 -= mq[2][0] * xy[8]; ab1 -= mq[2][1] * xy[9]; ab0 -= mq[2][2] * xy[10]; ab1 -= mq[2][3] * xy[11]; mq[2] = *(const LAS f32x4*)(Mg + 3808);
            ab0 -= mq[3][0] * xy[12]; ab1 -= mq[3][1] * xy[13]; ab0 -= mq[3][2] * xy[14]; ab1 -= mq[3][3] * xy[15]; mq[3] = *(const LAS f32x4*)(Mg + 3812);
            ab0 -= mq[4][0] * xy[16]; ab1 -= mq[4][1] * xy[17]; ab0 -= mq[4][2] * xy[18]; ab1 -= mq[4][3] * xy[19]; mq[4] = *(const LAS f32x4*)(Mg + 3816);
            ab0 -= mq[5][0] * xy[20]; ab1 -= mq[5][1] * xy[21]; ab0 -= mq[5][2] * xy[22]; ab1 -= mq[5][3] * xy[23]; mq[5] = *(const LAS f32x4*)(Mg + 3820);
            ab0 -= mq[0][0] * xy[24]; ab1 -= mq[0][1] * xy[25]; ab0 -= mq[0][2] * xy[26]; ab1 -= mq[0][3] * xy[27]; mq[0] = *(const LAS f32x4*)(Mg + 3824);
            ab0 -= mq[1][0] * xy[28]; ab1 -= mq[1][1] * xy[29]; ab0 -= mq[1][2] * xy[30]; ab1 -= mq[1][3] * xy[31]; mq[1] = *(const LAS f32x4*)(Mg + 3828);
            ab0 -= mq[2][0] * xy[32]; ab1 -= mq[2][1] * xy[33]; ab0 -= mq[2][2] * xy[34]; ab1 -= mq[2][3] * xy[35]; mq[2] = *(const LAS f32x4*)(Mg + 3832);
            ab0 -= mq[3][0] * xy[36]; ab1 -= mq[3][1] * xy[37]; ab0 -= mq[3][2] * xy[38]; ab1 -= mq[3][3] * xy[39]; mq[3] = *(const LAS f32x4*)(Mg + 3840);
            ab0 -= mq[4][0] * xy[40]; ab1 -= mq[4][1] * xy[41]; ab0 -= mq[4][2] * xy[42]; ab1 -= mq[4][3] * xy[43]; mq[4] = *(const LAS f32x4*)(Mg + 3844);
            ab0 -= mq[5][0] * xy[44]; ab1 -= mq[5][1] * xy[45]; ab0 -= mq[5][2] * xy[46]; ab1 -= mq[5][3] * xy[47]; mq[5] = *(const LAS f32x4*)(Mg + 3848);
            ab0 -= mq[0][0] * xy[48]; ab1 -= mq[0][1] * xy[49]; ab0 -= mq[0][2] * xy[50]; ab1 -= mq[0][3] * xy[51]; mq[0] = *(const LAS f32x4*)(Mg + 3852);
            ab0 -= mq[1][0] * xy[52]; ab1 -= mq[1][1] * xy[53]; ab0 -= mq[1][2] * xy[54]; ab1 -= mq[1][3] * xy[55]; mq[1] = *(const LAS f32x4*)(Mg + 3856);
            ab0 -= mq[2][0] * xy[56]; ab1 -= mq[2][1] * xy[57]; ab0 -= mq[2][2] * xy[58]; xy[59] = ab0 + ab1; up[7552] = xy[59][0]; wp[7552] = f2bf(-xy[59][1]); mq[2] = *(const LAS f32x4*)(Mg + 3860);
            { const float br = betg[60]; ab0 = (f32x2){bf2f(*(const LAS bf16_t*)(lg + P5_VS + 16320 + c * 2)) * br, bf2f(*(const LAS bf16_t*)(lg + P5_KS + 16320 + c * 2)) * br * __expf(decg[60])}; ab1 = (f32x2){0.f, 0.f}; } ab0 -= mq[3][0] * xy[0]; ab1 -= mq[3][1] * xy[1]; ab0 -= mq[3][2] * xy[2]; ab1 -= mq[3][3] * xy[3]; mq[3] = *(const LAS f32x4*)(Mg + 3864);
            ab0 -= mq[4][0] * xy[4]; ab1 -= mq[4][1] * xy[5]; ab0 -= mq[4][2] * xy[6]; ab1 -= mq[4][3] * xy[7]; mq[4] = *(const LAS f32x4*)(Mg + 3868);
            ab0 -= mq[5][0] * xy[8]; ab1 -= mq[5][1] * xy[9]; ab0 -= mq[5][2] * xy[10]; ab1 -= mq[5][3] * xy[11]; mq[5] = *(const LAS f32x4*)(Mg + 3872);
            ab0 -= mq[0][0] * xy[12]; ab1 -= mq[0][1] * xy[13]; ab0 -= mq[0][2] * xy[14]; ab1 -= mq[0][3] * xy[15]; mq[0] = *(const LAS f32x4*)(Mg + 3876);
            ab0 -= mq[1][0] * xy[16]; ab1 -= mq[1][1] * xy[17]; ab0 -= mq[1][2] * xy[18]; ab1 -= mq[1][3] * xy[19]; mq[1] = *(const LAS f32x4*)(Mg + 3880);
            ab0 -= mq[2][0] * xy[20]; ab1 -= mq[2][1] * xy[21]; ab0 -= mq[2][2] * xy[22]; ab1 -= mq[2][3] * xy[23]; mq[2] = *(const LAS f32x4*)(Mg + 3884);
            ab0 -= mq[3][0] * xy[24]; ab1 -= mq[3][1] * xy[25]; ab0 -= mq[3][2] * xy[26]; ab1 -= mq[3][3] * xy[27]; mq[3] = *(const LAS f32x4*)(Mg + 3888);
            ab0 -= mq[4][0] * xy[28]; ab1 -= mq[4][1] * xy[29]; ab0 -= mq[4][2] * xy[30]; ab1 -= mq[4][3] * xy[31]; mq[4] = *(const LAS f32x4*)(Mg + 3892);
            ab0 -= mq[5][0] * xy[32]; ab1 -= mq[5][1] * xy[33]; ab0 -= mq[5][2] * xy[34]; ab1 -= mq[5][3] * xy[35]; mq[5] = *(const LAS f32x4*)(Mg + 3896);
            ab0 -= mq[0][0] * xy[36]; ab1 -= mq[0][1] * xy[37]; ab0 -= mq[0][2] * xy[38]; ab1 -= mq[0][3] * xy[39]; mq[0] = *(const LAS f32x4*)(Mg + 3904);
            ab0 -= mq[1][0] * xy[40]; ab1 -= mq[1][1] * xy[41]; ab0 -= mq[1][2] * xy[42]; ab1 -= mq[1][3] * xy[43]; mq[1] = *(const LAS f32x4*)(Mg + 3908);
            ab0 -= mq[2][0] * xy[44]; ab1 -= mq[2][1] * xy[45]; ab0 -= mq[2][2] * xy[46]; ab1 -= mq[2][3] * xy[47]; mq[2] = *(const LAS f32x4*)(Mg + 3912);
            ab0 -= mq[3][0] * xy[48]; ab1 -= mq[3][1] * xy[49]; ab0 -= mq[3][2] * xy[50]; ab1 -= mq[3][3] * xy[51]; mq[3] = *(const LAS f32x4*)(Mg + 3916);
            ab0 -= mq[4][0] * xy[52]; ab1 -= mq[4][1] * xy[53]; ab0 -= mq[4][2] * xy[54]; ab1 -= mq[4][3] * xy[55]; mq[4] = *(const LAS f32x4*)(Mg + 3920);
            ab0 -= mq[5][0] * xy[56]; ab1 -= mq[5][1] * xy[57]; ab0 -= mq[5][2] * xy[58]; ab1 -= mq[5][3] * xy[59]; xy[60] = ab0 + ab1; up[7680] = xy[60][0]; wp[7680] = f2bf(-xy[60][1]); mq[5] = *(const LAS f32x4*)(Mg + 3924);
            { const float br = betg[61]; ab0 = (f32x2){bf2f(*(const LAS bf16_t*)(lg + P5_VS + 16592 + c * 2)) * br, bf2f(*(const LAS bf16_t*)(lg + P5_KS + 16592 + c * 2)) * br * __expf(decg[61])}; ab1 = (f32x2){0.f, 0.f}; } ab0 -= mq[0][0] * xy[0]; ab1 -= mq[0][1] * xy[1]; ab0 -= mq[0][2] * xy[2]; ab1 -= mq[0][3] * xy[3]; mq[0] = *(const LAS f32x4*)(Mg + 3928);
            ab0 -= mq[1][0] * xy[4]; ab1 -= mq[1][1] * xy[5]; ab0 -= mq[1][2] * xy[6]; ab1 -= mq[1][3] * xy[7]; mq[1] = *(const LAS f32x4*)(Mg + 3932);
            ab0 -= mq[2][0] * xy[8]; ab1 -= mq[2][1] * xy[9]; ab0 -= mq[2][2] * xy[10]; ab1 -= mq[2][3] * xy[11]; mq[2] = *(const LAS f32x4*)(Mg + 3936);
            ab0 -= mq[3][0] * xy[12]; ab1 -= mq[3][1] * xy[13]; ab0 -= mq[3][2] * xy[14]; ab1 -= mq[3][3] * xy[15]; mq[3] = *(const LAS f32x4*)(Mg + 3940);
            ab0 -= mq[4][0] * xy[16]; ab1 -= mq[4][1] * xy[17]; ab0 -= mq[4][2] * xy[18]; ab1 -= mq[4][3] * xy[19]; mq[4] = *(const LAS f32x4*)(Mg + 3944);
            ab0 -= mq[5][0] * xy[20]; ab1 -= mq[5][1] * xy[21]; ab0 -= mq[5][2] * xy[22]; ab1 -= mq[5][3] * xy[23]; mq[5] = *(const LAS f32x4*)(Mg + 3948);
            ab0 -= mq[0][0] * xy[24]; ab1 -= mq[0][1] * xy[25]; ab0 -= mq[0][2] * xy[26]; ab1 -= mq[0][3] * xy[27]; mq[0] = *(const LAS f32x4*)(Mg + 3952);
            ab0 -= mq[1][0] * xy[28]; ab1 -= mq[1][1] * xy[29]; ab0 -= mq[1][2] * xy[30]; ab1 -= mq[1][3] * xy[31]; mq[1] = *(const LAS f32x4*)(Mg + 3956);
            ab0 -= mq[2][0] * xy[32]; ab1 -= mq[2][1] * xy[33]; ab0 -= mq[2][2] * xy[34]; ab1 -= mq[2][3] * xy[35]; mq[2] = *(const LAS f32x4*)(Mg + 3960);
            ab0 -= mq[3][0] * xy[36]; ab1 -= mq[3][1] * xy[37]; ab0 -= mq[3][2] * xy[38]; ab1 -= mq[3][3] * xy[39]; mq[3] = *(const LAS f32x4*)(Mg + 3964);
            ab0 -= mq[4][0] * xy[40]; ab1 -= mq[4][1] * xy[41]; ab0 -= mq[4][2] * xy[42]; ab1 -= mq[4][3] * xy[43]; mq[4] = *(const LAS f32x4*)(Mg + 3968);
            ab0 -= mq[5][0] * xy[44]; ab1 -= mq[5][1] * xy[45]; ab0 -= mq[5][2] * xy[46]; ab1 -= mq[5][3] * xy[47]; mq[5] = *(const LAS f32x4*)(Mg + 3972);
            ab0 -= mq[0][0] * xy[48]; ab1 -= mq[0][1] * xy[49]; ab0 -= mq[0][2] * xy[50]; ab1 -= mq[0][3] * xy[51]; mq[0] = *(const LAS f32x4*)(Mg + 3976);
            ab0 -= mq[1][0] * xy[52]; ab1 -= mq[1][1] * xy[53]; ab0 -= mq[1][2] * xy[54]; ab1 -= mq[1][3] * xy[55]; mq[1] = *(const LAS f32x4*)(Mg + 3980);
            ab0 -= mq[2][0] * xy[56]; ab1 -= mq[2][1] * xy[57]; ab0 -= mq[2][2] * xy[58]; ab1 -= mq[2][3] * xy[59]; mq[2] = *(const LAS f32x4*)(Mg + 3984);
            ab0 -= mq[3][0] * xy[60]; xy[61] = ab0 + ab1; up[7808] = xy[61][0]; wp[7808] = f2bf(-xy[61][1]); mq[3] = *(const LAS f32x4*)(Mg + 3988);
            { const float br = betg[62]; ab0 = (f32x2){bf2f(*(const LAS bf16_t*)(lg + P5_VS + 16864 + c * 2)) * br, bf2f(*(const LAS bf16_t*)(lg + P5_KS + 16864 + c * 2)) * br * __expf(decg[62])}; ab1 = (f32x2){0.f, 0.f}; } ab0 -= mq[4][0] * xy[0]; ab1 -= mq[4][1] * xy[1]; ab0 -= mq[4][2] * xy[2]; ab1 -= mq[4][3] * xy[3]; mq[4] = *(const LAS f32x4*)(Mg + 3992);
            ab0 -= mq[5][0] * xy[4]; ab1 -= mq[5][1] * xy[5]; ab0 -= mq[5][2] * xy[6]; ab1 -= mq[5][3] * xy[7]; mq[5] = *(const LAS f32x4*)(Mg + 3996);
            ab0 -= mq[0][0] * xy[8]; ab1 -= mq[0][1] * xy[9]; ab0 -= mq[0][2] * xy[10]; ab1 -= mq[0][3] * xy[11]; mq[0] = *(const LAS f32x4*)(Mg + 4000);
            ab0 -= mq[1][0] * xy[12]; ab1 -= mq[1][1] * xy[13]; ab0 -= mq[1][2] * xy[14]; ab1 -= mq[1][3] * xy[15]; mq[1] = *(const LAS f32x4*)(Mg + 4004);
            ab0 -= mq[2][0] * xy[16]; ab1 -= mq[2][1] * xy[17]; ab0 -= mq[2][2] * xy[18]; ab1 -= mq[2][3] * xy[19]; mq[2] = *(const LAS f32x4*)(Mg + 4008);
            ab0 -= mq[3][0] * xy[20]; ab1 -= mq[3][1] * xy[21]; ab0 -= mq[3][2] * xy[22]; ab1 -= mq[3][3] * xy[23]; mq[3] = *(const LAS f32x4*)(Mg + 4012);
            ab0 -= mq[4][0] * xy[24]; ab1 -= mq[4][1] * xy[25]; ab0 -= mq[4][2] * xy[26]; ab1 -= mq[4][3] * xy[27]; mq[4] = *(const LAS f32x4*)(Mg + 4016);
            ab0 -= mq[5][0] * xy[28]; ab1 -= mq[5][1] * xy[29]; ab0 -= mq[5][2] * xy[30]; ab1 -= mq[5][3] * xy[31]; mq[5] = *(const LAS f32x4*)(Mg + 4020);
            ab0 -= mq[0][0] * xy[32]; ab1 -= mq[0][1] * xy[33]; ab0 -= mq[0][2] * xy[34]; ab1 -= mq[0][3] * xy[35]; mq[0] = *(const LAS f32x4*)(Mg + 4024);
            ab0 -= mq[1][0] * xy[36]; ab1 -= mq[1][1] * xy[37]; ab0 -= mq[1][2] * xy[38]; ab1 -= mq[1][3] * xy[39]; mq[1] = *(const LAS f32x4*)(Mg + 4028);
            ab0 -= mq[2][0] * xy[40]; ab1 -= mq[2][1] * xy[41]; ab0 -= mq[2][2] * xy[42]; ab1 -= mq[2][3] * xy[43]; mq[2] = *(const LAS f32x4*)(Mg + 4032);
            ab0 -= mq[3][0] * xy[44]; ab1 -= mq[3][1] * xy[45]; ab0 -= mq[3][2] * xy[46]; ab1 -= mq[3][3] * xy[47]; mq[3] = *(const LAS f32x4*)(Mg + 4036);
            ab0 -= mq[4][0] * xy[48]; ab1 -= mq[4][1] * xy[49]; ab0 -= mq[4][2] * xy[50]; ab1 -= mq[4][3] * xy[51]; mq[4] = *(const LAS f32x4*)(Mg + 4040);
            ab0 -= mq[5][0] * xy[52]; ab1 -= mq[5][1] * xy[53]; ab0 -= mq[5][2] * xy[54]; ab1 -= mq[5][3] * xy[55]; mq[5] = *(const LAS f32x4*)(Mg + 4044);
            ab0 -= mq[0][0] * xy[56]; ab1 -= mq[0][1] * xy[57]; ab0 -= mq[0][2] * xy[58]; ab1 -= mq[0][3] * xy[59]; mq[0] = *(const LAS f32x4*)(Mg + 4048);
            ab0 -= mq[1][0] * xy[60]; ab1 -= mq[1][1] * xy[61]; xy[62] = ab0 + ab1; up[7936] = xy[62][0]; wp[7936] = f2bf(-xy[62][1]); mq[1] = *(const LAS f32x4*)(Mg + 4052);
            { const float br = betg[63]; ab0 = (f32x2){bf2f(*(const LAS bf16_t*)(lg + P5_VS + 17136 + c * 2)) * br, bf2f(*(const LAS bf16_t*)(lg + P5_KS + 17136 + c * 2)) * br * __expf(decg[63])}; ab1 = (f32x2){0.f, 0.f}; } ab0 -= mq[2][0] * xy[0]; ab1 -= mq[2][1] * xy[1]; ab0 -= mq[2][2] * xy[2]; ab1 -= mq[2][3] * xy[3]; mq[2] = *(const LAS f32x4*)(Mg + 4056);
            ab0 -= mq[3][0] * xy[4]; ab1 -= mq[3][1] * xy[5]; ab0 -= mq[3][2] * xy[6]; ab1 -= mq[3][3] * xy[7]; mq[3] = *(const LAS f32x4*)(Mg + 4060);
            ab0 -= mq[4][0] * xy[8]; ab1 -= mq[4][1] * xy[9]; ab0 -= mq[4][2] * xy[10]; ab1 -= mq[4][3] * xy[11]; mq[4] = *(const LAS f32x4*)(Mg + 4064);
            ab0 -= mq[5][0] * xy[12]; ab1 -= mq[5][1] * xy[13]; ab0 -= mq[5][2] * xy[14]; ab1 -= mq[5][3] * xy[15]; mq[5] = *(const LAS f32x4*)(Mg + 4068);
            ab0 -= mq[0][0] * xy[16]; ab1 -= mq[0][1] * xy[17]; ab0 -= mq[0][2] * xy[18]; ab1 -= mq[0][3] * xy[19]; mq[0] = *(const LAS f32x4*)(Mg + 4072);
            ab0 -= mq[1][0] * xy[20]; ab1 -= mq[1][1] * xy[21]; ab0 -= mq[1][2] * xy[22]; ab1 -= mq[1][3] * xy[23]; mq[1] = *(const LAS f32x4*)(Mg + 4076);
            ab0 -= mq[2][0] * xy[24]; ab1 -= mq[2][1] * xy[25]; ab0 -= mq[2][2] * xy[26]; ab1 -= mq[2][3] * xy[27]; mq[2] = *(const LAS f32x4*)(Mg + 4080);
            ab0 -= mq[3][0] * xy[28]; ab1 -= mq[3][1] * xy[29]; ab0 -= mq[3][2] * xy[30]; ab1 -= mq[3][3] * xy[31]; mq[3] = *(const LAS f32x4*)(Mg + 4084);
            ab0 -= mq[4][0] * xy[32]; ab1 -= mq[4][1] * xy[33]; ab0 -= mq[4][2] * xy[34]; ab1 -= mq[4][3] * xy[35]; mq[4] = *(const LAS f32x4*)(Mg + 4088);
            ab0 -= mq[5][0] * xy[36]; ab1 -= mq[5][1] * xy[37]; ab0 -= mq[5][2] * xy[38]; ab1 -= mq[5][3] * xy[39]; mq[5] = *(const LAS f32x4*)(Mg + 4092);
            ab0 -= mq[0][0] * xy[40]; ab1 -= mq[0][1] * xy[41]; ab0 -= mq[0][2] * xy[42]; ab1 -= mq[0][3] * xy[43];
            ab0 -= mq[1][0] * xy[44]; ab1 -= mq[1][1] * xy[45]; ab0 -= mq[1][2] * xy[46]; ab1 -= mq[1][3] * xy[47];
            ab0 -= mq[2][0] * xy[48]; ab1 -= mq[2][1] * xy[49]; ab0 -= mq[2][2] * xy[50]; ab1 -= mq[2][3] * xy[51];
            ab0 -= mq[3][0] * xy[52]; ab1 -= mq[3][1] * xy[53]; ab0 -= mq[3][2] * xy[54]; ab1 -= mq[3][3] * xy[55];
            ab0 -= mq[4][0] * xy[56]; ab1 -= mq[4][1] * xy[57]; ab0 -= mq[4][2] * xy[58]; ab1 -= mq[4][3] * xy[59];
            ab0 -= mq[5][0] * xy[60]; ab1 -= mq[5][1] * xy[61]; ab0 -= mq[5][2] * xy[62]; xy[63] = ab0 + ab1; up[8064] = xy[63][0]; wp[8064] = f2bf(-xy[63][1]);
        } else {
            const int g2 = (w8 - 4) >> 1, tt = ((w8 - 4) & 1) * 64 + lane; const int item2 = it0 + g2;
            LAS unsigned char* lg = lds0 + g2 * P5_GRP; LAS float* decg = (LAS float*)(lg + P5_DEC);
            const float lastg = decg[63];
#pragma unroll
            for (int i = 0; i < 8; ++i) { const int vid = tt + 128 * i, r = vid >> 4, d0 = (vid & 15) * 8; float f[8]; unpack8(*(const LAS u32x4*)(lg + P5_QS + r * 272 + d0 * 2), f);
                const float e = scale * __expf(decg[r]);
#pragma unroll
                for (int q = 0; q < 8; ++q) f[q] *= e;
                *(u32x4*)(qd + (size_t)item2 * 8192 + r * 128 + d0) = pack8(f); }
#pragma unroll
            for (int i = 0; i < 8; ++i) { const int vid = tt + 128 * i, d = vid >> 3, rg = (vid & 7) * 8; float f[8];
#pragma unroll
                for (int q = 0; q < 8; ++q) f[q] = bf2f(*(const LAS bf16_t*)(lg + P5_KS + (rg + q) * 272 + d * 2)) * __expf(lastg - decg[rg + q]);
                *(u32x4*)(kt + (size_t)item2 * 8192 + d * 64 + rg) = pack8(f); }
            if (tt == 0) cdv[item2] = __expf(lastg);
        }
    }
    __syncthreads();
}

constexpr int SB_WD = 0, SB_QD = 17408, SB_KT = 34816, SB_QK = 53248, SB_UB = 62464, SB_SIZE = 66560;
constexpr int SC_ST = 2 * SB_SIZE, SC_UT = SC_ST + 4352, SC_END = SC_UT + 2304;
static_assert(SC_END <= LDS_BYTES, "lds");
__device__ __forceinline__ void scan_phase(const Params& p, int bid, int nblk, LAS unsigned char* lds) {
    const int tid = threadIdx.x, lane = tid & 63, wid = __builtin_amdgcn_readfirstlane(tid >> 6), fr = lane & 15, fq = lane >> 4;
    const bf16_t* wdc = (const bf16_t*)(p.ws + WS_WDC); const bf16_t* qd = (const bf16_t*)(p.ws + WS_QD); const bf16_t* kt = (const bf16_t*)(p.ws + WS_KT); const bf16_t* qk = (const bf16_t*)(p.ws + WS_QK);
    const float* cdv = (const float*)(p.ws + WS_CD); const float* ub = p.out + OS_UB; float* obuf = p.out + OS_O;
    for (int item = bid; item < 256; item += nblk) {
        const int xcd = item & 7, iq = item >> 3, bh = xcd * 4 + (iq >> 3), sl = iq & 7, h = bh & 7, b = bh >> 3;
        u32x4 r_wd[2], r_qd[2], r_kt[2], r_qk, r_ub;
        auto gload = [&](int n) {
            const size_t it = (size_t)(bh * 32 + n);
#pragma unroll
            for (int i = 0; i < 2; ++i) { const int ch = tid + 512 * i; r_wd[i] = *(const u32x4*)(wdc + it * 8192 + ch * 8); r_qd[i] = *(const u32x4*)(qd + it * 8192 + ch * 8); r_kt[i] = *(const u32x4*)(kt + it * 8192 + ch * 8); }
            r_qk = *(const u32x4*)(qk + it * 4096 + tid * 8);
            if (tid < 256) r_ub = *(const u32x4*)(ub + it * 8192 + (tid >> 2) * 128 + sl * 16 + (tid & 3) * 4);
        };
        auto lstore = [&](int buf) {
            LAS unsigned char* B = lds + buf * SB_SIZE;
#pragma unroll
            for (int i = 0; i < 2; ++i) { const int ch = tid + 512 * i; const int r = ch >> 4, c8 = (ch & 15) * 8; *(LAS u32x4*)(B + SB_WD + r * 272 + c8 * 2) = r_wd[i]; *(LAS u32x4*)(B + SB_QD + r * 272 + c8 * 2) = r_qd[i];
                const int d = ch >> 3, t8 = (ch & 7) * 8; *(LAS u32x4*)(B + SB_KT + d * 144 + t8 * 2) = r_kt[i]; }
            { const int r = tid >> 3, s8 = (tid & 7) * 8; *(LAS u32x4*)(B + SB_QK + r * 144 + s8 * 2) = r_qk; }
            if (tid < 256) *(LAS u32x4*)(B + SB_UB + (tid >> 2) * 64 + (tid & 3) * 16) = r_ub;
        };
        __syncthreads();
        gload(0);
        for (int i = tid; i < 4352 / 4; i += 512) *(LAS unsigned*)(lds + SC_ST + i * 4) = 0u;
        lstore(0);
        f32x4 sacc = (f32x4){0.f, 0.f, 0.f, 0.f};
        const float cdall = cdv[bh * 32 + (lane & 31)];
        __syncthreads();
        for (int n = 0; n < 32; ++n) {
            const int cur = n & 1; LAS unsigned char* B = lds + cur * SB_SIZE;
            if (n + 1 < 32) gload(n + 1);
            const float cd = __builtin_bit_cast(float, __builtin_amdgcn_readlane(__builtin_bit_cast(int, cdall), n));
            f32x4 acc;
            const int tw = wid & 3;
            if (wid < 4) {
#pragma unroll
                for (int j = 0; j < 4; ++j) acc[j] = *(const LAS float*)(B + SB_UB + ((tw * 16 + fq * 4 + j) * 16 + fr) * 4);
#pragma unroll
                for (int kk = 0; kk < 4; ++kk) { const bf16x8 a = *(const LAS bf16x8*)(B + SB_WD + (tw * 16 + fr) * 272 + (kk * 32 + fq * 8) * 2); const bf16x8 bb = *(const LAS bf16x8*)(lds + SC_ST + fr * 272 + (kk * 32 + fq * 8) * 2);
                    acc = __builtin_amdgcn_mfma_f32_16x16x32_bf16(a, bb, acc, 0, 0, 0); }
                u32x2 w; w.x = pk2(acc[0], acc[1]); w.y = pk2(acc[2], acc[3]);
                *(LAS u32x2*)(lds + SC_UT + fr * 144 + (tw * 16 + fq * 4) * 2) = w;
            } else {
                acc = (f32x4){0.f, 0.f, 0.f, 0.f};
#pragma unroll
                for (int kk = 0; kk < 4; ++kk) { const bf16x8 a = *(const LAS bf16x8*)(B + SB_QD + (tw * 16 + fr) * 272 + (kk * 32 + fq * 8) * 2); const bf16x8 bb = *(const LAS bf16x8*)(lds + SC_ST + fr * 272 + (kk * 32 + fq * 8) * 2);
                    acc = __builtin_amdgcn_mfma_f32_16x16x32_bf16(a, bb, acc, 0, 0, 0); }
            }
            __syncthreads();
            sacc *= cd;
#pragma unroll
            for (int kk = 0; kk < 2; ++kk) { const bf16x8 a = *(const LAS bf16x8*)(B + SB_KT + (wid * 16 + fr) * 144 + (kk * 32 + fq * 8) * 2); const bf16x8 bb = *(const LAS bf16x8*)(lds + SC_UT + fr * 144 + (kk * 32 + fq * 8) * 2);
                sacc = __builtin_amdgcn_mfma_f32_16x16x32_bf16(a, bb, sacc, 0, 0, 0); }
            if (wid >= 4) {
#pragma unroll
                for (int kk = 0; kk < 2; ++kk) { const bf16x8 a = *(const LAS bf16x8*)(B + SB_QK + (tw * 16 + fr) * 144 + (kk * 32 + fq * 8) * 2); const bf16x8 bb = *(const LAS bf16x8*)(lds + SC_UT + fr * 144 + (kk * 32 + fq * 8) * 2);
                    acc = __builtin_amdgcn_mfma_f32_16x16x32_bf16(a, bb, acc, 0, 0, 0); }
#pragma unroll
                for (int j = 0; j < 4; ++j) obuf[(size_t)(b * 2048 + n * 64 + tw * 16 + fq * 4 + j) * 1024 + h * 128 + sl * 16 + fr] = acc[j];
            }
            { u32x2 w; w.x = pk2(sacc[0], sacc[1]); w.y = pk2(sacc[2], sacc[3]); *(LAS u32x2*)(lds + SC_ST + fr * 272 + (wid * 16 + fq * 4) * 2) = w; }
            if (n + 1 < 32) lstore(cur ^ 1);
            __syncthreads();
        }
#pragma unroll
        for (int j = 0; j < 4; ++j) p.out[O_DP + ((size_t)bh * 128 + wid * 16 + fq * 4 + j) * 128 + sl * 16 + fr] = sacc[j];
    }
    __syncthreads();
    {
        const bf16_t* qn = (const bf16_t*)(p.ws + WS_QN); const bf16_t* kn = (const bf16_t*)(p.ws + WS_KN); const bf16_t* vv = (const bf16_t*)(p.ws + WS_VV);
        const float* gbuf = (const float*)(p.ws + WS_G); const float* bbuf = (const float*)(p.ws + WS_BETA);
        const int grp = tid >> 8, w4 = __builtin_amdgcn_readfirstlane(tid >> 6) & 3, j = w4 * 32 + (lane & 31), half = lane >> 5;
        LAS float* qs = (LAS float*)lds + grp * 1024;
        LAS float* ks = qs + 512;
        const float scale = 0.08838834764831845f;
        for (int it0 = bid * 2; it0 < 1024; it0 += nblk * 2) {
            const int item = it0 + grp, sb = item >> 3, h = item & 7;
            __syncthreads();
#pragma unroll
            for (int i = 0; i < 4; ++i) { const int idx = (tid & 255) + 256 * i, tk = idx >> 7, c = idx & 127, t = tk & 3; const size_t go = (size_t)(TP + sb * 4 + t) * 1024 + h * 128 + c;
                if (tk < 4) qs[t * 128 + c] = bf2f(qn[go]); else ks[t * 128 + c] = bf2f(kn[go]); }
            float S[64];
            const float* s0 = p.in[4] + (size_t)item * 16384 + (size_t)half * 64 * 128 + j;
#pragma unroll
            for (int i = 0; i < 64; ++i) S[i] = __builtin_nontemporal_load(s0 + i * 128);
            __syncthreads();
#pragma unroll 1
            for (int t = 0; t < 4; ++t) {
                const int row = TP + sb * 4 + t;
                const float a = __expf(gbuf[row * 8 + h]), be = bbuf[row * 8 + h], v = bf2f(vv[(size_t)row * 1024 + h * 128 + j]);
                float kS = 0.f;
#pragma unroll
                for (int i4 = 0; i4 < 16; ++i4) { const f32x4 k4 = *(const LAS f32x4*)(ks + t * 128 + half * 64 + i4 * 4); kS += k4[0] * S[i4 * 4] + k4[1] * S[i4 * 4 + 1] + k4[2] * S[i4 * 4 + 2] + k4[3] * S[i4 * 4 + 3]; }
                kS += __shfl_xor(kS, 32);
                const float coef = be * (v - a * kS);
                float o = 0.f;
#pragma unroll
                for (int i4 = 0; i4 < 16; ++i4) { const f32x4 k4 = *(const LAS f32x4*)(ks + t * 128 + half * 64 + i4 * 4); const f32x4 q4 = *(const LAS f32x4*)(qs + t * 128 + half * 64 + i4 * 4);
#pragma unroll
                    for (int q = 0; q < 4; ++q) { S[i4 * 4 + q] = a * S[i4 * 4 + q] + k4[q] * coef; o += q4[q] * S[i4 * 4 + q]; } }
                o += __shfl_xor(o, 32);
                if (half == 0) obuf[(size_t)row * 1024 + h * 128 + j] = o * scale;
            }
            float* so = p.out + O_DS + (size_t)item * 16384 + (size_t)half * 64 * 128 + j;
#pragma unroll
            for (int i = 0; i < 64; ++i) so[i * 128] = S[i];
        }
    }
    __syncthreads();
}

__device__ __forceinline__ void onorm_phase(const Params& p, int bid, int nblk) {
    const int lane = threadIdx.x & 63, wid = __builtin_amdgcn_readfirstlane(threadIdx.x >> 6);
    const float* obuf = p.out + OS_O; const bf16_t* proj = (const bf16_t*)(p.ws + WS_PROJ); bf16_t* acat = (bf16_t*)(p.ws + WS_U); const float* og = p.in[14];
    for (int row = bid * 8 + wid; row < TT; row += nblk * 8) {
        const int c0 = lane * 16; float o[16], z[16], g[16];
#pragma unroll
        for (int i = 0; i < 4; ++i) { const f32x4 v = *(const f32x4*)(obuf + (size_t)row * 1024 + c0 + i * 4); o[i * 4] = v[0]; o[i * 4 + 1] = v[1]; o[i * 4 + 2] = v[2]; o[i * 4 + 3] = v[3];
            const f32x4 gg = *(const f32x4*)(og + (c0 & 127) + i * 4); g[i * 4] = gg[0]; g[i * 4 + 1] = gg[1]; g[i * 4 + 2] = gg[2]; g[i * 4 + 3] = gg[3]; }
        unpack8(*(const u32x4*)(proj + (size_t)row * NPROJ + C_Z + c0), z); unpack8(*(const u32x4*)(proj + (size_t)row * NPROJ + C_Z + c0 + 8), z + 8);
        float ss = 0.f;
#pragma unroll
        for (int i = 0; i < 16; ++i) ss += o[i] * o[i];
        ss += __shfl_xor(ss, 1); ss += __shfl_xor(ss, 2); ss += __shfl_xor(ss, 4);
        const float rstd = rsqrtf(ss * (1.0f / 128.0f) + EPS);
#pragma unroll
        for (int i = 0; i < 16; ++i) o[i] = o[i] * rstd * g[i] * siluf_(z[i]);
        *(u32x4*)(acat + (size_t)row * DM + c0) = pack8(o); *(u32x4*)(acat + (size_t)row * DM + c0 + 8) = pack8(o + 8);
    }
}

#define XB_TMO      128
#define XB_XCNT(j)  (256  + 64 * (j))
#define XB_XSUB(j)  (1280 + 64 * (j))
#define XB_XGEN(j)  (2304 + 64 * (j))
#define XB_TOP      3328
#define XB_TOPGEN   3392
#define XCD_BAR_WORDS 3456
#define XB_SPIN_CAP (1u << 18)

__device__ __forceinline__ unsigned xb_ld(unsigned* p)              { return __hip_atomic_load(p, __ATOMIC_RELAXED, __HIP_MEMORY_SCOPE_AGENT); }
__device__ __forceinline__ unsigned xb_add(unsigned* p, unsigned v) { return __hip_atomic_fetch_add(p, v, __ATOMIC_RELAXED, __HIP_MEMORY_SCOPE_AGENT); }
__device__ __forceinline__ unsigned xb_xcc_id() { return (unsigned)__builtin_amdgcn_s_getreg((3 << 11) | 20) & 0xFu; }
#define XB_SPIN(cond, bar) do { unsigned _sp = 0; while (cond) { __builtin_amdgcn_s_sleep(1); \
    if ((++_sp & 255u) == 0u) { if (xb_ld(&(bar)[XB_TMO])) break; if (_sp > XB_SPIN_CAP) { atomicAdd(&(bar)[XB_TMO], 1u); break; } } } } while (0)

struct XcdBarrier {
    unsigned* bar; unsigned x;
    volatile LAS unsigned* st;
};

__device__ __forceinline__ XcdBarrier xcd_barrier_post(unsigned* bar, volatile LAS unsigned* st) {
    XcdBarrier b; b.bar = bar; b.x = xb_xcc_id(); b.st = st;
    if (threadIdx.x == 0) (void)xb_add(&bar[XB_XCNT(b.x)], 1u);
    return b;
}
__device__ __forceinline__ void xcd_barrier_complete(unsigned* bar, unsigned x, unsigned& nloc, unsigned& nx) {
    const unsigned G = gridDim.x * gridDim.y * gridDim.z;
    unsigned sum, cnt, mine, sp = 0u;
    for (;;) {
        sum = 0u; cnt = 0u; mine = 0u;
#pragma unroll
        for (unsigned j = 0; j < 16; ++j) { const unsigned c = xb_ld(&bar[XB_XCNT(j)]); sum += c; cnt += (c > 0u) ? 1u : 0u; mine = (j == x) ? c : mine; }
        if (sum == G) break;
        __builtin_amdgcn_s_sleep(1);
        if ((++sp & 255u) == 0u) { if (xb_ld(&bar[XB_TMO])) break; if (sp > XB_SPIN_CAP) { atomicAdd(&bar[XB_TMO], 1u); break; } }
    }
    nloc = mine > 0u ? mine : 1u; nx = cnt > 0u ? cnt : 1u;
}

__device__ __forceinline__ void xcd_barrier(const XcdBarrier& b) {
    asm volatile("s_waitcnt vmcnt(0)" ::: "memory");
    __syncthreads();
    if (threadIdx.x == 0) {
        unsigned* bar = b.bar;
        __builtin_amdgcn_s_waitcnt(0);
        unsigned nloc = b.st[0], nx = b.st[1];
        if (nloc == 0u) { xcd_barrier_complete(bar, b.x, nloc, nx); b.st[0] = nloc; b.st[1] = nx; }
        const unsigned old = xb_add(&bar[XB_XSUB(b.x)], 1u);
        const unsigned gen = old / nloc;
        if (old + 1u == (gen + 1u) * nloc) {
            __builtin_amdgcn_fence(__ATOMIC_RELEASE, "agent");
            asm volatile("s_waitcnt vmcnt(0)" ::: "memory");
            const unsigned og = xb_add(&bar[XB_TOP], 1u);
            const unsigned tg = og / nx;
            if (og + 1u == (tg + 1u) * nx) xb_add(&bar[XB_TOPGEN], 1u);
            else XB_SPIN(xb_ld(&bar[XB_TOPGEN]) == tg, bar);
            __builtin_amdgcn_fence(__ATOMIC_ACQUIRE, "agent");
            xb_add(&bar[XB_XGEN(b.x)], 1u);
            asm volatile("s_waitcnt vmcnt(0)" ::: "memory");
        } else {
            XB_SPIN(xb_ld(&bar[XB_XGEN(b.x)]) == gen, bar);
            __builtin_amdgcn_fence(__ATOMIC_ACQUIRE, "agent");
            asm volatile("s_waitcnt vmcnt(0)" ::: "memory");
        }
    }
    __syncthreads();
}

constexpr size_t WS_BAR = WS_END;
constexpr int LDS_ST_OFF = LDS_BYTES - 16;
struct KArgs { Params p; TJob jobs[11]; };
constexpr int N_PHASES = 15;
#ifndef PH_MASK
#define PH_MASK 0xFFFF
#endif
#ifndef DUP_MASK
#define DUP_MASK 0
#endif

__global__ void __launch_bounds__(512, 2) fwd_megakernel(KArgs ka) {
    extern __shared__ __attribute__((aligned(16))) unsigned char lds_raw[];
    LAS unsigned char* lds = (LAS unsigned char*)lds_raw;
    const Params& p = ka.p;
    const int bid = blockIdx.x, nblk = gridDim.x;
    unsigned char* ws = p.ws;
    const int lo = p.ph_lo, hi = p.ph_hi;
    if (threadIdx.x < 4) ((LAS unsigned*)(lds + LDS_ST_OFF))[threadIdx.x] = 0u;
    __syncthreads();
    if (hi > 1000) cg::this_grid().sync();
    XcdBarrier xbar = xcd_barrier_post((unsigned*)(ws + WS_BAR), (volatile LAS unsigned*)(lds + LDS_ST_OFF));
#define IN(k) ((PH_MASK & (1 << (k))) && lo <= (k) && (k) < hi)
#define SEAM(k) do { if (lo <= (k) && (k) + 1 < hi) xcd_barrier(xbar); } while (0)
    if (IN(0)) for (int rep = 0; rep <= ((DUP_MASK >> 0) & 1); ++rep) {
            bf16_t* aada = (bf16_t*)(ws + WS_AADA);
            for (int idx = bid * 512 + threadIdx.x; idx < 256 * 2048; idx += nblk * 512) { const int row = idx >> 11, col = idx & 2047;
                const float v = row < 4 ? siluf_(p.in[2][row * 2048 + col]) : (row < NB ? siluf_(p.in[3][(row - 4) * 2048 + col]) : 0.f); aada[idx] = f2bf(v); }
            transpose_jobs(ka.jobs, 1, bid, nblk, lds);
        }
    SEAM(0);
    if (IN(1)) for (int rep = 0; rep <= ((DUP_MASK >> 1) & 1); ++rep) {
            if (bid < 48) { pg8::Gemm g{(const bf16_t*)(ws + WS_AADA), (const bf16_t*)(ws + WS_PROJ), 2048, 2048, 2048, 0, 0, 0, 0, 0}; pg8::OneUnitOrder S{48, bid, 32}; pg8::EpiAda E{(float*)(ws + WS_MOD), p.in[8]}; pg8::gemm_phase(lds, g, S, E); }
            else { transpose_jobs(ka.jobs + 1, 1, bid - 48, nblk - 48, lds); transpose_jobs(ka.jobs + 4, 7, bid - 48, nblk - 48, lds); }
        }
    SEAM(1);
    if (IN(2)) for (int rep = 0; rep <= ((DUP_MASK >> 2) & 1); ++rep) norm_phase<0>(p, bid, nblk);
    SEAM(2);
    if (IN(3)) for (int rep = 0; rep <= ((DUP_MASK >> 3) & 1); ++rep) { pg8::Gemm g{(const bf16_t*)(ws + WS_U), (const bf16_t*)(ws + WS_WIN), 2048, 2048, 2048, 0, 0, 0, 0, 0}; pg8::StaticOrder S; S.init(TT, NPROJ, 2048, nblk, bid); pg8::EpiBf16 E{(bf16_t*)(ws + WS_PROJ), NPROJ, 0, nullptr}; pg8::gemm_phase(lds, g, S, E); }
    SEAM(3);
    if (IN(4)) for (int rep = 0; rep <= ((DUP_MASK >> 4) & 1); ++rep) mixer_prep_phase(p, bid, nblk);
    SEAM(4);
    if (IN(5)) for (int rep = 0; rep <= ((DUP_MASK >> 5) & 1); ++rep) chunk_prep_phase(p, bid, nblk, lds);
    SEAM(5);
    if (IN(6)) for (int rep = 0; rep <= ((DUP_MASK >> 6) & 1); ++rep) scan_phase(p, bid, nblk, lds);
    SEAM(6);
    if (IN(7)) for (int rep = 0; rep <= ((DUP_MASK >> 7) & 1); ++rep) { onorm_phase(p, bid, nblk);
            pg8::Gemm g{(const bf16_t*)(ws + WS_YP), (const bf16_t*)(ws + WS_PW), 1024, 256, 256, 512, 0, 0, 0, 0}; pg8::StaticOrder S; S.init(TT, 1024, 256, nblk, bid); pg8::EpiBf16 E{(bf16_t*)(ws + WS_U), DM, 1024, p.in[16]}; pg8::gemm_phase(lds, g, S, E);
            if (rep == 0) { if (nblk <= 136) transpose_jobs(ka.jobs + 3, 1, bid, nblk, lds); else if (bid >= 136) transpose_jobs(ka.jobs + 3, 1, bid - 136, nblk - 136, lds); } }
    SEAM(7);
    if (IN(8)) for (int rep = 0; rep <= ((DUP_MASK >> 8) & 1); ++rep) {
            pg8::Gemm g{(const bf16_t*)(ws + WS_U), (const bf16_t*)(ws + WS_WAB), 2048, 2048, 1024, 0, 2048, 2048, (size_t)128 * 2048 * 2, (size_t)128 * 2048 * 2}; pg8::StaticOrder S; S.init(68 * 256, 16 * 256, 1024, nblk, bid);
            pg8::EpiDiag E{(bf16_t*)(ws + WS_QN), (const bf16_t*)(ws + WS_PROJ)}; pg8::gemm_phase(lds, g, S, E);
            if (rep == 0) { const int nfull = 1088 % nblk; if (nfull == 0 || nfull >= nblk) transpose_jobs(ka.jobs + 2, 1, bid, nblk, lds); else if (bid >= nfull) transpose_jobs(ka.jobs + 2, 1, bid - nfull, nblk - nfull, lds); } }
    SEAM(9);
    if (IN(10)) for (int rep = 0; rep <= ((DUP_MASK >> 10) & 1); ++rep) { pg8::Gemm g{(const bf16_t*)(ws + WS_QN), (const bf16_t*)(ws + WS_WO), 2048, 2048, 2048, 0, 0, 0, 0, 0}; pg8::SplitOrder S{nblk, bid, 32, 4, 8}; pg8::EpiRes E{p.out + O_Y, p.in[0], p.in[1], (const float*)(ws + WS_MOD) + 4096, (float*)(ws + WS_PB10)}; pg8::gemm_phase(lds, g, S, E); }
    SEAM(10);
    if (IN(11)) for (int rep = 0; rep <= ((DUP_MASK >> 11) & 1); ++rep) norm_phase<1>(p, bid, nblk);
    SEAM(11);
    if (IN(12)) for (int rep = 0; rep <= ((DUP_MASK >> 12) & 1); ++rep) { pg8::Gemm g{(const bf16_t*)(ws + WS_U), (const bf16_t*)(ws + WS_WGU), 2048, 2048, 2048, 0, 0, 0, 0, 0}; pg8::StaticOrder S; S.init(TT, 11264, 2048, nblk, bid); pg8::EpiGU E{(bf16_t*)(ws + WS_PROJ)}; pg8::gemm_phase(lds, g, S, E); }
    SEAM(12);
    if (IN(13)) for (int rep = 0; rep <= ((DUP_MASK >> 13) & 1); ++rep) { pg8::Gemm g{(const bf16_t*)(ws + WS_PROJ), (const bf16_t*)(ws + WS_WD), DFF, DFF, DFF, 0, 0, 0, 0, 0}; pg8::SplitOrder S{nblk, bid, 88, 8, 11}; pg8::EpiRes E{p.out + O_Y, p.out + O_Y, p.out + O_Y + (size_t)TP * DM, (const float*)(ws + WS_MOD) + 10240, (float*)(ws + WS_PB13)}; pg8::gemm_phase(lds, g, S, E); }
    SEAM(13);
    if (IN(14)) for (int rep = 0; rep <= ((DUP_MASK >> 14) & 1); ++rep) norm_phase<2>(p, bid, nblk);
    SEAM(14);
}

extern "C" void kernel_launch(void* const* d_in, const int* in_sizes, int n_in, void* d_out, int out_size, void* d_ws, size_t ws_size, hipStream_t stream) {
    static int grid = 0;
    if (grid == 0) {
        if (n_in != 24 || ws_size < WS_BAR + XCD_BAR_WORDS * 4) { fprintf(stderr, "kernel_launch: unexpected n_in %d / ws_size %zu (need %zu)\n", n_in, ws_size, (size_t)WS_END); grid = -1; return; }
        int dev = 0, cus = 0, per_cu = 0;
        hipGetDevice(&dev); hipDeviceGetAttribute(&cus, hipDeviceAttributeMultiprocessorCount, dev);
        if (hipFuncSetAttribute((const void*)fwd_megakernel, hipFuncAttributeMaxDynamicSharedMemorySize, LDS_BYTES) != hipSuccess) { fprintf(stderr, "kernel_launch: hipFuncSetAttribute failed\n"); grid = -1; return; }
        if (hipOccupancyMaxActiveBlocksPerMultiprocessor(&per_cu, (const void*)fwd_megakernel, 512, LDS_BYTES) != hipSuccess || per_cu < 1) { fprintf(stderr, "kernel_launch: occupancy query says %d\n", per_cu); per_cu = 1; }
        (void)hipGetLastError();
        grid = cus > 0 ? cus : 256;
        if (grid < 64) grid = 64;
    }
    if (grid < 0) return;
    if (hipMemsetAsync((unsigned char*)d_ws + WS_BAR, 0, XCD_BAR_WORDS * 4, stream) != hipSuccess) { fprintf(stderr, "kernel_launch: memset failed\n"); return; }
    KArgs ka; memset(&ka, 0, sizeof(ka));
    for (int i = 0; i < 24; ++i) ka.p.in[i] = (const float*)d_in[i];
    ka.p.out = (float*)d_out; ka.p.ws = (unsigned char*)d_ws;
    unsigned char* ws = (unsigned char*)d_ws;
    auto setjob = [&](int i, const void* src, void* dst, int ld_src, int K, int Nout, int ld_dst, int map) { TJob& j = ka.jobs[i]; j.src = (const float*)src; j.dst = (bf16_t*)dst; j.ld_src = ld_src; j.K = K; j.Nout = Nout; j.ld_dst = ld_dst; j.map = map; j.pad = 0; };
    setjob(0, d_in[7], ws + WS_PROJ, MODW, 2048, MODW, 2048, 0);
    setjob(1, d_in[10], ws + WS_WIN, 9232, 2048, NPROJ, 2048, 1);
    setjob(2, d_in[21], ws + WS_WGU, 2 * DFF, 2048, 2 * DFF, 2048, 2);
    setjob(3, d_in[22], ws + WS_WD, 2048, DFF, 2048, DFF, 0);
    setjob(4, d_in[19], ws + WS_WO, 2048, 2048, 2048, 2048, 0);
    setjob(5, d_in[17], ws + WS_WAB, 2048, 1024, 2048, 2048, 0);
    setjob(6, d_in[18], ws + WS_WAB + 1024 * 2, 2048, 1024, 2048, 2048, 0);
    for (int g = 0; g < 4; ++g) setjob(7 + g, (const float*)d_in[15] + g * 65536, ws + WS_PW + (size_t)g * 65536 * 2, 256, 256, 256, 256, 0);
#if MK_PER_PHASE
    for (int ph = 0; ph < N_PHASES; ++ph) { ka.p.ph_lo = ph; ka.p.ph_hi = ph + 1; hipLaunchKernelGGL(fwd_megakernel, dim3(grid), dim3(512), LDS_BYTES, stream, ka); }
#else
    ka.p.ph_lo = 0; ka.p.ph_hi = N_PHASES;
    void* args[] = {&ka};
    hipError_t e = hipLaunchCooperativeKernel((const void*)fwd_megakernel, dim3(grid), dim3(512), args, LDS_BYTES, stream);
    if (e != hipSuccess) fprintf(stderr, "cooperative launch failed: %s (grid %d)\n", hipGetErrorString(e), grid);
#endif
}
```
